# Optimizing an MI355X kernel written in HIP

```python
import math
import jax
import jax.numpy as jnp
from jax import lax
import numpy as np

D_MODEL = 1024
BATCH = 8
SEQ = 4096
DEPTH = 2

GRID_W = 64
CTX_LEN = 256
EPS = 1e-6
N_MOD = 6

NA_HEADS = 8
NA_HEAD_DIM = 64
NA_WIDTH = NA_HEADS * NA_HEAD_DIM
NA_KH_MAX = 8
NA_KW = 16

HY_WIDTH = 256
HY_SHORT = 3
HY_BANDS = 16
HY_EMB = 1 + 2 * HY_BANDS
HY_HIDDEN = 64
HY_FAST_DECAY = 0.3
HY_SLOW_DECAY = 1.5
HY_TARGET = 1e-2

RG_WIDTH = 256
RG_BLOCKS = 4
RG_BLOCK_DIM = RG_WIDTH // RG_BLOCKS
RG_CONV = 4
RG_C = 8.0

N_BRANCH = 3
HY_OFF = 3 * NA_WIDTH
RG_OFF = HY_OFF + 3 * HY_WIDTH
IN_COLS = RG_OFF + 2 * RG_WIDTH

PEER_HEADS = 8
PEER_DK = 256
PEER_N_KEYS = 128
PEER_TOPK = 16
PEER_N_EXPERTS = PEER_N_KEYS * PEER_N_KEYS
PEER_CHUNK = 128

kernel_name = 'hybrid_na_hyena_rglru_peer_dit'


def rmsnorm(x, g):
    xf = x.astype(jnp.float32)
    y = xf * lax.rsqrt(jnp.mean(xf * xf, axis=-1, keepdims=True) + EPS)
    return (y * g.astype(jnp.float32)).astype(x.dtype)


def dwconv(x, w, b, pad):
    y = lax.conv_general_dilated(x, w[:, None, :].astype(x.dtype), window_strides=(1,), padding=[pad],
                                 dimension_numbers=('NWC', 'WIO', 'NWC'), feature_group_count=x.shape[-1])
    return y + b.astype(x.dtype)


def neighbourhood_attention(q, k, v, kc, vc, rpb):
    B, T, H, hd = q.shape
    rows = T // GRID_W
    kh = min(NA_KH_MAX, rows)
    scale = hd ** -0.5
    qg = q.reshape(B, rows, GRID_W, H, hd)
    kg = k.reshape(B, rows, GRID_W, H, hd)
    vg = v.reshape(B, rows, GRID_W, H, hd)
    row_start = jnp.clip(jnp.arange(rows) - kh // 2, 0, rows - kh)
    cols = jnp.arange(GRID_W)
    col_keys = jnp.clip(cols - NA_KW // 2, 0, GRID_W - NA_KW)[:, None] + jnp.arange(NA_KW)[None, :]
    dc_idx = col_keys - cols[:, None] + (NA_KW - 1)

    def row_block(r):
        rs = row_start[r]
        q_r = lax.dynamic_index_in_dim(qg, r, axis=1, keepdims=False)
        k_win = lax.dynamic_slice_in_dim(kg, rs, kh, axis=1)[:, :, col_keys]
        v_win = lax.dynamic_slice_in_dim(vg, rs, kh, axis=1)[:, :, col_keys]
        dr_idx = rs + jnp.arange(kh) - r + (NA_KH_MAX - 1)
        bias = rpb[:, dr_idx[:, None, None], dc_idx[None]].transpose(0, 2, 1, 3)
        s_loc = jnp.einsum('bwhd,bawkhd->bhwak', q_r, k_win) * scale + bias
        s_loc = s_loc.reshape(B, H, GRID_W, kh * NA_KW)
        s_ctx = jnp.einsum('bwhd,bchd->bhwc', q_r, kc) * scale
        s = jnp.concatenate([s_loc.astype(jnp.float32), s_ctx.astype(jnp.float32)], axis=-1)
        p = jax.nn.softmax(s, axis=-1).astype(v.dtype)
        p_loc = p[..., :kh * NA_KW].reshape(B, H, GRID_W, kh, NA_KW)
        p_ctx = p[..., kh * NA_KW:]
        return (jnp.einsum('bhwak,bawkhd->bwhd', p_loc, v_win)
                + jnp.einsum('bhwc,bchd->bwhd', p_ctx, vc))

    out = lax.map(row_block, jnp.arange(rows))
    return out.transpose(1, 0, 2, 3, 4).reshape(B, T, H * hd)


def context_attention(q, k, v):
    scale = q.shape[-1] ** -0.5
    s = jnp.einsum('bqhd,bkhd->bhqk', q, k).astype(jnp.float32) * scale
    p = jax.nn.softmax(s, axis=-1).astype(v.dtype)
    o = jnp.einsum('bhqk,bkhd->bqhd', p, v)
    return o.reshape(q.shape[0], q.shape[1], -1)


def hyena_filters(L, f1_w, f1_b, f2_w, f2_b, f3_w, freq):
    f32 = jnp.float32
    t = jnp.linspace(0.0, 1.0, L, dtype=f32)[:, None]
    w = (2.0 * math.pi / L) * jnp.arange(L, dtype=f32)[:, None]
    bands = jnp.linspace(1e-4, HY_BANDS - 1, HY_BANDS, dtype=f32)[None, :]
    z = jnp.concatenate([t, jnp.cos(bands * w), -jnp.sin(bands * w)], axis=-1)
    h = jnp.sin(freq[0].astype(f32) * (z @ f1_w.astype(f32) + f1_b.astype(f32)))
    h = jnp.sin(freq[1].astype(f32) * (h @ f2_w.astype(f32) + f2_b.astype(f32)))
    h = h @ f3_w.astype(f32)
    deltas = jnp.linspace(math.log(HY_TARGET) / HY_SLOW_DECAY, math.log(HY_TARGET) / HY_FAST_DECAY,
                          HY_WIDTH, dtype=f32)
    decay = jnp.exp(-t * jnp.abs(deltas)[None, :])
    h = h.reshape(L, 2, HY_WIDTH) * decay[:, None, :]
    return h[:, 0], h[:, 1]


def bidirectional_long_conv(u, h_fwd, h_bwd):
    L = u.shape[1]
    k = jnp.concatenate([h_fwd, jnp.zeros_like(h_fwd[:1]), jnp.flip(h_bwd[1:], axis=0)], axis=0)
    U = jnp.fft.rfft(u.astype(jnp.float32), n=2 * L, axis=1)
    K = jnp.fft.rfft(k, n=2 * L, axis=0)
    return jnp.fft.irfft(U * K[None], n=2 * L, axis=1)[:, :L]


def hyena(p, short_w, short_b, f1_w, f1_b, f2_w, f2_b, f3_w, freq, d_skip):
    L = p.shape[1]
    pc = dwconv(p, short_w, short_b, (HY_SHORT // 2, HY_SHORT // 2))
    x0, x1, v = jnp.split(pc, 3, axis=-1)
    u = (v * x1).astype(jnp.float32)
    h_fwd, h_bwd = hyena_filters(L, f1_w, f1_b, f2_w, f2_b, f3_w, freq)
    y = bidirectional_long_conv(u, h_fwd, h_bwd) + u * d_skip.astype(jnp.float32)
    return (x0.astype(jnp.float32) * y).astype(p.dtype)


def _lru_combine(e1, e2):
    a1, b1 = e1
    a2, b2 = e2
    return a1 * a2, a2 * b1 + b2


def rglru_coeffs(xc, wa, ba, wx, bx, lam):
    B, L, _ = xc.shape
    f32 = jnp.float32
    xb = xc.reshape(B, L, RG_BLOCKS, RG_BLOCK_DIM)
    r = jax.nn.sigmoid(jnp.einsum('blnd,nde->blne', xb, wa.astype(f32)).reshape(B, L, RG_WIDTH) + ba.astype(f32))
    i = jax.nn.sigmoid(jnp.einsum('blnd,nde->blne', xb, wx.astype(f32)).reshape(B, L, RG_WIDTH) + bx.astype(f32))
    log_a = -RG_C * r * jax.nn.softplus(-lam.astype(f32))
    a = jnp.exp(log_a)
    return a, jnp.sqrt(-jnp.expm1(2.0 * log_a)) * (i * xc)


def linear_scan(a, b, h0):
    b = b.at[:, 0].add(a[:, 0] * h0)
    return lax.associative_scan(_lru_combine, (a, b), axis=1)[1]


def rglru_bidirectional(x, conv_w, conv_b, wa, ba, wx, bx, lam, h0_fwd, h0_bwd):
    xc = dwconv(x, conv_w, conv_b, (RG_CONV // 2, RG_CONV - 1 - RG_CONV // 2)).astype(jnp.float32)
    a_f, b_f = rglru_coeffs(xc, wa[0], ba[0], wx[0], bx[0], lam[0])
    a_b, b_b = rglru_coeffs(xc, wa[1], ba[1], wx[1], bx[1], lam[1])
    h_fwd = linear_scan(a_f, b_f, h0_fwd)
    h_bwd = jnp.flip(linear_scan(jnp.flip(a_b, 1), jnp.flip(b_b, 1), h0_bwd), 1)
    return h_fwd, h_bwd


def gated_merge(xn, ya, yb, yc, w_gate, b_gate, w_br_a, w_br_b, w_br_c, w_out):
    g = jax.nn.sigmoid((xn @ w_gate + b_gate).astype(jnp.float32)).astype(xn.dtype)
    g = g.reshape(xn.shape[:-1] + (N_BRANCH, D_MODEL))
    m = g[..., 0, :] * (ya @ w_br_a) + g[..., 1, :] * (yb @ w_br_b) + g[..., 2, :] * (yc @ w_br_c)
    return m @ w_out


def peer(xt, wq, keys, u, v):
    N, D = xt.shape

    def chunk(xb):
        q = (xb @ wq).reshape(PEER_CHUNK, PEER_HEADS, 2, PEER_DK // 2)
        s = jnp.einsum('thpd,hpkd->thpk', q, keys).astype(jnp.float32)
        s_top, i_top = lax.top_k(s, PEER_TOPK)
        cand = (s_top[:, :, 0, :, None] + s_top[:, :, 1, None, :]).reshape(PEER_CHUNK, PEER_HEADS, PEER_TOPK * PEER_TOPK)
        cand_idx = (i_top[:, :, 0, :, None] * PEER_N_KEYS + i_top[:, :, 1, None, :]).reshape(PEER_CHUNK, PEER_HEADS, PEER_TOPK * PEER_TOPK)
        best, pos = lax.top_k(cand, PEER_TOPK)
        idx = jnp.take_along_axis(cand_idx, pos, axis=-1)
        g = jax.nn.softmax(best, axis=-1)
        u_sel = jnp.take(u, idx, axis=0)
        v_sel = jnp.take(v, idx, axis=0)
        act = jax.nn.gelu(jnp.einsum('thkd,td->thk', u_sel, xb).astype(jnp.float32)) * g
        return jnp.einsum('thk,thkd->td', act.astype(xb.dtype), v_sel)

    return lax.map(chunk, xt.reshape(N // PEER_CHUNK, PEER_CHUNK, D)).reshape(N, D)


def setup_inputs(seed: int = 0) -> dict:
    key = jax.random.key(seed)
    ks = iter(jax.random.split(key, 48))
    f32 = jnp.float32
    D = D_MODEL

    def nrm(shape, scale):
        return jax.random.normal(next(ks), shape, f32) * scale

    a8 = jax.random.uniform(next(ks), (DEPTH, 2, RG_WIDTH), f32, 0.9, 0.999)
    a_base = a8 ** (1.0 / RG_C)
    return {
        'x': nrm((BATCH, SEQ, D), 1.0),
        'c': nrm((BATCH, D), 1.0),
        'ctx': nrm((BATCH, CTX_LEN, D), 1.0),
        'c_ctx': nrm((D,), 1.0),
        'norm_mix_g': 1.0 + nrm((DEPTH, D), 0.02),
        'norm_ffn_g': 1.0 + nrm((DEPTH, D), 0.02),
        'w_ada': nrm((DEPTH, D, N_MOD * D), 0.5 * D ** -0.5),
        'b_ada': nrm((DEPTH, N_MOD * D), 0.02),
        'w_in': nrm((DEPTH, D, IN_COLS), D ** -0.5),
        'na_rpb': nrm((DEPTH, NA_HEADS, 2 * NA_KH_MAX - 1, 2 * NA_KW - 1), 0.5),
        'hy_short_w': nrm((DEPTH, HY_SHORT, 3 * HY_WIDTH), HY_SHORT ** -0.5),
        'hy_short_b': nrm((DEPTH, 3 * HY_WIDTH), 0.02),
        'hy_f1_w': nrm((DEPTH, HY_EMB, HY_HIDDEN), HY_EMB ** -0.5),
        'hy_f1_b': nrm((DEPTH, HY_HIDDEN), 0.1),
        'hy_f2_w': nrm((DEPTH, HY_HIDDEN, HY_HIDDEN), HY_HIDDEN ** -0.5),
        'hy_f2_b': nrm((DEPTH, HY_HIDDEN), 0.1),
        'hy_f3_w': nrm((DEPTH, HY_HIDDEN, 2 * HY_WIDTH), 0.01),
        'hy_freq': 1.0 + nrm((DEPTH, 2, HY_HIDDEN), 0.1),
        'hy_bias': nrm((DEPTH, HY_WIDTH), 0.1),
        'rg_conv_w': nrm((DEPTH, RG_CONV, RG_WIDTH), RG_CONV ** -0.5),
        'rg_conv_b': nrm((DEPTH, RG_WIDTH), 0.02),
        'rg_wa': nrm((DEPTH, 2, RG_BLOCKS, RG_BLOCK_DIM, RG_BLOCK_DIM), RG_BLOCK_DIM ** -0.5),
        'rg_ba': nrm((DEPTH, 2, RG_WIDTH), 0.1),
        'rg_wx': nrm((DEPTH, 2, RG_BLOCKS, RG_BLOCK_DIM, RG_BLOCK_DIM), RG_BLOCK_DIM ** -0.5),
        'rg_bx': nrm((DEPTH, 2, RG_WIDTH), 0.1),
        'rg_lambda': jnp.log(a_base) - jnp.log1p(-a_base),
        'w_gate': nrm((DEPTH, D, N_BRANCH * D), D ** -0.5),
        'b_gate': nrm((DEPTH, N_BRANCH * D), 0.1),
        'w_br_a': nrm((DEPTH, NA_WIDTH, D), NA_WIDTH ** -0.5),
        'w_br_b': nrm((DEPTH, HY_WIDTH, D), HY_WIDTH ** -0.5),
        'w_br_c': nrm((DEPTH, RG_WIDTH, D), RG_WIDTH ** -0.5),
        'w_out': nrm((DEPTH, D, D), D ** -0.5),
        'peer_wq': nrm((DEPTH, D, PEER_HEADS * PEER_DK), D ** -0.5),
        'peer_keys': nrm((DEPTH, PEER_HEADS, 2, PEER_N_KEYS, PEER_DK // 2), (PEER_DK // 2) ** -0.5),
        'peer_u': nrm((DEPTH, PEER_N_EXPERTS, D), D ** -0.5),
        'peer_v': nrm((DEPTH, PEER_N_EXPERTS, D), 0.5),
        'final_g': 1.0 + nrm((D,), 0.02),
    }


def reference(x, c, ctx, c_ctx, norm_mix_g, norm_ffn_g, w_ada, b_ada, w_in, na_rpb,
              hy_short_w, hy_short_b, hy_f1_w, hy_f1_b, hy_f2_w, hy_f2_b, hy_f3_w, hy_freq, hy_bias,
              rg_conv_w, rg_conv_b, rg_wa, rg_ba, rg_wx, rg_bx, rg_lambda,
              w_gate, b_gate, w_br_a, w_br_b, w_br_c, w_out,
              peer_wq, peer_keys, peer_u, peer_v, final_g):
    B, T, D = x.shape
    C = ctx.shape[1]
    H, hd = NA_HEADS, NA_HEAD_DIM
    for l in range(DEPTH):
        last = l == DEPTH - 1
        mod = (jax.nn.silu(c) @ w_ada[l] + b_ada[l]).reshape(B, 1, N_MOD, D)
        mod_c = (jax.nn.silu(c_ctx) @ w_ada[l] + b_ada[l]).reshape(1, 1, N_MOD, D)
        hy_args = (hy_short_w[l], hy_short_b[l], hy_f1_w[l], hy_f1_b[l], hy_f2_w[l], hy_f2_b[l],
                   hy_f3_w[l], hy_freq[l], hy_bias[l])
        rg_args = (rg_conv_w[l], rg_conv_b[l], rg_wa[l], rg_ba[l], rg_wx[l], rg_bx[l], rg_lambda[l])
        merge_args = (w_gate[l], b_gate[l], w_br_a[l], w_br_b[l], w_br_c[l], w_out[l])

        xn = rmsnorm(x, norm_mix_g[l]) * (1.0 + mod[:, :, 1]) + mod[:, :, 0]
        cn = rmsnorm(ctx, norm_mix_g[l]) * (1.0 + mod_c[:, :, 1]) + mod_c[:, :, 0]
        p = xn @ w_in[l]
        pc = cn @ w_in[l]
        q = p[..., 0:NA_WIDTH].reshape(B, T, H, hd)
        k = p[..., NA_WIDTH:2 * NA_WIDTH].reshape(B, T, H, hd)
        v = p[..., 2 * NA_WIDTH:3 * NA_WIDTH].reshape(B, T, H, hd)
        qc = pc[..., 0:NA_WIDTH].reshape(B, C, H, hd)
        kc = pc[..., NA_WIDTH:2 * NA_WIDTH].reshape(B, C, H, hd)
        vc = pc[..., 2 * NA_WIDTH:3 * NA_WIDTH].reshape(B, C, H, hd)
        ya = neighbourhood_attention(q, k, v, kc, vc, na_rpb[l])
        yb = hyena(p[..., HY_OFF:RG_OFF], *hy_args)
        h0 = jnp.zeros((B, RG_WIDTH), jnp.float32)
        hf_c, hb_c = rglru_bidirectional(pc[..., RG_OFF:RG_OFF + RG_WIDTH], *rg_args, h0, h0)
        hf, hb = rglru_bidirectional(p[..., RG_OFF:RG_OFF + RG_WIDTH], *rg_args, hf_c[:, -1], hb_c[:, 0])
        yc = ((hf + hb) * jax.nn.gelu(p[..., RG_OFF + RG_WIDTH:IN_COLS].astype(jnp.float32))).astype(x.dtype)
        x = x + (mod[:, :, 2] * gated_merge(xn, ya, yb, yc, *merge_args)).astype(x.dtype)
        if not last:
            ya_c = context_attention(qc, kc, vc)
            yb_c = hyena(pc[..., HY_OFF:RG_OFF], *hy_args)
            yc_c = ((hf_c + hb_c) * jax.nn.gelu(pc[..., RG_OFF + RG_WIDTH:IN_COLS].astype(jnp.float32))).astype(ctx.dtype)
            ctx = ctx + (mod_c[:, :, 2] * gated_merge(cn, ya_c, yb_c, yc_c, *merge_args)).astype(ctx.dtype)

        xn = rmsnorm(x, norm_ffn_g[l]) * (1.0 + mod[:, :, 4]) + mod[:, :, 3]
        y = peer(xn.reshape(B * T, D), peer_wq[l], peer_keys[l], peer_u[l], peer_v[l]).reshape(B, T, D)
        x = x + (mod[:, :, 5] * y).astype(x.dtype)
        if not last:
            cn = rmsnorm(ctx, norm_ffn_g[l]) * (1.0 + mod_c[:, :, 4]) + mod_c[:, :, 3]
            yc_f = peer(cn.reshape(B * C, D), peer_wq[l], peer_keys[l], peer_u[l], peer_v[l]).reshape(B, C, D)
            ctx = ctx + (mod_c[:, :, 5] * yc_f).astype(ctx.dtype)
    return rmsnorm(x, final_g)
```

```cpp
#include <hip/hip_runtime.h>
#include <hip/hip_cooperative_groups.h>
#include <cstdio>
#include <cstring>
namespace cg = cooperative_groups;

typedef unsigned short u16;
typedef __attribute__((ext_vector_type(8))) short bf16x8;
typedef __attribute__((ext_vector_type(16))) float f32x16;

#define NLAT 32768
#define NTOK 34816
#define SMEM_BYTES 151552
#define NTHR 512

struct P {
  const float *x, *c, *ctx, *c_ctx, *norm_mix_g, *norm_ffn_g, *w_ada, *b_ada, *w_in, *na_rpb,
      *hy_short_w, *hy_short_b, *hy_f1_w, *hy_f1_b, *hy_f2_w, *hy_f2_b, *hy_f3_w, *hy_freq, *hy_bias,
      *rg_conv_w, *rg_conv_b, *rg_wa, *rg_ba, *rg_wx, *rg_bx, *rg_lambda,
      *w_gate, *b_gate, *w_br_a, *w_br_b, *w_br_c, *w_out, *peer_wq, *peer_keys, *peer_u, *peer_v, *final_g;
  float* out;
  unsigned* counters;
  u16 *WinT, *WgT, *WaT, *WbT, *WcT, *WoT, *WqT, *keysB, *rgW;
  float *modpart, *mod, *hT, *hc;
  float* Kf;
  u16 *xn, *qk, *vT, *vTc, *hyT, *hyTc, *rg, *ycat, *mbuf, *Ub, *Vb;
  float *hf, *ctxs;
  unsigned* topk;
};

__device__ __forceinline__ u16 f2bf(float f) {
  unsigned u = __float_as_uint(f);
  u += 0x7fffu + ((u >> 16) & 1u);
  return (u16)(u >> 16);
}
__device__ __forceinline__ float bf2f(u16 h) { return __uint_as_float(((unsigned)h) << 16); }
__device__ __forceinline__ unsigned pk2(float a, float b) { return (unsigned)f2bf(a) | ((unsigned)f2bf(b) << 16); }
__device__ __forceinline__ float bflo(unsigned u) { return __uint_as_float(u << 16); }
__device__ __forceinline__ float bfhi(unsigned u) { return __uint_as_float(u & 0xffff0000u); }
__device__ __forceinline__ int opaque_tid() {
  int t = threadIdx.x;
  asm volatile("" : "+v"(t));
  return t;
}
__device__ __forceinline__ float wave_sum(float v) {
#pragma unroll
  for (int o = 32; o > 0; o >>= 1) v += __shfl_xor(v, o);
  return v;
}
__device__ __forceinline__ float wave_max(float v) {
#pragma unroll
  for (int o = 32; o > 0; o >>= 1) v = fmaxf(v, __shfl_xor(v, o));
  return v;
}
__device__ __forceinline__ float sigmoidf_(float x) { return 1.0f / (1.0f + __expf(-x)); }
__device__ __forceinline__ float gelu_tanh(float x) {
  float u = 0.7978845608028654f * (x + 0.044715f * x * x * x);
  return 0.5f * x * (1.0f + tanhf(u));
}
__device__ __forceinline__ f32x16 mfma32(bf16x8 a, bf16x8 b, f32x16 c) {
  return __builtin_amdgcn_mfma_f32_32x32x16_bf16(a, b, c, 0, 0, 0);
}
__device__ __forceinline__ f32x16 zero16() {
  f32x16 z;
#pragma unroll
  for (int i = 0; i < 16; ++i) z[i] = 0.f;
  return z;
}
__device__ __forceinline__ int swz128(int row, int ch) { return row * 128 + ((ch ^ ((row >> 1) & 7)) << 4); }
__device__ __forceinline__ int swz256(int row, int ch) { return row * 256 + ((ch ^ (row & 15)) << 4); }

struct c2 { float x, y; };
__device__ __forceinline__ c2 cadd(c2 a, c2 b) { return {a.x + b.x, a.y + b.y}; }
__device__ __forceinline__ c2 csub(c2 a, c2 b) { return {a.x - b.x, a.y - b.y}; }
__device__ __forceinline__ c2 cmul(c2 a, c2 b) { return {a.x * b.x - a.y * b.y, a.x * b.y + a.y * b.x}; }
__device__ __forceinline__ float c16(int i) {
  const float tb[16] = {1.0f, 0.9238795325112867f, 0.7071067811865476f, 0.3826834323650898f, 0.0f,
                        -0.3826834323650898f, -0.7071067811865476f, -0.9238795325112867f, -1.0f,
                        -0.9238795325112867f, -0.7071067811865476f, -0.3826834323650898f, 0.0f,
                        0.3826834323650898f, 0.7071067811865476f, 0.9238795325112867f};
  return tb[i & 15];
}
__device__ __forceinline__ float s16(int i) { return c16(i + 12); }
template <int R> __device__ __forceinline__ constexpr int brev(int k) {
  int r = 0;
  for (int b = 1, o = R >> 1; b < R; b <<= 1, o >>= 1)
    if (k & b) r |= o;
  return r;
}
template <int R> __device__ __forceinline__ void dft_reg(c2* v, float sgn) {
#pragma unroll
  for (int h = R / 2; h >= 1; h >>= 1) {
#pragma unroll
    for (int g = 0; g < R; g += 2 * h) {
#pragma unroll
      for (int j = 0; j < h; ++j) {
        c2 a = v[g + j], b = v[g + j + h];
        v[g + j] = cadd(a, b);
        c2 d = csub(a, b);
        const int ti = j * (16 / (2 * h));
        c2 w = {c16(ti), sgn * s16(ti)};
        v[g + j + h] = (j == 0) ? d : cmul(d, w);
      }
    }
  }
}
template <int R> __device__ __forceinline__ int fft_bfly(c2* v, int j, int Ns, float sgn) {
  const int k = j & (Ns - 1);
  const float f = sgn * (float)k / (float)(Ns * R);
#pragma unroll
  for (int r = 1; r < R; ++r) {
    float t = f * (float)r;
    c2 w = {__builtin_amdgcn_cosf(t), __builtin_amdgcn_sinf(t)};
    v[r] = cmul(v[r], w);
  }
  dft_reg<R>(v, sgn);
  return (j - k) * R + k;
}
template <int R> __device__ __forceinline__ void fft_pass(c2* buf, int Ns, float sgn) {
  constexpr int NBF = 8192 / R;
  constexpr int PER = NBF / NTHR;
  const int tid = opaque_tid();
  c2 v[PER][R];
#pragma unroll
  for (int i = 0; i < PER; ++i) {
    const int j = tid + NTHR * i;
#pragma unroll
    for (int r = 0; r < R; ++r) v[i][r] = buf[j + r * NBF];
  }
  __syncthreads();
#pragma unroll
  for (int i = 0; i < PER; ++i) {
    const int j = tid + NTHR * i;
    const int base = fft_bfly<R>(v[i], j, Ns, sgn);
#pragma unroll
    for (int r = 0; r < R; ++r) buf[base + r * Ns] = v[i][brev<R>(r)];
  }
  __syncthreads();
}
__device__ __forceinline__ void fft8192(c2* buf, float sgn) {
  fft_pass<8>(buf, 1, sgn);
  fft_pass<8>(buf, 8, sgn);
  fft_pass<8>(buf, 64, sgn);
  fft_pass<16>(buf, 512, sgn);
}

__device__ __forceinline__ void gemm_kloop(f32x16 (&acc)[2][2], const u16* __restrict__ A, int lda,
                                           const u16* __restrict__ B, int ldb, int K, char* smem) {
  const int tid = opaque_tid(), lane = tid & 63, wid = tid >> 6;
  const int wm = wid >> 1, wn = wid & 1;
  const int l31 = lane & 31, hh = lane >> 5;
  uint4 ra[4], rb[2];
  const int nk = K >> 6;
  const int srow = tid >> 3, sch = tid & 7;
  const char* Ab = (const char*)A;
  const char* Bb = (const char*)B;
  const unsigned aoff = (unsigned)(srow * lda + sch * 8) * 2u;
  const unsigned boff = (unsigned)(srow * ldb + sch * 8) * 2u;
  const unsigned astep = (unsigned)lda * 128u, bstep = (unsigned)ldb * 128u;
#pragma unroll
  for (int i = 0; i < 4; ++i) ra[i] = *(const uint4*)(Ab + (aoff + i * astep));
#pragma unroll
  for (int i = 0; i < 2; ++i) rb[i] = *(const uint4*)(Bb + (boff + i * bstep));
#pragma unroll
  for (int i = 0; i < 4; ++i) *(uint4*)(smem + swz128(srow + i * 64, sch)) = ra[i];
#pragma unroll
  for (int i = 0; i < 2; ++i) *(uint4*)(smem + 65536 + swz128(srow + i * 64, sch)) = rb[i];
  __syncthreads();
  for (int kt = 0; kt < nk; ++kt) {
    const bool more = (kt + 1 < nk);
    if (more) {
      const unsigned ko = (unsigned)(kt + 1) * 128u;
#pragma unroll
      for (int i = 0; i < 4; ++i) ra[i] = *(const uint4*)(Ab + (aoff + i * astep + ko));
#pragma unroll
      for (int i = 0; i < 2; ++i) rb[i] = *(const uint4*)(Bb + (boff + i * bstep + ko));
    }
    const char* as = smem + (kt & 1) * 32768;
    const char* bs = smem + 65536 + (kt & 1) * 16384;
    int lrow = l31;
    asm volatile("" : "+v"(lrow));
#pragma unroll
    for (int s = 0; s < 4; ++s) {
      bf16x8 af[2], bfr[2];
#pragma unroll
      for (int i = 0; i < 2; ++i) af[i] = *(const bf16x8*)(as + swz128(wm * 64 + i * 32 + lrow, s * 2 + hh));
#pragma unroll
      for (int j = 0; j < 2; ++j) bfr[j] = *(const bf16x8*)(bs + swz128(wn * 64 + j * 32 + lrow, s * 2 + hh));
#pragma unroll
      for (int i = 0; i < 2; ++i)
#pragma unroll
        for (int j = 0; j < 2; ++j) acc[i][j] = mfma32(af[i], bfr[j], acc[i][j]);
    }
    if (more) {
      char* an = smem + ((kt + 1) & 1) * 32768;
      char* bn = smem + 65536 + ((kt + 1) & 1) * 16384;
      int sr2 = srow;
      asm volatile("" : "+v"(sr2));
#pragma unroll
      for (int i = 0; i < 4; ++i) *(uint4*)(an + swz128(sr2 + i * 64, sch)) = ra[i];
#pragma unroll
      for (int i = 0; i < 2; ++i) *(uint4*)(bn + swz128(sr2 + i * 64, sch)) = rb[i];
    }
    __syncthreads();
  }
}
__device__ __forceinline__ void zero_acc(f32x16 (&acc)[2][2]) {
#pragma unroll
  for (int i = 0; i < 2; ++i)
#pragma unroll
    for (int j = 0; j < 2; ++j) acc[i][j] = zero16();
}
#define EPI_ROW(i, e) (wm * 64 + (i)*32 + ((e)&3) + 8 * ((e) >> 2) + 4 * hh)
#define EPI_COL(j) (wn * 64 + (j)*32 + l31)
#define EPI_VARS                                                    \
  const int tid = opaque_tid(), lane = tid & 63, wid = tid >> 6;     \
  const int wm = wid >> 1, wn = wid & 1, l31 = lane & 31, hh = lane >> 5; \
  (void)tid; (void)wm; (void)wn; (void)l31; (void)hh;

__device__ void tr_tile(const float* __restrict__ src, int N, int K, u16* __restrict__ dst, int tile, char* smem) {
  float* lds = (float*)smem;
  const int tiles_n = N >> 6;
  const int tk = tile / tiles_n, tn = tile - tk * tiles_n;
  const int tid = opaque_tid();
  {
    const int r = tid >> 3, c8 = (tid & 7) * 8;
    const float* s = src + (size_t)(tk * 64 + r) * N + tn * 64 + c8;
    float4 a = *(const float4*)s, b = *(const float4*)(s + 4);
    float* d = lds + r * 65 + c8;
    d[0] = a.x; d[1] = a.y; d[2] = a.z; d[3] = a.w; d[4] = b.x; d[5] = b.y; d[6] = b.z; d[7] = b.w;
  }
  __syncthreads();
  {
    const int n = tid >> 3, k0 = (tid & 7) * 8;
    uint4 o;
    o.x = pk2(lds[(k0 + 0) * 65 + n], lds[(k0 + 1) * 65 + n]);
    o.y = pk2(lds[(k0 + 2) * 65 + n], lds[(k0 + 3) * 65 + n]);
    o.z = pk2(lds[(k0 + 4) * 65 + n], lds[(k0 + 5) * 65 + n]);
    o.w = pk2(lds[(k0 + 6) * 65 + n], lds[(k0 + 7) * 65 + n]);
    *(uint4*)(dst + (size_t)(tn * 64 + n) * K + tk * 64 + k0) = o;
  }
  __syncthreads();
}
__device__ void cvt_chunk(const float* __restrict__ src, u16* __restrict__ dst, size_t chunk) {
  const size_t i = chunk * 4096 + (size_t)opaque_tid() * 8;
  float4 a = *(const float4*)(src + i), b = *(const float4*)(src + i + 4);
  uint4 o;
  o.x = pk2(a.x, a.y); o.y = pk2(a.z, a.w); o.z = pk2(b.x, b.y); o.w = pk2(b.z, b.w);
  *(uint4*)(dst + i) = o;
}
__device__ void phase_prep(const P& p, char* smem) {
  const int tid = opaque_tid();
  const int NTR = 2512;
  const int total = 2 * NTR + 128 + 384;
  for (int task = blockIdx.x; task < total; task += gridDim.x) {
    if (task < 2 * NTR) {
      const int l = task / NTR;
      int t = task - l * NTR;
      if (t < 704) tr_tile(p.w_in + (size_t)l * 1024 * 2816, 2816, 1024, p.WinT + (size_t)l * 2816 * 1024, t, smem);
      else if ((t -= 704) < 768) tr_tile(p.w_gate + (size_t)l * 1024 * 3072, 3072, 1024, p.WgT + (size_t)l * 3072 * 1024, t, smem);
      else if ((t -= 768) < 128) tr_tile(p.w_br_a + (size_t)l * 512 * 1024, 1024, 512, p.WaT + (size_t)l * 1024 * 512, t, smem);
      else if ((t -= 128) < 64) tr_tile(p.w_br_b + (size_t)l * 256 * 1024, 1024, 256, p.WbT + (size_t)l * 1024 * 256, t, smem);
      else if ((t -= 64) < 64) tr_tile(p.w_br_c + (size_t)l * 256 * 1024, 1024, 256, p.WcT + (size_t)l * 1024 * 256, t, smem);
      else if ((t -= 64) < 256) tr_tile(p.w_out + (size_t)l * 1024 * 1024, 1024, 1024, p.WoT + (size_t)l * 1024 * 1024, t, smem);
      else if ((t -= 256) < 512) tr_tile(p.peer_wq + (size_t)l * 1024 * 2048, 2048, 1024, p.WqT + (size_t)l * 2048 * 1024, t, smem);
      else {
        t -= 512;
        const int gate = t >> 3, dn = t & 7;
        const float* src = (gate ? p.rg_wx : p.rg_wa) + (size_t)(l * 8 + dn) * 4096;
        tr_tile(src, 64, 64, p.rgW + (size_t)((l * 2 + gate) * 8 + dn) * 4096, 0, smem);
      }
    } else if (task < 2 * NTR + 128) {
      cvt_chunk(p.peer_keys, p.keysB, (size_t)(task - 2 * NTR));
    } else {
      int t = task - 2 * NTR - 128;
      const int kc = t & 15; t >>= 4;
      const int jc = t % 12, l = t / 12;
      float* s = (float*)smem;
      for (int i = tid; i < 576; i += NTHR) {
        const int bi = i >> 6, kk = i & 63;
        const float v = (bi < 8) ? p.c[bi * 1024 + kc * 64 + kk] : p.c_ctx[kc * 64 + kk];
        s[i] = v / (1.0f + __expf(-v));
      }
      __syncthreads();
      const int j = jc * 512 + tid;
      float acc[9];
#pragma unroll
      for (int bi = 0; bi < 9; ++bi) acc[bi] = 0.f;
      const float* wp = p.w_ada + ((size_t)l * 1024 + kc * 64) * 6144 + j;
#pragma unroll 8
      for (int kk = 0; kk < 64; ++kk) {
        const float w = wp[(size_t)kk * 6144];
#pragma unroll
        for (int bi = 0; bi < 9; ++bi) acc[bi] += s[bi * 64 + kk] * w;
      }
#pragma unroll
      for (int bi = 0; bi < 9; ++bi) p.modpart[((size_t)(kc * 2 + l) * 9 + bi) * 6144 + j] = acc[bi];
      __syncthreads();
    }
  }
}
__device__ void phase_modreduce(const P& p) {
  const int n = 2 * 9 * 6144;
  for (int i = blockIdx.x * NTHR + opaque_tid(); i < n; i += gridDim.x * NTHR) {
    const int l = i / (9 * 6144);
    const int j = i % 6144;
    float s = p.b_ada[l * 6144 + j];
#pragma unroll
    for (int kc = 0; kc < 16; ++kc) s += p.modpart[(size_t)kc * n + i];
    p.mod[i] = s;
  }
}

__device__ void phase_norm(const P& p, int l, int which) {
  const int tid_ = opaque_tid(); const int lane = tid_ & 63, wid = tid_ >> 6;
  const int ntok = (which == 2 || (which == 1 && l == 1)) ? NLAT : NTOK;
  for (int row = blockIdx.x * 8 + wid; row < ntok; row += gridDim.x * 8) {
    const float* src;
    if (row < NLAT) src = ((which == 0 && l == 0) ? p.x : p.out) + (size_t)row * 1024;
    else src = ((which == 0 && l == 0) ? p.ctx : p.ctxs) + (size_t)(row - NLAT) * 1024;
    float4 v[4];
    float ss = 0.f;
#pragma unroll
    for (int i = 0; i < 4; ++i) {
      v[i] = *(const float4*)(src + i * 256 + lane * 4);
      ss += v[i].x * v[i].x + v[i].y * v[i].y + v[i].z * v[i].z + v[i].w * v[i].w;
    }
    ss = wave_sum(ss);
    const float rstd = rsqrtf(ss * (1.0f / 1024.0f) + 1e-6f);
    if (which == 2) {
#pragma unroll
      for (int i = 0; i < 4; ++i) {
        const int col = i * 256 + lane * 4;
        const float4 g = *(const float4*)(p.final_g + col);
        float4 o = {v[i].x * rstd * g.x, v[i].y * rstd * g.y, v[i].z * rstd * g.z, v[i].w * rstd * g.w};
        *(float4*)(p.out + (size_t)row * 1024 + col) = o;
      }
    } else {
      const int bi = row < NLAT ? (row >> 12) : 8;
      const float* gam = (which == 0 ? p.norm_mix_g : p.norm_ffn_g) + l * 1024;
      const float* msh = p.mod + ((size_t)(l * 9 + bi) * 6 + (which == 0 ? 0 : 3)) * 1024;
      const float* msc = msh + 1024;
#pragma unroll
      for (int i = 0; i < 4; ++i) {
        const int col = i * 256 + lane * 4;
        const float4 g = *(const float4*)(gam + col);
        const float4 sh = *(const float4*)(msh + col);
        const float4 sc = *(const float4*)(msc + col);
        uint2 o;
        o.x = pk2(v[i].x * rstd * g.x * (1.f + sc.x) + sh.x, v[i].y * rstd * g.y * (1.f + sc.y) + sh.y);
        o.y = pk2(v[i].z * rstd * g.z * (1.f + sc.z) + sh.z, v[i].w * rstd * g.w * (1.f + sc.w) + sh.w);
        *(uint2*)(p.xn + (size_t)row * 1024 + col) = o;
      }
    }
  }
}

__device__ void filter_wave(const P& p, int l, int L, int t, float* __restrict__ outp) {
  const int lane = opaque_tid() & 63;
  const float tl = (float)t / (float)(L - 1);
  const float wang = (6.283185307179586f / (float)L) * (float)t;
  float z = 0.f;
  if (lane == 0) z = tl;
  else if (lane <= 16) { const float band = 1e-4f + (float)(lane - 1) * ((15.0f - 1e-4f) / 15.0f); z = cosf(band * wang); }
  else if (lane <= 32) { const float band = 1e-4f + (float)(lane - 17) * ((15.0f - 1e-4f) / 15.0f); z = -sinf(band * wang); }
  float a1 = p.hy_f1_b[l * 64 + lane];
  for (int i = 0; i < 33; ++i) a1 += __shfl(z, i) * p.hy_f1_w[(l * 33 + i) * 64 + lane];
  const float h1 = sinf(p.hy_freq[l * 128 + lane] * a1);
  float a2 = p.hy_f2_b[l * 64 + lane];
  for (int i = 0; i < 64; ++i) a2 += __shfl(h1, i) * p.hy_f2_w[(l * 64 + i) * 64 + lane];
  const float h2 = sinf(p.hy_freq[l * 128 + 64 + lane] * a2);
  float a3[8];
#pragma unroll
  for (int m = 0; m < 8; ++m) a3[m] = 0.f;
  for (int i = 0; i < 64; ++i) {
    const float hv = __shfl(h2, i);
    const float* wr = p.hy_f3_w + (size_t)(l * 64 + i) * 512 + lane;
#pragma unroll
    for (int m = 0; m < 8; ++m) a3[m] += hv * wr[m * 64];
  }
  const float LN100 = 4.605170185988092f;
  const float d0 = LN100 / 1.5f, d1 = LN100 / 0.3f;
#pragma unroll
  for (int m = 0; m < 8; ++m) {
    const int cp = lane + 64 * m;
    const int ch = cp & 255;
    const float delta = d0 + (float)ch * ((d1 - d0) / 255.0f);
    outp[(size_t)cp * L + t] = a3[m] * expf(-tl * delta);
  }
}
__device__ void phase_filters(const P& p, int l) {
  const int wid = opaque_tid() >> 6;
  const int ntask = 4096 + (l == 0 ? 256 : 0);
  for (int t = blockIdx.x * 8 + wid; t < ntask; t += gridDim.x * 8) {
    if (t < 4096) filter_wave(p, l, 4096, t, p.hT);
    else filter_wave(p, l, 256, t - 4096, p.hc);
  }
}
__device__ void kf_task(const P& p, int c, char* smem) {
  c2* buf = (c2*)smem;
  const int tid = opaque_tid();
  for (int i = 0; i < 16; ++i) {
    const int j = tid + NTHR * i;
    float v;
    if (j < 4096) v = p.hT[(size_t)c * 4096 + j];
    else if (j == 4096) v = 0.f;
    else v = p.hT[(size_t)(256 + c) * 4096 + (8192 - j)];
    buf[j] = {v, 0.f};
  }
  __syncthreads();
  fft8192(buf, -1.f);
  c2* o = (c2*)p.Kf + (size_t)c * 8192;
  for (int i = 0; i < 16; ++i) { const int j = tid + NTHR * i; o[j] = buf[j]; }
  __syncthreads();
}

__device__ void inproj_tile(const P& p, int l, int mt, int nt, char* smem) {
  f32x16 acc[2][2];
  zero_acc(acc);
  const int m0 = mt * 256, n0 = nt * 128;
  gemm_kloop(acc, p.xn + (size_t)m0 * 1024, 1024, p.WinT + ((size_t)l * 2816 + n0) * 1024, 1024, 1024, smem);
  EPI_VARS
  if (nt < 8 || nt >= 18) {
    u16* dst; int ld, cbase;
    if (nt < 8) { dst = p.qk; ld = 1024; cbase = n0; }
    else { dst = p.rg; ld = 512; cbase = n0 - 2304; }
#pragma unroll
    for (int i = 0; i < 2; ++i)
#pragma unroll
      for (int j = 0; j < 2; ++j)
#pragma unroll
        for (int e = 0; e < 16; ++e)
          dst[(size_t)(m0 + EPI_ROW(i, e)) * ld + cbase + EPI_COL(j)] = f2bf(acc[i][j][e]);
  } else {
#pragma unroll
    for (int i = 0; i < 2; ++i)
#pragma unroll
      for (int j = 0; j < 2; ++j)
#pragma unroll
        for (int qd = 0; qd < 4; ++qd) {
          uint2 o;
          o.x = pk2(acc[i][j][4 * qd + 0], acc[i][j][4 * qd + 1]);
          o.y = pk2(acc[i][j][4 * qd + 2], acc[i][j][4 * qd + 3]);
          const int row0 = wm * 64 + i * 32 + 8 * qd + 4 * hh;
          *(uint2*)(smem + EPI_COL(j) * 520 + row0 * 2) = o;
        }
    __syncthreads();
    u16* dstT; int Lseg, t0, ncol0, nc;
    const bool isctx = (mt >= 128);
    const int b = isctx ? (mt - 128) : (mt >> 4);
    if (nt < 12) { ncol0 = n0 - 1024; nc = 512; dstT = isctx ? p.vTc : p.vT; }
    else { ncol0 = n0 - 1536; nc = 768; dstT = isctx ? p.hyTc : p.hyT; }
    if (isctx) { Lseg = 256; t0 = 0; } else { Lseg = 4096; t0 = (mt & 15) * 256; }
#pragma unroll 4
    for (int it = 0; it < 16; ++it) {
      const int idx = tid + NTHR * it;
      const int col = idx >> 6, u = idx & 63;
      const uint2 v = *(const uint2*)(smem + col * 520 + u * 8);
      *(uint2*)(dstT + ((size_t)(b * nc + ncol0 + col)) * Lseg + t0 + u * 4) = v;
    }
    __syncthreads();
  }
}

__device__ __forceinline__ float ldbf(const u16* p, int t, int L) { return (t >= 0 && t < L) ? bf2f(p[t]) : 0.f; }
__device__ void hyena_fft_task(const P& p, int l, int c, int bp, char* smem) {
  c2* buf = (c2*)smem;
  c2* ub = (c2*)(smem + 65536);
  const int tid = opaque_tid();
  const float* sw = p.hy_short_w + l * 3 * 768;
  const float* sb = p.hy_short_b + l * 768;
  const float wx0[3] = {sw[c], sw[768 + c], sw[1536 + c]};
  const float wx1[3] = {sw[256 + c], sw[768 + 256 + c], sw[1536 + 256 + c]};
  const float wv[3] = {sw[512 + c], sw[768 + 512 + c], sw[1536 + 512 + c]};
  const float bx0 = sb[c], bx1 = sb[256 + c], bv = sb[512 + c];
  const float dsk = p.hy_bias[l * 256 + c];
  for (int i = 0; i < 8; ++i) {
    const int t = tid + NTHR * i;
    float u[2];
#pragma unroll
    for (int bb = 0; bb < 2; ++bb) {
      const int b = 2 * bp + bb;
      const u16* x1 = p.hyT + ((size_t)(b * 768 + 256 + c)) * 4096;
      const u16* vv = p.hyT + ((size_t)(b * 768 + 512 + c)) * 4096;
      const float x1c = bx1 + wx1[0] * ldbf(x1, t - 1, 4096) + wx1[1] * ldbf(x1, t, 4096) + wx1[2] * ldbf(x1, t + 1, 4096);
      const float vc = bv + wv[0] * ldbf(vv, t - 1, 4096) + wv[1] * ldbf(vv, t, 4096) + wv[2] * ldbf(vv, t + 1, 4096);
      u[bb] = vc * x1c;
    }
    buf[t] = {u[0], u[1]};
    ub[t] = {u[0], u[1]};
    buf[t + 4096] = {0.f, 0.f};
  }
  __syncthreads();
  fft8192(buf, -1.f);
  const c2* kf = (const c2*)p.Kf + (size_t)c * 8192;
  for (int i = 0; i < 16; ++i) {
    const int k = tid + NTHR * i;
    buf[k] = cmul(buf[k], kf[k]);
  }
  __syncthreads();
  fft8192(buf, 1.f);
  for (int i = 0; i < 8; ++i) {
    const int t = tid + NTHR * i;
    const c2 y = buf[t];
    const c2 uu = ub[t];
#pragma unroll
    for (int bb = 0; bb < 2; ++bb) {
      const int b = 2 * bp + bb;
      const u16* x0 = p.hyT + ((size_t)(b * 768 + c)) * 4096;
      const float x0c = bx0 + wx0[0] * ldbf(x0, t - 1, 4096) + wx0[1] * ldbf(x0, t, 4096) + wx0[2] * ldbf(x0, t + 1, 4096);
      const float yy = ldexpf(bb ? y.y : y.x, -13);
      const float uv = bb ? uu.y : uu.x;
      p.ycat[(size_t)(b * 4096 + t) * 1024 + 512 + c] = f2bf(x0c * (yy + uv * dsk));
    }
  }
  __syncthreads();
}
__device__ void hyena_ctx_task(const P& p, int l, int b, int cg8, char* smem) {
  const int tid_ = opaque_tid(); const int lane = tid_ & 63, wid = tid_ >> 6;
  const int c = cg8 * 8 + wid;
  float* us = (float*)smem + wid * 1024;
  float* kfp = us + 256 + 255;
  const float* sw = p.hy_short_w + l * 3 * 768;
  const float* sb = p.hy_short_b + l * 768;
  const u16* x0 = p.hyTc + ((size_t)(b * 768 + c)) * 256;
  const u16* x1 = p.hyTc + ((size_t)(b * 768 + 256 + c)) * 256;
  const u16* vv = p.hyTc + ((size_t)(b * 768 + 512 + c)) * 256;
  for (int i = 0; i < 4; ++i) {
    const int t = lane + 64 * i;
    const float x1c = sb[256 + c] + sw[256 + c] * ldbf(x1, t - 1, 256) + sw[768 + 256 + c] * ldbf(x1, t, 256) + sw[1536 + 256 + c] * ldbf(x1, t + 1, 256);
    const float vc = sb[512 + c] + sw[512 + c] * ldbf(vv, t - 1, 256) + sw[768 + 512 + c] * ldbf(vv, t, 256) + sw[1536 + 512 + c] * ldbf(vv, t + 1, 256);
    us[t] = vc * x1c;
    kfp[t] = p.hc[(size_t)c * 256 + t];
    if (t > 0) kfp[-t] = p.hc[(size_t)(256 + c) * 256 + t];
  }
  __syncthreads();
  const float dsk = p.hy_bias[l * 256 + c];
  float acc[4] = {0.f, 0.f, 0.f, 0.f};
  for (int s = 0; s < 256; ++s) {
    const float uv = us[s];
#pragma unroll
    for (int i = 0; i < 4; ++i) acc[i] += kfp[lane + 64 * i - s] * uv;
  }
#pragma unroll
  for (int i = 0; i < 4; ++i) {
    const int t = lane + 64 * i;
    const float x0c = sb[c] + sw[c] * ldbf(x0, t - 1, 256) + sw[768 + c] * ldbf(x0, t, 256) + sw[1536 + c] * ldbf(x0, t + 1, 256);
    p.ycat[(size_t)(NLAT + b * 256 + t) * 1024 + 512 + c] = f2bf(x0c * (acc[i] + us[t] * dsk));
  }
  __syncthreads();
}

__device__ void rg_task(const P& p, int l, int b, int nblk, bool last, char* smem) {
  const int tid = opaque_tid(), lane = tid & 63, wid = tid >> 6;
  const int l31 = lane & 31, hh = lane >> 5;
  float* xcf = (float*)smem;
  char* xcb = smem + 16384;
  float* pre = (float*)(smem + 24576);
  float* Hs = (float*)(smem + 57344);
  const int gate = wid & 1, mt = (wid >> 1) & 1, nt = wid >> 2;
  const int tt = tid >> 3, c0 = (tid & 7) * 8;
  const int chb = nblk * 64 + c0;
  float cw[4][8], cb[8];
#pragma unroll
  for (int c = 0; c < 8; ++c) {
    cb[c] = p.rg_conv_b[l * 256 + chb + c];
#pragma unroll
    for (int k = 0; k < 4; ++k) cw[k][c] = p.rg_conv_w[(l * 4 + k) * 256 + chb + c];
  }
  for (int dir = 0; dir < 2; ++dir) {
    bf16x8 wf[4];
    {
      const u16* wp = p.rgW + (size_t)(((l * 2 + gate) * 2 + dir) * 4 + nblk) * 4096 + (nt * 32 + l31) * 64 + 8 * hh;
#pragma unroll
      for (int s = 0; s < 4; ++s) wf[s] = *(const bf16x8*)(wp + 16 * s);
    }
    float ba[8], bx[8], sp[8];
#pragma unroll
    for (int c = 0; c < 8; ++c) {
      const int ch = (l * 2 + dir) * 256 + chb + c;
      ba[c] = p.rg_ba[ch];
      bx[c] = p.rg_bx[ch];
      const float lam = p.rg_lambda[ch];
      sp[c] = log1pf(__expf(-lam));
    }
    float hstate = 0.f;
    for (int step = 0; step < 68; ++step) {
      int seg, sub;
      if (step < 4) { seg = 0; sub = dir ? (3 - step) : step; }
      else { seg = 1; sub = dir ? (63 - (step - 4)) : (step - 4); }
      const int Lseg = seg ? 4096 : 256;
      const int tokbase = seg ? b * 4096 : NLAT + b * 256;
      const int T0 = sub * 64;
      {
        float xc[8];
#pragma unroll
        for (int c = 0; c < 8; ++c) xc[c] = cb[c];
#pragma unroll
        for (int k = 0; k < 4; ++k) {
          const int pos = T0 + tt + k - 2;
          if (pos >= 0 && pos < Lseg) {
            const uint4 raw = *(const uint4*)(p.rg + (size_t)(tokbase + pos) * 512 + chb);
            xc[0] += cw[k][0] * bflo(raw.x); xc[1] += cw[k][1] * bfhi(raw.x);
            xc[2] += cw[k][2] * bflo(raw.y); xc[3] += cw[k][3] * bfhi(raw.y);
            xc[4] += cw[k][4] * bflo(raw.z); xc[5] += cw[k][5] * bfhi(raw.z);
            xc[6] += cw[k][6] * bflo(raw.w); xc[7] += cw[k][7] * bfhi(raw.w);
          }
        }
        *(float4*)(xcf + tt * 64 + c0) = make_float4(xc[0], xc[1], xc[2], xc[3]);
        *(float4*)(xcf + tt * 64 + c0 + 4) = make_float4(xc[4], xc[5], xc[6], xc[7]);
        uint4 o;
        o.x = pk2(xc[0], xc[1]); o.y = pk2(xc[2], xc[3]); o.z = pk2(xc[4], xc[5]); o.w = pk2(xc[6], xc[7]);
        *(uint4*)(xcb + swz128(tt, tid & 7)) = o;
      }
      __syncthreads();
      {
        f32x16 acc = zero16();
#pragma unroll
        for (int s = 0; s < 4; ++s) {
          const bf16x8 af = *(const bf16x8*)(xcb + swz128(mt * 32 + l31, 2 * s + hh));
          acc = mfma32(af, wf[s], acc);
        }
#pragma unroll
        for (int e = 0; e < 16; ++e) {
          const int tok = mt * 32 + (e & 3) + 8 * (e >> 2) + 4 * hh;
          pre[gate * 4096 + tok * 64 + nt * 32 + l31] = acc[e];
        }
      }
      __syncthreads();
      {
#pragma unroll
        for (int c = 0; c < 8; ++c) {
          const int o = tt * 64 + c0 + c;
          const float r = sigmoidf_(pre[o] + ba[c]);
          const float ii = sigmoidf_(pre[4096 + o] + bx[c]);
          const float la = -8.0f * r * sp[c];
          const float a = __expf(la);
          const float bc = sqrtf(-expm1f(2.0f * la)) * ii * xcf[o];
          pre[o] = a;
          pre[4096 + o] = bc;
        }
      }
      __syncthreads();
      if (tid < 64) {
        float h = hstate;
#pragma unroll 8
        for (int n = 0; n < 64; ++n) {
          const int tok = dir ? (63 - n) : n;
          h = pre[tok * 64 + tid] * h + pre[4096 + tok * 64 + tid];
          Hs[tok * 64 + tid] = h;
        }
        hstate = h;
      }
      __syncthreads();
      {
        const size_t gtok = (size_t)tokbase + T0 + tt;
        const float4 h0 = *(const float4*)(Hs + tt * 64 + c0);
        const float4 h1 = *(const float4*)(Hs + tt * 64 + c0 + 4);
        float* hfp = p.hf + gtok * 256 + chb;
        if (dir == 0) {
          *(float4*)hfp = h0;
          *(float4*)(hfp + 4) = h1;
        } else if (seg == 1 || !last) {
          const float4 f0 = *(const float4*)hfp;
          const float4 f1 = *(const float4*)(hfp + 4);
          const uint4 g = *(const uint4*)(p.rg + gtok * 512 + 256 + chb);
          uint4 o;
          o.x = pk2((f0.x + h0.x) * gelu_tanh(bflo(g.x)), (f0.y + h0.y) * gelu_tanh(bfhi(g.x)));
          o.y = pk2((f0.z + h0.z) * gelu_tanh(bflo(g.y)), (f0.w + h0.w) * gelu_tanh(bfhi(g.y)));
          o.z = pk2((f1.x + h1.x) * gelu_tanh(bflo(g.z)), (f1.y + h1.y) * gelu_tanh(bfhi(g.z)));
          o.w = pk2((f1.z + h1.z) * gelu_tanh(bflo(g.w)), (f1.w + h1.w) * gelu_tanh(bfhi(g.w)));
          *(uint4*)(p.ycat + gtok * 1024 + 768 + chb) = o;
        }
      }
    }
    __syncthreads();
  }
}

__device__ void attn_wave(const P& p, int l, int b, int h, bool local, int r, int half, int qtok0, const float* rpbL) {
  const int lane = opaque_tid() & 63, q = lane & 31, hh = lane >> 5;
  bf16x8 qf[4];
  {
    const u16* qp = p.qk + (size_t)(qtok0 + q) * 1024 + h * 64 + 8 * hh;
#pragma unroll
    for (int s = 0; s < 4; ++s) qf[s] = *(const bf16x8*)(qp + 16 * s);
  }
  f32x16 o0 = zero16(), o1 = zero16();
  float m_run = -1e30f, l_run = 0.f;
  const int pi = (q & 19) | ((q & 4) << 1) | ((q & 8) >> 1);
  const int w = half * 32 + q;
  const int st = min(max(w - 8, 0), 48);
  const int rs = min(max(r - 4, 0), 56);
  const int ntiles = local ? 24 : 8;
  for (int ti = 0; ti < ntiles; ++ti) {
    int ktok0, vstride, a = 0, g = 0;
    const u16* vb;
    if (ti < 8) {
      ktok0 = NLAT + b * 256 + ti * 32;
      vb = p.vTc + ((size_t)(b * 512 + h * 64)) * 256 + ti * 32;
      vstride = 256;
    } else {
      const int tl = ti - 8;
      a = tl >> 1; g = tl & 1;
      ktok0 = b * 4096 + (rs + a) * 64 + g * 32;
      vb = p.vT + ((size_t)(b * 512 + h * 64)) * 4096 + (rs + a) * 64 + g * 32;
      vstride = 4096;
    }
    bf16x8 kf[4], vf[2][2];
    {
      const u16* kp = p.qk + (size_t)(ktok0 + pi) * 1024 + 512 + h * 64 + 8 * hh;
#pragma unroll
      for (int s = 0; s < 4; ++s) kf[s] = *(const bf16x8*)(kp + 16 * s);
#pragma unroll
      for (int dt = 0; dt < 2; ++dt)
#pragma unroll
        for (int s2 = 0; s2 < 2; ++s2) vf[dt][s2] = *(const bf16x8*)(vb + (size_t)(dt * 32 + q) * vstride + 16 * s2 + 8 * hh);
    }
    f32x16 sacc = zero16();
#pragma unroll
    for (int s = 0; s < 4; ++s) sacc = mfma32(kf[s], qf[s], sacc);
    float sv[16];
    float tmax = -1e30f;
#pragma unroll
    for (int e = 0; e < 16; ++e) {
      float x = sacc[e] * 0.125f;
      if (ti >= 8) {
        const int kc = g * 32 + (e & 7) + 8 * hh + 16 * (e >> 3);
        const bool valid = (kc >= st) && (kc < st + 16);
        const int bi = valid ? ((rs + a - r + 7) * 31 + (kc - w + 15)) : 0;
        const float bias = rpbL[bi];
        x = valid ? (x + bias) : -1e30f;
      }
      sv[e] = x;
      tmax = fmaxf(tmax, x);
    }
    tmax = fmaxf(tmax, __shfl_xor(tmax, 32));
    const float m_new = fmaxf(m_run, tmax);
    const float alpha = __expf(m_run - m_new);
    m_run = m_new;
    l_run *= alpha;
#pragma unroll
    for (int e = 0; e < 16; ++e) { o0[e] *= alpha; o1[e] *= alpha; }
    float psum = 0.f;
#pragma unroll
    for (int e = 0; e < 16; ++e) { const float pe = __expf(sv[e] - m_new); sv[e] = pe; psum += pe; }
    l_run += psum;
    bf16x8 pf[2];
#pragma unroll
    for (int s2 = 0; s2 < 2; ++s2) {
      union { bf16x8 v; unsigned u[4]; } cv;
#pragma unroll
      for (int j = 0; j < 4; ++j) cv.u[j] = pk2(sv[8 * s2 + 2 * j], sv[8 * s2 + 2 * j + 1]);
      pf[s2] = cv.v;
    }
#pragma unroll
    for (int s2 = 0; s2 < 2; ++s2) {
      o0 = mfma32(vf[0][s2], pf[s2], o0);
      o1 = mfma32(vf[1][s2], pf[s2], o1);
    }
  }
  const float lt = l_run + __shfl_xor(l_run, 32);
  const float inv = 1.0f / lt;
  u16* op = p.ycat + (size_t)(qtok0 + q) * 1024 + h * 64;
#pragma unroll
  for (int qd = 0; qd < 4; ++qd) {
    uint2 a0, a1;
    a0.x = pk2(o0[4 * qd] * inv, o0[4 * qd + 1] * inv);
    a0.y = pk2(o0[4 * qd + 2] * inv, o0[4 * qd + 3] * inv);
    a1.x = pk2(o1[4 * qd] * inv, o1[4 * qd + 1] * inv);
    a1.y = pk2(o1[4 * qd + 2] * inv, o1[4 * qd + 3] * inv);
    *(uint2*)(op + 8 * qd + 4 * hh) = a0;
    *(uint2*)(op + 32 + 8 * qd + 4 * hh) = a1;
  }
}
__device__ void attn_task(const P& p, int l, int kind, int idx, char* smem) {
  const int tid_ = opaque_tid(); const int lane = tid_ & 63, wid = tid_ >> 6;
  float* rpbL = (float*)smem + wid * 480;
  for (int i = lane; i < 465; i += 64) rpbL[i] = p.na_rpb[(size_t)(l * 8 + wid) * 465 + i];
  __syncthreads();
  if (kind == 0) {
    const int half = idx & 1, r = (idx >> 1) & 63, b = idx >> 7;
    attn_wave(p, l, b, wid, true, r, half, b * 4096 + r * 64 + half * 32, rpbL);
  } else {
    const int qg = idx & 7, b = idx >> 3;
    attn_wave(p, l, b, wid, false, 0, 0, NLAT + b * 256 + qg * 32, rpbL);
  }
  __syncthreads();
}

__device__ void phase_mixers(const P& p, int l, char* smem, unsigned* counter) {
  const bool last = (l == 1);
  const int n_rg = 32, n_fft = 1024, n_hc = last ? 0 : 256, n_att = 1024, n_attc = last ? 0 : 64;
  const int total = n_rg + n_fft + n_hc + n_att + n_attc;
  __shared__ int s_task;
  for (;;) {
    __syncthreads();
    if (threadIdx.x == 0) s_task = (int)atomicAdd(counter, 1u);
    __syncthreads();
    int t = s_task;
    if (t >= total) break;
    if (t < n_rg) { rg_task(p, l, t >> 2, t & 3, last, smem); continue; }
    t -= n_rg;
    if (t < n_fft) { hyena_fft_task(p, l, t >> 2, t & 3, smem); continue; }
    t -= n_fft;
    if (t < n_hc) { hyena_ctx_task(p, l, t >> 5, t & 31, smem); continue; }
    t -= n_hc;
    if (t < n_att) { attn_task(p, l, 0, t, smem); continue; }
    t -= n_att;
    attn_task(p, l, 1, t, smem);
  }
}

__device__ void merge_tile(const P& p, int l, int mt, int nt, char* smem) {
  EPI_VARS
  const int m0 = mt * 256, n0 = nt * 128;
  f32x16 macc[2][2];
  zero_acc(macc);
  for (int br = 0; br < 3; ++br) {
    unsigned gp[2][2][8];
    {
      f32x16 acc[2][2];
      zero_acc(acc);
      gemm_kloop(acc, p.xn + (size_t)m0 * 1024, 1024, p.WgT + ((size_t)l * 3072 + br * 1024 + n0) * 1024, 1024, 1024, smem);
#pragma unroll
      for (int j = 0; j < 2; ++j) {
        const float bg = p.b_gate[l * 3072 + br * 1024 + n0 + EPI_COL(j)];
#pragma unroll
        for (int i = 0; i < 2; ++i)
#pragma unroll
          for (int e = 0; e < 8; ++e)
            gp[i][j][e] = pk2(sigmoidf_(acc[i][j][2 * e] + bg), sigmoidf_(acc[i][j][2 * e + 1] + bg));
      }
    }
    {
      f32x16 acc[2][2];
      zero_acc(acc);
      const u16* A; const u16* B; int K;
      if (br == 0) { A = p.ycat + (size_t)m0 * 1024; B = p.WaT + ((size_t)l * 1024 + n0) * 512; K = 512; }
      else if (br == 1) { A = p.ycat + (size_t)m0 * 1024 + 512; B = p.WbT + ((size_t)l * 1024 + n0) * 256; K = 256; }
      else { A = p.ycat + (size_t)m0 * 1024 + 768; B = p.WcT + ((size_t)l * 1024 + n0) * 256; K = 256; }
      gemm_kloop(acc, A, 1024, B, K, K, smem);
#pragma unroll
      for (int i = 0; i < 2; ++i)
#pragma unroll
        for (int j = 0; j < 2; ++j)
#pragma unroll
          for (int e = 0; e < 8; ++e) {
            macc[i][j][2 * e] += bflo(gp[i][j][e]) * acc[i][j][2 * e];
            macc[i][j][2 * e + 1] += bfhi(gp[i][j][e]) * acc[i][j][2 * e + 1];
          }
    }
  }
#pragma unroll
  for (int i = 0; i < 2; ++i)
#pragma unroll
    for (int j = 0; j < 2; ++j)
#pragma unroll
      for (int e = 0; e < 16; ++e)
        p.mbuf[(size_t)(m0 + EPI_ROW(i, e)) * 1024 + n0 + EPI_COL(j)] = f2bf(macc[i][j][e]);
}
__device__ void outproj_tile(const P& p, int l, int mt, int nt, char* smem) {
  EPI_VARS
  const int m0 = mt * 256, n0 = nt * 128;
  f32x16 acc[2][2];
  zero_acc(acc);
  gemm_kloop(acc, p.mbuf + (size_t)m0 * 1024, 1024, p.WoT + ((size_t)l * 1024 + n0) * 1024, 1024, 1024, smem);
  const bool isctx = (mt >= 128);
  const int bi = isctx ? 8 : (mt >> 4);
  const float* gatev = p.mod + ((size_t)(l * 9 + bi) * 6 + 2) * 1024;
  const float* src; float* dst;
  if (isctx) { src = (l == 0 ? p.ctx : p.ctxs) - (size_t)NLAT * 1024; dst = p.ctxs - (size_t)NLAT * 1024; }
  else { src = (l == 0 ? p.x : p.out); dst = p.out; }
#pragma unroll
  for (int j = 0; j < 2; ++j) {
    const int col = n0 + EPI_COL(j);
    const float gv = gatev[col];
#pragma unroll
    for (int i = 0; i < 2; ++i)
#pragma unroll
      for (int e = 0; e < 16; ++e) {
        const size_t o = (size_t)(m0 + EPI_ROW(i, e)) * 1024 + col;
        dst[o] = src[o] + gv * acc[i][j][e];
      }
  }
}

__device__ __forceinline__ void ins16(unsigned (&L)[16], unsigned x) {
#pragma unroll
  for (int i = 0; i < 16; ++i) {
    const unsigned hi = max(L[i], x);
    x = min(L[i], x);
    L[i] = hi;
  }
}
__device__ __forceinline__ unsigned f2sort(float f) {
  const unsigned b = __float_as_uint(f);
  return b ^ ((unsigned)((int)b >> 31) | 0x80000000u);
}
__device__ __forceinline__ float sort2f(unsigned k) {
  const unsigned u = k & ~127u;
  const unsigned b = (u & 0x80000000u) ? (u ^ 0x80000000u) : ~u;
  return __uint_as_float(b);
}
__device__ void peer_score_tile(const P& p, int l, int mt, int hp, char* smem) {
  EPI_VARS
  const int m0 = mt * 256;
  f32x16 acc[2][2];
  zero_acc(acc);
  gemm_kloop(acc, p.xn + (size_t)m0 * 1024, 1024, p.WqT + ((size_t)l * 2048 + hp * 128) * 1024, 1024, 1024, smem);
  {
    const u16* kb = p.keysB + ((size_t)l * 16 + hp) * 16384;
#pragma unroll
    for (int it = 0; it < 4; ++it) {
      const int id = tid + NTHR * it;
      const int row = id >> 4, ch = id & 15;
      *(uint4*)(smem + 65536 + swz256(row, ch)) = *(const uint4*)(kb + row * 128 + ch * 8);
    }
#pragma unroll
    for (int i = 0; i < 2; ++i)
#pragma unroll
      for (int j = 0; j < 2; ++j)
#pragma unroll
        for (int e = 0; e < 16; ++e) {
          const int row = EPI_ROW(i, e), col = EPI_COL(j);
          *(u16*)(smem + swz256(row, col >> 3) + (col & 7) * 2) = f2bf(acc[i][j][e]);
        }
  }
  __syncthreads();
  zero_acc(acc);
#pragma unroll
  for (int ks = 0; ks < 8; ++ks) {
    bf16x8 af[2], bfr[2];
#pragma unroll
    for (int i = 0; i < 2; ++i) af[i] = *(const bf16x8*)(smem + swz256(wm * 64 + i * 32 + l31, 2 * ks + hh));
#pragma unroll
    for (int j = 0; j < 2; ++j) bfr[j] = *(const bf16x8*)(smem + 65536 + swz256(wn * 64 + j * 32 + l31, 2 * ks + hh));
#pragma unroll
    for (int i = 0; i < 2; ++i)
#pragma unroll
      for (int j = 0; j < 2; ++j) acc[i][j] = mfma32(af[i], bfr[j], acc[i][j]);
  }
  __syncthreads();
  float* Sf = (float*)smem;
#pragma unroll
  for (int i = 0; i < 2; ++i)
#pragma unroll
    for (int j = 0; j < 2; ++j)
#pragma unroll
      for (int e = 0; e < 16; ++e) Sf[EPI_ROW(i, e) * 130 + EPI_COL(j)] = acc[i][j][e];
  __syncthreads();
  unsigned L[16];
#pragma unroll
  for (int i = 0; i < 16; ++i) L[i] = 0u;
  const int row = tid >> 1, hf = tid & 1;
  for (int i = 0; i < 64; ++i) {
    const int key = 2 * i + hf;
    const float v = Sf[row * 130 + key];
    ins16(L, (f2sort(v) & ~127u) | (unsigned)key);
  }
  unsigned* X = (unsigned*)(smem + 133120);
  if (hf) {
#pragma unroll
    for (int i = 0; i < 16; ++i) X[row * 16 + i] = L[i];
  }
  __syncthreads();
  if (!hf) {
#pragma unroll
    for (int i = 0; i < 16; ++i) ins16(L, X[row * 16 + i]);
    unsigned* o = p.topk + ((size_t)(m0 + row) * 16 + hp) * 16;
#pragma unroll
    for (int i = 0; i < 4; ++i) *(uint4*)(o + 4 * i) = make_uint4(L[4 * i], L[4 * i + 1], L[4 * i + 2], L[4 * i + 3]);
  }
  __syncthreads();
}

__device__ void phase_peer_experts(const P& p, int l) {
  const int tid_ = opaque_tid(); const int lane = tid_ & 63, wid = tid_ >> 6;
  const int ntok = (l == 1) ? NLAT : NTOK;
  int ci, cj;
  {
    const int e = lane;
    if (e < 16) { ci = 0; cj = e; }
    else if (e < 24) { ci = 1; cj = e - 16; }
    else if (e < 29) { ci = 2; cj = e - 24; }
    else if (e < 33) { ci = 3; cj = e - 29; }
    else if (e < 36) { ci = 4; cj = e - 33; }
    else if (e < 38) { ci = 5; cj = e - 36; }
    else if (e < 40) { ci = 6; cj = e - 38; }
    else if (e < 42) { ci = 7; cj = e - 40; }
    else { ci = min(8 + (e - 42), 15); cj = 0; }
  }
  for (int tok = blockIdx.x * 8 + wid; tok < ntok; tok += gridDim.x * 8) {
    float xr[16];
    {
      const uint4 a = *(const uint4*)(p.xn + (size_t)tok * 1024 + lane * 16);
      const uint4 b = *(const uint4*)(p.xn + (size_t)tok * 1024 + lane * 16 + 8);
      xr[0] = bflo(a.x); xr[1] = bfhi(a.x); xr[2] = bflo(a.y); xr[3] = bfhi(a.y);
      xr[4] = bflo(a.z); xr[5] = bfhi(a.z); xr[6] = bflo(a.w); xr[7] = bfhi(a.w);
      xr[8] = bflo(b.x); xr[9] = bfhi(b.x); xr[10] = bflo(b.y); xr[11] = bfhi(b.y);
      xr[12] = bflo(b.z); xr[13] = bfhi(b.z); xr[14] = bflo(b.w); xr[15] = bfhi(b.w);
    }
    float yacc[16];
#pragma unroll
    for (int i = 0; i < 16; ++i) yacc[i] = 0.f;
    for (int h = 0; h < 8; ++h) {
      const unsigned kv = p.topk[((size_t)tok * 16 + 2 * h) * 16 + (lane & 31)];
      const unsigned k0 = __shfl(kv, ci);
      const unsigned k1 = __shfl(kv, 16 + cj);
      const float val = (lane < 50) ? (sort2f(k0) + sort2f(k1)) : -3.0e38f;
      const int eidx = (int)((k0 & 127u) * 128u + (k1 & 127u));
      int cnt = 0;
      for (int e2 = 0; e2 < 50; ++e2) {
        const float v2 = __shfl(val, e2);
        cnt += (v2 > val || (v2 == val && e2 < lane)) ? 1 : 0;
      }
      const bool sel = (lane < 50) && (cnt < 16);
      const float mx = wave_max(sel ? val : -3.0e38f);
      const float ex = sel ? __expf(val - mx) : 0.f;
      const float sm = wave_sum(ex);
      const float gsel = ex / sm;
      unsigned long long mask = __ballot(sel);
      for (int it = 0; it < 4; ++it) {
        int ln[4];
#pragma unroll
        for (int k = 0; k < 4; ++k) {
          ln[k] = mask ? (__ffsll((long long)mask) - 1) : 0;
          mask &= mask - 1;
        }
        uint4 ur[4][2], vr[4][2];
        float gk[4];
#pragma unroll
        for (int k = 0; k < 4; ++k) {
          const int id = __shfl(eidx, ln[k]);
          gk[k] = __shfl(gsel, ln[k]);
          const u16* up = p.Ub + (size_t)id * 1024 + lane * 16;
          const u16* vp = p.Vb + (size_t)id * 1024 + lane * 16;
          ur[k][0] = *(const uint4*)up; ur[k][1] = *(const uint4*)(up + 8);
          vr[k][0] = *(const uint4*)vp; vr[k][1] = *(const uint4*)(vp + 8);
        }
#pragma unroll
        for (int k = 0; k < 4; ++k) {
          float d = 0.f;
#pragma unroll
          for (int hf2 = 0; hf2 < 2; ++hf2) {
            const uint4 u = ur[k][hf2];
            d += xr[8 * hf2 + 0] * bflo(u.x) + xr[8 * hf2 + 1] * bfhi(u.x) + xr[8 * hf2 + 2] * bflo(u.y) + xr[8 * hf2 + 3] * bfhi(u.y) +
                 xr[8 * hf2 + 4] * bflo(u.z) + xr[8 * hf2 + 5] * bfhi(u.z) + xr[8 * hf2 + 6] * bflo(u.w) + xr[8 * hf2 + 7] * bfhi(u.w);
          }
          d = wave_sum(d);
          const float act = gelu_tanh(d) * gk[k];
#pragma unroll
          for (int hf2 = 0; hf2 < 2; ++hf2) {
            const uint4 v = vr[k][hf2];
            yacc[8 * hf2 + 0] += act * bflo(v.x); yacc[8 * hf2 + 1] += act * bfhi(v.x);
            yacc[8 * hf2 + 2] += act * bflo(v.y); yacc[8 * hf2 + 3] += act * bfhi(v.y);
            yacc[8 * hf2 + 4] += act * bflo(v.z); yacc[8 * hf2 + 5] += act * bfhi(v.z);
            yacc[8 * hf2 + 6] += act * bflo(v.w); yacc[8 * hf2 + 7] += act * bfhi(v.w);
          }
        }
      }
    }
    const int bi = tok < NLAT ? (tok >> 12) : 8;
    const float* gv = p.mod + ((size_t)(l * 9 + bi) * 6 + 5) * 1024 + lane * 16;
    float* xp = (tok < NLAT) ? (p.out + (size_t)tok * 1024) : (p.ctxs + (size_t)(tok - NLAT) * 1024);
    xp += lane * 16;
#pragma unroll
    for (int i = 0; i < 4; ++i) {
      float4 xv = *(float4*)(xp + 4 * i);
      const float4 g4 = *(const float4*)(gv + 4 * i);
      xv.x += g4.x * yacc[4 * i]; xv.y += g4.y * yacc[4 * i + 1]; xv.z += g4.z * yacc[4 * i + 2]; xv.w += g4.w * yacc[4 * i + 3];
      *(float4*)(xp + 4 * i) = xv;
    }
  }
}

__global__ void __launch_bounds__(NTHR) fwd_megakernel(P p) {
  __shared__ __attribute__((aligned(16))) char smem[SMEM_BYTES];
  cg::grid_group grid = cg::this_grid();
  const int nb = gridDim.x, bid = blockIdx.x;

  phase_prep(p, smem);
  grid.sync();
  phase_modreduce(p);
  grid.sync();

  for (int l = 0; l < 2; ++l) {
    const bool last = (l == 1);
    const int n_mt = last ? 128 : 136;
    phase_filters(p, l);
    phase_norm(p, l, 0);
    grid.sync();
    {
      const int total = 256 + 136 * 22;
      for (int task = bid; task < total; task += nb) {
        if (task < 256) kf_task(p, task, smem);
        else { const int t = task - 256; inproj_tile(p, l, t / 22, t % 22, smem); }
      }
    }
    grid.sync();
    phase_mixers(p, l, smem, p.counters + l);
    grid.sync();
    for (int task = bid; task < n_mt * 8; task += nb) merge_tile(p, l, task >> 3, task & 7, smem);
    grid.sync();
    {
      const int ng = n_mt * 8;
      const int total = ng + 8192;
      for (int task = bid; task < total; task += nb) {
        if (task < ng) outproj_tile(p, l, task >> 3, task & 7, smem);
        else {
          const int t = task - ng;
          if (t < 4096) cvt_chunk(p.peer_u + (size_t)l * 16384 * 1024, p.Ub, (size_t)t);
          else cvt_chunk(p.peer_v + (size_t)l * 16384 * 1024, p.Vb, (size_t)(t - 4096));
        }
      }
    }
    grid.sync();
    phase_norm(p, l, 1);
    grid.sync();
    for (int task = bid; task < n_mt * 16; task += nb) peer_score_tile(p, l, task >> 4, task & 15, smem);
    grid.sync();
    phase_peer_experts(p, l);
    grid.sync();
  }
  phase_norm(p, 1, 2);
}

extern "C" void kernel_launch(void* const* d_in, const int* in_sizes, int n_in, void* d_out, int out_size, void* d_ws,
                              size_t ws_size, hipStream_t stream) {
  P p;
  memset(&p, 0, sizeof(p));
  const float** ins = (const float**)&p;
  for (int i = 0; i < 37; ++i) ins[i] = (const float*)d_in[i];
  p.out = (float*)d_out;
  char* w = (char*)d_ws;
  size_t off = 0;
  auto take = [&](size_t bytes) { char* r = w + off; off += (bytes + 255) & ~(size_t)255; return r; };
  p.counters = (unsigned*)take(4096);
  p.WinT = (u16*)take((size_t)2 * 2816 * 1024 * 2);
  p.WgT = (u16*)take((size_t)2 * 3072 * 1024 * 2);
  p.WaT = (u16*)take((size_t)2 * 1024 * 512 * 2);
  p.WbT = (u16*)take((size_t)2 * 1024 * 256 * 2);
  p.WcT = (u16*)take((size_t)2 * 1024 * 256 * 2);
  p.WoT = (u16*)take((size_t)2 * 1024 * 1024 * 2);
  p.WqT = (u16*)take((size_t)2 * 2048 * 1024 * 2);
  p.keysB = (u16*)take((size_t)2 * 16 * 16384 * 2);
  p.rgW = (u16*)take((size_t)2 * 16 * 4096 * 2);
  p.modpart = (float*)take((size_t)16 * 2 * 9 * 6144 * 4);
  p.mod = (float*)take((size_t)2 * 9 * 6144 * 4);
  p.hT = (float*)take((size_t)512 * 4096 * 4);
  p.hc = (float*)take((size_t)512 * 256 * 4);
  p.Kf = (float*)take((size_t)256 * 8192 * 8);
  p.xn = (u16*)take((size_t)NTOK * 1024 * 2);
  p.qk = (u16*)take((size_t)NTOK * 1024 * 2);
  p.mbuf = p.qk;
  p.vT = (u16*)take((size_t)8 * 512 * 4096 * 2);
  p.vTc = (u16*)take((size_t)8 * 512 * 256 * 2);
  p.hyT = (u16*)take((size_t)8 * 768 * 4096 * 2);
  p.topk = (unsigned*)p.hyT;
  p.hyTc = (u16*)take((size_t)8 * 768 * 256 * 2);
  p.rg = (u16*)take((size_t)NTOK * 512 * 2);
  p.ycat = (u16*)take((size_t)NTOK * 1024 * 2);
  p.Ub = p.ycat;
  p.Vb = p.ycat + (size_t)16384 * 1024;
  p.hf = (float*)take((size_t)NTOK * 256 * 4);
  p.ctxs = (float*)take((size_t)2048 * 1024 * 4);
  if (off > ws_size) {
    fprintf(stderr, "workspace too small: need %zu have %zu\n", off, ws_size);
    return;
  }
  static int grid_blocks = 0;
  if (!grid_blocks) {
    int dev = 0, cus = 0, per_cu = 0;
    (void)hipGetDevice(&dev);
    (void)hipDeviceGetAttribute(&cus, hipDeviceAttributeMultiprocessorCount, dev);
    (void)hipOccupancyMaxActiveBlocksPerMultiprocessor(&per_cu, fwd_megakernel, NTHR, 0);
    if (per_cu > 1) per_cu = 1;
    grid_blocks = cus * per_cu;
  }
  (void)hipMemsetAsync(p.counters, 0, 4096, stream);
  void* args[] = {&p};
  hipError_t e = hipLaunchCooperativeKernel((void*)fwd_megakernel, dim3(grid_blocks), dim3(NTHR), args, 0, stream);
  if (e != hipSuccess) fprintf(stderr, "cooperative launch failed: %s (grid %d)\n", hipGetErrorString(e), grid_blocks);
}
```

```cpp
#include <hip/hip_runtime.h>
#include <hip/hip_cooperative_groups.h>
#include <cstdio>
#include <cstring>
namespace cg = cooperative_groups;

typedef unsigned short u16;
typedef __attribute__((ext_vector_type(8))) short bf16x8;
typedef __attribute__((ext_vector_type(16))) float f32x16;
typedef __attribute__((ext_vector_type(2))) float f32x2;

#define NLAT 32768
#define NTOK 34816
#define SMEM_BYTES 151552
#define NTHR 512
#ifndef DUP_GEMM
#define DUP_GEMM 1
#endif
#ifndef DUP_PEER
#define DUP_PEER 1
#endif
#ifndef DUP_MIX
#define DUP_MIX 1
#endif
#ifndef XRG
#define XRG 1
#endif
#ifndef XFFT
#define XFFT 1
#endif
#ifndef XATT
#define XATT 1
#endif

struct P {
  const float *x, *c, *ctx, *c_ctx, *norm_mix_g, *norm_ffn_g, *w_ada, *b_ada, *w_in, *na_rpb,
      *hy_short_w, *hy_short_b, *hy_f1_w, *hy_f1_b, *hy_f2_w, *hy_f2_b, *hy_f3_w, *hy_freq, *hy_bias,
      *rg_conv_w, *rg_conv_b, *rg_wa, *rg_ba, *rg_wx, *rg_bx, *rg_lambda,
      *w_gate, *b_gate, *w_br_a, *w_br_b, *w_br_c, *w_out, *peer_wq, *peer_keys, *peer_u, *peer_v, *final_g;
  float* out;
  unsigned* counters;
  u16 *WinT, *WgT, *WaT, *WbT, *WcT, *WoT, *WqT, *keysB, *rgW;
  float *modpart, *mod, *hT, *hc;
  float* Kf;
  u16 *xn, *qk, *vT, *vTc, *hyT, *hyTc, *rg, *ycat, *mbuf;
  unsigned char *Ub, *Vb;
  float *agg, *ctxs;
  unsigned* topk;
};

__device__ __forceinline__ u16 f2bf(float f) {
  unsigned u = __float_as_uint(f);
  u += 0x7fffu + ((u >> 16) & 1u);
  return (u16)(u >> 16);
}
__device__ __forceinline__ float bf2f(u16 h) { return __uint_as_float(((unsigned)h) << 16); }
__device__ __forceinline__ unsigned pk2(float a, float b) { return (unsigned)f2bf(a) | ((unsigned)f2bf(b) << 16); }
__device__ __forceinline__ float bflo(unsigned u) { return __uint_as_float(u << 16); }
__device__ __forceinline__ float bfhi(unsigned u) { return __uint_as_float(u & 0xffff0000u); }
__device__ __forceinline__ int opaque_tid() {
  int t = threadIdx.x;
  asm volatile("" : "+v"(t));
  return t;
}
__device__ __forceinline__ float wave_sum(float v) {
#pragma unroll
  for (int o = 32; o > 0; o >>= 1) v += __shfl_xor(v, o);
  return v;
}
__device__ __forceinline__ float wave_max(float v) {
#pragma unroll
  for (int o = 32; o > 0; o >>= 1) v = fmaxf(v, __shfl_xor(v, o));
  return v;
}
__device__ __forceinline__ float sigmoidf_(float x) { return __builtin_amdgcn_rcpf(1.0f + __expf(-x)); }
__device__ __forceinline__ float gelu_tanh(float x) {
  const float u2 = 1.5957691216057308f * (x + 0.044715f * x * x * x);
  return x * __builtin_amdgcn_rcpf(1.0f + __expf(-u2));
}
__device__ __forceinline__ f32x16 mfma32(bf16x8 a, bf16x8 b, f32x16 c) {
  return __builtin_amdgcn_mfma_f32_32x32x16_bf16(a, b, c, 0, 0, 0);
}
__device__ __forceinline__ f32x16 zero16() {
  f32x16 z;
#pragma unroll
  for (int i = 0; i < 16; ++i) z[i] = 0.f;
  return z;
}
__device__ __forceinline__ int swz128(int row, int ch) { return row * 128 + ((ch ^ ((row >> 1) & 7)) << 4); }
__device__ __forceinline__ int swz256(int row, int ch) { return row * 256 + ((ch ^ (row & 15)) << 4); }

struct c2 { float x, y; };
__device__ __forceinline__ c2 cadd(c2 a, c2 b) { return {a.x + b.x, a.y + b.y}; }
__device__ __forceinline__ c2 csub(c2 a, c2 b) { return {a.x - b.x, a.y - b.y}; }
__device__ __forceinline__ c2 cmul(c2 a, c2 b) { return {a.x * b.x - a.y * b.y, a.x * b.y + a.y * b.x}; }
__device__ __forceinline__ float c16(int i) {
  const float tb[16] = {1.0f, 0.9238795325112867f, 0.7071067811865476f, 0.3826834323650898f, 0.0f,
                        -0.3826834323650898f, -0.7071067811865476f, -0.9238795325112867f, -1.0f,
                        -0.9238795325112867f, -0.7071067811865476f, -0.3826834323650898f, 0.0f,
                        0.3826834323650898f, 0.7071067811865476f, 0.9238795325112867f};
  return tb[i & 15];
}
__device__ __forceinline__ float s16(int i) { return c16(i + 12); }
template <int R> __device__ __forceinline__ constexpr int brev(int k) {
  int r = 0;
  for (int b = 1, o = R >> 1; b < R; b <<= 1, o >>= 1)
    if (k & b) r |= o;
  return r;
}
template <int R> __device__ __forceinline__ void dft_reg(c2* v, float sgn) {
#pragma unroll
  for (int h = R / 2; h >= 1; h >>= 1) {
#pragma unroll
    for (int g = 0; g < R; g += 2 * h) {
#pragma unroll
      for (int j = 0; j < h; ++j) {
        c2 a = v[g + j], b = v[g + j + h];
        v[g + j] = cadd(a, b);
        c2 d = csub(a, b);
        const int ti = j * (16 / (2 * h));
        c2 w = {c16(ti), sgn * s16(ti)};
        v[g + j + h] = (j == 0) ? d : cmul(d, w);
      }
    }
  }
}
template <int R> __device__ __forceinline__ int fft_bfly(c2* v, int j, int Ns, float sgn) {
  const int k = j & (Ns - 1);
  const float f = sgn * (float)k / (float)(Ns * R);
#pragma unroll
  for (int r = 1; r < R; ++r) {
    float t = f * (float)r;
    c2 w = {__builtin_amdgcn_cosf(t), __builtin_amdgcn_sinf(t)};
    v[r] = cmul(v[r], w);
  }
  dft_reg<R>(v, sgn);
  return (j - k) * R + k;
}
template <int R> __device__ __forceinline__ void fft_pass(c2* buf, int Ns, float sgn) {
  constexpr int NBF = 8192 / R;
  constexpr int PER = NBF / NTHR;
  const int tid = opaque_tid();
  c2 v[PER][R];
#pragma unroll
  for (int i = 0; i < PER; ++i) {
    const int j = tid + NTHR * i;
#pragma unroll
    for (int r = 0; r < R; ++r) v[i][r] = buf[j + r * NBF];
  }
  __syncthreads();
#pragma unroll
  for (int i = 0; i < PER; ++i) {
    const int j = tid + NTHR * i;
    const int base = fft_bfly<R>(v[i], j, Ns, sgn);
#pragma unroll
    for (int r = 0; r < R; ++r) buf[base + r * Ns] = v[i][brev<R>(r)];
  }
  __syncthreads();
}
__device__ __forceinline__ void fft8192(c2* buf, float sgn) {
  fft_pass<8>(buf, 1, sgn);
  fft_pass<8>(buf, 8, sgn);
  fft_pass<8>(buf, 64, sgn);
  fft_pass<16>(buf, 512, sgn);
}

__device__ __forceinline__ void gemm_kloop(f32x16 (&acc)[2][2], const u16* __restrict__ A, int lda,
                                           const u16* __restrict__ B, int ldb, int K, char* smem) {
  const int tid = opaque_tid(), lane = tid & 63, wid = tid >> 6;
  const int wm = wid >> 1, wn = wid & 1;
  const int l31 = lane & 31, hh = lane >> 5;
  uint4 ra[4], rb[2];
  const int nk = K >> 6;
  const int srow = tid >> 3, sch = tid & 7;
  const char* Ab = (const char*)A;
  const char* Bb = (const char*)B;
  const unsigned aoff = (unsigned)(srow * lda + sch * 8) * 2u;
  const unsigned boff = (unsigned)(srow * ldb + sch * 8) * 2u;
  const unsigned astep = (unsigned)lda * 128u, bstep = (unsigned)ldb * 128u;
#pragma unroll
  for (int i = 0; i < 4; ++i) ra[i] = *(const uint4*)(Ab + (aoff + i * astep));
#pragma unroll
  for (int i = 0; i < 2; ++i) rb[i] = *(const uint4*)(Bb + (boff + i * bstep));
#pragma unroll
  for (int i = 0; i < 4; ++i) *(uint4*)(smem + swz128(srow + i * 64, sch)) = ra[i];
#pragma unroll
  for (int i = 0; i < 2; ++i) *(uint4*)(smem + 65536 + swz128(srow + i * 64, sch)) = rb[i];
  __syncthreads();
  for (int kt = 0; kt < nk; ++kt) {
    const bool more = (kt + 1 < nk);
    if (more) {
      const unsigned ko = (unsigned)(kt + 1) * 128u;
#pragma unroll
      for (int i = 0; i < 4; ++i) ra[i] = *(const uint4*)(Ab + (aoff + i * astep + ko));
#pragma unroll
      for (int i = 0; i < 2; ++i) rb[i] = *(const uint4*)(Bb + (boff + i * bstep + ko));
    }
    const char* as = smem + (kt & 1) * 32768;
    const char* bs = smem + 65536 + (kt & 1) * 16384;
    int lrow = l31;
    asm volatile("" : "+v"(lrow));
#pragma unroll
    for (int s = 0; s < 4; ++s) {
      bf16x8 af[2], bfr[2];
#pragma unroll
      for (int i = 0; i < 2; ++i) af[i] = *(const bf16x8*)(as + swz128(wm * 64 + i * 32 + lrow, s * 2 + hh));
#pragma unroll
      for (int j = 0; j < 2; ++j) bfr[j] = *(const bf16x8*)(bs + swz128(wn * 64 + j * 32 + lrow, s * 2 + hh));
#pragma unroll
      for (int i = 0; i < 2; ++i)
#pragma unroll
        for (int j = 0; j < 2; ++j) acc[i][j] = mfma32(af[i], bfr[j], acc[i][j]);
    }
    if (more) {
      char* an = smem + ((kt + 1) & 1) * 32768;
      char* bn = smem + 65536 + ((kt + 1) & 1) * 16384;
      int sr2 = srow;
      asm volatile("" : "+v"(sr2));
#pragma unroll
      for (int i = 0; i < 4; ++i) *(uint4*)(an + swz128(sr2 + i * 64, sch)) = ra[i];
#pragma unroll
      for (int i = 0; i < 2; ++i) *(uint4*)(bn + swz128(sr2 + i * 64, sch)) = rb[i];
    }
    __syncthreads();
  }
}
__device__ __forceinline__ void zero_acc(f32x16 (&acc)[2][2]) {
#pragma unroll
  for (int i = 0; i < 2; ++i)
#pragma unroll
    for (int j = 0; j < 2; ++j) acc[i][j] = zero16();
}
#define EPI_ROW(i, e) (wm * 64 + (i)*32 + ((e)&3) + 8 * ((e) >> 2) + 4 * hh)
#define EPI_COL(j) (wn * 64 + (j)*32 + l31)
#define EPI_VARS                                                    \
  const int tid = opaque_tid(), lane = tid & 63, wid = tid >> 6;     \
  const int wm = wid >> 1, wn = wid & 1, l31 = lane & 31, hh = lane >> 5; \
  (void)tid; (void)wm; (void)wn; (void)l31; (void)hh;

__device__ void tr_tile(const float* __restrict__ src, int N, int K, u16* __restrict__ dst, int tile, char* smem) {
  float* lds = (float*)smem;
  const int tiles_n = N >> 6;
  const int tk = tile / tiles_n, tn = tile - tk * tiles_n;
  const int tid = opaque_tid();
  {
    const int r = tid >> 3, c8 = (tid & 7) * 8;
    const float* s = src + (size_t)(tk * 64 + r) * N + tn * 64 + c8;
    float4 a = *(const float4*)s, b = *(const float4*)(s + 4);
    float* d = lds + r * 65 + c8;
    d[0] = a.x; d[1] = a.y; d[2] = a.z; d[3] = a.w; d[4] = b.x; d[5] = b.y; d[6] = b.z; d[7] = b.w;
  }
  __syncthreads();
  {
    const int n = tid >> 3, k0 = (tid & 7) * 8;
    uint4 o;
    o.x = pk2(lds[(k0 + 0) * 65 + n], lds[(k0 + 1) * 65 + n]);
    o.y = pk2(lds[(k0 + 2) * 65 + n], lds[(k0 + 3) * 65 + n]);
    o.z = pk2(lds[(k0 + 4) * 65 + n], lds[(k0 + 5) * 65 + n]);
    o.w = pk2(lds[(k0 + 6) * 65 + n], lds[(k0 + 7) * 65 + n]);
    *(uint4*)(dst + (size_t)(tn * 64 + n) * K + tk * 64 + k0) = o;
  }
  __syncthreads();
}
__device__ void cvt_chunk(const float* __restrict__ src, u16* __restrict__ dst, size_t chunk) {
  const size_t i = chunk * 4096 + (size_t)opaque_tid() * 8;
  float4 a = *(const float4*)(src + i), b = *(const float4*)(src + i + 4);
  uint4 o;
  o.x = pk2(a.x, a.y); o.y = pk2(a.z, a.w); o.z = pk2(b.x, b.y); o.w = pk2(b.z, b.w);
  *(uint4*)(dst + i) = o;
}
__device__ void cvt_chunk_fp8(const float* __restrict__ src, unsigned char* __restrict__ dst, size_t chunk, float scale) {
  const size_t i = chunk * 4096 + (size_t)opaque_tid() * 8;
  const float4 a = *(const float4*)(src + i), b = *(const float4*)(src + i + 4);
  int w0 = __builtin_amdgcn_cvt_pk_fp8_f32(a.x * scale, a.y * scale, 0, false);
  w0 = __builtin_amdgcn_cvt_pk_fp8_f32(a.z * scale, a.w * scale, w0, true);
  int w1 = __builtin_amdgcn_cvt_pk_fp8_f32(b.x * scale, b.y * scale, 0, false);
  w1 = __builtin_amdgcn_cvt_pk_fp8_f32(b.z * scale, b.w * scale, w1, true);
  *(uint2*)(dst + i) = make_uint2((unsigned)w0, (unsigned)w1);
}
__device__ void phase_prep(const P& p, char* smem) {
  const int tid = opaque_tid();
  const int NTR = 2512;
  const int total = 2 * NTR + 128 + 384;
  for (int task = blockIdx.x; task < total; task += gridDim.x) {
    if (task < 2 * NTR) {
      const int l = task / NTR;
      int t = task - l * NTR;
      if (t < 704) tr_tile(p.w_in + (size_t)l * 1024 * 2816, 2816, 1024, p.WinT + (size_t)l * 2816 * 1024, t, smem);
      else if ((t -= 704) < 768) tr_tile(p.w_gate + (size_t)l * 1024 * 3072, 3072, 1024, p.WgT + (size_t)l * 3072 * 1024, t, smem);
      else if ((t -= 768) < 128) tr_tile(p.w_br_a + (size_t)l * 512 * 1024, 1024, 512, p.WaT + (size_t)l * 1024 * 512, t, smem);
      else if ((t -= 128) < 64) tr_tile(p.w_br_b + (size_t)l * 256 * 1024, 1024, 256, p.WbT + (size_t)l * 1024 * 256, t, smem);
      else if ((t -= 64) < 64) tr_tile(p.w_br_c + (size_t)l * 256 * 1024, 1024, 256, p.WcT + (size_t)l * 1024 * 256, t, smem);
      else if ((t -= 64) < 256) tr_tile(p.w_out + (size_t)l * 1024 * 1024, 1024, 1024, p.WoT + (size_t)l * 1024 * 1024, t, smem);
      else if ((t -= 256) < 512) tr_tile(p.peer_wq + (size_t)l * 1024 * 2048, 2048, 1024, p.WqT + (size_t)l * 2048 * 1024, t, smem);
      else {
        t -= 512;
        const int gate = t >> 3, dn = t & 7;
        const float* src = (gate ? p.rg_wx : p.rg_wa) + (size_t)(l * 8 + dn) * 4096;
        tr_tile(src, 64, 64, p.rgW + (size_t)((l * 2 + gate) * 8 + dn) * 4096, 0, smem);
      }
    } else if (task < 2 * NTR + 128) {
      cvt_chunk(p.peer_keys, p.keysB, (size_t)(task - 2 * NTR));
    } else {
      int t = task - 2 * NTR - 128;
      const int kc = t & 15; t >>= 4;
      const int jc = t % 12, l = t / 12;
      float* s = (float*)smem;
      for (int i = tid; i < 576; i += NTHR) {
        const int bi = i >> 6, kk = i & 63;
        const float v = (bi < 8) ? p.c[bi * 1024 + kc * 64 + kk] : p.c_ctx[kc * 64 + kk];
        s[i] = v / (1.0f + __expf(-v));
      }
      __syncthreads();
      const int j = jc * 512 + tid;
      float acc[9];
#pragma unroll
      for (int bi = 0; bi < 9; ++bi) acc[bi] = 0.f;
      const float* wp = p.w_ada + ((size_t)l * 1024 + kc * 64) * 6144 + j;
#pragma unroll 8
      for (int kk = 0; kk < 64; ++kk) {
        const float w = wp[(size_t)kk * 6144];
#pragma unroll
        for (int bi = 0; bi < 9; ++bi) acc[bi] += s[bi * 64 + kk] * w;
      }
#pragma unroll
      for (int bi = 0; bi < 9; ++bi) p.modpart[((size_t)(kc * 2 + l) * 9 + bi) * 6144 + j] = acc[bi];
      __syncthreads();
    }
  }
}
__device__ void phase_modreduce(const P& p) {
  const int n = 2 * 9 * 6144;
  for (int i = blockIdx.x * NTHR + opaque_tid(); i < n; i += gridDim.x * NTHR) {
    const int l = i / (9 * 6144);
    const int j = i % 6144;
    float s = p.b_ada[l * 6144 + j];
#pragma unroll
    for (int kc = 0; kc < 16; ++kc) s += p.modpart[(size_t)kc * n + i];
    p.mod[i] = s;
  }
}

__device__ void phase_norm(const P& p, int l, int which) {
  const int tid_ = opaque_tid(); const int lane = tid_ & 63, wid = tid_ >> 6;
  const int ntok = (which == 2 || (which == 1 && l == 1)) ? NLAT : NTOK;
  for (int row = blockIdx.x * 8 + wid; row < ntok; row += gridDim.x * 8) {
    const float* src;
    if (row < NLAT) src = ((which == 0 && l == 0) ? p.x : p.out) + (size_t)row * 1024;
    else src = ((which == 0 && l == 0) ? p.ctx : p.ctxs) + (size_t)(row - NLAT) * 1024;
    float4 v[4];
    float ss = 0.f;
#pragma unroll
    for (int i = 0; i < 4; ++i) {
      v[i] = *(const float4*)(src + i * 256 + lane * 4);
      ss += v[i].x * v[i].x + v[i].y * v[i].y + v[i].z * v[i].z + v[i].w * v[i].w;
    }
    ss = wave_sum(ss);
    const float rstd = rsqrtf(ss * (1.0f / 1024.0f) + 1e-6f);
    if (which == 2) {
#pragma unroll
      for (int i = 0; i < 4; ++i) {
        const int col = i * 256 + lane * 4;
        const float4 g = *(const float4*)(p.final_g + col);
        float4 o = {v[i].x * rstd * g.x, v[i].y * rstd * g.y, v[i].z * rstd * g.z, v[i].w * rstd * g.w};
        *(float4*)(p.out + (size_t)row * 1024 + col) = o;
      }
    } else {
      const int bi = row < NLAT ? (row >> 12) : 8;
      const float* gam = (which == 0 ? p.norm_mix_g : p.norm_ffn_g) + l * 1024;
      const float* msh = p.mod + ((size_t)(l * 9 + bi) * 6 + (which == 0 ? 0 : 3)) * 1024;
      const float* msc = msh + 1024;
#pragma unroll
      for (int i = 0; i < 4; ++i) {
        const int col = i * 256 + lane * 4;
        const float4 g = *(const float4*)(gam + col);
        const float4 sh = *(const float4*)(msh + col);
        const float4 sc = *(const float4*)(msc + col);
        uint2 o;
        o.x = pk2(v[i].x * rstd * g.x * (1.f + sc.x) + sh.x, v[i].y * rstd * g.y * (1.f + sc.y) + sh.y);
        o.y = pk2(v[i].z * rstd * g.z * (1.f + sc.z) + sh.z, v[i].w * rstd * g.w * (1.f + sc.w) + sh.w);
        *(uint2*)(p.xn + (size_t)row * 1024 + col) = o;
      }
    }
  }
}

__device__ void filter_wave(const P& p, int l, int L, int t, float* __restrict__ outp) {
  const int lane = opaque_tid() & 63;
  const float tl = (float)t / (float)(L - 1);
  const float wang = (6.283185307179586f / (float)L) * (float)t;
  float z = 0.f;
  if (lane == 0) z = tl;
  else if (lane <= 16) { const float band = 1e-4f + (float)(lane - 1) * ((15.0f - 1e-4f) / 15.0f); z = cosf(band * wang); }
  else if (lane <= 32) { const float band = 1e-4f + (float)(lane - 17) * ((15.0f - 1e-4f) / 15.0f); z = -sinf(band * wang); }
  float a1 = p.hy_f1_b[l * 64 + lane];
  for (int i = 0; i < 33; ++i) a1 += __shfl(z, i) * p.hy_f1_w[(l * 33 + i) * 64 + lane];
  const float h1 = sinf(p.hy_freq[l * 128 + lane] * a1);
  float a2 = p.hy_f2_b[l * 64 + lane];
  for (int i = 0; i < 64; ++i) a2 += __shfl(h1, i) * p.hy_f2_w[(l * 64 + i) * 64 + lane];
  const float h2 = sinf(p.hy_freq[l * 128 + 64 + lane] * a2);
  float a3[8];
#pragma unroll
  for (int m = 0; m < 8; ++m) a3[m] = 0.f;
  for (int i = 0; i < 64; ++i) {
    const float hv = __shfl(h2, i);
    const float* wr = p.hy_f3_w + (size_t)(l * 64 + i) * 512 + lane;
#pragma unroll
    for (int m = 0; m < 8; ++m) a3[m] += hv * wr[m * 64];
  }
  const float LN100 = 4.605170185988092f;
  const float d0 = LN100 / 1.5f, d1 = LN100 / 0.3f;
#pragma unroll
  for (int m = 0; m < 8; ++m) {
    const int cp = lane + 64 * m;
    const int ch = cp & 255;
    const float delta = d0 + (float)ch * ((d1 - d0) / 255.0f);
    outp[(size_t)cp * L + t] = a3[m] * expf(-tl * delta);
  }
}
__device__ void phase_filters(const P& p, int l) {
  const int wid = opaque_tid() >> 6;
  const int ntask = 4096 + (l == 0 ? 256 : 0);
  for (int t = blockIdx.x * 8 + wid; t < ntask; t += gridDim.x * 8) {
    if (t < 4096) filter_wave(p, l, 4096, t, p.hT);
    else filter_wave(p, l, 256, t - 4096, p.hc);
  }
}
__device__ void kf_task(const P& p, int c, char* smem) {
  c2* buf = (c2*)smem;
  const int tid = opaque_tid();
  for (int i = 0; i < 16; ++i) {
    const int j = tid + NTHR * i;
    float v;
    if (j < 4096) v = p.hT[(size_t)c * 4096 + j];
    else if (j == 4096) v = 0.f;
    else v = p.hT[(size_t)(256 + c) * 4096 + (8192 - j)];
    buf[j] = {v, 0.f};
  }
  __syncthreads();
  fft8192(buf, -1.f);
  c2* o = (c2*)p.Kf + (size_t)c * 8192;
  for (int i = 0; i < 16; ++i) { const int j = tid + NTHR * i; o[j] = buf[j]; }
  __syncthreads();
}

__device__ void inproj_tile(const P& p, int l, int mt, int nt, char* smem) {
  f32x16 acc[2][2];
  zero_acc(acc);
  const int m0 = mt * 256, n0 = nt * 128;
  gemm_kloop(acc, p.xn + (size_t)m0 * 1024, 1024, p.WinT + ((size_t)l * 2816 + n0) * 1024, 1024, 1024, smem);
  EPI_VARS
  if (nt < 8 || nt >= 18) {
    u16* dst; int ld, cbase;
    if (nt < 8) { dst = p.qk; ld = 1024; cbase = n0; }
    else { dst = p.rg; ld = 512; cbase = n0 - 2304; }
#pragma unroll
    for (int i = 0; i < 2; ++i)
#pragma unroll
      for (int j = 0; j < 2; ++j)
#pragma unroll
        for (int e = 0; e < 16; ++e)
          dst[(size_t)(m0 + EPI_ROW(i, e)) * ld + cbase + EPI_COL(j)] = f2bf(acc[i][j][e]);
  } else {
#pragma unroll
    for (int i = 0; i < 2; ++i)
#pragma unroll
      for (int j = 0; j < 2; ++j)
#pragma unroll
        for (int qd = 0; qd < 4; ++qd) {
          uint2 o;
          o.x = pk2(acc[i][j][4 * qd + 0], acc[i][j][4 * qd + 1]);
          o.y = pk2(acc[i][j][4 * qd + 2], acc[i][j][4 * qd + 3]);
          const int row0 = wm * 64 + i * 32 + 8 * qd + 4 * hh;
          *(uint2*)(smem + EPI_COL(j) * 520 + row0 * 2) = o;
        }
    __syncthreads();
    u16* dstT; int Lseg, t0, ncol0, nc;
    const bool isctx = (mt >= 128);
    const int b = isctx ? (mt - 128) : (mt >> 4);
    if (nt < 12) { ncol0 = n0 - 1024; nc = 512; dstT = isctx ? p.vTc : p.vT; }
    else { ncol0 = n0 - 1536; nc = 768; dstT = isctx ? p.hyTc : p.hyT; }
    if (isctx) { Lseg = 256; t0 = 0; } else { Lseg = 4096; t0 = (mt & 15) * 256; }
#pragma unroll 4
    for (int it = 0; it < 16; ++it) {
      const int idx = tid + NTHR * it;
      const int col = idx >> 6, u = idx & 63;
      const uint2 v = *(const uint2*)(smem + col * 520 + u * 8);
      *(uint2*)(dstT + ((size_t)(b * nc + ncol0 + col)) * Lseg + t0 + u * 4) = v;
    }
    __syncthreads();
  }
}

__device__ __forceinline__ float ldbf(const u16* p, int t, int L) { return (t >= 0 && t < L) ? bf2f(p[t]) : 0.f; }
__device__ void hyena_fft_task(const P& p, int l, int c, int bp, char* smem) {
  c2* buf = (c2*)smem;
  c2* ub = (c2*)(smem + 65536);
  const int tid = opaque_tid();
  const float* sw = p.hy_short_w + l * 3 * 768;
  const float* sb = p.hy_short_b + l * 768;
  const float wx0[3] = {sw[c], sw[768 + c], sw[1536 + c]};
  const float wx1[3] = {sw[256 + c], sw[768 + 256 + c], sw[1536 + 256 + c]};
  const float wv[3] = {sw[512 + c], sw[768 + 512 + c], sw[1536 + 512 + c]};
  const float bx0 = sb[c], bx1 = sb[256 + c], bv = sb[512 + c];
  const float dsk = p.hy_bias[l * 256 + c];
  for (int i = 0; i < 8; ++i) {
    const int t = tid + NTHR * i;
    float u[2];
#pragma unroll
    for (int bb = 0; bb < 2; ++bb) {
      const int b = 2 * bp + bb;
      const u16* x1 = p.hyT + ((size_t)(b * 768 + 256 + c)) * 4096;
      const u16* vv = p.hyT + ((size_t)(b * 768 + 512 + c)) * 4096;
      const float x1c = bx1 + wx1[0] * ldbf(x1, t - 1, 4096) + wx1[1] * ldbf(x1, t, 4096) + wx1[2] * ldbf(x1, t + 1, 4096);
      const float vc = bv + wv[0] * ldbf(vv, t - 1, 4096) + wv[1] * ldbf(vv, t, 4096) + wv[2] * ldbf(vv, t + 1, 4096);
      u[bb] = vc * x1c;
    }
    buf[t] = {u[0], u[1]};
    ub[t] = {u[0], u[1]};
    buf[t + 4096] = {0.f, 0.f};
  }
  __syncthreads();
  fft8192(buf, -1.f);
  const c2* kf = (const c2*)p.Kf + (size_t)c * 8192;
  for (int i = 0; i < 16; ++i) {
    const int k = tid + NTHR * i;
    buf[k] = cmul(buf[k], kf[k]);
  }
  __syncthreads();
  fft8192(buf, 1.f);
  for (int i = 0; i < 8; ++i) {
    const int t = tid + NTHR * i;
    const c2 y = buf[t];
    const c2 uu = ub[t];
#pragma unroll
    for (int bb = 0; bb < 2; ++bb) {
      const int b = 2 * bp + bb;
      const u16* x0 = p.hyT + ((size_t)(b * 768 + c)) * 4096;
      const float x0c = bx0 + wx0[0] * ldbf(x0, t - 1, 4096) + wx0[1] * ldbf(x0, t, 4096) + wx0[2] * ldbf(x0, t + 1, 4096);
      const float yy = ldexpf(bb ? y.y : y.x, -13);
      const float uv = bb ? uu.y : uu.x;
      p.ycat[(size_t)(b * 4096 + t) * 1024 + 512 + c] = f2bf(x0c * (yy + uv * dsk));
    }
  }
  __syncthreads();
}
__device__ void hyena_ctx_task(const P& p, int l, int b, int cg8, char* smem) {
  const int tid_ = opaque_tid(); const int lane = tid_ & 63, wid = tid_ >> 6;
  const int c = cg8 * 8 + wid;
  float* us = (float*)smem + wid * 1024;
  float* kfp = us + 256 + 255;
  const float* sw = p.hy_short_w + l * 3 * 768;
  const float* sb = p.hy_short_b + l * 768;
  const u16* x0 = p.hyTc + ((size_t)(b * 768 + c)) * 256;
  const u16* x1 = p.hyTc + ((size_t)(b * 768 + 256 + c)) * 256;
  const u16* vv = p.hyTc + ((size_t)(b * 768 + 512 + c)) * 256;
  for (int i = 0; i < 4; ++i) {
    const int t = lane + 64 * i;
    const float x1c = sb[256 + c] + sw[256 + c] * ldbf(x1, t - 1, 256) + sw[768 + 256 + c] * ldbf(x1, t, 256) + sw[1536 + 256 + c] * ldbf(x1, t + 1, 256);
    const float vc = sb[512 + c] + sw[512 + c] * ldbf(vv, t - 1, 256) + sw[768 + 512 + c] * ldbf(vv, t, 256) + sw[1536 + 512 + c] * ldbf(vv, t + 1, 256);
    us[t] = vc * x1c;
    kfp[t] = p.hc[(size_t)c * 256 + t];
    if (t > 0) kfp[-t] = p.hc[(size_t)(256 + c) * 256 + t];
  }
  __syncthreads();
  const float dsk = p.hy_bias[l * 256 + c];
  float acc[4] = {0.f, 0.f, 0.f, 0.f};
  for (int s = 0; s < 256; ++s) {
    const float uv = us[s];
#pragma unroll
    for (int i = 0; i < 4; ++i) acc[i] += kfp[lane + 64 * i - s] * uv;
  }
#pragma unroll
  for (int i = 0; i < 4; ++i) {
    const int t = lane + 64 * i;
    const float x0c = sb[c] + sw[c] * ldbf(x0, t - 1, 256) + sw[768 + c] * ldbf(x0, t, 256) + sw[1536 + c] * ldbf(x0, t + 1, 256);
    p.ycat[(size_t)(NLAT + b * 256 + t) * 1024 + 512 + c] = f2bf(x0c * (acc[i] + us[t] * dsk));
  }
  __syncthreads();
}

__device__ void rg_chunk_task(const P& p, int l, int cq, int nblk, int mode, bool last, char* smem) {
  const int tid = opaque_tid(), lane = tid & 63, wid = tid >> 6;
  const int l31 = lane & 31, hh = lane >> 5;
  const int b = cq / 68, rr = cq - b * 68;
  const int seg = rr < 4 ? 0 : 1, sub = rr < 4 ? rr : rr - 4;
  if (mode == 1 && seg == 0 && last) return;
  float* xcf = (float*)smem;
  char* xcb = smem + 16384;
  float* coef = (float*)(smem + 24576);
  float2* segagg = (float2*)(smem + 90112);
  float* hin = (float*)(smem + 94208);
  float* Hout = (float*)(smem + 94720);
  const int Lseg = seg ? 4096 : 256;
  const int tokbase = seg ? b * 4096 : NLAT + b * 256;
  const int T0 = sub * 64;
  const int tt = tid >> 3, c0 = (tid & 7) * 8;
  const int chb = nblk * 64 + c0;
  const int wdir = wid >> 2, wgate = (wid >> 1) & 1, wmt = wid & 1;
  bf16x8 wf[2][4];
  {
    const u16* wp = p.rgW + (size_t)(((l * 2 + wgate) * 2 + wdir) * 4 + nblk) * 4096 + l31 * 64 + 8 * hh;
#pragma unroll
    for (int nt = 0; nt < 2; ++nt)
#pragma unroll
      for (int s = 0; s < 4; ++s) wf[nt][s] = *(const bf16x8*)(wp + nt * 2048 + 16 * s);
  }
  {
    float xc[8];
#pragma unroll
    for (int c = 0; c < 8; ++c) xc[c] = p.rg_conv_b[l * 256 + chb + c];
#pragma unroll
    for (int k = 0; k < 4; ++k) {
      const int pos = T0 + tt + k - 2;
      if (pos >= 0 && pos < Lseg) {
        const uint4 raw = *(const uint4*)(p.rg + (size_t)(tokbase + pos) * 512 + chb);
        const float4 w0 = *(const float4*)(p.rg_conv_w + (l * 4 + k) * 256 + chb);
        const float4 w1 = *(const float4*)(p.rg_conv_w + (l * 4 + k) * 256 + chb + 4);
        xc[0] += w0.x * bflo(raw.x); xc[1] += w0.y * bfhi(raw.x);
        xc[2] += w0.z * bflo(raw.y); xc[3] += w0.w * bfhi(raw.y);
        xc[4] += w1.x * bflo(raw.z); xc[5] += w1.y * bfhi(raw.z);
        xc[6] += w1.z * bflo(raw.w); xc[7] += w1.w * bfhi(raw.w);
      }
    }
    *(float4*)(xcf + tt * 64 + c0) = make_float4(xc[0], xc[1], xc[2], xc[3]);
    *(float4*)(xcf + tt * 64 + c0 + 4) = make_float4(xc[4], xc[5], xc[6], xc[7]);
    uint4 o;
    o.x = pk2(xc[0], xc[1]); o.y = pk2(xc[2], xc[3]); o.z = pk2(xc[4], xc[5]); o.w = pk2(xc[6], xc[7]);
    *(uint4*)(xcb + swz128(tt, tid & 7)) = o;
  }
  __syncthreads();
  {
    f32x16 acc0 = zero16(), acc1 = zero16();
#pragma unroll
    for (int s = 0; s < 4; ++s) {
      const bf16x8 af = *(const bf16x8*)(xcb + swz128(wmt * 32 + l31, 2 * s + hh));
      acc0 = mfma32(af, wf[0][s], acc0);
      acc1 = mfma32(af, wf[1][s], acc1);
    }
    float* cp = coef + (wdir * 2 + wgate) * 4096;
#pragma unroll
    for (int e = 0; e < 16; ++e) {
      const int tok = wmt * 32 + (e & 3) + 8 * (e >> 2) + 4 * hh;
      cp[tok * 64 + l31] = acc0[e];
      cp[tok * 64 + 32 + l31] = acc1[e];
    }
  }
  __syncthreads();
#pragma unroll
  for (int dir = 0; dir < 2; ++dir) {
    float* ca = coef + (dir * 2) * 4096;
    float* cb2 = ca + 4096;
#pragma unroll
    for (int c = 0; c < 8; ++c) {
      const int ch = (l * 2 + dir) * 256 + chb + c;
      const float sp = __logf(1.0f + __expf(-p.rg_lambda[ch]));
      const int o = tt * 64 + c0 + c;
      const float r = sigmoidf_(ca[o] + p.rg_ba[ch]);
      const float ii = sigmoidf_(cb2[o] + p.rg_bx[ch]);
      const float la = -8.0f * r * sp;
      const float av = __expf(la);
      const float e2 = 2.0f * la;
      const float om = (e2 > -0.1f) ? (-e2 * (1.0f + e2 * (0.5f + e2 * (0.16666667f + e2 * 0.041666668f)))) : (1.0f - __expf(e2));
      ca[o] = av;
      cb2[o] = sqrtf(om) * ii * xcf[o];
    }
  }
  __syncthreads();
  const int sg = tid >> 7, sdir = (tid >> 6) & 1, sch = tid & 63;
  const float* sa = coef + (sdir * 2) * 4096 + sch;
  const float* sb = sa + 4096;
  {
    float Pm = 1.f, H = 0.f;
#pragma unroll
    for (int n = 0; n < 16; ++n) {
      const int tok = sdir ? (63 - (16 * sg + n)) : (16 * sg + n);
      const float av = sa[tok * 64], bv = sb[tok * 64];
      H = av * H + bv;
      Pm *= av;
    }
    segagg[(sg * 2 + sdir) * 64 + sch] = make_float2(Pm, H);
  }
  __syncthreads();
  const int pos = sdir ? (seg == 0 ? 3 - sub : 67 - sub) : (seg == 0 ? sub : 4 + sub);
  float2* aggp = (float2*)p.agg + ((size_t)(b * 2 + sdir) * 68) * 256 + nblk * 64 + sch;
  if (mode == 0) {
    if (tid < 128) {
      float A = 1.f, B = 0.f;
#pragma unroll
      for (int s2 = 0; s2 < 4; ++s2) {
        const float2 g = segagg[(s2 * 2 + sdir) * 64 + sch];
        B = g.x * B + g.y;
        A *= g.x;
      }
      aggp[(size_t)pos * 256] = make_float2(A, B);
    }
    __syncthreads();
    return;
  }
  if (tid < 128) {
    float h = 0.f;
    for (int j = 0; j < pos; ++j) {
      const float2 g = aggp[(size_t)j * 256];
      h = g.x * h + g.y;
    }
    hin[sdir * 64 + sch] = h;
  }
  __syncthreads();
  {
    float h = hin[sdir * 64 + sch];
    for (int s2 = 0; s2 < sg; ++s2) {
      const float2 g = segagg[(s2 * 2 + sdir) * 64 + sch];
      h = g.x * h + g.y;
    }
#pragma unroll
    for (int n = 0; n < 16; ++n) {
      const int tok = sdir ? (63 - (16 * sg + n)) : (16 * sg + n);
      h = sa[tok * 64] * h + sb[tok * 64];
      Hout[sdir * 4096 + tok * 64 + sch] = h;
    }
  }
  __syncthreads();
  {
    const size_t gtok = (size_t)tokbase + T0 + tt;
    const float4 f0 = *(const float4*)(Hout + tt * 64 + c0), f1 = *(const float4*)(Hout + tt * 64 + c0 + 4);
    const float4 h0 = *(const float4*)(Hout + 4096 + tt * 64 + c0), h1 = *(const float4*)(Hout + 4096 + tt * 64 + c0 + 4);
    const uint4 g = *(const uint4*)(p.rg + gtok * 512 + 256 + chb);
    uint4 o;
    o.x = pk2((f0.x + h0.x) * gelu_tanh(bflo(g.x)), (f0.y + h0.y) * gelu_tanh(bfhi(g.x)));
    o.y = pk2((f0.z + h0.z) * gelu_tanh(bflo(g.y)), (f0.w + h0.w) * gelu_tanh(bfhi(g.y)));
    o.z = pk2((f1.x + h1.x) * gelu_tanh(bflo(g.z)), (f1.y + h1.y) * gelu_tanh(bfhi(g.z)));
    o.w = pk2((f1.z + h1.z) * gelu_tanh(bflo(g.w)), (f1.w + h1.w) * gelu_tanh(bfhi(g.w)));
    *(uint4*)(p.ycat + gtok * 1024 + 768 + chb) = o;
  }
  __syncthreads();
}

__device__ void attn_wave(const P& p, int l, int b, int h, bool local, int r, int half, int qtok0, const float* rpbL) {
  const int lane = opaque_tid() & 63, q = lane & 31, hh = lane >> 5;
  bf16x8 qf[4];
  {
    const u16* qp = p.qk + (size_t)(qtok0 + q) * 1024 + h * 64 + 8 * hh;
#pragma unroll
    for (int s = 0; s < 4; ++s) qf[s] = *(const bf16x8*)(qp + 16 * s);
  }
  f32x16 o0 = zero16(), o1 = zero16();
  float m_run = -1e30f, l_run = 0.f;
  const int pi = (q & 19) | ((q & 4) << 1) | ((q & 8) >> 1);
  const int w = half * 32 + q;
  const int st = min(max(w - 8, 0), 48);
  const int rs = min(max(r - 4, 0), 56);
  const int ntiles = local ? 24 : 8;
  for (int ti = 0; ti < ntiles; ++ti) {
    int ktok0, vstride, a = 0, g = 0;
    const u16* vb;
    if (ti < 8) {
      ktok0 = NLAT + b * 256 + ti * 32;
      vb = p.vTc + ((size_t)(b * 512 + h * 64)) * 256 + ti * 32;
      vstride = 256;
    } else {
      const int tl = ti - 8;
      a = tl >> 1; g = tl & 1;
      ktok0 = b * 4096 + (rs + a) * 64 + g * 32;
      vb = p.vT + ((size_t)(b * 512 + h * 64)) * 4096 + (rs + a) * 64 + g * 32;
      vstride = 4096;
    }
    bf16x8 kf[4], vf[2][2];
    {
      const u16* kp = p.qk + (size_t)(ktok0 + pi) * 1024 + 512 + h * 64 + 8 * hh;
#pragma unroll
      for (int s = 0; s < 4; ++s) kf[s] = *(const bf16x8*)(kp + 16 * s);
#pragma unroll
      for (int dt = 0; dt < 2; ++dt)
#pragma unroll
        for (int s2 = 0; s2 < 2; ++s2) vf[dt][s2] = *(const bf16x8*)(vb + (size_t)(dt * 32 + q) * vstride + 16 * s2 + 8 * hh);
    }
    f32x16 sacc = zero16();
#pragma unroll
    for (int s = 0; s < 4; ++s) sacc = mfma32(kf[s], qf[s], sacc);
    float sv[16];
    float tmax = -1e30f;
#pragma unroll
    for (int e = 0; e < 16; ++e) {
      float x = sacc[e] * 0.125f;
      if (ti >= 8) {
        const int kc = g * 32 + (e & 7) + 8 * hh + 16 * (e >> 3);
        const bool valid = (kc >= st) && (kc < st + 16);
        const int bi = valid ? ((rs + a - r + 7) * 31 + (kc - w + 15)) : 0;
        const float bias = rpbL[bi];
        x = valid ? (x + bias) : -1e30f;
      }
      sv[e] = x;
      tmax = fmaxf(tmax, x);
    }
    tmax = fmaxf(tmax, __shfl_xor(tmax, 32));
    const float m_new = fmaxf(m_run, tmax);
    const float alpha = __expf(m_run - m_new);
    m_run = m_new;
    l_run *= alpha;
#pragma unroll
    for (int e = 0; e < 16; ++e) { o0[e] *= alpha; o1[e] *= alpha; }
    float psum = 0.f;
#pragma unroll
    for (int e = 0; e < 16; ++e) { const float pe = __expf(sv[e] - m_new); sv[e] = pe; psum += pe; }
    l_run += psum;
    bf16x8 pf[2];
#pragma unroll
    for (int s2 = 0; s2 < 2; ++s2) {
      union { bf16x8 v; unsigned u[4]; } cv;
#pragma unroll
      for (int j = 0; j < 4; ++j) cv.u[j] = pk2(sv[8 * s2 + 2 * j], sv[8 * s2 + 2 * j + 1]);
      pf[s2] = cv.v;
    }
#pragma unroll
    for (int s2 = 0; s2 < 2; ++s2) {
      o0 = mfma32(vf[0][s2], pf[s2], o0);
      o1 = mfma32(vf[1][s2], pf[s2], o1);
    }
  }
  const float lt = l_run + __shfl_xor(l_run, 32);
  const float inv = 1.0f / lt;
  u16* op = p.ycat + (size_t)(qtok0 + q) * 1024 + h * 64;
#pragma unroll
  for (int qd = 0; qd < 4; ++qd) {
    uint2 a0, a1;
    a0.x = pk2(o0[4 * qd] * inv, o0[4 * qd + 1] * inv);
    a0.y = pk2(o0[4 * qd + 2] * inv, o0[4 * qd + 3] * inv);
    a1.x = pk2(o1[4 * qd] * inv, o1[4 * qd + 1] * inv);
    a1.y = pk2(o1[4 * qd + 2] * inv, o1[4 * qd + 3] * inv);
    *(uint2*)(op + 8 * qd + 4 * hh) = a0;
    *(uint2*)(op + 32 + 8 * qd + 4 * hh) = a1;
  }
}
__device__ void attn_task(const P& p, int l, int kind, int idx, char* smem) {
  const int tid_ = opaque_tid(); const int lane = tid_ & 63, wid = tid_ >> 6;
  float* rpbL = (float*)smem + wid * 480;
  for (int i = lane; i < 465; i += 64) rpbL[i] = p.na_rpb[(size_t)(l * 8 + wid) * 465 + i];
  __syncthreads();
  if (kind == 0) {
    const int half = idx & 1, r = (idx >> 1) & 63, b = idx >> 7;
    attn_wave(p, l, b, wid, true, r, half, b * 4096 + r * 64 + half * 32, rpbL);
  } else {
    const int qg = idx & 7, b = idx >> 3;
    attn_wave(p, l, b, wid, false, 0, 0, NLAT + b * 256 + qg * 32, rpbL);
  }
  __syncthreads();
}

__device__ void phase_mixers(const P& p, int l, char* smem, unsigned* counter) {
  const bool last = (l == 1);
  const int n_rg = 2176, n_fft = 1024 * XFFT, n_hc = last ? 0 : 256, n_att = 1024 * XATT, n_attc = last ? 0 : 64;
  const int total = n_rg + n_fft + n_hc + n_att + n_attc;
  __shared__ int s_task;
  for (;;) {
    __syncthreads();
    if (threadIdx.x == 0) s_task = (int)atomicAdd(counter, 1u);
    __syncthreads();
    int t = s_task;
    if (t >= total) break;
    if (t < n_rg) { rg_chunk_task(p, l, t >> 2, t & 3, 0, last, smem); continue; }
    t -= n_rg;
    if (t < n_fft) { t &= 1023; hyena_fft_task(p, l, t >> 2, t & 3, smem); continue; }
    t -= n_fft;
    if (t < n_hc) { hyena_ctx_task(p, l, t >> 5, t & 31, smem); continue; }
    t -= n_hc;
    if (t < n_att) { t &= 1023; attn_task(p, l, 0, t, smem); continue; }
    t -= n_att;
    attn_task(p, l, 1, t, smem);
  }
}

__device__ void merge_tile(const P& p, int l, int mt, int nt, char* smem) {
  EPI_VARS
  const int m0 = mt * 256, n0 = nt * 128;
  f32x16 macc[2][2];
  zero_acc(macc);
  for (int br = 0; br < 3; ++br) {
    unsigned gp[2][2][8];
    {
      f32x16 acc[2][2];
      zero_acc(acc);
      gemm_kloop(acc, p.xn + (size_t)m0 * 1024, 1024, p.WgT + ((size_t)l * 3072 + br * 1024 + n0) * 1024, 1024, 1024, smem);
#pragma unroll
      for (int j = 0; j < 2; ++j) {
        const float bg = p.b_gate[l * 3072 + br * 1024 + n0 + EPI_COL(j)];
#pragma unroll
        for (int i = 0; i < 2; ++i)
#pragma unroll
          for (int e = 0; e < 8; ++e)
            gp[i][j][e] = pk2(sigmoidf_(acc[i][j][2 * e] + bg), sigmoidf_(acc[i][j][2 * e + 1] + bg));
      }
    }
    {
      f32x16 acc[2][2];
      zero_acc(acc);
      const u16* A; const u16* B; int K;
      if (br == 0) { A = p.ycat + (size_t)m0 * 1024; B = p.WaT + ((size_t)l * 1024 + n0) * 512; K = 512; }
      else if (br == 1) { A = p.ycat + (size_t)m0 * 1024 + 512; B = p.WbT + ((size_t)l * 1024 + n0) * 256; K = 256; }
      else { A = p.ycat + (size_t)m0 * 1024 + 768; B = p.WcT + ((size_t)l * 1024 + n0) * 256; K = 256; }
      gemm_kloop(acc, A, 1024, B, K, K, smem);
#pragma unroll
      for (int i = 0; i < 2; ++i)
#pragma unroll
        for (int j = 0; j < 2; ++j)
#pragma unroll
          for (int e = 0; e < 8; ++e) {
            macc[i][j][2 * e] += bflo(gp[i][j][e]) * acc[i][j][2 * e];
            macc[i][j][2 * e + 1] += bfhi(gp[i][j][e]) * acc[i][j][2 * e + 1];
          }
    }
  }
#pragma unroll
  for (int i = 0; i < 2; ++i)
#pragma unroll
    for (int j = 0; j < 2; ++j)
#pragma unroll
      for (int e = 0; e < 16; ++e)
        p.mbuf[(size_t)(m0 + EPI_ROW(i, e)) * 1024 + n0 + EPI_COL(j)] = f2bf(macc[i][j][e]);
}
__device__ void outproj_tile(const P& p, int l, int mt, int nt, char* smem, bool do_store) {
  EPI_VARS
  const int m0 = mt * 256, n0 = nt * 128;
  f32x16 acc[2][2];
  zero_acc(acc);
  gemm_kloop(acc, p.mbuf + (size_t)m0 * 1024, 1024, p.WoT + ((size_t)l * 1024 + n0) * 1024, 1024, 1024, smem);
  const bool isctx = (mt >= 128);
  const int bi = isctx ? 8 : (mt >> 4);
  const float* gatev = p.mod + ((size_t)(l * 9 + bi) * 6 + 2) * 1024;
  const float* src; float* dst;
  if (isctx) { src = (l == 0 ? p.ctx : p.ctxs) - (size_t)NLAT * 1024; dst = p.ctxs - (size_t)NLAT * 1024; }
  else { src = (l == 0 ? p.x : p.out); dst = p.out; }
#pragma unroll
  for (int j = 0; j < 2; ++j) {
    const int col = n0 + EPI_COL(j);
    const float gv = gatev[col];
#pragma unroll
    for (int i = 0; i < 2; ++i)
#pragma unroll
      for (int e = 0; e < 16; ++e) {
        const size_t o = (size_t)(m0 + EPI_ROW(i, e)) * 1024 + col;
        if (do_store) dst[o] = src[o] + gv * acc[i][j][e];
      }
  }
}

__device__ __forceinline__ void ins16(unsigned (&L)[16], unsigned x) {
#pragma unroll
  for (int i = 0; i < 16; ++i) {
    const unsigned hi = max(L[i], x);
    x = min(L[i], x);
    L[i] = hi;
  }
}
__device__ __forceinline__ unsigned f2sort(float f) {
  const unsigned b = __float_as_uint(f);
  return b ^ ((unsigned)((int)b >> 31) | 0x80000000u);
}
__device__ __forceinline__ float sort2f(unsigned k) {
  const unsigned u = k & ~127u;
  const unsigned b = (u & 0x80000000u) ? (u ^ 0x80000000u) : ~u;
  return __uint_as_float(b);
}
__device__ void peer_score_tile(const P& p, int l, int mt, int hp, char* smem) {
  EPI_VARS
  const int m0 = mt * 256;
  f32x16 acc[2][2];
  zero_acc(acc);
  gemm_kloop(acc, p.xn + (size_t)m0 * 1024, 1024, p.WqT + ((size_t)l * 2048 + hp * 128) * 1024, 1024, 1024, smem);
  {
    const u16* kb = p.keysB + ((size_t)l * 16 + hp) * 16384;
#pragma unroll
    for (int it = 0; it < 4; ++it) {
      const int id = tid + NTHR * it;
      const int row = id >> 4, ch = id & 15;
      *(uint4*)(smem + 65536 + swz256(row, ch)) = *(const uint4*)(kb + row * 128 + ch * 8);
    }
#pragma unroll
    for (int i = 0; i < 2; ++i)
#pragma unroll
      for (int j = 0; j < 2; ++j)
#pragma unroll
        for (int e = 0; e < 16; ++e) {
          const int row = EPI_ROW(i, e), col = EPI_COL(j);
          *(u16*)(smem + swz256(row, col >> 3) + (col & 7) * 2) = f2bf(acc[i][j][e]);
        }
  }
  __syncthreads();
  zero_acc(acc);
#pragma unroll
  for (int ks = 0; ks < 8; ++ks) {
    bf16x8 af[2], bfr[2];
#pragma unroll
    for (int i = 0; i < 2; ++i) af[i] = *(const bf16x8*)(smem + swz256(wm * 64 + i * 32 + l31, 2 * ks + hh));
#pragma unroll
    for (int j = 0; j < 2; ++j) bfr[j] = *(const bf16x8*)(smem + 65536 + swz256(wn * 64 + j * 32 + l31, 2 * ks + hh));
#pragma unroll
    for (int i = 0; i < 2; ++i)
#pragma unroll
      for (int j = 0; j < 2; ++j) acc[i][j] = mfma32(af[i], bfr[j], acc[i][j]);
  }
  __syncthreads();
  float* Sf = (float*)smem;
#pragma unroll
  for (int i = 0; i < 2; ++i)
#pragma unroll
    for (int j = 0; j < 2; ++j)
#pragma unroll
      for (int e = 0; e < 16; ++e) Sf[EPI_ROW(i, e) * 130 + EPI_COL(j)] = acc[i][j][e];
  __syncthreads();
  unsigned L[16];
#pragma unroll
  for (int i = 0; i < 16; ++i) L[i] = 0u;
  const int row = tid >> 1, hf = tid & 1;
  for (int i = 0; i < 64; ++i) {
    const int key = 2 * i + hf;
    const float v = Sf[row * 130 + key];
    ins16(L, (f2sort(v) & ~127u) | (unsigned)key);
  }
  unsigned* X = (unsigned*)(smem + 133120);
  if (hf) {
#pragma unroll
    for (int i = 0; i < 16; ++i) X[row * 16 + i] = L[i];
  }
  __syncthreads();
  if (!hf) {
#pragma unroll
    for (int i = 0; i < 16; ++i) ins16(L, X[row * 16 + i]);
    unsigned* o = p.topk + ((size_t)(m0 + row) * 16 + hp) * 16;
#pragma unroll
    for (int i = 0; i < 4; ++i) *(uint4*)(o + 4 * i) = make_uint4(L[4 * i], L[4 * i + 1], L[4 * i + 2], L[4 * i + 3]);
  }
  __syncthreads();
}

__device__ void phase_peer_experts(const P& p, int l, bool do_store) {
  const int tid_ = opaque_tid(); const int lane = tid_ & 63, wid = tid_ >> 6;
  const int ntok = (l == 1) ? NLAT : NTOK;
  int ci, cj;
  {
    const int e = lane;
    if (e < 16) { ci = 0; cj = e; }
    else if (e < 24) { ci = 1; cj = e - 16; }
    else if (e < 29) { ci = 2; cj = e - 24; }
    else if (e < 33) { ci = 3; cj = e - 29; }
    else if (e < 36) { ci = 4; cj = e - 33; }
    else if (e < 38) { ci = 5; cj = e - 36; }
    else if (e < 40) { ci = 6; cj = e - 38; }
    else if (e < 42) { ci = 7; cj = e - 40; }
    else { ci = min(8 + (e - 42), 15); cj = 0; }
  }
  for (int tok = blockIdx.x * 8 + wid; tok < ntok; tok += gridDim.x * 8) {
    float xr[16];
    {
      const uint4 a = *(const uint4*)(p.xn + (size_t)tok * 1024 + lane * 16);
      const uint4 b = *(const uint4*)(p.xn + (size_t)tok * 1024 + lane * 16 + 8);
      xr[0] = bflo(a.x); xr[1] = bfhi(a.x); xr[2] = bflo(a.y); xr[3] = bfhi(a.y);
      xr[4] = bflo(a.z); xr[5] = bfhi(a.z); xr[6] = bflo(a.w); xr[7] = bfhi(a.w);
      xr[8] = bflo(b.x); xr[9] = bfhi(b.x); xr[10] = bflo(b.y); xr[11] = bfhi(b.y);
      xr[12] = bflo(b.z); xr[13] = bfhi(b.z); xr[14] = bflo(b.w); xr[15] = bfhi(b.w);
    }
    float yacc[16];
#pragma unroll
    for (int i = 0; i < 16; ++i) yacc[i] = 0.f;
    for (int h = 0; h < 8; ++h) {
      const unsigned kv = p.topk[((size_t)tok * 16 + 2 * h) * 16 + (lane & 31)];
      const unsigned k0 = __shfl(kv, ci);
      const unsigned k1 = __shfl(kv, 16 + cj);
      const float val = (lane < 50) ? (sort2f(k0) + sort2f(k1)) : -3.0e38f;
      const int eidx = (int)((k0 & 127u) * 128u + (k1 & 127u));
      int cnt = 0;
      for (int e2 = 0; e2 < 50; ++e2) {
        const float v2 = __shfl(val, e2);
        cnt += (v2 > val || (v2 == val && e2 < lane)) ? 1 : 0;
      }
      const bool sel = (lane < 50) && (cnt < 16);
      const float mx = wave_max(sel ? val : -3.0e38f);
      const float ex = sel ? __expf(val - mx) : 0.f;
      const float sm = wave_sum(ex);
      const float gsel = ex / sm;
      unsigned long long mask = __ballot(sel);
      for (int it = 0; it < 2; ++it) {
        int ln[8];
#pragma unroll
        for (int k = 0; k < 8; ++k) {
          ln[k] = mask ? (__ffsll((long long)mask) - 1) : 0;
          mask &= mask - 1;
        }
        uint4 ur[8], vr[8];
        float gk[8];
#pragma unroll
        for (int k = 0; k < 8; ++k) {
          const int id = __shfl(eidx, ln[k]);
          gk[k] = __shfl(gsel, ln[k]);
          ur[k] = *(const uint4*)(p.Ub + (size_t)id * 1024 + lane * 16);
          vr[k] = *(const uint4*)(p.Vb + (size_t)id * 1024 + lane * 16);
        }
#pragma unroll
        for (int k = 0; k < 8; ++k) {
          float d = 0.f;
          {
            const unsigned uw[4] = {ur[k].x, ur[k].y, ur[k].z, ur[k].w};
#pragma unroll
            for (int q4 = 0; q4 < 4; ++q4) {
              const f32x2 lo = __builtin_amdgcn_cvt_pk_f32_fp8((int)uw[q4], false);
              const f32x2 hi = __builtin_amdgcn_cvt_pk_f32_fp8((int)uw[q4], true);
              d += xr[4 * q4] * lo.x + xr[4 * q4 + 1] * lo.y + xr[4 * q4 + 2] * hi.x + xr[4 * q4 + 3] * hi.y;
            }
          }
          d = wave_sum(d) * (1.0f / 64.0f);
          const float act = gelu_tanh(d) * gk[k];
          {
            const unsigned vw[4] = {vr[k].x, vr[k].y, vr[k].z, vr[k].w};
#pragma unroll
            for (int q4 = 0; q4 < 4; ++q4) {
              const f32x2 lo = __builtin_amdgcn_cvt_pk_f32_fp8((int)vw[q4], false);
              const f32x2 hi = __builtin_amdgcn_cvt_pk_f32_fp8((int)vw[q4], true);
              yacc[4 * q4] += act * lo.x; yacc[4 * q4 + 1] += act * lo.y;
              yacc[4 * q4 + 2] += act * hi.x; yacc[4 * q4 + 3] += act * hi.y;
            }
          }
        }
      }
    }
    const int bi = tok < NLAT ? (tok >> 12) : 8;
    const float* gv = p.mod + ((size_t)(l * 9 + bi) * 6 + 5) * 1024 + lane * 16;
    float* xp = (tok < NLAT) ? (p.out + (size_t)tok * 1024) : (p.ctxs + (size_t)(tok - NLAT) * 1024);
    xp += lane * 16;
#pragma unroll
    for (int i = 0; i < 4; ++i) {
      float4 xv = *(float4*)(xp + 4 * i);
      const float4 g4 = *(const float4*)(gv + 4 * i);
      xv.x += g4.x * yacc[4 * i] * 0.0625f; xv.y += g4.y * yacc[4 * i + 1] * 0.0625f; xv.z += g4.z * yacc[4 * i + 2] * 0.0625f; xv.w += g4.w * yacc[4 * i + 3] * 0.0625f;
      if (do_store) *(float4*)(xp + 4 * i) = xv;
    }
  }
}

__global__ void __launch_bounds__(NTHR) fwd_megakernel(P p) {
  __shared__ __attribute__((aligned(16))) char smem[SMEM_BYTES];
  cg::grid_group grid = cg::this_grid();
  const int nb = gridDim.x, bid = blockIdx.x;

  phase_prep(p, smem);
  grid.sync();
  phase_modreduce(p);
  grid.sync();

  const bool never = (p.counters[512] == 0x12345u);
  for (int l = 0; l < 2; ++l) {
    const bool last = (l == 1);
    const int n_mt = last ? 128 : 136;
    phase_filters(p, l);
    phase_norm(p, l, 0);
    grid.sync();
    for (int rep = 0; rep < DUP_GEMM; ++rep) {
      const int total = 256 + 136 * 22;
      for (int task = bid; task < total; task += nb) {
        if (task < 256) kf_task(p, task, smem);
        else { const int t = task - 256; inproj_tile(p, l, t / 22, t % 22, smem); }
      }
    }
    grid.sync();
    for (int rep = 0; rep < DUP_MIX; ++rep) {
      phase_mixers(p, l, smem, p.counters + l * 4 + rep);
    }
    grid.sync();
    for (int task = bid; task < 2176; task += nb) rg_chunk_task(p, l, task >> 2, task & 3, 1, last, smem);
    grid.sync();
    for (int rep = 0; rep < DUP_GEMM; ++rep)
      for (int task = bid; task < n_mt * 8; task += nb) merge_tile(p, l, task >> 3, task & 7, smem);
    grid.sync();
    for (int rep = 0; rep < DUP_GEMM; ++rep) {
      const int ng = n_mt * 8;
      const int total = ng + 8192;
      const bool st = (rep == DUP_GEMM - 1) || never;
      for (int task = bid; task < total; task += nb) {
        if (task < ng) outproj_tile(p, l, task >> 3, task & 7, smem, st);
        else {
          const int t = task - ng;
          if (t < 4096) cvt_chunk_fp8(p.peer_u + (size_t)l * 16384 * 1024, p.Ub, (size_t)t, 64.0f);
          else cvt_chunk_fp8(p.peer_v + (size_t)l * 16384 * 1024, p.Vb, (size_t)(t - 4096), 16.0f);
        }
      }
    }
    grid.sync();
    phase_norm(p, l, 1);
    grid.sync();
    for (int rep = 0; rep < DUP_GEMM; ++rep)
      for (int task = bid; task < n_mt * 16; task += nb) peer_score_tile(p, l, task >> 4, task & 15, smem);
    grid.sync();
    for (int rep = 0; rep < DUP_PEER; ++rep) phase_peer_experts(p, l, (rep == DUP_PEER - 1) || never);
    grid.sync();
  }
  phase_norm(p, 1, 2);
}

extern "C" void kernel_launch(void* const* d_in, const int* in_sizes, int n_in, void* d_out, int out_size, void* d_ws,
                              size_t ws_size, hipStream_t stream) {
  P p;
  memset(&p, 0, sizeof(p));
  const float** ins = (const float**)&p;
  for (int i = 0; i < 37; ++i) ins[i] = (const float*)d_in[i];
  p.out = (float*)d_out;
  char* w = (char*)d_ws;
  size_t off = 0;
  auto take = [&](size_t bytes) { char* r = w + off; off += (bytes + 255) & ~(size_t)255; return r; };
  p.counters = (unsigned*)take(4096);
  p.WinT = (u16*)take((size_t)2 * 2816 * 1024 * 2);
  p.WgT = (u16*)take((size_t)2 * 3072 * 1024 * 2);
  p.WaT = (u16*)take((size_t)2 * 1024 * 512 * 2);
  p.WbT = (u16*)take((size_t)2 * 1024 * 256 * 2);
  p.WcT = (u16*)take((size_t)2 * 1024 * 256 * 2);
  p.WoT = (u16*)take((size_t)2 * 1024 * 1024 * 2);
  p.WqT = (u16*)take((size_t)2 * 2048 * 1024 * 2);
  p.keysB = (u16*)take((size_t)2 * 16 * 16384 * 2);
  p.rgW = (u16*)take((size_t)2 * 16 * 4096 * 2);
  p.modpart = (float*)take((size_t)16 * 2 * 9 * 6144 * 4);
  p.mod = (float*)take((size_t)2 * 9 * 6144 * 4);
  p.hT = (float*)take((size_t)512 * 4096 * 4);
  p.hc = (float*)take((size_t)512 * 256 * 4);
  p.Kf = (float*)take((size_t)256 * 8192 * 8);
  p.xn = (u16*)take((size_t)NTOK * 1024 * 2);
  p.qk = (u16*)take((size_t)NTOK * 1024 * 2);
  p.mbuf = p.qk;
  p.vT = (u16*)take((size_t)8 * 512 * 4096 * 2);
  p.vTc = (u16*)take((size_t)8 * 512 * 256 * 2);
  p.hyT = (u16*)take((size_t)8 * 768 * 4096 * 2);
  p.topk = (unsigned*)p.hyT;
  p.hyTc = (u16*)take((size_t)8 * 768 * 256 * 2);
  p.rg = (u16*)take((size_t)NTOK * 512 * 2);
  p.ycat = (u16*)take((size_t)NTOK * 1024 * 2);
  p.Ub = (unsigned char*)p.ycat;
  p.Vb = p.Ub + (size_t)16384 * 1024;
  p.agg = (float*)take((size_t)8 * 2 * 68 * 256 * 8);
  p.ctxs = (float*)take((size_t)2048 * 1024 * 4);
  if (off > ws_size) {
    fprintf(stderr, "workspace too small: need %zu have %zu\n", off, ws_size);
    return;
  }
  static int grid_blocks = 0;
  if (!grid_blocks) {
    int dev = 0, cus = 0, per_cu = 0;
    (void)hipGetDevice(&dev);
    (void)hipDeviceGetAttribute(&cus, hipDeviceAttributeMultiprocessorCount, dev);
    (void)hipOccupancyMaxActiveBlocksPerMultiprocessor(&per_cu, fwd_megakernel, NTHR, 0);
    if (per_cu > 1) per_cu = 1;
    grid_blocks = cus * per_cu;
  }
  (void)hipMemsetAsync(p.counters, 0, 4096, stream);
  void* args[] = {&p};
  hipError_t e = hipLaunchCooperativeKernel((void*)fwd_megakernel, dim3(grid_blocks), dim3(NTHR), args, 0, stream);
  if (e != hipSuccess) fprintf(stderr, "cooperative launch failed: %s (grid %d)\n", hipGetErrorString(e), grid_blocks);
}
```

```cpp
#include <hip/hip_runtime.h>
#include <hip/hip_cooperative_groups.h>
#include <cstdio>
#include <cstring>
namespace cg = cooperative_groups;

typedef unsigned short u16;
typedef __attribute__((ext_vector_type(8))) short bf16x8;
typedef __attribute__((ext_vector_type(16))) float f32x16;
typedef __attribute__((ext_vector_type(2))) float f32x2;

#define NLAT 32768
#define NTOK 34816
#define SMEM_BYTES 151552
#define NTHR 512
#ifndef DUP_1A
#define DUP_1A 1
#endif
#ifndef DUP_PREP
#define DUP_PREP 1
#endif
#ifndef DUP_2B
#define DUP_2B 1
#endif
#ifndef XRGA
#define XRGA 1
#endif
#ifndef DUP_GEMM
#define DUP_GEMM 1
#endif
#ifndef DUP_PEER
#define DUP_PEER 1
#endif
#ifndef DUP_MIX
#define DUP_MIX 1
#endif
#ifndef XRG
#define XRG 1
#endif
#ifndef XFFT
#define XFFT 1
#endif
#ifndef XATT
#define XATT 1
#endif

struct P {
  const float *x, *c, *ctx, *c_ctx, *norm_mix_g, *norm_ffn_g, *w_ada, *b_ada, *w_in, *na_rpb,
      *hy_short_w, *hy_short_b, *hy_f1_w, *hy_f1_b, *hy_f2_w, *hy_f2_b, *hy_f3_w, *hy_freq, *hy_bias,
      *rg_conv_w, *rg_conv_b, *rg_wa, *rg_ba, *rg_wx, *rg_bx, *rg_lambda,
      *w_gate, *b_gate, *w_br_a, *w_br_b, *w_br_c, *w_out, *peer_wq, *peer_keys, *peer_u, *peer_v, *final_g;
  float* out;
  unsigned* counters;
  u16 *WinT, *WgT, *WaT, *WbT, *WcT, *WoT, *WqT, *keysB, *rgW;
  float *modpart, *mod, *hT, *hc;
  float* Kf;
  u16 *xn, *qk, *vT, *vTc, *hyT, *hyTc, *rg, *ycat, *mbuf;
  unsigned char *Ub, *Vb;
  float *agg, *ctxs;
  unsigned* topk;
};

__device__ __forceinline__ u16 f2bf(float f) {
  unsigned u = __float_as_uint(f);
  u += 0x7fffu + ((u >> 16) & 1u);
  return (u16)(u >> 16);
}
__device__ __forceinline__ float bf2f(u16 h) { return __uint_as_float(((unsigned)h) << 16); }
__device__ __forceinline__ unsigned pk2(float a, float b) { return (unsigned)f2bf(a) | ((unsigned)f2bf(b) << 16); }
__device__ __forceinline__ float bflo(unsigned u) { return __uint_as_float(u << 16); }
__device__ __forceinline__ float bfhi(unsigned u) { return __uint_as_float(u & 0xffff0000u); }
__device__ __forceinline__ int opaque_tid() {
  int t = threadIdx.x;
  asm volatile("" : "+v"(t));
  return t;
}
__device__ __forceinline__ float wave_sum(float v) {
#pragma unroll
  for (int o = 32; o > 0; o >>= 1) v += __shfl_xor(v, o);
  return v;
}
__device__ __forceinline__ float wave_max(float v) {
#pragma unroll
  for (int o = 32; o > 0; o >>= 1) v = fmaxf(v, __shfl_xor(v, o));
  return v;
}
__device__ __forceinline__ float sigmoidf_(float x) { return __builtin_amdgcn_rcpf(1.0f + __expf(-x)); }
__device__ __forceinline__ float gelu_tanh(float x) {
  const float u2 = 1.5957691216057308f * (x + 0.044715f * x * x * x);
  return x * __builtin_amdgcn_rcpf(1.0f + __expf(-u2));
}
__device__ __forceinline__ f32x16 mfma32(bf16x8 a, bf16x8 b, f32x16 c) {
  return __builtin_amdgcn_mfma_f32_32x32x16_bf16(a, b, c, 0, 0, 0);
}
__device__ __forceinline__ f32x16 zero16() {
  f32x16 z;
#pragma unroll
  for (int i = 0; i < 16; ++i) z[i] = 0.f;
  return z;
}
__device__ __forceinline__ int swz128(int row, int ch) { return row * 128 + ((ch ^ ((row >> 1) & 7)) << 4); }
__device__ __forceinline__ int swz256(int row, int ch) { return row * 256 + ((ch ^ (row & 15)) << 4); }

struct c2 { float x, y; };
__device__ __forceinline__ c2 cadd(c2 a, c2 b) { return {a.x + b.x, a.y + b.y}; }
__device__ __forceinline__ c2 csub(c2 a, c2 b) { return {a.x - b.x, a.y - b.y}; }
__device__ __forceinline__ c2 cmul(c2 a, c2 b) { return {a.x * b.x - a.y * b.y, a.x * b.y + a.y * b.x}; }
__device__ __forceinline__ float c16(int i) {
  const float tb[16] = {1.0f, 0.9238795325112867f, 0.7071067811865476f, 0.3826834323650898f, 0.0f,
                        -0.3826834323650898f, -0.7071067811865476f, -0.9238795325112867f, -1.0f,
                        -0.9238795325112867f, -0.7071067811865476f, -0.3826834323650898f, 0.0f,
                        0.3826834323650898f, 0.7071067811865476f, 0.9238795325112867f};
  return tb[i & 15];
}
__device__ __forceinline__ float s16(int i) { return c16(i + 12); }
template <int R> __device__ __forceinline__ constexpr int brev(int k) {
  int r = 0;
  for (int b = 1, o = R >> 1; b < R; b <<= 1, o >>= 1)
    if (k & b) r |= o;
  return r;
}
template <int R> __device__ __forceinline__ void dft_reg(c2* v, float sgn) {
#pragma unroll
  for (int h = R / 2; h >= 1; h >>= 1) {
#pragma unroll
    for (int g = 0; g < R; g += 2 * h) {
#pragma unroll
      for (int j = 0; j < h; ++j) {
        c2 a = v[g + j], b = v[g + j + h];
        v[g + j] = cadd(a, b);
        c2 d = csub(a, b);
        const int ti = j * (16 / (2 * h));
        c2 w = {c16(ti), sgn * s16(ti)};
        v[g + j + h] = (j == 0) ? d : cmul(d, w);
      }
    }
  }
}
template <int R> __device__ __forceinline__ int fft_bfly(c2* v, int j, int Ns, float sgn) {
  const int k = j & (Ns - 1);
  const float f = sgn * (float)k / (float)(Ns * R);
#pragma unroll
  for (int r = 1; r < R; ++r) {
    float t = f * (float)r;
    c2 w = {__builtin_amdgcn_cosf(t), __builtin_amdgcn_sinf(t)};
    v[r] = cmul(v[r], w);
  }
  dft_reg<R>(v, sgn);
  return (j - k) * R + k;
}
template <int R> __device__ __forceinline__ void fft_pass(c2* buf, int Ns, float sgn) {
  constexpr int NBF = 8192 / R;
  constexpr int PER = NBF / NTHR;
  const int tid = opaque_tid();
  c2 v[PER][R];
#pragma unroll
  for (int i = 0; i < PER; ++i) {
    const int j = tid + NTHR * i;
#pragma unroll
    for (int r = 0; r < R; ++r) v[i][r] = buf[j + r * NBF];
  }
  __syncthreads();
#pragma unroll
  for (int i = 0; i < PER; ++i) {
    const int j = tid + NTHR * i;
    const int base = fft_bfly<R>(v[i], j, Ns, sgn);
#pragma unroll
    for (int r = 0; r < R; ++r) buf[base + r * Ns] = v[i][brev<R>(r)];
  }
  __syncthreads();
}
__device__ __forceinline__ void fft8192(c2* buf, float sgn) {
  fft_pass<8>(buf, 1, sgn);
  fft_pass<8>(buf, 8, sgn);
  fft_pass<8>(buf, 64, sgn);
  fft_pass<16>(buf, 512, sgn);
}

__device__ __forceinline__ void gemm_kloop(f32x16 (&acc)[2][2], const u16* __restrict__ A, int lda,
                                           const u16* __restrict__ B, int ldb, int K, char* smem) {
  const int tid = opaque_tid(), lane = tid & 63, wid = tid >> 6;
  const int wm = wid >> 1, wn = wid & 1;
  const int l31 = lane & 31, hh = lane >> 5;
  uint4 ra[4], rb[2];
  const int nk = K >> 6;
  const int srow = tid >> 3, sch = tid & 7;
  const char* Ab = (const char*)A;
  const char* Bb = (const char*)B;
  const unsigned aoff = (unsigned)(srow * lda + sch * 8) * 2u;
  const unsigned boff = (unsigned)(srow * ldb + sch * 8) * 2u;
  const unsigned astep = (unsigned)lda * 128u, bstep = (unsigned)ldb * 128u;
#pragma unroll
  for (int i = 0; i < 4; ++i) ra[i] = *(const uint4*)(Ab + (aoff + i * astep));
#pragma unroll
  for (int i = 0; i < 2; ++i) rb[i] = *(const uint4*)(Bb + (boff + i * bstep));
#pragma unroll
  for (int i = 0; i < 4; ++i) *(uint4*)(smem + swz128(srow + i * 64, sch)) = ra[i];
#pragma unroll
  for (int i = 0; i < 2; ++i) *(uint4*)(smem + 65536 + swz128(srow + i * 64, sch)) = rb[i];
  __syncthreads();
  for (int kt = 0; kt < nk; ++kt) {
    const bool more = (kt + 1 < nk);
    if (more) {
      const unsigned ko = (unsigned)(kt + 1) * 128u;
#pragma unroll
      for (int i = 0; i < 4; ++i) ra[i] = *(const uint4*)(Ab + (aoff + i * astep + ko));
#pragma unroll
      for (int i = 0; i < 2; ++i) rb[i] = *(const uint4*)(Bb + (boff + i * bstep + ko));
    }
    const char* as = smem + (kt & 1) * 32768;
    const char* bs = smem + 65536 + (kt & 1) * 16384;
    int lrow = l31;
    asm volatile("" : "+v"(lrow));
#pragma unroll
    for (int s = 0; s < 4; ++s) {
      bf16x8 af[2], bfr[2];
#pragma unroll
      for (int i = 0; i < 2; ++i) af[i] = *(const bf16x8*)(as + swz128(wm * 64 + i * 32 + lrow, s * 2 + hh));
#pragma unroll
      for (int j = 0; j < 2; ++j) bfr[j] = *(const bf16x8*)(bs + swz128(wn * 64 + j * 32 + lrow, s * 2 + hh));
#pragma unroll
      for (int i = 0; i < 2; ++i)
#pragma unroll
        for (int j = 0; j < 2; ++j) acc[i][j] = mfma32(af[i], bfr[j], acc[i][j]);
    }
    if (more) {
      char* an = smem + ((kt + 1) & 1) * 32768;
      char* bn = smem + 65536 + ((kt + 1) & 1) * 16384;
      int sr2 = srow;
      asm volatile("" : "+v"(sr2));
#pragma unroll
      for (int i = 0; i < 4; ++i) *(uint4*)(an + swz128(sr2 + i * 64, sch)) = ra[i];
#pragma unroll
      for (int i = 0; i < 2; ++i) *(uint4*)(bn + swz128(sr2 + i * 64, sch)) = rb[i];
    }
    __syncthreads();
  }
}
__device__ __forceinline__ void zero_acc(f32x16 (&acc)[2][2]) {
#pragma unroll
  for (int i = 0; i < 2; ++i)
#pragma unroll
    for (int j = 0; j < 2; ++j) acc[i][j] = zero16();
}
#define EPI_ROW(i, e) (wm * 64 + (i)*32 + ((e)&3) + 8 * ((e) >> 2) + 4 * hh)
#define EPI_COL(j) (wn * 64 + (j)*32 + l31)
#define EPI_VARS                                                    \
  const int tid = opaque_tid(), lane = tid & 63, wid = tid >> 6;     \
  const int wm = wid >> 1, wn = wid & 1, l31 = lane & 31, hh = lane >> 5; \
  (void)tid; (void)wm; (void)wn; (void)l31; (void)hh;

__device__ void tr_tile(const float* __restrict__ src, int N, int K, u16* __restrict__ dst, int tile, char* smem) {
  float* lds = (float*)smem;
  const int tiles_n = N >> 6;
  const int tk = tile / tiles_n, tn = tile - tk * tiles_n;
  const int tid = opaque_tid();
  {
    const int r = tid >> 3, c8 = (tid & 7) * 8;
    const float* s = src + (size_t)(tk * 64 + r) * N + tn * 64 + c8;
    float4 a = *(const float4*)s, b = *(const float4*)(s + 4);
    float* d = lds + r * 65 + c8;
    d[0] = a.x; d[1] = a.y; d[2] = a.z; d[3] = a.w; d[4] = b.x; d[5] = b.y; d[6] = b.z; d[7] = b.w;
  }
  __syncthreads();
  {
    const int n = tid >> 3, k0 = (tid & 7) * 8;
    uint4 o;
    o.x = pk2(lds[(k0 + 0) * 65 + n], lds[(k0 + 1) * 65 + n]);
    o.y = pk2(lds[(k0 + 2) * 65 + n], lds[(k0 + 3) * 65 + n]);
    o.z = pk2(lds[(k0 + 4) * 65 + n], lds[(k0 + 5) * 65 + n]);
    o.w = pk2(lds[(k0 + 6) * 65 + n], lds[(k0 + 7) * 65 + n]);
    *(uint4*)(dst + (size_t)(tn * 64 + n) * K + tk * 64 + k0) = o;
  }
  __syncthreads();
}
__device__ void cvt_chunk(const float* __restrict__ src, u16* __restrict__ dst, size_t chunk) {
  const size_t i = chunk * 4096 + (size_t)opaque_tid() * 8;
  float4 a = *(const float4*)(src + i), b = *(const float4*)(src + i + 4);
  uint4 o;
  o.x = pk2(a.x, a.y); o.y = pk2(a.z, a.w); o.z = pk2(b.x, b.y); o.w = pk2(b.z, b.w);
  *(uint4*)(dst + i) = o;
}
__device__ void cvt_chunk_fp8(const float* __restrict__ src, unsigned char* __restrict__ dst, size_t chunk, float scale) {
  const size_t i = chunk * 4096 + (size_t)opaque_tid() * 8;
  const float4 a = *(const float4*)(src + i), b = *(const float4*)(src + i + 4);
  int w0 = __builtin_amdgcn_cvt_pk_fp8_f32(a.x * scale, a.y * scale, 0, false);
  w0 = __builtin_amdgcn_cvt_pk_fp8_f32(a.z * scale, a.w * scale, w0, true);
  int w1 = __builtin_amdgcn_cvt_pk_fp8_f32(b.x * scale, b.y * scale, 0, false);
  w1 = __builtin_amdgcn_cvt_pk_fp8_f32(b.z * scale, b.w * scale, w1, true);
  *(uint2*)(dst + i) = make_uint2((unsigned)w0, (unsigned)w1);
}
__device__ void phase_prep(const P& p, char* smem) {
  const int tid = opaque_tid();
  const int NTR = 2512;
  const int total = 2 * NTR + 128 + 384;
  for (int task = blockIdx.x; task < total; task += gridDim.x) {
    if (task < 2 * NTR) {
      const int l = task / NTR;
      int t = task - l * NTR;
      if (t < 704) tr_tile(p.w_in + (size_t)l * 1024 * 2816, 2816, 1024, p.WinT + (size_t)l * 2816 * 1024, t, smem);
      else if ((t -= 704) < 768) tr_tile(p.w_gate + (size_t)l * 1024 * 3072, 3072, 1024, p.WgT + (size_t)l * 3072 * 1024, t, smem);
      else if ((t -= 768) < 128) tr_tile(p.w_br_a + (size_t)l * 512 * 1024, 1024, 512, p.WaT + (size_t)l * 1024 * 512, t, smem);
      else if ((t -= 128) < 64) tr_tile(p.w_br_b + (size_t)l * 256 * 1024, 1024, 256, p.WbT + (size_t)l * 1024 * 256, t, smem);
      else if ((t -= 64) < 64) tr_tile(p.w_br_c + (size_t)l * 256 * 1024, 1024, 256, p.WcT + (size_t)l * 1024 * 256, t, smem);
      else if ((t -= 64) < 256) tr_tile(p.w_out + (size_t)l * 1024 * 1024, 1024, 1024, p.WoT + (size_t)l * 1024 * 1024, t, smem);
      else if ((t -= 256) < 512) tr_tile(p.peer_wq + (size_t)l * 1024 * 2048, 2048, 1024, p.WqT + (size_t)l * 2048 * 1024, t, smem);
      else {
        t -= 512;
        const int gate = t >> 3, dn = t & 7;
        const float* src = (gate ? p.rg_wx : p.rg_wa) + (size_t)(l * 8 + dn) * 4096;
        tr_tile(src, 64, 64, p.rgW + (size_t)((l * 2 + gate) * 8 + dn) * 4096, 0, smem);
      }
    } else if (task < 2 * NTR + 128) {
      cvt_chunk(p.peer_keys, p.keysB, (size_t)(task - 2 * NTR));
    } else {
      int t = task - 2 * NTR - 128;
      const int kc = t & 15; t >>= 4;
      const int jc = t % 12, l = t / 12;
      float* s = (float*)smem;
      for (int i = tid; i < 576; i += NTHR) {
        const int bi = i >> 6, kk = i & 63;
        const float v = (bi < 8) ? p.c[bi * 1024 + kc * 64 + kk] : p.c_ctx[kc * 64 + kk];
        s[i] = v / (1.0f + __expf(-v));
      }
      __syncthreads();
      const int j = jc * 512 + tid;
      float acc[9];
#pragma unroll
      for (int bi = 0; bi < 9; ++bi) acc[bi] = 0.f;
      const float* wp = p.w_ada + ((size_t)l * 1024 + kc * 64) * 6144 + j;
#pragma unroll 8
      for (int kk = 0; kk < 64; ++kk) {
        const float w = wp[(size_t)kk * 6144];
#pragma unroll
        for (int bi = 0; bi < 9; ++bi) acc[bi] += s[bi * 64 + kk] * w;
      }
#pragma unroll
      for (int bi = 0; bi < 9; ++bi) p.modpart[((size_t)(kc * 2 + l) * 9 + bi) * 6144 + j] = acc[bi];
      __syncthreads();
    }
  }
}
__device__ void phase_modreduce(const P& p) {
  const int n = 2 * 9 * 6144;
  for (int i = blockIdx.x * NTHR + opaque_tid(); i < n; i += gridDim.x * NTHR) {
    const int l = i / (9 * 6144);
    const int j = i % 6144;
    float s = p.b_ada[l * 6144 + j];
#pragma unroll
    for (int kc = 0; kc < 16; ++kc) s += p.modpart[(size_t)kc * n + i];
    p.mod[i] = s;
  }
}

__device__ void phase_norm(const P& p, int l, int which) {
  const int tid_ = opaque_tid(); const int lane = tid_ & 63, wid = tid_ >> 6;
  const int ntok = (which == 2 || (which == 1 && l == 1)) ? NLAT : NTOK;
  for (int row = blockIdx.x * 8 + wid; row < ntok; row += gridDim.x * 8) {
    const float* src;
    if (row < NLAT) src = ((which == 0 && l == 0) ? p.x : p.out) + (size_t)row * 1024;
    else src = ((which == 0 && l == 0) ? p.ctx : p.ctxs) + (size_t)(row - NLAT) * 1024;
    float4 v[4];
    float ss = 0.f;
#pragma unroll
    for (int i = 0; i < 4; ++i) {
      v[i] = *(const float4*)(src + i * 256 + lane * 4);
      ss += v[i].x * v[i].x + v[i].y * v[i].y + v[i].z * v[i].z + v[i].w * v[i].w;
    }
    ss = wave_sum(ss);
    const float rstd = rsqrtf(ss * (1.0f / 1024.0f) + 1e-6f);
    if (which == 2) {
#pragma unroll
      for (int i = 0; i < 4; ++i) {
        const int col = i * 256 + lane * 4;
        const float4 g = *(const float4*)(p.final_g + col);
        float4 o = {v[i].x * rstd * g.x, v[i].y * rstd * g.y, v[i].z * rstd * g.z, v[i].w * rstd * g.w};
        *(float4*)(p.out + (size_t)row * 1024 + col) = o;
      }
    } else {
      const int bi = row < NLAT ? (row >> 12) : 8;
      const float* gam = (which == 0 ? p.norm_mix_g : p.norm_ffn_g) + l * 1024;
      const float* msh = p.mod + ((size_t)(l * 9 + bi) * 6 + (which == 0 ? 0 : 3)) * 1024;
      const float* msc = msh + 1024;
#pragma unroll
      for (int i = 0; i < 4; ++i) {
        const int col = i * 256 + lane * 4;
        const float4 g = *(const float4*)(gam + col);
        const float4 sh = *(const float4*)(msh + col);
        const float4 sc = *(const float4*)(msc + col);
        uint2 o;
        o.x = pk2(v[i].x * rstd * g.x * (1.f + sc.x) + sh.x, v[i].y * rstd * g.y * (1.f + sc.y) + sh.y);
        o.y = pk2(v[i].z * rstd * g.z * (1.f + sc.z) + sh.z, v[i].w * rstd * g.w * (1.f + sc.w) + sh.w);
        *(uint2*)(p.xn + (size_t)row * 1024 + col) = o;
      }
    }
  }
}

__device__ void filter_wave(const P& p, int l, int L, int t, float* __restrict__ outp) {
  const int lane = opaque_tid() & 63;
  const float tl = (float)t / (float)(L - 1);
  const float wang = (6.283185307179586f / (float)L) * (float)t;
  float z = 0.f;
  if (lane == 0) z = tl;
  else if (lane <= 16) { const float band = 1e-4f + (float)(lane - 1) * ((15.0f - 1e-4f) / 15.0f); z = cosf(band * wang); }
  else if (lane <= 32) { const float band = 1e-4f + (float)(lane - 17) * ((15.0f - 1e-4f) / 15.0f); z = -sinf(band * wang); }
  float a1 = p.hy_f1_b[l * 64 + lane];
  for (int i = 0; i < 33; ++i) a1 += __shfl(z, i) * p.hy_f1_w[(l * 33 + i) * 64 + lane];
  const float h1 = sinf(p.hy_freq[l * 128 + lane] * a1);
  float a2 = p.hy_f2_b[l * 64 + lane];
  for (int i = 0; i < 64; ++i) a2 += __shfl(h1, i) * p.hy_f2_w[(l * 64 + i) * 64 + lane];
  const float h2 = sinf(p.hy_freq[l * 128 + 64 + lane] * a2);
  float a3[8];
#pragma unroll
  for (int m = 0; m < 8; ++m) a3[m] = 0.f;
  for (int i = 0; i < 64; ++i) {
    const float hv = __shfl(h2, i);
    const float* wr = p.hy_f3_w + (size_t)(l * 64 + i) * 512 + lane;
#pragma unroll
    for (int m = 0; m < 8; ++m) a3[m] += hv * wr[m * 64];
  }
  const float LN100 = 4.605170185988092f;
  const float d0 = LN100 / 1.5f, d1 = LN100 / 0.3f;
#pragma unroll
  for (int m = 0; m < 8; ++m) {
    const int cp = lane + 64 * m;
    const int ch = cp & 255;
    const float delta = d0 + (float)ch * ((d1 - d0) / 255.0f);
    outp[(size_t)cp * L + t] = a3[m] * expf(-tl * delta);
  }
}
__device__ void phase_filters(const P& p, int l) {
  const int wid = opaque_tid() >> 6;
  const int ntask = 4096 + (l == 0 ? 256 : 0);
  for (int t = blockIdx.x * 8 + wid; t < ntask; t += gridDim.x * 8) {
    if (t < 4096) filter_wave(p, l, 4096, t, p.hT);
    else filter_wave(p, l, 256, t - 4096, p.hc);
  }
}
__device__ void kf_task(const P& p, int c, char* smem) {
  c2* buf = (c2*)smem;
  const int tid = opaque_tid();
  for (int i = 0; i < 16; ++i) {
    const int j = tid + NTHR * i;
    float v;
    if (j < 4096) v = p.hT[(size_t)c * 4096 + j];
    else if (j == 4096) v = 0.f;
    else v = p.hT[(size_t)(256 + c) * 4096 + (8192 - j)];
    buf[j] = {v, 0.f};
  }
  __syncthreads();
  fft8192(buf, -1.f);
  c2* o = (c2*)p.Kf + (size_t)c * 8192;
  for (int i = 0; i < 16; ++i) { const int j = tid + NTHR * i; o[j] = buf[j]; }
  __syncthreads();
}

__device__ void inproj_tile(const P& p, int l, int mt, int nt, char* smem) {
  f32x16 acc[2][2];
  zero_acc(acc);
  const int m0 = mt * 256, n0 = nt * 128;
  gemm_kloop(acc, p.xn + (size_t)m0 * 1024, 1024, p.WinT + ((size_t)l * 2816 + n0) * 1024, 1024, 1024, smem);
  EPI_VARS
  if (nt < 8 || nt >= 18) {
    u16* dst; int ld, cbase;
    if (nt < 8) { dst = p.qk; ld = 1024; cbase = n0; }
    else { dst = p.rg; ld = 512; cbase = n0 - 2304; }
#pragma unroll
    for (int i = 0; i < 2; ++i)
#pragma unroll
      for (int j = 0; j < 2; ++j)
#pragma unroll
        for (int e = 0; e < 16; ++e)
          dst[(size_t)(m0 + EPI_ROW(i, e)) * ld + cbase + EPI_COL(j)] = f2bf(acc[i][j][e]);
  } else {
#pragma unroll
    for (int i = 0; i < 2; ++i)
#pragma unroll
      for (int j = 0; j < 2; ++j)
#pragma unroll
        for (int qd = 0; qd < 4; ++qd) {
          uint2 o;
          o.x = pk2(acc[i][j][4 * qd + 0], acc[i][j][4 * qd + 1]);
          o.y = pk2(acc[i][j][4 * qd + 2], acc[i][j][4 * qd + 3]);
          const int row0 = wm * 64 + i * 32 + 8 * qd + 4 * hh;
          *(uint2*)(smem + EPI_COL(j) * 520 + row0 * 2) = o;
        }
    __syncthreads();
    u16* dstT; int Lseg, t0, ncol0, nc;
    const bool isctx = (mt >= 128);
    const int b = isctx ? (mt - 128) : (mt >> 4);
    if (nt < 12) { ncol0 = n0 - 1024; nc = 512; dstT = isctx ? p.vTc : p.vT; }
    else { ncol0 = n0 - 1536; nc = 768; dstT = isctx ? p.hyTc : p.hyT; }
    if (isctx) { Lseg = 256; t0 = 0; } else { Lseg = 4096; t0 = (mt & 15) * 256; }
#pragma unroll 4
    for (int it = 0; it < 16; ++it) {
      const int idx = tid + NTHR * it;
      const int col = idx >> 6, u = idx & 63;
      const uint2 v = *(const uint2*)(smem + col * 520 + u * 8);
      *(uint2*)(dstT + ((size_t)(b * nc + ncol0 + col)) * Lseg + t0 + u * 4) = v;
    }
    __syncthreads();
  }
}

__device__ __forceinline__ float ldbf(const u16* p, int t, int L) { return (t >= 0 && t < L) ? bf2f(p[t]) : 0.f; }
__device__ void hyena_fft_task(const P& p, int l, int c, int bp, char* smem) {
  c2* buf = (c2*)smem;
  c2* ub = (c2*)(smem + 65536);
  const int tid = opaque_tid();
  const float* sw = p.hy_short_w + l * 3 * 768;
  const float* sb = p.hy_short_b + l * 768;
  const float wx0[3] = {sw[c], sw[768 + c], sw[1536 + c]};
  const float wx1[3] = {sw[256 + c], sw[768 + 256 + c], sw[1536 + 256 + c]};
  const float wv[3] = {sw[512 + c], sw[768 + 512 + c], sw[1536 + 512 + c]};
  const float bx0 = sb[c], bx1 = sb[256 + c], bv = sb[512 + c];
  const float dsk = p.hy_bias[l * 256 + c];
  for (int i = 0; i < 8; ++i) {
    const int t = tid + NTHR * i;
    float u[2];
#pragma unroll
    for (int bb = 0; bb < 2; ++bb) {
      const int b = 2 * bp + bb;
      const u16* x1 = p.hyT + ((size_t)(b * 768 + 256 + c)) * 4096;
      const u16* vv = p.hyT + ((size_t)(b * 768 + 512 + c)) * 4096;
      const float x1c = bx1 + wx1[0] * ldbf(x1, t - 1, 4096) + wx1[1] * ldbf(x1, t, 4096) + wx1[2] * ldbf(x1, t + 1, 4096);
      const float vc = bv + wv[0] * ldbf(vv, t - 1, 4096) + wv[1] * ldbf(vv, t, 4096) + wv[2] * ldbf(vv, t + 1, 4096);
      u[bb] = vc * x1c;
    }
    buf[t] = {u[0], u[1]};
    ub[t] = {u[0], u[1]};
    buf[t + 4096] = {0.f, 0.f};
  }
  __syncthreads();
  fft8192(buf, -1.f);
  const c2* kf = (const c2*)p.Kf + (size_t)c * 8192;
  for (int i = 0; i < 16; ++i) {
    const int k = tid + NTHR * i;
    buf[k] = cmul(buf[k], kf[k]);
  }
  __syncthreads();
  fft8192(buf, 1.f);
  for (int i = 0; i < 8; ++i) {
    const int t = tid + NTHR * i;
    const c2 y = buf[t];
    const c2 uu = ub[t];
#pragma unroll
    for (int bb = 0; bb < 2; ++bb) {
      const int b = 2 * bp + bb;
      const u16* x0 = p.hyT + ((size_t)(b * 768 + c)) * 4096;
      const float x0c = bx0 + wx0[0] * ldbf(x0, t - 1, 4096) + wx0[1] * ldbf(x0, t, 4096) + wx0[2] * ldbf(x0, t + 1, 4096);
      const float yy = ldexpf(bb ? y.y : y.x, -13);
      const float uv = bb ? uu.y : uu.x;
      p.ycat[(size_t)(b * 4096 + t) * 1024 + 512 + c] = f2bf(x0c * (yy + uv * dsk));
    }
  }
  __syncthreads();
}
__device__ void hyena_ctx_task(const P& p, int l, int b, int cg8, char* smem) {
  const int tid_ = opaque_tid(); const int lane = tid_ & 63, wid = tid_ >> 6;
  const int c = cg8 * 8 + wid;
  float* us = (float*)smem + wid * 1024;
  float* kfp = us + 256 + 255;
  const float* sw = p.hy_short_w + l * 3 * 768;
  const float* sb = p.hy_short_b + l * 768;
  const u16* x0 = p.hyTc + ((size_t)(b * 768 + c)) * 256;
  const u16* x1 = p.hyTc + ((size_t)(b * 768 + 256 + c)) * 256;
  const u16* vv = p.hyTc + ((size_t)(b * 768 + 512 + c)) * 256;
  for (int i = 0; i < 4; ++i) {
    const int t = lane + 64 * i;
    const float x1c = sb[256 + c] + sw[256 + c] * ldbf(x1, t - 1, 256) + sw[768 + 256 + c] * ldbf(x1, t, 256) + sw[1536 + 256 + c] * ldbf(x1, t + 1, 256);
    const float vc = sb[512 + c] + sw[512 + c] * ldbf(vv, t - 1, 256) + sw[768 + 512 + c] * ldbf(vv, t, 256) + sw[1536 + 512 + c] * ldbf(vv, t + 1, 256);
    us[t] = vc * x1c;
    kfp[t] = p.hc[(size_t)c * 256 + t];
    if (t > 0) kfp[-t] = p.hc[(size_t)(256 + c) * 256 + t];
  }
  __syncthreads();
  const float dsk = p.hy_bias[l * 256 + c];
  float acc[4] = {0.f, 0.f, 0.f, 0.f};
  for (int s = 0; s < 256; ++s) {
    const float uv = us[s];
#pragma unroll
    for (int i = 0; i < 4; ++i) acc[i] += kfp[lane + 64 * i - s] * uv;
  }
#pragma unroll
  for (int i = 0; i < 4; ++i) {
    const int t = lane + 64 * i;
    const float x0c = sb[c] + sw[c] * ldbf(x0, t - 1, 256) + sw[768 + c] * ldbf(x0, t, 256) + sw[1536 + c] * ldbf(x0, t + 1, 256);
    p.ycat[(size_t)(NLAT + b * 256 + t) * 1024 + 512 + c] = f2bf(x0c * (acc[i] + us[t] * dsk));
  }
  __syncthreads();
}

__device__ void rg_chunk_task(const P& p, int l, int cq, int nblk, int mode, bool last, char* smem) {
  const int tid = opaque_tid(), lane = tid & 63, wid = tid >> 6;
  const int l31 = lane & 31, hh = lane >> 5;
  const int b = cq / 68, rr = cq - b * 68;
  const int seg = rr < 4 ? 0 : 1, sub = rr < 4 ? rr : rr - 4;
  if (mode == 1 && seg == 0 && last) return;
  float* xcf = (float*)smem;
  char* xcb = smem + 16384;
  float* coef = (float*)(smem + 24576);
  float2* segagg = (float2*)(smem + 90112);
  float* hin = (float*)(smem + 94208);
  float* Hout = (float*)(smem + 94720);
  const int Lseg = seg ? 4096 : 256;
  const int tokbase = seg ? b * 4096 : NLAT + b * 256;
  const int T0 = sub * 64;
  const int tt = tid >> 3, c0 = (tid & 7) * 8;
  const int chb = nblk * 64 + c0;
  const int wdir = wid >> 2, wgate = (wid >> 1) & 1, wmt = wid & 1;
  bf16x8 wf[2][4];
  {
    const u16* wp = p.rgW + (size_t)(((l * 2 + wgate) * 2 + wdir) * 4 + nblk) * 4096 + l31 * 64 + 8 * hh;
#pragma unroll
    for (int nt = 0; nt < 2; ++nt)
#pragma unroll
      for (int s = 0; s < 4; ++s) wf[nt][s] = *(const bf16x8*)(wp + nt * 2048 + 16 * s);
  }
  {
    float xc[8];
#pragma unroll
    for (int c = 0; c < 8; ++c) xc[c] = p.rg_conv_b[l * 256 + chb + c];
#pragma unroll
    for (int k = 0; k < 4; ++k) {
      const int pos = T0 + tt + k - 2;
      if (pos >= 0 && pos < Lseg) {
        const uint4 raw = *(const uint4*)(p.rg + (size_t)(tokbase + pos) * 512 + chb);
        const float4 w0 = *(const float4*)(p.rg_conv_w + (l * 4 + k) * 256 + chb);
        const float4 w1 = *(const float4*)(p.rg_conv_w + (l * 4 + k) * 256 + chb + 4);
        xc[0] += w0.x * bflo(raw.x); xc[1] += w0.y * bfhi(raw.x);
        xc[2] += w0.z * bflo(raw.y); xc[3] += w0.w * bfhi(raw.y);
        xc[4] += w1.x * bflo(raw.z); xc[5] += w1.y * bfhi(raw.z);
        xc[6] += w1.z * bflo(raw.w); xc[7] += w1.w * bfhi(raw.w);
      }
    }
    *(float4*)(xcf + tt * 64 + c0) = make_float4(xc[0], xc[1], xc[2], xc[3]);
    *(float4*)(xcf + tt * 64 + c0 + 4) = make_float4(xc[4], xc[5], xc[6], xc[7]);
    uint4 o;
    o.x = pk2(xc[0], xc[1]); o.y = pk2(xc[2], xc[3]); o.z = pk2(xc[4], xc[5]); o.w = pk2(xc[6], xc[7]);
    *(uint4*)(xcb + swz128(tt, tid & 7)) = o;
  }
  __syncthreads();
  {
    f32x16 acc0 = zero16(), acc1 = zero16();
#pragma unroll
    for (int s = 0; s < 4; ++s) {
      const bf16x8 af = *(const bf16x8*)(xcb + swz128(wmt * 32 + l31, 2 * s + hh));
      acc0 = mfma32(af, wf[0][s], acc0);
      acc1 = mfma32(af, wf[1][s], acc1);
    }
    float* cp = coef + (wdir * 2 + wgate) * 4096;
#pragma unroll
    for (int e = 0; e < 16; ++e) {
      const int tok = wmt * 32 + (e & 3) + 8 * (e >> 2) + 4 * hh;
      cp[tok * 64 + l31] = acc0[e];
      cp[tok * 64 + 32 + l31] = acc1[e];
    }
  }
  __syncthreads();
#pragma unroll
  for (int dir = 0; dir < 2; ++dir) {
    float* ca = coef + (dir * 2) * 4096;
    float* cb2 = ca + 4096;
#pragma unroll
    for (int c = 0; c < 8; ++c) {
      const int ch = (l * 2 + dir) * 256 + chb + c;
      const float sp = __logf(1.0f + __expf(-p.rg_lambda[ch]));
      const int o = tt * 64 + c0 + c;
      const float r = sigmoidf_(ca[o] + p.rg_ba[ch]);
      const float ii = sigmoidf_(cb2[o] + p.rg_bx[ch]);
      const float la = -8.0f * r * sp;
      const float av = __expf(la);
      const float e2 = 2.0f * la;
      const float om = (e2 > -0.1f) ? (-e2 * (1.0f + e2 * (0.5f + e2 * (0.16666667f + e2 * 0.041666668f)))) : (1.0f - __expf(e2));
      ca[o] = av;
      cb2[o] = sqrtf(om) * ii * xcf[o];
    }
  }
  __syncthreads();
  const int sg = tid >> 7, sdir = (tid >> 6) & 1, sch = tid & 63;
  const float* sa = coef + (sdir * 2) * 4096 + sch;
  const float* sb = sa + 4096;
  {
    float Pm = 1.f, H = 0.f;
#pragma unroll
    for (int n = 0; n < 16; ++n) {
      const int tok = sdir ? (63 - (16 * sg + n)) : (16 * sg + n);
      const float av = sa[tok * 64], bv = sb[tok * 64];
      H = av * H + bv;
      Pm *= av;
    }
    segagg[(sg * 2 + sdir) * 64 + sch] = make_float2(Pm, H);
  }
  __syncthreads();
  const int pos = sdir ? (seg == 0 ? 3 - sub : 67 - sub) : (seg == 0 ? sub : 4 + sub);
  float2* aggp = (float2*)p.agg + ((size_t)(b * 2 + sdir) * 68) * 256 + nblk * 64 + sch;
  if (mode == 0) {
    if (tid < 128) {
      float A = 1.f, B = 0.f;
#pragma unroll
      for (int s2 = 0; s2 < 4; ++s2) {
        const float2 g = segagg[(s2 * 2 + sdir) * 64 + sch];
        B = g.x * B + g.y;
        A *= g.x;
      }
      aggp[(size_t)pos * 256] = make_float2(A, B);
    }
    __syncthreads();
    return;
  }
  if (tid < 128) {
    float h = 0.f;
    for (int j = 0; j < pos; ++j) {
      const float2 g = aggp[(size_t)j * 256];
      h = g.x * h + g.y;
    }
    hin[sdir * 64 + sch] = h;
  }
  __syncthreads();
  {
    float h = hin[sdir * 64 + sch];
    for (int s2 = 0; s2 < sg; ++s2) {
      const float2 g = segagg[(s2 * 2 + sdir) * 64 + sch];
      h = g.x * h + g.y;
    }
#pragma unroll
    for (int n = 0; n < 16; ++n) {
      const int tok = sdir ? (63 - (16 * sg + n)) : (16 * sg + n);
      h = sa[tok * 64] * h + sb[tok * 64];
      Hout[sdir * 4096 + tok * 64 + sch] = h;
    }
  }
  __syncthreads();
  {
    const size_t gtok = (size_t)tokbase + T0 + tt;
    const float4 f0 = *(const float4*)(Hout + tt * 64 + c0), f1 = *(const float4*)(Hout + tt * 64 + c0 + 4);
    const float4 h0 = *(const float4*)(Hout + 4096 + tt * 64 + c0), h1 = *(const float4*)(Hout + 4096 + tt * 64 + c0 + 4);
    const uint4 g = *(const uint4*)(p.rg + gtok * 512 + 256 + chb);
    uint4 o;
    o.x = pk2((f0.x + h0.x) * gelu_tanh(bflo(g.x)), (f0.y + h0.y) * gelu_tanh(bfhi(g.x)));
    o.y = pk2((f0.z + h0.z) * gelu_tanh(bflo(g.y)), (f0.w + h0.w) * gelu_tanh(bfhi(g.y)));
    o.z = pk2((f1.x + h1.x) * gelu_tanh(bflo(g.z)), (f1.y + h1.y) * gelu_tanh(bfhi(g.z)));
    o.w = pk2((f1.z + h1.z) * gelu_tanh(bflo(g.w)), (f1.w + h1.w) * gelu_tanh(bfhi(g.w)));
    *(uint4*)(p.ycat + gtok * 1024 + 768 + chb) = o;
  }
  __syncthreads();
}

__device__ void attn_wave(const P& p, int l, int b, int h, bool local, int r, int half, int qtok0, const float* rpbL) {
  const int lane = opaque_tid() & 63, q = lane & 31, hh = lane >> 5;
  bf16x8 qf[4];
  {
    const u16* qp = p.qk + (size_t)(qtok0 + q) * 1024 + h * 64 + 8 * hh;
#pragma unroll
    for (int s = 0; s < 4; ++s) qf[s] = *(const bf16x8*)(qp + 16 * s);
  }
  f32x16 o0 = zero16(), o1 = zero16();
  float m_run = -1e30f, l_run = 0.f;
  const int pi = (q & 19) | ((q & 4) << 1) | ((q & 8) >> 1);
  const int w = half * 32 + q;
  const int st = min(max(w - 8, 0), 48);
  const int rs = min(max(r - 4, 0), 56);
  const int ntiles = local ? 24 : 8;
  for (int ti = 0; ti < ntiles; ++ti) {
    int ktok0, vstride, a = 0, g = 0;
    const u16* vb;
    if (ti < 8) {
      ktok0 = NLAT + b * 256 + ti * 32;
      vb = p.vTc + ((size_t)(b * 512 + h * 64)) * 256 + ti * 32;
      vstride = 256;
    } else {
      const int tl = ti - 8;
      a = tl >> 1; g = tl & 1;
      ktok0 = b * 4096 + (rs + a) * 64 + g * 32;
      vb = p.vT + ((size_t)(b * 512 + h * 64)) * 4096 + (rs + a) * 64 + g * 32;
      vstride = 4096;
    }
    bf16x8 kf[4], vf[2][2];
    {
      const u16* kp = p.qk + (size_t)(ktok0 + pi) * 1024 + 512 + h * 64 + 8 * hh;
#pragma unroll
      for (int s = 0; s < 4; ++s) kf[s] = *(const bf16x8*)(kp + 16 * s);
#pragma unroll
      for (int dt = 0; dt < 2; ++dt)
#pragma unroll
        for (int s2 = 0; s2 < 2; ++s2) vf[dt][s2] = *(const bf16x8*)(vb + (size_t)(dt * 32 + q) * vstride + 16 * s2 + 8 * hh);
    }
    f32x16 sacc = zero16();
#pragma unroll
    for (int s = 0; s < 4; ++s) sacc = mfma32(kf[s], qf[s], sacc);
    float sv[16];
    float tmax = -1e30f;
#pragma unroll
    for (int e = 0; e < 16; ++e) {
      float x = sacc[e] * 0.125f;
      if (ti >= 8) {
        const int kc = g * 32 + (e & 7) + 8 * hh + 16 * (e >> 3);
        const bool valid = (kc >= st) && (kc < st + 16);
        const int bi = valid ? ((rs + a - r + 7) * 31 + (kc - w + 15)) : 0;
        const float bias = rpbL[bi];
        x = valid ? (x + bias) : -1e30f;
      }
      sv[e] = x;
      tmax = fmaxf(tmax, x);
    }
    tmax = fmaxf(tmax, __shfl_xor(tmax, 32));
    const float m_new = fmaxf(m_run, tmax);
    const float alpha = __expf(m_run - m_new);
    m_run = m_new;
    l_run *= alpha;
#pragma unroll
    for (int e = 0; e < 16; ++e) { o0[e] *= alpha; o1[e] *= alpha; }
    float psum = 0.f;
#pragma unroll
    for (int e = 0; e < 16; ++e) { const float pe = __expf(sv[e] - m_new); sv[e] = pe; psum += pe; }
    l_run += psum;
    bf16x8 pf[2];
#pragma unroll
    for (int s2 = 0; s2 < 2; ++s2) {
      union { bf16x8 v; unsigned u[4]; } cv;
#pragma unroll
      for (int j = 0; j < 4; ++j) cv.u[j] = pk2(sv[8 * s2 + 2 * j], sv[8 * s2 + 2 * j + 1]);
      pf[s2] = cv.v;
    }
#pragma unroll
    for (int s2 = 0; s2 < 2; ++s2) {
      o0 = mfma32(vf[0][s2], pf[s2], o0);
      o1 = mfma32(vf[1][s2], pf[s2], o1);
    }
  }
  const float lt = l_run + __shfl_xor(l_run, 32);
  const float inv = 1.0f / lt;
  u16* op = p.ycat + (size_t)(qtok0 + q) * 1024 + h * 64;
#pragma unroll
  for (int qd = 0; qd < 4; ++qd) {
    uint2 a0, a1;
    a0.x = pk2(o0[4 * qd] * inv, o0[4 * qd + 1] * inv);
    a0.y = pk2(o0[4 * qd + 2] * inv, o0[4 * qd + 3] * inv);
    a1.x = pk2(o1[4 * qd] * inv, o1[4 * qd + 1] * inv);
    a1.y = pk2(o1[4 * qd + 2] * inv, o1[4 * qd + 3] * inv);
    *(uint2*)(op + 8 * qd + 4 * hh) = a0;
    *(uint2*)(op + 32 + 8 * qd + 4 * hh) = a1;
  }
}
__device__ void attn_task(const P& p, int l, int kind, int idx, char* smem) {
  const int tid_ = opaque_tid(); const int lane = tid_ & 63, wid = tid_ >> 6;
  float* rpbL = (float*)smem + wid * 480;
  for (int i = lane; i < 465; i += 64) rpbL[i] = p.na_rpb[(size_t)(l * 8 + wid) * 465 + i];
  __syncthreads();
  if (kind == 0) {
    const int half = idx & 1, r = (idx >> 1) & 63, b = idx >> 7;
    attn_wave(p, l, b, wid, true, r, half, b * 4096 + r * 64 + half * 32, rpbL);
  } else {
    const int qg = idx & 7, b = idx >> 3;
    attn_wave(p, l, b, wid, false, 0, 0, NLAT + b * 256 + qg * 32, rpbL);
  }
  __syncthreads();
}

__device__ void phase_mixers(const P& p, int l, char* smem, unsigned* counter) {
  const bool last = (l == 1);
  const int n_rg = 2176 * XRGA, n_fft = 1024 * XFFT, n_hc = last ? 0 : 256, n_att = 1024 * XATT, n_attc = last ? 0 : 64;
  const int total = n_rg + n_fft + n_hc + n_att + n_attc;
  __shared__ int s_task_v;
  volatile int* s_taskp = &s_task_v;
  for (;;) {
    __syncthreads();
    if (threadIdx.x == 0) *s_taskp = (int)atomicAdd(counter, 1u);
    __syncthreads();
    int t = *s_taskp;
    if (t >= total) break;
    if (t < n_rg) { if (t >= 2176) t -= 2176; rg_chunk_task(p, l, t >> 2, t & 3, 0, last, smem); continue; }
    t -= n_rg;
    if (t < n_fft) { t &= 1023; hyena_fft_task(p, l, t >> 2, t & 3, smem); continue; }
    t -= n_fft;
    if (t < n_hc) { hyena_ctx_task(p, l, t >> 5, t & 31, smem); continue; }
    t -= n_hc;
    if (t < n_att) { t &= 1023; attn_task(p, l, 0, t, smem); continue; }
    t -= n_att;
    attn_task(p, l, 1, t, smem);
  }
}

__device__ void merge_tile(const P& p, int l, int mt, int nt, char* smem) {
  EPI_VARS
  const int m0 = mt * 256, n0 = nt * 128;
  f32x16 macc[2][2];
  zero_acc(macc);
  for (int br = 0; br < 3; ++br) {
    unsigned* gpl = (unsigned*)(smem + 98304) + tid;
    {
      f32x16 acc[2][2];
      zero_acc(acc);
      gemm_kloop(acc, p.xn + (size_t)m0 * 1024, 1024, p.WgT + ((size_t)l * 3072 + br * 1024 + n0) * 1024, 1024, 1024, smem);
#pragma unroll
      for (int j = 0; j < 2; ++j) {
        const float bg = p.b_gate[l * 3072 + br * 1024 + n0 + EPI_COL(j)];
#pragma unroll
        for (int i = 0; i < 2; ++i)
#pragma unroll
          for (int e = 0; e < 4; ++e) {
            const unsigned q0 = (unsigned)(sigmoidf_(acc[i][j][4 * e] + bg) * 255.0f + 0.5f);
            const unsigned q1 = (unsigned)(sigmoidf_(acc[i][j][4 * e + 1] + bg) * 255.0f + 0.5f);
            const unsigned q2 = (unsigned)(sigmoidf_(acc[i][j][4 * e + 2] + bg) * 255.0f + 0.5f);
            const unsigned q3 = (unsigned)(sigmoidf_(acc[i][j][4 * e + 3] + bg) * 255.0f + 0.5f);
            gpl[((i * 2 + j) * 4 + e) * 512] = q0 | (q1 << 8) | (q2 << 16) | (q3 << 24);
          }
      }
    }
    {
      f32x16 acc[2][2];
      zero_acc(acc);
      const u16* A; const u16* B; int K;
      if (br == 0) { A = p.ycat + (size_t)m0 * 1024; B = p.WaT + ((size_t)l * 1024 + n0) * 512; K = 512; }
      else if (br == 1) { A = p.ycat + (size_t)m0 * 1024 + 512; B = p.WbT + ((size_t)l * 1024 + n0) * 256; K = 256; }
      else { A = p.ycat + (size_t)m0 * 1024 + 768; B = p.WcT + ((size_t)l * 1024 + n0) * 256; K = 256; }
      gemm_kloop(acc, A, 1024, B, K, K, smem);
#pragma unroll
      for (int i = 0; i < 2; ++i)
#pragma unroll
        for (int j = 0; j < 2; ++j)
#pragma unroll
          for (int e = 0; e < 4; ++e) {
            const unsigned g4 = gpl[((i * 2 + j) * 4 + e) * 512];
            macc[i][j][4 * e] += (float)(g4 & 255u) * (1.0f / 255.0f) * acc[i][j][4 * e];
            macc[i][j][4 * e + 1] += (float)((g4 >> 8) & 255u) * (1.0f / 255.0f) * acc[i][j][4 * e + 1];
            macc[i][j][4 * e + 2] += (float)((g4 >> 16) & 255u) * (1.0f / 255.0f) * acc[i][j][4 * e + 2];
            macc[i][j][4 * e + 3] += (float)(g4 >> 24) * (1.0f / 255.0f) * acc[i][j][4 * e + 3];
          }
    }
  }
#pragma unroll
  for (int i = 0; i < 2; ++i)
#pragma unroll
    for (int j = 0; j < 2; ++j)
#pragma unroll
      for (int e = 0; e < 16; ++e)
        p.mbuf[(size_t)(m0 + EPI_ROW(i, e)) * 1024 + n0 + EPI_COL(j)] = f2bf(macc[i][j][e]);
}
__device__ void outproj_tile(const P& p, int l, int mt, int nt, char* smem, bool do_store) {
  EPI_VARS
  const int m0 = mt * 256, n0 = nt * 128;
  f32x16 acc[2][2];
  zero_acc(acc);
  gemm_kloop(acc, p.mbuf + (size_t)m0 * 1024, 1024, p.WoT + ((size_t)l * 1024 + n0) * 1024, 1024, 1024, smem);
  const bool isctx = (mt >= 128);
  const int bi = isctx ? 8 : (mt >> 4);
  const float* gatev = p.mod + ((size_t)(l * 9 + bi) * 6 + 2) * 1024;
  const float* src; float* dst;
  if (isctx) { src = (l == 0 ? p.ctx : p.ctxs) - (size_t)NLAT * 1024; dst = p.ctxs - (size_t)NLAT * 1024; }
  else { src = (l == 0 ? p.x : p.out); dst = p.out; }
#pragma unroll
  for (int j = 0; j < 2; ++j) {
    const int col = n0 + EPI_COL(j);
    const float gv = gatev[col];
#pragma unroll
    for (int i = 0; i < 2; ++i)
#pragma unroll
      for (int e = 0; e < 16; ++e) {
        const size_t o = (size_t)(m0 + EPI_ROW(i, e)) * 1024 + col;
        if (do_store) dst[o] = src[o] + gv * acc[i][j][e];
      }
  }
}

__device__ __forceinline__ void ins16(unsigned (&L)[16], unsigned x) {
#pragma unroll
  for (int i = 0; i < 16; ++i) {
    const unsigned hi = max(L[i], x);
    x = min(L[i], x);
    L[i] = hi;
  }
}
__device__ __forceinline__ unsigned f2sort(float f) {
  const unsigned b = __float_as_uint(f);
  return b ^ ((unsigned)((int)b >> 31) | 0x80000000u);
}
__device__ __forceinline__ float sort2f(unsigned k) {
  const unsigned u = k & ~127u;
  const unsigned b = (u & 0x80000000u) ? (u ^ 0x80000000u) : ~u;
  return __uint_as_float(b);
}
__device__ void peer_score_tile(const P& p, int l, int mt, int hp, char* smem) {
  EPI_VARS
  const int m0 = mt * 256;
  f32x16 acc[2][2];
  zero_acc(acc);
  gemm_kloop(acc, p.xn + (size_t)m0 * 1024, 1024, p.WqT + ((size_t)l * 2048 + hp * 128) * 1024, 1024, 1024, smem);
  {
    const u16* kb = p.keysB + ((size_t)l * 16 + hp) * 16384;
#pragma unroll
    for (int it = 0; it < 4; ++it) {
      const int id = tid + NTHR * it;
      const int row = id >> 4, ch = id & 15;
      *(uint4*)(smem + 65536 + swz256(row, ch)) = *(const uint4*)(kb + row * 128 + ch * 8);
    }
#pragma unroll
    for (int i = 0; i < 2; ++i)
#pragma unroll
      for (int j = 0; j < 2; ++j)
#pragma unroll
        for (int e = 0; e < 16; ++e) {
          const int row = EPI_ROW(i, e), col = EPI_COL(j);
          *(u16*)(smem + swz256(row, col >> 3) + (col & 7) * 2) = f2bf(acc[i][j][e]);
        }
  }
  __syncthreads();
  zero_acc(acc);
#pragma unroll
  for (int ks = 0; ks < 8; ++ks) {
    bf16x8 af[2], bfr[2];
#pragma unroll
    for (int i = 0; i < 2; ++i) af[i] = *(const bf16x8*)(smem + swz256(wm * 64 + i * 32 + l31, 2 * ks + hh));
#pragma unroll
    for (int j = 0; j < 2; ++j) bfr[j] = *(const bf16x8*)(smem + 65536 + swz256(wn * 64 + j * 32 + l31, 2 * ks + hh));
#pragma unroll
    for (int i = 0; i < 2; ++i)
#pragma unroll
      for (int j = 0; j < 2; ++j) acc[i][j] = mfma32(af[i], bfr[j], acc[i][j]);
  }
  __syncthreads();
  float* Sf = (float*)smem;
#pragma unroll
  for (int i = 0; i < 2; ++i)
#pragma unroll
    for (int j = 0; j < 2; ++j)
#pragma unroll
      for (int e = 0; e < 16; ++e) Sf[EPI_ROW(i, e) * 130 + EPI_COL(j)] = acc[i][j][e];
  __syncthreads();
  unsigned L[16];
#pragma unroll
  for (int i = 0; i < 16; ++i) L[i] = 0u;
  const int row = tid >> 1, hf = tid & 1;
  for (int i = 0; i < 64; ++i) {
    const int key = 2 * i + hf;
    const float v = Sf[row * 130 + key];
    ins16(L, (f2sort(v) & ~127u) | (unsigned)key);
  }
  unsigned* X = (unsigned*)(smem + 133120);
  if (hf) {
#pragma unroll
    for (int i = 0; i < 16; ++i) X[row * 16 + i] = L[i];
  }
  __syncthreads();
  if (!hf) {
#pragma unroll
    for (int i = 0; i < 16; ++i) ins16(L, X[row * 16 + i]);
    unsigned* o = p.topk + ((size_t)(m0 + row) * 16 + hp) * 16;
#pragma unroll
    for (int i = 0; i < 4; ++i) *(uint4*)(o + 4 * i) = make_uint4(L[4 * i], L[4 * i + 1], L[4 * i + 2], L[4 * i + 3]);
  }
  __syncthreads();
}

__device__ void phase_peer_experts(const P& p, int l, bool do_store) {
  const int tid_ = opaque_tid(); const int lane = tid_ & 63, wid = tid_ >> 6;
  const int ntok = (l == 1) ? NLAT : NTOK;
  int ci, cj;
  {
    const int e = lane;
    if (e < 16) { ci = 0; cj = e; }
    else if (e < 24) { ci = 1; cj = e - 16; }
    else if (e < 29) { ci = 2; cj = e - 24; }
    else if (e < 33) { ci = 3; cj = e - 29; }
    else if (e < 36) { ci = 4; cj = e - 33; }
    else if (e < 38) { ci = 5; cj = e - 36; }
    else if (e < 40) { ci = 6; cj = e - 38; }
    else if (e < 42) { ci = 7; cj = e - 40; }
    else { ci = min(8 + (e - 42), 15); cj = 0; }
  }
  for (int tok = blockIdx.x * 8 + wid; tok < ntok; tok += gridDim.x * 8) {
    float xr[16];
    {
      const uint4 a = *(const uint4*)(p.xn + (size_t)tok * 1024 + lane * 16);
      const uint4 b = *(const uint4*)(p.xn + (size_t)tok * 1024 + lane * 16 + 8);
      xr[0] = bflo(a.x); xr[1] = bfhi(a.x); xr[2] = bflo(a.y); xr[3] = bfhi(a.y);
      xr[4] = bflo(a.z); xr[5] = bfhi(a.z); xr[6] = bflo(a.w); xr[7] = bfhi(a.w);
      xr[8] = bflo(b.x); xr[9] = bfhi(b.x); xr[10] = bflo(b.y); xr[11] = bfhi(b.y);
      xr[12] = bflo(b.z); xr[13] = bfhi(b.z); xr[14] = bflo(b.w); xr[15] = bfhi(b.w);
    }
    float yacc[16];
#pragma unroll
    for (int i = 0; i < 16; ++i) yacc[i] = 0.f;
    for (int h = 0; h < 8; ++h) {
      const unsigned kv = p.topk[((size_t)tok * 16 + 2 * h) * 16 + (lane & 31)];
      const unsigned k0 = __shfl(kv, ci);
      const unsigned k1 = __shfl(kv, 16 + cj);
      const float val = (lane < 50) ? (sort2f(k0) + sort2f(k1)) : -3.0e38f;
      const int eidx = (int)((k0 & 127u) * 128u + (k1 & 127u));
      int cnt = 0;
      for (int e2 = 0; e2 < 50; ++e2) {
        const float v2 = __shfl(val, e2);
        cnt += (v2 > val || (v2 == val && e2 < lane)) ? 1 : 0;
      }
      const bool sel = (lane < 50) && (cnt < 16);
      const float mx = wave_max(sel ? val : -3.0e38f);
      const float ex = sel ? __expf(val - mx) : 0.f;
      const float sm = wave_sum(ex);
      const float gsel = ex / sm;
      unsigned long long mask = __ballot(sel);
      for (int it = 0; it < 2; ++it) {
        int ln[8];
#pragma unroll
        for (int k = 0; k < 8; ++k) {
          ln[k] = mask ? (__ffsll((long long)mask) - 1) : 0;
          mask &= mask - 1;
        }
        uint4 ur[8], vr[8];
        float gk[8];
#pragma unroll
        for (int k = 0; k < 8; ++k) {
          const int id = __shfl(eidx, ln[k]);
          gk[k] = __shfl(gsel, ln[k]);
          ur[k] = *(const uint4*)(p.Ub + (size_t)id * 1024 + lane * 16);
          vr[k] = *(const uint4*)(p.Vb + (size_t)id * 1024 + lane * 16);
        }
#pragma unroll
        for (int k = 0; k < 8; ++k) {
          float d = 0.f;
          {
            const unsigned uw[4] = {ur[k].x, ur[k].y, ur[k].z, ur[k].w};
#pragma unroll
            for (int q4 = 0; q4 < 4; ++q4) {
              const f32x2 lo = __builtin_amdgcn_cvt_pk_f32_fp8((int)uw[q4], false);
              const f32x2 hi = __builtin_amdgcn_cvt_pk_f32_fp8((int)uw[q4], true);
              d += xr[4 * q4] * lo.x + xr[4 * q4 + 1] * lo.y + xr[4 * q4 + 2] * hi.x + xr[4 * q4 + 3] * hi.y;
            }
          }
          d = wave_sum(d) * (1.0f / 64.0f);
          const float act = gelu_tanh(d) * gk[k];
          {
            const unsigned vw[4] = {vr[k].x, vr[k].y, vr[k].z, vr[k].w};
#pragma unroll
            for (int q4 = 0; q4 < 4; ++q4) {
              const f32x2 lo = __builtin_amdgcn_cvt_pk_f32_fp8((int)vw[q4], false);
              const f32x2 hi = __builtin_amdgcn_cvt_pk_f32_fp8((int)vw[q4], true);
              yacc[4 * q4] += act * lo.x; yacc[4 * q4 + 1] += act * lo.y;
              yacc[4 * q4 + 2] += act * hi.x; yacc[4 * q4 + 3] += act * hi.y;
            }
          }
        }
      }
    }
    const int bi = tok < NLAT ? (tok >> 12) : 8;
    const float* gv = p.mod + ((size_t)(l * 9 + bi) * 6 + 5) * 1024 + lane * 16;
    float* xp = (tok < NLAT) ? (p.out + (size_t)tok * 1024) : (p.ctxs + (size_t)(tok - NLAT) * 1024);
    xp += lane * 16;
#pragma unroll
    for (int i = 0; i < 4; ++i) {
      float4 xv = *(float4*)(xp + 4 * i);
      const float4 g4 = *(const float4*)(gv + 4 * i);
      xv.x += g4.x * yacc[4 * i] * 0.0625f; xv.y += g4.y * yacc[4 * i + 1] * 0.0625f; xv.z += g4.z * yacc[4 * i + 2] * 0.0625f; xv.w += g4.w * yacc[4 * i + 3] * 0.0625f;
      if (do_store) *(float4*)(xp + 4 * i) = xv;
    }
  }
}


#define XB_TMO      128
#define XB_XCNT(j)  (256  + 64 * (j))
#define XB_XSUB(j)  (1280 + 64 * (j))
#define XB_XGEN(j)  (2304 + 64 * (j))
#define XB_TOP      3328
#define XB_TOPGEN   3392
#define XCD_BAR_WORDS 3456
#define XB_SPIN_CAP (1u << 22)
#define LAS __attribute__((address_space(3)))
__device__ __forceinline__ unsigned xb_ld(unsigned* p) { return __hip_atomic_load(p, __ATOMIC_RELAXED, __HIP_MEMORY_SCOPE_AGENT); }
__device__ __forceinline__ unsigned xb_add(unsigned* p, unsigned v) { return __hip_atomic_fetch_add(p, v, __ATOMIC_RELAXED, __HIP_MEMORY_SCOPE_AGENT); }
__device__ __forceinline__ unsigned xb_xcc_id() { return (unsigned)__builtin_amdgcn_s_getreg((3 << 11) | 20) & 0xFu; }
#define XB_SPIN(cond, bar) do { unsigned _sp = 0; while (cond) { __builtin_amdgcn_s_sleep(1); \
    if ((++_sp & 255u) == 0u) { if (xb_ld(&(bar)[XB_TMO])) break; if (_sp > XB_SPIN_CAP) { atomicAdd(&(bar)[XB_TMO], 1u); break; } } } } while (0)
struct XcdBarrier { unsigned* bar; unsigned x; volatile LAS unsigned* st; };
__device__ __forceinline__ XcdBarrier xcd_barrier_post(unsigned* bar, volatile LAS unsigned* st) {
  XcdBarrier b; b.bar = bar; b.x = xb_xcc_id(); b.st = st;
  if (threadIdx.x == 0) (void)xb_add(&bar[XB_XCNT(b.x)], 1u);
  return b;
}
__device__ __forceinline__ void xcd_barrier_complete(unsigned* bar, unsigned x, unsigned& nloc, unsigned& nx) {
  const unsigned G = gridDim.x * gridDim.y * gridDim.z;
  unsigned sum, cnt, mine, sp = 0u;
  for (;;) {
    sum = 0u; cnt = 0u; mine = 0u;
#pragma unroll
    for (unsigned j = 0; j < 16; ++j) { const unsigned c = xb_ld(&bar[XB_XCNT(j)]); sum += c; cnt += (c > 0u) ? 1u : 0u; mine = (j == x) ? c : mine; }
    if (sum == G) break;
    __builtin_amdgcn_s_sleep(1);
    if ((++sp & 255u) == 0u) { if (xb_ld(&bar[XB_TMO])) break; if (sp > XB_SPIN_CAP) { atomicAdd(&bar[XB_TMO], 1u); break; } }
  }
  nloc = mine > 0u ? mine : 1u; nx = cnt > 0u ? cnt : 1u;
}
__device__ __forceinline__ void xcd_barrier(const XcdBarrier& b) {
  asm volatile("s_waitcnt vmcnt(0)" ::: "memory");
  __syncthreads();
  if (threadIdx.x == 0) {
    unsigned* bar = b.bar;
    __builtin_amdgcn_s_waitcnt(0);
    unsigned nloc = b.st[0], nx = b.st[1];
    if (nloc == 0u) { xcd_barrier_complete(bar, b.x, nloc, nx); b.st[0] = nloc; b.st[1] = nx; }
    const unsigned old = xb_add(&bar[XB_XSUB(b.x)], 1u);
    const unsigned gen = old / nloc;
    if (old + 1u == (gen + 1u) * nloc) {
      __builtin_amdgcn_fence(__ATOMIC_RELEASE, "agent");
      asm volatile("s_waitcnt vmcnt(0)" ::: "memory");
      const unsigned og = xb_add(&bar[XB_TOP], 1u);
      const unsigned tg = og / nx;
      if (og + 1u == (tg + 1u) * nx) xb_add(&bar[XB_TOPGEN], 1u);
      else XB_SPIN(xb_ld(&bar[XB_TOPGEN]) == tg, bar);
      __builtin_amdgcn_fence(__ATOMIC_ACQUIRE, "agent");
      xb_add(&bar[XB_XGEN(b.x)], 1u);
      asm volatile("s_waitcnt vmcnt(0)" ::: "memory");
    } else {
      XB_SPIN(xb_ld(&bar[XB_XGEN(b.x)]) == gen, bar);
      __builtin_amdgcn_fence(__ATOMIC_ACQUIRE, "agent");
      asm volatile("s_waitcnt vmcnt(0)" ::: "memory");
    }
  }
  __syncthreads();
}

__global__ void __launch_bounds__(NTHR) fwd_megakernel(P p) {
  __shared__ __attribute__((aligned(16))) char smem[SMEM_BYTES];
  cg::grid_group grid = cg::this_grid();
  __shared__ uint4 xb_words;
  if (threadIdx.x == 0) xb_words = make_uint4(0u, 0u, 0u, 0u);
  __syncthreads();
  XcdBarrier xb = xcd_barrier_post(p.counters + 1024, (volatile LAS unsigned*)&xb_words);
  const int nb = gridDim.x, bid = blockIdx.x;

  for (int rep = 0; rep < DUP_PREP; ++rep) phase_prep(p, smem);
  grid.sync();
  phase_modreduce(p);
  xcd_barrier(xb);

  const bool never = (p.counters[512] == 0x12345u);
  for (int l = 0; l < 2; ++l) {
    const bool last = (l == 1);
    const int n_mt = last ? 128 : 136;
    for (int rep = 0; rep < DUP_1A; ++rep) {
      phase_filters(p, l);
      phase_norm(p, l, 0);
    }
    xcd_barrier(xb);
    for (int rep = 0; rep < DUP_GEMM; ++rep) {
      const int total = 256 + 136 * 22;
      for (int task = bid; task < total; task += nb) {
        if (task < 256) kf_task(p, task, smem);
        else { const int t = task - 256; inproj_tile(p, l, t / 22, t % 22, smem); }
      }
    }
    xcd_barrier(xb);
    for (int rep = 0; rep < DUP_MIX; ++rep) {
      phase_mixers(p, l, smem, p.counters + l * 4 + rep);
    }
    xcd_barrier(xb);
    for (int rep = 0; rep < DUP_2B; ++rep)
      for (int task = bid; task < 2176; task += nb) rg_chunk_task(p, l, task >> 2, task & 3, 1, last, smem);
    xcd_barrier(xb);
    for (int rep = 0; rep < DUP_GEMM; ++rep)
      for (int task = bid; task < n_mt * 8; task += nb) merge_tile(p, l, task >> 3, task & 7, smem);
    xcd_barrier(xb);
    for (int rep = 0; rep < DUP_GEMM; ++rep) {
      const int ng = n_mt * 8;
      const int total = ng + 8192;
      const bool st = (rep == DUP_GEMM - 1) || never;
      for (int task = bid; task < total; task += nb) {
        if (task < ng) outproj_tile(p, l, task >> 3, task & 7, smem, st);
        else {
          const int t = task - ng;
          if (t < 4096) cvt_chunk_fp8(p.peer_u + (size_t)l * 16384 * 1024, p.Ub, (size_t)t, 64.0f);
          else cvt_chunk_fp8(p.peer_v + (size_t)l * 16384 * 1024, p.Vb, (size_t)(t - 4096), 16.0f);
        }
      }
    }
    xcd_barrier(xb);
    phase_norm(p, l, 1);
    xcd_barrier(xb);
    for (int rep = 0; rep < DUP_GEMM; ++rep)
      for (int task = bid; task < n_mt * 16; task += nb) peer_score_tile(p, l, task >> 4, task & 15, smem);
    xcd_barrier(xb);
    for (int rep = 0; rep < DUP_PEER; ++rep) phase_peer_experts(p, l, (rep == DUP_PEER - 1) || never);
    xcd_barrier(xb);
  }
  phase_norm(p, 1, 2);
}

extern "C" void kernel_launch(void* const* d_in, const int* in_sizes, int n_in, void* d_out, int out_size, void* d_ws,
                              size_t ws_size, hipStream_t stream) {
  P p;
  memset(&p, 0, sizeof(p));
  const float** ins = (const float**)&p;
  for (int i = 0; i < 37; ++i) ins[i] = (const float*)d_in[i];
  p.out = (float*)d_out;
  char* w = (char*)d_ws;
  size_t off = 0;
  auto take = [&](size_t bytes) { char* r = w + off; off += (bytes + 255) & ~(size_t)255; return r; };
  p.counters = (unsigned*)take(32768);
  p.WinT = (u16*)take((size_t)2 * 2816 * 1024 * 2);
  p.WgT = (u16*)take((size_t)2 * 3072 * 1024 * 2);
  p.WaT = (u16*)take((size_t)2 * 1024 * 512 * 2);
  p.WbT = (u16*)take((size_t)2 * 1024 * 256 * 2);
  p.WcT = (u16*)take((size_t)2 * 1024 * 256 * 2);
  p.WoT = (u16*)take((size_t)2 * 1024 * 1024 * 2);
  p.WqT = (u16*)take((size_t)2 * 2048 * 1024 * 2);
  p.keysB = (u16*)take((size_t)2 * 16 * 16384 * 2);
  p.rgW = (u16*)take((size_t)2 * 16 * 4096 * 2);
  p.modpart = (float*)take((size_t)16 * 2 * 9 * 6144 * 4);
  p.mod = (float*)take((size_t)2 * 9 * 6144 * 4);
  p.hT = (float*)take((size_t)512 * 4096 * 4);
  p.hc = (float*)take((size_t)512 * 256 * 4);
  p.Kf = (float*)take((size_t)256 * 8192 * 8);
  p.xn = (u16*)take((size_t)NTOK * 1024 * 2);
  p.qk = (u16*)take((size_t)NTOK * 1024 * 2);
  p.mbuf = p.qk;
  p.vT = (u16*)take((size_t)8 * 512 * 4096 * 2);
  p.vTc = (u16*)take((size_t)8 * 512 * 256 * 2);
  p.hyT = (u16*)take((size_t)8 * 768 * 4096 * 2);
  p.topk = (unsigned*)p.hyT;
  p.hyTc = (u16*)take((size_t)8 * 768 * 256 * 2);
  p.rg = (u16*)take((size_t)NTOK * 512 * 2);
  p.ycat = (u16*)take((size_t)NTOK * 1024 * 2);
  p.Ub = (unsigned char*)p.ycat;
  p.Vb = p.Ub + (size_t)16384 * 1024;
  p.agg = (float*)take((size_t)8 * 2 * 68 * 256 * 8);
  p.ctxs = (float*)take((size_t)2048 * 1024 * 4);
  if (off > ws_size) {
    fprintf(stderr, "workspace too small: need %zu have %zu\n", off, ws_size);
    return;
  }
  static int grid_blocks = 0;
  if (!grid_blocks) {
    int dev = 0, cus = 0, per_cu = 0;
    (void)hipGetDevice(&dev);
    (void)hipDeviceGetAttribute(&cus, hipDeviceAttributeMultiprocessorCount, dev);
    (void)hipOccupancyMaxActiveBlocksPerMultiprocessor(&per_cu, fwd_megakernel, NTHR, 0);
    if (per_cu > 1) per_cu = 1;
    grid_blocks = cus * per_cu;
  }
  (void)hipMemsetAsync(p.counters, 0, 32768, stream);
  void* args[] = {&p};
  hipError_t e = hipLaunchCooperativeKernel((void*)fwd_megakernel, dim3(grid_blocks), dim3(NTHR), args, 0, stream);
  if (e != hipSuccess) fprintf(stderr, "cooperative launch failed: %s (grid %d)\n", hipGetErrorString(e), grid_blocks);
}
```

```cpp
#include <hip/hip_runtime.h>
#include <hip/hip_cooperative_groups.h>
#include <cstdio>
#include <cstring>
namespace cg = cooperative_groups;

typedef unsigned short u16;
typedef __attribute__((ext_vector_type(8))) short bf16x8;
typedef __attribute__((ext_vector_type(16))) float f32x16;
typedef __attribute__((ext_vector_type(2))) float f32x2;

#define NLAT 32768
#define NTOK 34816
#define SMEM_BYTES 151552
#define NTHR 512
#ifndef DUP_1A
#define DUP_1A 1
#endif
#ifndef DUP_PREP
#define DUP_PREP 1
#endif
#ifndef DUP_2B
#define DUP_2B 1
#endif
#ifndef XRGA
#define XRGA 1
#endif
#ifndef DUP_GEMM
#define DUP_GEMM 1
#endif
#ifndef DUP_PEER
#define DUP_PEER 1
#endif
#ifndef DUP_MIX
#define DUP_MIX 1
#endif
#ifndef XRG
#define XRG 1
#endif
#ifndef XFFT
#define XFFT 1
#endif
#ifndef XATT
#define XATT 1
#endif

struct P {
  const float *x, *c, *ctx, *c_ctx, *norm_mix_g, *norm_ffn_g, *w_ada, *b_ada, *w_in, *na_rpb,
      *hy_short_w, *hy_short_b, *hy_f1_w, *hy_f1_b, *hy_f2_w, *hy_f2_b, *hy_f3_w, *hy_freq, *hy_bias,
      *rg_conv_w, *rg_conv_b, *rg_wa, *rg_ba, *rg_wx, *rg_bx, *rg_lambda,
      *w_gate, *b_gate, *w_br_a, *w_br_b, *w_br_c, *w_out, *peer_wq, *peer_keys, *peer_u, *peer_v, *final_g;
  float* out;
  unsigned* counters;
  u16 *WinT, *WgT, *WaT, *WbT, *WcT, *WoT, *WqT, *keysB, *rgW;
  float *modpart, *mod, *hT, *hc;
  float* Kf;
  u16 *xn, *qk, *vT, *vTc, *hyT, *hyTc, *rg, *ycat, *mbuf;
  unsigned char *Ub, *Vb, *g8;
  u16* q;
  float *agg, *ctxs;
  unsigned* topk;
};

__device__ __forceinline__ u16 f2bf(float f) {
  unsigned u = __float_as_uint(f);
  u += 0x7fffu + ((u >> 16) & 1u);
  return (u16)(u >> 16);
}
__device__ __forceinline__ float bf2f(u16 h) { return __uint_as_float(((unsigned)h) << 16); }
__device__ __forceinline__ unsigned pk2(float a, float b) { return (unsigned)f2bf(a) | ((unsigned)f2bf(b) << 16); }
__device__ __forceinline__ float bflo(unsigned u) { return __uint_as_float(u << 16); }
__device__ __forceinline__ float bfhi(unsigned u) { return __uint_as_float(u & 0xffff0000u); }
__device__ __forceinline__ int opaque_tid() {
  int t = threadIdx.x;
  asm volatile("" : "+v"(t));
  return t;
}
__device__ __forceinline__ float wave_sum(float v) {
#pragma unroll
  for (int o = 32; o > 0; o >>= 1) v += __shfl_xor(v, o);
  return v;
}
__device__ __forceinline__ float wave_max(float v) {
#pragma unroll
  for (int o = 32; o > 0; o >>= 1) v = fmaxf(v, __shfl_xor(v, o));
  return v;
}
__device__ __forceinline__ float sigmoidf_(float x) { return __builtin_amdgcn_rcpf(1.0f + __expf(-x)); }
__device__ __forceinline__ float gelu_tanh(float x) {
  const float u2 = 1.5957691216057308f * (x + 0.044715f * x * x * x);
  return x * __builtin_amdgcn_rcpf(1.0f + __expf(-u2));
}
__device__ __forceinline__ f32x16 mfma32(bf16x8 a, bf16x8 b, f32x16 c) {
  return __builtin_amdgcn_mfma_f32_32x32x16_bf16(a, b, c, 0, 0, 0);
}
__device__ __forceinline__ f32x16 zero16() {
  f32x16 z;
#pragma unroll
  for (int i = 0; i < 16; ++i) z[i] = 0.f;
  return z;
}
__device__ __forceinline__ int swz128(int row, int ch) { return row * 128 + ((ch ^ ((row >> 1) & 7)) << 4); }
__device__ __forceinline__ int swz256(int row, int ch) { return row * 256 + ((ch ^ (row & 15)) << 4); }

struct c2 { float x, y; };
__device__ __forceinline__ c2 cadd(c2 a, c2 b) { return {a.x + b.x, a.y + b.y}; }
__device__ __forceinline__ c2 csub(c2 a, c2 b) { return {a.x - b.x, a.y - b.y}; }
__device__ __forceinline__ c2 cmul(c2 a, c2 b) { return {a.x * b.x - a.y * b.y, a.x * b.y + a.y * b.x}; }
__device__ __forceinline__ float c16(int i) {
  const float tb[16] = {1.0f, 0.9238795325112867f, 0.7071067811865476f, 0.3826834323650898f, 0.0f,
                        -0.3826834323650898f, -0.7071067811865476f, -0.9238795325112867f, -1.0f,
                        -0.9238795325112867f, -0.7071067811865476f, -0.3826834323650898f, 0.0f,
                        0.3826834323650898f, 0.7071067811865476f, 0.9238795325112867f};
  return tb[i & 15];
}
__device__ __forceinline__ float s16(int i) { return c16(i + 12); }
template <int R> __device__ __forceinline__ constexpr int brev(int k) {
  int r = 0;
  for (int b = 1, o = R >> 1; b < R; b <<= 1, o >>= 1)
    if (k & b) r |= o;
  return r;
}
template <int R> __device__ __forceinline__ void dft_reg(c2* v, float sgn) {
#pragma unroll
  for (int h = R / 2; h >= 1; h >>= 1) {
#pragma unroll
    for (int g = 0; g < R; g += 2 * h) {
#pragma unroll
      for (int j = 0; j < h; ++j) {
        c2 a = v[g + j], b = v[g + j + h];
        v[g + j] = cadd(a, b);
        c2 d = csub(a, b);
        const int ti = j * (16 / (2 * h));
        c2 w = {c16(ti), sgn * s16(ti)};
        v[g + j + h] = (j == 0) ? d : cmul(d, w);
      }
    }
  }
}
template <int R> __device__ __forceinline__ int fft_bfly(c2* v, int j, int Ns, float sgn) {
  const int k = j & (Ns - 1);
  const float f = sgn * (float)k / (float)(Ns * R);
#pragma unroll
  for (int r = 1; r < R; ++r) {
    float t = f * (float)r;
    c2 w = {__builtin_amdgcn_cosf(t), __builtin_amdgcn_sinf(t)};
    v[r] = cmul(v[r], w);
  }
  dft_reg<R>(v, sgn);
  return (j - k) * R + k;
}
template <int R> __device__ __forceinline__ void fft_pass(c2* buf, int Ns, float sgn) {
  constexpr int NBF = 8192 / R;
  constexpr int PER = NBF / NTHR;
  const int tid = opaque_tid();
  c2 v[PER][R];
#pragma unroll
  for (int i = 0; i < PER; ++i) {
    const int j = tid + NTHR * i;
#pragma unroll
    for (int r = 0; r < R; ++r) v[i][r] = buf[j + r * NBF];
  }
  __syncthreads();
#pragma unroll
  for (int i = 0; i < PER; ++i) {
    const int j = tid + NTHR * i;
    const int base = fft_bfly<R>(v[i], j, Ns, sgn);
#pragma unroll
    for (int r = 0; r < R; ++r) buf[base + r * Ns] = v[i][brev<R>(r)];
  }
  __syncthreads();
}
__device__ __forceinline__ void fft8192(c2* buf, float sgn) {
  fft_pass<8>(buf, 1, sgn);
  fft_pass<8>(buf, 8, sgn);
  fft_pass<8>(buf, 64, sgn);
  fft_pass<16>(buf, 512, sgn);
}

__device__ __forceinline__ void gemm_kloop(f32x16 (&acc)[2][2], const u16* __restrict__ A, int lda,
                                           const u16* __restrict__ B, int ldb, int K, char* smem) {
  const int tid = opaque_tid(), lane = tid & 63, wid = tid >> 6;
  const int wm = wid >> 1, wn = wid & 1;
  const int l31 = lane & 31, hh = lane >> 5;
  uint4 ra[4], rb[2];
  const int nk = K >> 6;
  const int srow = tid >> 3, sch = tid & 7;
  const char* Ab = (const char*)A;
  const char* Bb = (const char*)B;
  const unsigned aoff = (unsigned)(srow * lda + sch * 8) * 2u;
  const unsigned boff = (unsigned)(srow * ldb + sch * 8) * 2u;
  const unsigned astep = (unsigned)lda * 128u, bstep = (unsigned)ldb * 128u;
#pragma unroll
  for (int i = 0; i < 4; ++i) ra[i] = *(const uint4*)(Ab + (aoff + i * astep));
#pragma unroll
  for (int i = 0; i < 2; ++i) rb[i] = *(const uint4*)(Bb + (boff + i * bstep));
#pragma unroll
  for (int i = 0; i < 4; ++i) *(uint4*)(smem + swz128(srow + i * 64, sch)) = ra[i];
#pragma unroll
  for (int i = 0; i < 2; ++i) *(uint4*)(smem + 65536 + swz128(srow + i * 64, sch)) = rb[i];
  __syncthreads();
  for (int kt = 0; kt < nk; ++kt) {
    const bool more = (kt + 1 < nk);
    if (more) {
      const unsigned ko = (unsigned)(kt + 1) * 128u;
#pragma unroll
      for (int i = 0; i < 4; ++i) ra[i] = *(const uint4*)(Ab + (aoff + i * astep + ko));
#pragma unroll
      for (int i = 0; i < 2; ++i) rb[i] = *(const uint4*)(Bb + (boff + i * bstep + ko));
    }
    const char* as = smem + (kt & 1) * 32768;
    const char* bs = smem + 65536 + (kt & 1) * 16384;
    int lrow = l31;
    asm volatile("" : "+v"(lrow));
#pragma unroll
    for (int s = 0; s < 4; ++s) {
      bf16x8 af[2], bfr[2];
#pragma unroll
      for (int i = 0; i < 2; ++i) af[i] = *(const bf16x8*)(as + swz128(wm * 64 + i * 32 + lrow, s * 2 + hh));
#pragma unroll
      for (int j = 0; j < 2; ++j) bfr[j] = *(const bf16x8*)(bs + swz128(wn * 64 + j * 32 + lrow, s * 2 + hh));
#pragma unroll
      for (int i = 0; i < 2; ++i)
#pragma unroll
        for (int j = 0; j < 2; ++j) acc[i][j] = mfma32(af[i], bfr[j], acc[i][j]);
    }
    if (more) {
      char* an = smem + ((kt + 1) & 1) * 32768;
      char* bn = smem + 65536 + ((kt + 1) & 1) * 16384;
      int sr2 = srow;
      asm volatile("" : "+v"(sr2));
#pragma unroll
      for (int i = 0; i < 4; ++i) *(uint4*)(an + swz128(sr2 + i * 64, sch)) = ra[i];
#pragma unroll
      for (int i = 0; i < 2; ++i) *(uint4*)(bn + swz128(sr2 + i * 64, sch)) = rb[i];
    }
    __syncthreads();
  }
}
__device__ __forceinline__ void zero_acc(f32x16 (&acc)[2][2]) {
#pragma unroll
  for (int i = 0; i < 2; ++i)
#pragma unroll
    for (int j = 0; j < 2; ++j) acc[i][j] = zero16();
}
#define EPI_ROW(i, e) (wm * 64 + (i)*32 + ((e)&3) + 8 * ((e) >> 2) + 4 * hh)
#define EPI_COL(j) (wn * 64 + (j)*32 + l31)
#define EPI_VARS                                                    \
  const int tid = opaque_tid(), lane = tid & 63, wid = tid >> 6;     \
  const int wm = wid >> 1, wn = wid & 1, l31 = lane & 31, hh = lane >> 5; \
  (void)tid; (void)wm; (void)wn; (void)l31; (void)hh;


namespace pg8 {
#define PG8_LAS __attribute__((address_space(3)))
typedef PG8_LAS unsigned char* PG8_LAS_T;
typedef float f32x4 __attribute__((ext_vector_type(4)));
typedef unsigned u32x4 __attribute__((ext_vector_type(4)));
constexpr int BM = 256, BK = 64, HALF = 128, HTB = HALF * BK * 2, STAGE_BYTES = 8 * HTB, NXCD = 8, WGM = 8;
__device__ __forceinline__ int lds_byte(int r, int c) { const int st = (r >> 4) * 2 + (c >> 5), rr = r & 15, cc = c & 31, ob = rr * 64 + cc * 2; return st * 1024 + (ob ^ (((ob >> 9) & 1) << 5)); }
__device__ __forceinline__ void stage_rc(int b, int& R, int& C) { const int st = b / 1024, sb = b % 1024, swz = sb ^ (((sb >> 9) & 1) << 5); R = (st >> 1) * 16 + swz / 64; C = (st & 1) * 32 + (swz % 64) / 2; }
__device__ __forceinline__ int perm32(int rho) { const int n = rho >> 4, i = rho & 15; return 8 * (i >> 2) + 4 * n + (i & 3); }
struct Unit { int pm, pn; };
struct Gemm { const u16* A; const u16* Bt; int lda, ldb, K; };
struct Order {
  int nM, nN, nwg, G, c, skip_from, skip_by;
  __device__ __forceinline__ void init(int nM_, int nN_, int G_, int c_, int sf = 1 << 30, int sb = 0) { nM = nM_; nN = nN_; nwg = nM * nN; G = G_; c = c_; skip_from = sf; skip_by = sb; }
  __device__ __forceinline__ bool next(int i, Unit& u) const {
    const long L = (long)i * G + c; if (L >= nwg) return false;
    int wgid = (int)L; { const int q = nwg / NXCD, r = nwg % NXCD, xcd = wgid % NXCD, off = wgid / NXCD; wgid = (xcd < r ? xcd * (q + 1) : r * (q + 1) + (xcd - r) * q) + off; }
    const int nig = WGM * nN, gid = wgid / nig, fm = gid * WGM, gsz = (nM - fm) < WGM ? (nM - fm) : WGM;
    u.pm = fm + ((wgid % nig) % gsz); u.pn = (wgid % nig) / gsz;
    if (u.pn >= skip_from) u.pn += skip_by;
    return true;
  }
};
template <class Epi>
__device__ __forceinline__ void gemm_phase(PG8_LAS unsigned char* lds, const Gemm g, const Order& S, const Epi& E) {
  const int tid = opaque_tid(), wid = __builtin_amdgcn_readfirstlane(tid >> 6), lane = tid & 63, wr = wid >> 2, wc = wid & 3, fr = lane & 15, fq = lane >> 4;
  const int K = g.K, nt = K / BK;
  unsigned voffA[2], voffB[2];
#pragma unroll
  for (int i = 0; i < 2; ++i) { int R, C; stage_rc(tid * 16 + i * 8192, R, C); const int Rb = Epi::PERM ? ((R & ~31) + perm32(R & 31)) : R;
    voffA[i] = (unsigned)(R * g.lda + C) * 2u; voffB[i] = (unsigned)(Rb * g.ldb + C) * 2u; }
  const size_t kstep = (size_t)(BK * 2);
  const size_t hstepA = (size_t)HALF * g.lda * 2, hstepB = (size_t)HALF * g.ldb * 2;
  const size_t tstepA = 2 * hstepA, tstepB = 2 * hstepB;
  const unsigned ldsw = (unsigned)wid * 1024u;
  const int aoff = lds_byte(wr * 64 + fr, fq * 8), boff = lds_byte(wc * 32 + fr, fq * 8);
#define PG8_SA(b, h) (((b) * 2 + (h)) * HTB)
#define PG8_SB(b, h) ((4 + (b) * 2 + (h)) * HTB)
#define PG8_STAGE(bufoff, gbase, voff) do { _Pragma("unroll") for (int _i = 0; _i < 2; ++_i) \
    __builtin_amdgcn_global_load_lds((const unsigned*)((const char*)(gbase) + (voff)[_i]), (PG8_LAS unsigned*)(lds + (bufoff) + ldsw + _i * 8192), 16, 0, 0); } while (0)
#define PG8_LDA(dst, b, h) do { _Pragma("unroll") for (int m = 0; m < 4; ++m) _Pragma("unroll") for (int k = 0; k < 2; ++k) dst[m][k] = *(const PG8_LAS bf16x8*)(lds + PG8_SA(b, h) + aoff + m * 2048 + k * 1024); } while (0)
#define PG8_LDB(dst, b, h) do { _Pragma("unroll") for (int n = 0; n < 2; ++n) _Pragma("unroll") for (int k = 0; k < 2; ++k) dst[n][k] = *(const PG8_LAS bf16x8*)(lds + PG8_SB(b, h) + boff + n * 2048 + k * 1024); } while (0)
#define PG8_MMA(ai, bj, At, Bt) do { __builtin_amdgcn_s_setprio(1); _Pragma("unroll") for (int m = 0; m < 4; ++m) _Pragma("unroll") for (int n = 0; n < 2; ++n) _Pragma("unroll") for (int k = 0; k < 2; ++k) \
    acc[ai][bj][m][n] = __builtin_amdgcn_mfma_f32_16x16x32_bf16(Bt[n][k], At[m][k], acc[ai][bj][m][n], 0, 0, 0); __builtin_amdgcn_s_setprio(0); } while (0)
#define PG8_WAIT_V(n) asm volatile("s_waitcnt vmcnt(" #n ")" ::: "memory")
#define PG8_WAIT_L(n) asm volatile("s_waitcnt lgkmcnt(" #n ")" ::: "memory")
#define PG8_BAR __builtin_amdgcn_s_barrier()
#define PG8_SCHED __builtin_amdgcn_sched_barrier(0)
  Unit cur, nxt; int ui = 0;
  if (!S.next(0, cur)) return;
  f32x4 acc[2][2][4][2];
#pragma unroll
  for (int a = 0; a < 2; ++a)
#pragma unroll
    for (int b = 0; b < 2; ++b)
#pragma unroll
      for (int m = 0; m < 4; ++m)
#pragma unroll
        for (int n = 0; n < 2; ++n) acc[a][b][m][n] = (f32x4){0.f, 0.f, 0.f, 0.f};
  bf16x8 At[4][2], B0[2][2], B1[2][2];
  const char* cA = (const char*)g.A + (size_t)cur.pm * tstepA; const char* cB = (const char*)g.Bt + (size_t)cur.pn * tstepB;
  PG8_STAGE(PG8_SB(0, 0), cB, voffB); PG8_STAGE(PG8_SA(0, 0), cA, voffA); PG8_STAGE(PG8_SB(0, 1), cB + hstepB, voffB); PG8_STAGE(PG8_SA(0, 1), cA + hstepA, voffA);
  if (wr == 1) PG8_BAR;
  PG8_WAIT_V(4); PG8_BAR;
  PG8_STAGE(PG8_SB(1, 0), cB + kstep, voffB); PG8_STAGE(PG8_SA(1, 0), cA + kstep, voffA); PG8_STAGE(PG8_SB(1, 1), cB + hstepB + kstep, voffB);
  PG8_WAIT_V(6); PG8_BAR;
  for (;;) {
    const bool has_next = S.next(ui + 1, nxt);
    const char* nA = has_next ? (const char*)g.A + (size_t)nxt.pm * tstepA : cA; const char* nB = has_next ? (const char*)g.Bt + (size_t)nxt.pn * tstepB : cB;
    for (int t = 0; t < nt; t += 2) {
      const bool last = (t == nt - 2);
      const char* a1 = cA + (size_t)(t + 1) * kstep;
      const char* a2 = last ? nA : cA + (size_t)(t + 2) * kstep; const char* b2 = last ? nB : cB + (size_t)(t + 2) * kstep;
      const char* a3 = a2 + kstep; const char* b3 = b2 + kstep;
      PG8_LDB(B0, 0, 0); PG8_SCHED; PG8_LDA(At, 0, 0); PG8_STAGE(PG8_SA(1, 1), a1 + hstepA, voffA);
      PG8_WAIT_L(8); PG8_BAR; PG8_WAIT_L(0); PG8_MMA(0, 0, At, B0); PG8_BAR; PG8_SCHED;
      PG8_LDB(B1, 0, 1); PG8_STAGE(PG8_SB(0, 0), b2, voffB);
      PG8_BAR; PG8_WAIT_L(0); PG8_MMA(0, 1, At, B1); PG8_BAR;
      PG8_LDA(At, 0, 1); PG8_STAGE(PG8_SA(0, 0), a2, voffA);
      PG8_BAR; PG8_WAIT_L(0); PG8_MMA(1, 0, At, B0); PG8_BAR; PG8_SCHED;
      PG8_STAGE(PG8_SB(0, 1), b2 + hstepB, voffB);
      PG8_WAIT_V(6); PG8_BAR; PG8_MMA(1, 1, At, B1); PG8_BAR;
      PG8_LDB(B0, 1, 0); PG8_SCHED; PG8_LDA(At, 1, 0); PG8_STAGE(PG8_SA(0, 1), a2 + hstepA, voffA);
      PG8_WAIT_L(8); PG8_BAR; PG8_WAIT_L(0); PG8_MMA(0, 0, At, B0); PG8_BAR; PG8_SCHED;
      PG8_LDB(B1, 1, 1); PG8_STAGE(PG8_SB(1, 0), b3, voffB);
      PG8_BAR; PG8_WAIT_L(0); PG8_MMA(0, 1, At, B1); PG8_BAR;
      PG8_LDA(At, 1, 1); PG8_STAGE(PG8_SA(1, 0), a3, voffA);
      PG8_BAR; PG8_WAIT_L(0); PG8_MMA(1, 0, At, B0); PG8_BAR; PG8_SCHED;
      PG8_STAGE(PG8_SB(1, 1), b3 + hstepB, voffB);
      PG8_WAIT_V(6); PG8_BAR; PG8_MMA(1, 1, At, B1); PG8_BAR;
    }
    E(acc, cur, wr, wc, fr, fq);
    if (!has_next) break;
#pragma unroll
    for (int a = 0; a < 2; ++a)
#pragma unroll
      for (int b = 0; b < 2; ++b)
#pragma unroll
        for (int m = 0; m < 4; ++m)
#pragma unroll
          for (int n = 0; n < 2; ++n) acc[a][b][m][n] = (f32x4){0.f, 0.f, 0.f, 0.f};
    cur = nxt; cA = nA; cB = nB; ++ui;
  }
  PG8_WAIT_V(0);
  if (wr == 0) PG8_BAR;
  PG8_BAR;
#undef PG8_SA
#undef PG8_SB
#undef PG8_STAGE
#undef PG8_LDA
#undef PG8_LDB
#undef PG8_MMA
#undef PG8_WAIT_V
#undef PG8_WAIT_L
#undef PG8_BAR
#undef PG8_SCHED
}
typedef const f32x4 (&AccRef)[2][2][4][2];
struct EpiInprojN {
  static constexpr bool PERM = true;
  u16* qk; u16* rg;
  __device__ __forceinline__ void operator()(AccRef acc, const Unit& u, int wr, int wc, int fr, int fq) const {
    const int row0 = u.pm * BM + wr * 64 + fr;
    u16* base; int ld, colt;
    if (u.pn < 4) { base = qk; ld = 1024; colt = u.pn * 256; } else { base = rg; ld = 512; colt = (u.pn - 9) * 256; }
    const int col0 = colt + wc * 32 + 8 * fq;
#pragma unroll
    for (int ai = 0; ai < 2; ++ai)
#pragma unroll
      for (int m = 0; m < 4; ++m) {
        u16* rowp = base + (size_t)(row0 + ai * HALF + m * 16) * ld + col0;
#pragma unroll
        for (int bj = 0; bj < 2; ++bj) {
          const f32x4 v0 = acc[ai][bj][m][0], v1 = acc[ai][bj][m][1];
          u32x4 w; w.x = pk2(v0[0], v0[1]); w.y = pk2(v0[2], v0[3]); w.z = pk2(v1[0], v1[1]); w.w = pk2(v1[2], v1[3]);
          *(u32x4*)(rowp + bj * HALF) = w;
        }
      }
  }
};
struct EpiInprojT {
  static constexpr bool PERM = true;
  u16 *vT, *vTc, *hyT, *hyTc;
  __device__ __forceinline__ void operator()(AccRef acc, const Unit& u, int wr, int wc, int fr, int fq) const {
    const bool isctx = (u.pn >= 128);
    const int b = isctx ? (u.pn - 128) : (u.pn >> 4);
    const int Lseg = isctx ? 256 : 4096, t0 = isctx ? 0 : (u.pn & 15) * 256;
    const bool isv = (u.pm < 2);
    const size_t boff = isv ? (isctx ? (size_t)16777216 : (size_t)0) : (isctx ? (size_t)(16777216 + 1048576 + 25165824) : (size_t)(16777216 + 1048576));
    u16* base = vT + boff;
    const int nc = isv ? 512 : 768;
    const int wrow0 = (isv ? u.pm : u.pm - 2) * BM + wr * 64 + fr;
    const int col0 = t0 + wc * 32 + 8 * fq;
#pragma unroll
    for (int ai = 0; ai < 2; ++ai)
#pragma unroll
      for (int m = 0; m < 4; ++m) {
        u16* rowp = base + ((size_t)(b * nc + wrow0 + ai * HALF + m * 16)) * Lseg + col0;
#pragma unroll
        for (int bj = 0; bj < 2; ++bj) {
          const f32x4 v0 = acc[ai][bj][m][0], v1 = acc[ai][bj][m][1];
          u32x4 w; w.x = pk2(v0[0], v0[1]); w.y = pk2(v0[2], v0[3]); w.z = pk2(v1[0], v1[1]); w.w = pk2(v1[2], v1[3]);
          *(u32x4*)(rowp + bj * HALF) = w;
        }
      }
  }
};
struct EpiGate {
  static constexpr bool PERM = true;
  unsigned char* g8; const float* bias;
  __device__ __forceinline__ void operator()(AccRef acc, const Unit& u, int wr, int wc, int fr, int fq) const {
    const int row0 = u.pm * BM + wr * 64 + fr;
    const int col0 = u.pn * BM + wc * 32 + 8 * fq;
#pragma unroll
    for (int bj = 0; bj < 2; ++bj) {
      const f32x4 b0 = *(const f32x4*)(bias + col0 + bj * HALF), b1 = *(const f32x4*)(bias + col0 + bj * HALF + 4);
#pragma unroll
      for (int ai = 0; ai < 2; ++ai)
#pragma unroll
        for (int m = 0; m < 4; ++m) {
          const f32x4 v0 = acc[ai][bj][m][0] + b0, v1 = acc[ai][bj][m][1] + b1;
          unsigned w0 = 0, w1 = 0;
#pragma unroll
          for (int k = 0; k < 4; ++k) {
            w0 |= (unsigned)(sigmoidf_(v0[k]) * 255.0f + 0.5f) << (8 * k);
            w1 |= (unsigned)(sigmoidf_(v1[k]) * 255.0f + 0.5f) << (8 * k);
          }
          *(uint2*)(g8 + (size_t)(row0 + ai * HALF + m * 16) * 3072 + col0 + bj * HALF) = make_uint2(w0, w1);
        }
    }
  }
};
struct EpiBranch {
  static constexpr bool PERM = true;
  u16* mbuf; const unsigned char* g8; int br;
  __device__ __forceinline__ void operator()(AccRef acc, const Unit& u, int wr, int wc, int fr, int fq) const {
    const int row0 = u.pm * BM + wr * 64 + fr;
    const int col0 = u.pn * BM + wc * 32 + 8 * fq;
#pragma unroll
    for (int ai = 0; ai < 2; ++ai)
#pragma unroll
      for (int m = 0; m < 4; ++m) {
        const size_t row = (size_t)(row0 + ai * HALF + m * 16);
#pragma unroll
        for (int bj = 0; bj < 2; ++bj) {
          const uint2 gq = *(const uint2*)(g8 + row * 3072 + br * 1024 + col0 + bj * HALF);
          u16* mp = mbuf + row * 1024 + col0 + bj * HALF;
          const f32x4 v0 = acc[ai][bj][m][0], v1 = acc[ai][bj][m][1];
          float r[8];
          r[0] = (float)(gq.x & 255u) * v0[0]; r[1] = (float)((gq.x >> 8) & 255u) * v0[1];
          r[2] = (float)((gq.x >> 16) & 255u) * v0[2]; r[3] = (float)(gq.x >> 24) * v0[3];
          r[4] = (float)(gq.y & 255u) * v1[0]; r[5] = (float)((gq.y >> 8) & 255u) * v1[1];
          r[6] = (float)((gq.y >> 16) & 255u) * v1[2]; r[7] = (float)(gq.y >> 24) * v1[3];
          u32x4 w;
          if (br == 0) {
            w.x = pk2(r[0] * (1.f / 255.f), r[1] * (1.f / 255.f)); w.y = pk2(r[2] * (1.f / 255.f), r[3] * (1.f / 255.f));
            w.z = pk2(r[4] * (1.f / 255.f), r[5] * (1.f / 255.f)); w.w = pk2(r[6] * (1.f / 255.f), r[7] * (1.f / 255.f));
          } else {
            const u32x4 o = *(const u32x4*)mp;
            w.x = pk2(bflo(o.x) + r[0] * (1.f / 255.f), bfhi(o.x) + r[1] * (1.f / 255.f));
            w.y = pk2(bflo(o.y) + r[2] * (1.f / 255.f), bfhi(o.y) + r[3] * (1.f / 255.f));
            w.z = pk2(bflo(o.z) + r[4] * (1.f / 255.f), bfhi(o.z) + r[5] * (1.f / 255.f));
            w.w = pk2(bflo(o.w) + r[6] * (1.f / 255.f), bfhi(o.w) + r[7] * (1.f / 255.f));
          }
          *(u32x4*)mp = w;
        }
      }
  }
};
struct EpiOut {
  static constexpr bool PERM = false;
  const float *xsrc, *csrc; float *xdst, *cdst; const float* modl;
  __device__ __forceinline__ void operator()(AccRef acc, const Unit& u, int wr, int wc, int fr, int fq) const {
    const bool isctx = (u.pm >= 128);
    const int bi = isctx ? 8 : (u.pm >> 4);
    const float* gatev = modl + ((size_t)bi * 6 + 2) * 1024;
    const float* src = isctx ? (csrc - (size_t)NLAT * 1024) : xsrc;
    float* dst = isctx ? (cdst - (size_t)NLAT * 1024) : xdst;
    const int row0 = u.pm * BM + wr * 64 + fr, col0 = u.pn * BM + wc * 32 + 4 * fq;
#pragma unroll
    for (int bj = 0; bj < 2; ++bj)
#pragma unroll
      for (int n = 0; n < 2; ++n) {
        const int col = col0 + bj * HALF + n * 16;
        const f32x4 gv = *(const f32x4*)(gatev + col);
#pragma unroll
        for (int ai = 0; ai < 2; ++ai)
#pragma unroll
          for (int m = 0; m < 4; ++m) {
            const size_t o = (size_t)(row0 + ai * HALF + m * 16) * 1024 + col;
            const f32x4 xv = *(const f32x4*)(src + o);
            *(f32x4*)(dst + o) = xv + gv * acc[ai][bj][m][n];
          }
      }
  }
};
struct EpiQ {
  static constexpr bool PERM = true;
  u16* q;
  __device__ __forceinline__ void operator()(AccRef acc, const Unit& u, int wr, int wc, int fr, int fq) const {
    const int row0 = u.pm * BM + wr * 64 + fr;
    const int col0 = u.pn * BM + wc * 32 + 8 * fq;
#pragma unroll
    for (int ai = 0; ai < 2; ++ai)
#pragma unroll
      for (int m = 0; m < 4; ++m) {
        u16* rowp = q + (size_t)(row0 + ai * HALF + m * 16) * 2048 + col0;
#pragma unroll
        for (int bj = 0; bj < 2; ++bj) {
          const f32x4 v0 = acc[ai][bj][m][0], v1 = acc[ai][bj][m][1];
          u32x4 w; w.x = pk2(v0[0], v0[1]); w.y = pk2(v0[2], v0[3]); w.z = pk2(v1[0], v1[1]); w.w = pk2(v1[2], v1[3]);
          *(u32x4*)(rowp + bj * HALF) = w;
        }
      }
  }
};
}

__device__ __forceinline__ void tr_tile(const float* __restrict__ src, int N, int K, u16* __restrict__ dst, int tile, char* smem) {
  float* lds = (float*)smem;
  const int tiles_n = N >> 6;
  const int tk = tile / tiles_n, tn = tile - tk * tiles_n;
  const int tid = opaque_tid();
  {
    const int r = tid >> 3, c8 = (tid & 7) * 8;
    const float* s = src + (size_t)(tk * 64 + r) * N + tn * 64 + c8;
    float4 a = *(const float4*)s, b = *(const float4*)(s + 4);
    float* d = lds + r * 65 + c8;
    d[0] = a.x; d[1] = a.y; d[2] = a.z; d[3] = a.w; d[4] = b.x; d[5] = b.y; d[6] = b.z; d[7] = b.w;
  }
  __syncthreads();
  {
    const int n = tid >> 3, k0 = (tid & 7) * 8;
    uint4 o;
    o.x = pk2(lds[(k0 + 0) * 65 + n], lds[(k0 + 1) * 65 + n]);
    o.y = pk2(lds[(k0 + 2) * 65 + n], lds[(k0 + 3) * 65 + n]);
    o.z = pk2(lds[(k0 + 4) * 65 + n], lds[(k0 + 5) * 65 + n]);
    o.w = pk2(lds[(k0 + 6) * 65 + n], lds[(k0 + 7) * 65 + n]);
    *(uint4*)(dst + (size_t)(tn * 64 + n) * K + tk * 64 + k0) = o;
  }
  __syncthreads();
}
__device__ __forceinline__ void cvt_chunk(const float* __restrict__ src, u16* __restrict__ dst, size_t chunk) {
  const size_t i = chunk * 4096 + (size_t)opaque_tid() * 8;
  float4 a = *(const float4*)(src + i), b = *(const float4*)(src + i + 4);
  uint4 o;
  o.x = pk2(a.x, a.y); o.y = pk2(a.z, a.w); o.z = pk2(b.x, b.y); o.w = pk2(b.z, b.w);
  *(uint4*)(dst + i) = o;
}
__device__ __forceinline__ void cvt_chunk_fp8(const float* __restrict__ src, unsigned char* __restrict__ dst, size_t chunk, float scale) {
  const size_t i = chunk * 4096 + (size_t)opaque_tid() * 8;
  const float4 a = *(const float4*)(src + i), b = *(const float4*)(src + i + 4);
  int w0 = __builtin_amdgcn_cvt_pk_fp8_f32(a.x * scale, a.y * scale, 0, false);
  w0 = __builtin_amdgcn_cvt_pk_fp8_f32(a.z * scale, a.w * scale, w0, true);
  int w1 = __builtin_amdgcn_cvt_pk_fp8_f32(b.x * scale, b.y * scale, 0, false);
  w1 = __builtin_amdgcn_cvt_pk_fp8_f32(b.z * scale, b.w * scale, w1, true);
  *(uint2*)(dst + i) = make_uint2((unsigned)w0, (unsigned)w1);
}
__device__ __forceinline__ void phase_prep(const P& p, char* smem) {
  const int tid = opaque_tid();
  const int NTR = 2512;
  const int total = 2 * NTR + 128 + 384;
  for (int task = blockIdx.x; task < total; task += gridDim.x) {
    if (task < 2 * NTR) {
      const int l = task / NTR;
      int t = task - l * NTR;
      if (t < 704) tr_tile(p.w_in + (size_t)l * 1024 * 2816, 2816, 1024, p.WinT + (size_t)l * 2816 * 1024, t, smem);
      else if ((t -= 704) < 768) tr_tile(p.w_gate + (size_t)l * 1024 * 3072, 3072, 1024, p.WgT + (size_t)l * 3072 * 1024, t, smem);
      else if ((t -= 768) < 128) tr_tile(p.w_br_a + (size_t)l * 512 * 1024, 1024, 512, p.WaT + (size_t)l * 1024 * 512, t, smem);
      else if ((t -= 128) < 64) tr_tile(p.w_br_b + (size_t)l * 256 * 1024, 1024, 256, p.WbT + (size_t)l * 1024 * 256, t, smem);
      else if ((t -= 64) < 64) tr_tile(p.w_br_c + (size_t)l * 256 * 1024, 1024, 256, p.WcT + (size_t)l * 1024 * 256, t, smem);
      else if ((t -= 64) < 256) tr_tile(p.w_out + (size_t)l * 1024 * 1024, 1024, 1024, p.WoT + (size_t)l * 1024 * 1024, t, smem);
      else if ((t -= 256) < 512) tr_tile(p.peer_wq + (size_t)l * 1024 * 2048, 2048, 1024, p.WqT + (size_t)l * 2048 * 1024, t, smem);
      else {
        t -= 512;
        const int gate = t >> 3, dn = t & 7;
        const float* src = (gate ? p.rg_wx : p.rg_wa) + (size_t)(l * 8 + dn) * 4096;
        tr_tile(src, 64, 64, p.rgW + (size_t)((l * 2 + gate) * 8 + dn) * 4096, 0, smem);
      }
    } else if (task < 2 * NTR + 128) {
      cvt_chunk(p.peer_keys, p.keysB, (size_t)(task - 2 * NTR));
    } else {
      int t = task - 2 * NTR - 128;
      const int kc = t & 15; t >>= 4;
      const int jc = t % 12, l = t / 12;
      float* s = (float*)smem;
      for (int i = tid; i < 576; i += NTHR) {
        const int bi = i >> 6, kk = i & 63;
        const float v = (bi < 8) ? p.c[bi * 1024 + kc * 64 + kk] : p.c_ctx[kc * 64 + kk];
        s[i] = v / (1.0f + __expf(-v));
      }
      __syncthreads();
      const int j = jc * 512 + tid;
      float acc[9];
#pragma unroll
      for (int bi = 0; bi < 9; ++bi) acc[bi] = 0.f;
      const float* wp = p.w_ada + ((size_t)l * 1024 + kc * 64) * 6144 + j;
#pragma unroll 8
      for (int kk = 0; kk < 64; ++kk) {
        const float w = wp[(size_t)kk * 6144];
#pragma unroll
        for (int bi = 0; bi < 9; ++bi) acc[bi] += s[bi * 64 + kk] * w;
      }
#pragma unroll
      for (int bi = 0; bi < 9; ++bi) p.modpart[((size_t)(kc * 2 + l) * 9 + bi) * 6144 + j] = acc[bi];
      __syncthreads();
    }
  }
}
__device__ __forceinline__ void phase_modreduce(const P& p) {
  const int n = 2 * 9 * 6144;
  for (int i = blockIdx.x * NTHR + opaque_tid(); i < n; i += gridDim.x * NTHR) {
    const int l = i / (9 * 6144);
    const int j = i % 6144;
    float s = p.b_ada[l * 6144 + j];
#pragma unroll
    for (int kc = 0; kc < 16; ++kc) s += p.modpart[(size_t)kc * n + i];
    p.mod[i] = s;
  }
}

__device__ __forceinline__ void phase_norm(const P& p, int l, int which) {
  const int tid_ = opaque_tid(); const int lane = tid_ & 63, wid = tid_ >> 6;
  const int ntok = (which == 2 || (which == 1 && l == 1)) ? NLAT : NTOK;
  for (int row = blockIdx.x * 8 + wid; row < ntok; row += gridDim.x * 8) {
    const float* src;
    if (row < NLAT) src = ((which == 0 && l == 0) ? p.x : p.out) + (size_t)row * 1024;
    else src = ((which == 0 && l == 0) ? p.ctx : p.ctxs) + (size_t)(row - NLAT) * 1024;
    float4 v[4];
    float ss = 0.f;
#pragma unroll
    for (int i = 0; i < 4; ++i) {
      v[i] = *(const float4*)(src + i * 256 + lane * 4);
      ss += v[i].x * v[i].x + v[i].y * v[i].y + v[i].z * v[i].z + v[i].w * v[i].w;
    }
    ss = wave_sum(ss);
    const float rstd = rsqrtf(ss * (1.0f / 1024.0f) + 1e-6f);
    if (which == 2) {
#pragma unroll
      for (int i = 0; i < 4; ++i) {
        const int col = i * 256 + lane * 4;
        const float4 g = *(const float4*)(p.final_g + col);
        float4 o = {v[i].x * rstd * g.x, v[i].y * rstd * g.y, v[i].z * rstd * g.z, v[i].w * rstd * g.w};
        *(float4*)(p.out + (size_t)row * 1024 + col) = o;
      }
    } else {
      const int bi = row < NLAT ? (row >> 12) : 8;
      const float* gam = (which == 0 ? p.norm_mix_g : p.norm_ffn_g) + l * 1024;
      const float* msh = p.mod + ((size_t)(l * 9 + bi) * 6 + (which == 0 ? 0 : 3)) * 1024;
      const float* msc = msh + 1024;
#pragma unroll
      for (int i = 0; i < 4; ++i) {
        const int col = i * 256 + lane * 4;
        const float4 g = *(const float4*)(gam + col);
        const float4 sh = *(const float4*)(msh + col);
        const float4 sc = *(const float4*)(msc + col);
        uint2 o;
        o.x = pk2(v[i].x * rstd * g.x * (1.f + sc.x) + sh.x, v[i].y * rstd * g.y * (1.f + sc.y) + sh.y);
        o.y = pk2(v[i].z * rstd * g.z * (1.f + sc.z) + sh.z, v[i].w * rstd * g.w * (1.f + sc.w) + sh.w);
        *(uint2*)(p.xn + (size_t)row * 1024 + col) = o;
      }
    }
  }
}

__device__ __forceinline__ void filter_wave(const P& p, int l, int L, int t, float* __restrict__ outp) {
  const int lane = opaque_tid() & 63;
  const float tl = (float)t / (float)(L - 1);
  const float wang = (6.283185307179586f / (float)L) * (float)t;
  float z = 0.f;
  if (lane == 0) z = tl;
  else if (lane <= 16) { const float band = 1e-4f + (float)(lane - 1) * ((15.0f - 1e-4f) / 15.0f); z = cosf(band * wang); }
  else if (lane <= 32) { const float band = 1e-4f + (float)(lane - 17) * ((15.0f - 1e-4f) / 15.0f); z = -sinf(band * wang); }
  float a1 = p.hy_f1_b[l * 64 + lane];
  for (int i = 0; i < 33; ++i) a1 += __shfl(z, i) * p.hy_f1_w[(l * 33 + i) * 64 + lane];
  const float h1 = sinf(p.hy_freq[l * 128 + lane] * a1);
  float a2 = p.hy_f2_b[l * 64 + lane];
  for (int i = 0; i < 64; ++i) a2 += __shfl(h1, i) * p.hy_f2_w[(l * 64 + i) * 64 + lane];
  const float h2 = sinf(p.hy_freq[l * 128 + 64 + lane] * a2);
  float a3[8];
#pragma unroll
  for (int m = 0; m < 8; ++m) a3[m] = 0.f;
  for (int i = 0; i < 64; ++i) {
    const float hv = __shfl(h2, i);
    const float* wr = p.hy_f3_w + (size_t)(l * 64 + i) * 512 + lane;
#pragma unroll
    for (int m = 0; m < 8; ++m) a3[m] += hv * wr[m * 64];
  }
  const float LN100 = 4.605170185988092f;
  const float d0 = LN100 / 1.5f, d1 = LN100 / 0.3f;
#pragma unroll
  for (int m = 0; m < 8; ++m) {
    const int cp = lane + 64 * m;
    const int ch = cp & 255;
    const float delta = d0 + (float)ch * ((d1 - d0) / 255.0f);
    outp[(size_t)cp * L + t] = a3[m] * expf(-tl * delta);
  }
}
__device__ __forceinline__ void phase_filters(const P& p, int l) {
  const int wid = opaque_tid() >> 6;
  const int ntask = 4096 + (l == 0 ? 256 : 0);
  for (int t = blockIdx.x * 8 + wid; t < ntask; t += gridDim.x * 8) {
    if (t < 4096) filter_wave(p, l, 4096, t, p.hT);
    else filter_wave(p, l, 256, t - 4096, p.hc);
  }
}
__device__ __forceinline__ void kf_task(const P& p, int c, char* smem) {
  c2* buf = (c2*)smem;
  const int tid = opaque_tid();
  for (int i = 0; i < 16; ++i) {
    const int j = tid + NTHR * i;
    float v;
    if (j < 4096) v = p.hT[(size_t)c * 4096 + j];
    else if (j == 4096) v = 0.f;
    else v = p.hT[(size_t)(256 + c) * 4096 + (8192 - j)];
    buf[j] = {v, 0.f};
  }
  __syncthreads();
  fft8192(buf, -1.f);
  c2* o = (c2*)p.Kf + (size_t)c * 8192;
  for (int i = 0; i < 16; ++i) { const int j = tid + NTHR * i; o[j] = buf[j]; }
  __syncthreads();
}

__device__ __forceinline__ void inproj_tile(const P& p, int l, int mt, int nt, char* smem) {
  f32x16 acc[2][2];
  zero_acc(acc);
  const int m0 = mt * 256, n0 = nt * 128;
  gemm_kloop(acc, p.xn + (size_t)m0 * 1024, 1024, p.WinT + ((size_t)l * 2816 + n0) * 1024, 1024, 1024, smem);
  EPI_VARS
  if (nt < 8 || nt >= 18) {
    u16* dst; int ld, cbase;
    if (nt < 8) { dst = p.qk; ld = 1024; cbase = n0; }
    else { dst = p.rg; ld = 512; cbase = n0 - 2304; }
#pragma unroll
    for (int i = 0; i < 2; ++i)
#pragma unroll
      for (int j = 0; j < 2; ++j)
#pragma unroll
        for (int e = 0; e < 16; ++e)
          dst[(size_t)(m0 + EPI_ROW(i, e)) * ld + cbase + EPI_COL(j)] = f2bf(acc[i][j][e]);
  } else {
#pragma unroll
    for (int i = 0; i < 2; ++i)
#pragma unroll
      for (int j = 0; j < 2; ++j)
#pragma unroll
        for (int qd = 0; qd < 4; ++qd) {
          uint2 o;
          o.x = pk2(acc[i][j][4 * qd + 0], acc[i][j][4 * qd + 1]);
          o.y = pk2(acc[i][j][4 * qd + 2], acc[i][j][4 * qd + 3]);
          const int row0 = wm * 64 + i * 32 + 8 * qd + 4 * hh;
          *(uint2*)(smem + EPI_COL(j) * 520 + row0 * 2) = o;
        }
    __syncthreads();
    u16* dstT; int Lseg, t0, ncol0, nc;
    const bool isctx = (mt >= 128);
    const int b = isctx ? (mt - 128) : (mt >> 4);
    if (nt < 12) { ncol0 = n0 - 1024; nc = 512; dstT = isctx ? p.vTc : p.vT; }
    else { ncol0 = n0 - 1536; nc = 768; dstT = isctx ? p.hyTc : p.hyT; }
    if (isctx) { Lseg = 256; t0 = 0; } else { Lseg = 4096; t0 = (mt & 15) * 256; }
#pragma unroll 4
    for (int it = 0; it < 16; ++it) {
      const int idx = tid + NTHR * it;
      const int col = idx >> 6, u = idx & 63;
      const uint2 v = *(const uint2*)(smem + col * 520 + u * 8);
      *(uint2*)(dstT + ((size_t)(b * nc + ncol0 + col)) * Lseg + t0 + u * 4) = v;
    }
    __syncthreads();
  }
}

__device__ __forceinline__ float ldbf(const u16* p, int t, int L) { return (t >= 0 && t < L) ? bf2f(p[t]) : 0.f; }
__device__ __forceinline__ void hyena_fft_task(const P& p, int l, int c, int bp, char* smem) {
  c2* buf = (c2*)smem;
  c2* ub = (c2*)(smem + 65536);
  const int tid = opaque_tid();
  const float* sw = p.hy_short_w + l * 3 * 768;
  const float* sb = p.hy_short_b + l * 768;
  const float wx0[3] = {sw[c], sw[768 + c], sw[1536 + c]};
  const float wx1[3] = {sw[256 + c], sw[768 + 256 + c], sw[1536 + 256 + c]};
  const float wv[3] = {sw[512 + c], sw[768 + 512 + c], sw[1536 + 512 + c]};
  const float bx0 = sb[c], bx1 = sb[256 + c], bv = sb[512 + c];
  const float dsk = p.hy_bias[l * 256 + c];
  for (int i = 0; i < 8; ++i) {
    const int t = tid + NTHR * i;
    float u[2];
#pragma unroll
    for (int bb = 0; bb < 2; ++bb) {
      const int b = 2 * bp + bb;
      const u16* x1 = p.hyT + ((size_t)(b * 768 + 256 + c)) * 4096;
      const u16* vv = p.hyT + ((size_t)(b * 768 + 512 + c)) * 4096;
      const float x1c = bx1 + wx1[0] * ldbf(x1, t - 1, 4096) + wx1[1] * ldbf(x1, t, 4096) + wx1[2] * ldbf(x1, t + 1, 4096);
      const float vc = bv + wv[0] * ldbf(vv, t - 1, 4096) + wv[1] * ldbf(vv, t, 4096) + wv[2] * ldbf(vv, t + 1, 4096);
      u[bb] = vc * x1c;
    }
    buf[t] = {u[0], u[1]};
    ub[t] = {u[0], u[1]};
    buf[t + 4096] = {0.f, 0.f};
  }
  __syncthreads();
  fft8192(buf, -1.f);
  const c2* kf = (const c2*)p.Kf + (size_t)c * 8192;
  for (int i = 0; i < 16; ++i) {
    const int k = tid + NTHR * i;
    buf[k] = cmul(buf[k], kf[k]);
  }
  __syncthreads();
  fft8192(buf, 1.f);
  for (int i = 0; i < 8; ++i) {
    const int t = tid + NTHR * i;
    const c2 y = buf[t];
    const c2 uu = ub[t];
#pragma unroll
    for (int bb = 0; bb < 2; ++bb) {
      const int b = 2 * bp + bb;
      const u16* x0 = p.hyT + ((size_t)(b * 768 + c)) * 4096;
      const float x0c = bx0 + wx0[0] * ldbf(x0, t - 1, 4096) + wx0[1] * ldbf(x0, t, 4096) + wx0[2] * ldbf(x0, t + 1, 4096);
      const float yy = ldexpf(bb ? y.y : y.x, -13);
      const float uv = bb ? uu.y : uu.x;
      p.ycat[(size_t)(b * 4096 + t) * 1024 + 512 + c] = f2bf(x0c * (yy + uv * dsk));
    }
  }
  __syncthreads();
}
__device__ __forceinline__ void hyena_ctx_task(const P& p, int l, int b, int cg8, char* smem) {
  const int tid_ = opaque_tid(); const int lane = tid_ & 63, wid = tid_ >> 6;
  const int c = cg8 * 8 + wid;
  float* us = (float*)smem + wid * 1024;
  float* kfp = us + 256 + 255;
  const float* sw = p.hy_short_w + l * 3 * 768;
  const float* sb = p.hy_short_b + l * 768;
  const u16* x0 = p.hyTc + ((size_t)(b * 768 + c)) * 256;
  const u16* x1 = p.hyTc + ((size_t)(b * 768 + 256 + c)) * 256;
  const u16* vv = p.hyTc + ((size_t)(b * 768 + 512 + c)) * 256;
  for (int i = 0; i < 4; ++i) {
    const int t = lane + 64 * i;
    const float x1c = sb[256 + c] + sw[256 + c] * ldbf(x1, t - 1, 256) + sw[768 + 256 + c] * ldbf(x1, t, 256) + sw[1536 + 256 + c] * ldbf(x1, t + 1, 256);
    const float vc = sb[512 + c] + sw[512 + c] * ldbf(vv, t - 1, 256) + sw[768 + 512 + c] * ldbf(vv, t, 256) + sw[1536 + 512 + c] * ldbf(vv, t + 1, 256);
    us[t] = vc * x1c;
    kfp[t] = p.hc[(size_t)c * 256 + t];
    if (t > 0) kfp[-t] = p.hc[(size_t)(256 + c) * 256 + t];
  }
  __syncthreads();
  const float dsk = p.hy_bias[l * 256 + c];
  float acc[4] = {0.f, 0.f, 0.f, 0.f};
  for (int s = 0; s < 256; ++s) {
    const float uv = us[s];
#pragma unroll
    for (int i = 0; i < 4; ++i) acc[i] += kfp[lane + 64 * i - s] * uv;
  }
#pragma unroll
  for (int i = 0; i < 4; ++i) {
    const int t = lane + 64 * i;
    const float x0c = sb[c] + sw[c] * ldbf(x0, t - 1, 256) + sw[768 + c] * ldbf(x0, t, 256) + sw[1536 + c] * ldbf(x0, t + 1, 256);
    p.ycat[(size_t)(NLAT + b * 256 + t) * 1024 + 512 + c] = f2bf(x0c * (acc[i] + us[t] * dsk));
  }
  __syncthreads();
}

__device__ __forceinline__ void rg_chunk_task(const P& p, int l, int cq, int nblk, int mode, bool last, char* smem) {
  const int tid = opaque_tid(), lane = tid & 63, wid = tid >> 6;
  const int l31 = lane & 31, hh = lane >> 5;
  const int b = cq / 68, rr = cq - b * 68;
  const int seg = rr < 4 ? 0 : 1, sub = rr < 4 ? rr : rr - 4;
  if (mode == 1 && seg == 0 && last) return;
  float* xcf = (float*)smem;
  char* xcb = smem + 16384;
  float* coef = (float*)(smem + 24576);
  float2* segagg = (float2*)(smem + 90112);
  float* hin = (float*)(smem + 94208);
  float* Hout = (float*)(smem + 94720);
  const int Lseg = seg ? 4096 : 256;
  const int tokbase = seg ? b * 4096 : NLAT + b * 256;
  const int T0 = sub * 64;
  const int tt = tid >> 3, c0 = (tid & 7) * 8;
  const int chb = nblk * 64 + c0;
  const int wdir = wid >> 2, wgate = (wid >> 1) & 1, wmt = wid & 1;
  bf16x8 wf[2][4];
  {
    const u16* wp = p.rgW + (size_t)(((l * 2 + wgate) * 2 + wdir) * 4 + nblk) * 4096 + l31 * 64 + 8 * hh;
#pragma unroll
    for (int nt = 0; nt < 2; ++nt)
#pragma unroll
      for (int s = 0; s < 4; ++s) wf[nt][s] = *(const bf16x8*)(wp + nt * 2048 + 16 * s);
  }
  {
    float xc[8];
#pragma unroll
    for (int c = 0; c < 8; ++c) xc[c] = p.rg_conv_b[l * 256 + chb + c];
#pragma unroll
    for (int k = 0; k < 4; ++k) {
      const int pos = T0 + tt + k - 2;
      if (pos >= 0 && pos < Lseg) {
        const uint4 raw = *(const uint4*)(p.rg + (size_t)(tokbase + pos) * 512 + chb);
        const float4 w0 = *(const float4*)(p.rg_conv_w + (l * 4 + k) * 256 + chb);
        const float4 w1 = *(const float4*)(p.rg_conv_w + (l * 4 + k) * 256 + chb + 4);
        xc[0] += w0.x * bflo(raw.x); xc[1] += w0.y * bfhi(raw.x);
        xc[2] += w0.z * bflo(raw.y); xc[3] += w0.w * bfhi(raw.y);
        xc[4] += w1.x * bflo(raw.z); xc[5] += w1.y * bfhi(raw.z);
        xc[6] += w1.z * bflo(raw.w); xc[7] += w1.w * bfhi(raw.w);
      }
    }
    *(float4*)(xcf + tt * 64 + c0) = make_float4(xc[0], xc[1], xc[2], xc[3]);
    *(float4*)(xcf + tt * 64 + c0 + 4) = make_float4(xc[4], xc[5], xc[6], xc[7]);
    uint4 o;
    o.x = pk2(xc[0], xc[1]); o.y = pk2(xc[2], xc[3]); o.z = pk2(xc[4], xc[5]); o.w = pk2(xc[6], xc[7]);
    *(uint4*)(xcb + swz128(tt, tid & 7)) = o;
  }
  __syncthreads();
  {
    f32x16 acc0 = zero16(), acc1 = zero16();
#pragma unroll
    for (int s = 0; s < 4; ++s) {
      const bf16x8 af = *(const bf16x8*)(xcb + swz128(wmt * 32 + l31, 2 * s + hh));
      acc0 = mfma32(af, wf[0][s], acc0);
      acc1 = mfma32(af, wf[1][s], acc1);
    }
    float* cp = coef + (wdir * 2 + wgate) * 4096;
#pragma unroll
    for (int e = 0; e < 16; ++e) {
      const int tok = wmt * 32 + (e & 3) + 8 * (e >> 2) + 4 * hh;
      cp[tok * 64 + l31] = acc0[e];
      cp[tok * 64 + 32 + l31] = acc1[e];
    }
  }
  __syncthreads();
#pragma unroll
  for (int dir = 0; dir < 2; ++dir) {
    float* ca = coef + (dir * 2) * 4096;
    float* cb2 = ca + 4096;
#pragma unroll
    for (int c = 0; c < 8; ++c) {
      const int ch = (l * 2 + dir) * 256 + chb + c;
      const float sp = __logf(1.0f + __expf(-p.rg_lambda[ch]));
      const int o = tt * 64 + c0 + c;
      const float r = sigmoidf_(ca[o] + p.rg_ba[ch]);
      const float ii = sigmoidf_(cb2[o] + p.rg_bx[ch]);
      const float la = -8.0f * r * sp;
      const float av = __expf(la);
      const float e2 = 2.0f * la;
      const float om = (e2 > -0.1f) ? (-e2 * (1.0f + e2 * (0.5f + e2 * (0.16666667f + e2 * 0.041666668f)))) : (1.0f - __expf(e2));
      ca[o] = av;
      cb2[o] = sqrtf(om) * ii * xcf[o];
    }
  }
  __syncthreads();
  const int sg = tid >> 7, sdir = (tid >> 6) & 1, sch = tid & 63;
  const float* sa = coef + (sdir * 2) * 4096 + sch;
  const float* sb = sa + 4096;
  {
    float Pm = 1.f, H = 0.f;
#pragma unroll
    for (int n = 0; n < 16; ++n) {
      const int tok = sdir ? (63 - (16 * sg + n)) : (16 * sg + n);
      const float av = sa[tok * 64], bv = sb[tok * 64];
      H = av * H + bv;
      Pm *= av;
    }
    segagg[(sg * 2 + sdir) * 64 + sch] = make_float2(Pm, H);
  }
  __syncthreads();
  const int pos = sdir ? (seg == 0 ? 3 - sub : 67 - sub) : (seg == 0 ? sub : 4 + sub);
  float2* aggp = (float2*)p.agg + ((size_t)(b * 2 + sdir) * 68) * 256 + nblk * 64 + sch;
  if (mode == 0) {
    if (tid < 128) {
      float A = 1.f, B = 0.f;
#pragma unroll
      for (int s2 = 0; s2 < 4; ++s2) {
        const float2 g = segagg[(s2 * 2 + sdir) * 64 + sch];
        B = g.x * B + g.y;
        A *= g.x;
      }
      aggp[(size_t)pos * 256] = make_float2(A, B);
    }
    __syncthreads();
    return;
  }
  if (tid < 128) {
    float h = 0.f;
    for (int j = 0; j < pos; ++j) {
      const float2 g = aggp[(size_t)j * 256];
      h = g.x * h + g.y;
    }
    hin[sdir * 64 + sch] = h;
  }
  __syncthreads();
  {
    float h = hin[sdir * 64 + sch];
    for (int s2 = 0; s2 < sg; ++s2) {
      const float2 g = segagg[(s2 * 2 + sdir) * 64 + sch];
      h = g.x * h + g.y;
    }
#pragma unroll
    for (int n = 0; n < 16; ++n) {
      const int tok = sdir ? (63 - (16 * sg + n)) : (16 * sg + n);
      h = sa[tok * 64] * h + sb[tok * 64];
      Hout[sdir * 4096 + tok * 64 + sch] = h;
    }
  }
  __syncthreads();
  {
    const size_t gtok = (size_t)tokbase + T0 + tt;
    const float4 f0 = *(const float4*)(Hout + tt * 64 + c0), f1 = *(const float4*)(Hout + tt * 64 + c0 + 4);
    const float4 h0 = *(const float4*)(Hout + 4096 + tt * 64 + c0), h1 = *(const float4*)(Hout + 4096 + tt * 64 + c0 + 4);
    const uint4 g = *(const uint4*)(p.rg + gtok * 512 + 256 + chb);
    uint4 o;
    o.x = pk2((f0.x + h0.x) * gelu_tanh(bflo(g.x)), (f0.y + h0.y) * gelu_tanh(bfhi(g.x)));
    o.y = pk2((f0.z + h0.z) * gelu_tanh(bflo(g.y)), (f0.w + h0.w) * gelu_tanh(bfhi(g.y)));
    o.z = pk2((f1.x + h1.x) * gelu_tanh(bflo(g.z)), (f1.y + h1.y) * gelu_tanh(bfhi(g.z)));
    o.w = pk2((f1.z + h1.z) * gelu_tanh(bflo(g.w)), (f1.w + h1.w) * gelu_tanh(bfhi(g.w)));
    *(uint4*)(p.ycat + gtok * 1024 + 768 + chb) = o;
  }
  __syncthreads();
}

__device__ __forceinline__ void attn_wave(const P& p, int l, int b, int h, bool local, int r, int half, int qtok0, const float* rpbL) {
  const int lane = opaque_tid() & 63, q = lane & 31, hh = lane >> 5;
  bf16x8 qf[4];
  {
    const u16* qp = p.qk + (size_t)(qtok0 + q) * 1024 + h * 64 + 8 * hh;
#pragma unroll
    for (int s = 0; s < 4; ++s) qf[s] = *(const bf16x8*)(qp + 16 * s);
  }
  f32x16 o0 = zero16(), o1 = zero16();
  float m_run = -1e30f, l_run = 0.f;
  const int pi = (q & 19) | ((q & 4) << 1) | ((q & 8) >> 1);
  const int w = half * 32 + q;
  const int st = min(max(w - 8, 0), 48);
  const int rs = min(max(r - 4, 0), 56);
  const int ntiles = local ? 24 : 8;
  for (int ti = 0; ti < ntiles; ++ti) {
    int ktok0, vstride, a = 0, g = 0;
    const u16* vb;
    if (ti < 8) {
      ktok0 = NLAT + b * 256 + ti * 32;
      vb = p.vTc + ((size_t)(b * 512 + h * 64)) * 256 + ti * 32;
      vstride = 256;
    } else {
      const int tl = ti - 8;
      a = tl >> 1; g = tl & 1;
      ktok0 = b * 4096 + (rs + a) * 64 + g * 32;
      vb = p.vT + ((size_t)(b * 512 + h * 64)) * 4096 + (rs + a) * 64 + g * 32;
      vstride = 4096;
    }
    bf16x8 kf[4], vf[2][2];
    {
      const u16* kp = p.qk + (size_t)(ktok0 + pi) * 1024 + 512 + h * 64 + 8 * hh;
#pragma unroll
      for (int s = 0; s < 4; ++s) kf[s] = *(const bf16x8*)(kp + 16 * s);
#pragma unroll
      for (int dt = 0; dt < 2; ++dt)
#pragma unroll
        for (int s2 = 0; s2 < 2; ++s2) vf[dt][s2] = *(const bf16x8*)(vb + (size_t)(dt * 32 + q) * vstride + 16 * s2 + 8 * hh);
    }
    f32x16 sacc = zero16();
#pragma unroll
    for (int s = 0; s < 4; ++s) sacc = mfma32(kf[s], qf[s], sacc);
    float sv[16];
    float tmax = -1e30f;
#pragma unroll
    for (int e = 0; e < 16; ++e) {
      float x = sacc[e] * 0.125f;
      if (ti >= 8) {
        const int kc = g * 32 + (e & 7) + 8 * hh + 16 * (e >> 3);
        const bool valid = (kc >= st) && (kc < st + 16);
        const int bi = valid ? ((rs + a - r + 7) * 31 + (kc - w + 15)) : 0;
        const float bias = rpbL[bi];
        x = valid ? (x + bias) : -1e30f;
      }
      sv[e] = x;
      tmax = fmaxf(tmax, x);
    }
    tmax = fmaxf(tmax, __shfl_xor(tmax, 32));
    const float m_new = fmaxf(m_run, tmax);
    const float alpha = __expf(m_run - m_new);
    m_run = m_new;
    l_run *= alpha;
#pragma unroll
    for (int e = 0; e < 16; ++e) { o0[e] *= alpha; o1[e] *= alpha; }
    float psum = 0.f;
#pragma unroll
    for (int e = 0; e < 16; ++e) { const float pe = __expf(sv[e] - m_new); sv[e] = pe; psum += pe; }
    l_run += psum;
    bf16x8 pf[2];
#pragma unroll
    for (int s2 = 0; s2 < 2; ++s2) {
      union { bf16x8 v; unsigned u[4]; } cv;
#pragma unroll
      for (int j = 0; j < 4; ++j) cv.u[j] = pk2(sv[8 * s2 + 2 * j], sv[8 * s2 + 2 * j + 1]);
      pf[s2] = cv.v;
    }
#pragma unroll
    for (int s2 = 0; s2 < 2; ++s2) {
      o0 = mfma32(vf[0][s2], pf[s2], o0);
      o1 = mfma32(vf[1][s2], pf[s2], o1);
    }
  }
  const float lt = l_run + __shfl_xor(l_run, 32);
  const float inv = 1.0f / lt;
  u16* op = p.ycat + (size_t)(qtok0 + q) * 1024 + h * 64;
#pragma unroll
  for (int qd = 0; qd < 4; ++qd) {
    uint2 a0, a1;
    a0.x = pk2(o0[4 * qd] * inv, o0[4 * qd + 1] * inv);
    a0.y = pk2(o0[4 * qd + 2] * inv, o0[4 * qd + 3] * inv);
    a1.x = pk2(o1[4 * qd] * inv, o1[4 * qd + 1] * inv);
    a1.y = pk2(o1[4 * qd + 2] * inv, o1[4 * qd + 3] * inv);
    *(uint2*)(op + 8 * qd + 4 * hh) = a0;
    *(uint2*)(op + 32 + 8 * qd + 4 * hh) = a1;
  }
}
__device__ __forceinline__ void attn_task(const P& p, int l, int kind, int idx, char* smem) {
  const int tid_ = opaque_tid(); const int lane = tid_ & 63, wid = tid_ >> 6;
  float* rpbL = (float*)smem + wid * 480;
  for (int i = lane; i < 465; i += 64) rpbL[i] = p.na_rpb[(size_t)(l * 8 + wid) * 465 + i];
  __syncthreads();
  if (kind == 0) {
    const int half = idx & 1, r = (idx >> 1) & 63, b = idx >> 7;
    attn_wave(p, l, b, wid, true, r, half, b * 4096 + r * 64 + half * 32, rpbL);
  } else {
    const int qg = idx & 7, b = idx >> 3;
    attn_wave(p, l, b, wid, false, 0, 0, NLAT + b * 256 + qg * 32, rpbL);
  }
  __syncthreads();
}

__device__ __forceinline__ void phase_mixers(const P& p, int l, char* smem, unsigned* counter) {
  const bool last = (l == 1);
  const int n_rg = 2176 * XRGA, n_fft = 1024 * XFFT, n_hc = last ? 0 : 256, n_att = 1024 * XATT, n_attc = last ? 0 : 64;
  const int total = n_rg + n_fft + n_hc + n_att + n_attc;
  volatile int* s_taskp = (volatile int*)(smem + SMEM_BYTES - 16);
  for (;;) {
    __syncthreads();
    if (threadIdx.x == 0) *s_taskp = (int)atomicAdd(counter, 1u);
    __syncthreads();
    int t = *s_taskp;
    if (t >= total) break;
    if (t < n_rg) { if (t >= 2176) t -= 2176; rg_chunk_task(p, l, t >> 2, t & 3, 0, last, smem); continue; }
    t -= n_rg;
    if (t < n_fft) { t &= 1023; hyena_fft_task(p, l, t >> 2, t & 3, smem); continue; }
    t -= n_fft;
    if (t < n_hc) { hyena_ctx_task(p, l, t >> 5, t & 31, smem); continue; }
    t -= n_hc;
    if (t < n_att) { t &= 1023; attn_task(p, l, 0, t, smem); continue; }
    t -= n_att;
    attn_task(p, l, 1, t, smem);
  }
}

__device__ __forceinline__ void merge_tile(const P& p, int l, int mt, int nt, char* smem) {
  EPI_VARS
  const int m0 = mt * 256, n0 = nt * 128;
  f32x16 macc[2][2];
  zero_acc(macc);
  for (int br = 0; br < 3; ++br) {
    unsigned* gpl = (unsigned*)(smem + 98304) + tid;
    {
      f32x16 acc[2][2];
      zero_acc(acc);
      gemm_kloop(acc, p.xn + (size_t)m0 * 1024, 1024, p.WgT + ((size_t)l * 3072 + br * 1024 + n0) * 1024, 1024, 1024, smem);
#pragma unroll
      for (int j = 0; j < 2; ++j) {
        const float bg = p.b_gate[l * 3072 + br * 1024 + n0 + EPI_COL(j)];
#pragma unroll
        for (int i = 0; i < 2; ++i)
#pragma unroll
          for (int e = 0; e < 4; ++e) {
            const unsigned q0 = (unsigned)(sigmoidf_(acc[i][j][4 * e] + bg) * 255.0f + 0.5f);
            const unsigned q1 = (unsigned)(sigmoidf_(acc[i][j][4 * e + 1] + bg) * 255.0f + 0.5f);
            const unsigned q2 = (unsigned)(sigmoidf_(acc[i][j][4 * e + 2] + bg) * 255.0f + 0.5f);
            const unsigned q3 = (unsigned)(sigmoidf_(acc[i][j][4 * e + 3] + bg) * 255.0f + 0.5f);
            gpl[((i * 2 + j) * 4 + e) * 512] = q0 | (q1 << 8) | (q2 << 16) | (q3 << 24);
          }
      }
    }
    {
      f32x16 acc[2][2];
      zero_acc(acc);
      const u16* A; const u16* B; int K;
      if (br == 0) { A = p.ycat + (size_t)m0 * 1024; B = p.WaT + ((size_t)l * 1024 + n0) * 512; K = 512; }
      else if (br == 1) { A = p.ycat + (size_t)m0 * 1024 + 512; B = p.WbT + ((size_t)l * 1024 + n0) * 256; K = 256; }
      else { A = p.ycat + (size_t)m0 * 1024 + 768; B = p.WcT + ((size_t)l * 1024 + n0) * 256; K = 256; }
      gemm_kloop(acc, A, 1024, B, K, K, smem);
#pragma unroll
      for (int i = 0; i < 2; ++i)
#pragma unroll
        for (int j = 0; j < 2; ++j)
#pragma unroll
          for (int e = 0; e < 4; ++e) {
            const unsigned g4 = gpl[((i * 2 + j) * 4 + e) * 512];
            macc[i][j][4 * e] += (float)(g4 & 255u) * (1.0f / 255.0f) * acc[i][j][4 * e];
            macc[i][j][4 * e + 1] += (float)((g4 >> 8) & 255u) * (1.0f / 255.0f) * acc[i][j][4 * e + 1];
            macc[i][j][4 * e + 2] += (float)((g4 >> 16) & 255u) * (1.0f / 255.0f) * acc[i][j][4 * e + 2];
            macc[i][j][4 * e + 3] += (float)(g4 >> 24) * (1.0f / 255.0f) * acc[i][j][4 * e + 3];
          }
    }
  }
#pragma unroll
  for (int i = 0; i < 2; ++i)
#pragma unroll
    for (int j = 0; j < 2; ++j)
#pragma unroll
      for (int e = 0; e < 16; ++e)
        p.mbuf[(size_t)(m0 + EPI_ROW(i, e)) * 1024 + n0 + EPI_COL(j)] = f2bf(macc[i][j][e]);
}
__device__ __forceinline__ void outproj_tile(const P& p, int l, int mt, int nt, char* smem, bool do_store) {
  EPI_VARS
  const int m0 = mt * 256, n0 = nt * 128;
  f32x16 acc[2][2];
  zero_acc(acc);
  gemm_kloop(acc, p.mbuf + (size_t)m0 * 1024, 1024, p.WoT + ((size_t)l * 1024 + n0) * 1024, 1024, 1024, smem);
  const bool isctx = (mt >= 128);
  const int bi = isctx ? 8 : (mt >> 4);
  const float* gatev = p.mod + ((size_t)(l * 9 + bi) * 6 + 2) * 1024;
  const float* src; float* dst;
  if (isctx) { src = (l == 0 ? p.ctx : p.ctxs) - (size_t)NLAT * 1024; dst = p.ctxs - (size_t)NLAT * 1024; }
  else { src = (l == 0 ? p.x : p.out); dst = p.out; }
#pragma unroll
  for (int j = 0; j < 2; ++j) {
    const int col = n0 + EPI_COL(j);
    const float gv = gatev[col];
#pragma unroll
    for (int i = 0; i < 2; ++i)
#pragma unroll
      for (int e = 0; e < 16; ++e) {
        const size_t o = (size_t)(m0 + EPI_ROW(i, e)) * 1024 + col;
        if (do_store) dst[o] = src[o] + gv * acc[i][j][e];
      }
  }
}

__device__ __forceinline__ void ins16(unsigned (&L)[16], unsigned x) {
#pragma unroll
  for (int i = 0; i < 16; ++i) {
    const unsigned hi = max(L[i], x);
    x = min(L[i], x);
    L[i] = hi;
  }
}
__device__ __forceinline__ unsigned f2sort(float f) {
  const unsigned b = __float_as_uint(f);
  return b ^ ((unsigned)((int)b >> 31) | 0x80000000u);
}
__device__ __forceinline__ float sort2f(unsigned k) {
  const unsigned u = k & ~127u;
  const unsigned b = (u & 0x80000000u) ? (u ^ 0x80000000u) : ~u;
  return __uint_as_float(b);
}
__device__ __forceinline__ void peer_score_tile(const P& p, int l, int mt, int hp, char* smem) {
  EPI_VARS
  const int m0 = mt * 256;
  f32x16 acc[2][2];
  zero_acc(acc);
  gemm_kloop(acc, p.q + (size_t)m0 * 2048 + hp * 128, 2048, p.keysB + ((size_t)l * 16 + hp) * 16384, 128, 128, smem);
  float* Sf = (float*)smem;
#pragma unroll
  for (int i = 0; i < 2; ++i)
#pragma unroll
    for (int j = 0; j < 2; ++j)
#pragma unroll
      for (int e = 0; e < 16; ++e) Sf[EPI_ROW(i, e) * 130 + EPI_COL(j)] = acc[i][j][e];
  __syncthreads();
  unsigned L[16];
#pragma unroll
  for (int i = 0; i < 16; ++i) L[i] = 0u;
  const int row = tid >> 1, hf = tid & 1;
  for (int i = 0; i < 64; ++i) {
    const int key = 2 * i + hf;
    const float v = Sf[row * 130 + key];
    ins16(L, (f2sort(v) & ~127u) | (unsigned)key);
  }
  unsigned* X = (unsigned*)(smem + 133120);
  if (hf) {
#pragma unroll
    for (int i = 0; i < 16; ++i) X[row * 16 + i] = L[i];
  }
  __syncthreads();
  if (!hf) {
#pragma unroll
    for (int i = 0; i < 16; ++i) ins16(L, X[row * 16 + i]);
    unsigned* o = p.topk + ((size_t)(m0 + row) * 16 + hp) * 16;
#pragma unroll
    for (int i = 0; i < 4; ++i) *(uint4*)(o + 4 * i) = make_uint4(L[4 * i], L[4 * i + 1], L[4 * i + 2], L[4 * i + 3]);
  }
  __syncthreads();
}

__device__ __forceinline__ void phase_peer_experts(const P& p, int l, bool do_store) {
  const int tid_ = opaque_tid(); const int lane = tid_ & 63, wid = tid_ >> 6;
  const int ntok = (l == 1) ? NLAT : NTOK;
  int ci, cj;
  {
    const int e = lane;
    if (e < 16) { ci = 0; cj = e; }
    else if (e < 24) { ci = 1; cj = e - 16; }
    else if (e < 29) { ci = 2; cj = e - 24; }
    else if (e < 33) { ci = 3; cj = e - 29; }
    else if (e < 36) { ci = 4; cj = e - 33; }
    else if (e < 38) { ci = 5; cj = e - 36; }
    else if (e < 40) { ci = 6; cj = e - 38; }
    else if (e < 42) { ci = 7; cj = e - 40; }
    else { ci = min(8 + (e - 42), 15); cj = 0; }
  }
  for (int tok = blockIdx.x * 8 + wid; tok < ntok; tok += gridDim.x * 8) {
    float xr[16];
    {
      const uint4 a = *(const uint4*)(p.xn + (size_t)tok * 1024 + lane * 16);
      const uint4 b = *(const uint4*)(p.xn + (size_t)tok * 1024 + lane * 16 + 8);
      xr[0] = bflo(a.x); xr[1] = bfhi(a.x); xr[2] = bflo(a.y); xr[3] = bfhi(a.y);
      xr[4] = bflo(a.z); xr[5] = bfhi(a.z); xr[6] = bflo(a.w); xr[7] = bfhi(a.w);
      xr[8] = bflo(b.x); xr[9] = bfhi(b.x); xr[10] = bflo(b.y); xr[11] = bfhi(b.y);
      xr[12] = bflo(b.z); xr[13] = bfhi(b.z); xr[14] = bflo(b.w); xr[15] = bfhi(b.w);
    }
    float yacc[16];
#pragma unroll
    for (int i = 0; i < 16; ++i) yacc[i] = 0.f;
    for (int h = 0; h < 8; ++h) {
      const unsigned kv = p.topk[((size_t)tok * 16 + 2 * h) * 16 + (lane & 31)];
      const unsigned k0 = __shfl(kv, ci);
      const unsigned k1 = __shfl(kv, 16 + cj);
      const float val = (lane < 50) ? (sort2f(k0) + sort2f(k1)) : -3.0e38f;
      const int eidx = (int)((k0 & 127u) * 128u + (k1 & 127u));
      int cnt = 0;
      for (int e2 = 0; e2 < 50; ++e2) {
        const float v2 = __shfl(val, e2);
        cnt += (v2 > val || (v2 == val && e2 < lane)) ? 1 : 0;
      }
      const bool sel = (lane < 50) && (cnt < 16);
      const float mx = wave_max(sel ? val : -3.0e38f);
      const float ex = sel ? __expf(val - mx) : 0.f;
      const float sm = wave_sum(ex);
      const float gsel = ex / sm;
      unsigned long long mask = __ballot(sel);
      for (int it = 0; it < 2; ++it) {
        int ln[8];
#pragma unroll
        for (int k = 0; k < 8; ++k) {
          ln[k] = mask ? (__ffsll((long long)mask) - 1) : 0;
          mask &= mask - 1;
        }
        uint4 ur[8], vr[8];
        float gk[8];
#pragma unroll
        for (int k = 0; k < 8; ++k) {
          const int id = __shfl(eidx, ln[k]);
          gk[k] = __shfl(gsel, ln[k]);
          ur[k] = *(const uint4*)(p.Ub + (size_t)id * 1024 + lane * 16);
          vr[k] = *(const uint4*)(p.Vb + (size_t)id * 1024 + lane * 16);
        }
#pragma unroll
        for (int k = 0; k < 8; ++k) {
          float d = 0.f;
          {
            const unsigned uw[4] = {ur[k].x, ur[k].y, ur[k].z, ur[k].w};
#pragma unroll
            for (int q4 = 0; q4 < 4; ++q4) {
              const f32x2 lo = __builtin_amdgcn_cvt_pk_f32_fp8((int)uw[q4], false);
              const f32x2 hi = __builtin_amdgcn_cvt_pk_f32_fp8((int)uw[q4], true);
              d += xr[4 * q4] * lo.x + xr[4 * q4 + 1] * lo.y + xr[4 * q4 + 2] * hi.x + xr[4 * q4 + 3] * hi.y;
            }
          }
          d = wave_sum(d) * (1.0f / 64.0f);
          const float act = gelu_tanh(d) * gk[k];
          {
            const unsigned vw[4] = {vr[k].x, vr[k].y, vr[k].z, vr[k].w};
#pragma unroll
            for (int q4 = 0; q4 < 4; ++q4) {
              const f32x2 lo = __builtin_amdgcn_cvt_pk_f32_fp8((int)vw[q4], false);
              const f32x2 hi = __builtin_amdgcn_cvt_pk_f32_fp8((int)vw[q4], true);
              yacc[4 * q4] += act * lo.x; yacc[4 * q4 + 1] += act * lo.y;
              yacc[4 * q4 + 2] += act * hi.x; yacc[4 * q4 + 3] += act * hi.y;
            }
          }
        }
      }
    }
    const int bi = tok < NLAT ? (tok >> 12) : 8;
    const float* gv = p.mod + ((size_t)(l * 9 + bi) * 6 + 5) * 1024 + lane * 16;
    float* xp = (tok < NLAT) ? (p.out + (size_t)tok * 1024) : (p.ctxs + (size_t)(tok - NLAT) * 1024);
    xp += lane * 16;
#pragma unroll
    for (int i = 0; i < 4; ++i) {
      float4 xv = *(float4*)(xp + 4 * i);
      const float4 g4 = *(const float4*)(gv + 4 * i);
      xv.x += g4.x * yacc[4 * i] * 0.0625f; xv.y += g4.y * yacc[4 * i + 1] * 0.0625f; xv.z += g4.z * yacc[4 * i + 2] * 0.0625f; xv.w += g4.w * yacc[4 * i + 3] * 0.0625f;
      if (do_store) *(float4*)(xp + 4 * i) = xv;
    }
  }
}


#define XB_TMO      128
#define XB_XCNT(j)  (256  + 64 * (j))
#define XB_XSUB(j)  (1280 + 64 * (j))
#define XB_XGEN(j)  (2304 + 64 * (j))
#define XB_TOP      3328
#define XB_TOPGEN   3392
#define XCD_BAR_WORDS 3456
#define XB_SPIN_CAP (1u << 22)
#define LAS __attribute__((address_space(3)))
__device__ __forceinline__ unsigned xb_ld(unsigned* p) { return __hip_atomic_load(p, __ATOMIC_RELAXED, __HIP_MEMORY_SCOPE_AGENT); }
__device__ __forceinline__ unsigned xb_add(unsigned* p, unsigned v) { return __hip_atomic_fetch_add(p, v, __ATOMIC_RELAXED, __HIP_MEMORY_SCOPE_AGENT); }
__device__ __forceinline__ unsigned xb_xcc_id() { return (unsigned)__builtin_amdgcn_s_getreg((3 << 11) | 20) & 0xFu; }
#define XB_SPIN(cond, bar) do { unsigned _sp = 0; while (cond) { __builtin_amdgcn_s_sleep(1); \
    if ((++_sp & 255u) == 0u) { if (xb_ld(&(bar)[XB_TMO])) break; if (_sp > XB_SPIN_CAP) { atomicAdd(&(bar)[XB_TMO], 1u); break; } } } } while (0)
struct XcdBarrier { unsigned* bar; unsigned x; volatile LAS unsigned* st; };
__device__ __forceinline__ XcdBarrier xcd_barrier_post(unsigned* bar, volatile LAS unsigned* st) {
  XcdBarrier b; b.bar = bar; b.x = xb_xcc_id(); b.st = st;
  if (threadIdx.x == 0) (void)xb_add(&bar[XB_XCNT(b.x)], 1u);
  return b;
}
__device__ __forceinline__ void xcd_barrier_complete(unsigned* bar, unsigned x, unsigned& nloc, unsigned& nx) {
  const unsigned G = gridDim.x * gridDim.y * gridDim.z;
  unsigned sum, cnt, mine, sp = 0u;
  for (;;) {
    sum = 0u; cnt = 0u; mine = 0u;
#pragma unroll
    for (unsigned j = 0; j < 16; ++j) { const unsigned c = xb_ld(&bar[XB_XCNT(j)]); sum += c; cnt += (c > 0u) ? 1u : 0u; mine = (j == x) ? c : mine; }
    if (sum == G) break;
    __builtin_amdgcn_s_sleep(1);
    if ((++sp & 255u) == 0u) { if (xb_ld(&bar[XB_TMO])) break; if (sp > XB_SPIN_CAP) { atomicAdd(&bar[XB_TMO], 1u); break; } }
  }
  nloc = mine > 0u ? mine : 1u; nx = cnt > 0u ? cnt : 1u;
}
__device__ __forceinline__ void xcd_barrier(unsigned* bar_u, volatile LAS unsigned* st_u) {
  XcdBarrier b; b.bar = bar_u; b.x = xb_xcc_id(); b.st = st_u;
  asm volatile("s_waitcnt vmcnt(0)" ::: "memory");
  __syncthreads();
  if (threadIdx.x == 0) {
    unsigned long long bp_ = (unsigned long long)b.bar;
    asm volatile("" : "+v"(bp_));
    unsigned* bar = (unsigned*)bp_;
    __builtin_amdgcn_s_waitcnt(0);
    unsigned nloc = b.st[0], nx = b.st[1];
    if (nloc == 0u) { xcd_barrier_complete(bar, b.x, nloc, nx); b.st[0] = nloc; b.st[1] = nx; }
    const unsigned old = xb_add(&bar[XB_XSUB(b.x)], 1u);
    const unsigned gen = old / nloc;
    if (old + 1u == (gen + 1u) * nloc) {
      __builtin_amdgcn_fence(__ATOMIC_RELEASE, "agent");
      asm volatile("s_waitcnt vmcnt(0)" ::: "memory");
      const unsigned og = xb_add(&bar[XB_TOP], 1u);
      const unsigned tg = og / nx;
      if (og + 1u == (tg + 1u) * nx) xb_add(&bar[XB_TOPGEN], 1u);
      else XB_SPIN(xb_ld(&bar[XB_TOPGEN]) == tg, bar);
      __builtin_amdgcn_fence(__ATOMIC_ACQUIRE, "agent");
      xb_add(&bar[XB_XGEN(b.x)], 1u);
      asm volatile("s_waitcnt vmcnt(0)" ::: "memory");
    } else {
      XB_SPIN(xb_ld(&bar[XB_XGEN(b.x)]) == gen, bar);
      __builtin_amdgcn_fence(__ATOMIC_ACQUIRE, "agent");
      asm volatile("s_waitcnt vmcnt(0)" ::: "memory");
    }
  }
  __syncthreads();
}

__global__ void __launch_bounds__(NTHR) fwd_megakernel(P p) {
  __shared__ __attribute__((aligned(16))) char smem[SMEM_BYTES];
  cg::grid_group grid = cg::this_grid();
  const int nb = gridDim.x, bid = blockIdx.x;
  pg8::PG8_LAS_T lds = (pg8::PG8_LAS_T)smem;
  volatile LAS unsigned* xbw = (volatile LAS unsigned*)(smem + SMEM_BYTES - 32);
  if (threadIdx.x == 0) { xbw[0] = 0u; xbw[1] = 0u; xbw[2] = 0u; xbw[3] = 0u; }
  __syncthreads();
  (void)xcd_barrier_post(p.counters + 1024, xbw);

  phase_prep(p, smem);
  grid.sync();
  phase_modreduce(p);
  xcd_barrier(p.counters + 1024, xbw);

  for (int l = 0; l < 2; ++l) {
    const bool last = (l == 1);
    const int n_mt = last ? 128 : 136;
    phase_filters(p, l);
    phase_norm(p, l, 0);
    xcd_barrier(p.counters + 1024, xbw);
    if (bid < 256) kf_task(p, bid, smem);
    for (int task = 256 + bid; task < 256; task += nb) kf_task(p, task, smem);
    {
      pg8::Gemm g; pg8::Order S;
      g.A = p.xn; g.Bt = p.WinT + (size_t)l * 2816 * 1024; g.lda = 1024; g.ldb = 1024; g.K = 1024;
      S.init(136, 6, nb, bid, 4, 5);
      pg8::EpiInprojN e1; e1.qk = p.qk; e1.rg = p.rg;
      pg8::gemm_phase(lds, g, S, e1);
      g.A = p.WinT + ((size_t)l * 2816 + 1024) * 1024; g.Bt = p.xn;
      S.init(5, 136, nb, bid);
      pg8::EpiInprojT e2; e2.vT = p.vT; e2.vTc = p.vTc; e2.hyT = p.hyT; e2.hyTc = p.hyTc;
      pg8::gemm_phase(lds, g, S, e2);
    }
    xcd_barrier(p.counters + 1024, xbw);
    phase_mixers(p, l, smem, p.counters + l * 4);
    xcd_barrier(p.counters + 1024, xbw);
    for (int task = bid; task < 2176; task += nb) rg_chunk_task(p, l, task >> 2, task & 3, 1, last, smem);
    xcd_barrier(p.counters + 1024, xbw);
    {
      pg8::Gemm g; pg8::Order S;
      g.A = p.xn; g.Bt = p.WgT + (size_t)l * 3072 * 1024; g.lda = 1024; g.ldb = 1024; g.K = 1024;
      S.init(n_mt, 12, nb, bid);
      pg8::EpiGate e; e.g8 = p.g8; e.bias = p.b_gate + l * 3072;
      pg8::gemm_phase(lds, g, S, e);
    }
    xcd_barrier(p.counters + 1024, xbw);
    {
      pg8::Gemm g; pg8::Order S;
      S.init(n_mt, 4, nb, bid);
      pg8::EpiBranch e; e.mbuf = p.mbuf; e.g8 = p.g8;
      g.lda = 1024;
      g.A = p.ycat; g.Bt = p.WaT + (size_t)l * 1024 * 512; g.ldb = 512; g.K = 512; e.br = 0;
      pg8::gemm_phase(lds, g, S, e);
      g.A = p.ycat + 512; g.Bt = p.WbT + (size_t)l * 1024 * 256; g.ldb = 256; g.K = 256; e.br = 1;
      pg8::gemm_phase(lds, g, S, e);
      g.A = p.ycat + 768; g.Bt = p.WcT + (size_t)l * 1024 * 256; g.ldb = 256; g.K = 256; e.br = 2;
      pg8::gemm_phase(lds, g, S, e);
    }
    xcd_barrier(p.counters + 1024, xbw);
    {
      pg8::Gemm g; pg8::Order S;
      g.A = p.mbuf; g.Bt = p.WoT + (size_t)l * 1024 * 1024; g.lda = 1024; g.ldb = 1024; g.K = 1024;
      S.init(n_mt, 4, nb, bid);
      pg8::EpiOut e; e.xsrc = (l == 0 ? p.x : p.out); e.csrc = (l == 0 ? p.ctx : p.ctxs); e.xdst = p.out; e.cdst = p.ctxs;
      e.modl = p.mod + (size_t)l * 9 * 6144;
      pg8::gemm_phase(lds, g, S, e);
      for (int t = bid; t < 8192; t += nb) {
        if (t < 4096) cvt_chunk_fp8(p.peer_u + (size_t)l * 16384 * 1024, p.Ub, (size_t)t, 64.0f);
        else cvt_chunk_fp8(p.peer_v + (size_t)l * 16384 * 1024, p.Vb, (size_t)(t - 4096), 16.0f);
      }
    }
    xcd_barrier(p.counters + 1024, xbw);
    phase_norm(p, l, 1);
    xcd_barrier(p.counters + 1024, xbw);
    {
      pg8::Gemm g; pg8::Order S;
      g.A = p.xn; g.Bt = p.WqT + (size_t)l * 2048 * 1024; g.lda = 1024; g.ldb = 1024; g.K = 1024;
      S.init(n_mt, 8, nb, bid);
      pg8::EpiQ e; e.q = p.q;
      pg8::gemm_phase(lds, g, S, e);
    }
    xcd_barrier(p.counters + 1024, xbw);
    for (int task = bid; task < n_mt * 16; task += nb) peer_score_tile(p, l, task >> 4, task & 15, smem);
    xcd_barrier(p.counters + 1024, xbw);
    phase_peer_experts(p, l, true);
    xcd_barrier(p.counters + 1024, xbw);
  }
  phase_norm(p, 1, 2);
}

extern "C" void kernel_launch(void* const* d_in, const int* in_sizes, int n_in, void* d_out, int out_size, void* d_ws,
                              size_t ws_size, hipStream_t stream) {
  P p;
  memset(&p, 0, sizeof(p));
  const float** ins = (const float**)&p;
  for (int i = 0; i < 37; ++i) ins[i] = (const float*)d_in[i];
  p.out = (float*)d_out;
  char* w = (char*)d_ws;
  size_t off = 0;
  auto take = [&](size_t bytes) { char* r = w + off; off += (bytes + 255) & ~(size_t)255; return r; };
  p.counters = (unsigned*)take(32768);
  p.WinT = (u16*)take((size_t)2 * 2816 * 1024 * 2);
  p.WgT = (u16*)take((size_t)2 * 3072 * 1024 * 2);
  p.WaT = (u16*)take((size_t)2 * 1024 * 512 * 2);
  p.WbT = (u16*)take((size_t)2 * 1024 * 256 * 2);
  p.WcT = (u16*)take((size_t)2 * 1024 * 256 * 2);
  p.WoT = (u16*)take((size_t)2 * 1024 * 1024 * 2);
  p.WqT = (u16*)take((size_t)2 * 2048 * 1024 * 2);
  p.keysB = (u16*)take((size_t)2 * 16 * 16384 * 2);
  p.rgW = (u16*)take((size_t)2 * 16 * 4096 * 2);
  p.modpart = (float*)take((size_t)16 * 2 * 9 * 6144 * 4);
  p.mod = (float*)take((size_t)2 * 9 * 6144 * 4);
  p.hT = (float*)take((size_t)512 * 4096 * 4);
  p.hc = (float*)take((size_t)512 * 256 * 4);
  p.Kf = (float*)take((size_t)256 * 8192 * 8);
  p.xn = (u16*)take((size_t)NTOK * 1024 * 2);
  p.qk = (u16*)take((size_t)NTOK * 1024 * 2);
  p.mbuf = p.qk;
  p.vT = (u16*)take((size_t)8 * 512 * 4096 * 2);
  p.vTc = (u16*)take((size_t)8 * 512 * 256 * 2);
  p.hyT = (u16*)take((size_t)8 * 768 * 4096 * 2);
  p.hyTc = (u16*)take((size_t)8 * 768 * 256 * 2);
  p.rg = (u16*)take((size_t)NTOK * 512 * 2);
  p.ycat = (u16*)take((size_t)NTOK * 1024 * 2);
  p.Ub = (unsigned char*)p.ycat;
  p.Vb = p.Ub + (size_t)16384 * 1024;
  p.agg = (float*)take((size_t)8 * 2 * 68 * 256 * 8);
  p.ctxs = (float*)take((size_t)2048 * 1024 * 4);
  p.g8 = (unsigned char*)p.vT;
  p.q = p.qk;
  p.topk = (unsigned*)((char*)p.qk + (size_t)NTOK * 2048 * 2);
  if (off > ws_size) {
    fprintf(stderr, "workspace too small: need %zu have %zu\n", off, ws_size);
    return;
  }
  static int grid_blocks = 0;
  if (!grid_blocks) {
    int dev = 0, cus = 0, per_cu = 0;
    (void)hipGetDevice(&dev);
    (void)hipDeviceGetAttribute(&cus, hipDeviceAttributeMultiprocessorCount, dev);
    (void)hipOccupancyMaxActiveBlocksPerMultiprocessor(&per_cu, fwd_megakernel, NTHR, 0);
    if (per_cu > 1) per_cu = 1;
    grid_blocks = cus * per_cu;
  }
  (void)hipMemsetAsync(p.counters, 0, 32768, stream);
  void* args[] = {&p};
  hipError_t e = hipLaunchCooperativeKernel((void*)fwd_megakernel, dim3(grid_blocks), dim3(NTHR), args, 0, stream);
  if (e != hipSuccess) fprintf(stderr, "cooperative launch failed: %s (grid %d)\n", hipGetErrorString(e), grid_blocks);
}
```

```cpp
#include <hip/hip_runtime.h>
#include <hip/hip_cooperative_groups.h>
#include <cstdio>
#include <cstring>
namespace cg = cooperative_groups;

typedef unsigned short u16;
typedef __attribute__((ext_vector_type(8))) short bf16x8;
typedef __attribute__((ext_vector_type(16))) float f32x16;
typedef __attribute__((ext_vector_type(2))) float f32x2;

#define NLAT 32768
#define NTOK 34816
#define SMEM_BYTES 151552
#define NTHR 512
#ifndef DUP_1A
#define DUP_1A 1
#endif
#ifndef DUP_PREP
#define DUP_PREP 1
#endif
#ifndef DUP_2B
#define DUP_2B 1
#endif
#ifndef XRGA
#define XRGA 1
#endif
#ifndef REP_INPROJ
#define REP_INPROJ 1
#endif
#ifndef REP_GATE
#define REP_GATE 1
#endif
#ifndef REP_BRANCH
#define REP_BRANCH 1
#endif
#ifndef REP_Q
#define REP_Q 1
#endif
#ifndef REP_SCORE
#define REP_SCORE 1
#endif
#ifndef REP_1A
#define REP_1A 1
#endif
#ifndef REP_2B
#define REP_2B 1
#endif
#ifndef REP_KF
#define REP_KF 1
#endif
#ifndef DUP_GEMM
#define DUP_GEMM 1
#endif
#ifndef DUP_PEER
#define DUP_PEER 1
#endif
#ifndef DUP_MIX
#define DUP_MIX 1
#endif
#ifndef XRG
#define XRG 1
#endif
#ifndef XFFT
#define XFFT 1
#endif
#ifndef XATT
#define XATT 1
#endif

struct P {
  const float *x, *c, *ctx, *c_ctx, *norm_mix_g, *norm_ffn_g, *w_ada, *b_ada, *w_in, *na_rpb,
      *hy_short_w, *hy_short_b, *hy_f1_w, *hy_f1_b, *hy_f2_w, *hy_f2_b, *hy_f3_w, *hy_freq, *hy_bias,
      *rg_conv_w, *rg_conv_b, *rg_wa, *rg_ba, *rg_wx, *rg_bx, *rg_lambda,
      *w_gate, *b_gate, *w_br_a, *w_br_b, *w_br_c, *w_out, *peer_wq, *peer_keys, *peer_u, *peer_v, *final_g;
  float* out;
  unsigned* counters;
  u16 *WinT, *WgT, *WaT, *WbT, *WcT, *WoT, *WqT, *keysB, *rgW;
  float *modpart, *mod, *hT, *hc;
  float* Kf;
  u16 *xn, *qk, *vT, *vTc, *hyT, *hyTc, *rg, *ycat, *mbuf;
  unsigned char *Ub, *Vb, *g8;
  u16* q;
  float *agg, *ctxs;
  unsigned* topk;
};

__device__ __forceinline__ u16 f2bf(float f) {
  unsigned u = __float_as_uint(f);
  u += 0x7fffu + ((u >> 16) & 1u);
  return (u16)(u >> 16);
}
__device__ __forceinline__ float bf2f(u16 h) { return __uint_as_float(((unsigned)h) << 16); }
__device__ __forceinline__ unsigned pk2(float a, float b) { return (unsigned)f2bf(a) | ((unsigned)f2bf(b) << 16); }
__device__ __forceinline__ float bflo(unsigned u) { return __uint_as_float(u << 16); }
__device__ __forceinline__ float bfhi(unsigned u) { return __uint_as_float(u & 0xffff0000u); }
__device__ __forceinline__ int opaque_tid() {
  int t = threadIdx.x;
  asm volatile("" : "+v"(t));
  return t;
}
__device__ __forceinline__ int my_lane() { return opaque_tid() & 63; }
__device__ __forceinline__ float shx(float v, int o) { return __builtin_bit_cast(float, __builtin_amdgcn_ds_bpermute(((my_lane() ^ o) << 2), __builtin_bit_cast(int, v))); }
__device__ __forceinline__ float shf(float v, int src) { return __builtin_bit_cast(float, __builtin_amdgcn_ds_bpermute((src & 63) << 2, __builtin_bit_cast(int, v))); }
__device__ __forceinline__ unsigned shu(unsigned v, int src) { return (unsigned)__builtin_amdgcn_ds_bpermute((src & 63) << 2, (int)v); }
__device__ __forceinline__ float wave_sum(float v) {
  const int lane = my_lane();
#pragma unroll
  for (int o = 32; o > 0; o >>= 1) v += __builtin_bit_cast(float, __builtin_amdgcn_ds_bpermute((lane ^ o) << 2, __builtin_bit_cast(int, v)));
  return v;
}
__device__ __forceinline__ float wave_max(float v) {
  const int lane = my_lane();
#pragma unroll
  for (int o = 32; o > 0; o >>= 1) v = fmaxf(v, __builtin_bit_cast(float, __builtin_amdgcn_ds_bpermute((lane ^ o) << 2, __builtin_bit_cast(int, v))));
  return v;
}
__device__ __forceinline__ float sigmoidf_(float x) { return __builtin_amdgcn_rcpf(1.0f + __expf(-x)); }
__device__ __forceinline__ float gelu_tanh(float x) {
  const float u2 = 1.5957691216057308f * (x + 0.044715f * x * x * x);
  return x * __builtin_amdgcn_rcpf(1.0f + __expf(-u2));
}
__device__ __forceinline__ f32x16 mfma32(bf16x8 a, bf16x8 b, f32x16 c) {
  return __builtin_amdgcn_mfma_f32_32x32x16_bf16(a, b, c, 0, 0, 0);
}
__device__ __forceinline__ f32x16 zero16() {
  f32x16 z;
#pragma unroll
  for (int i = 0; i < 16; ++i) z[i] = 0.f;
  return z;
}
__device__ __forceinline__ int swz128(int row, int ch) { return row * 128 + ((ch ^ ((row >> 1) & 7)) << 4); }
__device__ __forceinline__ int swz256(int row, int ch) { return row * 256 + ((ch ^ (row & 15)) << 4); }

struct c2 { float x, y; };
__device__ __forceinline__ c2 cadd(c2 a, c2 b) { return {a.x + b.x, a.y + b.y}; }
__device__ __forceinline__ c2 csub(c2 a, c2 b) { return {a.x - b.x, a.y - b.y}; }
__device__ __forceinline__ c2 cmul(c2 a, c2 b) { return {a.x * b.x - a.y * b.y, a.x * b.y + a.y * b.x}; }
__device__ __forceinline__ float c16(int i) {
  const float tb[16] = {1.0f, 0.9238795325112867f, 0.7071067811865476f, 0.3826834323650898f, 0.0f,
                        -0.3826834323650898f, -0.7071067811865476f, -0.9238795325112867f, -1.0f,
                        -0.9238795325112867f, -0.7071067811865476f, -0.3826834323650898f, 0.0f,
                        0.3826834323650898f, 0.7071067811865476f, 0.9238795325112867f};
  return tb[i & 15];
}
__device__ __forceinline__ float s16(int i) { return c16(i + 12); }
template <int R> __device__ __forceinline__ constexpr int brev(int k) {
  int r = 0;
  for (int b = 1, o = R >> 1; b < R; b <<= 1, o >>= 1)
    if (k & b) r |= o;
  return r;
}
template <int R> __device__ __forceinline__ void dft_reg(c2* v, float sgn) {
#pragma unroll
  for (int h = R / 2; h >= 1; h >>= 1) {
#pragma unroll
    for (int g = 0; g < R; g += 2 * h) {
#pragma unroll
      for (int j = 0; j < h; ++j) {
        c2 a = v[g + j], b = v[g + j + h];
        v[g + j] = cadd(a, b);
        c2 d = csub(a, b);
        const int ti = j * (16 / (2 * h));
        c2 w = {c16(ti), sgn * s16(ti)};
        v[g + j + h] = (j == 0) ? d : cmul(d, w);
      }
    }
  }
}
template <int R> __device__ __forceinline__ int fft_bfly(c2* v, int j, int Ns, float sgn) {
  const int k = j & (Ns - 1);
  const float f = sgn * (float)k / (float)(Ns * R);
#pragma unroll
  for (int r = 1; r < R; ++r) {
    float t = f * (float)r;
    c2 w = {__builtin_amdgcn_cosf(t), __builtin_amdgcn_sinf(t)};
    v[r] = cmul(v[r], w);
  }
  dft_reg<R>(v, sgn);
  return (j - k) * R + k;
}
template <int R> __device__ __forceinline__ void fft_pass(c2* buf, int Ns, float sgn) {
  constexpr int NBF = 8192 / R;
  constexpr int PER = NBF / NTHR;
  const int tid = opaque_tid();
  c2 v[PER][R];
#pragma unroll
  for (int i = 0; i < PER; ++i) {
    const int j = tid + NTHR * i;
#pragma unroll
    for (int r = 0; r < R; ++r) v[i][r] = buf[j + r * NBF];
  }
  __syncthreads();
#pragma unroll
  for (int i = 0; i < PER; ++i) {
    const int j = tid + NTHR * i;
    const int base = fft_bfly<R>(v[i], j, Ns, sgn);
#pragma unroll
    for (int r = 0; r < R; ++r) buf[base + r * Ns] = v[i][brev<R>(r)];
  }
  __syncthreads();
}
__device__ __forceinline__ void fft8192(c2* buf, float sgn) {
  fft_pass<8>(buf, 1, sgn);
  fft_pass<8>(buf, 8, sgn);
  fft_pass<8>(buf, 64, sgn);
  fft_pass<16>(buf, 512, sgn);
}

__device__ __forceinline__ void gemm_kloop(f32x16 (&acc)[2][2], const u16* __restrict__ A, int lda,
                                           const u16* __restrict__ B, int ldb, int K, char* smem) {
  const int tid = opaque_tid(), lane = tid & 63, wid = tid >> 6;
  const int wm = wid >> 1, wn = wid & 1;
  const int l31 = lane & 31, hh = lane >> 5;
  uint4 ra[4], rb[2];
  const int nk = K >> 6;
  const int srow = tid >> 3, sch = tid & 7;
  const char* Ab = (const char*)A;
  const char* Bb = (const char*)B;
  const unsigned aoff = (unsigned)(srow * lda + sch * 8) * 2u;
  const unsigned boff = (unsigned)(srow * ldb + sch * 8) * 2u;
  const unsigned astep = (unsigned)lda * 128u, bstep = (unsigned)ldb * 128u;
#pragma unroll
  for (int i = 0; i < 4; ++i) ra[i] = *(const uint4*)(Ab + (aoff + i * astep));
#pragma unroll
  for (int i = 0; i < 2; ++i) rb[i] = *(const uint4*)(Bb + (boff + i * bstep));
#pragma unroll
  for (int i = 0; i < 4; ++i) *(uint4*)(smem + swz128(srow + i * 64, sch)) = ra[i];
#pragma unroll
  for (int i = 0; i < 2; ++i) *(uint4*)(smem + 65536 + swz128(srow + i * 64, sch)) = rb[i];
  __syncthreads();
  for (int kt = 0; kt < nk; ++kt) {
    const bool more = (kt + 1 < nk);
    if (more) {
      const unsigned ko = (unsigned)(kt + 1) * 128u;
#pragma unroll
      for (int i = 0; i < 4; ++i) ra[i] = *(const uint4*)(Ab + (aoff + i * astep + ko));
#pragma unroll
      for (int i = 0; i < 2; ++i) rb[i] = *(const uint4*)(Bb + (boff + i * bstep + ko));
    }
    const char* as = smem + (kt & 1) * 32768;
    const char* bs = smem + 65536 + (kt & 1) * 16384;
    int lrow = l31;
    asm volatile("" : "+v"(lrow));
#pragma unroll
    for (int s = 0; s < 4; ++s) {
      bf16x8 af[2], bfr[2];
#pragma unroll
      for (int i = 0; i < 2; ++i) af[i] = *(const bf16x8*)(as + swz128(wm * 64 + i * 32 + lrow, s * 2 + hh));
#pragma unroll
      for (int j = 0; j < 2; ++j) bfr[j] = *(const bf16x8*)(bs + swz128(wn * 64 + j * 32 + lrow, s * 2 + hh));
#pragma unroll
      for (int i = 0; i < 2; ++i)
#pragma unroll
        for (int j = 0; j < 2; ++j) acc[i][j] = mfma32(af[i], bfr[j], acc[i][j]);
    }
    if (more) {
      char* an = smem + ((kt + 1) & 1) * 32768;
      char* bn = smem + 65536 + ((kt + 1) & 1) * 16384;
      int sr2 = srow;
      asm volatile("" : "+v"(sr2));
#pragma unroll
      for (int i = 0; i < 4; ++i) *(uint4*)(an + swz128(sr2 + i * 64, sch)) = ra[i];
#pragma unroll
      for (int i = 0; i < 2; ++i) *(uint4*)(bn + swz128(sr2 + i * 64, sch)) = rb[i];
    }
    __syncthreads();
  }
}
__device__ __forceinline__ void zero_acc(f32x16 (&acc)[2][2]) {
#pragma unroll
  for (int i = 0; i < 2; ++i)
#pragma unroll
    for (int j = 0; j < 2; ++j) acc[i][j] = zero16();
}
#define EPI_ROW(i, e) (wm * 64 + (i)*32 + ((e)&3) + 8 * ((e) >> 2) + 4 * hh)
#define EPI_COL(j) (wn * 64 + (j)*32 + l31)
#define EPI_VARS                                                    \
  const int tid = opaque_tid(), lane = tid & 63, wid = tid >> 6;     \
  const int wm = wid >> 1, wn = wid & 1, l31 = lane & 31, hh = lane >> 5; \
  (void)tid; (void)wm; (void)wn; (void)l31; (void)hh;


namespace pg8 {
#define PG8_LAS __attribute__((address_space(3)))
typedef PG8_LAS unsigned char* PG8_LAS_T;
typedef float f32x4 __attribute__((ext_vector_type(4)));
typedef unsigned u32x4 __attribute__((ext_vector_type(4)));
constexpr int BM = 256, BK = 64, HALF = 128, HTB = HALF * BK * 2, STAGE_BYTES = 8 * HTB, NXCD = 8, WGM = 8;
__device__ __forceinline__ int lds_byte(int r, int c) { const int st = (r >> 4) * 2 + (c >> 5), rr = r & 15, cc = c & 31, ob = rr * 64 + cc * 2; return st * 1024 + (ob ^ (((ob >> 9) & 1) << 5)); }
__device__ __forceinline__ void stage_rc(int b, int& R, int& C) { const int st = b / 1024, sb = b % 1024, swz = sb ^ (((sb >> 9) & 1) << 5); R = (st >> 1) * 16 + swz / 64; C = (st & 1) * 32 + (swz % 64) / 2; }
__device__ __forceinline__ int perm32(int rho) { const int n = rho >> 4, i = rho & 15; return 8 * (i >> 2) + 4 * n + (i & 3); }
struct Unit { int pm, pn; };
struct Gemm { const u16* A; const u16* Bt; int lda, ldb, K; };
struct Order {
  int nM, nN, nwg, G, c, skip_from, skip_by;
  __device__ __forceinline__ void init(int nM_, int nN_, int G_, int c_, int sf = 1 << 30, int sb = 0) { nM = nM_; nN = nN_; nwg = nM * nN; G = G_; c = c_; skip_from = sf; skip_by = sb; }
  __device__ __forceinline__ bool next(int i, Unit& u) const {
    const long L = (long)i * G + c; if (L >= nwg) return false;
    int wgid = (int)L; { const int q = nwg / NXCD, r = nwg % NXCD, xcd = wgid % NXCD, off = wgid / NXCD; wgid = (xcd < r ? xcd * (q + 1) : r * (q + 1) + (xcd - r) * q) + off; }
    const int nig = WGM * nN, gid = wgid / nig, fm = gid * WGM, gsz = (nM - fm) < WGM ? (nM - fm) : WGM;
    u.pm = fm + ((wgid % nig) % gsz); u.pn = (wgid % nig) / gsz;
    if (u.pn >= skip_from) u.pn += skip_by;
    return true;
  }
};
template <class Epi>
__device__ __forceinline__ void gemm_phase(PG8_LAS unsigned char* lds, const Gemm g, const Order& S, const Epi& E) {
  const int tid = opaque_tid(), wid = __builtin_amdgcn_readfirstlane(tid >> 6), lane = tid & 63, wr = wid >> 2, wc = wid & 3, fr = lane & 15, fq = lane >> 4;
  const int K = g.K, nt = K / BK;
  unsigned voffA[2], voffB[2];
#pragma unroll
  for (int i = 0; i < 2; ++i) { int R, C; stage_rc(tid * 16 + i * 8192, R, C); const int Rb = Epi::PERM ? ((R & ~31) + perm32(R & 31)) : R;
    voffA[i] = (unsigned)(R * g.lda + C) * 2u; voffB[i] = (unsigned)(Rb * g.ldb + C) * 2u; }
  const size_t kstep = (size_t)(BK * 2);
  const size_t hstepA = (size_t)HALF * g.lda * 2, hstepB = (size_t)HALF * g.ldb * 2;
  const size_t tstepA = 2 * hstepA, tstepB = 2 * hstepB;
  const unsigned ldsw = (unsigned)wid * 1024u;
  const int aoff = lds_byte(wr * 64 + fr, fq * 8), boff = lds_byte(wc * 32 + fr, fq * 8);
#define PG8_SA(b, h) (((b) * 2 + (h)) * HTB)
#define PG8_SB(b, h) ((4 + (b) * 2 + (h)) * HTB)
#define PG8_STAGE(bufoff, gbase, voff) do { _Pragma("unroll") for (int _i = 0; _i < 2; ++_i) \
    __builtin_amdgcn_global_load_lds((const unsigned*)((const char*)(gbase) + (voff)[_i]), (PG8_LAS unsigned*)(lds + (bufoff) + ldsw + _i * 8192), 16, 0, 0); } while (0)
#define PG8_LDA(dst, b, h) do { _Pragma("unroll") for (int m = 0; m < 4; ++m) _Pragma("unroll") for (int k = 0; k < 2; ++k) dst[m][k] = *(const PG8_LAS bf16x8*)(lds + PG8_SA(b, h) + aoff + m * 2048 + k * 1024); } while (0)
#define PG8_LDB(dst, b, h) do { _Pragma("unroll") for (int n = 0; n < 2; ++n) _Pragma("unroll") for (int k = 0; k < 2; ++k) dst[n][k] = *(const PG8_LAS bf16x8*)(lds + PG8_SB(b, h) + boff + n * 2048 + k * 1024); } while (0)
#define PG8_MMA(ai, bj, At, Bt) do { __builtin_amdgcn_s_setprio(1); _Pragma("unroll") for (int m = 0; m < 4; ++m) _Pragma("unroll") for (int n = 0; n < 2; ++n) _Pragma("unroll") for (int k = 0; k < 2; ++k) \
    acc[ai][bj][m][n] = __builtin_amdgcn_mfma_f32_16x16x32_bf16(Bt[n][k], At[m][k], acc[ai][bj][m][n], 0, 0, 0); __builtin_amdgcn_s_setprio(0); } while (0)
#define PG8_WAIT_V(n) asm volatile("s_waitcnt vmcnt(" #n ")" ::: "memory")
#define PG8_WAIT_L(n) asm volatile("s_waitcnt lgkmcnt(" #n ")" ::: "memory")
#define PG8_BAR __builtin_amdgcn_s_barrier()
#define PG8_SCHED __builtin_amdgcn_sched_barrier(0)
  Unit cur, nxt; int ui = 0;
  if (!S.next(0, cur)) return;
  f32x4 acc[2][2][4][2];
#pragma unroll
  for (int a = 0; a < 2; ++a)
#pragma unroll
    for (int b = 0; b < 2; ++b)
#pragma unroll
      for (int m = 0; m < 4; ++m)
#pragma unroll
        for (int n = 0; n < 2; ++n) acc[a][b][m][n] = (f32x4){0.f, 0.f, 0.f, 0.f};
  bf16x8 At[4][2], B0[2][2], B1[2][2];
  const char* cA = (const char*)g.A + (size_t)cur.pm * tstepA; const char* cB = (const char*)g.Bt + (size_t)cur.pn * tstepB;
  PG8_STAGE(PG8_SB(0, 0), cB, voffB); PG8_STAGE(PG8_SA(0, 0), cA, voffA); PG8_STAGE(PG8_SB(0, 1), cB + hstepB, voffB); PG8_STAGE(PG8_SA(0, 1), cA + hstepA, voffA);
  if (wr == 1) PG8_BAR;
  PG8_WAIT_V(4); PG8_BAR;
  PG8_STAGE(PG8_SB(1, 0), cB + kstep, voffB); PG8_STAGE(PG8_SA(1, 0), cA + kstep, voffA); PG8_STAGE(PG8_SB(1, 1), cB + hstepB + kstep, voffB);
  PG8_WAIT_V(6); PG8_BAR;
  for (;;) {
    const bool has_next = S.next(ui + 1, nxt);
    const char* nA = has_next ? (const char*)g.A + (size_t)nxt.pm * tstepA : cA; const char* nB = has_next ? (const char*)g.Bt + (size_t)nxt.pn * tstepB : cB;
    for (int t = 0; t < nt; t += 2) {
      const bool last = (t == nt - 2);
      const char* a1 = cA + (size_t)(t + 1) * kstep;
      const char* a2 = last ? nA : cA + (size_t)(t + 2) * kstep; const char* b2 = last ? nB : cB + (size_t)(t + 2) * kstep;
      const char* a3 = a2 + kstep; const char* b3 = b2 + kstep;
      PG8_LDB(B0, 0, 0); PG8_SCHED; PG8_LDA(At, 0, 0); PG8_STAGE(PG8_SA(1, 1), a1 + hstepA, voffA);
      PG8_WAIT_L(8); PG8_BAR; PG8_WAIT_L(0); PG8_MMA(0, 0, At, B0); PG8_BAR; PG8_SCHED;
      PG8_LDB(B1, 0, 1); PG8_STAGE(PG8_SB(0, 0), b2, voffB);
      PG8_BAR; PG8_WAIT_L(0); PG8_MMA(0, 1, At, B1); PG8_BAR;
      PG8_LDA(At, 0, 1); PG8_STAGE(PG8_SA(0, 0), a2, voffA);
      PG8_BAR; PG8_WAIT_L(0); PG8_MMA(1, 0, At, B0); PG8_BAR; PG8_SCHED;
      PG8_STAGE(PG8_SB(0, 1), b2 + hstepB, voffB);
      PG8_WAIT_V(6); PG8_BAR; PG8_MMA(1, 1, At, B1); PG8_BAR;
      PG8_LDB(B0, 1, 0); PG8_SCHED; PG8_LDA(At, 1, 0); PG8_STAGE(PG8_SA(0, 1), a2 + hstepA, voffA);
      PG8_WAIT_L(8); PG8_BAR; PG8_WAIT_L(0); PG8_MMA(0, 0, At, B0); PG8_BAR; PG8_SCHED;
      PG8_LDB(B1, 1, 1); PG8_STAGE(PG8_SB(1, 0), b3, voffB);
      PG8_BAR; PG8_WAIT_L(0); PG8_MMA(0, 1, At, B1); PG8_BAR;
      PG8_LDA(At, 1, 1); PG8_STAGE(PG8_SA(1, 0), a3, voffA);
      PG8_BAR; PG8_WAIT_L(0); PG8_MMA(1, 0, At, B0); PG8_BAR; PG8_SCHED;
      PG8_STAGE(PG8_SB(1, 1), b3 + hstepB, voffB);
      PG8_WAIT_V(6); PG8_BAR; PG8_MMA(1, 1, At, B1); PG8_BAR;
    }
    E(acc, cur, wr, wc, fr, fq);
    if (!has_next) break;
#pragma unroll
    for (int a = 0; a < 2; ++a)
#pragma unroll
      for (int b = 0; b < 2; ++b)
#pragma unroll
        for (int m = 0; m < 4; ++m)
#pragma unroll
          for (int n = 0; n < 2; ++n) acc[a][b][m][n] = (f32x4){0.f, 0.f, 0.f, 0.f};
    cur = nxt; cA = nA; cB = nB; ++ui;
  }
  PG8_WAIT_V(0);
  if (wr == 0) PG8_BAR;
  PG8_BAR;
#undef PG8_SA
#undef PG8_SB
#undef PG8_STAGE
#undef PG8_LDA
#undef PG8_LDB
#undef PG8_MMA
#undef PG8_WAIT_V
#undef PG8_WAIT_L
#undef PG8_BAR
#undef PG8_SCHED
}
typedef const f32x4 (&AccRef)[2][2][4][2];
struct EpiInprojN {
  static constexpr bool PERM = true;
  u16* qk; u16* rg;
  __device__ __forceinline__ void operator()(AccRef acc, const Unit& u, int wr, int wc, int fr, int fq) const {
    const int row0 = u.pm * BM + wr * 64 + fr;
    u16* base; int ld, colt;
    if (u.pn < 4) { base = qk; ld = 1024; colt = u.pn * 256; } else { base = rg; ld = 512; colt = (u.pn - 9) * 256; }
    const int col0 = colt + wc * 32 + 8 * fq;
#pragma unroll
    for (int ai = 0; ai < 2; ++ai)
#pragma unroll
      for (int m = 0; m < 4; ++m) {
        u16* rowp = base + (size_t)(row0 + ai * HALF + m * 16) * ld + col0;
#pragma unroll
        for (int bj = 0; bj < 2; ++bj) {
          const f32x4 v0 = acc[ai][bj][m][0], v1 = acc[ai][bj][m][1];
          u32x4 w; w.x = pk2(v0[0], v0[1]); w.y = pk2(v0[2], v0[3]); w.z = pk2(v1[0], v1[1]); w.w = pk2(v1[2], v1[3]);
          *(u32x4*)(rowp + bj * HALF) = w;
        }
      }
  }
};
struct EpiInprojT {
  static constexpr bool PERM = true;
  u16 *vT, *vTc, *hyT, *hyTc;
  __device__ __forceinline__ void operator()(AccRef acc, const Unit& u, int wr, int wc, int fr, int fq) const {
    const bool isctx = (u.pn >= 128);
    const int b = isctx ? (u.pn - 128) : (u.pn >> 4);
    const int Lseg = isctx ? 256 : 4096, t0 = isctx ? 0 : (u.pn & 15) * 256;
    const bool isv = (u.pm < 2);
    const size_t boff = isv ? (isctx ? (size_t)16777216 : (size_t)0) : (isctx ? (size_t)(16777216 + 1048576 + 25165824) : (size_t)(16777216 + 1048576));
    u16* base = vT + boff;
    const int nc = isv ? 512 : 768;
    const int wrow0 = (isv ? u.pm : u.pm - 2) * BM + wr * 64 + fr;
    const int col0 = t0 + wc * 32 + 8 * fq;
#pragma unroll
    for (int ai = 0; ai < 2; ++ai)
#pragma unroll
      for (int m = 0; m < 4; ++m) {
        u16* rowp = base + ((size_t)(b * nc + wrow0 + ai * HALF + m * 16)) * Lseg + col0;
#pragma unroll
        for (int bj = 0; bj < 2; ++bj) {
          const f32x4 v0 = acc[ai][bj][m][0], v1 = acc[ai][bj][m][1];
          u32x4 w; w.x = pk2(v0[0], v0[1]); w.y = pk2(v0[2], v0[3]); w.z = pk2(v1[0], v1[1]); w.w = pk2(v1[2], v1[3]);
          *(u32x4*)(rowp + bj * HALF) = w;
        }
      }
  }
};
struct EpiGate {
  static constexpr bool PERM = true;
  unsigned char* g8; const float* bias;
  __device__ __forceinline__ void operator()(AccRef acc, const Unit& u, int wr, int wc, int fr, int fq) const {
    const int row0 = u.pm * BM + wr * 64 + fr;
    const int col0 = u.pn * BM + wc * 32 + 8 * fq;
#pragma unroll
    for (int bj = 0; bj < 2; ++bj) {
      const f32x4 b0 = *(const f32x4*)(bias + col0 + bj * HALF), b1 = *(const f32x4*)(bias + col0 + bj * HALF + 4);
#pragma unroll
      for (int ai = 0; ai < 2; ++ai)
#pragma unroll
        for (int m = 0; m < 4; ++m) {
          const f32x4 v0 = acc[ai][bj][m][0] + b0, v1 = acc[ai][bj][m][1] + b1;
          unsigned w0 = 0, w1 = 0;
#pragma unroll
          for (int k = 0; k < 4; ++k) {
            w0 |= (unsigned)(sigmoidf_(v0[k]) * 255.0f + 0.5f) << (8 * k);
            w1 |= (unsigned)(sigmoidf_(v1[k]) * 255.0f + 0.5f) << (8 * k);
          }
          *(uint2*)(g8 + (size_t)(row0 + ai * HALF + m * 16) * 3072 + col0 + bj * HALF) = make_uint2(w0, w1);
        }
    }
  }
};
struct EpiBranch {
  static constexpr bool PERM = true;
  u16* mbuf; const unsigned char* g8; int br;
  __device__ __forceinline__ void operator()(AccRef acc, const Unit& u, int wr, int wc, int fr, int fq) const {
    const int row0 = u.pm * BM + wr * 64 + fr;
    const int col0 = u.pn * BM + wc * 32 + 8 * fq;
#pragma unroll
    for (int ai = 0; ai < 2; ++ai)
#pragma unroll
      for (int m = 0; m < 4; ++m) {
        const size_t row = (size_t)(row0 + ai * HALF + m * 16);
#pragma unroll
        for (int bj = 0; bj < 2; ++bj) {
          const uint2 gq = *(const uint2*)(g8 + row * 3072 + br * 1024 + col0 + bj * HALF);
          u16* mp = mbuf + row * 1024 + col0 + bj * HALF;
          const f32x4 v0 = acc[ai][bj][m][0], v1 = acc[ai][bj][m][1];
          float r[8];
          r[0] = (float)(gq.x & 255u) * v0[0]; r[1] = (float)((gq.x >> 8) & 255u) * v0[1];
          r[2] = (float)((gq.x >> 16) & 255u) * v0[2]; r[3] = (float)(gq.x >> 24) * v0[3];
          r[4] = (float)(gq.y & 255u) * v1[0]; r[5] = (float)((gq.y >> 8) & 255u) * v1[1];
          r[6] = (float)((gq.y >> 16) & 255u) * v1[2]; r[7] = (float)(gq.y >> 24) * v1[3];
          u32x4 w;
          if (br == 0) {
            w.x = pk2(r[0] * (1.f / 255.f), r[1] * (1.f / 255.f)); w.y = pk2(r[2] * (1.f / 255.f), r[3] * (1.f / 255.f));
            w.z = pk2(r[4] * (1.f / 255.f), r[5] * (1.f / 255.f)); w.w = pk2(r[6] * (1.f / 255.f), r[7] * (1.f / 255.f));
          } else {
            const u32x4 o = *(const u32x4*)mp;
            w.x = pk2(bflo(o.x) + r[0] * (1.f / 255.f), bfhi(o.x) + r[1] * (1.f / 255.f));
            w.y = pk2(bflo(o.y) + r[2] * (1.f / 255.f), bfhi(o.y) + r[3] * (1.f / 255.f));
            w.z = pk2(bflo(o.z) + r[4] * (1.f / 255.f), bfhi(o.z) + r[5] * (1.f / 255.f));
            w.w = pk2(bflo(o.w) + r[6] * (1.f / 255.f), bfhi(o.w) + r[7] * (1.f / 255.f));
          }
          *(u32x4*)mp = w;
        }
      }
  }
};
struct EpiOut {
  static constexpr bool PERM = false;
  const float *xsrc, *csrc; float *xdst, *cdst; const float* modl;
  __device__ __forceinline__ void operator()(AccRef acc, const Unit& u, int wr, int wc, int fr, int fq) const {
    const bool isctx = (u.pm >= 128);
    const int bi = isctx ? 8 : (u.pm >> 4);
    const float* gatev = modl + ((size_t)bi * 6 + 2) * 1024;
    const float* src = isctx ? (csrc - (size_t)NLAT * 1024) : xsrc;
    float* dst = isctx ? (cdst - (size_t)NLAT * 1024) : xdst;
    const int row0 = u.pm * BM + wr * 64 + fr, col0 = u.pn * BM + wc * 32 + 4 * fq;
#pragma unroll
    for (int bj = 0; bj < 2; ++bj)
#pragma unroll
      for (int n = 0; n < 2; ++n) {
        const int col = col0 + bj * HALF + n * 16;
        const f32x4 gv = *(const f32x4*)(gatev + col);
#pragma unroll
        for (int ai = 0; ai < 2; ++ai)
#pragma unroll
          for (int m = 0; m < 4; ++m) {
            const size_t o = (size_t)(row0 + ai * HALF + m * 16) * 1024 + col;
            const f32x4 xv = *(const f32x4*)(src + o);
            *(f32x4*)(dst + o) = xv + gv * acc[ai][bj][m][n];
          }
      }
  }
};
struct EpiQ {
  static constexpr bool PERM = true;
  u16* q;
  __device__ __forceinline__ void operator()(AccRef acc, const Unit& u, int wr, int wc, int fr, int fq) const {
    const int row0 = u.pm * BM + wr * 64 + fr;
    const int col0 = u.pn * BM + wc * 32 + 8 * fq;
#pragma unroll
    for (int ai = 0; ai < 2; ++ai)
#pragma unroll
      for (int m = 0; m < 4; ++m) {
        u16* rowp = q + (size_t)(row0 + ai * HALF + m * 16) * 2048 + col0;
#pragma unroll
        for (int bj = 0; bj < 2; ++bj) {
          const f32x4 v0 = acc[ai][bj][m][0], v1 = acc[ai][bj][m][1];
          u32x4 w; w.x = pk2(v0[0], v0[1]); w.y = pk2(v0[2], v0[3]); w.z = pk2(v1[0], v1[1]); w.w = pk2(v1[2], v1[3]);
          *(u32x4*)(rowp + bj * HALF) = w;
        }
      }
  }
};
}

__device__ __forceinline__ void tr_tile(const float* __restrict__ src, int N, int K, u16* __restrict__ dst, int tile, char* smem) {
  float* lds = (float*)smem;
  const int tiles_n = N >> 6;
  const int tk = tile / tiles_n, tn = tile - tk * tiles_n;
  const int tid = opaque_tid();
  {
    const int r = tid >> 3, c8 = (tid & 7) * 8;
    const float* s = src + (size_t)(tk * 64 + r) * N + tn * 64 + c8;
    float4 a = *(const float4*)s, b = *(const float4*)(s + 4);
    float* d = lds + r * 65 + c8;
    d[0] = a.x; d[1] = a.y; d[2] = a.z; d[3] = a.w; d[4] = b.x; d[5] = b.y; d[6] = b.z; d[7] = b.w;
  }
  __syncthreads();
  {
    const int n = tid >> 3, k0 = (tid & 7) * 8;
    uint4 o;
    o.x = pk2(lds[(k0 + 0) * 65 + n], lds[(k0 + 1) * 65 + n]);
    o.y = pk2(lds[(k0 + 2) * 65 + n], lds[(k0 + 3) * 65 + n]);
    o.z = pk2(lds[(k0 + 4) * 65 + n], lds[(k0 + 5) * 65 + n]);
    o.w = pk2(lds[(k0 + 6) * 65 + n], lds[(k0 + 7) * 65 + n]);
    *(uint4*)(dst + (size_t)(tn * 64 + n) * K + tk * 64 + k0) = o;
  }
  __syncthreads();
}
__device__ __forceinline__ void cvt_chunk(const float* __restrict__ src, u16* __restrict__ dst, size_t chunk) {
  const size_t i = chunk * 4096 + (size_t)opaque_tid() * 8;
  float4 a = *(const float4*)(src + i), b = *(const float4*)(src + i + 4);
  uint4 o;
  o.x = pk2(a.x, a.y); o.y = pk2(a.z, a.w); o.z = pk2(b.x, b.y); o.w = pk2(b.z, b.w);
  *(uint4*)(dst + i) = o;
}
__device__ __forceinline__ void cvt_chunk_fp8(const float* __restrict__ src, unsigned char* __restrict__ dst, size_t chunk, float scale) {
  const size_t i = chunk * 4096 + (size_t)opaque_tid() * 8;
  const float4 a = *(const float4*)(src + i), b = *(const float4*)(src + i + 4);
  int w0 = __builtin_amdgcn_cvt_pk_fp8_f32(a.x * scale, a.y * scale, 0, false);
  w0 = __builtin_amdgcn_cvt_pk_fp8_f32(a.z * scale, a.w * scale, w0, true);
  int w1 = __builtin_amdgcn_cvt_pk_fp8_f32(b.x * scale, b.y * scale, 0, false);
  w1 = __builtin_amdgcn_cvt_pk_fp8_f32(b.z * scale, b.w * scale, w1, true);
  *(uint2*)(dst + i) = make_uint2((unsigned)w0, (unsigned)w1);
}
__device__ __forceinline__ void phase_prep(const P& p, char* smem) {
  const int tid = opaque_tid();
  const int NTR = 2512;
  const int total = 2 * NTR + 128 + 384;
  for (int task = blockIdx.x; task < total; task += gridDim.x) {
    if (task < 2 * NTR) {
      const int l = task / NTR;
      int t = task - l * NTR;
      if (t < 704) tr_tile(p.w_in + (size_t)l * 1024 * 2816, 2816, 1024, p.WinT + (size_t)l * 2816 * 1024, t, smem);
      else if ((t -= 704) < 768) tr_tile(p.w_gate + (size_t)l * 1024 * 3072, 3072, 1024, p.WgT + (size_t)l * 3072 * 1024, t, smem);
      else if ((t -= 768) < 128) tr_tile(p.w_br_a + (size_t)l * 512 * 1024, 1024, 512, p.WaT + (size_t)l * 1024 * 512, t, smem);
      else if ((t -= 128) < 64) tr_tile(p.w_br_b + (size_t)l * 256 * 1024, 1024, 256, p.WbT + (size_t)l * 1024 * 256, t, smem);
      else if ((t -= 64) < 64) tr_tile(p.w_br_c + (size_t)l * 256 * 1024, 1024, 256, p.WcT + (size_t)l * 1024 * 256, t, smem);
      else if ((t -= 64) < 256) tr_tile(p.w_out + (size_t)l * 1024 * 1024, 1024, 1024, p.WoT + (size_t)l * 1024 * 1024, t, smem);
      else if ((t -= 256) < 512) tr_tile(p.peer_wq + (size_t)l * 1024 * 2048, 2048, 1024, p.WqT + (size_t)l * 2048 * 1024, t, smem);
      else {
        t -= 512;
        const int gate = t >> 3, dn = t & 7;
        const float* src = (gate ? p.rg_wx : p.rg_wa) + (size_t)(l * 8 + dn) * 4096;
        tr_tile(src, 64, 64, p.rgW + (size_t)((l * 2 + gate) * 8 + dn) * 4096, 0, smem);
      }
    } else if (task < 2 * NTR + 128) {
      cvt_chunk(p.peer_keys, p.keysB, (size_t)(task - 2 * NTR));
    } else {
      int t = task - 2 * NTR - 128;
      const int kc = t & 15; t >>= 4;
      const int jc = t % 12, l = t / 12;
      float* s = (float*)smem;
      for (int i = tid; i < 576; i += NTHR) {
        const int bi = i >> 6, kk = i & 63;
        const float v = (bi < 8) ? p.c[bi * 1024 + kc * 64 + kk] : p.c_ctx[kc * 64 + kk];
        s[i] = v / (1.0f + __expf(-v));
      }
      __syncthreads();
      const int j = jc * 512 + tid;
      float acc[9];
#pragma unroll
      for (int bi = 0; bi < 9; ++bi) acc[bi] = 0.f;
      const float* wp = p.w_ada + ((size_t)l * 1024 + kc * 64) * 6144 + j;
#pragma unroll 8
      for (int kk = 0; kk < 64; ++kk) {
        const float w = wp[(size_t)kk * 6144];
#pragma unroll
        for (int bi = 0; bi < 9; ++bi) acc[bi] += s[bi * 64 + kk] * w;
      }
#pragma unroll
      for (int bi = 0; bi < 9; ++bi) p.modpart[((size_t)(kc * 2 + l) * 9 + bi) * 6144 + j] = acc[bi];
      __syncthreads();
    }
  }
}
__device__ __forceinline__ void phase_modreduce(const P& p) {
  const int n = 2 * 9 * 6144;
  for (int i = blockIdx.x * NTHR + opaque_tid(); i < n; i += gridDim.x * NTHR) {
    const int l = i / (9 * 6144);
    const int j = i % 6144;
    float s = p.b_ada[l * 6144 + j];
#pragma unroll
    for (int kc = 0; kc < 16; ++kc) s += p.modpart[(size_t)kc * n + i];
    p.mod[i] = s;
  }
}

__device__ __forceinline__ void phase_norm(const P& p, int l, int which) {
  const int tid_ = opaque_tid(); const int lane = tid_ & 63, wid = tid_ >> 6;
  const int ntok = (which == 2 || (which == 1 && l == 1)) ? NLAT : NTOK;
  for (int row = blockIdx.x * 8 + wid; row < ntok; row += gridDim.x * 8) {
    const float* src;
    if (row < NLAT) src = ((which == 0 && l == 0) ? p.x : p.out) + (size_t)row * 1024;
    else src = ((which == 0 && l == 0) ? p.ctx : p.ctxs) + (size_t)(row - NLAT) * 1024;
    float4 v[4];
    float ss = 0.f;
#pragma unroll
    for (int i = 0; i < 4; ++i) {
      v[i] = *(const float4*)(src + i * 256 + lane * 4);
      ss += v[i].x * v[i].x + v[i].y * v[i].y + v[i].z * v[i].z + v[i].w * v[i].w;
    }
    ss = wave_sum(ss);
    const float rstd = rsqrtf(ss * (1.0f / 1024.0f) + 1e-6f);
    if (which == 2) {
#pragma unroll
      for (int i = 0; i < 4; ++i) {
        const int col = i * 256 + lane * 4;
        const float4 g = *(const float4*)(p.final_g + col);
        float4 o = {v[i].x * rstd * g.x, v[i].y * rstd * g.y, v[i].z * rstd * g.z, v[i].w * rstd * g.w};
        *(float4*)(p.out + (size_t)row * 1024 + col) = o;
      }
    } else {
      const int bi = row < NLAT ? (row >> 12) : 8;
      const float* gam = (which == 0 ? p.norm_mix_g : p.norm_ffn_g) + l * 1024;
      const float* msh = p.mod + ((size_t)(l * 9 + bi) * 6 + (which == 0 ? 0 : 3)) * 1024;
      const float* msc = msh + 1024;
#pragma unroll
      for (int i = 0; i < 4; ++i) {
        const int col = i * 256 + lane * 4;
        const float4 g = *(const float4*)(gam + col);
        const float4 sh = *(const float4*)(msh + col);
        const float4 sc = *(const float4*)(msc + col);
        uint2 o;
        o.x = pk2(v[i].x * rstd * g.x * (1.f + sc.x) + sh.x, v[i].y * rstd * g.y * (1.f + sc.y) + sh.y);
        o.y = pk2(v[i].z * rstd * g.z * (1.f + sc.z) + sh.z, v[i].w * rstd * g.w * (1.f + sc.w) + sh.w);
        *(uint2*)(p.xn + (size_t)row * 1024 + col) = o;
      }
    }
  }
}

__device__ __forceinline__ void filter_wave(const P& p, int l, int L, int t, float* __restrict__ outp) {
  const int lane = opaque_tid() & 63;
  const float tl = (float)t / (float)(L - 1);
  const float wang = (6.283185307179586f / (float)L) * (float)t;
  float z = 0.f;
  if (lane == 0) z = tl;
  else if (lane <= 16) { const float band = 1e-4f + (float)(lane - 1) * ((15.0f - 1e-4f) / 15.0f); z = cosf(band * wang); }
  else if (lane <= 32) { const float band = 1e-4f + (float)(lane - 17) * ((15.0f - 1e-4f) / 15.0f); z = -sinf(band * wang); }
  float a1 = p.hy_f1_b[l * 64 + lane];
  for (int i = 0; i < 33; ++i) a1 += shf(z, i) * p.hy_f1_w[(l * 33 + i) * 64 + lane];
  const float h1 = sinf(p.hy_freq[l * 128 + lane] * a1);
  float a2 = p.hy_f2_b[l * 64 + lane];
  for (int i = 0; i < 64; ++i) a2 += shf(h1, i) * p.hy_f2_w[(l * 64 + i) * 64 + lane];
  const float h2 = sinf(p.hy_freq[l * 128 + 64 + lane] * a2);
  float a3[8];
#pragma unroll
  for (int m = 0; m < 8; ++m) a3[m] = 0.f;
  for (int i = 0; i < 64; ++i) {
    const float hv = shf(h2, i);
    const float* wr = p.hy_f3_w + (size_t)(l * 64 + i) * 512 + lane;
#pragma unroll
    for (int m = 0; m < 8; ++m) a3[m] += hv * wr[m * 64];
  }
  const float LN100 = 4.605170185988092f;
  const float d0 = LN100 / 1.5f, d1 = LN100 / 0.3f;
#pragma unroll
  for (int m = 0; m < 8; ++m) {
    const int cp = lane + 64 * m;
    const int ch = cp & 255;
    const float delta = d0 + (float)ch * ((d1 - d0) / 255.0f);
    outp[(size_t)cp * L + t] = a3[m] * expf(-tl * delta);
  }
}
__device__ __forceinline__ void phase_filters(const P& p, int l) {
  const int wid = opaque_tid() >> 6;
  const int ntask = 4096 + (l == 0 ? 256 : 0);
  for (int t = blockIdx.x * 8 + wid; t < ntask; t += gridDim.x * 8) {
    if (t < 4096) filter_wave(p, l, 4096, t, p.hT);
    else filter_wave(p, l, 256, t - 4096, p.hc);
  }
}
__device__ __forceinline__ void kf_task(const P& p, int c, char* smem) {
  c2* buf = (c2*)smem;
  const int tid = opaque_tid();
  for (int i = 0; i < 16; ++i) {
    const int j = tid + NTHR * i;
    float v;
    if (j < 4096) v = p.hT[(size_t)c * 4096 + j];
    else if (j == 4096) v = 0.f;
    else v = p.hT[(size_t)(256 + c) * 4096 + (8192 - j)];
    buf[j] = {v, 0.f};
  }
  __syncthreads();
  fft8192(buf, -1.f);
  c2* o = (c2*)p.Kf + (size_t)c * 8192;
  for (int i = 0; i < 16; ++i) { const int j = tid + NTHR * i; o[j] = buf[j]; }
  __syncthreads();
}

__device__ __forceinline__ void inproj_tile(const P& p, int l, int mt, int nt, char* smem) {
  f32x16 acc[2][2];
  zero_acc(acc);
  const int m0 = mt * 256, n0 = nt * 128;
  gemm_kloop(acc, p.xn + (size_t)m0 * 1024, 1024, p.WinT + ((size_t)l * 2816 + n0) * 1024, 1024, 1024, smem);
  EPI_VARS
  if (nt < 8 || nt >= 18) {
    u16* dst; int ld, cbase;
    if (nt < 8) { dst = p.qk; ld = 1024; cbase = n0; }
    else { dst = p.rg; ld = 512; cbase = n0 - 2304; }
#pragma unroll
    for (int i = 0; i < 2; ++i)
#pragma unroll
      for (int j = 0; j < 2; ++j)
#pragma unroll
        for (int e = 0; e < 16; ++e)
          dst[(size_t)(m0 + EPI_ROW(i, e)) * ld + cbase + EPI_COL(j)] = f2bf(acc[i][j][e]);
  } else {
#pragma unroll
    for (int i = 0; i < 2; ++i)
#pragma unroll
      for (int j = 0; j < 2; ++j)
#pragma unroll
        for (int qd = 0; qd < 4; ++qd) {
          uint2 o;
          o.x = pk2(acc[i][j][4 * qd + 0], acc[i][j][4 * qd + 1]);
          o.y = pk2(acc[i][j][4 * qd + 2], acc[i][j][4 * qd + 3]);
          const int row0 = wm * 64 + i * 32 + 8 * qd + 4 * hh;
          *(uint2*)(smem + EPI_COL(j) * 520 + row0 * 2) = o;
        }
    __syncthreads();
    u16* dstT; int Lseg, t0, ncol0, nc;
    const bool isctx = (mt >= 128);
    const int b = isctx ? (mt - 128) : (mt >> 4);
    if (nt < 12) { ncol0 = n0 - 1024; nc = 512; dstT = isctx ? p.vTc : p.vT; }
    else { ncol0 = n0 - 1536; nc = 768; dstT = isctx ? p.hyTc : p.hyT; }
    if (isctx) { Lseg = 256; t0 = 0; } else { Lseg = 4096; t0 = (mt & 15) * 256; }
#pragma unroll 4
    for (int it = 0; it < 16; ++it) {
      const int idx = tid + NTHR * it;
      const int col = idx >> 6, u = idx & 63;
      const uint2 v = *(const uint2*)(smem + col * 520 + u * 8);
      *(uint2*)(dstT + ((size_t)(b * nc + ncol0 + col)) * Lseg + t0 + u * 4) = v;
    }
    __syncthreads();
  }
}

__device__ __forceinline__ float ldbf(const u16* p, int t, int L) { return (t >= 0 && t < L) ? bf2f(p[t]) : 0.f; }
__device__ __forceinline__ void hyena_fft_task(const P& p, int l, int c, int bp, char* smem) {
  c2* buf = (c2*)smem;
  c2* ub = (c2*)(smem + 65536);
  const int tid = opaque_tid();
  const float* sw = p.hy_short_w + l * 3 * 768;
  const float* sb = p.hy_short_b + l * 768;
  const float wx0[3] = {sw[c], sw[768 + c], sw[1536 + c]};
  const float wx1[3] = {sw[256 + c], sw[768 + 256 + c], sw[1536 + 256 + c]};
  const float wv[3] = {sw[512 + c], sw[768 + 512 + c], sw[1536 + 512 + c]};
  const float bx0 = sb[c], bx1 = sb[256 + c], bv = sb[512 + c];
  const float dsk = p.hy_bias[l * 256 + c];
  for (int i = 0; i < 8; ++i) {
    const int t = tid + NTHR * i;
    float u[2];
#pragma unroll
    for (int bb = 0; bb < 2; ++bb) {
      const int b = 2 * bp + bb;
      const u16* x1 = p.hyT + ((size_t)(b * 768 + 256 + c)) * 4096;
      const u16* vv = p.hyT + ((size_t)(b * 768 + 512 + c)) * 4096;
      const float x1c = bx1 + wx1[0] * ldbf(x1, t - 1, 4096) + wx1[1] * ldbf(x1, t, 4096) + wx1[2] * ldbf(x1, t + 1, 4096);
      const float vc = bv + wv[0] * ldbf(vv, t - 1, 4096) + wv[1] * ldbf(vv, t, 4096) + wv[2] * ldbf(vv, t + 1, 4096);
      u[bb] = vc * x1c;
    }
    buf[t] = {u[0], u[1]};
    ub[t] = {u[0], u[1]};
    buf[t + 4096] = {0.f, 0.f};
  }
  __syncthreads();
  fft8192(buf, -1.f);
  const c2* kf = (const c2*)p.Kf + (size_t)c * 8192;
  for (int i = 0; i < 16; ++i) {
    const int k = tid + NTHR * i;
    buf[k] = cmul(buf[k], kf[k]);
  }
  __syncthreads();
  fft8192(buf, 1.f);
  for (int i = 0; i < 8; ++i) {
    const int t = tid + NTHR * i;
    const c2 y = buf[t];
    const c2 uu = ub[t];
#pragma unroll
    for (int bb = 0; bb < 2; ++bb) {
      const int b = 2 * bp + bb;
      const u16* x0 = p.hyT + ((size_t)(b * 768 + c)) * 4096;
      const float x0c = bx0 + wx0[0] * ldbf(x0, t - 1, 4096) + wx0[1] * ldbf(x0, t, 4096) + wx0[2] * ldbf(x0, t + 1, 4096);
      const float yy = ldexpf(bb ? y.y : y.x, -13);
      const float uv = bb ? uu.y : uu.x;
      p.ycat[(size_t)(b * 4096 + t) * 1024 + 512 + c] = f2bf(x0c * (yy + uv * dsk));
    }
  }
  __syncthreads();
}
__device__ __forceinline__ void hyena_ctx_task(const P& p, int l, int b, int cg8, char* smem) {
  const int tid_ = opaque_tid(); const int lane = tid_ & 63, wid = tid_ >> 6;
  const int c = cg8 * 8 + wid;
  float* us = (float*)smem + wid * 1024;
  float* kfp = us + 256 + 255;
  const float* sw = p.hy_short_w + l * 3 * 768;
  const float* sb = p.hy_short_b + l * 768;
  const u16* x0 = p.hyTc + ((size_t)(b * 768 + c)) * 256;
  const u16* x1 = p.hyTc + ((size_t)(b * 768 + 256 + c)) * 256;
  const u16* vv = p.hyTc + ((size_t)(b * 768 + 512 + c)) * 256;
  for (int i = 0; i < 4; ++i) {
    const int t = lane + 64 * i;
    const float x1c = sb[256 + c] + sw[256 + c] * ldbf(x1, t - 1, 256) + sw[768 + 256 + c] * ldbf(x1, t, 256) + sw[1536 + 256 + c] * ldbf(x1, t + 1, 256);
    const float vc = sb[512 + c] + sw[512 + c] * ldbf(vv, t - 1, 256) + sw[768 + 512 + c] * ldbf(vv, t, 256) + sw[1536 + 512 + c] * ldbf(vv, t + 1, 256);
    us[t] = vc * x1c;
    kfp[t] = p.hc[(size_t)c * 256 + t];
    if (t > 0) kfp[-t] = p.hc[(size_t)(256 + c) * 256 + t];
  }
  __syncthreads();
  const float dsk = p.hy_bias[l * 256 + c];
  float acc[4] = {0.f, 0.f, 0.f, 0.f};
  for (int s = 0; s < 256; ++s) {
    const float uv = us[s];
#pragma unroll
    for (int i = 0; i < 4; ++i) acc[i] += kfp[lane + 64 * i - s] * uv;
  }
#pragma unroll
  for (int i = 0; i < 4; ++i) {
    const int t = lane + 64 * i;
    const float x0c = sb[c] + sw[c] * ldbf(x0, t - 1, 256) + sw[768 + c] * ldbf(x0, t, 256) + sw[1536 + c] * ldbf(x0, t + 1, 256);
    p.ycat[(size_t)(NLAT + b * 256 + t) * 1024 + 512 + c] = f2bf(x0c * (acc[i] + us[t] * dsk));
  }
  __syncthreads();
}

__device__ __forceinline__ void rg_chunk_task(const P& p, int l, int cq, int nblk, int mode, bool last, char* smem) {
  const int tid = opaque_tid(), lane = tid & 63, wid = tid >> 6;
  const int l31 = lane & 31, hh = lane >> 5;
  const int b = cq / 68, rr = cq - b * 68;
  const int seg = rr < 4 ? 0 : 1, sub = rr < 4 ? rr : rr - 4;
  if (mode == 1 && seg == 0 && last) return;
  float* xcf = (float*)smem;
  char* xcb = smem + 16384;
  float* coef = (float*)(smem + 24576);
  float2* segagg = (float2*)(smem + 90112);
  float* hin = (float*)(smem + 94208);
  float* Hout = (float*)(smem + 94720);
  const int Lseg = seg ? 4096 : 256;
  const int tokbase = seg ? b * 4096 : NLAT + b * 256;
  const int T0 = sub * 64;
  const int tt = tid >> 3, c0 = (tid & 7) * 8;
  const int chb = nblk * 64 + c0;
  const int wdir = wid >> 2, wgate = (wid >> 1) & 1, wmt = wid & 1;
  bf16x8 wf[2][4];
  {
    const u16* wp = p.rgW + (size_t)(((l * 2 + wgate) * 2 + wdir) * 4 + nblk) * 4096 + l31 * 64 + 8 * hh;
#pragma unroll
    for (int nt = 0; nt < 2; ++nt)
#pragma unroll
      for (int s = 0; s < 4; ++s) wf[nt][s] = *(const bf16x8*)(wp + nt * 2048 + 16 * s);
  }
  {
    float xc[8];
#pragma unroll
    for (int c = 0; c < 8; ++c) xc[c] = p.rg_conv_b[l * 256 + chb + c];
#pragma unroll
    for (int k = 0; k < 4; ++k) {
      const int pos = T0 + tt + k - 2;
      if (pos >= 0 && pos < Lseg) {
        const uint4 raw = *(const uint4*)(p.rg + (size_t)(tokbase + pos) * 512 + chb);
        const float4 w0 = *(const float4*)(p.rg_conv_w + (l * 4 + k) * 256 + chb);
        const float4 w1 = *(const float4*)(p.rg_conv_w + (l * 4 + k) * 256 + chb + 4);
        xc[0] += w0.x * bflo(raw.x); xc[1] += w0.y * bfhi(raw.x);
        xc[2] += w0.z * bflo(raw.y); xc[3] += w0.w * bfhi(raw.y);
        xc[4] += w1.x * bflo(raw.z); xc[5] += w1.y * bfhi(raw.z);
        xc[6] += w1.z * bflo(raw.w); xc[7] += w1.w * bfhi(raw.w);
      }
    }
    *(float4*)(xcf + tt * 64 + c0) = make_float4(xc[0], xc[1], xc[2], xc[3]);
    *(float4*)(xcf + tt * 64 + c0 + 4) = make_float4(xc[4], xc[5], xc[6], xc[7]);
    uint4 o;
    o.x = pk2(xc[0], xc[1]); o.y = pk2(xc[2], xc[3]); o.z = pk2(xc[4], xc[5]); o.w = pk2(xc[6], xc[7]);
    *(uint4*)(xcb + swz128(tt, tid & 7)) = o;
  }
  __syncthreads();
  {
    f32x16 acc0 = zero16(), acc1 = zero16();
#pragma unroll
    for (int s = 0; s < 4; ++s) {
      const bf16x8 af = *(const bf16x8*)(xcb + swz128(wmt * 32 + l31, 2 * s + hh));
      acc0 = mfma32(af, wf[0][s], acc0);
      acc1 = mfma32(af, wf[1][s], acc1);
    }
    float* cp = coef + (wdir * 2 + wgate) * 4096;
#pragma unroll
    for (int e = 0; e < 16; ++e) {
      const int tok = wmt * 32 + (e & 3) + 8 * (e >> 2) + 4 * hh;
      cp[tok * 64 + l31] = acc0[e];
      cp[tok * 64 + 32 + l31] = acc1[e];
    }
  }
  __syncthreads();
#pragma unroll
  for (int dir = 0; dir < 2; ++dir) {
    float* ca = coef + (dir * 2) * 4096;
    float* cb2 = ca + 4096;
#pragma unroll
    for (int c = 0; c < 8; ++c) {
      const int ch = (l * 2 + dir) * 256 + chb + c;
      const float sp = __logf(1.0f + __expf(-p.rg_lambda[ch]));
      const int o = tt * 64 + c0 + c;
      const float r = sigmoidf_(ca[o] + p.rg_ba[ch]);
      const float ii = sigmoidf_(cb2[o] + p.rg_bx[ch]);
      const float la = -8.0f * r * sp;
      const float av = __expf(la);
      const float e2 = 2.0f * la;
      const float om = (e2 > -0.1f) ? (-e2 * (1.0f + e2 * (0.5f + e2 * (0.16666667f + e2 * 0.041666668f)))) : (1.0f - __expf(e2));
      ca[o] = av;
      cb2[o] = sqrtf(om) * ii * xcf[o];
    }
  }
  __syncthreads();
  const int sg = tid >> 7, sdir = (tid >> 6) & 1, sch = tid & 63;
  const float* sa = coef + (sdir * 2) * 4096 + sch;
  const float* sb = sa + 4096;
  {
    float Pm = 1.f, H = 0.f;
#pragma unroll
    for (int n = 0; n < 16; ++n) {
      const int tok = sdir ? (63 - (16 * sg + n)) : (16 * sg + n);
      const float av = sa[tok * 64], bv = sb[tok * 64];
      H = av * H + bv;
      Pm *= av;
    }
    segagg[(sg * 2 + sdir) * 64 + sch] = make_float2(Pm, H);
  }
  __syncthreads();
  const int pos = sdir ? (seg == 0 ? 3 - sub : 67 - sub) : (seg == 0 ? sub : 4 + sub);
  float2* aggp = (float2*)p.agg + ((size_t)(b * 2 + sdir) * 68) * 256 + nblk * 64 + sch;
  if (mode == 0) {
    if (tid < 128) {
      float A = 1.f, B = 0.f;
#pragma unroll
      for (int s2 = 0; s2 < 4; ++s2) {
        const float2 g = segagg[(s2 * 2 + sdir) * 64 + sch];
        B = g.x * B + g.y;
        A *= g.x;
      }
      aggp[(size_t)pos * 256] = make_float2(A, B);
    }
    __syncthreads();
    return;
  }
  if (tid < 128) {
    float h = 0.f;
    for (int j = 0; j < pos; ++j) {
      const float2 g = aggp[(size_t)j * 256];
      h = g.x * h + g.y;
    }
    hin[sdir * 64 + sch] = h;
  }
  __syncthreads();
  {
    float h = hin[sdir * 64 + sch];
    for (int s2 = 0; s2 < sg; ++s2) {
      const float2 g = segagg[(s2 * 2 + sdir) * 64 + sch];
      h = g.x * h + g.y;
    }
#pragma unroll
    for (int n = 0; n < 16; ++n) {
      const int tok = sdir ? (63 - (16 * sg + n)) : (16 * sg + n);
      h = sa[tok * 64] * h + sb[tok * 64];
      Hout[sdir * 4096 + tok * 64 + sch] = h;
    }
  }
  __syncthreads();
  {
    const size_t gtok = (size_t)tokbase + T0 + tt;
    const float4 f0 = *(const float4*)(Hout + tt * 64 + c0), f1 = *(const float4*)(Hout + tt * 64 + c0 + 4);
    const float4 h0 = *(const float4*)(Hout + 4096 + tt * 64 + c0), h1 = *(const float4*)(Hout + 4096 + tt * 64 + c0 + 4);
    const uint4 g = *(const uint4*)(p.rg + gtok * 512 + 256 + chb);
    uint4 o;
    o.x = pk2((f0.x + h0.x) * gelu_tanh(bflo(g.x)), (f0.y + h0.y) * gelu_tanh(bfhi(g.x)));
    o.y = pk2((f0.z + h0.z) * gelu_tanh(bflo(g.y)), (f0.w + h0.w) * gelu_tanh(bfhi(g.y)));
    o.z = pk2((f1.x + h1.x) * gelu_tanh(bflo(g.z)), (f1.y + h1.y) * gelu_tanh(bfhi(g.z)));
    o.w = pk2((f1.z + h1.z) * gelu_tanh(bflo(g.w)), (f1.w + h1.w) * gelu_tanh(bfhi(g.w)));
    *(uint4*)(p.ycat + gtok * 1024 + 768 + chb) = o;
  }
  __syncthreads();
}

__device__ __forceinline__ void attn_wave(const P& p, int l, int b, int h, bool local, int r, int half, int qtok0, const float* rpbL) {
  const int lane = opaque_tid() & 63, q = lane & 31, hh = lane >> 5;
  bf16x8 qf[4];
  {
    const u16* qp = p.qk + (size_t)(qtok0 + q) * 1024 + h * 64 + 8 * hh;
#pragma unroll
    for (int s = 0; s < 4; ++s) qf[s] = *(const bf16x8*)(qp + 16 * s);
  }
  f32x16 o0 = zero16(), o1 = zero16();
  float m_run = -1e30f, l_run = 0.f;
  const int pi = (q & 19) | ((q & 4) << 1) | ((q & 8) >> 1);
  const int w = half * 32 + q;
  const int st = min(max(w - 8, 0), 48);
  const int rs = min(max(r - 4, 0), 56);
  const int ntiles = local ? 24 : 8;
  for (int ti = 0; ti < ntiles; ++ti) {
    int ktok0, vstride, a = 0, g = 0;
    const u16* vb;
    if (ti < 8) {
      ktok0 = NLAT + b * 256 + ti * 32;
      vb = p.vTc + ((size_t)(b * 512 + h * 64)) * 256 + ti * 32;
      vstride = 256;
    } else {
      const int tl = ti - 8;
      a = tl >> 1; g = tl & 1;
      ktok0 = b * 4096 + (rs + a) * 64 + g * 32;
      vb = p.vT + ((size_t)(b * 512 + h * 64)) * 4096 + (rs + a) * 64 + g * 32;
      vstride = 4096;
    }
    bf16x8 kf[4], vf[2][2];
    {
      const u16* kp = p.qk + (size_t)(ktok0 + pi) * 1024 + 512 + h * 64 + 8 * hh;
#pragma unroll
      for (int s = 0; s < 4; ++s) kf[s] = *(const bf16x8*)(kp + 16 * s);
#pragma unroll
      for (int dt = 0; dt < 2; ++dt)
#pragma unroll
        for (int s2 = 0; s2 < 2; ++s2) vf[dt][s2] = *(const bf16x8*)(vb + (size_t)(dt * 32 + q) * vstride + 16 * s2 + 8 * hh);
    }
    f32x16 sacc = zero16();
#pragma unroll
    for (int s = 0; s < 4; ++s) sacc = mfma32(kf[s], qf[s], sacc);
    float sv[16];
    float tmax = -1e30f;
#pragma unroll
    for (int e = 0; e < 16; ++e) {
      float x = sacc[e] * 0.125f;
      if (ti >= 8) {
        const int kc = g * 32 + (e & 7) + 8 * hh + 16 * (e >> 3);
        const bool valid = (kc >= st) && (kc < st + 16);
        const int bi = valid ? ((rs + a - r + 7) * 31 + (kc - w + 15)) : 0;
        const float bias = rpbL[bi];
        x = valid ? (x + bias) : -1e30f;
      }
      sv[e] = x;
      tmax = fmaxf(tmax, x);
    }
    tmax = fmaxf(tmax, shx(tmax, 32));
    const float m_new = fmaxf(m_run, tmax);
    const float alpha = __expf(m_run - m_new);
    m_run = m_new;
    l_run *= alpha;
#pragma unroll
    for (int e = 0; e < 16; ++e) { o0[e] *= alpha; o1[e] *= alpha; }
    float psum = 0.f;
#pragma unroll
    for (int e = 0; e < 16; ++e) { const float pe = __expf(sv[e] - m_new); sv[e] = pe; psum += pe; }
    l_run += psum;
    bf16x8 pf[2];
#pragma unroll
    for (int s2 = 0; s2 < 2; ++s2) {
      union { bf16x8 v; unsigned u[4]; } cv;
#pragma unroll
      for (int j = 0; j < 4; ++j) cv.u[j] = pk2(sv[8 * s2 + 2 * j], sv[8 * s2 + 2 * j + 1]);
      pf[s2] = cv.v;
    }
#pragma unroll
    for (int s2 = 0; s2 < 2; ++s2) {
      o0 = mfma32(vf[0][s2], pf[s2], o0);
      o1 = mfma32(vf[1][s2], pf[s2], o1);
    }
  }
  const float lt = l_run + shx(l_run, 32);
  const float inv = 1.0f / lt;
  u16* op = p.ycat + (size_t)(qtok0 + q) * 1024 + h * 64;
#pragma unroll
  for (int qd = 0; qd < 4; ++qd) {
    uint2 a0, a1;
    a0.x = pk2(o0[4 * qd] * inv, o0[4 * qd + 1] * inv);
    a0.y = pk2(o0[4 * qd + 2] * inv, o0[4 * qd + 3] * inv);
    a1.x = pk2(o1[4 * qd] * inv, o1[4 * qd + 1] * inv);
    a1.y = pk2(o1[4 * qd + 2] * inv, o1[4 * qd + 3] * inv);
    *(uint2*)(op + 8 * qd + 4 * hh) = a0;
    *(uint2*)(op + 32 + 8 * qd + 4 * hh) = a1;
  }
}
__device__ __forceinline__ void attn_task(const P& p, int l, int kind, int idx, char* smem) {
  const int tid_ = opaque_tid(); const int lane = tid_ & 63, wid = tid_ >> 6;
  float* rpbL = (float*)smem + wid * 480;
  for (int i = lane; i < 465; i += 64) rpbL[i] = p.na_rpb[(size_t)(l * 8 + wid) * 465 + i];
  __syncthreads();
  if (kind == 0) {
    const int half = idx & 1, r = (idx >> 1) & 63, b = idx >> 7;
    attn_wave(p, l, b, wid, true, r, half, b * 4096 + r * 64 + half * 32, rpbL);
  } else {
    const int qg = idx & 7, b = idx >> 3;
    attn_wave(p, l, b, wid, false, 0, 0, NLAT + b * 256 + qg * 32, rpbL);
  }
  __syncthreads();
}

__device__ __forceinline__ void phase_mixers(const P& p, int l, char* smem, unsigned* counter) {
  const bool last = (l == 1);
  const int n_rg = 2176 * XRGA, n_fft = 1024 * XFFT, n_hc = last ? 0 : 256, n_att = 1024 * XATT, n_attc = last ? 0 : 64;
  const int total = n_rg + n_fft + n_hc + n_att + n_attc;
  volatile int* s_taskp = (volatile int*)(smem + SMEM_BYTES - 16);
  for (;;) {
    __syncthreads();
    if (threadIdx.x == 0) *s_taskp = (int)atomicAdd(counter, 1u);
    __syncthreads();
    int t = *s_taskp;
    if (t >= total) break;
    if (t < n_rg) { if (t >= 2176) t -= 2176; rg_chunk_task(p, l, t >> 2, t & 3, 0, last, smem); continue; }
    t -= n_rg;
    if (t < n_fft) { t &= 1023; hyena_fft_task(p, l, t >> 2, t & 3, smem); continue; }
    t -= n_fft;
    if (t < n_hc) { hyena_ctx_task(p, l, t >> 5, t & 31, smem); continue; }
    t -= n_hc;
    if (t < n_att) { t &= 1023; attn_task(p, l, 0, t, smem); continue; }
    t -= n_att;
    attn_task(p, l, 1, t, smem);
  }
}

__device__ __forceinline__ void merge_tile(const P& p, int l, int mt, int nt, char* smem) {
  EPI_VARS
  const int m0 = mt * 256, n0 = nt * 128;
  f32x16 macc[2][2];
  zero_acc(macc);
  for (int br = 0; br < 3; ++br) {
    unsigned* gpl = (unsigned*)(smem + 98304) + tid;
    {
      f32x16 acc[2][2];
      zero_acc(acc);
      gemm_kloop(acc, p.xn + (size_t)m0 * 1024, 1024, p.WgT + ((size_t)l * 3072 + br * 1024 + n0) * 1024, 1024, 1024, smem);
#pragma unroll
      for (int j = 0; j < 2; ++j) {
        const float bg = p.b_gate[l * 3072 + br * 1024 + n0 + EPI_COL(j)];
#pragma unroll
        for (int i = 0; i < 2; ++i)
#pragma unroll
          for (int e = 0; e < 4; ++e) {
            const unsigned q0 = (unsigned)(sigmoidf_(acc[i][j][4 * e] + bg) * 255.0f + 0.5f);
            const unsigned q1 = (unsigned)(sigmoidf_(acc[i][j][4 * e + 1] + bg) * 255.0f + 0.5f);
            const unsigned q2 = (unsigned)(sigmoidf_(acc[i][j][4 * e + 2] + bg) * 255.0f + 0.5f);
            const unsigned q3 = (unsigned)(sigmoidf_(acc[i][j][4 * e + 3] + bg) * 255.0f + 0.5f);
            gpl[((i * 2 + j) * 4 + e) * 512] = q0 | (q1 << 8) | (q2 << 16) | (q3 << 24);
          }
      }
    }
    {
      f32x16 acc[2][2];
      zero_acc(acc);
      const u16* A; const u16* B; int K;
      if (br == 0) { A = p.ycat + (size_t)m0 * 1024; B = p.WaT + ((size_t)l * 1024 + n0) * 512; K = 512; }
      else if (br == 1) { A = p.ycat + (size_t)m0 * 1024 + 512; B = p.WbT + ((size_t)l * 1024 + n0) * 256; K = 256; }
      else { A = p.ycat + (size_t)m0 * 1024 + 768; B = p.WcT + ((size_t)l * 1024 + n0) * 256; K = 256; }
      gemm_kloop(acc, A, 1024, B, K, K, smem);
#pragma unroll
      for (int i = 0; i < 2; ++i)
#pragma unroll
        for (int j = 0; j < 2; ++j)
#pragma unroll
          for (int e = 0; e < 4; ++e) {
            const unsigned g4 = gpl[((i * 2 + j) * 4 + e) * 512];
            macc[i][j][4 * e] += (float)(g4 & 255u) * (1.0f / 255.0f) * acc[i][j][4 * e];
            macc[i][j][4 * e + 1] += (float)((g4 >> 8) & 255u) * (1.0f / 255.0f) * acc[i][j][4 * e + 1];
            macc[i][j][4 * e + 2] += (float)((g4 >> 16) & 255u) * (1.0f / 255.0f) * acc[i][j][4 * e + 2];
            macc[i][j][4 * e + 3] += (float)(g4 >> 24) * (1.0f / 255.0f) * acc[i][j][4 * e + 3];
          }
    }
  }
#pragma unroll
  for (int i = 0; i < 2; ++i)
#pragma unroll
    for (int j = 0; j < 2; ++j)
#pragma unroll
      for (int e = 0; e < 16; ++e)
        p.mbuf[(size_t)(m0 + EPI_ROW(i, e)) * 1024 + n0 + EPI_COL(j)] = f2bf(macc[i][j][e]);
}
__device__ __forceinline__ void outproj_tile(const P& p, int l, int mt, int nt, char* smem, bool do_store) {
  EPI_VARS
  const int m0 = mt * 256, n0 = nt * 128;
  f32x16 acc[2][2];
  zero_acc(acc);
  gemm_kloop(acc, p.mbuf + (size_t)m0 * 1024, 1024, p.WoT + ((size_t)l * 1024 + n0) * 1024, 1024, 1024, smem);
  const bool isctx = (mt >= 128);
  const int bi = isctx ? 8 : (mt >> 4);
  const float* gatev = p.mod + ((size_t)(l * 9 + bi) * 6 + 2) * 1024;
  const float* src; float* dst;
  if (isctx) { src = (l == 0 ? p.ctx : p.ctxs) - (size_t)NLAT * 1024; dst = p.ctxs - (size_t)NLAT * 1024; }
  else { src = (l == 0 ? p.x : p.out); dst = p.out; }
#pragma unroll
  for (int j = 0; j < 2; ++j) {
    const int col = n0 + EPI_COL(j);
    const float gv = gatev[col];
#pragma unroll
    for (int i = 0; i < 2; ++i)
#pragma unroll
      for (int e = 0; e < 16; ++e) {
        const size_t o = (size_t)(m0 + EPI_ROW(i, e)) * 1024 + col;
        if (do_store) dst[o] = src[o] + gv * acc[i][j][e];
      }
  }
}

__device__ __forceinline__ void ins16(unsigned (&L)[16], unsigned x) {
#pragma unroll
  for (int i = 0; i < 16; ++i) {
    const unsigned hi = max(L[i], x);
    x = min(L[i], x);
    L[i] = hi;
  }
}
__device__ __forceinline__ unsigned f2sort(float f) {
  const unsigned b = __float_as_uint(f);
  return b ^ ((unsigned)((int)b >> 31) | 0x80000000u);
}
__device__ __forceinline__ float sort2f(unsigned k) {
  const unsigned u = k & ~127u;
  const unsigned b = (u & 0x80000000u) ? (u ^ 0x80000000u) : ~u;
  return __uint_as_float(b);
}
__device__ __forceinline__ void peer_score_tile(const P& p, int l, int mt, int hp, char* smem) {
  EPI_VARS
  const int m0 = mt * 256;
  f32x16 acc[2][2];
  zero_acc(acc);
  gemm_kloop(acc, p.q + (size_t)m0 * 2048 + hp * 128, 2048, p.keysB + ((size_t)l * 16 + hp) * 16384, 128, 128, smem);
  float* Sf = (float*)smem;
#pragma unroll
  for (int i = 0; i < 2; ++i)
#pragma unroll
    for (int j = 0; j < 2; ++j)
#pragma unroll
      for (int e = 0; e < 16; ++e) Sf[EPI_ROW(i, e) * 130 + EPI_COL(j)] = acc[i][j][e];
  __syncthreads();
  unsigned L[16];
#pragma unroll
  for (int i = 0; i < 16; ++i) L[i] = 0u;
  const int row = tid >> 1, hf = tid & 1;
  for (int i = 0; i < 64; ++i) {
    const int key = 2 * i + hf;
    const float v = Sf[row * 130 + key];
    ins16(L, (f2sort(v) & ~127u) | (unsigned)key);
  }
  unsigned* X = (unsigned*)(smem + 133120);
  if (hf) {
#pragma unroll
    for (int i = 0; i < 16; ++i) X[row * 16 + i] = L[i];
  }
  __syncthreads();
  if (!hf) {
#pragma unroll
    for (int i = 0; i < 16; ++i) ins16(L, X[row * 16 + i]);
    unsigned* o = p.topk + ((size_t)(m0 + row) * 16 + hp) * 16;
#pragma unroll
    for (int i = 0; i < 4; ++i) *(uint4*)(o + 4 * i) = make_uint4(L[4 * i], L[4 * i + 1], L[4 * i + 2], L[4 * i + 3]);
  }
  __syncthreads();
}

__device__ __forceinline__ void phase_peer_experts(const P& p, int l, bool do_store) {
  const int tid_ = opaque_tid(); const int lane = tid_ & 63, wid = tid_ >> 6;
  const int ntok = (l == 1) ? NLAT : NTOK;
  int ci, cj;
  {
    const int e = lane;
    if (e < 16) { ci = 0; cj = e; }
    else if (e < 24) { ci = 1; cj = e - 16; }
    else if (e < 29) { ci = 2; cj = e - 24; }
    else if (e < 33) { ci = 3; cj = e - 29; }
    else if (e < 36) { ci = 4; cj = e - 33; }
    else if (e < 38) { ci = 5; cj = e - 36; }
    else if (e < 40) { ci = 6; cj = e - 38; }
    else if (e < 42) { ci = 7; cj = e - 40; }
    else { ci = min(8 + (e - 42), 15); cj = 0; }
  }
  for (int tok = blockIdx.x * 8 + wid; tok < ntok; tok += gridDim.x * 8) {
    float xr[16];
    {
      const uint4 a = *(const uint4*)(p.xn + (size_t)tok * 1024 + lane * 16);
      const uint4 b = *(const uint4*)(p.xn + (size_t)tok * 1024 + lane * 16 + 8);
      xr[0] = bflo(a.x); xr[1] = bfhi(a.x); xr[2] = bflo(a.y); xr[3] = bfhi(a.y);
      xr[4] = bflo(a.z); xr[5] = bfhi(a.z); xr[6] = bflo(a.w); xr[7] = bfhi(a.w);
      xr[8] = bflo(b.x); xr[9] = bfhi(b.x); xr[10] = bflo(b.y); xr[11] = bfhi(b.y);
      xr[12] = bflo(b.z); xr[13] = bfhi(b.z); xr[14] = bflo(b.w); xr[15] = bfhi(b.w);
    }
    float yacc[16];
#pragma unroll
    for (int i = 0; i < 16; ++i) yacc[i] = 0.f;
    unsigned kvh[8];
#pragma unroll
    for (int h = 0; h < 8; ++h) kvh[h] = p.topk[((size_t)tok * 16 + 2 * h) * 16 + (lane & 31)];
    int eperm[8], gperm[8];
#pragma unroll
    for (int h = 0; h < 8; ++h) {
      const unsigned k0 = shu(kvh[h], ci);
      const unsigned k1 = shu(kvh[h], 16 + cj);
      const float val = (lane < 50) ? (sort2f(k0) + sort2f(k1)) : -3.0e38f;
      const int eidx = (int)((k0 & 127u) * 128u + (k1 & 127u));
      int cnt = 0;
#pragma unroll
      for (int e2 = 0; e2 < 50; ++e2) {
        const float v2 = __builtin_bit_cast(float, __builtin_amdgcn_readlane(__builtin_bit_cast(int, val), e2));
        cnt += (v2 > val || (v2 == val && e2 < lane)) ? 1 : 0;
      }
      const bool sel = (lane < 50) && (cnt < 16);
      const float mx = wave_max(sel ? val : -3.0e38f);
      const float ex = sel ? __expf(val - mx) : 0.f;
      const float sm = wave_sum(ex);
      const float gsel = ex / sm;
      const int dst4 = (sel ? cnt : 63) * 4;
      eperm[h] = __builtin_amdgcn_ds_permute(dst4, eidx);
      gperm[h] = __builtin_amdgcn_ds_permute(dst4, __builtin_bit_cast(int, gsel));
    }
    uint4 ua[8], va[8], ub[8], vb[8];
#define PEER_LOAD(U, V, H, IT) do { _Pragma("unroll") for (int k = 0; k < 8; ++k) { \
      const int id = __builtin_amdgcn_readlane(eperm[H], (IT) * 8 + k); \
      U[k] = *(const uint4*)(p.Ub + (size_t)id * 1024 + lane * 16); \
      V[k] = *(const uint4*)(p.Vb + (size_t)id * 1024 + lane * 16); } } while (0)
#define PEER_COMPUTE(U, V, H, IT) do { \
      float d[8]; \
      _Pragma("unroll") for (int k = 0; k < 8; ++k) { \
        const unsigned uw[4] = {U[k].x, U[k].y, U[k].z, U[k].w}; \
        float dd = 0.f; \
        _Pragma("unroll") for (int q4 = 0; q4 < 4; ++q4) { \
          const f32x2 lo = __builtin_amdgcn_cvt_pk_f32_fp8((int)uw[q4], false); \
          const f32x2 hi = __builtin_amdgcn_cvt_pk_f32_fp8((int)uw[q4], true); \
          dd += xr[4 * q4] * lo.x + xr[4 * q4 + 1] * lo.y + xr[4 * q4 + 2] * hi.x + xr[4 * q4 + 3] * hi.y; } \
        d[k] = dd; } \
      { const bool b5 = (lane & 32) != 0, b4 = (lane & 16) != 0, b3 = (lane & 8) != 0; \
        _Pragma("unroll") for (int j = 0; j < 4; ++j) { const float keep = b5 ? d[j + 4] : d[j], send = b5 ? d[j] : d[j + 4]; d[j] = keep + shx(send, 32); } \
        _Pragma("unroll") for (int j = 0; j < 2; ++j) { const float keep = b4 ? d[j + 2] : d[j], send = b4 ? d[j] : d[j + 2]; d[j] = keep + shx(send, 16); } \
        { const float keep = b3 ? d[1] : d[0], send = b3 ? d[0] : d[1]; d[0] = keep + shx(send, 8); } \
        d[0] += shx(d[0], 4); d[0] += shx(d[0], 2); d[0] += shx(d[0], 1); } \
      const float gl = __builtin_bit_cast(float, shu((unsigned)gperm[H], (IT) * 8 + ((lane >> 3) & 7))); \
      const float act = gelu_tanh(d[0] * (1.0f / 64.0f)) * gl; \
      _Pragma("unroll") for (int k = 0; k < 8; ++k) { \
        const float ak = __builtin_bit_cast(float, __builtin_amdgcn_readlane(__builtin_bit_cast(int, act), 8 * k)); \
        const unsigned vw[4] = {V[k].x, V[k].y, V[k].z, V[k].w}; \
        _Pragma("unroll") for (int q4 = 0; q4 < 4; ++q4) { \
          const f32x2 lo = __builtin_amdgcn_cvt_pk_f32_fp8((int)vw[q4], false); \
          const f32x2 hi = __builtin_amdgcn_cvt_pk_f32_fp8((int)vw[q4], true); \
          yacc[4 * q4] += ak * lo.x; yacc[4 * q4 + 1] += ak * lo.y; yacc[4 * q4 + 2] += ak * hi.x; yacc[4 * q4 + 3] += ak * hi.y; } } } while (0)
#pragma unroll
    for (int h = 0; h < 8; ++h) {
      PEER_LOAD(ua, va, h, 0);
      PEER_COMPUTE(ua, va, h, 0);
      PEER_LOAD(ub, vb, h, 1);
      PEER_COMPUTE(ub, vb, h, 1);
    }
#undef PEER_LOAD
#undef PEER_COMPUTE
    const int bi = tok < NLAT ? (tok >> 12) : 8;
    const float* gv = p.mod + ((size_t)(l * 9 + bi) * 6 + 5) * 1024 + lane * 16;
    float* xp = (tok < NLAT) ? (p.out + (size_t)tok * 1024) : (p.ctxs + (size_t)(tok - NLAT) * 1024);
    xp += lane * 16;
#pragma unroll
    for (int i = 0; i < 4; ++i) {
      float4 xv = *(float4*)(xp + 4 * i);
      const float4 g4 = *(const float4*)(gv + 4 * i);
      xv.x += g4.x * yacc[4 * i] * 0.0625f; xv.y += g4.y * yacc[4 * i + 1] * 0.0625f; xv.z += g4.z * yacc[4 * i + 2] * 0.0625f; xv.w += g4.w * yacc[4 * i + 3] * 0.0625f;
      if (do_store) *(float4*)(xp + 4 * i) = xv;
    }
  }
}


#define XB_TMO      128
#define XB_XCNT(j)  (256  + 64 * (j))
#define XB_XSUB(j)  (1280 + 64 * (j))
#define XB_XGEN(j)  (2304 + 64 * (j))
#define XB_TOP      3328
#define XB_TOPGEN   3392
#define XCD_BAR_WORDS 3456
#define XB_SPIN_CAP (1u << 22)
#define LAS __attribute__((address_space(3)))
__device__ __forceinline__ unsigned xb_ld(unsigned* p) { return __hip_atomic_load(p, __ATOMIC_RELAXED, __HIP_MEMORY_SCOPE_AGENT); }
__device__ __forceinline__ unsigned xb_add(unsigned* p, unsigned v) { return __hip_atomic_fetch_add(p, v, __ATOMIC_RELAXED, __HIP_MEMORY_SCOPE_AGENT); }
__device__ __forceinline__ unsigned xb_xcc_id() { return (unsigned)__builtin_amdgcn_s_getreg((3 << 11) | 20) & 0xFu; }
#define XB_SPIN(cond, bar) do { unsigned _sp = 0; while (cond) { __builtin_amdgcn_s_sleep(1); \
    if ((++_sp & 255u) == 0u) { if (xb_ld(&(bar)[XB_TMO])) break; if (_sp > XB_SPIN_CAP) { atomicAdd(&(bar)[XB_TMO], 1u); break; } } } } while (0)
struct XcdBarrier { unsigned* bar; unsigned x; volatile LAS unsigned* st; };
__device__ __forceinline__ XcdBarrier xcd_barrier_post(unsigned* bar, volatile LAS unsigned* st) {
  XcdBarrier b; b.bar = bar; b.x = xb_xcc_id(); b.st = st;
  if (threadIdx.x == 0) (void)xb_add(&bar[XB_XCNT(b.x)], 1u);
  return b;
}
__device__ __forceinline__ void xcd_barrier_complete(unsigned* bar, unsigned x, unsigned& nloc, unsigned& nx) {
  const unsigned G = gridDim.x * gridDim.y * gridDim.z;
  unsigned sum, cnt, mine, sp = 0u;
  for (;;) {
    sum = 0u; cnt = 0u; mine = 0u;
#pragma unroll
    for (unsigned j = 0; j < 16; ++j) { const unsigned c = xb_ld(&bar[XB_XCNT(j)]); sum += c; cnt += (c > 0u) ? 1u : 0u; mine = (j == x) ? c : mine; }
    if (sum == G) break;
    __builtin_amdgcn_s_sleep(1);
    if ((++sp & 255u) == 0u) { if (xb_ld(&bar[XB_TMO])) break; if (sp > XB_SPIN_CAP) { atomicAdd(&bar[XB_TMO], 1u); break; } }
  }
  nloc = mine > 0u ? mine : 1u; nx = cnt > 0u ? cnt : 1u;
}
__device__ __forceinline__ void xcd_barrier(unsigned* bar_u, volatile LAS unsigned* st_u) {
  XcdBarrier b; b.bar = bar_u; b.x = xb_xcc_id(); b.st = st_u;
  asm volatile("s_waitcnt vmcnt(0)" ::: "memory");
  __syncthreads();
  if (threadIdx.x == 0) {
    unsigned long long bp_ = (unsigned long long)b.bar;
    asm volatile("" : "+v"(bp_));
    unsigned* bar = (unsigned*)bp_;
    __builtin_amdgcn_s_waitcnt(0);
    unsigned nloc = b.st[0], nx = b.st[1];
    if (nloc == 0u) { xcd_barrier_complete(bar, b.x, nloc, nx); b.st[0] = nloc; b.st[1] = nx; }
    const unsigned old = xb_add(&bar[XB_XSUB(b.x)], 1u);
    const unsigned gen = old / nloc;
    if (old + 1u == (gen + 1u) * nloc) {
      __builtin_amdgcn_fence(__ATOMIC_RELEASE, "agent");
      asm volatile("s_waitcnt vmcnt(0)" ::: "memory");
      const unsigned og = xb_add(&bar[XB_TOP], 1u);
      const unsigned tg = og / nx;
      if (og + 1u == (tg + 1u) * nx) xb_add(&bar[XB_TOPGEN], 1u);
      else XB_SPIN(xb_ld(&bar[XB_TOPGEN]) == tg, bar);
      __builtin_amdgcn_fence(__ATOMIC_ACQUIRE, "agent");
      xb_add(&bar[XB_XGEN(b.x)], 1u);
      asm volatile("s_waitcnt vmcnt(0)" ::: "memory");
    } else {
      XB_SPIN(xb_ld(&bar[XB_XGEN(b.x)]) == gen, bar);
      __builtin_amdgcn_fence(__ATOMIC_ACQUIRE, "agent");
      asm volatile("s_waitcnt vmcnt(0)" ::: "memory");
    }
  }
  __syncthreads();
}

__global__ void __launch_bounds__(NTHR) fwd_megakernel(P p) {
  __shared__ __attribute__((aligned(16))) char smem[SMEM_BYTES];
  cg::grid_group grid = cg::this_grid();
  const int nb = gridDim.x, bid = blockIdx.x;
  pg8::PG8_LAS_T lds = (pg8::PG8_LAS_T)smem;
  volatile LAS unsigned* xbw = (volatile LAS unsigned*)(smem + SMEM_BYTES - 32);
  if (threadIdx.x == 0) { xbw[0] = 0u; xbw[1] = 0u; xbw[2] = 0u; xbw[3] = 0u; }
  __syncthreads();
  (void)xcd_barrier_post(p.counters + 1024, xbw);

  phase_prep(p, smem);
  grid.sync();
  phase_modreduce(p);
  xcd_barrier(p.counters + 1024, xbw);

  for (int l = 0; l < 2; ++l) {
    const bool last = (l == 1);
    const int n_mt = last ? 128 : 136;
_Pragma("unroll 1")
    for (int rep = 0; rep < REP_1A; ++rep) {
      phase_filters(p, l);
      phase_norm(p, l, 0);
    }
    xcd_barrier(p.counters + 1024, xbw);
_Pragma("unroll 1")
    for (int rep = 0; rep < REP_KF; ++rep)
      if (bid < 256) kf_task(p, bid, smem);
_Pragma("unroll 1")
    for (int rep = 0; rep < REP_INPROJ; ++rep) {
      pg8::Gemm g; pg8::Order S;
      g.A = p.xn; g.Bt = p.WinT + (size_t)l * 2816 * 1024; g.lda = 1024; g.ldb = 1024; g.K = 1024;
      S.init(136, 6, nb, bid, 4, 5);
      pg8::EpiInprojN e1; e1.qk = p.qk; e1.rg = p.rg;
      pg8::gemm_phase(lds, g, S, e1);
      g.A = p.WinT + ((size_t)l * 2816 + 1024) * 1024; g.Bt = p.xn;
      S.init(5, 136, nb, bid);
      pg8::EpiInprojT e2; e2.vT = p.vT; e2.vTc = p.vTc; e2.hyT = p.hyT; e2.hyTc = p.hyTc;
      pg8::gemm_phase(lds, g, S, e2);
    }
    xcd_barrier(p.counters + 1024, xbw);
    phase_mixers(p, l, smem, p.counters + l * 4);
    xcd_barrier(p.counters + 1024, xbw);
_Pragma("unroll 1")
    for (int rep = 0; rep < REP_2B; ++rep)
      for (int task = bid; task < 2176; task += nb) rg_chunk_task(p, l, task >> 2, task & 3, 1, last, smem);
    xcd_barrier(p.counters + 1024, xbw);
_Pragma("unroll 1")
    for (int rep = 0; rep < REP_GATE; ++rep) {
      pg8::Gemm g; pg8::Order S;
      g.A = p.xn; g.Bt = p.WgT + (size_t)l * 3072 * 1024; g.lda = 1024; g.ldb = 1024; g.K = 1024;
      S.init(n_mt, 12, nb, bid);
      pg8::EpiGate e; e.g8 = p.g8; e.bias = p.b_gate + l * 3072;
      pg8::gemm_phase(lds, g, S, e);
    }
    xcd_barrier(p.counters + 1024, xbw);
_Pragma("unroll 1")
    for (int rep = 0; rep < REP_BRANCH; ++rep) {
      pg8::Gemm g; pg8::Order S;
      S.init(n_mt, 4, nb, bid);
      pg8::EpiBranch e; e.mbuf = p.mbuf; e.g8 = p.g8;
      g.lda = 1024;
      g.A = p.ycat; g.Bt = p.WaT + (size_t)l * 1024 * 512; g.ldb = 512; g.K = 512; e.br = 0;
      pg8::gemm_phase(lds, g, S, e);
      g.A = p.ycat + 512; g.Bt = p.WbT + (size_t)l * 1024 * 256; g.ldb = 256; g.K = 256; e.br = 1;
      pg8::gemm_phase(lds, g, S, e);
      g.A = p.ycat + 768; g.Bt = p.WcT + (size_t)l * 1024 * 256; g.ldb = 256; g.K = 256; e.br = 2;
      pg8::gemm_phase(lds, g, S, e);
    }
    xcd_barrier(p.counters + 1024, xbw);
    {
      pg8::Gemm g; pg8::Order S;
      g.A = p.mbuf; g.Bt = p.WoT + (size_t)l * 1024 * 1024; g.lda = 1024; g.ldb = 1024; g.K = 1024;
      S.init(n_mt, 4, nb, bid);
      pg8::EpiOut e; e.xsrc = (l == 0 ? p.x : p.out); e.csrc = (l == 0 ? p.ctx : p.ctxs); e.xdst = p.out; e.cdst = p.ctxs;
      e.modl = p.mod + (size_t)l * 9 * 6144;
      pg8::gemm_phase(lds, g, S, e);
      for (int t = bid; t < 8192; t += nb) {
        if (t < 4096) cvt_chunk_fp8(p.peer_u + (size_t)l * 16384 * 1024, p.Ub, (size_t)t, 64.0f);
        else cvt_chunk_fp8(p.peer_v + (size_t)l * 16384 * 1024, p.Vb, (size_t)(t - 4096), 16.0f);
      }
    }
    xcd_barrier(p.counters + 1024, xbw);
    phase_norm(p, l, 1);
    xcd_barrier(p.counters + 1024, xbw);
_Pragma("unroll 1")
    for (int rep = 0; rep < REP_Q; ++rep) {
      pg8::Gemm g; pg8::Order S;
      g.A = p.xn; g.Bt = p.WqT + (size_t)l * 2048 * 1024; g.lda = 1024; g.ldb = 1024; g.K = 1024;
      S.init(n_mt, 8, nb, bid);
      pg8::EpiQ e; e.q = p.q;
      pg8::gemm_phase(lds, g, S, e);
    }
    xcd_barrier(p.counters + 1024, xbw);
_Pragma("unroll 1")
    for (int rep = 0; rep < REP_SCORE; ++rep)
      for (int task = bid; task < n_mt * 16; task += nb) peer_score_tile(p, l, task >> 4, task & 15, smem);
    xcd_barrier(p.counters + 1024, xbw);
    phase_peer_experts(p, l, true);
    xcd_barrier(p.counters + 1024, xbw);
  }
  phase_norm(p, 1, 2);
}

extern "C" void kernel_launch(void* const* d_in, const int* in_sizes, int n_in, void* d_out, int out_size, void* d_ws,
                              size_t ws_size, hipStream_t stream) {
  P p;
  memset(&p, 0, sizeof(p));
  const float** ins = (const float**)&p;
  for (int i = 0; i < 37; ++i) ins[i] = (const float*)d_in[i];
  p.out = (float*)d_out;
  char* w = (char*)d_ws;
  size_t off = 0;
  auto take = [&](size_t bytes) { char* r = w + off; off += (bytes + 255) & ~(size_t)255; return r; };
  p.counters = (unsigned*)take(32768);
  p.WinT = (u16*)take((size_t)2 * 2816 * 1024 * 2);
  p.WgT = (u16*)take((size_t)2 * 3072 * 1024 * 2);
  p.WaT = (u16*)take((size_t)2 * 1024 * 512 * 2);
  p.WbT = (u16*)take((size_t)2 * 1024 * 256 * 2);
  p.WcT = (u16*)take((size_t)2 * 1024 * 256 * 2);
  p.WoT = (u16*)take((size_t)2 * 1024 * 1024 * 2);
  p.WqT = (u16*)take((size_t)2 * 2048 * 1024 * 2);
  p.keysB = (u16*)take((size_t)2 * 16 * 16384 * 2);
  p.rgW = (u16*)take((size_t)2 * 16 * 4096 * 2);
  p.modpart = (float*)take((size_t)16 * 2 * 9 * 6144 * 4);
  p.mod = (float*)take((size_t)2 * 9 * 6144 * 4);
  p.hT = (float*)take((size_t)512 * 4096 * 4);
  p.hc = (float*)take((size_t)512 * 256 * 4);
  p.Kf = (float*)take((size_t)256 * 8192 * 8);
  p.xn = (u16*)take((size_t)NTOK * 1024 * 2);
  p.qk = (u16*)take((size_t)NTOK * 1024 * 2);
  p.mbuf = p.qk;
  p.vT = (u16*)take((size_t)8 * 512 * 4096 * 2);
  p.vTc = (u16*)take((size_t)8 * 512 * 256 * 2);
  p.hyT = (u16*)take((size_t)8 * 768 * 4096 * 2);
  p.hyTc = (u16*)take((size_t)8 * 768 * 256 * 2);
  p.rg = (u16*)take((size_t)NTOK * 512 * 2);
  p.ycat = (u16*)take((size_t)NTOK * 1024 * 2);
  p.Ub = (unsigned char*)p.ycat;
  p.Vb = p.Ub + (size_t)16384 * 1024;
  p.agg = (float*)take((size_t)8 * 2 * 68 * 256 * 8);
  p.ctxs = (float*)take((size_t)2048 * 1024 * 4);
  p.g8 = (unsigned char*)p.vT;
  p.q = p.qk;
  p.topk = (unsigned*)((char*)p.qk + (size_t)NTOK * 2048 * 2);
  if (off > ws_size) {
    fprintf(stderr, "workspace too small: need %zu have %zu\n", off, ws_size);
    return;
  }
  static int grid_blocks = 0;
  if (!grid_blocks) {
    int dev = 0, cus = 0, per_cu = 0;
    (void)hipGetDevice(&dev);
    (void)hipDeviceGetAttribute(&cus, hipDeviceAttributeMultiprocessorCount, dev);
    (void)hipOccupancyMaxActiveBlocksPerMultiprocessor(&per_cu, fwd_megakernel, NTHR, 0);
    if (per_cu > 1) per_cu = 1;
    grid_blocks = cus * per_cu;
  }
  (void)hipMemsetAsync(p.counters, 0, 32768, stream);
  void* args[] = {&p};
  hipError_t e = hipLaunchCooperativeKernel((void*)fwd_megakernel, dim3(grid_blocks), dim3(NTHR), args, 0, stream);
  if (e != hipSuccess) fprintf(stderr, "cooperative launch failed: %s (grid %d)\n", hipGetErrorString(e), grid_blocks);
}
```

```cpp
#include <hip/hip_runtime.h>
#include <hip/hip_cooperative_groups.h>
#include <cstdio>
#include <cstring>
namespace cg = cooperative_groups;

typedef unsigned short u16;
typedef __attribute__((ext_vector_type(8))) short bf16x8;
typedef __attribute__((ext_vector_type(16))) float f32x16;
typedef __attribute__((ext_vector_type(2))) float f32x2;

#define NLAT 32768
#define NTOK 34816
#define SMEM_BYTES 151552
#define NTHR 512
#ifndef DUP_1A
#define DUP_1A 1
#endif
#ifndef DUP_PREP
#define DUP_PREP 1
#endif
#ifndef DUP_2B
#define DUP_2B 1
#endif
#ifndef XRGA
#define XRGA 1
#endif
#ifndef REP_INPROJ
#define REP_INPROJ 1
#endif
#ifndef REP_GATE
#define REP_GATE 1
#endif
#ifndef REP_BRANCH
#define REP_BRANCH 1
#endif
#ifndef REP_Q
#define REP_Q 1
#endif
#ifndef REP_SCORE
#define REP_SCORE 1
#endif
#ifndef REP_1A
#define REP_1A 1
#endif
#ifndef REP_2B
#define REP_2B 1
#endif
#ifndef REP_KF
#define REP_KF 1
#endif
#ifndef DUP_GEMM
#define DUP_GEMM 1
#endif
#ifndef DUP_PEER
#define DUP_PEER 1
#endif
#ifndef DUP_MIX
#define DUP_MIX 1
#endif
#ifndef XRG
#define XRG 1
#endif
#ifndef XFFT
#define XFFT 1
#endif
#ifndef XATT
#define XATT 1
#endif

struct P {
  const float *x, *c, *ctx, *c_ctx, *norm_mix_g, *norm_ffn_g, *w_ada, *b_ada, *w_in, *na_rpb,
      *hy_short_w, *hy_short_b, *hy_f1_w, *hy_f1_b, *hy_f2_w, *hy_f2_b, *hy_f3_w, *hy_freq, *hy_bias,
      *rg_conv_w, *rg_conv_b, *rg_wa, *rg_ba, *rg_wx, *rg_bx, *rg_lambda,
      *w_gate, *b_gate, *w_br_a, *w_br_b, *w_br_c, *w_out, *peer_wq, *peer_keys, *peer_u, *peer_v, *final_g;
  float* out;
  unsigned* counters;
  u16 *WinT, *WgT, *WaT, *WbT, *WcT, *WoT, *WqT, *keysB, *rgW;
  float *modpart, *mod, *hT, *hc;
  float* Kf;
  u16 *xn, *qk, *vT, *vTc, *hyT, *hyTc, *rg, *ycat, *mbuf;
  unsigned char *Ub, *Vb, *g8;
  u16* q;
  float *agg, *ctxs;
  unsigned* topk;
};

__device__ __forceinline__ u16 f2bf(float f) {
  unsigned u = __float_as_uint(f);
  u += 0x7fffu + ((u >> 16) & 1u);
  return (u16)(u >> 16);
}
__device__ __forceinline__ float bf2f(u16 h) { return __uint_as_float(((unsigned)h) << 16); }
__device__ __forceinline__ unsigned pk2(float a, float b) { return (unsigned)f2bf(a) | ((unsigned)f2bf(b) << 16); }
__device__ __forceinline__ float bflo(unsigned u) { return __uint_as_float(u << 16); }
__device__ __forceinline__ float bfhi(unsigned u) { return __uint_as_float(u & 0xffff0000u); }
__device__ __forceinline__ int opaque_tid() {
  int t = threadIdx.x;
  asm volatile("" : "+v"(t));
  return t;
}
__device__ __forceinline__ int my_lane() { return opaque_tid() & 63; }
__device__ __forceinline__ float shx(float v, int o) { return __builtin_bit_cast(float, __builtin_amdgcn_ds_bpermute(((my_lane() ^ o) << 2), __builtin_bit_cast(int, v))); }
__device__ __forceinline__ float shf(float v, int src) { return __builtin_bit_cast(float, __builtin_amdgcn_ds_bpermute((src & 63) << 2, __builtin_bit_cast(int, v))); }
__device__ __forceinline__ unsigned shu(unsigned v, int src) { return (unsigned)__builtin_amdgcn_ds_bpermute((src & 63) << 2, (int)v); }
__device__ __forceinline__ float wave_sum(float v) {
  const int lane = my_lane();
#pragma unroll
  for (int o = 32; o > 0; o >>= 1) v += __builtin_bit_cast(float, __builtin_amdgcn_ds_bpermute((lane ^ o) << 2, __builtin_bit_cast(int, v)));
  return v;
}
__device__ __forceinline__ float wave_max(float v) {
  const int lane = my_lane();
#pragma unroll
  for (int o = 32; o > 0; o >>= 1) v = fmaxf(v, __builtin_bit_cast(float, __builtin_amdgcn_ds_bpermute((lane ^ o) << 2, __builtin_bit_cast(int, v))));
  return v;
}
__device__ __forceinline__ float sigmoidf_(float x) { return __builtin_amdgcn_rcpf(1.0f + __expf(-x)); }
__device__ __forceinline__ float gelu_tanh(float x) {
  const float u2 = 1.5957691216057308f * (x + 0.044715f * x * x * x);
  return x * __builtin_amdgcn_rcpf(1.0f + __expf(-u2));
}
__device__ __forceinline__ f32x16 mfma32(bf16x8 a, bf16x8 b, f32x16 c) {
  return __builtin_amdgcn_mfma_f32_32x32x16_bf16(a, b, c, 0, 0, 0);
}
__device__ __forceinline__ f32x16 zero16() {
  f32x16 z;
#pragma unroll
  for (int i = 0; i < 16; ++i) z[i] = 0.f;
  return z;
}
__device__ __forceinline__ int swz128(int row, int ch) { return row * 128 + ((ch ^ ((row >> 1) & 7)) << 4); }
__device__ __forceinline__ int swz256(int row, int ch) { return row * 256 + ((ch ^ (row & 15)) << 4); }

struct c2 { float x, y; };
__device__ __forceinline__ c2 cadd(c2 a, c2 b) { return {a.x + b.x, a.y + b.y}; }
__device__ __forceinline__ c2 csub(c2 a, c2 b) { return {a.x - b.x, a.y - b.y}; }
__device__ __forceinline__ c2 cmul(c2 a, c2 b) { return {a.x * b.x - a.y * b.y, a.x * b.y + a.y * b.x}; }
__device__ __forceinline__ float c16(int i) {
  const float tb[16] = {1.0f, 0.9238795325112867f, 0.7071067811865476f, 0.3826834323650898f, 0.0f,
                        -0.3826834323650898f, -0.7071067811865476f, -0.9238795325112867f, -1.0f,
                        -0.9238795325112867f, -0.7071067811865476f, -0.3826834323650898f, 0.0f,
                        0.3826834323650898f, 0.7071067811865476f, 0.9238795325112867f};
  return tb[i & 15];
}
__device__ __forceinline__ float s16(int i) { return c16(i + 12); }
template <int R> __device__ __forceinline__ constexpr int brev(int k) {
  int r = 0;
  for (int b = 1, o = R >> 1; b < R; b <<= 1, o >>= 1)
    if (k & b) r |= o;
  return r;
}
template <int R> __device__ __forceinline__ void dft_reg(c2* v, float sgn) {
#pragma unroll
  for (int h = R / 2; h >= 1; h >>= 1) {
#pragma unroll
    for (int g = 0; g < R; g += 2 * h) {
#pragma unroll
      for (int j = 0; j < h; ++j) {
        c2 a = v[g + j], b = v[g + j + h];
        v[g + j] = cadd(a, b);
        c2 d = csub(a, b);
        const int ti = j * (16 / (2 * h));
        c2 w = {c16(ti), sgn * s16(ti)};
        v[g + j + h] = (j == 0) ? d : cmul(d, w);
      }
    }
  }
}
template <int R> __device__ __forceinline__ int fft_bfly(c2* v, int j, int Ns, float sgn) {
  const int k = j & (Ns - 1);
  const float f = sgn * (float)k / (float)(Ns * R);
#pragma unroll
  for (int r = 1; r < R; ++r) {
    float t = f * (float)r;
    c2 w = {__builtin_amdgcn_cosf(t), __builtin_amdgcn_sinf(t)};
    v[r] = cmul(v[r], w);
  }
  dft_reg<R>(v, sgn);
  return (j - k) * R + k;
}
template <int R> __device__ __forceinline__ void fft_pass(c2* buf, int Ns, float sgn) {
  constexpr int NBF = 8192 / R;
  constexpr int PER = NBF / NTHR;
  const int tid = opaque_tid();
  c2 v[PER][R];
#pragma unroll
  for (int i = 0; i < PER; ++i) {
    const int j = tid + NTHR * i;
#pragma unroll
    for (int r = 0; r < R; ++r) v[i][r] = buf[j + r * NBF];
  }
  __syncthreads();
#pragma unroll
  for (int i = 0; i < PER; ++i) {
    const int j = tid + NTHR * i;
    const int base = fft_bfly<R>(v[i], j, Ns, sgn);
#pragma unroll
    for (int r = 0; r < R; ++r) buf[base + r * Ns] = v[i][brev<R>(r)];
  }
  __syncthreads();
}
__device__ __forceinline__ void fft8192(c2* buf, float sgn) {
  fft_pass<8>(buf, 1, sgn);
  fft_pass<8>(buf, 8, sgn);
  fft_pass<8>(buf, 64, sgn);
  fft_pass<16>(buf, 512, sgn);
}

__device__ __forceinline__ void gemm_kloop(f32x16 (&acc)[2][2], const u16* __restrict__ A, int lda,
                                           const u16* __restrict__ B, int ldb, int K, char* smem) {
  const int tid = opaque_tid(), lane = tid & 63, wid = tid >> 6;
  const int wm = wid >> 1, wn = wid & 1;
  const int l31 = lane & 31, hh = lane >> 5;
  uint4 ra[4], rb[2];
  const int nk = K >> 6;
  const int srow = tid >> 3, sch = tid & 7;
  const char* Ab = (const char*)A;
  const char* Bb = (const char*)B;
  const unsigned aoff = (unsigned)(srow * lda + sch * 8) * 2u;
  const unsigned boff = (unsigned)(srow * ldb + sch * 8) * 2u;
  const unsigned astep = (unsigned)lda * 128u, bstep = (unsigned)ldb * 128u;
#pragma unroll
  for (int i = 0; i < 4; ++i) ra[i] = *(const uint4*)(Ab + (aoff + i * astep));
#pragma unroll
  for (int i = 0; i < 2; ++i) rb[i] = *(const uint4*)(Bb + (boff + i * bstep));
#pragma unroll
  for (int i = 0; i < 4; ++i) *(uint4*)(smem + swz128(srow + i * 64, sch)) = ra[i];
#pragma unroll
  for (int i = 0; i < 2; ++i) *(uint4*)(smem + 65536 + swz128(srow + i * 64, sch)) = rb[i];
  __syncthreads();
  for (int kt = 0; kt < nk; ++kt) {
    const bool more = (kt + 1 < nk);
    if (more) {
      const unsigned ko = (unsigned)(kt + 1) * 128u;
#pragma unroll
      for (int i = 0; i < 4; ++i) ra[i] = *(const uint4*)(Ab + (aoff + i * astep + ko));
#pragma unroll
      for (int i = 0; i < 2; ++i) rb[i] = *(const uint4*)(Bb + (boff + i * bstep + ko));
    }
    const char* as = smem + (kt & 1) * 32768;
    const char* bs = smem + 65536 + (kt & 1) * 16384;
    int lrow = l31;
    asm volatile("" : "+v"(lrow));
#pragma unroll
    for (int s = 0; s < 4; ++s) {
      bf16x8 af[2], bfr[2];
#pragma unroll
      for (int i = 0; i < 2; ++i) af[i] = *(const bf16x8*)(as + swz128(wm * 64 + i * 32 + lrow, s * 2 + hh));
#pragma unroll
      for (int j = 0; j < 2; ++j) bfr[j] = *(const bf16x8*)(bs + swz128(wn * 64 + j * 32 + lrow, s * 2 + hh));
#pragma unroll
      for (int i = 0; i < 2; ++i)
#pragma unroll
        for (int j = 0; j < 2; ++j) acc[i][j] = mfma32(af[i], bfr[j], acc[i][j]);
    }
    if (more) {
      char* an = smem + ((kt + 1) & 1) * 32768;
      char* bn = smem + 65536 + ((kt + 1) & 1) * 16384;
      int sr2 = srow;
      asm volatile("" : "+v"(sr2));
#pragma unroll
      for (int i = 0; i < 4; ++i) *(uint4*)(an + swz128(sr2 + i * 64, sch)) = ra[i];
#pragma unroll
      for (int i = 0; i < 2; ++i) *(uint4*)(bn + swz128(sr2 + i * 64, sch)) = rb[i];
    }
    __syncthreads();
  }
}
__device__ __forceinline__ void zero_acc(f32x16 (&acc)[2][2]) {
#pragma unroll
  for (int i = 0; i < 2; ++i)
#pragma unroll
    for (int j = 0; j < 2; ++j) acc[i][j] = zero16();
}
#define EPI_ROW(i, e) (wm * 64 + (i)*32 + ((e)&3) + 8 * ((e) >> 2) + 4 * hh)
#define EPI_COL(j) (wn * 64 + (j)*32 + l31)
#define EPI_VARS                                                    \
  const int tid = opaque_tid(), lane = tid & 63, wid = tid >> 6;     \
  const int wm = wid >> 1, wn = wid & 1, l31 = lane & 31, hh = lane >> 5; \
  (void)tid; (void)wm; (void)wn; (void)l31; (void)hh;


namespace pg8 {
#define PG8_LAS __attribute__((address_space(3)))
typedef PG8_LAS unsigned char* PG8_LAS_T;
typedef float f32x4 __attribute__((ext_vector_type(4)));
typedef unsigned u32x4 __attribute__((ext_vector_type(4)));
constexpr int BM = 256, BK = 64, HALF = 128, HTB = HALF * BK * 2, STAGE_BYTES = 8 * HTB, NXCD = 8, WGM = 8;
__device__ __forceinline__ int lds_byte(int r, int c) { const int st = (r >> 4) * 2 + (c >> 5), rr = r & 15, cc = c & 31, ob = rr * 64 + cc * 2; return st * 1024 + (ob ^ (((ob >> 9) & 1) << 5)); }
__device__ __forceinline__ void stage_rc(int b, int& R, int& C) { const int st = b / 1024, sb = b % 1024, swz = sb ^ (((sb >> 9) & 1) << 5); R = (st >> 1) * 16 + swz / 64; C = (st & 1) * 32 + (swz % 64) / 2; }
__device__ __forceinline__ int perm32(int rho) { const int n = rho >> 4, i = rho & 15; return 8 * (i >> 2) + 4 * n + (i & 3); }
struct Unit { int pm, pn; };
struct Gemm { const u16* A; const u16* Bt; int lda, ldb, K; };
struct Order {
  int nM, nN, nwg, G, c, skip_from, skip_by;
  __device__ __forceinline__ void init(int nM_, int nN_, int G_, int c_, int sf = 1 << 30, int sb = 0) { nM = nM_; nN = nN_; nwg = nM * nN; G = G_; c = c_; skip_from = sf; skip_by = sb; }
  __device__ __forceinline__ bool next(int i, Unit& u) const {
    const long L = (long)i * G + c; if (L >= nwg) return false;
    int wgid = (int)L; { const int q = nwg / NXCD, r = nwg % NXCD, xcd = wgid % NXCD, off = wgid / NXCD; wgid = (xcd < r ? xcd * (q + 1) : r * (q + 1) + (xcd - r) * q) + off; }
    const int nig = WGM * nN, gid = wgid / nig, fm = gid * WGM, gsz = (nM - fm) < WGM ? (nM - fm) : WGM;
    u.pm = fm + ((wgid % nig) % gsz); u.pn = (wgid % nig) / gsz;
    if (u.pn >= skip_from) u.pn += skip_by;
    return true;
  }
};
template <class Epi>
__device__ __forceinline__ void gemm_phase(PG8_LAS unsigned char* lds, const Gemm g, const Order& S, const Epi& E) {
  const int tid = opaque_tid(), wid = __builtin_amdgcn_readfirstlane(tid >> 6), lane = tid & 63, wr = wid >> 2, wc = wid & 3, fr = lane & 15, fq = lane >> 4;
  const int K = g.K, nt = K / BK;
  unsigned voffA[2], voffB[2];
#pragma unroll
  for (int i = 0; i < 2; ++i) { int R, C; stage_rc(tid * 16 + i * 8192, R, C); const int Rb = Epi::PERM ? ((R & ~31) + perm32(R & 31)) : R;
    voffA[i] = (unsigned)(R * g.lda + C) * 2u; voffB[i] = (unsigned)(Rb * g.ldb + C) * 2u; }
  const size_t kstep = (size_t)(BK * 2);
  const size_t hstepA = (size_t)HALF * g.lda * 2, hstepB = (size_t)HALF * g.ldb * 2;
  const size_t tstepA = 2 * hstepA, tstepB = 2 * hstepB;
  const unsigned ldsw = (unsigned)wid * 1024u;
  const int aoff = lds_byte(wr * 64 + fr, fq * 8), boff = lds_byte(wc * 32 + fr, fq * 8);
#define PG8_SA(b, h) (((b) * 2 + (h)) * HTB)
#define PG8_SB(b, h) ((4 + (b) * 2 + (h)) * HTB)
#define PG8_STAGE(bufoff, gbase, voff) do { _Pragma("unroll") for (int _i = 0; _i < 2; ++_i) \
    __builtin_amdgcn_global_load_lds((const unsigned*)((const char*)(gbase) + (voff)[_i]), (PG8_LAS unsigned*)(lds + (bufoff) + ldsw + _i * 8192), 16, 0, 0); } while (0)
#define PG8_LDA(dst, b, h) do { _Pragma("unroll") for (int m = 0; m < 4; ++m) _Pragma("unroll") for (int k = 0; k < 2; ++k) dst[m][k] = *(const PG8_LAS bf16x8*)(lds + PG8_SA(b, h) + aoff + m * 2048 + k * 1024); } while (0)
#define PG8_LDB(dst, b, h) do { _Pragma("unroll") for (int n = 0; n < 2; ++n) _Pragma("unroll") for (int k = 0; k < 2; ++k) dst[n][k] = *(const PG8_LAS bf16x8*)(lds + PG8_SB(b, h) + boff + n * 2048 + k * 1024); } while (0)
#define PG8_MMA(ai, bj, At, Bt) do { __builtin_amdgcn_s_setprio(1); _Pragma("unroll") for (int m = 0; m < 4; ++m) _Pragma("unroll") for (int n = 0; n < 2; ++n) _Pragma("unroll") for (int k = 0; k < 2; ++k) \
    acc[ai][bj][m][n] = __builtin_amdgcn_mfma_f32_16x16x32_bf16(Bt[n][k], At[m][k], acc[ai][bj][m][n], 0, 0, 0); __builtin_amdgcn_s_setprio(0); } while (0)
#define PG8_WAIT_V(n) asm volatile("s_waitcnt vmcnt(" #n ")" ::: "memory")
#define PG8_WAIT_L(n) asm volatile("s_waitcnt lgkmcnt(" #n ")" ::: "memory")
#define PG8_BAR __builtin_amdgcn_s_barrier()
#define PG8_SCHED __builtin_amdgcn_sched_barrier(0)
  Unit cur, nxt; int ui = 0;
  if (!S.next(0, cur)) return;
  f32x4 acc[2][2][4][2];
#pragma unroll
  for (int a = 0; a < 2; ++a)
#pragma unroll
    for (int b = 0; b < 2; ++b)
#pragma unroll
      for (int m = 0; m < 4; ++m)
#pragma unroll
        for (int n = 0; n < 2; ++n) acc[a][b][m][n] = (f32x4){0.f, 0.f, 0.f, 0.f};
  bf16x8 At[4][2], B0[2][2], B1[2][2];
  const char* cA = (const char*)g.A + (size_t)cur.pm * tstepA; const char* cB = (const char*)g.Bt + (size_t)cur.pn * tstepB;
  PG8_STAGE(PG8_SB(0, 0), cB, voffB); PG8_STAGE(PG8_SA(0, 0), cA, voffA); PG8_STAGE(PG8_SB(0, 1), cB + hstepB, voffB); PG8_STAGE(PG8_SA(0, 1), cA + hstepA, voffA);
  if (wr == 1) PG8_BAR;
  PG8_WAIT_V(4); PG8_BAR;
  PG8_STAGE(PG8_SB(1, 0), cB + kstep, voffB); PG8_STAGE(PG8_SA(1, 0), cA + kstep, voffA); PG8_STAGE(PG8_SB(1, 1), cB + hstepB + kstep, voffB);
  PG8_WAIT_V(6); PG8_BAR;
  for (;;) {
    const bool has_next = S.next(ui + 1, nxt);
    const char* nA = has_next ? (const char*)g.A + (size_t)nxt.pm * tstepA : cA; const char* nB = has_next ? (const char*)g.Bt + (size_t)nxt.pn * tstepB : cB;
    for (int t = 0; t < nt; t += 2) {
      const bool last = (t == nt - 2);
      const char* a1 = cA + (size_t)(t + 1) * kstep;
      const char* a2 = last ? nA : cA + (size_t)(t + 2) * kstep; const char* b2 = last ? nB : cB + (size_t)(t + 2) * kstep;
      const char* a3 = a2 + kstep; const char* b3 = b2 + kstep;
      PG8_LDB(B0, 0, 0); PG8_SCHED; PG8_LDA(At, 0, 0); PG8_STAGE(PG8_SA(1, 1), a1 + hstepA, voffA);
      PG8_WAIT_L(8); PG8_BAR; PG8_WAIT_L(0); PG8_MMA(0, 0, At, B0); PG8_BAR; PG8_SCHED;
      PG8_LDB(B1, 0, 1); PG8_STAGE(PG8_SB(0, 0), b2, voffB);
      PG8_BAR; PG8_WAIT_L(0); PG8_MMA(0, 1, At, B1); PG8_BAR;
      PG8_LDA(At, 0, 1); PG8_STAGE(PG8_SA(0, 0), a2, voffA);
      PG8_BAR; PG8_WAIT_L(0); PG8_MMA(1, 0, At, B0); PG8_BAR; PG8_SCHED;
      PG8_STAGE(PG8_SB(0, 1), b2 + hstepB, voffB);
      PG8_WAIT_V(6); PG8_BAR; PG8_MMA(1, 1, At, B1); PG8_BAR;
      PG8_LDB(B0, 1, 0); PG8_SCHED; PG8_LDA(At, 1, 0); PG8_STAGE(PG8_SA(0, 1), a2 + hstepA, voffA);
      PG8_WAIT_L(8); PG8_BAR; PG8_WAIT_L(0); PG8_MMA(0, 0, At, B0); PG8_BAR; PG8_SCHED;
      PG8_LDB(B1, 1, 1); PG8_STAGE(PG8_SB(1, 0), b3, voffB);
      PG8_BAR; PG8_WAIT_L(0); PG8_MMA(0, 1, At, B1); PG8_BAR;
      PG8_LDA(At, 1, 1); PG8_STAGE(PG8_SA(1, 0), a3, voffA);
      PG8_BAR; PG8_WAIT_L(0); PG8_MMA(1, 0, At, B0); PG8_BAR; PG8_SCHED;
      PG8_STAGE(PG8_SB(1, 1), b3 + hstepB, voffB);
      PG8_WAIT_V(6); PG8_BAR; PG8_MMA(1, 1, At, B1); PG8_BAR;
    }
    E(acc, cur, wr, wc, fr, fq);
    if (!has_next) break;
#pragma unroll
    for (int a = 0; a < 2; ++a)
#pragma unroll
      for (int b = 0; b < 2; ++b)
#pragma unroll
        for (int m = 0; m < 4; ++m)
#pragma unroll
          for (int n = 0; n < 2; ++n) acc[a][b][m][n] = (f32x4){0.f, 0.f, 0.f, 0.f};
    cur = nxt; cA = nA; cB = nB; ++ui;
  }
  PG8_WAIT_V(0);
  if (wr == 0) PG8_BAR;
  PG8_BAR;
#undef PG8_SA
#undef PG8_SB
#undef PG8_STAGE
#undef PG8_LDA
#undef PG8_LDB
#undef PG8_MMA
#undef PG8_WAIT_V
#undef PG8_WAIT_L
#undef PG8_BAR
#undef PG8_SCHED
}
typedef const f32x4 (&AccRef)[2][2][4][2];
struct EpiInprojN {
  static constexpr bool PERM = true;
  u16* qk; u16* rg;
  __device__ __forceinline__ void operator()(AccRef acc, const Unit& u, int wr, int wc, int fr, int fq) const {
    const int row0 = u.pm * BM + wr * 64 + fr;
    u16* base; int ld, colt;
    if (u.pn < 4) { base = qk; ld = 1024; colt = u.pn * 256; } else { base = rg; ld = 512; colt = (u.pn - 9) * 256; }
    const int col0 = colt + wc * 32 + 8 * fq;
#pragma unroll
    for (int ai = 0; ai < 2; ++ai)
#pragma unroll
      for (int m = 0; m < 4; ++m) {
        u16* rowp = base + (size_t)(row0 + ai * HALF + m * 16) * ld + col0;
#pragma unroll
        for (int bj = 0; bj < 2; ++bj) {
          const f32x4 v0 = acc[ai][bj][m][0], v1 = acc[ai][bj][m][1];
          u32x4 w; w.x = pk2(v0[0], v0[1]); w.y = pk2(v0[2], v0[3]); w.z = pk2(v1[0], v1[1]); w.w = pk2(v1[2], v1[3]);
          *(u32x4*)(rowp + bj * HALF) = w;
        }
      }
  }
};
struct EpiInprojT {
  static constexpr bool PERM = true;
  u16 *vT, *vTc, *hyT, *hyTc;
  __device__ __forceinline__ void operator()(AccRef acc, const Unit& u, int wr, int wc, int fr, int fq) const {
    const bool isctx = (u.pn >= 128);
    const int b = isctx ? (u.pn - 128) : (u.pn >> 4);
    const int Lseg = isctx ? 256 : 4096, t0 = isctx ? 0 : (u.pn & 15) * 256;
    const bool isv = (u.pm < 2);
    const size_t boff = isv ? (isctx ? (size_t)16777216 : (size_t)0) : (isctx ? (size_t)(16777216 + 1048576 + 25165824) : (size_t)(16777216 + 1048576));
    u16* base = vT + boff;
    const int nc = isv ? 512 : 768;
    const int wrow0 = (isv ? u.pm : u.pm - 2) * BM + wr * 64 + fr;
    const int col0 = t0 + wc * 32 + 8 * fq;
#pragma unroll
    for (int ai = 0; ai < 2; ++ai)
#pragma unroll
      for (int m = 0; m < 4; ++m) {
        u16* rowp = base + ((size_t)(b * nc + wrow0 + ai * HALF + m * 16)) * Lseg + col0;
#pragma unroll
        for (int bj = 0; bj < 2; ++bj) {
          const f32x4 v0 = acc[ai][bj][m][0], v1 = acc[ai][bj][m][1];
          u32x4 w; w.x = pk2(v0[0], v0[1]); w.y = pk2(v0[2], v0[3]); w.z = pk2(v1[0], v1[1]); w.w = pk2(v1[2], v1[3]);
          *(u32x4*)(rowp + bj * HALF) = w;
        }
      }
  }
};
struct EpiGate {
  static constexpr bool PERM = true;
  unsigned char* g8; const float* bias;
  __device__ __forceinline__ void operator()(AccRef acc, const Unit& u, int wr, int wc, int fr, int fq) const {
    const int row0 = u.pm * BM + wr * 64 + fr;
    const int col0 = u.pn * BM + wc * 32 + 8 * fq;
#pragma unroll
    for (int bj = 0; bj < 2; ++bj) {
      const f32x4 b0 = *(const f32x4*)(bias + col0 + bj * HALF), b1 = *(const f32x4*)(bias + col0 + bj * HALF + 4);
#pragma unroll
      for (int ai = 0; ai < 2; ++ai)
#pragma unroll
        for (int m = 0; m < 4; ++m) {
          const f32x4 v0 = acc[ai][bj][m][0] + b0, v1 = acc[ai][bj][m][1] + b1;
          unsigned w0 = 0, w1 = 0;
#pragma unroll
          for (int k = 0; k < 4; ++k) {
            w0 |= (unsigned)(sigmoidf_(v0[k]) * 255.0f + 0.5f) << (8 * k);
            w1 |= (unsigned)(sigmoidf_(v1[k]) * 255.0f + 0.5f) << (8 * k);
          }
          *(uint2*)(g8 + (size_t)(row0 + ai * HALF + m * 16) * 3072 + col0 + bj * HALF) = make_uint2(w0, w1);
        }
    }
  }
};
struct EpiBranch {
  static constexpr bool PERM = true;
  u16* mbuf; const unsigned char* g8; int br;
  __device__ __forceinline__ void operator()(AccRef acc, const Unit& u, int wr, int wc, int fr, int fq) const {
    const int row0 = u.pm * BM + wr * 64 + fr;
    const int col0 = u.pn * BM + wc * 32 + 8 * fq;
#pragma unroll
    for (int ai = 0; ai < 2; ++ai)
#pragma unroll
      for (int m = 0; m < 4; ++m) {
        const size_t row = (size_t)(row0 + ai * HALF + m * 16);
#pragma unroll
        for (int bj = 0; bj < 2; ++bj) {
          const uint2 gq = *(const uint2*)(g8 + row * 3072 + br * 1024 + col0 + bj * HALF);
          u16* mp = mbuf + row * 1024 + col0 + bj * HALF;
          const f32x4 v0 = acc[ai][bj][m][0], v1 = acc[ai][bj][m][1];
          float r[8];
          r[0] = (float)(gq.x & 255u) * v0[0]; r[1] = (float)((gq.x >> 8) & 255u) * v0[1];
          r[2] = (float)((gq.x >> 16) & 255u) * v0[2]; r[3] = (float)(gq.x >> 24) * v0[3];
          r[4] = (float)(gq.y & 255u) * v1[0]; r[5] = (float)((gq.y >> 8) & 255u) * v1[1];
          r[6] = (float)((gq.y >> 16) & 255u) * v1[2]; r[7] = (float)(gq.y >> 24) * v1[3];
          u32x4 w;
          if (br == 0) {
            w.x = pk2(r[0] * (1.f / 255.f), r[1] * (1.f / 255.f)); w.y = pk2(r[2] * (1.f / 255.f), r[3] * (1.f / 255.f));
            w.z = pk2(r[4] * (1.f / 255.f), r[5] * (1.f / 255.f)); w.w = pk2(r[6] * (1.f / 255.f), r[7] * (1.f / 255.f));
          } else {
            const u32x4 o = *(const u32x4*)mp;
            w.x = pk2(bflo(o.x) + r[0] * (1.f / 255.f), bfhi(o.x) + r[1] * (1.f / 255.f));
            w.y = pk2(bflo(o.y) + r[2] * (1.f / 255.f), bfhi(o.y) + r[3] * (1.f / 255.f));
            w.z = pk2(bflo(o.z) + r[4] * (1.f / 255.f), bfhi(o.z) + r[5] * (1.f / 255.f));
            w.w = pk2(bflo(o.w) + r[6] * (1.f / 255.f), bfhi(o.w) + r[7] * (1.f / 255.f));
          }
          *(u32x4*)mp = w;
        }
      }
  }
};
struct EpiOut {
  static constexpr bool PERM = false;
  const float *xsrc, *csrc; float *xdst, *cdst; const float* modl;
  __device__ __forceinline__ void operator()(AccRef acc, const Unit& u, int wr, int wc, int fr, int fq) const {
    const bool isctx = (u.pm >= 128);
    const int bi = isctx ? 8 : (u.pm >> 4);
    const float* gatev = modl + ((size_t)bi * 6 + 2) * 1024;
    const float* src = isctx ? (csrc - (size_t)NLAT * 1024) : xsrc;
    float* dst = isctx ? (cdst - (size_t)NLAT * 1024) : xdst;
    const int row0 = u.pm * BM + wr * 64 + fr, col0 = u.pn * BM + wc * 32 + 4 * fq;
#pragma unroll
    for (int bj = 0; bj < 2; ++bj)
#pragma unroll
      for (int n = 0; n < 2; ++n) {
        const int col = col0 + bj * HALF + n * 16;
        const f32x4 gv = *(const f32x4*)(gatev + col);
#pragma unroll
        for (int ai = 0; ai < 2; ++ai)
#pragma unroll
          for (int m = 0; m < 4; ++m) {
            const size_t o = (size_t)(row0 + ai * HALF + m * 16) * 1024 + col;
            const f32x4 xv = *(const f32x4*)(src + o);
            *(f32x4*)(dst + o) = xv + gv * acc[ai][bj][m][n];
          }
      }
  }
};
struct EpiQ {
  static constexpr bool PERM = true;
  u16* q;
  __device__ __forceinline__ void operator()(AccRef acc, const Unit& u, int wr, int wc, int fr, int fq) const {
    const int row0 = u.pm * BM + wr * 64 + fr;
    const int col0 = u.pn * BM + wc * 32 + 8 * fq;
#pragma unroll
    for (int ai = 0; ai < 2; ++ai)
#pragma unroll
      for (int m = 0; m < 4; ++m) {
        u16* rowp = q + (size_t)(row0 + ai * HALF + m * 16) * 2048 + col0;
#pragma unroll
        for (int bj = 0; bj < 2; ++bj) {
          const f32x4 v0 = acc[ai][bj][m][0], v1 = acc[ai][bj][m][1];
          u32x4 w; w.x = pk2(v0[0], v0[1]); w.y = pk2(v0[2], v0[3]); w.z = pk2(v1[0], v1[1]); w.w = pk2(v1[2], v1[3]);
          *(u32x4*)(rowp + bj * HALF) = w;
        }
      }
  }
};
}

__device__ __forceinline__ void tr_tile(const float* __restrict__ src, int N, int K, u16* __restrict__ dst, int tile, char* smem) {
  float* lds = (float*)smem;
  const int tiles_n = N >> 6;
  const int tk = tile / tiles_n, tn = tile - tk * tiles_n;
  const int tid = opaque_tid();
  {
    const int r = tid >> 3, c8 = (tid & 7) * 8;
    const float* s = src + (size_t)(tk * 64 + r) * N + tn * 64 + c8;
    float4 a = *(const float4*)s, b = *(const float4*)(s + 4);
    float* d = lds + r * 65 + c8;
    d[0] = a.x; d[1] = a.y; d[2] = a.z; d[3] = a.w; d[4] = b.x; d[5] = b.y; d[6] = b.z; d[7] = b.w;
  }
  __syncthreads();
  {
    const int n = tid >> 3, k0 = (tid & 7) * 8;
    uint4 o;
    o.x = pk2(lds[(k0 + 0) * 65 + n], lds[(k0 + 1) * 65 + n]);
    o.y = pk2(lds[(k0 + 2) * 65 + n], lds[(k0 + 3) * 65 + n]);
    o.z = pk2(lds[(k0 + 4) * 65 + n], lds[(k0 + 5) * 65 + n]);
    o.w = pk2(lds[(k0 + 6) * 65 + n], lds[(k0 + 7) * 65 + n]);
    *(uint4*)(dst + (size_t)(tn * 64 + n) * K + tk * 64 + k0) = o;
  }
  __syncthreads();
}
__device__ __forceinline__ void cvt_chunk(const float* __restrict__ src, u16* __restrict__ dst, size_t chunk) {
  const size_t i = chunk * 4096 + (size_t)opaque_tid() * 8;
  float4 a = *(const float4*)(src + i), b = *(const float4*)(src + i + 4);
  uint4 o;
  o.x = pk2(a.x, a.y); o.y = pk2(a.z, a.w); o.z = pk2(b.x, b.y); o.w = pk2(b.z, b.w);
  *(uint4*)(dst + i) = o;
}
__device__ __forceinline__ void cvt_chunk_fp8(const float* __restrict__ src, unsigned char* __restrict__ dst, size_t chunk, float scale) {
  const size_t i = chunk * 4096 + (size_t)opaque_tid() * 8;
  const float4 a = *(const float4*)(src + i), b = *(const float4*)(src + i + 4);
  int w0 = __builtin_amdgcn_cvt_pk_fp8_f32(a.x * scale, a.y * scale, 0, false);
  w0 = __builtin_amdgcn_cvt_pk_fp8_f32(a.z * scale, a.w * scale, w0, true);
  int w1 = __builtin_amdgcn_cvt_pk_fp8_f32(b.x * scale, b.y * scale, 0, false);
  w1 = __builtin_amdgcn_cvt_pk_fp8_f32(b.z * scale, b.w * scale, w1, true);
  *(uint2*)(dst + i) = make_uint2((unsigned)w0, (unsigned)w1);
}
__device__ __forceinline__ void cvt_chunk_fp4(const float* __restrict__ src, unsigned char* __restrict__ dst, size_t chunk, float scale) {
  const size_t i = chunk * 4096 + (size_t)opaque_tid() * 8;
  const float4 a = *(const float4*)(src + i), b = *(const float4*)(src + i + 4);
  unsigned w = 0;
  w = __builtin_amdgcn_cvt_scalef32_pk_fp4_f32(w, a.x * scale, a.y * scale, 1.0f, 0);
  w = __builtin_amdgcn_cvt_scalef32_pk_fp4_f32(w, a.z * scale, a.w * scale, 1.0f, 1);
  w = __builtin_amdgcn_cvt_scalef32_pk_fp4_f32(w, b.x * scale, b.y * scale, 1.0f, 2);
  w = __builtin_amdgcn_cvt_scalef32_pk_fp4_f32(w, b.z * scale, b.w * scale, 1.0f, 3);
  *(unsigned*)(dst + (i >> 1)) = w;
}
__device__ __forceinline__ void phase_prep(const P& p, char* smem) {
  const int tid = opaque_tid();
  const int NTR = 2512;
  const int total = 2 * NTR + 128 + 384;
  for (int task = blockIdx.x; task < total; task += gridDim.x) {
    if (task < 2 * NTR) {
      const int l = task / NTR;
      int t = task - l * NTR;
      if (t < 704) tr_tile(p.w_in + (size_t)l * 1024 * 2816, 2816, 1024, p.WinT + (size_t)l * 2816 * 1024, t, smem);
      else if ((t -= 704) < 768) tr_tile(p.w_gate + (size_t)l * 1024 * 3072, 3072, 1024, p.WgT + (size_t)l * 3072 * 1024, t, smem);
      else if ((t -= 768) < 128) tr_tile(p.w_br_a + (size_t)l * 512 * 1024, 1024, 512, p.WaT + (size_t)l * 1024 * 512, t, smem);
      else if ((t -= 128) < 64) tr_tile(p.w_br_b + (size_t)l * 256 * 1024, 1024, 256, p.WbT + (size_t)l * 1024 * 256, t, smem);
      else if ((t -= 64) < 64) tr_tile(p.w_br_c + (size_t)l * 256 * 1024, 1024, 256, p.WcT + (size_t)l * 1024 * 256, t, smem);
      else if ((t -= 64) < 256) tr_tile(p.w_out + (size_t)l * 1024 * 1024, 1024, 1024, p.WoT + (size_t)l * 1024 * 1024, t, smem);
      else if ((t -= 256) < 512) tr_tile(p.peer_wq + (size_t)l * 1024 * 2048, 2048, 1024, p.WqT + (size_t)l * 2048 * 1024, t, smem);
      else {
        t -= 512;
        const int gate = t >> 3, dn = t & 7;
        const float* src = (gate ? p.rg_wx : p.rg_wa) + (size_t)(l * 8 + dn) * 4096;
        tr_tile(src, 64, 64, p.rgW + (size_t)((l * 2 + gate) * 8 + dn) * 4096, 0, smem);
      }
    } else if (task < 2 * NTR + 128) {
      cvt_chunk(p.peer_keys, p.keysB, (size_t)(task - 2 * NTR));
    } else {
      int t = task - 2 * NTR - 128;
      const int kc = t & 15; t >>= 4;
      const int jc = t % 12, l = t / 12;
      float* s = (float*)smem;
      for (int i = tid; i < 576; i += NTHR) {
        const int bi = i >> 6, kk = i & 63;
        const float v = (bi < 8) ? p.c[bi * 1024 + kc * 64 + kk] : p.c_ctx[kc * 64 + kk];
        s[i] = v / (1.0f + __expf(-v));
      }
      __syncthreads();
      const int j = jc * 512 + tid;
      float acc[9];
#pragma unroll
      for (int bi = 0; bi < 9; ++bi) acc[bi] = 0.f;
      const float* wp = p.w_ada + ((size_t)l * 1024 + kc * 64) * 6144 + j;
#pragma unroll 8
      for (int kk = 0; kk < 64; ++kk) {
        const float w = wp[(size_t)kk * 6144];
#pragma unroll
        for (int bi = 0; bi < 9; ++bi) acc[bi] += s[bi * 64 + kk] * w;
      }
#pragma unroll
      for (int bi = 0; bi < 9; ++bi) p.modpart[((size_t)(kc * 2 + l) * 9 + bi) * 6144 + j] = acc[bi];
      __syncthreads();
    }
  }
}
__device__ __forceinline__ void phase_modreduce(const P& p) {
  const int n = 2 * 9 * 6144;
  for (int i = blockIdx.x * NTHR + opaque_tid(); i < n; i += gridDim.x * NTHR) {
    const int l = i / (9 * 6144);
    const int j = i % 6144;
    float s = p.b_ada[l * 6144 + j];
#pragma unroll
    for (int kc = 0; kc < 16; ++kc) s += p.modpart[(size_t)kc * n + i];
    p.mod[i] = s;
  }
}

__device__ __forceinline__ void phase_norm(const P& p, int l, int which) {
  const int tid_ = opaque_tid(); const int lane = tid_ & 63, wid = tid_ >> 6;
  const int ntok = (which == 2 || (which == 1 && l == 1)) ? NLAT : NTOK;
  for (int row = blockIdx.x * 8 + wid; row < ntok; row += gridDim.x * 8) {
    const float* src;
    if (row < NLAT) src = ((which == 0 && l == 0) ? p.x : p.out) + (size_t)row * 1024;
    else src = ((which == 0 && l == 0) ? p.ctx : p.ctxs) + (size_t)(row - NLAT) * 1024;
    float4 v[4];
    float ss = 0.f;
#pragma unroll
    for (int i = 0; i < 4; ++i) {
      v[i] = *(const float4*)(src + i * 256 + lane * 4);
      ss += v[i].x * v[i].x + v[i].y * v[i].y + v[i].z * v[i].z + v[i].w * v[i].w;
    }
    ss = wave_sum(ss);
    const float rstd = rsqrtf(ss * (1.0f / 1024.0f) + 1e-6f);
    if (which == 2) {
#pragma unroll
      for (int i = 0; i < 4; ++i) {
        const int col = i * 256 + lane * 4;
        const float4 g = *(const float4*)(p.final_g + col);
        float4 o = {v[i].x * rstd * g.x, v[i].y * rstd * g.y, v[i].z * rstd * g.z, v[i].w * rstd * g.w};
        *(float4*)(p.out + (size_t)row * 1024 + col) = o;
      }
    } else {
      const int bi = row < NLAT ? (row >> 12) : 8;
      const float* gam = (which == 0 ? p.norm_mix_g : p.norm_ffn_g) + l * 1024;
      const float* msh = p.mod + ((size_t)(l * 9 + bi) * 6 + (which == 0 ? 0 : 3)) * 1024;
      const float* msc = msh + 1024;
#pragma unroll
      for (int i = 0; i < 4; ++i) {
        const int col = i * 256 + lane * 4;
        const float4 g = *(const float4*)(gam + col);
        const float4 sh = *(const float4*)(msh + col);
        const float4 sc = *(const float4*)(msc + col);
        uint2 o;
        o.x = pk2(v[i].x * rstd * g.x * (1.f + sc.x) + sh.x, v[i].y * rstd * g.y * (1.f + sc.y) + sh.y);
        o.y = pk2(v[i].z * rstd * g.z * (1.f + sc.z) + sh.z, v[i].w * rstd * g.w * (1.f + sc.w) + sh.w);
        *(uint2*)(p.xn + (size_t)row * 1024 + col) = o;
      }
    }
  }
}

__device__ __forceinline__ void filter_wave(const P& p, int l, int L, int t, float* __restrict__ outp) {
  const int lane = opaque_tid() & 63;
  const float tl = (float)t / (float)(L - 1);
  const float wang = (6.283185307179586f / (float)L) * (float)t;
  float z = 0.f;
  if (lane == 0) z = tl;
  else if (lane <= 16) { const float band = 1e-4f + (float)(lane - 1) * ((15.0f - 1e-4f) / 15.0f); z = cosf(band * wang); }
  else if (lane <= 32) { const float band = 1e-4f + (float)(lane - 17) * ((15.0f - 1e-4f) / 15.0f); z = -sinf(band * wang); }
  float a1 = p.hy_f1_b[l * 64 + lane];
  for (int i = 0; i < 33; ++i) a1 += shf(z, i) * p.hy_f1_w[(l * 33 + i) * 64 + lane];
  const float h1 = sinf(p.hy_freq[l * 128 + lane] * a1);
  float a2 = p.hy_f2_b[l * 64 + lane];
  for (int i = 0; i < 64; ++i) a2 += shf(h1, i) * p.hy_f2_w[(l * 64 + i) * 64 + lane];
  const float h2 = sinf(p.hy_freq[l * 128 + 64 + lane] * a2);
  float a3[8];
#pragma unroll
  for (int m = 0; m < 8; ++m) a3[m] = 0.f;
  for (int i = 0; i < 64; ++i) {
    const float hv = shf(h2, i);
    const float* wr = p.hy_f3_w + (size_t)(l * 64 + i) * 512 + lane;
#pragma unroll
    for (int m = 0; m < 8; ++m) a3[m] += hv * wr[m * 64];
  }
  const float LN100 = 4.605170185988092f;
  const float d0 = LN100 / 1.5f, d1 = LN100 / 0.3f;
#pragma unroll
  for (int m = 0; m < 8; ++m) {
    const int cp = lane + 64 * m;
    const int ch = cp & 255;
    const float delta = d0 + (float)ch * ((d1 - d0) / 255.0f);
    outp[(size_t)cp * L + t] = a3[m] * expf(-tl * delta);
  }
}
__device__ __forceinline__ void phase_filters(const P& p, int l) {
  const int wid = opaque_tid() >> 6;
  const int ntask = 4096 + (l == 0 ? 256 : 0);
  for (int t = blockIdx.x * 8 + wid; t < ntask; t += gridDim.x * 8) {
    if (t < 4096) filter_wave(p, l, 4096, t, p.hT);
    else filter_wave(p, l, 256, t - 4096, p.hc);
  }
}
__device__ __forceinline__ void kf_task(const P& p, int c, char* smem) {
  c2* buf = (c2*)smem;
  const int tid = opaque_tid();
  for (int i = 0; i < 16; ++i) {
    const int j = tid + NTHR * i;
    float v;
    if (j < 4096) v = p.hT[(size_t)c * 4096 + j];
    else if (j == 4096) v = 0.f;
    else v = p.hT[(size_t)(256 + c) * 4096 + (8192 - j)];
    buf[j] = {v, 0.f};
  }
  __syncthreads();
  fft8192(buf, -1.f);
  c2* o = (c2*)p.Kf + (size_t)c * 8192;
  for (int i = 0; i < 16; ++i) { const int j = tid + NTHR * i; o[j] = buf[j]; }
  __syncthreads();
}

__device__ __forceinline__ void inproj_tile(const P& p, int l, int mt, int nt, char* smem) {
  f32x16 acc[2][2];
  zero_acc(acc);
  const int m0 = mt * 256, n0 = nt * 128;
  gemm_kloop(acc, p.xn + (size_t)m0 * 1024, 1024, p.WinT + ((size_t)l * 2816 + n0) * 1024, 1024, 1024, smem);
  EPI_VARS
  if (nt < 8 || nt >= 18) {
    u16* dst; int ld, cbase;
    if (nt < 8) { dst = p.qk; ld = 1024; cbase = n0; }
    else { dst = p.rg; ld = 512; cbase = n0 - 2304; }
#pragma unroll
    for (int i = 0; i < 2; ++i)
#pragma unroll
      for (int j = 0; j < 2; ++j)
#pragma unroll
        for (int e = 0; e < 16; ++e)
          dst[(size_t)(m0 + EPI_ROW(i, e)) * ld + cbase + EPI_COL(j)] = f2bf(acc[i][j][e]);
  } else {
#pragma unroll
    for (int i = 0; i < 2; ++i)
#pragma unroll
      for (int j = 0; j < 2; ++j)
#pragma unroll
        for (int qd = 0; qd < 4; ++qd) {
          uint2 o;
          o.x = pk2(acc[i][j][4 * qd + 0], acc[i][j][4 * qd + 1]);
          o.y = pk2(acc[i][j][4 * qd + 2], acc[i][j][4 * qd + 3]);
          const int row0 = wm * 64 + i * 32 + 8 * qd + 4 * hh;
          *(uint2*)(smem + EPI_COL(j) * 520 + row0 * 2) = o;
        }
    __syncthreads();
    u16* dstT; int Lseg, t0, ncol0, nc;
    const bool isctx = (mt >= 128);
    const int b = isctx ? (mt - 128) : (mt >> 4);
    if (nt < 12) { ncol0 = n0 - 1024; nc = 512; dstT = isctx ? p.vTc : p.vT; }
    else { ncol0 = n0 - 1536; nc = 768; dstT = isctx ? p.hyTc : p.hyT; }
    if (isctx) { Lseg = 256; t0 = 0; } else { Lseg = 4096; t0 = (mt & 15) * 256; }
#pragma unroll 4
    for (int it = 0; it < 16; ++it) {
      const int idx = tid + NTHR * it;
      const int col = idx >> 6, u = idx & 63;
      const uint2 v = *(const uint2*)(smem + col * 520 + u * 8);
      *(uint2*)(dstT + ((size_t)(b * nc + ncol0 + col)) * Lseg + t0 + u * 4) = v;
    }
    __syncthreads();
  }
}

__device__ __forceinline__ float ldbf(const u16* p, int t, int L) { return (t >= 0 && t < L) ? bf2f(p[t]) : 0.f; }
__device__ __forceinline__ void hyena_fft_task(const P& p, int l, int c, int bp, char* smem) {
  c2* buf = (c2*)smem;
  c2* ub = (c2*)(smem + 65536);
  const int tid = opaque_tid();
  const float* sw = p.hy_short_w + l * 3 * 768;
  const float* sb = p.hy_short_b + l * 768;
  const float wx0[3] = {sw[c], sw[768 + c], sw[1536 + c]};
  const float wx1[3] = {sw[256 + c], sw[768 + 256 + c], sw[1536 + 256 + c]};
  const float wv[3] = {sw[512 + c], sw[768 + 512 + c], sw[1536 + 512 + c]};
  const float bx0 = sb[c], bx1 = sb[256 + c], bv = sb[512 + c];
  const float dsk = p.hy_bias[l * 256 + c];
  for (int i = 0; i < 8; ++i) {
    const int t = tid + NTHR * i;
    float u[2];
#pragma unroll
    for (int bb = 0; bb < 2; ++bb) {
      const int b = 2 * bp + bb;
      const u16* x1 = p.hyT + ((size_t)(b * 768 + 256 + c)) * 4096;
      const u16* vv = p.hyT + ((size_t)(b * 768 + 512 + c)) * 4096;
      const float x1c = bx1 + wx1[0] * ldbf(x1, t - 1, 4096) + wx1[1] * ldbf(x1, t, 4096) + wx1[2] * ldbf(x1, t + 1, 4096);
      const float vc = bv + wv[0] * ldbf(vv, t - 1, 4096) + wv[1] * ldbf(vv, t, 4096) + wv[2] * ldbf(vv, t + 1, 4096);
      u[bb] = vc * x1c;
    }
    buf[t] = {u[0], u[1]};
    ub[t] = {u[0], u[1]};
    buf[t + 4096] = {0.f, 0.f};
  }
  __syncthreads();
  fft8192(buf, -1.f);
  const c2* kf = (const c2*)p.Kf + (size_t)c * 8192;
  for (int i = 0; i < 16; ++i) {
    const int k = tid + NTHR * i;
    buf[k] = cmul(buf[k], kf[k]);
  }
  __syncthreads();
  fft8192(buf, 1.f);
  for (int i = 0; i < 8; ++i) {
    const int t = tid + NTHR * i;
    const c2 y = buf[t];
    const c2 uu = ub[t];
#pragma unroll
    for (int bb = 0; bb < 2; ++bb) {
      const int b = 2 * bp + bb;
      const u16* x0 = p.hyT + ((size_t)(b * 768 + c)) * 4096;
      const float x0c = bx0 + wx0[0] * ldbf(x0, t - 1, 4096) + wx0[1] * ldbf(x0, t, 4096) + wx0[2] * ldbf(x0, t + 1, 4096);
      const float yy = ldexpf(bb ? y.y : y.x, -13);
      const float uv = bb ? uu.y : uu.x;
      p.ycat[(size_t)(b * 4096 + t) * 1024 + 512 + c] = f2bf(x0c * (yy + uv * dsk));
    }
  }
  __syncthreads();
}
__device__ __forceinline__ void hyena_ctx_task(const P& p, int l, int b, int cg8, char* smem) {
  const int tid_ = opaque_tid(); const int lane = tid_ & 63, wid = tid_ >> 6;
  const int c = cg8 * 8 + wid;
  float* us = (float*)smem + wid * 1024;
  float* kfp = us + 256 + 255;
  const float* sw = p.hy_short_w + l * 3 * 768;
  const float* sb = p.hy_short_b + l * 768;
  const u16* x0 = p.hyTc + ((size_t)(b * 768 + c)) * 256;
  const u16* x1 = p.hyTc + ((size_t)(b * 768 + 256 + c)) * 256;
  const u16* vv = p.hyTc + ((size_t)(b * 768 + 512 + c)) * 256;
  for (int i = 0; i < 4; ++i) {
    const int t = lane + 64 * i;
    const float x1c = sb[256 + c] + sw[256 + c] * ldbf(x1, t - 1, 256) + sw[768 + 256 + c] * ldbf(x1, t, 256) + sw[1536 + 256 + c] * ldbf(x1, t + 1, 256);
    const float vc = sb[512 + c] + sw[512 + c] * ldbf(vv, t - 1, 256) + sw[768 + 512 + c] * ldbf(vv, t, 256) + sw[1536 + 512 + c] * ldbf(vv, t + 1, 256);
    us[t] = vc * x1c;
    kfp[t] = p.hc[(size_t)c * 256 + t];
    if (t > 0) kfp[-t] = p.hc[(size_t)(256 + c) * 256 + t];
  }
  __syncthreads();
  const float dsk = p.hy_bias[l * 256 + c];
  float acc[4] = {0.f, 0.f, 0.f, 0.f};
  for (int s = 0; s < 256; ++s) {
    const float uv = us[s];
#pragma unroll
    for (int i = 0; i < 4; ++i) acc[i] += kfp[lane + 64 * i - s] * uv;
  }
#pragma unroll
  for (int i = 0; i < 4; ++i) {
    const int t = lane + 64 * i;
    const float x0c = sb[c] + sw[c] * ldbf(x0, t - 1, 256) + sw[768 + c] * ldbf(x0, t, 256) + sw[1536 + c] * ldbf(x0, t + 1, 256);
    p.ycat[(size_t)(NLAT + b * 256 + t) * 1024 + 512 + c] = f2bf(x0c * (acc[i] + us[t] * dsk));
  }
  __syncthreads();
}

__device__ __forceinline__ void rg_chunk_task(const P& p, int l, int cq, int nblk, int mode, bool last, char* smem) {
  const int tid = opaque_tid(), lane = tid & 63, wid = tid >> 6;
  const int l31 = lane & 31, hh = lane >> 5;
  const int b = cq / 68, rr = cq - b * 68;
  const int seg = rr < 4 ? 0 : 1, sub = rr < 4 ? rr : rr - 4;
  if (mode == 1 && seg == 0 && last) return;
  float* xcf = (float*)smem;
  char* xcb = smem + 16384;
  float* coef = (float*)(smem + 24576);
  float2* segagg = (float2*)(smem + 90112);
  float* hin = (float*)(smem + 94208);
  float* Hout = (float*)(smem + 94720);
  const int Lseg = seg ? 4096 : 256;
  const int tokbase = seg ? b * 4096 : NLAT + b * 256;
  const int T0 = sub * 64;
  const int tt = tid >> 3, c0 = (tid & 7) * 8;
  const int chb = nblk * 64 + c0;
  const int wdir = wid >> 2, wgate = (wid >> 1) & 1, wmt = wid & 1;
  bf16x8 wf[2][4];
  {
    const u16* wp = p.rgW + (size_t)(((l * 2 + wgate) * 2 + wdir) * 4 + nblk) * 4096 + l31 * 64 + 8 * hh;
#pragma unroll
    for (int nt = 0; nt < 2; ++nt)
#pragma unroll
      for (int s = 0; s < 4; ++s) wf[nt][s] = *(const bf16x8*)(wp + nt * 2048 + 16 * s);
  }
  {
    float xc[8];
#pragma unroll
    for (int c = 0; c < 8; ++c) xc[c] = p.rg_conv_b[l * 256 + chb + c];
#pragma unroll
    for (int k = 0; k < 4; ++k) {
      const int pos = T0 + tt + k - 2;
      if (pos >= 0 && pos < Lseg) {
        const uint4 raw = *(const uint4*)(p.rg + (size_t)(tokbase + pos) * 512 + chb);
        const float4 w0 = *(const float4*)(p.rg_conv_w + (l * 4 + k) * 256 + chb);
        const float4 w1 = *(const float4*)(p.rg_conv_w + (l * 4 + k) * 256 + chb + 4);
        xc[0] += w0.x * bflo(raw.x); xc[1] += w0.y * bfhi(raw.x);
        xc[2] += w0.z * bflo(raw.y); xc[3] += w0.w * bfhi(raw.y);
        xc[4] += w1.x * bflo(raw.z); xc[5] += w1.y * bfhi(raw.z);
        xc[6] += w1.z * bflo(raw.w); xc[7] += w1.w * bfhi(raw.w);
      }
    }
    *(float4*)(xcf + tt * 64 + c0) = make_float4(xc[0], xc[1], xc[2], xc[3]);
    *(float4*)(xcf + tt * 64 + c0 + 4) = make_float4(xc[4], xc[5], xc[6], xc[7]);
    uint4 o;
    o.x = pk2(xc[0], xc[1]); o.y = pk2(xc[2], xc[3]); o.z = pk2(xc[4], xc[5]); o.w = pk2(xc[6], xc[7]);
    *(uint4*)(xcb + swz128(tt, tid & 7)) = o;
  }
  __syncthreads();
  {
    f32x16 acc0 = zero16(), acc1 = zero16();
#pragma unroll
    for (int s = 0; s < 4; ++s) {
      const bf16x8 af = *(const bf16x8*)(xcb + swz128(wmt * 32 + l31, 2 * s + hh));
      acc0 = mfma32(af, wf[0][s], acc0);
      acc1 = mfma32(af, wf[1][s], acc1);
    }
    float* cp = coef + (wdir * 2 + wgate) * 4096;
#pragma unroll
    for (int e = 0; e < 16; ++e) {
      const int tok = wmt * 32 + (e & 3) + 8 * (e >> 2) + 4 * hh;
      cp[tok * 64 + l31] = acc0[e];
      cp[tok * 64 + 32 + l31] = acc1[e];
    }
  }
  __syncthreads();
#pragma unroll
  for (int dir = 0; dir < 2; ++dir) {
    float* ca = coef + (dir * 2) * 4096;
    float* cb2 = ca + 4096;
#pragma unroll
    for (int c = 0; c < 8; ++c) {
      const int ch = (l * 2 + dir) * 256 + chb + c;
      const float sp = __logf(1.0f + __expf(-p.rg_lambda[ch]));
      const int o = tt * 64 + c0 + c;
      const float r = sigmoidf_(ca[o] + p.rg_ba[ch]);
      const float ii = sigmoidf_(cb2[o] + p.rg_bx[ch]);
      const float la = -8.0f * r * sp;
      const float av = __expf(la);
      const float e2 = 2.0f * la;
      const float om = (e2 > -0.1f) ? (-e2 * (1.0f + e2 * (0.5f + e2 * (0.16666667f + e2 * 0.041666668f)))) : (1.0f - __expf(e2));
      ca[o] = av;
      cb2[o] = sqrtf(om) * ii * xcf[o];
    }
  }
  __syncthreads();
  const int sg = tid >> 7, sdir = (tid >> 6) & 1, sch = tid & 63;
  const float* sa = coef + (sdir * 2) * 4096 + sch;
  const float* sb = sa + 4096;
  {
    float Pm = 1.f, H = 0.f;
#pragma unroll
    for (int n = 0; n < 16; ++n) {
      const int tok = sdir ? (63 - (16 * sg + n)) : (16 * sg + n);
      const float av = sa[tok * 64], bv = sb[tok * 64];
      H = av * H + bv;
      Pm *= av;
    }
    segagg[(sg * 2 + sdir) * 64 + sch] = make_float2(Pm, H);
  }
  __syncthreads();
  const int pos = sdir ? (seg == 0 ? 3 - sub : 67 - sub) : (seg == 0 ? sub : 4 + sub);
  float2* aggp = (float2*)p.agg + ((size_t)(b * 2 + sdir) * 68) * 256 + nblk * 64 + sch;
  if (mode == 0) {
    if (tid < 128) {
      float A = 1.f, B = 0.f;
#pragma unroll
      for (int s2 = 0; s2 < 4; ++s2) {
        const float2 g = segagg[(s2 * 2 + sdir) * 64 + sch];
        B = g.x * B + g.y;
        A *= g.x;
      }
      aggp[(size_t)pos * 256] = make_float2(A, B);
    }
    __syncthreads();
    return;
  }
  if (tid < 128) {
    float h = 0.f;
    for (int j = 0; j < pos; ++j) {
      const float2 g = aggp[(size_t)j * 256];
      h = g.x * h + g.y;
    }
    hin[sdir * 64 + sch] = h;
  }
  __syncthreads();
  {
    float h = hin[sdir * 64 + sch];
    for (int s2 = 0; s2 < sg; ++s2) {
      const float2 g = segagg[(s2 * 2 + sdir) * 64 + sch];
      h = g.x * h + g.y;
    }
#pragma unroll
    for (int n = 0; n < 16; ++n) {
      const int tok = sdir ? (63 - (16 * sg + n)) : (16 * sg + n);
      h = sa[tok * 64] * h + sb[tok * 64];
      Hout[sdir * 4096 + tok * 64 + sch] = h;
    }
  }
  __syncthreads();
  {
    const size_t gtok = (size_t)tokbase + T0 + tt;
    const float4 f0 = *(const float4*)(Hout + tt * 64 + c0), f1 = *(const float4*)(Hout + tt * 64 + c0 + 4);
    const float4 h0 = *(const float4*)(Hout + 4096 + tt * 64 + c0), h1 = *(const float4*)(Hout + 4096 + tt * 64 + c0 + 4);
    const uint4 g = *(const uint4*)(p.rg + gtok * 512 + 256 + chb);
    uint4 o;
    o.x = pk2((f0.x + h0.x) * gelu_tanh(bflo(g.x)), (f0.y + h0.y) * gelu_tanh(bfhi(g.x)));
    o.y = pk2((f0.z + h0.z) * gelu_tanh(bflo(g.y)), (f0.w + h0.w) * gelu_tanh(bfhi(g.y)));
    o.z = pk2((f1.x + h1.x) * gelu_tanh(bflo(g.z)), (f1.y + h1.y) * gelu_tanh(bfhi(g.z)));
    o.w = pk2((f1.z + h1.z) * gelu_tanh(bflo(g.w)), (f1.w + h1.w) * gelu_tanh(bfhi(g.w)));
    *(uint4*)(p.ycat + gtok * 1024 + 768 + chb) = o;
  }
  __syncthreads();
}

__device__ __forceinline__ void attn_wave(const P& p, int l, int b, int h, bool local, int r, int half, int qtok0, const float* rpbL) {
  const int lane = opaque_tid() & 63, q = lane & 31, hh = lane >> 5;
  bf16x8 qf[4];
  {
    const u16* qp = p.qk + (size_t)(qtok0 + q) * 1024 + h * 64 + 8 * hh;
#pragma unroll
    for (int s = 0; s < 4; ++s) qf[s] = *(const bf16x8*)(qp + 16 * s);
  }
  f32x16 o0 = zero16(), o1 = zero16();
  float m_run = -1e30f, l_run = 0.f;
  const int pi = (q & 19) | ((q & 4) << 1) | ((q & 8) >> 1);
  const int w = half * 32 + q;
  const int st = min(max(w - 8, 0), 48);
  const int rs = min(max(r - 4, 0), 56);
  const int ntiles = local ? 24 : 8;
  for (int ti = 0; ti < ntiles; ++ti) {
    int ktok0, vstride, a = 0, g = 0;
    const u16* vb;
    if (ti < 8) {
      ktok0 = NLAT + b * 256 + ti * 32;
      vb = p.vTc + ((size_t)(b * 512 + h * 64)) * 256 + ti * 32;
      vstride = 256;
    } else {
      const int tl = ti - 8;
      a = tl >> 1; g = tl & 1;
      ktok0 = b * 4096 + (rs + a) * 64 + g * 32;
      vb = p.vT + ((size_t)(b * 512 + h * 64)) * 4096 + (rs + a) * 64 + g * 32;
      vstride = 4096;
    }
    bf16x8 kf[4], vf[2][2];
    {
      const u16* kp = p.qk + (size_t)(ktok0 + pi) * 1024 + 512 + h * 64 + 8 * hh;
#pragma unroll
      for (int s = 0; s < 4; ++s) kf[s] = *(const bf16x8*)(kp + 16 * s);
#pragma unroll
      for (int dt = 0; dt < 2; ++dt)
#pragma unroll
        for (int s2 = 0; s2 < 2; ++s2) vf[dt][s2] = *(const bf16x8*)(vb + (size_t)(dt * 32 + q) * vstride + 16 * s2 + 8 * hh);
    }
    f32x16 sacc = zero16();
#pragma unroll
    for (int s = 0; s < 4; ++s) sacc = mfma32(kf[s], qf[s], sacc);
    float sv[16];
    float tmax = -1e30f;
#pragma unroll
    for (int e = 0; e < 16; ++e) {
      float x = sacc[e] * 0.125f;
      if (ti >= 8) {
        const int kc = g * 32 + (e & 7) + 8 * hh + 16 * (e >> 3);
        const bool valid = (kc >= st) && (kc < st + 16);
        const int bi = valid ? ((rs + a - r + 7) * 31 + (kc - w + 15)) : 0;
        const float bias = rpbL[bi];
        x = valid ? (x + bias) : -1e30f;
      }
      sv[e] = x;
      tmax = fmaxf(tmax, x);
    }
    tmax = fmaxf(tmax, shx(tmax, 32));
    const float m_new = fmaxf(m_run, tmax);
    const float alpha = __expf(m_run - m_new);
    m_run = m_new;
    l_run *= alpha;
#pragma unroll
    for (int e = 0; e < 16; ++e) { o0[e] *= alpha; o1[e] *= alpha; }
    float psum = 0.f;
#pragma unroll
    for (int e = 0; e < 16; ++e) { const float pe = __expf(sv[e] - m_new); sv[e] = pe; psum += pe; }
    l_run += psum;
    bf16x8 pf[2];
#pragma unroll
    for (int s2 = 0; s2 < 2; ++s2) {
      union { bf16x8 v; unsigned u[4]; } cv;
#pragma unroll
      for (int j = 0; j < 4; ++j) cv.u[j] = pk2(sv[8 * s2 + 2 * j], sv[8 * s2 + 2 * j + 1]);
      pf[s2] = cv.v;
    }
#pragma unroll
    for (int s2 = 0; s2 < 2; ++s2) {
      o0 = mfma32(vf[0][s2], pf[s2], o0);
      o1 = mfma32(vf[1][s2], pf[s2], o1);
    }
  }
  const float lt = l_run + shx(l_run, 32);
  const float inv = 1.0f / lt;
  u16* op = p.ycat + (size_t)(qtok0 + q) * 1024 + h * 64;
#pragma unroll
  for (int qd = 0; qd < 4; ++qd) {
    uint2 a0, a1;
    a0.x = pk2(o0[4 * qd] * inv, o0[4 * qd + 1] * inv);
    a0.y = pk2(o0[4 * qd + 2] * inv, o0[4 * qd + 3] * inv);
    a1.x = pk2(o1[4 * qd] * inv, o1[4 * qd + 1] * inv);
    a1.y = pk2(o1[4 * qd + 2] * inv, o1[4 * qd + 3] * inv);
    *(uint2*)(op + 8 * qd + 4 * hh) = a0;
    *(uint2*)(op + 32 + 8 * qd + 4 * hh) = a1;
  }
}
__device__ __forceinline__ void attn_task(const P& p, int l, int kind, int idx, char* smem) {
  const int tid_ = opaque_tid(); const int lane = tid_ & 63, wid = tid_ >> 6;
  float* rpbL = (float*)smem + wid * 480;
  for (int i = lane; i < 465; i += 64) rpbL[i] = p.na_rpb[(size_t)(l * 8 + wid) * 465 + i];
  __syncthreads();
  if (kind == 0) {
    const int half = idx & 1, r = (idx >> 1) & 63, b = idx >> 7;
    attn_wave(p, l, b, wid, true, r, half, b * 4096 + r * 64 + half * 32, rpbL);
  } else {
    const int qg = idx & 7, b = idx >> 3;
    attn_wave(p, l, b, wid, false, 0, 0, NLAT + b * 256 + qg * 32, rpbL);
  }
  __syncthreads();
}

__device__ __forceinline__ void phase_mixers(const P& p, int l, char* smem, unsigned* counter) {
  const bool last = (l == 1);
  const int n_rg = 2176 * XRGA, n_fft = 1024 * XFFT, n_hc = last ? 0 : 256, n_att = 1024 * XATT, n_attc = last ? 0 : 64;
  const int total = n_rg + n_fft + n_hc + n_att + n_attc;
  volatile int* s_taskp = (volatile int*)(smem + SMEM_BYTES - 16);
  for (;;) {
    __syncthreads();
    if (threadIdx.x == 0) *s_taskp = (int)atomicAdd(counter, 1u);
    __syncthreads();
    int t = *s_taskp;
    if (t >= total) break;
    if (t < n_rg) { if (t >= 2176) t -= 2176; rg_chunk_task(p, l, t >> 2, t & 3, 0, last, smem); continue; }
    t -= n_rg;
    if (t < n_fft) { t &= 1023; hyena_fft_task(p, l, t >> 2, t & 3, smem); continue; }
    t -= n_fft;
    if (t < n_hc) { hyena_ctx_task(p, l, t >> 5, t & 31, smem); continue; }
    t -= n_hc;
    if (t < n_att) { t &= 1023; attn_task(p, l, 0, t, smem); continue; }
    t -= n_att;
    attn_task(p, l, 1, t, smem);
  }
}

__device__ __forceinline__ void merge_tile(const P& p, int l, int mt, int nt, char* smem) {
  EPI_VARS
  const int m0 = mt * 256, n0 = nt * 128;
  f32x16 macc[2][2];
  zero_acc(macc);
  for (int br = 0; br < 3; ++br) {
    unsigned* gpl = (unsigned*)(smem + 98304) + tid;
    {
      f32x16 acc[2][2];
      zero_acc(acc);
      gemm_kloop(acc, p.xn + (size_t)m0 * 1024, 1024, p.WgT + ((size_t)l * 3072 + br * 1024 + n0) * 1024, 1024, 1024, smem);
#pragma unroll
      for (int j = 0; j < 2; ++j) {
        const float bg = p.b_gate[l * 3072 + br * 1024 + n0 + EPI_COL(j)];
#pragma unroll
        for (int i = 0; i < 2; ++i)
#pragma unroll
          for (int e = 0; e < 4; ++e) {
            const unsigned q0 = (unsigned)(sigmoidf_(acc[i][j][4 * e] + bg) * 255.0f + 0.5f);
            const unsigned q1 = (unsigned)(sigmoidf_(acc[i][j][4 * e + 1] + bg) * 255.0f + 0.5f);
            const unsigned q2 = (unsigned)(sigmoidf_(acc[i][j][4 * e + 2] + bg) * 255.0f + 0.5f);
            const unsigned q3 = (unsigned)(sigmoidf_(acc[i][j][4 * e + 3] + bg) * 255.0f + 0.5f);
            gpl[((i * 2 + j) * 4 + e) * 512] = q0 | (q1 << 8) | (q2 << 16) | (q3 << 24);
          }
      }
    }
    {
      f32x16 acc[2][2];
      zero_acc(acc);
      const u16* A; const u16* B; int K;
      if (br == 0) { A = p.ycat + (size_t)m0 * 1024; B = p.WaT + ((size_t)l * 1024 + n0) * 512; K = 512; }
      else if (br == 1) { A = p.ycat + (size_t)m0 * 1024 + 512; B = p.WbT + ((size_t)l * 1024 + n0) * 256; K = 256; }
      else { A = p.ycat + (size_t)m0 * 1024 + 768; B = p.WcT + ((size_t)l * 1024 + n0) * 256; K = 256; }
      gemm_kloop(acc, A, 1024, B, K, K, smem);
#pragma unroll
      for (int i = 0; i < 2; ++i)
#pragma unroll
        for (int j = 0; j < 2; ++j)
#pragma unroll
          for (int e = 0; e < 4; ++e) {
            const unsigned g4 = gpl[((i * 2 + j) * 4 + e) * 512];
            macc[i][j][4 * e] += (float)(g4 & 255u) * (1.0f / 255.0f) * acc[i][j][4 * e];
            macc[i][j][4 * e + 1] += (float)((g4 >> 8) & 255u) * (1.0f / 255.0f) * acc[i][j][4 * e + 1];
            macc[i][j][4 * e + 2] += (float)((g4 >> 16) & 255u) * (1.0f / 255.0f) * acc[i][j][4 * e + 2];
            macc[i][j][4 * e + 3] += (float)(g4 >> 24) * (1.0f / 255.0f) * acc[i][j][4 * e + 3];
          }
    }
  }
#pragma unroll
  for (int i = 0; i < 2; ++i)
#pragma unroll
    for (int j = 0; j < 2; ++j)
#pragma unroll
      for (int e = 0; e < 16; ++e)
        p.mbuf[(size_t)(m0 + EPI_ROW(i, e)) * 1024 + n0 + EPI_COL(j)] = f2bf(macc[i][j][e]);
}
__device__ __forceinline__ void outproj_tile(const P& p, int l, int mt, int nt, char* smem, bool do_store) {
  EPI_VARS
  const int m0 = mt * 256, n0 = nt * 128;
  f32x16 acc[2][2];
  zero_acc(acc);
  gemm_kloop(acc, p.mbuf + (size_t)m0 * 1024, 1024, p.WoT + ((size_t)l * 1024 + n0) * 1024, 1024, 1024, smem);
  const bool isctx = (mt >= 128);
  const int bi = isctx ? 8 : (mt >> 4);
  const float* gatev = p.mod + ((size_t)(l * 9 + bi) * 6 + 2) * 1024;
  const float* src; float* dst;
  if (isctx) { src = (l == 0 ? p.ctx : p.ctxs) - (size_t)NLAT * 1024; dst = p.ctxs - (size_t)NLAT * 1024; }
  else { src = (l == 0 ? p.x : p.out); dst = p.out; }
#pragma unroll
  for (int j = 0; j < 2; ++j) {
    const int col = n0 + EPI_COL(j);
    const float gv = gatev[col];
#pragma unroll
    for (int i = 0; i < 2; ++i)
#pragma unroll
      for (int e = 0; e < 16; ++e) {
        const size_t o = (size_t)(m0 + EPI_ROW(i, e)) * 1024 + col;
        if (do_store) dst[o] = src[o] + gv * acc[i][j][e];
      }
  }
}

__device__ __forceinline__ void ins16(unsigned (&L)[16], unsigned x) {
#pragma unroll
  for (int i = 0; i < 16; ++i) {
    const unsigned hi = max(L[i], x);
    x = min(L[i], x);
    L[i] = hi;
  }
}
__device__ __forceinline__ unsigned f2sort(float f) {
  const unsigned b = __float_as_uint(f);
  return b ^ ((unsigned)((int)b >> 31) | 0x80000000u);
}
__device__ __forceinline__ float sort2f(unsigned k) {
  const unsigned u = k & ~127u;
  const unsigned b = (u & 0x80000000u) ? (u ^ 0x80000000u) : ~u;
  return __uint_as_float(b);
}
__device__ __forceinline__ void peer_score_tile(const P& p, int l, int mt, int hp, char* smem) {
  EPI_VARS
  const int m0 = mt * 256;
  f32x16 acc[2][2];
  zero_acc(acc);
  gemm_kloop(acc, p.q + (size_t)m0 * 2048 + hp * 128, 2048, p.keysB + ((size_t)l * 16 + hp) * 16384, 128, 128, smem);
  float* Sf = (float*)smem;
#pragma unroll
  for (int i = 0; i < 2; ++i)
#pragma unroll
    for (int j = 0; j < 2; ++j)
#pragma unroll
      for (int e = 0; e < 16; ++e) Sf[EPI_ROW(i, e) * 130 + EPI_COL(j)] = acc[i][j][e];
  __syncthreads();
  unsigned L[16];
#pragma unroll
  for (int i = 0; i < 16; ++i) L[i] = 0u;
  const int row = tid >> 1, hf = tid & 1;
  for (int i = 0; i < 64; ++i) {
    const int key = 2 * i + hf;
    const float v = Sf[row * 130 + key];
    ins16(L, (f2sort(v) & ~127u) | (unsigned)key);
  }
  unsigned* X = (unsigned*)(smem + 133120);
  if (hf) {
#pragma unroll
    for (int i = 0; i < 16; ++i) X[row * 16 + i] = L[i];
  }
  __syncthreads();
  if (!hf) {
#pragma unroll
    for (int i = 0; i < 16; ++i) ins16(L, X[row * 16 + i]);
    unsigned* o = p.topk + ((size_t)(m0 + row) * 16 + hp) * 16;
#pragma unroll
    for (int i = 0; i < 4; ++i) *(uint4*)(o + 4 * i) = make_uint4(L[4 * i], L[4 * i + 1], L[4 * i + 2], L[4 * i + 3]);
  }
  __syncthreads();
}

__device__ __forceinline__ void phase_peer_experts(const P& p, int l, bool do_store) {
  const int tid_ = opaque_tid(); const int lane = tid_ & 63, wid = tid_ >> 6;
  const int ntok = (l == 1) ? NLAT : NTOK;
  int ci, cj;
  {
    const int e = lane;
    if (e < 16) { ci = 0; cj = e; }
    else if (e < 24) { ci = 1; cj = e - 16; }
    else if (e < 29) { ci = 2; cj = e - 24; }
    else if (e < 33) { ci = 3; cj = e - 29; }
    else if (e < 36) { ci = 4; cj = e - 33; }
    else if (e < 38) { ci = 5; cj = e - 36; }
    else if (e < 40) { ci = 6; cj = e - 38; }
    else if (e < 42) { ci = 7; cj = e - 40; }
    else { ci = min(8 + (e - 42), 15); cj = 0; }
  }
  for (int tok = blockIdx.x * 8 + wid; tok < ntok; tok += gridDim.x * 8) {
    float xr[16];
    {
      const uint4 a = *(const uint4*)(p.xn + (size_t)tok * 1024 + lane * 16);
      const uint4 b = *(const uint4*)(p.xn + (size_t)tok * 1024 + lane * 16 + 8);
      xr[0] = bflo(a.x); xr[1] = bfhi(a.x); xr[2] = bflo(a.y); xr[3] = bfhi(a.y);
      xr[4] = bflo(a.z); xr[5] = bfhi(a.z); xr[6] = bflo(a.w); xr[7] = bfhi(a.w);
      xr[8] = bflo(b.x); xr[9] = bfhi(b.x); xr[10] = bflo(b.y); xr[11] = bfhi(b.y);
      xr[12] = bflo(b.z); xr[13] = bfhi(b.z); xr[14] = bflo(b.w); xr[15] = bfhi(b.w);
    }
    float yacc[16];
#pragma unroll
    for (int i = 0; i < 16; ++i) yacc[i] = 0.f;
    unsigned kvh[8];
#pragma unroll
    for (int h = 0; h < 8; ++h) kvh[h] = p.topk[((size_t)tok * 16 + 2 * h) * 16 + (lane & 31)];
    int eperm[8], gperm[8];
#pragma unroll
    for (int h = 0; h < 8; ++h) {
      const unsigned k0 = shu(kvh[h], ci);
      const unsigned k1 = shu(kvh[h], 16 + cj);
      const float val = (lane < 50) ? (sort2f(k0) + sort2f(k1)) : -3.0e38f;
      const int eidx = (int)((k0 & 127u) * 128u + (k1 & 127u));
      int cnt = 0;
#pragma unroll
      for (int e2 = 0; e2 < 50; ++e2) {
        const float v2 = __builtin_bit_cast(float, __builtin_amdgcn_readlane(__builtin_bit_cast(int, val), e2));
        cnt += (v2 > val || (v2 == val && e2 < lane)) ? 1 : 0;
      }
      const bool sel = (lane < 50) && (cnt < 16);
      const float mx = wave_max(sel ? val : -3.0e38f);
      const float ex = sel ? __expf(val - mx) : 0.f;
      const float sm = wave_sum(ex);
      const float gsel = ex / sm;
      const int dst4 = (sel ? cnt : 63) * 4;
      eperm[h] = __builtin_amdgcn_ds_permute(dst4, eidx);
      gperm[h] = __builtin_amdgcn_ds_permute(dst4, __builtin_bit_cast(int, gsel));
    }
    uint2 ua[8], va[8], ub[8], vb[8];
#define PEER_LOAD(U, V, H, IT) do { _Pragma("unroll") for (int k = 0; k < 8; ++k) { \
      const int id = __builtin_amdgcn_readlane(eperm[H], (IT) * 8 + k); \
      U[k] = *(const uint2*)(p.Ub + (size_t)id * 512 + lane * 8); \
      V[k] = *(const uint2*)(p.Vb + (size_t)id * 512 + lane * 8); } } while (0)
#define PEER_COMPUTE(U, V, H, IT) do { \
      float d[8]; \
      _Pragma("unroll") for (int k = 0; k < 8; ++k) { \
        const unsigned uw[2] = {U[k].x, U[k].y}; \
        float dd = 0.f; \
        _Pragma("unroll") for (int q2 = 0; q2 < 2; ++q2) { \
          const f32x2 e0 = __builtin_amdgcn_cvt_scalef32_pk_f32_fp4(uw[q2], 1.0f, 0); \
          const f32x2 e1 = __builtin_amdgcn_cvt_scalef32_pk_f32_fp4(uw[q2], 1.0f, 1); \
          const f32x2 e2 = __builtin_amdgcn_cvt_scalef32_pk_f32_fp4(uw[q2], 1.0f, 2); \
          const f32x2 e3 = __builtin_amdgcn_cvt_scalef32_pk_f32_fp4(uw[q2], 1.0f, 3); \
          dd += xr[8 * q2] * e0.x + xr[8 * q2 + 1] * e0.y + xr[8 * q2 + 2] * e1.x + xr[8 * q2 + 3] * e1.y + \
                xr[8 * q2 + 4] * e2.x + xr[8 * q2 + 5] * e2.y + xr[8 * q2 + 6] * e3.x + xr[8 * q2 + 7] * e3.y; } \
        d[k] = dd; } \
      { const bool b5 = (lane & 32) != 0, b4 = (lane & 16) != 0, b3 = (lane & 8) != 0; \
        _Pragma("unroll") for (int j = 0; j < 4; ++j) { const float keep = b5 ? d[j + 4] : d[j], send = b5 ? d[j] : d[j + 4]; d[j] = keep + shx(send, 32); } \
        _Pragma("unroll") for (int j = 0; j < 2; ++j) { const float keep = b4 ? d[j + 2] : d[j], send = b4 ? d[j] : d[j + 2]; d[j] = keep + shx(send, 16); } \
        { const float keep = b3 ? d[1] : d[0], send = b3 ? d[0] : d[1]; d[0] = keep + shx(send, 8); } \
        d[0] += shx(d[0], 4); d[0] += shx(d[0], 2); d[0] += shx(d[0], 1); } \
      const float gl = __builtin_bit_cast(float, shu((unsigned)gperm[H], (IT) * 8 + ((lane >> 3) & 7))); \
      const float act = gelu_tanh(d[0] * (1.0f / 64.0f)) * gl; \
      _Pragma("unroll") for (int k = 0; k < 8; ++k) { \
        const float ak = __builtin_bit_cast(float, __builtin_amdgcn_readlane(__builtin_bit_cast(int, act), 8 * k)); \
        const unsigned vw[2] = {V[k].x, V[k].y}; \
        _Pragma("unroll") for (int q2 = 0; q2 < 2; ++q2) { \
          const f32x2 e0 = __builtin_amdgcn_cvt_scalef32_pk_f32_fp4(vw[q2], 1.0f, 0); \
          const f32x2 e1 = __builtin_amdgcn_cvt_scalef32_pk_f32_fp4(vw[q2], 1.0f, 1); \
          const f32x2 e2 = __builtin_amdgcn_cvt_scalef32_pk_f32_fp4(vw[q2], 1.0f, 2); \
          const f32x2 e3 = __builtin_amdgcn_cvt_scalef32_pk_f32_fp4(vw[q2], 1.0f, 3); \
          yacc[8 * q2] += ak * e0.x; yacc[8 * q2 + 1] += ak * e0.y; yacc[8 * q2 + 2] += ak * e1.x; yacc[8 * q2 + 3] += ak * e1.y; \
          yacc[8 * q2 + 4] += ak * e2.x; yacc[8 * q2 + 5] += ak * e2.y; yacc[8 * q2 + 6] += ak * e3.x; yacc[8 * q2 + 7] += ak * e3.y; } } } while (0)
#pragma unroll
    for (int h = 0; h < 8; ++h) {
      PEER_LOAD(ua, va, h, 0);
      PEER_COMPUTE(ua, va, h, 0);
      PEER_LOAD(ub, vb, h, 1);
      PEER_COMPUTE(ub, vb, h, 1);
    }
#undef PEER_LOAD
#undef PEER_COMPUTE
    const int bi = tok < NLAT ? (tok >> 12) : 8;
    const float* gv = p.mod + ((size_t)(l * 9 + bi) * 6 + 5) * 1024 + lane * 16;
    float* xp = (tok < NLAT) ? (p.out + (size_t)tok * 1024) : (p.ctxs + (size_t)(tok - NLAT) * 1024);
    xp += lane * 16;
#pragma unroll
    for (int i = 0; i < 4; ++i) {
      float4 xv = *(float4*)(xp + 4 * i);
      const float4 g4 = *(const float4*)(gv + 4 * i);
      xv.x += g4.x * yacc[4 * i] * 0.25f; xv.y += g4.y * yacc[4 * i + 1] * 0.25f; xv.z += g4.z * yacc[4 * i + 2] * 0.25f; xv.w += g4.w * yacc[4 * i + 3] * 0.25f;
      if (do_store) *(float4*)(xp + 4 * i) = xv;
    }
  }
}


#define XB_TMO      128
#define XB_XCNT(j)  (256  + 64 * (j))
#define XB_XSUB(j)  (1280 + 64 * (j))
#define XB_XGEN(j)  (2304 + 64 * (j))
#define XB_TOP      3328
#define XB_TOPGEN   3392
#define XCD_BAR_WORDS 3456
#define XB_SPIN_CAP (1u << 22)
#define LAS __attribute__((address_space(3)))
__device__ __forceinline__ unsigned xb_ld(unsigned* p) { return __hip_atomic_load(p, __ATOMIC_RELAXED, __HIP_MEMORY_SCOPE_AGENT); }
__device__ __forceinline__ unsigned xb_add(unsigned* p, unsigned v) { return __hip_atomic_fetch_add(p, v, __ATOMIC_RELAXED, __HIP_MEMORY_SCOPE_AGENT); }
__device__ __forceinline__ unsigned xb_xcc_id() { return (unsigned)__builtin_amdgcn_s_getreg((3 << 11) | 20) & 0xFu; }
#define XB_SPIN(cond, bar) do { unsigned _sp = 0; while (cond) { __builtin_amdgcn_s_sleep(1); \
    if ((++_sp & 255u) == 0u) { if (xb_ld(&(bar)[XB_TMO])) break; if (_sp > XB_SPIN_CAP) { atomicAdd(&(bar)[XB_TMO], 1u); break; } } } } while (0)
struct XcdBarrier { unsigned* bar; unsigned x; volatile LAS unsigned* st; };
__device__ __forceinline__ XcdBarrier xcd_barrier_post(unsigned* bar, volatile LAS unsigned* st) {
  XcdBarrier b; b.bar = bar; b.x = xb_xcc_id(); b.st = st;
  if (threadIdx.x == 0) (void)xb_add(&bar[XB_XCNT(b.x)], 1u);
  return b;
}
__device__ __forceinline__ void xcd_barrier_complete(unsigned* bar, unsigned x, unsigned& nloc, unsigned& nx) {
  const unsigned G = gridDim.x * gridDim.y * gridDim.z;
  unsigned sum, cnt, mine, sp = 0u;
  for (;;) {
    sum = 0u; cnt = 0u; mine = 0u;
#pragma unroll
    for (unsigned j = 0; j < 16; ++j) { const unsigned c = xb_ld(&bar[XB_XCNT(j)]); sum += c; cnt += (c > 0u) ? 1u : 0u; mine = (j == x) ? c : mine; }
    if (sum == G) break;
    __builtin_amdgcn_s_sleep(1);
    if ((++sp & 255u) == 0u) { if (xb_ld(&bar[XB_TMO])) break; if (sp > XB_SPIN_CAP) { atomicAdd(&bar[XB_TMO], 1u); break; } }
  }
  nloc = mine > 0u ? mine : 1u; nx = cnt > 0u ? cnt : 1u;
}
__device__ __forceinline__ void xcd_barrier(unsigned* bar_u, volatile LAS unsigned* st_u) {
  XcdBarrier b; b.bar = bar_u; b.x = xb_xcc_id(); b.st = st_u;
  asm volatile("s_waitcnt vmcnt(0)" ::: "memory");
  __syncthreads();
  if (threadIdx.x == 0) {
    unsigned long long bp_ = (unsigned long long)b.bar;
    asm volatile("" : "+v"(bp_));
    unsigned* bar = (unsigned*)bp_;
    __builtin_amdgcn_s_waitcnt(0);
    unsigned nloc = b.st[0], nx = b.st[1];
    if (nloc == 0u) { xcd_barrier_complete(bar, b.x, nloc, nx); b.st[0] = nloc; b.st[1] = nx; }
    const unsigned old = xb_add(&bar[XB_XSUB(b.x)], 1u);
    const unsigned gen = old / nloc;
    if (old + 1u == (gen + 1u) * nloc) {
      __builtin_amdgcn_fence(__ATOMIC_RELEASE, "agent");
      asm volatile("s_waitcnt vmcnt(0)" ::: "memory");
      const unsigned og = xb_add(&bar[XB_TOP], 1u);
      const unsigned tg = og / nx;
      if (og + 1u == (tg + 1u) * nx) xb_add(&bar[XB_TOPGEN], 1u);
      else XB_SPIN(xb_ld(&bar[XB_TOPGEN]) == tg, bar);
      __builtin_amdgcn_fence(__ATOMIC_ACQUIRE, "agent");
      xb_add(&bar[XB_XGEN(b.x)], 1u);
      asm volatile("s_waitcnt vmcnt(0)" ::: "memory");
    } else {
      XB_SPIN(xb_ld(&bar[XB_XGEN(b.x)]) == gen, bar);
      __builtin_amdgcn_fence(__ATOMIC_ACQUIRE, "agent");
      asm volatile("s_waitcnt vmcnt(0)" ::: "memory");
    }
  }
  __syncthreads();
}

__global__ void __launch_bounds__(NTHR) fwd_megakernel(P p) {
  __shared__ __attribute__((aligned(16))) char smem[SMEM_BYTES];
  cg::grid_group grid = cg::this_grid();
  const int nb = gridDim.x, bid = blockIdx.x;
  pg8::PG8_LAS_T lds = (pg8::PG8_LAS_T)smem;
  volatile LAS unsigned* xbw = (volatile LAS unsigned*)(smem + SMEM_BYTES - 32);
  if (threadIdx.x == 0) { xbw[0] = 0u; xbw[1] = 0u; xbw[2] = 0u; xbw[3] = 0u; }
  __syncthreads();
  (void)xcd_barrier_post(p.counters + 1024, xbw);

  phase_prep(p, smem);
  grid.sync();
  phase_modreduce(p);
  xcd_barrier(p.counters + 1024, xbw);

  for (int l = 0; l < 2; ++l) {
    const bool last = (l == 1);
    const int n_mt = last ? 128 : 136;
_Pragma("unroll 1")
    for (int rep = 0; rep < REP_1A; ++rep) {
      phase_filters(p, l);
      phase_norm(p, l, 0);
    }
    xcd_barrier(p.counters + 1024, xbw);
_Pragma("unroll 1")
    for (int rep = 0; rep < REP_KF; ++rep)
      if (bid < 256) kf_task(p, bid, smem);
_Pragma("unroll 1")
    for (int rep = 0; rep < REP_INPROJ; ++rep) {
      pg8::Gemm g; pg8::Order S;
      g.A = p.xn; g.Bt = p.WinT + (size_t)l * 2816 * 1024; g.lda = 1024; g.ldb = 1024; g.K = 1024;
      S.init(136, 6, nb, bid, 4, 5);
      pg8::EpiInprojN e1; e1.qk = p.qk; e1.rg = p.rg;
      pg8::gemm_phase(lds, g, S, e1);
      g.A = p.WinT + ((size_t)l * 2816 + 1024) * 1024; g.Bt = p.xn;
      S.init(5, 136, nb, bid);
      pg8::EpiInprojT e2; e2.vT = p.vT; e2.vTc = p.vTc; e2.hyT = p.hyT; e2.hyTc = p.hyTc;
      pg8::gemm_phase(lds, g, S, e2);
    }
    xcd_barrier(p.counters + 1024, xbw);
    phase_mixers(p, l, smem, p.counters + l * 4);
    xcd_barrier(p.counters + 1024, xbw);
_Pragma("unroll 1")
    for (int rep = 0; rep < REP_2B; ++rep)
      for (int task = bid; task < 2176; task += nb) rg_chunk_task(p, l, task >> 2, task & 3, 1, last, smem);
    xcd_barrier(p.counters + 1024, xbw);
_Pragma("unroll 1")
    for (int rep = 0; rep < REP_GATE; ++rep) {
      pg8::Gemm g; pg8::Order S;
      g.A = p.xn; g.Bt = p.WgT + (size_t)l * 3072 * 1024; g.lda = 1024; g.ldb = 1024; g.K = 1024;
      S.init(n_mt, 12, nb, bid);
      pg8::EpiGate e; e.g8 = p.g8; e.bias = p.b_gate + l * 3072;
      pg8::gemm_phase(lds, g, S, e);
    }
    xcd_barrier(p.counters + 1024, xbw);
_Pragma("unroll 1")
    for (int rep = 0; rep < REP_BRANCH; ++rep) {
      pg8::Gemm g; pg8::Order S;
      S.init(n_mt, 4, nb, bid);
      pg8::EpiBranch e; e.mbuf = p.mbuf; e.g8 = p.g8;
      g.lda = 1024;
      g.A = p.ycat; g.Bt = p.WaT + (size_t)l * 1024 * 512; g.ldb = 512; g.K = 512; e.br = 0;
      pg8::gemm_phase(lds, g, S, e);
      g.A = p.ycat + 512; g.Bt = p.WbT + (size_t)l * 1024 * 256; g.ldb = 256; g.K = 256; e.br = 1;
      pg8::gemm_phase(lds, g, S, e);
      g.A = p.ycat + 768; g.Bt = p.WcT + (size_t)l * 1024 * 256; g.ldb = 256; g.K = 256; e.br = 2;
      pg8::gemm_phase(lds, g, S, e);
    }
    xcd_barrier(p.counters + 1024, xbw);
    {
      pg8::Gemm g; pg8::Order S;
      g.A = p.mbuf; g.Bt = p.WoT + (size_t)l * 1024 * 1024; g.lda = 1024; g.ldb = 1024; g.K = 1024;
      S.init(n_mt, 4, nb, bid);
      pg8::EpiOut e; e.xsrc = (l == 0 ? p.x : p.out); e.csrc = (l == 0 ? p.ctx : p.ctxs); e.xdst = p.out; e.cdst = p.ctxs;
      e.modl = p.mod + (size_t)l * 9 * 6144;
      pg8::gemm_phase(lds, g, S, e);
      for (int t = bid; t < 8192; t += nb) {
        if (t < 4096) cvt_chunk_fp4(p.peer_u + (size_t)l * 16384 * 1024, p.Ub, (size_t)t, 64.0f);
        else cvt_chunk_fp4(p.peer_v + (size_t)l * 16384 * 1024, p.Vb, (size_t)(t - 4096), 4.0f);
      }
    }
    xcd_barrier(p.counters + 1024, xbw);
    phase_norm(p, l, 1);
    xcd_barrier(p.counters + 1024, xbw);
_Pragma("unroll 1")
    for (int rep = 0; rep < REP_Q; ++rep) {
      pg8::Gemm g; pg8::Order S;
      g.A = p.xn; g.Bt = p.WqT + (size_t)l * 2048 * 1024; g.lda = 1024; g.ldb = 1024; g.K = 1024;
      S.init(n_mt, 8, nb, bid);
      pg8::EpiQ e; e.q = p.q;
      pg8::gemm_phase(lds, g, S, e);
    }
    xcd_barrier(p.counters + 1024, xbw);
_Pragma("unroll 1")
    for (int rep = 0; rep < REP_SCORE; ++rep)
      for (int task = bid; task < n_mt * 16; task += nb) peer_score_tile(p, l, task >> 4, task & 15, smem);
    xcd_barrier(p.counters + 1024, xbw);
    phase_peer_experts(p, l, true);
    xcd_barrier(p.counters + 1024, xbw);
  }
  phase_norm(p, 1, 2);
}

extern "C" void kernel_launch(void* const* d_in, const int* in_sizes, int n_in, void* d_out, int out_size, void* d_ws,
                              size_t ws_size, hipStream_t stream) {
  P p;
  memset(&p, 0, sizeof(p));
  const float** ins = (const float**)&p;
  for (int i = 0; i < 37; ++i) ins[i] = (const float*)d_in[i];
  p.out = (float*)d_out;
  char* w = (char*)d_ws;
  size_t off = 0;
  auto take = [&](size_t bytes) { char* r = w + off; off += (bytes + 255) & ~(size_t)255; return r; };
  p.counters = (unsigned*)take(32768);
  p.WinT = (u16*)take((size_t)2 * 2816 * 1024 * 2);
  p.WgT = (u16*)take((size_t)2 * 3072 * 1024 * 2);
  p.WaT = (u16*)take((size_t)2 * 1024 * 512 * 2);
  p.WbT = (u16*)take((size_t)2 * 1024 * 256 * 2);
  p.WcT = (u16*)take((size_t)2 * 1024 * 256 * 2);
  p.WoT = (u16*)take((size_t)2 * 1024 * 1024 * 2);
  p.WqT = (u16*)take((size_t)2 * 2048 * 1024 * 2);
  p.keysB = (u16*)take((size_t)2 * 16 * 16384 * 2);
  p.rgW = (u16*)take((size_t)2 * 16 * 4096 * 2);
  p.modpart = (float*)take((size_t)16 * 2 * 9 * 6144 * 4);
  p.mod = (float*)take((size_t)2 * 9 * 6144 * 4);
  p.hT = (float*)take((size_t)512 * 4096 * 4);
  p.hc = (float*)take((size_t)512 * 256 * 4);
  p.Kf = (float*)take((size_t)256 * 8192 * 8);
  p.xn = (u16*)take((size_t)NTOK * 1024 * 2);
  p.qk = (u16*)take((size_t)NTOK * 1024 * 2);
  p.mbuf = p.qk;
  p.vT = (u16*)take((size_t)8 * 512 * 4096 * 2);
  p.vTc = (u16*)take((size_t)8 * 512 * 256 * 2);
  p.hyT = (u16*)take((size_t)8 * 768 * 4096 * 2);
  p.hyTc = (u16*)take((size_t)8 * 768 * 256 * 2);
  p.rg = (u16*)take((size_t)NTOK * 512 * 2);
  p.ycat = (u16*)take((size_t)NTOK * 1024 * 2);
  p.Ub = (unsigned char*)p.ycat;
  p.Vb = p.Ub + (size_t)16384 * 512;
  p.agg = (float*)take((size_t)8 * 2 * 68 * 256 * 8);
  p.ctxs = (float*)take((size_t)2048 * 1024 * 4);
  p.g8 = (unsigned char*)p.vT;
  p.q = p.qk;
  p.topk = (unsigned*)((char*)p.qk + (size_t)NTOK * 2048 * 2);
  if (off > ws_size) {
    fprintf(stderr, "workspace too small: need %zu have %zu\n", off, ws_size);
    return;
  }
  static int grid_blocks = 0;
  if (!grid_blocks) {
    int dev = 0, cus = 0, per_cu = 0;
    (void)hipGetDevice(&dev);
    (void)hipDeviceGetAttribute(&cus, hipDeviceAttributeMultiprocessorCount, dev);
    (void)hipOccupancyMaxActiveBlocksPerMultiprocessor(&per_cu, fwd_megakernel, NTHR, 0);
    if (per_cu > 1) per_cu = 1;
    grid_blocks = cus * per_cu;
  }
  (void)hipMemsetAsync(p.counters, 0, 32768, stream);
  void* args[] = {&p};
  hipError_t e = hipLaunchCooperativeKernel((void*)fwd_megakernel, dim3(grid_blocks), dim3(NTHR), args, 0, stream);
  if (e != hipSuccess) fprintf(stderr, "cooperative launch failed: %s (grid %d)\n", hipGetErrorString(e), grid_blocks);
}
```

```cpp
#include <hip/hip_runtime.h>
#include <hip/hip_cooperative_groups.h>
#include <cstdio>
#include <cstring>
namespace cg = cooperative_groups;

typedef unsigned short u16;
typedef __attribute__((ext_vector_type(8))) short bf16x8;
typedef __attribute__((ext_vector_type(16))) float f32x16;
typedef __attribute__((ext_vector_type(2))) float f32x2;

#define NLAT 32768
#define NTOK 34816
#define SMEM_BYTES 151552
#define NTHR 512
#ifndef DUP_1A
#define DUP_1A 1
#endif
#ifndef DUP_PREP
#define DUP_PREP 1
#endif
#ifndef DUP_2B
#define DUP_2B 1
#endif
#ifndef XRGA
#define XRGA 1
#endif
#ifndef REP_PEER
#define REP_PEER 1
#endif
#ifndef REP_INPROJ
#define REP_INPROJ 1
#endif
#ifndef REP_GATE
#define REP_GATE 1
#endif
#ifndef REP_BRANCH
#define REP_BRANCH 1
#endif
#ifndef REP_Q
#define REP_Q 1
#endif
#ifndef REP_SCORE
#define REP_SCORE 1
#endif
#ifndef REP_1A
#define REP_1A 1
#endif
#ifndef REP_2B
#define REP_2B 1
#endif
#ifndef REP_KF
#define REP_KF 1
#endif
#ifndef DUP_GEMM
#define DUP_GEMM 1
#endif
#ifndef DUP_PEER
#define DUP_PEER 1
#endif
#ifndef DUP_MIX
#define DUP_MIX 1
#endif
#ifndef XRG
#define XRG 1
#endif
#ifndef XFFT
#define XFFT 1
#endif
#ifndef XATT
#define XATT 1
#endif

struct P {
  const float *x, *c, *ctx, *c_ctx, *norm_mix_g, *norm_ffn_g, *w_ada, *b_ada, *w_in, *na_rpb,
      *hy_short_w, *hy_short_b, *hy_f1_w, *hy_f1_b, *hy_f2_w, *hy_f2_b, *hy_f3_w, *hy_freq, *hy_bias,
      *rg_conv_w, *rg_conv_b, *rg_wa, *rg_ba, *rg_wx, *rg_bx, *rg_lambda,
      *w_gate, *b_gate, *w_br_a, *w_br_b, *w_br_c, *w_out, *peer_wq, *peer_keys, *peer_u, *peer_v, *final_g;
  float* out;
  unsigned* counters;
  u16 *WinT, *WgT, *WaT, *WbT, *WcT, *WoT, *WqT, *keysB, *rgW;
  float *modpart, *mod, *hT, *hc;
  float* Kf;
  u16 *xn, *qk, *vT, *vTc, *hyT, *hyTc, *rg, *ycat, *mbuf;
  unsigned char *Ub, *Vb, *g8;
  u16* q;
  float *agg, *ctxs;
  unsigned* topk;
};

__device__ __forceinline__ u16 f2bf(float f) {
  unsigned u = __float_as_uint(f);
  u += 0x7fffu + ((u >> 16) & 1u);
  return (u16)(u >> 16);
}
__device__ __forceinline__ float bf2f(u16 h) { return __uint_as_float(((unsigned)h) << 16); }
__device__ __forceinline__ unsigned pk2(float a, float b) { return (unsigned)f2bf(a) | ((unsigned)f2bf(b) << 16); }
__device__ __forceinline__ float bflo(unsigned u) { return __uint_as_float(u << 16); }
__device__ __forceinline__ float bfhi(unsigned u) { return __uint_as_float(u & 0xffff0000u); }
__device__ __forceinline__ int opaque_tid() {
  int t = threadIdx.x;
  asm volatile("" : "+v"(t));
  return t;
}
__device__ __forceinline__ int my_lane() { return opaque_tid() & 63; }
__device__ __forceinline__ float shx(float v, int o) { return __builtin_bit_cast(float, __builtin_amdgcn_ds_bpermute(((my_lane() ^ o) << 2), __builtin_bit_cast(int, v))); }
__device__ __forceinline__ float shf(float v, int src) { return __builtin_bit_cast(float, __builtin_amdgcn_ds_bpermute((src & 63) << 2, __builtin_bit_cast(int, v))); }
__device__ __forceinline__ unsigned shu(unsigned v, int src) { return (unsigned)__builtin_amdgcn_ds_bpermute((src & 63) << 2, (int)v); }
__device__ __forceinline__ float wave_sum(float v) {
  const int lane = my_lane();
#pragma unroll
  for (int o = 32; o > 0; o >>= 1) v += __builtin_bit_cast(float, __builtin_amdgcn_ds_bpermute((lane ^ o) << 2, __builtin_bit_cast(int, v)));
  return v;
}
__device__ __forceinline__ float wave_max(float v) {
  const int lane = my_lane();
#pragma unroll
  for (int o = 32; o > 0; o >>= 1) v = fmaxf(v, __builtin_bit_cast(float, __builtin_amdgcn_ds_bpermute((lane ^ o) << 2, __builtin_bit_cast(int, v))));
  return v;
}
__device__ __forceinline__ float sigmoidf_(float x) { return __builtin_amdgcn_rcpf(1.0f + __expf(-x)); }
__device__ __forceinline__ float gelu_tanh(float x) {
  const float u2 = 1.5957691216057308f * (x + 0.044715f * x * x * x);
  return x * __builtin_amdgcn_rcpf(1.0f + __expf(-u2));
}
__device__ __forceinline__ f32x16 mfma32(bf16x8 a, bf16x8 b, f32x16 c) {
  return __builtin_amdgcn_mfma_f32_32x32x16_bf16(a, b, c, 0, 0, 0);
}
__device__ __forceinline__ f32x16 zero16() {
  f32x16 z;
#pragma unroll
  for (int i = 0; i < 16; ++i) z[i] = 0.f;
  return z;
}
__device__ __forceinline__ int swz128(int row, int ch) { return row * 128 + ((ch ^ ((row >> 1) & 7)) << 4); }
__device__ __forceinline__ int swz256(int row, int ch) { return row * 256 + ((ch ^ (row & 15)) << 4); }

struct c2 { float x, y; };
__device__ __forceinline__ c2 cadd(c2 a, c2 b) { return {a.x + b.x, a.y + b.y}; }
__device__ __forceinline__ c2 csub(c2 a, c2 b) { return {a.x - b.x, a.y - b.y}; }
__device__ __forceinline__ c2 cmul(c2 a, c2 b) { return {a.x * b.x - a.y * b.y, a.x * b.y + a.y * b.x}; }
__device__ __forceinline__ float c16(int i) {
  const float tb[16] = {1.0f, 0.9238795325112867f, 0.7071067811865476f, 0.3826834323650898f, 0.0f,
                        -0.3826834323650898f, -0.7071067811865476f, -0.9238795325112867f, -1.0f,
                        -0.9238795325112867f, -0.7071067811865476f, -0.3826834323650898f, 0.0f,
                        0.3826834323650898f, 0.7071067811865476f, 0.9238795325112867f};
  return tb[i & 15];
}
__device__ __forceinline__ float s16(int i) { return c16(i + 12); }
template <int R> __device__ __forceinline__ constexpr int brev(int k) {
  int r = 0;
  for (int b = 1, o = R >> 1; b < R; b <<= 1, o >>= 1)
    if (k & b) r |= o;
  return r;
}
template <int R> __device__ __forceinline__ void dft_reg(c2* v, float sgn) {
#pragma unroll
  for (int h = R / 2; h >= 1; h >>= 1) {
#pragma unroll
    for (int g = 0; g < R; g += 2 * h) {
#pragma unroll
      for (int j = 0; j < h; ++j) {
        c2 a = v[g + j], b = v[g + j + h];
        v[g + j] = cadd(a, b);
        c2 d = csub(a, b);
        const int ti = j * (16 / (2 * h));
        c2 w = {c16(ti), sgn * s16(ti)};
        v[g + j + h] = (j == 0) ? d : cmul(d, w);
      }
    }
  }
}
template <int R> __device__ __forceinline__ int fft_bfly(c2* v, int j, int Ns, float sgn) {
  const int k = j & (Ns - 1);
  const float f = sgn * (float)k / (float)(Ns * R);
#pragma unroll
  for (int r = 1; r < R; ++r) {
    float t = f * (float)r;
    c2 w = {__builtin_amdgcn_cosf(t), __builtin_amdgcn_sinf(t)};
    v[r] = cmul(v[r], w);
  }
  dft_reg<R>(v, sgn);
  return (j - k) * R + k;
}
template <int R> __device__ __forceinline__ void fft_pass(c2* buf, int Ns, float sgn) {
  constexpr int NBF = 8192 / R;
  constexpr int PER = NBF / NTHR;
  const int tid = opaque_tid();
  c2 v[PER][R];
#pragma unroll
  for (int i = 0; i < PER; ++i) {
    const int j = tid + NTHR * i;
#pragma unroll
    for (int r = 0; r < R; ++r) v[i][r] = buf[j + r * NBF];
  }
  __syncthreads();
#pragma unroll
  for (int i = 0; i < PER; ++i) {
    const int j = tid + NTHR * i;
    const int base = fft_bfly<R>(v[i], j, Ns, sgn);
#pragma unroll
    for (int r = 0; r < R; ++r) buf[base + r * Ns] = v[i][brev<R>(r)];
  }
  __syncthreads();
}
__device__ __forceinline__ void fft8192(c2* buf, float sgn) {
  fft_pass<8>(buf, 1, sgn);
  fft_pass<8>(buf, 8, sgn);
  fft_pass<8>(buf, 64, sgn);
  fft_pass<16>(buf, 512, sgn);
}

__device__ __forceinline__ void gemm_kloop(f32x16 (&acc)[2][2], const u16* __restrict__ A, int lda,
                                           const u16* __restrict__ B, int ldb, int K, char* smem) {
  const int tid = opaque_tid(), lane = tid & 63, wid = tid >> 6;
  const int wm = wid >> 1, wn = wid & 1;
  const int l31 = lane & 31, hh = lane >> 5;
  uint4 ra[4], rb[2];
  const int nk = K >> 6;
  const int srow = tid >> 3, sch = tid & 7;
  const char* Ab = (const char*)A;
  const char* Bb = (const char*)B;
  const unsigned aoff = (unsigned)(srow * lda + sch * 8) * 2u;
  const unsigned boff = (unsigned)(srow * ldb + sch * 8) * 2u;
  const unsigned astep = (unsigned)lda * 128u, bstep = (unsigned)ldb * 128u;
#pragma unroll
  for (int i = 0; i < 4; ++i) ra[i] = *(const uint4*)(Ab + (aoff + i * astep));
#pragma unroll
  for (int i = 0; i < 2; ++i) rb[i] = *(const uint4*)(Bb + (boff + i * bstep));
#pragma unroll
  for (int i = 0; i < 4; ++i) *(uint4*)(smem + swz128(srow + i * 64, sch)) = ra[i];
#pragma unroll
  for (int i = 0; i < 2; ++i) *(uint4*)(smem + 65536 + swz128(srow + i * 64, sch)) = rb[i];
  __syncthreads();
  for (int kt = 0; kt < nk; ++kt) {
    const bool more = (kt + 1 < nk);
    if (more) {
      const unsigned ko = (unsigned)(kt + 1) * 128u;
#pragma unroll
      for (int i = 0; i < 4; ++i) ra[i] = *(const uint4*)(Ab + (aoff + i * astep + ko));
#pragma unroll
      for (int i = 0; i < 2; ++i) rb[i] = *(const uint4*)(Bb + (boff + i * bstep + ko));
    }
    const char* as = smem + (kt & 1) * 32768;
    const char* bs = smem + 65536 + (kt & 1) * 16384;
    int lrow = l31;
    asm volatile("" : "+v"(lrow));
#pragma unroll
    for (int s = 0; s < 4; ++s) {
      bf16x8 af[2], bfr[2];
#pragma unroll
      for (int i = 0; i < 2; ++i) af[i] = *(const bf16x8*)(as + swz128(wm * 64 + i * 32 + lrow, s * 2 + hh));
#pragma unroll
      for (int j = 0; j < 2; ++j) bfr[j] = *(const bf16x8*)(bs + swz128(wn * 64 + j * 32 + lrow, s * 2 + hh));
#pragma unroll
      for (int i = 0; i < 2; ++i)
#pragma unroll
        for (int j = 0; j < 2; ++j) acc[i][j] = mfma32(af[i], bfr[j], acc[i][j]);
    }
    if (more) {
      char* an = smem + ((kt + 1) & 1) * 32768;
      char* bn = smem + 65536 + ((kt + 1) & 1) * 16384;
      int sr2 = srow;
      asm volatile("" : "+v"(sr2));
#pragma unroll
      for (int i = 0; i < 4; ++i) *(uint4*)(an + swz128(sr2 + i * 64, sch)) = ra[i];
#pragma unroll
      for (int i = 0; i < 2; ++i) *(uint4*)(bn + swz128(sr2 + i * 64, sch)) = rb[i];
    }
    __syncthreads();
  }
}
__device__ __forceinline__ void zero_acc(f32x16 (&acc)[2][2]) {
#pragma unroll
  for (int i = 0; i < 2; ++i)
#pragma unroll
    for (int j = 0; j < 2; ++j) acc[i][j] = zero16();
}
#define EPI_ROW(i, e) (wm * 64 + (i)*32 + ((e)&3) + 8 * ((e) >> 2) + 4 * hh)
#define EPI_COL(j) (wn * 64 + (j)*32 + l31)
#define EPI_VARS                                                    \
  const int tid = opaque_tid(), lane = tid & 63, wid = tid >> 6;     \
  const int wm = wid >> 1, wn = wid & 1, l31 = lane & 31, hh = lane >> 5; \
  (void)tid; (void)wm; (void)wn; (void)l31; (void)hh;


namespace pg8 {
#define PG8_LAS __attribute__((address_space(3)))
typedef PG8_LAS unsigned char* PG8_LAS_T;
typedef float f32x4 __attribute__((ext_vector_type(4)));
typedef unsigned u32x4 __attribute__((ext_vector_type(4)));
constexpr int BM = 256, BK = 64, HALF = 128, HTB = HALF * BK * 2, STAGE_BYTES = 8 * HTB, NXCD = 8, WGM = 8;
__device__ __forceinline__ int lds_byte(int r, int c) { const int st = (r >> 4) * 2 + (c >> 5), rr = r & 15, cc = c & 31, ob = rr * 64 + cc * 2; return st * 1024 + (ob ^ (((ob >> 9) & 1) << 5)); }
__device__ __forceinline__ void stage_rc(int b, int& R, int& C) { const int st = b / 1024, sb = b % 1024, swz = sb ^ (((sb >> 9) & 1) << 5); R = (st >> 1) * 16 + swz / 64; C = (st & 1) * 32 + (swz % 64) / 2; }
__device__ __forceinline__ int perm32(int rho) { const int n = rho >> 4, i = rho & 15; return 8 * (i >> 2) + 4 * n + (i & 3); }
struct Unit { int pm, pn; };
struct Gemm { const u16* A; const u16* Bt; int lda, ldb, K; };
struct Order {
  int nM, nN, nwg, G, c, skip_from, skip_by;
  __device__ __forceinline__ void init(int nM_, int nN_, int G_, int c_, int sf = 1 << 30, int sb = 0) { nM = nM_; nN = nN_; nwg = nM * nN; G = G_; c = c_; skip_from = sf; skip_by = sb; }
  __device__ __forceinline__ bool next(int i, Unit& u) const {
    const long L = (long)i * G + c; if (L >= nwg) return false;
    int wgid = (int)L; { const int q = nwg / NXCD, r = nwg % NXCD, xcd = wgid % NXCD, off = wgid / NXCD; wgid = (xcd < r ? xcd * (q + 1) : r * (q + 1) + (xcd - r) * q) + off; }
    const int nig = WGM * nN, gid = wgid / nig, fm = gid * WGM, gsz = (nM - fm) < WGM ? (nM - fm) : WGM;
    u.pm = fm + ((wgid % nig) % gsz); u.pn = (wgid % nig) / gsz;
    if (u.pn >= skip_from) u.pn += skip_by;
    return true;
  }
};
template <class Epi>
__device__ __forceinline__ void gemm_phase(PG8_LAS unsigned char* lds, const Gemm g, const Order& S, const Epi& E) {
  const int tid = opaque_tid(), wid = __builtin_amdgcn_readfirstlane(tid >> 6), lane = tid & 63, wr = wid >> 2, wc = wid & 3, fr = lane & 15, fq = lane >> 4;
  const int K = g.K, nt = K / BK;
  unsigned voffA[2], voffB[2];
#pragma unroll
  for (int i = 0; i < 2; ++i) { int R, C; stage_rc(tid * 16 + i * 8192, R, C); const int Rb = Epi::PERM ? ((R & ~31) + perm32(R & 31)) : R;
    voffA[i] = (unsigned)(R * g.lda + C) * 2u; voffB[i] = (unsigned)(Rb * g.ldb + C) * 2u; }
  const size_t kstep = (size_t)(BK * 2);
  const size_t hstepA = (size_t)HALF * g.lda * 2, hstepB = (size_t)HALF * g.ldb * 2;
  const size_t tstepA = 2 * hstepA, tstepB = 2 * hstepB;
  const unsigned ldsw = (unsigned)wid * 1024u;
  const int aoff = lds_byte(wr * 64 + fr, fq * 8), boff = lds_byte(wc * 32 + fr, fq * 8);
#define PG8_SA(b, h) (((b) * 2 + (h)) * HTB)
#define PG8_SB(b, h) ((4 + (b) * 2 + (h)) * HTB)
#define PG8_STAGE(bufoff, gbase, voff) do { _Pragma("unroll") for (int _i = 0; _i < 2; ++_i) \
    __builtin_amdgcn_global_load_lds((const unsigned*)((const char*)(gbase) + (voff)[_i]), (PG8_LAS unsigned*)(lds + (bufoff) + ldsw + _i * 8192), 16, 0, 0); } while (0)
#define PG8_LDA(dst, b, h) do { _Pragma("unroll") for (int m = 0; m < 4; ++m) _Pragma("unroll") for (int k = 0; k < 2; ++k) dst[m][k] = *(const PG8_LAS bf16x8*)(lds + PG8_SA(b, h) + aoff + m * 2048 + k * 1024); } while (0)
#define PG8_LDB(dst, b, h) do { _Pragma("unroll") for (int n = 0; n < 2; ++n) _Pragma("unroll") for (int k = 0; k < 2; ++k) dst[n][k] = *(const PG8_LAS bf16x8*)(lds + PG8_SB(b, h) + boff + n * 2048 + k * 1024); } while (0)
#define PG8_MMA(ai, bj, At, Bt) do { __builtin_amdgcn_s_setprio(1); _Pragma("unroll") for (int m = 0; m < 4; ++m) _Pragma("unroll") for (int n = 0; n < 2; ++n) _Pragma("unroll") for (int k = 0; k < 2; ++k) \
    acc[ai][bj][m][n] = __builtin_amdgcn_mfma_f32_16x16x32_bf16(Bt[n][k], At[m][k], acc[ai][bj][m][n], 0, 0, 0); __builtin_amdgcn_s_setprio(0); } while (0)
#define PG8_WAIT_V(n) asm volatile("s_waitcnt vmcnt(" #n ")" ::: "memory")
#define PG8_WAIT_L(n) asm volatile("s_waitcnt lgkmcnt(" #n ")" ::: "memory")
#define PG8_BAR __builtin_amdgcn_s_barrier()
#define PG8_SCHED __builtin_amdgcn_sched_barrier(0)
  Unit cur, nxt; int ui = 0;
  if (!S.next(0, cur)) return;
  f32x4 acc[2][2][4][2];
#pragma unroll
  for (int a = 0; a < 2; ++a)
#pragma unroll
    for (int b = 0; b < 2; ++b)
#pragma unroll
      for (int m = 0; m < 4; ++m)
#pragma unroll
        for (int n = 0; n < 2; ++n) acc[a][b][m][n] = (f32x4){0.f, 0.f, 0.f, 0.f};
  bf16x8 At[4][2], B0[2][2], B1[2][2];
  const char* cA = (const char*)g.A + (size_t)cur.pm * tstepA; const char* cB = (const char*)g.Bt + (size_t)cur.pn * tstepB;
  PG8_STAGE(PG8_SB(0, 0), cB, voffB); PG8_STAGE(PG8_SA(0, 0), cA, voffA); PG8_STAGE(PG8_SB(0, 1), cB + hstepB, voffB); PG8_STAGE(PG8_SA(0, 1), cA + hstepA, voffA);
  if (wr == 1) PG8_BAR;
  PG8_WAIT_V(4); PG8_BAR;
  PG8_STAGE(PG8_SB(1, 0), cB + kstep, voffB); PG8_STAGE(PG8_SA(1, 0), cA + kstep, voffA); PG8_STAGE(PG8_SB(1, 1), cB + hstepB + kstep, voffB);
  PG8_WAIT_V(6); PG8_BAR;
  for (;;) {
    const bool has_next = S.next(ui + 1, nxt);
    const char* nA = has_next ? (const char*)g.A + (size_t)nxt.pm * tstepA : cA; const char* nB = has_next ? (const char*)g.Bt + (size_t)nxt.pn * tstepB : cB;
    for (int t = 0; t < nt; t += 2) {
      const bool last = (t == nt - 2);
      const char* a1 = cA + (size_t)(t + 1) * kstep;
      const char* a2 = last ? nA : cA + (size_t)(t + 2) * kstep; const char* b2 = last ? nB : cB + (size_t)(t + 2) * kstep;
      const char* a3 = a2 + kstep; const char* b3 = b2 + kstep;
      PG8_LDB(B0, 0, 0); PG8_SCHED; PG8_LDA(At, 0, 0); PG8_STAGE(PG8_SA(1, 1), a1 + hstepA, voffA);
      PG8_WAIT_L(8); PG8_BAR; PG8_WAIT_L(0); PG8_MMA(0, 0, At, B0); PG8_BAR; PG8_SCHED;
      PG8_LDB(B1, 0, 1); PG8_STAGE(PG8_SB(0, 0), b2, voffB);
      PG8_BAR; PG8_WAIT_L(0); PG8_MMA(0, 1, At, B1); PG8_BAR;
      PG8_LDA(At, 0, 1); PG8_STAGE(PG8_SA(0, 0), a2, voffA);
      PG8_BAR; PG8_WAIT_L(0); PG8_MMA(1, 0, At, B0); PG8_BAR; PG8_SCHED;
      PG8_STAGE(PG8_SB(0, 1), b2 + hstepB, voffB);
      PG8_WAIT_V(6); PG8_BAR; PG8_MMA(1, 1, At, B1); PG8_BAR;
      PG8_LDB(B0, 1, 0); PG8_SCHED; PG8_LDA(At, 1, 0); PG8_STAGE(PG8_SA(0, 1), a2 + hstepA, voffA);
      PG8_WAIT_L(8); PG8_BAR; PG8_WAIT_L(0); PG8_MMA(0, 0, At, B0); PG8_BAR; PG8_SCHED;
      PG8_LDB(B1, 1, 1); PG8_STAGE(PG8_SB(1, 0), b3, voffB);
      PG8_BAR; PG8_WAIT_L(0); PG8_MMA(0, 1, At, B1); PG8_BAR;
      PG8_LDA(At, 1, 1); PG8_STAGE(PG8_SA(1, 0), a3, voffA);
      PG8_BAR; PG8_WAIT_L(0); PG8_MMA(1, 0, At, B0); PG8_BAR; PG8_SCHED;
      PG8_STAGE(PG8_SB(1, 1), b3 + hstepB, voffB);
      PG8_WAIT_V(6); PG8_BAR; PG8_MMA(1, 1, At, B1); PG8_BAR;
    }
    E(acc, cur, wr, wc, fr, fq);
    if (!has_next) break;
#pragma unroll
    for (int a = 0; a < 2; ++a)
#pragma unroll
      for (int b = 0; b < 2; ++b)
#pragma unroll
        for (int m = 0; m < 4; ++m)
#pragma unroll
          for (int n = 0; n < 2; ++n) acc[a][b][m][n] = (f32x4){0.f, 0.f, 0.f, 0.f};
    cur = nxt; cA = nA; cB = nB; ++ui;
  }
  PG8_WAIT_V(0);
  if (wr == 0) PG8_BAR;
  PG8_BAR;
#undef PG8_SA
#undef PG8_SB
#undef PG8_STAGE
#undef PG8_LDA
#undef PG8_LDB
#undef PG8_MMA
#undef PG8_WAIT_V
#undef PG8_WAIT_L
#undef PG8_BAR
#undef PG8_SCHED
}
typedef const f32x4 (&AccRef)[2][2][4][2];
struct EpiInprojN {
  static constexpr bool PERM = true;
  u16* qk; u16* rg;
  __device__ __forceinline__ void operator()(AccRef acc, const Unit& u, int wr, int wc, int fr, int fq) const {
    const int row0 = u.pm * BM + wr * 64 + fr;
    u16* base; int ld, colt;
    if (u.pn < 4) { base = qk; ld = 1024; colt = u.pn * 256; } else { base = rg; ld = 512; colt = (u.pn - 9) * 256; }
    const int col0 = colt + wc * 32 + 8 * fq;
#pragma unroll
    for (int ai = 0; ai < 2; ++ai)
#pragma unroll
      for (int m = 0; m < 4; ++m) {
        u16* rowp = base + (size_t)(row0 + ai * HALF + m * 16) * ld + col0;
#pragma unroll
        for (int bj = 0; bj < 2; ++bj) {
          const f32x4 v0 = acc[ai][bj][m][0], v1 = acc[ai][bj][m][1];
          u32x4 w; w.x = pk2(v0[0], v0[1]); w.y = pk2(v0[2], v0[3]); w.z = pk2(v1[0], v1[1]); w.w = pk2(v1[2], v1[3]);
          *(u32x4*)(rowp + bj * HALF) = w;
        }
      }
  }
};
struct EpiInprojT {
  static constexpr bool PERM = true;
  u16 *vT, *vTc, *hyT, *hyTc;
  __device__ __forceinline__ void operator()(AccRef acc, const Unit& u, int wr, int wc, int fr, int fq) const {
    const bool isctx = (u.pn >= 128);
    const int b = isctx ? (u.pn - 128) : (u.pn >> 4);
    const int Lseg = isctx ? 256 : 4096, t0 = isctx ? 0 : (u.pn & 15) * 256;
    const bool isv = (u.pm < 2);
    const size_t boff = isv ? (isctx ? (size_t)16777216 : (size_t)0) : (isctx ? (size_t)(16777216 + 1048576 + 25165824) : (size_t)(16777216 + 1048576));
    u16* base = vT + boff;
    const int nc = isv ? 512 : 768;
    const int wrow0 = (isv ? u.pm : u.pm - 2) * BM + wr * 64 + fr;
    const int col0 = t0 + wc * 32 + 8 * fq;
#pragma unroll
    for (int ai = 0; ai < 2; ++ai)
#pragma unroll
      for (int m = 0; m < 4; ++m) {
        u16* rowp = base + ((size_t)(b * nc + wrow0 + ai * HALF + m * 16)) * Lseg + col0;
#pragma unroll
        for (int bj = 0; bj < 2; ++bj) {
          const f32x4 v0 = acc[ai][bj][m][0], v1 = acc[ai][bj][m][1];
          u32x4 w; w.x = pk2(v0[0], v0[1]); w.y = pk2(v0[2], v0[3]); w.z = pk2(v1[0], v1[1]); w.w = pk2(v1[2], v1[3]);
          *(u32x4*)(rowp + bj * HALF) = w;
        }
      }
  }
};
struct EpiGate {
  static constexpr bool PERM = true;
  unsigned char* g8; const float* bias;
  __device__ __forceinline__ void operator()(AccRef acc, const Unit& u, int wr, int wc, int fr, int fq) const {
    const int row0 = u.pm * BM + wr * 64 + fr;
    const int col0 = u.pn * BM + wc * 32 + 8 * fq;
#pragma unroll
    for (int bj = 0; bj < 2; ++bj) {
      const f32x4 b0 = *(const f32x4*)(bias + col0 + bj * HALF), b1 = *(const f32x4*)(bias + col0 + bj * HALF + 4);
#pragma unroll
      for (int ai = 0; ai < 2; ++ai)
#pragma unroll
        for (int m = 0; m < 4; ++m) {
          const f32x4 v0 = acc[ai][bj][m][0] + b0, v1 = acc[ai][bj][m][1] + b1;
          unsigned w0 = 0, w1 = 0;
#pragma unroll
          for (int k = 0; k < 4; ++k) {
            w0 |= (unsigned)(sigmoidf_(v0[k]) * 255.0f + 0.5f) << (8 * k);
            w1 |= (unsigned)(sigmoidf_(v1[k]) * 255.0f + 0.5f) << (8 * k);
          }
          *(uint2*)(g8 + (size_t)(row0 + ai * HALF + m * 16) * 3072 + col0 + bj * HALF) = make_uint2(w0, w1);
        }
    }
  }
};
struct EpiBranch {
  static constexpr bool PERM = true;
  u16* mbuf; const unsigned char* g8; int br;
  __device__ __forceinline__ void operator()(AccRef acc, const Unit& u, int wr, int wc, int fr, int fq) const {
    const int row0 = u.pm * BM + wr * 64 + fr;
    const int col0 = u.pn * BM + wc * 32 + 8 * fq;
#pragma unroll
    for (int ai = 0; ai < 2; ++ai)
#pragma unroll
      for (int m = 0; m < 4; ++m) {
        const size_t row = (size_t)(row0 + ai * HALF + m * 16);
#pragma unroll
        for (int bj = 0; bj < 2; ++bj) {
          const uint2 gq = *(const uint2*)(g8 + row * 3072 + br * 1024 + col0 + bj * HALF);
          u16* mp = mbuf + row * 1024 + col0 + bj * HALF;
          const f32x4 v0 = acc[ai][bj][m][0], v1 = acc[ai][bj][m][1];
          float r[8];
          r[0] = (float)(gq.x & 255u) * v0[0]; r[1] = (float)((gq.x >> 8) & 255u) * v0[1];
          r[2] = (float)((gq.x >> 16) & 255u) * v0[2]; r[3] = (float)(gq.x >> 24) * v0[3];
          r[4] = (float)(gq.y & 255u) * v1[0]; r[5] = (float)((gq.y >> 8) & 255u) * v1[1];
          r[6] = (float)((gq.y >> 16) & 255u) * v1[2]; r[7] = (float)(gq.y >> 24) * v1[3];
          u32x4 w;
          if (br == 0) {
            w.x = pk2(r[0] * (1.f / 255.f), r[1] * (1.f / 255.f)); w.y = pk2(r[2] * (1.f / 255.f), r[3] * (1.f / 255.f));
            w.z = pk2(r[4] * (1.f / 255.f), r[5] * (1.f / 255.f)); w.w = pk2(r[6] * (1.f / 255.f), r[7] * (1.f / 255.f));
          } else {
            const u32x4 o = *(const u32x4*)mp;
            w.x = pk2(bflo(o.x) + r[0] * (1.f / 255.f), bfhi(o.x) + r[1] * (1.f / 255.f));
            w.y = pk2(bflo(o.y) + r[2] * (1.f / 255.f), bfhi(o.y) + r[3] * (1.f / 255.f));
            w.z = pk2(bflo(o.z) + r[4] * (1.f / 255.f), bfhi(o.z) + r[5] * (1.f / 255.f));
            w.w = pk2(bflo(o.w) + r[6] * (1.f / 255.f), bfhi(o.w) + r[7] * (1.f / 255.f));
          }
          *(u32x4*)mp = w;
        }
      }
  }
};
struct EpiOut {
  static constexpr bool PERM = false;
  const float *xsrc, *csrc; float *xdst, *cdst; const float* modl;
  __device__ __forceinline__ void operator()(AccRef acc, const Unit& u, int wr, int wc, int fr, int fq) const {
    const bool isctx = (u.pm >= 128);
    const int bi = isctx ? 8 : (u.pm >> 4);
    const float* gatev = modl + ((size_t)bi * 6 + 2) * 1024;
    const float* src = isctx ? (csrc - (size_t)NLAT * 1024) : xsrc;
    float* dst = isctx ? (cdst - (size_t)NLAT * 1024) : xdst;
    const int row0 = u.pm * BM + wr * 64 + fr, col0 = u.pn * BM + wc * 32 + 4 * fq;
#pragma unroll
    for (int bj = 0; bj < 2; ++bj)
#pragma unroll
      for (int n = 0; n < 2; ++n) {
        const int col = col0 + bj * HALF + n * 16;
        const f32x4 gv = *(const f32x4*)(gatev + col);
#pragma unroll
        for (int ai = 0; ai < 2; ++ai)
#pragma unroll
          for (int m = 0; m < 4; ++m) {
            const size_t o = (size_t)(row0 + ai * HALF + m * 16) * 1024 + col;
            const f32x4 xv = *(const f32x4*)(src + o);
            *(f32x4*)(dst + o) = xv + gv * acc[ai][bj][m][n];
          }
      }
  }
};
struct EpiQ {
  static constexpr bool PERM = true;
  u16* q;
  __device__ __forceinline__ void operator()(AccRef acc, const Unit& u, int wr, int wc, int fr, int fq) const {
    const int row0 = u.pm * BM + wr * 64 + fr;
    const int col0 = u.pn * BM + wc * 32 + 8 * fq;
#pragma unroll
    for (int ai = 0; ai < 2; ++ai)
#pragma unroll
      for (int m = 0; m < 4; ++m) {
        u16* rowp = q + (size_t)(row0 + ai * HALF + m * 16) * 2048 + col0;
#pragma unroll
        for (int bj = 0; bj < 2; ++bj) {
          const f32x4 v0 = acc[ai][bj][m][0], v1 = acc[ai][bj][m][1];
          u32x4 w; w.x = pk2(v0[0], v0[1]); w.y = pk2(v0[2], v0[3]); w.z = pk2(v1[0], v1[1]); w.w = pk2(v1[2], v1[3]);
          *(u32x4*)(rowp + bj * HALF) = w;
        }
      }
  }
};
}

__device__ __forceinline__ void tr_tile(const float* __restrict__ src, int N, int K, u16* __restrict__ dst, int tile, char* smem) {
  float* lds = (float*)smem;
  const int tiles_n = N >> 6;
  const int tk = tile / tiles_n, tn = tile - tk * tiles_n;
  const int tid = opaque_tid();
  {
    const int r = tid >> 3, c8 = (tid & 7) * 8;
    const float* s = src + (size_t)(tk * 64 + r) * N + tn * 64 + c8;
    float4 a = *(const float4*)s, b = *(const float4*)(s + 4);
    float* d = lds + r * 65 + c8;
    d[0] = a.x; d[1] = a.y; d[2] = a.z; d[3] = a.w; d[4] = b.x; d[5] = b.y; d[6] = b.z; d[7] = b.w;
  }
  __syncthreads();
  {
    const int n = tid >> 3, k0 = (tid & 7) * 8;
    uint4 o;
    o.x = pk2(lds[(k0 + 0) * 65 + n], lds[(k0 + 1) * 65 + n]);
    o.y = pk2(lds[(k0 + 2) * 65 + n], lds[(k0 + 3) * 65 + n]);
    o.z = pk2(lds[(k0 + 4) * 65 + n], lds[(k0 + 5) * 65 + n]);
    o.w = pk2(lds[(k0 + 6) * 65 + n], lds[(k0 + 7) * 65 + n]);
    *(uint4*)(dst + (size_t)(tn * 64 + n) * K + tk * 64 + k0) = o;
  }
  __syncthreads();
}
__device__ __forceinline__ void cvt_chunk(const float* __restrict__ src, u16* __restrict__ dst, size_t chunk) {
  const size_t i = chunk * 4096 + (size_t)opaque_tid() * 8;
  float4 a = *(const float4*)(src + i), b = *(const float4*)(src + i + 4);
  uint4 o;
  o.x = pk2(a.x, a.y); o.y = pk2(a.z, a.w); o.z = pk2(b.x, b.y); o.w = pk2(b.z, b.w);
  *(uint4*)(dst + i) = o;
}
__device__ __forceinline__ void cvt_chunk_fp8(const float* __restrict__ src, unsigned char* __restrict__ dst, size_t chunk, float scale) {
  const size_t i = chunk * 4096 + (size_t)opaque_tid() * 8;
  const float4 a = *(const float4*)(src + i), b = *(const float4*)(src + i + 4);
  int w0 = __builtin_amdgcn_cvt_pk_fp8_f32(a.x * scale, a.y * scale, 0, false);
  w0 = __builtin_amdgcn_cvt_pk_fp8_f32(a.z * scale, a.w * scale, w0, true);
  int w1 = __builtin_amdgcn_cvt_pk_fp8_f32(b.x * scale, b.y * scale, 0, false);
  w1 = __builtin_amdgcn_cvt_pk_fp8_f32(b.z * scale, b.w * scale, w1, true);
  *(uint2*)(dst + i) = make_uint2((unsigned)w0, (unsigned)w1);
}
__device__ __forceinline__ void cvt_chunk_fp4(const float* __restrict__ src, unsigned char* __restrict__ dst, size_t chunk, float scale) {
  const size_t i = chunk * 4096 + (size_t)opaque_tid() * 8;
  const float4 a = *(const float4*)(src + i), b = *(const float4*)(src + i + 4);
  unsigned w = 0;
  w = __builtin_amdgcn_cvt_scalef32_pk_fp4_f32(w, a.x * scale, a.y * scale, 1.0f, 0);
  w = __builtin_amdgcn_cvt_scalef32_pk_fp4_f32(w, a.z * scale, a.w * scale, 1.0f, 1);
  w = __builtin_amdgcn_cvt_scalef32_pk_fp4_f32(w, b.x * scale, b.y * scale, 1.0f, 2);
  w = __builtin_amdgcn_cvt_scalef32_pk_fp4_f32(w, b.z * scale, b.w * scale, 1.0f, 3);
  *(unsigned*)(dst + (i >> 1)) = w;
}
__device__ __forceinline__ void phase_prep(const P& p, char* smem) {
  const int tid = opaque_tid();
  const int NTR = 2512;
  const int total = 2 * NTR + 128 + 384;
  for (int task = blockIdx.x; task < total; task += gridDim.x) {
    if (task < 2 * NTR) {
      const int l = task / NTR;
      int t = task - l * NTR;
      if (t < 704) tr_tile(p.w_in + (size_t)l * 1024 * 2816, 2816, 1024, p.WinT + (size_t)l * 2816 * 1024, t, smem);
      else if ((t -= 704) < 768) tr_tile(p.w_gate + (size_t)l * 1024 * 3072, 3072, 1024, p.WgT + (size_t)l * 3072 * 1024, t, smem);
      else if ((t -= 768) < 128) tr_tile(p.w_br_a + (size_t)l * 512 * 1024, 1024, 512, p.WaT + (size_t)l * 1024 * 512, t, smem);
      else if ((t -= 128) < 64) tr_tile(p.w_br_b + (size_t)l * 256 * 1024, 1024, 256, p.WbT + (size_t)l * 1024 * 256, t, smem);
      else if ((t -= 64) < 64) tr_tile(p.w_br_c + (size_t)l * 256 * 1024, 1024, 256, p.WcT + (size_t)l * 1024 * 256, t, smem);
      else if ((t -= 64) < 256) tr_tile(p.w_out + (size_t)l * 1024 * 1024, 1024, 1024, p.WoT + (size_t)l * 1024 * 1024, t, smem);
      else if ((t -= 256) < 512) tr_tile(p.peer_wq + (size_t)l * 1024 * 2048, 2048, 1024, p.WqT + (size_t)l * 2048 * 1024, t, smem);
      else {
        t -= 512;
        const int gate = t >> 3, dn = t & 7;
        const float* src = (gate ? p.rg_wx : p.rg_wa) + (size_t)(l * 8 + dn) * 4096;
        tr_tile(src, 64, 64, p.rgW + (size_t)((l * 2 + gate) * 8 + dn) * 4096, 0, smem);
      }
    } else if (task < 2 * NTR + 128) {
      cvt_chunk(p.peer_keys, p.keysB, (size_t)(task - 2 * NTR));
    } else {
      int t = task - 2 * NTR - 128;
      const int kc = t & 15; t >>= 4;
      const int jc = t % 12, l = t / 12;
      float* s = (float*)smem;
      for (int i = tid; i < 576; i += NTHR) {
        const int bi = i >> 6, kk = i & 63;
        const float v = (bi < 8) ? p.c[bi * 1024 + kc * 64 + kk] : p.c_ctx[kc * 64 + kk];
        s[i] = v / (1.0f + __expf(-v));
      }
      __syncthreads();
      const int j = jc * 512 + tid;
      float acc[9];
#pragma unroll
      for (int bi = 0; bi < 9; ++bi) acc[bi] = 0.f;
      const float* wp = p.w_ada + ((size_t)l * 1024 + kc * 64) * 6144 + j;
#pragma unroll 8
      for (int kk = 0; kk < 64; ++kk) {
        const float w = wp[(size_t)kk * 6144];
#pragma unroll
        for (int bi = 0; bi < 9; ++bi) acc[bi] += s[bi * 64 + kk] * w;
      }
#pragma unroll
      for (int bi = 0; bi < 9; ++bi) p.modpart[((size_t)(kc * 2 + l) * 9 + bi) * 6144 + j] = acc[bi];
      __syncthreads();
    }
  }
}
__device__ __forceinline__ void phase_modreduce(const P& p) {
  const int n = 2 * 9 * 6144;
  for (int i = blockIdx.x * NTHR + opaque_tid(); i < n; i += gridDim.x * NTHR) {
    const int l = i / (9 * 6144);
    const int j = i % 6144;
    float s = p.b_ada[l * 6144 + j];
#pragma unroll
    for (int kc = 0; kc < 16; ++kc) s += p.modpart[(size_t)kc * n + i];
    p.mod[i] = s;
  }
}

__device__ __forceinline__ void phase_norm(const P& p, int l, int which) {
  const int tid_ = opaque_tid(); const int lane = tid_ & 63, wid = tid_ >> 6;
  const int ntok = (which == 2 || (which == 1 && l == 1)) ? NLAT : NTOK;
  for (int row = blockIdx.x * 8 + wid; row < ntok; row += gridDim.x * 8) {
    const float* src;
    if (row < NLAT) src = ((which == 0 && l == 0) ? p.x : p.out) + (size_t)row * 1024;
    else src = ((which == 0 && l == 0) ? p.ctx : p.ctxs) + (size_t)(row - NLAT) * 1024;
    float4 v[4];
    float ss = 0.f;
#pragma unroll
    for (int i = 0; i < 4; ++i) {
      v[i] = *(const float4*)(src + i * 256 + lane * 4);
      ss += v[i].x * v[i].x + v[i].y * v[i].y + v[i].z * v[i].z + v[i].w * v[i].w;
    }
    ss = wave_sum(ss);
    const float rstd = rsqrtf(ss * (1.0f / 1024.0f) + 1e-6f);
    if (which == 2) {
#pragma unroll
      for (int i = 0; i < 4; ++i) {
        const int col = i * 256 + lane * 4;
        const float4 g = *(const float4*)(p.final_g + col);
        float4 o = {v[i].x * rstd * g.x, v[i].y * rstd * g.y, v[i].z * rstd * g.z, v[i].w * rstd * g.w};
        *(float4*)(p.out + (size_t)row * 1024 + col) = o;
      }
    } else {
      const int bi = row < NLAT ? (row >> 12) : 8;
      const float* gam = (which == 0 ? p.norm_mix_g : p.norm_ffn_g) + l * 1024;
      const float* msh = p.mod + ((size_t)(l * 9 + bi) * 6 + (which == 0 ? 0 : 3)) * 1024;
      const float* msc = msh + 1024;
#pragma unroll
      for (int i = 0; i < 4; ++i) {
        const int col = i * 256 + lane * 4;
        const float4 g = *(const float4*)(gam + col);
        const float4 sh = *(const float4*)(msh + col);
        const float4 sc = *(const float4*)(msc + col);
        uint2 o;
        o.x = pk2(v[i].x * rstd * g.x * (1.f + sc.x) + sh.x, v[i].y * rstd * g.y * (1.f + sc.y) + sh.y);
        o.y = pk2(v[i].z * rstd * g.z * (1.f + sc.z) + sh.z, v[i].w * rstd * g.w * (1.f + sc.w) + sh.w);
        *(uint2*)(p.xn + (size_t)row * 1024 + col) = o;
      }
    }
  }
}

__device__ __forceinline__ void filter_wave(const P& p, int l, int L, int t, float* __restrict__ outp) {
  const int lane = opaque_tid() & 63;
  const float tl = (float)t / (float)(L - 1);
  const float wang = (6.283185307179586f / (float)L) * (float)t;
  float z = 0.f;
  if (lane == 0) z = tl;
  else if (lane <= 16) { const float band = 1e-4f + (float)(lane - 1) * ((15.0f - 1e-4f) / 15.0f); z = cosf(band * wang); }
  else if (lane <= 32) { const float band = 1e-4f + (float)(lane - 17) * ((15.0f - 1e-4f) / 15.0f); z = -sinf(band * wang); }
  float a1 = p.hy_f1_b[l * 64 + lane];
  for (int i = 0; i < 33; ++i) a1 += shf(z, i) * p.hy_f1_w[(l * 33 + i) * 64 + lane];
  const float h1 = sinf(p.hy_freq[l * 128 + lane] * a1);
  float a2 = p.hy_f2_b[l * 64 + lane];
  for (int i = 0; i < 64; ++i) a2 += shf(h1, i) * p.hy_f2_w[(l * 64 + i) * 64 + lane];
  const float h2 = sinf(p.hy_freq[l * 128 + 64 + lane] * a2);
  float a3[8];
#pragma unroll
  for (int m = 0; m < 8; ++m) a3[m] = 0.f;
  for (int i = 0; i < 64; ++i) {
    const float hv = shf(h2, i);
    const float* wr = p.hy_f3_w + (size_t)(l * 64 + i) * 512 + lane;
#pragma unroll
    for (int m = 0; m < 8; ++m) a3[m] += hv * wr[m * 64];
  }
  const float LN100 = 4.605170185988092f;
  const float d0 = LN100 / 1.5f, d1 = LN100 / 0.3f;
#pragma unroll
  for (int m = 0; m < 8; ++m) {
    const int cp = lane + 64 * m;
    const int ch = cp & 255;
    const float delta = d0 + (float)ch * ((d1 - d0) / 255.0f);
    outp[(size_t)cp * L + t] = a3[m] * expf(-tl * delta);
  }
}
__device__ __forceinline__ void phase_filters(const P& p, int l) {
  const int wid = opaque_tid() >> 6;
  const int ntask = 4096 + (l == 0 ? 256 : 0);
  for (int t = blockIdx.x * 8 + wid; t < ntask; t += gridDim.x * 8) {
    if (t < 4096) filter_wave(p, l, 4096, t, p.hT + (size_t)l * 512 * 4096);
    else filter_wave(p, l, 256, t - 4096, p.hc);
  }
}
__device__ __forceinline__ void kf_task(const P& p, int l, int c, char* smem) {
  const float* hTl = p.hT + (size_t)l * 512 * 4096;
  c2* buf = (c2*)smem;
  const int tid = opaque_tid();
  for (int i = 0; i < 16; ++i) {
    const int j = tid + NTHR * i;
    float v;
    if (j < 4096) v = hTl[(size_t)c * 4096 + j];
    else if (j == 4096) v = 0.f;
    else v = hTl[(size_t)(256 + c) * 4096 + (8192 - j)];
    buf[j] = {v, 0.f};
  }
  __syncthreads();
  fft8192(buf, -1.f);
  c2* o = (c2*)p.Kf + ((size_t)l * 256 + c) * 8192;
  for (int i = 0; i < 16; ++i) { const int j = tid + NTHR * i; o[j] = buf[j]; }
  __syncthreads();
}

__device__ __forceinline__ void inproj_tile(const P& p, int l, int mt, int nt, char* smem) {
  f32x16 acc[2][2];
  zero_acc(acc);
  const int m0 = mt * 256, n0 = nt * 128;
  gemm_kloop(acc, p.xn + (size_t)m0 * 1024, 1024, p.WinT + ((size_t)l * 2816 + n0) * 1024, 1024, 1024, smem);
  EPI_VARS
  if (nt < 8 || nt >= 18) {
    u16* dst; int ld, cbase;
    if (nt < 8) { dst = p.qk; ld = 1024; cbase = n0; }
    else { dst = p.rg; ld = 512; cbase = n0 - 2304; }
#pragma unroll
    for (int i = 0; i < 2; ++i)
#pragma unroll
      for (int j = 0; j < 2; ++j)
#pragma unroll
        for (int e = 0; e < 16; ++e)
          dst[(size_t)(m0 + EPI_ROW(i, e)) * ld + cbase + EPI_COL(j)] = f2bf(acc[i][j][e]);
  } else {
#pragma unroll
    for (int i = 0; i < 2; ++i)
#pragma unroll
      for (int j = 0; j < 2; ++j)
#pragma unroll
        for (int qd = 0; qd < 4; ++qd) {
          uint2 o;
          o.x = pk2(acc[i][j][4 * qd + 0], acc[i][j][4 * qd + 1]);
          o.y = pk2(acc[i][j][4 * qd + 2], acc[i][j][4 * qd + 3]);
          const int row0 = wm * 64 + i * 32 + 8 * qd + 4 * hh;
          *(uint2*)(smem + EPI_COL(j) * 520 + row0 * 2) = o;
        }
    __syncthreads();
    u16* dstT; int Lseg, t0, ncol0, nc;
    const bool isctx = (mt >= 128);
    const int b = isctx ? (mt - 128) : (mt >> 4);
    if (nt < 12) { ncol0 = n0 - 1024; nc = 512; dstT = isctx ? p.vTc : p.vT; }
    else { ncol0 = n0 - 1536; nc = 768; dstT = isctx ? p.hyTc : p.hyT; }
    if (isctx) { Lseg = 256; t0 = 0; } else { Lseg = 4096; t0 = (mt & 15) * 256; }
#pragma unroll 4
    for (int it = 0; it < 16; ++it) {
      const int idx = tid + NTHR * it;
      const int col = idx >> 6, u = idx & 63;
      const uint2 v = *(const uint2*)(smem + col * 520 + u * 8);
      *(uint2*)(dstT + ((size_t)(b * nc + ncol0 + col)) * Lseg + t0 + u * 4) = v;
    }
    __syncthreads();
  }
}

__device__ __forceinline__ float ldbf(const u16* p, int t, int L) { return (t >= 0 && t < L) ? bf2f(p[t]) : 0.f; }
__device__ __forceinline__ void hyena_fft_task(const P& p, int l, int c, int bp, char* smem) {
  c2* buf = (c2*)smem;
  c2* ub = (c2*)(smem + 65536);
  const int tid = opaque_tid();
  const float* sw = p.hy_short_w + l * 3 * 768;
  const float* sb = p.hy_short_b + l * 768;
  const float wx0[3] = {sw[c], sw[768 + c], sw[1536 + c]};
  const float wx1[3] = {sw[256 + c], sw[768 + 256 + c], sw[1536 + 256 + c]};
  const float wv[3] = {sw[512 + c], sw[768 + 512 + c], sw[1536 + 512 + c]};
  const float bx0 = sb[c], bx1 = sb[256 + c], bv = sb[512 + c];
  const float dsk = p.hy_bias[l * 256 + c];
  for (int i = 0; i < 8; ++i) {
    const int t = tid + NTHR * i;
    float u[2];
#pragma unroll
    for (int bb = 0; bb < 2; ++bb) {
      const int b = 2 * bp + bb;
      const u16* x1 = p.hyT + ((size_t)(b * 768 + 256 + c)) * 4096;
      const u16* vv = p.hyT + ((size_t)(b * 768 + 512 + c)) * 4096;
      const float x1c = bx1 + wx1[0] * ldbf(x1, t - 1, 4096) + wx1[1] * ldbf(x1, t, 4096) + wx1[2] * ldbf(x1, t + 1, 4096);
      const float vc = bv + wv[0] * ldbf(vv, t - 1, 4096) + wv[1] * ldbf(vv, t, 4096) + wv[2] * ldbf(vv, t + 1, 4096);
      u[bb] = vc * x1c;
    }
    buf[t] = {u[0], u[1]};
    ub[t] = {u[0], u[1]};
    buf[t + 4096] = {0.f, 0.f};
  }
  __syncthreads();
  fft8192(buf, -1.f);
  const c2* kf = (const c2*)p.Kf + ((size_t)l * 256 + c) * 8192;
  for (int i = 0; i < 16; ++i) {
    const int k = tid + NTHR * i;
    buf[k] = cmul(buf[k], kf[k]);
  }
  __syncthreads();
  fft8192(buf, 1.f);
  for (int i = 0; i < 8; ++i) {
    const int t = tid + NTHR * i;
    const c2 y = buf[t];
    const c2 uu = ub[t];
#pragma unroll
    for (int bb = 0; bb < 2; ++bb) {
      const int b = 2 * bp + bb;
      const u16* x0 = p.hyT + ((size_t)(b * 768 + c)) * 4096;
      const float x0c = bx0 + wx0[0] * ldbf(x0, t - 1, 4096) + wx0[1] * ldbf(x0, t, 4096) + wx0[2] * ldbf(x0, t + 1, 4096);
      const float yy = ldexpf(bb ? y.y : y.x, -13);
      const float uv = bb ? uu.y : uu.x;
      p.ycat[(size_t)(b * 4096 + t) * 1024 + 512 + c] = f2bf(x0c * (yy + uv * dsk));
    }
  }
  __syncthreads();
}
__device__ __forceinline__ void hyena_ctx_task(const P& p, int l, int b, int cg8, char* smem) {
  const int tid_ = opaque_tid(); const int lane = tid_ & 63, wid = tid_ >> 6;
  const int c = cg8 * 8 + wid;
  float* us = (float*)smem + wid * 1024;
  float* kfp = us + 256 + 255;
  const float* sw = p.hy_short_w + l * 3 * 768;
  const float* sb = p.hy_short_b + l * 768;
  const u16* x0 = p.hyTc + ((size_t)(b * 768 + c)) * 256;
  const u16* x1 = p.hyTc + ((size_t)(b * 768 + 256 + c)) * 256;
  const u16* vv = p.hyTc + ((size_t)(b * 768 + 512 + c)) * 256;
  for (int i = 0; i < 4; ++i) {
    const int t = lane + 64 * i;
    const float x1c = sb[256 + c] + sw[256 + c] * ldbf(x1, t - 1, 256) + sw[768 + 256 + c] * ldbf(x1, t, 256) + sw[1536 + 256 + c] * ldbf(x1, t + 1, 256);
    const float vc = sb[512 + c] + sw[512 + c] * ldbf(vv, t - 1, 256) + sw[768 + 512 + c] * ldbf(vv, t, 256) + sw[1536 + 512 + c] * ldbf(vv, t + 1, 256);
    us[t] = vc * x1c;
    kfp[t] = p.hc[(size_t)c * 256 + t];
    if (t > 0) kfp[-t] = p.hc[(size_t)(256 + c) * 256 + t];
  }
  __syncthreads();
  const float dsk = p.hy_bias[l * 256 + c];
  float acc[4] = {0.f, 0.f, 0.f, 0.f};
  for (int s = 0; s < 256; ++s) {
    const float uv = us[s];
#pragma unroll
    for (int i = 0; i < 4; ++i) acc[i] += kfp[lane + 64 * i - s] * uv;
  }
#pragma unroll
  for (int i = 0; i < 4; ++i) {
    const int t = lane + 64 * i;
    const float x0c = sb[c] + sw[c] * ldbf(x0, t - 1, 256) + sw[768 + c] * ldbf(x0, t, 256) + sw[1536 + c] * ldbf(x0, t + 1, 256);
    p.ycat[(size_t)(NLAT + b * 256 + t) * 1024 + 512 + c] = f2bf(x0c * (acc[i] + us[t] * dsk));
  }
  __syncthreads();
}

__device__ __forceinline__ void rg_chunk_task(const P& p, int l, int cq, int nblk, int mode, bool last, char* smem) {
  const int tid = opaque_tid(), lane = tid & 63, wid = tid >> 6;
  const int l31 = lane & 31, hh = lane >> 5;
  const int b = cq / 68, rr = cq - b * 68;
  const int seg = rr < 4 ? 0 : 1, sub = rr < 4 ? rr : rr - 4;
  if (mode == 1 && seg == 0 && last) return;
  float* xcf = (float*)smem;
  char* xcb = smem + 16384;
  float* coef = (float*)(smem + 24576);
  float2* segagg = (float2*)(smem + 90112);
  float* hin = (float*)(smem + 94208);
  float* Hout = (float*)(smem + 94720);
  const int Lseg = seg ? 4096 : 256;
  const int tokbase = seg ? b * 4096 : NLAT + b * 256;
  const int T0 = sub * 64;
  const int tt = tid >> 3, c0 = (tid & 7) * 8;
  const int chb = nblk * 64 + c0;
  const int wdir = wid >> 2, wgate = (wid >> 1) & 1, wmt = wid & 1;
  bf16x8 wf[2][4];
  {
    const u16* wp = p.rgW + (size_t)(((l * 2 + wgate) * 2 + wdir) * 4 + nblk) * 4096 + l31 * 64 + 8 * hh;
#pragma unroll
    for (int nt = 0; nt < 2; ++nt)
#pragma unroll
      for (int s = 0; s < 4; ++s) wf[nt][s] = *(const bf16x8*)(wp + nt * 2048 + 16 * s);
  }
  {
    float xc[8];
#pragma unroll
    for (int c = 0; c < 8; ++c) xc[c] = p.rg_conv_b[l * 256 + chb + c];
#pragma unroll
    for (int k = 0; k < 4; ++k) {
      const int pos = T0 + tt + k - 2;
      if (pos >= 0 && pos < Lseg) {
        const uint4 raw = *(const uint4*)(p.rg + (size_t)(tokbase + pos) * 512 + chb);
        const float4 w0 = *(const float4*)(p.rg_conv_w + (l * 4 + k) * 256 + chb);
        const float4 w1 = *(const float4*)(p.rg_conv_w + (l * 4 + k) * 256 + chb + 4);
        xc[0] += w0.x * bflo(raw.x); xc[1] += w0.y * bfhi(raw.x);
        xc[2] += w0.z * bflo(raw.y); xc[3] += w0.w * bfhi(raw.y);
        xc[4] += w1.x * bflo(raw.z); xc[5] += w1.y * bfhi(raw.z);
        xc[6] += w1.z * bflo(raw.w); xc[7] += w1.w * bfhi(raw.w);
      }
    }
    *(float4*)(xcf + tt * 64 + c0) = make_float4(xc[0], xc[1], xc[2], xc[3]);
    *(float4*)(xcf + tt * 64 + c0 + 4) = make_float4(xc[4], xc[5], xc[6], xc[7]);
    uint4 o;
    o.x = pk2(xc[0], xc[1]); o.y = pk2(xc[2], xc[3]); o.z = pk2(xc[4], xc[5]); o.w = pk2(xc[6], xc[7]);
    *(uint4*)(xcb + swz128(tt, tid & 7)) = o;
  }
  __syncthreads();
  {
    f32x16 acc0 = zero16(), acc1 = zero16();
#pragma unroll
    for (int s = 0; s < 4; ++s) {
      const bf16x8 af = *(const bf16x8*)(xcb + swz128(wmt * 32 + l31, 2 * s + hh));
      acc0 = mfma32(af, wf[0][s], acc0);
      acc1 = mfma32(af, wf[1][s], acc1);
    }
    float* cp = coef + (wdir * 2 + wgate) * 4096;
#pragma unroll
    for (int e = 0; e < 16; ++e) {
      const int tok = wmt * 32 + (e & 3) + 8 * (e >> 2) + 4 * hh;
      cp[tok * 64 + l31] = acc0[e];
      cp[tok * 64 + 32 + l31] = acc1[e];
    }
  }
  __syncthreads();
#pragma unroll
  for (int dir = 0; dir < 2; ++dir) {
    float* ca = coef + (dir * 2) * 4096;
    float* cb2 = ca + 4096;
#pragma unroll
    for (int c = 0; c < 8; ++c) {
      const int ch = (l * 2 + dir) * 256 + chb + c;
      const float sp = __logf(1.0f + __expf(-p.rg_lambda[ch]));
      const int o = tt * 64 + c0 + c;
      const float r = sigmoidf_(ca[o] + p.rg_ba[ch]);
      const float ii = sigmoidf_(cb2[o] + p.rg_bx[ch]);
      const float la = -8.0f * r * sp;
      const float av = __expf(la);
      const float e2 = 2.0f * la;
      const float om = (e2 > -0.1f) ? (-e2 * (1.0f + e2 * (0.5f + e2 * (0.16666667f + e2 * 0.041666668f)))) : (1.0f - __expf(e2));
      ca[o] = av;
      cb2[o] = sqrtf(om) * ii * xcf[o];
    }
  }
  __syncthreads();
  const int sg = tid >> 7, sdir = (tid >> 6) & 1, sch = tid & 63;
  const float* sa = coef + (sdir * 2) * 4096 + sch;
  const float* sb = sa + 4096;
  {
    float Pm = 1.f, H = 0.f;
#pragma unroll
    for (int n = 0; n < 16; ++n) {
      const int tok = sdir ? (63 - (16 * sg + n)) : (16 * sg + n);
      const float av = sa[tok * 64], bv = sb[tok * 64];
      H = av * H + bv;
      Pm *= av;
    }
    segagg[(sg * 2 + sdir) * 64 + sch] = make_float2(Pm, H);
  }
  __syncthreads();
  const int pos = sdir ? (seg == 0 ? 3 - sub : 67 - sub) : (seg == 0 ? sub : 4 + sub);
  float2* aggp = (float2*)p.agg + ((size_t)(b * 2 + sdir) * 68) * 256 + nblk * 64 + sch;
  if (mode == 0) {
    if (tid < 128) {
      float A = 1.f, B = 0.f;
#pragma unroll
      for (int s2 = 0; s2 < 4; ++s2) {
        const float2 g = segagg[(s2 * 2 + sdir) * 64 + sch];
        B = g.x * B + g.y;
        A *= g.x;
      }
      aggp[(size_t)pos * 256] = make_float2(A, B);
    }
    __syncthreads();
    return;
  }
  if (tid < 128) {
    float h = 0.f;
    int j = 0;
    for (; j + 8 <= pos; j += 8) {
      float2 g[8];
#pragma unroll
      for (int u = 0; u < 8; ++u) g[u] = aggp[(size_t)(j + u) * 256];
#pragma unroll
      for (int u = 0; u < 8; ++u) h = g[u].x * h + g[u].y;
    }
    for (; j < pos; ++j) {
      const float2 g = aggp[(size_t)j * 256];
      h = g.x * h + g.y;
    }
    hin[sdir * 64 + sch] = h;
  }
  __syncthreads();
  {
    float h = hin[sdir * 64 + sch];
    for (int s2 = 0; s2 < sg; ++s2) {
      const float2 g = segagg[(s2 * 2 + sdir) * 64 + sch];
      h = g.x * h + g.y;
    }
#pragma unroll
    for (int n = 0; n < 16; ++n) {
      const int tok = sdir ? (63 - (16 * sg + n)) : (16 * sg + n);
      h = sa[tok * 64] * h + sb[tok * 64];
      Hout[sdir * 4096 + tok * 64 + sch] = h;
    }
  }
  __syncthreads();
  {
    const size_t gtok = (size_t)tokbase + T0 + tt;
    const float4 f0 = *(const float4*)(Hout + tt * 64 + c0), f1 = *(const float4*)(Hout + tt * 64 + c0 + 4);
    const float4 h0 = *(const float4*)(Hout + 4096 + tt * 64 + c0), h1 = *(const float4*)(Hout + 4096 + tt * 64 + c0 + 4);
    const uint4 g = *(const uint4*)(p.rg + gtok * 512 + 256 + chb);
    uint4 o;
    o.x = pk2((f0.x + h0.x) * gelu_tanh(bflo(g.x)), (f0.y + h0.y) * gelu_tanh(bfhi(g.x)));
    o.y = pk2((f0.z + h0.z) * gelu_tanh(bflo(g.y)), (f0.w + h0.w) * gelu_tanh(bfhi(g.y)));
    o.z = pk2((f1.x + h1.x) * gelu_tanh(bflo(g.z)), (f1.y + h1.y) * gelu_tanh(bfhi(g.z)));
    o.w = pk2((f1.z + h1.z) * gelu_tanh(bflo(g.w)), (f1.w + h1.w) * gelu_tanh(bfhi(g.w)));
    *(uint4*)(p.ycat + gtok * 1024 + 768 + chb) = o;
  }
  __syncthreads();
}

__device__ __forceinline__ void attn_wave(const P& p, int l, int b, int h, bool local, int r, int half, int qtok0, const float* rpbL) {
  const int lane = opaque_tid() & 63, q = lane & 31, hh = lane >> 5;
  bf16x8 qf[4];
  {
    const u16* qp = p.qk + (size_t)(qtok0 + q) * 1024 + h * 64 + 8 * hh;
#pragma unroll
    for (int s = 0; s < 4; ++s) qf[s] = *(const bf16x8*)(qp + 16 * s);
  }
  f32x16 o0 = zero16(), o1 = zero16();
  float m_run = -1e30f, l_run = 0.f;
  const int pi = (q & 19) | ((q & 4) << 1) | ((q & 8) >> 1);
  const int w = half * 32 + q;
  const int st = min(max(w - 8, 0), 48);
  const int rs = min(max(r - 4, 0), 56);
  const int ntiles = local ? 24 : 8;
  bf16x8 kfn[4], vfn[2][2];
  auto tile_load = [&](int ti, bf16x8 (&kfo)[4], bf16x8 (&vfo)[2][2]) {
    int ktok0, vstride;
    const u16* vb;
    if (ti < 8) {
      ktok0 = NLAT + b * 256 + ti * 32;
      vb = p.vTc + ((size_t)(b * 512 + h * 64)) * 256 + ti * 32;
      vstride = 256;
    } else {
      const int tl = ti - 8;
      const int a2 = tl >> 1, g2 = tl & 1;
      ktok0 = b * 4096 + (rs + a2) * 64 + g2 * 32;
      vb = p.vT + ((size_t)(b * 512 + h * 64)) * 4096 + (rs + a2) * 64 + g2 * 32;
      vstride = 4096;
    }
    const u16* kp = p.qk + (size_t)(ktok0 + pi) * 1024 + 512 + h * 64 + 8 * hh;
#pragma unroll
    for (int s = 0; s < 4; ++s) kfo[s] = *(const bf16x8*)(kp + 16 * s);
#pragma unroll
    for (int dt = 0; dt < 2; ++dt)
#pragma unroll
      for (int s2 = 0; s2 < 2; ++s2) vfo[dt][s2] = *(const bf16x8*)(vb + (size_t)(dt * 32 + q) * vstride + 16 * s2 + 8 * hh);
  };
  tile_load(0, kfn, vfn);
  for (int ti = 0; ti < ntiles; ++ti) {
    int a = 0, g = 0;
    if (ti >= 8) { a = (ti - 8) >> 1; g = (ti - 8) & 1; }
    bf16x8 kf[4], vf[2][2];
#pragma unroll
    for (int s = 0; s < 4; ++s) kf[s] = kfn[s];
#pragma unroll
    for (int dt = 0; dt < 2; ++dt)
#pragma unroll
      for (int s2 = 0; s2 < 2; ++s2) vf[dt][s2] = vfn[dt][s2];
    if (ti + 1 < ntiles) tile_load(ti + 1, kfn, vfn);
    f32x16 sacc = zero16();
#pragma unroll
    for (int s = 0; s < 4; ++s) sacc = mfma32(kf[s], qf[s], sacc);
    float sv[16];
    float tmax = -1e30f;
#pragma unroll
    for (int e = 0; e < 16; ++e) {
      float x = sacc[e] * 0.125f;
      if (ti >= 8) {
        const int kc = g * 32 + (e & 7) + 8 * hh + 16 * (e >> 3);
        const bool valid = (kc >= st) && (kc < st + 16);
        const int bi = valid ? ((rs + a - r + 7) * 31 + (kc - w + 15)) : 0;
        const float bias = rpbL[bi];
        x = valid ? (x + bias) : -1e30f;
      }
      sv[e] = x;
      tmax = fmaxf(tmax, x);
    }
    tmax = fmaxf(tmax, shx(tmax, 32));
    const float m_new = fmaxf(m_run, tmax);
    const float alpha = __expf(m_run - m_new);
    m_run = m_new;
    l_run *= alpha;
#pragma unroll
    for (int e = 0; e < 16; ++e) { o0[e] *= alpha; o1[e] *= alpha; }
    float psum = 0.f;
#pragma unroll
    for (int e = 0; e < 16; ++e) { const float pe = __expf(sv[e] - m_new); sv[e] = pe; psum += pe; }
    l_run += psum;
    bf16x8 pf[2];
#pragma unroll
    for (int s2 = 0; s2 < 2; ++s2) {
      union { bf16x8 v; unsigned u[4]; } cv;
#pragma unroll
      for (int j = 0; j < 4; ++j) cv.u[j] = pk2(sv[8 * s2 + 2 * j], sv[8 * s2 + 2 * j + 1]);
      pf[s2] = cv.v;
    }
#pragma unroll
    for (int s2 = 0; s2 < 2; ++s2) {
      o0 = mfma32(vf[0][s2], pf[s2], o0);
      o1 = mfma32(vf[1][s2], pf[s2], o1);
    }
  }
  const float lt = l_run + shx(l_run, 32);
  const float inv = 1.0f / lt;
  u16* op = p.ycat + (size_t)(qtok0 + q) * 1024 + h * 64;
#pragma unroll
  for (int qd = 0; qd < 4; ++qd) {
    uint2 a0, a1;
    a0.x = pk2(o0[4 * qd] * inv, o0[4 * qd + 1] * inv);
    a0.y = pk2(o0[4 * qd + 2] * inv, o0[4 * qd + 3] * inv);
    a1.x = pk2(o1[4 * qd] * inv, o1[4 * qd + 1] * inv);
    a1.y = pk2(o1[4 * qd + 2] * inv, o1[4 * qd + 3] * inv);
    *(uint2*)(op + 8 * qd + 4 * hh) = a0;
    *(uint2*)(op + 32 + 8 * qd + 4 * hh) = a1;
  }
}
__device__ __forceinline__ void attn_task(const P& p, int l, int kind, int idx, char* smem) {
  const int tid_ = opaque_tid(); const int lane = tid_ & 63, wid = tid_ >> 6;
  float* rpbL = (float*)smem + wid * 480;
  for (int i = lane; i < 465; i += 64) rpbL[i] = p.na_rpb[(size_t)(l * 8 + wid) * 465 + i];
  __syncthreads();
  if (kind == 0) {
    const int half = idx & 1, r = (idx >> 1) & 63, b = idx >> 7;
    attn_wave(p, l, b, wid, true, r, half, b * 4096 + r * 64 + half * 32, rpbL);
  } else {
    const int qg = idx & 7, b = idx >> 3;
    attn_wave(p, l, b, wid, false, 0, 0, NLAT + b * 256 + qg * 32, rpbL);
  }
  __syncthreads();
}

__device__ __forceinline__ void phase_mixers(const P& p, int l, char* smem, unsigned* counter) {
  const bool last = (l == 1);
  const int n_rg = 2176 * XRGA, n_fft = 1024 * XFFT, n_hc = last ? 0 : 256, n_att = 1024 * XATT, n_attc = last ? 0 : 64;
  const int total = n_rg + n_fft + n_hc + n_att + n_attc;
  volatile int* s_taskp = (volatile int*)(smem + SMEM_BYTES - 16);
  for (;;) {
    __syncthreads();
    if (threadIdx.x == 0) *s_taskp = (int)atomicAdd(counter, 1u);
    __syncthreads();
    int t = *s_taskp;
    if (t >= total) break;
    if (t < n_rg) { if (t >= 2176) t -= 2176; rg_chunk_task(p, l, t >> 2, t & 3, 0, last, smem); continue; }
    t -= n_rg;
    if (t < n_fft) { t &= 1023; hyena_fft_task(p, l, t >> 2, t & 3, smem); continue; }
    t -= n_fft;
    if (t < n_hc) { hyena_ctx_task(p, l, t >> 5, t & 31, smem); continue; }
    t -= n_hc;
    if (t < n_att) { t &= 1023; attn_task(p, l, 0, t, smem); continue; }
    t -= n_att;
    attn_task(p, l, 1, t, smem);
  }
}

__device__ __forceinline__ void merge_tile(const P& p, int l, int mt, int nt, char* smem) {
  EPI_VARS
  const int m0 = mt * 256, n0 = nt * 128;
  f32x16 macc[2][2];
  zero_acc(macc);
  for (int br = 0; br < 3; ++br) {
    unsigned* gpl = (unsigned*)(smem + 98304) + tid;
    {
      f32x16 acc[2][2];
      zero_acc(acc);
      gemm_kloop(acc, p.xn + (size_t)m0 * 1024, 1024, p.WgT + ((size_t)l * 3072 + br * 1024 + n0) * 1024, 1024, 1024, smem);
#pragma unroll
      for (int j = 0; j < 2; ++j) {
        const float bg = p.b_gate[l * 3072 + br * 1024 + n0 + EPI_COL(j)];
#pragma unroll
        for (int i = 0; i < 2; ++i)
#pragma unroll
          for (int e = 0; e < 4; ++e) {
            const unsigned q0 = (unsigned)(sigmoidf_(acc[i][j][4 * e] + bg) * 255.0f + 0.5f);
            const unsigned q1 = (unsigned)(sigmoidf_(acc[i][j][4 * e + 1] + bg) * 255.0f + 0.5f);
            const unsigned q2 = (unsigned)(sigmoidf_(acc[i][j][4 * e + 2] + bg) * 255.0f + 0.5f);
            const unsigned q3 = (unsigned)(sigmoidf_(acc[i][j][4 * e + 3] + bg) * 255.0f + 0.5f);
            gpl[((i * 2 + j) * 4 + e) * 512] = q0 | (q1 << 8) | (q2 << 16) | (q3 << 24);
          }
      }
    }
    {
      f32x16 acc[2][2];
      zero_acc(acc);
      const u16* A; const u16* B; int K;
      if (br == 0) { A = p.ycat + (size_t)m0 * 1024; B = p.WaT + ((size_t)l * 1024 + n0) * 512; K = 512; }
      else if (br == 1) { A = p.ycat + (size_t)m0 * 1024 + 512; B = p.WbT + ((size_t)l * 1024 + n0) * 256; K = 256; }
      else { A = p.ycat + (size_t)m0 * 1024 + 768; B = p.WcT + ((size_t)l * 1024 + n0) * 256; K = 256; }
      gemm_kloop(acc, A, 1024, B, K, K, smem);
#pragma unroll
      for (int i = 0; i < 2; ++i)
#pragma unroll
        for (int j = 0; j < 2; ++j)
#pragma unroll
          for (int e = 0; e < 4; ++e) {
            const unsigned g4 = gpl[((i * 2 + j) * 4 + e) * 512];
            macc[i][j][4 * e] += (float)(g4 & 255u) * (1.0f / 255.0f) * acc[i][j][4 * e];
            macc[i][j][4 * e + 1] += (float)((g4 >> 8) & 255u) * (1.0f / 255.0f) * acc[i][j][4 * e + 1];
            macc[i][j][4 * e + 2] += (float)((g4 >> 16) & 255u) * (1.0f / 255.0f) * acc[i][j][4 * e + 2];
            macc[i][j][4 * e + 3] += (float)(g4 >> 24) * (1.0f / 255.0f) * acc[i][j][4 * e + 3];
          }
    }
  }
#pragma unroll
  for (int i = 0; i < 2; ++i)
#pragma unroll
    for (int j = 0; j < 2; ++j)
#pragma unroll
      for (int e = 0; e < 16; ++e)
        p.mbuf[(size_t)(m0 + EPI_ROW(i, e)) * 1024 + n0 + EPI_COL(j)] = f2bf(macc[i][j][e]);
}
__device__ __forceinline__ void outproj_tile(const P& p, int l, int mt, int nt, char* smem, bool do_store) {
  EPI_VARS
  const int m0 = mt * 256, n0 = nt * 128;
  f32x16 acc[2][2];
  zero_acc(acc);
  gemm_kloop(acc, p.mbuf + (size_t)m0 * 1024, 1024, p.WoT + ((size_t)l * 1024 + n0) * 1024, 1024, 1024, smem);
  const bool isctx = (mt >= 128);
  const int bi = isctx ? 8 : (mt >> 4);
  const float* gatev = p.mod + ((size_t)(l * 9 + bi) * 6 + 2) * 1024;
  const float* src; float* dst;
  if (isctx) { src = (l == 0 ? p.ctx : p.ctxs) - (size_t)NLAT * 1024; dst = p.ctxs - (size_t)NLAT * 1024; }
  else { src = (l == 0 ? p.x : p.out); dst = p.out; }
#pragma unroll
  for (int j = 0; j < 2; ++j) {
    const int col = n0 + EPI_COL(j);
    const float gv = gatev[col];
#pragma unroll
    for (int i = 0; i < 2; ++i)
#pragma unroll
      for (int e = 0; e < 16; ++e) {
        const size_t o = (size_t)(m0 + EPI_ROW(i, e)) * 1024 + col;
        if (do_store) dst[o] = src[o] + gv * acc[i][j][e];
      }
  }
}

__device__ __forceinline__ void ins16(unsigned (&L)[16], unsigned x) {
#pragma unroll
  for (int i = 0; i < 16; ++i) {
    const unsigned hi = max(L[i], x);
    x = min(L[i], x);
    L[i] = hi;
  }
}
__device__ __forceinline__ unsigned f2sort(float f) {
  const unsigned b = __float_as_uint(f);
  return b ^ ((unsigned)((int)b >> 31) | 0x80000000u);
}
__device__ __forceinline__ float sort2f(unsigned k) {
  const unsigned u = k & ~127u;
  const unsigned b = (u & 0x80000000u) ? (u ^ 0x80000000u) : ~u;
  return __uint_as_float(b);
}
__device__ __forceinline__ void peer_score_tile(const P& p, int l, int mt, int hp, char* smem) {
  EPI_VARS
  const int m0 = mt * 256;
  f32x16 acc[2][2];
  zero_acc(acc);
  gemm_kloop(acc, p.q + (size_t)m0 * 2048 + hp * 128, 2048, p.keysB + ((size_t)l * 16 + hp) * 16384, 128, 128, smem);
  float* Sf = (float*)smem;
#pragma unroll
  for (int i = 0; i < 2; ++i)
#pragma unroll
    for (int j = 0; j < 2; ++j)
#pragma unroll
      for (int e = 0; e < 16; ++e) Sf[EPI_ROW(i, e) * 130 + EPI_COL(j)] = acc[i][j][e];
  __syncthreads();
  unsigned L[16];
#pragma unroll
  for (int i = 0; i < 16; ++i) L[i] = 0u;
  const int row = tid >> 1, hf = tid & 1;
  for (int i = 0; i < 64; ++i) {
    const int key = 2 * i + hf;
    const float v = Sf[row * 130 + key];
    ins16(L, (f2sort(v) & ~127u) | (unsigned)key);
  }
  unsigned* X = (unsigned*)(smem + 133120);
  if (hf) {
#pragma unroll
    for (int i = 0; i < 16; ++i) X[row * 16 + i] = L[i];
  }
  __syncthreads();
  if (!hf) {
#pragma unroll
    for (int i = 0; i < 16; ++i) ins16(L, X[row * 16 + i]);
    unsigned* o = p.topk + ((size_t)(m0 + row) * 16 + hp) * 16;
#pragma unroll
    for (int i = 0; i < 4; ++i) *(uint4*)(o + 4 * i) = make_uint4(L[4 * i], L[4 * i + 1], L[4 * i + 2], L[4 * i + 3]);
  }
  __syncthreads();
}

__device__ __forceinline__ void phase_peer_experts(const P& p, int l, bool do_store) {
  const int tid_ = opaque_tid(); const int lane = tid_ & 63, wid = tid_ >> 6;
  const int ntok = (l == 1) ? NLAT : NTOK;
  int ci, cj;
  {
    const int e = lane;
    if (e < 16) { ci = 0; cj = e; }
    else if (e < 24) { ci = 1; cj = e - 16; }
    else if (e < 29) { ci = 2; cj = e - 24; }
    else if (e < 33) { ci = 3; cj = e - 29; }
    else if (e < 36) { ci = 4; cj = e - 33; }
    else if (e < 38) { ci = 5; cj = e - 36; }
    else if (e < 40) { ci = 6; cj = e - 38; }
    else if (e < 42) { ci = 7; cj = e - 40; }
    else { ci = min(8 + (e - 42), 15); cj = 0; }
  }
  for (int tok = blockIdx.x * 8 + wid; tok < ntok; tok += gridDim.x * 8) {
    float xr[16];
    {
      const uint4 a = *(const uint4*)(p.xn + (size_t)tok * 1024 + lane * 16);
      const uint4 b = *(const uint4*)(p.xn + (size_t)tok * 1024 + lane * 16 + 8);
      xr[0] = bflo(a.x); xr[1] = bfhi(a.x); xr[2] = bflo(a.y); xr[3] = bfhi(a.y);
      xr[4] = bflo(a.z); xr[5] = bfhi(a.z); xr[6] = bflo(a.w); xr[7] = bfhi(a.w);
      xr[8] = bflo(b.x); xr[9] = bfhi(b.x); xr[10] = bflo(b.y); xr[11] = bfhi(b.y);
      xr[12] = bflo(b.z); xr[13] = bfhi(b.z); xr[14] = bflo(b.w); xr[15] = bfhi(b.w);
    }
    float yacc[16];
#pragma unroll
    for (int i = 0; i < 16; ++i) yacc[i] = 0.f;
    unsigned kvh[8];
#pragma unroll
    for (int h = 0; h < 8; ++h) kvh[h] = p.topk[((size_t)tok * 16 + 2 * h) * 16 + (lane & 31)];
    int eperm[8], gperm[8];
#pragma unroll
    for (int h = 0; h < 8; ++h) {
      const unsigned k0 = shu(kvh[h], ci);
      const unsigned k1 = shu(kvh[h], 16 + cj);
      const float val = (lane < 50) ? (sort2f(k0) + sort2f(k1)) : -3.0e38f;
      const int eidx = (int)((k0 & 127u) * 128u + (k1 & 127u));
      int cnt = 0;
#pragma unroll
      for (int e2 = 0; e2 < 50; ++e2) {
        const float v2 = __builtin_bit_cast(float, __builtin_amdgcn_readlane(__builtin_bit_cast(int, val), e2));
        cnt += (v2 > val || (v2 == val && e2 < lane)) ? 1 : 0;
      }
      const bool sel = (lane < 50) && (cnt < 16);
      const float mx = wave_max(sel ? val : -3.0e38f);
      const float ex = sel ? __expf(val - mx) : 0.f;
      const float sm = wave_sum(ex);
      const float gsel = ex / sm;
      const int dst4 = (sel ? cnt : 63) * 4;
      eperm[h] = __builtin_amdgcn_ds_permute(dst4, eidx);
      gperm[h] = __builtin_amdgcn_ds_permute(dst4, __builtin_bit_cast(int, gsel));
    }
#pragma unroll
    for (int h = 0; h < 8; ++h) {
      uint2 U[16], V[16];
#pragma unroll
      for (int k = 0; k < 16; ++k) {
        const int id = __builtin_amdgcn_readlane(eperm[h], k);
        U[k] = *(const uint2*)(p.Ub + (size_t)id * 512 + lane * 8);
        V[k] = *(const uint2*)(p.Vb + (size_t)id * 512 + lane * 8);
      }
      float d[16];
#pragma unroll
      for (int k = 0; k < 16; ++k) {
        const unsigned uw[2] = {U[k].x, U[k].y};
        float dd = 0.f;
#pragma unroll
        for (int q2 = 0; q2 < 2; ++q2) {
          const f32x2 e0 = __builtin_amdgcn_cvt_scalef32_pk_f32_fp4(uw[q2], 1.0f, 0);
          const f32x2 e1 = __builtin_amdgcn_cvt_scalef32_pk_f32_fp4(uw[q2], 1.0f, 1);
          const f32x2 e2 = __builtin_amdgcn_cvt_scalef32_pk_f32_fp4(uw[q2], 1.0f, 2);
          const f32x2 e3 = __builtin_amdgcn_cvt_scalef32_pk_f32_fp4(uw[q2], 1.0f, 3);
          dd += xr[8 * q2] * e0.x + xr[8 * q2 + 1] * e0.y + xr[8 * q2 + 2] * e1.x + xr[8 * q2 + 3] * e1.y +
                xr[8 * q2 + 4] * e2.x + xr[8 * q2 + 5] * e2.y + xr[8 * q2 + 6] * e3.x + xr[8 * q2 + 7] * e3.y;
        }
        d[k] = dd;
      }
      {
        const bool b5 = (lane & 32) != 0, b4 = (lane & 16) != 0, b3 = (lane & 8) != 0, b2 = (lane & 4) != 0;
#pragma unroll
        for (int j = 0; j < 8; ++j) { const float keep = b5 ? d[j + 8] : d[j], send = b5 ? d[j] : d[j + 8]; d[j] = keep + shx(send, 32); }
#pragma unroll
        for (int j = 0; j < 4; ++j) { const float keep = b4 ? d[j + 4] : d[j], send = b4 ? d[j] : d[j + 4]; d[j] = keep + shx(send, 16); }
#pragma unroll
        for (int j = 0; j < 2; ++j) { const float keep = b3 ? d[j + 2] : d[j], send = b3 ? d[j] : d[j + 2]; d[j] = keep + shx(send, 8); }
        { const float keep = b2 ? d[1] : d[0], send = b2 ? d[0] : d[1]; d[0] = keep + shx(send, 4); }
        d[0] += shx(d[0], 2);
        d[0] += shx(d[0], 1);
      }
      const float gl = __builtin_bit_cast(float, shu((unsigned)gperm[h], (lane >> 2) & 15));
      const float act = gelu_tanh(d[0] * (1.0f / 64.0f)) * gl;
#pragma unroll
      for (int k = 0; k < 16; ++k) {
        const float ak = __builtin_bit_cast(float, __builtin_amdgcn_readlane(__builtin_bit_cast(int, act), 4 * k));
        const unsigned vw[2] = {V[k].x, V[k].y};
#pragma unroll
        for (int q2 = 0; q2 < 2; ++q2) {
          const f32x2 e0 = __builtin_amdgcn_cvt_scalef32_pk_f32_fp4(vw[q2], 1.0f, 0);
          const f32x2 e1 = __builtin_amdgcn_cvt_scalef32_pk_f32_fp4(vw[q2], 1.0f, 1);
          const f32x2 e2 = __builtin_amdgcn_cvt_scalef32_pk_f32_fp4(vw[q2], 1.0f, 2);
          const f32x2 e3 = __builtin_amdgcn_cvt_scalef32_pk_f32_fp4(vw[q2], 1.0f, 3);
          yacc[8 * q2] += ak * e0.x; yacc[8 * q2 + 1] += ak * e0.y; yacc[8 * q2 + 2] += ak * e1.x; yacc[8 * q2 + 3] += ak * e1.y;
          yacc[8 * q2 + 4] += ak * e2.x; yacc[8 * q2 + 5] += ak * e2.y; yacc[8 * q2 + 6] += ak * e3.x; yacc[8 * q2 + 7] += ak * e3.y;
        }
      }
    }
    const int bi = tok < NLAT ? (tok >> 12) : 8;
    const float* gv = p.mod + ((size_t)(l * 9 + bi) * 6 + 5) * 1024 + lane * 16;
    float* xp = (tok < NLAT) ? (p.out + (size_t)tok * 1024) : (p.ctxs + (size_t)(tok - NLAT) * 1024);
    xp += lane * 16;
#pragma unroll
    for (int i = 0; i < 4; ++i) {
      float4 xv = *(float4*)(xp + 4 * i);
      const float4 g4 = *(const float4*)(gv + 4 * i);
      xv.x += g4.x * yacc[4 * i] * 0.25f; xv.y += g4.y * yacc[4 * i + 1] * 0.25f; xv.z += g4.z * yacc[4 * i + 2] * 0.25f; xv.w += g4.w * yacc[4 * i + 3] * 0.25f;
      if (do_store) *(float4*)(xp + 4 * i) = xv;
    }
  }
}


#define XB_TMO      128
#define XB_XCNT(j)  (256  + 64 * (j))
#define XB_XSUB(j)  (1280 + 64 * (j))
#define XB_XGEN(j)  (2304 + 64 * (j))
#define XB_TOP      3328
#define XB_TOPGEN   3392
#define XCD_BAR_WORDS 3456
#define XB_SPIN_CAP (1u << 22)
#define LAS __attribute__((address_space(3)))
__device__ __forceinline__ unsigned xb_ld(unsigned* p) { return __hip_atomic_load(p, __ATOMIC_RELAXED, __HIP_MEMORY_SCOPE_AGENT); }
__device__ __forceinline__ unsigned xb_add(unsigned* p, unsigned v) { return __hip_atomic_fetch_add(p, v, __ATOMIC_RELAXED, __HIP_MEMORY_SCOPE_AGENT); }
__device__ __forceinline__ unsigned xb_xcc_id() { return (unsigned)__builtin_amdgcn_s_getreg((3 << 11) | 20) & 0xFu; }
#define XB_SPIN(cond, bar) do { unsigned _sp = 0; while (cond) { __builtin_amdgcn_s_sleep(1); \
    if ((++_sp & 255u) == 0u) { if (xb_ld(&(bar)[XB_TMO])) break; if (_sp > XB_SPIN_CAP) { atomicAdd(&(bar)[XB_TMO], 1u); break; } } } } while (0)
struct XcdBarrier { unsigned* bar; unsigned x; volatile LAS unsigned* st; };
__device__ __forceinline__ XcdBarrier xcd_barrier_post(unsigned* bar, volatile LAS unsigned* st) {
  XcdBarrier b; b.bar = bar; b.x = xb_xcc_id(); b.st = st;
  if (threadIdx.x == 0) (void)xb_add(&bar[XB_XCNT(b.x)], 1u);
  return b;
}
__device__ __forceinline__ void xcd_barrier_complete(unsigned* bar, unsigned x, unsigned& nloc, unsigned& nx) {
  const unsigned G = gridDim.x * gridDim.y * gridDim.z;
  unsigned sum, cnt, mine, sp = 0u;
  for (;;) {
    sum = 0u; cnt = 0u; mine = 0u;
#pragma unroll
    for (unsigned j = 0; j < 16; ++j) { const unsigned c = xb_ld(&bar[XB_XCNT(j)]); sum += c; cnt += (c > 0u) ? 1u : 0u; mine = (j == x) ? c : mine; }
    if (sum == G) break;
    __builtin_amdgcn_s_sleep(1);
    if ((++sp & 255u) == 0u) { if (xb_ld(&bar[XB_TMO])) break; if (sp > XB_SPIN_CAP) { atomicAdd(&bar[XB_TMO], 1u); break; } }
  }
  nloc = mine > 0u ? mine : 1u; nx = cnt > 0u ? cnt : 1u;
}
__device__ __forceinline__ void xcd_barrier(unsigned* bar_u, volatile LAS unsigned* st_u) {
  XcdBarrier b; b.bar = bar_u; b.x = xb_xcc_id(); b.st = st_u;
  asm volatile("s_waitcnt vmcnt(0)" ::: "memory");
  __syncthreads();
  if (threadIdx.x == 0) {
    unsigned long long bp_ = (unsigned long long)b.bar;
    asm volatile("" : "+v"(bp_));
    unsigned* bar = (unsigned*)bp_;
    __builtin_amdgcn_s_waitcnt(0);
    unsigned nloc = b.st[0], nx = b.st[1];
    if (nloc == 0u) { xcd_barrier_complete(bar, b.x, nloc, nx); b.st[0] = nloc; b.st[1] = nx; }
    const unsigned old = xb_add(&bar[XB_XSUB(b.x)], 1u);
    const unsigned gen = old / nloc;
    if (old + 1u == (gen + 1u) * nloc) {
      __builtin_amdgcn_fence(__ATOMIC_RELEASE, "agent");
      asm volatile("s_waitcnt vmcnt(0)" ::: "memory");
      const unsigned og = xb_add(&bar[XB_TOP], 1u);
      const unsigned tg = og / nx;
      if (og + 1u == (tg + 1u) * nx) xb_add(&bar[XB_TOPGEN], 1u);
      else XB_SPIN(xb_ld(&bar[XB_TOPGEN]) == tg, bar);
      __builtin_amdgcn_fence(__ATOMIC_ACQUIRE, "agent");
      xb_add(&bar[XB_XGEN(b.x)], 1u);
      asm volatile("s_waitcnt vmcnt(0)" ::: "memory");
    } else {
      XB_SPIN(xb_ld(&bar[XB_XGEN(b.x)]) == gen, bar);
      __builtin_amdgcn_fence(__ATOMIC_ACQUIRE, "agent");
      asm volatile("s_waitcnt vmcnt(0)" ::: "memory");
    }
  }
  __syncthreads();
}

template <int l>
__device__ __forceinline__ void layer_body(const P& p, char* smem, pg8::PG8_LAS_T lds, volatile LAS unsigned* xbw, const int nb, const int bid) {
    const bool last = (l == 1);
    const int n_mt = last ? 128 : 136;
_Pragma("unroll 1")
    for (int rep = 0; rep < REP_1A; ++rep) {
      phase_norm(p, l, 0);
    }
    xcd_barrier(p.counters + 1024, xbw);
_Pragma("unroll 1")
    for (int rep = 0; rep < REP_INPROJ; ++rep) {
      pg8::Gemm g; pg8::Order S;
      g.A = p.xn; g.Bt = p.WinT + (size_t)l * 2816 * 1024; g.lda = 1024; g.ldb = 1024; g.K = 1024;
      S.init(136, 6, nb, bid, 4, 5);
      pg8::EpiInprojN e1; e1.qk = p.qk; e1.rg = p.rg;
      pg8::gemm_phase(lds, g, S, e1);
      g.A = p.WinT + ((size_t)l * 2816 + 1024) * 1024; g.Bt = p.xn;
      S.init(5, 136, nb, bid);
      pg8::EpiInprojT e2; e2.vT = p.vT; e2.vTc = p.vTc; e2.hyT = p.hyT; e2.hyTc = p.hyTc;
      pg8::gemm_phase(lds, g, S, e2);
    }
    xcd_barrier(p.counters + 1024, xbw);
    phase_mixers(p, l, smem, p.counters + l * 4);
    xcd_barrier(p.counters + 1024, xbw);
_Pragma("unroll 1")
    for (int rep = 0; rep < REP_2B; ++rep)
      for (int task = bid; task < 2176; task += nb) rg_chunk_task(p, l, task >> 2, task & 3, 1, last, smem);
    xcd_barrier(p.counters + 1024, xbw);
_Pragma("unroll 1")
    for (int rep = 0; rep < REP_GATE; ++rep) {
      pg8::Gemm g; pg8::Order S;
      g.A = p.xn; g.Bt = p.WgT + (size_t)l * 3072 * 1024; g.lda = 1024; g.ldb = 1024; g.K = 1024;
      S.init(n_mt, 12, nb, bid);
      pg8::EpiGate e; e.g8 = p.g8; e.bias = p.b_gate + l * 3072;
      pg8::gemm_phase(lds, g, S, e);
    }
    xcd_barrier(p.counters + 1024, xbw);
_Pragma("unroll 1")
    for (int rep = 0; rep < REP_BRANCH; ++rep) {
      pg8::Gemm g; pg8::Order S;
      S.init(n_mt, 4, nb, bid);
      pg8::EpiBranch e; e.mbuf = p.mbuf; e.g8 = p.g8;
      g.lda = 1024;
      g.A = p.ycat; g.Bt = p.WaT + (size_t)l * 1024 * 512; g.ldb = 512; g.K = 512; e.br = 0;
      pg8::gemm_phase(lds, g, S, e);
      g.A = p.ycat + 512; g.Bt = p.WbT + (size_t)l * 1024 * 256; g.ldb = 256; g.K = 256; e.br = 1;
      pg8::gemm_phase(lds, g, S, e);
      g.A = p.ycat + 768; g.Bt = p.WcT + (size_t)l * 1024 * 256; g.ldb = 256; g.K = 256; e.br = 2;
      pg8::gemm_phase(lds, g, S, e);
    }
    xcd_barrier(p.counters + 1024, xbw);
    {
      pg8::Gemm g; pg8::Order S;
      g.A = p.mbuf; g.Bt = p.WoT + (size_t)l * 1024 * 1024; g.lda = 1024; g.ldb = 1024; g.K = 1024;
      S.init(n_mt, 4, nb, bid);
      pg8::EpiOut e; e.xsrc = (l == 0 ? p.x : p.out); e.csrc = (l == 0 ? p.ctx : p.ctxs); e.xdst = p.out; e.cdst = p.ctxs;
      e.modl = p.mod + (size_t)l * 9 * 6144;
      pg8::gemm_phase(lds, g, S, e);
      for (int t = bid; t < 8192; t += nb) {
        if (t < 4096) cvt_chunk_fp4(p.peer_u + (size_t)l * 16384 * 1024, p.Ub, (size_t)t, 64.0f);
        else cvt_chunk_fp4(p.peer_v + (size_t)l * 16384 * 1024, p.Vb, (size_t)(t - 4096), 4.0f);
      }
    }
    xcd_barrier(p.counters + 1024, xbw);
    phase_norm(p, l, 1);
    xcd_barrier(p.counters + 1024, xbw);
_Pragma("unroll 1")
    for (int rep = 0; rep < REP_Q; ++rep) {
      pg8::Gemm g; pg8::Order S;
      g.A = p.xn; g.Bt = p.WqT + (size_t)l * 2048 * 1024; g.lda = 1024; g.ldb = 1024; g.K = 1024;
      S.init(n_mt, 8, nb, bid);
      pg8::EpiQ e; e.q = p.q;
      pg8::gemm_phase(lds, g, S, e);
    }
    xcd_barrier(p.counters + 1024, xbw);
_Pragma("unroll 1")
    for (int rep = 0; rep < REP_SCORE; ++rep)
      for (int task = bid; task < n_mt * 16; task += nb) peer_score_tile(p, l, task >> 4, task & 15, smem);
    xcd_barrier(p.counters + 1024, xbw);
_Pragma("unroll 1")
    for (int rep = 0; rep < REP_PEER; ++rep) phase_peer_experts(p, l, rep == REP_PEER - 1);
    xcd_barrier(p.counters + 1024, xbw);
  }

__global__ void __launch_bounds__(NTHR) fwd_megakernel(P p) {
  __shared__ __attribute__((aligned(16))) char smem[SMEM_BYTES];
  cg::grid_group grid = cg::this_grid();
  const int nb = gridDim.x, bid = blockIdx.x;
  pg8::PG8_LAS_T lds = (pg8::PG8_LAS_T)smem;
  volatile LAS unsigned* xbw = (volatile LAS unsigned*)(smem + SMEM_BYTES - 32);
  if (threadIdx.x == 0) { xbw[0] = 0u; xbw[1] = 0u; xbw[2] = 0u; xbw[3] = 0u; }
  __syncthreads();
  (void)xcd_barrier_post(p.counters + 1024, xbw);

  phase_prep(p, smem);
  phase_filters(p, 0);
  phase_filters(p, 1);
  grid.sync();
  phase_modreduce(p);
  for (int task = blockIdx.x; task < 512; task += gridDim.x) kf_task(p, task >> 8, task & 255, smem);
  xcd_barrier(p.counters + 1024, xbw);

  layer_body<0>(p, smem, lds, xbw, nb, bid);
  layer_body<1>(p, smem, lds, xbw, nb, bid);
  phase_norm(p, 1, 2);
}

extern "C" void kernel_launch(void* const* d_in, const int* in_sizes, int n_in, void* d_out, int out_size, void* d_ws,
                              size_t ws_size, hipStream_t stream) {
  P p;
  memset(&p, 0, sizeof(p));
  const float** ins = (const float**)&p;
  for (int i = 0; i < 37; ++i) ins[i] = (const float*)d_in[i];
  p.out = (float*)d_out;
  char* w = (char*)d_ws;
  size_t off = 0;
  auto take = [&](size_t bytes) { char* r = w + off; off += (bytes + 255) & ~(size_t)255; return r; };
  p.counters = (unsigned*)take(32768);
  p.WinT = (u16*)take((size_t)2 * 2816 * 1024 * 2);
  p.WgT = (u16*)take((size_t)2 * 3072 * 1024 * 2);
  p.WaT = (u16*)take((size_t)2 * 1024 * 512 * 2);
  p.WbT = (u16*)take((size_t)2 * 1024 * 256 * 2);
  p.WcT = (u16*)take((size_t)2 * 1024 * 256 * 2);
  p.WoT = (u16*)take((size_t)2 * 1024 * 1024 * 2);
  p.WqT = (u16*)take((size_t)2 * 2048 * 1024 * 2);
  p.keysB = (u16*)take((size_t)2 * 16 * 16384 * 2);
  p.rgW = (u16*)take((size_t)2 * 16 * 4096 * 2);
  p.modpart = (float*)take((size_t)16 * 2 * 9 * 6144 * 4);
  p.mod = (float*)take((size_t)2 * 9 * 6144 * 4);
  p.hT = (float*)take((size_t)2 * 512 * 4096 * 4);
  p.hc = (float*)take((size_t)512 * 256 * 4);
  p.Kf = (float*)take((size_t)2 * 256 * 8192 * 8);
  p.xn = (u16*)take((size_t)NTOK * 1024 * 2);
  p.qk = (u16*)take((size_t)NTOK * 1024 * 2);
  p.mbuf = p.qk;
  p.vT = (u16*)take((size_t)8 * 512 * 4096 * 2);
  p.vTc = (u16*)take((size_t)8 * 512 * 256 * 2);
  p.hyT = (u16*)take((size_t)8 * 768 * 4096 * 2);
  p.hyTc = (u16*)take((size_t)8 * 768 * 256 * 2);
  p.rg = (u16*)take((size_t)NTOK * 512 * 2);
  p.ycat = (u16*)take((size_t)NTOK * 1024 * 2);
  p.Ub = (unsigned char*)p.ycat;
  p.Vb = p.Ub + (size_t)16384 * 512;
  p.agg = (float*)take((size_t)8 * 2 * 68 * 256 * 8);
  p.ctxs = (float*)take((size_t)2048 * 1024 * 4);
  p.g8 = (unsigned char*)p.vT;
  p.q = p.qk;
  p.topk = (unsigned*)((char*)p.qk + (size_t)NTOK * 2048 * 2);
  if (off > ws_size) {
    fprintf(stderr, "workspace too small: need %zu have %zu\n", off, ws_size);
    return;
  }
  static int grid_blocks = 0;
  if (!grid_blocks) {
    int dev = 0, cus = 0, per_cu = 0;
    (void)hipGetDevice(&dev);
    (void)hipDeviceGetAttribute(&cus, hipDeviceAttributeMultiprocessorCount, dev);
    (void)hipOccupancyMaxActiveBlocksPerMultiprocessor(&per_cu, fwd_megakernel, NTHR, 0);
    if (per_cu > 1) per_cu = 1;
    grid_blocks = cus * per_cu;
  }
  (void)hipMemsetAsync(p.counters, 0, 32768, stream);
  void* args[] = {&p};
  hipError_t e = hipLaunchCooperativeKernel((void*)fwd_megakernel, dim3(grid_blocks), dim3(NTHR), args, 0, stream);
  if (e != hipSuccess) fprintf(stderr, "cooperative launch failed: %s (grid %d)\n", hipGetErrorString(e), grid_blocks);
}
```

```cpp
#include <hip/hip_runtime.h>
#include <hip/hip_cooperative_groups.h>
#include <cstdio>
#include <cstring>
namespace cg = cooperative_groups;

typedef unsigned short u16;
typedef __attribute__((ext_vector_type(8))) short bf16x8;
typedef __attribute__((ext_vector_type(16))) float f32x16;
typedef __attribute__((ext_vector_type(2))) float f32x2;

#define NLAT 32768
#define NTOK 34816
#define SMEM_BYTES 151552
#define NTHR 512
#ifndef DUP_1A
#define DUP_1A 1
#endif
#ifndef DUP_PREP
#define DUP_PREP 1
#endif
#ifndef DUP_2B
#define DUP_2B 1
#endif
#ifndef XRGA
#define XRGA 1
#endif
#ifndef REP_PEER
#define REP_PEER 1
#endif
#ifndef REP_INPROJ
#define REP_INPROJ 1
#endif
#ifndef REP_GATE
#define REP_GATE 1
#endif
#ifndef REP_BRANCH
#define REP_BRANCH 1
#endif
#ifndef REP_Q
#define REP_Q 1
#endif
#ifndef REP_SCORE
#define REP_SCORE 1
#endif
#ifndef REP_1A
#define REP_1A 1
#endif
#ifndef REP_2B
#define REP_2B 1
#endif
#ifndef REP_KF
#define REP_KF 1
#endif
#ifndef DUP_GEMM
#define DUP_GEMM 1
#endif
#ifndef DUP_PEER
#define DUP_PEER 1
#endif
#ifndef DUP_MIX
#define DUP_MIX 1
#endif
#ifndef XRG
#define XRG 1
#endif
#ifndef XFFT
#define XFFT 1
#endif
#ifndef XATT
#define XATT 1
#endif

struct P {
  const float *x, *c, *ctx, *c_ctx, *norm_mix_g, *norm_ffn_g, *w_ada, *b_ada, *w_in, *na_rpb,
      *hy_short_w, *hy_short_b, *hy_f1_w, *hy_f1_b, *hy_f2_w, *hy_f2_b, *hy_f3_w, *hy_freq, *hy_bias,
      *rg_conv_w, *rg_conv_b, *rg_wa, *rg_ba, *rg_wx, *rg_bx, *rg_lambda,
      *w_gate, *b_gate, *w_br_a, *w_br_b, *w_br_c, *w_out, *peer_wq, *peer_keys, *peer_u, *peer_v, *final_g;
  float* out;
  unsigned* counters;
  u16 *WinT, *WgT, *WaT, *WbT, *WcT, *WoT, *WqT, *keysB, *rgW;
  float *modpart, *mod, *hT, *hc;
  float* Kf;
  u16 *xn, *qk, *vT, *vTc, *hyT, *hyTc, *rg, *ycat, *mbuf, *ybT;
  unsigned char *Ub, *Vb, *g8;
  u16* q;
  float *agg, *ctxs;
  unsigned* topk;
};

__device__ __forceinline__ u16 f2bf(float f) {
  unsigned u = __float_as_uint(f);
  u += 0x7fffu + ((u >> 16) & 1u);
  return (u16)(u >> 16);
}
__device__ __forceinline__ float bf2f(u16 h) { return __uint_as_float(((unsigned)h) << 16); }
__device__ __forceinline__ unsigned pk2(float a, float b) { return (unsigned)f2bf(a) | ((unsigned)f2bf(b) << 16); }
__device__ __forceinline__ float bflo(unsigned u) { return __uint_as_float(u << 16); }
__device__ __forceinline__ float bfhi(unsigned u) { return __uint_as_float(u & 0xffff0000u); }
__device__ __forceinline__ int opaque_tid() {
  int t = threadIdx.x;
  asm volatile("" : "+v"(t));
  return t;
}
__device__ __forceinline__ int my_lane() { return opaque_tid() & 63; }
__device__ __forceinline__ float shx(float v, int o) { return __builtin_bit_cast(float, __builtin_amdgcn_ds_bpermute(((my_lane() ^ o) << 2), __builtin_bit_cast(int, v))); }
__device__ __forceinline__ float shf(float v, int src) { return __builtin_bit_cast(float, __builtin_amdgcn_ds_bpermute((src & 63) << 2, __builtin_bit_cast(int, v))); }
__device__ __forceinline__ unsigned shu(unsigned v, int src) { return (unsigned)__builtin_amdgcn_ds_bpermute((src & 63) << 2, (int)v); }
__device__ __forceinline__ float wave_sum(float v) {
  const int lane = my_lane();
#pragma unroll
  for (int o = 32; o > 0; o >>= 1) v += __builtin_bit_cast(float, __builtin_amdgcn_ds_bpermute((lane ^ o) << 2, __builtin_bit_cast(int, v)));
  return v;
}
__device__ __forceinline__ float wave_max(float v) {
  const int lane = my_lane();
#pragma unroll
  for (int o = 32; o > 0; o >>= 1) v = fmaxf(v, __builtin_bit_cast(float, __builtin_amdgcn_ds_bpermute((lane ^ o) << 2, __builtin_bit_cast(int, v))));
  return v;
}
__device__ __forceinline__ float sigmoidf_(float x) { return __builtin_amdgcn_rcpf(1.0f + __expf(-x)); }
__device__ __forceinline__ float gelu_tanh(float x) {
  const float u2 = 1.5957691216057308f * (x + 0.044715f * x * x * x);
  return x * __builtin_amdgcn_rcpf(1.0f + __expf(-u2));
}
__device__ __forceinline__ f32x16 mfma32(bf16x8 a, bf16x8 b, f32x16 c) {
  return __builtin_amdgcn_mfma_f32_32x32x16_bf16(a, b, c, 0, 0, 0);
}
__device__ __forceinline__ f32x16 zero16() {
  f32x16 z;
#pragma unroll
  for (int i = 0; i < 16; ++i) z[i] = 0.f;
  return z;
}
__device__ __forceinline__ int swz128(int row, int ch) { return row * 128 + ((ch ^ ((row >> 1) & 7)) << 4); }
__device__ __forceinline__ int swz256(int row, int ch) { return row * 256 + ((ch ^ (row & 15)) << 4); }

struct c2 { float x, y; };
__device__ __forceinline__ c2 cadd(c2 a, c2 b) { return {a.x + b.x, a.y + b.y}; }
__device__ __forceinline__ c2 csub(c2 a, c2 b) { return {a.x - b.x, a.y - b.y}; }
__device__ __forceinline__ c2 cmul(c2 a, c2 b) { return {a.x * b.x - a.y * b.y, a.x * b.y + a.y * b.x}; }
__device__ __forceinline__ float c16(int i) {
  const float tb[16] = {1.0f, 0.9238795325112867f, 0.7071067811865476f, 0.3826834323650898f, 0.0f,
                        -0.3826834323650898f, -0.7071067811865476f, -0.9238795325112867f, -1.0f,
                        -0.9238795325112867f, -0.7071067811865476f, -0.3826834323650898f, 0.0f,
                        0.3826834323650898f, 0.7071067811865476f, 0.9238795325112867f};
  return tb[i & 15];
}
__device__ __forceinline__ float s16(int i) { return c16(i + 12); }
template <int R> __device__ __forceinline__ constexpr int brev(int k) {
  int r = 0;
  for (int b = 1, o = R >> 1; b < R; b <<= 1, o >>= 1)
    if (k & b) r |= o;
  return r;
}
template <int R> __device__ __forceinline__ void dft_reg(c2* v, float sgn) {
#pragma unroll
  for (int h = R / 2; h >= 1; h >>= 1) {
#pragma unroll
    for (int g = 0; g < R; g += 2 * h) {
#pragma unroll
      for (int j = 0; j < h; ++j) {
        c2 a = v[g + j], b = v[g + j + h];
        v[g + j] = cadd(a, b);
        c2 d = csub(a, b);
        const int ti = j * (16 / (2 * h));
        c2 w = {c16(ti), sgn * s16(ti)};
        v[g + j + h] = (j == 0) ? d : cmul(d, w);
      }
    }
  }
}
template <int R> __device__ __forceinline__ int fft_bfly(c2* v, int j, int Ns, float sgn) {
  const int k = j & (Ns - 1);
  const float f = sgn * (float)k / (float)(Ns * R);
#pragma unroll
  for (int r = 1; r < R; ++r) {
    float t = f * (float)r;
    c2 w = {__builtin_amdgcn_cosf(t), __builtin_amdgcn_sinf(t)};
    v[r] = cmul(v[r], w);
  }
  dft_reg<R>(v, sgn);
  return (j - k) * R + k;
}
template <int R> __device__ __forceinline__ void fft_pass(c2* buf, int Ns, float sgn) {
  constexpr int NBF = 8192 / R;
  constexpr int PER = NBF / NTHR;
  const int tid = opaque_tid();
  c2 v[PER][R];
#pragma unroll
  for (int i = 0; i < PER; ++i) {
    const int j = tid + NTHR * i;
#pragma unroll
    for (int r = 0; r < R; ++r) v[i][r] = buf[j + r * NBF];
  }
  __syncthreads();
#pragma unroll
  for (int i = 0; i < PER; ++i) {
    const int j = tid + NTHR * i;
    const int base = fft_bfly<R>(v[i], j, Ns, sgn);
#pragma unroll
    for (int r = 0; r < R; ++r) buf[base + r * Ns] = v[i][brev<R>(r)];
  }
  __syncthreads();
}
__device__ __forceinline__ void fft8192(c2* buf, float sgn) {
  fft_pass<8>(buf, 1, sgn);
  fft_pass<8>(buf, 8, sgn);
  fft_pass<8>(buf, 64, sgn);
  fft_pass<16>(buf, 512, sgn);
}

__device__ __forceinline__ void gemm_kloop(f32x16 (&acc)[2][2], const u16* __restrict__ A, int lda,
                                           const u16* __restrict__ B, int ldb, int K, char* smem) {
  const int tid = opaque_tid(), lane = tid & 63, wid = tid >> 6;
  const int wm = wid >> 1, wn = wid & 1;
  const int l31 = lane & 31, hh = lane >> 5;
  uint4 ra[4], rb[2];
  const int nk = K >> 6;
  const int srow = tid >> 3, sch = tid & 7;
  const char* Ab = (const char*)A;
  const char* Bb = (const char*)B;
  const unsigned aoff = (unsigned)(srow * lda + sch * 8) * 2u;
  const unsigned boff = (unsigned)(srow * ldb + sch * 8) * 2u;
  const unsigned astep = (unsigned)lda * 128u, bstep = (unsigned)ldb * 128u;
#pragma unroll
  for (int i = 0; i < 4; ++i) ra[i] = *(const uint4*)(Ab + (aoff + i * astep));
#pragma unroll
  for (int i = 0; i < 2; ++i) rb[i] = *(const uint4*)(Bb + (boff + i * bstep));
#pragma unroll
  for (int i = 0; i < 4; ++i) *(uint4*)(smem + swz128(srow + i * 64, sch)) = ra[i];
#pragma unroll
  for (int i = 0; i < 2; ++i) *(uint4*)(smem + 65536 + swz128(srow + i * 64, sch)) = rb[i];
  __syncthreads();
  for (int kt = 0; kt < nk; ++kt) {
    const bool more = (kt + 1 < nk);
    if (more) {
      const unsigned ko = (unsigned)(kt + 1) * 128u;
#pragma unroll
      for (int i = 0; i < 4; ++i) ra[i] = *(const uint4*)(Ab + (aoff + i * astep + ko));
#pragma unroll
      for (int i = 0; i < 2; ++i) rb[i] = *(const uint4*)(Bb + (boff + i * bstep + ko));
    }
    const char* as = smem + (kt & 1) * 32768;
    const char* bs = smem + 65536 + (kt & 1) * 16384;
    int lrow = l31;
    asm volatile("" : "+v"(lrow));
#pragma unroll
    for (int s = 0; s < 4; ++s) {
      bf16x8 af[2], bfr[2];
#pragma unroll
      for (int i = 0; i < 2; ++i) af[i] = *(const bf16x8*)(as + swz128(wm * 64 + i * 32 + lrow, s * 2 + hh));
#pragma unroll
      for (int j = 0; j < 2; ++j) bfr[j] = *(const bf16x8*)(bs + swz128(wn * 64 + j * 32 + lrow, s * 2 + hh));
#pragma unroll
      for (int i = 0; i < 2; ++i)
#pragma unroll
        for (int j = 0; j < 2; ++j) acc[i][j] = mfma32(af[i], bfr[j], acc[i][j]);
    }
    if (more) {
      char* an = smem + ((kt + 1) & 1) * 32768;
      char* bn = smem + 65536 + ((kt + 1) & 1) * 16384;
      int sr2 = srow;
      asm volatile("" : "+v"(sr2));
#pragma unroll
      for (int i = 0; i < 4; ++i) *(uint4*)(an + swz128(sr2 + i * 64, sch)) = ra[i];
#pragma unroll
      for (int i = 0; i < 2; ++i) *(uint4*)(bn + swz128(sr2 + i * 64, sch)) = rb[i];
    }
    __syncthreads();
  }
}
__device__ __forceinline__ void zero_acc(f32x16 (&acc)[2][2]) {
#pragma unroll
  for (int i = 0; i < 2; ++i)
#pragma unroll
    for (int j = 0; j < 2; ++j) acc[i][j] = zero16();
}
#define EPI_ROW(i, e) (wm * 64 + (i)*32 + ((e)&3) + 8 * ((e) >> 2) + 4 * hh)
#define EPI_COL(j) (wn * 64 + (j)*32 + l31)
#define EPI_VARS                                                    \
  const int tid = opaque_tid(), lane = tid & 63, wid = tid >> 6;     \
  const int wm = wid >> 1, wn = wid & 1, l31 = lane & 31, hh = lane >> 5; \
  (void)tid; (void)wm; (void)wn; (void)l31; (void)hh;


namespace pg8 {
#define PG8_LAS __attribute__((address_space(3)))
typedef PG8_LAS unsigned char* PG8_LAS_T;
typedef float f32x4 __attribute__((ext_vector_type(4)));
typedef unsigned u32x4 __attribute__((ext_vector_type(4)));
constexpr int BM = 256, BK = 64, HALF = 128, HTB = HALF * BK * 2, STAGE_BYTES = 8 * HTB, NXCD = 8, WGM = 8;
__device__ __forceinline__ int lds_byte(int r, int c) { const int st = (r >> 4) * 2 + (c >> 5), rr = r & 15, cc = c & 31, ob = rr * 64 + cc * 2; return st * 1024 + (ob ^ (((ob >> 9) & 1) << 5)); }
__device__ __forceinline__ void stage_rc(int b, int& R, int& C) { const int st = b / 1024, sb = b % 1024, swz = sb ^ (((sb >> 9) & 1) << 5); R = (st >> 1) * 16 + swz / 64; C = (st & 1) * 32 + (swz % 64) / 2; }
__device__ __forceinline__ int perm32(int rho) { const int n = rho >> 4, i = rho & 15; return 8 * (i >> 2) + 4 * n + (i & 3); }
struct Unit { int pm, pn; };
struct Gemm { const u16* A; const u16* Bt; int lda, ldb, K; };
struct Order {
  int nM, nN, nwg, G, c, skip_from, skip_by;
  __device__ __forceinline__ void init(int nM_, int nN_, int G_, int c_, int sf = 1 << 30, int sb = 0) { nM = nM_; nN = nN_; nwg = nM * nN; G = G_; c = c_; skip_from = sf; skip_by = sb; }
  __device__ __forceinline__ bool next(int i, Unit& u) const {
    const long L = (long)i * G + c; if (L >= nwg) return false;
    int wgid = (int)L; { const int q = nwg / NXCD, r = nwg % NXCD, xcd = wgid % NXCD, off = wgid / NXCD; wgid = (xcd < r ? xcd * (q + 1) : r * (q + 1) + (xcd - r) * q) + off; }
    const int nig = WGM * nN, gid = wgid / nig, fm = gid * WGM, gsz = (nM - fm) < WGM ? (nM - fm) : WGM;
    u.pm = fm + ((wgid % nig) % gsz); u.pn = (wgid % nig) / gsz;
    if (u.pn >= skip_from) u.pn += skip_by;
    return true;
  }
};
template <class Epi>
__device__ __forceinline__ void gemm_phase(PG8_LAS unsigned char* lds, const Gemm g, const Order& S, const Epi& E) {
  const int tid = opaque_tid(), wid = __builtin_amdgcn_readfirstlane(tid >> 6), lane = tid & 63, wr = wid >> 2, wc = wid & 3, fr = lane & 15, fq = lane >> 4;
  const int K = g.K, nt = K / BK;
  unsigned voffA[2], voffB[2];
#pragma unroll
  for (int i = 0; i < 2; ++i) { int R, C; stage_rc(tid * 16 + i * 8192, R, C); const int Rb = Epi::PERM ? ((R & ~31) + perm32(R & 31)) : R;
    voffA[i] = (unsigned)(R * g.lda + C) * 2u; voffB[i] = (unsigned)(Rb * g.ldb + C) * 2u; }
  const size_t kstep = (size_t)(BK * 2);
  const size_t hstepA = (size_t)HALF * g.lda * 2, hstepB = (size_t)HALF * g.ldb * 2;
  const size_t tstepA = 2 * hstepA, tstepB = 2 * hstepB;
  const unsigned ldsw = (unsigned)wid * 1024u;
  const int aoff = lds_byte(wr * 64 + fr, fq * 8), boff = lds_byte(wc * 32 + fr, fq * 8);
#define PG8_SA(b, h) (((b) * 2 + (h)) * HTB)
#define PG8_SB(b, h) ((4 + (b) * 2 + (h)) * HTB)
#define PG8_STAGE(bufoff, gbase, voff) do { _Pragma("unroll") for (int _i = 0; _i < 2; ++_i) \
    __builtin_amdgcn_global_load_lds((const unsigned*)((const char*)(gbase) + (voff)[_i]), (PG8_LAS unsigned*)(lds + (bufoff) + ldsw + _i * 8192), 16, 0, 0); } while (0)
#define PG8_LDA(dst, b, h) do { _Pragma("unroll") for (int m = 0; m < 4; ++m) _Pragma("unroll") for (int k = 0; k < 2; ++k) dst[m][k] = *(const PG8_LAS bf16x8*)(lds + PG8_SA(b, h) + aoff + m * 2048 + k * 1024); } while (0)
#define PG8_LDB(dst, b, h) do { _Pragma("unroll") for (int n = 0; n < 2; ++n) _Pragma("unroll") for (int k = 0; k < 2; ++k) dst[n][k] = *(const PG8_LAS bf16x8*)(lds + PG8_SB(b, h) + boff + n * 2048 + k * 1024); } while (0)
#define PG8_MMA(ai, bj, At, Bt) do { __builtin_amdgcn_s_setprio(1); _Pragma("unroll") for (int m = 0; m < 4; ++m) _Pragma("unroll") for (int n = 0; n < 2; ++n) _Pragma("unroll") for (int k = 0; k < 2; ++k) \
    acc[ai][bj][m][n] = __builtin_amdgcn_mfma_f32_16x16x32_bf16(Bt[n][k], At[m][k], acc[ai][bj][m][n], 0, 0, 0); __builtin_amdgcn_s_setprio(0); } while (0)
#define PG8_WAIT_V(n) asm volatile("s_waitcnt vmcnt(" #n ")" ::: "memory")
#define PG8_WAIT_L(n) asm volatile("s_waitcnt lgkmcnt(" #n ")" ::: "memory")
#define PG8_BAR __builtin_amdgcn_s_barrier()
#define PG8_SCHED __builtin_amdgcn_sched_barrier(0)
  Unit cur, nxt; int ui = 0;
  if (!S.next(0, cur)) return;
  f32x4 acc[2][2][4][2];
#pragma unroll
  for (int a = 0; a < 2; ++a)
#pragma unroll
    for (int b = 0; b < 2; ++b)
#pragma unroll
      for (int m = 0; m < 4; ++m)
#pragma unroll
        for (int n = 0; n < 2; ++n) acc[a][b][m][n] = (f32x4){0.f, 0.f, 0.f, 0.f};
  bf16x8 At[4][2], B0[2][2], B1[2][2];
  const char* cA = (const char*)g.A + (size_t)cur.pm * tstepA; const char* cB = (const char*)g.Bt + (size_t)cur.pn * tstepB;
  PG8_STAGE(PG8_SB(0, 0), cB, voffB); PG8_STAGE(PG8_SA(0, 0), cA, voffA); PG8_STAGE(PG8_SB(0, 1), cB + hstepB, voffB); PG8_STAGE(PG8_SA(0, 1), cA + hstepA, voffA);
  if (wr == 1) PG8_BAR;
  PG8_WAIT_V(4); PG8_BAR;
  PG8_STAGE(PG8_SB(1, 0), cB + kstep, voffB); PG8_STAGE(PG8_SA(1, 0), cA + kstep, voffA); PG8_STAGE(PG8_SB(1, 1), cB + hstepB + kstep, voffB);
  PG8_WAIT_V(6); PG8_BAR;
  for (;;) {
    const bool has_next = S.next(ui + 1, nxt);
    const char* nA = has_next ? (const char*)g.A + (size_t)nxt.pm * tstepA : cA; const char* nB = has_next ? (const char*)g.Bt + (size_t)nxt.pn * tstepB : cB;
    for (int t = 0; t < nt; t += 2) {
      const bool last = (t == nt - 2);
      const char* a1 = cA + (size_t)(t + 1) * kstep;
      const char* a2 = last ? nA : cA + (size_t)(t + 2) * kstep; const char* b2 = last ? nB : cB + (size_t)(t + 2) * kstep;
      const char* a3 = a2 + kstep; const char* b3 = b2 + kstep;
      PG8_LDB(B0, 0, 0); PG8_SCHED; PG8_LDA(At, 0, 0); PG8_STAGE(PG8_SA(1, 1), a1 + hstepA, voffA);
      PG8_WAIT_L(8); PG8_BAR; PG8_WAIT_L(0); PG8_MMA(0, 0, At, B0); PG8_BAR; PG8_SCHED;
      PG8_LDB(B1, 0, 1); PG8_STAGE(PG8_SB(0, 0), b2, voffB);
      PG8_BAR; PG8_WAIT_L(0); PG8_MMA(0, 1, At, B1); PG8_BAR;
      PG8_LDA(At, 0, 1); PG8_STAGE(PG8_SA(0, 0), a2, voffA);
      PG8_BAR; PG8_WAIT_L(0); PG8_MMA(1, 0, At, B0); PG8_BAR; PG8_SCHED;
      PG8_STAGE(PG8_SB(0, 1), b2 + hstepB, voffB);
      PG8_WAIT_V(6); PG8_BAR; PG8_MMA(1, 1, At, B1); PG8_BAR;
      PG8_LDB(B0, 1, 0); PG8_SCHED; PG8_LDA(At, 1, 0); PG8_STAGE(PG8_SA(0, 1), a2 + hstepA, voffA);
      PG8_WAIT_L(8); PG8_BAR; PG8_WAIT_L(0); PG8_MMA(0, 0, At, B0); PG8_BAR; PG8_SCHED;
      PG8_LDB(B1, 1, 1); PG8_STAGE(PG8_SB(1, 0), b3, voffB);
      PG8_BAR; PG8_WAIT_L(0); PG8_MMA(0, 1, At, B1); PG8_BAR;
      PG8_LDA(At, 1, 1); PG8_STAGE(PG8_SA(1, 0), a3, voffA);
      PG8_BAR; PG8_WAIT_L(0); PG8_MMA(1, 0, At, B0); PG8_BAR; PG8_SCHED;
      PG8_STAGE(PG8_SB(1, 1), b3 + hstepB, voffB);
      PG8_WAIT_V(6); PG8_BAR; PG8_MMA(1, 1, At, B1); PG8_BAR;
    }
    E(acc, cur, wr, wc, fr, fq);
    if (!has_next) break;
#pragma unroll
    for (int a = 0; a < 2; ++a)
#pragma unroll
      for (int b = 0; b < 2; ++b)
#pragma unroll
        for (int m = 0; m < 4; ++m)
#pragma unroll
          for (int n = 0; n < 2; ++n) acc[a][b][m][n] = (f32x4){0.f, 0.f, 0.f, 0.f};
    cur = nxt; cA = nA; cB = nB; ++ui;
  }
  PG8_WAIT_V(0);
  if (wr == 0) PG8_BAR;
  PG8_BAR;
#undef PG8_SA
#undef PG8_SB
#undef PG8_STAGE
#undef PG8_LDA
#undef PG8_LDB
#undef PG8_MMA
#undef PG8_WAIT_V
#undef PG8_WAIT_L
#undef PG8_BAR
#undef PG8_SCHED
}
typedef const f32x4 (&AccRef)[2][2][4][2];
struct EpiInprojN {
  static constexpr bool PERM = true;
  u16* qk; u16* rg;
  __device__ __forceinline__ void operator()(AccRef acc, const Unit& u, int wr, int wc, int fr, int fq) const {
    const int row0 = u.pm * BM + wr * 64 + fr;
    u16* base; int ld, colt;
    if (u.pn < 4) { base = qk; ld = 1024; colt = u.pn * 256; } else { base = rg; ld = 512; colt = (u.pn - 9) * 256; }
    const int col0 = colt + wc * 32 + 8 * fq;
#pragma unroll
    for (int ai = 0; ai < 2; ++ai)
#pragma unroll
      for (int m = 0; m < 4; ++m) {
        u16* rowp = base + (size_t)(row0 + ai * HALF + m * 16) * ld + col0;
#pragma unroll
        for (int bj = 0; bj < 2; ++bj) {
          const f32x4 v0 = acc[ai][bj][m][0], v1 = acc[ai][bj][m][1];
          u32x4 w; w.x = pk2(v0[0], v0[1]); w.y = pk2(v0[2], v0[3]); w.z = pk2(v1[0], v1[1]); w.w = pk2(v1[2], v1[3]);
          *(u32x4*)(rowp + bj * HALF) = w;
        }
      }
  }
};
struct EpiInprojT {
  static constexpr bool PERM = true;
  u16 *vT, *vTc, *hyT, *hyTc;
  __device__ __forceinline__ void operator()(AccRef acc, const Unit& u, int wr, int wc, int fr, int fq) const {
    const bool isctx = (u.pn >= 128);
    const int b = isctx ? (u.pn - 128) : (u.pn >> 4);
    const int Lseg = isctx ? 256 : 4096, t0 = isctx ? 0 : (u.pn & 15) * 256;
    const bool isv = (u.pm < 2);
    const size_t boff = isv ? (isctx ? (size_t)16777216 : (size_t)0) : (isctx ? (size_t)(16777216 + 1048576 + 25165824) : (size_t)(16777216 + 1048576));
    u16* base = vT + boff;
    const int nc = isv ? 512 : 768;
    const int wrow0 = (isv ? u.pm : u.pm - 2) * BM + wr * 64 + fr;
    const int col0 = t0 + wc * 32 + 8 * fq;
#pragma unroll
    for (int ai = 0; ai < 2; ++ai)
#pragma unroll
      for (int m = 0; m < 4; ++m) {
        u16* rowp = base + ((size_t)(b * nc + wrow0 + ai * HALF + m * 16)) * Lseg + col0;
#pragma unroll
        for (int bj = 0; bj < 2; ++bj) {
          const f32x4 v0 = acc[ai][bj][m][0], v1 = acc[ai][bj][m][1];
          u32x4 w; w.x = pk2(v0[0], v0[1]); w.y = pk2(v0[2], v0[3]); w.z = pk2(v1[0], v1[1]); w.w = pk2(v1[2], v1[3]);
          *(u32x4*)(rowp + bj * HALF) = w;
        }
      }
  }
};
struct EpiGate {
  static constexpr bool PERM = true;
  unsigned char* g8; const float* bias;
  __device__ __forceinline__ void operator()(AccRef acc, const Unit& u, int wr, int wc, int fr, int fq) const {
    const int row0 = u.pm * BM + wr * 64 + fr;
    const int col0 = u.pn * BM + wc * 32 + 8 * fq;
#pragma unroll
    for (int bj = 0; bj < 2; ++bj) {
      const f32x4 b0 = *(const f32x4*)(bias + col0 + bj * HALF), b1 = *(const f32x4*)(bias + col0 + bj * HALF + 4);
#pragma unroll
      for (int ai = 0; ai < 2; ++ai)
#pragma unroll
        for (int m = 0; m < 4; ++m) {
          const f32x4 v0 = acc[ai][bj][m][0] + b0, v1 = acc[ai][bj][m][1] + b1;
          unsigned w0 = 0, w1 = 0;
#pragma unroll
          for (int k = 0; k < 4; ++k) {
            w0 |= (unsigned)(sigmoidf_(v0[k]) * 255.0f + 0.5f) << (8 * k);
            w1 |= (unsigned)(sigmoidf_(v1[k]) * 255.0f + 0.5f) << (8 * k);
          }
          *(uint2*)(g8 + (size_t)(row0 + ai * HALF + m * 16) * 3072 + col0 + bj * HALF) = make_uint2(w0, w1);
        }
    }
  }
};
struct EpiBranch {
  static constexpr bool PERM = true;
  u16* mbuf; const unsigned char* g8; int br;
  __device__ __forceinline__ void operator()(AccRef acc, const Unit& u, int wr, int wc, int fr, int fq) const {
    const int row0 = u.pm * BM + wr * 64 + fr;
    const int col0 = u.pn * BM + wc * 32 + 8 * fq;
#pragma unroll
    for (int ai = 0; ai < 2; ++ai)
#pragma unroll
      for (int m = 0; m < 4; ++m) {
        const size_t row = (size_t)(row0 + ai * HALF + m * 16);
#pragma unroll
        for (int bj = 0; bj < 2; ++bj) {
          const uint2 gq = *(const uint2*)(g8 + row * 3072 + br * 1024 + col0 + bj * HALF);
          u16* mp = mbuf + row * 1024 + col0 + bj * HALF;
          const f32x4 v0 = acc[ai][bj][m][0], v1 = acc[ai][bj][m][1];
          float r[8];
          r[0] = (float)(gq.x & 255u) * v0[0]; r[1] = (float)((gq.x >> 8) & 255u) * v0[1];
          r[2] = (float)((gq.x >> 16) & 255u) * v0[2]; r[3] = (float)(gq.x >> 24) * v0[3];
          r[4] = (float)(gq.y & 255u) * v1[0]; r[5] = (float)((gq.y >> 8) & 255u) * v1[1];
          r[6] = (float)((gq.y >> 16) & 255u) * v1[2]; r[7] = (float)(gq.y >> 24) * v1[3];
          u32x4 w;
          if (br == 0) {
            w.x = pk2(r[0] * (1.f / 255.f), r[1] * (1.f / 255.f)); w.y = pk2(r[2] * (1.f / 255.f), r[3] * (1.f / 255.f));
            w.z = pk2(r[4] * (1.f / 255.f), r[5] * (1.f / 255.f)); w.w = pk2(r[6] * (1.f / 255.f), r[7] * (1.f / 255.f));
          } else {
            const u32x4 o = *(const u32x4*)mp;
            w.x = pk2(bflo(o.x) + r[0] * (1.f / 255.f), bfhi(o.x) + r[1] * (1.f / 255.f));
            w.y = pk2(bflo(o.y) + r[2] * (1.f / 255.f), bfhi(o.y) + r[3] * (1.f / 255.f));
            w.z = pk2(bflo(o.z) + r[4] * (1.f / 255.f), bfhi(o.z) + r[5] * (1.f / 255.f));
            w.w = pk2(bflo(o.w) + r[6] * (1.f / 255.f), bfhi(o.w) + r[7] * (1.f / 255.f));
          }
          *(u32x4*)mp = w;
        }
      }
  }
};
struct EpiOut {
  static constexpr bool PERM = false;
  const float *xsrc, *csrc; float *xdst, *cdst; const float* modl;
  __device__ __forceinline__ void operator()(AccRef acc, const Unit& u, int wr, int wc, int fr, int fq) const {
    const bool isctx = (u.pm >= 128);
    const int bi = isctx ? 8 : (u.pm >> 4);
    const float* gatev = modl + ((size_t)bi * 6 + 2) * 1024;
    const float* src = isctx ? (csrc - (size_t)NLAT * 1024) : xsrc;
    float* dst = isctx ? (cdst - (size_t)NLAT * 1024) : xdst;
    const int row0 = u.pm * BM + wr * 64 + fr, col0 = u.pn * BM + wc * 32 + 4 * fq;
#pragma unroll
    for (int bj = 0; bj < 2; ++bj)
#pragma unroll
      for (int n = 0; n < 2; ++n) {
        const int col = col0 + bj * HALF + n * 16;
        const f32x4 gv = *(const f32x4*)(gatev + col);
#pragma unroll
        for (int ai = 0; ai < 2; ++ai)
#pragma unroll
          for (int m = 0; m < 4; ++m) {
            const size_t o = (size_t)(row0 + ai * HALF + m * 16) * 1024 + col;
            const f32x4 xv = *(const f32x4*)(src + o);
            *(f32x4*)(dst + o) = xv + gv * acc[ai][bj][m][n];
          }
      }
  }
};
struct EpiQ {
  static constexpr bool PERM = true;
  u16* q;
  __device__ __forceinline__ void operator()(AccRef acc, const Unit& u, int wr, int wc, int fr, int fq) const {
    const int row0 = u.pm * BM + wr * 64 + fr;
    const int col0 = u.pn * BM + wc * 32 + 8 * fq;
#pragma unroll
    for (int ai = 0; ai < 2; ++ai)
#pragma unroll
      for (int m = 0; m < 4; ++m) {
        u16* rowp = q + (size_t)(row0 + ai * HALF + m * 16) * 2048 + col0;
#pragma unroll
        for (int bj = 0; bj < 2; ++bj) {
          const f32x4 v0 = acc[ai][bj][m][0], v1 = acc[ai][bj][m][1];
          u32x4 w; w.x = pk2(v0[0], v0[1]); w.y = pk2(v0[2], v0[3]); w.z = pk2(v1[0], v1[1]); w.w = pk2(v1[2], v1[3]);
          *(u32x4*)(rowp + bj * HALF) = w;
        }
      }
  }
};
}

__device__ __forceinline__ void tr_tile(const float* __restrict__ src, int N, int K, u16* __restrict__ dst, int tile, char* smem) {
  float* lds = (float*)smem;
  const int tiles_n = N >> 6;
  const int tk = tile / tiles_n, tn = tile - tk * tiles_n;
  const int tid = opaque_tid();
  {
    const int r = tid >> 3, c8 = (tid & 7) * 8;
    const float* s = src + (size_t)(tk * 64 + r) * N + tn * 64 + c8;
    float4 a = *(const float4*)s, b = *(const float4*)(s + 4);
    float* d = lds + r * 65 + c8;
    d[0] = a.x; d[1] = a.y; d[2] = a.z; d[3] = a.w; d[4] = b.x; d[5] = b.y; d[6] = b.z; d[7] = b.w;
  }
  __syncthreads();
  {
    const int n = tid >> 3, k0 = (tid & 7) * 8;
    uint4 o;
    o.x = pk2(lds[(k0 + 0) * 65 + n], lds[(k0 + 1) * 65 + n]);
    o.y = pk2(lds[(k0 + 2) * 65 + n], lds[(k0 + 3) * 65 + n]);
    o.z = pk2(lds[(k0 + 4) * 65 + n], lds[(k0 + 5) * 65 + n]);
    o.w = pk2(lds[(k0 + 6) * 65 + n], lds[(k0 + 7) * 65 + n]);
    *(uint4*)(dst + (size_t)(tn * 64 + n) * K + tk * 64 + k0) = o;
  }
  __syncthreads();
}
__device__ __forceinline__ void cvt_chunk(const float* __restrict__ src, u16* __restrict__ dst, size_t chunk) {
  const size_t i = chunk * 4096 + (size_t)opaque_tid() * 8;
  float4 a = *(const float4*)(src + i), b = *(const float4*)(src + i + 4);
  uint4 o;
  o.x = pk2(a.x, a.y); o.y = pk2(a.z, a.w); o.z = pk2(b.x, b.y); o.w = pk2(b.z, b.w);
  *(uint4*)(dst + i) = o;
}
__device__ __forceinline__ void cvt_chunk_fp8(const float* __restrict__ src, unsigned char* __restrict__ dst, size_t chunk, float scale) {
  const size_t i = chunk * 4096 + (size_t)opaque_tid() * 8;
  const float4 a = *(const float4*)(src + i), b = *(const float4*)(src + i + 4);
  int w0 = __builtin_amdgcn_cvt_pk_fp8_f32(a.x * scale, a.y * scale, 0, false);
  w0 = __builtin_amdgcn_cvt_pk_fp8_f32(a.z * scale, a.w * scale, w0, true);
  int w1 = __builtin_amdgcn_cvt_pk_fp8_f32(b.x * scale, b.y * scale, 0, false);
  w1 = __builtin_amdgcn_cvt_pk_fp8_f32(b.z * scale, b.w * scale, w1, true);
  *(uint2*)(dst + i) = make_uint2((unsigned)w0, (unsigned)w1);
}
__device__ __forceinline__ void cvt_chunk_fp4(const float* __restrict__ src, unsigned char* __restrict__ dst, size_t chunk, float scale) {
  const size_t i = chunk * 4096 + (size_t)opaque_tid() * 8;
  const float4 a = *(const float4*)(src + i), b = *(const float4*)(src + i + 4);
  unsigned w = 0;
  w = __builtin_amdgcn_cvt_scalef32_pk_fp4_f32(w, a.x * scale, a.y * scale, 1.0f, 0);
  w = __builtin_amdgcn_cvt_scalef32_pk_fp4_f32(w, a.z * scale, a.w * scale, 1.0f, 1);
  w = __builtin_amdgcn_cvt_scalef32_pk_fp4_f32(w, b.x * scale, b.y * scale, 1.0f, 2);
  w = __builtin_amdgcn_cvt_scalef32_pk_fp4_f32(w, b.z * scale, b.w * scale, 1.0f, 3);
  *(unsigned*)(dst + (i >> 1)) = w;
}
__device__ __forceinline__ void phase_prep(const P& p, char* smem) {
  const int tid = opaque_tid();
  const int NTR = 2512;
  const int total = 2 * NTR + 128 + 384;
  for (int task = blockIdx.x; task < total; task += gridDim.x) {
    if (task < 2 * NTR) {
      const int l = task / NTR;
      int t = task - l * NTR;
      if (t < 704) tr_tile(p.w_in + (size_t)l * 1024 * 2816, 2816, 1024, p.WinT + (size_t)l * 2816 * 1024, t, smem);
      else if ((t -= 704) < 768) tr_tile(p.w_gate + (size_t)l * 1024 * 3072, 3072, 1024, p.WgT + (size_t)l * 3072 * 1024, t, smem);
      else if ((t -= 768) < 128) tr_tile(p.w_br_a + (size_t)l * 512 * 1024, 1024, 512, p.WaT + (size_t)l * 1024 * 512, t, smem);
      else if ((t -= 128) < 64) tr_tile(p.w_br_b + (size_t)l * 256 * 1024, 1024, 256, p.WbT + (size_t)l * 1024 * 256, t, smem);
      else if ((t -= 64) < 64) tr_tile(p.w_br_c + (size_t)l * 256 * 1024, 1024, 256, p.WcT + (size_t)l * 1024 * 256, t, smem);
      else if ((t -= 64) < 256) tr_tile(p.w_out + (size_t)l * 1024 * 1024, 1024, 1024, p.WoT + (size_t)l * 1024 * 1024, t, smem);
      else if ((t -= 256) < 512) tr_tile(p.peer_wq + (size_t)l * 1024 * 2048, 2048, 1024, p.WqT + (size_t)l * 2048 * 1024, t, smem);
      else {
        t -= 512;
        const int gate = t >> 3, dn = t & 7;
        const float* src = (gate ? p.rg_wx : p.rg_wa) + (size_t)(l * 8 + dn) * 4096;
        tr_tile(src, 64, 64, p.rgW + (size_t)((l * 2 + gate) * 8 + dn) * 4096, 0, smem);
      }
    } else if (task < 2 * NTR + 128) {
      cvt_chunk(p.peer_keys, p.keysB, (size_t)(task - 2 * NTR));
    } else {
      int t = task - 2 * NTR - 128;
      const int kc = t & 15; t >>= 4;
      const int jc = t % 12, l = t / 12;
      float* s = (float*)smem;
      for (int i = tid; i < 576; i += NTHR) {
        const int bi = i >> 6, kk = i & 63;
        const float v = (bi < 8) ? p.c[bi * 1024 + kc * 64 + kk] : p.c_ctx[kc * 64 + kk];
        s[i] = v / (1.0f + __expf(-v));
      }
      __syncthreads();
      const int j = jc * 512 + tid;
      float acc[9];
#pragma unroll
      for (int bi = 0; bi < 9; ++bi) acc[bi] = 0.f;
      const float* wp = p.w_ada + ((size_t)l * 1024 + kc * 64) * 6144 + j;
#pragma unroll 8
      for (int kk = 0; kk < 64; ++kk) {
        const float w = wp[(size_t)kk * 6144];
#pragma unroll
        for (int bi = 0; bi < 9; ++bi) acc[bi] += s[bi * 64 + kk] * w;
      }
#pragma unroll
      for (int bi = 0; bi < 9; ++bi) p.modpart[((size_t)(kc * 2 + l) * 9 + bi) * 6144 + j] = acc[bi];
      __syncthreads();
    }
  }
}
__device__ __forceinline__ void phase_modreduce(const P& p) {
  const int n = 2 * 9 * 6144;
  for (int i = blockIdx.x * NTHR + opaque_tid(); i < n; i += gridDim.x * NTHR) {
    const int l = i / (9 * 6144);
    const int j = i % 6144;
    float s = p.b_ada[l * 6144 + j];
#pragma unroll
    for (int kc = 0; kc < 16; ++kc) s += p.modpart[(size_t)kc * n + i];
    p.mod[i] = s;
  }
}

__device__ __forceinline__ void phase_norm(const P& p, int l, int which) {
  const int tid_ = opaque_tid(); const int lane = tid_ & 63, wid = tid_ >> 6;
  const int ntok = (which == 2 || (which == 1 && l == 1)) ? NLAT : NTOK;
  for (int row = blockIdx.x * 8 + wid; row < ntok; row += gridDim.x * 8) {
    const float* src;
    if (row < NLAT) src = ((which == 0 && l == 0) ? p.x : p.out) + (size_t)row * 1024;
    else src = ((which == 0 && l == 0) ? p.ctx : p.ctxs) + (size_t)(row - NLAT) * 1024;
    float4 v[4];
    float ss = 0.f;
#pragma unroll
    for (int i = 0; i < 4; ++i) {
      v[i] = *(const float4*)(src + i * 256 + lane * 4);
      ss += v[i].x * v[i].x + v[i].y * v[i].y + v[i].z * v[i].z + v[i].w * v[i].w;
    }
    ss = wave_sum(ss);
    const float rstd = rsqrtf(ss * (1.0f / 1024.0f) + 1e-6f);
    if (which == 2) {
#pragma unroll
      for (int i = 0; i < 4; ++i) {
        const int col = i * 256 + lane * 4;
        const float4 g = *(const float4*)(p.final_g + col);
        float4 o = {v[i].x * rstd * g.x, v[i].y * rstd * g.y, v[i].z * rstd * g.z, v[i].w * rstd * g.w};
        *(float4*)(p.out + (size_t)row * 1024 + col) = o;
      }
    } else {
      const int bi = row < NLAT ? (row >> 12) : 8;
      const float* gam = (which == 0 ? p.norm_mix_g : p.norm_ffn_g) + l * 1024;
      const float* msh = p.mod + ((size_t)(l * 9 + bi) * 6 + (which == 0 ? 0 : 3)) * 1024;
      const float* msc = msh + 1024;
#pragma unroll
      for (int i = 0; i < 4; ++i) {
        const int col = i * 256 + lane * 4;
        const float4 g = *(const float4*)(gam + col);
        const float4 sh = *(const float4*)(msh + col);
        const float4 sc = *(const float4*)(msc + col);
        uint2 o;
        o.x = pk2(v[i].x * rstd * g.x * (1.f + sc.x) + sh.x, v[i].y * rstd * g.y * (1.f + sc.y) + sh.y);
        o.y = pk2(v[i].z * rstd * g.z * (1.f + sc.z) + sh.z, v[i].w * rstd * g.w * (1.f + sc.w) + sh.w);
        *(uint2*)(p.xn + (size_t)row * 1024 + col) = o;
      }
    }
  }
}

__device__ __forceinline__ void filter_wave(const P& p, int l, int L, int t, float* __restrict__ outp) {
  const int lane = opaque_tid() & 63;
  const float tl = (float)t / (float)(L - 1);
  const float wang = (6.283185307179586f / (float)L) * (float)t;
  float z = 0.f;
  if (lane == 0) z = tl;
  else if (lane <= 16) { const float band = 1e-4f + (float)(lane - 1) * ((15.0f - 1e-4f) / 15.0f); z = cosf(band * wang); }
  else if (lane <= 32) { const float band = 1e-4f + (float)(lane - 17) * ((15.0f - 1e-4f) / 15.0f); z = -sinf(band * wang); }
  float a1 = p.hy_f1_b[l * 64 + lane];
  for (int i = 0; i < 33; ++i) a1 += shf(z, i) * p.hy_f1_w[(l * 33 + i) * 64 + lane];
  const float h1 = sinf(p.hy_freq[l * 128 + lane] * a1);
  float a2 = p.hy_f2_b[l * 64 + lane];
  for (int i = 0; i < 64; ++i) a2 += shf(h1, i) * p.hy_f2_w[(l * 64 + i) * 64 + lane];
  const float h2 = sinf(p.hy_freq[l * 128 + 64 + lane] * a2);
  float a3[8];
#pragma unroll
  for (int m = 0; m < 8; ++m) a3[m] = 0.f;
  for (int i = 0; i < 64; ++i) {
    const float hv = shf(h2, i);
    const float* wr = p.hy_f3_w + (size_t)(l * 64 + i) * 512 + lane;
#pragma unroll
    for (int m = 0; m < 8; ++m) a3[m] += hv * wr[m * 64];
  }
  const float LN100 = 4.605170185988092f;
  const float d0 = LN100 / 1.5f, d1 = LN100 / 0.3f;
#pragma unroll
  for (int m = 0; m < 8; ++m) {
    const int cp = lane + 64 * m;
    const int ch = cp & 255;
    const float delta = d0 + (float)ch * ((d1 - d0) / 255.0f);
    outp[(size_t)cp * L + t] = a3[m] * expf(-tl * delta);
  }
}
__device__ __forceinline__ void phase_filters(const P& p, int l) {
  const int wid = opaque_tid() >> 6;
  const int ntask = 4096 + (l == 0 ? 256 : 0);
  for (int t = blockIdx.x * 8 + wid; t < ntask; t += gridDim.x * 8) {
    if (t < 4096) filter_wave(p, l, 4096, t, p.hT + (size_t)l * 512 * 4096);
    else filter_wave(p, l, 256, t - 4096, p.hc);
  }
}
__device__ __forceinline__ void kf_task(const P& p, int l, int c, char* smem) {
  const float* hTl = p.hT + (size_t)l * 512 * 4096;
  c2* buf = (c2*)smem;
  const int tid = opaque_tid();
  for (int i = 0; i < 16; ++i) {
    const int j = tid + NTHR * i;
    float v;
    if (j < 4096) v = hTl[(size_t)c * 4096 + j];
    else if (j == 4096) v = 0.f;
    else v = hTl[(size_t)(256 + c) * 4096 + (8192 - j)];
    buf[j] = {v, 0.f};
  }
  __syncthreads();
  fft8192(buf, -1.f);
  c2* o = (c2*)p.Kf + ((size_t)l * 256 + c) * 8192;
  for (int i = 0; i < 16; ++i) { const int j = tid + NTHR * i; o[j] = buf[j]; }
  __syncthreads();
}

__device__ __forceinline__ void inproj_tile(const P& p, int l, int mt, int nt, char* smem) {
  f32x16 acc[2][2];
  zero_acc(acc);
  const int m0 = mt * 256, n0 = nt * 128;
  gemm_kloop(acc, p.xn + (size_t)m0 * 1024, 1024, p.WinT + ((size_t)l * 2816 + n0) * 1024, 1024, 1024, smem);
  EPI_VARS
  if (nt < 8 || nt >= 18) {
    u16* dst; int ld, cbase;
    if (nt < 8) { dst = p.qk; ld = 1024; cbase = n0; }
    else { dst = p.rg; ld = 512; cbase = n0 - 2304; }
#pragma unroll
    for (int i = 0; i < 2; ++i)
#pragma unroll
      for (int j = 0; j < 2; ++j)
#pragma unroll
        for (int e = 0; e < 16; ++e)
          dst[(size_t)(m0 + EPI_ROW(i, e)) * ld + cbase + EPI_COL(j)] = f2bf(acc[i][j][e]);
  } else {
#pragma unroll
    for (int i = 0; i < 2; ++i)
#pragma unroll
      for (int j = 0; j < 2; ++j)
#pragma unroll
        for (int qd = 0; qd < 4; ++qd) {
          uint2 o;
          o.x = pk2(acc[i][j][4 * qd + 0], acc[i][j][4 * qd + 1]);
          o.y = pk2(acc[i][j][4 * qd + 2], acc[i][j][4 * qd + 3]);
          const int row0 = wm * 64 + i * 32 + 8 * qd + 4 * hh;
          *(uint2*)(smem + EPI_COL(j) * 520 + row0 * 2) = o;
        }
    __syncthreads();
    u16* dstT; int Lseg, t0, ncol0, nc;
    const bool isctx = (mt >= 128);
    const int b = isctx ? (mt - 128) : (mt >> 4);
    if (nt < 12) { ncol0 = n0 - 1024; nc = 512; dstT = isctx ? p.vTc : p.vT; }
    else { ncol0 = n0 - 1536; nc = 768; dstT = isctx ? p.hyTc : p.hyT; }
    if (isctx) { Lseg = 256; t0 = 0; } else { Lseg = 4096; t0 = (mt & 15) * 256; }
#pragma unroll 4
    for (int it = 0; it < 16; ++it) {
      const int idx = tid + NTHR * it;
      const int col = idx >> 6, u = idx & 63;
      const uint2 v = *(const uint2*)(smem + col * 520 + u * 8);
      *(uint2*)(dstT + ((size_t)(b * nc + ncol0 + col)) * Lseg + t0 + u * 4) = v;
    }
    __syncthreads();
  }
}

__device__ __forceinline__ float ldbf(const u16* p, int t, int L) { return (t >= 0 && t < L) ? bf2f(p[t]) : 0.f; }
__device__ __forceinline__ void ld10(const u16* __restrict__ seq, int t0, float (&v)[10]) {
  const uint4 r = *(const uint4*)(seq + t0);
  v[0] = (t0 > 0) ? bf2f(seq[t0 - 1]) : 0.f;
  v[9] = (t0 + 8 < 4096) ? bf2f(seq[t0 + 8]) : 0.f;
  v[1] = bflo(r.x); v[2] = bfhi(r.x); v[3] = bflo(r.y); v[4] = bfhi(r.y);
  v[5] = bflo(r.z); v[6] = bfhi(r.z); v[7] = bflo(r.w); v[8] = bfhi(r.w);
}
__device__ __forceinline__ void hyena_fft_task(const P& p, int l, int c, int bp, char* smem) {
  c2* buf = (c2*)smem;
  c2* ub = (c2*)(smem + 65536);
  const int tid = opaque_tid();
  const float* sw = p.hy_short_w + l * 3 * 768;
  const float* sb = p.hy_short_b + l * 768;
  const float wx0[3] = {sw[c], sw[768 + c], sw[1536 + c]};
  const float wx1[3] = {sw[256 + c], sw[768 + 256 + c], sw[1536 + 256 + c]};
  const float wv[3] = {sw[512 + c], sw[768 + 512 + c], sw[1536 + 512 + c]};
  const float bx0 = sb[c], bx1 = sb[256 + c], bv = sb[512 + c];
  const float dsk = p.hy_bias[l * 256 + c];
  const int t0 = tid * 8;
  {
    float u[2][8];
#pragma unroll
    for (int bb = 0; bb < 2; ++bb) {
      const int b = 2 * bp + bb;
      float x1[10], vv[10];
      ld10(p.hyT + ((size_t)(b * 768 + 256 + c)) * 4096, t0, x1);
      ld10(p.hyT + ((size_t)(b * 768 + 512 + c)) * 4096, t0, vv);
#pragma unroll
      for (int k = 0; k < 8; ++k) {
        const float x1c = bx1 + wx1[0] * x1[k] + wx1[1] * x1[k + 1] + wx1[2] * x1[k + 2];
        const float vc = bv + wv[0] * vv[k] + wv[1] * vv[k + 1] + wv[2] * vv[k + 2];
        u[bb][k] = vc * x1c;
      }
    }
#pragma unroll
    for (int k = 0; k < 8; k += 2) {
      const float4 w = make_float4(u[0][k], u[1][k], u[0][k + 1], u[1][k + 1]);
      *(float4*)(buf + t0 + k) = w;
      *(float4*)(ub + t0 + k) = w;
      *(float4*)(buf + 4096 + t0 + k) = make_float4(0.f, 0.f, 0.f, 0.f);
    }
  }
  __syncthreads();
  fft8192(buf, -1.f);
  const c2* kf = (const c2*)p.Kf + ((size_t)l * 256 + c) * 8192;
  for (int i = 0; i < 16; ++i) {
    const int k = tid + NTHR * i;
    buf[k] = cmul(buf[k], kf[k]);
  }
  __syncthreads();
  fft8192(buf, 1.f);
#pragma unroll
  for (int bb = 0; bb < 2; ++bb) {
    const int b = 2 * bp + bb;
    float x0[10];
    ld10(p.hyT + ((size_t)(b * 768 + c)) * 4096, t0, x0);
    float o[8];
#pragma unroll
    for (int k = 0; k < 8; ++k) {
      const c2 y = buf[t0 + k];
      const c2 uu = ub[t0 + k];
      const float x0c = bx0 + wx0[0] * x0[k] + wx0[1] * x0[k + 1] + wx0[2] * x0[k + 2];
      const float yy = ldexpf(bb ? y.y : y.x, -13);
      const float uv = bb ? uu.y : uu.x;
      o[k] = x0c * (yy + uv * dsk);
    }
    uint4 w; w.x = pk2(o[0], o[1]); w.y = pk2(o[2], o[3]); w.z = pk2(o[4], o[5]); w.w = pk2(o[6], o[7]);
    *(uint4*)(p.ybT + ((size_t)(b * 256 + c)) * 4096 + t0) = w;
  }
  __syncthreads();
}
__device__ __forceinline__ void yb_transpose_task(const P& p, int b, int tb, char* smem) {
  const int tid = opaque_tid(), lane = tid & 63, wid = tid >> 6;
  u16* T = (u16*)smem;
#pragma unroll
  for (int it = 0; it < 4; ++it) {
    const int id = tid + NTHR * it;
    const int c = id >> 3, ch = id & 7;
    const uint4 r = *(const uint4*)(p.ybT + ((size_t)(b * 256 + c)) * 4096 + tb * 64 + ch * 8);
    unsigned* d = (unsigned*)(T + c * 66 + ch * 8);
    d[0] = r.x; d[1] = r.y; d[2] = r.z; d[3] = r.w;
  }
  __syncthreads();
#pragma unroll
  for (int it = 0; it < 8; ++it) {
    const int tt = wid + 8 * it;
    const int c0 = lane * 4;
    uint2 w;
    w.x = (unsigned)T[(c0 + 0) * 66 + tt] | ((unsigned)T[(c0 + 1) * 66 + tt] << 16);
    w.y = (unsigned)T[(c0 + 2) * 66 + tt] | ((unsigned)T[(c0 + 3) * 66 + tt] << 16);
    *(uint2*)(p.ycat + (size_t)(b * 4096 + tb * 64 + tt) * 1024 + 512 + c0) = w;
  }
  __syncthreads();
}
__device__ __forceinline__ void hyena_ctx_task(const P& p, int l, int b, int cg8, char* smem) {
  const int tid_ = opaque_tid(); const int lane = tid_ & 63, wid = tid_ >> 6;
  const int c = cg8 * 8 + wid;
  float* us = (float*)smem + wid * 1024;
  float* kfp = us + 256 + 255;
  const float* sw = p.hy_short_w + l * 3 * 768;
  const float* sb = p.hy_short_b + l * 768;
  const u16* x0 = p.hyTc + ((size_t)(b * 768 + c)) * 256;
  const u16* x1 = p.hyTc + ((size_t)(b * 768 + 256 + c)) * 256;
  const u16* vv = p.hyTc + ((size_t)(b * 768 + 512 + c)) * 256;
  for (int i = 0; i < 4; ++i) {
    const int t = lane + 64 * i;
    const float x1c = sb[256 + c] + sw[256 + c] * ldbf(x1, t - 1, 256) + sw[768 + 256 + c] * ldbf(x1, t, 256) + sw[1536 + 256 + c] * ldbf(x1, t + 1, 256);
    const float vc = sb[512 + c] + sw[512 + c] * ldbf(vv, t - 1, 256) + sw[768 + 512 + c] * ldbf(vv, t, 256) + sw[1536 + 512 + c] * ldbf(vv, t + 1, 256);
    us[t] = vc * x1c;
    kfp[t] = p.hc[(size_t)c * 256 + t];
    if (t > 0) kfp[-t] = p.hc[(size_t)(256 + c) * 256 + t];
  }
  __syncthreads();
  const float dsk = p.hy_bias[l * 256 + c];
  float acc[4] = {0.f, 0.f, 0.f, 0.f};
  for (int s = 0; s < 256; ++s) {
    const float uv = us[s];
#pragma unroll
    for (int i = 0; i < 4; ++i) acc[i] += kfp[lane + 64 * i - s] * uv;
  }
#pragma unroll
  for (int i = 0; i < 4; ++i) {
    const int t = lane + 64 * i;
    const float x0c = sb[c] + sw[c] * ldbf(x0, t - 1, 256) + sw[768 + c] * ldbf(x0, t, 256) + sw[1536 + c] * ldbf(x0, t + 1, 256);
    p.ycat[(size_t)(NLAT + b * 256 + t) * 1024 + 512 + c] = f2bf(x0c * (acc[i] + us[t] * dsk));
  }
  __syncthreads();
}

__device__ __forceinline__ void rg_chunk_task(const P& p, int l, int cq, int nblk, int mode, bool last, char* smem) {
  const int tid = opaque_tid(), lane = tid & 63, wid = tid >> 6;
  const int l31 = lane & 31, hh = lane >> 5;
  const int b = cq / 68, rr = cq - b * 68;
  const int seg = rr < 4 ? 0 : 1, sub = rr < 4 ? rr : rr - 4;
  if (mode == 1 && seg == 0 && last) return;
  float* xcf = (float*)smem;
  char* xcb = smem + 16384;
  float* coef = (float*)(smem + 24576);
  float2* segagg = (float2*)(smem + 90112);
  float* hin = (float*)(smem + 94208);
  float* Hout = (float*)(smem + 94720);
  const int Lseg = seg ? 4096 : 256;
  const int tokbase = seg ? b * 4096 : NLAT + b * 256;
  const int T0 = sub * 64;
  const int tt = tid >> 3, c0 = (tid & 7) * 8;
  const int chb = nblk * 64 + c0;
  const int wdir = wid >> 2, wgate = (wid >> 1) & 1, wmt = wid & 1;
  bf16x8 wf[2][4];
  {
    const u16* wp = p.rgW + (size_t)(((l * 2 + wgate) * 2 + wdir) * 4 + nblk) * 4096 + l31 * 64 + 8 * hh;
#pragma unroll
    for (int nt = 0; nt < 2; ++nt)
#pragma unroll
      for (int s = 0; s < 4; ++s) wf[nt][s] = *(const bf16x8*)(wp + nt * 2048 + 16 * s);
  }
  {
    float xc[8];
#pragma unroll
    for (int c = 0; c < 8; ++c) xc[c] = p.rg_conv_b[l * 256 + chb + c];
#pragma unroll
    for (int k = 0; k < 4; ++k) {
      const int pos = T0 + tt + k - 2;
      if (pos >= 0 && pos < Lseg) {
        const uint4 raw = *(const uint4*)(p.rg + (size_t)(tokbase + pos) * 512 + chb);
        const float4 w0 = *(const float4*)(p.rg_conv_w + (l * 4 + k) * 256 + chb);
        const float4 w1 = *(const float4*)(p.rg_conv_w + (l * 4 + k) * 256 + chb + 4);
        xc[0] += w0.x * bflo(raw.x); xc[1] += w0.y * bfhi(raw.x);
        xc[2] += w0.z * bflo(raw.y); xc[3] += w0.w * bfhi(raw.y);
        xc[4] += w1.x * bflo(raw.z); xc[5] += w1.y * bfhi(raw.z);
        xc[6] += w1.z * bflo(raw.w); xc[7] += w1.w * bfhi(raw.w);
      }
    }
    *(float4*)(xcf + tt * 64 + c0) = make_float4(xc[0], xc[1], xc[2], xc[3]);
    *(float4*)(xcf + tt * 64 + c0 + 4) = make_float4(xc[4], xc[5], xc[6], xc[7]);
    uint4 o;
    o.x = pk2(xc[0], xc[1]); o.y = pk2(xc[2], xc[3]); o.z = pk2(xc[4], xc[5]); o.w = pk2(xc[6], xc[7]);
    *(uint4*)(xcb + swz128(tt, tid & 7)) = o;
  }
  __syncthreads();
  {
    f32x16 acc0 = zero16(), acc1 = zero16();
#pragma unroll
    for (int s = 0; s < 4; ++s) {
      const bf16x8 af = *(const bf16x8*)(xcb + swz128(wmt * 32 + l31, 2 * s + hh));
      acc0 = mfma32(af, wf[0][s], acc0);
      acc1 = mfma32(af, wf[1][s], acc1);
    }
    float* cp = coef + (wdir * 2 + wgate) * 4096;
#pragma unroll
    for (int e = 0; e < 16; ++e) {
      const int tok = wmt * 32 + (e & 3) + 8 * (e >> 2) + 4 * hh;
      cp[tok * 64 + l31] = acc0[e];
      cp[tok * 64 + 32 + l31] = acc1[e];
    }
  }
  __syncthreads();
#pragma unroll
  for (int dir = 0; dir < 2; ++dir) {
    float* ca = coef + (dir * 2) * 4096;
    float* cb2 = ca + 4096;
#pragma unroll
    for (int c = 0; c < 8; ++c) {
      const int ch = (l * 2 + dir) * 256 + chb + c;
      const float sp = __logf(1.0f + __expf(-p.rg_lambda[ch]));
      const int o = tt * 64 + c0 + c;
      const float r = sigmoidf_(ca[o] + p.rg_ba[ch]);
      const float ii = sigmoidf_(cb2[o] + p.rg_bx[ch]);
      const float la = -8.0f * r * sp;
      const float av = __expf(la);
      const float e2 = 2.0f * la;
      const float om = (e2 > -0.1f) ? (-e2 * (1.0f + e2 * (0.5f + e2 * (0.16666667f + e2 * 0.041666668f)))) : (1.0f - __expf(e2));
      ca[o] = av;
      cb2[o] = sqrtf(om) * ii * xcf[o];
    }
  }
  __syncthreads();
  const int sg = tid >> 7, sdir = (tid >> 6) & 1, sch = tid & 63;
  const float* sa = coef + (sdir * 2) * 4096 + sch;
  const float* sb = sa + 4096;
  {
    float Pm = 1.f, H = 0.f;
#pragma unroll
    for (int n = 0; n < 16; ++n) {
      const int tok = sdir ? (63 - (16 * sg + n)) : (16 * sg + n);
      const float av = sa[tok * 64], bv = sb[tok * 64];
      H = av * H + bv;
      Pm *= av;
    }
    segagg[(sg * 2 + sdir) * 64 + sch] = make_float2(Pm, H);
  }
  __syncthreads();
  const int pos = sdir ? (seg == 0 ? 3 - sub : 67 - sub) : (seg == 0 ? sub : 4 + sub);
  float2* aggp = (float2*)p.agg + ((size_t)(b * 2 + sdir) * 68) * 256 + nblk * 64 + sch;
  if (mode == 0) {
    if (tid < 128) {
      float A = 1.f, B = 0.f;
#pragma unroll
      for (int s2 = 0; s2 < 4; ++s2) {
        const float2 g = segagg[(s2 * 2 + sdir) * 64 + sch];
        B = g.x * B + g.y;
        A *= g.x;
      }
      aggp[(size_t)pos * 256] = make_float2(A, B);
    }
    __syncthreads();
    return;
  }
  if (tid < 128) {
    float h = 0.f;
    int j = 0;
    for (; j + 8 <= pos; j += 8) {
      float2 g[8];
#pragma unroll
      for (int u = 0; u < 8; ++u) g[u] = aggp[(size_t)(j + u) * 256];
#pragma unroll
      for (int u = 0; u < 8; ++u) h = g[u].x * h + g[u].y;
    }
    for (; j < pos; ++j) {
      const float2 g = aggp[(size_t)j * 256];
      h = g.x * h + g.y;
    }
    hin[sdir * 64 + sch] = h;
  }
  __syncthreads();
  {
    float h = hin[sdir * 64 + sch];
    for (int s2 = 0; s2 < sg; ++s2) {
      const float2 g = segagg[(s2 * 2 + sdir) * 64 + sch];
      h = g.x * h + g.y;
    }
#pragma unroll
    for (int n = 0; n < 16; ++n) {
      const int tok = sdir ? (63 - (16 * sg + n)) : (16 * sg + n);
      h = sa[tok * 64] * h + sb[tok * 64];
      Hout[sdir * 4096 + tok * 64 + sch] = h;
    }
  }
  __syncthreads();
  {
    const size_t gtok = (size_t)tokbase + T0 + tt;
    const float4 f0 = *(const float4*)(Hout + tt * 64 + c0), f1 = *(const float4*)(Hout + tt * 64 + c0 + 4);
    const float4 h0 = *(const float4*)(Hout + 4096 + tt * 64 + c0), h1 = *(const float4*)(Hout + 4096 + tt * 64 + c0 + 4);
    const uint4 g = *(const uint4*)(p.rg + gtok * 512 + 256 + chb);
    uint4 o;
    o.x = pk2((f0.x + h0.x) * gelu_tanh(bflo(g.x)), (f0.y + h0.y) * gelu_tanh(bfhi(g.x)));
    o.y = pk2((f0.z + h0.z) * gelu_tanh(bflo(g.y)), (f0.w + h0.w) * gelu_tanh(bfhi(g.y)));
    o.z = pk2((f1.x + h1.x) * gelu_tanh(bflo(g.z)), (f1.y + h1.y) * gelu_tanh(bfhi(g.z)));
    o.w = pk2((f1.z + h1.z) * gelu_tanh(bflo(g.w)), (f1.w + h1.w) * gelu_tanh(bfhi(g.w)));
    *(uint4*)(p.ycat + gtok * 1024 + 768 + chb) = o;
  }
  __syncthreads();
}

__device__ __forceinline__ void attn_wave(const P& p, int l, int b, int h, bool local, int r, int half, int qtok0, const float* rpbL) {
  const int lane = opaque_tid() & 63, q = lane & 31, hh = lane >> 5;
  bf16x8 qf[4];
  {
    const u16* qp = p.qk + (size_t)(qtok0 + q) * 1024 + h * 64 + 8 * hh;
#pragma unroll
    for (int s = 0; s < 4; ++s) qf[s] = *(const bf16x8*)(qp + 16 * s);
  }
  f32x16 o0 = zero16(), o1 = zero16();
  float m_run = -1e30f, l_run = 0.f;
  const int pi = (q & 19) | ((q & 4) << 1) | ((q & 8) >> 1);
  const int w = half * 32 + q;
  const int st = min(max(w - 8, 0), 48);
  const int rs = min(max(r - 4, 0), 56);
  const int ntiles = local ? 24 : 8;
  bf16x8 kfn[4], vfn[2][2];
  auto tile_load = [&](int ti, bf16x8 (&kfo)[4], bf16x8 (&vfo)[2][2]) {
    int ktok0, vstride;
    const u16* vb;
    if (ti < 8) {
      ktok0 = NLAT + b * 256 + ti * 32;
      vb = p.vTc + ((size_t)(b * 512 + h * 64)) * 256 + ti * 32;
      vstride = 256;
    } else {
      const int tl = ti - 8;
      const int a2 = tl >> 1, g2 = tl & 1;
      ktok0 = b * 4096 + (rs + a2) * 64 + g2 * 32;
      vb = p.vT + ((size_t)(b * 512 + h * 64)) * 4096 + (rs + a2) * 64 + g2 * 32;
      vstride = 4096;
    }
    const u16* kp = p.qk + (size_t)(ktok0 + pi) * 1024 + 512 + h * 64 + 8 * hh;
#pragma unroll
    for (int s = 0; s < 4; ++s) kfo[s] = *(const bf16x8*)(kp + 16 * s);
#pragma unroll
    for (int dt = 0; dt < 2; ++dt)
#pragma unroll
      for (int s2 = 0; s2 < 2; ++s2) vfo[dt][s2] = *(const bf16x8*)(vb + (size_t)(dt * 32 + q) * vstride + 16 * s2 + 8 * hh);
  };
  tile_load(0, kfn, vfn);
  for (int ti = 0; ti < ntiles; ++ti) {
    int a = 0, g = 0;
    if (ti >= 8) { a = (ti - 8) >> 1; g = (ti - 8) & 1; }
    bf16x8 kf[4], vf[2][2];
#pragma unroll
    for (int s = 0; s < 4; ++s) kf[s] = kfn[s];
#pragma unroll
    for (int dt = 0; dt < 2; ++dt)
#pragma unroll
      for (int s2 = 0; s2 < 2; ++s2) vf[dt][s2] = vfn[dt][s2];
    if (ti + 1 < ntiles) tile_load(ti + 1, kfn, vfn);
    f32x16 sacc = zero16();
#pragma unroll
    for (int s = 0; s < 4; ++s) sacc = mfma32(kf[s], qf[s], sacc);
    float sv[16];
    float tmax = -1e30f;
#pragma unroll
    for (int e = 0; e < 16; ++e) {
      float x = sacc[e] * 0.125f;
      if (ti >= 8) {
        const int kc = g * 32 + (e & 7) + 8 * hh + 16 * (e >> 3);
        const bool valid = (kc >= st) && (kc < st + 16);
        const int bi = valid ? ((rs + a - r + 7) * 31 + (kc - w + 15)) : 0;
        const float bias = rpbL[bi];
        x = valid ? (x + bias) : -1e30f;
      }
      sv[e] = x;
      tmax = fmaxf(tmax, x);
    }
    tmax = fmaxf(tmax, shx(tmax, 32));
    const float m_new = fmaxf(m_run, tmax);
    const float alpha = __expf(m_run - m_new);
    m_run = m_new;
    l_run *= alpha;
#pragma unroll
    for (int e = 0; e < 16; ++e) { o0[e] *= alpha; o1[e] *= alpha; }
    float psum = 0.f;
#pragma unroll
    for (int e = 0; e < 16; ++e) { const float pe = __expf(sv[e] - m_new); sv[e] = pe; psum += pe; }
    l_run += psum;
    bf16x8 pf[2];
#pragma unroll
    for (int s2 = 0; s2 < 2; ++s2) {
      union { bf16x8 v; unsigned u[4]; } cv;
#pragma unroll
      for (int j = 0; j < 4; ++j) cv.u[j] = pk2(sv[8 * s2 + 2 * j], sv[8 * s2 + 2 * j + 1]);
      pf[s2] = cv.v;
    }
#pragma unroll
    for (int s2 = 0; s2 < 2; ++s2) {
      o0 = mfma32(vf[0][s2], pf[s2], o0);
      o1 = mfma32(vf[1][s2], pf[s2], o1);
    }
  }
  const float lt = l_run + shx(l_run, 32);
  const float inv = 1.0f / lt;
  u16* op = p.ycat + (size_t)(qtok0 + q) * 1024 + h * 64;
#pragma unroll
  for (int qd = 0; qd < 4; ++qd) {
    uint2 a0, a1;
    a0.x = pk2(o0[4 * qd] * inv, o0[4 * qd + 1] * inv);
    a0.y = pk2(o0[4 * qd + 2] * inv, o0[4 * qd + 3] * inv);
    a1.x = pk2(o1[4 * qd] * inv, o1[4 * qd + 1] * inv);
    a1.y = pk2(o1[4 * qd + 2] * inv, o1[4 * qd + 3] * inv);
    *(uint2*)(op + 8 * qd + 4 * hh) = a0;
    *(uint2*)(op + 32 + 8 * qd + 4 * hh) = a1;
  }
}
__device__ __forceinline__ void attn_block_task(const P& p, int l, int b, int h, int rg4, char* smem) {
  const int tid = opaque_tid(), lane = tid & 63, wid = tid >> 6;
  const int q = lane & 31, hh = lane >> 5;
  const int R0 = rg4 * 4;
  const int r = R0 + (wid >> 1), half = wid & 1;
  float* rpbL = (float*)(smem + 32768);
  for (int i = tid; i < 465; i += NTHR) rpbL[i] = p.na_rpb[(size_t)(l * 8 + h) * 465 + i];
  const int lo = min(max(R0 - 4, 0), 56);
  const int hi = min(max(R0 + 3 - 4, 0), 56) + 7;
  const int ntile = 4 + (hi - lo + 1);
  const int rs = min(max(r - 4, 0), 56);
  const int qtok = b * 4096 + r * 64 + half * 32 + q;
  bf16x8 qf[4];
  {
    const u16* qp = p.qk + (size_t)qtok * 1024 + h * 64 + 8 * hh;
#pragma unroll
    for (int s = 0; s < 4; ++s) qf[s] = *(const bf16x8*)(qp + 16 * s);
  }
  f32x16 o0 = zero16(), o1 = zero16();
  float m_run = -1e30f, l_run = 0.f;
  const int pi = (q & 19) | ((q & 4) << 1) | ((q & 8) >> 1);
  const int w = half * 32 + q;
  const int st = min(max(w - 8, 0), 48);
  const int srow = tid >> 3, sch = tid & 7;
  uint4 rk, rv;
  auto gload = [&](int ti) {
    int ktok0, vstride;
    const u16* vb;
    if (ti < 4) { ktok0 = NLAT + b * 256 + ti * 64; vb = p.vTc + ((size_t)(b * 512 + h * 64)) * 256 + ti * 64; vstride = 256; }
    else { const int R = lo + ti - 4; ktok0 = b * 4096 + R * 64; vb = p.vT + ((size_t)(b * 512 + h * 64)) * 4096 + R * 64; vstride = 4096; }
    rk = *(const uint4*)(p.qk + (size_t)(ktok0 + srow) * 1024 + 512 + h * 64 + sch * 8);
    rv = *(const uint4*)(vb + (size_t)srow * vstride + sch * 8);
  };
  gload(0);
  *(uint4*)(smem + swz128(srow, sch)) = rk;
  *(uint4*)(smem + 16384 + swz128(srow, sch)) = rv;
  __syncthreads();
  for (int ti = 0; ti < ntile; ++ti) {
    const bool more = (ti + 1 < ntile);
    if (more) gload(ti + 1);
    const char* Kb = smem + (ti & 1) * 8192;
    const char* Vb = smem + 16384 + (ti & 1) * 8192;
    const int R = lo + ti - 4;
    const bool active = (ti < 4) || (R >= rs && R < rs + 8);
    if (active) {
#pragma unroll
      for (int g = 0; g < 2; ++g) {
        f32x16 sacc = zero16();
#pragma unroll
        for (int s = 0; s < 4; ++s) {
          const bf16x8 kf = *(const bf16x8*)(Kb + swz128(g * 32 + pi, 2 * s + hh));
          sacc = mfma32(kf, qf[s], sacc);
        }
        float sv[16];
        float tmax = -1e30f;
#pragma unroll
        for (int e = 0; e < 16; ++e) {
          float x = sacc[e] * 0.125f;
          if (ti >= 4) {
            const int kc = g * 32 + (e & 7) + 8 * hh + 16 * (e >> 3);
            const bool valid = (kc >= st) && (kc < st + 16);
            const int bi = valid ? ((R - r + 7) * 31 + (kc - w + 15)) : 0;
            const float bias = rpbL[bi];
            x = valid ? (x + bias) : -1e30f;
          }
          sv[e] = x;
          tmax = fmaxf(tmax, x);
        }
        tmax = fmaxf(tmax, shx(tmax, 32));
        const float m_new = fmaxf(m_run, tmax);
        const float alpha = __expf(m_run - m_new);
        m_run = m_new;
        l_run *= alpha;
#pragma unroll
        for (int e = 0; e < 16; ++e) { o0[e] *= alpha; o1[e] *= alpha; }
        float psum = 0.f;
#pragma unroll
        for (int e = 0; e < 16; ++e) { const float pe = __expf(sv[e] - m_new); sv[e] = pe; psum += pe; }
        l_run += psum;
#pragma unroll
        for (int s2 = 0; s2 < 2; ++s2) {
          union { bf16x8 v; unsigned u[4]; } cv;
#pragma unroll
          for (int j = 0; j < 4; ++j) cv.u[j] = pk2(sv[8 * s2 + 2 * j], sv[8 * s2 + 2 * j + 1]);
          const bf16x8 v0 = *(const bf16x8*)(Vb + swz128(q, g * 4 + 2 * s2 + hh));
          const bf16x8 v1 = *(const bf16x8*)(Vb + swz128(32 + q, g * 4 + 2 * s2 + hh));
          o0 = mfma32(v0, cv.v, o0);
          o1 = mfma32(v1, cv.v, o1);
        }
      }
    }
    if (more) {
      *(uint4*)(smem + ((ti + 1) & 1) * 8192 + swz128(srow, sch)) = rk;
      *(uint4*)(smem + 16384 + ((ti + 1) & 1) * 8192 + swz128(srow, sch)) = rv;
    }
    __syncthreads();
  }
  const float lt = l_run + shx(l_run, 32);
  const float inv = 1.0f / lt;
  u16* op = p.ycat + (size_t)qtok * 1024 + h * 64;
#pragma unroll
  for (int qd = 0; qd < 4; ++qd) {
    uint2 a0, a1;
    a0.x = pk2(o0[4 * qd] * inv, o0[4 * qd + 1] * inv);
    a0.y = pk2(o0[4 * qd + 2] * inv, o0[4 * qd + 3] * inv);
    a1.x = pk2(o1[4 * qd] * inv, o1[4 * qd + 1] * inv);
    a1.y = pk2(o1[4 * qd + 2] * inv, o1[4 * qd + 3] * inv);
    *(uint2*)(op + 8 * qd + 4 * hh) = a0;
    *(uint2*)(op + 32 + 8 * qd + 4 * hh) = a1;
  }
}
__device__ __forceinline__ void attn_task(const P& p, int l, int kind, int idx, char* smem) {
  const int tid_ = opaque_tid(); const int lane = tid_ & 63, wid = tid_ >> 6;
  float* rpbL = (float*)smem + wid * 480;
  for (int i = lane; i < 465; i += 64) rpbL[i] = p.na_rpb[(size_t)(l * 8 + wid) * 465 + i];
  __syncthreads();
  if (kind == 0) {
    const int half = idx & 1, r = (idx >> 1) & 63, b = idx >> 7;
    attn_wave(p, l, b, wid, true, r, half, b * 4096 + r * 64 + half * 32, rpbL);
  } else {
    const int qg = idx & 7, b = idx >> 3;
    attn_wave(p, l, b, wid, false, 0, 0, NLAT + b * 256 + qg * 32, rpbL);
  }
  __syncthreads();
}

__device__ __forceinline__ void phase_mixers(const P& p, int l, char* smem, unsigned* counter) {
  const bool last = (l == 1);
  const int n_rg = 2176 * XRGA, n_fft = 1024 * XFFT, n_hc = last ? 0 : 256, n_att = 1024 * XATT, n_attc = last ? 0 : 64;
  const int total = n_rg + n_fft + n_hc + n_att + n_attc;
  volatile int* s_taskp = (volatile int*)(smem + SMEM_BYTES - 16);
  for (;;) {
    __syncthreads();
    if (threadIdx.x == 0) *s_taskp = (int)atomicAdd(counter, 1u);
    __syncthreads();
    int t = *s_taskp;
    if (t >= total) break;
    if (t < n_rg) { if (t >= 2176) t -= 2176; rg_chunk_task(p, l, t >> 2, t & 3, 0, last, smem); continue; }
    t -= n_rg;
    if (t < n_fft) { t &= 1023; hyena_fft_task(p, l, t >> 2, t & 3, smem); continue; }
    t -= n_fft;
    if (t < n_hc) { hyena_ctx_task(p, l, t >> 5, t & 31, smem); continue; }
    t -= n_hc;
    if (t < n_att) { t &= 1023; attn_block_task(p, l, t >> 7, (t >> 4) & 7, t & 15, smem); continue; }
    t -= n_att;
    attn_task(p, l, 1, t, smem);
  }
}

__device__ __forceinline__ void merge_tile(const P& p, int l, int mt, int nt, char* smem) {
  EPI_VARS
  const int m0 = mt * 256, n0 = nt * 128;
  f32x16 macc[2][2];
  zero_acc(macc);
  for (int br = 0; br < 3; ++br) {
    unsigned* gpl = (unsigned*)(smem + 98304) + tid;
    {
      f32x16 acc[2][2];
      zero_acc(acc);
      gemm_kloop(acc, p.xn + (size_t)m0 * 1024, 1024, p.WgT + ((size_t)l * 3072 + br * 1024 + n0) * 1024, 1024, 1024, smem);
#pragma unroll
      for (int j = 0; j < 2; ++j) {
        const float bg = p.b_gate[l * 3072 + br * 1024 + n0 + EPI_COL(j)];
#pragma unroll
        for (int i = 0; i < 2; ++i)
#pragma unroll
          for (int e = 0; e < 4; ++e) {
            const unsigned q0 = (unsigned)(sigmoidf_(acc[i][j][4 * e] + bg) * 255.0f + 0.5f);
            const unsigned q1 = (unsigned)(sigmoidf_(acc[i][j][4 * e + 1] + bg) * 255.0f + 0.5f);
            const unsigned q2 = (unsigned)(sigmoidf_(acc[i][j][4 * e + 2] + bg) * 255.0f + 0.5f);
            const unsigned q3 = (unsigned)(sigmoidf_(acc[i][j][4 * e + 3] + bg) * 255.0f + 0.5f);
            gpl[((i * 2 + j) * 4 + e) * 512] = q0 | (q1 << 8) | (q2 << 16) | (q3 << 24);
          }
      }
    }
    {
      f32x16 acc[2][2];
      zero_acc(acc);
      const u16* A; const u16* B; int K;
      if (br == 0) { A = p.ycat + (size_t)m0 * 1024; B = p.WaT + ((size_t)l * 1024 + n0) * 512; K = 512; }
      else if (br == 1) { A = p.ycat + (size_t)m0 * 1024 + 512; B = p.WbT + ((size_t)l * 1024 + n0) * 256; K = 256; }
      else { A = p.ycat + (size_t)m0 * 1024 + 768; B = p.WcT + ((size_t)l * 1024 + n0) * 256; K = 256; }
      gemm_kloop(acc, A, 1024, B, K, K, smem);
#pragma unroll
      for (int i = 0; i < 2; ++i)
#pragma unroll
        for (int j = 0; j < 2; ++j)
#pragma unroll
          for (int e = 0; e < 4; ++e) {
            const unsigned g4 = gpl[((i * 2 + j) * 4 + e) * 512];
            macc[i][j][4 * e] += (float)(g4 & 255u) * (1.0f / 255.0f) * acc[i][j][4 * e];
            macc[i][j][4 * e + 1] += (float)((g4 >> 8) & 255u) * (1.0f / 255.0f) * acc[i][j][4 * e + 1];
            macc[i][j][4 * e + 2] += (float)((g4 >> 16) & 255u) * (1.0f / 255.0f) * acc[i][j][4 * e + 2];
            macc[i][j][4 * e + 3] += (float)(g4 >> 24) * (1.0f / 255.0f) * acc[i][j][4 * e + 3];
          }
    }
  }
#pragma unroll
  for (int i = 0; i < 2; ++i)
#pragma unroll
    for (int j = 0; j < 2; ++j)
#pragma unroll
      for (int e = 0; e < 16; ++e)
        p.mbuf[(size_t)(m0 + EPI_ROW(i, e)) * 1024 + n0 + EPI_COL(j)] = f2bf(macc[i][j][e]);
}
__device__ __forceinline__ void outproj_tile(const P& p, int l, int mt, int nt, char* smem, bool do_store) {
  EPI_VARS
  const int m0 = mt * 256, n0 = nt * 128;
  f32x16 acc[2][2];
  zero_acc(acc);
  gemm_kloop(acc, p.mbuf + (size_t)m0 * 1024, 1024, p.WoT + ((size_t)l * 1024 + n0) * 1024, 1024, 1024, smem);
  const bool isctx = (mt >= 128);
  const int bi = isctx ? 8 : (mt >> 4);
  const float* gatev = p.mod + ((size_t)(l * 9 + bi) * 6 + 2) * 1024;
  const float* src; float* dst;
  if (isctx) { src = (l == 0 ? p.ctx : p.ctxs) - (size_t)NLAT * 1024; dst = p.ctxs - (size_t)NLAT * 1024; }
  else { src = (l == 0 ? p.x : p.out); dst = p.out; }
#pragma unroll
  for (int j = 0; j < 2; ++j) {
    const int col = n0 + EPI_COL(j);
    const float gv = gatev[col];
#pragma unroll
    for (int i = 0; i < 2; ++i)
#pragma unroll
      for (int e = 0; e < 16; ++e) {
        const size_t o = (size_t)(m0 + EPI_ROW(i, e)) * 1024 + col;
        if (do_store) dst[o] = src[o] + gv * acc[i][j][e];
      }
  }
}

__device__ __forceinline__ void ins16(unsigned (&L)[16], unsigned x) {
#pragma unroll
  for (int i = 0; i < 16; ++i) {
    const unsigned hi = max(L[i], x);
    x = min(L[i], x);
    L[i] = hi;
  }
}
__device__ __forceinline__ unsigned f2sort(float f) {
  const unsigned b = __float_as_uint(f);
  return b ^ ((unsigned)((int)b >> 31) | 0x80000000u);
}
__device__ __forceinline__ float sort2f(unsigned k) {
  const unsigned u = k & ~127u;
  const unsigned b = (u & 0x80000000u) ? (u ^ 0x80000000u) : ~u;
  return __uint_as_float(b);
}
__device__ __forceinline__ void peer_score_tile(const P& p, int l, int mt, int hp, char* smem) {
  EPI_VARS
  const int m0 = mt * 256;
  f32x16 acc[2][2];
  zero_acc(acc);
  gemm_kloop(acc, p.q + (size_t)m0 * 2048 + hp * 128, 2048, p.keysB + ((size_t)l * 16 + hp) * 16384, 128, 128, smem);
  float* Sf = (float*)smem;
#pragma unroll
  for (int i = 0; i < 2; ++i)
#pragma unroll
    for (int j = 0; j < 2; ++j)
#pragma unroll
      for (int e = 0; e < 16; ++e) Sf[EPI_ROW(i, e) * 130 + EPI_COL(j)] = acc[i][j][e];
  __syncthreads();
  unsigned L[16];
#pragma unroll
  for (int i = 0; i < 16; ++i) L[i] = 0u;
  const int row = tid >> 1, hf = tid & 1;
  for (int i = 0; i < 64; ++i) {
    const int key = 2 * i + hf;
    const float v = Sf[row * 130 + key];
    ins16(L, (f2sort(v) & ~127u) | (unsigned)key);
  }
  unsigned* X = (unsigned*)(smem + 133120);
  if (hf) {
#pragma unroll
    for (int i = 0; i < 16; ++i) X[row * 16 + i] = L[i];
  }
  __syncthreads();
  if (!hf) {
#pragma unroll
    for (int i = 0; i < 16; ++i) ins16(L, X[row * 16 + i]);
    unsigned* o = p.topk + ((size_t)(m0 + row) * 16 + hp) * 16;
#pragma unroll
    for (int i = 0; i < 4; ++i) *(uint4*)(o + 4 * i) = make_uint4(L[4 * i], L[4 * i + 1], L[4 * i + 2], L[4 * i + 3]);
  }
  __syncthreads();
}

__device__ __forceinline__ void phase_peer_experts(const P& p, int l, bool do_store) {
  const int tid_ = opaque_tid(); const int lane = tid_ & 63, wid = tid_ >> 6;
  const int ntok = (l == 1) ? NLAT : NTOK;
  int ci, cj;
  {
    const int e = lane;
    if (e < 16) { ci = 0; cj = e; }
    else if (e < 24) { ci = 1; cj = e - 16; }
    else if (e < 29) { ci = 2; cj = e - 24; }
    else if (e < 33) { ci = 3; cj = e - 29; }
    else if (e < 36) { ci = 4; cj = e - 33; }
    else if (e < 38) { ci = 5; cj = e - 36; }
    else if (e < 40) { ci = 6; cj = e - 38; }
    else if (e < 42) { ci = 7; cj = e - 40; }
    else { ci = min(8 + (e - 42), 15); cj = 0; }
  }
  for (int tok = blockIdx.x * 8 + wid; tok < ntok; tok += gridDim.x * 8) {
    float xr[16];
    {
      const uint4 a = *(const uint4*)(p.xn + (size_t)tok * 1024 + lane * 16);
      const uint4 b = *(const uint4*)(p.xn + (size_t)tok * 1024 + lane * 16 + 8);
      xr[0] = bflo(a.x); xr[1] = bfhi(a.x); xr[2] = bflo(a.y); xr[3] = bfhi(a.y);
      xr[4] = bflo(a.z); xr[5] = bfhi(a.z); xr[6] = bflo(a.w); xr[7] = bfhi(a.w);
      xr[8] = bflo(b.x); xr[9] = bfhi(b.x); xr[10] = bflo(b.y); xr[11] = bfhi(b.y);
      xr[12] = bflo(b.z); xr[13] = bfhi(b.z); xr[14] = bflo(b.w); xr[15] = bfhi(b.w);
    }
    float yacc[16];
#pragma unroll
    for (int i = 0; i < 16; ++i) yacc[i] = 0.f;
    unsigned kvh[8];
#pragma unroll
    for (int h = 0; h < 8; ++h) kvh[h] = p.topk[((size_t)tok * 16 + 2 * h) * 16 + (lane & 31)];
    int eperm[8], gperm[8];
#pragma unroll
    for (int h = 0; h < 8; ++h) {
      const unsigned k0 = shu(kvh[h], ci);
      const unsigned k1 = shu(kvh[h], 16 + cj);
      const float val = (lane < 50) ? (sort2f(k0) + sort2f(k1)) : -3.0e38f;
      const int eidx = (int)((k0 & 127u) * 128u + (k1 & 127u));
      int cnt = 0;
#pragma unroll
      for (int e2 = 0; e2 < 50; ++e2) {
        const float v2 = __builtin_bit_cast(float, __builtin_amdgcn_readlane(__builtin_bit_cast(int, val), e2));
        cnt += (v2 > val || (v2 == val && e2 < lane)) ? 1 : 0;
      }
      const bool sel = (lane < 50) && (cnt < 16);
      const float mx = wave_max(sel ? val : -3.0e38f);
      const float ex = sel ? __expf(val - mx) : 0.f;
      const float sm = wave_sum(ex);
      const float gsel = ex / sm;
      const int dst4 = (sel ? cnt : 63) * 4;
      eperm[h] = __builtin_amdgcn_ds_permute(dst4, eidx);
      gperm[h] = __builtin_amdgcn_ds_permute(dst4, __builtin_bit_cast(int, gsel));
    }
#pragma unroll
    for (int h = 0; h < 8; ++h) {
      uint2 U[16], V[16];
#pragma unroll
      for (int k = 0; k < 16; ++k) {
        const int id = __builtin_amdgcn_readlane(eperm[h], k);
        U[k] = *(const uint2*)(p.Ub + (size_t)id * 512 + lane * 8);
        V[k] = *(const uint2*)(p.Vb + (size_t)id * 512 + lane * 8);
      }
      float d[16];
#pragma unroll
      for (int k = 0; k < 16; ++k) {
        const unsigned uw[2] = {U[k].x, U[k].y};
        float dd = 0.f;
#pragma unroll
        for (int q2 = 0; q2 < 2; ++q2) {
          const f32x2 e0 = __builtin_amdgcn_cvt_scalef32_pk_f32_fp4(uw[q2], 1.0f, 0);
          const f32x2 e1 = __builtin_amdgcn_cvt_scalef32_pk_f32_fp4(uw[q2], 1.0f, 1);
          const f32x2 e2 = __builtin_amdgcn_cvt_scalef32_pk_f32_fp4(uw[q2], 1.0f, 2);
          const f32x2 e3 = __builtin_amdgcn_cvt_scalef32_pk_f32_fp4(uw[q2], 1.0f, 3);
          dd += xr[8 * q2] * e0.x + xr[8 * q2 + 1] * e0.y + xr[8 * q2 + 2] * e1.x + xr[8 * q2 + 3] * e1.y +
                xr[8 * q2 + 4] * e2.x + xr[8 * q2 + 5] * e2.y + xr[8 * q2 + 6] * e3.x + xr[8 * q2 + 7] * e3.y;
        }
        d[k] = dd;
      }
      {
        const bool b5 = (lane & 32) != 0, b4 = (lane & 16) != 0, b3 = (lane & 8) != 0, b2 = (lane & 4) != 0;
#pragma unroll
        for (int j = 0; j < 8; ++j) { const float keep = b5 ? d[j + 8] : d[j], send = b5 ? d[j] : d[j + 8]; d[j] = keep + shx(send, 32); }
#pragma unroll
        for (int j = 0; j < 4; ++j) { const float keep = b4 ? d[j + 4] : d[j], send = b4 ? d[j] : d[j + 4]; d[j] = keep + shx(send, 16); }
#pragma unroll
        for (int j = 0; j < 2; ++j) { const float keep = b3 ? d[j + 2] : d[j], send = b3 ? d[j] : d[j + 2]; d[j] = keep + shx(send, 8); }
        { const float keep = b2 ? d[1] : d[0], send = b2 ? d[0] : d[1]; d[0] = keep + shx(send, 4); }
        d[0] += shx(d[0], 2);
        d[0] += shx(d[0], 1);
      }
      const float gl = __builtin_bit_cast(float, shu((unsigned)gperm[h], (lane >> 2) & 15));
      const float act = gelu_tanh(d[0] * (1.0f / 64.0f)) * gl;
#pragma unroll
      for (int k = 0; k < 16; ++k) {
        const float ak = __builtin_bit_cast(float, __builtin_amdgcn_readlane(__builtin_bit_cast(int, act), 4 * k));
        const unsigned vw[2] = {V[k].x, V[k].y};
#pragma unroll
        for (int q2 = 0; q2 < 2; ++q2) {
          const f32x2 e0 = __builtin_amdgcn_cvt_scalef32_pk_f32_fp4(vw[q2], 1.0f, 0);
          const f32x2 e1 = __builtin_amdgcn_cvt_scalef32_pk_f32_fp4(vw[q2], 1.0f, 1);
          const f32x2 e2 = __builtin_amdgcn_cvt_scalef32_pk_f32_fp4(vw[q2], 1.0f, 2);
          const f32x2 e3 = __builtin_amdgcn_cvt_scalef32_pk_f32_fp4(vw[q2], 1.0f, 3);
          yacc[8 * q2] += ak * e0.x; yacc[8 * q2 + 1] += ak * e0.y; yacc[8 * q2 + 2] += ak * e1.x; yacc[8 * q2 + 3] += ak * e1.y;
          yacc[8 * q2 + 4] += ak * e2.x; yacc[8 * q2 + 5] += ak * e2.y; yacc[8 * q2 + 6] += ak * e3.x; yacc[8 * q2 + 7] += ak * e3.y;
        }
      }
    }
    const int bi = tok < NLAT ? (tok >> 12) : 8;
    const float* gv = p.mod + ((size_t)(l * 9 + bi) * 6 + 5) * 1024 + lane * 16;
    float* xp = (tok < NLAT) ? (p.out + (size_t)tok * 1024) : (p.ctxs + (size_t)(tok - NLAT) * 1024);
    xp += lane * 16;
#pragma unroll
    for (int i = 0; i < 4; ++i) {
      float4 xv = *(float4*)(xp + 4 * i);
      const float4 g4 = *(const float4*)(gv + 4 * i);
      xv.x += g4.x * yacc[4 * i] * 0.25f; xv.y += g4.y * yacc[4 * i + 1] * 0.25f; xv.z += g4.z * yacc[4 * i + 2] * 0.25f; xv.w += g4.w * yacc[4 * i + 3] * 0.25f;
      if (do_store) *(float4*)(xp + 4 * i) = xv;
    }
  }
}


#define XB_TMO      128
#define XB_XCNT(j)  (256  + 64 * (j))
#define XB_XSUB(j)  (1280 + 64 * (j))
#define XB_XGEN(j)  (2304 + 64 * (j))
#define XB_TOP      3328
#define XB_TOPGEN   3392
#define XCD_BAR_WORDS 3456
#define XB_SPIN_CAP (1u << 22)
#define LAS __attribute__((address_space(3)))
__device__ __forceinline__ unsigned xb_ld(unsigned* p) { return __hip_atomic_load(p, __ATOMIC_RELAXED, __HIP_MEMORY_SCOPE_AGENT); }
__device__ __forceinline__ unsigned xb_add(unsigned* p, unsigned v) { return __hip_atomic_fetch_add(p, v, __ATOMIC_RELAXED, __HIP_MEMORY_SCOPE_AGENT); }
__device__ __forceinline__ unsigned xb_xcc_id() { return (unsigned)__builtin_amdgcn_s_getreg((3 << 11) | 20) & 0xFu; }
#define XB_SPIN(cond, bar) do { unsigned _sp = 0; while (cond) { __builtin_amdgcn_s_sleep(1); \
    if ((++_sp & 255u) == 0u) { if (xb_ld(&(bar)[XB_TMO])) break; if (_sp > XB_SPIN_CAP) { atomicAdd(&(bar)[XB_TMO], 1u); break; } } } } while (0)
struct XcdBarrier { unsigned* bar; unsigned x; volatile LAS unsigned* st; };
__device__ __forceinline__ XcdBarrier xcd_barrier_post(unsigned* bar, volatile LAS unsigned* st) {
  XcdBarrier b; b.bar = bar; b.x = xb_xcc_id(); b.st = st;
  if (threadIdx.x == 0) (void)xb_add(&bar[XB_XCNT(b.x)], 1u);
  return b;
}
__device__ __forceinline__ void xcd_barrier_complete(unsigned* bar, unsigned x, unsigned& nloc, unsigned& nx) {
  const unsigned G = gridDim.x * gridDim.y * gridDim.z;
  unsigned sum, cnt, mine, sp = 0u;
  for (;;) {
    sum = 0u; cnt = 0u; mine = 0u;
#pragma unroll
    for (unsigned j = 0; j < 16; ++j) { const unsigned c = xb_ld(&bar[XB_XCNT(j)]); sum += c; cnt += (c > 0u) ? 1u : 0u; mine = (j == x) ? c : mine; }
    if (sum == G) break;
    __builtin_amdgcn_s_sleep(1);
    if ((++sp & 255u) == 0u) { if (xb_ld(&bar[XB_TMO])) break; if (sp > XB_SPIN_CAP) { atomicAdd(&bar[XB_TMO], 1u); break; } }
  }
  nloc = mine > 0u ? mine : 1u; nx = cnt > 0u ? cnt : 1u;
}
__device__ __forceinline__ void xcd_barrier(unsigned* bar_u, volatile LAS unsigned* st_u) {
  XcdBarrier b; b.bar = bar_u; b.x = xb_xcc_id(); b.st = st_u;
  asm volatile("s_waitcnt vmcnt(0)" ::: "memory");
  __syncthreads();
  if (threadIdx.x == 0) {
    unsigned long long bp_ = (unsigned long long)b.bar;
    asm volatile("" : "+v"(bp_));
    unsigned* bar = (unsigned*)bp_;
    __builtin_amdgcn_s_waitcnt(0);
    unsigned nloc = b.st[0], nx = b.st[1];
    if (nloc == 0u) { xcd_barrier_complete(bar, b.x, nloc, nx); b.st[0] = nloc; b.st[1] = nx; }
    const unsigned old = xb_add(&bar[XB_XSUB(b.x)], 1u);
    const unsigned gen = old / nloc;
    if (old + 1u == (gen + 1u) * nloc) {
      __builtin_amdgcn_fence(__ATOMIC_RELEASE, "agent");
      asm volatile("s_waitcnt vmcnt(0)" ::: "memory");
      const unsigned og = xb_add(&bar[XB_TOP], 1u);
      const unsigned tg = og / nx;
      if (og + 1u == (tg + 1u) * nx) xb_add(&bar[XB_TOPGEN], 1u);
      else XB_SPIN(xb_ld(&bar[XB_TOPGEN]) == tg, bar);
      __builtin_amdgcn_fence(__ATOMIC_ACQUIRE, "agent");
      xb_add(&bar[XB_XGEN(b.x)], 1u);
      asm volatile("s_waitcnt vmcnt(0)" ::: "memory");
    } else {
      XB_SPIN(xb_ld(&bar[XB_XGEN(b.x)]) == gen, bar);
      __builtin_amdgcn_fence(__ATOMIC_ACQUIRE, "agent");
      asm volatile("s_waitcnt vmcnt(0)" ::: "memory");
    }
  }
  __syncthreads();
}

template <int l>
__device__ __forceinline__ void layer_body(const P& p, char* smem, pg8::PG8_LAS_T lds, volatile LAS unsigned* xbw, const int nb, const int bid) {
    const bool last = (l == 1);
    const int n_mt = last ? 128 : 136;
_Pragma("unroll 1")
    for (int rep = 0; rep < REP_1A; ++rep) {
      phase_norm(p, l, 0);
    }
    xcd_barrier(p.counters + 1024, xbw);
_Pragma("unroll 1")
    for (int rep = 0; rep < REP_INPROJ; ++rep) {
      pg8::Gemm g; pg8::Order S;
      g.A = p.xn; g.Bt = p.WinT + (size_t)l * 2816 * 1024; g.lda = 1024; g.ldb = 1024; g.K = 1024;
      S.init(136, 6, nb, bid, 4, 5);
      pg8::EpiInprojN e1; e1.qk = p.qk; e1.rg = p.rg;
      pg8::gemm_phase(lds, g, S, e1);
      g.A = p.WinT + ((size_t)l * 2816 + 1024) * 1024; g.Bt = p.xn;
      S.init(5, 136, nb, bid);
      pg8::EpiInprojT e2; e2.vT = p.vT; e2.vTc = p.vTc; e2.hyT = p.hyT; e2.hyTc = p.hyTc;
      pg8::gemm_phase(lds, g, S, e2);
    }
    xcd_barrier(p.counters + 1024, xbw);
    phase_mixers(p, l, smem, p.counters + l * 4);
    xcd_barrier(p.counters + 1024, xbw);
_Pragma("unroll 1")
    for (int rep = 0; rep < REP_2B; ++rep)
      for (int task = bid; task < 2176 + 512; task += nb) {
        if (task < 2176) rg_chunk_task(p, l, task >> 2, task & 3, 1, last, smem);
        else yb_transpose_task(p, (task - 2176) >> 6, (task - 2176) & 63, smem);
      }
    xcd_barrier(p.counters + 1024, xbw);
_Pragma("unroll 1")
    for (int rep = 0; rep < REP_GATE; ++rep) {
      pg8::Gemm g; pg8::Order S;
      g.A = p.xn; g.Bt = p.WgT + (size_t)l * 3072 * 1024; g.lda = 1024; g.ldb = 1024; g.K = 1024;
      S.init(n_mt, 12, nb, bid);
      pg8::EpiGate e; e.g8 = p.g8; e.bias = p.b_gate + l * 3072;
      pg8::gemm_phase(lds, g, S, e);
    }
    xcd_barrier(p.counters + 1024, xbw);
_Pragma("unroll 1")
    for (int rep = 0; rep < REP_BRANCH; ++rep) {
      pg8::Gemm g; pg8::Order S;
      S.init(n_mt, 4, nb, bid);
      pg8::EpiBranch e; e.mbuf = p.mbuf; e.g8 = p.g8;
      g.lda = 1024;
      g.A = p.ycat; g.Bt = p.WaT + (size_t)l * 1024 * 512; g.ldb = 512; g.K = 512; e.br = 0;
      pg8::gemm_phase(lds, g, S, e);
      g.A = p.ycat + 512; g.Bt = p.WbT + (size_t)l * 1024 * 256; g.ldb = 256; g.K = 256; e.br = 1;
      pg8::gemm_phase(lds, g, S, e);
      g.A = p.ycat + 768; g.Bt = p.WcT + (size_t)l * 1024 * 256; g.ldb = 256; g.K = 256; e.br = 2;
      pg8::gemm_phase(lds, g, S, e);
    }
    xcd_barrier(p.counters + 1024, xbw);
    {
      pg8::Gemm g; pg8::Order S;
      g.A = p.mbuf; g.Bt = p.WoT + (size_t)l * 1024 * 1024; g.lda = 1024; g.ldb = 1024; g.K = 1024;
      S.init(n_mt, 4, nb, bid);
      pg8::EpiOut e; e.xsrc = (l == 0 ? p.x : p.out); e.csrc = (l == 0 ? p.ctx : p.ctxs); e.xdst = p.out; e.cdst = p.ctxs;
      e.modl = p.mod + (size_t)l * 9 * 6144;
      pg8::gemm_phase(lds, g, S, e);
      for (int t = bid; t < 8192; t += nb) {
        if (t < 4096) cvt_chunk_fp4(p.peer_u + (size_t)l * 16384 * 1024, p.Ub, (size_t)t, 64.0f);
        else cvt_chunk_fp4(p.peer_v + (size_t)l * 16384 * 1024, p.Vb, (size_t)(t - 4096), 4.0f);
      }
    }
    xcd_barrier(p.counters + 1024, xbw);
    phase_norm(p, l, 1);
    xcd_barrier(p.counters + 1024, xbw);
_Pragma("unroll 1")
    for (int rep = 0; rep < REP_Q; ++rep) {
      pg8::Gemm g; pg8::Order S;
      g.A = p.xn; g.Bt = p.WqT + (size_t)l * 2048 * 1024; g.lda = 1024; g.ldb = 1024; g.K = 1024;
      S.init(n_mt, 8, nb, bid);
      pg8::EpiQ e; e.q = p.q;
      pg8::gemm_phase(lds, g, S, e);
    }
    xcd_barrier(p.counters + 1024, xbw);
_Pragma("unroll 1")
    for (int rep = 0; rep < REP_SCORE; ++rep)
      for (int task = bid; task < n_mt * 16; task += nb) peer_score_tile(p, l, task >> 4, task & 15, smem);
    xcd_barrier(p.counters + 1024, xbw);
_Pragma("unroll 1")
    for (int rep = 0; rep < REP_PEER; ++rep) phase_peer_experts(p, l, rep == REP_PEER - 1);
    xcd_barrier(p.counters + 1024, xbw);
  }

__global__ void __launch_bounds__(NTHR) fwd_megakernel(P p) {
  __shared__ __attribute__((aligned(16))) char smem[SMEM_BYTES];
  cg::grid_group grid = cg::this_grid();
  const int nb = gridDim.x, bid = blockIdx.x;
  pg8::PG8_LAS_T lds = (pg8::PG8_LAS_T)smem;
  volatile LAS unsigned* xbw = (volatile LAS unsigned*)(smem + SMEM_BYTES - 32);
  if (threadIdx.x == 0) { xbw[0] = 0u; xbw[1] = 0u; xbw[2] = 0u; xbw[3] = 0u; }
  __syncthreads();
  (void)xcd_barrier_post(p.counters + 1024, xbw);

  phase_prep(p, smem);
  phase_filters(p, 0);
  phase_filters(p, 1);
  grid.sync();
  phase_modreduce(p);
  for (int task = blockIdx.x; task < 512; task += gridDim.x) kf_task(p, task >> 8, task & 255, smem);
  xcd_barrier(p.counters + 1024, xbw);

  layer_body<0>(p, smem, lds, xbw, nb, bid);
  layer_body<1>(p, smem, lds, xbw, nb, bid);
  phase_norm(p, 1, 2);
}

extern "C" void kernel_launch(void* const* d_in, const int* in_sizes, int n_in, void* d_out, int out_size, void* d_ws,
                              size_t ws_size, hipStream_t stream) {
  P p;
  memset(&p, 0, sizeof(p));
  const float** ins = (const float**)&p;
  for (int i = 0; i < 37; ++i) ins[i] = (const float*)d_in[i];
  p.out = (float*)d_out;
  char* w = (char*)d_ws;
  size_t off = 0;
  auto take = [&](size_t bytes) { char* r = w + off; off += (bytes + 255) & ~(size_t)255; return r; };
  p.counters = (unsigned*)take(32768);
  p.WinT = (u16*)take((size_t)2 * 2816 * 1024 * 2);
  p.WgT = (u16*)take((size_t)2 * 3072 * 1024 * 2);
  p.WaT = (u16*)take((size_t)2 * 1024 * 512 * 2);
  p.WbT = (u16*)take((size_t)2 * 1024 * 256 * 2);
  p.WcT = (u16*)take((size_t)2 * 1024 * 256 * 2);
  p.WoT = (u16*)take((size_t)2 * 1024 * 1024 * 2);
  p.WqT = (u16*)take((size_t)2 * 2048 * 1024 * 2);
  p.keysB = (u16*)take((size_t)2 * 16 * 16384 * 2);
  p.rgW = (u16*)take((size_t)2 * 16 * 4096 * 2);
  p.modpart = (float*)take((size_t)16 * 2 * 9 * 6144 * 4);
  p.mod = (float*)take((size_t)2 * 9 * 6144 * 4);
  p.hT = (float*)take((size_t)2 * 512 * 4096 * 4);
  p.hc = (float*)take((size_t)512 * 256 * 4);
  p.Kf = (float*)take((size_t)2 * 256 * 8192 * 8);
  p.xn = (u16*)take((size_t)NTOK * 1024 * 2);
  p.qk = (u16*)take((size_t)NTOK * 1024 * 2);
  p.mbuf = p.qk;
  p.vT = (u16*)take((size_t)8 * 512 * 4096 * 2);
  p.vTc = (u16*)take((size_t)8 * 512 * 256 * 2);
  p.hyT = (u16*)take((size_t)8 * 768 * 4096 * 2);
  p.hyTc = (u16*)take((size_t)8 * 768 * 256 * 2);
  p.rg = (u16*)take((size_t)NTOK * 512 * 2);
  p.ycat = (u16*)take((size_t)NTOK * 1024 * 2);
  p.Ub = (unsigned char*)p.ycat;
  p.Vb = p.Ub + (size_t)16384 * 512;
  p.agg = (float*)take((size_t)8 * 2 * 68 * 256 * 8);
  p.ybT = (u16*)take((size_t)8 * 256 * 4096 * 2);
  p.ctxs = (float*)take((size_t)2048 * 1024 * 4);
  p.g8 = (unsigned char*)p.vT;
  p.q = p.qk;
  p.topk = (unsigned*)((char*)p.qk + (size_t)NTOK * 2048 * 2);
  if (off > ws_size) {
    fprintf(stderr, "workspace too small: need %zu have %zu\n", off, ws_size);
    return;
  }
  static int grid_blocks = 0;
  if (!grid_blocks) {
    int dev = 0, cus = 0, per_cu = 0;
    (void)hipGetDevice(&dev);
    (void)hipDeviceGetAttribute(&cus, hipDeviceAttributeMultiprocessorCount, dev);
    (void)hipOccupancyMaxActiveBlocksPerMultiprocessor(&per_cu, fwd_megakernel, NTHR, 0);
    if (per_cu > 1) per_cu = 1;
    grid_blocks = cus * per_cu;
  }
  (void)hipMemsetAsync(p.counters, 0, 32768, stream);
  void* args[] = {&p};
  hipError_t e = hipLaunchCooperativeKernel((void*)fwd_megakernel, dim3(grid_blocks), dim3(NTHR), args, 0, stream);
  if (e != hipSuccess) fprintf(stderr, "cooperative launch failed: %s (grid %d)\n", hipGetErrorString(e), grid_blocks);
}
```

```cpp
#include <hip/hip_runtime.h>
#include <hip/hip_cooperative_groups.h>
#include <cstdio>
#include <cstring>
namespace cg = cooperative_groups;

typedef unsigned short u16;
typedef __attribute__((ext_vector_type(8))) short bf16x8;
typedef __attribute__((ext_vector_type(16))) float f32x16;
typedef __attribute__((ext_vector_type(2))) float f32x2;

#define NLAT 32768
#define NTOK 34816
#define SMEM_BYTES 151552
#define NTHR 512
#ifndef DUP_1A
#define DUP_1A 1
#endif
#ifndef DUP_PREP
#define DUP_PREP 1
#endif
#ifndef DUP_2B
#define DUP_2B 1
#endif
#ifndef XRGA
#define XRGA 1
#endif
#ifndef REP_PEER
#define REP_PEER 1
#endif
#ifndef REP_INPROJ
#define REP_INPROJ 1
#endif
#ifndef REP_GATE
#define REP_GATE 1
#endif
#ifndef REP_BRANCH
#define REP_BRANCH 1
#endif
#ifndef REP_Q
#define REP_Q 1
#endif
#ifndef REP_SCORE
#define REP_SCORE 1
#endif
#ifndef REP_1A
#define REP_1A 1
#endif
#ifndef REP_2B
#define REP_2B 1
#endif
#ifndef REP_KF
#define REP_KF 1
#endif
#ifndef DUP_GEMM
#define DUP_GEMM 1
#endif
#ifndef DUP_PEER
#define DUP_PEER 1
#endif
#ifndef DUP_MIX
#define DUP_MIX 1
#endif
#ifndef XRG
#define XRG 1
#endif
#ifndef XFFT
#define XFFT 1
#endif
#ifndef XATT
#define XATT 1
#endif

struct P {
  const float *x, *c, *ctx, *c_ctx, *norm_mix_g, *norm_ffn_g, *w_ada, *b_ada, *w_in, *na_rpb,
      *hy_short_w, *hy_short_b, *hy_f1_w, *hy_f1_b, *hy_f2_w, *hy_f2_b, *hy_f3_w, *hy_freq, *hy_bias,
      *rg_conv_w, *rg_conv_b, *rg_wa, *rg_ba, *rg_wx, *rg_bx, *rg_lambda,
      *w_gate, *b_gate, *w_br_a, *w_br_b, *w_br_c, *w_out, *peer_wq, *peer_keys, *peer_u, *peer_v, *final_g;
  float* out;
  unsigned* counters;
  u16 *WinT, *WgT, *WaT, *WbT, *WcT, *WoT, *WqB, *WqkT, *keysB, *rgW;
  float *modpart, *mod, *hT, *hc;
  float* Kf;
  u16 *xn, *qk, *vT, *vTc, *hyT, *hyTc, *rg, *ycat, *mbuf, *ybT;
  unsigned char *Ub, *Vb, *g8;
  u16* q;
  float *agg, *ctxs;
  unsigned* topk;
};

__device__ __forceinline__ u16 f2bf(float f) {
  unsigned u = __float_as_uint(f);
  u += 0x7fffu + ((u >> 16) & 1u);
  return (u16)(u >> 16);
}
__device__ __forceinline__ float bf2f(u16 h) { return __uint_as_float(((unsigned)h) << 16); }
__device__ __forceinline__ unsigned pk2(float a, float b) { return (unsigned)f2bf(a) | ((unsigned)f2bf(b) << 16); }
__device__ __forceinline__ float bflo(unsigned u) { return __uint_as_float(u << 16); }
__device__ __forceinline__ float bfhi(unsigned u) { return __uint_as_float(u & 0xffff0000u); }
__device__ __forceinline__ int opaque_tid() {
  int t = threadIdx.x;
  asm volatile("" : "+v"(t));
  return t;
}
__device__ __forceinline__ int my_lane() { return opaque_tid() & 63; }
__device__ __forceinline__ float shx(float v, int o) { return __builtin_bit_cast(float, __builtin_amdgcn_ds_bpermute(((my_lane() ^ o) << 2), __builtin_bit_cast(int, v))); }
__device__ __forceinline__ float shf(float v, int src) { return __builtin_bit_cast(float, __builtin_amdgcn_ds_bpermute((src & 63) << 2, __builtin_bit_cast(int, v))); }
__device__ __forceinline__ unsigned shu(unsigned v, int src) { return (unsigned)__builtin_amdgcn_ds_bpermute((src & 63) << 2, (int)v); }
__device__ __forceinline__ float wave_sum(float v) {
  const int lane = my_lane();
#pragma unroll
  for (int o = 32; o > 0; o >>= 1) v += __builtin_bit_cast(float, __builtin_amdgcn_ds_bpermute((lane ^ o) << 2, __builtin_bit_cast(int, v)));
  return v;
}
__device__ __forceinline__ float wave_max(float v) {
  const int lane = my_lane();
#pragma unroll
  for (int o = 32; o > 0; o >>= 1) v = fmaxf(v, __builtin_bit_cast(float, __builtin_amdgcn_ds_bpermute((lane ^ o) << 2, __builtin_bit_cast(int, v))));
  return v;
}
__device__ __forceinline__ float sigmoidf_(float x) { return __builtin_amdgcn_rcpf(1.0f + __expf(-x)); }
__device__ __forceinline__ float gelu_tanh(float x) {
  const float u2 = 1.5957691216057308f * (x + 0.044715f * x * x * x);
  return x * __builtin_amdgcn_rcpf(1.0f + __expf(-u2));
}
__device__ __forceinline__ f32x16 mfma32(bf16x8 a, bf16x8 b, f32x16 c) {
  return __builtin_amdgcn_mfma_f32_32x32x16_bf16(a, b, c, 0, 0, 0);
}
__device__ __forceinline__ f32x16 zero16() {
  f32x16 z;
#pragma unroll
  for (int i = 0; i < 16; ++i) z[i] = 0.f;
  return z;
}
__device__ __forceinline__ int swz128(int row, int ch) { return row * 128 + ((ch ^ ((row >> 1) & 7)) << 4); }
__device__ __forceinline__ int swz256(int row, int ch) { return row * 256 + ((ch ^ (row & 15)) << 4); }

struct c2 { float x, y; };
__device__ __forceinline__ c2 cadd(c2 a, c2 b) { return {a.x + b.x, a.y + b.y}; }
__device__ __forceinline__ c2 csub(c2 a, c2 b) { return {a.x - b.x, a.y - b.y}; }
__device__ __forceinline__ c2 cmul(c2 a, c2 b) { return {a.x * b.x - a.y * b.y, a.x * b.y + a.y * b.x}; }
__device__ __forceinline__ float c16(int i) {
  const float tb[16] = {1.0f, 0.9238795325112867f, 0.7071067811865476f, 0.3826834323650898f, 0.0f,
                        -0.3826834323650898f, -0.7071067811865476f, -0.9238795325112867f, -1.0f,
                        -0.9238795325112867f, -0.7071067811865476f, -0.3826834323650898f, 0.0f,
                        0.3826834323650898f, 0.7071067811865476f, 0.9238795325112867f};
  return tb[i & 15];
}
__device__ __forceinline__ float s16(int i) { return c16(i + 12); }
template <int R> __device__ __forceinline__ constexpr int brev(int k) {
  int r = 0;
  for (int b = 1, o = R >> 1; b < R; b <<= 1, o >>= 1)
    if (k & b) r |= o;
  return r;
}
template <int R> __device__ __forceinline__ void dft_reg(c2* v, float sgn) {
#pragma unroll
  for (int h = R / 2; h >= 1; h >>= 1) {
#pragma unroll
    for (int g = 0; g < R; g += 2 * h) {
#pragma unroll
      for (int j = 0; j < h; ++j) {
        c2 a = v[g + j], b = v[g + j + h];
        v[g + j] = cadd(a, b);
        c2 d = csub(a, b);
        const int ti = j * (16 / (2 * h));
        c2 w = {c16(ti), sgn * s16(ti)};
        v[g + j + h] = (j == 0) ? d : cmul(d, w);
      }
    }
  }
}
template <int R> __device__ __forceinline__ int fft_bfly(c2* v, int j, int Ns, float sgn) {
  const int k = j & (Ns - 1);
  const float f = sgn * (float)k / (float)(Ns * R);
#pragma unroll
  for (int r = 1; r < R; ++r) {
    float t = f * (float)r;
    c2 w = {__builtin_amdgcn_cosf(t), __builtin_amdgcn_sinf(t)};
    v[r] = cmul(v[r], w);
  }
  dft_reg<R>(v, sgn);
  return (j - k) * R + k;
}
template <int R> __device__ __forceinline__ void fft_pass(c2* buf, int Ns, float sgn) {
  constexpr int NBF = 8192 / R;
  constexpr int PER = NBF / NTHR;
  const int tid = opaque_tid();
  c2 v[PER][R];
#pragma unroll
  for (int i = 0; i < PER; ++i) {
    const int j = tid + NTHR * i;
#pragma unroll
    for (int r = 0; r < R; ++r) v[i][r] = buf[j + r * NBF];
  }
  __syncthreads();
#pragma unroll
  for (int i = 0; i < PER; ++i) {
    const int j = tid + NTHR * i;
    const int base = fft_bfly<R>(v[i], j, Ns, sgn);
#pragma unroll
    for (int r = 0; r < R; ++r) buf[base + r * Ns] = v[i][brev<R>(r)];
  }
  __syncthreads();
}
__device__ __forceinline__ void fft8192(c2* buf, float sgn) {
  fft_pass<8>(buf, 1, sgn);
  fft_pass<8>(buf, 8, sgn);
  fft_pass<8>(buf, 64, sgn);
  fft_pass<16>(buf, 512, sgn);
}

__device__ __forceinline__ void gemm_kloop(f32x16 (&acc)[2][2], const u16* __restrict__ A, int lda,
                                           const u16* __restrict__ B, int ldb, int K, char* smem) {
  const int tid = opaque_tid(), lane = tid & 63, wid = tid >> 6;
  const int wm = wid >> 1, wn = wid & 1;
  const int l31 = lane & 31, hh = lane >> 5;
  uint4 ra[4], rb[2];
  const int nk = K >> 6;
  const int srow = tid >> 3, sch = tid & 7;
  const char* Ab = (const char*)A;
  const char* Bb = (const char*)B;
  const unsigned aoff = (unsigned)(srow * lda + sch * 8) * 2u;
  const unsigned boff = (unsigned)(srow * ldb + sch * 8) * 2u;
  const unsigned astep = (unsigned)lda * 128u, bstep = (unsigned)ldb * 128u;
#pragma unroll
  for (int i = 0; i < 4; ++i) ra[i] = *(const uint4*)(Ab + (aoff + i * astep));
#pragma unroll
  for (int i = 0; i < 2; ++i) rb[i] = *(const uint4*)(Bb + (boff + i * bstep));
#pragma unroll
  for (int i = 0; i < 4; ++i) *(uint4*)(smem + swz128(srow + i * 64, sch)) = ra[i];
#pragma unroll
  for (int i = 0; i < 2; ++i) *(uint4*)(smem + 65536 + swz128(srow + i * 64, sch)) = rb[i];
  __syncthreads();
  for (int kt = 0; kt < nk; ++kt) {
    const bool more = (kt + 1 < nk);
    if (more) {
      const unsigned ko = (unsigned)(kt + 1) * 128u;
#pragma unroll
      for (int i = 0; i < 4; ++i) ra[i] = *(const uint4*)(Ab + (aoff + i * astep + ko));
#pragma unroll
      for (int i = 0; i < 2; ++i) rb[i] = *(const uint4*)(Bb + (boff + i * bstep + ko));
    }
    const char* as = smem + (kt & 1) * 32768;
    const char* bs = smem + 65536 + (kt & 1) * 16384;
    int lrow = l31;
    asm volatile("" : "+v"(lrow));
#pragma unroll
    for (int s = 0; s < 4; ++s) {
      bf16x8 af[2], bfr[2];
#pragma unroll
      for (int i = 0; i < 2; ++i) af[i] = *(const bf16x8*)(as + swz128(wm * 64 + i * 32 + lrow, s * 2 + hh));
#pragma unroll
      for (int j = 0; j < 2; ++j) bfr[j] = *(const bf16x8*)(bs + swz128(wn * 64 + j * 32 + lrow, s * 2 + hh));
#pragma unroll
      for (int i = 0; i < 2; ++i)
#pragma unroll
        for (int j = 0; j < 2; ++j) acc[i][j] = mfma32(af[i], bfr[j], acc[i][j]);
    }
    if (more) {
      char* an = smem + ((kt + 1) & 1) * 32768;
      char* bn = smem + 65536 + ((kt + 1) & 1) * 16384;
      int sr2 = srow;
      asm volatile("" : "+v"(sr2));
#pragma unroll
      for (int i = 0; i < 4; ++i) *(uint4*)(an + swz128(sr2 + i * 64, sch)) = ra[i];
#pragma unroll
      for (int i = 0; i < 2; ++i) *(uint4*)(bn + swz128(sr2 + i * 64, sch)) = rb[i];
    }
    __syncthreads();
  }
}
__device__ __forceinline__ void zero_acc(f32x16 (&acc)[2][2]) {
#pragma unroll
  for (int i = 0; i < 2; ++i)
#pragma unroll
    for (int j = 0; j < 2; ++j) acc[i][j] = zero16();
}
#define EPI_ROW(i, e) (wm * 64 + (i)*32 + ((e)&3) + 8 * ((e) >> 2) + 4 * hh)
#define EPI_COL(j) (wn * 64 + (j)*32 + l31)
#define EPI_VARS                                                    \
  const int tid = opaque_tid(), lane = tid & 63, wid = tid >> 6;     \
  const int wm = wid >> 1, wn = wid & 1, l31 = lane & 31, hh = lane >> 5; \
  (void)tid; (void)wm; (void)wn; (void)l31; (void)hh;


namespace pg8 {
#define PG8_LAS __attribute__((address_space(3)))
typedef PG8_LAS unsigned char* PG8_LAS_T;
typedef float f32x4 __attribute__((ext_vector_type(4)));
typedef unsigned u32x4 __attribute__((ext_vector_type(4)));
constexpr int BM = 256, BK = 64, HALF = 128, HTB = HALF * BK * 2, STAGE_BYTES = 8 * HTB, NXCD = 8, WGM = 8;
__device__ __forceinline__ int lds_byte(int r, int c) { const int st = (r >> 4) * 2 + (c >> 5), rr = r & 15, cc = c & 31, ob = rr * 64 + cc * 2; return st * 1024 + (ob ^ (((ob >> 9) & 1) << 5)); }
__device__ __forceinline__ void stage_rc(int b, int& R, int& C) { const int st = b / 1024, sb = b % 1024, swz = sb ^ (((sb >> 9) & 1) << 5); R = (st >> 1) * 16 + swz / 64; C = (st & 1) * 32 + (swz % 64) / 2; }
__device__ __forceinline__ int perm32(int rho) { const int n = rho >> 4, i = rho & 15; return 8 * (i >> 2) + 4 * n + (i & 3); }
struct Unit { int pm, pn; };
struct Gemm { const u16* A; const u16* Bt; int lda, ldb, K; };
struct Order {
  int nM, nN, nwg, G, c, skip_from, skip_by;
  __device__ __forceinline__ void init(int nM_, int nN_, int G_, int c_, int sf = 1 << 30, int sb = 0) { nM = nM_; nN = nN_; nwg = nM * nN; G = G_; c = c_; skip_from = sf; skip_by = sb; }
  __device__ __forceinline__ bool next(int i, Unit& u) const {
    const long L = (long)i * G + c; if (L >= nwg) return false;
    int wgid = (int)L; { const int q = nwg / NXCD, r = nwg % NXCD, xcd = wgid % NXCD, off = wgid / NXCD; wgid = (xcd < r ? xcd * (q + 1) : r * (q + 1) + (xcd - r) * q) + off; }
    const int nig = WGM * nN, gid = wgid / nig, fm = gid * WGM, gsz = (nM - fm) < WGM ? (nM - fm) : WGM;
    u.pm = fm + ((wgid % nig) % gsz); u.pn = (wgid % nig) / gsz;
    if (u.pn >= skip_from) u.pn += skip_by;
    return true;
  }
};
template <class Epi>
__device__ __forceinline__ void gemm_phase(PG8_LAS unsigned char* lds, const Gemm g, const Order& S, const Epi& E) {
  const int tid = opaque_tid(), wid = __builtin_amdgcn_readfirstlane(tid >> 6), lane = tid & 63, wr = wid >> 2, wc = wid & 3, fr = lane & 15, fq = lane >> 4;
  const int K = g.K, nt = K / BK;
  unsigned voffA[2], voffB[2];
#pragma unroll
  for (int i = 0; i < 2; ++i) { int R, C; stage_rc(tid * 16 + i * 8192, R, C); const int Rb = Epi::PERM ? ((R & ~31) + perm32(R & 31)) : R;
    voffA[i] = (unsigned)(R * g.lda + C) * 2u; voffB[i] = (unsigned)(Rb * g.ldb + C) * 2u; }
  const size_t kstep = (size_t)(BK * 2);
  const size_t hstepA = (size_t)HALF * g.lda * 2, hstepB = (size_t)HALF * g.ldb * 2;
  const size_t tstepA = 2 * hstepA, tstepB = 2 * hstepB;
  const unsigned ldsw = (unsigned)wid * 1024u;
  const int aoff = lds_byte(wr * 64 + fr, fq * 8), boff = lds_byte(wc * 32 + fr, fq * 8);
#define PG8_SA(b, h) (((b) * 2 + (h)) * HTB)
#define PG8_SB(b, h) ((4 + (b) * 2 + (h)) * HTB)
#define PG8_STAGE(bufoff, gbase, voff) do { _Pragma("unroll") for (int _i = 0; _i < 2; ++_i) \
    __builtin_amdgcn_global_load_lds((const unsigned*)((const char*)(gbase) + (voff)[_i]), (PG8_LAS unsigned*)(lds + (bufoff) + ldsw + _i * 8192), 16, 0, 0); } while (0)
#define PG8_LDA(dst, b, h) do { _Pragma("unroll") for (int m = 0; m < 4; ++m) _Pragma("unroll") for (int k = 0; k < 2; ++k) dst[m][k] = *(const PG8_LAS bf16x8*)(lds + PG8_SA(b, h) + aoff + m * 2048 + k * 1024); } while (0)
#define PG8_LDB(dst, b, h) do { _Pragma("unroll") for (int n = 0; n < 2; ++n) _Pragma("unroll") for (int k = 0; k < 2; ++k) dst[n][k] = *(const PG8_LAS bf16x8*)(lds + PG8_SB(b, h) + boff + n * 2048 + k * 1024); } while (0)
#define PG8_MMA(ai, bj, At, Bt) do { __builtin_amdgcn_s_setprio(1); _Pragma("unroll") for (int m = 0; m < 4; ++m) _Pragma("unroll") for (int n = 0; n < 2; ++n) _Pragma("unroll") for (int k = 0; k < 2; ++k) \
    acc[ai][bj][m][n] = __builtin_amdgcn_mfma_f32_16x16x32_bf16(Bt[n][k], At[m][k], acc[ai][bj][m][n], 0, 0, 0); __builtin_amdgcn_s_setprio(0); } while (0)
#define PG8_WAIT_V(n) asm volatile("s_waitcnt vmcnt(" #n ")" ::: "memory")
#define PG8_WAIT_L(n) asm volatile("s_waitcnt lgkmcnt(" #n ")" ::: "memory")
#define PG8_BAR __builtin_amdgcn_s_barrier()
#define PG8_SCHED __builtin_amdgcn_sched_barrier(0)
  Unit cur, nxt; int ui = 0;
  if (!S.next(0, cur)) return;
  f32x4 acc[2][2][4][2];
#pragma unroll
  for (int a = 0; a < 2; ++a)
#pragma unroll
    for (int b = 0; b < 2; ++b)
#pragma unroll
      for (int m = 0; m < 4; ++m)
#pragma unroll
        for (int n = 0; n < 2; ++n) acc[a][b][m][n] = (f32x4){0.f, 0.f, 0.f, 0.f};
  bf16x8 At[4][2], B0[2][2], B1[2][2];
  const char* cA = (const char*)g.A + (size_t)cur.pm * tstepA; const char* cB = (const char*)g.Bt + (size_t)cur.pn * tstepB;
  PG8_STAGE(PG8_SB(0, 0), cB, voffB); PG8_STAGE(PG8_SA(0, 0), cA, voffA); PG8_STAGE(PG8_SB(0, 1), cB + hstepB, voffB); PG8_STAGE(PG8_SA(0, 1), cA + hstepA, voffA);
  if (wr == 1) PG8_BAR;
  PG8_WAIT_V(4); PG8_BAR;
  PG8_STAGE(PG8_SB(1, 0), cB + kstep, voffB); PG8_STAGE(PG8_SA(1, 0), cA + kstep, voffA); PG8_STAGE(PG8_SB(1, 1), cB + hstepB + kstep, voffB);
  PG8_WAIT_V(6); PG8_BAR;
  for (;;) {
    const bool has_next = S.next(ui + 1, nxt);
    const char* nA = has_next ? (const char*)g.A + (size_t)nxt.pm * tstepA : cA; const char* nB = has_next ? (const char*)g.Bt + (size_t)nxt.pn * tstepB : cB;
    for (int t = 0; t < nt; t += 2) {
      const bool last = (t == nt - 2);
      const char* a1 = cA + (size_t)(t + 1) * kstep;
      const char* a2 = last ? nA : cA + (size_t)(t + 2) * kstep; const char* b2 = last ? nB : cB + (size_t)(t + 2) * kstep;
      const char* a3 = a2 + kstep; const char* b3 = b2 + kstep;
      PG8_LDB(B0, 0, 0); PG8_SCHED; PG8_LDA(At, 0, 0); PG8_STAGE(PG8_SA(1, 1), a1 + hstepA, voffA);
      PG8_WAIT_L(8); PG8_BAR; PG8_WAIT_L(0); PG8_MMA(0, 0, At, B0); PG8_BAR; PG8_SCHED;
      PG8_LDB(B1, 0, 1); PG8_STAGE(PG8_SB(0, 0), b2, voffB);
      PG8_BAR; PG8_WAIT_L(0); PG8_MMA(0, 1, At, B1); PG8_BAR;
      PG8_LDA(At, 0, 1); PG8_STAGE(PG8_SA(0, 0), a2, voffA);
      PG8_BAR; PG8_WAIT_L(0); PG8_MMA(1, 0, At, B0); PG8_BAR; PG8_SCHED;
      PG8_STAGE(PG8_SB(0, 1), b2 + hstepB, voffB);
      PG8_WAIT_V(6); PG8_BAR; PG8_MMA(1, 1, At, B1); PG8_BAR;
      PG8_LDB(B0, 1, 0); PG8_SCHED; PG8_LDA(At, 1, 0); PG8_STAGE(PG8_SA(0, 1), a2 + hstepA, voffA);
      PG8_WAIT_L(8); PG8_BAR; PG8_WAIT_L(0); PG8_MMA(0, 0, At, B0); PG8_BAR; PG8_SCHED;
      PG8_LDB(B1, 1, 1); PG8_STAGE(PG8_SB(1, 0), b3, voffB);
      PG8_BAR; PG8_WAIT_L(0); PG8_MMA(0, 1, At, B1); PG8_BAR;
      PG8_LDA(At, 1, 1); PG8_STAGE(PG8_SA(1, 0), a3, voffA);
      PG8_BAR; PG8_WAIT_L(0); PG8_MMA(1, 0, At, B0); PG8_BAR; PG8_SCHED;
      PG8_STAGE(PG8_SB(1, 1), b3 + hstepB, voffB);
      PG8_WAIT_V(6); PG8_BAR; PG8_MMA(1, 1, At, B1); PG8_BAR;
    }
    E(acc, cur, wr, wc, fr, fq);
    if (!has_next) break;
#pragma unroll
    for (int a = 0; a < 2; ++a)
#pragma unroll
      for (int b = 0; b < 2; ++b)
#pragma unroll
        for (int m = 0; m < 4; ++m)
#pragma unroll
          for (int n = 0; n < 2; ++n) acc[a][b][m][n] = (f32x4){0.f, 0.f, 0.f, 0.f};
    cur = nxt; cA = nA; cB = nB; ++ui;
  }
  PG8_WAIT_V(0);
  if (wr == 0) PG8_BAR;
  PG8_BAR;
#undef PG8_SA
#undef PG8_SB
#undef PG8_STAGE
#undef PG8_LDA
#undef PG8_LDB
#undef PG8_MMA
#undef PG8_WAIT_V
#undef PG8_WAIT_L
#undef PG8_BAR
#undef PG8_SCHED
}
typedef const f32x4 (&AccRef)[2][2][4][2];
struct EpiInprojN {
  static constexpr bool PERM = true;
  u16* qk; u16* rg;
  __device__ __forceinline__ void operator()(AccRef acc, const Unit& u, int wr, int wc, int fr, int fq) const {
    const int row0 = u.pm * BM + wr * 64 + fr;
    u16* base; int ld, colt;
    if (u.pn < 4) { base = qk; ld = 1024; colt = u.pn * 256; } else { base = rg; ld = 512; colt = (u.pn - 9) * 256; }
    const int col0 = colt + wc * 32 + 8 * fq;
#pragma unroll
    for (int ai = 0; ai < 2; ++ai)
#pragma unroll
      for (int m = 0; m < 4; ++m) {
        u16* rowp = base + (size_t)(row0 + ai * HALF + m * 16) * ld + col0;
#pragma unroll
        for (int bj = 0; bj < 2; ++bj) {
          const f32x4 v0 = acc[ai][bj][m][0], v1 = acc[ai][bj][m][1];
          u32x4 w; w.x = pk2(v0[0], v0[1]); w.y = pk2(v0[2], v0[3]); w.z = pk2(v1[0], v1[1]); w.w = pk2(v1[2], v1[3]);
          *(u32x4*)(rowp + bj * HALF) = w;
        }
      }
  }
};
struct EpiInprojT {
  static constexpr bool PERM = true;
  u16 *vT, *vTc, *hyT, *hyTc;
  __device__ __forceinline__ void operator()(AccRef acc, const Unit& u, int wr, int wc, int fr, int fq) const {
    const bool isctx = (u.pn >= 128);
    const int b = isctx ? (u.pn - 128) : (u.pn >> 4);
    const int Lseg = isctx ? 256 : 4096, t0 = isctx ? 0 : (u.pn & 15) * 256;
    const bool isv = (u.pm < 2);
    const size_t boff = isv ? (isctx ? (size_t)16777216 : (size_t)0) : (isctx ? (size_t)(16777216 + 1048576 + 25165824) : (size_t)(16777216 + 1048576));
    u16* base = vT + boff;
    const int nc = isv ? 512 : 768;
    const int wrow0 = (isv ? u.pm : u.pm - 2) * BM + wr * 64 + fr;
    const int col0 = t0 + wc * 32 + 8 * fq;
#pragma unroll
    for (int ai = 0; ai < 2; ++ai)
#pragma unroll
      for (int m = 0; m < 4; ++m) {
        u16* rowp = base + ((size_t)(b * nc + wrow0 + ai * HALF + m * 16)) * Lseg + col0;
#pragma unroll
        for (int bj = 0; bj < 2; ++bj) {
          const f32x4 v0 = acc[ai][bj][m][0], v1 = acc[ai][bj][m][1];
          u32x4 w; w.x = pk2(v0[0], v0[1]); w.y = pk2(v0[2], v0[3]); w.z = pk2(v1[0], v1[1]); w.w = pk2(v1[2], v1[3]);
          *(u32x4*)(rowp + bj * HALF) = w;
        }
      }
  }
};
struct EpiGate {
  static constexpr bool PERM = true;
  unsigned char* g8; const float* bias;
  __device__ __forceinline__ void operator()(AccRef acc, const Unit& u, int wr, int wc, int fr, int fq) const {
    const int row0 = u.pm * BM + wr * 64 + fr;
    const int col0 = u.pn * BM + wc * 32 + 8 * fq;
#pragma unroll
    for (int bj = 0; bj < 2; ++bj) {
      const f32x4 b0 = *(const f32x4*)(bias + col0 + bj * HALF), b1 = *(const f32x4*)(bias + col0 + bj * HALF + 4);
#pragma unroll
      for (int ai = 0; ai < 2; ++ai)
#pragma unroll
        for (int m = 0; m < 4; ++m) {
          const f32x4 v0 = acc[ai][bj][m][0] + b0, v1 = acc[ai][bj][m][1] + b1;
          unsigned w0 = 0, w1 = 0;
#pragma unroll
          for (int k = 0; k < 4; ++k) {
            w0 |= (unsigned)(sigmoidf_(v0[k]) * 255.0f + 0.5f) << (8 * k);
            w1 |= (unsigned)(sigmoidf_(v1[k]) * 255.0f + 0.5f) << (8 * k);
          }
          *(uint2*)(g8 + (size_t)(row0 + ai * HALF + m * 16) * 3072 + col0 + bj * HALF) = make_uint2(w0, w1);
        }
    }
  }
};
struct EpiBranch {
  static constexpr bool PERM = true;
  u16* mbuf; const unsigned char* g8; int br;
  __device__ __forceinline__ void operator()(AccRef acc, const Unit& u, int wr, int wc, int fr, int fq) const {
    const int row0 = u.pm * BM + wr * 64 + fr;
    const int col0 = u.pn * BM + wc * 32 + 8 * fq;
#pragma unroll
    for (int ai = 0; ai < 2; ++ai)
#pragma unroll
      for (int m = 0; m < 4; ++m) {
        const size_t row = (size_t)(row0 + ai * HALF + m * 16);
#pragma unroll
        for (int bj = 0; bj < 2; ++bj) {
          const uint2 gq = *(const uint2*)(g8 + row * 3072 + br * 1024 + col0 + bj * HALF);
          u16* mp = mbuf + row * 1024 + col0 + bj * HALF;
          const f32x4 v0 = acc[ai][bj][m][0], v1 = acc[ai][bj][m][1];
          float r[8];
          r[0] = (float)(gq.x & 255u) * v0[0]; r[1] = (float)((gq.x >> 8) & 255u) * v0[1];
          r[2] = (float)((gq.x >> 16) & 255u) * v0[2]; r[3] = (float)(gq.x >> 24) * v0[3];
          r[4] = (float)(gq.y & 255u) * v1[0]; r[5] = (float)((gq.y >> 8) & 255u) * v1[1];
          r[6] = (float)((gq.y >> 16) & 255u) * v1[2]; r[7] = (float)(gq.y >> 24) * v1[3];
          u32x4 w;
          if (br == 0) {
            w.x = pk2(r[0] * (1.f / 255.f), r[1] * (1.f / 255.f)); w.y = pk2(r[2] * (1.f / 255.f), r[3] * (1.f / 255.f));
            w.z = pk2(r[4] * (1.f / 255.f), r[5] * (1.f / 255.f)); w.w = pk2(r[6] * (1.f / 255.f), r[7] * (1.f / 255.f));
          } else {
            const u32x4 o = *(const u32x4*)mp;
            w.x = pk2(bflo(o.x) + r[0] * (1.f / 255.f), bfhi(o.x) + r[1] * (1.f / 255.f));
            w.y = pk2(bflo(o.y) + r[2] * (1.f / 255.f), bfhi(o.y) + r[3] * (1.f / 255.f));
            w.z = pk2(bflo(o.z) + r[4] * (1.f / 255.f), bfhi(o.z) + r[5] * (1.f / 255.f));
            w.w = pk2(bflo(o.w) + r[6] * (1.f / 255.f), bfhi(o.w) + r[7] * (1.f / 255.f));
          }
          *(u32x4*)mp = w;
        }
      }
  }
};
struct EpiOut {
  static constexpr bool PERM = false;
  const float *xsrc, *csrc; float *xdst, *cdst; const float* modl;
  __device__ __forceinline__ void operator()(AccRef acc, const Unit& u, int wr, int wc, int fr, int fq) const {
    const bool isctx = (u.pm >= 128);
    const int bi = isctx ? 8 : (u.pm >> 4);
    const float* gatev = modl + ((size_t)bi * 6 + 2) * 1024;
    const float* src = isctx ? (csrc - (size_t)NLAT * 1024) : xsrc;
    float* dst = isctx ? (cdst - (size_t)NLAT * 1024) : xdst;
    const int row0 = u.pm * BM + wr * 64 + fr, col0 = u.pn * BM + wc * 32 + 4 * fq;
#pragma unroll
    for (int bj = 0; bj < 2; ++bj)
#pragma unroll
      for (int n = 0; n < 2; ++n) {
        const int col = col0 + bj * HALF + n * 16;
        const f32x4 gv = *(const f32x4*)(gatev + col);
#pragma unroll
        for (int ai = 0; ai < 2; ++ai)
#pragma unroll
          for (int m = 0; m < 4; ++m) {
            const size_t o = (size_t)(row0 + ai * HALF + m * 16) * 1024 + col;
            const f32x4 xv = *(const f32x4*)(src + o);
            *(f32x4*)(dst + o) = xv + gv * acc[ai][bj][m][n];
          }
      }
  }
};
struct EpiQ {
  static constexpr bool PERM = true;
  u16* q;
  __device__ __forceinline__ void operator()(AccRef acc, const Unit& u, int wr, int wc, int fr, int fq) const {
    const int row0 = u.pm * BM + wr * 64 + fr;
    const int col0 = u.pn * BM + wc * 32 + 8 * fq;
#pragma unroll
    for (int ai = 0; ai < 2; ++ai)
#pragma unroll
      for (int m = 0; m < 4; ++m) {
        u16* rowp = q + (size_t)(row0 + ai * HALF + m * 16) * 2048 + col0;
#pragma unroll
        for (int bj = 0; bj < 2; ++bj) {
          const f32x4 v0 = acc[ai][bj][m][0], v1 = acc[ai][bj][m][1];
          u32x4 w;
          w.x = __builtin_bit_cast(unsigned, __builtin_amdgcn_cvt_pkrtz(v0[0], v0[1]));
          w.y = __builtin_bit_cast(unsigned, __builtin_amdgcn_cvt_pkrtz(v0[2], v0[3]));
          w.z = __builtin_bit_cast(unsigned, __builtin_amdgcn_cvt_pkrtz(v1[0], v1[1]));
          w.w = __builtin_bit_cast(unsigned, __builtin_amdgcn_cvt_pkrtz(v1[2], v1[3]));
          *(u32x4*)(rowp + bj * HALF) = w;
        }
      }
  }
};
}

__device__ __forceinline__ void tr_tile(const float* __restrict__ src, int N, int K, u16* __restrict__ dst, int tile, char* smem) {
  float* lds = (float*)smem;
  const int tiles_n = N >> 6;
  const int tk = tile / tiles_n, tn = tile - tk * tiles_n;
  const int tid = opaque_tid();
  {
    const int r = tid >> 3, c8 = (tid & 7) * 8;
    const float* s = src + (size_t)(tk * 64 + r) * N + tn * 64 + c8;
    float4 a = *(const float4*)s, b = *(const float4*)(s + 4);
    float* d = lds + r * 65 + c8;
    d[0] = a.x; d[1] = a.y; d[2] = a.z; d[3] = a.w; d[4] = b.x; d[5] = b.y; d[6] = b.z; d[7] = b.w;
  }
  __syncthreads();
  {
    const int n = tid >> 3, k0 = (tid & 7) * 8;
    uint4 o;
    o.x = pk2(lds[(k0 + 0) * 65 + n], lds[(k0 + 1) * 65 + n]);
    o.y = pk2(lds[(k0 + 2) * 65 + n], lds[(k0 + 3) * 65 + n]);
    o.z = pk2(lds[(k0 + 4) * 65 + n], lds[(k0 + 5) * 65 + n]);
    o.w = pk2(lds[(k0 + 6) * 65 + n], lds[(k0 + 7) * 65 + n]);
    *(uint4*)(dst + (size_t)(tn * 64 + n) * K + tk * 64 + k0) = o;
  }
  __syncthreads();
}
__device__ __forceinline__ void cvt_chunk(const float* __restrict__ src, u16* __restrict__ dst, size_t chunk) {
  const size_t i = chunk * 4096 + (size_t)opaque_tid() * 8;
  float4 a = *(const float4*)(src + i), b = *(const float4*)(src + i + 4);
  uint4 o;
  o.x = pk2(a.x, a.y); o.y = pk2(a.z, a.w); o.z = pk2(b.x, b.y); o.w = pk2(b.z, b.w);
  *(uint4*)(dst + i) = o;
}
__device__ __forceinline__ void cvt_chunk_fp8(const float* __restrict__ src, unsigned char* __restrict__ dst, size_t chunk, float scale) {
  const size_t i = chunk * 4096 + (size_t)opaque_tid() * 8;
  const float4 a = *(const float4*)(src + i), b = *(const float4*)(src + i + 4);
  int w0 = __builtin_amdgcn_cvt_pk_fp8_f32(a.x * scale, a.y * scale, 0, false);
  w0 = __builtin_amdgcn_cvt_pk_fp8_f32(a.z * scale, a.w * scale, w0, true);
  int w1 = __builtin_amdgcn_cvt_pk_fp8_f32(b.x * scale, b.y * scale, 0, false);
  w1 = __builtin_amdgcn_cvt_pk_fp8_f32(b.z * scale, b.w * scale, w1, true);
  *(uint2*)(dst + i) = make_uint2((unsigned)w0, (unsigned)w1);
}
__device__ __forceinline__ void cvt_chunk_fp4(const float* __restrict__ src, unsigned char* __restrict__ dst, size_t chunk, float scale) {
  const size_t i = chunk * 4096 + (size_t)opaque_tid() * 8;
  const float4 a = *(const float4*)(src + i), b = *(const float4*)(src + i + 4);
  unsigned w = 0;
  w = __builtin_amdgcn_cvt_scalef32_pk_fp4_f32(w, a.x * scale, a.y * scale, 1.0f, 0);
  w = __builtin_amdgcn_cvt_scalef32_pk_fp4_f32(w, a.z * scale, a.w * scale, 1.0f, 1);
  w = __builtin_amdgcn_cvt_scalef32_pk_fp4_f32(w, b.x * scale, b.y * scale, 1.0f, 2);
  w = __builtin_amdgcn_cvt_scalef32_pk_fp4_f32(w, b.z * scale, b.w * scale, 1.0f, 3);
  *(unsigned*)(dst + (i >> 1)) = w;
}
__device__ __forceinline__ void phase_prep(const P& p, char* smem) {
  const int tid = opaque_tid();
  const int NTR = 2512;
  const int total = 2 * NTR + 128 + 384;
  for (int task = blockIdx.x; task < total; task += gridDim.x) {
    if (task < 2 * NTR) {
      const int l = task / NTR;
      int t = task - l * NTR;
      if (t < 704) tr_tile(p.w_in + (size_t)l * 1024 * 2816, 2816, 1024, p.WinT + (size_t)l * 2816 * 1024, t, smem);
      else if ((t -= 704) < 768) tr_tile(p.w_gate + (size_t)l * 1024 * 3072, 3072, 1024, p.WgT + (size_t)l * 3072 * 1024, t, smem);
      else if ((t -= 768) < 128) tr_tile(p.w_br_a + (size_t)l * 512 * 1024, 1024, 512, p.WaT + (size_t)l * 1024 * 512, t, smem);
      else if ((t -= 128) < 64) tr_tile(p.w_br_b + (size_t)l * 256 * 1024, 1024, 256, p.WbT + (size_t)l * 1024 * 256, t, smem);
      else if ((t -= 64) < 64) tr_tile(p.w_br_c + (size_t)l * 256 * 1024, 1024, 256, p.WcT + (size_t)l * 1024 * 256, t, smem);
      else if ((t -= 64) < 256) tr_tile(p.w_out + (size_t)l * 1024 * 1024, 1024, 1024, p.WoT + (size_t)l * 1024 * 1024, t, smem);
      else if ((t -= 256) < 512) cvt_chunk(p.peer_wq + (size_t)l * 1024 * 2048, p.WqB + (size_t)l * 1024 * 2048, (size_t)t);
      else {
        t -= 512;
        const int gate = t >> 3, dn = t & 7;
        const float* src = (gate ? p.rg_wx : p.rg_wa) + (size_t)(l * 8 + dn) * 4096;
        tr_tile(src, 64, 64, p.rgW + (size_t)((l * 2 + gate) * 8 + dn) * 4096, 0, smem);
      }
    } else if (task < 2 * NTR + 128) {
      cvt_chunk(p.peer_keys, p.keysB, (size_t)(task - 2 * NTR));
    } else {
      int t = task - 2 * NTR - 128;
      const int kc = t & 15; t >>= 4;
      const int jc = t % 12, l = t / 12;
      float* s = (float*)smem;
      for (int i = tid; i < 576; i += NTHR) {
        const int bi = i >> 6, kk = i & 63;
        const float v = (bi < 8) ? p.c[bi * 1024 + kc * 64 + kk] : p.c_ctx[kc * 64 + kk];
        s[i] = v / (1.0f + __expf(-v));
      }
      __syncthreads();
      const int j = jc * 512 + tid;
      float acc[9];
#pragma unroll
      for (int bi = 0; bi < 9; ++bi) acc[bi] = 0.f;
      const float* wp = p.w_ada + ((size_t)l * 1024 + kc * 64) * 6144 + j;
#pragma unroll 8
      for (int kk = 0; kk < 64; ++kk) {
        const float w = wp[(size_t)kk * 6144];
#pragma unroll
        for (int bi = 0; bi < 9; ++bi) acc[bi] += s[bi * 64 + kk] * w;
      }
#pragma unroll
      for (int bi = 0; bi < 9; ++bi) p.modpart[((size_t)(kc * 2 + l) * 9 + bi) * 6144 + j] = acc[bi];
      __syncthreads();
    }
  }
}
__device__ __forceinline__ void phase_modreduce(const P& p) {
  const int n = 2 * 9 * 6144;
  for (int i = blockIdx.x * NTHR + opaque_tid(); i < n; i += gridDim.x * NTHR) {
    const int l = i / (9 * 6144);
    const int j = i % 6144;
    float s = p.b_ada[l * 6144 + j];
#pragma unroll
    for (int kc = 0; kc < 16; ++kc) s += p.modpart[(size_t)kc * n + i];
    p.mod[i] = s;
  }
}

__device__ __forceinline__ void phase_norm(const P& p, int l, int which) {
  const int tid_ = opaque_tid(); const int lane = tid_ & 63, wid = tid_ >> 6;
  const int ntok = (which == 2 || (which == 1 && l == 1)) ? NLAT : NTOK;
  for (int row = blockIdx.x * 8 + wid; row < ntok; row += gridDim.x * 8) {
    const float* src;
    if (row < NLAT) src = ((which == 0 && l == 0) ? p.x : p.out) + (size_t)row * 1024;
    else src = ((which == 0 && l == 0) ? p.ctx : p.ctxs) + (size_t)(row - NLAT) * 1024;
    float4 v[4];
    float ss = 0.f;
#pragma unroll
    for (int i = 0; i < 4; ++i) {
      v[i] = *(const float4*)(src + i * 256 + lane * 4);
      ss += v[i].x * v[i].x + v[i].y * v[i].y + v[i].z * v[i].z + v[i].w * v[i].w;
    }
    ss = wave_sum(ss);
    const float rstd = rsqrtf(ss * (1.0f / 1024.0f) + 1e-6f);
    if (which == 2) {
#pragma unroll
      for (int i = 0; i < 4; ++i) {
        const int col = i * 256 + lane * 4;
        const float4 g = *(const float4*)(p.final_g + col);
        float4 o = {v[i].x * rstd * g.x, v[i].y * rstd * g.y, v[i].z * rstd * g.z, v[i].w * rstd * g.w};
        *(float4*)(p.out + (size_t)row * 1024 + col) = o;
      }
    } else {
      const int bi = row < NLAT ? (row >> 12) : 8;
      const float* gam = (which == 0 ? p.norm_mix_g : p.norm_ffn_g) + l * 1024;
      const float* msh = p.mod + ((size_t)(l * 9 + bi) * 6 + (which == 0 ? 0 : 3)) * 1024;
      const float* msc = msh + 1024;
#pragma unroll
      for (int i = 0; i < 4; ++i) {
        const int col = i * 256 + lane * 4;
        const float4 g = *(const float4*)(gam + col);
        const float4 sh = *(const float4*)(msh + col);
        const float4 sc = *(const float4*)(msc + col);
        uint2 o;
        o.x = pk2(v[i].x * rstd * g.x * (1.f + sc.x) + sh.x, v[i].y * rstd * g.y * (1.f + sc.y) + sh.y);
        o.y = pk2(v[i].z * rstd * g.z * (1.f + sc.z) + sh.z, v[i].w * rstd * g.w * (1.f + sc.w) + sh.w);
        *(uint2*)(p.xn + (size_t)row * 1024 + col) = o;
      }
    }
  }
}

__device__ __forceinline__ void filter_wave(const P& p, int l, int L, int t, float* __restrict__ outp) {
  const int lane = opaque_tid() & 63;
  const float tl = (float)t / (float)(L - 1);
  const float wang = (6.283185307179586f / (float)L) * (float)t;
  float z = 0.f;
  if (lane == 0) z = tl;
  else if (lane <= 16) { const float band = 1e-4f + (float)(lane - 1) * ((15.0f - 1e-4f) / 15.0f); z = cosf(band * wang); }
  else if (lane <= 32) { const float band = 1e-4f + (float)(lane - 17) * ((15.0f - 1e-4f) / 15.0f); z = -sinf(band * wang); }
  float a1 = p.hy_f1_b[l * 64 + lane];
  for (int i = 0; i < 33; ++i) a1 += shf(z, i) * p.hy_f1_w[(l * 33 + i) * 64 + lane];
  const float h1 = sinf(p.hy_freq[l * 128 + lane] * a1);
  float a2 = p.hy_f2_b[l * 64 + lane];
  for (int i = 0; i < 64; ++i) a2 += shf(h1, i) * p.hy_f2_w[(l * 64 + i) * 64 + lane];
  const float h2 = sinf(p.hy_freq[l * 128 + 64 + lane] * a2);
  float a3[8];
#pragma unroll
  for (int m = 0; m < 8; ++m) a3[m] = 0.f;
  for (int i = 0; i < 64; ++i) {
    const float hv = shf(h2, i);
    const float* wr = p.hy_f3_w + (size_t)(l * 64 + i) * 512 + lane;
#pragma unroll
    for (int m = 0; m < 8; ++m) a3[m] += hv * wr[m * 64];
  }
  const float LN100 = 4.605170185988092f;
  const float d0 = LN100 / 1.5f, d1 = LN100 / 0.3f;
#pragma unroll
  for (int m = 0; m < 8; ++m) {
    const int cp = lane + 64 * m;
    const int ch = cp & 255;
    const float delta = d0 + (float)ch * ((d1 - d0) / 255.0f);
    outp[(size_t)cp * L + t] = a3[m] * expf(-tl * delta);
  }
}
__device__ __forceinline__ void phase_filters(const P& p, int l) {
  const int wid = opaque_tid() >> 6;
  const int ntask = 4096 + (l == 0 ? 256 : 0);
  for (int t = blockIdx.x * 8 + wid; t < ntask; t += gridDim.x * 8) {
    if (t < 4096) filter_wave(p, l, 4096, t, p.hT + (size_t)l * 512 * 4096);
    else filter_wave(p, l, 256, t - 4096, p.hc);
  }
}
__device__ __forceinline__ void kf_task(const P& p, int l, int c, char* smem) {
  const float* hTl = p.hT + (size_t)l * 512 * 4096;
  c2* buf = (c2*)smem;
  const int tid = opaque_tid();
  for (int i = 0; i < 16; ++i) {
    const int j = tid + NTHR * i;
    float v;
    if (j < 4096) v = hTl[(size_t)c * 4096 + j];
    else if (j == 4096) v = 0.f;
    else v = hTl[(size_t)(256 + c) * 4096 + (8192 - j)];
    buf[j] = {v, 0.f};
  }
  __syncthreads();
  fft8192(buf, -1.f);
  c2* o = (c2*)p.Kf + ((size_t)l * 256 + c) * 8192;
  for (int i = 0; i < 16; ++i) { const int j = tid + NTHR * i; o[j] = buf[j]; }
  __syncthreads();
}

__device__ __forceinline__ void inproj_tile(const P& p, int l, int mt, int nt, char* smem) {
  f32x16 acc[2][2];
  zero_acc(acc);
  const int m0 = mt * 256, n0 = nt * 128;
  gemm_kloop(acc, p.xn + (size_t)m0 * 1024, 1024, p.WinT + ((size_t)l * 2816 + n0) * 1024, 1024, 1024, smem);
  EPI_VARS
  if (nt < 8 || nt >= 18) {
    u16* dst; int ld, cbase;
    if (nt < 8) { dst = p.qk; ld = 1024; cbase = n0; }
    else { dst = p.rg; ld = 512; cbase = n0 - 2304; }
#pragma unroll
    for (int i = 0; i < 2; ++i)
#pragma unroll
      for (int j = 0; j < 2; ++j)
#pragma unroll
        for (int e = 0; e < 16; ++e)
          dst[(size_t)(m0 + EPI_ROW(i, e)) * ld + cbase + EPI_COL(j)] = f2bf(acc[i][j][e]);
  } else {
#pragma unroll
    for (int i = 0; i < 2; ++i)
#pragma unroll
      for (int j = 0; j < 2; ++j)
#pragma unroll
        for (int qd = 0; qd < 4; ++qd) {
          uint2 o;
          o.x = pk2(acc[i][j][4 * qd + 0], acc[i][j][4 * qd + 1]);
          o.y = pk2(acc[i][j][4 * qd + 2], acc[i][j][4 * qd + 3]);
          const int row0 = wm * 64 + i * 32 + 8 * qd + 4 * hh;
          *(uint2*)(smem + EPI_COL(j) * 520 + row0 * 2) = o;
        }
    __syncthreads();
    u16* dstT; int Lseg, t0, ncol0, nc;
    const bool isctx = (mt >= 128);
    const int b = isctx ? (mt - 128) : (mt >> 4);
    if (nt < 12) { ncol0 = n0 - 1024; nc = 512; dstT = isctx ? p.vTc : p.vT; }
    else { ncol0 = n0 - 1536; nc = 768; dstT = isctx ? p.hyTc : p.hyT; }
    if (isctx) { Lseg = 256; t0 = 0; } else { Lseg = 4096; t0 = (mt & 15) * 256; }
#pragma unroll 4
    for (int it = 0; it < 16; ++it) {
      const int idx = tid + NTHR * it;
      const int col = idx >> 6, u = idx & 63;
      const uint2 v = *(const uint2*)(smem + col * 520 + u * 8);
      *(uint2*)(dstT + ((size_t)(b * nc + ncol0 + col)) * Lseg + t0 + u * 4) = v;
    }
    __syncthreads();
  }
}

__device__ __forceinline__ float ldbf(const u16* p, int t, int L) { return (t >= 0 && t < L) ? bf2f(p[t]) : 0.f; }
__device__ __forceinline__ void ld10(const u16* __restrict__ seq, int t0, float (&v)[10]) {
  const uint4 r = *(const uint4*)(seq + t0);
  v[0] = (t0 > 0) ? bf2f(seq[t0 - 1]) : 0.f;
  v[9] = (t0 + 8 < 4096) ? bf2f(seq[t0 + 8]) : 0.f;
  v[1] = bflo(r.x); v[2] = bfhi(r.x); v[3] = bflo(r.y); v[4] = bfhi(r.y);
  v[5] = bflo(r.z); v[6] = bfhi(r.z); v[7] = bflo(r.w); v[8] = bfhi(r.w);
}
__device__ __forceinline__ void hyena_fft_task(const P& p, int l, int c, int bp, char* smem) {
  c2* buf = (c2*)smem;
  c2* ub = (c2*)(smem + 65536);
  const int tid = opaque_tid();
  const float* sw = p.hy_short_w + l * 3 * 768;
  const float* sb = p.hy_short_b + l * 768;
  const float wx0[3] = {sw[c], sw[768 + c], sw[1536 + c]};
  const float wx1[3] = {sw[256 + c], sw[768 + 256 + c], sw[1536 + 256 + c]};
  const float wv[3] = {sw[512 + c], sw[768 + 512 + c], sw[1536 + 512 + c]};
  const float bx0 = sb[c], bx1 = sb[256 + c], bv = sb[512 + c];
  const float dsk = p.hy_bias[l * 256 + c];
  const int t0 = tid * 8;
  {
    float u[2][8];
#pragma unroll
    for (int bb = 0; bb < 2; ++bb) {
      const int b = 2 * bp + bb;
      float x1[10], vv[10];
      ld10(p.hyT + ((size_t)(b * 768 + 256 + c)) * 4096, t0, x1);
      ld10(p.hyT + ((size_t)(b * 768 + 512 + c)) * 4096, t0, vv);
#pragma unroll
      for (int k = 0; k < 8; ++k) {
        const float x1c = bx1 + wx1[0] * x1[k] + wx1[1] * x1[k + 1] + wx1[2] * x1[k + 2];
        const float vc = bv + wv[0] * vv[k] + wv[1] * vv[k + 1] + wv[2] * vv[k + 2];
        u[bb][k] = vc * x1c;
      }
    }
#pragma unroll
    for (int k = 0; k < 8; k += 2) {
      const float4 w = make_float4(u[0][k], u[1][k], u[0][k + 1], u[1][k + 1]);
      *(float4*)(buf + t0 + k) = w;
      *(float4*)(ub + t0 + k) = w;
      *(float4*)(buf + 4096 + t0 + k) = make_float4(0.f, 0.f, 0.f, 0.f);
    }
  }
  __syncthreads();
  fft8192(buf, -1.f);
  const c2* kf = (const c2*)p.Kf + ((size_t)l * 256 + c) * 8192;
  for (int i = 0; i < 16; ++i) {
    const int k = tid + NTHR * i;
    buf[k] = cmul(buf[k], kf[k]);
  }
  __syncthreads();
  fft8192(buf, 1.f);
#pragma unroll
  for (int bb = 0; bb < 2; ++bb) {
    const int b = 2 * bp + bb;
    float x0[10];
    ld10(p.hyT + ((size_t)(b * 768 + c)) * 4096, t0, x0);
    float o[8];
#pragma unroll
    for (int k = 0; k < 8; ++k) {
      const c2 y = buf[t0 + k];
      const c2 uu = ub[t0 + k];
      const float x0c = bx0 + wx0[0] * x0[k] + wx0[1] * x0[k + 1] + wx0[2] * x0[k + 2];
      const float yy = ldexpf(bb ? y.y : y.x, -13);
      const float uv = bb ? uu.y : uu.x;
      o[k] = x0c * (yy + uv * dsk);
    }
    uint4 w; w.x = pk2(o[0], o[1]); w.y = pk2(o[2], o[3]); w.z = pk2(o[4], o[5]); w.w = pk2(o[6], o[7]);
    *(uint4*)(p.ybT + ((size_t)(b * 256 + c)) * 4096 + t0) = w;
  }
  __syncthreads();
}
__device__ __forceinline__ void yb_transpose_task(const P& p, int b, int tb, char* smem) {
  const int tid = opaque_tid(), lane = tid & 63, wid = tid >> 6;
  u16* T = (u16*)smem;
#pragma unroll
  for (int it = 0; it < 4; ++it) {
    const int id = tid + NTHR * it;
    const int c = id >> 3, ch = id & 7;
    const uint4 r = *(const uint4*)(p.ybT + ((size_t)(b * 256 + c)) * 4096 + tb * 64 + ch * 8);
    unsigned* d = (unsigned*)(T + c * 66 + ch * 8);
    d[0] = r.x; d[1] = r.y; d[2] = r.z; d[3] = r.w;
  }
  __syncthreads();
#pragma unroll
  for (int it = 0; it < 8; ++it) {
    const int tt = wid + 8 * it;
    const int c0 = lane * 4;
    uint2 w;
    w.x = (unsigned)T[(c0 + 0) * 66 + tt] | ((unsigned)T[(c0 + 1) * 66 + tt] << 16);
    w.y = (unsigned)T[(c0 + 2) * 66 + tt] | ((unsigned)T[(c0 + 3) * 66 + tt] << 16);
    *(uint2*)(p.ycat + (size_t)(b * 4096 + tb * 64 + tt) * 1024 + 512 + c0) = w;
  }
  __syncthreads();
}
__device__ __forceinline__ void hyena_ctx_task(const P& p, int l, int b, int cg8, char* smem) {
  const int tid_ = opaque_tid(); const int lane = tid_ & 63, wid = tid_ >> 6;
  const int c = cg8 * 8 + wid;
  float* us = (float*)smem + wid * 1024;
  float* kfp = us + 256 + 255;
  const float* sw = p.hy_short_w + l * 3 * 768;
  const float* sb = p.hy_short_b + l * 768;
  const u16* x0 = p.hyTc + ((size_t)(b * 768 + c)) * 256;
  const u16* x1 = p.hyTc + ((size_t)(b * 768 + 256 + c)) * 256;
  const u16* vv = p.hyTc + ((size_t)(b * 768 + 512 + c)) * 256;
  for (int i = 0; i < 4; ++i) {
    const int t = lane + 64 * i;
    const float x1c = sb[256 + c] + sw[256 + c] * ldbf(x1, t - 1, 256) + sw[768 + 256 + c] * ldbf(x1, t, 256) + sw[1536 + 256 + c] * ldbf(x1, t + 1, 256);
    const float vc = sb[512 + c] + sw[512 + c] * ldbf(vv, t - 1, 256) + sw[768 + 512 + c] * ldbf(vv, t, 256) + sw[1536 + 512 + c] * ldbf(vv, t + 1, 256);
    us[t] = vc * x1c;
    kfp[t] = p.hc[(size_t)c * 256 + t];
    if (t > 0) kfp[-t] = p.hc[(size_t)(256 + c) * 256 + t];
  }
  __syncthreads();
  const float dsk = p.hy_bias[l * 256 + c];
  float acc[4] = {0.f, 0.f, 0.f, 0.f};
  for (int s = 0; s < 256; ++s) {
    const float uv = us[s];
#pragma unroll
    for (int i = 0; i < 4; ++i) acc[i] += kfp[lane + 64 * i - s] * uv;
  }
#pragma unroll
  for (int i = 0; i < 4; ++i) {
    const int t = lane + 64 * i;
    const float x0c = sb[c] + sw[c] * ldbf(x0, t - 1, 256) + sw[768 + c] * ldbf(x0, t, 256) + sw[1536 + c] * ldbf(x0, t + 1, 256);
    p.ycat[(size_t)(NLAT + b * 256 + t) * 1024 + 512 + c] = f2bf(x0c * (acc[i] + us[t] * dsk));
  }
  __syncthreads();
}

__device__ __forceinline__ void rg_chunk_task(const P& p, int l, int cq, int nblk, int mode, bool last, char* smem) {
  const int tid = opaque_tid(), lane = tid & 63, wid = tid >> 6;
  const int l31 = lane & 31, hh = lane >> 5;
  const int b = cq / 68, rr = cq - b * 68;
  const int seg = rr < 4 ? 0 : 1, sub = rr < 4 ? rr : rr - 4;
  if (mode == 1 && seg == 0 && last) return;
  float* xcf = (float*)smem;
  char* xcb = smem + 16384;
  float* coef = (float*)(smem + 24576);
  float2* segagg = (float2*)(smem + 90112);
  float* hin = (float*)(smem + 94208);
  float* Hout = (float*)(smem + 94720);
  const int Lseg = seg ? 4096 : 256;
  const int tokbase = seg ? b * 4096 : NLAT + b * 256;
  const int T0 = sub * 64;
  const int tt = tid >> 3, c0 = (tid & 7) * 8;
  const int chb = nblk * 64 + c0;
  const int wdir = wid >> 2, wgate = (wid >> 1) & 1, wmt = wid & 1;
  bf16x8 wf[2][4];
  {
    const u16* wp = p.rgW + (size_t)(((l * 2 + wgate) * 2 + wdir) * 4 + nblk) * 4096 + l31 * 64 + 8 * hh;
#pragma unroll
    for (int nt = 0; nt < 2; ++nt)
#pragma unroll
      for (int s = 0; s < 4; ++s) wf[nt][s] = *(const bf16x8*)(wp + nt * 2048 + 16 * s);
  }
  {
    float xc[8];
#pragma unroll
    for (int c = 0; c < 8; ++c) xc[c] = p.rg_conv_b[l * 256 + chb + c];
#pragma unroll
    for (int k = 0; k < 4; ++k) {
      const int pos = T0 + tt + k - 2;
      if (pos >= 0 && pos < Lseg) {
        const uint4 raw = *(const uint4*)(p.rg + (size_t)(tokbase + pos) * 512 + chb);
        const float4 w0 = *(const float4*)(p.rg_conv_w + (l * 4 + k) * 256 + chb);
        const float4 w1 = *(const float4*)(p.rg_conv_w + (l * 4 + k) * 256 + chb + 4);
        xc[0] += w0.x * bflo(raw.x); xc[1] += w0.y * bfhi(raw.x);
        xc[2] += w0.z * bflo(raw.y); xc[3] += w0.w * bfhi(raw.y);
        xc[4] += w1.x * bflo(raw.z); xc[5] += w1.y * bfhi(raw.z);
        xc[6] += w1.z * bflo(raw.w); xc[7] += w1.w * bfhi(raw.w);
      }
    }
    *(float4*)(xcf + tt * 64 + c0) = make_float4(xc[0], xc[1], xc[2], xc[3]);
    *(float4*)(xcf + tt * 64 + c0 + 4) = make_float4(xc[4], xc[5], xc[6], xc[7]);
    uint4 o;
    o.x = pk2(xc[0], xc[1]); o.y = pk2(xc[2], xc[3]); o.z = pk2(xc[4], xc[5]); o.w = pk2(xc[6], xc[7]);
    *(uint4*)(xcb + swz128(tt, tid & 7)) = o;
  }
  __syncthreads();
  {
    f32x16 acc0 = zero16(), acc1 = zero16();
#pragma unroll
    for (int s = 0; s < 4; ++s) {
      const bf16x8 af = *(const bf16x8*)(xcb + swz128(wmt * 32 + l31, 2 * s + hh));
      acc0 = mfma32(af, wf[0][s], acc0);
      acc1 = mfma32(af, wf[1][s], acc1);
    }
    float* cp = coef + (wdir * 2 + wgate) * 4096;
#pragma unroll
    for (int e = 0; e < 16; ++e) {
      const int tok = wmt * 32 + (e & 3) + 8 * (e >> 2) + 4 * hh;
      cp[tok * 64 + l31] = acc0[e];
      cp[tok * 64 + 32 + l31] = acc1[e];
    }
  }
  __syncthreads();
#pragma unroll
  for (int dir = 0; dir < 2; ++dir) {
    float* ca = coef + (dir * 2) * 4096;
    float* cb2 = ca + 4096;
#pragma unroll
    for (int c = 0; c < 8; ++c) {
      const int ch = (l * 2 + dir) * 256 + chb + c;
      const float sp = __logf(1.0f + __expf(-p.rg_lambda[ch]));
      const int o = tt * 64 + c0 + c;
      const float r = sigmoidf_(ca[o] + p.rg_ba[ch]);
      const float ii = sigmoidf_(cb2[o] + p.rg_bx[ch]);
      const float la = -8.0f * r * sp;
      const float av = __expf(la);
      const float e2 = 2.0f * la;
      const float om = (e2 > -0.1f) ? (-e2 * (1.0f + e2 * (0.5f + e2 * (0.16666667f + e2 * 0.041666668f)))) : (1.0f - __expf(e2));
      ca[o] = av;
      cb2[o] = sqrtf(om) * ii * xcf[o];
    }
  }
  __syncthreads();
  const int sg = tid >> 7, sdir = (tid >> 6) & 1, sch = tid & 63;
  const float* sa = coef + (sdir * 2) * 4096 + sch;
  const float* sb = sa + 4096;
  {
    float Pm = 1.f, H = 0.f;
#pragma unroll
    for (int n = 0; n < 16; ++n) {
      const int tok = sdir ? (63 - (16 * sg + n)) : (16 * sg + n);
      const float av = sa[tok * 64], bv = sb[tok * 64];
      H = av * H + bv;
      Pm *= av;
    }
    segagg[(sg * 2 + sdir) * 64 + sch] = make_float2(Pm, H);
  }
  __syncthreads();
  const int pos = sdir ? (seg == 0 ? 3 - sub : 67 - sub) : (seg == 0 ? sub : 4 + sub);
  float2* aggp = (float2*)p.agg + ((size_t)(b * 2 + sdir) * 68) * 256 + nblk * 64 + sch;
  if (mode == 0) {
    if (tid < 128) {
      float A = 1.f, B = 0.f;
#pragma unroll
      for (int s2 = 0; s2 < 4; ++s2) {
        const float2 g = segagg[(s2 * 2 + sdir) * 64 + sch];
        B = g.x * B + g.y;
        A *= g.x;
      }
      aggp[(size_t)pos * 256] = make_float2(A, B);
    }
    __syncthreads();
    return;
  }
  if (tid < 128) {
    float h = 0.f;
    int j = 0;
    for (; j + 8 <= pos; j += 8) {
      float2 g[8];
#pragma unroll
      for (int u = 0; u < 8; ++u) g[u] = aggp[(size_t)(j + u) * 256];
#pragma unroll
      for (int u = 0; u < 8; ++u) h = g[u].x * h + g[u].y;
    }
    for (; j < pos; ++j) {
      const float2 g = aggp[(size_t)j * 256];
      h = g.x * h + g.y;
    }
    hin[sdir * 64 + sch] = h;
  }
  __syncthreads();
  {
    float h = hin[sdir * 64 + sch];
    for (int s2 = 0; s2 < sg; ++s2) {
      const float2 g = segagg[(s2 * 2 + sdir) * 64 + sch];
      h = g.x * h + g.y;
    }
#pragma unroll
    for (int n = 0; n < 16; ++n) {
      const int tok = sdir ? (63 - (16 * sg + n)) : (16 * sg + n);
      h = sa[tok * 64] * h + sb[tok * 64];
      Hout[sdir * 4096 + tok * 64 + sch] = h;
    }
  }
  __syncthreads();
  {
    const size_t gtok = (size_t)tokbase + T0 + tt;
    const float4 f0 = *(const float4*)(Hout + tt * 64 + c0), f1 = *(const float4*)(Hout + tt * 64 + c0 + 4);
    const float4 h0 = *(const float4*)(Hout + 4096 + tt * 64 + c0), h1 = *(const float4*)(Hout + 4096 + tt * 64 + c0 + 4);
    const uint4 g = *(const uint4*)(p.rg + gtok * 512 + 256 + chb);
    uint4 o;
    o.x = pk2((f0.x + h0.x) * gelu_tanh(bflo(g.x)), (f0.y + h0.y) * gelu_tanh(bfhi(g.x)));
    o.y = pk2((f0.z + h0.z) * gelu_tanh(bflo(g.y)), (f0.w + h0.w) * gelu_tanh(bfhi(g.y)));
    o.z = pk2((f1.x + h1.x) * gelu_tanh(bflo(g.z)), (f1.y + h1.y) * gelu_tanh(bfhi(g.z)));
    o.w = pk2((f1.z + h1.z) * gelu_tanh(bflo(g.w)), (f1.w + h1.w) * gelu_tanh(bfhi(g.w)));
    *(uint4*)(p.ycat + gtok * 1024 + 768 + chb) = o;
  }
  __syncthreads();
}

__device__ __forceinline__ void attn_wave(const P& p, int l, int b, int h, bool local, int r, int half, int qtok0, const float* rpbL) {
  const int lane = opaque_tid() & 63, q = lane & 31, hh = lane >> 5;
  bf16x8 qf[4];
  {
    const u16* qp = p.qk + (size_t)(qtok0 + q) * 1024 + h * 64 + 8 * hh;
#pragma unroll
    for (int s = 0; s < 4; ++s) qf[s] = *(const bf16x8*)(qp + 16 * s);
  }
  f32x16 o0 = zero16(), o1 = zero16();
  float m_run = -1e30f, l_run = 0.f;
  const int pi = (q & 19) | ((q & 4) << 1) | ((q & 8) >> 1);
  const int w = half * 32 + q;
  const int st = min(max(w - 8, 0), 48);
  const int rs = min(max(r - 4, 0), 56);
  const int ntiles = local ? 24 : 8;
  bf16x8 kfn[4], vfn[2][2];
  auto tile_load = [&](int ti, bf16x8 (&kfo)[4], bf16x8 (&vfo)[2][2]) {
    int ktok0, vstride;
    const u16* vb;
    if (ti < 8) {
      ktok0 = NLAT + b * 256 + ti * 32;
      vb = p.vTc + ((size_t)(b * 512 + h * 64)) * 256 + ti * 32;
      vstride = 256;
    } else {
      const int tl = ti - 8;
      const int a2 = tl >> 1, g2 = tl & 1;
      ktok0 = b * 4096 + (rs + a2) * 64 + g2 * 32;
      vb = p.vT + ((size_t)(b * 512 + h * 64)) * 4096 + (rs + a2) * 64 + g2 * 32;
      vstride = 4096;
    }
    const u16* kp = p.qk + (size_t)(ktok0 + pi) * 1024 + 512 + h * 64 + 8 * hh;
#pragma unroll
    for (int s = 0; s < 4; ++s) kfo[s] = *(const bf16x8*)(kp + 16 * s);
#pragma unroll
    for (int dt = 0; dt < 2; ++dt)
#pragma unroll
      for (int s2 = 0; s2 < 2; ++s2) vfo[dt][s2] = *(const bf16x8*)(vb + (size_t)(dt * 32 + q) * vstride + 16 * s2 + 8 * hh);
  };
  tile_load(0, kfn, vfn);
  for (int ti = 0; ti < ntiles; ++ti) {
    int a = 0, g = 0;
    if (ti >= 8) { a = (ti - 8) >> 1; g = (ti - 8) & 1; }
    bf16x8 kf[4], vf[2][2];
#pragma unroll
    for (int s = 0; s < 4; ++s) kf[s] = kfn[s];
#pragma unroll
    for (int dt = 0; dt < 2; ++dt)
#pragma unroll
      for (int s2 = 0; s2 < 2; ++s2) vf[dt][s2] = vfn[dt][s2];
    if (ti + 1 < ntiles) tile_load(ti + 1, kfn, vfn);
    f32x16 sacc = zero16();
#pragma unroll
    for (int s = 0; s < 4; ++s) sacc = mfma32(kf[s], qf[s], sacc);
    float sv[16];
    float tmax = -1e30f;
#pragma unroll
    for (int e = 0; e < 16; ++e) {
      float x = sacc[e] * 0.125f;
      if (ti >= 8) {
        const int kc = g * 32 + (e & 7) + 8 * hh + 16 * (e >> 3);
        const bool valid = (kc >= st) && (kc < st + 16);
        const int bi = valid ? ((rs + a - r + 7) * 31 + (kc - w + 15)) : 0;
        const float bias = rpbL[bi];
        x = valid ? (x + bias) : -1e30f;
      }
      sv[e] = x;
      tmax = fmaxf(tmax, x);
    }
    tmax = fmaxf(tmax, shx(tmax, 32));
    const float m_new = fmaxf(m_run, tmax);
    const float alpha = __expf(m_run - m_new);
    m_run = m_new;
    l_run *= alpha;
#pragma unroll
    for (int e = 0; e < 16; ++e) { o0[e] *= alpha; o1[e] *= alpha; }
    float psum = 0.f;
#pragma unroll
    for (int e = 0; e < 16; ++e) { const float pe = __expf(sv[e] - m_new); sv[e] = pe; psum += pe; }
    l_run += psum;
    bf16x8 pf[2];
#pragma unroll
    for (int s2 = 0; s2 < 2; ++s2) {
      union { bf16x8 v; unsigned u[4]; } cv;
#pragma unroll
      for (int j = 0; j < 4; ++j) cv.u[j] = pk2(sv[8 * s2 + 2 * j], sv[8 * s2 + 2 * j + 1]);
      pf[s2] = cv.v;
    }
#pragma unroll
    for (int s2 = 0; s2 < 2; ++s2) {
      o0 = mfma32(vf[0][s2], pf[s2], o0);
      o1 = mfma32(vf[1][s2], pf[s2], o1);
    }
  }
  const float lt = l_run + shx(l_run, 32);
  const float inv = 1.0f / lt;
  u16* op = p.ycat + (size_t)(qtok0 + q) * 1024 + h * 64;
#pragma unroll
  for (int qd = 0; qd < 4; ++qd) {
    uint2 a0, a1;
    a0.x = pk2(o0[4 * qd] * inv, o0[4 * qd + 1] * inv);
    a0.y = pk2(o0[4 * qd + 2] * inv, o0[4 * qd + 3] * inv);
    a1.x = pk2(o1[4 * qd] * inv, o1[4 * qd + 1] * inv);
    a1.y = pk2(o1[4 * qd + 2] * inv, o1[4 * qd + 3] * inv);
    *(uint2*)(op + 8 * qd + 4 * hh) = a0;
    *(uint2*)(op + 32 + 8 * qd + 4 * hh) = a1;
  }
}
__device__ __forceinline__ void attn_block_task(const P& p, int l, int b, int h, int rg4, char* smem) {
  const int tid = opaque_tid(), lane = tid & 63, wid = tid >> 6;
  const int q = lane & 31, hh = lane >> 5;
  const int R0 = rg4 * 4;
  const int r = R0 + (wid >> 1), half = wid & 1;
  float* rpbL = (float*)(smem + 32768);
  for (int i = tid; i < 465; i += NTHR) rpbL[i] = p.na_rpb[(size_t)(l * 8 + h) * 465 + i];
  const int lo = min(max(R0 - 4, 0), 56);
  const int hi = min(max(R0 + 3 - 4, 0), 56) + 7;
  const int ntile = 4 + (hi - lo + 1);
  const int rs = min(max(r - 4, 0), 56);
  const int qtok = b * 4096 + r * 64 + half * 32 + q;
  bf16x8 qf[4];
  {
    const u16* qp = p.qk + (size_t)qtok * 1024 + h * 64 + 8 * hh;
#pragma unroll
    for (int s = 0; s < 4; ++s) qf[s] = *(const bf16x8*)(qp + 16 * s);
  }
  f32x16 o0 = zero16(), o1 = zero16();
  float m_run = -1e30f, l_run = 0.f;
  const int pi = (q & 19) | ((q & 4) << 1) | ((q & 8) >> 1);
  const int w = half * 32 + q;
  const int st = min(max(w - 8, 0), 48);
  const int srow = tid >> 3, sch = tid & 7;
  uint4 rk, rv;
  auto gload = [&](int ti) {
    int ktok0, vstride;
    const u16* vb;
    if (ti < 4) { ktok0 = NLAT + b * 256 + ti * 64; vb = p.vTc + ((size_t)(b * 512 + h * 64)) * 256 + ti * 64; vstride = 256; }
    else { const int R = lo + ti - 4; ktok0 = b * 4096 + R * 64; vb = p.vT + ((size_t)(b * 512 + h * 64)) * 4096 + R * 64; vstride = 4096; }
    rk = *(const uint4*)(p.qk + (size_t)(ktok0 + srow) * 1024 + 512 + h * 64 + sch * 8);
    rv = *(const uint4*)(vb + (size_t)srow * vstride + sch * 8);
  };
  gload(0);
  *(uint4*)(smem + swz128(srow, sch)) = rk;
  *(uint4*)(smem + 16384 + swz128(srow, sch)) = rv;
  __syncthreads();
  for (int ti = 0; ti < ntile; ++ti) {
    const bool more = (ti + 1 < ntile);
    if (more) gload(ti + 1);
    const char* Kb = smem + (ti & 1) * 8192;
    const char* Vb = smem + 16384 + (ti & 1) * 8192;
    const int R = lo + ti - 4;
    const bool active = (ti < 4) || (R >= rs && R < rs + 8);
    if (active) {
#pragma unroll
      for (int g = 0; g < 2; ++g) {
        f32x16 sacc = zero16();
#pragma unroll
        for (int s = 0; s < 4; ++s) {
          const bf16x8 kf = *(const bf16x8*)(Kb + swz128(g * 32 + pi, 2 * s + hh));
          sacc = mfma32(kf, qf[s], sacc);
        }
        float sv[16];
        float tmax = -1e30f;
#pragma unroll
        for (int e = 0; e < 16; ++e) {
          float x = sacc[e] * 0.125f;
          if (ti >= 4) {
            const int kc = g * 32 + (e & 7) + 8 * hh + 16 * (e >> 3);
            const bool valid = (kc >= st) && (kc < st + 16);
            const int bi = valid ? ((R - r + 7) * 31 + (kc - w + 15)) : 0;
            const float bias = rpbL[bi];
            x = valid ? (x + bias) : -1e30f;
          }
          sv[e] = x;
          tmax = fmaxf(tmax, x);
        }
        tmax = fmaxf(tmax, shx(tmax, 32));
        const float m_new = fmaxf(m_run, tmax);
        const float alpha = __expf(m_run - m_new);
        m_run = m_new;
        l_run *= alpha;
#pragma unroll
        for (int e = 0; e < 16; ++e) { o0[e] *= alpha; o1[e] *= alpha; }
        float psum = 0.f;
#pragma unroll
        for (int e = 0; e < 16; ++e) { const float pe = __expf(sv[e] - m_new); sv[e] = pe; psum += pe; }
        l_run += psum;
#pragma unroll
        for (int s2 = 0; s2 < 2; ++s2) {
          union { bf16x8 v; unsigned u[4]; } cv;
#pragma unroll
          for (int j = 0; j < 4; ++j) cv.u[j] = pk2(sv[8 * s2 + 2 * j], sv[8 * s2 + 2 * j + 1]);
          const bf16x8 v0 = *(const bf16x8*)(Vb + swz128(q, g * 4 + 2 * s2 + hh));
          const bf16x8 v1 = *(const bf16x8*)(Vb + swz128(32 + q, g * 4 + 2 * s2 + hh));
          o0 = mfma32(v0, cv.v, o0);
          o1 = mfma32(v1, cv.v, o1);
        }
      }
    }
    if (more) {
      *(uint4*)(smem + ((ti + 1) & 1) * 8192 + swz128(srow, sch)) = rk;
      *(uint4*)(smem + 16384 + ((ti + 1) & 1) * 8192 + swz128(srow, sch)) = rv;
    }
    __syncthreads();
  }
  const float lt = l_run + shx(l_run, 32);
  const float inv = 1.0f / lt;
  u16* op = p.ycat + (size_t)qtok * 1024 + h * 64;
#pragma unroll
  for (int qd = 0; qd < 4; ++qd) {
    uint2 a0, a1;
    a0.x = pk2(o0[4 * qd] * inv, o0[4 * qd + 1] * inv);
    a0.y = pk2(o0[4 * qd + 2] * inv, o0[4 * qd + 3] * inv);
    a1.x = pk2(o1[4 * qd] * inv, o1[4 * qd + 1] * inv);
    a1.y = pk2(o1[4 * qd + 2] * inv, o1[4 * qd + 3] * inv);
    *(uint2*)(op + 8 * qd + 4 * hh) = a0;
    *(uint2*)(op + 32 + 8 * qd + 4 * hh) = a1;
  }
}
__device__ __forceinline__ void attn_task(const P& p, int l, int kind, int idx, char* smem) {
  const int tid_ = opaque_tid(); const int lane = tid_ & 63, wid = tid_ >> 6;
  float* rpbL = (float*)smem + wid * 480;
  for (int i = lane; i < 465; i += 64) rpbL[i] = p.na_rpb[(size_t)(l * 8 + wid) * 465 + i];
  __syncthreads();
  if (kind == 0) {
    const int half = idx & 1, r = (idx >> 1) & 63, b = idx >> 7;
    attn_wave(p, l, b, wid, true, r, half, b * 4096 + r * 64 + half * 32, rpbL);
  } else {
    const int qg = idx & 7, b = idx >> 3;
    attn_wave(p, l, b, wid, false, 0, 0, NLAT + b * 256 + qg * 32, rpbL);
  }
  __syncthreads();
}

__device__ __forceinline__ void phase_mixers(const P& p, int l, char* smem, unsigned* counter) {
  const bool last = (l == 1);
  const int n_rg = 2176 * XRGA, n_fft = 1024 * XFFT, n_hc = last ? 0 : 256, n_att = 1024 * XATT, n_attc = last ? 0 : 64;
  const int total = n_rg + n_fft + n_hc + n_att + n_attc;
  volatile int* s_taskp = (volatile int*)(smem + SMEM_BYTES - 16);
  for (;;) {
    __syncthreads();
    if (threadIdx.x == 0) *s_taskp = (int)atomicAdd(counter, 1u);
    __syncthreads();
    int t = *s_taskp;
    if (t >= total) break;
    if (t < n_rg) { if (t >= 2176) t -= 2176; rg_chunk_task(p, l, t >> 2, t & 3, 0, last, smem); continue; }
    t -= n_rg;
    if (t < n_fft) { t &= 1023; hyena_fft_task(p, l, t >> 2, t & 3, smem); continue; }
    t -= n_fft;
    if (t < n_hc) { hyena_ctx_task(p, l, t >> 5, t & 31, smem); continue; }
    t -= n_hc;
    if (t < n_att) { t &= 1023; attn_block_task(p, l, t >> 7, (t >> 4) & 7, t & 15, smem); continue; }
    t -= n_att;
    attn_task(p, l, 1, t, smem);
  }
}

__device__ __forceinline__ void merge_tile(const P& p, int l, int mt, int nt, char* smem) {
  EPI_VARS
  const int m0 = mt * 256, n0 = nt * 128;
  f32x16 macc[2][2];
  zero_acc(macc);
  for (int br = 0; br < 3; ++br) {
    unsigned* gpl = (unsigned*)(smem + 98304) + tid;
    {
      f32x16 acc[2][2];
      zero_acc(acc);
      gemm_kloop(acc, p.xn + (size_t)m0 * 1024, 1024, p.WgT + ((size_t)l * 3072 + br * 1024 + n0) * 1024, 1024, 1024, smem);
#pragma unroll
      for (int j = 0; j < 2; ++j) {
        const float bg = p.b_gate[l * 3072 + br * 1024 + n0 + EPI_COL(j)];
#pragma unroll
        for (int i = 0; i < 2; ++i)
#pragma unroll
          for (int e = 0; e < 4; ++e) {
            const unsigned q0 = (unsigned)(sigmoidf_(acc[i][j][4 * e] + bg) * 255.0f + 0.5f);
            const unsigned q1 = (unsigned)(sigmoidf_(acc[i][j][4 * e + 1] + bg) * 255.0f + 0.5f);
            const unsigned q2 = (unsigned)(sigmoidf_(acc[i][j][4 * e + 2] + bg) * 255.0f + 0.5f);
            const unsigned q3 = (unsigned)(sigmoidf_(acc[i][j][4 * e + 3] + bg) * 255.0f + 0.5f);
            gpl[((i * 2 + j) * 4 + e) * 512] = q0 | (q1 << 8) | (q2 << 16) | (q3 << 24);
          }
      }
    }
    {
      f32x16 acc[2][2];
      zero_acc(acc);
      const u16* A; const u16* B; int K;
      if (br == 0) { A = p.ycat + (size_t)m0 * 1024; B = p.WaT + ((size_t)l * 1024 + n0) * 512; K = 512; }
      else if (br == 1) { A = p.ycat + (size_t)m0 * 1024 + 512; B = p.WbT + ((size_t)l * 1024 + n0) * 256; K = 256; }
      else { A = p.ycat + (size_t)m0 * 1024 + 768; B = p.WcT + ((size_t)l * 1024 + n0) * 256; K = 256; }
      gemm_kloop(acc, A, 1024, B, K, K, smem);
#pragma unroll
      for (int i = 0; i < 2; ++i)
#pragma unroll
        for (int j = 0; j < 2; ++j)
#pragma unroll
          for (int e = 0; e < 4; ++e) {
            const unsigned g4 = gpl[((i * 2 + j) * 4 + e) * 512];
            macc[i][j][4 * e] += (float)(g4 & 255u) * (1.0f / 255.0f) * acc[i][j][4 * e];
            macc[i][j][4 * e + 1] += (float)((g4 >> 8) & 255u) * (1.0f / 255.0f) * acc[i][j][4 * e + 1];
            macc[i][j][4 * e + 2] += (float)((g4 >> 16) & 255u) * (1.0f / 255.0f) * acc[i][j][4 * e + 2];
            macc[i][j][4 * e + 3] += (float)(g4 >> 24) * (1.0f / 255.0f) * acc[i][j][4 * e + 3];
          }
    }
  }
#pragma unroll
  for (int i = 0; i < 2; ++i)
#pragma unroll
    for (int j = 0; j < 2; ++j)
#pragma unroll
      for (int e = 0; e < 16; ++e)
        p.mbuf[(size_t)(m0 + EPI_ROW(i, e)) * 1024 + n0 + EPI_COL(j)] = f2bf(macc[i][j][e]);
}
__device__ __forceinline__ void outproj_tile(const P& p, int l, int mt, int nt, char* smem, bool do_store) {
  EPI_VARS
  const int m0 = mt * 256, n0 = nt * 128;
  f32x16 acc[2][2];
  zero_acc(acc);
  gemm_kloop(acc, p.mbuf + (size_t)m0 * 1024, 1024, p.WoT + ((size_t)l * 1024 + n0) * 1024, 1024, 1024, smem);
  const bool isctx = (mt >= 128);
  const int bi = isctx ? 8 : (mt >> 4);
  const float* gatev = p.mod + ((size_t)(l * 9 + bi) * 6 + 2) * 1024;
  const float* src; float* dst;
  if (isctx) { src = (l == 0 ? p.ctx : p.ctxs) - (size_t)NLAT * 1024; dst = p.ctxs - (size_t)NLAT * 1024; }
  else { src = (l == 0 ? p.x : p.out); dst = p.out; }
#pragma unroll
  for (int j = 0; j < 2; ++j) {
    const int col = n0 + EPI_COL(j);
    const float gv = gatev[col];
#pragma unroll
    for (int i = 0; i < 2; ++i)
#pragma unroll
      for (int e = 0; e < 16; ++e) {
        const size_t o = (size_t)(m0 + EPI_ROW(i, e)) * 1024 + col;
        if (do_store) dst[o] = src[o] + gv * acc[i][j][e];
      }
  }
}

__device__ __forceinline__ void wqk_task(const P& p, int l, int hp, int nt, char* smem) {
  EPI_VARS
  f32x16 acc[2][2];
  zero_acc(acc);
  gemm_kloop(acc, p.keysB + ((size_t)l * 16 + hp) * 16384, 128, p.WqB + (size_t)l * 1024 * 2048 + (size_t)(nt * 128) * 2048 + hp * 128, 2048, 128, smem);
  if (wm < 2) {
#pragma unroll
    for (int i = 0; i < 2; ++i)
#pragma unroll
      for (int j = 0; j < 2; ++j)
#pragma unroll
        for (int e = 0; e < 16; ++e)
          p.WqkT[((size_t)l * 2048 + hp * 128 + EPI_ROW(i, e)) * 1024 + nt * 128 + EPI_COL(j)] = f2bf(acc[i][j][e]);
  }
}
__device__ __forceinline__ void ins16(unsigned (&L)[16], unsigned x) {
#pragma unroll
  for (int i = 0; i < 16; ++i) {
    const unsigned hi = max(L[i], x);
    x = min(L[i], x);
    L[i] = hi;
  }
}
__device__ __forceinline__ unsigned f2sort(float f) {
  const unsigned b = __float_as_uint(f);
  return b ^ ((unsigned)((int)b >> 31) | 0x80000000u);
}
__device__ __forceinline__ float sort2f(unsigned k) {
  const unsigned u = k & ~127u;
  const unsigned b = (u & 0x80000000u) ? (u ^ 0x80000000u) : ~u;
  return __uint_as_float(b);
}
__device__ __forceinline__ void peer_score_tile(const P& p, int l, int mt, int hp, char* smem) {
  const int tid = opaque_tid();
  const int m0 = mt * 256;
  unsigned L[16];
#pragma unroll
  for (int i = 0; i < 16; ++i) L[i] = 0u;
  const int row = tid >> 1, hf = tid & 1;
  const unsigned* sp = (const unsigned*)(p.q + (size_t)(m0 + row) * 2048 + hp * 128 + hf * 64);
#pragma unroll
  for (int c = 0; c < 8; ++c) {
    const uint4 r = *(const uint4*)(sp + 4 * c);
    const unsigned w[4] = {r.x, r.y, r.z, r.w};
#pragma unroll
    for (int k = 0; k < 4; ++k) {
      const float v0 = __builtin_bit_cast(_Float16, (unsigned short)(w[k] & 0xffffu));
      const float v1 = __builtin_bit_cast(_Float16, (unsigned short)(w[k] >> 16));
      const int key = hf * 64 + c * 8 + k * 2;
      ins16(L, (f2sort(v0) & ~127u) | (unsigned)key);
      ins16(L, (f2sort(v1) & ~127u) | (unsigned)(key + 1));
    }
  }
  unsigned* X = (unsigned*)smem;
  if (hf) {
#pragma unroll
    for (int i = 0; i < 16; ++i) X[row * 16 + i] = L[i];
  }
  __syncthreads();
  if (!hf) {
#pragma unroll
    for (int i = 0; i < 16; ++i) ins16(L, X[row * 16 + i]);
    unsigned* o = p.topk + ((size_t)(m0 + row) * 16 + hp) * 16;
#pragma unroll
    for (int i = 0; i < 4; ++i) *(uint4*)(o + 4 * i) = make_uint4(L[4 * i], L[4 * i + 1], L[4 * i + 2], L[4 * i + 3]);
  }
  __syncthreads();
}

__device__ __forceinline__ void phase_peer_experts(const P& p, int l, bool do_store, char* smem) {
  const int tid_ = opaque_tid(); const int lane = tid_ & 63, wid = tid_ >> 6;
  const int ntok = (l == 1) ? NLAT : NTOK;
  int ci, cj;
  {
    const int e = lane;
    if (e < 16) { ci = 0; cj = e; }
    else if (e < 24) { ci = 1; cj = e - 16; }
    else if (e < 29) { ci = 2; cj = e - 24; }
    else if (e < 33) { ci = 3; cj = e - 29; }
    else if (e < 36) { ci = 4; cj = e - 33; }
    else if (e < 38) { ci = 5; cj = e - 36; }
    else if (e < 40) { ci = 6; cj = e - 38; }
    else if (e < 42) { ci = 7; cj = e - 40; }
    else { ci = min(8 + (e - 42), 15); cj = 0; }
  }
  for (int tok = blockIdx.x * 8 + wid; tok < ntok; tok += gridDim.x * 8) {
    float xr[16];
    {
      const uint4 a = *(const uint4*)(p.xn + (size_t)tok * 1024 + lane * 16);
      const uint4 b = *(const uint4*)(p.xn + (size_t)tok * 1024 + lane * 16 + 8);
      xr[0] = bflo(a.x); xr[1] = bfhi(a.x); xr[2] = bflo(a.y); xr[3] = bfhi(a.y);
      xr[4] = bflo(a.z); xr[5] = bfhi(a.z); xr[6] = bflo(a.w); xr[7] = bfhi(a.w);
      xr[8] = bflo(b.x); xr[9] = bfhi(b.x); xr[10] = bflo(b.y); xr[11] = bfhi(b.y);
      xr[12] = bflo(b.z); xr[13] = bfhi(b.z); xr[14] = bflo(b.w); xr[15] = bfhi(b.w);
    }
    float yacc[16];
#pragma unroll
    for (int i = 0; i < 16; ++i) yacc[i] = 0.f;
    int* selw = (int*)(smem + wid * 4096);
    const unsigned* kvp = p.topk + (size_t)tok * 256 + (lane & 31);
    unsigned kv_next = kvp[0];
#pragma unroll 1
    for (int h = 0; h < 8; ++h) {
      const unsigned kv = kv_next;
      if (h < 7) kv_next = kvp[(h + 1) * 32];
      const unsigned k0 = shu(kv, ci);
      const unsigned k1 = shu(kv, 16 + cj);
      const float val = (lane < 50) ? (sort2f(k0) + sort2f(k1)) : -3.0e38f;
      const int eidx = (int)((k0 & 127u) * 128u + (k1 & 127u));
      float sv = val; int si = eidx;
#pragma unroll
      for (int k = 2; k <= 64; k <<= 1) {
#pragma unroll
        for (int j = k >> 1; j >= 1; j >>= 1) {
          const float ov = __builtin_bit_cast(float, __builtin_amdgcn_ds_bpermute((lane ^ j) << 2, __builtin_bit_cast(int, sv)));
          const int oi = __builtin_amdgcn_ds_bpermute((lane ^ j) << 2, si);
          const bool take_max = (((lane & j) == 0) == ((lane & k) == 0));
          const bool sw = take_max ? (ov > sv) : (ov < sv);
          sv = sw ? ov : sv;
          si = sw ? oi : si;
        }
      }
      const float mx = __builtin_bit_cast(float, __builtin_amdgcn_readlane(__builtin_bit_cast(int, sv), 0));
      const float ex = (lane < 16) ? __builtin_amdgcn_exp2f((sv - mx) * 1.4426950408889634f) : 0.f;
      const float sm = wave_sum(ex);
      selw[h * 64 + lane] = si;
      selw[512 + h * 64 + lane] = __builtin_bit_cast(int, ex * __builtin_amdgcn_rcpf(sm));
    }
#pragma unroll 1
    for (int h = 0; h < 8; ++h) {
      const int eperm_h = selw[h * 64 + lane];
      const int gperm_h = selw[512 + h * 64 + lane];
      uint2 U[16], V[16];
#pragma unroll
      for (int k = 0; k < 16; ++k) {
        const int id = __builtin_amdgcn_readlane(eperm_h, k);
        U[k] = *(const uint2*)(p.Ub + (size_t)id * 512 + lane * 8);
        V[k] = *(const uint2*)(p.Vb + (size_t)id * 512 + lane * 8);
      }
      float d[16];
#pragma unroll
      for (int k = 0; k < 16; ++k) {
        const unsigned uw[2] = {U[k].x, U[k].y};
        float dd = 0.f;
#pragma unroll
        for (int q2 = 0; q2 < 2; ++q2) {
          const f32x2 e0 = __builtin_amdgcn_cvt_scalef32_pk_f32_fp4(uw[q2], 1.0f, 0);
          const f32x2 e1 = __builtin_amdgcn_cvt_scalef32_pk_f32_fp4(uw[q2], 1.0f, 1);
          const f32x2 e2 = __builtin_amdgcn_cvt_scalef32_pk_f32_fp4(uw[q2], 1.0f, 2);
          const f32x2 e3 = __builtin_amdgcn_cvt_scalef32_pk_f32_fp4(uw[q2], 1.0f, 3);
          dd += xr[8 * q2] * e0.x + xr[8 * q2 + 1] * e0.y + xr[8 * q2 + 2] * e1.x + xr[8 * q2 + 3] * e1.y +
                xr[8 * q2 + 4] * e2.x + xr[8 * q2 + 5] * e2.y + xr[8 * q2 + 6] * e3.x + xr[8 * q2 + 7] * e3.y;
        }
        d[k] = dd;
      }
      {
        const bool b5 = (lane & 32) != 0, b4 = (lane & 16) != 0, b3 = (lane & 8) != 0, b2 = (lane & 4) != 0;
#pragma unroll
        for (int j = 0; j < 8; ++j) { const float keep = b5 ? d[j + 8] : d[j], send = b5 ? d[j] : d[j + 8]; d[j] = keep + shx(send, 32); }
#pragma unroll
        for (int j = 0; j < 4; ++j) { const float keep = b4 ? d[j + 4] : d[j], send = b4 ? d[j] : d[j + 4]; d[j] = keep + shx(send, 16); }
#pragma unroll
        for (int j = 0; j < 2; ++j) { const float keep = b3 ? d[j + 2] : d[j], send = b3 ? d[j] : d[j + 2]; d[j] = keep + shx(send, 8); }
        { const float keep = b2 ? d[1] : d[0], send = b2 ? d[0] : d[1]; d[0] = keep + shx(send, 4); }
        d[0] += shx(d[0], 2);
        d[0] += shx(d[0], 1);
      }
      const float gl = __builtin_bit_cast(float, shu((unsigned)gperm_h, (lane >> 2) & 15));
      const float act = gelu_tanh(d[0] * (1.0f / 64.0f)) * gl;
#pragma unroll
      for (int k = 0; k < 16; ++k) {
        const float ak = __builtin_bit_cast(float, __builtin_amdgcn_readlane(__builtin_bit_cast(int, act), 4 * k));
        const unsigned vw[2] = {V[k].x, V[k].y};
#pragma unroll
        for (int q2 = 0; q2 < 2; ++q2) {
          const f32x2 e0 = __builtin_amdgcn_cvt_scalef32_pk_f32_fp4(vw[q2], 1.0f, 0);
          const f32x2 e1 = __builtin_amdgcn_cvt_scalef32_pk_f32_fp4(vw[q2], 1.0f, 1);
          const f32x2 e2 = __builtin_amdgcn_cvt_scalef32_pk_f32_fp4(vw[q2], 1.0f, 2);
          const f32x2 e3 = __builtin_amdgcn_cvt_scalef32_pk_f32_fp4(vw[q2], 1.0f, 3);
          yacc[8 * q2] += ak * e0.x; yacc[8 * q2 + 1] += ak * e0.y; yacc[8 * q2 + 2] += ak * e1.x; yacc[8 * q2 + 3] += ak * e1.y;
          yacc[8 * q2 + 4] += ak * e2.x; yacc[8 * q2 + 5] += ak * e2.y; yacc[8 * q2 + 6] += ak * e3.x; yacc[8 * q2 + 7] += ak * e3.y;
        }
      }
    }
    const int bi = tok < NLAT ? (tok >> 12) : 8;
    const float* gv = p.mod + ((size_t)(l * 9 + bi) * 6 + 5) * 1024 + lane * 16;
    float* xp = (tok < NLAT) ? (p.out + (size_t)tok * 1024) : (p.ctxs + (size_t)(tok - NLAT) * 1024);
    xp += lane * 16;
#pragma unroll
    for (int i = 0; i < 4; ++i) {
      float4 xv = *(float4*)(xp + 4 * i);
      const float4 g4 = *(const float4*)(gv + 4 * i);
      xv.x += g4.x * yacc[4 * i] * 0.25f; xv.y += g4.y * yacc[4 * i + 1] * 0.25f; xv.z += g4.z * yacc[4 * i + 2] * 0.25f; xv.w += g4.w * yacc[4 * i + 3] * 0.25f;
      if (do_store) *(float4*)(xp + 4 * i) = xv;
    }
  }
}


#define XB_TMO      128
#define XB_XCNT(j)  (256  + 64 * (j))
#define XB_XSUB(j)  (1280 + 64 * (j))
#define XB_XGEN(j)  (2304 + 64 * (j))
#define XB_TOP      3328
#define XB_TOPGEN   3392
#define XCD_BAR_WORDS 3456
#define XB_SPIN_CAP (1u << 22)
#define LAS __attribute__((address_space(3)))
__device__ __forceinline__ unsigned xb_ld(unsigned* p) { return __hip_atomic_load(p, __ATOMIC_RELAXED, __HIP_MEMORY_SCOPE_AGENT); }
__device__ __forceinline__ unsigned xb_add(unsigned* p, unsigned v) { return __hip_atomic_fetch_add(p, v, __ATOMIC_RELAXED, __HIP_MEMORY_SCOPE_AGENT); }
__device__ __forceinline__ unsigned xb_xcc_id() { return (unsigned)__builtin_amdgcn_s_getreg((3 << 11) | 20) & 0xFu; }
#define XB_SPIN(cond, bar) do { unsigned _sp = 0; while (cond) { __builtin_amdgcn_s_sleep(1); \
    if ((++_sp & 255u) == 0u) { if (xb_ld(&(bar)[XB_TMO])) break; if (_sp > XB_SPIN_CAP) { atomicAdd(&(bar)[XB_TMO], 1u); break; } } } } while (0)
struct XcdBarrier { unsigned* bar; unsigned x; volatile LAS unsigned* st; };
__device__ __forceinline__ XcdBarrier xcd_barrier_post(unsigned* bar, volatile LAS unsigned* st) {
  XcdBarrier b; b.bar = bar; b.x = xb_xcc_id(); b.st = st;
  if (threadIdx.x == 0) (void)xb_add(&bar[XB_XCNT(b.x)], 1u);
  return b;
}
__device__ __forceinline__ void xcd_barrier_complete(unsigned* bar, unsigned x, unsigned& nloc, unsigned& nx) {
  const unsigned G = gridDim.x * gridDim.y * gridDim.z;
  unsigned sum, cnt, mine, sp = 0u;
  for (;;) {
    sum = 0u; cnt = 0u; mine = 0u;
#pragma unroll
    for (unsigned j = 0; j < 16; ++j) { const unsigned c = xb_ld(&bar[XB_XCNT(j)]); sum += c; cnt += (c > 0u) ? 1u : 0u; mine = (j == x) ? c : mine; }
    if (sum == G) break;
    __builtin_amdgcn_s_sleep(1);
    if ((++sp & 255u) == 0u) { if (xb_ld(&bar[XB_TMO])) break; if (sp > XB_SPIN_CAP) { atomicAdd(&bar[XB_TMO], 1u); break; } }
  }
  nloc = mine > 0u ? mine : 1u; nx = cnt > 0u ? cnt : 1u;
}
__device__ __forceinline__ void xcd_barrier(unsigned* bar_u, volatile LAS unsigned* st_u) {
  XcdBarrier b; b.bar = bar_u; b.x = xb_xcc_id(); b.st = st_u;
  asm volatile("s_waitcnt vmcnt(0)" ::: "memory");
  __syncthreads();
  if (threadIdx.x == 0) {
    unsigned long long bp_ = (unsigned long long)b.bar;
    asm volatile("" : "+v"(bp_));
    unsigned* bar = (unsigned*)bp_;
    __builtin_amdgcn_s_waitcnt(0);
    unsigned nloc = b.st[0], nx = b.st[1];
    if (nloc == 0u) { xcd_barrier_complete(bar, b.x, nloc, nx); b.st[0] = nloc; b.st[1] = nx; }
    const unsigned old = xb_add(&bar[XB_XSUB(b.x)], 1u);
    const unsigned gen = old / nloc;
    if (old + 1u == (gen + 1u) * nloc) {
      __builtin_amdgcn_fence(__ATOMIC_RELEASE, "agent");
      asm volatile("s_waitcnt vmcnt(0)" ::: "memory");
      const unsigned og = xb_add(&bar[XB_TOP], 1u);
      const unsigned tg = og / nx;
      if (og + 1u == (tg + 1u) * nx) xb_add(&bar[XB_TOPGEN], 1u);
      else XB_SPIN(xb_ld(&bar[XB_TOPGEN]) == tg, bar);
      __builtin_amdgcn_fence(__ATOMIC_ACQUIRE, "agent");
      xb_add(&bar[XB_XGEN(b.x)], 1u);
      asm volatile("s_waitcnt vmcnt(0)" ::: "memory");
    } else {
      XB_SPIN(xb_ld(&bar[XB_XGEN(b.x)]) == gen, bar);
      __builtin_amdgcn_fence(__ATOMIC_ACQUIRE, "agent");
      asm volatile("s_waitcnt vmcnt(0)" ::: "memory");
    }
  }
  __syncthreads();
}

template <int l>
__device__ __forceinline__ void layer_body(const P& p, char* smem, pg8::PG8_LAS_T lds, volatile LAS unsigned* xbw, const int nb, const int bid) {
    const bool last = (l == 1);
    const int n_mt = last ? 128 : 136;
_Pragma("unroll 1")
    for (int rep = 0; rep < REP_1A; ++rep) {
      phase_norm(p, l, 0);
    }
    xcd_barrier(p.counters + 1024, xbw);
_Pragma("unroll 1")
    for (int rep = 0; rep < REP_INPROJ; ++rep) {
      pg8::Gemm g; pg8::Order S;
      g.A = p.xn; g.Bt = p.WinT + (size_t)l * 2816 * 1024; g.lda = 1024; g.ldb = 1024; g.K = 1024;
      S.init(136, 6, nb, bid, 4, 5);
      pg8::EpiInprojN e1; e1.qk = p.qk; e1.rg = p.rg;
      pg8::gemm_phase(lds, g, S, e1);
      g.A = p.WinT + ((size_t)l * 2816 + 1024) * 1024; g.Bt = p.xn;
      S.init(5, 136, nb, bid);
      pg8::EpiInprojT e2; e2.vT = p.vT; e2.vTc = p.vTc; e2.hyT = p.hyT; e2.hyTc = p.hyTc;
      pg8::gemm_phase(lds, g, S, e2);
    }
    xcd_barrier(p.counters + 1024, xbw);
    phase_mixers(p, l, smem, p.counters + l * 4);
    xcd_barrier(p.counters + 1024, xbw);
_Pragma("unroll 1")
    for (int rep = 0; rep < REP_2B; ++rep)
      for (int task = bid; task < 2176 + 512; task += nb) {
        if (task < 2176) rg_chunk_task(p, l, task >> 2, task & 3, 1, last, smem);
        else yb_transpose_task(p, (task - 2176) >> 6, (task - 2176) & 63, smem);
      }
    xcd_barrier(p.counters + 1024, xbw);
_Pragma("unroll 1")
    for (int rep = 0; rep < REP_GATE; ++rep) {
      pg8::Gemm g; pg8::Order S;
      g.A = p.xn; g.Bt = p.WgT + (size_t)l * 3072 * 1024; g.lda = 1024; g.ldb = 1024; g.K = 1024;
      S.init(n_mt, 12, nb, bid);
      pg8::EpiGate e; e.g8 = p.g8; e.bias = p.b_gate + l * 3072;
      pg8::gemm_phase(lds, g, S, e);
    }
    xcd_barrier(p.counters + 1024, xbw);
_Pragma("unroll 1")
    for (int rep = 0; rep < REP_BRANCH; ++rep) {
      pg8::Gemm g; pg8::Order S;
      S.init(n_mt, 4, nb, bid);
      pg8::EpiBranch e; e.mbuf = p.mbuf; e.g8 = p.g8;
      g.lda = 1024;
      g.A = p.ycat; g.Bt = p.WaT + (size_t)l * 1024 * 512; g.ldb = 512; g.K = 512; e.br = 0;
      pg8::gemm_phase(lds, g, S, e);
      g.A = p.ycat + 512; g.Bt = p.WbT + (size_t)l * 1024 * 256; g.ldb = 256; g.K = 256; e.br = 1;
      pg8::gemm_phase(lds, g, S, e);
      g.A = p.ycat + 768; g.Bt = p.WcT + (size_t)l * 1024 * 256; g.ldb = 256; g.K = 256; e.br = 2;
      pg8::gemm_phase(lds, g, S, e);
    }
    xcd_barrier(p.counters + 1024, xbw);
    {
      pg8::Gemm g; pg8::Order S;
      g.A = p.mbuf; g.Bt = p.WoT + (size_t)l * 1024 * 1024; g.lda = 1024; g.ldb = 1024; g.K = 1024;
      S.init(n_mt, 4, nb, bid);
      pg8::EpiOut e; e.xsrc = (l == 0 ? p.x : p.out); e.csrc = (l == 0 ? p.ctx : p.ctxs); e.xdst = p.out; e.cdst = p.ctxs;
      e.modl = p.mod + (size_t)l * 9 * 6144;
      pg8::gemm_phase(lds, g, S, e);
      for (int t = bid; t < 8192; t += nb) {
        if (t < 4096) cvt_chunk_fp4(p.peer_u + (size_t)l * 16384 * 1024, p.Ub, (size_t)t, 64.0f);
        else cvt_chunk_fp4(p.peer_v + (size_t)l * 16384 * 1024, p.Vb, (size_t)(t - 4096), 4.0f);
      }
    }
    xcd_barrier(p.counters + 1024, xbw);
    phase_norm(p, l, 1);
    xcd_barrier(p.counters + 1024, xbw);
_Pragma("unroll 1")
    for (int rep = 0; rep < REP_Q; ++rep) {
      pg8::Gemm g; pg8::Order S;
      g.A = p.xn; g.Bt = p.WqkT + (size_t)l * 2048 * 1024; g.lda = 1024; g.ldb = 1024; g.K = 1024;
      S.init(n_mt, 8, nb, bid);
      pg8::EpiQ e; e.q = p.q;
      pg8::gemm_phase(lds, g, S, e);
    }
    xcd_barrier(p.counters + 1024, xbw);
_Pragma("unroll 1")
    for (int rep = 0; rep < REP_SCORE; ++rep)
      for (int task = bid; task < n_mt * 16; task += nb) peer_score_tile(p, l, task >> 4, task & 15, smem);
    xcd_barrier(p.counters + 1024, xbw);
_Pragma("unroll 1")
    for (int rep = 0; rep < REP_PEER; ++rep) phase_peer_experts(p, l, rep == REP_PEER - 1, smem);
    xcd_barrier(p.counters + 1024, xbw);
  }

__global__ void __launch_bounds__(NTHR) fwd_megakernel(P p) {
  __shared__ __attribute__((aligned(16))) char smem[SMEM_BYTES];
  cg::grid_group grid = cg::this_grid();
  const int nb = gridDim.x, bid = blockIdx.x;
  pg8::PG8_LAS_T lds = (pg8::PG8_LAS_T)smem;
  volatile LAS unsigned* xbw = (volatile LAS unsigned*)(smem + SMEM_BYTES - 32);
  if (threadIdx.x == 0) { xbw[0] = 0u; xbw[1] = 0u; xbw[2] = 0u; xbw[3] = 0u; }
  __syncthreads();
  (void)xcd_barrier_post(p.counters + 1024, xbw);

  phase_prep(p, smem);
  phase_filters(p, 0);
  phase_filters(p, 1);
  grid.sync();
  phase_modreduce(p);
  for (int task = blockIdx.x; task < 512; task += gridDim.x) kf_task(p, task >> 8, task & 255, smem);
  for (int task = blockIdx.x; task < 256; task += gridDim.x) wqk_task(p, task >> 7, (task >> 3) & 15, task & 7, smem);
  xcd_barrier(p.counters + 1024, xbw);

  layer_body<0>(p, smem, lds, xbw, nb, bid);
  layer_body<1>(p, smem, lds, xbw, nb, bid);
  phase_norm(p, 1, 2);
}

extern "C" void kernel_launch(void* const* d_in, const int* in_sizes, int n_in, void* d_out, int out_size, void* d_ws,
                              size_t ws_size, hipStream_t stream) {
  P p;
  memset(&p, 0, sizeof(p));
  const float** ins = (const float**)&p;
  for (int i = 0; i < 37; ++i) ins[i] = (const float*)d_in[i];
  p.out = (float*)d_out;
  char* w = (char*)d_ws;
  size_t off = 0;
  auto take = [&](size_t bytes) { char* r = w + off; off += (bytes + 255) & ~(size_t)255; return r; };
  p.counters = (unsigned*)take(32768);
  p.WinT = (u16*)take((size_t)2 * 2816 * 1024 * 2);
  p.WgT = (u16*)take((size_t)2 * 3072 * 1024 * 2);
  p.WaT = (u16*)take((size_t)2 * 1024 * 512 * 2);
  p.WbT = (u16*)take((size_t)2 * 1024 * 256 * 2);
  p.WcT = (u16*)take((size_t)2 * 1024 * 256 * 2);
  p.WoT = (u16*)take((size_t)2 * 1024 * 1024 * 2);
  p.WqB = (u16*)take((size_t)2 * 1024 * 2048 * 2);
  p.WqkT = (u16*)take((size_t)2 * 2048 * 1024 * 2);
  p.keysB = (u16*)take((size_t)2 * 16 * 16384 * 2);
  p.rgW = (u16*)take((size_t)2 * 16 * 4096 * 2);
  p.modpart = (float*)take((size_t)16 * 2 * 9 * 6144 * 4);
  p.mod = (float*)take((size_t)2 * 9 * 6144 * 4);
  p.hT = (float*)take((size_t)2 * 512 * 4096 * 4);
  p.hc = (float*)take((size_t)512 * 256 * 4);
  p.Kf = (float*)take((size_t)2 * 256 * 8192 * 8);
  p.xn = (u16*)take((size_t)NTOK * 1024 * 2);
  p.qk = (u16*)take((size_t)NTOK * 1024 * 2);
  p.mbuf = p.qk;
  p.vT = (u16*)take((size_t)8 * 512 * 4096 * 2);
  p.vTc = (u16*)take((size_t)8 * 512 * 256 * 2);
  p.hyT = (u16*)take((size_t)8 * 768 * 4096 * 2);
  p.hyTc = (u16*)take((size_t)8 * 768 * 256 * 2);
  p.rg = (u16*)take((size_t)NTOK * 512 * 2);
  p.ycat = (u16*)take((size_t)NTOK * 1024 * 2);
  p.Ub = (unsigned char*)p.ycat;
  p.Vb = p.Ub + (size_t)16384 * 512;
  p.agg = (float*)take((size_t)8 * 2 * 68 * 256 * 8);
  p.ybT = (u16*)take((size_t)8 * 256 * 4096 * 2);
  p.ctxs = (float*)take((size_t)2048 * 1024 * 4);
  p.g8 = (unsigned char*)p.vT;
  p.q = p.qk;
  p.topk = (unsigned*)((char*)p.qk + (size_t)NTOK * 2048 * 2);
  if (off > ws_size) {
    fprintf(stderr, "workspace too small: need %zu have %zu\n", off, ws_size);
    return;
  }
  static int grid_blocks = 0;
  if (!grid_blocks) {
    int dev = 0, cus = 0, per_cu = 0;
    (void)hipGetDevice(&dev);
    (void)hipDeviceGetAttribute(&cus, hipDeviceAttributeMultiprocessorCount, dev);
    (void)hipOccupancyMaxActiveBlocksPerMultiprocessor(&per_cu, fwd_megakernel, NTHR, 0);
    if (per_cu > 1) per_cu = 1;
    grid_blocks = cus * per_cu;
  }
  (void)hipMemsetAsync(p.counters, 0, 32768, stream);
  void* args[] = {&p};
  hipError_t e = hipLaunchCooperativeKernel((void*)fwd_megakernel, dim3(grid_blocks), dim3(NTHR), args, 0, stream);
  if (e != hipSuccess) fprintf(stderr, "cooperative launch failed: %s (grid %d)\n", hipGetErrorString(e), grid_blocks);
}
```

```cpp
#include <hip/hip_runtime.h>
#include <hip/hip_cooperative_groups.h>
#include <cstdio>
#include <cstring>
namespace cg = cooperative_groups;

typedef unsigned short u16;
typedef __attribute__((ext_vector_type(8))) short bf16x8;
typedef __attribute__((ext_vector_type(16))) float f32x16;
typedef __attribute__((ext_vector_type(2))) float f32x2;

#define NLAT 32768
#define NTOK 34816
#define SMEM_BYTES 151552
#define NTHR 512
#ifndef DUP_1A
#define DUP_1A 1
#endif
#ifndef DUP_PREP
#define DUP_PREP 1
#endif
#ifndef DUP_2B
#define DUP_2B 1
#endif
#ifndef XRGA
#define XRGA 1
#endif
#ifndef REP_PEER
#define REP_PEER 1
#endif
#ifndef REP_INPROJ
#define REP_INPROJ 1
#endif
#ifndef REP_GATE
#define REP_GATE 1
#endif
#ifndef REP_BRANCH
#define REP_BRANCH 1
#endif
#ifndef REP_Q
#define REP_Q 1
#endif
#ifndef REP_SCORE
#define REP_SCORE 1
#endif
#ifndef REP_1A
#define REP_1A 1
#endif
#ifndef REP_2B
#define REP_2B 1
#endif
#ifndef REP_KF
#define REP_KF 1
#endif
#ifndef DUP_GEMM
#define DUP_GEMM 1
#endif
#ifndef DUP_PEER
#define DUP_PEER 1
#endif
#ifndef DUP_MIX
#define DUP_MIX 1
#endif
#ifndef XRG
#define XRG 1
#endif
#ifndef XFFT
#define XFFT 1
#endif
#ifndef XATT
#define XATT 1
#endif

struct P {
  const float *x, *c, *ctx, *c_ctx, *norm_mix_g, *norm_ffn_g, *w_ada, *b_ada, *w_in, *na_rpb,
      *hy_short_w, *hy_short_b, *hy_f1_w, *hy_f1_b, *hy_f2_w, *hy_f2_b, *hy_f3_w, *hy_freq, *hy_bias,
      *rg_conv_w, *rg_conv_b, *rg_wa, *rg_ba, *rg_wx, *rg_bx, *rg_lambda,
      *w_gate, *b_gate, *w_br_a, *w_br_b, *w_br_c, *w_out, *peer_wq, *peer_keys, *peer_u, *peer_v, *final_g;
  float* out;
  unsigned* counters;
  u16 *WinT, *WgT, *WaT, *WbT, *WcT, *WoT, *WqB, *WqkT, *keysB, *rgW;
  float *modpart, *mod, *hT, *hc;
  float* Kf;
  u16 *xn, *qk, *vT, *vTc, *hyT, *hyTc, *rg, *ycat, *mbuf, *ybT;
  unsigned char *Ub, *Vb, *g8;
  u16* q;
  float *agg, *ctxs;
  unsigned* topk;
};

__device__ __forceinline__ u16 f2bf(float f) {
  unsigned u = __float_as_uint(f);
  u += 0x7fffu + ((u >> 16) & 1u);
  return (u16)(u >> 16);
}
__device__ __forceinline__ float bf2f(u16 h) { return __uint_as_float(((unsigned)h) << 16); }
__device__ __forceinline__ unsigned pk2(float a, float b) { return (unsigned)f2bf(a) | ((unsigned)f2bf(b) << 16); }
__device__ __forceinline__ float bflo(unsigned u) { return __uint_as_float(u << 16); }
__device__ __forceinline__ float bfhi(unsigned u) { return __uint_as_float(u & 0xffff0000u); }
__device__ __forceinline__ int opaque_tid() {
  int t = threadIdx.x;
  asm volatile("" : "+v"(t));
  return t;
}
__device__ __forceinline__ int my_lane() { return opaque_tid() & 63; }
__device__ __forceinline__ float shx(float v, int o) { return __builtin_bit_cast(float, __builtin_amdgcn_ds_bpermute(((my_lane() ^ o) << 2), __builtin_bit_cast(int, v))); }
__device__ __forceinline__ float shf(float v, int src) { return __builtin_bit_cast(float, __builtin_amdgcn_ds_bpermute((src & 63) << 2, __builtin_bit_cast(int, v))); }
__device__ __forceinline__ unsigned shu(unsigned v, int src) { return (unsigned)__builtin_amdgcn_ds_bpermute((src & 63) << 2, (int)v); }
__device__ __forceinline__ float wave_sum(float v) {
  const int lane = my_lane();
#pragma unroll
  for (int o = 32; o > 0; o >>= 1) v += __builtin_bit_cast(float, __builtin_amdgcn_ds_bpermute((lane ^ o) << 2, __builtin_bit_cast(int, v)));
  return v;
}
__device__ __forceinline__ float wave_max(float v) {
  const int lane = my_lane();
#pragma unroll
  for (int o = 32; o > 0; o >>= 1) v = fmaxf(v, __builtin_bit_cast(float, __builtin_amdgcn_ds_bpermute((lane ^ o) << 2, __builtin_bit_cast(int, v))));
  return v;
}
__device__ __forceinline__ float sigmoidf_(float x) { return __builtin_amdgcn_rcpf(1.0f + __expf(-x)); }
__device__ __forceinline__ float gelu_tanh(float x) {
  const float u2 = 1.5957691216057308f * (x + 0.044715f * x * x * x);
  return x * __builtin_amdgcn_rcpf(1.0f + __expf(-u2));
}
__device__ __forceinline__ f32x16 mfma32(bf16x8 a, bf16x8 b, f32x16 c) {
  return __builtin_amdgcn_mfma_f32_32x32x16_bf16(a, b, c, 0, 0, 0);
}
__device__ __forceinline__ f32x16 zero16() {
  f32x16 z;
#pragma unroll
  for (int i = 0; i < 16; ++i) z[i] = 0.f;
  return z;
}
__device__ __forceinline__ int swz128(int row, int ch) { return row * 128 + ((ch ^ ((row >> 1) & 7)) << 4); }
__device__ __forceinline__ int swz256(int row, int ch) { return row * 256 + ((ch ^ (row & 15)) << 4); }

struct c2 { float x, y; };
__device__ __forceinline__ c2 cadd(c2 a, c2 b) { return {a.x + b.x, a.y + b.y}; }
__device__ __forceinline__ c2 csub(c2 a, c2 b) { return {a.x - b.x, a.y - b.y}; }
__device__ __forceinline__ c2 cmul(c2 a, c2 b) { return {a.x * b.x - a.y * b.y, a.x * b.y + a.y * b.x}; }
__device__ __forceinline__ float c16(int i) {
  const float tb[16] = {1.0f, 0.9238795325112867f, 0.7071067811865476f, 0.3826834323650898f, 0.0f,
                        -0.3826834323650898f, -0.7071067811865476f, -0.9238795325112867f, -1.0f,
                        -0.9238795325112867f, -0.7071067811865476f, -0.3826834323650898f, 0.0f,
                        0.3826834323650898f, 0.7071067811865476f, 0.9238795325112867f};
  return tb[i & 15];
}
__device__ __forceinline__ float s16(int i) { return c16(i + 12); }
template <int R> __device__ __forceinline__ constexpr int brev(int k) {
  int r = 0;
  for (int b = 1, o = R >> 1; b < R; b <<= 1, o >>= 1)
    if (k & b) r |= o;
  return r;
}
template <int R> __device__ __forceinline__ void dft_reg(c2* v, float sgn) {
#pragma unroll
  for (int h = R / 2; h >= 1; h >>= 1) {
#pragma unroll
    for (int g = 0; g < R; g += 2 * h) {
#pragma unroll
      for (int j = 0; j < h; ++j) {
        c2 a = v[g + j], b = v[g + j + h];
        v[g + j] = cadd(a, b);
        c2 d = csub(a, b);
        const int ti = j * (16 / (2 * h));
        c2 w = {c16(ti), sgn * s16(ti)};
        v[g + j + h] = (j == 0) ? d : cmul(d, w);
      }
    }
  }
}
template <int R> __device__ __forceinline__ int fft_bfly(c2* v, int j, int Ns, float sgn) {
  const int k = j & (Ns - 1);
  const float f = sgn * (float)k / (float)(Ns * R);
#pragma unroll
  for (int r = 1; r < R; ++r) {
    float t = f * (float)r;
    c2 w = {__builtin_amdgcn_cosf(t), __builtin_amdgcn_sinf(t)};
    v[r] = cmul(v[r], w);
  }
  dft_reg<R>(v, sgn);
  return (j - k) * R + k;
}
template <int R> __device__ __forceinline__ void fft_pass(c2* buf, int Ns, float sgn) {
  constexpr int NBF = 8192 / R;
  constexpr int PER = NBF / NTHR;
  const int tid = opaque_tid();
  c2 v[PER][R];
#pragma unroll
  for (int i = 0; i < PER; ++i) {
    const int j = tid + NTHR * i;
#pragma unroll
    for (int r = 0; r < R; ++r) v[i][r] = buf[j + r * NBF];
  }
  __syncthreads();
#pragma unroll
  for (int i = 0; i < PER; ++i) {
    const int j = tid + NTHR * i;
    const int base = fft_bfly<R>(v[i], j, Ns, sgn);
#pragma unroll
    for (int r = 0; r < R; ++r) buf[base + r * Ns] = v[i][brev<R>(r)];
  }
  __syncthreads();
}
__device__ __forceinline__ void fft8192(c2* buf, float sgn) {
  fft_pass<8>(buf, 1, sgn);
  fft_pass<8>(buf, 8, sgn);
  fft_pass<8>(buf, 64, sgn);
  fft_pass<16>(buf, 512, sgn);
}

__device__ __forceinline__ void gemm_kloop(f32x16 (&acc)[2][2], const u16* __restrict__ A, int lda,
                                           const u16* __restrict__ B, int ldb, int K, char* smem) {
  const int tid = opaque_tid(), lane = tid & 63, wid = tid >> 6;
  const int wm = wid >> 1, wn = wid & 1;
  const int l31 = lane & 31, hh = lane >> 5;
  uint4 ra[4], rb[2];
  const int nk = K >> 6;
  const int srow = tid >> 3, sch = tid & 7;
  const char* Ab = (const char*)A;
  const char* Bb = (const char*)B;
  const unsigned aoff = (unsigned)(srow * lda + sch * 8) * 2u;
  const unsigned boff = (unsigned)(srow * ldb + sch * 8) * 2u;
  const unsigned astep = (unsigned)lda * 128u, bstep = (unsigned)ldb * 128u;
#pragma unroll
  for (int i = 0; i < 4; ++i) ra[i] = *(const uint4*)(Ab + (aoff + i * astep));
#pragma unroll
  for (int i = 0; i < 2; ++i) rb[i] = *(const uint4*)(Bb + (boff + i * bstep));
#pragma unroll
  for (int i = 0; i < 4; ++i) *(uint4*)(smem + swz128(srow + i * 64, sch)) = ra[i];
#pragma unroll
  for (int i = 0; i < 2; ++i) *(uint4*)(smem + 65536 + swz128(srow + i * 64, sch)) = rb[i];
  __syncthreads();
  for (int kt = 0; kt < nk; ++kt) {
    const bool more = (kt + 1 < nk);
    if (more) {
      const unsigned ko = (unsigned)(kt + 1) * 128u;
#pragma unroll
      for (int i = 0; i < 4; ++i) ra[i] = *(const uint4*)(Ab + (aoff + i * astep + ko));
#pragma unroll
      for (int i = 0; i < 2; ++i) rb[i] = *(const uint4*)(Bb + (boff + i * bstep + ko));
    }
    const char* as = smem + (kt & 1) * 32768;
    const char* bs = smem + 65536 + (kt & 1) * 16384;
    int lrow = l31;
    asm volatile("" : "+v"(lrow));
#pragma unroll
    for (int s = 0; s < 4; ++s) {
      bf16x8 af[2], bfr[2];
#pragma unroll
      for (int i = 0; i < 2; ++i) af[i] = *(const bf16x8*)(as + swz128(wm * 64 + i * 32 + lrow, s * 2 + hh));
#pragma unroll
      for (int j = 0; j < 2; ++j) bfr[j] = *(const bf16x8*)(bs + swz128(wn * 64 + j * 32 + lrow, s * 2 + hh));
#pragma unroll
      for (int i = 0; i < 2; ++i)
#pragma unroll
        for (int j = 0; j < 2; ++j) acc[i][j] = mfma32(af[i], bfr[j], acc[i][j]);
    }
    if (more) {
      char* an = smem + ((kt + 1) & 1) * 32768;
      char* bn = smem + 65536 + ((kt + 1) & 1) * 16384;
      int sr2 = srow;
      asm volatile("" : "+v"(sr2));
#pragma unroll
      for (int i = 0; i < 4; ++i) *(uint4*)(an + swz128(sr2 + i * 64, sch)) = ra[i];
#pragma unroll
      for (int i = 0; i < 2; ++i) *(uint4*)(bn + swz128(sr2 + i * 64, sch)) = rb[i];
    }
    __syncthreads();
  }
}
__device__ __forceinline__ void zero_acc(f32x16 (&acc)[2][2]) {
#pragma unroll
  for (int i = 0; i < 2; ++i)
#pragma unroll
    for (int j = 0; j < 2; ++j) acc[i][j] = zero16();
}
#define EPI_ROW(i, e) (wm * 64 + (i)*32 + ((e)&3) + 8 * ((e) >> 2) + 4 * hh)
#define EPI_COL(j) (wn * 64 + (j)*32 + l31)
#define EPI_VARS                                                    \
  const int tid = opaque_tid(), lane = tid & 63, wid = tid >> 6;     \
  const int wm = wid >> 1, wn = wid & 1, l31 = lane & 31, hh = lane >> 5; \
  (void)tid; (void)wm; (void)wn; (void)l31; (void)hh;


namespace pg8 {
#define PG8_LAS __attribute__((address_space(3)))
typedef PG8_LAS unsigned char* PG8_LAS_T;
typedef float f32x4 __attribute__((ext_vector_type(4)));
typedef unsigned u32x4 __attribute__((ext_vector_type(4)));
constexpr int BM = 256, BK = 64, HALF = 128, HTB = HALF * BK * 2, STAGE_BYTES = 8 * HTB, NXCD = 8, WGM = 8;
__device__ __forceinline__ int lds_byte(int r, int c) { const int st = (r >> 4) * 2 + (c >> 5), rr = r & 15, cc = c & 31, ob = rr * 64 + cc * 2; return st * 1024 + (ob ^ (((ob >> 9) & 1) << 5)); }
__device__ __forceinline__ void stage_rc(int b, int& R, int& C) { const int st = b / 1024, sb = b % 1024, swz = sb ^ (((sb >> 9) & 1) << 5); R = (st >> 1) * 16 + swz / 64; C = (st & 1) * 32 + (swz % 64) / 2; }
__device__ __forceinline__ int perm32(int rho) { const int n = rho >> 4, i = rho & 15; return 8 * (i >> 2) + 4 * n + (i & 3); }
struct Unit { int pm, pn; };
struct Gemm { const u16* A; const u16* Bt; int lda, ldb, K; };
struct Order {
  int nM, nN, nwg, G, c, skip_from, skip_by;
  __device__ __forceinline__ void init(int nM_, int nN_, int G_, int c_, int sf = 1 << 30, int sb = 0) { nM = nM_; nN = nN_; nwg = nM * nN; G = G_; c = c_; skip_from = sf; skip_by = sb; }
  __device__ __forceinline__ bool next(int i, Unit& u) const {
    const long L = (long)i * G + c; if (L >= nwg) return false;
    int wgid = (int)L; { const int q = nwg / NXCD, r = nwg % NXCD, xcd = wgid % NXCD, off = wgid / NXCD; wgid = (xcd < r ? xcd * (q + 1) : r * (q + 1) + (xcd - r) * q) + off; }
    const int nig = WGM * nN, gid = wgid / nig, fm = gid * WGM, gsz = (nM - fm) < WGM ? (nM - fm) : WGM;
    u.pm = fm + ((wgid % nig) % gsz); u.pn = (wgid % nig) / gsz;
    if (u.pn >= skip_from) u.pn += skip_by;
    return true;
  }
};
template <class Epi>
__device__ __forceinline__ void gemm_phase(PG8_LAS unsigned char* lds, const Gemm g, const Order& S, const Epi& E) {
  const int tid = opaque_tid(), wid = __builtin_amdgcn_readfirstlane(tid >> 6), lane = tid & 63, wr = wid >> 2, wc = wid & 3, fr = lane & 15, fq = lane >> 4;
  const int K = g.K, nt = K / BK;
  unsigned voffA[2], voffB[2];
#pragma unroll
  for (int i = 0; i < 2; ++i) { int R, C; stage_rc(tid * 16 + i * 8192, R, C); const int Rb = Epi::PERM ? ((R & ~31) + perm32(R & 31)) : R;
    voffA[i] = (unsigned)(R * g.lda + C) * 2u; voffB[i] = (unsigned)(Rb * g.ldb + C) * 2u; }
  const size_t kstep = (size_t)(BK * 2);
  const size_t hstepA = (size_t)HALF * g.lda * 2, hstepB = (size_t)HALF * g.ldb * 2;
  const size_t tstepA = 2 * hstepA, tstepB = 2 * hstepB;
  const unsigned ldsw = (unsigned)wid * 1024u;
  const int aoff = lds_byte(wr * 64 + fr, fq * 8), boff = lds_byte(wc * 32 + fr, fq * 8);
#define PG8_SA(b, h) (((b) * 2 + (h)) * HTB)
#define PG8_SB(b, h) ((4 + (b) * 2 + (h)) * HTB)
#define PG8_STAGE(bufoff, gbase, voff) do { _Pragma("unroll") for (int _i = 0; _i < 2; ++_i) \
    __builtin_amdgcn_global_load_lds((const unsigned*)((const char*)(gbase) + (voff)[_i]), (PG8_LAS unsigned*)(lds + (bufoff) + ldsw + _i * 8192), 16, 0, 0); } while (0)
#define PG8_LDA(dst, b, h) do { _Pragma("unroll") for (int m = 0; m < 4; ++m) _Pragma("unroll") for (int k = 0; k < 2; ++k) dst[m][k] = *(const PG8_LAS bf16x8*)(lds + PG8_SA(b, h) + aoff + m * 2048 + k * 1024); } while (0)
#define PG8_LDB(dst, b, h) do { _Pragma("unroll") for (int n = 0; n < 2; ++n) _Pragma("unroll") for (int k = 0; k < 2; ++k) dst[n][k] = *(const PG8_LAS bf16x8*)(lds + PG8_SB(b, h) + boff + n * 2048 + k * 1024); } while (0)
#define PG8_MMA(ai, bj, At, Bt) do { __builtin_amdgcn_s_setprio(1); _Pragma("unroll") for (int m = 0; m < 4; ++m) _Pragma("unroll") for (int n = 0; n < 2; ++n) _Pragma("unroll") for (int k = 0; k < 2; ++k) \
    acc[ai][bj][m][n] = __builtin_amdgcn_mfma_f32_16x16x32_bf16(Bt[n][k], At[m][k], acc[ai][bj][m][n], 0, 0, 0); __builtin_amdgcn_s_setprio(0); } while (0)
#define PG8_WAIT_V(n) asm volatile("s_waitcnt vmcnt(" #n ")" ::: "memory")
#define PG8_WAIT_L(n) asm volatile("s_waitcnt lgkmcnt(" #n ")" ::: "memory")
#define PG8_BAR __builtin_amdgcn_s_barrier()
#define PG8_SCHED __builtin_amdgcn_sched_barrier(0)
  Unit cur, nxt; int ui = 0;
  if (!S.next(0, cur)) return;
  f32x4 acc[2][2][4][2];
#pragma unroll
  for (int a = 0; a < 2; ++a)
#pragma unroll
    for (int b = 0; b < 2; ++b)
#pragma unroll
      for (int m = 0; m < 4; ++m)
#pragma unroll
        for (int n = 0; n < 2; ++n) acc[a][b][m][n] = (f32x4){0.f, 0.f, 0.f, 0.f};
  bf16x8 At[4][2], B0[2][2], B1[2][2];
  const char* cA = (const char*)g.A + (size_t)cur.pm * tstepA; const char* cB = (const char*)g.Bt + (size_t)cur.pn * tstepB;
  PG8_STAGE(PG8_SB(0, 0), cB, voffB); PG8_STAGE(PG8_SA(0, 0), cA, voffA); PG8_STAGE(PG8_SB(0, 1), cB + hstepB, voffB); PG8_STAGE(PG8_SA(0, 1), cA + hstepA, voffA);
  if (wr == 1) PG8_BAR;
  PG8_WAIT_V(4); PG8_BAR;
  PG8_STAGE(PG8_SB(1, 0), cB + kstep, voffB); PG8_STAGE(PG8_SA(1, 0), cA + kstep, voffA); PG8_STAGE(PG8_SB(1, 1), cB + hstepB + kstep, voffB);
  PG8_WAIT_V(6); PG8_BAR;
  for (;;) {
    const bool has_next = S.next(ui + 1, nxt);
    const char* nA = has_next ? (const char*)g.A + (size_t)nxt.pm * tstepA : cA; const char* nB = has_next ? (const char*)g.Bt + (size_t)nxt.pn * tstepB : cB;
    for (int t = 0; t < nt; t += 2) {
      const bool last = (t == nt - 2);
      const char* a1 = cA + (size_t)(t + 1) * kstep;
      const char* a2 = last ? nA : cA + (size_t)(t + 2) * kstep; const char* b2 = last ? nB : cB + (size_t)(t + 2) * kstep;
      const char* a3 = a2 + kstep; const char* b3 = b2 + kstep;
      PG8_LDB(B0, 0, 0); PG8_SCHED; PG8_LDA(At, 0, 0); PG8_STAGE(PG8_SA(1, 1), a1 + hstepA, voffA);
      PG8_WAIT_L(8); PG8_BAR; PG8_WAIT_L(0); PG8_MMA(0, 0, At, B0); PG8_BAR; PG8_SCHED;
      PG8_LDB(B1, 0, 1); PG8_STAGE(PG8_SB(0, 0), b2, voffB);
      PG8_BAR; PG8_WAIT_L(0); PG8_MMA(0, 1, At, B1); PG8_BAR;
      PG8_LDA(At, 0, 1); PG8_STAGE(PG8_SA(0, 0), a2, voffA);
      PG8_BAR; PG8_WAIT_L(0); PG8_MMA(1, 0, At, B0); PG8_BAR; PG8_SCHED;
      PG8_STAGE(PG8_SB(0, 1), b2 + hstepB, voffB);
      PG8_WAIT_V(6); PG8_BAR; PG8_MMA(1, 1, At, B1); PG8_BAR;
      PG8_LDB(B0, 1, 0); PG8_SCHED; PG8_LDA(At, 1, 0); PG8_STAGE(PG8_SA(0, 1), a2 + hstepA, voffA);
      PG8_WAIT_L(8); PG8_BAR; PG8_WAIT_L(0); PG8_MMA(0, 0, At, B0); PG8_BAR; PG8_SCHED;
      PG8_LDB(B1, 1, 1); PG8_STAGE(PG8_SB(1, 0), b3, voffB);
      PG8_BAR; PG8_WAIT_L(0); PG8_MMA(0, 1, At, B1); PG8_BAR;
      PG8_LDA(At, 1, 1); PG8_STAGE(PG8_SA(1, 0), a3, voffA);
      PG8_BAR; PG8_WAIT_L(0); PG8_MMA(1, 0, At, B0); PG8_BAR; PG8_SCHED;
      PG8_STAGE(PG8_SB(1, 1), b3 + hstepB, voffB);
      PG8_WAIT_V(6); PG8_BAR; PG8_MMA(1, 1, At, B1); PG8_BAR;
    }
    E(acc, cur, wr, wc, fr, fq);
    if (!has_next) break;
#pragma unroll
    for (int a = 0; a < 2; ++a)
#pragma unroll
      for (int b = 0; b < 2; ++b)
#pragma unroll
        for (int m = 0; m < 4; ++m)
#pragma unroll
          for (int n = 0; n < 2; ++n) acc[a][b][m][n] = (f32x4){0.f, 0.f, 0.f, 0.f};
    cur = nxt; cA = nA; cB = nB; ++ui;
  }
  PG8_WAIT_V(0);
  if (wr == 0) PG8_BAR;
  PG8_BAR;
#undef PG8_SA
#undef PG8_SB
#undef PG8_STAGE
#undef PG8_LDA
#undef PG8_LDB
#undef PG8_MMA
#undef PG8_WAIT_V
#undef PG8_WAIT_L
#undef PG8_BAR
#undef PG8_SCHED
}
typedef const f32x4 (&AccRef)[2][2][4][2];
struct EpiInprojN {
  static constexpr bool PERM = true;
  u16* qk; u16* rg;
  __device__ __forceinline__ void operator()(AccRef acc, const Unit& u, int wr, int wc, int fr, int fq) const {
    const int row0 = u.pm * BM + wr * 64 + fr;
    u16* base; int ld, colt;
    if (u.pn < 4) { base = qk; ld = 1024; colt = u.pn * 256; } else { base = rg; ld = 512; colt = (u.pn - 9) * 256; }
    const int col0 = colt + wc * 32 + 8 * fq;
#pragma unroll
    for (int ai = 0; ai < 2; ++ai)
#pragma unroll
      for (int m = 0; m < 4; ++m) {
        u16* rowp = base + (size_t)(row0 + ai * HALF + m * 16) * ld + col0;
#pragma unroll
        for (int bj = 0; bj < 2; ++bj) {
          const f32x4 v0 = acc[ai][bj][m][0], v1 = acc[ai][bj][m][1];
          u32x4 w; w.x = pk2(v0[0], v0[1]); w.y = pk2(v0[2], v0[3]); w.z = pk2(v1[0], v1[1]); w.w = pk2(v1[2], v1[3]);
          *(u32x4*)(rowp + bj * HALF) = w;
        }
      }
  }
};
struct EpiInprojT {
  static constexpr bool PERM = true;
  u16 *vT, *vTc, *hyT, *hyTc;
  __device__ __forceinline__ void operator()(AccRef acc, const Unit& u, int wr, int wc, int fr, int fq) const {
    const bool isctx = (u.pn >= 128);
    const int b = isctx ? (u.pn - 128) : (u.pn >> 4);
    const int Lseg = isctx ? 256 : 4096, t0 = isctx ? 0 : (u.pn & 15) * 256;
    const bool isv = (u.pm < 2);
    const size_t boff = isv ? (isctx ? (size_t)16777216 : (size_t)0) : (isctx ? (size_t)(16777216 + 1048576 + 25165824) : (size_t)(16777216 + 1048576));
    u16* base = vT + boff;
    const int nc = isv ? 512 : 768;
    const int wrow0 = (isv ? u.pm : u.pm - 2) * BM + wr * 64 + fr;
    const int col0 = t0 + wc * 32 + 8 * fq;
#pragma unroll
    for (int ai = 0; ai < 2; ++ai)
#pragma unroll
      for (int m = 0; m < 4; ++m) {
        u16* rowp = base + ((size_t)(b * nc + wrow0 + ai * HALF + m * 16)) * Lseg + col0;
#pragma unroll
        for (int bj = 0; bj < 2; ++bj) {
          const f32x4 v0 = acc[ai][bj][m][0], v1 = acc[ai][bj][m][1];
          u32x4 w; w.x = pk2(v0[0], v0[1]); w.y = pk2(v0[2], v0[3]); w.z = pk2(v1[0], v1[1]); w.w = pk2(v1[2], v1[3]);
          *(u32x4*)(rowp + bj * HALF) = w;
        }
      }
  }
};
struct EpiGate {
  static constexpr bool PERM = true;
  unsigned char* g8; const float* bias;
  __device__ __forceinline__ void operator()(AccRef acc, const Unit& u, int wr, int wc, int fr, int fq) const {
    const int row0 = u.pm * BM + wr * 64 + fr;
    const int col0 = u.pn * BM + wc * 32 + 8 * fq;
#pragma unroll
    for (int bj = 0; bj < 2; ++bj) {
      const f32x4 b0 = *(const f32x4*)(bias + col0 + bj * HALF), b1 = *(const f32x4*)(bias + col0 + bj * HALF + 4);
#pragma unroll
      for (int ai = 0; ai < 2; ++ai)
#pragma unroll
        for (int m = 0; m < 4; ++m) {
          const f32x4 v0 = acc[ai][bj][m][0] + b0, v1 = acc[ai][bj][m][1] + b1;
          unsigned w0 = 0, w1 = 0;
#pragma unroll
          for (int k = 0; k < 4; ++k) {
            w0 |= (unsigned)(sigmoidf_(v0[k]) * 255.0f + 0.5f) << (8 * k);
            w1 |= (unsigned)(sigmoidf_(v1[k]) * 255.0f + 0.5f) << (8 * k);
          }
          *(uint2*)(g8 + (size_t)(row0 + ai * HALF + m * 16) * 3072 + col0 + bj * HALF) = make_uint2(w0, w1);
        }
    }
  }
};
struct EpiBranch {
  static constexpr bool PERM = true;
  u16* mbuf; const unsigned char* g8; int br;
  __device__ __forceinline__ void operator()(AccRef acc, const Unit& u, int wr, int wc, int fr, int fq) const {
    const int row0 = u.pm * BM + wr * 64 + fr;
    const int col0 = u.pn * BM + wc * 32 + 8 * fq;
#pragma unroll
    for (int ai = 0; ai < 2; ++ai)
#pragma unroll
      for (int m = 0; m < 4; ++m) {
        const size_t row = (size_t)(row0 + ai * HALF + m * 16);
#pragma unroll
        for (int bj = 0; bj < 2; ++bj) {
          const uint2 gq = *(const uint2*)(g8 + row * 3072 + br * 1024 + col0 + bj * HALF);
          u16* mp = mbuf + row * 1024 + col0 + bj * HALF;
          const f32x4 v0 = acc[ai][bj][m][0], v1 = acc[ai][bj][m][1];
          float r[8];
          r[0] = (float)(gq.x & 255u) * v0[0]; r[1] = (float)((gq.x >> 8) & 255u) * v0[1];
          r[2] = (float)((gq.x >> 16) & 255u) * v0[2]; r[3] = (float)(gq.x >> 24) * v0[3];
          r[4] = (float)(gq.y & 255u) * v1[0]; r[5] = (float)((gq.y >> 8) & 255u) * v1[1];
          r[6] = (float)((gq.y >> 16) & 255u) * v1[2]; r[7] = (float)(gq.y >> 24) * v1[3];
          u32x4 w;
          if (br == 0) {
            w.x = pk2(r[0] * (1.f / 255.f), r[1] * (1.f / 255.f)); w.y = pk2(r[2] * (1.f / 255.f), r[3] * (1.f / 255.f));
            w.z = pk2(r[4] * (1.f / 255.f), r[5] * (1.f / 255.f)); w.w = pk2(r[6] * (1.f / 255.f), r[7] * (1.f / 255.f));
          } else {
            const u32x4 o = *(const u32x4*)mp;
            w.x = pk2(bflo(o.x) + r[0] * (1.f / 255.f), bfhi(o.x) + r[1] * (1.f / 255.f));
            w.y = pk2(bflo(o.y) + r[2] * (1.f / 255.f), bfhi(o.y) + r[3] * (1.f / 255.f));
            w.z = pk2(bflo(o.z) + r[4] * (1.f / 255.f), bfhi(o.z) + r[5] * (1.f / 255.f));
            w.w = pk2(bflo(o.w) + r[6] * (1.f / 255.f), bfhi(o.w) + r[7] * (1.f / 255.f));
          }
          *(u32x4*)mp = w;
        }
      }
  }
};
struct EpiOut {
  static constexpr bool PERM = false;
  const float *xsrc, *csrc; float *xdst, *cdst; const float* modl;
  __device__ __forceinline__ void operator()(AccRef acc, const Unit& u, int wr, int wc, int fr, int fq) const {
    const bool isctx = (u.pm >= 128);
    const int bi = isctx ? 8 : (u.pm >> 4);
    const float* gatev = modl + ((size_t)bi * 6 + 2) * 1024;
    const float* src = isctx ? (csrc - (size_t)NLAT * 1024) : xsrc;
    float* dst = isctx ? (cdst - (size_t)NLAT * 1024) : xdst;
    const int row0 = u.pm * BM + wr * 64 + fr, col0 = u.pn * BM + wc * 32 + 4 * fq;
#pragma unroll
    for (int bj = 0; bj < 2; ++bj)
#pragma unroll
      for (int n = 0; n < 2; ++n) {
        const int col = col0 + bj * HALF + n * 16;
        const f32x4 gv = *(const f32x4*)(gatev + col);
#pragma unroll
        for (int ai = 0; ai < 2; ++ai)
#pragma unroll
          for (int m = 0; m < 4; ++m) {
            const size_t o = (size_t)(row0 + ai * HALF + m * 16) * 1024 + col;
            const f32x4 xv = *(const f32x4*)(src + o);
            *(f32x4*)(dst + o) = xv + gv * acc[ai][bj][m][n];
          }
      }
  }
};
struct EpiQ {
  static constexpr bool PERM = true;
  u16* q;
  __device__ __forceinline__ void operator()(AccRef acc, const Unit& u, int wr, int wc, int fr, int fq) const {
    const int row0 = u.pm * BM + wr * 64 + fr;
    const int col0 = u.pn * BM + wc * 32 + 8 * fq;
#pragma unroll
    for (int ai = 0; ai < 2; ++ai)
#pragma unroll
      for (int m = 0; m < 4; ++m) {
        u16* rowp = q + (size_t)(row0 + ai * HALF + m * 16) * 2048 + col0;
#pragma unroll
        for (int bj = 0; bj < 2; ++bj) {
          const f32x4 v0 = acc[ai][bj][m][0], v1 = acc[ai][bj][m][1];
          u32x4 w;
          w.x = __builtin_bit_cast(unsigned, __builtin_amdgcn_cvt_pkrtz(v0[0], v0[1]));
          w.y = __builtin_bit_cast(unsigned, __builtin_amdgcn_cvt_pkrtz(v0[2], v0[3]));
          w.z = __builtin_bit_cast(unsigned, __builtin_amdgcn_cvt_pkrtz(v1[0], v1[1]));
          w.w = __builtin_bit_cast(unsigned, __builtin_amdgcn_cvt_pkrtz(v1[2], v1[3]));
          *(u32x4*)(rowp + bj * HALF) = w;
        }
      }
  }
};
}

__device__ __forceinline__ void tr_tile(const float* __restrict__ src, int N, int K, u16* __restrict__ dst, int tile, char* smem) {
  float* lds = (float*)smem;
  const int tiles_n = N >> 6;
  const int tk = tile / tiles_n, tn = tile - tk * tiles_n;
  const int tid = opaque_tid();
  {
    const int r = tid >> 3, c8 = (tid & 7) * 8;
    const float* s = src + (size_t)(tk * 64 + r) * N + tn * 64 + c8;
    float4 a = *(const float4*)s, b = *(const float4*)(s + 4);
    float* d = lds + r * 65 + c8;
    d[0] = a.x; d[1] = a.y; d[2] = a.z; d[3] = a.w; d[4] = b.x; d[5] = b.y; d[6] = b.z; d[7] = b.w;
  }
  __syncthreads();
  {
    const int n = tid >> 3, k0 = (tid & 7) * 8;
    uint4 o;
    o.x = pk2(lds[(k0 + 0) * 65 + n], lds[(k0 + 1) * 65 + n]);
    o.y = pk2(lds[(k0 + 2) * 65 + n], lds[(k0 + 3) * 65 + n]);
    o.z = pk2(lds[(k0 + 4) * 65 + n], lds[(k0 + 5) * 65 + n]);
    o.w = pk2(lds[(k0 + 6) * 65 + n], lds[(k0 + 7) * 65 + n]);
    *(uint4*)(dst + (size_t)(tn * 64 + n) * K + tk * 64 + k0) = o;
  }
  __syncthreads();
}
__device__ __forceinline__ void cvt_chunk(const float* __restrict__ src, u16* __restrict__ dst, size_t chunk) {
  const size_t i = chunk * 4096 + (size_t)opaque_tid() * 8;
  float4 a = *(const float4*)(src + i), b = *(const float4*)(src + i + 4);
  uint4 o;
  o.x = pk2(a.x, a.y); o.y = pk2(a.z, a.w); o.z = pk2(b.x, b.y); o.w = pk2(b.z, b.w);
  *(uint4*)(dst + i) = o;
}
__device__ __forceinline__ void cvt_chunk_fp8(const float* __restrict__ src, unsigned char* __restrict__ dst, size_t chunk, float scale) {
  const size_t i = chunk * 4096 + (size_t)opaque_tid() * 8;
  const float4 a = *(const float4*)(src + i), b = *(const float4*)(src + i + 4);
  int w0 = __builtin_amdgcn_cvt_pk_fp8_f32(a.x * scale, a.y * scale, 0, false);
  w0 = __builtin_amdgcn_cvt_pk_fp8_f32(a.z * scale, a.w * scale, w0, true);
  int w1 = __builtin_amdgcn_cvt_pk_fp8_f32(b.x * scale, b.y * scale, 0, false);
  w1 = __builtin_amdgcn_cvt_pk_fp8_f32(b.z * scale, b.w * scale, w1, true);
  *(uint2*)(dst + i) = make_uint2((unsigned)w0, (unsigned)w1);
}
__device__ __forceinline__ void cvt_chunk_fp4(const float* __restrict__ src, unsigned char* __restrict__ dst, size_t chunk, float scale) {
  const size_t i = chunk * 4096 + (size_t)opaque_tid() * 8;
  const float4 a = *(const float4*)(src + i), b = *(const float4*)(src + i + 4);
  unsigned w = 0;
  w = __builtin_amdgcn_cvt_scalef32_pk_fp4_f32(w, a.x * scale, a.y * scale, 1.0f, 0);
  w = __builtin_amdgcn_cvt_scalef32_pk_fp4_f32(w, a.z * scale, a.w * scale, 1.0f, 1);
  w = __builtin_amdgcn_cvt_scalef32_pk_fp4_f32(w, b.x * scale, b.y * scale, 1.0f, 2);
  w = __builtin_amdgcn_cvt_scalef32_pk_fp4_f32(w, b.z * scale, b.w * scale, 1.0f, 3);
  *(unsigned*)(dst + (i >> 1)) = w;
}
__device__ __forceinline__ void phase_prep(const P& p, char* smem) {
  const int tid = opaque_tid();
  const int NTR = 2512;
  const int total = 2 * NTR + 128 + 384;
  for (int task = blockIdx.x; task < total; task += gridDim.x) {
    if (task < 2 * NTR) {
      const int l = task / NTR;
      int t = task - l * NTR;
      if (t < 704) tr_tile(p.w_in + (size_t)l * 1024 * 2816, 2816, 1024, p.WinT + (size_t)l * 2816 * 1024, t, smem);
      else if ((t -= 704) < 768) tr_tile(p.w_gate + (size_t)l * 1024 * 3072, 3072, 1024, p.WgT + (size_t)l * 3072 * 1024, t, smem);
      else if ((t -= 768) < 128) tr_tile(p.w_br_a + (size_t)l * 512 * 1024, 1024, 512, p.WaT + (size_t)l * 1024 * 512, t, smem);
      else if ((t -= 128) < 64) tr_tile(p.w_br_b + (size_t)l * 256 * 1024, 1024, 256, p.WbT + (size_t)l * 1024 * 256, t, smem);
      else if ((t -= 64) < 64) tr_tile(p.w_br_c + (size_t)l * 256 * 1024, 1024, 256, p.WcT + (size_t)l * 1024 * 256, t, smem);
      else if ((t -= 64) < 256) tr_tile(p.w_out + (size_t)l * 1024 * 1024, 1024, 1024, p.WoT + (size_t)l * 1024 * 1024, t, smem);
      else if ((t -= 256) < 512) cvt_chunk(p.peer_wq + (size_t)l * 1024 * 2048, p.WqB + (size_t)l * 1024 * 2048, (size_t)t);
      else {
        t -= 512;
        const int gate = t >> 3, dn = t & 7;
        const float* src = (gate ? p.rg_wx : p.rg_wa) + (size_t)(l * 8 + dn) * 4096;
        tr_tile(src, 64, 64, p.rgW + (size_t)((l * 2 + gate) * 8 + dn) * 4096, 0, smem);
      }
    } else if (task < 2 * NTR + 128) {
      cvt_chunk(p.peer_keys, p.keysB, (size_t)(task - 2 * NTR));
    } else {
      int t = task - 2 * NTR - 128;
      const int kc = t & 15; t >>= 4;
      const int jc = t % 12, l = t / 12;
      float* s = (float*)smem;
      for (int i = tid; i < 576; i += NTHR) {
        const int bi = i >> 6, kk = i & 63;
        const float v = (bi < 8) ? p.c[bi * 1024 + kc * 64 + kk] : p.c_ctx[kc * 64 + kk];
        s[i] = v / (1.0f + __expf(-v));
      }
      __syncthreads();
      const int j = jc * 512 + tid;
      float acc[9];
#pragma unroll
      for (int bi = 0; bi < 9; ++bi) acc[bi] = 0.f;
      const float* wp = p.w_ada + ((size_t)l * 1024 + kc * 64) * 6144 + j;
#pragma unroll 8
      for (int kk = 0; kk < 64; ++kk) {
        const float w = wp[(size_t)kk * 6144];
#pragma unroll
        for (int bi = 0; bi < 9; ++bi) acc[bi] += s[bi * 64 + kk] * w;
      }
#pragma unroll
      for (int bi = 0; bi < 9; ++bi) p.modpart[((size_t)(kc * 2 + l) * 9 + bi) * 6144 + j] = acc[bi];
      __syncthreads();
    }
  }
}
__device__ __forceinline__ void phase_modreduce(const P& p) {
  const int n = 2 * 9 * 6144;
  for (int i = blockIdx.x * NTHR + opaque_tid(); i < n; i += gridDim.x * NTHR) {
    const int l = i / (9 * 6144);
    const int j = i % 6144;
    float s = p.b_ada[l * 6144 + j];
#pragma unroll
    for (int kc = 0; kc < 16; ++kc) s += p.modpart[(size_t)kc * n + i];
    p.mod[i] = s;
  }
}

__device__ __forceinline__ void phase_norm(const P& p, int l, int which) {
  const int tid_ = opaque_tid(); const int lane = tid_ & 63, wid = tid_ >> 6;
  const int ntok = (which == 2 || (which == 1 && l == 1)) ? NLAT : NTOK;
  for (int row = blockIdx.x * 8 + wid; row < ntok; row += gridDim.x * 8) {
    const float* src;
    if (row < NLAT) src = ((which == 0 && l == 0) ? p.x : p.out) + (size_t)row * 1024;
    else src = ((which == 0 && l == 0) ? p.ctx : p.ctxs) + (size_t)(row - NLAT) * 1024;
    float4 v[4];
    float ss = 0.f;
#pragma unroll
    for (int i = 0; i < 4; ++i) {
      v[i] = *(const float4*)(src + i * 256 + lane * 4);
      ss += v[i].x * v[i].x + v[i].y * v[i].y + v[i].z * v[i].z + v[i].w * v[i].w;
    }
    ss = wave_sum(ss);
    const float rstd = rsqrtf(ss * (1.0f / 1024.0f) + 1e-6f);
    if (which == 2) {
#pragma unroll
      for (int i = 0; i < 4; ++i) {
        const int col = i * 256 + lane * 4;
        const float4 g = *(const float4*)(p.final_g + col);
        float4 o = {v[i].x * rstd * g.x, v[i].y * rstd * g.y, v[i].z * rstd * g.z, v[i].w * rstd * g.w};
        *(float4*)(p.out + (size_t)row * 1024 + col) = o;
      }
    } else {
      const int bi = row < NLAT ? (row >> 12) : 8;
      const float* gam = (which == 0 ? p.norm_mix_g : p.norm_ffn_g) + l * 1024;
      const float* msh = p.mod + ((size_t)(l * 9 + bi) * 6 + (which == 0 ? 0 : 3)) * 1024;
      const float* msc = msh + 1024;
#pragma unroll
      for (int i = 0; i < 4; ++i) {
        const int col = i * 256 + lane * 4;
        const float4 g = *(const float4*)(gam + col);
        const float4 sh = *(const float4*)(msh + col);
        const float4 sc = *(const float4*)(msc + col);
        uint2 o;
        o.x = pk2(v[i].x * rstd * g.x * (1.f + sc.x) + sh.x, v[i].y * rstd * g.y * (1.f + sc.y) + sh.y);
        o.y = pk2(v[i].z * rstd * g.z * (1.f + sc.z) + sh.z, v[i].w * rstd * g.w * (1.f + sc.w) + sh.w);
        *(uint2*)(p.xn + (size_t)row * 1024 + col) = o;
      }
    }
  }
}

__device__ __forceinline__ void filter_wave(const P& p, int l, int L, int t, float* __restrict__ outp) {
  const int lane = opaque_tid() & 63;
  const float tl = (float)t / (float)(L - 1);
  const float wang = (6.283185307179586f / (float)L) * (float)t;
  float z = 0.f;
  if (lane == 0) z = tl;
  else if (lane <= 16) { const float band = 1e-4f + (float)(lane - 1) * ((15.0f - 1e-4f) / 15.0f); z = cosf(band * wang); }
  else if (lane <= 32) { const float band = 1e-4f + (float)(lane - 17) * ((15.0f - 1e-4f) / 15.0f); z = -sinf(band * wang); }
  float a1 = p.hy_f1_b[l * 64 + lane];
  for (int i = 0; i < 33; ++i) a1 += shf(z, i) * p.hy_f1_w[(l * 33 + i) * 64 + lane];
  const float h1 = sinf(p.hy_freq[l * 128 + lane] * a1);
  float a2 = p.hy_f2_b[l * 64 + lane];
  for (int i = 0; i < 64; ++i) a2 += shf(h1, i) * p.hy_f2_w[(l * 64 + i) * 64 + lane];
  const float h2 = sinf(p.hy_freq[l * 128 + 64 + lane] * a2);
  float a3[8];
#pragma unroll
  for (int m = 0; m < 8; ++m) a3[m] = 0.f;
  for (int i = 0; i < 64; ++i) {
    const float hv = shf(h2, i);
    const float* wr = p.hy_f3_w + (size_t)(l * 64 + i) * 512 + lane;
#pragma unroll
    for (int m = 0; m < 8; ++m) a3[m] += hv * wr[m * 64];
  }
  const float LN100 = 4.605170185988092f;
  const float d0 = LN100 / 1.5f, d1 = LN100 / 0.3f;
#pragma unroll
  for (int m = 0; m < 8; ++m) {
    const int cp = lane + 64 * m;
    const int ch = cp & 255;
    const float delta = d0 + (float)ch * ((d1 - d0) / 255.0f);
    outp[(size_t)cp * L + t] = a3[m] * expf(-tl * delta);
  }
}
__device__ __forceinline__ void phase_filters(const P& p, int l) {
  const int wid = opaque_tid() >> 6;
  const int ntask = 4096 + (l == 0 ? 256 : 0);
  for (int t = blockIdx.x * 8 + wid; t < ntask; t += gridDim.x * 8) {
    if (t < 4096) filter_wave(p, l, 4096, t, p.hT + (size_t)l * 512 * 4096);
    else filter_wave(p, l, 256, t - 4096, p.hc);
  }
}
__device__ __forceinline__ void kf_task(const P& p, int l, int c, char* smem) {
  const float* hTl = p.hT + (size_t)l * 512 * 4096;
  c2* buf = (c2*)smem;
  const int tid = opaque_tid();
  for (int i = 0; i < 16; ++i) {
    const int j = tid + NTHR * i;
    float v;
    if (j < 4096) v = hTl[(size_t)c * 4096 + j];
    else if (j == 4096) v = 0.f;
    else v = hTl[(size_t)(256 + c) * 4096 + (8192 - j)];
    buf[j] = {v, 0.f};
  }
  __syncthreads();
  fft8192(buf, -1.f);
  c2* o = (c2*)p.Kf + ((size_t)l * 256 + c) * 8192;
  for (int i = 0; i < 16; ++i) { const int j = tid + NTHR * i; o[j] = buf[j]; }
  __syncthreads();
}

__device__ __forceinline__ void inproj_tile(const P& p, int l, int mt, int nt, char* smem) {
  f32x16 acc[2][2];
  zero_acc(acc);
  const int m0 = mt * 256, n0 = nt * 128;
  gemm_kloop(acc, p.xn + (size_t)m0 * 1024, 1024, p.WinT + ((size_t)l * 2816 + n0) * 1024, 1024, 1024, smem);
  EPI_VARS
  if (nt < 8 || nt >= 18) {
    u16* dst; int ld, cbase;
    if (nt < 8) { dst = p.qk; ld = 1024; cbase = n0; }
    else { dst = p.rg; ld = 512; cbase = n0 - 2304; }
#pragma unroll
    for (int i = 0; i < 2; ++i)
#pragma unroll
      for (int j = 0; j < 2; ++j)
#pragma unroll
        for (int e = 0; e < 16; ++e)
          dst[(size_t)(m0 + EPI_ROW(i, e)) * ld + cbase + EPI_COL(j)] = f2bf(acc[i][j][e]);
  } else {
#pragma unroll
    for (int i = 0; i < 2; ++i)
#pragma unroll
      for (int j = 0; j < 2; ++j)
#pragma unroll
        for (int qd = 0; qd < 4; ++qd) {
          uint2 o;
          o.x = pk2(acc[i][j][4 * qd + 0], acc[i][j][4 * qd + 1]);
          o.y = pk2(acc[i][j][4 * qd + 2], acc[i][j][4 * qd + 3]);
          const int row0 = wm * 64 + i * 32 + 8 * qd + 4 * hh;
          *(uint2*)(smem + EPI_COL(j) * 520 + row0 * 2) = o;
        }
    __syncthreads();
    u16* dstT; int Lseg, t0, ncol0, nc;
    const bool isctx = (mt >= 128);
    const int b = isctx ? (mt - 128) : (mt >> 4);
    if (nt < 12) { ncol0 = n0 - 1024; nc = 512; dstT = isctx ? p.vTc : p.vT; }
    else { ncol0 = n0 - 1536; nc = 768; dstT = isctx ? p.hyTc : p.hyT; }
    if (isctx) { Lseg = 256; t0 = 0; } else { Lseg = 4096; t0 = (mt & 15) * 256; }
#pragma unroll 4
    for (int it = 0; it < 16; ++it) {
      const int idx = tid + NTHR * it;
      const int col = idx >> 6, u = idx & 63;
      const uint2 v = *(const uint2*)(smem + col * 520 + u * 8);
      *(uint2*)(dstT + ((size_t)(b * nc + ncol0 + col)) * Lseg + t0 + u * 4) = v;
    }
    __syncthreads();
  }
}

__device__ __forceinline__ float ldbf(const u16* p, int t, int L) { return (t >= 0 && t < L) ? bf2f(p[t]) : 0.f; }
__device__ __forceinline__ void ld10(const u16* __restrict__ seq, int t0, float (&v)[10]) {
  const uint4 r = *(const uint4*)(seq + t0);
  v[0] = (t0 > 0) ? bf2f(seq[t0 - 1]) : 0.f;
  v[9] = (t0 + 8 < 4096) ? bf2f(seq[t0 + 8]) : 0.f;
  v[1] = bflo(r.x); v[2] = bfhi(r.x); v[3] = bflo(r.y); v[4] = bfhi(r.y);
  v[5] = bflo(r.z); v[6] = bfhi(r.z); v[7] = bflo(r.w); v[8] = bfhi(r.w);
}
__device__ __forceinline__ void hyena_fft_task(const P& p, int l, int c, int bp, char* smem) {
  c2* buf = (c2*)smem;
  c2* ub = (c2*)(smem + 65536);
  const int tid = opaque_tid();
  const float* sw = p.hy_short_w + l * 3 * 768;
  const float* sb = p.hy_short_b + l * 768;
  const float wx0[3] = {sw[c], sw[768 + c], sw[1536 + c]};
  const float wx1[3] = {sw[256 + c], sw[768 + 256 + c], sw[1536 + 256 + c]};
  const float wv[3] = {sw[512 + c], sw[768 + 512 + c], sw[1536 + 512 + c]};
  const float bx0 = sb[c], bx1 = sb[256 + c], bv = sb[512 + c];
  const float dsk = p.hy_bias[l * 256 + c];
  const int t0 = tid * 8;
  {
    float u[2][8];
#pragma unroll
    for (int bb = 0; bb < 2; ++bb) {
      const int b = 2 * bp + bb;
      float x1[10], vv[10];
      ld10(p.hyT + ((size_t)(b * 768 + 256 + c)) * 4096, t0, x1);
      ld10(p.hyT + ((size_t)(b * 768 + 512 + c)) * 4096, t0, vv);
#pragma unroll
      for (int k = 0; k < 8; ++k) {
        const float x1c = bx1 + wx1[0] * x1[k] + wx1[1] * x1[k + 1] + wx1[2] * x1[k + 2];
        const float vc = bv + wv[0] * vv[k] + wv[1] * vv[k + 1] + wv[2] * vv[k + 2];
        u[bb][k] = vc * x1c;
      }
    }
#pragma unroll
    for (int k = 0; k < 8; k += 2) {
      const float4 w = make_float4(u[0][k], u[1][k], u[0][k + 1], u[1][k + 1]);
      *(float4*)(buf + t0 + k) = w;
      *(float4*)(ub + t0 + k) = w;
      *(float4*)(buf + 4096 + t0 + k) = make_float4(0.f, 0.f, 0.f, 0.f);
    }
  }
  __syncthreads();
  fft8192(buf, -1.f);
  const c2* kf = (const c2*)p.Kf + ((size_t)l * 256 + c) * 8192;
  for (int i = 0; i < 16; ++i) {
    const int k = tid + NTHR * i;
    buf[k] = cmul(buf[k], kf[k]);
  }
  __syncthreads();
  fft8192(buf, 1.f);
#pragma unroll
  for (int bb = 0; bb < 2; ++bb) {
    const int b = 2 * bp + bb;
    float x0[10];
    ld10(p.hyT + ((size_t)(b * 768 + c)) * 4096, t0, x0);
    float o[8];
#pragma unroll
    for (int k = 0; k < 8; ++k) {
      const c2 y = buf[t0 + k];
      const c2 uu = ub[t0 + k];
      const float x0c = bx0 + wx0[0] * x0[k] + wx0[1] * x0[k + 1] + wx0[2] * x0[k + 2];
      const float yy = ldexpf(bb ? y.y : y.x, -13);
      const float uv = bb ? uu.y : uu.x;
      o[k] = x0c * (yy + uv * dsk);
    }
    uint4 w; w.x = pk2(o[0], o[1]); w.y = pk2(o[2], o[3]); w.z = pk2(o[4], o[5]); w.w = pk2(o[6], o[7]);
    *(uint4*)(p.ybT + ((size_t)(b * 256 + c)) * 4096 + t0) = w;
  }
  __syncthreads();
}
__device__ __forceinline__ void yb_transpose_task(const P& p, int b, int tb, char* smem) {
  const int tid = opaque_tid(), lane = tid & 63, wid = tid >> 6;
  u16* T = (u16*)smem;
#pragma unroll
  for (int it = 0; it < 4; ++it) {
    const int id = tid + NTHR * it;
    const int c = id >> 3, ch = id & 7;
    const uint4 r = *(const uint4*)(p.ybT + ((size_t)(b * 256 + c)) * 4096 + tb * 64 + ch * 8);
    unsigned* d = (unsigned*)(T + c * 66 + ch * 8);
    d[0] = r.x; d[1] = r.y; d[2] = r.z; d[3] = r.w;
  }
  __syncthreads();
#pragma unroll
  for (int it = 0; it < 8; ++it) {
    const int tt = wid + 8 * it;
    const int c0 = lane * 4;
    uint2 w;
    w.x = (unsigned)T[(c0 + 0) * 66 + tt] | ((unsigned)T[(c0 + 1) * 66 + tt] << 16);
    w.y = (unsigned)T[(c0 + 2) * 66 + tt] | ((unsigned)T[(c0 + 3) * 66 + tt] << 16);
    *(uint2*)(p.ycat + (size_t)(b * 4096 + tb * 64 + tt) * 1024 + 512 + c0) = w;
  }
  __syncthreads();
}
__device__ __forceinline__ void hyena_ctx_task(const P& p, int l, int b, int cg8, char* smem) {
  const int tid_ = opaque_tid(); const int lane = tid_ & 63, wid = tid_ >> 6;
  const int c = cg8 * 8 + wid;
  float* us = (float*)smem + wid * 1024;
  float* kfp = us + 256 + 255;
  const float* sw = p.hy_short_w + l * 3 * 768;
  const float* sb = p.hy_short_b + l * 768;
  const u16* x0 = p.hyTc + ((size_t)(b * 768 + c)) * 256;
  const u16* x1 = p.hyTc + ((size_t)(b * 768 + 256 + c)) * 256;
  const u16* vv = p.hyTc + ((size_t)(b * 768 + 512 + c)) * 256;
  for (int i = 0; i < 4; ++i) {
    const int t = lane + 64 * i;
    const float x1c = sb[256 + c] + sw[256 + c] * ldbf(x1, t - 1, 256) + sw[768 + 256 + c] * ldbf(x1, t, 256) + sw[1536 + 256 + c] * ldbf(x1, t + 1, 256);
    const float vc = sb[512 + c] + sw[512 + c] * ldbf(vv, t - 1, 256) + sw[768 + 512 + c] * ldbf(vv, t, 256) + sw[1536 + 512 + c] * ldbf(vv, t + 1, 256);
    us[t] = vc * x1c;
    kfp[t] = p.hc[(size_t)c * 256 + t];
    if (t > 0) kfp[-t] = p.hc[(size_t)(256 + c) * 256 + t];
  }
  __syncthreads();
  const float dsk = p.hy_bias[l * 256 + c];
  float acc[4] = {0.f, 0.f, 0.f, 0.f};
  for (int s = 0; s < 256; ++s) {
    const float uv = us[s];
#pragma unroll
    for (int i = 0; i < 4; ++i) acc[i] += kfp[lane + 64 * i - s] * uv;
  }
#pragma unroll
  for (int i = 0; i < 4; ++i) {
    const int t = lane + 64 * i;
    const float x0c = sb[c] + sw[c] * ldbf(x0, t - 1, 256) + sw[768 + c] * ldbf(x0, t, 256) + sw[1536 + c] * ldbf(x0, t + 1, 256);
    p.ycat[(size_t)(NLAT + b * 256 + t) * 1024 + 512 + c] = f2bf(x0c * (acc[i] + us[t] * dsk));
  }
  __syncthreads();
}

__device__ __forceinline__ void rg_chunk_task(const P& p, int l, int cq, int nblk, int mode, bool last, char* smem) {
  const int tid = opaque_tid(), lane = tid & 63, wid = tid >> 6;
  const int l31 = lane & 31, hh = lane >> 5;
  const int b = cq / 68, rr = cq - b * 68;
  const int seg = rr < 4 ? 0 : 1, sub = rr < 4 ? rr : rr - 4;
  if (mode == 1 && seg == 0 && last) return;
  float* xcf = (float*)smem;
  char* xcb = smem + 16384;
  float* coef = (float*)(smem + 24576);
  float2* segagg = (float2*)(smem + 90112);
  float* hin = (float*)(smem + 94208);
  float* Hout = (float*)(smem + 94720);
  float* cst = (float*)(smem + 127488);
  if (tid < 384) {
    const int dir = tid / 192, rem = tid - dir * 192, kind = rem >> 6, c = rem & 63;
    const int ch = (l * 2 + dir) * 256 + nblk * 64 + c;
    float v;
    if (kind == 0) v = p.rg_ba[ch];
    else if (kind == 1) v = p.rg_bx[ch];
    else v = __logf(1.0f + __expf(-p.rg_lambda[ch]));
    cst[tid] = v;
  }
  const int Lseg = seg ? 4096 : 256;
  const int tokbase = seg ? b * 4096 : NLAT + b * 256;
  const int T0 = sub * 64;
  const int tt = tid >> 3, c0 = (tid & 7) * 8;
  const int chb = nblk * 64 + c0;
  const int wdir = wid >> 2, wgate = (wid >> 1) & 1, wmt = wid & 1;
  bf16x8 wf[2][4];
  {
    const u16* wp = p.rgW + (size_t)(((l * 2 + wgate) * 2 + wdir) * 4 + nblk) * 4096 + l31 * 64 + 8 * hh;
#pragma unroll
    for (int nt = 0; nt < 2; ++nt)
#pragma unroll
      for (int s = 0; s < 4; ++s) wf[nt][s] = *(const bf16x8*)(wp + nt * 2048 + 16 * s);
  }
  {
    float xc[8];
#pragma unroll
    for (int c = 0; c < 8; ++c) xc[c] = p.rg_conv_b[l * 256 + chb + c];
#pragma unroll
    for (int k = 0; k < 4; ++k) {
      const int pos = T0 + tt + k - 2;
      if (pos >= 0 && pos < Lseg) {
        const uint4 raw = *(const uint4*)(p.rg + (size_t)(tokbase + pos) * 512 + chb);
        const float4 w0 = *(const float4*)(p.rg_conv_w + (l * 4 + k) * 256 + chb);
        const float4 w1 = *(const float4*)(p.rg_conv_w + (l * 4 + k) * 256 + chb + 4);
        xc[0] += w0.x * bflo(raw.x); xc[1] += w0.y * bfhi(raw.x);
        xc[2] += w0.z * bflo(raw.y); xc[3] += w0.w * bfhi(raw.y);
        xc[4] += w1.x * bflo(raw.z); xc[5] += w1.y * bfhi(raw.z);
        xc[6] += w1.z * bflo(raw.w); xc[7] += w1.w * bfhi(raw.w);
      }
    }
    *(float4*)(xcf + tt * 64 + c0) = make_float4(xc[0], xc[1], xc[2], xc[3]);
    *(float4*)(xcf + tt * 64 + c0 + 4) = make_float4(xc[4], xc[5], xc[6], xc[7]);
    uint4 o;
    o.x = pk2(xc[0], xc[1]); o.y = pk2(xc[2], xc[3]); o.z = pk2(xc[4], xc[5]); o.w = pk2(xc[6], xc[7]);
    *(uint4*)(xcb + swz128(tt, tid & 7)) = o;
  }
  __syncthreads();
  {
    f32x16 acc0 = zero16(), acc1 = zero16();
#pragma unroll
    for (int s = 0; s < 4; ++s) {
      const bf16x8 af = *(const bf16x8*)(xcb + swz128(wmt * 32 + l31, 2 * s + hh));
      acc0 = mfma32(af, wf[0][s], acc0);
      acc1 = mfma32(af, wf[1][s], acc1);
    }
    float* cp = coef + (wdir * 2 + wgate) * 4096;
#pragma unroll
    for (int e = 0; e < 16; ++e) {
      const int tok = wmt * 32 + (e & 3) + 8 * (e >> 2) + 4 * hh;
      cp[tok * 64 + l31] = acc0[e];
      cp[tok * 64 + 32 + l31] = acc1[e];
    }
  }
  __syncthreads();
#pragma unroll
  for (int dir = 0; dir < 2; ++dir) {
    float* ca = coef + (dir * 2) * 4096;
    float* cb2 = ca + 4096;
#pragma unroll
    for (int c = 0; c < 8; ++c) {
      const float sp = cst[dir * 192 + 128 + c0 + c];
      const int o = tt * 64 + c0 + c;
      const float r = sigmoidf_(ca[o] + cst[dir * 192 + c0 + c]);
      const float ii = sigmoidf_(cb2[o] + cst[dir * 192 + 64 + c0 + c]);
      const float la = -8.0f * r * sp;
      const float av = __expf(la);
      const float e2 = 2.0f * la;
      const float om = (e2 > -0.1f) ? (-e2 * (1.0f + e2 * (0.5f + e2 * (0.16666667f + e2 * 0.041666668f)))) : (1.0f - __expf(e2));
      ca[o] = av;
      cb2[o] = sqrtf(om) * ii * xcf[o];
    }
  }
  __syncthreads();
  const int sg = tid >> 7, sdir = (tid >> 6) & 1, sch = tid & 63;
  const float* sa = coef + (sdir * 2) * 4096 + sch;
  const float* sb = sa + 4096;
  {
    float Pm = 1.f, H = 0.f;
#pragma unroll
    for (int n = 0; n < 16; ++n) {
      const int tok = sdir ? (63 - (16 * sg + n)) : (16 * sg + n);
      const float av = sa[tok * 64], bv = sb[tok * 64];
      H = av * H + bv;
      Pm *= av;
    }
    segagg[(sg * 2 + sdir) * 64 + sch] = make_float2(Pm, H);
  }
  __syncthreads();
  const int pos = sdir ? (seg == 0 ? 3 - sub : 67 - sub) : (seg == 0 ? sub : 4 + sub);
  float2* aggp = (float2*)p.agg + ((size_t)(b * 2 + sdir) * 68) * 256 + nblk * 64 + sch;
  if (mode == 0) {
    if (tid < 128) {
      float A = 1.f, B = 0.f;
#pragma unroll
      for (int s2 = 0; s2 < 4; ++s2) {
        const float2 g = segagg[(s2 * 2 + sdir) * 64 + sch];
        B = g.x * B + g.y;
        A *= g.x;
      }
      aggp[(size_t)pos * 256] = make_float2(A, B);
    }
    __syncthreads();
    return;
  }
  if (tid < 128) {
    float h = 0.f;
    int j = 0;
    for (; j + 8 <= pos; j += 8) {
      float2 g[8];
#pragma unroll
      for (int u = 0; u < 8; ++u) g[u] = aggp[(size_t)(j + u) * 256];
#pragma unroll
      for (int u = 0; u < 8; ++u) h = g[u].x * h + g[u].y;
    }
    for (; j < pos; ++j) {
      const float2 g = aggp[(size_t)j * 256];
      h = g.x * h + g.y;
    }
    hin[sdir * 64 + sch] = h;
  }
  __syncthreads();
  {
    float h = hin[sdir * 64 + sch];
    for (int s2 = 0; s2 < sg; ++s2) {
      const float2 g = segagg[(s2 * 2 + sdir) * 64 + sch];
      h = g.x * h + g.y;
    }
#pragma unroll
    for (int n = 0; n < 16; ++n) {
      const int tok = sdir ? (63 - (16 * sg + n)) : (16 * sg + n);
      h = sa[tok * 64] * h + sb[tok * 64];
      Hout[sdir * 4096 + tok * 64 + sch] = h;
    }
  }
  __syncthreads();
  {
    const size_t gtok = (size_t)tokbase + T0 + tt;
    const float4 f0 = *(const float4*)(Hout + tt * 64 + c0), f1 = *(const float4*)(Hout + tt * 64 + c0 + 4);
    const float4 h0 = *(const float4*)(Hout + 4096 + tt * 64 + c0), h1 = *(const float4*)(Hout + 4096 + tt * 64 + c0 + 4);
    const uint4 g = *(const uint4*)(p.rg + gtok * 512 + 256 + chb);
    uint4 o;
    o.x = pk2((f0.x + h0.x) * gelu_tanh(bflo(g.x)), (f0.y + h0.y) * gelu_tanh(bfhi(g.x)));
    o.y = pk2((f0.z + h0.z) * gelu_tanh(bflo(g.y)), (f0.w + h0.w) * gelu_tanh(bfhi(g.y)));
    o.z = pk2((f1.x + h1.x) * gelu_tanh(bflo(g.z)), (f1.y + h1.y) * gelu_tanh(bfhi(g.z)));
    o.w = pk2((f1.z + h1.z) * gelu_tanh(bflo(g.w)), (f1.w + h1.w) * gelu_tanh(bfhi(g.w)));
    *(uint4*)(p.ycat + gtok * 1024 + 768 + chb) = o;
  }
  __syncthreads();
}

__device__ __forceinline__ void attn_wave(const P& p, int l, int b, int h, bool local, int r, int half, int qtok0, const float* rpbL) {
  const int lane = opaque_tid() & 63, q = lane & 31, hh = lane >> 5;
  bf16x8 qf[4];
  {
    const u16* qp = p.qk + (size_t)(qtok0 + q) * 1024 + h * 64 + 8 * hh;
#pragma unroll
    for (int s = 0; s < 4; ++s) qf[s] = *(const bf16x8*)(qp + 16 * s);
  }
  f32x16 o0 = zero16(), o1 = zero16();
  float m_run = -1e30f, l_run = 0.f;
  const int pi = (q & 19) | ((q & 4) << 1) | ((q & 8) >> 1);
  const int w = half * 32 + q;
  const int st = min(max(w - 8, 0), 48);
  const int rs = min(max(r - 4, 0), 56);
  const int ntiles = local ? 24 : 8;
  bf16x8 kfn[4], vfn[2][2];
  auto tile_load = [&](int ti, bf16x8 (&kfo)[4], bf16x8 (&vfo)[2][2]) {
    int ktok0, vstride;
    const u16* vb;
    if (ti < 8) {
      ktok0 = NLAT + b * 256 + ti * 32;
      vb = p.vTc + ((size_t)(b * 512 + h * 64)) * 256 + ti * 32;
      vstride = 256;
    } else {
      const int tl = ti - 8;
      const int a2 = tl >> 1, g2 = tl & 1;
      ktok0 = b * 4096 + (rs + a2) * 64 + g2 * 32;
      vb = p.vT + ((size_t)(b * 512 + h * 64)) * 4096 + (rs + a2) * 64 + g2 * 32;
      vstride = 4096;
    }
    const u16* kp = p.qk + (size_t)(ktok0 + pi) * 1024 + 512 + h * 64 + 8 * hh;
#pragma unroll
    for (int s = 0; s < 4; ++s) kfo[s] = *(const bf16x8*)(kp + 16 * s);
#pragma unroll
    for (int dt = 0; dt < 2; ++dt)
#pragma unroll
      for (int s2 = 0; s2 < 2; ++s2) vfo[dt][s2] = *(const bf16x8*)(vb + (size_t)(dt * 32 + q) * vstride + 16 * s2 + 8 * hh);
  };
  tile_load(0, kfn, vfn);
  for (int ti = 0; ti < ntiles; ++ti) {
    int a = 0, g = 0;
    if (ti >= 8) { a = (ti - 8) >> 1; g = (ti - 8) & 1; }
    bf16x8 kf[4], vf[2][2];
#pragma unroll
    for (int s = 0; s < 4; ++s) kf[s] = kfn[s];
#pragma unroll
    for (int dt = 0; dt < 2; ++dt)
#pragma unroll
      for (int s2 = 0; s2 < 2; ++s2) vf[dt][s2] = vfn[dt][s2];
    if (ti + 1 < ntiles) tile_load(ti + 1, kfn, vfn);
    f32x16 sacc = zero16();
#pragma unroll
    for (int s = 0; s < 4; ++s) sacc = mfma32(kf[s], qf[s], sacc);
    float sv[16];
    float tmax = -1e30f;
#pragma unroll
    for (int e = 0; e < 16; ++e) {
      float x = sacc[e] * 0.125f;
      if (ti >= 8) {
        const int kc = g * 32 + (e & 7) + 8 * hh + 16 * (e >> 3);
        const bool valid = (kc >= st) && (kc < st + 16);
        const int bi = valid ? ((rs + a - r + 7) * 31 + (kc - w + 15)) : 0;
        const float bias = rpbL[bi];
        x = valid ? (x + bias) : -1e30f;
      }
      sv[e] = x;
      tmax = fmaxf(tmax, x);
    }
    tmax = fmaxf(tmax, shx(tmax, 32));
    const float m_new = fmaxf(m_run, tmax);
    const float alpha = __expf(m_run - m_new);
    m_run = m_new;
    l_run *= alpha;
#pragma unroll
    for (int e = 0; e < 16; ++e) { o0[e] *= alpha; o1[e] *= alpha; }
    float psum = 0.f;
#pragma unroll
    for (int e = 0; e < 16; ++e) { const float pe = __expf(sv[e] - m_new); sv[e] = pe; psum += pe; }
    l_run += psum;
    bf16x8 pf[2];
#pragma unroll
    for (int s2 = 0; s2 < 2; ++s2) {
      union { bf16x8 v; unsigned u[4]; } cv;
#pragma unroll
      for (int j = 0; j < 4; ++j) cv.u[j] = pk2(sv[8 * s2 + 2 * j], sv[8 * s2 + 2 * j + 1]);
      pf[s2] = cv.v;
    }
#pragma unroll
    for (int s2 = 0; s2 < 2; ++s2) {
      o0 = mfma32(vf[0][s2], pf[s2], o0);
      o1 = mfma32(vf[1][s2], pf[s2], o1);
    }
  }
  const float lt = l_run + shx(l_run, 32);
  const float inv = 1.0f / lt;
  u16* op = p.ycat + (size_t)(qtok0 + q) * 1024 + h * 64;
#pragma unroll
  for (int qd = 0; qd < 4; ++qd) {
    uint2 a0, a1;
    a0.x = pk2(o0[4 * qd] * inv, o0[4 * qd + 1] * inv);
    a0.y = pk2(o0[4 * qd + 2] * inv, o0[4 * qd + 3] * inv);
    a1.x = pk2(o1[4 * qd] * inv, o1[4 * qd + 1] * inv);
    a1.y = pk2(o1[4 * qd + 2] * inv, o1[4 * qd + 3] * inv);
    *(uint2*)(op + 8 * qd + 4 * hh) = a0;
    *(uint2*)(op + 32 + 8 * qd + 4 * hh) = a1;
  }
}
__device__ __forceinline__ void attn_block_task(const P& p, int l, int b, int h, int rg4, char* smem) {
  const int tid = opaque_tid(), lane = tid & 63, wid = tid >> 6;
  const int q = lane & 31, hh = lane >> 5;
  const int R0 = rg4 * 4;
  const int r = R0 + (wid >> 1), half = wid & 1;
  float* rpbL = (float*)(smem + 32768) + 64;
  for (int i = tid; i < 465; i += NTHR) rpbL[i] = p.na_rpb[(size_t)(l * 8 + h) * 465 + i] * 1.4426950408889634f;
  const int lo = min(max(R0 - 4, 0), 56);
  const int hi = min(max(R0 + 3 - 4, 0), 56) + 7;
  const int ntile = 4 + (hi - lo + 1);
  const int rs = min(max(r - 4, 0), 56);
  const int qtok = b * 4096 + r * 64 + half * 32 + q;
  bf16x8 qf[4];
  {
    const u16* qp = p.qk + (size_t)qtok * 1024 + h * 64 + 8 * hh;
#pragma unroll
    for (int s = 0; s < 4; ++s) qf[s] = *(const bf16x8*)(qp + 16 * s);
  }
  f32x16 o0 = zero16(), o1 = zero16();
  float m_run = -1e30f, l_run = 0.f;
  const int pi = (q & 19) | ((q & 4) << 1) | ((q & 8) >> 1);
  const int w = half * 32 + q;
  const int st = min(max(w - 8, 0), 48);
  unsigned vmask = 0u;
#pragma unroll
  for (int g = 0; g < 2; ++g)
#pragma unroll
    for (int e = 0; e < 16; ++e) {
      const int kc = g * 32 + (e & 7) + 8 * hh + 16 * (e >> 3);
      vmask |= ((kc >= st) && (kc < st + 16)) ? (1u << (g * 16 + e)) : 0u;
    }
  const int cbase = 8 * hh - w + 15;
  const int srow = tid >> 3, sch = tid & 7;
  uint4 rkA, rvA, rkB, rvB;
  auto gload = [&](int ti, uint4& rk, uint4& rv) {
    int ktok0, vstride;
    const u16* vb;
    if (ti < 4) { ktok0 = NLAT + b * 256 + ti * 64; vb = p.vTc + ((size_t)(b * 512 + h * 64)) * 256 + ti * 64; vstride = 256; }
    else { const int R = lo + ti - 4; ktok0 = b * 4096 + R * 64; vb = p.vT + ((size_t)(b * 512 + h * 64)) * 4096 + R * 64; vstride = 4096; }
    rk = *(const uint4*)(p.qk + (size_t)(ktok0 + srow) * 1024 + 512 + h * 64 + sch * 8);
    rv = *(const uint4*)(vb + (size_t)srow * vstride + sch * 8);
  };
  gload(0, rkA, rvA);
  *(uint4*)(smem + swz128(srow, sch)) = rkA;
  *(uint4*)(smem + 16384 + swz128(srow, sch)) = rvA;
  gload(1, rkA, rvA);
  if (2 < ntile) gload(2, rkB, rvB);
  __syncthreads();
  auto compute = [&](int ti) {
    const char* Kb = smem + (ti & 1) * 8192;
    const char* Vb = smem + 16384 + (ti & 1) * 8192;
    const int R = lo + ti - 4;
    const bool active = (ti < 4) || (R >= rs && R < rs + 8);
    if (active) {
#pragma unroll
      for (int g = 0; g < 2; ++g) {
        f32x16 sacc = zero16();
#pragma unroll
        for (int s = 0; s < 4; ++s) {
          const bf16x8 kf = *(const bf16x8*)(Kb + swz128(g * 32 + pi, 2 * s + hh));
          sacc = mfma32(kf, qf[s], sacc);
        }
        float sv[16];
        float tmax = -1e30f;
        if (ti >= 4) {
          const float* brow = rpbL + (R - r + 7) * 31 + cbase + g * 32;
          float bias[16];
#pragma unroll
          for (int e = 0; e < 16; ++e) bias[e] = brow[(e & 7) + 16 * (e >> 3)];
#pragma unroll
          for (int e = 0; e < 16; ++e) {
            const float x = ((int)(vmask << (31 - (g * 16 + e))) < 0) ? fmaf(sacc[e], 0.18033688011112042f, bias[e]) : -1e30f;
            sv[e] = x;
            tmax = fmaxf(tmax, x);
          }
        } else {
#pragma unroll
          for (int e = 0; e < 16; ++e) {
            const float x = sacc[e] * 0.18033688011112042f;
            sv[e] = x;
            tmax = fmaxf(tmax, x);
          }
        }
        tmax = fmaxf(tmax, shx(tmax, 32));
        if (__builtin_amdgcn_ballot_w64(tmax > m_run) != 0ull) {
          const float m_new = fmaxf(m_run, tmax);
          const float alpha = __builtin_amdgcn_exp2f(m_run - m_new);
          m_run = m_new;
          l_run *= alpha;
#pragma unroll
          for (int e = 0; e < 16; ++e) { o0[e] *= alpha; o1[e] *= alpha; }
        }
        float psum = 0.f;
#pragma unroll
        for (int e = 0; e < 16; ++e) { const float pe = __builtin_amdgcn_exp2f(sv[e] - m_run); sv[e] = pe; psum += pe; }
        l_run += psum;
#pragma unroll
        for (int s2 = 0; s2 < 2; ++s2) {
          union { bf16x8 v; unsigned u[4]; } cv;
#pragma unroll
          for (int j = 0; j < 4; ++j) cv.u[j] = pk2(sv[8 * s2 + 2 * j], sv[8 * s2 + 2 * j + 1]);
          const bf16x8 v0 = *(const bf16x8*)(Vb + swz128(q, g * 4 + 2 * s2 + hh));
          const bf16x8 v1 = *(const bf16x8*)(Vb + swz128(32 + q, g * 4 + 2 * s2 + hh));
          o0 = mfma32(v0, cv.v, o0);
          o1 = mfma32(v1, cv.v, o1);
        }
      }
    }
  };
  for (int ti = 0; ti < ntile; ti += 2) {
    compute(ti);
    if (ti + 1 < ntile) {
      *(uint4*)(smem + 8192 + swz128(srow, sch)) = rkA;
      *(uint4*)(smem + 16384 + 8192 + swz128(srow, sch)) = rvA;
      if (ti + 3 < ntile) gload(ti + 3, rkA, rvA);
    }
    __syncthreads();
    if (ti + 1 < ntile) {
      compute(ti + 1);
      if (ti + 2 < ntile) {
        *(uint4*)(smem + swz128(srow, sch)) = rkB;
        *(uint4*)(smem + 16384 + swz128(srow, sch)) = rvB;
        if (ti + 4 < ntile) gload(ti + 4, rkB, rvB);
      }
      __syncthreads();
    }
  }
  const float lt = l_run + shx(l_run, 32);
  const float inv = 1.0f / lt;
  u16* op = p.ycat + (size_t)qtok * 1024 + h * 64;
#pragma unroll
  for (int qd = 0; qd < 4; ++qd) {
    uint2 a0, a1;
    a0.x = pk2(o0[4 * qd] * inv, o0[4 * qd + 1] * inv);
    a0.y = pk2(o0[4 * qd + 2] * inv, o0[4 * qd + 3] * inv);
    a1.x = pk2(o1[4 * qd] * inv, o1[4 * qd + 1] * inv);
    a1.y = pk2(o1[4 * qd + 2] * inv, o1[4 * qd + 3] * inv);
    *(uint2*)(op + 8 * qd + 4 * hh) = a0;
    *(uint2*)(op + 32 + 8 * qd + 4 * hh) = a1;
  }
}
__device__ __forceinline__ void attn_task(const P& p, int l, int kind, int idx, char* smem) {
  const int tid_ = opaque_tid(); const int lane = tid_ & 63, wid = tid_ >> 6;
  float* rpbL = (float*)smem + wid * 480;
  for (int i = lane; i < 465; i += 64) rpbL[i] = p.na_rpb[(size_t)(l * 8 + wid) * 465 + i];
  __syncthreads();
  if (kind == 0) {
    const int half = idx & 1, r = (idx >> 1) & 63, b = idx >> 7;
    attn_wave(p, l, b, wid, true, r, half, b * 4096 + r * 64 + half * 32, rpbL);
  } else {
    const int qg = idx & 7, b = idx >> 3;
    attn_wave(p, l, b, wid, false, 0, 0, NLAT + b * 256 + qg * 32, rpbL);
  }
  __syncthreads();
}

__device__ __forceinline__ void phase_mixers(const P& p, int l, char* smem, unsigned* counter) {
  const bool last = (l == 1);
  const int n_rg = 2176 * XRGA, n_fft = 1024 * XFFT, n_hc = last ? 0 : 256, n_att = 1024 * XATT, n_attc = last ? 0 : 64;
  const int total = n_rg + n_fft + n_hc + n_att + n_attc;
  volatile int* s_taskp = (volatile int*)(smem + SMEM_BYTES - 16);
  for (;;) {
    __syncthreads();
    if (threadIdx.x == 0) *s_taskp = (int)atomicAdd(counter, 1u);
    __syncthreads();
    int t = *s_taskp;
    if (t >= total) break;
    if (t < n_att) { t &= 1023; attn_block_task(p, l, t >> 7, (t >> 4) & 7, t & 15, smem); continue; }
    t -= n_att;
    if (t < n_attc) { attn_task(p, l, 1, t, smem); continue; }
    t -= n_attc;
    if (t < n_fft) { t &= 1023; hyena_fft_task(p, l, t >> 2, t & 3, smem); continue; }
    t -= n_fft;
    if (t < n_hc) { hyena_ctx_task(p, l, t >> 5, t & 31, smem); continue; }
    t -= n_hc;
    if (t >= 2176) t -= 2176;
    rg_chunk_task(p, l, t >> 2, t & 3, 0, last, smem);
  }
}

__device__ __forceinline__ void merge_tile(const P& p, int l, int mt, int nt, char* smem) {
  EPI_VARS
  const int m0 = mt * 256, n0 = nt * 128;
  f32x16 macc[2][2];
  zero_acc(macc);
  for (int br = 0; br < 3; ++br) {
    unsigned* gpl = (unsigned*)(smem + 98304) + tid;
    {
      f32x16 acc[2][2];
      zero_acc(acc);
      gemm_kloop(acc, p.xn + (size_t)m0 * 1024, 1024, p.WgT + ((size_t)l * 3072 + br * 1024 + n0) * 1024, 1024, 1024, smem);
#pragma unroll
      for (int j = 0; j < 2; ++j) {
        const float bg = p.b_gate[l * 3072 + br * 1024 + n0 + EPI_COL(j)];
#pragma unroll
        for (int i = 0; i < 2; ++i)
#pragma unroll
          for (int e = 0; e < 4; ++e) {
            const unsigned q0 = (unsigned)(sigmoidf_(acc[i][j][4 * e] + bg) * 255.0f + 0.5f);
            const unsigned q1 = (unsigned)(sigmoidf_(acc[i][j][4 * e + 1] + bg) * 255.0f + 0.5f);
            const unsigned q2 = (unsigned)(sigmoidf_(acc[i][j][4 * e + 2] + bg) * 255.0f + 0.5f);
            const unsigned q3 = (unsigned)(sigmoidf_(acc[i][j][4 * e + 3] + bg) * 255.0f + 0.5f);
            gpl[((i * 2 + j) * 4 + e) * 512] = q0 | (q1 << 8) | (q2 << 16) | (q3 << 24);
          }
      }
    }
    {
      f32x16 acc[2][2];
      zero_acc(acc);
      const u16* A; const u16* B; int K;
      if (br == 0) { A = p.ycat + (size_t)m0 * 1024; B = p.WaT + ((size_t)l * 1024 + n0) * 512; K = 512; }
      else if (br == 1) { A = p.ycat + (size_t)m0 * 1024 + 512; B = p.WbT + ((size_t)l * 1024 + n0) * 256; K = 256; }
      else { A = p.ycat + (size_t)m0 * 1024 + 768; B = p.WcT + ((size_t)l * 1024 + n0) * 256; K = 256; }
      gemm_kloop(acc, A, 1024, B, K, K, smem);
#pragma unroll
      for (int i = 0; i < 2; ++i)
#pragma unroll
        for (int j = 0; j < 2; ++j)
#pragma unroll
          for (int e = 0; e < 4; ++e) {
            const unsigned g4 = gpl[((i * 2 + j) * 4 + e) * 512];
            macc[i][j][4 * e] += (float)(g4 & 255u) * (1.0f / 255.0f) * acc[i][j][4 * e];
            macc[i][j][4 * e + 1] += (float)((g4 >> 8) & 255u) * (1.0f / 255.0f) * acc[i][j][4 * e + 1];
            macc[i][j][4 * e + 2] += (float)((g4 >> 16) & 255u) * (1.0f / 255.0f) * acc[i][j][4 * e + 2];
            macc[i][j][4 * e + 3] += (float)(g4 >> 24) * (1.0f / 255.0f) * acc[i][j][4 * e + 3];
          }
    }
  }
#pragma unroll
  for (int i = 0; i < 2; ++i)
#pragma unroll
    for (int j = 0; j < 2; ++j)
#pragma unroll
      for (int e = 0; e < 16; ++e)
        p.mbuf[(size_t)(m0 + EPI_ROW(i, e)) * 1024 + n0 + EPI_COL(j)] = f2bf(macc[i][j][e]);
}
__device__ __forceinline__ void outproj_tile(const P& p, int l, int mt, int nt, char* smem, bool do_store) {
  EPI_VARS
  const int m0 = mt * 256, n0 = nt * 128;
  f32x16 acc[2][2];
  zero_acc(acc);
  gemm_kloop(acc, p.mbuf + (size_t)m0 * 1024, 1024, p.WoT + ((size_t)l * 1024 + n0) * 1024, 1024, 1024, smem);
  const bool isctx = (mt >= 128);
  const int bi = isctx ? 8 : (mt >> 4);
  const float* gatev = p.mod + ((size_t)(l * 9 + bi) * 6 + 2) * 1024;
  const float* src; float* dst;
  if (isctx) { src = (l == 0 ? p.ctx : p.ctxs) - (size_t)NLAT * 1024; dst = p.ctxs - (size_t)NLAT * 1024; }
  else { src = (l == 0 ? p.x : p.out); dst = p.out; }
#pragma unroll
  for (int j = 0; j < 2; ++j) {
    const int col = n0 + EPI_COL(j);
    const float gv = gatev[col];
#pragma unroll
    for (int i = 0; i < 2; ++i)
#pragma unroll
      for (int e = 0; e < 16; ++e) {
        const size_t o = (size_t)(m0 + EPI_ROW(i, e)) * 1024 + col;
        if (do_store) dst[o] = src[o] + gv * acc[i][j][e];
      }
  }
}

__device__ __forceinline__ void wqk_task(const P& p, int l, int hp, int nt, char* smem) {
  EPI_VARS
  f32x16 acc[2][2];
  zero_acc(acc);
  gemm_kloop(acc, p.keysB + ((size_t)l * 16 + hp) * 16384, 128, p.WqB + (size_t)l * 1024 * 2048 + (size_t)(nt * 128) * 2048 + hp * 128, 2048, 128, smem);
  if (wm < 2) {
#pragma unroll
    for (int i = 0; i < 2; ++i)
#pragma unroll
      for (int j = 0; j < 2; ++j)
#pragma unroll
        for (int e = 0; e < 16; ++e)
          p.WqkT[((size_t)l * 2048 + hp * 128 + EPI_ROW(i, e)) * 1024 + nt * 128 + EPI_COL(j)] = f2bf(acc[i][j][e]);
  }
}
__device__ __forceinline__ void ins16(unsigned (&L)[16], unsigned x) {
#pragma unroll
  for (int i = 0; i < 16; ++i) {
    const unsigned hi = max(L[i], x);
    x = min(L[i], x);
    L[i] = hi;
  }
}
__device__ __forceinline__ unsigned f2sort(float f) {
  const unsigned b = __float_as_uint(f);
  return b ^ ((unsigned)((int)b >> 31) | 0x80000000u);
}
__device__ __forceinline__ float sort2f(unsigned k) {
  const unsigned u = k & ~127u;
  const unsigned b = (u & 0x80000000u) ? (u ^ 0x80000000u) : ~u;
  return __uint_as_float(b);
}
__device__ __forceinline__ void peer_score_tile(const P& p, int l, int mt, int hp, char* smem) {
  const int tid = opaque_tid();
  const int m0 = mt * 256;
  unsigned L[16];
#pragma unroll
  for (int i = 0; i < 16; ++i) L[i] = 0u;
  const int row = tid >> 1, hf = tid & 1;
  const unsigned* sp = (const unsigned*)(p.q + (size_t)(m0 + row) * 2048 + hp * 128 + hf * 64);
#pragma unroll
  for (int c = 0; c < 8; ++c) {
    const uint4 r = *(const uint4*)(sp + 4 * c);
    const unsigned w[4] = {r.x, r.y, r.z, r.w};
#pragma unroll
    for (int k = 0; k < 4; ++k) {
      const float v0 = __builtin_bit_cast(_Float16, (unsigned short)(w[k] & 0xffffu));
      const float v1 = __builtin_bit_cast(_Float16, (unsigned short)(w[k] >> 16));
      const int key = hf * 64 + c * 8 + k * 2;
      ins16(L, (f2sort(v0) & ~127u) | (unsigned)key);
      ins16(L, (f2sort(v1) & ~127u) | (unsigned)(key + 1));
    }
  }
  unsigned* X = (unsigned*)smem;
  if (hf) {
#pragma unroll
    for (int i = 0; i < 16; ++i) X[row * 16 + i] = L[i];
  }
  __syncthreads();
  if (!hf) {
#pragma unroll
    for (int i = 0; i < 16; ++i) ins16(L, X[row * 16 + i]);
    unsigned* o = p.topk + ((size_t)(m0 + row) * 16 + hp) * 16;
#pragma unroll
    for (int i = 0; i < 4; ++i) *(uint4*)(o + 4 * i) = make_uint4(L[4 * i], L[4 * i + 1], L[4 * i + 2], L[4 * i + 3]);
  }
  __syncthreads();
}

__device__ __forceinline__ void phase_peer_experts(const P& p, int l, bool do_store, char* smem) {
  const int tid_ = opaque_tid(); const int lane = tid_ & 63, wid = tid_ >> 6;
  const int ntok = (l == 1) ? NLAT : NTOK;
  int ci, cj;
  {
    const int e = lane;
    if (e < 16) { ci = 0; cj = e; }
    else if (e < 24) { ci = 1; cj = e - 16; }
    else if (e < 29) { ci = 2; cj = e - 24; }
    else if (e < 33) { ci = 3; cj = e - 29; }
    else if (e < 36) { ci = 4; cj = e - 33; }
    else if (e < 38) { ci = 5; cj = e - 36; }
    else if (e < 40) { ci = 6; cj = e - 38; }
    else if (e < 42) { ci = 7; cj = e - 40; }
    else { ci = min(8 + (e - 42), 15); cj = 0; }
  }
  for (int tok = blockIdx.x * 8 + wid; tok < ntok; tok += gridDim.x * 8) {
    float xr[16];
    {
      const uint4 a = *(const uint4*)(p.xn + (size_t)tok * 1024 + lane * 16);
      const uint4 b = *(const uint4*)(p.xn + (size_t)tok * 1024 + lane * 16 + 8);
      xr[0] = bflo(a.x); xr[1] = bfhi(a.x); xr[2] = bflo(a.y); xr[3] = bfhi(a.y);
      xr[4] = bflo(a.z); xr[5] = bfhi(a.z); xr[6] = bflo(a.w); xr[7] = bfhi(a.w);
      xr[8] = bflo(b.x); xr[9] = bfhi(b.x); xr[10] = bflo(b.y); xr[11] = bfhi(b.y);
      xr[12] = bflo(b.z); xr[13] = bfhi(b.z); xr[14] = bflo(b.w); xr[15] = bfhi(b.w);
    }
    float yacc[16];
#pragma unroll
    for (int i = 0; i < 16; ++i) yacc[i] = 0.f;
    int* selw = (int*)(smem + wid * 4096);
    const unsigned* kvp = p.topk + (size_t)tok * 256 + (lane & 31);
    unsigned kv_next = kvp[0];
#pragma unroll 1
    for (int h = 0; h < 8; ++h) {
      const unsigned kv = kv_next;
      if (h < 7) kv_next = kvp[(h + 1) * 32];
      const unsigned k0 = shu(kv, ci);
      const unsigned k1 = shu(kv, 16 + cj);
      const float val = (lane < 50) ? (sort2f(k0) + sort2f(k1)) : -3.0e38f;
      const int eidx = (int)((k0 & 127u) * 128u + (k1 & 127u));
      float sv = val; int si = eidx;
#pragma unroll
      for (int k = 2; k <= 64; k <<= 1) {
#pragma unroll
        for (int j = k >> 1; j >= 1; j >>= 1) {
          const float ov = __builtin_bit_cast(float, __builtin_amdgcn_ds_bpermute((lane ^ j) << 2, __builtin_bit_cast(int, sv)));
          const int oi = __builtin_amdgcn_ds_bpermute((lane ^ j) << 2, si);
          const bool take_max = (((lane & j) == 0) == ((lane & k) == 0));
          const bool sw = take_max ? (ov > sv) : (ov < sv);
          sv = sw ? ov : sv;
          si = sw ? oi : si;
        }
      }
      const float mx = __builtin_bit_cast(float, __builtin_amdgcn_readlane(__builtin_bit_cast(int, sv), 0));
      const float ex = (lane < 16) ? __builtin_amdgcn_exp2f((sv - mx) * 1.4426950408889634f) : 0.f;
      const float sm = wave_sum(ex);
      selw[h * 64 + lane] = si;
      selw[512 + h * 64 + lane] = __builtin_bit_cast(int, ex * __builtin_amdgcn_rcpf(sm));
    }
#pragma unroll 1
    for (int h = 0; h < 8; ++h) {
      const int eperm_h = selw[h * 64 + lane];
      const int gperm_h = selw[512 + h * 64 + lane];
      uint2 U[16], V[16];
#pragma unroll
      for (int k = 0; k < 16; ++k) {
        const int id = __builtin_amdgcn_readlane(eperm_h, k);
        U[k] = *(const uint2*)(p.Ub + (size_t)id * 512 + lane * 8);
        V[k] = *(const uint2*)(p.Vb + (size_t)id * 512 + lane * 8);
      }
      float d[16];
#pragma unroll
      for (int k = 0; k < 16; ++k) {
        const unsigned uw[2] = {U[k].x, U[k].y};
        float dd = 0.f;
#pragma unroll
        for (int q2 = 0; q2 < 2; ++q2) {
          const f32x2 e0 = __builtin_amdgcn_cvt_scalef32_pk_f32_fp4(uw[q2], 1.0f, 0);
          const f32x2 e1 = __builtin_amdgcn_cvt_scalef32_pk_f32_fp4(uw[q2], 1.0f, 1);
          const f32x2 e2 = __builtin_amdgcn_cvt_scalef32_pk_f32_fp4(uw[q2], 1.0f, 2);
          const f32x2 e3 = __builtin_amdgcn_cvt_scalef32_pk_f32_fp4(uw[q2], 1.0f, 3);
          dd += xr[8 * q2] * e0.x + xr[8 * q2 + 1] * e0.y + xr[8 * q2 + 2] * e1.x + xr[8 * q2 + 3] * e1.y +
                xr[8 * q2 + 4] * e2.x + xr[8 * q2 + 5] * e2.y + xr[8 * q2 + 6] * e3.x + xr[8 * q2 + 7] * e3.y;
        }
        d[k] = dd;
      }
      {
        const bool b5 = (lane & 32) != 0, b4 = (lane & 16) != 0, b3 = (lane & 8) != 0, b2 = (lane & 4) != 0;
#pragma unroll
        for (int j = 0; j < 8; ++j) { const float keep = b5 ? d[j + 8] : d[j], send = b5 ? d[j] : d[j + 8]; d[j] = keep + shx(send, 32); }
#pragma unroll
        for (int j = 0; j < 4; ++j) { const float keep = b4 ? d[j + 4] : d[j], send = b4 ? d[j] : d[j + 4]; d[j] = keep + shx(send, 16); }
#pragma unroll
        for (int j = 0; j < 2; ++j) { const float keep = b3 ? d[j + 2] : d[j], send = b3 ? d[j] : d[j + 2]; d[j] = keep + shx(send, 8); }
        { const float keep = b2 ? d[1] : d[0], send = b2 ? d[0] : d[1]; d[0] = keep + shx(send, 4); }
        d[0] += shx(d[0], 2);
        d[0] += shx(d[0], 1);
      }
      const float gl = __builtin_bit_cast(float, shu((unsigned)gperm_h, (lane >> 2) & 15));
      const float act = gelu_tanh(d[0] * (1.0f / 64.0f)) * gl;
#pragma unroll
      for (int k = 0; k < 16; ++k) {
        const float ak = __builtin_bit_cast(float, __builtin_amdgcn_readlane(__builtin_bit_cast(int, act), 4 * k));
        const unsigned vw[2] = {V[k].x, V[k].y};
#pragma unroll
        for (int q2 = 0; q2 < 2; ++q2) {
          const f32x2 e0 = __builtin_amdgcn_cvt_scalef32_pk_f32_fp4(vw[q2], 1.0f, 0);
          const f32x2 e1 = __builtin_amdgcn_cvt_scalef32_pk_f32_fp4(vw[q2], 1.0f, 1);
          const f32x2 e2 = __builtin_amdgcn_cvt_scalef32_pk_f32_fp4(vw[q2], 1.0f, 2);
          const f32x2 e3 = __builtin_amdgcn_cvt_scalef32_pk_f32_fp4(vw[q2], 1.0f, 3);
          yacc[8 * q2] += ak * e0.x; yacc[8 * q2 + 1] += ak * e0.y; yacc[8 * q2 + 2] += ak * e1.x; yacc[8 * q2 + 3] += ak * e1.y;
          yacc[8 * q2 + 4] += ak * e2.x; yacc[8 * q2 + 5] += ak * e2.y; yacc[8 * q2 + 6] += ak * e3.x; yacc[8 * q2 + 7] += ak * e3.y;
        }
      }
    }
    const int bi = tok < NLAT ? (tok >> 12) : 8;
    const float* gv = p.mod + ((size_t)(l * 9 + bi) * 6 + 5) * 1024 + lane * 16;
    float* xp = (tok < NLAT) ? (p.out + (size_t)tok * 1024) : (p.ctxs + (size_t)(tok - NLAT) * 1024);
    xp += lane * 16;
    float4 xv[4];
    float ss = 0.f;
#pragma unroll
    for (int i = 0; i < 4; ++i) {
      xv[i] = *(float4*)(xp + 4 * i);
      const float4 g4 = *(const float4*)(gv + 4 * i);
      xv[i].x += g4.x * yacc[4 * i] * 0.25f; xv[i].y += g4.y * yacc[4 * i + 1] * 0.25f; xv[i].z += g4.z * yacc[4 * i + 2] * 0.25f; xv[i].w += g4.w * yacc[4 * i + 3] * 0.25f;
      ss += xv[i].x * xv[i].x + xv[i].y * xv[i].y + xv[i].z * xv[i].z + xv[i].w * xv[i].w;
    }
    ss = wave_sum(ss);
    const float rstd = rsqrtf(ss * (1.0f / 1024.0f) + 1e-6f);
    if (l == 0) {
      const float* gam = p.norm_mix_g + 1024 + lane * 16;
      const float* msh = p.mod + ((size_t)(9 + bi) * 6 + 0) * 1024 + lane * 16;
      const float* msc = msh + 1024;
      u16* xo = p.xn + (size_t)tok * 1024 + lane * 16;
#pragma unroll
      for (int i = 0; i < 4; ++i) {
        if (do_store) *(float4*)(xp + 4 * i) = xv[i];
        const float4 g = *(const float4*)(gam + 4 * i);
        const float4 sh = *(const float4*)(msh + 4 * i);
        const float4 sc = *(const float4*)(msc + 4 * i);
        uint2 o;
        o.x = pk2(xv[i].x * rstd * g.x * (1.f + sc.x) + sh.x, xv[i].y * rstd * g.y * (1.f + sc.y) + sh.y);
        o.y = pk2(xv[i].z * rstd * g.z * (1.f + sc.z) + sh.z, xv[i].w * rstd * g.w * (1.f + sc.w) + sh.w);
        if (do_store) *(uint2*)(xo + 4 * i) = o;
      }
    } else {
      const float* fg = p.final_g + lane * 16;
#pragma unroll
      for (int i = 0; i < 4; ++i) {
        const float4 g = *(const float4*)(fg + 4 * i);
        const float4 o = make_float4(xv[i].x * rstd * g.x, xv[i].y * rstd * g.y, xv[i].z * rstd * g.z, xv[i].w * rstd * g.w);
        if (do_store) *(float4*)(xp + 4 * i) = o;
      }
    }
  }
}


#define XB_TMO      128
#define XB_XCNT(j)  (256  + 64 * (j))
#define XB_XSUB(j)  (1280 + 64 * (j))
#define XB_XGEN(j)  (2304 + 64 * (j))
#define XB_TOP      3328
#define XB_TOPGEN   3392
#define XCD_BAR_WORDS 3456
#define XB_SPIN_CAP (1u << 22)
#define LAS __attribute__((address_space(3)))
__device__ __forceinline__ unsigned xb_ld(unsigned* p) { return __hip_atomic_load(p, __ATOMIC_RELAXED, __HIP_MEMORY_SCOPE_AGENT); }
__device__ __forceinline__ unsigned xb_add(unsigned* p, unsigned v) { return __hip_atomic_fetch_add(p, v, __ATOMIC_RELAXED, __HIP_MEMORY_SCOPE_AGENT); }
__device__ __forceinline__ unsigned xb_xcc_id() { return (unsigned)__builtin_amdgcn_s_getreg((3 << 11) | 20) & 0xFu; }
#define XB_SPIN(cond, bar) do { unsigned _sp = 0; while (cond) { __builtin_amdgcn_s_sleep(1); \
    if ((++_sp & 255u) == 0u) { if (xb_ld(&(bar)[XB_TMO])) break; if (_sp > XB_SPIN_CAP) { atomicAdd(&(bar)[XB_TMO], 1u); break; } } } } while (0)
struct XcdBarrier { unsigned* bar; unsigned x; volatile LAS unsigned* st; };
__device__ __forceinline__ XcdBarrier xcd_barrier_post(unsigned* bar, volatile LAS unsigned* st) {
  XcdBarrier b; b.bar = bar; b.x = xb_xcc_id(); b.st = st;
  if (threadIdx.x == 0) (void)xb_add(&bar[XB_XCNT(b.x)], 1u);
  return b;
}
__device__ __forceinline__ void xcd_barrier_complete(unsigned* bar, unsigned x, unsigned& nloc, unsigned& nx) {
  const unsigned G = gridDim.x * gridDim.y * gridDim.z;
  unsigned sum, cnt, mine, sp = 0u;
  for (;;) {
    sum = 0u; cnt = 0u; mine = 0u;
#pragma unroll
    for (unsigned j = 0; j < 16; ++j) { const unsigned c = xb_ld(&bar[XB_XCNT(j)]); sum += c; cnt += (c > 0u) ? 1u : 0u; mine = (j == x) ? c : mine; }
    if (sum == G) break;
    __builtin_amdgcn_s_sleep(1);
    if ((++sp & 255u) == 0u) { if (xb_ld(&bar[XB_TMO])) break; if (sp > XB_SPIN_CAP) { atomicAdd(&bar[XB_TMO], 1u); break; } }
  }
  nloc = mine > 0u ? mine : 1u; nx = cnt > 0u ? cnt : 1u;
}
__device__ __forceinline__ void xcd_barrier(unsigned* bar_u, volatile LAS unsigned* st_u) {
  XcdBarrier b; b.bar = bar_u; b.x = xb_xcc_id(); b.st = st_u;
  asm volatile("s_waitcnt vmcnt(0)" ::: "memory");
  __syncthreads();
  if (threadIdx.x == 0) {
    unsigned long long bp_ = (unsigned long long)b.bar;
    asm volatile("" : "+v"(bp_));
    unsigned* bar = (unsigned*)bp_;
    __builtin_amdgcn_s_waitcnt(0);
    unsigned nloc = b.st[0], nx = b.st[1];
    if (nloc == 0u) { xcd_barrier_complete(bar, b.x, nloc, nx); b.st[0] = nloc; b.st[1] = nx; }
    const unsigned old = xb_add(&bar[XB_XSUB(b.x)], 1u);
    const unsigned gen = old / nloc;
    if (old + 1u == (gen + 1u) * nloc) {
      __builtin_amdgcn_fence(__ATOMIC_RELEASE, "agent");
      asm volatile("s_waitcnt vmcnt(0)" ::: "memory");
      const unsigned og = xb_add(&bar[XB_TOP], 1u);
      const unsigned tg = og / nx;
      if (og + 1u == (tg + 1u) * nx) xb_add(&bar[XB_TOPGEN], 1u);
      else XB_SPIN(xb_ld(&bar[XB_TOPGEN]) == tg, bar);
      __builtin_amdgcn_fence(__ATOMIC_ACQUIRE, "agent");
      xb_add(&bar[XB_XGEN(b.x)], 1u);
      asm volatile("s_waitcnt vmcnt(0)" ::: "memory");
    } else {
      XB_SPIN(xb_ld(&bar[XB_XGEN(b.x)]) == gen, bar);
      __builtin_amdgcn_fence(__ATOMIC_ACQUIRE, "agent");
      asm volatile("s_waitcnt vmcnt(0)" ::: "memory");
    }
  }
  __syncthreads();
}

template <int l>
__device__ __forceinline__ void layer_body(const P& p, char* smem, pg8::PG8_LAS_T lds, volatile LAS unsigned* xbw, const int nb, const int bid) {
    const bool last = (l == 1);
    const int n_mt = last ? 128 : 136;
    if (l == 0) {
      phase_norm(p, l, 0);
      xcd_barrier(p.counters + 1024, xbw);
    }
_Pragma("unroll 1")
    for (int rep = 0; rep < REP_INPROJ; ++rep) {
      pg8::Gemm g; pg8::Order S;
      g.A = p.xn; g.Bt = p.WinT + (size_t)l * 2816 * 1024; g.lda = 1024; g.ldb = 1024; g.K = 1024;
      S.init(136, 6, nb, bid, 4, 5);
      pg8::EpiInprojN e1; e1.qk = p.qk; e1.rg = p.rg;
      pg8::gemm_phase(lds, g, S, e1);
      g.A = p.WinT + ((size_t)l * 2816 + 1024) * 1024; g.Bt = p.xn;
      S.init(5, 136, nb, bid);
      pg8::EpiInprojT e2; e2.vT = p.vT; e2.vTc = p.vTc; e2.hyT = p.hyT; e2.hyTc = p.hyTc;
      pg8::gemm_phase(lds, g, S, e2);
    }
    xcd_barrier(p.counters + 1024, xbw);
    phase_mixers(p, l, smem, p.counters + l * 4);
    xcd_barrier(p.counters + 1024, xbw);
_Pragma("unroll 1")
    for (int rep = 0; rep < REP_2B; ++rep)
      for (int task = bid; task < 2176 + 512; task += nb) {
        if (task < 2176) rg_chunk_task(p, l, task >> 2, task & 3, 1, last, smem);
        else yb_transpose_task(p, (task - 2176) >> 6, (task - 2176) & 63, smem);
      }
    xcd_barrier(p.counters + 1024, xbw);
_Pragma("unroll 1")
    for (int rep = 0; rep < REP_GATE; ++rep) {
      pg8::Gemm g; pg8::Order S;
      g.A = p.xn; g.Bt = p.WgT + (size_t)l * 3072 * 1024; g.lda = 1024; g.ldb = 1024; g.K = 1024;
      S.init(n_mt, 12, nb, bid);
      pg8::EpiGate e; e.g8 = p.g8; e.bias = p.b_gate + l * 3072;
      pg8::gemm_phase(lds, g, S, e);
    }
    xcd_barrier(p.counters + 1024, xbw);
_Pragma("unroll 1")
    for (int rep = 0; rep < REP_BRANCH; ++rep) {
      pg8::Gemm g; pg8::Order S;
      S.init(n_mt, 4, nb, bid);
      pg8::EpiBranch e; e.mbuf = p.mbuf; e.g8 = p.g8;
      g.lda = 1024;
      g.A = p.ycat; g.Bt = p.WaT + (size_t)l * 1024 * 512; g.ldb = 512; g.K = 512; e.br = 0;
      pg8::gemm_phase(lds, g, S, e);
      g.A = p.ycat + 512; g.Bt = p.WbT + (size_t)l * 1024 * 256; g.ldb = 256; g.K = 256; e.br = 1;
      pg8::gemm_phase(lds, g, S, e);
      g.A = p.ycat + 768; g.Bt = p.WcT + (size_t)l * 1024 * 256; g.ldb = 256; g.K = 256; e.br = 2;
      pg8::gemm_phase(lds, g, S, e);
    }
    xcd_barrier(p.counters + 1024, xbw);
    {
      pg8::Gemm g; pg8::Order S;
      g.A = p.mbuf; g.Bt = p.WoT + (size_t)l * 1024 * 1024; g.lda = 1024; g.ldb = 1024; g.K = 1024;
      S.init(n_mt, 4, nb, bid);
      pg8::EpiOut e; e.xsrc = (l == 0 ? p.x : p.out); e.csrc = (l == 0 ? p.ctx : p.ctxs); e.xdst = p.out; e.cdst = p.ctxs;
      e.modl = p.mod + (size_t)l * 9 * 6144;
      pg8::gemm_phase(lds, g, S, e);
      for (int t = bid; t < 8192; t += nb) {
        if (t < 4096) cvt_chunk_fp4(p.peer_u + (size_t)l * 16384 * 1024, p.Ub, (size_t)t, 64.0f);
        else cvt_chunk_fp4(p.peer_v + (size_t)l * 16384 * 1024, p.Vb, (size_t)(t - 4096), 4.0f);
      }
    }
    xcd_barrier(p.counters + 1024, xbw);
    phase_norm(p, l, 1);
    xcd_barrier(p.counters + 1024, xbw);
_Pragma("unroll 1")
    for (int rep = 0; rep < REP_Q; ++rep) {
      pg8::Gemm g; pg8::Order S;
      g.A = p.xn; g.Bt = p.WqkT + (size_t)l * 2048 * 1024; g.lda = 1024; g.ldb = 1024; g.K = 1024;
      S.init(n_mt, 8, nb, bid);
      pg8::EpiQ e; e.q = p.q;
      pg8::gemm_phase(lds, g, S, e);
    }
    xcd_barrier(p.counters + 1024, xbw);
_Pragma("unroll 1")
    for (int rep = 0; rep < REP_SCORE; ++rep)
      for (int task = bid; task < n_mt * 16; task += nb) peer_score_tile(p, l, task >> 4, task & 15, smem);
    xcd_barrier(p.counters + 1024, xbw);
_Pragma("unroll 1")
    for (int rep = 0; rep < REP_PEER; ++rep) phase_peer_experts(p, l, rep == REP_PEER - 1, smem);
    xcd_barrier(p.counters + 1024, xbw);
  }

__global__ void __launch_bounds__(NTHR) fwd_megakernel(P p) {
  __shared__ __attribute__((aligned(16))) char smem[SMEM_BYTES];
  cg::grid_group grid = cg::this_grid();
  const int nb = gridDim.x, bid = blockIdx.x;
  pg8::PG8_LAS_T lds = (pg8::PG8_LAS_T)smem;
  volatile LAS unsigned* xbw = (volatile LAS unsigned*)(smem + SMEM_BYTES - 32);
  if (threadIdx.x == 0) { xbw[0] = 0u; xbw[1] = 0u; xbw[2] = 0u; xbw[3] = 0u; }
  __syncthreads();
  (void)xcd_barrier_post(p.counters + 1024, xbw);

  phase_prep(p, smem);
  phase_filters(p, 0);
  phase_filters(p, 1);
  grid.sync();
  phase_modreduce(p);
  for (int task = blockIdx.x; task < 512; task += gridDim.x) kf_task(p, task >> 8, task & 255, smem);
  for (int task = blockIdx.x; task < 256; task += gridDim.x) wqk_task(p, task >> 7, (task >> 3) & 15, task & 7, smem);
  xcd_barrier(p.counters + 1024, xbw);

  layer_body<0>(p, smem, lds, xbw, nb, bid);
  layer_body<1>(p, smem, lds, xbw, nb, bid);
}

extern "C" void kernel_launch(void* const* d_in, const int* in_sizes, int n_in, void* d_out, int out_size, void* d_ws,
                              size_t ws_size, hipStream_t stream) {
  P p;
  memset(&p, 0, sizeof(p));
  const float** ins = (const float**)&p;
  for (int i = 0; i < 37; ++i) ins[i] = (const float*)d_in[i];
  p.out = (float*)d_out;
  char* w = (char*)d_ws;
  size_t off = 0;
  auto take = [&](size_t bytes) { char* r = w + off; off += (bytes + 255) & ~(size_t)255; return r; };
  p.counters = (unsigned*)take(32768);
  p.WinT = (u16*)take((size_t)2 * 2816 * 1024 * 2);
  p.WgT = (u16*)take((size_t)2 * 3072 * 1024 * 2);
  p.WaT = (u16*)take((size_t)2 * 1024 * 512 * 2);
  p.WbT = (u16*)take((size_t)2 * 1024 * 256 * 2);
  p.WcT = (u16*)take((size_t)2 * 1024 * 256 * 2);
  p.WoT = (u16*)take((size_t)2 * 1024 * 1024 * 2);
  p.WqB = (u16*)take((size_t)2 * 1024 * 2048 * 2);
  p.WqkT = (u16*)take((size_t)2 * 2048 * 1024 * 2);
  p.keysB = (u16*)take((size_t)2 * 16 * 16384 * 2);
  p.rgW = (u16*)take((size_t)2 * 16 * 4096 * 2);
  p.modpart = (float*)take((size_t)16 * 2 * 9 * 6144 * 4);
  p.mod = (float*)take((size_t)2 * 9 * 6144 * 4);
  p.hT = (float*)take((size_t)2 * 512 * 4096 * 4);
  p.hc = (float*)take((size_t)512 * 256 * 4);
  p.Kf = (float*)take((size_t)2 * 256 * 8192 * 8);
  p.xn = (u16*)take((size_t)NTOK * 1024 * 2);
  p.qk = (u16*)take((size_t)NTOK * 1024 * 2);
  p.mbuf = p.qk;
  p.vT = (u16*)take((size_t)8 * 512 * 4096 * 2);
  p.vTc = (u16*)take((size_t)8 * 512 * 256 * 2);
  p.hyT = (u16*)take((size_t)8 * 768 * 4096 * 2);
  p.hyTc = (u16*)take((size_t)8 * 768 * 256 * 2);
  p.rg = (u16*)take((size_t)NTOK * 512 * 2);
  p.ycat = (u16*)take((size_t)NTOK * 1024 * 2);
  p.Ub = (unsigned char*)p.ycat;
  p.Vb = p.Ub + (size_t)16384 * 512;
  p.agg = (float*)take((size_t)8 * 2 * 68 * 256 * 8);
  p.ybT = (u16*)take((size_t)8 * 256 * 4096 * 2);
  p.ctxs = (float*)take((size_t)2048 * 1024 * 4);
  p.g8 = (unsigned char*)p.vT;
  p.q = p.qk;
  p.topk = (unsigned*)((char*)p.qk + (size_t)NTOK * 2048 * 2);
  if (off > ws_size) {
    fprintf(stderr, "workspace too small: need %zu have %zu\n", off, ws_size);
    return;
  }
  static int grid_blocks = 0;
  if (!grid_blocks) {
    int dev = 0, cus = 0, per_cu = 0;
    (void)hipGetDevice(&dev);
    (void)hipDeviceGetAttribute(&cus, hipDeviceAttributeMultiprocessorCount, dev);
    (void)hipOccupancyMaxActiveBlocksPerMultiprocessor(&per_cu, fwd_megakernel, NTHR, 0);
    if (per_cu > 1) per_cu = 1;
    grid_blocks = cus * per_cu;
  }
  (void)hipMemsetAsync(p.counters, 0, 32768, stream);
  void* args[] = {&p};
  hipError_t e = hipLaunchCooperativeKernel((void*)fwd_megakernel, dim3(grid_blocks), dim3(NTHR), args, 0, stream);
  if (e != hipSuccess) fprintf(stderr, "cooperative launch failed: %s (grid %d)\n", hipGetErrorString(e), grid_blocks);
}
```

```cpp
#include <hip/hip_runtime.h>
#include <hip/hip_cooperative_groups.h>
#include <cstdio>
#include <cstring>
namespace cg = cooperative_groups;

typedef unsigned short u16;
typedef __attribute__((ext_vector_type(8))) short bf16x8;
typedef __attribute__((ext_vector_type(16))) float f32x16;
typedef __attribute__((ext_vector_type(2))) float f32x2;

#define NLAT 32768
#define NTOK 34816
#define SMEM_BYTES 151552
#define NTHR 512
#ifndef DUP_1A
#define DUP_1A 1
#endif
#ifndef DUP_PREP
#define DUP_PREP 1
#endif
#ifndef DUP_2B
#define DUP_2B 1
#endif
#ifndef XRGA
#define XRGA 1
#endif
#ifndef REP_PEER
#define REP_PEER 1
#endif
#ifndef REP_INPROJ
#define REP_INPROJ 1
#endif
#ifndef REP_GATE
#define REP_GATE 1
#endif
#ifndef REP_BRANCH
#define REP_BRANCH 1
#endif
#ifndef REP_Q
#define REP_Q 1
#endif
#ifndef REP_SCORE
#define REP_SCORE 1
#endif
#ifndef REP_1A
#define REP_1A 1
#endif
#ifndef REP_2B
#define REP_2B 1
#endif
#ifndef REP_KF
#define REP_KF 1
#endif
#ifndef DUP_GEMM
#define DUP_GEMM 1
#endif
#ifndef DUP_PEER
#define DUP_PEER 1
#endif
#ifndef DUP_MIX
#define DUP_MIX 1
#endif
#ifndef XRG
#define XRG 1
#endif
#ifndef XFFT
#define XFFT 1
#endif
#ifndef XATT
#define XATT 1
#endif

struct P {
  const float *x, *c, *ctx, *c_ctx, *norm_mix_g, *norm_ffn_g, *w_ada, *b_ada, *w_in, *na_rpb,
      *hy_short_w, *hy_short_b, *hy_f1_w, *hy_f1_b, *hy_f2_w, *hy_f2_b, *hy_f3_w, *hy_freq, *hy_bias,
      *rg_conv_w, *rg_conv_b, *rg_wa, *rg_ba, *rg_wx, *rg_bx, *rg_lambda,
      *w_gate, *b_gate, *w_br_a, *w_br_b, *w_br_c, *w_out, *peer_wq, *peer_keys, *peer_u, *peer_v, *final_g;
  float* out;
  unsigned* counters;
  u16 *WinT, *WgT, *WaT, *WbT, *WcT, *WoT, *WqB, *WqkT, *keysB, *rgW;
  float *modpart, *mod, *hT, *hc;
  float* Kf;
  u16 *xn, *qk, *vT, *vTc, *hyT, *hyTc, *rg, *ycat, *mbuf, *ybT;
  unsigned char *Ub, *Vb, *g8;
  u16* q;
  float *agg, *ctxs;
  unsigned* topk;
};

__device__ __forceinline__ u16 f2bf(float f) {
  unsigned u = __float_as_uint(f);
  u += 0x7fffu + ((u >> 16) & 1u);
  return (u16)(u >> 16);
}
__device__ __forceinline__ float bf2f(u16 h) { return __uint_as_float(((unsigned)h) << 16); }
__device__ __forceinline__ unsigned pk2(float a, float b) { return (unsigned)f2bf(a) | ((unsigned)f2bf(b) << 16); }
__device__ __forceinline__ float bflo(unsigned u) { return __uint_as_float(u << 16); }
__device__ __forceinline__ float bfhi(unsigned u) { return __uint_as_float(u & 0xffff0000u); }
__device__ __forceinline__ int opaque_tid() {
  int t = threadIdx.x;
  asm volatile("" : "+v"(t));
  return t;
}
__device__ __forceinline__ int my_lane() { return opaque_tid() & 63; }
__device__ __forceinline__ float shx(float v, int o) { return __builtin_bit_cast(float, __builtin_amdgcn_ds_bpermute(((my_lane() ^ o) << 2), __builtin_bit_cast(int, v))); }
__device__ __forceinline__ float shf(float v, int src) { return __builtin_bit_cast(float, __builtin_amdgcn_ds_bpermute((src & 63) << 2, __builtin_bit_cast(int, v))); }
__device__ __forceinline__ unsigned shu(unsigned v, int src) { return (unsigned)__builtin_amdgcn_ds_bpermute((src & 63) << 2, (int)v); }
__device__ __forceinline__ float wave_sum(float v) {
  const int lane = my_lane();
#pragma unroll
  for (int o = 32; o > 0; o >>= 1) v += __builtin_bit_cast(float, __builtin_amdgcn_ds_bpermute((lane ^ o) << 2, __builtin_bit_cast(int, v)));
  return v;
}
__device__ __forceinline__ float wave_max(float v) {
  const int lane = my_lane();
#pragma unroll
  for (int o = 32; o > 0; o >>= 1) v = fmaxf(v, __builtin_bit_cast(float, __builtin_amdgcn_ds_bpermute((lane ^ o) << 2, __builtin_bit_cast(int, v))));
  return v;
}
__device__ __forceinline__ float sigmoidf_(float x) { return __builtin_amdgcn_rcpf(1.0f + __expf(-x)); }
__device__ __forceinline__ float gelu_tanh(float x) {
  const float u2 = 1.5957691216057308f * (x + 0.044715f * x * x * x);
  return x * __builtin_amdgcn_rcpf(1.0f + __expf(-u2));
}
__device__ __forceinline__ f32x16 mfma32(bf16x8 a, bf16x8 b, f32x16 c) {
  return __builtin_amdgcn_mfma_f32_32x32x16_bf16(a, b, c, 0, 0, 0);
}
__device__ __forceinline__ f32x16 zero16() {
  f32x16 z;
#pragma unroll
  for (int i = 0; i < 16; ++i) z[i] = 0.f;
  return z;
}
__device__ __forceinline__ int swz128(int row, int ch) { return row * 128 + ((ch ^ ((row >> 1) & 7)) << 4); }
__device__ __forceinline__ int swz256(int row, int ch) { return row * 256 + ((ch ^ (row & 15)) << 4); }

struct c2 { float x, y; };
__device__ __forceinline__ c2 cadd(c2 a, c2 b) { return {a.x + b.x, a.y + b.y}; }
__device__ __forceinline__ c2 csub(c2 a, c2 b) { return {a.x - b.x, a.y - b.y}; }
__device__ __forceinline__ c2 cmul(c2 a, c2 b) { return {a.x * b.x - a.y * b.y, a.x * b.y + a.y * b.x}; }
__device__ __forceinline__ float c16(int i) {
  const float tb[16] = {1.0f, 0.9238795325112867f, 0.7071067811865476f, 0.3826834323650898f, 0.0f,
                        -0.3826834323650898f, -0.7071067811865476f, -0.9238795325112867f, -1.0f,
                        -0.9238795325112867f, -0.7071067811865476f, -0.3826834323650898f, 0.0f,
                        0.3826834323650898f, 0.7071067811865476f, 0.9238795325112867f};
  return tb[i & 15];
}
__device__ __forceinline__ float s16(int i) { return c16(i + 12); }
template <int R> __device__ __forceinline__ constexpr int brev(int k) {
  int r = 0;
  for (int b = 1, o = R >> 1; b < R; b <<= 1, o >>= 1)
    if (k & b) r |= o;
  return r;
}
template <int R> __device__ __forceinline__ void dft_reg(c2* v, float sgn) {
#pragma unroll
  for (int h = R / 2; h >= 1; h >>= 1) {
#pragma unroll
    for (int g = 0; g < R; g += 2 * h) {
#pragma unroll
      for (int j = 0; j < h; ++j) {
        c2 a = v[g + j], b = v[g + j + h];
        v[g + j] = cadd(a, b);
        c2 d = csub(a, b);
        const int ti = j * (16 / (2 * h));
        c2 w = {c16(ti), sgn * s16(ti)};
        v[g + j + h] = (j == 0) ? d : cmul(d, w);
      }
    }
  }
}
template <int R> __device__ __forceinline__ int fft_bfly(c2* v, int j, int Ns, float sgn) {
  const int k = j & (Ns - 1);
  const float f = sgn * (float)k / (float)(Ns * R);
#pragma unroll
  for (int r = 1; r < R; ++r) {
    float t = f * (float)r;
    c2 w = {__builtin_amdgcn_cosf(t), __builtin_amdgcn_sinf(t)};
    v[r] = cmul(v[r], w);
  }
  dft_reg<R>(v, sgn);
  return (j - k) * R + k;
}
template <int R> __device__ __forceinline__ void fft_pass(c2* buf, int Ns, float sgn) {
  constexpr int NBF = 8192 / R;
  constexpr int PER = NBF / NTHR;
  const int tid = opaque_tid();
  c2 v[PER][R];
#pragma unroll
  for (int i = 0; i < PER; ++i) {
    const int j = tid + NTHR * i;
#pragma unroll
    for (int r = 0; r < R; ++r) v[i][r] = buf[j + r * NBF];
  }
  __syncthreads();
#pragma unroll
  for (int i = 0; i < PER; ++i) {
    const int j = tid + NTHR * i;
    const int base = fft_bfly<R>(v[i], j, Ns, sgn);
#pragma unroll
    for (int r = 0; r < R; ++r) buf[base + r * Ns] = v[i][brev<R>(r)];
  }
  __syncthreads();
}
__device__ __forceinline__ void fft8192(c2* buf, float sgn) {
  fft_pass<8>(buf, 1, sgn);
  fft_pass<8>(buf, 8, sgn);
  fft_pass<8>(buf, 64, sgn);
  fft_pass<16>(buf, 512, sgn);
}

__device__ __forceinline__ void gemm_kloop(f32x16 (&acc)[2][2], const u16* __restrict__ A, int lda,
                                           const u16* __restrict__ B, int ldb, int K, char* smem) {
  const int tid = opaque_tid(), lane = tid & 63, wid = tid >> 6;
  const int wm = wid >> 1, wn = wid & 1;
  const int l31 = lane & 31, hh = lane >> 5;
  uint4 ra[4], rb[2];
  const int nk = K >> 6;
  const int srow = tid >> 3, sch = tid & 7;
  const char* Ab = (const char*)A;
  const char* Bb = (const char*)B;
  const unsigned aoff = (unsigned)(srow * lda + sch * 8) * 2u;
  const unsigned boff = (unsigned)(srow * ldb + sch * 8) * 2u;
  const unsigned astep = (unsigned)lda * 128u, bstep = (unsigned)ldb * 128u;
#pragma unroll
  for (int i = 0; i < 4; ++i) ra[i] = *(const uint4*)(Ab + (aoff + i * astep));
#pragma unroll
  for (int i = 0; i < 2; ++i) rb[i] = *(const uint4*)(Bb + (boff + i * bstep));
#pragma unroll
  for (int i = 0; i < 4; ++i) *(uint4*)(smem + swz128(srow + i * 64, sch)) = ra[i];
#pragma unroll
  for (int i = 0; i < 2; ++i) *(uint4*)(smem + 65536 + swz128(srow + i * 64, sch)) = rb[i];
  __syncthreads();
  for (int kt = 0; kt < nk; ++kt) {
    const bool more = (kt + 1 < nk);
    if (more) {
      const unsigned ko = (unsigned)(kt + 1) * 128u;
#pragma unroll
      for (int i = 0; i < 4; ++i) ra[i] = *(const uint4*)(Ab + (aoff + i * astep + ko));
#pragma unroll
      for (int i = 0; i < 2; ++i) rb[i] = *(const uint4*)(Bb + (boff + i * bstep + ko));
    }
    const char* as = smem + (kt & 1) * 32768;
    const char* bs = smem + 65536 + (kt & 1) * 16384;
    int lrow = l31;
    asm volatile("" : "+v"(lrow));
#pragma unroll
    for (int s = 0; s < 4; ++s) {
      bf16x8 af[2], bfr[2];
#pragma unroll
      for (int i = 0; i < 2; ++i) af[i] = *(const bf16x8*)(as + swz128(wm * 64 + i * 32 + lrow, s * 2 + hh));
#pragma unroll
      for (int j = 0; j < 2; ++j) bfr[j] = *(const bf16x8*)(bs + swz128(wn * 64 + j * 32 + lrow, s * 2 + hh));
#pragma unroll
      for (int i = 0; i < 2; ++i)
#pragma unroll
        for (int j = 0; j < 2; ++j) acc[i][j] = mfma32(af[i], bfr[j], acc[i][j]);
    }
    if (more) {
      char* an = smem + ((kt + 1) & 1) * 32768;
      char* bn = smem + 65536 + ((kt + 1) & 1) * 16384;
      int sr2 = srow;
      asm volatile("" : "+v"(sr2));
#pragma unroll
      for (int i = 0; i < 4; ++i) *(uint4*)(an + swz128(sr2 + i * 64, sch)) = ra[i];
#pragma unroll
      for (int i = 0; i < 2; ++i) *(uint4*)(bn + swz128(sr2 + i * 64, sch)) = rb[i];
    }
    __syncthreads();
  }
}
__device__ __forceinline__ void zero_acc(f32x16 (&acc)[2][2]) {
#pragma unroll
  for (int i = 0; i < 2; ++i)
#pragma unroll
    for (int j = 0; j < 2; ++j) acc[i][j] = zero16();
}
#define EPI_ROW(i, e) (wm * 64 + (i)*32 + ((e)&3) + 8 * ((e) >> 2) + 4 * hh)
#define EPI_COL(j) (wn * 64 + (j)*32 + l31)
#define EPI_VARS                                                    \
  const int tid = opaque_tid(), lane = tid & 63, wid = tid >> 6;     \
  const int wm = wid >> 1, wn = wid & 1, l31 = lane & 31, hh = lane >> 5; \
  (void)tid; (void)wm; (void)wn; (void)l31; (void)hh;


namespace pg8 {
#define PG8_LAS __attribute__((address_space(3)))
typedef PG8_LAS unsigned char* PG8_LAS_T;
typedef float f32x4 __attribute__((ext_vector_type(4)));
typedef unsigned u32x4 __attribute__((ext_vector_type(4)));
constexpr int BM = 256, BK = 64, HALF = 128, HTB = HALF * BK * 2, STAGE_BYTES = 8 * HTB, NXCD = 8, WGM = 8;
__device__ __forceinline__ int lds_byte(int r, int c) { const int st = (r >> 4) * 2 + (c >> 5), rr = r & 15, cc = c & 31, ob = rr * 64 + cc * 2; return st * 1024 + (ob ^ (((ob >> 9) & 1) << 5)); }
__device__ __forceinline__ void stage_rc(int b, int& R, int& C) { const int st = b / 1024, sb = b % 1024, swz = sb ^ (((sb >> 9) & 1) << 5); R = (st >> 1) * 16 + swz / 64; C = (st & 1) * 32 + (swz % 64) / 2; }
__device__ __forceinline__ int perm32(int rho) { const int n = rho >> 4, i = rho & 15; return 8 * (i >> 2) + 4 * n + (i & 3); }
struct Unit { int pm, pn; };
struct Gemm { const u16* A; const u16* Bt; int lda, ldb, K; };
struct Order {
  int nM, nN, nwg, G, c, skip_from, skip_by;
  __device__ __forceinline__ void init(int nM_, int nN_, int G_, int c_, int sf = 1 << 30, int sb = 0) { nM = nM_; nN = nN_; nwg = nM * nN; G = G_; c = c_; skip_from = sf; skip_by = sb; }
  __device__ __forceinline__ bool next(int i, Unit& u) const {
    const long L = (long)i * G + c; if (L >= nwg) return false;
    int wgid = (int)L; { const int q = nwg / NXCD, r = nwg % NXCD, xcd = wgid % NXCD, off = wgid / NXCD; wgid = (xcd < r ? xcd * (q + 1) : r * (q + 1) + (xcd - r) * q) + off; }
    const int nig = WGM * nN, gid = wgid / nig, fm = gid * WGM, gsz = (nM - fm) < WGM ? (nM - fm) : WGM;
    u.pm = fm + ((wgid % nig) % gsz); u.pn = (wgid % nig) / gsz;
    if (u.pn >= skip_from) u.pn += skip_by;
    return true;
  }
};
template <class Epi>
__device__ __forceinline__ void gemm_phase(PG8_LAS unsigned char* lds, const Gemm g, const Order& S, const Epi& E) {
  const int tid = opaque_tid(), wid = __builtin_amdgcn_readfirstlane(tid >> 6), lane = tid & 63, wr = wid >> 2, wc = wid & 3, fr = lane & 15, fq = lane >> 4;
  const int K = g.K, nt = K / BK;
  unsigned voffA[2], voffB[2];
#pragma unroll
  for (int i = 0; i < 2; ++i) { int R, C; stage_rc(tid * 16 + i * 8192, R, C); const int Rb = Epi::PERM ? ((R & ~31) + perm32(R & 31)) : R;
    voffA[i] = (unsigned)(R * g.lda + C) * 2u; voffB[i] = (unsigned)(Rb * g.ldb + C) * 2u; }
  const size_t kstep = (size_t)(BK * 2);
  const size_t hstepA = (size_t)HALF * g.lda * 2, hstepB = (size_t)HALF * g.ldb * 2;
  const size_t tstepA = 2 * hstepA, tstepB = 2 * hstepB;
  const unsigned ldsw = (unsigned)wid * 1024u;
  const int aoff = lds_byte(wr * 64 + fr, fq * 8), boff = lds_byte(wc * 32 + fr, fq * 8);
#define PG8_SA(b, h) (((b) * 2 + (h)) * HTB)
#define PG8_SB(b, h) ((4 + (b) * 2 + (h)) * HTB)
#define PG8_STAGE(bufoff, gbase, voff) do { _Pragma("unroll") for (int _i = 0; _i < 2; ++_i) \
    __builtin_amdgcn_global_load_lds((const unsigned*)((const char*)(gbase) + (voff)[_i]), (PG8_LAS unsigned*)(lds + (bufoff) + ldsw + _i * 8192), 16, 0, 0); } while (0)
#define PG8_LDA(dst, b, h) do { _Pragma("unroll") for (int m = 0; m < 4; ++m) _Pragma("unroll") for (int k = 0; k < 2; ++k) dst[m][k] = *(const PG8_LAS bf16x8*)(lds + PG8_SA(b, h) + aoff + m * 2048 + k * 1024); } while (0)
#define PG8_LDB(dst, b, h) do { _Pragma("unroll") for (int n = 0; n < 2; ++n) _Pragma("unroll") for (int k = 0; k < 2; ++k) dst[n][k] = *(const PG8_LAS bf16x8*)(lds + PG8_SB(b, h) + boff + n * 2048 + k * 1024); } while (0)
#define PG8_MMA(ai, bj, At, Bt) do { __builtin_amdgcn_s_setprio(1); _Pragma("unroll") for (int m = 0; m < 4; ++m) _Pragma("unroll") for (int n = 0; n < 2; ++n) _Pragma("unroll") for (int k = 0; k < 2; ++k) \
    acc[ai][bj][m][n] = __builtin_amdgcn_mfma_f32_16x16x32_bf16(Bt[n][k], At[m][k], acc[ai][bj][m][n], 0, 0, 0); __builtin_amdgcn_s_setprio(0); } while (0)
#define PG8_WAIT_V(n) asm volatile("s_waitcnt vmcnt(" #n ")" ::: "memory")
#define PG8_WAIT_L(n) asm volatile("s_waitcnt lgkmcnt(" #n ")" ::: "memory")
#define PG8_BAR __builtin_amdgcn_s_barrier()
#define PG8_SCHED __builtin_amdgcn_sched_barrier(0)
  Unit cur, nxt; int ui = 0;
  if (!S.next(0, cur)) return;
  f32x4 acc[2][2][4][2];
#pragma unroll
  for (int a = 0; a < 2; ++a)
#pragma unroll
    for (int b = 0; b < 2; ++b)
#pragma unroll
      for (int m = 0; m < 4; ++m)
#pragma unroll
        for (int n = 0; n < 2; ++n) acc[a][b][m][n] = (f32x4){0.f, 0.f, 0.f, 0.f};
  bf16x8 At[4][2], B0[2][2], B1[2][2];
  const char* cA = (const char*)g.A + (size_t)cur.pm * tstepA; const char* cB = (const char*)g.Bt + (size_t)cur.pn * tstepB;
  PG8_STAGE(PG8_SB(0, 0), cB, voffB); PG8_STAGE(PG8_SA(0, 0), cA, voffA); PG8_STAGE(PG8_SB(0, 1), cB + hstepB, voffB); PG8_STAGE(PG8_SA(0, 1), cA + hstepA, voffA);
  if (wr == 1) PG8_BAR;
  PG8_WAIT_V(4); PG8_BAR;
  PG8_STAGE(PG8_SB(1, 0), cB + kstep, voffB); PG8_STAGE(PG8_SA(1, 0), cA + kstep, voffA); PG8_STAGE(PG8_SB(1, 1), cB + hstepB + kstep, voffB);
  PG8_WAIT_V(6); PG8_BAR;
  for (;;) {
    const bool has_next = S.next(ui + 1, nxt);
    const char* nA = has_next ? (const char*)g.A + (size_t)nxt.pm * tstepA : cA; const char* nB = has_next ? (const char*)g.Bt + (size_t)nxt.pn * tstepB : cB;
    for (int t = 0; t < nt; t += 2) {
      const bool last = (t == nt - 2);
      const char* a1 = cA + (size_t)(t + 1) * kstep;
      const char* a2 = last ? nA : cA + (size_t)(t + 2) * kstep; const char* b2 = last ? nB : cB + (size_t)(t + 2) * kstep;
      const char* a3 = a2 + kstep; const char* b3 = b2 + kstep;
      PG8_LDB(B0, 0, 0); PG8_SCHED; PG8_LDA(At, 0, 0); PG8_STAGE(PG8_SA(1, 1), a1 + hstepA, voffA);
      PG8_WAIT_L(8); PG8_BAR; PG8_WAIT_L(0); PG8_MMA(0, 0, At, B0); PG8_BAR; PG8_SCHED;
      PG8_LDB(B1, 0, 1); PG8_STAGE(PG8_SB(0, 0), b2, voffB);
      PG8_BAR; PG8_WAIT_L(0); PG8_MMA(0, 1, At, B1); PG8_BAR;
      PG8_LDA(At, 0, 1); PG8_STAGE(PG8_SA(0, 0), a2, voffA);
      PG8_BAR; PG8_WAIT_L(0); PG8_MMA(1, 0, At, B0); PG8_BAR; PG8_SCHED;
      PG8_STAGE(PG8_SB(0, 1), b2 + hstepB, voffB);
      PG8_WAIT_V(6); PG8_BAR; PG8_MMA(1, 1, At, B1); PG8_BAR;
      PG8_LDB(B0, 1, 0); PG8_SCHED; PG8_LDA(At, 1, 0); PG8_STAGE(PG8_SA(0, 1), a2 + hstepA, voffA);
      PG8_WAIT_L(8); PG8_BAR; PG8_WAIT_L(0); PG8_MMA(0, 0, At, B0); PG8_BAR; PG8_SCHED;
      PG8_LDB(B1, 1, 1); PG8_STAGE(PG8_SB(1, 0), b3, voffB);
      PG8_BAR; PG8_WAIT_L(0); PG8_MMA(0, 1, At, B1); PG8_BAR;
      PG8_LDA(At, 1, 1); PG8_STAGE(PG8_SA(1, 0), a3, voffA);
      PG8_BAR; PG8_WAIT_L(0); PG8_MMA(1, 0, At, B0); PG8_BAR; PG8_SCHED;
      PG8_STAGE(PG8_SB(1, 1), b3 + hstepB, voffB);
      PG8_WAIT_V(6); PG8_BAR; PG8_MMA(1, 1, At, B1); PG8_BAR;
    }
    E(acc, cur, wr, wc, fr, fq);
    if (!has_next) break;
#pragma unroll
    for (int a = 0; a < 2; ++a)
#pragma unroll
      for (int b = 0; b < 2; ++b)
#pragma unroll
        for (int m = 0; m < 4; ++m)
#pragma unroll
          for (int n = 0; n < 2; ++n) acc[a][b][m][n] = (f32x4){0.f, 0.f, 0.f, 0.f};
    cur = nxt; cA = nA; cB = nB; ++ui;
  }
  PG8_WAIT_V(0);
  if (wr == 0) PG8_BAR;
  PG8_BAR;
#undef PG8_SA
#undef PG8_SB
#undef PG8_STAGE
#undef PG8_LDA
#undef PG8_LDB
#undef PG8_MMA
#undef PG8_WAIT_V
#undef PG8_WAIT_L
#undef PG8_BAR
#undef PG8_SCHED
}
typedef const f32x4 (&AccRef)[2][2][4][2];
struct EpiInprojN {
  static constexpr bool PERM = true;
  u16* qk; u16* rg;
  __device__ __forceinline__ void operator()(AccRef acc, const Unit& u, int wr, int wc, int fr, int fq) const {
    const int row0 = u.pm * BM + wr * 64 + fr;
    u16* base; int ld, colt;
    if (u.pn < 4) { base = qk; ld = 1024; colt = u.pn * 256; } else { base = rg; ld = 512; colt = (u.pn - 9) * 256; }
    const int col0 = colt + wc * 32 + 8 * fq;
#pragma unroll
    for (int ai = 0; ai < 2; ++ai)
#pragma unroll
      for (int m = 0; m < 4; ++m) {
        u16* rowp = base + (size_t)(row0 + ai * HALF + m * 16) * ld + col0;
#pragma unroll
        for (int bj = 0; bj < 2; ++bj) {
          const f32x4 v0 = acc[ai][bj][m][0], v1 = acc[ai][bj][m][1];
          u32x4 w; w.x = pk2(v0[0], v0[1]); w.y = pk2(v0[2], v0[3]); w.z = pk2(v1[0], v1[1]); w.w = pk2(v1[2], v1[3]);
          *(u32x4*)(rowp + bj * HALF) = w;
        }
      }
  }
};
struct EpiInprojT {
  static constexpr bool PERM = true;
  u16 *vT, *vTc, *hyT, *hyTc;
  __device__ __forceinline__ void operator()(AccRef acc, const Unit& u, int wr, int wc, int fr, int fq) const {
    const bool isctx = (u.pn >= 128);
    const int b = isctx ? (u.pn - 128) : (u.pn >> 4);
    const int Lseg = isctx ? 256 : 4096, t0 = isctx ? 0 : (u.pn & 15) * 256;
    const bool isv = (u.pm < 2);
    const size_t boff = isv ? (isctx ? (size_t)16777216 : (size_t)0) : (isctx ? (size_t)(16777216 + 1048576 + 25165824) : (size_t)(16777216 + 1048576));
    u16* base = vT + boff;
    const int nc = isv ? 512 : 768;
    const int wrow0 = (isv ? u.pm : u.pm - 2) * BM + wr * 64 + fr;
    const int col0 = t0 + wc * 32 + 8 * fq;
#pragma unroll
    for (int ai = 0; ai < 2; ++ai)
#pragma unroll
      for (int m = 0; m < 4; ++m) {
        u16* rowp = base + ((size_t)(b * nc + wrow0 + ai * HALF + m * 16)) * Lseg + col0;
#pragma unroll
        for (int bj = 0; bj < 2; ++bj) {
          const f32x4 v0 = acc[ai][bj][m][0], v1 = acc[ai][bj][m][1];
          u32x4 w; w.x = pk2(v0[0], v0[1]); w.y = pk2(v0[2], v0[3]); w.z = pk2(v1[0], v1[1]); w.w = pk2(v1[2], v1[3]);
          *(u32x4*)(rowp + bj * HALF) = w;
        }
      }
  }
};
struct EpiGate {
  static constexpr bool PERM = true;
  unsigned char* g8; const float* bias;
  __device__ __forceinline__ void operator()(AccRef acc, const Unit& u, int wr, int wc, int fr, int fq) const {
    const int row0 = u.pm * BM + wr * 64 + fr;
    const int col0 = u.pn * BM + wc * 32 + 8 * fq;
#pragma unroll
    for (int bj = 0; bj < 2; ++bj) {
      const f32x4 b0 = *(const f32x4*)(bias + col0 + bj * HALF), b1 = *(const f32x4*)(bias + col0 + bj * HALF + 4);
#pragma unroll
      for (int ai = 0; ai < 2; ++ai)
#pragma unroll
        for (int m = 0; m < 4; ++m) {
          const f32x4 v0 = acc[ai][bj][m][0] + b0, v1 = acc[ai][bj][m][1] + b1;
          unsigned w0 = 0, w1 = 0;
#pragma unroll
          for (int k = 0; k < 4; ++k) {
            w0 |= (unsigned)(sigmoidf_(v0[k]) * 255.0f + 0.5f) << (8 * k);
            w1 |= (unsigned)(sigmoidf_(v1[k]) * 255.0f + 0.5f) << (8 * k);
          }
          *(uint2*)(g8 + (size_t)(row0 + ai * HALF + m * 16) * 3072 + col0 + bj * HALF) = make_uint2(w0, w1);
        }
    }
  }
};
struct EpiBranch {
  static constexpr bool PERM = true;
  u16* mbuf; const unsigned char* g8; int br;
  __device__ __forceinline__ void operator()(AccRef acc, const Unit& u, int wr, int wc, int fr, int fq) const {
    const int row0 = u.pm * BM + wr * 64 + fr;
    const int col0 = u.pn * BM + wc * 32 + 8 * fq;
#pragma unroll
    for (int ai = 0; ai < 2; ++ai)
#pragma unroll
      for (int m = 0; m < 4; ++m) {
        const size_t row = (size_t)(row0 + ai * HALF + m * 16);
#pragma unroll
        for (int bj = 0; bj < 2; ++bj) {
          const uint2 gq = *(const uint2*)(g8 + row * 3072 + br * 1024 + col0 + bj * HALF);
          u16* mp = mbuf + row * 1024 + col0 + bj * HALF;
          const f32x4 v0 = acc[ai][bj][m][0], v1 = acc[ai][bj][m][1];
          float r[8];
          r[0] = (float)(gq.x & 255u) * v0[0]; r[1] = (float)((gq.x >> 8) & 255u) * v0[1];
          r[2] = (float)((gq.x >> 16) & 255u) * v0[2]; r[3] = (float)(gq.x >> 24) * v0[3];
          r[4] = (float)(gq.y & 255u) * v1[0]; r[5] = (float)((gq.y >> 8) & 255u) * v1[1];
          r[6] = (float)((gq.y >> 16) & 255u) * v1[2]; r[7] = (float)(gq.y >> 24) * v1[3];
          u32x4 w;
          if (br == 0) {
            w.x = pk2(r[0] * (1.f / 255.f), r[1] * (1.f / 255.f)); w.y = pk2(r[2] * (1.f / 255.f), r[3] * (1.f / 255.f));
            w.z = pk2(r[4] * (1.f / 255.f), r[5] * (1.f / 255.f)); w.w = pk2(r[6] * (1.f / 255.f), r[7] * (1.f / 255.f));
          } else {
            const u32x4 o = *(const u32x4*)mp;
            w.x = pk2(bflo(o.x) + r[0] * (1.f / 255.f), bfhi(o.x) + r[1] * (1.f / 255.f));
            w.y = pk2(bflo(o.y) + r[2] * (1.f / 255.f), bfhi(o.y) + r[3] * (1.f / 255.f));
            w.z = pk2(bflo(o.z) + r[4] * (1.f / 255.f), bfhi(o.z) + r[5] * (1.f / 255.f));
            w.w = pk2(bflo(o.w) + r[6] * (1.f / 255.f), bfhi(o.w) + r[7] * (1.f / 255.f));
          }
          *(u32x4*)mp = w;
        }
      }
  }
};
struct EpiOut {
  static constexpr bool PERM = false;
  const float *xsrc, *csrc; float *xdst, *cdst; const float* modl;
  __device__ __forceinline__ void operator()(AccRef acc, const Unit& u, int wr, int wc, int fr, int fq) const {
    const bool isctx = (u.pm >= 128);
    const int bi = isctx ? 8 : (u.pm >> 4);
    const float* gatev = modl + ((size_t)bi * 6 + 2) * 1024;
    const float* src = isctx ? (csrc - (size_t)NLAT * 1024) : xsrc;
    float* dst = isctx ? (cdst - (size_t)NLAT * 1024) : xdst;
    const int row0 = u.pm * BM + wr * 64 + fr, col0 = u.pn * BM + wc * 32 + 4 * fq;
#pragma unroll
    for (int bj = 0; bj < 2; ++bj)
#pragma unroll
      for (int n = 0; n < 2; ++n) {
        const int col = col0 + bj * HALF + n * 16;
        const f32x4 gv = *(const f32x4*)(gatev + col);
#pragma unroll
        for (int ai = 0; ai < 2; ++ai)
#pragma unroll
          for (int m = 0; m < 4; ++m) {
            const size_t o = (size_t)(row0 + ai * HALF + m * 16) * 1024 + col;
            const f32x4 xv = *(const f32x4*)(src + o);
            *(f32x4*)(dst + o) = xv + gv * acc[ai][bj][m][n];
          }
      }
  }
};
struct EpiQ {
  static constexpr bool PERM = true;
  u16* q;
  __device__ __forceinline__ void operator()(AccRef acc, const Unit& u, int wr, int wc, int fr, int fq) const {
    const int row0 = u.pm * BM + wr * 64 + fr;
    const int col0 = u.pn * BM + wc * 32 + 8 * fq;
#pragma unroll
    for (int ai = 0; ai < 2; ++ai)
#pragma unroll
      for (int m = 0; m < 4; ++m) {
        u16* rowp = q + (size_t)(row0 + ai * HALF + m * 16) * 2048 + col0;
#pragma unroll
        for (int bj = 0; bj < 2; ++bj) {
          const f32x4 v0 = acc[ai][bj][m][0], v1 = acc[ai][bj][m][1];
          u32x4 w;
          w.x = __builtin_bit_cast(unsigned, __builtin_amdgcn_cvt_pkrtz(v0[0], v0[1]));
          w.y = __builtin_bit_cast(unsigned, __builtin_amdgcn_cvt_pkrtz(v0[2], v0[3]));
          w.z = __builtin_bit_cast(unsigned, __builtin_amdgcn_cvt_pkrtz(v1[0], v1[1]));
          w.w = __builtin_bit_cast(unsigned, __builtin_amdgcn_cvt_pkrtz(v1[2], v1[3]));
          *(u32x4*)(rowp + bj * HALF) = w;
        }
      }
  }
};
}

__device__ __forceinline__ void tr_tile(const float* __restrict__ src, int N, int K, u16* __restrict__ dst, int tile, char* smem) {
  float* lds = (float*)smem;
  const int tiles_n = N >> 6;
  const int tk = tile / tiles_n, tn = tile - tk * tiles_n;
  const int tid = opaque_tid();
  {
    const int r = tid >> 3, c8 = (tid & 7) * 8;
    const float* s = src + (size_t)(tk * 64 + r) * N + tn * 64 + c8;
    float4 a = *(const float4*)s, b = *(const float4*)(s + 4);
    float* d = lds + r * 65 + c8;
    d[0] = a.x; d[1] = a.y; d[2] = a.z; d[3] = a.w; d[4] = b.x; d[5] = b.y; d[6] = b.z; d[7] = b.w;
  }
  __syncthreads();
  {
    const int n = tid >> 3, k0 = (tid & 7) * 8;
    uint4 o;
    o.x = pk2(lds[(k0 + 0) * 65 + n], lds[(k0 + 1) * 65 + n]);
    o.y = pk2(lds[(k0 + 2) * 65 + n], lds[(k0 + 3) * 65 + n]);
    o.z = pk2(lds[(k0 + 4) * 65 + n], lds[(k0 + 5) * 65 + n]);
    o.w = pk2(lds[(k0 + 6) * 65 + n], lds[(k0 + 7) * 65 + n]);
    *(uint4*)(dst + (size_t)(tn * 64 + n) * K + tk * 64 + k0) = o;
  }
  __syncthreads();
}
__device__ __forceinline__ void cvt_chunk(const float* __restrict__ src, u16* __restrict__ dst, size_t chunk) {
  const size_t i = chunk * 4096 + (size_t)opaque_tid() * 8;
  float4 a = *(const float4*)(src + i), b = *(const float4*)(src + i + 4);
  uint4 o;
  o.x = pk2(a.x, a.y); o.y = pk2(a.z, a.w); o.z = pk2(b.x, b.y); o.w = pk2(b.z, b.w);
  *(uint4*)(dst + i) = o;
}
__device__ __forceinline__ void cvt_chunk_fp8(const float* __restrict__ src, unsigned char* __restrict__ dst, size_t chunk, float scale) {
  const size_t i = chunk * 4096 + (size_t)opaque_tid() * 8;
  const float4 a = *(const float4*)(src + i), b = *(const float4*)(src + i + 4);
  int w0 = __builtin_amdgcn_cvt_pk_fp8_f32(a.x * scale, a.y * scale, 0, false);
  w0 = __builtin_amdgcn_cvt_pk_fp8_f32(a.z * scale, a.w * scale, w0, true);
  int w1 = __builtin_amdgcn_cvt_pk_fp8_f32(b.x * scale, b.y * scale, 0, false);
  w1 = __builtin_amdgcn_cvt_pk_fp8_f32(b.z * scale, b.w * scale, w1, true);
  *(uint2*)(dst + i) = make_uint2((unsigned)w0, (unsigned)w1);
}
__device__ __forceinline__ void cvt_chunk_fp4(const float* __restrict__ src, unsigned char* __restrict__ dst, size_t chunk, float scale, int vhalf) {
  const size_t i = chunk * 4096 + (size_t)opaque_tid() * 8;
  const float4 a = *(const float4*)(src + i), b = *(const float4*)(src + i + 4);
  unsigned w = 0;
  w = __builtin_amdgcn_cvt_scalef32_pk_fp4_f32(w, a.x * scale, a.y * scale, 1.0f, 0);
  w = __builtin_amdgcn_cvt_scalef32_pk_fp4_f32(w, a.z * scale, a.w * scale, 1.0f, 1);
  w = __builtin_amdgcn_cvt_scalef32_pk_fp4_f32(w, b.x * scale, b.y * scale, 1.0f, 2);
  w = __builtin_amdgcn_cvt_scalef32_pk_fp4_f32(w, b.z * scale, b.w * scale, 1.0f, 3);
  const size_t e = i >> 10;
  const unsigned d = (unsigned)(i & 1023);
  *(unsigned*)(dst + e * 1024 + (d >> 4) * 16 + vhalf * 8 + ((d & 15) >> 1)) = w;
}
__device__ __forceinline__ void phase_prep(const P& p, char* smem) {
  const int tid = opaque_tid();
  const int NTR = 2512;
  const int total = 2 * NTR + 128 + 384;
  for (int task = blockIdx.x; task < total; task += gridDim.x) {
    if (task < 2 * NTR) {
      const int l = task / NTR;
      int t = task - l * NTR;
      if (t < 704) tr_tile(p.w_in + (size_t)l * 1024 * 2816, 2816, 1024, p.WinT + (size_t)l * 2816 * 1024, t, smem);
      else if ((t -= 704) < 768) tr_tile(p.w_gate + (size_t)l * 1024 * 3072, 3072, 1024, p.WgT + (size_t)l * 3072 * 1024, t, smem);
      else if ((t -= 768) < 128) tr_tile(p.w_br_a + (size_t)l * 512 * 1024, 1024, 512, p.WaT + (size_t)l * 1024 * 512, t, smem);
      else if ((t -= 128) < 64) tr_tile(p.w_br_b + (size_t)l * 256 * 1024, 1024, 256, p.WbT + (size_t)l * 1024 * 256, t, smem);
      else if ((t -= 64) < 64) tr_tile(p.w_br_c + (size_t)l * 256 * 1024, 1024, 256, p.WcT + (size_t)l * 1024 * 256, t, smem);
      else if ((t -= 64) < 256) tr_tile(p.w_out + (size_t)l * 1024 * 1024, 1024, 1024, p.WoT + (size_t)l * 1024 * 1024, t, smem);
      else if ((t -= 256) < 512) cvt_chunk(p.peer_wq + (size_t)l * 1024 * 2048, p.WqB + (size_t)l * 1024 * 2048, (size_t)t);
      else {
        t -= 512;
        const int gate = t >> 3, dn = t & 7;
        const float* src = (gate ? p.rg_wx : p.rg_wa) + (size_t)(l * 8 + dn) * 4096;
        tr_tile(src, 64, 64, p.rgW + (size_t)((l * 2 + gate) * 8 + dn) * 4096, 0, smem);
      }
    } else if (task < 2 * NTR + 128) {
      cvt_chunk(p.peer_keys, p.keysB, (size_t)(task - 2 * NTR));
    } else {
      int t = task - 2 * NTR - 128;
      const int kc = t & 15; t >>= 4;
      const int jc = t % 12, l = t / 12;
      float* s = (float*)smem;
      for (int i = tid; i < 576; i += NTHR) {
        const int bi = i >> 6, kk = i & 63;
        const float v = (bi < 8) ? p.c[bi * 1024 + kc * 64 + kk] : p.c_ctx[kc * 64 + kk];
        s[i] = v / (1.0f + __expf(-v));
      }
      __syncthreads();
      const int j = jc * 512 + tid;
      float acc[9];
#pragma unroll
      for (int bi = 0; bi < 9; ++bi) acc[bi] = 0.f;
      const float* wp = p.w_ada + ((size_t)l * 1024 + kc * 64) * 6144 + j;
#pragma unroll 8
      for (int kk = 0; kk < 64; ++kk) {
        const float w = wp[(size_t)kk * 6144];
#pragma unroll
        for (int bi = 0; bi < 9; ++bi) acc[bi] += s[bi * 64 + kk] * w;
      }
#pragma unroll
      for (int bi = 0; bi < 9; ++bi) p.modpart[((size_t)(kc * 2 + l) * 9 + bi) * 6144 + j] = acc[bi];
      __syncthreads();
    }
  }
}
__device__ __forceinline__ void phase_modreduce(const P& p) {
  const int n = 2 * 9 * 6144;
  for (int i = blockIdx.x * NTHR + opaque_tid(); i < n; i += gridDim.x * NTHR) {
    const int l = i / (9 * 6144);
    const int j = i % 6144;
    float s = p.b_ada[l * 6144 + j];
#pragma unroll
    for (int kc = 0; kc < 16; ++kc) s += p.modpart[(size_t)kc * n + i];
    p.mod[i] = s;
  }
}

__device__ __forceinline__ void phase_norm(const P& p, int l, int which) {
  const int tid_ = opaque_tid(); const int lane = tid_ & 63, wid = tid_ >> 6;
  const int ntok = (which == 2 || (which == 1 && l == 1)) ? NLAT : NTOK;
  for (int row = blockIdx.x * 8 + wid; row < ntok; row += gridDim.x * 8) {
    const float* src;
    if (row < NLAT) src = ((which == 0 && l == 0) ? p.x : p.out) + (size_t)row * 1024;
    else src = ((which == 0 && l == 0) ? p.ctx : p.ctxs) + (size_t)(row - NLAT) * 1024;
    float4 v[4];
    float ss = 0.f;
#pragma unroll
    for (int i = 0; i < 4; ++i) {
      v[i] = *(const float4*)(src + i * 256 + lane * 4);
      ss += v[i].x * v[i].x + v[i].y * v[i].y + v[i].z * v[i].z + v[i].w * v[i].w;
    }
    ss = wave_sum(ss);
    const float rstd = rsqrtf(ss * (1.0f / 1024.0f) + 1e-6f);
    if (which == 2) {
#pragma unroll
      for (int i = 0; i < 4; ++i) {
        const int col = i * 256 + lane * 4;
        const float4 g = *(const float4*)(p.final_g + col);
        float4 o = {v[i].x * rstd * g.x, v[i].y * rstd * g.y, v[i].z * rstd * g.z, v[i].w * rstd * g.w};
        *(float4*)(p.out + (size_t)row * 1024 + col) = o;
      }
    } else {
      const int bi = row < NLAT ? (row >> 12) : 8;
      const float* gam = (which == 0 ? p.norm_mix_g : p.norm_ffn_g) + l * 1024;
      const float* msh = p.mod + ((size_t)(l * 9 + bi) * 6 + (which == 0 ? 0 : 3)) * 1024;
      const float* msc = msh + 1024;
#pragma unroll
      for (int i = 0; i < 4; ++i) {
        const int col = i * 256 + lane * 4;
        const float4 g = *(const float4*)(gam + col);
        const float4 sh = *(const float4*)(msh + col);
        const float4 sc = *(const float4*)(msc + col);
        uint2 o;
        o.x = pk2(v[i].x * rstd * g.x * (1.f + sc.x) + sh.x, v[i].y * rstd * g.y * (1.f + sc.y) + sh.y);
        o.y = pk2(v[i].z * rstd * g.z * (1.f + sc.z) + sh.z, v[i].w * rstd * g.w * (1.f + sc.w) + sh.w);
        *(uint2*)(p.xn + (size_t)row * 1024 + col) = o;
      }
    }
  }
}

__device__ __forceinline__ void filter_wave(const P& p, int l, int L, int t, float* __restrict__ outp) {
  const int lane = opaque_tid() & 63;
  const float tl = (float)t / (float)(L - 1);
  const float wang = (6.283185307179586f / (float)L) * (float)t;
  float z = 0.f;
  if (lane == 0) z = tl;
  else if (lane <= 16) { const float band = 1e-4f + (float)(lane - 1) * ((15.0f - 1e-4f) / 15.0f); z = cosf(band * wang); }
  else if (lane <= 32) { const float band = 1e-4f + (float)(lane - 17) * ((15.0f - 1e-4f) / 15.0f); z = -sinf(band * wang); }
  float a1 = p.hy_f1_b[l * 64 + lane];
  for (int i = 0; i < 33; ++i) a1 += shf(z, i) * p.hy_f1_w[(l * 33 + i) * 64 + lane];
  const float h1 = sinf(p.hy_freq[l * 128 + lane] * a1);
  float a2 = p.hy_f2_b[l * 64 + lane];
  for (int i = 0; i < 64; ++i) a2 += shf(h1, i) * p.hy_f2_w[(l * 64 + i) * 64 + lane];
  const float h2 = sinf(p.hy_freq[l * 128 + 64 + lane] * a2);
  float a3[8];
#pragma unroll
  for (int m = 0; m < 8; ++m) a3[m] = 0.f;
  for (int i = 0; i < 64; ++i) {
    const float hv = shf(h2, i);
    const float* wr = p.hy_f3_w + (size_t)(l * 64 + i) * 512 + lane;
#pragma unroll
    for (int m = 0; m < 8; ++m) a3[m] += hv * wr[m * 64];
  }
  const float LN100 = 4.605170185988092f;
  const float d0 = LN100 / 1.5f, d1 = LN100 / 0.3f;
#pragma unroll
  for (int m = 0; m < 8; ++m) {
    const int cp = lane + 64 * m;
    const int ch = cp & 255;
    const float delta = d0 + (float)ch * ((d1 - d0) / 255.0f);
    outp[(size_t)cp * L + t] = a3[m] * expf(-tl * delta);
  }
}
__device__ __forceinline__ void filter_block_task(const P& p, int l, int L, int t0, float* __restrict__ outp, char* smem) {
  const int tid = opaque_tid(), lane = tid & 63, wid = tid >> 6;
  float* W3s = (float*)smem;
  float* W2s = (float*)(smem + 131072);
  {
    const float4* s3 = (const float4*)(p.hy_f3_w + (size_t)l * 64 * 512);
    const float4* s2 = (const float4*)(p.hy_f2_w + (size_t)l * 64 * 64);
#pragma unroll
    for (int i = 0; i < 16; ++i) ((float4*)W3s)[tid + NTHR * i] = s3[tid + NTHR * i];
#pragma unroll
    for (int i = 0; i < 2; ++i) ((float4*)W2s)[tid + NTHR * i] = s2[tid + NTHR * i];
  }
  __syncthreads();
  float z[4], tl[4];
#pragma unroll
  for (int j = 0; j < 4; ++j) {
    const int t = t0 + wid * 4 + j;
    tl[j] = (float)t / (float)(L - 1);
    const float wang = (6.283185307179586f / (float)L) * (float)t;
    float zz = 0.f;
    if (lane == 0) zz = tl[j];
    else if (lane <= 16) { const float band = 1e-4f + (float)(lane - 1) * ((15.0f - 1e-4f) / 15.0f); zz = cosf(band * wang); }
    else if (lane <= 32) { const float band = 1e-4f + (float)(lane - 17) * ((15.0f - 1e-4f) / 15.0f); zz = -sinf(band * wang); }
    z[j] = zz;
  }
  float a1[4], a2[4];
  {
    const float b1 = p.hy_f1_b[l * 64 + lane];
#pragma unroll
    for (int j = 0; j < 4; ++j) a1[j] = b1;
#pragma unroll 11
    for (int i = 0; i < 33; ++i) {
      const float w = p.hy_f1_w[(l * 33 + i) * 64 + lane];
#pragma unroll
      for (int j = 0; j < 4; ++j) a1[j] += shf(z[j], i) * w;
    }
    const float f0 = p.hy_freq[l * 128 + lane];
#pragma unroll
    for (int j = 0; j < 4; ++j) a1[j] = sinf(f0 * a1[j]);
  }
  {
    const float b2 = p.hy_f2_b[l * 64 + lane];
#pragma unroll
    for (int j = 0; j < 4; ++j) a2[j] = b2;
#pragma unroll 8
    for (int i = 0; i < 64; ++i) {
      const float w = W2s[i * 64 + lane];
#pragma unroll
      for (int j = 0; j < 4; ++j) a2[j] += shf(a1[j], i) * w;
    }
    const float f1 = p.hy_freq[l * 128 + 64 + lane];
#pragma unroll
    for (int j = 0; j < 4; ++j) a2[j] = sinf(f1 * a2[j]);
  }
  float a3[4][8];
#pragma unroll
  for (int j = 0; j < 4; ++j)
#pragma unroll
    for (int m = 0; m < 8; ++m) a3[j][m] = 0.f;
#pragma unroll 4
  for (int i = 0; i < 64; ++i) {
    float w[8];
#pragma unroll
    for (int m = 0; m < 8; ++m) w[m] = W3s[i * 512 + lane + 64 * m];
#pragma unroll
    for (int j = 0; j < 4; ++j) {
      const float hv = shf(a2[j], i);
#pragma unroll
      for (int m = 0; m < 8; ++m) a3[j][m] += hv * w[m];
    }
  }
  const float LN100 = 4.605170185988092f;
  const float d0 = LN100 / 1.5f, d1 = LN100 / 0.3f;
#pragma unroll
  for (int m = 0; m < 8; ++m) {
    const int cp = lane + 64 * m;
    const float delta = d0 + (float)(cp & 255) * ((d1 - d0) / 255.0f);
    float4 o;
    o.x = a3[0][m] * expf(-tl[0] * delta); o.y = a3[1][m] * expf(-tl[1] * delta);
    o.z = a3[2][m] * expf(-tl[2] * delta); o.w = a3[3][m] * expf(-tl[3] * delta);
    *(float4*)(outp + (size_t)cp * L + t0 + wid * 4) = o;
  }
  __syncthreads();
}
__device__ __forceinline__ void phase_filters(const P& p, int l, char* smem) {
  const int ntask = 128 + (l == 0 ? 8 : 0);
  for (int t = blockIdx.x; t < ntask; t += gridDim.x) {
    if (t < 128) filter_block_task(p, l, 4096, t * 32, p.hT + (size_t)l * 512 * 4096, smem);
    else filter_block_task(p, l, 256, (t - 128) * 32, p.hc, smem);
  }
}
__device__ __forceinline__ void kf_task(const P& p, int l, int c, char* smem) {
  const float* hTl = p.hT + (size_t)l * 512 * 4096;
  c2* buf = (c2*)smem;
  const int tid = opaque_tid();
  for (int i = 0; i < 16; ++i) {
    const int j = tid + NTHR * i;
    float v;
    if (j < 4096) v = hTl[(size_t)c * 4096 + j];
    else if (j == 4096) v = 0.f;
    else v = hTl[(size_t)(256 + c) * 4096 + (8192 - j)];
    buf[j] = {v, 0.f};
  }
  __syncthreads();
  fft8192(buf, -1.f);
  c2* o = (c2*)p.Kf + ((size_t)l * 256 + c) * 8192;
  for (int i = 0; i < 16; ++i) { const int j = tid + NTHR * i; o[j] = buf[j]; }
  __syncthreads();
}

__device__ __forceinline__ void inproj_tile(const P& p, int l, int mt, int nt, char* smem) {
  f32x16 acc[2][2];
  zero_acc(acc);
  const int m0 = mt * 256, n0 = nt * 128;
  gemm_kloop(acc, p.xn + (size_t)m0 * 1024, 1024, p.WinT + ((size_t)l * 2816 + n0) * 1024, 1024, 1024, smem);
  EPI_VARS
  if (nt < 8 || nt >= 18) {
    u16* dst; int ld, cbase;
    if (nt < 8) { dst = p.qk; ld = 1024; cbase = n0; }
    else { dst = p.rg; ld = 512; cbase = n0 - 2304; }
#pragma unroll
    for (int i = 0; i < 2; ++i)
#pragma unroll
      for (int j = 0; j < 2; ++j)
#pragma unroll
        for (int e = 0; e < 16; ++e)
          dst[(size_t)(m0 + EPI_ROW(i, e)) * ld + cbase + EPI_COL(j)] = f2bf(acc[i][j][e]);
  } else {
#pragma unroll
    for (int i = 0; i < 2; ++i)
#pragma unroll
      for (int j = 0; j < 2; ++j)
#pragma unroll
        for (int qd = 0; qd < 4; ++qd) {
          uint2 o;
          o.x = pk2(acc[i][j][4 * qd + 0], acc[i][j][4 * qd + 1]);
          o.y = pk2(acc[i][j][4 * qd + 2], acc[i][j][4 * qd + 3]);
          const int row0 = wm * 64 + i * 32 + 8 * qd + 4 * hh;
          *(uint2*)(smem + EPI_COL(j) * 520 + row0 * 2) = o;
        }
    __syncthreads();
    u16* dstT; int Lseg, t0, ncol0, nc;
    const bool isctx = (mt >= 128);
    const int b = isctx ? (mt - 128) : (mt >> 4);
    if (nt < 12) { ncol0 = n0 - 1024; nc = 512; dstT = isctx ? p.vTc : p.vT; }
    else { ncol0 = n0 - 1536; nc = 768; dstT = isctx ? p.hyTc : p.hyT; }
    if (isctx) { Lseg = 256; t0 = 0; } else { Lseg = 4096; t0 = (mt & 15) * 256; }
#pragma unroll 4
    for (int it = 0; it < 16; ++it) {
      const int idx = tid + NTHR * it;
      const int col = idx >> 6, u = idx & 63;
      const uint2 v = *(const uint2*)(smem + col * 520 + u * 8);
      *(uint2*)(dstT + ((size_t)(b * nc + ncol0 + col)) * Lseg + t0 + u * 4) = v;
    }
    __syncthreads();
  }
}

__device__ __forceinline__ float ldbf(const u16* p, int t, int L) { return (t >= 0 && t < L) ? bf2f(p[t]) : 0.f; }
__device__ __forceinline__ void ld10(const u16* __restrict__ seq, int t0, float (&v)[10]) {
  const uint4 r = *(const uint4*)(seq + t0);
  v[0] = (t0 > 0) ? bf2f(seq[t0 - 1]) : 0.f;
  v[9] = (t0 + 8 < 4096) ? bf2f(seq[t0 + 8]) : 0.f;
  v[1] = bflo(r.x); v[2] = bfhi(r.x); v[3] = bflo(r.y); v[4] = bfhi(r.y);
  v[5] = bflo(r.z); v[6] = bfhi(r.z); v[7] = bflo(r.w); v[8] = bfhi(r.w);
}
__device__ __forceinline__ void hyena_fft_task(const P& p, int l, int c, int bp, char* smem) {
  c2* buf = (c2*)smem;
  c2* ub = (c2*)(smem + 65536);
  const int tid = opaque_tid();
  const float* sw = p.hy_short_w + l * 3 * 768;
  const float* sb = p.hy_short_b + l * 768;
  const float wx0[3] = {sw[c], sw[768 + c], sw[1536 + c]};
  const float wx1[3] = {sw[256 + c], sw[768 + 256 + c], sw[1536 + 256 + c]};
  const float wv[3] = {sw[512 + c], sw[768 + 512 + c], sw[1536 + 512 + c]};
  const float bx0 = sb[c], bx1 = sb[256 + c], bv = sb[512 + c];
  const float dsk = p.hy_bias[l * 256 + c];
  const int t0 = tid * 8;
  {
    float u[2][8];
#pragma unroll
    for (int bb = 0; bb < 2; ++bb) {
      const int b = 2 * bp + bb;
      float x1[10], vv[10];
      ld10(p.hyT + ((size_t)(b * 768 + 256 + c)) * 4096, t0, x1);
      ld10(p.hyT + ((size_t)(b * 768 + 512 + c)) * 4096, t0, vv);
#pragma unroll
      for (int k = 0; k < 8; ++k) {
        const float x1c = bx1 + wx1[0] * x1[k] + wx1[1] * x1[k + 1] + wx1[2] * x1[k + 2];
        const float vc = bv + wv[0] * vv[k] + wv[1] * vv[k + 1] + wv[2] * vv[k + 2];
        u[bb][k] = vc * x1c;
      }
    }
#pragma unroll
    for (int k = 0; k < 8; k += 2) {
      const float4 w = make_float4(u[0][k], u[1][k], u[0][k + 1], u[1][k + 1]);
      *(float4*)(buf + t0 + k) = w;
      *(float4*)(ub + t0 + k) = w;
      *(float4*)(buf + 4096 + t0 + k) = make_float4(0.f, 0.f, 0.f, 0.f);
    }
  }
  __syncthreads();
  fft8192(buf, -1.f);
  const c2* kf = (const c2*)p.Kf + ((size_t)l * 256 + c) * 8192;
  for (int i = 0; i < 16; ++i) {
    const int k = tid + NTHR * i;
    buf[k] = cmul(buf[k], kf[k]);
  }
  __syncthreads();
  fft8192(buf, 1.f);
#pragma unroll
  for (int bb = 0; bb < 2; ++bb) {
    const int b = 2 * bp + bb;
    float x0[10];
    ld10(p.hyT + ((size_t)(b * 768 + c)) * 4096, t0, x0);
    float o[8];
#pragma unroll
    for (int k = 0; k < 8; ++k) {
      const c2 y = buf[t0 + k];
      const c2 uu = ub[t0 + k];
      const float x0c = bx0 + wx0[0] * x0[k] + wx0[1] * x0[k + 1] + wx0[2] * x0[k + 2];
      const float yy = ldexpf(bb ? y.y : y.x, -13);
      const float uv = bb ? uu.y : uu.x;
      o[k] = x0c * (yy + uv * dsk);
    }
    uint4 w; w.x = pk2(o[0], o[1]); w.y = pk2(o[2], o[3]); w.z = pk2(o[4], o[5]); w.w = pk2(o[6], o[7]);
    *(uint4*)(p.ybT + ((size_t)(b * 256 + c)) * 4096 + t0) = w;
  }
  __syncthreads();
}
__device__ __forceinline__ void yb_transpose_task(const P& p, int b, int tb, char* smem) {
  const int tid = opaque_tid(), lane = tid & 63, wid = tid >> 6;
  u16* T = (u16*)smem;
#pragma unroll
  for (int it = 0; it < 4; ++it) {
    const int id = tid + NTHR * it;
    const int c = id >> 3, ch = id & 7;
    const uint4 r = *(const uint4*)(p.ybT + ((size_t)(b * 256 + c)) * 4096 + tb * 64 + ch * 8);
    unsigned* d = (unsigned*)(T + c * 66 + ch * 8);
    d[0] = r.x; d[1] = r.y; d[2] = r.z; d[3] = r.w;
  }
  __syncthreads();
#pragma unroll
  for (int it = 0; it < 8; ++it) {
    const int tt = wid + 8 * it;
    const int c0 = lane * 4;
    uint2 w;
    w.x = (unsigned)T[(c0 + 0) * 66 + tt] | ((unsigned)T[(c0 + 1) * 66 + tt] << 16);
    w.y = (unsigned)T[(c0 + 2) * 66 + tt] | ((unsigned)T[(c0 + 3) * 66 + tt] << 16);
    *(uint2*)(p.ycat + (size_t)(b * 4096 + tb * 64 + tt) * 1024 + 512 + c0) = w;
  }
  __syncthreads();
}
__device__ __forceinline__ void hyena_ctx_task(const P& p, int l, int b, int cg8, char* smem) {
  const int tid_ = opaque_tid(); const int lane = tid_ & 63, wid = tid_ >> 6;
  const int c = cg8 * 8 + wid;
  float* us = (float*)smem + wid * 1024;
  float* kfp = us + 256 + 255;
  const float* sw = p.hy_short_w + l * 3 * 768;
  const float* sb = p.hy_short_b + l * 768;
  const u16* x0 = p.hyTc + ((size_t)(b * 768 + c)) * 256;
  const u16* x1 = p.hyTc + ((size_t)(b * 768 + 256 + c)) * 256;
  const u16* vv = p.hyTc + ((size_t)(b * 768 + 512 + c)) * 256;
  for (int i = 0; i < 4; ++i) {
    const int t = lane + 64 * i;
    const float x1c = sb[256 + c] + sw[256 + c] * ldbf(x1, t - 1, 256) + sw[768 + 256 + c] * ldbf(x1, t, 256) + sw[1536 + 256 + c] * ldbf(x1, t + 1, 256);
    const float vc = sb[512 + c] + sw[512 + c] * ldbf(vv, t - 1, 256) + sw[768 + 512 + c] * ldbf(vv, t, 256) + sw[1536 + 512 + c] * ldbf(vv, t + 1, 256);
    us[t] = vc * x1c;
    kfp[t] = p.hc[(size_t)c * 256 + t];
    if (t > 0) kfp[-t] = p.hc[(size_t)(256 + c) * 256 + t];
  }
  __syncthreads();
  const float dsk = p.hy_bias[l * 256 + c];
  float acc[4] = {0.f, 0.f, 0.f, 0.f};
  for (int s = 0; s < 256; ++s) {
    const float uv = us[s];
#pragma unroll
    for (int i = 0; i < 4; ++i) acc[i] += kfp[lane + 64 * i - s] * uv;
  }
#pragma unroll
  for (int i = 0; i < 4; ++i) {
    const int t = lane + 64 * i;
    const float x0c = sb[c] + sw[c] * ldbf(x0, t - 1, 256) + sw[768 + c] * ldbf(x0, t, 256) + sw[1536 + c] * ldbf(x0, t + 1, 256);
    p.ycat[(size_t)(NLAT + b * 256 + t) * 1024 + 512 + c] = f2bf(x0c * (acc[i] + us[t] * dsk));
  }
  __syncthreads();
}

template <int DIR>
__device__ __forceinline__ void rg_scan32(const float (&Av)[2][16], const float (&Bv)[2][16], float (&carry)[2], float (&H)[2][16], int hh) {
#pragma unroll
  for (int nt = 0; nt < 2; ++nt) {
    float c = carry[nt];
#pragma unroll
    for (int go = 0; go < 8; ++go) {
      const int g = DIR ? 7 - go : go, q = g >> 1, own = g & 1;
      float h = c;
#pragma unroll
      for (int io = 0; io < 4; ++io) {
        const int e = 4 * q + (DIR ? 3 - io : io);
        h = Av[nt][e] * h + Bv[nt][e];
        H[nt][e] = (hh == own) ? h : H[nt][e];
      }
      const float mine = (hh == own) ? h : c;
      const float other = shx(mine, 32);
      c = (hh == own) ? mine : other;
    }
    carry[nt] = c;
  }
}
__device__ __forceinline__ void rg_wave_task(const P& p, int l, int bq, int nblk, int mode, bool last, char* smem) {
  const int tid = opaque_tid(), lane = tid & 63, wid = tid >> 6;
  const int l31 = lane & 31, hh = lane >> 5;
  const int b = bq / 34, rr = bq - b * 34;
  const int seg = rr < 2 ? 0 : 1, blk = rr < 2 ? rr : rr - 2;
  if (mode == 1 && seg == 0 && last) return;
  const int ck = wid >> 1, dir = wid & 1;
  char* wreg = smem + wid * 17408;
  u16* xs = (u16*)wreg;
  char* xcb = wreg + 4608;
  float* xcf = (float*)(wreg + 8704);
  float2* blockagg = (float2*)(smem + 139264);
  const int Lseg = seg ? 4096 : 256;
  const int tokbase = seg ? b * 4096 : NLAT + b * 256;
  const int T0 = blk * 128 + ck * 32;
  const int cg32 = (seg ? 8 : 0) + blk * 4 + ck;
  bf16x8 wf[2][2][4];
#pragma unroll
  for (int gate = 0; gate < 2; ++gate) {
    const u16* wp = p.rgW + (size_t)(((l * 2 + gate) * 2 + dir) * 4 + nblk) * 4096 + l31 * 64 + 8 * hh;
#pragma unroll
    for (int nt = 0; nt < 2; ++nt)
#pragma unroll
      for (int s = 0; s < 4; ++s) wf[gate][nt][s] = *(const bf16x8*)(wp + nt * 2048 + 16 * s);
  }
  float cba[2], cbx[2], csp[2];
#pragma unroll
  for (int nt = 0; nt < 2; ++nt) {
    const int ch = (l * 2 + dir) * 256 + nblk * 64 + nt * 32 + l31;
    cba[nt] = p.rg_ba[ch];
    cbx[nt] = p.rg_bx[ch];
    csp[nt] = __logf(1.0f + __expf(-p.rg_lambda[ch]));
  }
#pragma unroll
  for (int i = 0; i < 5; ++i) {
    const int idx = lane + 64 * i;
    const int row = idx >> 3, chunk = idx & 7;
    if (row < 35) {
      const int pos = T0 - 2 + row;
      uint4 v = make_uint4(0u, 0u, 0u, 0u);
      if (pos >= 0 && pos < Lseg) v = *(const uint4*)(p.rg + (size_t)(tokbase + pos) * 512 + nblk * 64 + chunk * 8);
      *(uint4*)(xs + row * 64 + chunk * 8) = v;
    }
  }
  asm volatile("s_waitcnt lgkmcnt(0)" ::: "memory");
  {
    const int ch = l * 256 + nblk * 64 + lane;
    const float w0 = p.rg_conv_w[(l * 4 + 0) * 256 + nblk * 64 + lane], w1 = p.rg_conv_w[(l * 4 + 1) * 256 + nblk * 64 + lane];
    const float w2 = p.rg_conv_w[(l * 4 + 2) * 256 + nblk * 64 + lane], w3 = p.rg_conv_w[(l * 4 + 3) * 256 + nblk * 64 + lane];
    const float cb = p.rg_conv_b[ch];
    float x0 = bf2f(xs[0 * 64 + lane]), x1 = bf2f(xs[1 * 64 + lane]), x2 = bf2f(xs[2 * 64 + lane]);
#pragma unroll
    for (int t = 0; t < 32; ++t) {
      const float x3 = bf2f(xs[(t + 3) * 64 + lane]);
      const float xc = cb + w0 * x0 + w1 * x1 + w2 * x2 + w3 * x3;
      xcf[t * 68 + lane] = xc;
      *(u16*)(xcb + swz128(t, lane >> 3) + (lane & 7) * 2) = f2bf(xc);
      x0 = x1; x1 = x2; x2 = x3;
    }
  }
  asm volatile("s_waitcnt lgkmcnt(0)" ::: "memory");
  float Av[2][16], Bv[2][16];
  {
    f32x16 acc[2][2];
#pragma unroll
    for (int gate = 0; gate < 2; ++gate)
#pragma unroll
      for (int nt = 0; nt < 2; ++nt) acc[gate][nt] = zero16();
#pragma unroll
    for (int s = 0; s < 4; ++s) {
      const bf16x8 af = *(const bf16x8*)(xcb + swz128(l31, 2 * s + hh));
#pragma unroll
      for (int gate = 0; gate < 2; ++gate)
#pragma unroll
        for (int nt = 0; nt < 2; ++nt) acc[gate][nt] = mfma32(af, wf[gate][nt][s], acc[gate][nt]);
    }
#pragma unroll
    for (int nt = 0; nt < 2; ++nt)
#pragma unroll
      for (int e = 0; e < 16; ++e) {
        const int tok = (e & 3) + 8 * (e >> 2) + 4 * hh;
        const float r = sigmoidf_(acc[0][nt][e] + cba[nt]);
        const float ii = sigmoidf_(acc[1][nt][e] + cbx[nt]);
        const float la = -8.0f * r * csp[nt];
        const float av = __expf(la);
        const float e2 = 2.0f * la;
        const float om = (e2 > -0.1f) ? (-e2 * (1.0f + e2 * (0.5f + e2 * (0.16666667f + e2 * 0.041666668f)))) : (1.0f - __expf(e2));
        Av[nt][e] = av;
        Bv[nt][e] = sqrtf(om) * ii * xcf[tok * 68 + nt * 32 + l31];
      }
  }
  float H[2][16];
#pragma unroll
  for (int nt = 0; nt < 2; ++nt)
#pragma unroll
    for (int e = 0; e < 16; ++e) H[nt][e] = 0.f;
  float carry[2] = {0.f, 0.f};
  float2* agg1 = (float2*)p.agg;
  float2* agg2 = (float2*)p.agg + (size_t)8 * 2 * 136 * 256;
  const int pos2 = dir ? (seg == 0 ? 1 - blk : 33 - blk) : (seg == 0 ? blk : 2 + blk);
  if (mode == 0) {
    if (dir) rg_scan32<1>(Av, Bv, carry, H, hh); else rg_scan32<0>(Av, Bv, carry, H, hh);
    float P[2];
#pragma unroll
    for (int nt = 0; nt < 2; ++nt) {
      float pr = 1.f;
#pragma unroll
      for (int e = 0; e < 16; ++e) pr *= Av[nt][e];
      P[nt] = pr * shx(pr, 32);
    }
    const float2 mine = make_float2(hh ? P[1] : P[0], hh ? carry[1] : carry[0]);
    agg1[((size_t)(b * 2 + dir) * 136 + cg32) * 256 + nblk * 64 + lane] = mine;
    blockagg[(ck * 2 + dir) * 64 + lane] = mine;
    __syncthreads();
    if (wid < 2) {
      const int d2 = wid;
      float A = 1.f, B = 0.f;
#pragma unroll
      for (int co = 0; co < 4; ++co) {
        const int c = d2 ? 3 - co : co;
        const float2 g = blockagg[(c * 2 + d2) * 64 + lane];
        B = g.x * B + g.y;
        A *= g.x;
      }
      const int p2 = d2 ? (seg == 0 ? 1 - blk : 33 - blk) : (seg == 0 ? blk : 2 + blk);
      agg2[((size_t)(b * 2 + d2) * 34 + p2) * 256 + nblk * 64 + lane] = make_float2(A, B);
    }
    __syncthreads();
    return;
  }
  {
    float h = 0.f;
    const float2* a2 = agg2 + ((size_t)(b * 2 + dir) * 34) * 256 + nblk * 64 + lane;
    int j = 0;
    for (; j + 8 <= pos2; j += 8) {
      float2 g[8];
#pragma unroll
      for (int u = 0; u < 8; ++u) g[u] = a2[(size_t)(j + u) * 256];
#pragma unroll
      for (int u = 0; u < 8; ++u) h = g[u].x * h + g[u].y;
    }
    for (; j < pos2; ++j) { const float2 g = a2[(size_t)j * 256]; h = g.x * h + g.y; }
    const float2* a1 = agg1 + ((size_t)(b * 2 + dir) * 136 + (cg32 - ck)) * 256 + nblk * 64 + lane;
    const int npre = dir ? 3 - ck : ck;
    for (int i = 0; i < npre; ++i) {
      const int c = dir ? 3 - i : i;
      const float2 g = a1[(size_t)c * 256];
      h = g.x * h + g.y;
    }
    carry[0] = shf(h, l31);
    carry[1] = shf(h, 32 + l31);
  }
  if (dir) rg_scan32<1>(Av, Bv, carry, H, hh); else rg_scan32<0>(Av, Bv, carry, H, hh);
  asm volatile("s_waitcnt lgkmcnt(0)" ::: "memory");
#pragma unroll
  for (int nt = 0; nt < 2; ++nt)
#pragma unroll
    for (int e = 0; e < 16; ++e) xcf[((e & 3) + 8 * (e >> 2) + 4 * hh) * 68 + nt * 32 + l31] = H[nt][e];
  __syncthreads();
  {
    const float* hfT = (const float*)(smem + (ck * 2 + 0) * 17408 + 8704);
    const float* hbT = (const float*)(smem + (ck * 2 + 1) * 17408 + 8704);
    const int tok = 16 * dir + (lane >> 2), c16 = (lane & 3) * 16;
    const size_t gtok = (size_t)tokbase + T0 + tok;
    const u16* gp = p.rg + gtok * 512 + 256 + nblk * 64 + c16;
    u16* op = p.ycat + gtok * 1024 + 768 + nblk * 64 + c16;
#pragma unroll
    for (int hv = 0; hv < 2; ++hv) {
      const uint4 g = *(const uint4*)(gp + hv * 8);
      const float4 f0 = *(const float4*)(hfT + tok * 68 + c16 + hv * 8), f1 = *(const float4*)(hfT + tok * 68 + c16 + hv * 8 + 4);
      const float4 h0 = *(const float4*)(hbT + tok * 68 + c16 + hv * 8), h1 = *(const float4*)(hbT + tok * 68 + c16 + hv * 8 + 4);
      uint4 o;
      o.x = pk2((f0.x + h0.x) * gelu_tanh(bflo(g.x)), (f0.y + h0.y) * gelu_tanh(bfhi(g.x)));
      o.y = pk2((f0.z + h0.z) * gelu_tanh(bflo(g.y)), (f0.w + h0.w) * gelu_tanh(bfhi(g.y)));
      o.z = pk2((f1.x + h1.x) * gelu_tanh(bflo(g.z)), (f1.y + h1.y) * gelu_tanh(bfhi(g.z)));
      o.w = pk2((f1.z + h1.z) * gelu_tanh(bflo(g.w)), (f1.w + h1.w) * gelu_tanh(bfhi(g.w)));
      *(uint4*)(op + hv * 8) = o;
    }
  }
  __syncthreads();
}

__device__ __forceinline__ void attn_wave(const P& p, int l, int b, int h, bool local, int r, int half, int qtok0, const float* rpbL) {
  const int lane = opaque_tid() & 63, q = lane & 31, hh = lane >> 5;
  bf16x8 qf[4];
  {
    const u16* qp = p.qk + (size_t)(qtok0 + q) * 1024 + h * 64 + 8 * hh;
#pragma unroll
    for (int s = 0; s < 4; ++s) qf[s] = *(const bf16x8*)(qp + 16 * s);
  }
  f32x16 o0 = zero16(), o1 = zero16();
  float m_run = -1e30f, l_run = 0.f;
  const int pi = (q & 19) | ((q & 4) << 1) | ((q & 8) >> 1);
  const int w = half * 32 + q;
  const int st = min(max(w - 8, 0), 48);
  const int rs = min(max(r - 4, 0), 56);
  const int ntiles = local ? 24 : 8;
  bf16x8 kfn[4], vfn[2][2];
  auto tile_load = [&](int ti, bf16x8 (&kfo)[4], bf16x8 (&vfo)[2][2]) {
    int ktok0, vstride;
    const u16* vb;
    if (ti < 8) {
      ktok0 = NLAT + b * 256 + ti * 32;
      vb = p.vTc + ((size_t)(b * 512 + h * 64)) * 256 + ti * 32;
      vstride = 256;
    } else {
      const int tl = ti - 8;
      const int a2 = tl >> 1, g2 = tl & 1;
      ktok0 = b * 4096 + (rs + a2) * 64 + g2 * 32;
      vb = p.vT + ((size_t)(b * 512 + h * 64)) * 4096 + (rs + a2) * 64 + g2 * 32;
      vstride = 4096;
    }
    const u16* kp = p.qk + (size_t)(ktok0 + pi) * 1024 + 512 + h * 64 + 8 * hh;
#pragma unroll
    for (int s = 0; s < 4; ++s) kfo[s] = *(const bf16x8*)(kp + 16 * s);
#pragma unroll
    for (int dt = 0; dt < 2; ++dt)
#pragma unroll
      for (int s2 = 0; s2 < 2; ++s2) vfo[dt][s2] = *(const bf16x8*)(vb + (size_t)(dt * 32 + q) * vstride + 16 * s2 + 8 * hh);
  };
  tile_load(0, kfn, vfn);
  for (int ti = 0; ti < ntiles; ++ti) {
    int a = 0, g = 0;
    if (ti >= 8) { a = (ti - 8) >> 1; g = (ti - 8) & 1; }
    bf16x8 kf[4], vf[2][2];
#pragma unroll
    for (int s = 0; s < 4; ++s) kf[s] = kfn[s];
#pragma unroll
    for (int dt = 0; dt < 2; ++dt)
#pragma unroll
      for (int s2 = 0; s2 < 2; ++s2) vf[dt][s2] = vfn[dt][s2];
    if (ti + 1 < ntiles) tile_load(ti + 1, kfn, vfn);
    f32x16 sacc = zero16();
#pragma unroll
    for (int s = 0; s < 4; ++s) sacc = mfma32(kf[s], qf[s], sacc);
    float sv[16];
    float tmax = -1e30f;
#pragma unroll
    for (int e = 0; e < 16; ++e) {
      float x = sacc[e] * 0.125f;
      if (ti >= 8) {
        const int kc = g * 32 + (e & 7) + 8 * hh + 16 * (e >> 3);
        const bool valid = (kc >= st) && (kc < st + 16);
        const int bi = valid ? ((rs + a - r + 7) * 31 + (kc - w + 15)) : 0;
        const float bias = rpbL[bi];
        x = valid ? (x + bias) : -1e30f;
      }
      sv[e] = x;
      tmax = fmaxf(tmax, x);
    }
    tmax = fmaxf(tmax, shx(tmax, 32));
    const float m_new = fmaxf(m_run, tmax);
    const float alpha = __expf(m_run - m_new);
    m_run = m_new;
    l_run *= alpha;
#pragma unroll
    for (int e = 0; e < 16; ++e) { o0[e] *= alpha; o1[e] *= alpha; }
    float psum = 0.f;
#pragma unroll
    for (int e = 0; e < 16; ++e) { const float pe = __expf(sv[e] - m_new); sv[e] = pe; psum += pe; }
    l_run += psum;
    bf16x8 pf[2];
#pragma unroll
    for (int s2 = 0; s2 < 2; ++s2) {
      union { bf16x8 v; unsigned u[4]; } cv;
#pragma unroll
      for (int j = 0; j < 4; ++j) cv.u[j] = pk2(sv[8 * s2 + 2 * j], sv[8 * s2 + 2 * j + 1]);
      pf[s2] = cv.v;
    }
#pragma unroll
    for (int s2 = 0; s2 < 2; ++s2) {
      o0 = mfma32(vf[0][s2], pf[s2], o0);
      o1 = mfma32(vf[1][s2], pf[s2], o1);
    }
  }
  const float lt = l_run + shx(l_run, 32);
  const float inv = 1.0f / lt;
  u16* op = p.ycat + (size_t)(qtok0 + q) * 1024 + h * 64;
#pragma unroll
  for (int qd = 0; qd < 4; ++qd) {
    uint2 a0, a1;
    a0.x = pk2(o0[4 * qd] * inv, o0[4 * qd + 1] * inv);
    a0.y = pk2(o0[4 * qd + 2] * inv, o0[4 * qd + 3] * inv);
    a1.x = pk2(o1[4 * qd] * inv, o1[4 * qd + 1] * inv);
    a1.y = pk2(o1[4 * qd + 2] * inv, o1[4 * qd + 3] * inv);
    *(uint2*)(op + 8 * qd + 4 * hh) = a0;
    *(uint2*)(op + 32 + 8 * qd + 4 * hh) = a1;
  }
}
__device__ __forceinline__ void attn_block_task(const P& p, int l, int b, int h, int rg4, char* smem) {
  const int tid = opaque_tid(), lane = tid & 63, wid = tid >> 6;
  const int q = lane & 31, hh = lane >> 5;
  const int R0 = rg4 * 4;
  const int r = R0 + (wid >> 1), half = wid & 1;
  float* rpbL = (float*)(smem + 32768) + 64;
  for (int i = tid; i < 465; i += NTHR) rpbL[i] = p.na_rpb[(size_t)(l * 8 + h) * 465 + i] * 1.4426950408889634f;
  const int lo = min(max(R0 - 4, 0), 56);
  const int hi = min(max(R0 + 3 - 4, 0), 56) + 7;
  const int ntile = 4 + (hi - lo + 1);
  const int rs = min(max(r - 4, 0), 56);
  const int qtok = b * 4096 + r * 64 + half * 32 + q;
  bf16x8 qf[4];
  {
    const u16* qp = p.qk + (size_t)qtok * 1024 + h * 64 + 8 * hh;
#pragma unroll
    for (int s = 0; s < 4; ++s) qf[s] = *(const bf16x8*)(qp + 16 * s);
  }
  f32x16 o0 = zero16(), o1 = zero16();
  float m_run = -1e30f, l_run = 0.f;
  const int pi = (q & 19) | ((q & 4) << 1) | ((q & 8) >> 1);
  const int w = half * 32 + q;
  const int st = min(max(w - 8, 0), 48);
  unsigned vmask = 0u;
#pragma unroll
  for (int g = 0; g < 2; ++g)
#pragma unroll
    for (int e = 0; e < 16; ++e) {
      const int kc = g * 32 + (e & 7) + 8 * hh + 16 * (e >> 3);
      vmask |= ((kc >= st) && (kc < st + 16)) ? (1u << (g * 16 + e)) : 0u;
    }
  const int cbase = 8 * hh - w + 15;
  const int srow = tid >> 3, sch = tid & 7;
  uint4 rkA, rvA, rkB, rvB;
  auto gload = [&](int ti, uint4& rk, uint4& rv) {
    int ktok0, vstride;
    const u16* vb;
    if (ti < 4) { ktok0 = NLAT + b * 256 + ti * 64; vb = p.vTc + ((size_t)(b * 512 + h * 64)) * 256 + ti * 64; vstride = 256; }
    else { const int R = lo + ti - 4; ktok0 = b * 4096 + R * 64; vb = p.vT + ((size_t)(b * 512 + h * 64)) * 4096 + R * 64; vstride = 4096; }
    rk = *(const uint4*)(p.qk + (size_t)(ktok0 + srow) * 1024 + 512 + h * 64 + sch * 8);
    rv = *(const uint4*)(vb + (size_t)srow * vstride + sch * 8);
  };
  gload(0, rkA, rvA);
  *(uint4*)(smem + swz128(srow, sch)) = rkA;
  *(uint4*)(smem + 16384 + swz128(srow, sch)) = rvA;
  gload(1, rkA, rvA);
  if (2 < ntile) gload(2, rkB, rvB);
  __syncthreads();
  auto compute = [&](int ti) {
    const char* Kb = smem + (ti & 1) * 8192;
    const char* Vb = smem + 16384 + (ti & 1) * 8192;
    const int R = lo + ti - 4;
    const bool active = (ti < 4) || (R >= rs && R < rs + 8);
    if (active) {
#pragma unroll
      for (int g = 0; g < 2; ++g) {
        f32x16 sacc = zero16();
#pragma unroll
        for (int s = 0; s < 4; ++s) {
          const bf16x8 kf = *(const bf16x8*)(Kb + swz128(g * 32 + pi, 2 * s + hh));
          sacc = mfma32(kf, qf[s], sacc);
        }
        float sv[16];
        float tmax = -1e30f;
        if (ti >= 4) {
          const float* brow = rpbL + (R - r + 7) * 31 + cbase + g * 32;
          float bias[16];
#pragma unroll
          for (int e = 0; e < 16; ++e) bias[e] = brow[(e & 7) + 16 * (e >> 3)];
#pragma unroll
          for (int e = 0; e < 16; ++e) {
            const float x = ((int)(vmask << (31 - (g * 16 + e))) < 0) ? fmaf(sacc[e], 0.18033688011112042f, bias[e]) : -1e30f;
            sv[e] = x;
            tmax = fmaxf(tmax, x);
          }
        } else {
#pragma unroll
          for (int e = 0; e < 16; ++e) {
            const float x = sacc[e] * 0.18033688011112042f;
            sv[e] = x;
            tmax = fmaxf(tmax, x);
          }
        }
        tmax = fmaxf(tmax, shx(tmax, 32));
        if (__builtin_amdgcn_ballot_w64(tmax > m_run) != 0ull) {
          const float m_new = fmaxf(m_run, tmax);
          const float alpha = __builtin_amdgcn_exp2f(m_run - m_new);
          m_run = m_new;
          l_run *= alpha;
#pragma unroll
          for (int e = 0; e < 16; ++e) { o0[e] *= alpha; o1[e] *= alpha; }
        }
        float psum = 0.f;
#pragma unroll
        for (int e = 0; e < 16; ++e) { const float pe = __builtin_amdgcn_exp2f(sv[e] - m_run); sv[e] = pe; psum += pe; }
        l_run += psum;
#pragma unroll
        for (int s2 = 0; s2 < 2; ++s2) {
          union { bf16x8 v; unsigned u[4]; } cv;
#pragma unroll
          for (int j = 0; j < 4; ++j) cv.u[j] = pk2(sv[8 * s2 + 2 * j], sv[8 * s2 + 2 * j + 1]);
          const bf16x8 v0 = *(const bf16x8*)(Vb + swz128(q, g * 4 + 2 * s2 + hh));
          const bf16x8 v1 = *(const bf16x8*)(Vb + swz128(32 + q, g * 4 + 2 * s2 + hh));
          o0 = mfma32(v0, cv.v, o0);
          o1 = mfma32(v1, cv.v, o1);
        }
      }
    }
  };
  for (int ti = 0; ti < ntile; ti += 2) {
    compute(ti);
    if (ti + 1 < ntile) {
      *(uint4*)(smem + 8192 + swz128(srow, sch)) = rkA;
      *(uint4*)(smem + 16384 + 8192 + swz128(srow, sch)) = rvA;
      if (ti + 3 < ntile) gload(ti + 3, rkA, rvA);
    }
    __syncthreads();
    if (ti + 1 < ntile) {
      compute(ti + 1);
      if (ti + 2 < ntile) {
        *(uint4*)(smem + swz128(srow, sch)) = rkB;
        *(uint4*)(smem + 16384 + swz128(srow, sch)) = rvB;
        if (ti + 4 < ntile) gload(ti + 4, rkB, rvB);
      }
      __syncthreads();
    }
  }
  const float lt = l_run + shx(l_run, 32);
  const float inv = 1.0f / lt;
  u16* op = p.ycat + (size_t)qtok * 1024 + h * 64;
#pragma unroll
  for (int qd = 0; qd < 4; ++qd) {
    uint2 a0, a1;
    a0.x = pk2(o0[4 * qd] * inv, o0[4 * qd + 1] * inv);
    a0.y = pk2(o0[4 * qd + 2] * inv, o0[4 * qd + 3] * inv);
    a1.x = pk2(o1[4 * qd] * inv, o1[4 * qd + 1] * inv);
    a1.y = pk2(o1[4 * qd + 2] * inv, o1[4 * qd + 3] * inv);
    *(uint2*)(op + 8 * qd + 4 * hh) = a0;
    *(uint2*)(op + 32 + 8 * qd + 4 * hh) = a1;
  }
}
__device__ __forceinline__ void attn_task(const P& p, int l, int kind, int idx, char* smem) {
  const int tid_ = opaque_tid(); const int lane = tid_ & 63, wid = tid_ >> 6;
  float* rpbL = (float*)smem + wid * 480;
  for (int i = lane; i < 465; i += 64) rpbL[i] = p.na_rpb[(size_t)(l * 8 + wid) * 465 + i];
  __syncthreads();
  if (kind == 0) {
    const int half = idx & 1, r = (idx >> 1) & 63, b = idx >> 7;
    attn_wave(p, l, b, wid, true, r, half, b * 4096 + r * 64 + half * 32, rpbL);
  } else {
    const int qg = idx & 7, b = idx >> 3;
    attn_wave(p, l, b, wid, false, 0, 0, NLAT + b * 256 + qg * 32, rpbL);
  }
  __syncthreads();
}

__device__ __forceinline__ void phase_mixers(const P& p, int l, char* smem, unsigned* counter) {
  const bool last = (l == 1);
  const int n_rg = 1088 * XRGA, n_fft = 1024 * XFFT, n_hc = last ? 0 : 256, n_att = 1024 * XATT, n_attc = last ? 0 : 64;
  const int total = n_rg + n_fft + n_hc + n_att + n_attc;
  volatile int* s_taskp = (volatile int*)(smem + SMEM_BYTES - 16);
  for (;;) {
    __syncthreads();
    if (threadIdx.x == 0) *s_taskp = (int)atomicAdd(counter, 1u);
    __syncthreads();
    int t = *s_taskp;
    if (t >= total) break;
    if (t < n_att) { t &= 1023; attn_block_task(p, l, t >> 7, (t >> 4) & 7, t & 15, smem); continue; }
    t -= n_att;
    if (t < n_attc) { attn_task(p, l, 1, t, smem); continue; }
    t -= n_attc;
    if (t < n_fft) { t &= 1023; hyena_fft_task(p, l, t >> 2, t & 3, smem); continue; }
    t -= n_fft;
    if (t < n_hc) { hyena_ctx_task(p, l, t >> 5, t & 31, smem); continue; }
    t -= n_hc;
    if (t >= 1088) t -= 1088;
    rg_wave_task(p, l, t >> 2, t & 3, 0, last, smem);
  }
}

__device__ __forceinline__ void merge_tile(const P& p, int l, int mt, int nt, char* smem) {
  EPI_VARS
  const int m0 = mt * 256, n0 = nt * 128;
  f32x16 macc[2][2];
  zero_acc(macc);
  for (int br = 0; br < 3; ++br) {
    unsigned* gpl = (unsigned*)(smem + 98304) + tid;
    {
      f32x16 acc[2][2];
      zero_acc(acc);
      gemm_kloop(acc, p.xn + (size_t)m0 * 1024, 1024, p.WgT + ((size_t)l * 3072 + br * 1024 + n0) * 1024, 1024, 1024, smem);
#pragma unroll
      for (int j = 0; j < 2; ++j) {
        const float bg = p.b_gate[l * 3072 + br * 1024 + n0 + EPI_COL(j)];
#pragma unroll
        for (int i = 0; i < 2; ++i)
#pragma unroll
          for (int e = 0; e < 4; ++e) {
            const unsigned q0 = (unsigned)(sigmoidf_(acc[i][j][4 * e] + bg) * 255.0f + 0.5f);
            const unsigned q1 = (unsigned)(sigmoidf_(acc[i][j][4 * e + 1] + bg) * 255.0f + 0.5f);
            const unsigned q2 = (unsigned)(sigmoidf_(acc[i][j][4 * e + 2] + bg) * 255.0f + 0.5f);
            const unsigned q3 = (unsigned)(sigmoidf_(acc[i][j][4 * e + 3] + bg) * 255.0f + 0.5f);
            gpl[((i * 2 + j) * 4 + e) * 512] = q0 | (q1 << 8) | (q2 << 16) | (q3 << 24);
          }
      }
    }
    {
      f32x16 acc[2][2];
      zero_acc(acc);
      const u16* A; const u16* B; int K;
      if (br == 0) { A = p.ycat + (size_t)m0 * 1024; B = p.WaT + ((size_t)l * 1024 + n0) * 512; K = 512; }
      else if (br == 1) { A = p.ycat + (size_t)m0 * 1024 + 512; B = p.WbT + ((size_t)l * 1024 + n0) * 256; K = 256; }
      else { A = p.ycat + (size_t)m0 * 1024 + 768; B = p.WcT + ((size_t)l * 1024 + n0) * 256; K = 256; }
      gemm_kloop(acc, A, 1024, B, K, K, smem);
#pragma unroll
      for (int i = 0; i < 2; ++i)
#pragma unroll
        for (int j = 0; j < 2; ++j)
#pragma unroll
          for (int e = 0; e < 4; ++e) {
            const unsigned g4 = gpl[((i * 2 + j) * 4 + e) * 512];
            macc[i][j][4 * e] += (float)(g4 & 255u) * (1.0f / 255.0f) * acc[i][j][4 * e];
            macc[i][j][4 * e + 1] += (float)((g4 >> 8) & 255u) * (1.0f / 255.0f) * acc[i][j][4 * e + 1];
            macc[i][j][4 * e + 2] += (float)((g4 >> 16) & 255u) * (1.0f / 255.0f) * acc[i][j][4 * e + 2];
            macc[i][j][4 * e + 3] += (float)(g4 >> 24) * (1.0f / 255.0f) * acc[i][j][4 * e + 3];
          }
    }
  }
#pragma unroll
  for (int i = 0; i < 2; ++i)
#pragma unroll
    for (int j = 0; j < 2; ++j)
#pragma unroll
      for (int e = 0; e < 16; ++e)
        p.mbuf[(size_t)(m0 + EPI_ROW(i, e)) * 1024 + n0 + EPI_COL(j)] = f2bf(macc[i][j][e]);
}
__device__ __forceinline__ void outproj_tile(const P& p, int l, int mt, int nt, char* smem, bool do_store) {
  EPI_VARS
  const int m0 = mt * 256, n0 = nt * 128;
  f32x16 acc[2][2];
  zero_acc(acc);
  gemm_kloop(acc, p.mbuf + (size_t)m0 * 1024, 1024, p.WoT + ((size_t)l * 1024 + n0) * 1024, 1024, 1024, smem);
  const bool isctx = (mt >= 128);
  const int bi = isctx ? 8 : (mt >> 4);
  const float* gatev = p.mod + ((size_t)(l * 9 + bi) * 6 + 2) * 1024;
  const float* src; float* dst;
  if (isctx) { src = (l == 0 ? p.ctx : p.ctxs) - (size_t)NLAT * 1024; dst = p.ctxs - (size_t)NLAT * 1024; }
  else { src = (l == 0 ? p.x : p.out); dst = p.out; }
#pragma unroll
  for (int j = 0; j < 2; ++j) {
    const int col = n0 + EPI_COL(j);
    const float gv = gatev[col];
#pragma unroll
    for (int i = 0; i < 2; ++i)
#pragma unroll
      for (int e = 0; e < 16; ++e) {
        const size_t o = (size_t)(m0 + EPI_ROW(i, e)) * 1024 + col;
        if (do_store) dst[o] = src[o] + gv * acc[i][j][e];
      }
  }
}

__device__ __forceinline__ void wqk_task(const P& p, int l, int hp, int nt, char* smem) {
  EPI_VARS
  f32x16 acc[2][2];
  zero_acc(acc);
  gemm_kloop(acc, p.keysB + ((size_t)l * 16 + hp) * 16384, 128, p.WqB + (size_t)l * 1024 * 2048 + (size_t)(nt * 128) * 2048 + hp * 128, 2048, 128, smem);
  if (wm < 2) {
#pragma unroll
    for (int i = 0; i < 2; ++i)
#pragma unroll
      for (int j = 0; j < 2; ++j)
#pragma unroll
        for (int e = 0; e < 16; ++e)
          p.WqkT[((size_t)l * 2048 + hp * 128 + EPI_ROW(i, e)) * 1024 + nt * 128 + EPI_COL(j)] = f2bf(acc[i][j][e]);
  }
}
__device__ __forceinline__ void ins16(unsigned (&L)[16], unsigned x) {
#pragma unroll
  for (int i = 0; i < 16; ++i) {
    const unsigned hi = max(L[i], x);
    x = min(L[i], x);
    L[i] = hi;
  }
}
__device__ __forceinline__ unsigned f2sort(float f) {
  const unsigned b = __float_as_uint(f);
  return b ^ ((unsigned)((int)b >> 31) | 0x80000000u);
}
__device__ __forceinline__ float sort2f(unsigned k) {
  const unsigned u = k & ~127u;
  const unsigned b = (u & 0x80000000u) ? (u ^ 0x80000000u) : ~u;
  return __uint_as_float(b);
}
__device__ __forceinline__ void peer_score_tile(const P& p, int l, int mt, int hp, char* smem) {
  const int tid = opaque_tid();
  const int m0 = mt * 256;
  unsigned L[16];
#pragma unroll
  for (int i = 0; i < 16; ++i) L[i] = 0u;
  const int row = tid >> 1, hf = tid & 1;
  const unsigned* sp = (const unsigned*)(p.q + (size_t)(m0 + row) * 2048 + hp * 128 + hf * 64);
#pragma unroll
  for (int c = 0; c < 8; ++c) {
    const uint4 r = *(const uint4*)(sp + 4 * c);
    const unsigned w[4] = {r.x, r.y, r.z, r.w};
#pragma unroll
    for (int k = 0; k < 4; ++k) {
      const float v0 = __builtin_bit_cast(_Float16, (unsigned short)(w[k] & 0xffffu));
      const float v1 = __builtin_bit_cast(_Float16, (unsigned short)(w[k] >> 16));
      const int key = hf * 64 + c * 8 + k * 2;
      ins16(L, (f2sort(v0) & ~127u) | (unsigned)key);
      ins16(L, (f2sort(v1) & ~127u) | (unsigned)(key + 1));
    }
  }
  unsigned* X = (unsigned*)smem;
  if (hf) {
#pragma unroll
    for (int i = 0; i < 16; ++i) X[row * 16 + i] = L[i];
  }
  __syncthreads();
  if (!hf) {
#pragma unroll
    for (int i = 0; i < 16; ++i) ins16(L, X[row * 16 + i]);
    unsigned* o = p.topk + ((size_t)(m0 + row) * 16 + hp) * 16;
#pragma unroll
    for (int i = 0; i < 4; ++i) *(uint4*)(o + 4 * i) = make_uint4(L[4 * i], L[4 * i + 1], L[4 * i + 2], L[4 * i + 3]);
  }
  __syncthreads();
}

__device__ __forceinline__ void phase_peer_experts(const P& p, int l, bool do_store, char* smem) {
  const int tid_ = opaque_tid(); const int lane = tid_ & 63, wid = tid_ >> 6;
  const int ntok = (l == 1) ? NLAT : NTOK;
  int ci, cj;
  {
    const int e = lane;
    if (e < 16) { ci = 0; cj = e; }
    else if (e < 24) { ci = 1; cj = e - 16; }
    else if (e < 29) { ci = 2; cj = e - 24; }
    else if (e < 33) { ci = 3; cj = e - 29; }
    else if (e < 36) { ci = 4; cj = e - 33; }
    else if (e < 38) { ci = 5; cj = e - 36; }
    else if (e < 40) { ci = 6; cj = e - 38; }
    else if (e < 42) { ci = 7; cj = e - 40; }
    else { ci = min(8 + (e - 42), 15); cj = 0; }
  }
  for (int tok = blockIdx.x * 8 + wid; tok < ntok; tok += gridDim.x * 8) {
    float xr[16];
    {
      const uint4 a = *(const uint4*)(p.xn + (size_t)tok * 1024 + lane * 16);
      const uint4 b = *(const uint4*)(p.xn + (size_t)tok * 1024 + lane * 16 + 8);
      xr[0] = bflo(a.x); xr[1] = bfhi(a.x); xr[2] = bflo(a.y); xr[3] = bfhi(a.y);
      xr[4] = bflo(a.z); xr[5] = bfhi(a.z); xr[6] = bflo(a.w); xr[7] = bfhi(a.w);
      xr[8] = bflo(b.x); xr[9] = bfhi(b.x); xr[10] = bflo(b.y); xr[11] = bfhi(b.y);
      xr[12] = bflo(b.z); xr[13] = bfhi(b.z); xr[14] = bflo(b.w); xr[15] = bfhi(b.w);
    }
    float yacc[16];
#pragma unroll
    for (int i = 0; i < 16; ++i) yacc[i] = 0.f;
    int* selw = (int*)(smem + wid * 4096);
    const unsigned* kvp = p.topk + (size_t)tok * 256 + (lane & 31);
    unsigned kv_next = kvp[0];
#pragma unroll 1
    for (int h = 0; h < 8; ++h) {
      const unsigned kv = kv_next;
      if (h < 7) kv_next = kvp[(h + 1) * 32];
      const unsigned k0 = shu(kv, ci);
      const unsigned k1 = shu(kv, 16 + cj);
      const float val = (lane < 50) ? (sort2f(k0) + sort2f(k1)) : -3.0e38f;
      const int eidx = (int)((k0 & 127u) * 128u + (k1 & 127u));
      float sv = val; int si = eidx;
#pragma unroll
      for (int k = 2; k <= 64; k <<= 1) {
#pragma unroll
        for (int j = k >> 1; j >= 1; j >>= 1) {
          const float ov = __builtin_bit_cast(float, __builtin_amdgcn_ds_bpermute((lane ^ j) << 2, __builtin_bit_cast(int, sv)));
          const int oi = __builtin_amdgcn_ds_bpermute((lane ^ j) << 2, si);
          const bool take_max = (((lane & j) == 0) == ((lane & k) == 0));
          const bool sw = take_max ? (ov > sv) : (ov < sv);
          sv = sw ? ov : sv;
          si = sw ? oi : si;
        }
      }
      const float mx = __builtin_bit_cast(float, __builtin_amdgcn_readlane(__builtin_bit_cast(int, sv), 0));
      const float ex = (lane < 16) ? __builtin_amdgcn_exp2f((sv - mx) * 1.4426950408889634f) : 0.f;
      const float sm = wave_sum(ex);
      selw[h * 64 + lane] = si;
      selw[512 + h * 64 + lane] = __builtin_bit_cast(int, ex * __builtin_amdgcn_rcpf(sm));
    }
#pragma unroll 1
    for (int h = 0; h < 8; ++h) {
      const int eperm_h = selw[h * 64 + lane];
      const int gperm_h = selw[512 + h * 64 + lane];
      uint2 U[16], V[16];
#pragma unroll
      for (int k = 0; k < 16; ++k) {
        const int id = __builtin_amdgcn_readlane(eperm_h, k);
        const uint4 rec = *(const uint4*)(p.Ub + (size_t)id * 1024 + lane * 16);
        U[k] = make_uint2(rec.x, rec.y);
        V[k] = make_uint2(rec.z, rec.w);
      }
      float d[16];
#pragma unroll
      for (int k = 0; k < 16; ++k) {
        const unsigned uw[2] = {U[k].x, U[k].y};
        float dd = 0.f;
#pragma unroll
        for (int q2 = 0; q2 < 2; ++q2) {
          const f32x2 e0 = __builtin_amdgcn_cvt_scalef32_pk_f32_fp4(uw[q2], 1.0f, 0);
          const f32x2 e1 = __builtin_amdgcn_cvt_scalef32_pk_f32_fp4(uw[q2], 1.0f, 1);
          const f32x2 e2 = __builtin_amdgcn_cvt_scalef32_pk_f32_fp4(uw[q2], 1.0f, 2);
          const f32x2 e3 = __builtin_amdgcn_cvt_scalef32_pk_f32_fp4(uw[q2], 1.0f, 3);
          dd += xr[8 * q2] * e0.x + xr[8 * q2 + 1] * e0.y + xr[8 * q2 + 2] * e1.x + xr[8 * q2 + 3] * e1.y +
                xr[8 * q2 + 4] * e2.x + xr[8 * q2 + 5] * e2.y + xr[8 * q2 + 6] * e3.x + xr[8 * q2 + 7] * e3.y;
        }
        d[k] = dd;
      }
      {
        const bool b5 = (lane & 32) != 0, b4 = (lane & 16) != 0, b3 = (lane & 8) != 0, b2 = (lane & 4) != 0;
#pragma unroll
        for (int j = 0; j < 8; ++j) { const float keep = b5 ? d[j + 8] : d[j], send = b5 ? d[j] : d[j + 8]; d[j] = keep + shx(send, 32); }
#pragma unroll
        for (int j = 0; j < 4; ++j) { const float keep = b4 ? d[j + 4] : d[j], send = b4 ? d[j] : d[j + 4]; d[j] = keep + shx(send, 16); }
#pragma unroll
        for (int j = 0; j < 2; ++j) { const float keep = b3 ? d[j + 2] : d[j], send = b3 ? d[j] : d[j + 2]; d[j] = keep + shx(send, 8); }
        { const float keep = b2 ? d[1] : d[0], send = b2 ? d[0] : d[1]; d[0] = keep + shx(send, 4); }
        d[0] += shx(d[0], 2);
        d[0] += shx(d[0], 1);
      }
      const float gl = __builtin_bit_cast(float, shu((unsigned)gperm_h, (lane >> 2) & 15));
      const float act = gelu_tanh(d[0] * (1.0f / 64.0f)) * gl;
#pragma unroll
      for (int k = 0; k < 16; ++k) {
        const float ak = __builtin_bit_cast(float, __builtin_amdgcn_readlane(__builtin_bit_cast(int, act), 4 * k));
        const unsigned vw[2] = {V[k].x, V[k].y};
#pragma unroll
        for (int q2 = 0; q2 < 2; ++q2) {
          const f32x2 e0 = __builtin_amdgcn_cvt_scalef32_pk_f32_fp4(vw[q2], 1.0f, 0);
          const f32x2 e1 = __builtin_amdgcn_cvt_scalef32_pk_f32_fp4(vw[q2], 1.0f, 1);
          const f32x2 e2 = __builtin_amdgcn_cvt_scalef32_pk_f32_fp4(vw[q2], 1.0f, 2);
          const f32x2 e3 = __builtin_amdgcn_cvt_scalef32_pk_f32_fp4(vw[q2], 1.0f, 3);
          yacc[8 * q2] += ak * e0.x; yacc[8 * q2 + 1] += ak * e0.y; yacc[8 * q2 + 2] += ak * e1.x; yacc[8 * q2 + 3] += ak * e1.y;
          yacc[8 * q2 + 4] += ak * e2.x; yacc[8 * q2 + 5] += ak * e2.y; yacc[8 * q2 + 6] += ak * e3.x; yacc[8 * q2 + 7] += ak * e3.y;
        }
      }
    }
    const int bi = tok < NLAT ? (tok >> 12) : 8;
    const float* gv = p.mod + ((size_t)(l * 9 + bi) * 6 + 5) * 1024 + lane * 16;
    float* xp = (tok < NLAT) ? (p.out + (size_t)tok * 1024) : (p.ctxs + (size_t)(tok - NLAT) * 1024);
    xp += lane * 16;
    float4 xv[4];
    float ss = 0.f;
#pragma unroll
    for (int i = 0; i < 4; ++i) {
      xv[i] = *(float4*)(xp + 4 * i);
      const float4 g4 = *(const float4*)(gv + 4 * i);
      xv[i].x += g4.x * yacc[4 * i] * 0.25f; xv[i].y += g4.y * yacc[4 * i + 1] * 0.25f; xv[i].z += g4.z * yacc[4 * i + 2] * 0.25f; xv[i].w += g4.w * yacc[4 * i + 3] * 0.25f;
      ss += xv[i].x * xv[i].x + xv[i].y * xv[i].y + xv[i].z * xv[i].z + xv[i].w * xv[i].w;
    }
    ss = wave_sum(ss);
    const float rstd = rsqrtf(ss * (1.0f / 1024.0f) + 1e-6f);
    if (l == 0) {
      const float* gam = p.norm_mix_g + 1024 + lane * 16;
      const float* msh = p.mod + ((size_t)(9 + bi) * 6 + 0) * 1024 + lane * 16;
      const float* msc = msh + 1024;
      u16* xo = p.xn + (size_t)tok * 1024 + lane * 16;
#pragma unroll
      for (int i = 0; i < 4; ++i) {
        if (do_store) *(float4*)(xp + 4 * i) = xv[i];
        const float4 g = *(const float4*)(gam + 4 * i);
        const float4 sh = *(const float4*)(msh + 4 * i);
        const float4 sc = *(const float4*)(msc + 4 * i);
        uint2 o;
        o.x = pk2(xv[i].x * rstd * g.x * (1.f + sc.x) + sh.x, xv[i].y * rstd * g.y * (1.f + sc.y) + sh.y);
        o.y = pk2(xv[i].z * rstd * g.z * (1.f + sc.z) + sh.z, xv[i].w * rstd * g.w * (1.f + sc.w) + sh.w);
        if (do_store) *(uint2*)(xo + 4 * i) = o;
      }
    } else {
      const float* fg = p.final_g + lane * 16;
#pragma unroll
      for (int i = 0; i < 4; ++i) {
        const float4 g = *(const float4*)(fg + 4 * i);
        const float4 o = make_float4(xv[i].x * rstd * g.x, xv[i].y * rstd * g.y, xv[i].z * rstd * g.z, xv[i].w * rstd * g.w);
        if (do_store) *(float4*)(xp + 4 * i) = o;
      }
    }
  }
}


#define XB_TMO      128
#define XB_XCNT(j)  (256  + 64 * (j))
#define XB_XSUB(j)  (1280 + 64 * (j))
#define XB_XGEN(j)  (2304 + 64 * (j))
#define XB_TOP      3328
#define XB_TOPGEN   3392
#define XCD_BAR_WORDS 3456
#define XB_SPIN_CAP (1u << 22)
#define LAS __attribute__((address_space(3)))
__device__ __forceinline__ unsigned xb_ld(unsigned* p) { return __hip_atomic_load(p, __ATOMIC_RELAXED, __HIP_MEMORY_SCOPE_AGENT); }
__device__ __forceinline__ unsigned xb_add(unsigned* p, unsigned v) { return __hip_atomic_fetch_add(p, v, __ATOMIC_RELAXED, __HIP_MEMORY_SCOPE_AGENT); }
__device__ __forceinline__ unsigned xb_xcc_id() { return (unsigned)__builtin_amdgcn_s_getreg((3 << 11) | 20) & 0xFu; }
#define XB_SPIN(cond, bar) do { unsigned _sp = 0; while (cond) { __builtin_amdgcn_s_sleep(1); \
    if ((++_sp & 255u) == 0u) { if (xb_ld(&(bar)[XB_TMO])) break; if (_sp > XB_SPIN_CAP) { atomicAdd(&(bar)[XB_TMO], 1u); break; } } } } while (0)
struct XcdBarrier { unsigned* bar; unsigned x; volatile LAS unsigned* st; };
__device__ __forceinline__ XcdBarrier xcd_barrier_post(unsigned* bar, volatile LAS unsigned* st) {
  XcdBarrier b; b.bar = bar; b.x = xb_xcc_id(); b.st = st;
  if (threadIdx.x == 0) (void)xb_add(&bar[XB_XCNT(b.x)], 1u);
  return b;
}
__device__ __forceinline__ void xcd_barrier_complete(unsigned* bar, unsigned x, unsigned& nloc, unsigned& nx) {
  const unsigned G = gridDim.x * gridDim.y * gridDim.z;
  unsigned sum, cnt, mine, sp = 0u;
  for (;;) {
    sum = 0u; cnt = 0u; mine = 0u;
#pragma unroll
    for (unsigned j = 0; j < 16; ++j) { const unsigned c = xb_ld(&bar[XB_XCNT(j)]); sum += c; cnt += (c > 0u) ? 1u : 0u; mine = (j == x) ? c : mine; }
    if (sum == G) break;
    __builtin_amdgcn_s_sleep(1);
    if ((++sp & 255u) == 0u) { if (xb_ld(&bar[XB_TMO])) break; if (sp > XB_SPIN_CAP) { atomicAdd(&bar[XB_TMO], 1u); break; } }
  }
  nloc = mine > 0u ? mine : 1u; nx = cnt > 0u ? cnt : 1u;
}
__device__ __forceinline__ void xcd_barrier(unsigned* bar_u, volatile LAS unsigned* st_u) {
  XcdBarrier b; b.bar = bar_u; b.x = xb_xcc_id(); b.st = st_u;
  asm volatile("s_waitcnt vmcnt(0)" ::: "memory");
  __syncthreads();
  if (threadIdx.x == 0) {
    unsigned long long bp_ = (unsigned long long)b.bar;
    asm volatile("" : "+v"(bp_));
    unsigned* bar = (unsigned*)bp_;
    __builtin_amdgcn_s_waitcnt(0);
    unsigned nloc = b.st[0], nx = b.st[1];
    if (nloc == 0u) { xcd_barrier_complete(bar, b.x, nloc, nx); b.st[0] = nloc; b.st[1] = nx; }
    const unsigned old = xb_add(&bar[XB_XSUB(b.x)], 1u);
    const unsigned gen = old / nloc;
    if (old + 1u == (gen + 1u) * nloc) {
      __builtin_amdgcn_fence(__ATOMIC_RELEASE, "agent");
      asm volatile("s_waitcnt vmcnt(0)" ::: "memory");
      const unsigned og = xb_add(&bar[XB_TOP], 1u);
      const unsigned tg = og / nx;
      if (og + 1u == (tg + 1u) * nx) xb_add(&bar[XB_TOPGEN], 1u);
      else XB_SPIN(xb_ld(&bar[XB_TOPGEN]) == tg, bar);
      __builtin_amdgcn_fence(__ATOMIC_ACQUIRE, "agent");
      xb_add(&bar[XB_XGEN(b.x)], 1u);
      asm volatile("s_waitcnt vmcnt(0)" ::: "memory");
    } else {
      XB_SPIN(xb_ld(&bar[XB_XGEN(b.x)]) == gen, bar);
      __builtin_amdgcn_fence(__ATOMIC_ACQUIRE, "agent");
      asm volatile("s_waitcnt vmcnt(0)" ::: "memory");
    }
  }
  __syncthreads();
}

template <int l>
__device__ __forceinline__ void layer_body(const P& p, char* smem, pg8::PG8_LAS_T lds, volatile LAS unsigned* xbw, const int nb, const int bid) {
    const bool last = (l == 1);
    const int n_mt = last ? 128 : 136;
    if (l == 0) {
      phase_norm(p, l, 0);
      xcd_barrier(p.counters + 1024, xbw);
    }
_Pragma("unroll 1")
    for (int rep = 0; rep < REP_INPROJ; ++rep) {
      pg8::Gemm g; pg8::Order S;
      g.A = p.xn; g.Bt = p.WinT + (size_t)l * 2816 * 1024; g.lda = 1024; g.ldb = 1024; g.K = 1024;
      S.init(136, 6, nb, bid, 4, 5);
      pg8::EpiInprojN e1; e1.qk = p.qk; e1.rg = p.rg;
      pg8::gemm_phase(lds, g, S, e1);
      g.A = p.WinT + ((size_t)l * 2816 + 1024) * 1024; g.Bt = p.xn;
      S.init(5, 136, nb, bid);
      pg8::EpiInprojT e2; e2.vT = p.vT; e2.vTc = p.vTc; e2.hyT = p.hyT; e2.hyTc = p.hyTc;
      pg8::gemm_phase(lds, g, S, e2);
    }
    xcd_barrier(p.counters + 1024, xbw);
    phase_mixers(p, l, smem, p.counters + l * 4);
    xcd_barrier(p.counters + 1024, xbw);
_Pragma("unroll 1")
    for (int rep = 0; rep < REP_2B; ++rep)
      for (int task = bid; task < 1088 + 512; task += nb) {
        if (task < 1088) rg_wave_task(p, l, task >> 2, task & 3, 1, last, smem);
        else yb_transpose_task(p, (task - 1088) >> 6, (task - 1088) & 63, smem);
      }
    xcd_barrier(p.counters + 1024, xbw);
_Pragma("unroll 1")
    for (int rep = 0; rep < REP_GATE; ++rep) {
      pg8::Gemm g; pg8::Order S;
      g.A = p.xn; g.Bt = p.WgT + (size_t)l * 3072 * 1024; g.lda = 1024; g.ldb = 1024; g.K = 1024;
      S.init(n_mt, 12, nb, bid);
      pg8::EpiGate e; e.g8 = p.g8; e.bias = p.b_gate + l * 3072;
      pg8::gemm_phase(lds, g, S, e);
    }
    xcd_barrier(p.counters + 1024, xbw);
_Pragma("unroll 1")
    for (int rep = 0; rep < REP_BRANCH; ++rep) {
      pg8::Gemm g; pg8::Order S;
      S.init(n_mt, 4, nb, bid);
      pg8::EpiBranch e; e.mbuf = p.mbuf; e.g8 = p.g8;
      g.lda = 1024;
      g.A = p.ycat; g.Bt = p.WaT + (size_t)l * 1024 * 512; g.ldb = 512; g.K = 512; e.br = 0;
      pg8::gemm_phase(lds, g, S, e);
      g.A = p.ycat + 512; g.Bt = p.WbT + (size_t)l * 1024 * 256; g.ldb = 256; g.K = 256; e.br = 1;
      pg8::gemm_phase(lds, g, S, e);
      g.A = p.ycat + 768; g.Bt = p.WcT + (size_t)l * 1024 * 256; g.ldb = 256; g.K = 256; e.br = 2;
      pg8::gemm_phase(lds, g, S, e);
    }
    xcd_barrier(p.counters + 1024, xbw);
    {
      pg8::Gemm g; pg8::Order S;
      g.A = p.mbuf; g.Bt = p.WoT + (size_t)l * 1024 * 1024; g.lda = 1024; g.ldb = 1024; g.K = 1024;
      S.init(n_mt, 4, nb, bid);
      pg8::EpiOut e; e.xsrc = (l == 0 ? p.x : p.out); e.csrc = (l == 0 ? p.ctx : p.ctxs); e.xdst = p.out; e.cdst = p.ctxs;
      e.modl = p.mod + (size_t)l * 9 * 6144;
      pg8::gemm_phase(lds, g, S, e);
      for (int t = bid; t < 8192; t += nb) {
        if (t < 4096) cvt_chunk_fp4(p.peer_u + (size_t)l * 16384 * 1024, p.Ub, (size_t)t, 64.0f, 0);
        else cvt_chunk_fp4(p.peer_v + (size_t)l * 16384 * 1024, p.Ub, (size_t)(t - 4096), 4.0f, 1);
      }
    }
    xcd_barrier(p.counters + 1024, xbw);
    phase_norm(p, l, 1);
    xcd_barrier(p.counters + 1024, xbw);
_Pragma("unroll 1")
    for (int rep = 0; rep < REP_Q; ++rep) {
      pg8::Gemm g; pg8::Order S;
      g.A = p.xn; g.Bt = p.WqkT + (size_t)l * 2048 * 1024; g.lda = 1024; g.ldb = 1024; g.K = 1024;
      S.init(n_mt, 8, nb, bid);
      pg8::EpiQ e; e.q = p.q;
      pg8::gemm_phase(lds, g, S, e);
    }
    xcd_barrier(p.counters + 1024, xbw);
_Pragma("unroll 1")
    for (int rep = 0; rep < REP_SCORE; ++rep)
      for (int task = bid; task < n_mt * 16; task += nb) peer_score_tile(p, l, task >> 4, task & 15, smem);
    xcd_barrier(p.counters + 1024, xbw);
_Pragma("unroll 1")
    for (int rep = 0; rep < REP_PEER; ++rep) phase_peer_experts(p, l, rep == REP_PEER - 1, smem);
    xcd_barrier(p.counters + 1024, xbw);
  }

__global__ void __launch_bounds__(NTHR) fwd_megakernel(P p) {
  __shared__ __attribute__((aligned(16))) char smem[SMEM_BYTES];
  cg::grid_group grid = cg::this_grid();
  const int nb = gridDim.x, bid = blockIdx.x;
  pg8::PG8_LAS_T lds = (pg8::PG8_LAS_T)smem;
  volatile LAS unsigned* xbw = (volatile LAS unsigned*)(smem + SMEM_BYTES - 32);
  if (threadIdx.x == 0) { xbw[0] = 0u; xbw[1] = 0u; xbw[2] = 0u; xbw[3] = 0u; }
  __syncthreads();
  (void)xcd_barrier_post(p.counters + 1024, xbw);

  phase_prep(p, smem);
  if (blockIdx.x < 136) phase_filters(p, 0, smem);
  if (blockIdx.x >= gridDim.x - 128) { for (int t = blockIdx.x - (gridDim.x - 128); t < 128; t += 128) filter_block_task(p, 1, 4096, t * 32, p.hT + (size_t)512 * 4096, smem); }
  grid.sync();
  phase_modreduce(p);
  for (int task = blockIdx.x; task < 512; task += gridDim.x) kf_task(p, task >> 8, task & 255, smem);
  for (int task = blockIdx.x; task < 256; task += gridDim.x) wqk_task(p, task >> 7, (task >> 3) & 15, task & 7, smem);
  xcd_barrier(p.counters + 1024, xbw);

  layer_body<0>(p, smem, lds, xbw, nb, bid);
  layer_body<1>(p, smem, lds, xbw, nb, bid);
}

extern "C" void kernel_launch(void* const* d_in, const int* in_sizes, int n_in, void* d_out, int out_size, void* d_ws,
                              size_t ws_size, hipStream_t stream) {
  P p;
  memset(&p, 0, sizeof(p));
  const float** ins = (const float**)&p;
  for (int i = 0; i < 37; ++i) ins[i] = (const float*)d_in[i];
  p.out = (float*)d_out;
  char* w = (char*)d_ws;
  size_t off = 0;
  auto take = [&](size_t bytes) { char* r = w + off; off += (bytes + 255) & ~(size_t)255; return r; };
  p.counters = (unsigned*)take(32768);
  p.WinT = (u16*)take((size_t)2 * 2816 * 1024 * 2);
  p.WgT = (u16*)take((size_t)2 * 3072 * 1024 * 2);
  p.WaT = (u16*)take((size_t)2 * 1024 * 512 * 2);
  p.WbT = (u16*)take((size_t)2 * 1024 * 256 * 2);
  p.WcT = (u16*)take((size_t)2 * 1024 * 256 * 2);
  p.WoT = (u16*)take((size_t)2 * 1024 * 1024 * 2);
  p.WqB = (u16*)take((size_t)2 * 1024 * 2048 * 2);
  p.WqkT = (u16*)take((size_t)2 * 2048 * 1024 * 2);
  p.keysB = (u16*)take((size_t)2 * 16 * 16384 * 2);
  p.rgW = (u16*)take((size_t)2 * 16 * 4096 * 2);
  p.modpart = (float*)take((size_t)16 * 2 * 9 * 6144 * 4);
  p.mod = (float*)take((size_t)2 * 9 * 6144 * 4);
  p.hT = (float*)take((size_t)2 * 512 * 4096 * 4);
  p.hc = (float*)take((size_t)512 * 256 * 4);
  p.Kf = (float*)take((size_t)2 * 256 * 8192 * 8);
  p.xn = (u16*)take((size_t)NTOK * 1024 * 2);
  p.qk = (u16*)take((size_t)NTOK * 1024 * 2);
  p.mbuf = p.qk;
  p.vT = (u16*)take((size_t)8 * 512 * 4096 * 2);
  p.vTc = (u16*)take((size_t)8 * 512 * 256 * 2);
  p.hyT = (u16*)take((size_t)8 * 768 * 4096 * 2);
  p.hyTc = (u16*)take((size_t)8 * 768 * 256 * 2);
  p.rg = (u16*)take((size_t)NTOK * 512 * 2);
  p.ycat = (u16*)take((size_t)NTOK * 1024 * 2);
  p.Ub = (unsigned char*)p.ycat;
  p.Vb = p.Ub + (size_t)16384 * 512;
  p.agg = (float*)take((size_t)8 * 2 * (136 + 34) * 256 * 8);
  p.ybT = (u16*)take((size_t)8 * 256 * 4096 * 2);
  p.ctxs = (float*)take((size_t)2048 * 1024 * 4);
  p.g8 = (unsigned char*)p.vT;
  p.q = p.qk;
  p.topk = (unsigned*)((char*)p.qk + (size_t)NTOK * 2048 * 2);
  if (off > ws_size) {
    fprintf(stderr, "workspace too small: need %zu have %zu\n", off, ws_size);
    return;
  }
  static int grid_blocks = 0;
  if (!grid_blocks) {
    int dev = 0, cus = 0, per_cu = 0;
    (void)hipGetDevice(&dev);
    (void)hipDeviceGetAttribute(&cus, hipDeviceAttributeMultiprocessorCount, dev);
    (void)hipOccupancyMaxActiveBlocksPerMultiprocessor(&per_cu, fwd_megakernel, NTHR, 0);
    if (per_cu > 1) per_cu = 1;
    grid_blocks = cus * per_cu;
  }
  (void)hipMemsetAsync(p.counters, 0, 32768, stream);
  void* args[] = {&p};
  hipError_t e = hipLaunchCooperativeKernel((void*)fwd_megakernel, dim3(grid_blocks), dim3(NTHR), args, 0, stream);
  if (e != hipSuccess) fprintf(stderr, "cooperative launch failed: %s (grid %d)\n", hipGetErrorString(e), grid_blocks);
}
```

```cpp
#include <hip/hip_runtime.h>
#include <hip/hip_cooperative_groups.h>
#include <cstdio>
#include <cstring>
namespace cg = cooperative_groups;

typedef unsigned short u16;
typedef __attribute__((ext_vector_type(8))) short bf16x8;
typedef __attribute__((ext_vector_type(16))) float f32x16;
typedef __attribute__((ext_vector_type(2))) float f32x2;

#define NLAT 32768
#define NTOK 34816
#define SMEM_BYTES 151552
#define NTHR 512
#ifndef DUP_1A
#define DUP_1A 1
#endif
#ifndef DUP_PREP
#define DUP_PREP 1
#endif
#ifndef DUP_2B
#define DUP_2B 1
#endif
#ifndef XRGA
#define XRGA 1
#endif
#ifndef REP_PEER
#define REP_PEER 1
#endif
#ifndef REP_INPROJ
#define REP_INPROJ 1
#endif
#ifndef REP_GATE
#define REP_GATE 1
#endif
#ifndef REP_BRANCH
#define REP_BRANCH 1
#endif
#ifndef REP_Q
#define REP_Q 1
#endif
#ifndef REP_SCORE
#define REP_SCORE 1
#endif
#ifndef REP_1A
#define REP_1A 1
#endif
#ifndef REP_2B
#define REP_2B 1
#endif
#ifndef REP_KF
#define REP_KF 1
#endif
#ifndef DUP_GEMM
#define DUP_GEMM 1
#endif
#ifndef DUP_PEER
#define DUP_PEER 1
#endif
#ifndef DUP_MIX
#define DUP_MIX 1
#endif
#ifndef XRG
#define XRG 1
#endif
#ifndef XFFT
#define XFFT 1
#endif
#ifndef XATT
#define XATT 1
#endif

struct P {
  const float *x, *c, *ctx, *c_ctx, *norm_mix_g, *norm_ffn_g, *w_ada, *b_ada, *w_in, *na_rpb,
      *hy_short_w, *hy_short_b, *hy_f1_w, *hy_f1_b, *hy_f2_w, *hy_f2_b, *hy_f3_w, *hy_freq, *hy_bias,
      *rg_conv_w, *rg_conv_b, *rg_wa, *rg_ba, *rg_wx, *rg_bx, *rg_lambda,
      *w_gate, *b_gate, *w_br_a, *w_br_b, *w_br_c, *w_out, *peer_wq, *peer_keys, *peer_u, *peer_v, *final_g;
  float* out;
  unsigned* counters;
  u16 *WinT, *WgT, *WaT, *WbT, *WcT, *WoT, *WqB, *WqkT, *keysB, *rgW;
  float *modpart, *mod, *hT, *hc;
  float* Kf;
  u16 *xn, *qk, *vT, *vTc, *hyT, *hyTc, *rg, *ycat, *mbuf, *ybT;
  unsigned char *Ub, *Vb, *g8, *xn8, *Win8, *Wg8;
  float *sa, *sw;
  u16* q;
  float *agg, *ctxs;
  unsigned* topk;
};

__device__ __forceinline__ u16 f2bf(float f) {
  unsigned u = __float_as_uint(f);
  u += 0x7fffu + ((u >> 16) & 1u);
  return (u16)(u >> 16);
}
__device__ __forceinline__ float bf2f(u16 h) { return __uint_as_float(((unsigned)h) << 16); }
__device__ __forceinline__ unsigned pk2(float a, float b) { return (unsigned)f2bf(a) | ((unsigned)f2bf(b) << 16); }
__device__ __forceinline__ float bflo(unsigned u) { return __uint_as_float(u << 16); }
__device__ __forceinline__ float bfhi(unsigned u) { return __uint_as_float(u & 0xffff0000u); }
__device__ __forceinline__ int opaque_tid() {
  int t = threadIdx.x;
  asm volatile("" : "+v"(t));
  return t;
}
__device__ __forceinline__ int my_lane() { return opaque_tid() & 63; }
__device__ __forceinline__ float shx(float v, int o) { return __builtin_bit_cast(float, __builtin_amdgcn_ds_bpermute(((my_lane() ^ o) << 2), __builtin_bit_cast(int, v))); }
__device__ __forceinline__ float shf(float v, int src) { return __builtin_bit_cast(float, __builtin_amdgcn_ds_bpermute((src & 63) << 2, __builtin_bit_cast(int, v))); }
__device__ __forceinline__ unsigned shu(unsigned v, int src) { return (unsigned)__builtin_amdgcn_ds_bpermute((src & 63) << 2, (int)v); }
__device__ __forceinline__ float wave_sum(float v) {
  const int lane = my_lane();
#pragma unroll
  for (int o = 32; o > 0; o >>= 1) v += __builtin_bit_cast(float, __builtin_amdgcn_ds_bpermute((lane ^ o) << 2, __builtin_bit_cast(int, v)));
  return v;
}
__device__ __forceinline__ float wave_max(float v) {
  const int lane = my_lane();
#pragma unroll
  for (int o = 32; o > 0; o >>= 1) v = fmaxf(v, __builtin_bit_cast(float, __builtin_amdgcn_ds_bpermute((lane ^ o) << 2, __builtin_bit_cast(int, v))));
  return v;
}
__device__ __forceinline__ float sigmoidf_(float x) { return __builtin_amdgcn_rcpf(1.0f + __expf(-x)); }
__device__ __forceinline__ float gelu_tanh(float x) {
  const float u2 = 1.5957691216057308f * (x + 0.044715f * x * x * x);
  return x * __builtin_amdgcn_rcpf(1.0f + __expf(-u2));
}
__device__ __forceinline__ f32x16 mfma32(bf16x8 a, bf16x8 b, f32x16 c) {
  return __builtin_amdgcn_mfma_f32_32x32x16_bf16(a, b, c, 0, 0, 0);
}
__device__ __forceinline__ f32x16 zero16() {
  f32x16 z;
#pragma unroll
  for (int i = 0; i < 16; ++i) z[i] = 0.f;
  return z;
}
__device__ __forceinline__ int swz128(int row, int ch) { return row * 128 + ((ch ^ ((row >> 1) & 7)) << 4); }
__device__ __forceinline__ int swz256(int row, int ch) { return row * 256 + ((ch ^ (row & 15)) << 4); }

struct c2 { float x, y; };
__device__ __forceinline__ c2 cadd(c2 a, c2 b) { return {a.x + b.x, a.y + b.y}; }
__device__ __forceinline__ c2 csub(c2 a, c2 b) { return {a.x - b.x, a.y - b.y}; }
__device__ __forceinline__ c2 cmul(c2 a, c2 b) { return {a.x * b.x - a.y * b.y, a.x * b.y + a.y * b.x}; }
__device__ __forceinline__ float c16(int i) {
  const float tb[16] = {1.0f, 0.9238795325112867f, 0.7071067811865476f, 0.3826834323650898f, 0.0f,
                        -0.3826834323650898f, -0.7071067811865476f, -0.9238795325112867f, -1.0f,
                        -0.9238795325112867f, -0.7071067811865476f, -0.3826834323650898f, 0.0f,
                        0.3826834323650898f, 0.7071067811865476f, 0.9238795325112867f};
  return tb[i & 15];
}
__device__ __forceinline__ float s16(int i) { return c16(i + 12); }
template <int R> __device__ __forceinline__ constexpr int brev(int k) {
  int r = 0;
  for (int b = 1, o = R >> 1; b < R; b <<= 1, o >>= 1)
    if (k & b) r |= o;
  return r;
}
template <int R> __device__ __forceinline__ void dft_reg(c2* v, float sgn) {
#pragma unroll
  for (int h = R / 2; h >= 1; h >>= 1) {
#pragma unroll
    for (int g = 0; g < R; g += 2 * h) {
#pragma unroll
      for (int j = 0; j < h; ++j) {
        c2 a = v[g + j], b = v[g + j + h];
        v[g + j] = cadd(a, b);
        c2 d = csub(a, b);
        const int ti = j * (16 / (2 * h));
        c2 w = {c16(ti), sgn * s16(ti)};
        v[g + j + h] = (j == 0) ? d : cmul(d, w);
      }
    }
  }
}
template <int R> __device__ __forceinline__ int fft_bfly(c2* v, int j, int Ns, float sgn) {
  const int k = j & (Ns - 1);
  const float f = sgn * (float)k / (float)(Ns * R);
#pragma unroll
  for (int r = 1; r < R; ++r) {
    float t = f * (float)r;
    c2 w = {__builtin_amdgcn_cosf(t), __builtin_amdgcn_sinf(t)};
    v[r] = cmul(v[r], w);
  }
  dft_reg<R>(v, sgn);
  return (j - k) * R + k;
}
template <int R> __device__ __forceinline__ void fft_pass(c2* buf, int Ns, float sgn) {
  constexpr int NBF = 8192 / R;
  constexpr int PER = NBF / NTHR;
  const int tid = opaque_tid();
  c2 v[PER][R];
#pragma unroll
  for (int i = 0; i < PER; ++i) {
    const int j = tid + NTHR * i;
#pragma unroll
    for (int r = 0; r < R; ++r) v[i][r] = buf[j + r * NBF];
  }
  __syncthreads();
#pragma unroll
  for (int i = 0; i < PER; ++i) {
    const int j = tid + NTHR * i;
    const int base = fft_bfly<R>(v[i], j, Ns, sgn);
#pragma unroll
    for (int r = 0; r < R; ++r) buf[base + r * Ns] = v[i][brev<R>(r)];
  }
  __syncthreads();
}
__device__ __forceinline__ void fft8192(c2* buf, float sgn) {
  fft_pass<8>(buf, 1, sgn);
  fft_pass<8>(buf, 8, sgn);
  fft_pass<8>(buf, 64, sgn);
  fft_pass<16>(buf, 512, sgn);
}

__device__ __forceinline__ void gemm_kloop(f32x16 (&acc)[2][2], const u16* __restrict__ A, int lda,
                                           const u16* __restrict__ B, int ldb, int K, char* smem) {
  const int tid = opaque_tid(), lane = tid & 63, wid = tid >> 6;
  const int wm = wid >> 1, wn = wid & 1;
  const int l31 = lane & 31, hh = lane >> 5;
  uint4 ra[4], rb[2];
  const int nk = K >> 6;
  const int srow = tid >> 3, sch = tid & 7;
  const char* Ab = (const char*)A;
  const char* Bb = (const char*)B;
  const unsigned aoff = (unsigned)(srow * lda + sch * 8) * 2u;
  const unsigned boff = (unsigned)(srow * ldb + sch * 8) * 2u;
  const unsigned astep = (unsigned)lda * 128u, bstep = (unsigned)ldb * 128u;
#pragma unroll
  for (int i = 0; i < 4; ++i) ra[i] = *(const uint4*)(Ab + (aoff + i * astep));
#pragma unroll
  for (int i = 0; i < 2; ++i) rb[i] = *(const uint4*)(Bb + (boff + i * bstep));
#pragma unroll
  for (int i = 0; i < 4; ++i) *(uint4*)(smem + swz128(srow + i * 64, sch)) = ra[i];
#pragma unroll
  for (int i = 0; i < 2; ++i) *(uint4*)(smem + 65536 + swz128(srow + i * 64, sch)) = rb[i];
  __syncthreads();
  for (int kt = 0; kt < nk; ++kt) {
    const bool more = (kt + 1 < nk);
    if (more) {
      const unsigned ko = (unsigned)(kt + 1) * 128u;
#pragma unroll
      for (int i = 0; i < 4; ++i) ra[i] = *(const uint4*)(Ab + (aoff + i * astep + ko));
#pragma unroll
      for (int i = 0; i < 2; ++i) rb[i] = *(const uint4*)(Bb + (boff + i * bstep + ko));
    }
    const char* as = smem + (kt & 1) * 32768;
    const char* bs = smem + 65536 + (kt & 1) * 16384;
    int lrow = l31;
    asm volatile("" : "+v"(lrow));
#pragma unroll
    for (int s = 0; s < 4; ++s) {
      bf16x8 af[2], bfr[2];
#pragma unroll
      for (int i = 0; i < 2; ++i) af[i] = *(const bf16x8*)(as + swz128(wm * 64 + i * 32 + lrow, s * 2 + hh));
#pragma unroll
      for (int j = 0; j < 2; ++j) bfr[j] = *(const bf16x8*)(bs + swz128(wn * 64 + j * 32 + lrow, s * 2 + hh));
#pragma unroll
      for (int i = 0; i < 2; ++i)
#pragma unroll
        for (int j = 0; j < 2; ++j) acc[i][j] = mfma32(af[i], bfr[j], acc[i][j]);
    }
    if (more) {
      char* an = smem + ((kt + 1) & 1) * 32768;
      char* bn = smem + 65536 + ((kt + 1) & 1) * 16384;
      int sr2 = srow;
      asm volatile("" : "+v"(sr2));
#pragma unroll
      for (int i = 0; i < 4; ++i) *(uint4*)(an + swz128(sr2 + i * 64, sch)) = ra[i];
#pragma unroll
      for (int i = 0; i < 2; ++i) *(uint4*)(bn + swz128(sr2 + i * 64, sch)) = rb[i];
    }
    __syncthreads();
  }
}
__device__ __forceinline__ void zero_acc(f32x16 (&acc)[2][2]) {
#pragma unroll
  for (int i = 0; i < 2; ++i)
#pragma unroll
    for (int j = 0; j < 2; ++j) acc[i][j] = zero16();
}
#define EPI_ROW(i, e) (wm * 64 + (i)*32 + ((e)&3) + 8 * ((e) >> 2) + 4 * hh)
#define EPI_COL(j) (wn * 64 + (j)*32 + l31)
#define EPI_VARS                                                    \
  const int tid = opaque_tid(), lane = tid & 63, wid = tid >> 6;     \
  const int wm = wid >> 1, wn = wid & 1, l31 = lane & 31, hh = lane >> 5; \
  (void)tid; (void)wm; (void)wn; (void)l31; (void)hh;


namespace pg8 {
#define PG8_LAS __attribute__((address_space(3)))
typedef PG8_LAS unsigned char* PG8_LAS_T;
typedef float f32x4 __attribute__((ext_vector_type(4)));
typedef unsigned u32x4 __attribute__((ext_vector_type(4)));
typedef int i32x4 __attribute__((ext_vector_type(4)));
constexpr int BM = 256, BK = 64, HALF = 128, HTB = HALF * BK * 2, STAGE_BYTES = 8 * HTB, NXCD = 8, WGM = 8;
__device__ __forceinline__ int lds_byte(int r, int c) { const int st = (r >> 4) * 2 + (c >> 5), rr = r & 15, cc = c & 31, ob = rr * 64 + cc * 2; return st * 1024 + (ob ^ (((ob >> 9) & 1) << 5)); }
__device__ __forceinline__ void stage_rc(int b, int& R, int& C) { const int st = b / 1024, sb = b % 1024, swz = sb ^ (((sb >> 9) & 1) << 5); R = (st >> 1) * 16 + swz / 64; C = (st & 1) * 32 + (swz % 64) / 2; }
__device__ __forceinline__ int perm32(int rho) { const int n = rho >> 4, i = rho & 15; return 8 * (i >> 2) + 4 * n + (i & 3); }
struct Unit { int pm, pn; };
struct Gemm { const u16* A; const u16* Bt; int lda, ldb, K; };
struct Order {
  int nM, nN, nwg, G, c, skip_from, skip_by;
  __device__ __forceinline__ void init(int nM_, int nN_, int G_, int c_, int sf = 1 << 30, int sb = 0) { nM = nM_; nN = nN_; nwg = nM * nN; G = G_; c = c_; skip_from = sf; skip_by = sb; }
  __device__ __forceinline__ bool next(int i, Unit& u) const {
    const long L = (long)i * G + c; if (L >= nwg) return false;
    int wgid = (int)L; { const int q = nwg / NXCD, r = nwg % NXCD, xcd = wgid % NXCD, off = wgid / NXCD; wgid = (xcd < r ? xcd * (q + 1) : r * (q + 1) + (xcd - r) * q) + off; }
    const int nig = WGM * nN, gid = wgid / nig, fm = gid * WGM, gsz = (nM - fm) < WGM ? (nM - fm) : WGM;
    u.pm = fm + ((wgid % nig) % gsz); u.pn = (wgid % nig) / gsz;
    if (u.pn >= skip_from) u.pn += skip_by;
    return true;
  }
};
__device__ __forceinline__ f32x4 mma16(bf16x8 a, bf16x8 b, f32x4 c) { return __builtin_amdgcn_mfma_f32_16x16x32_bf16(a, b, c, 0, 0, 0); }
__device__ __forceinline__ i32x4 mma16(bf16x8 a, bf16x8 b, i32x4 c) { return __builtin_amdgcn_mfma_i32_16x16x64_i8(__builtin_bit_cast(i32x4, a), __builtin_bit_cast(i32x4, b), c, 0, 0, 0); }
template <class Epi>
__device__ __forceinline__ void gemm_phase(PG8_LAS unsigned char* lds, const Gemm g, const Order& S, const Epi& E) {
  const int tid = opaque_tid(), wid = __builtin_amdgcn_readfirstlane(tid >> 6), lane = tid & 63, wr = wid >> 2, wc = wid & 3, fr = lane & 15, fq = lane >> 4;
  const int K = g.K, nt = K / BK;
  unsigned voffA[2], voffB[2];
#pragma unroll
  for (int i = 0; i < 2; ++i) { int R, C; stage_rc(tid * 16 + i * 8192, R, C); const int Rb = Epi::PERM ? ((R & ~31) + perm32(R & 31)) : R;
    voffA[i] = (unsigned)(R * g.lda + C) * 2u; voffB[i] = (unsigned)(Rb * g.ldb + C) * 2u; }
  const size_t kstep = (size_t)(BK * 2);
  const size_t hstepA = (size_t)HALF * g.lda * 2, hstepB = (size_t)HALF * g.ldb * 2;
  const size_t tstepA = 2 * hstepA, tstepB = 2 * hstepB;
  const unsigned ldsw = (unsigned)wid * 1024u;
  const int aoff = lds_byte(wr * 64 + fr, fq * 8), boff = lds_byte(wc * 32 + fr, fq * 8);
#define PG8_SA(b, h) (((b) * 2 + (h)) * HTB)
#define PG8_SB(b, h) ((4 + (b) * 2 + (h)) * HTB)
#define PG8_STAGE(bufoff, gbase, voff) do { _Pragma("unroll") for (int _i = 0; _i < 2; ++_i) \
    __builtin_amdgcn_global_load_lds((const unsigned*)((const char*)(gbase) + (voff)[_i]), (PG8_LAS unsigned*)(lds + (bufoff) + ldsw + _i * 8192), 16, 0, 0); } while (0)
#define PG8_LDA(dst, b, h) do { _Pragma("unroll") for (int m = 0; m < 4; ++m) _Pragma("unroll") for (int k = 0; k < 2; ++k) dst[m][k] = *(const PG8_LAS bf16x8*)(lds + PG8_SA(b, h) + aoff + m * 2048 + k * 1024); } while (0)
#define PG8_LDB(dst, b, h) do { _Pragma("unroll") for (int n = 0; n < 2; ++n) _Pragma("unroll") for (int k = 0; k < 2; ++k) dst[n][k] = *(const PG8_LAS bf16x8*)(lds + PG8_SB(b, h) + boff + n * 2048 + k * 1024); } while (0)
#define PG8_MMA(ai, bj, At, Bt) do { __builtin_amdgcn_s_setprio(1); _Pragma("unroll") for (int m = 0; m < 4; ++m) _Pragma("unroll") for (int n = 0; n < 2; ++n) _Pragma("unroll") for (int k = 0; k < 2; ++k) \
    acc[ai][bj][m][n] = mma16(Bt[n][k], At[m][k], acc[ai][bj][m][n]); __builtin_amdgcn_s_setprio(0); } while (0)
#define PG8_WAIT_V(n) asm volatile("s_waitcnt vmcnt(" #n ")" ::: "memory")
#define PG8_WAIT_L(n) asm volatile("s_waitcnt lgkmcnt(" #n ")" ::: "memory")
#define PG8_BAR __builtin_amdgcn_s_barrier()
#define PG8_SCHED __builtin_amdgcn_sched_barrier(0)
  Unit cur, nxt; int ui = 0;
  if (!S.next(0, cur)) return;
  typedef typename Epi::acc_t acc_t;
  acc_t acc[2][2][4][2];
#pragma unroll
  for (int a = 0; a < 2; ++a)
#pragma unroll
    for (int b = 0; b < 2; ++b)
#pragma unroll
      for (int m = 0; m < 4; ++m)
#pragma unroll
        for (int n = 0; n < 2; ++n) acc[a][b][m][n] = (acc_t){0, 0, 0, 0};
  bf16x8 At[4][2], B0[2][2], B1[2][2];
  const char* cA = (const char*)g.A + (size_t)cur.pm * tstepA; const char* cB = (const char*)g.Bt + (size_t)cur.pn * tstepB;
  PG8_STAGE(PG8_SB(0, 0), cB, voffB); PG8_STAGE(PG8_SA(0, 0), cA, voffA); PG8_STAGE(PG8_SB(0, 1), cB + hstepB, voffB); PG8_STAGE(PG8_SA(0, 1), cA + hstepA, voffA);
  if (wr == 1) PG8_BAR;
  PG8_WAIT_V(4); PG8_BAR;
  PG8_STAGE(PG8_SB(1, 0), cB + kstep, voffB); PG8_STAGE(PG8_SA(1, 0), cA + kstep, voffA); PG8_STAGE(PG8_SB(1, 1), cB + hstepB + kstep, voffB);
  PG8_WAIT_V(6); PG8_BAR;
  for (;;) {
    const bool has_next = S.next(ui + 1, nxt);
    const char* nA = has_next ? (const char*)g.A + (size_t)nxt.pm * tstepA : cA; const char* nB = has_next ? (const char*)g.Bt + (size_t)nxt.pn * tstepB : cB;
    for (int t = 0; t < nt; t += 2) {
      const bool last = (t == nt - 2);
      const char* a1 = cA + (size_t)(t + 1) * kstep;
      const char* a2 = last ? nA : cA + (size_t)(t + 2) * kstep; const char* b2 = last ? nB : cB + (size_t)(t + 2) * kstep;
      const char* a3 = a2 + kstep; const char* b3 = b2 + kstep;
      PG8_LDB(B0, 0, 0); PG8_SCHED; PG8_LDA(At, 0, 0); PG8_STAGE(PG8_SA(1, 1), a1 + hstepA, voffA);
      PG8_WAIT_L(8); PG8_BAR; PG8_WAIT_L(0); PG8_MMA(0, 0, At, B0); PG8_BAR; PG8_SCHED;
      PG8_LDB(B1, 0, 1); PG8_STAGE(PG8_SB(0, 0), b2, voffB);
      PG8_BAR; PG8_WAIT_L(0); PG8_MMA(0, 1, At, B1); PG8_BAR;
      PG8_LDA(At, 0, 1); PG8_STAGE(PG8_SA(0, 0), a2, voffA);
      PG8_BAR; PG8_WAIT_L(0); PG8_MMA(1, 0, At, B0); PG8_BAR; PG8_SCHED;
      PG8_STAGE(PG8_SB(0, 1), b2 + hstepB, voffB);
      PG8_WAIT_V(6); PG8_BAR; PG8_MMA(1, 1, At, B1); PG8_BAR;
      PG8_LDB(B0, 1, 0); PG8_SCHED; PG8_LDA(At, 1, 0); PG8_STAGE(PG8_SA(0, 1), a2 + hstepA, voffA);
      PG8_WAIT_L(8); PG8_BAR; PG8_WAIT_L(0); PG8_MMA(0, 0, At, B0); PG8_BAR; PG8_SCHED;
      PG8_LDB(B1, 1, 1); PG8_STAGE(PG8_SB(1, 0), b3, voffB);
      PG8_BAR; PG8_WAIT_L(0); PG8_MMA(0, 1, At, B1); PG8_BAR;
      PG8_LDA(At, 1, 1); PG8_STAGE(PG8_SA(1, 0), a3, voffA);
      PG8_BAR; PG8_WAIT_L(0); PG8_MMA(1, 0, At, B0); PG8_BAR; PG8_SCHED;
      PG8_STAGE(PG8_SB(1, 1), b3 + hstepB, voffB);
      PG8_WAIT_V(6); PG8_BAR; PG8_MMA(1, 1, At, B1); PG8_BAR;
    }
    E(acc, cur, wr, wc, fr, fq);
    if (!has_next) break;
#pragma unroll
    for (int a = 0; a < 2; ++a)
#pragma unroll
      for (int b = 0; b < 2; ++b)
#pragma unroll
        for (int m = 0; m < 4; ++m)
#pragma unroll
          for (int n = 0; n < 2; ++n) acc[a][b][m][n] = (acc_t){0, 0, 0, 0};
    cur = nxt; cA = nA; cB = nB; ++ui;
  }
  PG8_WAIT_V(0);
  if (wr == 0) PG8_BAR;
  PG8_BAR;
#undef PG8_SA
#undef PG8_SB
#undef PG8_STAGE
#undef PG8_LDA
#undef PG8_LDB
#undef PG8_MMA
#undef PG8_WAIT_V
#undef PG8_WAIT_L
#undef PG8_BAR
#undef PG8_SCHED
}
typedef const f32x4 (&AccRef)[2][2][4][2];
typedef const i32x4 (&AccRefI)[2][2][4][2];
struct EpiInprojN {
  static constexpr bool PERM = true;
  typedef f32x4 acc_t;
  u16* qk; u16* rg;
  __device__ __forceinline__ void operator()(AccRef acc, const Unit& u, int wr, int wc, int fr, int fq) const {
    const int row0 = u.pm * BM + wr * 64 + fr;
    u16* base; int ld, colt;
    if (u.pn < 4) { base = qk; ld = 1024; colt = u.pn * 256; } else { base = rg; ld = 512; colt = (u.pn - 9) * 256; }
    const int col0 = colt + wc * 32 + 8 * fq;
#pragma unroll
    for (int ai = 0; ai < 2; ++ai)
#pragma unroll
      for (int m = 0; m < 4; ++m) {
        u16* rowp = base + (size_t)(row0 + ai * HALF + m * 16) * ld + col0;
#pragma unroll
        for (int bj = 0; bj < 2; ++bj) {
          const f32x4 v0 = acc[ai][bj][m][0], v1 = acc[ai][bj][m][1];
          u32x4 w; w.x = pk2(v0[0], v0[1]); w.y = pk2(v0[2], v0[3]); w.z = pk2(v1[0], v1[1]); w.w = pk2(v1[2], v1[3]);
          *(u32x4*)(rowp + bj * HALF) = w;
        }
      }
  }
};
struct EpiInprojT {
  static constexpr bool PERM = true;
  typedef f32x4 acc_t;
  u16 *vT, *vTc, *hyT, *hyTc;
  __device__ __forceinline__ void operator()(AccRef acc, const Unit& u, int wr, int wc, int fr, int fq) const {
    const bool isctx = (u.pn >= 128);
    const int b = isctx ? (u.pn - 128) : (u.pn >> 4);
    const int Lseg = isctx ? 256 : 4096, t0 = isctx ? 0 : (u.pn & 15) * 256;
    const bool isv = (u.pm < 2);
    const size_t boff = isv ? (isctx ? (size_t)16777216 : (size_t)0) : (isctx ? (size_t)(16777216 + 1048576 + 25165824) : (size_t)(16777216 + 1048576));
    u16* base = vT + boff;
    const int nc = isv ? 512 : 768;
    const int wrow0 = (isv ? u.pm : u.pm - 2) * BM + wr * 64 + fr;
    const int col0 = t0 + wc * 32 + 8 * fq;
#pragma unroll
    for (int ai = 0; ai < 2; ++ai)
#pragma unroll
      for (int m = 0; m < 4; ++m) {
        u16* rowp = base + ((size_t)(b * nc + wrow0 + ai * HALF + m * 16)) * Lseg + col0;
#pragma unroll
        for (int bj = 0; bj < 2; ++bj) {
          const f32x4 v0 = acc[ai][bj][m][0], v1 = acc[ai][bj][m][1];
          u32x4 w; w.x = pk2(v0[0], v0[1]); w.y = pk2(v0[2], v0[3]); w.z = pk2(v1[0], v1[1]); w.w = pk2(v1[2], v1[3]);
          *(u32x4*)(rowp + bj * HALF) = w;
        }
      }
  }
};
struct EpiGate {
  static constexpr bool PERM = true;
  typedef f32x4 acc_t;
  unsigned char* g8; const float* bias;
  __device__ __forceinline__ void operator()(AccRef acc, const Unit& u, int wr, int wc, int fr, int fq) const {
    const int row0 = u.pm * BM + wr * 64 + fr;
    const int col0 = u.pn * BM + wc * 32 + 8 * fq;
#pragma unroll
    for (int bj = 0; bj < 2; ++bj) {
      const f32x4 b0 = *(const f32x4*)(bias + col0 + bj * HALF), b1 = *(const f32x4*)(bias + col0 + bj * HALF + 4);
#pragma unroll
      for (int ai = 0; ai < 2; ++ai)
#pragma unroll
        for (int m = 0; m < 4; ++m) {
          const f32x4 v0 = acc[ai][bj][m][0] + b0, v1 = acc[ai][bj][m][1] + b1;
          unsigned w0 = 0, w1 = 0;
#pragma unroll
          for (int k = 0; k < 4; ++k) {
            w0 |= (unsigned)(sigmoidf_(v0[k]) * 255.0f + 0.5f) << (8 * k);
            w1 |= (unsigned)(sigmoidf_(v1[k]) * 255.0f + 0.5f) << (8 * k);
          }
          *(uint2*)(g8 + (size_t)(row0 + ai * HALF + m * 16) * 3072 + col0 + bj * HALF) = make_uint2(w0, w1);
        }
    }
  }
};
struct EpiBranch {
  static constexpr bool PERM = true;
  typedef f32x4 acc_t;
  u16* mbuf; const unsigned char* g8; int br;
  __device__ __forceinline__ void operator()(AccRef acc, const Unit& u, int wr, int wc, int fr, int fq) const {
    const int row0 = u.pm * BM + wr * 64 + fr;
    const int col0 = u.pn * BM + wc * 32 + 8 * fq;
#pragma unroll
    for (int ai = 0; ai < 2; ++ai)
#pragma unroll
      for (int m = 0; m < 4; ++m) {
        const size_t row = (size_t)(row0 + ai * HALF + m * 16);
#pragma unroll
        for (int bj = 0; bj < 2; ++bj) {
          const uint2 gq = *(const uint2*)(g8 + row * 3072 + br * 1024 + col0 + bj * HALF);
          u16* mp = mbuf + row * 1024 + col0 + bj * HALF;
          const f32x4 v0 = acc[ai][bj][m][0], v1 = acc[ai][bj][m][1];
          float r[8];
          r[0] = (float)(gq.x & 255u) * v0[0]; r[1] = (float)((gq.x >> 8) & 255u) * v0[1];
          r[2] = (float)((gq.x >> 16) & 255u) * v0[2]; r[3] = (float)(gq.x >> 24) * v0[3];
          r[4] = (float)(gq.y & 255u) * v1[0]; r[5] = (float)((gq.y >> 8) & 255u) * v1[1];
          r[6] = (float)((gq.y >> 16) & 255u) * v1[2]; r[7] = (float)(gq.y >> 24) * v1[3];
          u32x4 w;
          if (br == 0) {
            w.x = pk2(r[0] * (1.f / 255.f), r[1] * (1.f / 255.f)); w.y = pk2(r[2] * (1.f / 255.f), r[3] * (1.f / 255.f));
            w.z = pk2(r[4] * (1.f / 255.f), r[5] * (1.f / 255.f)); w.w = pk2(r[6] * (1.f / 255.f), r[7] * (1.f / 255.f));
          } else {
            const u32x4 o = *(const u32x4*)mp;
            w.x = pk2(bflo(o.x) + r[0] * (1.f / 255.f), bfhi(o.x) + r[1] * (1.f / 255.f));
            w.y = pk2(bflo(o.y) + r[2] * (1.f / 255.f), bfhi(o.y) + r[3] * (1.f / 255.f));
            w.z = pk2(bflo(o.z) + r[4] * (1.f / 255.f), bfhi(o.z) + r[5] * (1.f / 255.f));
            w.w = pk2(bflo(o.w) + r[6] * (1.f / 255.f), bfhi(o.w) + r[7] * (1.f / 255.f));
          }
          *(u32x4*)mp = w;
        }
      }
  }
};
struct EpiOut {
  static constexpr bool PERM = false;
  typedef f32x4 acc_t;
  const float *xsrc, *csrc; float *xdst, *cdst; const float* modl;
  __device__ __forceinline__ void operator()(AccRef acc, const Unit& u, int wr, int wc, int fr, int fq) const {
    const bool isctx = (u.pm >= 128);
    const int bi = isctx ? 8 : (u.pm >> 4);
    const float* gatev = modl + ((size_t)bi * 6 + 2) * 1024;
    const float* src = isctx ? (csrc - (size_t)NLAT * 1024) : xsrc;
    float* dst = isctx ? (cdst - (size_t)NLAT * 1024) : xdst;
    const int row0 = u.pm * BM + wr * 64 + fr, col0 = u.pn * BM + wc * 32 + 4 * fq;
#pragma unroll
    for (int bj = 0; bj < 2; ++bj)
#pragma unroll
      for (int n = 0; n < 2; ++n) {
        const int col = col0 + bj * HALF + n * 16;
        const f32x4 gv = *(const f32x4*)(gatev + col);
#pragma unroll
        for (int ai = 0; ai < 2; ++ai)
#pragma unroll
          for (int m = 0; m < 4; ++m) {
            const size_t o = (size_t)(row0 + ai * HALF + m * 16) * 1024 + col;
            const f32x4 xv = *(const f32x4*)(src + o);
            *(f32x4*)(dst + o) = xv + gv * acc[ai][bj][m][n];
          }
      }
  }
};
struct EpiQ {
  static constexpr bool PERM = true;
  typedef f32x4 acc_t;
  u16* q;
  __device__ __forceinline__ void operator()(AccRef acc, const Unit& u, int wr, int wc, int fr, int fq) const {
    const int row0 = u.pm * BM + wr * 64 + fr;
    const int col0 = u.pn * BM + wc * 32 + 8 * fq;
#pragma unroll
    for (int ai = 0; ai < 2; ++ai)
#pragma unroll
      for (int m = 0; m < 4; ++m) {
        u16* rowp = q + (size_t)(row0 + ai * HALF + m * 16) * 2048 + col0;
#pragma unroll
        for (int bj = 0; bj < 2; ++bj) {
          const f32x4 v0 = acc[ai][bj][m][0], v1 = acc[ai][bj][m][1];
          u32x4 w;
          w.x = __builtin_bit_cast(unsigned, __builtin_amdgcn_cvt_pkrtz(v0[0], v0[1]));
          w.y = __builtin_bit_cast(unsigned, __builtin_amdgcn_cvt_pkrtz(v0[2], v0[3]));
          w.z = __builtin_bit_cast(unsigned, __builtin_amdgcn_cvt_pkrtz(v1[0], v1[1]));
          w.w = __builtin_bit_cast(unsigned, __builtin_amdgcn_cvt_pkrtz(v1[2], v1[3]));
          *(u32x4*)(rowp + bj * HALF) = w;
        }
      }
  }
};
struct EpiInprojN8 {
  static constexpr bool PERM = true;
  typedef i32x4 acc_t;
  u16* qk; u16* rg; const float* sa; const float* sw;
  __device__ __forceinline__ void operator()(AccRefI acc, const Unit& u, int wr, int wc, int fr, int fq) const {
    const int row0 = u.pm * BM + wr * 64 + fr;
    u16* base; int ld, colt;
    if (u.pn < 4) { base = qk; ld = 1024; colt = u.pn * 256; } else { base = rg; ld = 512; colt = (u.pn - 9) * 256; }
    const int col0 = colt + wc * 32 + 8 * fq;
    const int wcol0 = u.pn * 256 + wc * 32 + 8 * fq;
#pragma unroll
    for (int bj = 0; bj < 2; ++bj) {
      const f32x4 c0 = *(const f32x4*)(sw + wcol0 + bj * HALF), c1 = *(const f32x4*)(sw + wcol0 + bj * HALF + 4);
#pragma unroll
      for (int ai = 0; ai < 2; ++ai)
#pragma unroll
        for (int m = 0; m < 4; ++m) {
          const int row = row0 + ai * HALF + m * 16;
          const float rs = sa[row];
          const i32x4 a0 = acc[ai][bj][m][0], a1 = acc[ai][bj][m][1];
          u32x4 w;
          w.x = pk2((float)a0[0] * rs * c0[0], (float)a0[1] * rs * c0[1]); w.y = pk2((float)a0[2] * rs * c0[2], (float)a0[3] * rs * c0[3]);
          w.z = pk2((float)a1[0] * rs * c1[0], (float)a1[1] * rs * c1[1]); w.w = pk2((float)a1[2] * rs * c1[2], (float)a1[3] * rs * c1[3]);
          *(u32x4*)(base + (size_t)row * ld + col0 + bj * HALF) = w;
        }
    }
  }
};
struct EpiInprojT8 {
  static constexpr bool PERM = true;
  typedef i32x4 acc_t;
  u16* vT; const float* sa; const float* sw;
  __device__ __forceinline__ void operator()(AccRefI acc, const Unit& u, int wr, int wc, int fr, int fq) const {
    const bool isctx = (u.pn >= 128);
    const int b = isctx ? (u.pn - 128) : (u.pn >> 4);
    const int Lseg = isctx ? 256 : 4096, t0 = isctx ? 0 : (u.pn & 15) * 256;
    const bool isv = (u.pm < 2);
    const size_t boff = isv ? (isctx ? (size_t)16777216 : (size_t)0) : (isctx ? (size_t)(16777216 + 1048576 + 25165824) : (size_t)(16777216 + 1048576));
    u16* base = vT + boff;
    const int nc = isv ? 512 : 768;
    const int wrow0 = (isv ? u.pm : u.pm - 2) * BM + wr * 64 + fr;
    const int srow0 = u.pm * BM + wr * 64 + fr;
    const int col0 = t0 + wc * 32 + 8 * fq;
    const int tok0 = u.pn * BM + wc * 32 + 8 * fq;
#pragma unroll
    for (int bj = 0; bj < 2; ++bj) {
      const f32x4 c0 = *(const f32x4*)(sa + tok0 + bj * HALF), c1 = *(const f32x4*)(sa + tok0 + bj * HALF + 4);
#pragma unroll
      for (int ai = 0; ai < 2; ++ai)
#pragma unroll
        for (int m = 0; m < 4; ++m) {
          const float rs = sw[srow0 + ai * HALF + m * 16];
          const i32x4 a0 = acc[ai][bj][m][0], a1 = acc[ai][bj][m][1];
          u32x4 w;
          w.x = pk2((float)a0[0] * rs * c0[0], (float)a0[1] * rs * c0[1]); w.y = pk2((float)a0[2] * rs * c0[2], (float)a0[3] * rs * c0[3]);
          w.z = pk2((float)a1[0] * rs * c1[0], (float)a1[1] * rs * c1[1]); w.w = pk2((float)a1[2] * rs * c1[2], (float)a1[3] * rs * c1[3]);
          *(u32x4*)(base + ((size_t)(b * nc + wrow0 + ai * HALF + m * 16)) * Lseg + col0 + bj * HALF) = w;
        }
    }
  }
};
struct EpiGate8 {
  static constexpr bool PERM = true;
  typedef i32x4 acc_t;
  unsigned char* g8; const float* bias; const float* sa; const float* sw;
  __device__ __forceinline__ void operator()(AccRefI acc, const Unit& u, int wr, int wc, int fr, int fq) const {
    const int row0 = u.pm * BM + wr * 64 + fr;
    const int col0 = u.pn * BM + wc * 32 + 8 * fq;
#pragma unroll
    for (int bj = 0; bj < 2; ++bj) {
      const f32x4 b0 = *(const f32x4*)(bias + col0 + bj * HALF), b1 = *(const f32x4*)(bias + col0 + bj * HALF + 4);
      const f32x4 c0 = *(const f32x4*)(sw + col0 + bj * HALF), c1 = *(const f32x4*)(sw + col0 + bj * HALF + 4);
#pragma unroll
      for (int ai = 0; ai < 2; ++ai)
#pragma unroll
        for (int m = 0; m < 4; ++m) {
          const int row = row0 + ai * HALF + m * 16;
          const float rs = sa[row];
          const i32x4 a0 = acc[ai][bj][m][0], a1 = acc[ai][bj][m][1];
          unsigned w0 = 0, w1 = 0;
#pragma unroll
          for (int k = 0; k < 4; ++k) {
            w0 |= (unsigned)(sigmoidf_((float)a0[k] * rs * c0[k] + b0[k]) * 255.0f + 0.5f) << (8 * k);
            w1 |= (unsigned)(sigmoidf_((float)a1[k] * rs * c1[k] + b1[k]) * 255.0f + 0.5f) << (8 * k);
          }
          *(uint2*)(g8 + (size_t)row * 3072 + col0 + bj * HALF) = make_uint2(w0, w1);
        }
    }
  }
};
}

__device__ __forceinline__ void tr_tile(const float* __restrict__ src, int N, int K, u16* __restrict__ dst, int tile, char* smem) {
  float* lds = (float*)smem;
  const int tiles_n = N >> 6;
  const int tk = tile / tiles_n, tn = tile - tk * tiles_n;
  const int tid = opaque_tid();
  {
    const int r = tid >> 3, c8 = (tid & 7) * 8;
    const float* s = src + (size_t)(tk * 64 + r) * N + tn * 64 + c8;
    float4 a = *(const float4*)s, b = *(const float4*)(s + 4);
    float* d = lds + r * 65 + c8;
    d[0] = a.x; d[1] = a.y; d[2] = a.z; d[3] = a.w; d[4] = b.x; d[5] = b.y; d[6] = b.z; d[7] = b.w;
  }
  __syncthreads();
  {
    const int n = tid >> 3, k0 = (tid & 7) * 8;
    uint4 o;
    o.x = pk2(lds[(k0 + 0) * 65 + n], lds[(k0 + 1) * 65 + n]);
    o.y = pk2(lds[(k0 + 2) * 65 + n], lds[(k0 + 3) * 65 + n]);
    o.z = pk2(lds[(k0 + 4) * 65 + n], lds[(k0 + 5) * 65 + n]);
    o.w = pk2(lds[(k0 + 6) * 65 + n], lds[(k0 + 7) * 65 + n]);
    *(uint4*)(dst + (size_t)(tn * 64 + n) * K + tk * 64 + k0) = o;
  }
  __syncthreads();
}
__device__ __forceinline__ void colmax_task(const float* __restrict__ w, int N, int n0, float* __restrict__ swp, char* smem) {
  const int tid = opaque_tid();
  const int col = tid & 63, kg = tid >> 6;
  float m = 0.f;
  const float* wp = w + (size_t)(kg * 128) * N + n0 + col;
#pragma unroll 16
  for (int k = 0; k < 128; ++k) m = fmaxf(m, fabsf(wp[(size_t)k * N]));
  float* red = (float*)smem;
  red[kg * 64 + col] = m;
  __syncthreads();
  if (tid < 64) {
    float mm = red[tid];
#pragma unroll
    for (int g = 1; g < 8; ++g) mm = fmaxf(mm, red[g * 64 + tid]);
    swp[n0 + tid] = fmaxf(mm, 1e-20f) * (1.0f / 127.0f);
  }
  __syncthreads();
}
__device__ __forceinline__ void tr_tile_i8(const float* __restrict__ src, int N, int K, unsigned char* __restrict__ dst, int tile, const float* __restrict__ swp, char* smem) {
  float* lds = (float*)smem;
  const int tiles_n = N >> 6;
  const int tk = tile / tiles_n, tn = tile - tk * tiles_n;
  const int tid = opaque_tid();
  {
    const int r = tid >> 3, c8 = (tid & 7) * 8;
    const float* sp = src + (size_t)(tk * 64 + r) * N + tn * 64 + c8;
    float4 a = *(const float4*)sp, b = *(const float4*)(sp + 4);
    float* d = lds + r * 65 + c8;
    d[0] = a.x; d[1] = a.y; d[2] = a.z; d[3] = a.w; d[4] = b.x; d[5] = b.y; d[6] = b.z; d[7] = b.w;
  }
  __syncthreads();
  {
    const int n = tid >> 3, k0 = (tid & 7) * 8;
    const float inv = 1.0f / swp[tn * 64 + n];
    unsigned w0 = 0, w1 = 0;
#pragma unroll
    for (int i = 0; i < 4; ++i) {
      w0 |= ((unsigned)__float2int_rn(lds[(k0 + i) * 65 + n] * inv) & 255u) << (8 * i);
      w1 |= ((unsigned)__float2int_rn(lds[(k0 + 4 + i) * 65 + n] * inv) & 255u) << (8 * i);
    }
    *(uint2*)(dst + (size_t)(tn * 64 + n) * K + tk * 64 + k0) = make_uint2(w0, w1);
  }
  __syncthreads();
}
__device__ __forceinline__ void cvt_chunk(const float* __restrict__ src, u16* __restrict__ dst, size_t chunk) {
  const size_t i = chunk * 4096 + (size_t)opaque_tid() * 8;
  float4 a = *(const float4*)(src + i), b = *(const float4*)(src + i + 4);
  uint4 o;
  o.x = pk2(a.x, a.y); o.y = pk2(a.z, a.w); o.z = pk2(b.x, b.y); o.w = pk2(b.z, b.w);
  *(uint4*)(dst + i) = o;
}
__device__ __forceinline__ void cvt_chunk_fp8(const float* __restrict__ src, unsigned char* __restrict__ dst, size_t chunk, float scale) {
  const size_t i = chunk * 4096 + (size_t)opaque_tid() * 8;
  const float4 a = *(const float4*)(src + i), b = *(const float4*)(src + i + 4);
  int w0 = __builtin_amdgcn_cvt_pk_fp8_f32(a.x * scale, a.y * scale, 0, false);
  w0 = __builtin_amdgcn_cvt_pk_fp8_f32(a.z * scale, a.w * scale, w0, true);
  int w1 = __builtin_amdgcn_cvt_pk_fp8_f32(b.x * scale, b.y * scale, 0, false);
  w1 = __builtin_amdgcn_cvt_pk_fp8_f32(b.z * scale, b.w * scale, w1, true);
  *(uint2*)(dst + i) = make_uint2((unsigned)w0, (unsigned)w1);
}
__device__ __forceinline__ void cvt_chunk_fp4(const float* __restrict__ src, unsigned char* __restrict__ dst, size_t chunk, float scale, int vhalf) {
  const size_t i = chunk * 4096 + (size_t)opaque_tid() * 8;
  const float4 a = *(const float4*)(src + i), b = *(const float4*)(src + i + 4);
  unsigned w = 0;
  w = __builtin_amdgcn_cvt_scalef32_pk_fp4_f32(w, a.x * scale, a.y * scale, 1.0f, 0);
  w = __builtin_amdgcn_cvt_scalef32_pk_fp4_f32(w, a.z * scale, a.w * scale, 1.0f, 1);
  w = __builtin_amdgcn_cvt_scalef32_pk_fp4_f32(w, b.x * scale, b.y * scale, 1.0f, 2);
  w = __builtin_amdgcn_cvt_scalef32_pk_fp4_f32(w, b.z * scale, b.w * scale, 1.0f, 3);
  const size_t e = i >> 10;
  const unsigned d = (unsigned)(i & 1023);
  *(unsigned*)(dst + e * 1024 + (d >> 4) * 16 + vhalf * 8 + ((d & 15) >> 1)) = w;
}
__device__ __forceinline__ void phase_prep(const P& p, char* smem) {
  const int tid = opaque_tid();
  const int NTR = 2512;
  const int total = 2 * NTR + 128 + 384;
  for (int task = blockIdx.x; task < total; task += gridDim.x) {
    if (task < 2 * NTR) {
      const int l = task / NTR;
      int t = task - l * NTR;
      if (t < 704) { if (t < 44) colmax_task(p.w_in + (size_t)l * 1024 * 2816, 2816, t * 64, p.sw + l * 5888, smem); }
      else if ((t -= 704) < 768) { if (t < 48) colmax_task(p.w_gate + (size_t)l * 1024 * 3072, 3072, t * 64, p.sw + l * 5888 + 2816, smem); }
      else if ((t -= 768) < 128) tr_tile(p.w_br_a + (size_t)l * 512 * 1024, 1024, 512, p.WaT + (size_t)l * 1024 * 512, t, smem);
      else if ((t -= 128) < 64) tr_tile(p.w_br_b + (size_t)l * 256 * 1024, 1024, 256, p.WbT + (size_t)l * 1024 * 256, t, smem);
      else if ((t -= 64) < 64) tr_tile(p.w_br_c + (size_t)l * 256 * 1024, 1024, 256, p.WcT + (size_t)l * 1024 * 256, t, smem);
      else if ((t -= 64) < 256) tr_tile(p.w_out + (size_t)l * 1024 * 1024, 1024, 1024, p.WoT + (size_t)l * 1024 * 1024, t, smem);
      else if ((t -= 256) < 512) cvt_chunk(p.peer_wq + (size_t)l * 1024 * 2048, p.WqB + (size_t)l * 1024 * 2048, (size_t)t);
      else {
        t -= 512;
        const int gate = t >> 3, dn = t & 7;
        const float* src = (gate ? p.rg_wx : p.rg_wa) + (size_t)(l * 8 + dn) * 4096;
        tr_tile(src, 64, 64, p.rgW + (size_t)((l * 2 + gate) * 8 + dn) * 4096, 0, smem);
      }
    } else if (task < 2 * NTR + 128) {
      cvt_chunk(p.peer_keys, p.keysB, (size_t)(task - 2 * NTR));
    } else {
      int t = task - 2 * NTR - 128;
      const int kc = t & 15; t >>= 4;
      const int jc = t % 12, l = t / 12;
      float* s = (float*)smem;
      for (int i = tid; i < 576; i += NTHR) {
        const int bi = i >> 6, kk = i & 63;
        const float v = (bi < 8) ? p.c[bi * 1024 + kc * 64 + kk] : p.c_ctx[kc * 64 + kk];
        s[i] = v / (1.0f + __expf(-v));
      }
      __syncthreads();
      const int j = jc * 512 + tid;
      float acc[9];
#pragma unroll
      for (int bi = 0; bi < 9; ++bi) acc[bi] = 0.f;
      const float* wp = p.w_ada + ((size_t)l * 1024 + kc * 64) * 6144 + j;
#pragma unroll 8
      for (int kk = 0; kk < 64; ++kk) {
        const float w = wp[(size_t)kk * 6144];
#pragma unroll
        for (int bi = 0; bi < 9; ++bi) acc[bi] += s[bi * 64 + kk] * w;
      }
#pragma unroll
      for (int bi = 0; bi < 9; ++bi) p.modpart[((size_t)(kc * 2 + l) * 9 + bi) * 6144 + j] = acc[bi];
      __syncthreads();
    }
  }
}
__device__ __forceinline__ void phase_modreduce(const P& p) {
  const int n = 2 * 9 * 6144;
  for (int i = blockIdx.x * NTHR + opaque_tid(); i < n; i += gridDim.x * NTHR) {
    const int l = i / (9 * 6144);
    const int j = i % 6144;
    float s = p.b_ada[l * 6144 + j];
#pragma unroll
    for (int kc = 0; kc < 16; ++kc) s += p.modpart[(size_t)kc * n + i];
    p.mod[i] = s;
  }
}

__device__ __forceinline__ void phase_norm(const P& p, int l, int which) {
  const int tid_ = opaque_tid(); const int lane = tid_ & 63, wid = tid_ >> 6;
  const int ntok = (which == 2 || (which == 1 && l == 1)) ? NLAT : NTOK;
  for (int row = blockIdx.x * 8 + wid; row < ntok; row += gridDim.x * 8) {
    const float* src;
    if (row < NLAT) src = ((which == 0 && l == 0) ? p.x : p.out) + (size_t)row * 1024;
    else src = ((which == 0 && l == 0) ? p.ctx : p.ctxs) + (size_t)(row - NLAT) * 1024;
    float4 v[4];
    float ss = 0.f;
#pragma unroll
    for (int i = 0; i < 4; ++i) {
      v[i] = *(const float4*)(src + i * 256 + lane * 4);
      ss += v[i].x * v[i].x + v[i].y * v[i].y + v[i].z * v[i].z + v[i].w * v[i].w;
    }
    ss = wave_sum(ss);
    const float rstd = rsqrtf(ss * (1.0f / 1024.0f) + 1e-6f);
    if (which == 2) {
#pragma unroll
      for (int i = 0; i < 4; ++i) {
        const int col = i * 256 + lane * 4;
        const float4 g = *(const float4*)(p.final_g + col);
        float4 o = {v[i].x * rstd * g.x, v[i].y * rstd * g.y, v[i].z * rstd * g.z, v[i].w * rstd * g.w};
        *(float4*)(p.out + (size_t)row * 1024 + col) = o;
      }
    } else {
      const int bi = row < NLAT ? (row >> 12) : 8;
      const float* gam = (which == 0 ? p.norm_mix_g : p.norm_ffn_g) + l * 1024;
      const float* msh = p.mod + ((size_t)(l * 9 + bi) * 6 + (which == 0 ? 0 : 3)) * 1024;
      const float* msc = msh + 1024;
      float4 y[4];
      float amax = 0.f;
#pragma unroll
      for (int i = 0; i < 4; ++i) {
        const int col = i * 256 + lane * 4;
        const float4 g = *(const float4*)(gam + col);
        const float4 sh = *(const float4*)(msh + col);
        const float4 sc = *(const float4*)(msc + col);
        y[i].x = v[i].x * rstd * g.x * (1.f + sc.x) + sh.x; y[i].y = v[i].y * rstd * g.y * (1.f + sc.y) + sh.y;
        y[i].z = v[i].z * rstd * g.z * (1.f + sc.z) + sh.z; y[i].w = v[i].w * rstd * g.w * (1.f + sc.w) + sh.w;
        amax = fmaxf(amax, fmaxf(fmaxf(fabsf(y[i].x), fabsf(y[i].y)), fmaxf(fabsf(y[i].z), fabsf(y[i].w))));
      }
      if (which == 0) {
        amax = fmaxf(wave_max(amax), 1e-20f);
        const float inv = 127.0f / amax;
#pragma unroll
        for (int i = 0; i < 4; ++i) {
          const unsigned w = ((unsigned)__float2int_rn(y[i].x * inv) & 255u) | (((unsigned)__float2int_rn(y[i].y * inv) & 255u) << 8) |
                             (((unsigned)__float2int_rn(y[i].z * inv) & 255u) << 16) | (((unsigned)__float2int_rn(y[i].w * inv) & 255u) << 24);
          *(unsigned*)(p.xn8 + (size_t)row * 1024 + i * 256 + lane * 4) = w;
        }
        if (lane == 0) p.sa[row] = amax * (1.0f / 127.0f);
      } else {
#pragma unroll
        for (int i = 0; i < 4; ++i) {
          uint2 o;
          o.x = pk2(y[i].x, y[i].y);
          o.y = pk2(y[i].z, y[i].w);
          *(uint2*)(p.xn + (size_t)row * 1024 + i * 256 + lane * 4) = o;
        }
      }
    }
  }
}

__device__ __forceinline__ void filter_wave(const P& p, int l, int L, int t, float* __restrict__ outp) {
  const int lane = opaque_tid() & 63;
  const float tl = (float)t / (float)(L - 1);
  const float wang = (6.283185307179586f / (float)L) * (float)t;
  float z = 0.f;
  if (lane == 0) z = tl;
  else if (lane <= 16) { const float band = 1e-4f + (float)(lane - 1) * ((15.0f - 1e-4f) / 15.0f); z = cosf(band * wang); }
  else if (lane <= 32) { const float band = 1e-4f + (float)(lane - 17) * ((15.0f - 1e-4f) / 15.0f); z = -sinf(band * wang); }
  float a1 = p.hy_f1_b[l * 64 + lane];
  for (int i = 0; i < 33; ++i) a1 += shf(z, i) * p.hy_f1_w[(l * 33 + i) * 64 + lane];
  const float h1 = sinf(p.hy_freq[l * 128 + lane] * a1);
  float a2 = p.hy_f2_b[l * 64 + lane];
  for (int i = 0; i < 64; ++i) a2 += shf(h1, i) * p.hy_f2_w[(l * 64 + i) * 64 + lane];
  const float h2 = sinf(p.hy_freq[l * 128 + 64 + lane] * a2);
  float a3[8];
#pragma unroll
  for (int m = 0; m < 8; ++m) a3[m] = 0.f;
  for (int i = 0; i < 64; ++i) {
    const float hv = shf(h2, i);
    const float* wr = p.hy_f3_w + (size_t)(l * 64 + i) * 512 + lane;
#pragma unroll
    for (int m = 0; m < 8; ++m) a3[m] += hv * wr[m * 64];
  }
  const float LN100 = 4.605170185988092f;
  const float d0 = LN100 / 1.5f, d1 = LN100 / 0.3f;
#pragma unroll
  for (int m = 0; m < 8; ++m) {
    const int cp = lane + 64 * m;
    const int ch = cp & 255;
    const float delta = d0 + (float)ch * ((d1 - d0) / 255.0f);
    outp[(size_t)cp * L + t] = a3[m] * expf(-tl * delta);
  }
}
__device__ __forceinline__ void filter_block_task(const P& p, int l, int L, int t0, float* __restrict__ outp, char* smem) {
  const int tid = opaque_tid(), lane = tid & 63, wid = tid >> 6;
  float* W3s = (float*)smem;
  float* W2s = (float*)(smem + 131072);
  {
    const float4* s3 = (const float4*)(p.hy_f3_w + (size_t)l * 64 * 512);
    const float4* s2 = (const float4*)(p.hy_f2_w + (size_t)l * 64 * 64);
#pragma unroll
    for (int i = 0; i < 16; ++i) ((float4*)W3s)[tid + NTHR * i] = s3[tid + NTHR * i];
#pragma unroll
    for (int i = 0; i < 2; ++i) ((float4*)W2s)[tid + NTHR * i] = s2[tid + NTHR * i];
  }
  __syncthreads();
  float z[4], tl[4];
#pragma unroll
  for (int j = 0; j < 4; ++j) {
    const int t = t0 + wid * 4 + j;
    tl[j] = (float)t / (float)(L - 1);
    const float wang = (6.283185307179586f / (float)L) * (float)t;
    float zz = 0.f;
    if (lane == 0) zz = tl[j];
    else if (lane <= 16) { const float band = 1e-4f + (float)(lane - 1) * ((15.0f - 1e-4f) / 15.0f); zz = cosf(band * wang); }
    else if (lane <= 32) { const float band = 1e-4f + (float)(lane - 17) * ((15.0f - 1e-4f) / 15.0f); zz = -sinf(band * wang); }
    z[j] = zz;
  }
  float a1[4], a2[4];
  {
    const float b1 = p.hy_f1_b[l * 64 + lane];
#pragma unroll
    for (int j = 0; j < 4; ++j) a1[j] = b1;
#pragma unroll 11
    for (int i = 0; i < 33; ++i) {
      const float w = p.hy_f1_w[(l * 33 + i) * 64 + lane];
#pragma unroll
      for (int j = 0; j < 4; ++j) a1[j] += shf(z[j], i) * w;
    }
    const float f0 = p.hy_freq[l * 128 + lane];
#pragma unroll
    for (int j = 0; j < 4; ++j) a1[j] = sinf(f0 * a1[j]);
  }
  {
    const float b2 = p.hy_f2_b[l * 64 + lane];
#pragma unroll
    for (int j = 0; j < 4; ++j) a2[j] = b2;
#pragma unroll 8
    for (int i = 0; i < 64; ++i) {
      const float w = W2s[i * 64 + lane];
#pragma unroll
      for (int j = 0; j < 4; ++j) a2[j] += shf(a1[j], i) * w;
    }
    const float f1 = p.hy_freq[l * 128 + 64 + lane];
#pragma unroll
    for (int j = 0; j < 4; ++j) a2[j] = sinf(f1 * a2[j]);
  }
  float a3[4][8];
#pragma unroll
  for (int j = 0; j < 4; ++j)
#pragma unroll
    for (int m = 0; m < 8; ++m) a3[j][m] = 0.f;
#pragma unroll 4
  for (int i = 0; i < 64; ++i) {
    float w[8];
#pragma unroll
    for (int m = 0; m < 8; ++m) w[m] = W3s[i * 512 + lane + 64 * m];
#pragma unroll
    for (int j = 0; j < 4; ++j) {
      const float hv = shf(a2[j], i);
#pragma unroll
      for (int m = 0; m < 8; ++m) a3[j][m] += hv * w[m];
    }
  }
  const float LN100 = 4.605170185988092f;
  const float d0 = LN100 / 1.5f, d1 = LN100 / 0.3f;
#pragma unroll
  for (int m = 0; m < 8; ++m) {
    const int cp = lane + 64 * m;
    const float delta = d0 + (float)(cp & 255) * ((d1 - d0) / 255.0f);
    float4 o;
    o.x = a3[0][m] * expf(-tl[0] * delta); o.y = a3[1][m] * expf(-tl[1] * delta);
    o.z = a3[2][m] * expf(-tl[2] * delta); o.w = a3[3][m] * expf(-tl[3] * delta);
    *(float4*)(outp + (size_t)cp * L + t0 + wid * 4) = o;
  }
  __syncthreads();
}
__device__ __forceinline__ void phase_filters(const P& p, int l, char* smem) {
  const int ntask = 128 + (l == 0 ? 8 : 0);
  for (int t = blockIdx.x; t < ntask; t += gridDim.x) {
    if (t < 128) filter_block_task(p, l, 4096, t * 32, p.hT + (size_t)l * 512 * 4096, smem);
    else filter_block_task(p, l, 256, (t - 128) * 32, p.hc, smem);
  }
}
__device__ __forceinline__ void kf_task(const P& p, int l, int c, char* smem) {
  const float* hTl = p.hT + (size_t)l * 512 * 4096;
  c2* buf = (c2*)smem;
  const int tid = opaque_tid();
  for (int i = 0; i < 16; ++i) {
    const int j = tid + NTHR * i;
    float v;
    if (j < 4096) v = hTl[(size_t)c * 4096 + j];
    else if (j == 4096) v = 0.f;
    else v = hTl[(size_t)(256 + c) * 4096 + (8192 - j)];
    buf[j] = {v, 0.f};
  }
  __syncthreads();
  fft8192(buf, -1.f);
  c2* o = (c2*)p.Kf + ((size_t)l * 256 + c) * 8192;
  for (int i = 0; i < 16; ++i) { const int j = tid + NTHR * i; o[j] = buf[j]; }
  __syncthreads();
}

__device__ __forceinline__ void inproj_tile(const P& p, int l, int mt, int nt, char* smem) {
  f32x16 acc[2][2];
  zero_acc(acc);
  const int m0 = mt * 256, n0 = nt * 128;
  gemm_kloop(acc, p.xn + (size_t)m0 * 1024, 1024, p.WinT + ((size_t)l * 2816 + n0) * 1024, 1024, 1024, smem);
  EPI_VARS
  if (nt < 8 || nt >= 18) {
    u16* dst; int ld, cbase;
    if (nt < 8) { dst = p.qk; ld = 1024; cbase = n0; }
    else { dst = p.rg; ld = 512; cbase = n0 - 2304; }
#pragma unroll
    for (int i = 0; i < 2; ++i)
#pragma unroll
      for (int j = 0; j < 2; ++j)
#pragma unroll
        for (int e = 0; e < 16; ++e)
          dst[(size_t)(m0 + EPI_ROW(i, e)) * ld + cbase + EPI_COL(j)] = f2bf(acc[i][j][e]);
  } else {
#pragma unroll
    for (int i = 0; i < 2; ++i)
#pragma unroll
      for (int j = 0; j < 2; ++j)
#pragma unroll
        for (int qd = 0; qd < 4; ++qd) {
          uint2 o;
          o.x = pk2(acc[i][j][4 * qd + 0], acc[i][j][4 * qd + 1]);
          o.y = pk2(acc[i][j][4 * qd + 2], acc[i][j][4 * qd + 3]);
          const int row0 = wm * 64 + i * 32 + 8 * qd + 4 * hh;
          *(uint2*)(smem + EPI_COL(j) * 520 + row0 * 2) = o;
        }
    __syncthreads();
    u16* dstT; int Lseg, t0, ncol0, nc;
    const bool isctx = (mt >= 128);
    const int b = isctx ? (mt - 128) : (mt >> 4);
    if (nt < 12) { ncol0 = n0 - 1024; nc = 512; dstT = isctx ? p.vTc : p.vT; }
    else { ncol0 = n0 - 1536; nc = 768; dstT = isctx ? p.hyTc : p.hyT; }
    if (isctx) { Lseg = 256; t0 = 0; } else { Lseg = 4096; t0 = (mt & 15) * 256; }
#pragma unroll 4
    for (int it = 0; it < 16; ++it) {
      const int idx = tid + NTHR * it;
      const int col = idx >> 6, u = idx & 63;
      const uint2 v = *(const uint2*)(smem + col * 520 + u * 8);
      *(uint2*)(dstT + ((size_t)(b * nc + ncol0 + col)) * Lseg + t0 + u * 4) = v;
    }
    __syncthreads();
  }
}

__device__ __forceinline__ float ldbf(const u16* p, int t, int L) { return (t >= 0 && t < L) ? bf2f(p[t]) : 0.f; }
__device__ __forceinline__ void ld10(const u16* __restrict__ seq, int t0, float (&v)[10]) {
  const uint4 r = *(const uint4*)(seq + t0);
  v[0] = (t0 > 0) ? bf2f(seq[t0 - 1]) : 0.f;
  v[9] = (t0 + 8 < 4096) ? bf2f(seq[t0 + 8]) : 0.f;
  v[1] = bflo(r.x); v[2] = bfhi(r.x); v[3] = bflo(r.y); v[4] = bfhi(r.y);
  v[5] = bflo(r.z); v[6] = bfhi(r.z); v[7] = bflo(r.w); v[8] = bfhi(r.w);
}
__device__ __forceinline__ void hyena_fft_task(const P& p, int l, int c, int bp, char* smem) {
  c2* buf = (c2*)smem;
  c2* ub = (c2*)(smem + 65536);
  const int tid = opaque_tid();
  const float* sw = p.hy_short_w + l * 3 * 768;
  const float* sb = p.hy_short_b + l * 768;
  const float wx0[3] = {sw[c], sw[768 + c], sw[1536 + c]};
  const float wx1[3] = {sw[256 + c], sw[768 + 256 + c], sw[1536 + 256 + c]};
  const float wv[3] = {sw[512 + c], sw[768 + 512 + c], sw[1536 + 512 + c]};
  const float bx0 = sb[c], bx1 = sb[256 + c], bv = sb[512 + c];
  const float dsk = p.hy_bias[l * 256 + c];
  const int t0 = tid * 8;
  {
    float u[2][8];
#pragma unroll
    for (int bb = 0; bb < 2; ++bb) {
      const int b = 2 * bp + bb;
      float x1[10], vv[10];
      ld10(p.hyT + ((size_t)(b * 768 + 256 + c)) * 4096, t0, x1);
      ld10(p.hyT + ((size_t)(b * 768 + 512 + c)) * 4096, t0, vv);
#pragma unroll
      for (int k = 0; k < 8; ++k) {
        const float x1c = bx1 + wx1[0] * x1[k] + wx1[1] * x1[k + 1] + wx1[2] * x1[k + 2];
        const float vc = bv + wv[0] * vv[k] + wv[1] * vv[k + 1] + wv[2] * vv[k + 2];
        u[bb][k] = vc * x1c;
      }
    }
#pragma unroll
    for (int k = 0; k < 8; k += 2) {
      const float4 w = make_float4(u[0][k], u[1][k], u[0][k + 1], u[1][k + 1]);
      *(float4*)(buf + t0 + k) = w;
      *(float4*)(ub + t0 + k) = w;
      *(float4*)(buf + 4096 + t0 + k) = make_float4(0.f, 0.f, 0.f, 0.f);
    }
  }
  __syncthreads();
  fft8192(buf, -1.f);
  const c2* kf = (const c2*)p.Kf + ((size_t)l * 256 + c) * 8192;
  for (int i = 0; i < 16; ++i) {
    const int k = tid + NTHR * i;
    buf[k] = cmul(buf[k], kf[k]);
  }
  __syncthreads();
  fft8192(buf, 1.f);
#pragma unroll
  for (int bb = 0; bb < 2; ++bb) {
    const int b = 2 * bp + bb;
    float x0[10];
    ld10(p.hyT + ((size_t)(b * 768 + c)) * 4096, t0, x0);
    float o[8];
#pragma unroll
    for (int k = 0; k < 8; ++k) {
      const c2 y = buf[t0 + k];
      const c2 uu = ub[t0 + k];
      const float x0c = bx0 + wx0[0] * x0[k] + wx0[1] * x0[k + 1] + wx0[2] * x0[k + 2];
      const float yy = ldexpf(bb ? y.y : y.x, -13);
      const float uv = bb ? uu.y : uu.x;
      o[k] = x0c * (yy + uv * dsk);
    }
    uint4 w; w.x = pk2(o[0], o[1]); w.y = pk2(o[2], o[3]); w.z = pk2(o[4], o[5]); w.w = pk2(o[6], o[7]);
    *(uint4*)(p.ybT + ((size_t)(b * 256 + c)) * 4096 + t0) = w;
  }
  __syncthreads();
}
__device__ __forceinline__ void yb_transpose_task(const P& p, int b, int tb, char* smem) {
  const int tid = opaque_tid(), lane = tid & 63, wid = tid >> 6;
  u16* T = (u16*)smem;
#pragma unroll
  for (int it = 0; it < 4; ++it) {
    const int id = tid + NTHR * it;
    const int c = id >> 3, ch = id & 7;
    const uint4 r = *(const uint4*)(p.ybT + ((size_t)(b * 256 + c)) * 4096 + tb * 64 + ch * 8);
    unsigned* d = (unsigned*)(T + c * 66 + ch * 8);
    d[0] = r.x; d[1] = r.y; d[2] = r.z; d[3] = r.w;
  }
  __syncthreads();
#pragma unroll
  for (int it = 0; it < 8; ++it) {
    const int tt = wid + 8 * it;
    const int c0 = lane * 4;
    uint2 w;
    w.x = (unsigned)T[(c0 + 0) * 66 + tt] | ((unsigned)T[(c0 + 1) * 66 + tt] << 16);
    w.y = (unsigned)T[(c0 + 2) * 66 + tt] | ((unsigned)T[(c0 + 3) * 66 + tt] << 16);
    *(uint2*)(p.ycat + (size_t)(b * 4096 + tb * 64 + tt) * 1024 + 512 + c0) = w;
  }
  __syncthreads();
}
__device__ __forceinline__ void hyena_ctx_task(const P& p, int l, int b, int cg8, char* smem) {
  const int tid_ = opaque_tid(); const int lane = tid_ & 63, wid = tid_ >> 6;
  const int c = cg8 * 8 + wid;
  float* us = (float*)smem + wid * 1024;
  float* kfp = us + 256 + 255;
  const float* sw = p.hy_short_w + l * 3 * 768;
  const float* sb = p.hy_short_b + l * 768;
  const u16* x0 = p.hyTc + ((size_t)(b * 768 + c)) * 256;
  const u16* x1 = p.hyTc + ((size_t)(b * 768 + 256 + c)) * 256;
  const u16* vv = p.hyTc + ((size_t)(b * 768 + 512 + c)) * 256;
  for (int i = 0; i < 4; ++i) {
    const int t = lane + 64 * i;
    const float x1c = sb[256 + c] + sw[256 + c] * ldbf(x1, t - 1, 256) + sw[768 + 256 + c] * ldbf(x1, t, 256) + sw[1536 + 256 + c] * ldbf(x1, t + 1, 256);
    const float vc = sb[512 + c] + sw[512 + c] * ldbf(vv, t - 1, 256) + sw[768 + 512 + c] * ldbf(vv, t, 256) + sw[1536 + 512 + c] * ldbf(vv, t + 1, 256);
    us[t] = vc * x1c;
    kfp[t] = p.hc[(size_t)c * 256 + t];
    if (t > 0) kfp[-t] = p.hc[(size_t)(256 + c) * 256 + t];
  }
  __syncthreads();
  const float dsk = p.hy_bias[l * 256 + c];
  float acc[4] = {0.f, 0.f, 0.f, 0.f};
  for (int s = 0; s < 256; ++s) {
    const float uv = us[s];
#pragma unroll
    for (int i = 0; i < 4; ++i) acc[i] += kfp[lane + 64 * i - s] * uv;
  }
#pragma unroll
  for (int i = 0; i < 4; ++i) {
    const int t = lane + 64 * i;
    const float x0c = sb[c] + sw[c] * ldbf(x0, t - 1, 256) + sw[768 + c] * ldbf(x0, t, 256) + sw[1536 + c] * ldbf(x0, t + 1, 256);
    p.ycat[(size_t)(NLAT + b * 256 + t) * 1024 + 512 + c] = f2bf(x0c * (acc[i] + us[t] * dsk));
  }
  __syncthreads();
}

template <int DIR>
__device__ __forceinline__ void rg_scan32(const float (&Av)[2][16], const float (&Bv)[2][16], float (&carry)[2], float (&H)[2][16], int hh) {
#pragma unroll
  for (int nt = 0; nt < 2; ++nt) {
    float c = carry[nt];
#pragma unroll
    for (int go = 0; go < 8; ++go) {
      const int g = DIR ? 7 - go : go, q = g >> 1, own = g & 1;
      float h = c;
#pragma unroll
      for (int io = 0; io < 4; ++io) {
        const int e = 4 * q + (DIR ? 3 - io : io);
        h = Av[nt][e] * h + Bv[nt][e];
        H[nt][e] = (hh == own) ? h : H[nt][e];
      }
      const float mine = (hh == own) ? h : c;
      const float other = shx(mine, 32);
      c = (hh == own) ? mine : other;
    }
    carry[nt] = c;
  }
}
__device__ __forceinline__ void rg_wave_task(const P& p, int l, int bq, int nblk, int mode, bool last, char* smem) {
  const int tid = opaque_tid(), lane = tid & 63, wid = tid >> 6;
  const int l31 = lane & 31, hh = lane >> 5;
  const int b = bq / 34, rr = bq - b * 34;
  const int seg = rr < 2 ? 0 : 1, blk = rr < 2 ? rr : rr - 2;
  if (mode == 1 && seg == 0 && last) return;
  const int ck = wid >> 1, dir = wid & 1;
  char* wreg = smem + wid * 17408;
  u16* xs = (u16*)wreg;
  char* xcb = wreg + 4608;
  float* xcf = (float*)(wreg + 8704);
  float2* blockagg = (float2*)(smem + 139264);
  const int Lseg = seg ? 4096 : 256;
  const int tokbase = seg ? b * 4096 : NLAT + b * 256;
  const int T0 = blk * 128 + ck * 32;
  const int cg32 = (seg ? 8 : 0) + blk * 4 + ck;
  bf16x8 wf[2][2][4];
#pragma unroll
  for (int gate = 0; gate < 2; ++gate) {
    const u16* wp = p.rgW + (size_t)(((l * 2 + gate) * 2 + dir) * 4 + nblk) * 4096 + l31 * 64 + 8 * hh;
#pragma unroll
    for (int nt = 0; nt < 2; ++nt)
#pragma unroll
      for (int s = 0; s < 4; ++s) wf[gate][nt][s] = *(const bf16x8*)(wp + nt * 2048 + 16 * s);
  }
  float cba[2], cbx[2], csp[2];
#pragma unroll
  for (int nt = 0; nt < 2; ++nt) {
    const int ch = (l * 2 + dir) * 256 + nblk * 64 + nt * 32 + l31;
    cba[nt] = p.rg_ba[ch];
    cbx[nt] = p.rg_bx[ch];
    csp[nt] = __logf(1.0f + __expf(-p.rg_lambda[ch]));
  }
#pragma unroll
  for (int i = 0; i < 5; ++i) {
    const int idx = lane + 64 * i;
    const int row = idx >> 3, chunk = idx & 7;
    if (row < 35) {
      const int pos = T0 - 2 + row;
      uint4 v = make_uint4(0u, 0u, 0u, 0u);
      if (pos >= 0 && pos < Lseg) v = *(const uint4*)(p.rg + (size_t)(tokbase + pos) * 512 + nblk * 64 + chunk * 8);
      *(uint4*)(xs + row * 64 + chunk * 8) = v;
    }
  }
  asm volatile("s_waitcnt lgkmcnt(0)" ::: "memory");
  {
    const int ch = l * 256 + nblk * 64 + lane;
    const float w0 = p.rg_conv_w[(l * 4 + 0) * 256 + nblk * 64 + lane], w1 = p.rg_conv_w[(l * 4 + 1) * 256 + nblk * 64 + lane];
    const float w2 = p.rg_conv_w[(l * 4 + 2) * 256 + nblk * 64 + lane], w3 = p.rg_conv_w[(l * 4 + 3) * 256 + nblk * 64 + lane];
    const float cb = p.rg_conv_b[ch];
    float x0 = bf2f(xs[0 * 64 + lane]), x1 = bf2f(xs[1 * 64 + lane]), x2 = bf2f(xs[2 * 64 + lane]);
#pragma unroll
    for (int t = 0; t < 32; ++t) {
      const float x3 = bf2f(xs[(t + 3) * 64 + lane]);
      const float xc = cb + w0 * x0 + w1 * x1 + w2 * x2 + w3 * x3;
      xcf[t * 68 + lane] = xc;
      *(u16*)(xcb + swz128(t, lane >> 3) + (lane & 7) * 2) = f2bf(xc);
      x0 = x1; x1 = x2; x2 = x3;
    }
  }
  asm volatile("s_waitcnt lgkmcnt(0)" ::: "memory");
  float Av[2][16], Bv[2][16];
  {
    f32x16 acc[2][2];
#pragma unroll
    for (int gate = 0; gate < 2; ++gate)
#pragma unroll
      for (int nt = 0; nt < 2; ++nt) acc[gate][nt] = zero16();
#pragma unroll
    for (int s = 0; s < 4; ++s) {
      const bf16x8 af = *(const bf16x8*)(xcb + swz128(l31, 2 * s + hh));
#pragma unroll
      for (int gate = 0; gate < 2; ++gate)
#pragma unroll
        for (int nt = 0; nt < 2; ++nt) acc[gate][nt] = mfma32(af, wf[gate][nt][s], acc[gate][nt]);
    }
#pragma unroll
    for (int nt = 0; nt < 2; ++nt)
#pragma unroll
      for (int e = 0; e < 16; ++e) {
        const int tok = (e & 3) + 8 * (e >> 2) + 4 * hh;
        const float r = sigmoidf_(acc[0][nt][e] + cba[nt]);
        const float ii = sigmoidf_(acc[1][nt][e] + cbx[nt]);
        const float la = -8.0f * r * csp[nt];
        const float av = __expf(la);
        const float e2 = 2.0f * la;
        const float om = (e2 > -0.1f) ? (-e2 * (1.0f + e2 * (0.5f + e2 * (0.16666667f + e2 * 0.041666668f)))) : (1.0f - __expf(e2));
        Av[nt][e] = av;
        Bv[nt][e] = sqrtf(om) * ii * xcf[tok * 68 + nt * 32 + l31];
      }
  }
  float H[2][16];
#pragma unroll
  for (int nt = 0; nt < 2; ++nt)
#pragma unroll
    for (int e = 0; e < 16; ++e) H[nt][e] = 0.f;
  float carry[2] = {0.f, 0.f};
  float2* agg1 = (float2*)p.agg;
  float2* agg2 = (float2*)p.agg + (size_t)8 * 2 * 136 * 256;
  const int pos2 = dir ? (seg == 0 ? 1 - blk : 33 - blk) : (seg == 0 ? blk : 2 + blk);
  if (mode == 0) {
    if (dir) rg_scan32<1>(Av, Bv, carry, H, hh); else rg_scan32<0>(Av, Bv, carry, H, hh);
    float P[2];
#pragma unroll
    for (int nt = 0; nt < 2; ++nt) {
      float pr = 1.f;
#pragma unroll
      for (int e = 0; e < 16; ++e) pr *= Av[nt][e];
      P[nt] = pr * shx(pr, 32);
    }
    const float2 mine = make_float2(hh ? P[1] : P[0], hh ? carry[1] : carry[0]);
    agg1[((size_t)(b * 2 + dir) * 136 + cg32) * 256 + nblk * 64 + lane] = mine;
    blockagg[(ck * 2 + dir) * 64 + lane] = mine;
    __syncthreads();
    if (wid < 2) {
      const int d2 = wid;
      float A = 1.f, B = 0.f;
#pragma unroll
      for (int co = 0; co < 4; ++co) {
        const int c = d2 ? 3 - co : co;
        const float2 g = blockagg[(c * 2 + d2) * 64 + lane];
        B = g.x * B + g.y;
        A *= g.x;
      }
      const int p2 = d2 ? (seg == 0 ? 1 - blk : 33 - blk) : (seg == 0 ? blk : 2 + blk);
      agg2[((size_t)(b * 2 + d2) * 34 + p2) * 256 + nblk * 64 + lane] = make_float2(A, B);
    }
    __syncthreads();
    return;
  }
  {
    float h = 0.f;
    const float2* a2 = agg2 + ((size_t)(b * 2 + dir) * 34) * 256 + nblk * 64 + lane;
    int j = 0;
    for (; j + 8 <= pos2; j += 8) {
      float2 g[8];
#pragma unroll
      for (int u = 0; u < 8; ++u) g[u] = a2[(size_t)(j + u) * 256];
#pragma unroll
      for (int u = 0; u < 8; ++u) h = g[u].x * h + g[u].y;
    }
    for (; j < pos2; ++j) { const float2 g = a2[(size_t)j * 256]; h = g.x * h + g.y; }
    const float2* a1 = agg1 + ((size_t)(b * 2 + dir) * 136 + (cg32 - ck)) * 256 + nblk * 64 + lane;
    const int npre = dir ? 3 - ck : ck;
    for (int i = 0; i < npre; ++i) {
      const int c = dir ? 3 - i : i;
      const float2 g = a1[(size_t)c * 256];
      h = g.x * h + g.y;
    }
    carry[0] = shf(h, l31);
    carry[1] = shf(h, 32 + l31);
  }
  if (dir) rg_scan32<1>(Av, Bv, carry, H, hh); else rg_scan32<0>(Av, Bv, carry, H, hh);
  asm volatile("s_waitcnt lgkmcnt(0)" ::: "memory");
#pragma unroll
  for (int nt = 0; nt < 2; ++nt)
#pragma unroll
    for (int e = 0; e < 16; ++e) xcf[((e & 3) + 8 * (e >> 2) + 4 * hh) * 68 + nt * 32 + l31] = H[nt][e];
  __syncthreads();
  {
    const float* hfT = (const float*)(smem + (ck * 2 + 0) * 17408 + 8704);
    const float* hbT = (const float*)(smem + (ck * 2 + 1) * 17408 + 8704);
    const int tok = 16 * dir + (lane >> 2), c16 = (lane & 3) * 16;
    const size_t gtok = (size_t)tokbase + T0 + tok;
    const u16* gp = p.rg + gtok * 512 + 256 + nblk * 64 + c16;
    u16* op = p.ycat + gtok * 1024 + 768 + nblk * 64 + c16;
#pragma unroll
    for (int hv = 0; hv < 2; ++hv) {
      const uint4 g = *(const uint4*)(gp + hv * 8);
      const float4 f0 = *(const float4*)(hfT + tok * 68 + c16 + hv * 8), f1 = *(const float4*)(hfT + tok * 68 + c16 + hv * 8 + 4);
      const float4 h0 = *(const float4*)(hbT + tok * 68 + c16 + hv * 8), h1 = *(const float4*)(hbT + tok * 68 + c16 + hv * 8 + 4);
      uint4 o;
      o.x = pk2((f0.x + h0.x) * gelu_tanh(bflo(g.x)), (f0.y + h0.y) * gelu_tanh(bfhi(g.x)));
      o.y = pk2((f0.z + h0.z) * gelu_tanh(bflo(g.y)), (f0.w + h0.w) * gelu_tanh(bfhi(g.y)));
      o.z = pk2((f1.x + h1.x) * gelu_tanh(bflo(g.z)), (f1.y + h1.y) * gelu_tanh(bfhi(g.z)));
      o.w = pk2((f1.z + h1.z) * gelu_tanh(bflo(g.w)), (f1.w + h1.w) * gelu_tanh(bfhi(g.w)));
      *(uint4*)(op + hv * 8) = o;
    }
  }
  __syncthreads();
}

__device__ __forceinline__ void attn_wave(const P& p, int l, int b, int h, bool local, int r, int half, int qtok0, const float* rpbL) {
  const int lane = opaque_tid() & 63, q = lane & 31, hh = lane >> 5;
  bf16x8 qf[4];
  {
    const u16* qp = p.qk + (size_t)(qtok0 + q) * 1024 + h * 64 + 8 * hh;
#pragma unroll
    for (int s = 0; s < 4; ++s) qf[s] = *(const bf16x8*)(qp + 16 * s);
  }
  f32x16 o0 = zero16(), o1 = zero16();
  float m_run = -1e30f, l_run = 0.f;
  const int pi = (q & 19) | ((q & 4) << 1) | ((q & 8) >> 1);
  const int w = half * 32 + q;
  const int st = min(max(w - 8, 0), 48);
  const int rs = min(max(r - 4, 0), 56);
  const int ntiles = local ? 24 : 8;
  bf16x8 kfn[4], vfn[2][2];
  auto tile_load = [&](int ti, bf16x8 (&kfo)[4], bf16x8 (&vfo)[2][2]) {
    int ktok0, vstride;
    const u16* vb;
    if (ti < 8) {
      ktok0 = NLAT + b * 256 + ti * 32;
      vb = p.vTc + ((size_t)(b * 512 + h * 64)) * 256 + ti * 32;
      vstride = 256;
    } else {
      const int tl = ti - 8;
      const int a2 = tl >> 1, g2 = tl & 1;
      ktok0 = b * 4096 + (rs + a2) * 64 + g2 * 32;
      vb = p.vT + ((size_t)(b * 512 + h * 64)) * 4096 + (rs + a2) * 64 + g2 * 32;
      vstride = 4096;
    }
    const u16* kp = p.qk + (size_t)(ktok0 + pi) * 1024 + 512 + h * 64 + 8 * hh;
#pragma unroll
    for (int s = 0; s < 4; ++s) kfo[s] = *(const bf16x8*)(kp + 16 * s);
#pragma unroll
    for (int dt = 0; dt < 2; ++dt)
#pragma unroll
      for (int s2 = 0; s2 < 2; ++s2) vfo[dt][s2] = *(const bf16x8*)(vb + (size_t)(dt * 32 + q) * vstride + 16 * s2 + 8 * hh);
  };
  tile_load(0, kfn, vfn);
  for (int ti = 0; ti < ntiles; ++ti) {
    int a = 0, g = 0;
    if (ti >= 8) { a = (ti - 8) >> 1; g = (ti - 8) & 1; }
    bf16x8 kf[4], vf[2][2];
#pragma unroll
    for (int s = 0; s < 4; ++s) kf[s] = kfn[s];
#pragma unroll
    for (int dt = 0; dt < 2; ++dt)
#pragma unroll
      for (int s2 = 0; s2 < 2; ++s2) vf[dt][s2] = vfn[dt][s2];
    if (ti + 1 < ntiles) tile_load(ti + 1, kfn, vfn);
    f32x16 sacc = zero16();
#pragma unroll
    for (int s = 0; s < 4; ++s) sacc = mfma32(kf[s], qf[s], sacc);
    float sv[16];
    float tmax = -1e30f;
#pragma unroll
    for (int e = 0; e < 16; ++e) {
      float x = sacc[e] * 0.125f;
      if (ti >= 8) {
        const int kc = g * 32 + (e & 7) + 8 * hh + 16 * (e >> 3);
        const bool valid = (kc >= st) && (kc < st + 16);
        const int bi = valid ? ((rs + a - r + 7) * 31 + (kc - w + 15)) : 0;
        const float bias = rpbL[bi];
        x = valid ? (x + bias) : -1e30f;
      }
      sv[e] = x;
      tmax = fmaxf(tmax, x);
    }
    tmax = fmaxf(tmax, shx(tmax, 32));
    const float m_new = fmaxf(m_run, tmax);
    const float alpha = __expf(m_run - m_new);
    m_run = m_new;
    l_run *= alpha;
#pragma unroll
    for (int e = 0; e < 16; ++e) { o0[e] *= alpha; o1[e] *= alpha; }
    float psum = 0.f;
#pragma unroll
    for (int e = 0; e < 16; ++e) { const float pe = __expf(sv[e] - m_new); sv[e] = pe; psum += pe; }
    l_run += psum;
    bf16x8 pf[2];
#pragma unroll
    for (int s2 = 0; s2 < 2; ++s2) {
      union { bf16x8 v; unsigned u[4]; } cv;
#pragma unroll
      for (int j = 0; j < 4; ++j) cv.u[j] = pk2(sv[8 * s2 + 2 * j], sv[8 * s2 + 2 * j + 1]);
      pf[s2] = cv.v;
    }
#pragma unroll
    for (int s2 = 0; s2 < 2; ++s2) {
      o0 = mfma32(vf[0][s2], pf[s2], o0);
      o1 = mfma32(vf[1][s2], pf[s2], o1);
    }
  }
  const float lt = l_run + shx(l_run, 32);
  const float inv = 1.0f / lt;
  u16* op = p.ycat + (size_t)(qtok0 + q) * 1024 + h * 64;
#pragma unroll
  for (int qd = 0; qd < 4; ++qd) {
    uint2 a0, a1;
    a0.x = pk2(o0[4 * qd] * inv, o0[4 * qd + 1] * inv);
    a0.y = pk2(o0[4 * qd + 2] * inv, o0[4 * qd + 3] * inv);
    a1.x = pk2(o1[4 * qd] * inv, o1[4 * qd + 1] * inv);
    a1.y = pk2(o1[4 * qd + 2] * inv, o1[4 * qd + 3] * inv);
    *(uint2*)(op + 8 * qd + 4 * hh) = a0;
    *(uint2*)(op + 32 + 8 * qd + 4 * hh) = a1;
  }
}
__device__ __forceinline__ void attn_block_task(const P& p, int l, int b, int h, int rg4, char* smem) {
  const int tid = opaque_tid(), lane = tid & 63, wid = tid >> 6;
  const int q = lane & 31, hh = lane >> 5;
  const int R0 = rg4 * 4;
  const int r = R0 + (wid >> 1), half = wid & 1;
  float* rpbL = (float*)(smem + 32768) + 64;
  for (int i = tid; i < 465; i += NTHR) rpbL[i] = p.na_rpb[(size_t)(l * 8 + h) * 465 + i] * 1.4426950408889634f;
  const int lo = min(max(R0 - 4, 0), 56);
  const int hi = min(max(R0 + 3 - 4, 0), 56) + 7;
  const int ntile = 4 + (hi - lo + 1);
  const int rs = min(max(r - 4, 0), 56);
  const int qtok = b * 4096 + r * 64 + half * 32 + q;
  bf16x8 qf[4];
  {
    const u16* qp = p.qk + (size_t)qtok * 1024 + h * 64 + 8 * hh;
#pragma unroll
    for (int s = 0; s < 4; ++s) qf[s] = *(const bf16x8*)(qp + 16 * s);
  }
  f32x16 o0 = zero16(), o1 = zero16();
  float m_run = -1e30f, l_run = 0.f;
  const int pi = (q & 19) | ((q & 4) << 1) | ((q & 8) >> 1);
  const int w = half * 32 + q;
  const int st = min(max(w - 8, 0), 48);
  unsigned vmask = 0u;
#pragma unroll
  for (int g = 0; g < 2; ++g)
#pragma unroll
    for (int e = 0; e < 16; ++e) {
      const int kc = g * 32 + (e & 7) + 8 * hh + 16 * (e >> 3);
      vmask |= ((kc >= st) && (kc < st + 16)) ? (1u << (g * 16 + e)) : 0u;
    }
  const int cbase = 8 * hh - w + 15;
  const int srow = tid >> 3, sch = tid & 7;
  uint4 rkA, rvA, rkB, rvB;
  auto gload = [&](int ti, uint4& rk, uint4& rv) {
    int ktok0, vstride;
    const u16* vb;
    if (ti < 4) { ktok0 = NLAT + b * 256 + ti * 64; vb = p.vTc + ((size_t)(b * 512 + h * 64)) * 256 + ti * 64; vstride = 256; }
    else { const int R = lo + ti - 4; ktok0 = b * 4096 + R * 64; vb = p.vT + ((size_t)(b * 512 + h * 64)) * 4096 + R * 64; vstride = 4096; }
    rk = *(const uint4*)(p.qk + (size_t)(ktok0 + srow) * 1024 + 512 + h * 64 + sch * 8);
    rv = *(const uint4*)(vb + (size_t)srow * vstride + sch * 8);
  };
  gload(0, rkA, rvA);
  *(uint4*)(smem + swz128(srow, sch)) = rkA;
  *(uint4*)(smem + 16384 + swz128(srow, sch)) = rvA;
  gload(1, rkA, rvA);
  if (2 < ntile) gload(2, rkB, rvB);
  __syncthreads();
  auto compute = [&](int ti) {
    const char* Kb = smem + (ti & 1) * 8192;
    const char* Vb = smem + 16384 + (ti & 1) * 8192;
    const int R = lo + ti - 4;
    const bool active = (ti < 4) || (R >= rs && R < rs + 8);
    if (active) {
#pragma unroll
      for (int g = 0; g < 2; ++g) {
        f32x16 sacc = zero16();
#pragma unroll
        for (int s = 0; s < 4; ++s) {
          const bf16x8 kf = *(const bf16x8*)(Kb + swz128(g * 32 + pi, 2 * s + hh));
          sacc = mfma32(kf, qf[s], sacc);
        }
        float sv[16];
        float tmax = -1e30f;
        if (ti >= 4) {
          const float* brow = rpbL + (R - r + 7) * 31 + cbase + g * 32;
          float bias[16];
#pragma unroll
          for (int e = 0; e < 16; ++e) bias[e] = brow[(e & 7) + 16 * (e >> 3)];
#pragma unroll
          for (int e = 0; e < 16; ++e) {
            const float x = ((int)(vmask << (31 - (g * 16 + e))) < 0) ? fmaf(sacc[e], 0.18033688011112042f, bias[e]) : -1e30f;
            sv[e] = x;
            tmax = fmaxf(tmax, x);
          }
        } else {
#pragma unroll
          for (int e = 0; e < 16; ++e) {
            const float x = sacc[e] * 0.18033688011112042f;
            sv[e] = x;
            tmax = fmaxf(tmax, x);
          }
        }
        tmax = fmaxf(tmax, shx(tmax, 32));
        if (__builtin_amdgcn_ballot_w64(tmax > m_run) != 0ull) {
          const float m_new = fmaxf(m_run, tmax);
          const float alpha = __builtin_amdgcn_exp2f(m_run - m_new);
          m_run = m_new;
          l_run *= alpha;
#pragma unroll
          for (int e = 0; e < 16; ++e) { o0[e] *= alpha; o1[e] *= alpha; }
        }
        float psum = 0.f;
#pragma unroll
        for (int e = 0; e < 16; ++e) { const float pe = __builtin_amdgcn_exp2f(sv[e] - m_run); sv[e] = pe; psum += pe; }
        l_run += psum;
#pragma unroll
        for (int s2 = 0; s2 < 2; ++s2) {
          union { bf16x8 v; unsigned u[4]; } cv;
#pragma unroll
          for (int j = 0; j < 4; ++j) cv.u[j] = pk2(sv[8 * s2 + 2 * j], sv[8 * s2 + 2 * j + 1]);
          const bf16x8 v0 = *(const bf16x8*)(Vb + swz128(q, g * 4 + 2 * s2 + hh));
          const bf16x8 v1 = *(const bf16x8*)(Vb + swz128(32 + q, g * 4 + 2 * s2 + hh));
          o0 = mfma32(v0, cv.v, o0);
          o1 = mfma32(v1, cv.v, o1);
        }
      }
    }
  };
  for (int ti = 0; ti < ntile; ti += 2) {
    compute(ti);
    if (ti + 1 < ntile) {
      *(uint4*)(smem + 8192 + swz128(srow, sch)) = rkA;
      *(uint4*)(smem + 16384 + 8192 + swz128(srow, sch)) = rvA;
      if (ti + 3 < ntile) gload(ti + 3, rkA, rvA);
    }
    __syncthreads();
    if (ti + 1 < ntile) {
      compute(ti + 1);
      if (ti + 2 < ntile) {
        *(uint4*)(smem + swz128(srow, sch)) = rkB;
        *(uint4*)(smem + 16384 + swz128(srow, sch)) = rvB;
        if (ti + 4 < ntile) gload(ti + 4, rkB, rvB);
      }
      __syncthreads();
    }
  }
  const float lt = l_run + shx(l_run, 32);
  const float inv = 1.0f / lt;
  __syncthreads();
  {
    char* ot = smem + wid * 4608;
#pragma unroll
    for (int qd = 0; qd < 4; ++qd) {
      uint2 a0, a1;
      a0.x = pk2(o0[4 * qd] * inv, o0[4 * qd + 1] * inv);
      a0.y = pk2(o0[4 * qd + 2] * inv, o0[4 * qd + 3] * inv);
      a1.x = pk2(o1[4 * qd] * inv, o1[4 * qd + 1] * inv);
      a1.y = pk2(o1[4 * qd + 2] * inv, o1[4 * qd + 3] * inv);
      *(uint2*)(ot + q * 144 + (8 * qd + 4 * hh) * 2) = a0;
      *(uint2*)(ot + q * 144 + (32 + 8 * qd + 4 * hh) * 2) = a1;
    }
    asm volatile("s_waitcnt lgkmcnt(0)" ::: "memory");
    const int tok0 = b * 4096 + r * 64 + half * 32;
#pragma unroll
    for (int it = 0; it < 4; ++it) {
      const int qq = it * 8 + (lane >> 3), ch = lane & 7;
      const uint4 v = *(const uint4*)(ot + qq * 144 + ch * 16);
      *(uint4*)(p.ycat + (size_t)(tok0 + qq) * 1024 + h * 64 + ch * 8) = v;
    }
  }
  __syncthreads();
}
__device__ __forceinline__ void attn_task(const P& p, int l, int kind, int idx, char* smem) {
  const int tid_ = opaque_tid(); const int lane = tid_ & 63, wid = tid_ >> 6;
  float* rpbL = (float*)smem + wid * 480;
  for (int i = lane; i < 465; i += 64) rpbL[i] = p.na_rpb[(size_t)(l * 8 + wid) * 465 + i];
  __syncthreads();
  if (kind == 0) {
    const int half = idx & 1, r = (idx >> 1) & 63, b = idx >> 7;
    attn_wave(p, l, b, wid, true, r, half, b * 4096 + r * 64 + half * 32, rpbL);
  } else {
    const int qg = idx & 7, b = idx >> 3;
    attn_wave(p, l, b, wid, false, 0, 0, NLAT + b * 256 + qg * 32, rpbL);
  }
  __syncthreads();
}

__device__ __forceinline__ void phase_mixers(const P& p, int l, char* smem, unsigned* counter) {
  const bool last = (l == 1);
  const int n_rg = 1088 * XRGA, n_fft = 1024 * XFFT, n_hc = last ? 0 : 256, n_att = 1024 * XATT, n_attc = last ? 0 : 64;
  const int total = n_rg + n_fft + n_hc + n_att + n_attc;
  volatile int* s_taskp = (volatile int*)(smem + SMEM_BYTES - 16);
  for (;;) {
    __syncthreads();
    if (threadIdx.x == 0) *s_taskp = (int)atomicAdd(counter, 1u);
    __syncthreads();
    int t = *s_taskp;
    if (t >= total) break;
    if (t < n_att) { t &= 1023; attn_block_task(p, l, t >> 7, (t >> 4) & 7, t & 15, smem); continue; }
    t -= n_att;
    if (t < n_attc) { attn_task(p, l, 1, t, smem); continue; }
    t -= n_attc;
    if (t < n_fft) { t &= 1023; hyena_fft_task(p, l, t >> 2, t & 3, smem); continue; }
    t -= n_fft;
    if (t < n_hc) { hyena_ctx_task(p, l, t >> 5, t & 31, smem); continue; }
    t -= n_hc;
    if (t >= 1088) t -= 1088;
    rg_wave_task(p, l, t >> 2, t & 3, 0, last, smem);
  }
}

__device__ __forceinline__ void merge_tile(const P& p, int l, int mt, int nt, char* smem) {
  EPI_VARS
  const int m0 = mt * 256, n0 = nt * 128;
  f32x16 macc[2][2];
  zero_acc(macc);
  for (int br = 0; br < 3; ++br) {
    unsigned* gpl = (unsigned*)(smem + 98304) + tid;
    {
      f32x16 acc[2][2];
      zero_acc(acc);
      gemm_kloop(acc, p.xn + (size_t)m0 * 1024, 1024, p.WgT + ((size_t)l * 3072 + br * 1024 + n0) * 1024, 1024, 1024, smem);
#pragma unroll
      for (int j = 0; j < 2; ++j) {
        const float bg = p.b_gate[l * 3072 + br * 1024 + n0 + EPI_COL(j)];
#pragma unroll
        for (int i = 0; i < 2; ++i)
#pragma unroll
          for (int e = 0; e < 4; ++e) {
            const unsigned q0 = (unsigned)(sigmoidf_(acc[i][j][4 * e] + bg) * 255.0f + 0.5f);
            const unsigned q1 = (unsigned)(sigmoidf_(acc[i][j][4 * e + 1] + bg) * 255.0f + 0.5f);
            const unsigned q2 = (unsigned)(sigmoidf_(acc[i][j][4 * e + 2] + bg) * 255.0f + 0.5f);
            const unsigned q3 = (unsigned)(sigmoidf_(acc[i][j][4 * e + 3] + bg) * 255.0f + 0.5f);
            gpl[((i * 2 + j) * 4 + e) * 512] = q0 | (q1 << 8) | (q2 << 16) | (q3 << 24);
          }
      }
    }
    {
      f32x16 acc[2][2];
      zero_acc(acc);
      const u16* A; const u16* B; int K;
      if (br == 0) { A = p.ycat + (size_t)m0 * 1024; B = p.WaT + ((size_t)l * 1024 + n0) * 512; K = 512; }
      else if (br == 1) { A = p.ycat + (size_t)m0 * 1024 + 512; B = p.WbT + ((size_t)l * 1024 + n0) * 256; K = 256; }
      else { A = p.ycat + (size_t)m0 * 1024 + 768; B = p.WcT + ((size_t)l * 1024 + n0) * 256; K = 256; }
      gemm_kloop(acc, A, 1024, B, K, K, smem);
#pragma unroll
      for (int i = 0; i < 2; ++i)
#pragma unroll
        for (int j = 0; j < 2; ++j)
#pragma unroll
          for (int e = 0; e < 4; ++e) {
            const unsigned g4 = gpl[((i * 2 + j) * 4 + e) * 512];
            macc[i][j][4 * e] += (float)(g4 & 255u) * (1.0f / 255.0f) * acc[i][j][4 * e];
            macc[i][j][4 * e + 1] += (float)((g4 >> 8) & 255u) * (1.0f / 255.0f) * acc[i][j][4 * e + 1];
            macc[i][j][4 * e + 2] += (float)((g4 >> 16) & 255u) * (1.0f / 255.0f) * acc[i][j][4 * e + 2];
            macc[i][j][4 * e + 3] += (float)(g4 >> 24) * (1.0f / 255.0f) * acc[i][j][4 * e + 3];
          }
    }
  }
#pragma unroll
  for (int i = 0; i < 2; ++i)
#pragma unroll
    for (int j = 0; j < 2; ++j)
#pragma unroll
      for (int e = 0; e < 16; ++e)
        p.mbuf[(size_t)(m0 + EPI_ROW(i, e)) * 1024 + n0 + EPI_COL(j)] = f2bf(macc[i][j][e]);
}
__device__ __forceinline__ void outproj_tile(const P& p, int l, int mt, int nt, char* smem, bool do_store) {
  EPI_VARS
  const int m0 = mt * 256, n0 = nt * 128;
  f32x16 acc[2][2];
  zero_acc(acc);
  gemm_kloop(acc, p.mbuf + (size_t)m0 * 1024, 1024, p.WoT + ((size_t)l * 1024 + n0) * 1024, 1024, 1024, smem);
  const bool isctx = (mt >= 128);
  const int bi = isctx ? 8 : (mt >> 4);
  const float* gatev = p.mod + ((size_t)(l * 9 + bi) * 6 + 2) * 1024;
  const float* src; float* dst;
  if (isctx) { src = (l == 0 ? p.ctx : p.ctxs) - (size_t)NLAT * 1024; dst = p.ctxs - (size_t)NLAT * 1024; }
  else { src = (l == 0 ? p.x : p.out); dst = p.out; }
#pragma unroll
  for (int j = 0; j < 2; ++j) {
    const int col = n0 + EPI_COL(j);
    const float gv = gatev[col];
#pragma unroll
    for (int i = 0; i < 2; ++i)
#pragma unroll
      for (int e = 0; e < 16; ++e) {
        const size_t o = (size_t)(m0 + EPI_ROW(i, e)) * 1024 + col;
        if (do_store) dst[o] = src[o] + gv * acc[i][j][e];
      }
  }
}

__device__ __forceinline__ void wqk_task(const P& p, int l, int hp, int nt, char* smem) {
  EPI_VARS
  f32x16 acc[2][2];
  zero_acc(acc);
  gemm_kloop(acc, p.keysB + ((size_t)l * 16 + hp) * 16384, 128, p.WqB + (size_t)l * 1024 * 2048 + (size_t)(nt * 128) * 2048 + hp * 128, 2048, 128, smem);
  if (wm < 2) {
#pragma unroll
    for (int i = 0; i < 2; ++i)
#pragma unroll
      for (int j = 0; j < 2; ++j)
#pragma unroll
        for (int e = 0; e < 16; ++e)
          p.WqkT[((size_t)l * 2048 + hp * 128 + EPI_ROW(i, e)) * 1024 + nt * 128 + EPI_COL(j)] = f2bf(acc[i][j][e]);
  }
}
__device__ __forceinline__ void ins16(unsigned (&L)[16], unsigned x) {
#pragma unroll
  for (int i = 0; i < 16; ++i) {
    const unsigned hi = max(L[i], x);
    x = min(L[i], x);
    L[i] = hi;
  }
}
__device__ __forceinline__ unsigned f2sort(float f) {
  const unsigned b = __float_as_uint(f);
  return b ^ ((unsigned)((int)b >> 31) | 0x80000000u);
}
__device__ __forceinline__ float sort2f(unsigned k) {
  const unsigned u = k & ~127u;
  const unsigned b = (u & 0x80000000u) ? (u ^ 0x80000000u) : ~u;
  return __uint_as_float(b);
}
__device__ __forceinline__ void cx_desc(unsigned& a, unsigned& b) { const unsigned hi = max(a, b), lo = min(a, b); a = hi; b = lo; }
template <int BASE> __device__ __forceinline__ void sort16_desc(unsigned (&k)[64]) {
#pragma unroll
  for (int sz = 2; sz <= 16; sz <<= 1) {
#pragma unroll
    for (int j = sz >> 1; j >= 1; j >>= 1) {
#pragma unroll
      for (int i = 0; i < 16; ++i) {
        const int l2 = i ^ j;
        if (l2 > i) {
          if ((i & sz) == 0) cx_desc(k[BASE + i], k[BASE + l2]);
          else cx_desc(k[BASE + l2], k[BASE + i]);
        }
      }
    }
  }
}
template <int AB, int BB> __device__ __forceinline__ void merge16_desc(unsigned (&k)[64]) {
#pragma unroll
  for (int i = 0; i < 16; ++i) k[AB + i] = max(k[AB + i], k[BB + 15 - i]);
#pragma unroll
  for (int j = 8; j >= 1; j >>= 1) {
#pragma unroll
    for (int i = 0; i < 16; ++i)
      if ((i & j) == 0) cx_desc(k[AB + i], k[AB + i + j]);
  }
}
__device__ __forceinline__ void peer_score_tile(const P& p, int l, int mt, int hp, char* smem) {
  const int tid = opaque_tid();
  const int m0 = mt * 256;
  const int row = tid >> 1, hf = tid & 1;
  {
    char* T = smem + 16384;
#pragma unroll
    for (int it = 0; it < 8; ++it) {
      const int id = tid + NTHR * it;
      const int r = id >> 4, ch = id & 15;
      *(uint4*)(T + r * 272 + ch * 16) = *(const uint4*)(p.q + (size_t)(m0 + r) * 2048 + hp * 128 + ch * 8);
    }
  }
  __syncthreads();
  const char* sp = smem + 16384 + row * 272 + hf * 128;
  unsigned k[64];
#pragma unroll
  for (int c = 0; c < 8; ++c) {
    const uint4 r = *(const uint4*)(sp + 16 * c);
    const unsigned w[4] = {r.x, r.y, r.z, r.w};
#pragma unroll
    for (int q = 0; q < 4; ++q) {
      const float v0 = __builtin_bit_cast(_Float16, (unsigned short)(w[q] & 0xffffu));
      const float v1 = __builtin_bit_cast(_Float16, (unsigned short)(w[q] >> 16));
      const int key = hf * 64 + c * 8 + q * 2;
      k[c * 8 + q * 2] = (f2sort(v0) & ~127u) | (unsigned)key;
      k[c * 8 + q * 2 + 1] = (f2sort(v1) & ~127u) | (unsigned)(key + 1);
    }
  }
  sort16_desc<0>(k); sort16_desc<16>(k); sort16_desc<32>(k); sort16_desc<48>(k);
  merge16_desc<0, 16>(k);
  merge16_desc<32, 48>(k);
  merge16_desc<0, 32>(k);
  unsigned* X = (unsigned*)smem;
  if (hf) {
#pragma unroll
    for (int i = 0; i < 16; ++i) X[row * 16 + i] = k[i];
  }
  __syncthreads();
  if (!hf) {
#pragma unroll
    for (int i = 0; i < 16; ++i) k[16 + i] = X[row * 16 + i];
    merge16_desc<0, 16>(k);
    unsigned* o = p.topk + ((size_t)(m0 + row) * 16 + hp) * 16;
#pragma unroll
    for (int i = 0; i < 4; ++i) *(uint4*)(o + 4 * i) = make_uint4(k[4 * i], k[4 * i + 1], k[4 * i + 2], k[4 * i + 3]);
  }
  __syncthreads();
}

__device__ __forceinline__ void phase_peer_experts(const P& p, int l, bool do_store, char* smem) {
  const int tid_ = opaque_tid(); const int lane = tid_ & 63, wid = tid_ >> 6;
  const int ntok = (l == 1) ? NLAT : NTOK;
  int ci, cj;
  {
    const int e = lane;
    if (e < 16) { ci = 0; cj = e; }
    else if (e < 24) { ci = 1; cj = e - 16; }
    else if (e < 29) { ci = 2; cj = e - 24; }
    else if (e < 33) { ci = 3; cj = e - 29; }
    else if (e < 36) { ci = 4; cj = e - 33; }
    else if (e < 38) { ci = 5; cj = e - 36; }
    else if (e < 40) { ci = 6; cj = e - 38; }
    else if (e < 42) { ci = 7; cj = e - 40; }
    else { ci = min(8 + (e - 42), 15); cj = 0; }
  }
  for (int tok = blockIdx.x * 8 + wid; tok < ntok; tok += gridDim.x * 8) {
    float xr[16];
    {
      const uint4 a = *(const uint4*)(p.xn + (size_t)tok * 1024 + lane * 16);
      const uint4 b = *(const uint4*)(p.xn + (size_t)tok * 1024 + lane * 16 + 8);
      xr[0] = bflo(a.x); xr[1] = bfhi(a.x); xr[2] = bflo(a.y); xr[3] = bfhi(a.y);
      xr[4] = bflo(a.z); xr[5] = bfhi(a.z); xr[6] = bflo(a.w); xr[7] = bfhi(a.w);
      xr[8] = bflo(b.x); xr[9] = bfhi(b.x); xr[10] = bflo(b.y); xr[11] = bfhi(b.y);
      xr[12] = bflo(b.z); xr[13] = bfhi(b.z); xr[14] = bflo(b.w); xr[15] = bfhi(b.w);
    }
    float yacc[16];
#pragma unroll
    for (int i = 0; i < 16; ++i) yacc[i] = 0.f;
    int* selw = (int*)(smem + wid * 4096);
    const unsigned* kvp = p.topk + (size_t)tok * 256 + (lane & 31);
    unsigned kv_next = kvp[0];
#pragma unroll 1
    for (int h = 0; h < 8; ++h) {
      const unsigned kv = kv_next;
      if (h < 7) kv_next = kvp[(h + 1) * 32];
      const unsigned k0 = shu(kv, ci);
      const unsigned k1 = shu(kv, 16 + cj);
      const float val = (lane < 50) ? (sort2f(k0) + sort2f(k1)) : -3.0e38f;
      const int eidx = (int)((k0 & 127u) * 128u + (k1 & 127u));
      float sv = val; int si = eidx;
#pragma unroll
      for (int k = 2; k <= 64; k <<= 1) {
#pragma unroll
        for (int j = k >> 1; j >= 1; j >>= 1) {
          const float ov = __builtin_bit_cast(float, __builtin_amdgcn_ds_bpermute((lane ^ j) << 2, __builtin_bit_cast(int, sv)));
          const int oi = __builtin_amdgcn_ds_bpermute((lane ^ j) << 2, si);
          const bool take_max = (((lane & j) == 0) == ((lane & k) == 0));
          const bool sw = take_max ? (ov > sv) : (ov < sv);
          sv = sw ? ov : sv;
          si = sw ? oi : si;
        }
      }
      const float mx = __builtin_bit_cast(float, __builtin_amdgcn_readlane(__builtin_bit_cast(int, sv), 0));
      const float ex = (lane < 16) ? __builtin_amdgcn_exp2f((sv - mx) * 1.4426950408889634f) : 0.f;
      const float sm = wave_sum(ex);
      selw[h * 64 + lane] = si;
      selw[512 + h * 64 + lane] = __builtin_bit_cast(int, ex * __builtin_amdgcn_rcpf(sm));
    }
#pragma unroll 1
    for (int h = 0; h < 8; ++h) {
      const int eperm_h = selw[h * 64 + lane];
      const int gperm_h = selw[512 + h * 64 + lane];
      uint2 U[16], V[16];
#pragma unroll
      for (int k = 0; k < 16; ++k) {
        const int id = __builtin_amdgcn_readlane(eperm_h, k);
        const uint4 rec = *(const uint4*)(p.Ub + (size_t)id * 1024 + lane * 16);
        U[k] = make_uint2(rec.x, rec.y);
        V[k] = make_uint2(rec.z, rec.w);
      }
      float d[16];
#pragma unroll
      for (int k = 0; k < 16; ++k) {
        const unsigned uw[2] = {U[k].x, U[k].y};
        float dd = 0.f;
#pragma unroll
        for (int q2 = 0; q2 < 2; ++q2) {
          const f32x2 e0 = __builtin_amdgcn_cvt_scalef32_pk_f32_fp4(uw[q2], 1.0f, 0);
          const f32x2 e1 = __builtin_amdgcn_cvt_scalef32_pk_f32_fp4(uw[q2], 1.0f, 1);
          const f32x2 e2 = __builtin_amdgcn_cvt_scalef32_pk_f32_fp4(uw[q2], 1.0f, 2);
          const f32x2 e3 = __builtin_amdgcn_cvt_scalef32_pk_f32_fp4(uw[q2], 1.0f, 3);
          dd += xr[8 * q2] * e0.x + xr[8 * q2 + 1] * e0.y + xr[8 * q2 + 2] * e1.x + xr[8 * q2 + 3] * e1.y +
                xr[8 * q2 + 4] * e2.x + xr[8 * q2 + 5] * e2.y + xr[8 * q2 + 6] * e3.x + xr[8 * q2 + 7] * e3.y;
        }
        d[k] = dd;
      }
      {
        const bool b5 = (lane & 32) != 0, b4 = (lane & 16) != 0, b3 = (lane & 8) != 0, b2 = (lane & 4) != 0;
#pragma unroll
        for (int j = 0; j < 8; ++j) { const float keep = b5 ? d[j + 8] : d[j], send = b5 ? d[j] : d[j + 8]; d[j] = keep + shx(send, 32); }
#pragma unroll
        for (int j = 0; j < 4; ++j) { const float keep = b4 ? d[j + 4] : d[j], send = b4 ? d[j] : d[j + 4]; d[j] = keep + shx(send, 16); }
#pragma unroll
        for (int j = 0; j < 2; ++j) { const float keep = b3 ? d[j + 2] : d[j], send = b3 ? d[j] : d[j + 2]; d[j] = keep + shx(send, 8); }
        { const float keep = b2 ? d[1] : d[0], send = b2 ? d[0] : d[1]; d[0] = keep + shx(send, 4); }
        d[0] += shx(d[0], 2);
        d[0] += shx(d[0], 1);
      }
      const float gl = __builtin_bit_cast(float, shu((unsigned)gperm_h, (lane >> 2) & 15));
      const float act = gelu_tanh(d[0] * (1.0f / 64.0f)) * gl;
#pragma unroll
      for (int k = 0; k < 16; ++k) {
        const float ak = __builtin_bit_cast(float, __builtin_amdgcn_readlane(__builtin_bit_cast(int, act), 4 * k));
        const unsigned vw[2] = {V[k].x, V[k].y};
#pragma unroll
        for (int q2 = 0; q2 < 2; ++q2) {
          const f32x2 e0 = __builtin_amdgcn_cvt_scalef32_pk_f32_fp4(vw[q2], 1.0f, 0);
          const f32x2 e1 = __builtin_amdgcn_cvt_scalef32_pk_f32_fp4(vw[q2], 1.0f, 1);
          const f32x2 e2 = __builtin_amdgcn_cvt_scalef32_pk_f32_fp4(vw[q2], 1.0f, 2);
          const f32x2 e3 = __builtin_amdgcn_cvt_scalef32_pk_f32_fp4(vw[q2], 1.0f, 3);
          yacc[8 * q2] += ak * e0.x; yacc[8 * q2 + 1] += ak * e0.y; yacc[8 * q2 + 2] += ak * e1.x; yacc[8 * q2 + 3] += ak * e1.y;
          yacc[8 * q2 + 4] += ak * e2.x; yacc[8 * q2 + 5] += ak * e2.y; yacc[8 * q2 + 6] += ak * e3.x; yacc[8 * q2 + 7] += ak * e3.y;
        }
      }
    }
    const int bi = tok < NLAT ? (tok >> 12) : 8;
    const float* gv = p.mod + ((size_t)(l * 9 + bi) * 6 + 5) * 1024 + lane * 16;
    float* xp = (tok < NLAT) ? (p.out + (size_t)tok * 1024) : (p.ctxs + (size_t)(tok - NLAT) * 1024);
    xp += lane * 16;
    float4 xv[4];
    float ss = 0.f;
#pragma unroll
    for (int i = 0; i < 4; ++i) {
      xv[i] = *(float4*)(xp + 4 * i);
      const float4 g4 = *(const float4*)(gv + 4 * i);
      xv[i].x += g4.x * yacc[4 * i] * 0.25f; xv[i].y += g4.y * yacc[4 * i + 1] * 0.25f; xv[i].z += g4.z * yacc[4 * i + 2] * 0.25f; xv[i].w += g4.w * yacc[4 * i + 3] * 0.25f;
      ss += xv[i].x * xv[i].x + xv[i].y * xv[i].y + xv[i].z * xv[i].z + xv[i].w * xv[i].w;
    }
    ss = wave_sum(ss);
    const float rstd = rsqrtf(ss * (1.0f / 1024.0f) + 1e-6f);
    if (l == 0) {
      const float* gam = p.norm_mix_g + 1024 + lane * 16;
      const float* msh = p.mod + ((size_t)(9 + bi) * 6 + 0) * 1024 + lane * 16;
      const float* msc = msh + 1024;
      float yv[16];
      float amax = 0.f;
#pragma unroll
      for (int i = 0; i < 4; ++i) {
        if (do_store) *(float4*)(xp + 4 * i) = xv[i];
        const float4 g = *(const float4*)(gam + 4 * i);
        const float4 sh = *(const float4*)(msh + 4 * i);
        const float4 sc = *(const float4*)(msc + 4 * i);
        yv[4 * i] = xv[i].x * rstd * g.x * (1.f + sc.x) + sh.x; yv[4 * i + 1] = xv[i].y * rstd * g.y * (1.f + sc.y) + sh.y;
        yv[4 * i + 2] = xv[i].z * rstd * g.z * (1.f + sc.z) + sh.z; yv[4 * i + 3] = xv[i].w * rstd * g.w * (1.f + sc.w) + sh.w;
      }
#pragma unroll
      for (int i = 0; i < 16; ++i) amax = fmaxf(amax, fabsf(yv[i]));
      amax = fmaxf(wave_max(amax), 1e-20f);
      const float inv = 127.0f / amax;
      unsigned w[4];
#pragma unroll
      for (int i = 0; i < 4; ++i)
        w[i] = ((unsigned)__float2int_rn(yv[4 * i] * inv) & 255u) | (((unsigned)__float2int_rn(yv[4 * i + 1] * inv) & 255u) << 8) |
               (((unsigned)__float2int_rn(yv[4 * i + 2] * inv) & 255u) << 16) | (((unsigned)__float2int_rn(yv[4 * i + 3] * inv) & 255u) << 24);
      if (do_store) {
        *(uint4*)(p.xn8 + (size_t)tok * 1024 + lane * 16) = make_uint4(w[0], w[1], w[2], w[3]);
        if (lane == 0) p.sa[tok] = amax * (1.0f / 127.0f);
      }
    } else {
      const float* fg = p.final_g + lane * 16;
#pragma unroll
      for (int i = 0; i < 4; ++i) {
        const float4 g = *(const float4*)(fg + 4 * i);
        const float4 o = make_float4(xv[i].x * rstd * g.x, xv[i].y * rstd * g.y, xv[i].z * rstd * g.z, xv[i].w * rstd * g.w);
        if (do_store) *(float4*)(xp + 4 * i) = o;
      }
    }
  }
}


#define XB_TMO      128
#define XB_XCNT(j)  (256  + 64 * (j))
#define XB_XSUB(j)  (1280 + 64 * (j))
#define XB_XGEN(j)  (2304 + 64 * (j))
#define XB_TOP      3328
#define XB_TOPGEN   3392
#define XCD_BAR_WORDS 3456
#define XB_SPIN_CAP (1u << 22)
#define LAS __attribute__((address_space(3)))
__device__ __forceinline__ unsigned xb_ld(unsigned* p) { return __hip_atomic_load(p, __ATOMIC_RELAXED, __HIP_MEMORY_SCOPE_AGENT); }
__device__ __forceinline__ unsigned xb_add(unsigned* p, unsigned v) { return __hip_atomic_fetch_add(p, v, __ATOMIC_RELAXED, __HIP_MEMORY_SCOPE_AGENT); }
__device__ __forceinline__ unsigned xb_xcc_id() { return (unsigned)__builtin_amdgcn_s_getreg((3 << 11) | 20) & 0xFu; }
#define XB_SPIN(cond, bar) do { unsigned _sp = 0; while (cond) { __builtin_amdgcn_s_sleep(1); \
    if ((++_sp & 255u) == 0u) { if (xb_ld(&(bar)[XB_TMO])) break; if (_sp > XB_SPIN_CAP) { atomicAdd(&(bar)[XB_TMO], 1u); break; } } } } while (0)
struct XcdBarrier { unsigned* bar; unsigned x; volatile LAS unsigned* st; };
__device__ __forceinline__ XcdBarrier xcd_barrier_post(unsigned* bar, volatile LAS unsigned* st) {
  XcdBarrier b; b.bar = bar; b.x = xb_xcc_id(); b.st = st;
  if (threadIdx.x == 0) (void)xb_add(&bar[XB_XCNT(b.x)], 1u);
  return b;
}
__device__ __forceinline__ void xcd_barrier_complete(unsigned* bar, unsigned x, unsigned& nloc, unsigned& nx) {
  const unsigned G = gridDim.x * gridDim.y * gridDim.z;
  unsigned sum, cnt, mine, sp = 0u;
  for (;;) {
    sum = 0u; cnt = 0u; mine = 0u;
#pragma unroll
    for (unsigned j = 0; j < 16; ++j) { const unsigned c = xb_ld(&bar[XB_XCNT(j)]); sum += c; cnt += (c > 0u) ? 1u : 0u; mine = (j == x) ? c : mine; }
    if (sum == G) break;
    __builtin_amdgcn_s_sleep(1);
    if ((++sp & 255u) == 0u) { if (xb_ld(&bar[XB_TMO])) break; if (sp > XB_SPIN_CAP) { atomicAdd(&bar[XB_TMO], 1u); break; } }
  }
  nloc = mine > 0u ? mine : 1u; nx = cnt > 0u ? cnt : 1u;
}
__device__ __forceinline__ void xcd_barrier(unsigned* bar_u, volatile LAS unsigned* st_u) {
  XcdBarrier b; b.bar = bar_u; b.x = xb_xcc_id(); b.st = st_u;
  asm volatile("s_waitcnt vmcnt(0)" ::: "memory");
  __syncthreads();
  if (threadIdx.x == 0) {
    unsigned long long bp_ = (unsigned long long)b.bar;
    asm volatile("" : "+v"(bp_));
    unsigned* bar = (unsigned*)bp_;
    __builtin_amdgcn_s_waitcnt(0);
    unsigned nloc = b.st[0], nx = b.st[1];
    if (nloc == 0u) { xcd_barrier_complete(bar, b.x, nloc, nx); b.st[0] = nloc; b.st[1] = nx; }
    const unsigned old = xb_add(&bar[XB_XSUB(b.x)], 1u);
    const unsigned gen = old / nloc;
    if (old + 1u == (gen + 1u) * nloc) {
      __builtin_amdgcn_fence(__ATOMIC_RELEASE, "agent");
      asm volatile("s_waitcnt vmcnt(0)" ::: "memory");
      const unsigned og = xb_add(&bar[XB_TOP], 1u);
      const unsigned tg = og / nx;
      if (og + 1u == (tg + 1u) * nx) xb_add(&bar[XB_TOPGEN], 1u);
      else XB_SPIN(xb_ld(&bar[XB_TOPGEN]) == tg, bar);
      __builtin_amdgcn_fence(__ATOMIC_ACQUIRE, "agent");
      xb_add(&bar[XB_XGEN(b.x)], 1u);
      asm volatile("s_waitcnt vmcnt(0)" ::: "memory");
    } else {
      XB_SPIN(xb_ld(&bar[XB_XGEN(b.x)]) == gen, bar);
      __builtin_amdgcn_fence(__ATOMIC_ACQUIRE, "agent");
      asm volatile("s_waitcnt vmcnt(0)" ::: "memory");
    }
  }
  __syncthreads();
}

template <int l>
__device__ __forceinline__ void layer_body(const P& p, char* smem, pg8::PG8_LAS_T lds, volatile LAS unsigned* xbw, const int nb, const int bid) {
    const bool last = (l == 1);
    const int n_mt = last ? 128 : 136;
    if (l == 0) {
      phase_norm(p, l, 0);
      xcd_barrier(p.counters + 1024, xbw);
    }
_Pragma("unroll 1")
    for (int rep = 0; rep < REP_INPROJ; ++rep) {
      pg8::Gemm g; pg8::Order S;
      g.A = (const u16*)p.xn8; g.Bt = (const u16*)(p.Win8 + (size_t)l * 2816 * 1024); g.lda = 512; g.ldb = 512; g.K = 512;
      S.init(136, 6, nb, bid, 4, 5);
      pg8::EpiInprojN8 e1; e1.qk = p.qk; e1.rg = p.rg; e1.sa = p.sa; e1.sw = p.sw + l * 5888;
      pg8::gemm_phase(lds, g, S, e1);
      g.A = (const u16*)(p.Win8 + ((size_t)l * 2816 + 1024) * 1024); g.Bt = (const u16*)p.xn8;
      S.init(5, 136, nb, bid);
      pg8::EpiInprojT8 e2; e2.vT = p.vT; e2.sa = p.sa; e2.sw = p.sw + l * 5888 + 1024;
      pg8::gemm_phase(lds, g, S, e2);
    }
    xcd_barrier(p.counters + 1024, xbw);
    phase_mixers(p, l, smem, p.counters + l * 4);
    xcd_barrier(p.counters + 1024, xbw);
_Pragma("unroll 1")
    for (int rep = 0; rep < REP_2B; ++rep)
      for (int task = bid; task < 1088 + 512; task += nb) {
        if (task < 1088) rg_wave_task(p, l, task >> 2, task & 3, 1, last, smem);
        else yb_transpose_task(p, (task - 1088) >> 6, (task - 1088) & 63, smem);
      }
    xcd_barrier(p.counters + 1024, xbw);
_Pragma("unroll 1")
    for (int rep = 0; rep < REP_GATE; ++rep) {
      pg8::Gemm g; pg8::Order S;
      g.A = (const u16*)p.xn8; g.Bt = (const u16*)(p.Wg8 + (size_t)l * 3072 * 1024); g.lda = 512; g.ldb = 512; g.K = 512;
      S.init(n_mt, 12, nb, bid);
      pg8::EpiGate8 e; e.g8 = p.g8; e.bias = p.b_gate + l * 3072; e.sa = p.sa; e.sw = p.sw + l * 5888 + 2816;
      pg8::gemm_phase(lds, g, S, e);
    }
    xcd_barrier(p.counters + 1024, xbw);
_Pragma("unroll 1")
    for (int rep = 0; rep < REP_BRANCH; ++rep) {
      pg8::Gemm g; pg8::Order S;
      S.init(n_mt, 4, nb, bid);
      pg8::EpiBranch e; e.mbuf = p.mbuf; e.g8 = p.g8;
      g.lda = 1024;
      g.A = p.ycat; g.Bt = p.WaT + (size_t)l * 1024 * 512; g.ldb = 512; g.K = 512; e.br = 0;
      pg8::gemm_phase(lds, g, S, e);
      g.A = p.ycat + 512; g.Bt = p.WbT + (size_t)l * 1024 * 256; g.ldb = 256; g.K = 256; e.br = 1;
      pg8::gemm_phase(lds, g, S, e);
      g.A = p.ycat + 768; g.Bt = p.WcT + (size_t)l * 1024 * 256; g.ldb = 256; g.K = 256; e.br = 2;
      pg8::gemm_phase(lds, g, S, e);
    }
    xcd_barrier(p.counters + 1024, xbw);
    {
      pg8::Gemm g; pg8::Order S;
      g.A = p.mbuf; g.Bt = p.WoT + (size_t)l * 1024 * 1024; g.lda = 1024; g.ldb = 1024; g.K = 1024;
      S.init(n_mt, 4, nb, bid);
      pg8::EpiOut e; e.xsrc = (l == 0 ? p.x : p.out); e.csrc = (l == 0 ? p.ctx : p.ctxs); e.xdst = p.out; e.cdst = p.ctxs;
      e.modl = p.mod + (size_t)l * 9 * 6144;
      pg8::gemm_phase(lds, g, S, e);
      for (int t = bid; t < 8192; t += nb) {
        if (t < 4096) cvt_chunk_fp4(p.peer_u + (size_t)l * 16384 * 1024, p.Ub, (size_t)t, 64.0f, 0);
        else cvt_chunk_fp4(p.peer_v + (size_t)l * 16384 * 1024, p.Ub, (size_t)(t - 4096), 4.0f, 1);
      }
    }
    xcd_barrier(p.counters + 1024, xbw);
    phase_norm(p, l, 1);
    xcd_barrier(p.counters + 1024, xbw);
_Pragma("unroll 1")
    for (int rep = 0; rep < REP_Q; ++rep) {
      pg8::Gemm g; pg8::Order S;
      g.A = p.xn; g.Bt = p.WqkT + (size_t)l * 2048 * 1024; g.lda = 1024; g.ldb = 1024; g.K = 1024;
      S.init(n_mt, 8, nb, bid);
      pg8::EpiQ e; e.q = p.q;
      pg8::gemm_phase(lds, g, S, e);
    }
    xcd_barrier(p.counters + 1024, xbw);
_Pragma("unroll 1")
    for (int rep = 0; rep < REP_SCORE; ++rep)
      for (int task = bid; task < n_mt * 16; task += nb) peer_score_tile(p, l, task >> 4, task & 15, smem);
    xcd_barrier(p.counters + 1024, xbw);
_Pragma("unroll 1")
    for (int rep = 0; rep < REP_PEER; ++rep) phase_peer_experts(p, l, rep == REP_PEER - 1, smem);
    xcd_barrier(p.counters + 1024, xbw);
  }

__global__ void __launch_bounds__(NTHR) fwd_megakernel(P p) {
  __shared__ __attribute__((aligned(16))) char smem[SMEM_BYTES];
  cg::grid_group grid = cg::this_grid();
  const int nb = gridDim.x, bid = blockIdx.x;
  pg8::PG8_LAS_T lds = (pg8::PG8_LAS_T)smem;
  volatile LAS unsigned* xbw = (volatile LAS unsigned*)(smem + SMEM_BYTES - 32);
  if (threadIdx.x == 0) { xbw[0] = 0u; xbw[1] = 0u; xbw[2] = 0u; xbw[3] = 0u; }
  __syncthreads();
  (void)xcd_barrier_post(p.counters + 1024, xbw);

  phase_prep(p, smem);
  if (blockIdx.x < 136) phase_filters(p, 0, smem);
  if (blockIdx.x >= gridDim.x - 128) { for (int t = blockIdx.x - (gridDim.x - 128); t < 128; t += 128) filter_block_task(p, 1, 4096, t * 32, p.hT + (size_t)512 * 4096, smem); }
  grid.sync();
  phase_modreduce(p);
  for (int task = blockIdx.x; task < 512; task += gridDim.x) kf_task(p, task >> 8, task & 255, smem);
  for (int task = blockIdx.x; task < 256; task += gridDim.x) wqk_task(p, task >> 7, (task >> 3) & 15, task & 7, smem);
  for (int task = blockIdx.x; task < 2 * 1472; task += gridDim.x) {
    const int l = task / 1472, t = task - l * 1472;
    if (t < 704) tr_tile_i8(p.w_in + (size_t)l * 1024 * 2816, 2816, 1024, p.Win8 + (size_t)l * 2816 * 1024, t, p.sw + l * 5888, smem);
    else tr_tile_i8(p.w_gate + (size_t)l * 1024 * 3072, 3072, 1024, p.Wg8 + (size_t)l * 3072 * 1024, t - 704, p.sw + l * 5888 + 2816, smem);
  }
  xcd_barrier(p.counters + 1024, xbw);

  layer_body<0>(p, smem, lds, xbw, nb, bid);
  layer_body<1>(p, smem, lds, xbw, nb, bid);
}

extern "C" void kernel_launch(void* const* d_in, const int* in_sizes, int n_in, void* d_out, int out_size, void* d_ws,
                              size_t ws_size, hipStream_t stream) {
  P p;
  memset(&p, 0, sizeof(p));
  const float** ins = (const float**)&p;
  for (int i = 0; i < 37; ++i) ins[i] = (const float*)d_in[i];
  p.out = (float*)d_out;
  char* w = (char*)d_ws;
  size_t off = 0;
  auto take = [&](size_t bytes) { char* r = w + off; off += (bytes + 255) & ~(size_t)255; return r; };
  p.counters = (unsigned*)take(32768);
  p.WinT = nullptr; p.WgT = nullptr;
  p.Win8 = (unsigned char*)take((size_t)2 * 2816 * 1024);
  p.Wg8 = (unsigned char*)take((size_t)2 * 3072 * 1024);
  p.sw = (float*)take((size_t)2 * 5888 * 4);
  p.xn8 = (unsigned char*)take((size_t)NTOK * 1024);
  p.sa = (float*)take((size_t)NTOK * 4);
  p.WaT = (u16*)take((size_t)2 * 1024 * 512 * 2);
  p.WbT = (u16*)take((size_t)2 * 1024 * 256 * 2);
  p.WcT = (u16*)take((size_t)2 * 1024 * 256 * 2);
  p.WoT = (u16*)take((size_t)2 * 1024 * 1024 * 2);
  p.WqB = (u16*)take((size_t)2 * 1024 * 2048 * 2);
  p.WqkT = (u16*)take((size_t)2 * 2048 * 1024 * 2);
  p.keysB = (u16*)take((size_t)2 * 16 * 16384 * 2);
  p.rgW = (u16*)take((size_t)2 * 16 * 4096 * 2);
  p.modpart = (float*)take((size_t)16 * 2 * 9 * 6144 * 4);
  p.mod = (float*)take((size_t)2 * 9 * 6144 * 4);
  p.hT = (float*)take((size_t)2 * 512 * 4096 * 4);
  p.hc = (float*)take((size_t)512 * 256 * 4);
  p.Kf = (float*)take((size_t)2 * 256 * 8192 * 8);
  p.xn = (u16*)take((size_t)NTOK * 1024 * 2);
  p.qk = (u16*)take((size_t)NTOK * 1024 * 2);
  p.mbuf = p.qk;
  p.vT = (u16*)take((size_t)8 * 512 * 4096 * 2);
  p.vTc = (u16*)take((size_t)8 * 512 * 256 * 2);
  p.hyT = (u16*)take((size_t)8 * 768 * 4096 * 2);
  p.hyTc = (u16*)take((size_t)8 * 768 * 256 * 2);
  p.rg = (u16*)take((size_t)NTOK * 512 * 2);
  p.ycat = (u16*)take((size_t)NTOK * 1024 * 2);
  p.Ub = (unsigned char*)p.ycat;
  p.Vb = p.Ub + (size_t)16384 * 512;
  p.agg = (float*)take((size_t)8 * 2 * (136 + 34) * 256 * 8);
  p.ybT = (u16*)take((size_t)8 * 256 * 4096 * 2);
  p.ctxs = (float*)take((size_t)2048 * 1024 * 4);
  p.g8 = (unsigned char*)p.vT;
  p.q = p.qk;
  p.topk = (unsigned*)((char*)p.qk + (size_t)NTOK * 2048 * 2);
  if (off > ws_size) {
    fprintf(stderr, "workspace too small: need %zu have %zu\n", off, ws_size);
    return;
  }
  static int grid_blocks = 0;
  if (!grid_blocks) {
    int dev = 0, cus = 0, per_cu = 0;
    (void)hipGetDevice(&dev);
    (void)hipDeviceGetAttribute(&cus, hipDeviceAttributeMultiprocessorCount, dev);
    (void)hipOccupancyMaxActiveBlocksPerMultiprocessor(&per_cu, fwd_megakernel, NTHR, 0);
    if (per_cu > 1) per_cu = 1;
    grid_blocks = cus * per_cu;
  }
  (void)hipMemsetAsync(p.counters, 0, 32768, stream);
  void* args[] = {&p};
  hipError_t e = hipLaunchCooperativeKernel((void*)fwd_megakernel, dim3(grid_blocks), dim3(NTHR), args, 0, stream);
  if (e != hipSuccess) fprintf(stderr, "cooperative launch failed: %s (grid %d)\n", hipGetErrorString(e), grid_blocks);
}
```

```cpp
#include <hip/hip_runtime.h>
#include <hip/hip_cooperative_groups.h>
#include <cstdio>
#include <cstring>
namespace cg = cooperative_groups;

typedef unsigned short u16;
typedef __attribute__((ext_vector_type(8))) short bf16x8;
typedef __attribute__((ext_vector_type(16))) float f32x16;
typedef __attribute__((ext_vector_type(2))) float f32x2;

#define NLAT 32768
#define NTOK 34816
#define SMEM_BYTES 151552
#define NTHR 512
#ifndef DUP_1A
#define DUP_1A 1
#endif
#ifndef DUP_PREP
#define DUP_PREP 1
#endif
#ifndef DUP_2B
#define DUP_2B 1
#endif
#ifndef XRGA
#define XRGA 1
#endif
#ifndef REP_PEER
#define REP_PEER 1
#endif
#ifndef REP_INPROJ
#define REP_INPROJ 1
#endif
#ifndef REP_GATE
#define REP_GATE 1
#endif
#ifndef REP_BRANCH
#define REP_BRANCH 1
#endif
#ifndef REP_Q
#define REP_Q 1
#endif
#ifndef REP_SCORE
#define REP_SCORE 1
#endif
#ifndef REP_1A
#define REP_1A 1
#endif
#ifndef REP_2B
#define REP_2B 1
#endif
#ifndef REP_KF
#define REP_KF 1
#endif
#ifndef DUP_GEMM
#define DUP_GEMM 1
#endif
#ifndef DUP_PEER
#define DUP_PEER 1
#endif
#ifndef DUP_MIX
#define DUP_MIX 1
#endif
#ifndef XRG
#define XRG 1
#endif
#ifndef XFFT
#define XFFT 1
#endif
#ifndef XATT
#define XATT 1
#endif

struct P {
  const float *x, *c, *ctx, *c_ctx, *norm_mix_g, *norm_ffn_g, *w_ada, *b_ada, *w_in, *na_rpb,
      *hy_short_w, *hy_short_b, *hy_f1_w, *hy_f1_b, *hy_f2_w, *hy_f2_b, *hy_f3_w, *hy_freq, *hy_bias,
      *rg_conv_w, *rg_conv_b, *rg_wa, *rg_ba, *rg_wx, *rg_bx, *rg_lambda,
      *w_gate, *b_gate, *w_br_a, *w_br_b, *w_br_c, *w_out, *peer_wq, *peer_keys, *peer_u, *peer_v, *final_g;
  float* out;
  unsigned* counters;
  u16 *WinT, *WgT, *WaT, *WbT, *WcT, *WoT, *WqB, *WqkT, *keysB, *rgW;
  float *modpart, *mod, *hT, *hc;
  float* Kf;
  u16 *xn, *qk, *vT, *vTc, *hyT, *hyTc, *rg, *ycat, *mbuf, *ybT;
  unsigned char *Ub, *Vb, *g8, *xn8, *Win8, *Wg8;
  float *sa, *sw;
  u16* q;
  float *agg, *ctxs;
  unsigned* topk;
};

__device__ __forceinline__ u16 f2bf(float f) {
  unsigned u = __float_as_uint(f);
  u += 0x7fffu + ((u >> 16) & 1u);
  return (u16)(u >> 16);
}
__device__ __forceinline__ float bf2f(u16 h) { return __uint_as_float(((unsigned)h) << 16); }
__device__ __forceinline__ unsigned pk2(float a, float b) { return (unsigned)f2bf(a) | ((unsigned)f2bf(b) << 16); }
__device__ __forceinline__ float bflo(unsigned u) { return __uint_as_float(u << 16); }
__device__ __forceinline__ float bfhi(unsigned u) { return __uint_as_float(u & 0xffff0000u); }
__device__ __forceinline__ int opaque_tid() {
  int t = threadIdx.x;
  asm volatile("" : "+v"(t));
  return t;
}
__device__ __forceinline__ int my_lane() { return opaque_tid() & 63; }
__device__ __forceinline__ float shx(float v, int o);
__device__ __forceinline__ float shf(float v, int src) { return __builtin_bit_cast(float, __builtin_amdgcn_ds_bpermute((src & 63) << 2, __builtin_bit_cast(int, v))); }
__device__ __forceinline__ unsigned shu(unsigned v, int src) { return (unsigned)__builtin_amdgcn_ds_bpermute((src & 63) << 2, (int)v); }
typedef unsigned u32x2_t __attribute__((ext_vector_type(2)));
template <int J> __device__ __forceinline__ unsigned xorl(unsigned v, int lane) {
  if constexpr (J == 1) return (unsigned)__builtin_amdgcn_mov_dpp((int)v, 0xB1, 0xF, 0xF, true);
  else if constexpr (J == 2) return (unsigned)__builtin_amdgcn_mov_dpp((int)v, 0x4E, 0xF, 0xF, true);
  else if constexpr (J == 4) {
    const unsigned a = (unsigned)__builtin_amdgcn_mov_dpp((int)v, 0x104, 0xF, 0xF, true);
    const unsigned b = (unsigned)__builtin_amdgcn_mov_dpp((int)v, 0x114, 0xF, 0xF, true);
    return (lane & 4) ? b : a;
  }
  else if constexpr (J == 8) return (unsigned)__builtin_amdgcn_mov_dpp((int)v, 0x128, 0xF, 0xF, true);
  else if constexpr (J == 16) { const u32x2_t r = __builtin_amdgcn_permlane16_swap(v, v, false, false); return (lane & 16) ? r.x : r.y; }
  else { const u32x2_t r = __builtin_amdgcn_permlane32_swap(v, v, false, false); return (lane & 32) ? r.x : r.y; }
}
template <int J> __device__ __forceinline__ float xorf(float v, int lane) { return __uint_as_float(xorl<J>(__float_as_uint(v), lane)); }
__device__ __forceinline__ float shx(float v, int o) {
  const int lane = my_lane();
  switch (o) {
    case 1: return xorf<1>(v, lane);
    case 2: return xorf<2>(v, lane);
    case 4: return xorf<4>(v, lane);
    case 8: return xorf<8>(v, lane);
    case 16: return xorf<16>(v, lane);
    case 32: return xorf<32>(v, lane);
    default: return __builtin_bit_cast(float, __builtin_amdgcn_ds_bpermute(((lane ^ o) << 2), __builtin_bit_cast(int, v)));
  }
}
__device__ __forceinline__ float wave_sum(float v) {
  const int lane = my_lane();
  v += xorf<32>(v, lane); v += xorf<16>(v, lane); v += xorf<8>(v, lane); v += xorf<4>(v, lane); v += xorf<2>(v, lane); v += xorf<1>(v, lane);
  return v;
}
__device__ __forceinline__ float wave_max(float v) {
  const int lane = my_lane();
  v = fmaxf(v, xorf<32>(v, lane)); v = fmaxf(v, xorf<16>(v, lane)); v = fmaxf(v, xorf<8>(v, lane));
  v = fmaxf(v, xorf<4>(v, lane)); v = fmaxf(v, xorf<2>(v, lane)); v = fmaxf(v, xorf<1>(v, lane));
  return v;
}
__device__ __forceinline__ float sigmoidf_(float x) { return __builtin_amdgcn_rcpf(1.0f + __expf(-x)); }
__device__ __forceinline__ float gelu_tanh(float x) {
  const float u2 = 1.5957691216057308f * (x + 0.044715f * x * x * x);
  return x * __builtin_amdgcn_rcpf(1.0f + __expf(-u2));
}
__device__ __forceinline__ f32x16 mfma32(bf16x8 a, bf16x8 b, f32x16 c) {
  return __builtin_amdgcn_mfma_f32_32x32x16_bf16(a, b, c, 0, 0, 0);
}
__device__ __forceinline__ f32x16 zero16() {
  f32x16 z;
#pragma unroll
  for (int i = 0; i < 16; ++i) z[i] = 0.f;
  return z;
}
__device__ __forceinline__ int swz128(int row, int ch) { return row * 128 + ((ch ^ ((row >> 1) & 7)) << 4); }
__device__ __forceinline__ int swz256(int row, int ch) { return row * 256 + ((ch ^ (row & 15)) << 4); }

struct c2 { float x, y; };
__device__ __forceinline__ c2 cadd(c2 a, c2 b) { return {a.x + b.x, a.y + b.y}; }
__device__ __forceinline__ c2 csub(c2 a, c2 b) { return {a.x - b.x, a.y - b.y}; }
__device__ __forceinline__ c2 cmul(c2 a, c2 b) { return {a.x * b.x - a.y * b.y, a.x * b.y + a.y * b.x}; }
__device__ __forceinline__ float c16(int i) {
  const float tb[16] = {1.0f, 0.9238795325112867f, 0.7071067811865476f, 0.3826834323650898f, 0.0f,
                        -0.3826834323650898f, -0.7071067811865476f, -0.9238795325112867f, -1.0f,
                        -0.9238795325112867f, -0.7071067811865476f, -0.3826834323650898f, 0.0f,
                        0.3826834323650898f, 0.7071067811865476f, 0.9238795325112867f};
  return tb[i & 15];
}
__device__ __forceinline__ float s16(int i) { return c16(i + 12); }
template <int R> __device__ __forceinline__ constexpr int brev(int k) {
  int r = 0;
  for (int b = 1, o = R >> 1; b < R; b <<= 1, o >>= 1)
    if (k & b) r |= o;
  return r;
}
template <int R> __device__ __forceinline__ void dft_reg(c2* v, float sgn) {
#pragma unroll
  for (int h = R / 2; h >= 1; h >>= 1) {
#pragma unroll
    for (int g = 0; g < R; g += 2 * h) {
#pragma unroll
      for (int j = 0; j < h; ++j) {
        c2 a = v[g + j], b = v[g + j + h];
        v[g + j] = cadd(a, b);
        c2 d = csub(a, b);
        const int ti = j * (16 / (2 * h));
        c2 w = {c16(ti), sgn * s16(ti)};
        v[g + j + h] = (j == 0) ? d : cmul(d, w);
      }
    }
  }
}
template <int R> __device__ __forceinline__ int fft_bfly(c2* v, int j, int Ns, float sgn) {
  const int k = j & (Ns - 1);
  const float f = sgn * (float)k / (float)(Ns * R);
#pragma unroll
  for (int r = 1; r < R; ++r) {
    float t = f * (float)r;
    c2 w = {__builtin_amdgcn_cosf(t), __builtin_amdgcn_sinf(t)};
    v[r] = cmul(v[r], w);
  }
  dft_reg<R>(v, sgn);
  return (j - k) * R + k;
}
template <int R> __device__ __forceinline__ void fft_pass(c2* buf, int Ns, float sgn) {
  constexpr int NBF = 8192 / R;
  constexpr int PER = NBF / NTHR;
  const int tid = opaque_tid();
  c2 v[PER][R];
#pragma unroll
  for (int i = 0; i < PER; ++i) {
    const int j = tid + NTHR * i;
#pragma unroll
    for (int r = 0; r < R; ++r) v[i][r] = buf[j + r * NBF];
  }
  __syncthreads();
#pragma unroll
  for (int i = 0; i < PER; ++i) {
    const int j = tid + NTHR * i;
    const int base = fft_bfly<R>(v[i], j, Ns, sgn);
#pragma unroll
    for (int r = 0; r < R; ++r) buf[base + r * Ns] = v[i][brev<R>(r)];
  }
  __syncthreads();
}
__device__ __forceinline__ void fft8192(c2* buf, float sgn) {
  fft_pass<8>(buf, 1, sgn);
  fft_pass<8>(buf, 8, sgn);
  fft_pass<8>(buf, 64, sgn);
  fft_pass<16>(buf, 512, sgn);
}

__device__ __forceinline__ void gemm_kloop(f32x16 (&acc)[2][2], const u16* __restrict__ A, int lda,
                                           const u16* __restrict__ B, int ldb, int K, char* smem) {
  const int tid = opaque_tid(), lane = tid & 63, wid = tid >> 6;
  const int wm = wid >> 1, wn = wid & 1;
  const int l31 = lane & 31, hh = lane >> 5;
  uint4 ra[4], rb[2];
  const int nk = K >> 6;
  const int srow = tid >> 3, sch = tid & 7;
  const char* Ab = (const char*)A;
  const char* Bb = (const char*)B;
  const unsigned aoff = (unsigned)(srow * lda + sch * 8) * 2u;
  const unsigned boff = (unsigned)(srow * ldb + sch * 8) * 2u;
  const unsigned astep = (unsigned)lda * 128u, bstep = (unsigned)ldb * 128u;
#pragma unroll
  for (int i = 0; i < 4; ++i) ra[i] = *(const uint4*)(Ab + (aoff + i * astep));
#pragma unroll
  for (int i = 0; i < 2; ++i) rb[i] = *(const uint4*)(Bb + (boff + i * bstep));
#pragma unroll
  for (int i = 0; i < 4; ++i) *(uint4*)(smem + swz128(srow + i * 64, sch)) = ra[i];
#pragma unroll
  for (int i = 0; i < 2; ++i) *(uint4*)(smem + 65536 + swz128(srow + i * 64, sch)) = rb[i];
  __syncthreads();
  for (int kt = 0; kt < nk; ++kt) {
    const bool more = (kt + 1 < nk);
    if (more) {
      const unsigned ko = (unsigned)(kt + 1) * 128u;
#pragma unroll
      for (int i = 0; i < 4; ++i) ra[i] = *(const uint4*)(Ab + (aoff + i * astep + ko));
#pragma unroll
      for (int i = 0; i < 2; ++i) rb[i] = *(const uint4*)(Bb + (boff + i * bstep + ko));
    }
    const char* as = smem + (kt & 1) * 32768;
    const char* bs = smem + 65536 + (kt & 1) * 16384;
    int lrow = l31;
    asm volatile("" : "+v"(lrow));
#pragma unroll
    for (int s = 0; s < 4; ++s) {
      bf16x8 af[2], bfr[2];
#pragma unroll
      for (int i = 0; i < 2; ++i) af[i] = *(const bf16x8*)(as + swz128(wm * 64 + i * 32 + lrow, s * 2 + hh));
#pragma unroll
      for (int j = 0; j < 2; ++j) bfr[j] = *(const bf16x8*)(bs + swz128(wn * 64 + j * 32 + lrow, s * 2 + hh));
#pragma unroll
      for (int i = 0; i < 2; ++i)
#pragma unroll
        for (int j = 0; j < 2; ++j) acc[i][j] = mfma32(af[i], bfr[j], acc[i][j]);
    }
    if (more) {
      char* an = smem + ((kt + 1) & 1) * 32768;
      char* bn = smem + 65536 + ((kt + 1) & 1) * 16384;
      int sr2 = srow;
      asm volatile("" : "+v"(sr2));
#pragma unroll
      for (int i = 0; i < 4; ++i) *(uint4*)(an + swz128(sr2 + i * 64, sch)) = ra[i];
#pragma unroll
      for (int i = 0; i < 2; ++i) *(uint4*)(bn + swz128(sr2 + i * 64, sch)) = rb[i];
    }
    __syncthreads();
  }
}
__device__ __forceinline__ void zero_acc(f32x16 (&acc)[2][2]) {
#pragma unroll
  for (int i = 0; i < 2; ++i)
#pragma unroll
    for (int j = 0; j < 2; ++j) acc[i][j] = zero16();
}
#define EPI_ROW(i, e) (wm * 64 + (i)*32 + ((e)&3) + 8 * ((e) >> 2) + 4 * hh)
#define EPI_COL(j) (wn * 64 + (j)*32 + l31)
#define EPI_VARS                                                    \
  const int tid = opaque_tid(), lane = tid & 63, wid = tid >> 6;     \
  const int wm = wid >> 1, wn = wid & 1, l31 = lane & 31, hh = lane >> 5; \
  (void)tid; (void)wm; (void)wn; (void)l31; (void)hh;


namespace pg8 {
__device__ __forceinline__ unsigned pkh(float a, float b) { unsigned r; asm("v_cvt_pk_bf16_f32 %0, %1, %2" : "=v"(r) : "v"(a), "v"(b)); return r; }
#define PG8_LAS __attribute__((address_space(3)))
typedef PG8_LAS unsigned char* PG8_LAS_T;
typedef float f32x4 __attribute__((ext_vector_type(4)));
typedef unsigned u32x4 __attribute__((ext_vector_type(4)));
typedef int i32x4 __attribute__((ext_vector_type(4)));
constexpr int BM = 256, BK = 64, HALF = 128, HTB = HALF * BK * 2, STAGE_BYTES = 8 * HTB, NXCD = 8, WGM = 8;
__device__ __forceinline__ int lds_byte(int r, int c) { const int st = (r >> 4) * 2 + (c >> 5), rr = r & 15, cc = c & 31, ob = rr * 64 + cc * 2; return st * 1024 + (ob ^ (((ob >> 9) & 1) << 5)); }
__device__ __forceinline__ void stage_rc(int b, int& R, int& C) { const int st = b / 1024, sb = b % 1024, swz = sb ^ (((sb >> 9) & 1) << 5); R = (st >> 1) * 16 + swz / 64; C = (st & 1) * 32 + (swz % 64) / 2; }
__device__ __forceinline__ int perm32(int rho) { const int n = rho >> 4, i = rho & 15; return 8 * (i >> 2) + 4 * n + (i & 3); }
struct Unit { int pm, pn; };
struct Gemm { const u16* A; const u16* Bt; int lda, ldb, K; };
struct Order {
  int nM, nN, nwg, G, c, skip_from, skip_by;
  __device__ __forceinline__ void init(int nM_, int nN_, int G_, int c_, int sf = 1 << 30, int sb = 0) { nM = nM_; nN = nN_; nwg = nM * nN; G = G_; c = c_; skip_from = sf; skip_by = sb; }
  __device__ __forceinline__ bool next(int i, Unit& u) const {
    const long L = (long)i * G + c; if (L >= nwg) return false;
    int wgid = (int)L; { const int q = nwg / NXCD, r = nwg % NXCD, xcd = wgid % NXCD, off = wgid / NXCD; wgid = (xcd < r ? xcd * (q + 1) : r * (q + 1) + (xcd - r) * q) + off; }
    const int nig = WGM * nN, gid = wgid / nig, fm = gid * WGM, gsz = (nM - fm) < WGM ? (nM - fm) : WGM;
    u.pm = fm + ((wgid % nig) % gsz); u.pn = (wgid % nig) / gsz;
    if (u.pn >= skip_from) u.pn += skip_by;
    return true;
  }
};
__device__ __forceinline__ f32x4 mma16(bf16x8 a, bf16x8 b, f32x4 c) { return __builtin_amdgcn_mfma_f32_16x16x32_bf16(a, b, c, 0, 0, 0); }
__device__ __forceinline__ i32x4 mma16(bf16x8 a, bf16x8 b, i32x4 c) { return __builtin_amdgcn_mfma_i32_16x16x64_i8(__builtin_bit_cast(i32x4, a), __builtin_bit_cast(i32x4, b), c, 0, 0, 0); }
template <class Epi>
__device__ __forceinline__ void gemm_phase(PG8_LAS unsigned char* lds, const Gemm g, const Order& S, const Epi& E) {
  const int tid = opaque_tid(), wid = __builtin_amdgcn_readfirstlane(tid >> 6), lane = tid & 63, wr = wid >> 2, wc = wid & 3, fr = lane & 15, fq = lane >> 4;
  const int K = g.K, nt = K / BK;
  unsigned voffA[2], voffB[2];
#pragma unroll
  for (int i = 0; i < 2; ++i) { int R, C; stage_rc(tid * 16 + i * 8192, R, C); const int Rb = Epi::PERM ? ((R & ~31) + perm32(R & 31)) : R;
    voffA[i] = (unsigned)(R * g.lda + C) * 2u; voffB[i] = (unsigned)(Rb * g.ldb + C) * 2u; }
  const size_t kstep = (size_t)(BK * 2);
  const size_t hstepA = (size_t)HALF * g.lda * 2, hstepB = (size_t)HALF * g.ldb * 2;
  const size_t tstepA = 2 * hstepA, tstepB = 2 * hstepB;
  const unsigned ldsw = (unsigned)wid * 1024u;
  const int aoff = lds_byte(wr * 64 + fr, fq * 8), boff = lds_byte(wc * 32 + fr, fq * 8);
#define PG8_SA(b, h) (((b) * 2 + (h)) * HTB)
#define PG8_SB(b, h) ((4 + (b) * 2 + (h)) * HTB)
#define PG8_STAGE(bufoff, gbase, voff) do { _Pragma("unroll") for (int _i = 0; _i < 2; ++_i) \
    __builtin_amdgcn_global_load_lds((const unsigned*)((const char*)(gbase) + (voff)[_i]), (PG8_LAS unsigned*)(lds + (bufoff) + ldsw + _i * 8192), 16, 0, 0); } while (0)
#define PG8_LDA(dst, b, h) do { _Pragma("unroll") for (int m = 0; m < 4; ++m) _Pragma("unroll") for (int k = 0; k < 2; ++k) dst[m][k] = *(const PG8_LAS bf16x8*)(lds + PG8_SA(b, h) + aoff + m * 2048 + k * 1024); } while (0)
#define PG8_LDB(dst, b, h) do { _Pragma("unroll") for (int n = 0; n < 2; ++n) _Pragma("unroll") for (int k = 0; k < 2; ++k) dst[n][k] = *(const PG8_LAS bf16x8*)(lds + PG8_SB(b, h) + boff + n * 2048 + k * 1024); } while (0)
#define PG8_MMA(ai, bj, At, Bt) do { __builtin_amdgcn_s_setprio(1); _Pragma("unroll") for (int m = 0; m < 4; ++m) _Pragma("unroll") for (int n = 0; n < 2; ++n) _Pragma("unroll") for (int k = 0; k < 2; ++k) \
    acc[ai][bj][m][n] = mma16(Bt[n][k], At[m][k], acc[ai][bj][m][n]); __builtin_amdgcn_s_setprio(0); } while (0)
#define PG8_WAIT_V(n) asm volatile("s_waitcnt vmcnt(" #n ")" ::: "memory")
#define PG8_WAIT_L(n) asm volatile("s_waitcnt lgkmcnt(" #n ")" ::: "memory")
#define PG8_BAR __builtin_amdgcn_s_barrier()
#define PG8_SCHED __builtin_amdgcn_sched_barrier(0)
  Unit cur, nxt; int ui = 0;
  if (!S.next(0, cur)) return;
  typedef typename Epi::acc_t acc_t;
  acc_t acc[2][2][4][2];
#pragma unroll
  for (int a = 0; a < 2; ++a)
#pragma unroll
    for (int b = 0; b < 2; ++b)
#pragma unroll
      for (int m = 0; m < 4; ++m)
#pragma unroll
        for (int n = 0; n < 2; ++n) acc[a][b][m][n] = (acc_t){0, 0, 0, 0};
  bf16x8 At[4][2], B0[2][2], B1[2][2];
  const char* cA = (const char*)g.A + (size_t)cur.pm * tstepA; const char* cB = (const char*)g.Bt + (size_t)cur.pn * tstepB;
  PG8_STAGE(PG8_SB(0, 0), cB, voffB); PG8_STAGE(PG8_SA(0, 0), cA, voffA); PG8_STAGE(PG8_SB(0, 1), cB + hstepB, voffB); PG8_STAGE(PG8_SA(0, 1), cA + hstepA, voffA);
  if (wr == 1) PG8_BAR;
  PG8_WAIT_V(4); PG8_BAR;
  PG8_STAGE(PG8_SB(1, 0), cB + kstep, voffB); PG8_STAGE(PG8_SA(1, 0), cA + kstep, voffA); PG8_STAGE(PG8_SB(1, 1), cB + hstepB + kstep, voffB);
  PG8_WAIT_V(6); PG8_BAR;
  for (;;) {
    const bool has_next = S.next(ui + 1, nxt);
    const char* nA = has_next ? (const char*)g.A + (size_t)nxt.pm * tstepA : cA; const char* nB = has_next ? (const char*)g.Bt + (size_t)nxt.pn * tstepB : cB;
    for (int t = 0; t < nt; t += 2) {
      const bool last = (t == nt - 2);
      const char* a1 = cA + (size_t)(t + 1) * kstep;
      const char* a2 = last ? nA : cA + (size_t)(t + 2) * kstep; const char* b2 = last ? nB : cB + (size_t)(t + 2) * kstep;
      const char* a3 = a2 + kstep; const char* b3 = b2 + kstep;
      PG8_LDB(B0, 0, 0); PG8_SCHED; PG8_LDA(At, 0, 0); PG8_STAGE(PG8_SA(1, 1), a1 + hstepA, voffA);
      PG8_WAIT_L(8); PG8_BAR; PG8_WAIT_L(0); PG8_MMA(0, 0, At, B0); PG8_BAR; PG8_SCHED;
      PG8_LDB(B1, 0, 1); PG8_STAGE(PG8_SB(0, 0), b2, voffB);
      PG8_BAR; PG8_WAIT_L(0); PG8_MMA(0, 1, At, B1); PG8_BAR;
      PG8_LDA(At, 0, 1); PG8_STAGE(PG8_SA(0, 0), a2, voffA);
      PG8_BAR; PG8_WAIT_L(0); PG8_MMA(1, 0, At, B0); PG8_BAR; PG8_SCHED;
      PG8_STAGE(PG8_SB(0, 1), b2 + hstepB, voffB);
      PG8_WAIT_V(6); PG8_BAR; PG8_MMA(1, 1, At, B1); PG8_BAR;
      PG8_LDB(B0, 1, 0); PG8_SCHED; PG8_LDA(At, 1, 0); PG8_STAGE(PG8_SA(0, 1), a2 + hstepA, voffA);
      PG8_WAIT_L(8); PG8_BAR; PG8_WAIT_L(0); PG8_MMA(0, 0, At, B0); PG8_BAR; PG8_SCHED;
      PG8_LDB(B1, 1, 1); PG8_STAGE(PG8_SB(1, 0), b3, voffB);
      PG8_BAR; PG8_WAIT_L(0); PG8_MMA(0, 1, At, B1); PG8_BAR;
      PG8_LDA(At, 1, 1); PG8_STAGE(PG8_SA(1, 0), a3, voffA);
      PG8_BAR; PG8_WAIT_L(0); PG8_MMA(1, 0, At, B0); PG8_BAR; PG8_SCHED;
      PG8_STAGE(PG8_SB(1, 1), b3 + hstepB, voffB);
      PG8_WAIT_V(6); PG8_BAR; PG8_MMA(1, 1, At, B1); PG8_BAR;
    }
    E(acc, cur, wr, wc, fr, fq);
    if (!has_next) break;
#pragma unroll
    for (int a = 0; a < 2; ++a)
#pragma unroll
      for (int b = 0; b < 2; ++b)
#pragma unroll
        for (int m = 0; m < 4; ++m)
#pragma unroll
          for (int n = 0; n < 2; ++n) acc[a][b][m][n] = (acc_t){0, 0, 0, 0};
    cur = nxt; cA = nA; cB = nB; ++ui;
  }
  PG8_WAIT_V(0);
  if (wr == 0) PG8_BAR;
  PG8_BAR;
#undef PG8_SA
#undef PG8_SB
#undef PG8_STAGE
#undef PG8_LDA
#undef PG8_LDB
#undef PG8_MMA
#undef PG8_WAIT_V
#undef PG8_WAIT_L
#undef PG8_BAR
#undef PG8_SCHED
}
typedef const f32x4 (&AccRef)[2][2][4][2];
typedef const i32x4 (&AccRefI)[2][2][4][2];
struct EpiInprojN {
  static constexpr bool PERM = true;
  typedef f32x4 acc_t;
  u16* qk; u16* rg;
  __device__ __forceinline__ void operator()(AccRef acc, const Unit& u, int wr, int wc, int fr, int fq) const {
    const int row0 = u.pm * BM + wr * 64 + fr;
    u16* base; int ld, colt;
    if (u.pn < 4) { base = qk; ld = 1024; colt = u.pn * 256; } else { base = rg; ld = 512; colt = (u.pn - 9) * 256; }
    const int col0 = colt + wc * 32 + 8 * fq;
#pragma unroll
    for (int ai = 0; ai < 2; ++ai)
#pragma unroll
      for (int m = 0; m < 4; ++m) {
        u16* rowp = base + (size_t)(row0 + ai * HALF + m * 16) * ld + col0;
#pragma unroll
        for (int bj = 0; bj < 2; ++bj) {
          const f32x4 v0 = acc[ai][bj][m][0], v1 = acc[ai][bj][m][1];
          u32x4 w; w.x = pkh(v0[0], v0[1]); w.y = pkh(v0[2], v0[3]); w.z = pkh(v1[0], v1[1]); w.w = pkh(v1[2], v1[3]);
          *(u32x4*)(rowp + bj * HALF) = w;
        }
      }
  }
};
struct EpiInprojT {
  static constexpr bool PERM = true;
  typedef f32x4 acc_t;
  u16 *vT, *vTc, *hyT, *hyTc;
  __device__ __forceinline__ void operator()(AccRef acc, const Unit& u, int wr, int wc, int fr, int fq) const {
    const bool isctx = (u.pn >= 128);
    const int b = isctx ? (u.pn - 128) : (u.pn >> 4);
    const int Lseg = isctx ? 256 : 4096, t0 = isctx ? 0 : (u.pn & 15) * 256;
    const bool isv = (u.pm < 2);
    const size_t boff = isv ? (isctx ? (size_t)16777216 : (size_t)0) : (isctx ? (size_t)(16777216 + 1048576 + 25165824) : (size_t)(16777216 + 1048576));
    u16* base = vT + boff;
    const int nc = isv ? 512 : 768;
    const int wrow0 = (isv ? u.pm : u.pm - 2) * BM + wr * 64 + fr;
    const int col0 = t0 + wc * 32 + 8 * fq;
#pragma unroll
    for (int ai = 0; ai < 2; ++ai)
#pragma unroll
      for (int m = 0; m < 4; ++m) {
        u16* rowp = base + ((size_t)(b * nc + wrow0 + ai * HALF + m * 16)) * Lseg + col0;
#pragma unroll
        for (int bj = 0; bj < 2; ++bj) {
          const f32x4 v0 = acc[ai][bj][m][0], v1 = acc[ai][bj][m][1];
          u32x4 w; w.x = pkh(v0[0], v0[1]); w.y = pkh(v0[2], v0[3]); w.z = pkh(v1[0], v1[1]); w.w = pkh(v1[2], v1[3]);
          *(u32x4*)(rowp + bj * HALF) = w;
        }
      }
  }
};
struct EpiGate {
  static constexpr bool PERM = true;
  typedef f32x4 acc_t;
  unsigned char* g8; const float* bias;
  __device__ __forceinline__ void operator()(AccRef acc, const Unit& u, int wr, int wc, int fr, int fq) const {
    const int row0 = u.pm * BM + wr * 64 + fr;
    const int col0 = u.pn * BM + wc * 32 + 8 * fq;
#pragma unroll
    for (int bj = 0; bj < 2; ++bj) {
      const f32x4 b0 = *(const f32x4*)(bias + col0 + bj * HALF), b1 = *(const f32x4*)(bias + col0 + bj * HALF + 4);
#pragma unroll
      for (int ai = 0; ai < 2; ++ai)
#pragma unroll
        for (int m = 0; m < 4; ++m) {
          const f32x4 v0 = acc[ai][bj][m][0] + b0, v1 = acc[ai][bj][m][1] + b1;
          unsigned w0 = 0, w1 = 0;
#pragma unroll
          for (int k = 0; k < 4; ++k) {
            w0 |= (unsigned)(sigmoidf_(v0[k]) * 255.0f + 0.5f) << (8 * k);
            w1 |= (unsigned)(sigmoidf_(v1[k]) * 255.0f + 0.5f) << (8 * k);
          }
          *(uint2*)(g8 + (size_t)(row0 + ai * HALF + m * 16) * 3072 + col0 + bj * HALF) = make_uint2(w0, w1);
        }
    }
  }
};
struct EpiBranch {
  static constexpr bool PERM = true;
  typedef f32x4 acc_t;
  u16* mbuf; const unsigned char* g8; int br;
  __device__ __forceinline__ void operator()(AccRef acc, const Unit& u, int wr, int wc, int fr, int fq) const {
    const int row0 = u.pm * BM + wr * 64 + fr;
    const int col0 = u.pn * BM + wc * 32 + 8 * fq;
#pragma unroll
    for (int ai = 0; ai < 2; ++ai)
#pragma unroll
      for (int m = 0; m < 4; ++m) {
        const size_t row = (size_t)(row0 + ai * HALF + m * 16);
#pragma unroll
        for (int bj = 0; bj < 2; ++bj) {
          const uint2 gq = *(const uint2*)(g8 + row * 3072 + br * 1024 + col0 + bj * HALF);
          u16* mp = mbuf + row * 1024 + col0 + bj * HALF;
          const f32x4 v0 = acc[ai][bj][m][0], v1 = acc[ai][bj][m][1];
          float r[8];
          r[0] = (float)(gq.x & 255u) * v0[0]; r[1] = (float)((gq.x >> 8) & 255u) * v0[1];
          r[2] = (float)((gq.x >> 16) & 255u) * v0[2]; r[3] = (float)(gq.x >> 24) * v0[3];
          r[4] = (float)(gq.y & 255u) * v1[0]; r[5] = (float)((gq.y >> 8) & 255u) * v1[1];
          r[6] = (float)((gq.y >> 16) & 255u) * v1[2]; r[7] = (float)(gq.y >> 24) * v1[3];
          u32x4 w;
          if (br == 0) {
            w.x = pkh(r[0] * (1.f / 255.f), r[1] * (1.f / 255.f)); w.y = pkh(r[2] * (1.f / 255.f), r[3] * (1.f / 255.f));
            w.z = pkh(r[4] * (1.f / 255.f), r[5] * (1.f / 255.f)); w.w = pkh(r[6] * (1.f / 255.f), r[7] * (1.f / 255.f));
          } else {
            const u32x4 o = *(const u32x4*)mp;
            w.x = pkh(bflo(o.x) + r[0] * (1.f / 255.f), bfhi(o.x) + r[1] * (1.f / 255.f));
            w.y = pkh(bflo(o.y) + r[2] * (1.f / 255.f), bfhi(o.y) + r[3] * (1.f / 255.f));
            w.z = pkh(bflo(o.z) + r[4] * (1.f / 255.f), bfhi(o.z) + r[5] * (1.f / 255.f));
            w.w = pkh(bflo(o.w) + r[6] * (1.f / 255.f), bfhi(o.w) + r[7] * (1.f / 255.f));
          }
          *(u32x4*)mp = w;
        }
      }
  }
};
struct EpiOut {
  static constexpr bool PERM = false;
  typedef f32x4 acc_t;
  const float *xsrc, *csrc; float *xdst, *cdst; const float* modl;
  __device__ __forceinline__ void operator()(AccRef acc, const Unit& u, int wr, int wc, int fr, int fq) const {
    const bool isctx = (u.pm >= 128);
    const int bi = isctx ? 8 : (u.pm >> 4);
    const float* gatev = modl + ((size_t)bi * 6 + 2) * 1024;
    const float* src = isctx ? (csrc - (size_t)NLAT * 1024) : xsrc;
    float* dst = isctx ? (cdst - (size_t)NLAT * 1024) : xdst;
    const int row0 = u.pm * BM + wr * 64 + fr, col0 = u.pn * BM + wc * 32 + 4 * fq;
#pragma unroll
    for (int bj = 0; bj < 2; ++bj)
#pragma unroll
      for (int n = 0; n < 2; ++n) {
        const int col = col0 + bj * HALF + n * 16;
        const f32x4 gv = *(const f32x4*)(gatev + col);
#pragma unroll
        for (int ai = 0; ai < 2; ++ai)
#pragma unroll
          for (int m = 0; m < 4; ++m) {
            const size_t o = (size_t)(row0 + ai * HALF + m * 16) * 1024 + col;
            const f32x4 xv = *(const f32x4*)(src + o);
            *(f32x4*)(dst + o) = xv + gv * acc[ai][bj][m][n];
          }
      }
  }
};
struct EpiQ {
  static constexpr bool PERM = true;
  typedef f32x4 acc_t;
  u16* q;
  __device__ __forceinline__ void operator()(AccRef acc, const Unit& u, int wr, int wc, int fr, int fq) const {
    const int row0 = u.pm * BM + wr * 64 + fr;
    const int col0 = u.pn * BM + wc * 32 + 8 * fq;
#pragma unroll
    for (int ai = 0; ai < 2; ++ai)
#pragma unroll
      for (int m = 0; m < 4; ++m) {
        u16* rowp = q + (size_t)(row0 + ai * HALF + m * 16) * 2048 + col0;
#pragma unroll
        for (int bj = 0; bj < 2; ++bj) {
          const f32x4 v0 = acc[ai][bj][m][0], v1 = acc[ai][bj][m][1];
          u32x4 w;
          w.x = __builtin_bit_cast(unsigned, __builtin_amdgcn_cvt_pkrtz(v0[0], v0[1]));
          w.y = __builtin_bit_cast(unsigned, __builtin_amdgcn_cvt_pkrtz(v0[2], v0[3]));
          w.z = __builtin_bit_cast(unsigned, __builtin_amdgcn_cvt_pkrtz(v1[0], v1[1]));
          w.w = __builtin_bit_cast(unsigned, __builtin_amdgcn_cvt_pkrtz(v1[2], v1[3]));
          *(u32x4*)(rowp + bj * HALF) = w;
        }
      }
  }
};
struct EpiInprojN8 {
  static constexpr bool PERM = true;
  typedef i32x4 acc_t;
  u16* qk; u16* rg; const float* sa; const float* sw;
  __device__ __forceinline__ void operator()(AccRefI acc, const Unit& u, int wr, int wc, int fr, int fq) const {
    const int row0 = u.pm * BM + wr * 64 + fr;
    u16* base; int ld, colt;
    if (u.pn < 4) { base = qk; ld = 1024; colt = u.pn * 256; } else { base = rg; ld = 512; colt = (u.pn - 9) * 256; }
    const int col0 = colt + wc * 32 + 8 * fq;
    const int wcol0 = u.pn * 256 + wc * 32 + 8 * fq;
#pragma unroll
    for (int bj = 0; bj < 2; ++bj) {
      const f32x4 c0 = *(const f32x4*)(sw + wcol0 + bj * HALF), c1 = *(const f32x4*)(sw + wcol0 + bj * HALF + 4);
#pragma unroll
      for (int ai = 0; ai < 2; ++ai)
#pragma unroll
        for (int m = 0; m < 4; ++m) {
          const int row = row0 + ai * HALF + m * 16;
          const float rs = sa[row];
          const i32x4 a0 = acc[ai][bj][m][0], a1 = acc[ai][bj][m][1];
          u32x4 w;
          w.x = pkh((float)a0[0] * rs * c0[0], (float)a0[1] * rs * c0[1]); w.y = pkh((float)a0[2] * rs * c0[2], (float)a0[3] * rs * c0[3]);
          w.z = pkh((float)a1[0] * rs * c1[0], (float)a1[1] * rs * c1[1]); w.w = pkh((float)a1[2] * rs * c1[2], (float)a1[3] * rs * c1[3]);
          *(u32x4*)(base + (size_t)row * ld + col0 + bj * HALF) = w;
        }
    }
  }
};
struct EpiInprojT8 {
  static constexpr bool PERM = true;
  typedef i32x4 acc_t;
  u16* vT; const float* sa; const float* sw;
  __device__ __forceinline__ void operator()(AccRefI acc, const Unit& u, int wr, int wc, int fr, int fq) const {
    const bool isctx = (u.pn >= 128);
    const int b = isctx ? (u.pn - 128) : (u.pn >> 4);
    const int Lseg = isctx ? 256 : 4096, t0 = isctx ? 0 : (u.pn & 15) * 256;
    const bool isv = (u.pm < 2);
    const size_t boff = isv ? (isctx ? (size_t)16777216 : (size_t)0) : (isctx ? (size_t)(16777216 + 1048576 + 25165824) : (size_t)(16777216 + 1048576));
    u16* base = vT + boff;
    const int nc = isv ? 512 : 768;
    const int wrow0 = (isv ? u.pm : u.pm - 2) * BM + wr * 64 + fr;
    const int srow0 = u.pm * BM + wr * 64 + fr;
    const int col0 = t0 + wc * 32 + 8 * fq;
    const int tok0 = u.pn * BM + wc * 32 + 8 * fq;
#pragma unroll
    for (int bj = 0; bj < 2; ++bj) {
      const f32x4 c0 = *(const f32x4*)(sa + tok0 + bj * HALF), c1 = *(const f32x4*)(sa + tok0 + bj * HALF + 4);
#pragma unroll
      for (int ai = 0; ai < 2; ++ai)
#pragma unroll
        for (int m = 0; m < 4; ++m) {
          const float rs = sw[srow0 + ai * HALF + m * 16];
          const i32x4 a0 = acc[ai][bj][m][0], a1 = acc[ai][bj][m][1];
          u32x4 w;
          w.x = pkh((float)a0[0] * rs * c0[0], (float)a0[1] * rs * c0[1]); w.y = pkh((float)a0[2] * rs * c0[2], (float)a0[3] * rs * c0[3]);
          w.z = pkh((float)a1[0] * rs * c1[0], (float)a1[1] * rs * c1[1]); w.w = pkh((float)a1[2] * rs * c1[2], (float)a1[3] * rs * c1[3]);
          *(u32x4*)(base + ((size_t)(b * nc + wrow0 + ai * HALF + m * 16)) * Lseg + col0 + bj * HALF) = w;
        }
    }
  }
};
struct EpiGate8 {
  static constexpr bool PERM = true;
  typedef i32x4 acc_t;
  unsigned char* g8; const float* bias; const float* sa; const float* sw;
  __device__ __forceinline__ void operator()(AccRefI acc, const Unit& u, int wr, int wc, int fr, int fq) const {
    const int row0 = u.pm * BM + wr * 64 + fr;
    const int col0 = u.pn * BM + wc * 32 + 8 * fq;
#pragma unroll
    for (int bj = 0; bj < 2; ++bj) {
      const f32x4 b0 = *(const f32x4*)(bias + col0 + bj * HALF), b1 = *(const f32x4*)(bias + col0 + bj * HALF + 4);
      const f32x4 c0 = *(const f32x4*)(sw + col0 + bj * HALF), c1 = *(const f32x4*)(sw + col0 + bj * HALF + 4);
#pragma unroll
      for (int ai = 0; ai < 2; ++ai)
#pragma unroll
        for (int m = 0; m < 4; ++m) {
          const int row = row0 + ai * HALF + m * 16;
          const float rs = sa[row];
          const i32x4 a0 = acc[ai][bj][m][0], a1 = acc[ai][bj][m][1];
          unsigned w0 = 0, w1 = 0;
#pragma unroll
          for (int k = 0; k < 4; ++k) {
            w0 |= (unsigned)(sigmoidf_((float)a0[k] * rs * c0[k] + b0[k]) * 255.0f + 0.5f) << (8 * k);
            w1 |= (unsigned)(sigmoidf_((float)a1[k] * rs * c1[k] + b1[k]) * 255.0f + 0.5f) << (8 * k);
          }
          *(uint2*)(g8 + (size_t)row * 3072 + col0 + bj * HALF) = make_uint2(w0, w1);
        }
    }
  }
};
}

__device__ __forceinline__ void tr_tile(const float* __restrict__ src, int N, int K, u16* __restrict__ dst, int tile, char* smem) {
  float* lds = (float*)smem;
  const int tiles_n = N >> 6;
  const int tk = tile / tiles_n, tn = tile - tk * tiles_n;
  const int tid = opaque_tid();
  {
    const int r = tid >> 3, c8 = (tid & 7) * 8;
    const float* s = src + (size_t)(tk * 64 + r) * N + tn * 64 + c8;
    float4 a = *(const float4*)s, b = *(const float4*)(s + 4);
    float* d = lds + r * 65 + c8;
    d[0] = a.x; d[1] = a.y; d[2] = a.z; d[3] = a.w; d[4] = b.x; d[5] = b.y; d[6] = b.z; d[7] = b.w;
  }
  __syncthreads();
  {
    const int n = tid >> 3, k0 = (tid & 7) * 8;
    uint4 o;
    o.x = pk2(lds[(k0 + 0) * 65 + n], lds[(k0 + 1) * 65 + n]);
    o.y = pk2(lds[(k0 + 2) * 65 + n], lds[(k0 + 3) * 65 + n]);
    o.z = pk2(lds[(k0 + 4) * 65 + n], lds[(k0 + 5) * 65 + n]);
    o.w = pk2(lds[(k0 + 6) * 65 + n], lds[(k0 + 7) * 65 + n]);
    *(uint4*)(dst + (size_t)(tn * 64 + n) * K + tk * 64 + k0) = o;
  }
  __syncthreads();
}
__device__ __forceinline__ void colmax_task(const float* __restrict__ w, int N, int n0, float* __restrict__ swp, char* smem) {
  const int tid = opaque_tid();
  const int col = tid & 63, kg = tid >> 6;
  float m = 0.f;
  const float* wp = w + (size_t)(kg * 128) * N + n0 + col;
#pragma unroll 16
  for (int k = 0; k < 128; ++k) m = fmaxf(m, fabsf(wp[(size_t)k * N]));
  float* red = (float*)smem;
  red[kg * 64 + col] = m;
  __syncthreads();
  if (tid < 64) {
    float mm = red[tid];
#pragma unroll
    for (int g = 1; g < 8; ++g) mm = fmaxf(mm, red[g * 64 + tid]);
    swp[n0 + tid] = fmaxf(mm, 1e-20f) * (1.0f / 127.0f);
  }
  __syncthreads();
}
__device__ __forceinline__ void tr_tile_i8(const float* __restrict__ src, int N, int K, unsigned char* __restrict__ dst, int tile, const float* __restrict__ swp, char* smem) {
  float* lds = (float*)smem;
  const int tiles_n = N >> 6;
  const int tk = tile / tiles_n, tn = tile - tk * tiles_n;
  const int tid = opaque_tid();
  {
    const int r = tid >> 3, c8 = (tid & 7) * 8;
    const float* sp = src + (size_t)(tk * 64 + r) * N + tn * 64 + c8;
    float4 a = *(const float4*)sp, b = *(const float4*)(sp + 4);
    float* d = lds + r * 65 + c8;
    d[0] = a.x; d[1] = a.y; d[2] = a.z; d[3] = a.w; d[4] = b.x; d[5] = b.y; d[6] = b.z; d[7] = b.w;
  }
  __syncthreads();
  {
    const int n = tid >> 3, k0 = (tid & 7) * 8;
    const float inv = 1.0f / swp[tn * 64 + n];
    unsigned w0 = 0, w1 = 0;
#pragma unroll
    for (int i = 0; i < 4; ++i) {
      w0 |= ((unsigned)__float2int_rn(lds[(k0 + i) * 65 + n] * inv) & 255u) << (8 * i);
      w1 |= ((unsigned)__float2int_rn(lds[(k0 + 4 + i) * 65 + n] * inv) & 255u) << (8 * i);
    }
    *(uint2*)(dst + (size_t)(tn * 64 + n) * K + tk * 64 + k0) = make_uint2(w0, w1);
  }
  __syncthreads();
}
__device__ __forceinline__ void cvt_chunk(const float* __restrict__ src, u16* __restrict__ dst, size_t chunk) {
  const size_t i = chunk * 4096 + (size_t)opaque_tid() * 8;
  float4 a = *(const float4*)(src + i), b = *(const float4*)(src + i + 4);
  uint4 o;
  o.x = pk2(a.x, a.y); o.y = pk2(a.z, a.w); o.z = pk2(b.x, b.y); o.w = pk2(b.z, b.w);
  *(uint4*)(dst + i) = o;
}
__device__ __forceinline__ void cvt_chunk_fp8(const float* __restrict__ src, unsigned char* __restrict__ dst, size_t chunk, float scale) {
  const size_t i = chunk * 4096 + (size_t)opaque_tid() * 8;
  const float4 a = *(const float4*)(src + i), b = *(const float4*)(src + i + 4);
  int w0 = __builtin_amdgcn_cvt_pk_fp8_f32(a.x * scale, a.y * scale, 0, false);
  w0 = __builtin_amdgcn_cvt_pk_fp8_f32(a.z * scale, a.w * scale, w0, true);
  int w1 = __builtin_amdgcn_cvt_pk_fp8_f32(b.x * scale, b.y * scale, 0, false);
  w1 = __builtin_amdgcn_cvt_pk_fp8_f32(b.z * scale, b.w * scale, w1, true);
  *(uint2*)(dst + i) = make_uint2((unsigned)w0, (unsigned)w1);
}
__device__ __forceinline__ void cvt_chunk_fp4(const float* __restrict__ src, unsigned char* __restrict__ dst, size_t chunk, float scale, int vhalf) {
  const size_t i = chunk * 4096 + (size_t)opaque_tid() * 8;
  const float4 a = *(const float4*)(src + i), b = *(const float4*)(src + i + 4);
  unsigned w = 0;
  w = __builtin_amdgcn_cvt_scalef32_pk_fp4_f32(w, a.x * scale, a.y * scale, 1.0f, 0);
  w = __builtin_amdgcn_cvt_scalef32_pk_fp4_f32(w, a.z * scale, a.w * scale, 1.0f, 1);
  w = __builtin_amdgcn_cvt_scalef32_pk_fp4_f32(w, b.x * scale, b.y * scale, 1.0f, 2);
  w = __builtin_amdgcn_cvt_scalef32_pk_fp4_f32(w, b.z * scale, b.w * scale, 1.0f, 3);
  const size_t e = i >> 10;
  const unsigned d = (unsigned)(i & 1023);
  *(unsigned*)(dst + e * 1024 + (d >> 4) * 16 + vhalf * 8 + ((d & 15) >> 1)) = w;
}
__device__ __forceinline__ void phase_prep(const P& p, char* smem) {
  const int tid = opaque_tid();
  const int NTR = 2512;
  const int total = 2 * NTR + 128 + 384;
  for (int task = blockIdx.x; task < total; task += gridDim.x) {
    if (task < 2 * NTR) {
      const int l = task / NTR;
      int t = task - l * NTR;
      if (t < 704) { if (t < 44) colmax_task(p.w_in + (size_t)l * 1024 * 2816, 2816, t * 64, p.sw + l * 5888, smem); }
      else if ((t -= 704) < 768) { if (t < 48) colmax_task(p.w_gate + (size_t)l * 1024 * 3072, 3072, t * 64, p.sw + l * 5888 + 2816, smem); }
      else if ((t -= 768) < 128) tr_tile(p.w_br_a + (size_t)l * 512 * 1024, 1024, 512, p.WaT + (size_t)l * 1024 * 512, t, smem);
      else if ((t -= 128) < 64) tr_tile(p.w_br_b + (size_t)l * 256 * 1024, 1024, 256, p.WbT + (size_t)l * 1024 * 256, t, smem);
      else if ((t -= 64) < 64) tr_tile(p.w_br_c + (size_t)l * 256 * 1024, 1024, 256, p.WcT + (size_t)l * 1024 * 256, t, smem);
      else if ((t -= 64) < 256) tr_tile(p.w_out + (size_t)l * 1024 * 1024, 1024, 1024, p.WoT + (size_t)l * 1024 * 1024, t, smem);
      else if ((t -= 256) < 512) cvt_chunk(p.peer_wq + (size_t)l * 1024 * 2048, p.WqB + (size_t)l * 1024 * 2048, (size_t)t);
      else {
        t -= 512;
        const int gate = t >> 3, dn = t & 7;
        const float* src = (gate ? p.rg_wx : p.rg_wa) + (size_t)(l * 8 + dn) * 4096;
        tr_tile(src, 64, 64, p.rgW + (size_t)((l * 2 + gate) * 8 + dn) * 4096, 0, smem);
      }
    } else if (task < 2 * NTR + 128) {
      cvt_chunk(p.peer_keys, p.keysB, (size_t)(task - 2 * NTR));
    } else {
      int t = task - 2 * NTR - 128;
      const int kc = t & 15; t >>= 4;
      const int jc = t % 12, l = t / 12;
      float* s = (float*)smem;
      for (int i = tid; i < 576; i += NTHR) {
        const int bi = i >> 6, kk = i & 63;
        const float v = (bi < 8) ? p.c[bi * 1024 + kc * 64 + kk] : p.c_ctx[kc * 64 + kk];
        s[i] = v / (1.0f + __expf(-v));
      }
      __syncthreads();
      const int j = jc * 512 + tid;
      float acc[9];
#pragma unroll
      for (int bi = 0; bi < 9; ++bi) acc[bi] = 0.f;
      const float* wp = p.w_ada + ((size_t)l * 1024 + kc * 64) * 6144 + j;
#pragma unroll 8
      for (int kk = 0; kk < 64; ++kk) {
        const float w = wp[(size_t)kk * 6144];
#pragma unroll
        for (int bi = 0; bi < 9; ++bi) acc[bi] += s[bi * 64 + kk] * w;
      }
#pragma unroll
      for (int bi = 0; bi < 9; ++bi) p.modpart[((size_t)(kc * 2 + l) * 9 + bi) * 6144 + j] = acc[bi];
      __syncthreads();
    }
  }
}
__device__ __forceinline__ void phase_modreduce(const P& p) {
  const int n = 2 * 9 * 6144;
  for (int i = blockIdx.x * NTHR + opaque_tid(); i < n; i += gridDim.x * NTHR) {
    const int l = i / (9 * 6144);
    const int j = i % 6144;
    float s = p.b_ada[l * 6144 + j];
#pragma unroll
    for (int kc = 0; kc < 16; ++kc) s += p.modpart[(size_t)kc * n + i];
    p.mod[i] = s;
  }
}

__device__ __forceinline__ void phase_norm(const P& p, int l, int which) {
  const int tid_ = opaque_tid(); const int lane = tid_ & 63, wid = tid_ >> 6;
  const int ntok = (which == 2 || (which == 1 && l == 1)) ? NLAT : NTOK;
  for (int row = blockIdx.x * 8 + wid; row < ntok; row += gridDim.x * 8) {
    const float* src;
    if (row < NLAT) src = ((which == 0 && l == 0) ? p.x : p.out) + (size_t)row * 1024;
    else src = ((which == 0 && l == 0) ? p.ctx : p.ctxs) + (size_t)(row - NLAT) * 1024;
    float4 v[4];
    float ss = 0.f;
#pragma unroll
    for (int i = 0; i < 4; ++i) {
      v[i] = *(const float4*)(src + i * 256 + lane * 4);
      ss += v[i].x * v[i].x + v[i].y * v[i].y + v[i].z * v[i].z + v[i].w * v[i].w;
    }
    ss = wave_sum(ss);
    const float rstd = rsqrtf(ss * (1.0f / 1024.0f) + 1e-6f);
    if (which == 2) {
#pragma unroll
      for (int i = 0; i < 4; ++i) {
        const int col = i * 256 + lane * 4;
        const float4 g = *(const float4*)(p.final_g + col);
        float4 o = {v[i].x * rstd * g.x, v[i].y * rstd * g.y, v[i].z * rstd * g.z, v[i].w * rstd * g.w};
        *(float4*)(p.out + (size_t)row * 1024 + col) = o;
      }
    } else {
      const int bi = row < NLAT ? (row >> 12) : 8;
      const float* gam = (which == 0 ? p.norm_mix_g : p.norm_ffn_g) + l * 1024;
      const float* msh = p.mod + ((size_t)(l * 9 + bi) * 6 + (which == 0 ? 0 : 3)) * 1024;
      const float* msc = msh + 1024;
      float4 y[4];
      float amax = 0.f;
#pragma unroll
      for (int i = 0; i < 4; ++i) {
        const int col = i * 256 + lane * 4;
        const float4 g = *(const float4*)(gam + col);
        const float4 sh = *(const float4*)(msh + col);
        const float4 sc = *(const float4*)(msc + col);
        y[i].x = v[i].x * rstd * g.x * (1.f + sc.x) + sh.x; y[i].y = v[i].y * rstd * g.y * (1.f + sc.y) + sh.y;
        y[i].z = v[i].z * rstd * g.z * (1.f + sc.z) + sh.z; y[i].w = v[i].w * rstd * g.w * (1.f + sc.w) + sh.w;
        amax = fmaxf(amax, fmaxf(fmaxf(fabsf(y[i].x), fabsf(y[i].y)), fmaxf(fabsf(y[i].z), fabsf(y[i].w))));
      }
      if (which == 0) {
        amax = fmaxf(wave_max(amax), 1e-20f);
        const float inv = 127.0f / amax;
#pragma unroll
        for (int i = 0; i < 4; ++i) {
          const unsigned w = ((unsigned)__float2int_rn(y[i].x * inv) & 255u) | (((unsigned)__float2int_rn(y[i].y * inv) & 255u) << 8) |
                             (((unsigned)__float2int_rn(y[i].z * inv) & 255u) << 16) | (((unsigned)__float2int_rn(y[i].w * inv) & 255u) << 24);
          *(unsigned*)(p.xn8 + (size_t)row * 1024 + i * 256 + lane * 4) = w;
        }
        if (lane == 0) p.sa[row] = amax * (1.0f / 127.0f);
      } else {
#pragma unroll
        for (int i = 0; i < 4; ++i) {
          uint2 o;
          o.x = pk2(y[i].x, y[i].y);
          o.y = pk2(y[i].z, y[i].w);
          *(uint2*)(p.xn + (size_t)row * 1024 + i * 256 + lane * 4) = o;
        }
      }
    }
  }
}

__device__ __forceinline__ void filter_wave(const P& p, int l, int L, int t, float* __restrict__ outp) {
  const int lane = opaque_tid() & 63;
  const float tl = (float)t / (float)(L - 1);
  const float wang = (6.283185307179586f / (float)L) * (float)t;
  float z = 0.f;
  if (lane == 0) z = tl;
  else if (lane <= 16) { const float band = 1e-4f + (float)(lane - 1) * ((15.0f - 1e-4f) / 15.0f); z = cosf(band * wang); }
  else if (lane <= 32) { const float band = 1e-4f + (float)(lane - 17) * ((15.0f - 1e-4f) / 15.0f); z = -sinf(band * wang); }
  float a1 = p.hy_f1_b[l * 64 + lane];
  for (int i = 0; i < 33; ++i) a1 += shf(z, i) * p.hy_f1_w[(l * 33 + i) * 64 + lane];
  const float h1 = sinf(p.hy_freq[l * 128 + lane] * a1);
  float a2 = p.hy_f2_b[l * 64 + lane];
  for (int i = 0; i < 64; ++i) a2 += shf(h1, i) * p.hy_f2_w[(l * 64 + i) * 64 + lane];
  const float h2 = sinf(p.hy_freq[l * 128 + 64 + lane] * a2);
  float a3[8];
#pragma unroll
  for (int m = 0; m < 8; ++m) a3[m] = 0.f;
  for (int i = 0; i < 64; ++i) {
    const float hv = shf(h2, i);
    const float* wr = p.hy_f3_w + (size_t)(l * 64 + i) * 512 + lane;
#pragma unroll
    for (int m = 0; m < 8; ++m) a3[m] += hv * wr[m * 64];
  }
  const float LN100 = 4.605170185988092f;
  const float d0 = LN100 / 1.5f, d1 = LN100 / 0.3f;
#pragma unroll
  for (int m = 0; m < 8; ++m) {
    const int cp = lane + 64 * m;
    const int ch = cp & 255;
    const float delta = d0 + (float)ch * ((d1 - d0) / 255.0f);
    outp[(size_t)cp * L + t] = a3[m] * expf(-tl * delta);
  }
}
__device__ __forceinline__ void filter_block_task(const P& p, int l, int L, int t0, float* __restrict__ outp, char* smem) {
  const int tid = opaque_tid(), lane = tid & 63, wid = tid >> 6;
  float* W3s = (float*)smem;
  float* W2s = (float*)(smem + 131072);
  {
    const float4* s3 = (const float4*)(p.hy_f3_w + (size_t)l * 64 * 512);
    const float4* s2 = (const float4*)(p.hy_f2_w + (size_t)l * 64 * 64);
#pragma unroll
    for (int i = 0; i < 16; ++i) ((float4*)W3s)[tid + NTHR * i] = s3[tid + NTHR * i];
#pragma unroll
    for (int i = 0; i < 2; ++i) ((float4*)W2s)[tid + NTHR * i] = s2[tid + NTHR * i];
  }
  __syncthreads();
  float z[4], tl[4];
#pragma unroll
  for (int j = 0; j < 4; ++j) {
    const int t = t0 + wid * 4 + j;
    tl[j] = (float)t / (float)(L - 1);
    const float wang = (6.283185307179586f / (float)L) * (float)t;
    float zz = 0.f;
    if (lane == 0) zz = tl[j];
    else if (lane <= 16) { const float band = 1e-4f + (float)(lane - 1) * ((15.0f - 1e-4f) / 15.0f); zz = cosf(band * wang); }
    else if (lane <= 32) { const float band = 1e-4f + (float)(lane - 17) * ((15.0f - 1e-4f) / 15.0f); zz = -sinf(band * wang); }
    z[j] = zz;
  }
  float a1[4], a2[4];
  {
    const float b1 = p.hy_f1_b[l * 64 + lane];
#pragma unroll
    for (int j = 0; j < 4; ++j) a1[j] = b1;
#pragma unroll 11
    for (int i = 0; i < 33; ++i) {
      const float w = p.hy_f1_w[(l * 33 + i) * 64 + lane];
#pragma unroll
      for (int j = 0; j < 4; ++j) a1[j] += shf(z[j], i) * w;
    }
    const float f0 = p.hy_freq[l * 128 + lane];
#pragma unroll
    for (int j = 0; j < 4; ++j) a1[j] = sinf(f0 * a1[j]);
  }
  {
    const float b2 = p.hy_f2_b[l * 64 + lane];
#pragma unroll
    for (int j = 0; j < 4; ++j) a2[j] = b2;
#pragma unroll 8
    for (int i = 0; i < 64; ++i) {
      const float w = W2s[i * 64 + lane];
#pragma unroll
      for (int j = 0; j < 4; ++j) a2[j] += shf(a1[j], i) * w;
    }
    const float f1 = p.hy_freq[l * 128 + 64 + lane];
#pragma unroll
    for (int j = 0; j < 4; ++j) a2[j] = sinf(f1 * a2[j]);
  }
  float a3[4][8];
#pragma unroll
  for (int j = 0; j < 4; ++j)
#pragma unroll
    for (int m = 0; m < 8; ++m) a3[j][m] = 0.f;
#pragma unroll 4
  for (int i = 0; i < 64; ++i) {
    float w[8];
#pragma unroll
    for (int m = 0; m < 8; ++m) w[m] = W3s[i * 512 + lane + 64 * m];
#pragma unroll
    for (int j = 0; j < 4; ++j) {
      const float hv = shf(a2[j], i);
#pragma unroll
      for (int m = 0; m < 8; ++m) a3[j][m] += hv * w[m];
    }
  }
  const float LN100 = 4.605170185988092f;
  const float d0 = LN100 / 1.5f, d1 = LN100 / 0.3f;
#pragma unroll
  for (int m = 0; m < 8; ++m) {
    const int cp = lane + 64 * m;
    const float delta = d0 + (float)(cp & 255) * ((d1 - d0) / 255.0f);
    float4 o;
    o.x = a3[0][m] * expf(-tl[0] * delta); o.y = a3[1][m] * expf(-tl[1] * delta);
    o.z = a3[2][m] * expf(-tl[2] * delta); o.w = a3[3][m] * expf(-tl[3] * delta);
    *(float4*)(outp + (size_t)cp * L + t0 + wid * 4) = o;
  }
  __syncthreads();
}
__device__ __forceinline__ void phase_filters(const P& p, int l, char* smem) {
  const int ntask = 128 + (l == 0 ? 8 : 0);
  for (int t = blockIdx.x; t < ntask; t += gridDim.x) {
    if (t < 128) filter_block_task(p, l, 4096, t * 32, p.hT + (size_t)l * 512 * 4096, smem);
    else filter_block_task(p, l, 256, (t - 128) * 32, p.hc, smem);
  }
}
__device__ __forceinline__ void kf_task(const P& p, int l, int c, char* smem) {
  const float* hTl = p.hT + (size_t)l * 512 * 4096;
  c2* buf = (c2*)smem;
  const int tid = opaque_tid();
  for (int i = 0; i < 16; ++i) {
    const int j = tid + NTHR * i;
    float v;
    if (j < 4096) v = hTl[(size_t)c * 4096 + j];
    else if (j == 4096) v = 0.f;
    else v = hTl[(size_t)(256 + c) * 4096 + (8192 - j)];
    buf[j] = {v, 0.f};
  }
  __syncthreads();
  fft8192(buf, -1.f);
  c2* o = (c2*)p.Kf + ((size_t)l * 256 + c) * 8192;
  for (int i = 0; i < 16; ++i) { const int j = tid + NTHR * i; o[j] = buf[j]; }
  __syncthreads();
}

__device__ __forceinline__ void inproj_tile(const P& p, int l, int mt, int nt, char* smem) {
  f32x16 acc[2][2];
  zero_acc(acc);
  const int m0 = mt * 256, n0 = nt * 128;
  gemm_kloop(acc, p.xn + (size_t)m0 * 1024, 1024, p.WinT + ((size_t)l * 2816 + n0) * 1024, 1024, 1024, smem);
  EPI_VARS
  if (nt < 8 || nt >= 18) {
    u16* dst; int ld, cbase;
    if (nt < 8) { dst = p.qk; ld = 1024; cbase = n0; }
    else { dst = p.rg; ld = 512; cbase = n0 - 2304; }
#pragma unroll
    for (int i = 0; i < 2; ++i)
#pragma unroll
      for (int j = 0; j < 2; ++j)
#pragma unroll
        for (int e = 0; e < 16; ++e)
          dst[(size_t)(m0 + EPI_ROW(i, e)) * ld + cbase + EPI_COL(j)] = f2bf(acc[i][j][e]);
  } else {
#pragma unroll
    for (int i = 0; i < 2; ++i)
#pragma unroll
      for (int j = 0; j < 2; ++j)
#pragma unroll
        for (int qd = 0; qd < 4; ++qd) {
          uint2 o;
          o.x = pk2(acc[i][j][4 * qd + 0], acc[i][j][4 * qd + 1]);
          o.y = pk2(acc[i][j][4 * qd + 2], acc[i][j][4 * qd + 3]);
          const int row0 = wm * 64 + i * 32 + 8 * qd + 4 * hh;
          *(uint2*)(smem + EPI_COL(j) * 520 + row0 * 2) = o;
        }
    __syncthreads();
    u16* dstT; int Lseg, t0, ncol0, nc;
    const bool isctx = (mt >= 128);
    const int b = isctx ? (mt - 128) : (mt >> 4);
    if (nt < 12) { ncol0 = n0 - 1024; nc = 512; dstT = isctx ? p.vTc : p.vT; }
    else { ncol0 = n0 - 1536; nc = 768; dstT = isctx ? p.hyTc : p.hyT; }
    if (isctx) { Lseg = 256; t0 = 0; } else { Lseg = 4096; t0 = (mt & 15) * 256; }
#pragma unroll 4
    for (int it = 0; it < 16; ++it) {
      const int idx = tid + NTHR * it;
      const int col = idx >> 6, u = idx & 63;
      const uint2 v = *(const uint2*)(smem + col * 520 + u * 8);
      *(uint2*)(dstT + ((size_t)(b * nc + ncol0 + col)) * Lseg + t0 + u * 4) = v;
    }
    __syncthreads();
  }
}

__device__ __forceinline__ float ldbf(const u16* p, int t, int L) { return (t >= 0 && t < L) ? bf2f(p[t]) : 0.f; }
__device__ __forceinline__ void ld10(const u16* __restrict__ seq, int t0, float (&v)[10]) {
  const uint4 r = *(const uint4*)(seq + t0);
  v[0] = (t0 > 0) ? bf2f(seq[t0 - 1]) : 0.f;
  v[9] = (t0 + 8 < 4096) ? bf2f(seq[t0 + 8]) : 0.f;
  v[1] = bflo(r.x); v[2] = bfhi(r.x); v[3] = bflo(r.y); v[4] = bfhi(r.y);
  v[5] = bflo(r.z); v[6] = bfhi(r.z); v[7] = bflo(r.w); v[8] = bfhi(r.w);
}
__device__ __forceinline__ void hyena_fft_task(const P& p, int l, int c, int bp, char* smem) {
  c2* buf = (c2*)smem;
  c2* ub = (c2*)(smem + 65536);
  const int tid = opaque_tid();
  const float* sw = p.hy_short_w + l * 3 * 768;
  const float* sb = p.hy_short_b + l * 768;
  const float wx0[3] = {sw[c], sw[768 + c], sw[1536 + c]};
  const float wx1[3] = {sw[256 + c], sw[768 + 256 + c], sw[1536 + 256 + c]};
  const float wv[3] = {sw[512 + c], sw[768 + 512 + c], sw[1536 + 512 + c]};
  const float bx0 = sb[c], bx1 = sb[256 + c], bv = sb[512 + c];
  const float dsk = p.hy_bias[l * 256 + c];
  const int t0 = tid * 8;
  {
    float u[2][8];
#pragma unroll
    for (int bb = 0; bb < 2; ++bb) {
      const int b = 2 * bp + bb;
      float x1[10], vv[10];
      ld10(p.hyT + ((size_t)(b * 768 + 256 + c)) * 4096, t0, x1);
      ld10(p.hyT + ((size_t)(b * 768 + 512 + c)) * 4096, t0, vv);
#pragma unroll
      for (int k = 0; k < 8; ++k) {
        const float x1c = bx1 + wx1[0] * x1[k] + wx1[1] * x1[k + 1] + wx1[2] * x1[k + 2];
        const float vc = bv + wv[0] * vv[k] + wv[1] * vv[k + 1] + wv[2] * vv[k + 2];
        u[bb][k] = vc * x1c;
      }
    }
#pragma unroll
    for (int k = 0; k < 8; k += 2) {
      const float4 w = make_float4(u[0][k], u[1][k], u[0][k + 1], u[1][k + 1]);
      *(float4*)(buf + t0 + k) = w;
      *(float4*)(ub + t0 + k) = w;
      *(float4*)(buf + 4096 + t0 + k) = make_float4(0.f, 0.f, 0.f, 0.f);
    }
  }
  __syncthreads();
  fft8192(buf, -1.f);
  const c2* kf = (const c2*)p.Kf + ((size_t)l * 256 + c) * 8192;
  for (int i = 0; i < 16; ++i) {
    const int k = tid + NTHR * i;
    buf[k] = cmul(buf[k], kf[k]);
  }
  __syncthreads();
  fft8192(buf, 1.f);
#pragma unroll
  for (int bb = 0; bb < 2; ++bb) {
    const int b = 2 * bp + bb;
    float x0[10];
    ld10(p.hyT + ((size_t)(b * 768 + c)) * 4096, t0, x0);
    float o[8];
#pragma unroll
    for (int k = 0; k < 8; ++k) {
      const c2 y = buf[t0 + k];
      const c2 uu = ub[t0 + k];
      const float x0c = bx0 + wx0[0] * x0[k] + wx0[1] * x0[k + 1] + wx0[2] * x0[k + 2];
      const float yy = ldexpf(bb ? y.y : y.x, -13);
      const float uv = bb ? uu.y : uu.x;
      o[k] = x0c * (yy + uv * dsk);
    }
    uint4 w; w.x = pk2(o[0], o[1]); w.y = pk2(o[2], o[3]); w.z = pk2(o[4], o[5]); w.w = pk2(o[6], o[7]);
    *(uint4*)(p.ybT + ((size_t)(b * 256 + c)) * 4096 + t0) = w;
  }
  __syncthreads();
}
__device__ __forceinline__ void yb_transpose_task(const P& p, int b, int tb, char* smem) {
  const int tid = opaque_tid(), lane = tid & 63, wid = tid >> 6;
  u16* T = (u16*)smem;
#pragma unroll
  for (int it = 0; it < 4; ++it) {
    const int id = tid + NTHR * it;
    const int c = id >> 3, ch = id & 7;
    const uint4 r = *(const uint4*)(p.ybT + ((size_t)(b * 256 + c)) * 4096 + tb * 64 + ch * 8);
    unsigned* d = (unsigned*)(T + c * 66 + ch * 8);
    d[0] = r.x; d[1] = r.y; d[2] = r.z; d[3] = r.w;
  }
  __syncthreads();
#pragma unroll
  for (int it = 0; it < 8; ++it) {
    const int tt = wid + 8 * it;
    const int c0 = lane * 4;
    uint2 w;
    w.x = (unsigned)T[(c0 + 0) * 66 + tt] | ((unsigned)T[(c0 + 1) * 66 + tt] << 16);
    w.y = (unsigned)T[(c0 + 2) * 66 + tt] | ((unsigned)T[(c0 + 3) * 66 + tt] << 16);
    *(uint2*)(p.ycat + (size_t)(b * 4096 + tb * 64 + tt) * 1024 + 512 + c0) = w;
  }
  __syncthreads();
}
__device__ __forceinline__ void hyena_ctx_task(const P& p, int l, int b, int cg8, char* smem) {
  const int tid_ = opaque_tid(); const int lane = tid_ & 63, wid = tid_ >> 6;
  const int c = cg8 * 8 + wid;
  float* us = (float*)smem + wid * 1024;
  float* kfp = us + 256 + 255;
  const float* sw = p.hy_short_w + l * 3 * 768;
  const float* sb = p.hy_short_b + l * 768;
  const u16* x0 = p.hyTc + ((size_t)(b * 768 + c)) * 256;
  const u16* x1 = p.hyTc + ((size_t)(b * 768 + 256 + c)) * 256;
  const u16* vv = p.hyTc + ((size_t)(b * 768 + 512 + c)) * 256;
  for (int i = 0; i < 4; ++i) {
    const int t = lane + 64 * i;
    const float x1c = sb[256 + c] + sw[256 + c] * ldbf(x1, t - 1, 256) + sw[768 + 256 + c] * ldbf(x1, t, 256) + sw[1536 + 256 + c] * ldbf(x1, t + 1, 256);
    const float vc = sb[512 + c] + sw[512 + c] * ldbf(vv, t - 1, 256) + sw[768 + 512 + c] * ldbf(vv, t, 256) + sw[1536 + 512 + c] * ldbf(vv, t + 1, 256);
    us[t] = vc * x1c;
    kfp[t] = p.hc[(size_t)c * 256 + t];
    if (t > 0) kfp[-t] = p.hc[(size_t)(256 + c) * 256 + t];
  }
  __syncthreads();
  const float dsk = p.hy_bias[l * 256 + c];
  float acc[4] = {0.f, 0.f, 0.f, 0.f};
  for (int s = 0; s < 256; ++s) {
    const float uv = us[s];
#pragma unroll
    for (int i = 0; i < 4; ++i) acc[i] += kfp[lane + 64 * i - s] * uv;
  }
#pragma unroll
  for (int i = 0; i < 4; ++i) {
    const int t = lane + 64 * i;
    const float x0c = sb[c] + sw[c] * ldbf(x0, t - 1, 256) + sw[768 + c] * ldbf(x0, t, 256) + sw[1536 + c] * ldbf(x0, t + 1, 256);
    p.ycat[(size_t)(NLAT + b * 256 + t) * 1024 + 512 + c] = f2bf(x0c * (acc[i] + us[t] * dsk));
  }
  __syncthreads();
}

template <int DIR>
__device__ __forceinline__ void rg_scan32(const float (&Av)[2][16], const float (&Bv)[2][16], float (&carry)[2], float (&H)[2][16], int hh) {
#pragma unroll
  for (int nt = 0; nt < 2; ++nt) {
    float c = carry[nt];
#pragma unroll
    for (int go = 0; go < 8; ++go) {
      const int g = DIR ? 7 - go : go, q = g >> 1, own = g & 1;
      float h = c;
#pragma unroll
      for (int io = 0; io < 4; ++io) {
        const int e = 4 * q + (DIR ? 3 - io : io);
        h = Av[nt][e] * h + Bv[nt][e];
        H[nt][e] = (hh == own) ? h : H[nt][e];
      }
      const float mine = (hh == own) ? h : c;
      const float other = shx(mine, 32);
      c = (hh == own) ? mine : other;
    }
    carry[nt] = c;
  }
}
__device__ __forceinline__ void rg_wave_task(const P& p, int l, int bq, int nblk, int mode, bool last, char* smem) {
  const int tid = opaque_tid(), lane = tid & 63, wid = tid >> 6;
  const int l31 = lane & 31, hh = lane >> 5;
  const int b = bq / 34, rr = bq - b * 34;
  const int seg = rr < 2 ? 0 : 1, blk = rr < 2 ? rr : rr - 2;
  if (mode == 1 && seg == 0 && last) return;
  const int ck = wid >> 1, dir = wid & 1;
  char* wreg = smem + wid * 17408;
  u16* xs = (u16*)wreg;
  char* xcb = wreg + 4608;
  float* xcf = (float*)(wreg + 8704);
  float2* blockagg = (float2*)(smem + 139264);
  const int Lseg = seg ? 4096 : 256;
  const int tokbase = seg ? b * 4096 : NLAT + b * 256;
  const int T0 = blk * 128 + ck * 32;
  const int cg32 = (seg ? 8 : 0) + blk * 4 + ck;
  bf16x8 wf[2][2][4];
#pragma unroll
  for (int gate = 0; gate < 2; ++gate) {
    const u16* wp = p.rgW + (size_t)(((l * 2 + gate) * 2 + dir) * 4 + nblk) * 4096 + l31 * 64 + 8 * hh;
#pragma unroll
    for (int nt = 0; nt < 2; ++nt)
#pragma unroll
      for (int s = 0; s < 4; ++s) wf[gate][nt][s] = *(const bf16x8*)(wp + nt * 2048 + 16 * s);
  }
  float cba[2], cbx[2], csp[2];
#pragma unroll
  for (int nt = 0; nt < 2; ++nt) {
    const int ch = (l * 2 + dir) * 256 + nblk * 64 + nt * 32 + l31;
    cba[nt] = p.rg_ba[ch];
    cbx[nt] = p.rg_bx[ch];
    csp[nt] = __logf(1.0f + __expf(-p.rg_lambda[ch]));
  }
#pragma unroll
  for (int i = 0; i < 5; ++i) {
    const int idx = lane + 64 * i;
    const int row = idx >> 3, chunk = idx & 7;
    if (row < 35) {
      const int pos = T0 - 2 + row;
      uint4 v = make_uint4(0u, 0u, 0u, 0u);
      if (pos >= 0 && pos < Lseg) v = *(const uint4*)(p.rg + (size_t)(tokbase + pos) * 512 + nblk * 64 + chunk * 8);
      *(uint4*)(xs + row * 64 + chunk * 8) = v;
    }
  }
  asm volatile("s_waitcnt lgkmcnt(0)" ::: "memory");
  {
    const int ch = l * 256 + nblk * 64 + lane;
    const float w0 = p.rg_conv_w[(l * 4 + 0) * 256 + nblk * 64 + lane], w1 = p.rg_conv_w[(l * 4 + 1) * 256 + nblk * 64 + lane];
    const float w2 = p.rg_conv_w[(l * 4 + 2) * 256 + nblk * 64 + lane], w3 = p.rg_conv_w[(l * 4 + 3) * 256 + nblk * 64 + lane];
    const float cb = p.rg_conv_b[ch];
    float x0 = bf2f(xs[0 * 64 + lane]), x1 = bf2f(xs[1 * 64 + lane]), x2 = bf2f(xs[2 * 64 + lane]);
#pragma unroll
    for (int t = 0; t < 32; ++t) {
      const float x3 = bf2f(xs[(t + 3) * 64 + lane]);
      const float xc = cb + w0 * x0 + w1 * x1 + w2 * x2 + w3 * x3;
      xcf[t * 68 + lane] = xc;
      *(u16*)(xcb + swz128(t, lane >> 3) + (lane & 7) * 2) = f2bf(xc);
      x0 = x1; x1 = x2; x2 = x3;
    }
  }
  asm volatile("s_waitcnt lgkmcnt(0)" ::: "memory");
  float Av[2][16], Bv[2][16];
  {
    f32x16 acc[2][2];
#pragma unroll
    for (int gate = 0; gate < 2; ++gate)
#pragma unroll
      for (int nt = 0; nt < 2; ++nt) acc[gate][nt] = zero16();
#pragma unroll
    for (int s = 0; s < 4; ++s) {
      const bf16x8 af = *(const bf16x8*)(xcb + swz128(l31, 2 * s + hh));
#pragma unroll
      for (int gate = 0; gate < 2; ++gate)
#pragma unroll
        for (int nt = 0; nt < 2; ++nt) acc[gate][nt] = mfma32(af, wf[gate][nt][s], acc[gate][nt]);
    }
#pragma unroll
    for (int nt = 0; nt < 2; ++nt)
#pragma unroll
      for (int e = 0; e < 16; ++e) {
        const int tok = (e & 3) + 8 * (e >> 2) + 4 * hh;
        const float r = sigmoidf_(acc[0][nt][e] + cba[nt]);
        const float ii = sigmoidf_(acc[1][nt][e] + cbx[nt]);
        const float la = -8.0f * r * csp[nt];
        const float av = __expf(la);
        const float e2 = 2.0f * la;
        const float om = (e2 > -0.1f) ? (-e2 * (1.0f + e2 * (0.5f + e2 * (0.16666667f + e2 * 0.041666668f)))) : (1.0f - __expf(e2));
        Av[nt][e] = av;
        Bv[nt][e] = sqrtf(om) * ii * xcf[tok * 68 + nt * 32 + l31];
      }
  }
  float H[2][16];
#pragma unroll
  for (int nt = 0; nt < 2; ++nt)
#pragma unroll
    for (int e = 0; e < 16; ++e) H[nt][e] = 0.f;
  float carry[2] = {0.f, 0.f};
  float2* agg1 = (float2*)p.agg;
  float2* agg2 = (float2*)p.agg + (size_t)8 * 2 * 136 * 256;
  const int pos2 = dir ? (seg == 0 ? 1 - blk : 33 - blk) : (seg == 0 ? blk : 2 + blk);
  if (mode == 0) {
    if (dir) rg_scan32<1>(Av, Bv, carry, H, hh); else rg_scan32<0>(Av, Bv, carry, H, hh);
    float P[2];
#pragma unroll
    for (int nt = 0; nt < 2; ++nt) {
      float pr = 1.f;
#pragma unroll
      for (int e = 0; e < 16; ++e) pr *= Av[nt][e];
      P[nt] = pr * shx(pr, 32);
    }
    const float2 mine = make_float2(hh ? P[1] : P[0], hh ? carry[1] : carry[0]);
    agg1[((size_t)(b * 2 + dir) * 136 + cg32) * 256 + nblk * 64 + lane] = mine;
    blockagg[(ck * 2 + dir) * 64 + lane] = mine;
    __syncthreads();
    if (wid < 2) {
      const int d2 = wid;
      float A = 1.f, B = 0.f;
#pragma unroll
      for (int co = 0; co < 4; ++co) {
        const int c = d2 ? 3 - co : co;
        const float2 g = blockagg[(c * 2 + d2) * 64 + lane];
        B = g.x * B + g.y;
        A *= g.x;
      }
      const int p2 = d2 ? (seg == 0 ? 1 - blk : 33 - blk) : (seg == 0 ? blk : 2 + blk);
      agg2[((size_t)(b * 2 + d2) * 34 + p2) * 256 + nblk * 64 + lane] = make_float2(A, B);
    }
    __syncthreads();
    return;
  }
  {
    float h = 0.f;
    const float2* a2 = agg2 + ((size_t)(b * 2 + dir) * 34) * 256 + nblk * 64 + lane;
    int j = 0;
    for (; j + 8 <= pos2; j += 8) {
      float2 g[8];
#pragma unroll
      for (int u = 0; u < 8; ++u) g[u] = a2[(size_t)(j + u) * 256];
#pragma unroll
      for (int u = 0; u < 8; ++u) h = g[u].x * h + g[u].y;
    }
    for (; j < pos2; ++j) { const float2 g = a2[(size_t)j * 256]; h = g.x * h + g.y; }
    const float2* a1 = agg1 + ((size_t)(b * 2 + dir) * 136 + (cg32 - ck)) * 256 + nblk * 64 + lane;
    const int npre = dir ? 3 - ck : ck;
    for (int i = 0; i < npre; ++i) {
      const int c = dir ? 3 - i : i;
      const float2 g = a1[(size_t)c * 256];
      h = g.x * h + g.y;
    }
    carry[0] = shf(h, l31);
    carry[1] = shf(h, 32 + l31);
  }
  if (dir) rg_scan32<1>(Av, Bv, carry, H, hh); else rg_scan32<0>(Av, Bv, carry, H, hh);
  asm volatile("s_waitcnt lgkmcnt(0)" ::: "memory");
#pragma unroll
  for (int nt = 0; nt < 2; ++nt)
#pragma unroll
    for (int e = 0; e < 16; ++e) xcf[((e & 3) + 8 * (e >> 2) + 4 * hh) * 68 + nt * 32 + l31] = H[nt][e];
  __syncthreads();
  {
    const float* hfT = (const float*)(smem + (ck * 2 + 0) * 17408 + 8704);
    const float* hbT = (const float*)(smem + (ck * 2 + 1) * 17408 + 8704);
    const int tok = 16 * dir + (lane >> 2), c16 = (lane & 3) * 16;
    const size_t gtok = (size_t)tokbase + T0 + tok;
    const u16* gp = p.rg + gtok * 512 + 256 + nblk * 64 + c16;
    u16* op = p.ycat + gtok * 1024 + 768 + nblk * 64 + c16;
#pragma unroll
    for (int hv = 0; hv < 2; ++hv) {
      const uint4 g = *(const uint4*)(gp + hv * 8);
      const float4 f0 = *(const float4*)(hfT + tok * 68 + c16 + hv * 8), f1 = *(const float4*)(hfT + tok * 68 + c16 + hv * 8 + 4);
      const float4 h0 = *(const float4*)(hbT + tok * 68 + c16 + hv * 8), h1 = *(const float4*)(hbT + tok * 68 + c16 + hv * 8 + 4);
      uint4 o;
      o.x = pk2((f0.x + h0.x) * gelu_tanh(bflo(g.x)), (f0.y + h0.y) * gelu_tanh(bfhi(g.x)));
      o.y = pk2((f0.z + h0.z) * gelu_tanh(bflo(g.y)), (f0.w + h0.w) * gelu_tanh(bfhi(g.y)));
      o.z = pk2((f1.x + h1.x) * gelu_tanh(bflo(g.z)), (f1.y + h1.y) * gelu_tanh(bfhi(g.z)));
      o.w = pk2((f1.z + h1.z) * gelu_tanh(bflo(g.w)), (f1.w + h1.w) * gelu_tanh(bfhi(g.w)));
      *(uint4*)(op + hv * 8) = o;
    }
  }
  __syncthreads();
}

__device__ __forceinline__ void attn_wave(const P& p, int l, int b, int h, bool local, int r, int half, int qtok0, const float* rpbL) {
  const int lane = opaque_tid() & 63, q = lane & 31, hh = lane >> 5;
  bf16x8 qf[4];
  {
    const u16* qp = p.qk + (size_t)(qtok0 + q) * 1024 + h * 64 + 8 * hh;
#pragma unroll
    for (int s = 0; s < 4; ++s) qf[s] = *(const bf16x8*)(qp + 16 * s);
  }
  f32x16 o0 = zero16(), o1 = zero16();
  float m_run = -1e30f, l_run = 0.f;
  const int pi = (q & 19) | ((q & 4) << 1) | ((q & 8) >> 1);
  const int w = half * 32 + q;
  const int st = min(max(w - 8, 0), 48);
  const int rs = min(max(r - 4, 0), 56);
  const int ntiles = local ? 24 : 8;
  bf16x8 kfn[4], vfn[2][2];
  auto tile_load = [&](int ti, bf16x8 (&kfo)[4], bf16x8 (&vfo)[2][2]) {
    int ktok0, vstride;
    const u16* vb;
    if (ti < 8) {
      ktok0 = NLAT + b * 256 + ti * 32;
      vb = p.vTc + ((size_t)(b * 512 + h * 64)) * 256 + ti * 32;
      vstride = 256;
    } else {
      const int tl = ti - 8;
      const int a2 = tl >> 1, g2 = tl & 1;
      ktok0 = b * 4096 + (rs + a2) * 64 + g2 * 32;
      vb = p.vT + ((size_t)(b * 512 + h * 64)) * 4096 + (rs + a2) * 64 + g2 * 32;
      vstride = 4096;
    }
    const u16* kp = p.qk + (size_t)(ktok0 + pi) * 1024 + 512 + h * 64 + 8 * hh;
#pragma unroll
    for (int s = 0; s < 4; ++s) kfo[s] = *(const bf16x8*)(kp + 16 * s);
#pragma unroll
    for (int dt = 0; dt < 2; ++dt)
#pragma unroll
      for (int s2 = 0; s2 < 2; ++s2) vfo[dt][s2] = *(const bf16x8*)(vb + (size_t)(dt * 32 + q) * vstride + 16 * s2 + 8 * hh);
  };
  tile_load(0, kfn, vfn);
  for (int ti = 0; ti < ntiles; ++ti) {
    int a = 0, g = 0;
    if (ti >= 8) { a = (ti - 8) >> 1; g = (ti - 8) & 1; }
    bf16x8 kf[4], vf[2][2];
#pragma unroll
    for (int s = 0; s < 4; ++s) kf[s] = kfn[s];
#pragma unroll
    for (int dt = 0; dt < 2; ++dt)
#pragma unroll
      for (int s2 = 0; s2 < 2; ++s2) vf[dt][s2] = vfn[dt][s2];
    if (ti + 1 < ntiles) tile_load(ti + 1, kfn, vfn);
    f32x16 sacc = zero16();
#pragma unroll
    for (int s = 0; s < 4; ++s) sacc = mfma32(kf[s], qf[s], sacc);
    float sv[16];
    float tmax = -1e30f;
#pragma unroll
    for (int e = 0; e < 16; ++e) {
      float x = sacc[e] * 0.125f;
      if (ti >= 8) {
        const int kc = g * 32 + (e & 7) + 8 * hh + 16 * (e >> 3);
        const bool valid = (kc >= st) && (kc < st + 16);
        const int bi = valid ? ((rs + a - r + 7) * 31 + (kc - w + 15)) : 0;
        const float bias = rpbL[bi];
        x = valid ? (x + bias) : -1e30f;
      }
      sv[e] = x;
      tmax = fmaxf(tmax, x);
    }
    tmax = fmaxf(tmax, shx(tmax, 32));
    const float m_new = fmaxf(m_run, tmax);
    const float alpha = __expf(m_run - m_new);
    m_run = m_new;
    l_run *= alpha;
#pragma unroll
    for (int e = 0; e < 16; ++e) { o0[e] *= alpha; o1[e] *= alpha; }
    float psum = 0.f;
#pragma unroll
    for (int e = 0; e < 16; ++e) { const float pe = __expf(sv[e] - m_new); sv[e] = pe; psum += pe; }
    l_run += psum;
    bf16x8 pf[2];
#pragma unroll
    for (int s2 = 0; s2 < 2; ++s2) {
      union { bf16x8 v; unsigned u[4]; } cv;
#pragma unroll
      for (int j = 0; j < 4; ++j) cv.u[j] = pk2(sv[8 * s2 + 2 * j], sv[8 * s2 + 2 * j + 1]);
      pf[s2] = cv.v;
    }
#pragma unroll
    for (int s2 = 0; s2 < 2; ++s2) {
      o0 = mfma32(vf[0][s2], pf[s2], o0);
      o1 = mfma32(vf[1][s2], pf[s2], o1);
    }
  }
  const float lt = l_run + shx(l_run, 32);
  const float inv = 1.0f / lt;
  u16* op = p.ycat + (size_t)(qtok0 + q) * 1024 + h * 64;
#pragma unroll
  for (int qd = 0; qd < 4; ++qd) {
    uint2 a0, a1;
    a0.x = pk2(o0[4 * qd] * inv, o0[4 * qd + 1] * inv);
    a0.y = pk2(o0[4 * qd + 2] * inv, o0[4 * qd + 3] * inv);
    a1.x = pk2(o1[4 * qd] * inv, o1[4 * qd + 1] * inv);
    a1.y = pk2(o1[4 * qd + 2] * inv, o1[4 * qd + 3] * inv);
    *(uint2*)(op + 8 * qd + 4 * hh) = a0;
    *(uint2*)(op + 32 + 8 * qd + 4 * hh) = a1;
  }
}
__device__ __forceinline__ void attn_block_task(const P& p, int l, int b, int h, int rg4, char* smem) {
  const int tid = opaque_tid(), lane = tid & 63, wid = tid >> 6;
  const int q = lane & 31, hh = lane >> 5;
  const int R0 = rg4 * 4;
  const int r = R0 + (wid >> 1), half = wid & 1;
  float* rpbL = (float*)(smem + 32768) + 64;
  for (int i = tid; i < 465; i += NTHR) rpbL[i] = p.na_rpb[(size_t)(l * 8 + h) * 465 + i] * 1.4426950408889634f;
  const int lo = min(max(R0 - 4, 0), 56);
  const int hi = min(max(R0 + 3 - 4, 0), 56) + 7;
  const int ntile = 4 + (hi - lo + 1);
  const int rs = min(max(r - 4, 0), 56);
  const int qtok = b * 4096 + r * 64 + half * 32 + q;
  bf16x8 qf[4];
  {
    const u16* qp = p.qk + (size_t)qtok * 1024 + h * 64 + 8 * hh;
#pragma unroll
    for (int s = 0; s < 4; ++s) qf[s] = *(const bf16x8*)(qp + 16 * s);
  }
  f32x16 o0 = zero16(), o1 = zero16();
  float m_run = -1e30f, l_run = 0.f;
  const int pi = (q & 19) | ((q & 4) << 1) | ((q & 8) >> 1);
  const int w = half * 32 + q;
  const int st = min(max(w - 8, 0), 48);
  unsigned vmask = 0u;
#pragma unroll
  for (int g = 0; g < 2; ++g)
#pragma unroll
    for (int e = 0; e < 16; ++e) {
      const int kc = g * 32 + (e & 7) + 8 * hh + 16 * (e >> 3);
      vmask |= ((kc >= st) && (kc < st + 16)) ? (1u << (g * 16 + e)) : 0u;
    }
  const int cbase = 8 * hh - w + 15;
  const int srow = tid >> 3, sch = tid & 7;
  uint4 rkA, rvA, rkB, rvB;
  auto gload = [&](int ti, uint4& rk, uint4& rv) {
    int ktok0, vstride;
    const u16* vb;
    if (ti < 4) { ktok0 = NLAT + b * 256 + ti * 64; vb = p.vTc + ((size_t)(b * 512 + h * 64)) * 256 + ti * 64; vstride = 256; }
    else { const int R = lo + ti - 4; ktok0 = b * 4096 + R * 64; vb = p.vT + ((size_t)(b * 512 + h * 64)) * 4096 + R * 64; vstride = 4096; }
    rk = *(const uint4*)(p.qk + (size_t)(ktok0 + srow) * 1024 + 512 + h * 64 + sch * 8);
    rv = *(const uint4*)(vb + (size_t)srow * vstride + sch * 8);
  };
  gload(0, rkA, rvA);
  *(uint4*)(smem + swz128(srow, sch)) = rkA;
  *(uint4*)(smem + 16384 + swz128(srow, sch)) = rvA;
  gload(1, rkA, rvA);
  if (2 < ntile) gload(2, rkB, rvB);
  __syncthreads();
  auto compute = [&](int ti) {
    const char* Kb = smem + (ti & 1) * 8192;
    const char* Vb = smem + 16384 + (ti & 1) * 8192;
    const int R = lo + ti - 4;
    const bool active = (ti < 4) || (R >= rs && R < rs + 8);
    if (active) {
      f32x16 sacc0 = zero16(), sacc1 = zero16();
#pragma unroll
      for (int s = 0; s < 4; ++s) {
        const bf16x8 kf0 = *(const bf16x8*)(Kb + swz128(pi, 2 * s + hh));
        const bf16x8 kf1 = *(const bf16x8*)(Kb + swz128(32 + pi, 2 * s + hh));
        sacc0 = mfma32(kf0, qf[s], sacc0);
        sacc1 = mfma32(kf1, qf[s], sacc1);
      }
      float sv[32];
      float tmax = -1e30f;
      if (ti >= 4) {
        const float* brow = rpbL + (R - r + 7) * 31 + cbase;
        float bias[32];
#pragma unroll
        for (int g = 0; g < 2; ++g)
#pragma unroll
          for (int e = 0; e < 16; ++e) bias[g * 16 + e] = brow[g * 32 + (e & 7) + 16 * (e >> 3)];
#pragma unroll
        for (int g = 0; g < 2; ++g)
#pragma unroll
          for (int e = 0; e < 16; ++e) {
            const float sc = g ? sacc1[e] : sacc0[e];
            const float x = ((int)(vmask << (31 - (g * 16 + e))) < 0) ? fmaf(sc, 0.18033688011112042f, bias[g * 16 + e]) : -1e30f;
            sv[g * 16 + e] = x;
            tmax = fmaxf(tmax, x);
          }
      } else {
#pragma unroll
        for (int g = 0; g < 2; ++g)
#pragma unroll
          for (int e = 0; e < 16; ++e) {
            const float x = (g ? sacc1[e] : sacc0[e]) * 0.18033688011112042f;
            sv[g * 16 + e] = x;
            tmax = fmaxf(tmax, x);
          }
      }
      tmax = fmaxf(tmax, shx(tmax, 32));
      if (__builtin_amdgcn_ballot_w64(tmax > m_run) != 0ull) {
        const float m_new = fmaxf(m_run, tmax);
        const float alpha = __builtin_amdgcn_exp2f(m_run - m_new);
        m_run = m_new;
        l_run *= alpha;
#pragma unroll
        for (int e = 0; e < 16; ++e) { o0[e] *= alpha; o1[e] *= alpha; }
      }
      float psum = 0.f;
#pragma unroll
      for (int e = 0; e < 32; ++e) { const float pe = __builtin_amdgcn_exp2f(sv[e] - m_run); sv[e] = pe; psum += pe; }
      l_run += psum;
#pragma unroll
      for (int g = 0; g < 2; ++g)
#pragma unroll
        for (int s2 = 0; s2 < 2; ++s2) {
          union { bf16x8 v; unsigned u[4]; } cv;
#pragma unroll
          for (int j = 0; j < 4; ++j) cv.u[j] = pk2(sv[g * 16 + 8 * s2 + 2 * j], sv[g * 16 + 8 * s2 + 2 * j + 1]);
          const bf16x8 v0 = *(const bf16x8*)(Vb + swz128(q, g * 4 + 2 * s2 + hh));
          const bf16x8 v1 = *(const bf16x8*)(Vb + swz128(32 + q, g * 4 + 2 * s2 + hh));
          o0 = mfma32(v0, cv.v, o0);
          o1 = mfma32(v1, cv.v, o1);
        }
    }
  };
  for (int ti = 0; ti < ntile; ti += 2) {
    compute(ti);
    if (ti + 1 < ntile) {
      *(uint4*)(smem + 8192 + swz128(srow, sch)) = rkA;
      *(uint4*)(smem + 16384 + 8192 + swz128(srow, sch)) = rvA;
      if (ti + 3 < ntile) gload(ti + 3, rkA, rvA);
    }
    __syncthreads();
    if (ti + 1 < ntile) {
      compute(ti + 1);
      if (ti + 2 < ntile) {
        *(uint4*)(smem + swz128(srow, sch)) = rkB;
        *(uint4*)(smem + 16384 + swz128(srow, sch)) = rvB;
        if (ti + 4 < ntile) gload(ti + 4, rkB, rvB);
      }
      __syncthreads();
    }
  }
  const float lt = l_run + shx(l_run, 32);
  const float inv = 1.0f / lt;
  __syncthreads();
  {
    char* ot = smem + wid * 4608;
#pragma unroll
    for (int qd = 0; qd < 4; ++qd) {
      uint2 a0, a1;
      a0.x = pk2(o0[4 * qd] * inv, o0[4 * qd + 1] * inv);
      a0.y = pk2(o0[4 * qd + 2] * inv, o0[4 * qd + 3] * inv);
      a1.x = pk2(o1[4 * qd] * inv, o1[4 * qd + 1] * inv);
      a1.y = pk2(o1[4 * qd + 2] * inv, o1[4 * qd + 3] * inv);
      *(uint2*)(ot + q * 144 + (8 * qd + 4 * hh) * 2) = a0;
      *(uint2*)(ot + q * 144 + (32 + 8 * qd + 4 * hh) * 2) = a1;
    }
    asm volatile("s_waitcnt lgkmcnt(0)" ::: "memory");
    const int tok0 = b * 4096 + r * 64 + half * 32;
#pragma unroll
    for (int it = 0; it < 4; ++it) {
      const int qq = it * 8 + (lane >> 3), ch = lane & 7;
      const uint4 v = *(const uint4*)(ot + qq * 144 + ch * 16);
      *(uint4*)(p.ycat + (size_t)(tok0 + qq) * 1024 + h * 64 + ch * 8) = v;
    }
  }
  __syncthreads();
}
__device__ __forceinline__ void attn_task(const P& p, int l, int kind, int idx, char* smem) {
  const int tid_ = opaque_tid(); const int lane = tid_ & 63, wid = tid_ >> 6;
  float* rpbL = (float*)smem + wid * 480;
  for (int i = lane; i < 465; i += 64) rpbL[i] = p.na_rpb[(size_t)(l * 8 + wid) * 465 + i];
  __syncthreads();
  if (kind == 0) {
    const int half = idx & 1, r = (idx >> 1) & 63, b = idx >> 7;
    attn_wave(p, l, b, wid, true, r, half, b * 4096 + r * 64 + half * 32, rpbL);
  } else {
    const int qg = idx & 7, b = idx >> 3;
    attn_wave(p, l, b, wid, false, 0, 0, NLAT + b * 256 + qg * 32, rpbL);
  }
  __syncthreads();
}

__device__ __forceinline__ void phase_mixers(const P& p, int l, char* smem, unsigned* counter) {
  const bool last = (l == 1);
  const int n_rg = 1088 * XRGA, n_fft = 1024 * XFFT, n_hc = last ? 0 : 256, n_att = 1024 * XATT, n_attc = last ? 0 : 64;
  const int total = n_rg + n_fft + n_hc + n_att + n_attc;
  volatile int* s_taskp = (volatile int*)(smem + SMEM_BYTES - 16);
  for (;;) {
    __syncthreads();
    if (threadIdx.x == 0) *s_taskp = (int)atomicAdd(counter, 1u);
    __syncthreads();
    int t = *s_taskp;
    if (t >= total) break;
    if (t < n_att) { t &= 1023; attn_block_task(p, l, t >> 7, (t >> 4) & 7, t & 15, smem); continue; }
    t -= n_att;
    if (t < n_attc) { attn_task(p, l, 1, t, smem); continue; }
    t -= n_attc;
    if (t < n_fft) { t &= 1023; hyena_fft_task(p, l, t >> 2, t & 3, smem); continue; }
    t -= n_fft;
    if (t < n_hc) { hyena_ctx_task(p, l, t >> 5, t & 31, smem); continue; }
    t -= n_hc;
    if (t >= 1088) t -= 1088;
    rg_wave_task(p, l, t >> 2, t & 3, 0, last, smem);
  }
}

__device__ __forceinline__ void merge_tile(const P& p, int l, int mt, int nt, char* smem) {
  EPI_VARS
  const int m0 = mt * 256, n0 = nt * 128;
  f32x16 macc[2][2];
  zero_acc(macc);
  for (int br = 0; br < 3; ++br) {
    unsigned* gpl = (unsigned*)(smem + 98304) + tid;
    {
      f32x16 acc[2][2];
      zero_acc(acc);
      gemm_kloop(acc, p.xn + (size_t)m0 * 1024, 1024, p.WgT + ((size_t)l * 3072 + br * 1024 + n0) * 1024, 1024, 1024, smem);
#pragma unroll
      for (int j = 0; j < 2; ++j) {
        const float bg = p.b_gate[l * 3072 + br * 1024 + n0 + EPI_COL(j)];
#pragma unroll
        for (int i = 0; i < 2; ++i)
#pragma unroll
          for (int e = 0; e < 4; ++e) {
            const unsigned q0 = (unsigned)(sigmoidf_(acc[i][j][4 * e] + bg) * 255.0f + 0.5f);
            const unsigned q1 = (unsigned)(sigmoidf_(acc[i][j][4 * e + 1] + bg) * 255.0f + 0.5f);
            const unsigned q2 = (unsigned)(sigmoidf_(acc[i][j][4 * e + 2] + bg) * 255.0f + 0.5f);
            const unsigned q3 = (unsigned)(sigmoidf_(acc[i][j][4 * e + 3] + bg) * 255.0f + 0.5f);
            gpl[((i * 2 + j) * 4 + e) * 512] = q0 | (q1 << 8) | (q2 << 16) | (q3 << 24);
          }
      }
    }
    {
      f32x16 acc[2][2];
      zero_acc(acc);
      const u16* A; const u16* B; int K;
      if (br == 0) { A = p.ycat + (size_t)m0 * 1024; B = p.WaT + ((size_t)l * 1024 + n0) * 512; K = 512; }
      else if (br == 1) { A = p.ycat + (size_t)m0 * 1024 + 512; B = p.WbT + ((size_t)l * 1024 + n0) * 256; K = 256; }
      else { A = p.ycat + (size_t)m0 * 1024 + 768; B = p.WcT + ((size_t)l * 1024 + n0) * 256; K = 256; }
      gemm_kloop(acc, A, 1024, B, K, K, smem);
#pragma unroll
      for (int i = 0; i < 2; ++i)
#pragma unroll
        for (int j = 0; j < 2; ++j)
#pragma unroll
          for (int e = 0; e < 4; ++e) {
            const unsigned g4 = gpl[((i * 2 + j) * 4 + e) * 512];
            macc[i][j][4 * e] += (float)(g4 & 255u) * (1.0f / 255.0f) * acc[i][j][4 * e];
            macc[i][j][4 * e + 1] += (float)((g4 >> 8) & 255u) * (1.0f / 255.0f) * acc[i][j][4 * e + 1];
            macc[i][j][4 * e + 2] += (float)((g4 >> 16) & 255u) * (1.0f / 255.0f) * acc[i][j][4 * e + 2];
            macc[i][j][4 * e + 3] += (float)(g4 >> 24) * (1.0f / 255.0f) * acc[i][j][4 * e + 3];
          }
    }
  }
#pragma unroll
  for (int i = 0; i < 2; ++i)
#pragma unroll
    for (int j = 0; j < 2; ++j)
#pragma unroll
      for (int e = 0; e < 16; ++e)
        p.mbuf[(size_t)(m0 + EPI_ROW(i, e)) * 1024 + n0 + EPI_COL(j)] = f2bf(macc[i][j][e]);
}
__device__ __forceinline__ void outproj_tile(const P& p, int l, int mt, int nt, char* smem, bool do_store) {
  EPI_VARS
  const int m0 = mt * 256, n0 = nt * 128;
  f32x16 acc[2][2];
  zero_acc(acc);
  gemm_kloop(acc, p.mbuf + (size_t)m0 * 1024, 1024, p.WoT + ((size_t)l * 1024 + n0) * 1024, 1024, 1024, smem);
  const bool isctx = (mt >= 128);
  const int bi = isctx ? 8 : (mt >> 4);
  const float* gatev = p.mod + ((size_t)(l * 9 + bi) * 6 + 2) * 1024;
  const float* src; float* dst;
  if (isctx) { src = (l == 0 ? p.ctx : p.ctxs) - (size_t)NLAT * 1024; dst = p.ctxs - (size_t)NLAT * 1024; }
  else { src = (l == 0 ? p.x : p.out); dst = p.out; }
#pragma unroll
  for (int j = 0; j < 2; ++j) {
    const int col = n0 + EPI_COL(j);
    const float gv = gatev[col];
#pragma unroll
    for (int i = 0; i < 2; ++i)
#pragma unroll
      for (int e = 0; e < 16; ++e) {
        const size_t o = (size_t)(m0 + EPI_ROW(i, e)) * 1024 + col;
        if (do_store) dst[o] = src[o] + gv * acc[i][j][e];
      }
  }
}

__device__ __forceinline__ void wqk_task(const P& p, int l, int hp, int nt, char* smem) {
  EPI_VARS
  f32x16 acc[2][2];
  zero_acc(acc);
  gemm_kloop(acc, p.keysB + ((size_t)l * 16 + hp) * 16384, 128, p.WqB + (size_t)l * 1024 * 2048 + (size_t)(nt * 128) * 2048 + hp * 128, 2048, 128, smem);
  if (wm < 2) {
#pragma unroll
    for (int i = 0; i < 2; ++i)
#pragma unroll
      for (int j = 0; j < 2; ++j)
#pragma unroll
        for (int e = 0; e < 16; ++e)
          p.WqkT[((size_t)l * 2048 + hp * 128 + EPI_ROW(i, e)) * 1024 + nt * 128 + EPI_COL(j)] = f2bf(acc[i][j][e]);
  }
}
__device__ __forceinline__ void ins16(unsigned (&L)[16], unsigned x) {
#pragma unroll
  for (int i = 0; i < 16; ++i) {
    const unsigned hi = max(L[i], x);
    x = min(L[i], x);
    L[i] = hi;
  }
}
__device__ __forceinline__ unsigned f2sort(float f) {
  const unsigned b = __float_as_uint(f);
  return b ^ ((unsigned)((int)b >> 31) | 0x80000000u);
}
__device__ __forceinline__ float sort2f(unsigned k) {
  const unsigned u = k & ~127u;
  const unsigned b = (u & 0x80000000u) ? (u ^ 0x80000000u) : ~u;
  return __uint_as_float(b);
}
__device__ __forceinline__ void cx_desc(unsigned& a, unsigned& b) { const unsigned hi = max(a, b), lo = min(a, b); a = hi; b = lo; }
template <int BASE> __device__ __forceinline__ void sort16_desc(unsigned (&k)[64]) {
#pragma unroll
  for (int sz = 2; sz <= 16; sz <<= 1) {
#pragma unroll
    for (int j = sz >> 1; j >= 1; j >>= 1) {
#pragma unroll
      for (int i = 0; i < 16; ++i) {
        const int l2 = i ^ j;
        if (l2 > i) {
          if ((i & sz) == 0) cx_desc(k[BASE + i], k[BASE + l2]);
          else cx_desc(k[BASE + l2], k[BASE + i]);
        }
      }
    }
  }
}
template <int AB, int BB> __device__ __forceinline__ void merge16_desc(unsigned (&k)[64]) {
#pragma unroll
  for (int i = 0; i < 16; ++i) k[AB + i] = max(k[AB + i], k[BB + 15 - i]);
#pragma unroll
  for (int j = 8; j >= 1; j >>= 1) {
#pragma unroll
    for (int i = 0; i < 16; ++i)
      if ((i & j) == 0) cx_desc(k[AB + i], k[AB + i + j]);
  }
}
__device__ __forceinline__ void peer_score_tile(const P& p, int l, int mt, int hp, char* smem) {
  const int tid = opaque_tid();
  const int m0 = mt * 256;
  const int row = tid >> 1, hf = tid & 1;
  {
    char* T = smem + 16384;
#pragma unroll
    for (int it = 0; it < 8; ++it) {
      const int id = tid + NTHR * it;
      const int r = id >> 4, ch = id & 15;
      *(uint4*)(T + r * 272 + ch * 16) = *(const uint4*)(p.q + (size_t)(m0 + r) * 2048 + hp * 128 + ch * 8);
    }
  }
  __syncthreads();
  const char* sp = smem + 16384 + row * 272 + hf * 128;
  unsigned k[64];
#pragma unroll
  for (int c = 0; c < 8; ++c) {
    const uint4 r = *(const uint4*)(sp + 16 * c);
    const unsigned w[4] = {r.x, r.y, r.z, r.w};
#pragma unroll
    for (int q = 0; q < 4; ++q) {
      const float v0 = __builtin_bit_cast(_Float16, (unsigned short)(w[q] & 0xffffu));
      const float v1 = __builtin_bit_cast(_Float16, (unsigned short)(w[q] >> 16));
      const int key = hf * 64 + c * 8 + q * 2;
      k[c * 8 + q * 2] = (f2sort(v0) & ~127u) | (unsigned)key;
      k[c * 8 + q * 2 + 1] = (f2sort(v1) & ~127u) | (unsigned)(key + 1);
    }
  }
  sort16_desc<0>(k); sort16_desc<16>(k); sort16_desc<32>(k); sort16_desc<48>(k);
  merge16_desc<0, 16>(k);
  merge16_desc<32, 48>(k);
  merge16_desc<0, 32>(k);
  unsigned* X = (unsigned*)smem;
  if (hf) {
#pragma unroll
    for (int i = 0; i < 16; ++i) X[row * 16 + i] = k[i];
  }
  __syncthreads();
  if (!hf) {
#pragma unroll
    for (int i = 0; i < 16; ++i) k[16 + i] = X[row * 16 + i];
    merge16_desc<0, 16>(k);
    unsigned* o = p.topk + ((size_t)(m0 + row) * 16 + hp) * 16;
#pragma unroll
    for (int i = 0; i < 4; ++i) *(uint4*)(o + 4 * i) = make_uint4(k[4 * i], k[4 * i + 1], k[4 * i + 2], k[4 * i + 3]);
  }
  __syncthreads();
}

__device__ __forceinline__ void phase_peer_experts(const P& p, int l, bool do_store, char* smem) {
  const int tid_ = opaque_tid(); const int lane = tid_ & 63, wid = tid_ >> 6;
  const int ntok = (l == 1) ? NLAT : NTOK;
  int ci, cj;
  {
    const int e = lane;
    if (e < 16) { ci = 0; cj = e; }
    else if (e < 24) { ci = 1; cj = e - 16; }
    else if (e < 29) { ci = 2; cj = e - 24; }
    else if (e < 33) { ci = 3; cj = e - 29; }
    else if (e < 36) { ci = 4; cj = e - 33; }
    else if (e < 38) { ci = 5; cj = e - 36; }
    else if (e < 40) { ci = 6; cj = e - 38; }
    else if (e < 42) { ci = 7; cj = e - 40; }
    else { ci = min(8 + (e - 42), 15); cj = 0; }
  }
  for (int tok = blockIdx.x * 8 + wid; tok < ntok; tok += gridDim.x * 8) {
    float xr[16];
    {
      const uint4 a = *(const uint4*)(p.xn + (size_t)tok * 1024 + lane * 16);
      const uint4 b = *(const uint4*)(p.xn + (size_t)tok * 1024 + lane * 16 + 8);
      xr[0] = bflo(a.x); xr[1] = bfhi(a.x); xr[2] = bflo(a.y); xr[3] = bfhi(a.y);
      xr[4] = bflo(a.z); xr[5] = bfhi(a.z); xr[6] = bflo(a.w); xr[7] = bfhi(a.w);
      xr[8] = bflo(b.x); xr[9] = bfhi(b.x); xr[10] = bflo(b.y); xr[11] = bfhi(b.y);
      xr[12] = bflo(b.z); xr[13] = bfhi(b.z); xr[14] = bflo(b.w); xr[15] = bfhi(b.w);
    }
    float yacc[16];
#pragma unroll
    for (int i = 0; i < 16; ++i) yacc[i] = 0.f;
    int* selw = (int*)(smem + wid * 4096);
    const unsigned* kvp = p.topk + (size_t)tok * 256 + (lane & 31);
#pragma unroll 1
    for (int hb = 0; hb < 8; hb += 4) {
      unsigned key[4]; int eidx[4];
#pragma unroll
      for (int u = 0; u < 4; ++u) {
        const unsigned kv = kvp[(hb + u) * 32];
        const unsigned k0 = shu(kv, ci);
        const unsigned k1 = shu(kv, 16 + cj);
        const float val = (lane < 50) ? (sort2f(k0) + sort2f(k1)) : -3.0e38f;
        eidx[u] = (int)((k0 & 127u) * 128u + (k1 & 127u));
        key[u] = (f2sort(val) & ~63u) | (unsigned)lane;
      }
#pragma unroll
      for (int k = 2; k <= 64; k <<= 1) {
#pragma unroll
        for (int j = k >> 1; j >= 1; j >>= 1) {
          const bool take_max = (((lane & j) == 0) == ((lane & k) == 0));
#pragma unroll
          for (int u = 0; u < 4; ++u) {
            unsigned ok;
            if (j == 1) ok = xorl<1>(key[u], lane); else if (j == 2) ok = xorl<2>(key[u], lane); else if (j == 4) ok = xorl<4>(key[u], lane);
            else if (j == 8) ok = xorl<8>(key[u], lane); else if (j == 16) ok = xorl<16>(key[u], lane); else ok = xorl<32>(key[u], lane);
            key[u] = take_max ? max(key[u], ok) : min(key[u], ok);
          }
        }
      }
#pragma unroll
      for (int u = 0; u < 4; ++u) {
        const int si = __builtin_amdgcn_ds_bpermute((int)(key[u] & 63u) << 2, eidx[u]);
        const unsigned ku = key[u] & ~63u;
        const float sv = __uint_as_float((ku & 0x80000000u) ? (ku ^ 0x80000000u) : ~ku);
        const float mx = __builtin_bit_cast(float, __builtin_amdgcn_readlane(__builtin_bit_cast(int, sv), 0));
        const float ex = (lane < 16) ? __builtin_amdgcn_exp2f((sv - mx) * 1.4426950408889634f) : 0.f;
        const float sm = wave_sum(ex);
        selw[(hb + u) * 64 + lane] = si;
        selw[512 + (hb + u) * 64 + lane] = __builtin_bit_cast(int, ex * __builtin_amdgcn_rcpf(sm));
      }
    }
#pragma unroll 1
    for (int h = 0; h < 8; ++h) {
      const int eperm_h = selw[h * 64 + lane];
      const int gperm_h = selw[512 + h * 64 + lane];
      uint2 U[16], V[16];
#pragma unroll
      for (int k = 0; k < 16; ++k) {
        const int id = __builtin_amdgcn_readlane(eperm_h, k);
        const uint4 rec = *(const uint4*)(p.Ub + (size_t)id * 1024 + lane * 16);
        U[k] = make_uint2(rec.x, rec.y);
        V[k] = make_uint2(rec.z, rec.w);
      }
      float d[16];
#pragma unroll
      for (int k = 0; k < 16; ++k) {
        const unsigned uw[2] = {U[k].x, U[k].y};
        float dd = 0.f;
#pragma unroll
        for (int q2 = 0; q2 < 2; ++q2) {
          const f32x2 e0 = __builtin_amdgcn_cvt_scalef32_pk_f32_fp4(uw[q2], 1.0f, 0);
          const f32x2 e1 = __builtin_amdgcn_cvt_scalef32_pk_f32_fp4(uw[q2], 1.0f, 1);
          const f32x2 e2 = __builtin_amdgcn_cvt_scalef32_pk_f32_fp4(uw[q2], 1.0f, 2);
          const f32x2 e3 = __builtin_amdgcn_cvt_scalef32_pk_f32_fp4(uw[q2], 1.0f, 3);
          dd += xr[8 * q2] * e0.x + xr[8 * q2 + 1] * e0.y + xr[8 * q2 + 2] * e1.x + xr[8 * q2 + 3] * e1.y +
                xr[8 * q2 + 4] * e2.x + xr[8 * q2 + 5] * e2.y + xr[8 * q2 + 6] * e3.x + xr[8 * q2 + 7] * e3.y;
        }
        d[k] = dd;
      }
      {
        const bool b5 = (lane & 32) != 0, b4 = (lane & 16) != 0, b3 = (lane & 8) != 0, b2 = (lane & 4) != 0;
#pragma unroll
        for (int j = 0; j < 8; ++j) { const float keep = b5 ? d[j + 8] : d[j], send = b5 ? d[j] : d[j + 8]; d[j] = keep + xorf<32>(send, lane); }
#pragma unroll
        for (int j = 0; j < 4; ++j) { const float keep = b4 ? d[j + 4] : d[j], send = b4 ? d[j] : d[j + 4]; d[j] = keep + xorf<16>(send, lane); }
#pragma unroll
        for (int j = 0; j < 2; ++j) { const float keep = b3 ? d[j + 2] : d[j], send = b3 ? d[j] : d[j + 2]; d[j] = keep + xorf<8>(send, lane); }
        { const float keep = b2 ? d[1] : d[0], send = b2 ? d[0] : d[1]; d[0] = keep + xorf<4>(send, lane); }
        d[0] += xorf<2>(d[0], lane);
        d[0] += xorf<1>(d[0], lane);
      }
      const float gl = __builtin_bit_cast(float, shu((unsigned)gperm_h, (lane >> 2) & 15));
      const float act = gelu_tanh(d[0] * (1.0f / 64.0f)) * gl;
#pragma unroll
      for (int k = 0; k < 16; ++k) {
        const float ak = __builtin_bit_cast(float, __builtin_amdgcn_readlane(__builtin_bit_cast(int, act), 4 * k));
        const unsigned vw[2] = {V[k].x, V[k].y};
#pragma unroll
        for (int q2 = 0; q2 < 2; ++q2) {
          const f32x2 e0 = __builtin_amdgcn_cvt_scalef32_pk_f32_fp4(vw[q2], 1.0f, 0);
          const f32x2 e1 = __builtin_amdgcn_cvt_scalef32_pk_f32_fp4(vw[q2], 1.0f, 1);
          const f32x2 e2 = __builtin_amdgcn_cvt_scalef32_pk_f32_fp4(vw[q2], 1.0f, 2);
          const f32x2 e3 = __builtin_amdgcn_cvt_scalef32_pk_f32_fp4(vw[q2], 1.0f, 3);
          yacc[8 * q2] += ak * e0.x; yacc[8 * q2 + 1] += ak * e0.y; yacc[8 * q2 + 2] += ak * e1.x; yacc[8 * q2 + 3] += ak * e1.y;
          yacc[8 * q2 + 4] += ak * e2.x; yacc[8 * q2 + 5] += ak * e2.y; yacc[8 * q2 + 6] += ak * e3.x; yacc[8 * q2 + 7] += ak * e3.y;
        }
      }
    }
    const int bi = tok < NLAT ? (tok >> 12) : 8;
    const float* gv = p.mod + ((size_t)(l * 9 + bi) * 6 + 5) * 1024 + lane * 16;
    float* xp = (tok < NLAT) ? (p.out + (size_t)tok * 1024) : (p.ctxs + (size_t)(tok - NLAT) * 1024);
    xp += lane * 16;
    float4 xv[4];
    float ss = 0.f;
#pragma unroll
    for (int i = 0; i < 4; ++i) {
      xv[i] = *(float4*)(xp + 4 * i);
      const float4 g4 = *(const float4*)(gv + 4 * i);
      xv[i].x += g4.x * yacc[4 * i] * 0.25f; xv[i].y += g4.y * yacc[4 * i + 1] * 0.25f; xv[i].z += g4.z * yacc[4 * i + 2] * 0.25f; xv[i].w += g4.w * yacc[4 * i + 3] * 0.25f;
      ss += xv[i].x * xv[i].x + xv[i].y * xv[i].y + xv[i].z * xv[i].z + xv[i].w * xv[i].w;
    }
    ss = wave_sum(ss);
    const float rstd = rsqrtf(ss * (1.0f / 1024.0f) + 1e-6f);
    if (l == 0) {
      const float* gam = p.norm_mix_g + 1024 + lane * 16;
      const float* msh = p.mod + ((size_t)(9 + bi) * 6 + 0) * 1024 + lane * 16;
      const float* msc = msh + 1024;
      float yv[16];
      float amax = 0.f;
#pragma unroll
      for (int i = 0; i < 4; ++i) {
        if (do_store) *(float4*)(xp + 4 * i) = xv[i];
        const float4 g = *(const float4*)(gam + 4 * i);
        const float4 sh = *(const float4*)(msh + 4 * i);
        const float4 sc = *(const float4*)(msc + 4 * i);
        yv[4 * i] = xv[i].x * rstd * g.x * (1.f + sc.x) + sh.x; yv[4 * i + 1] = xv[i].y * rstd * g.y * (1.f + sc.y) + sh.y;
        yv[4 * i + 2] = xv[i].z * rstd * g.z * (1.f + sc.z) + sh.z; yv[4 * i + 3] = xv[i].w * rstd * g.w * (1.f + sc.w) + sh.w;
      }
#pragma unroll
      for (int i = 0; i < 16; ++i) amax = fmaxf(amax, fabsf(yv[i]));
      amax = fmaxf(wave_max(amax), 1e-20f);
      const float inv = 127.0f / amax;
      unsigned w[4];
#pragma unroll
      for (int i = 0; i < 4; ++i)
        w[i] = ((unsigned)__float2int_rn(yv[4 * i] * inv) & 255u) | (((unsigned)__float2int_rn(yv[4 * i + 1] * inv) & 255u) << 8) |
               (((unsigned)__float2int_rn(yv[4 * i + 2] * inv) & 255u) << 16) | (((unsigned)__float2int_rn(yv[4 * i + 3] * inv) & 255u) << 24);
      if (do_store) {
        *(uint4*)(p.xn8 + (size_t)tok * 1024 + lane * 16) = make_uint4(w[0], w[1], w[2], w[3]);
        if (lane == 0) p.sa[tok] = amax * (1.0f / 127.0f);
      }
    } else {
      const float* fg = p.final_g + lane * 16;
#pragma unroll
      for (int i = 0; i < 4; ++i) {
        const float4 g = *(const float4*)(fg + 4 * i);
        const float4 o = make_float4(xv[i].x * rstd * g.x, xv[i].y * rstd * g.y, xv[i].z * rstd * g.z, xv[i].w * rstd * g.w);
        if (do_store) *(float4*)(xp + 4 * i) = o;
      }
    }
  }
}


#define XB_TMO      128
#define XB_XCNT(j)  (256  + 64 * (j))
#define XB_XSUB(j)  (1280 + 64 * (j))
#define XB_XGEN(j)  (2304 + 64 * (j))
#define XB_TOP      3328
#define XB_TOPGEN   3392
#define XCD_BAR_WORDS 3456
#define XB_SPIN_CAP (1u << 22)
#define LAS __attribute__((address_space(3)))
__device__ __forceinline__ unsigned xb_ld(unsigned* p) { return __hip_atomic_load(p, __ATOMIC_RELAXED, __HIP_MEMORY_SCOPE_AGENT); }
__device__ __forceinline__ unsigned xb_add(unsigned* p, unsigned v) { return __hip_atomic_fetch_add(p, v, __ATOMIC_RELAXED, __HIP_MEMORY_SCOPE_AGENT); }
__device__ __forceinline__ unsigned xb_xcc_id() { return (unsigned)__builtin_amdgcn_s_getreg((3 << 11) | 20) & 0xFu; }
#define XB_SPIN(cond, bar) do { unsigned _sp = 0; while (cond) { __builtin_amdgcn_s_sleep(1); \
    if ((++_sp & 255u) == 0u) { if (xb_ld(&(bar)[XB_TMO])) break; if (_sp > XB_SPIN_CAP) { atomicAdd(&(bar)[XB_TMO], 1u); break; } } } } while (0)
struct XcdBarrier { unsigned* bar; unsigned x; volatile LAS unsigned* st; };
__device__ __forceinline__ XcdBarrier xcd_barrier_post(unsigned* bar, volatile LAS unsigned* st) {
  XcdBarrier b; b.bar = bar; b.x = xb_xcc_id(); b.st = st;
  if (threadIdx.x == 0) (void)xb_add(&bar[XB_XCNT(b.x)], 1u);
  return b;
}
__device__ __forceinline__ void xcd_barrier_complete(unsigned* bar, unsigned x, unsigned& nloc, unsigned& nx) {
  const unsigned G = gridDim.x * gridDim.y * gridDim.z;
  unsigned sum, cnt, mine, sp = 0u;
  for (;;) {
    sum = 0u; cnt = 0u; mine = 0u;
#pragma unroll
    for (unsigned j = 0; j < 16; ++j) { const unsigned c = xb_ld(&bar[XB_XCNT(j)]); sum += c; cnt += (c > 0u) ? 1u : 0u; mine = (j == x) ? c : mine; }
    if (sum == G) break;
    __builtin_amdgcn_s_sleep(1);
    if ((++sp & 255u) == 0u) { if (xb_ld(&bar[XB_TMO])) break; if (sp > XB_SPIN_CAP) { atomicAdd(&bar[XB_TMO], 1u); break; } }
  }
  nloc = mine > 0u ? mine : 1u; nx = cnt > 0u ? cnt : 1u;
}
__device__ __forceinline__ void xcd_barrier(unsigned* bar_u, volatile LAS unsigned* st_u) {
  XcdBarrier b; b.bar = bar_u; b.x = xb_xcc_id(); b.st = st_u;
  asm volatile("s_waitcnt vmcnt(0)" ::: "memory");
  __syncthreads();
  if (threadIdx.x == 0) {
    unsigned long long bp_ = (unsigned long long)b.bar;
    asm volatile("" : "+v"(bp_));
    unsigned* bar = (unsigned*)bp_;
    __builtin_amdgcn_s_waitcnt(0);
    unsigned nloc = b.st[0], nx = b.st[1];
    if (nloc == 0u) { xcd_barrier_complete(bar, b.x, nloc, nx); b.st[0] = nloc; b.st[1] = nx; }
    const unsigned old = xb_add(&bar[XB_XSUB(b.x)], 1u);
    const unsigned gen = old / nloc;
    if (old + 1u == (gen + 1u) * nloc) {
      __builtin_amdgcn_fence(__ATOMIC_RELEASE, "agent");
      asm volatile("s_waitcnt vmcnt(0)" ::: "memory");
      const unsigned og = xb_add(&bar[XB_TOP], 1u);
      const unsigned tg = og / nx;
      if (og + 1u == (tg + 1u) * nx) xb_add(&bar[XB_TOPGEN], 1u);
      else XB_SPIN(xb_ld(&bar[XB_TOPGEN]) == tg, bar);
      __builtin_amdgcn_fence(__ATOMIC_ACQUIRE, "agent");
      xb_add(&bar[XB_XGEN(b.x)], 1u);
      asm volatile("s_waitcnt vmcnt(0)" ::: "memory");
    } else {
      XB_SPIN(xb_ld(&bar[XB_XGEN(b.x)]) == gen, bar);
      __builtin_amdgcn_fence(__ATOMIC_ACQUIRE, "agent");
      asm volatile("s_waitcnt vmcnt(0)" ::: "memory");
    }
  }
  __syncthreads();
}

template <int l>
__device__ __forceinline__ void layer_body(const P& p, char* smem, pg8::PG8_LAS_T lds, volatile LAS unsigned* xbw, const int nb, const int bid) {
    const bool last = (l == 1);
    const int n_mt = last ? 128 : 136;
    if (l == 0) {
      phase_norm(p, l, 0);
      xcd_barrier(p.counters + 1024, xbw);
    }
_Pragma("unroll 1")
    for (int rep = 0; rep < REP_INPROJ; ++rep) {
      pg8::Gemm g; pg8::Order S;
      g.A = (const u16*)p.xn8; g.Bt = (const u16*)(p.Win8 + (size_t)l * 2816 * 1024); g.lda = 512; g.ldb = 512; g.K = 512;
      S.init(136, 6, nb, bid, 4, 5);
      pg8::EpiInprojN8 e1; e1.qk = p.qk; e1.rg = p.rg; e1.sa = p.sa; e1.sw = p.sw + l * 5888;
      pg8::gemm_phase(lds, g, S, e1);
      g.A = (const u16*)(p.Win8 + ((size_t)l * 2816 + 1024) * 1024); g.Bt = (const u16*)p.xn8;
      S.init(5, 136, nb, bid);
      pg8::EpiInprojT8 e2; e2.vT = p.vT; e2.sa = p.sa; e2.sw = p.sw + l * 5888 + 1024;
      pg8::gemm_phase(lds, g, S, e2);
    }
    xcd_barrier(p.counters + 1024, xbw);
    phase_mixers(p, l, smem, p.counters + l * 4);
    xcd_barrier(p.counters + 1024, xbw);
_Pragma("unroll 1")
    for (int rep = 0; rep < REP_2B; ++rep)
      for (int task = bid; task < 1088 + 512; task += nb) {
        if (task < 1088) rg_wave_task(p, l, task >> 2, task & 3, 1, last, smem);
        else yb_transpose_task(p, (task - 1088) >> 6, (task - 1088) & 63, smem);
      }
    xcd_barrier(p.counters + 1024, xbw);
_Pragma("unroll 1")
    for (int rep = 0; rep < REP_GATE; ++rep) {
      pg8::Gemm g; pg8::Order S;
      g.A = (const u16*)p.xn8; g.Bt = (const u16*)(p.Wg8 + (size_t)l * 3072 * 1024); g.lda = 512; g.ldb = 512; g.K = 512;
      S.init(n_mt, 12, nb, bid);
      pg8::EpiGate8 e; e.g8 = p.g8; e.bias = p.b_gate + l * 3072; e.sa = p.sa; e.sw = p.sw + l * 5888 + 2816;
      pg8::gemm_phase(lds, g, S, e);
    }
    xcd_barrier(p.counters + 1024, xbw);
_Pragma("unroll 1")
    for (int rep = 0; rep < REP_BRANCH; ++rep) {
      pg8::Gemm g; pg8::Order S;
      S.init(n_mt, 4, nb, bid);
      pg8::EpiBranch e; e.mbuf = p.mbuf; e.g8 = p.g8;
      g.lda = 1024;
      g.A = p.ycat; g.Bt = p.WaT + (size_t)l * 1024 * 512; g.ldb = 512; g.K = 512; e.br = 0;
      pg8::gemm_phase(lds, g, S, e);
      g.A = p.ycat + 512; g.Bt = p.WbT + (size_t)l * 1024 * 256; g.ldb = 256; g.K = 256; e.br = 1;
      pg8::gemm_phase(lds, g, S, e);
      g.A = p.ycat + 768; g.Bt = p.WcT + (size_t)l * 1024 * 256; g.ldb = 256; g.K = 256; e.br = 2;
      pg8::gemm_phase(lds, g, S, e);
    }
    xcd_barrier(p.counters + 1024, xbw);
    {
      pg8::Gemm g; pg8::Order S;
      g.A = p.mbuf; g.Bt = p.WoT + (size_t)l * 1024 * 1024; g.lda = 1024; g.ldb = 1024; g.K = 1024;
      S.init(n_mt, 4, nb, bid);
      pg8::EpiOut e; e.xsrc = (l == 0 ? p.x : p.out); e.csrc = (l == 0 ? p.ctx : p.ctxs); e.xdst = p.out; e.cdst = p.ctxs;
      e.modl = p.mod + (size_t)l * 9 * 6144;
      pg8::gemm_phase(lds, g, S, e);
      for (int t = bid; t < 8192; t += nb) {
        if (t < 4096) cvt_chunk_fp4(p.peer_u + (size_t)l * 16384 * 1024, p.Ub, (size_t)t, 64.0f, 0);
        else cvt_chunk_fp4(p.peer_v + (size_t)l * 16384 * 1024, p.Ub, (size_t)(t - 4096), 4.0f, 1);
      }
    }
    xcd_barrier(p.counters + 1024, xbw);
    phase_norm(p, l, 1);
    xcd_barrier(p.counters + 1024, xbw);
_Pragma("unroll 1")
    for (int rep = 0; rep < REP_Q; ++rep) {
      pg8::Gemm g; pg8::Order S;
      g.A = p.xn; g.Bt = p.WqkT + (size_t)l * 2048 * 1024; g.lda = 1024; g.ldb = 1024; g.K = 1024;
      S.init(n_mt, 8, nb, bid);
      pg8::EpiQ e; e.q = p.q;
      pg8::gemm_phase(lds, g, S, e);
    }
    xcd_barrier(p.counters + 1024, xbw);
_Pragma("unroll 1")
    for (int rep = 0; rep < REP_SCORE; ++rep)
      for (int task = bid; task < n_mt * 16; task += nb) peer_score_tile(p, l, task >> 4, task & 15, smem);
    xcd_barrier(p.counters + 1024, xbw);
_Pragma("unroll 1")
    for (int rep = 0; rep < REP_PEER; ++rep) phase_peer_experts(p, l, rep == REP_PEER - 1, smem);
    xcd_barrier(p.counters + 1024, xbw);
  }

__global__ void __launch_bounds__(NTHR) fwd_megakernel(P p) {
  __shared__ __attribute__((aligned(16))) char smem[SMEM_BYTES];
  cg::grid_group grid = cg::this_grid();
  const int nb = gridDim.x, bid = blockIdx.x;
  pg8::PG8_LAS_T lds = (pg8::PG8_LAS_T)smem;
  volatile LAS unsigned* xbw = (volatile LAS unsigned*)(smem + SMEM_BYTES - 32);
  if (threadIdx.x == 0) { xbw[0] = 0u; xbw[1] = 0u; xbw[2] = 0u; xbw[3] = 0u; }
  __syncthreads();
  (void)xcd_barrier_post(p.counters + 1024, xbw);

  phase_prep(p, smem);
  if (blockIdx.x < 136) phase_filters(p, 0, smem);
  if (blockIdx.x >= gridDim.x - 128) { for (int t = blockIdx.x - (gridDim.x - 128); t < 128; t += 128) filter_block_task(p, 1, 4096, t * 32, p.hT + (size_t)512 * 4096, smem); }
  grid.sync();
  phase_modreduce(p);
  for (int task = blockIdx.x; task < 512; task += gridDim.x) kf_task(p, task >> 8, task & 255, smem);
  for (int task = blockIdx.x; task < 256; task += gridDim.x) wqk_task(p, task >> 7, (task >> 3) & 15, task & 7, smem);
  for (int task = blockIdx.x; task < 2 * 1472; task += gridDim.x) {
    const int l = task / 1472, t = task - l * 1472;
    if (t < 704) tr_tile_i8(p.w_in + (size_t)l * 1024 * 2816, 2816, 1024, p.Win8 + (size_t)l * 2816 * 1024, t, p.sw + l * 5888, smem);
    else tr_tile_i8(p.w_gate + (size_t)l * 1024 * 3072, 3072, 1024, p.Wg8 + (size_t)l * 3072 * 1024, t - 704, p.sw + l * 5888 + 2816, smem);
  }
  xcd_barrier(p.counters + 1024, xbw);

  layer_body<0>(p, smem, lds, xbw, nb, bid);
  layer_body<1>(p, smem, lds, xbw, nb, bid);
}

extern "C" void kernel_launch(void* const* d_in, const int* in_sizes, int n_in, void* d_out, int out_size, void* d_ws,
                              size_t ws_size, hipStream_t stream) {
  P p;
  memset(&p, 0, sizeof(p));
  const float** ins = (const float**)&p;
  for (int i = 0; i < 37; ++i) ins[i] = (const float*)d_in[i];
  p.out = (float*)d_out;
  char* w = (char*)d_ws;
  size_t off = 0;
  auto take = [&](size_t bytes) { char* r = w + off; off += (bytes + 255) & ~(size_t)255; return r; };
  p.counters = (unsigned*)take(32768);
  p.WinT = nullptr; p.WgT = nullptr;
  p.Win8 = (unsigned char*)take((size_t)2 * 2816 * 1024);
  p.Wg8 = (unsigned char*)take((size_t)2 * 3072 * 1024);
  p.sw = (float*)take((size_t)2 * 5888 * 4);
  p.xn8 = (unsigned char*)take((size_t)NTOK * 1024);
  p.sa = (float*)take((size_t)NTOK * 4);
  p.WaT = (u16*)take((size_t)2 * 1024 * 512 * 2);
  p.WbT = (u16*)take((size_t)2 * 1024 * 256 * 2);
  p.WcT = (u16*)take((size_t)2 * 1024 * 256 * 2);
  p.WoT = (u16*)take((size_t)2 * 1024 * 1024 * 2);
  p.WqB = (u16*)take((size_t)2 * 1024 * 2048 * 2);
  p.WqkT = (u16*)take((size_t)2 * 2048 * 1024 * 2);
  p.keysB = (u16*)take((size_t)2 * 16 * 16384 * 2);
  p.rgW = (u16*)take((size_t)2 * 16 * 4096 * 2);
  p.modpart = (float*)take((size_t)16 * 2 * 9 * 6144 * 4);
  p.mod = (float*)take((size_t)2 * 9 * 6144 * 4);
  p.hT = (float*)take((size_t)2 * 512 * 4096 * 4);
  p.hc = (float*)take((size_t)512 * 256 * 4);
  p.Kf = (float*)take((size_t)2 * 256 * 8192 * 8);
  p.xn = (u16*)take((size_t)NTOK * 1024 * 2);
  p.qk = (u16*)take((size_t)NTOK * 1024 * 2);
  p.mbuf = p.qk;
  p.vT = (u16*)take((size_t)8 * 512 * 4096 * 2);
  p.vTc = (u16*)take((size_t)8 * 512 * 256 * 2);
  p.hyT = (u16*)take((size_t)8 * 768 * 4096 * 2);
  p.hyTc = (u16*)take((size_t)8 * 768 * 256 * 2);
  p.rg = (u16*)take((size_t)NTOK * 512 * 2);
  p.ycat = (u16*)take((size_t)NTOK * 1024 * 2);
  p.Ub = (unsigned char*)p.ycat;
  p.Vb = p.Ub + (size_t)16384 * 512;
  p.agg = (float*)take((size_t)8 * 2 * (136 + 34) * 256 * 8);
  p.ybT = (u16*)take((size_t)8 * 256 * 4096 * 2);
  p.ctxs = (float*)take((size_t)2048 * 1024 * 4);
  p.g8 = (unsigned char*)p.vT;
  p.q = p.qk;
  p.topk = (unsigned*)((char*)p.qk + (size_t)NTOK * 2048 * 2);
  if (off > ws_size) {
    fprintf(stderr, "workspace too small: need %zu have %zu\n", off, ws_size);
    return;
  }
  static int grid_blocks = 0;
  if (!grid_blocks) {
    int dev = 0, cus = 0, per_cu = 0;
    (void)hipGetDevice(&dev);
    (void)hipDeviceGetAttribute(&cus, hipDeviceAttributeMultiprocessorCount, dev);
    (void)hipOccupancyMaxActiveBlocksPerMultiprocessor(&per_cu, fwd_megakernel, NTHR, 0);
    if (per_cu > 1) per_cu = 1;
    grid_blocks = cus * per_cu;
  }
  (void)hipMemsetAsync(p.counters, 0, 32768, stream);
  void* args[] = {&p};
  hipError_t e = hipLaunchCooperativeKernel((void*)fwd_megakernel, dim3(grid_blocks), dim3(NTHR), args, 0, stream);
  if (e != hipSuccess) fprintf(stderr, "cooperative launch failed: %s (grid %d)\n", hipGetErrorString(e), grid_blocks);
}
```

```cpp
#include <hip/hip_runtime.h>
#include <hip/hip_cooperative_groups.h>
#include <cstdio>
#include <cstring>
namespace cg = cooperative_groups;

typedef unsigned short u16;
typedef __attribute__((ext_vector_type(8))) short bf16x8;
typedef __attribute__((ext_vector_type(16))) float f32x16;
typedef __attribute__((ext_vector_type(2))) float f32x2;
typedef int i32x8 __attribute__((ext_vector_type(8)));

#define NLAT 32768
#define NTOK 34816
#define SMEM_BYTES 151552
#define NTHR 512
#ifndef DUP_1A
#define DUP_1A 1
#endif
#ifndef DUP_PREP
#define DUP_PREP 1
#endif
#ifndef DUP_2B
#define DUP_2B 1
#endif
#ifndef XRGA
#define XRGA 1
#endif
#ifndef REP_PEER
#define REP_PEER 1
#endif
#ifndef REP_INPROJ
#define REP_INPROJ 1
#endif
#ifndef REP_GATE
#define REP_GATE 1
#endif
#ifndef REP_BRANCH
#define REP_BRANCH 1
#endif
#ifndef REP_Q
#define REP_Q 1
#endif
#ifndef REP_SCORE
#define REP_SCORE 1
#endif
#ifndef REP_1A
#define REP_1A 1
#endif
#ifndef REP_2B
#define REP_2B 1
#endif
#ifndef REP_KF
#define REP_KF 1
#endif
#ifndef DUP_GEMM
#define DUP_GEMM 1
#endif
#ifndef DUP_PEER
#define DUP_PEER 1
#endif
#ifndef DUP_MIX
#define DUP_MIX 1
#endif
#ifndef XRG
#define XRG 1
#endif
#ifndef XFFT
#define XFFT 1
#endif
#ifndef XATT
#define XATT 1
#endif

struct P {
  const float *x, *c, *ctx, *c_ctx, *norm_mix_g, *norm_ffn_g, *w_ada, *b_ada, *w_in, *na_rpb,
      *hy_short_w, *hy_short_b, *hy_f1_w, *hy_f1_b, *hy_f2_w, *hy_f2_b, *hy_f3_w, *hy_freq, *hy_bias,
      *rg_conv_w, *rg_conv_b, *rg_wa, *rg_ba, *rg_wx, *rg_bx, *rg_lambda,
      *w_gate, *b_gate, *w_br_a, *w_br_b, *w_br_c, *w_out, *peer_wq, *peer_keys, *peer_u, *peer_v, *final_g;
  float* out;
  unsigned* counters;
  u16 *WinT, *WgT, *WaT, *WbT, *WcT, *WoT, *WqB, *WqkT, *keysB, *rgW;
  float *modpart, *mod, *hT, *hc;
  float* Kf;
  u16 *xn, *qk, *vT, *vTc, *hyT, *hyTc, *rg, *ycat, *mbuf, *ybT;
  unsigned char *Ub, *Vb, *g8, *xn8, *Win8, *Wg8;
  float *sa, *sw;
  u16* q;
  float *agg, *ctxs;
  unsigned* topk;
};

__device__ __forceinline__ u16 f2bf(float f) {
  unsigned u = __float_as_uint(f);
  u += 0x7fffu + ((u >> 16) & 1u);
  return (u16)(u >> 16);
}
__device__ __forceinline__ float bf2f(u16 h) { return __uint_as_float(((unsigned)h) << 16); }
__device__ __forceinline__ unsigned pk2(float a, float b) { return (unsigned)f2bf(a) | ((unsigned)f2bf(b) << 16); }
__device__ __forceinline__ float bflo(unsigned u) { return __uint_as_float(u << 16); }
__device__ __forceinline__ float bfhi(unsigned u) { return __uint_as_float(u & 0xffff0000u); }
__device__ __forceinline__ int opaque_tid() {
  int t = threadIdx.x;
  asm volatile("" : "+v"(t));
  return t;
}
__device__ __forceinline__ int my_lane() { return opaque_tid() & 63; }
__device__ __forceinline__ float shx(float v, int o);
__device__ __forceinline__ float shf(float v, int src) { return __builtin_bit_cast(float, __builtin_amdgcn_ds_bpermute((src & 63) << 2, __builtin_bit_cast(int, v))); }
__device__ __forceinline__ unsigned shu(unsigned v, int src) { return (unsigned)__builtin_amdgcn_ds_bpermute((src & 63) << 2, (int)v); }
typedef unsigned u32x2_t __attribute__((ext_vector_type(2)));
template <int J> __device__ __forceinline__ unsigned xorl(unsigned v, int lane) {
  if constexpr (J == 1) return (unsigned)__builtin_amdgcn_mov_dpp((int)v, 0xB1, 0xF, 0xF, true);
  else if constexpr (J == 2) return (unsigned)__builtin_amdgcn_mov_dpp((int)v, 0x4E, 0xF, 0xF, true);
  else if constexpr (J == 4) {
    const unsigned a = (unsigned)__builtin_amdgcn_mov_dpp((int)v, 0x104, 0xF, 0xF, true);
    const unsigned b = (unsigned)__builtin_amdgcn_mov_dpp((int)v, 0x114, 0xF, 0xF, true);
    return (lane & 4) ? b : a;
  }
  else if constexpr (J == 8) return (unsigned)__builtin_amdgcn_mov_dpp((int)v, 0x128, 0xF, 0xF, true);
  else if constexpr (J == 16) { const u32x2_t r = __builtin_amdgcn_permlane16_swap(v, v, false, false); return (lane & 16) ? r.x : r.y; }
  else { const u32x2_t r = __builtin_amdgcn_permlane32_swap(v, v, false, false); return (lane & 32) ? r.x : r.y; }
}
template <int J> __device__ __forceinline__ float xorf(float v, int lane) { return __uint_as_float(xorl<J>(__float_as_uint(v), lane)); }
__device__ __forceinline__ float shx(float v, int o) {
  const int lane = my_lane();
  switch (o) {
    case 1: return xorf<1>(v, lane);
    case 2: return xorf<2>(v, lane);
    case 4: return xorf<4>(v, lane);
    case 8: return xorf<8>(v, lane);
    case 16: return xorf<16>(v, lane);
    case 32: return xorf<32>(v, lane);
    default: return __builtin_bit_cast(float, __builtin_amdgcn_ds_bpermute(((lane ^ o) << 2), __builtin_bit_cast(int, v)));
  }
}
__device__ __forceinline__ float wave_sum(float v) {
  const int lane = my_lane();
  v += xorf<32>(v, lane); v += xorf<16>(v, lane); v += xorf<8>(v, lane); v += xorf<4>(v, lane); v += xorf<2>(v, lane); v += xorf<1>(v, lane);
  return v;
}
__device__ __forceinline__ float wave_max(float v) {
  const int lane = my_lane();
  v = fmaxf(v, xorf<32>(v, lane)); v = fmaxf(v, xorf<16>(v, lane)); v = fmaxf(v, xorf<8>(v, lane));
  v = fmaxf(v, xorf<4>(v, lane)); v = fmaxf(v, xorf<2>(v, lane)); v = fmaxf(v, xorf<1>(v, lane));
  return v;
}
__device__ __forceinline__ float sigmoidf_(float x) { return __builtin_amdgcn_rcpf(1.0f + __expf(-x)); }
__device__ __forceinline__ float gelu_tanh(float x) {
  const float u2 = 1.5957691216057308f * (x + 0.044715f * x * x * x);
  return x * __builtin_amdgcn_rcpf(1.0f + __expf(-u2));
}
__device__ __forceinline__ f32x16 mfma32(bf16x8 a, bf16x8 b, f32x16 c) {
  return __builtin_amdgcn_mfma_f32_32x32x16_bf16(a, b, c, 0, 0, 0);
}
__device__ __forceinline__ f32x16 zero16() {
  f32x16 z;
#pragma unroll
  for (int i = 0; i < 16; ++i) z[i] = 0.f;
  return z;
}
__device__ __forceinline__ int swz128(int row, int ch) { return row * 128 + ((ch ^ ((row >> 1) & 7)) << 4); }
__device__ __forceinline__ int swz256(int row, int ch) { return row * 256 + ((ch ^ (row & 15)) << 4); }

struct c2 { float x, y; };
__device__ __forceinline__ c2 cadd(c2 a, c2 b) { return {a.x + b.x, a.y + b.y}; }
__device__ __forceinline__ c2 csub(c2 a, c2 b) { return {a.x - b.x, a.y - b.y}; }
__device__ __forceinline__ c2 cmul(c2 a, c2 b) { return {a.x * b.x - a.y * b.y, a.x * b.y + a.y * b.x}; }
__device__ __forceinline__ float c16(int i) {
  const float tb[16] = {1.0f, 0.9238795325112867f, 0.7071067811865476f, 0.3826834323650898f, 0.0f,
                        -0.3826834323650898f, -0.7071067811865476f, -0.9238795325112867f, -1.0f,
                        -0.9238795325112867f, -0.7071067811865476f, -0.3826834323650898f, 0.0f,
                        0.3826834323650898f, 0.7071067811865476f, 0.9238795325112867f};
  return tb[i & 15];
}
__device__ __forceinline__ float s16(int i) { return c16(i + 12); }
template <int R> __device__ __forceinline__ constexpr int brev(int k) {
  int r = 0;
  for (int b = 1, o = R >> 1; b < R; b <<= 1, o >>= 1)
    if (k & b) r |= o;
  return r;
}
template <int R> __device__ __forceinline__ void dft_reg(c2* v, float sgn) {
#pragma unroll
  for (int h = R / 2; h >= 1; h >>= 1) {
#pragma unroll
    for (int g = 0; g < R; g += 2 * h) {
#pragma unroll
      for (int j = 0; j < h; ++j) {
        c2 a = v[g + j], b = v[g + j + h];
        v[g + j] = cadd(a, b);
        c2 d = csub(a, b);
        const int ti = j * (16 / (2 * h));
        c2 w = {c16(ti), sgn * s16(ti)};
        v[g + j + h] = (j == 0) ? d : cmul(d, w);
      }
    }
  }
}
template <int R> __device__ __forceinline__ int fft_bfly(c2* v, int j, int Ns, float sgn) {
  const int k = j & (Ns - 1);
  const float f = sgn * (float)k / (float)(Ns * R);
#pragma unroll
  for (int r = 1; r < R; ++r) {
    float t = f * (float)r;
    c2 w = {__builtin_amdgcn_cosf(t), __builtin_amdgcn_sinf(t)};
    v[r] = cmul(v[r], w);
  }
  dft_reg<R>(v, sgn);
  return (j - k) * R + k;
}
template <int R> __device__ __forceinline__ void fft_pass(c2* buf, int Ns, float sgn) {
  constexpr int NBF = 8192 / R;
  constexpr int PER = NBF / NTHR;
  const int tid = opaque_tid();
  c2 v[PER][R];
#pragma unroll
  for (int i = 0; i < PER; ++i) {
    const int j = tid + NTHR * i;
#pragma unroll
    for (int r = 0; r < R; ++r) v[i][r] = buf[j + r * NBF];
  }
  __syncthreads();
#pragma unroll
  for (int i = 0; i < PER; ++i) {
    const int j = tid + NTHR * i;
    const int base = fft_bfly<R>(v[i], j, Ns, sgn);
#pragma unroll
    for (int r = 0; r < R; ++r) buf[base + r * Ns] = v[i][brev<R>(r)];
  }
  __syncthreads();
}
__device__ __forceinline__ void fft8192(c2* buf, float sgn) {
  fft_pass<8>(buf, 1, sgn);
  fft_pass<8>(buf, 8, sgn);
  fft_pass<8>(buf, 64, sgn);
  fft_pass<16>(buf, 512, sgn);
}

__device__ __forceinline__ void gemm_kloop(f32x16 (&acc)[2][2], const u16* __restrict__ A, int lda,
                                           const u16* __restrict__ B, int ldb, int K, char* smem) {
  const int tid = opaque_tid(), lane = tid & 63, wid = tid >> 6;
  const int wm = wid >> 1, wn = wid & 1;
  const int l31 = lane & 31, hh = lane >> 5;
  uint4 ra[4], rb[2];
  const int nk = K >> 6;
  const int srow = tid >> 3, sch = tid & 7;
  const char* Ab = (const char*)A;
  const char* Bb = (const char*)B;
  const unsigned aoff = (unsigned)(srow * lda + sch * 8) * 2u;
  const unsigned boff = (unsigned)(srow * ldb + sch * 8) * 2u;
  const unsigned astep = (unsigned)lda * 128u, bstep = (unsigned)ldb * 128u;
#pragma unroll
  for (int i = 0; i < 4; ++i) ra[i] = *(const uint4*)(Ab + (aoff + i * astep));
#pragma unroll
  for (int i = 0; i < 2; ++i) rb[i] = *(const uint4*)(Bb + (boff + i * bstep));
#pragma unroll
  for (int i = 0; i < 4; ++i) *(uint4*)(smem + swz128(srow + i * 64, sch)) = ra[i];
#pragma unroll
  for (int i = 0; i < 2; ++i) *(uint4*)(smem + 65536 + swz128(srow + i * 64, sch)) = rb[i];
  __syncthreads();
  for (int kt = 0; kt < nk; ++kt) {
    const bool more = (kt + 1 < nk);
    if (more) {
      const unsigned ko = (unsigned)(kt + 1) * 128u;
#pragma unroll
      for (int i = 0; i < 4; ++i) ra[i] = *(const uint4*)(Ab + (aoff + i * astep + ko));
#pragma unroll
      for (int i = 0; i < 2; ++i) rb[i] = *(const uint4*)(Bb + (boff + i * bstep + ko));
    }
    const char* as = smem + (kt & 1) * 32768;
    const char* bs = smem + 65536 + (kt & 1) * 16384;
    int lrow = l31;
    asm volatile("" : "+v"(lrow));
#pragma unroll
    for (int s = 0; s < 4; ++s) {
      bf16x8 af[2], bfr[2];
#pragma unroll
      for (int i = 0; i < 2; ++i) af[i] = *(const bf16x8*)(as + swz128(wm * 64 + i * 32 + lrow, s * 2 + hh));
#pragma unroll
      for (int j = 0; j < 2; ++j) bfr[j] = *(const bf16x8*)(bs + swz128(wn * 64 + j * 32 + lrow, s * 2 + hh));
#pragma unroll
      for (int i = 0; i < 2; ++i)
#pragma unroll
        for (int j = 0; j < 2; ++j) acc[i][j] = mfma32(af[i], bfr[j], acc[i][j]);
    }
    if (more) {
      char* an = smem + ((kt + 1) & 1) * 32768;
      char* bn = smem + 65536 + ((kt + 1) & 1) * 16384;
      int sr2 = srow;
      asm volatile("" : "+v"(sr2));
#pragma unroll
      for (int i = 0; i < 4; ++i) *(uint4*)(an + swz128(sr2 + i * 64, sch)) = ra[i];
#pragma unroll
      for (int i = 0; i < 2; ++i) *(uint4*)(bn + swz128(sr2 + i * 64, sch)) = rb[i];
    }
    __syncthreads();
  }
}
__device__ __forceinline__ void zero_acc(f32x16 (&acc)[2][2]) {
#pragma unroll
  for (int i = 0; i < 2; ++i)
#pragma unroll
    for (int j = 0; j < 2; ++j) acc[i][j] = zero16();
}
#define EPI_ROW(i, e) (wm * 64 + (i)*32 + ((e)&3) + 8 * ((e) >> 2) + 4 * hh)
#define EPI_COL(j) (wn * 64 + (j)*32 + l31)
#define EPI_VARS                                                    \
  const int tid = opaque_tid(), lane = tid & 63, wid = tid >> 6;     \
  const int wm = wid >> 1, wn = wid & 1, l31 = lane & 31, hh = lane >> 5; \
  (void)tid; (void)wm; (void)wn; (void)l31; (void)hh;


namespace pg8 {
__device__ __forceinline__ unsigned pkh(float a, float b) { unsigned r; asm("v_cvt_pk_bf16_f32 %0, %1, %2" : "=v"(r) : "v"(a), "v"(b)); return r; }
#define PG8_LAS __attribute__((address_space(3)))
typedef PG8_LAS unsigned char* PG8_LAS_T;
typedef float f32x4 __attribute__((ext_vector_type(4)));
typedef unsigned u32x4 __attribute__((ext_vector_type(4)));
typedef int i32x4 __attribute__((ext_vector_type(4)));
constexpr int BM = 256, BK = 64, HALF = 128, HTB = HALF * BK * 2, STAGE_BYTES = 8 * HTB, NXCD = 8, WGM = 8;
__device__ __forceinline__ int lds_byte(int r, int c) { const int st = (r >> 4) * 2 + (c >> 5), rr = r & 15, cc = c & 31, ob = rr * 64 + cc * 2; return st * 1024 + (ob ^ (((ob >> 9) & 1) << 5)); }
__device__ __forceinline__ void stage_rc(int b, int& R, int& C) { const int st = b / 1024, sb = b % 1024, swz = sb ^ (((sb >> 9) & 1) << 5); R = (st >> 1) * 16 + swz / 64; C = (st & 1) * 32 + (swz % 64) / 2; }
__device__ __forceinline__ int perm32(int rho) { const int n = rho >> 4, i = rho & 15; return 8 * (i >> 2) + 4 * n + (i & 3); }
struct Unit { int pm, pn; };
struct Gemm { const u16* A; const u16* Bt; int lda, ldb, K; };
struct Order {
  int nM, nN, nwg, G, c, skip_from, skip_by;
  __device__ __forceinline__ void init(int nM_, int nN_, int G_, int c_, int sf = 1 << 30, int sb = 0) { nM = nM_; nN = nN_; nwg = nM * nN; G = G_; c = c_; skip_from = sf; skip_by = sb; }
  __device__ __forceinline__ bool next(int i, Unit& u) const {
    const long L = (long)i * G + c; if (L >= nwg) return false;
    int wgid = (int)L; { const int q = nwg / NXCD, r = nwg % NXCD, xcd = wgid % NXCD, off = wgid / NXCD; wgid = (xcd < r ? xcd * (q + 1) : r * (q + 1) + (xcd - r) * q) + off; }
    const int nig = WGM * nN, gid = wgid / nig, fm = gid * WGM, gsz = (nM - fm) < WGM ? (nM - fm) : WGM;
    u.pm = fm + ((wgid % nig) % gsz); u.pn = (wgid % nig) / gsz;
    if (u.pn >= skip_from) u.pn += skip_by;
    return true;
  }
};
__device__ __forceinline__ f32x4 mma16(bf16x8 a, bf16x8 b, f32x4 c) { return __builtin_amdgcn_mfma_f32_16x16x32_bf16(a, b, c, 0, 0, 0); }
__device__ __forceinline__ i32x4 mma16(bf16x8 a, bf16x8 b, i32x4 c) { return __builtin_amdgcn_mfma_i32_16x16x64_i8(__builtin_bit_cast(i32x4, a), __builtin_bit_cast(i32x4, b), c, 0, 0, 0); }
template <class Epi>
__device__ __forceinline__ void gemm_phase(PG8_LAS unsigned char* lds, const Gemm g, const Order& S, const Epi& E) {
  const int tid = opaque_tid(), wid = __builtin_amdgcn_readfirstlane(tid >> 6), lane = tid & 63, wr = wid >> 2, wc = wid & 3, fr = lane & 15, fq = lane >> 4;
  const int K = g.K, nt = K / BK;
  unsigned voffA[2], voffB[2];
#pragma unroll
  for (int i = 0; i < 2; ++i) { int R, C; stage_rc(tid * 16 + i * 8192, R, C); const int Rb = Epi::PERM ? ((R & ~31) + perm32(R & 31)) : R;
    voffA[i] = (unsigned)(R * g.lda + C) * 2u; voffB[i] = (unsigned)(Rb * g.ldb + C) * 2u; }
  const size_t kstep = (size_t)(BK * 2);
  const size_t hstepA = (size_t)HALF * g.lda * 2, hstepB = (size_t)HALF * g.ldb * 2;
  const size_t tstepA = 2 * hstepA, tstepB = 2 * hstepB;
  const unsigned ldsw = (unsigned)wid * 1024u;
  const int aoff = lds_byte(wr * 64 + fr, fq * 8), boff = lds_byte(wc * 32 + fr, fq * 8);
#define PG8_SA(b, h) (((b) * 2 + (h)) * HTB)
#define PG8_SB(b, h) ((4 + (b) * 2 + (h)) * HTB)
#define PG8_STAGE(bufoff, gbase, voff) do { _Pragma("unroll") for (int _i = 0; _i < 2; ++_i) \
    __builtin_amdgcn_global_load_lds((const unsigned*)((const char*)(gbase) + (voff)[_i]), (PG8_LAS unsigned*)(lds + (bufoff) + ldsw + _i * 8192), 16, 0, 0); } while (0)
#define PG8_LDA(dst, b, h) do { _Pragma("unroll") for (int m = 0; m < 4; ++m) _Pragma("unroll") for (int k = 0; k < 2; ++k) dst[m][k] = *(const PG8_LAS bf16x8*)(lds + PG8_SA(b, h) + aoff + m * 2048 + k * 1024); } while (0)
#define PG8_LDB(dst, b, h) do { _Pragma("unroll") for (int n = 0; n < 2; ++n) _Pragma("unroll") for (int k = 0; k < 2; ++k) dst[n][k] = *(const PG8_LAS bf16x8*)(lds + PG8_SB(b, h) + boff + n * 2048 + k * 1024); } while (0)
#define PG8_MMA(ai, bj, At, Bt) do { __builtin_amdgcn_s_setprio(1); _Pragma("unroll") for (int m = 0; m < 4; ++m) _Pragma("unroll") for (int n = 0; n < 2; ++n) _Pragma("unroll") for (int k = 0; k < 2; ++k) \
    acc[ai][bj][m][n] = mma16(Bt[n][k], At[m][k], acc[ai][bj][m][n]); __builtin_amdgcn_s_setprio(0); } while (0)
#define PG8_WAIT_V(n) asm volatile("s_waitcnt vmcnt(" #n ")" ::: "memory")
#define PG8_WAIT_L(n) asm volatile("s_waitcnt lgkmcnt(" #n ")" ::: "memory")
#define PG8_BAR __builtin_amdgcn_s_barrier()
#define PG8_SCHED __builtin_amdgcn_sched_barrier(0)
  Unit cur, nxt; int ui = 0;
  if (!S.next(0, cur)) return;
  typedef typename Epi::acc_t acc_t;
  acc_t acc[2][2][4][2];
#pragma unroll
  for (int a = 0; a < 2; ++a)
#pragma unroll
    for (int b = 0; b < 2; ++b)
#pragma unroll
      for (int m = 0; m < 4; ++m)
#pragma unroll
        for (int n = 0; n < 2; ++n) acc[a][b][m][n] = (acc_t){0, 0, 0, 0};
  bf16x8 At[4][2], B0[2][2], B1[2][2];
  const char* cA = (const char*)g.A + (size_t)cur.pm * tstepA; const char* cB = (const char*)g.Bt + (size_t)cur.pn * tstepB;
  PG8_STAGE(PG8_SB(0, 0), cB, voffB); PG8_STAGE(PG8_SA(0, 0), cA, voffA); PG8_STAGE(PG8_SB(0, 1), cB + hstepB, voffB); PG8_STAGE(PG8_SA(0, 1), cA + hstepA, voffA);
  if (wr == 1) PG8_BAR;
  PG8_WAIT_V(4); PG8_BAR;
  PG8_STAGE(PG8_SB(1, 0), cB + kstep, voffB); PG8_STAGE(PG8_SA(1, 0), cA + kstep, voffA); PG8_STAGE(PG8_SB(1, 1), cB + hstepB + kstep, voffB);
  PG8_WAIT_V(6); PG8_BAR;
  for (;;) {
    const bool has_next = S.next(ui + 1, nxt);
    const char* nA = has_next ? (const char*)g.A + (size_t)nxt.pm * tstepA : cA; const char* nB = has_next ? (const char*)g.Bt + (size_t)nxt.pn * tstepB : cB;
    for (int t = 0; t < nt; t += 2) {
      const bool last = (t == nt - 2);
      const char* a1 = cA + (size_t)(t + 1) * kstep;
      const char* a2 = last ? nA : cA + (size_t)(t + 2) * kstep; const char* b2 = last ? nB : cB + (size_t)(t + 2) * kstep;
      const char* a3 = a2 + kstep; const char* b3 = b2 + kstep;
      PG8_LDB(B0, 0, 0); PG8_SCHED; PG8_LDA(At, 0, 0); PG8_STAGE(PG8_SA(1, 1), a1 + hstepA, voffA);
      PG8_WAIT_L(8); PG8_BAR; PG8_WAIT_L(0); PG8_MMA(0, 0, At, B0); PG8_BAR; PG8_SCHED;
      PG8_LDB(B1, 0, 1); PG8_STAGE(PG8_SB(0, 0), b2, voffB);
      PG8_BAR; PG8_WAIT_L(0); PG8_MMA(0, 1, At, B1); PG8_BAR;
      PG8_LDA(At, 0, 1); PG8_STAGE(PG8_SA(0, 0), a2, voffA);
      PG8_BAR; PG8_WAIT_L(0); PG8_MMA(1, 0, At, B0); PG8_BAR; PG8_SCHED;
      PG8_STAGE(PG8_SB(0, 1), b2 + hstepB, voffB);
      PG8_WAIT_V(6); PG8_BAR; PG8_MMA(1, 1, At, B1); PG8_BAR;
      PG8_LDB(B0, 1, 0); PG8_SCHED; PG8_LDA(At, 1, 0); PG8_STAGE(PG8_SA(0, 1), a2 + hstepA, voffA);
      PG8_WAIT_L(8); PG8_BAR; PG8_WAIT_L(0); PG8_MMA(0, 0, At, B0); PG8_BAR; PG8_SCHED;
      PG8_LDB(B1, 1, 1); PG8_STAGE(PG8_SB(1, 0), b3, voffB);
      PG8_BAR; PG8_WAIT_L(0); PG8_MMA(0, 1, At, B1); PG8_BAR;
      PG8_LDA(At, 1, 1); PG8_STAGE(PG8_SA(1, 0), a3, voffA);
      PG8_BAR; PG8_WAIT_L(0); PG8_MMA(1, 0, At, B0); PG8_BAR; PG8_SCHED;
      PG8_STAGE(PG8_SB(1, 1), b3 + hstepB, voffB);
      PG8_WAIT_V(6); PG8_BAR; PG8_MMA(1, 1, At, B1); PG8_BAR;
    }
    E(acc, cur, wr, wc, fr, fq);
    if (!has_next) break;
#pragma unroll
    for (int a = 0; a < 2; ++a)
#pragma unroll
      for (int b = 0; b < 2; ++b)
#pragma unroll
        for (int m = 0; m < 4; ++m)
#pragma unroll
          for (int n = 0; n < 2; ++n) acc[a][b][m][n] = (acc_t){0, 0, 0, 0};
    cur = nxt; cA = nA; cB = nB; ++ui;
  }
  PG8_WAIT_V(0);
  if (wr == 0) PG8_BAR;
  PG8_BAR;
#undef PG8_SA
#undef PG8_SB
#undef PG8_STAGE
#undef PG8_LDA
#undef PG8_LDB
#undef PG8_MMA
#undef PG8_WAIT_V
#undef PG8_WAIT_L
#undef PG8_BAR
#undef PG8_SCHED
}
typedef const f32x4 (&AccRef)[2][2][4][2];
typedef const i32x4 (&AccRefI)[2][2][4][2];
struct EpiInprojN {
  static constexpr bool PERM = true;
  typedef f32x4 acc_t;
  u16* qk; u16* rg;
  __device__ __forceinline__ void operator()(AccRef acc, const Unit& u, int wr, int wc, int fr, int fq) const {
    const int row0 = u.pm * BM + wr * 64 + fr;
    u16* base; int ld, colt;
    if (u.pn < 4) { base = qk; ld = 1024; colt = u.pn * 256; } else { base = rg; ld = 512; colt = (u.pn - 9) * 256; }
    const int col0 = colt + wc * 32 + 8 * fq;
#pragma unroll
    for (int ai = 0; ai < 2; ++ai)
#pragma unroll
      for (int m = 0; m < 4; ++m) {
        u16* rowp = base + (size_t)(row0 + ai * HALF + m * 16) * ld + col0;
#pragma unroll
        for (int bj = 0; bj < 2; ++bj) {
          const f32x4 v0 = acc[ai][bj][m][0], v1 = acc[ai][bj][m][1];
          u32x4 w; w.x = pkh(v0[0], v0[1]); w.y = pkh(v0[2], v0[3]); w.z = pkh(v1[0], v1[1]); w.w = pkh(v1[2], v1[3]);
          *(u32x4*)(rowp + bj * HALF) = w;
        }
      }
  }
};
struct EpiInprojT {
  static constexpr bool PERM = true;
  typedef f32x4 acc_t;
  u16 *vT, *vTc, *hyT, *hyTc;
  __device__ __forceinline__ void operator()(AccRef acc, const Unit& u, int wr, int wc, int fr, int fq) const {
    const bool isctx = (u.pn >= 128);
    const int b = isctx ? (u.pn - 128) : (u.pn >> 4);
    const int Lseg = isctx ? 256 : 4096, t0 = isctx ? 0 : (u.pn & 15) * 256;
    const bool isv = (u.pm < 2);
    const size_t boff = isv ? (isctx ? (size_t)16777216 : (size_t)0) : (isctx ? (size_t)(16777216 + 1048576 + 25165824) : (size_t)(16777216 + 1048576));
    u16* base = vT + boff;
    const int nc = isv ? 512 : 768;
    const int wrow0 = (isv ? u.pm : u.pm - 2) * BM + wr * 64 + fr;
    const int col0 = t0 + wc * 32 + 8 * fq;
#pragma unroll
    for (int ai = 0; ai < 2; ++ai)
#pragma unroll
      for (int m = 0; m < 4; ++m) {
        u16* rowp = base + ((size_t)(b * nc + wrow0 + ai * HALF + m * 16)) * Lseg + col0;
#pragma unroll
        for (int bj = 0; bj < 2; ++bj) {
          const f32x4 v0 = acc[ai][bj][m][0], v1 = acc[ai][bj][m][1];
          u32x4 w; w.x = pkh(v0[0], v0[1]); w.y = pkh(v0[2], v0[3]); w.z = pkh(v1[0], v1[1]); w.w = pkh(v1[2], v1[3]);
          *(u32x4*)(rowp + bj * HALF) = w;
        }
      }
  }
};
struct EpiGate {
  static constexpr bool PERM = true;
  typedef f32x4 acc_t;
  unsigned char* g8; const float* bias;
  __device__ __forceinline__ void operator()(AccRef acc, const Unit& u, int wr, int wc, int fr, int fq) const {
    const int row0 = u.pm * BM + wr * 64 + fr;
    const int col0 = u.pn * BM + wc * 32 + 8 * fq;
#pragma unroll
    for (int bj = 0; bj < 2; ++bj) {
      const f32x4 b0 = *(const f32x4*)(bias + col0 + bj * HALF), b1 = *(const f32x4*)(bias + col0 + bj * HALF + 4);
#pragma unroll
      for (int ai = 0; ai < 2; ++ai)
#pragma unroll
        for (int m = 0; m < 4; ++m) {
          const f32x4 v0 = acc[ai][bj][m][0] + b0, v1 = acc[ai][bj][m][1] + b1;
          unsigned w0 = 0, w1 = 0;
#pragma unroll
          for (int k = 0; k < 4; ++k) {
            w0 |= (unsigned)(sigmoidf_(v0[k]) * 255.0f + 0.5f) << (8 * k);
            w1 |= (unsigned)(sigmoidf_(v1[k]) * 255.0f + 0.5f) << (8 * k);
          }
          *(uint2*)(g8 + (size_t)(row0 + ai * HALF + m * 16) * 3072 + col0 + bj * HALF) = make_uint2(w0, w1);
        }
    }
  }
};
struct EpiBranch {
  static constexpr bool PERM = true;
  typedef f32x4 acc_t;
  u16* mbuf; const unsigned char* g8; int br;
  __device__ __forceinline__ void operator()(AccRef acc, const Unit& u, int wr, int wc, int fr, int fq) const {
    const int row0 = u.pm * BM + wr * 64 + fr;
    const int col0 = u.pn * BM + wc * 32 + 8 * fq;
#pragma unroll
    for (int ai = 0; ai < 2; ++ai)
#pragma unroll
      for (int m = 0; m < 4; ++m) {
        const size_t row = (size_t)(row0 + ai * HALF + m * 16);
#pragma unroll
        for (int bj = 0; bj < 2; ++bj) {
          const uint2 gq = *(const uint2*)(g8 + row * 3072 + br * 1024 + col0 + bj * HALF);
          u16* mp = mbuf + row * 1024 + col0 + bj * HALF;
          const f32x4 v0 = acc[ai][bj][m][0], v1 = acc[ai][bj][m][1];
          float r[8];
          r[0] = (float)(gq.x & 255u) * v0[0]; r[1] = (float)((gq.x >> 8) & 255u) * v0[1];
          r[2] = (float)((gq.x >> 16) & 255u) * v0[2]; r[3] = (float)(gq.x >> 24) * v0[3];
          r[4] = (float)(gq.y & 255u) * v1[0]; r[5] = (float)((gq.y >> 8) & 255u) * v1[1];
          r[6] = (float)((gq.y >> 16) & 255u) * v1[2]; r[7] = (float)(gq.y >> 24) * v1[3];
          u32x4 w;
          if (br == 0) {
            w.x = pkh(r[0] * (1.f / 255.f), r[1] * (1.f / 255.f)); w.y = pkh(r[2] * (1.f / 255.f), r[3] * (1.f / 255.f));
            w.z = pkh(r[4] * (1.f / 255.f), r[5] * (1.f / 255.f)); w.w = pkh(r[6] * (1.f / 255.f), r[7] * (1.f / 255.f));
          } else {
            const u32x4 o = *(const u32x4*)mp;
            w.x = pkh(bflo(o.x) + r[0] * (1.f / 255.f), bfhi(o.x) + r[1] * (1.f / 255.f));
            w.y = pkh(bflo(o.y) + r[2] * (1.f / 255.f), bfhi(o.y) + r[3] * (1.f / 255.f));
            w.z = pkh(bflo(o.z) + r[4] * (1.f / 255.f), bfhi(o.z) + r[5] * (1.f / 255.f));
            w.w = pkh(bflo(o.w) + r[6] * (1.f / 255.f), bfhi(o.w) + r[7] * (1.f / 255.f));
          }
          *(u32x4*)mp = w;
        }
      }
  }
};
struct EpiOut {
  static constexpr bool PERM = false;
  typedef f32x4 acc_t;
  const float *xsrc, *csrc; float *xdst, *cdst; const float* modl;
  __device__ __forceinline__ void operator()(AccRef acc, const Unit& u, int wr, int wc, int fr, int fq) const {
    const bool isctx = (u.pm >= 128);
    const int bi = isctx ? 8 : (u.pm >> 4);
    const float* gatev = modl + ((size_t)bi * 6 + 2) * 1024;
    const float* src = isctx ? (csrc - (size_t)NLAT * 1024) : xsrc;
    float* dst = isctx ? (cdst - (size_t)NLAT * 1024) : xdst;
    const int row0 = u.pm * BM + wr * 64 + fr, col0 = u.pn * BM + wc * 32 + 4 * fq;
#pragma unroll
    for (int bj = 0; bj < 2; ++bj)
#pragma unroll
      for (int n = 0; n < 2; ++n) {
        const int col = col0 + bj * HALF + n * 16;
        const f32x4 gv = *(const f32x4*)(gatev + col);
#pragma unroll
        for (int ai = 0; ai < 2; ++ai)
#pragma unroll
          for (int m = 0; m < 4; ++m) {
            const size_t o = (size_t)(row0 + ai * HALF + m * 16) * 1024 + col;
            const f32x4 xv = *(const f32x4*)(src + o);
            *(f32x4*)(dst + o) = xv + gv * acc[ai][bj][m][n];
          }
      }
  }
};
struct EpiQ {
  static constexpr bool PERM = true;
  typedef f32x4 acc_t;
  u16* q;
  __device__ __forceinline__ void operator()(AccRef acc, const Unit& u, int wr, int wc, int fr, int fq) const {
    const int row0 = u.pm * BM + wr * 64 + fr;
    const int col0 = u.pn * BM + wc * 32 + 8 * fq;
#pragma unroll
    for (int ai = 0; ai < 2; ++ai)
#pragma unroll
      for (int m = 0; m < 4; ++m) {
        u16* rowp = q + (size_t)(row0 + ai * HALF + m * 16) * 2048 + col0;
#pragma unroll
        for (int bj = 0; bj < 2; ++bj) {
          const f32x4 v0 = acc[ai][bj][m][0], v1 = acc[ai][bj][m][1];
          u32x4 w;
          w.x = __builtin_bit_cast(unsigned, __builtin_amdgcn_cvt_pkrtz(v0[0], v0[1]));
          w.y = __builtin_bit_cast(unsigned, __builtin_amdgcn_cvt_pkrtz(v0[2], v0[3]));
          w.z = __builtin_bit_cast(unsigned, __builtin_amdgcn_cvt_pkrtz(v1[0], v1[1]));
          w.w = __builtin_bit_cast(unsigned, __builtin_amdgcn_cvt_pkrtz(v1[2], v1[3]));
          *(u32x4*)(rowp + bj * HALF) = w;
        }
      }
  }
};
struct EpiInprojN8 {
  static constexpr bool PERM = true;
  typedef i32x4 acc_t;
  u16* qk; u16* rg; const float* sa; const float* sw;
  __device__ __forceinline__ void operator()(AccRefI acc, const Unit& u, int wr, int wc, int fr, int fq) const {
    const int row0 = u.pm * BM + wr * 64 + fr;
    u16* base; int ld, colt;
    if (u.pn < 4) { base = qk; ld = 1024; colt = u.pn * 256; } else { base = rg; ld = 512; colt = (u.pn - 9) * 256; }
    const int col0 = colt + wc * 32 + 8 * fq;
    const int wcol0 = u.pn * 256 + wc * 32 + 8 * fq;
#pragma unroll
    for (int bj = 0; bj < 2; ++bj) {
      const f32x4 c0 = *(const f32x4*)(sw + wcol0 + bj * HALF), c1 = *(const f32x4*)(sw + wcol0 + bj * HALF + 4);
#pragma unroll
      for (int ai = 0; ai < 2; ++ai)
#pragma unroll
        for (int m = 0; m < 4; ++m) {
          const int row = row0 + ai * HALF + m * 16;
          const float rs = sa[row];
          const i32x4 a0 = acc[ai][bj][m][0], a1 = acc[ai][bj][m][1];
          u32x4 w;
          w.x = pkh((float)a0[0] * rs * c0[0], (float)a0[1] * rs * c0[1]); w.y = pkh((float)a0[2] * rs * c0[2], (float)a0[3] * rs * c0[3]);
          w.z = pkh((float)a1[0] * rs * c1[0], (float)a1[1] * rs * c1[1]); w.w = pkh((float)a1[2] * rs * c1[2], (float)a1[3] * rs * c1[3]);
          *(u32x4*)(base + (size_t)row * ld + col0 + bj * HALF) = w;
        }
    }
  }
};
struct EpiInprojT8 {
  static constexpr bool PERM = true;
  typedef i32x4 acc_t;
  u16* vT; const float* sa; const float* sw;
  __device__ __forceinline__ void operator()(AccRefI acc, const Unit& u, int wr, int wc, int fr, int fq) const {
    const bool isctx = (u.pn >= 128);
    const int b = isctx ? (u.pn - 128) : (u.pn >> 4);
    const int Lseg = isctx ? 256 : 4096, t0 = isctx ? 0 : (u.pn & 15) * 256;
    const bool isv = (u.pm < 2);
    const size_t boff = isv ? (isctx ? (size_t)16777216 : (size_t)0) : (isctx ? (size_t)(16777216 + 1048576 + 25165824) : (size_t)(16777216 + 1048576));
    u16* base = vT + boff;
    const int nc = isv ? 512 : 768;
    const int wrow0 = (isv ? u.pm : u.pm - 2) * BM + wr * 64 + fr;
    const int srow0 = u.pm * BM + wr * 64 + fr;
    const int col0 = t0 + wc * 32 + 8 * fq;
    const int tok0 = u.pn * BM + wc * 32 + 8 * fq;
#pragma unroll
    for (int bj = 0; bj < 2; ++bj) {
      const f32x4 c0 = *(const f32x4*)(sa + tok0 + bj * HALF), c1 = *(const f32x4*)(sa + tok0 + bj * HALF + 4);
#pragma unroll
      for (int ai = 0; ai < 2; ++ai)
#pragma unroll
        for (int m = 0; m < 4; ++m) {
          const float rs = sw[srow0 + ai * HALF + m * 16];
          const i32x4 a0 = acc[ai][bj][m][0], a1 = acc[ai][bj][m][1];
          u32x4 w;
          w.x = pkh((float)a0[0] * rs * c0[0], (float)a0[1] * rs * c0[1]); w.y = pkh((float)a0[2] * rs * c0[2], (float)a0[3] * rs * c0[3]);
          w.z = pkh((float)a1[0] * rs * c1[0], (float)a1[1] * rs * c1[1]); w.w = pkh((float)a1[2] * rs * c1[2], (float)a1[3] * rs * c1[3]);
          *(u32x4*)(base + ((size_t)(b * nc + wrow0 + ai * HALF + m * 16)) * Lseg + col0 + bj * HALF) = w;
        }
    }
  }
};
struct EpiGate8 {
  static constexpr bool PERM = true;
  typedef i32x4 acc_t;
  unsigned char* g8; const float* bias; const float* sa; const float* sw;
  __device__ __forceinline__ void operator()(AccRefI acc, const Unit& u, int wr, int wc, int fr, int fq) const {
    const int row0 = u.pm * BM + wr * 64 + fr;
    const int col0 = u.pn * BM + wc * 32 + 8 * fq;
#pragma unroll
    for (int bj = 0; bj < 2; ++bj) {
      const f32x4 b0 = *(const f32x4*)(bias + col0 + bj * HALF), b1 = *(const f32x4*)(bias + col0 + bj * HALF + 4);
      const f32x4 c0 = *(const f32x4*)(sw + col0 + bj * HALF), c1 = *(const f32x4*)(sw + col0 + bj * HALF + 4);
#pragma unroll
      for (int ai = 0; ai < 2; ++ai)
#pragma unroll
        for (int m = 0; m < 4; ++m) {
          const int row = row0 + ai * HALF + m * 16;
          const float rs = sa[row];
          const i32x4 a0 = acc[ai][bj][m][0], a1 = acc[ai][bj][m][1];
          unsigned w0 = 0, w1 = 0;
#pragma unroll
          for (int k = 0; k < 4; ++k) {
            w0 |= (unsigned)(sigmoidf_((float)a0[k] * rs * c0[k] + b0[k]) * 255.0f + 0.5f) << (8 * k);
            w1 |= (unsigned)(sigmoidf_((float)a1[k] * rs * c1[k] + b1[k]) * 255.0f + 0.5f) << (8 * k);
          }
          *(uint2*)(g8 + (size_t)row * 3072 + col0 + bj * HALF) = make_uint2(w0, w1);
        }
    }
  }
};
}

__device__ __forceinline__ void tr_tile(const float* __restrict__ src, int N, int K, u16* __restrict__ dst, int tile, char* smem) {
  float* lds = (float*)smem;
  const int tiles_n = N >> 6;
  const int tk = tile / tiles_n, tn = tile - tk * tiles_n;
  const int tid = opaque_tid();
  {
    const int r = tid >> 3, c8 = (tid & 7) * 8;
    const float* s = src + (size_t)(tk * 64 + r) * N + tn * 64 + c8;
    float4 a = *(const float4*)s, b = *(const float4*)(s + 4);
    float* d = lds + r * 65 + c8;
    d[0] = a.x; d[1] = a.y; d[2] = a.z; d[3] = a.w; d[4] = b.x; d[5] = b.y; d[6] = b.z; d[7] = b.w;
  }
  __syncthreads();
  {
    const int n = tid >> 3, k0 = (tid & 7) * 8;
    uint4 o;
    o.x = pk2(lds[(k0 + 0) * 65 + n], lds[(k0 + 1) * 65 + n]);
    o.y = pk2(lds[(k0 + 2) * 65 + n], lds[(k0 + 3) * 65 + n]);
    o.z = pk2(lds[(k0 + 4) * 65 + n], lds[(k0 + 5) * 65 + n]);
    o.w = pk2(lds[(k0 + 6) * 65 + n], lds[(k0 + 7) * 65 + n]);
    *(uint4*)(dst + (size_t)(tn * 64 + n) * K + tk * 64 + k0) = o;
  }
  __syncthreads();
}
__device__ __forceinline__ void colmax_task(const float* __restrict__ w, int N, int n0, float* __restrict__ swp, char* smem) {
  const int tid = opaque_tid();
  const int col = tid & 63, kg = tid >> 6;
  float m = 0.f;
  const float* wp = w + (size_t)(kg * 128) * N + n0 + col;
#pragma unroll 16
  for (int k = 0; k < 128; ++k) m = fmaxf(m, fabsf(wp[(size_t)k * N]));
  float* red = (float*)smem;
  red[kg * 64 + col] = m;
  __syncthreads();
  if (tid < 64) {
    float mm = red[tid];
#pragma unroll
    for (int g = 1; g < 8; ++g) mm = fmaxf(mm, red[g * 64 + tid]);
    swp[n0 + tid] = fmaxf(mm, 1e-20f) * (1.0f / 127.0f);
  }
  __syncthreads();
}
__device__ __forceinline__ void tr_tile_i8(const float* __restrict__ src, int N, int K, unsigned char* __restrict__ dst, int tile, const float* __restrict__ swp, char* smem) {
  float* lds = (float*)smem;
  const int tiles_n = N >> 6;
  const int tk = tile / tiles_n, tn = tile - tk * tiles_n;
  const int tid = opaque_tid();
  {
    const int r = tid >> 3, c8 = (tid & 7) * 8;
    const float* sp = src + (size_t)(tk * 64 + r) * N + tn * 64 + c8;
    float4 a = *(const float4*)sp, b = *(const float4*)(sp + 4);
    float* d = lds + r * 65 + c8;
    d[0] = a.x; d[1] = a.y; d[2] = a.z; d[3] = a.w; d[4] = b.x; d[5] = b.y; d[6] = b.z; d[7] = b.w;
  }
  __syncthreads();
  {
    const int n = tid >> 3, k0 = (tid & 7) * 8;
    const float inv = 1.0f / swp[tn * 64 + n];
    unsigned w0 = 0, w1 = 0;
#pragma unroll
    for (int i = 0; i < 4; ++i) {
      w0 |= ((unsigned)__float2int_rn(lds[(k0 + i) * 65 + n] * inv) & 255u) << (8 * i);
      w1 |= ((unsigned)__float2int_rn(lds[(k0 + 4 + i) * 65 + n] * inv) & 255u) << (8 * i);
    }
    *(uint2*)(dst + (size_t)(tn * 64 + n) * K + tk * 64 + k0) = make_uint2(w0, w1);
  }
  __syncthreads();
}
__device__ __forceinline__ void cvt_chunk(const float* __restrict__ src, u16* __restrict__ dst, size_t chunk) {
  const size_t i = chunk * 4096 + (size_t)opaque_tid() * 8;
  float4 a = *(const float4*)(src + i), b = *(const float4*)(src + i + 4);
  uint4 o;
  o.x = pk2(a.x, a.y); o.y = pk2(a.z, a.w); o.z = pk2(b.x, b.y); o.w = pk2(b.z, b.w);
  *(uint4*)(dst + i) = o;
}
__device__ __forceinline__ void cvt_chunk_fp8(const float* __restrict__ src, unsigned char* __restrict__ dst, size_t chunk, float scale) {
  const size_t i = chunk * 4096 + (size_t)opaque_tid() * 8;
  const float4 a = *(const float4*)(src + i), b = *(const float4*)(src + i + 4);
  int w0 = __builtin_amdgcn_cvt_pk_fp8_f32(a.x * scale, a.y * scale, 0, false);
  w0 = __builtin_amdgcn_cvt_pk_fp8_f32(a.z * scale, a.w * scale, w0, true);
  int w1 = __builtin_amdgcn_cvt_pk_fp8_f32(b.x * scale, b.y * scale, 0, false);
  w1 = __builtin_amdgcn_cvt_pk_fp8_f32(b.z * scale, b.w * scale, w1, true);
  *(uint2*)(dst + i) = make_uint2((unsigned)w0, (unsigned)w1);
}
__device__ __forceinline__ void cvt_chunk_fp4(const float* __restrict__ src, unsigned char* __restrict__ dst, size_t chunk, float scale, int vhalf) {
  const size_t i = chunk * 4096 + (size_t)opaque_tid() * 8;
  const float4 a = *(const float4*)(src + i), b = *(const float4*)(src + i + 4);
  unsigned w = 0;
  w = __builtin_amdgcn_cvt_scalef32_pk_fp4_f32(w, a.x * scale, a.y * scale, 1.0f, 0);
  w = __builtin_amdgcn_cvt_scalef32_pk_fp4_f32(w, a.z * scale, a.w * scale, 1.0f, 1);
  w = __builtin_amdgcn_cvt_scalef32_pk_fp4_f32(w, b.x * scale, b.y * scale, 1.0f, 2);
  w = __builtin_amdgcn_cvt_scalef32_pk_fp4_f32(w, b.z * scale, b.w * scale, 1.0f, 3);
  const size_t e = i >> 10;
  const unsigned d = (unsigned)(i & 1023);
  *(unsigned*)(dst + e * 1024 + vhalf * 512 + (d >> 1)) = w;
}
__device__ __forceinline__ void phase_prep(const P& p, char* smem) {
  const int tid = opaque_tid();
  const int NTR = 2512;
  const int total = 2 * NTR + 128 + 384;
  for (int task = blockIdx.x; task < total; task += gridDim.x) {
    if (task < 2 * NTR) {
      const int l = task / NTR;
      int t = task - l * NTR;
      if (t < 704) { if (t < 44) colmax_task(p.w_in + (size_t)l * 1024 * 2816, 2816, t * 64, p.sw + l * 5888, smem); }
      else if ((t -= 704) < 768) { if (t < 48) colmax_task(p.w_gate + (size_t)l * 1024 * 3072, 3072, t * 64, p.sw + l * 5888 + 2816, smem); }
      else if ((t -= 768) < 128) tr_tile(p.w_br_a + (size_t)l * 512 * 1024, 1024, 512, p.WaT + (size_t)l * 1024 * 512, t, smem);
      else if ((t -= 128) < 64) tr_tile(p.w_br_b + (size_t)l * 256 * 1024, 1024, 256, p.WbT + (size_t)l * 1024 * 256, t, smem);
      else if ((t -= 64) < 64) tr_tile(p.w_br_c + (size_t)l * 256 * 1024, 1024, 256, p.WcT + (size_t)l * 1024 * 256, t, smem);
      else if ((t -= 64) < 256) tr_tile(p.w_out + (size_t)l * 1024 * 1024, 1024, 1024, p.WoT + (size_t)l * 1024 * 1024, t, smem);
      else if ((t -= 256) < 512) cvt_chunk(p.peer_wq + (size_t)l * 1024 * 2048, p.WqB + (size_t)l * 1024 * 2048, (size_t)t);
      else {
        t -= 512;
        const int gate = t >> 3, dn = t & 7;
        const float* src = (gate ? p.rg_wx : p.rg_wa) + (size_t)(l * 8 + dn) * 4096;
        tr_tile(src, 64, 64, p.rgW + (size_t)((l * 2 + gate) * 8 + dn) * 4096, 0, smem);
      }
    } else if (task < 2 * NTR + 128) {
      cvt_chunk(p.peer_keys, p.keysB, (size_t)(task - 2 * NTR));
    } else {
      int t = task - 2 * NTR - 128;
      const int kc = t & 15; t >>= 4;
      const int jc = t % 12, l = t / 12;
      float* s = (float*)smem;
      for (int i = tid; i < 576; i += NTHR) {
        const int bi = i >> 6, kk = i & 63;
        const float v = (bi < 8) ? p.c[bi * 1024 + kc * 64 + kk] : p.c_ctx[kc * 64 + kk];
        s[i] = v / (1.0f + __expf(-v));
      }
      __syncthreads();
      const int j = jc * 512 + tid;
      float acc[9];
#pragma unroll
      for (int bi = 0; bi < 9; ++bi) acc[bi] = 0.f;
      const float* wp = p.w_ada + ((size_t)l * 1024 + kc * 64) * 6144 + j;
#pragma unroll 8
      for (int kk = 0; kk < 64; ++kk) {
        const float w = wp[(size_t)kk * 6144];
#pragma unroll
        for (int bi = 0; bi < 9; ++bi) acc[bi] += s[bi * 64 + kk] * w;
      }
#pragma unroll
      for (int bi = 0; bi < 9; ++bi) p.modpart[((size_t)(kc * 2 + l) * 9 + bi) * 6144 + j] = acc[bi];
      __syncthreads();
    }
  }
}
__device__ __forceinline__ void phase_modreduce(const P& p) {
  const int n = 2 * 9 * 6144;
  for (int i = blockIdx.x * NTHR + opaque_tid(); i < n; i += gridDim.x * NTHR) {
    const int l = i / (9 * 6144);
    const int j = i % 6144;
    float s = p.b_ada[l * 6144 + j];
#pragma unroll
    for (int kc = 0; kc < 16; ++kc) s += p.modpart[(size_t)kc * n + i];
    p.mod[i] = s;
  }
}

__device__ __forceinline__ void phase_norm(const P& p, int l, int which) {
  const int tid_ = opaque_tid(); const int lane = tid_ & 63, wid = tid_ >> 6;
  const int ntok = (which == 2 || (which == 1 && l == 1)) ? NLAT : NTOK;
  for (int row = blockIdx.x * 8 + wid; row < ntok; row += gridDim.x * 8) {
    const float* src;
    if (row < NLAT) src = ((which == 0 && l == 0) ? p.x : p.out) + (size_t)row * 1024;
    else src = ((which == 0 && l == 0) ? p.ctx : p.ctxs) + (size_t)(row - NLAT) * 1024;
    float4 v[4];
    float ss = 0.f;
#pragma unroll
    for (int i = 0; i < 4; ++i) {
      v[i] = *(const float4*)(src + i * 256 + lane * 4);
      ss += v[i].x * v[i].x + v[i].y * v[i].y + v[i].z * v[i].z + v[i].w * v[i].w;
    }
    ss = wave_sum(ss);
    const float rstd = rsqrtf(ss * (1.0f / 1024.0f) + 1e-6f);
    if (which == 2) {
#pragma unroll
      for (int i = 0; i < 4; ++i) {
        const int col = i * 256 + lane * 4;
        const float4 g = *(const float4*)(p.final_g + col);
        float4 o = {v[i].x * rstd * g.x, v[i].y * rstd * g.y, v[i].z * rstd * g.z, v[i].w * rstd * g.w};
        *(float4*)(p.out + (size_t)row * 1024 + col) = o;
      }
    } else {
      const int bi = row < NLAT ? (row >> 12) : 8;
      const float* gam = (which == 0 ? p.norm_mix_g : p.norm_ffn_g) + l * 1024;
      const float* msh = p.mod + ((size_t)(l * 9 + bi) * 6 + (which == 0 ? 0 : 3)) * 1024;
      const float* msc = msh + 1024;
      float4 y[4];
      float amax = 0.f;
#pragma unroll
      for (int i = 0; i < 4; ++i) {
        const int col = i * 256 + lane * 4;
        const float4 g = *(const float4*)(gam + col);
        const float4 sh = *(const float4*)(msh + col);
        const float4 sc = *(const float4*)(msc + col);
        y[i].x = v[i].x * rstd * g.x * (1.f + sc.x) + sh.x; y[i].y = v[i].y * rstd * g.y * (1.f + sc.y) + sh.y;
        y[i].z = v[i].z * rstd * g.z * (1.f + sc.z) + sh.z; y[i].w = v[i].w * rstd * g.w * (1.f + sc.w) + sh.w;
        amax = fmaxf(amax, fmaxf(fmaxf(fabsf(y[i].x), fabsf(y[i].y)), fmaxf(fabsf(y[i].z), fabsf(y[i].w))));
      }
      if (which == 0) {
        amax = fmaxf(wave_max(amax), 1e-20f);
        const float inv = 127.0f / amax;
#pragma unroll
        for (int i = 0; i < 4; ++i) {
          const unsigned w = ((unsigned)__float2int_rn(y[i].x * inv) & 255u) | (((unsigned)__float2int_rn(y[i].y * inv) & 255u) << 8) |
                             (((unsigned)__float2int_rn(y[i].z * inv) & 255u) << 16) | (((unsigned)__float2int_rn(y[i].w * inv) & 255u) << 24);
          *(unsigned*)(p.xn8 + (size_t)row * 1024 + i * 256 + lane * 4) = w;
        }
        if (lane == 0) p.sa[row] = amax * (1.0f / 127.0f);
      } else {
#pragma unroll
        for (int i = 0; i < 4; ++i) {
          uint2 o;
          o.x = pk2(y[i].x, y[i].y);
          o.y = pk2(y[i].z, y[i].w);
          *(uint2*)(p.xn + (size_t)row * 1024 + i * 256 + lane * 4) = o;
        }
      }
    }
  }
}

__device__ __forceinline__ void filter_wave(const P& p, int l, int L, int t, float* __restrict__ outp) {
  const int lane = opaque_tid() & 63;
  const float tl = (float)t / (float)(L - 1);
  const float wang = (6.283185307179586f / (float)L) * (float)t;
  float z = 0.f;
  if (lane == 0) z = tl;
  else if (lane <= 16) { const float band = 1e-4f + (float)(lane - 1) * ((15.0f - 1e-4f) / 15.0f); z = cosf(band * wang); }
  else if (lane <= 32) { const float band = 1e-4f + (float)(lane - 17) * ((15.0f - 1e-4f) / 15.0f); z = -sinf(band * wang); }
  float a1 = p.hy_f1_b[l * 64 + lane];
  for (int i = 0; i < 33; ++i) a1 += shf(z, i) * p.hy_f1_w[(l * 33 + i) * 64 + lane];
  const float h1 = sinf(p.hy_freq[l * 128 + lane] * a1);
  float a2 = p.hy_f2_b[l * 64 + lane];
  for (int i = 0; i < 64; ++i) a2 += shf(h1, i) * p.hy_f2_w[(l * 64 + i) * 64 + lane];
  const float h2 = sinf(p.hy_freq[l * 128 + 64 + lane] * a2);
  float a3[8];
#pragma unroll
  for (int m = 0; m < 8; ++m) a3[m] = 0.f;
  for (int i = 0; i < 64; ++i) {
    const float hv = shf(h2, i);
    const float* wr = p.hy_f3_w + (size_t)(l * 64 + i) * 512 + lane;
#pragma unroll
    for (int m = 0; m < 8; ++m) a3[m] += hv * wr[m * 64];
  }
  const float LN100 = 4.605170185988092f;
  const float d0 = LN100 / 1.5f, d1 = LN100 / 0.3f;
#pragma unroll
  for (int m = 0; m < 8; ++m) {
    const int cp = lane + 64 * m;
    const int ch = cp & 255;
    const float delta = d0 + (float)ch * ((d1 - d0) / 255.0f);
    outp[(size_t)cp * L + t] = a3[m] * expf(-tl * delta);
  }
}
__device__ __forceinline__ void filter_block_task(const P& p, int l, int L, int t0, float* __restrict__ outp, char* smem) {
  const int tid = opaque_tid(), lane = tid & 63, wid = tid >> 6;
  float* W3s = (float*)smem;
  float* W2s = (float*)(smem + 131072);
  {
    const float4* s3 = (const float4*)(p.hy_f3_w + (size_t)l * 64 * 512);
    const float4* s2 = (const float4*)(p.hy_f2_w + (size_t)l * 64 * 64);
#pragma unroll
    for (int i = 0; i < 16; ++i) ((float4*)W3s)[tid + NTHR * i] = s3[tid + NTHR * i];
#pragma unroll
    for (int i = 0; i < 2; ++i) ((float4*)W2s)[tid + NTHR * i] = s2[tid + NTHR * i];
  }
  __syncthreads();
  float z[4], tl[4];
#pragma unroll
  for (int j = 0; j < 4; ++j) {
    const int t = t0 + wid * 4 + j;
    tl[j] = (float)t / (float)(L - 1);
    const float wang = (6.283185307179586f / (float)L) * (float)t;
    float zz = 0.f;
    if (lane == 0) zz = tl[j];
    else if (lane <= 16) { const float band = 1e-4f + (float)(lane - 1) * ((15.0f - 1e-4f) / 15.0f); zz = cosf(band * wang); }
    else if (lane <= 32) { const float band = 1e-4f + (float)(lane - 17) * ((15.0f - 1e-4f) / 15.0f); zz = -sinf(band * wang); }
    z[j] = zz;
  }
  float a1[4], a2[4];
  {
    const float b1 = p.hy_f1_b[l * 64 + lane];
#pragma unroll
    for (int j = 0; j < 4; ++j) a1[j] = b1;
#pragma unroll 11
    for (int i = 0; i < 33; ++i) {
      const float w = p.hy_f1_w[(l * 33 + i) * 64 + lane];
#pragma unroll
      for (int j = 0; j < 4; ++j) a1[j] += shf(z[j], i) * w;
    }
    const float f0 = p.hy_freq[l * 128 + lane];
#pragma unroll
    for (int j = 0; j < 4; ++j) a1[j] = sinf(f0 * a1[j]);
  }
  {
    const float b2 = p.hy_f2_b[l * 64 + lane];
#pragma unroll
    for (int j = 0; j < 4; ++j) a2[j] = b2;
#pragma unroll 8
    for (int i = 0; i < 64; ++i) {
      const float w = W2s[i * 64 + lane];
#pragma unroll
      for (int j = 0; j < 4; ++j) a2[j] += shf(a1[j], i) * w;
    }
    const float f1 = p.hy_freq[l * 128 + 64 + lane];
#pragma unroll
    for (int j = 0; j < 4; ++j) a2[j] = sinf(f1 * a2[j]);
  }
  float a3[4][8];
#pragma unroll
  for (int j = 0; j < 4; ++j)
#pragma unroll
    for (int m = 0; m < 8; ++m) a3[j][m] = 0.f;
#pragma unroll 4
  for (int i = 0; i < 64; ++i) {
    float w[8];
#pragma unroll
    for (int m = 0; m < 8; ++m) w[m] = W3s[i * 512 + lane + 64 * m];
#pragma unroll
    for (int j = 0; j < 4; ++j) {
      const float hv = shf(a2[j], i);
#pragma unroll
      for (int m = 0; m < 8; ++m) a3[j][m] += hv * w[m];
    }
  }
  const float LN100 = 4.605170185988092f;
  const float d0 = LN100 / 1.5f, d1 = LN100 / 0.3f;
#pragma unroll
  for (int m = 0; m < 8; ++m) {
    const int cp = lane + 64 * m;
    const float delta = d0 + (float)(cp & 255) * ((d1 - d0) / 255.0f);
    float4 o;
    o.x = a3[0][m] * expf(-tl[0] * delta); o.y = a3[1][m] * expf(-tl[1] * delta);
    o.z = a3[2][m] * expf(-tl[2] * delta); o.w = a3[3][m] * expf(-tl[3] * delta);
    *(float4*)(outp + (size_t)cp * L + t0 + wid * 4) = o;
  }
  __syncthreads();
}
__device__ __forceinline__ void phase_filters(const P& p, int l, char* smem) {
  const int ntask = 128 + (l == 0 ? 8 : 0);
  for (int t = blockIdx.x; t < ntask; t += gridDim.x) {
    if (t < 128) filter_block_task(p, l, 4096, t * 32, p.hT + (size_t)l * 512 * 4096, smem);
    else filter_block_task(p, l, 256, (t - 128) * 32, p.hc, smem);
  }
}
__device__ __forceinline__ void kf_task(const P& p, int l, int c, char* smem) {
  const float* hTl = p.hT + (size_t)l * 512 * 4096;
  c2* buf = (c2*)smem;
  const int tid = opaque_tid();
  for (int i = 0; i < 16; ++i) {
    const int j = tid + NTHR * i;
    float v;
    if (j < 4096) v = hTl[(size_t)c * 4096 + j];
    else if (j == 4096) v = 0.f;
    else v = hTl[(size_t)(256 + c) * 4096 + (8192 - j)];
    buf[j] = {v, 0.f};
  }
  __syncthreads();
  fft8192(buf, -1.f);
  c2* o = (c2*)p.Kf + ((size_t)l * 256 + c) * 8192;
  for (int i = 0; i < 16; ++i) { const int j = tid + NTHR * i; o[j] = buf[j]; }
  __syncthreads();
}

__device__ __forceinline__ void inproj_tile(const P& p, int l, int mt, int nt, char* smem) {
  f32x16 acc[2][2];
  zero_acc(acc);
  const int m0 = mt * 256, n0 = nt * 128;
  gemm_kloop(acc, p.xn + (size_t)m0 * 1024, 1024, p.WinT + ((size_t)l * 2816 + n0) * 1024, 1024, 1024, smem);
  EPI_VARS
  if (nt < 8 || nt >= 18) {
    u16* dst; int ld, cbase;
    if (nt < 8) { dst = p.qk; ld = 1024; cbase = n0; }
    else { dst = p.rg; ld = 512; cbase = n0 - 2304; }
#pragma unroll
    for (int i = 0; i < 2; ++i)
#pragma unroll
      for (int j = 0; j < 2; ++j)
#pragma unroll
        for (int e = 0; e < 16; ++e)
          dst[(size_t)(m0 + EPI_ROW(i, e)) * ld + cbase + EPI_COL(j)] = f2bf(acc[i][j][e]);
  } else {
#pragma unroll
    for (int i = 0; i < 2; ++i)
#pragma unroll
      for (int j = 0; j < 2; ++j)
#pragma unroll
        for (int qd = 0; qd < 4; ++qd) {
          uint2 o;
          o.x = pk2(acc[i][j][4 * qd + 0], acc[i][j][4 * qd + 1]);
          o.y = pk2(acc[i][j][4 * qd + 2], acc[i][j][4 * qd + 3]);
          const int row0 = wm * 64 + i * 32 + 8 * qd + 4 * hh;
          *(uint2*)(smem + EPI_COL(j) * 520 + row0 * 2) = o;
        }
    __syncthreads();
    u16* dstT; int Lseg, t0, ncol0, nc;
    const bool isctx = (mt >= 128);
    const int b = isctx ? (mt - 128) : (mt >> 4);
    if (nt < 12) { ncol0 = n0 - 1024; nc = 512; dstT = isctx ? p.vTc : p.vT; }
    else { ncol0 = n0 - 1536; nc = 768; dstT = isctx ? p.hyTc : p.hyT; }
    if (isctx) { Lseg = 256; t0 = 0; } else { Lseg = 4096; t0 = (mt & 15) * 256; }
#pragma unroll 4
    for (int it = 0; it < 16; ++it) {
      const int idx = tid + NTHR * it;
      const int col = idx >> 6, u = idx & 63;
      const uint2 v = *(const uint2*)(smem + col * 520 + u * 8);
      *(uint2*)(dstT + ((size_t)(b * nc + ncol0 + col)) * Lseg + t0 + u * 4) = v;
    }
    __syncthreads();
  }
}

__device__ __forceinline__ float ldbf(const u16* p, int t, int L) { return (t >= 0 && t < L) ? bf2f(p[t]) : 0.f; }
__device__ __forceinline__ void ld10(const u16* __restrict__ seq, int t0, float (&v)[10]) {
  const uint4 r = *(const uint4*)(seq + t0);
  v[0] = (t0 > 0) ? bf2f(seq[t0 - 1]) : 0.f;
  v[9] = (t0 + 8 < 4096) ? bf2f(seq[t0 + 8]) : 0.f;
  v[1] = bflo(r.x); v[2] = bfhi(r.x); v[3] = bflo(r.y); v[4] = bfhi(r.y);
  v[5] = bflo(r.z); v[6] = bfhi(r.z); v[7] = bflo(r.w); v[8] = bfhi(r.w);
}
__device__ __forceinline__ void hyena_fft_task(const P& p, int l, int c, int bp, char* smem) {
  c2* buf = (c2*)smem;
  c2* ub = (c2*)(smem + 65536);
  const int tid = opaque_tid();
  const float* sw = p.hy_short_w + l * 3 * 768;
  const float* sb = p.hy_short_b + l * 768;
  const float wx0[3] = {sw[c], sw[768 + c], sw[1536 + c]};
  const float wx1[3] = {sw[256 + c], sw[768 + 256 + c], sw[1536 + 256 + c]};
  const float wv[3] = {sw[512 + c], sw[768 + 512 + c], sw[1536 + 512 + c]};
  const float bx0 = sb[c], bx1 = sb[256 + c], bv = sb[512 + c];
  const float dsk = p.hy_bias[l * 256 + c];
  const int t0 = tid * 8;
  {
    float u[2][8];
#pragma unroll
    for (int bb = 0; bb < 2; ++bb) {
      const int b = 2 * bp + bb;
      float x1[10], vv[10];
      ld10(p.hyT + ((size_t)(b * 768 + 256 + c)) * 4096, t0, x1);
      ld10(p.hyT + ((size_t)(b * 768 + 512 + c)) * 4096, t0, vv);
#pragma unroll
      for (int k = 0; k < 8; ++k) {
        const float x1c = bx1 + wx1[0] * x1[k] + wx1[1] * x1[k + 1] + wx1[2] * x1[k + 2];
        const float vc = bv + wv[0] * vv[k] + wv[1] * vv[k + 1] + wv[2] * vv[k + 2];
        u[bb][k] = vc * x1c;
      }
    }
#pragma unroll
    for (int k = 0; k < 8; k += 2) {
      const float4 w = make_float4(u[0][k], u[1][k], u[0][k + 1], u[1][k + 1]);
      *(float4*)(buf + t0 + k) = w;
      *(float4*)(ub + t0 + k) = w;
      *(float4*)(buf + 4096 + t0 + k) = make_float4(0.f, 0.f, 0.f, 0.f);
    }
  }
  __syncthreads();
  fft8192(buf, -1.f);
  const c2* kf = (const c2*)p.Kf + ((size_t)l * 256 + c) * 8192;
  for (int i = 0; i < 16; ++i) {
    const int k = tid + NTHR * i;
    buf[k] = cmul(buf[k], kf[k]);
  }
  __syncthreads();
  fft8192(buf, 1.f);
#pragma unroll
  for (int bb = 0; bb < 2; ++bb) {
    const int b = 2 * bp + bb;
    float x0[10];
    ld10(p.hyT + ((size_t)(b * 768 + c)) * 4096, t0, x0);
    float o[8];
#pragma unroll
    for (int k = 0; k < 8; ++k) {
      const c2 y = buf[t0 + k];
      const c2 uu = ub[t0 + k];
      const float x0c = bx0 + wx0[0] * x0[k] + wx0[1] * x0[k + 1] + wx0[2] * x0[k + 2];
      const float yy = ldexpf(bb ? y.y : y.x, -13);
      const float uv = bb ? uu.y : uu.x;
      o[k] = x0c * (yy + uv * dsk);
    }
    uint4 w; w.x = pk2(o[0], o[1]); w.y = pk2(o[2], o[3]); w.z = pk2(o[4], o[5]); w.w = pk2(o[6], o[7]);
    *(uint4*)(p.ybT + ((size_t)(b * 256 + c)) * 4096 + t0) = w;
  }
  __syncthreads();
}
__device__ __forceinline__ void yb_transpose_task(const P& p, int b, int tb, char* smem) {
  const int tid = opaque_tid(), lane = tid & 63, wid = tid >> 6;
  u16* T = (u16*)smem;
#pragma unroll
  for (int it = 0; it < 4; ++it) {
    const int id = tid + NTHR * it;
    const int c = id >> 3, ch = id & 7;
    const uint4 r = *(const uint4*)(p.ybT + ((size_t)(b * 256 + c)) * 4096 + tb * 64 + ch * 8);
    unsigned* d = (unsigned*)(T + c * 66 + ch * 8);
    d[0] = r.x; d[1] = r.y; d[2] = r.z; d[3] = r.w;
  }
  __syncthreads();
#pragma unroll
  for (int it = 0; it < 8; ++it) {
    const int tt = wid + 8 * it;
    const int c0 = lane * 4;
    uint2 w;
    w.x = (unsigned)T[(c0 + 0) * 66 + tt] | ((unsigned)T[(c0 + 1) * 66 + tt] << 16);
    w.y = (unsigned)T[(c0 + 2) * 66 + tt] | ((unsigned)T[(c0 + 3) * 66 + tt] << 16);
    *(uint2*)(p.ycat + (size_t)(b * 4096 + tb * 64 + tt) * 1024 + 512 + c0) = w;
  }
  __syncthreads();
}
__device__ __forceinline__ void hyena_ctx_task(const P& p, int l, int b, int cg8, char* smem) {
  const int tid_ = opaque_tid(); const int lane = tid_ & 63, wid = tid_ >> 6;
  const int c = cg8 * 8 + wid;
  float* us = (float*)smem + wid * 1024;
  float* kfp = us + 256 + 255;
  const float* sw = p.hy_short_w + l * 3 * 768;
  const float* sb = p.hy_short_b + l * 768;
  const u16* x0 = p.hyTc + ((size_t)(b * 768 + c)) * 256;
  const u16* x1 = p.hyTc + ((size_t)(b * 768 + 256 + c)) * 256;
  const u16* vv = p.hyTc + ((size_t)(b * 768 + 512 + c)) * 256;
  for (int i = 0; i < 4; ++i) {
    const int t = lane + 64 * i;
    const float x1c = sb[256 + c] + sw[256 + c] * ldbf(x1, t - 1, 256) + sw[768 + 256 + c] * ldbf(x1, t, 256) + sw[1536 + 256 + c] * ldbf(x1, t + 1, 256);
    const float vc = sb[512 + c] + sw[512 + c] * ldbf(vv, t - 1, 256) + sw[768 + 512 + c] * ldbf(vv, t, 256) + sw[1536 + 512 + c] * ldbf(vv, t + 1, 256);
    us[t] = vc * x1c;
    kfp[t] = p.hc[(size_t)c * 256 + t];
    if (t > 0) kfp[-t] = p.hc[(size_t)(256 + c) * 256 + t];
  }
  __syncthreads();
  const float dsk = p.hy_bias[l * 256 + c];
  float acc[4] = {0.f, 0.f, 0.f, 0.f};
  for (int s = 0; s < 256; ++s) {
    const float uv = us[s];
#pragma unroll
    for (int i = 0; i < 4; ++i) acc[i] += kfp[lane + 64 * i - s] * uv;
  }
#pragma unroll
  for (int i = 0; i < 4; ++i) {
    const int t = lane + 64 * i;
    const float x0c = sb[c] + sw[c] * ldbf(x0, t - 1, 256) + sw[768 + c] * ldbf(x0, t, 256) + sw[1536 + c] * ldbf(x0, t + 1, 256);
    p.ycat[(size_t)(NLAT + b * 256 + t) * 1024 + 512 + c] = f2bf(x0c * (acc[i] + us[t] * dsk));
  }
  __syncthreads();
}

template <int DIR>
__device__ __forceinline__ void rg_scan32(const float (&Av)[2][16], const float (&Bv)[2][16], float (&carry)[2], float (&H)[2][16], int hh) {
#pragma unroll
  for (int nt = 0; nt < 2; ++nt) {
    float c = carry[nt];
#pragma unroll
    for (int go = 0; go < 8; ++go) {
      const int g = DIR ? 7 - go : go, q = g >> 1, own = g & 1;
      float h = c;
#pragma unroll
      for (int io = 0; io < 4; ++io) {
        const int e = 4 * q + (DIR ? 3 - io : io);
        h = Av[nt][e] * h + Bv[nt][e];
        H[nt][e] = (hh == own) ? h : H[nt][e];
      }
      const float mine = (hh == own) ? h : c;
      const float other = shx(mine, 32);
      c = (hh == own) ? mine : other;
    }
    carry[nt] = c;
  }
}
__device__ __forceinline__ void rg_wave_task(const P& p, int l, int bq, int nblk, int mode, bool last, char* smem) {
  const int tid = opaque_tid(), lane = tid & 63, wid = tid >> 6;
  const int l31 = lane & 31, hh = lane >> 5;
  const int b = bq / 34, rr = bq - b * 34;
  const int seg = rr < 2 ? 0 : 1, blk = rr < 2 ? rr : rr - 2;
  if (mode == 1 && seg == 0 && last) return;
  const int ck = wid >> 1, dir = wid & 1;
  char* wreg = smem + wid * 17408;
  u16* xs = (u16*)wreg;
  char* xcb = wreg + 4608;
  float* xcf = (float*)(wreg + 8704);
  float2* blockagg = (float2*)(smem + 139264);
  const int Lseg = seg ? 4096 : 256;
  const int tokbase = seg ? b * 4096 : NLAT + b * 256;
  const int T0 = blk * 128 + ck * 32;
  const int cg32 = (seg ? 8 : 0) + blk * 4 + ck;
  bf16x8 wf[2][2][4];
#pragma unroll
  for (int gate = 0; gate < 2; ++gate) {
    const u16* wp = p.rgW + (size_t)(((l * 2 + gate) * 2 + dir) * 4 + nblk) * 4096 + l31 * 64 + 8 * hh;
#pragma unroll
    for (int nt = 0; nt < 2; ++nt)
#pragma unroll
      for (int s = 0; s < 4; ++s) wf[gate][nt][s] = *(const bf16x8*)(wp + nt * 2048 + 16 * s);
  }
  float cba[2], cbx[2], csp[2];
#pragma unroll
  for (int nt = 0; nt < 2; ++nt) {
    const int ch = (l * 2 + dir) * 256 + nblk * 64 + nt * 32 + l31;
    cba[nt] = p.rg_ba[ch];
    cbx[nt] = p.rg_bx[ch];
    csp[nt] = __logf(1.0f + __expf(-p.rg_lambda[ch]));
  }
#pragma unroll
  for (int i = 0; i < 5; ++i) {
    const int idx = lane + 64 * i;
    const int row = idx >> 3, chunk = idx & 7;
    if (row < 35) {
      const int pos = T0 - 2 + row;
      uint4 v = make_uint4(0u, 0u, 0u, 0u);
      if (pos >= 0 && pos < Lseg) v = *(const uint4*)(p.rg + (size_t)(tokbase + pos) * 512 + nblk * 64 + chunk * 8);
      *(uint4*)(xs + row * 64 + chunk * 8) = v;
    }
  }
  asm volatile("s_waitcnt lgkmcnt(0)" ::: "memory");
  {
    const int ch = l * 256 + nblk * 64 + lane;
    const float w0 = p.rg_conv_w[(l * 4 + 0) * 256 + nblk * 64 + lane], w1 = p.rg_conv_w[(l * 4 + 1) * 256 + nblk * 64 + lane];
    const float w2 = p.rg_conv_w[(l * 4 + 2) * 256 + nblk * 64 + lane], w3 = p.rg_conv_w[(l * 4 + 3) * 256 + nblk * 64 + lane];
    const float cb = p.rg_conv_b[ch];
    float x0 = bf2f(xs[0 * 64 + lane]), x1 = bf2f(xs[1 * 64 + lane]), x2 = bf2f(xs[2 * 64 + lane]);
#pragma unroll
    for (int t = 0; t < 32; ++t) {
      const float x3 = bf2f(xs[(t + 3) * 64 + lane]);
      const float xc = cb + w0 * x0 + w1 * x1 + w2 * x2 + w3 * x3;
      xcf[t * 68 + lane] = xc;
      *(u16*)(xcb + swz128(t, lane >> 3) + (lane & 7) * 2) = f2bf(xc);
      x0 = x1; x1 = x2; x2 = x3;
    }
  }
  asm volatile("s_waitcnt lgkmcnt(0)" ::: "memory");
  float Av[2][16], Bv[2][16];
  {
    f32x16 acc[2][2];
#pragma unroll
    for (int gate = 0; gate < 2; ++gate)
#pragma unroll
      for (int nt = 0; nt < 2; ++nt) acc[gate][nt] = zero16();
#pragma unroll
    for (int s = 0; s < 4; ++s) {
      const bf16x8 af = *(const bf16x8*)(xcb + swz128(l31, 2 * s + hh));
#pragma unroll
      for (int gate = 0; gate < 2; ++gate)
#pragma unroll
        for (int nt = 0; nt < 2; ++nt) acc[gate][nt] = mfma32(af, wf[gate][nt][s], acc[gate][nt]);
    }
#pragma unroll
    for (int nt = 0; nt < 2; ++nt)
#pragma unroll
      for (int e = 0; e < 16; ++e) {
        const int tok = (e & 3) + 8 * (e >> 2) + 4 * hh;
        const float r = sigmoidf_(acc[0][nt][e] + cba[nt]);
        const float ii = sigmoidf_(acc[1][nt][e] + cbx[nt]);
        const float la = -8.0f * r * csp[nt];
        const float av = __expf(la);
        const float e2 = 2.0f * la;
        const float om = (e2 > -0.1f) ? (-e2 * (1.0f + e2 * (0.5f + e2 * (0.16666667f + e2 * 0.041666668f)))) : (1.0f - __expf(e2));
        Av[nt][e] = av;
        Bv[nt][e] = sqrtf(om) * ii * xcf[tok * 68 + nt * 32 + l31];
      }
  }
  float H[2][16];
#pragma unroll
  for (int nt = 0; nt < 2; ++nt)
#pragma unroll
    for (int e = 0; e < 16; ++e) H[nt][e] = 0.f;
  float carry[2] = {0.f, 0.f};
  float2* agg1 = (float2*)p.agg;
  float2* agg2 = (float2*)p.agg + (size_t)8 * 2 * 136 * 256;
  const int pos2 = dir ? (seg == 0 ? 1 - blk : 33 - blk) : (seg == 0 ? blk : 2 + blk);
  if (mode == 0) {
    if (dir) rg_scan32<1>(Av, Bv, carry, H, hh); else rg_scan32<0>(Av, Bv, carry, H, hh);
    float P[2];
#pragma unroll
    for (int nt = 0; nt < 2; ++nt) {
      float pr = 1.f;
#pragma unroll
      for (int e = 0; e < 16; ++e) pr *= Av[nt][e];
      P[nt] = pr * shx(pr, 32);
    }
    const float2 mine = make_float2(hh ? P[1] : P[0], hh ? carry[1] : carry[0]);
    agg1[((size_t)(b * 2 + dir) * 136 + cg32) * 256 + nblk * 64 + lane] = mine;
    blockagg[(ck * 2 + dir) * 64 + lane] = mine;
    __syncthreads();
    if (wid < 2) {
      const int d2 = wid;
      float A = 1.f, B = 0.f;
#pragma unroll
      for (int co = 0; co < 4; ++co) {
        const int c = d2 ? 3 - co : co;
        const float2 g = blockagg[(c * 2 + d2) * 64 + lane];
        B = g.x * B + g.y;
        A *= g.x;
      }
      const int p2 = d2 ? (seg == 0 ? 1 - blk : 33 - blk) : (seg == 0 ? blk : 2 + blk);
      agg2[((size_t)(b * 2 + d2) * 34 + p2) * 256 + nblk * 64 + lane] = make_float2(A, B);
    }
    __syncthreads();
    return;
  }
  {
    float h = 0.f;
    const float2* a2 = agg2 + ((size_t)(b * 2 + dir) * 34) * 256 + nblk * 64 + lane;
    int j = 0;
    for (; j + 8 <= pos2; j += 8) {
      float2 g[8];
#pragma unroll
      for (int u = 0; u < 8; ++u) g[u] = a2[(size_t)(j + u) * 256];
#pragma unroll
      for (int u = 0; u < 8; ++u) h = g[u].x * h + g[u].y;
    }
    for (; j < pos2; ++j) { const float2 g = a2[(size_t)j * 256]; h = g.x * h + g.y; }
    const float2* a1 = agg1 + ((size_t)(b * 2 + dir) * 136 + (cg32 - ck)) * 256 + nblk * 64 + lane;
    const int npre = dir ? 3 - ck : ck;
    for (int i = 0; i < npre; ++i) {
      const int c = dir ? 3 - i : i;
      const float2 g = a1[(size_t)c * 256];
      h = g.x * h + g.y;
    }
    carry[0] = shf(h, l31);
    carry[1] = shf(h, 32 + l31);
  }
  if (dir) rg_scan32<1>(Av, Bv, carry, H, hh); else rg_scan32<0>(Av, Bv, carry, H, hh);
  asm volatile("s_waitcnt lgkmcnt(0)" ::: "memory");
#pragma unroll
  for (int nt = 0; nt < 2; ++nt)
#pragma unroll
    for (int e = 0; e < 16; ++e) xcf[((e & 3) + 8 * (e >> 2) + 4 * hh) * 68 + nt * 32 + l31] = H[nt][e];
  __syncthreads();
  {
    const float* hfT = (const float*)(smem + (ck * 2 + 0) * 17408 + 8704);
    const float* hbT = (const float*)(smem + (ck * 2 + 1) * 17408 + 8704);
    const int tok = 16 * dir + (lane >> 2), c16 = (lane & 3) * 16;
    const size_t gtok = (size_t)tokbase + T0 + tok;
    const u16* gp = p.rg + gtok * 512 + 256 + nblk * 64 + c16;
    u16* op = p.ycat + gtok * 1024 + 768 + nblk * 64 + c16;
#pragma unroll
    for (int hv = 0; hv < 2; ++hv) {
      const uint4 g = *(const uint4*)(gp + hv * 8);
      const float4 f0 = *(const float4*)(hfT + tok * 68 + c16 + hv * 8), f1 = *(const float4*)(hfT + tok * 68 + c16 + hv * 8 + 4);
      const float4 h0 = *(const float4*)(hbT + tok * 68 + c16 + hv * 8), h1 = *(const float4*)(hbT + tok * 68 + c16 + hv * 8 + 4);
      uint4 o;
      o.x = pk2((f0.x + h0.x) * gelu_tanh(bflo(g.x)), (f0.y + h0.y) * gelu_tanh(bfhi(g.x)));
      o.y = pk2((f0.z + h0.z) * gelu_tanh(bflo(g.y)), (f0.w + h0.w) * gelu_tanh(bfhi(g.y)));
      o.z = pk2((f1.x + h1.x) * gelu_tanh(bflo(g.z)), (f1.y + h1.y) * gelu_tanh(bfhi(g.z)));
      o.w = pk2((f1.z + h1.z) * gelu_tanh(bflo(g.w)), (f1.w + h1.w) * gelu_tanh(bfhi(g.w)));
      *(uint4*)(op + hv * 8) = o;
    }
  }
  __syncthreads();
}

__device__ __forceinline__ void attn_wave(const P& p, int l, int b, int h, bool local, int r, int half, int qtok0, const float* rpbL) {
  const int lane = opaque_tid() & 63, q = lane & 31, hh = lane >> 5;
  bf16x8 qf[4];
  {
    const u16* qp = p.qk + (size_t)(qtok0 + q) * 1024 + h * 64 + 8 * hh;
#pragma unroll
    for (int s = 0; s < 4; ++s) qf[s] = *(const bf16x8*)(qp + 16 * s);
  }
  f32x16 o0 = zero16(), o1 = zero16();
  float m_run = -1e30f, l_run = 0.f;
  const int pi = (q & 19) | ((q & 4) << 1) | ((q & 8) >> 1);
  const int w = half * 32 + q;
  const int st = min(max(w - 8, 0), 48);
  const int rs = min(max(r - 4, 0), 56);
  const int ntiles = local ? 24 : 8;
  bf16x8 kfn[4], vfn[2][2];
  auto tile_load = [&](int ti, bf16x8 (&kfo)[4], bf16x8 (&vfo)[2][2]) {
    int ktok0, vstride;
    const u16* vb;
    if (ti < 8) {
      ktok0 = NLAT + b * 256 + ti * 32;
      vb = p.vTc + ((size_t)(b * 512 + h * 64)) * 256 + ti * 32;
      vstride = 256;
    } else {
      const int tl = ti - 8;
      const int a2 = tl >> 1, g2 = tl & 1;
      ktok0 = b * 4096 + (rs + a2) * 64 + g2 * 32;
      vb = p.vT + ((size_t)(b * 512 + h * 64)) * 4096 + (rs + a2) * 64 + g2 * 32;
      vstride = 4096;
    }
    const u16* kp = p.qk + (size_t)(ktok0 + pi) * 1024 + 512 + h * 64 + 8 * hh;
#pragma unroll
    for (int s = 0; s < 4; ++s) kfo[s] = *(const bf16x8*)(kp + 16 * s);
#pragma unroll
    for (int dt = 0; dt < 2; ++dt)
#pragma unroll
      for (int s2 = 0; s2 < 2; ++s2) vfo[dt][s2] = *(const bf16x8*)(vb + (size_t)(dt * 32 + q) * vstride + 16 * s2 + 8 * hh);
  };
  tile_load(0, kfn, vfn);
  for (int ti = 0; ti < ntiles; ++ti) {
    int a = 0, g = 0;
    if (ti >= 8) { a = (ti - 8) >> 1; g = (ti - 8) & 1; }
    bf16x8 kf[4], vf[2][2];
#pragma unroll
    for (int s = 0; s < 4; ++s) kf[s] = kfn[s];
#pragma unroll
    for (int dt = 0; dt < 2; ++dt)
#pragma unroll
      for (int s2 = 0; s2 < 2; ++s2) vf[dt][s2] = vfn[dt][s2];
    if (ti + 1 < ntiles) tile_load(ti + 1, kfn, vfn);
    f32x16 sacc = zero16();
#pragma unroll
    for (int s = 0; s < 4; ++s) sacc = mfma32(kf[s], qf[s], sacc);
    float sv[16];
    float tmax = -1e30f;
#pragma unroll
    for (int e = 0; e < 16; ++e) {
      float x = sacc[e] * 0.125f;
      if (ti >= 8) {
        const int kc = g * 32 + (e & 7) + 8 * hh + 16 * (e >> 3);
        const bool valid = (kc >= st) && (kc < st + 16);
        const int bi = valid ? ((rs + a - r + 7) * 31 + (kc - w + 15)) : 0;
        const float bias = rpbL[bi];
        x = valid ? (x + bias) : -1e30f;
      }
      sv[e] = x;
      tmax = fmaxf(tmax, x);
    }
    tmax = fmaxf(tmax, shx(tmax, 32));
    const float m_new = fmaxf(m_run, tmax);
    const float alpha = __expf(m_run - m_new);
    m_run = m_new;
    l_run *= alpha;
#pragma unroll
    for (int e = 0; e < 16; ++e) { o0[e] *= alpha; o1[e] *= alpha; }
    float psum = 0.f;
#pragma unroll
    for (int e = 0; e < 16; ++e) { const float pe = __expf(sv[e] - m_new); sv[e] = pe; psum += pe; }
    l_run += psum;
    bf16x8 pf[2];
#pragma unroll
    for (int s2 = 0; s2 < 2; ++s2) {
      union { bf16x8 v; unsigned u[4]; } cv;
#pragma unroll
      for (int j = 0; j < 4; ++j) cv.u[j] = pk2(sv[8 * s2 + 2 * j], sv[8 * s2 + 2 * j + 1]);
      pf[s2] = cv.v;
    }
#pragma unroll
    for (int s2 = 0; s2 < 2; ++s2) {
      o0 = mfma32(vf[0][s2], pf[s2], o0);
      o1 = mfma32(vf[1][s2], pf[s2], o1);
    }
  }
  const float lt = l_run + shx(l_run, 32);
  const float inv = 1.0f / lt;
  u16* op = p.ycat + (size_t)(qtok0 + q) * 1024 + h * 64;
#pragma unroll
  for (int qd = 0; qd < 4; ++qd) {
    uint2 a0, a1;
    a0.x = pk2(o0[4 * qd] * inv, o0[4 * qd + 1] * inv);
    a0.y = pk2(o0[4 * qd + 2] * inv, o0[4 * qd + 3] * inv);
    a1.x = pk2(o1[4 * qd] * inv, o1[4 * qd + 1] * inv);
    a1.y = pk2(o1[4 * qd + 2] * inv, o1[4 * qd + 3] * inv);
    *(uint2*)(op + 8 * qd + 4 * hh) = a0;
    *(uint2*)(op + 32 + 8 * qd + 4 * hh) = a1;
  }
}
__device__ __forceinline__ void attn_block_task(const P& p, int l, int b, int h, int rg4, char* smem) {
  const int tid = opaque_tid(), lane = tid & 63, wid = tid >> 6;
  const int q = lane & 31, hh = lane >> 5;
  const int R0 = rg4 * 4;
  const int r = R0 + (wid >> 1), half = wid & 1;
  float* rpbL = (float*)(smem + 32768) + 64;
  for (int i = tid; i < 465; i += NTHR) rpbL[i] = p.na_rpb[(size_t)(l * 8 + h) * 465 + i] * 1.4426950408889634f;
  const int lo = min(max(R0 - 4, 0), 56);
  const int hi = min(max(R0 + 3 - 4, 0), 56) + 7;
  const int ntile = 4 + (hi - lo + 1);
  const int rs = min(max(r - 4, 0), 56);
  const int qtok = b * 4096 + r * 64 + half * 32 + q;
  bf16x8 qf[4];
  {
    const u16* qp = p.qk + (size_t)qtok * 1024 + h * 64 + 8 * hh;
#pragma unroll
    for (int s = 0; s < 4; ++s) qf[s] = *(const bf16x8*)(qp + 16 * s);
  }
  f32x16 o0 = zero16(), o1 = zero16();
  float m_run = -1e30f, l_run = 0.f;
  const int pi = (q & 19) | ((q & 4) << 1) | ((q & 8) >> 1);
  const int w = half * 32 + q;
  const int st = min(max(w - 8, 0), 48);
  unsigned vmask = 0u;
#pragma unroll
  for (int g = 0; g < 2; ++g)
#pragma unroll
    for (int e = 0; e < 16; ++e) {
      const int kc = g * 32 + (e & 7) + 8 * hh + 16 * (e >> 3);
      vmask |= ((kc >= st) && (kc < st + 16)) ? (1u << (g * 16 + e)) : 0u;
    }
  const int cbase = 8 * hh - w + 15;
  const int srow = tid >> 3, sch = tid & 7;
  uint4 rkA, rvA, rkB, rvB;
  auto gload = [&](int ti, uint4& rk, uint4& rv) {
    int ktok0, vstride;
    const u16* vb;
    if (ti < 4) { ktok0 = NLAT + b * 256 + ti * 64; vb = p.vTc + ((size_t)(b * 512 + h * 64)) * 256 + ti * 64; vstride = 256; }
    else { const int R = lo + ti - 4; ktok0 = b * 4096 + R * 64; vb = p.vT + ((size_t)(b * 512 + h * 64)) * 4096 + R * 64; vstride = 4096; }
    rk = *(const uint4*)(p.qk + (size_t)(ktok0 + srow) * 1024 + 512 + h * 64 + sch * 8);
    rv = *(const uint4*)(vb + (size_t)srow * vstride + sch * 8);
  };
  gload(0, rkA, rvA);
  *(uint4*)(smem + swz128(srow, sch)) = rkA;
  *(uint4*)(smem + 16384 + swz128(srow, sch)) = rvA;
  gload(1, rkA, rvA);
  if (2 < ntile) gload(2, rkB, rvB);
  __syncthreads();
  auto compute = [&](int ti) {
    const char* Kb = smem + (ti & 1) * 8192;
    const char* Vb = smem + 16384 + (ti & 1) * 8192;
    const int R = lo + ti - 4;
    const bool active = (ti < 4) || (R >= rs && R < rs + 8);
    if (active) {
      f32x16 sacc0 = zero16(), sacc1 = zero16();
#pragma unroll
      for (int s = 0; s < 4; ++s) {
        const bf16x8 kf0 = *(const bf16x8*)(Kb + swz128(pi, 2 * s + hh));
        const bf16x8 kf1 = *(const bf16x8*)(Kb + swz128(32 + pi, 2 * s + hh));
        sacc0 = mfma32(kf0, qf[s], sacc0);
        sacc1 = mfma32(kf1, qf[s], sacc1);
      }
      float sv[32];
      float tmax = -1e30f;
      if (ti >= 4) {
        const float* brow = rpbL + (R - r + 7) * 31 + cbase;
        float bias[32];
#pragma unroll
        for (int g = 0; g < 2; ++g)
#pragma unroll
          for (int e = 0; e < 16; ++e) bias[g * 16 + e] = brow[g * 32 + (e & 7) + 16 * (e >> 3)];
#pragma unroll
        for (int g = 0; g < 2; ++g)
#pragma unroll
          for (int e = 0; e < 16; ++e) {
            const float sc = g ? sacc1[e] : sacc0[e];
            const float x = ((int)(vmask << (31 - (g * 16 + e))) < 0) ? fmaf(sc, 0.18033688011112042f, bias[g * 16 + e]) : -1e30f;
            sv[g * 16 + e] = x;
            tmax = fmaxf(tmax, x);
          }
      } else {
#pragma unroll
        for (int g = 0; g < 2; ++g)
#pragma unroll
          for (int e = 0; e < 16; ++e) {
            const float x = (g ? sacc1[e] : sacc0[e]) * 0.18033688011112042f;
            sv[g * 16 + e] = x;
            tmax = fmaxf(tmax, x);
          }
      }
      tmax = fmaxf(tmax, shx(tmax, 32));
      if (__builtin_amdgcn_ballot_w64(tmax > m_run) != 0ull) {
        const float m_new = fmaxf(m_run, tmax);
        const float alpha = __builtin_amdgcn_exp2f(m_run - m_new);
        m_run = m_new;
        l_run *= alpha;
#pragma unroll
        for (int e = 0; e < 16; ++e) { o0[e] *= alpha; o1[e] *= alpha; }
      }
      float psum = 0.f;
#pragma unroll
      for (int e = 0; e < 32; ++e) { const float pe = __builtin_amdgcn_exp2f(sv[e] - m_run); sv[e] = pe; psum += pe; }
      l_run += psum;
#pragma unroll
      for (int g = 0; g < 2; ++g)
#pragma unroll
        for (int s2 = 0; s2 < 2; ++s2) {
          union { bf16x8 v; unsigned u[4]; } cv;
#pragma unroll
          for (int j = 0; j < 4; ++j) cv.u[j] = pk2(sv[g * 16 + 8 * s2 + 2 * j], sv[g * 16 + 8 * s2 + 2 * j + 1]);
          const bf16x8 v0 = *(const bf16x8*)(Vb + swz128(q, g * 4 + 2 * s2 + hh));
          const bf16x8 v1 = *(const bf16x8*)(Vb + swz128(32 + q, g * 4 + 2 * s2 + hh));
          o0 = mfma32(v0, cv.v, o0);
          o1 = mfma32(v1, cv.v, o1);
        }
    }
  };
  for (int ti = 0; ti < ntile; ti += 2) {
    compute(ti);
    if (ti + 1 < ntile) {
      *(uint4*)(smem + 8192 + swz128(srow, sch)) = rkA;
      *(uint4*)(smem + 16384 + 8192 + swz128(srow, sch)) = rvA;
      if (ti + 3 < ntile) gload(ti + 3, rkA, rvA);
    }
    __syncthreads();
    if (ti + 1 < ntile) {
      compute(ti + 1);
      if (ti + 2 < ntile) {
        *(uint4*)(smem + swz128(srow, sch)) = rkB;
        *(uint4*)(smem + 16384 + swz128(srow, sch)) = rvB;
        if (ti + 4 < ntile) gload(ti + 4, rkB, rvB);
      }
      __syncthreads();
    }
  }
  const float lt = l_run + shx(l_run, 32);
  const float inv = 1.0f / lt;
  __syncthreads();
  {
    char* ot = smem + wid * 4608;
#pragma unroll
    for (int qd = 0; qd < 4; ++qd) {
      uint2 a0, a1;
      a0.x = pk2(o0[4 * qd] * inv, o0[4 * qd + 1] * inv);
      a0.y = pk2(o0[4 * qd + 2] * inv, o0[4 * qd + 3] * inv);
      a1.x = pk2(o1[4 * qd] * inv, o1[4 * qd + 1] * inv);
      a1.y = pk2(o1[4 * qd + 2] * inv, o1[4 * qd + 3] * inv);
      *(uint2*)(ot + q * 144 + (8 * qd + 4 * hh) * 2) = a0;
      *(uint2*)(ot + q * 144 + (32 + 8 * qd + 4 * hh) * 2) = a1;
    }
    asm volatile("s_waitcnt lgkmcnt(0)" ::: "memory");
    const int tok0 = b * 4096 + r * 64 + half * 32;
#pragma unroll
    for (int it = 0; it < 4; ++it) {
      const int qq = it * 8 + (lane >> 3), ch = lane & 7;
      const uint4 v = *(const uint4*)(ot + qq * 144 + ch * 16);
      *(uint4*)(p.ycat + (size_t)(tok0 + qq) * 1024 + h * 64 + ch * 8) = v;
    }
  }
  __syncthreads();
}
__device__ __forceinline__ void attn_task(const P& p, int l, int kind, int idx, char* smem) {
  const int tid_ = opaque_tid(); const int lane = tid_ & 63, wid = tid_ >> 6;
  float* rpbL = (float*)smem + wid * 480;
  for (int i = lane; i < 465; i += 64) rpbL[i] = p.na_rpb[(size_t)(l * 8 + wid) * 465 + i];
  __syncthreads();
  if (kind == 0) {
    const int half = idx & 1, r = (idx >> 1) & 63, b = idx >> 7;
    attn_wave(p, l, b, wid, true, r, half, b * 4096 + r * 64 + half * 32, rpbL);
  } else {
    const int qg = idx & 7, b = idx >> 3;
    attn_wave(p, l, b, wid, false, 0, 0, NLAT + b * 256 + qg * 32, rpbL);
  }
  __syncthreads();
}

__device__ __forceinline__ void phase_mixers(const P& p, int l, char* smem, unsigned* counter) {
  const bool last = (l == 1);
  const int n_rg = 1088 * XRGA, n_fft = 1024 * XFFT, n_hc = last ? 0 : 256, n_att = 1024 * XATT, n_attc = last ? 0 : 64;
  const int total = n_rg + n_fft + n_hc + n_att + n_attc;
  volatile int* s_taskp = (volatile int*)(smem + SMEM_BYTES - 16);
  for (;;) {
    __syncthreads();
    if (threadIdx.x == 0) *s_taskp = (int)atomicAdd(counter, 1u);
    __syncthreads();
    int t = *s_taskp;
    if (t >= total) break;
    if (t < n_att) { t &= 1023; attn_block_task(p, l, t >> 7, (t >> 4) & 7, t & 15, smem); continue; }
    t -= n_att;
    if (t < n_attc) { attn_task(p, l, 1, t, smem); continue; }
    t -= n_attc;
    if (t < n_fft) { t &= 1023; hyena_fft_task(p, l, t >> 2, t & 3, smem); continue; }
    t -= n_fft;
    if (t < n_hc) { hyena_ctx_task(p, l, t >> 5, t & 31, smem); continue; }
    t -= n_hc;
    if (t >= 1088) t -= 1088;
    rg_wave_task(p, l, t >> 2, t & 3, 0, last, smem);
  }
}

__device__ __forceinline__ void merge_tile(const P& p, int l, int mt, int nt, char* smem) {
  EPI_VARS
  const int m0 = mt * 256, n0 = nt * 128;
  f32x16 macc[2][2];
  zero_acc(macc);
  for (int br = 0; br < 3; ++br) {
    unsigned* gpl = (unsigned*)(smem + 98304) + tid;
    {
      f32x16 acc[2][2];
      zero_acc(acc);
      gemm_kloop(acc, p.xn + (size_t)m0 * 1024, 1024, p.WgT + ((size_t)l * 3072 + br * 1024 + n0) * 1024, 1024, 1024, smem);
#pragma unroll
      for (int j = 0; j < 2; ++j) {
        const float bg = p.b_gate[l * 3072 + br * 1024 + n0 + EPI_COL(j)];
#pragma unroll
        for (int i = 0; i < 2; ++i)
#pragma unroll
          for (int e = 0; e < 4; ++e) {
            const unsigned q0 = (unsigned)(sigmoidf_(acc[i][j][4 * e] + bg) * 255.0f + 0.5f);
            const unsigned q1 = (unsigned)(sigmoidf_(acc[i][j][4 * e + 1] + bg) * 255.0f + 0.5f);
            const unsigned q2 = (unsigned)(sigmoidf_(acc[i][j][4 * e + 2] + bg) * 255.0f + 0.5f);
            const unsigned q3 = (unsigned)(sigmoidf_(acc[i][j][4 * e + 3] + bg) * 255.0f + 0.5f);
            gpl[((i * 2 + j) * 4 + e) * 512] = q0 | (q1 << 8) | (q2 << 16) | (q3 << 24);
          }
      }
    }
    {
      f32x16 acc[2][2];
      zero_acc(acc);
      const u16* A; const u16* B; int K;
      if (br == 0) { A = p.ycat + (size_t)m0 * 1024; B = p.WaT + ((size_t)l * 1024 + n0) * 512; K = 512; }
      else if (br == 1) { A = p.ycat + (size_t)m0 * 1024 + 512; B = p.WbT + ((size_t)l * 1024 + n0) * 256; K = 256; }
      else { A = p.ycat + (size_t)m0 * 1024 + 768; B = p.WcT + ((size_t)l * 1024 + n0) * 256; K = 256; }
      gemm_kloop(acc, A, 1024, B, K, K, smem);
#pragma unroll
      for (int i = 0; i < 2; ++i)
#pragma unroll
        for (int j = 0; j < 2; ++j)
#pragma unroll
          for (int e = 0; e < 4; ++e) {
            const unsigned g4 = gpl[((i * 2 + j) * 4 + e) * 512];
            macc[i][j][4 * e] += (float)(g4 & 255u) * (1.0f / 255.0f) * acc[i][j][4 * e];
            macc[i][j][4 * e + 1] += (float)((g4 >> 8) & 255u) * (1.0f / 255.0f) * acc[i][j][4 * e + 1];
            macc[i][j][4 * e + 2] += (float)((g4 >> 16) & 255u) * (1.0f / 255.0f) * acc[i][j][4 * e + 2];
            macc[i][j][4 * e + 3] += (float)(g4 >> 24) * (1.0f / 255.0f) * acc[i][j][4 * e + 3];
          }
    }
  }
#pragma unroll
  for (int i = 0; i < 2; ++i)
#pragma unroll
    for (int j = 0; j < 2; ++j)
#pragma unroll
      for (int e = 0; e < 16; ++e)
        p.mbuf[(size_t)(m0 + EPI_ROW(i, e)) * 1024 + n0 + EPI_COL(j)] = f2bf(macc[i][j][e]);
}
__device__ __forceinline__ void outproj_tile(const P& p, int l, int mt, int nt, char* smem, bool do_store) {
  EPI_VARS
  const int m0 = mt * 256, n0 = nt * 128;
  f32x16 acc[2][2];
  zero_acc(acc);
  gemm_kloop(acc, p.mbuf + (size_t)m0 * 1024, 1024, p.WoT + ((size_t)l * 1024 + n0) * 1024, 1024, 1024, smem);
  const bool isctx = (mt >= 128);
  const int bi = isctx ? 8 : (mt >> 4);
  const float* gatev = p.mod + ((size_t)(l * 9 + bi) * 6 + 2) * 1024;
  const float* src; float* dst;
  if (isctx) { src = (l == 0 ? p.ctx : p.ctxs) - (size_t)NLAT * 1024; dst = p.ctxs - (size_t)NLAT * 1024; }
  else { src = (l == 0 ? p.x : p.out); dst = p.out; }
#pragma unroll
  for (int j = 0; j < 2; ++j) {
    const int col = n0 + EPI_COL(j);
    const float gv = gatev[col];
#pragma unroll
    for (int i = 0; i < 2; ++i)
#pragma unroll
      for (int e = 0; e < 16; ++e) {
        const size_t o = (size_t)(m0 + EPI_ROW(i, e)) * 1024 + col;
        if (do_store) dst[o] = src[o] + gv * acc[i][j][e];
      }
  }
}

__device__ __forceinline__ void wqk_task(const P& p, int l, int hp, int nt, char* smem) {
  EPI_VARS
  f32x16 acc[2][2];
  zero_acc(acc);
  gemm_kloop(acc, p.keysB + ((size_t)l * 16 + hp) * 16384, 128, p.WqB + (size_t)l * 1024 * 2048 + (size_t)(nt * 128) * 2048 + hp * 128, 2048, 128, smem);
  if (wm < 2) {
#pragma unroll
    for (int i = 0; i < 2; ++i)
#pragma unroll
      for (int j = 0; j < 2; ++j)
#pragma unroll
        for (int e = 0; e < 16; ++e)
          p.WqkT[((size_t)l * 2048 + hp * 128 + EPI_ROW(i, e)) * 1024 + nt * 128 + EPI_COL(j)] = f2bf(acc[i][j][e]);
  }
}
__device__ __forceinline__ void ins16(unsigned (&L)[16], unsigned x) {
#pragma unroll
  for (int i = 0; i < 16; ++i) {
    const unsigned hi = max(L[i], x);
    x = min(L[i], x);
    L[i] = hi;
  }
}
__device__ __forceinline__ unsigned f2sort(float f) {
  const unsigned b = __float_as_uint(f);
  return b ^ ((unsigned)((int)b >> 31) | 0x80000000u);
}
__device__ __forceinline__ float sort2f(unsigned k) {
  const unsigned u = k & ~127u;
  const unsigned b = (u & 0x80000000u) ? (u ^ 0x80000000u) : ~u;
  return __uint_as_float(b);
}
__device__ __forceinline__ void cx_desc(unsigned& a, unsigned& b) { const unsigned hi = max(a, b), lo = min(a, b); a = hi; b = lo; }
template <int BASE> __device__ __forceinline__ void sort16_desc(unsigned (&k)[64]) {
#pragma unroll
  for (int sz = 2; sz <= 16; sz <<= 1) {
#pragma unroll
    for (int j = sz >> 1; j >= 1; j >>= 1) {
#pragma unroll
      for (int i = 0; i < 16; ++i) {
        const int l2 = i ^ j;
        if (l2 > i) {
          if ((i & sz) == 0) cx_desc(k[BASE + i], k[BASE + l2]);
          else cx_desc(k[BASE + l2], k[BASE + i]);
        }
      }
    }
  }
}
template <int AB, int BB> __device__ __forceinline__ void merge16_desc(unsigned (&k)[64]) {
#pragma unroll
  for (int i = 0; i < 16; ++i) k[AB + i] = max(k[AB + i], k[BB + 15 - i]);
#pragma unroll
  for (int j = 8; j >= 1; j >>= 1) {
#pragma unroll
    for (int i = 0; i < 16; ++i)
      if ((i & j) == 0) cx_desc(k[AB + i], k[AB + i + j]);
  }
}
__device__ __forceinline__ void peer_score_tile(const P& p, int l, int mt, int hp, char* smem) {
  const int tid = opaque_tid();
  const int m0 = mt * 256;
  const int row = tid >> 1, hf = tid & 1;
  {
    char* T = smem + 16384;
#pragma unroll
    for (int it = 0; it < 8; ++it) {
      const int id = tid + NTHR * it;
      const int r = id >> 4, ch = id & 15;
      *(uint4*)(T + r * 272 + ch * 16) = *(const uint4*)(p.q + (size_t)(m0 + r) * 2048 + hp * 128 + ch * 8);
    }
  }
  __syncthreads();
  const char* sp = smem + 16384 + row * 272 + hf * 128;
  unsigned k[64];
#pragma unroll
  for (int c = 0; c < 8; ++c) {
    const uint4 r = *(const uint4*)(sp + 16 * c);
    const unsigned w[4] = {r.x, r.y, r.z, r.w};
#pragma unroll
    for (int q = 0; q < 4; ++q) {
      const float v0 = __builtin_bit_cast(_Float16, (unsigned short)(w[q] & 0xffffu));
      const float v1 = __builtin_bit_cast(_Float16, (unsigned short)(w[q] >> 16));
      const int key = hf * 64 + c * 8 + q * 2;
      k[c * 8 + q * 2] = (f2sort(v0) & ~127u) | (unsigned)key;
      k[c * 8 + q * 2 + 1] = (f2sort(v1) & ~127u) | (unsigned)(key + 1);
    }
  }
  sort16_desc<0>(k); sort16_desc<16>(k); sort16_desc<32>(k); sort16_desc<48>(k);
  merge16_desc<0, 16>(k);
  merge16_desc<32, 48>(k);
  merge16_desc<0, 32>(k);
  unsigned* X = (unsigned*)smem;
  if (hf) {
#pragma unroll
    for (int i = 0; i < 16; ++i) X[row * 16 + i] = k[i];
  }
  __syncthreads();
  if (!hf) {
#pragma unroll
    for (int i = 0; i < 16; ++i) k[16 + i] = X[row * 16 + i];
    merge16_desc<0, 16>(k);
    unsigned* o = p.topk + ((size_t)(m0 + row) * 16 + hp) * 16;
#pragma unroll
    for (int i = 0; i < 4; ++i) *(uint4*)(o + 4 * i) = make_uint4(k[4 * i], k[4 * i + 1], k[4 * i + 2], k[4 * i + 3]);
  }
  __syncthreads();
}

__device__ __forceinline__ void phase_peer_experts(const P& p, int l, bool do_store, char* smem) {
  const int tid_ = opaque_tid(); const int lane = tid_ & 63, wid = tid_ >> 6;
  const int ntok = (l == 1) ? NLAT : NTOK;
  int ci, cj;
  {
    const int e = lane;
    if (e < 16) { ci = 0; cj = e; }
    else if (e < 24) { ci = 1; cj = e - 16; }
    else if (e < 29) { ci = 2; cj = e - 24; }
    else if (e < 33) { ci = 3; cj = e - 29; }
    else if (e < 36) { ci = 4; cj = e - 33; }
    else if (e < 38) { ci = 5; cj = e - 36; }
    else if (e < 40) { ci = 6; cj = e - 38; }
    else if (e < 42) { ci = 7; cj = e - 40; }
    else { ci = min(8 + (e - 42), 15); cj = 0; }
  }
  for (int tok = blockIdx.x * 8 + wid; tok < ntok; tok += gridDim.x * 8) {
    float xr[16];
    {
      const uint4 a = *(const uint4*)(p.xn + (size_t)tok * 1024 + lane * 16);
      const uint4 b = *(const uint4*)(p.xn + (size_t)tok * 1024 + lane * 16 + 8);
      xr[0] = bflo(a.x); xr[1] = bfhi(a.x); xr[2] = bflo(a.y); xr[3] = bfhi(a.y);
      xr[4] = bflo(a.z); xr[5] = bfhi(a.z); xr[6] = bflo(a.w); xr[7] = bfhi(a.w);
      xr[8] = bflo(b.x); xr[9] = bfhi(b.x); xr[10] = bflo(b.y); xr[11] = bfhi(b.y);
      xr[12] = bflo(b.z); xr[13] = bfhi(b.z); xr[14] = bflo(b.w); xr[15] = bfhi(b.w);
    }
    float yacc[16];
#pragma unroll
    for (int i = 0; i < 16; ++i) yacc[i] = 0.f;
    int* selw = (int*)(smem + wid * 4096);
    const unsigned* kvp = p.topk + (size_t)tok * 256 + (lane & 31);
#pragma unroll 1
    for (int hb = 0; hb < 8; hb += 4) {
      unsigned key[4]; int eidx[4];
#pragma unroll
      for (int u = 0; u < 4; ++u) {
        const unsigned kv = kvp[(hb + u) * 32];
        const unsigned k0 = shu(kv, ci);
        const unsigned k1 = shu(kv, 16 + cj);
        const float val = (lane < 50) ? (sort2f(k0) + sort2f(k1)) : -3.0e38f;
        eidx[u] = (int)((k0 & 127u) * 128u + (k1 & 127u));
        key[u] = (f2sort(val) & ~63u) | (unsigned)lane;
      }
#pragma unroll
      for (int k = 2; k <= 64; k <<= 1) {
#pragma unroll
        for (int j = k >> 1; j >= 1; j >>= 1) {
          const bool take_max = (((lane & j) == 0) == ((lane & k) == 0));
#pragma unroll
          for (int u = 0; u < 4; ++u) {
            unsigned ok;
            if (j == 1) ok = xorl<1>(key[u], lane); else if (j == 2) ok = xorl<2>(key[u], lane); else if (j == 4) ok = xorl<4>(key[u], lane);
            else if (j == 8) ok = xorl<8>(key[u], lane); else if (j == 16) ok = xorl<16>(key[u], lane); else ok = xorl<32>(key[u], lane);
            key[u] = take_max ? max(key[u], ok) : min(key[u], ok);
          }
        }
      }
#pragma unroll
      for (int u = 0; u < 4; ++u) {
        const int si = __builtin_amdgcn_ds_bpermute((int)(key[u] & 63u) << 2, eidx[u]);
        const unsigned ku = key[u] & ~63u;
        const float sv = __uint_as_float((ku & 0x80000000u) ? (ku ^ 0x80000000u) : ~ku);
        const float mx = __builtin_bit_cast(float, __builtin_amdgcn_readlane(__builtin_bit_cast(int, sv), 0));
        const float ex = (lane < 16) ? __builtin_amdgcn_exp2f((sv - mx) * 1.4426950408889634f) : 0.f;
        const float sm = wave_sum(ex);
        selw[(hb + u) * 64 + lane] = si;
        selw[512 + (hb + u) * 64 + lane] = __builtin_bit_cast(int, ex * __builtin_amdgcn_rcpf(sm));
      }
    }
    {
      int w[4];
#pragma unroll
      for (int i = 0; i < 4; ++i) {
        int t = __builtin_amdgcn_cvt_pk_fp8_f32(xr[4 * i], xr[4 * i + 1], 0, false);
        w[i] = __builtin_amdgcn_cvt_pk_fp8_f32(xr[4 * i + 2], xr[4 * i + 3], t, true);
      }
      *(uint4*)(smem + 32768 + wid * 1024 + lane * 16) = make_uint4((unsigned)w[0], (unsigned)w[1], (unsigned)w[2], (unsigned)w[3]);
    }
    asm volatile("s_waitcnt lgkmcnt(0)" ::: "memory");
    const int e15 = lane & 15, g4 = lane >> 4;
#pragma unroll 1
    for (int h = 0; h < 8; ++h) {
      const int eperm_h = selw[h * 64 + lane];
      const int gperm_h = selw[512 + h * 64 + lane];
      const int ide = (int)shu((unsigned)eperm_h, e15);
      const unsigned char* ub = p.Ub + (size_t)ide * 1024 + g4 * 16;
      uint4 ua[8];
#pragma unroll
      for (int sI = 0; sI < 8; ++sI) ua[sI] = *(const uint4*)(ub + sI * 64);
      pg8::f32x4 hacc = {0.f, 0.f, 0.f, 0.f};
#pragma unroll
      for (int sI = 0; sI < 8; ++sI) {
        const uint4 b0 = *(const uint4*)(smem + 32768 + wid * 1024 + sI * 128 + g4 * 16);
        const uint4 b1 = *(const uint4*)(smem + 32768 + wid * 1024 + sI * 128 + 64 + g4 * 16);
        const i32x8 A = {(int)ua[sI].x, (int)ua[sI].y, (int)ua[sI].z, (int)ua[sI].w, 0, 0, 0, 0};
        const i32x8 B = {(int)b0.x, (int)b0.y, (int)b0.z, (int)b0.w, (int)b1.x, (int)b1.y, (int)b1.z, (int)b1.w};
        hacc = __builtin_amdgcn_mfma_scale_f32_16x16x128_f8f6f4(A, B, hacc, 4  , 0  , 0, 0x7f7f7f7f, 0, 0x7f7f7f7f);
      }
      asm volatile("" ::: "memory");
      uint2 V[16];
#pragma unroll
      for (int k = 0; k < 16; ++k) {
        const int id = __builtin_amdgcn_readlane(eperm_h, k);
        V[k] = *(const uint2*)(p.Ub + (size_t)id * 1024 + 512 + lane * 8);
      }
      float actv[4];
#pragma unroll
      for (int r4 = 0; r4 < 4; ++r4) {
        const float gl = __builtin_bit_cast(float, shu((unsigned)gperm_h, 4 * g4 + r4));
        actv[r4] = gelu_tanh(hacc[r4] * (1.0f / 64.0f)) * gl;
      }
#pragma unroll
      for (int k = 0; k < 16; ++k) {
        const float ak = __builtin_bit_cast(float, __builtin_amdgcn_readlane(__builtin_bit_cast(int, actv[k & 3]), 16 * (k >> 2)));
        const unsigned vw[2] = {V[k].x, V[k].y};
#pragma unroll
        for (int q2 = 0; q2 < 2; ++q2) {
          const f32x2 e0 = __builtin_amdgcn_cvt_scalef32_pk_f32_fp4(vw[q2], 1.0f, 0);
          const f32x2 e1 = __builtin_amdgcn_cvt_scalef32_pk_f32_fp4(vw[q2], 1.0f, 1);
          const f32x2 e2 = __builtin_amdgcn_cvt_scalef32_pk_f32_fp4(vw[q2], 1.0f, 2);
          const f32x2 e3 = __builtin_amdgcn_cvt_scalef32_pk_f32_fp4(vw[q2], 1.0f, 3);
          yacc[8 * q2] += ak * e0.x; yacc[8 * q2 + 1] += ak * e0.y; yacc[8 * q2 + 2] += ak * e1.x; yacc[8 * q2 + 3] += ak * e1.y;
          yacc[8 * q2 + 4] += ak * e2.x; yacc[8 * q2 + 5] += ak * e2.y; yacc[8 * q2 + 6] += ak * e3.x; yacc[8 * q2 + 7] += ak * e3.y;
        }
      }
    }
    const int bi = tok < NLAT ? (tok >> 12) : 8;
    const float* gv = p.mod + ((size_t)(l * 9 + bi) * 6 + 5) * 1024 + lane * 16;
    float* xp = (tok < NLAT) ? (p.out + (size_t)tok * 1024) : (p.ctxs + (size_t)(tok - NLAT) * 1024);
    xp += lane * 16;
    float4 xv[4];
    float ss = 0.f;
#pragma unroll
    for (int i = 0; i < 4; ++i) {
      xv[i] = *(float4*)(xp + 4 * i);
      const float4 g4 = *(const float4*)(gv + 4 * i);
      xv[i].x += g4.x * yacc[4 * i] * 0.25f; xv[i].y += g4.y * yacc[4 * i + 1] * 0.25f; xv[i].z += g4.z * yacc[4 * i + 2] * 0.25f; xv[i].w += g4.w * yacc[4 * i + 3] * 0.25f;
      ss += xv[i].x * xv[i].x + xv[i].y * xv[i].y + xv[i].z * xv[i].z + xv[i].w * xv[i].w;
    }
    ss = wave_sum(ss);
    const float rstd = rsqrtf(ss * (1.0f / 1024.0f) + 1e-6f);
    if (l == 0) {
      const float* gam = p.norm_mix_g + 1024 + lane * 16;
      const float* msh = p.mod + ((size_t)(9 + bi) * 6 + 0) * 1024 + lane * 16;
      const float* msc = msh + 1024;
      float yv[16];
      float amax = 0.f;
#pragma unroll
      for (int i = 0; i < 4; ++i) {
        if (do_store) *(float4*)(xp + 4 * i) = xv[i];
        const float4 g = *(const float4*)(gam + 4 * i);
        const float4 sh = *(const float4*)(msh + 4 * i);
        const float4 sc = *(const float4*)(msc + 4 * i);
        yv[4 * i] = xv[i].x * rstd * g.x * (1.f + sc.x) + sh.x; yv[4 * i + 1] = xv[i].y * rstd * g.y * (1.f + sc.y) + sh.y;
        yv[4 * i + 2] = xv[i].z * rstd * g.z * (1.f + sc.z) + sh.z; yv[4 * i + 3] = xv[i].w * rstd * g.w * (1.f + sc.w) + sh.w;
      }
#pragma unroll
      for (int i = 0; i < 16; ++i) amax = fmaxf(amax, fabsf(yv[i]));
      amax = fmaxf(wave_max(amax), 1e-20f);
      const float inv = 127.0f / amax;
      unsigned w[4];
#pragma unroll
      for (int i = 0; i < 4; ++i)
        w[i] = ((unsigned)__float2int_rn(yv[4 * i] * inv) & 255u) | (((unsigned)__float2int_rn(yv[4 * i + 1] * inv) & 255u) << 8) |
               (((unsigned)__float2int_rn(yv[4 * i + 2] * inv) & 255u) << 16) | (((unsigned)__float2int_rn(yv[4 * i + 3] * inv) & 255u) << 24);
      if (do_store) {
        *(uint4*)(p.xn8 + (size_t)tok * 1024 + lane * 16) = make_uint4(w[0], w[1], w[2], w[3]);
        if (lane == 0) p.sa[tok] = amax * (1.0f / 127.0f);
      }
    } else {
      const float* fg = p.final_g + lane * 16;
#pragma unroll
      for (int i = 0; i < 4; ++i) {
        const float4 g = *(const float4*)(fg + 4 * i);
        const float4 o = make_float4(xv[i].x * rstd * g.x, xv[i].y * rstd * g.y, xv[i].z * rstd * g.z, xv[i].w * rstd * g.w);
        if (do_store) *(float4*)(xp + 4 * i) = o;
      }
    }
  }
}


#define XB_TMO      128
#define XB_XCNT(j)  (256  + 64 * (j))
#define XB_XSUB(j)  (1280 + 64 * (j))
#define XB_XGEN(j)  (2304 + 64 * (j))
#define XB_TOP      3328
#define XB_TOPGEN   3392
#define XCD_BAR_WORDS 3456
#define XB_SPIN_CAP (1u << 22)
#define LAS __attribute__((address_space(3)))
__device__ __forceinline__ unsigned xb_ld(unsigned* p) { return __hip_atomic_load(p, __ATOMIC_RELAXED, __HIP_MEMORY_SCOPE_AGENT); }
__device__ __forceinline__ unsigned xb_add(unsigned* p, unsigned v) { return __hip_atomic_fetch_add(p, v, __ATOMIC_RELAXED, __HIP_MEMORY_SCOPE_AGENT); }
__device__ __forceinline__ unsigned xb_xcc_id() { return (unsigned)__builtin_amdgcn_s_getreg((3 << 11) | 20) & 0xFu; }
#define XB_SPIN(cond, bar) do { unsigned _sp = 0; while (cond) { __builtin_amdgcn_s_sleep(1); \
    if ((++_sp & 255u) == 0u) { if (xb_ld(&(bar)[XB_TMO])) break; if (_sp > XB_SPIN_CAP) { atomicAdd(&(bar)[XB_TMO], 1u); break; } } } } while (0)
struct XcdBarrier { unsigned* bar; unsigned x; volatile LAS unsigned* st; };
__device__ __forceinline__ XcdBarrier xcd_barrier_post(unsigned* bar, volatile LAS unsigned* st) {
  XcdBarrier b; b.bar = bar; b.x = xb_xcc_id(); b.st = st;
  if (threadIdx.x == 0) (void)xb_add(&bar[XB_XCNT(b.x)], 1u);
  return b;
}
__device__ __forceinline__ void xcd_barrier_complete(unsigned* bar, unsigned x, unsigned& nloc, unsigned& nx) {
  const unsigned G = gridDim.x * gridDim.y * gridDim.z;
  unsigned sum, cnt, mine, sp = 0u;
  for (;;) {
    sum = 0u; cnt = 0u; mine = 0u;
#pragma unroll
    for (unsigned j = 0; j < 16; ++j) { const unsigned c = xb_ld(&bar[XB_XCNT(j)]); sum += c; cnt += (c > 0u) ? 1u : 0u; mine = (j == x) ? c : mine; }
    if (sum == G) break;
    __builtin_amdgcn_s_sleep(1);
    if ((++sp & 255u) == 0u) { if (xb_ld(&bar[XB_TMO])) break; if (sp > XB_SPIN_CAP) { atomicAdd(&bar[XB_TMO], 1u); break; } }
  }
  nloc = mine > 0u ? mine : 1u; nx = cnt > 0u ? cnt : 1u;
}
__device__ __forceinline__ void xcd_barrier(unsigned* bar_u, volatile LAS unsigned* st_u) {
  XcdBarrier b; b.bar = bar_u; b.x = xb_xcc_id(); b.st = st_u;
  asm volatile("s_waitcnt vmcnt(0)" ::: "memory");
  __syncthreads();
  if (threadIdx.x == 0) {
    unsigned long long bp_ = (unsigned long long)b.bar;
    asm volatile("" : "+v"(bp_));
    unsigned* bar = (unsigned*)bp_;
    __builtin_amdgcn_s_waitcnt(0);
    unsigned nloc = b.st[0], nx = b.st[1];
    if (nloc == 0u) { xcd_barrier_complete(bar, b.x, nloc, nx); b.st[0] = nloc; b.st[1] = nx; }
    const unsigned old = xb_add(&bar[XB_XSUB(b.x)], 1u);
    const unsigned gen = old / nloc;
    if (old + 1u == (gen + 1u) * nloc) {
      __builtin_amdgcn_fence(__ATOMIC_RELEASE, "agent");
      asm volatile("s_waitcnt vmcnt(0)" ::: "memory");
      const unsigned og = xb_add(&bar[XB_TOP], 1u);
      const unsigned tg = og / nx;
      if (og + 1u == (tg + 1u) * nx) xb_add(&bar[XB_TOPGEN], 1u);
      else XB_SPIN(xb_ld(&bar[XB_TOPGEN]) == tg, bar);
      __builtin_amdgcn_fence(__ATOMIC_ACQUIRE, "agent");
      xb_add(&bar[XB_XGEN(b.x)], 1u);
      asm volatile("s_waitcnt vmcnt(0)" ::: "memory");
    } else {
      XB_SPIN(xb_ld(&bar[XB_XGEN(b.x)]) == gen, bar);
      __builtin_amdgcn_fence(__ATOMIC_ACQUIRE, "agent");
      asm volatile("s_waitcnt vmcnt(0)" ::: "memory");
    }
  }
  __syncthreads();
}

template <int l>
__device__ __forceinline__ void layer_body(const P& p, char* smem, pg8::PG8_LAS_T lds, volatile LAS unsigned* xbw, const int nb, const int bid) {
    const bool last = (l == 1);
    const int n_mt = last ? 128 : 136;
    if (l == 0) {
      phase_norm(p, l, 0);
      xcd_barrier(p.counters + 1024, xbw);
    }
_Pragma("unroll 1")
    for (int rep = 0; rep < REP_INPROJ; ++rep) {
      pg8::Gemm g; pg8::Order S;
      g.A = (const u16*)p.xn8; g.Bt = (const u16*)(p.Win8 + (size_t)l * 2816 * 1024); g.lda = 512; g.ldb = 512; g.K = 512;
      S.init(136, 6, nb, bid, 4, 5);
      pg8::EpiInprojN8 e1; e1.qk = p.qk; e1.rg = p.rg; e1.sa = p.sa; e1.sw = p.sw + l * 5888;
      pg8::gemm_phase(lds, g, S, e1);
      g.A = (const u16*)(p.Win8 + ((size_t)l * 2816 + 1024) * 1024); g.Bt = (const u16*)p.xn8;
      S.init(5, 136, nb, bid);
      pg8::EpiInprojT8 e2; e2.vT = p.vT; e2.sa = p.sa; e2.sw = p.sw + l * 5888 + 1024;
      pg8::gemm_phase(lds, g, S, e2);
    }
    xcd_barrier(p.counters + 1024, xbw);
    phase_mixers(p, l, smem, p.counters + l * 4);
    xcd_barrier(p.counters + 1024, xbw);
_Pragma("unroll 1")
    for (int rep = 0; rep < REP_2B; ++rep)
      for (int task = bid; task < 1088 + 512; task += nb) {
        if (task < 1088) rg_wave_task(p, l, task >> 2, task & 3, 1, last, smem);
        else yb_transpose_task(p, (task - 1088) >> 6, (task - 1088) & 63, smem);
      }
    xcd_barrier(p.counters + 1024, xbw);
_Pragma("unroll 1")
    for (int rep = 0; rep < REP_GATE; ++rep) {
      pg8::Gemm g; pg8::Order S;
      g.A = (const u16*)p.xn8; g.Bt = (const u16*)(p.Wg8 + (size_t)l * 3072 * 1024); g.lda = 512; g.ldb = 512; g.K = 512;
      S.init(n_mt, 12, nb, bid);
      pg8::EpiGate8 e; e.g8 = p.g8; e.bias = p.b_gate + l * 3072; e.sa = p.sa; e.sw = p.sw + l * 5888 + 2816;
      pg8::gemm_phase(lds, g, S, e);
    }
    xcd_barrier(p.counters + 1024, xbw);
_Pragma("unroll 1")
    for (int rep = 0; rep < REP_BRANCH; ++rep) {
      pg8::Gemm g; pg8::Order S;
      S.init(n_mt, 4, nb, bid);
      pg8::EpiBranch e; e.mbuf = p.mbuf; e.g8 = p.g8;
      g.lda = 1024;
      g.A = p.ycat; g.Bt = p.WaT + (size_t)l * 1024 * 512; g.ldb = 512; g.K = 512; e.br = 0;
      pg8::gemm_phase(lds, g, S, e);
      g.A = p.ycat + 512; g.Bt = p.WbT + (size_t)l * 1024 * 256; g.ldb = 256; g.K = 256; e.br = 1;
      pg8::gemm_phase(lds, g, S, e);
      g.A = p.ycat + 768; g.Bt = p.WcT + (size_t)l * 1024 * 256; g.ldb = 256; g.K = 256; e.br = 2;
      pg8::gemm_phase(lds, g, S, e);
    }
    xcd_barrier(p.counters + 1024, xbw);
    {
      pg8::Gemm g; pg8::Order S;
      g.A = p.mbuf; g.Bt = p.WoT + (size_t)l * 1024 * 1024; g.lda = 1024; g.ldb = 1024; g.K = 1024;
      S.init(n_mt, 4, nb, bid);
      pg8::EpiOut e; e.xsrc = (l == 0 ? p.x : p.out); e.csrc = (l == 0 ? p.ctx : p.ctxs); e.xdst = p.out; e.cdst = p.ctxs;
      e.modl = p.mod + (size_t)l * 9 * 6144;
      pg8::gemm_phase(lds, g, S, e);
      for (int t = bid; t < 8192; t += nb) {
        if (t < 4096) cvt_chunk_fp4(p.peer_u + (size_t)l * 16384 * 1024, p.Ub, (size_t)t, 64.0f, 0);
        else cvt_chunk_fp4(p.peer_v + (size_t)l * 16384 * 1024, p.Ub, (size_t)(t - 4096), 4.0f, 1);
      }
    }
    xcd_barrier(p.counters + 1024, xbw);
    phase_norm(p, l, 1);
    xcd_barrier(p.counters + 1024, xbw);
_Pragma("unroll 1")
    for (int rep = 0; rep < REP_Q; ++rep) {
      pg8::Gemm g; pg8::Order S;
      g.A = p.xn; g.Bt = p.WqkT + (size_t)l * 2048 * 1024; g.lda = 1024; g.ldb = 1024; g.K = 1024;
      S.init(n_mt, 8, nb, bid);
      pg8::EpiQ e; e.q = p.q;
      pg8::gemm_phase(lds, g, S, e);
    }
    xcd_barrier(p.counters + 1024, xbw);
_Pragma("unroll 1")
    for (int rep = 0; rep < REP_SCORE; ++rep)
      for (int task = bid; task < n_mt * 16; task += nb) peer_score_tile(p, l, task >> 4, task & 15, smem);
    xcd_barrier(p.counters + 1024, xbw);
_Pragma("unroll 1")
    for (int rep = 0; rep < REP_PEER; ++rep) phase_peer_experts(p, l, rep == REP_PEER - 1, smem);
    xcd_barrier(p.counters + 1024, xbw);
  }

__global__ void __launch_bounds__(NTHR) fwd_megakernel(P p) {
  __shared__ __attribute__((aligned(16))) char smem[SMEM_BYTES];
  cg::grid_group grid = cg::this_grid();
  const int nb = gridDim.x, bid = blockIdx.x;
  pg8::PG8_LAS_T lds = (pg8::PG8_LAS_T)smem;
  volatile LAS unsigned* xbw = (volatile LAS unsigned*)(smem + SMEM_BYTES - 32);
  if (threadIdx.x == 0) { xbw[0] = 0u; xbw[1] = 0u; xbw[2] = 0u; xbw[3] = 0u; }
  __syncthreads();
  (void)xcd_barrier_post(p.counters + 1024, xbw);

  phase_prep(p, smem);
  if (blockIdx.x < 136) phase_filters(p, 0, smem);
  if (blockIdx.x >= gridDim.x - 128) { for (int t = blockIdx.x - (gridDim.x - 128); t < 128; t += 128) filter_block_task(p, 1, 4096, t * 32, p.hT + (size_t)512 * 4096, smem); }
  grid.sync();
  phase_modreduce(p);
  for (int task = blockIdx.x; task < 512; task += gridDim.x) kf_task(p, task >> 8, task & 255, smem);
  for (int task = blockIdx.x; task < 256; task += gridDim.x) wqk_task(p, task >> 7, (task >> 3) & 15, task & 7, smem);
  for (int task = blockIdx.x; task < 2 * 1472; task += gridDim.x) {
    const int l = task / 1472, t = task - l * 1472;
    if (t < 704) tr_tile_i8(p.w_in + (size_t)l * 1024 * 2816, 2816, 1024, p.Win8 + (size_t)l * 2816 * 1024, t, p.sw + l * 5888, smem);
    else tr_tile_i8(p.w_gate + (size_t)l * 1024 * 3072, 3072, 1024, p.Wg8 + (size_t)l * 3072 * 1024, t - 704, p.sw + l * 5888 + 2816, smem);
  }
  xcd_barrier(p.counters + 1024, xbw);

  layer_body<0>(p, smem, lds, xbw, nb, bid);
  layer_body<1>(p, smem, lds, xbw, nb, bid);
}

extern "C" void kernel_launch(void* const* d_in, const int* in_sizes, int n_in, void* d_out, int out_size, void* d_ws,
                              size_t ws_size, hipStream_t stream) {
  P p;
  memset(&p, 0, sizeof(p));
  const float** ins = (const float**)&p;
  for (int i = 0; i < 37; ++i) ins[i] = (const float*)d_in[i];
  p.out = (float*)d_out;
  char* w = (char*)d_ws;
  size_t off = 0;
  auto take = [&](size_t bytes) { char* r = w + off; off += (bytes + 255) & ~(size_t)255; return r; };
  p.counters = (unsigned*)take(32768);
  p.WinT = nullptr; p.WgT = nullptr;
  p.Win8 = (unsigned char*)take((size_t)2 * 2816 * 1024);
  p.Wg8 = (unsigned char*)take((size_t)2 * 3072 * 1024);
  p.sw = (float*)take((size_t)2 * 5888 * 4);
  p.xn8 = (unsigned char*)take((size_t)NTOK * 1024);
  p.sa = (float*)take((size_t)NTOK * 4);
  p.WaT = (u16*)take((size_t)2 * 1024 * 512 * 2);
  p.WbT = (u16*)take((size_t)2 * 1024 * 256 * 2);
  p.WcT = (u16*)take((size_t)2 * 1024 * 256 * 2);
  p.WoT = (u16*)take((size_t)2 * 1024 * 1024 * 2);
  p.WqB = (u16*)take((size_t)2 * 1024 * 2048 * 2);
  p.WqkT = (u16*)take((size_t)2 * 2048 * 1024 * 2);
  p.keysB = (u16*)take((size_t)2 * 16 * 16384 * 2);
  p.rgW = (u16*)take((size_t)2 * 16 * 4096 * 2);
  p.modpart = (float*)take((size_t)16 * 2 * 9 * 6144 * 4);
  p.mod = (float*)take((size_t)2 * 9 * 6144 * 4);
  p.hT = (float*)take((size_t)2 * 512 * 4096 * 4);
  p.hc = (float*)take((size_t)512 * 256 * 4);
  p.Kf = (float*)take((size_t)2 * 256 * 8192 * 8);
  p.xn = (u16*)take((size_t)NTOK * 1024 * 2);
  p.qk = (u16*)take((size_t)NTOK * 1024 * 2);
  p.mbuf = p.qk;
  p.vT = (u16*)take((size_t)8 * 512 * 4096 * 2);
  p.vTc = (u16*)take((size_t)8 * 512 * 256 * 2);
  p.hyT = (u16*)take((size_t)8 * 768 * 4096 * 2);
  p.hyTc = (u16*)take((size_t)8 * 768 * 256 * 2);
  p.rg = (u16*)take((size_t)NTOK * 512 * 2);
  p.ycat = (u16*)take((size_t)NTOK * 1024 * 2);
  p.Ub = (unsigned char*)p.ycat;
  p.Vb = p.Ub + (size_t)16384 * 512;
  p.agg = (float*)take((size_t)8 * 2 * (136 + 34) * 256 * 8);
  p.ybT = (u16*)take((size_t)8 * 256 * 4096 * 2);
  p.ctxs = (float*)take((size_t)2048 * 1024 * 4);
  p.g8 = (unsigned char*)p.vT;
  p.q = p.qk;
  p.topk = (unsigned*)((char*)p.qk + (size_t)NTOK * 2048 * 2);
  if (off > ws_size) {
    fprintf(stderr, "workspace too small: need %zu have %zu\n", off, ws_size);
    return;
  }
  static int grid_blocks = 0;
  if (!grid_blocks) {
    int dev = 0, cus = 0, per_cu = 0;
    (void)hipGetDevice(&dev);
    (void)hipDeviceGetAttribute(&cus, hipDeviceAttributeMultiprocessorCount, dev);
    (void)hipOccupancyMaxActiveBlocksPerMultiprocessor(&per_cu, fwd_megakernel, NTHR, 0);
    if (per_cu > 1) per_cu = 1;
    grid_blocks = cus * per_cu;
  }
  (void)hipMemsetAsync(p.counters, 0, 32768, stream);
  void* args[] = {&p};
  hipError_t e = hipLaunchCooperativeKernel((void*)fwd_megakernel, dim3(grid_blocks), dim3(NTHR), args, 0, stream);
  if (e != hipSuccess) fprintf(stderr, "cooperative launch failed: %s (grid %d)\n", hipGetErrorString(e), grid_blocks);
}
```

```cpp
#include <hip/hip_runtime.h>
#include <hip/hip_cooperative_groups.h>
#include <cstdio>
#include <cstring>
namespace cg = cooperative_groups;

typedef unsigned short u16;
typedef __attribute__((ext_vector_type(8))) short bf16x8;
typedef __attribute__((ext_vector_type(16))) float f32x16;
typedef __attribute__((ext_vector_type(2))) float f32x2;
typedef int i32x8 __attribute__((ext_vector_type(8)));

#define NLAT 32768
#define NTOK 34816
#define SMEM_BYTES 151552
#define NTHR 512
#ifndef DUP_1A
#define DUP_1A 1
#endif
#ifndef DUP_PREP
#define DUP_PREP 1
#endif
#ifndef DUP_2B
#define DUP_2B 1
#endif
#ifndef XRGA
#define XRGA 1
#endif
#ifndef REP_PEER
#define REP_PEER 1
#endif
#ifndef REP_INPROJ
#define REP_INPROJ 1
#endif
#ifndef REP_GATE
#define REP_GATE 1
#endif
#ifndef REP_BRANCH
#define REP_BRANCH 1
#endif
#ifndef REP_Q
#define REP_Q 1
#endif
#ifndef REP_SCORE
#define REP_SCORE 1
#endif
#ifndef REP_1A
#define REP_1A 1
#endif
#ifndef REP_2B
#define REP_2B 1
#endif
#ifndef REP_KF
#define REP_KF 1
#endif
#ifndef DUP_GEMM
#define DUP_GEMM 1
#endif
#ifndef DUP_PEER
#define DUP_PEER 1
#endif
#ifndef DUP_MIX
#define DUP_MIX 1
#endif
#ifndef XRG
#define XRG 1
#endif
#ifndef XFFT
#define XFFT 1
#endif
#ifndef XATT
#define XATT 1
#endif

struct P {
  const float *x, *c, *ctx, *c_ctx, *norm_mix_g, *norm_ffn_g, *w_ada, *b_ada, *w_in, *na_rpb,
      *hy_short_w, *hy_short_b, *hy_f1_w, *hy_f1_b, *hy_f2_w, *hy_f2_b, *hy_f3_w, *hy_freq, *hy_bias,
      *rg_conv_w, *rg_conv_b, *rg_wa, *rg_ba, *rg_wx, *rg_bx, *rg_lambda,
      *w_gate, *b_gate, *w_br_a, *w_br_b, *w_br_c, *w_out, *peer_wq, *peer_keys, *peer_u, *peer_v, *final_g;
  float* out;
  unsigned* counters;
  u16 *WinT, *WgT, *WaT, *WbT, *WcT, *WoT, *WqB, *WqkT, *keysB, *rgW;
  float *modpart, *mod, *hT, *hc;
  float* Kf;
  u16 *xn, *qk, *vT, *vTc, *hyT, *hyTc, *rg, *ycat, *mbuf, *ybT;
  unsigned char *Ub, *Vb, *g8, *xn8, *Win8, *Wg8;
  float *sa, *sw;
  u16* q;
  float *agg, *ctxs;
  unsigned* topk;
};

__device__ __forceinline__ u16 f2bf(float f) {
  unsigned u = __float_as_uint(f);
  u += 0x7fffu + ((u >> 16) & 1u);
  return (u16)(u >> 16);
}
__device__ __forceinline__ float bf2f(u16 h) { return __uint_as_float(((unsigned)h) << 16); }
__device__ __forceinline__ unsigned pk2(float a, float b) { return (unsigned)f2bf(a) | ((unsigned)f2bf(b) << 16); }
__device__ __forceinline__ float bflo(unsigned u) { return __uint_as_float(u << 16); }
__device__ __forceinline__ float bfhi(unsigned u) { return __uint_as_float(u & 0xffff0000u); }
__device__ __forceinline__ int opaque_tid() {
  int t = threadIdx.x;
  asm volatile("" : "+v"(t));
  return t;
}
__device__ __forceinline__ int my_lane() { return opaque_tid() & 63; }
__device__ __forceinline__ float shx(float v, int o);
__device__ __forceinline__ float shf(float v, int src) { return __builtin_bit_cast(float, __builtin_amdgcn_ds_bpermute((src & 63) << 2, __builtin_bit_cast(int, v))); }
__device__ __forceinline__ unsigned shu(unsigned v, int src) { return (unsigned)__builtin_amdgcn_ds_bpermute((src & 63) << 2, (int)v); }
typedef unsigned u32x2_t __attribute__((ext_vector_type(2)));
template <int J> __device__ __forceinline__ unsigned xorl(unsigned v, int lane) {
  if constexpr (J == 1) return (unsigned)__builtin_amdgcn_mov_dpp((int)v, 0xB1, 0xF, 0xF, true);
  else if constexpr (J == 2) return (unsigned)__builtin_amdgcn_mov_dpp((int)v, 0x4E, 0xF, 0xF, true);
  else if constexpr (J == 4) {
    const unsigned a = (unsigned)__builtin_amdgcn_mov_dpp((int)v, 0x104, 0xF, 0xF, true);
    const unsigned b = (unsigned)__builtin_amdgcn_mov_dpp((int)v, 0x114, 0xF, 0xF, true);
    return (lane & 4) ? b : a;
  }
  else if constexpr (J == 8) return (unsigned)__builtin_amdgcn_mov_dpp((int)v, 0x128, 0xF, 0xF, true);
  else if constexpr (J == 16) { const u32x2_t r = __builtin_amdgcn_permlane16_swap(v, v, false, false); return (lane & 16) ? r.x : r.y; }
  else { const u32x2_t r = __builtin_amdgcn_permlane32_swap(v, v, false, false); return (lane & 32) ? r.x : r.y; }
}
template <int J> __device__ __forceinline__ float xorf(float v, int lane) { return __uint_as_float(xorl<J>(__float_as_uint(v), lane)); }
__device__ __forceinline__ float shx(float v, int o) {
  const int lane = my_lane();
  switch (o) {
    case 1: return xorf<1>(v, lane);
    case 2: return xorf<2>(v, lane);
    case 4: return xorf<4>(v, lane);
    case 8: return xorf<8>(v, lane);
    case 16: return xorf<16>(v, lane);
    case 32: return xorf<32>(v, lane);
    default: return __builtin_bit_cast(float, __builtin_amdgcn_ds_bpermute(((lane ^ o) << 2), __builtin_bit_cast(int, v)));
  }
}
__device__ __forceinline__ float wave_sum(float v) {
  const int lane = my_lane();
  v += xorf<32>(v, lane); v += xorf<16>(v, lane); v += xorf<8>(v, lane); v += xorf<4>(v, lane); v += xorf<2>(v, lane); v += xorf<1>(v, lane);
  return v;
}
__device__ __forceinline__ float wave_max(float v) {
  const int lane = my_lane();
  v = fmaxf(v, xorf<32>(v, lane)); v = fmaxf(v, xorf<16>(v, lane)); v = fmaxf(v, xorf<8>(v, lane));
  v = fmaxf(v, xorf<4>(v, lane)); v = fmaxf(v, xorf<2>(v, lane)); v = fmaxf(v, xorf<1>(v, lane));
  return v;
}
__device__ __forceinline__ float sigmoidf_(float x) { return __builtin_amdgcn_rcpf(1.0f + __expf(-x)); }
__device__ __forceinline__ float gelu_tanh(float x) {
  const float u2 = 1.5957691216057308f * (x + 0.044715f * x * x * x);
  return x * __builtin_amdgcn_rcpf(1.0f + __expf(-u2));
}
__device__ __forceinline__ f32x16 mfma32(bf16x8 a, bf16x8 b, f32x16 c) {
  return __builtin_amdgcn_mfma_f32_32x32x16_bf16(a, b, c, 0, 0, 0);
}
__device__ __forceinline__ f32x16 zero16() {
  f32x16 z;
#pragma unroll
  for (int i = 0; i < 16; ++i) z[i] = 0.f;
  return z;
}
__device__ __forceinline__ int swz128(int row, int ch) { return row * 128 + ((ch ^ ((row >> 1) & 7)) << 4); }
__device__ __forceinline__ int swz256(int row, int ch) { return row * 256 + ((ch ^ (row & 15)) << 4); }

struct c2 { float x, y; };
__device__ __forceinline__ c2 cadd(c2 a, c2 b) { return {a.x + b.x, a.y + b.y}; }
__device__ __forceinline__ c2 csub(c2 a, c2 b) { return {a.x - b.x, a.y - b.y}; }
__device__ __forceinline__ c2 cmul(c2 a, c2 b) { return {a.x * b.x - a.y * b.y, a.x * b.y + a.y * b.x}; }
__device__ __forceinline__ float c16(int i) {
  const float tb[16] = {1.0f, 0.9238795325112867f, 0.7071067811865476f, 0.3826834323650898f, 0.0f,
                        -0.3826834323650898f, -0.7071067811865476f, -0.9238795325112867f, -1.0f,
                        -0.9238795325112867f, -0.7071067811865476f, -0.3826834323650898f, 0.0f,
                        0.3826834323650898f, 0.7071067811865476f, 0.9238795325112867f};
  return tb[i & 15];
}
__device__ __forceinline__ float s16(int i) { return c16(i + 12); }
template <int R> __device__ __forceinline__ constexpr int brev(int k) {
  int r = 0;
  for (int b = 1, o = R >> 1; b < R; b <<= 1, o >>= 1)
    if (k & b) r |= o;
  return r;
}
template <int R> __device__ __forceinline__ void dft_reg(c2* v, float sgn) {
#pragma unroll
  for (int h = R / 2; h >= 1; h >>= 1) {
#pragma unroll
    for (int g = 0; g < R; g += 2 * h) {
#pragma unroll
      for (int j = 0; j < h; ++j) {
        c2 a = v[g + j], b = v[g + j + h];
        v[g + j] = cadd(a, b);
        c2 d = csub(a, b);
        const int ti = j * (16 / (2 * h));
        c2 w = {c16(ti), sgn * s16(ti)};
        v[g + j + h] = (j == 0) ? d : cmul(d, w);
      }
    }
  }
}
template <int R> __device__ __forceinline__ int fft_bfly(c2* v, int j, int Ns, float sgn) {
  const int k = j & (Ns - 1);
  const float f = sgn * (float)k / (float)(Ns * R);
#pragma unroll
  for (int r = 1; r < R; ++r) {
    float t = f * (float)r;
    c2 w = {__builtin_amdgcn_cosf(t), __builtin_amdgcn_sinf(t)};
    v[r] = cmul(v[r], w);
  }
  dft_reg<R>(v, sgn);
  return (j - k) * R + k;
}
template <int R> __device__ __forceinline__ void fft_pass(c2* buf, int Ns, float sgn) {
  constexpr int NBF = 8192 / R;
  constexpr int PER = NBF / NTHR;
  const int tid = opaque_tid();
  c2 v[PER][R];
#pragma unroll
  for (int i = 0; i < PER; ++i) {
    const int j = tid + NTHR * i;
#pragma unroll
    for (int r = 0; r < R; ++r) v[i][r] = buf[j + r * NBF];
  }
  __syncthreads();
#pragma unroll
  for (int i = 0; i < PER; ++i) {
    const int j = tid + NTHR * i;
    const int base = fft_bfly<R>(v[i], j, Ns, sgn);
#pragma unroll
    for (int r = 0; r < R; ++r) buf[base + r * Ns] = v[i][brev<R>(r)];
  }
  __syncthreads();
}
__device__ __forceinline__ void fft8192(c2* buf, float sgn) {
  fft_pass<8>(buf, 1, sgn);
  fft_pass<8>(buf, 8, sgn);
  fft_pass<8>(buf, 64, sgn);
  fft_pass<16>(buf, 512, sgn);
}

__device__ __forceinline__ void gemm_kloop(f32x16 (&acc)[2][2], const u16* __restrict__ A, int lda,
                                           const u16* __restrict__ B, int ldb, int K, char* smem) {
  const int tid = opaque_tid(), lane = tid & 63, wid = tid >> 6;
  const int wm = wid >> 1, wn = wid & 1;
  const int l31 = lane & 31, hh = lane >> 5;
  uint4 ra[4], rb[2];
  const int nk = K >> 6;
  const int srow = tid >> 3, sch = tid & 7;
  const char* Ab = (const char*)A;
  const char* Bb = (const char*)B;
  const unsigned aoff = (unsigned)(srow * lda + sch * 8) * 2u;
  const unsigned boff = (unsigned)(srow * ldb + sch * 8) * 2u;
  const unsigned astep = (unsigned)lda * 128u, bstep = (unsigned)ldb * 128u;
#pragma unroll
  for (int i = 0; i < 4; ++i) ra[i] = *(const uint4*)(Ab + (aoff + i * astep));
#pragma unroll
  for (int i = 0; i < 2; ++i) rb[i] = *(const uint4*)(Bb + (boff + i * bstep));
#pragma unroll
  for (int i = 0; i < 4; ++i) *(uint4*)(smem + swz128(srow + i * 64, sch)) = ra[i];
#pragma unroll
  for (int i = 0; i < 2; ++i) *(uint4*)(smem + 65536 + swz128(srow + i * 64, sch)) = rb[i];
  __syncthreads();
  for (int kt = 0; kt < nk; ++kt) {
    const bool more = (kt + 1 < nk);
    if (more) {
      const unsigned ko = (unsigned)(kt + 1) * 128u;
#pragma unroll
      for (int i = 0; i < 4; ++i) ra[i] = *(const uint4*)(Ab + (aoff + i * astep + ko));
#pragma unroll
      for (int i = 0; i < 2; ++i) rb[i] = *(const uint4*)(Bb + (boff + i * bstep + ko));
    }
    const char* as = smem + (kt & 1) * 32768;
    const char* bs = smem + 65536 + (kt & 1) * 16384;
    int lrow = l31;
    asm volatile("" : "+v"(lrow));
#pragma unroll
    for (int s = 0; s < 4; ++s) {
      bf16x8 af[2], bfr[2];
#pragma unroll
      for (int i = 0; i < 2; ++i) af[i] = *(const bf16x8*)(as + swz128(wm * 64 + i * 32 + lrow, s * 2 + hh));
#pragma unroll
      for (int j = 0; j < 2; ++j) bfr[j] = *(const bf16x8*)(bs + swz128(wn * 64 + j * 32 + lrow, s * 2 + hh));
#pragma unroll
      for (int i = 0; i < 2; ++i)
#pragma unroll
        for (int j = 0; j < 2; ++j) acc[i][j] = mfma32(af[i], bfr[j], acc[i][j]);
    }
    if (more) {
      char* an = smem + ((kt + 1) & 1) * 32768;
      char* bn = smem + 65536 + ((kt + 1) & 1) * 16384;
      int sr2 = srow;
      asm volatile("" : "+v"(sr2));
#pragma unroll
      for (int i = 0; i < 4; ++i) *(uint4*)(an + swz128(sr2 + i * 64, sch)) = ra[i];
#pragma unroll
      for (int i = 0; i < 2; ++i) *(uint4*)(bn + swz128(sr2 + i * 64, sch)) = rb[i];
    }
    __syncthreads();
  }
}
__device__ __forceinline__ void zero_acc(f32x16 (&acc)[2][2]) {
#pragma unroll
  for (int i = 0; i < 2; ++i)
#pragma unroll
    for (int j = 0; j < 2; ++j) acc[i][j] = zero16();
}
#define EPI_ROW(i, e) (wm * 64 + (i)*32 + ((e)&3) + 8 * ((e) >> 2) + 4 * hh)
#define EPI_COL(j) (wn * 64 + (j)*32 + l31)
#define EPI_VARS                                                    \
  const int tid = opaque_tid(), lane = tid & 63, wid = tid >> 6;     \
  const int wm = wid >> 1, wn = wid & 1, l31 = lane & 31, hh = lane >> 5; \
  (void)tid; (void)wm; (void)wn; (void)l31; (void)hh;


namespace pg8 {
__device__ __forceinline__ unsigned pkh(float a, float b) { unsigned r; asm("v_cvt_pk_bf16_f32 %0, %1, %2" : "=v"(r) : "v"(a), "v"(b)); return r; }
#define PG8_LAS __attribute__((address_space(3)))
typedef PG8_LAS unsigned char* PG8_LAS_T;
typedef float f32x4 __attribute__((ext_vector_type(4)));
typedef unsigned u32x4 __attribute__((ext_vector_type(4)));
typedef int i32x4 __attribute__((ext_vector_type(4)));
constexpr int BM = 256, BK = 64, HALF = 128, HTB = HALF * BK * 2, STAGE_BYTES = 8 * HTB, NXCD = 8, WGM = 8;
__device__ __forceinline__ int lds_byte(int r, int c) { const int st = (r >> 4) * 2 + (c >> 5), rr = r & 15, cc = c & 31, ob = rr * 64 + cc * 2; return st * 1024 + (ob ^ (((ob >> 9) & 1) << 5)); }
__device__ __forceinline__ void stage_rc(int b, int& R, int& C) { const int st = b / 1024, sb = b % 1024, swz = sb ^ (((sb >> 9) & 1) << 5); R = (st >> 1) * 16 + swz / 64; C = (st & 1) * 32 + (swz % 64) / 2; }
__device__ __forceinline__ int perm32(int rho) { const int n = rho >> 4, i = rho & 15; return 8 * (i >> 2) + 4 * n + (i & 3); }
struct Unit { int pm, pn; };
struct Gemm { const u16* A; const u16* Bt; int lda, ldb, K; };
struct Order {
  int nM, nN, nwg, G, c, skip_from, skip_by;
  __device__ __forceinline__ void init(int nM_, int nN_, int G_, int c_, int sf = 1 << 30, int sb = 0) { nM = nM_; nN = nN_; nwg = nM * nN; G = G_; c = c_; skip_from = sf; skip_by = sb; }
  __device__ __forceinline__ bool next(int i, Unit& u) const {
    const long L = (long)i * G + c; if (L >= nwg) return false;
    int wgid = (int)L; { const int q = nwg / NXCD, r = nwg % NXCD, xcd = wgid % NXCD, off = wgid / NXCD; wgid = (xcd < r ? xcd * (q + 1) : r * (q + 1) + (xcd - r) * q) + off; }
    const int nig = WGM * nN, gid = wgid / nig, fm = gid * WGM, gsz = (nM - fm) < WGM ? (nM - fm) : WGM;
    u.pm = fm + ((wgid % nig) % gsz); u.pn = (wgid % nig) / gsz;
    if (u.pn >= skip_from) u.pn += skip_by;
    return true;
  }
};
__device__ __forceinline__ f32x4 mma16(bf16x8 a, bf16x8 b, f32x4 c) { return __builtin_amdgcn_mfma_f32_16x16x32_bf16(a, b, c, 0, 0, 0); }
__device__ __forceinline__ i32x4 mma16(bf16x8 a, bf16x8 b, i32x4 c) { return __builtin_amdgcn_mfma_i32_16x16x64_i8(__builtin_bit_cast(i32x4, a), __builtin_bit_cast(i32x4, b), c, 0, 0, 0); }
template <class Epi>
__device__ __forceinline__ void gemm_phase(PG8_LAS unsigned char* lds, const Gemm g, const Order& S, const Epi& E) {
  const int tid = opaque_tid(), wid = __builtin_amdgcn_readfirstlane(tid >> 6), lane = tid & 63, wr = wid >> 2, wc = wid & 3, fr = lane & 15, fq = lane >> 4;
  const int K = g.K, nt = K / BK;
  unsigned voffA[2], voffB[2];
#pragma unroll
  for (int i = 0; i < 2; ++i) { int R, C; stage_rc(tid * 16 + i * 8192, R, C); const int Rb = Epi::PERM ? ((R & ~31) + perm32(R & 31)) : R;
    voffA[i] = (unsigned)(R * g.lda + C) * 2u; voffB[i] = (unsigned)(Rb * g.ldb + C) * 2u; }
  const size_t kstep = (size_t)(BK * 2);
  const size_t hstepA = (size_t)HALF * g.lda * 2, hstepB = (size_t)HALF * g.ldb * 2;
  const size_t tstepA = 2 * hstepA, tstepB = 2 * hstepB;
  const unsigned ldsw = (unsigned)wid * 1024u;
  const int aoff = lds_byte(wr * 64 + fr, fq * 8), boff = lds_byte(wc * 32 + fr, fq * 8);
#define PG8_SA(b, h) (((b) * 2 + (h)) * HTB)
#define PG8_SB(b, h) ((4 + (b) * 2 + (h)) * HTB)
#define PG8_STAGE(bufoff, gbase, voff) do { _Pragma("unroll") for (int _i = 0; _i < 2; ++_i) \
    __builtin_amdgcn_global_load_lds((const unsigned*)((const char*)(gbase) + (voff)[_i]), (PG8_LAS unsigned*)(lds + (bufoff) + ldsw + _i * 8192), 16, 0, 0); } while (0)
#define PG8_LDA(dst, b, h) do { _Pragma("unroll") for (int m = 0; m < 4; ++m) _Pragma("unroll") for (int k = 0; k < 2; ++k) dst[m][k] = *(const PG8_LAS bf16x8*)(lds + PG8_SA(b, h) + aoff + m * 2048 + k * 1024); } while (0)
#define PG8_LDB(dst, b, h) do { _Pragma("unroll") for (int n = 0; n < 2; ++n) _Pragma("unroll") for (int k = 0; k < 2; ++k) dst[n][k] = *(const PG8_LAS bf16x8*)(lds + PG8_SB(b, h) + boff + n * 2048 + k * 1024); } while (0)
#define PG8_MMA(ai, bj, At, Bt) do { __builtin_amdgcn_s_setprio(1); _Pragma("unroll") for (int m = 0; m < 4; ++m) _Pragma("unroll") for (int n = 0; n < 2; ++n) _Pragma("unroll") for (int k = 0; k < 2; ++k) \
    acc[ai][bj][m][n] = mma16(Bt[n][k], At[m][k], acc[ai][bj][m][n]); __builtin_amdgcn_s_setprio(0); } while (0)
#define PG8_WAIT_V(n) asm volatile("s_waitcnt vmcnt(" #n ")" ::: "memory")
#define PG8_WAIT_L(n) asm volatile("s_waitcnt lgkmcnt(" #n ")" ::: "memory")
#define PG8_BAR __builtin_amdgcn_s_barrier()
#define PG8_SCHED __builtin_amdgcn_sched_barrier(0)
  Unit cur, nxt; int ui = 0;
  if (!S.next(0, cur)) return;
  typedef typename Epi::acc_t acc_t;
  acc_t acc[2][2][4][2];
#pragma unroll
  for (int a = 0; a < 2; ++a)
#pragma unroll
    for (int b = 0; b < 2; ++b)
#pragma unroll
      for (int m = 0; m < 4; ++m)
#pragma unroll
        for (int n = 0; n < 2; ++n) acc[a][b][m][n] = (acc_t){0, 0, 0, 0};
  bf16x8 At[4][2], B0[2][2], B1[2][2];
  const char* cA = (const char*)g.A + (size_t)cur.pm * tstepA; const char* cB = (const char*)g.Bt + (size_t)cur.pn * tstepB;
  PG8_STAGE(PG8_SB(0, 0), cB, voffB); PG8_STAGE(PG8_SA(0, 0), cA, voffA); PG8_STAGE(PG8_SB(0, 1), cB + hstepB, voffB); PG8_STAGE(PG8_SA(0, 1), cA + hstepA, voffA);
  if (wr == 1) PG8_BAR;
  PG8_WAIT_V(4); PG8_BAR;
  PG8_STAGE(PG8_SB(1, 0), cB + kstep, voffB); PG8_STAGE(PG8_SA(1, 0), cA + kstep, voffA); PG8_STAGE(PG8_SB(1, 1), cB + hstepB + kstep, voffB);
  PG8_WAIT_V(6); PG8_BAR;
  for (;;) {
    const bool has_next = S.next(ui + 1, nxt);
    const char* nA = has_next ? (const char*)g.A + (size_t)nxt.pm * tstepA : cA; const char* nB = has_next ? (const char*)g.Bt + (size_t)nxt.pn * tstepB : cB;
    for (int t = 0; t < nt; t += 2) {
      const bool last = (t == nt - 2);
      const char* a1 = cA + (size_t)(t + 1) * kstep;
      const char* a2 = last ? nA : cA + (size_t)(t + 2) * kstep; const char* b2 = last ? nB : cB + (size_t)(t + 2) * kstep;
      const char* a3 = a2 + kstep; const char* b3 = b2 + kstep;
      PG8_LDB(B0, 0, 0); PG8_SCHED; PG8_LDA(At, 0, 0); PG8_STAGE(PG8_SA(1, 1), a1 + hstepA, voffA);
      PG8_WAIT_L(8); PG8_BAR; PG8_WAIT_L(0); PG8_MMA(0, 0, At, B0); PG8_BAR; PG8_SCHED;
      PG8_LDB(B1, 0, 1); PG8_STAGE(PG8_SB(0, 0), b2, voffB);
      PG8_BAR; PG8_WAIT_L(0); PG8_MMA(0, 1, At, B1); PG8_BAR;
      PG8_LDA(At, 0, 1); PG8_STAGE(PG8_SA(0, 0), a2, voffA);
      PG8_BAR; PG8_WAIT_L(0); PG8_MMA(1, 0, At, B0); PG8_BAR; PG8_SCHED;
      PG8_STAGE(PG8_SB(0, 1), b2 + hstepB, voffB);
      PG8_WAIT_V(6); PG8_BAR; PG8_MMA(1, 1, At, B1); PG8_BAR;
      PG8_LDB(B0, 1, 0); PG8_SCHED; PG8_LDA(At, 1, 0); PG8_STAGE(PG8_SA(0, 1), a2 + hstepA, voffA);
      PG8_WAIT_L(8); PG8_BAR; PG8_WAIT_L(0); PG8_MMA(0, 0, At, B0); PG8_BAR; PG8_SCHED;
      PG8_LDB(B1, 1, 1); PG8_STAGE(PG8_SB(1, 0), b3, voffB);
      PG8_BAR; PG8_WAIT_L(0); PG8_MMA(0, 1, At, B1); PG8_BAR;
      PG8_LDA(At, 1, 1); PG8_STAGE(PG8_SA(1, 0), a3, voffA);
      PG8_BAR; PG8_WAIT_L(0); PG8_MMA(1, 0, At, B0); PG8_BAR; PG8_SCHED;
      PG8_STAGE(PG8_SB(1, 1), b3 + hstepB, voffB);
      PG8_WAIT_V(6); PG8_BAR; PG8_MMA(1, 1, At, B1); PG8_BAR;
    }
    E(acc, cur, wr, wc, fr, fq);
    if (!has_next) break;
#pragma unroll
    for (int a = 0; a < 2; ++a)
#pragma unroll
      for (int b = 0; b < 2; ++b)
#pragma unroll
        for (int m = 0; m < 4; ++m)
#pragma unroll
          for (int n = 0; n < 2; ++n) acc[a][b][m][n] = (acc_t){0, 0, 0, 0};
    cur = nxt; cA = nA; cB = nB; ++ui;
  }
  PG8_WAIT_V(0);
  if (wr == 0) PG8_BAR;
  PG8_BAR;
#undef PG8_SA
#undef PG8_SB
#undef PG8_STAGE
#undef PG8_LDA
#undef PG8_LDB
#undef PG8_MMA
#undef PG8_WAIT_V
#undef PG8_WAIT_L
#undef PG8_BAR
#undef PG8_SCHED
}
typedef const f32x4 (&AccRef)[2][2][4][2];
typedef const i32x4 (&AccRefI)[2][2][4][2];
struct EpiInprojN {
  static constexpr bool PERM = true;
  typedef f32x4 acc_t;
  u16* qk; u16* rg;
  __device__ __forceinline__ void operator()(AccRef acc, const Unit& u, int wr, int wc, int fr, int fq) const {
    const int row0 = u.pm * BM + wr * 64 + fr;
    u16* base; int ld, colt;
    if (u.pn < 4) { base = qk; ld = 1024; colt = u.pn * 256; } else { base = rg; ld = 512; colt = (u.pn - 9) * 256; }
    const int col0 = colt + wc * 32 + 8 * fq;
#pragma unroll
    for (int ai = 0; ai < 2; ++ai)
#pragma unroll
      for (int m = 0; m < 4; ++m) {
        u16* rowp = base + (size_t)(row0 + ai * HALF + m * 16) * ld + col0;
#pragma unroll
        for (int bj = 0; bj < 2; ++bj) {
          const f32x4 v0 = acc[ai][bj][m][0], v1 = acc[ai][bj][m][1];
          u32x4 w; w.x = pkh(v0[0], v0[1]); w.y = pkh(v0[2], v0[3]); w.z = pkh(v1[0], v1[1]); w.w = pkh(v1[2], v1[3]);
          *(u32x4*)(rowp + bj * HALF) = w;
        }
      }
  }
};
struct EpiInprojT {
  static constexpr bool PERM = true;
  typedef f32x4 acc_t;
  u16 *vT, *vTc, *hyT, *hyTc;
  __device__ __forceinline__ void operator()(AccRef acc, const Unit& u, int wr, int wc, int fr, int fq) const {
    const bool isctx = (u.pn >= 128);
    const int b = isctx ? (u.pn - 128) : (u.pn >> 4);
    const int Lseg = isctx ? 256 : 4096, t0 = isctx ? 0 : (u.pn & 15) * 256;
    const bool isv = (u.pm < 2);
    const size_t boff = isv ? (isctx ? (size_t)16777216 : (size_t)0) : (isctx ? (size_t)(16777216 + 1048576 + 25165824) : (size_t)(16777216 + 1048576));
    u16* base = vT + boff;
    const int nc = isv ? 512 : 768;
    const int wrow0 = (isv ? u.pm : u.pm - 2) * BM + wr * 64 + fr;
    const int col0 = t0 + wc * 32 + 8 * fq;
#pragma unroll
    for (int ai = 0; ai < 2; ++ai)
#pragma unroll
      for (int m = 0; m < 4; ++m) {
        u16* rowp = base + ((size_t)(b * nc + wrow0 + ai * HALF + m * 16)) * Lseg + col0;
#pragma unroll
        for (int bj = 0; bj < 2; ++bj) {
          const f32x4 v0 = acc[ai][bj][m][0], v1 = acc[ai][bj][m][1];
          u32x4 w; w.x = pkh(v0[0], v0[1]); w.y = pkh(v0[2], v0[3]); w.z = pkh(v1[0], v1[1]); w.w = pkh(v1[2], v1[3]);
          *(u32x4*)(rowp + bj * HALF) = w;
        }
      }
  }
};
struct EpiGate {
  static constexpr bool PERM = true;
  typedef f32x4 acc_t;
  unsigned char* g8; const float* bias;
  __device__ __forceinline__ void operator()(AccRef acc, const Unit& u, int wr, int wc, int fr, int fq) const {
    const int row0 = u.pm * BM + wr * 64 + fr;
    const int col0 = u.pn * BM + wc * 32 + 8 * fq;
#pragma unroll
    for (int bj = 0; bj < 2; ++bj) {
      const f32x4 b0 = *(const f32x4*)(bias + col0 + bj * HALF), b1 = *(const f32x4*)(bias + col0 + bj * HALF + 4);
#pragma unroll
      for (int ai = 0; ai < 2; ++ai)
#pragma unroll
        for (int m = 0; m < 4; ++m) {
          const f32x4 v0 = acc[ai][bj][m][0] + b0, v1 = acc[ai][bj][m][1] + b1;
          unsigned w0 = 0, w1 = 0;
#pragma unroll
          for (int k = 0; k < 4; ++k) {
            w0 |= (unsigned)(sigmoidf_(v0[k]) * 255.0f + 0.5f) << (8 * k);
            w1 |= (unsigned)(sigmoidf_(v1[k]) * 255.0f + 0.5f) << (8 * k);
          }
          *(uint2*)(g8 + (size_t)(row0 + ai * HALF + m * 16) * 3072 + col0 + bj * HALF) = make_uint2(w0, w1);
        }
    }
  }
};
struct EpiBranch {
  static constexpr bool PERM = true;
  typedef f32x4 acc_t;
  u16* mbuf; const unsigned char* g8; int br;
  __device__ __forceinline__ void operator()(AccRef acc, const Unit& u, int wr, int wc, int fr, int fq) const {
    const int row0 = u.pm * BM + wr * 64 + fr;
    const int col0 = u.pn * BM + wc * 32 + 8 * fq;
#pragma unroll
    for (int ai = 0; ai < 2; ++ai)
#pragma unroll
      for (int m = 0; m < 4; ++m) {
        const size_t row = (size_t)(row0 + ai * HALF + m * 16);
#pragma unroll
        for (int bj = 0; bj < 2; ++bj) {
          const uint2 gq = *(const uint2*)(g8 + row * 3072 + br * 1024 + col0 + bj * HALF);
          u16* mp = mbuf + row * 1024 + col0 + bj * HALF;
          const f32x4 v0 = acc[ai][bj][m][0], v1 = acc[ai][bj][m][1];
          float r[8];
          r[0] = (float)(gq.x & 255u) * v0[0]; r[1] = (float)((gq.x >> 8) & 255u) * v0[1];
          r[2] = (float)((gq.x >> 16) & 255u) * v0[2]; r[3] = (float)(gq.x >> 24) * v0[3];
          r[4] = (float)(gq.y & 255u) * v1[0]; r[5] = (float)((gq.y >> 8) & 255u) * v1[1];
          r[6] = (float)((gq.y >> 16) & 255u) * v1[2]; r[7] = (float)(gq.y >> 24) * v1[3];
          u32x4 w;
          if (br == 0) {
            w.x = pkh(r[0] * (1.f / 255.f), r[1] * (1.f / 255.f)); w.y = pkh(r[2] * (1.f / 255.f), r[3] * (1.f / 255.f));
            w.z = pkh(r[4] * (1.f / 255.f), r[5] * (1.f / 255.f)); w.w = pkh(r[6] * (1.f / 255.f), r[7] * (1.f / 255.f));
          } else {
            const u32x4 o = *(const u32x4*)mp;
            w.x = pkh(bflo(o.x) + r[0] * (1.f / 255.f), bfhi(o.x) + r[1] * (1.f / 255.f));
            w.y = pkh(bflo(o.y) + r[2] * (1.f / 255.f), bfhi(o.y) + r[3] * (1.f / 255.f));
            w.z = pkh(bflo(o.z) + r[4] * (1.f / 255.f), bfhi(o.z) + r[5] * (1.f / 255.f));
            w.w = pkh(bflo(o.w) + r[6] * (1.f / 255.f), bfhi(o.w) + r[7] * (1.f / 255.f));
          }
          *(u32x4*)mp = w;
        }
      }
  }
};
struct EpiOut {
  static constexpr bool PERM = false;
  typedef f32x4 acc_t;
  const float *xsrc, *csrc; float *xdst, *cdst; const float* modl;
  __device__ __forceinline__ void operator()(AccRef acc, const Unit& u, int wr, int wc, int fr, int fq) const {
    const bool isctx = (u.pm >= 128);
    const int bi = isctx ? 8 : (u.pm >> 4);
    const float* gatev = modl + ((size_t)bi * 6 + 2) * 1024;
    const float* src = isctx ? (csrc - (size_t)NLAT * 1024) : xsrc;
    float* dst = isctx ? (cdst - (size_t)NLAT * 1024) : xdst;
    const int row0 = u.pm * BM + wr * 64 + fr, col0 = u.pn * BM + wc * 32 + 4 * fq;
#pragma unroll
    for (int bj = 0; bj < 2; ++bj)
#pragma unroll
      for (int n = 0; n < 2; ++n) {
        const int col = col0 + bj * HALF + n * 16;
        const f32x4 gv = *(const f32x4*)(gatev + col);
#pragma unroll
        for (int ai = 0; ai < 2; ++ai)
#pragma unroll
          for (int m = 0; m < 4; ++m) {
            const size_t o = (size_t)(row0 + ai * HALF + m * 16) * 1024 + col;
            const f32x4 xv = *(const f32x4*)(src + o);
            *(f32x4*)(dst + o) = xv + gv * acc[ai][bj][m][n];
          }
      }
  }
};
struct EpiQ {
  static constexpr bool PERM = true;
  typedef f32x4 acc_t;
  u16* q;
  __device__ __forceinline__ void operator()(AccRef acc, const Unit& u, int wr, int wc, int fr, int fq) const {
    const int row0 = u.pm * BM + wr * 64 + fr;
    const int col0 = u.pn * BM + wc * 32 + 8 * fq;
#pragma unroll
    for (int ai = 0; ai < 2; ++ai)
#pragma unroll
      for (int m = 0; m < 4; ++m) {
        u16* rowp = q + (size_t)(row0 + ai * HALF + m * 16) * 2048 + col0;
#pragma unroll
        for (int bj = 0; bj < 2; ++bj) {
          const f32x4 v0 = acc[ai][bj][m][0], v1 = acc[ai][bj][m][1];
          u32x4 w;
          w.x = __builtin_bit_cast(unsigned, __builtin_amdgcn_cvt_pkrtz(v0[0], v0[1]));
          w.y = __builtin_bit_cast(unsigned, __builtin_amdgcn_cvt_pkrtz(v0[2], v0[3]));
          w.z = __builtin_bit_cast(unsigned, __builtin_amdgcn_cvt_pkrtz(v1[0], v1[1]));
          w.w = __builtin_bit_cast(unsigned, __builtin_amdgcn_cvt_pkrtz(v1[2], v1[3]));
          *(u32x4*)(rowp + bj * HALF) = w;
        }
      }
  }
};
struct EpiInprojN8 {
  static constexpr bool PERM = true;
  typedef i32x4 acc_t;
  u16* qk; u16* rg; const float* sa; const float* sw;
  __device__ __forceinline__ void operator()(AccRefI acc, const Unit& u, int wr, int wc, int fr, int fq) const {
    const int row0 = u.pm * BM + wr * 64 + fr;
    u16* base; int ld, colt;
    if (u.pn < 4) { base = qk; ld = 1024; colt = u.pn * 256; } else { base = rg; ld = 512; colt = (u.pn - 9) * 256; }
    const int col0 = colt + wc * 32 + 8 * fq;
    const int wcol0 = u.pn * 256 + wc * 32 + 8 * fq;
#pragma unroll
    for (int bj = 0; bj < 2; ++bj) {
      const f32x4 c0 = *(const f32x4*)(sw + wcol0 + bj * HALF), c1 = *(const f32x4*)(sw + wcol0 + bj * HALF + 4);
#pragma unroll
      for (int ai = 0; ai < 2; ++ai)
#pragma unroll
        for (int m = 0; m < 4; ++m) {
          const int row = row0 + ai * HALF + m * 16;
          const float rs = sa[row];
          const i32x4 a0 = acc[ai][bj][m][0], a1 = acc[ai][bj][m][1];
          u32x4 w;
          w.x = pkh((float)a0[0] * rs * c0[0], (float)a0[1] * rs * c0[1]); w.y = pkh((float)a0[2] * rs * c0[2], (float)a0[3] * rs * c0[3]);
          w.z = pkh((float)a1[0] * rs * c1[0], (float)a1[1] * rs * c1[1]); w.w = pkh((float)a1[2] * rs * c1[2], (float)a1[3] * rs * c1[3]);
          *(u32x4*)(base + (size_t)row * ld + col0 + bj * HALF) = w;
        }
    }
  }
};
struct EpiInprojT8 {
  static constexpr bool PERM = true;
  typedef i32x4 acc_t;
  u16* vT; const float* sa; const float* sw;
  __device__ __forceinline__ void operator()(AccRefI acc, const Unit& u, int wr, int wc, int fr, int fq) const {
    const bool isctx = (u.pn >= 128);
    const int b = isctx ? (u.pn - 128) : (u.pn >> 4);
    const int Lseg = isctx ? 256 : 4096, t0 = isctx ? 0 : (u.pn & 15) * 256;
    const bool isv = (u.pm < 2);
    const size_t boff = isv ? (isctx ? (size_t)16777216 : (size_t)0) : (isctx ? (size_t)(16777216 + 1048576 + 25165824) : (size_t)(16777216 + 1048576));
    u16* base = vT + boff;
    const int nc = isv ? 512 : 768;
    const int wrow0 = (isv ? u.pm : u.pm - 2) * BM + wr * 64 + fr;
    const int srow0 = u.pm * BM + wr * 64 + fr;
    const int col0 = t0 + wc * 32 + 8 * fq;
    const int tok0 = u.pn * BM + wc * 32 + 8 * fq;
#pragma unroll
    for (int bj = 0; bj < 2; ++bj) {
      const f32x4 c0 = *(const f32x4*)(sa + tok0 + bj * HALF), c1 = *(const f32x4*)(sa + tok0 + bj * HALF + 4);
#pragma unroll
      for (int ai = 0; ai < 2; ++ai)
#pragma unroll
        for (int m = 0; m < 4; ++m) {
          const float rs = sw[srow0 + ai * HALF + m * 16];
          const i32x4 a0 = acc[ai][bj][m][0], a1 = acc[ai][bj][m][1];
          u32x4 w;
          w.x = pkh((float)a0[0] * rs * c0[0], (float)a0[1] * rs * c0[1]); w.y = pkh((float)a0[2] * rs * c0[2], (float)a0[3] * rs * c0[3]);
          w.z = pkh((float)a1[0] * rs * c1[0], (float)a1[1] * rs * c1[1]); w.w = pkh((float)a1[2] * rs * c1[2], (float)a1[3] * rs * c1[3]);
          *(u32x4*)(base + ((size_t)(b * nc + wrow0 + ai * HALF + m * 16)) * Lseg + col0 + bj * HALF) = w;
        }
    }
  }
};
struct EpiGate8 {
  static constexpr bool PERM = true;
  typedef i32x4 acc_t;
  unsigned char* g8; const float* bias; const float* sa; const float* sw;
  __device__ __forceinline__ void operator()(AccRefI acc, const Unit& u, int wr, int wc, int fr, int fq) const {
    const int row0 = u.pm * BM + wr * 64 + fr;
    const int col0 = u.pn * BM + wc * 32 + 8 * fq;
#pragma unroll
    for (int bj = 0; bj < 2; ++bj) {
      const f32x4 b0 = *(const f32x4*)(bias + col0 + bj * HALF), b1 = *(const f32x4*)(bias + col0 + bj * HALF + 4);
      const f32x4 c0 = *(const f32x4*)(sw + col0 + bj * HALF), c1 = *(const f32x4*)(sw + col0 + bj * HALF + 4);
#pragma unroll
      for (int ai = 0; ai < 2; ++ai)
#pragma unroll
        for (int m = 0; m < 4; ++m) {
          const int row = row0 + ai * HALF + m * 16;
          const float rs = sa[row];
          const i32x4 a0 = acc[ai][bj][m][0], a1 = acc[ai][bj][m][1];
          unsigned w0 = 0, w1 = 0;
#pragma unroll
          for (int k = 0; k < 4; ++k) {
            w0 |= (unsigned)(sigmoidf_((float)a0[k] * rs * c0[k] + b0[k]) * 255.0f + 0.5f) << (8 * k);
            w1 |= (unsigned)(sigmoidf_((float)a1[k] * rs * c1[k] + b1[k]) * 255.0f + 0.5f) << (8 * k);
          }
          *(uint2*)(g8 + (size_t)row * 3072 + col0 + bj * HALF) = make_uint2(w0, w1);
        }
    }
  }
};
}

__device__ __forceinline__ void tr_tile(const float* __restrict__ src, int N, int K, u16* __restrict__ dst, int tile, char* smem) {
  float* lds = (float*)smem;
  const int tiles_n = N >> 6;
  const int tk = tile / tiles_n, tn = tile - tk * tiles_n;
  const int tid = opaque_tid();
  {
    const int r = tid >> 3, c8 = (tid & 7) * 8;
    const float* s = src + (size_t)(tk * 64 + r) * N + tn * 64 + c8;
    float4 a = *(const float4*)s, b = *(const float4*)(s + 4);
    float* d = lds + r * 65 + c8;
    d[0] = a.x; d[1] = a.y; d[2] = a.z; d[3] = a.w; d[4] = b.x; d[5] = b.y; d[6] = b.z; d[7] = b.w;
  }
  __syncthreads();
  {
    const int n = tid >> 3, k0 = (tid & 7) * 8;
    uint4 o;
    o.x = pk2(lds[(k0 + 0) * 65 + n], lds[(k0 + 1) * 65 + n]);
    o.y = pk2(lds[(k0 + 2) * 65 + n], lds[(k0 + 3) * 65 + n]);
    o.z = pk2(lds[(k0 + 4) * 65 + n], lds[(k0 + 5) * 65 + n]);
    o.w = pk2(lds[(k0 + 6) * 65 + n], lds[(k0 + 7) * 65 + n]);
    *(uint4*)(dst + (size_t)(tn * 64 + n) * K + tk * 64 + k0) = o;
  }
  __syncthreads();
}
__device__ __forceinline__ void colmax_task(const float* __restrict__ w, int N, int n0, float* __restrict__ swp, char* smem) {
  const int tid = opaque_tid();
  const int col = tid & 63, kg = tid >> 6;
  float m = 0.f;
  const float* wp = w + (size_t)(kg * 128) * N + n0 + col;
#pragma unroll 16
  for (int k = 0; k < 128; ++k) m = fmaxf(m, fabsf(wp[(size_t)k * N]));
  float* red = (float*)smem;
  red[kg * 64 + col] = m;
  __syncthreads();
  if (tid < 64) {
    float mm = red[tid];
#pragma unroll
    for (int g = 1; g < 8; ++g) mm = fmaxf(mm, red[g * 64 + tid]);
    swp[n0 + tid] = fmaxf(mm, 1e-20f) * (1.0f / 127.0f);
  }
  __syncthreads();
}
__device__ __forceinline__ void tr_tile_i8(const float* __restrict__ src, int N, int K, unsigned char* __restrict__ dst, int tile, const float* __restrict__ swp, char* smem) {
  float* lds = (float*)smem;
  const int tiles_n = N >> 6;
  const int tk = tile / tiles_n, tn = tile - tk * tiles_n;
  const int tid = opaque_tid();
  {
    const int r = tid >> 3, c8 = (tid & 7) * 8;
    const float* sp = src + (size_t)(tk * 64 + r) * N + tn * 64 + c8;
    float4 a = *(const float4*)sp, b = *(const float4*)(sp + 4);
    float* d = lds + r * 65 + c8;
    d[0] = a.x; d[1] = a.y; d[2] = a.z; d[3] = a.w; d[4] = b.x; d[5] = b.y; d[6] = b.z; d[7] = b.w;
  }
  __syncthreads();
  {
    const int n = tid >> 3, k0 = (tid & 7) * 8;
    const float inv = 1.0f / swp[tn * 64 + n];
    unsigned w0 = 0, w1 = 0;
#pragma unroll
    for (int i = 0; i < 4; ++i) {
      w0 |= ((unsigned)__float2int_rn(lds[(k0 + i) * 65 + n] * inv) & 255u) << (8 * i);
      w1 |= ((unsigned)__float2int_rn(lds[(k0 + 4 + i) * 65 + n] * inv) & 255u) << (8 * i);
    }
    *(uint2*)(dst + (size_t)(tn * 64 + n) * K + tk * 64 + k0) = make_uint2(w0, w1);
  }
  __syncthreads();
}
__device__ __forceinline__ void cvt_chunk(const float* __restrict__ src, u16* __restrict__ dst, size_t chunk) {
  const size_t i = chunk * 4096 + (size_t)opaque_tid() * 8;
  float4 a = *(const float4*)(src + i), b = *(const float4*)(src + i + 4);
  uint4 o;
  o.x = pk2(a.x, a.y); o.y = pk2(a.z, a.w); o.z = pk2(b.x, b.y); o.w = pk2(b.z, b.w);
  *(uint4*)(dst + i) = o;
}
__device__ __forceinline__ void cvt_chunk_fp8(const float* __restrict__ src, unsigned char* __restrict__ dst, size_t chunk, float scale) {
  const size_t i = chunk * 4096 + (size_t)opaque_tid() * 8;
  const float4 a = *(const float4*)(src + i), b = *(const float4*)(src + i + 4);
  int w0 = __builtin_amdgcn_cvt_pk_fp8_f32(a.x * scale, a.y * scale, 0, false);
  w0 = __builtin_amdgcn_cvt_pk_fp8_f32(a.z * scale, a.w * scale, w0, true);
  int w1 = __builtin_amdgcn_cvt_pk_fp8_f32(b.x * scale, b.y * scale, 0, false);
  w1 = __builtin_amdgcn_cvt_pk_fp8_f32(b.z * scale, b.w * scale, w1, true);
  *(uint2*)(dst + i) = make_uint2((unsigned)w0, (unsigned)w1);
}
__device__ __forceinline__ void cvt_chunk_fp4(const float* __restrict__ src, unsigned char* __restrict__ dst, size_t chunk, float scale, int vhalf) {
  const size_t i = chunk * 4096 + (size_t)opaque_tid() * 8;
  const float4 a = *(const float4*)(src + i), b = *(const float4*)(src + i + 4);
  unsigned w = 0;
  w = __builtin_amdgcn_cvt_scalef32_pk_fp4_f32(w, a.x * scale, a.y * scale, 1.0f, 0);
  w = __builtin_amdgcn_cvt_scalef32_pk_fp4_f32(w, a.z * scale, a.w * scale, 1.0f, 1);
  w = __builtin_amdgcn_cvt_scalef32_pk_fp4_f32(w, b.x * scale, b.y * scale, 1.0f, 2);
  w = __builtin_amdgcn_cvt_scalef32_pk_fp4_f32(w, b.z * scale, b.w * scale, 1.0f, 3);
  const size_t e = i >> 10;
  const unsigned d = (unsigned)(i & 1023);
  *(unsigned*)(dst + e * 1024 + vhalf * 512 + (d >> 1)) = w;
}
__device__ __forceinline__ void phase_prep(const P& p, char* smem) {
  const int tid = opaque_tid();
  const int NTR = 2512;
  const int total = 2 * NTR + 128 + 384;
  for (int task = blockIdx.x; task < total; task += gridDim.x) {
    if (task < 2 * NTR) {
      const int l = task / NTR;
      int t = task - l * NTR;
      if (t < 704) { if (t < 44) colmax_task(p.w_in + (size_t)l * 1024 * 2816, 2816, t * 64, p.sw + l * 5888, smem); }
      else if ((t -= 704) < 768) { if (t < 48) colmax_task(p.w_gate + (size_t)l * 1024 * 3072, 3072, t * 64, p.sw + l * 5888 + 2816, smem); }
      else if ((t -= 768) < 128) tr_tile(p.w_br_a + (size_t)l * 512 * 1024, 1024, 512, p.WaT + (size_t)l * 1024 * 512, t, smem);
      else if ((t -= 128) < 64) tr_tile(p.w_br_b + (size_t)l * 256 * 1024, 1024, 256, p.WbT + (size_t)l * 1024 * 256, t, smem);
      else if ((t -= 64) < 64) tr_tile(p.w_br_c + (size_t)l * 256 * 1024, 1024, 256, p.WcT + (size_t)l * 1024 * 256, t, smem);
      else if ((t -= 64) < 256) tr_tile(p.w_out + (size_t)l * 1024 * 1024, 1024, 1024, p.WoT + (size_t)l * 1024 * 1024, t, smem);
      else if ((t -= 256) < 512) cvt_chunk(p.peer_wq + (size_t)l * 1024 * 2048, p.WqB + (size_t)l * 1024 * 2048, (size_t)t);
      else {
        t -= 512;
        const int gate = t >> 3, dn = t & 7;
        const float* src = (gate ? p.rg_wx : p.rg_wa) + (size_t)(l * 8 + dn) * 4096;
        tr_tile(src, 64, 64, p.rgW + (size_t)((l * 2 + gate) * 8 + dn) * 4096, 0, smem);
      }
    } else if (task < 2 * NTR + 128) {
      cvt_chunk(p.peer_keys, p.keysB, (size_t)(task - 2 * NTR));
    } else {
      int t = task - 2 * NTR - 128;
      const int kc = t & 15; t >>= 4;
      const int jc = t % 12, l = t / 12;
      float* s = (float*)smem;
      for (int i = tid; i < 576; i += NTHR) {
        const int bi = i >> 6, kk = i & 63;
        const float v = (bi < 8) ? p.c[bi * 1024 + kc * 64 + kk] : p.c_ctx[kc * 64 + kk];
        s[i] = v / (1.0f + __expf(-v));
      }
      __syncthreads();
      const int j = jc * 512 + tid;
      float acc[9];
#pragma unroll
      for (int bi = 0; bi < 9; ++bi) acc[bi] = 0.f;
      const float* wp = p.w_ada + ((size_t)l * 1024 + kc * 64) * 6144 + j;
#pragma unroll 8
      for (int kk = 0; kk < 64; ++kk) {
        const float w = wp[(size_t)kk * 6144];
#pragma unroll
        for (int bi = 0; bi < 9; ++bi) acc[bi] += s[bi * 64 + kk] * w;
      }
#pragma unroll
      for (int bi = 0; bi < 9; ++bi) p.modpart[((size_t)(kc * 2 + l) * 9 + bi) * 6144 + j] = acc[bi];
      __syncthreads();
    }
  }
}
__device__ __forceinline__ void phase_modreduce(const P& p) {
  const int n = 2 * 9 * 6144;
  for (int i = blockIdx.x * NTHR + opaque_tid(); i < n; i += gridDim.x * NTHR) {
    const int l = i / (9 * 6144);
    const int j = i % 6144;
    float s = p.b_ada[l * 6144 + j];
#pragma unroll
    for (int kc = 0; kc < 16; ++kc) s += p.modpart[(size_t)kc * n + i];
    p.mod[i] = s;
  }
}

__device__ __forceinline__ void phase_norm(const P& p, int l, int which) {
  const int tid_ = opaque_tid(); const int lane = tid_ & 63, wid = tid_ >> 6;
  const int ntok = (which == 2 || (which == 1 && l == 1)) ? NLAT : NTOK;
  for (int row = blockIdx.x * 8 + wid; row < ntok; row += gridDim.x * 8) {
    const float* src;
    if (row < NLAT) src = ((which == 0 && l == 0) ? p.x : p.out) + (size_t)row * 1024;
    else src = ((which == 0 && l == 0) ? p.ctx : p.ctxs) + (size_t)(row - NLAT) * 1024;
    float4 v[4];
    float ss = 0.f;
#pragma unroll
    for (int i = 0; i < 4; ++i) {
      v[i] = *(const float4*)(src + i * 256 + lane * 4);
      ss += v[i].x * v[i].x + v[i].y * v[i].y + v[i].z * v[i].z + v[i].w * v[i].w;
    }
    ss = wave_sum(ss);
    const float rstd = rsqrtf(ss * (1.0f / 1024.0f) + 1e-6f);
    if (which == 2) {
#pragma unroll
      for (int i = 0; i < 4; ++i) {
        const int col = i * 256 + lane * 4;
        const float4 g = *(const float4*)(p.final_g + col);
        float4 o = {v[i].x * rstd * g.x, v[i].y * rstd * g.y, v[i].z * rstd * g.z, v[i].w * rstd * g.w};
        *(float4*)(p.out + (size_t)row * 1024 + col) = o;
      }
    } else {
      const int bi = row < NLAT ? (row >> 12) : 8;
      const float* gam = (which == 0 ? p.norm_mix_g : p.norm_ffn_g) + l * 1024;
      const float* msh = p.mod + ((size_t)(l * 9 + bi) * 6 + (which == 0 ? 0 : 3)) * 1024;
      const float* msc = msh + 1024;
      float4 y[4];
      float amax = 0.f;
#pragma unroll
      for (int i = 0; i < 4; ++i) {
        const int col = i * 256 + lane * 4;
        const float4 g = *(const float4*)(gam + col);
        const float4 sh = *(const float4*)(msh + col);
        const float4 sc = *(const float4*)(msc + col);
        y[i].x = v[i].x * rstd * g.x * (1.f + sc.x) + sh.x; y[i].y = v[i].y * rstd * g.y * (1.f + sc.y) + sh.y;
        y[i].z = v[i].z * rstd * g.z * (1.f + sc.z) + sh.z; y[i].w = v[i].w * rstd * g.w * (1.f + sc.w) + sh.w;
        amax = fmaxf(amax, fmaxf(fmaxf(fabsf(y[i].x), fabsf(y[i].y)), fmaxf(fabsf(y[i].z), fabsf(y[i].w))));
      }
      if (which == 0) {
        amax = fmaxf(wave_max(amax), 1e-20f);
        const float inv = 127.0f / amax;
#pragma unroll
        for (int i = 0; i < 4; ++i) {
          const unsigned w = ((unsigned)__float2int_rn(y[i].x * inv) & 255u) | (((unsigned)__float2int_rn(y[i].y * inv) & 255u) << 8) |
                             (((unsigned)__float2int_rn(y[i].z * inv) & 255u) << 16) | (((unsigned)__float2int_rn(y[i].w * inv) & 255u) << 24);
          *(unsigned*)(p.xn8 + (size_t)row * 1024 + i * 256 + lane * 4) = w;
        }
        if (lane == 0) p.sa[row] = amax * (1.0f / 127.0f);
      } else {
#pragma unroll
        for (int i = 0; i < 4; ++i) {
          uint2 o;
          o.x = pk2(y[i].x, y[i].y);
          o.y = pk2(y[i].z, y[i].w);
          *(uint2*)(p.xn + (size_t)row * 1024 + i * 256 + lane * 4) = o;
        }
      }
    }
  }
}

__device__ __forceinline__ void filter_wave(const P& p, int l, int L, int t, float* __restrict__ outp) {
  const int lane = opaque_tid() & 63;
  const float tl = (float)t / (float)(L - 1);
  const float wang = (6.283185307179586f / (float)L) * (float)t;
  float z = 0.f;
  if (lane == 0) z = tl;
  else if (lane <= 16) { const float band = 1e-4f + (float)(lane - 1) * ((15.0f - 1e-4f) / 15.0f); z = cosf(band * wang); }
  else if (lane <= 32) { const float band = 1e-4f + (float)(lane - 17) * ((15.0f - 1e-4f) / 15.0f); z = -sinf(band * wang); }
  float a1 = p.hy_f1_b[l * 64 + lane];
  for (int i = 0; i < 33; ++i) a1 += shf(z, i) * p.hy_f1_w[(l * 33 + i) * 64 + lane];
  const float h1 = sinf(p.hy_freq[l * 128 + lane] * a1);
  float a2 = p.hy_f2_b[l * 64 + lane];
  for (int i = 0; i < 64; ++i) a2 += shf(h1, i) * p.hy_f2_w[(l * 64 + i) * 64 + lane];
  const float h2 = sinf(p.hy_freq[l * 128 + 64 + lane] * a2);
  float a3[8];
#pragma unroll
  for (int m = 0; m < 8; ++m) a3[m] = 0.f;
  for (int i = 0; i < 64; ++i) {
    const float hv = shf(h2, i);
    const float* wr = p.hy_f3_w + (size_t)(l * 64 + i) * 512 + lane;
#pragma unroll
    for (int m = 0; m < 8; ++m) a3[m] += hv * wr[m * 64];
  }
  const float LN100 = 4.605170185988092f;
  const float d0 = LN100 / 1.5f, d1 = LN100 / 0.3f;
#pragma unroll
  for (int m = 0; m < 8; ++m) {
    const int cp = lane + 64 * m;
    const int ch = cp & 255;
    const float delta = d0 + (float)ch * ((d1 - d0) / 255.0f);
    outp[(size_t)cp * L + t] = a3[m] * expf(-tl * delta);
  }
}
__device__ __forceinline__ void filter_block_task(const P& p, int l, int L, int t0, float* __restrict__ outp, char* smem) {
  const int tid = opaque_tid(), lane = tid & 63, wid = tid >> 6;
  float* W3s = (float*)smem;
  float* W2s = (float*)(smem + 131072);
  {
    const float4* s3 = (const float4*)(p.hy_f3_w + (size_t)l * 64 * 512);
    const float4* s2 = (const float4*)(p.hy_f2_w + (size_t)l * 64 * 64);
#pragma unroll
    for (int i = 0; i < 16; ++i) ((float4*)W3s)[tid + NTHR * i] = s3[tid + NTHR * i];
#pragma unroll
    for (int i = 0; i < 2; ++i) ((float4*)W2s)[tid + NTHR * i] = s2[tid + NTHR * i];
  }
  __syncthreads();
  float z[4], tl[4];
#pragma unroll
  for (int j = 0; j < 4; ++j) {
    const int t = t0 + wid * 4 + j;
    tl[j] = (float)t / (float)(L - 1);
    const float wang = (6.283185307179586f / (float)L) * (float)t;
    float zz = 0.f;
    if (lane == 0) zz = tl[j];
    else if (lane <= 16) { const float band = 1e-4f + (float)(lane - 1) * ((15.0f - 1e-4f) / 15.0f); zz = cosf(band * wang); }
    else if (lane <= 32) { const float band = 1e-4f + (float)(lane - 17) * ((15.0f - 1e-4f) / 15.0f); zz = -sinf(band * wang); }
    z[j] = zz;
  }
  float a1[4], a2[4];
  {
    const float b1 = p.hy_f1_b[l * 64 + lane];
#pragma unroll
    for (int j = 0; j < 4; ++j) a1[j] = b1;
#pragma unroll 11
    for (int i = 0; i < 33; ++i) {
      const float w = p.hy_f1_w[(l * 33 + i) * 64 + lane];
#pragma unroll
      for (int j = 0; j < 4; ++j) a1[j] += shf(z[j], i) * w;
    }
    const float f0 = p.hy_freq[l * 128 + lane];
#pragma unroll
    for (int j = 0; j < 4; ++j) a1[j] = sinf(f0 * a1[j]);
  }
  {
    const float b2 = p.hy_f2_b[l * 64 + lane];
#pragma unroll
    for (int j = 0; j < 4; ++j) a2[j] = b2;
#pragma unroll 8
    for (int i = 0; i < 64; ++i) {
      const float w = W2s[i * 64 + lane];
#pragma unroll
      for (int j = 0; j < 4; ++j) a2[j] += shf(a1[j], i) * w;
    }
    const float f1 = p.hy_freq[l * 128 + 64 + lane];
#pragma unroll
    for (int j = 0; j < 4; ++j) a2[j] = sinf(f1 * a2[j]);
  }
  float a3[4][8];
#pragma unroll
  for (int j = 0; j < 4; ++j)
#pragma unroll
    for (int m = 0; m < 8; ++m) a3[j][m] = 0.f;
#pragma unroll 4
  for (int i = 0; i < 64; ++i) {
    float w[8];
#pragma unroll
    for (int m = 0; m < 8; ++m) w[m] = W3s[i * 512 + lane + 64 * m];
#pragma unroll
    for (int j = 0; j < 4; ++j) {
      const float hv = shf(a2[j], i);
#pragma unroll
      for (int m = 0; m < 8; ++m) a3[j][m] += hv * w[m];
    }
  }
  const float LN100 = 4.605170185988092f;
  const float d0 = LN100 / 1.5f, d1 = LN100 / 0.3f;
#pragma unroll
  for (int m = 0; m < 8; ++m) {
    const int cp = lane + 64 * m;
    const float delta = d0 + (float)(cp & 255) * ((d1 - d0) / 255.0f);
    float4 o;
    o.x = a3[0][m] * expf(-tl[0] * delta); o.y = a3[1][m] * expf(-tl[1] * delta);
    o.z = a3[2][m] * expf(-tl[2] * delta); o.w = a3[3][m] * expf(-tl[3] * delta);
    *(float4*)(outp + (size_t)cp * L + t0 + wid * 4) = o;
  }
  __syncthreads();
}
__device__ __forceinline__ void phase_filters(const P& p, int l, char* smem) {
  const int ntask = 128 + (l == 0 ? 8 : 0);
  for (int t = blockIdx.x; t < ntask; t += gridDim.x) {
    if (t < 128) filter_block_task(p, l, 4096, t * 32, p.hT + (size_t)l * 512 * 4096, smem);
    else filter_block_task(p, l, 256, (t - 128) * 32, p.hc, smem);
  }
}
__device__ __forceinline__ void kf_task(const P& p, int l, int c, char* smem) {
  const float* hTl = p.hT + (size_t)l * 512 * 4096;
  c2* buf = (c2*)smem;
  const int tid = opaque_tid();
  for (int i = 0; i < 16; ++i) {
    const int j = tid + NTHR * i;
    float v;
    if (j < 4096) v = hTl[(size_t)c * 4096 + j];
    else if (j == 4096) v = 0.f;
    else v = hTl[(size_t)(256 + c) * 4096 + (8192 - j)];
    buf[j] = {v, 0.f};
  }
  __syncthreads();
  fft8192(buf, -1.f);
  c2* o = (c2*)p.Kf + ((size_t)l * 256 + c) * 8192;
  for (int i = 0; i < 16; ++i) { const int j = tid + NTHR * i; o[j] = buf[j]; }
  __syncthreads();
}

__device__ __forceinline__ void inproj_tile(const P& p, int l, int mt, int nt, char* smem) {
  f32x16 acc[2][2];
  zero_acc(acc);
  const int m0 = mt * 256, n0 = nt * 128;
  gemm_kloop(acc, p.xn + (size_t)m0 * 1024, 1024, p.WinT + ((size_t)l * 2816 + n0) * 1024, 1024, 1024, smem);
  EPI_VARS
  if (nt < 8 || nt >= 18) {
    u16* dst; int ld, cbase;
    if (nt < 8) { dst = p.qk; ld = 1024; cbase = n0; }
    else { dst = p.rg; ld = 512; cbase = n0 - 2304; }
#pragma unroll
    for (int i = 0; i < 2; ++i)
#pragma unroll
      for (int j = 0; j < 2; ++j)
#pragma unroll
        for (int e = 0; e < 16; ++e)
          dst[(size_t)(m0 + EPI_ROW(i, e)) * ld + cbase + EPI_COL(j)] = f2bf(acc[i][j][e]);
  } else {
#pragma unroll
    for (int i = 0; i < 2; ++i)
#pragma unroll
      for (int j = 0; j < 2; ++j)
#pragma unroll
        for (int qd = 0; qd < 4; ++qd) {
          uint2 o;
          o.x = pk2(acc[i][j][4 * qd + 0], acc[i][j][4 * qd + 1]);
          o.y = pk2(acc[i][j][4 * qd + 2], acc[i][j][4 * qd + 3]);
          const int row0 = wm * 64 + i * 32 + 8 * qd + 4 * hh;
          *(uint2*)(smem + EPI_COL(j) * 520 + row0 * 2) = o;
        }
    __syncthreads();
    u16* dstT; int Lseg, t0, ncol0, nc;
    const bool isctx = (mt >= 128);
    const int b = isctx ? (mt - 128) : (mt >> 4);
    if (nt < 12) { ncol0 = n0 - 1024; nc = 512; dstT = isctx ? p.vTc : p.vT; }
    else { ncol0 = n0 - 1536; nc = 768; dstT = isctx ? p.hyTc : p.hyT; }
    if (isctx) { Lseg = 256; t0 = 0; } else { Lseg = 4096; t0 = (mt & 15) * 256; }
#pragma unroll 4
    for (int it = 0; it < 16; ++it) {
      const int idx = tid + NTHR * it;
      const int col = idx >> 6, u = idx & 63;
      const uint2 v = *(const uint2*)(smem + col * 520 + u * 8);
      *(uint2*)(dstT + ((size_t)(b * nc + ncol0 + col)) * Lseg + t0 + u * 4) = v;
    }
    __syncthreads();
  }
}

__device__ __forceinline__ float ldbf(const u16* p, int t, int L) { return (t >= 0 && t < L) ? bf2f(p[t]) : 0.f; }
__device__ __forceinline__ void ld10(const u16* __restrict__ seq, int t0, float (&v)[10]) {
  const uint4 r = *(const uint4*)(seq + t0);
  v[0] = (t0 > 0) ? bf2f(seq[t0 - 1]) : 0.f;
  v[9] = (t0 + 8 < 4096) ? bf2f(seq[t0 + 8]) : 0.f;
  v[1] = bflo(r.x); v[2] = bfhi(r.x); v[3] = bflo(r.y); v[4] = bfhi(r.y);
  v[5] = bflo(r.z); v[6] = bfhi(r.z); v[7] = bflo(r.w); v[8] = bfhi(r.w);
}
__device__ __forceinline__ void hyena_fft_task(const P& p, int l, int c, int bp, char* smem) {
  c2* buf = (c2*)smem;
  c2* ub = (c2*)(smem + 65536);
  const int tid = opaque_tid();
  const float* sw = p.hy_short_w + l * 3 * 768;
  const float* sb = p.hy_short_b + l * 768;
  const float wx0[3] = {sw[c], sw[768 + c], sw[1536 + c]};
  const float wx1[3] = {sw[256 + c], sw[768 + 256 + c], sw[1536 + 256 + c]};
  const float wv[3] = {sw[512 + c], sw[768 + 512 + c], sw[1536 + 512 + c]};
  const float bx0 = sb[c], bx1 = sb[256 + c], bv = sb[512 + c];
  const float dsk = p.hy_bias[l * 256 + c];
  const int t0 = tid * 8;
  {
    float u[2][8];
#pragma unroll
    for (int bb = 0; bb < 2; ++bb) {
      const int b = 2 * bp + bb;
      float x1[10], vv[10];
      ld10(p.hyT + ((size_t)(b * 768 + 256 + c)) * 4096, t0, x1);
      ld10(p.hyT + ((size_t)(b * 768 + 512 + c)) * 4096, t0, vv);
#pragma unroll
      for (int k = 0; k < 8; ++k) {
        const float x1c = bx1 + wx1[0] * x1[k] + wx1[1] * x1[k + 1] + wx1[2] * x1[k + 2];
        const float vc = bv + wv[0] * vv[k] + wv[1] * vv[k + 1] + wv[2] * vv[k + 2];
        u[bb][k] = vc * x1c;
      }
    }
#pragma unroll
    for (int k = 0; k < 8; k += 2) {
      const float4 w = make_float4(u[0][k], u[1][k], u[0][k + 1], u[1][k + 1]);
      *(float4*)(buf + t0 + k) = w;
      *(float4*)(ub + t0 + k) = w;
      *(float4*)(buf + 4096 + t0 + k) = make_float4(0.f, 0.f, 0.f, 0.f);
    }
  }
  __syncthreads();
  fft8192(buf, -1.f);
  const c2* kf = (const c2*)p.Kf + ((size_t)l * 256 + c) * 8192;
  for (int i = 0; i < 16; ++i) {
    const int k = tid + NTHR * i;
    buf[k] = cmul(buf[k], kf[k]);
  }
  __syncthreads();
  fft8192(buf, 1.f);
#pragma unroll
  for (int bb = 0; bb < 2; ++bb) {
    const int b = 2 * bp + bb;
    float x0[10];
    ld10(p.hyT + ((size_t)(b * 768 + c)) * 4096, t0, x0);
    float o[8];
#pragma unroll
    for (int k = 0; k < 8; ++k) {
      const c2 y = buf[t0 + k];
      const c2 uu = ub[t0 + k];
      const float x0c = bx0 + wx0[0] * x0[k] + wx0[1] * x0[k + 1] + wx0[2] * x0[k + 2];
      const float yy = ldexpf(bb ? y.y : y.x, -13);
      const float uv = bb ? uu.y : uu.x;
      o[k] = x0c * (yy + uv * dsk);
    }
    uint4 w; w.x = pk2(o[0], o[1]); w.y = pk2(o[2], o[3]); w.z = pk2(o[4], o[5]); w.w = pk2(o[6], o[7]);
    *(uint4*)(p.ybT + ((size_t)(b * 256 + c)) * 4096 + t0) = w;
  }
  __syncthreads();
}
__device__ __forceinline__ void yb_transpose_task(const P& p, int b, int tb, char* smem) {
  const int tid = opaque_tid(), lane = tid & 63, wid = tid >> 6;
  u16* T = (u16*)smem;
#pragma unroll
  for (int it = 0; it < 4; ++it) {
    const int id = tid + NTHR * it;
    const int c = id >> 3, ch = id & 7;
    const uint4 r = *(const uint4*)(p.ybT + ((size_t)(b * 256 + c)) * 4096 + tb * 64 + ch * 8);
    unsigned* d = (unsigned*)(T + c * 66 + ch * 8);
    d[0] = r.x; d[1] = r.y; d[2] = r.z; d[3] = r.w;
  }
  __syncthreads();
#pragma unroll
  for (int it = 0; it < 8; ++it) {
    const int tt = wid + 8 * it;
    const int c0 = lane * 4;
    uint2 w;
    w.x = (unsigned)T[(c0 + 0) * 66 + tt] | ((unsigned)T[(c0 + 1) * 66 + tt] << 16);
    w.y = (unsigned)T[(c0 + 2) * 66 + tt] | ((unsigned)T[(c0 + 3) * 66 + tt] << 16);
    *(uint2*)(p.ycat + (size_t)(b * 4096 + tb * 64 + tt) * 1024 + 512 + c0) = w;
  }
  __syncthreads();
}
__device__ __forceinline__ void hyena_ctx_task(const P& p, int l, int b, int cg8, char* smem) {
  const int tid_ = opaque_tid(); const int lane = tid_ & 63, wid = tid_ >> 6;
  const int c = cg8 * 8 + wid;
  float* us = (float*)smem + wid * 1024;
  float* kfp = us + 256 + 255;
  const float* sw = p.hy_short_w + l * 3 * 768;
  const float* sb = p.hy_short_b + l * 768;
  const u16* x0 = p.hyTc + ((size_t)(b * 768 + c)) * 256;
  const u16* x1 = p.hyTc + ((size_t)(b * 768 + 256 + c)) * 256;
  const u16* vv = p.hyTc + ((size_t)(b * 768 + 512 + c)) * 256;
  for (int i = 0; i < 4; ++i) {
    const int t = lane + 64 * i;
    const float x1c = sb[256 + c] + sw[256 + c] * ldbf(x1, t - 1, 256) + sw[768 + 256 + c] * ldbf(x1, t, 256) + sw[1536 + 256 + c] * ldbf(x1, t + 1, 256);
    const float vc = sb[512 + c] + sw[512 + c] * ldbf(vv, t - 1, 256) + sw[768 + 512 + c] * ldbf(vv, t, 256) + sw[1536 + 512 + c] * ldbf(vv, t + 1, 256);
    us[t] = vc * x1c;
    kfp[t] = p.hc[(size_t)c * 256 + t];
    if (t > 0) kfp[-t] = p.hc[(size_t)(256 + c) * 256 + t];
  }
  __syncthreads();
  const float dsk = p.hy_bias[l * 256 + c];
  float acc[4] = {0.f, 0.f, 0.f, 0.f};
  for (int s = 0; s < 256; ++s) {
    const float uv = us[s];
#pragma unroll
    for (int i = 0; i < 4; ++i) acc[i] += kfp[lane + 64 * i - s] * uv;
  }
#pragma unroll
  for (int i = 0; i < 4; ++i) {
    const int t = lane + 64 * i;
    const float x0c = sb[c] + sw[c] * ldbf(x0, t - 1, 256) + sw[768 + c] * ldbf(x0, t, 256) + sw[1536 + c] * ldbf(x0, t + 1, 256);
    p.ycat[(size_t)(NLAT + b * 256 + t) * 1024 + 512 + c] = f2bf(x0c * (acc[i] + us[t] * dsk));
  }
  __syncthreads();
}

template <int DIR>
__device__ __forceinline__ void rg_scan32(const float (&Av)[2][16], const float (&Bv)[2][16], float (&carry)[2], float (&H)[2][16], int hh) {
#pragma unroll
  for (int nt = 0; nt < 2; ++nt) {
    float c = carry[nt];
#pragma unroll
    for (int go = 0; go < 8; ++go) {
      const int g = DIR ? 7 - go : go, q = g >> 1, own = g & 1;
      float h = c;
#pragma unroll
      for (int io = 0; io < 4; ++io) {
        const int e = 4 * q + (DIR ? 3 - io : io);
        h = Av[nt][e] * h + Bv[nt][e];
        H[nt][e] = (hh == own) ? h : H[nt][e];
      }
      const float mine = (hh == own) ? h : c;
      const float other = shx(mine, 32);
      c = (hh == own) ? mine : other;
    }
    carry[nt] = c;
  }
}
__device__ __forceinline__ void rg_wave_task(const P& p, int l, int bq, int nblk, int mode, bool last, char* smem) {
  const int tid = opaque_tid(), lane = tid & 63, wid = tid >> 6;
  const int l31 = lane & 31, hh = lane >> 5;
  const int b = bq / 34, rr = bq - b * 34;
  const int seg = rr < 2 ? 0 : 1, blk = rr < 2 ? rr : rr - 2;
  if (mode == 1 && seg == 0 && last) return;
  const int ck = wid >> 1, dir = wid & 1;
  char* wreg = smem + wid * 17408;
  u16* xs = (u16*)wreg;
  char* xcb = wreg + 4608;
  float* xcf = (float*)(wreg + 8704);
  float2* blockagg = (float2*)(smem + 139264);
  const int Lseg = seg ? 4096 : 256;
  const int tokbase = seg ? b * 4096 : NLAT + b * 256;
  const int T0 = blk * 128 + ck * 32;
  const int cg32 = (seg ? 8 : 0) + blk * 4 + ck;
  bf16x8 wf[2][2][4];
#pragma unroll
  for (int gate = 0; gate < 2; ++gate) {
    const u16* wp = p.rgW + (size_t)(((l * 2 + gate) * 2 + dir) * 4 + nblk) * 4096 + l31 * 64 + 8 * hh;
#pragma unroll
    for (int nt = 0; nt < 2; ++nt)
#pragma unroll
      for (int s = 0; s < 4; ++s) wf[gate][nt][s] = *(const bf16x8*)(wp + nt * 2048 + 16 * s);
  }
  float cba[2], cbx[2], csp[2];
#pragma unroll
  for (int nt = 0; nt < 2; ++nt) {
    const int ch = (l * 2 + dir) * 256 + nblk * 64 + nt * 32 + l31;
    cba[nt] = p.rg_ba[ch];
    cbx[nt] = p.rg_bx[ch];
    csp[nt] = __logf(1.0f + __expf(-p.rg_lambda[ch]));
  }
#pragma unroll
  for (int i = 0; i < 5; ++i) {
    const int idx = lane + 64 * i;
    const int row = idx >> 3, chunk = idx & 7;
    if (row < 35) {
      const int pos = T0 - 2 + row;
      uint4 v = make_uint4(0u, 0u, 0u, 0u);
      if (pos >= 0 && pos < Lseg) v = *(const uint4*)(p.rg + (size_t)(tokbase + pos) * 512 + nblk * 64 + chunk * 8);
      *(uint4*)(xs + row * 64 + chunk * 8) = v;
    }
  }
  asm volatile("s_waitcnt lgkmcnt(0)" ::: "memory");
  {
    const int ch = l * 256 + nblk * 64 + lane;
    const float w0 = p.rg_conv_w[(l * 4 + 0) * 256 + nblk * 64 + lane], w1 = p.rg_conv_w[(l * 4 + 1) * 256 + nblk * 64 + lane];
    const float w2 = p.rg_conv_w[(l * 4 + 2) * 256 + nblk * 64 + lane], w3 = p.rg_conv_w[(l * 4 + 3) * 256 + nblk * 64 + lane];
    const float cb = p.rg_conv_b[ch];
    float x0 = bf2f(xs[0 * 64 + lane]), x1 = bf2f(xs[1 * 64 + lane]), x2 = bf2f(xs[2 * 64 + lane]);
#pragma unroll
    for (int t = 0; t < 32; ++t) {
      const float x3 = bf2f(xs[(t + 3) * 64 + lane]);
      const float xc = cb + w0 * x0 + w1 * x1 + w2 * x2 + w3 * x3;
      xcf[t * 68 + lane] = xc;
      *(u16*)(xcb + swz128(t, lane >> 3) + (lane & 7) * 2) = f2bf(xc);
      x0 = x1; x1 = x2; x2 = x3;
    }
  }
  asm volatile("s_waitcnt lgkmcnt(0)" ::: "memory");
  float Av[2][16], Bv[2][16];
  {
    f32x16 acc[2][2];
#pragma unroll
    for (int gate = 0; gate < 2; ++gate)
#pragma unroll
      for (int nt = 0; nt < 2; ++nt) acc[gate][nt] = zero16();
#pragma unroll
    for (int s = 0; s < 4; ++s) {
      const bf16x8 af = *(const bf16x8*)(xcb + swz128(l31, 2 * s + hh));
#pragma unroll
      for (int gate = 0; gate < 2; ++gate)
#pragma unroll
        for (int nt = 0; nt < 2; ++nt) acc[gate][nt] = mfma32(af, wf[gate][nt][s], acc[gate][nt]);
    }
#pragma unroll
    for (int nt = 0; nt < 2; ++nt)
#pragma unroll
      for (int e = 0; e < 16; ++e) {
        const int tok = (e & 3) + 8 * (e >> 2) + 4 * hh;
        const float r = sigmoidf_(acc[0][nt][e] + cba[nt]);
        const float ii = sigmoidf_(acc[1][nt][e] + cbx[nt]);
        const float la = -8.0f * r * csp[nt];
        const float av = __expf(la);
        const float e2 = 2.0f * la;
        const float om = (e2 > -0.1f) ? (-e2 * (1.0f + e2 * (0.5f + e2 * (0.16666667f + e2 * 0.041666668f)))) : (1.0f - __expf(e2));
        Av[nt][e] = av;
        Bv[nt][e] = sqrtf(om) * ii * xcf[tok * 68 + nt * 32 + l31];
      }
  }
  float H[2][16];
#pragma unroll
  for (int nt = 0; nt < 2; ++nt)
#pragma unroll
    for (int e = 0; e < 16; ++e) H[nt][e] = 0.f;
  float carry[2] = {0.f, 0.f};
  float2* agg1 = (float2*)p.agg;
  float2* agg2 = (float2*)p.agg + (size_t)8 * 2 * 136 * 256;
  const int pos2 = dir ? (seg == 0 ? 1 - blk : 33 - blk) : (seg == 0 ? blk : 2 + blk);
  if (mode == 0) {
    if (dir) rg_scan32<1>(Av, Bv, carry, H, hh); else rg_scan32<0>(Av, Bv, carry, H, hh);
    float P[2];
#pragma unroll
    for (int nt = 0; nt < 2; ++nt) {
      float pr = 1.f;
#pragma unroll
      for (int e = 0; e < 16; ++e) pr *= Av[nt][e];
      P[nt] = pr * shx(pr, 32);
    }
    const float2 mine = make_float2(hh ? P[1] : P[0], hh ? carry[1] : carry[0]);
    agg1[((size_t)(b * 2 + dir) * 136 + cg32) * 256 + nblk * 64 + lane] = mine;
    blockagg[(ck * 2 + dir) * 64 + lane] = mine;
    __syncthreads();
    if (wid < 2) {
      const int d2 = wid;
      float A = 1.f, B = 0.f;
#pragma unroll
      for (int co = 0; co < 4; ++co) {
        const int c = d2 ? 3 - co : co;
        const float2 g = blockagg[(c * 2 + d2) * 64 + lane];
        B = g.x * B + g.y;
        A *= g.x;
      }
      const int p2 = d2 ? (seg == 0 ? 1 - blk : 33 - blk) : (seg == 0 ? blk : 2 + blk);
      agg2[((size_t)(b * 2 + d2) * 34 + p2) * 256 + nblk * 64 + lane] = make_float2(A, B);
    }
    __syncthreads();
    return;
  }
  {
    float h = 0.f;
    const float2* a2 = agg2 + ((size_t)(b * 2 + dir) * 34) * 256 + nblk * 64 + lane;
    int j = 0;
    for (; j + 8 <= pos2; j += 8) {
      float2 g[8];
#pragma unroll
      for (int u = 0; u < 8; ++u) g[u] = a2[(size_t)(j + u) * 256];
#pragma unroll
      for (int u = 0; u < 8; ++u) h = g[u].x * h + g[u].y;
    }
    for (; j < pos2; ++j) { const float2 g = a2[(size_t)j * 256]; h = g.x * h + g.y; }
    const float2* a1 = agg1 + ((size_t)(b * 2 + dir) * 136 + (cg32 - ck)) * 256 + nblk * 64 + lane;
    const int npre = dir ? 3 - ck : ck;
    for (int i = 0; i < npre; ++i) {
      const int c = dir ? 3 - i : i;
      const float2 g = a1[(size_t)c * 256];
      h = g.x * h + g.y;
    }
    carry[0] = shf(h, l31);
    carry[1] = shf(h, 32 + l31);
  }
  if (dir) rg_scan32<1>(Av, Bv, carry, H, hh); else rg_scan32<0>(Av, Bv, carry, H, hh);
  asm volatile("s_waitcnt lgkmcnt(0)" ::: "memory");
#pragma unroll
  for (int nt = 0; nt < 2; ++nt)
#pragma unroll
    for (int e = 0; e < 16; ++e) xcf[((e & 3) + 8 * (e >> 2) + 4 * hh) * 68 + nt * 32 + l31] = H[nt][e];
  __syncthreads();
  {
    const float* hfT = (const float*)(smem + (ck * 2 + 0) * 17408 + 8704);
    const float* hbT = (const float*)(smem + (ck * 2 + 1) * 17408 + 8704);
    const int tok = 16 * dir + (lane >> 2), c16 = (lane & 3) * 16;
    const size_t gtok = (size_t)tokbase + T0 + tok;
    const u16* gp = p.rg + gtok * 512 + 256 + nblk * 64 + c16;
    u16* op = p.ycat + gtok * 1024 + 768 + nblk * 64 + c16;
#pragma unroll
    for (int hv = 0; hv < 2; ++hv) {
      const uint4 g = *(const uint4*)(gp + hv * 8);
      const float4 f0 = *(const float4*)(hfT + tok * 68 + c16 + hv * 8), f1 = *(const float4*)(hfT + tok * 68 + c16 + hv * 8 + 4);
      const float4 h0 = *(const float4*)(hbT + tok * 68 + c16 + hv * 8), h1 = *(const float4*)(hbT + tok * 68 + c16 + hv * 8 + 4);
      uint4 o;
      o.x = pk2((f0.x + h0.x) * gelu_tanh(bflo(g.x)), (f0.y + h0.y) * gelu_tanh(bfhi(g.x)));
      o.y = pk2((f0.z + h0.z) * gelu_tanh(bflo(g.y)), (f0.w + h0.w) * gelu_tanh(bfhi(g.y)));
      o.z = pk2((f1.x + h1.x) * gelu_tanh(bflo(g.z)), (f1.y + h1.y) * gelu_tanh(bfhi(g.z)));
      o.w = pk2((f1.z + h1.z) * gelu_tanh(bflo(g.w)), (f1.w + h1.w) * gelu_tanh(bfhi(g.w)));
      *(uint4*)(op + hv * 8) = o;
    }
  }
  __syncthreads();
}

__device__ __forceinline__ void attn_wave(const P& p, int l, int b, int h, bool local, int r, int half, int qtok0, const float* rpbL) {
  const int lane = opaque_tid() & 63, q = lane & 31, hh = lane >> 5;
  bf16x8 qf[4];
  {
    const u16* qp = p.qk + (size_t)(qtok0 + q) * 1024 + h * 64 + 8 * hh;
#pragma unroll
    for (int s = 0; s < 4; ++s) qf[s] = *(const bf16x8*)(qp + 16 * s);
  }
  f32x16 o0 = zero16(), o1 = zero16();
  float m_run = -1e30f, l_run = 0.f;
  const int pi = (q & 19) | ((q & 4) << 1) | ((q & 8) >> 1);
  const int w = half * 32 + q;
  const int st = min(max(w - 8, 0), 48);
  const int rs = min(max(r - 4, 0), 56);
  const int ntiles = local ? 24 : 8;
  bf16x8 kfn[4], vfn[2][2];
  auto tile_load = [&](int ti, bf16x8 (&kfo)[4], bf16x8 (&vfo)[2][2]) {
    int ktok0, vstride;
    const u16* vb;
    if (ti < 8) {
      ktok0 = NLAT + b * 256 + ti * 32;
      vb = p.vTc + ((size_t)(b * 512 + h * 64)) * 256 + ti * 32;
      vstride = 256;
    } else {
      const int tl = ti - 8;
      const int a2 = tl >> 1, g2 = tl & 1;
      ktok0 = b * 4096 + (rs + a2) * 64 + g2 * 32;
      vb = p.vT + ((size_t)(b * 512 + h * 64)) * 4096 + (rs + a2) * 64 + g2 * 32;
      vstride = 4096;
    }
    const u16* kp = p.qk + (size_t)(ktok0 + pi) * 1024 + 512 + h * 64 + 8 * hh;
#pragma unroll
    for (int s = 0; s < 4; ++s) kfo[s] = *(const bf16x8*)(kp + 16 * s);
#pragma unroll
    for (int dt = 0; dt < 2; ++dt)
#pragma unroll
      for (int s2 = 0; s2 < 2; ++s2) vfo[dt][s2] = *(const bf16x8*)(vb + (size_t)(dt * 32 + q) * vstride + 16 * s2 + 8 * hh);
  };
  tile_load(0, kfn, vfn);
  for (int ti = 0; ti < ntiles; ++ti) {
    int a = 0, g = 0;
    if (ti >= 8) { a = (ti - 8) >> 1; g = (ti - 8) & 1; }
    bf16x8 kf[4], vf[2][2];
#pragma unroll
    for (int s = 0; s < 4; ++s) kf[s] = kfn[s];
#pragma unroll
    for (int dt = 0; dt < 2; ++dt)
#pragma unroll
      for (int s2 = 0; s2 < 2; ++s2) vf[dt][s2] = vfn[dt][s2];
    if (ti + 1 < ntiles) tile_load(ti + 1, kfn, vfn);
    f32x16 sacc = zero16();
#pragma unroll
    for (int s = 0; s < 4; ++s) sacc = mfma32(kf[s], qf[s], sacc);
    float sv[16];
    float tmax = -1e30f;
#pragma unroll
    for (int e = 0; e < 16; ++e) {
      float x = sacc[e] * 0.125f;
      if (ti >= 8) {
        const int kc = g * 32 + (e & 7) + 8 * hh + 16 * (e >> 3);
        const bool valid = (kc >= st) && (kc < st + 16);
        const int bi = valid ? ((rs + a - r + 7) * 31 + (kc - w + 15)) : 0;
        const float bias = rpbL[bi];
        x = valid ? (x + bias) : -1e30f;
      }
      sv[e] = x;
      tmax = fmaxf(tmax, x);
    }
    tmax = fmaxf(tmax, shx(tmax, 32));
    const float m_new = fmaxf(m_run, tmax);
    const float alpha = __expf(m_run - m_new);
    m_run = m_new;
    l_run *= alpha;
#pragma unroll
    for (int e = 0; e < 16; ++e) { o0[e] *= alpha; o1[e] *= alpha; }
    float psum = 0.f;
#pragma unroll
    for (int e = 0; e < 16; ++e) { const float pe = __expf(sv[e] - m_new); sv[e] = pe; psum += pe; }
    l_run += psum;
    bf16x8 pf[2];
#pragma unroll
    for (int s2 = 0; s2 < 2; ++s2) {
      union { bf16x8 v; unsigned u[4]; } cv;
#pragma unroll
      for (int j = 0; j < 4; ++j) cv.u[j] = pk2(sv[8 * s2 + 2 * j], sv[8 * s2 + 2 * j + 1]);
      pf[s2] = cv.v;
    }
#pragma unroll
    for (int s2 = 0; s2 < 2; ++s2) {
      o0 = mfma32(vf[0][s2], pf[s2], o0);
      o1 = mfma32(vf[1][s2], pf[s2], o1);
    }
  }
  const float lt = l_run + shx(l_run, 32);
  const float inv = 1.0f / lt;
  u16* op = p.ycat + (size_t)(qtok0 + q) * 1024 + h * 64;
#pragma unroll
  for (int qd = 0; qd < 4; ++qd) {
    uint2 a0, a1;
    a0.x = pk2(o0[4 * qd] * inv, o0[4 * qd + 1] * inv);
    a0.y = pk2(o0[4 * qd + 2] * inv, o0[4 * qd + 3] * inv);
    a1.x = pk2(o1[4 * qd] * inv, o1[4 * qd + 1] * inv);
    a1.y = pk2(o1[4 * qd + 2] * inv, o1[4 * qd + 3] * inv);
    *(uint2*)(op + 8 * qd + 4 * hh) = a0;
    *(uint2*)(op + 32 + 8 * qd + 4 * hh) = a1;
  }
}
__device__ __forceinline__ void attn_block_task(const P& p, int l, int b, int h, int rg4, char* smem) {
  const int tid = opaque_tid(), lane = tid & 63, wid = tid >> 6;
  const int q = lane & 31, hh = lane >> 5;
  const int R0 = rg4 * 4;
  const int r = R0 + (wid >> 1), half = wid & 1;
  float* rpbL = (float*)(smem + 32768) + 64;
  for (int i = tid; i < 465; i += NTHR) rpbL[i] = p.na_rpb[(size_t)(l * 8 + h) * 465 + i] * 1.4426950408889634f;
  const int lo = min(max(R0 - 4, 0), 56);
  const int hi = min(max(R0 + 3 - 4, 0), 56) + 7;
  const int ntile = 4 + (hi - lo + 1);
  const int rs = min(max(r - 4, 0), 56);
  const int qtok = b * 4096 + r * 64 + half * 32 + q;
  bf16x8 qf[4];
  {
    const u16* qp = p.qk + (size_t)qtok * 1024 + h * 64 + 8 * hh;
#pragma unroll
    for (int s = 0; s < 4; ++s) qf[s] = *(const bf16x8*)(qp + 16 * s);
  }
  f32x16 o0 = zero16(), o1 = zero16();
  float m_run = -1e30f, l_run = 0.f;
  const int pi = (q & 19) | ((q & 4) << 1) | ((q & 8) >> 1);
  const int w = half * 32 + q;
  const int st = min(max(w - 8, 0), 48);
  unsigned vmask = 0u;
#pragma unroll
  for (int g = 0; g < 2; ++g)
#pragma unroll
    for (int e = 0; e < 16; ++e) {
      const int kc = g * 32 + (e & 7) + 8 * hh + 16 * (e >> 3);
      vmask |= ((kc >= st) && (kc < st + 16)) ? (1u << (g * 16 + e)) : 0u;
    }
  const int cbase = 8 * hh - w + 15;
  const int srow = tid >> 3, sch = tid & 7;
  uint4 rkA, rvA, rkB, rvB;
  auto gload = [&](int ti, uint4& rk, uint4& rv) {
    int ktok0, vstride;
    const u16* vb;
    if (ti < 4) { ktok0 = NLAT + b * 256 + ti * 64; vb = p.vTc + ((size_t)(b * 512 + h * 64)) * 256 + ti * 64; vstride = 256; }
    else { const int R = lo + ti - 4; ktok0 = b * 4096 + R * 64; vb = p.vT + ((size_t)(b * 512 + h * 64)) * 4096 + R * 64; vstride = 4096; }
    rk = *(const uint4*)(p.qk + (size_t)(ktok0 + srow) * 1024 + 512 + h * 64 + sch * 8);
    rv = *(const uint4*)(vb + (size_t)srow * vstride + sch * 8);
  };
  gload(0, rkA, rvA);
  *(uint4*)(smem + swz128(srow, sch)) = rkA;
  *(uint4*)(smem + 16384 + swz128(srow, sch)) = rvA;
  gload(1, rkA, rvA);
  if (2 < ntile) gload(2, rkB, rvB);
  __syncthreads();
  auto compute = [&](int ti) {
    const char* Kb = smem + (ti & 1) * 8192;
    const char* Vb = smem + 16384 + (ti & 1) * 8192;
    const int R = lo + ti - 4;
    const bool active = (ti < 4) || (R >= rs && R < rs + 8);
    if (active) {
      f32x16 sacc0 = zero16(), sacc1 = zero16();
#pragma unroll
      for (int s = 0; s < 4; ++s) {
        const bf16x8 kf0 = *(const bf16x8*)(Kb + swz128(pi, 2 * s + hh));
        const bf16x8 kf1 = *(const bf16x8*)(Kb + swz128(32 + pi, 2 * s + hh));
        sacc0 = mfma32(kf0, qf[s], sacc0);
        sacc1 = mfma32(kf1, qf[s], sacc1);
      }
      float sv[32];
      float tmax = -1e30f;
      if (ti >= 4) {
        const float* brow = rpbL + (R - r + 7) * 31 + cbase;
        float bias[32];
#pragma unroll
        for (int g = 0; g < 2; ++g)
#pragma unroll
          for (int e = 0; e < 16; ++e) bias[g * 16 + e] = brow[g * 32 + (e & 7) + 16 * (e >> 3)];
#pragma unroll
        for (int g = 0; g < 2; ++g)
#pragma unroll
          for (int e = 0; e < 16; ++e) {
            const float sc = g ? sacc1[e] : sacc0[e];
            const float x = ((int)(vmask << (31 - (g * 16 + e))) < 0) ? fmaf(sc, 0.18033688011112042f, bias[g * 16 + e]) : -1e30f;
            sv[g * 16 + e] = x;
            tmax = fmaxf(tmax, x);
          }
      } else {
#pragma unroll
        for (int g = 0; g < 2; ++g)
#pragma unroll
          for (int e = 0; e < 16; ++e) {
            const float x = (g ? sacc1[e] : sacc0[e]) * 0.18033688011112042f;
            sv[g * 16 + e] = x;
            tmax = fmaxf(tmax, x);
          }
      }
      tmax = fmaxf(tmax, shx(tmax, 32));
      if (__builtin_amdgcn_ballot_w64(tmax > m_run) != 0ull) {
        const float m_new = fmaxf(m_run, tmax);
        const float alpha = __builtin_amdgcn_exp2f(m_run - m_new);
        m_run = m_new;
        l_run *= alpha;
#pragma unroll
        for (int e = 0; e < 16; ++e) { o0[e] *= alpha; o1[e] *= alpha; }
      }
      float psum = 0.f;
#pragma unroll
      for (int e = 0; e < 32; ++e) { const float pe = __builtin_amdgcn_exp2f(sv[e] - m_run); sv[e] = pe; psum += pe; }
      l_run += psum;
#pragma unroll
      for (int g = 0; g < 2; ++g)
#pragma unroll
        for (int s2 = 0; s2 < 2; ++s2) {
          union { bf16x8 v; unsigned u[4]; } cv;
#pragma unroll
          for (int j = 0; j < 4; ++j) cv.u[j] = pk2(sv[g * 16 + 8 * s2 + 2 * j], sv[g * 16 + 8 * s2 + 2 * j + 1]);
          const bf16x8 v0 = *(const bf16x8*)(Vb + swz128(q, g * 4 + 2 * s2 + hh));
          const bf16x8 v1 = *(const bf16x8*)(Vb + swz128(32 + q, g * 4 + 2 * s2 + hh));
          o0 = mfma32(v0, cv.v, o0);
          o1 = mfma32(v1, cv.v, o1);
        }
    }
  };
  for (int ti = 0; ti < ntile; ti += 2) {
    compute(ti);
    if (ti + 1 < ntile) {
      *(uint4*)(smem + 8192 + swz128(srow, sch)) = rkA;
      *(uint4*)(smem + 16384 + 8192 + swz128(srow, sch)) = rvA;
      if (ti + 3 < ntile) gload(ti + 3, rkA, rvA);
    }
    __syncthreads();
    if (ti + 1 < ntile) {
      compute(ti + 1);
      if (ti + 2 < ntile) {
        *(uint4*)(smem + swz128(srow, sch)) = rkB;
        *(uint4*)(smem + 16384 + swz128(srow, sch)) = rvB;
        if (ti + 4 < ntile) gload(ti + 4, rkB, rvB);
      }
      __syncthreads();
    }
  }
  const float lt = l_run + shx(l_run, 32);
  const float inv = 1.0f / lt;
  __syncthreads();
  {
    char* ot = smem + wid * 4608;
#pragma unroll
    for (int qd = 0; qd < 4; ++qd) {
      uint2 a0, a1;
      a0.x = pk2(o0[4 * qd] * inv, o0[4 * qd + 1] * inv);
      a0.y = pk2(o0[4 * qd + 2] * inv, o0[4 * qd + 3] * inv);
      a1.x = pk2(o1[4 * qd] * inv, o1[4 * qd + 1] * inv);
      a1.y = pk2(o1[4 * qd + 2] * inv, o1[4 * qd + 3] * inv);
      *(uint2*)(ot + q * 144 + (8 * qd + 4 * hh) * 2) = a0;
      *(uint2*)(ot + q * 144 + (32 + 8 * qd + 4 * hh) * 2) = a1;
    }
    asm volatile("s_waitcnt lgkmcnt(0)" ::: "memory");
    const int tok0 = b * 4096 + r * 64 + half * 32;
#pragma unroll
    for (int it = 0; it < 4; ++it) {
      const int qq = it * 8 + (lane >> 3), ch = lane & 7;
      const uint4 v = *(const uint4*)(ot + qq * 144 + ch * 16);
      *(uint4*)(p.ycat + (size_t)(tok0 + qq) * 1024 + h * 64 + ch * 8) = v;
    }
  }
  __syncthreads();
}
__device__ __forceinline__ void attn_task(const P& p, int l, int kind, int idx, char* smem) {
  const int tid_ = opaque_tid(); const int lane = tid_ & 63, wid = tid_ >> 6;
  float* rpbL = (float*)smem + wid * 480;
  for (int i = lane; i < 465; i += 64) rpbL[i] = p.na_rpb[(size_t)(l * 8 + wid) * 465 + i];
  __syncthreads();
  if (kind == 0) {
    const int half = idx & 1, r = (idx >> 1) & 63, b = idx >> 7;
    attn_wave(p, l, b, wid, true, r, half, b * 4096 + r * 64 + half * 32, rpbL);
  } else {
    const int qg = idx & 7, b = idx >> 3;
    attn_wave(p, l, b, wid, false, 0, 0, NLAT + b * 256 + qg * 32, rpbL);
  }
  __syncthreads();
}

__device__ __forceinline__ void phase_mixers(const P& p, int l, char* smem, unsigned* counter) {
  const bool last = (l == 1);
  const int n_rg = 1088 * XRGA, n_fft = 1024 * XFFT, n_hc = last ? 0 : 256, n_att = 1024 * XATT, n_attc = last ? 0 : 64;
  const int total = n_rg + n_fft + n_hc + n_att + n_attc;
  volatile int* s_taskp = (volatile int*)(smem + SMEM_BYTES - 16);
  for (;;) {
    __syncthreads();
    if (threadIdx.x == 0) *s_taskp = (int)atomicAdd(counter, 1u);
    __syncthreads();
    int t = *s_taskp;
    if (t >= total) break;
    if (t < n_att) { t &= 1023; attn_block_task(p, l, t >> 7, (t >> 4) & 7, t & 15, smem); continue; }
    t -= n_att;
    if (t < n_attc) { attn_task(p, l, 1, t, smem); continue; }
    t -= n_attc;
    if (t < n_fft) { t &= 1023; hyena_fft_task(p, l, t >> 2, t & 3, smem); continue; }
    t -= n_fft;
    if (t < n_hc) { hyena_ctx_task(p, l, t >> 5, t & 31, smem); continue; }
    t -= n_hc;
    if (t >= 1088) t -= 1088;
    rg_wave_task(p, l, t >> 2, t & 3, 0, last, smem);
  }
}

__device__ __forceinline__ void merge_tile(const P& p, int l, int mt, int nt, char* smem) {
  EPI_VARS
  const int m0 = mt * 256, n0 = nt * 128;
  f32x16 macc[2][2];
  zero_acc(macc);
  for (int br = 0; br < 3; ++br) {
    unsigned* gpl = (unsigned*)(smem + 98304) + tid;
    {
      f32x16 acc[2][2];
      zero_acc(acc);
      gemm_kloop(acc, p.xn + (size_t)m0 * 1024, 1024, p.WgT + ((size_t)l * 3072 + br * 1024 + n0) * 1024, 1024, 1024, smem);
#pragma unroll
      for (int j = 0; j < 2; ++j) {
        const float bg = p.b_gate[l * 3072 + br * 1024 + n0 + EPI_COL(j)];
#pragma unroll
        for (int i = 0; i < 2; ++i)
#pragma unroll
          for (int e = 0; e < 4; ++e) {
            const unsigned q0 = (unsigned)(sigmoidf_(acc[i][j][4 * e] + bg) * 255.0f + 0.5f);
            const unsigned q1 = (unsigned)(sigmoidf_(acc[i][j][4 * e + 1] + bg) * 255.0f + 0.5f);
            const unsigned q2 = (unsigned)(sigmoidf_(acc[i][j][4 * e + 2] + bg) * 255.0f + 0.5f);
            const unsigned q3 = (unsigned)(sigmoidf_(acc[i][j][4 * e + 3] + bg) * 255.0f + 0.5f);
            gpl[((i * 2 + j) * 4 + e) * 512] = q0 | (q1 << 8) | (q2 << 16) | (q3 << 24);
          }
      }
    }
    {
      f32x16 acc[2][2];
      zero_acc(acc);
      const u16* A; const u16* B; int K;
      if (br == 0) { A = p.ycat + (size_t)m0 * 1024; B = p.WaT + ((size_t)l * 1024 + n0) * 512; K = 512; }
      else if (br == 1) { A = p.ycat + (size_t)m0 * 1024 + 512; B = p.WbT + ((size_t)l * 1024 + n0) * 256; K = 256; }
      else { A = p.ycat + (size_t)m0 * 1024 + 768; B = p.WcT + ((size_t)l * 1024 + n0) * 256; K = 256; }
      gemm_kloop(acc, A, 1024, B, K, K, smem);
#pragma unroll
      for (int i = 0; i < 2; ++i)
#pragma unroll
        for (int j = 0; j < 2; ++j)
#pragma unroll
          for (int e = 0; e < 4; ++e) {
            const unsigned g4 = gpl[((i * 2 + j) * 4 + e) * 512];
            macc[i][j][4 * e] += (float)(g4 & 255u) * (1.0f / 255.0f) * acc[i][j][4 * e];
            macc[i][j][4 * e + 1] += (float)((g4 >> 8) & 255u) * (1.0f / 255.0f) * acc[i][j][4 * e + 1];
            macc[i][j][4 * e + 2] += (float)((g4 >> 16) & 255u) * (1.0f / 255.0f) * acc[i][j][4 * e + 2];
            macc[i][j][4 * e + 3] += (float)(g4 >> 24) * (1.0f / 255.0f) * acc[i][j][4 * e + 3];
          }
    }
  }
#pragma unroll
  for (int i = 0; i < 2; ++i)
#pragma unroll
    for (int j = 0; j < 2; ++j)
#pragma unroll
      for (int e = 0; e < 16; ++e)
        p.mbuf[(size_t)(m0 + EPI_ROW(i, e)) * 1024 + n0 + EPI_COL(j)] = f2bf(macc[i][j][e]);
}
__device__ __forceinline__ void outproj_tile(const P& p, int l, int mt, int nt, char* smem, bool do_store) {
  EPI_VARS
  const int m0 = mt * 256, n0 = nt * 128;
  f32x16 acc[2][2];
  zero_acc(acc);
  gemm_kloop(acc, p.mbuf + (size_t)m0 * 1024, 1024, p.WoT + ((size_t)l * 1024 + n0) * 1024, 1024, 1024, smem);
  const bool isctx = (mt >= 128);
  const int bi = isctx ? 8 : (mt >> 4);
  const float* gatev = p.mod + ((size_t)(l * 9 + bi) * 6 + 2) * 1024;
  const float* src; float* dst;
  if (isctx) { src = (l == 0 ? p.ctx : p.ctxs) - (size_t)NLAT * 1024; dst = p.ctxs - (size_t)NLAT * 1024; }
  else { src = (l == 0 ? p.x : p.out); dst = p.out; }
#pragma unroll
  for (int j = 0; j < 2; ++j) {
    const int col = n0 + EPI_COL(j);
    const float gv = gatev[col];
#pragma unroll
    for (int i = 0; i < 2; ++i)
#pragma unroll
      for (int e = 0; e < 16; ++e) {
        const size_t o = (size_t)(m0 + EPI_ROW(i, e)) * 1024 + col;
        if (do_store) dst[o] = src[o] + gv * acc[i][j][e];
      }
  }
}

__device__ __forceinline__ void wqk_task(const P& p, int l, int hp, int nt, char* smem) {
  EPI_VARS
  f32x16 acc[2][2];
  zero_acc(acc);
  gemm_kloop(acc, p.keysB + ((size_t)l * 16 + hp) * 16384, 128, p.WqB + (size_t)l * 1024 * 2048 + (size_t)(nt * 128) * 2048 + hp * 128, 2048, 128, smem);
  if (wm < 2) {
#pragma unroll
    for (int i = 0; i < 2; ++i)
#pragma unroll
      for (int j = 0; j < 2; ++j)
#pragma unroll
        for (int e = 0; e < 16; ++e)
          p.WqkT[((size_t)l * 2048 + hp * 128 + EPI_ROW(i, e)) * 1024 + nt * 128 + EPI_COL(j)] = f2bf(acc[i][j][e]);
  }
}
__device__ __forceinline__ void ins16(unsigned (&L)[16], unsigned x) {
#pragma unroll
  for (int i = 0; i < 16; ++i) {
    const unsigned hi = max(L[i], x);
    x = min(L[i], x);
    L[i] = hi;
  }
}
__device__ __forceinline__ unsigned f2sort(float f) {
  const unsigned b = __float_as_uint(f);
  return b ^ ((unsigned)((int)b >> 31) | 0x80000000u);
}
__device__ __forceinline__ float sort2f(unsigned k) {
  const unsigned u = k & ~127u;
  const unsigned b = (u & 0x80000000u) ? (u ^ 0x80000000u) : ~u;
  return __uint_as_float(b);
}
__device__ __forceinline__ void cx_desc(unsigned& a, unsigned& b) { const unsigned hi = max(a, b), lo = min(a, b); a = hi; b = lo; }
template <int BASE> __device__ __forceinline__ void sort16_desc(unsigned (&k)[64]) {
#pragma unroll
  for (int sz = 2; sz <= 16; sz <<= 1) {
#pragma unroll
    for (int j = sz >> 1; j >= 1; j >>= 1) {
#pragma unroll
      for (int i = 0; i < 16; ++i) {
        const int l2 = i ^ j;
        if (l2 > i) {
          if ((i & sz) == 0) cx_desc(k[BASE + i], k[BASE + l2]);
          else cx_desc(k[BASE + l2], k[BASE + i]);
        }
      }
    }
  }
}
template <int AB, int BB> __device__ __forceinline__ void merge16_desc(unsigned (&k)[64]) {
#pragma unroll
  for (int i = 0; i < 16; ++i) k[AB + i] = max(k[AB + i], k[BB + 15 - i]);
#pragma unroll
  for (int j = 8; j >= 1; j >>= 1) {
#pragma unroll
    for (int i = 0; i < 16; ++i)
      if ((i & j) == 0) cx_desc(k[AB + i], k[AB + i + j]);
  }
}
__device__ __forceinline__ void peer_score_tile(const P& p, int l, int mt, int hp, char* smem) {
  const int tid = opaque_tid();
  const int m0 = mt * 256;
  const int row = tid >> 1, hf = tid & 1;
  {
    char* T = smem + 16384;
#pragma unroll
    for (int it = 0; it < 8; ++it) {
      const int id = tid + NTHR * it;
      const int r = id >> 4, ch = id & 15;
      *(uint4*)(T + r * 272 + ch * 16) = *(const uint4*)(p.q + (size_t)(m0 + r) * 2048 + hp * 128 + ch * 8);
    }
  }
  __syncthreads();
  const char* sp = smem + 16384 + row * 272 + hf * 128;
  unsigned k[64];
#pragma unroll
  for (int c = 0; c < 8; ++c) {
    const uint4 r = *(const uint4*)(sp + 16 * c);
    const unsigned w[4] = {r.x, r.y, r.z, r.w};
#pragma unroll
    for (int q = 0; q < 4; ++q) {
      const float v0 = __builtin_bit_cast(_Float16, (unsigned short)(w[q] & 0xffffu));
      const float v1 = __builtin_bit_cast(_Float16, (unsigned short)(w[q] >> 16));
      const int key = hf * 64 + c * 8 + q * 2;
      k[c * 8 + q * 2] = (f2sort(v0) & ~127u) | (unsigned)key;
      k[c * 8 + q * 2 + 1] = (f2sort(v1) & ~127u) | (unsigned)(key + 1);
    }
  }
  sort16_desc<0>(k); sort16_desc<16>(k); sort16_desc<32>(k); sort16_desc<48>(k);
  merge16_desc<0, 16>(k);
  merge16_desc<32, 48>(k);
  merge16_desc<0, 32>(k);
  unsigned* X = (unsigned*)smem;
  if (hf) {
#pragma unroll
    for (int i = 0; i < 16; ++i) X[row * 16 + i] = k[i];
  }
  __syncthreads();
  if (!hf) {
#pragma unroll
    for (int i = 0; i < 16; ++i) k[16 + i] = X[row * 16 + i];
    merge16_desc<0, 16>(k);
    unsigned* o = p.topk + ((size_t)(m0 + row) * 16 + hp) * 16;
#pragma unroll
    for (int i = 0; i < 4; ++i) *(uint4*)(o + 4 * i) = make_uint4(k[4 * i], k[4 * i + 1], k[4 * i + 2], k[4 * i + 3]);
  }
  __syncthreads();
}

__device__ __forceinline__ void phase_peer_experts(const P& p, int l, bool do_store, char* smem) {
  const int tid_ = opaque_tid(); const int lane = tid_ & 63, wid = tid_ >> 6;
  const int ntok = (l == 1) ? NLAT : NTOK;
  int ci, cj;
  {
    const int e = lane;
    if (e < 16) { ci = 0; cj = e; }
    else if (e < 24) { ci = 1; cj = e - 16; }
    else if (e < 29) { ci = 2; cj = e - 24; }
    else if (e < 33) { ci = 3; cj = e - 29; }
    else if (e < 36) { ci = 4; cj = e - 33; }
    else if (e < 38) { ci = 5; cj = e - 36; }
    else if (e < 40) { ci = 6; cj = e - 38; }
    else if (e < 42) { ci = 7; cj = e - 40; }
    else { ci = min(8 + (e - 42), 15); cj = 0; }
  }
  for (int tok = blockIdx.x * 8 + wid; tok < ntok; tok += gridDim.x * 8) {
    float xr[16];
    {
      const uint4 a = *(const uint4*)(p.xn + (size_t)tok * 1024 + lane * 16);
      const uint4 b = *(const uint4*)(p.xn + (size_t)tok * 1024 + lane * 16 + 8);
      xr[0] = bflo(a.x); xr[1] = bfhi(a.x); xr[2] = bflo(a.y); xr[3] = bfhi(a.y);
      xr[4] = bflo(a.z); xr[5] = bfhi(a.z); xr[6] = bflo(a.w); xr[7] = bfhi(a.w);
      xr[8] = bflo(b.x); xr[9] = bfhi(b.x); xr[10] = bflo(b.y); xr[11] = bfhi(b.y);
      xr[12] = bflo(b.z); xr[13] = bfhi(b.z); xr[14] = bflo(b.w); xr[15] = bfhi(b.w);
    }
    typedef _Float16 h2_t __attribute__((ext_vector_type(2)));
    h2_t yh[8];
#pragma unroll
    for (int i = 0; i < 8; ++i) yh[i] = (h2_t){(_Float16)0, (_Float16)0};
    int* selw = (int*)(smem + wid * 4096);
    const unsigned* kvp = p.topk + (size_t)tok * 256 + (lane & 31);
#pragma unroll 1
    for (int hb = 0; hb < 8; hb += 4) {
      unsigned key[4]; int eidx[4];
#pragma unroll
      for (int u = 0; u < 4; ++u) {
        const unsigned kv = kvp[(hb + u) * 32];
        const unsigned k0 = shu(kv, ci);
        const unsigned k1 = shu(kv, 16 + cj);
        const float val = (lane < 50) ? (sort2f(k0) + sort2f(k1)) : -3.0e38f;
        eidx[u] = (int)((k0 & 127u) * 128u + (k1 & 127u));
        key[u] = (f2sort(val) & ~63u) | (unsigned)lane;
      }
#pragma unroll
      for (int k = 2; k <= 64; k <<= 1) {
#pragma unroll
        for (int j = k >> 1; j >= 1; j >>= 1) {
          const bool take_max = (((lane & j) == 0) == ((lane & k) == 0));
#pragma unroll
          for (int u = 0; u < 4; ++u) {
            unsigned ok;
            if (j == 1) ok = xorl<1>(key[u], lane); else if (j == 2) ok = xorl<2>(key[u], lane); else if (j == 4) ok = xorl<4>(key[u], lane);
            else if (j == 8) ok = xorl<8>(key[u], lane); else if (j == 16) ok = xorl<16>(key[u], lane); else ok = xorl<32>(key[u], lane);
            key[u] = take_max ? max(key[u], ok) : min(key[u], ok);
          }
        }
      }
#pragma unroll
      for (int u = 0; u < 4; ++u) {
        const int si = __builtin_amdgcn_ds_bpermute((int)(key[u] & 63u) << 2, eidx[u]);
        const unsigned ku = key[u] & ~63u;
        const float sv = __uint_as_float((ku & 0x80000000u) ? (ku ^ 0x80000000u) : ~ku);
        const float mx = __builtin_bit_cast(float, __builtin_amdgcn_readlane(__builtin_bit_cast(int, sv), 0));
        const float ex = (lane < 16) ? __builtin_amdgcn_exp2f((sv - mx) * 1.4426950408889634f) : 0.f;
        const float sm = wave_sum(ex);
        selw[(hb + u) * 64 + lane] = si;
        selw[512 + (hb + u) * 64 + lane] = __builtin_bit_cast(int, ex * __builtin_amdgcn_rcpf(sm));
      }
    }
    {
      int w[4];
#pragma unroll
      for (int i = 0; i < 4; ++i) {
        int t = __builtin_amdgcn_cvt_pk_fp8_f32(xr[4 * i], xr[4 * i + 1], 0, false);
        w[i] = __builtin_amdgcn_cvt_pk_fp8_f32(xr[4 * i + 2], xr[4 * i + 3], t, true);
      }
      *(uint4*)(smem + 32768 + wid * 1024 + lane * 16) = make_uint4((unsigned)w[0], (unsigned)w[1], (unsigned)w[2], (unsigned)w[3]);
    }
    asm volatile("s_waitcnt lgkmcnt(0)" ::: "memory");
    const int e15 = lane & 15, g4 = lane >> 4;
#pragma unroll 1
    for (int h = 0; h < 8; ++h) {
      const int eperm_h = selw[h * 64 + lane];
      const int gperm_h = selw[512 + h * 64 + lane];
      const int ide = (int)shu((unsigned)eperm_h, e15);
      const unsigned char* ub = p.Ub + (size_t)ide * 1024 + g4 * 16;
      uint4 ua[8];
#pragma unroll
      for (int sI = 0; sI < 8; ++sI) ua[sI] = *(const uint4*)(ub + sI * 64);
      pg8::f32x4 hacc = {0.f, 0.f, 0.f, 0.f};
#pragma unroll
      for (int sI = 0; sI < 8; ++sI) {
        const uint4 b0 = *(const uint4*)(smem + 32768 + wid * 1024 + sI * 128 + g4 * 16);
        const uint4 b1 = *(const uint4*)(smem + 32768 + wid * 1024 + sI * 128 + 64 + g4 * 16);
        const i32x8 A = {(int)ua[sI].x, (int)ua[sI].y, (int)ua[sI].z, (int)ua[sI].w, 0, 0, 0, 0};
        const i32x8 B = {(int)b0.x, (int)b0.y, (int)b0.z, (int)b0.w, (int)b1.x, (int)b1.y, (int)b1.z, (int)b1.w};
        hacc = __builtin_amdgcn_mfma_scale_f32_16x16x128_f8f6f4(A, B, hacc, 4  , 0  , 0, 0x7f7f7f7f, 0, 0x7f7f7f7f);
      }
      asm volatile("" ::: "memory");
      uint2 V[16];
#pragma unroll
      for (int k = 0; k < 16; ++k) {
        const int id = __builtin_amdgcn_readlane(eperm_h, k);
        V[k] = *(const uint2*)(p.Ub + (size_t)id * 1024 + 512 + lane * 8);
      }
      float actv[4];
#pragma unroll
      for (int r4 = 0; r4 < 4; ++r4) {
        const float gl = __builtin_bit_cast(float, shu((unsigned)gperm_h, 4 * g4 + r4));
        actv[r4] = gelu_tanh(hacc[r4] * (1.0f / 64.0f)) * gl;
      }
#pragma unroll
      for (int k = 0; k < 16; ++k) {
        const float ak = __builtin_bit_cast(float, __builtin_amdgcn_readlane(__builtin_bit_cast(int, actv[k & 3]), 16 * (k >> 2)));
        const h2_t akh = {(_Float16)ak, (_Float16)ak};
        const unsigned vw[2] = {V[k].x, V[k].y};
#pragma unroll
        for (int q2 = 0; q2 < 2; ++q2) {
          yh[4 * q2 + 0] = __builtin_elementwise_fma(akh, __builtin_bit_cast(h2_t, __builtin_amdgcn_cvt_scalef32_pk_f16_fp4(vw[q2], 1.0f, 0)), yh[4 * q2 + 0]);
          yh[4 * q2 + 1] = __builtin_elementwise_fma(akh, __builtin_bit_cast(h2_t, __builtin_amdgcn_cvt_scalef32_pk_f16_fp4(vw[q2], 1.0f, 1)), yh[4 * q2 + 1]);
          yh[4 * q2 + 2] = __builtin_elementwise_fma(akh, __builtin_bit_cast(h2_t, __builtin_amdgcn_cvt_scalef32_pk_f16_fp4(vw[q2], 1.0f, 2)), yh[4 * q2 + 2]);
          yh[4 * q2 + 3] = __builtin_elementwise_fma(akh, __builtin_bit_cast(h2_t, __builtin_amdgcn_cvt_scalef32_pk_f16_fp4(vw[q2], 1.0f, 3)), yh[4 * q2 + 3]);
        }
      }
    }
    float yacc[16];
#pragma unroll
    for (int i = 0; i < 8; ++i) { yacc[2 * i] = (float)yh[i].x; yacc[2 * i + 1] = (float)yh[i].y; }
    const int bi = tok < NLAT ? (tok >> 12) : 8;
    const float* gv = p.mod + ((size_t)(l * 9 + bi) * 6 + 5) * 1024 + lane * 16;
    float* xp = (tok < NLAT) ? (p.out + (size_t)tok * 1024) : (p.ctxs + (size_t)(tok - NLAT) * 1024);
    xp += lane * 16;
    float4 xv[4];
    float ss = 0.f;
#pragma unroll
    for (int i = 0; i < 4; ++i) {
      xv[i] = *(float4*)(xp + 4 * i);
      const float4 g4 = *(const float4*)(gv + 4 * i);
      xv[i].x += g4.x * yacc[4 * i] * 0.25f; xv[i].y += g4.y * yacc[4 * i + 1] * 0.25f; xv[i].z += g4.z * yacc[4 * i + 2] * 0.25f; xv[i].w += g4.w * yacc[4 * i + 3] * 0.25f;
      ss += xv[i].x * xv[i].x + xv[i].y * xv[i].y + xv[i].z * xv[i].z + xv[i].w * xv[i].w;
    }
    ss = wave_sum(ss);
    const float rstd = rsqrtf(ss * (1.0f / 1024.0f) + 1e-6f);
    if (l == 0) {
      const float* gam = p.norm_mix_g + 1024 + lane * 16;
      const float* msh = p.mod + ((size_t)(9 + bi) * 6 + 0) * 1024 + lane * 16;
      const float* msc = msh + 1024;
      float yv[16];
      float amax = 0.f;
#pragma unroll
      for (int i = 0; i < 4; ++i) {
        if (do_store) *(float4*)(xp + 4 * i) = xv[i];
        const float4 g = *(const float4*)(gam + 4 * i);
        const float4 sh = *(const float4*)(msh + 4 * i);
        const float4 sc = *(const float4*)(msc + 4 * i);
        yv[4 * i] = xv[i].x * rstd * g.x * (1.f + sc.x) + sh.x; yv[4 * i + 1] = xv[i].y * rstd * g.y * (1.f + sc.y) + sh.y;
        yv[4 * i + 2] = xv[i].z * rstd * g.z * (1.f + sc.z) + sh.z; yv[4 * i + 3] = xv[i].w * rstd * g.w * (1.f + sc.w) + sh.w;
      }
#pragma unroll
      for (int i = 0; i < 16; ++i) amax = fmaxf(amax, fabsf(yv[i]));
      amax = fmaxf(wave_max(amax), 1e-20f);
      const float inv = 127.0f / amax;
      unsigned w[4];
#pragma unroll
      for (int i = 0; i < 4; ++i)
        w[i] = ((unsigned)__float2int_rn(yv[4 * i] * inv) & 255u) | (((unsigned)__float2int_rn(yv[4 * i + 1] * inv) & 255u) << 8) |
               (((unsigned)__float2int_rn(yv[4 * i + 2] * inv) & 255u) << 16) | (((unsigned)__float2int_rn(yv[4 * i + 3] * inv) & 255u) << 24);
      if (do_store) {
        *(uint4*)(p.xn8 + (size_t)tok * 1024 + lane * 16) = make_uint4(w[0], w[1], w[2], w[3]);
        if (lane == 0) p.sa[tok] = amax * (1.0f / 127.0f);
      }
    } else {
      const float* fg = p.final_g + lane * 16;
#pragma unroll
      for (int i = 0; i < 4; ++i) {
        const float4 g = *(const float4*)(fg + 4 * i);
        const float4 o = make_float4(xv[i].x * rstd * g.x, xv[i].y * rstd * g.y, xv[i].z * rstd * g.z, xv[i].w * rstd * g.w);
        if (do_store) *(float4*)(xp + 4 * i) = o;
      }
    }
  }
}


#define XB_TMO      128
#define XB_XCNT(j)  (256  + 64 * (j))
#define XB_XSUB(j)  (1280 + 64 * (j))
#define XB_XGEN(j)  (2304 + 64 * (j))
#define XB_TOP      3328
#define XB_TOPGEN   3392
#define XCD_BAR_WORDS 3456
#define XB_SPIN_CAP (1u << 22)
#define LAS __attribute__((address_space(3)))
__device__ __forceinline__ unsigned xb_ld(unsigned* p) { return __hip_atomic_load(p, __ATOMIC_RELAXED, __HIP_MEMORY_SCOPE_AGENT); }
__device__ __forceinline__ unsigned xb_add(unsigned* p, unsigned v) { return __hip_atomic_fetch_add(p, v, __ATOMIC_RELAXED, __HIP_MEMORY_SCOPE_AGENT); }
__device__ __forceinline__ unsigned xb_xcc_id() { return (unsigned)__builtin_amdgcn_s_getreg((3 << 11) | 20) & 0xFu; }
#define XB_SPIN(cond, bar) do { unsigned _sp = 0; while (cond) { __builtin_amdgcn_s_sleep(1); \
    if ((++_sp & 255u) == 0u) { if (xb_ld(&(bar)[XB_TMO])) break; if (_sp > XB_SPIN_CAP) { atomicAdd(&(bar)[XB_TMO], 1u); break; } } } } while (0)
struct XcdBarrier { unsigned* bar; unsigned x; volatile LAS unsigned* st; };
__device__ __forceinline__ XcdBarrier xcd_barrier_post(unsigned* bar, volatile LAS unsigned* st) {
  XcdBarrier b; b.bar = bar; b.x = xb_xcc_id(); b.st = st;
  if (threadIdx.x == 0) (void)xb_add(&bar[XB_XCNT(b.x)], 1u);
  return b;
}
__device__ __forceinline__ void xcd_barrier_complete(unsigned* bar, unsigned x, unsigned& nloc, unsigned& nx) {
  const unsigned G = gridDim.x * gridDim.y * gridDim.z;
  unsigned sum, cnt, mine, sp = 0u;
  for (;;) {
    sum = 0u; cnt = 0u; mine = 0u;
#pragma unroll
    for (unsigned j = 0; j < 16; ++j) { const unsigned c = xb_ld(&bar[XB_XCNT(j)]); sum += c; cnt += (c > 0u) ? 1u : 0u; mine = (j == x) ? c : mine; }
    if (sum == G) break;
    __builtin_amdgcn_s_sleep(1);
    if ((++sp & 255u) == 0u) { if (xb_ld(&bar[XB_TMO])) break; if (sp > XB_SPIN_CAP) { atomicAdd(&bar[XB_TMO], 1u); break; } }
  }
  nloc = mine > 0u ? mine : 1u; nx = cnt > 0u ? cnt : 1u;
}
__device__ __forceinline__ void xcd_barrier(unsigned* bar_u, volatile LAS unsigned* st_u) {
  XcdBarrier b; b.bar = bar_u; b.x = xb_xcc_id(); b.st = st_u;
  asm volatile("s_waitcnt vmcnt(0)" ::: "memory");
  __syncthreads();
  if (threadIdx.x == 0) {
    unsigned long long bp_ = (unsigned long long)b.bar;
    asm volatile("" : "+v"(bp_));
    unsigned* bar = (unsigned*)bp_;
    __builtin_amdgcn_s_waitcnt(0);
    unsigned nloc = b.st[0], nx = b.st[1];
    if (nloc == 0u) { xcd_barrier_complete(bar, b.x, nloc, nx); b.st[0] = nloc; b.st[1] = nx; }
    const unsigned old = xb_add(&bar[XB_XSUB(b.x)], 1u);
    const unsigned gen = old / nloc;
    if (old + 1u == (gen + 1u) * nloc) {
      __builtin_amdgcn_fence(__ATOMIC_RELEASE, "agent");
      asm volatile("s_waitcnt vmcnt(0)" ::: "memory");
      const unsigned og = xb_add(&bar[XB_TOP], 1u);
      const unsigned tg = og / nx;
      if (og + 1u == (tg + 1u) * nx) xb_add(&bar[XB_TOPGEN], 1u);
      else XB_SPIN(xb_ld(&bar[XB_TOPGEN]) == tg, bar);
      __builtin_amdgcn_fence(__ATOMIC_ACQUIRE, "agent");
      xb_add(&bar[XB_XGEN(b.x)], 1u);
      asm volatile("s_waitcnt vmcnt(0)" ::: "memory");
    } else {
      XB_SPIN(xb_ld(&bar[XB_XGEN(b.x)]) == gen, bar);
      __builtin_amdgcn_fence(__ATOMIC_ACQUIRE, "agent");
      asm volatile("s_waitcnt vmcnt(0)" ::: "memory");
    }
  }
  __syncthreads();
}

template <int l>
__device__ __forceinline__ void layer_body(const P& p, char* smem, pg8::PG8_LAS_T lds, volatile LAS unsigned* xbw, const int nb, const int bid) {
    const bool last = (l == 1);
    const int n_mt = last ? 128 : 136;
    if (l == 0) {
      phase_norm(p, l, 0);
      xcd_barrier(p.counters + 1024, xbw);
    }
_Pragma("unroll 1")
    for (int rep = 0; rep < REP_INPROJ; ++rep) {
      pg8::Gemm g; pg8::Order S;
      g.A = (const u16*)p.xn8; g.Bt = (const u16*)(p.Win8 + (size_t)l * 2816 * 1024); g.lda = 512; g.ldb = 512; g.K = 512;
      S.init(136, 6, nb, bid, 4, 5);
      pg8::EpiInprojN8 e1; e1.qk = p.qk; e1.rg = p.rg; e1.sa = p.sa; e1.sw = p.sw + l * 5888;
      pg8::gemm_phase(lds, g, S, e1);
      g.A = (const u16*)(p.Win8 + ((size_t)l * 2816 + 1024) * 1024); g.Bt = (const u16*)p.xn8;
      S.init(5, 136, nb, bid);
      pg8::EpiInprojT8 e2; e2.vT = p.vT; e2.sa = p.sa; e2.sw = p.sw + l * 5888 + 1024;
      pg8::gemm_phase(lds, g, S, e2);
    }
    xcd_barrier(p.counters + 1024, xbw);
    phase_mixers(p, l, smem, p.counters + l * 4);
    xcd_barrier(p.counters + 1024, xbw);
_Pragma("unroll 1")
    for (int rep = 0; rep < REP_2B; ++rep)
      for (int task = bid; task < 1088 + 512; task += nb) {
        if (task < 1088) rg_wave_task(p, l, task >> 2, task & 3, 1, last, smem);
        else yb_transpose_task(p, (task - 1088) >> 6, (task - 1088) & 63, smem);
      }
    xcd_barrier(p.counters + 1024, xbw);
_Pragma("unroll 1")
    for (int rep = 0; rep < REP_GATE; ++rep) {
      pg8::Gemm g; pg8::Order S;
      g.A = (const u16*)p.xn8; g.Bt = (const u16*)(p.Wg8 + (size_t)l * 3072 * 1024); g.lda = 512; g.ldb = 512; g.K = 512;
      S.init(n_mt, 12, nb, bid);
      pg8::EpiGate8 e; e.g8 = p.g8; e.bias = p.b_gate + l * 3072; e.sa = p.sa; e.sw = p.sw + l * 5888 + 2816;
      pg8::gemm_phase(lds, g, S, e);
    }
    xcd_barrier(p.counters + 1024, xbw);
_Pragma("unroll 1")
    for (int rep = 0; rep < REP_BRANCH; ++rep) {
      pg8::Gemm g; pg8::Order S;
      S.init(n_mt, 4, nb, bid);
      pg8::EpiBranch e; e.mbuf = p.mbuf; e.g8 = p.g8;
      g.lda = 1024;
      g.A = p.ycat; g.Bt = p.WaT + (size_t)l * 1024 * 512; g.ldb = 512; g.K = 512; e.br = 0;
      pg8::gemm_phase(lds, g, S, e);
      g.A = p.ycat + 512; g.Bt = p.WbT + (size_t)l * 1024 * 256; g.ldb = 256; g.K = 256; e.br = 1;
      pg8::gemm_phase(lds, g, S, e);
      g.A = p.ycat + 768; g.Bt = p.WcT + (size_t)l * 1024 * 256; g.ldb = 256; g.K = 256; e.br = 2;
      pg8::gemm_phase(lds, g, S, e);
    }
    xcd_barrier(p.counters + 1024, xbw);
    {
      pg8::Gemm g; pg8::Order S;
      g.A = p.mbuf; g.Bt = p.WoT + (size_t)l * 1024 * 1024; g.lda = 1024; g.ldb = 1024; g.K = 1024;
      S.init(n_mt, 4, nb, bid);
      pg8::EpiOut e; e.xsrc = (l == 0 ? p.x : p.out); e.csrc = (l == 0 ? p.ctx : p.ctxs); e.xdst = p.out; e.cdst = p.ctxs;
      e.modl = p.mod + (size_t)l * 9 * 6144;
      pg8::gemm_phase(lds, g, S, e);
      for (int t = bid; t < 8192; t += nb) {
        if (t < 4096) cvt_chunk_fp4(p.peer_u + (size_t)l * 16384 * 1024, p.Ub, (size_t)t, 64.0f, 0);
        else cvt_chunk_fp4(p.peer_v + (size_t)l * 16384 * 1024, p.Ub, (size_t)(t - 4096), 4.0f, 1);
      }
    }
    xcd_barrier(p.counters + 1024, xbw);
    phase_norm(p, l, 1);
    xcd_barrier(p.counters + 1024, xbw);
_Pragma("unroll 1")
    for (int rep = 0; rep < REP_Q; ++rep) {
      pg8::Gemm g; pg8::Order S;
      g.A = p.xn; g.Bt = p.WqkT + (size_t)l * 2048 * 1024; g.lda = 1024; g.ldb = 1024; g.K = 1024;
      S.init(n_mt, 8, nb, bid);
      pg8::EpiQ e; e.q = p.q;
      pg8::gemm_phase(lds, g, S, e);
    }
    xcd_barrier(p.counters + 1024, xbw);
_Pragma("unroll 1")
    for (int rep = 0; rep < REP_SCORE; ++rep)
      for (int task = bid; task < n_mt * 16; task += nb) peer_score_tile(p, l, task >> 4, task & 15, smem);
    xcd_barrier(p.counters + 1024, xbw);
_Pragma("unroll 1")
    for (int rep = 0; rep < REP_PEER; ++rep) phase_peer_experts(p, l, rep == REP_PEER - 1, smem);
    xcd_barrier(p.counters + 1024, xbw);
  }

__global__ void __launch_bounds__(NTHR) fwd_megakernel(P p) {
  __shared__ __attribute__((aligned(16))) char smem[SMEM_BYTES];
  cg::grid_group grid = cg::this_grid();
  const int nb = gridDim.x, bid = blockIdx.x;
  pg8::PG8_LAS_T lds = (pg8::PG8_LAS_T)smem;
  volatile LAS unsigned* xbw = (volatile LAS unsigned*)(smem + SMEM_BYTES - 32);
  if (threadIdx.x == 0) { xbw[0] = 0u; xbw[1] = 0u; xbw[2] = 0u; xbw[3] = 0u; }
  __syncthreads();
  (void)xcd_barrier_post(p.counters + 1024, xbw);

  phase_prep(p, smem);
  if (blockIdx.x < 136) phase_filters(p, 0, smem);
  if (blockIdx.x >= gridDim.x - 128) { for (int t = blockIdx.x - (gridDim.x - 128); t < 128; t += 128) filter_block_task(p, 1, 4096, t * 32, p.hT + (size_t)512 * 4096, smem); }
  grid.sync();
  phase_modreduce(p);
  for (int task = blockIdx.x; task < 512; task += gridDim.x) kf_task(p, task >> 8, task & 255, smem);
  for (int task = blockIdx.x; task < 256; task += gridDim.x) wqk_task(p, task >> 7, (task >> 3) & 15, task & 7, smem);
  for (int task = blockIdx.x; task < 2 * 1472; task += gridDim.x) {
    const int l = task / 1472, t = task - l * 1472;
    if (t < 704) tr_tile_i8(p.w_in + (size_t)l * 1024 * 2816, 2816, 1024, p.Win8 + (size_t)l * 2816 * 1024, t, p.sw + l * 5888, smem);
    else tr_tile_i8(p.w_gate + (size_t)l * 1024 * 3072, 3072, 1024, p.Wg8 + (size_t)l * 3072 * 1024, t - 704, p.sw + l * 5888 + 2816, smem);
  }
  xcd_barrier(p.counters + 1024, xbw);

  layer_body<0>(p, smem, lds, xbw, nb, bid);
  layer_body<1>(p, smem, lds, xbw, nb, bid);
}

extern "C" void kernel_launch(void* const* d_in, const int* in_sizes, int n_in, void* d_out, int out_size, void* d_ws,
                              size_t ws_size, hipStream_t stream) {
  P p;
  memset(&p, 0, sizeof(p));
  const float** ins = (const float**)&p;
  for (int i = 0; i < 37; ++i) ins[i] = (const float*)d_in[i];
  p.out = (float*)d_out;
  char* w = (char*)d_ws;
  size_t off = 0;
  auto take = [&](size_t bytes) { char* r = w + off; off += (bytes + 255) & ~(size_t)255; return r; };
  p.counters = (unsigned*)take(32768);
  p.WinT = nullptr; p.WgT = nullptr;
  p.Win8 = (unsigned char*)take((size_t)2 * 2816 * 1024);
  p.Wg8 = (unsigned char*)take((size_t)2 * 3072 * 1024);
  p.sw = (float*)take((size_t)2 * 5888 * 4);
  p.xn8 = (unsigned char*)take((size_t)NTOK * 1024);
  p.sa = (float*)take((size_t)NTOK * 4);
  p.WaT = (u16*)take((size_t)2 * 1024 * 512 * 2);
  p.WbT = (u16*)take((size_t)2 * 1024 * 256 * 2);
  p.WcT = (u16*)take((size_t)2 * 1024 * 256 * 2);
  p.WoT = (u16*)take((size_t)2 * 1024 * 1024 * 2);
  p.WqB = (u16*)take((size_t)2 * 1024 * 2048 * 2);
  p.WqkT = (u16*)take((size_t)2 * 2048 * 1024 * 2);
  p.keysB = (u16*)take((size_t)2 * 16 * 16384 * 2);
  p.rgW = (u16*)take((size_t)2 * 16 * 4096 * 2);
  p.modpart = (float*)take((size_t)16 * 2 * 9 * 6144 * 4);
  p.mod = (float*)take((size_t)2 * 9 * 6144 * 4);
  p.hT = (float*)take((size_t)2 * 512 * 4096 * 4);
  p.hc = (float*)take((size_t)512 * 256 * 4);
  p.Kf = (float*)take((size_t)2 * 256 * 8192 * 8);
  p.xn = (u16*)take((size_t)NTOK * 1024 * 2);
  p.qk = (u16*)take((size_t)NTOK * 1024 * 2);
  p.mbuf = p.qk;
  p.vT = (u16*)take((size_t)8 * 512 * 4096 * 2);
  p.vTc = (u16*)take((size_t)8 * 512 * 256 * 2);
  p.hyT = (u16*)take((size_t)8 * 768 * 4096 * 2);
  p.hyTc = (u16*)take((size_t)8 * 768 * 256 * 2);
  p.rg = (u16*)take((size_t)NTOK * 512 * 2);
  p.ycat = (u16*)take((size_t)NTOK * 1024 * 2);
  p.Ub = (unsigned char*)p.ycat;
  p.Vb = p.Ub + (size_t)16384 * 512;
  p.agg = (float*)take((size_t)8 * 2 * (136 + 34) * 256 * 8);
  p.ybT = (u16*)take((size_t)8 * 256 * 4096 * 2);
  p.ctxs = (float*)take((size_t)2048 * 1024 * 4);
  p.g8 = (unsigned char*)p.vT;
  p.q = p.qk;
  p.topk = (unsigned*)((char*)p.qk + (size_t)NTOK * 2048 * 2);
  if (off > ws_size) {
    fprintf(stderr, "workspace too small: need %zu have %zu\n", off, ws_size);
    return;
  }
  static int grid_blocks = 0;
  if (!grid_blocks) {
    int dev = 0, cus = 0, per_cu = 0;
    (void)hipGetDevice(&dev);
    (void)hipDeviceGetAttribute(&cus, hipDeviceAttributeMultiprocessorCount, dev);
    (void)hipOccupancyMaxActiveBlocksPerMultiprocessor(&per_cu, fwd_megakernel, NTHR, 0);
    if (per_cu > 1) per_cu = 1;
    grid_blocks = cus * per_cu;
  }
  (void)hipMemsetAsync(p.counters, 0, 32768, stream);
  void* args[] = {&p};
  hipError_t e = hipLaunchCooperativeKernel((void*)fwd_megakernel, dim3(grid_blocks), dim3(NTHR), args, 0, stream);
  if (e != hipSuccess) fprintf(stderr, "cooperative launch failed: %s (grid %d)\n", hipGetErrorString(e), grid_blocks);
}
```

```cpp
#include <hip/hip_runtime.h>
#include <hip/hip_cooperative_groups.h>
#include <cstdio>
#include <cstring>
namespace cg = cooperative_groups;

typedef unsigned short u16;
typedef __attribute__((ext_vector_type(8))) short bf16x8;
typedef __attribute__((ext_vector_type(16))) float f32x16;
typedef __attribute__((ext_vector_type(2))) float f32x2;
typedef int i32x8 __attribute__((ext_vector_type(8)));

#define NLAT 32768
#define NTOK 34816
#define SMEM_BYTES 151552
#define NTHR 512
#ifndef DUP_1A
#define DUP_1A 1
#endif
#ifndef DUP_PREP
#define DUP_PREP 1
#endif
#ifndef DUP_2B
#define DUP_2B 1
#endif
#ifndef XRGA
#define XRGA 1
#endif
#ifndef REP_PEER
#define REP_PEER 1
#endif
#ifndef REP_INPROJ
#define REP_INPROJ 1
#endif
#ifndef REP_GATE
#define REP_GATE 1
#endif
#ifndef REP_BRANCH
#define REP_BRANCH 1
#endif
#ifndef REP_Q
#define REP_Q 1
#endif
#ifndef REP_SCORE
#define REP_SCORE 1
#endif
#ifndef REP_1A
#define REP_1A 1
#endif
#ifndef REP_2B
#define REP_2B 1
#endif
#ifndef REP_KF
#define REP_KF 1
#endif
#ifndef DUP_GEMM
#define DUP_GEMM 1
#endif
#ifndef DUP_PEER
#define DUP_PEER 1
#endif
#ifndef DUP_MIX
#define DUP_MIX 1
#endif
#ifndef XRG
#define XRG 1
#endif
#ifndef XFFT
#define XFFT 1
#endif
#ifndef XATT
#define XATT 1
#endif

struct P {
  const float *x, *c, *ctx, *c_ctx, *norm_mix_g, *norm_ffn_g, *w_ada, *b_ada, *w_in, *na_rpb,
      *hy_short_w, *hy_short_b, *hy_f1_w, *hy_f1_b, *hy_f2_w, *hy_f2_b, *hy_f3_w, *hy_freq, *hy_bias,
      *rg_conv_w, *rg_conv_b, *rg_wa, *rg_ba, *rg_wx, *rg_bx, *rg_lambda,
      *w_gate, *b_gate, *w_br_a, *w_br_b, *w_br_c, *w_out, *peer_wq, *peer_keys, *peer_u, *peer_v, *final_g;
  float* out;
  unsigned* counters;
  u16 *WinT, *WgT, *WaT, *WbT, *WcT, *WoT, *WqB, *WqkT, *keysB, *rgW;
  float *modpart, *mod, *hT, *hc;
  float* Kf;
  u16 *xn, *qk, *vT, *vTc, *hyT, *hyTc, *rg, *ycat, *mbuf, *ybT;
  unsigned char *Ub, *Vb, *g8, *xn8, *Win8, *Wg8;
  float *sa, *sw;
  u16* q;
  float *agg, *ctxs;
  unsigned* topk;
};

__device__ __forceinline__ u16 f2bf(float f) {
  unsigned u = __float_as_uint(f);
  u += 0x7fffu + ((u >> 16) & 1u);
  return (u16)(u >> 16);
}
__device__ __forceinline__ float bf2f(u16 h) { return __uint_as_float(((unsigned)h) << 16); }
__device__ __forceinline__ unsigned pk2(float a, float b) { return (unsigned)f2bf(a) | ((unsigned)f2bf(b) << 16); }
__device__ __forceinline__ float bflo(unsigned u) { return __uint_as_float(u << 16); }
__device__ __forceinline__ float bfhi(unsigned u) { return __uint_as_float(u & 0xffff0000u); }
__device__ __forceinline__ int opaque_tid() {
  int t = threadIdx.x;
  asm volatile("" : "+v"(t));
  return t;
}
__device__ __forceinline__ int my_lane() { return opaque_tid() & 63; }
__device__ __forceinline__ float shx(float v, int o);
__device__ __forceinline__ float shf(float v, int src) { return __builtin_bit_cast(float, __builtin_amdgcn_ds_bpermute((src & 63) << 2, __builtin_bit_cast(int, v))); }
__device__ __forceinline__ unsigned shu(unsigned v, int src) { return (unsigned)__builtin_amdgcn_ds_bpermute((src & 63) << 2, (int)v); }
typedef unsigned u32x2_t __attribute__((ext_vector_type(2)));
template <int J> __device__ __forceinline__ unsigned xorl(unsigned v, int lane) {
  if constexpr (J == 1) return (unsigned)__builtin_amdgcn_mov_dpp((int)v, 0xB1, 0xF, 0xF, true);
  else if constexpr (J == 2) return (unsigned)__builtin_amdgcn_mov_dpp((int)v, 0x4E, 0xF, 0xF, true);
  else if constexpr (J == 4) {
    const unsigned a = (unsigned)__builtin_amdgcn_mov_dpp((int)v, 0x104, 0xF, 0xF, true);
    const unsigned b = (unsigned)__builtin_amdgcn_mov_dpp((int)v, 0x114, 0xF, 0xF, true);
    return (lane & 4) ? b : a;
  }
  else if constexpr (J == 8) return (unsigned)__builtin_amdgcn_mov_dpp((int)v, 0x128, 0xF, 0xF, true);
  else if constexpr (J == 16) { const u32x2_t r = __builtin_amdgcn_permlane16_swap(v, v, false, false); return (lane & 16) ? r.x : r.y; }
  else { const u32x2_t r = __builtin_amdgcn_permlane32_swap(v, v, false, false); return (lane & 32) ? r.x : r.y; }
}
template <int J> __device__ __forceinline__ float xorf(float v, int lane) { return __uint_as_float(xorl<J>(__float_as_uint(v), lane)); }
__device__ __forceinline__ float shx(float v, int o) {
  const int lane = my_lane();
  switch (o) {
    case 1: return xorf<1>(v, lane);
    case 2: return xorf<2>(v, lane);
    case 4: return xorf<4>(v, lane);
    case 8: return xorf<8>(v, lane);
    case 16: return xorf<16>(v, lane);
    case 32: return xorf<32>(v, lane);
    default: return __builtin_bit_cast(float, __builtin_amdgcn_ds_bpermute(((lane ^ o) << 2), __builtin_bit_cast(int, v)));
  }
}
__device__ __forceinline__ float wave_sum(float v) {
  const int lane = my_lane();
  v += xorf<32>(v, lane); v += xorf<16>(v, lane); v += xorf<8>(v, lane); v += xorf<4>(v, lane); v += xorf<2>(v, lane); v += xorf<1>(v, lane);
  return v;
}
__device__ __forceinline__ float wave_max(float v) {
  const int lane = my_lane();
  v = fmaxf(v, xorf<32>(v, lane)); v = fmaxf(v, xorf<16>(v, lane)); v = fmaxf(v, xorf<8>(v, lane));
  v = fmaxf(v, xorf<4>(v, lane)); v = fmaxf(v, xorf<2>(v, lane)); v = fmaxf(v, xorf<1>(v, lane));
  return v;
}
__device__ __forceinline__ float sigmoidf_(float x) { return __builtin_amdgcn_rcpf(1.0f + __expf(-x)); }
__device__ __forceinline__ float gelu_tanh(float x) {
  const float u2 = 1.5957691216057308f * (x + 0.044715f * x * x * x);
  return x * __builtin_amdgcn_rcpf(1.0f + __expf(-u2));
}
__device__ __forceinline__ f32x16 mfma32(bf16x8 a, bf16x8 b, f32x16 c) {
  return __builtin_amdgcn_mfma_f32_32x32x16_bf16(a, b, c, 0, 0, 0);
}
__device__ __forceinline__ f32x16 zero16() {
  f32x16 z;
#pragma unroll
  for (int i = 0; i < 16; ++i) z[i] = 0.f;
  return z;
}
__device__ __forceinline__ int swz128(int row, int ch) { return row * 128 + ((ch ^ ((row >> 1) & 7)) << 4); }
__device__ __forceinline__ int swz256(int row, int ch) { return row * 256 + ((ch ^ (row & 15)) << 4); }

struct c2 { float x, y; };
__device__ __forceinline__ c2 cadd(c2 a, c2 b) { return {a.x + b.x, a.y + b.y}; }
__device__ __forceinline__ c2 csub(c2 a, c2 b) { return {a.x - b.x, a.y - b.y}; }
__device__ __forceinline__ c2 cmul(c2 a, c2 b) { return {a.x * b.x - a.y * b.y, a.x * b.y + a.y * b.x}; }
__device__ __forceinline__ float c16(int i) {
  const float tb[16] = {1.0f, 0.9238795325112867f, 0.7071067811865476f, 0.3826834323650898f, 0.0f,
                        -0.3826834323650898f, -0.7071067811865476f, -0.9238795325112867f, -1.0f,
                        -0.9238795325112867f, -0.7071067811865476f, -0.3826834323650898f, 0.0f,
                        0.3826834323650898f, 0.7071067811865476f, 0.9238795325112867f};
  return tb[i & 15];
}
__device__ __forceinline__ float s16(int i) { return c16(i + 12); }
template <int R> __device__ __forceinline__ constexpr int brev(int k) {
  int r = 0;
  for (int b = 1, o = R >> 1; b < R; b <<= 1, o >>= 1)
    if (k & b) r |= o;
  return r;
}
template <int R> __device__ __forceinline__ void dft_reg(c2* v, float sgn) {
#pragma unroll
  for (int h = R / 2; h >= 1; h >>= 1) {
#pragma unroll
    for (int g = 0; g < R; g += 2 * h) {
#pragma unroll
      for (int j = 0; j < h; ++j) {
        c2 a = v[g + j], b = v[g + j + h];
        v[g + j] = cadd(a, b);
        c2 d = csub(a, b);
        const int ti = j * (16 / (2 * h));
        c2 w = {c16(ti), sgn * s16(ti)};
        v[g + j + h] = (j == 0) ? d : cmul(d, w);
      }
    }
  }
}
template <int R> __device__ __forceinline__ int fft_bfly(c2* v, int j, int Ns, float sgn) {
  const int k = j & (Ns - 1);
  const float f = sgn * (float)k / (float)(Ns * R);
#pragma unroll
  for (int r = 1; r < R; ++r) {
    float t = f * (float)r;
    c2 w = {__builtin_amdgcn_cosf(t), __builtin_amdgcn_sinf(t)};
    v[r] = cmul(v[r], w);
  }
  dft_reg<R>(v, sgn);
  return (j - k) * R + k;
}
template <int R> __device__ __forceinline__ void fft_pass(c2* buf, int Ns, float sgn) {
  constexpr int NBF = 8192 / R;
  constexpr int PER = NBF / NTHR;
  const int tid = opaque_tid();
  c2 v[PER][R];
#pragma unroll
  for (int i = 0; i < PER; ++i) {
    const int j = tid + NTHR * i;
#pragma unroll
    for (int r = 0; r < R; ++r) v[i][r] = buf[j + r * NBF];
  }
  __syncthreads();
#pragma unroll
  for (int i = 0; i < PER; ++i) {
    const int j = tid + NTHR * i;
    const int base = fft_bfly<R>(v[i], j, Ns, sgn);
#pragma unroll
    for (int r = 0; r < R; ++r) buf[base + r * Ns] = v[i][brev<R>(r)];
  }
  __syncthreads();
}
__device__ __forceinline__ void fft8192(c2* buf, float sgn) {
  fft_pass<8>(buf, 1, sgn);
  fft_pass<8>(buf, 8, sgn);
  fft_pass<8>(buf, 64, sgn);
  fft_pass<16>(buf, 512, sgn);
}

__device__ __forceinline__ void gemm_kloop(f32x16 (&acc)[2][2], const u16* __restrict__ A, int lda,
                                           const u16* __restrict__ B, int ldb, int K, char* smem) {
  const int tid = opaque_tid(), lane = tid & 63, wid = tid >> 6;
  const int wm = wid >> 1, wn = wid & 1;
  const int l31 = lane & 31, hh = lane >> 5;
  uint4 ra[4], rb[2];
  const int nk = K >> 6;
  const int srow = tid >> 3, sch = tid & 7;
  const char* Ab = (const char*)A;
  const char* Bb = (const char*)B;
  const unsigned aoff = (unsigned)(srow * lda + sch * 8) * 2u;
  const unsigned boff = (unsigned)(srow * ldb + sch * 8) * 2u;
  const unsigned astep = (unsigned)lda * 128u, bstep = (unsigned)ldb * 128u;
#pragma unroll
  for (int i = 0; i < 4; ++i) ra[i] = *(const uint4*)(Ab + (aoff + i * astep));
#pragma unroll
  for (int i = 0; i < 2; ++i) rb[i] = *(const uint4*)(Bb + (boff + i * bstep));
#pragma unroll
  for (int i = 0; i < 4; ++i) *(uint4*)(smem + swz128(srow + i * 64, sch)) = ra[i];
#pragma unroll
  for (int i = 0; i < 2; ++i) *(uint4*)(smem + 65536 + swz128(srow + i * 64, sch)) = rb[i];
  __syncthreads();
  for (int kt = 0; kt < nk; ++kt) {
    const bool more = (kt + 1 < nk);
    if (more) {
      const unsigned ko = (unsigned)(kt + 1) * 128u;
#pragma unroll
      for (int i = 0; i < 4; ++i) ra[i] = *(const uint4*)(Ab + (aoff + i * astep + ko));
#pragma unroll
      for (int i = 0; i < 2; ++i) rb[i] = *(const uint4*)(Bb + (boff + i * bstep + ko));
    }
    const char* as = smem + (kt & 1) * 32768;
    const char* bs = smem + 65536 + (kt & 1) * 16384;
    int lrow = l31;
    asm volatile("" : "+v"(lrow));
#pragma unroll
    for (int s = 0; s < 4; ++s) {
      bf16x8 af[2], bfr[2];
#pragma unroll
      for (int i = 0; i < 2; ++i) af[i] = *(const bf16x8*)(as + swz128(wm * 64 + i * 32 + lrow, s * 2 + hh));
#pragma unroll
      for (int j = 0; j < 2; ++j) bfr[j] = *(const bf16x8*)(bs + swz128(wn * 64 + j * 32 + lrow, s * 2 + hh));
#pragma unroll
      for (int i = 0; i < 2; ++i)
#pragma unroll
        for (int j = 0; j < 2; ++j) acc[i][j] = mfma32(af[i], bfr[j], acc[i][j]);
    }
    if (more) {
      char* an = smem + ((kt + 1) & 1) * 32768;
      char* bn = smem + 65536 + ((kt + 1) & 1) * 16384;
      int sr2 = srow;
      asm volatile("" : "+v"(sr2));
#pragma unroll
      for (int i = 0; i < 4; ++i) *(uint4*)(an + swz128(sr2 + i * 64, sch)) = ra[i];
#pragma unroll
      for (int i = 0; i < 2; ++i) *(uint4*)(bn + swz128(sr2 + i * 64, sch)) = rb[i];
    }
    __syncthreads();
  }
}
__device__ __forceinline__ void zero_acc(f32x16 (&acc)[2][2]) {
#pragma unroll
  for (int i = 0; i < 2; ++i)
#pragma unroll
    for (int j = 0; j < 2; ++j) acc[i][j] = zero16();
}
#define EPI_ROW(i, e) (wm * 64 + (i)*32 + ((e)&3) + 8 * ((e) >> 2) + 4 * hh)
#define EPI_COL(j) (wn * 64 + (j)*32 + l31)
#define EPI_VARS                                                    \
  const int tid = opaque_tid(), lane = tid & 63, wid = tid >> 6;     \
  const int wm = wid >> 1, wn = wid & 1, l31 = lane & 31, hh = lane >> 5; \
  (void)tid; (void)wm; (void)wn; (void)l31; (void)hh;


namespace pg8 {
__device__ __forceinline__ unsigned pkh(float a, float b) { unsigned r; asm("v_cvt_pk_bf16_f32 %0, %1, %2" : "=v"(r) : "v"(a), "v"(b)); return r; }
#define PG8_LAS __attribute__((address_space(3)))
typedef PG8_LAS unsigned char* PG8_LAS_T;
typedef float f32x4 __attribute__((ext_vector_type(4)));
typedef unsigned u32x4 __attribute__((ext_vector_type(4)));
typedef int i32x4 __attribute__((ext_vector_type(4)));
constexpr int BM = 256, BK = 64, HALF = 128, HTB = HALF * BK * 2, STAGE_BYTES = 8 * HTB, NXCD = 8, WGM = 8;
__device__ __forceinline__ int lds_byte(int r, int c) { const int st = (r >> 4) * 2 + (c >> 5), rr = r & 15, cc = c & 31, ob = rr * 64 + cc * 2; return st * 1024 + (ob ^ (((ob >> 9) & 1) << 5)); }
__device__ __forceinline__ void stage_rc(int b, int& R, int& C) { const int st = b / 1024, sb = b % 1024, swz = sb ^ (((sb >> 9) & 1) << 5); R = (st >> 1) * 16 + swz / 64; C = (st & 1) * 32 + (swz % 64) / 2; }
__device__ __forceinline__ int perm32(int rho) { const int n = rho >> 4, i = rho & 15; return 8 * (i >> 2) + 4 * n + (i & 3); }
struct Unit { int pm, pn; };
struct Gemm { const u16* A; const u16* Bt; int lda, ldb, K; };
struct Order {
  int nM, nN, nwg, G, c, skip_from, skip_by;
  __device__ __forceinline__ void init(int nM_, int nN_, int G_, int c_, int sf = 1 << 30, int sb = 0) { nM = nM_; nN = nN_; nwg = nM * nN; G = G_; c = c_; skip_from = sf; skip_by = sb; }
  __device__ __forceinline__ bool next(int i, Unit& u) const {
    const long L = (long)i * G + c; if (L >= nwg) return false;
    int wgid = (int)L; { const int q = nwg / NXCD, r = nwg % NXCD, xcd = wgid % NXCD, off = wgid / NXCD; wgid = (xcd < r ? xcd * (q + 1) : r * (q + 1) + (xcd - r) * q) + off; }
    const int nig = WGM * nN, gid = wgid / nig, fm = gid * WGM, gsz = (nM - fm) < WGM ? (nM - fm) : WGM;
    u.pm = fm + ((wgid % nig) % gsz); u.pn = (wgid % nig) / gsz;
    if (u.pn >= skip_from) u.pn += skip_by;
    return true;
  }
};
__device__ __forceinline__ f32x4 mma16(bf16x8 a, bf16x8 b, f32x4 c) { return __builtin_amdgcn_mfma_f32_16x16x32_bf16(a, b, c, 0, 0, 0); }
__device__ __forceinline__ i32x4 mma16(bf16x8 a, bf16x8 b, i32x4 c) { return __builtin_amdgcn_mfma_i32_16x16x64_i8(__builtin_bit_cast(i32x4, a), __builtin_bit_cast(i32x4, b), c, 0, 0, 0); }
template <class Epi>
__device__ __forceinline__ void gemm_phase(PG8_LAS unsigned char* lds, const Gemm g, const Order& S, const Epi& E) {
  const int tid = opaque_tid(), wid = __builtin_amdgcn_readfirstlane(tid >> 6), lane = tid & 63, wr = wid >> 2, wc = wid & 3, fr = lane & 15, fq = lane >> 4;
  const int K = g.K, nt = K / BK;
  unsigned voffA[2], voffB[2];
#pragma unroll
  for (int i = 0; i < 2; ++i) { int R, C; stage_rc(tid * 16 + i * 8192, R, C); const int Rb = Epi::PERM ? ((R & ~31) + perm32(R & 31)) : R;
    voffA[i] = (unsigned)(R * g.lda + C) * 2u; voffB[i] = (unsigned)(Rb * g.ldb + C) * 2u; }
  const size_t kstep = (size_t)(BK * 2);
  const size_t hstepA = (size_t)HALF * g.lda * 2, hstepB = (size_t)HALF * g.ldb * 2;
  const size_t tstepA = 2 * hstepA, tstepB = 2 * hstepB;
  const unsigned ldsw = (unsigned)wid * 1024u;
  const int aoff = lds_byte(wr * 64 + fr, fq * 8), boff = lds_byte(wc * 32 + fr, fq * 8);
#define PG8_SA(b, h) (((b) * 2 + (h)) * HTB)
#define PG8_SB(b, h) ((4 + (b) * 2 + (h)) * HTB)
#define PG8_STAGE(bufoff, gbase, voff) do { _Pragma("unroll") for (int _i = 0; _i < 2; ++_i) \
    __builtin_amdgcn_global_load_lds((const unsigned*)((const char*)(gbase) + (voff)[_i]), (PG8_LAS unsigned*)(lds + (bufoff) + ldsw + _i * 8192), 16, 0, 0); } while (0)
#define PG8_LDA(dst, b, h) do { _Pragma("unroll") for (int m = 0; m < 4; ++m) _Pragma("unroll") for (int k = 0; k < 2; ++k) dst[m][k] = *(const PG8_LAS bf16x8*)(lds + PG8_SA(b, h) + aoff + m * 2048 + k * 1024); } while (0)
#define PG8_LDB(dst, b, h) do { _Pragma("unroll") for (int n = 0; n < 2; ++n) _Pragma("unroll") for (int k = 0; k < 2; ++k) dst[n][k] = *(const PG8_LAS bf16x8*)(lds + PG8_SB(b, h) + boff + n * 2048 + k * 1024); } while (0)
#define PG8_MMA(ai, bj, At, Bt) do { __builtin_amdgcn_s_setprio(1); _Pragma("unroll") for (int m = 0; m < 4; ++m) _Pragma("unroll") for (int n = 0; n < 2; ++n) _Pragma("unroll") for (int k = 0; k < 2; ++k) \
    acc[ai][bj][m][n] = mma16(Bt[n][k], At[m][k], acc[ai][bj][m][n]); __builtin_amdgcn_s_setprio(0); } while (0)
#define PG8_WAIT_V(n) asm volatile("s_waitcnt vmcnt(" #n ")" ::: "memory")
#define PG8_WAIT_L(n) asm volatile("s_waitcnt lgkmcnt(" #n ")" ::: "memory")
#define PG8_BAR __builtin_amdgcn_s_barrier()
#define PG8_SCHED __builtin_amdgcn_sched_barrier(0)
  Unit cur, nxt; int ui = 0;
  if (!S.next(0, cur)) return;
  typedef typename Epi::acc_t acc_t;
  acc_t acc[2][2][4][2];
#pragma unroll
  for (int a = 0; a < 2; ++a)
#pragma unroll
    for (int b = 0; b < 2; ++b)
#pragma unroll
      for (int m = 0; m < 4; ++m)
#pragma unroll
        for (int n = 0; n < 2; ++n) acc[a][b][m][n] = (acc_t){0, 0, 0, 0};
  bf16x8 At[4][2], B0[2][2], B1[2][2];
  const char* cA = (const char*)g.A + (size_t)cur.pm * tstepA; const char* cB = (const char*)g.Bt + (size_t)cur.pn * tstepB;
  PG8_STAGE(PG8_SB(0, 0), cB, voffB); PG8_STAGE(PG8_SA(0, 0), cA, voffA); PG8_STAGE(PG8_SB(0, 1), cB + hstepB, voffB); PG8_STAGE(PG8_SA(0, 1), cA + hstepA, voffA);
  if (wr == 1) PG8_BAR;
  PG8_WAIT_V(4); PG8_BAR;
  PG8_STAGE(PG8_SB(1, 0), cB + kstep, voffB); PG8_STAGE(PG8_SA(1, 0), cA + kstep, voffA); PG8_STAGE(PG8_SB(1, 1), cB + hstepB + kstep, voffB);
  PG8_WAIT_V(6); PG8_BAR;
  for (;;) {
    const bool has_next = S.next(ui + 1, nxt);
    const char* nA = has_next ? (const char*)g.A + (size_t)nxt.pm * tstepA : cA; const char* nB = has_next ? (const char*)g.Bt + (size_t)nxt.pn * tstepB : cB;
    for (int t = 0; t < nt; t += 2) {
      const bool last = (t == nt - 2);
      const char* a1 = cA + (size_t)(t + 1) * kstep;
      const char* a2 = last ? nA : cA + (size_t)(t + 2) * kstep; const char* b2 = last ? nB : cB + (size_t)(t + 2) * kstep;
      const char* a3 = a2 + kstep; const char* b3 = b2 + kstep;
      PG8_LDB(B0, 0, 0); PG8_SCHED; PG8_LDA(At, 0, 0); PG8_STAGE(PG8_SA(1, 1), a1 + hstepA, voffA);
      PG8_WAIT_L(8); PG8_BAR; PG8_WAIT_L(0); PG8_MMA(0, 0, At, B0); PG8_BAR; PG8_SCHED;
      PG8_LDB(B1, 0, 1); PG8_STAGE(PG8_SB(0, 0), b2, voffB);
      PG8_BAR; PG8_WAIT_L(0); PG8_MMA(0, 1, At, B1); PG8_BAR;
      PG8_LDA(At, 0, 1); PG8_STAGE(PG8_SA(0, 0), a2, voffA);
      PG8_BAR; PG8_WAIT_L(0); PG8_MMA(1, 0, At, B0); PG8_BAR; PG8_SCHED;
      PG8_STAGE(PG8_SB(0, 1), b2 + hstepB, voffB);
      PG8_WAIT_V(6); PG8_BAR; PG8_MMA(1, 1, At, B1); PG8_BAR;
      PG8_LDB(B0, 1, 0); PG8_SCHED; PG8_LDA(At, 1, 0); PG8_STAGE(PG8_SA(0, 1), a2 + hstepA, voffA);
      PG8_WAIT_L(8); PG8_BAR; PG8_WAIT_L(0); PG8_MMA(0, 0, At, B0); PG8_BAR; PG8_SCHED;
      PG8_LDB(B1, 1, 1); PG8_STAGE(PG8_SB(1, 0), b3, voffB);
      PG8_BAR; PG8_WAIT_L(0); PG8_MMA(0, 1, At, B1); PG8_BAR;
      PG8_LDA(At, 1, 1); PG8_STAGE(PG8_SA(1, 0), a3, voffA);
      PG8_BAR; PG8_WAIT_L(0); PG8_MMA(1, 0, At, B0); PG8_BAR; PG8_SCHED;
      PG8_STAGE(PG8_SB(1, 1), b3 + hstepB, voffB);
      PG8_WAIT_V(6); PG8_BAR; PG8_MMA(1, 1, At, B1); PG8_BAR;
    }
    E(acc, cur, wr, wc, fr, fq);
    if (!has_next) break;
#pragma unroll
    for (int a = 0; a < 2; ++a)
#pragma unroll
      for (int b = 0; b < 2; ++b)
#pragma unroll
        for (int m = 0; m < 4; ++m)
#pragma unroll
          for (int n = 0; n < 2; ++n) acc[a][b][m][n] = (acc_t){0, 0, 0, 0};
    cur = nxt; cA = nA; cB = nB; ++ui;
  }
  PG8_WAIT_V(0);
  if (wr == 0) PG8_BAR;
  PG8_BAR;
#undef PG8_SA
#undef PG8_SB
#undef PG8_STAGE
#undef PG8_LDA
#undef PG8_LDB
#undef PG8_MMA
#undef PG8_WAIT_V
#undef PG8_WAIT_L
#undef PG8_BAR
#undef PG8_SCHED
}
typedef const f32x4 (&AccRef)[2][2][4][2];
typedef const i32x4 (&AccRefI)[2][2][4][2];
struct EpiInprojN {
  static constexpr bool PERM = true;
  typedef f32x4 acc_t;
  u16* qk; u16* rg;
  __device__ __forceinline__ void operator()(AccRef acc, const Unit& u, int wr, int wc, int fr, int fq) const {
    const int row0 = u.pm * BM + wr * 64 + fr;
    u16* base; int ld, colt;
    if (u.pn < 4) { base = qk; ld = 1024; colt = u.pn * 256; } else { base = rg; ld = 512; colt = (u.pn - 9) * 256; }
    const int col0 = colt + wc * 32 + 8 * fq;
#pragma unroll
    for (int ai = 0; ai < 2; ++ai)
#pragma unroll
      for (int m = 0; m < 4; ++m) {
        u16* rowp = base + (size_t)(row0 + ai * HALF + m * 16) * ld + col0;
#pragma unroll
        for (int bj = 0; bj < 2; ++bj) {
          const f32x4 v0 = acc[ai][bj][m][0], v1 = acc[ai][bj][m][1];
          u32x4 w; w.x = pkh(v0[0], v0[1]); w.y = pkh(v0[2], v0[3]); w.z = pkh(v1[0], v1[1]); w.w = pkh(v1[2], v1[3]);
          *(u32x4*)(rowp + bj * HALF) = w;
        }
      }
  }
};
struct EpiInprojT {
  static constexpr bool PERM = true;
  typedef f32x4 acc_t;
  u16 *vT, *vTc, *hyT, *hyTc;
  __device__ __forceinline__ void operator()(AccRef acc, const Unit& u, int wr, int wc, int fr, int fq) const {
    const bool isctx = (u.pn >= 128);
    const int b = isctx ? (u.pn - 128) : (u.pn >> 4);
    const int Lseg = isctx ? 256 : 4096, t0 = isctx ? 0 : (u.pn & 15) * 256;
    const bool isv = (u.pm < 2);
    const size_t boff = isv ? (isctx ? (size_t)16777216 : (size_t)0) : (isctx ? (size_t)(16777216 + 1048576 + 25165824) : (size_t)(16777216 + 1048576));
    u16* base = vT + boff;
    const int nc = isv ? 512 : 768;
    const int wrow0 = (isv ? u.pm : u.pm - 2) * BM + wr * 64 + fr;
    const int col0 = t0 + wc * 32 + 8 * fq;
#pragma unroll
    for (int ai = 0; ai < 2; ++ai)
#pragma unroll
      for (int m = 0; m < 4; ++m) {
        u16* rowp = base + ((size_t)(b * nc + wrow0 + ai * HALF + m * 16)) * Lseg + col0;
#pragma unroll
        for (int bj = 0; bj < 2; ++bj) {
          const f32x4 v0 = acc[ai][bj][m][0], v1 = acc[ai][bj][m][1];
          u32x4 w; w.x = pkh(v0[0], v0[1]); w.y = pkh(v0[2], v0[3]); w.z = pkh(v1[0], v1[1]); w.w = pkh(v1[2], v1[3]);
          *(u32x4*)(rowp + bj * HALF) = w;
        }
      }
  }
};
struct EpiGate {
  static constexpr bool PERM = true;
  typedef f32x4 acc_t;
  unsigned char* g8; const float* bias;
  __device__ __forceinline__ void operator()(AccRef acc, const Unit& u, int wr, int wc, int fr, int fq) const {
    const int row0 = u.pm * BM + wr * 64 + fr;
    const int col0 = u.pn * BM + wc * 32 + 8 * fq;
#pragma unroll
    for (int bj = 0; bj < 2; ++bj) {
      const f32x4 b0 = *(const f32x4*)(bias + col0 + bj * HALF), b1 = *(const f32x4*)(bias + col0 + bj * HALF + 4);
#pragma unroll
      for (int ai = 0; ai < 2; ++ai)
#pragma unroll
        for (int m = 0; m < 4; ++m) {
          const f32x4 v0 = acc[ai][bj][m][0] + b0, v1 = acc[ai][bj][m][1] + b1;
          unsigned w0 = 0, w1 = 0;
#pragma unroll
          for (int k = 0; k < 4; ++k) {
            w0 |= (unsigned)(sigmoidf_(v0[k]) * 255.0f + 0.5f) << (8 * k);
            w1 |= (unsigned)(sigmoidf_(v1[k]) * 255.0f + 0.5f) << (8 * k);
          }
          *(uint2*)(g8 + (size_t)(row0 + ai * HALF + m * 16) * 3072 + col0 + bj * HALF) = make_uint2(w0, w1);
        }
    }
  }
};
struct EpiBranch {
  static constexpr bool PERM = true;
  typedef f32x4 acc_t;
  u16* mbuf; const unsigned char* g8; int br;
  __device__ __forceinline__ void operator()(AccRef acc, const Unit& u, int wr, int wc, int fr, int fq) const {
    const int row0 = u.pm * BM + wr * 64 + fr;
    const int col0 = u.pn * BM + wc * 32 + 8 * fq;
#pragma unroll
    for (int ai = 0; ai < 2; ++ai)
#pragma unroll
      for (int m = 0; m < 4; ++m) {
        const size_t row = (size_t)(row0 + ai * HALF + m * 16);
#pragma unroll
        for (int bj = 0; bj < 2; ++bj) {
          const uint2 gq = *(const uint2*)(g8 + row * 3072 + br * 1024 + col0 + bj * HALF);
          u16* mp = mbuf + row * 1024 + col0 + bj * HALF;
          const f32x4 v0 = acc[ai][bj][m][0], v1 = acc[ai][bj][m][1];
          float r[8];
          r[0] = (float)(gq.x & 255u) * v0[0]; r[1] = (float)((gq.x >> 8) & 255u) * v0[1];
          r[2] = (float)((gq.x >> 16) & 255u) * v0[2]; r[3] = (float)(gq.x >> 24) * v0[3];
          r[4] = (float)(gq.y & 255u) * v1[0]; r[5] = (float)((gq.y >> 8) & 255u) * v1[1];
          r[6] = (float)((gq.y >> 16) & 255u) * v1[2]; r[7] = (float)(gq.y >> 24) * v1[3];
          u32x4 w;
          if (br == 0) {
            w.x = pkh(r[0] * (1.f / 255.f), r[1] * (1.f / 255.f)); w.y = pkh(r[2] * (1.f / 255.f), r[3] * (1.f / 255.f));
            w.z = pkh(r[4] * (1.f / 255.f), r[5] * (1.f / 255.f)); w.w = pkh(r[6] * (1.f / 255.f), r[7] * (1.f / 255.f));
          } else {
            const u32x4 o = *(const u32x4*)mp;
            w.x = pkh(bflo(o.x) + r[0] * (1.f / 255.f), bfhi(o.x) + r[1] * (1.f / 255.f));
            w.y = pkh(bflo(o.y) + r[2] * (1.f / 255.f), bfhi(o.y) + r[3] * (1.f / 255.f));
            w.z = pkh(bflo(o.z) + r[4] * (1.f / 255.f), bfhi(o.z) + r[5] * (1.f / 255.f));
            w.w = pkh(bflo(o.w) + r[6] * (1.f / 255.f), bfhi(o.w) + r[7] * (1.f / 255.f));
          }
          *(u32x4*)mp = w;
        }
      }
  }
};
struct EpiOut {
  static constexpr bool PERM = false;
  typedef f32x4 acc_t;
  const float *xsrc, *csrc; float *xdst, *cdst; const float* modl;
  __device__ __forceinline__ void operator()(AccRef acc, const Unit& u, int wr, int wc, int fr, int fq) const {
    const bool isctx = (u.pm >= 128);
    const int bi = isctx ? 8 : (u.pm >> 4);
    const float* gatev = modl + ((size_t)bi * 6 + 2) * 1024;
    const float* src = isctx ? (csrc - (size_t)NLAT * 1024) : xsrc;
    float* dst = isctx ? (cdst - (size_t)NLAT * 1024) : xdst;
    const int row0 = u.pm * BM + wr * 64 + fr, col0 = u.pn * BM + wc * 32 + 4 * fq;
#pragma unroll
    for (int bj = 0; bj < 2; ++bj)
#pragma unroll
      for (int n = 0; n < 2; ++n) {
        const int col = col0 + bj * HALF + n * 16;
        const f32x4 gv = *(const f32x4*)(gatev + col);
#pragma unroll
        for (int ai = 0; ai < 2; ++ai)
#pragma unroll
          for (int m = 0; m < 4; ++m) {
            const size_t o = (size_t)(row0 + ai * HALF + m * 16) * 1024 + col;
            const f32x4 xv = *(const f32x4*)(src + o);
            *(f32x4*)(dst + o) = xv + gv * acc[ai][bj][m][n];
          }
      }
  }
};
struct EpiQ {
  static constexpr bool PERM = true;
  typedef f32x4 acc_t;
  u16* q;
  __device__ __forceinline__ void operator()(AccRef acc, const Unit& u, int wr, int wc, int fr, int fq) const {
    const int row0 = u.pm * BM + wr * 64 + fr;
    const int col0 = u.pn * BM + wc * 32 + 8 * fq;
#pragma unroll
    for (int ai = 0; ai < 2; ++ai)
#pragma unroll
      for (int m = 0; m < 4; ++m) {
        u16* rowp = q + (size_t)(row0 + ai * HALF + m * 16) * 2048 + col0;
#pragma unroll
        for (int bj = 0; bj < 2; ++bj) {
          const f32x4 v0 = acc[ai][bj][m][0], v1 = acc[ai][bj][m][1];
          u32x4 w;
          w.x = __builtin_bit_cast(unsigned, __builtin_amdgcn_cvt_pkrtz(v0[0], v0[1]));
          w.y = __builtin_bit_cast(unsigned, __builtin_amdgcn_cvt_pkrtz(v0[2], v0[3]));
          w.z = __builtin_bit_cast(unsigned, __builtin_amdgcn_cvt_pkrtz(v1[0], v1[1]));
          w.w = __builtin_bit_cast(unsigned, __builtin_amdgcn_cvt_pkrtz(v1[2], v1[3]));
          *(u32x4*)(rowp + bj * HALF) = w;
        }
      }
  }
};
struct EpiInprojN8 {
  static constexpr bool PERM = true;
  typedef i32x4 acc_t;
  u16* qk; u16* rg; const float* sa; const float* sw;
  __device__ __forceinline__ void operator()(AccRefI acc, const Unit& u, int wr, int wc, int fr, int fq) const {
    const int row0 = u.pm * BM + wr * 64 + fr;
    u16* base; int ld, colt;
    if (u.pn < 4) { base = qk; ld = 1024; colt = u.pn * 256; } else { base = rg; ld = 512; colt = (u.pn - 9) * 256; }
    const int col0 = colt + wc * 32 + 8 * fq;
    const int wcol0 = u.pn * 256 + wc * 32 + 8 * fq;
#pragma unroll
    for (int bj = 0; bj < 2; ++bj) {
      const f32x4 c0 = *(const f32x4*)(sw + wcol0 + bj * HALF), c1 = *(const f32x4*)(sw + wcol0 + bj * HALF + 4);
#pragma unroll
      for (int ai = 0; ai < 2; ++ai)
#pragma unroll
        for (int m = 0; m < 4; ++m) {
          const int row = row0 + ai * HALF + m * 16;
          const float rs = sa[row];
          const i32x4 a0 = acc[ai][bj][m][0], a1 = acc[ai][bj][m][1];
          u32x4 w;
          w.x = pkh((float)a0[0] * rs * c0[0], (float)a0[1] * rs * c0[1]); w.y = pkh((float)a0[2] * rs * c0[2], (float)a0[3] * rs * c0[3]);
          w.z = pkh((float)a1[0] * rs * c1[0], (float)a1[1] * rs * c1[1]); w.w = pkh((float)a1[2] * rs * c1[2], (float)a1[3] * rs * c1[3]);
          *(u32x4*)(base + (size_t)row * ld + col0 + bj * HALF) = w;
        }
    }
  }
};
struct EpiInprojT8 {
  static constexpr bool PERM = true;
  typedef i32x4 acc_t;
  u16* vT; const float* sa; const float* sw;
  __device__ __forceinline__ void operator()(AccRefI acc, const Unit& u, int wr, int wc, int fr, int fq) const {
    const bool isctx = (u.pn >= 128);
    const int b = isctx ? (u.pn - 128) : (u.pn >> 4);
    const int Lseg = isctx ? 256 : 4096, t0 = isctx ? 0 : (u.pn & 15) * 256;
    const bool isv = (u.pm < 2);
    const size_t boff = isv ? (isctx ? (size_t)16777216 : (size_t)0) : (isctx ? (size_t)(16777216 + 1048576 + 25165824) : (size_t)(16777216 + 1048576));
    u16* base = vT + boff;
    const int nc = isv ? 512 : 768;
    const int wrow0 = (isv ? u.pm : u.pm - 2) * BM + wr * 64 + fr;
    const int srow0 = u.pm * BM + wr * 64 + fr;
    const int col0 = t0 + wc * 32 + 8 * fq;
    const int tok0 = u.pn * BM + wc * 32 + 8 * fq;
#pragma unroll
    for (int bj = 0; bj < 2; ++bj) {
      const f32x4 c0 = *(const f32x4*)(sa + tok0 + bj * HALF), c1 = *(const f32x4*)(sa + tok0 + bj * HALF + 4);
#pragma unroll
      for (int ai = 0; ai < 2; ++ai)
#pragma unroll
        for (int m = 0; m < 4; ++m) {
          const float rs = sw[srow0 + ai * HALF + m * 16];
          const i32x4 a0 = acc[ai][bj][m][0], a1 = acc[ai][bj][m][1];
          u32x4 w;
          w.x = pkh((float)a0[0] * rs * c0[0], (float)a0[1] * rs * c0[1]); w.y = pkh((float)a0[2] * rs * c0[2], (float)a0[3] * rs * c0[3]);
          w.z = pkh((float)a1[0] * rs * c1[0], (float)a1[1] * rs * c1[1]); w.w = pkh((float)a1[2] * rs * c1[2], (float)a1[3] * rs * c1[3]);
          *(u32x4*)(base + ((size_t)(b * nc + wrow0 + ai * HALF + m * 16)) * Lseg + col0 + bj * HALF) = w;
        }
    }
  }
};
struct EpiGate8 {
  static constexpr bool PERM = true;
  typedef i32x4 acc_t;
  unsigned char* g8; const float* bias; const float* sa; const float* sw;
  __device__ __forceinline__ void operator()(AccRefI acc, const Unit& u, int wr, int wc, int fr, int fq) const {
    const int row0 = u.pm * BM + wr * 64 + fr;
    const int col0 = u.pn * BM + wc * 32 + 8 * fq;
#pragma unroll
    for (int bj = 0; bj < 2; ++bj) {
      const f32x4 b0 = *(const f32x4*)(bias + col0 + bj * HALF), b1 = *(const f32x4*)(bias + col0 + bj * HALF + 4);
      const f32x4 c0 = *(const f32x4*)(sw + col0 + bj * HALF), c1 = *(const f32x4*)(sw + col0 + bj * HALF + 4);
#pragma unroll
      for (int ai = 0; ai < 2; ++ai)
#pragma unroll
        for (int m = 0; m < 4; ++m) {
          const int row = row0 + ai * HALF + m * 16;
          const float rs = sa[row];
          const i32x4 a0 = acc[ai][bj][m][0], a1 = acc[ai][bj][m][1];
          unsigned w0 = 0, w1 = 0;
#pragma unroll
          for (int k = 0; k < 4; ++k) {
            w0 |= (unsigned)(sigmoidf_((float)a0[k] * rs * c0[k] + b0[k]) * 255.0f + 0.5f) << (8 * k);
            w1 |= (unsigned)(sigmoidf_((float)a1[k] * rs * c1[k] + b1[k]) * 255.0f + 0.5f) << (8 * k);
          }
          *(uint2*)(g8 + (size_t)row * 3072 + col0 + bj * HALF) = make_uint2(w0, w1);
        }
    }
  }
};
}

__device__ __forceinline__ void tr_tile(const float* __restrict__ src, int N, int K, u16* __restrict__ dst, int tile, char* smem) {
  float* lds = (float*)smem;
  const int tiles_n = N >> 6;
  const int tk = tile / tiles_n, tn = tile - tk * tiles_n;
  const int tid = opaque_tid();
  {
    const int r = tid >> 3, c8 = (tid & 7) * 8;
    const float* s = src + (size_t)(tk * 64 + r) * N + tn * 64 + c8;
    float4 a = *(const float4*)s, b = *(const float4*)(s + 4);
    float* d = lds + r * 65 + c8;
    d[0] = a.x; d[1] = a.y; d[2] = a.z; d[3] = a.w; d[4] = b.x; d[5] = b.y; d[6] = b.z; d[7] = b.w;
  }
  __syncthreads();
  {
    const int n = tid >> 3, k0 = (tid & 7) * 8;
    uint4 o;
    o.x = pk2(lds[(k0 + 0) * 65 + n], lds[(k0 + 1) * 65 + n]);
    o.y = pk2(lds[(k0 + 2) * 65 + n], lds[(k0 + 3) * 65 + n]);
    o.z = pk2(lds[(k0 + 4) * 65 + n], lds[(k0 + 5) * 65 + n]);
    o.w = pk2(lds[(k0 + 6) * 65 + n], lds[(k0 + 7) * 65 + n]);
    *(uint4*)(dst + (size_t)(tn * 64 + n) * K + tk * 64 + k0) = o;
  }
  __syncthreads();
}
__device__ __forceinline__ void colmax_task(const float* __restrict__ w, int N, int n0, float* __restrict__ swp, char* smem) {
  const int tid = opaque_tid();
  const int col = tid & 63, kg = tid >> 6;
  float m = 0.f;
  const float* wp = w + (size_t)(kg * 128) * N + n0 + col;
#pragma unroll 16
  for (int k = 0; k < 128; ++k) m = fmaxf(m, fabsf(wp[(size_t)k * N]));
  float* red = (float*)smem;
  red[kg * 64 + col] = m;
  __syncthreads();
  if (tid < 64) {
    float mm = red[tid];
#pragma unroll
    for (int g = 1; g < 8; ++g) mm = fmaxf(mm, red[g * 64 + tid]);
    swp[n0 + tid] = fmaxf(mm, 1e-20f) * (1.0f / 127.0f);
  }
  __syncthreads();
}
__device__ __forceinline__ void tr_tile_i8(const float* __restrict__ src, int N, int K, unsigned char* __restrict__ dst, int tile, const float* __restrict__ swp, char* smem) {
  float* lds = (float*)smem;
  const int tiles_n = N >> 6;
  const int tk = tile / tiles_n, tn = tile - tk * tiles_n;
  const int tid = opaque_tid();
  {
    const int r = tid >> 3, c8 = (tid & 7) * 8;
    const float* sp = src + (size_t)(tk * 64 + r) * N + tn * 64 + c8;
    float4 a = *(const float4*)sp, b = *(const float4*)(sp + 4);
    float* d = lds + r * 65 + c8;
    d[0] = a.x; d[1] = a.y; d[2] = a.z; d[3] = a.w; d[4] = b.x; d[5] = b.y; d[6] = b.z; d[7] = b.w;
  }
  __syncthreads();
  {
    const int n = tid >> 3, k0 = (tid & 7) * 8;
    const float inv = 1.0f / swp[tn * 64 + n];
    unsigned w0 = 0, w1 = 0;
#pragma unroll
    for (int i = 0; i < 4; ++i) {
      w0 |= ((unsigned)__float2int_rn(lds[(k0 + i) * 65 + n] * inv) & 255u) << (8 * i);
      w1 |= ((unsigned)__float2int_rn(lds[(k0 + 4 + i) * 65 + n] * inv) & 255u) << (8 * i);
    }
    *(uint2*)(dst + (size_t)(tn * 64 + n) * K + tk * 64 + k0) = make_uint2(w0, w1);
  }
  __syncthreads();
}
__device__ __forceinline__ void cvt_chunk(const float* __restrict__ src, u16* __restrict__ dst, size_t chunk) {
  const size_t i = chunk * 4096 + (size_t)opaque_tid() * 8;
  float4 a = *(const float4*)(src + i), b = *(const float4*)(src + i + 4);
  uint4 o;
  o.x = pk2(a.x, a.y); o.y = pk2(a.z, a.w); o.z = pk2(b.x, b.y); o.w = pk2(b.z, b.w);
  *(uint4*)(dst + i) = o;
}
template <bool I8>
__device__ __forceinline__ void tr_tile4(const float* __restrict__ src, int N, int K, void* __restrict__ dstv, int tile4, const float* __restrict__ swp, char* smem) {
  float* lds = (float*)smem;
  const int tiles_n = N >> 6;
  const int tkq = tile4 / tiles_n, tn = tile4 - tkq * tiles_n;
  const int tid = opaque_tid();
  {
    const int r = tid >> 3, c8 = (tid & 7) * 8;
    const float* sp = src + (size_t)(tkq * 256 + r) * N + tn * 64 + c8;
    float4 a[4], b[4];
#pragma unroll
    for (int q = 0; q < 4; ++q) { a[q] = *(const float4*)(sp + (size_t)q * 64 * N); b[q] = *(const float4*)(sp + (size_t)q * 64 * N + 4); }
#pragma unroll
    for (int q = 0; q < 4; ++q) {
      float* d = lds + q * 4160 + r * 65 + c8;
      d[0] = a[q].x; d[1] = a[q].y; d[2] = a[q].z; d[3] = a[q].w; d[4] = b[q].x; d[5] = b[q].y; d[6] = b[q].z; d[7] = b[q].w;
    }
  }
  __syncthreads();
  {
    const int n = tid >> 3, k0 = (tid & 7) * 8;
    if (I8) {
      const float inv = 1.0f / swp[tn * 64 + n];
      unsigned char* dst = (unsigned char*)dstv;
#pragma unroll
      for (int q = 0; q < 4; ++q) {
        const float* lq = lds + q * 4160;
        unsigned w0 = 0, w1 = 0;
#pragma unroll
        for (int i = 0; i < 4; ++i) {
          w0 |= ((unsigned)__float2int_rn(lq[(k0 + i) * 65 + n] * inv) & 255u) << (8 * i);
          w1 |= ((unsigned)__float2int_rn(lq[(k0 + 4 + i) * 65 + n] * inv) & 255u) << (8 * i);
        }
        *(uint2*)(dst + (size_t)(tn * 64 + n) * K + tkq * 256 + q * 64 + k0) = make_uint2(w0, w1);
      }
    } else {
      u16* dst = (u16*)dstv;
#pragma unroll
      for (int q = 0; q < 4; ++q) {
        const float* lq = lds + q * 4160;
        uint4 o;
        o.x = pk2(lq[(k0 + 0) * 65 + n], lq[(k0 + 1) * 65 + n]);
        o.y = pk2(lq[(k0 + 2) * 65 + n], lq[(k0 + 3) * 65 + n]);
        o.z = pk2(lq[(k0 + 4) * 65 + n], lq[(k0 + 5) * 65 + n]);
        o.w = pk2(lq[(k0 + 6) * 65 + n], lq[(k0 + 7) * 65 + n]);
        *(uint4*)(dst + (size_t)(tn * 64 + n) * K + tkq * 256 + q * 64 + k0) = o;
      }
    }
  }
  __syncthreads();
}
__device__ __forceinline__ void colmax4_task(const float* __restrict__ w, int N, int n0, float* __restrict__ swp, char* smem) {
  const int tid = opaque_tid();
  const int c4 = (tid & 15) * 4, rg = tid >> 4;
  const float* wp = w + (size_t)(rg * 32) * N + n0 + c4;
  float4 m = {0.f, 0.f, 0.f, 0.f};
#pragma unroll 16
  for (int k = 0; k < 32; ++k) {
    const float4 v = *(const float4*)(wp + (size_t)k * N);
    m.x = fmaxf(m.x, fabsf(v.x)); m.y = fmaxf(m.y, fabsf(v.y)); m.z = fmaxf(m.z, fabsf(v.z)); m.w = fmaxf(m.w, fabsf(v.w));
  }
  float* red = (float*)smem;
  *(float4*)(red + rg * 64 + c4) = m;
  __syncthreads();
  if (tid < 64) {
    float mm = red[tid];
#pragma unroll
    for (int g = 1; g < 32; ++g) mm = fmaxf(mm, red[g * 64 + tid]);
    swp[n0 + tid] = fmaxf(mm, 1e-20f) * (1.0f / 127.0f);
  }
  __syncthreads();
}
__device__ __forceinline__ void cvt_chunk4(const float* __restrict__ src, u16* __restrict__ dst, size_t chunk4) {
  const size_t i = chunk4 * 16384 + (size_t)opaque_tid() * 8;
  float4 a[4], b[4];
#pragma unroll
  for (int q = 0; q < 4; ++q) { a[q] = *(const float4*)(src + i + q * 4096); b[q] = *(const float4*)(src + i + q * 4096 + 4); }
#pragma unroll
  for (int q = 0; q < 4; ++q) {
    uint4 o;
    o.x = pk2(a[q].x, a[q].y); o.y = pk2(a[q].z, a[q].w); o.z = pk2(b[q].x, b[q].y); o.w = pk2(b[q].z, b[q].w);
    *(uint4*)(dst + i + q * 4096) = o;
  }
}
__device__ __forceinline__ void cvt_chunk_fp8(const float* __restrict__ src, unsigned char* __restrict__ dst, size_t chunk, float scale) {
  const size_t i = chunk * 4096 + (size_t)opaque_tid() * 8;
  const float4 a = *(const float4*)(src + i), b = *(const float4*)(src + i + 4);
  int w0 = __builtin_amdgcn_cvt_pk_fp8_f32(a.x * scale, a.y * scale, 0, false);
  w0 = __builtin_amdgcn_cvt_pk_fp8_f32(a.z * scale, a.w * scale, w0, true);
  int w1 = __builtin_amdgcn_cvt_pk_fp8_f32(b.x * scale, b.y * scale, 0, false);
  w1 = __builtin_amdgcn_cvt_pk_fp8_f32(b.z * scale, b.w * scale, w1, true);
  *(uint2*)(dst + i) = make_uint2((unsigned)w0, (unsigned)w1);
}
__device__ __forceinline__ void cvt_chunk_fp4(const float* __restrict__ src, unsigned char* __restrict__ dst, size_t chunk, float scale, int vhalf) {
  const size_t i = chunk * 4096 + (size_t)opaque_tid() * 8;
  const float4 a = *(const float4*)(src + i), b = *(const float4*)(src + i + 4);
  unsigned w = 0;
  w = __builtin_amdgcn_cvt_scalef32_pk_fp4_f32(w, a.x * scale, a.y * scale, 1.0f, 0);
  w = __builtin_amdgcn_cvt_scalef32_pk_fp4_f32(w, a.z * scale, a.w * scale, 1.0f, 1);
  w = __builtin_amdgcn_cvt_scalef32_pk_fp4_f32(w, b.x * scale, b.y * scale, 1.0f, 2);
  w = __builtin_amdgcn_cvt_scalef32_pk_fp4_f32(w, b.z * scale, b.w * scale, 1.0f, 3);
  const size_t e = i >> 10;
  const unsigned d = (unsigned)(i & 1023);
  *(unsigned*)(dst + e * 1024 + vhalf * 512 + (d >> 1)) = w;
}
__device__ __forceinline__ void phase_modreduce(const P& p) {
  const int n = 2 * 9 * 6144;
  for (int i = blockIdx.x * NTHR + opaque_tid(); i < n; i += gridDim.x * NTHR) {
    const int l = i / (9 * 6144);
    const int j = i % 6144;
    float s = p.b_ada[l * 6144 + j];
#pragma unroll
    for (int kc = 0; kc < 16; ++kc) s += p.modpart[(size_t)kc * n + i];
    p.mod[i] = s;
  }
}

__device__ __forceinline__ void phase_norm(const P& p, int l, int which) {
  const int tid_ = opaque_tid(); const int lane = tid_ & 63, wid = tid_ >> 6;
  const int ntok = (which == 2 || (which == 1 && l == 1)) ? NLAT : NTOK;
  for (int row = blockIdx.x * 8 + wid; row < ntok; row += gridDim.x * 8) {
    const float* src;
    if (row < NLAT) src = ((which == 0 && l == 0) ? p.x : p.out) + (size_t)row * 1024;
    else src = ((which == 0 && l == 0) ? p.ctx : p.ctxs) + (size_t)(row - NLAT) * 1024;
    float4 v[4];
    float ss = 0.f;
#pragma unroll
    for (int i = 0; i < 4; ++i) {
      v[i] = *(const float4*)(src + i * 256 + lane * 4);
      ss += v[i].x * v[i].x + v[i].y * v[i].y + v[i].z * v[i].z + v[i].w * v[i].w;
    }
    ss = wave_sum(ss);
    const float rstd = rsqrtf(ss * (1.0f / 1024.0f) + 1e-6f);
    if (which == 2) {
#pragma unroll
      for (int i = 0; i < 4; ++i) {
        const int col = i * 256 + lane * 4;
        const float4 g = *(const float4*)(p.final_g + col);
        float4 o = {v[i].x * rstd * g.x, v[i].y * rstd * g.y, v[i].z * rstd * g.z, v[i].w * rstd * g.w};
        *(float4*)(p.out + (size_t)row * 1024 + col) = o;
      }
    } else {
      const int bi = row < NLAT ? (row >> 12) : 8;
      const float* gam = (which == 0 ? p.norm_mix_g : p.norm_ffn_g) + l * 1024;
      const float* msh = p.mod + ((size_t)(l * 9 + bi) * 6 + (which == 0 ? 0 : 3)) * 1024;
      const float* msc = msh + 1024;
      float4 y[4];
      float amax = 0.f;
#pragma unroll
      for (int i = 0; i < 4; ++i) {
        const int col = i * 256 + lane * 4;
        const float4 g = *(const float4*)(gam + col);
        const float4 sh = *(const float4*)(msh + col);
        const float4 sc = *(const float4*)(msc + col);
        y[i].x = v[i].x * rstd * g.x * (1.f + sc.x) + sh.x; y[i].y = v[i].y * rstd * g.y * (1.f + sc.y) + sh.y;
        y[i].z = v[i].z * rstd * g.z * (1.f + sc.z) + sh.z; y[i].w = v[i].w * rstd * g.w * (1.f + sc.w) + sh.w;
        amax = fmaxf(amax, fmaxf(fmaxf(fabsf(y[i].x), fabsf(y[i].y)), fmaxf(fabsf(y[i].z), fabsf(y[i].w))));
      }
      if (which == 0) {
        amax = fmaxf(wave_max(amax), 1e-20f);
        const float inv = 127.0f / amax;
#pragma unroll
        for (int i = 0; i < 4; ++i) {
          const unsigned w = ((unsigned)__float2int_rn(y[i].x * inv) & 255u) | (((unsigned)__float2int_rn(y[i].y * inv) & 255u) << 8) |
                             (((unsigned)__float2int_rn(y[i].z * inv) & 255u) << 16) | (((unsigned)__float2int_rn(y[i].w * inv) & 255u) << 24);
          *(unsigned*)(p.xn8 + (size_t)row * 1024 + i * 256 + lane * 4) = w;
        }
        if (lane == 0) p.sa[row] = amax * (1.0f / 127.0f);
      } else {
#pragma unroll
        for (int i = 0; i < 4; ++i) {
          uint2 o;
          o.x = pk2(y[i].x, y[i].y);
          o.y = pk2(y[i].z, y[i].w);
          *(uint2*)(p.xn + (size_t)row * 1024 + i * 256 + lane * 4) = o;
        }
      }
    }
  }
}

__device__ __forceinline__ void filter_wave(const P& p, int l, int L, int t, float* __restrict__ outp) {
  const int lane = opaque_tid() & 63;
  const float tl = (float)t / (float)(L - 1);
  const float wang = (6.283185307179586f / (float)L) * (float)t;
  float z = 0.f;
  if (lane == 0) z = tl;
  else if (lane <= 16) { const float band = 1e-4f + (float)(lane - 1) * ((15.0f - 1e-4f) / 15.0f); z = cosf(band * wang); }
  else if (lane <= 32) { const float band = 1e-4f + (float)(lane - 17) * ((15.0f - 1e-4f) / 15.0f); z = -sinf(band * wang); }
  float a1 = p.hy_f1_b[l * 64 + lane];
  for (int i = 0; i < 33; ++i) a1 += shf(z, i) * p.hy_f1_w[(l * 33 + i) * 64 + lane];
  const float h1 = sinf(p.hy_freq[l * 128 + lane] * a1);
  float a2 = p.hy_f2_b[l * 64 + lane];
  for (int i = 0; i < 64; ++i) a2 += shf(h1, i) * p.hy_f2_w[(l * 64 + i) * 64 + lane];
  const float h2 = sinf(p.hy_freq[l * 128 + 64 + lane] * a2);
  float a3[8];
#pragma unroll
  for (int m = 0; m < 8; ++m) a3[m] = 0.f;
  for (int i = 0; i < 64; ++i) {
    const float hv = shf(h2, i);
    const float* wr = p.hy_f3_w + (size_t)(l * 64 + i) * 512 + lane;
#pragma unroll
    for (int m = 0; m < 8; ++m) a3[m] += hv * wr[m * 64];
  }
  const float LN100 = 4.605170185988092f;
  const float d0 = LN100 / 1.5f, d1 = LN100 / 0.3f;
#pragma unroll
  for (int m = 0; m < 8; ++m) {
    const int cp = lane + 64 * m;
    const int ch = cp & 255;
    const float delta = d0 + (float)ch * ((d1 - d0) / 255.0f);
    outp[(size_t)cp * L + t] = a3[m] * expf(-tl * delta);
  }
}
__device__ __forceinline__ void filter_block_task(const P& p, int l, int L, int t0, float* __restrict__ outp, char* smem) {
  const int tid = opaque_tid(), lane = tid & 63, wid = tid >> 6;
  float* W3s = (float*)smem;
  float* W2s = (float*)(smem + 131072);
  {
    const float4* s3 = (const float4*)(p.hy_f3_w + (size_t)l * 64 * 512);
    const float4* s2 = (const float4*)(p.hy_f2_w + (size_t)l * 64 * 64);
#pragma unroll
    for (int i = 0; i < 16; ++i) ((float4*)W3s)[tid + NTHR * i] = s3[tid + NTHR * i];
#pragma unroll
    for (int i = 0; i < 2; ++i) ((float4*)W2s)[tid + NTHR * i] = s2[tid + NTHR * i];
  }
  __syncthreads();
  float z[4], tl[4];
#pragma unroll
  for (int j = 0; j < 4; ++j) {
    const int t = t0 + wid * 4 + j;
    tl[j] = (float)t / (float)(L - 1);
    const float wang = (6.283185307179586f / (float)L) * (float)t;
    float zz = 0.f;
    if (lane == 0) zz = tl[j];
    else if (lane <= 16) { const float band = 1e-4f + (float)(lane - 1) * ((15.0f - 1e-4f) / 15.0f); zz = cosf(band * wang); }
    else if (lane <= 32) { const float band = 1e-4f + (float)(lane - 17) * ((15.0f - 1e-4f) / 15.0f); zz = -sinf(band * wang); }
    z[j] = zz;
  }
  float a1[4], a2[4];
  {
    const float b1 = p.hy_f1_b[l * 64 + lane];
#pragma unroll
    for (int j = 0; j < 4; ++j) a1[j] = b1;
#pragma unroll 11
    for (int i = 0; i < 33; ++i) {
      const float w = p.hy_f1_w[(l * 33 + i) * 64 + lane];
#pragma unroll
      for (int j = 0; j < 4; ++j) a1[j] += shf(z[j], i) * w;
    }
    const float f0 = p.hy_freq[l * 128 + lane];
#pragma unroll
    for (int j = 0; j < 4; ++j) a1[j] = sinf(f0 * a1[j]);
  }
  {
    const float b2 = p.hy_f2_b[l * 64 + lane];
#pragma unroll
    for (int j = 0; j < 4; ++j) a2[j] = b2;
#pragma unroll 8
    for (int i = 0; i < 64; ++i) {
      const float w = W2s[i * 64 + lane];
#pragma unroll
      for (int j = 0; j < 4; ++j) a2[j] += shf(a1[j], i) * w;
    }
    const float f1 = p.hy_freq[l * 128 + 64 + lane];
#pragma unroll
    for (int j = 0; j < 4; ++j) a2[j] = sinf(f1 * a2[j]);
  }
  float a3[4][8];
#pragma unroll
  for (int j = 0; j < 4; ++j)
#pragma unroll
    for (int m = 0; m < 8; ++m) a3[j][m] = 0.f;
#pragma unroll 4
  for (int i = 0; i < 64; ++i) {
    float w[8];
#pragma unroll
    for (int m = 0; m < 8; ++m) w[m] = W3s[i * 512 + lane + 64 * m];
#pragma unroll
    for (int j = 0; j < 4; ++j) {
      const float hv = shf(a2[j], i);
#pragma unroll
      for (int m = 0; m < 8; ++m) a3[j][m] += hv * w[m];
    }
  }
  const float LN100 = 4.605170185988092f;
  const float d0 = LN100 / 1.5f, d1 = LN100 / 0.3f;
#pragma unroll
  for (int m = 0; m < 8; ++m) {
    const int cp = lane + 64 * m;
    const float delta = d0 + (float)(cp & 255) * ((d1 - d0) / 255.0f);
    float4 o;
    o.x = a3[0][m] * expf(-tl[0] * delta); o.y = a3[1][m] * expf(-tl[1] * delta);
    o.z = a3[2][m] * expf(-tl[2] * delta); o.w = a3[3][m] * expf(-tl[3] * delta);
    *(float4*)(outp + (size_t)cp * L + t0 + wid * 4) = o;
  }
  __syncthreads();
}
__device__ __forceinline__ void phase_filters(const P& p, int l, char* smem) {
  const int ntask = 128 + (l == 0 ? 8 : 0);
  for (int t = blockIdx.x; t < ntask; t += gridDim.x) {
    if (t < 128) filter_block_task(p, l, 4096, t * 32, p.hT + (size_t)l * 512 * 4096, smem);
    else filter_block_task(p, l, 256, (t - 128) * 32, p.hc, smem);
  }
}
__device__ __forceinline__ void adaln_task(const P& p, int t, char* smem) {
  const int tid = opaque_tid();
  const int kc = t & 15; t >>= 4;
  const int jc = t % 12, l = t / 12;
  float* s = (float*)smem;
  float* red = (float*)(smem + 4096);
  for (int i = tid; i < 576; i += NTHR) {
    const int bi = i >> 6, kk = i & 63;
    const float v = (bi < 8) ? p.c[bi * 1024 + kc * 64 + kk] : p.c_ctx[kc * 64 + kk];
    s[i] = v / (1.0f + __expf(-v));
  }
  const int kq = tid >> 7, c4 = (tid & 127) * 4;
  const float* wp = p.w_ada + ((size_t)l * 1024 + kc * 64 + kq * 16) * 6144 + jc * 512 + c4;
  float4 w[16];
#pragma unroll
  for (int kk = 0; kk < 16; ++kk) w[kk] = *(const float4*)(wp + (size_t)kk * 6144);
  __syncthreads();
  float4 acc[9];
#pragma unroll
  for (int bi = 0; bi < 9; ++bi) acc[bi] = make_float4(0.f, 0.f, 0.f, 0.f);
#pragma unroll
  for (int kk = 0; kk < 16; ++kk) {
#pragma unroll
    for (int bi = 0; bi < 9; ++bi) {
      const float sv = s[bi * 64 + kq * 16 + kk];
      acc[bi].x += sv * w[kk].x; acc[bi].y += sv * w[kk].y; acc[bi].z += sv * w[kk].z; acc[bi].w += sv * w[kk].w;
    }
  }
#pragma unroll
  for (int bi = 0; bi < 9; ++bi) *(float4*)(red + (kq * 9 + bi) * 512 + c4) = acc[bi];
  __syncthreads();
#pragma unroll
  for (int bi = 0; bi < 9; ++bi) {
    const float v = red[bi * 512 + tid] + red[(9 + bi) * 512 + tid] + red[(18 + bi) * 512 + tid] + red[(27 + bi) * 512 + tid];
    p.modpart[((size_t)(kc * 2 + l) * 9 + bi) * 6144 + jc * 512 + tid] = v;
  }
  __syncthreads();
}
__device__ __forceinline__ void phase_prep(const P& p, char* smem, unsigned* counter) {
  volatile int* s_taskp = (volatile int*)(smem + SMEM_BYTES - 16);
  const int total = 264 + 184 + 384 + 544 + 32;
  int nxt = 0;
  if (threadIdx.x == 0) nxt = (int)atomicAdd(counter, 1u);
  for (;;) {
    __syncthreads();
    if (threadIdx.x == 0) *s_taskp = nxt;
    __syncthreads();
    int t = *s_taskp;
    if (t >= total) break;
    if (threadIdx.x == 0) nxt = (int)atomicAdd(counter, 1u);
    if (t < 264) {
      if (t < 128) filter_block_task(p, 0, 4096, t * 32, p.hT, smem);
      else if (t < 256) filter_block_task(p, 1, 4096, (t - 128) * 32, p.hT + (size_t)512 * 4096, smem);
      else filter_block_task(p, 0, 256, (t - 256) * 32, p.hc, smem);
      continue;
    }
    t -= 264;
    if (t < 184) {
      const int l = t / 92; t -= l * 92;
      if (t < 44) colmax4_task(p.w_in + (size_t)l * 1024 * 2816, 2816, t * 64, p.sw + l * 5888, smem);
      else colmax4_task(p.w_gate + (size_t)l * 1024 * 3072, 3072, (t - 44) * 64, p.sw + l * 5888 + 2816, smem);
      continue;
    }
    t -= 184;
    if (t < 384) { adaln_task(p, t, smem); continue; }
    t -= 384;
    if (t < 544) {
      const int l = t / 272; t -= l * 272;
      if (t < 32) tr_tile4<false>(p.w_br_a + (size_t)l * 512 * 1024, 1024, 512, p.WaT + (size_t)l * 1024 * 512, t, nullptr, smem);
      else if ((t -= 32) < 16) tr_tile4<false>(p.w_br_b + (size_t)l * 256 * 1024, 1024, 256, p.WbT + (size_t)l * 1024 * 256, t, nullptr, smem);
      else if ((t -= 16) < 16) tr_tile4<false>(p.w_br_c + (size_t)l * 256 * 1024, 1024, 256, p.WcT + (size_t)l * 1024 * 256, t, nullptr, smem);
      else if ((t -= 16) < 64) tr_tile4<false>(p.w_out + (size_t)l * 1024 * 1024, 1024, 1024, p.WoT + (size_t)l * 1024 * 1024, t, nullptr, smem);
      else if ((t -= 64) < 128) cvt_chunk4(p.peer_wq + (size_t)l * 1024 * 2048, p.WqB + (size_t)l * 1024 * 2048, (size_t)t);
      else {
        t -= 128;
        const int gate = t >> 3, dn = t & 7;
        const float* src = (gate ? p.rg_wx : p.rg_wa) + (size_t)(l * 8 + dn) * 4096;
        tr_tile(src, 64, 64, p.rgW + (size_t)((l * 2 + gate) * 8 + dn) * 4096, 0, smem);
      }
      continue;
    }
    t -= 544;
    cvt_chunk4(p.peer_keys, p.keysB, (size_t)t);
  }
}
__device__ __forceinline__ void kf_task(const P& p, int l, int c, char* smem) {
  const float* hTl = p.hT + (size_t)l * 512 * 4096;
  c2* buf = (c2*)smem;
  const int tid = opaque_tid();
  for (int i = 0; i < 16; ++i) {
    const int j = tid + NTHR * i;
    float v;
    if (j < 4096) v = hTl[(size_t)c * 4096 + j];
    else if (j == 4096) v = 0.f;
    else v = hTl[(size_t)(256 + c) * 4096 + (8192 - j)];
    buf[j] = {v, 0.f};
  }
  __syncthreads();
  fft8192(buf, -1.f);
  c2* o = (c2*)p.Kf + ((size_t)l * 256 + c) * 8192;
  for (int i = 0; i < 16; ++i) { const int j = tid + NTHR * i; o[j] = buf[j]; }
  __syncthreads();
}

__device__ __forceinline__ void inproj_tile(const P& p, int l, int mt, int nt, char* smem) {
  f32x16 acc[2][2];
  zero_acc(acc);
  const int m0 = mt * 256, n0 = nt * 128;
  gemm_kloop(acc, p.xn + (size_t)m0 * 1024, 1024, p.WinT + ((size_t)l * 2816 + n0) * 1024, 1024, 1024, smem);
  EPI_VARS
  if (nt < 8 || nt >= 18) {
    u16* dst; int ld, cbase;
    if (nt < 8) { dst = p.qk; ld = 1024; cbase = n0; }
    else { dst = p.rg; ld = 512; cbase = n0 - 2304; }
#pragma unroll
    for (int i = 0; i < 2; ++i)
#pragma unroll
      for (int j = 0; j < 2; ++j)
#pragma unroll
        for (int e = 0; e < 16; ++e)
          dst[(size_t)(m0 + EPI_ROW(i, e)) * ld + cbase + EPI_COL(j)] = f2bf(acc[i][j][e]);
  } else {
#pragma unroll
    for (int i = 0; i < 2; ++i)
#pragma unroll
      for (int j = 0; j < 2; ++j)
#pragma unroll
        for (int qd = 0; qd < 4; ++qd) {
          uint2 o;
          o.x = pk2(acc[i][j][4 * qd + 0], acc[i][j][4 * qd + 1]);
          o.y = pk2(acc[i][j][4 * qd + 2], acc[i][j][4 * qd + 3]);
          const int row0 = wm * 64 + i * 32 + 8 * qd + 4 * hh;
          *(uint2*)(smem + EPI_COL(j) * 520 + row0 * 2) = o;
        }
    __syncthreads();
    u16* dstT; int Lseg, t0, ncol0, nc;
    const bool isctx = (mt >= 128);
    const int b = isctx ? (mt - 128) : (mt >> 4);
    if (nt < 12) { ncol0 = n0 - 1024; nc = 512; dstT = isctx ? p.vTc : p.vT; }
    else { ncol0 = n0 - 1536; nc = 768; dstT = isctx ? p.hyTc : p.hyT; }
    if (isctx) { Lseg = 256; t0 = 0; } else { Lseg = 4096; t0 = (mt & 15) * 256; }
#pragma unroll 4
    for (int it = 0; it < 16; ++it) {
      const int idx = tid + NTHR * it;
      const int col = idx >> 6, u = idx & 63;
      const uint2 v = *(const uint2*)(smem + col * 520 + u * 8);
      *(uint2*)(dstT + ((size_t)(b * nc + ncol0 + col)) * Lseg + t0 + u * 4) = v;
    }
    __syncthreads();
  }
}

__device__ __forceinline__ float ldbf(const u16* p, int t, int L) { return (t >= 0 && t < L) ? bf2f(p[t]) : 0.f; }
__device__ __forceinline__ void ld10(const u16* __restrict__ seq, int t0, float (&v)[10]) {
  const uint4 r = *(const uint4*)(seq + t0);
  v[0] = (t0 > 0) ? bf2f(seq[t0 - 1]) : 0.f;
  v[9] = (t0 + 8 < 4096) ? bf2f(seq[t0 + 8]) : 0.f;
  v[1] = bflo(r.x); v[2] = bfhi(r.x); v[3] = bflo(r.y); v[4] = bfhi(r.y);
  v[5] = bflo(r.z); v[6] = bfhi(r.z); v[7] = bflo(r.w); v[8] = bfhi(r.w);
}
__device__ __forceinline__ void hyena_fft_task(const P& p, int l, int c, int bp, char* smem) {
  c2* buf = (c2*)smem;
  c2* ub = (c2*)(smem + 65536);
  const int tid = opaque_tid();
  const float* sw = p.hy_short_w + l * 3 * 768;
  const float* sb = p.hy_short_b + l * 768;
  const float wx0[3] = {sw[c], sw[768 + c], sw[1536 + c]};
  const float wx1[3] = {sw[256 + c], sw[768 + 256 + c], sw[1536 + 256 + c]};
  const float wv[3] = {sw[512 + c], sw[768 + 512 + c], sw[1536 + 512 + c]};
  const float bx0 = sb[c], bx1 = sb[256 + c], bv = sb[512 + c];
  const float dsk = p.hy_bias[l * 256 + c];
  const int t0 = tid * 8;
  {
    float u[2][8];
#pragma unroll
    for (int bb = 0; bb < 2; ++bb) {
      const int b = 2 * bp + bb;
      float x1[10], vv[10];
      ld10(p.hyT + ((size_t)(b * 768 + 256 + c)) * 4096, t0, x1);
      ld10(p.hyT + ((size_t)(b * 768 + 512 + c)) * 4096, t0, vv);
#pragma unroll
      for (int k = 0; k < 8; ++k) {
        const float x1c = bx1 + wx1[0] * x1[k] + wx1[1] * x1[k + 1] + wx1[2] * x1[k + 2];
        const float vc = bv + wv[0] * vv[k] + wv[1] * vv[k + 1] + wv[2] * vv[k + 2];
        u[bb][k] = vc * x1c;
      }
    }
#pragma unroll
    for (int k = 0; k < 8; k += 2) {
      const float4 w = make_float4(u[0][k], u[1][k], u[0][k + 1], u[1][k + 1]);
      *(float4*)(buf + t0 + k) = w;
      *(float4*)(ub + t0 + k) = w;
      *(float4*)(buf + 4096 + t0 + k) = make_float4(0.f, 0.f, 0.f, 0.f);
    }
  }
  __syncthreads();
  fft8192(buf, -1.f);
  const c2* kf = (const c2*)p.Kf + ((size_t)l * 256 + c) * 8192;
  for (int i = 0; i < 16; ++i) {
    const int k = tid + NTHR * i;
    buf[k] = cmul(buf[k], kf[k]);
  }
  __syncthreads();
  fft8192(buf, 1.f);
#pragma unroll
  for (int bb = 0; bb < 2; ++bb) {
    const int b = 2 * bp + bb;
    float x0[10];
    ld10(p.hyT + ((size_t)(b * 768 + c)) * 4096, t0, x0);
    float o[8];
#pragma unroll
    for (int k = 0; k < 8; ++k) {
      const c2 y = buf[t0 + k];
      const c2 uu = ub[t0 + k];
      const float x0c = bx0 + wx0[0] * x0[k] + wx0[1] * x0[k + 1] + wx0[2] * x0[k + 2];
      const float yy = ldexpf(bb ? y.y : y.x, -13);
      const float uv = bb ? uu.y : uu.x;
      o[k] = x0c * (yy + uv * dsk);
    }
    uint4 w; w.x = pk2(o[0], o[1]); w.y = pk2(o[2], o[3]); w.z = pk2(o[4], o[5]); w.w = pk2(o[6], o[7]);
    *(uint4*)(p.ybT + ((size_t)(b * 256 + c)) * 4096 + t0) = w;
  }
  __syncthreads();
}
__device__ __forceinline__ void yb_transpose_task(const P& p, int b, int tb, char* smem) {
  const int tid = opaque_tid(), lane = tid & 63, wid = tid >> 6;
  u16* T = (u16*)smem;
#pragma unroll
  for (int it = 0; it < 4; ++it) {
    const int id = tid + NTHR * it;
    const int c = id >> 3, ch = id & 7;
    const uint4 r = *(const uint4*)(p.ybT + ((size_t)(b * 256 + c)) * 4096 + tb * 64 + ch * 8);
    unsigned* d = (unsigned*)(T + c * 66 + ch * 8);
    d[0] = r.x; d[1] = r.y; d[2] = r.z; d[3] = r.w;
  }
  __syncthreads();
#pragma unroll
  for (int it = 0; it < 8; ++it) {
    const int tt = wid + 8 * it;
    const int c0 = lane * 4;
    uint2 w;
    w.x = (unsigned)T[(c0 + 0) * 66 + tt] | ((unsigned)T[(c0 + 1) * 66 + tt] << 16);
    w.y = (unsigned)T[(c0 + 2) * 66 + tt] | ((unsigned)T[(c0 + 3) * 66 + tt] << 16);
    *(uint2*)(p.ycat + (size_t)(b * 4096 + tb * 64 + tt) * 1024 + 512 + c0) = w;
  }
  __syncthreads();
}
__device__ __forceinline__ void hyena_ctx_task(const P& p, int l, int b, int cg8, char* smem) {
  const int tid_ = opaque_tid(); const int lane = tid_ & 63, wid = tid_ >> 6;
  const int c = cg8 * 8 + wid;
  float* us = (float*)smem + wid * 1024;
  float* kfp = us + 256 + 255;
  const float* sw = p.hy_short_w + l * 3 * 768;
  const float* sb = p.hy_short_b + l * 768;
  const u16* x0 = p.hyTc + ((size_t)(b * 768 + c)) * 256;
  const u16* x1 = p.hyTc + ((size_t)(b * 768 + 256 + c)) * 256;
  const u16* vv = p.hyTc + ((size_t)(b * 768 + 512 + c)) * 256;
  for (int i = 0; i < 4; ++i) {
    const int t = lane + 64 * i;
    const float x1c = sb[256 + c] + sw[256 + c] * ldbf(x1, t - 1, 256) + sw[768 + 256 + c] * ldbf(x1, t, 256) + sw[1536 + 256 + c] * ldbf(x1, t + 1, 256);
    const float vc = sb[512 + c] + sw[512 + c] * ldbf(vv, t - 1, 256) + sw[768 + 512 + c] * ldbf(vv, t, 256) + sw[1536 + 512 + c] * ldbf(vv, t + 1, 256);
    us[t] = vc * x1c;
    kfp[t] = p.hc[(size_t)c * 256 + t];
    if (t > 0) kfp[-t] = p.hc[(size_t)(256 + c) * 256 + t];
  }
  __syncthreads();
  const float dsk = p.hy_bias[l * 256 + c];
  float acc[4] = {0.f, 0.f, 0.f, 0.f};
  for (int s = 0; s < 256; ++s) {
    const float uv = us[s];
#pragma unroll
    for (int i = 0; i < 4; ++i) acc[i] += kfp[lane + 64 * i - s] * uv;
  }
#pragma unroll
  for (int i = 0; i < 4; ++i) {
    const int t = lane + 64 * i;
    const float x0c = sb[c] + sw[c] * ldbf(x0, t - 1, 256) + sw[768 + c] * ldbf(x0, t, 256) + sw[1536 + c] * ldbf(x0, t + 1, 256);
    p.ycat[(size_t)(NLAT + b * 256 + t) * 1024 + 512 + c] = f2bf(x0c * (acc[i] + us[t] * dsk));
  }
  __syncthreads();
}

template <int DIR>
__device__ __forceinline__ void rg_scan32(const float (&Av)[2][16], const float (&Bv)[2][16], float (&carry)[2], float (&H)[2][16], int hh) {
#pragma unroll
  for (int nt = 0; nt < 2; ++nt) {
    float c = carry[nt];
#pragma unroll
    for (int go = 0; go < 8; ++go) {
      const int g = DIR ? 7 - go : go, q = g >> 1, own = g & 1;
      float h = c;
#pragma unroll
      for (int io = 0; io < 4; ++io) {
        const int e = 4 * q + (DIR ? 3 - io : io);
        h = Av[nt][e] * h + Bv[nt][e];
        H[nt][e] = (hh == own) ? h : H[nt][e];
      }
      const float mine = (hh == own) ? h : c;
      const float other = shx(mine, 32);
      c = (hh == own) ? mine : other;
    }
    carry[nt] = c;
  }
}
__device__ __forceinline__ void rg_wave_task(const P& p, int l, int bq, int nblk, int mode, bool last, char* smem) {
  const int tid = opaque_tid(), lane = tid & 63, wid = tid >> 6;
  const int l31 = lane & 31, hh = lane >> 5;
  const int b = bq / 34, rr = bq - b * 34;
  const int seg = rr < 2 ? 0 : 1, blk = rr < 2 ? rr : rr - 2;
  if (mode == 1 && seg == 0 && last) return;
  const int ck = wid >> 1, dir = wid & 1;
  char* wreg = smem + wid * 17408;
  u16* xs = (u16*)wreg;
  char* xcb = wreg + 4608;
  float* xcf = (float*)(wreg + 8704);
  float2* blockagg = (float2*)(smem + 139264);
  const int Lseg = seg ? 4096 : 256;
  const int tokbase = seg ? b * 4096 : NLAT + b * 256;
  const int T0 = blk * 128 + ck * 32;
  const int cg32 = (seg ? 8 : 0) + blk * 4 + ck;
  bf16x8 wf[2][2][4];
#pragma unroll
  for (int gate = 0; gate < 2; ++gate) {
    const u16* wp = p.rgW + (size_t)(((l * 2 + gate) * 2 + dir) * 4 + nblk) * 4096 + l31 * 64 + 8 * hh;
#pragma unroll
    for (int nt = 0; nt < 2; ++nt)
#pragma unroll
      for (int s = 0; s < 4; ++s) wf[gate][nt][s] = *(const bf16x8*)(wp + nt * 2048 + 16 * s);
  }
  float cba[2], cbx[2], csp[2];
#pragma unroll
  for (int nt = 0; nt < 2; ++nt) {
    const int ch = (l * 2 + dir) * 256 + nblk * 64 + nt * 32 + l31;
    cba[nt] = p.rg_ba[ch];
    cbx[nt] = p.rg_bx[ch];
    csp[nt] = __logf(1.0f + __expf(-p.rg_lambda[ch]));
  }
#pragma unroll
  for (int i = 0; i < 5; ++i) {
    const int idx = lane + 64 * i;
    const int row = idx >> 3, chunk = idx & 7;
    if (row < 35) {
      const int pos = T0 - 2 + row;
      uint4 v = make_uint4(0u, 0u, 0u, 0u);
      if (pos >= 0 && pos < Lseg) v = *(const uint4*)(p.rg + (size_t)(tokbase + pos) * 512 + nblk * 64 + chunk * 8);
      *(uint4*)(xs + row * 64 + chunk * 8) = v;
    }
  }
  asm volatile("s_waitcnt lgkmcnt(0)" ::: "memory");
  {
    const int ch = l * 256 + nblk * 64 + lane;
    const float w0 = p.rg_conv_w[(l * 4 + 0) * 256 + nblk * 64 + lane], w1 = p.rg_conv_w[(l * 4 + 1) * 256 + nblk * 64 + lane];
    const float w2 = p.rg_conv_w[(l * 4 + 2) * 256 + nblk * 64 + lane], w3 = p.rg_conv_w[(l * 4 + 3) * 256 + nblk * 64 + lane];
    const float cb = p.rg_conv_b[ch];
    float x0 = bf2f(xs[0 * 64 + lane]), x1 = bf2f(xs[1 * 64 + lane]), x2 = bf2f(xs[2 * 64 + lane]);
#pragma unroll
    for (int t = 0; t < 32; ++t) {
      const float x3 = bf2f(xs[(t + 3) * 64 + lane]);
      const float xc = cb + w0 * x0 + w1 * x1 + w2 * x2 + w3 * x3;
      xcf[t * 68 + lane] = xc;
      *(u16*)(xcb + swz128(t, lane >> 3) + (lane & 7) * 2) = f2bf(xc);
      x0 = x1; x1 = x2; x2 = x3;
    }
  }
  asm volatile("s_waitcnt lgkmcnt(0)" ::: "memory");
  float Av[2][16], Bv[2][16];
  {
    f32x16 acc[2][2];
#pragma unroll
    for (int gate = 0; gate < 2; ++gate)
#pragma unroll
      for (int nt = 0; nt < 2; ++nt) acc[gate][nt] = zero16();
#pragma unroll
    for (int s = 0; s < 4; ++s) {
      const bf16x8 af = *(const bf16x8*)(xcb + swz128(l31, 2 * s + hh));
#pragma unroll
      for (int gate = 0; gate < 2; ++gate)
#pragma unroll
        for (int nt = 0; nt < 2; ++nt) acc[gate][nt] = mfma32(af, wf[gate][nt][s], acc[gate][nt]);
    }
#pragma unroll
    for (int nt = 0; nt < 2; ++nt)
#pragma unroll
      for (int e = 0; e < 16; ++e) {
        const int tok = (e & 3) + 8 * (e >> 2) + 4 * hh;
        const float r = sigmoidf_(acc[0][nt][e] + cba[nt]);
        const float ii = sigmoidf_(acc[1][nt][e] + cbx[nt]);
        const float la = -8.0f * r * csp[nt];
        const float av = __expf(la);
        const float e2 = 2.0f * la;
        const float om = (e2 > -0.1f) ? (-e2 * (1.0f + e2 * (0.5f + e2 * (0.16666667f + e2 * 0.041666668f)))) : (1.0f - __expf(e2));
        Av[nt][e] = av;
        Bv[nt][e] = sqrtf(om) * ii * xcf[tok * 68 + nt * 32 + l31];
      }
  }
  float H[2][16];
#pragma unroll
  for (int nt = 0; nt < 2; ++nt)
#pragma unroll
    for (int e = 0; e < 16; ++e) H[nt][e] = 0.f;
  float carry[2] = {0.f, 0.f};
  float2* agg1 = (float2*)p.agg;
  float2* agg2 = (float2*)p.agg + (size_t)8 * 2 * 136 * 256;
  const int pos2 = dir ? (seg == 0 ? 1 - blk : 33 - blk) : (seg == 0 ? blk : 2 + blk);
  if (mode == 0) {
    if (dir) rg_scan32<1>(Av, Bv, carry, H, hh); else rg_scan32<0>(Av, Bv, carry, H, hh);
    float P[2];
#pragma unroll
    for (int nt = 0; nt < 2; ++nt) {
      float pr = 1.f;
#pragma unroll
      for (int e = 0; e < 16; ++e) pr *= Av[nt][e];
      P[nt] = pr * shx(pr, 32);
    }
    const float2 mine = make_float2(hh ? P[1] : P[0], hh ? carry[1] : carry[0]);
    agg1[((size_t)(b * 2 + dir) * 136 + cg32) * 256 + nblk * 64 + lane] = mine;
    blockagg[(ck * 2 + dir) * 64 + lane] = mine;
    __syncthreads();
    if (wid < 2) {
      const int d2 = wid;
      float A = 1.f, B = 0.f;
#pragma unroll
      for (int co = 0; co < 4; ++co) {
        const int c = d2 ? 3 - co : co;
        const float2 g = blockagg[(c * 2 + d2) * 64 + lane];
        B = g.x * B + g.y;
        A *= g.x;
      }
      const int p2 = d2 ? (seg == 0 ? 1 - blk : 33 - blk) : (seg == 0 ? blk : 2 + blk);
      agg2[((size_t)(b * 2 + d2) * 34 + p2) * 256 + nblk * 64 + lane] = make_float2(A, B);
    }
    __syncthreads();
    return;
  }
  {
    float h = 0.f;
    const float2* a2 = agg2 + ((size_t)(b * 2 + dir) * 34) * 256 + nblk * 64 + lane;
    int j = 0;
    for (; j + 8 <= pos2; j += 8) {
      float2 g[8];
#pragma unroll
      for (int u = 0; u < 8; ++u) g[u] = a2[(size_t)(j + u) * 256];
#pragma unroll
      for (int u = 0; u < 8; ++u) h = g[u].x * h + g[u].y;
    }
    for (; j < pos2; ++j) { const float2 g = a2[(size_t)j * 256]; h = g.x * h + g.y; }
    const float2* a1 = agg1 + ((size_t)(b * 2 + dir) * 136 + (cg32 - ck)) * 256 + nblk * 64 + lane;
    const int npre = dir ? 3 - ck : ck;
    for (int i = 0; i < npre; ++i) {
      const int c = dir ? 3 - i : i;
      const float2 g = a1[(size_t)c * 256];
      h = g.x * h + g.y;
    }
    carry[0] = shf(h, l31);
    carry[1] = shf(h, 32 + l31);
  }
  if (dir) rg_scan32<1>(Av, Bv, carry, H, hh); else rg_scan32<0>(Av, Bv, carry, H, hh);
  asm volatile("s_waitcnt lgkmcnt(0)" ::: "memory");
#pragma unroll
  for (int nt = 0; nt < 2; ++nt)
#pragma unroll
    for (int e = 0; e < 16; ++e) xcf[((e & 3) + 8 * (e >> 2) + 4 * hh) * 68 + nt * 32 + l31] = H[nt][e];
  __syncthreads();
  {
    const float* hfT = (const float*)(smem + (ck * 2 + 0) * 17408 + 8704);
    const float* hbT = (const float*)(smem + (ck * 2 + 1) * 17408 + 8704);
    const int tok = 16 * dir + (lane >> 2), c16 = (lane & 3) * 16;
    const size_t gtok = (size_t)tokbase + T0 + tok;
    const u16* gp = p.rg + gtok * 512 + 256 + nblk * 64 + c16;
    u16* op = p.ycat + gtok * 1024 + 768 + nblk * 64 + c16;
#pragma unroll
    for (int hv = 0; hv < 2; ++hv) {
      const uint4 g = *(const uint4*)(gp + hv * 8);
      const float4 f0 = *(const float4*)(hfT + tok * 68 + c16 + hv * 8), f1 = *(const float4*)(hfT + tok * 68 + c16 + hv * 8 + 4);
      const float4 h0 = *(const float4*)(hbT + tok * 68 + c16 + hv * 8), h1 = *(const float4*)(hbT + tok * 68 + c16 + hv * 8 + 4);
      uint4 o;
      o.x = pk2((f0.x + h0.x) * gelu_tanh(bflo(g.x)), (f0.y + h0.y) * gelu_tanh(bfhi(g.x)));
      o.y = pk2((f0.z + h0.z) * gelu_tanh(bflo(g.y)), (f0.w + h0.w) * gelu_tanh(bfhi(g.y)));
      o.z = pk2((f1.x + h1.x) * gelu_tanh(bflo(g.z)), (f1.y + h1.y) * gelu_tanh(bfhi(g.z)));
      o.w = pk2((f1.z + h1.z) * gelu_tanh(bflo(g.w)), (f1.w + h1.w) * gelu_tanh(bfhi(g.w)));
      *(uint4*)(op + hv * 8) = o;
    }
  }
  __syncthreads();
}

__device__ __forceinline__ void attn_wave(const P& p, int l, int b, int h, bool local, int r, int half, int qtok0, const float* rpbL) {
  const int lane = opaque_tid() & 63, q = lane & 31, hh = lane >> 5;
  bf16x8 qf[4];
  {
    const u16* qp = p.qk + (size_t)(qtok0 + q) * 1024 + h * 64 + 8 * hh;
#pragma unroll
    for (int s = 0; s < 4; ++s) qf[s] = *(const bf16x8*)(qp + 16 * s);
  }
  f32x16 o0 = zero16(), o1 = zero16();
  float m_run = -1e30f, l_run = 0.f;
  const int pi = (q & 19) | ((q & 4) << 1) | ((q & 8) >> 1);
  const int w = half * 32 + q;
  const int st = min(max(w - 8, 0), 48);
  const int rs = min(max(r - 4, 0), 56);
  const int ntiles = local ? 24 : 8;
  bf16x8 kfn[4], vfn[2][2];
  auto tile_load = [&](int ti, bf16x8 (&kfo)[4], bf16x8 (&vfo)[2][2]) {
    int ktok0, vstride;
    const u16* vb;
    if (ti < 8) {
      ktok0 = NLAT + b * 256 + ti * 32;
      vb = p.vTc + ((size_t)(b * 512 + h * 64)) * 256 + ti * 32;
      vstride = 256;
    } else {
      const int tl = ti - 8;
      const int a2 = tl >> 1, g2 = tl & 1;
      ktok0 = b * 4096 + (rs + a2) * 64 + g2 * 32;
      vb = p.vT + ((size_t)(b * 512 + h * 64)) * 4096 + (rs + a2) * 64 + g2 * 32;
      vstride = 4096;
    }
    const u16* kp = p.qk + (size_t)(ktok0 + pi) * 1024 + 512 + h * 64 + 8 * hh;
#pragma unroll
    for (int s = 0; s < 4; ++s) kfo[s] = *(const bf16x8*)(kp + 16 * s);
#pragma unroll
    for (int dt = 0; dt < 2; ++dt)
#pragma unroll
      for (int s2 = 0; s2 < 2; ++s2) vfo[dt][s2] = *(const bf16x8*)(vb + (size_t)(dt * 32 + q) * vstride + 16 * s2 + 8 * hh);
  };
  tile_load(0, kfn, vfn);
  for (int ti = 0; ti < ntiles; ++ti) {
    int a = 0, g = 0;
    if (ti >= 8) { a = (ti - 8) >> 1; g = (ti - 8) & 1; }
    bf16x8 kf[4], vf[2][2];
#pragma unroll
    for (int s = 0; s < 4; ++s) kf[s] = kfn[s];
#pragma unroll
    for (int dt = 0; dt < 2; ++dt)
#pragma unroll
      for (int s2 = 0; s2 < 2; ++s2) vf[dt][s2] = vfn[dt][s2];
    if (ti + 1 < ntiles) tile_load(ti + 1, kfn, vfn);
    f32x16 sacc = zero16();
#pragma unroll
    for (int s = 0; s < 4; ++s) sacc = mfma32(kf[s], qf[s], sacc);
    float sv[16];
    float tmax = -1e30f;
#pragma unroll
    for (int e = 0; e < 16; ++e) {
      float x = sacc[e] * 0.125f;
      if (ti >= 8) {
        const int kc = g * 32 + (e & 7) + 8 * hh + 16 * (e >> 3);
        const bool valid = (kc >= st) && (kc < st + 16);
        const int bi = valid ? ((rs + a - r + 7) * 31 + (kc - w + 15)) : 0;
        const float bias = rpbL[bi];
        x = valid ? (x + bias) : -1e30f;
      }
      sv[e] = x;
      tmax = fmaxf(tmax, x);
    }
    tmax = fmaxf(tmax, shx(tmax, 32));
    const float m_new = fmaxf(m_run, tmax);
    const float alpha = __expf(m_run - m_new);
    m_run = m_new;
    l_run *= alpha;
#pragma unroll
    for (int e = 0; e < 16; ++e) { o0[e] *= alpha; o1[e] *= alpha; }
    float psum = 0.f;
#pragma unroll
    for (int e = 0; e < 16; ++e) { const float pe = __expf(sv[e] - m_new); sv[e] = pe; psum += pe; }
    l_run += psum;
    bf16x8 pf[2];
#pragma unroll
    for (int s2 = 0; s2 < 2; ++s2) {
      union { bf16x8 v; unsigned u[4]; } cv;
#pragma unroll
      for (int j = 0; j < 4; ++j) cv.u[j] = pk2(sv[8 * s2 + 2 * j], sv[8 * s2 + 2 * j + 1]);
      pf[s2] = cv.v;
    }
#pragma unroll
    for (int s2 = 0; s2 < 2; ++s2) {
      o0 = mfma32(vf[0][s2], pf[s2], o0);
      o1 = mfma32(vf[1][s2], pf[s2], o1);
    }
  }
  const float lt = l_run + shx(l_run, 32);
  const float inv = 1.0f / lt;
  u16* op = p.ycat + (size_t)(qtok0 + q) * 1024 + h * 64;
#pragma unroll
  for (int qd = 0; qd < 4; ++qd) {
    uint2 a0, a1;
    a0.x = pk2(o0[4 * qd] * inv, o0[4 * qd + 1] * inv);
    a0.y = pk2(o0[4 * qd + 2] * inv, o0[4 * qd + 3] * inv);
    a1.x = pk2(o1[4 * qd] * inv, o1[4 * qd + 1] * inv);
    a1.y = pk2(o1[4 * qd + 2] * inv, o1[4 * qd + 3] * inv);
    *(uint2*)(op + 8 * qd + 4 * hh) = a0;
    *(uint2*)(op + 32 + 8 * qd + 4 * hh) = a1;
  }
}
__device__ __forceinline__ void attn_block_task(const P& p, int l, int b, int h, int rg4, char* smem) {
  const int tid = opaque_tid(), lane = tid & 63, wid = tid >> 6;
  const int q = lane & 31, hh = lane >> 5;
  const int R0 = rg4 * 4;
  const int r = R0 + (wid >> 1), half = wid & 1;
  float* rpbL = (float*)(smem + 32768) + 64;
  for (int i = tid; i < 465; i += NTHR) rpbL[i] = p.na_rpb[(size_t)(l * 8 + h) * 465 + i] * 1.4426950408889634f;
  const int lo = min(max(R0 - 4, 0), 56);
  const int hi = min(max(R0 + 3 - 4, 0), 56) + 7;
  const int ntile = 4 + (hi - lo + 1);
  const int rs = min(max(r - 4, 0), 56);
  const int qtok = b * 4096 + r * 64 + half * 32 + q;
  bf16x8 qf[4];
  {
    const u16* qp = p.qk + (size_t)qtok * 1024 + h * 64 + 8 * hh;
#pragma unroll
    for (int s = 0; s < 4; ++s) qf[s] = *(const bf16x8*)(qp + 16 * s);
  }
  f32x16 o0 = zero16(), o1 = zero16();
  float m_run = -1e30f, l_run = 0.f;
  const int pi = (q & 19) | ((q & 4) << 1) | ((q & 8) >> 1);
  const int w = half * 32 + q;
  const int st = min(max(w - 8, 0), 48);
  unsigned vmask = 0u;
#pragma unroll
  for (int g = 0; g < 2; ++g)
#pragma unroll
    for (int e = 0; e < 16; ++e) {
      const int kc = g * 32 + (e & 7) + 8 * hh + 16 * (e >> 3);
      vmask |= ((kc >= st) && (kc < st + 16)) ? (1u << (g * 16 + e)) : 0u;
    }
  const int cbase = 8 * hh - w + 15;
  const int srow = tid >> 3, sch = tid & 7;
  uint4 rkA, rvA, rkB, rvB;
  auto gload = [&](int ti, uint4& rk, uint4& rv) {
    int ktok0, vstride;
    const u16* vb;
    if (ti < 4) { ktok0 = NLAT + b * 256 + ti * 64; vb = p.vTc + ((size_t)(b * 512 + h * 64)) * 256 + ti * 64; vstride = 256; }
    else { const int R = lo + ti - 4; ktok0 = b * 4096 + R * 64; vb = p.vT + ((size_t)(b * 512 + h * 64)) * 4096 + R * 64; vstride = 4096; }
    rk = *(const uint4*)(p.qk + (size_t)(ktok0 + srow) * 1024 + 512 + h * 64 + sch * 8);
    rv = *(const uint4*)(vb + (size_t)srow * vstride + sch * 8);
  };
  gload(0, rkA, rvA);
  *(uint4*)(smem + swz128(srow, sch)) = rkA;
  *(uint4*)(smem + 16384 + swz128(srow, sch)) = rvA;
  gload(1, rkA, rvA);
  if (2 < ntile) gload(2, rkB, rvB);
  __syncthreads();
  auto compute = [&](int ti) {
    const char* Kb = smem + (ti & 1) * 8192;
    const char* Vb = smem + 16384 + (ti & 1) * 8192;
    const int R = lo + ti - 4;
    const bool active = (ti < 4) || (R >= rs && R < rs + 8);
    if (active) {
      f32x16 sacc0 = zero16(), sacc1 = zero16();
#pragma unroll
      for (int s = 0; s < 4; ++s) {
        const bf16x8 kf0 = *(const bf16x8*)(Kb + swz128(pi, 2 * s + hh));
        const bf16x8 kf1 = *(const bf16x8*)(Kb + swz128(32 + pi, 2 * s + hh));
        sacc0 = mfma32(kf0, qf[s], sacc0);
        sacc1 = mfma32(kf1, qf[s], sacc1);
      }
      float sv[32];
      float tmax = -1e30f;
      if (ti >= 4) {
        const float* brow = rpbL + (R - r + 7) * 31 + cbase;
        float bias[32];
#pragma unroll
        for (int g = 0; g < 2; ++g)
#pragma unroll
          for (int e = 0; e < 16; ++e) bias[g * 16 + e] = brow[g * 32 + (e & 7) + 16 * (e >> 3)];
#pragma unroll
        for (int g = 0; g < 2; ++g)
#pragma unroll
          for (int e = 0; e < 16; ++e) {
            const float sc = g ? sacc1[e] : sacc0[e];
            const float x = ((int)(vmask << (31 - (g * 16 + e))) < 0) ? fmaf(sc, 0.18033688011112042f, bias[g * 16 + e]) : -1e30f;
            sv[g * 16 + e] = x;
            tmax = fmaxf(tmax, x);
          }
      } else {
#pragma unroll
        for (int g = 0; g < 2; ++g)
#pragma unroll
          for (int e = 0; e < 16; ++e) {
            const float x = (g ? sacc1[e] : sacc0[e]) * 0.18033688011112042f;
            sv[g * 16 + e] = x;
            tmax = fmaxf(tmax, x);
          }
      }
      tmax = fmaxf(tmax, shx(tmax, 32));
      if (__builtin_amdgcn_ballot_w64(tmax > m_run) != 0ull) {
        const float m_new = fmaxf(m_run, tmax);
        const float alpha = __builtin_amdgcn_exp2f(m_run - m_new);
        m_run = m_new;
        l_run *= alpha;
#pragma unroll
        for (int e = 0; e < 16; ++e) { o0[e] *= alpha; o1[e] *= alpha; }
      }
      float psum = 0.f;
#pragma unroll
      for (int e = 0; e < 32; ++e) { const float pe = __builtin_amdgcn_exp2f(sv[e] - m_run); sv[e] = pe; psum += pe; }
      l_run += psum;
#pragma unroll
      for (int g = 0; g < 2; ++g)
#pragma unroll
        for (int s2 = 0; s2 < 2; ++s2) {
          union { bf16x8 v; unsigned u[4]; } cv;
#pragma unroll
          for (int j = 0; j < 4; ++j) cv.u[j] = pk2(sv[g * 16 + 8 * s2 + 2 * j], sv[g * 16 + 8 * s2 + 2 * j + 1]);
          const bf16x8 v0 = *(const bf16x8*)(Vb + swz128(q, g * 4 + 2 * s2 + hh));
          const bf16x8 v1 = *(const bf16x8*)(Vb + swz128(32 + q, g * 4 + 2 * s2 + hh));
          o0 = mfma32(v0, cv.v, o0);
          o1 = mfma32(v1, cv.v, o1);
        }
    }
  };
  for (int ti = 0; ti < ntile; ti += 2) {
    compute(ti);
    if (ti + 1 < ntile) {
      *(uint4*)(smem + 8192 + swz128(srow, sch)) = rkA;
      *(uint4*)(smem + 16384 + 8192 + swz128(srow, sch)) = rvA;
      if (ti + 3 < ntile) gload(ti + 3, rkA, rvA);
    }
    __syncthreads();
    if (ti + 1 < ntile) {
      compute(ti + 1);
      if (ti + 2 < ntile) {
        *(uint4*)(smem + swz128(srow, sch)) = rkB;
        *(uint4*)(smem + 16384 + swz128(srow, sch)) = rvB;
        if (ti + 4 < ntile) gload(ti + 4, rkB, rvB);
      }
      __syncthreads();
    }
  }
  const float lt = l_run + shx(l_run, 32);
  const float inv = 1.0f / lt;
  __syncthreads();
  {
    char* ot = smem + wid * 4608;
#pragma unroll
    for (int qd = 0; qd < 4; ++qd) {
      uint2 a0, a1;
      a0.x = pk2(o0[4 * qd] * inv, o0[4 * qd + 1] * inv);
      a0.y = pk2(o0[4 * qd + 2] * inv, o0[4 * qd + 3] * inv);
      a1.x = pk2(o1[4 * qd] * inv, o1[4 * qd + 1] * inv);
      a1.y = pk2(o1[4 * qd + 2] * inv, o1[4 * qd + 3] * inv);
      *(uint2*)(ot + q * 144 + (8 * qd + 4 * hh) * 2) = a0;
      *(uint2*)(ot + q * 144 + (32 + 8 * qd + 4 * hh) * 2) = a1;
    }
    asm volatile("s_waitcnt lgkmcnt(0)" ::: "memory");
    const int tok0 = b * 4096 + r * 64 + half * 32;
#pragma unroll
    for (int it = 0; it < 4; ++it) {
      const int qq = it * 8 + (lane >> 3), ch = lane & 7;
      const uint4 v = *(const uint4*)(ot + qq * 144 + ch * 16);
      *(uint4*)(p.ycat + (size_t)(tok0 + qq) * 1024 + h * 64 + ch * 8) = v;
    }
  }
  __syncthreads();
}
__device__ __forceinline__ void attn_task(const P& p, int l, int kind, int idx, char* smem) {
  const int tid_ = opaque_tid(); const int lane = tid_ & 63, wid = tid_ >> 6;
  float* rpbL = (float*)smem + wid * 480;
  for (int i = lane; i < 465; i += 64) rpbL[i] = p.na_rpb[(size_t)(l * 8 + wid) * 465 + i];
  __syncthreads();
  if (kind == 0) {
    const int half = idx & 1, r = (idx >> 1) & 63, b = idx >> 7;
    attn_wave(p, l, b, wid, true, r, half, b * 4096 + r * 64 + half * 32, rpbL);
  } else {
    const int qg = idx & 7, b = idx >> 3;
    attn_wave(p, l, b, wid, false, 0, 0, NLAT + b * 256 + qg * 32, rpbL);
  }
  __syncthreads();
}

__device__ __forceinline__ void phase_mixers(const P& p, int l, char* smem, unsigned* counter) {
  const bool last = (l == 1);
  const int n_rg = 1088 * XRGA, n_fft = 1024 * XFFT, n_hc = last ? 0 : 256, n_att = 1024 * XATT, n_attc = last ? 0 : 64;
  const int total = n_rg + n_fft + n_hc + n_att + n_attc;
  volatile int* s_taskp = (volatile int*)(smem + SMEM_BYTES - 16);
  for (;;) {
    __syncthreads();
    if (threadIdx.x == 0) *s_taskp = (int)atomicAdd(counter, 1u);
    __syncthreads();
    int t = *s_taskp;
    if (t >= total) break;
    if (t < n_att) { t &= 1023; attn_block_task(p, l, t >> 7, (t >> 4) & 7, t & 15, smem); continue; }
    t -= n_att;
    if (t < n_attc) { attn_task(p, l, 1, t, smem); continue; }
    t -= n_attc;
    if (t < n_fft) { t &= 1023; hyena_fft_task(p, l, t >> 2, t & 3, smem); continue; }
    t -= n_fft;
    if (t < n_hc) { hyena_ctx_task(p, l, t >> 5, t & 31, smem); continue; }
    t -= n_hc;
    if (t >= 1088) t -= 1088;
    rg_wave_task(p, l, t >> 2, t & 3, 0, last, smem);
  }
}

__device__ __forceinline__ void merge_tile(const P& p, int l, int mt, int nt, char* smem) {
  EPI_VARS
  const int m0 = mt * 256, n0 = nt * 128;
  f32x16 macc[2][2];
  zero_acc(macc);
  for (int br = 0; br < 3; ++br) {
    unsigned* gpl = (unsigned*)(smem + 98304) + tid;
    {
      f32x16 acc[2][2];
      zero_acc(acc);
      gemm_kloop(acc, p.xn + (size_t)m0 * 1024, 1024, p.WgT + ((size_t)l * 3072 + br * 1024 + n0) * 1024, 1024, 1024, smem);
#pragma unroll
      for (int j = 0; j < 2; ++j) {
        const float bg = p.b_gate[l * 3072 + br * 1024 + n0 + EPI_COL(j)];
#pragma unroll
        for (int i = 0; i < 2; ++i)
#pragma unroll
          for (int e = 0; e < 4; ++e) {
            const unsigned q0 = (unsigned)(sigmoidf_(acc[i][j][4 * e] + bg) * 255.0f + 0.5f);
            const unsigned q1 = (unsigned)(sigmoidf_(acc[i][j][4 * e + 1] + bg) * 255.0f + 0.5f);
            const unsigned q2 = (unsigned)(sigmoidf_(acc[i][j][4 * e + 2] + bg) * 255.0f + 0.5f);
            const unsigned q3 = (unsigned)(sigmoidf_(acc[i][j][4 * e + 3] + bg) * 255.0f + 0.5f);
            gpl[((i * 2 + j) * 4 + e) * 512] = q0 | (q1 << 8) | (q2 << 16) | (q3 << 24);
          }
      }
    }
    {
      f32x16 acc[2][2];
      zero_acc(acc);
      const u16* A; const u16* B; int K;
      if (br == 0) { A = p.ycat + (size_t)m0 * 1024; B = p.WaT + ((size_t)l * 1024 + n0) * 512; K = 512; }
      else if (br == 1) { A = p.ycat + (size_t)m0 * 1024 + 512; B = p.WbT + ((size_t)l * 1024 + n0) * 256; K = 256; }
      else { A = p.ycat + (size_t)m0 * 1024 + 768; B = p.WcT + ((size_t)l * 1024 + n0) * 256; K = 256; }
      gemm_kloop(acc, A, 1024, B, K, K, smem);
#pragma unroll
      for (int i = 0; i < 2; ++i)
#pragma unroll
        for (int j = 0; j < 2; ++j)
#pragma unroll
          for (int e = 0; e < 4; ++e) {
            const unsigned g4 = gpl[((i * 2 + j) * 4 + e) * 512];
            macc[i][j][4 * e] += (float)(g4 & 255u) * (1.0f / 255.0f) * acc[i][j][4 * e];
            macc[i][j][4 * e + 1] += (float)((g4 >> 8) & 255u) * (1.0f / 255.0f) * acc[i][j][4 * e + 1];
            macc[i][j][4 * e + 2] += (float)((g4 >> 16) & 255u) * (1.0f / 255.0f) * acc[i][j][4 * e + 2];
            macc[i][j][4 * e + 3] += (float)(g4 >> 24) * (1.0f / 255.0f) * acc[i][j][4 * e + 3];
          }
    }
  }
#pragma unroll
  for (int i = 0; i < 2; ++i)
#pragma unroll
    for (int j = 0; j < 2; ++j)
#pragma unroll
      for (int e = 0; e < 16; ++e)
        p.mbuf[(size_t)(m0 + EPI_ROW(i, e)) * 1024 + n0 + EPI_COL(j)] = f2bf(macc[i][j][e]);
}
__device__ __forceinline__ void outproj_tile(const P& p, int l, int mt, int nt, char* smem, bool do_store) {
  EPI_VARS
  const int m0 = mt * 256, n0 = nt * 128;
  f32x16 acc[2][2];
  zero_acc(acc);
  gemm_kloop(acc, p.mbuf + (size_t)m0 * 1024, 1024, p.WoT + ((size_t)l * 1024 + n0) * 1024, 1024, 1024, smem);
  const bool isctx = (mt >= 128);
  const int bi = isctx ? 8 : (mt >> 4);
  const float* gatev = p.mod + ((size_t)(l * 9 + bi) * 6 + 2) * 1024;
  const float* src; float* dst;
  if (isctx) { src = (l == 0 ? p.ctx : p.ctxs) - (size_t)NLAT * 1024; dst = p.ctxs - (size_t)NLAT * 1024; }
  else { src = (l == 0 ? p.x : p.out); dst = p.out; }
#pragma unroll
  for (int j = 0; j < 2; ++j) {
    const int col = n0 + EPI_COL(j);
    const float gv = gatev[col];
#pragma unroll
    for (int i = 0; i < 2; ++i)
#pragma unroll
      for (int e = 0; e < 16; ++e) {
        const size_t o = (size_t)(m0 + EPI_ROW(i, e)) * 1024 + col;
        if (do_store) dst[o] = src[o] + gv * acc[i][j][e];
      }
  }
}

__device__ __forceinline__ void wqk_task(const P& p, int l, int hp, int nt, char* smem) {
  EPI_VARS
  f32x16 acc[2][2];
  zero_acc(acc);
  gemm_kloop(acc, p.keysB + ((size_t)l * 16 + hp) * 16384, 128, p.WqB + (size_t)l * 1024 * 2048 + (size_t)(nt * 128) * 2048 + hp * 128, 2048, 128, smem);
  if (wm < 2) {
#pragma unroll
    for (int i = 0; i < 2; ++i)
#pragma unroll
      for (int j = 0; j < 2; ++j)
#pragma unroll
        for (int e = 0; e < 16; ++e)
          p.WqkT[((size_t)l * 2048 + hp * 128 + EPI_ROW(i, e)) * 1024 + nt * 128 + EPI_COL(j)] = f2bf(acc[i][j][e]);
  }
}
__device__ __forceinline__ void ins16(unsigned (&L)[16], unsigned x) {
#pragma unroll
  for (int i = 0; i < 16; ++i) {
    const unsigned hi = max(L[i], x);
    x = min(L[i], x);
    L[i] = hi;
  }
}
__device__ __forceinline__ unsigned f2sort(float f) {
  const unsigned b = __float_as_uint(f);
  return b ^ ((unsigned)((int)b >> 31) | 0x80000000u);
}
__device__ __forceinline__ float sort2f(unsigned k) {
  const unsigned u = k & ~127u;
  const unsigned b = (u & 0x80000000u) ? (u ^ 0x80000000u) : ~u;
  return __uint_as_float(b);
}
__device__ __forceinline__ void cx_desc(unsigned& a, unsigned& b) { const unsigned hi = max(a, b), lo = min(a, b); a = hi; b = lo; }
template <int BASE> __device__ __forceinline__ void sort16_desc(unsigned (&k)[64]) {
#pragma unroll
  for (int sz = 2; sz <= 16; sz <<= 1) {
#pragma unroll
    for (int j = sz >> 1; j >= 1; j >>= 1) {
#pragma unroll
      for (int i = 0; i < 16; ++i) {
        const int l2 = i ^ j;
        if (l2 > i) {
          if ((i & sz) == 0) cx_desc(k[BASE + i], k[BASE + l2]);
          else cx_desc(k[BASE + l2], k[BASE + i]);
        }
      }
    }
  }
}
template <int AB, int BB> __device__ __forceinline__ void merge16_desc(unsigned (&k)[64]) {
#pragma unroll
  for (int i = 0; i < 16; ++i) k[AB + i] = max(k[AB + i], k[BB + 15 - i]);
#pragma unroll
  for (int j = 8; j >= 1; j >>= 1) {
#pragma unroll
    for (int i = 0; i < 16; ++i)
      if ((i & j) == 0) cx_desc(k[AB + i], k[AB + i + j]);
  }
}
__device__ __forceinline__ void peer_score_tile(const P& p, int l, int mt, int hp, char* smem) {
  const int tid = opaque_tid();
  const int m0 = mt * 256;
  const int row = tid >> 1, hf = tid & 1;
  {
    char* T = smem + 16384;
#pragma unroll
    for (int it = 0; it < 8; ++it) {
      const int id = tid + NTHR * it;
      const int r = id >> 4, ch = id & 15;
      *(uint4*)(T + r * 272 + ch * 16) = *(const uint4*)(p.q + (size_t)(m0 + r) * 2048 + hp * 128 + ch * 8);
    }
  }
  __syncthreads();
  const char* sp = smem + 16384 + row * 272 + hf * 128;
  unsigned k[64];
#pragma unroll
  for (int c = 0; c < 8; ++c) {
    const uint4 r = *(const uint4*)(sp + 16 * c);
    const unsigned w[4] = {r.x, r.y, r.z, r.w};
#pragma unroll
    for (int q = 0; q < 4; ++q) {
      const float v0 = __builtin_bit_cast(_Float16, (unsigned short)(w[q] & 0xffffu));
      const float v1 = __builtin_bit_cast(_Float16, (unsigned short)(w[q] >> 16));
      const int key = hf * 64 + c * 8 + q * 2;
      k[c * 8 + q * 2] = (f2sort(v0) & ~127u) | (unsigned)key;
      k[c * 8 + q * 2 + 1] = (f2sort(v1) & ~127u) | (unsigned)(key + 1);
    }
  }
  sort16_desc<0>(k); sort16_desc<16>(k); sort16_desc<32>(k); sort16_desc<48>(k);
  merge16_desc<0, 16>(k);
  merge16_desc<32, 48>(k);
  merge16_desc<0, 32>(k);
  unsigned* X = (unsigned*)smem;
  if (hf) {
#pragma unroll
    for (int i = 0; i < 16; ++i) X[row * 16 + i] = k[i];
  }
  __syncthreads();
  if (!hf) {
#pragma unroll
    for (int i = 0; i < 16; ++i) k[16 + i] = X[row * 16 + i];
    merge16_desc<0, 16>(k);
    unsigned* o = p.topk + ((size_t)(m0 + row) * 16 + hp) * 16;
#pragma unroll
    for (int i = 0; i < 4; ++i) *(uint4*)(o + 4 * i) = make_uint4(k[4 * i], k[4 * i + 1], k[4 * i + 2], k[4 * i + 3]);
  }
  __syncthreads();
}

__device__ __forceinline__ void phase_peer_experts(const P& p, int l, bool do_store, char* smem) {
  const int tid_ = opaque_tid(); const int lane = tid_ & 63, wid = tid_ >> 6;
  const int ntok = (l == 1) ? NLAT : NTOK;
  int ci, cj;
  {
    const int e = lane;
    if (e < 16) { ci = 0; cj = e; }
    else if (e < 24) { ci = 1; cj = e - 16; }
    else if (e < 29) { ci = 2; cj = e - 24; }
    else if (e < 33) { ci = 3; cj = e - 29; }
    else if (e < 36) { ci = 4; cj = e - 33; }
    else if (e < 38) { ci = 5; cj = e - 36; }
    else if (e < 40) { ci = 6; cj = e - 38; }
    else if (e < 42) { ci = 7; cj = e - 40; }
    else { ci = min(8 + (e - 42), 15); cj = 0; }
  }
  for (int tok = blockIdx.x * 8 + wid; tok < ntok; tok += gridDim.x * 8) {
    float xr[16];
    {
      const uint4 a = *(const uint4*)(p.xn + (size_t)tok * 1024 + lane * 16);
      const uint4 b = *(const uint4*)(p.xn + (size_t)tok * 1024 + lane * 16 + 8);
      xr[0] = bflo(a.x); xr[1] = bfhi(a.x); xr[2] = bflo(a.y); xr[3] = bfhi(a.y);
      xr[4] = bflo(a.z); xr[5] = bfhi(a.z); xr[6] = bflo(a.w); xr[7] = bfhi(a.w);
      xr[8] = bflo(b.x); xr[9] = bfhi(b.x); xr[10] = bflo(b.y); xr[11] = bfhi(b.y);
      xr[12] = bflo(b.z); xr[13] = bfhi(b.z); xr[14] = bflo(b.w); xr[15] = bfhi(b.w);
    }
    typedef _Float16 h2_t __attribute__((ext_vector_type(2)));
    h2_t yh[8];
#pragma unroll
    for (int i = 0; i < 8; ++i) yh[i] = (h2_t){(_Float16)0, (_Float16)0};
    int* selw = (int*)(smem + wid * 4096);
    const unsigned* kvp = p.topk + (size_t)tok * 256 + (lane & 31);
#pragma unroll 1
    for (int hb = 0; hb < 8; hb += 4) {
      unsigned key[4]; int eidx[4];
#pragma unroll
      for (int u = 0; u < 4; ++u) {
        const unsigned kv = kvp[(hb + u) * 32];
        const unsigned k0 = shu(kv, ci);
        const unsigned k1 = shu(kv, 16 + cj);
        const float val = (lane < 50) ? (sort2f(k0) + sort2f(k1)) : -3.0e38f;
        eidx[u] = (int)((k0 & 127u) * 128u + (k1 & 127u));
        key[u] = (f2sort(val) & ~63u) | (unsigned)lane;
      }
#pragma unroll
      for (int k = 2; k <= 64; k <<= 1) {
#pragma unroll
        for (int j = k >> 1; j >= 1; j >>= 1) {
          const bool take_max = (((lane & j) == 0) == ((lane & k) == 0));
#pragma unroll
          for (int u = 0; u < 4; ++u) {
            unsigned ok;
            if (j == 1) ok = xorl<1>(key[u], lane); else if (j == 2) ok = xorl<2>(key[u], lane); else if (j == 4) ok = xorl<4>(key[u], lane);
            else if (j == 8) ok = xorl<8>(key[u], lane); else if (j == 16) ok = xorl<16>(key[u], lane); else ok = xorl<32>(key[u], lane);
            key[u] = take_max ? max(key[u], ok) : min(key[u], ok);
          }
        }
      }
#pragma unroll
      for (int u = 0; u < 4; ++u) {
        const int si = __builtin_amdgcn_ds_bpermute((int)(key[u] & 63u) << 2, eidx[u]);
        const unsigned ku = key[u] & ~63u;
        const float sv = __uint_as_float((ku & 0x80000000u) ? (ku ^ 0x80000000u) : ~ku);
        const float mx = __builtin_bit_cast(float, __builtin_amdgcn_readlane(__builtin_bit_cast(int, sv), 0));
        const float ex = (lane < 16) ? __builtin_amdgcn_exp2f((sv - mx) * 1.4426950408889634f) : 0.f;
        const float sm = wave_sum(ex);
        selw[(hb + u) * 64 + lane] = si;
        selw[512 + (hb + u) * 64 + lane] = __builtin_bit_cast(int, ex * __builtin_amdgcn_rcpf(sm));
      }
    }
    {
      int w[4];
#pragma unroll
      for (int i = 0; i < 4; ++i) {
        int t = __builtin_amdgcn_cvt_pk_fp8_f32(xr[4 * i], xr[4 * i + 1], 0, false);
        w[i] = __builtin_amdgcn_cvt_pk_fp8_f32(xr[4 * i + 2], xr[4 * i + 3], t, true);
      }
      *(uint4*)(smem + 32768 + wid * 1024 + lane * 16) = make_uint4((unsigned)w[0], (unsigned)w[1], (unsigned)w[2], (unsigned)w[3]);
    }
    asm volatile("s_waitcnt lgkmcnt(0)" ::: "memory");
    const int e15 = lane & 15, g4 = lane >> 4;
#pragma unroll 1
    for (int h = 0; h < 8; ++h) {
      const int eperm_h = selw[h * 64 + lane];
      const int gperm_h = selw[512 + h * 64 + lane];
      const int ide = (int)shu((unsigned)eperm_h, e15);
      const unsigned char* ub = p.Ub + (size_t)ide * 1024 + g4 * 16;
      uint4 ua[8];
#pragma unroll
      for (int sI = 0; sI < 8; ++sI) ua[sI] = *(const uint4*)(ub + sI * 64);
      pg8::f32x4 hacc = {0.f, 0.f, 0.f, 0.f};
#pragma unroll
      for (int sI = 0; sI < 8; ++sI) {
        const uint4 b0 = *(const uint4*)(smem + 32768 + wid * 1024 + sI * 128 + g4 * 16);
        const uint4 b1 = *(const uint4*)(smem + 32768 + wid * 1024 + sI * 128 + 64 + g4 * 16);
        const i32x8 A = {(int)ua[sI].x, (int)ua[sI].y, (int)ua[sI].z, (int)ua[sI].w, 0, 0, 0, 0};
        const i32x8 B = {(int)b0.x, (int)b0.y, (int)b0.z, (int)b0.w, (int)b1.x, (int)b1.y, (int)b1.z, (int)b1.w};
        hacc = __builtin_amdgcn_mfma_scale_f32_16x16x128_f8f6f4(A, B, hacc, 4  , 0  , 0, 0x7f7f7f7f, 0, 0x7f7f7f7f);
      }
      asm volatile("" ::: "memory");
      uint2 V[16];
#pragma unroll
      for (int k = 0; k < 16; ++k) {
        const int id = __builtin_amdgcn_readlane(eperm_h, k);
        V[k] = *(const uint2*)(p.Ub + (size_t)id * 1024 + 512 + lane * 8);
      }
      float actv[4];
#pragma unroll
      for (int r4 = 0; r4 < 4; ++r4) {
        const float gl = __builtin_bit_cast(float, shu((unsigned)gperm_h, 4 * g4 + r4));
        actv[r4] = gelu_tanh(hacc[r4] * (1.0f / 64.0f)) * gl;
      }
#pragma unroll
      for (int k = 0; k < 16; ++k) {
        const float ak = __builtin_bit_cast(float, __builtin_amdgcn_readlane(__builtin_bit_cast(int, actv[k & 3]), 16 * (k >> 2)));
        const h2_t akh = {(_Float16)ak, (_Float16)ak};
        const unsigned vw[2] = {V[k].x, V[k].y};
#pragma unroll
        for (int q2 = 0; q2 < 2; ++q2) {
          yh[4 * q2 + 0] = __builtin_elementwise_fma(akh, __builtin_bit_cast(h2_t, __builtin_amdgcn_cvt_scalef32_pk_f16_fp4(vw[q2], 1.0f, 0)), yh[4 * q2 + 0]);
          yh[4 * q2 + 1] = __builtin_elementwise_fma(akh, __builtin_bit_cast(h2_t, __builtin_amdgcn_cvt_scalef32_pk_f16_fp4(vw[q2], 1.0f, 1)), yh[4 * q2 + 1]);
          yh[4 * q2 + 2] = __builtin_elementwise_fma(akh, __builtin_bit_cast(h2_t, __builtin_amdgcn_cvt_scalef32_pk_f16_fp4(vw[q2], 1.0f, 2)), yh[4 * q2 + 2]);
          yh[4 * q2 + 3] = __builtin_elementwise_fma(akh, __builtin_bit_cast(h2_t, __builtin_amdgcn_cvt_scalef32_pk_f16_fp4(vw[q2], 1.0f, 3)), yh[4 * q2 + 3]);
        }
      }
    }
    float yacc[16];
#pragma unroll
    for (int i = 0; i < 8; ++i) { yacc[2 * i] = (float)yh[i].x; yacc[2 * i + 1] = (float)yh[i].y; }
    const int bi = tok < NLAT ? (tok >> 12) : 8;
    const float* gv = p.mod + ((size_t)(l * 9 + bi) * 6 + 5) * 1024 + lane * 16;
    float* xp = (tok < NLAT) ? (p.out + (size_t)tok * 1024) : (p.ctxs + (size_t)(tok - NLAT) * 1024);
    xp += lane * 16;
    float4 xv[4];
    float ss = 0.f;
#pragma unroll
    for (int i = 0; i < 4; ++i) {
      xv[i] = *(float4*)(xp + 4 * i);
      const float4 g4 = *(const float4*)(gv + 4 * i);
      xv[i].x += g4.x * yacc[4 * i] * 0.25f; xv[i].y += g4.y * yacc[4 * i + 1] * 0.25f; xv[i].z += g4.z * yacc[4 * i + 2] * 0.25f; xv[i].w += g4.w * yacc[4 * i + 3] * 0.25f;
      ss += xv[i].x * xv[i].x + xv[i].y * xv[i].y + xv[i].z * xv[i].z + xv[i].w * xv[i].w;
    }
    ss = wave_sum(ss);
    const float rstd = rsqrtf(ss * (1.0f / 1024.0f) + 1e-6f);
    if (l == 0) {
      const float* gam = p.norm_mix_g + 1024 + lane * 16;
      const float* msh = p.mod + ((size_t)(9 + bi) * 6 + 0) * 1024 + lane * 16;
      const float* msc = msh + 1024;
      float yv[16];
      float amax = 0.f;
#pragma unroll
      for (int i = 0; i < 4; ++i) {
        if (do_store) *(float4*)(xp + 4 * i) = xv[i];
        const float4 g = *(const float4*)(gam + 4 * i);
        const float4 sh = *(const float4*)(msh + 4 * i);
        const float4 sc = *(const float4*)(msc + 4 * i);
        yv[4 * i] = xv[i].x * rstd * g.x * (1.f + sc.x) + sh.x; yv[4 * i + 1] = xv[i].y * rstd * g.y * (1.f + sc.y) + sh.y;
        yv[4 * i + 2] = xv[i].z * rstd * g.z * (1.f + sc.z) + sh.z; yv[4 * i + 3] = xv[i].w * rstd * g.w * (1.f + sc.w) + sh.w;
      }
#pragma unroll
      for (int i = 0; i < 16; ++i) amax = fmaxf(amax, fabsf(yv[i]));
      amax = fmaxf(wave_max(amax), 1e-20f);
      const float inv = 127.0f / amax;
      unsigned w[4];
#pragma unroll
      for (int i = 0; i < 4; ++i)
        w[i] = ((unsigned)__float2int_rn(yv[4 * i] * inv) & 255u) | (((unsigned)__float2int_rn(yv[4 * i + 1] * inv) & 255u) << 8) |
               (((unsigned)__float2int_rn(yv[4 * i + 2] * inv) & 255u) << 16) | (((unsigned)__float2int_rn(yv[4 * i + 3] * inv) & 255u) << 24);
      if (do_store) {
        *(uint4*)(p.xn8 + (size_t)tok * 1024 + lane * 16) = make_uint4(w[0], w[1], w[2], w[3]);
        if (lane == 0) p.sa[tok] = amax * (1.0f / 127.0f);
      }
    } else {
      const float* fg = p.final_g + lane * 16;
#pragma unroll
      for (int i = 0; i < 4; ++i) {
        const float4 g = *(const float4*)(fg + 4 * i);
        const float4 o = make_float4(xv[i].x * rstd * g.x, xv[i].y * rstd * g.y, xv[i].z * rstd * g.z, xv[i].w * rstd * g.w);
        if (do_store) *(float4*)(xp + 4 * i) = o;
      }
    }
  }
}


#define XB_TMO      128
#define XB_XCNT(j)  (256  + 64 * (j))
#define XB_XSUB(j)  (1280 + 64 * (j))
#define XB_XGEN(j)  (2304 + 64 * (j))
#define XB_TOP      3328
#define XB_TOPGEN   3392
#define XCD_BAR_WORDS 3456
#define XB_SPIN_CAP (1u << 22)
#define LAS __attribute__((address_space(3)))
__device__ __forceinline__ unsigned xb_ld(unsigned* p) { return __hip_atomic_load(p, __ATOMIC_RELAXED, __HIP_MEMORY_SCOPE_AGENT); }
__device__ __forceinline__ unsigned xb_add(unsigned* p, unsigned v) { return __hip_atomic_fetch_add(p, v, __ATOMIC_RELAXED, __HIP_MEMORY_SCOPE_AGENT); }
__device__ __forceinline__ unsigned xb_xcc_id() { return (unsigned)__builtin_amdgcn_s_getreg((3 << 11) | 20) & 0xFu; }
#define XB_SPIN(cond, bar) do { unsigned _sp = 0; while (cond) { __builtin_amdgcn_s_sleep(1); \
    if ((++_sp & 255u) == 0u) { if (xb_ld(&(bar)[XB_TMO])) break; if (_sp > XB_SPIN_CAP) { atomicAdd(&(bar)[XB_TMO], 1u); break; } } } } while (0)
struct XcdBarrier { unsigned* bar; unsigned x; volatile LAS unsigned* st; };
__device__ __forceinline__ XcdBarrier xcd_barrier_post(unsigned* bar, volatile LAS unsigned* st) {
  XcdBarrier b; b.bar = bar; b.x = xb_xcc_id(); b.st = st;
  if (threadIdx.x == 0) (void)xb_add(&bar[XB_XCNT(b.x)], 1u);
  return b;
}
__device__ __forceinline__ void xcd_barrier_complete(unsigned* bar, unsigned x, unsigned& nloc, unsigned& nx) {
  const unsigned G = gridDim.x * gridDim.y * gridDim.z;
  unsigned sum, cnt, mine, sp = 0u;
  for (;;) {
    sum = 0u; cnt = 0u; mine = 0u;
#pragma unroll
    for (unsigned j = 0; j < 16; ++j) { const unsigned c = xb_ld(&bar[XB_XCNT(j)]); sum += c; cnt += (c > 0u) ? 1u : 0u; mine = (j == x) ? c : mine; }
    if (sum == G) break;
    __builtin_amdgcn_s_sleep(1);
    if ((++sp & 255u) == 0u) { if (xb_ld(&bar[XB_TMO])) break; if (sp > XB_SPIN_CAP) { atomicAdd(&bar[XB_TMO], 1u); break; } }
  }
  nloc = mine > 0u ? mine : 1u; nx = cnt > 0u ? cnt : 1u;
}
__device__ __forceinline__ void xcd_barrier(unsigned* bar_u, volatile LAS unsigned* st_u) {
  XcdBarrier b; b.bar = bar_u; b.x = xb_xcc_id(); b.st = st_u;
  asm volatile("s_waitcnt vmcnt(0)" ::: "memory");
  __syncthreads();
  if (threadIdx.x == 0) {
    unsigned long long bp_ = (unsigned long long)b.bar;
    asm volatile("" : "+v"(bp_));
    unsigned* bar = (unsigned*)bp_;
    __builtin_amdgcn_s_waitcnt(0);
    unsigned nloc = b.st[0], nx = b.st[1];
    if (nloc == 0u) { xcd_barrier_complete(bar, b.x, nloc, nx); b.st[0] = nloc; b.st[1] = nx; }
    const unsigned old = xb_add(&bar[XB_XSUB(b.x)], 1u);
    const unsigned gen = old / nloc;
    if (old + 1u == (gen + 1u) * nloc) {
      __builtin_amdgcn_fence(__ATOMIC_RELEASE, "agent");
      asm volatile("s_waitcnt vmcnt(0)" ::: "memory");
      const unsigned og = xb_add(&bar[XB_TOP], 1u);
      const unsigned tg = og / nx;
      if (og + 1u == (tg + 1u) * nx) xb_add(&bar[XB_TOPGEN], 1u);
      else XB_SPIN(xb_ld(&bar[XB_TOPGEN]) == tg, bar);
      __builtin_amdgcn_fence(__ATOMIC_ACQUIRE, "agent");
      xb_add(&bar[XB_XGEN(b.x)], 1u);
      asm volatile("s_waitcnt vmcnt(0)" ::: "memory");
    } else {
      XB_SPIN(xb_ld(&bar[XB_XGEN(b.x)]) == gen, bar);
      __builtin_amdgcn_fence(__ATOMIC_ACQUIRE, "agent");
      asm volatile("s_waitcnt vmcnt(0)" ::: "memory");
    }
  }
  __syncthreads();
}

template <int l>
__device__ __forceinline__ void layer_body(const P& p, char* smem, pg8::PG8_LAS_T lds, volatile LAS unsigned* xbw, const int nb, const int bid) {
    const bool last = (l == 1);
    const int n_mt = last ? 128 : 136;
    if (l == 0) {
      phase_norm(p, l, 0);
      xcd_barrier(p.counters + 1024, xbw);
    }
_Pragma("unroll 1")
    for (int rep = 0; rep < REP_INPROJ; ++rep) {
      pg8::Gemm g; pg8::Order S;
      g.A = (const u16*)p.xn8; g.Bt = (const u16*)(p.Win8 + (size_t)l * 2816 * 1024); g.lda = 512; g.ldb = 512; g.K = 512;
      S.init(136, 6, nb, bid, 4, 5);
      pg8::EpiInprojN8 e1; e1.qk = p.qk; e1.rg = p.rg; e1.sa = p.sa; e1.sw = p.sw + l * 5888;
      pg8::gemm_phase(lds, g, S, e1);
      g.A = (const u16*)(p.Win8 + ((size_t)l * 2816 + 1024) * 1024); g.Bt = (const u16*)p.xn8;
      S.init(5, 136, nb, bid);
      pg8::EpiInprojT8 e2; e2.vT = p.vT; e2.sa = p.sa; e2.sw = p.sw + l * 5888 + 1024;
      pg8::gemm_phase(lds, g, S, e2);
    }
    xcd_barrier(p.counters + 1024, xbw);
    phase_mixers(p, l, smem, p.counters + l * 4);
    xcd_barrier(p.counters + 1024, xbw);
_Pragma("unroll 1")
    for (int rep = 0; rep < REP_2B; ++rep)
      for (int task = bid; task < 1088 + 512; task += nb) {
        if (task < 1088) rg_wave_task(p, l, task >> 2, task & 3, 1, last, smem);
        else yb_transpose_task(p, (task - 1088) >> 6, (task - 1088) & 63, smem);
      }
    xcd_barrier(p.counters + 1024, xbw);
_Pragma("unroll 1")
    for (int rep = 0; rep < REP_GATE; ++rep) {
      pg8::Gemm g; pg8::Order S;
      g.A = (const u16*)p.xn8; g.Bt = (const u16*)(p.Wg8 + (size_t)l * 3072 * 1024); g.lda = 512; g.ldb = 512; g.K = 512;
      S.init(n_mt, 12, nb, bid);
      pg8::EpiGate8 e; e.g8 = p.g8; e.bias = p.b_gate + l * 3072; e.sa = p.sa; e.sw = p.sw + l * 5888 + 2816;
      pg8::gemm_phase(lds, g, S, e);
    }
    xcd_barrier(p.counters + 1024, xbw);
_Pragma("unroll 1")
    for (int rep = 0; rep < REP_BRANCH; ++rep) {
      pg8::Gemm g; pg8::Order S;
      S.init(n_mt, 4, nb, bid);
      pg8::EpiBranch e; e.mbuf = p.mbuf; e.g8 = p.g8;
      g.lda = 1024;
      g.A = p.ycat; g.Bt = p.WaT + (size_t)l * 1024 * 512; g.ldb = 512; g.K = 512; e.br = 0;
      pg8::gemm_phase(lds, g, S, e);
      g.A = p.ycat + 512; g.Bt = p.WbT + (size_t)l * 1024 * 256; g.ldb = 256; g.K = 256; e.br = 1;
      pg8::gemm_phase(lds, g, S, e);
      g.A = p.ycat + 768; g.Bt = p.WcT + (size_t)l * 1024 * 256; g.ldb = 256; g.K = 256; e.br = 2;
      pg8::gemm_phase(lds, g, S, e);
    }
    xcd_barrier(p.counters + 1024, xbw);
    {
      pg8::Gemm g; pg8::Order S;
      g.A = p.mbuf; g.Bt = p.WoT + (size_t)l * 1024 * 1024; g.lda = 1024; g.ldb = 1024; g.K = 1024;
      S.init(n_mt, 4, nb, bid);
      pg8::EpiOut e; e.xsrc = (l == 0 ? p.x : p.out); e.csrc = (l == 0 ? p.ctx : p.ctxs); e.xdst = p.out; e.cdst = p.ctxs;
      e.modl = p.mod + (size_t)l * 9 * 6144;
      pg8::gemm_phase(lds, g, S, e);
      for (int t = bid; t < 8192; t += nb) {
        if (t < 4096) cvt_chunk_fp4(p.peer_u + (size_t)l * 16384 * 1024, p.Ub, (size_t)t, 64.0f, 0);
        else cvt_chunk_fp4(p.peer_v + (size_t)l * 16384 * 1024, p.Ub, (size_t)(t - 4096), 4.0f, 1);
      }
    }
    xcd_barrier(p.counters + 1024, xbw);
    phase_norm(p, l, 1);
    xcd_barrier(p.counters + 1024, xbw);
_Pragma("unroll 1")
    for (int rep = 0; rep < REP_Q; ++rep) {
      pg8::Gemm g; pg8::Order S;
      g.A = p.xn; g.Bt = p.WqkT + (size_t)l * 2048 * 1024; g.lda = 1024; g.ldb = 1024; g.K = 1024;
      S.init(n_mt, 8, nb, bid);
      pg8::EpiQ e; e.q = p.q;
      pg8::gemm_phase(lds, g, S, e);
    }
    xcd_barrier(p.counters + 1024, xbw);
_Pragma("unroll 1")
    for (int rep = 0; rep < REP_SCORE; ++rep)
      for (int task = bid; task < n_mt * 16; task += nb) peer_score_tile(p, l, task >> 4, task & 15, smem);
    xcd_barrier(p.counters + 1024, xbw);
_Pragma("unroll 1")
    for (int rep = 0; rep < REP_PEER; ++rep) phase_peer_experts(p, l, rep == REP_PEER - 1, smem);
    xcd_barrier(p.counters + 1024, xbw);
  }

__global__ void __launch_bounds__(NTHR) fwd_megakernel(P p) {
  __shared__ __attribute__((aligned(16))) char smem[SMEM_BYTES];
  cg::grid_group grid = cg::this_grid();
  const int nb = gridDim.x, bid = blockIdx.x;
  pg8::PG8_LAS_T lds = (pg8::PG8_LAS_T)smem;
  volatile LAS unsigned* xbw = (volatile LAS unsigned*)(smem + SMEM_BYTES - 32);
  if (threadIdx.x == 0) { xbw[0] = 0u; xbw[1] = 0u; xbw[2] = 0u; xbw[3] = 0u; }
  __syncthreads();
  (void)xcd_barrier_post(p.counters + 1024, xbw);

  phase_prep(p, smem, p.counters + 32);
  grid.sync();
  phase_modreduce(p);
  for (int task = blockIdx.x; task < 512; task += gridDim.x) kf_task(p, task >> 8, task & 255, smem);
  for (int task = blockIdx.x; task < 256; task += gridDim.x) wqk_task(p, task >> 7, (task >> 3) & 15, task & 7, smem);
  for (int task = blockIdx.x; task < 2 * 368; task += gridDim.x) {
    const int l = task / 368, t = task - l * 368;
    if (t < 176) tr_tile4<true>(p.w_in + (size_t)l * 1024 * 2816, 2816, 1024, p.Win8 + (size_t)l * 2816 * 1024, t, p.sw + l * 5888, smem);
    else tr_tile4<true>(p.w_gate + (size_t)l * 1024 * 3072, 3072, 1024, p.Wg8 + (size_t)l * 3072 * 1024, t - 176, p.sw + l * 5888 + 2816, smem);
  }
  xcd_barrier(p.counters + 1024, xbw);

  layer_body<0>(p, smem, lds, xbw, nb, bid);
  layer_body<1>(p, smem, lds, xbw, nb, bid);
}

extern "C" void kernel_launch(void* const* d_in, const int* in_sizes, int n_in, void* d_out, int out_size, void* d_ws,
                              size_t ws_size, hipStream_t stream) {
  P p;
  memset(&p, 0, sizeof(p));
  const float** ins = (const float**)&p;
  for (int i = 0; i < 37; ++i) ins[i] = (const float*)d_in[i];
  p.out = (float*)d_out;
  char* w = (char*)d_ws;
  size_t off = 0;
  auto take = [&](size_t bytes) { char* r = w + off; off += (bytes + 255) & ~(size_t)255; return r; };
  p.counters = (unsigned*)take(32768);
  p.WinT = nullptr; p.WgT = nullptr;
  p.Win8 = (unsigned char*)take((size_t)2 * 2816 * 1024);
  p.Wg8 = (unsigned char*)take((size_t)2 * 3072 * 1024);
  p.sw = (float*)take((size_t)2 * 5888 * 4);
  p.xn8 = (unsigned char*)take((size_t)NTOK * 1024);
  p.sa = (float*)take((size_t)NTOK * 4);
  p.WaT = (u16*)take((size_t)2 * 1024 * 512 * 2);
  p.WbT = (u16*)take((size_t)2 * 1024 * 256 * 2);
  p.WcT = (u16*)take((size_t)2 * 1024 * 256 * 2);
  p.WoT = (u16*)take((size_t)2 * 1024 * 1024 * 2);
  p.WqB = (u16*)take((size_t)2 * 1024 * 2048 * 2);
  p.WqkT = (u16*)take((size_t)2 * 2048 * 1024 * 2);
  p.keysB = (u16*)take((size_t)2 * 16 * 16384 * 2);
  p.rgW = (u16*)take((size_t)2 * 16 * 4096 * 2);
  p.modpart = (float*)take((size_t)16 * 2 * 9 * 6144 * 4);
  p.mod = (float*)take((size_t)2 * 9 * 6144 * 4);
  p.hT = (float*)take((size_t)2 * 512 * 4096 * 4);
  p.hc = (float*)take((size_t)512 * 256 * 4);
  p.Kf = (float*)take((size_t)2 * 256 * 8192 * 8);
  p.xn = (u16*)take((size_t)NTOK * 1024 * 2);
  p.qk = (u16*)take((size_t)NTOK * 1024 * 2);
  p.mbuf = p.qk;
  p.vT = (u16*)take((size_t)8 * 512 * 4096 * 2);
  p.vTc = (u16*)take((size_t)8 * 512 * 256 * 2);
  p.hyT = (u16*)take((size_t)8 * 768 * 4096 * 2);
  p.hyTc = (u16*)take((size_t)8 * 768 * 256 * 2);
  p.rg = (u16*)take((size_t)NTOK * 512 * 2);
  p.ycat = (u16*)take((size_t)NTOK * 1024 * 2);
  p.Ub = (unsigned char*)p.ycat;
  p.Vb = p.Ub + (size_t)16384 * 512;
  p.agg = (float*)take((size_t)8 * 2 * (136 + 34) * 256 * 8);
  p.ybT = (u16*)take((size_t)8 * 256 * 4096 * 2);
  p.ctxs = (float*)take((size_t)2048 * 1024 * 4);
  p.g8 = (unsigned char*)p.vT;
  p.q = p.qk;
  p.topk = (unsigned*)((char*)p.qk + (size_t)NTOK * 2048 * 2);
  if (off > ws_size) {
    fprintf(stderr, "workspace too small: need %zu have %zu\n", off, ws_size);
    return;
  }
  static int grid_blocks = 0;
  if (!grid_blocks) {
    int dev = 0, cus = 0, per_cu = 0;
    (void)hipGetDevice(&dev);
    (void)hipDeviceGetAttribute(&cus, hipDeviceAttributeMultiprocessorCount, dev);
    (void)hipOccupancyMaxActiveBlocksPerMultiprocessor(&per_cu, fwd_megakernel, NTHR, 0);
    if (per_cu > 1) per_cu = 1;
    grid_blocks = cus * per_cu;
  }
  (void)hipMemsetAsync(p.counters, 0, 32768, stream);
  void* args[] = {&p};
  hipError_t e = hipLaunchCooperativeKernel((void*)fwd_megakernel, dim3(grid_blocks), dim3(NTHR), args, 0, stream);
  if (e != hipSuccess) fprintf(stderr, "cooperative launch failed: %s (grid %d)\n", hipGetErrorString(e), grid_blocks);
}
```

```cpp
#include <hip/hip_runtime.h>
#include <hip/hip_cooperative_groups.h>
#include <cstdio>
#include <cstring>
namespace cg = cooperative_groups;

typedef unsigned short u16;
typedef __attribute__((ext_vector_type(8))) short bf16x8;
typedef __attribute__((ext_vector_type(16))) float f32x16;
typedef __attribute__((ext_vector_type(2))) float f32x2;
typedef int i32x8 __attribute__((ext_vector_type(8)));

#define NLAT 32768
#define NTOK 34816
#define SMEM_BYTES 151552
#define NTHR 512
#ifndef DUP_1A
#define DUP_1A 1
#endif
#ifndef DUP_PREP
#define DUP_PREP 1
#endif
#ifndef DUP_2B
#define DUP_2B 1
#endif
#ifndef XRGA
#define XRGA 1
#endif
#ifndef REP_PEER
#define REP_PEER 1
#endif
#ifndef REP_INPROJ
#define REP_INPROJ 1
#endif
#ifndef REP_GATE
#define REP_GATE 1
#endif
#ifndef REP_BRANCH
#define REP_BRANCH 1
#endif
#ifndef REP_Q
#define REP_Q 1
#endif
#ifndef REP_SCORE
#define REP_SCORE 1
#endif
#ifndef REP_1A
#define REP_1A 1
#endif
#ifndef REP_2B
#define REP_2B 1
#endif
#ifndef REP_KF
#define REP_KF 1
#endif
#ifndef DUP_GEMM
#define DUP_GEMM 1
#endif
#ifndef DUP_PEER
#define DUP_PEER 1
#endif
#ifndef DUP_MIX
#define DUP_MIX 1
#endif
#ifndef XRG
#define XRG 1
#endif
#ifndef XFFT
#define XFFT 1
#endif
#ifndef XATT
#define XATT 1
#endif

struct P {
  const float *x, *c, *ctx, *c_ctx, *norm_mix_g, *norm_ffn_g, *w_ada, *b_ada, *w_in, *na_rpb,
      *hy_short_w, *hy_short_b, *hy_f1_w, *hy_f1_b, *hy_f2_w, *hy_f2_b, *hy_f3_w, *hy_freq, *hy_bias,
      *rg_conv_w, *rg_conv_b, *rg_wa, *rg_ba, *rg_wx, *rg_bx, *rg_lambda,
      *w_gate, *b_gate, *w_br_a, *w_br_b, *w_br_c, *w_out, *peer_wq, *peer_keys, *peer_u, *peer_v, *final_g;
  float* out;
  unsigned* counters;
  u16 *WinT, *WgT, *WaT, *WbT, *WcT, *WoT, *WqB, *WqkT, *keysB, *rgW;
  float *modpart, *mod, *hT, *hc;
  float* Kf;
  u16 *xn, *qk, *vT, *vTc, *hyT, *hyTc, *rg, *ycat, *mbuf, *ybT;
  unsigned char *Ub, *Vb, *g8, *xn8, *Win8, *Wg8;
  float *sa, *sw;
  u16* q;
  float *agg, *ctxs;
  unsigned* topk;
};

__device__ __forceinline__ u16 f2bf(float f) {
  unsigned u = __float_as_uint(f);
  u += 0x7fffu + ((u >> 16) & 1u);
  return (u16)(u >> 16);
}
__device__ __forceinline__ float bf2f(u16 h) { return __uint_as_float(((unsigned)h) << 16); }
__device__ __forceinline__ unsigned pk2(float a, float b) { return (unsigned)f2bf(a) | ((unsigned)f2bf(b) << 16); }
__device__ __forceinline__ float bflo(unsigned u) { return __uint_as_float(u << 16); }
__device__ __forceinline__ float bfhi(unsigned u) { return __uint_as_float(u & 0xffff0000u); }
__device__ __forceinline__ int opaque_tid() {
  int t = threadIdx.x;
  asm volatile("" : "+v"(t));
  return t;
}
__device__ __forceinline__ int my_lane() { return opaque_tid() & 63; }
__device__ __forceinline__ float shx(float v, int o);
__device__ __forceinline__ float shf(float v, int src) { return __builtin_bit_cast(float, __builtin_amdgcn_ds_bpermute((src & 63) << 2, __builtin_bit_cast(int, v))); }
__device__ __forceinline__ unsigned shu(unsigned v, int src) { return (unsigned)__builtin_amdgcn_ds_bpermute((src & 63) << 2, (int)v); }
typedef unsigned u32x2_t __attribute__((ext_vector_type(2)));
template <int J> __device__ __forceinline__ unsigned xorl(unsigned v, int lane) {
  if constexpr (J == 1) return (unsigned)__builtin_amdgcn_mov_dpp((int)v, 0xB1, 0xF, 0xF, true);
  else if constexpr (J == 2) return (unsigned)__builtin_amdgcn_mov_dpp((int)v, 0x4E, 0xF, 0xF, true);
  else if constexpr (J == 4) {
    const unsigned a = (unsigned)__builtin_amdgcn_mov_dpp((int)v, 0x104, 0xF, 0xF, true);
    const unsigned b = (unsigned)__builtin_amdgcn_mov_dpp((int)v, 0x114, 0xF, 0xF, true);
    return (lane & 4) ? b : a;
  }
  else if constexpr (J == 8) return (unsigned)__builtin_amdgcn_mov_dpp((int)v, 0x128, 0xF, 0xF, true);
  else if constexpr (J == 16) { const u32x2_t r = __builtin_amdgcn_permlane16_swap(v, v, false, false); return (lane & 16) ? r.x : r.y; }
  else { const u32x2_t r = __builtin_amdgcn_permlane32_swap(v, v, false, false); return (lane & 32) ? r.x : r.y; }
}
template <int J> __device__ __forceinline__ float xorf(float v, int lane) { return __uint_as_float(xorl<J>(__float_as_uint(v), lane)); }
__device__ __forceinline__ float shx(float v, int o) {
  const int lane = my_lane();
  switch (o) {
    case 1: return xorf<1>(v, lane);
    case 2: return xorf<2>(v, lane);
    case 4: return xorf<4>(v, lane);
    case 8: return xorf<8>(v, lane);
    case 16: return xorf<16>(v, lane);
    case 32: return xorf<32>(v, lane);
    default: return __builtin_bit_cast(float, __builtin_amdgcn_ds_bpermute(((lane ^ o) << 2), __builtin_bit_cast(int, v)));
  }
}
__device__ __forceinline__ float wave_sum(float v) {
  const int lane = my_lane();
  v += xorf<32>(v, lane); v += xorf<16>(v, lane); v += xorf<8>(v, lane); v += xorf<4>(v, lane); v += xorf<2>(v, lane); v += xorf<1>(v, lane);
  return v;
}
__device__ __forceinline__ float wave_max(float v) {
  const int lane = my_lane();
  v = fmaxf(v, xorf<32>(v, lane)); v = fmaxf(v, xorf<16>(v, lane)); v = fmaxf(v, xorf<8>(v, lane));
  v = fmaxf(v, xorf<4>(v, lane)); v = fmaxf(v, xorf<2>(v, lane)); v = fmaxf(v, xorf<1>(v, lane));
  return v;
}
__device__ __forceinline__ float sigmoidf_(float x) { return __builtin_amdgcn_rcpf(1.0f + __expf(-x)); }
__device__ __forceinline__ float gelu_tanh(float x) {
  const float u2 = 1.5957691216057308f * (x + 0.044715f * x * x * x);
  return x * __builtin_amdgcn_rcpf(1.0f + __expf(-u2));
}
__device__ __forceinline__ f32x16 mfma32(bf16x8 a, bf16x8 b, f32x16 c) {
  return __builtin_amdgcn_mfma_f32_32x32x16_bf16(a, b, c, 0, 0, 0);
}
__device__ __forceinline__ f32x16 zero16() {
  f32x16 z;
#pragma unroll
  for (int i = 0; i < 16; ++i) z[i] = 0.f;
  return z;
}
__device__ __forceinline__ int swz128(int row, int ch) { return row * 128 + ((ch ^ ((row >> 1) & 7)) << 4); }
__device__ __forceinline__ int swz256(int row, int ch) { return row * 256 + ((ch ^ (row & 15)) << 4); }

struct c2 { float x, y; };
__device__ __forceinline__ c2 cadd(c2 a, c2 b) { return {a.x + b.x, a.y + b.y}; }
__device__ __forceinline__ c2 csub(c2 a, c2 b) { return {a.x - b.x, a.y - b.y}; }
__device__ __forceinline__ c2 cmul(c2 a, c2 b) { return {a.x * b.x - a.y * b.y, a.x * b.y + a.y * b.x}; }
__device__ __forceinline__ float c16(int i) {
  const float tb[16] = {1.0f, 0.9238795325112867f, 0.7071067811865476f, 0.3826834323650898f, 0.0f,
                        -0.3826834323650898f, -0.7071067811865476f, -0.9238795325112867f, -1.0f,
                        -0.9238795325112867f, -0.7071067811865476f, -0.3826834323650898f, 0.0f,
                        0.3826834323650898f, 0.7071067811865476f, 0.9238795325112867f};
  return tb[i & 15];
}
__device__ __forceinline__ float s16(int i) { return c16(i + 12); }
template <int R> __device__ __forceinline__ constexpr int brev(int k) {
  int r = 0;
  for (int b = 1, o = R >> 1; b < R; b <<= 1, o >>= 1)
    if (k & b) r |= o;
  return r;
}
template <int R> __device__ __forceinline__ void dft_reg(c2* v, float sgn) {
#pragma unroll
  for (int h = R / 2; h >= 1; h >>= 1) {
#pragma unroll
    for (int g = 0; g < R; g += 2 * h) {
#pragma unroll
      for (int j = 0; j < h; ++j) {
        c2 a = v[g + j], b = v[g + j + h];
        v[g + j] = cadd(a, b);
        c2 d = csub(a, b);
        const int ti = j * (16 / (2 * h));
        c2 w = {c16(ti), sgn * s16(ti)};
        v[g + j + h] = (j == 0) ? d : cmul(d, w);
      }
    }
  }
}
template <int R> __device__ __forceinline__ int fft_bfly(c2* v, int j, int Ns, float sgn) {
  const int k = j & (Ns - 1);
  const float f = sgn * (float)k / (float)(Ns * R);
#pragma unroll
  for (int r = 1; r < R; ++r) {
    float t = f * (float)r;
    c2 w = {__builtin_amdgcn_cosf(t), __builtin_amdgcn_sinf(t)};
    v[r] = cmul(v[r], w);
  }
  dft_reg<R>(v, sgn);
  return (j - k) * R + k;
}
template <int R> __device__ __forceinline__ void fft_pass(c2* buf, int Ns, float sgn) {
  constexpr int NBF = 8192 / R;
  constexpr int PER = NBF / NTHR;
  const int tid = opaque_tid();
  c2 v[PER][R];
#pragma unroll
  for (int i = 0; i < PER; ++i) {
    const int j = tid + NTHR * i;
#pragma unroll
    for (int r = 0; r < R; ++r) v[i][r] = buf[j + r * NBF];
  }
  __syncthreads();
#pragma unroll
  for (int i = 0; i < PER; ++i) {
    const int j = tid + NTHR * i;
    const int base = fft_bfly<R>(v[i], j, Ns, sgn);
#pragma unroll
    for (int r = 0; r < R; ++r) buf[base + r * Ns] = v[i][brev<R>(r)];
  }
  __syncthreads();
}
__device__ __forceinline__ void fft8192(c2* buf, float sgn) {
  fft_pass<8>(buf, 1, sgn);
  fft_pass<8>(buf, 8, sgn);
  fft_pass<8>(buf, 64, sgn);
  fft_pass<16>(buf, 512, sgn);
}

__device__ __forceinline__ void gemm_kloop(f32x16 (&acc)[2][2], const u16* __restrict__ A, int lda,
                                           const u16* __restrict__ B, int ldb, int K, char* smem) {
  const int tid = opaque_tid(), lane = tid & 63, wid = tid >> 6;
  const int wm = wid >> 1, wn = wid & 1;
  const int l31 = lane & 31, hh = lane >> 5;
  uint4 ra[4], rb[2];
  const int nk = K >> 6;
  const int srow = tid >> 3, sch = tid & 7;
  const char* Ab = (const char*)A;
  const char* Bb = (const char*)B;
  const unsigned aoff = (unsigned)(srow * lda + sch * 8) * 2u;
  const unsigned boff = (unsigned)(srow * ldb + sch * 8) * 2u;
  const unsigned astep = (unsigned)lda * 128u, bstep = (unsigned)ldb * 128u;
#pragma unroll
  for (int i = 0; i < 4; ++i) ra[i] = *(const uint4*)(Ab + (aoff + i * astep));
#pragma unroll
  for (int i = 0; i < 2; ++i) rb[i] = *(const uint4*)(Bb + (boff + i * bstep));
#pragma unroll
  for (int i = 0; i < 4; ++i) *(uint4*)(smem + swz128(srow + i * 64, sch)) = ra[i];
#pragma unroll
  for (int i = 0; i < 2; ++i) *(uint4*)(smem + 65536 + swz128(srow + i * 64, sch)) = rb[i];
  __syncthreads();
  for (int kt = 0; kt < nk; ++kt) {
    const bool more = (kt + 1 < nk);
    if (more) {
      const unsigned ko = (unsigned)(kt + 1) * 128u;
#pragma unroll
      for (int i = 0; i < 4; ++i) ra[i] = *(const uint4*)(Ab + (aoff + i * astep + ko));
#pragma unroll
      for (int i = 0; i < 2; ++i) rb[i] = *(const uint4*)(Bb + (boff + i * bstep + ko));
    }
    const char* as = smem + (kt & 1) * 32768;
    const char* bs = smem + 65536 + (kt & 1) * 16384;
    int lrow = l31;
    asm volatile("" : "+v"(lrow));
#pragma unroll
    for (int s = 0; s < 4; ++s) {
      bf16x8 af[2], bfr[2];
#pragma unroll
      for (int i = 0; i < 2; ++i) af[i] = *(const bf16x8*)(as + swz128(wm * 64 + i * 32 + lrow, s * 2 + hh));
#pragma unroll
      for (int j = 0; j < 2; ++j) bfr[j] = *(const bf16x8*)(bs + swz128(wn * 64 + j * 32 + lrow, s * 2 + hh));
#pragma unroll
      for (int i = 0; i < 2; ++i)
#pragma unroll
        for (int j = 0; j < 2; ++j) acc[i][j] = mfma32(af[i], bfr[j], acc[i][j]);
    }
    if (more) {
      char* an = smem + ((kt + 1) & 1) * 32768;
      char* bn = smem + 65536 + ((kt + 1) & 1) * 16384;
      int sr2 = srow;
      asm volatile("" : "+v"(sr2));
#pragma unroll
      for (int i = 0; i < 4; ++i) *(uint4*)(an + swz128(sr2 + i * 64, sch)) = ra[i];
#pragma unroll
      for (int i = 0; i < 2; ++i) *(uint4*)(bn + swz128(sr2 + i * 64, sch)) = rb[i];
    }
    __syncthreads();
  }
}
__device__ __forceinline__ void zero_acc(f32x16 (&acc)[2][2]) {
#pragma unroll
  for (int i = 0; i < 2; ++i)
#pragma unroll
    for (int j = 0; j < 2; ++j) acc[i][j] = zero16();
}
#define EPI_ROW(i, e) (wm * 64 + (i)*32 + ((e)&3) + 8 * ((e) >> 2) + 4 * hh)
#define EPI_COL(j) (wn * 64 + (j)*32 + l31)
#define EPI_VARS                                                    \
  const int tid = opaque_tid(), lane = tid & 63, wid = tid >> 6;     \
  const int wm = wid >> 1, wn = wid & 1, l31 = lane & 31, hh = lane >> 5; \
  (void)tid; (void)wm; (void)wn; (void)l31; (void)hh;


namespace pg8 {
__device__ __forceinline__ unsigned pkh(float a, float b) { unsigned r; asm("v_cvt_pk_bf16_f32 %0, %1, %2" : "=v"(r) : "v"(a), "v"(b)); return r; }
#define PG8_LAS __attribute__((address_space(3)))
typedef PG8_LAS unsigned char* PG8_LAS_T;
typedef float f32x4 __attribute__((ext_vector_type(4)));
typedef unsigned u32x4 __attribute__((ext_vector_type(4)));
typedef int i32x4 __attribute__((ext_vector_type(4)));
constexpr int BM = 256, BK = 64, HALF = 128, HTB = HALF * BK * 2, STAGE_BYTES = 8 * HTB, NXCD = 8, WGM = 8;
__device__ __forceinline__ int lds_byte(int r, int c) { const int st = (r >> 4) * 2 + (c >> 5), rr = r & 15, cc = c & 31, ob = rr * 64 + cc * 2; return st * 1024 + (ob ^ (((ob >> 9) & 1) << 5)); }
__device__ __forceinline__ void stage_rc(int b, int& R, int& C) { const int st = b / 1024, sb = b % 1024, swz = sb ^ (((sb >> 9) & 1) << 5); R = (st >> 1) * 16 + swz / 64; C = (st & 1) * 32 + (swz % 64) / 2; }
__device__ __forceinline__ int perm32(int rho) { const int n = rho >> 4, i = rho & 15; return 8 * (i >> 2) + 4 * n + (i & 3); }
struct Unit { int pm, pn; };
struct Gemm { const u16* A; const u16* Bt; int lda, ldb, K; };
struct Order {
  int nM, nN, nwg, G, c, skip_from, skip_by;
  __device__ __forceinline__ void init(int nM_, int nN_, int G_, int c_, int sf = 1 << 30, int sb = 0) { nM = nM_; nN = nN_; nwg = nM * nN; G = G_; c = c_; skip_from = sf; skip_by = sb; }
  __device__ __forceinline__ bool next(int i, Unit& u) const {
    const long L = (long)i * G + c; if (L >= nwg) return false;
    int wgid = (int)L; { const int q = nwg / NXCD, r = nwg % NXCD, xcd = wgid % NXCD, off = wgid / NXCD; wgid = (xcd < r ? xcd * (q + 1) : r * (q + 1) + (xcd - r) * q) + off; }
    const int nig = WGM * nN, gid = wgid / nig, fm = gid * WGM, gsz = (nM - fm) < WGM ? (nM - fm) : WGM;
    u.pm = fm + ((wgid % nig) % gsz); u.pn = (wgid % nig) / gsz;
    if (u.pn >= skip_from) u.pn += skip_by;
    return true;
  }
};
__device__ __forceinline__ f32x4 mma16(bf16x8 a, bf16x8 b, f32x4 c) { return __builtin_amdgcn_mfma_f32_16x16x32_bf16(a, b, c, 0, 0, 0); }
__device__ __forceinline__ i32x4 mma16(bf16x8 a, bf16x8 b, i32x4 c) { return __builtin_amdgcn_mfma_i32_16x16x64_i8(__builtin_bit_cast(i32x4, a), __builtin_bit_cast(i32x4, b), c, 0, 0, 0); }
template <class Epi>
__device__ __forceinline__ void gemm_phase(PG8_LAS unsigned char* lds, const Gemm g, const Order& S, const Epi& E) {
  const int tid = opaque_tid(), wid = __builtin_amdgcn_readfirstlane(tid >> 6), lane = tid & 63, wr = wid >> 2, wc = wid & 3, fr = lane & 15, fq = lane >> 4;
  const int K = g.K, nt = K / BK;
  unsigned voffA[2], voffB[2];
#pragma unroll
  for (int i = 0; i < 2; ++i) { int R, C; stage_rc(tid * 16 + i * 8192, R, C); const int Rb = Epi::PERM ? ((R & ~31) + perm32(R & 31)) : R;
    voffA[i] = (unsigned)(R * g.lda + C) * 2u; voffB[i] = (unsigned)(Rb * g.ldb + C) * 2u; }
  const size_t kstep = (size_t)(BK * 2);
  const size_t hstepA = (size_t)HALF * g.lda * 2, hstepB = (size_t)HALF * g.ldb * 2;
  const size_t tstepA = 2 * hstepA, tstepB = 2 * hstepB;
  const unsigned ldsw = (unsigned)wid * 1024u;
  const int aoff = lds_byte(wr * 64 + fr, fq * 8), boff = lds_byte(wc * 32 + fr, fq * 8);
#define PG8_SA(b, h) (((b) * 2 + (h)) * HTB)
#define PG8_SB(b, h) ((4 + (b) * 2 + (h)) * HTB)
#define PG8_STAGE(bufoff, gbase, voff) do { _Pragma("unroll") for (int _i = 0; _i < 2; ++_i) \
    __builtin_amdgcn_global_load_lds((const unsigned*)((const char*)(gbase) + (voff)[_i]), (PG8_LAS unsigned*)(lds + (bufoff) + ldsw + _i * 8192), 16, 0, 0); } while (0)
#define PG8_LDA(dst, b, h) do { _Pragma("unroll") for (int m = 0; m < 4; ++m) _Pragma("unroll") for (int k = 0; k < 2; ++k) dst[m][k] = *(const PG8_LAS bf16x8*)(lds + PG8_SA(b, h) + aoff + m * 2048 + k * 1024); } while (0)
#define PG8_LDB(dst, b, h) do { _Pragma("unroll") for (int n = 0; n < 2; ++n) _Pragma("unroll") for (int k = 0; k < 2; ++k) dst[n][k] = *(const PG8_LAS bf16x8*)(lds + PG8_SB(b, h) + boff + n * 2048 + k * 1024); } while (0)
#define PG8_MMA(ai, bj, At, Bt) do { __builtin_amdgcn_s_setprio(1); _Pragma("unroll") for (int m = 0; m < 4; ++m) _Pragma("unroll") for (int n = 0; n < 2; ++n) _Pragma("unroll") for (int k = 0; k < 2; ++k) \
    acc[ai][bj][m][n] = mma16(Bt[n][k], At[m][k], acc[ai][bj][m][n]); __builtin_amdgcn_s_setprio(0); } while (0)
#define PG8_WAIT_V(n) asm volatile("s_waitcnt vmcnt(" #n ")" ::: "memory")
#define PG8_WAIT_L(n) asm volatile("s_waitcnt lgkmcnt(" #n ")" ::: "memory")
#define PG8_BAR __builtin_amdgcn_s_barrier()
#define PG8_SCHED __builtin_amdgcn_sched_barrier(0)
  Unit cur, nxt; int ui = 0;
  if (!S.next(0, cur)) return;
  typedef typename Epi::acc_t acc_t;
  acc_t acc[2][2][4][2];
#pragma unroll
  for (int a = 0; a < 2; ++a)
#pragma unroll
    for (int b = 0; b < 2; ++b)
#pragma unroll
      for (int m = 0; m < 4; ++m)
#pragma unroll
        for (int n = 0; n < 2; ++n) acc[a][b][m][n] = (acc_t){0, 0, 0, 0};
  bf16x8 At[4][2], B0[2][2], B1[2][2];
  const char* cA = (const char*)g.A + (size_t)cur.pm * tstepA; const char* cB = (const char*)g.Bt + (size_t)cur.pn * tstepB;
  PG8_STAGE(PG8_SB(0, 0), cB, voffB); PG8_STAGE(PG8_SA(0, 0), cA, voffA); PG8_STAGE(PG8_SB(0, 1), cB + hstepB, voffB); PG8_STAGE(PG8_SA(0, 1), cA + hstepA, voffA);
  if (wr == 1) PG8_BAR;
  PG8_WAIT_V(4); PG8_BAR;
  PG8_STAGE(PG8_SB(1, 0), cB + kstep, voffB); PG8_STAGE(PG8_SA(1, 0), cA + kstep, voffA); PG8_STAGE(PG8_SB(1, 1), cB + hstepB + kstep, voffB);
  PG8_WAIT_V(6); PG8_BAR;
  for (;;) {
    const bool has_next = S.next(ui + 1, nxt);
    const char* nA = has_next ? (const char*)g.A + (size_t)nxt.pm * tstepA : cA; const char* nB = has_next ? (const char*)g.Bt + (size_t)nxt.pn * tstepB : cB;
    for (int t = 0; t < nt; t += 2) {
      const bool last = (t == nt - 2);
      const char* a1 = cA + (size_t)(t + 1) * kstep;
      const char* a2 = last ? nA : cA + (size_t)(t + 2) * kstep; const char* b2 = last ? nB : cB + (size_t)(t + 2) * kstep;
      const char* a3 = a2 + kstep; const char* b3 = b2 + kstep;
      PG8_LDB(B0, 0, 0); PG8_SCHED; PG8_LDA(At, 0, 0); PG8_STAGE(PG8_SA(1, 1), a1 + hstepA, voffA);
      PG8_WAIT_L(8); PG8_BAR; PG8_WAIT_L(0); PG8_MMA(0, 0, At, B0); PG8_BAR; PG8_SCHED;
      PG8_LDB(B1, 0, 1); PG8_STAGE(PG8_SB(0, 0), b2, voffB);
      PG8_BAR; PG8_WAIT_L(0); PG8_MMA(0, 1, At, B1); PG8_BAR;
      PG8_LDA(At, 0, 1); PG8_STAGE(PG8_SA(0, 0), a2, voffA);
      PG8_BAR; PG8_WAIT_L(0); PG8_MMA(1, 0, At, B0); PG8_BAR; PG8_SCHED;
      PG8_STAGE(PG8_SB(0, 1), b2 + hstepB, voffB);
      PG8_WAIT_V(6); PG8_BAR; PG8_MMA(1, 1, At, B1); PG8_BAR;
      PG8_LDB(B0, 1, 0); PG8_SCHED; PG8_LDA(At, 1, 0); PG8_STAGE(PG8_SA(0, 1), a2 + hstepA, voffA);
      PG8_WAIT_L(8); PG8_BAR; PG8_WAIT_L(0); PG8_MMA(0, 0, At, B0); PG8_BAR; PG8_SCHED;
      PG8_LDB(B1, 1, 1); PG8_STAGE(PG8_SB(1, 0), b3, voffB);
      PG8_BAR; PG8_WAIT_L(0); PG8_MMA(0, 1, At, B1); PG8_BAR;
      PG8_LDA(At, 1, 1); PG8_STAGE(PG8_SA(1, 0), a3, voffA);
      PG8_BAR; PG8_WAIT_L(0); PG8_MMA(1, 0, At, B0); PG8_BAR; PG8_SCHED;
      PG8_STAGE(PG8_SB(1, 1), b3 + hstepB, voffB);
      PG8_WAIT_V(6); PG8_BAR; PG8_MMA(1, 1, At, B1); PG8_BAR;
    }
    E(acc, cur, wr, wc, fr, fq);
    if (!has_next) break;
#pragma unroll
    for (int a = 0; a < 2; ++a)
#pragma unroll
      for (int b = 0; b < 2; ++b)
#pragma unroll
        for (int m = 0; m < 4; ++m)
#pragma unroll
          for (int n = 0; n < 2; ++n) acc[a][b][m][n] = (acc_t){0, 0, 0, 0};
    cur = nxt; cA = nA; cB = nB; ++ui;
  }
  PG8_WAIT_V(0);
  if (wr == 0) PG8_BAR;
  PG8_BAR;
#undef PG8_SA
#undef PG8_SB
#undef PG8_STAGE
#undef PG8_LDA
#undef PG8_LDB
#undef PG8_MMA
#undef PG8_WAIT_V
#undef PG8_WAIT_L
#undef PG8_BAR
#undef PG8_SCHED
}
typedef const f32x4 (&AccRef)[2][2][4][2];
typedef const i32x4 (&AccRefI)[2][2][4][2];
struct EpiInprojN {
  static constexpr bool PERM = true;
  typedef f32x4 acc_t;
  u16* qk; u16* rg;
  __device__ __forceinline__ void operator()(AccRef acc, const Unit& u, int wr, int wc, int fr, int fq) const {
    const int row0 = u.pm * BM + wr * 64 + fr;
    u16* base; int ld, colt;
    if (u.pn < 4) { base = qk; ld = 1024; colt = u.pn * 256; } else { base = rg; ld = 512; colt = (u.pn - 9) * 256; }
    const int col0 = colt + wc * 32 + 8 * fq;
#pragma unroll
    for (int ai = 0; ai < 2; ++ai)
#pragma unroll
      for (int m = 0; m < 4; ++m) {
        u16* rowp = base + (size_t)(row0 + ai * HALF + m * 16) * ld + col0;
#pragma unroll
        for (int bj = 0; bj < 2; ++bj) {
          const f32x4 v0 = acc[ai][bj][m][0], v1 = acc[ai][bj][m][1];
          u32x4 w; w.x = pkh(v0[0], v0[1]); w.y = pkh(v0[2], v0[3]); w.z = pkh(v1[0], v1[1]); w.w = pkh(v1[2], v1[3]);
          *(u32x4*)(rowp + bj * HALF) = w;
        }
      }
  }
};
struct EpiInprojT {
  static constexpr bool PERM = true;
  typedef f32x4 acc_t;
  u16 *vT, *vTc, *hyT, *hyTc;
  __device__ __forceinline__ void operator()(AccRef acc, const Unit& u, int wr, int wc, int fr, int fq) const {
    const bool isctx = (u.pn >= 128);
    const int b = isctx ? (u.pn - 128) : (u.pn >> 4);
    const int Lseg = isctx ? 256 : 4096, t0 = isctx ? 0 : (u.pn & 15) * 256;
    const bool isv = (u.pm < 2);
    const size_t boff = isv ? (isctx ? (size_t)16777216 : (size_t)0) : (isctx ? (size_t)(16777216 + 1048576 + 25165824) : (size_t)(16777216 + 1048576));
    u16* base = vT + boff;
    const int nc = isv ? 512 : 768;
    const int wrow0 = (isv ? u.pm : u.pm - 2) * BM + wr * 64 + fr;
    const int col0 = t0 + wc * 32 + 8 * fq;
#pragma unroll
    for (int ai = 0; ai < 2; ++ai)
#pragma unroll
      for (int m = 0; m < 4; ++m) {
        u16* rowp = base + ((size_t)(b * nc + wrow0 + ai * HALF + m * 16)) * Lseg + col0;
#pragma unroll
        for (int bj = 0; bj < 2; ++bj) {
          const f32x4 v0 = acc[ai][bj][m][0], v1 = acc[ai][bj][m][1];
          u32x4 w; w.x = pkh(v0[0], v0[1]); w.y = pkh(v0[2], v0[3]); w.z = pkh(v1[0], v1[1]); w.w = pkh(v1[2], v1[3]);
          *(u32x4*)(rowp + bj * HALF) = w;
        }
      }
  }
};
struct EpiGate {
  static constexpr bool PERM = true;
  typedef f32x4 acc_t;
  unsigned char* g8; const float* bias;
  __device__ __forceinline__ void operator()(AccRef acc, const Unit& u, int wr, int wc, int fr, int fq) const {
    const int row0 = u.pm * BM + wr * 64 + fr;
    const int col0 = u.pn * BM + wc * 32 + 8 * fq;
#pragma unroll
    for (int bj = 0; bj < 2; ++bj) {
      const f32x4 b0 = *(const f32x4*)(bias + col0 + bj * HALF), b1 = *(const f32x4*)(bias + col0 + bj * HALF + 4);
#pragma unroll
      for (int ai = 0; ai < 2; ++ai)
#pragma unroll
        for (int m = 0; m < 4; ++m) {
          const f32x4 v0 = acc[ai][bj][m][0] + b0, v1 = acc[ai][bj][m][1] + b1;
          unsigned w0 = 0, w1 = 0;
#pragma unroll
          for (int k = 0; k < 4; ++k) {
            w0 |= (unsigned)(sigmoidf_(v0[k]) * 255.0f + 0.5f) << (8 * k);
            w1 |= (unsigned)(sigmoidf_(v1[k]) * 255.0f + 0.5f) << (8 * k);
          }
          *(uint2*)(g8 + (size_t)(row0 + ai * HALF + m * 16) * 3072 + col0 + bj * HALF) = make_uint2(w0, w1);
        }
    }
  }
};
struct EpiBranch {
  static constexpr bool PERM = true;
  typedef f32x4 acc_t;
  u16* mbuf; const unsigned char* g8; int br;
  __device__ __forceinline__ void operator()(AccRef acc, const Unit& u, int wr, int wc, int fr, int fq) const {
    const int row0 = u.pm * BM + wr * 64 + fr;
    const int col0 = u.pn * BM + wc * 32 + 8 * fq;
#pragma unroll
    for (int ai = 0; ai < 2; ++ai) {
      uint2 gq[4][2];
      u32x4 o[4][2];
#pragma unroll
      for (int m = 0; m < 4; ++m)
#pragma unroll
        for (int bj = 0; bj < 2; ++bj)
          gq[m][bj] = *(const uint2*)(g8 + (size_t)(row0 + ai * HALF + m * 16) * 3072 + br * 1024 + col0 + bj * HALF);
      if (br != 0) {
#pragma unroll
        for (int m = 0; m < 4; ++m)
#pragma unroll
          for (int bj = 0; bj < 2; ++bj)
            o[m][bj] = *(const u32x4*)(mbuf + (size_t)(row0 + ai * HALF + m * 16) * 1024 + col0 + bj * HALF);
      }
#pragma unroll
      for (int m = 0; m < 4; ++m) {
        const size_t row = (size_t)(row0 + ai * HALF + m * 16);
#pragma unroll
        for (int bj = 0; bj < 2; ++bj) {
          const uint2 g = gq[m][bj];
          u16* mp = mbuf + row * 1024 + col0 + bj * HALF;
          const f32x4 v0 = acc[ai][bj][m][0], v1 = acc[ai][bj][m][1];
          float r[8];
          r[0] = (float)(g.x & 255u) * v0[0]; r[1] = (float)((g.x >> 8) & 255u) * v0[1];
          r[2] = (float)((g.x >> 16) & 255u) * v0[2]; r[3] = (float)(g.x >> 24) * v0[3];
          r[4] = (float)(g.y & 255u) * v1[0]; r[5] = (float)((g.y >> 8) & 255u) * v1[1];
          r[6] = (float)((g.y >> 16) & 255u) * v1[2]; r[7] = (float)(g.y >> 24) * v1[3];
          u32x4 w;
          if (br == 0) {
            w.x = pkh(r[0] * (1.f / 255.f), r[1] * (1.f / 255.f)); w.y = pkh(r[2] * (1.f / 255.f), r[3] * (1.f / 255.f));
            w.z = pkh(r[4] * (1.f / 255.f), r[5] * (1.f / 255.f)); w.w = pkh(r[6] * (1.f / 255.f), r[7] * (1.f / 255.f));
          } else {
            const u32x4 ov = o[m][bj];
            w.x = pkh(bflo(ov.x) + r[0] * (1.f / 255.f), bfhi(ov.x) + r[1] * (1.f / 255.f));
            w.y = pkh(bflo(ov.y) + r[2] * (1.f / 255.f), bfhi(ov.y) + r[3] * (1.f / 255.f));
            w.z = pkh(bflo(ov.z) + r[4] * (1.f / 255.f), bfhi(ov.z) + r[5] * (1.f / 255.f));
            w.w = pkh(bflo(ov.w) + r[6] * (1.f / 255.f), bfhi(ov.w) + r[7] * (1.f / 255.f));
          }
          *(u32x4*)mp = w;
        }
      }
    }
  }
};
struct EpiOut {
  static constexpr bool PERM = false;
  typedef f32x4 acc_t;
  const float *xsrc, *csrc; float *xdst, *cdst; const float* modl;
  __device__ __forceinline__ void operator()(AccRef acc, const Unit& u, int wr, int wc, int fr, int fq) const {
    const bool isctx = (u.pm >= 128);
    const int bi = isctx ? 8 : (u.pm >> 4);
    const float* gatev = modl + ((size_t)bi * 6 + 2) * 1024;
    const float* src = isctx ? (csrc - (size_t)NLAT * 1024) : xsrc;
    float* dst = isctx ? (cdst - (size_t)NLAT * 1024) : xdst;
    const int row0 = u.pm * BM + wr * 64 + fr, col0 = u.pn * BM + wc * 32 + 4 * fq;
    f32x4 gv[4];
#pragma unroll
    for (int g = 0; g < 4; ++g) gv[g] = *(const f32x4*)(gatev + col0 + (g >> 1) * HALF + (g & 1) * 16);
#pragma unroll
    for (int g = 0; g < 4; ++g) {
      const int bj = g >> 1, n = g & 1;
      const int col = col0 + bj * HALF + n * 16;
      f32x4 xv[8];
#pragma unroll
      for (int i = 0; i < 8; ++i) xv[i] = *(const f32x4*)(src + (size_t)(row0 + (i >> 2) * HALF + (i & 3) * 16) * 1024 + col);
#pragma unroll
      for (int i = 0; i < 8; ++i) {
        const size_t o = (size_t)(row0 + (i >> 2) * HALF + (i & 3) * 16) * 1024 + col;
        *(f32x4*)(dst + o) = xv[i] + gv[g] * acc[i >> 2][bj][i & 3][n];
      }
    }
  }
};
struct EpiQ {
  static constexpr bool PERM = true;
  typedef f32x4 acc_t;
  u16* q;
  __device__ __forceinline__ void operator()(AccRef acc, const Unit& u, int wr, int wc, int fr, int fq) const {
    const int row0 = u.pm * BM + wr * 64 + fr;
    const int col0 = u.pn * BM + wc * 32 + 8 * fq;
#pragma unroll
    for (int ai = 0; ai < 2; ++ai)
#pragma unroll
      for (int m = 0; m < 4; ++m) {
        u16* rowp = q + (size_t)(row0 + ai * HALF + m * 16) * 2048 + col0;
#pragma unroll
        for (int bj = 0; bj < 2; ++bj) {
          const f32x4 v0 = acc[ai][bj][m][0], v1 = acc[ai][bj][m][1];
          u32x4 w;
          w.x = __builtin_bit_cast(unsigned, __builtin_amdgcn_cvt_pkrtz(v0[0], v0[1]));
          w.y = __builtin_bit_cast(unsigned, __builtin_amdgcn_cvt_pkrtz(v0[2], v0[3]));
          w.z = __builtin_bit_cast(unsigned, __builtin_amdgcn_cvt_pkrtz(v1[0], v1[1]));
          w.w = __builtin_bit_cast(unsigned, __builtin_amdgcn_cvt_pkrtz(v1[2], v1[3]));
          *(u32x4*)(rowp + bj * HALF) = w;
        }
      }
  }
};
struct EpiInprojN8 {
  static constexpr bool PERM = true;
  typedef i32x4 acc_t;
  u16* qk; u16* rg; const float* sa; const float* sw;
  __device__ __forceinline__ void operator()(AccRefI acc, const Unit& u, int wr, int wc, int fr, int fq) const {
    const int row0 = u.pm * BM + wr * 64 + fr;
    u16* base; int ld, colt;
    if (u.pn < 4) { base = qk; ld = 1024; colt = u.pn * 256; } else { base = rg; ld = 512; colt = (u.pn - 9) * 256; }
    const int col0 = colt + wc * 32 + 8 * fq;
    const int wcol0 = u.pn * 256 + wc * 32 + 8 * fq;
    float rs[8];
    f32x4 cs[2][2];
#pragma unroll
    for (int i = 0; i < 8; ++i) rs[i] = sa[row0 + (i >> 2) * HALF + (i & 3) * 16];
#pragma unroll
    for (int bj = 0; bj < 2; ++bj) { cs[bj][0] = *(const f32x4*)(sw + wcol0 + bj * HALF); cs[bj][1] = *(const f32x4*)(sw + wcol0 + bj * HALF + 4); }
#pragma unroll
    for (int bj = 0; bj < 2; ++bj) {
      const f32x4 c0 = cs[bj][0], c1 = cs[bj][1];
#pragma unroll
      for (int ai = 0; ai < 2; ++ai)
#pragma unroll
        for (int m = 0; m < 4; ++m) {
          const int row = row0 + ai * HALF + m * 16;
          const float r = rs[ai * 4 + m];
          const i32x4 a0 = acc[ai][bj][m][0], a1 = acc[ai][bj][m][1];
          u32x4 w;
          w.x = pkh((float)a0[0] * r * c0[0], (float)a0[1] * r * c0[1]); w.y = pkh((float)a0[2] * r * c0[2], (float)a0[3] * r * c0[3]);
          w.z = pkh((float)a1[0] * r * c1[0], (float)a1[1] * r * c1[1]); w.w = pkh((float)a1[2] * r * c1[2], (float)a1[3] * r * c1[3]);
          *(u32x4*)(base + (size_t)row * ld + col0 + bj * HALF) = w;
        }
    }
  }
};
struct EpiInprojT8 {
  static constexpr bool PERM = true;
  typedef i32x4 acc_t;
  u16* vT; const float* sa; const float* sw;
  __device__ __forceinline__ void operator()(AccRefI acc, const Unit& u, int wr, int wc, int fr, int fq) const {
    const bool isctx = (u.pn >= 128);
    const int b = isctx ? (u.pn - 128) : (u.pn >> 4);
    const int Lseg = isctx ? 256 : 4096, t0 = isctx ? 0 : (u.pn & 15) * 256;
    const bool isv = (u.pm < 2);
    const size_t boff = isv ? (isctx ? (size_t)16777216 : (size_t)0) : (isctx ? (size_t)(16777216 + 1048576 + 25165824) : (size_t)(16777216 + 1048576));
    u16* base = vT + boff;
    const int nc = isv ? 512 : 768;
    const int wrow0 = (isv ? u.pm : u.pm - 2) * BM + wr * 64 + fr;
    const int srow0 = u.pm * BM + wr * 64 + fr;
    const int col0 = t0 + wc * 32 + 8 * fq;
    const int tok0 = u.pn * BM + wc * 32 + 8 * fq;
    float rs[8];
    f32x4 cs[2][2];
#pragma unroll
    for (int i = 0; i < 8; ++i) rs[i] = sw[srow0 + (i >> 2) * HALF + (i & 3) * 16];
#pragma unroll
    for (int bj = 0; bj < 2; ++bj) { cs[bj][0] = *(const f32x4*)(sa + tok0 + bj * HALF); cs[bj][1] = *(const f32x4*)(sa + tok0 + bj * HALF + 4); }
#pragma unroll
    for (int bj = 0; bj < 2; ++bj) {
      const f32x4 c0 = cs[bj][0], c1 = cs[bj][1];
#pragma unroll
      for (int ai = 0; ai < 2; ++ai)
#pragma unroll
        for (int m = 0; m < 4; ++m) {
          const float r = rs[ai * 4 + m];
          const i32x4 a0 = acc[ai][bj][m][0], a1 = acc[ai][bj][m][1];
          u32x4 w;
          w.x = pkh((float)a0[0] * r * c0[0], (float)a0[1] * r * c0[1]); w.y = pkh((float)a0[2] * r * c0[2], (float)a0[3] * r * c0[3]);
          w.z = pkh((float)a1[0] * r * c1[0], (float)a1[1] * r * c1[1]); w.w = pkh((float)a1[2] * r * c1[2], (float)a1[3] * r * c1[3]);
          *(u32x4*)(base + ((size_t)(b * nc + wrow0 + ai * HALF + m * 16)) * Lseg + col0 + bj * HALF) = w;
        }
    }
  }
};
struct EpiGate8 {
  static constexpr bool PERM = true;
  typedef i32x4 acc_t;
  unsigned char* g8; const float* bias; const float* sa; const float* sw;
  __device__ __forceinline__ void operator()(AccRefI acc, const Unit& u, int wr, int wc, int fr, int fq) const {
    const int row0 = u.pm * BM + wr * 64 + fr;
    const int col0 = u.pn * BM + wc * 32 + 8 * fq;
    float rs[8];
    f32x4 bs[2][2], cs[2][2];
#pragma unroll
    for (int i = 0; i < 8; ++i) rs[i] = sa[row0 + (i >> 2) * HALF + (i & 3) * 16];
#pragma unroll
    for (int bj = 0; bj < 2; ++bj) {
      bs[bj][0] = *(const f32x4*)(bias + col0 + bj * HALF); bs[bj][1] = *(const f32x4*)(bias + col0 + bj * HALF + 4);
      cs[bj][0] = *(const f32x4*)(sw + col0 + bj * HALF); cs[bj][1] = *(const f32x4*)(sw + col0 + bj * HALF + 4);
    }
#pragma unroll
    for (int bj = 0; bj < 2; ++bj) {
      const f32x4 b0 = bs[bj][0], b1 = bs[bj][1], c0 = cs[bj][0], c1 = cs[bj][1];
#pragma unroll
      for (int ai = 0; ai < 2; ++ai)
#pragma unroll
        for (int m = 0; m < 4; ++m) {
          const int row = row0 + ai * HALF + m * 16;
          const float r = rs[ai * 4 + m];
          const i32x4 a0 = acc[ai][bj][m][0], a1 = acc[ai][bj][m][1];
          unsigned w0 = 0, w1 = 0;
#pragma unroll
          for (int k = 0; k < 4; ++k) {
            w0 |= (unsigned)(sigmoidf_((float)a0[k] * r * c0[k] + b0[k]) * 255.0f + 0.5f) << (8 * k);
            w1 |= (unsigned)(sigmoidf_((float)a1[k] * r * c1[k] + b1[k]) * 255.0f + 0.5f) << (8 * k);
          }
          *(uint2*)(g8 + (size_t)row * 3072 + col0 + bj * HALF) = make_uint2(w0, w1);
        }
    }
  }
};
}

__device__ __forceinline__ void tr_tile(const float* __restrict__ src, int N, int K, u16* __restrict__ dst, int tile, char* smem) {
  float* lds = (float*)smem;
  const int tiles_n = N >> 6;
  const int tk = tile / tiles_n, tn = tile - tk * tiles_n;
  const int tid = opaque_tid();
  {
    const int r = tid >> 3, c8 = (tid & 7) * 8;
    const float* s = src + (size_t)(tk * 64 + r) * N + tn * 64 + c8;
    float4 a = *(const float4*)s, b = *(const float4*)(s + 4);
    float* d = lds + r * 65 + c8;
    d[0] = a.x; d[1] = a.y; d[2] = a.z; d[3] = a.w; d[4] = b.x; d[5] = b.y; d[6] = b.z; d[7] = b.w;
  }
  __syncthreads();
  {
    const int n = tid >> 3, k0 = (tid & 7) * 8;
    uint4 o;
    o.x = pk2(lds[(k0 + 0) * 65 + n], lds[(k0 + 1) * 65 + n]);
    o.y = pk2(lds[(k0 + 2) * 65 + n], lds[(k0 + 3) * 65 + n]);
    o.z = pk2(lds[(k0 + 4) * 65 + n], lds[(k0 + 5) * 65 + n]);
    o.w = pk2(lds[(k0 + 6) * 65 + n], lds[(k0 + 7) * 65 + n]);
    *(uint4*)(dst + (size_t)(tn * 64 + n) * K + tk * 64 + k0) = o;
  }
  __syncthreads();
}
__device__ __forceinline__ void colmax_task(const float* __restrict__ w, int N, int n0, float* __restrict__ swp, char* smem) {
  const int tid = opaque_tid();
  const int col = tid & 63, kg = tid >> 6;
  float m = 0.f;
  const float* wp = w + (size_t)(kg * 128) * N + n0 + col;
#pragma unroll 16
  for (int k = 0; k < 128; ++k) m = fmaxf(m, fabsf(wp[(size_t)k * N]));
  float* red = (float*)smem;
  red[kg * 64 + col] = m;
  __syncthreads();
  if (tid < 64) {
    float mm = red[tid];
#pragma unroll
    for (int g = 1; g < 8; ++g) mm = fmaxf(mm, red[g * 64 + tid]);
    swp[n0 + tid] = fmaxf(mm, 1e-20f) * (1.0f / 127.0f);
  }
  __syncthreads();
}
__device__ __forceinline__ void tr_tile_i8(const float* __restrict__ src, int N, int K, unsigned char* __restrict__ dst, int tile, const float* __restrict__ swp, char* smem) {
  float* lds = (float*)smem;
  const int tiles_n = N >> 6;
  const int tk = tile / tiles_n, tn = tile - tk * tiles_n;
  const int tid = opaque_tid();
  {
    const int r = tid >> 3, c8 = (tid & 7) * 8;
    const float* sp = src + (size_t)(tk * 64 + r) * N + tn * 64 + c8;
    float4 a = *(const float4*)sp, b = *(const float4*)(sp + 4);
    float* d = lds + r * 65 + c8;
    d[0] = a.x; d[1] = a.y; d[2] = a.z; d[3] = a.w; d[4] = b.x; d[5] = b.y; d[6] = b.z; d[7] = b.w;
  }
  __syncthreads();
  {
    const int n = tid >> 3, k0 = (tid & 7) * 8;
    const float inv = 1.0f / swp[tn * 64 + n];
    unsigned w0 = 0, w1 = 0;
#pragma unroll
    for (int i = 0; i < 4; ++i) {
      w0 |= ((unsigned)__float2int_rn(lds[(k0 + i) * 65 + n] * inv) & 255u) << (8 * i);
      w1 |= ((unsigned)__float2int_rn(lds[(k0 + 4 + i) * 65 + n] * inv) & 255u) << (8 * i);
    }
    *(uint2*)(dst + (size_t)(tn * 64 + n) * K + tk * 64 + k0) = make_uint2(w0, w1);
  }
  __syncthreads();
}
__device__ __forceinline__ void cvt_chunk(const float* __restrict__ src, u16* __restrict__ dst, size_t chunk) {
  const size_t i = chunk * 4096 + (size_t)opaque_tid() * 8;
  float4 a = *(const float4*)(src + i), b = *(const float4*)(src + i + 4);
  uint4 o;
  o.x = pk2(a.x, a.y); o.y = pk2(a.z, a.w); o.z = pk2(b.x, b.y); o.w = pk2(b.z, b.w);
  *(uint4*)(dst + i) = o;
}
template <bool I8>
__device__ __forceinline__ void tr_tile4(const float* __restrict__ src, int N, int K, void* __restrict__ dstv, int tile4, const float* __restrict__ swp, char* smem) {
  float* lds = (float*)smem;
  const int tiles_n = N >> 6;
  const int tkq = tile4 / tiles_n, tn = tile4 - tkq * tiles_n;
  const int tid = opaque_tid();
  {
    const int r = tid >> 3, c8 = (tid & 7) * 8;
    const float* sp = src + (size_t)(tkq * 256 + r) * N + tn * 64 + c8;
    float4 a[4], b[4];
#pragma unroll
    for (int q = 0; q < 4; ++q) { a[q] = *(const float4*)(sp + (size_t)q * 64 * N); b[q] = *(const float4*)(sp + (size_t)q * 64 * N + 4); }
#pragma unroll
    for (int q = 0; q < 4; ++q) {
      float* d = lds + q * 4160 + r * 65 + c8;
      d[0] = a[q].x; d[1] = a[q].y; d[2] = a[q].z; d[3] = a[q].w; d[4] = b[q].x; d[5] = b[q].y; d[6] = b[q].z; d[7] = b[q].w;
    }
  }
  __syncthreads();
  {
    const int n = tid >> 3, k0 = (tid & 7) * 8;
    if (I8) {
      const float inv = 1.0f / swp[tn * 64 + n];
      unsigned char* dst = (unsigned char*)dstv;
#pragma unroll
      for (int q = 0; q < 4; ++q) {
        const float* lq = lds + q * 4160;
        unsigned w0 = 0, w1 = 0;
#pragma unroll
        for (int i = 0; i < 4; ++i) {
          w0 |= ((unsigned)__float2int_rn(lq[(k0 + i) * 65 + n] * inv) & 255u) << (8 * i);
          w1 |= ((unsigned)__float2int_rn(lq[(k0 + 4 + i) * 65 + n] * inv) & 255u) << (8 * i);
        }
        *(uint2*)(dst + (size_t)(tn * 64 + n) * K + tkq * 256 + q * 64 + k0) = make_uint2(w0, w1);
      }
    } else {
      u16* dst = (u16*)dstv;
#pragma unroll
      for (int q = 0; q < 4; ++q) {
        const float* lq = lds + q * 4160;
        uint4 o;
        o.x = pk2(lq[(k0 + 0) * 65 + n], lq[(k0 + 1) * 65 + n]);
        o.y = pk2(lq[(k0 + 2) * 65 + n], lq[(k0 + 3) * 65 + n]);
        o.z = pk2(lq[(k0 + 4) * 65 + n], lq[(k0 + 5) * 65 + n]);
        o.w = pk2(lq[(k0 + 6) * 65 + n], lq[(k0 + 7) * 65 + n]);
        *(uint4*)(dst + (size_t)(tn * 64 + n) * K + tkq * 256 + q * 64 + k0) = o;
      }
    }
  }
  __syncthreads();
}
__device__ __forceinline__ void colmax4_task(const float* __restrict__ w, int N, int n0, float* __restrict__ swp, char* smem) {
  const int tid = opaque_tid();
  const int c4 = (tid & 15) * 4, rg = tid >> 4;
  const float* wp = w + (size_t)(rg * 32) * N + n0 + c4;
  float4 m = {0.f, 0.f, 0.f, 0.f};
#pragma unroll 16
  for (int k = 0; k < 32; ++k) {
    const float4 v = *(const float4*)(wp + (size_t)k * N);
    m.x = fmaxf(m.x, fabsf(v.x)); m.y = fmaxf(m.y, fabsf(v.y)); m.z = fmaxf(m.z, fabsf(v.z)); m.w = fmaxf(m.w, fabsf(v.w));
  }
  float* red = (float*)smem;
  *(float4*)(red + rg * 64 + c4) = m;
  __syncthreads();
  if (tid < 64) {
    float mm = red[tid];
#pragma unroll
    for (int g = 1; g < 32; ++g) mm = fmaxf(mm, red[g * 64 + tid]);
    swp[n0 + tid] = fmaxf(mm, 1e-20f) * (1.0f / 127.0f);
  }
  __syncthreads();
}
__device__ __forceinline__ void cvt_chunk4(const float* __restrict__ src, u16* __restrict__ dst, size_t chunk4) {
  const size_t i = chunk4 * 16384 + (size_t)opaque_tid() * 8;
  float4 a[4], b[4];
#pragma unroll
  for (int q = 0; q < 4; ++q) { a[q] = *(const float4*)(src + i + q * 4096); b[q] = *(const float4*)(src + i + q * 4096 + 4); }
#pragma unroll
  for (int q = 0; q < 4; ++q) {
    uint4 o;
    o.x = pk2(a[q].x, a[q].y); o.y = pk2(a[q].z, a[q].w); o.z = pk2(b[q].x, b[q].y); o.w = pk2(b[q].z, b[q].w);
    *(uint4*)(dst + i + q * 4096) = o;
  }
}
__device__ __forceinline__ void cvt_chunk_fp8(const float* __restrict__ src, unsigned char* __restrict__ dst, size_t chunk, float scale) {
  const size_t i = chunk * 4096 + (size_t)opaque_tid() * 8;
  const float4 a = *(const float4*)(src + i), b = *(const float4*)(src + i + 4);
  int w0 = __builtin_amdgcn_cvt_pk_fp8_f32(a.x * scale, a.y * scale, 0, false);
  w0 = __builtin_amdgcn_cvt_pk_fp8_f32(a.z * scale, a.w * scale, w0, true);
  int w1 = __builtin_amdgcn_cvt_pk_fp8_f32(b.x * scale, b.y * scale, 0, false);
  w1 = __builtin_amdgcn_cvt_pk_fp8_f32(b.z * scale, b.w * scale, w1, true);
  *(uint2*)(dst + i) = make_uint2((unsigned)w0, (unsigned)w1);
}
__device__ __forceinline__ void cvt_chunk_fp4(const float* __restrict__ src, unsigned char* __restrict__ dst, size_t chunk, float scale, int vhalf) {
  const size_t i = chunk * 4096 + (size_t)opaque_tid() * 8;
  const float4 a = *(const float4*)(src + i), b = *(const float4*)(src + i + 4);
  unsigned w = 0;
  w = __builtin_amdgcn_cvt_scalef32_pk_fp4_f32(w, a.x * scale, a.y * scale, 1.0f, 0);
  w = __builtin_amdgcn_cvt_scalef32_pk_fp4_f32(w, a.z * scale, a.w * scale, 1.0f, 1);
  w = __builtin_amdgcn_cvt_scalef32_pk_fp4_f32(w, b.x * scale, b.y * scale, 1.0f, 2);
  w = __builtin_amdgcn_cvt_scalef32_pk_fp4_f32(w, b.z * scale, b.w * scale, 1.0f, 3);
  const size_t e = i >> 10;
  const unsigned d = (unsigned)(i & 1023);
  *(unsigned*)(dst + e * 1024 + vhalf * 512 + (d >> 1)) = w;
}
__device__ __forceinline__ void phase_modreduce(const P& p) {
  const int n = 2 * 9 * 6144;
  for (int i = blockIdx.x * NTHR + opaque_tid(); i < n; i += gridDim.x * NTHR) {
    const int l = i / (9 * 6144);
    const int j = i % 6144;
    float s = p.b_ada[l * 6144 + j];
#pragma unroll
    for (int kc = 0; kc < 16; ++kc) s += p.modpart[(size_t)kc * n + i];
    p.mod[i] = s;
  }
}

__device__ __forceinline__ void phase_norm(const P& p, int l, int which) {
  const int tid_ = opaque_tid(); const int lane = tid_ & 63, wid = tid_ >> 6;
  const int ntok = (which == 2 || (which == 1 && l == 1)) ? NLAT : NTOK;
  for (int row = blockIdx.x * 8 + wid; row < ntok; row += gridDim.x * 8) {
    const float* src;
    if (row < NLAT) src = ((which == 0 && l == 0) ? p.x : p.out) + (size_t)row * 1024;
    else src = ((which == 0 && l == 0) ? p.ctx : p.ctxs) + (size_t)(row - NLAT) * 1024;
    float4 v[4];
    float ss = 0.f;
#pragma unroll
    for (int i = 0; i < 4; ++i) {
      v[i] = *(const float4*)(src + i * 256 + lane * 4);
      ss += v[i].x * v[i].x + v[i].y * v[i].y + v[i].z * v[i].z + v[i].w * v[i].w;
    }
    ss = wave_sum(ss);
    const float rstd = rsqrtf(ss * (1.0f / 1024.0f) + 1e-6f);
    if (which == 2) {
#pragma unroll
      for (int i = 0; i < 4; ++i) {
        const int col = i * 256 + lane * 4;
        const float4 g = *(const float4*)(p.final_g + col);
        float4 o = {v[i].x * rstd * g.x, v[i].y * rstd * g.y, v[i].z * rstd * g.z, v[i].w * rstd * g.w};
        *(float4*)(p.out + (size_t)row * 1024 + col) = o;
      }
    } else {
      const int bi = row < NLAT ? (row >> 12) : 8;
      const float* gam = (which == 0 ? p.norm_mix_g : p.norm_ffn_g) + l * 1024;
      const float* msh = p.mod + ((size_t)(l * 9 + bi) * 6 + (which == 0 ? 0 : 3)) * 1024;
      const float* msc = msh + 1024;
      float4 y[4];
      float amax = 0.f;
#pragma unroll
      for (int i = 0; i < 4; ++i) {
        const int col = i * 256 + lane * 4;
        const float4 g = *(const float4*)(gam + col);
        const float4 sh = *(const float4*)(msh + col);
        const float4 sc = *(const float4*)(msc + col);
        y[i].x = v[i].x * rstd * g.x * (1.f + sc.x) + sh.x; y[i].y = v[i].y * rstd * g.y * (1.f + sc.y) + sh.y;
        y[i].z = v[i].z * rstd * g.z * (1.f + sc.z) + sh.z; y[i].w = v[i].w * rstd * g.w * (1.f + sc.w) + sh.w;
        amax = fmaxf(amax, fmaxf(fmaxf(fabsf(y[i].x), fabsf(y[i].y)), fmaxf(fabsf(y[i].z), fabsf(y[i].w))));
      }
      if (which == 0) {
        amax = fmaxf(wave_max(amax), 1e-20f);
        const float inv = 127.0f / amax;
#pragma unroll
        for (int i = 0; i < 4; ++i) {
          const unsigned w = ((unsigned)__float2int_rn(y[i].x * inv) & 255u) | (((unsigned)__float2int_rn(y[i].y * inv) & 255u) << 8) |
                             (((unsigned)__float2int_rn(y[i].z * inv) & 255u) << 16) | (((unsigned)__float2int_rn(y[i].w * inv) & 255u) << 24);
          *(unsigned*)(p.xn8 + (size_t)row * 1024 + i * 256 + lane * 4) = w;
        }
        if (lane == 0) p.sa[row] = amax * (1.0f / 127.0f);
      } else {
#pragma unroll
        for (int i = 0; i < 4; ++i) {
          uint2 o;
          o.x = pk2(y[i].x, y[i].y);
          o.y = pk2(y[i].z, y[i].w);
          *(uint2*)(p.xn + (size_t)row * 1024 + i * 256 + lane * 4) = o;
        }
      }
    }
  }
}

__device__ __forceinline__ void filter_wave(const P& p, int l, int L, int t, float* __restrict__ outp) {
  const int lane = opaque_tid() & 63;
  const float tl = (float)t / (float)(L - 1);
  const float wang = (6.283185307179586f / (float)L) * (float)t;
  float z = 0.f;
  if (lane == 0) z = tl;
  else if (lane <= 16) { const float band = 1e-4f + (float)(lane - 1) * ((15.0f - 1e-4f) / 15.0f); z = cosf(band * wang); }
  else if (lane <= 32) { const float band = 1e-4f + (float)(lane - 17) * ((15.0f - 1e-4f) / 15.0f); z = -sinf(band * wang); }
  float a1 = p.hy_f1_b[l * 64 + lane];
  for (int i = 0; i < 33; ++i) a1 += shf(z, i) * p.hy_f1_w[(l * 33 + i) * 64 + lane];
  const float h1 = sinf(p.hy_freq[l * 128 + lane] * a1);
  float a2 = p.hy_f2_b[l * 64 + lane];
  for (int i = 0; i < 64; ++i) a2 += shf(h1, i) * p.hy_f2_w[(l * 64 + i) * 64 + lane];
  const float h2 = sinf(p.hy_freq[l * 128 + 64 + lane] * a2);
  float a3[8];
#pragma unroll
  for (int m = 0; m < 8; ++m) a3[m] = 0.f;
  for (int i = 0; i < 64; ++i) {
    const float hv = shf(h2, i);
    const float* wr = p.hy_f3_w + (size_t)(l * 64 + i) * 512 + lane;
#pragma unroll
    for (int m = 0; m < 8; ++m) a3[m] += hv * wr[m * 64];
  }
  const float LN100 = 4.605170185988092f;
  const float d0 = LN100 / 1.5f, d1 = LN100 / 0.3f;
#pragma unroll
  for (int m = 0; m < 8; ++m) {
    const int cp = lane + 64 * m;
    const int ch = cp & 255;
    const float delta = d0 + (float)ch * ((d1 - d0) / 255.0f);
    outp[(size_t)cp * L + t] = a3[m] * expf(-tl * delta);
  }
}
__device__ __forceinline__ void filter_block_task(const P& p, int l, int L, int t0, float* __restrict__ outp, char* smem) {
  const int tid = opaque_tid(), lane = tid & 63, wid = tid >> 6;
  float* W3s = (float*)smem;
  float* W2s = (float*)(smem + 131072);
  {
    const float4* s3 = (const float4*)(p.hy_f3_w + (size_t)l * 64 * 512);
    const float4* s2 = (const float4*)(p.hy_f2_w + (size_t)l * 64 * 64);
#pragma unroll
    for (int i = 0; i < 16; ++i) ((float4*)W3s)[tid + NTHR * i] = s3[tid + NTHR * i];
#pragma unroll
    for (int i = 0; i < 2; ++i) ((float4*)W2s)[tid + NTHR * i] = s2[tid + NTHR * i];
  }
  __syncthreads();
  float z[4], tl[4];
#pragma unroll
  for (int j = 0; j < 4; ++j) {
    const int t = t0 + wid * 4 + j;
    tl[j] = (float)t / (float)(L - 1);
    const float wang = (6.283185307179586f / (float)L) * (float)t;
    float zz = 0.f;
    if (lane == 0) zz = tl[j];
    else if (lane <= 16) { const float band = 1e-4f + (float)(lane - 1) * ((15.0f - 1e-4f) / 15.0f); zz = cosf(band * wang); }
    else if (lane <= 32) { const float band = 1e-4f + (float)(lane - 17) * ((15.0f - 1e-4f) / 15.0f); zz = -sinf(band * wang); }
    z[j] = zz;
  }
  float a1[4], a2[4];
  {
    const float b1 = p.hy_f1_b[l * 64 + lane];
#pragma unroll
    for (int j = 0; j < 4; ++j) a1[j] = b1;
#pragma unroll 11
    for (int i = 0; i < 33; ++i) {
      const float w = p.hy_f1_w[(l * 33 + i) * 64 + lane];
#pragma unroll
      for (int j = 0; j < 4; ++j) a1[j] += shf(z[j], i) * w;
    }
    const float f0 = p.hy_freq[l * 128 + lane];
#pragma unroll
    for (int j = 0; j < 4; ++j) a1[j] = sinf(f0 * a1[j]);
  }
  {
    const float b2 = p.hy_f2_b[l * 64 + lane];
#pragma unroll
    for (int j = 0; j < 4; ++j) a2[j] = b2;
#pragma unroll 8
    for (int i = 0; i < 64; ++i) {
      const float w = W2s[i * 64 + lane];
#pragma unroll
      for (int j = 0; j < 4; ++j) a2[j] += shf(a1[j], i) * w;
    }
    const float f1 = p.hy_freq[l * 128 + 64 + lane];
#pragma unroll
    for (int j = 0; j < 4; ++j) a2[j] = sinf(f1 * a2[j]);
  }
  float a3[4][8];
#pragma unroll
  for (int j = 0; j < 4; ++j)
#pragma unroll
    for (int m = 0; m < 8; ++m) a3[j][m] = 0.f;
#pragma unroll 4
  for (int i = 0; i < 64; ++i) {
    float w[8];
#pragma unroll
    for (int m = 0; m < 8; ++m) w[m] = W3s[i * 512 + lane + 64 * m];
#pragma unroll
    for (int j = 0; j < 4; ++j) {
      const float hv = shf(a2[j], i);
#pragma unroll
      for (int m = 0; m < 8; ++m) a3[j][m] += hv * w[m];
    }
  }
  const float LN100 = 4.605170185988092f;
  const float d0 = LN100 / 1.5f, d1 = LN100 / 0.3f;
#pragma unroll
  for (int m = 0; m < 8; ++m) {
    const int cp = lane + 64 * m;
    const float delta = d0 + (float)(cp & 255) * ((d1 - d0) / 255.0f);
    float4 o;
    o.x = a3[0][m] * expf(-tl[0] * delta); o.y = a3[1][m] * expf(-tl[1] * delta);
    o.z = a3[2][m] * expf(-tl[2] * delta); o.w = a3[3][m] * expf(-tl[3] * delta);
    *(float4*)(outp + (size_t)cp * L + t0 + wid * 4) = o;
  }
  __syncthreads();
}
__device__ __forceinline__ void phase_filters(const P& p, int l, char* smem) {
  const int ntask = 128 + (l == 0 ? 8 : 0);
  for (int t = blockIdx.x; t < ntask; t += gridDim.x) {
    if (t < 128) filter_block_task(p, l, 4096, t * 32, p.hT + (size_t)l * 512 * 4096, smem);
    else filter_block_task(p, l, 256, (t - 128) * 32, p.hc, smem);
  }
}
__device__ __forceinline__ void adaln_task(const P& p, int t, char* smem) {
  const int tid = opaque_tid();
  const int kc = t & 15; t >>= 4;
  const int jc = t % 12, l = t / 12;
  float* s = (float*)smem;
  float* red = (float*)(smem + 4096);
  for (int i = tid; i < 576; i += NTHR) {
    const int bi = i >> 6, kk = i & 63;
    const float v = (bi < 8) ? p.c[bi * 1024 + kc * 64 + kk] : p.c_ctx[kc * 64 + kk];
    s[i] = v / (1.0f + __expf(-v));
  }
  const int kq = tid >> 7, c4 = (tid & 127) * 4;
  const float* wp = p.w_ada + ((size_t)l * 1024 + kc * 64 + kq * 16) * 6144 + jc * 512 + c4;
  float4 w[16];
#pragma unroll
  for (int kk = 0; kk < 16; ++kk) w[kk] = *(const float4*)(wp + (size_t)kk * 6144);
  __syncthreads();
  float4 acc[9];
#pragma unroll
  for (int bi = 0; bi < 9; ++bi) acc[bi] = make_float4(0.f, 0.f, 0.f, 0.f);
#pragma unroll
  for (int kk = 0; kk < 16; ++kk) {
#pragma unroll
    for (int bi = 0; bi < 9; ++bi) {
      const float sv = s[bi * 64 + kq * 16 + kk];
      acc[bi].x += sv * w[kk].x; acc[bi].y += sv * w[kk].y; acc[bi].z += sv * w[kk].z; acc[bi].w += sv * w[kk].w;
    }
  }
#pragma unroll
  for (int bi = 0; bi < 9; ++bi) *(float4*)(red + (kq * 9 + bi) * 512 + c4) = acc[bi];
  __syncthreads();
#pragma unroll
  for (int bi = 0; bi < 9; ++bi) {
    const float v = red[bi * 512 + tid] + red[(9 + bi) * 512 + tid] + red[(18 + bi) * 512 + tid] + red[(27 + bi) * 512 + tid];
    p.modpart[((size_t)(kc * 2 + l) * 9 + bi) * 6144 + jc * 512 + tid] = v;
  }
  __syncthreads();
}
__device__ __forceinline__ void phase_prep(const P& p, char* smem, unsigned* counter) {
  volatile int* s_taskp = (volatile int*)(smem + SMEM_BYTES - 16);
  const int total = 264 + 184 + 384 + 544 + 32;
  int nxt = 0;
  if (threadIdx.x == 0) nxt = (int)atomicAdd(counter, 1u);
  for (;;) {
    __syncthreads();
    if (threadIdx.x == 0) *s_taskp = nxt;
    __syncthreads();
    int t = *s_taskp;
    if (t >= total) break;
    if (threadIdx.x == 0) nxt = (int)atomicAdd(counter, 1u);
    if (t < 264) {
      if (t < 128) filter_block_task(p, 0, 4096, t * 32, p.hT, smem);
      else if (t < 256) filter_block_task(p, 1, 4096, (t - 128) * 32, p.hT + (size_t)512 * 4096, smem);
      else filter_block_task(p, 0, 256, (t - 256) * 32, p.hc, smem);
      continue;
    }
    t -= 264;
    if (t < 184) {
      const int l = t / 92; t -= l * 92;
      if (t < 44) colmax4_task(p.w_in + (size_t)l * 1024 * 2816, 2816, t * 64, p.sw + l * 5888, smem);
      else colmax4_task(p.w_gate + (size_t)l * 1024 * 3072, 3072, (t - 44) * 64, p.sw + l * 5888 + 2816, smem);
      continue;
    }
    t -= 184;
    if (t < 384) { adaln_task(p, t, smem); continue; }
    t -= 384;
    if (t < 544) {
      const int l = t / 272; t -= l * 272;
      if (t < 32) tr_tile4<false>(p.w_br_a + (size_t)l * 512 * 1024, 1024, 512, p.WaT + (size_t)l * 1024 * 512, t, nullptr, smem);
      else if ((t -= 32) < 16) tr_tile4<false>(p.w_br_b + (size_t)l * 256 * 1024, 1024, 256, p.WbT + (size_t)l * 1024 * 256, t, nullptr, smem);
      else if ((t -= 16) < 16) tr_tile4<false>(p.w_br_c + (size_t)l * 256 * 1024, 1024, 256, p.WcT + (size_t)l * 1024 * 256, t, nullptr, smem);
      else if ((t -= 16) < 64) tr_tile4<false>(p.w_out + (size_t)l * 1024 * 1024, 1024, 1024, p.WoT + (size_t)l * 1024 * 1024, t, nullptr, smem);
      else if ((t -= 64) < 128) cvt_chunk4(p.peer_wq + (size_t)l * 1024 * 2048, p.WqB + (size_t)l * 1024 * 2048, (size_t)t);
      else {
        t -= 128;
        const int gate = t >> 3, dn = t & 7;
        const float* src = (gate ? p.rg_wx : p.rg_wa) + (size_t)(l * 8 + dn) * 4096;
        tr_tile(src, 64, 64, p.rgW + (size_t)((l * 2 + gate) * 8 + dn) * 4096, 0, smem);
      }
      continue;
    }
    t -= 544;
    cvt_chunk4(p.peer_keys, p.keysB, (size_t)t);
  }
}
__device__ __forceinline__ void kf_task(const P& p, int l, int c, char* smem) {
  const float* hTl = p.hT + (size_t)l * 512 * 4096;
  c2* buf = (c2*)smem;
  const int tid = opaque_tid();
  for (int i = 0; i < 16; ++i) {
    const int j = tid + NTHR * i;
    float v;
    if (j < 4096) v = hTl[(size_t)c * 4096 + j];
    else if (j == 4096) v = 0.f;
    else v = hTl[(size_t)(256 + c) * 4096 + (8192 - j)];
    buf[j] = {v, 0.f};
  }
  __syncthreads();
  fft8192(buf, -1.f);
  c2* o = (c2*)p.Kf + ((size_t)l * 256 + c) * 8192;
  for (int i = 0; i < 16; ++i) { const int j = tid + NTHR * i; o[j] = buf[j]; }
  __syncthreads();
}

__device__ __forceinline__ void inproj_tile(const P& p, int l, int mt, int nt, char* smem) {
  f32x16 acc[2][2];
  zero_acc(acc);
  const int m0 = mt * 256, n0 = nt * 128;
  gemm_kloop(acc, p.xn + (size_t)m0 * 1024, 1024, p.WinT + ((size_t)l * 2816 + n0) * 1024, 1024, 1024, smem);
  EPI_VARS
  if (nt < 8 || nt >= 18) {
    u16* dst; int ld, cbase;
    if (nt < 8) { dst = p.qk; ld = 1024; cbase = n0; }
    else { dst = p.rg; ld = 512; cbase = n0 - 2304; }
#pragma unroll
    for (int i = 0; i < 2; ++i)
#pragma unroll
      for (int j = 0; j < 2; ++j)
#pragma unroll
        for (int e = 0; e < 16; ++e)
          dst[(size_t)(m0 + EPI_ROW(i, e)) * ld + cbase + EPI_COL(j)] = f2bf(acc[i][j][e]);
  } else {
#pragma unroll
    for (int i = 0; i < 2; ++i)
#pragma unroll
      for (int j = 0; j < 2; ++j)
#pragma unroll
        for (int qd = 0; qd < 4; ++qd) {
          uint2 o;
          o.x = pk2(acc[i][j][4 * qd + 0], acc[i][j][4 * qd + 1]);
          o.y = pk2(acc[i][j][4 * qd + 2], acc[i][j][4 * qd + 3]);
          const int row0 = wm * 64 + i * 32 + 8 * qd + 4 * hh;
          *(uint2*)(smem + EPI_COL(j) * 520 + row0 * 2) = o;
        }
    __syncthreads();
    u16* dstT; int Lseg, t0, ncol0, nc;
    const bool isctx = (mt >= 128);
    const int b = isctx ? (mt - 128) : (mt >> 4);
    if (nt < 12) { ncol0 = n0 - 1024; nc = 512; dstT = isctx ? p.vTc : p.vT; }
    else { ncol0 = n0 - 1536; nc = 768; dstT = isctx ? p.hyTc : p.hyT; }
    if (isctx) { Lseg = 256; t0 = 0; } else { Lseg = 4096; t0 = (mt & 15) * 256; }
#pragma unroll 4
    for (int it = 0; it < 16; ++it) {
      const int idx = tid + NTHR * it;
      const int col = idx >> 6, u = idx & 63;
      const uint2 v = *(const uint2*)(smem + col * 520 + u * 8);
      *(uint2*)(dstT + ((size_t)(b * nc + ncol0 + col)) * Lseg + t0 + u * 4) = v;
    }
    __syncthreads();
  }
}

__device__ __forceinline__ float ldbf(const u16* p, int t, int L) { return (t >= 0 && t < L) ? bf2f(p[t]) : 0.f; }
__device__ __forceinline__ void ld10(const u16* __restrict__ seq, int t0, float (&v)[10]) {
  const uint4 r = *(const uint4*)(seq + t0);
  v[0] = (t0 > 0) ? bf2f(seq[t0 - 1]) : 0.f;
  v[9] = (t0 + 8 < 4096) ? bf2f(seq[t0 + 8]) : 0.f;
  v[1] = bflo(r.x); v[2] = bfhi(r.x); v[3] = bflo(r.y); v[4] = bfhi(r.y);
  v[5] = bflo(r.z); v[6] = bfhi(r.z); v[7] = bflo(r.w); v[8] = bfhi(r.w);
}
__device__ __forceinline__ void hyena_fft_task(const P& p, int l, int c, int bp, char* smem) {
  c2* buf = (c2*)smem;
  c2* ub = (c2*)(smem + 65536);
  const int tid = opaque_tid();
  const float* sw = p.hy_short_w + l * 3 * 768;
  const float* sb = p.hy_short_b + l * 768;
  const float wx0[3] = {sw[c], sw[768 + c], sw[1536 + c]};
  const float wx1[3] = {sw[256 + c], sw[768 + 256 + c], sw[1536 + 256 + c]};
  const float wv[3] = {sw[512 + c], sw[768 + 512 + c], sw[1536 + 512 + c]};
  const float bx0 = sb[c], bx1 = sb[256 + c], bv = sb[512 + c];
  const float dsk = p.hy_bias[l * 256 + c];
  const int t0 = tid * 8;
  {
    float u[2][8];
#pragma unroll
    for (int bb = 0; bb < 2; ++bb) {
      const int b = 2 * bp + bb;
      float x1[10], vv[10];
      ld10(p.hyT + ((size_t)(b * 768 + 256 + c)) * 4096, t0, x1);
      ld10(p.hyT + ((size_t)(b * 768 + 512 + c)) * 4096, t0, vv);
#pragma unroll
      for (int k = 0; k < 8; ++k) {
        const float x1c = bx1 + wx1[0] * x1[k] + wx1[1] * x1[k + 1] + wx1[2] * x1[k + 2];
        const float vc = bv + wv[0] * vv[k] + wv[1] * vv[k + 1] + wv[2] * vv[k + 2];
        u[bb][k] = vc * x1c;
      }
    }
#pragma unroll
    for (int k = 0; k < 8; k += 2) {
      const float4 w = make_float4(u[0][k], u[1][k], u[0][k + 1], u[1][k + 1]);
      *(float4*)(buf + t0 + k) = w;
      *(float4*)(ub + t0 + k) = w;
      *(float4*)(buf + 4096 + t0 + k) = make_float4(0.f, 0.f, 0.f, 0.f);
    }
  }
  __syncthreads();
  fft8192(buf, -1.f);
  const c2* kf = (const c2*)p.Kf + ((size_t)l * 256 + c) * 8192;
  for (int i = 0; i < 16; ++i) {
    const int k = tid + NTHR * i;
    buf[k] = cmul(buf[k], kf[k]);
  }
  __syncthreads();
  fft8192(buf, 1.f);
#pragma unroll
  for (int bb = 0; bb < 2; ++bb) {
    const int b = 2 * bp + bb;
    float x0[10];
    ld10(p.hyT + ((size_t)(b * 768 + c)) * 4096, t0, x0);
    float o[8];
#pragma unroll
    for (int k = 0; k < 8; ++k) {
      const c2 y = buf[t0 + k];
      const c2 uu = ub[t0 + k];
      const float x0c = bx0 + wx0[0] * x0[k] + wx0[1] * x0[k + 1] + wx0[2] * x0[k + 2];
      const float yy = ldexpf(bb ? y.y : y.x, -13);
      const float uv = bb ? uu.y : uu.x;
      o[k] = x0c * (yy + uv * dsk);
    }
    uint4 w; w.x = pk2(o[0], o[1]); w.y = pk2(o[2], o[3]); w.z = pk2(o[4], o[5]); w.w = pk2(o[6], o[7]);
    *(uint4*)(p.ybT + ((size_t)(b * 256 + c)) * 4096 + t0) = w;
  }
  __syncthreads();
}
__device__ __forceinline__ void yb_transpose_task(const P& p, int b, int tb, char* smem) {
  const int tid = opaque_tid(), lane = tid & 63, wid = tid >> 6;
  u16* T = (u16*)smem;
#pragma unroll
  for (int it = 0; it < 4; ++it) {
    const int id = tid + NTHR * it;
    const int c = id >> 3, ch = id & 7;
    const uint4 r = *(const uint4*)(p.ybT + ((size_t)(b * 256 + c)) * 4096 + tb * 64 + ch * 8);
    unsigned* d = (unsigned*)(T + c * 66 + ch * 8);
    d[0] = r.x; d[1] = r.y; d[2] = r.z; d[3] = r.w;
  }
  __syncthreads();
#pragma unroll
  for (int it = 0; it < 8; ++it) {
    const int tt = wid + 8 * it;
    const int c0 = lane * 4;
    uint2 w;
    w.x = (unsigned)T[(c0 + 0) * 66 + tt] | ((unsigned)T[(c0 + 1) * 66 + tt] << 16);
    w.y = (unsigned)T[(c0 + 2) * 66 + tt] | ((unsigned)T[(c0 + 3) * 66 + tt] << 16);
    *(uint2*)(p.ycat + (size_t)(b * 4096 + tb * 64 + tt) * 1024 + 512 + c0) = w;
  }
  __syncthreads();
}
__device__ __forceinline__ void hyena_ctx_task(const P& p, int l, int b, int cg8, char* smem) {
  const int tid_ = opaque_tid(); const int lane = tid_ & 63, wid = tid_ >> 6;
  const int c = cg8 * 8 + wid;
  float* us = (float*)smem + wid * 1024;
  float* kfp = us + 256 + 255;
  const float* sw = p.hy_short_w + l * 3 * 768;
  const float* sb = p.hy_short_b + l * 768;
  const u16* x0 = p.hyTc + ((size_t)(b * 768 + c)) * 256;
  const u16* x1 = p.hyTc + ((size_t)(b * 768 + 256 + c)) * 256;
  const u16* vv = p.hyTc + ((size_t)(b * 768 + 512 + c)) * 256;
  for (int i = 0; i < 4; ++i) {
    const int t = lane + 64 * i;
    const float x1c = sb[256 + c] + sw[256 + c] * ldbf(x1, t - 1, 256) + sw[768 + 256 + c] * ldbf(x1, t, 256) + sw[1536 + 256 + c] * ldbf(x1, t + 1, 256);
    const float vc = sb[512 + c] + sw[512 + c] * ldbf(vv, t - 1, 256) + sw[768 + 512 + c] * ldbf(vv, t, 256) + sw[1536 + 512 + c] * ldbf(vv, t + 1, 256);
    us[t] = vc * x1c;
    kfp[t] = p.hc[(size_t)c * 256 + t];
    if (t > 0) kfp[-t] = p.hc[(size_t)(256 + c) * 256 + t];
  }
  __syncthreads();
  const float dsk = p.hy_bias[l * 256 + c];
  float acc[4] = {0.f, 0.f, 0.f, 0.f};
  for (int s = 0; s < 256; ++s) {
    const float uv = us[s];
#pragma unroll
    for (int i = 0; i < 4; ++i) acc[i] += kfp[lane + 64 * i - s] * uv;
  }
#pragma unroll
  for (int i = 0; i < 4; ++i) {
    const int t = lane + 64 * i;
    const float x0c = sb[c] + sw[c] * ldbf(x0, t - 1, 256) + sw[768 + c] * ldbf(x0, t, 256) + sw[1536 + c] * ldbf(x0, t + 1, 256);
    p.ycat[(size_t)(NLAT + b * 256 + t) * 1024 + 512 + c] = f2bf(x0c * (acc[i] + us[t] * dsk));
  }
  __syncthreads();
}

template <int DIR>
__device__ __forceinline__ void rg_scan32(const float (&Av)[2][16], const float (&Bv)[2][16], float (&carry)[2], float (&H)[2][16], int hh) {
#pragma unroll
  for (int nt = 0; nt < 2; ++nt) {
    float c = carry[nt];
#pragma unroll
    for (int go = 0; go < 8; ++go) {
      const int g = DIR ? 7 - go : go, q = g >> 1, own = g & 1;
      float h = c;
#pragma unroll
      for (int io = 0; io < 4; ++io) {
        const int e = 4 * q + (DIR ? 3 - io : io);
        h = Av[nt][e] * h + Bv[nt][e];
        H[nt][e] = (hh == own) ? h : H[nt][e];
      }
      const float mine = (hh == own) ? h : c;
      const float other = shx(mine, 32);
      c = (hh == own) ? mine : other;
    }
    carry[nt] = c;
  }
}
__device__ __forceinline__ void rg_wave_task(const P& p, int l, int bq, int nblk, int mode, bool last, char* smem) {
  const int tid = opaque_tid(), lane = tid & 63, wid = tid >> 6;
  const int l31 = lane & 31, hh = lane >> 5;
  const int b = bq / 34, rr = bq - b * 34;
  const int seg = rr < 2 ? 0 : 1, blk = rr < 2 ? rr : rr - 2;
  if (mode == 1 && seg == 0 && last) return;
  const int ck = wid >> 1, dir = wid & 1;
  char* wreg = smem + wid * 17408;
  u16* xs = (u16*)wreg;
  char* xcb = wreg + 4608;
  float* xcf = (float*)(wreg + 8704);
  float2* blockagg = (float2*)(smem + 139264);
  const int Lseg = seg ? 4096 : 256;
  const int tokbase = seg ? b * 4096 : NLAT + b * 256;
  const int T0 = blk * 128 + ck * 32;
  const int cg32 = (seg ? 8 : 0) + blk * 4 + ck;
  bf16x8 wf[2][2][4];
#pragma unroll
  for (int gate = 0; gate < 2; ++gate) {
    const u16* wp = p.rgW + (size_t)(((l * 2 + gate) * 2 + dir) * 4 + nblk) * 4096 + l31 * 64 + 8 * hh;
#pragma unroll
    for (int nt = 0; nt < 2; ++nt)
#pragma unroll
      for (int s = 0; s < 4; ++s) wf[gate][nt][s] = *(const bf16x8*)(wp + nt * 2048 + 16 * s);
  }
  float cba[2], cbx[2], csp[2];
#pragma unroll
  for (int nt = 0; nt < 2; ++nt) {
    const int ch = (l * 2 + dir) * 256 + nblk * 64 + nt * 32 + l31;
    cba[nt] = p.rg_ba[ch];
    cbx[nt] = p.rg_bx[ch];
    csp[nt] = __logf(1.0f + __expf(-p.rg_lambda[ch]));
  }
#pragma unroll
  for (int i = 0; i < 5; ++i) {
    const int idx = lane + 64 * i;
    const int row = idx >> 3, chunk = idx & 7;
    if (row < 35) {
      const int pos = T0 - 2 + row;
      uint4 v = make_uint4(0u, 0u, 0u, 0u);
      if (pos >= 0 && pos < Lseg) v = *(const uint4*)(p.rg + (size_t)(tokbase + pos) * 512 + nblk * 64 + chunk * 8);
      *(uint4*)(xs + row * 64 + chunk * 8) = v;
    }
  }
  asm volatile("s_waitcnt lgkmcnt(0)" ::: "memory");
  {
    const int ch = l * 256 + nblk * 64 + lane;
    const float w0 = p.rg_conv_w[(l * 4 + 0) * 256 + nblk * 64 + lane], w1 = p.rg_conv_w[(l * 4 + 1) * 256 + nblk * 64 + lane];
    const float w2 = p.rg_conv_w[(l * 4 + 2) * 256 + nblk * 64 + lane], w3 = p.rg_conv_w[(l * 4 + 3) * 256 + nblk * 64 + lane];
    const float cb = p.rg_conv_b[ch];
    float x0 = bf2f(xs[0 * 64 + lane]), x1 = bf2f(xs[1 * 64 + lane]), x2 = bf2f(xs[2 * 64 + lane]);
#pragma unroll
    for (int t = 0; t < 32; ++t) {
      const float x3 = bf2f(xs[(t + 3) * 64 + lane]);
      const float xc = cb + w0 * x0 + w1 * x1 + w2 * x2 + w3 * x3;
      xcf[t * 68 + lane] = xc;
      *(u16*)(xcb + swz128(t, lane >> 3) + (lane & 7) * 2) = f2bf(xc);
      x0 = x1; x1 = x2; x2 = x3;
    }
  }
  asm volatile("s_waitcnt lgkmcnt(0)" ::: "memory");
  float Av[2][16], Bv[2][16];
  {
    f32x16 acc[2][2];
#pragma unroll
    for (int gate = 0; gate < 2; ++gate)
#pragma unroll
      for (int nt = 0; nt < 2; ++nt) acc[gate][nt] = zero16();
#pragma unroll
    for (int s = 0; s < 4; ++s) {
      const bf16x8 af = *(const bf16x8*)(xcb + swz128(l31, 2 * s + hh));
#pragma unroll
      for (int gate = 0; gate < 2; ++gate)
#pragma unroll
        for (int nt = 0; nt < 2; ++nt) acc[gate][nt] = mfma32(af, wf[gate][nt][s], acc[gate][nt]);
    }
#pragma unroll
    for (int nt = 0; nt < 2; ++nt)
#pragma unroll
      for (int e = 0; e < 16; ++e) {
        const int tok = (e & 3) + 8 * (e >> 2) + 4 * hh;
        const float r = sigmoidf_(acc[0][nt][e] + cba[nt]);
        const float ii = sigmoidf_(acc[1][nt][e] + cbx[nt]);
        const float la = -8.0f * r * csp[nt];
        const float av = __expf(la);
        const float e2 = 2.0f * la;
        const float om = (e2 > -0.1f) ? (-e2 * (1.0f + e2 * (0.5f + e2 * (0.16666667f + e2 * 0.041666668f)))) : (1.0f - __expf(e2));
        Av[nt][e] = av;
        Bv[nt][e] = sqrtf(om) * ii * xcf[tok * 68 + nt * 32 + l31];
      }
  }
  float H[2][16];
#pragma unroll
  for (int nt = 0; nt < 2; ++nt)
#pragma unroll
    for (int e = 0; e < 16; ++e) H[nt][e] = 0.f;
  float carry[2] = {0.f, 0.f};
  float2* agg1 = (float2*)p.agg;
  float2* agg2 = (float2*)p.agg + (size_t)8 * 2 * 136 * 256;
  const int pos2 = dir ? (seg == 0 ? 1 - blk : 33 - blk) : (seg == 0 ? blk : 2 + blk);
  if (mode == 0) {
    if (dir) rg_scan32<1>(Av, Bv, carry, H, hh); else rg_scan32<0>(Av, Bv, carry, H, hh);
    float P[2];
#pragma unroll
    for (int nt = 0; nt < 2; ++nt) {
      float pr = 1.f;
#pragma unroll
      for (int e = 0; e < 16; ++e) pr *= Av[nt][e];
      P[nt] = pr * shx(pr, 32);
    }
    const float2 mine = make_float2(hh ? P[1] : P[0], hh ? carry[1] : carry[0]);
    agg1[((size_t)(b * 2 + dir) * 136 + cg32) * 256 + nblk * 64 + lane] = mine;
    blockagg[(ck * 2 + dir) * 64 + lane] = mine;
    __syncthreads();
    if (wid < 2) {
      const int d2 = wid;
      float A = 1.f, B = 0.f;
#pragma unroll
      for (int co = 0; co < 4; ++co) {
        const int c = d2 ? 3 - co : co;
        const float2 g = blockagg[(c * 2 + d2) * 64 + lane];
        B = g.x * B + g.y;
        A *= g.x;
      }
      const int p2 = d2 ? (seg == 0 ? 1 - blk : 33 - blk) : (seg == 0 ? blk : 2 + blk);
      agg2[((size_t)(b * 2 + d2) * 34 + p2) * 256 + nblk * 64 + lane] = make_float2(A, B);
    }
    __syncthreads();
    return;
  }
  {
    float h = 0.f;
    const float2* a2 = agg2 + ((size_t)(b * 2 + dir) * 34) * 256 + nblk * 64 + lane;
    int j = 0;
    for (; j + 8 <= pos2; j += 8) {
      float2 g[8];
#pragma unroll
      for (int u = 0; u < 8; ++u) g[u] = a2[(size_t)(j + u) * 256];
#pragma unroll
      for (int u = 0; u < 8; ++u) h = g[u].x * h + g[u].y;
    }
    for (; j < pos2; ++j) { const float2 g = a2[(size_t)j * 256]; h = g.x * h + g.y; }
    const float2* a1 = agg1 + ((size_t)(b * 2 + dir) * 136 + (cg32 - ck)) * 256 + nblk * 64 + lane;
    const int npre = dir ? 3 - ck : ck;
    for (int i = 0; i < npre; ++i) {
      const int c = dir ? 3 - i : i;
      const float2 g = a1[(size_t)c * 256];
      h = g.x * h + g.y;
    }
    carry[0] = shf(h, l31);
    carry[1] = shf(h, 32 + l31);
  }
  if (dir) rg_scan32<1>(Av, Bv, carry, H, hh); else rg_scan32<0>(Av, Bv, carry, H, hh);
  asm volatile("s_waitcnt lgkmcnt(0)" ::: "memory");
#pragma unroll
  for (int nt = 0; nt < 2; ++nt)
#pragma unroll
    for (int e = 0; e < 16; ++e) xcf[((e & 3) + 8 * (e >> 2) + 4 * hh) * 68 + nt * 32 + l31] = H[nt][e];
  __syncthreads();
  {
    const float* hfT = (const float*)(smem + (ck * 2 + 0) * 17408 + 8704);
    const float* hbT = (const float*)(smem + (ck * 2 + 1) * 17408 + 8704);
    const int tok = 16 * dir + (lane >> 2), c16 = (lane & 3) * 16;
    const size_t gtok = (size_t)tokbase + T0 + tok;
    const u16* gp = p.rg + gtok * 512 + 256 + nblk * 64 + c16;
    u16* op = p.ycat + gtok * 1024 + 768 + nblk * 64 + c16;
#pragma unroll
    for (int hv = 0; hv < 2; ++hv) {
      const uint4 g = *(const uint4*)(gp + hv * 8);
      const float4 f0 = *(const float4*)(hfT + tok * 68 + c16 + hv * 8), f1 = *(const float4*)(hfT + tok * 68 + c16 + hv * 8 + 4);
      const float4 h0 = *(const float4*)(hbT + tok * 68 + c16 + hv * 8), h1 = *(const float4*)(hbT + tok * 68 + c16 + hv * 8 + 4);
      uint4 o;
      o.x = pk2((f0.x + h0.x) * gelu_tanh(bflo(g.x)), (f0.y + h0.y) * gelu_tanh(bfhi(g.x)));
      o.y = pk2((f0.z + h0.z) * gelu_tanh(bflo(g.y)), (f0.w + h0.w) * gelu_tanh(bfhi(g.y)));
      o.z = pk2((f1.x + h1.x) * gelu_tanh(bflo(g.z)), (f1.y + h1.y) * gelu_tanh(bfhi(g.z)));
      o.w = pk2((f1.z + h1.z) * gelu_tanh(bflo(g.w)), (f1.w + h1.w) * gelu_tanh(bfhi(g.w)));
      *(uint4*)(op + hv * 8) = o;
    }
  }
  __syncthreads();
}

__device__ __forceinline__ void attn_wave(const P& p, int l, int b, int h, bool local, int r, int half, int qtok0, const float* rpbL) {
  const int lane = opaque_tid() & 63, q = lane & 31, hh = lane >> 5;
  bf16x8 qf[4];
  {
    const u16* qp = p.qk + (size_t)(qtok0 + q) * 1024 + h * 64 + 8 * hh;
#pragma unroll
    for (int s = 0; s < 4; ++s) qf[s] = *(const bf16x8*)(qp + 16 * s);
  }
  f32x16 o0 = zero16(), o1 = zero16();
  float m_run = -1e30f, l_run = 0.f;
  const int pi = (q & 19) | ((q & 4) << 1) | ((q & 8) >> 1);
  const int w = half * 32 + q;
  const int st = min(max(w - 8, 0), 48);
  const int rs = min(max(r - 4, 0), 56);
  const int ntiles = local ? 24 : 8;
  bf16x8 kfn[4], vfn[2][2];
  auto tile_load = [&](int ti, bf16x8 (&kfo)[4], bf16x8 (&vfo)[2][2]) {
    int ktok0, vstride;
    const u16* vb;
    if (ti < 8) {
      ktok0 = NLAT + b * 256 + ti * 32;
      vb = p.vTc + ((size_t)(b * 512 + h * 64)) * 256 + ti * 32;
      vstride = 256;
    } else {
      const int tl = ti - 8;
      const int a2 = tl >> 1, g2 = tl & 1;
      ktok0 = b * 4096 + (rs + a2) * 64 + g2 * 32;
      vb = p.vT + ((size_t)(b * 512 + h * 64)) * 4096 + (rs + a2) * 64 + g2 * 32;
      vstride = 4096;
    }
    const u16* kp = p.qk + (size_t)(ktok0 + pi) * 1024 + 512 + h * 64 + 8 * hh;
#pragma unroll
    for (int s = 0; s < 4; ++s) kfo[s] = *(const bf16x8*)(kp + 16 * s);
#pragma unroll
    for (int dt = 0; dt < 2; ++dt)
#pragma unroll
      for (int s2 = 0; s2 < 2; ++s2) vfo[dt][s2] = *(const bf16x8*)(vb + (size_t)(dt * 32 + q) * vstride + 16 * s2 + 8 * hh);
  };
  tile_load(0, kfn, vfn);
  for (int ti = 0; ti < ntiles; ++ti) {
    int a = 0, g = 0;
    if (ti >= 8) { a = (ti - 8) >> 1; g = (ti - 8) & 1; }
    bf16x8 kf[4], vf[2][2];
#pragma unroll
    for (int s = 0; s < 4; ++s) kf[s] = kfn[s];
#pragma unroll
    for (int dt = 0; dt < 2; ++dt)
#pragma unroll
      for (int s2 = 0; s2 < 2; ++s2) vf[dt][s2] = vfn[dt][s2];
    if (ti + 1 < ntiles) tile_load(ti + 1, kfn, vfn);
    f32x16 sacc = zero16();
#pragma unroll
    for (int s = 0; s < 4; ++s) sacc = mfma32(kf[s], qf[s], sacc);
    float sv[16];
    float tmax = -1e30f;
#pragma unroll
    for (int e = 0; e < 16; ++e) {
      float x = sacc[e] * 0.125f;
      if (ti >= 8) {
        const int kc = g * 32 + (e & 7) + 8 * hh + 16 * (e >> 3);
        const bool valid = (kc >= st) && (kc < st + 16);
        const int bi = valid ? ((rs + a - r + 7) * 31 + (kc - w + 15)) : 0;
        const float bias = rpbL[bi];
        x = valid ? (x + bias) : -1e30f;
      }
      sv[e] = x;
      tmax = fmaxf(tmax, x);
    }
    tmax = fmaxf(tmax, shx(tmax, 32));
    const float m_new = fmaxf(m_run, tmax);
    const float alpha = __expf(m_run - m_new);
    m_run = m_new;
    l_run *= alpha;
#pragma unroll
    for (int e = 0; e < 16; ++e) { o0[e] *= alpha; o1[e] *= alpha; }
    float psum = 0.f;
#pragma unroll
    for (int e = 0; e < 16; ++e) { const float pe = __expf(sv[e] - m_new); sv[e] = pe; psum += pe; }
    l_run += psum;
    bf16x8 pf[2];
#pragma unroll
    for (int s2 = 0; s2 < 2; ++s2) {
      union { bf16x8 v; unsigned u[4]; } cv;
#pragma unroll
      for (int j = 0; j < 4; ++j) cv.u[j] = pk2(sv[8 * s2 + 2 * j], sv[8 * s2 + 2 * j + 1]);
      pf[s2] = cv.v;
    }
#pragma unroll
    for (int s2 = 0; s2 < 2; ++s2) {
      o0 = mfma32(vf[0][s2], pf[s2], o0);
      o1 = mfma32(vf[1][s2], pf[s2], o1);
    }
  }
  const float lt = l_run + shx(l_run, 32);
  const float inv = 1.0f / lt;
  u16* op = p.ycat + (size_t)(qtok0 + q) * 1024 + h * 64;
#pragma unroll
  for (int qd = 0; qd < 4; ++qd) {
    uint2 a0, a1;
    a0.x = pk2(o0[4 * qd] * inv, o0[4 * qd + 1] * inv);
    a0.y = pk2(o0[4 * qd + 2] * inv, o0[4 * qd + 3] * inv);
    a1.x = pk2(o1[4 * qd] * inv, o1[4 * qd + 1] * inv);
    a1.y = pk2(o1[4 * qd + 2] * inv, o1[4 * qd + 3] * inv);
    *(uint2*)(op + 8 * qd + 4 * hh) = a0;
    *(uint2*)(op + 32 + 8 * qd + 4 * hh) = a1;
  }
}
__device__ __forceinline__ void attn_block_task(const P& p, int l, int b, int h, int rg4, char* smem) {
  const int tid = opaque_tid(), lane = tid & 63, wid = tid >> 6;
  const int q = lane & 31, hh = lane >> 5;
  const int R0 = rg4 * 4;
  const int r = R0 + (wid >> 1), half = wid & 1;
  float* rpbL = (float*)(smem + 32768) + 64;
  for (int i = tid; i < 465; i += NTHR) rpbL[i] = p.na_rpb[(size_t)(l * 8 + h) * 465 + i] * 1.4426950408889634f;
  const int lo = min(max(R0 - 4, 0), 56);
  const int hi = min(max(R0 + 3 - 4, 0), 56) + 7;
  const int ntile = 4 + (hi - lo + 1);
  const int rs = min(max(r - 4, 0), 56);
  const int qtok = b * 4096 + r * 64 + half * 32 + q;
  bf16x8 qf[4];
  {
    const u16* qp = p.qk + (size_t)qtok * 1024 + h * 64 + 8 * hh;
#pragma unroll
    for (int s = 0; s < 4; ++s) qf[s] = *(const bf16x8*)(qp + 16 * s);
  }
  f32x16 o0 = zero16(), o1 = zero16();
  float m_run = -1e30f, l_run = 0.f;
  const int pi = (q & 19) | ((q & 4) << 1) | ((q & 8) >> 1);
  const int w = half * 32 + q;
  const int st = min(max(w - 8, 0), 48);
  unsigned vmask = 0u;
#pragma unroll
  for (int g = 0; g < 2; ++g)
#pragma unroll
    for (int e = 0; e < 16; ++e) {
      const int kc = g * 32 + (e & 7) + 8 * hh + 16 * (e >> 3);
      vmask |= ((kc >= st) && (kc < st + 16)) ? (1u << (g * 16 + e)) : 0u;
    }
  const int cbase = 8 * hh - w + 15;
  const int srow = tid >> 3, sch = tid & 7;
  uint4 rkA, rvA, rkB, rvB;
  auto gload = [&](int ti, uint4& rk, uint4& rv) {
    int ktok0, vstride;
    const u16* vb;
    if (ti < 4) { ktok0 = NLAT + b * 256 + ti * 64; vb = p.vTc + ((size_t)(b * 512 + h * 64)) * 256 + ti * 64; vstride = 256; }
    else { const int R = lo + ti - 4; ktok0 = b * 4096 + R * 64; vb = p.vT + ((size_t)(b * 512 + h * 64)) * 4096 + R * 64; vstride = 4096; }
    rk = *(const uint4*)(p.qk + (size_t)(ktok0 + srow) * 1024 + 512 + h * 64 + sch * 8);
    rv = *(const uint4*)(vb + (size_t)srow * vstride + sch * 8);
  };
  gload(0, rkA, rvA);
  *(uint4*)(smem + swz128(srow, sch)) = rkA;
  *(uint4*)(smem + 16384 + swz128(srow, sch)) = rvA;
  gload(1, rkA, rvA);
  if (2 < ntile) gload(2, rkB, rvB);
  __syncthreads();
  auto compute = [&](int ti) {
    const char* Kb = smem + (ti & 1) * 8192;
    const char* Vb = smem + 16384 + (ti & 1) * 8192;
    const int R = lo + ti - 4;
    const bool active = (ti < 4) || (R >= rs && R < rs + 8);
    if (active) {
      f32x16 sacc0 = zero16(), sacc1 = zero16();
#pragma unroll
      for (int s = 0; s < 4; ++s) {
        const bf16x8 kf0 = *(const bf16x8*)(Kb + swz128(pi, 2 * s + hh));
        const bf16x8 kf1 = *(const bf16x8*)(Kb + swz128(32 + pi, 2 * s + hh));
        sacc0 = mfma32(kf0, qf[s], sacc0);
        sacc1 = mfma32(kf1, qf[s], sacc1);
      }
      float sv[32];
      float tmax = -1e30f;
      if (ti >= 4) {
        const float* brow = rpbL + (R - r + 7) * 31 + cbase;
        float bias[32];
#pragma unroll
        for (int g = 0; g < 2; ++g)
#pragma unroll
          for (int e = 0; e < 16; ++e) bias[g * 16 + e] = brow[g * 32 + (e & 7) + 16 * (e >> 3)];
#pragma unroll
        for (int g = 0; g < 2; ++g)
#pragma unroll
          for (int e = 0; e < 16; ++e) {
            const float sc = g ? sacc1[e] : sacc0[e];
            const float x = ((int)(vmask << (31 - (g * 16 + e))) < 0) ? fmaf(sc, 0.18033688011112042f, bias[g * 16 + e]) : -1e30f;
            sv[g * 16 + e] = x;
            tmax = fmaxf(tmax, x);
          }
      } else {
#pragma unroll
        for (int g = 0; g < 2; ++g)
#pragma unroll
          for (int e = 0; e < 16; ++e) {
            const float x = (g ? sacc1[e] : sacc0[e]) * 0.18033688011112042f;
            sv[g * 16 + e] = x;
            tmax = fmaxf(tmax, x);
          }
      }
      tmax = fmaxf(tmax, shx(tmax, 32));
      if (__builtin_amdgcn_ballot_w64(tmax > m_run) != 0ull) {
        const float m_new = fmaxf(m_run, tmax);
        const float alpha = __builtin_amdgcn_exp2f(m_run - m_new);
        m_run = m_new;
        l_run *= alpha;
#pragma unroll
        for (int e = 0; e < 16; ++e) { o0[e] *= alpha; o1[e] *= alpha; }
      }
      float psum = 0.f;
#pragma unroll
      for (int e = 0; e < 32; ++e) { const float pe = __builtin_amdgcn_exp2f(sv[e] - m_run); sv[e] = pe; psum += pe; }
      l_run += psum;
#pragma unroll
      for (int g = 0; g < 2; ++g)
#pragma unroll
        for (int s2 = 0; s2 < 2; ++s2) {
          union { bf16x8 v; unsigned u[4]; } cv;
#pragma unroll
          for (int j = 0; j < 4; ++j) cv.u[j] = pk2(sv[g * 16 + 8 * s2 + 2 * j], sv[g * 16 + 8 * s2 + 2 * j + 1]);
          const bf16x8 v0 = *(const bf16x8*)(Vb + swz128(q, g * 4 + 2 * s2 + hh));
          const bf16x8 v1 = *(const bf16x8*)(Vb + swz128(32 + q, g * 4 + 2 * s2 + hh));
          o0 = mfma32(v0, cv.v, o0);
          o1 = mfma32(v1, cv.v, o1);
        }
    }
  };
  for (int ti = 0; ti < ntile; ti += 2) {
    compute(ti);
    if (ti + 1 < ntile) {
      *(uint4*)(smem + 8192 + swz128(srow, sch)) = rkA;
      *(uint4*)(smem + 16384 + 8192 + swz128(srow, sch)) = rvA;
      if (ti + 3 < ntile) gload(ti + 3, rkA, rvA);
    }
    __syncthreads();
    if (ti + 1 < ntile) {
      compute(ti + 1);
      if (ti + 2 < ntile) {
        *(uint4*)(smem + swz128(srow, sch)) = rkB;
        *(uint4*)(smem + 16384 + swz128(srow, sch)) = rvB;
        if (ti + 4 < ntile) gload(ti + 4, rkB, rvB);
      }
      __syncthreads();
    }
  }
  const float lt = l_run + shx(l_run, 32);
  const float inv = 1.0f / lt;
  __syncthreads();
  {
    char* ot = smem + wid * 4608;
#pragma unroll
    for (int qd = 0; qd < 4; ++qd) {
      uint2 a0, a1;
      a0.x = pk2(o0[4 * qd] * inv, o0[4 * qd + 1] * inv);
      a0.y = pk2(o0[4 * qd + 2] * inv, o0[4 * qd + 3] * inv);
      a1.x = pk2(o1[4 * qd] * inv, o1[4 * qd + 1] * inv);
      a1.y = pk2(o1[4 * qd + 2] * inv, o1[4 * qd + 3] * inv);
      *(uint2*)(ot + q * 144 + (8 * qd + 4 * hh) * 2) = a0;
      *(uint2*)(ot + q * 144 + (32 + 8 * qd + 4 * hh) * 2) = a1;
    }
    asm volatile("s_waitcnt lgkmcnt(0)" ::: "memory");
    const int tok0 = b * 4096 + r * 64 + half * 32;
#pragma unroll
    for (int it = 0; it < 4; ++it) {
      const int qq = it * 8 + (lane >> 3), ch = lane & 7;
      const uint4 v = *(const uint4*)(ot + qq * 144 + ch * 16);
      *(uint4*)(p.ycat + (size_t)(tok0 + qq) * 1024 + h * 64 + ch * 8) = v;
    }
  }
  __syncthreads();
}
__device__ __forceinline__ void attn_task(const P& p, int l, int kind, int idx, char* smem) {
  const int tid_ = opaque_tid(); const int lane = tid_ & 63, wid = tid_ >> 6;
  float* rpbL = (float*)smem + wid * 480;
  for (int i = lane; i < 465; i += 64) rpbL[i] = p.na_rpb[(size_t)(l * 8 + wid) * 465 + i];
  __syncthreads();
  if (kind == 0) {
    const int half = idx & 1, r = (idx >> 1) & 63, b = idx >> 7;
    attn_wave(p, l, b, wid, true, r, half, b * 4096 + r * 64 + half * 32, rpbL);
  } else {
    const int qg = idx & 7, b = idx >> 3;
    attn_wave(p, l, b, wid, false, 0, 0, NLAT + b * 256 + qg * 32, rpbL);
  }
  __syncthreads();
}

__device__ __forceinline__ void phase_mixers(const P& p, int l, char* smem, unsigned* counter) {
  const bool last = (l == 1);
  const int n_rg = 1088 * XRGA, n_fft = 1024 * XFFT, n_hc = last ? 0 : 256, n_att = 1024 * XATT, n_attc = last ? 0 : 64;
  const int total = n_rg + n_fft + n_hc + n_att + n_attc;
  volatile int* s_taskp = (volatile int*)(smem + SMEM_BYTES - 16);
  for (;;) {
    __syncthreads();
    if (threadIdx.x == 0) *s_taskp = (int)atomicAdd(counter, 1u);
    __syncthreads();
    int t = *s_taskp;
    if (t >= total) break;
    if (t < n_att) { t &= 1023; attn_block_task(p, l, t >> 7, (t >> 4) & 7, t & 15, smem); continue; }
    t -= n_att;
    if (t < n_attc) { attn_task(p, l, 1, t, smem); continue; }
    t -= n_attc;
    if (t < n_fft) { t &= 1023; hyena_fft_task(p, l, t >> 2, t & 3, smem); continue; }
    t -= n_fft;
    if (t < n_hc) { hyena_ctx_task(p, l, t >> 5, t & 31, smem); continue; }
    t -= n_hc;
    if (t >= 1088) t -= 1088;
    rg_wave_task(p, l, t >> 2, t & 3, 0, last, smem);
  }
}

__device__ __forceinline__ void merge_tile(const P& p, int l, int mt, int nt, char* smem) {
  EPI_VARS
  const int m0 = mt * 256, n0 = nt * 128;
  f32x16 macc[2][2];
  zero_acc(macc);
  for (int br = 0; br < 3; ++br) {
    unsigned* gpl = (unsigned*)(smem + 98304) + tid;
    {
      f32x16 acc[2][2];
      zero_acc(acc);
      gemm_kloop(acc, p.xn + (size_t)m0 * 1024, 1024, p.WgT + ((size_t)l * 3072 + br * 1024 + n0) * 1024, 1024, 1024, smem);
#pragma unroll
      for (int j = 0; j < 2; ++j) {
        const float bg = p.b_gate[l * 3072 + br * 1024 + n0 + EPI_COL(j)];
#pragma unroll
        for (int i = 0; i < 2; ++i)
#pragma unroll
          for (int e = 0; e < 4; ++e) {
            const unsigned q0 = (unsigned)(sigmoidf_(acc[i][j][4 * e] + bg) * 255.0f + 0.5f);
            const unsigned q1 = (unsigned)(sigmoidf_(acc[i][j][4 * e + 1] + bg) * 255.0f + 0.5f);
            const unsigned q2 = (unsigned)(sigmoidf_(acc[i][j][4 * e + 2] + bg) * 255.0f + 0.5f);
            const unsigned q3 = (unsigned)(sigmoidf_(acc[i][j][4 * e + 3] + bg) * 255.0f + 0.5f);
            gpl[((i * 2 + j) * 4 + e) * 512] = q0 | (q1 << 8) | (q2 << 16) | (q3 << 24);
          }
      }
    }
    {
      f32x16 acc[2][2];
      zero_acc(acc);
      const u16* A; const u16* B; int K;
      if (br == 0) { A = p.ycat + (size_t)m0 * 1024; B = p.WaT + ((size_t)l * 1024 + n0) * 512; K = 512; }
      else if (br == 1) { A = p.ycat + (size_t)m0 * 1024 + 512; B = p.WbT + ((size_t)l * 1024 + n0) * 256; K = 256; }
      else { A = p.ycat + (size_t)m0 * 1024 + 768; B = p.WcT + ((size_t)l * 1024 + n0) * 256; K = 256; }
      gemm_kloop(acc, A, 1024, B, K, K, smem);
#pragma unroll
      for (int i = 0; i < 2; ++i)
#pragma unroll
        for (int j = 0; j < 2; ++j)
#pragma unroll
          for (int e = 0; e < 4; ++e) {
            const unsigned g4 = gpl[((i * 2 + j) * 4 + e) * 512];
            macc[i][j][4 * e] += (float)(g4 & 255u) * (1.0f / 255.0f) * acc[i][j][4 * e];
            macc[i][j][4 * e + 1] += (float)((g4 >> 8) & 255u) * (1.0f / 255.0f) * acc[i][j][4 * e + 1];
            macc[i][j][4 * e + 2] += (float)((g4 >> 16) & 255u) * (1.0f / 255.0f) * acc[i][j][4 * e + 2];
            macc[i][j][4 * e + 3] += (float)(g4 >> 24) * (1.0f / 255.0f) * acc[i][j][4 * e + 3];
          }
    }
  }
#pragma unroll
  for (int i = 0; i < 2; ++i)
#pragma unroll
    for (int j = 0; j < 2; ++j)
#pragma unroll
      for (int e = 0; e < 16; ++e)
        p.mbuf[(size_t)(m0 + EPI_ROW(i, e)) * 1024 + n0 + EPI_COL(j)] = f2bf(macc[i][j][e]);
}
__device__ __forceinline__ void outproj_tile(const P& p, int l, int mt, int nt, char* smem, bool do_store) {
  EPI_VARS
  const int m0 = mt * 256, n0 = nt * 128;
  f32x16 acc[2][2];
  zero_acc(acc);
  gemm_kloop(acc, p.mbuf + (size_t)m0 * 1024, 1024, p.WoT + ((size_t)l * 1024 + n0) * 1024, 1024, 1024, smem);
  const bool isctx = (mt >= 128);
  const int bi = isctx ? 8 : (mt >> 4);
  const float* gatev = p.mod + ((size_t)(l * 9 + bi) * 6 + 2) * 1024;
  const float* src; float* dst;
  if (isctx) { src = (l == 0 ? p.ctx : p.ctxs) - (size_t)NLAT * 1024; dst = p.ctxs - (size_t)NLAT * 1024; }
  else { src = (l == 0 ? p.x : p.out); dst = p.out; }
#pragma unroll
  for (int j = 0; j < 2; ++j) {
    const int col = n0 + EPI_COL(j);
    const float gv = gatev[col];
#pragma unroll
    for (int i = 0; i < 2; ++i)
#pragma unroll
      for (int e = 0; e < 16; ++e) {
        const size_t o = (size_t)(m0 + EPI_ROW(i, e)) * 1024 + col;
        if (do_store) dst[o] = src[o] + gv * acc[i][j][e];
      }
  }
}

__device__ __forceinline__ void wqk_task(const P& p, int l, int hp, int nt, char* smem) {
  EPI_VARS
  f32x16 acc[2][2];
  zero_acc(acc);
  gemm_kloop(acc, p.keysB + ((size_t)l * 16 + hp) * 16384, 128, p.WqB + (size_t)l * 1024 * 2048 + (size_t)(nt * 128) * 2048 + hp * 128, 2048, 128, smem);
  if (wm < 2) {
#pragma unroll
    for (int i = 0; i < 2; ++i)
#pragma unroll
      for (int j = 0; j < 2; ++j)
#pragma unroll
        for (int e = 0; e < 16; ++e)
          p.WqkT[((size_t)l * 2048 + hp * 128 + EPI_ROW(i, e)) * 1024 + nt * 128 + EPI_COL(j)] = f2bf(acc[i][j][e]);
  }
}
__device__ __forceinline__ void ins16(unsigned (&L)[16], unsigned x) {
#pragma unroll
  for (int i = 0; i < 16; ++i) {
    const unsigned hi = max(L[i], x);
    x = min(L[i], x);
    L[i] = hi;
  }
}
__device__ __forceinline__ unsigned f2sort(float f) {
  const unsigned b = __float_as_uint(f);
  return b ^ ((unsigned)((int)b >> 31) | 0x80000000u);
}
__device__ __forceinline__ float sort2f(unsigned k) {
  const unsigned u = k & ~127u;
  const unsigned b = (u & 0x80000000u) ? (u ^ 0x80000000u) : ~u;
  return __uint_as_float(b);
}
__device__ __forceinline__ void cx_desc(unsigned& a, unsigned& b) { const unsigned hi = max(a, b), lo = min(a, b); a = hi; b = lo; }
template <int BASE> __device__ __forceinline__ void sort16_desc(unsigned (&k)[64]) {
#pragma unroll
  for (int sz = 2; sz <= 16; sz <<= 1) {
#pragma unroll
    for (int j = sz >> 1; j >= 1; j >>= 1) {
#pragma unroll
      for (int i = 0; i < 16; ++i) {
        const int l2 = i ^ j;
        if (l2 > i) {
          if ((i & sz) == 0) cx_desc(k[BASE + i], k[BASE + l2]);
          else cx_desc(k[BASE + l2], k[BASE + i]);
        }
      }
    }
  }
}
template <int AB, int BB> __device__ __forceinline__ void merge16_desc(unsigned (&k)[64]) {
#pragma unroll
  for (int i = 0; i < 16; ++i) k[AB + i] = max(k[AB + i], k[BB + 15 - i]);
#pragma unroll
  for (int j = 8; j >= 1; j >>= 1) {
#pragma unroll
    for (int i = 0; i < 16; ++i)
      if ((i & j) == 0) cx_desc(k[AB + i], k[AB + i + j]);
  }
}
__device__ __forceinline__ void peer_score_tile(const P& p, int l, int mt, int hp, char* smem) {
  const int tid = opaque_tid();
  const int m0 = mt * 256;
  const int row = tid >> 1, hf = tid & 1;
  {
    char* T = smem + 16384;
#pragma unroll
    for (int it = 0; it < 8; ++it) {
      const int id = tid + NTHR * it;
      const int r = id >> 4, ch = id & 15;
      *(uint4*)(T + r * 272 + ch * 16) = *(const uint4*)(p.q + (size_t)(m0 + r) * 2048 + hp * 128 + ch * 8);
    }
  }
  __syncthreads();
  const char* sp = smem + 16384 + row * 272 + hf * 128;
  unsigned k[64];
#pragma unroll
  for (int c = 0; c < 8; ++c) {
    const uint4 r = *(const uint4*)(sp + 16 * c);
    const unsigned w[4] = {r.x, r.y, r.z, r.w};
#pragma unroll
    for (int q = 0; q < 4; ++q) {
      const float v0 = __builtin_bit_cast(_Float16, (unsigned short)(w[q] & 0xffffu));
      const float v1 = __builtin_bit_cast(_Float16, (unsigned short)(w[q] >> 16));
      const int key = hf * 64 + c * 8 + q * 2;
      k[c * 8 + q * 2] = (f2sort(v0) & ~127u) | (unsigned)key;
      k[c * 8 + q * 2 + 1] = (f2sort(v1) & ~127u) | (unsigned)(key + 1);
    }
  }
  sort16_desc<0>(k); sort16_desc<16>(k); sort16_desc<32>(k); sort16_desc<48>(k);
  merge16_desc<0, 16>(k);
  merge16_desc<32, 48>(k);
  merge16_desc<0, 32>(k);
  unsigned* X = (unsigned*)smem;
  if (hf) {
#pragma unroll
    for (int i = 0; i < 16; ++i) X[row * 16 + i] = k[i];
  }
  __syncthreads();
  if (!hf) {
#pragma unroll
    for (int i = 0; i < 16; ++i) k[16 + i] = X[row * 16 + i];
    merge16_desc<0, 16>(k);
    unsigned* o = p.topk + ((size_t)(m0 + row) * 16 + hp) * 16;
#pragma unroll
    for (int i = 0; i < 4; ++i) *(uint4*)(o + 4 * i) = make_uint4(k[4 * i], k[4 * i + 1], k[4 * i + 2], k[4 * i + 3]);
  }
  __syncthreads();
}

__device__ __forceinline__ void phase_peer_experts(const P& p, int l, bool do_store, char* smem) {
  const int tid_ = opaque_tid(); const int lane = tid_ & 63, wid = tid_ >> 6;
  const int ntok = (l == 1) ? NLAT : NTOK;
  int ci, cj;
  {
    const int e = lane;
    if (e < 16) { ci = 0; cj = e; }
    else if (e < 24) { ci = 1; cj = e - 16; }
    else if (e < 29) { ci = 2; cj = e - 24; }
    else if (e < 33) { ci = 3; cj = e - 29; }
    else if (e < 36) { ci = 4; cj = e - 33; }
    else if (e < 38) { ci = 5; cj = e - 36; }
    else if (e < 40) { ci = 6; cj = e - 38; }
    else if (e < 42) { ci = 7; cj = e - 40; }
    else { ci = min(8 + (e - 42), 15); cj = 0; }
  }
  for (int tok = blockIdx.x * 8 + wid; tok < ntok; tok += gridDim.x * 8) {
    float xr[16];
    {
      const uint4 a = *(const uint4*)(p.xn + (size_t)tok * 1024 + lane * 16);
      const uint4 b = *(const uint4*)(p.xn + (size_t)tok * 1024 + lane * 16 + 8);
      xr[0] = bflo(a.x); xr[1] = bfhi(a.x); xr[2] = bflo(a.y); xr[3] = bfhi(a.y);
      xr[4] = bflo(a.z); xr[5] = bfhi(a.z); xr[6] = bflo(a.w); xr[7] = bfhi(a.w);
      xr[8] = bflo(b.x); xr[9] = bfhi(b.x); xr[10] = bflo(b.y); xr[11] = bfhi(b.y);
      xr[12] = bflo(b.z); xr[13] = bfhi(b.z); xr[14] = bflo(b.w); xr[15] = bfhi(b.w);
    }
    typedef _Float16 h2_t __attribute__((ext_vector_type(2)));
    h2_t yh[8];
#pragma unroll
    for (int i = 0; i < 8; ++i) yh[i] = (h2_t){(_Float16)0, (_Float16)0};
    int* selw = (int*)(smem + wid * 4096);
    const unsigned* kvp = p.topk + (size_t)tok * 256 + (lane & 31);
#pragma unroll 1
    for (int hb = 0; hb < 8; hb += 4) {
      unsigned key[4]; int eidx[4];
#pragma unroll
      for (int u = 0; u < 4; ++u) {
        const unsigned kv = kvp[(hb + u) * 32];
        const unsigned k0 = shu(kv, ci);
        const unsigned k1 = shu(kv, 16 + cj);
        const float val = (lane < 50) ? (sort2f(k0) + sort2f(k1)) : -3.0e38f;
        eidx[u] = (int)((k0 & 127u) * 128u + (k1 & 127u));
        key[u] = (f2sort(val) & ~63u) | (unsigned)lane;
      }
#pragma unroll
      for (int k = 2; k <= 64; k <<= 1) {
#pragma unroll
        for (int j = k >> 1; j >= 1; j >>= 1) {
          const bool take_max = (((lane & j) == 0) == ((lane & k) == 0));
#pragma unroll
          for (int u = 0; u < 4; ++u) {
            unsigned ok;
            if (j == 1) ok = xorl<1>(key[u], lane); else if (j == 2) ok = xorl<2>(key[u], lane); else if (j == 4) ok = xorl<4>(key[u], lane);
            else if (j == 8) ok = xorl<8>(key[u], lane); else if (j == 16) ok = xorl<16>(key[u], lane); else ok = xorl<32>(key[u], lane);
            key[u] = take_max ? max(key[u], ok) : min(key[u], ok);
          }
        }
      }
#pragma unroll
      for (int u = 0; u < 4; ++u) {
        const int si = __builtin_amdgcn_ds_bpermute((int)(key[u] & 63u) << 2, eidx[u]);
        const unsigned ku = key[u] & ~63u;
        const float sv = __uint_as_float((ku & 0x80000000u) ? (ku ^ 0x80000000u) : ~ku);
        const float mx = __builtin_bit_cast(float, __builtin_amdgcn_readlane(__builtin_bit_cast(int, sv), 0));
        const float ex = (lane < 16) ? __builtin_amdgcn_exp2f((sv - mx) * 1.4426950408889634f) : 0.f;
        const float sm = wave_sum(ex);
        selw[(hb + u) * 64 + lane] = si;
        selw[512 + (hb + u) * 64 + lane] = __builtin_bit_cast(int, ex * __builtin_amdgcn_rcpf(sm));
      }
    }
    {
      int w[4];
#pragma unroll
      for (int i = 0; i < 4; ++i) {
        int t = __builtin_amdgcn_cvt_pk_fp8_f32(xr[4 * i], xr[4 * i + 1], 0, false);
        w[i] = __builtin_amdgcn_cvt_pk_fp8_f32(xr[4 * i + 2], xr[4 * i + 3], t, true);
      }
      *(uint4*)(smem + 32768 + wid * 1024 + lane * 16) = make_uint4((unsigned)w[0], (unsigned)w[1], (unsigned)w[2], (unsigned)w[3]);
    }
    asm volatile("s_waitcnt lgkmcnt(0)" ::: "memory");
    const int e15 = lane & 15, g4 = lane >> 4;
#pragma unroll 1
    for (int h = 0; h < 8; ++h) {
      const int eperm_h = selw[h * 64 + lane];
      const int gperm_h = selw[512 + h * 64 + lane];
      const int ide = (int)shu((unsigned)eperm_h, e15);
      const unsigned char* ub = p.Ub + (size_t)ide * 1024 + g4 * 16;
      uint4 ua[8];
#pragma unroll
      for (int sI = 0; sI < 8; ++sI) ua[sI] = *(const uint4*)(ub + sI * 64);
      pg8::f32x4 hacc = {0.f, 0.f, 0.f, 0.f};
#pragma unroll
      for (int sI = 0; sI < 8; ++sI) {
        const uint4 b0 = *(const uint4*)(smem + 32768 + wid * 1024 + sI * 128 + g4 * 16);
        const uint4 b1 = *(const uint4*)(smem + 32768 + wid * 1024 + sI * 128 + 64 + g4 * 16);
        const i32x8 A = {(int)ua[sI].x, (int)ua[sI].y, (int)ua[sI].z, (int)ua[sI].w, 0, 0, 0, 0};
        const i32x8 B = {(int)b0.x, (int)b0.y, (int)b0.z, (int)b0.w, (int)b1.x, (int)b1.y, (int)b1.z, (int)b1.w};
        hacc = __builtin_amdgcn_mfma_scale_f32_16x16x128_f8f6f4(A, B, hacc, 4  , 0  , 0, 0x7f7f7f7f, 0, 0x7f7f7f7f);
      }
      asm volatile("" ::: "memory");
      uint2 V[16];
#pragma unroll
      for (int k = 0; k < 16; ++k) {
        const int id = __builtin_amdgcn_readlane(eperm_h, k);
        V[k] = *(const uint2*)(p.Ub + (size_t)id * 1024 + 512 + lane * 8);
      }
      float actv[4];
#pragma unroll
      for (int r4 = 0; r4 < 4; ++r4) {
        const float gl = __builtin_bit_cast(float, shu((unsigned)gperm_h, 4 * g4 + r4));
        actv[r4] = gelu_tanh(hacc[r4] * (1.0f / 64.0f)) * gl;
      }
#pragma unroll
      for (int k = 0; k < 16; ++k) {
        const float ak = __builtin_bit_cast(float, __builtin_amdgcn_readlane(__builtin_bit_cast(int, actv[k & 3]), 16 * (k >> 2)));
        const h2_t akh = {(_Float16)ak, (_Float16)ak};
        const unsigned vw[2] = {V[k].x, V[k].y};
#pragma unroll
        for (int q2 = 0; q2 < 2; ++q2) {
          yh[4 * q2 + 0] = __builtin_elementwise_fma(akh, __builtin_bit_cast(h2_t, __builtin_amdgcn_cvt_scalef32_pk_f16_fp4(vw[q2], 1.0f, 0)), yh[4 * q2 + 0]);
          yh[4 * q2 + 1] = __builtin_elementwise_fma(akh, __builtin_bit_cast(h2_t, __builtin_amdgcn_cvt_scalef32_pk_f16_fp4(vw[q2], 1.0f, 1)), yh[4 * q2 + 1]);
          yh[4 * q2 + 2] = __builtin_elementwise_fma(akh, __builtin_bit_cast(h2_t, __builtin_amdgcn_cvt_scalef32_pk_f16_fp4(vw[q2], 1.0f, 2)), yh[4 * q2 + 2]);
          yh[4 * q2 + 3] = __builtin_elementwise_fma(akh, __builtin_bit_cast(h2_t, __builtin_amdgcn_cvt_scalef32_pk_f16_fp4(vw[q2], 1.0f, 3)), yh[4 * q2 + 3]);
        }
      }
    }
    float yacc[16];
#pragma unroll
    for (int i = 0; i < 8; ++i) { yacc[2 * i] = (float)yh[i].x; yacc[2 * i + 1] = (float)yh[i].y; }
    const int bi = tok < NLAT ? (tok >> 12) : 8;
    const float* gv = p.mod + ((size_t)(l * 9 + bi) * 6 + 5) * 1024 + lane * 16;
    float* xp = (tok < NLAT) ? (p.out + (size_t)tok * 1024) : (p.ctxs + (size_t)(tok - NLAT) * 1024);
    xp += lane * 16;
    float4 xv[4];
    float ss = 0.f;
#pragma unroll
    for (int i = 0; i < 4; ++i) {
      xv[i] = *(float4*)(xp + 4 * i);
      const float4 g4 = *(const float4*)(gv + 4 * i);
      xv[i].x += g4.x * yacc[4 * i] * 0.25f; xv[i].y += g4.y * yacc[4 * i + 1] * 0.25f; xv[i].z += g4.z * yacc[4 * i + 2] * 0.25f; xv[i].w += g4.w * yacc[4 * i + 3] * 0.25f;
      ss += xv[i].x * xv[i].x + xv[i].y * xv[i].y + xv[i].z * xv[i].z + xv[i].w * xv[i].w;
    }
    ss = wave_sum(ss);
    const float rstd = rsqrtf(ss * (1.0f / 1024.0f) + 1e-6f);
    if (l == 0) {
      const float* gam = p.norm_mix_g + 1024 + lane * 16;
      const float* msh = p.mod + ((size_t)(9 + bi) * 6 + 0) * 1024 + lane * 16;
      const float* msc = msh + 1024;
      float yv[16];
      float amax = 0.f;
#pragma unroll
      for (int i = 0; i < 4; ++i) {
        if (do_store) *(float4*)(xp + 4 * i) = xv[i];
        const float4 g = *(const float4*)(gam + 4 * i);
        const float4 sh = *(const float4*)(msh + 4 * i);
        const float4 sc = *(const float4*)(msc + 4 * i);
        yv[4 * i] = xv[i].x * rstd * g.x * (1.f + sc.x) + sh.x; yv[4 * i + 1] = xv[i].y * rstd * g.y * (1.f + sc.y) + sh.y;
        yv[4 * i + 2] = xv[i].z * rstd * g.z * (1.f + sc.z) + sh.z; yv[4 * i + 3] = xv[i].w * rstd * g.w * (1.f + sc.w) + sh.w;
      }
#pragma unroll
      for (int i = 0; i < 16; ++i) amax = fmaxf(amax, fabsf(yv[i]));
      amax = fmaxf(wave_max(amax), 1e-20f);
      const float inv = 127.0f / amax;
      unsigned w[4];
#pragma unroll
      for (int i = 0; i < 4; ++i)
        w[i] = ((unsigned)__float2int_rn(yv[4 * i] * inv) & 255u) | (((unsigned)__float2int_rn(yv[4 * i + 1] * inv) & 255u) << 8) |
               (((unsigned)__float2int_rn(yv[4 * i + 2] * inv) & 255u) << 16) | (((unsigned)__float2int_rn(yv[4 * i + 3] * inv) & 255u) << 24);
      if (do_store) {
        *(uint4*)(p.xn8 + (size_t)tok * 1024 + lane * 16) = make_uint4(w[0], w[1], w[2], w[3]);
        if (lane == 0) p.sa[tok] = amax * (1.0f / 127.0f);
      }
    } else {
      const float* fg = p.final_g + lane * 16;
#pragma unroll
      for (int i = 0; i < 4; ++i) {
        const float4 g = *(const float4*)(fg + 4 * i);
        const float4 o = make_float4(xv[i].x * rstd * g.x, xv[i].y * rstd * g.y, xv[i].z * rstd * g.z, xv[i].w * rstd * g.w);
        if (do_store) *(float4*)(xp + 4 * i) = o;
      }
    }
  }
}


#define XB_TMO      128
#define XB_XCNT(j)  (256  + 64 * (j))
#define XB_XSUB(j)  (1280 + 64 * (j))
#define XB_XGEN(j)  (2304 + 64 * (j))
#define XB_TOP      3328
#define XB_TOPGEN   3392
#define XCD_BAR_WORDS 3456
#define XB_SPIN_CAP (1u << 22)
#define LAS __attribute__((address_space(3)))
__device__ __forceinline__ unsigned xb_ld(unsigned* p) { return __hip_atomic_load(p, __ATOMIC_RELAXED, __HIP_MEMORY_SCOPE_AGENT); }
__device__ __forceinline__ unsigned xb_add(unsigned* p, unsigned v) { return __hip_atomic_fetch_add(p, v, __ATOMIC_RELAXED, __HIP_MEMORY_SCOPE_AGENT); }
__device__ __forceinline__ unsigned xb_xcc_id() { return (unsigned)__builtin_amdgcn_s_getreg((3 << 11) | 20) & 0xFu; }
#define XB_SPIN(cond, bar) do { unsigned _sp = 0; while (cond) { __builtin_amdgcn_s_sleep(1); \
    if ((++_sp & 255u) == 0u) { if (xb_ld(&(bar)[XB_TMO])) break; if (_sp > XB_SPIN_CAP) { atomicAdd(&(bar)[XB_TMO], 1u); break; } } } } while (0)
struct XcdBarrier { unsigned* bar; unsigned x; volatile LAS unsigned* st; };
__device__ __forceinline__ XcdBarrier xcd_barrier_post(unsigned* bar, volatile LAS unsigned* st) {
  XcdBarrier b; b.bar = bar; b.x = xb_xcc_id(); b.st = st;
  if (threadIdx.x == 0) (void)xb_add(&bar[XB_XCNT(b.x)], 1u);
  return b;
}
__device__ __forceinline__ void xcd_barrier_complete(unsigned* bar, unsigned x, unsigned& nloc, unsigned& nx) {
  const unsigned G = gridDim.x * gridDim.y * gridDim.z;
  unsigned sum, cnt, mine, sp = 0u;
  for (;;) {
    sum = 0u; cnt = 0u; mine = 0u;
#pragma unroll
    for (unsigned j = 0; j < 16; ++j) { const unsigned c = xb_ld(&bar[XB_XCNT(j)]); sum += c; cnt += (c > 0u) ? 1u : 0u; mine = (j == x) ? c : mine; }
    if (sum == G) break;
    __builtin_amdgcn_s_sleep(1);
    if ((++sp & 255u) == 0u) { if (xb_ld(&bar[XB_TMO])) break; if (sp > XB_SPIN_CAP) { atomicAdd(&bar[XB_TMO], 1u); break; } }
  }
  nloc = mine > 0u ? mine : 1u; nx = cnt > 0u ? cnt : 1u;
}
__device__ __forceinline__ void xcd_barrier(unsigned* bar_u, volatile LAS unsigned* st_u) {
  XcdBarrier b; b.bar = bar_u; b.x = xb_xcc_id(); b.st = st_u;
  asm volatile("s_waitcnt vmcnt(0)" ::: "memory");
  __syncthreads();
  if (threadIdx.x == 0) {
    unsigned long long bp_ = (unsigned long long)b.bar;
    asm volatile("" : "+v"(bp_));
    unsigned* bar = (unsigned*)bp_;
    __builtin_amdgcn_s_waitcnt(0);
    unsigned nloc = b.st[0], nx = b.st[1];
    if (nloc == 0u) { xcd_barrier_complete(bar, b.x, nloc, nx); b.st[0] = nloc; b.st[1] = nx; }
    const unsigned old = xb_add(&bar[XB_XSUB(b.x)], 1u);
    const unsigned gen = old / nloc;
    if (old + 1u == (gen + 1u) * nloc) {
      __builtin_amdgcn_fence(__ATOMIC_RELEASE, "agent");
      asm volatile("s_waitcnt vmcnt(0)" ::: "memory");
      const unsigned og = xb_add(&bar[XB_TOP], 1u);
      const unsigned tg = og / nx;
      if (og + 1u == (tg + 1u) * nx) xb_add(&bar[XB_TOPGEN], 1u);
      else XB_SPIN(xb_ld(&bar[XB_TOPGEN]) == tg, bar);
      __builtin_amdgcn_fence(__ATOMIC_ACQUIRE, "agent");
      xb_add(&bar[XB_XGEN(b.x)], 1u);
      asm volatile("s_waitcnt vmcnt(0)" ::: "memory");
    } else {
      XB_SPIN(xb_ld(&bar[XB_XGEN(b.x)]) == gen, bar);
      __builtin_amdgcn_fence(__ATOMIC_ACQUIRE, "agent");
      asm volatile("s_waitcnt vmcnt(0)" ::: "memory");
    }
  }
  __syncthreads();
}

template <int l>
__device__ __forceinline__ void layer_body(const P& p, char* smem, pg8::PG8_LAS_T lds, volatile LAS unsigned* xbw, const int nb, const int bid) {
    const bool last = (l == 1);
    const int n_mt = last ? 128 : 136;
    if (l == 0) {
      phase_norm(p, l, 0);
      xcd_barrier(p.counters + 1024, xbw);
    }
_Pragma("unroll 1")
    for (int rep = 0; rep < REP_INPROJ; ++rep) {
      pg8::Gemm g; pg8::Order S;
      g.A = (const u16*)p.xn8; g.Bt = (const u16*)(p.Win8 + (size_t)l * 2816 * 1024); g.lda = 512; g.ldb = 512; g.K = 512;
      S.init(136, 6, nb, bid, 4, 5);
      pg8::EpiInprojN8 e1; e1.qk = p.qk; e1.rg = p.rg; e1.sa = p.sa; e1.sw = p.sw + l * 5888;
      pg8::gemm_phase(lds, g, S, e1);
      g.A = (const u16*)(p.Win8 + ((size_t)l * 2816 + 1024) * 1024); g.Bt = (const u16*)p.xn8;
      S.init(5, 136, nb, bid);
      pg8::EpiInprojT8 e2; e2.vT = p.vT; e2.sa = p.sa; e2.sw = p.sw + l * 5888 + 1024;
      pg8::gemm_phase(lds, g, S, e2);
    }
    xcd_barrier(p.counters + 1024, xbw);
    phase_mixers(p, l, smem, p.counters + l * 4);
    xcd_barrier(p.counters + 1024, xbw);
_Pragma("unroll 1")
    for (int rep = 0; rep < REP_2B; ++rep)
      for (int task = bid; task < 1088 + 512; task += nb) {
        if (task < 1088) rg_wave_task(p, l, task >> 2, task & 3, 1, last, smem);
        else yb_transpose_task(p, (task - 1088) >> 6, (task - 1088) & 63, smem);
      }
    xcd_barrier(p.counters + 1024, xbw);
_Pragma("unroll 1")
    for (int rep = 0; rep < REP_GATE; ++rep) {
      pg8::Gemm g; pg8::Order S;
      g.A = (const u16*)p.xn8; g.Bt = (const u16*)(p.Wg8 + (size_t)l * 3072 * 1024); g.lda = 512; g.ldb = 512; g.K = 512;
      S.init(n_mt, 12, nb, bid);
      pg8::EpiGate8 e; e.g8 = p.g8; e.bias = p.b_gate + l * 3072; e.sa = p.sa; e.sw = p.sw + l * 5888 + 2816;
      pg8::gemm_phase(lds, g, S, e);
    }
    xcd_barrier(p.counters + 1024, xbw);
_Pragma("unroll 1")
    for (int rep = 0; rep < REP_BRANCH; ++rep) {
      pg8::Gemm g; pg8::Order S;
      S.init(n_mt, 4, nb, bid);
      pg8::EpiBranch e; e.mbuf = p.mbuf; e.g8 = p.g8;
      g.lda = 1024;
      g.A = p.ycat; g.Bt = p.WaT + (size_t)l * 1024 * 512; g.ldb = 512; g.K = 512; e.br = 0;
      pg8::gemm_phase(lds, g, S, e);
      g.A = p.ycat + 512; g.Bt = p.WbT + (size_t)l * 1024 * 256; g.ldb = 256; g.K = 256; e.br = 1;
      pg8::gemm_phase(lds, g, S, e);
      g.A = p.ycat + 768; g.Bt = p.WcT + (size_t)l * 1024 * 256; g.ldb = 256; g.K = 256; e.br = 2;
      pg8::gemm_phase(lds, g, S, e);
    }
    xcd_barrier(p.counters + 1024, xbw);
    {
      pg8::Gemm g; pg8::Order S;
      g.A = p.mbuf; g.Bt = p.WoT + (size_t)l * 1024 * 1024; g.lda = 1024; g.ldb = 1024; g.K = 1024;
      S.init(n_mt, 4, nb, bid);
      pg8::EpiOut e; e.xsrc = (l == 0 ? p.x : p.out); e.csrc = (l == 0 ? p.ctx : p.ctxs); e.xdst = p.out; e.cdst = p.ctxs;
      e.modl = p.mod + (size_t)l * 9 * 6144;
      pg8::gemm_phase(lds, g, S, e);
      for (int t = bid; t < 8192; t += nb) {
        if (t < 4096) cvt_chunk_fp4(p.peer_u + (size_t)l * 16384 * 1024, p.Ub, (size_t)t, 64.0f, 0);
        else cvt_chunk_fp4(p.peer_v + (size_t)l * 16384 * 1024, p.Ub, (size_t)(t - 4096), 4.0f, 1);
      }
    }
    xcd_barrier(p.counters + 1024, xbw);
    phase_norm(p, l, 1);
    xcd_barrier(p.counters + 1024, xbw);
_Pragma("unroll 1")
    for (int rep = 0; rep < REP_Q; ++rep) {
      pg8::Gemm g; pg8::Order S;
      g.A = p.xn; g.Bt = p.WqkT + (size_t)l * 2048 * 1024; g.lda = 1024; g.ldb = 1024; g.K = 1024;
      S.init(n_mt, 8, nb, bid);
      pg8::EpiQ e; e.q = p.q;
      pg8::gemm_phase(lds, g, S, e);
    }
    xcd_barrier(p.counters + 1024, xbw);
_Pragma("unroll 1")
    for (int rep = 0; rep < REP_SCORE; ++rep)
      for (int task = bid; task < n_mt * 16; task += nb) peer_score_tile(p, l, task >> 4, task & 15, smem);
    xcd_barrier(p.counters + 1024, xbw);
_Pragma("unroll 1")
    for (int rep = 0; rep < REP_PEER; ++rep) phase_peer_experts(p, l, rep == REP_PEER - 1, smem);
    xcd_barrier(p.counters + 1024, xbw);
  }

__global__ void __launch_bounds__(NTHR) fwd_megakernel(P p) {
  __shared__ __attribute__((aligned(16))) char smem[SMEM_BYTES];
  cg::grid_group grid = cg::this_grid();
  const int nb = gridDim.x, bid = blockIdx.x;
  pg8::PG8_LAS_T lds = (pg8::PG8_LAS_T)smem;
  volatile LAS unsigned* xbw = (volatile LAS unsigned*)(smem + SMEM_BYTES - 32);
  if (threadIdx.x == 0) { xbw[0] = 0u; xbw[1] = 0u; xbw[2] = 0u; xbw[3] = 0u; }
  __syncthreads();
  (void)xcd_barrier_post(p.counters + 1024, xbw);

  phase_prep(p, smem, p.counters + 32);
  grid.sync();
  phase_modreduce(p);
  for (int task = blockIdx.x; task < 512; task += gridDim.x) kf_task(p, task >> 8, task & 255, smem);
  for (int task = blockIdx.x; task < 256; task += gridDim.x) wqk_task(p, task >> 7, (task >> 3) & 15, task & 7, smem);
  for (int task = blockIdx.x; task < 2 * 368; task += gridDim.x) {
    const int l = task / 368, t = task - l * 368;
    if (t < 176) tr_tile4<true>(p.w_in + (size_t)l * 1024 * 2816, 2816, 1024, p.Win8 + (size_t)l * 2816 * 1024, t, p.sw + l * 5888, smem);
    else tr_tile4<true>(p.w_gate + (size_t)l * 1024 * 3072, 3072, 1024, p.Wg8 + (size_t)l * 3072 * 1024, t - 176, p.sw + l * 5888 + 2816, smem);
  }
  xcd_barrier(p.counters + 1024, xbw);

  layer_body<0>(p, smem, lds, xbw, nb, bid);
  layer_body<1>(p, smem, lds, xbw, nb, bid);
}

extern "C" void kernel_launch(void* const* d_in, const int* in_sizes, int n_in, void* d_out, int out_size, void* d_ws,
                              size_t ws_size, hipStream_t stream) {
  P p;
  memset(&p, 0, sizeof(p));
  const float** ins = (const float**)&p;
  for (int i = 0; i < 37; ++i) ins[i] = (const float*)d_in[i];
  p.out = (float*)d_out;
  char* w = (char*)d_ws;
  size_t off = 0;
  auto take = [&](size_t bytes) { char* r = w + off; off += (bytes + 255) & ~(size_t)255; return r; };
  p.counters = (unsigned*)take(32768);
  p.WinT = nullptr; p.WgT = nullptr;
  p.Win8 = (unsigned char*)take((size_t)2 * 2816 * 1024);
  p.Wg8 = (unsigned char*)take((size_t)2 * 3072 * 1024);
  p.sw = (float*)take((size_t)2 * 5888 * 4);
  p.xn8 = (unsigned char*)take((size_t)NTOK * 1024);
  p.sa = (float*)take((size_t)NTOK * 4);
  p.WaT = (u16*)take((size_t)2 * 1024 * 512 * 2);
  p.WbT = (u16*)take((size_t)2 * 1024 * 256 * 2);
  p.WcT = (u16*)take((size_t)2 * 1024 * 256 * 2);
  p.WoT = (u16*)take((size_t)2 * 1024 * 1024 * 2);
  p.WqB = (u16*)take((size_t)2 * 1024 * 2048 * 2);
  p.WqkT = (u16*)take((size_t)2 * 2048 * 1024 * 2);
  p.keysB = (u16*)take((size_t)2 * 16 * 16384 * 2);
  p.rgW = (u16*)take((size_t)2 * 16 * 4096 * 2);
  p.modpart = (float*)take((size_t)16 * 2 * 9 * 6144 * 4);
  p.mod = (float*)take((size_t)2 * 9 * 6144 * 4);
  p.hT = (float*)take((size_t)2 * 512 * 4096 * 4);
  p.hc = (float*)take((size_t)512 * 256 * 4);
  p.Kf = (float*)take((size_t)2 * 256 * 8192 * 8);
  p.xn = (u16*)take((size_t)NTOK * 1024 * 2);
  p.qk = (u16*)take((size_t)NTOK * 1024 * 2);
  p.mbuf = p.qk;
  p.vT = (u16*)take((size_t)8 * 512 * 4096 * 2);
  p.vTc = (u16*)take((size_t)8 * 512 * 256 * 2);
  p.hyT = (u16*)take((size_t)8 * 768 * 4096 * 2);
  p.hyTc = (u16*)take((size_t)8 * 768 * 256 * 2);
  p.rg = (u16*)take((size_t)NTOK * 512 * 2);
  p.ycat = (u16*)take((size_t)NTOK * 1024 * 2);
  p.Ub = (unsigned char*)p.ycat;
  p.Vb = p.Ub + (size_t)16384 * 512;
  p.agg = (float*)take((size_t)8 * 2 * (136 + 34) * 256 * 8);
  p.ybT = (u16*)take((size_t)8 * 256 * 4096 * 2);
  p.ctxs = (float*)take((size_t)2048 * 1024 * 4);
  p.g8 = (unsigned char*)p.vT;
  p.q = p.qk;
  p.topk = (unsigned*)((char*)p.qk + (size_t)NTOK * 2048 * 2);
  if (off > ws_size) {
    fprintf(stderr, "workspace too small: need %zu have %zu\n", off, ws_size);
    return;
  }
  static int grid_blocks = 0;
  if (!grid_blocks) {
    int dev = 0, cus = 0, per_cu = 0;
    (void)hipGetDevice(&dev);
    (void)hipDeviceGetAttribute(&cus, hipDeviceAttributeMultiprocessorCount, dev);
    (void)hipOccupancyMaxActiveBlocksPerMultiprocessor(&per_cu, fwd_megakernel, NTHR, 0);
    if (per_cu > 1) per_cu = 1;
    grid_blocks = cus * per_cu;
  }
  (void)hipMemsetAsync(p.counters, 0, 32768, stream);
  void* args[] = {&p};
  hipError_t e = hipLaunchCooperativeKernel((void*)fwd_megakernel, dim3(grid_blocks), dim3(NTHR), args, 0, stream);
  if (e != hipSuccess) fprintf(stderr, "cooperative launch failed: %s (grid %d)\n", hipGetErrorString(e), grid_blocks);
}
```

```cpp
#include <hip/hip_runtime.h>
#include <hip/hip_cooperative_groups.h>
#include <cstdio>
#include <cstring>
namespace cg = cooperative_groups;

typedef unsigned short u16;
typedef __attribute__((ext_vector_type(8))) short bf16x8;
typedef __attribute__((ext_vector_type(16))) float f32x16;
typedef __attribute__((ext_vector_type(2))) float f32x2;
typedef int i32x8 __attribute__((ext_vector_type(8)));

#define NLAT 32768
#define NTOK 34816
#define SMEM_BYTES 151552
#define NTHR 512
#ifndef DUP_1A
#define DUP_1A 1
#endif
#ifndef DUP_PREP
#define DUP_PREP 1
#endif
#ifndef DUP_2B
#define DUP_2B 1
#endif
#ifndef XRGA
#define XRGA 1
#endif
#ifndef REP_PEER
#define REP_PEER 1
#endif
#ifndef REP_INPROJ
#define REP_INPROJ 1
#endif
#ifndef REP_GATE
#define REP_GATE 1
#endif
#ifndef REP_BRANCH
#define REP_BRANCH 1
#endif
#ifndef REP_Q
#define REP_Q 1
#endif
#ifndef REP_SCORE
#define REP_SCORE 1
#endif
#ifndef REP_1A
#define REP_1A 1
#endif
#ifndef REP_2B
#define REP_2B 1
#endif
#ifndef REP_KF
#define REP_KF 1
#endif
#ifndef DUP_GEMM
#define DUP_GEMM 1
#endif
#ifndef DUP_PEER
#define DUP_PEER 1
#endif
#ifndef DUP_MIX
#define DUP_MIX 1
#endif
#ifndef XRG
#define XRG 1
#endif
#ifndef XFFT
#define XFFT 1
#endif
#ifndef XATT
#define XATT 1
#endif

struct P {
  const float *x, *c, *ctx, *c_ctx, *norm_mix_g, *norm_ffn_g, *w_ada, *b_ada, *w_in, *na_rpb,
      *hy_short_w, *hy_short_b, *hy_f1_w, *hy_f1_b, *hy_f2_w, *hy_f2_b, *hy_f3_w, *hy_freq, *hy_bias,
      *rg_conv_w, *rg_conv_b, *rg_wa, *rg_ba, *rg_wx, *rg_bx, *rg_lambda,
      *w_gate, *b_gate, *w_br_a, *w_br_b, *w_br_c, *w_out, *peer_wq, *peer_keys, *peer_u, *peer_v, *final_g;
  float* out;
  unsigned* counters;
  u16 *WinT, *WgT, *WaT, *WbT, *WcT, *WoT, *WqB, *WqkT, *keysB, *rgW;
  float *modpart, *mod, *hT, *hc;
  float* Kf;
  u16 *xn, *qk, *vT, *vTc, *hyT, *hyTc, *rg, *ycat, *mbuf, *ybT;
  unsigned char *Ub, *Vb, *g8, *xn8, *Win8, *Wg8;
  float *sa, *sw;
  u16* q;
  float *agg, *ctxs;
  unsigned* topk;
};

__device__ __forceinline__ u16 f2bf(float f) {
  unsigned u = __float_as_uint(f);
  u += 0x7fffu + ((u >> 16) & 1u);
  return (u16)(u >> 16);
}
__device__ __forceinline__ float bf2f(u16 h) { return __uint_as_float(((unsigned)h) << 16); }
__device__ __forceinline__ unsigned pk2(float a, float b) { return (unsigned)f2bf(a) | ((unsigned)f2bf(b) << 16); }
__device__ __forceinline__ float bflo(unsigned u) { return __uint_as_float(u << 16); }
__device__ __forceinline__ float bfhi(unsigned u) { return __uint_as_float(u & 0xffff0000u); }
__device__ __forceinline__ int opaque_tid() {
  int t = threadIdx.x;
  asm volatile("" : "+v"(t));
  return t;
}
__device__ __forceinline__ int my_lane() { return opaque_tid() & 63; }
__device__ __forceinline__ float shx(float v, int o);
__device__ __forceinline__ float shf(float v, int src) { return __builtin_bit_cast(float, __builtin_amdgcn_ds_bpermute((src & 63) << 2, __builtin_bit_cast(int, v))); }
__device__ __forceinline__ unsigned shu(unsigned v, int src) { return (unsigned)__builtin_amdgcn_ds_bpermute((src & 63) << 2, (int)v); }
typedef unsigned u32x2_t __attribute__((ext_vector_type(2)));
template <int J> __device__ __forceinline__ unsigned xorl(unsigned v, int lane) {
  if constexpr (J == 1) return (unsigned)__builtin_amdgcn_mov_dpp((int)v, 0xB1, 0xF, 0xF, true);
  else if constexpr (J == 2) return (unsigned)__builtin_amdgcn_mov_dpp((int)v, 0x4E, 0xF, 0xF, true);
  else if constexpr (J == 4) {
    const unsigned a = (unsigned)__builtin_amdgcn_mov_dpp((int)v, 0x104, 0xF, 0xF, true);
    const unsigned b = (unsigned)__builtin_amdgcn_mov_dpp((int)v, 0x114, 0xF, 0xF, true);
    return (lane & 4) ? b : a;
  }
  else if constexpr (J == 8) return (unsigned)__builtin_amdgcn_mov_dpp((int)v, 0x128, 0xF, 0xF, true);
  else if constexpr (J == 16) { const u32x2_t r = __builtin_amdgcn_permlane16_swap(v, v, false, false); return (lane & 16) ? r.x : r.y; }
  else { const u32x2_t r = __builtin_amdgcn_permlane32_swap(v, v, false, false); return (lane & 32) ? r.x : r.y; }
}
template <int J> __device__ __forceinline__ float xorf(float v, int lane) { return __uint_as_float(xorl<J>(__float_as_uint(v), lane)); }
__device__ __forceinline__ float shx(float v, int o) {
  const int lane = my_lane();
  switch (o) {
    case 1: return xorf<1>(v, lane);
    case 2: return xorf<2>(v, lane);
    case 4: return xorf<4>(v, lane);
    case 8: return xorf<8>(v, lane);
    case 16: return xorf<16>(v, lane);
    case 32: return xorf<32>(v, lane);
    default: return __builtin_bit_cast(float, __builtin_amdgcn_ds_bpermute(((lane ^ o) << 2), __builtin_bit_cast(int, v)));
  }
}
__device__ __forceinline__ float wave_sum(float v) {
  const int lane = my_lane();
  v += xorf<32>(v, lane); v += xorf<16>(v, lane); v += xorf<8>(v, lane); v += xorf<4>(v, lane); v += xorf<2>(v, lane); v += xorf<1>(v, lane);
  return v;
}
__device__ __forceinline__ float wave_max(float v) {
  const int lane = my_lane();
  v = fmaxf(v, xorf<32>(v, lane)); v = fmaxf(v, xorf<16>(v, lane)); v = fmaxf(v, xorf<8>(v, lane));
  v = fmaxf(v, xorf<4>(v, lane)); v = fmaxf(v, xorf<2>(v, lane)); v = fmaxf(v, xorf<1>(v, lane));
  return v;
}
__device__ __forceinline__ float sigmoidf_(float x) { return __builtin_amdgcn_rcpf(1.0f + __expf(-x)); }
__device__ __forceinline__ float gelu_tanh(float x) {
  const float u2 = 1.5957691216057308f * (x + 0.044715f * x * x * x);
  return x * __builtin_amdgcn_rcpf(1.0f + __expf(-u2));
}
__device__ __forceinline__ f32x16 mfma32(bf16x8 a, bf16x8 b, f32x16 c) {
  return __builtin_amdgcn_mfma_f32_32x32x16_bf16(a, b, c, 0, 0, 0);
}
__device__ __forceinline__ f32x16 zero16() {
  f32x16 z;
#pragma unroll
  for (int i = 0; i < 16; ++i) z[i] = 0.f;
  return z;
}
__device__ __forceinline__ int swz128(int row, int ch) { return row * 128 + ((ch ^ ((row >> 1) & 7)) << 4); }
__device__ __forceinline__ int swz256(int row, int ch) { return row * 256 + ((ch ^ (row & 15)) << 4); }

struct c2 { float x, y; };
__device__ __forceinline__ c2 cadd(c2 a, c2 b) { return {a.x + b.x, a.y + b.y}; }
__device__ __forceinline__ c2 csub(c2 a, c2 b) { return {a.x - b.x, a.y - b.y}; }
__device__ __forceinline__ c2 cmul(c2 a, c2 b) { return {a.x * b.x - a.y * b.y, a.x * b.y + a.y * b.x}; }
__device__ __forceinline__ float c16(int i) {
  const float tb[16] = {1.0f, 0.9238795325112867f, 0.7071067811865476f, 0.3826834323650898f, 0.0f,
                        -0.3826834323650898f, -0.7071067811865476f, -0.9238795325112867f, -1.0f,
                        -0.9238795325112867f, -0.7071067811865476f, -0.3826834323650898f, 0.0f,
                        0.3826834323650898f, 0.7071067811865476f, 0.9238795325112867f};
  return tb[i & 15];
}
__device__ __forceinline__ float s16(int i) { return c16(i + 12); }
template <int R> __device__ __forceinline__ constexpr int brev(int k) {
  int r = 0;
  for (int b = 1, o = R >> 1; b < R; b <<= 1, o >>= 1)
    if (k & b) r |= o;
  return r;
}
template <int R> __device__ __forceinline__ void dft_reg(c2* v, float sgn) {
#pragma unroll
  for (int h = R / 2; h >= 1; h >>= 1) {
#pragma unroll
    for (int g = 0; g < R; g += 2 * h) {
#pragma unroll
      for (int j = 0; j < h; ++j) {
        c2 a = v[g + j], b = v[g + j + h];
        v[g + j] = cadd(a, b);
        c2 d = csub(a, b);
        const int ti = j * (16 / (2 * h));
        c2 w = {c16(ti), sgn * s16(ti)};
        v[g + j + h] = (j == 0) ? d : cmul(d, w);
      }
    }
  }
}
template <int R> __device__ __forceinline__ int fft_bfly(c2* v, int j, int Ns, float sgn) {
  const int k = j & (Ns - 1);
  const float f = sgn * (float)k / (float)(Ns * R);
#pragma unroll
  for (int r = 1; r < R; ++r) {
    float t = f * (float)r;
    c2 w = {__builtin_amdgcn_cosf(t), __builtin_amdgcn_sinf(t)};
    v[r] = cmul(v[r], w);
  }
  dft_reg<R>(v, sgn);
  return (j - k) * R + k;
}
template <int R> __device__ __forceinline__ void fft_pass(c2* buf, int Ns, float sgn) {
  constexpr int NBF = 8192 / R;
  constexpr int PER = NBF / NTHR;
  const int tid = opaque_tid();
  c2 v[PER][R];
#pragma unroll
  for (int i = 0; i < PER; ++i) {
    const int j = tid + NTHR * i;
#pragma unroll
    for (int r = 0; r < R; ++r) v[i][r] = buf[j + r * NBF];
  }
  __syncthreads();
#pragma unroll
  for (int i = 0; i < PER; ++i) {
    const int j = tid + NTHR * i;
    const int base = fft_bfly<R>(v[i], j, Ns, sgn);
#pragma unroll
    for (int r = 0; r < R; ++r) buf[base + r * Ns] = v[i][brev<R>(r)];
  }
  __syncthreads();
}
__device__ __forceinline__ void fft8192(c2* buf, float sgn) {
  fft_pass<8>(buf, 1, sgn);
  fft_pass<8>(buf, 8, sgn);
  fft_pass<8>(buf, 64, sgn);
  fft_pass<16>(buf, 512, sgn);
}

__device__ __forceinline__ void gemm_kloop(f32x16 (&acc)[2][2], const u16* __restrict__ A, int lda,
                                           const u16* __restrict__ B, int ldb, int K, char* smem) {
  const int tid = opaque_tid(), lane = tid & 63, wid = tid >> 6;
  const int wm = wid >> 1, wn = wid & 1;
  const int l31 = lane & 31, hh = lane >> 5;
  uint4 ra[4], rb[2];
  const int nk = K >> 6;
  const int srow = tid >> 3, sch = tid & 7;
  const char* Ab = (const char*)A;
  const char* Bb = (const char*)B;
  const unsigned aoff = (unsigned)(srow * lda + sch * 8) * 2u;
  const unsigned boff = (unsigned)(srow * ldb + sch * 8) * 2u;
  const unsigned astep = (unsigned)lda * 128u, bstep = (unsigned)ldb * 128u;
#pragma unroll
  for (int i = 0; i < 4; ++i) ra[i] = *(const uint4*)(Ab + (aoff + i * astep));
#pragma unroll
  for (int i = 0; i < 2; ++i) rb[i] = *(const uint4*)(Bb + (boff + i * bstep));
#pragma unroll
  for (int i = 0; i < 4; ++i) *(uint4*)(smem + swz128(srow + i * 64, sch)) = ra[i];
#pragma unroll
  for (int i = 0; i < 2; ++i) *(uint4*)(smem + 65536 + swz128(srow + i * 64, sch)) = rb[i];
  __syncthreads();
  for (int kt = 0; kt < nk; ++kt) {
    const bool more = (kt + 1 < nk);
    if (more) {
      const unsigned ko = (unsigned)(kt + 1) * 128u;
#pragma unroll
      for (int i = 0; i < 4; ++i) ra[i] = *(const uint4*)(Ab + (aoff + i * astep + ko));
#pragma unroll
      for (int i = 0; i < 2; ++i) rb[i] = *(const uint4*)(Bb + (boff + i * bstep + ko));
    }
    const char* as = smem + (kt & 1) * 32768;
    const char* bs = smem + 65536 + (kt & 1) * 16384;
    int lrow = l31;
    asm volatile("" : "+v"(lrow));
#pragma unroll
    for (int s = 0; s < 4; ++s) {
      bf16x8 af[2], bfr[2];
#pragma unroll
      for (int i = 0; i < 2; ++i) af[i] = *(const bf16x8*)(as + swz128(wm * 64 + i * 32 + lrow, s * 2 + hh));
#pragma unroll
      for (int j = 0; j < 2; ++j) bfr[j] = *(const bf16x8*)(bs + swz128(wn * 64 + j * 32 + lrow, s * 2 + hh));
#pragma unroll
      for (int i = 0; i < 2; ++i)
#pragma unroll
        for (int j = 0; j < 2; ++j) acc[i][j] = mfma32(af[i], bfr[j], acc[i][j]);
    }
    if (more) {
      char* an = smem + ((kt + 1) & 1) * 32768;
      char* bn = smem + 65536 + ((kt + 1) & 1) * 16384;
      int sr2 = srow;
      asm volatile("" : "+v"(sr2));
#pragma unroll
      for (int i = 0; i < 4; ++i) *(uint4*)(an + swz128(sr2 + i * 64, sch)) = ra[i];
#pragma unroll
      for (int i = 0; i < 2; ++i) *(uint4*)(bn + swz128(sr2 + i * 64, sch)) = rb[i];
    }
    __syncthreads();
  }
}
__device__ __forceinline__ void zero_acc(f32x16 (&acc)[2][2]) {
#pragma unroll
  for (int i = 0; i < 2; ++i)
#pragma unroll
    for (int j = 0; j < 2; ++j) acc[i][j] = zero16();
}
#define EPI_ROW(i, e) (wm * 64 + (i)*32 + ((e)&3) + 8 * ((e) >> 2) + 4 * hh)
#define EPI_COL(j) (wn * 64 + (j)*32 + l31)
#define EPI_VARS                                                    \
  const int tid = opaque_tid(), lane = tid & 63, wid = tid >> 6;     \
  const int wm = wid >> 1, wn = wid & 1, l31 = lane & 31, hh = lane >> 5; \
  (void)tid; (void)wm; (void)wn; (void)l31; (void)hh;


namespace pg8 {
__device__ __forceinline__ unsigned pkh(float a, float b) { unsigned r; asm("v_cvt_pk_bf16_f32 %0, %1, %2" : "=v"(r) : "v"(a), "v"(b)); return r; }
#define PG8_LAS __attribute__((address_space(3)))
typedef PG8_LAS unsigned char* PG8_LAS_T;
typedef float f32x4 __attribute__((ext_vector_type(4)));
typedef unsigned u32x4 __attribute__((ext_vector_type(4)));
typedef int i32x4 __attribute__((ext_vector_type(4)));
constexpr int BM = 256, BK = 64, HALF = 128, HTB = HALF * BK * 2, STAGE_BYTES = 8 * HTB, NXCD = 8, WGM = 8;
__device__ __forceinline__ int lds_byte(int r, int c) { const int st = (r >> 4) * 2 + (c >> 5), rr = r & 15, cc = c & 31, ob = rr * 64 + cc * 2; return st * 1024 + (ob ^ (((ob >> 9) & 1) << 5)); }
__device__ __forceinline__ void stage_rc(int b, int& R, int& C) { const int st = b / 1024, sb = b % 1024, swz = sb ^ (((sb >> 9) & 1) << 5); R = (st >> 1) * 16 + swz / 64; C = (st & 1) * 32 + (swz % 64) / 2; }
__device__ __forceinline__ int perm32(int rho) { const int n = rho >> 4, i = rho & 15; return 8 * (i >> 2) + 4 * n + (i & 3); }
struct Unit { int pm, pn; };
struct Gemm { const u16* A; const u16* Bt; int lda, ldb, K; };
struct Order {
  int nM, nN, nwg, G, c, skip_from, skip_by;
  __device__ __forceinline__ void init(int nM_, int nN_, int G_, int c_, int sf = 1 << 30, int sb = 0) { nM = nM_; nN = nN_; nwg = nM * nN; G = G_; c = c_; skip_from = sf; skip_by = sb; }
  __device__ __forceinline__ bool next(int i, Unit& u) const {
    const long L = (long)i * G + c; if (L >= nwg) return false;
    int wgid = (int)L; { const int q = nwg / NXCD, r = nwg % NXCD, xcd = wgid % NXCD, off = wgid / NXCD; wgid = (xcd < r ? xcd * (q + 1) : r * (q + 1) + (xcd - r) * q) + off; }
    const int nig = WGM * nN, gid = wgid / nig, fm = gid * WGM, gsz = (nM - fm) < WGM ? (nM - fm) : WGM;
    u.pm = fm + ((wgid % nig) % gsz); u.pn = (wgid % nig) / gsz;
    if (u.pn >= skip_from) u.pn += skip_by;
    return true;
  }
};
__device__ __forceinline__ f32x4 mma16(bf16x8 a, bf16x8 b, f32x4 c) { return __builtin_amdgcn_mfma_f32_16x16x32_bf16(a, b, c, 0, 0, 0); }
__device__ __forceinline__ i32x4 mma16(bf16x8 a, bf16x8 b, i32x4 c) { return __builtin_amdgcn_mfma_i32_16x16x64_i8(__builtin_bit_cast(i32x4, a), __builtin_bit_cast(i32x4, b), c, 0, 0, 0); }
template <class Epi>
__device__ __forceinline__ void gemm_phase(PG8_LAS unsigned char* lds, const Gemm g, const Order& S, const Epi& E) {
  const int tid = opaque_tid(), wid = __builtin_amdgcn_readfirstlane(tid >> 6), lane = tid & 63, wr = wid >> 2, wc = wid & 3, fr = lane & 15, fq = lane >> 4;
  const int K = g.K, nt = K / BK;
  unsigned voffA[2], voffB[2];
#pragma unroll
  for (int i = 0; i < 2; ++i) { int R, C; stage_rc(tid * 16 + i * 8192, R, C); const int Rb = Epi::PERM ? ((R & ~31) + perm32(R & 31)) : R;
    voffA[i] = (unsigned)(R * g.lda + C) * 2u; voffB[i] = (unsigned)(Rb * g.ldb + C) * 2u; }
  const size_t kstep = (size_t)(BK * 2);
  const size_t hstepA = (size_t)HALF * g.lda * 2, hstepB = (size_t)HALF * g.ldb * 2;
  const size_t tstepA = 2 * hstepA, tstepB = 2 * hstepB;
  const unsigned ldsw = (unsigned)wid * 1024u;
  const int aoff = lds_byte(wr * 64 + fr, fq * 8), boff = lds_byte(wc * 32 + fr, fq * 8);
#define PG8_SA(b, h) (((b) * 2 + (h)) * HTB)
#define PG8_SB(b, h) ((4 + (b) * 2 + (h)) * HTB)
#define PG8_STAGE(bufoff, gbase, voff) do { _Pragma("unroll") for (int _i = 0; _i < 2; ++_i) \
    __builtin_amdgcn_global_load_lds((const unsigned*)((const char*)(gbase) + (voff)[_i]), (PG8_LAS unsigned*)(lds + (bufoff) + ldsw + _i * 8192), 16, 0, 0); } while (0)
#define PG8_LDA(dst, b, h) do { _Pragma("unroll") for (int m = 0; m < 4; ++m) _Pragma("unroll") for (int k = 0; k < 2; ++k) dst[m][k] = *(const PG8_LAS bf16x8*)(lds + PG8_SA(b, h) + aoff + m * 2048 + k * 1024); } while (0)
#define PG8_LDB(dst, b, h) do { _Pragma("unroll") for (int n = 0; n < 2; ++n) _Pragma("unroll") for (int k = 0; k < 2; ++k) dst[n][k] = *(const PG8_LAS bf16x8*)(lds + PG8_SB(b, h) + boff + n * 2048 + k * 1024); } while (0)
#define PG8_MMA(ai, bj, At, Bt) do { __builtin_amdgcn_s_setprio(1); _Pragma("unroll") for (int m = 0; m < 4; ++m) _Pragma("unroll") for (int n = 0; n < 2; ++n) _Pragma("unroll") for (int k = 0; k < 2; ++k) \
    acc[ai][bj][m][n] = mma16(Bt[n][k], At[m][k], acc[ai][bj][m][n]); __builtin_amdgcn_s_setprio(0); } while (0)
#define PG8_WAIT_V(n) asm volatile("s_waitcnt vmcnt(" #n ")" ::: "memory")
#define PG8_WAIT_L(n) asm volatile("s_waitcnt lgkmcnt(" #n ")" ::: "memory")
#define PG8_BAR __builtin_amdgcn_s_barrier()
#define PG8_SCHED __builtin_amdgcn_sched_barrier(0)
  Unit cur, nxt; int ui = 0;
  if (!S.next(0, cur)) return;
  typedef typename Epi::acc_t acc_t;
  acc_t acc[2][2][4][2];
#pragma unroll
  for (int a = 0; a < 2; ++a)
#pragma unroll
    for (int b = 0; b < 2; ++b)
#pragma unroll
      for (int m = 0; m < 4; ++m)
#pragma unroll
        for (int n = 0; n < 2; ++n) acc[a][b][m][n] = (acc_t){0, 0, 0, 0};
  bf16x8 At[4][2], B0[2][2], B1[2][2];
  const char* cA = (const char*)g.A + (size_t)cur.pm * tstepA; const char* cB = (const char*)g.Bt + (size_t)cur.pn * tstepB;
  PG8_STAGE(PG8_SB(0, 0), cB, voffB); PG8_STAGE(PG8_SA(0, 0), cA, voffA); PG8_STAGE(PG8_SB(0, 1), cB + hstepB, voffB); PG8_STAGE(PG8_SA(0, 1), cA + hstepA, voffA);
  if (wr == 1) PG8_BAR;
  PG8_WAIT_V(4); PG8_BAR;
  PG8_STAGE(PG8_SB(1, 0), cB + kstep, voffB); PG8_STAGE(PG8_SA(1, 0), cA + kstep, voffA); PG8_STAGE(PG8_SB(1, 1), cB + hstepB + kstep, voffB);
  PG8_WAIT_V(6); PG8_BAR;
  for (;;) {
    const bool has_next = S.next(ui + 1, nxt);
    const char* nA = has_next ? (const char*)g.A + (size_t)nxt.pm * tstepA : cA; const char* nB = has_next ? (const char*)g.Bt + (size_t)nxt.pn * tstepB : cB;
    for (int t = 0; t < nt; t += 2) {
      const bool last = (t == nt - 2);
      const char* a1 = cA + (size_t)(t + 1) * kstep;
      const char* a2 = last ? nA : cA + (size_t)(t + 2) * kstep; const char* b2 = last ? nB : cB + (size_t)(t + 2) * kstep;
      const char* a3 = a2 + kstep; const char* b3 = b2 + kstep;
      PG8_LDB(B0, 0, 0); PG8_SCHED; PG8_LDA(At, 0, 0); PG8_STAGE(PG8_SA(1, 1), a1 + hstepA, voffA);
      PG8_WAIT_L(8); PG8_BAR; PG8_WAIT_L(0); PG8_MMA(0, 0, At, B0); PG8_BAR; PG8_SCHED;
      PG8_LDB(B1, 0, 1); PG8_STAGE(PG8_SB(0, 0), b2, voffB);
      PG8_BAR; PG8_WAIT_L(0); PG8_MMA(0, 1, At, B1); PG8_BAR;
      PG8_LDA(At, 0, 1); PG8_STAGE(PG8_SA(0, 0), a2, voffA);
      PG8_BAR; PG8_WAIT_L(0); PG8_MMA(1, 0, At, B0); PG8_BAR; PG8_SCHED;
      PG8_STAGE(PG8_SB(0, 1), b2 + hstepB, voffB);
      PG8_WAIT_V(6); PG8_BAR; PG8_MMA(1, 1, At, B1); PG8_BAR;
      PG8_LDB(B0, 1, 0); PG8_SCHED; PG8_LDA(At, 1, 0); PG8_STAGE(PG8_SA(0, 1), a2 + hstepA, voffA);
      PG8_WAIT_L(8); PG8_BAR; PG8_WAIT_L(0); PG8_MMA(0, 0, At, B0); PG8_BAR; PG8_SCHED;
      PG8_LDB(B1, 1, 1); PG8_STAGE(PG8_SB(1, 0), b3, voffB);
      PG8_BAR; PG8_WAIT_L(0); PG8_MMA(0, 1, At, B1); PG8_BAR;
      PG8_LDA(At, 1, 1); PG8_STAGE(PG8_SA(1, 0), a3, voffA);
      PG8_BAR; PG8_WAIT_L(0); PG8_MMA(1, 0, At, B0); PG8_BAR; PG8_SCHED;
      PG8_STAGE(PG8_SB(1, 1), b3 + hstepB, voffB);
      PG8_WAIT_V(6); PG8_BAR; PG8_MMA(1, 1, At, B1); PG8_BAR;
    }
    E(acc, cur, wr, wc, fr, fq);
    if (!has_next) break;
#pragma unroll
    for (int a = 0; a < 2; ++a)
#pragma unroll
      for (int b = 0; b < 2; ++b)
#pragma unroll
        for (int m = 0; m < 4; ++m)
#pragma unroll
          for (int n = 0; n < 2; ++n) acc[a][b][m][n] = (acc_t){0, 0, 0, 0};
    cur = nxt; cA = nA; cB = nB; ++ui;
  }
  PG8_WAIT_V(0);
  if (wr == 0) PG8_BAR;
  PG8_BAR;
#undef PG8_SA
#undef PG8_SB
#undef PG8_STAGE
#undef PG8_LDA
#undef PG8_LDB
#undef PG8_MMA
#undef PG8_WAIT_V
#undef PG8_WAIT_L
#undef PG8_BAR
#undef PG8_SCHED
}
typedef const f32x4 (&AccRef)[2][2][4][2];
typedef const i32x4 (&AccRefI)[2][2][4][2];
struct EpiInprojN {
  static constexpr bool PERM = true;
  typedef f32x4 acc_t;
  u16* qk; u16* rg;
  __device__ __forceinline__ void operator()(AccRef acc, const Unit& u, int wr, int wc, int fr, int fq) const {
    const int row0 = u.pm * BM + wr * 64 + fr;
    u16* base; int ld, colt;
    if (u.pn < 4) { base = qk; ld = 1024; colt = u.pn * 256; } else { base = rg; ld = 512; colt = (u.pn - 9) * 256; }
    const int col0 = colt + wc * 32 + 8 * fq;
#pragma unroll
    for (int ai = 0; ai < 2; ++ai)
#pragma unroll
      for (int m = 0; m < 4; ++m) {
        u16* rowp = base + (size_t)(row0 + ai * HALF + m * 16) * ld + col0;
#pragma unroll
        for (int bj = 0; bj < 2; ++bj) {
          const f32x4 v0 = acc[ai][bj][m][0], v1 = acc[ai][bj][m][1];
          u32x4 w; w.x = pkh(v0[0], v0[1]); w.y = pkh(v0[2], v0[3]); w.z = pkh(v1[0], v1[1]); w.w = pkh(v1[2], v1[3]);
          *(u32x4*)(rowp + bj * HALF) = w;
        }
      }
  }
};
struct EpiInprojT {
  static constexpr bool PERM = true;
  typedef f32x4 acc_t;
  u16 *vT, *vTc, *hyT, *hyTc;
  __device__ __forceinline__ void operator()(AccRef acc, const Unit& u, int wr, int wc, int fr, int fq) const {
    const bool isctx = (u.pn >= 128);
    const int b = isctx ? (u.pn - 128) : (u.pn >> 4);
    const int Lseg = isctx ? 256 : 4096, t0 = isctx ? 0 : (u.pn & 15) * 256;
    const bool isv = (u.pm < 2);
    const size_t boff = isv ? (isctx ? (size_t)16777216 : (size_t)0) : (isctx ? (size_t)(16777216 + 1048576 + 25165824) : (size_t)(16777216 + 1048576));
    u16* base = vT + boff;
    const int nc = isv ? 512 : 768;
    const int wrow0 = (isv ? u.pm : u.pm - 2) * BM + wr * 64 + fr;
    const int col0 = t0 + wc * 32 + 8 * fq;
#pragma unroll
    for (int ai = 0; ai < 2; ++ai)
#pragma unroll
      for (int m = 0; m < 4; ++m) {
        u16* rowp = base + ((size_t)(b * nc + wrow0 + ai * HALF + m * 16)) * Lseg + col0;
#pragma unroll
        for (int bj = 0; bj < 2; ++bj) {
          const f32x4 v0 = acc[ai][bj][m][0], v1 = acc[ai][bj][m][1];
          u32x4 w; w.x = pkh(v0[0], v0[1]); w.y = pkh(v0[2], v0[3]); w.z = pkh(v1[0], v1[1]); w.w = pkh(v1[2], v1[3]);
          *(u32x4*)(rowp + bj * HALF) = w;
        }
      }
  }
};
struct EpiGate {
  static constexpr bool PERM = true;
  typedef f32x4 acc_t;
  unsigned char* g8; const float* bias;
  __device__ __forceinline__ void operator()(AccRef acc, const Unit& u, int wr, int wc, int fr, int fq) const {
    const int row0 = u.pm * BM + wr * 64 + fr;
    const int col0 = u.pn * BM + wc * 32 + 8 * fq;
#pragma unroll
    for (int bj = 0; bj < 2; ++bj) {
      const f32x4 b0 = *(const f32x4*)(bias + col0 + bj * HALF), b1 = *(const f32x4*)(bias + col0 + bj * HALF + 4);
#pragma unroll
      for (int ai = 0; ai < 2; ++ai)
#pragma unroll
        for (int m = 0; m < 4; ++m) {
          const f32x4 v0 = acc[ai][bj][m][0] + b0, v1 = acc[ai][bj][m][1] + b1;
          unsigned w0 = 0, w1 = 0;
#pragma unroll
          for (int k = 0; k < 4; ++k) {
            w0 |= (unsigned)(sigmoidf_(v0[k]) * 255.0f + 0.5f) << (8 * k);
            w1 |= (unsigned)(sigmoidf_(v1[k]) * 255.0f + 0.5f) << (8 * k);
          }
          *(uint2*)(g8 + (size_t)(row0 + ai * HALF + m * 16) * 3072 + col0 + bj * HALF) = make_uint2(w0, w1);
        }
    }
  }
};
struct EpiBranch {
  static constexpr bool PERM = true;
  typedef f32x4 acc_t;
  u16* mbuf; const unsigned char* g8; int br;
  __device__ __forceinline__ void operator()(AccRef acc, const Unit& u, int wr, int wc, int fr, int fq) const {
    const int row0 = u.pm * BM + wr * 64 + fr;
    const int col0 = u.pn * BM + wc * 32 + 8 * fq;
    uint2 gq[2][2][2];
    u32x4 o[2][2][2];
#define EB_LOAD(G) do { _Pragma("unroll") for (int j = 0; j < 2; ++j) _Pragma("unroll") for (int bj = 0; bj < 2; ++bj) { \
      const size_t row = (size_t)(row0 + (((G) * 2 + j) >> 2) * HALF + (((G) * 2 + j) & 3) * 16); \
      gq[(G) & 1][j][bj] = *(const uint2*)(g8 + row * 3072 + br * 1024 + col0 + bj * HALF); \
      if (br != 0) o[(G) & 1][j][bj] = *(const u32x4*)(mbuf + row * 1024 + col0 + bj * HALF); } } while (0)
    EB_LOAD(0);
#pragma unroll
    for (int G = 0; G < 4; ++G) {
      if (G < 3) EB_LOAD(G + 1);
#pragma unroll
      for (int j = 0; j < 2; ++j) {
        const int ai = (G * 2 + j) >> 2, m = (G * 2 + j) & 3;
        const size_t row = (size_t)(row0 + ai * HALF + m * 16);
#pragma unroll
        for (int bj = 0; bj < 2; ++bj) {
          const uint2 g = gq[G & 1][j][bj];
          u16* mp = mbuf + row * 1024 + col0 + bj * HALF;
          const f32x4 v0 = acc[ai][bj][m][0], v1 = acc[ai][bj][m][1];
          float r[8];
          r[0] = (float)(g.x & 255u) * v0[0]; r[1] = (float)((g.x >> 8) & 255u) * v0[1];
          r[2] = (float)((g.x >> 16) & 255u) * v0[2]; r[3] = (float)(g.x >> 24) * v0[3];
          r[4] = (float)(g.y & 255u) * v1[0]; r[5] = (float)((g.y >> 8) & 255u) * v1[1];
          r[6] = (float)((g.y >> 16) & 255u) * v1[2]; r[7] = (float)(g.y >> 24) * v1[3];
          u32x4 w;
          if (br == 0) {
            w.x = pkh(r[0] * (1.f / 255.f), r[1] * (1.f / 255.f)); w.y = pkh(r[2] * (1.f / 255.f), r[3] * (1.f / 255.f));
            w.z = pkh(r[4] * (1.f / 255.f), r[5] * (1.f / 255.f)); w.w = pkh(r[6] * (1.f / 255.f), r[7] * (1.f / 255.f));
          } else {
            const u32x4 ov = o[G & 1][j][bj];
            w.x = pkh(bflo(ov.x) + r[0] * (1.f / 255.f), bfhi(ov.x) + r[1] * (1.f / 255.f));
            w.y = pkh(bflo(ov.y) + r[2] * (1.f / 255.f), bfhi(ov.y) + r[3] * (1.f / 255.f));
            w.z = pkh(bflo(ov.z) + r[4] * (1.f / 255.f), bfhi(ov.z) + r[5] * (1.f / 255.f));
            w.w = pkh(bflo(ov.w) + r[6] * (1.f / 255.f), bfhi(ov.w) + r[7] * (1.f / 255.f));
          }
          *(u32x4*)mp = w;
        }
      }
    }
#undef EB_LOAD
  }
};
struct EpiOut {
  static constexpr bool PERM = false;
  typedef f32x4 acc_t;
  const float *xsrc, *csrc; float *xdst, *cdst; const float* modl;
  __device__ __forceinline__ void operator()(AccRef acc, const Unit& u, int wr, int wc, int fr, int fq) const {
    const bool isctx = (u.pm >= 128);
    const int bi = isctx ? 8 : (u.pm >> 4);
    const float* gatev = modl + ((size_t)bi * 6 + 2) * 1024;
    const float* src = isctx ? (csrc - (size_t)NLAT * 1024) : xsrc;
    float* dst = isctx ? (cdst - (size_t)NLAT * 1024) : xdst;
    const int row0 = u.pm * BM + wr * 64 + fr, col0 = u.pn * BM + wc * 32 + 4 * fq;
    f32x4 gv[4], xv[2][4];
#pragma unroll
    for (int g = 0; g < 4; ++g) gv[g] = *(const f32x4*)(gatev + col0 + (g >> 1) * HALF + (g & 1) * 16);
#define EO_LOAD(G) do { _Pragma("unroll") for (int m = 0; m < 4; ++m) \
      xv[(G) & 1][m] = *(const f32x4*)(src + (size_t)(row0 + ((G) & 1) * HALF + m * 16) * 1024 + col0 + ((G) >> 2) * HALF + (((G) >> 1) & 1) * 16); } while (0)
    EO_LOAD(0);
#pragma unroll
    for (int G = 0; G < 8; ++G) {
      const int bj = G >> 2, n = (G >> 1) & 1, ai = G & 1;
      if (G < 7) EO_LOAD(G + 1);
#pragma unroll
      for (int m = 0; m < 4; ++m) {
        const size_t o = (size_t)(row0 + ai * HALF + m * 16) * 1024 + col0 + bj * HALF + n * 16;
        *(f32x4*)(dst + o) = xv[G & 1][m] + gv[bj * 2 + n] * acc[ai][bj][m][n];
      }
    }
#undef EO_LOAD
  }
};
struct EpiQ {
  static constexpr bool PERM = true;
  typedef f32x4 acc_t;
  u16* q;
  __device__ __forceinline__ void operator()(AccRef acc, const Unit& u, int wr, int wc, int fr, int fq) const {
    const int row0 = u.pm * BM + wr * 64 + fr;
    const int col0 = u.pn * BM + wc * 32 + 8 * fq;
#pragma unroll
    for (int ai = 0; ai < 2; ++ai)
#pragma unroll
      for (int m = 0; m < 4; ++m) {
        u16* rowp = q + (size_t)(row0 + ai * HALF + m * 16) * 2048 + col0;
#pragma unroll
        for (int bj = 0; bj < 2; ++bj) {
          const f32x4 v0 = acc[ai][bj][m][0], v1 = acc[ai][bj][m][1];
          u32x4 w;
          w.x = __builtin_bit_cast(unsigned, __builtin_amdgcn_cvt_pkrtz(v0[0], v0[1]));
          w.y = __builtin_bit_cast(unsigned, __builtin_amdgcn_cvt_pkrtz(v0[2], v0[3]));
          w.z = __builtin_bit_cast(unsigned, __builtin_amdgcn_cvt_pkrtz(v1[0], v1[1]));
          w.w = __builtin_bit_cast(unsigned, __builtin_amdgcn_cvt_pkrtz(v1[2], v1[3]));
          *(u32x4*)(rowp + bj * HALF) = w;
        }
      }
  }
};
struct EpiInprojN8 {
  static constexpr bool PERM = true;
  typedef i32x4 acc_t;
  u16* qk; u16* rg; const float* sa; const float* sw;
  __device__ __forceinline__ void operator()(AccRefI acc, const Unit& u, int wr, int wc, int fr, int fq) const {
    const int row0 = u.pm * BM + wr * 64 + fr;
    u16* base; int ld, colt;
    if (u.pn < 4) { base = qk; ld = 1024; colt = u.pn * 256; } else { base = rg; ld = 512; colt = (u.pn - 9) * 256; }
    const int col0 = colt + wc * 32 + 8 * fq;
    const int wcol0 = u.pn * 256 + wc * 32 + 8 * fq;
    float rs[8];
    f32x4 cs[2][2];
#pragma unroll
    for (int i = 0; i < 8; ++i) rs[i] = sa[row0 + (i >> 2) * HALF + (i & 3) * 16];
#pragma unroll
    for (int bj = 0; bj < 2; ++bj) { cs[bj][0] = *(const f32x4*)(sw + wcol0 + bj * HALF); cs[bj][1] = *(const f32x4*)(sw + wcol0 + bj * HALF + 4); }
#pragma unroll
    for (int bj = 0; bj < 2; ++bj) {
      const f32x4 c0 = cs[bj][0], c1 = cs[bj][1];
#pragma unroll
      for (int ai = 0; ai < 2; ++ai)
#pragma unroll
        for (int m = 0; m < 4; ++m) {
          const int row = row0 + ai * HALF + m * 16;
          const float r = rs[ai * 4 + m];
          const i32x4 a0 = acc[ai][bj][m][0], a1 = acc[ai][bj][m][1];
          u32x4 w;
          w.x = pkh((float)a0[0] * r * c0[0], (float)a0[1] * r * c0[1]); w.y = pkh((float)a0[2] * r * c0[2], (float)a0[3] * r * c0[3]);
          w.z = pkh((float)a1[0] * r * c1[0], (float)a1[1] * r * c1[1]); w.w = pkh((float)a1[2] * r * c1[2], (float)a1[3] * r * c1[3]);
          *(u32x4*)(base + (size_t)row * ld + col0 + bj * HALF) = w;
        }
    }
  }
};
struct EpiInprojT8 {
  static constexpr bool PERM = true;
  typedef i32x4 acc_t;
  u16* vT; const float* sa; const float* sw;
  __device__ __forceinline__ void operator()(AccRefI acc, const Unit& u, int wr, int wc, int fr, int fq) const {
    const bool isctx = (u.pn >= 128);
    const int b = isctx ? (u.pn - 128) : (u.pn >> 4);
    const int Lseg = isctx ? 256 : 4096, t0 = isctx ? 0 : (u.pn & 15) * 256;
    const bool isv = (u.pm < 2);
    const size_t boff = isv ? (isctx ? (size_t)16777216 : (size_t)0) : (isctx ? (size_t)(16777216 + 1048576 + 25165824) : (size_t)(16777216 + 1048576));
    u16* base = vT + boff;
    const int nc = isv ? 512 : 768;
    const int wrow0 = (isv ? u.pm : u.pm - 2) * BM + wr * 64 + fr;
    const int srow0 = u.pm * BM + wr * 64 + fr;
    const int col0 = t0 + wc * 32 + 8 * fq;
    const int tok0 = u.pn * BM + wc * 32 + 8 * fq;
    float rs[8];
    f32x4 cs[2][2];
#pragma unroll
    for (int i = 0; i < 8; ++i) rs[i] = sw[srow0 + (i >> 2) * HALF + (i & 3) * 16];
#pragma unroll
    for (int bj = 0; bj < 2; ++bj) { cs[bj][0] = *(const f32x4*)(sa + tok0 + bj * HALF); cs[bj][1] = *(const f32x4*)(sa + tok0 + bj * HALF + 4); }
#pragma unroll
    for (int bj = 0; bj < 2; ++bj) {
      const f32x4 c0 = cs[bj][0], c1 = cs[bj][1];
#pragma unroll
      for (int ai = 0; ai < 2; ++ai)
#pragma unroll
        for (int m = 0; m < 4; ++m) {
          const float r = rs[ai * 4 + m];
          const i32x4 a0 = acc[ai][bj][m][0], a1 = acc[ai][bj][m][1];
          u32x4 w;
          w.x = pkh((float)a0[0] * r * c0[0], (float)a0[1] * r * c0[1]); w.y = pkh((float)a0[2] * r * c0[2], (float)a0[3] * r * c0[3]);
          w.z = pkh((float)a1[0] * r * c1[0], (float)a1[1] * r * c1[1]); w.w = pkh((float)a1[2] * r * c1[2], (float)a1[3] * r * c1[3]);
          *(u32x4*)(base + ((size_t)(b * nc + wrow0 + ai * HALF + m * 16)) * Lseg + col0 + bj * HALF) = w;
        }
    }
  }
};
struct EpiGate8 {
  static constexpr bool PERM = true;
  typedef i32x4 acc_t;
  unsigned char* g8; const float* bias; const float* sa; const float* sw;
  __device__ __forceinline__ void operator()(AccRefI acc, const Unit& u, int wr, int wc, int fr, int fq) const {
    const int row0 = u.pm * BM + wr * 64 + fr;
    const int col0 = u.pn * BM + wc * 32 + 8 * fq;
    float rs[8];
    f32x4 bs[2][2], cs[2][2];
#pragma unroll
    for (int i = 0; i < 8; ++i) rs[i] = sa[row0 + (i >> 2) * HALF + (i & 3) * 16];
#pragma unroll
    for (int bj = 0; bj < 2; ++bj) {
      bs[bj][0] = *(const f32x4*)(bias + col0 + bj * HALF); bs[bj][1] = *(const f32x4*)(bias + col0 + bj * HALF + 4);
      cs[bj][0] = *(const f32x4*)(sw + col0 + bj * HALF); cs[bj][1] = *(const f32x4*)(sw + col0 + bj * HALF + 4);
    }
#pragma unroll
    for (int bj = 0; bj < 2; ++bj) {
      const f32x4 b0 = bs[bj][0], b1 = bs[bj][1], c0 = cs[bj][0], c1 = cs[bj][1];
#pragma unroll
      for (int ai = 0; ai < 2; ++ai)
#pragma unroll
        for (int m = 0; m < 4; ++m) {
          const int row = row0 + ai * HALF + m * 16;
          const float r = rs[ai * 4 + m];
          const i32x4 a0 = acc[ai][bj][m][0], a1 = acc[ai][bj][m][1];
          unsigned w0 = 0, w1 = 0;
#pragma unroll
          for (int k = 0; k < 4; ++k) {
            w0 |= (unsigned)(sigmoidf_((float)a0[k] * r * c0[k] + b0[k]) * 255.0f + 0.5f) << (8 * k);
            w1 |= (unsigned)(sigmoidf_((float)a1[k] * r * c1[k] + b1[k]) * 255.0f + 0.5f) << (8 * k);
          }
          *(uint2*)(g8 + (size_t)row * 3072 + col0 + bj * HALF) = make_uint2(w0, w1);
        }
    }
  }
};
}

__device__ __forceinline__ void tr_tile(const float* __restrict__ src, int N, int K, u16* __restrict__ dst, int tile, char* smem) {
  float* lds = (float*)smem;
  const int tiles_n = N >> 6;
  const int tk = tile / tiles_n, tn = tile - tk * tiles_n;
  const int tid = opaque_tid();
  {
    const int r = tid >> 3, c8 = (tid & 7) * 8;
    const float* s = src + (size_t)(tk * 64 + r) * N + tn * 64 + c8;
    float4 a = *(const float4*)s, b = *(const float4*)(s + 4);
    float* d = lds + r * 65 + c8;
    d[0] = a.x; d[1] = a.y; d[2] = a.z; d[3] = a.w; d[4] = b.x; d[5] = b.y; d[6] = b.z; d[7] = b.w;
  }
  __syncthreads();
  {
    const int n = tid >> 3, k0 = (tid & 7) * 8;
    uint4 o;
    o.x = pk2(lds[(k0 + 0) * 65 + n], lds[(k0 + 1) * 65 + n]);
    o.y = pk2(lds[(k0 + 2) * 65 + n], lds[(k0 + 3) * 65 + n]);
    o.z = pk2(lds[(k0 + 4) * 65 + n], lds[(k0 + 5) * 65 + n]);
    o.w = pk2(lds[(k0 + 6) * 65 + n], lds[(k0 + 7) * 65 + n]);
    *(uint4*)(dst + (size_t)(tn * 64 + n) * K + tk * 64 + k0) = o;
  }
  __syncthreads();
}
__device__ __forceinline__ void colmax_task(const float* __restrict__ w, int N, int n0, float* __restrict__ swp, char* smem) {
  const int tid = opaque_tid();
  const int col = tid & 63, kg = tid >> 6;
  float m = 0.f;
  const float* wp = w + (size_t)(kg * 128) * N + n0 + col;
#pragma unroll 16
  for (int k = 0; k < 128; ++k) m = fmaxf(m, fabsf(wp[(size_t)k * N]));
  float* red = (float*)smem;
  red[kg * 64 + col] = m;
  __syncthreads();
  if (tid < 64) {
    float mm = red[tid];
#pragma unroll
    for (int g = 1; g < 8; ++g) mm = fmaxf(mm, red[g * 64 + tid]);
    swp[n0 + tid] = fmaxf(mm, 1e-20f) * (1.0f / 127.0f);
  }
  __syncthreads();
}
__device__ __forceinline__ void tr_tile_i8(const float* __restrict__ src, int N, int K, unsigned char* __restrict__ dst, int tile, const float* __restrict__ swp, char* smem) {
  float* lds = (float*)smem;
  const int tiles_n = N >> 6;
  const int tk = tile / tiles_n, tn = tile - tk * tiles_n;
  const int tid = opaque_tid();
  {
    const int r = tid >> 3, c8 = (tid & 7) * 8;
    const float* sp = src + (size_t)(tk * 64 + r) * N + tn * 64 + c8;
    float4 a = *(const float4*)sp, b = *(const float4*)(sp + 4);
    float* d = lds + r * 65 + c8;
    d[0] = a.x; d[1] = a.y; d[2] = a.z; d[3] = a.w; d[4] = b.x; d[5] = b.y; d[6] = b.z; d[7] = b.w;
  }
  __syncthreads();
  {
    const int n = tid >> 3, k0 = (tid & 7) * 8;
    const float inv = 1.0f / swp[tn * 64 + n];
    unsigned w0 = 0, w1 = 0;
#pragma unroll
    for (int i = 0; i < 4; ++i) {
      w0 |= ((unsigned)__float2int_rn(lds[(k0 + i) * 65 + n] * inv) & 255u) << (8 * i);
      w1 |= ((unsigned)__float2int_rn(lds[(k0 + 4 + i) * 65 + n] * inv) & 255u) << (8 * i);
    }
    *(uint2*)(dst + (size_t)(tn * 64 + n) * K + tk * 64 + k0) = make_uint2(w0, w1);
  }
  __syncthreads();
}
__device__ __forceinline__ void cvt_chunk(const float* __restrict__ src, u16* __restrict__ dst, size_t chunk) {
  const size_t i = chunk * 4096 + (size_t)opaque_tid() * 8;
  float4 a = *(const float4*)(src + i), b = *(const float4*)(src + i + 4);
  uint4 o;
  o.x = pk2(a.x, a.y); o.y = pk2(a.z, a.w); o.z = pk2(b.x, b.y); o.w = pk2(b.z, b.w);
  *(uint4*)(dst + i) = o;
}
template <bool I8>
__device__ __forceinline__ void tr_tile4(const float* __restrict__ src, int N, int K, void* __restrict__ dstv, int tile4, const float* __restrict__ swp, char* smem) {
  float* lds = (float*)smem;
  const int tiles_n = N >> 6;
  const int tkq = tile4 / tiles_n, tn = tile4 - tkq * tiles_n;
  const int tid = opaque_tid();
  {
    const int r = tid >> 3, c8 = (tid & 7) * 8;
    const float* sp = src + (size_t)(tkq * 256 + r) * N + tn * 64 + c8;
    float4 a[4], b[4];
#pragma unroll
    for (int q = 0; q < 4; ++q) { a[q] = *(const float4*)(sp + (size_t)q * 64 * N); b[q] = *(const float4*)(sp + (size_t)q * 64 * N + 4); }
#pragma unroll
    for (int q = 0; q < 4; ++q) {
      float* d = lds + q * 4160 + r * 65 + c8;
      d[0] = a[q].x; d[1] = a[q].y; d[2] = a[q].z; d[3] = a[q].w; d[4] = b[q].x; d[5] = b[q].y; d[6] = b[q].z; d[7] = b[q].w;
    }
  }
  __syncthreads();
  {
    const int n = tid >> 3, k0 = (tid & 7) * 8;
    if (I8) {
      const float inv = 1.0f / swp[tn * 64 + n];
      unsigned char* dst = (unsigned char*)dstv;
#pragma unroll
      for (int q = 0; q < 4; ++q) {
        const float* lq = lds + q * 4160;
        unsigned w0 = 0, w1 = 0;
#pragma unroll
        for (int i = 0; i < 4; ++i) {
          w0 |= ((unsigned)__float2int_rn(lq[(k0 + i) * 65 + n] * inv) & 255u) << (8 * i);
          w1 |= ((unsigned)__float2int_rn(lq[(k0 + 4 + i) * 65 + n] * inv) & 255u) << (8 * i);
        }
        *(uint2*)(dst + (size_t)(tn * 64 + n) * K + tkq * 256 + q * 64 + k0) = make_uint2(w0, w1);
      }
    } else {
      u16* dst = (u16*)dstv;
#pragma unroll
      for (int q = 0; q < 4; ++q) {
        const float* lq = lds + q * 4160;
        uint4 o;
        o.x = pk2(lq[(k0 + 0) * 65 + n], lq[(k0 + 1) * 65 + n]);
        o.y = pk2(lq[(k0 + 2) * 65 + n], lq[(k0 + 3) * 65 + n]);
        o.z = pk2(lq[(k0 + 4) * 65 + n], lq[(k0 + 5) * 65 + n]);
        o.w = pk2(lq[(k0 + 6) * 65 + n], lq[(k0 + 7) * 65 + n]);
        *(uint4*)(dst + (size_t)(tn * 64 + n) * K + tkq * 256 + q * 64 + k0) = o;
      }
    }
  }
  __syncthreads();
}
__device__ __forceinline__ void colmax4_task(const float* __restrict__ w, int N, int n0, float* __restrict__ swp, char* smem) {
  const int tid = opaque_tid();
  const int c4 = (tid & 15) * 4, rg = tid >> 4;
  const float* wp = w + (size_t)(rg * 32) * N + n0 + c4;
  float4 m = {0.f, 0.f, 0.f, 0.f};
#pragma unroll 16
  for (int k = 0; k < 32; ++k) {
    const float4 v = *(const float4*)(wp + (size_t)k * N);
    m.x = fmaxf(m.x, fabsf(v.x)); m.y = fmaxf(m.y, fabsf(v.y)); m.z = fmaxf(m.z, fabsf(v.z)); m.w = fmaxf(m.w, fabsf(v.w));
  }
  float* red = (float*)smem;
  *(float4*)(red + rg * 64 + c4) = m;
  __syncthreads();
  if (tid < 64) {
    float mm = red[tid];
#pragma unroll
    for (int g = 1; g < 32; ++g) mm = fmaxf(mm, red[g * 64 + tid]);
    swp[n0 + tid] = fmaxf(mm, 1e-20f) * (1.0f / 127.0f);
  }
  __syncthreads();
}
__device__ __forceinline__ void cvt_chunk4(const float* __restrict__ src, u16* __restrict__ dst, size_t chunk4) {
  const size_t i = chunk4 * 16384 + (size_t)opaque_tid() * 8;
  float4 a[4], b[4];
#pragma unroll
  for (int q = 0; q < 4; ++q) { a[q] = *(const float4*)(src + i + q * 4096); b[q] = *(const float4*)(src + i + q * 4096 + 4); }
#pragma unroll
  for (int q = 0; q < 4; ++q) {
    uint4 o;
    o.x = pk2(a[q].x, a[q].y); o.y = pk2(a[q].z, a[q].w); o.z = pk2(b[q].x, b[q].y); o.w = pk2(b[q].z, b[q].w);
    *(uint4*)(dst + i + q * 4096) = o;
  }
}
__device__ __forceinline__ void cvt_chunk_fp8(const float* __restrict__ src, unsigned char* __restrict__ dst, size_t chunk, float scale) {
  const size_t i = chunk * 4096 + (size_t)opaque_tid() * 8;
  const float4 a = *(const float4*)(src + i), b = *(const float4*)(src + i + 4);
  int w0 = __builtin_amdgcn_cvt_pk_fp8_f32(a.x * scale, a.y * scale, 0, false);
  w0 = __builtin_amdgcn_cvt_pk_fp8_f32(a.z * scale, a.w * scale, w0, true);
  int w1 = __builtin_amdgcn_cvt_pk_fp8_f32(b.x * scale, b.y * scale, 0, false);
  w1 = __builtin_amdgcn_cvt_pk_fp8_f32(b.z * scale, b.w * scale, w1, true);
  *(uint2*)(dst + i) = make_uint2((unsigned)w0, (unsigned)w1);
}
__device__ __forceinline__ void cvt_chunk_fp4(const float* __restrict__ src, unsigned char* __restrict__ dst, size_t chunk, float scale, int vhalf) {
  const size_t i = chunk * 4096 + (size_t)opaque_tid() * 8;
  const float4 a = *(const float4*)(src + i), b = *(const float4*)(src + i + 4);
  unsigned w = 0;
  w = __builtin_amdgcn_cvt_scalef32_pk_fp4_f32(w, a.x * scale, a.y * scale, 1.0f, 0);
  w = __builtin_amdgcn_cvt_scalef32_pk_fp4_f32(w, a.z * scale, a.w * scale, 1.0f, 1);
  w = __builtin_amdgcn_cvt_scalef32_pk_fp4_f32(w, b.x * scale, b.y * scale, 1.0f, 2);
  w = __builtin_amdgcn_cvt_scalef32_pk_fp4_f32(w, b.z * scale, b.w * scale, 1.0f, 3);
  const size_t e = i >> 10;
  const unsigned d = (unsigned)(i & 1023);
  *(unsigned*)(dst + e * 1024 + vhalf * 512 + (d >> 1)) = w;
}
__device__ __forceinline__ void phase_modreduce(const P& p) {
  const int n = 2 * 9 * 6144;
  for (int i = blockIdx.x * NTHR + opaque_tid(); i < n; i += gridDim.x * NTHR) {
    const int l = i / (9 * 6144);
    const int j = i % 6144;
    float s = p.b_ada[l * 6144 + j];
#pragma unroll
    for (int kc = 0; kc < 16; ++kc) s += p.modpart[(size_t)kc * n + i];
    p.mod[i] = s;
  }
}

__device__ __forceinline__ void phase_norm(const P& p, int l, int which) {
  const int tid_ = opaque_tid(); const int lane = tid_ & 63, wid = tid_ >> 6;
  const int ntok = (which == 2 || (which == 1 && l == 1)) ? NLAT : NTOK;
  for (int row = blockIdx.x * 8 + wid; row < ntok; row += gridDim.x * 8) {
    const float* src;
    if (row < NLAT) src = ((which == 0 && l == 0) ? p.x : p.out) + (size_t)row * 1024;
    else src = ((which == 0 && l == 0) ? p.ctx : p.ctxs) + (size_t)(row - NLAT) * 1024;
    float4 v[4];
    float ss = 0.f;
#pragma unroll
    for (int i = 0; i < 4; ++i) {
      v[i] = *(const float4*)(src + i * 256 + lane * 4);
      ss += v[i].x * v[i].x + v[i].y * v[i].y + v[i].z * v[i].z + v[i].w * v[i].w;
    }
    ss = wave_sum(ss);
    const float rstd = rsqrtf(ss * (1.0f / 1024.0f) + 1e-6f);
    if (which == 2) {
#pragma unroll
      for (int i = 0; i < 4; ++i) {
        const int col = i * 256 + lane * 4;
        const float4 g = *(const float4*)(p.final_g + col);
        float4 o = {v[i].x * rstd * g.x, v[i].y * rstd * g.y, v[i].z * rstd * g.z, v[i].w * rstd * g.w};
        *(float4*)(p.out + (size_t)row * 1024 + col) = o;
      }
    } else {
      const int bi = row < NLAT ? (row >> 12) : 8;
      const float* gam = (which == 0 ? p.norm_mix_g : p.norm_ffn_g) + l * 1024;
      const float* msh = p.mod + ((size_t)(l * 9 + bi) * 6 + (which == 0 ? 0 : 3)) * 1024;
      const float* msc = msh + 1024;
      float4 y[4];
      float amax = 0.f;
#pragma unroll
      for (int i = 0; i < 4; ++i) {
        const int col = i * 256 + lane * 4;
        const float4 g = *(const float4*)(gam + col);
        const float4 sh = *(const float4*)(msh + col);
        const float4 sc = *(const float4*)(msc + col);
        y[i].x = v[i].x * rstd * g.x * (1.f + sc.x) + sh.x; y[i].y = v[i].y * rstd * g.y * (1.f + sc.y) + sh.y;
        y[i].z = v[i].z * rstd * g.z * (1.f + sc.z) + sh.z; y[i].w = v[i].w * rstd * g.w * (1.f + sc.w) + sh.w;
        amax = fmaxf(amax, fmaxf(fmaxf(fabsf(y[i].x), fabsf(y[i].y)), fmaxf(fabsf(y[i].z), fabsf(y[i].w))));
      }
      if (which == 0) {
        amax = fmaxf(wave_max(amax), 1e-20f);
        const float inv = 127.0f / amax;
#pragma unroll
        for (int i = 0; i < 4; ++i) {
          const unsigned w = ((unsigned)__float2int_rn(y[i].x * inv) & 255u) | (((unsigned)__float2int_rn(y[i].y * inv) & 255u) << 8) |
                             (((unsigned)__float2int_rn(y[i].z * inv) & 255u) << 16) | (((unsigned)__float2int_rn(y[i].w * inv) & 255u) << 24);
          *(unsigned*)(p.xn8 + (size_t)row * 1024 + i * 256 + lane * 4) = w;
        }
        if (lane == 0) p.sa[row] = amax * (1.0f / 127.0f);
      } else {
#pragma unroll
        for (int i = 0; i < 4; ++i) {
          uint2 o;
          o.x = pk2(y[i].x, y[i].y);
          o.y = pk2(y[i].z, y[i].w);
          *(uint2*)(p.xn + (size_t)row * 1024 + i * 256 + lane * 4) = o;
        }
      }
    }
  }
}

__device__ __forceinline__ void filter_wave(const P& p, int l, int L, int t, float* __restrict__ outp) {
  const int lane = opaque_tid() & 63;
  const float tl = (float)t / (float)(L - 1);
  const float wang = (6.283185307179586f / (float)L) * (float)t;
  float z = 0.f;
  if (lane == 0) z = tl;
  else if (lane <= 16) { const float band = 1e-4f + (float)(lane - 1) * ((15.0f - 1e-4f) / 15.0f); z = cosf(band * wang); }
  else if (lane <= 32) { const float band = 1e-4f + (float)(lane - 17) * ((15.0f - 1e-4f) / 15.0f); z = -sinf(band * wang); }
  float a1 = p.hy_f1_b[l * 64 + lane];
  for (int i = 0; i < 33; ++i) a1 += shf(z, i) * p.hy_f1_w[(l * 33 + i) * 64 + lane];
  const float h1 = sinf(p.hy_freq[l * 128 + lane] * a1);
  float a2 = p.hy_f2_b[l * 64 + lane];
  for (int i = 0; i < 64; ++i) a2 += shf(h1, i) * p.hy_f2_w[(l * 64 + i) * 64 + lane];
  const float h2 = sinf(p.hy_freq[l * 128 + 64 + lane] * a2);
  float a3[8];
#pragma unroll
  for (int m = 0; m < 8; ++m) a3[m] = 0.f;
  for (int i = 0; i < 64; ++i) {
    const float hv = shf(h2, i);
    const float* wr = p.hy_f3_w + (size_t)(l * 64 + i) * 512 + lane;
#pragma unroll
    for (int m = 0; m < 8; ++m) a3[m] += hv * wr[m * 64];
  }
  const float LN100 = 4.605170185988092f;
  const float d0 = LN100 / 1.5f, d1 = LN100 / 0.3f;
#pragma unroll
  for (int m = 0; m < 8; ++m) {
    const int cp = lane + 64 * m;
    const int ch = cp & 255;
    const float delta = d0 + (float)ch * ((d1 - d0) / 255.0f);
    outp[(size_t)cp * L + t] = a3[m] * expf(-tl * delta);
  }
}
__device__ __forceinline__ void filter_block_task(const P& p, int l, int L, int t0, float* __restrict__ outp, char* smem) {
  const int tid = opaque_tid(), lane = tid & 63, wid = tid >> 6;
  float* W3s = (float*)smem;
  float* W2s = (float*)(smem + 131072);
  {
    const float4* s3 = (const float4*)(p.hy_f3_w + (size_t)l * 64 * 512);
    const float4* s2 = (const float4*)(p.hy_f2_w + (size_t)l * 64 * 64);
#pragma unroll
    for (int i = 0; i < 16; ++i) ((float4*)W3s)[tid + NTHR * i] = s3[tid + NTHR * i];
#pragma unroll
    for (int i = 0; i < 2; ++i) ((float4*)W2s)[tid + NTHR * i] = s2[tid + NTHR * i];
  }
  __syncthreads();
  float z[4], tl[4];
#pragma unroll
  for (int j = 0; j < 4; ++j) {
    const int t = t0 + wid * 4 + j;
    tl[j] = (float)t / (float)(L - 1);
    const float wang = (6.283185307179586f / (float)L) * (float)t;
    float zz = 0.f;
    if (lane == 0) zz = tl[j];
    else if (lane <= 16) { const float band = 1e-4f + (float)(lane - 1) * ((15.0f - 1e-4f) / 15.0f); zz = cosf(band * wang); }
    else if (lane <= 32) { const float band = 1e-4f + (float)(lane - 17) * ((15.0f - 1e-4f) / 15.0f); zz = -sinf(band * wang); }
    z[j] = zz;
  }
  float a1[4], a2[4];
  {
    const float b1 = p.hy_f1_b[l * 64 + lane];
#pragma unroll
    for (int j = 0; j < 4; ++j) a1[j] = b1;
#pragma unroll 11
    for (int i = 0; i < 33; ++i) {
      const float w = p.hy_f1_w[(l * 33 + i) * 64 + lane];
#pragma unroll
      for (int j = 0; j < 4; ++j) a1[j] += shf(z[j], i) * w;
    }
    const float f0 = p.hy_freq[l * 128 + lane];
#pragma unroll
    for (int j = 0; j < 4; ++j) a1[j] = sinf(f0 * a1[j]);
  }
  {
    const float b2 = p.hy_f2_b[l * 64 + lane];
#pragma unroll
    for (int j = 0; j < 4; ++j) a2[j] = b2;
#pragma unroll 8
    for (int i = 0; i < 64; ++i) {
      const float w = W2s[i * 64 + lane];
#pragma unroll
      for (int j = 0; j < 4; ++j) a2[j] += shf(a1[j], i) * w;
    }
    const float f1 = p.hy_freq[l * 128 + 64 + lane];
#pragma unroll
    for (int j = 0; j < 4; ++j) a2[j] = sinf(f1 * a2[j]);
  }
  float a3[4][8];
#pragma unroll
  for (int j = 0; j < 4; ++j)
#pragma unroll
    for (int m = 0; m < 8; ++m) a3[j][m] = 0.f;
#pragma unroll 4
  for (int i = 0; i < 64; ++i) {
    float w[8];
#pragma unroll
    for (int m = 0; m < 8; ++m) w[m] = W3s[i * 512 + lane + 64 * m];
#pragma unroll
    for (int j = 0; j < 4; ++j) {
      const float hv = shf(a2[j], i);
#pragma unroll
      for (int m = 0; m < 8; ++m) a3[j][m] += hv * w[m];
    }
  }
  const float LN100 = 4.605170185988092f;
  const float d0 = LN100 / 1.5f, d1 = LN100 / 0.3f;
#pragma unroll
  for (int m = 0; m < 8; ++m) {
    const int cp = lane + 64 * m;
    const float delta = d0 + (float)(cp & 255) * ((d1 - d0) / 255.0f);
    float4 o;
    o.x = a3[0][m] * expf(-tl[0] * delta); o.y = a3[1][m] * expf(-tl[1] * delta);
    o.z = a3[2][m] * expf(-tl[2] * delta); o.w = a3[3][m] * expf(-tl[3] * delta);
    *(float4*)(outp + (size_t)cp * L + t0 + wid * 4) = o;
  }
  __syncthreads();
}
__device__ __forceinline__ void phase_filters(const P& p, int l, char* smem) {
  const int ntask = 128 + (l == 0 ? 8 : 0);
  for (int t = blockIdx.x; t < ntask; t += gridDim.x) {
    if (t < 128) filter_block_task(p, l, 4096, t * 32, p.hT + (size_t)l * 512 * 4096, smem);
    else filter_block_task(p, l, 256, (t - 128) * 32, p.hc, smem);
  }
}
__device__ __forceinline__ void adaln_task(const P& p, int t, char* smem) {
  const int tid = opaque_tid();
  const int kc = t & 15; t >>= 4;
  const int jc = t % 12, l = t / 12;
  float* s = (float*)smem;
  float* red = (float*)(smem + 4096);
  for (int i = tid; i < 576; i += NTHR) {
    const int bi = i >> 6, kk = i & 63;
    const float v = (bi < 8) ? p.c[bi * 1024 + kc * 64 + kk] : p.c_ctx[kc * 64 + kk];
    s[i] = v / (1.0f + __expf(-v));
  }
  const int kq = tid >> 7, c4 = (tid & 127) * 4;
  const float* wp = p.w_ada + ((size_t)l * 1024 + kc * 64 + kq * 16) * 6144 + jc * 512 + c4;
  float4 w[16];
#pragma unroll
  for (int kk = 0; kk < 16; ++kk) w[kk] = *(const float4*)(wp + (size_t)kk * 6144);
  __syncthreads();
  float4 acc[9];
#pragma unroll
  for (int bi = 0; bi < 9; ++bi) acc[bi] = make_float4(0.f, 0.f, 0.f, 0.f);
#pragma unroll
  for (int kk = 0; kk < 16; ++kk) {
#pragma unroll
    for (int bi = 0; bi < 9; ++bi) {
      const float sv = s[bi * 64 + kq * 16 + kk];
      acc[bi].x += sv * w[kk].x; acc[bi].y += sv * w[kk].y; acc[bi].z += sv * w[kk].z; acc[bi].w += sv * w[kk].w;
    }
  }
#pragma unroll
  for (int bi = 0; bi < 9; ++bi) *(float4*)(red + (kq * 9 + bi) * 512 + c4) = acc[bi];
  __syncthreads();
#pragma unroll
  for (int bi = 0; bi < 9; ++bi) {
    const float v = red[bi * 512 + tid] + red[(9 + bi) * 512 + tid] + red[(18 + bi) * 512 + tid] + red[(27 + bi) * 512 + tid];
    p.modpart[((size_t)(kc * 2 + l) * 9 + bi) * 6144 + jc * 512 + tid] = v;
  }
  __syncthreads();
}
__device__ __forceinline__ void phase_prep(const P& p, char* smem, unsigned* counter) {
  volatile int* s_taskp = (volatile int*)(smem + SMEM_BYTES - 16);
  const int total = 264 + 184 + 384 + 544 + 32;
  int nxt = 0;
  if (threadIdx.x == 0) nxt = (int)atomicAdd(counter, 1u);
  for (;;) {
    __syncthreads();
    if (threadIdx.x == 0) *s_taskp = nxt;
    __syncthreads();
    int t = *s_taskp;
    if (t >= total) break;
    if (threadIdx.x == 0) nxt = (int)atomicAdd(counter, 1u);
    if (t < 264) {
      if (t < 128) filter_block_task(p, 0, 4096, t * 32, p.hT, smem);
      else if (t < 256) filter_block_task(p, 1, 4096, (t - 128) * 32, p.hT + (size_t)512 * 4096, smem);
      else filter_block_task(p, 0, 256, (t - 256) * 32, p.hc, smem);
      continue;
    }
    t -= 264;
    if (t < 184) {
      const int l = t / 92; t -= l * 92;
      if (t < 44) colmax4_task(p.w_in + (size_t)l * 1024 * 2816, 2816, t * 64, p.sw + l * 5888, smem);
      else colmax4_task(p.w_gate + (size_t)l * 1024 * 3072, 3072, (t - 44) * 64, p.sw + l * 5888 + 2816, smem);
      continue;
    }
    t -= 184;
    if (t < 384) { adaln_task(p, t, smem); continue; }
    t -= 384;
    if (t < 544) {
      const int l = t / 272; t -= l * 272;
      if (t < 32) tr_tile4<false>(p.w_br_a + (size_t)l * 512 * 1024, 1024, 512, p.WaT + (size_t)l * 1024 * 512, t, nullptr, smem);
      else if ((t -= 32) < 16) tr_tile4<false>(p.w_br_b + (size_t)l * 256 * 1024, 1024, 256, p.WbT + (size_t)l * 1024 * 256, t, nullptr, smem);
      else if ((t -= 16) < 16) tr_tile4<false>(p.w_br_c + (size_t)l * 256 * 1024, 1024, 256, p.WcT + (size_t)l * 1024 * 256, t, nullptr, smem);
      else if ((t -= 16) < 64) tr_tile4<false>(p.w_out + (size_t)l * 1024 * 1024, 1024, 1024, p.WoT + (size_t)l * 1024 * 1024, t, nullptr, smem);
      else if ((t -= 64) < 128) cvt_chunk4(p.peer_wq + (size_t)l * 1024 * 2048, p.WqB + (size_t)l * 1024 * 2048, (size_t)t);
      else {
        t -= 128;
        const int gate = t >> 3, dn = t & 7;
        const float* src = (gate ? p.rg_wx : p.rg_wa) + (size_t)(l * 8 + dn) * 4096;
        tr_tile(src, 64, 64, p.rgW + (size_t)((l * 2 + gate) * 8 + dn) * 4096, 0, smem);
      }
      continue;
    }
    t -= 544;
    cvt_chunk4(p.peer_keys, p.keysB, (size_t)t);
  }
}
__device__ __forceinline__ void kf_task(const P& p, int l, int c, char* smem) {
  const float* hTl = p.hT + (size_t)l * 512 * 4096;
  c2* buf = (c2*)smem;
  const int tid = opaque_tid();
  for (int i = 0; i < 16; ++i) {
    const int j = tid + NTHR * i;
    float v;
    if (j < 4096) v = hTl[(size_t)c * 4096 + j];
    else if (j == 4096) v = 0.f;
    else v = hTl[(size_t)(256 + c) * 4096 + (8192 - j)];
    buf[j] = {v, 0.f};
  }
  __syncthreads();
  fft8192(buf, -1.f);
  c2* o = (c2*)p.Kf + ((size_t)l * 256 + c) * 8192;
  for (int i = 0; i < 16; ++i) { const int j = tid + NTHR * i; o[j] = buf[j]; }
  __syncthreads();
}

__device__ __forceinline__ void inproj_tile(const P& p, int l, int mt, int nt, char* smem) {
  f32x16 acc[2][2];
  zero_acc(acc);
  const int m0 = mt * 256, n0 = nt * 128;
  gemm_kloop(acc, p.xn + (size_t)m0 * 1024, 1024, p.WinT + ((size_t)l * 2816 + n0) * 1024, 1024, 1024, smem);
  EPI_VARS
  if (nt < 8 || nt >= 18) {
    u16* dst; int ld, cbase;
    if (nt < 8) { dst = p.qk; ld = 1024; cbase = n0; }
    else { dst = p.rg; ld = 512; cbase = n0 - 2304; }
#pragma unroll
    for (int i = 0; i < 2; ++i)
#pragma unroll
      for (int j = 0; j < 2; ++j)
#pragma unroll
        for (int e = 0; e < 16; ++e)
          dst[(size_t)(m0 + EPI_ROW(i, e)) * ld + cbase + EPI_COL(j)] = f2bf(acc[i][j][e]);
  } else {
#pragma unroll
    for (int i = 0; i < 2; ++i)
#pragma unroll
      for (int j = 0; j < 2; ++j)
#pragma unroll
        for (int qd = 0; qd < 4; ++qd) {
          uint2 o;
          o.x = pk2(acc[i][j][4 * qd + 0], acc[i][j][4 * qd + 1]);
          o.y = pk2(acc[i][j][4 * qd + 2], acc[i][j][4 * qd + 3]);
          const int row0 = wm * 64 + i * 32 + 8 * qd + 4 * hh;
          *(uint2*)(smem + EPI_COL(j) * 520 + row0 * 2) = o;
        }
    __syncthreads();
    u16* dstT; int Lseg, t0, ncol0, nc;
    const bool isctx = (mt >= 128);
    const int b = isctx ? (mt - 128) : (mt >> 4);
    if (nt < 12) { ncol0 = n0 - 1024; nc = 512; dstT = isctx ? p.vTc : p.vT; }
    else { ncol0 = n0 - 1536; nc = 768; dstT = isctx ? p.hyTc : p.hyT; }
    if (isctx) { Lseg = 256; t0 = 0; } else { Lseg = 4096; t0 = (mt & 15) * 256; }
#pragma unroll 4
    for (int it = 0; it < 16; ++it) {
      const int idx = tid + NTHR * it;
      const int col = idx >> 6, u = idx & 63;
      const uint2 v = *(const uint2*)(smem + col * 520 + u * 8);
      *(uint2*)(dstT + ((size_t)(b * nc + ncol0 + col)) * Lseg + t0 + u * 4) = v;
    }
    __syncthreads();
  }
}

__device__ __forceinline__ float ldbf(const u16* p, int t, int L) { return (t >= 0 && t < L) ? bf2f(p[t]) : 0.f; }
__device__ __forceinline__ void ld10(const u16* __restrict__ seq, int t0, float (&v)[10]) {
  const uint4 r = *(const uint4*)(seq + t0);
  v[0] = (t0 > 0) ? bf2f(seq[t0 - 1]) : 0.f;
  v[9] = (t0 + 8 < 4096) ? bf2f(seq[t0 + 8]) : 0.f;
  v[1] = bflo(r.x); v[2] = bfhi(r.x); v[3] = bflo(r.y); v[4] = bfhi(r.y);
  v[5] = bflo(r.z); v[6] = bfhi(r.z); v[7] = bflo(r.w); v[8] = bfhi(r.w);
}
__device__ __forceinline__ void hyena_fft_task(const P& p, int l, int c, int bp, char* smem) {
  c2* buf = (c2*)smem;
  c2* ub = (c2*)(smem + 65536);
  const int tid = opaque_tid();
  const float* sw = p.hy_short_w + l * 3 * 768;
  const float* sb = p.hy_short_b + l * 768;
  const float wx0[3] = {sw[c], sw[768 + c], sw[1536 + c]};
  const float wx1[3] = {sw[256 + c], sw[768 + 256 + c], sw[1536 + 256 + c]};
  const float wv[3] = {sw[512 + c], sw[768 + 512 + c], sw[1536 + 512 + c]};
  const float bx0 = sb[c], bx1 = sb[256 + c], bv = sb[512 + c];
  const float dsk = p.hy_bias[l * 256 + c];
  const int t0 = tid * 8;
  {
    float u[2][8];
#pragma unroll
    for (int bb = 0; bb < 2; ++bb) {
      const int b = 2 * bp + bb;
      float x1[10], vv[10];
      ld10(p.hyT + ((size_t)(b * 768 + 256 + c)) * 4096, t0, x1);
      ld10(p.hyT + ((size_t)(b * 768 + 512 + c)) * 4096, t0, vv);
#pragma unroll
      for (int k = 0; k < 8; ++k) {
        const float x1c = bx1 + wx1[0] * x1[k] + wx1[1] * x1[k + 1] + wx1[2] * x1[k + 2];
        const float vc = bv + wv[0] * vv[k] + wv[1] * vv[k + 1] + wv[2] * vv[k + 2];
        u[bb][k] = vc * x1c;
      }
    }
#pragma unroll
    for (int k = 0; k < 8; k += 2) {
      const float4 w = make_float4(u[0][k], u[1][k], u[0][k + 1], u[1][k + 1]);
      *(float4*)(buf + t0 + k) = w;
      *(float4*)(ub + t0 + k) = w;
      *(float4*)(buf + 4096 + t0 + k) = make_float4(0.f, 0.f, 0.f, 0.f);
    }
  }
  __syncthreads();
  fft8192(buf, -1.f);
  const c2* kf = (const c2*)p.Kf + ((size_t)l * 256 + c) * 8192;
  for (int i = 0; i < 16; ++i) {
    const int k = tid + NTHR * i;
    buf[k] = cmul(buf[k], kf[k]);
  }
  __syncthreads();
  fft8192(buf, 1.f);
#pragma unroll
  for (int bb = 0; bb < 2; ++bb) {
    const int b = 2 * bp + bb;
    float x0[10];
    ld10(p.hyT + ((size_t)(b * 768 + c)) * 4096, t0, x0);
    float o[8];
#pragma unroll
    for (int k = 0; k < 8; ++k) {
      const c2 y = buf[t0 + k];
      const c2 uu = ub[t0 + k];
      const float x0c = bx0 + wx0[0] * x0[k] + wx0[1] * x0[k + 1] + wx0[2] * x0[k + 2];
      const float yy = ldexpf(bb ? y.y : y.x, -13);
      const float uv = bb ? uu.y : uu.x;
      o[k] = x0c * (yy + uv * dsk);
    }
    uint4 w; w.x = pk2(o[0], o[1]); w.y = pk2(o[2], o[3]); w.z = pk2(o[4], o[5]); w.w = pk2(o[6], o[7]);
    *(uint4*)(p.ybT + ((size_t)(b * 256 + c)) * 4096 + t0) = w;
  }
  __syncthreads();
}
__device__ __forceinline__ void yb_transpose_task(const P& p, int b, int tb, char* smem) {
  const int tid = opaque_tid(), lane = tid & 63, wid = tid >> 6;
  u16* T = (u16*)smem;
#pragma unroll
  for (int it = 0; it < 4; ++it) {
    const int id = tid + NTHR * it;
    const int c = id >> 3, ch = id & 7;
    const uint4 r = *(const uint4*)(p.ybT + ((size_t)(b * 256 + c)) * 4096 + tb * 64 + ch * 8);
    unsigned* d = (unsigned*)(T + c * 66 + ch * 8);
    d[0] = r.x; d[1] = r.y; d[2] = r.z; d[3] = r.w;
  }
  __syncthreads();
#pragma unroll
  for (int it = 0; it < 8; ++it) {
    const int tt = wid + 8 * it;
    const int c0 = lane * 4;
    uint2 w;
    w.x = (unsigned)T[(c0 + 0) * 66 + tt] | ((unsigned)T[(c0 + 1) * 66 + tt] << 16);
    w.y = (unsigned)T[(c0 + 2) * 66 + tt] | ((unsigned)T[(c0 + 3) * 66 + tt] << 16);
    *(uint2*)(p.ycat + (size_t)(b * 4096 + tb * 64 + tt) * 1024 + 512 + c0) = w;
  }
  __syncthreads();
}
__device__ __forceinline__ void hyena_ctx_task(const P& p, int l, int b, int cg8, char* smem) {
  const int tid_ = opaque_tid(); const int lane = tid_ & 63, wid = tid_ >> 6;
  const int c = cg8 * 8 + wid;
  float* us = (float*)smem + wid * 1024;
  float* kfp = us + 256 + 255;
  const float* sw = p.hy_short_w + l * 3 * 768;
  const float* sb = p.hy_short_b + l * 768;
  const u16* x0 = p.hyTc + ((size_t)(b * 768 + c)) * 256;
  const u16* x1 = p.hyTc + ((size_t)(b * 768 + 256 + c)) * 256;
  const u16* vv = p.hyTc + ((size_t)(b * 768 + 512 + c)) * 256;
  for (int i = 0; i < 4; ++i) {
    const int t = lane + 64 * i;
    const float x1c = sb[256 + c] + sw[256 + c] * ldbf(x1, t - 1, 256) + sw[768 + 256 + c] * ldbf(x1, t, 256) + sw[1536 + 256 + c] * ldbf(x1, t + 1, 256);
    const float vc = sb[512 + c] + sw[512 + c] * ldbf(vv, t - 1, 256) + sw[768 + 512 + c] * ldbf(vv, t, 256) + sw[1536 + 512 + c] * ldbf(vv, t + 1, 256);
    us[t] = vc * x1c;
    kfp[t] = p.hc[(size_t)c * 256 + t];
    if (t > 0) kfp[-t] = p.hc[(size_t)(256 + c) * 256 + t];
  }
  __syncthreads();
  const float dsk = p.hy_bias[l * 256 + c];
  float acc[4] = {0.f, 0.f, 0.f, 0.f};
  for (int s = 0; s < 256; ++s) {
    const float uv = us[s];
#pragma unroll
    for (int i = 0; i < 4; ++i) acc[i] += kfp[lane + 64 * i - s] * uv;
  }
#pragma unroll
  for (int i = 0; i < 4; ++i) {
    const int t = lane + 64 * i;
    const float x0c = sb[c] + sw[c] * ldbf(x0, t - 1, 256) + sw[768 + c] * ldbf(x0, t, 256) + sw[1536 + c] * ldbf(x0, t + 1, 256);
    p.ycat[(size_t)(NLAT + b * 256 + t) * 1024 + 512 + c] = f2bf(x0c * (acc[i] + us[t] * dsk));
  }
  __syncthreads();
}

template <int DIR>
__device__ __forceinline__ void rg_scan32(const float (&Av)[2][16], const float (&Bv)[2][16], float (&carry)[2], float (&H)[2][16], int hh) {
#pragma unroll
  for (int nt = 0; nt < 2; ++nt) {
    float c = carry[nt];
#pragma unroll
    for (int go = 0; go < 8; ++go) {
      const int g = DIR ? 7 - go : go, q = g >> 1, own = g & 1;
      float h = c;
#pragma unroll
      for (int io = 0; io < 4; ++io) {
        const int e = 4 * q + (DIR ? 3 - io : io);
        h = Av[nt][e] * h + Bv[nt][e];
        H[nt][e] = (hh == own) ? h : H[nt][e];
      }
      const float mine = (hh == own) ? h : c;
      const float other = shx(mine, 32);
      c = (hh == own) ? mine : other;
    }
    carry[nt] = c;
  }
}
__device__ __forceinline__ void rg_wave_task(const P& p, int l, int bq, int nblk, int mode, bool last, char* smem) {
  const int tid = opaque_tid(), lane = tid & 63, wid = tid >> 6;
  const int l31 = lane & 31, hh = lane >> 5;
  const int b = bq / 34, rr = bq - b * 34;
  const int seg = rr < 2 ? 0 : 1, blk = rr < 2 ? rr : rr - 2;
  if (mode == 1 && seg == 0 && last) return;
  const int ck = wid >> 1, dir = wid & 1;
  char* wreg = smem + wid * 17408;
  u16* xs = (u16*)wreg;
  char* xcb = wreg + 4608;
  float* xcf = (float*)(wreg + 8704);
  float2* blockagg = (float2*)(smem + 139264);
  const int Lseg = seg ? 4096 : 256;
  const int tokbase = seg ? b * 4096 : NLAT + b * 256;
  const int T0 = blk * 128 + ck * 32;
  const int cg32 = (seg ? 8 : 0) + blk * 4 + ck;
  bf16x8 wf[2][2][4];
#pragma unroll
  for (int gate = 0; gate < 2; ++gate) {
    const u16* wp = p.rgW + (size_t)(((l * 2 + gate) * 2 + dir) * 4 + nblk) * 4096 + l31 * 64 + 8 * hh;
#pragma unroll
    for (int nt = 0; nt < 2; ++nt)
#pragma unroll
      for (int s = 0; s < 4; ++s) wf[gate][nt][s] = *(const bf16x8*)(wp + nt * 2048 + 16 * s);
  }
  float cba[2], cbx[2], csp[2];
#pragma unroll
  for (int nt = 0; nt < 2; ++nt) {
    const int ch = (l * 2 + dir) * 256 + nblk * 64 + nt * 32 + l31;
    cba[nt] = p.rg_ba[ch];
    cbx[nt] = p.rg_bx[ch];
    csp[nt] = __logf(1.0f + __expf(-p.rg_lambda[ch]));
  }
#pragma unroll
  for (int i = 0; i < 5; ++i) {
    const int idx = lane + 64 * i;
    const int row = idx >> 3, chunk = idx & 7;
    if (row < 35) {
      const int pos = T0 - 2 + row;
      uint4 v = make_uint4(0u, 0u, 0u, 0u);
      if (pos >= 0 && pos < Lseg) v = *(const uint4*)(p.rg + (size_t)(tokbase + pos) * 512 + nblk * 64 + chunk * 8);
      *(uint4*)(xs + row * 64 + chunk * 8) = v;
    }
  }
  asm volatile("s_waitcnt lgkmcnt(0)" ::: "memory");
  {
    const int ch = l * 256 + nblk * 64 + lane;
    const float w0 = p.rg_conv_w[(l * 4 + 0) * 256 + nblk * 64 + lane], w1 = p.rg_conv_w[(l * 4 + 1) * 256 + nblk * 64 + lane];
    const float w2 = p.rg_conv_w[(l * 4 + 2) * 256 + nblk * 64 + lane], w3 = p.rg_conv_w[(l * 4 + 3) * 256 + nblk * 64 + lane];
    const float cb = p.rg_conv_b[ch];
    float x0 = bf2f(xs[0 * 64 + lane]), x1 = bf2f(xs[1 * 64 + lane]), x2 = bf2f(xs[2 * 64 + lane]);
#pragma unroll
    for (int t = 0; t < 32; ++t) {
      const float x3 = bf2f(xs[(t + 3) * 64 + lane]);
      const float xc = cb + w0 * x0 + w1 * x1 + w2 * x2 + w3 * x3;
      xcf[t * 68 + lane] = xc;
      *(u16*)(xcb + swz128(t, lane >> 3) + (lane & 7) * 2) = f2bf(xc);
      x0 = x1; x1 = x2; x2 = x3;
    }
  }
  asm volatile("s_waitcnt lgkmcnt(0)" ::: "memory");
  float Av[2][16], Bv[2][16];
  {
    f32x16 acc[2][2];
#pragma unroll
    for (int gate = 0; gate < 2; ++gate)
#pragma unroll
      for (int nt = 0; nt < 2; ++nt) acc[gate][nt] = zero16();
#pragma unroll
    for (int s = 0; s < 4; ++s) {
      const bf16x8 af = *(const bf16x8*)(xcb + swz128(l31, 2 * s + hh));
#pragma unroll
      for (int gate = 0; gate < 2; ++gate)
#pragma unroll
        for (int nt = 0; nt < 2; ++nt) acc[gate][nt] = mfma32(af, wf[gate][nt][s], acc[gate][nt]);
    }
#pragma unroll
    for (int nt = 0; nt < 2; ++nt)
#pragma unroll
      for (int e = 0; e < 16; ++e) {
        const int tok = (e & 3) + 8 * (e >> 2) + 4 * hh;
        const float r = sigmoidf_(acc[0][nt][e] + cba[nt]);
        const float ii = sigmoidf_(acc[1][nt][e] + cbx[nt]);
        const float la = -8.0f * r * csp[nt];
        const float av = __expf(la);
        const float e2 = 2.0f * la;
        const float om = (e2 > -0.1f) ? (-e2 * (1.0f + e2 * (0.5f + e2 * (0.16666667f + e2 * 0.041666668f)))) : (1.0f - __expf(e2));
        Av[nt][e] = av;
        Bv[nt][e] = sqrtf(om) * ii * xcf[tok * 68 + nt * 32 + l31];
      }
  }
  float H[2][16];
#pragma unroll
  for (int nt = 0; nt < 2; ++nt)
#pragma unroll
    for (int e = 0; e < 16; ++e) H[nt][e] = 0.f;
  float carry[2] = {0.f, 0.f};
  float2* agg1 = (float2*)p.agg;
  float2* agg2 = (float2*)p.agg + (size_t)8 * 2 * 136 * 256;
  const int pos2 = dir ? (seg == 0 ? 1 - blk : 33 - blk) : (seg == 0 ? blk : 2 + blk);
  if (mode == 0) {
    if (dir) rg_scan32<1>(Av, Bv, carry, H, hh); else rg_scan32<0>(Av, Bv, carry, H, hh);
    float P[2];
#pragma unroll
    for (int nt = 0; nt < 2; ++nt) {
      float pr = 1.f;
#pragma unroll
      for (int e = 0; e < 16; ++e) pr *= Av[nt][e];
      P[nt] = pr * shx(pr, 32);
    }
    const float2 mine = make_float2(hh ? P[1] : P[0], hh ? carry[1] : carry[0]);
    agg1[((size_t)(b * 2 + dir) * 136 + cg32) * 256 + nblk * 64 + lane] = mine;
    blockagg[(ck * 2 + dir) * 64 + lane] = mine;
    __syncthreads();
    if (wid < 2) {
      const int d2 = wid;
      float A = 1.f, B = 0.f;
#pragma unroll
      for (int co = 0; co < 4; ++co) {
        const int c = d2 ? 3 - co : co;
        const float2 g = blockagg[(c * 2 + d2) * 64 + lane];
        B = g.x * B + g.y;
        A *= g.x;
      }
      const int p2 = d2 ? (seg == 0 ? 1 - blk : 33 - blk) : (seg == 0 ? blk : 2 + blk);
      agg2[((size_t)(b * 2 + d2) * 34 + p2) * 256 + nblk * 64 + lane] = make_float2(A, B);
    }
    __syncthreads();
    return;
  }
  {
    float h = 0.f;
    const float2* a2 = agg2 + ((size_t)(b * 2 + dir) * 34) * 256 + nblk * 64 + lane;
    int j = 0;
    for (; j + 8 <= pos2; j += 8) {
      float2 g[8];
#pragma unroll
      for (int u = 0; u < 8; ++u) g[u] = a2[(size_t)(j + u) * 256];
#pragma unroll
      for (int u = 0; u < 8; ++u) h = g[u].x * h + g[u].y;
    }
    for (; j < pos2; ++j) { const float2 g = a2[(size_t)j * 256]; h = g.x * h + g.y; }
    const float2* a1 = agg1 + ((size_t)(b * 2 + dir) * 136 + (cg32 - ck)) * 256 + nblk * 64 + lane;
    const int npre = dir ? 3 - ck : ck;
    for (int i = 0; i < npre; ++i) {
      const int c = dir ? 3 - i : i;
      const float2 g = a1[(size_t)c * 256];
      h = g.x * h + g.y;
    }
    carry[0] = shf(h, l31);
    carry[1] = shf(h, 32 + l31);
  }
  if (dir) rg_scan32<1>(Av, Bv, carry, H, hh); else rg_scan32<0>(Av, Bv, carry, H, hh);
  asm volatile("s_waitcnt lgkmcnt(0)" ::: "memory");
#pragma unroll
  for (int nt = 0; nt < 2; ++nt)
#pragma unroll
    for (int e = 0; e < 16; ++e) xcf[((e & 3) + 8 * (e >> 2) + 4 * hh) * 68 + nt * 32 + l31] = H[nt][e];
  __syncthreads();
  {
    const float* hfT = (const float*)(smem + (ck * 2 + 0) * 17408 + 8704);
    const float* hbT = (const float*)(smem + (ck * 2 + 1) * 17408 + 8704);
    const int tok = 16 * dir + (lane >> 2), c16 = (lane & 3) * 16;
    const size_t gtok = (size_t)tokbase + T0 + tok;
    const u16* gp = p.rg + gtok * 512 + 256 + nblk * 64 + c16;
    u16* op = p.ycat + gtok * 1024 + 768 + nblk * 64 + c16;
#pragma unroll
    for (int hv = 0; hv < 2; ++hv) {
      const uint4 g = *(const uint4*)(gp + hv * 8);
      const float4 f0 = *(const float4*)(hfT + tok * 68 + c16 + hv * 8), f1 = *(const float4*)(hfT + tok * 68 + c16 + hv * 8 + 4);
      const float4 h0 = *(const float4*)(hbT + tok * 68 + c16 + hv * 8), h1 = *(const float4*)(hbT + tok * 68 + c16 + hv * 8 + 4);
      uint4 o;
      o.x = pk2((f0.x + h0.x) * gelu_tanh(bflo(g.x)), (f0.y + h0.y) * gelu_tanh(bfhi(g.x)));
      o.y = pk2((f0.z + h0.z) * gelu_tanh(bflo(g.y)), (f0.w + h0.w) * gelu_tanh(bfhi(g.y)));
      o.z = pk2((f1.x + h1.x) * gelu_tanh(bflo(g.z)), (f1.y + h1.y) * gelu_tanh(bfhi(g.z)));
      o.w = pk2((f1.z + h1.z) * gelu_tanh(bflo(g.w)), (f1.w + h1.w) * gelu_tanh(bfhi(g.w)));
      *(uint4*)(op + hv * 8) = o;
    }
  }
  __syncthreads();
}

__device__ __forceinline__ void attn_wave(const P& p, int l, int b, int h, bool local, int r, int half, int qtok0, const float* rpbL) {
  const int lane = opaque_tid() & 63, q = lane & 31, hh = lane >> 5;
  bf16x8 qf[4];
  {
    const u16* qp = p.qk + (size_t)(qtok0 + q) * 1024 + h * 64 + 8 * hh;
#pragma unroll
    for (int s = 0; s < 4; ++s) qf[s] = *(const bf16x8*)(qp + 16 * s);
  }
  f32x16 o0 = zero16(), o1 = zero16();
  float m_run = -1e30f, l_run = 0.f;
  const int pi = (q & 19) | ((q & 4) << 1) | ((q & 8) >> 1);
  const int w = half * 32 + q;
  const int st = min(max(w - 8, 0), 48);
  const int rs = min(max(r - 4, 0), 56);
  const int ntiles = local ? 24 : 8;
  bf16x8 kfn[4], vfn[2][2];
  auto tile_load = [&](int ti, bf16x8 (&kfo)[4], bf16x8 (&vfo)[2][2]) {
    int ktok0, vstride;
    const u16* vb;
    if (ti < 8) {
      ktok0 = NLAT + b * 256 + ti * 32;
      vb = p.vTc + ((size_t)(b * 512 + h * 64)) * 256 + ti * 32;
      vstride = 256;
    } else {
      const int tl = ti - 8;
      const int a2 = tl >> 1, g2 = tl & 1;
      ktok0 = b * 4096 + (rs + a2) * 64 + g2 * 32;
      vb = p.vT + ((size_t)(b * 512 + h * 64)) * 4096 + (rs + a2) * 64 + g2 * 32;
      vstride = 4096;
    }
    const u16* kp = p.qk + (size_t)(ktok0 + pi) * 1024 + 512 + h * 64 + 8 * hh;
#pragma unroll
    for (int s = 0; s < 4; ++s) kfo[s] = *(const bf16x8*)(kp + 16 * s);
#pragma unroll
    for (int dt = 0; dt < 2; ++dt)
#pragma unroll
      for (int s2 = 0; s2 < 2; ++s2) vfo[dt][s2] = *(const bf16x8*)(vb + (size_t)(dt * 32 + q) * vstride + 16 * s2 + 8 * hh);
  };
  tile_load(0, kfn, vfn);
  for (int ti = 0; ti < ntiles; ++ti) {
    int a = 0, g = 0;
    if (ti >= 8) { a = (ti - 8) >> 1; g = (ti - 8) & 1; }
    bf16x8 kf[4], vf[2][2];
#pragma unroll
    for (int s = 0; s < 4; ++s) kf[s] = kfn[s];
#pragma unroll
    for (int dt = 0; dt < 2; ++dt)
#pragma unroll
      for (int s2 = 0; s2 < 2; ++s2) vf[dt][s2] = vfn[dt][s2];
    if (ti + 1 < ntiles) tile_load(ti + 1, kfn, vfn);
    f32x16 sacc = zero16();
#pragma unroll
    for (int s = 0; s < 4; ++s) sacc = mfma32(kf[s], qf[s], sacc);
    float sv[16];
    float tmax = -1e30f;
#pragma unroll
    for (int e = 0; e < 16; ++e) {
      float x = sacc[e] * 0.125f;
      if (ti >= 8) {
        const int kc = g * 32 + (e & 7) + 8 * hh + 16 * (e >> 3);
        const bool valid = (kc >= st) && (kc < st + 16);
        const int bi = valid ? ((rs + a - r + 7) * 31 + (kc - w + 15)) : 0;
        const float bias = rpbL[bi];
        x = valid ? (x + bias) : -1e30f;
      }
      sv[e] = x;
      tmax = fmaxf(tmax, x);
    }
    tmax = fmaxf(tmax, shx(tmax, 32));
    const float m_new = fmaxf(m_run, tmax);
    const float alpha = __expf(m_run - m_new);
    m_run = m_new;
    l_run *= alpha;
#pragma unroll
    for (int e = 0; e < 16; ++e) { o0[e] *= alpha; o1[e] *= alpha; }
    float psum = 0.f;
#pragma unroll
    for (int e = 0; e < 16; ++e) { const float pe = __expf(sv[e] - m_new); sv[e] = pe; psum += pe; }
    l_run += psum;
    bf16x8 pf[2];
#pragma unroll
    for (int s2 = 0; s2 < 2; ++s2) {
      union { bf16x8 v; unsigned u[4]; } cv;
#pragma unroll
      for (int j = 0; j < 4; ++j) cv.u[j] = pk2(sv[8 * s2 + 2 * j], sv[8 * s2 + 2 * j + 1]);
      pf[s2] = cv.v;
    }
#pragma unroll
    for (int s2 = 0; s2 < 2; ++s2) {
      o0 = mfma32(vf[0][s2], pf[s2], o0);
      o1 = mfma32(vf[1][s2], pf[s2], o1);
    }
  }
  const float lt = l_run + shx(l_run, 32);
  const float inv = 1.0f / lt;
  u16* op = p.ycat + (size_t)(qtok0 + q) * 1024 + h * 64;
#pragma unroll
  for (int qd = 0; qd < 4; ++qd) {
    uint2 a0, a1;
    a0.x = pk2(o0[4 * qd] * inv, o0[4 * qd + 1] * inv);
    a0.y = pk2(o0[4 * qd + 2] * inv, o0[4 * qd + 3] * inv);
    a1.x = pk2(o1[4 * qd] * inv, o1[4 * qd + 1] * inv);
    a1.y = pk2(o1[4 * qd + 2] * inv, o1[4 * qd + 3] * inv);
    *(uint2*)(op + 8 * qd + 4 * hh) = a0;
    *(uint2*)(op + 32 + 8 * qd + 4 * hh) = a1;
  }
}
__device__ __forceinline__ void attn_block_task(const P& p, int l, int b, int h, int rg4, char* smem) {
  const int tid = opaque_tid(), lane = tid & 63, wid = tid >> 6;
  const int q = lane & 31, hh = lane >> 5;
  const int R0 = rg4 * 4;
  const int r = R0 + (wid >> 1), half = wid & 1;
  float* rpbL = (float*)(smem + 32768) + 64;
  for (int i = tid; i < 465; i += NTHR) rpbL[i] = p.na_rpb[(size_t)(l * 8 + h) * 465 + i] * 1.4426950408889634f;
  const int lo = min(max(R0 - 4, 0), 56);
  const int hi = min(max(R0 + 3 - 4, 0), 56) + 7;
  const int ntile = 4 + (hi - lo + 1);
  const int rs = min(max(r - 4, 0), 56);
  const int qtok = b * 4096 + r * 64 + half * 32 + q;
  bf16x8 qf[4];
  {
    const u16* qp = p.qk + (size_t)qtok * 1024 + h * 64 + 8 * hh;
#pragma unroll
    for (int s = 0; s < 4; ++s) qf[s] = *(const bf16x8*)(qp + 16 * s);
  }
  f32x16 o0 = zero16(), o1 = zero16();
  float m_run = -1e30f, l_run = 0.f;
  const int pi = (q & 19) | ((q & 4) << 1) | ((q & 8) >> 1);
  const int w = half * 32 + q;
  const int st = min(max(w - 8, 0), 48);
  unsigned vmask = 0u;
#pragma unroll
  for (int g = 0; g < 2; ++g)
#pragma unroll
    for (int e = 0; e < 16; ++e) {
      const int kc = g * 32 + (e & 7) + 8 * hh + 16 * (e >> 3);
      vmask |= ((kc >= st) && (kc < st + 16)) ? (1u << (g * 16 + e)) : 0u;
    }
  const int cbase = 8 * hh - w + 15;
  const int srow = tid >> 3, sch = tid & 7;
  uint4 rkA, rvA, rkB, rvB;
  auto gload = [&](int ti, uint4& rk, uint4& rv) {
    int ktok0, vstride;
    const u16* vb;
    if (ti < 4) { ktok0 = NLAT + b * 256 + ti * 64; vb = p.vTc + ((size_t)(b * 512 + h * 64)) * 256 + ti * 64; vstride = 256; }
    else { const int R = lo + ti - 4; ktok0 = b * 4096 + R * 64; vb = p.vT + ((size_t)(b * 512 + h * 64)) * 4096 + R * 64; vstride = 4096; }
    rk = *(const uint4*)(p.qk + (size_t)(ktok0 + srow) * 1024 + 512 + h * 64 + sch * 8);
    rv = *(const uint4*)(vb + (size_t)srow * vstride + sch * 8);
  };
  gload(0, rkA, rvA);
  *(uint4*)(smem + swz128(srow, sch)) = rkA;
  *(uint4*)(smem + 16384 + swz128(srow, sch)) = rvA;
  gload(1, rkA, rvA);
  if (2 < ntile) gload(2, rkB, rvB);
  __syncthreads();
  auto compute = [&](int ti) {
    const char* Kb = smem + (ti & 1) * 8192;
    const char* Vb = smem + 16384 + (ti & 1) * 8192;
    const int R = lo + ti - 4;
    const bool active = (ti < 4) || (R >= rs && R < rs + 8);
    if (active) {
      f32x16 sacc0 = zero16(), sacc1 = zero16();
#pragma unroll
      for (int s = 0; s < 4; ++s) {
        const bf16x8 kf0 = *(const bf16x8*)(Kb + swz128(pi, 2 * s + hh));
        const bf16x8 kf1 = *(const bf16x8*)(Kb + swz128(32 + pi, 2 * s + hh));
        sacc0 = mfma32(kf0, qf[s], sacc0);
        sacc1 = mfma32(kf1, qf[s], sacc1);
      }
      float sv[32];
      float tmax = -1e30f;
      if (ti >= 4) {
        const float* brow = rpbL + (R - r + 7) * 31 + cbase;
        float bias[32];
#pragma unroll
        for (int g = 0; g < 2; ++g)
#pragma unroll
          for (int e = 0; e < 16; ++e) bias[g * 16 + e] = brow[g * 32 + (e & 7) + 16 * (e >> 3)];
#pragma unroll
        for (int g = 0; g < 2; ++g)
#pragma unroll
          for (int e = 0; e < 16; ++e) {
            const float sc = g ? sacc1[e] : sacc0[e];
            const float x = ((int)(vmask << (31 - (g * 16 + e))) < 0) ? fmaf(sc, 0.18033688011112042f, bias[g * 16 + e]) : -1e30f;
            sv[g * 16 + e] = x;
            tmax = fmaxf(tmax, x);
          }
      } else {
#pragma unroll
        for (int g = 0; g < 2; ++g)
#pragma unroll
          for (int e = 0; e < 16; ++e) {
            const float x = (g ? sacc1[e] : sacc0[e]) * 0.18033688011112042f;
            sv[g * 16 + e] = x;
            tmax = fmaxf(tmax, x);
          }
      }
      tmax = fmaxf(tmax, shx(tmax, 32));
      if (__builtin_amdgcn_ballot_w64(tmax > m_run) != 0ull) {
        const float m_new = fmaxf(m_run, tmax);
        const float alpha = __builtin_amdgcn_exp2f(m_run - m_new);
        m_run = m_new;
        l_run *= alpha;
#pragma unroll
        for (int e = 0; e < 16; ++e) { o0[e] *= alpha; o1[e] *= alpha; }
      }
      float psum = 0.f;
#pragma unroll
      for (int e = 0; e < 32; ++e) { const float pe = __builtin_amdgcn_exp2f(sv[e] - m_run); sv[e] = pe; psum += pe; }
      l_run += psum;
#pragma unroll
      for (int g = 0; g < 2; ++g)
#pragma unroll
        for (int s2 = 0; s2 < 2; ++s2) {
          union { bf16x8 v; unsigned u[4]; } cv;
#pragma unroll
          for (int j = 0; j < 4; ++j) cv.u[j] = pk2(sv[g * 16 + 8 * s2 + 2 * j], sv[g * 16 + 8 * s2 + 2 * j + 1]);
          const bf16x8 v0 = *(const bf16x8*)(Vb + swz128(q, g * 4 + 2 * s2 + hh));
          const bf16x8 v1 = *(const bf16x8*)(Vb + swz128(32 + q, g * 4 + 2 * s2 + hh));
          o0 = mfma32(v0, cv.v, o0);
          o1 = mfma32(v1, cv.v, o1);
        }
    }
  };
  for (int ti = 0; ti < ntile; ti += 2) {
    compute(ti);
    if (ti + 1 < ntile) {
      *(uint4*)(smem + 8192 + swz128(srow, sch)) = rkA;
      *(uint4*)(smem + 16384 + 8192 + swz128(srow, sch)) = rvA;
      if (ti + 3 < ntile) gload(ti + 3, rkA, rvA);
    }
    __syncthreads();
    if (ti + 1 < ntile) {
      compute(ti + 1);
      if (ti + 2 < ntile) {
        *(uint4*)(smem + swz128(srow, sch)) = rkB;
        *(uint4*)(smem + 16384 + swz128(srow, sch)) = rvB;
        if (ti + 4 < ntile) gload(ti + 4, rkB, rvB);
      }
      __syncthreads();
    }
  }
  const float lt = l_run + shx(l_run, 32);
  const float inv = 1.0f / lt;
  __syncthreads();
  {
    char* ot = smem + wid * 4608;
#pragma unroll
    for (int qd = 0; qd < 4; ++qd) {
      uint2 a0, a1;
      a0.x = pk2(o0[4 * qd] * inv, o0[4 * qd + 1] * inv);
      a0.y = pk2(o0[4 * qd + 2] * inv, o0[4 * qd + 3] * inv);
      a1.x = pk2(o1[4 * qd] * inv, o1[4 * qd + 1] * inv);
      a1.y = pk2(o1[4 * qd + 2] * inv, o1[4 * qd + 3] * inv);
      *(uint2*)(ot + q * 144 + (8 * qd + 4 * hh) * 2) = a0;
      *(uint2*)(ot + q * 144 + (32 + 8 * qd + 4 * hh) * 2) = a1;
    }
    asm volatile("s_waitcnt lgkmcnt(0)" ::: "memory");
    const int tok0 = b * 4096 + r * 64 + half * 32;
#pragma unroll
    for (int it = 0; it < 4; ++it) {
      const int qq = it * 8 + (lane >> 3), ch = lane & 7;
      const uint4 v = *(const uint4*)(ot + qq * 144 + ch * 16);
      *(uint4*)(p.ycat + (size_t)(tok0 + qq) * 1024 + h * 64 + ch * 8) = v;
    }
  }
  __syncthreads();
}
__device__ __forceinline__ void attn_task(const P& p, int l, int kind, int idx, char* smem) {
  const int tid_ = opaque_tid(); const int lane = tid_ & 63, wid = tid_ >> 6;
  float* rpbL = (float*)smem + wid * 480;
  for (int i = lane; i < 465; i += 64) rpbL[i] = p.na_rpb[(size_t)(l * 8 + wid) * 465 + i];
  __syncthreads();
  if (kind == 0) {
    const int half = idx & 1, r = (idx >> 1) & 63, b = idx >> 7;
    attn_wave(p, l, b, wid, true, r, half, b * 4096 + r * 64 + half * 32, rpbL);
  } else {
    const int qg = idx & 7, b = idx >> 3;
    attn_wave(p, l, b, wid, false, 0, 0, NLAT + b * 256 + qg * 32, rpbL);
  }
  __syncthreads();
}

__device__ __forceinline__ void phase_mixers(const P& p, int l, char* smem, unsigned* counter) {
  const bool last = (l == 1);
  const int n_rg = 1088 * XRGA, n_fft = 1024 * XFFT, n_hc = last ? 0 : 256, n_att = 1024 * XATT, n_attc = last ? 0 : 64;
  const int total = n_rg + n_fft + n_hc + n_att + n_attc;
  volatile int* s_taskp = (volatile int*)(smem + SMEM_BYTES - 16);
  for (;;) {
    __syncthreads();
    if (threadIdx.x == 0) *s_taskp = (int)atomicAdd(counter, 1u);
    __syncthreads();
    int t = *s_taskp;
    if (t >= total) break;
    if (t < n_att) { t &= 1023; attn_block_task(p, l, t >> 7, (t >> 4) & 7, t & 15, smem); continue; }
    t -= n_att;
    if (t < n_attc) { attn_task(p, l, 1, t, smem); continue; }
    t -= n_attc;
    if (t < n_fft) { t &= 1023; hyena_fft_task(p, l, t >> 2, t & 3, smem); continue; }
    t -= n_fft;
    if (t < n_hc) { hyena_ctx_task(p, l, t >> 5, t & 31, smem); continue; }
    t -= n_hc;
    if (t >= 1088) t -= 1088;
    rg_wave_task(p, l, t >> 2, t & 3, 0, last, smem);
  }
}

__device__ __forceinline__ void merge_tile(const P& p, int l, int mt, int nt, char* smem) {
  EPI_VARS
  const int m0 = mt * 256, n0 = nt * 128;
  f32x16 macc[2][2];
  zero_acc(macc);
  for (int br = 0; br < 3; ++br) {
    unsigned* gpl = (unsigned*)(smem + 98304) + tid;
    {
      f32x16 acc[2][2];
      zero_acc(acc);
      gemm_kloop(acc, p.xn + (size_t)m0 * 1024, 1024, p.WgT + ((size_t)l * 3072 + br * 1024 + n0) * 1024, 1024, 1024, smem);
#pragma unroll
      for (int j = 0; j < 2; ++j) {
        const float bg = p.b_gate[l * 3072 + br * 1024 + n0 + EPI_COL(j)];
#pragma unroll
        for (int i = 0; i < 2; ++i)
#pragma unroll
          for (int e = 0; e < 4; ++e) {
            const unsigned q0 = (unsigned)(sigmoidf_(acc[i][j][4 * e] + bg) * 255.0f + 0.5f);
            const unsigned q1 = (unsigned)(sigmoidf_(acc[i][j][4 * e + 1] + bg) * 255.0f + 0.5f);
            const unsigned q2 = (unsigned)(sigmoidf_(acc[i][j][4 * e + 2] + bg) * 255.0f + 0.5f);
            const unsigned q3 = (unsigned)(sigmoidf_(acc[i][j][4 * e + 3] + bg) * 255.0f + 0.5f);
            gpl[((i * 2 + j) * 4 + e) * 512] = q0 | (q1 << 8) | (q2 << 16) | (q3 << 24);
          }
      }
    }
    {
      f32x16 acc[2][2];
      zero_acc(acc);
      const u16* A; const u16* B; int K;
      if (br == 0) { A = p.ycat + (size_t)m0 * 1024; B = p.WaT + ((size_t)l * 1024 + n0) * 512; K = 512; }
      else if (br == 1) { A = p.ycat + (size_t)m0 * 1024 + 512; B = p.WbT + ((size_t)l * 1024 + n0) * 256; K = 256; }
      else { A = p.ycat + (size_t)m0 * 1024 + 768; B = p.WcT + ((size_t)l * 1024 + n0) * 256; K = 256; }
      gemm_kloop(acc, A, 1024, B, K, K, smem);
#pragma unroll
      for (int i = 0; i < 2; ++i)
#pragma unroll
        for (int j = 0; j < 2; ++j)
#pragma unroll
          for (int e = 0; e < 4; ++e) {
            const unsigned g4 = gpl[((i * 2 + j) * 4 + e) * 512];
            macc[i][j][4 * e] += (float)(g4 & 255u) * (1.0f / 255.0f) * acc[i][j][4 * e];
            macc[i][j][4 * e + 1] += (float)((g4 >> 8) & 255u) * (1.0f / 255.0f) * acc[i][j][4 * e + 1];
            macc[i][j][4 * e + 2] += (float)((g4 >> 16) & 255u) * (1.0f / 255.0f) * acc[i][j][4 * e + 2];
            macc[i][j][4 * e + 3] += (float)(g4 >> 24) * (1.0f / 255.0f) * acc[i][j][4 * e + 3];
          }
    }
  }
#pragma unroll
  for (int i = 0; i < 2; ++i)
#pragma unroll
    for (int j = 0; j < 2; ++j)
#pragma unroll
      for (int e = 0; e < 16; ++e)
        p.mbuf[(size_t)(m0 + EPI_ROW(i, e)) * 1024 + n0 + EPI_COL(j)] = f2bf(macc[i][j][e]);
}
__device__ __forceinline__ void outproj_tile(const P& p, int l, int mt, int nt, char* smem, bool do_store) {
  EPI_VARS
  const int m0 = mt * 256, n0 = nt * 128;
  f32x16 acc[2][2];
  zero_acc(acc);
  gemm_kloop(acc, p.mbuf + (size_t)m0 * 1024, 1024, p.WoT + ((size_t)l * 1024 + n0) * 1024, 1024, 1024, smem);
  const bool isctx = (mt >= 128);
  const int bi = isctx ? 8 : (mt >> 4);
  const float* gatev = p.mod + ((size_t)(l * 9 + bi) * 6 + 2) * 1024;
  const float* src; float* dst;
  if (isctx) { src = (l == 0 ? p.ctx : p.ctxs) - (size_t)NLAT * 1024; dst = p.ctxs - (size_t)NLAT * 1024; }
  else { src = (l == 0 ? p.x : p.out); dst = p.out; }
#pragma unroll
  for (int j = 0; j < 2; ++j) {
    const int col = n0 + EPI_COL(j);
    const float gv = gatev[col];
#pragma unroll
    for (int i = 0; i < 2; ++i)
#pragma unroll
      for (int e = 0; e < 16; ++e) {
        const size_t o = (size_t)(m0 + EPI_ROW(i, e)) * 1024 + col;
        if (do_store) dst[o] = src[o] + gv * acc[i][j][e];
      }
  }
}

__device__ __forceinline__ void wqk_task(const P& p, int l, int hp, int nt, char* smem) {
  EPI_VARS
  f32x16 acc[2][2];
  zero_acc(acc);
  gemm_kloop(acc, p.keysB + ((size_t)l * 16 + hp) * 16384, 128, p.WqB + (size_t)l * 1024 * 2048 + (size_t)(nt * 128) * 2048 + hp * 128, 2048, 128, smem);
  if (wm < 2) {
#pragma unroll
    for (int i = 0; i < 2; ++i)
#pragma unroll
      for (int j = 0; j < 2; ++j)
#pragma unroll
        for (int e = 0; e < 16; ++e)
          p.WqkT[((size_t)l * 2048 + hp * 128 + EPI_ROW(i, e)) * 1024 + nt * 128 + EPI_COL(j)] = f2bf(acc[i][j][e]);
  }
}
__device__ __forceinline__ void ins16(unsigned (&L)[16], unsigned x) {
#pragma unroll
  for (int i = 0; i < 16; ++i) {
    const unsigned hi = max(L[i], x);
    x = min(L[i], x);
    L[i] = hi;
  }
}
__device__ __forceinline__ unsigned f2sort(float f) {
  const unsigned b = __float_as_uint(f);
  return b ^ ((unsigned)((int)b >> 31) | 0x80000000u);
}
__device__ __forceinline__ float sort2f(unsigned k) {
  const unsigned u = k & ~127u;
  const unsigned b = (u & 0x80000000u) ? (u ^ 0x80000000u) : ~u;
  return __uint_as_float(b);
}
__device__ __forceinline__ void cx_desc(unsigned& a, unsigned& b) { const unsigned hi = max(a, b), lo = min(a, b); a = hi; b = lo; }
template <int BASE> __device__ __forceinline__ void sort16_desc(unsigned (&k)[64]) {
#pragma unroll
  for (int sz = 2; sz <= 16; sz <<= 1) {
#pragma unroll
    for (int j = sz >> 1; j >= 1; j >>= 1) {
#pragma unroll
      for (int i = 0; i < 16; ++i) {
        const int l2 = i ^ j;
        if (l2 > i) {
          if ((i & sz) == 0) cx_desc(k[BASE + i], k[BASE + l2]);
          else cx_desc(k[BASE + l2], k[BASE + i]);
        }
      }
    }
  }
}
template <int AB, int BB> __device__ __forceinline__ void merge16_desc(unsigned (&k)[64]) {
#pragma unroll
  for (int i = 0; i < 16; ++i) k[AB + i] = max(k[AB + i], k[BB + 15 - i]);
#pragma unroll
  for (int j = 8; j >= 1; j >>= 1) {
#pragma unroll
    for (int i = 0; i < 16; ++i)
      if ((i & j) == 0) cx_desc(k[AB + i], k[AB + i + j]);
  }
}
__device__ __forceinline__ void peer_score_tile(const P& p, int l, int mt, int hp, char* smem) {
  const int tid = opaque_tid();
  const int m0 = mt * 256;
  const int row = tid >> 1, hf = tid & 1;
  {
    char* T = smem + 16384;
#pragma unroll
    for (int it = 0; it < 8; ++it) {
      const int id = tid + NTHR * it;
      const int r = id >> 4, ch = id & 15;
      *(uint4*)(T + r * 272 + ch * 16) = *(const uint4*)(p.q + (size_t)(m0 + r) * 2048 + hp * 128 + ch * 8);
    }
  }
  __syncthreads();
  const char* sp = smem + 16384 + row * 272 + hf * 128;
  unsigned k[64];
#pragma unroll
  for (int c = 0; c < 8; ++c) {
    const uint4 r = *(const uint4*)(sp + 16 * c);
    const unsigned w[4] = {r.x, r.y, r.z, r.w};
#pragma unroll
    for (int q = 0; q < 4; ++q) {
      const float v0 = __builtin_bit_cast(_Float16, (unsigned short)(w[q] & 0xffffu));
      const float v1 = __builtin_bit_cast(_Float16, (unsigned short)(w[q] >> 16));
      const int key = hf * 64 + c * 8 + q * 2;
      k[c * 8 + q * 2] = (f2sort(v0) & ~127u) | (unsigned)key;
      k[c * 8 + q * 2 + 1] = (f2sort(v1) & ~127u) | (unsigned)(key + 1);
    }
  }
  sort16_desc<0>(k); sort16_desc<16>(k); sort16_desc<32>(k); sort16_desc<48>(k);
  merge16_desc<0, 16>(k);
  merge16_desc<32, 48>(k);
  merge16_desc<0, 32>(k);
  unsigned* X = (unsigned*)smem;
  if (hf) {
#pragma unroll
    for (int i = 0; i < 16; ++i) X[row * 16 + i] = k[i];
  }
  __syncthreads();
  if (!hf) {
#pragma unroll
    for (int i = 0; i < 16; ++i) k[16 + i] = X[row * 16 + i];
    merge16_desc<0, 16>(k);
    unsigned* o = p.topk + ((size_t)(m0 + row) * 16 + hp) * 16;
#pragma unroll
    for (int i = 0; i < 4; ++i) *(uint4*)(o + 4 * i) = make_uint4(k[4 * i], k[4 * i + 1], k[4 * i + 2], k[4 * i + 3]);
  }
  __syncthreads();
}

__device__ __forceinline__ void phase_peer_experts(const P& p, int l, bool do_store, char* smem) {
  const int tid_ = opaque_tid(); const int lane = tid_ & 63, wid = tid_ >> 6;
  const int ntok = (l == 1) ? NLAT : NTOK;
  int ci, cj;
  {
    const int e = lane;
    if (e < 16) { ci = 0; cj = e; }
    else if (e < 24) { ci = 1; cj = e - 16; }
    else if (e < 29) { ci = 2; cj = e - 24; }
    else if (e < 33) { ci = 3; cj = e - 29; }
    else if (e < 36) { ci = 4; cj = e - 33; }
    else if (e < 38) { ci = 5; cj = e - 36; }
    else if (e < 40) { ci = 6; cj = e - 38; }
    else if (e < 42) { ci = 7; cj = e - 40; }
    else { ci = min(8 + (e - 42), 15); cj = 0; }
  }
  for (int tok = blockIdx.x * 8 + wid; tok < ntok; tok += gridDim.x * 8) {
    float xr[16];
    {
      const uint4 a = *(const uint4*)(p.xn + (size_t)tok * 1024 + lane * 16);
      const uint4 b = *(const uint4*)(p.xn + (size_t)tok * 1024 + lane * 16 + 8);
      xr[0] = bflo(a.x); xr[1] = bfhi(a.x); xr[2] = bflo(a.y); xr[3] = bfhi(a.y);
      xr[4] = bflo(a.z); xr[5] = bfhi(a.z); xr[6] = bflo(a.w); xr[7] = bfhi(a.w);
      xr[8] = bflo(b.x); xr[9] = bfhi(b.x); xr[10] = bflo(b.y); xr[11] = bfhi(b.y);
      xr[12] = bflo(b.z); xr[13] = bfhi(b.z); xr[14] = bflo(b.w); xr[15] = bfhi(b.w);
    }
    typedef _Float16 h2_t __attribute__((ext_vector_type(2)));
    h2_t yh[8];
#pragma unroll
    for (int i = 0; i < 8; ++i) yh[i] = (h2_t){(_Float16)0, (_Float16)0};
    int* selw = (int*)(smem + wid * 4096);
    const unsigned* kvp = p.topk + (size_t)tok * 256 + (lane & 31);
#pragma unroll 1
    for (int hb = 0; hb < 8; hb += 4) {
      unsigned key[4]; int eidx[4];
#pragma unroll
      for (int u = 0; u < 4; ++u) {
        const unsigned kv = kvp[(hb + u) * 32];
        const unsigned k0 = shu(kv, ci);
        const unsigned k1 = shu(kv, 16 + cj);
        const float val = (lane < 50) ? (sort2f(k0) + sort2f(k1)) : -3.0e38f;
        eidx[u] = (int)((k0 & 127u) * 128u + (k1 & 127u));
        key[u] = (f2sort(val) & ~63u) | (unsigned)lane;
      }
#pragma unroll
      for (int k = 2; k <= 64; k <<= 1) {
#pragma unroll
        for (int j = k >> 1; j >= 1; j >>= 1) {
          const bool take_max = (((lane & j) == 0) == ((lane & k) == 0));
#pragma unroll
          for (int u = 0; u < 4; ++u) {
            unsigned ok;
            if (j == 1) ok = xorl<1>(key[u], lane); else if (j == 2) ok = xorl<2>(key[u], lane); else if (j == 4) ok = xorl<4>(key[u], lane);
            else if (j == 8) ok = xorl<8>(key[u], lane); else if (j == 16) ok = xorl<16>(key[u], lane); else ok = xorl<32>(key[u], lane);
            key[u] = take_max ? max(key[u], ok) : min(key[u], ok);
          }
        }
      }
#pragma unroll
      for (int u = 0; u < 4; ++u) {
        const int si = __builtin_amdgcn_ds_bpermute((int)(key[u] & 63u) << 2, eidx[u]);
        const unsigned ku = key[u] & ~63u;
        const float sv = __uint_as_float((ku & 0x80000000u) ? (ku ^ 0x80000000u) : ~ku);
        const float mx = __builtin_bit_cast(float, __builtin_amdgcn_readlane(__builtin_bit_cast(int, sv), 0));
        const float ex = (lane < 16) ? __builtin_amdgcn_exp2f((sv - mx) * 1.4426950408889634f) : 0.f;
        const float sm = wave_sum(ex);
        selw[(hb + u) * 64 + lane] = si;
        selw[512 + (hb + u) * 64 + lane] = __builtin_bit_cast(int, ex * __builtin_amdgcn_rcpf(sm));
      }
    }
    {
      int w[4];
#pragma unroll
      for (int i = 0; i < 4; ++i) {
        int t = __builtin_amdgcn_cvt_pk_fp8_f32(xr[4 * i], xr[4 * i + 1], 0, false);
        w[i] = __builtin_amdgcn_cvt_pk_fp8_f32(xr[4 * i + 2], xr[4 * i + 3], t, true);
      }
      *(uint4*)(smem + 32768 + wid * 1024 + lane * 16) = make_uint4((unsigned)w[0], (unsigned)w[1], (unsigned)w[2], (unsigned)w[3]);
    }
    asm volatile("s_waitcnt lgkmcnt(0)" ::: "memory");
    const int e15 = lane & 15, g4 = lane >> 4;
#pragma unroll 1
    for (int h = 0; h < 8; ++h) {
      const int eperm_h = selw[h * 64 + lane];
      const int gperm_h = selw[512 + h * 64 + lane];
      const int ide = (int)shu((unsigned)eperm_h, e15);
      const unsigned char* ub = p.Ub + (size_t)ide * 1024 + g4 * 16;
      uint4 ua[8];
#pragma unroll
      for (int sI = 0; sI < 8; ++sI) ua[sI] = *(const uint4*)(ub + sI * 64);
      pg8::f32x4 hacc = {0.f, 0.f, 0.f, 0.f};
#pragma unroll
      for (int sI = 0; sI < 8; ++sI) {
        const uint4 b0 = *(const uint4*)(smem + 32768 + wid * 1024 + sI * 128 + g4 * 16);
        const uint4 b1 = *(const uint4*)(smem + 32768 + wid * 1024 + sI * 128 + 64 + g4 * 16);
        const i32x8 A = {(int)ua[sI].x, (int)ua[sI].y, (int)ua[sI].z, (int)ua[sI].w, 0, 0, 0, 0};
        const i32x8 B = {(int)b0.x, (int)b0.y, (int)b0.z, (int)b0.w, (int)b1.x, (int)b1.y, (int)b1.z, (int)b1.w};
        hacc = __builtin_amdgcn_mfma_scale_f32_16x16x128_f8f6f4(A, B, hacc, 4  , 0  , 0, 0x7f7f7f7f, 0, 0x7f7f7f7f);
      }
      asm volatile("" ::: "memory");
      uint2 V[16];
#pragma unroll
      for (int k = 0; k < 16; ++k) {
        const int id = __builtin_amdgcn_readlane(eperm_h, k);
        V[k] = *(const uint2*)(p.Ub + (size_t)id * 1024 + 512 + lane * 8);
      }
      float actv[4];
#pragma unroll
      for (int r4 = 0; r4 < 4; ++r4) {
        const float gl = __builtin_bit_cast(float, shu((unsigned)gperm_h, 4 * g4 + r4));
        actv[r4] = gelu_tanh(hacc[r4] * (1.0f / 64.0f)) * gl;
      }
#pragma unroll
      for (int k = 0; k < 16; ++k) {
        const float ak = __builtin_bit_cast(float, __builtin_amdgcn_readlane(__builtin_bit_cast(int, actv[k & 3]), 16 * (k >> 2)));
        const h2_t akh = {(_Float16)ak, (_Float16)ak};
        const unsigned vw[2] = {V[k].x, V[k].y};
#pragma unroll
        for (int q2 = 0; q2 < 2; ++q2) {
          yh[4 * q2 + 0] = __builtin_elementwise_fma(akh, __builtin_bit_cast(h2_t, __builtin_amdgcn_cvt_scalef32_pk_f16_fp4(vw[q2], 1.0f, 0)), yh[4 * q2 + 0]);
          yh[4 * q2 + 1] = __builtin_elementwise_fma(akh, __builtin_bit_cast(h2_t, __builtin_amdgcn_cvt_scalef32_pk_f16_fp4(vw[q2], 1.0f, 1)), yh[4 * q2 + 1]);
          yh[4 * q2 + 2] = __builtin_elementwise_fma(akh, __builtin_bit_cast(h2_t, __builtin_amdgcn_cvt_scalef32_pk_f16_fp4(vw[q2], 1.0f, 2)), yh[4 * q2 + 2]);
          yh[4 * q2 + 3] = __builtin_elementwise_fma(akh, __builtin_bit_cast(h2_t, __builtin_amdgcn_cvt_scalef32_pk_f16_fp4(vw[q2], 1.0f, 3)), yh[4 * q2 + 3]);
        }
      }
    }
    float yacc[16];
#pragma unroll
    for (int i = 0; i < 8; ++i) { yacc[2 * i] = (float)yh[i].x; yacc[2 * i + 1] = (float)yh[i].y; }
    const int bi = tok < NLAT ? (tok >> 12) : 8;
    const float* gv = p.mod + ((size_t)(l * 9 + bi) * 6 + 5) * 1024 + lane * 16;
    float* xp = (tok < NLAT) ? (p.out + (size_t)tok * 1024) : (p.ctxs + (size_t)(tok - NLAT) * 1024);
    xp += lane * 16;
    float4 xv[4];
    float ss = 0.f;
#pragma unroll
    for (int i = 0; i < 4; ++i) {
      xv[i] = *(float4*)(xp + 4 * i);
      const float4 g4 = *(const float4*)(gv + 4 * i);
      xv[i].x += g4.x * yacc[4 * i] * 0.25f; xv[i].y += g4.y * yacc[4 * i + 1] * 0.25f; xv[i].z += g4.z * yacc[4 * i + 2] * 0.25f; xv[i].w += g4.w * yacc[4 * i + 3] * 0.25f;
      ss += xv[i].x * xv[i].x + xv[i].y * xv[i].y + xv[i].z * xv[i].z + xv[i].w * xv[i].w;
    }
    ss = wave_sum(ss);
    const float rstd = rsqrtf(ss * (1.0f / 1024.0f) + 1e-6f);
    if (l == 0) {
      const float* gam = p.norm_mix_g + 1024 + lane * 16;
      const float* msh = p.mod + ((size_t)(9 + bi) * 6 + 0) * 1024 + lane * 16;
      const float* msc = msh + 1024;
      float yv[16];
      float amax = 0.f;
#pragma unroll
      for (int i = 0; i < 4; ++i) {
        if (do_store) *(float4*)(xp + 4 * i) = xv[i];
        const float4 g = *(const float4*)(gam + 4 * i);
        const float4 sh = *(const float4*)(msh + 4 * i);
        const float4 sc = *(const float4*)(msc + 4 * i);
        yv[4 * i] = xv[i].x * rstd * g.x * (1.f + sc.x) + sh.x; yv[4 * i + 1] = xv[i].y * rstd * g.y * (1.f + sc.y) + sh.y;
        yv[4 * i + 2] = xv[i].z * rstd * g.z * (1.f + sc.z) + sh.z; yv[4 * i + 3] = xv[i].w * rstd * g.w * (1.f + sc.w) + sh.w;
      }
#pragma unroll
      for (int i = 0; i < 16; ++i) amax = fmaxf(amax, fabsf(yv[i]));
      amax = fmaxf(wave_max(amax), 1e-20f);
      const float inv = 127.0f / amax;
      unsigned w[4];
#pragma unroll
      for (int i = 0; i < 4; ++i)
        w[i] = ((unsigned)__float2int_rn(yv[4 * i] * inv) & 255u) | (((unsigned)__float2int_rn(yv[4 * i + 1] * inv) & 255u) << 8) |
               (((unsigned)__float2int_rn(yv[4 * i + 2] * inv) & 255u) << 16) | (((unsigned)__float2int_rn(yv[4 * i + 3] * inv) & 255u) << 24);
      if (do_store) {
        *(uint4*)(p.xn8 + (size_t)tok * 1024 + lane * 16) = make_uint4(w[0], w[1], w[2], w[3]);
        if (lane == 0) p.sa[tok] = amax * (1.0f / 127.0f);
      }
    } else {
      const float* fg = p.final_g + lane * 16;
#pragma unroll
      for (int i = 0; i < 4; ++i) {
        const float4 g = *(const float4*)(fg + 4 * i);
        const float4 o = make_float4(xv[i].x * rstd * g.x, xv[i].y * rstd * g.y, xv[i].z * rstd * g.z, xv[i].w * rstd * g.w);
        if (do_store) *(float4*)(xp + 4 * i) = o;
      }
    }
  }
}


#define XB_TMO      128
#define XB_XCNT(j)  (256  + 64 * (j))
#define XB_XSUB(j)  (1280 + 64 * (j))
#define XB_XGEN(j)  (2304 + 64 * (j))
#define XB_TOP      3328
#define XB_TOPGEN   3392
#define XCD_BAR_WORDS 3456
#define XB_SPIN_CAP (1u << 22)
#define LAS __attribute__((address_space(3)))
__device__ __forceinline__ unsigned xb_ld(unsigned* p) { return __hip_atomic_load(p, __ATOMIC_RELAXED, __HIP_MEMORY_SCOPE_AGENT); }
__device__ __forceinline__ unsigned xb_add(unsigned* p, unsigned v) { return __hip_atomic_fetch_add(p, v, __ATOMIC_RELAXED, __HIP_MEMORY_SCOPE_AGENT); }
__device__ __forceinline__ unsigned xb_xcc_id() { return (unsigned)__builtin_amdgcn_s_getreg((3 << 11) | 20) & 0xFu; }
#define XB_SPIN(cond, bar) do { unsigned _sp = 0; while (cond) { __builtin_amdgcn_s_sleep(1); \
    if ((++_sp & 255u) == 0u) { if (xb_ld(&(bar)[XB_TMO])) break; if (_sp > XB_SPIN_CAP) { atomicAdd(&(bar)[XB_TMO], 1u); break; } } } } while (0)
struct XcdBarrier { unsigned* bar; unsigned x; volatile LAS unsigned* st; };
__device__ __forceinline__ XcdBarrier xcd_barrier_post(unsigned* bar, volatile LAS unsigned* st) {
  XcdBarrier b; b.bar = bar; b.x = xb_xcc_id(); b.st = st;
  if (threadIdx.x == 0) (void)xb_add(&bar[XB_XCNT(b.x)], 1u);
  return b;
}
__device__ __forceinline__ void xcd_barrier_complete(unsigned* bar, unsigned x, unsigned& nloc, unsigned& nx) {
  const unsigned G = gridDim.x * gridDim.y * gridDim.z;
  unsigned sum, cnt, mine, sp = 0u;
  for (;;) {
    sum = 0u; cnt = 0u; mine = 0u;
#pragma unroll
    for (unsigned j = 0; j < 16; ++j) { const unsigned c = xb_ld(&bar[XB_XCNT(j)]); sum += c; cnt += (c > 0u) ? 1u : 0u; mine = (j == x) ? c : mine; }
    if (sum == G) break;
    __builtin_amdgcn_s_sleep(1);
    if ((++sp & 255u) == 0u) { if (xb_ld(&bar[XB_TMO])) break; if (sp > XB_SPIN_CAP) { atomicAdd(&bar[XB_TMO], 1u); break; } }
  }
  nloc = mine > 0u ? mine : 1u; nx = cnt > 0u ? cnt : 1u;
}
__device__ __forceinline__ void xcd_barrier(unsigned* bar_u, volatile LAS unsigned* st_u) {
  XcdBarrier b; b.bar = bar_u; b.x = xb_xcc_id(); b.st = st_u;
  asm volatile("s_waitcnt vmcnt(0)" ::: "memory");
  __syncthreads();
  if (threadIdx.x == 0) {
    unsigned long long bp_ = (unsigned long long)b.bar;
    asm volatile("" : "+v"(bp_));
    unsigned* bar = (unsigned*)bp_;
    __builtin_amdgcn_s_waitcnt(0);
    unsigned nloc = b.st[0], nx = b.st[1];
    if (nloc == 0u) { xcd_barrier_complete(bar, b.x, nloc, nx); b.st[0] = nloc; b.st[1] = nx; }
    const unsigned old = xb_add(&bar[XB_XSUB(b.x)], 1u);
    const unsigned gen = old / nloc;
    if (old + 1u == (gen + 1u) * nloc) {
      __builtin_amdgcn_fence(__ATOMIC_RELEASE, "agent");
      asm volatile("s_waitcnt vmcnt(0)" ::: "memory");
      const unsigned og = xb_add(&bar[XB_TOP], 1u);
      const unsigned tg = og / nx;
      if (og + 1u == (tg + 1u) * nx) xb_add(&bar[XB_TOPGEN], 1u);
      else XB_SPIN(xb_ld(&bar[XB_TOPGEN]) == tg, bar);
      __builtin_amdgcn_fence(__ATOMIC_ACQUIRE, "agent");
      xb_add(&bar[XB_XGEN(b.x)], 1u);
      asm volatile("s_waitcnt vmcnt(0)" ::: "memory");
    } else {
      XB_SPIN(xb_ld(&bar[XB_XGEN(b.x)]) == gen, bar);
      __builtin_amdgcn_fence(__ATOMIC_ACQUIRE, "agent");
      asm volatile("s_waitcnt vmcnt(0)" ::: "memory");
    }
  }
  __syncthreads();
}

template <int l>
__device__ __forceinline__ void layer_body(const P& p, char* smem, pg8::PG8_LAS_T lds, volatile LAS unsigned* xbw, const int nb, const int bid) {
    const bool last = (l == 1);
    const int n_mt = last ? 128 : 136;
    if (l == 0) {
      phase_norm(p, l, 0);
      xcd_barrier(p.counters + 1024, xbw);
    }
_Pragma("unroll 1")
    for (int rep = 0; rep < REP_INPROJ; ++rep) {
      pg8::Gemm g; pg8::Order S;
      g.A = (const u16*)p.xn8; g.Bt = (const u16*)(p.Win8 + (size_t)l * 2816 * 1024); g.lda = 512; g.ldb = 512; g.K = 512;
      S.init(136, 6, nb, bid, 4, 5);
      pg8::EpiInprojN8 e1; e1.qk = p.qk; e1.rg = p.rg; e1.sa = p.sa; e1.sw = p.sw + l * 5888;
      pg8::gemm_phase(lds, g, S, e1);
      g.A = (const u16*)(p.Win8 + ((size_t)l * 2816 + 1024) * 1024); g.Bt = (const u16*)p.xn8;
      S.init(5, 136, nb, (bid + nb - (136 * 6) % nb) % nb);
      pg8::EpiInprojT8 e2; e2.vT = p.vT; e2.sa = p.sa; e2.sw = p.sw + l * 5888 + 1024;
      pg8::gemm_phase(lds, g, S, e2);
    }
    xcd_barrier(p.counters + 1024, xbw);
    phase_mixers(p, l, smem, p.counters + l * 4);
    xcd_barrier(p.counters + 1024, xbw);
_Pragma("unroll 1")
    for (int rep = 0; rep < REP_2B; ++rep)
      for (int task = bid; task < 1088 + 512; task += nb) {
        if (task < 1088) rg_wave_task(p, l, task >> 2, task & 3, 1, last, smem);
        else yb_transpose_task(p, (task - 1088) >> 6, (task - 1088) & 63, smem);
      }
    xcd_barrier(p.counters + 1024, xbw);
_Pragma("unroll 1")
    for (int rep = 0; rep < REP_GATE; ++rep) {
      pg8::Gemm g; pg8::Order S;
      g.A = (const u16*)p.xn8; g.Bt = (const u16*)(p.Wg8 + (size_t)l * 3072 * 1024); g.lda = 512; g.ldb = 512; g.K = 512;
      S.init(n_mt, 12, nb, bid);
      pg8::EpiGate8 e; e.g8 = p.g8; e.bias = p.b_gate + l * 3072; e.sa = p.sa; e.sw = p.sw + l * 5888 + 2816;
      pg8::gemm_phase(lds, g, S, e);
    }
    xcd_barrier(p.counters + 1024, xbw);
_Pragma("unroll 1")
    for (int rep = 0; rep < REP_BRANCH; ++rep) {
      pg8::Gemm g; pg8::Order S;
      S.init(n_mt, 4, nb, bid);
      pg8::EpiBranch e; e.mbuf = p.mbuf; e.g8 = p.g8;
      g.lda = 1024;
      g.A = p.ycat; g.Bt = p.WaT + (size_t)l * 1024 * 512; g.ldb = 512; g.K = 512; e.br = 0;
      pg8::gemm_phase(lds, g, S, e);
      g.A = p.ycat + 512; g.Bt = p.WbT + (size_t)l * 1024 * 256; g.ldb = 256; g.K = 256; e.br = 1;
      pg8::gemm_phase(lds, g, S, e);
      g.A = p.ycat + 768; g.Bt = p.WcT + (size_t)l * 1024 * 256; g.ldb = 256; g.K = 256; e.br = 2;
      pg8::gemm_phase(lds, g, S, e);
    }
    xcd_barrier(p.counters + 1024, xbw);
    {
      pg8::Gemm g; pg8::Order S;
      g.A = p.mbuf; g.Bt = p.WoT + (size_t)l * 1024 * 1024; g.lda = 1024; g.ldb = 1024; g.K = 1024;
      S.init(n_mt, 4, nb, bid);
      pg8::EpiOut e; e.xsrc = (l == 0 ? p.x : p.out); e.csrc = (l == 0 ? p.ctx : p.ctxs); e.xdst = p.out; e.cdst = p.ctxs;
      e.modl = p.mod + (size_t)l * 9 * 6144;
      pg8::gemm_phase(lds, g, S, e);
      for (int t = bid; t < 8192; t += nb) {
        if (t < 4096) cvt_chunk_fp4(p.peer_u + (size_t)l * 16384 * 1024, p.Ub, (size_t)t, 64.0f, 0);
        else cvt_chunk_fp4(p.peer_v + (size_t)l * 16384 * 1024, p.Ub, (size_t)(t - 4096), 4.0f, 1);
      }
    }
    xcd_barrier(p.counters + 1024, xbw);
    phase_norm(p, l, 1);
    xcd_barrier(p.counters + 1024, xbw);
_Pragma("unroll 1")
    for (int rep = 0; rep < REP_Q; ++rep) {
      pg8::Gemm g; pg8::Order S;
      g.A = p.xn; g.Bt = p.WqkT + (size_t)l * 2048 * 1024; g.lda = 1024; g.ldb = 1024; g.K = 1024;
      S.init(n_mt, 8, nb, bid);
      pg8::EpiQ e; e.q = p.q;
      pg8::gemm_phase(lds, g, S, e);
    }
    xcd_barrier(p.counters + 1024, xbw);
_Pragma("unroll 1")
    for (int rep = 0; rep < REP_SCORE; ++rep)
      for (int task = bid; task < n_mt * 16; task += nb) peer_score_tile(p, l, task >> 4, task & 15, smem);
    xcd_barrier(p.counters + 1024, xbw);
_Pragma("unroll 1")
    for (int rep = 0; rep < REP_PEER; ++rep) phase_peer_experts(p, l, rep == REP_PEER - 1, smem);
    xcd_barrier(p.counters + 1024, xbw);
  }

__global__ void __launch_bounds__(NTHR) fwd_megakernel(P p) {
  __shared__ __attribute__((aligned(16))) char smem[SMEM_BYTES];
  cg::grid_group grid = cg::this_grid();
  const int nb = gridDim.x, bid = blockIdx.x;
  pg8::PG8_LAS_T lds = (pg8::PG8_LAS_T)smem;
  volatile LAS unsigned* xbw = (volatile LAS unsigned*)(smem + SMEM_BYTES - 32);
  if (threadIdx.x == 0) { xbw[0] = 0u; xbw[1] = 0u; xbw[2] = 0u; xbw[3] = 0u; }
  __syncthreads();
  (void)xcd_barrier_post(p.counters + 1024, xbw);

  phase_prep(p, smem, p.counters + 32);
  grid.sync();
  phase_modreduce(p);
  for (int task = blockIdx.x; task < 512; task += gridDim.x) kf_task(p, task >> 8, task & 255, smem);
  for (int task = blockIdx.x; task < 256; task += gridDim.x) wqk_task(p, task >> 7, (task >> 3) & 15, task & 7, smem);
  for (int task = blockIdx.x; task < 2 * 368; task += gridDim.x) {
    const int l = task / 368, t = task - l * 368;
    if (t < 176) tr_tile4<true>(p.w_in + (size_t)l * 1024 * 2816, 2816, 1024, p.Win8 + (size_t)l * 2816 * 1024, t, p.sw + l * 5888, smem);
    else tr_tile4<true>(p.w_gate + (size_t)l * 1024 * 3072, 3072, 1024, p.Wg8 + (size_t)l * 3072 * 1024, t - 176, p.sw + l * 5888 + 2816, smem);
  }
  xcd_barrier(p.counters + 1024, xbw);

  layer_body<0>(p, smem, lds, xbw, nb, bid);
  layer_body<1>(p, smem, lds, xbw, nb, bid);
}

extern "C" void kernel_launch(void* const* d_in, const int* in_sizes, int n_in, void* d_out, int out_size, void* d_ws,
                              size_t ws_size, hipStream_t stream) {
  P p;
  memset(&p, 0, sizeof(p));
  const float** ins = (const float**)&p;
  for (int i = 0; i < 37; ++i) ins[i] = (const float*)d_in[i];
  p.out = (float*)d_out;
  char* w = (char*)d_ws;
  size_t off = 0;
  auto take = [&](size_t bytes) { char* r = w + off; off += (bytes + 255) & ~(size_t)255; return r; };
  p.counters = (unsigned*)take(32768);
  p.WinT = nullptr; p.WgT = nullptr;
  p.Win8 = (unsigned char*)take((size_t)2 * 2816 * 1024);
  p.Wg8 = (unsigned char*)take((size_t)2 * 3072 * 1024);
  p.sw = (float*)take((size_t)2 * 5888 * 4);
  p.xn8 = (unsigned char*)take((size_t)NTOK * 1024);
  p.sa = (float*)take((size_t)NTOK * 4);
  p.WaT = (u16*)take((size_t)2 * 1024 * 512 * 2);
  p.WbT = (u16*)take((size_t)2 * 1024 * 256 * 2);
  p.WcT = (u16*)take((size_t)2 * 1024 * 256 * 2);
  p.WoT = (u16*)take((size_t)2 * 1024 * 1024 * 2);
  p.WqB = (u16*)take((size_t)2 * 1024 * 2048 * 2);
  p.WqkT = (u16*)take((size_t)2 * 2048 * 1024 * 2);
  p.keysB = (u16*)take((size_t)2 * 16 * 16384 * 2);
  p.rgW = (u16*)take((size_t)2 * 16 * 4096 * 2);
  p.modpart = (float*)take((size_t)16 * 2 * 9 * 6144 * 4);
  p.mod = (float*)take((size_t)2 * 9 * 6144 * 4);
  p.hT = (float*)take((size_t)2 * 512 * 4096 * 4);
  p.hc = (float*)take((size_t)512 * 256 * 4);
  p.Kf = (float*)take((size_t)2 * 256 * 8192 * 8);
  p.xn = (u16*)take((size_t)NTOK * 1024 * 2);
  p.qk = (u16*)take((size_t)NTOK * 1024 * 2);
  p.mbuf = p.qk;
  p.vT = (u16*)take((size_t)8 * 512 * 4096 * 2);
  p.vTc = (u16*)take((size_t)8 * 512 * 256 * 2);
  p.hyT = (u16*)take((size_t)8 * 768 * 4096 * 2);
  p.hyTc = (u16*)take((size_t)8 * 768 * 256 * 2);
  p.rg = (u16*)take((size_t)NTOK * 512 * 2);
  p.ycat = (u16*)take((size_t)NTOK * 1024 * 2);
  p.Ub = (unsigned char*)p.ycat;
  p.Vb = p.Ub + (size_t)16384 * 512;
  p.agg = (float*)take((size_t)8 * 2 * (136 + 34) * 256 * 8);
  p.ybT = (u16*)take((size_t)8 * 256 * 4096 * 2);
  p.ctxs = (float*)take((size_t)2048 * 1024 * 4);
  p.g8 = (unsigned char*)p.vT;
  p.q = p.qk;
  p.topk = (unsigned*)((char*)p.qk + (size_t)NTOK * 2048 * 2);
  if (off > ws_size) {
    fprintf(stderr, "workspace too small: need %zu have %zu\n", off, ws_size);
    return;
  }
  static int grid_blocks = 0;
  if (!grid_blocks) {
    int dev = 0, cus = 0, per_cu = 0;
    (void)hipGetDevice(&dev);
    (void)hipDeviceGetAttribute(&cus, hipDeviceAttributeMultiprocessorCount, dev);
    (void)hipOccupancyMaxActiveBlocksPerMultiprocessor(&per_cu, fwd_megakernel, NTHR, 0);
    if (per_cu > 1) per_cu = 1;
    grid_blocks = cus * per_cu;
  }
  (void)hipMemsetAsync(p.counters, 0, 32768, stream);
  void* args[] = {&p};
  hipError_t e = hipLaunchCooperativeKernel((void*)fwd_megakernel, dim3(grid_blocks), dim3(NTHR), args, 0, stream);
  if (e != hipSuccess) fprintf(stderr, "cooperative launch failed: %s (grid %d)\n", hipGetErrorString(e), grid_blocks);
}
```

```cpp
#include <hip/hip_runtime.h>
#include <hip/hip_cooperative_groups.h>
#include <cstdio>
#include <cstring>
namespace cg = cooperative_groups;

typedef unsigned short u16;
typedef __attribute__((ext_vector_type(8))) short bf16x8;
typedef __attribute__((ext_vector_type(16))) float f32x16;
typedef __attribute__((ext_vector_type(2))) float f32x2;
typedef int i32x8 __attribute__((ext_vector_type(8)));

#define NLAT 32768
#define NTOK 34816
#define SMEM_BYTES 151552
#define NTHR 512
#ifndef DUP_1A
#define DUP_1A 1
#endif
#ifndef DUP_PREP
#define DUP_PREP 1
#endif
#ifndef DUP_2B
#define DUP_2B 1
#endif
#ifndef XRGA
#define XRGA 1
#endif
#ifndef REP_PEER
#define REP_PEER 1
#endif
#ifndef REP_INPROJ
#define REP_INPROJ 1
#endif
#ifndef REP_GATE
#define REP_GATE 1
#endif
#ifndef REP_BRANCH
#define REP_BRANCH 1
#endif
#ifndef REP_Q
#define REP_Q 1
#endif
#ifndef REP_SCORE
#define REP_SCORE 1
#endif
#ifndef REP_1A
#define REP_1A 1
#endif
#ifndef REP_2B
#define REP_2B 1
#endif
#ifndef REP_KF
#define REP_KF 1
#endif
#ifndef DUP_GEMM
#define DUP_GEMM 1
#endif
#ifndef DUP_PEER
#define DUP_PEER 1
#endif
#ifndef DUP_MIX
#define DUP_MIX 1
#endif
#ifndef XRG
#define XRG 1
#endif
#ifndef XFFT
#define XFFT 1
#endif
#ifndef XATT
#define XATT 1
#endif

struct P {
  const float *x, *c, *ctx, *c_ctx, *norm_mix_g, *norm_ffn_g, *w_ada, *b_ada, *w_in, *na_rpb,
      *hy_short_w, *hy_short_b, *hy_f1_w, *hy_f1_b, *hy_f2_w, *hy_f2_b, *hy_f3_w, *hy_freq, *hy_bias,
      *rg_conv_w, *rg_conv_b, *rg_wa, *rg_ba, *rg_wx, *rg_bx, *rg_lambda,
      *w_gate, *b_gate, *w_br_a, *w_br_b, *w_br_c, *w_out, *peer_wq, *peer_keys, *peer_u, *peer_v, *final_g;
  float* out;
  unsigned* counters;
  u16 *WinT, *WgT, *WaT, *WbT, *WcT, *WoT, *WqB, *WqkT, *keysB, *rgW;
  float *modpart, *mod, *hT, *hc;
  float* Kf;
  u16 *xn, *qk, *vT, *vTc, *hyT, *hyTc, *rg, *ycat, *mbuf, *ybT;
  unsigned char *Ub, *Vb, *g8, *xn8, *Win8, *Wg8;
  float *sa, *sw;
  u16* q;
  float *agg, *ctxs;
  unsigned* topk;
};

__device__ __forceinline__ u16 f2bf(float f) {
  unsigned u = __float_as_uint(f);
  u += 0x7fffu + ((u >> 16) & 1u);
  return (u16)(u >> 16);
}
__device__ __forceinline__ float bf2f(u16 h) { return __uint_as_float(((unsigned)h) << 16); }
__device__ __forceinline__ unsigned pk2(float a, float b) { return (unsigned)f2bf(a) | ((unsigned)f2bf(b) << 16); }
__device__ __forceinline__ float bflo(unsigned u) { return __uint_as_float(u << 16); }
__device__ __forceinline__ float bfhi(unsigned u) { return __uint_as_float(u & 0xffff0000u); }
__device__ __forceinline__ int opaque_tid() {
  int t = threadIdx.x;
  asm volatile("" : "+v"(t));
  return t;
}
__device__ __forceinline__ int my_lane() { return opaque_tid() & 63; }
__device__ __forceinline__ float shx(float v, int o);
__device__ __forceinline__ float shf(float v, int src) { return __builtin_bit_cast(float, __builtin_amdgcn_ds_bpermute((src & 63) << 2, __builtin_bit_cast(int, v))); }
__device__ __forceinline__ unsigned shu(unsigned v, int src) { return (unsigned)__builtin_amdgcn_ds_bpermute((src & 63) << 2, (int)v); }
typedef unsigned u32x2_t __attribute__((ext_vector_type(2)));
template <int J> __device__ __forceinline__ unsigned xorl(unsigned v, int lane) {
  if constexpr (J == 1) return (unsigned)__builtin_amdgcn_mov_dpp((int)v, 0xB1, 0xF, 0xF, true);
  else if constexpr (J == 2) return (unsigned)__builtin_amdgcn_mov_dpp((int)v, 0x4E, 0xF, 0xF, true);
  else if constexpr (J == 4) {
    const unsigned a = (unsigned)__builtin_amdgcn_mov_dpp((int)v, 0x104, 0xF, 0xF, true);
    const unsigned b = (unsigned)__builtin_amdgcn_mov_dpp((int)v, 0x114, 0xF, 0xF, true);
    return (lane & 4) ? b : a;
  }
  else if constexpr (J == 8) return (unsigned)__builtin_amdgcn_mov_dpp((int)v, 0x128, 0xF, 0xF, true);
  else if constexpr (J == 16) { const u32x2_t r = __builtin_amdgcn_permlane16_swap(v, v, false, false); return (lane & 16) ? r.x : r.y; }
  else { const u32x2_t r = __builtin_amdgcn_permlane32_swap(v, v, false, false); return (lane & 32) ? r.x : r.y; }
}
template <int J> __device__ __forceinline__ float xorf(float v, int lane) { return __uint_as_float(xorl<J>(__float_as_uint(v), lane)); }
__device__ __forceinline__ float shx(float v, int o) {
  const int lane = my_lane();
  switch (o) {
    case 1: return xorf<1>(v, lane);
    case 2: return xorf<2>(v, lane);
    case 4: return xorf<4>(v, lane);
    case 8: return xorf<8>(v, lane);
    case 16: return xorf<16>(v, lane);
    case 32: return xorf<32>(v, lane);
    default: return __builtin_bit_cast(float, __builtin_amdgcn_ds_bpermute(((lane ^ o) << 2), __builtin_bit_cast(int, v)));
  }
}
__device__ __forceinline__ float wave_sum(float v) {
  const int lane = my_lane();
  v += xorf<32>(v, lane); v += xorf<16>(v, lane); v += xorf<8>(v, lane); v += xorf<4>(v, lane); v += xorf<2>(v, lane); v += xorf<1>(v, lane);
  return v;
}
__device__ __forceinline__ float wave_max(float v) {
  const int lane = my_lane();
  v = fmaxf(v, xorf<32>(v, lane)); v = fmaxf(v, xorf<16>(v, lane)); v = fmaxf(v, xorf<8>(v, lane));
  v = fmaxf(v, xorf<4>(v, lane)); v = fmaxf(v, xorf<2>(v, lane)); v = fmaxf(v, xorf<1>(v, lane));
  return v;
}
__device__ __forceinline__ float sigmoidf_(float x) { return __builtin_amdgcn_rcpf(1.0f + __expf(-x)); }
__device__ __forceinline__ float gelu_tanh(float x) {
  const float u2 = 1.5957691216057308f * (x + 0.044715f * x * x * x);
  return x * __builtin_amdgcn_rcpf(1.0f + __expf(-u2));
}
__device__ __forceinline__ f32x16 mfma32(bf16x8 a, bf16x8 b, f32x16 c) {
  return __builtin_amdgcn_mfma_f32_32x32x16_bf16(a, b, c, 0, 0, 0);
}
__device__ __forceinline__ f32x16 zero16() {
  f32x16 z;
#pragma unroll
  for (int i = 0; i < 16; ++i) z[i] = 0.f;
  return z;
}
__device__ __forceinline__ int swz128(int row, int ch) { return row * 128 + ((ch ^ ((row >> 1) & 7)) << 4); }
__device__ __forceinline__ int swz256(int row, int ch) { return row * 256 + ((ch ^ (row & 15)) << 4); }

struct c2 { float x, y; };
__device__ __forceinline__ c2 cadd(c2 a, c2 b) { return {a.x + b.x, a.y + b.y}; }
__device__ __forceinline__ c2 csub(c2 a, c2 b) { return {a.x - b.x, a.y - b.y}; }
__device__ __forceinline__ c2 cmul(c2 a, c2 b) { return {a.x * b.x - a.y * b.y, a.x * b.y + a.y * b.x}; }
__device__ __forceinline__ float c16(int i) {
  const float tb[16] = {1.0f, 0.9238795325112867f, 0.7071067811865476f, 0.3826834323650898f, 0.0f,
                        -0.3826834323650898f, -0.7071067811865476f, -0.9238795325112867f, -1.0f,
                        -0.9238795325112867f, -0.7071067811865476f, -0.3826834323650898f, 0.0f,
                        0.3826834323650898f, 0.7071067811865476f, 0.9238795325112867f};
  return tb[i & 15];
}
__device__ __forceinline__ float s16(int i) { return c16(i + 12); }
template <int R> __device__ __forceinline__ constexpr int brev(int k) {
  int r = 0;
  for (int b = 1, o = R >> 1; b < R; b <<= 1, o >>= 1)
    if (k & b) r |= o;
  return r;
}
template <int R> __device__ __forceinline__ void dft_reg(c2* v, float sgn) {
#pragma unroll
  for (int h = R / 2; h >= 1; h >>= 1) {
#pragma unroll
    for (int g = 0; g < R; g += 2 * h) {
#pragma unroll
      for (int j = 0; j < h; ++j) {
        c2 a = v[g + j], b = v[g + j + h];
        v[g + j] = cadd(a, b);
        c2 d = csub(a, b);
        const int ti = j * (16 / (2 * h));
        c2 w = {c16(ti), sgn * s16(ti)};
        v[g + j + h] = (j == 0) ? d : cmul(d, w);
      }
    }
  }
}
template <int R> __device__ __forceinline__ int fft_bfly(c2* v, int j, int Ns, float sgn) {
  const int k = j & (Ns - 1);
  const float f = sgn * (float)k / (float)(Ns * R);
#pragma unroll
  for (int r = 1; r < R; ++r) {
    float t = f * (float)r;
    c2 w = {__builtin_amdgcn_cosf(t), __builtin_amdgcn_sinf(t)};
    v[r] = cmul(v[r], w);
  }
  dft_reg<R>(v, sgn);
  return (j - k) * R + k;
}
template <int R> __device__ __forceinline__ void fft_pass(c2* buf, int Ns, float sgn) {
  constexpr int NBF = 8192 / R;
  constexpr int PER = NBF / NTHR;
  const int tid = opaque_tid();
  c2 v[PER][R];
#pragma unroll
  for (int i = 0; i < PER; ++i) {
    const int j = tid + NTHR * i;
#pragma unroll
    for (int r = 0; r < R; ++r) v[i][r] = buf[j + r * NBF];
  }
  __syncthreads();
#pragma unroll
  for (int i = 0; i < PER; ++i) {
    const int j = tid + NTHR * i;
    const int base = fft_bfly<R>(v[i], j, Ns, sgn);
#pragma unroll
    for (int r = 0; r < R; ++r) buf[base + r * Ns] = v[i][brev<R>(r)];
  }
  __syncthreads();
}
__device__ __forceinline__ void fft8192(c2* buf, float sgn) {
  fft_pass<8>(buf, 1, sgn);
  fft_pass<8>(buf, 8, sgn);
  fft_pass<8>(buf, 64, sgn);
  fft_pass<16>(buf, 512, sgn);
}

__device__ __forceinline__ void gemm_kloop(f32x16 (&acc)[2][2], const u16* __restrict__ A, int lda,
                                           const u16* __restrict__ B, int ldb, int K, char* smem) {
  const int tid = opaque_tid(), lane = tid & 63, wid = tid >> 6;
  const int wm = wid >> 1, wn = wid & 1;
  const int l31 = lane & 31, hh = lane >> 5;
  uint4 ra[4], rb[2];
  const int nk = K >> 6;
  const int srow = tid >> 3, sch = tid & 7;
  const char* Ab = (const char*)A;
  const char* Bb = (const char*)B;
  const unsigned aoff = (unsigned)(srow * lda + sch * 8) * 2u;
  const unsigned boff = (unsigned)(srow * ldb + sch * 8) * 2u;
  const unsigned astep = (unsigned)lda * 128u, bstep = (unsigned)ldb * 128u;
#pragma unroll
  for (int i = 0; i < 4; ++i) ra[i] = *(const uint4*)(Ab + (aoff + i * astep));
#pragma unroll
  for (int i = 0; i < 2; ++i) rb[i] = *(const uint4*)(Bb + (boff + i * bstep));
#pragma unroll
  for (int i = 0; i < 4; ++i) *(uint4*)(smem + swz128(srow + i * 64, sch)) = ra[i];
#pragma unroll
  for (int i = 0; i < 2; ++i) *(uint4*)(smem + 65536 + swz128(srow + i * 64, sch)) = rb[i];
  __syncthreads();
  for (int kt = 0; kt < nk; ++kt) {
    const bool more = (kt + 1 < nk);
    if (more) {
      const unsigned ko = (unsigned)(kt + 1) * 128u;
#pragma unroll
      for (int i = 0; i < 4; ++i) ra[i] = *(const uint4*)(Ab + (aoff + i * astep + ko));
#pragma unroll
      for (int i = 0; i < 2; ++i) rb[i] = *(const uint4*)(Bb + (boff + i * bstep + ko));
    }
    const char* as = smem + (kt & 1) * 32768;
    const char* bs = smem + 65536 + (kt & 1) * 16384;
    int lrow = l31;
    asm volatile("" : "+v"(lrow));
#pragma unroll
    for (int s = 0; s < 4; ++s) {
      bf16x8 af[2], bfr[2];
#pragma unroll
      for (int i = 0; i < 2; ++i) af[i] = *(const bf16x8*)(as + swz128(wm * 64 + i * 32 + lrow, s * 2 + hh));
#pragma unroll
      for (int j = 0; j < 2; ++j) bfr[j] = *(const bf16x8*)(bs + swz128(wn * 64 + j * 32 + lrow, s * 2 + hh));
#pragma unroll
      for (int i = 0; i < 2; ++i)
#pragma unroll
        for (int j = 0; j < 2; ++j) acc[i][j] = mfma32(af[i], bfr[j], acc[i][j]);
    }
    if (more) {
      char* an = smem + ((kt + 1) & 1) * 32768;
      char* bn = smem + 65536 + ((kt + 1) & 1) * 16384;
      int sr2 = srow;
      asm volatile("" : "+v"(sr2));
#pragma unroll
      for (int i = 0; i < 4; ++i) *(uint4*)(an + swz128(sr2 + i * 64, sch)) = ra[i];
#pragma unroll
      for (int i = 0; i < 2; ++i) *(uint4*)(bn + swz128(sr2 + i * 64, sch)) = rb[i];
    }
    __syncthreads();
  }
}
__device__ __forceinline__ void zero_acc(f32x16 (&acc)[2][2]) {
#pragma unroll
  for (int i = 0; i < 2; ++i)
#pragma unroll
    for (int j = 0; j < 2; ++j) acc[i][j] = zero16();
}
#define EPI_ROW(i, e) (wm * 64 + (i)*32 + ((e)&3) + 8 * ((e) >> 2) + 4 * hh)
#define EPI_COL(j) (wn * 64 + (j)*32 + l31)
#define EPI_VARS                                                    \
  const int tid = opaque_tid(), lane = tid & 63, wid = tid >> 6;     \
  const int wm = wid >> 1, wn = wid & 1, l31 = lane & 31, hh = lane >> 5; \
  (void)tid; (void)wm; (void)wn; (void)l31; (void)hh;


namespace pg8 {
__device__ __forceinline__ unsigned pkh(float a, float b) { unsigned r; asm("v_cvt_pk_bf16_f32 %0, %1, %2" : "=v"(r) : "v"(a), "v"(b)); return r; }
#define PG8_LAS __attribute__((address_space(3)))
typedef PG8_LAS unsigned char* PG8_LAS_T;
typedef float f32x4 __attribute__((ext_vector_type(4)));
typedef unsigned u32x4 __attribute__((ext_vector_type(4)));
typedef int i32x4 __attribute__((ext_vector_type(4)));
constexpr int BM = 256, BK = 64, HALF = 128, HTB = HALF * BK * 2, STAGE_BYTES = 8 * HTB, NXCD = 8, WGM = 8;
__device__ __forceinline__ int lds_byte(int r, int c) { const int st = (r >> 4) * 2 + (c >> 5), rr = r & 15, cc = c & 31, ob = rr * 64 + cc * 2; return st * 1024 + (ob ^ (((ob >> 9) & 1) << 5)); }
__device__ __forceinline__ void stage_rc(int b, int& R, int& C) { const int st = b / 1024, sb = b % 1024, swz = sb ^ (((sb >> 9) & 1) << 5); R = (st >> 1) * 16 + swz / 64; C = (st & 1) * 32 + (swz % 64) / 2; }
__device__ __forceinline__ int perm32(int rho) { const int n = rho >> 4, i = rho & 15; return 8 * (i >> 2) + 4 * n + (i & 3); }
struct Unit { int pm, pn; };
struct Gemm { const u16* A; const u16* Bt; int lda, ldb, K; };
struct Order {
  int nM, nN, nwg, G, c, skip_from, skip_by;
  __device__ __forceinline__ void init(int nM_, int nN_, int G_, int c_, int sf = 1 << 30, int sb = 0) { nM = nM_; nN = nN_; nwg = nM * nN; G = G_; c = c_; skip_from = sf; skip_by = sb; }
  __device__ __forceinline__ bool next(int i, Unit& u) const {
    const long L = (long)i * G + c; if (L >= nwg) return false;
    int wgid = (int)L; { const int q = nwg / NXCD, r = nwg % NXCD, xcd = wgid % NXCD, off = wgid / NXCD; wgid = (xcd < r ? xcd * (q + 1) : r * (q + 1) + (xcd - r) * q) + off; }
    const int nig = WGM * nN, gid = wgid / nig, fm = gid * WGM, gsz = (nM - fm) < WGM ? (nM - fm) : WGM;
    u.pm = fm + ((wgid % nig) % gsz); u.pn = (wgid % nig) / gsz;
    if (u.pn >= skip_from) u.pn += skip_by;
    return true;
  }
};
__device__ __forceinline__ f32x4 mma16(bf16x8 a, bf16x8 b, f32x4 c) { return __builtin_amdgcn_mfma_f32_16x16x32_bf16(a, b, c, 0, 0, 0); }
__device__ __forceinline__ i32x4 mma16(bf16x8 a, bf16x8 b, i32x4 c) { return __builtin_amdgcn_mfma_i32_16x16x64_i8(__builtin_bit_cast(i32x4, a), __builtin_bit_cast(i32x4, b), c, 0, 0, 0); }
template <class Epi>
__device__ __forceinline__ void gemm_phase(PG8_LAS unsigned char* lds, const Gemm g, const Order& S, const Epi& E) {
  const int tid = opaque_tid(), wid = __builtin_amdgcn_readfirstlane(tid >> 6), lane = tid & 63, wr = wid >> 2, wc = wid & 3, fr = lane & 15, fq = lane >> 4;
  const int K = g.K, nt = K / BK;
  unsigned voffA[2], voffB[2];
#pragma unroll
  for (int i = 0; i < 2; ++i) { int R, C; stage_rc(tid * 16 + i * 8192, R, C); const int Rb = Epi::PERM ? ((R & ~31) + perm32(R & 31)) : R;
    voffA[i] = (unsigned)(R * g.lda + C) * 2u; voffB[i] = (unsigned)(Rb * g.ldb + C) * 2u; }
  const size_t kstep = (size_t)(BK * 2);
  const size_t hstepA = (size_t)HALF * g.lda * 2, hstepB = (size_t)HALF * g.ldb * 2;
  const size_t tstepA = 2 * hstepA, tstepB = 2 * hstepB;
  const unsigned ldsw = (unsigned)wid * 1024u;
  const int aoff = lds_byte(wr * 64 + fr, fq * 8), boff = lds_byte(wc * 32 + fr, fq * 8);
#define PG8_SA(b, h) (((b) * 2 + (h)) * HTB)
#define PG8_SB(b, h) ((4 + (b) * 2 + (h)) * HTB)
#define PG8_STAGE(bufoff, gbase, voff) do { _Pragma("unroll") for (int _i = 0; _i < 2; ++_i) \
    __builtin_amdgcn_global_load_lds((const unsigned*)((const char*)(gbase) + (voff)[_i]), (PG8_LAS unsigned*)(lds + (bufoff) + ldsw + _i * 8192), 16, 0, 0); } while (0)
#define PG8_LDA(dst, b, h) do { _Pragma("unroll") for (int m = 0; m < 4; ++m) _Pragma("unroll") for (int k = 0; k < 2; ++k) dst[m][k] = *(const PG8_LAS bf16x8*)(lds + PG8_SA(b, h) + aoff + m * 2048 + k * 1024); } while (0)
#define PG8_LDB(dst, b, h) do { _Pragma("unroll") for (int n = 0; n < 2; ++n) _Pragma("unroll") for (int k = 0; k < 2; ++k) dst[n][k] = *(const PG8_LAS bf16x8*)(lds + PG8_SB(b, h) + boff + n * 2048 + k * 1024); } while (0)
#define PG8_MMA(ai, bj, At, Bt) do { __builtin_amdgcn_s_setprio(1); _Pragma("unroll") for (int m = 0; m < 4; ++m) _Pragma("unroll") for (int n = 0; n < 2; ++n) _Pragma("unroll") for (int k = 0; k < 2; ++k) \
    acc[ai][bj][m][n] = mma16(Bt[n][k], At[m][k], acc[ai][bj][m][n]); __builtin_amdgcn_s_setprio(0); } while (0)
#define PG8_WAIT_V(n) asm volatile("s_waitcnt vmcnt(" #n ")" ::: "memory")
#define PG8_WAIT_L(n) asm volatile("s_waitcnt lgkmcnt(" #n ")" ::: "memory")
#define PG8_BAR __builtin_amdgcn_s_barrier()
#define PG8_SCHED __builtin_amdgcn_sched_barrier(0)
  Unit cur, nxt; int ui = 0;
  if (!S.next(0, cur)) return;
  typedef typename Epi::acc_t acc_t;
  acc_t acc[2][2][4][2];
#pragma unroll
  for (int a = 0; a < 2; ++a)
#pragma unroll
    for (int b = 0; b < 2; ++b)
#pragma unroll
      for (int m = 0; m < 4; ++m)
#pragma unroll
        for (int n = 0; n < 2; ++n) acc[a][b][m][n] = (acc_t){0, 0, 0, 0};
  bf16x8 At[4][2], B0[2][2], B1[2][2];
  const char* cA = (const char*)g.A + (size_t)cur.pm * tstepA; const char* cB = (const char*)g.Bt + (size_t)cur.pn * tstepB;
  PG8_STAGE(PG8_SB(0, 0), cB, voffB); PG8_STAGE(PG8_SA(0, 0), cA, voffA); PG8_STAGE(PG8_SB(0, 1), cB + hstepB, voffB); PG8_STAGE(PG8_SA(0, 1), cA + hstepA, voffA);
  if (wr == 1) PG8_BAR;
  PG8_WAIT_V(4); PG8_BAR;
  PG8_STAGE(PG8_SB(1, 0), cB + kstep, voffB); PG8_STAGE(PG8_SA(1, 0), cA + kstep, voffA); PG8_STAGE(PG8_SB(1, 1), cB + hstepB + kstep, voffB);
  PG8_WAIT_V(6); PG8_BAR;
  for (;;) {
    const bool has_next = S.next(ui + 1, nxt);
    const char* nA = has_next ? (const char*)g.A + (size_t)nxt.pm * tstepA : cA; const char* nB = has_next ? (const char*)g.Bt + (size_t)nxt.pn * tstepB : cB;
    for (int t = 0; t < nt; t += 2) {
      const bool last = (t == nt - 2);
      const char* a1 = cA + (size_t)(t + 1) * kstep;
      const char* a2 = last ? nA : cA + (size_t)(t + 2) * kstep; const char* b2 = last ? nB : cB + (size_t)(t + 2) * kstep;
      const char* a3 = a2 + kstep; const char* b3 = b2 + kstep;
      PG8_LDB(B0, 0, 0); PG8_SCHED; PG8_LDA(At, 0, 0); PG8_STAGE(PG8_SA(1, 1), a1 + hstepA, voffA);
      PG8_WAIT_L(8); PG8_BAR; PG8_WAIT_L(0); PG8_MMA(0, 0, At, B0); PG8_BAR; PG8_SCHED;
      PG8_LDB(B1, 0, 1); PG8_STAGE(PG8_SB(0, 0), b2, voffB);
      PG8_BAR; PG8_WAIT_L(0); PG8_MMA(0, 1, At, B1); PG8_BAR;
      PG8_LDA(At, 0, 1); PG8_STAGE(PG8_SA(0, 0), a2, voffA);
      PG8_BAR; PG8_WAIT_L(0); PG8_MMA(1, 0, At, B0); PG8_BAR; PG8_SCHED;
      PG8_STAGE(PG8_SB(0, 1), b2 + hstepB, voffB);
      PG8_WAIT_V(6); PG8_BAR; PG8_MMA(1, 1, At, B1); PG8_BAR;
      PG8_LDB(B0, 1, 0); PG8_SCHED; PG8_LDA(At, 1, 0); PG8_STAGE(PG8_SA(0, 1), a2 + hstepA, voffA);
      PG8_WAIT_L(8); PG8_BAR; PG8_WAIT_L(0); PG8_MMA(0, 0, At, B0); PG8_BAR; PG8_SCHED;
      PG8_LDB(B1, 1, 1); PG8_STAGE(PG8_SB(1, 0), b3, voffB);
      PG8_BAR; PG8_WAIT_L(0); PG8_MMA(0, 1, At, B1); PG8_BAR;
      PG8_LDA(At, 1, 1); PG8_STAGE(PG8_SA(1, 0), a3, voffA);
      PG8_BAR; PG8_WAIT_L(0); PG8_MMA(1, 0, At, B0); PG8_BAR; PG8_SCHED;
      PG8_STAGE(PG8_SB(1, 1), b3 + hstepB, voffB);
      PG8_WAIT_V(6); PG8_BAR; PG8_MMA(1, 1, At, B1); PG8_BAR;
    }
    E(acc, cur, wr, wc, fr, fq);
    if (!has_next) break;
#pragma unroll
    for (int a = 0; a < 2; ++a)
#pragma unroll
      for (int b = 0; b < 2; ++b)
#pragma unroll
        for (int m = 0; m < 4; ++m)
#pragma unroll
          for (int n = 0; n < 2; ++n) acc[a][b][m][n] = (acc_t){0, 0, 0, 0};
    cur = nxt; cA = nA; cB = nB; ++ui;
  }
  PG8_WAIT_V(0);
  if (wr == 0) PG8_BAR;
  PG8_BAR;
#undef PG8_SA
#undef PG8_SB
#undef PG8_STAGE
#undef PG8_LDA
#undef PG8_LDB
#undef PG8_MMA
#undef PG8_WAIT_V
#undef PG8_WAIT_L
#undef PG8_BAR
#undef PG8_SCHED
}
typedef const f32x4 (&AccRef)[2][2][4][2];
typedef const i32x4 (&AccRefI)[2][2][4][2];
struct EpiInprojN {
  static constexpr bool PERM = true;
  typedef f32x4 acc_t;
  u16* qk; u16* rg;
  __device__ __forceinline__ void operator()(AccRef acc, const Unit& u, int wr, int wc, int fr, int fq) const {
    const int row0 = u.pm * BM + wr * 64 + fr;
    u16* base; int ld, colt;
    if (u.pn < 4) { base = qk; ld = 1024; colt = u.pn * 256; } else { base = rg; ld = 512; colt = (u.pn - 9) * 256; }
    const int col0 = colt + wc * 32 + 8 * fq;
#pragma unroll
    for (int ai = 0; ai < 2; ++ai)
#pragma unroll
      for (int m = 0; m < 4; ++m) {
        u16* rowp = base + (size_t)(row0 + ai * HALF + m * 16) * ld + col0;
#pragma unroll
        for (int bj = 0; bj < 2; ++bj) {
          const f32x4 v0 = acc[ai][bj][m][0], v1 = acc[ai][bj][m][1];
          u32x4 w; w.x = pkh(v0[0], v0[1]); w.y = pkh(v0[2], v0[3]); w.z = pkh(v1[0], v1[1]); w.w = pkh(v1[2], v1[3]);
          *(u32x4*)(rowp + bj * HALF) = w;
        }
      }
  }
};
struct EpiInprojT {
  static constexpr bool PERM = true;
  typedef f32x4 acc_t;
  u16 *vT, *vTc, *hyT, *hyTc;
  __device__ __forceinline__ void operator()(AccRef acc, const Unit& u, int wr, int wc, int fr, int fq) const {
    const bool isctx = (u.pn >= 128);
    const int b = isctx ? (u.pn - 128) : (u.pn >> 4);
    const int Lseg = isctx ? 256 : 4096, t0 = isctx ? 0 : (u.pn & 15) * 256;
    const bool isv = (u.pm < 2);
    const size_t boff = isv ? (isctx ? (size_t)16777216 : (size_t)0) : (isctx ? (size_t)(16777216 + 1048576 + 25165824) : (size_t)(16777216 + 1048576));
    u16* base = vT + boff;
    const int nc = isv ? 512 : 768;
    const int wrow0 = (isv ? u.pm : u.pm - 2) * BM + wr * 64 + fr;
    const int col0 = t0 + wc * 32 + 8 * fq;
#pragma unroll
    for (int ai = 0; ai < 2; ++ai)
#pragma unroll
      for (int m = 0; m < 4; ++m) {
        u16* rowp = base + ((size_t)(b * nc + wrow0 + ai * HALF + m * 16)) * Lseg + col0;
#pragma unroll
        for (int bj = 0; bj < 2; ++bj) {
          const f32x4 v0 = acc[ai][bj][m][0], v1 = acc[ai][bj][m][1];
          u32x4 w; w.x = pkh(v0[0], v0[1]); w.y = pkh(v0[2], v0[3]); w.z = pkh(v1[0], v1[1]); w.w = pkh(v1[2], v1[3]);
          *(u32x4*)(rowp + bj * HALF) = w;
        }
      }
  }
};
struct EpiGate {
  static constexpr bool PERM = true;
  typedef f32x4 acc_t;
  unsigned char* g8; const float* bias;
  __device__ __forceinline__ void operator()(AccRef acc, const Unit& u, int wr, int wc, int fr, int fq) const {
    const int row0 = u.pm * BM + wr * 64 + fr;
    const int col0 = u.pn * BM + wc * 32 + 8 * fq;
#pragma unroll
    for (int bj = 0; bj < 2; ++bj) {
      const f32x4 b0 = *(const f32x4*)(bias + col0 + bj * HALF), b1 = *(const f32x4*)(bias + col0 + bj * HALF + 4);
#pragma unroll
      for (int ai = 0; ai < 2; ++ai)
#pragma unroll
        for (int m = 0; m < 4; ++m) {
          const f32x4 v0 = acc[ai][bj][m][0] + b0, v1 = acc[ai][bj][m][1] + b1;
          unsigned w0 = 0, w1 = 0;
#pragma unroll
          for (int k = 0; k < 4; ++k) {
            w0 |= (unsigned)(sigmoidf_(v0[k]) * 255.0f + 0.5f) << (8 * k);
            w1 |= (unsigned)(sigmoidf_(v1[k]) * 255.0f + 0.5f) << (8 * k);
          }
          *(uint2*)(g8 + (size_t)(row0 + ai * HALF + m * 16) * 3072 + col0 + bj * HALF) = make_uint2(w0, w1);
        }
    }
  }
};
struct EpiBranch {
  static constexpr bool PERM = true;
  typedef f32x4 acc_t;
  u16* mbuf; const unsigned char* g8; int br;
  __device__ __forceinline__ void operator()(AccRef acc, const Unit& u, int wr, int wc, int fr, int fq) const {
    const int row0 = u.pm * BM + wr * 64 + fr;
    const int col0 = u.pn * BM + wc * 32 + 8 * fq;
    uint2 gq[2][2][2];
    u32x4 o[2][2][2];
#define EB_LOAD(G) do { _Pragma("unroll") for (int j = 0; j < 2; ++j) _Pragma("unroll") for (int bj = 0; bj < 2; ++bj) { \
      const size_t row = (size_t)(row0 + (((G) * 2 + j) >> 2) * HALF + (((G) * 2 + j) & 3) * 16); \
      gq[(G) & 1][j][bj] = *(const uint2*)(g8 + row * 3072 + br * 1024 + col0 + bj * HALF); \
      if (br != 0) o[(G) & 1][j][bj] = *(const u32x4*)(mbuf + row * 1024 + col0 + bj * HALF); } } while (0)
    EB_LOAD(0);
#pragma unroll
    for (int G = 0; G < 4; ++G) {
      if (G < 3) EB_LOAD(G + 1);
#pragma unroll
      for (int j = 0; j < 2; ++j) {
        const int ai = (G * 2 + j) >> 2, m = (G * 2 + j) & 3;
        const size_t row = (size_t)(row0 + ai * HALF + m * 16);
#pragma unroll
        for (int bj = 0; bj < 2; ++bj) {
          const uint2 g = gq[G & 1][j][bj];
          u16* mp = mbuf + row * 1024 + col0 + bj * HALF;
          const f32x4 v0 = acc[ai][bj][m][0], v1 = acc[ai][bj][m][1];
          float r[8];
          r[0] = (float)(g.x & 255u) * v0[0]; r[1] = (float)((g.x >> 8) & 255u) * v0[1];
          r[2] = (float)((g.x >> 16) & 255u) * v0[2]; r[3] = (float)(g.x >> 24) * v0[3];
          r[4] = (float)(g.y & 255u) * v1[0]; r[5] = (float)((g.y >> 8) & 255u) * v1[1];
          r[6] = (float)((g.y >> 16) & 255u) * v1[2]; r[7] = (float)(g.y >> 24) * v1[3];
          u32x4 w;
          if (br == 0) {
            w.x = pkh(r[0] * (1.f / 255.f), r[1] * (1.f / 255.f)); w.y = pkh(r[2] * (1.f / 255.f), r[3] * (1.f / 255.f));
            w.z = pkh(r[4] * (1.f / 255.f), r[5] * (1.f / 255.f)); w.w = pkh(r[6] * (1.f / 255.f), r[7] * (1.f / 255.f));
          } else {
            const u32x4 ov = o[G & 1][j][bj];
            w.x = pkh(bflo(ov.x) + r[0] * (1.f / 255.f), bfhi(ov.x) + r[1] * (1.f / 255.f));
            w.y = pkh(bflo(ov.y) + r[2] * (1.f / 255.f), bfhi(ov.y) + r[3] * (1.f / 255.f));
            w.z = pkh(bflo(ov.z) + r[4] * (1.f / 255.f), bfhi(ov.z) + r[5] * (1.f / 255.f));
            w.w = pkh(bflo(ov.w) + r[6] * (1.f / 255.f), bfhi(ov.w) + r[7] * (1.f / 255.f));
          }
          *(u32x4*)mp = w;
        }
      }
    }
#undef EB_LOAD
  }
};
struct EpiOut {
  static constexpr bool PERM = false;
  typedef f32x4 acc_t;
  const float *xsrc, *csrc; float *xdst, *cdst; const float* modl;
  __device__ __forceinline__ void operator()(AccRef acc, const Unit& u, int wr, int wc, int fr, int fq) const {
    const bool isctx = (u.pm >= 128);
    const int bi = isctx ? 8 : (u.pm >> 4);
    const float* gatev = modl + ((size_t)bi * 6 + 2) * 1024;
    const float* src = isctx ? (csrc - (size_t)NLAT * 1024) : xsrc;
    float* dst = isctx ? (cdst - (size_t)NLAT * 1024) : xdst;
    const int row0 = u.pm * BM + wr * 64 + fr, col0 = u.pn * BM + wc * 32 + 4 * fq;
    f32x4 gv[4], xv[2][4];
#pragma unroll
    for (int g = 0; g < 4; ++g) gv[g] = *(const f32x4*)(gatev + col0 + (g >> 1) * HALF + (g & 1) * 16);
#define EO_LOAD(G) do { _Pragma("unroll") for (int m = 0; m < 4; ++m) \
      xv[(G) & 1][m] = *(const f32x4*)(src + (size_t)(row0 + ((G) & 1) * HALF + m * 16) * 1024 + col0 + ((G) >> 2) * HALF + (((G) >> 1) & 1) * 16); } while (0)
    EO_LOAD(0);
#pragma unroll
    for (int G = 0; G < 8; ++G) {
      const int bj = G >> 2, n = (G >> 1) & 1, ai = G & 1;
      if (G < 7) EO_LOAD(G + 1);
#pragma unroll
      for (int m = 0; m < 4; ++m) {
        const size_t o = (size_t)(row0 + ai * HALF + m * 16) * 1024 + col0 + bj * HALF + n * 16;
        *(f32x4*)(dst + o) = xv[G & 1][m] + gv[bj * 2 + n] * acc[ai][bj][m][n];
      }
    }
#undef EO_LOAD
  }
};
struct EpiQ {
  static constexpr bool PERM = true;
  typedef f32x4 acc_t;
  u16* q;
  __device__ __forceinline__ void operator()(AccRef acc, const Unit& u, int wr, int wc, int fr, int fq) const {
    const int row0 = u.pm * BM + wr * 64 + fr;
    const int col0 = u.pn * BM + wc * 32 + 8 * fq;
#pragma unroll
    for (int ai = 0; ai < 2; ++ai)
#pragma unroll
      for (int m = 0; m < 4; ++m) {
        u16* rowp = q + (size_t)(row0 + ai * HALF + m * 16) * 2048 + col0;
#pragma unroll
        for (int bj = 0; bj < 2; ++bj) {
          const f32x4 v0 = acc[ai][bj][m][0], v1 = acc[ai][bj][m][1];
          u32x4 w;
          w.x = __builtin_bit_cast(unsigned, __builtin_amdgcn_cvt_pkrtz(v0[0], v0[1]));
          w.y = __builtin_bit_cast(unsigned, __builtin_amdgcn_cvt_pkrtz(v0[2], v0[3]));
          w.z = __builtin_bit_cast(unsigned, __builtin_amdgcn_cvt_pkrtz(v1[0], v1[1]));
          w.w = __builtin_bit_cast(unsigned, __builtin_amdgcn_cvt_pkrtz(v1[2], v1[3]));
          *(u32x4*)(rowp + bj * HALF) = w;
        }
      }
  }
};
struct EpiInprojN8 {
  static constexpr bool PERM = true;
  typedef i32x4 acc_t;
  u16* qk; u16* rg; const float* sa; const float* sw;
  __device__ __forceinline__ void operator()(AccRefI acc, const Unit& u, int wr, int wc, int fr, int fq) const {
    const int row0 = u.pm * BM + wr * 64 + fr;
    u16* base; int ld, colt;
    if (u.pn < 4) { base = qk; ld = 1024; colt = u.pn * 256; } else { base = rg; ld = 512; colt = (u.pn - 9) * 256; }
    const int col0 = colt + wc * 32 + 8 * fq;
    const int wcol0 = u.pn * 256 + wc * 32 + 8 * fq;
    float rs[8];
    f32x4 cs[2][2];
#pragma unroll
    for (int i = 0; i < 8; ++i) rs[i] = sa[row0 + (i >> 2) * HALF + (i & 3) * 16];
#pragma unroll
    for (int bj = 0; bj < 2; ++bj) { cs[bj][0] = *(const f32x4*)(sw + wcol0 + bj * HALF); cs[bj][1] = *(const f32x4*)(sw + wcol0 + bj * HALF + 4); }
#pragma unroll
    for (int bj = 0; bj < 2; ++bj) {
      const f32x4 c0 = cs[bj][0], c1 = cs[bj][1];
#pragma unroll
      for (int ai = 0; ai < 2; ++ai)
#pragma unroll
        for (int m = 0; m < 4; ++m) {
          const int row = row0 + ai * HALF + m * 16;
          const float r = rs[ai * 4 + m];
          const i32x4 a0 = acc[ai][bj][m][0], a1 = acc[ai][bj][m][1];
          u32x4 w;
          w.x = pkh((float)a0[0] * r * c0[0], (float)a0[1] * r * c0[1]); w.y = pkh((float)a0[2] * r * c0[2], (float)a0[3] * r * c0[3]);
          w.z = pkh((float)a1[0] * r * c1[0], (float)a1[1] * r * c1[1]); w.w = pkh((float)a1[2] * r * c1[2], (float)a1[3] * r * c1[3]);
          *(u32x4*)(base + (size_t)row * ld + col0 + bj * HALF) = w;
        }
    }
  }
};
struct EpiInprojT8 {
  static constexpr bool PERM = true;
  typedef i32x4 acc_t;
  u16* vT; const float* sa; const float* sw;
  __device__ __forceinline__ void operator()(AccRefI acc, const Unit& u, int wr, int wc, int fr, int fq) const {
    const bool isctx = (u.pn >= 128);
    const int b = isctx ? (u.pn - 128) : (u.pn >> 4);
    const int Lseg = isctx ? 256 : 4096, t0 = isctx ? 0 : (u.pn & 15) * 256;
    const bool isv = (u.pm < 2);
    const size_t boff = isv ? (isctx ? (size_t)16777216 : (size_t)0) : (isctx ? (size_t)(16777216 + 1048576 + 25165824) : (size_t)(16777216 + 1048576));
    u16* base = vT + boff;
    const int nc = isv ? 512 : 768;
    const int wrow0 = (isv ? u.pm : u.pm - 2) * BM + wr * 64 + fr;
    const int srow0 = u.pm * BM + wr * 64 + fr;
    const int col0 = t0 + wc * 32 + 8 * fq;
    const int tok0 = u.pn * BM + wc * 32 + 8 * fq;
    float rs[8];
    f32x4 cs[2][2];
#pragma unroll
    for (int i = 0; i < 8; ++i) rs[i] = sw[srow0 + (i >> 2) * HALF + (i & 3) * 16];
#pragma unroll
    for (int bj = 0; bj < 2; ++bj) { cs[bj][0] = *(const f32x4*)(sa + tok0 + bj * HALF); cs[bj][1] = *(const f32x4*)(sa + tok0 + bj * HALF + 4); }
#pragma unroll
    for (int bj = 0; bj < 2; ++bj) {
      const f32x4 c0 = cs[bj][0], c1 = cs[bj][1];
#pragma unroll
      for (int ai = 0; ai < 2; ++ai)
#pragma unroll
        for (int m = 0; m < 4; ++m) {
          const float r = rs[ai * 4 + m];
          const i32x4 a0 = acc[ai][bj][m][0], a1 = acc[ai][bj][m][1];
          u32x4 w;
          w.x = pkh((float)a0[0] * r * c0[0], (float)a0[1] * r * c0[1]); w.y = pkh((float)a0[2] * r * c0[2], (float)a0[3] * r * c0[3]);
          w.z = pkh((float)a1[0] * r * c1[0], (float)a1[1] * r * c1[1]); w.w = pkh((float)a1[2] * r * c1[2], (float)a1[3] * r * c1[3]);
          *(u32x4*)(base + ((size_t)(b * nc + wrow0 + ai * HALF + m * 16)) * Lseg + col0 + bj * HALF) = w;
        }
    }
  }
};
struct EpiGate8 {
  static constexpr bool PERM = true;
  typedef i32x4 acc_t;
  unsigned char* g8; const float* bias; const float* sa; const float* sw;
  __device__ __forceinline__ void operator()(AccRefI acc, const Unit& u, int wr, int wc, int fr, int fq) const {
    const int row0 = u.pm * BM + wr * 64 + fr;
    const int col0 = u.pn * BM + wc * 32 + 8 * fq;
    typedef float f32x2 __attribute__((ext_vector_type(2)));
    float rs[8];
    f32x4 bs[2][2], cs[2][2];
#pragma unroll
    for (int i = 0; i < 8; ++i) rs[i] = sa[row0 + (i >> 2) * HALF + (i & 3) * 16];
#pragma unroll
    for (int bj = 0; bj < 2; ++bj) {
      bs[bj][0] = *(const f32x4*)(bias + col0 + bj * HALF); bs[bj][1] = *(const f32x4*)(bias + col0 + bj * HALF + 4);
      cs[bj][0] = *(const f32x4*)(sw + col0 + bj * HALF); cs[bj][1] = *(const f32x4*)(sw + col0 + bj * HALF + 4);
    }
#pragma unroll
    for (int bj = 0; bj < 2; ++bj) {
      f32x2 cn[4], bn[4];
#pragma unroll
      for (int k = 0; k < 2; ++k) {
        cn[k] = (f32x2){cs[bj][0][2 * k], cs[bj][0][2 * k + 1]} * -1.4426950408889634f; cn[2 + k] = (f32x2){cs[bj][1][2 * k], cs[bj][1][2 * k + 1]} * -1.4426950408889634f;
        bn[k] = (f32x2){bs[bj][0][2 * k], bs[bj][0][2 * k + 1]} * -1.4426950408889634f; bn[2 + k] = (f32x2){bs[bj][1][2 * k], bs[bj][1][2 * k + 1]} * -1.4426950408889634f;
      }
#pragma unroll
      for (int ai = 0; ai < 2; ++ai)
#pragma unroll
        for (int m = 0; m < 4; ++m) {
          const int row = row0 + ai * HALF + m * 16;
          const float r = rs[ai * 4 + m];
          const i32x4 a0 = acc[ai][bj][m][0], a1 = acc[ai][bj][m][1];
          unsigned qb[8];
#pragma unroll
          for (int k = 0; k < 4; ++k) {
            const f32x2 av = (k < 2) ? (f32x2){(float)a0[2 * k], (float)a0[2 * k + 1]} : (f32x2){(float)a1[2 * k - 4], (float)a1[2 * k - 3]};
            const f32x2 z = __builtin_elementwise_fma(av * r, cn[k], bn[k]);
            const f32x2 d = (f32x2){__builtin_amdgcn_exp2f(z.x), __builtin_amdgcn_exp2f(z.y)} + 1.0f;
            const f32x2 sg = {__builtin_amdgcn_rcpf(d.x), __builtin_amdgcn_rcpf(d.y)};
            const f32x2 q = __builtin_elementwise_fma(sg, (f32x2){255.0f, 255.0f}, (f32x2){8388608.0f, 8388608.0f});
            const float qx = q.x, qy = q.y;
            qb[2 * k] = __float_as_uint(qx); qb[2 * k + 1] = __float_as_uint(qy);
          }
          unsigned p0, p1, p2, p3;
          asm("v_perm_b32 %0, %1, %2, %3" : "=v"(p0) : "v"(qb[1]), "v"(qb[0]), "s"(0x0c0c0400u));
          asm("v_perm_b32 %0, %1, %2, %3" : "=v"(p1) : "v"(qb[3]), "v"(qb[2]), "s"(0x04000c0cu));
          asm("v_perm_b32 %0, %1, %2, %3" : "=v"(p2) : "v"(qb[5]), "v"(qb[4]), "s"(0x0c0c0400u));
          asm("v_perm_b32 %0, %1, %2, %3" : "=v"(p3) : "v"(qb[7]), "v"(qb[6]), "s"(0x04000c0cu));
          const unsigned w0 = p0 | p1, w1 = p2 | p3;
          *(uint2*)(g8 + (size_t)row * 3072 + col0 + bj * HALF) = make_uint2(w0, w1);
        }
    }
  }
};
}

__device__ __forceinline__ void tr_tile(const float* __restrict__ src, int N, int K, u16* __restrict__ dst, int tile, char* smem) {
  float* lds = (float*)smem;
  const int tiles_n = N >> 6;
  const int tk = tile / tiles_n, tn = tile - tk * tiles_n;
  const int tid = opaque_tid();
  {
    const int r = tid >> 3, c8 = (tid & 7) * 8;
    const float* s = src + (size_t)(tk * 64 + r) * N + tn * 64 + c8;
    float4 a = *(const float4*)s, b = *(const float4*)(s + 4);
    float* d = lds + r * 65 + c8;
    d[0] = a.x; d[1] = a.y; d[2] = a.z; d[3] = a.w; d[4] = b.x; d[5] = b.y; d[6] = b.z; d[7] = b.w;
  }
  __syncthreads();
  {
    const int n = tid >> 3, k0 = (tid & 7) * 8;
    uint4 o;
    o.x = pk2(lds[(k0 + 0) * 65 + n], lds[(k0 + 1) * 65 + n]);
    o.y = pk2(lds[(k0 + 2) * 65 + n], lds[(k0 + 3) * 65 + n]);
    o.z = pk2(lds[(k0 + 4) * 65 + n], lds[(k0 + 5) * 65 + n]);
    o.w = pk2(lds[(k0 + 6) * 65 + n], lds[(k0 + 7) * 65 + n]);
    *(uint4*)(dst + (size_t)(tn * 64 + n) * K + tk * 64 + k0) = o;
  }
  __syncthreads();
}
__device__ __forceinline__ void colmax_task(const float* __restrict__ w, int N, int n0, float* __restrict__ swp, char* smem) {
  const int tid = opaque_tid();
  const int col = tid & 63, kg = tid >> 6;
  float m = 0.f;
  const float* wp = w + (size_t)(kg * 128) * N + n0 + col;
#pragma unroll 16
  for (int k = 0; k < 128; ++k) m = fmaxf(m, fabsf(wp[(size_t)k * N]));
  float* red = (float*)smem;
  red[kg * 64 + col] = m;
  __syncthreads();
  if (tid < 64) {
    float mm = red[tid];
#pragma unroll
    for (int g = 1; g < 8; ++g) mm = fmaxf(mm, red[g * 64 + tid]);
    swp[n0 + tid] = fmaxf(mm, 1e-20f) * (1.0f / 127.0f);
  }
  __syncthreads();
}
__device__ __forceinline__ void tr_tile_i8(const float* __restrict__ src, int N, int K, unsigned char* __restrict__ dst, int tile, const float* __restrict__ swp, char* smem) {
  float* lds = (float*)smem;
  const int tiles_n = N >> 6;
  const int tk = tile / tiles_n, tn = tile - tk * tiles_n;
  const int tid = opaque_tid();
  {
    const int r = tid >> 3, c8 = (tid & 7) * 8;
    const float* sp = src + (size_t)(tk * 64 + r) * N + tn * 64 + c8;
    float4 a = *(const float4*)sp, b = *(const float4*)(sp + 4);
    float* d = lds + r * 65 + c8;
    d[0] = a.x; d[1] = a.y; d[2] = a.z; d[3] = a.w; d[4] = b.x; d[5] = b.y; d[6] = b.z; d[7] = b.w;
  }
  __syncthreads();
  {
    const int n = tid >> 3, k0 = (tid & 7) * 8;
    const float inv = 1.0f / swp[tn * 64 + n];
    unsigned w0 = 0, w1 = 0;
#pragma unroll
    for (int i = 0; i < 4; ++i) {
      w0 |= ((unsigned)__float2int_rn(lds[(k0 + i) * 65 + n] * inv) & 255u) << (8 * i);
      w1 |= ((unsigned)__float2int_rn(lds[(k0 + 4 + i) * 65 + n] * inv) & 255u) << (8 * i);
    }
    *(uint2*)(dst + (size_t)(tn * 64 + n) * K + tk * 64 + k0) = make_uint2(w0, w1);
  }
  __syncthreads();
}
__device__ __forceinline__ void cvt_chunk(const float* __restrict__ src, u16* __restrict__ dst, size_t chunk) {
  const size_t i = chunk * 4096 + (size_t)opaque_tid() * 8;
  float4 a = *(const float4*)(src + i), b = *(const float4*)(src + i + 4);
  uint4 o;
  o.x = pk2(a.x, a.y); o.y = pk2(a.z, a.w); o.z = pk2(b.x, b.y); o.w = pk2(b.z, b.w);
  *(uint4*)(dst + i) = o;
}
template <bool I8>
__device__ __forceinline__ void tr_tile4(const float* __restrict__ src, int N, int K, void* __restrict__ dstv, int tile4, const float* __restrict__ swp, char* smem) {
  float* lds = (float*)smem;
  const int tiles_n = N >> 6;
  const int tkq = tile4 / tiles_n, tn = tile4 - tkq * tiles_n;
  const int tid = opaque_tid();
  {
    const int r = tid >> 3, c8 = (tid & 7) * 8;
    const float* sp = src + (size_t)(tkq * 256 + r) * N + tn * 64 + c8;
    float4 a[4], b[4];
#pragma unroll
    for (int q = 0; q < 4; ++q) { a[q] = *(const float4*)(sp + (size_t)q * 64 * N); b[q] = *(const float4*)(sp + (size_t)q * 64 * N + 4); }
#pragma unroll
    for (int q = 0; q < 4; ++q) {
      float* d = lds + q * 4160 + r * 65 + c8;
      d[0] = a[q].x; d[1] = a[q].y; d[2] = a[q].z; d[3] = a[q].w; d[4] = b[q].x; d[5] = b[q].y; d[6] = b[q].z; d[7] = b[q].w;
    }
  }
  __syncthreads();
  {
    const int n = tid >> 3, k0 = (tid & 7) * 8;
    if (I8) {
      const float inv = 1.0f / swp[tn * 64 + n];
      unsigned char* dst = (unsigned char*)dstv;
#pragma unroll
      for (int q = 0; q < 4; ++q) {
        const float* lq = lds + q * 4160;
        unsigned w0 = 0, w1 = 0;
#pragma unroll
        for (int i = 0; i < 4; ++i) {
          w0 |= ((unsigned)__float2int_rn(lq[(k0 + i) * 65 + n] * inv) & 255u) << (8 * i);
          w1 |= ((unsigned)__float2int_rn(lq[(k0 + 4 + i) * 65 + n] * inv) & 255u) << (8 * i);
        }
        *(uint2*)(dst + (size_t)(tn * 64 + n) * K + tkq * 256 + q * 64 + k0) = make_uint2(w0, w1);
      }
    } else {
      u16* dst = (u16*)dstv;
#pragma unroll
      for (int q = 0; q < 4; ++q) {
        const float* lq = lds + q * 4160;
        uint4 o;
        o.x = pk2(lq[(k0 + 0) * 65 + n], lq[(k0 + 1) * 65 + n]);
        o.y = pk2(lq[(k0 + 2) * 65 + n], lq[(k0 + 3) * 65 + n]);
        o.z = pk2(lq[(k0 + 4) * 65 + n], lq[(k0 + 5) * 65 + n]);
        o.w = pk2(lq[(k0 + 6) * 65 + n], lq[(k0 + 7) * 65 + n]);
        *(uint4*)(dst + (size_t)(tn * 64 + n) * K + tkq * 256 + q * 64 + k0) = o;
      }
    }
  }
  __syncthreads();
}
__device__ __forceinline__ void colmax4_task(const float* __restrict__ w, int N, int n0, float* __restrict__ swp, char* smem) {
  const int tid = opaque_tid();
  const int c4 = (tid & 15) * 4, rg = tid >> 4;
  const float* wp = w + (size_t)(rg * 32) * N + n0 + c4;
  float4 m = {0.f, 0.f, 0.f, 0.f};
#pragma unroll 16
  for (int k = 0; k < 32; ++k) {
    const float4 v = *(const float4*)(wp + (size_t)k * N);
    m.x = fmaxf(m.x, fabsf(v.x)); m.y = fmaxf(m.y, fabsf(v.y)); m.z = fmaxf(m.z, fabsf(v.z)); m.w = fmaxf(m.w, fabsf(v.w));
  }
  float* red = (float*)smem;
  *(float4*)(red + rg * 64 + c4) = m;
  __syncthreads();
  if (tid < 64) {
    float mm = red[tid];
#pragma unroll
    for (int g = 1; g < 32; ++g) mm = fmaxf(mm, red[g * 64 + tid]);
    swp[n0 + tid] = fmaxf(mm, 1e-20f) * (1.0f / 127.0f);
  }
  __syncthreads();
}
__device__ __forceinline__ void cvt_chunk4(const float* __restrict__ src, u16* __restrict__ dst, size_t chunk4) {
  const size_t i = chunk4 * 16384 + (size_t)opaque_tid() * 8;
  float4 a[4], b[4];
#pragma unroll
  for (int q = 0; q < 4; ++q) { a[q] = *(const float4*)(src + i + q * 4096); b[q] = *(const float4*)(src + i + q * 4096 + 4); }
#pragma unroll
  for (int q = 0; q < 4; ++q) {
    uint4 o;
    o.x = pk2(a[q].x, a[q].y); o.y = pk2(a[q].z, a[q].w); o.z = pk2(b[q].x, b[q].y); o.w = pk2(b[q].z, b[q].w);
    *(uint4*)(dst + i + q * 4096) = o;
  }
}
__device__ __forceinline__ void cvt_chunk_fp8(const float* __restrict__ src, unsigned char* __restrict__ dst, size_t chunk, float scale) {
  const size_t i = chunk * 4096 + (size_t)opaque_tid() * 8;
  const float4 a = *(const float4*)(src + i), b = *(const float4*)(src + i + 4);
  int w0 = __builtin_amdgcn_cvt_pk_fp8_f32(a.x * scale, a.y * scale, 0, false);
  w0 = __builtin_amdgcn_cvt_pk_fp8_f32(a.z * scale, a.w * scale, w0, true);
  int w1 = __builtin_amdgcn_cvt_pk_fp8_f32(b.x * scale, b.y * scale, 0, false);
  w1 = __builtin_amdgcn_cvt_pk_fp8_f32(b.z * scale, b.w * scale, w1, true);
  *(uint2*)(dst + i) = make_uint2((unsigned)w0, (unsigned)w1);
}
__device__ __forceinline__ void cvt_chunk_fp4(const float* __restrict__ src, unsigned char* __restrict__ dst, size_t chunk, float scale, int vhalf) {
  const size_t i = chunk * 4096 + (size_t)opaque_tid() * 8;
  const float4 a = *(const float4*)(src + i), b = *(const float4*)(src + i + 4);
  unsigned w = 0;
  w = __builtin_amdgcn_cvt_scalef32_pk_fp4_f32(w, a.x * scale, a.y * scale, 1.0f, 0);
  w = __builtin_amdgcn_cvt_scalef32_pk_fp4_f32(w, a.z * scale, a.w * scale, 1.0f, 1);
  w = __builtin_amdgcn_cvt_scalef32_pk_fp4_f32(w, b.x * scale, b.y * scale, 1.0f, 2);
  w = __builtin_amdgcn_cvt_scalef32_pk_fp4_f32(w, b.z * scale, b.w * scale, 1.0f, 3);
  const size_t e = i >> 10;
  const unsigned d = (unsigned)(i & 1023);
  *(unsigned*)(dst + e * 1024 + vhalf * 512 + (d >> 1)) = w;
}
__device__ __forceinline__ void phase_modreduce(const P& p) {
  const int n = 2 * 9 * 6144;
  for (int i = blockIdx.x * NTHR + opaque_tid(); i < n; i += gridDim.x * NTHR) {
    const int l = i / (9 * 6144);
    const int j = i % 6144;
    float s = p.b_ada[l * 6144 + j];
#pragma unroll
    for (int kc = 0; kc < 16; ++kc) s += p.modpart[(size_t)kc * n + i];
    p.mod[i] = s;
  }
}

__device__ __forceinline__ void phase_norm(const P& p, int l, int which) {
  const int tid_ = opaque_tid(); const int lane = tid_ & 63, wid = tid_ >> 6;
  const int ntok = (which == 2 || (which == 1 && l == 1)) ? NLAT : NTOK;
  float4 vn[4];
  {
    const int row = blockIdx.x * 8 + wid;
    if (row < ntok) {
      const float* src = (row < NLAT) ? ((which == 0 && l == 0) ? p.x : p.out) + (size_t)row * 1024 : ((which == 0 && l == 0) ? p.ctx : p.ctxs) + (size_t)(row - NLAT) * 1024;
#pragma unroll
      for (int i = 0; i < 4; ++i) vn[i] = *(const float4*)(src + i * 256 + lane * 4);
    }
  }
  for (int row = blockIdx.x * 8 + wid; row < ntok; row += gridDim.x * 8) {
    float4 v[4];
    float ss = 0.f;
#pragma unroll
    for (int i = 0; i < 4; ++i) {
      v[i] = vn[i];
      ss += v[i].x * v[i].x + v[i].y * v[i].y + v[i].z * v[i].z + v[i].w * v[i].w;
    }
    {
      const int nrow = row + gridDim.x * 8;
      if (nrow < ntok) {
        const float* src = (nrow < NLAT) ? ((which == 0 && l == 0) ? p.x : p.out) + (size_t)nrow * 1024 : ((which == 0 && l == 0) ? p.ctx : p.ctxs) + (size_t)(nrow - NLAT) * 1024;
#pragma unroll
        for (int i = 0; i < 4; ++i) vn[i] = *(const float4*)(src + i * 256 + lane * 4);
      }
    }
    ss = wave_sum(ss);
    const float rstd = rsqrtf(ss * (1.0f / 1024.0f) + 1e-6f);
    if (which == 2) {
#pragma unroll
      for (int i = 0; i < 4; ++i) {
        const int col = i * 256 + lane * 4;
        const float4 g = *(const float4*)(p.final_g + col);
        float4 o = {v[i].x * rstd * g.x, v[i].y * rstd * g.y, v[i].z * rstd * g.z, v[i].w * rstd * g.w};
        *(float4*)(p.out + (size_t)row * 1024 + col) = o;
      }
    } else {
      const int bi = row < NLAT ? (row >> 12) : 8;
      const float* gam = (which == 0 ? p.norm_mix_g : p.norm_ffn_g) + l * 1024;
      const float* msh = p.mod + ((size_t)(l * 9 + bi) * 6 + (which == 0 ? 0 : 3)) * 1024;
      const float* msc = msh + 1024;
      float4 y[4];
      float amax = 0.f;
#pragma unroll
      for (int i = 0; i < 4; ++i) {
        const int col = i * 256 + lane * 4;
        const float4 g = *(const float4*)(gam + col);
        const float4 sh = *(const float4*)(msh + col);
        const float4 sc = *(const float4*)(msc + col);
        y[i].x = v[i].x * rstd * g.x * (1.f + sc.x) + sh.x; y[i].y = v[i].y * rstd * g.y * (1.f + sc.y) + sh.y;
        y[i].z = v[i].z * rstd * g.z * (1.f + sc.z) + sh.z; y[i].w = v[i].w * rstd * g.w * (1.f + sc.w) + sh.w;
        amax = fmaxf(amax, fmaxf(fmaxf(fabsf(y[i].x), fabsf(y[i].y)), fmaxf(fabsf(y[i].z), fabsf(y[i].w))));
      }
      if (which == 0) {
        amax = fmaxf(wave_max(amax), 1e-20f);
        const float inv = 127.0f / amax;
#pragma unroll
        for (int i = 0; i < 4; ++i) {
          const unsigned w = ((unsigned)__float2int_rn(y[i].x * inv) & 255u) | (((unsigned)__float2int_rn(y[i].y * inv) & 255u) << 8) |
                             (((unsigned)__float2int_rn(y[i].z * inv) & 255u) << 16) | (((unsigned)__float2int_rn(y[i].w * inv) & 255u) << 24);
          *(unsigned*)(p.xn8 + (size_t)row * 1024 + i * 256 + lane * 4) = w;
        }
        if (lane == 0) p.sa[row] = amax * (1.0f / 127.0f);
      } else {
#pragma unroll
        for (int i = 0; i < 4; ++i) {
          uint2 o;
          o.x = pk2(y[i].x, y[i].y);
          o.y = pk2(y[i].z, y[i].w);
          *(uint2*)(p.xn + (size_t)row * 1024 + i * 256 + lane * 4) = o;
        }
      }
    }
  }
}

__device__ __forceinline__ void filter_wave(const P& p, int l, int L, int t, float* __restrict__ outp) {
  const int lane = opaque_tid() & 63;
  const float tl = (float)t / (float)(L - 1);
  const float wang = (6.283185307179586f / (float)L) * (float)t;
  float z = 0.f;
  if (lane == 0) z = tl;
  else if (lane <= 16) { const float band = 1e-4f + (float)(lane - 1) * ((15.0f - 1e-4f) / 15.0f); z = cosf(band * wang); }
  else if (lane <= 32) { const float band = 1e-4f + (float)(lane - 17) * ((15.0f - 1e-4f) / 15.0f); z = -sinf(band * wang); }
  float a1 = p.hy_f1_b[l * 64 + lane];
  for (int i = 0; i < 33; ++i) a1 += shf(z, i) * p.hy_f1_w[(l * 33 + i) * 64 + lane];
  const float h1 = sinf(p.hy_freq[l * 128 + lane] * a1);
  float a2 = p.hy_f2_b[l * 64 + lane];
  for (int i = 0; i < 64; ++i) a2 += shf(h1, i) * p.hy_f2_w[(l * 64 + i) * 64 + lane];
  const float h2 = sinf(p.hy_freq[l * 128 + 64 + lane] * a2);
  float a3[8];
#pragma unroll
  for (int m = 0; m < 8; ++m) a3[m] = 0.f;
  for (int i = 0; i < 64; ++i) {
    const float hv = shf(h2, i);
    const float* wr = p.hy_f3_w + (size_t)(l * 64 + i) * 512 + lane;
#pragma unroll
    for (int m = 0; m < 8; ++m) a3[m] += hv * wr[m * 64];
  }
  const float LN100 = 4.605170185988092f;
  const float d0 = LN100 / 1.5f, d1 = LN100 / 0.3f;
#pragma unroll
  for (int m = 0; m < 8; ++m) {
    const int cp = lane + 64 * m;
    const int ch = cp & 255;
    const float delta = d0 + (float)ch * ((d1 - d0) / 255.0f);
    outp[(size_t)cp * L + t] = a3[m] * expf(-tl * delta);
  }
}
__device__ __forceinline__ void filter_block_task(const P& p, int l, int L, int t0, float* __restrict__ outp, char* smem) {
  const int tid = opaque_tid(), lane = tid & 63, wid = tid >> 6;
  float* W3s = (float*)smem;
  float* W2s = (float*)(smem + 131072);
  {
    const float4* s3 = (const float4*)(p.hy_f3_w + (size_t)l * 64 * 512);
    const float4* s2 = (const float4*)(p.hy_f2_w + (size_t)l * 64 * 64);
#pragma unroll
    for (int i = 0; i < 16; ++i) ((float4*)W3s)[tid + NTHR * i] = s3[tid + NTHR * i];
#pragma unroll
    for (int i = 0; i < 2; ++i) ((float4*)W2s)[tid + NTHR * i] = s2[tid + NTHR * i];
  }
  __syncthreads();
  float z[4], tl[4];
#pragma unroll
  for (int j = 0; j < 4; ++j) {
    const int t = t0 + wid * 4 + j;
    tl[j] = (float)t / (float)(L - 1);
    const float wang = (6.283185307179586f / (float)L) * (float)t;
    float zz = 0.f;
    if (lane == 0) zz = tl[j];
    else if (lane <= 16) { const float band = 1e-4f + (float)(lane - 1) * ((15.0f - 1e-4f) / 15.0f); zz = cosf(band * wang); }
    else if (lane <= 32) { const float band = 1e-4f + (float)(lane - 17) * ((15.0f - 1e-4f) / 15.0f); zz = -sinf(band * wang); }
    z[j] = zz;
  }
  float a1[4], a2[4];
  {
    const float b1 = p.hy_f1_b[l * 64 + lane];
#pragma unroll
    for (int j = 0; j < 4; ++j) a1[j] = b1;
#pragma unroll 11
    for (int i = 0; i < 33; ++i) {
      const float w = p.hy_f1_w[(l * 33 + i) * 64 + lane];
#pragma unroll
      for (int j = 0; j < 4; ++j) a1[j] += shf(z[j], i) * w;
    }
    const float f0 = p.hy_freq[l * 128 + lane];
#pragma unroll
    for (int j = 0; j < 4; ++j) a1[j] = sinf(f0 * a1[j]);
  }
  {
    const float b2 = p.hy_f2_b[l * 64 + lane];
#pragma unroll
    for (int j = 0; j < 4; ++j) a2[j] = b2;
#pragma unroll 8
    for (int i = 0; i < 64; ++i) {
      const float w = W2s[i * 64 + lane];
#pragma unroll
      for (int j = 0; j < 4; ++j) a2[j] += shf(a1[j], i) * w;
    }
    const float f1 = p.hy_freq[l * 128 + 64 + lane];
#pragma unroll
    for (int j = 0; j < 4; ++j) a2[j] = sinf(f1 * a2[j]);
  }
  float a3[4][8];
#pragma unroll
  for (int j = 0; j < 4; ++j)
#pragma unroll
    for (int m = 0; m < 8; ++m) a3[j][m] = 0.f;
#pragma unroll 4
  for (int i = 0; i < 64; ++i) {
    float w[8];
#pragma unroll
    for (int m = 0; m < 8; ++m) w[m] = W3s[i * 512 + lane + 64 * m];
#pragma unroll
    for (int j = 0; j < 4; ++j) {
      const float hv = shf(a2[j], i);
#pragma unroll
      for (int m = 0; m < 8; ++m) a3[j][m] += hv * w[m];
    }
  }
  const float LN100 = 4.605170185988092f;
  const float d0 = LN100 / 1.5f, d1 = LN100 / 0.3f;
#pragma unroll
  for (int m = 0; m < 8; ++m) {
    const int cp = lane + 64 * m;
    const float delta = d0 + (float)(cp & 255) * ((d1 - d0) / 255.0f);
    float4 o;
    o.x = a3[0][m] * expf(-tl[0] * delta); o.y = a3[1][m] * expf(-tl[1] * delta);
    o.z = a3[2][m] * expf(-tl[2] * delta); o.w = a3[3][m] * expf(-tl[3] * delta);
    *(float4*)(outp + (size_t)cp * L + t0 + wid * 4) = o;
  }
  __syncthreads();
}
__device__ __forceinline__ void phase_filters(const P& p, int l, char* smem) {
  const int ntask = 128 + (l == 0 ? 8 : 0);
  for (int t = blockIdx.x; t < ntask; t += gridDim.x) {
    if (t < 128) filter_block_task(p, l, 4096, t * 32, p.hT + (size_t)l * 512 * 4096, smem);
    else filter_block_task(p, l, 256, (t - 128) * 32, p.hc, smem);
  }
}
__device__ __forceinline__ void adaln_task(const P& p, int t, char* smem) {
  const int tid = opaque_tid();
  const int kc = t & 15; t >>= 4;
  const int jc = t % 12, l = t / 12;
  float* s = (float*)smem;
  float* red = (float*)(smem + 4096);
  for (int i = tid; i < 576; i += NTHR) {
    const int bi = i >> 6, kk = i & 63;
    const float v = (bi < 8) ? p.c[bi * 1024 + kc * 64 + kk] : p.c_ctx[kc * 64 + kk];
    s[i] = v / (1.0f + __expf(-v));
  }
  const int kq = tid >> 7, c4 = (tid & 127) * 4;
  const float* wp = p.w_ada + ((size_t)l * 1024 + kc * 64 + kq * 16) * 6144 + jc * 512 + c4;
  float4 w[16];
#pragma unroll
  for (int kk = 0; kk < 16; ++kk) w[kk] = *(const float4*)(wp + (size_t)kk * 6144);
  __syncthreads();
  float4 acc[9];
#pragma unroll
  for (int bi = 0; bi < 9; ++bi) acc[bi] = make_float4(0.f, 0.f, 0.f, 0.f);
#pragma unroll
  for (int kk = 0; kk < 16; ++kk) {
#pragma unroll
    for (int bi = 0; bi < 9; ++bi) {
      const float sv = s[bi * 64 + kq * 16 + kk];
      acc[bi].x += sv * w[kk].x; acc[bi].y += sv * w[kk].y; acc[bi].z += sv * w[kk].z; acc[bi].w += sv * w[kk].w;
    }
  }
#pragma unroll
  for (int bi = 0; bi < 9; ++bi) *(float4*)(red + (kq * 9 + bi) * 512 + c4) = acc[bi];
  __syncthreads();
#pragma unroll
  for (int bi = 0; bi < 9; ++bi) {
    const float v = red[bi * 512 + tid] + red[(9 + bi) * 512 + tid] + red[(18 + bi) * 512 + tid] + red[(27 + bi) * 512 + tid];
    p.modpart[((size_t)(kc * 2 + l) * 9 + bi) * 6144 + jc * 512 + tid] = v;
  }
  __syncthreads();
}
__device__ __forceinline__ void phase_prep(const P& p, char* smem, unsigned* counter) {
  volatile int* s_taskp = (volatile int*)(smem + SMEM_BYTES - 16);
  const int total = 264 + 184 + 384 + 544 + 32;
  int nxt = 0;
  if (threadIdx.x == 0) nxt = (int)atomicAdd(counter, 1u);
  for (;;) {
    __syncthreads();
    if (threadIdx.x == 0) *s_taskp = nxt;
    __syncthreads();
    int t = *s_taskp;
    if (t >= total) break;
    if (threadIdx.x == 0) nxt = (int)atomicAdd(counter, 1u);
    if (t < 264) {
      if (t < 128) filter_block_task(p, 0, 4096, t * 32, p.hT, smem);
      else if (t < 256) filter_block_task(p, 1, 4096, (t - 128) * 32, p.hT + (size_t)512 * 4096, smem);
      else filter_block_task(p, 0, 256, (t - 256) * 32, p.hc, smem);
      continue;
    }
    t -= 264;
    if (t < 184) {
      const int l = t / 92; t -= l * 92;
      if (t < 44) colmax4_task(p.w_in + (size_t)l * 1024 * 2816, 2816, t * 64, p.sw + l * 5888, smem);
      else colmax4_task(p.w_gate + (size_t)l * 1024 * 3072, 3072, (t - 44) * 64, p.sw + l * 5888 + 2816, smem);
      continue;
    }
    t -= 184;
    if (t < 384) { adaln_task(p, t, smem); continue; }
    t -= 384;
    if (t < 544) {
      const int l = t / 272; t -= l * 272;
      if (t < 32) tr_tile4<false>(p.w_br_a + (size_t)l * 512 * 1024, 1024, 512, p.WaT + (size_t)l * 1024 * 512, t, nullptr, smem);
      else if ((t -= 32) < 16) tr_tile4<false>(p.w_br_b + (size_t)l * 256 * 1024, 1024, 256, p.WbT + (size_t)l * 1024 * 256, t, nullptr, smem);
      else if ((t -= 16) < 16) tr_tile4<false>(p.w_br_c + (size_t)l * 256 * 1024, 1024, 256, p.WcT + (size_t)l * 1024 * 256, t, nullptr, smem);
      else if ((t -= 16) < 64) tr_tile4<false>(p.w_out + (size_t)l * 1024 * 1024, 1024, 1024, p.WoT + (size_t)l * 1024 * 1024, t, nullptr, smem);
      else if ((t -= 64) < 128) cvt_chunk4(p.peer_wq + (size_t)l * 1024 * 2048, p.WqB + (size_t)l * 1024 * 2048, (size_t)t);
      else {
        t -= 128;
        const int gate = t >> 3, dn = t & 7;
        const float* src = (gate ? p.rg_wx : p.rg_wa) + (size_t)(l * 8 + dn) * 4096;
        tr_tile(src, 64, 64, p.rgW + (size_t)((l * 2 + gate) * 8 + dn) * 4096, 0, smem);
      }
      continue;
    }
    t -= 544;
    cvt_chunk4(p.peer_keys, p.keysB, (size_t)t);
  }
}
__device__ __forceinline__ void kf_task(const P& p, int l, int c, char* smem) {
  const float* hTl = p.hT + (size_t)l * 512 * 4096;
  c2* buf = (c2*)smem;
  const int tid = opaque_tid();
  for (int i = 0; i < 16; ++i) {
    const int j = tid + NTHR * i;
    float v;
    if (j < 4096) v = hTl[(size_t)c * 4096 + j];
    else if (j == 4096) v = 0.f;
    else v = hTl[(size_t)(256 + c) * 4096 + (8192 - j)];
    buf[j] = {v, 0.f};
  }
  __syncthreads();
  fft8192(buf, -1.f);
  c2* o = (c2*)p.Kf + ((size_t)l * 256 + c) * 8192;
  for (int i = 0; i < 16; ++i) { const int j = tid + NTHR * i; o[j] = buf[j]; }
  __syncthreads();
}

__device__ __forceinline__ void inproj_tile(const P& p, int l, int mt, int nt, char* smem) {
  f32x16 acc[2][2];
  zero_acc(acc);
  const int m0 = mt * 256, n0 = nt * 128;
  gemm_kloop(acc, p.xn + (size_t)m0 * 1024, 1024, p.WinT + ((size_t)l * 2816 + n0) * 1024, 1024, 1024, smem);
  EPI_VARS
  if (nt < 8 || nt >= 18) {
    u16* dst; int ld, cbase;
    if (nt < 8) { dst = p.qk; ld = 1024; cbase = n0; }
    else { dst = p.rg; ld = 512; cbase = n0 - 2304; }
#pragma unroll
    for (int i = 0; i < 2; ++i)
#pragma unroll
      for (int j = 0; j < 2; ++j)
#pragma unroll
        for (int e = 0; e < 16; ++e)
          dst[(size_t)(m0 + EPI_ROW(i, e)) * ld + cbase + EPI_COL(j)] = f2bf(acc[i][j][e]);
  } else {
#pragma unroll
    for (int i = 0; i < 2; ++i)
#pragma unroll
      for (int j = 0; j < 2; ++j)
#pragma unroll
        for (int qd = 0; qd < 4; ++qd) {
          uint2 o;
          o.x = pk2(acc[i][j][4 * qd + 0], acc[i][j][4 * qd + 1]);
          o.y = pk2(acc[i][j][4 * qd + 2], acc[i][j][4 * qd + 3]);
          const int row0 = wm * 64 + i * 32 + 8 * qd + 4 * hh;
          *(uint2*)(smem + EPI_COL(j) * 520 + row0 * 2) = o;
        }
    __syncthreads();
    u16* dstT; int Lseg, t0, ncol0, nc;
    const bool isctx = (mt >= 128);
    const int b = isctx ? (mt - 128) : (mt >> 4);
    if (nt < 12) { ncol0 = n0 - 1024; nc = 512; dstT = isctx ? p.vTc : p.vT; }
    else { ncol0 = n0 - 1536; nc = 768; dstT = isctx ? p.hyTc : p.hyT; }
    if (isctx) { Lseg = 256; t0 = 0; } else { Lseg = 4096; t0 = (mt & 15) * 256; }
#pragma unroll 4
    for (int it = 0; it < 16; ++it) {
      const int idx = tid + NTHR * it;
      const int col = idx >> 6, u = idx & 63;
      const uint2 v = *(const uint2*)(smem + col * 520 + u * 8);
      *(uint2*)(dstT + ((size_t)(b * nc + ncol0 + col)) * Lseg + t0 + u * 4) = v;
    }
    __syncthreads();
  }
}

__device__ __forceinline__ float ldbf(const u16* p, int t, int L) { return (t >= 0 && t < L) ? bf2f(p[t]) : 0.f; }
__device__ __forceinline__ void ld10(const u16* __restrict__ seq, int t0, float (&v)[10]) {
  const uint4 r = *(const uint4*)(seq + t0);
  v[0] = (t0 > 0) ? bf2f(seq[t0 - 1]) : 0.f;
  v[9] = (t0 + 8 < 4096) ? bf2f(seq[t0 + 8]) : 0.f;
  v[1] = bflo(r.x); v[2] = bfhi(r.x); v[3] = bflo(r.y); v[4] = bfhi(r.y);
  v[5] = bflo(r.z); v[6] = bfhi(r.z); v[7] = bflo(r.w); v[8] = bfhi(r.w);
}
__device__ __forceinline__ void hyena_fft_task(const P& p, int l, int c, int bp, char* smem) {
  c2* buf = (c2*)smem;
  c2* ub = (c2*)(smem + 65536);
  const int tid = opaque_tid();
  const float* sw = p.hy_short_w + l * 3 * 768;
  const float* sb = p.hy_short_b + l * 768;
  const float wx0[3] = {sw[c], sw[768 + c], sw[1536 + c]};
  const float wx1[3] = {sw[256 + c], sw[768 + 256 + c], sw[1536 + 256 + c]};
  const float wv[3] = {sw[512 + c], sw[768 + 512 + c], sw[1536 + 512 + c]};
  const float bx0 = sb[c], bx1 = sb[256 + c], bv = sb[512 + c];
  const float dsk = p.hy_bias[l * 256 + c];
  const int t0 = tid * 8;
  {
    float u[2][8];
#pragma unroll
    for (int bb = 0; bb < 2; ++bb) {
      const int b = 2 * bp + bb;
      float x1[10], vv[10];
      ld10(p.hyT + ((size_t)(b * 768 + 256 + c)) * 4096, t0, x1);
      ld10(p.hyT + ((size_t)(b * 768 + 512 + c)) * 4096, t0, vv);
#pragma unroll
      for (int k = 0; k < 8; ++k) {
        const float x1c = bx1 + wx1[0] * x1[k] + wx1[1] * x1[k + 1] + wx1[2] * x1[k + 2];
        const float vc = bv + wv[0] * vv[k] + wv[1] * vv[k + 1] + wv[2] * vv[k + 2];
        u[bb][k] = vc * x1c;
      }
    }
#pragma unroll
    for (int k = 0; k < 8; k += 2) {
      const float4 w = make_float4(u[0][k], u[1][k], u[0][k + 1], u[1][k + 1]);
      *(float4*)(buf + t0 + k) = w;
      *(float4*)(ub + t0 + k) = w;
      *(float4*)(buf + 4096 + t0 + k) = make_float4(0.f, 0.f, 0.f, 0.f);
    }
  }
  __syncthreads();
  fft8192(buf, -1.f);
  const c2* kf = (const c2*)p.Kf + ((size_t)l * 256 + c) * 8192;
  for (int i = 0; i < 16; ++i) {
    const int k = tid + NTHR * i;
    buf[k] = cmul(buf[k], kf[k]);
  }
  __syncthreads();
  fft8192(buf, 1.f);
#pragma unroll
  for (int bb = 0; bb < 2; ++bb) {
    const int b = 2 * bp + bb;
    float x0[10];
    ld10(p.hyT + ((size_t)(b * 768 + c)) * 4096, t0, x0);
    float o[8];
#pragma unroll
    for (int k = 0; k < 8; ++k) {
      const c2 y = buf[t0 + k];
      const c2 uu = ub[t0 + k];
      const float x0c = bx0 + wx0[0] * x0[k] + wx0[1] * x0[k + 1] + wx0[2] * x0[k + 2];
      const float yy = ldexpf(bb ? y.y : y.x, -13);
      const float uv = bb ? uu.y : uu.x;
      o[k] = x0c * (yy + uv * dsk);
    }
    uint4 w; w.x = pk2(o[0], o[1]); w.y = pk2(o[2], o[3]); w.z = pk2(o[4], o[5]); w.w = pk2(o[6], o[7]);
    *(uint4*)(p.ybT + ((size_t)(b * 256 + c)) * 4096 + t0) = w;
  }
  __syncthreads();
}
__device__ __forceinline__ void yb_transpose_task(const P& p, int b, int tb, char* smem) {
  const int tid = opaque_tid(), lane = tid & 63, wid = tid >> 6;
  u16* T = (u16*)smem;
#pragma unroll
  for (int it = 0; it < 4; ++it) {
    const int id = tid + NTHR * it;
    const int c = id >> 3, ch = id & 7;
    const uint4 r = *(const uint4*)(p.ybT + ((size_t)(b * 256 + c)) * 4096 + tb * 64 + ch * 8);
    unsigned* d = (unsigned*)(T + c * 66 + ch * 8);
    d[0] = r.x; d[1] = r.y; d[2] = r.z; d[3] = r.w;
  }
  __syncthreads();
#pragma unroll
  for (int it = 0; it < 8; ++it) {
    const int tt = wid + 8 * it;
    const int c0 = lane * 4;
    uint2 w;
    w.x = (unsigned)T[(c0 + 0) * 66 + tt] | ((unsigned)T[(c0 + 1) * 66 + tt] << 16);
    w.y = (unsigned)T[(c0 + 2) * 66 + tt] | ((unsigned)T[(c0 + 3) * 66 + tt] << 16);
    *(uint2*)(p.ycat + (size_t)(b * 4096 + tb * 64 + tt) * 1024 + 512 + c0) = w;
  }
  __syncthreads();
}
__device__ __forceinline__ void hyena_ctx_task(const P& p, int l, int b, int cg8, char* smem) {
  const int tid_ = opaque_tid(); const int lane = tid_ & 63, wid = tid_ >> 6;
  const int c = cg8 * 8 + wid;
  float* us = (float*)smem + wid * 1024;
  float* kfp = us + 256 + 255;
  const float* sw = p.hy_short_w + l * 3 * 768;
  const float* sb = p.hy_short_b + l * 768;
  const u16* x0 = p.hyTc + ((size_t)(b * 768 + c)) * 256;
  const u16* x1 = p.hyTc + ((size_t)(b * 768 + 256 + c)) * 256;
  const u16* vv = p.hyTc + ((size_t)(b * 768 + 512 + c)) * 256;
  for (int i = 0; i < 4; ++i) {
    const int t = lane + 64 * i;
    const float x1c = sb[256 + c] + sw[256 + c] * ldbf(x1, t - 1, 256) + sw[768 + 256 + c] * ldbf(x1, t, 256) + sw[1536 + 256 + c] * ldbf(x1, t + 1, 256);
    const float vc = sb[512 + c] + sw[512 + c] * ldbf(vv, t - 1, 256) + sw[768 + 512 + c] * ldbf(vv, t, 256) + sw[1536 + 512 + c] * ldbf(vv, t + 1, 256);
    us[t] = vc * x1c;
    kfp[t] = p.hc[(size_t)c * 256 + t];
    if (t > 0) kfp[-t] = p.hc[(size_t)(256 + c) * 256 + t];
  }
  __syncthreads();
  const float dsk = p.hy_bias[l * 256 + c];
  float acc[4] = {0.f, 0.f, 0.f, 0.f};
  for (int s = 0; s < 256; ++s) {
    const float uv = us[s];
#pragma unroll
    for (int i = 0; i < 4; ++i) acc[i] += kfp[lane + 64 * i - s] * uv;
  }
#pragma unroll
  for (int i = 0; i < 4; ++i) {
    const int t = lane + 64 * i;
    const float x0c = sb[c] + sw[c] * ldbf(x0, t - 1, 256) + sw[768 + c] * ldbf(x0, t, 256) + sw[1536 + c] * ldbf(x0, t + 1, 256);
    p.ycat[(size_t)(NLAT + b * 256 + t) * 1024 + 512 + c] = f2bf(x0c * (acc[i] + us[t] * dsk));
  }
  __syncthreads();
}

template <int DIR>
__device__ __forceinline__ void rg_scan32(const float (&Av)[2][16], const float (&Bv)[2][16], float (&carry)[2], float (&H)[2][16], int hh) {
#pragma unroll
  for (int nt = 0; nt < 2; ++nt) {
    float c = carry[nt];
#pragma unroll
    for (int go = 0; go < 8; ++go) {
      const int g = DIR ? 7 - go : go, q = g >> 1, own = g & 1;
      float h = c;
#pragma unroll
      for (int io = 0; io < 4; ++io) {
        const int e = 4 * q + (DIR ? 3 - io : io);
        h = Av[nt][e] * h + Bv[nt][e];
        H[nt][e] = (hh == own) ? h : H[nt][e];
      }
      const float mine = (hh == own) ? h : c;
      const float other = shx(mine, 32);
      c = (hh == own) ? mine : other;
    }
    carry[nt] = c;
  }
}
__device__ __forceinline__ void rg_wave_task(const P& p, int l, int bq, int nblk, int mode, bool last, char* smem) {
  const int tid = opaque_tid(), lane = tid & 63, wid = tid >> 6;
  const int l31 = lane & 31, hh = lane >> 5;
  const int b = bq / 34, rr = bq - b * 34;
  const int seg = rr < 2 ? 0 : 1, blk = rr < 2 ? rr : rr - 2;
  if (mode == 1 && seg == 0 && last) return;
  const int ck = wid >> 1, dir = wid & 1;
  char* wreg = smem + wid * 17408;
  u16* xs = (u16*)wreg;
  char* xcb = wreg + 4608;
  float* xcf = (float*)(wreg + 8704);
  float2* blockagg = (float2*)(smem + 139264);
  const int Lseg = seg ? 4096 : 256;
  const int tokbase = seg ? b * 4096 : NLAT + b * 256;
  const int T0 = blk * 128 + ck * 32;
  const int cg32 = (seg ? 8 : 0) + blk * 4 + ck;
  bf16x8 wf[2][2][4];
#pragma unroll
  for (int gate = 0; gate < 2; ++gate) {
    const u16* wp = p.rgW + (size_t)(((l * 2 + gate) * 2 + dir) * 4 + nblk) * 4096 + l31 * 64 + 8 * hh;
#pragma unroll
    for (int nt = 0; nt < 2; ++nt)
#pragma unroll
      for (int s = 0; s < 4; ++s) wf[gate][nt][s] = *(const bf16x8*)(wp + nt * 2048 + 16 * s);
  }
  float cba[2], cbx[2], csp[2];
#pragma unroll
  for (int nt = 0; nt < 2; ++nt) {
    const int ch = (l * 2 + dir) * 256 + nblk * 64 + nt * 32 + l31;
    cba[nt] = p.rg_ba[ch];
    cbx[nt] = p.rg_bx[ch];
    csp[nt] = __logf(1.0f + __expf(-p.rg_lambda[ch]));
  }
#pragma unroll
  for (int i = 0; i < 5; ++i) {
    const int idx = lane + 64 * i;
    const int row = idx >> 3, chunk = idx & 7;
    if (row < 35) {
      const int pos = T0 - 2 + row;
      uint4 v = make_uint4(0u, 0u, 0u, 0u);
      if (pos >= 0 && pos < Lseg) v = *(const uint4*)(p.rg + (size_t)(tokbase + pos) * 512 + nblk * 64 + chunk * 8);
      *(uint4*)(xs + row * 64 + chunk * 8) = v;
    }
  }
  asm volatile("s_waitcnt lgkmcnt(0)" ::: "memory");
  {
    const int ch = l * 256 + nblk * 64 + lane;
    const float w0 = p.rg_conv_w[(l * 4 + 0) * 256 + nblk * 64 + lane], w1 = p.rg_conv_w[(l * 4 + 1) * 256 + nblk * 64 + lane];
    const float w2 = p.rg_conv_w[(l * 4 + 2) * 256 + nblk * 64 + lane], w3 = p.rg_conv_w[(l * 4 + 3) * 256 + nblk * 64 + lane];
    const float cb = p.rg_conv_b[ch];
    float x0 = bf2f(xs[0 * 64 + lane]), x1 = bf2f(xs[1 * 64 + lane]), x2 = bf2f(xs[2 * 64 + lane]);
#pragma unroll
    for (int t = 0; t < 32; ++t) {
      const float x3 = bf2f(xs[(t + 3) * 64 + lane]);
      const float xc = cb + w0 * x0 + w1 * x1 + w2 * x2 + w3 * x3;
      xcf[t * 68 + lane] = xc;
      *(u16*)(xcb + swz128(t, lane >> 3) + (lane & 7) * 2) = f2bf(xc);
      x0 = x1; x1 = x2; x2 = x3;
    }
  }
  asm volatile("s_waitcnt lgkmcnt(0)" ::: "memory");
  float Av[2][16], Bv[2][16];
  {
    f32x16 acc[2][2];
#pragma unroll
    for (int gate = 0; gate < 2; ++gate)
#pragma unroll
      for (int nt = 0; nt < 2; ++nt) acc[gate][nt] = zero16();
#pragma unroll
    for (int s = 0; s < 4; ++s) {
      const bf16x8 af = *(const bf16x8*)(xcb + swz128(l31, 2 * s + hh));
#pragma unroll
      for (int gate = 0; gate < 2; ++gate)
#pragma unroll
        for (int nt = 0; nt < 2; ++nt) acc[gate][nt] = mfma32(af, wf[gate][nt][s], acc[gate][nt]);
    }
#pragma unroll
    for (int nt = 0; nt < 2; ++nt)
#pragma unroll
      for (int e = 0; e < 16; ++e) {
        const int tok = (e & 3) + 8 * (e >> 2) + 4 * hh;
        const float r = sigmoidf_(acc[0][nt][e] + cba[nt]);
        const float ii = sigmoidf_(acc[1][nt][e] + cbx[nt]);
        const float la = -8.0f * r * csp[nt];
        const float av = __expf(la);
        const float e2 = 2.0f * la;
        const float om = (e2 > -0.1f) ? (-e2 * (1.0f + e2 * (0.5f + e2 * (0.16666667f + e2 * 0.041666668f)))) : (1.0f - __expf(e2));
        Av[nt][e] = av;
        Bv[nt][e] = sqrtf(om) * ii * xcf[tok * 68 + nt * 32 + l31];
      }
  }
  float H[2][16];
#pragma unroll
  for (int nt = 0; nt < 2; ++nt)
#pragma unroll
    for (int e = 0; e < 16; ++e) H[nt][e] = 0.f;
  float carry[2] = {0.f, 0.f};
  float2* agg1 = (float2*)p.agg;
  float2* agg2 = (float2*)p.agg + (size_t)8 * 2 * 136 * 256;
  const int pos2 = dir ? (seg == 0 ? 1 - blk : 33 - blk) : (seg == 0 ? blk : 2 + blk);
  if (mode == 0) {
    if (dir) rg_scan32<1>(Av, Bv, carry, H, hh); else rg_scan32<0>(Av, Bv, carry, H, hh);
    float P[2];
#pragma unroll
    for (int nt = 0; nt < 2; ++nt) {
      float pr = 1.f;
#pragma unroll
      for (int e = 0; e < 16; ++e) pr *= Av[nt][e];
      P[nt] = pr * shx(pr, 32);
    }
    const float2 mine = make_float2(hh ? P[1] : P[0], hh ? carry[1] : carry[0]);
    agg1[((size_t)(b * 2 + dir) * 136 + cg32) * 256 + nblk * 64 + lane] = mine;
    blockagg[(ck * 2 + dir) * 64 + lane] = mine;
    __syncthreads();
    if (wid < 2) {
      const int d2 = wid;
      float A = 1.f, B = 0.f;
#pragma unroll
      for (int co = 0; co < 4; ++co) {
        const int c = d2 ? 3 - co : co;
        const float2 g = blockagg[(c * 2 + d2) * 64 + lane];
        B = g.x * B + g.y;
        A *= g.x;
      }
      const int p2 = d2 ? (seg == 0 ? 1 - blk : 33 - blk) : (seg == 0 ? blk : 2 + blk);
      agg2[((size_t)(b * 2 + d2) * 34 + p2) * 256 + nblk * 64 + lane] = make_float2(A, B);
    }
    __syncthreads();
    return;
  }
  {
    float h = 0.f;
    const float2* a2 = agg2 + ((size_t)(b * 2 + dir) * 34) * 256 + nblk * 64 + lane;
    int j = 0;
    for (; j + 8 <= pos2; j += 8) {
      float2 g[8];
#pragma unroll
      for (int u = 0; u < 8; ++u) g[u] = a2[(size_t)(j + u) * 256];
#pragma unroll
      for (int u = 0; u < 8; ++u) h = g[u].x * h + g[u].y;
    }
    for (; j < pos2; ++j) { const float2 g = a2[(size_t)j * 256]; h = g.x * h + g.y; }
    const float2* a1 = agg1 + ((size_t)(b * 2 + dir) * 136 + (cg32 - ck)) * 256 + nblk * 64 + lane;
    const int npre = dir ? 3 - ck : ck;
    for (int i = 0; i < npre; ++i) {
      const int c = dir ? 3 - i : i;
      const float2 g = a1[(size_t)c * 256];
      h = g.x * h + g.y;
    }
    carry[0] = shf(h, l31);
    carry[1] = shf(h, 32 + l31);
  }
  if (dir) rg_scan32<1>(Av, Bv, carry, H, hh); else rg_scan32<0>(Av, Bv, carry, H, hh);
  asm volatile("s_waitcnt lgkmcnt(0)" ::: "memory");
#pragma unroll
  for (int nt = 0; nt < 2; ++nt)
#pragma unroll
    for (int e = 0; e < 16; ++e) xcf[((e & 3) + 8 * (e >> 2) + 4 * hh) * 68 + nt * 32 + l31] = H[nt][e];
  __syncthreads();
  {
    const float* hfT = (const float*)(smem + (ck * 2 + 0) * 17408 + 8704);
    const float* hbT = (const float*)(smem + (ck * 2 + 1) * 17408 + 8704);
    const int tok = 16 * dir + (lane >> 2), c16 = (lane & 3) * 16;
    const size_t gtok = (size_t)tokbase + T0 + tok;
    const u16* gp = p.rg + gtok * 512 + 256 + nblk * 64 + c16;
    u16* op = p.ycat + gtok * 1024 + 768 + nblk * 64 + c16;
#pragma unroll
    for (int hv = 0; hv < 2; ++hv) {
      const uint4 g = *(const uint4*)(gp + hv * 8);
      const float4 f0 = *(const float4*)(hfT + tok * 68 + c16 + hv * 8), f1 = *(const float4*)(hfT + tok * 68 + c16 + hv * 8 + 4);
      const float4 h0 = *(const float4*)(hbT + tok * 68 + c16 + hv * 8), h1 = *(const float4*)(hbT + tok * 68 + c16 + hv * 8 + 4);
      uint4 o;
      o.x = pk2((f0.x + h0.x) * gelu_tanh(bflo(g.x)), (f0.y + h0.y) * gelu_tanh(bfhi(g.x)));
      o.y = pk2((f0.z + h0.z) * gelu_tanh(bflo(g.y)), (f0.w + h0.w) * gelu_tanh(bfhi(g.y)));
      o.z = pk2((f1.x + h1.x) * gelu_tanh(bflo(g.z)), (f1.y + h1.y) * gelu_tanh(bfhi(g.z)));
      o.w = pk2((f1.z + h1.z) * gelu_tanh(bflo(g.w)), (f1.w + h1.w) * gelu_tanh(bfhi(g.w)));
      *(uint4*)(op + hv * 8) = o;
    }
  }
  __syncthreads();
}

__device__ __forceinline__ void attn_wave(const P& p, int l, int b, int h, bool local, int r, int half, int qtok0, const float* rpbL) {
  const int lane = opaque_tid() & 63, q = lane & 31, hh = lane >> 5;
  bf16x8 qf[4];
  {
    const u16* qp = p.qk + (size_t)(qtok0 + q) * 1024 + h * 64 + 8 * hh;
#pragma unroll
    for (int s = 0; s < 4; ++s) qf[s] = *(const bf16x8*)(qp + 16 * s);
  }
  f32x16 o0 = zero16(), o1 = zero16();
  float m_run = -1e30f, l_run = 0.f;
  const int pi = (q & 19) | ((q & 4) << 1) | ((q & 8) >> 1);
  const int w = half * 32 + q;
  const int st = min(max(w - 8, 0), 48);
  const int rs = min(max(r - 4, 0), 56);
  const int ntiles = local ? 24 : 8;
  bf16x8 kfn[4], vfn[2][2];
  auto tile_load = [&](int ti, bf16x8 (&kfo)[4], bf16x8 (&vfo)[2][2]) {
    int ktok0, vstride;
    const u16* vb;
    if (ti < 8) {
      ktok0 = NLAT + b * 256 + ti * 32;
      vb = p.vTc + ((size_t)(b * 512 + h * 64)) * 256 + ti * 32;
      vstride = 256;
    } else {
      const int tl = ti - 8;
      const int a2 = tl >> 1, g2 = tl & 1;
      ktok0 = b * 4096 + (rs + a2) * 64 + g2 * 32;
      vb = p.vT + ((size_t)(b * 512 + h * 64)) * 4096 + (rs + a2) * 64 + g2 * 32;
      vstride = 4096;
    }
    const u16* kp = p.qk + (size_t)(ktok0 + pi) * 1024 + 512 + h * 64 + 8 * hh;
#pragma unroll
    for (int s = 0; s < 4; ++s) kfo[s] = *(const bf16x8*)(kp + 16 * s);
#pragma unroll
    for (int dt = 0; dt < 2; ++dt)
#pragma unroll
      for (int s2 = 0; s2 < 2; ++s2) vfo[dt][s2] = *(const bf16x8*)(vb + (size_t)(dt * 32 + q) * vstride + 16 * s2 + 8 * hh);
  };
  tile_load(0, kfn, vfn);
  for (int ti = 0; ti < ntiles; ++ti) {
    int a = 0, g = 0;
    if (ti >= 8) { a = (ti - 8) >> 1; g = (ti - 8) & 1; }
    bf16x8 kf[4], vf[2][2];
#pragma unroll
    for (int s = 0; s < 4; ++s) kf[s] = kfn[s];
#pragma unroll
    for (int dt = 0; dt < 2; ++dt)
#pragma unroll
      for (int s2 = 0; s2 < 2; ++s2) vf[dt][s2] = vfn[dt][s2];
    if (ti + 1 < ntiles) tile_load(ti + 1, kfn, vfn);
    f32x16 sacc = zero16();
#pragma unroll
    for (int s = 0; s < 4; ++s) sacc = mfma32(kf[s], qf[s], sacc);
    float sv[16];
    float tmax = -1e30f;
#pragma unroll
    for (int e = 0; e < 16; ++e) {
      float x = sacc[e] * 0.125f;
      if (ti >= 8) {
        const int kc = g * 32 + (e & 7) + 8 * hh + 16 * (e >> 3);
        const bool valid = (kc >= st) && (kc < st + 16);
        const int bi = valid ? ((rs + a - r + 7) * 31 + (kc - w + 15)) : 0;
        const float bias = rpbL[bi];
        x = valid ? (x + bias) : -1e30f;
      }
      sv[e] = x;
      tmax = fmaxf(tmax, x);
    }
    tmax = fmaxf(tmax, shx(tmax, 32));
    const float m_new = fmaxf(m_run, tmax);
    const float alpha = __expf(m_run - m_new);
    m_run = m_new;
    l_run *= alpha;
#pragma unroll
    for (int e = 0; e < 16; ++e) { o0[e] *= alpha; o1[e] *= alpha; }
    float psum = 0.f;
#pragma unroll
    for (int e = 0; e < 16; ++e) { const float pe = __expf(sv[e] - m_new); sv[e] = pe; psum += pe; }
    l_run += psum;
    bf16x8 pf[2];
#pragma unroll
    for (int s2 = 0; s2 < 2; ++s2) {
      union { bf16x8 v; unsigned u[4]; } cv;
#pragma unroll
      for (int j = 0; j < 4; ++j) cv.u[j] = pk2(sv[8 * s2 + 2 * j], sv[8 * s2 + 2 * j + 1]);
      pf[s2] = cv.v;
    }
#pragma unroll
    for (int s2 = 0; s2 < 2; ++s2) {
      o0 = mfma32(vf[0][s2], pf[s2], o0);
      o1 = mfma32(vf[1][s2], pf[s2], o1);
    }
  }
  const float lt = l_run + shx(l_run, 32);
  const float inv = 1.0f / lt;
  u16* op = p.ycat + (size_t)(qtok0 + q) * 1024 + h * 64;
#pragma unroll
  for (int qd = 0; qd < 4; ++qd) {
    uint2 a0, a1;
    a0.x = pk2(o0[4 * qd] * inv, o0[4 * qd + 1] * inv);
    a0.y = pk2(o0[4 * qd + 2] * inv, o0[4 * qd + 3] * inv);
    a1.x = pk2(o1[4 * qd] * inv, o1[4 * qd + 1] * inv);
    a1.y = pk2(o1[4 * qd + 2] * inv, o1[4 * qd + 3] * inv);
    *(uint2*)(op + 8 * qd + 4 * hh) = a0;
    *(uint2*)(op + 32 + 8 * qd + 4 * hh) = a1;
  }
}
__device__ __forceinline__ void attn_block_task(const P& p, int l, int b, int h, int rg4, char* smem) {
  const int tid = opaque_tid(), lane = tid & 63, wid = tid >> 6;
  const int q = lane & 31, hh = lane >> 5;
  const int R0 = rg4 * 4;
  const int r = R0 + (wid >> 1), half = wid & 1;
  float* rpbL = (float*)(smem + 32768) + 64;
  for (int i = tid; i < 465; i += NTHR) rpbL[i] = p.na_rpb[(size_t)(l * 8 + h) * 465 + i] * 1.4426950408889634f;
  const int lo = min(max(R0 - 4, 0), 56);
  const int hi = min(max(R0 + 3 - 4, 0), 56) + 7;
  const int ntile = 4 + (hi - lo + 1);
  const int rs = min(max(r - 4, 0), 56);
  const int qtok = b * 4096 + r * 64 + half * 32 + q;
  bf16x8 qf[4];
  {
    const u16* qp = p.qk + (size_t)qtok * 1024 + h * 64 + 8 * hh;
#pragma unroll
    for (int s = 0; s < 4; ++s) qf[s] = *(const bf16x8*)(qp + 16 * s);
  }
  f32x16 o0 = zero16(), o1 = zero16();
  float m_run = -1e30f, l_run = 0.f;
  const int pi = (q & 19) | ((q & 4) << 1) | ((q & 8) >> 1);
  const int w = half * 32 + q;
  const int st = min(max(w - 8, 0), 48);
  unsigned vmask = 0u;
#pragma unroll
  for (int g = 0; g < 2; ++g)
#pragma unroll
    for (int e = 0; e < 16; ++e) {
      const int kc = g * 32 + (e & 7) + 8 * hh + 16 * (e >> 3);
      vmask |= ((kc >= st) && (kc < st + 16)) ? (1u << (g * 16 + e)) : 0u;
    }
  const int cbase = 8 * hh - w + 15;
  const int srow = tid >> 3, sch = tid & 7;
  uint4 rkA, rvA, rkB, rvB;
  auto gload = [&](int ti, uint4& rk, uint4& rv) {
    int ktok0, vstride;
    const u16* vb;
    if (ti < 4) { ktok0 = NLAT + b * 256 + ti * 64; vb = p.vTc + ((size_t)(b * 512 + h * 64)) * 256 + ti * 64; vstride = 256; }
    else { const int R = lo + ti - 4; ktok0 = b * 4096 + R * 64; vb = p.vT + ((size_t)(b * 512 + h * 64)) * 4096 + R * 64; vstride = 4096; }
    rk = *(const uint4*)(p.qk + (size_t)(ktok0 + srow) * 1024 + 512 + h * 64 + sch * 8);
    rv = *(const uint4*)(vb + (size_t)srow * vstride + sch * 8);
  };
  gload(0, rkA, rvA);
  *(uint4*)(smem + swz128(srow, sch)) = rkA;
  *(uint4*)(smem + 16384 + swz128(srow, sch)) = rvA;
  gload(1, rkA, rvA);
  if (2 < ntile) gload(2, rkB, rvB);
  __syncthreads();
  auto compute = [&](int ti) {
    const char* Kb = smem + (ti & 1) * 8192;
    const char* Vb = smem + 16384 + (ti & 1) * 8192;
    const int R = lo + ti - 4;
    const bool active = (ti < 4) || (R >= rs && R < rs + 8);
    if (active) {
      f32x16 sacc0 = zero16(), sacc1 = zero16();
#pragma unroll
      for (int s = 0; s < 4; ++s) {
        const bf16x8 kf0 = *(const bf16x8*)(Kb + swz128(pi, 2 * s + hh));
        const bf16x8 kf1 = *(const bf16x8*)(Kb + swz128(32 + pi, 2 * s + hh));
        sacc0 = mfma32(kf0, qf[s], sacc0);
        sacc1 = mfma32(kf1, qf[s], sacc1);
      }
      float sv[32];
      float tmax = -1e30f;
      if (ti >= 4) {
        const float* brow = rpbL + (R - r + 7) * 31 + cbase;
        float bias[32];
#pragma unroll
        for (int g = 0; g < 2; ++g)
#pragma unroll
          for (int e = 0; e < 16; ++e) bias[g * 16 + e] = brow[g * 32 + (e & 7) + 16 * (e >> 3)];
#pragma unroll
        for (int g = 0; g < 2; ++g)
#pragma unroll
          for (int e = 0; e < 16; ++e) {
            const float sc = g ? sacc1[e] : sacc0[e];
            const float x = ((int)(vmask << (31 - (g * 16 + e))) < 0) ? fmaf(sc, 0.18033688011112042f, bias[g * 16 + e]) : -1e30f;
            sv[g * 16 + e] = x;
            tmax = fmaxf(tmax, x);
          }
      } else {
#pragma unroll
        for (int g = 0; g < 2; ++g)
#pragma unroll
          for (int e = 0; e < 16; ++e) {
            const float x = (g ? sacc1[e] : sacc0[e]) * 0.18033688011112042f;
            sv[g * 16 + e] = x;
            tmax = fmaxf(tmax, x);
          }
      }
      tmax = fmaxf(tmax, shx(tmax, 32));
      if (__builtin_amdgcn_ballot_w64(tmax > m_run) != 0ull) {
        const float m_new = fmaxf(m_run, tmax);
        const float alpha = __builtin_amdgcn_exp2f(m_run - m_new);
        m_run = m_new;
        l_run *= alpha;
#pragma unroll
        for (int e = 0; e < 16; ++e) { o0[e] *= alpha; o1[e] *= alpha; }
      }
      float psum = 0.f;
#pragma unroll
      for (int e = 0; e < 32; ++e) { const float pe = __builtin_amdgcn_exp2f(sv[e] - m_run); sv[e] = pe; psum += pe; }
      l_run += psum;
#pragma unroll
      for (int g = 0; g < 2; ++g)
#pragma unroll
        for (int s2 = 0; s2 < 2; ++s2) {
          union { bf16x8 v; unsigned u[4]; } cv;
#pragma unroll
          for (int j = 0; j < 4; ++j) cv.u[j] = pk2(sv[g * 16 + 8 * s2 + 2 * j], sv[g * 16 + 8 * s2 + 2 * j + 1]);
          const bf16x8 v0 = *(const bf16x8*)(Vb + swz128(q, g * 4 + 2 * s2 + hh));
          const bf16x8 v1 = *(const bf16x8*)(Vb + swz128(32 + q, g * 4 + 2 * s2 + hh));
          o0 = mfma32(v0, cv.v, o0);
          o1 = mfma32(v1, cv.v, o1);
        }
    }
  };
  for (int ti = 0; ti < ntile; ti += 2) {
    compute(ti);
    if (ti + 1 < ntile) {
      *(uint4*)(smem + 8192 + swz128(srow, sch)) = rkA;
      *(uint4*)(smem + 16384 + 8192 + swz128(srow, sch)) = rvA;
      if (ti + 3 < ntile) gload(ti + 3, rkA, rvA);
    }
    __syncthreads();
    if (ti + 1 < ntile) {
      compute(ti + 1);
      if (ti + 2 < ntile) {
        *(uint4*)(smem + swz128(srow, sch)) = rkB;
        *(uint4*)(smem + 16384 + swz128(srow, sch)) = rvB;
        if (ti + 4 < ntile) gload(ti + 4, rkB, rvB);
      }
      __syncthreads();
    }
  }
  const float lt = l_run + shx(l_run, 32);
  const float inv = 1.0f / lt;
  __syncthreads();
  {
    char* ot = smem + wid * 4608;
#pragma unroll
    for (int qd = 0; qd < 4; ++qd) {
      uint2 a0, a1;
      a0.x = pk2(o0[4 * qd] * inv, o0[4 * qd + 1] * inv);
      a0.y = pk2(o0[4 * qd + 2] * inv, o0[4 * qd + 3] * inv);
      a1.x = pk2(o1[4 * qd] * inv, o1[4 * qd + 1] * inv);
      a1.y = pk2(o1[4 * qd + 2] * inv, o1[4 * qd + 3] * inv);
      *(uint2*)(ot + q * 144 + (8 * qd + 4 * hh) * 2) = a0;
      *(uint2*)(ot + q * 144 + (32 + 8 * qd + 4 * hh) * 2) = a1;
    }
    asm volatile("s_waitcnt lgkmcnt(0)" ::: "memory");
    const int tok0 = b * 4096 + r * 64 + half * 32;
#pragma unroll
    for (int it = 0; it < 4; ++it) {
      const int qq = it * 8 + (lane >> 3), ch = lane & 7;
      const uint4 v = *(const uint4*)(ot + qq * 144 + ch * 16);
      *(uint4*)(p.ycat + (size_t)(tok0 + qq) * 1024 + h * 64 + ch * 8) = v;
    }
  }
  __syncthreads();
}
__device__ __forceinline__ void attn_task(const P& p, int l, int kind, int idx, char* smem) {
  const int tid_ = opaque_tid(); const int lane = tid_ & 63, wid = tid_ >> 6;
  float* rpbL = (float*)smem + wid * 480;
  for (int i = lane; i < 465; i += 64) rpbL[i] = p.na_rpb[(size_t)(l * 8 + wid) * 465 + i];
  __syncthreads();
  if (kind == 0) {
    const int half = idx & 1, r = (idx >> 1) & 63, b = idx >> 7;
    attn_wave(p, l, b, wid, true, r, half, b * 4096 + r * 64 + half * 32, rpbL);
  } else {
    const int qg = idx & 7, b = idx >> 3;
    attn_wave(p, l, b, wid, false, 0, 0, NLAT + b * 256 + qg * 32, rpbL);
  }
  __syncthreads();
}

__device__ __forceinline__ void phase_mixers(const P& p, int l, char* smem, unsigned* counter) {
  const bool last = (l == 1);
  const int n_rg = 1088 * XRGA, n_fft = 1024 * XFFT, n_hc = last ? 0 : 256, n_att = 1024 * XATT, n_attc = last ? 0 : 64;
  const int total = n_rg + n_fft + n_hc + n_att + n_attc;
  volatile int* s_taskp = (volatile int*)(smem + SMEM_BYTES - 16);
  for (;;) {
    __syncthreads();
    if (threadIdx.x == 0) *s_taskp = (int)atomicAdd(counter, 1u);
    __syncthreads();
    int t = *s_taskp;
    if (t >= total) break;
    if (t < n_att) { t &= 1023; attn_block_task(p, l, t >> 7, (t >> 4) & 7, t & 15, smem); continue; }
    t -= n_att;
    if (t < n_attc) { attn_task(p, l, 1, t, smem); continue; }
    t -= n_attc;
    if (t < n_fft) { t &= 1023; hyena_fft_task(p, l, t >> 2, t & 3, smem); continue; }
    t -= n_fft;
    if (t < n_hc) { hyena_ctx_task(p, l, t >> 5, t & 31, smem); continue; }
    t -= n_hc;
    if (t >= 1088) t -= 1088;
    rg_wave_task(p, l, t >> 2, t & 3, 0, last, smem);
  }
}

__device__ __forceinline__ void merge_tile(const P& p, int l, int mt, int nt, char* smem) {
  EPI_VARS
  const int m0 = mt * 256, n0 = nt * 128;
  f32x16 macc[2][2];
  zero_acc(macc);
  for (int br = 0; br < 3; ++br) {
    unsigned* gpl = (unsigned*)(smem + 98304) + tid;
    {
      f32x16 acc[2][2];
      zero_acc(acc);
      gemm_kloop(acc, p.xn + (size_t)m0 * 1024, 1024, p.WgT + ((size_t)l * 3072 + br * 1024 + n0) * 1024, 1024, 1024, smem);
#pragma unroll
      for (int j = 0; j < 2; ++j) {
        const float bg = p.b_gate[l * 3072 + br * 1024 + n0 + EPI_COL(j)];
#pragma unroll
        for (int i = 0; i < 2; ++i)
#pragma unroll
          for (int e = 0; e < 4; ++e) {
            const unsigned q0 = (unsigned)(sigmoidf_(acc[i][j][4 * e] + bg) * 255.0f + 0.5f);
            const unsigned q1 = (unsigned)(sigmoidf_(acc[i][j][4 * e + 1] + bg) * 255.0f + 0.5f);
            const unsigned q2 = (unsigned)(sigmoidf_(acc[i][j][4 * e + 2] + bg) * 255.0f + 0.5f);
            const unsigned q3 = (unsigned)(sigmoidf_(acc[i][j][4 * e + 3] + bg) * 255.0f + 0.5f);
            gpl[((i * 2 + j) * 4 + e) * 512] = q0 | (q1 << 8) | (q2 << 16) | (q3 << 24);
          }
      }
    }
    {
      f32x16 acc[2][2];
      zero_acc(acc);
      const u16* A; const u16* B; int K;
      if (br == 0) { A = p.ycat + (size_t)m0 * 1024; B = p.WaT + ((size_t)l * 1024 + n0) * 512; K = 512; }
      else if (br == 1) { A = p.ycat + (size_t)m0 * 1024 + 512; B = p.WbT + ((size_t)l * 1024 + n0) * 256; K = 256; }
      else { A = p.ycat + (size_t)m0 * 1024 + 768; B = p.WcT + ((size_t)l * 1024 + n0) * 256; K = 256; }
      gemm_kloop(acc, A, 1024, B, K, K, smem);
#pragma unroll
      for (int i = 0; i < 2; ++i)
#pragma unroll
        for (int j = 0; j < 2; ++j)
#pragma unroll
          for (int e = 0; e < 4; ++e) {
            const unsigned g4 = gpl[((i * 2 + j) * 4 + e) * 512];
            macc[i][j][4 * e] += (float)(g4 & 255u) * (1.0f / 255.0f) * acc[i][j][4 * e];
            macc[i][j][4 * e + 1] += (float)((g4 >> 8) & 255u) * (1.0f / 255.0f) * acc[i][j][4 * e + 1];
            macc[i][j][4 * e + 2] += (float)((g4 >> 16) & 255u) * (1.0f / 255.0f) * acc[i][j][4 * e + 2];
            macc[i][j][4 * e + 3] += (float)(g4 >> 24) * (1.0f / 255.0f) * acc[i][j][4 * e + 3];
          }
    }
  }
#pragma unroll
  for (int i = 0; i < 2; ++i)
#pragma unroll
    for (int j = 0; j < 2; ++j)
#pragma unroll
      for (int e = 0; e < 16; ++e)
        p.mbuf[(size_t)(m0 + EPI_ROW(i, e)) * 1024 + n0 + EPI_COL(j)] = f2bf(macc[i][j][e]);
}
__device__ __forceinline__ void outproj_tile(const P& p, int l, int mt, int nt, char* smem, bool do_store) {
  EPI_VARS
  const int m0 = mt * 256, n0 = nt * 128;
  f32x16 acc[2][2];
  zero_acc(acc);
  gemm_kloop(acc, p.mbuf + (size_t)m0 * 1024, 1024, p.WoT + ((size_t)l * 1024 + n0) * 1024, 1024, 1024, smem);
  const bool isctx = (mt >= 128);
  const int bi = isctx ? 8 : (mt >> 4);
  const float* gatev = p.mod + ((size_t)(l * 9 + bi) * 6 + 2) * 1024;
  const float* src; float* dst;
  if (isctx) { src = (l == 0 ? p.ctx : p.ctxs) - (size_t)NLAT * 1024; dst = p.ctxs - (size_t)NLAT * 1024; }
  else { src = (l == 0 ? p.x : p.out); dst = p.out; }
#pragma unroll
  for (int j = 0; j < 2; ++j) {
    const int col = n0 + EPI_COL(j);
    const float gv = gatev[col];
#pragma unroll
    for (int i = 0; i < 2; ++i)
#pragma unroll
      for (int e = 0; e < 16; ++e) {
        const size_t o = (size_t)(m0 + EPI_ROW(i, e)) * 1024 + col;
        if (do_store) dst[o] = src[o] + gv * acc[i][j][e];
      }
  }
}

__device__ __forceinline__ void wqk_task(const P& p, int l, int hp, int nt, char* smem) {
  EPI_VARS
  f32x16 acc[2][2];
  zero_acc(acc);
  gemm_kloop(acc, p.keysB + ((size_t)l * 16 + hp) * 16384, 128, p.WqB + (size_t)l * 1024 * 2048 + (size_t)(nt * 128) * 2048 + hp * 128, 2048, 128, smem);
  if (wm < 2) {
#pragma unroll
    for (int i = 0; i < 2; ++i)
#pragma unroll
      for (int j = 0; j < 2; ++j)
#pragma unroll
        for (int e = 0; e < 16; ++e)
          p.WqkT[((size_t)l * 2048 + hp * 128 + EPI_ROW(i, e)) * 1024 + nt * 128 + EPI_COL(j)] = f2bf(acc[i][j][e]);
  }
}
__device__ __forceinline__ void ins16(unsigned (&L)[16], unsigned x) {
#pragma unroll
  for (int i = 0; i < 16; ++i) {
    const unsigned hi = max(L[i], x);
    x = min(L[i], x);
    L[i] = hi;
  }
}
__device__ __forceinline__ unsigned f2sort(float f) {
  const unsigned b = __float_as_uint(f);
  return b ^ ((unsigned)((int)b >> 31) | 0x80000000u);
}
__device__ __forceinline__ float sort2f(unsigned k) {
  const unsigned u = k & ~127u;
  const unsigned b = (u & 0x80000000u) ? (u ^ 0x80000000u) : ~u;
  return __uint_as_float(b);
}
__device__ __forceinline__ void cx_desc(unsigned& a, unsigned& b) { const unsigned hi = max(a, b), lo = min(a, b); a = hi; b = lo; }
template <int BASE> __device__ __forceinline__ void sort16_desc(unsigned (&k)[64]) {
#pragma unroll
  for (int sz = 2; sz <= 16; sz <<= 1) {
#pragma unroll
    for (int j = sz >> 1; j >= 1; j >>= 1) {
#pragma unroll
      for (int i = 0; i < 16; ++i) {
        const int l2 = i ^ j;
        if (l2 > i) {
          if ((i & sz) == 0) cx_desc(k[BASE + i], k[BASE + l2]);
          else cx_desc(k[BASE + l2], k[BASE + i]);
        }
      }
    }
  }
}
template <int AB, int BB> __device__ __forceinline__ void merge16_desc(unsigned (&k)[64]) {
#pragma unroll
  for (int i = 0; i < 16; ++i) k[AB + i] = max(k[AB + i], k[BB + 15 - i]);
#pragma unroll
  for (int j = 8; j >= 1; j >>= 1) {
#pragma unroll
    for (int i = 0; i < 16; ++i)
      if ((i & j) == 0) cx_desc(k[AB + i], k[AB + i + j]);
  }
}
__device__ __forceinline__ void peer_score_tile(const P& p, int l, int mt, int hp, char* smem) {
  const int tid = opaque_tid();
  const int m0 = mt * 256;
  const int row = tid >> 1, hf = tid & 1;
  {
    char* T = smem + 16384;
#pragma unroll
    for (int it = 0; it < 8; ++it) {
      const int id = tid + NTHR * it;
      const int r = id >> 4, ch = id & 15;
      *(uint4*)(T + r * 272 + ch * 16) = *(const uint4*)(p.q + (size_t)(m0 + r) * 2048 + hp * 128 + ch * 8);
    }
  }
  __syncthreads();
  const char* sp = smem + 16384 + row * 272 + hf * 128;
  unsigned k[64];
#pragma unroll
  for (int c = 0; c < 8; ++c) {
    const uint4 r = *(const uint4*)(sp + 16 * c);
    const unsigned w[4] = {r.x, r.y, r.z, r.w};
#pragma unroll
    for (int q = 0; q < 4; ++q) {
      const float v0 = __builtin_bit_cast(_Float16, (unsigned short)(w[q] & 0xffffu));
      const float v1 = __builtin_bit_cast(_Float16, (unsigned short)(w[q] >> 16));
      const int key = hf * 64 + c * 8 + q * 2;
      k[c * 8 + q * 2] = (f2sort(v0) & ~127u) | (unsigned)key;
      k[c * 8 + q * 2 + 1] = (f2sort(v1) & ~127u) | (unsigned)(key + 1);
    }
  }
  sort16_desc<0>(k); sort16_desc<16>(k); sort16_desc<32>(k); sort16_desc<48>(k);
  merge16_desc<0, 16>(k);
  merge16_desc<32, 48>(k);
  merge16_desc<0, 32>(k);
  unsigned* X = (unsigned*)smem;
  if (hf) {
#pragma unroll
    for (int i = 0; i < 16; ++i) X[row * 16 + i] = k[i];
  }
  __syncthreads();
  if (!hf) {
#pragma unroll
    for (int i = 0; i < 16; ++i) k[16 + i] = X[row * 16 + i];
    merge16_desc<0, 16>(k);
    unsigned* o = p.topk + ((size_t)(m0 + row) * 16 + hp) * 16;
#pragma unroll
    for (int i = 0; i < 4; ++i) *(uint4*)(o + 4 * i) = make_uint4(k[4 * i], k[4 * i + 1], k[4 * i + 2], k[4 * i + 3]);
  }
  __syncthreads();
}

__device__ __forceinline__ void phase_peer_experts(const P& p, int l, bool do_store, char* smem) {
  const int tid_ = opaque_tid(); const int lane = tid_ & 63, wid = tid_ >> 6;
  const int ntok = (l == 1) ? NLAT : NTOK;
  int ci, cj;
  {
    const int e = lane;
    if (e < 16) { ci = 0; cj = e; }
    else if (e < 24) { ci = 1; cj = e - 16; }
    else if (e < 29) { ci = 2; cj = e - 24; }
    else if (e < 33) { ci = 3; cj = e - 29; }
    else if (e < 36) { ci = 4; cj = e - 33; }
    else if (e < 38) { ci = 5; cj = e - 36; }
    else if (e < 40) { ci = 6; cj = e - 38; }
    else if (e < 42) { ci = 7; cj = e - 40; }
    else { ci = min(8 + (e - 42), 15); cj = 0; }
  }
  for (int tok = blockIdx.x * 8 + wid; tok < ntok; tok += gridDim.x * 8) {
    float xr[16];
    {
      const uint4 a = *(const uint4*)(p.xn + (size_t)tok * 1024 + lane * 16);
      const uint4 b = *(const uint4*)(p.xn + (size_t)tok * 1024 + lane * 16 + 8);
      xr[0] = bflo(a.x); xr[1] = bfhi(a.x); xr[2] = bflo(a.y); xr[3] = bfhi(a.y);
      xr[4] = bflo(a.z); xr[5] = bfhi(a.z); xr[6] = bflo(a.w); xr[7] = bfhi(a.w);
      xr[8] = bflo(b.x); xr[9] = bfhi(b.x); xr[10] = bflo(b.y); xr[11] = bfhi(b.y);
      xr[12] = bflo(b.z); xr[13] = bfhi(b.z); xr[14] = bflo(b.w); xr[15] = bfhi(b.w);
    }
    typedef _Float16 h2_t __attribute__((ext_vector_type(2)));
    h2_t yh[8];
#pragma unroll
    for (int i = 0; i < 8; ++i) yh[i] = (h2_t){(_Float16)0, (_Float16)0};
    int* selw = (int*)(smem + wid * 4096);
    const unsigned* kvp = p.topk + (size_t)tok * 256 + (lane & 31);
#pragma unroll 1
    for (int hb = 0; hb < 8; hb += 4) {
      unsigned key[4]; int eidx[4];
#pragma unroll
      for (int u = 0; u < 4; ++u) {
        const unsigned kv = kvp[(hb + u) * 32];
        const unsigned k0 = shu(kv, ci);
        const unsigned k1 = shu(kv, 16 + cj);
        const float val = (lane < 50) ? (sort2f(k0) + sort2f(k1)) : -3.0e38f;
        eidx[u] = (int)((k0 & 127u) * 128u + (k1 & 127u));
        key[u] = (f2sort(val) & ~63u) | (unsigned)lane;
      }
#pragma unroll
      for (int k = 2; k <= 64; k <<= 1) {
#pragma unroll
        for (int j = k >> 1; j >= 1; j >>= 1) {
          const bool take_max = (((lane & j) == 0) == ((lane & k) == 0));
#pragma unroll
          for (int u = 0; u < 4; ++u) {
            unsigned ok;
            if (j == 1) ok = xorl<1>(key[u], lane); else if (j == 2) ok = xorl<2>(key[u], lane); else if (j == 4) ok = xorl<4>(key[u], lane);
            else if (j == 8) ok = xorl<8>(key[u], lane); else if (j == 16) ok = xorl<16>(key[u], lane); else ok = xorl<32>(key[u], lane);
            key[u] = take_max ? max(key[u], ok) : min(key[u], ok);
          }
        }
      }
#pragma unroll
      for (int u = 0; u < 4; ++u) {
        const int si = __builtin_amdgcn_ds_bpermute((int)(key[u] & 63u) << 2, eidx[u]);
        const unsigned ku = key[u] & ~63u;
        const float sv = __uint_as_float((ku & 0x80000000u) ? (ku ^ 0x80000000u) : ~ku);
        const float mx = __builtin_bit_cast(float, __builtin_amdgcn_readlane(__builtin_bit_cast(int, sv), 0));
        const float ex = (lane < 16) ? __builtin_amdgcn_exp2f((sv - mx) * 1.4426950408889634f) : 0.f;
        const float sm = wave_sum(ex);
        selw[(hb + u) * 64 + lane] = si;
        selw[512 + (hb + u) * 64 + lane] = __builtin_bit_cast(int, ex * __builtin_amdgcn_rcpf(sm));
      }
    }
    {
      int w[4];
#pragma unroll
      for (int i = 0; i < 4; ++i) {
        int t = __builtin_amdgcn_cvt_pk_fp8_f32(xr[4 * i], xr[4 * i + 1], 0, false);
        w[i] = __builtin_amdgcn_cvt_pk_fp8_f32(xr[4 * i + 2], xr[4 * i + 3], t, true);
      }
      *(uint4*)(smem + 32768 + wid * 1024 + lane * 16) = make_uint4((unsigned)w[0], (unsigned)w[1], (unsigned)w[2], (unsigned)w[3]);
    }
    asm volatile("s_waitcnt lgkmcnt(0)" ::: "memory");
    const int e15 = lane & 15, g4 = lane >> 4;
#pragma unroll 1
    for (int h = 0; h < 8; ++h) {
      const int eperm_h = selw[h * 64 + lane];
      const int gperm_h = selw[512 + h * 64 + lane];
      const int ide = (int)shu((unsigned)eperm_h, e15);
      const unsigned char* ub = p.Ub + (size_t)ide * 1024 + g4 * 16;
      uint4 ua[8];
#pragma unroll
      for (int sI = 0; sI < 8; ++sI) ua[sI] = *(const uint4*)(ub + sI * 64);
      pg8::f32x4 hacc = {0.f, 0.f, 0.f, 0.f};
#pragma unroll
      for (int sI = 0; sI < 8; ++sI) {
        const uint4 b0 = *(const uint4*)(smem + 32768 + wid * 1024 + sI * 128 + g4 * 16);
        const uint4 b1 = *(const uint4*)(smem + 32768 + wid * 1024 + sI * 128 + 64 + g4 * 16);
        const i32x8 A = {(int)ua[sI].x, (int)ua[sI].y, (int)ua[sI].z, (int)ua[sI].w, 0, 0, 0, 0};
        const i32x8 B = {(int)b0.x, (int)b0.y, (int)b0.z, (int)b0.w, (int)b1.x, (int)b1.y, (int)b1.z, (int)b1.w};
        hacc = __builtin_amdgcn_mfma_scale_f32_16x16x128_f8f6f4(A, B, hacc, 4  , 0  , 0, 0x7f7f7f7f, 0, 0x7f7f7f7f);
      }
      asm volatile("" ::: "memory");
      uint2 V[16];
#pragma unroll
      for (int k = 0; k < 16; ++k) {
        const int id = __builtin_amdgcn_readlane(eperm_h, k);
        V[k] = *(const uint2*)(p.Ub + (size_t)id * 1024 + 512 + lane * 8);
      }
      float actv[4];
#pragma unroll
      for (int r4 = 0; r4 < 4; ++r4) {
        const float gl = __builtin_bit_cast(float, shu((unsigned)gperm_h, 4 * g4 + r4));
        actv[r4] = gelu_tanh(hacc[r4] * (1.0f / 64.0f)) * gl;
      }
#pragma unroll
      for (int k = 0; k < 16; ++k) {
        const float ak = __builtin_bit_cast(float, __builtin_amdgcn_readlane(__builtin_bit_cast(int, actv[k & 3]), 16 * (k >> 2)));
        const h2_t akh = {(_Float16)ak, (_Float16)ak};
        const unsigned vw[2] = {V[k].x, V[k].y};
#pragma unroll
        for (int q2 = 0; q2 < 2; ++q2) {
          yh[4 * q2 + 0] = __builtin_elementwise_fma(akh, __builtin_bit_cast(h2_t, __builtin_amdgcn_cvt_scalef32_pk_f16_fp4(vw[q2], 1.0f, 0)), yh[4 * q2 + 0]);
          yh[4 * q2 + 1] = __builtin_elementwise_fma(akh, __builtin_bit_cast(h2_t, __builtin_amdgcn_cvt_scalef32_pk_f16_fp4(vw[q2], 1.0f, 1)), yh[4 * q2 + 1]);
          yh[4 * q2 + 2] = __builtin_elementwise_fma(akh, __builtin_bit_cast(h2_t, __builtin_amdgcn_cvt_scalef32_pk_f16_fp4(vw[q2], 1.0f, 2)), yh[4 * q2 + 2]);
          yh[4 * q2 + 3] = __builtin_elementwise_fma(akh, __builtin_bit_cast(h2_t, __builtin_amdgcn_cvt_scalef32_pk_f16_fp4(vw[q2], 1.0f, 3)), yh[4 * q2 + 3]);
        }
      }
    }
    float yacc[16];
#pragma unroll
    for (int i = 0; i < 8; ++i) { yacc[2 * i] = (float)yh[i].x; yacc[2 * i + 1] = (float)yh[i].y; }
    const int bi = tok < NLAT ? (tok >> 12) : 8;
    const float* gv = p.mod + ((size_t)(l * 9 + bi) * 6 + 5) * 1024 + lane * 16;
    float* xp = (tok < NLAT) ? (p.out + (size_t)tok * 1024) : (p.ctxs + (size_t)(tok - NLAT) * 1024);
    xp += lane * 16;
    float4 xv[4];
    float ss = 0.f;
#pragma unroll
    for (int i = 0; i < 4; ++i) {
      xv[i] = *(float4*)(xp + 4 * i);
      const float4 g4 = *(const float4*)(gv + 4 * i);
      xv[i].x += g4.x * yacc[4 * i] * 0.25f; xv[i].y += g4.y * yacc[4 * i + 1] * 0.25f; xv[i].z += g4.z * yacc[4 * i + 2] * 0.25f; xv[i].w += g4.w * yacc[4 * i + 3] * 0.25f;
      ss += xv[i].x * xv[i].x + xv[i].y * xv[i].y + xv[i].z * xv[i].z + xv[i].w * xv[i].w;
    }
    ss = wave_sum(ss);
    const float rstd = rsqrtf(ss * (1.0f / 1024.0f) + 1e-6f);
    if (l == 0) {
      const float* gam = p.norm_mix_g + 1024 + lane * 16;
      const float* msh = p.mod + ((size_t)(9 + bi) * 6 + 0) * 1024 + lane * 16;
      const float* msc = msh + 1024;
      float yv[16];
      float amax = 0.f;
#pragma unroll
      for (int i = 0; i < 4; ++i) {
        const float4 g = *(const float4*)(gam + 4 * i);
        const float4 sh = *(const float4*)(msh + 4 * i);
        const float4 sc = *(const float4*)(msc + 4 * i);
        yv[4 * i] = xv[i].x * rstd * g.x * (1.f + sc.x) + sh.x; yv[4 * i + 1] = xv[i].y * rstd * g.y * (1.f + sc.y) + sh.y;
        yv[4 * i + 2] = xv[i].z * rstd * g.z * (1.f + sc.z) + sh.z; yv[4 * i + 3] = xv[i].w * rstd * g.w * (1.f + sc.w) + sh.w;
      }
#pragma unroll
      for (int i = 0; i < 16; ++i) amax = fmaxf(amax, fabsf(yv[i]));
      amax = fmaxf(wave_max(amax), 1e-20f);
      const float inv = 127.0f / amax;
      unsigned w[4];
#pragma unroll
      for (int i = 0; i < 4; ++i)
        w[i] = ((unsigned)__float2int_rn(yv[4 * i] * inv) & 255u) | (((unsigned)__float2int_rn(yv[4 * i + 1] * inv) & 255u) << 8) |
               (((unsigned)__float2int_rn(yv[4 * i + 2] * inv) & 255u) << 16) | (((unsigned)__float2int_rn(yv[4 * i + 3] * inv) & 255u) << 24);
      if (do_store) {
#pragma unroll
        for (int i = 0; i < 4; ++i) *(float4*)(xp + 4 * i) = xv[i];
        *(uint4*)(p.xn8 + (size_t)tok * 1024 + lane * 16) = make_uint4(w[0], w[1], w[2], w[3]);
        if (lane == 0) p.sa[tok] = amax * (1.0f / 127.0f);
      }
    } else {
      const float* fg = p.final_g + lane * 16;
      float4 gf[4];
#pragma unroll
      for (int i = 0; i < 4; ++i) gf[i] = *(const float4*)(fg + 4 * i);
#pragma unroll
      for (int i = 0; i < 4; ++i) {
        const float4 g = gf[i];
        const float4 o = make_float4(xv[i].x * rstd * g.x, xv[i].y * rstd * g.y, xv[i].z * rstd * g.z, xv[i].w * rstd * g.w);
        if (do_store) *(float4*)(xp + 4 * i) = o;
      }
    }
  }
}


#define XB_TMO      128
#define XB_XCNT(j)  (256  + 64 * (j))
#define XB_XSUB(j)  (1280 + 64 * (j))
#define XB_XGEN(j)  (2304 + 64 * (j))
#define XB_TOP      3328
#define XB_TOPGEN   3392
#define XCD_BAR_WORDS 3456
#define XB_SPIN_CAP (1u << 22)
#define LAS __attribute__((address_space(3)))
__device__ __forceinline__ unsigned xb_ld(unsigned* p) { return __hip_atomic_load(p, __ATOMIC_RELAXED, __HIP_MEMORY_SCOPE_AGENT); }
__device__ __forceinline__ unsigned xb_add(unsigned* p, unsigned v) { return __hip_atomic_fetch_add(p, v, __ATOMIC_RELAXED, __HIP_MEMORY_SCOPE_AGENT); }
__device__ __forceinline__ unsigned xb_xcc_id() { return (unsigned)__builtin_amdgcn_s_getreg((3 << 11) | 20) & 0xFu; }
#define XB_SPIN(cond, bar) do { unsigned _sp = 0; while (cond) { __builtin_amdgcn_s_sleep(1); \
    if ((++_sp & 255u) == 0u) { if (xb_ld(&(bar)[XB_TMO])) break; if (_sp > XB_SPIN_CAP) { atomicAdd(&(bar)[XB_TMO], 1u); break; } } } } while (0)
struct XcdBarrier { unsigned* bar; unsigned x; volatile LAS unsigned* st; };
__device__ __forceinline__ XcdBarrier xcd_barrier_post(unsigned* bar, volatile LAS unsigned* st) {
  XcdBarrier b; b.bar = bar; b.x = xb_xcc_id(); b.st = st;
  if (threadIdx.x == 0) (void)xb_add(&bar[XB_XCNT(b.x)], 1u);
  return b;
}
__device__ __forceinline__ void xcd_barrier_complete(unsigned* bar, unsigned x, unsigned& nloc, unsigned& nx) {
  const unsigned G = gridDim.x * gridDim.y * gridDim.z;
  unsigned sum, cnt, mine, sp = 0u;
  for (;;) {
    sum = 0u; cnt = 0u; mine = 0u;
#pragma unroll
    for (unsigned j = 0; j < 16; ++j) { const unsigned c = xb_ld(&bar[XB_XCNT(j)]); sum += c; cnt += (c > 0u) ? 1u : 0u; mine = (j == x) ? c : mine; }
    if (sum == G) break;
    __builtin_amdgcn_s_sleep(1);
    if ((++sp & 255u) == 0u) { if (xb_ld(&bar[XB_TMO])) break; if (sp > XB_SPIN_CAP) { atomicAdd(&bar[XB_TMO], 1u); break; } }
  }
  nloc = mine > 0u ? mine : 1u; nx = cnt > 0u ? cnt : 1u;
}
__device__ __forceinline__ void xcd_barrier(unsigned* bar_u, volatile LAS unsigned* st_u) {
  XcdBarrier b; b.bar = bar_u; b.x = xb_xcc_id(); b.st = st_u;
  asm volatile("s_waitcnt vmcnt(0)" ::: "memory");
  __syncthreads();
  if (threadIdx.x == 0) {
    unsigned long long bp_ = (unsigned long long)b.bar;
    asm volatile("" : "+v"(bp_));
    unsigned* bar = (unsigned*)bp_;
    __builtin_amdgcn_s_waitcnt(0);
    unsigned nloc = b.st[0], nx = b.st[1];
    if (nloc == 0u) { xcd_barrier_complete(bar, b.x, nloc, nx); b.st[0] = nloc; b.st[1] = nx; }
    const unsigned old = xb_add(&bar[XB_XSUB(b.x)], 1u);
    const unsigned gen = old / nloc;
    if (old + 1u == (gen + 1u) * nloc) {
      __builtin_amdgcn_fence(__ATOMIC_RELEASE, "agent");
      asm volatile("s_waitcnt vmcnt(0)" ::: "memory");
      const unsigned og = xb_add(&bar[XB_TOP], 1u);
      const unsigned tg = og / nx;
      if (og + 1u == (tg + 1u) * nx) xb_add(&bar[XB_TOPGEN], 1u);
      else XB_SPIN(xb_ld(&bar[XB_TOPGEN]) == tg, bar);
      __builtin_amdgcn_fence(__ATOMIC_ACQUIRE, "agent");
      xb_add(&bar[XB_XGEN(b.x)], 1u);
      asm volatile("s_waitcnt vmcnt(0)" ::: "memory");
    } else {
      XB_SPIN(xb_ld(&bar[XB_XGEN(b.x)]) == gen, bar);
      __builtin_amdgcn_fence(__ATOMIC_ACQUIRE, "agent");
      asm volatile("s_waitcnt vmcnt(0)" ::: "memory");
    }
  }
  __syncthreads();
}

template <int l>
__device__ __forceinline__ void layer_body(const P& p, char* smem, pg8::PG8_LAS_T lds, volatile LAS unsigned* xbw, const int nb, const int bid) {
    const bool last = (l == 1);
    const int n_mt = last ? 128 : 136;
    if (l == 0) {
      phase_norm(p, l, 0);
      xcd_barrier(p.counters + 1024, xbw);
    }
_Pragma("unroll 1")
    for (int rep = 0; rep < REP_INPROJ; ++rep) {
      pg8::Gemm g; pg8::Order S;
      g.A = (const u16*)p.xn8; g.Bt = (const u16*)(p.Win8 + (size_t)l * 2816 * 1024); g.lda = 512; g.ldb = 512; g.K = 512;
      S.init(136, 6, nb, bid, 4, 5);
      pg8::EpiInprojN8 e1; e1.qk = p.qk; e1.rg = p.rg; e1.sa = p.sa; e1.sw = p.sw + l * 5888;
      pg8::gemm_phase(lds, g, S, e1);
      g.A = (const u16*)(p.Win8 + ((size_t)l * 2816 + 1024) * 1024); g.Bt = (const u16*)p.xn8;
      S.init(5, 136, nb, (bid + nb - (136 * 6) % nb) % nb);
      pg8::EpiInprojT8 e2; e2.vT = p.vT; e2.sa = p.sa; e2.sw = p.sw + l * 5888 + 1024;
      pg8::gemm_phase(lds, g, S, e2);
    }
    xcd_barrier(p.counters + 1024, xbw);
    phase_mixers(p, l, smem, p.counters + l * 4);
    xcd_barrier(p.counters + 1024, xbw);
_Pragma("unroll 1")
    for (int rep = 0; rep < REP_2B; ++rep)
      for (int task = bid; task < 1088 + 512; task += nb) {
        if (task < 1088) rg_wave_task(p, l, task >> 2, task & 3, 1, last, smem);
        else yb_transpose_task(p, (task - 1088) >> 6, (task - 1088) & 63, smem);
      }
    xcd_barrier(p.counters + 1024, xbw);
_Pragma("unroll 1")
    for (int rep = 0; rep < REP_GATE; ++rep) {
      pg8::Gemm g; pg8::Order S;
      g.A = (const u16*)p.xn8; g.Bt = (const u16*)(p.Wg8 + (size_t)l * 3072 * 1024); g.lda = 512; g.ldb = 512; g.K = 512;
      S.init(n_mt, 12, nb, bid);
      pg8::EpiGate8 e; e.g8 = p.g8; e.bias = p.b_gate + l * 3072; e.sa = p.sa; e.sw = p.sw + l * 5888 + 2816;
      pg8::gemm_phase(lds, g, S, e);
    }
    xcd_barrier(p.counters + 1024, xbw);
_Pragma("unroll 1")
    for (int rep = 0; rep < REP_BRANCH; ++rep) {
      pg8::Gemm g; pg8::Order S;
      S.init(n_mt, 4, nb, bid);
      pg8::EpiBranch e; e.mbuf = p.mbuf; e.g8 = p.g8;
      g.lda = 1024;
      g.A = p.ycat; g.Bt = p.WaT + (size_t)l * 1024 * 512; g.ldb = 512; g.K = 512; e.br = 0;
      pg8::gemm_phase(lds, g, S, e);
      g.A = p.ycat + 512; g.Bt = p.WbT + (size_t)l * 1024 * 256; g.ldb = 256; g.K = 256; e.br = 1;
      pg8::gemm_phase(lds, g, S, e);
      g.A = p.ycat + 768; g.Bt = p.WcT + (size_t)l * 1024 * 256; g.ldb = 256; g.K = 256; e.br = 2;
      pg8::gemm_phase(lds, g, S, e);
    }
    xcd_barrier(p.counters + 1024, xbw);
    {
      pg8::Gemm g; pg8::Order S;
      g.A = p.mbuf; g.Bt = p.WoT + (size_t)l * 1024 * 1024; g.lda = 1024; g.ldb = 1024; g.K = 1024;
      S.init(n_mt, 4, nb, bid);
      pg8::EpiOut e; e.xsrc = (l == 0 ? p.x : p.out); e.csrc = (l == 0 ? p.ctx : p.ctxs); e.xdst = p.out; e.cdst = p.ctxs;
      e.modl = p.mod + (size_t)l * 9 * 6144;
      pg8::gemm_phase(lds, g, S, e);
      for (int t = bid; t < 8192; t += nb) {
        if (t < 4096) cvt_chunk_fp4(p.peer_u + (size_t)l * 16384 * 1024, p.Ub, (size_t)t, 64.0f, 0);
        else cvt_chunk_fp4(p.peer_v + (size_t)l * 16384 * 1024, p.Ub, (size_t)(t - 4096), 4.0f, 1);
      }
    }
    xcd_barrier(p.counters + 1024, xbw);
    phase_norm(p, l, 1);
    xcd_barrier(p.counters + 1024, xbw);
_Pragma("unroll 1")
    for (int rep = 0; rep < REP_Q; ++rep) {
      pg8::Gemm g; pg8::Order S;
      g.A = p.xn; g.Bt = p.WqkT + (size_t)l * 2048 * 1024; g.lda = 1024; g.ldb = 1024; g.K = 1024;
      S.init(n_mt, 8, nb, bid);
      pg8::EpiQ e; e.q = p.q;
      pg8::gemm_phase(lds, g, S, e);
    }
    xcd_barrier(p.counters + 1024, xbw);
_Pragma("unroll 1")
    for (int rep = 0; rep < REP_SCORE; ++rep)
      for (int task = bid; task < n_mt * 16; task += nb) peer_score_tile(p, l, task >> 4, task & 15, smem);
    xcd_barrier(p.counters + 1024, xbw);
_Pragma("unroll 1")
    for (int rep = 0; rep < REP_PEER; ++rep) phase_peer_experts(p, l, rep == REP_PEER - 1, smem);
    xcd_barrier(p.counters + 1024, xbw);
  }

__global__ void __launch_bounds__(NTHR) fwd_megakernel(P p) {
  __shared__ __attribute__((aligned(16))) char smem[SMEM_BYTES];
  cg::grid_group grid = cg::this_grid();
  const int nb = gridDim.x, bid = blockIdx.x;
  pg8::PG8_LAS_T lds = (pg8::PG8_LAS_T)smem;
  volatile LAS unsigned* xbw = (volatile LAS unsigned*)(smem + SMEM_BYTES - 32);
  if (threadIdx.x == 0) { xbw[0] = 0u; xbw[1] = 0u; xbw[2] = 0u; xbw[3] = 0u; }
  __syncthreads();
  (void)xcd_barrier_post(p.counters + 1024, xbw);

  phase_prep(p, smem, p.counters + 32);
  grid.sync();
  phase_modreduce(p);
  for (int task = blockIdx.x; task < 512; task += gridDim.x) kf_task(p, task >> 8, task & 255, smem);
  for (int task = blockIdx.x; task < 256; task += gridDim.x) wqk_task(p, task >> 7, (task >> 3) & 15, task & 7, smem);
  for (int task = blockIdx.x; task < 2 * 368; task += gridDim.x) {
    const int l = task / 368, t = task - l * 368;
    if (t < 176) tr_tile4<true>(p.w_in + (size_t)l * 1024 * 2816, 2816, 1024, p.Win8 + (size_t)l * 2816 * 1024, t, p.sw + l * 5888, smem);
    else tr_tile4<true>(p.w_gate + (size_t)l * 1024 * 3072, 3072, 1024, p.Wg8 + (size_t)l * 3072 * 1024, t - 176, p.sw + l * 5888 + 2816, smem);
  }
  xcd_barrier(p.counters + 1024, xbw);

  layer_body<0>(p, smem, lds, xbw, nb, bid);
  layer_body<1>(p, smem, lds, xbw, nb, bid);
}

extern "C" void kernel_launch(void* const* d_in, const int* in_sizes, int n_in, void* d_out, int out_size, void* d_ws,
                              size_t ws_size, hipStream_t stream) {
  P p;
  memset(&p, 0, sizeof(p));
  const float** ins = (const float**)&p;
  for (int i = 0; i < 37; ++i) ins[i] = (const float*)d_in[i];
  p.out = (float*)d_out;
  char* w = (char*)d_ws;
  size_t off = 0;
  auto take = [&](size_t bytes) { char* r = w + off; off += (bytes + 255) & ~(size_t)255; return r; };
  p.counters = (unsigned*)take(32768);
  p.WinT = nullptr; p.WgT = nullptr;
  p.Win8 = (unsigned char*)take((size_t)2 * 2816 * 1024);
  p.Wg8 = (unsigned char*)take((size_t)2 * 3072 * 1024);
  p.sw = (float*)take((size_t)2 * 5888 * 4);
  p.xn8 = (unsigned char*)take((size_t)NTOK * 1024);
  p.sa = (float*)take((size_t)NTOK * 4);
  p.WaT = (u16*)take((size_t)2 * 1024 * 512 * 2);
  p.WbT = (u16*)take((size_t)2 * 1024 * 256 * 2);
  p.WcT = (u16*)take((size_t)2 * 1024 * 256 * 2);
  p.WoT = (u16*)take((size_t)2 * 1024 * 1024 * 2);
  p.WqB = (u16*)take((size_t)2 * 1024 * 2048 * 2);
  p.WqkT = (u16*)take((size_t)2 * 2048 * 1024 * 2);
  p.keysB = (u16*)take((size_t)2 * 16 * 16384 * 2);
  p.rgW = (u16*)take((size_t)2 * 16 * 4096 * 2);
  p.modpart = (float*)take((size_t)16 * 2 * 9 * 6144 * 4);
  p.mod = (float*)take((size_t)2 * 9 * 6144 * 4);
  p.hT = (float*)take((size_t)2 * 512 * 4096 * 4);
  p.hc = (float*)take((size_t)512 * 256 * 4);
  p.Kf = (float*)take((size_t)2 * 256 * 8192 * 8);
  p.xn = (u16*)take((size_t)NTOK * 1024 * 2);
  p.qk = (u16*)take((size_t)NTOK * 1024 * 2);
  p.mbuf = p.qk;
  p.vT = (u16*)take((size_t)8 * 512 * 4096 * 2);
  p.vTc = (u16*)take((size_t)8 * 512 * 256 * 2);
  p.hyT = (u16*)take((size_t)8 * 768 * 4096 * 2);
  p.hyTc = (u16*)take((size_t)8 * 768 * 256 * 2);
  p.rg = (u16*)take((size_t)NTOK * 512 * 2);
  p.ycat = (u16*)take((size_t)NTOK * 1024 * 2);
  p.Ub = (unsigned char*)p.ycat;
  p.Vb = p.Ub + (size_t)16384 * 512;
  p.agg = (float*)take((size_t)8 * 2 * (136 + 34) * 256 * 8);
  p.ybT = (u16*)take((size_t)8 * 256 * 4096 * 2);
  p.ctxs = (float*)take((size_t)2048 * 1024 * 4);
  p.g8 = (unsigned char*)p.vT;
  p.q = p.qk;
  p.topk = (unsigned*)((char*)p.qk + (size_t)NTOK * 2048 * 2);
  if (off > ws_size) {
    fprintf(stderr, "workspace too small: need %zu have %zu\n", off, ws_size);
    return;
  }
  static int grid_blocks = 0;
  if (!grid_blocks) {
    int dev = 0, cus = 0, per_cu = 0;
    (void)hipGetDevice(&dev);
    (void)hipDeviceGetAttribute(&cus, hipDeviceAttributeMultiprocessorCount, dev);
    (void)hipOccupancyMaxActiveBlocksPerMultiprocessor(&per_cu, fwd_megakernel, NTHR, 0);
    if (per_cu > 1) per_cu = 1;
    grid_blocks = cus * per_cu;
  }
  (void)hipMemsetAsync(p.counters, 0, 32768, stream);
  void* args[] = {&p};
  hipError_t e = hipLaunchCooperativeKernel((void*)fwd_megakernel, dim3(grid_blocks), dim3(NTHR), args, 0, stream);
  if (e != hipSuccess) fprintf(stderr, "cooperative launch failed: %s (grid %d)\n", hipGetErrorString(e), grid_blocks);
}
```

```cpp
#include <hip/hip_runtime.h>
#include <hip/hip_cooperative_groups.h>
#include <cstdio>
#include <cstring>
namespace cg = cooperative_groups;

typedef unsigned short u16;
typedef __attribute__((ext_vector_type(8))) short bf16x8;
typedef __attribute__((ext_vector_type(16))) float f32x16;
typedef __attribute__((ext_vector_type(2))) float f32x2;
typedef int i32x8 __attribute__((ext_vector_type(8)));

#define NLAT 32768
#define NTOK 34816
#define SMEM_BYTES 151552
#define NTHR 512
#ifndef DUP_1A
#define DUP_1A 1
#endif
#ifndef DUP_PREP
#define DUP_PREP 1
#endif
#ifndef DUP_2B
#define DUP_2B 1
#endif
#ifndef XRGA
#define XRGA 1
#endif
#ifndef REP_PEER
#define REP_PEER 1
#endif
#ifndef REP_INPROJ
#define REP_INPROJ 1
#endif
#ifndef REP_GATE
#define REP_GATE 1
#endif
#ifndef REP_BRANCH
#define REP_BRANCH 1
#endif
#ifndef REP_Q
#define REP_Q 1
#endif
#ifndef REP_SCORE
#define REP_SCORE 1
#endif
#ifndef REP_1A
#define REP_1A 1
#endif
#ifndef REP_2B
#define REP_2B 1
#endif
#ifndef REP_KF
#define REP_KF 1
#endif
#ifndef DUP_GEMM
#define DUP_GEMM 1
#endif
#ifndef DUP_PEER
#define DUP_PEER 1
#endif
#ifndef DUP_MIX
#define DUP_MIX 1
#endif
#ifndef XRG
#define XRG 1
#endif
#ifndef XFFT
#define XFFT 1
#endif
#ifndef XATT
#define XATT 1
#endif

struct P {
  const float *x, *c, *ctx, *c_ctx, *norm_mix_g, *norm_ffn_g, *w_ada, *b_ada, *w_in, *na_rpb,
      *hy_short_w, *hy_short_b, *hy_f1_w, *hy_f1_b, *hy_f2_w, *hy_f2_b, *hy_f3_w, *hy_freq, *hy_bias,
      *rg_conv_w, *rg_conv_b, *rg_wa, *rg_ba, *rg_wx, *rg_bx, *rg_lambda,
      *w_gate, *b_gate, *w_br_a, *w_br_b, *w_br_c, *w_out, *peer_wq, *peer_keys, *peer_u, *peer_v, *final_g;
  float* out;
  unsigned* counters;
  u16 *WinT, *WgT, *WaT, *WbT, *WcT, *WoT, *WqB, *WqkT, *keysB, *rgW;
  float *modpart, *mod, *hT, *hc;
  float* Kf;
  u16 *xn, *qk, *vT, *vTc, *hyT, *hyTc, *rg, *ycat, *mbuf, *ybT;
  unsigned char *Ub, *Vb, *g8, *xn8, *Win8, *Wg8;
  float *sa, *sw;
  u16* q;
  float *agg, *ctxs;
  unsigned* topk;
};

__device__ __forceinline__ u16 f2bf(float f) {
  unsigned u = __float_as_uint(f);
  u += 0x7fffu + ((u >> 16) & 1u);
  return (u16)(u >> 16);
}
__device__ __forceinline__ float bf2f(u16 h) { return __uint_as_float(((unsigned)h) << 16); }
__device__ __forceinline__ unsigned pk2(float a, float b) { return (unsigned)f2bf(a) | ((unsigned)f2bf(b) << 16); }
__device__ __forceinline__ float bflo(unsigned u) { return __uint_as_float(u << 16); }
__device__ __forceinline__ float bfhi(unsigned u) { return __uint_as_float(u & 0xffff0000u); }
__device__ __forceinline__ int opaque_tid() {
  int t = threadIdx.x;
  asm volatile("" : "+v"(t));
  return t;
}
__device__ __forceinline__ int my_lane() { return opaque_tid() & 63; }
__device__ __forceinline__ float shx(float v, int o);
__device__ __forceinline__ float shf(float v, int src) { return __builtin_bit_cast(float, __builtin_amdgcn_ds_bpermute((src & 63) << 2, __builtin_bit_cast(int, v))); }
__device__ __forceinline__ unsigned shu(unsigned v, int src) { return (unsigned)__builtin_amdgcn_ds_bpermute((src & 63) << 2, (int)v); }
typedef unsigned u32x2_t __attribute__((ext_vector_type(2)));
template <int J> __device__ __forceinline__ unsigned xorl(unsigned v, int lane) {
  if constexpr (J == 1) return (unsigned)__builtin_amdgcn_mov_dpp((int)v, 0xB1, 0xF, 0xF, true);
  else if constexpr (J == 2) return (unsigned)__builtin_amdgcn_mov_dpp((int)v, 0x4E, 0xF, 0xF, true);
  else if constexpr (J == 4) {
    const unsigned a = (unsigned)__builtin_amdgcn_mov_dpp((int)v, 0x104, 0xF, 0xF, true);
    const unsigned b = (unsigned)__builtin_amdgcn_mov_dpp((int)v, 0x114, 0xF, 0xF, true);
    return (lane & 4) ? b : a;
  }
  else if constexpr (J == 8) return (unsigned)__builtin_amdgcn_mov_dpp((int)v, 0x128, 0xF, 0xF, true);
  else if constexpr (J == 16) { const u32x2_t r = __builtin_amdgcn_permlane16_swap(v, v, false, false); return (lane & 16) ? r.x : r.y; }
  else { const u32x2_t r = __builtin_amdgcn_permlane32_swap(v, v, false, false); return (lane & 32) ? r.x : r.y; }
}
template <int J> __device__ __forceinline__ float xorf(float v, int lane) { return __uint_as_float(xorl<J>(__float_as_uint(v), lane)); }
__device__ __forceinline__ float shx(float v, int o) {
  const int lane = my_lane();
  switch (o) {
    case 1: return xorf<1>(v, lane);
    case 2: return xorf<2>(v, lane);
    case 4: return xorf<4>(v, lane);
    case 8: return xorf<8>(v, lane);
    case 16: return xorf<16>(v, lane);
    case 32: return xorf<32>(v, lane);
    default: return __builtin_bit_cast(float, __builtin_amdgcn_ds_bpermute(((lane ^ o) << 2), __builtin_bit_cast(int, v)));
  }
}
__device__ __forceinline__ float wave_sum(float v) {
  const int lane = my_lane();
  v += xorf<32>(v, lane); v += xorf<16>(v, lane); v += xorf<8>(v, lane); v += xorf<4>(v, lane); v += xorf<2>(v, lane); v += xorf<1>(v, lane);
  return v;
}
__device__ __forceinline__ float wave_max(float v) {
  const int lane = my_lane();
  v = fmaxf(v, xorf<32>(v, lane)); v = fmaxf(v, xorf<16>(v, lane)); v = fmaxf(v, xorf<8>(v, lane));
  v = fmaxf(v, xorf<4>(v, lane)); v = fmaxf(v, xorf<2>(v, lane)); v = fmaxf(v, xorf<1>(v, lane));
  return v;
}
__device__ __forceinline__ float sigmoidf_(float x) { return __builtin_amdgcn_rcpf(1.0f + __expf(-x)); }
__device__ __forceinline__ float gelu_tanh(float x) {
  const float u2 = 1.5957691216057308f * (x + 0.044715f * x * x * x);
  return x * __builtin_amdgcn_rcpf(1.0f + __expf(-u2));
}
__device__ __forceinline__ f32x16 mfma32(bf16x8 a, bf16x8 b, f32x16 c) {
  return __builtin_amdgcn_mfma_f32_32x32x16_bf16(a, b, c, 0, 0, 0);
}
__device__ __forceinline__ f32x16 zero16() {
  f32x16 z;
#pragma unroll
  for (int i = 0; i < 16; ++i) z[i] = 0.f;
  return z;
}
__device__ __forceinline__ int swz128(int row, int ch) { return row * 128 + ((ch ^ ((row >> 1) & 7)) << 4); }
__device__ __forceinline__ int swz256(int row, int ch) { return row * 256 + ((ch ^ (row & 15)) << 4); }

struct c2 { float x, y; };
__device__ __forceinline__ c2 cadd(c2 a, c2 b) { return {a.x + b.x, a.y + b.y}; }
__device__ __forceinline__ c2 csub(c2 a, c2 b) { return {a.x - b.x, a.y - b.y}; }
__device__ __forceinline__ c2 cmul(c2 a, c2 b) { return {a.x * b.x - a.y * b.y, a.x * b.y + a.y * b.x}; }
__device__ __forceinline__ float c16(int i) {
  const float tb[16] = {1.0f, 0.9238795325112867f, 0.7071067811865476f, 0.3826834323650898f, 0.0f,
                        -0.3826834323650898f, -0.7071067811865476f, -0.9238795325112867f, -1.0f,
                        -0.9238795325112867f, -0.7071067811865476f, -0.3826834323650898f, 0.0f,
                        0.3826834323650898f, 0.7071067811865476f, 0.9238795325112867f};
  return tb[i & 15];
}
__device__ __forceinline__ float s16(int i) { return c16(i + 12); }
template <int R> __device__ __forceinline__ constexpr int brev(int k) {
  int r = 0;
  for (int b = 1, o = R >> 1; b < R; b <<= 1, o >>= 1)
    if (k & b) r |= o;
  return r;
}
template <int R> __device__ __forceinline__ void dft_reg(c2* v, float sgn) {
#pragma unroll
  for (int h = R / 2; h >= 1; h >>= 1) {
#pragma unroll
    for (int g = 0; g < R; g += 2 * h) {
#pragma unroll
      for (int j = 0; j < h; ++j) {
        c2 a = v[g + j], b = v[g + j + h];
        v[g + j] = cadd(a, b);
        c2 d = csub(a, b);
        const int ti = j * (16 / (2 * h));
        c2 w = {c16(ti), sgn * s16(ti)};
        v[g + j + h] = (j == 0) ? d : cmul(d, w);
      }
    }
  }
}
template <int R> __device__ __forceinline__ int fft_bfly(c2* v, int j, int Ns, float sgn) {
  const int k = j & (Ns - 1);
  const float f = sgn * (float)k / (float)(Ns * R);
#pragma unroll
  for (int r = 1; r < R; ++r) {
    float t = f * (float)r;
    c2 w = {__builtin_amdgcn_cosf(t), __builtin_amdgcn_sinf(t)};
    v[r] = cmul(v[r], w);
  }
  dft_reg<R>(v, sgn);
  return (j - k) * R + k;
}
template <int R> __device__ __forceinline__ void fft_pass(c2* buf, int Ns, float sgn) {
  constexpr int NBF = 8192 / R;
  constexpr int PER = NBF / NTHR;
  const int tid = opaque_tid();
  c2 v[PER][R];
#pragma unroll
  for (int i = 0; i < PER; ++i) {
    const int j = tid + NTHR * i;
#pragma unroll
    for (int r = 0; r < R; ++r) v[i][r] = buf[j + r * NBF];
  }
  __syncthreads();
#pragma unroll
  for (int i = 0; i < PER; ++i) {
    const int j = tid + NTHR * i;
    const int base = fft_bfly<R>(v[i], j, Ns, sgn);
#pragma unroll
    for (int r = 0; r < R; ++r) buf[base + r * Ns] = v[i][brev<R>(r)];
  }
  __syncthreads();
}
__device__ __forceinline__ void fft8192(c2* buf, float sgn) {
  fft_pass<8>(buf, 1, sgn);
  fft_pass<8>(buf, 8, sgn);
  fft_pass<8>(buf, 64, sgn);
  fft_pass<16>(buf, 512, sgn);
}

__device__ __forceinline__ void gemm_kloop(f32x16 (&acc)[2][2], const u16* __restrict__ A, int lda,
                                           const u16* __restrict__ B, int ldb, int K, char* smem) {
  const int tid = opaque_tid(), lane = tid & 63, wid = tid >> 6;
  const int wm = wid >> 1, wn = wid & 1;
  const int l31 = lane & 31, hh = lane >> 5;
  uint4 ra[4], rb[2];
  const int nk = K >> 6;
  const int srow = tid >> 3, sch = tid & 7;
  const char* Ab = (const char*)A;
  const char* Bb = (const char*)B;
  const unsigned aoff = (unsigned)(srow * lda + sch * 8) * 2u;
  const unsigned boff = (unsigned)(srow * ldb + sch * 8) * 2u;
  const unsigned astep = (unsigned)lda * 128u, bstep = (unsigned)ldb * 128u;
#pragma unroll
  for (int i = 0; i < 4; ++i) ra[i] = *(const uint4*)(Ab + (aoff + i * astep));
#pragma unroll
  for (int i = 0; i < 2; ++i) rb[i] = *(const uint4*)(Bb + (boff + i * bstep));
#pragma unroll
  for (int i = 0; i < 4; ++i) *(uint4*)(smem + swz128(srow + i * 64, sch)) = ra[i];
#pragma unroll
  for (int i = 0; i < 2; ++i) *(uint4*)(smem + 65536 + swz128(srow + i * 64, sch)) = rb[i];
  __syncthreads();
  for (int kt = 0; kt < nk; ++kt) {
    const bool more = (kt + 1 < nk);
    if (more) {
      const unsigned ko = (unsigned)(kt + 1) * 128u;
#pragma unroll
      for (int i = 0; i < 4; ++i) ra[i] = *(const uint4*)(Ab + (aoff + i * astep + ko));
#pragma unroll
      for (int i = 0; i < 2; ++i) rb[i] = *(const uint4*)(Bb + (boff + i * bstep + ko));
    }
    const char* as = smem + (kt & 1) * 32768;
    const char* bs = smem + 65536 + (kt & 1) * 16384;
    int lrow = l31;
    asm volatile("" : "+v"(lrow));
#pragma unroll
    for (int s = 0; s < 4; ++s) {
      bf16x8 af[2], bfr[2];
#pragma unroll
      for (int i = 0; i < 2; ++i) af[i] = *(const bf16x8*)(as + swz128(wm * 64 + i * 32 + lrow, s * 2 + hh));
#pragma unroll
      for (int j = 0; j < 2; ++j) bfr[j] = *(const bf16x8*)(bs + swz128(wn * 64 + j * 32 + lrow, s * 2 + hh));
#pragma unroll
      for (int i = 0; i < 2; ++i)
#pragma unroll
        for (int j = 0; j < 2; ++j) acc[i][j] = mfma32(af[i], bfr[j], acc[i][j]);
    }
    if (more) {
      char* an = smem + ((kt + 1) & 1) * 32768;
      char* bn = smem + 65536 + ((kt + 1) & 1) * 16384;
      int sr2 = srow;
      asm volatile("" : "+v"(sr2));
#pragma unroll
      for (int i = 0; i < 4; ++i) *(uint4*)(an + swz128(sr2 + i * 64, sch)) = ra[i];
#pragma unroll
      for (int i = 0; i < 2; ++i) *(uint4*)(bn + swz128(sr2 + i * 64, sch)) = rb[i];
    }
    __syncthreads();
  }
}
__device__ __forceinline__ void zero_acc(f32x16 (&acc)[2][2]) {
#pragma unroll
  for (int i = 0; i < 2; ++i)
#pragma unroll
    for (int j = 0; j < 2; ++j) acc[i][j] = zero16();
}
#define EPI_ROW(i, e) (wm * 64 + (i)*32 + ((e)&3) + 8 * ((e) >> 2) + 4 * hh)
#define EPI_COL(j) (wn * 64 + (j)*32 + l31)
#define EPI_VARS                                                    \
  const int tid = opaque_tid(), lane = tid & 63, wid = tid >> 6;     \
  const int wm = wid >> 1, wn = wid & 1, l31 = lane & 31, hh = lane >> 5; \
  (void)tid; (void)wm; (void)wn; (void)l31; (void)hh;


namespace pg8 {
__device__ __forceinline__ unsigned pkh(float a, float b) { unsigned r; asm("v_cvt_pk_bf16_f32 %0, %1, %2" : "=v"(r) : "v"(a), "v"(b)); return r; }
#define PG8_LAS __attribute__((address_space(3)))
typedef PG8_LAS unsigned char* PG8_LAS_T;
typedef float f32x4 __attribute__((ext_vector_type(4)));
typedef unsigned u32x4 __attribute__((ext_vector_type(4)));
typedef int i32x4 __attribute__((ext_vector_type(4)));
constexpr int BM = 256, BK = 64, HALF = 128, HTB = HALF * BK * 2, STAGE_BYTES = 8 * HTB, NXCD = 8, WGM = 8;
__device__ __forceinline__ int lds_byte(int r, int c) { const int st = (r >> 4) * 2 + (c >> 5), rr = r & 15, cc = c & 31, ob = rr * 64 + cc * 2; return st * 1024 + (ob ^ (((ob >> 9) & 1) << 5)); }
__device__ __forceinline__ void stage_rc(int b, int& R, int& C) { const int st = b / 1024, sb = b % 1024, swz = sb ^ (((sb >> 9) & 1) << 5); R = (st >> 1) * 16 + swz / 64; C = (st & 1) * 32 + (swz % 64) / 2; }
__device__ __forceinline__ int perm32(int rho) { const int n = rho >> 4, i = rho & 15; return 8 * (i >> 2) + 4 * n + (i & 3); }
struct Unit { int pm, pn; };
struct Gemm { const u16* A; const u16* Bt; int lda, ldb, K; };
struct Order {
  int nM, nN, nwg, G, c, skip_from, skip_by;
  __device__ __forceinline__ void init(int nM_, int nN_, int G_, int c_, int sf = 1 << 30, int sb = 0) { nM = nM_; nN = nN_; nwg = nM * nN; G = G_; c = c_; skip_from = sf; skip_by = sb; }
  __device__ __forceinline__ bool next(int i, Unit& u) const {
    const long L = (long)i * G + c; if (L >= nwg) return false;
    int wgid = (int)L; { const int q = nwg / NXCD, r = nwg % NXCD, xcd = wgid % NXCD, off = wgid / NXCD; wgid = (xcd < r ? xcd * (q + 1) : r * (q + 1) + (xcd - r) * q) + off; }
    const int nig = WGM * nN, gid = wgid / nig, fm = gid * WGM, gsz = (nM - fm) < WGM ? (nM - fm) : WGM;
    u.pm = fm + ((wgid % nig) % gsz); u.pn = (wgid % nig) / gsz;
    if (u.pn >= skip_from) u.pn += skip_by;
    return true;
  }
};
__device__ __forceinline__ f32x4 mma16(bf16x8 a, bf16x8 b, f32x4 c) { return __builtin_amdgcn_mfma_f32_16x16x32_bf16(a, b, c, 0, 0, 0); }
__device__ __forceinline__ i32x4 mma16(bf16x8 a, bf16x8 b, i32x4 c) { return __builtin_amdgcn_mfma_i32_16x16x64_i8(__builtin_bit_cast(i32x4, a), __builtin_bit_cast(i32x4, b), c, 0, 0, 0); }
template <class Epi>
__device__ __forceinline__ void gemm_phase(PG8_LAS unsigned char* lds, const Gemm g, const Order& S, const Epi& E) {
  const int tid = opaque_tid(), wid = __builtin_amdgcn_readfirstlane(tid >> 6), lane = tid & 63, wr = wid >> 2, wc = wid & 3, fr = lane & 15, fq = lane >> 4;
  const int K = g.K, nt = K / BK;
  unsigned voffA[2], voffB[2];
#pragma unroll
  for (int i = 0; i < 2; ++i) { int R, C; stage_rc(tid * 16 + i * 8192, R, C); const int Rb = Epi::PERM ? ((R & ~31) + perm32(R & 31)) : R;
    voffA[i] = (unsigned)(R * g.lda + C) * 2u; voffB[i] = (unsigned)(Rb * g.ldb + C) * 2u; }
  const size_t kstep = (size_t)(BK * 2);
  const size_t hstepA = (size_t)HALF * g.lda * 2, hstepB = (size_t)HALF * g.ldb * 2;
  const size_t tstepA = 2 * hstepA, tstepB = 2 * hstepB;
  const unsigned ldsw = (unsigned)wid * 1024u;
  const int aoff = lds_byte(wr * 64 + fr, fq * 8), boff = lds_byte(wc * 32 + fr, fq * 8);
#define PG8_SA(b, h) (((b) * 2 + (h)) * HTB)
#define PG8_SB(b, h) ((4 + (b) * 2 + (h)) * HTB)
#define PG8_STAGE(bufoff, gbase, voff) do { _Pragma("unroll") for (int _i = 0; _i < 2; ++_i) \
    __builtin_amdgcn_global_load_lds((const unsigned*)((const char*)(gbase) + (voff)[_i]), (PG8_LAS unsigned*)(lds + (bufoff) + ldsw + _i * 8192), 16, 0, 0); } while (0)
#define PG8_LDA(dst, b, h) do { _Pragma("unroll") for (int m = 0; m < 4; ++m) _Pragma("unroll") for (int k = 0; k < 2; ++k) dst[m][k] = *(const PG8_LAS bf16x8*)(lds + PG8_SA(b, h) + aoff + m * 2048 + k * 1024); } while (0)
#define PG8_LDB(dst, b, h) do { _Pragma("unroll") for (int n = 0; n < 2; ++n) _Pragma("unroll") for (int k = 0; k < 2; ++k) dst[n][k] = *(const PG8_LAS bf16x8*)(lds + PG8_SB(b, h) + boff + n * 2048 + k * 1024); } while (0)
#define PG8_MMA(ai, bj, At, Bt) do { __builtin_amdgcn_s_setprio(1); _Pragma("unroll") for (int m = 0; m < 4; ++m) _Pragma("unroll") for (int n = 0; n < 2; ++n) _Pragma("unroll") for (int k = 0; k < 2; ++k) \
    acc[ai][bj][m][n] = mma16(Bt[n][k], At[m][k], acc[ai][bj][m][n]); __builtin_amdgcn_s_setprio(0); } while (0)
#define PG8_WAIT_V(n) asm volatile("s_waitcnt vmcnt(" #n ")" ::: "memory")
#define PG8_WAIT_L(n) asm volatile("s_waitcnt lgkmcnt(" #n ")" ::: "memory")
#define PG8_BAR __builtin_amdgcn_s_barrier()
#define PG8_SCHED __builtin_amdgcn_sched_barrier(0)
  Unit cur, nxt; int ui = 0;
  if (!S.next(0, cur)) return;
  typedef typename Epi::acc_t acc_t;
  acc_t acc[2][2][4][2];
#pragma unroll
  for (int a = 0; a < 2; ++a)
#pragma unroll
    for (int b = 0; b < 2; ++b)
#pragma unroll
      for (int m = 0; m < 4; ++m)
#pragma unroll
        for (int n = 0; n < 2; ++n) acc[a][b][m][n] = (acc_t){0, 0, 0, 0};
  bf16x8 At[4][2], B0[2][2], B1[2][2];
  const char* cA = (const char*)g.A + (size_t)cur.pm * tstepA; const char* cB = (const char*)g.Bt + (size_t)cur.pn * tstepB;
  PG8_STAGE(PG8_SB(0, 0), cB, voffB); PG8_STAGE(PG8_SA(0, 0), cA, voffA); PG8_STAGE(PG8_SB(0, 1), cB + hstepB, voffB); PG8_STAGE(PG8_SA(0, 1), cA + hstepA, voffA);
  if (wr == 1) PG8_BAR;
  PG8_WAIT_V(4); PG8_BAR;
  PG8_STAGE(PG8_SB(1, 0), cB + kstep, voffB); PG8_STAGE(PG8_SA(1, 0), cA + kstep, voffA); PG8_STAGE(PG8_SB(1, 1), cB + hstepB + kstep, voffB);
  PG8_WAIT_V(6); PG8_BAR;
  for (;;) {
    const bool has_next = S.next(ui + 1, nxt);
    const char* nA = has_next ? (const char*)g.A + (size_t)nxt.pm * tstepA : cA; const char* nB = has_next ? (const char*)g.Bt + (size_t)nxt.pn * tstepB : cB;
    for (int t = 0; t < nt; t += 2) {
      const bool last = (t == nt - 2);
      const char* a1 = cA + (size_t)(t + 1) * kstep;
      const char* a2 = last ? nA : cA + (size_t)(t + 2) * kstep; const char* b2 = last ? nB : cB + (size_t)(t + 2) * kstep;
      const char* a3 = a2 + kstep; const char* b3 = b2 + kstep;
      PG8_LDB(B0, 0, 0); PG8_SCHED; PG8_LDA(At, 0, 0); PG8_STAGE(PG8_SA(1, 1), a1 + hstepA, voffA);
      PG8_WAIT_L(8); PG8_BAR; PG8_WAIT_L(0); PG8_MMA(0, 0, At, B0); PG8_BAR; PG8_SCHED;
      PG8_LDB(B1, 0, 1); PG8_STAGE(PG8_SB(0, 0), b2, voffB);
      PG8_BAR; PG8_WAIT_L(0); PG8_MMA(0, 1, At, B1); PG8_BAR;
      PG8_LDA(At, 0, 1); PG8_STAGE(PG8_SA(0, 0), a2, voffA);
      PG8_BAR; PG8_WAIT_L(0); PG8_MMA(1, 0, At, B0); PG8_BAR; PG8_SCHED;
      PG8_STAGE(PG8_SB(0, 1), b2 + hstepB, voffB);
      PG8_WAIT_V(6); PG8_BAR; PG8_MMA(1, 1, At, B1); PG8_BAR;
      PG8_LDB(B0, 1, 0); PG8_SCHED; PG8_LDA(At, 1, 0); PG8_STAGE(PG8_SA(0, 1), a2 + hstepA, voffA);
      PG8_WAIT_L(8); PG8_BAR; PG8_WAIT_L(0); PG8_MMA(0, 0, At, B0); PG8_BAR; PG8_SCHED;
      PG8_LDB(B1, 1, 1); PG8_STAGE(PG8_SB(1, 0), b3, voffB);
      PG8_BAR; PG8_WAIT_L(0); PG8_MMA(0, 1, At, B1); PG8_BAR;
      PG8_LDA(At, 1, 1); PG8_STAGE(PG8_SA(1, 0), a3, voffA);
      PG8_BAR; PG8_WAIT_L(0); PG8_MMA(1, 0, At, B0); PG8_BAR; PG8_SCHED;
      PG8_STAGE(PG8_SB(1, 1), b3 + hstepB, voffB);
      PG8_WAIT_V(6); PG8_BAR; PG8_MMA(1, 1, At, B1); PG8_BAR;
    }
    E(acc, cur, wr, wc, fr, fq);
    if (!has_next) break;
#pragma unroll
    for (int a = 0; a < 2; ++a)
#pragma unroll
      for (int b = 0; b < 2; ++b)
#pragma unroll
        for (int m = 0; m < 4; ++m)
#pragma unroll
          for (int n = 0; n < 2; ++n) acc[a][b][m][n] = (acc_t){0, 0, 0, 0};
    cur = nxt; cA = nA; cB = nB; ++ui;
  }
  PG8_WAIT_V(0);
  if (wr == 0) PG8_BAR;
  PG8_BAR;
#undef PG8_SA
#undef PG8_SB
#undef PG8_STAGE
#undef PG8_LDA
#undef PG8_LDB
#undef PG8_MMA
#undef PG8_WAIT_V
#undef PG8_WAIT_L
#undef PG8_BAR
#undef PG8_SCHED
}
typedef const f32x4 (&AccRef)[2][2][4][2];
typedef const i32x4 (&AccRefI)[2][2][4][2];
struct EpiInprojN {
  static constexpr bool PERM = true;
  typedef f32x4 acc_t;
  u16* qk; u16* rg;
  __device__ __forceinline__ void operator()(AccRef acc, const Unit& u, int wr, int wc, int fr, int fq) const {
    const int row0 = u.pm * BM + wr * 64 + fr;
    u16* base; int ld, colt;
    if (u.pn < 4) { base = qk; ld = 1024; colt = u.pn * 256; } else { base = rg; ld = 512; colt = (u.pn - 9) * 256; }
    const int col0 = colt + wc * 32 + 8 * fq;
#pragma unroll
    for (int ai = 0; ai < 2; ++ai)
#pragma unroll
      for (int m = 0; m < 4; ++m) {
        u16* rowp = base + (size_t)(row0 + ai * HALF + m * 16) * ld + col0;
#pragma unroll
        for (int bj = 0; bj < 2; ++bj) {
          const f32x4 v0 = acc[ai][bj][m][0], v1 = acc[ai][bj][m][1];
          u32x4 w; w.x = pkh(v0[0], v0[1]); w.y = pkh(v0[2], v0[3]); w.z = pkh(v1[0], v1[1]); w.w = pkh(v1[2], v1[3]);
          *(u32x4*)(rowp + bj * HALF) = w;
        }
      }
  }
};
struct EpiInprojT {
  static constexpr bool PERM = true;
  typedef f32x4 acc_t;
  u16 *vT, *vTc, *hyT, *hyTc;
  __device__ __forceinline__ void operator()(AccRef acc, const Unit& u, int wr, int wc, int fr, int fq) const {
    const bool isctx = (u.pn >= 128);
    const int b = isctx ? (u.pn - 128) : (u.pn >> 4);
    const int Lseg = isctx ? 256 : 4096, t0 = isctx ? 0 : (u.pn & 15) * 256;
    const bool isv = (u.pm < 2);
    const size_t boff = isv ? (isctx ? (size_t)16777216 : (size_t)0) : (isctx ? (size_t)(16777216 + 1048576 + 25165824) : (size_t)(16777216 + 1048576));
    u16* base = vT + boff;
    const int nc = isv ? 512 : 768;
    const int wrow0 = (isv ? u.pm : u.pm - 2) * BM + wr * 64 + fr;
    const int col0 = t0 + wc * 32 + 8 * fq;
#pragma unroll
    for (int ai = 0; ai < 2; ++ai)
#pragma unroll
      for (int m = 0; m < 4; ++m) {
        u16* rowp = base + ((size_t)(b * nc + wrow0 + ai * HALF + m * 16)) * Lseg + col0;
#pragma unroll
        for (int bj = 0; bj < 2; ++bj) {
          const f32x4 v0 = acc[ai][bj][m][0], v1 = acc[ai][bj][m][1];
          u32x4 w; w.x = pkh(v0[0], v0[1]); w.y = pkh(v0[2], v0[3]); w.z = pkh(v1[0], v1[1]); w.w = pkh(v1[2], v1[3]);
          *(u32x4*)(rowp + bj * HALF) = w;
        }
      }
  }
};
struct EpiGate {
  static constexpr bool PERM = true;
  typedef f32x4 acc_t;
  unsigned char* g8; const float* bias;
  __device__ __forceinline__ void operator()(AccRef acc, const Unit& u, int wr, int wc, int fr, int fq) const {
    const int row0 = u.pm * BM + wr * 64 + fr;
    const int col0 = u.pn * BM + wc * 32 + 8 * fq;
#pragma unroll
    for (int bj = 0; bj < 2; ++bj) {
      const f32x4 b0 = *(const f32x4*)(bias + col0 + bj * HALF), b1 = *(const f32x4*)(bias + col0 + bj * HALF + 4);
#pragma unroll
      for (int ai = 0; ai < 2; ++ai)
#pragma unroll
        for (int m = 0; m < 4; ++m) {
          const f32x4 v0 = acc[ai][bj][m][0] + b0, v1 = acc[ai][bj][m][1] + b1;
          unsigned w0 = 0, w1 = 0;
#pragma unroll
          for (int k = 0; k < 4; ++k) {
            w0 |= (unsigned)(sigmoidf_(v0[k]) * 255.0f + 0.5f) << (8 * k);
            w1 |= (unsigned)(sigmoidf_(v1[k]) * 255.0f + 0.5f) << (8 * k);
          }
          *(uint2*)(g8 + (size_t)(row0 + ai * HALF + m * 16) * 3072 + col0 + bj * HALF) = make_uint2(w0, w1);
        }
    }
  }
};
struct EpiBranch {
  static constexpr bool PERM = true;
  typedef f32x4 acc_t;
  u16* mbuf; const unsigned char* g8; int br;
  __device__ __forceinline__ void operator()(AccRef acc, const Unit& u, int wr, int wc, int fr, int fq) const {
    const int row0 = u.pm * BM + wr * 64 + fr;
    const int col0 = u.pn * BM + wc * 32 + 8 * fq;
    uint2 gq[2][2][2];
    u32x4 o[2][2][2];
#define EB_LOAD(G) do { _Pragma("unroll") for (int j = 0; j < 2; ++j) _Pragma("unroll") for (int bj = 0; bj < 2; ++bj) { \
      const size_t row = (size_t)(row0 + (((G) * 2 + j) >> 2) * HALF + (((G) * 2 + j) & 3) * 16); \
      gq[(G) & 1][j][bj] = *(const uint2*)(g8 + row * 3072 + br * 1024 + col0 + bj * HALF); \
      if (br != 0) o[(G) & 1][j][bj] = *(const u32x4*)(mbuf + row * 1024 + col0 + bj * HALF); } } while (0)
    EB_LOAD(0);
#pragma unroll
    for (int G = 0; G < 4; ++G) {
      if (G < 3) EB_LOAD(G + 1);
#pragma unroll
      for (int j = 0; j < 2; ++j) {
        const int ai = (G * 2 + j) >> 2, m = (G * 2 + j) & 3;
        const size_t row = (size_t)(row0 + ai * HALF + m * 16);
#pragma unroll
        for (int bj = 0; bj < 2; ++bj) {
          const uint2 g = gq[G & 1][j][bj];
          u16* mp = mbuf + row * 1024 + col0 + bj * HALF;
          const f32x4 v0 = acc[ai][bj][m][0], v1 = acc[ai][bj][m][1];
          float r[8];
          r[0] = (float)(g.x & 255u) * v0[0]; r[1] = (float)((g.x >> 8) & 255u) * v0[1];
          r[2] = (float)((g.x >> 16) & 255u) * v0[2]; r[3] = (float)(g.x >> 24) * v0[3];
          r[4] = (float)(g.y & 255u) * v1[0]; r[5] = (float)((g.y >> 8) & 255u) * v1[1];
          r[6] = (float)((g.y >> 16) & 255u) * v1[2]; r[7] = (float)(g.y >> 24) * v1[3];
          u32x4 w;
          if (br == 0) {
            w.x = pkh(r[0] * (1.f / 255.f), r[1] * (1.f / 255.f)); w.y = pkh(r[2] * (1.f / 255.f), r[3] * (1.f / 255.f));
            w.z = pkh(r[4] * (1.f / 255.f), r[5] * (1.f / 255.f)); w.w = pkh(r[6] * (1.f / 255.f), r[7] * (1.f / 255.f));
          } else {
            const u32x4 ov = o[G & 1][j][bj];
            w.x = pkh(bflo(ov.x) + r[0] * (1.f / 255.f), bfhi(ov.x) + r[1] * (1.f / 255.f));
            w.y = pkh(bflo(ov.y) + r[2] * (1.f / 255.f), bfhi(ov.y) + r[3] * (1.f / 255.f));
            w.z = pkh(bflo(ov.z) + r[4] * (1.f / 255.f), bfhi(ov.z) + r[5] * (1.f / 255.f));
            w.w = pkh(bflo(ov.w) + r[6] * (1.f / 255.f), bfhi(ov.w) + r[7] * (1.f / 255.f));
          }
          *(u32x4*)mp = w;
        }
      }
    }
#undef EB_LOAD
  }
};
struct EpiOut {
  static constexpr bool PERM = false;
  typedef f32x4 acc_t;
  const float *xsrc, *csrc; float *xdst, *cdst; const float* modl;
  __device__ __forceinline__ void operator()(AccRef acc, const Unit& u, int wr, int wc, int fr, int fq) const {
    const bool isctx = (u.pm >= 128);
    const int bi = isctx ? 8 : (u.pm >> 4);
    const float* gatev = modl + ((size_t)bi * 6 + 2) * 1024;
    const float* src = isctx ? (csrc - (size_t)NLAT * 1024) : xsrc;
    float* dst = isctx ? (cdst - (size_t)NLAT * 1024) : xdst;
    const int row0 = u.pm * BM + wr * 64 + fr, col0 = u.pn * BM + wc * 32 + 4 * fq;
    f32x4 gv[4], xv[2][4];
#pragma unroll
    for (int g = 0; g < 4; ++g) gv[g] = *(const f32x4*)(gatev + col0 + (g >> 1) * HALF + (g & 1) * 16);
#define EO_LOAD(G) do { _Pragma("unroll") for (int m = 0; m < 4; ++m) \
      xv[(G) & 1][m] = *(const f32x4*)(src + (size_t)(row0 + ((G) & 1) * HALF + m * 16) * 1024 + col0 + ((G) >> 2) * HALF + (((G) >> 1) & 1) * 16); } while (0)
    EO_LOAD(0);
#pragma unroll
    for (int G = 0; G < 8; ++G) {
      const int bj = G >> 2, n = (G >> 1) & 1, ai = G & 1;
      if (G < 7) EO_LOAD(G + 1);
#pragma unroll
      for (int m = 0; m < 4; ++m) {
        const size_t o = (size_t)(row0 + ai * HALF + m * 16) * 1024 + col0 + bj * HALF + n * 16;
        *(f32x4*)(dst + o) = xv[G & 1][m] + gv[bj * 2 + n] * acc[ai][bj][m][n];
      }
    }
#undef EO_LOAD
  }
};
struct EpiQ {
  static constexpr bool PERM = true;
  typedef f32x4 acc_t;
  u16* q;
  __device__ __forceinline__ void operator()(AccRef acc, const Unit& u, int wr, int wc, int fr, int fq) const {
    const int row0 = u.pm * BM + wr * 64 + fr;
    const int col0 = u.pn * BM + wc * 32 + 8 * fq;
#pragma unroll
    for (int ai = 0; ai < 2; ++ai)
#pragma unroll
      for (int m = 0; m < 4; ++m) {
        u16* rowp = q + (size_t)(row0 + ai * HALF + m * 16) * 2048 + col0;
#pragma unroll
        for (int bj = 0; bj < 2; ++bj) {
          const f32x4 v0 = acc[ai][bj][m][0], v1 = acc[ai][bj][m][1];
          u32x4 w;
          w.x = __builtin_bit_cast(unsigned, __builtin_amdgcn_cvt_pkrtz(v0[0], v0[1]));
          w.y = __builtin_bit_cast(unsigned, __builtin_amdgcn_cvt_pkrtz(v0[2], v0[3]));
          w.z = __builtin_bit_cast(unsigned, __builtin_amdgcn_cvt_pkrtz(v1[0], v1[1]));
          w.w = __builtin_bit_cast(unsigned, __builtin_amdgcn_cvt_pkrtz(v1[2], v1[3]));
          *(u32x4*)(rowp + bj * HALF) = w;
        }
      }
  }
};
struct EpiInprojN8 {
  static constexpr bool PERM = true;
  typedef i32x4 acc_t;
  u16* qk; u16* rg; const float* sa; const float* sw;
  __device__ __forceinline__ void operator()(AccRefI acc, const Unit& u, int wr, int wc, int fr, int fq) const {
    const int row0 = u.pm * BM + wr * 64 + fr;
    u16* base; int ld, colt;
    if (u.pn < 4) { base = qk; ld = 1024; colt = u.pn * 256; } else { base = rg; ld = 512; colt = (u.pn - 9) * 256; }
    const int col0 = colt + wc * 32 + 8 * fq;
    const int wcol0 = u.pn * 256 + wc * 32 + 8 * fq;
    float rs[8];
    f32x4 cs[2][2];
#pragma unroll
    for (int i = 0; i < 8; ++i) rs[i] = sa[row0 + (i >> 2) * HALF + (i & 3) * 16];
#pragma unroll
    for (int bj = 0; bj < 2; ++bj) { cs[bj][0] = *(const f32x4*)(sw + wcol0 + bj * HALF); cs[bj][1] = *(const f32x4*)(sw + wcol0 + bj * HALF + 4); }
#pragma unroll
    for (int bj = 0; bj < 2; ++bj) {
      const f32x4 c0 = cs[bj][0], c1 = cs[bj][1];
#pragma unroll
      for (int ai = 0; ai < 2; ++ai)
#pragma unroll
        for (int m = 0; m < 4; ++m) {
          const int row = row0 + ai * HALF + m * 16;
          const float r = rs[ai * 4 + m];
          const i32x4 a0 = acc[ai][bj][m][0], a1 = acc[ai][bj][m][1];
          u32x4 w;
          w.x = pkh((float)a0[0] * r * c0[0], (float)a0[1] * r * c0[1]); w.y = pkh((float)a0[2] * r * c0[2], (float)a0[3] * r * c0[3]);
          w.z = pkh((float)a1[0] * r * c1[0], (float)a1[1] * r * c1[1]); w.w = pkh((float)a1[2] * r * c1[2], (float)a1[3] * r * c1[3]);
          *(u32x4*)(base + (size_t)row * ld + col0 + bj * HALF) = w;
        }
    }
  }
};
struct EpiInprojT8 {
  static constexpr bool PERM = true;
  typedef i32x4 acc_t;
  u16* vT; const float* sa; const float* sw;
  __device__ __forceinline__ void operator()(AccRefI acc, const Unit& u, int wr, int wc, int fr, int fq) const {
    const bool isctx = (u.pn >= 128);
    const int b = isctx ? (u.pn - 128) : (u.pn >> 4);
    const int Lseg = isctx ? 256 : 4096, t0 = isctx ? 0 : (u.pn & 15) * 256;
    const bool isv = (u.pm < 2);
    const size_t boff = isv ? (isctx ? (size_t)16777216 : (size_t)0) : (isctx ? (size_t)(16777216 + 1048576 + 25165824) : (size_t)(16777216 + 1048576));
    u16* base = vT + boff;
    const int nc = isv ? 512 : 768;
    const int wrow0 = (isv ? u.pm : u.pm - 2) * BM + wr * 64 + fr;
    const int srow0 = u.pm * BM + wr * 64 + fr;
    const int col0 = t0 + wc * 32 + 8 * fq;
    const int tok0 = u.pn * BM + wc * 32 + 8 * fq;
    float rs[8];
    f32x4 cs[2][2];
#pragma unroll
    for (int i = 0; i < 8; ++i) rs[i] = sw[srow0 + (i >> 2) * HALF + (i & 3) * 16];
#pragma unroll
    for (int bj = 0; bj < 2; ++bj) { cs[bj][0] = *(const f32x4*)(sa + tok0 + bj * HALF); cs[bj][1] = *(const f32x4*)(sa + tok0 + bj * HALF + 4); }
#pragma unroll
    for (int bj = 0; bj < 2; ++bj) {
      const f32x4 c0 = cs[bj][0], c1 = cs[bj][1];
#pragma unroll
      for (int ai = 0; ai < 2; ++ai)
#pragma unroll
        for (int m = 0; m < 4; ++m) {
          const float r = rs[ai * 4 + m];
          const i32x4 a0 = acc[ai][bj][m][0], a1 = acc[ai][bj][m][1];
          u32x4 w;
          w.x = pkh((float)a0[0] * r * c0[0], (float)a0[1] * r * c0[1]); w.y = pkh((float)a0[2] * r * c0[2], (float)a0[3] * r * c0[3]);
          w.z = pkh((float)a1[0] * r * c1[0], (float)a1[1] * r * c1[1]); w.w = pkh((float)a1[2] * r * c1[2], (float)a1[3] * r * c1[3]);
          *(u32x4*)(base + ((size_t)(b * nc + wrow0 + ai * HALF + m * 16)) * Lseg + col0 + bj * HALF) = w;
        }
    }
  }
};
struct EpiGate8 {
  static constexpr bool PERM = true;
  typedef i32x4 acc_t;
  unsigned char* g8; const float* bias; const float* sa; const float* sw;
  __device__ __forceinline__ void operator()(AccRefI acc, const Unit& u, int wr, int wc, int fr, int fq) const {
    const int row0 = u.pm * BM + wr * 64 + fr;
    const int col0 = u.pn * BM + wc * 32 + 8 * fq;
    typedef float f32x2 __attribute__((ext_vector_type(2)));
    float rs[8];
    f32x4 bs[2][2], cs[2][2];
#pragma unroll
    for (int i = 0; i < 8; ++i) rs[i] = sa[row0 + (i >> 2) * HALF + (i & 3) * 16];
#pragma unroll
    for (int bj = 0; bj < 2; ++bj) {
      bs[bj][0] = *(const f32x4*)(bias + col0 + bj * HALF); bs[bj][1] = *(const f32x4*)(bias + col0 + bj * HALF + 4);
      cs[bj][0] = *(const f32x4*)(sw + col0 + bj * HALF); cs[bj][1] = *(const f32x4*)(sw + col0 + bj * HALF + 4);
    }
#pragma unroll
    for (int bj = 0; bj < 2; ++bj) {
      f32x2 cn[4], bn[4];
#pragma unroll
      for (int k = 0; k < 2; ++k) {
        cn[k] = (f32x2){cs[bj][0][2 * k], cs[bj][0][2 * k + 1]} * -1.4426950408889634f; cn[2 + k] = (f32x2){cs[bj][1][2 * k], cs[bj][1][2 * k + 1]} * -1.4426950408889634f;
        bn[k] = (f32x2){bs[bj][0][2 * k], bs[bj][0][2 * k + 1]} * -1.4426950408889634f; bn[2 + k] = (f32x2){bs[bj][1][2 * k], bs[bj][1][2 * k + 1]} * -1.4426950408889634f;
      }
#pragma unroll
      for (int ai = 0; ai < 2; ++ai)
#pragma unroll
        for (int m = 0; m < 4; ++m) {
          const int row = row0 + ai * HALF + m * 16;
          const float r = rs[ai * 4 + m];
          const i32x4 a0 = acc[ai][bj][m][0], a1 = acc[ai][bj][m][1];
          unsigned qb[8];
#pragma unroll
          for (int k = 0; k < 4; ++k) {
            const f32x2 av = (k < 2) ? (f32x2){(float)a0[2 * k], (float)a0[2 * k + 1]} : (f32x2){(float)a1[2 * k - 4], (float)a1[2 * k - 3]};
            const f32x2 z = __builtin_elementwise_fma(av * r, cn[k], bn[k]);
            const f32x2 d = (f32x2){__builtin_amdgcn_exp2f(z.x), __builtin_amdgcn_exp2f(z.y)} + 1.0f;
            const f32x2 sg = {__builtin_amdgcn_rcpf(d.x), __builtin_amdgcn_rcpf(d.y)};
            const f32x2 q = __builtin_elementwise_fma(sg, (f32x2){255.0f, 255.0f}, (f32x2){8388608.0f, 8388608.0f});
            const float qx = q.x, qy = q.y;
            qb[2 * k] = __float_as_uint(qx); qb[2 * k + 1] = __float_as_uint(qy);
          }
          unsigned p0, p1, p2, p3;
          asm("v_perm_b32 %0, %1, %2, %3" : "=v"(p0) : "v"(qb[1]), "v"(qb[0]), "s"(0x0c0c0400u));
          asm("v_perm_b32 %0, %1, %2, %3" : "=v"(p1) : "v"(qb[3]), "v"(qb[2]), "s"(0x04000c0cu));
          asm("v_perm_b32 %0, %1, %2, %3" : "=v"(p2) : "v"(qb[5]), "v"(qb[4]), "s"(0x0c0c0400u));
          asm("v_perm_b32 %0, %1, %2, %3" : "=v"(p3) : "v"(qb[7]), "v"(qb[6]), "s"(0x04000c0cu));
          const unsigned w0 = p0 | p1, w1 = p2 | p3;
          *(uint2*)(g8 + (size_t)row * 3072 + col0 + bj * HALF) = make_uint2(w0, w1);
        }
    }
  }
};
}

__device__ __forceinline__ void tr_tile(const float* __restrict__ src, int N, int K, u16* __restrict__ dst, int tile, char* smem) {
  float* lds = (float*)smem;
  const int tiles_n = N >> 6;
  const int tk = tile / tiles_n, tn = tile - tk * tiles_n;
  const int tid = opaque_tid();
  {
    const int r = tid >> 3, c8 = (tid & 7) * 8;
    const float* s = src + (size_t)(tk * 64 + r) * N + tn * 64 + c8;
    float4 a = *(const float4*)s, b = *(const float4*)(s + 4);
    float* d = lds + r * 65 + c8;
    d[0] = a.x; d[1] = a.y; d[2] = a.z; d[3] = a.w; d[4] = b.x; d[5] = b.y; d[6] = b.z; d[7] = b.w;
  }
  __syncthreads();
  {
    const int n = tid >> 3, k0 = (tid & 7) * 8;
    uint4 o;
    o.x = pk2(lds[(k0 + 0) * 65 + n], lds[(k0 + 1) * 65 + n]);
    o.y = pk2(lds[(k0 + 2) * 65 + n], lds[(k0 + 3) * 65 + n]);
    o.z = pk2(lds[(k0 + 4) * 65 + n], lds[(k0 + 5) * 65 + n]);
    o.w = pk2(lds[(k0 + 6) * 65 + n], lds[(k0 + 7) * 65 + n]);
    *(uint4*)(dst + (size_t)(tn * 64 + n) * K + tk * 64 + k0) = o;
  }
  __syncthreads();
}
__device__ __forceinline__ void colmax_task(const float* __restrict__ w, int N, int n0, float* __restrict__ swp, char* smem) {
  const int tid = opaque_tid();
  const int col = tid & 63, kg = tid >> 6;
  float m = 0.f;
  const float* wp = w + (size_t)(kg * 128) * N + n0 + col;
#pragma unroll 16
  for (int k = 0; k < 128; ++k) m = fmaxf(m, fabsf(wp[(size_t)k * N]));
  float* red = (float*)smem;
  red[kg * 64 + col] = m;
  __syncthreads();
  if (tid < 64) {
    float mm = red[tid];
#pragma unroll
    for (int g = 1; g < 8; ++g) mm = fmaxf(mm, red[g * 64 + tid]);
    swp[n0 + tid] = fmaxf(mm, 1e-20f) * (1.0f / 127.0f);
  }
  __syncthreads();
}
__device__ __forceinline__ void tr_tile_i8(const float* __restrict__ src, int N, int K, unsigned char* __restrict__ dst, int tile, const float* __restrict__ swp, char* smem) {
  float* lds = (float*)smem;
  const int tiles_n = N >> 6;
  const int tk = tile / tiles_n, tn = tile - tk * tiles_n;
  const int tid = opaque_tid();
  {
    const int r = tid >> 3, c8 = (tid & 7) * 8;
    const float* sp = src + (size_t)(tk * 64 + r) * N + tn * 64 + c8;
    float4 a = *(const float4*)sp, b = *(const float4*)(sp + 4);
    float* d = lds + r * 65 + c8;
    d[0] = a.x; d[1] = a.y; d[2] = a.z; d[3] = a.w; d[4] = b.x; d[5] = b.y; d[6] = b.z; d[7] = b.w;
  }
  __syncthreads();
  {
    const int n = tid >> 3, k0 = (tid & 7) * 8;
    const float inv = 1.0f / swp[tn * 64 + n];
    unsigned w0 = 0, w1 = 0;
#pragma unroll
    for (int i = 0; i < 4; ++i) {
      w0 |= ((unsigned)__float2int_rn(lds[(k0 + i) * 65 + n] * inv) & 255u) << (8 * i);
      w1 |= ((unsigned)__float2int_rn(lds[(k0 + 4 + i) * 65 + n] * inv) & 255u) << (8 * i);
    }
    *(uint2*)(dst + (size_t)(tn * 64 + n) * K + tk * 64 + k0) = make_uint2(w0, w1);
  }
  __syncthreads();
}
__device__ __forceinline__ void cvt_chunk(const float* __restrict__ src, u16* __restrict__ dst, size_t chunk) {
  const size_t i = chunk * 4096 + (size_t)opaque_tid() * 8;
  float4 a = *(const float4*)(src + i), b = *(const float4*)(src + i + 4);
  uint4 o;
  o.x = pk2(a.x, a.y); o.y = pk2(a.z, a.w); o.z = pk2(b.x, b.y); o.w = pk2(b.z, b.w);
  *(uint4*)(dst + i) = o;
}
template <bool I8>
__device__ __forceinline__ void tr_tile4(const float* __restrict__ src, int N, int K, void* __restrict__ dstv, int tile4, const float* __restrict__ swp, char* smem) {
  float* lds = (float*)smem;
  const int tiles_n = N >> 6;
  const int tkq = tile4 / tiles_n, tn = tile4 - tkq * tiles_n;
  const int tid = opaque_tid();
  {
    const int r = tid >> 3, c8 = (tid & 7) * 8;
    const float* sp = src + (size_t)(tkq * 256 + r) * N + tn * 64 + c8;
    float4 a[4], b[4];
#pragma unroll
    for (int q = 0; q < 4; ++q) { a[q] = *(const float4*)(sp + (size_t)q * 64 * N); b[q] = *(const float4*)(sp + (size_t)q * 64 * N + 4); }
#pragma unroll
    for (int q = 0; q < 4; ++q) {
      float* d = lds + q * 4160 + r * 65 + c8;
      d[0] = a[q].x; d[1] = a[q].y; d[2] = a[q].z; d[3] = a[q].w; d[4] = b[q].x; d[5] = b[q].y; d[6] = b[q].z; d[7] = b[q].w;
    }
  }
  __syncthreads();
  {
    const int n = tid >> 3, k0 = (tid & 7) * 8;
    if (I8) {
      const float inv = 1.0f / swp[tn * 64 + n];
      unsigned char* dst = (unsigned char*)dstv;
#pragma unroll
      for (int q = 0; q < 4; ++q) {
        const float* lq = lds + q * 4160;
        unsigned w0 = 0, w1 = 0;
#pragma unroll
        for (int i = 0; i < 4; ++i) {
          w0 |= ((unsigned)__float2int_rn(lq[(k0 + i) * 65 + n] * inv) & 255u) << (8 * i);
          w1 |= ((unsigned)__float2int_rn(lq[(k0 + 4 + i) * 65 + n] * inv) & 255u) << (8 * i);
        }
        *(uint2*)(dst + (size_t)(tn * 64 + n) * K + tkq * 256 + q * 64 + k0) = make_uint2(w0, w1);
      }
    } else {
      u16* dst = (u16*)dstv;
#pragma unroll
      for (int q = 0; q < 4; ++q) {
        const float* lq = lds + q * 4160;
        uint4 o;
        o.x = pk2(lq[(k0 + 0) * 65 + n], lq[(k0 + 1) * 65 + n]);
        o.y = pk2(lq[(k0 + 2) * 65 + n], lq[(k0 + 3) * 65 + n]);
        o.z = pk2(lq[(k0 + 4) * 65 + n], lq[(k0 + 5) * 65 + n]);
        o.w = pk2(lq[(k0 + 6) * 65 + n], lq[(k0 + 7) * 65 + n]);
        *(uint4*)(dst + (size_t)(tn * 64 + n) * K + tkq * 256 + q * 64 + k0) = o;
      }
    }
  }
  __syncthreads();
}
__device__ __forceinline__ void colmax4_task(const float* __restrict__ w, int N, int n0, float* __restrict__ swp, char* smem) {
  const int tid = opaque_tid();
  const int c4 = (tid & 15) * 4, rg = tid >> 4;
  const float* wp = w + (size_t)(rg * 32) * N + n0 + c4;
  float4 m = {0.f, 0.f, 0.f, 0.f};
#pragma unroll 16
  for (int k = 0; k < 32; ++k) {
    const float4 v = *(const float4*)(wp + (size_t)k * N);
    m.x = fmaxf(m.x, fabsf(v.x)); m.y = fmaxf(m.y, fabsf(v.y)); m.z = fmaxf(m.z, fabsf(v.z)); m.w = fmaxf(m.w, fabsf(v.w));
  }
  float* red = (float*)smem;
  *(float4*)(red + rg * 64 + c4) = m;
  __syncthreads();
  if (tid < 64) {
    float mm = red[tid];
#pragma unroll
    for (int g = 1; g < 32; ++g) mm = fmaxf(mm, red[g * 64 + tid]);
    swp[n0 + tid] = fmaxf(mm, 1e-20f) * (1.0f / 127.0f);
  }
  __syncthreads();
}
__device__ __forceinline__ void cvt_chunk4(const float* __restrict__ src, u16* __restrict__ dst, size_t chunk4) {
  const size_t i = chunk4 * 16384 + (size_t)opaque_tid() * 8;
  float4 a[4], b[4];
#pragma unroll
  for (int q = 0; q < 4; ++q) { a[q] = *(const float4*)(src + i + q * 4096); b[q] = *(const float4*)(src + i + q * 4096 + 4); }
#pragma unroll
  for (int q = 0; q < 4; ++q) {
    uint4 o;
    o.x = pk2(a[q].x, a[q].y); o.y = pk2(a[q].z, a[q].w); o.z = pk2(b[q].x, b[q].y); o.w = pk2(b[q].z, b[q].w);
    *(uint4*)(dst + i + q * 4096) = o;
  }
}
__device__ __forceinline__ void cvt_chunk_fp8(const float* __restrict__ src, unsigned char* __restrict__ dst, size_t chunk, float scale) {
  const size_t i = chunk * 4096 + (size_t)opaque_tid() * 8;
  const float4 a = *(const float4*)(src + i), b = *(const float4*)(src + i + 4);
  int w0 = __builtin_amdgcn_cvt_pk_fp8_f32(a.x * scale, a.y * scale, 0, false);
  w0 = __builtin_amdgcn_cvt_pk_fp8_f32(a.z * scale, a.w * scale, w0, true);
  int w1 = __builtin_amdgcn_cvt_pk_fp8_f32(b.x * scale, b.y * scale, 0, false);
  w1 = __builtin_amdgcn_cvt_pk_fp8_f32(b.z * scale, b.w * scale, w1, true);
  *(uint2*)(dst + i) = make_uint2((unsigned)w0, (unsigned)w1);
}
__device__ __forceinline__ void cvt_chunk_fp4(const float* __restrict__ src, unsigned char* __restrict__ dst, size_t chunk, float scale, int vhalf) {
  const size_t i = chunk * 4096 + (size_t)opaque_tid() * 8;
  const float4 a = *(const float4*)(src + i), b = *(const float4*)(src + i + 4);
  unsigned w = 0;
  w = __builtin_amdgcn_cvt_scalef32_pk_fp4_f32(w, a.x * scale, a.y * scale, 1.0f, 0);
  w = __builtin_amdgcn_cvt_scalef32_pk_fp4_f32(w, a.z * scale, a.w * scale, 1.0f, 1);
  w = __builtin_amdgcn_cvt_scalef32_pk_fp4_f32(w, b.x * scale, b.y * scale, 1.0f, 2);
  w = __builtin_amdgcn_cvt_scalef32_pk_fp4_f32(w, b.z * scale, b.w * scale, 1.0f, 3);
  const size_t e = i >> 10;
  const unsigned d = (unsigned)(i & 1023);
  *(unsigned*)(dst + e * 1024 + vhalf * 512 + (d >> 1)) = w;
}
__device__ __forceinline__ void cvt_chunk_fp4x8(const float* __restrict__ src, unsigned char* __restrict__ dst, int t0, int step, int tmax, float scale, int vhalf) {
  const int tid8 = opaque_tid() * 8;
  float4 a[8], b[8];
#pragma unroll
  for (int q = 0; q < 8; ++q) {
    const int t = t0 + q * step;
    const size_t i = (size_t)(t < tmax ? t : t0) * 4096 + tid8;
    a[q] = *(const float4*)(src + i); b[q] = *(const float4*)(src + i + 4);
  }
#pragma unroll
  for (int q = 0; q < 8; ++q) {
    const int t = t0 + q * step;
    if (t < tmax) {
      const size_t i = (size_t)t * 4096 + tid8;
      unsigned w = 0;
      w = __builtin_amdgcn_cvt_scalef32_pk_fp4_f32(w, a[q].x * scale, a[q].y * scale, 1.0f, 0);
      w = __builtin_amdgcn_cvt_scalef32_pk_fp4_f32(w, a[q].z * scale, a[q].w * scale, 1.0f, 1);
      w = __builtin_amdgcn_cvt_scalef32_pk_fp4_f32(w, b[q].x * scale, b[q].y * scale, 1.0f, 2);
      w = __builtin_amdgcn_cvt_scalef32_pk_fp4_f32(w, b[q].z * scale, b[q].w * scale, 1.0f, 3);
      const size_t e = i >> 10;
      const unsigned d = (unsigned)(i & 1023);
      *(unsigned*)(dst + e * 1024 + vhalf * 512 + (d >> 1)) = w;
    }
  }
}
__device__ __forceinline__ void phase_modreduce(const P& p) {
  const int n = 2 * 9 * 6144;
  for (int i = blockIdx.x * NTHR + opaque_tid(); i < n; i += gridDim.x * NTHR) {
    const int l = i / (9 * 6144);
    const int j = i % 6144;
    float s = p.b_ada[l * 6144 + j];
#pragma unroll
    for (int kc = 0; kc < 16; ++kc) s += p.modpart[(size_t)kc * n + i];
    p.mod[i] = s;
  }
}

__device__ __forceinline__ void phase_norm(const P& p, int l, int which) {
  const int tid_ = opaque_tid(); const int lane = tid_ & 63, wid = tid_ >> 6;
  const int ntok = (which == 2 || (which == 1 && l == 1)) ? NLAT : NTOK;
  float4 vn[4];
  {
    const int row = blockIdx.x * 8 + wid;
    if (row < ntok) {
      const float* src = (row < NLAT) ? ((which == 0 && l == 0) ? p.x : p.out) + (size_t)row * 1024 : ((which == 0 && l == 0) ? p.ctx : p.ctxs) + (size_t)(row - NLAT) * 1024;
#pragma unroll
      for (int i = 0; i < 4; ++i) vn[i] = *(const float4*)(src + i * 256 + lane * 4);
    }
  }
  for (int row = blockIdx.x * 8 + wid; row < ntok; row += gridDim.x * 8) {
    float4 v[4];
    float ss = 0.f;
#pragma unroll
    for (int i = 0; i < 4; ++i) {
      v[i] = vn[i];
      ss += v[i].x * v[i].x + v[i].y * v[i].y + v[i].z * v[i].z + v[i].w * v[i].w;
    }
    {
      const int nrow = row + gridDim.x * 8;
      if (nrow < ntok) {
        const float* src = (nrow < NLAT) ? ((which == 0 && l == 0) ? p.x : p.out) + (size_t)nrow * 1024 : ((which == 0 && l == 0) ? p.ctx : p.ctxs) + (size_t)(nrow - NLAT) * 1024;
#pragma unroll
        for (int i = 0; i < 4; ++i) vn[i] = *(const float4*)(src + i * 256 + lane * 4);
      }
    }
    ss = wave_sum(ss);
    const float rstd = rsqrtf(ss * (1.0f / 1024.0f) + 1e-6f);
    if (which == 2) {
#pragma unroll
      for (int i = 0; i < 4; ++i) {
        const int col = i * 256 + lane * 4;
        const float4 g = *(const float4*)(p.final_g + col);
        float4 o = {v[i].x * rstd * g.x, v[i].y * rstd * g.y, v[i].z * rstd * g.z, v[i].w * rstd * g.w};
        *(float4*)(p.out + (size_t)row * 1024 + col) = o;
      }
    } else {
      const int bi = row < NLAT ? (row >> 12) : 8;
      const float* gam = (which == 0 ? p.norm_mix_g : p.norm_ffn_g) + l * 1024;
      const float* msh = p.mod + ((size_t)(l * 9 + bi) * 6 + (which == 0 ? 0 : 3)) * 1024;
      const float* msc = msh + 1024;
      float4 y[4];
      float amax = 0.f;
#pragma unroll
      for (int i = 0; i < 4; ++i) {
        const int col = i * 256 + lane * 4;
        const float4 g = *(const float4*)(gam + col);
        const float4 sh = *(const float4*)(msh + col);
        const float4 sc = *(const float4*)(msc + col);
        y[i].x = v[i].x * rstd * g.x * (1.f + sc.x) + sh.x; y[i].y = v[i].y * rstd * g.y * (1.f + sc.y) + sh.y;
        y[i].z = v[i].z * rstd * g.z * (1.f + sc.z) + sh.z; y[i].w = v[i].w * rstd * g.w * (1.f + sc.w) + sh.w;
        amax = fmaxf(amax, fmaxf(fmaxf(fabsf(y[i].x), fabsf(y[i].y)), fmaxf(fabsf(y[i].z), fabsf(y[i].w))));
      }
      if (which == 0) {
        amax = fmaxf(wave_max(amax), 1e-20f);
        const float inv = 127.0f / amax;
#pragma unroll
        for (int i = 0; i < 4; ++i) {
          const unsigned w = ((unsigned)__float2int_rn(y[i].x * inv) & 255u) | (((unsigned)__float2int_rn(y[i].y * inv) & 255u) << 8) |
                             (((unsigned)__float2int_rn(y[i].z * inv) & 255u) << 16) | (((unsigned)__float2int_rn(y[i].w * inv) & 255u) << 24);
          *(unsigned*)(p.xn8 + (size_t)row * 1024 + i * 256 + lane * 4) = w;
        }
        if (lane == 0) p.sa[row] = amax * (1.0f / 127.0f);
      } else {
#pragma unroll
        for (int i = 0; i < 4; ++i) {
          uint2 o;
          o.x = pk2(y[i].x, y[i].y);
          o.y = pk2(y[i].z, y[i].w);
          *(uint2*)(p.xn + (size_t)row * 1024 + i * 256 + lane * 4) = o;
        }
      }
    }
  }
}

__device__ __forceinline__ void filter_wave(const P& p, int l, int L, int t, float* __restrict__ outp) {
  const int lane = opaque_tid() & 63;
  const float tl = (float)t / (float)(L - 1);
  const float wang = (6.283185307179586f / (float)L) * (float)t;
  float z = 0.f;
  if (lane == 0) z = tl;
  else if (lane <= 16) { const float band = 1e-4f + (float)(lane - 1) * ((15.0f - 1e-4f) / 15.0f); z = cosf(band * wang); }
  else if (lane <= 32) { const float band = 1e-4f + (float)(lane - 17) * ((15.0f - 1e-4f) / 15.0f); z = -sinf(band * wang); }
  float a1 = p.hy_f1_b[l * 64 + lane];
  for (int i = 0; i < 33; ++i) a1 += shf(z, i) * p.hy_f1_w[(l * 33 + i) * 64 + lane];
  const float h1 = sinf(p.hy_freq[l * 128 + lane] * a1);
  float a2 = p.hy_f2_b[l * 64 + lane];
  for (int i = 0; i < 64; ++i) a2 += shf(h1, i) * p.hy_f2_w[(l * 64 + i) * 64 + lane];
  const float h2 = sinf(p.hy_freq[l * 128 + 64 + lane] * a2);
  float a3[8];
#pragma unroll
  for (int m = 0; m < 8; ++m) a3[m] = 0.f;
  for (int i = 0; i < 64; ++i) {
    const float hv = shf(h2, i);
    const float* wr = p.hy_f3_w + (size_t)(l * 64 + i) * 512 + lane;
#pragma unroll
    for (int m = 0; m < 8; ++m) a3[m] += hv * wr[m * 64];
  }
  const float LN100 = 4.605170185988092f;
  const float d0 = LN100 / 1.5f, d1 = LN100 / 0.3f;
#pragma unroll
  for (int m = 0; m < 8; ++m) {
    const int cp = lane + 64 * m;
    const int ch = cp & 255;
    const float delta = d0 + (float)ch * ((d1 - d0) / 255.0f);
    outp[(size_t)cp * L + t] = a3[m] * expf(-tl * delta);
  }
}
__device__ __forceinline__ void filter_block_task(const P& p, int l, int L, int t0, float* __restrict__ outp, char* smem) {
  const int tid = opaque_tid(), lane = tid & 63, wid = tid >> 6;
  float* W3s = (float*)smem;
  float* W2s = (float*)(smem + 131072);
  {
    const float4* s3 = (const float4*)(p.hy_f3_w + (size_t)l * 64 * 512);
    const float4* s2 = (const float4*)(p.hy_f2_w + (size_t)l * 64 * 64);
#pragma unroll
    for (int i = 0; i < 16; ++i) ((float4*)W3s)[tid + NTHR * i] = s3[tid + NTHR * i];
#pragma unroll
    for (int i = 0; i < 2; ++i) ((float4*)W2s)[tid + NTHR * i] = s2[tid + NTHR * i];
  }
  __syncthreads();
  float z[4], tl[4];
#pragma unroll
  for (int j = 0; j < 4; ++j) {
    const int t = t0 + wid * 4 + j;
    tl[j] = (float)t / (float)(L - 1);
    const float wang = (6.283185307179586f / (float)L) * (float)t;
    float zz = 0.f;
    if (lane == 0) zz = tl[j];
    else if (lane <= 16) { const float band = 1e-4f + (float)(lane - 1) * ((15.0f - 1e-4f) / 15.0f); zz = cosf(band * wang); }
    else if (lane <= 32) { const float band = 1e-4f + (float)(lane - 17) * ((15.0f - 1e-4f) / 15.0f); zz = -sinf(band * wang); }
    z[j] = zz;
  }
  float a1[4], a2[4];
  {
    const float b1 = p.hy_f1_b[l * 64 + lane];
#pragma unroll
    for (int j = 0; j < 4; ++j) a1[j] = b1;
#pragma unroll 11
    for (int i = 0; i < 33; ++i) {
      const float w = p.hy_f1_w[(l * 33 + i) * 64 + lane];
#pragma unroll
      for (int j = 0; j < 4; ++j) a1[j] += shf(z[j], i) * w;
    }
    const float f0 = p.hy_freq[l * 128 + lane];
#pragma unroll
    for (int j = 0; j < 4; ++j) a1[j] = sinf(f0 * a1[j]);
  }
  {
    const float b2 = p.hy_f2_b[l * 64 + lane];
#pragma unroll
    for (int j = 0; j < 4; ++j) a2[j] = b2;
#pragma unroll 8
    for (int i = 0; i < 64; ++i) {
      const float w = W2s[i * 64 + lane];
#pragma unroll
      for (int j = 0; j < 4; ++j) a2[j] += shf(a1[j], i) * w;
    }
    const float f1 = p.hy_freq[l * 128 + 64 + lane];
#pragma unroll
    for (int j = 0; j < 4; ++j) a2[j] = sinf(f1 * a2[j]);
  }
  float a3[4][8];
#pragma unroll
  for (int j = 0; j < 4; ++j)
#pragma unroll
    for (int m = 0; m < 8; ++m) a3[j][m] = 0.f;
#pragma unroll 4
  for (int i = 0; i < 64; ++i) {
    float w[8];
#pragma unroll
    for (int m = 0; m < 8; ++m) w[m] = W3s[i * 512 + lane + 64 * m];
#pragma unroll
    for (int j = 0; j < 4; ++j) {
      const float hv = shf(a2[j], i);
#pragma unroll
      for (int m = 0; m < 8; ++m) a3[j][m] += hv * w[m];
    }
  }
  const float LN100 = 4.605170185988092f;
  const float d0 = LN100 / 1.5f, d1 = LN100 / 0.3f;
#pragma unroll
  for (int m = 0; m < 8; ++m) {
    const int cp = lane + 64 * m;
    const float delta = d0 + (float)(cp & 255) * ((d1 - d0) / 255.0f);
    float4 o;
    o.x = a3[0][m] * expf(-tl[0] * delta); o.y = a3[1][m] * expf(-tl[1] * delta);
    o.z = a3[2][m] * expf(-tl[2] * delta); o.w = a3[3][m] * expf(-tl[3] * delta);
    *(float4*)(outp + (size_t)cp * L + t0 + wid * 4) = o;
  }
  __syncthreads();
}
__device__ __forceinline__ void phase_filters(const P& p, int l, char* smem) {
  const int ntask = 128 + (l == 0 ? 8 : 0);
  for (int t = blockIdx.x; t < ntask; t += gridDim.x) {
    if (t < 128) filter_block_task(p, l, 4096, t * 32, p.hT + (size_t)l * 512 * 4096, smem);
    else filter_block_task(p, l, 256, (t - 128) * 32, p.hc, smem);
  }
}
__device__ __forceinline__ void adaln_task(const P& p, int t, char* smem) {
  const int tid = opaque_tid();
  const int kc = t & 15; t >>= 4;
  const int jc = t % 12, l = t / 12;
  float* s = (float*)smem;
  float* red = (float*)(smem + 4096);
  for (int i = tid; i < 576; i += NTHR) {
    const int bi = i >> 6, kk = i & 63;
    const float v = (bi < 8) ? p.c[bi * 1024 + kc * 64 + kk] : p.c_ctx[kc * 64 + kk];
    s[i] = v / (1.0f + __expf(-v));
  }
  const int kq = tid >> 7, c4 = (tid & 127) * 4;
  const float* wp = p.w_ada + ((size_t)l * 1024 + kc * 64 + kq * 16) * 6144 + jc * 512 + c4;
  float4 w[16];
#pragma unroll
  for (int kk = 0; kk < 16; ++kk) w[kk] = *(const float4*)(wp + (size_t)kk * 6144);
  __syncthreads();
  float4 acc[9];
#pragma unroll
  for (int bi = 0; bi < 9; ++bi) acc[bi] = make_float4(0.f, 0.f, 0.f, 0.f);
#pragma unroll
  for (int kk = 0; kk < 16; ++kk) {
#pragma unroll
    for (int bi = 0; bi < 9; ++bi) {
      const float sv = s[bi * 64 + kq * 16 + kk];
      acc[bi].x += sv * w[kk].x; acc[bi].y += sv * w[kk].y; acc[bi].z += sv * w[kk].z; acc[bi].w += sv * w[kk].w;
    }
  }
#pragma unroll
  for (int bi = 0; bi < 9; ++bi) *(float4*)(red + (kq * 9 + bi) * 512 + c4) = acc[bi];
  __syncthreads();
#pragma unroll
  for (int bi = 0; bi < 9; ++bi) {
    const float v = red[bi * 512 + tid] + red[(9 + bi) * 512 + tid] + red[(18 + bi) * 512 + tid] + red[(27 + bi) * 512 + tid];
    p.modpart[((size_t)(kc * 2 + l) * 9 + bi) * 6144 + jc * 512 + tid] = v;
  }
  __syncthreads();
}
__device__ __forceinline__ void phase_prep(const P& p, char* smem, unsigned* counter) {
  volatile int* s_taskp = (volatile int*)(smem + SMEM_BYTES - 16);
  const int total = 264 + 184 + 384 + 544 + 32;
  int nxt = 0;
  if (threadIdx.x == 0) nxt = (int)atomicAdd(counter, 1u);
  for (;;) {
    __syncthreads();
    if (threadIdx.x == 0) *s_taskp = nxt;
    __syncthreads();
    int t = *s_taskp;
    if (t >= total) break;
    if (threadIdx.x == 0) nxt = (int)atomicAdd(counter, 1u);
    if (t < 264) {
      if (t < 128) filter_block_task(p, 0, 4096, t * 32, p.hT, smem);
      else if (t < 256) filter_block_task(p, 1, 4096, (t - 128) * 32, p.hT + (size_t)512 * 4096, smem);
      else filter_block_task(p, 0, 256, (t - 256) * 32, p.hc, smem);
      continue;
    }
    t -= 264;
    if (t < 184) {
      const int l = t / 92; t -= l * 92;
      if (t < 44) colmax4_task(p.w_in + (size_t)l * 1024 * 2816, 2816, t * 64, p.sw + l * 5888, smem);
      else colmax4_task(p.w_gate + (size_t)l * 1024 * 3072, 3072, (t - 44) * 64, p.sw + l * 5888 + 2816, smem);
      continue;
    }
    t -= 184;
    if (t < 384) { adaln_task(p, t, smem); continue; }
    t -= 384;
    if (t < 544) {
      const int l = t / 272; t -= l * 272;
      if (t < 32) tr_tile4<false>(p.w_br_a + (size_t)l * 512 * 1024, 1024, 512, p.WaT + (size_t)l * 1024 * 512, t, nullptr, smem);
      else if ((t -= 32) < 16) tr_tile4<false>(p.w_br_b + (size_t)l * 256 * 1024, 1024, 256, p.WbT + (size_t)l * 1024 * 256, t, nullptr, smem);
      else if ((t -= 16) < 16) tr_tile4<false>(p.w_br_c + (size_t)l * 256 * 1024, 1024, 256, p.WcT + (size_t)l * 1024 * 256, t, nullptr, smem);
      else if ((t -= 16) < 64) tr_tile4<false>(p.w_out + (size_t)l * 1024 * 1024, 1024, 1024, p.WoT + (size_t)l * 1024 * 1024, t, nullptr, smem);
      else if ((t -= 64) < 128) cvt_chunk4(p.peer_wq + (size_t)l * 1024 * 2048, p.WqB + (size_t)l * 1024 * 2048, (size_t)t);
      else {
        t -= 128;
        const int gate = t >> 3, dn = t & 7;
        const float* src = (gate ? p.rg_wx : p.rg_wa) + (size_t)(l * 8 + dn) * 4096;
        tr_tile(src, 64, 64, p.rgW + (size_t)((l * 2 + gate) * 8 + dn) * 4096, 0, smem);
      }
      continue;
    }
    t -= 544;
    cvt_chunk4(p.peer_keys, p.keysB, (size_t)t);
  }
}
__device__ __forceinline__ void kf_task(const P& p, int l, int c, char* smem) {
  const float* hTl = p.hT + (size_t)l * 512 * 4096;
  c2* buf = (c2*)smem;
  const int tid = opaque_tid();
  for (int i = 0; i < 16; ++i) {
    const int j = tid + NTHR * i;
    float v;
    if (j < 4096) v = hTl[(size_t)c * 4096 + j];
    else if (j == 4096) v = 0.f;
    else v = hTl[(size_t)(256 + c) * 4096 + (8192 - j)];
    buf[j] = {v, 0.f};
  }
  __syncthreads();
  fft8192(buf, -1.f);
  c2* o = (c2*)p.Kf + ((size_t)l * 256 + c) * 8192;
  for (int i = 0; i < 16; ++i) { const int j = tid + NTHR * i; o[j] = buf[j]; }
  __syncthreads();
}

__device__ __forceinline__ void inproj_tile(const P& p, int l, int mt, int nt, char* smem) {
  f32x16 acc[2][2];
  zero_acc(acc);
  const int m0 = mt * 256, n0 = nt * 128;
  gemm_kloop(acc, p.xn + (size_t)m0 * 1024, 1024, p.WinT + ((size_t)l * 2816 + n0) * 1024, 1024, 1024, smem);
  EPI_VARS
  if (nt < 8 || nt >= 18) {
    u16* dst; int ld, cbase;
    if (nt < 8) { dst = p.qk; ld = 1024; cbase = n0; }
    else { dst = p.rg; ld = 512; cbase = n0 - 2304; }
#pragma unroll
    for (int i = 0; i < 2; ++i)
#pragma unroll
      for (int j = 0; j < 2; ++j)
#pragma unroll
        for (int e = 0; e < 16; ++e)
          dst[(size_t)(m0 + EPI_ROW(i, e)) * ld + cbase + EPI_COL(j)] = f2bf(acc[i][j][e]);
  } else {
#pragma unroll
    for (int i = 0; i < 2; ++i)
#pragma unroll
      for (int j = 0; j < 2; ++j)
#pragma unroll
        for (int qd = 0; qd < 4; ++qd) {
          uint2 o;
          o.x = pk2(acc[i][j][4 * qd + 0], acc[i][j][4 * qd + 1]);
          o.y = pk2(acc[i][j][4 * qd + 2], acc[i][j][4 * qd + 3]);
          const int row0 = wm * 64 + i * 32 + 8 * qd + 4 * hh;
          *(uint2*)(smem + EPI_COL(j) * 520 + row0 * 2) = o;
        }
    __syncthreads();
    u16* dstT; int Lseg, t0, ncol0, nc;
    const bool isctx = (mt >= 128);
    const int b = isctx ? (mt - 128) : (mt >> 4);
    if (nt < 12) { ncol0 = n0 - 1024; nc = 512; dstT = isctx ? p.vTc : p.vT; }
    else { ncol0 = n0 - 1536; nc = 768; dstT = isctx ? p.hyTc : p.hyT; }
    if (isctx) { Lseg = 256; t0 = 0; } else { Lseg = 4096; t0 = (mt & 15) * 256; }
#pragma unroll 4
    for (int it = 0; it < 16; ++it) {
      const int idx = tid + NTHR * it;
      const int col = idx >> 6, u = idx & 63;
      const uint2 v = *(const uint2*)(smem + col * 520 + u * 8);
      *(uint2*)(dstT + ((size_t)(b * nc + ncol0 + col)) * Lseg + t0 + u * 4) = v;
    }
    __syncthreads();
  }
}

__device__ __forceinline__ float ldbf(const u16* p, int t, int L) { return (t >= 0 && t < L) ? bf2f(p[t]) : 0.f; }
__device__ __forceinline__ void ld10(const u16* __restrict__ seq, int t0, float (&v)[10]) {
  const uint4 r = *(const uint4*)(seq + t0);
  v[0] = (t0 > 0) ? bf2f(seq[t0 - 1]) : 0.f;
  v[9] = (t0 + 8 < 4096) ? bf2f(seq[t0 + 8]) : 0.f;
  v[1] = bflo(r.x); v[2] = bfhi(r.x); v[3] = bflo(r.y); v[4] = bfhi(r.y);
  v[5] = bflo(r.z); v[6] = bfhi(r.z); v[7] = bflo(r.w); v[8] = bfhi(r.w);
}
__device__ __forceinline__ void hyena_fft_task(const P& p, int l, int c, int bp, char* smem) {
  c2* buf = (c2*)smem;
  c2* ub = (c2*)(smem + 65536);
  const int tid = opaque_tid();
  const float* sw = p.hy_short_w + l * 3 * 768;
  const float* sb = p.hy_short_b + l * 768;
  const float wx0[3] = {sw[c], sw[768 + c], sw[1536 + c]};
  const float wx1[3] = {sw[256 + c], sw[768 + 256 + c], sw[1536 + 256 + c]};
  const float wv[3] = {sw[512 + c], sw[768 + 512 + c], sw[1536 + 512 + c]};
  const float bx0 = sb[c], bx1 = sb[256 + c], bv = sb[512 + c];
  const float dsk = p.hy_bias[l * 256 + c];
  const int t0 = tid * 8;
  {
    float u[2][8];
#pragma unroll
    for (int bb = 0; bb < 2; ++bb) {
      const int b = 2 * bp + bb;
      float x1[10], vv[10];
      ld10(p.hyT + ((size_t)(b * 768 + 256 + c)) * 4096, t0, x1);
      ld10(p.hyT + ((size_t)(b * 768 + 512 + c)) * 4096, t0, vv);
#pragma unroll
      for (int k = 0; k < 8; ++k) {
        const float x1c = bx1 + wx1[0] * x1[k] + wx1[1] * x1[k + 1] + wx1[2] * x1[k + 2];
        const float vc = bv + wv[0] * vv[k] + wv[1] * vv[k + 1] + wv[2] * vv[k + 2];
        u[bb][k] = vc * x1c;
      }
    }
#pragma unroll
    for (int k = 0; k < 8; k += 2) {
      const float4 w = make_float4(u[0][k], u[1][k], u[0][k + 1], u[1][k + 1]);
      *(float4*)(buf + t0 + k) = w;
      *(float4*)(ub + t0 + k) = w;
      *(float4*)(buf + 4096 + t0 + k) = make_float4(0.f, 0.f, 0.f, 0.f);
    }
  }
  __syncthreads();
  fft8192(buf, -1.f);
  const c2* kf = (const c2*)p.Kf + ((size_t)l * 256 + c) * 8192;
  for (int i = 0; i < 16; ++i) {
    const int k = tid + NTHR * i;
    buf[k] = cmul(buf[k], kf[k]);
  }
  __syncthreads();
  fft8192(buf, 1.f);
#pragma unroll
  for (int bb = 0; bb < 2; ++bb) {
    const int b = 2 * bp + bb;
    float x0[10];
    ld10(p.hyT + ((size_t)(b * 768 + c)) * 4096, t0, x0);
    float o[8];
#pragma unroll
    for (int k = 0; k < 8; ++k) {
      const c2 y = buf[t0 + k];
      const c2 uu = ub[t0 + k];
      const float x0c = bx0 + wx0[0] * x0[k] + wx0[1] * x0[k + 1] + wx0[2] * x0[k + 2];
      const float yy = ldexpf(bb ? y.y : y.x, -13);
      const float uv = bb ? uu.y : uu.x;
      o[k] = x0c * (yy + uv * dsk);
    }
    uint4 w; w.x = pk2(o[0], o[1]); w.y = pk2(o[2], o[3]); w.z = pk2(o[4], o[5]); w.w = pk2(o[6], o[7]);
    *(uint4*)(p.ybT + ((size_t)(b * 256 + c)) * 4096 + t0) = w;
  }
  __syncthreads();
}
__device__ __forceinline__ void yb_transpose_task(const P& p, int b, int tb, char* smem) {
  const int tid = opaque_tid(), lane = tid & 63, wid = tid >> 6;
  u16* T = (u16*)smem;
#pragma unroll
  for (int it = 0; it < 4; ++it) {
    const int id = tid + NTHR * it;
    const int c = id >> 3, ch = id & 7;
    const uint4 r = *(const uint4*)(p.ybT + ((size_t)(b * 256 + c)) * 4096 + tb * 64 + ch * 8);
    unsigned* d = (unsigned*)(T + c * 66 + ch * 8);
    d[0] = r.x; d[1] = r.y; d[2] = r.z; d[3] = r.w;
  }
  __syncthreads();
#pragma unroll
  for (int it = 0; it < 8; ++it) {
    const int tt = wid + 8 * it;
    const int c0 = lane * 4;
    uint2 w;
    w.x = (unsigned)T[(c0 + 0) * 66 + tt] | ((unsigned)T[(c0 + 1) * 66 + tt] << 16);
    w.y = (unsigned)T[(c0 + 2) * 66 + tt] | ((unsigned)T[(c0 + 3) * 66 + tt] << 16);
    *(uint2*)(p.ycat + (size_t)(b * 4096 + tb * 64 + tt) * 1024 + 512 + c0) = w;
  }
  __syncthreads();
}
__device__ __forceinline__ void hyena_ctx_task(const P& p, int l, int b, int cg8, char* smem) {
  const int tid_ = opaque_tid(); const int lane = tid_ & 63, wid = tid_ >> 6;
  const int c = cg8 * 8 + wid;
  float* us = (float*)smem + wid * 1024;
  float* kfp = us + 256 + 255;
  const float* sw = p.hy_short_w + l * 3 * 768;
  const float* sb = p.hy_short_b + l * 768;
  const u16* x0 = p.hyTc + ((size_t)(b * 768 + c)) * 256;
  const u16* x1 = p.hyTc + ((size_t)(b * 768 + 256 + c)) * 256;
  const u16* vv = p.hyTc + ((size_t)(b * 768 + 512 + c)) * 256;
  for (int i = 0; i < 4; ++i) {
    const int t = lane + 64 * i;
    const float x1c = sb[256 + c] + sw[256 + c] * ldbf(x1, t - 1, 256) + sw[768 + 256 + c] * ldbf(x1, t, 256) + sw[1536 + 256 + c] * ldbf(x1, t + 1, 256);
    const float vc = sb[512 + c] + sw[512 + c] * ldbf(vv, t - 1, 256) + sw[768 + 512 + c] * ldbf(vv, t, 256) + sw[1536 + 512 + c] * ldbf(vv, t + 1, 256);
    us[t] = vc * x1c;
    kfp[t] = p.hc[(size_t)c * 256 + t];
    if (t > 0) kfp[-t] = p.hc[(size_t)(256 + c) * 256 + t];
  }
  __syncthreads();
  const float dsk = p.hy_bias[l * 256 + c];
  float acc[4] = {0.f, 0.f, 0.f, 0.f};
  for (int s = 0; s < 256; ++s) {
    const float uv = us[s];
#pragma unroll
    for (int i = 0; i < 4; ++i) acc[i] += kfp[lane + 64 * i - s] * uv;
  }
#pragma unroll
  for (int i = 0; i < 4; ++i) {
    const int t = lane + 64 * i;
    const float x0c = sb[c] + sw[c] * ldbf(x0, t - 1, 256) + sw[768 + c] * ldbf(x0, t, 256) + sw[1536 + c] * ldbf(x0, t + 1, 256);
    p.ycat[(size_t)(NLAT + b * 256 + t) * 1024 + 512 + c] = f2bf(x0c * (acc[i] + us[t] * dsk));
  }
  __syncthreads();
}

template <int DIR>
__device__ __forceinline__ void rg_scan32(const float (&Av)[2][16], const float (&Bv)[2][16], float (&carry)[2], float (&H)[2][16], int hh) {
#pragma unroll
  for (int nt = 0; nt < 2; ++nt) {
    float c = carry[nt];
#pragma unroll
    for (int go = 0; go < 8; ++go) {
      const int g = DIR ? 7 - go : go, q = g >> 1, own = g & 1;
      float h = c;
#pragma unroll
      for (int io = 0; io < 4; ++io) {
        const int e = 4 * q + (DIR ? 3 - io : io);
        h = Av[nt][e] * h + Bv[nt][e];
        H[nt][e] = (hh == own) ? h : H[nt][e];
      }
      const float mine = (hh == own) ? h : c;
      const float other = shx(mine, 32);
      c = (hh == own) ? mine : other;
    }
    carry[nt] = c;
  }
}
__device__ __forceinline__ void rg_wave_task(const P& p, int l, int bq, int nblk, int mode, bool last, char* smem) {
  const int tid = opaque_tid(), lane = tid & 63, wid = tid >> 6;
  const int l31 = lane & 31, hh = lane >> 5;
  const int b = bq / 34, rr = bq - b * 34;
  const int seg = rr < 2 ? 0 : 1, blk = rr < 2 ? rr : rr - 2;
  if (mode == 1 && seg == 0 && last) return;
  const int ck = wid >> 1, dir = wid & 1;
  char* wreg = smem + wid * 17408;
  u16* xs = (u16*)wreg;
  char* xcb = wreg + 4608;
  float* xcf = (float*)(wreg + 8704);
  float2* blockagg = (float2*)(smem + 139264);
  const int Lseg = seg ? 4096 : 256;
  const int tokbase = seg ? b * 4096 : NLAT + b * 256;
  const int T0 = blk * 128 + ck * 32;
  const int cg32 = (seg ? 8 : 0) + blk * 4 + ck;
  uint4 xt[5];
#pragma unroll
  for (int i = 0; i < 5; ++i) {
    const int idx = lane + 64 * i;
    const int row = idx >> 3, chunk = idx & 7;
    xt[i] = make_uint4(0u, 0u, 0u, 0u);
    if (row < 35) {
      const int pos = T0 - 2 + row;
      if (pos >= 0 && pos < Lseg) xt[i] = *(const uint4*)(p.rg + (size_t)(tokbase + pos) * 512 + nblk * 64 + chunk * 8);
    }
  }
  const float cw0 = p.rg_conv_w[(l * 4 + 0) * 256 + nblk * 64 + lane], cw1 = p.rg_conv_w[(l * 4 + 1) * 256 + nblk * 64 + lane];
  const float cw2 = p.rg_conv_w[(l * 4 + 2) * 256 + nblk * 64 + lane], cw3 = p.rg_conv_w[(l * 4 + 3) * 256 + nblk * 64 + lane];
  const float ccb = p.rg_conv_b[l * 256 + nblk * 64 + lane];
  bf16x8 wf[2][2][4];
#pragma unroll
  for (int gate = 0; gate < 2; ++gate) {
    const u16* wp = p.rgW + (size_t)(((l * 2 + gate) * 2 + dir) * 4 + nblk) * 4096 + l31 * 64 + 8 * hh;
#pragma unroll
    for (int nt = 0; nt < 2; ++nt)
#pragma unroll
      for (int s = 0; s < 4; ++s) wf[gate][nt][s] = *(const bf16x8*)(wp + nt * 2048 + 16 * s);
  }
  float cba[2], cbx[2], csp[2];
#pragma unroll
  for (int nt = 0; nt < 2; ++nt) {
    const int ch = (l * 2 + dir) * 256 + nblk * 64 + nt * 32 + l31;
    cba[nt] = p.rg_ba[ch];
    cbx[nt] = p.rg_bx[ch];
    csp[nt] = p.rg_lambda[ch];
  }
  float2* agg1 = (float2*)p.agg;
  float2* agg2 = (float2*)p.agg + (size_t)8 * 2 * 136 * 256;
  const int pos2 = dir ? (seg == 0 ? 1 - blk : 33 - blk) : (seg == 0 ? blk : 2 + blk);
  float hin = 0.f;
  uint4 gq[2];
  if (mode == 1) {
    const float2* a2 = agg2 + ((size_t)(b * 2 + dir) * 34) * 256 + nblk * 64 + lane;
    const float2* a1 = agg1 + ((size_t)(b * 2 + dir) * 136 + (cg32 - ck)) * 256 + nblk * 64 + lane;
    const int npre = dir ? 3 - ck : ck;
    float2 ga[34], gb[3];
    const int pm1 = pos2 > 0 ? pos2 - 1 : 0;
#pragma unroll
    for (int j = 0; j < 34; ++j) ga[j] = a2[(size_t)(j < pm1 ? j : pm1) * 256];
#pragma unroll
    for (int i = 0; i < 3; ++i) { const int ii = i < npre ? i : 0; gb[i] = a1[(size_t)(dir ? 3 - ii : ii) * 256]; }
    {
      const int tok = 16 * dir + (lane >> 2), c16 = (lane & 3) * 16;
      const u16* gp = p.rg + ((size_t)tokbase + T0 + tok) * 512 + 256 + nblk * 64 + c16;
      gq[0] = *(const uint4*)gp; gq[1] = *(const uint4*)(gp + 8);
    }
#pragma unroll
    for (int j = 0; j < 34; ++j) hin = (j < pos2) ? ga[j].x * hin + ga[j].y : hin;
#pragma unroll
    for (int i = 0; i < 3; ++i) hin = (i < npre) ? gb[i].x * hin + gb[i].y : hin;
  }
#pragma unroll
  for (int nt = 0; nt < 2; ++nt) csp[nt] = __logf(1.0f + __expf(-csp[nt]));
#pragma unroll
  for (int i = 0; i < 5; ++i) {
    const int idx = lane + 64 * i;
    const int row = idx >> 3, chunk = idx & 7;
    if (row < 35) *(uint4*)(xs + row * 64 + chunk * 8) = xt[i];
  }
  asm volatile("s_waitcnt lgkmcnt(0)" ::: "memory");
  {
    float x0 = bf2f(xs[0 * 64 + lane]), x1 = bf2f(xs[1 * 64 + lane]), x2 = bf2f(xs[2 * 64 + lane]);
#pragma unroll
    for (int t = 0; t < 32; ++t) {
      const float x3 = bf2f(xs[(t + 3) * 64 + lane]);
      const float xc = ccb + cw0 * x0 + cw1 * x1 + cw2 * x2 + cw3 * x3;
      xcf[t * 68 + lane] = xc;
      *(u16*)(xcb + swz128(t, lane >> 3) + (lane & 7) * 2) = f2bf(xc);
      x0 = x1; x1 = x2; x2 = x3;
    }
  }
  asm volatile("s_waitcnt lgkmcnt(0)" ::: "memory");
  float Av[2][16], Bv[2][16];
  {
    f32x16 acc[2][2];
#pragma unroll
    for (int gate = 0; gate < 2; ++gate)
#pragma unroll
      for (int nt = 0; nt < 2; ++nt) acc[gate][nt] = zero16();
#pragma unroll
    for (int s = 0; s < 4; ++s) {
      const bf16x8 af = *(const bf16x8*)(xcb + swz128(l31, 2 * s + hh));
#pragma unroll
      for (int gate = 0; gate < 2; ++gate)
#pragma unroll
        for (int nt = 0; nt < 2; ++nt) acc[gate][nt] = mfma32(af, wf[gate][nt][s], acc[gate][nt]);
    }
#pragma unroll
    for (int nt = 0; nt < 2; ++nt)
#pragma unroll
      for (int e = 0; e < 16; ++e) {
        const int tok = (e & 3) + 8 * (e >> 2) + 4 * hh;
        const float r = sigmoidf_(acc[0][nt][e] + cba[nt]);
        const float ii = sigmoidf_(acc[1][nt][e] + cbx[nt]);
        const float la = -8.0f * r * csp[nt];
        const float av = __expf(la);
        const float e2 = 2.0f * la;
        const float om = (e2 > -0.1f) ? (-e2 * (1.0f + e2 * (0.5f + e2 * (0.16666667f + e2 * 0.041666668f)))) : (1.0f - __expf(e2));
        Av[nt][e] = av;
        Bv[nt][e] = sqrtf(om) * ii * xcf[tok * 68 + nt * 32 + l31];
      }
  }
  float H[2][16];
#pragma unroll
  for (int nt = 0; nt < 2; ++nt)
#pragma unroll
    for (int e = 0; e < 16; ++e) H[nt][e] = 0.f;
  float carry[2] = {0.f, 0.f};
  if (mode == 0) {
    if (dir) rg_scan32<1>(Av, Bv, carry, H, hh); else rg_scan32<0>(Av, Bv, carry, H, hh);
    float P[2];
#pragma unroll
    for (int nt = 0; nt < 2; ++nt) {
      float pr = 1.f;
#pragma unroll
      for (int e = 0; e < 16; ++e) pr *= Av[nt][e];
      P[nt] = pr * shx(pr, 32);
    }
    const float2 mine = make_float2(hh ? P[1] : P[0], hh ? carry[1] : carry[0]);
    agg1[((size_t)(b * 2 + dir) * 136 + cg32) * 256 + nblk * 64 + lane] = mine;
    blockagg[(ck * 2 + dir) * 64 + lane] = mine;
    __syncthreads();
    if (wid < 2) {
      const int d2 = wid;
      float A = 1.f, B = 0.f;
#pragma unroll
      for (int co = 0; co < 4; ++co) {
        const int c = d2 ? 3 - co : co;
        const float2 g = blockagg[(c * 2 + d2) * 64 + lane];
        B = g.x * B + g.y;
        A *= g.x;
      }
      const int p2 = d2 ? (seg == 0 ? 1 - blk : 33 - blk) : (seg == 0 ? blk : 2 + blk);
      agg2[((size_t)(b * 2 + d2) * 34 + p2) * 256 + nblk * 64 + lane] = make_float2(A, B);
    }
    __syncthreads();
    return;
  }
  carry[0] = shf(hin, l31);
  carry[1] = shf(hin, 32 + l31);
  if (dir) rg_scan32<1>(Av, Bv, carry, H, hh); else rg_scan32<0>(Av, Bv, carry, H, hh);
  asm volatile("s_waitcnt lgkmcnt(0)" ::: "memory");
#pragma unroll
  for (int nt = 0; nt < 2; ++nt)
#pragma unroll
    for (int e = 0; e < 16; ++e) xcf[((e & 3) + 8 * (e >> 2) + 4 * hh) * 68 + nt * 32 + l31] = H[nt][e];
  __syncthreads();
  {
    const float* hfT = (const float*)(smem + (ck * 2 + 0) * 17408 + 8704);
    const float* hbT = (const float*)(smem + (ck * 2 + 1) * 17408 + 8704);
    const int tok = 16 * dir + (lane >> 2), c16 = (lane & 3) * 16;
    const size_t gtok = (size_t)tokbase + T0 + tok;
    u16* op = p.ycat + gtok * 1024 + 768 + nblk * 64 + c16;
#pragma unroll
    for (int hv = 0; hv < 2; ++hv) {
      const uint4 g = gq[hv];
      const float4 f0 = *(const float4*)(hfT + tok * 68 + c16 + hv * 8), f1 = *(const float4*)(hfT + tok * 68 + c16 + hv * 8 + 4);
      const float4 h0 = *(const float4*)(hbT + tok * 68 + c16 + hv * 8), h1 = *(const float4*)(hbT + tok * 68 + c16 + hv * 8 + 4);
      uint4 o;
      o.x = pk2((f0.x + h0.x) * gelu_tanh(bflo(g.x)), (f0.y + h0.y) * gelu_tanh(bfhi(g.x)));
      o.y = pk2((f0.z + h0.z) * gelu_tanh(bflo(g.y)), (f0.w + h0.w) * gelu_tanh(bfhi(g.y)));
      o.z = pk2((f1.x + h1.x) * gelu_tanh(bflo(g.z)), (f1.y + h1.y) * gelu_tanh(bfhi(g.z)));
      o.w = pk2((f1.z + h1.z) * gelu_tanh(bflo(g.w)), (f1.w + h1.w) * gelu_tanh(bfhi(g.w)));
      *(uint4*)(op + hv * 8) = o;
    }
  }
  __syncthreads();
}

__device__ __forceinline__ void attn_wave(const P& p, int l, int b, int h, bool local, int r, int half, int qtok0, const float* rpbL) {
  const int lane = opaque_tid() & 63, q = lane & 31, hh = lane >> 5;
  bf16x8 qf[4];
  {
    const u16* qp = p.qk + (size_t)(qtok0 + q) * 1024 + h * 64 + 8 * hh;
#pragma unroll
    for (int s = 0; s < 4; ++s) qf[s] = *(const bf16x8*)(qp + 16 * s);
  }
  f32x16 o0 = zero16(), o1 = zero16();
  float m_run = -1e30f, l_run = 0.f;
  const int pi = (q & 19) | ((q & 4) << 1) | ((q & 8) >> 1);
  const int w = half * 32 + q;
  const int st = min(max(w - 8, 0), 48);
  const int rs = min(max(r - 4, 0), 56);
  const int ntiles = local ? 24 : 8;
  bf16x8 kfn[4], vfn[2][2];
  auto tile_load = [&](int ti, bf16x8 (&kfo)[4], bf16x8 (&vfo)[2][2]) {
    int ktok0, vstride;
    const u16* vb;
    if (ti < 8) {
      ktok0 = NLAT + b * 256 + ti * 32;
      vb = p.vTc + ((size_t)(b * 512 + h * 64)) * 256 + ti * 32;
      vstride = 256;
    } else {
      const int tl = ti - 8;
      const int a2 = tl >> 1, g2 = tl & 1;
      ktok0 = b * 4096 + (rs + a2) * 64 + g2 * 32;
      vb = p.vT + ((size_t)(b * 512 + h * 64)) * 4096 + (rs + a2) * 64 + g2 * 32;
      vstride = 4096;
    }
    const u16* kp = p.qk + (size_t)(ktok0 + pi) * 1024 + 512 + h * 64 + 8 * hh;
#pragma unroll
    for (int s = 0; s < 4; ++s) kfo[s] = *(const bf16x8*)(kp + 16 * s);
#pragma unroll
    for (int dt = 0; dt < 2; ++dt)
#pragma unroll
      for (int s2 = 0; s2 < 2; ++s2) vfo[dt][s2] = *(const bf16x8*)(vb + (size_t)(dt * 32 + q) * vstride + 16 * s2 + 8 * hh);
  };
  tile_load(0, kfn, vfn);
  for (int ti = 0; ti < ntiles; ++ti) {
    int a = 0, g = 0;
    if (ti >= 8) { a = (ti - 8) >> 1; g = (ti - 8) & 1; }
    bf16x8 kf[4], vf[2][2];
#pragma unroll
    for (int s = 0; s < 4; ++s) kf[s] = kfn[s];
#pragma unroll
    for (int dt = 0; dt < 2; ++dt)
#pragma unroll
      for (int s2 = 0; s2 < 2; ++s2) vf[dt][s2] = vfn[dt][s2];
    if (ti + 1 < ntiles) tile_load(ti + 1, kfn, vfn);
    f32x16 sacc = zero16();
#pragma unroll
    for (int s = 0; s < 4; ++s) sacc = mfma32(kf[s], qf[s], sacc);
    float sv[16];
    float tmax = -1e30f;
#pragma unroll
    for (int e = 0; e < 16; ++e) {
      float x = sacc[e] * 0.125f;
      if (ti >= 8) {
        const int kc = g * 32 + (e & 7) + 8 * hh + 16 * (e >> 3);
        const bool valid = (kc >= st) && (kc < st + 16);
        const int bi = valid ? ((rs + a - r + 7) * 31 + (kc - w + 15)) : 0;
        const float bias = rpbL[bi];
        x = valid ? (x + bias) : -1e30f;
      }
      sv[e] = x;
      tmax = fmaxf(tmax, x);
    }
    tmax = fmaxf(tmax, shx(tmax, 32));
    const float m_new = fmaxf(m_run, tmax);
    const float alpha = __expf(m_run - m_new);
    m_run = m_new;
    l_run *= alpha;
#pragma unroll
    for (int e = 0; e < 16; ++e) { o0[e] *= alpha; o1[e] *= alpha; }
    float psum = 0.f;
#pragma unroll
    for (int e = 0; e < 16; ++e) { const float pe = __expf(sv[e] - m_new); sv[e] = pe; psum += pe; }
    l_run += psum;
    bf16x8 pf[2];
#pragma unroll
    for (int s2 = 0; s2 < 2; ++s2) {
      union { bf16x8 v; unsigned u[4]; } cv;
#pragma unroll
      for (int j = 0; j < 4; ++j) cv.u[j] = pk2(sv[8 * s2 + 2 * j], sv[8 * s2 + 2 * j + 1]);
      pf[s2] = cv.v;
    }
#pragma unroll
    for (int s2 = 0; s2 < 2; ++s2) {
      o0 = mfma32(vf[0][s2], pf[s2], o0);
      o1 = mfma32(vf[1][s2], pf[s2], o1);
    }
  }
  const float lt = l_run + shx(l_run, 32);
  const float inv = 1.0f / lt;
  u16* op = p.ycat + (size_t)(qtok0 + q) * 1024 + h * 64;
#pragma unroll
  for (int qd = 0; qd < 4; ++qd) {
    uint2 a0, a1;
    a0.x = pk2(o0[4 * qd] * inv, o0[4 * qd + 1] * inv);
    a0.y = pk2(o0[4 * qd + 2] * inv, o0[4 * qd + 3] * inv);
    a1.x = pk2(o1[4 * qd] * inv, o1[4 * qd + 1] * inv);
    a1.y = pk2(o1[4 * qd + 2] * inv, o1[4 * qd + 3] * inv);
    *(uint2*)(op + 8 * qd + 4 * hh) = a0;
    *(uint2*)(op + 32 + 8 * qd + 4 * hh) = a1;
  }
}
__device__ __forceinline__ void attn_block_task(const P& p, int l, int b, int h, int rg4, char* smem) {
  const int tid = opaque_tid(), lane = tid & 63, wid = tid >> 6;
  const int q = lane & 31, hh = lane >> 5;
  const int R0 = rg4 * 4;
  const int r = R0 + (wid >> 1), half = wid & 1;
  float* rpbL = (float*)(smem + 32768) + 64;
  for (int i = tid; i < 465; i += NTHR) rpbL[i] = p.na_rpb[(size_t)(l * 8 + h) * 465 + i] * 1.4426950408889634f;
  const int lo = min(max(R0 - 4, 0), 56);
  const int hi = min(max(R0 + 3 - 4, 0), 56) + 7;
  const int ntile = 4 + (hi - lo + 1);
  const int rs = min(max(r - 4, 0), 56);
  const int qtok = b * 4096 + r * 64 + half * 32 + q;
  bf16x8 qf[4];
  {
    const u16* qp = p.qk + (size_t)qtok * 1024 + h * 64 + 8 * hh;
#pragma unroll
    for (int s = 0; s < 4; ++s) qf[s] = *(const bf16x8*)(qp + 16 * s);
  }
  f32x16 o0 = zero16(), o1 = zero16();
  float m_run = -1e30f, l_run = 0.f;
  const int pi = (q & 19) | ((q & 4) << 1) | ((q & 8) >> 1);
  const int w = half * 32 + q;
  const int st = min(max(w - 8, 0), 48);
  unsigned vmask = 0u;
#pragma unroll
  for (int g = 0; g < 2; ++g)
#pragma unroll
    for (int e = 0; e < 16; ++e) {
      const int kc = g * 32 + (e & 7) + 8 * hh + 16 * (e >> 3);
      vmask |= ((kc >= st) && (kc < st + 16)) ? (1u << (g * 16 + e)) : 0u;
    }
  const int cbase = 8 * hh - w + 15;
  const int srow = tid >> 3, sch = tid & 7;
  uint4 rkA, rvA, rkB, rvB;
  auto gload = [&](int ti, uint4& rk, uint4& rv) {
    int ktok0, vstride;
    const u16* vb;
    if (ti < 4) { ktok0 = NLAT + b * 256 + ti * 64; vb = p.vTc + ((size_t)(b * 512 + h * 64)) * 256 + ti * 64; vstride = 256; }
    else { const int R = lo + ti - 4; ktok0 = b * 4096 + R * 64; vb = p.vT + ((size_t)(b * 512 + h * 64)) * 4096 + R * 64; vstride = 4096; }
    rk = *(const uint4*)(p.qk + (size_t)(ktok0 + srow) * 1024 + 512 + h * 64 + sch * 8);
    rv = *(const uint4*)(vb + (size_t)srow * vstride + sch * 8);
  };
  gload(0, rkA, rvA);
  *(uint4*)(smem + swz128(srow, sch)) = rkA;
  *(uint4*)(smem + 16384 + swz128(srow, sch)) = rvA;
  gload(1, rkA, rvA);
  if (2 < ntile) gload(2, rkB, rvB);
  __syncthreads();
  auto compute = [&](int ti) {
    const char* Kb = smem + (ti & 1) * 8192;
    const char* Vb = smem + 16384 + (ti & 1) * 8192;
    const int R = lo + ti - 4;
    const bool active = (ti < 4) || (R >= rs && R < rs + 8);
    if (active) {
      f32x16 sacc0 = zero16(), sacc1 = zero16();
#pragma unroll
      for (int s = 0; s < 4; ++s) {
        const bf16x8 kf0 = *(const bf16x8*)(Kb + swz128(pi, 2 * s + hh));
        const bf16x8 kf1 = *(const bf16x8*)(Kb + swz128(32 + pi, 2 * s + hh));
        sacc0 = mfma32(kf0, qf[s], sacc0);
        sacc1 = mfma32(kf1, qf[s], sacc1);
      }
      float sv[32];
      float tmax = -1e30f;
      if (ti >= 4) {
        const float* brow = rpbL + (R - r + 7) * 31 + cbase;
        float bias[32];
#pragma unroll
        for (int g = 0; g < 2; ++g)
#pragma unroll
          for (int e = 0; e < 16; ++e) bias[g * 16 + e] = brow[g * 32 + (e & 7) + 16 * (e >> 3)];
#pragma unroll
        for (int g = 0; g < 2; ++g)
#pragma unroll
          for (int e = 0; e < 16; ++e) {
            const float sc = g ? sacc1[e] : sacc0[e];
            const float x = ((int)(vmask << (31 - (g * 16 + e))) < 0) ? fmaf(sc, 0.18033688011112042f, bias[g * 16 + e]) : -1e30f;
            sv[g * 16 + e] = x;
            tmax = fmaxf(tmax, x);
          }
      } else {
#pragma unroll
        for (int g = 0; g < 2; ++g)
#pragma unroll
          for (int e = 0; e < 16; ++e) {
            const float x = (g ? sacc1[e] : sacc0[e]) * 0.18033688011112042f;
            sv[g * 16 + e] = x;
            tmax = fmaxf(tmax, x);
          }
      }
      tmax = fmaxf(tmax, shx(tmax, 32));
      if (__builtin_amdgcn_ballot_w64(tmax > m_run) != 0ull) {
        const float m_new = fmaxf(m_run, tmax);
        const float alpha = __builtin_amdgcn_exp2f(m_run - m_new);
        m_run = m_new;
        l_run *= alpha;
#pragma unroll
        for (int e = 0; e < 16; ++e) { o0[e] *= alpha; o1[e] *= alpha; }
      }
      float psum = 0.f;
#pragma unroll
      for (int e = 0; e < 32; ++e) { const float pe = __builtin_amdgcn_exp2f(sv[e] - m_run); sv[e] = pe; psum += pe; }
      l_run += psum;
#pragma unroll
      for (int g = 0; g < 2; ++g)
#pragma unroll
        for (int s2 = 0; s2 < 2; ++s2) {
          union { bf16x8 v; unsigned u[4]; } cv;
#pragma unroll
          for (int j = 0; j < 4; ++j) cv.u[j] = pk2(sv[g * 16 + 8 * s2 + 2 * j], sv[g * 16 + 8 * s2 + 2 * j + 1]);
          const bf16x8 v0 = *(const bf16x8*)(Vb + swz128(q, g * 4 + 2 * s2 + hh));
          const bf16x8 v1 = *(const bf16x8*)(Vb + swz128(32 + q, g * 4 + 2 * s2 + hh));
          o0 = mfma32(v0, cv.v, o0);
          o1 = mfma32(v1, cv.v, o1);
        }
    }
  };
  for (int ti = 0; ti < ntile; ti += 2) {
    compute(ti);
    if (ti + 1 < ntile) {
      *(uint4*)(smem + 8192 + swz128(srow, sch)) = rkA;
      *(uint4*)(smem + 16384 + 8192 + swz128(srow, sch)) = rvA;
      if (ti + 3 < ntile) gload(ti + 3, rkA, rvA);
    }
    __syncthreads();
    if (ti + 1 < ntile) {
      compute(ti + 1);
      if (ti + 2 < ntile) {
        *(uint4*)(smem + swz128(srow, sch)) = rkB;
        *(uint4*)(smem + 16384 + swz128(srow, sch)) = rvB;
        if (ti + 4 < ntile) gload(ti + 4, rkB, rvB);
      }
      __syncthreads();
    }
  }
  const float lt = l_run + shx(l_run, 32);
  const float inv = 1.0f / lt;
  __syncthreads();
  {
    char* ot = smem + wid * 4608;
#pragma unroll
    for (int qd = 0; qd < 4; ++qd) {
      uint2 a0, a1;
      a0.x = pk2(o0[4 * qd] * inv, o0[4 * qd + 1] * inv);
      a0.y = pk2(o0[4 * qd + 2] * inv, o0[4 * qd + 3] * inv);
      a1.x = pk2(o1[4 * qd] * inv, o1[4 * qd + 1] * inv);
      a1.y = pk2(o1[4 * qd + 2] * inv, o1[4 * qd + 3] * inv);
      *(uint2*)(ot + q * 144 + (8 * qd + 4 * hh) * 2) = a0;
      *(uint2*)(ot + q * 144 + (32 + 8 * qd + 4 * hh) * 2) = a1;
    }
    asm volatile("s_waitcnt lgkmcnt(0)" ::: "memory");
    const int tok0 = b * 4096 + r * 64 + half * 32;
#pragma unroll
    for (int it = 0; it < 4; ++it) {
      const int qq = it * 8 + (lane >> 3), ch = lane & 7;
      const uint4 v = *(const uint4*)(ot + qq * 144 + ch * 16);
      *(uint4*)(p.ycat + (size_t)(tok0 + qq) * 1024 + h * 64 + ch * 8) = v;
    }
  }
  __syncthreads();
}
__device__ __forceinline__ void attn_task(const P& p, int l, int kind, int idx, char* smem) {
  const int tid_ = opaque_tid(); const int lane = tid_ & 63, wid = tid_ >> 6;
  float* rpbL = (float*)smem + wid * 480;
  for (int i = lane; i < 465; i += 64) rpbL[i] = p.na_rpb[(size_t)(l * 8 + wid) * 465 + i];
  __syncthreads();
  if (kind == 0) {
    const int half = idx & 1, r = (idx >> 1) & 63, b = idx >> 7;
    attn_wave(p, l, b, wid, true, r, half, b * 4096 + r * 64 + half * 32, rpbL);
  } else {
    const int qg = idx & 7, b = idx >> 3;
    attn_wave(p, l, b, wid, false, 0, 0, NLAT + b * 256 + qg * 32, rpbL);
  }
  __syncthreads();
}

__device__ __forceinline__ void phase_mixers(const P& p, int l, char* smem, unsigned* counter) {
  const bool last = (l == 1);
  const int n_rg = 1088 * XRGA, n_fft = 1024 * XFFT, n_hc = last ? 0 : 256, n_att = 1024 * XATT, n_attc = last ? 0 : 64;
  const int total = n_rg + n_fft + n_hc + n_att + n_attc;
  volatile int* s_taskp = (volatile int*)(smem + SMEM_BYTES - 16);
  for (;;) {
    __syncthreads();
    if (threadIdx.x == 0) *s_taskp = (int)atomicAdd(counter, 1u);
    __syncthreads();
    int t = *s_taskp;
    if (t >= total) break;
    if (t < n_att) { t &= 1023; attn_block_task(p, l, t >> 7, (t >> 4) & 7, t & 15, smem); continue; }
    t -= n_att;
    if (t < n_attc) { attn_task(p, l, 1, t, smem); continue; }
    t -= n_attc;
    if (t < n_fft) { t &= 1023; hyena_fft_task(p, l, t >> 2, t & 3, smem); continue; }
    t -= n_fft;
    if (t < n_hc) { hyena_ctx_task(p, l, t >> 5, t & 31, smem); continue; }
    t -= n_hc;
    if (t >= 1088) t -= 1088;
    rg_wave_task(p, l, t >> 2, t & 3, 0, last, smem);
  }
}

__device__ __forceinline__ void merge_tile(const P& p, int l, int mt, int nt, char* smem) {
  EPI_VARS
  const int m0 = mt * 256, n0 = nt * 128;
  f32x16 macc[2][2];
  zero_acc(macc);
  for (int br = 0; br < 3; ++br) {
    unsigned* gpl = (unsigned*)(smem + 98304) + tid;
    {
      f32x16 acc[2][2];
      zero_acc(acc);
      gemm_kloop(acc, p.xn + (size_t)m0 * 1024, 1024, p.WgT + ((size_t)l * 3072 + br * 1024 + n0) * 1024, 1024, 1024, smem);
#pragma unroll
      for (int j = 0; j < 2; ++j) {
        const float bg = p.b_gate[l * 3072 + br * 1024 + n0 + EPI_COL(j)];
#pragma unroll
        for (int i = 0; i < 2; ++i)
#pragma unroll
          for (int e = 0; e < 4; ++e) {
            const unsigned q0 = (unsigned)(sigmoidf_(acc[i][j][4 * e] + bg) * 255.0f + 0.5f);
            const unsigned q1 = (unsigned)(sigmoidf_(acc[i][j][4 * e + 1] + bg) * 255.0f + 0.5f);
            const unsigned q2 = (unsigned)(sigmoidf_(acc[i][j][4 * e + 2] + bg) * 255.0f + 0.5f);
            const unsigned q3 = (unsigned)(sigmoidf_(acc[i][j][4 * e + 3] + bg) * 255.0f + 0.5f);
            gpl[((i * 2 + j) * 4 + e) * 512] = q0 | (q1 << 8) | (q2 << 16) | (q3 << 24);
          }
      }
    }
    {
      f32x16 acc[2][2];
      zero_acc(acc);
      const u16* A; const u16* B; int K;
      if (br == 0) { A = p.ycat + (size_t)m0 * 1024; B = p.WaT + ((size_t)l * 1024 + n0) * 512; K = 512; }
      else if (br == 1) { A = p.ycat + (size_t)m0 * 1024 + 512; B = p.WbT + ((size_t)l * 1024 + n0) * 256; K = 256; }
      else { A = p.ycat + (size_t)m0 * 1024 + 768; B = p.WcT + ((size_t)l * 1024 + n0) * 256; K = 256; }
      gemm_kloop(acc, A, 1024, B, K, K, smem);
#pragma unroll
      for (int i = 0; i < 2; ++i)
#pragma unroll
        for (int j = 0; j < 2; ++j)
#pragma unroll
          for (int e = 0; e < 4; ++e) {
            const unsigned g4 = gpl[((i * 2 + j) * 4 + e) * 512];
            macc[i][j][4 * e] += (float)(g4 & 255u) * (1.0f / 255.0f) * acc[i][j][4 * e];
            macc[i][j][4 * e + 1] += (float)((g4 >> 8) & 255u) * (1.0f / 255.0f) * acc[i][j][4 * e + 1];
            macc[i][j][4 * e + 2] += (float)((g4 >> 16) & 255u) * (1.0f / 255.0f) * acc[i][j][4 * e + 2];
            macc[i][j][4 * e + 3] += (float)(g4 >> 24) * (1.0f / 255.0f) * acc[i][j][4 * e + 3];
          }
    }
  }
#pragma unroll
  for (int i = 0; i < 2; ++i)
#pragma unroll
    for (int j = 0; j < 2; ++j)
#pragma unroll
      for (int e = 0; e < 16; ++e)
        p.mbuf[(size_t)(m0 + EPI_ROW(i, e)) * 1024 + n0 + EPI_COL(j)] = f2bf(macc[i][j][e]);
}
__device__ __forceinline__ void outproj_tile(const P& p, int l, int mt, int nt, char* smem, bool do_store) {
  EPI_VARS
  const int m0 = mt * 256, n0 = nt * 128;
  f32x16 acc[2][2];
  zero_acc(acc);
  gemm_kloop(acc, p.mbuf + (size_t)m0 * 1024, 1024, p.WoT + ((size_t)l * 1024 + n0) * 1024, 1024, 1024, smem);
  const bool isctx = (mt >= 128);
  const int bi = isctx ? 8 : (mt >> 4);
  const float* gatev = p.mod + ((size_t)(l * 9 + bi) * 6 + 2) * 1024;
  const float* src; float* dst;
  if (isctx) { src = (l == 0 ? p.ctx : p.ctxs) - (size_t)NLAT * 1024; dst = p.ctxs - (size_t)NLAT * 1024; }
  else { src = (l == 0 ? p.x : p.out); dst = p.out; }
#pragma unroll
  for (int j = 0; j < 2; ++j) {
    const int col = n0 + EPI_COL(j);
    const float gv = gatev[col];
#pragma unroll
    for (int i = 0; i < 2; ++i)
#pragma unroll
      for (int e = 0; e < 16; ++e) {
        const size_t o = (size_t)(m0 + EPI_ROW(i, e)) * 1024 + col;
        if (do_store) dst[o] = src[o] + gv * acc[i][j][e];
      }
  }
}

__device__ __forceinline__ void wqk_task(const P& p, int l, int hp, int nt, char* smem) {
  EPI_VARS
  f32x16 acc[2][2];
  zero_acc(acc);
  gemm_kloop(acc, p.keysB + ((size_t)l * 16 + hp) * 16384, 128, p.WqB + (size_t)l * 1024 * 2048 + (size_t)(nt * 128) * 2048 + hp * 128, 2048, 128, smem);
  if (wm < 2) {
#pragma unroll
    for (int i = 0; i < 2; ++i)
#pragma unroll
      for (int j = 0; j < 2; ++j)
#pragma unroll
        for (int e = 0; e < 16; ++e)
          p.WqkT[((size_t)l * 2048 + hp * 128 + EPI_ROW(i, e)) * 1024 + nt * 128 + EPI_COL(j)] = f2bf(acc[i][j][e]);
  }
}
__device__ __forceinline__ void ins16(unsigned (&L)[16], unsigned x) {
#pragma unroll
  for (int i = 0; i < 16; ++i) {
    const unsigned hi = max(L[i], x);
    x = min(L[i], x);
    L[i] = hi;
  }
}
__device__ __forceinline__ unsigned f2sort(float f) {
  const unsigned b = __float_as_uint(f);
  return b ^ ((unsigned)((int)b >> 31) | 0x80000000u);
}
__device__ __forceinline__ float sort2f(unsigned k) {
  const unsigned u = k & ~127u;
  const unsigned b = (u & 0x80000000u) ? (u ^ 0x80000000u) : ~u;
  return __uint_as_float(b);
}
__device__ __forceinline__ void cx_desc(unsigned& a, unsigned& b) { const unsigned hi = max(a, b), lo = min(a, b); a = hi; b = lo; }
template <int BASE> __device__ __forceinline__ void sort16_desc(unsigned (&k)[64]) {
#pragma unroll
  for (int sz = 2; sz <= 16; sz <<= 1) {
#pragma unroll
    for (int j = sz >> 1; j >= 1; j >>= 1) {
#pragma unroll
      for (int i = 0; i < 16; ++i) {
        const int l2 = i ^ j;
        if (l2 > i) {
          if ((i & sz) == 0) cx_desc(k[BASE + i], k[BASE + l2]);
          else cx_desc(k[BASE + l2], k[BASE + i]);
        }
      }
    }
  }
}
template <int AB, int BB> __device__ __forceinline__ void merge16_desc(unsigned (&k)[64]) {
#pragma unroll
  for (int i = 0; i < 16; ++i) k[AB + i] = max(k[AB + i], k[BB + 15 - i]);
#pragma unroll
  for (int j = 8; j >= 1; j >>= 1) {
#pragma unroll
    for (int i = 0; i < 16; ++i)
      if ((i & j) == 0) cx_desc(k[AB + i], k[AB + i + j]);
  }
}
#define PS_LOAD(mt_, hp_) do { _Pragma("unroll") for (int it = 0; it < 8; ++it) { const int id = tid + NTHR * it; \
    pre[it] = *(const uint4*)(p.q + (size_t)((mt_) * 256 + (id >> 4)) * 2048 + (hp_) * 128 + (id & 15) * 8); } } while (0)
__device__ __forceinline__ void peer_score_tile(const P& p, int l, int mt, int hp, char* smem, uint4& p0, uint4& p1, uint4& p2, uint4& p3, uint4& p4, uint4& p5, uint4& p6, uint4& p7, int nmt, int nhp) {
  const int tid = opaque_tid();
  const int m0 = mt * 256;
  const int row = tid >> 1, hf = tid & 1;
  {
    char* T = smem + 16384;
    uint4 pre[8] = {p0, p1, p2, p3, p4, p5, p6, p7};
#pragma unroll
    for (int it = 0; it < 8; ++it) {
      const int id = tid + NTHR * it;
      const int r = id >> 4, ch = id & 15;
      *(uint4*)(T + r * 272 + ch * 16) = pre[it];
    }
    PS_LOAD(nmt, nhp);
    p0 = pre[0]; p1 = pre[1]; p2 = pre[2]; p3 = pre[3]; p4 = pre[4]; p5 = pre[5]; p6 = pre[6]; p7 = pre[7];
  }
  __syncthreads();
  const char* sp = smem + 16384 + row * 272 + hf * 128;
  unsigned k[64];
#pragma unroll
  for (int c = 0; c < 8; ++c) {
    const uint4 r = *(const uint4*)(sp + 16 * c);
    const unsigned w[4] = {r.x, r.y, r.z, r.w};
#pragma unroll
    for (int q = 0; q < 4; ++q) {
      const float v0 = __builtin_bit_cast(_Float16, (unsigned short)(w[q] & 0xffffu));
      const float v1 = __builtin_bit_cast(_Float16, (unsigned short)(w[q] >> 16));
      const int key = hf * 64 + c * 8 + q * 2;
      k[c * 8 + q * 2] = (f2sort(v0) & ~127u) | (unsigned)key;
      k[c * 8 + q * 2 + 1] = (f2sort(v1) & ~127u) | (unsigned)(key + 1);
    }
  }
  sort16_desc<0>(k); sort16_desc<16>(k); sort16_desc<32>(k); sort16_desc<48>(k);
  merge16_desc<0, 16>(k);
  merge16_desc<32, 48>(k);
  merge16_desc<0, 32>(k);
  unsigned* X = (unsigned*)smem;
  if (hf) {
#pragma unroll
    for (int i = 0; i < 16; ++i) X[row * 16 + i] = k[i];
  }
  __syncthreads();
  if (!hf) {
#pragma unroll
    for (int i = 0; i < 16; ++i) k[16 + i] = X[row * 16 + i];
    merge16_desc<0, 16>(k);
    unsigned* o = p.topk + ((size_t)(m0 + row) * 16 + hp) * 16;
#pragma unroll
    for (int i = 0; i < 4; ++i) *(uint4*)(o + 4 * i) = make_uint4(k[4 * i], k[4 * i + 1], k[4 * i + 2], k[4 * i + 3]);
  }
  __syncthreads();
}

__device__ __forceinline__ void phase_peer_experts(const P& p, int l, bool do_store, char* smem) {
  const int tid_ = opaque_tid(); const int lane = tid_ & 63, wid = tid_ >> 6;
  const int ntok = (l == 1) ? NLAT : NTOK;
  int ci, cj;
  {
    const int e = lane;
    if (e < 16) { ci = 0; cj = e; }
    else if (e < 24) { ci = 1; cj = e - 16; }
    else if (e < 29) { ci = 2; cj = e - 24; }
    else if (e < 33) { ci = 3; cj = e - 29; }
    else if (e < 36) { ci = 4; cj = e - 33; }
    else if (e < 38) { ci = 5; cj = e - 36; }
    else if (e < 40) { ci = 6; cj = e - 38; }
    else if (e < 42) { ci = 7; cj = e - 40; }
    else { ci = min(8 + (e - 42), 15); cj = 0; }
  }
  for (int tok = blockIdx.x * 8 + wid; tok < ntok; tok += gridDim.x * 8) {
    float xr[16];
    {
      const uint4 a = *(const uint4*)(p.xn + (size_t)tok * 1024 + lane * 16);
      const uint4 b = *(const uint4*)(p.xn + (size_t)tok * 1024 + lane * 16 + 8);
      xr[0] = bflo(a.x); xr[1] = bfhi(a.x); xr[2] = bflo(a.y); xr[3] = bfhi(a.y);
      xr[4] = bflo(a.z); xr[5] = bfhi(a.z); xr[6] = bflo(a.w); xr[7] = bfhi(a.w);
      xr[8] = bflo(b.x); xr[9] = bfhi(b.x); xr[10] = bflo(b.y); xr[11] = bfhi(b.y);
      xr[12] = bflo(b.z); xr[13] = bfhi(b.z); xr[14] = bflo(b.w); xr[15] = bfhi(b.w);
    }
    typedef _Float16 h2_t __attribute__((ext_vector_type(2)));
    h2_t yh[8];
#pragma unroll
    for (int i = 0; i < 8; ++i) yh[i] = (h2_t){(_Float16)0, (_Float16)0};
    int* selw = (int*)(smem + wid * 4096);
    const unsigned* kvp = p.topk + (size_t)tok * 256 + (lane & 31);
#pragma unroll 1
    for (int hb = 0; hb < 8; hb += 4) {
      unsigned key[4]; int eidx[4];
#pragma unroll
      for (int u = 0; u < 4; ++u) {
        const unsigned kv = kvp[(hb + u) * 32];
        const unsigned k0 = shu(kv, ci);
        const unsigned k1 = shu(kv, 16 + cj);
        const float val = (lane < 50) ? (sort2f(k0) + sort2f(k1)) : -3.0e38f;
        eidx[u] = (int)((k0 & 127u) * 128u + (k1 & 127u));
        key[u] = (f2sort(val) & ~63u) | (unsigned)lane;
      }
#pragma unroll
      for (int k = 2; k <= 64; k <<= 1) {
#pragma unroll
        for (int j = k >> 1; j >= 1; j >>= 1) {
          const bool take_max = (((lane & j) == 0) == ((lane & k) == 0));
#pragma unroll
          for (int u = 0; u < 4; ++u) {
            unsigned ok;
            if (j == 1) ok = xorl<1>(key[u], lane); else if (j == 2) ok = xorl<2>(key[u], lane); else if (j == 4) ok = xorl<4>(key[u], lane);
            else if (j == 8) ok = xorl<8>(key[u], lane); else if (j == 16) ok = xorl<16>(key[u], lane); else ok = xorl<32>(key[u], lane);
            key[u] = take_max ? max(key[u], ok) : min(key[u], ok);
          }
        }
      }
#pragma unroll
      for (int u = 0; u < 4; ++u) {
        const int si = __builtin_amdgcn_ds_bpermute((int)(key[u] & 63u) << 2, eidx[u]);
        const unsigned ku = key[u] & ~63u;
        const float sv = __uint_as_float((ku & 0x80000000u) ? (ku ^ 0x80000000u) : ~ku);
        const float mx = __builtin_bit_cast(float, __builtin_amdgcn_readlane(__builtin_bit_cast(int, sv), 0));
        const float ex = (lane < 16) ? __builtin_amdgcn_exp2f((sv - mx) * 1.4426950408889634f) : 0.f;
        const float sm = wave_sum(ex);
        selw[(hb + u) * 64 + lane] = si;
        selw[512 + (hb + u) * 64 + lane] = __builtin_bit_cast(int, ex * __builtin_amdgcn_rcpf(sm));
      }
    }
    {
      int w[4];
#pragma unroll
      for (int i = 0; i < 4; ++i) {
        int t = __builtin_amdgcn_cvt_pk_fp8_f32(xr[4 * i], xr[4 * i + 1], 0, false);
        w[i] = __builtin_amdgcn_cvt_pk_fp8_f32(xr[4 * i + 2], xr[4 * i + 3], t, true);
      }
      *(uint4*)(smem + 32768 + wid * 1024 + lane * 16) = make_uint4((unsigned)w[0], (unsigned)w[1], (unsigned)w[2], (unsigned)w[3]);
    }
    asm volatile("s_waitcnt lgkmcnt(0)" ::: "memory");
    const int e15 = lane & 15, g4 = lane >> 4;
#pragma unroll 1
    for (int h = 0; h < 8; ++h) {
      const int eperm_h = selw[h * 64 + lane];
      const int gperm_h = selw[512 + h * 64 + lane];
      const int ide = (int)shu((unsigned)eperm_h, e15);
      const unsigned char* ub = p.Ub + (size_t)ide * 1024 + g4 * 16;
      uint4 ua[8];
#pragma unroll
      for (int sI = 0; sI < 8; ++sI) ua[sI] = *(const uint4*)(ub + sI * 64);
      pg8::f32x4 hacc = {0.f, 0.f, 0.f, 0.f};
#pragma unroll
      for (int sI = 0; sI < 8; ++sI) {
        const uint4 b0 = *(const uint4*)(smem + 32768 + wid * 1024 + sI * 128 + g4 * 16);
        const uint4 b1 = *(const uint4*)(smem + 32768 + wid * 1024 + sI * 128 + 64 + g4 * 16);
        const i32x8 A = {(int)ua[sI].x, (int)ua[sI].y, (int)ua[sI].z, (int)ua[sI].w, 0, 0, 0, 0};
        const i32x8 B = {(int)b0.x, (int)b0.y, (int)b0.z, (int)b0.w, (int)b1.x, (int)b1.y, (int)b1.z, (int)b1.w};
        hacc = __builtin_amdgcn_mfma_scale_f32_16x16x128_f8f6f4(A, B, hacc, 4  , 0  , 0, 0x7f7f7f7f, 0, 0x7f7f7f7f);
      }
      asm volatile("" ::: "memory");
      uint2 V[16];
#pragma unroll
      for (int k = 0; k < 16; ++k) {
        const int id = __builtin_amdgcn_readlane(eperm_h, k);
        V[k] = *(const uint2*)(p.Ub + (size_t)id * 1024 + 512 + lane * 8);
      }
      float actv[4];
#pragma unroll
      for (int r4 = 0; r4 < 4; ++r4) {
        const float gl = __builtin_bit_cast(float, shu((unsigned)gperm_h, 4 * g4 + r4));
        actv[r4] = gelu_tanh(hacc[r4] * (1.0f / 64.0f)) * gl;
      }
#pragma unroll
      for (int k = 0; k < 16; ++k) {
        const float ak = __builtin_bit_cast(float, __builtin_amdgcn_readlane(__builtin_bit_cast(int, actv[k & 3]), 16 * (k >> 2)));
        const h2_t akh = {(_Float16)ak, (_Float16)ak};
        const unsigned vw[2] = {V[k].x, V[k].y};
#pragma unroll
        for (int q2 = 0; q2 < 2; ++q2) {
          yh[4 * q2 + 0] = __builtin_elementwise_fma(akh, __builtin_bit_cast(h2_t, __builtin_amdgcn_cvt_scalef32_pk_f16_fp4(vw[q2], 1.0f, 0)), yh[4 * q2 + 0]);
          yh[4 * q2 + 1] = __builtin_elementwise_fma(akh, __builtin_bit_cast(h2_t, __builtin_amdgcn_cvt_scalef32_pk_f16_fp4(vw[q2], 1.0f, 1)), yh[4 * q2 + 1]);
          yh[4 * q2 + 2] = __builtin_elementwise_fma(akh, __builtin_bit_cast(h2_t, __builtin_amdgcn_cvt_scalef32_pk_f16_fp4(vw[q2], 1.0f, 2)), yh[4 * q2 + 2]);
          yh[4 * q2 + 3] = __builtin_elementwise_fma(akh, __builtin_bit_cast(h2_t, __builtin_amdgcn_cvt_scalef32_pk_f16_fp4(vw[q2], 1.0f, 3)), yh[4 * q2 + 3]);
        }
      }
    }
    float yacc[16];
#pragma unroll
    for (int i = 0; i < 8; ++i) { yacc[2 * i] = (float)yh[i].x; yacc[2 * i + 1] = (float)yh[i].y; }
    const int bi = tok < NLAT ? (tok >> 12) : 8;
    const float* gv = p.mod + ((size_t)(l * 9 + bi) * 6 + 5) * 1024 + lane * 16;
    float* xp = (tok < NLAT) ? (p.out + (size_t)tok * 1024) : (p.ctxs + (size_t)(tok - NLAT) * 1024);
    xp += lane * 16;
    float4 xv[4];
    float ss = 0.f;
#pragma unroll
    for (int i = 0; i < 4; ++i) {
      xv[i] = *(float4*)(xp + 4 * i);
      const float4 g4 = *(const float4*)(gv + 4 * i);
      xv[i].x += g4.x * yacc[4 * i] * 0.25f; xv[i].y += g4.y * yacc[4 * i + 1] * 0.25f; xv[i].z += g4.z * yacc[4 * i + 2] * 0.25f; xv[i].w += g4.w * yacc[4 * i + 3] * 0.25f;
      ss += xv[i].x * xv[i].x + xv[i].y * xv[i].y + xv[i].z * xv[i].z + xv[i].w * xv[i].w;
    }
    ss = wave_sum(ss);
    const float rstd = rsqrtf(ss * (1.0f / 1024.0f) + 1e-6f);
    if (l == 0) {
      const float* gam = p.norm_mix_g + 1024 + lane * 16;
      const float* msh = p.mod + ((size_t)(9 + bi) * 6 + 0) * 1024 + lane * 16;
      const float* msc = msh + 1024;
      float yv[16];
      float amax = 0.f;
#pragma unroll
      for (int i = 0; i < 4; ++i) {
        const float4 g = *(const float4*)(gam + 4 * i);
        const float4 sh = *(const float4*)(msh + 4 * i);
        const float4 sc = *(const float4*)(msc + 4 * i);
        yv[4 * i] = xv[i].x * rstd * g.x * (1.f + sc.x) + sh.x; yv[4 * i + 1] = xv[i].y * rstd * g.y * (1.f + sc.y) + sh.y;
        yv[4 * i + 2] = xv[i].z * rstd * g.z * (1.f + sc.z) + sh.z; yv[4 * i + 3] = xv[i].w * rstd * g.w * (1.f + sc.w) + sh.w;
      }
#pragma unroll
      for (int i = 0; i < 16; ++i) amax = fmaxf(amax, fabsf(yv[i]));
      amax = fmaxf(wave_max(amax), 1e-20f);
      const float inv = 127.0f / amax;
      unsigned w[4];
#pragma unroll
      for (int i = 0; i < 4; ++i)
        w[i] = ((unsigned)__float2int_rn(yv[4 * i] * inv) & 255u) | (((unsigned)__float2int_rn(yv[4 * i + 1] * inv) & 255u) << 8) |
               (((unsigned)__float2int_rn(yv[4 * i + 2] * inv) & 255u) << 16) | (((unsigned)__float2int_rn(yv[4 * i + 3] * inv) & 255u) << 24);
      if (do_store) {
#pragma unroll
        for (int i = 0; i < 4; ++i) *(float4*)(xp + 4 * i) = xv[i];
        *(uint4*)(p.xn8 + (size_t)tok * 1024 + lane * 16) = make_uint4(w[0], w[1], w[2], w[3]);
        if (lane == 0) p.sa[tok] = amax * (1.0f / 127.0f);
      }
    } else {
      const float* fg = p.final_g + lane * 16;
      float4 gf[4];
#pragma unroll
      for (int i = 0; i < 4; ++i) gf[i] = *(const float4*)(fg + 4 * i);
#pragma unroll
      for (int i = 0; i < 4; ++i) {
        const float4 g = gf[i];
        const float4 o = make_float4(xv[i].x * rstd * g.x, xv[i].y * rstd * g.y, xv[i].z * rstd * g.z, xv[i].w * rstd * g.w);
        if (do_store) *(float4*)(xp + 4 * i) = o;
      }
    }
  }
}


#define XB_TMO      128
#define XB_XCNT(j)  (256  + 64 * (j))
#define XB_XSUB(j)  (1280 + 64 * (j))
#define XB_XGEN(j)  (2304 + 64 * (j))
#define XB_TOP      3328
#define XB_TOPGEN   3392
#define XCD_BAR_WORDS 3456
#define XB_SPIN_CAP (1u << 22)
#define LAS __attribute__((address_space(3)))
__device__ __forceinline__ unsigned xb_ld(unsigned* p) { return __hip_atomic_load(p, __ATOMIC_RELAXED, __HIP_MEMORY_SCOPE_AGENT); }
__device__ __forceinline__ unsigned xb_add(unsigned* p, unsigned v) { return __hip_atomic_fetch_add(p, v, __ATOMIC_RELAXED, __HIP_MEMORY_SCOPE_AGENT); }
__device__ __forceinline__ unsigned xb_xcc_id() { return (unsigned)__builtin_amdgcn_s_getreg((3 << 11) | 20) & 0xFu; }
#define XB_SPIN(cond, bar) do { unsigned _sp = 0; while (cond) { __builtin_amdgcn_s_sleep(1); \
    if ((++_sp & 255u) == 0u) { if (xb_ld(&(bar)[XB_TMO])) break; if (_sp > XB_SPIN_CAP) { atomicAdd(&(bar)[XB_TMO], 1u); break; } } } } while (0)
struct XcdBarrier { unsigned* bar; unsigned x; volatile LAS unsigned* st; };
__device__ __forceinline__ XcdBarrier xcd_barrier_post(unsigned* bar, volatile LAS unsigned* st) {
  XcdBarrier b; b.bar = bar; b.x = xb_xcc_id(); b.st = st;
  if (threadIdx.x == 0) (void)xb_add(&bar[XB_XCNT(b.x)], 1u);
  return b;
}
__device__ __forceinline__ void xcd_barrier_complete(unsigned* bar, unsigned x, unsigned& nloc, unsigned& nx) {
  const unsigned G = gridDim.x * gridDim.y * gridDim.z;
  unsigned sum, cnt, mine, sp = 0u;
  for (;;) {
    sum = 0u; cnt = 0u; mine = 0u;
#pragma unroll
    for (unsigned j = 0; j < 16; ++j) { const unsigned c = xb_ld(&bar[XB_XCNT(j)]); sum += c; cnt += (c > 0u) ? 1u : 0u; mine = (j == x) ? c : mine; }
    if (sum == G) break;
    __builtin_amdgcn_s_sleep(1);
    if ((++sp & 255u) == 0u) { if (xb_ld(&bar[XB_TMO])) break; if (sp > XB_SPIN_CAP) { atomicAdd(&bar[XB_TMO], 1u); break; } }
  }
  nloc = mine > 0u ? mine : 1u; nx = cnt > 0u ? cnt : 1u;
}
__device__ __forceinline__ void xcd_barrier(unsigned* bar_u, volatile LAS unsigned* st_u) {
  XcdBarrier b; b.bar = bar_u; b.x = xb_xcc_id(); b.st = st_u;
  asm volatile("s_waitcnt vmcnt(0)" ::: "memory");
  __syncthreads();
  if (threadIdx.x == 0) {
    unsigned long long bp_ = (unsigned long long)b.bar;
    asm volatile("" : "+v"(bp_));
    unsigned* bar = (unsigned*)bp_;
    __builtin_amdgcn_s_waitcnt(0);
    unsigned nloc = b.st[0], nx = b.st[1];
    if (nloc == 0u) { xcd_barrier_complete(bar, b.x, nloc, nx); b.st[0] = nloc; b.st[1] = nx; }
    const unsigned old = xb_add(&bar[XB_XSUB(b.x)], 1u);
    const unsigned gen = old / nloc;
    if (old + 1u == (gen + 1u) * nloc) {
      __builtin_amdgcn_fence(__ATOMIC_RELEASE, "agent");
      asm volatile("s_waitcnt vmcnt(0)" ::: "memory");
      const unsigned og = xb_add(&bar[XB_TOP], 1u);
      const unsigned tg = og / nx;
      if (og + 1u == (tg + 1u) * nx) xb_add(&bar[XB_TOPGEN], 1u);
      else XB_SPIN(xb_ld(&bar[XB_TOPGEN]) == tg, bar);
      __builtin_amdgcn_fence(__ATOMIC_ACQUIRE, "agent");
      xb_add(&bar[XB_XGEN(b.x)], 1u);
      asm volatile("s_waitcnt vmcnt(0)" ::: "memory");
    } else {
      XB_SPIN(xb_ld(&bar[XB_XGEN(b.x)]) == gen, bar);
      __builtin_amdgcn_fence(__ATOMIC_ACQUIRE, "agent");
      asm volatile("s_waitcnt vmcnt(0)" ::: "memory");
    }
  }
  __syncthreads();
}

template <int l>
__device__ __forceinline__ void layer_body(const P& p, char* smem, pg8::PG8_LAS_T lds, volatile LAS unsigned* xbw, const int nb, const int bid) {
    const bool last = (l == 1);
    const int n_mt = last ? 128 : 136;
    if (l == 0) {
      phase_norm(p, l, 0);
      xcd_barrier(p.counters + 1024, xbw);
    }
_Pragma("unroll 1")
    for (int rep = 0; rep < REP_INPROJ; ++rep) {
      pg8::Gemm g; pg8::Order S;
      g.A = (const u16*)p.xn8; g.Bt = (const u16*)(p.Win8 + (size_t)l * 2816 * 1024); g.lda = 512; g.ldb = 512; g.K = 512;
      S.init(136, 6, nb, bid, 4, 5);
      pg8::EpiInprojN8 e1; e1.qk = p.qk; e1.rg = p.rg; e1.sa = p.sa; e1.sw = p.sw + l * 5888;
      pg8::gemm_phase(lds, g, S, e1);
      g.A = (const u16*)(p.Win8 + ((size_t)l * 2816 + 1024) * 1024); g.Bt = (const u16*)p.xn8;
      S.init(5, 136, nb, (bid + nb - (136 * 6) % nb) % nb);
      pg8::EpiInprojT8 e2; e2.vT = p.vT; e2.sa = p.sa; e2.sw = p.sw + l * 5888 + 1024;
      pg8::gemm_phase(lds, g, S, e2);
    }
    xcd_barrier(p.counters + 1024, xbw);
    phase_mixers(p, l, smem, p.counters + l * 4);
    xcd_barrier(p.counters + 1024, xbw);
_Pragma("unroll 1")
    for (int rep = 0; rep < REP_2B; ++rep)
      for (int task = bid; task < 1088 + 512; task += nb) {
        if (task < 1088) rg_wave_task(p, l, task >> 2, task & 3, 1, last, smem);
        else yb_transpose_task(p, (task - 1088) >> 6, (task - 1088) & 63, smem);
      }
    xcd_barrier(p.counters + 1024, xbw);
_Pragma("unroll 1")
    for (int rep = 0; rep < REP_GATE; ++rep) {
      pg8::Gemm g; pg8::Order S;
      g.A = (const u16*)p.xn8; g.Bt = (const u16*)(p.Wg8 + (size_t)l * 3072 * 1024); g.lda = 512; g.ldb = 512; g.K = 512;
      S.init(n_mt, 12, nb, bid);
      pg8::EpiGate8 e; e.g8 = p.g8; e.bias = p.b_gate + l * 3072; e.sa = p.sa; e.sw = p.sw + l * 5888 + 2816;
      pg8::gemm_phase(lds, g, S, e);
    }
    xcd_barrier(p.counters + 1024, xbw);
_Pragma("unroll 1")
    for (int rep = 0; rep < REP_BRANCH; ++rep) {
      pg8::Gemm g; pg8::Order S;
      S.init(n_mt, 4, nb, bid);
      pg8::EpiBranch e; e.mbuf = p.mbuf; e.g8 = p.g8;
      g.lda = 1024;
      g.A = p.ycat; g.Bt = p.WaT + (size_t)l * 1024 * 512; g.ldb = 512; g.K = 512; e.br = 0;
      pg8::gemm_phase(lds, g, S, e);
      g.A = p.ycat + 512; g.Bt = p.WbT + (size_t)l * 1024 * 256; g.ldb = 256; g.K = 256; e.br = 1;
      pg8::gemm_phase(lds, g, S, e);
      g.A = p.ycat + 768; g.Bt = p.WcT + (size_t)l * 1024 * 256; g.ldb = 256; g.K = 256; e.br = 2;
      pg8::gemm_phase(lds, g, S, e);
    }
    xcd_barrier(p.counters + 1024, xbw);
    {
      pg8::Gemm g; pg8::Order S;
      g.A = p.mbuf; g.Bt = p.WoT + (size_t)l * 1024 * 1024; g.lda = 1024; g.ldb = 1024; g.K = 1024;
      S.init(n_mt, 4, nb, bid);
      pg8::EpiOut e; e.xsrc = (l == 0 ? p.x : p.out); e.csrc = (l == 0 ? p.ctx : p.ctxs); e.xdst = p.out; e.cdst = p.ctxs;
      e.modl = p.mod + (size_t)l * 9 * 6144;
      pg8::gemm_phase(lds, g, S, e);
      for (int t = bid; t < 4096; t += 8 * nb) {
        cvt_chunk_fp4x8(p.peer_u + (size_t)l * 16384 * 1024, p.Ub, t, nb, 4096, 64.0f, 0);
        cvt_chunk_fp4x8(p.peer_v + (size_t)l * 16384 * 1024, p.Ub, t, nb, 4096, 4.0f, 1);
      }
    }
    xcd_barrier(p.counters + 1024, xbw);
    phase_norm(p, l, 1);
    xcd_barrier(p.counters + 1024, xbw);
_Pragma("unroll 1")
    for (int rep = 0; rep < REP_Q; ++rep) {
      pg8::Gemm g; pg8::Order S;
      g.A = p.xn; g.Bt = p.WqkT + (size_t)l * 2048 * 1024; g.lda = 1024; g.ldb = 1024; g.K = 1024;
      S.init(n_mt, 8, nb, bid);
      pg8::EpiQ e; e.q = p.q;
      pg8::gemm_phase(lds, g, S, e);
    }
    xcd_barrier(p.counters + 1024, xbw);
_Pragma("unroll 1")
    for (int rep = 0; rep < REP_SCORE; ++rep)
    {
      uint4 q0, q1, q2, q3, q4, q5, q6, q7;
      {
        const int tid = opaque_tid();
        const int t0 = bid < n_mt * 16 ? bid : 0;
        uint4 pre[8];
        PS_LOAD(t0 >> 4, t0 & 15);
        q0 = pre[0]; q1 = pre[1]; q2 = pre[2]; q3 = pre[3]; q4 = pre[4]; q5 = pre[5]; q6 = pre[6]; q7 = pre[7];
      }
      for (int task = bid; task < n_mt * 16; task += nb) {
        const int nt_ = (task + nb < n_mt * 16) ? task + nb : task;
        peer_score_tile(p, l, task >> 4, task & 15, smem, q0, q1, q2, q3, q4, q5, q6, q7, nt_ >> 4, nt_ & 15);
      }
    }
    xcd_barrier(p.counters + 1024, xbw);
_Pragma("unroll 1")
    for (int rep = 0; rep < REP_PEER; ++rep) phase_peer_experts(p, l, rep == REP_PEER - 1, smem);
    xcd_barrier(p.counters + 1024, xbw);
  }

__global__ void __launch_bounds__(NTHR) fwd_megakernel(P p) {
  __shared__ __attribute__((aligned(16))) char smem[SMEM_BYTES];
  cg::grid_group grid = cg::this_grid();
  const int nb = gridDim.x, bid = blockIdx.x;
  pg8::PG8_LAS_T lds = (pg8::PG8_LAS_T)smem;
  volatile LAS unsigned* xbw = (volatile LAS unsigned*)(smem + SMEM_BYTES - 32);
  if (threadIdx.x == 0) { xbw[0] = 0u; xbw[1] = 0u; xbw[2] = 0u; xbw[3] = 0u; }
  __syncthreads();
  (void)xcd_barrier_post(p.counters + 1024, xbw);

  phase_prep(p, smem, p.counters + 32);
  grid.sync();
  phase_modreduce(p);
  for (int task = blockIdx.x; task < 512; task += gridDim.x) kf_task(p, task >> 8, task & 255, smem);
  for (int task = blockIdx.x; task < 256; task += gridDim.x) wqk_task(p, task >> 7, (task >> 3) & 15, task & 7, smem);
  for (int task = blockIdx.x; task < 2 * 368; task += gridDim.x) {
    const int l = task / 368, t = task - l * 368;
    if (t < 176) tr_tile4<true>(p.w_in + (size_t)l * 1024 * 2816, 2816, 1024, p.Win8 + (size_t)l * 2816 * 1024, t, p.sw + l * 5888, smem);
    else tr_tile4<true>(p.w_gate + (size_t)l * 1024 * 3072, 3072, 1024, p.Wg8 + (size_t)l * 3072 * 1024, t - 176, p.sw + l * 5888 + 2816, smem);
  }
  xcd_barrier(p.counters + 1024, xbw);

  layer_body<0>(p, smem, lds, xbw, nb, bid);
  layer_body<1>(p, smem, lds, xbw, nb, bid);
}

extern "C" void kernel_launch(void* const* d_in, const int* in_sizes, int n_in, void* d_out, int out_size, void* d_ws,
                              size_t ws_size, hipStream_t stream) {
  P p;
  memset(&p, 0, sizeof(p));
  const float** ins = (const float**)&p;
  for (int i = 0; i < 37; ++i) ins[i] = (const float*)d_in[i];
  p.out = (float*)d_out;
  char* w = (char*)d_ws;
  size_t off = 0;
  auto take = [&](size_t bytes) { char* r = w + off; off += (bytes + 255) & ~(size_t)255; return r; };
  p.counters = (unsigned*)take(32768);
  p.WinT = nullptr; p.WgT = nullptr;
  p.Win8 = (unsigned char*)take((size_t)2 * 2816 * 1024);
  p.Wg8 = (unsigned char*)take((size_t)2 * 3072 * 1024);
  p.sw = (float*)take((size_t)2 * 5888 * 4);
  p.xn8 = (unsigned char*)take((size_t)NTOK * 1024);
  p.sa = (float*)take((size_t)NTOK * 4);
  p.WaT = (u16*)take((size_t)2 * 1024 * 512 * 2);
  p.WbT = (u16*)take((size_t)2 * 1024 * 256 * 2);
  p.WcT = (u16*)take((size_t)2 * 1024 * 256 * 2);
  p.WoT = (u16*)take((size_t)2 * 1024 * 1024 * 2);
  p.WqB = (u16*)take((size_t)2 * 1024 * 2048 * 2);
  p.WqkT = (u16*)take((size_t)2 * 2048 * 1024 * 2);
  p.keysB = (u16*)take((size_t)2 * 16 * 16384 * 2);
  p.rgW = (u16*)take((size_t)2 * 16 * 4096 * 2);
  p.modpart = (float*)take((size_t)16 * 2 * 9 * 6144 * 4);
  p.mod = (float*)take((size_t)2 * 9 * 6144 * 4);
  p.hT = (float*)take((size_t)2 * 512 * 4096 * 4);
  p.hc = (float*)take((size_t)512 * 256 * 4);
  p.Kf = (float*)take((size_t)2 * 256 * 8192 * 8);
  p.xn = (u16*)take((size_t)NTOK * 1024 * 2);
  p.qk = (u16*)take((size_t)NTOK * 1024 * 2);
  p.mbuf = p.qk;
  p.vT = (u16*)take((size_t)8 * 512 * 4096 * 2);
  p.vTc = (u16*)take((size_t)8 * 512 * 256 * 2);
  p.hyT = (u16*)take((size_t)8 * 768 * 4096 * 2);
  p.hyTc = (u16*)take((size_t)8 * 768 * 256 * 2);
  p.rg = (u16*)take((size_t)NTOK * 512 * 2);
  p.ycat = (u16*)take((size_t)NTOK * 1024 * 2);
  p.Ub = (unsigned char*)p.ycat;
  p.Vb = p.Ub + (size_t)16384 * 512;
  p.agg = (float*)take((size_t)8 * 2 * (136 + 34) * 256 * 8);
  p.ybT = (u16*)take((size_t)8 * 256 * 4096 * 2);
  p.ctxs = (float*)take((size_t)2048 * 1024 * 4);
  p.g8 = (unsigned char*)p.vT;
  p.q = p.qk;
  p.topk = (unsigned*)((char*)p.qk + (size_t)NTOK * 2048 * 2);
  if (off > ws_size) {
    fprintf(stderr, "workspace too small: need %zu have %zu\n", off, ws_size);
    return;
  }
  static int grid_blocks = 0;
  if (!grid_blocks) {
    int dev = 0, cus = 0, per_cu = 0;
    (void)hipGetDevice(&dev);
    (void)hipDeviceGetAttribute(&cus, hipDeviceAttributeMultiprocessorCount, dev);
    (void)hipOccupancyMaxActiveBlocksPerMultiprocessor(&per_cu, fwd_megakernel, NTHR, 0);
    if (per_cu > 1) per_cu = 1;
    grid_blocks = cus * per_cu;
  }
  (void)hipMemsetAsync(p.counters, 0, 32768, stream);
  void* args[] = {&p};
  hipError_t e = hipLaunchCooperativeKernel((void*)fwd_megakernel, dim3(grid_blocks), dim3(NTHR), args, 0, stream);
  if (e != hipSuccess) fprintf(stderr, "cooperative launch failed: %s (grid %d)\n", hipGetErrorString(e), grid_blocks);
}
```

```cpp
#include <hip/hip_runtime.h>
#include <hip/hip_cooperative_groups.h>
#include <cstdio>
#include <cstring>
namespace cg = cooperative_groups;

typedef unsigned short u16;
typedef __attribute__((ext_vector_type(8))) short bf16x8;
typedef __attribute__((ext_vector_type(16))) float f32x16;
typedef __attribute__((ext_vector_type(2))) float f32x2;
typedef int i32x8 __attribute__((ext_vector_type(8)));

#define NLAT 32768
#define NTOK 34816
#define SMEM_BYTES 151552
#define NTHR 512
#ifndef DUP_1A
#define DUP_1A 1
#endif
#ifndef DUP_PREP
#define DUP_PREP 1
#endif
#ifndef DUP_2B
#define DUP_2B 1
#endif
#ifndef XRGA
#define XRGA 1
#endif
#ifndef REP_PEER
#define REP_PEER 1
#endif
#ifndef REP_INPROJ
#define REP_INPROJ 1
#endif
#ifndef REP_GATE
#define REP_GATE 1
#endif
#ifndef REP_BRANCH
#define REP_BRANCH 1
#endif
#ifndef REP_Q
#define REP_Q 1
#endif
#ifndef REP_SCORE
#define REP_SCORE 1
#endif
#ifndef REP_1A
#define REP_1A 1
#endif
#ifndef REP_2B
#define REP_2B 1
#endif
#ifndef REP_KF
#define REP_KF 1
#endif
#ifndef DUP_GEMM
#define DUP_GEMM 1
#endif
#ifndef DUP_PEER
#define DUP_PEER 1
#endif
#ifndef DUP_MIX
#define DUP_MIX 1
#endif
#ifndef XRG
#define XRG 1
#endif
#ifndef XFFT
#define XFFT 1
#endif
#ifndef XATT
#define XATT 1
#endif

struct P {
  const float *x, *c, *ctx, *c_ctx, *norm_mix_g, *norm_ffn_g, *w_ada, *b_ada, *w_in, *na_rpb,
      *hy_short_w, *hy_short_b, *hy_f1_w, *hy_f1_b, *hy_f2_w, *hy_f2_b, *hy_f3_w, *hy_freq, *hy_bias,
      *rg_conv_w, *rg_conv_b, *rg_wa, *rg_ba, *rg_wx, *rg_bx, *rg_lambda,
      *w_gate, *b_gate, *w_br_a, *w_br_b, *w_br_c, *w_out, *peer_wq, *peer_keys, *peer_u, *peer_v, *final_g;
  float* out;
  unsigned* counters;
  u16 *WinT, *WgT, *WaT, *WbT, *WcT, *WoT, *WqB, *WqkT, *keysB, *rgW;
  float *modpart, *mod, *hT, *hc;
  float* Kf;
  u16 *xn, *qk, *vT, *vTc, *hyT, *hyTc, *rg, *ycat, *mbuf, *ybT;
  unsigned char *Ub, *Vb, *g8, *xn8, *Win8, *Wg8;
  float *sa, *sw;
  u16* q;
  float *agg, *ctxs;
  u16* res;
  unsigned* topk;
};

__device__ __forceinline__ u16 f2bf(float f) {
  unsigned u = __float_as_uint(f);
  u += 0x7fffu + ((u >> 16) & 1u);
  return (u16)(u >> 16);
}
__device__ __forceinline__ float bf2f(u16 h) { return __uint_as_float(((unsigned)h) << 16); }
__device__ __forceinline__ unsigned pk2(float a, float b) { return (unsigned)f2bf(a) | ((unsigned)f2bf(b) << 16); }
__device__ __forceinline__ float bflo(unsigned u) { return __uint_as_float(u << 16); }
__device__ __forceinline__ float bfhi(unsigned u) { return __uint_as_float(u & 0xffff0000u); }
__device__ __forceinline__ int opaque_tid() {
  int t = threadIdx.x;
  asm volatile("" : "+v"(t));
  return t;
}
__device__ __forceinline__ int my_lane() { return opaque_tid() & 63; }
__device__ __forceinline__ float shx(float v, int o);
__device__ __forceinline__ float shf(float v, int src) { return __builtin_bit_cast(float, __builtin_amdgcn_ds_bpermute((src & 63) << 2, __builtin_bit_cast(int, v))); }
__device__ __forceinline__ unsigned shu(unsigned v, int src) { return (unsigned)__builtin_amdgcn_ds_bpermute((src & 63) << 2, (int)v); }
typedef unsigned u32x2_t __attribute__((ext_vector_type(2)));
template <int J> __device__ __forceinline__ unsigned xorl(unsigned v, int lane) {
  if constexpr (J == 1) return (unsigned)__builtin_amdgcn_mov_dpp((int)v, 0xB1, 0xF, 0xF, true);
  else if constexpr (J == 2) return (unsigned)__builtin_amdgcn_mov_dpp((int)v, 0x4E, 0xF, 0xF, true);
  else if constexpr (J == 4) {
    const unsigned a = (unsigned)__builtin_amdgcn_mov_dpp((int)v, 0x104, 0xF, 0xF, true);
    const unsigned b = (unsigned)__builtin_amdgcn_mov_dpp((int)v, 0x114, 0xF, 0xF, true);
    return (lane & 4) ? b : a;
  }
  else if constexpr (J == 8) return (unsigned)__builtin_amdgcn_mov_dpp((int)v, 0x128, 0xF, 0xF, true);
  else if constexpr (J == 16) { const u32x2_t r = __builtin_amdgcn_permlane16_swap(v, v, false, false); return (lane & 16) ? r.x : r.y; }
  else { const u32x2_t r = __builtin_amdgcn_permlane32_swap(v, v, false, false); return (lane & 32) ? r.x : r.y; }
}
template <int J> __device__ __forceinline__ float xorf(float v, int lane) { return __uint_as_float(xorl<J>(__float_as_uint(v), lane)); }
__device__ __forceinline__ float shx(float v, int o) {
  const int lane = my_lane();
  switch (o) {
    case 1: return xorf<1>(v, lane);
    case 2: return xorf<2>(v, lane);
    case 4: return xorf<4>(v, lane);
    case 8: return xorf<8>(v, lane);
    case 16: return xorf<16>(v, lane);
    case 32: return xorf<32>(v, lane);
    default: return __builtin_bit_cast(float, __builtin_amdgcn_ds_bpermute(((lane ^ o) << 2), __builtin_bit_cast(int, v)));
  }
}
__device__ __forceinline__ float wave_sum(float v) {
  const int lane = my_lane();
  v += xorf<32>(v, lane); v += xorf<16>(v, lane); v += xorf<8>(v, lane); v += xorf<4>(v, lane); v += xorf<2>(v, lane); v += xorf<1>(v, lane);
  return v;
}
__device__ __forceinline__ float wave_max(float v) {
  const int lane = my_lane();
  v = fmaxf(v, xorf<32>(v, lane)); v = fmaxf(v, xorf<16>(v, lane)); v = fmaxf(v, xorf<8>(v, lane));
  v = fmaxf(v, xorf<4>(v, lane)); v = fmaxf(v, xorf<2>(v, lane)); v = fmaxf(v, xorf<1>(v, lane));
  return v;
}
__device__ __forceinline__ float sigmoidf_(float x) { return __builtin_amdgcn_rcpf(1.0f + __expf(-x)); }
__device__ __forceinline__ float gelu_tanh(float x) {
  const float u2 = 1.5957691216057308f * (x + 0.044715f * x * x * x);
  return x * __builtin_amdgcn_rcpf(1.0f + __expf(-u2));
}
__device__ __forceinline__ f32x16 mfma32(bf16x8 a, bf16x8 b, f32x16 c) {
  return __builtin_amdgcn_mfma_f32_32x32x16_bf16(a, b, c, 0, 0, 0);
}
__device__ __forceinline__ f32x16 zero16() {
  f32x16 z;
#pragma unroll
  for (int i = 0; i < 16; ++i) z[i] = 0.f;
  return z;
}
__device__ __forceinline__ int swz128(int row, int ch) { return row * 128 + ((ch ^ ((row >> 1) & 7)) << 4); }
__device__ __forceinline__ int swz256(int row, int ch) { return row * 256 + ((ch ^ (row & 15)) << 4); }

struct c2 { float x, y; };
__device__ __forceinline__ c2 cadd(c2 a, c2 b) { return {a.x + b.x, a.y + b.y}; }
__device__ __forceinline__ c2 csub(c2 a, c2 b) { return {a.x - b.x, a.y - b.y}; }
__device__ __forceinline__ c2 cmul(c2 a, c2 b) { return {a.x * b.x - a.y * b.y, a.x * b.y + a.y * b.x}; }
__device__ __forceinline__ float c16(int i) {
  const float tb[16] = {1.0f, 0.9238795325112867f, 0.7071067811865476f, 0.3826834323650898f, 0.0f,
                        -0.3826834323650898f, -0.7071067811865476f, -0.9238795325112867f, -1.0f,
                        -0.9238795325112867f, -0.7071067811865476f, -0.3826834323650898f, 0.0f,
                        0.3826834323650898f, 0.7071067811865476f, 0.9238795325112867f};
  return tb[i & 15];
}
__device__ __forceinline__ float s16(int i) { return c16(i + 12); }
template <int R> __device__ __forceinline__ constexpr int brev(int k) {
  int r = 0;
  for (int b = 1, o = R >> 1; b < R; b <<= 1, o >>= 1)
    if (k & b) r |= o;
  return r;
}
template <int R> __device__ __forceinline__ void dft_reg(c2* v, float sgn) {
#pragma unroll
  for (int h = R / 2; h >= 1; h >>= 1) {
#pragma unroll
    for (int g = 0; g < R; g += 2 * h) {
#pragma unroll
      for (int j = 0; j < h; ++j) {
        c2 a = v[g + j], b = v[g + j + h];
        v[g + j] = cadd(a, b);
        c2 d = csub(a, b);
        const int ti = j * (16 / (2 * h));
        c2 w = {c16(ti), sgn * s16(ti)};
        v[g + j + h] = (j == 0) ? d : cmul(d, w);
      }
    }
  }
}
template <int R> __device__ __forceinline__ int fft_bfly(c2* v, int j, int Ns, float sgn) {
  const int k = j & (Ns - 1);
  const float f = sgn * (float)k / (float)(Ns * R);
#pragma unroll
  for (int r = 1; r < R; ++r) {
    float t = f * (float)r;
    c2 w = {__builtin_amdgcn_cosf(t), __builtin_amdgcn_sinf(t)};
    v[r] = cmul(v[r], w);
  }
  dft_reg<R>(v, sgn);
  return (j - k) * R + k;
}
template <int R> __device__ __forceinline__ void fft_pass(c2* buf, int Ns, float sgn) {
  constexpr int NBF = 8192 / R;
  constexpr int PER = NBF / NTHR;
  const int tid = opaque_tid();
  c2 v[PER][R];
#pragma unroll
  for (int i = 0; i < PER; ++i) {
    const int j = tid + NTHR * i;
#pragma unroll
    for (int r = 0; r < R; ++r) v[i][r] = buf[j + r * NBF];
  }
  __syncthreads();
#pragma unroll
  for (int i = 0; i < PER; ++i) {
    const int j = tid + NTHR * i;
    const int base = fft_bfly<R>(v[i], j, Ns, sgn);
#pragma unroll
    for (int r = 0; r < R; ++r) buf[base + r * Ns] = v[i][brev<R>(r)];
  }
  __syncthreads();
}
__device__ __forceinline__ void fft8192(c2* buf, float sgn) {
  fft_pass<8>(buf, 1, sgn);
  fft_pass<8>(buf, 8, sgn);
  fft_pass<8>(buf, 64, sgn);
  fft_pass<16>(buf, 512, sgn);
}

__device__ __forceinline__ void gemm_kloop(f32x16 (&acc)[2][2], const u16* __restrict__ A, int lda,
                                           const u16* __restrict__ B, int ldb, int K, char* smem) {
  const int tid = opaque_tid(), lane = tid & 63, wid = tid >> 6;
  const int wm = wid >> 1, wn = wid & 1;
  const int l31 = lane & 31, hh = lane >> 5;
  uint4 ra[4], rb[2];
  const int nk = K >> 6;
  const int srow = tid >> 3, sch = tid & 7;
  const char* Ab = (const char*)A;
  const char* Bb = (const char*)B;
  const unsigned aoff = (unsigned)(srow * lda + sch * 8) * 2u;
  const unsigned boff = (unsigned)(srow * ldb + sch * 8) * 2u;
  const unsigned astep = (unsigned)lda * 128u, bstep = (unsigned)ldb * 128u;
#pragma unroll
  for (int i = 0; i < 4; ++i) ra[i] = *(const uint4*)(Ab + (aoff + i * astep));
#pragma unroll
  for (int i = 0; i < 2; ++i) rb[i] = *(const uint4*)(Bb + (boff + i * bstep));
#pragma unroll
  for (int i = 0; i < 4; ++i) *(uint4*)(smem + swz128(srow + i * 64, sch)) = ra[i];
#pragma unroll
  for (int i = 0; i < 2; ++i) *(uint4*)(smem + 65536 + swz128(srow + i * 64, sch)) = rb[i];
  __syncthreads();
  for (int kt = 0; kt < nk; ++kt) {
    const bool more = (kt + 1 < nk);
    if (more) {
      const unsigned ko = (unsigned)(kt + 1) * 128u;
#pragma unroll
      for (int i = 0; i < 4; ++i) ra[i] = *(const uint4*)(Ab + (aoff + i * astep + ko));
#pragma unroll
      for (int i = 0; i < 2; ++i) rb[i] = *(const uint4*)(Bb + (boff + i * bstep + ko));
    }
    const char* as = smem + (kt & 1) * 32768;
    const char* bs = smem + 65536 + (kt & 1) * 16384;
    int lrow = l31;
    asm volatile("" : "+v"(lrow));
#pragma unroll
    for (int s = 0; s < 4; ++s) {
      bf16x8 af[2], bfr[2];
#pragma unroll
      for (int i = 0; i < 2; ++i) af[i] = *(const bf16x8*)(as + swz128(wm * 64 + i * 32 + lrow, s * 2 + hh));
#pragma unroll
      for (int j = 0; j < 2; ++j) bfr[j] = *(const bf16x8*)(bs + swz128(wn * 64 + j * 32 + lrow, s * 2 + hh));
#pragma unroll
      for (int i = 0; i < 2; ++i)
#pragma unroll
        for (int j = 0; j < 2; ++j) acc[i][j] = mfma32(af[i], bfr[j], acc[i][j]);
    }
    if (more) {
      char* an = smem + ((kt + 1) & 1) * 32768;
      char* bn = smem + 65536 + ((kt + 1) & 1) * 16384;
      int sr2 = srow;
      asm volatile("" : "+v"(sr2));
#pragma unroll
      for (int i = 0; i < 4; ++i) *(uint4*)(an + swz128(sr2 + i * 64, sch)) = ra[i];
#pragma unroll
      for (int i = 0; i < 2; ++i) *(uint4*)(bn + swz128(sr2 + i * 64, sch)) = rb[i];
    }
    __syncthreads();
  }
}
__device__ __forceinline__ void zero_acc(f32x16 (&acc)[2][2]) {
#pragma unroll
  for (int i = 0; i < 2; ++i)
#pragma unroll
    for (int j = 0; j < 2; ++j) acc[i][j] = zero16();
}
#define EPI_ROW(i, e) (wm * 64 + (i)*32 + ((e)&3) + 8 * ((e) >> 2) + 4 * hh)
#define EPI_COL(j) (wn * 64 + (j)*32 + l31)
#define EPI_VARS                                                    \
  const int tid = opaque_tid(), lane = tid & 63, wid = tid >> 6;     \
  const int wm = wid >> 1, wn = wid & 1, l31 = lane & 31, hh = lane >> 5; \
  (void)tid; (void)wm; (void)wn; (void)l31; (void)hh;


namespace pg8 {
__device__ __forceinline__ unsigned pkh(float a, float b) { unsigned r; asm("v_cvt_pk_bf16_f32 %0, %1, %2" : "=v"(r) : "v"(a), "v"(b)); return r; }
#define PG8_LAS __attribute__((address_space(3)))
typedef PG8_LAS unsigned char* PG8_LAS_T;
typedef float f32x4 __attribute__((ext_vector_type(4)));
typedef unsigned u32x4 __attribute__((ext_vector_type(4)));
typedef int i32x4 __attribute__((ext_vector_type(4)));
constexpr int BM = 256, BK = 64, HALF = 128, HTB = HALF * BK * 2, STAGE_BYTES = 8 * HTB, NXCD = 8, WGM = 8;
__device__ __forceinline__ int lds_byte(int r, int c) { const int st = (r >> 4) * 2 + (c >> 5), rr = r & 15, cc = c & 31, ob = rr * 64 + cc * 2; return st * 1024 + (ob ^ (((ob >> 9) & 1) << 5)); }
__device__ __forceinline__ void stage_rc(int b, int& R, int& C) { const int st = b / 1024, sb = b % 1024, swz = sb ^ (((sb >> 9) & 1) << 5); R = (st >> 1) * 16 + swz / 64; C = (st & 1) * 32 + (swz % 64) / 2; }
__device__ __forceinline__ int perm32(int rho) { const int n = rho >> 4, i = rho & 15; return 8 * (i >> 2) + 4 * n + (i & 3); }
struct Unit { int pm, pn; };
struct Gemm { const u16* A; const u16* Bt; int lda, ldb, K; };
struct Order {
  int nM, nN, nwg, G, c, skip_from, skip_by;
  __device__ __forceinline__ void init(int nM_, int nN_, int G_, int c_, int sf = 1 << 30, int sb = 0) { nM = nM_; nN = nN_; nwg = nM * nN; G = G_; c = c_; skip_from = sf; skip_by = sb; }
  __device__ __forceinline__ bool next(int i, Unit& u) const {
    const long L = (long)i * G + c; if (L >= nwg) return false;
    int wgid = (int)L; { const int q = nwg / NXCD, r = nwg % NXCD, xcd = wgid % NXCD, off = wgid / NXCD; wgid = (xcd < r ? xcd * (q + 1) : r * (q + 1) + (xcd - r) * q) + off; }
    const int nig = WGM * nN, gid = wgid / nig, fm = gid * WGM, gsz = (nM - fm) < WGM ? (nM - fm) : WGM;
    u.pm = fm + ((wgid % nig) % gsz); u.pn = (wgid % nig) / gsz;
    if (u.pn >= skip_from) u.pn += skip_by;
    return true;
  }
};
__device__ __forceinline__ f32x4 mma16(bf16x8 a, bf16x8 b, f32x4 c) { return __builtin_amdgcn_mfma_f32_16x16x32_bf16(a, b, c, 0, 0, 0); }
__device__ __forceinline__ i32x4 mma16(bf16x8 a, bf16x8 b, i32x4 c) { return __builtin_amdgcn_mfma_i32_16x16x64_i8(__builtin_bit_cast(i32x4, a), __builtin_bit_cast(i32x4, b), c, 0, 0, 0); }
template <class Epi>
__device__ __forceinline__ void gemm_phase(PG8_LAS unsigned char* lds, const Gemm g, const Order& S, const Epi& E) {
  const int tid = opaque_tid(), wid = __builtin_amdgcn_readfirstlane(tid >> 6), lane = tid & 63, wr = wid >> 2, wc = wid & 3, fr = lane & 15, fq = lane >> 4;
  const int K = g.K, nt = K / BK;
  unsigned voffA[2], voffB[2];
#pragma unroll
  for (int i = 0; i < 2; ++i) { int R, C; stage_rc(tid * 16 + i * 8192, R, C); const int Rb = Epi::PERM ? ((R & ~31) + perm32(R & 31)) : R;
    voffA[i] = (unsigned)(R * g.lda + C) * 2u; voffB[i] = (unsigned)(Rb * g.ldb + C) * 2u; }
  const size_t kstep = (size_t)(BK * 2);
  const size_t hstepA = (size_t)HALF * g.lda * 2, hstepB = (size_t)HALF * g.ldb * 2;
  const size_t tstepA = 2 * hstepA, tstepB = 2 * hstepB;
  const unsigned ldsw = (unsigned)wid * 1024u;
  const int aoff = lds_byte(wr * 64 + fr, fq * 8), boff = lds_byte(wc * 32 + fr, fq * 8);
#define PG8_SA(b, h) (((b) * 2 + (h)) * HTB)
#define PG8_SB(b, h) ((4 + (b) * 2 + (h)) * HTB)
#define PG8_STAGE(bufoff, gbase, voff) do { _Pragma("unroll") for (int _i = 0; _i < 2; ++_i) \
    __builtin_amdgcn_global_load_lds((const unsigned*)((const char*)(gbase) + (voff)[_i]), (PG8_LAS unsigned*)(lds + (bufoff) + ldsw + _i * 8192), 16, 0, 0); } while (0)
#define PG8_LDA(dst, b, h) do { _Pragma("unroll") for (int m = 0; m < 4; ++m) _Pragma("unroll") for (int k = 0; k < 2; ++k) dst[m][k] = *(const PG8_LAS bf16x8*)(lds + PG8_SA(b, h) + aoff + m * 2048 + k * 1024); } while (0)
#define PG8_LDB(dst, b, h) do { _Pragma("unroll") for (int n = 0; n < 2; ++n) _Pragma("unroll") for (int k = 0; k < 2; ++k) dst[n][k] = *(const PG8_LAS bf16x8*)(lds + PG8_SB(b, h) + boff + n * 2048 + k * 1024); } while (0)
#define PG8_MMA(ai, bj, At, Bt) do { __builtin_amdgcn_s_setprio(1); _Pragma("unroll") for (int m = 0; m < 4; ++m) _Pragma("unroll") for (int n = 0; n < 2; ++n) _Pragma("unroll") for (int k = 0; k < 2; ++k) \
    acc[ai][bj][m][n] = mma16(Bt[n][k], At[m][k], acc[ai][bj][m][n]); __builtin_amdgcn_s_setprio(0); } while (0)
#define PG8_WAIT_V(n) asm volatile("s_waitcnt vmcnt(" #n ")" ::: "memory")
#define PG8_WAIT_L(n) asm volatile("s_waitcnt lgkmcnt(" #n ")" ::: "memory")
#define PG8_BAR __builtin_amdgcn_s_barrier()
#define PG8_SCHED __builtin_amdgcn_sched_barrier(0)
  Unit cur, nxt; int ui = 0;
  if (!S.next(0, cur)) return;
  typedef typename Epi::acc_t acc_t;
  acc_t acc[2][2][4][2];
#pragma unroll
  for (int a = 0; a < 2; ++a)
#pragma unroll
    for (int b = 0; b < 2; ++b)
#pragma unroll
      for (int m = 0; m < 4; ++m)
#pragma unroll
        for (int n = 0; n < 2; ++n) acc[a][b][m][n] = (acc_t){0, 0, 0, 0};
  bf16x8 At[4][2], B0[2][2], B1[2][2];
  const char* cA = (const char*)g.A + (size_t)cur.pm * tstepA; const char* cB = (const char*)g.Bt + (size_t)cur.pn * tstepB;
  PG8_STAGE(PG8_SB(0, 0), cB, voffB); PG8_STAGE(PG8_SA(0, 0), cA, voffA); PG8_STAGE(PG8_SB(0, 1), cB + hstepB, voffB); PG8_STAGE(PG8_SA(0, 1), cA + hstepA, voffA);
  if (wr == 1) PG8_BAR;
  PG8_WAIT_V(4); PG8_BAR;
  PG8_STAGE(PG8_SB(1, 0), cB + kstep, voffB); PG8_STAGE(PG8_SA(1, 0), cA + kstep, voffA); PG8_STAGE(PG8_SB(1, 1), cB + hstepB + kstep, voffB);
  PG8_WAIT_V(6); PG8_BAR;
  for (;;) {
    const bool has_next = S.next(ui + 1, nxt);
    const char* nA = has_next ? (const char*)g.A + (size_t)nxt.pm * tstepA : cA; const char* nB = has_next ? (const char*)g.Bt + (size_t)nxt.pn * tstepB : cB;
    for (int t = 0; t < nt; t += 2) {
      const bool last = (t == nt - 2);
      const char* a1 = cA + (size_t)(t + 1) * kstep;
      const char* a2 = last ? nA : cA + (size_t)(t + 2) * kstep; const char* b2 = last ? nB : cB + (size_t)(t + 2) * kstep;
      const char* a3 = a2 + kstep; const char* b3 = b2 + kstep;
      PG8_LDB(B0, 0, 0); PG8_SCHED; PG8_LDA(At, 0, 0); PG8_STAGE(PG8_SA(1, 1), a1 + hstepA, voffA);
      PG8_WAIT_L(8); PG8_BAR; PG8_WAIT_L(0); PG8_MMA(0, 0, At, B0); PG8_BAR; PG8_SCHED;
      PG8_LDB(B1, 0, 1); PG8_STAGE(PG8_SB(0, 0), b2, voffB);
      PG8_BAR; PG8_WAIT_L(0); PG8_MMA(0, 1, At, B1); PG8_BAR;
      PG8_LDA(At, 0, 1); PG8_STAGE(PG8_SA(0, 0), a2, voffA);
      PG8_BAR; PG8_WAIT_L(0); PG8_MMA(1, 0, At, B0); PG8_BAR; PG8_SCHED;
      PG8_STAGE(PG8_SB(0, 1), b2 + hstepB, voffB);
      PG8_WAIT_V(6); PG8_BAR; PG8_MMA(1, 1, At, B1); PG8_BAR;
      PG8_LDB(B0, 1, 0); PG8_SCHED; PG8_LDA(At, 1, 0); PG8_STAGE(PG8_SA(0, 1), a2 + hstepA, voffA);
      PG8_WAIT_L(8); PG8_BAR; PG8_WAIT_L(0); PG8_MMA(0, 0, At, B0); PG8_BAR; PG8_SCHED;
      PG8_LDB(B1, 1, 1); PG8_STAGE(PG8_SB(1, 0), b3, voffB);
      PG8_BAR; PG8_WAIT_L(0); PG8_MMA(0, 1, At, B1); PG8_BAR;
      PG8_LDA(At, 1, 1); PG8_STAGE(PG8_SA(1, 0), a3, voffA);
      PG8_BAR; PG8_WAIT_L(0); PG8_MMA(1, 0, At, B0); PG8_BAR; PG8_SCHED;
      PG8_STAGE(PG8_SB(1, 1), b3 + hstepB, voffB);
      PG8_WAIT_V(6); PG8_BAR; PG8_MMA(1, 1, At, B1); PG8_BAR;
    }
    E(acc, cur, wr, wc, fr, fq);
    if (!has_next) break;
#pragma unroll
    for (int a = 0; a < 2; ++a)
#pragma unroll
      for (int b = 0; b < 2; ++b)
#pragma unroll
        for (int m = 0; m < 4; ++m)
#pragma unroll
          for (int n = 0; n < 2; ++n) acc[a][b][m][n] = (acc_t){0, 0, 0, 0};
    cur = nxt; cA = nA; cB = nB; ++ui;
  }
  PG8_WAIT_V(0);
  if (wr == 0) PG8_BAR;
  PG8_BAR;
#undef PG8_SA
#undef PG8_SB
#undef PG8_STAGE
#undef PG8_LDA
#undef PG8_LDB
#undef PG8_MMA
#undef PG8_WAIT_V
#undef PG8_WAIT_L
#undef PG8_BAR
#undef PG8_SCHED
}
typedef const f32x4 (&AccRef)[2][2][4][2];
typedef const i32x4 (&AccRefI)[2][2][4][2];
struct EpiInprojN {
  static constexpr bool PERM = true;
  typedef f32x4 acc_t;
  u16* qk; u16* rg;
  __device__ __forceinline__ void operator()(AccRef acc, const Unit& u, int wr, int wc, int fr, int fq) const {
    const int row0 = u.pm * BM + wr * 64 + fr;
    u16* base; int ld, colt;
    if (u.pn < 4) { base = qk; ld = 1024; colt = u.pn * 256; } else { base = rg; ld = 512; colt = (u.pn - 9) * 256; }
    const int col0 = colt + wc * 32 + 8 * fq;
#pragma unroll
    for (int ai = 0; ai < 2; ++ai)
#pragma unroll
      for (int m = 0; m < 4; ++m) {
        u16* rowp = base + (size_t)(row0 + ai * HALF + m * 16) * ld + col0;
#pragma unroll
        for (int bj = 0; bj < 2; ++bj) {
          const f32x4 v0 = acc[ai][bj][m][0], v1 = acc[ai][bj][m][1];
          u32x4 w; w.x = pkh(v0[0], v0[1]); w.y = pkh(v0[2], v0[3]); w.z = pkh(v1[0], v1[1]); w.w = pkh(v1[2], v1[3]);
          *(u32x4*)(rowp + bj * HALF) = w;
        }
      }
  }
};
struct EpiInprojT {
  static constexpr bool PERM = true;
  typedef f32x4 acc_t;
  u16 *vT, *vTc, *hyT, *hyTc;
  __device__ __forceinline__ void operator()(AccRef acc, const Unit& u, int wr, int wc, int fr, int fq) const {
    const bool isctx = (u.pn >= 128);
    const int b = isctx ? (u.pn - 128) : (u.pn >> 4);
    const int Lseg = isctx ? 256 : 4096, t0 = isctx ? 0 : (u.pn & 15) * 256;
    const bool isv = (u.pm < 2);
    const size_t boff = isv ? (isctx ? (size_t)16777216 : (size_t)0) : (isctx ? (size_t)(16777216 + 1048576 + 25165824) : (size_t)(16777216 + 1048576));
    u16* base = vT + boff;
    const int nc = isv ? 512 : 768;
    const int wrow0 = (isv ? u.pm : u.pm - 2) * BM + wr * 64 + fr;
    const int col0 = t0 + wc * 32 + 8 * fq;
#pragma unroll
    for (int ai = 0; ai < 2; ++ai)
#pragma unroll
      for (int m = 0; m < 4; ++m) {
        u16* rowp = base + ((size_t)(b * nc + wrow0 + ai * HALF + m * 16)) * Lseg + col0;
#pragma unroll
        for (int bj = 0; bj < 2; ++bj) {
          const f32x4 v0 = acc[ai][bj][m][0], v1 = acc[ai][bj][m][1];
          u32x4 w; w.x = pkh(v0[0], v0[1]); w.y = pkh(v0[2], v0[3]); w.z = pkh(v1[0], v1[1]); w.w = pkh(v1[2], v1[3]);
          *(u32x4*)(rowp + bj * HALF) = w;
        }
      }
  }
};
struct EpiGate {
  static constexpr bool PERM = true;
  typedef f32x4 acc_t;
  unsigned char* g8; const float* bias;
  __device__ __forceinline__ void operator()(AccRef acc, const Unit& u, int wr, int wc, int fr, int fq) const {
    const int row0 = u.pm * BM + wr * 64 + fr;
    const int col0 = u.pn * BM + wc * 32 + 8 * fq;
#pragma unroll
    for (int bj = 0; bj < 2; ++bj) {
      const f32x4 b0 = *(const f32x4*)(bias + col0 + bj * HALF), b1 = *(const f32x4*)(bias + col0 + bj * HALF + 4);
#pragma unroll
      for (int ai = 0; ai < 2; ++ai)
#pragma unroll
        for (int m = 0; m < 4; ++m) {
          const f32x4 v0 = acc[ai][bj][m][0] + b0, v1 = acc[ai][bj][m][1] + b1;
          unsigned w0 = 0, w1 = 0;
#pragma unroll
          for (int k = 0; k < 4; ++k) {
            w0 |= (unsigned)(sigmoidf_(v0[k]) * 255.0f + 0.5f) << (8 * k);
            w1 |= (unsigned)(sigmoidf_(v1[k]) * 255.0f + 0.5f) << (8 * k);
          }
          *(uint2*)(g8 + (size_t)(row0 + ai * HALF + m * 16) * 3072 + col0 + bj * HALF) = make_uint2(w0, w1);
        }
    }
  }
};
struct EpiBranch {
  static constexpr bool PERM = true;
  typedef f32x4 acc_t;
  u16* mbuf; const unsigned char* g8; int br;
  __device__ __forceinline__ void operator()(AccRef acc, const Unit& u, int wr, int wc, int fr, int fq) const {
    const int row0 = u.pm * BM + wr * 64 + fr;
    const int col0 = u.pn * BM + wc * 32 + 8 * fq;
    uint2 gq[2][2][2];
    u32x4 o[2][2][2];
#define EB_LOAD(G) do { _Pragma("unroll") for (int j = 0; j < 2; ++j) _Pragma("unroll") for (int bj = 0; bj < 2; ++bj) { \
      const size_t row = (size_t)(row0 + (((G) * 2 + j) >> 2) * HALF + (((G) * 2 + j) & 3) * 16); \
      gq[(G) & 1][j][bj] = *(const uint2*)(g8 + row * 3072 + br * 1024 + col0 + bj * HALF); \
      if (br != 0) o[(G) & 1][j][bj] = *(const u32x4*)(mbuf + row * 1024 + col0 + bj * HALF); } } while (0)
    EB_LOAD(0);
#pragma unroll
    for (int G = 0; G < 4; ++G) {
      if (G < 3) EB_LOAD(G + 1);
#pragma unroll
      for (int j = 0; j < 2; ++j) {
        const int ai = (G * 2 + j) >> 2, m = (G * 2 + j) & 3;
        const size_t row = (size_t)(row0 + ai * HALF + m * 16);
#pragma unroll
        for (int bj = 0; bj < 2; ++bj) {
          const uint2 g = gq[G & 1][j][bj];
          u16* mp = mbuf + row * 1024 + col0 + bj * HALF;
          const f32x4 v0 = acc[ai][bj][m][0], v1 = acc[ai][bj][m][1];
          float r[8];
          r[0] = (float)(g.x & 255u) * v0[0]; r[1] = (float)((g.x >> 8) & 255u) * v0[1];
          r[2] = (float)((g.x >> 16) & 255u) * v0[2]; r[3] = (float)(g.x >> 24) * v0[3];
          r[4] = (float)(g.y & 255u) * v1[0]; r[5] = (float)((g.y >> 8) & 255u) * v1[1];
          r[6] = (float)((g.y >> 16) & 255u) * v1[2]; r[7] = (float)(g.y >> 24) * v1[3];
          u32x4 w;
          if (br == 0) {
            w.x = pkh(r[0] * (1.f / 255.f), r[1] * (1.f / 255.f)); w.y = pkh(r[2] * (1.f / 255.f), r[3] * (1.f / 255.f));
            w.z = pkh(r[4] * (1.f / 255.f), r[5] * (1.f / 255.f)); w.w = pkh(r[6] * (1.f / 255.f), r[7] * (1.f / 255.f));
          } else {
            const u32x4 ov = o[G & 1][j][bj];
            w.x = pkh(bflo(ov.x) + r[0] * (1.f / 255.f), bfhi(ov.x) + r[1] * (1.f / 255.f));
            w.y = pkh(bflo(ov.y) + r[2] * (1.f / 255.f), bfhi(ov.y) + r[3] * (1.f / 255.f));
            w.z = pkh(bflo(ov.z) + r[4] * (1.f / 255.f), bfhi(ov.z) + r[5] * (1.f / 255.f));
            w.w = pkh(bflo(ov.w) + r[6] * (1.f / 255.f), bfhi(ov.w) + r[7] * (1.f / 255.f));
          }
          *(u32x4*)mp = w;
        }
      }
    }
#undef EB_LOAD
  }
};
template <bool SRC_F32>
struct EpiOutR {
  static constexpr bool PERM = true;
  typedef f32x4 acc_t;
  const float *xsrc, *csrc; u16* res; const float* modl;
  __device__ __forceinline__ void operator()(AccRef acc, const Unit& u, int wr, int wc, int fr, int fq) const {
    const bool isctx = (u.pm >= 128);
    const int bi = isctx ? 8 : (u.pm >> 4);
    const float* gatev = modl + ((size_t)bi * 6 + 2) * 1024;
    const int row0 = u.pm * BM + wr * 64 + fr, col0 = u.pn * BM + wc * 32 + 8 * fq;
    f32x4 gv[2][2];
#pragma unroll
    for (int bj = 0; bj < 2; ++bj) { gv[bj][0] = *(const f32x4*)(gatev + col0 + bj * HALF); gv[bj][1] = *(const f32x4*)(gatev + col0 + bj * HALF + 4); }
    if (SRC_F32) {
      const float* src = isctx ? (csrc - (size_t)NLAT * 1024) : xsrc;
#pragma unroll
      for (int G = 0; G < 4; ++G) {
        f32x4 sv[2][2][2];
#pragma unroll
        for (int j = 0; j < 2; ++j)
#pragma unroll
          for (int bj = 0; bj < 2; ++bj) {
            const float* sp = src + (size_t)(row0 + ((G * 2 + j) >> 2) * HALF + ((G * 2 + j) & 3) * 16) * 1024 + col0 + bj * HALF;
            sv[j][bj][0] = *(const f32x4*)sp; sv[j][bj][1] = *(const f32x4*)(sp + 4);
          }
#pragma unroll
        for (int j = 0; j < 2; ++j) {
          const int ai = (G * 2 + j) >> 2, m = (G * 2 + j) & 3;
#pragma unroll
          for (int bj = 0; bj < 2; ++bj) {
            const f32x4 o0 = sv[j][bj][0] + gv[bj][0] * acc[ai][bj][m][0], o1 = sv[j][bj][1] + gv[bj][1] * acc[ai][bj][m][1];
            u32x4 w;
            w.x = pkh(o0[0], o0[1]); w.y = pkh(o0[2], o0[3]); w.z = pkh(o1[0], o1[1]); w.w = pkh(o1[2], o1[3]);
            *(u32x4*)(res + (size_t)(row0 + ai * HALF + m * 16) * 1024 + col0 + bj * HALF) = w;
          }
        }
      }
    } else {
#pragma unroll
      for (int G = 0; G < 2; ++G) {
        u32x4 sv[4][2];
#pragma unroll
        for (int m = 0; m < 4; ++m)
#pragma unroll
          for (int bj = 0; bj < 2; ++bj) sv[m][bj] = *(const u32x4*)(res + (size_t)(row0 + G * HALF + m * 16) * 1024 + col0 + bj * HALF);
#pragma unroll
        for (int m = 0; m < 4; ++m)
#pragma unroll
          for (int bj = 0; bj < 2; ++bj) {
            const u32x4 r = sv[m][bj];
            const f32x4 a0 = acc[G][bj][m][0], a1 = acc[G][bj][m][1], g0 = gv[bj][0], g1 = gv[bj][1];
            u32x4 w;
            w.x = pkh(bflo(r.x) + g0[0] * a0[0], bfhi(r.x) + g0[1] * a0[1]); w.y = pkh(bflo(r.y) + g0[2] * a0[2], bfhi(r.y) + g0[3] * a0[3]);
            w.z = pkh(bflo(r.z) + g1[0] * a1[0], bfhi(r.z) + g1[1] * a1[1]); w.w = pkh(bflo(r.w) + g1[2] * a1[2], bfhi(r.w) + g1[3] * a1[3]);
            *(u32x4*)(res + (size_t)(row0 + G * HALF + m * 16) * 1024 + col0 + bj * HALF) = w;
          }
      }
    }
  }
};
struct EpiQ {
  static constexpr bool PERM = true;
  typedef f32x4 acc_t;
  u16* q;
  __device__ __forceinline__ void operator()(AccRef acc, const Unit& u, int wr, int wc, int fr, int fq) const {
    const int row0 = u.pm * BM + wr * 64 + fr;
    const int col0 = u.pn * BM + wc * 32 + 8 * fq;
#pragma unroll
    for (int ai = 0; ai < 2; ++ai)
#pragma unroll
      for (int m = 0; m < 4; ++m) {
        u16* rowp = q + (size_t)(row0 + ai * HALF + m * 16) * 2048 + col0;
#pragma unroll
        for (int bj = 0; bj < 2; ++bj) {
          const f32x4 v0 = acc[ai][bj][m][0], v1 = acc[ai][bj][m][1];
          u32x4 w;
          w.x = __builtin_bit_cast(unsigned, __builtin_amdgcn_cvt_pkrtz(v0[0], v0[1]));
          w.y = __builtin_bit_cast(unsigned, __builtin_amdgcn_cvt_pkrtz(v0[2], v0[3]));
          w.z = __builtin_bit_cast(unsigned, __builtin_amdgcn_cvt_pkrtz(v1[0], v1[1]));
          w.w = __builtin_bit_cast(unsigned, __builtin_amdgcn_cvt_pkrtz(v1[2], v1[3]));
          *(u32x4*)(rowp + bj * HALF) = w;
        }
      }
  }
};
struct EpiInprojN8 {
  static constexpr bool PERM = true;
  typedef i32x4 acc_t;
  u16* qk; u16* rg; const float* sa; const float* sw;
  __device__ __forceinline__ void operator()(AccRefI acc, const Unit& u, int wr, int wc, int fr, int fq) const {
    const int row0 = u.pm * BM + wr * 64 + fr;
    u16* base; int ld, colt;
    if (u.pn < 4) { base = qk; ld = 1024; colt = u.pn * 256; } else { base = rg; ld = 512; colt = (u.pn - 9) * 256; }
    const int col0 = colt + wc * 32 + 8 * fq;
    const int wcol0 = u.pn * 256 + wc * 32 + 8 * fq;
    float rs[8];
    f32x4 cs[2][2];
#pragma unroll
    for (int i = 0; i < 8; ++i) rs[i] = sa[row0 + (i >> 2) * HALF + (i & 3) * 16];
#pragma unroll
    for (int bj = 0; bj < 2; ++bj) { cs[bj][0] = *(const f32x4*)(sw + wcol0 + bj * HALF); cs[bj][1] = *(const f32x4*)(sw + wcol0 + bj * HALF + 4); }
#pragma unroll
    for (int bj = 0; bj < 2; ++bj) {
      const f32x4 c0 = cs[bj][0], c1 = cs[bj][1];
#pragma unroll
      for (int ai = 0; ai < 2; ++ai)
#pragma unroll
        for (int m = 0; m < 4; ++m) {
          const int row = row0 + ai * HALF + m * 16;
          const float r = rs[ai * 4 + m];
          const i32x4 a0 = acc[ai][bj][m][0], a1 = acc[ai][bj][m][1];
          u32x4 w;
          w.x = pkh((float)a0[0] * r * c0[0], (float)a0[1] * r * c0[1]); w.y = pkh((float)a0[2] * r * c0[2], (float)a0[3] * r * c0[3]);
          w.z = pkh((float)a1[0] * r * c1[0], (float)a1[1] * r * c1[1]); w.w = pkh((float)a1[2] * r * c1[2], (float)a1[3] * r * c1[3]);
          *(u32x4*)(base + (size_t)row * ld + col0 + bj * HALF) = w;
        }
    }
  }
};
struct EpiInprojT8 {
  static constexpr bool PERM = true;
  typedef i32x4 acc_t;
  u16* vT; const float* sa; const float* sw;
  __device__ __forceinline__ void operator()(AccRefI acc, const Unit& u, int wr, int wc, int fr, int fq) const {
    const bool isctx = (u.pn >= 128);
    const int b = isctx ? (u.pn - 128) : (u.pn >> 4);
    const int Lseg = isctx ? 256 : 4096, t0 = isctx ? 0 : (u.pn & 15) * 256;
    const bool isv = (u.pm < 2);
    const size_t boff = isv ? (isctx ? (size_t)16777216 : (size_t)0) : (isctx ? (size_t)(16777216 + 1048576 + 25165824) : (size_t)(16777216 + 1048576));
    u16* base = vT + boff;
    const int nc = isv ? 512 : 768;
    const int wrow0 = (isv ? u.pm : u.pm - 2) * BM + wr * 64 + fr;
    const int srow0 = u.pm * BM + wr * 64 + fr;
    const int col0 = t0 + wc * 32 + 8 * fq;
    const int tok0 = u.pn * BM + wc * 32 + 8 * fq;
    float rs[8];
    f32x4 cs[2][2];
#pragma unroll
    for (int i = 0; i < 8; ++i) rs[i] = sw[srow0 + (i >> 2) * HALF + (i & 3) * 16];
#pragma unroll
    for (int bj = 0; bj < 2; ++bj) { cs[bj][0] = *(const f32x4*)(sa + tok0 + bj * HALF); cs[bj][1] = *(const f32x4*)(sa + tok0 + bj * HALF + 4); }
#pragma unroll
    for (int bj = 0; bj < 2; ++bj) {
      const f32x4 c0 = cs[bj][0], c1 = cs[bj][1];
#pragma unroll
      for (int ai = 0; ai < 2; ++ai)
#pragma unroll
        for (int m = 0; m < 4; ++m) {
          const float r = rs[ai * 4 + m];
          const i32x4 a0 = acc[ai][bj][m][0], a1 = acc[ai][bj][m][1];
          u32x4 w;
          w.x = pkh((float)a0[0] * r * c0[0], (float)a0[1] * r * c0[1]); w.y = pkh((float)a0[2] * r * c0[2], (float)a0[3] * r * c0[3]);
          w.z = pkh((float)a1[0] * r * c1[0], (float)a1[1] * r * c1[1]); w.w = pkh((float)a1[2] * r * c1[2], (float)a1[3] * r * c1[3]);
          *(u32x4*)(base + ((size_t)(b * nc + wrow0 + ai * HALF + m * 16)) * Lseg + col0 + bj * HALF) = w;
        }
    }
  }
};
struct EpiGate8 {
  static constexpr bool PERM = true;
  typedef i32x4 acc_t;
  unsigned char* g8; const float* bias; const float* sa; const float* sw;
  __device__ __forceinline__ void operator()(AccRefI acc, const Unit& u, int wr, int wc, int fr, int fq) const {
    const int row0 = u.pm * BM + wr * 64 + fr;
    const int col0 = u.pn * BM + wc * 32 + 8 * fq;
    typedef float f32x2 __attribute__((ext_vector_type(2)));
    float rs[8];
    f32x4 bs[2][2], cs[2][2];
#pragma unroll
    for (int i = 0; i < 8; ++i) rs[i] = sa[row0 + (i >> 2) * HALF + (i & 3) * 16];
#pragma unroll
    for (int bj = 0; bj < 2; ++bj) {
      bs[bj][0] = *(const f32x4*)(bias + col0 + bj * HALF); bs[bj][1] = *(const f32x4*)(bias + col0 + bj * HALF + 4);
      cs[bj][0] = *(const f32x4*)(sw + col0 + bj * HALF); cs[bj][1] = *(const f32x4*)(sw + col0 + bj * HALF + 4);
    }
#pragma unroll
    for (int bj = 0; bj < 2; ++bj) {
      f32x2 cn[4], bn[4];
#pragma unroll
      for (int k = 0; k < 2; ++k) {
        cn[k] = (f32x2){cs[bj][0][2 * k], cs[bj][0][2 * k + 1]} * -1.4426950408889634f; cn[2 + k] = (f32x2){cs[bj][1][2 * k], cs[bj][1][2 * k + 1]} * -1.4426950408889634f;
        bn[k] = (f32x2){bs[bj][0][2 * k], bs[bj][0][2 * k + 1]} * -1.4426950408889634f; bn[2 + k] = (f32x2){bs[bj][1][2 * k], bs[bj][1][2 * k + 1]} * -1.4426950408889634f;
      }
#pragma unroll
      for (int ai = 0; ai < 2; ++ai)
#pragma unroll
        for (int m = 0; m < 4; ++m) {
          const int row = row0 + ai * HALF + m * 16;
          const float r = rs[ai * 4 + m];
          const i32x4 a0 = acc[ai][bj][m][0], a1 = acc[ai][bj][m][1];
          unsigned qb[8];
#pragma unroll
          for (int k = 0; k < 4; ++k) {
            const f32x2 av = (k < 2) ? (f32x2){(float)a0[2 * k], (float)a0[2 * k + 1]} : (f32x2){(float)a1[2 * k - 4], (float)a1[2 * k - 3]};
            const f32x2 z = __builtin_elementwise_fma(av * r, cn[k], bn[k]);
            const f32x2 d = (f32x2){__builtin_amdgcn_exp2f(z.x), __builtin_amdgcn_exp2f(z.y)} + 1.0f;
            const f32x2 sg = {__builtin_amdgcn_rcpf(d.x), __builtin_amdgcn_rcpf(d.y)};
            const f32x2 q = __builtin_elementwise_fma(sg, (f32x2){255.0f, 255.0f}, (f32x2){8388608.0f, 8388608.0f});
            const float qx = q.x, qy = q.y;
            qb[2 * k] = __float_as_uint(qx); qb[2 * k + 1] = __float_as_uint(qy);
          }
          unsigned p0, p1, p2, p3;
          asm("v_perm_b32 %0, %1, %2, %3" : "=v"(p0) : "v"(qb[1]), "v"(qb[0]), "s"(0x0c0c0400u));
          asm("v_perm_b32 %0, %1, %2, %3" : "=v"(p1) : "v"(qb[3]), "v"(qb[2]), "s"(0x04000c0cu));
          asm("v_perm_b32 %0, %1, %2, %3" : "=v"(p2) : "v"(qb[5]), "v"(qb[4]), "s"(0x0c0c0400u));
          asm("v_perm_b32 %0, %1, %2, %3" : "=v"(p3) : "v"(qb[7]), "v"(qb[6]), "s"(0x04000c0cu));
          const unsigned w0 = p0 | p1, w1 = p2 | p3;
          *(uint2*)(g8 + (size_t)row * 3072 + col0 + bj * HALF) = make_uint2(w0, w1);
        }
    }
  }
};
}

__device__ __forceinline__ void tr_tile(const float* __restrict__ src, int N, int K, u16* __restrict__ dst, int tile, char* smem) {
  float* lds = (float*)smem;
  const int tiles_n = N >> 6;
  const int tk = tile / tiles_n, tn = tile - tk * tiles_n;
  const int tid = opaque_tid();
  {
    const int r = tid >> 3, c8 = (tid & 7) * 8;
    const float* s = src + (size_t)(tk * 64 + r) * N + tn * 64 + c8;
    float4 a = *(const float4*)s, b = *(const float4*)(s + 4);
    float* d = lds + r * 65 + c8;
    d[0] = a.x; d[1] = a.y; d[2] = a.z; d[3] = a.w; d[4] = b.x; d[5] = b.y; d[6] = b.z; d[7] = b.w;
  }
  __syncthreads();
  {
    const int n = tid >> 3, k0 = (tid & 7) * 8;
    uint4 o;
    o.x = pk2(lds[(k0 + 0) * 65 + n], lds[(k0 + 1) * 65 + n]);
    o.y = pk2(lds[(k0 + 2) * 65 + n], lds[(k0 + 3) * 65 + n]);
    o.z = pk2(lds[(k0 + 4) * 65 + n], lds[(k0 + 5) * 65 + n]);
    o.w = pk2(lds[(k0 + 6) * 65 + n], lds[(k0 + 7) * 65 + n]);
    *(uint4*)(dst + (size_t)(tn * 64 + n) * K + tk * 64 + k0) = o;
  }
  __syncthreads();
}
__device__ __forceinline__ void colmax_task(const float* __restrict__ w, int N, int n0, float* __restrict__ swp, char* smem) {
  const int tid = opaque_tid();
  const int col = tid & 63, kg = tid >> 6;
  float m = 0.f;
  const float* wp = w + (size_t)(kg * 128) * N + n0 + col;
#pragma unroll 16
  for (int k = 0; k < 128; ++k) m = fmaxf(m, fabsf(wp[(size_t)k * N]));
  float* red = (float*)smem;
  red[kg * 64 + col] = m;
  __syncthreads();
  if (tid < 64) {
    float mm = red[tid];
#pragma unroll
    for (int g = 1; g < 8; ++g) mm = fmaxf(mm, red[g * 64 + tid]);
    swp[n0 + tid] = fmaxf(mm, 1e-20f) * (1.0f / 127.0f);
  }
  __syncthreads();
}
__device__ __forceinline__ void tr_tile_i8(const float* __restrict__ src, int N, int K, unsigned char* __restrict__ dst, int tile, const float* __restrict__ swp, char* smem) {
  float* lds = (float*)smem;
  const int tiles_n = N >> 6;
  const int tk = tile / tiles_n, tn = tile - tk * tiles_n;
  const int tid = opaque_tid();
  {
    const int r = tid >> 3, c8 = (tid & 7) * 8;
    const float* sp = src + (size_t)(tk * 64 + r) * N + tn * 64 + c8;
    float4 a = *(const float4*)sp, b = *(const float4*)(sp + 4);
    float* d = lds + r * 65 + c8;
    d[0] = a.x; d[1] = a.y; d[2] = a.z; d[3] = a.w; d[4] = b.x; d[5] = b.y; d[6] = b.z; d[7] = b.w;
  }
  __syncthreads();
  {
    const int n = tid >> 3, k0 = (tid & 7) * 8;
    const float inv = 1.0f / swp[tn * 64 + n];
    unsigned w0 = 0, w1 = 0;
#pragma unroll
    for (int i = 0; i < 4; ++i) {
      w0 |= ((unsigned)__float2int_rn(lds[(k0 + i) * 65 + n] * inv) & 255u) << (8 * i);
      w1 |= ((unsigned)__float2int_rn(lds[(k0 + 4 + i) * 65 + n] * inv) & 255u) << (8 * i);
    }
    *(uint2*)(dst + (size_t)(tn * 64 + n) * K + tk * 64 + k0) = make_uint2(w0, w1);
  }
  __syncthreads();
}
__device__ __forceinline__ void cvt_chunk(const float* __restrict__ src, u16* __restrict__ dst, size_t chunk) {
  const size_t i = chunk * 4096 + (size_t)opaque_tid() * 8;
  float4 a = *(const float4*)(src + i), b = *(const float4*)(src + i + 4);
  uint4 o;
  o.x = pk2(a.x, a.y); o.y = pk2(a.z, a.w); o.z = pk2(b.x, b.y); o.w = pk2(b.z, b.w);
  *(uint4*)(dst + i) = o;
}
template <bool I8>
__device__ __forceinline__ void tr_tile4(const float* __restrict__ src, int N, int K, void* __restrict__ dstv, int tile4, const float* __restrict__ swp, char* smem) {
  float* lds = (float*)smem;
  const int tiles_n = N >> 6;
  const int tkq = tile4 / tiles_n, tn = tile4 - tkq * tiles_n;
  const int tid = opaque_tid();
  {
    const int r = tid >> 3, c8 = (tid & 7) * 8;
    const float* sp = src + (size_t)(tkq * 256 + r) * N + tn * 64 + c8;
    float4 a[4], b[4];
#pragma unroll
    for (int q = 0; q < 4; ++q) { a[q] = *(const float4*)(sp + (size_t)q * 64 * N); b[q] = *(const float4*)(sp + (size_t)q * 64 * N + 4); }
#pragma unroll
    for (int q = 0; q < 4; ++q) {
      float* d = lds + q * 4160 + r * 65 + c8;
      d[0] = a[q].x; d[1] = a[q].y; d[2] = a[q].z; d[3] = a[q].w; d[4] = b[q].x; d[5] = b[q].y; d[6] = b[q].z; d[7] = b[q].w;
    }
  }
  __syncthreads();
  {
    const int n = tid >> 3, k0 = (tid & 7) * 8;
    if (I8) {
      const float inv = 1.0f / swp[tn * 64 + n];
      unsigned char* dst = (unsigned char*)dstv;
#pragma unroll
      for (int q = 0; q < 4; ++q) {
        const float* lq = lds + q * 4160;
        unsigned w0 = 0, w1 = 0;
#pragma unroll
        for (int i = 0; i < 4; ++i) {
          w0 |= ((unsigned)__float2int_rn(lq[(k0 + i) * 65 + n] * inv) & 255u) << (8 * i);
          w1 |= ((unsigned)__float2int_rn(lq[(k0 + 4 + i) * 65 + n] * inv) & 255u) << (8 * i);
        }
        *(uint2*)(dst + (size_t)(tn * 64 + n) * K + tkq * 256 + q * 64 + k0) = make_uint2(w0, w1);
      }
    } else {
      u16* dst = (u16*)dstv;
#pragma unroll
      for (int q = 0; q < 4; ++q) {
        const float* lq = lds + q * 4160;
        uint4 o;
        o.x = pk2(lq[(k0 + 0) * 65 + n], lq[(k0 + 1) * 65 + n]);
        o.y = pk2(lq[(k0 + 2) * 65 + n], lq[(k0 + 3) * 65 + n]);
        o.z = pk2(lq[(k0 + 4) * 65 + n], lq[(k0 + 5) * 65 + n]);
        o.w = pk2(lq[(k0 + 6) * 65 + n], lq[(k0 + 7) * 65 + n]);
        *(uint4*)(dst + (size_t)(tn * 64 + n) * K + tkq * 256 + q * 64 + k0) = o;
      }
    }
  }
  __syncthreads();
}
__device__ __forceinline__ void colmax4_task(const float* __restrict__ w, int N, int n0, float* __restrict__ swp, char* smem) {
  const int tid = opaque_tid();
  const int c4 = (tid & 15) * 4, rg = tid >> 4;
  const float* wp = w + (size_t)(rg * 32) * N + n0 + c4;
  float4 m = {0.f, 0.f, 0.f, 0.f};
#pragma unroll 16
  for (int k = 0; k < 32; ++k) {
    const float4 v = *(const float4*)(wp + (size_t)k * N);
    m.x = fmaxf(m.x, fabsf(v.x)); m.y = fmaxf(m.y, fabsf(v.y)); m.z = fmaxf(m.z, fabsf(v.z)); m.w = fmaxf(m.w, fabsf(v.w));
  }
  float* red = (float*)smem;
  *(float4*)(red + rg * 64 + c4) = m;
  __syncthreads();
  if (tid < 64) {
    float mm = red[tid];
#pragma unroll
    for (int g = 1; g < 32; ++g) mm = fmaxf(mm, red[g * 64 + tid]);
    swp[n0 + tid] = fmaxf(mm, 1e-20f) * (1.0f / 127.0f);
  }
  __syncthreads();
}
__device__ __forceinline__ void cvt_chunk4(const float* __restrict__ src, u16* __restrict__ dst, size_t chunk4) {
  const size_t i = chunk4 * 16384 + (size_t)opaque_tid() * 8;
  float4 a[4], b[4];
#pragma unroll
  for (int q = 0; q < 4; ++q) { a[q] = *(const float4*)(src + i + q * 4096); b[q] = *(const float4*)(src + i + q * 4096 + 4); }
#pragma unroll
  for (int q = 0; q < 4; ++q) {
    uint4 o;
    o.x = pk2(a[q].x, a[q].y); o.y = pk2(a[q].z, a[q].w); o.z = pk2(b[q].x, b[q].y); o.w = pk2(b[q].z, b[q].w);
    *(uint4*)(dst + i + q * 4096) = o;
  }
}
__device__ __forceinline__ void cvt_chunk_fp8(const float* __restrict__ src, unsigned char* __restrict__ dst, size_t chunk, float scale) {
  const size_t i = chunk * 4096 + (size_t)opaque_tid() * 8;
  const float4 a = *(const float4*)(src + i), b = *(const float4*)(src + i + 4);
  int w0 = __builtin_amdgcn_cvt_pk_fp8_f32(a.x * scale, a.y * scale, 0, false);
  w0 = __builtin_amdgcn_cvt_pk_fp8_f32(a.z * scale, a.w * scale, w0, true);
  int w1 = __builtin_amdgcn_cvt_pk_fp8_f32(b.x * scale, b.y * scale, 0, false);
  w1 = __builtin_amdgcn_cvt_pk_fp8_f32(b.z * scale, b.w * scale, w1, true);
  *(uint2*)(dst + i) = make_uint2((unsigned)w0, (unsigned)w1);
}
__device__ __forceinline__ void cvt_chunk_fp4(const float* __restrict__ src, unsigned char* __restrict__ dst, size_t chunk, float scale, int vhalf) {
  const size_t i = chunk * 4096 + (size_t)opaque_tid() * 8;
  const float4 a = *(const float4*)(src + i), b = *(const float4*)(src + i + 4);
  unsigned w = 0;
  w = __builtin_amdgcn_cvt_scalef32_pk_fp4_f32(w, a.x * scale, a.y * scale, 1.0f, 0);
  w = __builtin_amdgcn_cvt_scalef32_pk_fp4_f32(w, a.z * scale, a.w * scale, 1.0f, 1);
  w = __builtin_amdgcn_cvt_scalef32_pk_fp4_f32(w, b.x * scale, b.y * scale, 1.0f, 2);
  w = __builtin_amdgcn_cvt_scalef32_pk_fp4_f32(w, b.z * scale, b.w * scale, 1.0f, 3);
  const size_t e = i >> 10;
  const unsigned d = (unsigned)(i & 1023);
  *(unsigned*)(dst + e * 1024 + vhalf * 512 + (d >> 1)) = w;
}
__device__ __forceinline__ void cvt_chunk_fp4x8(const float* __restrict__ src, unsigned char* __restrict__ dst, int t0, int step, int tmax, float scale, int vhalf) {
  const int tid8 = opaque_tid() * 8;
  float4 a[8], b[8];
#pragma unroll
  for (int q = 0; q < 8; ++q) {
    const int t = t0 + q * step;
    const size_t i = (size_t)(t < tmax ? t : t0) * 4096 + tid8;
    a[q] = *(const float4*)(src + i); b[q] = *(const float4*)(src + i + 4);
  }
#pragma unroll
  for (int q = 0; q < 8; ++q) {
    const int t = t0 + q * step;
    if (t < tmax) {
      const size_t i = (size_t)t * 4096 + tid8;
      unsigned w = 0;
      w = __builtin_amdgcn_cvt_scalef32_pk_fp4_f32(w, a[q].x * scale, a[q].y * scale, 1.0f, 0);
      w = __builtin_amdgcn_cvt_scalef32_pk_fp4_f32(w, a[q].z * scale, a[q].w * scale, 1.0f, 1);
      w = __builtin_amdgcn_cvt_scalef32_pk_fp4_f32(w, b[q].x * scale, b[q].y * scale, 1.0f, 2);
      w = __builtin_amdgcn_cvt_scalef32_pk_fp4_f32(w, b[q].z * scale, b[q].w * scale, 1.0f, 3);
      const size_t e = i >> 10;
      const unsigned d = (unsigned)(i & 1023);
      *(unsigned*)(dst + e * 1024 + vhalf * 512 + (d >> 1)) = w;
    }
  }
}
__device__ __forceinline__ void phase_modreduce(const P& p) {
  const int n = 2 * 9 * 6144;
  for (int i = blockIdx.x * NTHR + opaque_tid(); i < n; i += gridDim.x * NTHR) {
    const int l = i / (9 * 6144);
    const int j = i % 6144;
    float s = p.b_ada[l * 6144 + j];
#pragma unroll
    for (int kc = 0; kc < 16; ++kc) s += p.modpart[(size_t)kc * n + i];
    p.mod[i] = s;
  }
}

__device__ __forceinline__ void phase_norm(const P& p, int l, int which) {
  const int tid_ = opaque_tid(); const int lane = tid_ & 63, wid = tid_ >> 6;
  const int ntok = (which == 2 || (which == 1 && l == 1)) ? NLAT : NTOK;
  float4 vn[4]; uint2 rn[4];
#define PN_LOAD(R) do { const int r_ = (R); if (which == 0) { const float* src_ = (r_ < NLAT) ? p.x + (size_t)r_ * 1024 : p.ctx + (size_t)(r_ - NLAT) * 1024; \
      _Pragma("unroll") for (int i = 0; i < 4; ++i) vn[i] = *(const float4*)(src_ + i * 256 + lane * 4); } \
    else { _Pragma("unroll") for (int i = 0; i < 4; ++i) rn[i] = *(const uint2*)(p.res + (size_t)r_ * 1024 + i * 256 + lane * 4); } } while (0)
  if (blockIdx.x * 8 + wid < ntok) PN_LOAD(blockIdx.x * 8 + wid);
  for (int row = blockIdx.x * 8 + wid; row < ntok; row += gridDim.x * 8) {
    float4 v[4];
    float ss = 0.f;
#pragma unroll
    for (int i = 0; i < 4; ++i) {
      if (which == 0) v[i] = vn[i]; else v[i] = make_float4(bflo(rn[i].x), bfhi(rn[i].x), bflo(rn[i].y), bfhi(rn[i].y));
      ss += v[i].x * v[i].x + v[i].y * v[i].y + v[i].z * v[i].z + v[i].w * v[i].w;
    }
    {
      const int nrow = row + gridDim.x * 8;
      if (nrow < ntok) PN_LOAD(nrow);
    }
    ss = wave_sum(ss);
    const float rstd = rsqrtf(ss * (1.0f / 1024.0f) + 1e-6f);
    if (which == 2) {
#pragma unroll
      for (int i = 0; i < 4; ++i) {
        const int col = i * 256 + lane * 4;
        const float4 g = *(const float4*)(p.final_g + col);
        float4 o = {v[i].x * rstd * g.x, v[i].y * rstd * g.y, v[i].z * rstd * g.z, v[i].w * rstd * g.w};
        *(float4*)(p.out + (size_t)row * 1024 + col) = o;
      }
    } else {
      const int bi = row < NLAT ? (row >> 12) : 8;
      const float* gam = (which == 0 ? p.norm_mix_g : p.norm_ffn_g) + l * 1024;
      const float* msh = p.mod + ((size_t)(l * 9 + bi) * 6 + (which == 0 ? 0 : 3)) * 1024;
      const float* msc = msh + 1024;
      float4 y[4];
      float amax = 0.f;
#pragma unroll
      for (int i = 0; i < 4; ++i) {
        const int col = i * 256 + lane * 4;
        const float4 g = *(const float4*)(gam + col);
        const float4 sh = *(const float4*)(msh + col);
        const float4 sc = *(const float4*)(msc + col);
        y[i].x = v[i].x * rstd * g.x * (1.f + sc.x) + sh.x; y[i].y = v[i].y * rstd * g.y * (1.f + sc.y) + sh.y;
        y[i].z = v[i].z * rstd * g.z * (1.f + sc.z) + sh.z; y[i].w = v[i].w * rstd * g.w * (1.f + sc.w) + sh.w;
        amax = fmaxf(amax, fmaxf(fmaxf(fabsf(y[i].x), fabsf(y[i].y)), fmaxf(fabsf(y[i].z), fabsf(y[i].w))));
      }
      if (which == 0) {
        amax = fmaxf(wave_max(amax), 1e-20f);
        const float inv = 127.0f / amax;
#pragma unroll
        for (int i = 0; i < 4; ++i) {
          const unsigned w = ((unsigned)__float2int_rn(y[i].x * inv) & 255u) | (((unsigned)__float2int_rn(y[i].y * inv) & 255u) << 8) |
                             (((unsigned)__float2int_rn(y[i].z * inv) & 255u) << 16) | (((unsigned)__float2int_rn(y[i].w * inv) & 255u) << 24);
          *(unsigned*)(p.xn8 + (size_t)row * 1024 + i * 256 + lane * 4) = w;
        }
        if (lane == 0) p.sa[row] = amax * (1.0f / 127.0f);
      } else {
#pragma unroll
        for (int i = 0; i < 4; ++i) {
          uint2 o;
          o.x = pk2(y[i].x, y[i].y);
          o.y = pk2(y[i].z, y[i].w);
          *(uint2*)(p.xn + (size_t)row * 1024 + i * 256 + lane * 4) = o;
        }
      }
    }
  }
}

__device__ __forceinline__ void filter_wave(const P& p, int l, int L, int t, float* __restrict__ outp) {
  const int lane = opaque_tid() & 63;
  const float tl = (float)t / (float)(L - 1);
  const float wang = (6.283185307179586f / (float)L) * (float)t;
  float z = 0.f;
  if (lane == 0) z = tl;
  else if (lane <= 16) { const float band = 1e-4f + (float)(lane - 1) * ((15.0f - 1e-4f) / 15.0f); z = cosf(band * wang); }
  else if (lane <= 32) { const float band = 1e-4f + (float)(lane - 17) * ((15.0f - 1e-4f) / 15.0f); z = -sinf(band * wang); }
  float a1 = p.hy_f1_b[l * 64 + lane];
  for (int i = 0; i < 33; ++i) a1 += shf(z, i) * p.hy_f1_w[(l * 33 + i) * 64 + lane];
  const float h1 = sinf(p.hy_freq[l * 128 + lane] * a1);
  float a2 = p.hy_f2_b[l * 64 + lane];
  for (int i = 0; i < 64; ++i) a2 += shf(h1, i) * p.hy_f2_w[(l * 64 + i) * 64 + lane];
  const float h2 = sinf(p.hy_freq[l * 128 + 64 + lane] * a2);
  float a3[8];
#pragma unroll
  for (int m = 0; m < 8; ++m) a3[m] = 0.f;
  for (int i = 0; i < 64; ++i) {
    const float hv = shf(h2, i);
    const float* wr = p.hy_f3_w + (size_t)(l * 64 + i) * 512 + lane;
#pragma unroll
    for (int m = 0; m < 8; ++m) a3[m] += hv * wr[m * 64];
  }
  const float LN100 = 4.605170185988092f;
  const float d0 = LN100 / 1.5f, d1 = LN100 / 0.3f;
#pragma unroll
  for (int m = 0; m < 8; ++m) {
    const int cp = lane + 64 * m;
    const int ch = cp & 255;
    const float delta = d0 + (float)ch * ((d1 - d0) / 255.0f);
    outp[(size_t)cp * L + t] = a3[m] * expf(-tl * delta);
  }
}
__device__ __forceinline__ void filter_block_task(const P& p, int l, int L, int t0, float* __restrict__ outp, char* smem) {
  const int tid = opaque_tid(), lane = tid & 63, wid = tid >> 6;
  float* W3s = (float*)smem;
  float* W2s = (float*)(smem + 131072);
  {
    const float4* s3 = (const float4*)(p.hy_f3_w + (size_t)l * 64 * 512);
    const float4* s2 = (const float4*)(p.hy_f2_w + (size_t)l * 64 * 64);
#pragma unroll
    for (int i = 0; i < 16; ++i) ((float4*)W3s)[tid + NTHR * i] = s3[tid + NTHR * i];
#pragma unroll
    for (int i = 0; i < 2; ++i) ((float4*)W2s)[tid + NTHR * i] = s2[tid + NTHR * i];
  }
  __syncthreads();
  float z[4], tl[4];
#pragma unroll
  for (int j = 0; j < 4; ++j) {
    const int t = t0 + wid * 4 + j;
    tl[j] = (float)t / (float)(L - 1);
    const float wang = (6.283185307179586f / (float)L) * (float)t;
    float zz = 0.f;
    if (lane == 0) zz = tl[j];
    else if (lane <= 16) { const float band = 1e-4f + (float)(lane - 1) * ((15.0f - 1e-4f) / 15.0f); zz = cosf(band * wang); }
    else if (lane <= 32) { const float band = 1e-4f + (float)(lane - 17) * ((15.0f - 1e-4f) / 15.0f); zz = -sinf(band * wang); }
    z[j] = zz;
  }
  float a1[4], a2[4];
  {
    const float b1 = p.hy_f1_b[l * 64 + lane];
#pragma unroll
    for (int j = 0; j < 4; ++j) a1[j] = b1;
#pragma unroll 11
    for (int i = 0; i < 33; ++i) {
      const float w = p.hy_f1_w[(l * 33 + i) * 64 + lane];
#pragma unroll
      for (int j = 0; j < 4; ++j) a1[j] += shf(z[j], i) * w;
    }
    const float f0 = p.hy_freq[l * 128 + lane];
#pragma unroll
    for (int j = 0; j < 4; ++j) a1[j] = sinf(f0 * a1[j]);
  }
  {
    const float b2 = p.hy_f2_b[l * 64 + lane];
#pragma unroll
    for (int j = 0; j < 4; ++j) a2[j] = b2;
#pragma unroll 8
    for (int i = 0; i < 64; ++i) {
      const float w = W2s[i * 64 + lane];
#pragma unroll
      for (int j = 0; j < 4; ++j) a2[j] += shf(a1[j], i) * w;
    }
    const float f1 = p.hy_freq[l * 128 + 64 + lane];
#pragma unroll
    for (int j = 0; j < 4; ++j) a2[j] = sinf(f1 * a2[j]);
  }
  float a3[4][8];
#pragma unroll
  for (int j = 0; j < 4; ++j)
#pragma unroll
    for (int m = 0; m < 8; ++m) a3[j][m] = 0.f;
#pragma unroll 4
  for (int i = 0; i < 64; ++i) {
    float w[8];
#pragma unroll
    for (int m = 0; m < 8; ++m) w[m] = W3s[i * 512 + lane + 64 * m];
#pragma unroll
    for (int j = 0; j < 4; ++j) {
      const float hv = shf(a2[j], i);
#pragma unroll
      for (int m = 0; m < 8; ++m) a3[j][m] += hv * w[m];
    }
  }
  const float LN100 = 4.605170185988092f;
  const float d0 = LN100 / 1.5f, d1 = LN100 / 0.3f;
#pragma unroll
  for (int m = 0; m < 8; ++m) {
    const int cp = lane + 64 * m;
    const float delta = d0 + (float)(cp & 255) * ((d1 - d0) / 255.0f);
    float4 o;
    o.x = a3[0][m] * expf(-tl[0] * delta); o.y = a3[1][m] * expf(-tl[1] * delta);
    o.z = a3[2][m] * expf(-tl[2] * delta); o.w = a3[3][m] * expf(-tl[3] * delta);
    *(float4*)(outp + (size_t)cp * L + t0 + wid * 4) = o;
  }
  __syncthreads();
}
__device__ __forceinline__ void phase_filters(const P& p, int l, char* smem) {
  const int ntask = 128 + (l == 0 ? 8 : 0);
  for (int t = blockIdx.x; t < ntask; t += gridDim.x) {
    if (t < 128) filter_block_task(p, l, 4096, t * 32, p.hT + (size_t)l * 512 * 4096, smem);
    else filter_block_task(p, l, 256, (t - 128) * 32, p.hc, smem);
  }
}
__device__ __forceinline__ void adaln_task(const P& p, int t, char* smem) {
  const int tid = opaque_tid();
  const int kc = t & 15; t >>= 4;
  const int jc = t % 12, l = t / 12;
  float* s = (float*)smem;
  float* red = (float*)(smem + 4096);
  for (int i = tid; i < 576; i += NTHR) {
    const int bi = i >> 6, kk = i & 63;
    const float v = (bi < 8) ? p.c[bi * 1024 + kc * 64 + kk] : p.c_ctx[kc * 64 + kk];
    s[i] = v / (1.0f + __expf(-v));
  }
  const int kq = tid >> 7, c4 = (tid & 127) * 4;
  const float* wp = p.w_ada + ((size_t)l * 1024 + kc * 64 + kq * 16) * 6144 + jc * 512 + c4;
  float4 w[16];
#pragma unroll
  for (int kk = 0; kk < 16; ++kk) w[kk] = *(const float4*)(wp + (size_t)kk * 6144);
  __syncthreads();
  float4 acc[9];
#pragma unroll
  for (int bi = 0; bi < 9; ++bi) acc[bi] = make_float4(0.f, 0.f, 0.f, 0.f);
#pragma unroll
  for (int kk = 0; kk < 16; ++kk) {
#pragma unroll
    for (int bi = 0; bi < 9; ++bi) {
      const float sv = s[bi * 64 + kq * 16 + kk];
      acc[bi].x += sv * w[kk].x; acc[bi].y += sv * w[kk].y; acc[bi].z += sv * w[kk].z; acc[bi].w += sv * w[kk].w;
    }
  }
#pragma unroll
  for (int bi = 0; bi < 9; ++bi) *(float4*)(red + (kq * 9 + bi) * 512 + c4) = acc[bi];
  __syncthreads();
#pragma unroll
  for (int bi = 0; bi < 9; ++bi) {
    const float v = red[bi * 512 + tid] + red[(9 + bi) * 512 + tid] + red[(18 + bi) * 512 + tid] + red[(27 + bi) * 512 + tid];
    p.modpart[((size_t)(kc * 2 + l) * 9 + bi) * 6144 + jc * 512 + tid] = v;
  }
  __syncthreads();
}
__device__ __forceinline__ void phase_prep(const P& p, char* smem, unsigned* counter) {
  volatile int* s_taskp = (volatile int*)(smem + SMEM_BYTES - 16);
  const int total = 264 + 184 + 384 + 544 + 32;
  int nxt = 0;
  if (threadIdx.x == 0) nxt = (int)atomicAdd(counter, 1u);
  for (;;) {
    __syncthreads();
    if (threadIdx.x == 0) *s_taskp = nxt;
    __syncthreads();
    int t = *s_taskp;
    if (t >= total) break;
    if (threadIdx.x == 0) nxt = (int)atomicAdd(counter, 1u);
    if (t < 264) {
      if (t < 128) filter_block_task(p, 0, 4096, t * 32, p.hT, smem);
      else if (t < 256) filter_block_task(p, 1, 4096, (t - 128) * 32, p.hT + (size_t)512 * 4096, smem);
      else filter_block_task(p, 0, 256, (t - 256) * 32, p.hc, smem);
      continue;
    }
    t -= 264;
    if (t < 184) {
      const int l = t / 92; t -= l * 92;
      if (t < 44) colmax4_task(p.w_in + (size_t)l * 1024 * 2816, 2816, t * 64, p.sw + l * 5888, smem);
      else colmax4_task(p.w_gate + (size_t)l * 1024 * 3072, 3072, (t - 44) * 64, p.sw + l * 5888 + 2816, smem);
      continue;
    }
    t -= 184;
    if (t < 384) { adaln_task(p, t, smem); continue; }
    t -= 384;
    if (t < 544) {
      const int l = t / 272; t -= l * 272;
      if (t < 32) tr_tile4<false>(p.w_br_a + (size_t)l * 512 * 1024, 1024, 512, p.WaT + (size_t)l * 1024 * 512, t, nullptr, smem);
      else if ((t -= 32) < 16) tr_tile4<false>(p.w_br_b + (size_t)l * 256 * 1024, 1024, 256, p.WbT + (size_t)l * 1024 * 256, t, nullptr, smem);
      else if ((t -= 16) < 16) tr_tile4<false>(p.w_br_c + (size_t)l * 256 * 1024, 1024, 256, p.WcT + (size_t)l * 1024 * 256, t, nullptr, smem);
      else if ((t -= 16) < 64) tr_tile4<false>(p.w_out + (size_t)l * 1024 * 1024, 1024, 1024, p.WoT + (size_t)l * 1024 * 1024, t, nullptr, smem);
      else if ((t -= 64) < 128) cvt_chunk4(p.peer_wq + (size_t)l * 1024 * 2048, p.WqB + (size_t)l * 1024 * 2048, (size_t)t);
      else {
        t -= 128;
        const int gate = t >> 3, dn = t & 7;
        const float* src = (gate ? p.rg_wx : p.rg_wa) + (size_t)(l * 8 + dn) * 4096;
        tr_tile(src, 64, 64, p.rgW + (size_t)((l * 2 + gate) * 8 + dn) * 4096, 0, smem);
      }
      continue;
    }
    t -= 544;
    cvt_chunk4(p.peer_keys, p.keysB, (size_t)t);
  }
}
__device__ __forceinline__ void kf_task(const P& p, int l, int c, char* smem) {
  const float* hTl = p.hT + (size_t)l * 512 * 4096;
  c2* buf = (c2*)smem;
  const int tid = opaque_tid();
  for (int i = 0; i < 16; ++i) {
    const int j = tid + NTHR * i;
    float v;
    if (j < 4096) v = hTl[(size_t)c * 4096 + j];
    else if (j == 4096) v = 0.f;
    else v = hTl[(size_t)(256 + c) * 4096 + (8192 - j)];
    buf[j] = {v, 0.f};
  }
  __syncthreads();
  fft8192(buf, -1.f);
  c2* o = (c2*)p.Kf + ((size_t)l * 256 + c) * 8192;
  for (int i = 0; i < 16; ++i) { const int j = tid + NTHR * i; o[j] = buf[j]; }
  __syncthreads();
}

__device__ __forceinline__ void inproj_tile(const P& p, int l, int mt, int nt, char* smem) {
  f32x16 acc[2][2];
  zero_acc(acc);
  const int m0 = mt * 256, n0 = nt * 128;
  gemm_kloop(acc, p.xn + (size_t)m0 * 1024, 1024, p.WinT + ((size_t)l * 2816 + n0) * 1024, 1024, 1024, smem);
  EPI_VARS
  if (nt < 8 || nt >= 18) {
    u16* dst; int ld, cbase;
    if (nt < 8) { dst = p.qk; ld = 1024; cbase = n0; }
    else { dst = p.rg; ld = 512; cbase = n0 - 2304; }
#pragma unroll
    for (int i = 0; i < 2; ++i)
#pragma unroll
      for (int j = 0; j < 2; ++j)
#pragma unroll
        for (int e = 0; e < 16; ++e)
          dst[(size_t)(m0 + EPI_ROW(i, e)) * ld + cbase + EPI_COL(j)] = f2bf(acc[i][j][e]);
  } else {
#pragma unroll
    for (int i = 0; i < 2; ++i)
#pragma unroll
      for (int j = 0; j < 2; ++j)
#pragma unroll
        for (int qd = 0; qd < 4; ++qd) {
          uint2 o;
          o.x = pk2(acc[i][j][4 * qd + 0], acc[i][j][4 * qd + 1]);
          o.y = pk2(acc[i][j][4 * qd + 2], acc[i][j][4 * qd + 3]);
          const int row0 = wm * 64 + i * 32 + 8 * qd + 4 * hh;
          *(uint2*)(smem + EPI_COL(j) * 520 + row0 * 2) = o;
        }
    __syncthreads();
    u16* dstT; int Lseg, t0, ncol0, nc;
    const bool isctx = (mt >= 128);
    const int b = isctx ? (mt - 128) : (mt >> 4);
    if (nt < 12) { ncol0 = n0 - 1024; nc = 512; dstT = isctx ? p.vTc : p.vT; }
    else { ncol0 = n0 - 1536; nc = 768; dstT = isctx ? p.hyTc : p.hyT; }
    if (isctx) { Lseg = 256; t0 = 0; } else { Lseg = 4096; t0 = (mt & 15) * 256; }
#pragma unroll 4
    for (int it = 0; it < 16; ++it) {
      const int idx = tid + NTHR * it;
      const int col = idx >> 6, u = idx & 63;
      const uint2 v = *(const uint2*)(smem + col * 520 + u * 8);
      *(uint2*)(dstT + ((size_t)(b * nc + ncol0 + col)) * Lseg + t0 + u * 4) = v;
    }
    __syncthreads();
  }
}

__device__ __forceinline__ float ldbf(const u16* p, int t, int L) { return (t >= 0 && t < L) ? bf2f(p[t]) : 0.f; }
__device__ __forceinline__ void ld10(const u16* __restrict__ seq, int t0, float (&v)[10]) {
  const uint4 r = *(const uint4*)(seq + t0);
  v[0] = (t0 > 0) ? bf2f(seq[t0 - 1]) : 0.f;
  v[9] = (t0 + 8 < 4096) ? bf2f(seq[t0 + 8]) : 0.f;
  v[1] = bflo(r.x); v[2] = bfhi(r.x); v[3] = bflo(r.y); v[4] = bfhi(r.y);
  v[5] = bflo(r.z); v[6] = bfhi(r.z); v[7] = bflo(r.w); v[8] = bfhi(r.w);
}
__device__ __forceinline__ void hyena_fft_task(const P& p, int l, int c, int bp, char* smem) {
  c2* buf = (c2*)smem;
  c2* ub = (c2*)(smem + 65536);
  const int tid = opaque_tid();
  const float* sw = p.hy_short_w + l * 3 * 768;
  const float* sb = p.hy_short_b + l * 768;
  const float wx0[3] = {sw[c], sw[768 + c], sw[1536 + c]};
  const float wx1[3] = {sw[256 + c], sw[768 + 256 + c], sw[1536 + 256 + c]};
  const float wv[3] = {sw[512 + c], sw[768 + 512 + c], sw[1536 + 512 + c]};
  const float bx0 = sb[c], bx1 = sb[256 + c], bv = sb[512 + c];
  const float dsk = p.hy_bias[l * 256 + c];
  const int t0 = tid * 8;
  {
    float u[2][8];
#pragma unroll
    for (int bb = 0; bb < 2; ++bb) {
      const int b = 2 * bp + bb;
      float x1[10], vv[10];
      ld10(p.hyT + ((size_t)(b * 768 + 256 + c)) * 4096, t0, x1);
      ld10(p.hyT + ((size_t)(b * 768 + 512 + c)) * 4096, t0, vv);
#pragma unroll
      for (int k = 0; k < 8; ++k) {
        const float x1c = bx1 + wx1[0] * x1[k] + wx1[1] * x1[k + 1] + wx1[2] * x1[k + 2];
        const float vc = bv + wv[0] * vv[k] + wv[1] * vv[k + 1] + wv[2] * vv[k + 2];
        u[bb][k] = vc * x1c;
      }
    }
#pragma unroll
    for (int k = 0; k < 8; k += 2) {
      const float4 w = make_float4(u[0][k], u[1][k], u[0][k + 1], u[1][k + 1]);
      *(float4*)(buf + t0 + k) = w;
      *(float4*)(ub + t0 + k) = w;
      *(float4*)(buf + 4096 + t0 + k) = make_float4(0.f, 0.f, 0.f, 0.f);
    }
  }
  __syncthreads();
  fft8192(buf, -1.f);
  const c2* kf = (const c2*)p.Kf + ((size_t)l * 256 + c) * 8192;
  for (int i = 0; i < 16; ++i) {
    const int k = tid + NTHR * i;
    buf[k] = cmul(buf[k], kf[k]);
  }
  __syncthreads();
  fft8192(buf, 1.f);
#pragma unroll
  for (int bb = 0; bb < 2; ++bb) {
    const int b = 2 * bp + bb;
    float x0[10];
    ld10(p.hyT + ((size_t)(b * 768 + c)) * 4096, t0, x0);
    float o[8];
#pragma unroll
    for (int k = 0; k < 8; ++k) {
      const c2 y = buf[t0 + k];
      const c2 uu = ub[t0 + k];
      const float x0c = bx0 + wx0[0] * x0[k] + wx0[1] * x0[k + 1] + wx0[2] * x0[k + 2];
      const float yy = ldexpf(bb ? y.y : y.x, -13);
      const float uv = bb ? uu.y : uu.x;
      o[k] = x0c * (yy + uv * dsk);
    }
    uint4 w; w.x = pk2(o[0], o[1]); w.y = pk2(o[2], o[3]); w.z = pk2(o[4], o[5]); w.w = pk2(o[6], o[7]);
    *(uint4*)(p.ybT + ((size_t)(b * 256 + c)) * 4096 + t0) = w;
  }
  __syncthreads();
}
__device__ __forceinline__ void yb_transpose_task(const P& p, int b, int tb, char* smem) {
  const int tid = opaque_tid(), lane = tid & 63, wid = tid >> 6;
  u16* T = (u16*)smem;
#pragma unroll
  for (int it = 0; it < 4; ++it) {
    const int id = tid + NTHR * it;
    const int c = id >> 3, ch = id & 7;
    const uint4 r = *(const uint4*)(p.ybT + ((size_t)(b * 256 + c)) * 4096 + tb * 64 + ch * 8);
    unsigned* d = (unsigned*)(T + c * 66 + ch * 8);
    d[0] = r.x; d[1] = r.y; d[2] = r.z; d[3] = r.w;
  }
  __syncthreads();
#pragma unroll
  for (int it = 0; it < 8; ++it) {
    const int tt = wid + 8 * it;
    const int c0 = lane * 4;
    uint2 w;
    w.x = (unsigned)T[(c0 + 0) * 66 + tt] | ((unsigned)T[(c0 + 1) * 66 + tt] << 16);
    w.y = (unsigned)T[(c0 + 2) * 66 + tt] | ((unsigned)T[(c0 + 3) * 66 + tt] << 16);
    *(uint2*)(p.ycat + (size_t)(b * 4096 + tb * 64 + tt) * 1024 + 512 + c0) = w;
  }
  __syncthreads();
}
__device__ __forceinline__ void hyena_ctx_task(const P& p, int l, int b, int cg8, char* smem) {
  const int tid_ = opaque_tid(); const int lane = tid_ & 63, wid = tid_ >> 6;
  const int c = cg8 * 8 + wid;
  float* us = (float*)smem + wid * 1024;
  float* kfp = us + 256 + 255;
  const float* sw = p.hy_short_w + l * 3 * 768;
  const float* sb = p.hy_short_b + l * 768;
  const u16* x0 = p.hyTc + ((size_t)(b * 768 + c)) * 256;
  const u16* x1 = p.hyTc + ((size_t)(b * 768 + 256 + c)) * 256;
  const u16* vv = p.hyTc + ((size_t)(b * 768 + 512 + c)) * 256;
  for (int i = 0; i < 4; ++i) {
    const int t = lane + 64 * i;
    const float x1c = sb[256 + c] + sw[256 + c] * ldbf(x1, t - 1, 256) + sw[768 + 256 + c] * ldbf(x1, t, 256) + sw[1536 + 256 + c] * ldbf(x1, t + 1, 256);
    const float vc = sb[512 + c] + sw[512 + c] * ldbf(vv, t - 1, 256) + sw[768 + 512 + c] * ldbf(vv, t, 256) + sw[1536 + 512 + c] * ldbf(vv, t + 1, 256);
    us[t] = vc * x1c;
    kfp[t] = p.hc[(size_t)c * 256 + t];
    if (t > 0) kfp[-t] = p.hc[(size_t)(256 + c) * 256 + t];
  }
  __syncthreads();
  const float dsk = p.hy_bias[l * 256 + c];
  float acc[4] = {0.f, 0.f, 0.f, 0.f};
  for (int s = 0; s < 256; ++s) {
    const float uv = us[s];
#pragma unroll
    for (int i = 0; i < 4; ++i) acc[i] += kfp[lane + 64 * i - s] * uv;
  }
#pragma unroll
  for (int i = 0; i < 4; ++i) {
    const int t = lane + 64 * i;
    const float x0c = sb[c] + sw[c] * ldbf(x0, t - 1, 256) + sw[768 + c] * ldbf(x0, t, 256) + sw[1536 + c] * ldbf(x0, t + 1, 256);
    p.ycat[(size_t)(NLAT + b * 256 + t) * 1024 + 512 + c] = f2bf(x0c * (acc[i] + us[t] * dsk));
  }
  __syncthreads();
}

template <int DIR>
__device__ __forceinline__ void rg_scan32(const float (&Av)[2][16], const float (&Bv)[2][16], float (&carry)[2], float (&H)[2][16], int hh) {
#pragma unroll
  for (int nt = 0; nt < 2; ++nt) {
    float c = carry[nt];
#pragma unroll
    for (int go = 0; go < 8; ++go) {
      const int g = DIR ? 7 - go : go, q = g >> 1, own = g & 1;
      float h = c;
#pragma unroll
      for (int io = 0; io < 4; ++io) {
        const int e = 4 * q + (DIR ? 3 - io : io);
        h = Av[nt][e] * h + Bv[nt][e];
        H[nt][e] = (hh == own) ? h : H[nt][e];
      }
      const float mine = (hh == own) ? h : c;
      const float other = shx(mine, 32);
      c = (hh == own) ? mine : other;
    }
    carry[nt] = c;
  }
}
__device__ __forceinline__ void rg_wave_task(const P& p, int l, int bq, int nblk, int mode, bool last, char* smem) {
  const int tid = opaque_tid(), lane = tid & 63, wid = tid >> 6;
  const int l31 = lane & 31, hh = lane >> 5;
  const int b = bq / 34, rr = bq - b * 34;
  const int seg = rr < 2 ? 0 : 1, blk = rr < 2 ? rr : rr - 2;
  if (mode == 1 && seg == 0 && last) return;
  const int ck = wid >> 1, dir = wid & 1;
  char* wreg = smem + wid * 17408;
  u16* xs = (u16*)wreg;
  char* xcb = wreg + 4608;
  float* xcf = (float*)(wreg + 8704);
  float2* blockagg = (float2*)(smem + 139264);
  const int Lseg = seg ? 4096 : 256;
  const int tokbase = seg ? b * 4096 : NLAT + b * 256;
  const int T0 = blk * 128 + ck * 32;
  const int cg32 = (seg ? 8 : 0) + blk * 4 + ck;
  uint4 xt[5];
#pragma unroll
  for (int i = 0; i < 5; ++i) {
    const int idx = lane + 64 * i;
    const int row = idx >> 3, chunk = idx & 7;
    xt[i] = make_uint4(0u, 0u, 0u, 0u);
    if (row < 35) {
      const int pos = T0 - 2 + row;
      if (pos >= 0 && pos < Lseg) xt[i] = *(const uint4*)(p.rg + (size_t)(tokbase + pos) * 512 + nblk * 64 + chunk * 8);
    }
  }
  const float cw0 = p.rg_conv_w[(l * 4 + 0) * 256 + nblk * 64 + lane], cw1 = p.rg_conv_w[(l * 4 + 1) * 256 + nblk * 64 + lane];
  const float cw2 = p.rg_conv_w[(l * 4 + 2) * 256 + nblk * 64 + lane], cw3 = p.rg_conv_w[(l * 4 + 3) * 256 + nblk * 64 + lane];
  const float ccb = p.rg_conv_b[l * 256 + nblk * 64 + lane];
  bf16x8 wf[2][2][4];
#pragma unroll
  for (int gate = 0; gate < 2; ++gate) {
    const u16* wp = p.rgW + (size_t)(((l * 2 + gate) * 2 + dir) * 4 + nblk) * 4096 + l31 * 64 + 8 * hh;
#pragma unroll
    for (int nt = 0; nt < 2; ++nt)
#pragma unroll
      for (int s = 0; s < 4; ++s) wf[gate][nt][s] = *(const bf16x8*)(wp + nt * 2048 + 16 * s);
  }
  float cba[2], cbx[2], csp[2];
#pragma unroll
  for (int nt = 0; nt < 2; ++nt) {
    const int ch = (l * 2 + dir) * 256 + nblk * 64 + nt * 32 + l31;
    cba[nt] = p.rg_ba[ch];
    cbx[nt] = p.rg_bx[ch];
    csp[nt] = p.rg_lambda[ch];
  }
  float2* agg1 = (float2*)p.agg;
  float2* agg2 = (float2*)p.agg + (size_t)8 * 2 * 136 * 256;
  const int pos2 = dir ? (seg == 0 ? 1 - blk : 33 - blk) : (seg == 0 ? blk : 2 + blk);
  float hin = 0.f;
  uint4 gq[2];
  if (mode == 1) {
    const float2* a2 = agg2 + ((size_t)(b * 2 + dir) * 34) * 256 + nblk * 64 + lane;
    const float2* a1 = agg1 + ((size_t)(b * 2 + dir) * 136 + (cg32 - ck)) * 256 + nblk * 64 + lane;
    const int npre = dir ? 3 - ck : ck;
    float2 ga[34], gb[3];
    const int pm1 = pos2 > 0 ? pos2 - 1 : 0;
#pragma unroll
    for (int j = 0; j < 34; ++j) ga[j] = a2[(size_t)(j < pm1 ? j : pm1) * 256];
#pragma unroll
    for (int i = 0; i < 3; ++i) { const int ii = i < npre ? i : 0; gb[i] = a1[(size_t)(dir ? 3 - ii : ii) * 256]; }
    {
      const int tok = 16 * dir + (lane >> 2), c16 = (lane & 3) * 16;
      const u16* gp = p.rg + ((size_t)tokbase + T0 + tok) * 512 + 256 + nblk * 64 + c16;
      gq[0] = *(const uint4*)gp; gq[1] = *(const uint4*)(gp + 8);
    }
#pragma unroll
    for (int j = 0; j < 34; ++j) hin = (j < pos2) ? ga[j].x * hin + ga[j].y : hin;
#pragma unroll
    for (int i = 0; i < 3; ++i) hin = (i < npre) ? gb[i].x * hin + gb[i].y : hin;
  }
#pragma unroll
  for (int nt = 0; nt < 2; ++nt) csp[nt] = __logf(1.0f + __expf(-csp[nt]));
#pragma unroll
  for (int i = 0; i < 5; ++i) {
    const int idx = lane + 64 * i;
    const int row = idx >> 3, chunk = idx & 7;
    if (row < 35) *(uint4*)(xs + row * 64 + chunk * 8) = xt[i];
  }
  asm volatile("s_waitcnt lgkmcnt(0)" ::: "memory");
  {
    float x0 = bf2f(xs[0 * 64 + lane]), x1 = bf2f(xs[1 * 64 + lane]), x2 = bf2f(xs[2 * 64 + lane]);
#pragma unroll
    for (int t = 0; t < 32; ++t) {
      const float x3 = bf2f(xs[(t + 3) * 64 + lane]);
      const float xc = ccb + cw0 * x0 + cw1 * x1 + cw2 * x2 + cw3 * x3;
      xcf[t * 68 + lane] = xc;
      *(u16*)(xcb + swz128(t, lane >> 3) + (lane & 7) * 2) = f2bf(xc);
      x0 = x1; x1 = x2; x2 = x3;
    }
  }
  asm volatile("s_waitcnt lgkmcnt(0)" ::: "memory");
  float Av[2][16], Bv[2][16];
  {
    f32x16 acc[2][2];
#pragma unroll
    for (int gate = 0; gate < 2; ++gate)
#pragma unroll
      for (int nt = 0; nt < 2; ++nt) acc[gate][nt] = zero16();
#pragma unroll
    for (int s = 0; s < 4; ++s) {
      const bf16x8 af = *(const bf16x8*)(xcb + swz128(l31, 2 * s + hh));
#pragma unroll
      for (int gate = 0; gate < 2; ++gate)
#pragma unroll
        for (int nt = 0; nt < 2; ++nt) acc[gate][nt] = mfma32(af, wf[gate][nt][s], acc[gate][nt]);
    }
#pragma unroll
    for (int nt = 0; nt < 2; ++nt)
#pragma unroll
      for (int e = 0; e < 16; ++e) {
        const int tok = (e & 3) + 8 * (e >> 2) + 4 * hh;
        const float r = sigmoidf_(acc[0][nt][e] + cba[nt]);
        const float ii = sigmoidf_(acc[1][nt][e] + cbx[nt]);
        const float la = -8.0f * r * csp[nt];
        const float av = __expf(la);
        const float e2 = 2.0f * la;
        const float om = (e2 > -0.1f) ? (-e2 * (1.0f + e2 * (0.5f + e2 * (0.16666667f + e2 * 0.041666668f)))) : (1.0f - __expf(e2));
        Av[nt][e] = av;
        Bv[nt][e] = sqrtf(om) * ii * xcf[tok * 68 + nt * 32 + l31];
      }
  }
  float H[2][16];
#pragma unroll
  for (int nt = 0; nt < 2; ++nt)
#pragma unroll
    for (int e = 0; e < 16; ++e) H[nt][e] = 0.f;
  float carry[2] = {0.f, 0.f};
  if (mode == 0) {
    if (dir) rg_scan32<1>(Av, Bv, carry, H, hh); else rg_scan32<0>(Av, Bv, carry, H, hh);
    float P[2];
#pragma unroll
    for (int nt = 0; nt < 2; ++nt) {
      float pr = 1.f;
#pragma unroll
      for (int e = 0; e < 16; ++e) pr *= Av[nt][e];
      P[nt] = pr * shx(pr, 32);
    }
    const float2 mine = make_float2(hh ? P[1] : P[0], hh ? carry[1] : carry[0]);
    agg1[((size_t)(b * 2 + dir) * 136 + cg32) * 256 + nblk * 64 + lane] = mine;
    blockagg[(ck * 2 + dir) * 64 + lane] = mine;
    __syncthreads();
    if (wid < 2) {
      const int d2 = wid;
      float A = 1.f, B = 0.f;
#pragma unroll
      for (int co = 0; co < 4; ++co) {
        const int c = d2 ? 3 - co : co;
        const float2 g = blockagg[(c * 2 + d2) * 64 + lane];
        B = g.x * B + g.y;
        A *= g.x;
      }
      const int p2 = d2 ? (seg == 0 ? 1 - blk : 33 - blk) : (seg == 0 ? blk : 2 + blk);
      agg2[((size_t)(b * 2 + d2) * 34 + p2) * 256 + nblk * 64 + lane] = make_float2(A, B);
    }
    __syncthreads();
    return;
  }
  carry[0] = shf(hin, l31);
  carry[1] = shf(hin, 32 + l31);
  if (dir) rg_scan32<1>(Av, Bv, carry, H, hh); else rg_scan32<0>(Av, Bv, carry, H, hh);
  asm volatile("s_waitcnt lgkmcnt(0)" ::: "memory");
#pragma unroll
  for (int nt = 0; nt < 2; ++nt)
#pragma unroll
    for (int e = 0; e < 16; ++e) xcf[((e & 3) + 8 * (e >> 2) + 4 * hh) * 68 + nt * 32 + l31] = H[nt][e];
  __syncthreads();
  {
    const float* hfT = (const float*)(smem + (ck * 2 + 0) * 17408 + 8704);
    const float* hbT = (const float*)(smem + (ck * 2 + 1) * 17408 + 8704);
    const int tok = 16 * dir + (lane >> 2), c16 = (lane & 3) * 16;
    const size_t gtok = (size_t)tokbase + T0 + tok;
    u16* op = p.ycat + gtok * 1024 + 768 + nblk * 64 + c16;
#pragma unroll
    for (int hv = 0; hv < 2; ++hv) {
      const uint4 g = gq[hv];
      const float4 f0 = *(const float4*)(hfT + tok * 68 + c16 + hv * 8), f1 = *(const float4*)(hfT + tok * 68 + c16 + hv * 8 + 4);
      const float4 h0 = *(const float4*)(hbT + tok * 68 + c16 + hv * 8), h1 = *(const float4*)(hbT + tok * 68 + c16 + hv * 8 + 4);
      uint4 o;
      o.x = pk2((f0.x + h0.x) * gelu_tanh(bflo(g.x)), (f0.y + h0.y) * gelu_tanh(bfhi(g.x)));
      o.y = pk2((f0.z + h0.z) * gelu_tanh(bflo(g.y)), (f0.w + h0.w) * gelu_tanh(bfhi(g.y)));
      o.z = pk2((f1.x + h1.x) * gelu_tanh(bflo(g.z)), (f1.y + h1.y) * gelu_tanh(bfhi(g.z)));
      o.w = pk2((f1.z + h1.z) * gelu_tanh(bflo(g.w)), (f1.w + h1.w) * gelu_tanh(bfhi(g.w)));
      *(uint4*)(op + hv * 8) = o;
    }
  }
  __syncthreads();
}

__device__ __forceinline__ void attn_wave(const P& p, int l, int b, int h, bool local, int r, int half, int qtok0, const float* rpbL) {
  const int lane = opaque_tid() & 63, q = lane & 31, hh = lane >> 5;
  bf16x8 qf[4];
  {
    const u16* qp = p.qk + (size_t)(qtok0 + q) * 1024 + h * 64 + 8 * hh;
#pragma unroll
    for (int s = 0; s < 4; ++s) qf[s] = *(const bf16x8*)(qp + 16 * s);
  }
  f32x16 o0 = zero16(), o1 = zero16();
  float m_run = -1e30f, l_run = 0.f;
  const int pi = (q & 19) | ((q & 4) << 1) | ((q & 8) >> 1);
  const int w = half * 32 + q;
  const int st = min(max(w - 8, 0), 48);
  const int rs = min(max(r - 4, 0), 56);
  const int ntiles = local ? 24 : 8;
  bf16x8 kfn[4], vfn[2][2];
  auto tile_load = [&](int ti, bf16x8 (&kfo)[4], bf16x8 (&vfo)[2][2]) {
    int ktok0, vstride;
    const u16* vb;
    if (ti < 8) {
      ktok0 = NLAT + b * 256 + ti * 32;
      vb = p.vTc + ((size_t)(b * 512 + h * 64)) * 256 + ti * 32;
      vstride = 256;
    } else {
      const int tl = ti - 8;
      const int a2 = tl >> 1, g2 = tl & 1;
      ktok0 = b * 4096 + (rs + a2) * 64 + g2 * 32;
      vb = p.vT + ((size_t)(b * 512 + h * 64)) * 4096 + (rs + a2) * 64 + g2 * 32;
      vstride = 4096;
    }
    const u16* kp = p.qk + (size_t)(ktok0 + pi) * 1024 + 512 + h * 64 + 8 * hh;
#pragma unroll
    for (int s = 0; s < 4; ++s) kfo[s] = *(const bf16x8*)(kp + 16 * s);
#pragma unroll
    for (int dt = 0; dt < 2; ++dt)
#pragma unroll
      for (int s2 = 0; s2 < 2; ++s2) vfo[dt][s2] = *(const bf16x8*)(vb + (size_t)(dt * 32 + q) * vstride + 16 * s2 + 8 * hh);
  };
  tile_load(0, kfn, vfn);
  for (int ti = 0; ti < ntiles; ++ti) {
    int a = 0, g = 0;
    if (ti >= 8) { a = (ti - 8) >> 1; g = (ti - 8) & 1; }
    bf16x8 kf[4], vf[2][2];
#pragma unroll
    for (int s = 0; s < 4; ++s) kf[s] = kfn[s];
#pragma unroll
    for (int dt = 0; dt < 2; ++dt)
#pragma unroll
      for (int s2 = 0; s2 < 2; ++s2) vf[dt][s2] = vfn[dt][s2];
    if (ti + 1 < ntiles) tile_load(ti + 1, kfn, vfn);
    f32x16 sacc = zero16();
#pragma unroll
    for (int s = 0; s < 4; ++s) sacc = mfma32(kf[s], qf[s], sacc);
    float sv[16];
    float tmax = -1e30f;
#pragma unroll
    for (int e = 0; e < 16; ++e) {
      float x = sacc[e] * 0.125f;
      if (ti >= 8) {
        const int kc = g * 32 + (e & 7) + 8 * hh + 16 * (e >> 3);
        const bool valid = (kc >= st) && (kc < st + 16);
        const int bi = valid ? ((rs + a - r + 7) * 31 + (kc - w + 15)) : 0;
        const float bias = rpbL[bi];
        x = valid ? (x + bias) : -1e30f;
      }
      sv[e] = x;
      tmax = fmaxf(tmax, x);
    }
    tmax = fmaxf(tmax, shx(tmax, 32));
    const float m_new = fmaxf(m_run, tmax);
    const float alpha = __expf(m_run - m_new);
    m_run = m_new;
    l_run *= alpha;
#pragma unroll
    for (int e = 0; e < 16; ++e) { o0[e] *= alpha; o1[e] *= alpha; }
    float psum = 0.f;
#pragma unroll
    for (int e = 0; e < 16; ++e) { const float pe = __expf(sv[e] - m_new); sv[e] = pe; psum += pe; }
    l_run += psum;
    bf16x8 pf[2];
#pragma unroll
    for (int s2 = 0; s2 < 2; ++s2) {
      union { bf16x8 v; unsigned u[4]; } cv;
#pragma unroll
      for (int j = 0; j < 4; ++j) cv.u[j] = pk2(sv[8 * s2 + 2 * j], sv[8 * s2 + 2 * j + 1]);
      pf[s2] = cv.v;
    }
#pragma unroll
    for (int s2 = 0; s2 < 2; ++s2) {
      o0 = mfma32(vf[0][s2], pf[s2], o0);
      o1 = mfma32(vf[1][s2], pf[s2], o1);
    }
  }
  const float lt = l_run + shx(l_run, 32);
  const float inv = 1.0f / lt;
  u16* op = p.ycat + (size_t)(qtok0 + q) * 1024 + h * 64;
#pragma unroll
  for (int qd = 0; qd < 4; ++qd) {
    uint2 a0, a1;
    a0.x = pk2(o0[4 * qd] * inv, o0[4 * qd + 1] * inv);
    a0.y = pk2(o0[4 * qd + 2] * inv, o0[4 * qd + 3] * inv);
    a1.x = pk2(o1[4 * qd] * inv, o1[4 * qd + 1] * inv);
    a1.y = pk2(o1[4 * qd + 2] * inv, o1[4 * qd + 3] * inv);
    *(uint2*)(op + 8 * qd + 4 * hh) = a0;
    *(uint2*)(op + 32 + 8 * qd + 4 * hh) = a1;
  }
}
__device__ __forceinline__ void attn_block_task(const P& p, int l, int b, int h, int rg4, char* smem) {
  const int tid = opaque_tid(), lane = tid & 63, wid = tid >> 6;
  const int q = lane & 31, hh = lane >> 5;
  const int R0 = rg4 * 4;
  const int r = R0 + (wid >> 1), half = wid & 1;
  float* rpbL = (float*)(smem + 32768) + 64;
  for (int i = tid; i < 465; i += NTHR) rpbL[i] = p.na_rpb[(size_t)(l * 8 + h) * 465 + i] * 1.4426950408889634f;
  const int lo = min(max(R0 - 4, 0), 56);
  const int hi = min(max(R0 + 3 - 4, 0), 56) + 7;
  const int ntile = 4 + (hi - lo + 1);
  const int rs = min(max(r - 4, 0), 56);
  const int qtok = b * 4096 + r * 64 + half * 32 + q;
  bf16x8 qf[4];
  {
    const u16* qp = p.qk + (size_t)qtok * 1024 + h * 64 + 8 * hh;
#pragma unroll
    for (int s = 0; s < 4; ++s) qf[s] = *(const bf16x8*)(qp + 16 * s);
  }
  f32x16 o0 = zero16(), o1 = zero16();
  float m_run = -1e30f, l_run = 0.f;
  const int pi = (q & 19) | ((q & 4) << 1) | ((q & 8) >> 1);
  const int w = half * 32 + q;
  const int st = min(max(w - 8, 0), 48);
  unsigned vmask = 0u;
#pragma unroll
  for (int g = 0; g < 2; ++g)
#pragma unroll
    for (int e = 0; e < 16; ++e) {
      const int kc = g * 32 + (e & 7) + 8 * hh + 16 * (e >> 3);
      vmask |= ((kc >= st) && (kc < st + 16)) ? (1u << (g * 16 + e)) : 0u;
    }
  const int cbase = 8 * hh - w + 15;
  const int srow = tid >> 3, sch = tid & 7;
  uint4 rkA, rvA, rkB, rvB;
  auto gload = [&](int ti, uint4& rk, uint4& rv) {
    int ktok0, vstride;
    const u16* vb;
    if (ti < 4) { ktok0 = NLAT + b * 256 + ti * 64; vb = p.vTc + ((size_t)(b * 512 + h * 64)) * 256 + ti * 64; vstride = 256; }
    else { const int R = lo + ti - 4; ktok0 = b * 4096 + R * 64; vb = p.vT + ((size_t)(b * 512 + h * 64)) * 4096 + R * 64; vstride = 4096; }
    rk = *(const uint4*)(p.qk + (size_t)(ktok0 + srow) * 1024 + 512 + h * 64 + sch * 8);
    rv = *(const uint4*)(vb + (size_t)srow * vstride + sch * 8);
  };
  gload(0, rkA, rvA);
  *(uint4*)(smem + swz128(srow, sch)) = rkA;
  *(uint4*)(smem + 16384 + swz128(srow, sch)) = rvA;
  gload(1, rkA, rvA);
  if (2 < ntile) gload(2, rkB, rvB);
  __syncthreads();
  auto compute = [&](int ti) {
    const char* Kb = smem + (ti & 1) * 8192;
    const char* Vb = smem + 16384 + (ti & 1) * 8192;
    const int R = lo + ti - 4;
    const bool active = (ti < 4) || (R >= rs && R < rs + 8);
    if (active) {
      f32x16 sacc0 = zero16(), sacc1 = zero16();
#pragma unroll
      for (int s = 0; s < 4; ++s) {
        const bf16x8 kf0 = *(const bf16x8*)(Kb + swz128(pi, 2 * s + hh));
        const bf16x8 kf1 = *(const bf16x8*)(Kb + swz128(32 + pi, 2 * s + hh));
        sacc0 = mfma32(kf0, qf[s], sacc0);
        sacc1 = mfma32(kf1, qf[s], sacc1);
      }
      float sv[32];
      float tmax = -1e30f;
      if (ti >= 4) {
        const float* brow = rpbL + (R - r + 7) * 31 + cbase;
        float bias[32];
#pragma unroll
        for (int g = 0; g < 2; ++g)
#pragma unroll
          for (int e = 0; e < 16; ++e) bias[g * 16 + e] = brow[g * 32 + (e & 7) + 16 * (e >> 3)];
#pragma unroll
        for (int g = 0; g < 2; ++g)
#pragma unroll
          for (int e = 0; e < 16; ++e) {
            const float sc = g ? sacc1[e] : sacc0[e];
            const float x = ((int)(vmask << (31 - (g * 16 + e))) < 0) ? fmaf(sc, 0.18033688011112042f, bias[g * 16 + e]) : -1e30f;
            sv[g * 16 + e] = x;
            tmax = fmaxf(tmax, x);
          }
      } else {
#pragma unroll
        for (int g = 0; g < 2; ++g)
#pragma unroll
          for (int e = 0; e < 16; ++e) {
            const float x = (g ? sacc1[e] : sacc0[e]) * 0.18033688011112042f;
            sv[g * 16 + e] = x;
            tmax = fmaxf(tmax, x);
          }
      }
      tmax = fmaxf(tmax, shx(tmax, 32));
      if (__builtin_amdgcn_ballot_w64(tmax > m_run) != 0ull) {
        const float m_new = fmaxf(m_run, tmax);
        const float alpha = __builtin_amdgcn_exp2f(m_run - m_new);
        m_run = m_new;
        l_run *= alpha;
#pragma unroll
        for (int e = 0; e < 16; ++e) { o0[e] *= alpha; o1[e] *= alpha; }
      }
      float psum = 0.f;
#pragma unroll
      for (int e = 0; e < 32; ++e) { const float pe = __builtin_amdgcn_exp2f(sv[e] - m_run); sv[e] = pe; psum += pe; }
      l_run += psum;
#pragma unroll
      for (int g = 0; g < 2; ++g)
#pragma unroll
        for (int s2 = 0; s2 < 2; ++s2) {
          union { bf16x8 v; unsigned u[4]; } cv;
#pragma unroll
          for (int j = 0; j < 4; ++j) cv.u[j] = pk2(sv[g * 16 + 8 * s2 + 2 * j], sv[g * 16 + 8 * s2 + 2 * j + 1]);
          const bf16x8 v0 = *(const bf16x8*)(Vb + swz128(q, g * 4 + 2 * s2 + hh));
          const bf16x8 v1 = *(const bf16x8*)(Vb + swz128(32 + q, g * 4 + 2 * s2 + hh));
          o0 = mfma32(v0, cv.v, o0);
          o1 = mfma32(v1, cv.v, o1);
        }
    }
  };
  for (int ti = 0; ti < ntile; ti += 2) {
    compute(ti);
    if (ti + 1 < ntile) {
      *(uint4*)(smem + 8192 + swz128(srow, sch)) = rkA;
      *(uint4*)(smem + 16384 + 8192 + swz128(srow, sch)) = rvA;
      if (ti + 3 < ntile) gload(ti + 3, rkA, rvA);
    }
    __syncthreads();
    if (ti + 1 < ntile) {
      compute(ti + 1);
      if (ti + 2 < ntile) {
        *(uint4*)(smem + swz128(srow, sch)) = rkB;
        *(uint4*)(smem + 16384 + swz128(srow, sch)) = rvB;
        if (ti + 4 < ntile) gload(ti + 4, rkB, rvB);
      }
      __syncthreads();
    }
  }
  const float lt = l_run + shx(l_run, 32);
  const float inv = 1.0f / lt;
  __syncthreads();
  {
    char* ot = smem + wid * 4608;
#pragma unroll
    for (int qd = 0; qd < 4; ++qd) {
      uint2 a0, a1;
      a0.x = pk2(o0[4 * qd] * inv, o0[4 * qd + 1] * inv);
      a0.y = pk2(o0[4 * qd + 2] * inv, o0[4 * qd + 3] * inv);
      a1.x = pk2(o1[4 * qd] * inv, o1[4 * qd + 1] * inv);
      a1.y = pk2(o1[4 * qd + 2] * inv, o1[4 * qd + 3] * inv);
      *(uint2*)(ot + q * 144 + (8 * qd + 4 * hh) * 2) = a0;
      *(uint2*)(ot + q * 144 + (32 + 8 * qd + 4 * hh) * 2) = a1;
    }
    asm volatile("s_waitcnt lgkmcnt(0)" ::: "memory");
    const int tok0 = b * 4096 + r * 64 + half * 32;
#pragma unroll
    for (int it = 0; it < 4; ++it) {
      const int qq = it * 8 + (lane >> 3), ch = lane & 7;
      const uint4 v = *(const uint4*)(ot + qq * 144 + ch * 16);
      *(uint4*)(p.ycat + (size_t)(tok0 + qq) * 1024 + h * 64 + ch * 8) = v;
    }
  }
  __syncthreads();
}
__device__ __forceinline__ void attn_task(const P& p, int l, int kind, int idx, char* smem) {
  const int tid_ = opaque_tid(); const int lane = tid_ & 63, wid = tid_ >> 6;
  float* rpbL = (float*)smem + wid * 480;
  for (int i = lane; i < 465; i += 64) rpbL[i] = p.na_rpb[(size_t)(l * 8 + wid) * 465 + i];
  __syncthreads();
  if (kind == 0) {
    const int half = idx & 1, r = (idx >> 1) & 63, b = idx >> 7;
    attn_wave(p, l, b, wid, true, r, half, b * 4096 + r * 64 + half * 32, rpbL);
  } else {
    const int qg = idx & 7, b = idx >> 3;
    attn_wave(p, l, b, wid, false, 0, 0, NLAT + b * 256 + qg * 32, rpbL);
  }
  __syncthreads();
}

__device__ __forceinline__ void phase_mixers(const P& p, int l, char* smem, unsigned* counter) {
  const bool last = (l == 1);
  const int n_rg = 1088 * XRGA, n_fft = 1024 * XFFT, n_hc = last ? 0 : 256, n_att = 1024 * XATT, n_attc = last ? 0 : 64;
  const int total = n_rg + n_fft + n_hc + n_att + n_attc;
  volatile int* s_taskp = (volatile int*)(smem + SMEM_BYTES - 16);
  for (;;) {
    __syncthreads();
    if (threadIdx.x == 0) *s_taskp = (int)atomicAdd(counter, 1u);
    __syncthreads();
    int t = *s_taskp;
    if (t >= total) break;
    if (t < n_att) { t &= 1023; attn_block_task(p, l, t >> 7, (t >> 4) & 7, t & 15, smem); continue; }
    t -= n_att;
    if (t < n_attc) { attn_task(p, l, 1, t, smem); continue; }
    t -= n_attc;
    if (t < n_fft) { t &= 1023; hyena_fft_task(p, l, t >> 2, t & 3, smem); continue; }
    t -= n_fft;
    if (t < n_hc) { hyena_ctx_task(p, l, t >> 5, t & 31, smem); continue; }
    t -= n_hc;
    if (t >= 1088) t -= 1088;
    rg_wave_task(p, l, t >> 2, t & 3, 0, last, smem);
  }
}

__device__ __forceinline__ void merge_tile(const P& p, int l, int mt, int nt, char* smem) {
  EPI_VARS
  const int m0 = mt * 256, n0 = nt * 128;
  f32x16 macc[2][2];
  zero_acc(macc);
  for (int br = 0; br < 3; ++br) {
    unsigned* gpl = (unsigned*)(smem + 98304) + tid;
    {
      f32x16 acc[2][2];
      zero_acc(acc);
      gemm_kloop(acc, p.xn + (size_t)m0 * 1024, 1024, p.WgT + ((size_t)l * 3072 + br * 1024 + n0) * 1024, 1024, 1024, smem);
#pragma unroll
      for (int j = 0; j < 2; ++j) {
        const float bg = p.b_gate[l * 3072 + br * 1024 + n0 + EPI_COL(j)];
#pragma unroll
        for (int i = 0; i < 2; ++i)
#pragma unroll
          for (int e = 0; e < 4; ++e) {
            const unsigned q0 = (unsigned)(sigmoidf_(acc[i][j][4 * e] + bg) * 255.0f + 0.5f);
            const unsigned q1 = (unsigned)(sigmoidf_(acc[i][j][4 * e + 1] + bg) * 255.0f + 0.5f);
            const unsigned q2 = (unsigned)(sigmoidf_(acc[i][j][4 * e + 2] + bg) * 255.0f + 0.5f);
            const unsigned q3 = (unsigned)(sigmoidf_(acc[i][j][4 * e + 3] + bg) * 255.0f + 0.5f);
            gpl[((i * 2 + j) * 4 + e) * 512] = q0 | (q1 << 8) | (q2 << 16) | (q3 << 24);
          }
      }
    }
    {
      f32x16 acc[2][2];
      zero_acc(acc);
      const u16* A; const u16* B; int K;
      if (br == 0) { A = p.ycat + (size_t)m0 * 1024; B = p.WaT + ((size_t)l * 1024 + n0) * 512; K = 512; }
      else if (br == 1) { A = p.ycat + (size_t)m0 * 1024 + 512; B = p.WbT + ((size_t)l * 1024 + n0) * 256; K = 256; }
      else { A = p.ycat + (size_t)m0 * 1024 + 768; B = p.WcT + ((size_t)l * 1024 + n0) * 256; K = 256; }
      gemm_kloop(acc, A, 1024, B, K, K, smem);
#pragma unroll
      for (int i = 0; i < 2; ++i)
#pragma unroll
        for (int j = 0; j < 2; ++j)
#pragma unroll
          for (int e = 0; e < 4; ++e) {
            const unsigned g4 = gpl[((i * 2 + j) * 4 + e) * 512];
            macc[i][j][4 * e] += (float)(g4 & 255u) * (1.0f / 255.0f) * acc[i][j][4 * e];
            macc[i][j][4 * e + 1] += (float)((g4 >> 8) & 255u) * (1.0f / 255.0f) * acc[i][j][4 * e + 1];
            macc[i][j][4 * e + 2] += (float)((g4 >> 16) & 255u) * (1.0f / 255.0f) * acc[i][j][4 * e + 2];
            macc[i][j][4 * e + 3] += (float)(g4 >> 24) * (1.0f / 255.0f) * acc[i][j][4 * e + 3];
          }
    }
  }
#pragma unroll
  for (int i = 0; i < 2; ++i)
#pragma unroll
    for (int j = 0; j < 2; ++j)
#pragma unroll
      for (int e = 0; e < 16; ++e)
        p.mbuf[(size_t)(m0 + EPI_ROW(i, e)) * 1024 + n0 + EPI_COL(j)] = f2bf(macc[i][j][e]);
}
__device__ __forceinline__ void outproj_tile(const P& p, int l, int mt, int nt, char* smem, bool do_store) {
  EPI_VARS
  const int m0 = mt * 256, n0 = nt * 128;
  f32x16 acc[2][2];
  zero_acc(acc);
  gemm_kloop(acc, p.mbuf + (size_t)m0 * 1024, 1024, p.WoT + ((size_t)l * 1024 + n0) * 1024, 1024, 1024, smem);
  const bool isctx = (mt >= 128);
  const int bi = isctx ? 8 : (mt >> 4);
  const float* gatev = p.mod + ((size_t)(l * 9 + bi) * 6 + 2) * 1024;
  const float* src; float* dst;
  if (isctx) { src = (l == 0 ? p.ctx : p.ctxs) - (size_t)NLAT * 1024; dst = p.ctxs - (size_t)NLAT * 1024; }
  else { src = (l == 0 ? p.x : p.out); dst = p.out; }
#pragma unroll
  for (int j = 0; j < 2; ++j) {
    const int col = n0 + EPI_COL(j);
    const float gv = gatev[col];
#pragma unroll
    for (int i = 0; i < 2; ++i)
#pragma unroll
      for (int e = 0; e < 16; ++e) {
        const size_t o = (size_t)(m0 + EPI_ROW(i, e)) * 1024 + col;
        if (do_store) dst[o] = src[o] + gv * acc[i][j][e];
      }
  }
}

__device__ __forceinline__ void wqk_task(const P& p, int l, int hp, int nt, char* smem) {
  EPI_VARS
  f32x16 acc[2][2];
  zero_acc(acc);
  gemm_kloop(acc, p.keysB + ((size_t)l * 16 + hp) * 16384, 128, p.WqB + (size_t)l * 1024 * 2048 + (size_t)(nt * 128) * 2048 + hp * 128, 2048, 128, smem);
  if (wm < 2) {
#pragma unroll
    for (int i = 0; i < 2; ++i)
#pragma unroll
      for (int j = 0; j < 2; ++j)
#pragma unroll
        for (int e = 0; e < 16; ++e)
          p.WqkT[((size_t)l * 2048 + hp * 128 + EPI_ROW(i, e)) * 1024 + nt * 128 + EPI_COL(j)] = f2bf(acc[i][j][e]);
  }
}
__device__ __forceinline__ void ins16(unsigned (&L)[16], unsigned x) {
#pragma unroll
  for (int i = 0; i < 16; ++i) {
    const unsigned hi = max(L[i], x);
    x = min(L[i], x);
    L[i] = hi;
  }
}
__device__ __forceinline__ unsigned f2sort(float f) {
  const unsigned b = __float_as_uint(f);
  return b ^ ((unsigned)((int)b >> 31) | 0x80000000u);
}
__device__ __forceinline__ float sort2f(unsigned k) {
  const unsigned u = k & ~127u;
  const unsigned b = (u & 0x80000000u) ? (u ^ 0x80000000u) : ~u;
  return __uint_as_float(b);
}
__device__ __forceinline__ void cx_desc(unsigned& a, unsigned& b) { const unsigned hi = max(a, b), lo = min(a, b); a = hi; b = lo; }
template <int BASE> __device__ __forceinline__ void sort16_desc(unsigned (&k)[64]) {
#pragma unroll
  for (int sz = 2; sz <= 16; sz <<= 1) {
#pragma unroll
    for (int j = sz >> 1; j >= 1; j >>= 1) {
#pragma unroll
      for (int i = 0; i < 16; ++i) {
        const int l2 = i ^ j;
        if (l2 > i) {
          if ((i & sz) == 0) cx_desc(k[BASE + i], k[BASE + l2]);
          else cx_desc(k[BASE + l2], k[BASE + i]);
        }
      }
    }
  }
}
template <int AB, int BB> __device__ __forceinline__ void merge16_desc(unsigned (&k)[64]) {
#pragma unroll
  for (int i = 0; i < 16; ++i) k[AB + i] = max(k[AB + i], k[BB + 15 - i]);
#pragma unroll
  for (int j = 8; j >= 1; j >>= 1) {
#pragma unroll
    for (int i = 0; i < 16; ++i)
      if ((i & j) == 0) cx_desc(k[AB + i], k[AB + i + j]);
  }
}
#define PS_LOAD(mt_, hp_) do { _Pragma("unroll") for (int it = 0; it < 8; ++it) { const int id = tid + NTHR * it; \
    pre[it] = *(const uint4*)(p.q + (size_t)((mt_) * 256 + (id >> 4)) * 2048 + (hp_) * 128 + (id & 15) * 8); } } while (0)
__device__ __forceinline__ void peer_score_tile(const P& p, int l, int mt, int hp, char* smem, uint4& p0, uint4& p1, uint4& p2, uint4& p3, uint4& p4, uint4& p5, uint4& p6, uint4& p7, int nmt, int nhp) {
  const int tid = opaque_tid();
  const int m0 = mt * 256;
  const int row = tid >> 1, hf = tid & 1;
  {
    char* T = smem + 16384;
    uint4 pre[8] = {p0, p1, p2, p3, p4, p5, p6, p7};
#pragma unroll
    for (int it = 0; it < 8; ++it) {
      const int id = tid + NTHR * it;
      const int r = id >> 4, ch = id & 15;
      *(uint4*)(T + r * 272 + ch * 16) = pre[it];
    }
    PS_LOAD(nmt, nhp);
    p0 = pre[0]; p1 = pre[1]; p2 = pre[2]; p3 = pre[3]; p4 = pre[4]; p5 = pre[5]; p6 = pre[6]; p7 = pre[7];
  }
  __syncthreads();
  const char* sp = smem + 16384 + row * 272 + hf * 128;
  unsigned k[64];
#pragma unroll
  for (int c = 0; c < 8; ++c) {
    const uint4 r = *(const uint4*)(sp + 16 * c);
    const unsigned w[4] = {r.x, r.y, r.z, r.w};
#pragma unroll
    for (int q = 0; q < 4; ++q) {
      const float v0 = __builtin_bit_cast(_Float16, (unsigned short)(w[q] & 0xffffu));
      const float v1 = __builtin_bit_cast(_Float16, (unsigned short)(w[q] >> 16));
      const int key = hf * 64 + c * 8 + q * 2;
      k[c * 8 + q * 2] = (f2sort(v0) & ~127u) | (unsigned)key;
      k[c * 8 + q * 2 + 1] = (f2sort(v1) & ~127u) | (unsigned)(key + 1);
    }
  }
  sort16_desc<0>(k); sort16_desc<16>(k); sort16_desc<32>(k); sort16_desc<48>(k);
  merge16_desc<0, 16>(k);
  merge16_desc<32, 48>(k);
  merge16_desc<0, 32>(k);
  unsigned* X = (unsigned*)smem;
  if (hf) {
#pragma unroll
    for (int i = 0; i < 16; ++i) X[row * 16 + i] = k[i];
  }
  __syncthreads();
  if (!hf) {
#pragma unroll
    for (int i = 0; i < 16; ++i) k[16 + i] = X[row * 16 + i];
    merge16_desc<0, 16>(k);
    unsigned* o = p.topk + ((size_t)(m0 + row) * 16 + hp) * 16;
#pragma unroll
    for (int i = 0; i < 4; ++i) *(uint4*)(o + 4 * i) = make_uint4(k[4 * i], k[4 * i + 1], k[4 * i + 2], k[4 * i + 3]);
  }
  __syncthreads();
}

__device__ __forceinline__ void phase_peer_experts(const P& p, int l, bool do_store, char* smem) {
  const int tid_ = opaque_tid(); const int lane = tid_ & 63, wid = tid_ >> 6;
  const int ntok = (l == 1) ? NLAT : NTOK;
  int ci, cj;
  {
    const int e = lane;
    if (e < 16) { ci = 0; cj = e; }
    else if (e < 24) { ci = 1; cj = e - 16; }
    else if (e < 29) { ci = 2; cj = e - 24; }
    else if (e < 33) { ci = 3; cj = e - 29; }
    else if (e < 36) { ci = 4; cj = e - 33; }
    else if (e < 38) { ci = 5; cj = e - 36; }
    else if (e < 40) { ci = 6; cj = e - 38; }
    else if (e < 42) { ci = 7; cj = e - 40; }
    else { ci = min(8 + (e - 42), 15); cj = 0; }
  }
  for (int tok = blockIdx.x * 8 + wid; tok < ntok; tok += gridDim.x * 8) {
    float xr[16];
    {
      const uint4 a = *(const uint4*)(p.xn + (size_t)tok * 1024 + lane * 16);
      const uint4 b = *(const uint4*)(p.xn + (size_t)tok * 1024 + lane * 16 + 8);
      xr[0] = bflo(a.x); xr[1] = bfhi(a.x); xr[2] = bflo(a.y); xr[3] = bfhi(a.y);
      xr[4] = bflo(a.z); xr[5] = bfhi(a.z); xr[6] = bflo(a.w); xr[7] = bfhi(a.w);
      xr[8] = bflo(b.x); xr[9] = bfhi(b.x); xr[10] = bflo(b.y); xr[11] = bfhi(b.y);
      xr[12] = bflo(b.z); xr[13] = bfhi(b.z); xr[14] = bflo(b.w); xr[15] = bfhi(b.w);
    }
    typedef _Float16 h2_t __attribute__((ext_vector_type(2)));
    h2_t yh[8];
#pragma unroll
    for (int i = 0; i < 8; ++i) yh[i] = (h2_t){(_Float16)0, (_Float16)0};
    int* selw = (int*)(smem + wid * 4096);
    const unsigned* kvp = p.topk + (size_t)tok * 256 + (lane & 31);
#pragma unroll 1
    for (int hb = 0; hb < 8; hb += 4) {
      unsigned key[4]; int eidx[4];
#pragma unroll
      for (int u = 0; u < 4; ++u) {
        const unsigned kv = kvp[(hb + u) * 32];
        const unsigned k0 = shu(kv, ci);
        const unsigned k1 = shu(kv, 16 + cj);
        const float val = (lane < 50) ? (sort2f(k0) + sort2f(k1)) : -3.0e38f;
        eidx[u] = (int)((k0 & 127u) * 128u + (k1 & 127u));
        key[u] = (f2sort(val) & ~63u) | (unsigned)lane;
      }
#pragma unroll
      for (int k = 2; k <= 64; k <<= 1) {
#pragma unroll
        for (int j = k >> 1; j >= 1; j >>= 1) {
          const bool take_max = (((lane & j) == 0) == ((lane & k) == 0));
#pragma unroll
          for (int u = 0; u < 4; ++u) {
            unsigned ok;
            if (j == 1) ok = xorl<1>(key[u], lane); else if (j == 2) ok = xorl<2>(key[u], lane); else if (j == 4) ok = xorl<4>(key[u], lane);
            else if (j == 8) ok = xorl<8>(key[u], lane); else if (j == 16) ok = xorl<16>(key[u], lane); else ok = xorl<32>(key[u], lane);
            key[u] = take_max ? max(key[u], ok) : min(key[u], ok);
          }
        }
      }
#pragma unroll
      for (int u = 0; u < 4; ++u) {
        const int si = __builtin_amdgcn_ds_bpermute((int)(key[u] & 63u) << 2, eidx[u]);
        const unsigned ku = key[u] & ~63u;
        const float sv = __uint_as_float((ku & 0x80000000u) ? (ku ^ 0x80000000u) : ~ku);
        const float mx = __builtin_bit_cast(float, __builtin_amdgcn_readlane(__builtin_bit_cast(int, sv), 0));
        const float ex = (lane < 16) ? __builtin_amdgcn_exp2f((sv - mx) * 1.4426950408889634f) : 0.f;
        const float sm = wave_sum(ex);
        selw[(hb + u) * 64 + lane] = si;
        selw[512 + (hb + u) * 64 + lane] = __builtin_bit_cast(int, ex * __builtin_amdgcn_rcpf(sm));
      }
    }
    {
      int w[4];
#pragma unroll
      for (int i = 0; i < 4; ++i) {
        int t = __builtin_amdgcn_cvt_pk_fp8_f32(xr[4 * i], xr[4 * i + 1], 0, false);
        w[i] = __builtin_amdgcn_cvt_pk_fp8_f32(xr[4 * i + 2], xr[4 * i + 3], t, true);
      }
      *(uint4*)(smem + 32768 + wid * 1024 + lane * 16) = make_uint4((unsigned)w[0], (unsigned)w[1], (unsigned)w[2], (unsigned)w[3]);
    }
    asm volatile("s_waitcnt lgkmcnt(0)" ::: "memory");
    const int e15 = lane & 15, g4 = lane >> 4;
#pragma unroll 1
    for (int h = 0; h < 8; ++h) {
      const int eperm_h = selw[h * 64 + lane];
      const int gperm_h = selw[512 + h * 64 + lane];
      const int ide = (int)shu((unsigned)eperm_h, e15);
      const unsigned char* ub = p.Ub + (size_t)ide * 1024 + g4 * 16;
      uint4 ua[8];
#pragma unroll
      for (int sI = 0; sI < 8; ++sI) ua[sI] = *(const uint4*)(ub + sI * 64);
      pg8::f32x4 hacc = {0.f, 0.f, 0.f, 0.f};
#pragma unroll
      for (int sI = 0; sI < 8; ++sI) {
        const uint4 b0 = *(const uint4*)(smem + 32768 + wid * 1024 + sI * 128 + g4 * 16);
        const uint4 b1 = *(const uint4*)(smem + 32768 + wid * 1024 + sI * 128 + 64 + g4 * 16);
        const i32x8 A = {(int)ua[sI].x, (int)ua[sI].y, (int)ua[sI].z, (int)ua[sI].w, 0, 0, 0, 0};
        const i32x8 B = {(int)b0.x, (int)b0.y, (int)b0.z, (int)b0.w, (int)b1.x, (int)b1.y, (int)b1.z, (int)b1.w};
        hacc = __builtin_amdgcn_mfma_scale_f32_16x16x128_f8f6f4(A, B, hacc, 4  , 0  , 0, 0x7f7f7f7f, 0, 0x7f7f7f7f);
      }
      asm volatile("" ::: "memory");
      uint2 V[16];
#pragma unroll
      for (int k = 0; k < 16; ++k) {
        const int id = __builtin_amdgcn_readlane(eperm_h, k);
        V[k] = *(const uint2*)(p.Ub + (size_t)id * 1024 + 512 + lane * 8);
      }
      float actv[4];
#pragma unroll
      for (int r4 = 0; r4 < 4; ++r4) {
        const float gl = __builtin_bit_cast(float, shu((unsigned)gperm_h, 4 * g4 + r4));
        actv[r4] = gelu_tanh(hacc[r4] * (1.0f / 64.0f)) * gl;
      }
#pragma unroll
      for (int k = 0; k < 16; ++k) {
        const float ak = __builtin_bit_cast(float, __builtin_amdgcn_readlane(__builtin_bit_cast(int, actv[k & 3]), 16 * (k >> 2)));
        const h2_t akh = {(_Float16)ak, (_Float16)ak};
        const unsigned vw[2] = {V[k].x, V[k].y};
#pragma unroll
        for (int q2 = 0; q2 < 2; ++q2) {
          yh[4 * q2 + 0] = __builtin_elementwise_fma(akh, __builtin_bit_cast(h2_t, __builtin_amdgcn_cvt_scalef32_pk_f16_fp4(vw[q2], 1.0f, 0)), yh[4 * q2 + 0]);
          yh[4 * q2 + 1] = __builtin_elementwise_fma(akh, __builtin_bit_cast(h2_t, __builtin_amdgcn_cvt_scalef32_pk_f16_fp4(vw[q2], 1.0f, 1)), yh[4 * q2 + 1]);
          yh[4 * q2 + 2] = __builtin_elementwise_fma(akh, __builtin_bit_cast(h2_t, __builtin_amdgcn_cvt_scalef32_pk_f16_fp4(vw[q2], 1.0f, 2)), yh[4 * q2 + 2]);
          yh[4 * q2 + 3] = __builtin_elementwise_fma(akh, __builtin_bit_cast(h2_t, __builtin_amdgcn_cvt_scalef32_pk_f16_fp4(vw[q2], 1.0f, 3)), yh[4 * q2 + 3]);
        }
      }
    }
    float yacc[16];
#pragma unroll
    for (int i = 0; i < 8; ++i) { yacc[2 * i] = (float)yh[i].x; yacc[2 * i + 1] = (float)yh[i].y; }
    const int bi = tok < NLAT ? (tok >> 12) : 8;
    const float* gv = p.mod + ((size_t)(l * 9 + bi) * 6 + 5) * 1024 + lane * 16;
    u16* rp = p.res + (size_t)tok * 1024 + lane * 16;
    float4 xv[4];
    float ss = 0.f;
    {
      const uint4 r0 = *(const uint4*)rp, r1 = *(const uint4*)(rp + 8);
      xv[0] = make_float4(bflo(r0.x), bfhi(r0.x), bflo(r0.y), bfhi(r0.y)); xv[1] = make_float4(bflo(r0.z), bfhi(r0.z), bflo(r0.w), bfhi(r0.w));
      xv[2] = make_float4(bflo(r1.x), bfhi(r1.x), bflo(r1.y), bfhi(r1.y)); xv[3] = make_float4(bflo(r1.z), bfhi(r1.z), bflo(r1.w), bfhi(r1.w));
    }
#pragma unroll
    for (int i = 0; i < 4; ++i) {
      const float4 g4 = *(const float4*)(gv + 4 * i);
      xv[i].x += g4.x * yacc[4 * i] * 0.25f; xv[i].y += g4.y * yacc[4 * i + 1] * 0.25f; xv[i].z += g4.z * yacc[4 * i + 2] * 0.25f; xv[i].w += g4.w * yacc[4 * i + 3] * 0.25f;
      ss += xv[i].x * xv[i].x + xv[i].y * xv[i].y + xv[i].z * xv[i].z + xv[i].w * xv[i].w;
    }
    ss = wave_sum(ss);
    const float rstd = rsqrtf(ss * (1.0f / 1024.0f) + 1e-6f);
    if (l == 0) {
      const float* gam = p.norm_mix_g + 1024 + lane * 16;
      const float* msh = p.mod + ((size_t)(9 + bi) * 6 + 0) * 1024 + lane * 16;
      const float* msc = msh + 1024;
      float yv[16];
      float amax = 0.f;
#pragma unroll
      for (int i = 0; i < 4; ++i) {
        const float4 g = *(const float4*)(gam + 4 * i);
        const float4 sh = *(const float4*)(msh + 4 * i);
        const float4 sc = *(const float4*)(msc + 4 * i);
        yv[4 * i] = xv[i].x * rstd * g.x * (1.f + sc.x) + sh.x; yv[4 * i + 1] = xv[i].y * rstd * g.y * (1.f + sc.y) + sh.y;
        yv[4 * i + 2] = xv[i].z * rstd * g.z * (1.f + sc.z) + sh.z; yv[4 * i + 3] = xv[i].w * rstd * g.w * (1.f + sc.w) + sh.w;
      }
#pragma unroll
      for (int i = 0; i < 16; ++i) amax = fmaxf(amax, fabsf(yv[i]));
      amax = fmaxf(wave_max(amax), 1e-20f);
      const float inv = 127.0f / amax;
      unsigned w[4];
#pragma unroll
      for (int i = 0; i < 4; ++i)
        w[i] = ((unsigned)__float2int_rn(yv[4 * i] * inv) & 255u) | (((unsigned)__float2int_rn(yv[4 * i + 1] * inv) & 255u) << 8) |
               (((unsigned)__float2int_rn(yv[4 * i + 2] * inv) & 255u) << 16) | (((unsigned)__float2int_rn(yv[4 * i + 3] * inv) & 255u) << 24);
      if (do_store) {
        *(uint4*)rp = make_uint4(pk2(xv[0].x, xv[0].y), pk2(xv[0].z, xv[0].w), pk2(xv[1].x, xv[1].y), pk2(xv[1].z, xv[1].w));
        *(uint4*)(rp + 8) = make_uint4(pk2(xv[2].x, xv[2].y), pk2(xv[2].z, xv[2].w), pk2(xv[3].x, xv[3].y), pk2(xv[3].z, xv[3].w));
        *(uint4*)(p.xn8 + (size_t)tok * 1024 + lane * 16) = make_uint4(w[0], w[1], w[2], w[3]);
        if (lane == 0) p.sa[tok] = amax * (1.0f / 127.0f);
      }
    } else {
      const float* fg = p.final_g + lane * 16;
      float4 gf[4];
#pragma unroll
      for (int i = 0; i < 4; ++i) gf[i] = *(const float4*)(fg + 4 * i);
#pragma unroll
      for (int i = 0; i < 4; ++i) {
        const float4 g = gf[i];
        const float4 o = make_float4(xv[i].x * rstd * g.x, xv[i].y * rstd * g.y, xv[i].z * rstd * g.z, xv[i].w * rstd * g.w);
        if (do_store) *(float4*)(p.out + (size_t)tok * 1024 + lane * 16 + 4 * i) = o;
      }
    }
  }
}


#define XB_TMO      128
#define XB_XCNT(j)  (256  + 64 * (j))
#define XB_XSUB(j)  (1280 + 64 * (j))
#define XB_XGEN(j)  (2304 + 64 * (j))
#define XB_TOP      3328
#define XB_TOPGEN   3392
#define XCD_BAR_WORDS 3456
#define XB_SPIN_CAP (1u << 22)
#define LAS __attribute__((address_space(3)))
__device__ __forceinline__ unsigned xb_ld(unsigned* p) { return __hip_atomic_load(p, __ATOMIC_RELAXED, __HIP_MEMORY_SCOPE_AGENT); }
__device__ __forceinline__ unsigned xb_add(unsigned* p, unsigned v) { return __hip_atomic_fetch_add(p, v, __ATOMIC_RELAXED, __HIP_MEMORY_SCOPE_AGENT); }
__device__ __forceinline__ unsigned xb_xcc_id() { return (unsigned)__builtin_amdgcn_s_getreg((3 << 11) | 20) & 0xFu; }
#define XB_SPIN(cond, bar) do { unsigned _sp = 0; while (cond) { __builtin_amdgcn_s_sleep(1); \
    if ((++_sp & 255u) == 0u) { if (xb_ld(&(bar)[XB_TMO])) break; if (_sp > XB_SPIN_CAP) { atomicAdd(&(bar)[XB_TMO], 1u); break; } } } } while (0)
struct XcdBarrier { unsigned* bar; unsigned x; volatile LAS unsigned* st; };
__device__ __forceinline__ XcdBarrier xcd_barrier_post(unsigned* bar, volatile LAS unsigned* st) {
  XcdBarrier b; b.bar = bar; b.x = xb_xcc_id(); b.st = st;
  if (threadIdx.x == 0) (void)xb_add(&bar[XB_XCNT(b.x)], 1u);
  return b;
}
__device__ __forceinline__ void xcd_barrier_complete(unsigned* bar, unsigned x, unsigned& nloc, unsigned& nx) {
  const unsigned G = gridDim.x * gridDim.y * gridDim.z;
  unsigned sum, cnt, mine, sp = 0u;
  for (;;) {
    sum = 0u; cnt = 0u; mine = 0u;
#pragma unroll
    for (unsigned j = 0; j < 16; ++j) { const unsigned c = xb_ld(&bar[XB_XCNT(j)]); sum += c; cnt += (c > 0u) ? 1u : 0u; mine = (j == x) ? c : mine; }
    if (sum == G) break;
    __builtin_amdgcn_s_sleep(1);
    if ((++sp & 255u) == 0u) { if (xb_ld(&bar[XB_TMO])) break; if (sp > XB_SPIN_CAP) { atomicAdd(&bar[XB_TMO], 1u); break; } }
  }
  nloc = mine > 0u ? mine : 1u; nx = cnt > 0u ? cnt : 1u;
}
__device__ __forceinline__ void xcd_barrier(unsigned* bar_u, volatile LAS unsigned* st_u) {
  XcdBarrier b; b.bar = bar_u; b.x = xb_xcc_id(); b.st = st_u;
  asm volatile("s_waitcnt vmcnt(0)" ::: "memory");
  __syncthreads();
  if (threadIdx.x == 0) {
    unsigned long long bp_ = (unsigned long long)b.bar;
    asm volatile("" : "+v"(bp_));
    unsigned* bar = (unsigned*)bp_;
    __builtin_amdgcn_s_waitcnt(0);
    unsigned nloc = b.st[0], nx = b.st[1];
    if (nloc == 0u) { xcd_barrier_complete(bar, b.x, nloc, nx); b.st[0] = nloc; b.st[1] = nx; }
    const unsigned old = xb_add(&bar[XB_XSUB(b.x)], 1u);
    const unsigned gen = old / nloc;
    if (old + 1u == (gen + 1u) * nloc) {
      __builtin_amdgcn_fence(__ATOMIC_RELEASE, "agent");
      asm volatile("s_waitcnt vmcnt(0)" ::: "memory");
      const unsigned og = xb_add(&bar[XB_TOP], 1u);
      const unsigned tg = og / nx;
      if (og + 1u == (tg + 1u) * nx) xb_add(&bar[XB_TOPGEN], 1u);
      else XB_SPIN(xb_ld(&bar[XB_TOPGEN]) == tg, bar);
      __builtin_amdgcn_fence(__ATOMIC_ACQUIRE, "agent");
      xb_add(&bar[XB_XGEN(b.x)], 1u);
      asm volatile("s_waitcnt vmcnt(0)" ::: "memory");
    } else {
      XB_SPIN(xb_ld(&bar[XB_XGEN(b.x)]) == gen, bar);
      __builtin_amdgcn_fence(__ATOMIC_ACQUIRE, "agent");
      asm volatile("s_waitcnt vmcnt(0)" ::: "memory");
    }
  }
  __syncthreads();
}

template <int l>
__device__ __forceinline__ void layer_body(const P& p, char* smem, pg8::PG8_LAS_T lds, volatile LAS unsigned* xbw, const int nb, const int bid) {
    const bool last = (l == 1);
    const int n_mt = last ? 128 : 136;
    if (l == 0) {
      phase_norm(p, l, 0);
      xcd_barrier(p.counters + 1024, xbw);
    }
_Pragma("unroll 1")
    for (int rep = 0; rep < REP_INPROJ; ++rep) {
      pg8::Gemm g; pg8::Order S;
      g.A = (const u16*)p.xn8; g.Bt = (const u16*)(p.Win8 + (size_t)l * 2816 * 1024); g.lda = 512; g.ldb = 512; g.K = 512;
      S.init(136, 6, nb, bid, 4, 5);
      pg8::EpiInprojN8 e1; e1.qk = p.qk; e1.rg = p.rg; e1.sa = p.sa; e1.sw = p.sw + l * 5888;
      pg8::gemm_phase(lds, g, S, e1);
      g.A = (const u16*)(p.Win8 + ((size_t)l * 2816 + 1024) * 1024); g.Bt = (const u16*)p.xn8;
      S.init(5, 136, nb, (bid + nb - (136 * 6) % nb) % nb);
      pg8::EpiInprojT8 e2; e2.vT = p.vT; e2.sa = p.sa; e2.sw = p.sw + l * 5888 + 1024;
      pg8::gemm_phase(lds, g, S, e2);
    }
    xcd_barrier(p.counters + 1024, xbw);
    phase_mixers(p, l, smem, p.counters + l * 4);
    xcd_barrier(p.counters + 1024, xbw);
_Pragma("unroll 1")
    for (int rep = 0; rep < REP_2B; ++rep)
      for (int task = bid; task < 1088 + 512; task += nb) {
        if (task < 1088) rg_wave_task(p, l, task >> 2, task & 3, 1, last, smem);
        else yb_transpose_task(p, (task - 1088) >> 6, (task - 1088) & 63, smem);
      }
    xcd_barrier(p.counters + 1024, xbw);
_Pragma("unroll 1")
    for (int rep = 0; rep < REP_GATE; ++rep) {
      pg8::Gemm g; pg8::Order S;
      g.A = (const u16*)p.xn8; g.Bt = (const u16*)(p.Wg8 + (size_t)l * 3072 * 1024); g.lda = 512; g.ldb = 512; g.K = 512;
      S.init(n_mt, 12, nb, bid);
      pg8::EpiGate8 e; e.g8 = p.g8; e.bias = p.b_gate + l * 3072; e.sa = p.sa; e.sw = p.sw + l * 5888 + 2816;
      pg8::gemm_phase(lds, g, S, e);
    }
    xcd_barrier(p.counters + 1024, xbw);
_Pragma("unroll 1")
    for (int rep = 0; rep < REP_BRANCH; ++rep) {
      pg8::Gemm g; pg8::Order S;
      S.init(n_mt, 4, nb, bid);
      pg8::EpiBranch e; e.mbuf = p.mbuf; e.g8 = p.g8;
      g.lda = 1024;
      g.A = p.ycat; g.Bt = p.WaT + (size_t)l * 1024 * 512; g.ldb = 512; g.K = 512; e.br = 0;
      pg8::gemm_phase(lds, g, S, e);
      g.A = p.ycat + 512; g.Bt = p.WbT + (size_t)l * 1024 * 256; g.ldb = 256; g.K = 256; e.br = 1;
      pg8::gemm_phase(lds, g, S, e);
      g.A = p.ycat + 768; g.Bt = p.WcT + (size_t)l * 1024 * 256; g.ldb = 256; g.K = 256; e.br = 2;
      pg8::gemm_phase(lds, g, S, e);
    }
    xcd_barrier(p.counters + 1024, xbw);
    {
      pg8::Gemm g; pg8::Order S;
      g.A = p.mbuf; g.Bt = p.WoT + (size_t)l * 1024 * 1024; g.lda = 1024; g.ldb = 1024; g.K = 1024;
      S.init(n_mt, 4, nb, bid);
      pg8::EpiOutR<(l == 0)> e; e.xsrc = p.x; e.csrc = p.ctx; e.res = p.res;
      e.modl = p.mod + (size_t)l * 9 * 6144;
_Pragma("unroll 1")
      for (int half = 0; half < 2; ++half) {
        if ((bid & 1) != half) {
          for (int t = bid; t < 4096; t += 8 * nb) {
            cvt_chunk_fp4x8(p.peer_u + (size_t)l * 16384 * 1024, p.Ub, t, nb, 4096, 64.0f, 0);
            cvt_chunk_fp4x8(p.peer_v + (size_t)l * 16384 * 1024, p.Ub, t, nb, 4096, 4.0f, 1);
          }
        }
        if (half == 0) pg8::gemm_phase(lds, g, S, e);
      }
    }
    xcd_barrier(p.counters + 1024, xbw);
    phase_norm(p, l, 1);
    xcd_barrier(p.counters + 1024, xbw);
_Pragma("unroll 1")
    for (int rep = 0; rep < REP_Q; ++rep) {
      pg8::Gemm g; pg8::Order S;
      g.A = p.xn; g.Bt = p.WqkT + (size_t)l * 2048 * 1024; g.lda = 1024; g.ldb = 1024; g.K = 1024;
      S.init(n_mt, 8, nb, bid);
      pg8::EpiQ e; e.q = p.q;
      pg8::gemm_phase(lds, g, S, e);
    }
    xcd_barrier(p.counters + 1024, xbw);
_Pragma("unroll 1")
    for (int rep = 0; rep < REP_SCORE; ++rep)
    {
      uint4 q0, q1, q2, q3, q4, q5, q6, q7;
      {
        const int tid = opaque_tid();
        const int t0 = bid < n_mt * 16 ? bid : 0;
        uint4 pre[8];
        PS_LOAD(t0 >> 4, t0 & 15);
        q0 = pre[0]; q1 = pre[1]; q2 = pre[2]; q3 = pre[3]; q4 = pre[4]; q5 = pre[5]; q6 = pre[6]; q7 = pre[7];
      }
      for (int task = bid; task < n_mt * 16; task += nb) {
        const int nt_ = (task + nb < n_mt * 16) ? task + nb : task;
        peer_score_tile(p, l, task >> 4, task & 15, smem, q0, q1, q2, q3, q4, q5, q6, q7, nt_ >> 4, nt_ & 15);
      }
    }
    xcd_barrier(p.counters + 1024, xbw);
_Pragma("unroll 1")
    for (int rep = 0; rep < REP_PEER; ++rep) phase_peer_experts(p, l, rep == REP_PEER - 1, smem);
    xcd_barrier(p.counters + 1024, xbw);
  }

__global__ void __launch_bounds__(NTHR) fwd_megakernel(P p) {
  __shared__ __attribute__((aligned(16))) char smem[SMEM_BYTES];
  cg::grid_group grid = cg::this_grid();
  const int nb = gridDim.x, bid = blockIdx.x;
  pg8::PG8_LAS_T lds = (pg8::PG8_LAS_T)smem;
  volatile LAS unsigned* xbw = (volatile LAS unsigned*)(smem + SMEM_BYTES - 32);
  if (threadIdx.x == 0) { xbw[0] = 0u; xbw[1] = 0u; xbw[2] = 0u; xbw[3] = 0u; }
  __syncthreads();
  (void)xcd_barrier_post(p.counters + 1024, xbw);

  phase_prep(p, smem, p.counters + 32);
  grid.sync();
  phase_modreduce(p);
  for (int task = blockIdx.x; task < 512; task += gridDim.x) kf_task(p, task >> 8, task & 255, smem);
  for (int task = blockIdx.x; task < 256; task += gridDim.x) wqk_task(p, task >> 7, (task >> 3) & 15, task & 7, smem);
  for (int task = blockIdx.x; task < 2 * 368; task += gridDim.x) {
    const int l = task / 368, t = task - l * 368;
    if (t < 176) tr_tile4<true>(p.w_in + (size_t)l * 1024 * 2816, 2816, 1024, p.Win8 + (size_t)l * 2816 * 1024, t, p.sw + l * 5888, smem);
    else tr_tile4<true>(p.w_gate + (size_t)l * 1024 * 3072, 3072, 1024, p.Wg8 + (size_t)l * 3072 * 1024, t - 176, p.sw + l * 5888 + 2816, smem);
  }
  xcd_barrier(p.counters + 1024, xbw);

  layer_body<0>(p, smem, lds, xbw, nb, bid);
  layer_body<1>(p, smem, lds, xbw, nb, bid);
}

extern "C" void kernel_launch(void* const* d_in, const int* in_sizes, int n_in, void* d_out, int out_size, void* d_ws,
                              size_t ws_size, hipStream_t stream) {
  P p;
  memset(&p, 0, sizeof(p));
  const float** ins = (const float**)&p;
  for (int i = 0; i < 37; ++i) ins[i] = (const float*)d_in[i];
  p.out = (float*)d_out;
  char* w = (char*)d_ws;
  size_t off = 0;
  auto take = [&](size_t bytes) { char* r = w + off; off += (bytes + 255) & ~(size_t)255; return r; };
  p.counters = (unsigned*)take(32768);
  p.WinT = nullptr; p.WgT = nullptr;
  p.Win8 = (unsigned char*)take((size_t)2 * 2816 * 1024);
  p.Wg8 = (unsigned char*)take((size_t)2 * 3072 * 1024);
  p.sw = (float*)take((size_t)2 * 5888 * 4);
  p.xn8 = (unsigned char*)take((size_t)NTOK * 1024);
  p.sa = (float*)take((size_t)NTOK * 4);
  p.WaT = (u16*)take((size_t)2 * 1024 * 512 * 2);
  p.WbT = (u16*)take((size_t)2 * 1024 * 256 * 2);
  p.WcT = (u16*)take((size_t)2 * 1024 * 256 * 2);
  p.WoT = (u16*)take((size_t)2 * 1024 * 1024 * 2);
  p.WqkT = (u16*)take((size_t)2 * 2048 * 1024 * 2);
  p.rgW = (u16*)take((size_t)2 * 16 * 4096 * 2);
  p.mod = (float*)take((size_t)2 * 9 * 6144 * 4);
  p.hc = (float*)take((size_t)512 * 256 * 4);
  p.Kf = (float*)take((size_t)2 * 256 * 8192 * 8);
  p.xn = (u16*)take((size_t)NTOK * 1024 * 2);
  p.qk = (u16*)take((size_t)NTOK * 1024 * 2);
  p.mbuf = p.qk;
  p.vT = (u16*)take((size_t)8 * 512 * 4096 * 2);
  p.vTc = (u16*)take((size_t)8 * 512 * 256 * 2);
  p.hyT = (u16*)take((size_t)8 * 768 * 4096 * 2);
  p.hyTc = (u16*)take((size_t)8 * 768 * 256 * 2);
  p.rg = (u16*)take((size_t)NTOK * 512 * 2);
  p.ycat = (u16*)take((size_t)NTOK * 1024 * 2);
  p.Ub = (unsigned char*)p.ycat;
  p.Vb = p.Ub + (size_t)16384 * 512;
  p.agg = (float*)take((size_t)8 * 2 * (136 + 34) * 256 * 8);
  p.ybT = (u16*)take((size_t)8 * 256 * 4096 * 2);
  p.hT = (float*)take((size_t)2 * 512 * 4096 * 4);
  p.WqB = (u16*)take((size_t)2 * 1024 * 2048 * 2);
  p.modpart = (float*)take((size_t)16 * 2 * 9 * 6144 * 4);
  p.keysB = (u16*)take((size_t)2 * 16 * 16384 * 2);
  p.res = (u16*)p.hT;
  {
    const size_t have = (size_t)((w + off) - (char*)p.hT), need = (size_t)NTOK * 1024 * 2;
    if (need > have) (void)take(need - have);
  }
  p.ctxs = nullptr;
  p.g8 = (unsigned char*)p.vT;
  p.q = p.qk;
  p.topk = (unsigned*)((char*)p.qk + (size_t)NTOK * 2048 * 2);
  if (off > ws_size) {
    fprintf(stderr, "workspace too small: need %zu have %zu\n", off, ws_size);
    return;
  }
  static int grid_blocks = 0;
  if (!grid_blocks) {
    int dev = 0, cus = 0, per_cu = 0;
    (void)hipGetDevice(&dev);
    (void)hipDeviceGetAttribute(&cus, hipDeviceAttributeMultiprocessorCount, dev);
    (void)hipOccupancyMaxActiveBlocksPerMultiprocessor(&per_cu, fwd_megakernel, NTHR, 0);
    if (per_cu > 1) per_cu = 1;
    grid_blocks = cus * per_cu;
  }
  (void)hipMemsetAsync(p.counters, 0, 32768, stream);
  void* args[] = {&p};
  hipError_t e = hipLaunchCooperativeKernel((void*)fwd_megakernel, dim3(grid_blocks), dim3(NTHR), args, 0, stream);
  if (e != hipSuccess) fprintf(stderr, "cooperative launch failed: %s (grid %d)\n", hipGetErrorString(e), grid_blocks);
}
```

```cpp
#include <hip/hip_runtime.h>
#include <hip/hip_cooperative_groups.h>
#include <cstdio>
#include <cstring>
namespace cg = cooperative_groups;

typedef unsigned short u16;
typedef __attribute__((ext_vector_type(8))) short bf16x8;
typedef __attribute__((ext_vector_type(16))) float f32x16;
typedef __attribute__((ext_vector_type(2))) float f32x2;
typedef int i32x8 __attribute__((ext_vector_type(8)));

#define NLAT 32768
#define NTOK 34816
#define SMEM_BYTES 151552
#define NTHR 512
#ifndef DUP_1A
#define DUP_1A 1
#endif
#ifndef DUP_PREP
#define DUP_PREP 1
#endif
#ifndef DUP_2B
#define DUP_2B 1
#endif
#ifndef XRGA
#define XRGA 1
#endif
#ifndef REP_PEER
#define HOOK_NG 2
#define REP_PEER 1
#endif
#ifndef REP_INPROJ
#define REP_INPROJ 1
#endif
#ifndef REP_GATE
#define REP_GATE 1
#endif
#ifndef REP_BRANCH
#define REP_BRANCH 1
#endif
#ifndef REP_Q
#define REP_Q 1
#endif
#ifndef REP_SCORE
#define REP_SCORE 1
#endif
#ifndef REP_1A
#define REP_1A 1
#endif
#ifndef REP_2B
#define REP_2B 1
#endif
#ifndef REP_KF
#define REP_KF 1
#endif
#ifndef DUP_GEMM
#define DUP_GEMM 1
#endif
#ifndef DUP_PEER
#define DUP_PEER 1
#endif
#ifndef DUP_MIX
#define DUP_MIX 1
#endif
#ifndef XRG
#define XRG 1
#endif
#ifndef XFFT
#define XFFT 1
#endif
#ifndef XATT
#define XATT 1
#endif

struct P {
  const float *x, *c, *ctx, *c_ctx, *norm_mix_g, *norm_ffn_g, *w_ada, *b_ada, *w_in, *na_rpb,
      *hy_short_w, *hy_short_b, *hy_f1_w, *hy_f1_b, *hy_f2_w, *hy_f2_b, *hy_f3_w, *hy_freq, *hy_bias,
      *rg_conv_w, *rg_conv_b, *rg_wa, *rg_ba, *rg_wx, *rg_bx, *rg_lambda,
      *w_gate, *b_gate, *w_br_a, *w_br_b, *w_br_c, *w_out, *peer_wq, *peer_keys, *peer_u, *peer_v, *final_g;
  float* out;
  unsigned* counters;
  u16 *WinT, *WgT, *WaT, *WbT, *WcT, *WoT, *WqB, *WqkT, *keysB, *rgW;
  float *modpart, *mod, *hT, *hc;
  float* Kf;
  u16 *xn, *qk, *vT, *vTc, *hyT, *hyTc, *rg, *ycat, *mbuf, *ybT;
  unsigned char *Ub, *Vb, *g8, *xn8, *Win8, *Wg8;
  float *sa, *sw;
  u16* q;
  float *agg, *ctxs;
  u16* res;
  unsigned* topk;
};

__device__ __forceinline__ u16 f2bf(float f) {
  unsigned u = __float_as_uint(f);
  u += 0x7fffu + ((u >> 16) & 1u);
  return (u16)(u >> 16);
}
__device__ __forceinline__ float bf2f(u16 h) { return __uint_as_float(((unsigned)h) << 16); }
__device__ __forceinline__ unsigned pk2(float a, float b) { return (unsigned)f2bf(a) | ((unsigned)f2bf(b) << 16); }
__device__ __forceinline__ float bflo(unsigned u) { return __uint_as_float(u << 16); }
__device__ __forceinline__ float bfhi(unsigned u) { return __uint_as_float(u & 0xffff0000u); }
__device__ __forceinline__ int opaque_tid() {
  int t = threadIdx.x;
  asm volatile("" : "+v"(t));
  return t;
}
__device__ __forceinline__ int my_lane() { return opaque_tid() & 63; }
__device__ __forceinline__ float shx(float v, int o);
__device__ __forceinline__ float shf(float v, int src) { return __builtin_bit_cast(float, __builtin_amdgcn_ds_bpermute((src & 63) << 2, __builtin_bit_cast(int, v))); }
__device__ __forceinline__ unsigned shu(unsigned v, int src) { return (unsigned)__builtin_amdgcn_ds_bpermute((src & 63) << 2, (int)v); }
typedef unsigned u32x2_t __attribute__((ext_vector_type(2)));
template <int J> __device__ __forceinline__ unsigned xorl(unsigned v, int lane) {
  if constexpr (J == 1) return (unsigned)__builtin_amdgcn_mov_dpp((int)v, 0xB1, 0xF, 0xF, true);
  else if constexpr (J == 2) return (unsigned)__builtin_amdgcn_mov_dpp((int)v, 0x4E, 0xF, 0xF, true);
  else if constexpr (J == 4) {
    const unsigned a = (unsigned)__builtin_amdgcn_mov_dpp((int)v, 0x104, 0xF, 0xF, true);
    const unsigned b = (unsigned)__builtin_amdgcn_mov_dpp((int)v, 0x114, 0xF, 0xF, true);
    return (lane & 4) ? b : a;
  }
  else if constexpr (J == 8) return (unsigned)__builtin_amdgcn_mov_dpp((int)v, 0x128, 0xF, 0xF, true);
  else if constexpr (J == 16) { const u32x2_t r = __builtin_amdgcn_permlane16_swap(v, v, false, false); return (lane & 16) ? r.x : r.y; }
  else { const u32x2_t r = __builtin_amdgcn_permlane32_swap(v, v, false, false); return (lane & 32) ? r.x : r.y; }
}
template <int J> __device__ __forceinline__ float xorf(float v, int lane) { return __uint_as_float(xorl<J>(__float_as_uint(v), lane)); }
__device__ __forceinline__ float shx(float v, int o) {
  const int lane = my_lane();
  switch (o) {
    case 1: return xorf<1>(v, lane);
    case 2: return xorf<2>(v, lane);
    case 4: return xorf<4>(v, lane);
    case 8: return xorf<8>(v, lane);
    case 16: return xorf<16>(v, lane);
    case 32: return xorf<32>(v, lane);
    default: return __builtin_bit_cast(float, __builtin_amdgcn_ds_bpermute(((lane ^ o) << 2), __builtin_bit_cast(int, v)));
  }
}
__device__ __forceinline__ float wave_sum(float v) {
  const int lane = my_lane();
  v += xorf<32>(v, lane); v += xorf<16>(v, lane); v += xorf<8>(v, lane); v += xorf<4>(v, lane); v += xorf<2>(v, lane); v += xorf<1>(v, lane);
  return v;
}
__device__ __forceinline__ float wave_max(float v) {
  const int lane = my_lane();
  v = fmaxf(v, xorf<32>(v, lane)); v = fmaxf(v, xorf<16>(v, lane)); v = fmaxf(v, xorf<8>(v, lane));
  v = fmaxf(v, xorf<4>(v, lane)); v = fmaxf(v, xorf<2>(v, lane)); v = fmaxf(v, xorf<1>(v, lane));
  return v;
}
__device__ __forceinline__ float sigmoidf_(float x) { return __builtin_amdgcn_rcpf(1.0f + __expf(-x)); }
__device__ __forceinline__ float gelu_tanh(float x) {
  const float u2 = 1.5957691216057308f * (x + 0.044715f * x * x * x);
  return x * __builtin_amdgcn_rcpf(1.0f + __expf(-u2));
}
__device__ __forceinline__ f32x16 mfma32(bf16x8 a, bf16x8 b, f32x16 c) {
  return __builtin_amdgcn_mfma_f32_32x32x16_bf16(a, b, c, 0, 0, 0);
}
__device__ __forceinline__ f32x16 zero16() {
  f32x16 z;
#pragma unroll
  for (int i = 0; i < 16; ++i) z[i] = 0.f;
  return z;
}
__device__ __forceinline__ int swz128(int row, int ch) { return row * 128 + ((ch ^ ((row >> 1) & 7)) << 4); }
__device__ __forceinline__ int swz256(int row, int ch) { return row * 256 + ((ch ^ (row & 15)) << 4); }

struct c2 { float x, y; };
__device__ __forceinline__ c2 cadd(c2 a, c2 b) { return {a.x + b.x, a.y + b.y}; }
__device__ __forceinline__ c2 csub(c2 a, c2 b) { return {a.x - b.x, a.y - b.y}; }
__device__ __forceinline__ c2 cmul(c2 a, c2 b) { return {a.x * b.x - a.y * b.y, a.x * b.y + a.y * b.x}; }
__device__ __forceinline__ float c16(int i) {
  const float tb[16] = {1.0f, 0.9238795325112867f, 0.7071067811865476f, 0.3826834323650898f, 0.0f,
                        -0.3826834323650898f, -0.7071067811865476f, -0.9238795325112867f, -1.0f,
                        -0.9238795325112867f, -0.7071067811865476f, -0.3826834323650898f, 0.0f,
                        0.3826834323650898f, 0.7071067811865476f, 0.9238795325112867f};
  return tb[i & 15];
}
__device__ __forceinline__ float s16(int i) { return c16(i + 12); }
template <int R> __device__ __forceinline__ constexpr int brev(int k) {
  int r = 0;
  for (int b = 1, o = R >> 1; b < R; b <<= 1, o >>= 1)
    if (k & b) r |= o;
  return r;
}
template <int R> __device__ __forceinline__ void dft_reg(c2* v, float sgn) {
#pragma unroll
  for (int h = R / 2; h >= 1; h >>= 1) {
#pragma unroll
    for (int g = 0; g < R; g += 2 * h) {
#pragma unroll
      for (int j = 0; j < h; ++j) {
        c2 a = v[g + j], b = v[g + j + h];
        v[g + j] = cadd(a, b);
        c2 d = csub(a, b);
        const int ti = j * (16 / (2 * h));
        c2 w = {c16(ti), sgn * s16(ti)};
        v[g + j + h] = (j == 0) ? d : cmul(d, w);
      }
    }
  }
}
template <int R> __device__ __forceinline__ int fft_bfly(c2* v, int j, int Ns, float sgn) {
  const int k = j & (Ns - 1);
  const float f = sgn * (float)k / (float)(Ns * R);
#pragma unroll
  for (int r = 1; r < R; ++r) {
    float t = f * (float)r;
    c2 w = {__builtin_amdgcn_cosf(t), __builtin_amdgcn_sinf(t)};
    v[r] = cmul(v[r], w);
  }
  dft_reg<R>(v, sgn);
  return (j - k) * R + k;
}
template <int R> __device__ __forceinline__ void fft_pass(c2* buf, int Ns, float sgn) {
  constexpr int NBF = 8192 / R;
  constexpr int PER = NBF / NTHR;
  const int tid = opaque_tid();
  c2 v[PER][R];
#pragma unroll
  for (int i = 0; i < PER; ++i) {
    const int j = tid + NTHR * i;
#pragma unroll
    for (int r = 0; r < R; ++r) v[i][r] = buf[j + r * NBF];
  }
  __syncthreads();
#pragma unroll
  for (int i = 0; i < PER; ++i) {
    const int j = tid + NTHR * i;
    const int base = fft_bfly<R>(v[i], j, Ns, sgn);
#pragma unroll
    for (int r = 0; r < R; ++r) buf[base + r * Ns] = v[i][brev<R>(r)];
  }
  __syncthreads();
}
__device__ __forceinline__ void fft8192(c2* buf, float sgn) {
  fft_pass<8>(buf, 1, sgn);
  fft_pass<8>(buf, 8, sgn);
  fft_pass<8>(buf, 64, sgn);
  fft_pass<16>(buf, 512, sgn);
}

__device__ __forceinline__ void gemm_kloop(f32x16 (&acc)[2][2], const u16* __restrict__ A, int lda,
                                           const u16* __restrict__ B, int ldb, int K, char* smem) {
  const int tid = opaque_tid(), lane = tid & 63, wid = tid >> 6;
  const int wm = wid >> 1, wn = wid & 1;
  const int l31 = lane & 31, hh = lane >> 5;
  uint4 ra[4], rb[2];
  const int nk = K >> 6;
  const int srow = tid >> 3, sch = tid & 7;
  const char* Ab = (const char*)A;
  const char* Bb = (const char*)B;
  const unsigned aoff = (unsigned)(srow * lda + sch * 8) * 2u;
  const unsigned boff = (unsigned)(srow * ldb + sch * 8) * 2u;
  const unsigned astep = (unsigned)lda * 128u, bstep = (unsigned)ldb * 128u;
#pragma unroll
  for (int i = 0; i < 4; ++i) ra[i] = *(const uint4*)(Ab + (aoff + i * astep));
#pragma unroll
  for (int i = 0; i < 2; ++i) rb[i] = *(const uint4*)(Bb + (boff + i * bstep));
#pragma unroll
  for (int i = 0; i < 4; ++i) *(uint4*)(smem + swz128(srow + i * 64, sch)) = ra[i];
#pragma unroll
  for (int i = 0; i < 2; ++i) *(uint4*)(smem + 65536 + swz128(srow + i * 64, sch)) = rb[i];
  __syncthreads();
  for (int kt = 0; kt < nk; ++kt) {
    const bool more = (kt + 1 < nk);
    if (more) {
      const unsigned ko = (unsigned)(kt + 1) * 128u;
#pragma unroll
      for (int i = 0; i < 4; ++i) ra[i] = *(const uint4*)(Ab + (aoff + i * astep + ko));
#pragma unroll
      for (int i = 0; i < 2; ++i) rb[i] = *(const uint4*)(Bb + (boff + i * bstep + ko));
    }
    const char* as = smem + (kt & 1) * 32768;
    const char* bs = smem + 65536 + (kt & 1) * 16384;
    int lrow = l31;
    asm volatile("" : "+v"(lrow));
#pragma unroll
    for (int s = 0; s < 4; ++s) {
      bf16x8 af[2], bfr[2];
#pragma unroll
      for (int i = 0; i < 2; ++i) af[i] = *(const bf16x8*)(as + swz128(wm * 64 + i * 32 + lrow, s * 2 + hh));
#pragma unroll
      for (int j = 0; j < 2; ++j) bfr[j] = *(const bf16x8*)(bs + swz128(wn * 64 + j * 32 + lrow, s * 2 + hh));
#pragma unroll
      for (int i = 0; i < 2; ++i)
#pragma unroll
        for (int j = 0; j < 2; ++j) acc[i][j] = mfma32(af[i], bfr[j], acc[i][j]);
    }
    if (more) {
      char* an = smem + ((kt + 1) & 1) * 32768;
      char* bn = smem + 65536 + ((kt + 1) & 1) * 16384;
      int sr2 = srow;
      asm volatile("" : "+v"(sr2));
#pragma unroll
      for (int i = 0; i < 4; ++i) *(uint4*)(an + swz128(sr2 + i * 64, sch)) = ra[i];
#pragma unroll
      for (int i = 0; i < 2; ++i) *(uint4*)(bn + swz128(sr2 + i * 64, sch)) = rb[i];
    }
    __syncthreads();
  }
}
__device__ __forceinline__ void zero_acc(f32x16 (&acc)[2][2]) {
#pragma unroll
  for (int i = 0; i < 2; ++i)
#pragma unroll
    for (int j = 0; j < 2; ++j) acc[i][j] = zero16();
}
#define EPI_ROW(i, e) (wm * 64 + (i)*32 + ((e)&3) + 8 * ((e) >> 2) + 4 * hh)
#define EPI_COL(j) (wn * 64 + (j)*32 + l31)
#define EPI_VARS                                                    \
  const int tid = opaque_tid(), lane = tid & 63, wid = tid >> 6;     \
  const int wm = wid >> 1, wn = wid & 1, l31 = lane & 31, hh = lane >> 5; \
  (void)tid; (void)wm; (void)wn; (void)l31; (void)hh;


namespace pg8 {
__device__ __forceinline__ unsigned pkh(float a, float b) { unsigned r; asm("v_cvt_pk_bf16_f32 %0, %1, %2" : "=v"(r) : "v"(a), "v"(b)); return r; }
#define PG8_LAS __attribute__((address_space(3)))
typedef PG8_LAS unsigned char* PG8_LAS_T;
typedef float f32x4 __attribute__((ext_vector_type(4)));
typedef unsigned u32x4 __attribute__((ext_vector_type(4)));
typedef int i32x4 __attribute__((ext_vector_type(4)));
constexpr int BM = 256, BK = 64, HALF = 128, HTB = HALF * BK * 2, STAGE_BYTES = 8 * HTB, NXCD = 8, WGM = 8;
__device__ __forceinline__ int lds_byte(int r, int c) { const int st = (r >> 4) * 2 + (c >> 5), rr = r & 15, cc = c & 31, ob = rr * 64 + cc * 2; return st * 1024 + (ob ^ (((ob >> 9) & 1) << 5)); }
__device__ __forceinline__ void stage_rc(int b, int& R, int& C) { const int st = b / 1024, sb = b % 1024, swz = sb ^ (((sb >> 9) & 1) << 5); R = (st >> 1) * 16 + swz / 64; C = (st & 1) * 32 + (swz % 64) / 2; }
__device__ __forceinline__ int perm32(int rho) { const int n = rho >> 4, i = rho & 15; return 8 * (i >> 2) + 4 * n + (i & 3); }
struct Unit { int pm, pn; };
struct Gemm { const u16* A; const u16* Bt; int lda, ldb, K; };
struct Order {
  int nM, nN, nwg, G, c, skip_from, skip_by;
  __device__ __forceinline__ void init(int nM_, int nN_, int G_, int c_, int sf = 1 << 30, int sb = 0) { nM = nM_; nN = nN_; nwg = nM * nN; G = G_; c = c_; skip_from = sf; skip_by = sb; }
  __device__ __forceinline__ bool next(int i, Unit& u) const {
    const long L = (long)i * G + c; if (L >= nwg) return false;
    int wgid = (int)L; { const int q = nwg / NXCD, r = nwg % NXCD, xcd = wgid % NXCD, off = wgid / NXCD; wgid = (xcd < r ? xcd * (q + 1) : r * (q + 1) + (xcd - r) * q) + off; }
    const int nig = WGM * nN, gid = wgid / nig, fm = gid * WGM, gsz = (nM - fm) < WGM ? (nM - fm) : WGM;
    u.pm = fm + ((wgid % nig) % gsz); u.pn = (wgid % nig) / gsz;
    if (u.pn >= skip_from) u.pn += skip_by;
    return true;
  }
};
__device__ __forceinline__ f32x4 mma16(bf16x8 a, bf16x8 b, f32x4 c) { return __builtin_amdgcn_mfma_f32_16x16x32_bf16(a, b, c, 0, 0, 0); }
__device__ __forceinline__ i32x4 mma16(bf16x8 a, bf16x8 b, i32x4 c) { return __builtin_amdgcn_mfma_i32_16x16x64_i8(__builtin_bit_cast(i32x4, a), __builtin_bit_cast(i32x4, b), c, 0, 0, 0); }
template <class Epi>
__device__ __forceinline__ void gemm_phase(PG8_LAS unsigned char* lds, const Gemm g, const Order& S, const Epi& E) {
  const int tid = opaque_tid(), wid = __builtin_amdgcn_readfirstlane(tid >> 6), lane = tid & 63, wr = wid >> 2, wc = wid & 3, fr = lane & 15, fq = lane >> 4;
  const int K = g.K, nt = K / BK;
  unsigned voffA[2], voffB[2];
#pragma unroll
  for (int i = 0; i < 2; ++i) { int R, C; stage_rc(tid * 16 + i * 8192, R, C); const int Rb = Epi::PERM ? ((R & ~31) + perm32(R & 31)) : R;
    voffA[i] = (unsigned)(R * g.lda + C) * 2u; voffB[i] = (unsigned)(Rb * g.ldb + C) * 2u; }
#define PG8_VOFF(T) do { _Pragma("unroll") for (int i = 0; i < 2; ++i) { int R, C; stage_rc((T) * 16 + i * 8192, R, C); const int Rb = Epi::PERM ? ((R & ~31) + perm32(R & 31)) : R; \
    voffA[i] = (unsigned)(R * g.lda + C) * 2u; voffB[i] = (unsigned)(Rb * g.ldb + C) * 2u; } } while (0)
  const size_t kstep = (size_t)(BK * 2);
  const size_t hstepA = (size_t)HALF * g.lda * 2, hstepB = (size_t)HALF * g.ldb * 2;
  const size_t tstepA = 2 * hstepA, tstepB = 2 * hstepB;
  const unsigned ldsw = (unsigned)wid * 1024u;
  int aoff = lds_byte(wr * 64 + fr, fq * 8), boff = lds_byte(wc * 32 + fr, fq * 8);
#define PG8_SA(b, h) (((b) * 2 + (h)) * HTB)
#define PG8_SB(b, h) ((4 + (b) * 2 + (h)) * HTB)
#define PG8_STAGE(bufoff, gbase, voff) do { _Pragma("unroll") for (int _i = 0; _i < 2; ++_i) \
    __builtin_amdgcn_global_load_lds((const unsigned*)((const char*)(gbase) + (voff)[_i]), (PG8_LAS unsigned*)(lds + (bufoff) + ldsw + _i * 8192), 16, 0, 0); } while (0)
#define PG8_LDA(dst, b, h) do { _Pragma("unroll") for (int m = 0; m < 4; ++m) _Pragma("unroll") for (int k = 0; k < 2; ++k) dst[m][k] = *(const PG8_LAS bf16x8*)(lds + PG8_SA(b, h) + aoff + m * 2048 + k * 1024); } while (0)
#define PG8_LDB(dst, b, h) do { _Pragma("unroll") for (int n = 0; n < 2; ++n) _Pragma("unroll") for (int k = 0; k < 2; ++k) dst[n][k] = *(const PG8_LAS bf16x8*)(lds + PG8_SB(b, h) + boff + n * 2048 + k * 1024); } while (0)
#define PG8_MMA(ai, bj, At, Bt) do { __builtin_amdgcn_s_setprio(1); _Pragma("unroll") for (int m = 0; m < 4; ++m) _Pragma("unroll") for (int n = 0; n < 2; ++n) _Pragma("unroll") for (int k = 0; k < 2; ++k) \
    acc[ai][bj][m][n] = mma16(Bt[n][k], At[m][k], acc[ai][bj][m][n]); __builtin_amdgcn_s_setprio(0); } while (0)
#define PG8_WAIT_V(n) asm volatile("s_waitcnt vmcnt(" #n ")" ::: "memory")
#define PG8_WAIT_L(n) asm volatile("s_waitcnt lgkmcnt(" #n ")" ::: "memory")
#define PG8_BAR __builtin_amdgcn_s_barrier()
#define PG8_SCHED __builtin_amdgcn_sched_barrier(0)
  Unit cur, nxt; int ui = 0;
  if (!S.next(0, cur)) return;
  typedef typename Epi::acc_t acc_t;
  acc_t acc[2][2][4][2];
#pragma unroll
  for (int a = 0; a < 2; ++a)
#pragma unroll
    for (int b = 0; b < 2; ++b)
#pragma unroll
      for (int m = 0; m < 4; ++m)
#pragma unroll
        for (int n = 0; n < 2; ++n) acc[a][b][m][n] = (acc_t){0, 0, 0, 0};
  bf16x8 At[4][2], B0[2][2], B1[2][2];
  const char* cA = (const char*)g.A + (size_t)cur.pm * tstepA; const char* cB = (const char*)g.Bt + (size_t)cur.pn * tstepB;
  PG8_STAGE(PG8_SB(0, 0), cB, voffB); PG8_STAGE(PG8_SA(0, 0), cA, voffA); PG8_STAGE(PG8_SB(0, 1), cB + hstepB, voffB); PG8_STAGE(PG8_SA(0, 1), cA + hstepA, voffA);
  if (wr == 1) PG8_BAR;
  PG8_WAIT_V(4); PG8_BAR;
  PG8_STAGE(PG8_SB(1, 0), cB + kstep, voffB); PG8_STAGE(PG8_SA(1, 0), cA + kstep, voffA); PG8_STAGE(PG8_SB(1, 1), cB + hstepB + kstep, voffB);
  PG8_WAIT_V(6); PG8_BAR;
  for (;;) {
    const bool has_next = S.next(ui + 1, nxt);
    const char* nA = has_next ? (const char*)g.A + (size_t)nxt.pm * tstepA : cA; const char* nB = has_next ? (const char*)g.Bt + (size_t)nxt.pn * tstepB : cB;
#define PG8_KBODY \
      const bool last = (t == nt - 2); \
      const char* a1 = cA + (size_t)(t + 1) * kstep; \
      const char* a2 = last ? nA : cA + (size_t)(t + 2) * kstep; const char* b2 = last ? nB : cB + (size_t)(t + 2) * kstep; \
      const char* a3 = a2 + kstep; const char* b3 = b2 + kstep; \
      PG8_LDB(B0, 0, 0); PG8_SCHED; PG8_LDA(At, 0, 0); PG8_STAGE(PG8_SA(1, 1), a1 + hstepA, voffA); \
      PG8_WAIT_L(8); PG8_BAR; PG8_WAIT_L(0); PG8_MMA(0, 0, At, B0); PG8_BAR; PG8_SCHED; \
      PG8_LDB(B1, 0, 1); PG8_STAGE(PG8_SB(0, 0), b2, voffB); \
      PG8_BAR; PG8_WAIT_L(0); PG8_MMA(0, 1, At, B1); PG8_BAR; \
      PG8_LDA(At, 0, 1); PG8_STAGE(PG8_SA(0, 0), a2, voffA); \
      PG8_BAR; PG8_WAIT_L(0); PG8_MMA(1, 0, At, B0); PG8_BAR; PG8_SCHED; \
      PG8_STAGE(PG8_SB(0, 1), b2 + hstepB, voffB); \
      PG8_WAIT_V(6); PG8_BAR; PG8_MMA(1, 1, At, B1); PG8_BAR; \
      PG8_LDB(B0, 1, 0); PG8_SCHED; PG8_LDA(At, 1, 0); PG8_STAGE(PG8_SA(0, 1), a2 + hstepA, voffA); \
      PG8_WAIT_L(8); PG8_BAR; PG8_WAIT_L(0); PG8_MMA(0, 0, At, B0); PG8_BAR; PG8_SCHED; \
      PG8_LDB(B1, 1, 1); PG8_STAGE(PG8_SB(1, 0), b3, voffB); \
      PG8_BAR; PG8_WAIT_L(0); PG8_MMA(0, 1, At, B1); PG8_BAR; \
      PG8_LDA(At, 1, 1); PG8_STAGE(PG8_SA(1, 0), a3, voffA); \
      PG8_BAR; PG8_WAIT_L(0); PG8_MMA(1, 0, At, B0); PG8_BAR; PG8_SCHED; \
      PG8_STAGE(PG8_SB(1, 1), b3 + hstepB, voffB); \
      PG8_WAIT_V(6); PG8_BAR; PG8_MMA(1, 1, At, B1); PG8_BAR;
    if constexpr (Epi::HOOKS) {
      asm volatile("" : "+v"(aoff), "+v"(boff));
      PG8_VOFF(opaque_tid());
      for (int t = 0; t < Epi::H1; t += 2) { PG8_KBODY }
      E.hook(acc, cur, wr, wc, fr, fq, Epi::H1);
      asm volatile("" : "+v"(aoff), "+v"(boff));
      PG8_VOFF(opaque_tid());
      for (int t = Epi::H1; t < Epi::H2; t += 2) { PG8_KBODY }
      E.hook(acc, cur, wr, wc, fr, fq, Epi::H2);
      asm volatile("" : "+v"(aoff), "+v"(boff));
      PG8_VOFF(opaque_tid());
      for (int t = Epi::H2; t < nt; t += 2) { PG8_KBODY }
    } else {
      for (int t = 0; t < nt; t += 2) { PG8_KBODY }
    }
#undef PG8_KBODY
    E(acc, cur, wr, wc, fr, fq);
    if (!has_next) break;
#pragma unroll
    for (int a = 0; a < 2; ++a)
#pragma unroll
      for (int b = 0; b < 2; ++b)
#pragma unroll
        for (int m = 0; m < 4; ++m)
#pragma unroll
          for (int n = 0; n < 2; ++n) acc[a][b][m][n] = (acc_t){0, 0, 0, 0};
    cur = nxt; cA = nA; cB = nB; ++ui;
  }
  PG8_WAIT_V(0);
  if (wr == 0) PG8_BAR;
  PG8_BAR;
#undef PG8_VOFF
#undef PG8_SA
#undef PG8_SB
#undef PG8_STAGE
#undef PG8_LDA
#undef PG8_LDB
#undef PG8_MMA
#undef PG8_WAIT_V
#undef PG8_WAIT_L
#undef PG8_BAR
#undef PG8_SCHED
}
typedef const f32x4 (&AccRef)[2][2][4][2];
typedef const i32x4 (&AccRefI)[2][2][4][2];
struct EpiInprojN {
  static constexpr bool PERM = true; static constexpr bool HOOKS = false; static constexpr int H1 = 0, H2 = 0;
  typedef f32x4 acc_t;
  u16* qk; u16* rg;
  __device__ __forceinline__ void operator()(AccRef acc, const Unit& u, int wr, int wc, int fr, int fq) const {
    const int row0 = u.pm * BM + wr * 64 + fr;
    u16* base; int ld, colt;
    if (u.pn < 4) { base = qk; ld = 1024; colt = u.pn * 256; } else { base = rg; ld = 512; colt = (u.pn - 9) * 256; }
    const int col0 = colt + wc * 32 + 8 * fq;
#pragma unroll
    for (int ai = 0; ai < 2; ++ai)
#pragma unroll
      for (int m = 0; m < 4; ++m) {
        u16* rowp = base + (size_t)(row0 + ai * HALF + m * 16) * ld + col0;
#pragma unroll
        for (int bj = 0; bj < 2; ++bj) {
          const f32x4 v0 = acc[ai][bj][m][0], v1 = acc[ai][bj][m][1];
          u32x4 w; w.x = pkh(v0[0], v0[1]); w.y = pkh(v0[2], v0[3]); w.z = pkh(v1[0], v1[1]); w.w = pkh(v1[2], v1[3]);
          *(u32x4*)(rowp + bj * HALF) = w;
        }
      }
  }
};
struct EpiInprojT {
  static constexpr bool PERM = true; static constexpr bool HOOKS = false; static constexpr int H1 = 0, H2 = 0;
  typedef f32x4 acc_t;
  u16 *vT, *vTc, *hyT, *hyTc;
  __device__ __forceinline__ void operator()(AccRef acc, const Unit& u, int wr, int wc, int fr, int fq) const {
    const bool isctx = (u.pn >= 128);
    const int b = isctx ? (u.pn - 128) : (u.pn >> 4);
    const int Lseg = isctx ? 256 : 4096, t0 = isctx ? 0 : (u.pn & 15) * 256;
    const bool isv = (u.pm < 2);
    const size_t boff = isv ? (isctx ? (size_t)16777216 : (size_t)0) : (isctx ? (size_t)(16777216 + 1048576 + 25165824) : (size_t)(16777216 + 1048576));
    u16* base = vT + boff;
    const int nc = isv ? 512 : 768;
    const int wrow0 = (isv ? u.pm : u.pm - 2) * BM + wr * 64 + fr;
    const int col0 = t0 + wc * 32 + 8 * fq;
#pragma unroll
    for (int ai = 0; ai < 2; ++ai)
#pragma unroll
      for (int m = 0; m < 4; ++m) {
        u16* rowp = base + ((size_t)(b * nc + wrow0 + ai * HALF + m * 16)) * Lseg + col0;
#pragma unroll
        for (int bj = 0; bj < 2; ++bj) {
          const f32x4 v0 = acc[ai][bj][m][0], v1 = acc[ai][bj][m][1];
          u32x4 w; w.x = pkh(v0[0], v0[1]); w.y = pkh(v0[2], v0[3]); w.z = pkh(v1[0], v1[1]); w.w = pkh(v1[2], v1[3]);
          *(u32x4*)(rowp + bj * HALF) = w;
        }
      }
  }
};
struct EpiGate {
  static constexpr bool PERM = true; static constexpr bool HOOKS = false; static constexpr int H1 = 0, H2 = 0;
  typedef f32x4 acc_t;
  unsigned char* g8; const float* bias;
  __device__ __forceinline__ void operator()(AccRef acc, const Unit& u, int wr, int wc, int fr, int fq) const {
    const int row0 = u.pm * BM + wr * 64 + fr;
    const int col0 = u.pn * BM + wc * 32 + 8 * fq;
#pragma unroll
    for (int bj = 0; bj < 2; ++bj) {
      const f32x4 b0 = *(const f32x4*)(bias + col0 + bj * HALF), b1 = *(const f32x4*)(bias + col0 + bj * HALF + 4);
#pragma unroll
      for (int ai = 0; ai < 2; ++ai)
#pragma unroll
        for (int m = 0; m < 4; ++m) {
          const f32x4 v0 = acc[ai][bj][m][0] + b0, v1 = acc[ai][bj][m][1] + b1;
          unsigned w0 = 0, w1 = 0;
#pragma unroll
          for (int k = 0; k < 4; ++k) {
            w0 |= (unsigned)(sigmoidf_(v0[k]) * 255.0f + 0.5f) << (8 * k);
            w1 |= (unsigned)(sigmoidf_(v1[k]) * 255.0f + 0.5f) << (8 * k);
          }
          *(uint2*)(g8 + (size_t)(row0 + ai * HALF + m * 16) * 3072 + col0 + bj * HALF) = make_uint2(w0, w1);
        }
    }
  }
};
struct EpiBranch {
  static constexpr bool PERM = true; static constexpr bool HOOKS = false; static constexpr int H1 = 0, H2 = 0;
  typedef f32x4 acc_t;
  u16* mbuf; const unsigned char* g8; int br;
  __device__ __forceinline__ void operator()(AccRef acc, const Unit& u, int wr, int wc, int fr, int fq) const {
    const int row0 = u.pm * BM + wr * 64 + fr;
    const int col0 = u.pn * BM + wc * 32 + 8 * fq;
    uint2 gq[2][2][2];
    u32x4 o[2][2][2];
#define EB_LOAD(G) do { _Pragma("unroll") for (int j = 0; j < 2; ++j) _Pragma("unroll") for (int bj = 0; bj < 2; ++bj) { \
      const size_t row = (size_t)(row0 + (((G) * 2 + j) >> 2) * HALF + (((G) * 2 + j) & 3) * 16); \
      gq[(G) & 1][j][bj] = *(const uint2*)(g8 + row * 3072 + br * 1024 + col0 + bj * HALF); \
      if (br != 0) o[(G) & 1][j][bj] = *(const u32x4*)(mbuf + row * 1024 + col0 + bj * HALF); } } while (0)
    EB_LOAD(0);
#pragma unroll
    for (int G = 0; G < 4; ++G) {
      if (G < 3) EB_LOAD(G + 1);
#pragma unroll
      for (int j = 0; j < 2; ++j) {
        const int ai = (G * 2 + j) >> 2, m = (G * 2 + j) & 3;
        const size_t row = (size_t)(row0 + ai * HALF + m * 16);
#pragma unroll
        for (int bj = 0; bj < 2; ++bj) {
          const uint2 g = gq[G & 1][j][bj];
          u16* mp = mbuf + row * 1024 + col0 + bj * HALF;
          const f32x4 v0 = acc[ai][bj][m][0], v1 = acc[ai][bj][m][1];
          float r[8];
          r[0] = (float)(g.x & 255u) * v0[0]; r[1] = (float)((g.x >> 8) & 255u) * v0[1];
          r[2] = (float)((g.x >> 16) & 255u) * v0[2]; r[3] = (float)(g.x >> 24) * v0[3];
          r[4] = (float)(g.y & 255u) * v1[0]; r[5] = (float)((g.y >> 8) & 255u) * v1[1];
          r[6] = (float)((g.y >> 16) & 255u) * v1[2]; r[7] = (float)(g.y >> 24) * v1[3];
          u32x4 w;
          if (br == 0) {
            w.x = pkh(r[0] * (1.f / 255.f), r[1] * (1.f / 255.f)); w.y = pkh(r[2] * (1.f / 255.f), r[3] * (1.f / 255.f));
            w.z = pkh(r[4] * (1.f / 255.f), r[5] * (1.f / 255.f)); w.w = pkh(r[6] * (1.f / 255.f), r[7] * (1.f / 255.f));
          } else {
            const u32x4 ov = o[G & 1][j][bj];
            w.x = pkh(bflo(ov.x) + r[0] * (1.f / 255.f), bfhi(ov.x) + r[1] * (1.f / 255.f));
            w.y = pkh(bflo(ov.y) + r[2] * (1.f / 255.f), bfhi(ov.y) + r[3] * (1.f / 255.f));
            w.z = pkh(bflo(ov.z) + r[4] * (1.f / 255.f), bfhi(ov.z) + r[5] * (1.f / 255.f));
            w.w = pkh(bflo(ov.w) + r[6] * (1.f / 255.f), bfhi(ov.w) + r[7] * (1.f / 255.f));
          }
          *(u32x4*)mp = w;
        }
      }
    }
#undef EB_LOAD
  }
};
struct EpiBranchF {
  static constexpr bool PERM = true; static constexpr bool HOOKS = true;
  static constexpr int H1 = 8, H2 = 12;
  typedef f32x4 acc_t;
  u16* mbuf; const unsigned char* g8;
  template <int NUM, int NG>
  __device__ __forceinline__ void rescale(f32x4 (&acc)[2][2][4][2], const Unit& u) const {
    const int tid_ = opaque_tid(), lane_ = tid_ & 63, wid_ = tid_ >> 6;
    const int row0 = u.pm * BM + (wid_ >> 2) * 64 + (lane_ & 15);
    const int col0 = u.pn * BM + (wid_ & 3) * 32 + 8 * (lane_ >> 4);
    constexpr int PER = 8 / NG;
#pragma unroll
    for (int G = 0; G < NG; ++G) {
      __builtin_amdgcn_sched_barrier(0);
      uint2 gn[PER][2], gd[PER][2];
#pragma unroll
      for (int j = 0; j < PER; ++j)
#pragma unroll
        for (int bj = 0; bj < 2; ++bj) {
          const unsigned char* gp = g8 + (size_t)(row0 + ((G * PER + j) >> 2) * HALF + ((G * PER + j) & 3) * 16) * 3072 + col0 + bj * HALF;
          gn[j][bj] = *(const uint2*)(gp + NUM * 1024); gd[j][bj] = *(const uint2*)(gp + (NUM + 1) * 1024);
        }
#pragma unroll
      for (int j = 0; j < PER; ++j) {
        const int ai = (G * PER + j) >> 2, m = (G * PER + j) & 3;
#pragma unroll
        for (int bj = 0; bj < 2; ++bj) {
          __builtin_amdgcn_sched_barrier(0);
          const unsigned n0 = gn[j][bj].x, n1 = gn[j][bj].y, d0 = gd[j][bj].x, d1 = gd[j][bj].y;
          f32x4 r0, r1;
#pragma unroll
          for (int k = 0; k < 4; ++k) {
            float fn0 = (float)((n0 >> (8 * k)) & 255u), fn1 = (float)((n1 >> (8 * k)) & 255u);
            if (NUM != 0) { fn0 = fmaxf(fn0, 1.0f); fn1 = fmaxf(fn1, 1.0f); }
            const float fd0 = fmaxf((float)((d0 >> (8 * k)) & 255u), 1.0f), fd1 = fmaxf((float)((d1 >> (8 * k)) & 255u), 1.0f);
            r0[k] = fn0 * __builtin_amdgcn_rcpf(fd0);
            r1[k] = fn1 * __builtin_amdgcn_rcpf(fd1);
          }
          acc[ai][bj][m][0] *= r0;
          acc[ai][bj][m][1] *= r1;
        }
      }
    }
    __builtin_amdgcn_sched_barrier(0);
  }
  __device__ __forceinline__ void hook(f32x4 (&acc)[2][2][4][2], const Unit& u, int wr, int wc, int fr, int fq, int t) const {
    if (t == H1) rescale<0, HOOK_NG>(acc, u); else rescale<1, HOOK_NG>(acc, u);
  }
  __device__ __forceinline__ void operator()(AccRef acc, const Unit& u, int wr, int wc, int fr, int fq) const {
    const int tid_ = opaque_tid(), lane_ = tid_ & 63, wid_ = tid_ >> 6;
    const int row0 = u.pm * BM + (wid_ >> 2) * 64 + (lane_ & 15);
    const int col0 = u.pn * BM + (wid_ & 3) * 32 + 8 * (lane_ >> 4);
    uint2 gq[2][4][2];
#pragma unroll
    for (int ai = 0; ai < 2; ++ai)
#pragma unroll
      for (int m = 0; m < 4; ++m)
#pragma unroll
        for (int bj = 0; bj < 2; ++bj)
          gq[ai][m][bj] = *(const uint2*)(g8 + (size_t)(row0 + ai * HALF + m * 16) * 3072 + 2048 + col0 + bj * HALF);
#pragma unroll
    for (int ai = 0; ai < 2; ++ai)
#pragma unroll
      for (int m = 0; m < 4; ++m)
#pragma unroll
        for (int bj = 0; bj < 2; ++bj) {
          const uint2 g = gq[ai][m][bj];
          const f32x4 v0 = acc[ai][bj][m][0], v1 = acc[ai][bj][m][1];
          float r[8];
#pragma unroll
          for (int k = 0; k < 4; ++k) {
            r[k] = fmaxf((float)((g.x >> (8 * k)) & 255u), 1.0f) * (1.f / 255.f) * v0[k];
            r[4 + k] = fmaxf((float)((g.y >> (8 * k)) & 255u), 1.0f) * (1.f / 255.f) * v1[k];
          }
          u32x4 w;
          w.x = pkh(r[0], r[1]); w.y = pkh(r[2], r[3]); w.z = pkh(r[4], r[5]); w.w = pkh(r[6], r[7]);
          *(u32x4*)(mbuf + (size_t)(row0 + ai * HALF + m * 16) * 1024 + col0 + bj * HALF) = w;
        }
  }
};
template <bool SRC_F32>
struct EpiOutR {
  static constexpr bool PERM = true; static constexpr bool HOOKS = false; static constexpr int H1 = 0, H2 = 0;
  typedef f32x4 acc_t;
  const float *xsrc, *csrc; u16* res; const float* modl;
  __device__ __forceinline__ void operator()(AccRef acc, const Unit& u, int wr, int wc, int fr, int fq) const {
    const bool isctx = (u.pm >= 128);
    const int bi = isctx ? 8 : (u.pm >> 4);
    const float* gatev = modl + ((size_t)bi * 6 + 2) * 1024;
    const int row0 = u.pm * BM + wr * 64 + fr, col0 = u.pn * BM + wc * 32 + 8 * fq;
    f32x4 gv[2][2];
#pragma unroll
    for (int bj = 0; bj < 2; ++bj) { gv[bj][0] = *(const f32x4*)(gatev + col0 + bj * HALF); gv[bj][1] = *(const f32x4*)(gatev + col0 + bj * HALF + 4); }
    if (SRC_F32) {
      const float* src = isctx ? (csrc - (size_t)NLAT * 1024) : xsrc;
#pragma unroll
      for (int G = 0; G < 4; ++G) {
        f32x4 sv[2][2][2];
#pragma unroll
        for (int j = 0; j < 2; ++j)
#pragma unroll
          for (int bj = 0; bj < 2; ++bj) {
            const float* sp = src + (size_t)(row0 + ((G * 2 + j) >> 2) * HALF + ((G * 2 + j) & 3) * 16) * 1024 + col0 + bj * HALF;
            sv[j][bj][0] = *(const f32x4*)sp; sv[j][bj][1] = *(const f32x4*)(sp + 4);
          }
#pragma unroll
        for (int j = 0; j < 2; ++j) {
          const int ai = (G * 2 + j) >> 2, m = (G * 2 + j) & 3;
#pragma unroll
          for (int bj = 0; bj < 2; ++bj) {
            const f32x4 o0 = sv[j][bj][0] + gv[bj][0] * acc[ai][bj][m][0], o1 = sv[j][bj][1] + gv[bj][1] * acc[ai][bj][m][1];
            u32x4 w;
            w.x = pkh(o0[0], o0[1]); w.y = pkh(o0[2], o0[3]); w.z = pkh(o1[0], o1[1]); w.w = pkh(o1[2], o1[3]);
            *(u32x4*)(res + (size_t)(row0 + ai * HALF + m * 16) * 1024 + col0 + bj * HALF) = w;
          }
        }
      }
    } else {
#pragma unroll
      for (int G = 0; G < 2; ++G) {
        u32x4 sv[4][2];
#pragma unroll
        for (int m = 0; m < 4; ++m)
#pragma unroll
          for (int bj = 0; bj < 2; ++bj) sv[m][bj] = *(const u32x4*)(res + (size_t)(row0 + G * HALF + m * 16) * 1024 + col0 + bj * HALF);
#pragma unroll
        for (int m = 0; m < 4; ++m)
#pragma unroll
          for (int bj = 0; bj < 2; ++bj) {
            const u32x4 r = sv[m][bj];
            const f32x4 a0 = acc[G][bj][m][0], a1 = acc[G][bj][m][1], g0 = gv[bj][0], g1 = gv[bj][1];
            u32x4 w;
            w.x = pkh(bflo(r.x) + g0[0] * a0[0], bfhi(r.x) + g0[1] * a0[1]); w.y = pkh(bflo(r.y) + g0[2] * a0[2], bfhi(r.y) + g0[3] * a0[3]);
            w.z = pkh(bflo(r.z) + g1[0] * a1[0], bfhi(r.z) + g1[1] * a1[1]); w.w = pkh(bflo(r.w) + g1[2] * a1[2], bfhi(r.w) + g1[3] * a1[3]);
            *(u32x4*)(res + (size_t)(row0 + G * HALF + m * 16) * 1024 + col0 + bj * HALF) = w;
          }
      }
    }
  }
};
struct EpiQ {
  static constexpr bool PERM = true; static constexpr bool HOOKS = false; static constexpr int H1 = 0, H2 = 0;
  typedef f32x4 acc_t;
  u16* q;
  __device__ __forceinline__ void operator()(AccRef acc, const Unit& u, int wr, int wc, int fr, int fq) const {
    const int row0 = u.pm * BM + wr * 64 + fr;
    const int col0 = u.pn * BM + wc * 32 + 8 * fq;
#pragma unroll
    for (int ai = 0; ai < 2; ++ai)
#pragma unroll
      for (int m = 0; m < 4; ++m) {
        u16* rowp = q + (size_t)(row0 + ai * HALF + m * 16) * 2048 + col0;
#pragma unroll
        for (int bj = 0; bj < 2; ++bj) {
          const f32x4 v0 = acc[ai][bj][m][0], v1 = acc[ai][bj][m][1];
          u32x4 w;
          w.x = __builtin_bit_cast(unsigned, __builtin_amdgcn_cvt_pkrtz(v0[0], v0[1]));
          w.y = __builtin_bit_cast(unsigned, __builtin_amdgcn_cvt_pkrtz(v0[2], v0[3]));
          w.z = __builtin_bit_cast(unsigned, __builtin_amdgcn_cvt_pkrtz(v1[0], v1[1]));
          w.w = __builtin_bit_cast(unsigned, __builtin_amdgcn_cvt_pkrtz(v1[2], v1[3]));
          *(u32x4*)(rowp + bj * HALF) = w;
        }
      }
  }
};
struct EpiInprojN8 {
  static constexpr bool PERM = true; static constexpr bool HOOKS = false; static constexpr int H1 = 0, H2 = 0;
  typedef i32x4 acc_t;
  u16* qk; u16* rg; const float* sa; const float* sw;
  __device__ __forceinline__ void operator()(AccRefI acc, const Unit& u, int wr, int wc, int fr, int fq) const {
    const int row0 = u.pm * BM + wr * 64 + fr;
    u16* base; int ld, colt;
    if (u.pn < 4) { base = qk; ld = 1024; colt = u.pn * 256; } else { base = rg; ld = 512; colt = (u.pn - 9) * 256; }
    const int col0 = colt + wc * 32 + 8 * fq;
    const int wcol0 = u.pn * 256 + wc * 32 + 8 * fq;
    float rs[8];
    f32x4 cs[2][2];
#pragma unroll
    for (int i = 0; i < 8; ++i) rs[i] = sa[row0 + (i >> 2) * HALF + (i & 3) * 16];
#pragma unroll
    for (int bj = 0; bj < 2; ++bj) { cs[bj][0] = *(const f32x4*)(sw + wcol0 + bj * HALF); cs[bj][1] = *(const f32x4*)(sw + wcol0 + bj * HALF + 4); }
#pragma unroll
    for (int bj = 0; bj < 2; ++bj) {
      const f32x4 c0 = cs[bj][0], c1 = cs[bj][1];
#pragma unroll
      for (int ai = 0; ai < 2; ++ai)
#pragma unroll
        for (int m = 0; m < 4; ++m) {
          const int row = row0 + ai * HALF + m * 16;
          const float r = rs[ai * 4 + m];
          const i32x4 a0 = acc[ai][bj][m][0], a1 = acc[ai][bj][m][1];
          u32x4 w;
          w.x = pkh((float)a0[0] * r * c0[0], (float)a0[1] * r * c0[1]); w.y = pkh((float)a0[2] * r * c0[2], (float)a0[3] * r * c0[3]);
          w.z = pkh((float)a1[0] * r * c1[0], (float)a1[1] * r * c1[1]); w.w = pkh((float)a1[2] * r * c1[2], (float)a1[3] * r * c1[3]);
          *(u32x4*)(base + (size_t)row * ld + col0 + bj * HALF) = w;
        }
    }
  }
};
struct EpiInprojT8 {
  static constexpr bool PERM = true; static constexpr bool HOOKS = false; static constexpr int H1 = 0, H2 = 0;
  typedef i32x4 acc_t;
  u16* vT; const float* sa; const float* sw;
  __device__ __forceinline__ void operator()(AccRefI acc, const Unit& u, int wr, int wc, int fr, int fq) const {
    const bool isctx = (u.pn >= 128);
    const int b = isctx ? (u.pn - 128) : (u.pn >> 4);
    const int Lseg = isctx ? 256 : 4096, t0 = isctx ? 0 : (u.pn & 15) * 256;
    const bool isv = (u.pm < 2);
    const size_t boff = isv ? (isctx ? (size_t)16777216 : (size_t)0) : (isctx ? (size_t)(16777216 + 1048576 + 25165824) : (size_t)(16777216 + 1048576));
    u16* base = vT + boff;
    const int nc = isv ? 512 : 768;
    const int wrow0 = (isv ? u.pm : u.pm - 2) * BM + wr * 64 + fr;
    const int srow0 = u.pm * BM + wr * 64 + fr;
    const int col0 = t0 + wc * 32 + 8 * fq;
    const int tok0 = u.pn * BM + wc * 32 + 8 * fq;
    float rs[8];
    f32x4 cs[2][2];
#pragma unroll
    for (int i = 0; i < 8; ++i) rs[i] = sw[srow0 + (i >> 2) * HALF + (i & 3) * 16];
#pragma unroll
    for (int bj = 0; bj < 2; ++bj) { cs[bj][0] = *(const f32x4*)(sa + tok0 + bj * HALF); cs[bj][1] = *(const f32x4*)(sa + tok0 + bj * HALF + 4); }
#pragma unroll
    for (int bj = 0; bj < 2; ++bj) {
      const f32x4 c0 = cs[bj][0], c1 = cs[bj][1];
#pragma unroll
      for (int ai = 0; ai < 2; ++ai)
#pragma unroll
        for (int m = 0; m < 4; ++m) {
          const float r = rs[ai * 4 + m];
          const i32x4 a0 = acc[ai][bj][m][0], a1 = acc[ai][bj][m][1];
          u32x4 w;
          w.x = pkh((float)a0[0] * r * c0[0], (float)a0[1] * r * c0[1]); w.y = pkh((float)a0[2] * r * c0[2], (float)a0[3] * r * c0[3]);
          w.z = pkh((float)a1[0] * r * c1[0], (float)a1[1] * r * c1[1]); w.w = pkh((float)a1[2] * r * c1[2], (float)a1[3] * r * c1[3]);
          *(u32x4*)(base + ((size_t)(b * nc + wrow0 + ai * HALF + m * 16)) * Lseg + col0 + bj * HALF) = w;
        }
    }
  }
};
struct EpiGate8 {
  static constexpr bool PERM = true; static constexpr bool HOOKS = false; static constexpr int H1 = 0, H2 = 0;
  typedef i32x4 acc_t;
  unsigned char* g8; const float* bias; const float* sa; const float* sw;
  __device__ __forceinline__ void operator()(AccRefI acc, const Unit& u, int wr, int wc, int fr, int fq) const {
    const int row0 = u.pm * BM + wr * 64 + fr;
    const int col0 = u.pn * BM + wc * 32 + 8 * fq;
    typedef float f32x2 __attribute__((ext_vector_type(2)));
    float rs[8];
    f32x4 bs[2][2], cs[2][2];
#pragma unroll
    for (int i = 0; i < 8; ++i) rs[i] = sa[row0 + (i >> 2) * HALF + (i & 3) * 16];
#pragma unroll
    for (int bj = 0; bj < 2; ++bj) {
      bs[bj][0] = *(const f32x4*)(bias + col0 + bj * HALF); bs[bj][1] = *(const f32x4*)(bias + col0 + bj * HALF + 4);
      cs[bj][0] = *(const f32x4*)(sw + col0 + bj * HALF); cs[bj][1] = *(const f32x4*)(sw + col0 + bj * HALF + 4);
    }
#pragma unroll
    for (int bj = 0; bj < 2; ++bj) {
      f32x2 cn[4], bn[4];
#pragma unroll
      for (int k = 0; k < 2; ++k) {
        cn[k] = (f32x2){cs[bj][0][2 * k], cs[bj][0][2 * k + 1]} * -1.4426950408889634f; cn[2 + k] = (f32x2){cs[bj][1][2 * k], cs[bj][1][2 * k + 1]} * -1.4426950408889634f;
        bn[k] = (f32x2){bs[bj][0][2 * k], bs[bj][0][2 * k + 1]} * -1.4426950408889634f; bn[2 + k] = (f32x2){bs[bj][1][2 * k], bs[bj][1][2 * k + 1]} * -1.4426950408889634f;
      }
#pragma unroll
      for (int ai = 0; ai < 2; ++ai)
#pragma unroll
        for (int m = 0; m < 4; ++m) {
          const int row = row0 + ai * HALF + m * 16;
          const float r = rs[ai * 4 + m];
          const i32x4 a0 = acc[ai][bj][m][0], a1 = acc[ai][bj][m][1];
          unsigned qb[8];
#pragma unroll
          for (int k = 0; k < 4; ++k) {
            const f32x2 av = (k < 2) ? (f32x2){(float)a0[2 * k], (float)a0[2 * k + 1]} : (f32x2){(float)a1[2 * k - 4], (float)a1[2 * k - 3]};
            const f32x2 z = __builtin_elementwise_fma(av * r, cn[k], bn[k]);
            const f32x2 d = (f32x2){__builtin_amdgcn_exp2f(z.x), __builtin_amdgcn_exp2f(z.y)} + 1.0f;
            const f32x2 sg = {__builtin_amdgcn_rcpf(d.x), __builtin_amdgcn_rcpf(d.y)};
            const f32x2 q = __builtin_elementwise_fma(sg, (f32x2){255.0f, 255.0f}, (f32x2){8388608.0f, 8388608.0f});
            const float qx = q.x, qy = q.y;
            qb[2 * k] = __float_as_uint(qx); qb[2 * k + 1] = __float_as_uint(qy);
          }
          unsigned p0, p1, p2, p3;
          asm("v_perm_b32 %0, %1, %2, %3" : "=v"(p0) : "v"(qb[1]), "v"(qb[0]), "s"(0x0c0c0400u));
          asm("v_perm_b32 %0, %1, %2, %3" : "=v"(p1) : "v"(qb[3]), "v"(qb[2]), "s"(0x04000c0cu));
          asm("v_perm_b32 %0, %1, %2, %3" : "=v"(p2) : "v"(qb[5]), "v"(qb[4]), "s"(0x0c0c0400u));
          asm("v_perm_b32 %0, %1, %2, %3" : "=v"(p3) : "v"(qb[7]), "v"(qb[6]), "s"(0x04000c0cu));
          const unsigned w0 = p0 | p1, w1 = p2 | p3;
          *(uint2*)(g8 + (size_t)row * 3072 + col0 + bj * HALF) = make_uint2(w0, w1);
        }
    }
  }
};
}

__device__ __forceinline__ void tr_tile(const float* __restrict__ src, int N, int K, u16* __restrict__ dst, int tile, char* smem) {
  float* lds = (float*)smem;
  const int tiles_n = N >> 6;
  const int tk = tile / tiles_n, tn = tile - tk * tiles_n;
  const int tid = opaque_tid();
  {
    const int r = tid >> 3, c8 = (tid & 7) * 8;
    const float* s = src + (size_t)(tk * 64 + r) * N + tn * 64 + c8;
    float4 a = *(const float4*)s, b = *(const float4*)(s + 4);
    float* d = lds + r * 65 + c8;
    d[0] = a.x; d[1] = a.y; d[2] = a.z; d[3] = a.w; d[4] = b.x; d[5] = b.y; d[6] = b.z; d[7] = b.w;
  }
  __syncthreads();
  {
    const int n = tid >> 3, k0 = (tid & 7) * 8;
    uint4 o;
    o.x = pk2(lds[(k0 + 0) * 65 + n], lds[(k0 + 1) * 65 + n]);
    o.y = pk2(lds[(k0 + 2) * 65 + n], lds[(k0 + 3) * 65 + n]);
    o.z = pk2(lds[(k0 + 4) * 65 + n], lds[(k0 + 5) * 65 + n]);
    o.w = pk2(lds[(k0 + 6) * 65 + n], lds[(k0 + 7) * 65 + n]);
    *(uint4*)(dst + (size_t)(tn * 64 + n) * K + tk * 64 + k0) = o;
  }
  __syncthreads();
}
__device__ __forceinline__ void colmax_task(const float* __restrict__ w, int N, int n0, float* __restrict__ swp, char* smem) {
  const int tid = opaque_tid();
  const int col = tid & 63, kg = tid >> 6;
  float m = 0.f;
  const float* wp = w + (size_t)(kg * 128) * N + n0 + col;
#pragma unroll 16
  for (int k = 0; k < 128; ++k) m = fmaxf(m, fabsf(wp[(size_t)k * N]));
  float* red = (float*)smem;
  red[kg * 64 + col] = m;
  __syncthreads();
  if (tid < 64) {
    float mm = red[tid];
#pragma unroll
    for (int g = 1; g < 8; ++g) mm = fmaxf(mm, red[g * 64 + tid]);
    swp[n0 + tid] = fmaxf(mm, 1e-20f) * (1.0f / 127.0f);
  }
  __syncthreads();
}
__device__ __forceinline__ void tr_tile_i8(const float* __restrict__ src, int N, int K, unsigned char* __restrict__ dst, int tile, const float* __restrict__ swp, char* smem) {
  float* lds = (float*)smem;
  const int tiles_n = N >> 6;
  const int tk = tile / tiles_n, tn = tile - tk * tiles_n;
  const int tid = opaque_tid();
  {
    const int r = tid >> 3, c8 = (tid & 7) * 8;
    const float* sp = src + (size_t)(tk * 64 + r) * N + tn * 64 + c8;
    float4 a = *(const float4*)sp, b = *(const float4*)(sp + 4);
    float* d = lds + r * 65 + c8;
    d[0] = a.x; d[1] = a.y; d[2] = a.z; d[3] = a.w; d[4] = b.x; d[5] = b.y; d[6] = b.z; d[7] = b.w;
  }
  __syncthreads();
  {
    const int n = tid >> 3, k0 = (tid & 7) * 8;
    const float inv = 1.0f / swp[tn * 64 + n];
    unsigned w0 = 0, w1 = 0;
#pragma unroll
    for (int i = 0; i < 4; ++i) {
      w0 |= ((unsigned)__float2int_rn(lds[(k0 + i) * 65 + n] * inv) & 255u) << (8 * i);
      w1 |= ((unsigned)__float2int_rn(lds[(k0 + 4 + i) * 65 + n] * inv) & 255u) << (8 * i);
    }
    *(uint2*)(dst + (size_t)(tn * 64 + n) * K + tk * 64 + k0) = make_uint2(w0, w1);
  }
  __syncthreads();
}
__device__ __forceinline__ void cvt_chunk(const float* __restrict__ src, u16* __restrict__ dst, size_t chunk) {
  const size_t i = chunk * 4096 + (size_t)opaque_tid() * 8;
  float4 a = *(const float4*)(src + i), b = *(const float4*)(src + i + 4);
  uint4 o;
  o.x = pk2(a.x, a.y); o.y = pk2(a.z, a.w); o.z = pk2(b.x, b.y); o.w = pk2(b.z, b.w);
  *(uint4*)(dst + i) = o;
}
template <bool I8>
__device__ __forceinline__ void tr_tile4(const float* __restrict__ src, int N, int K, void* __restrict__ dstv, int tile4, const float* __restrict__ swp, char* smem) {
  float* lds = (float*)smem;
  const int tiles_n = N >> 6;
  const int tkq = tile4 / tiles_n, tn = tile4 - tkq * tiles_n;
  const int tid = opaque_tid();
  {
    const int r = tid >> 3, c8 = (tid & 7) * 8;
    const float* sp = src + (size_t)(tkq * 256 + r) * N + tn * 64 + c8;
    float4 a[4], b[4];
#pragma unroll
    for (int q = 0; q < 4; ++q) { a[q] = *(const float4*)(sp + (size_t)q * 64 * N); b[q] = *(const float4*)(sp + (size_t)q * 64 * N + 4); }
#pragma unroll
    for (int q = 0; q < 4; ++q) {
      float* d = lds + q * 4160 + r * 65 + c8;
      d[0] = a[q].x; d[1] = a[q].y; d[2] = a[q].z; d[3] = a[q].w; d[4] = b[q].x; d[5] = b[q].y; d[6] = b[q].z; d[7] = b[q].w;
    }
  }
  __syncthreads();
  {
    const int n = tid >> 3, k0 = (tid & 7) * 8;
    if (I8) {
      const float inv = 1.0f / swp[tn * 64 + n];
      unsigned char* dst = (unsigned char*)dstv;
#pragma unroll
      for (int q = 0; q < 4; ++q) {
        const float* lq = lds + q * 4160;
        unsigned w0 = 0, w1 = 0;
#pragma unroll
        for (int i = 0; i < 4; ++i) {
          w0 |= ((unsigned)__float2int_rn(lq[(k0 + i) * 65 + n] * inv) & 255u) << (8 * i);
          w1 |= ((unsigned)__float2int_rn(lq[(k0 + 4 + i) * 65 + n] * inv) & 255u) << (8 * i);
        }
        *(uint2*)(dst + (size_t)(tn * 64 + n) * K + tkq * 256 + q * 64 + k0) = make_uint2(w0, w1);
      }
    } else {
      u16* dst = (u16*)dstv;
#pragma unroll
      for (int q = 0; q < 4; ++q) {
        const float* lq = lds + q * 4160;
        uint4 o;
        o.x = pk2(lq[(k0 + 0) * 65 + n], lq[(k0 + 1) * 65 + n]);
        o.y = pk2(lq[(k0 + 2) * 65 + n], lq[(k0 + 3) * 65 + n]);
        o.z = pk2(lq[(k0 + 4) * 65 + n], lq[(k0 + 5) * 65 + n]);
        o.w = pk2(lq[(k0 + 6) * 65 + n], lq[(k0 + 7) * 65 + n]);
        *(uint4*)(dst + (size_t)(tn * 64 + n) * K + tkq * 256 + q * 64 + k0) = o;
      }
    }
  }
  __syncthreads();
}
__device__ __forceinline__ void colmax4_task(const float* __restrict__ w, int N, int n0, float* __restrict__ swp, char* smem) {
  const int tid = opaque_tid();
  const int c4 = (tid & 15) * 4, rg = tid >> 4;
  const float* wp = w + (size_t)(rg * 32) * N + n0 + c4;
  float4 m = {0.f, 0.f, 0.f, 0.f};
#pragma unroll 16
  for (int k = 0; k < 32; ++k) {
    const float4 v = *(const float4*)(wp + (size_t)k * N);
    m.x = fmaxf(m.x, fabsf(v.x)); m.y = fmaxf(m.y, fabsf(v.y)); m.z = fmaxf(m.z, fabsf(v.z)); m.w = fmaxf(m.w, fabsf(v.w));
  }
  float* red = (float*)smem;
  *(float4*)(red + rg * 64 + c4) = m;
  __syncthreads();
  if (tid < 64) {
    float mm = red[tid];
#pragma unroll
    for (int g = 1; g < 32; ++g) mm = fmaxf(mm, red[g * 64 + tid]);
    swp[n0 + tid] = fmaxf(mm, 1e-20f) * (1.0f / 127.0f);
  }
  __syncthreads();
}
__device__ __forceinline__ void cvt_chunk4(const float* __restrict__ src, u16* __restrict__ dst, size_t chunk4) {
  const size_t i = chunk4 * 16384 + (size_t)opaque_tid() * 8;
  float4 a[4], b[4];
#pragma unroll
  for (int q = 0; q < 4; ++q) { a[q] = *(const float4*)(src + i + q * 4096); b[q] = *(const float4*)(src + i + q * 4096 + 4); }
#pragma unroll
  for (int q = 0; q < 4; ++q) {
    uint4 o;
    o.x = pk2(a[q].x, a[q].y); o.y = pk2(a[q].z, a[q].w); o.z = pk2(b[q].x, b[q].y); o.w = pk2(b[q].z, b[q].w);
    *(uint4*)(dst + i + q * 4096) = o;
  }
}
__device__ __forceinline__ void cvt_chunk_fp8(const float* __restrict__ src, unsigned char* __restrict__ dst, size_t chunk, float scale) {
  const size_t i = chunk * 4096 + (size_t)opaque_tid() * 8;
  const float4 a = *(const float4*)(src + i), b = *(const float4*)(src + i + 4);
  int w0 = __builtin_amdgcn_cvt_pk_fp8_f32(a.x * scale, a.y * scale, 0, false);
  w0 = __builtin_amdgcn_cvt_pk_fp8_f32(a.z * scale, a.w * scale, w0, true);
  int w1 = __builtin_amdgcn_cvt_pk_fp8_f32(b.x * scale, b.y * scale, 0, false);
  w1 = __builtin_amdgcn_cvt_pk_fp8_f32(b.z * scale, b.w * scale, w1, true);
  *(uint2*)(dst + i) = make_uint2((unsigned)w0, (unsigned)w1);
}
__device__ __forceinline__ void cvt_chunk_fp4(const float* __restrict__ src, unsigned char* __restrict__ dst, size_t chunk, float scale, int vhalf) {
  const size_t i = chunk * 4096 + (size_t)opaque_tid() * 8;
  const float4 a = *(const float4*)(src + i), b = *(const float4*)(src + i + 4);
  unsigned w = 0;
  w = __builtin_amdgcn_cvt_scalef32_pk_fp4_f32(w, a.x * scale, a.y * scale, 1.0f, 0);
  w = __builtin_amdgcn_cvt_scalef32_pk_fp4_f32(w, a.z * scale, a.w * scale, 1.0f, 1);
  w = __builtin_amdgcn_cvt_scalef32_pk_fp4_f32(w, b.x * scale, b.y * scale, 1.0f, 2);
  w = __builtin_amdgcn_cvt_scalef32_pk_fp4_f32(w, b.z * scale, b.w * scale, 1.0f, 3);
  const size_t e = i >> 10;
  const unsigned d = (unsigned)(i & 1023);
  *(unsigned*)(dst + e * 1024 + vhalf * 512 + (d >> 1)) = w;
}
__device__ __forceinline__ void cvt_chunk_fp4x8(const float* __restrict__ src, unsigned char* __restrict__ dst, int t0, int step, int tmax, float scale, int vhalf) {
  const int tid8 = opaque_tid() * 8;
  float4 a[8], b[8];
#pragma unroll
  for (int q = 0; q < 8; ++q) {
    const int t = t0 + q * step;
    const size_t i = (size_t)(t < tmax ? t : t0) * 4096 + tid8;
    a[q] = *(const float4*)(src + i); b[q] = *(const float4*)(src + i + 4);
  }
#pragma unroll
  for (int q = 0; q < 8; ++q) {
    const int t = t0 + q * step;
    if (t < tmax) {
      const size_t i = (size_t)t * 4096 + tid8;
      unsigned w = 0;
      w = __builtin_amdgcn_cvt_scalef32_pk_fp4_f32(w, a[q].x * scale, a[q].y * scale, 1.0f, 0);
      w = __builtin_amdgcn_cvt_scalef32_pk_fp4_f32(w, a[q].z * scale, a[q].w * scale, 1.0f, 1);
      w = __builtin_amdgcn_cvt_scalef32_pk_fp4_f32(w, b[q].x * scale, b[q].y * scale, 1.0f, 2);
      w = __builtin_amdgcn_cvt_scalef32_pk_fp4_f32(w, b[q].z * scale, b[q].w * scale, 1.0f, 3);
      const size_t e = i >> 10;
      const unsigned d = (unsigned)(i & 1023);
      *(unsigned*)(dst + e * 1024 + vhalf * 512 + (d >> 1)) = w;
    }
  }
}
__device__ __forceinline__ void phase_modreduce(const P& p) {
  const int n = 2 * 9 * 6144;
  for (int i = blockIdx.x * NTHR + opaque_tid(); i < n; i += gridDim.x * NTHR) {
    const int l = i / (9 * 6144);
    const int j = i % 6144;
    float s = p.b_ada[l * 6144 + j];
#pragma unroll
    for (int kc = 0; kc < 16; ++kc) s += p.modpart[(size_t)kc * n + i];
    p.mod[i] = s;
  }
}

__device__ __forceinline__ void phase_norm(const P& p, int l, int which) {
  const int tid_ = opaque_tid(); const int lane = tid_ & 63, wid = tid_ >> 6;
  const int ntok = (which == 2 || (which == 1 && l == 1)) ? NLAT : NTOK;
  float4 vn[4]; uint2 rn[4];
#define PN_LOAD(R) do { const int r_ = (R); if (which == 0) { const float* src_ = (r_ < NLAT) ? p.x + (size_t)r_ * 1024 : p.ctx + (size_t)(r_ - NLAT) * 1024; \
      _Pragma("unroll") for (int i = 0; i < 4; ++i) vn[i] = *(const float4*)(src_ + i * 256 + lane * 4); } \
    else { _Pragma("unroll") for (int i = 0; i < 4; ++i) rn[i] = *(const uint2*)(p.res + (size_t)r_ * 1024 + i * 256 + lane * 4); } } while (0)
  if (blockIdx.x * 8 + wid < ntok) PN_LOAD(blockIdx.x * 8 + wid);
  for (int row = blockIdx.x * 8 + wid; row < ntok; row += gridDim.x * 8) {
    float4 v[4];
    float ss = 0.f;
#pragma unroll
    for (int i = 0; i < 4; ++i) {
      if (which == 0) v[i] = vn[i]; else v[i] = make_float4(bflo(rn[i].x), bfhi(rn[i].x), bflo(rn[i].y), bfhi(rn[i].y));
      ss += v[i].x * v[i].x + v[i].y * v[i].y + v[i].z * v[i].z + v[i].w * v[i].w;
    }
    {
      const int nrow = row + gridDim.x * 8;
      if (nrow < ntok) PN_LOAD(nrow);
    }
    ss = wave_sum(ss);
    const float rstd = rsqrtf(ss * (1.0f / 1024.0f) + 1e-6f);
    if (which == 2) {
#pragma unroll
      for (int i = 0; i < 4; ++i) {
        const int col = i * 256 + lane * 4;
        const float4 g = *(const float4*)(p.final_g + col);
        float4 o = {v[i].x * rstd * g.x, v[i].y * rstd * g.y, v[i].z * rstd * g.z, v[i].w * rstd * g.w};
        *(float4*)(p.out + (size_t)row * 1024 + col) = o;
      }
    } else {
      const int bi = row < NLAT ? (row >> 12) : 8;
      const float* gam = (which == 0 ? p.norm_mix_g : p.norm_ffn_g) + l * 1024;
      const float* msh = p.mod + ((size_t)(l * 9 + bi) * 6 + (which == 0 ? 0 : 3)) * 1024;
      const float* msc = msh + 1024;
      float4 y[4];
      float amax = 0.f;
#pragma unroll
      for (int i = 0; i < 4; ++i) {
        const int col = i * 256 + lane * 4;
        const float4 g = *(const float4*)(gam + col);
        const float4 sh = *(const float4*)(msh + col);
        const float4 sc = *(const float4*)(msc + col);
        y[i].x = v[i].x * rstd * g.x * (1.f + sc.x) + sh.x; y[i].y = v[i].y * rstd * g.y * (1.f + sc.y) + sh.y;
        y[i].z = v[i].z * rstd * g.z * (1.f + sc.z) + sh.z; y[i].w = v[i].w * rstd * g.w * (1.f + sc.w) + sh.w;
        amax = fmaxf(amax, fmaxf(fmaxf(fabsf(y[i].x), fabsf(y[i].y)), fmaxf(fabsf(y[i].z), fabsf(y[i].w))));
      }
      if (which == 0) {
        amax = fmaxf(wave_max(amax), 1e-20f);
        const float inv = 127.0f / amax;
#pragma unroll
        for (int i = 0; i < 4; ++i) {
          const unsigned w = ((unsigned)__float2int_rn(y[i].x * inv) & 255u) | (((unsigned)__float2int_rn(y[i].y * inv) & 255u) << 8) |
                             (((unsigned)__float2int_rn(y[i].z * inv) & 255u) << 16) | (((unsigned)__float2int_rn(y[i].w * inv) & 255u) << 24);
          *(unsigned*)(p.xn8 + (size_t)row * 1024 + i * 256 + lane * 4) = w;
        }
        if (lane == 0) p.sa[row] = amax * (1.0f / 127.0f);
      } else {
#pragma unroll
        for (int i = 0; i < 4; ++i) {
          uint2 o;
          o.x = pk2(y[i].x, y[i].y);
          o.y = pk2(y[i].z, y[i].w);
          *(uint2*)(p.xn + (size_t)row * 1024 + i * 256 + lane * 4) = o;
        }
      }
    }
  }
}

__device__ __forceinline__ void filter_wave(const P& p, int l, int L, int t, float* __restrict__ outp) {
  const int lane = opaque_tid() & 63;
  const float tl = (float)t / (float)(L - 1);
  const float wang = (6.283185307179586f / (float)L) * (float)t;
  float z = 0.f;
  if (lane == 0) z = tl;
  else if (lane <= 16) { const float band = 1e-4f + (float)(lane - 1) * ((15.0f - 1e-4f) / 15.0f); z = cosf(band * wang); }
  else if (lane <= 32) { const float band = 1e-4f + (float)(lane - 17) * ((15.0f - 1e-4f) / 15.0f); z = -sinf(band * wang); }
  float a1 = p.hy_f1_b[l * 64 + lane];
  for (int i = 0; i < 33; ++i) a1 += shf(z, i) * p.hy_f1_w[(l * 33 + i) * 64 + lane];
  const float h1 = sinf(p.hy_freq[l * 128 + lane] * a1);
  float a2 = p.hy_f2_b[l * 64 + lane];
  for (int i = 0; i < 64; ++i) a2 += shf(h1, i) * p.hy_f2_w[(l * 64 + i) * 64 + lane];
  const float h2 = sinf(p.hy_freq[l * 128 + 64 + lane] * a2);
  float a3[8];
#pragma unroll
  for (int m = 0; m < 8; ++m) a3[m] = 0.f;
  for (int i = 0; i < 64; ++i) {
    const float hv = shf(h2, i);
    const float* wr = p.hy_f3_w + (size_t)(l * 64 + i) * 512 + lane;
#pragma unroll
    for (int m = 0; m < 8; ++m) a3[m] += hv * wr[m * 64];
  }
  const float LN100 = 4.605170185988092f;
  const float d0 = LN100 / 1.5f, d1 = LN100 / 0.3f;
#pragma unroll
  for (int m = 0; m < 8; ++m) {
    const int cp = lane + 64 * m;
    const int ch = cp & 255;
    const float delta = d0 + (float)ch * ((d1 - d0) / 255.0f);
    outp[(size_t)cp * L + t] = a3[m] * expf(-tl * delta);
  }
}
__device__ __forceinline__ void filter_block_task(const P& p, int l, int L, int t0, float* __restrict__ outp, char* smem) {
  const int tid = opaque_tid(), lane = tid & 63, wid = tid >> 6;
  float* W3s = (float*)smem;
  float* W2s = (float*)(smem + 131072);
  {
    const float4* s3 = (const float4*)(p.hy_f3_w + (size_t)l * 64 * 512);
    const float4* s2 = (const float4*)(p.hy_f2_w + (size_t)l * 64 * 64);
#pragma unroll
    for (int i = 0; i < 16; ++i) ((float4*)W3s)[tid + NTHR * i] = s3[tid + NTHR * i];
#pragma unroll
    for (int i = 0; i < 2; ++i) ((float4*)W2s)[tid + NTHR * i] = s2[tid + NTHR * i];
  }
  __syncthreads();
  float z[4], tl[4];
#pragma unroll
  for (int j = 0; j < 4; ++j) {
    const int t = t0 + wid * 4 + j;
    tl[j] = (float)t / (float)(L - 1);
    const float wang = (6.283185307179586f / (float)L) * (float)t;
    float zz = 0.f;
    if (lane == 0) zz = tl[j];
    else if (lane <= 16) { const float band = 1e-4f + (float)(lane - 1) * ((15.0f - 1e-4f) / 15.0f); zz = cosf(band * wang); }
    else if (lane <= 32) { const float band = 1e-4f + (float)(lane - 17) * ((15.0f - 1e-4f) / 15.0f); zz = -sinf(band * wang); }
    z[j] = zz;
  }
  float a1[4], a2[4];
  {
    const float b1 = p.hy_f1_b[l * 64 + lane];
#pragma unroll
    for (int j = 0; j < 4; ++j) a1[j] = b1;
#pragma unroll 11
    for (int i = 0; i < 33; ++i) {
      const float w = p.hy_f1_w[(l * 33 + i) * 64 + lane];
#pragma unroll
      for (int j = 0; j < 4; ++j) a1[j] += shf(z[j], i) * w;
    }
    const float f0 = p.hy_freq[l * 128 + lane];
#pragma unroll
    for (int j = 0; j < 4; ++j) a1[j] = sinf(f0 * a1[j]);
  }
  {
    const float b2 = p.hy_f2_b[l * 64 + lane];
#pragma unroll
    for (int j = 0; j < 4; ++j) a2[j] = b2;
#pragma unroll 8
    for (int i = 0; i < 64; ++i) {
      const float w = W2s[i * 64 + lane];
#pragma unroll
      for (int j = 0; j < 4; ++j) a2[j] += shf(a1[j], i) * w;
    }
    const float f1 = p.hy_freq[l * 128 + 64 + lane];
#pragma unroll
    for (int j = 0; j < 4; ++j) a2[j] = sinf(f1 * a2[j]);
  }
  float a3[4][8];
#pragma unroll
  for (int j = 0; j < 4; ++j)
#pragma unroll
    for (int m = 0; m < 8; ++m) a3[j][m] = 0.f;
#pragma unroll 4
  for (int i = 0; i < 64; ++i) {
    float w[8];
#pragma unroll
    for (int m = 0; m < 8; ++m) w[m] = W3s[i * 512 + lane + 64 * m];
#pragma unroll
    for (int j = 0; j < 4; ++j) {
      const float hv = shf(a2[j], i);
#pragma unroll
      for (int m = 0; m < 8; ++m) a3[j][m] += hv * w[m];
    }
  }
  const float LN100 = 4.605170185988092f;
  const float d0 = LN100 / 1.5f, d1 = LN100 / 0.3f;
#pragma unroll
  for (int m = 0; m < 8; ++m) {
    const int cp = lane + 64 * m;
    const float delta = d0 + (float)(cp & 255) * ((d1 - d0) / 255.0f);
    float4 o;
    o.x = a3[0][m] * expf(-tl[0] * delta); o.y = a3[1][m] * expf(-tl[1] * delta);
    o.z = a3[2][m] * expf(-tl[2] * delta); o.w = a3[3][m] * expf(-tl[3] * delta);
    *(float4*)(outp + (size_t)cp * L + t0 + wid * 4) = o;
  }
  __syncthreads();
}
__device__ __forceinline__ void phase_filters(const P& p, int l, char* smem) {
  const int ntask = 128 + (l == 0 ? 8 : 0);
  for (int t = blockIdx.x; t < ntask; t += gridDim.x) {
    if (t < 128) filter_block_task(p, l, 4096, t * 32, p.hT + (size_t)l * 512 * 4096, smem);
    else filter_block_task(p, l, 256, (t - 128) * 32, p.hc, smem);
  }
}
__device__ __forceinline__ void adaln_task(const P& p, int t, char* smem) {
  const int tid = opaque_tid();
  const int kc = t & 15; t >>= 4;
  const int jc = t % 12, l = t / 12;
  float* s = (float*)smem;
  float* red = (float*)(smem + 4096);
  for (int i = tid; i < 576; i += NTHR) {
    const int bi = i >> 6, kk = i & 63;
    const float v = (bi < 8) ? p.c[bi * 1024 + kc * 64 + kk] : p.c_ctx[kc * 64 + kk];
    s[i] = v / (1.0f + __expf(-v));
  }
  const int kq = tid >> 7, c4 = (tid & 127) * 4;
  const float* wp = p.w_ada + ((size_t)l * 1024 + kc * 64 + kq * 16) * 6144 + jc * 512 + c4;
  float4 w[16];
#pragma unroll
  for (int kk = 0; kk < 16; ++kk) w[kk] = *(const float4*)(wp + (size_t)kk * 6144);
  __syncthreads();
  float4 acc[9];
#pragma unroll
  for (int bi = 0; bi < 9; ++bi) acc[bi] = make_float4(0.f, 0.f, 0.f, 0.f);
#pragma unroll
  for (int kk = 0; kk < 16; ++kk) {
#pragma unroll
    for (int bi = 0; bi < 9; ++bi) {
      const float sv = s[bi * 64 + kq * 16 + kk];
      acc[bi].x += sv * w[kk].x; acc[bi].y += sv * w[kk].y; acc[bi].z += sv * w[kk].z; acc[bi].w += sv * w[kk].w;
    }
  }
#pragma unroll
  for (int bi = 0; bi < 9; ++bi) *(float4*)(red + (kq * 9 + bi) * 512 + c4) = acc[bi];
  __syncthreads();
#pragma unroll
  for (int bi = 0; bi < 9; ++bi) {
    const float v = red[bi * 512 + tid] + red[(9 + bi) * 512 + tid] + red[(18 + bi) * 512 + tid] + red[(27 + bi) * 512 + tid];
    p.modpart[((size_t)(kc * 2 + l) * 9 + bi) * 6144 + jc * 512 + tid] = v;
  }
  __syncthreads();
}
__device__ __forceinline__ void phase_prep(const P& p, char* smem, unsigned* counter) {
  volatile int* s_taskp = (volatile int*)(smem + SMEM_BYTES - 16);
  const int total = 264 + 184 + 384 + 544 + 32;
  int nxt = 0;
  if (threadIdx.x == 0) nxt = (int)atomicAdd(counter, 1u);
  for (;;) {
    __syncthreads();
    if (threadIdx.x == 0) *s_taskp = nxt;
    __syncthreads();
    int t = *s_taskp;
    if (t >= total) break;
    if (threadIdx.x == 0) nxt = (int)atomicAdd(counter, 1u);
    if (t < 264) {
      if (t < 128) filter_block_task(p, 0, 4096, t * 32, p.hT, smem);
      else if (t < 256) filter_block_task(p, 1, 4096, (t - 128) * 32, p.hT + (size_t)512 * 4096, smem);
      else filter_block_task(p, 0, 256, (t - 256) * 32, p.hc, smem);
      continue;
    }
    t -= 264;
    if (t < 184) {
      const int l = t / 92; t -= l * 92;
      if (t < 44) colmax4_task(p.w_in + (size_t)l * 1024 * 2816, 2816, t * 64, p.sw + l * 5888, smem);
      else colmax4_task(p.w_gate + (size_t)l * 1024 * 3072, 3072, (t - 44) * 64, p.sw + l * 5888 + 2816, smem);
      continue;
    }
    t -= 184;
    if (t < 384) { adaln_task(p, t, smem); continue; }
    t -= 384;
    if (t < 544) {
      const int l = t / 272; t -= l * 272;
      if (t < 32) tr_tile4<false>(p.w_br_a + (size_t)l * 512 * 1024, 1024, 1024, p.WaT + (size_t)l * 1024 * 1024, t, nullptr, smem);
      else if ((t -= 32) < 16) tr_tile4<false>(p.w_br_b + (size_t)l * 256 * 1024, 1024, 1024, p.WaT + (size_t)l * 1024 * 1024 + 512, t, nullptr, smem);
      else if ((t -= 16) < 16) tr_tile4<false>(p.w_br_c + (size_t)l * 256 * 1024, 1024, 1024, p.WaT + (size_t)l * 1024 * 1024 + 768, t, nullptr, smem);
      else if ((t -= 16) < 64) tr_tile4<false>(p.w_out + (size_t)l * 1024 * 1024, 1024, 1024, p.WoT + (size_t)l * 1024 * 1024, t, nullptr, smem);
      else if ((t -= 64) < 128) cvt_chunk4(p.peer_wq + (size_t)l * 1024 * 2048, p.WqB + (size_t)l * 1024 * 2048, (size_t)t);
      else {
        t -= 128;
        const int gate = t >> 3, dn = t & 7;
        const float* src = (gate ? p.rg_wx : p.rg_wa) + (size_t)(l * 8 + dn) * 4096;
        tr_tile(src, 64, 64, p.rgW + (size_t)((l * 2 + gate) * 8 + dn) * 4096, 0, smem);
      }
      continue;
    }
    t -= 544;
    cvt_chunk4(p.peer_keys, p.keysB, (size_t)t);
  }
}
__device__ __forceinline__ void kf_task(const P& p, int l, int c, char* smem) {
  const float* hTl = p.hT + (size_t)l * 512 * 4096;
  c2* buf = (c2*)smem;
  const int tid = opaque_tid();
  for (int i = 0; i < 16; ++i) {
    const int j = tid + NTHR * i;
    float v;
    if (j < 4096) v = hTl[(size_t)c * 4096 + j];
    else if (j == 4096) v = 0.f;
    else v = hTl[(size_t)(256 + c) * 4096 + (8192 - j)];
    buf[j] = {v, 0.f};
  }
  __syncthreads();
  fft8192(buf, -1.f);
  c2* o = (c2*)p.Kf + ((size_t)l * 256 + c) * 8192;
  for (int i = 0; i < 16; ++i) { const int j = tid + NTHR * i; o[j] = buf[j]; }
  __syncthreads();
}

__device__ __forceinline__ void inproj_tile(const P& p, int l, int mt, int nt, char* smem) {
  f32x16 acc[2][2];
  zero_acc(acc);
  const int m0 = mt * 256, n0 = nt * 128;
  gemm_kloop(acc, p.xn + (size_t)m0 * 1024, 1024, p.WinT + ((size_t)l * 2816 + n0) * 1024, 1024, 1024, smem);
  EPI_VARS
  if (nt < 8 || nt >= 18) {
    u16* dst; int ld, cbase;
    if (nt < 8) { dst = p.qk; ld = 1024; cbase = n0; }
    else { dst = p.rg; ld = 512; cbase = n0 - 2304; }
#pragma unroll
    for (int i = 0; i < 2; ++i)
#pragma unroll
      for (int j = 0; j < 2; ++j)
#pragma unroll
        for (int e = 0; e < 16; ++e)
          dst[(size_t)(m0 + EPI_ROW(i, e)) * ld + cbase + EPI_COL(j)] = f2bf(acc[i][j][e]);
  } else {
#pragma unroll
    for (int i = 0; i < 2; ++i)
#pragma unroll
      for (int j = 0; j < 2; ++j)
#pragma unroll
        for (int qd = 0; qd < 4; ++qd) {
          uint2 o;
          o.x = pk2(acc[i][j][4 * qd + 0], acc[i][j][4 * qd + 1]);
          o.y = pk2(acc[i][j][4 * qd + 2], acc[i][j][4 * qd + 3]);
          const int row0 = wm * 64 + i * 32 + 8 * qd + 4 * hh;
          *(uint2*)(smem + EPI_COL(j) * 520 + row0 * 2) = o;
        }
    __syncthreads();
    u16* dstT; int Lseg, t0, ncol0, nc;
    const bool isctx = (mt >= 128);
    const int b = isctx ? (mt - 128) : (mt >> 4);
    if (nt < 12) { ncol0 = n0 - 1024; nc = 512; dstT = isctx ? p.vTc : p.vT; }
    else { ncol0 = n0 - 1536; nc = 768; dstT = isctx ? p.hyTc : p.hyT; }
    if (isctx) { Lseg = 256; t0 = 0; } else { Lseg = 4096; t0 = (mt & 15) * 256; }
#pragma unroll 4
    for (int it = 0; it < 16; ++it) {
      const int idx = tid + NTHR * it;
      const int col = idx >> 6, u = idx & 63;
      const uint2 v = *(const uint2*)(smem + col * 520 + u * 8);
      *(uint2*)(dstT + ((size_t)(b * nc + ncol0 + col)) * Lseg + t0 + u * 4) = v;
    }
    __syncthreads();
  }
}

__device__ __forceinline__ float ldbf(const u16* p, int t, int L) { return (t >= 0 && t < L) ? bf2f(p[t]) : 0.f; }
__device__ __forceinline__ void ld10(const u16* __restrict__ seq, int t0, float (&v)[10]) {
  const uint4 r = *(const uint4*)(seq + t0);
  v[0] = (t0 > 0) ? bf2f(seq[t0 - 1]) : 0.f;
  v[9] = (t0 + 8 < 4096) ? bf2f(seq[t0 + 8]) : 0.f;
  v[1] = bflo(r.x); v[2] = bfhi(r.x); v[3] = bflo(r.y); v[4] = bfhi(r.y);
  v[5] = bflo(r.z); v[6] = bfhi(r.z); v[7] = bflo(r.w); v[8] = bfhi(r.w);
}
__device__ __forceinline__ void hyena_fft_task(const P& p, int l, int c, int bp, char* smem) {
  c2* buf = (c2*)smem;
  c2* ub = (c2*)(smem + 65536);
  const int tid = opaque_tid();
  const float* sw = p.hy_short_w + l * 3 * 768;
  const float* sb = p.hy_short_b + l * 768;
  const float wx0[3] = {sw[c], sw[768 + c], sw[1536 + c]};
  const float wx1[3] = {sw[256 + c], sw[768 + 256 + c], sw[1536 + 256 + c]};
  const float wv[3] = {sw[512 + c], sw[768 + 512 + c], sw[1536 + 512 + c]};
  const float bx0 = sb[c], bx1 = sb[256 + c], bv = sb[512 + c];
  const float dsk = p.hy_bias[l * 256 + c];
  const int t0 = tid * 8;
  {
    float u[2][8];
#pragma unroll
    for (int bb = 0; bb < 2; ++bb) {
      const int b = 2 * bp + bb;
      float x1[10], vv[10];
      ld10(p.hyT + ((size_t)(b * 768 + 256 + c)) * 4096, t0, x1);
      ld10(p.hyT + ((size_t)(b * 768 + 512 + c)) * 4096, t0, vv);
#pragma unroll
      for (int k = 0; k < 8; ++k) {
        const float x1c = bx1 + wx1[0] * x1[k] + wx1[1] * x1[k + 1] + wx1[2] * x1[k + 2];
        const float vc = bv + wv[0] * vv[k] + wv[1] * vv[k + 1] + wv[2] * vv[k + 2];
        u[bb][k] = vc * x1c;
      }
    }
#pragma unroll
    for (int k = 0; k < 8; k += 2) {
      const float4 w = make_float4(u[0][k], u[1][k], u[0][k + 1], u[1][k + 1]);
      *(float4*)(buf + t0 + k) = w;
      *(float4*)(ub + t0 + k) = w;
      *(float4*)(buf + 4096 + t0 + k) = make_float4(0.f, 0.f, 0.f, 0.f);
    }
  }
  __syncthreads();
  fft8192(buf, -1.f);
  const c2* kf = (const c2*)p.Kf + ((size_t)l * 256 + c) * 8192;
  for (int i = 0; i < 16; ++i) {
    const int k = tid + NTHR * i;
    buf[k] = cmul(buf[k], kf[k]);
  }
  __syncthreads();
  fft8192(buf, 1.f);
#pragma unroll
  for (int bb = 0; bb < 2; ++bb) {
    const int b = 2 * bp + bb;
    float x0[10];
    ld10(p.hyT + ((size_t)(b * 768 + c)) * 4096, t0, x0);
    float o[8];
#pragma unroll
    for (int k = 0; k < 8; ++k) {
      const c2 y = buf[t0 + k];
      const c2 uu = ub[t0 + k];
      const float x0c = bx0 + wx0[0] * x0[k] + wx0[1] * x0[k + 1] + wx0[2] * x0[k + 2];
      const float yy = ldexpf(bb ? y.y : y.x, -13);
      const float uv = bb ? uu.y : uu.x;
      o[k] = x0c * (yy + uv * dsk);
    }
    uint4 w; w.x = pk2(o[0], o[1]); w.y = pk2(o[2], o[3]); w.z = pk2(o[4], o[5]); w.w = pk2(o[6], o[7]);
    *(uint4*)(p.ybT + ((size_t)(b * 256 + c)) * 4096 + t0) = w;
  }
  __syncthreads();
}
__device__ __forceinline__ void yb_transpose_task(const P& p, int b, int tb, char* smem) {
  const int tid = opaque_tid(), lane = tid & 63, wid = tid >> 6;
  u16* T = (u16*)smem;
#pragma unroll
  for (int it = 0; it < 4; ++it) {
    const int id = tid + NTHR * it;
    const int c = id >> 3, ch = id & 7;
    const uint4 r = *(const uint4*)(p.ybT + ((size_t)(b * 256 + c)) * 4096 + tb * 64 + ch * 8);
    unsigned* d = (unsigned*)(T + c * 66 + ch * 8);
    d[0] = r.x; d[1] = r.y; d[2] = r.z; d[3] = r.w;
  }
  __syncthreads();
#pragma unroll
  for (int it = 0; it < 8; ++it) {
    const int tt = wid + 8 * it;
    const int c0 = lane * 4;
    uint2 w;
    w.x = (unsigned)T[(c0 + 0) * 66 + tt] | ((unsigned)T[(c0 + 1) * 66 + tt] << 16);
    w.y = (unsigned)T[(c0 + 2) * 66 + tt] | ((unsigned)T[(c0 + 3) * 66 + tt] << 16);
    *(uint2*)(p.ycat + (size_t)(b * 4096 + tb * 64 + tt) * 1024 + 512 + c0) = w;
  }
  __syncthreads();
}
__device__ __forceinline__ void hyena_ctx_task(const P& p, int l, int b, int cg8, char* smem) {
  const int tid_ = opaque_tid(); const int lane = tid_ & 63, wid = tid_ >> 6;
  const int c = cg8 * 8 + wid;
  float* us = (float*)smem + wid * 1024;
  float* kfp = us + 256 + 255;
  const float* sw = p.hy_short_w + l * 3 * 768;
  const float* sb = p.hy_short_b + l * 768;
  const u16* x0 = p.hyTc + ((size_t)(b * 768 + c)) * 256;
  const u16* x1 = p.hyTc + ((size_t)(b * 768 + 256 + c)) * 256;
  const u16* vv = p.hyTc + ((size_t)(b * 768 + 512 + c)) * 256;
  for (int i = 0; i < 4; ++i) {
    const int t = lane + 64 * i;
    const float x1c = sb[256 + c] + sw[256 + c] * ldbf(x1, t - 1, 256) + sw[768 + 256 + c] * ldbf(x1, t, 256) + sw[1536 + 256 + c] * ldbf(x1, t + 1, 256);
    const float vc = sb[512 + c] + sw[512 + c] * ldbf(vv, t - 1, 256) + sw[768 + 512 + c] * ldbf(vv, t, 256) + sw[1536 + 512 + c] * ldbf(vv, t + 1, 256);
    us[t] = vc * x1c;
    kfp[t] = p.hc[(size_t)c * 256 + t];
    if (t > 0) kfp[-t] = p.hc[(size_t)(256 + c) * 256 + t];
  }
  __syncthreads();
  const float dsk = p.hy_bias[l * 256 + c];
  float acc[4] = {0.f, 0.f, 0.f, 0.f};
  for (int s = 0; s < 256; ++s) {
    const float uv = us[s];
#pragma unroll
    for (int i = 0; i < 4; ++i) acc[i] += kfp[lane + 64 * i - s] * uv;
  }
#pragma unroll
  for (int i = 0; i < 4; ++i) {
    const int t = lane + 64 * i;
    const float x0c = sb[c] + sw[c] * ldbf(x0, t - 1, 256) + sw[768 + c] * ldbf(x0, t, 256) + sw[1536 + c] * ldbf(x0, t + 1, 256);
    p.ycat[(size_t)(NLAT + b * 256 + t) * 1024 + 512 + c] = f2bf(x0c * (acc[i] + us[t] * dsk));
  }
  __syncthreads();
}

template <int DIR>
__device__ __forceinline__ void rg_scan32(const float (&Av)[2][16], const float (&Bv)[2][16], float (&carry)[2], float (&H)[2][16], int hh) {
#pragma unroll
  for (int nt = 0; nt < 2; ++nt) {
    float c = carry[nt];
#pragma unroll
    for (int go = 0; go < 8; ++go) {
      const int g = DIR ? 7 - go : go, q = g >> 1, own = g & 1;
      float h = c;
#pragma unroll
      for (int io = 0; io < 4; ++io) {
        const int e = 4 * q + (DIR ? 3 - io : io);
        h = Av[nt][e] * h + Bv[nt][e];
        H[nt][e] = (hh == own) ? h : H[nt][e];
      }
      const float mine = (hh == own) ? h : c;
      const float other = shx(mine, 32);
      c = (hh == own) ? mine : other;
    }
    carry[nt] = c;
  }
}
__device__ __forceinline__ void rg_wave_task(const P& p, int l, int bq, int nblk, int mode, bool last, char* smem) {
  const int tid = opaque_tid(), lane = tid & 63, wid = tid >> 6;
  const int l31 = lane & 31, hh = lane >> 5;
  const int b = bq / 34, rr = bq - b * 34;
  const int seg = rr < 2 ? 0 : 1, blk = rr < 2 ? rr : rr - 2;
  if (mode == 1 && seg == 0 && last) return;
  const int ck = wid >> 1, dir = wid & 1;
  char* wreg = smem + wid * 17408;
  u16* xs = (u16*)wreg;
  char* xcb = wreg + 4608;
  float* xcf = (float*)(wreg + 8704);
  float2* blockagg = (float2*)(smem + 139264);
  const int Lseg = seg ? 4096 : 256;
  const int tokbase = seg ? b * 4096 : NLAT + b * 256;
  const int T0 = blk * 128 + ck * 32;
  const int cg32 = (seg ? 8 : 0) + blk * 4 + ck;
  uint4 xt[5];
#pragma unroll
  for (int i = 0; i < 5; ++i) {
    const int idx = lane + 64 * i;
    const int row = idx >> 3, chunk = idx & 7;
    xt[i] = make_uint4(0u, 0u, 0u, 0u);
    if (row < 35) {
      const int pos = T0 - 2 + row;
      if (pos >= 0 && pos < Lseg) xt[i] = *(const uint4*)(p.rg + (size_t)(tokbase + pos) * 512 + nblk * 64 + chunk * 8);
    }
  }
  const float cw0 = p.rg_conv_w[(l * 4 + 0) * 256 + nblk * 64 + lane], cw1 = p.rg_conv_w[(l * 4 + 1) * 256 + nblk * 64 + lane];
  const float cw2 = p.rg_conv_w[(l * 4 + 2) * 256 + nblk * 64 + lane], cw3 = p.rg_conv_w[(l * 4 + 3) * 256 + nblk * 64 + lane];
  const float ccb = p.rg_conv_b[l * 256 + nblk * 64 + lane];
  bf16x8 wf[2][2][4];
#pragma unroll
  for (int gate = 0; gate < 2; ++gate) {
    const u16* wp = p.rgW + (size_t)(((l * 2 + gate) * 2 + dir) * 4 + nblk) * 4096 + l31 * 64 + 8 * hh;
#pragma unroll
    for (int nt = 0; nt < 2; ++nt)
#pragma unroll
      for (int s = 0; s < 4; ++s) wf[gate][nt][s] = *(const bf16x8*)(wp + nt * 2048 + 16 * s);
  }
  float cba[2], cbx[2], csp[2];
#pragma unroll
  for (int nt = 0; nt < 2; ++nt) {
    const int ch = (l * 2 + dir) * 256 + nblk * 64 + nt * 32 + l31;
    cba[nt] = p.rg_ba[ch];
    cbx[nt] = p.rg_bx[ch];
    csp[nt] = p.rg_lambda[ch];
  }
  float2* agg1 = (float2*)p.agg;
  float2* agg2 = (float2*)p.agg + (size_t)8 * 2 * 136 * 256;
  const int pos2 = dir ? (seg == 0 ? 1 - blk : 33 - blk) : (seg == 0 ? blk : 2 + blk);
  float hin = 0.f;
  uint4 gq[2];
  if (mode == 1) {
    const float2* a2 = agg2 + ((size_t)(b * 2 + dir) * 34) * 256 + nblk * 64 + lane;
    const float2* a1 = agg1 + ((size_t)(b * 2 + dir) * 136 + (cg32 - ck)) * 256 + nblk * 64 + lane;
    const int npre = dir ? 3 - ck : ck;
    float2 ga[34], gb[3];
    const int pm1 = pos2 > 0 ? pos2 - 1 : 0;
#pragma unroll
    for (int j = 0; j < 34; ++j) ga[j] = a2[(size_t)(j < pm1 ? j : pm1) * 256];
#pragma unroll
    for (int i = 0; i < 3; ++i) { const int ii = i < npre ? i : 0; gb[i] = a1[(size_t)(dir ? 3 - ii : ii) * 256]; }
    {
      const int tok = 16 * dir + (lane >> 2), c16 = (lane & 3) * 16;
      const u16* gp = p.rg + ((size_t)tokbase + T0 + tok) * 512 + 256 + nblk * 64 + c16;
      gq[0] = *(const uint4*)gp; gq[1] = *(const uint4*)(gp + 8);
    }
#pragma unroll
    for (int j = 0; j < 34; ++j) hin = (j < pos2) ? ga[j].x * hin + ga[j].y : hin;
#pragma unroll
    for (int i = 0; i < 3; ++i) hin = (i < npre) ? gb[i].x * hin + gb[i].y : hin;
  }
#pragma unroll
  for (int nt = 0; nt < 2; ++nt) csp[nt] = __logf(1.0f + __expf(-csp[nt]));
#pragma unroll
  for (int i = 0; i < 5; ++i) {
    const int idx = lane + 64 * i;
    const int row = idx >> 3, chunk = idx & 7;
    if (row < 35) *(uint4*)(xs + row * 64 + chunk * 8) = xt[i];
  }
  asm volatile("s_waitcnt lgkmcnt(0)" ::: "memory");
  {
    float x0 = bf2f(xs[0 * 64 + lane]), x1 = bf2f(xs[1 * 64 + lane]), x2 = bf2f(xs[2 * 64 + lane]);
#pragma unroll
    for (int t = 0; t < 32; ++t) {
      const float x3 = bf2f(xs[(t + 3) * 64 + lane]);
      const float xc = ccb + cw0 * x0 + cw1 * x1 + cw2 * x2 + cw3 * x3;
      xcf[t * 68 + lane] = xc;
      *(u16*)(xcb + swz128(t, lane >> 3) + (lane & 7) * 2) = f2bf(xc);
      x0 = x1; x1 = x2; x2 = x3;
    }
  }
  asm volatile("s_waitcnt lgkmcnt(0)" ::: "memory");
  float Av[2][16], Bv[2][16];
  {
    f32x16 acc[2][2];
#pragma unroll
    for (int gate = 0; gate < 2; ++gate)
#pragma unroll
      for (int nt = 0; nt < 2; ++nt) acc[gate][nt] = zero16();
#pragma unroll
    for (int s = 0; s < 4; ++s) {
      const bf16x8 af = *(const bf16x8*)(xcb + swz128(l31, 2 * s + hh));
#pragma unroll
      for (int gate = 0; gate < 2; ++gate)
#pragma unroll
        for (int nt = 0; nt < 2; ++nt) acc[gate][nt] = mfma32(af, wf[gate][nt][s], acc[gate][nt]);
    }
#pragma unroll
    for (int nt = 0; nt < 2; ++nt)
#pragma unroll
      for (int e = 0; e < 16; ++e) {
        const int tok = (e & 3) + 8 * (e >> 2) + 4 * hh;
        const float r = sigmoidf_(acc[0][nt][e] + cba[nt]);
        const float ii = sigmoidf_(acc[1][nt][e] + cbx[nt]);
        const float la = -8.0f * r * csp[nt];
        const float av = __expf(la);
        const float e2 = 2.0f * la;
        const float om = (e2 > -0.1f) ? (-e2 * (1.0f + e2 * (0.5f + e2 * (0.16666667f + e2 * 0.041666668f)))) : (1.0f - __expf(e2));
        Av[nt][e] = av;
        Bv[nt][e] = sqrtf(om) * ii * xcf[tok * 68 + nt * 32 + l31];
      }
  }
  float H[2][16];
#pragma unroll
  for (int nt = 0; nt < 2; ++nt)
#pragma unroll
    for (int e = 0; e < 16; ++e) H[nt][e] = 0.f;
  float carry[2] = {0.f, 0.f};
  if (mode == 0) {
    if (dir) rg_scan32<1>(Av, Bv, carry, H, hh); else rg_scan32<0>(Av, Bv, carry, H, hh);
    float P[2];
#pragma unroll
    for (int nt = 0; nt < 2; ++nt) {
      float pr = 1.f;
#pragma unroll
      for (int e = 0; e < 16; ++e) pr *= Av[nt][e];
      P[nt] = pr * shx(pr, 32);
    }
    const float2 mine = make_float2(hh ? P[1] : P[0], hh ? carry[1] : carry[0]);
    agg1[((size_t)(b * 2 + dir) * 136 + cg32) * 256 + nblk * 64 + lane] = mine;
    blockagg[(ck * 2 + dir) * 64 + lane] = mine;
    __syncthreads();
    if (wid < 2) {
      const int d2 = wid;
      float A = 1.f, B = 0.f;
#pragma unroll
      for (int co = 0; co < 4; ++co) {
        const int c = d2 ? 3 - co : co;
        const float2 g = blockagg[(c * 2 + d2) * 64 + lane];
        B = g.x * B + g.y;
        A *= g.x;
      }
      const int p2 = d2 ? (seg == 0 ? 1 - blk : 33 - blk) : (seg == 0 ? blk : 2 + blk);
      agg2[((size_t)(b * 2 + d2) * 34 + p2) * 256 + nblk * 64 + lane] = make_float2(A, B);
    }
    __syncthreads();
    return;
  }
  carry[0] = shf(hin, l31);
  carry[1] = shf(hin, 32 + l31);
  if (dir) rg_scan32<1>(Av, Bv, carry, H, hh); else rg_scan32<0>(Av, Bv, carry, H, hh);
  asm volatile("s_waitcnt lgkmcnt(0)" ::: "memory");
#pragma unroll
  for (int nt = 0; nt < 2; ++nt)
#pragma unroll
    for (int e = 0; e < 16; ++e) xcf[((e & 3) + 8 * (e >> 2) + 4 * hh) * 68 + nt * 32 + l31] = H[nt][e];
  __syncthreads();
  {
    const float* hfT = (const float*)(smem + (ck * 2 + 0) * 17408 + 8704);
    const float* hbT = (const float*)(smem + (ck * 2 + 1) * 17408 + 8704);
    const int tok = 16 * dir + (lane >> 2), c16 = (lane & 3) * 16;
    const size_t gtok = (size_t)tokbase + T0 + tok;
    u16* op = p.ycat + gtok * 1024 + 768 + nblk * 64 + c16;
#pragma unroll
    for (int hv = 0; hv < 2; ++hv) {
      const uint4 g = gq[hv];
      const float4 f0 = *(const float4*)(hfT + tok * 68 + c16 + hv * 8), f1 = *(const float4*)(hfT + tok * 68 + c16 + hv * 8 + 4);
      const float4 h0 = *(const float4*)(hbT + tok * 68 + c16 + hv * 8), h1 = *(const float4*)(hbT + tok * 68 + c16 + hv * 8 + 4);
      uint4 o;
      o.x = pk2((f0.x + h0.x) * gelu_tanh(bflo(g.x)), (f0.y + h0.y) * gelu_tanh(bfhi(g.x)));
      o.y = pk2((f0.z + h0.z) * gelu_tanh(bflo(g.y)), (f0.w + h0.w) * gelu_tanh(bfhi(g.y)));
      o.z = pk2((f1.x + h1.x) * gelu_tanh(bflo(g.z)), (f1.y + h1.y) * gelu_tanh(bfhi(g.z)));
      o.w = pk2((f1.z + h1.z) * gelu_tanh(bflo(g.w)), (f1.w + h1.w) * gelu_tanh(bfhi(g.w)));
      *(uint4*)(op + hv * 8) = o;
    }
  }
  __syncthreads();
}

__device__ __forceinline__ void attn_wave(const P& p, int l, int b, int h, bool local, int r, int half, int qtok0, const float* rpbL) {
  const int lane = opaque_tid() & 63, q = lane & 31, hh = lane >> 5;
  bf16x8 qf[4];
  {
    const u16* qp = p.qk + (size_t)(qtok0 + q) * 1024 + h * 64 + 8 * hh;
#pragma unroll
    for (int s = 0; s < 4; ++s) qf[s] = *(const bf16x8*)(qp + 16 * s);
  }
  f32x16 o0 = zero16(), o1 = zero16();
  float m_run = -1e30f, l_run = 0.f;
  const int pi = (q & 19) | ((q & 4) << 1) | ((q & 8) >> 1);
  const int w = half * 32 + q;
  const int st = min(max(w - 8, 0), 48);
  const int rs = min(max(r - 4, 0), 56);
  const int ntiles = local ? 24 : 8;
  bf16x8 kfn[4], vfn[2][2];
  auto tile_load = [&](int ti, bf16x8 (&kfo)[4], bf16x8 (&vfo)[2][2]) {
    int ktok0, vstride;
    const u16* vb;
    if (ti < 8) {
      ktok0 = NLAT + b * 256 + ti * 32;
      vb = p.vTc + ((size_t)(b * 512 + h * 64)) * 256 + ti * 32;
      vstride = 256;
    } else {
      const int tl = ti - 8;
      const int a2 = tl >> 1, g2 = tl & 1;
      ktok0 = b * 4096 + (rs + a2) * 64 + g2 * 32;
      vb = p.vT + ((size_t)(b * 512 + h * 64)) * 4096 + (rs + a2) * 64 + g2 * 32;
      vstride = 4096;
    }
    const u16* kp = p.qk + (size_t)(ktok0 + pi) * 1024 + 512 + h * 64 + 8 * hh;
#pragma unroll
    for (int s = 0; s < 4; ++s) kfo[s] = *(const bf16x8*)(kp + 16 * s);
#pragma unroll
    for (int dt = 0; dt < 2; ++dt)
#pragma unroll
      for (int s2 = 0; s2 < 2; ++s2) vfo[dt][s2] = *(const bf16x8*)(vb + (size_t)(dt * 32 + q) * vstride + 16 * s2 + 8 * hh);
  };
  tile_load(0, kfn, vfn);
  for (int ti = 0; ti < ntiles; ++ti) {
    int a = 0, g = 0;
    if (ti >= 8) { a = (ti - 8) >> 1; g = (ti - 8) & 1; }
    bf16x8 kf[4], vf[2][2];
#pragma unroll
    for (int s = 0; s < 4; ++s) kf[s] = kfn[s];
#pragma unroll
    for (int dt = 0; dt < 2; ++dt)
#pragma unroll
      for (int s2 = 0; s2 < 2; ++s2) vf[dt][s2] = vfn[dt][s2];
    if (ti + 1 < ntiles) tile_load(ti + 1, kfn, vfn);
    f32x16 sacc = zero16();
#pragma unroll
    for (int s = 0; s < 4; ++s) sacc = mfma32(kf[s], qf[s], sacc);
    float sv[16];
    float tmax = -1e30f;
#pragma unroll
    for (int e = 0; e < 16; ++e) {
      float x = sacc[e] * 0.125f;
      if (ti >= 8) {
        const int kc = g * 32 + (e & 7) + 8 * hh + 16 * (e >> 3);
        const bool valid = (kc >= st) && (kc < st + 16);
        const int bi = valid ? ((rs + a - r + 7) * 31 + (kc - w + 15)) : 0;
        const float bias = rpbL[bi];
        x = valid ? (x + bias) : -1e30f;
      }
      sv[e] = x;
      tmax = fmaxf(tmax, x);
    }
    tmax = fmaxf(tmax, shx(tmax, 32));
    const float m_new = fmaxf(m_run, tmax);
    const float alpha = __expf(m_run - m_new);
    m_run = m_new;
    l_run *= alpha;
#pragma unroll
    for (int e = 0; e < 16; ++e) { o0[e] *= alpha; o1[e] *= alpha; }
    float psum = 0.f;
#pragma unroll
    for (int e = 0; e < 16; ++e) { const float pe = __expf(sv[e] - m_new); sv[e] = pe; psum += pe; }
    l_run += psum;
    bf16x8 pf[2];
#pragma unroll
    for (int s2 = 0; s2 < 2; ++s2) {
      union { bf16x8 v; unsigned u[4]; } cv;
#pragma unroll
      for (int j = 0; j < 4; ++j) cv.u[j] = pk2(sv[8 * s2 + 2 * j], sv[8 * s2 + 2 * j + 1]);
      pf[s2] = cv.v;
    }
#pragma unroll
    for (int s2 = 0; s2 < 2; ++s2) {
      o0 = mfma32(vf[0][s2], pf[s2], o0);
      o1 = mfma32(vf[1][s2], pf[s2], o1);
    }
  }
  const float lt = l_run + shx(l_run, 32);
  const float inv = 1.0f / lt;
  u16* op = p.ycat + (size_t)(qtok0 + q) * 1024 + h * 64;
#pragma unroll
  for (int qd = 0; qd < 4; ++qd) {
    uint2 a0, a1;
    a0.x = pk2(o0[4 * qd] * inv, o0[4 * qd + 1] * inv);
    a0.y = pk2(o0[4 * qd + 2] * inv, o0[4 * qd + 3] * inv);
    a1.x = pk2(o1[4 * qd] * inv, o1[4 * qd + 1] * inv);
    a1.y = pk2(o1[4 * qd + 2] * inv, o1[4 * qd + 3] * inv);
    *(uint2*)(op + 8 * qd + 4 * hh) = a0;
    *(uint2*)(op + 32 + 8 * qd + 4 * hh) = a1;
  }
}
__device__ __forceinline__ void attn_block_task(const P& p, int l, int b, int h, int rg4, char* smem) {
  const int tid = opaque_tid(), lane = tid & 63, wid = tid >> 6;
  const int q = lane & 31, hh = lane >> 5;
  const int R0 = rg4 * 4;
  const int r = R0 + (wid >> 1), half = wid & 1;
  float* rpbL = (float*)(smem + 32768) + 64;
  for (int i = tid; i < 465; i += NTHR) rpbL[i] = p.na_rpb[(size_t)(l * 8 + h) * 465 + i] * 1.4426950408889634f;
  const int lo = min(max(R0 - 4, 0), 56);
  const int hi = min(max(R0 + 3 - 4, 0), 56) + 7;
  const int ntile = 4 + (hi - lo + 1);
  const int rs = min(max(r - 4, 0), 56);
  const int qtok = b * 4096 + r * 64 + half * 32 + q;
  bf16x8 qf[4];
  {
    const u16* qp = p.qk + (size_t)qtok * 1024 + h * 64 + 8 * hh;
#pragma unroll
    for (int s = 0; s < 4; ++s) qf[s] = *(const bf16x8*)(qp + 16 * s);
  }
  f32x16 o0 = zero16(), o1 = zero16();
  float m_run = -1e30f, l_run = 0.f;
  const int pi = (q & 19) | ((q & 4) << 1) | ((q & 8) >> 1);
  const int w = half * 32 + q;
  const int st = min(max(w - 8, 0), 48);
  unsigned vmask = 0u;
#pragma unroll
  for (int g = 0; g < 2; ++g)
#pragma unroll
    for (int e = 0; e < 16; ++e) {
      const int kc = g * 32 + (e & 7) + 8 * hh + 16 * (e >> 3);
      vmask |= ((kc >= st) && (kc < st + 16)) ? (1u << (g * 16 + e)) : 0u;
    }
  const int cbase = 8 * hh - w + 15;
  const int srow = tid >> 3, sch = tid & 7;
  uint4 rkA, rvA, rkB, rvB;
  auto gload = [&](int ti, uint4& rk, uint4& rv) {
    int ktok0, vstride;
    const u16* vb;
    if (ti < 4) { ktok0 = NLAT + b * 256 + ti * 64; vb = p.vTc + ((size_t)(b * 512 + h * 64)) * 256 + ti * 64; vstride = 256; }
    else { const int R = lo + ti - 4; ktok0 = b * 4096 + R * 64; vb = p.vT + ((size_t)(b * 512 + h * 64)) * 4096 + R * 64; vstride = 4096; }
    rk = *(const uint4*)(p.qk + (size_t)(ktok0 + srow) * 1024 + 512 + h * 64 + sch * 8);
    rv = *(const uint4*)(vb + (size_t)srow * vstride + sch * 8);
  };
  gload(0, rkA, rvA);
  *(uint4*)(smem + swz128(srow, sch)) = rkA;
  *(uint4*)(smem + 16384 + swz128(srow, sch)) = rvA;
  gload(1, rkA, rvA);
  if (2 < ntile) gload(2, rkB, rvB);
  __syncthreads();
  auto compute = [&](int ti) {
    const char* Kb = smem + (ti & 1) * 8192;
    const char* Vb = smem + 16384 + (ti & 1) * 8192;
    const int R = lo + ti - 4;
    const bool active = (ti < 4) || (R >= rs && R < rs + 8);
    if (active) {
      f32x16 sacc0 = zero16(), sacc1 = zero16();
#pragma unroll
      for (int s = 0; s < 4; ++s) {
        const bf16x8 kf0 = *(const bf16x8*)(Kb + swz128(pi, 2 * s + hh));
        const bf16x8 kf1 = *(const bf16x8*)(Kb + swz128(32 + pi, 2 * s + hh));
        sacc0 = mfma32(kf0, qf[s], sacc0);
        sacc1 = mfma32(kf1, qf[s], sacc1);
      }
      float sv[32];
      float tmax = -1e30f;
      if (ti >= 4) {
        const float* brow = rpbL + (R - r + 7) * 31 + cbase;
        float bias[32];
#pragma unroll
        for (int g = 0; g < 2; ++g)
#pragma unroll
          for (int e = 0; e < 16; ++e) bias[g * 16 + e] = brow[g * 32 + (e & 7) + 16 * (e >> 3)];
#pragma unroll
        for (int g = 0; g < 2; ++g)
#pragma unroll
          for (int e = 0; e < 16; ++e) {
            const float sc = g ? sacc1[e] : sacc0[e];
            const float x = ((int)(vmask << (31 - (g * 16 + e))) < 0) ? fmaf(sc, 0.18033688011112042f, bias[g * 16 + e]) : -1e30f;
            sv[g * 16 + e] = x;
            tmax = fmaxf(tmax, x);
          }
      } else {
#pragma unroll
        for (int g = 0; g < 2; ++g)
#pragma unroll
          for (int e = 0; e < 16; ++e) {
            const float x = (g ? sacc1[e] : sacc0[e]) * 0.18033688011112042f;
            sv[g * 16 + e] = x;
            tmax = fmaxf(tmax, x);
          }
      }
      tmax = fmaxf(tmax, shx(tmax, 32));
      if (__builtin_amdgcn_ballot_w64(tmax > m_run) != 0ull) {
        const float m_new = fmaxf(m_run, tmax);
        const float alpha = __builtin_amdgcn_exp2f(m_run - m_new);
        m_run = m_new;
        l_run *= alpha;
#pragma unroll
        for (int e = 0; e < 16; ++e) { o0[e] *= alpha; o1[e] *= alpha; }
      }
      float psum = 0.f;
#pragma unroll
      for (int e = 0; e < 32; ++e) { const float pe = __builtin_amdgcn_exp2f(sv[e] - m_run); sv[e] = pe; psum += pe; }
      l_run += psum;
#pragma unroll
      for (int g = 0; g < 2; ++g)
#pragma unroll
        for (int s2 = 0; s2 < 2; ++s2) {
          union { bf16x8 v; unsigned u[4]; } cv;
#pragma unroll
          for (int j = 0; j < 4; ++j) cv.u[j] = pk2(sv[g * 16 + 8 * s2 + 2 * j], sv[g * 16 + 8 * s2 + 2 * j + 1]);
          const bf16x8 v0 = *(const bf16x8*)(Vb + swz128(q, g * 4 + 2 * s2 + hh));
          const bf16x8 v1 = *(const bf16x8*)(Vb + swz128(32 + q, g * 4 + 2 * s2 + hh));
          o0 = mfma32(v0, cv.v, o0);
          o1 = mfma32(v1, cv.v, o1);
        }
    }
  };
  for (int ti = 0; ti < ntile; ti += 2) {
    compute(ti);
    if (ti + 1 < ntile) {
      *(uint4*)(smem + 8192 + swz128(srow, sch)) = rkA;
      *(uint4*)(smem + 16384 + 8192 + swz128(srow, sch)) = rvA;
      if (ti + 3 < ntile) gload(ti + 3, rkA, rvA);
    }
    __syncthreads();
    if (ti + 1 < ntile) {
      compute(ti + 1);
      if (ti + 2 < ntile) {
        *(uint4*)(smem + swz128(srow, sch)) = rkB;
        *(uint4*)(smem + 16384 + swz128(srow, sch)) = rvB;
        if (ti + 4 < ntile) gload(ti + 4, rkB, rvB);
      }
      __syncthreads();
    }
  }
  const float lt = l_run + shx(l_run, 32);
  const float inv = 1.0f / lt;
  __syncthreads();
  {
    char* ot = smem + wid * 4608;
#pragma unroll
    for (int qd = 0; qd < 4; ++qd) {
      uint2 a0, a1;
      a0.x = pk2(o0[4 * qd] * inv, o0[4 * qd + 1] * inv);
      a0.y = pk2(o0[4 * qd + 2] * inv, o0[4 * qd + 3] * inv);
      a1.x = pk2(o1[4 * qd] * inv, o1[4 * qd + 1] * inv);
      a1.y = pk2(o1[4 * qd + 2] * inv, o1[4 * qd + 3] * inv);
      *(uint2*)(ot + q * 144 + (8 * qd + 4 * hh) * 2) = a0;
      *(uint2*)(ot + q * 144 + (32 + 8 * qd + 4 * hh) * 2) = a1;
    }
    asm volatile("s_waitcnt lgkmcnt(0)" ::: "memory");
    const int tok0 = b * 4096 + r * 64 + half * 32;
#pragma unroll
    for (int it = 0; it < 4; ++it) {
      const int qq = it * 8 + (lane >> 3), ch = lane & 7;
      const uint4 v = *(const uint4*)(ot + qq * 144 + ch * 16);
      *(uint4*)(p.ycat + (size_t)(tok0 + qq) * 1024 + h * 64 + ch * 8) = v;
    }
  }
  __syncthreads();
}
__device__ __forceinline__ void attn_task(const P& p, int l, int kind, int idx, char* smem) {
  const int tid_ = opaque_tid(); const int lane = tid_ & 63, wid = tid_ >> 6;
  float* rpbL = (float*)smem + wid * 480;
  for (int i = lane; i < 465; i += 64) rpbL[i] = p.na_rpb[(size_t)(l * 8 + wid) * 465 + i];
  __syncthreads();
  if (kind == 0) {
    const int half = idx & 1, r = (idx >> 1) & 63, b = idx >> 7;
    attn_wave(p, l, b, wid, true, r, half, b * 4096 + r * 64 + half * 32, rpbL);
  } else {
    const int qg = idx & 7, b = idx >> 3;
    attn_wave(p, l, b, wid, false, 0, 0, NLAT + b * 256 + qg * 32, rpbL);
  }
  __syncthreads();
}

__device__ __forceinline__ void phase_mixers(const P& p, int l, char* smem, unsigned* counter) {
  const bool last = (l == 1);
  const int n_rg = 1088 * XRGA, n_fft = 1024 * XFFT, n_hc = last ? 0 : 256, n_att = 1024 * XATT, n_attc = last ? 0 : 64;
  const int total = n_rg + n_fft + n_hc + n_att + n_attc;
  volatile int* s_taskp = (volatile int*)(smem + SMEM_BYTES - 16);
  for (;;) {
    __syncthreads();
    if (threadIdx.x == 0) *s_taskp = (int)atomicAdd(counter, 1u);
    __syncthreads();
    int t = *s_taskp;
    if (t >= total) break;
    if (t < n_att) { t &= 1023; attn_block_task(p, l, t >> 7, (t >> 4) & 7, t & 15, smem); continue; }
    t -= n_att;
    if (t < n_attc) { attn_task(p, l, 1, t, smem); continue; }
    t -= n_attc;
    if (t < n_fft) { t &= 1023; hyena_fft_task(p, l, t >> 2, t & 3, smem); continue; }
    t -= n_fft;
    if (t < n_hc) { hyena_ctx_task(p, l, t >> 5, t & 31, smem); continue; }
    t -= n_hc;
    if (t >= 1088) t -= 1088;
    rg_wave_task(p, l, t >> 2, t & 3, 0, last, smem);
  }
}

__device__ __forceinline__ void merge_tile(const P& p, int l, int mt, int nt, char* smem) {
  EPI_VARS
  const int m0 = mt * 256, n0 = nt * 128;
  f32x16 macc[2][2];
  zero_acc(macc);
  for (int br = 0; br < 3; ++br) {
    unsigned* gpl = (unsigned*)(smem + 98304) + tid;
    {
      f32x16 acc[2][2];
      zero_acc(acc);
      gemm_kloop(acc, p.xn + (size_t)m0 * 1024, 1024, p.WgT + ((size_t)l * 3072 + br * 1024 + n0) * 1024, 1024, 1024, smem);
#pragma unroll
      for (int j = 0; j < 2; ++j) {
        const float bg = p.b_gate[l * 3072 + br * 1024 + n0 + EPI_COL(j)];
#pragma unroll
        for (int i = 0; i < 2; ++i)
#pragma unroll
          for (int e = 0; e < 4; ++e) {
            const unsigned q0 = (unsigned)(sigmoidf_(acc[i][j][4 * e] + bg) * 255.0f + 0.5f);
            const unsigned q1 = (unsigned)(sigmoidf_(acc[i][j][4 * e + 1] + bg) * 255.0f + 0.5f);
            const unsigned q2 = (unsigned)(sigmoidf_(acc[i][j][4 * e + 2] + bg) * 255.0f + 0.5f);
            const unsigned q3 = (unsigned)(sigmoidf_(acc[i][j][4 * e + 3] + bg) * 255.0f + 0.5f);
            gpl[((i * 2 + j) * 4 + e) * 512] = q0 | (q1 << 8) | (q2 << 16) | (q3 << 24);
          }
      }
    }
    {
      f32x16 acc[2][2];
      zero_acc(acc);
      const u16* A; const u16* B; int K;
      if (br == 0) { A = p.ycat + (size_t)m0 * 1024; B = p.WaT + ((size_t)l * 1024 + n0) * 512; K = 512; }
      else if (br == 1) { A = p.ycat + (size_t)m0 * 1024 + 512; B = p.WbT + ((size_t)l * 1024 + n0) * 256; K = 256; }
      else { A = p.ycat + (size_t)m0 * 1024 + 768; B = p.WcT + ((size_t)l * 1024 + n0) * 256; K = 256; }
      gemm_kloop(acc, A, 1024, B, K, K, smem);
#pragma unroll
      for (int i = 0; i < 2; ++i)
#pragma unroll
        for (int j = 0; j < 2; ++j)
#pragma unroll
          for (int e = 0; e < 4; ++e) {
            const unsigned g4 = gpl[((i * 2 + j) * 4 + e) * 512];
            macc[i][j][4 * e] += (float)(g4 & 255u) * (1.0f / 255.0f) * acc[i][j][4 * e];
            macc[i][j][4 * e + 1] += (float)((g4 >> 8) & 255u) * (1.0f / 255.0f) * acc[i][j][4 * e + 1];
            macc[i][j][4 * e + 2] += (float)((g4 >> 16) & 255u) * (1.0f / 255.0f) * acc[i][j][4 * e + 2];
            macc[i][j][4 * e + 3] += (float)(g4 >> 24) * (1.0f / 255.0f) * acc[i][j][4 * e + 3];
          }
    }
  }
#pragma unroll
  for (int i = 0; i < 2; ++i)
#pragma unroll
    for (int j = 0; j < 2; ++j)
#pragma unroll
      for (int e = 0; e < 16; ++e)
        p.mbuf[(size_t)(m0 + EPI_ROW(i, e)) * 1024 + n0 + EPI_COL(j)] = f2bf(macc[i][j][e]);
}
__device__ __forceinline__ void outproj_tile(const P& p, int l, int mt, int nt, char* smem, bool do_store) {
  EPI_VARS
  const int m0 = mt * 256, n0 = nt * 128;
  f32x16 acc[2][2];
  zero_acc(acc);
  gemm_kloop(acc, p.mbuf + (size_t)m0 * 1024, 1024, p.WoT + ((size_t)l * 1024 + n0) * 1024, 1024, 1024, smem);
  const bool isctx = (mt >= 128);
  const int bi = isctx ? 8 : (mt >> 4);
  const float* gatev = p.mod + ((size_t)(l * 9 + bi) * 6 + 2) * 1024;
  const float* src; float* dst;
  if (isctx) { src = (l == 0 ? p.ctx : p.ctxs) - (size_t)NLAT * 1024; dst = p.ctxs - (size_t)NLAT * 1024; }
  else { src = (l == 0 ? p.x : p.out); dst = p.out; }
#pragma unroll
  for (int j = 0; j < 2; ++j) {
    const int col = n0 + EPI_COL(j);
    const float gv = gatev[col];
#pragma unroll
    for (int i = 0; i < 2; ++i)
#pragma unroll
      for (int e = 0; e < 16; ++e) {
        const size_t o = (size_t)(m0 + EPI_ROW(i, e)) * 1024 + col;
        if (do_store) dst[o] = src[o] + gv * acc[i][j][e];
      }
  }
}

__device__ __forceinline__ void wqk_task(const P& p, int l, int hp, int nt, char* smem) {
  EPI_VARS
  f32x16 acc[2][2];
  zero_acc(acc);
  gemm_kloop(acc, p.keysB + ((size_t)l * 16 + hp) * 16384, 128, p.WqB + (size_t)l * 1024 * 2048 + (size_t)(nt * 128) * 2048 + hp * 128, 2048, 128, smem);
  if (wm < 2) {
#pragma unroll
    for (int i = 0; i < 2; ++i)
#pragma unroll
      for (int j = 0; j < 2; ++j)
#pragma unroll
        for (int e = 0; e < 16; ++e)
          p.WqkT[((size_t)l * 2048 + hp * 128 + EPI_ROW(i, e)) * 1024 + nt * 128 + EPI_COL(j)] = f2bf(acc[i][j][e]);
  }
}
__device__ __forceinline__ void ins16(unsigned (&L)[16], unsigned x) {
#pragma unroll
  for (int i = 0; i < 16; ++i) {
    const unsigned hi = max(L[i], x);
    x = min(L[i], x);
    L[i] = hi;
  }
}
__device__ __forceinline__ unsigned f2sort(float f) {
  const unsigned b = __float_as_uint(f);
  return b ^ ((unsigned)((int)b >> 31) | 0x80000000u);
}
__device__ __forceinline__ float sort2f(unsigned k) {
  const unsigned u = k & ~127u;
  const unsigned b = (u & 0x80000000u) ? (u ^ 0x80000000u) : ~u;
  return __uint_as_float(b);
}
__device__ __forceinline__ void cx_desc(unsigned& a, unsigned& b) { const unsigned hi = max(a, b), lo = min(a, b); a = hi; b = lo; }
template <int BASE> __device__ __forceinline__ void sort16_desc(unsigned (&k)[64]) {
#pragma unroll
  for (int sz = 2; sz <= 16; sz <<= 1) {
#pragma unroll
    for (int j = sz >> 1; j >= 1; j >>= 1) {
#pragma unroll
      for (int i = 0; i < 16; ++i) {
        const int l2 = i ^ j;
        if (l2 > i) {
          if ((i & sz) == 0) cx_desc(k[BASE + i], k[BASE + l2]);
          else cx_desc(k[BASE + l2], k[BASE + i]);
        }
      }
    }
  }
}
template <int AB, int BB> __device__ __forceinline__ void merge16_desc(unsigned (&k)[64]) {
#pragma unroll
  for (int i = 0; i < 16; ++i) k[AB + i] = max(k[AB + i], k[BB + 15 - i]);
#pragma unroll
  for (int j = 8; j >= 1; j >>= 1) {
#pragma unroll
    for (int i = 0; i < 16; ++i)
      if ((i & j) == 0) cx_desc(k[AB + i], k[AB + i + j]);
  }
}
#define PS_LOAD(mt_, hp_) do { _Pragma("unroll") for (int it = 0; it < 8; ++it) { const int id = tid + NTHR * it; \
    pre[it] = *(const uint4*)(p.q + (size_t)((mt_) * 256 + (id >> 4)) * 2048 + (hp_) * 128 + (id & 15) * 8); } } while (0)
__device__ __forceinline__ void peer_score_tile(const P& p, int l, int mt, int hp, char* smem, uint4& p0, uint4& p1, uint4& p2, uint4& p3, uint4& p4, uint4& p5, uint4& p6, uint4& p7, int nmt, int nhp) {
  const int tid = opaque_tid();
  const int m0 = mt * 256;
  const int row = tid >> 1, hf = tid & 1;
  {
    char* T = smem + 16384;
    uint4 pre[8] = {p0, p1, p2, p3, p4, p5, p6, p7};
#pragma unroll
    for (int it = 0; it < 8; ++it) {
      const int id = tid + NTHR * it;
      const int r = id >> 4, ch = id & 15;
      *(uint4*)(T + r * 272 + ch * 16) = pre[it];
    }
    PS_LOAD(nmt, nhp);
    p0 = pre[0]; p1 = pre[1]; p2 = pre[2]; p3 = pre[3]; p4 = pre[4]; p5 = pre[5]; p6 = pre[6]; p7 = pre[7];
  }
  __syncthreads();
  const char* sp = smem + 16384 + row * 272 + hf * 128;
  unsigned k[64];
#pragma unroll
  for (int c = 0; c < 8; ++c) {
    const uint4 r = *(const uint4*)(sp + 16 * c);
    const unsigned w[4] = {r.x, r.y, r.z, r.w};
#pragma unroll
    for (int q = 0; q < 4; ++q) {
      const float v0 = __builtin_bit_cast(_Float16, (unsigned short)(w[q] & 0xffffu));
      const float v1 = __builtin_bit_cast(_Float16, (unsigned short)(w[q] >> 16));
      const int key = hf * 64 + c * 8 + q * 2;
      k[c * 8 + q * 2] = (f2sort(v0) & ~127u) | (unsigned)key;
      k[c * 8 + q * 2 + 1] = (f2sort(v1) & ~127u) | (unsigned)(key + 1);
    }
  }
  sort16_desc<0>(k); sort16_desc<16>(k); sort16_desc<32>(k); sort16_desc<48>(k);
  merge16_desc<0, 16>(k);
  merge16_desc<32, 48>(k);
  merge16_desc<0, 32>(k);
  unsigned* X = (unsigned*)smem;
  if (hf) {
#pragma unroll
    for (int i = 0; i < 16; ++i) X[row * 16 + i] = k[i];
  }
  __syncthreads();
  if (!hf) {
#pragma unroll
    for (int i = 0; i < 16; ++i) k[16 + i] = X[row * 16 + i];
    merge16_desc<0, 16>(k);
    unsigned* o = p.topk + ((size_t)(m0 + row) * 16 + hp) * 16;
#pragma unroll
    for (int i = 0; i < 4; ++i) *(uint4*)(o + 4 * i) = make_uint4(k[4 * i], k[4 * i + 1], k[4 * i + 2], k[4 * i + 3]);
  }
  __syncthreads();
}

__device__ __forceinline__ void phase_peer_experts(const P& p, int l, bool do_store, char* smem) {
  const int tid_ = opaque_tid(); const int lane = tid_ & 63, wid = tid_ >> 6;
  const int ntok = (l == 1) ? NLAT : NTOK;
  int ci, cj;
  {
    const int e = lane;
    if (e < 16) { ci = 0; cj = e; }
    else if (e < 24) { ci = 1; cj = e - 16; }
    else if (e < 29) { ci = 2; cj = e - 24; }
    else if (e < 33) { ci = 3; cj = e - 29; }
    else if (e < 36) { ci = 4; cj = e - 33; }
    else if (e < 38) { ci = 5; cj = e - 36; }
    else if (e < 40) { ci = 6; cj = e - 38; }
    else if (e < 42) { ci = 7; cj = e - 40; }
    else { ci = min(8 + (e - 42), 15); cj = 0; }
  }
  for (int tok = blockIdx.x * 8 + wid; tok < ntok; tok += gridDim.x * 8) {
    float xr[16];
    {
      const uint4 a = *(const uint4*)(p.xn + (size_t)tok * 1024 + lane * 16);
      const uint4 b = *(const uint4*)(p.xn + (size_t)tok * 1024 + lane * 16 + 8);
      xr[0] = bflo(a.x); xr[1] = bfhi(a.x); xr[2] = bflo(a.y); xr[3] = bfhi(a.y);
      xr[4] = bflo(a.z); xr[5] = bfhi(a.z); xr[6] = bflo(a.w); xr[7] = bfhi(a.w);
      xr[8] = bflo(b.x); xr[9] = bfhi(b.x); xr[10] = bflo(b.y); xr[11] = bfhi(b.y);
      xr[12] = bflo(b.z); xr[13] = bfhi(b.z); xr[14] = bflo(b.w); xr[15] = bfhi(b.w);
    }
    typedef _Float16 h2_t __attribute__((ext_vector_type(2)));
    h2_t yh[8];
#pragma unroll
    for (int i = 0; i < 8; ++i) yh[i] = (h2_t){(_Float16)0, (_Float16)0};
    int* selw = (int*)(smem + wid * 4096);
    const unsigned* kvp = p.topk + (size_t)tok * 256 + (lane & 31);
#pragma unroll 1
    for (int hb = 0; hb < 8; hb += 4) {
      unsigned key[4]; int eidx[4];
#pragma unroll
      for (int u = 0; u < 4; ++u) {
        const unsigned kv = kvp[(hb + u) * 32];
        const unsigned k0 = shu(kv, ci);
        const unsigned k1 = shu(kv, 16 + cj);
        const float val = (lane < 50) ? (sort2f(k0) + sort2f(k1)) : -3.0e38f;
        eidx[u] = (int)((k0 & 127u) * 128u + (k1 & 127u));
        key[u] = (f2sort(val) & ~63u) | (unsigned)lane;
      }
#pragma unroll
      for (int k = 2; k <= 64; k <<= 1) {
#pragma unroll
        for (int j = k >> 1; j >= 1; j >>= 1) {
          const bool take_max = (((lane & j) == 0) == ((lane & k) == 0));
#pragma unroll
          for (int u = 0; u < 4; ++u) {
            unsigned ok;
            if (j == 1) ok = xorl<1>(key[u], lane); else if (j == 2) ok = xorl<2>(key[u], lane); else if (j == 4) ok = xorl<4>(key[u], lane);
            else if (j == 8) ok = xorl<8>(key[u], lane); else if (j == 16) ok = xorl<16>(key[u], lane); else ok = xorl<32>(key[u], lane);
            key[u] = take_max ? max(key[u], ok) : min(key[u], ok);
          }
        }
      }
#pragma unroll
      for (int u = 0; u < 4; ++u) {
        const int si = __builtin_amdgcn_ds_bpermute((int)(key[u] & 63u) << 2, eidx[u]);
        const unsigned ku = key[u] & ~63u;
        const float sv = __uint_as_float((ku & 0x80000000u) ? (ku ^ 0x80000000u) : ~ku);
        const float mx = __builtin_bit_cast(float, __builtin_amdgcn_readlane(__builtin_bit_cast(int, sv), 0));
        const float ex = (lane < 16) ? __builtin_amdgcn_exp2f((sv - mx) * 1.4426950408889634f) : 0.f;
        const float sm = wave_sum(ex);
        selw[(hb + u) * 64 + lane] = si;
        selw[512 + (hb + u) * 64 + lane] = __builtin_bit_cast(int, ex * __builtin_amdgcn_rcpf(sm));
      }
    }
    {
      int w[4];
#pragma unroll
      for (int i = 0; i < 4; ++i) {
        int t = __builtin_amdgcn_cvt_pk_fp8_f32(xr[4 * i], xr[4 * i + 1], 0, false);
        w[i] = __builtin_amdgcn_cvt_pk_fp8_f32(xr[4 * i + 2], xr[4 * i + 3], t, true);
      }
      *(uint4*)(smem + 32768 + wid * 1024 + lane * 16) = make_uint4((unsigned)w[0], (unsigned)w[1], (unsigned)w[2], (unsigned)w[3]);
    }
    asm volatile("s_waitcnt lgkmcnt(0)" ::: "memory");
    const int e15 = lane & 15, g4 = lane >> 4;
#pragma unroll 1
    for (int h = 0; h < 8; ++h) {
      const int eperm_h = selw[h * 64 + lane];
      const int gperm_h = selw[512 + h * 64 + lane];
      const int ide = (int)shu((unsigned)eperm_h, e15);
      const unsigned char* ub = p.Ub + (size_t)ide * 1024 + g4 * 16;
      uint4 ua[8];
#pragma unroll
      for (int sI = 0; sI < 8; ++sI) ua[sI] = *(const uint4*)(ub + sI * 64);
      pg8::f32x4 hacc = {0.f, 0.f, 0.f, 0.f};
#pragma unroll
      for (int sI = 0; sI < 8; ++sI) {
        const uint4 b0 = *(const uint4*)(smem + 32768 + wid * 1024 + sI * 128 + g4 * 16);
        const uint4 b1 = *(const uint4*)(smem + 32768 + wid * 1024 + sI * 128 + 64 + g4 * 16);
        const i32x8 A = {(int)ua[sI].x, (int)ua[sI].y, (int)ua[sI].z, (int)ua[sI].w, 0, 0, 0, 0};
        const i32x8 B = {(int)b0.x, (int)b0.y, (int)b0.z, (int)b0.w, (int)b1.x, (int)b1.y, (int)b1.z, (int)b1.w};
        hacc = __builtin_amdgcn_mfma_scale_f32_16x16x128_f8f6f4(A, B, hacc, 4  , 0  , 0, 0x7f7f7f7f, 0, 0x7f7f7f7f);
      }
      asm volatile("" ::: "memory");
      uint2 V[16];
#pragma unroll
      for (int k = 0; k < 16; ++k) {
        const int id = __builtin_amdgcn_readlane(eperm_h, k);
        V[k] = *(const uint2*)(p.Ub + (size_t)id * 1024 + 512 + lane * 8);
      }
      float actv[4];
#pragma unroll
      for (int r4 = 0; r4 < 4; ++r4) {
        const float gl = __builtin_bit_cast(float, shu((unsigned)gperm_h, 4 * g4 + r4));
        actv[r4] = gelu_tanh(hacc[r4] * (1.0f / 64.0f)) * gl;
      }
#pragma unroll
      for (int k = 0; k < 16; ++k) {
        const float ak = __builtin_bit_cast(float, __builtin_amdgcn_readlane(__builtin_bit_cast(int, actv[k & 3]), 16 * (k >> 2)));
        const h2_t akh = {(_Float16)ak, (_Float16)ak};
        const unsigned vw[2] = {V[k].x, V[k].y};
#pragma unroll
        for (int q2 = 0; q2 < 2; ++q2) {
          yh[4 * q2 + 0] = __builtin_elementwise_fma(akh, __builtin_bit_cast(h2_t, __builtin_amdgcn_cvt_scalef32_pk_f16_fp4(vw[q2], 1.0f, 0)), yh[4 * q2 + 0]);
          yh[4 * q2 + 1] = __builtin_elementwise_fma(akh, __builtin_bit_cast(h2_t, __builtin_amdgcn_cvt_scalef32_pk_f16_fp4(vw[q2], 1.0f, 1)), yh[4 * q2 + 1]);
          yh[4 * q2 + 2] = __builtin_elementwise_fma(akh, __builtin_bit_cast(h2_t, __builtin_amdgcn_cvt_scalef32_pk_f16_fp4(vw[q2], 1.0f, 2)), yh[4 * q2 + 2]);
          yh[4 * q2 + 3] = __builtin_elementwise_fma(akh, __builtin_bit_cast(h2_t, __builtin_amdgcn_cvt_scalef32_pk_f16_fp4(vw[q2], 1.0f, 3)), yh[4 * q2 + 3]);
        }
      }
    }
    float yacc[16];
#pragma unroll
    for (int i = 0; i < 8; ++i) { yacc[2 * i] = (float)yh[i].x; yacc[2 * i + 1] = (float)yh[i].y; }
    const int bi = tok < NLAT ? (tok >> 12) : 8;
    const float* gv = p.mod + ((size_t)(l * 9 + bi) * 6 + 5) * 1024 + lane * 16;
    u16* rp = p.res + (size_t)tok * 1024 + lane * 16;
    float4 xv[4];
    float ss = 0.f;
    {
      const uint4 r0 = *(const uint4*)rp, r1 = *(const uint4*)(rp + 8);
      xv[0] = make_float4(bflo(r0.x), bfhi(r0.x), bflo(r0.y), bfhi(r0.y)); xv[1] = make_float4(bflo(r0.z), bfhi(r0.z), bflo(r0.w), bfhi(r0.w));
      xv[2] = make_float4(bflo(r1.x), bfhi(r1.x), bflo(r1.y), bfhi(r1.y)); xv[3] = make_float4(bflo(r1.z), bfhi(r1.z), bflo(r1.w), bfhi(r1.w));
    }
#pragma unroll
    for (int i = 0; i < 4; ++i) {
      const float4 g4 = *(const float4*)(gv + 4 * i);
      xv[i].x += g4.x * yacc[4 * i] * 0.25f; xv[i].y += g4.y * yacc[4 * i + 1] * 0.25f; xv[i].z += g4.z * yacc[4 * i + 2] * 0.25f; xv[i].w += g4.w * yacc[4 * i + 3] * 0.25f;
      ss += xv[i].x * xv[i].x + xv[i].y * xv[i].y + xv[i].z * xv[i].z + xv[i].w * xv[i].w;
    }
    ss = wave_sum(ss);
    const float rstd = rsqrtf(ss * (1.0f / 1024.0f) + 1e-6f);
    if (l == 0) {
      const float* gam = p.norm_mix_g + 1024 + lane * 16;
      const float* msh = p.mod + ((size_t)(9 + bi) * 6 + 0) * 1024 + lane * 16;
      const float* msc = msh + 1024;
      float yv[16];
      float amax = 0.f;
#pragma unroll
      for (int i = 0; i < 4; ++i) {
        const float4 g = *(const float4*)(gam + 4 * i);
        const float4 sh = *(const float4*)(msh + 4 * i);
        const float4 sc = *(const float4*)(msc + 4 * i);
        yv[4 * i] = xv[i].x * rstd * g.x * (1.f + sc.x) + sh.x; yv[4 * i + 1] = xv[i].y * rstd * g.y * (1.f + sc.y) + sh.y;
        yv[4 * i + 2] = xv[i].z * rstd * g.z * (1.f + sc.z) + sh.z; yv[4 * i + 3] = xv[i].w * rstd * g.w * (1.f + sc.w) + sh.w;
      }
#pragma unroll
      for (int i = 0; i < 16; ++i) amax = fmaxf(amax, fabsf(yv[i]));
      amax = fmaxf(wave_max(amax), 1e-20f);
      const float inv = 127.0f / amax;
      unsigned w[4];
#pragma unroll
      for (int i = 0; i < 4; ++i)
        w[i] = ((unsigned)__float2int_rn(yv[4 * i] * inv) & 255u) | (((unsigned)__float2int_rn(yv[4 * i + 1] * inv) & 255u) << 8) |
               (((unsigned)__float2int_rn(yv[4 * i + 2] * inv) & 255u) << 16) | (((unsigned)__float2int_rn(yv[4 * i + 3] * inv) & 255u) << 24);
      if (do_store) {
        *(uint4*)rp = make_uint4(pk2(xv[0].x, xv[0].y), pk2(xv[0].z, xv[0].w), pk2(xv[1].x, xv[1].y), pk2(xv[1].z, xv[1].w));
        *(uint4*)(rp + 8) = make_uint4(pk2(xv[2].x, xv[2].y), pk2(xv[2].z, xv[2].w), pk2(xv[3].x, xv[3].y), pk2(xv[3].z, xv[3].w));
        *(uint4*)(p.xn8 + (size_t)tok * 1024 + lane * 16) = make_uint4(w[0], w[1], w[2], w[3]);
        if (lane == 0) p.sa[tok] = amax * (1.0f / 127.0f);
      }
    } else {
      const float* fg = p.final_g + lane * 16;
      float4 gf[4];
#pragma unroll
      for (int i = 0; i < 4; ++i) gf[i] = *(const float4*)(fg + 4 * i);
#pragma unroll
      for (int i = 0; i < 4; ++i) {
        const float4 g = gf[i];
        const float4 o = make_float4(xv[i].x * rstd * g.x, xv[i].y * rstd * g.y, xv[i].z * rstd * g.z, xv[i].w * rstd * g.w);
        if (do_store) *(float4*)(p.out + (size_t)tok * 1024 + lane * 16 + 4 * i) = o;
      }
    }
  }
}


#define XB_TMO      128
#define XB_XCNT(j)  (256  + 64 * (j))
#define XB_XSUB(j)  (1280 + 64 * (j))
#define XB_XGEN(j)  (2304 + 64 * (j))
#define XB_TOP      3328
#define XB_TOPGEN   3392
#define XCD_BAR_WORDS 3456
#define XB_SPIN_CAP (1u << 22)
#define LAS __attribute__((address_space(3)))
__device__ __forceinline__ unsigned xb_ld(unsigned* p) { return __hip_atomic_load(p, __ATOMIC_RELAXED, __HIP_MEMORY_SCOPE_AGENT); }
__device__ __forceinline__ unsigned xb_add(unsigned* p, unsigned v) { return __hip_atomic_fetch_add(p, v, __ATOMIC_RELAXED, __HIP_MEMORY_SCOPE_AGENT); }
__device__ __forceinline__ unsigned xb_xcc_id() { return (unsigned)__builtin_amdgcn_s_getreg((3 << 11) | 20) & 0xFu; }
#define XB_SPIN(cond, bar) do { unsigned _sp = 0; while (cond) { __builtin_amdgcn_s_sleep(1); \
    if ((++_sp & 255u) == 0u) { if (xb_ld(&(bar)[XB_TMO])) break; if (_sp > XB_SPIN_CAP) { atomicAdd(&(bar)[XB_TMO], 1u); break; } } } } while (0)
struct XcdBarrier { unsigned* bar; unsigned x; volatile LAS unsigned* st; };
__device__ __forceinline__ XcdBarrier xcd_barrier_post(unsigned* bar, volatile LAS unsigned* st) {
  XcdBarrier b; b.bar = bar; b.x = xb_xcc_id(); b.st = st;
  if (threadIdx.x == 0) (void)xb_add(&bar[XB_XCNT(b.x)], 1u);
  return b;
}
__device__ __forceinline__ void xcd_barrier_complete(unsigned* bar, unsigned x, unsigned& nloc, unsigned& nx) {
  const unsigned G = gridDim.x * gridDim.y * gridDim.z;
  unsigned sum, cnt, mine, sp = 0u;
  for (;;) {
    sum = 0u; cnt = 0u; mine = 0u;
#pragma unroll
    for (unsigned j = 0; j < 16; ++j) { const unsigned c = xb_ld(&bar[XB_XCNT(j)]); sum += c; cnt += (c > 0u) ? 1u : 0u; mine = (j == x) ? c : mine; }
    if (sum == G) break;
    __builtin_amdgcn_s_sleep(1);
    if ((++sp & 255u) == 0u) { if (xb_ld(&bar[XB_TMO])) break; if (sp > XB_SPIN_CAP) { atomicAdd(&bar[XB_TMO], 1u); break; } }
  }
  nloc = mine > 0u ? mine : 1u; nx = cnt > 0u ? cnt : 1u;
}
__device__ __forceinline__ void xcd_barrier(unsigned* bar_u, volatile LAS unsigned* st_u) {
  XcdBarrier b; b.bar = bar_u; b.x = xb_xcc_id(); b.st = st_u;
  asm volatile("s_waitcnt vmcnt(0)" ::: "memory");
  __syncthreads();
  if (threadIdx.x == 0) {
    unsigned long long bp_ = (unsigned long long)b.bar;
    asm volatile("" : "+v"(bp_));
    unsigned* bar = (unsigned*)bp_;
    __builtin_amdgcn_s_waitcnt(0);
    unsigned nloc = b.st[0], nx = b.st[1];
    if (nloc == 0u) { xcd_barrier_complete(bar, b.x, nloc, nx); b.st[0] = nloc; b.st[1] = nx; }
    const unsigned old = xb_add(&bar[XB_XSUB(b.x)], 1u);
    const unsigned gen = old / nloc;
    if (old + 1u == (gen + 1u) * nloc) {
      __builtin_amdgcn_fence(__ATOMIC_RELEASE, "agent");
      asm volatile("s_waitcnt vmcnt(0)" ::: "memory");
      const unsigned og = xb_add(&bar[XB_TOP], 1u);
      const unsigned tg = og / nx;
      if (og + 1u == (tg + 1u) * nx) xb_add(&bar[XB_TOPGEN], 1u);
      else XB_SPIN(xb_ld(&bar[XB_TOPGEN]) == tg, bar);
      __builtin_amdgcn_fence(__ATOMIC_ACQUIRE, "agent");
      xb_add(&bar[XB_XGEN(b.x)], 1u);
      asm volatile("s_waitcnt vmcnt(0)" ::: "memory");
    } else {
      XB_SPIN(xb_ld(&bar[XB_XGEN(b.x)]) == gen, bar);
      __builtin_amdgcn_fence(__ATOMIC_ACQUIRE, "agent");
      asm volatile("s_waitcnt vmcnt(0)" ::: "memory");
    }
  }
  __syncthreads();
}

template <int l>
__device__ __forceinline__ void layer_body(const P& p, char* smem, pg8::PG8_LAS_T lds, volatile LAS unsigned* xbw, const int nb, const int bid) {
    const bool last = (l == 1);
    const int n_mt = last ? 128 : 136;
    if (l == 0) {
      phase_norm(p, l, 0);
      xcd_barrier(p.counters + 1024, xbw);
    }
_Pragma("unroll 1")
    for (int rep = 0; rep < REP_INPROJ; ++rep) {
      pg8::Gemm g; pg8::Order S;
      g.A = (const u16*)p.xn8; g.Bt = (const u16*)(p.Win8 + (size_t)l * 2816 * 1024); g.lda = 512; g.ldb = 512; g.K = 512;
      S.init(136, 6, nb, bid, 4, 5);
      pg8::EpiInprojN8 e1; e1.qk = p.qk; e1.rg = p.rg; e1.sa = p.sa; e1.sw = p.sw + l * 5888;
      pg8::gemm_phase(lds, g, S, e1);
      g.A = (const u16*)(p.Win8 + ((size_t)l * 2816 + 1024) * 1024); g.Bt = (const u16*)p.xn8;
      S.init(5, 136, nb, (bid + nb - (136 * 6) % nb) % nb);
      pg8::EpiInprojT8 e2; e2.vT = p.vT; e2.sa = p.sa; e2.sw = p.sw + l * 5888 + 1024;
      pg8::gemm_phase(lds, g, S, e2);
    }
    xcd_barrier(p.counters + 1024, xbw);
    phase_mixers(p, l, smem, p.counters + l * 4);
    xcd_barrier(p.counters + 1024, xbw);
_Pragma("unroll 1")
    for (int rep = 0; rep < REP_2B; ++rep)
      for (int task = bid; task < 1088 + 512; task += nb) {
        if (task < 1088) rg_wave_task(p, l, task >> 2, task & 3, 1, last, smem);
        else yb_transpose_task(p, (task - 1088) >> 6, (task - 1088) & 63, smem);
      }
    xcd_barrier(p.counters + 1024, xbw);
_Pragma("unroll 1")
    for (int rep = 0; rep < REP_GATE; ++rep) {
      pg8::Gemm g; pg8::Order S;
      g.A = (const u16*)p.xn8; g.Bt = (const u16*)(p.Wg8 + (size_t)l * 3072 * 1024); g.lda = 512; g.ldb = 512; g.K = 512;
      S.init(n_mt, 12, nb, bid);
      pg8::EpiGate8 e; e.g8 = p.g8; e.bias = p.b_gate + l * 3072; e.sa = p.sa; e.sw = p.sw + l * 5888 + 2816;
      pg8::gemm_phase(lds, g, S, e);
    }
    xcd_barrier(p.counters + 1024, xbw);
_Pragma("unroll 1")
    for (int rep = 0; rep < REP_BRANCH; ++rep) {
      pg8::Gemm g; pg8::Order S;
      S.init(n_mt, 4, nb, bid);
      pg8::EpiBranchF e; e.mbuf = p.mbuf; e.g8 = p.g8;
      g.A = p.ycat; g.lda = 1024; g.Bt = p.WaT + (size_t)l * 1024 * 1024; g.ldb = 1024; g.K = 1024;
      pg8::gemm_phase(lds, g, S, e);
    }
    xcd_barrier(p.counters + 1024, xbw);
    {
      pg8::Gemm g; pg8::Order S;
      g.A = p.mbuf; g.Bt = p.WoT + (size_t)l * 1024 * 1024; g.lda = 1024; g.ldb = 1024; g.K = 1024;
      S.init(n_mt, 4, nb, bid);
      pg8::EpiOutR<(l == 0)> e; e.xsrc = p.x; e.csrc = p.ctx; e.res = p.res;
      e.modl = p.mod + (size_t)l * 9 * 6144;
_Pragma("unroll 1")
      for (int half = 0; half < 2; ++half) {
        if ((bid & 1) != half) {
          for (int t = bid; t < 4096; t += 8 * nb) {
            cvt_chunk_fp4x8(p.peer_u + (size_t)l * 16384 * 1024, p.Ub, t, nb, 4096, 64.0f, 0);
            cvt_chunk_fp4x8(p.peer_v + (size_t)l * 16384 * 1024, p.Ub, t, nb, 4096, 4.0f, 1);
          }
        }
        if (half == 0) pg8::gemm_phase(lds, g, S, e);
      }
    }
    xcd_barrier(p.counters + 1024, xbw);
    phase_norm(p, l, 1);
    xcd_barrier(p.counters + 1024, xbw);
_Pragma("unroll 1")
    for (int rep = 0; rep < REP_Q; ++rep) {
      pg8::Gemm g; pg8::Order S;
      g.A = p.xn; g.Bt = p.WqkT + (size_t)l * 2048 * 1024; g.lda = 1024; g.ldb = 1024; g.K = 1024;
      S.init(n_mt, 8, nb, bid);
      pg8::EpiQ e; e.q = p.q;
      pg8::gemm_phase(lds, g, S, e);
    }
    xcd_barrier(p.counters + 1024, xbw);
_Pragma("unroll 1")
    for (int rep = 0; rep < REP_SCORE; ++rep)
    {
      uint4 q0, q1, q2, q3, q4, q5, q6, q7;
      {
        const int tid = opaque_tid();
        const int t0 = bid < n_mt * 16 ? bid : 0;
        uint4 pre[8];
        PS_LOAD(t0 >> 4, t0 & 15);
        q0 = pre[0]; q1 = pre[1]; q2 = pre[2]; q3 = pre[3]; q4 = pre[4]; q5 = pre[5]; q6 = pre[6]; q7 = pre[7];
      }
      for (int task = bid; task < n_mt * 16; task += nb) {
        const int nt_ = (task + nb < n_mt * 16) ? task + nb : task;
        peer_score_tile(p, l, task >> 4, task & 15, smem, q0, q1, q2, q3, q4, q5, q6, q7, nt_ >> 4, nt_ & 15);
      }
    }
    xcd_barrier(p.counters + 1024, xbw);
_Pragma("unroll 1")
    for (int rep = 0; rep < REP_PEER; ++rep) phase_peer_experts(p, l, rep == REP_PEER - 1, smem);
    xcd_barrier(p.counters + 1024, xbw);
  }

__global__ void __launch_bounds__(NTHR) fwd_megakernel(P p) {
  __shared__ __attribute__((aligned(16))) char smem[SMEM_BYTES];
  cg::grid_group grid = cg::this_grid();
  const int nb = gridDim.x, bid = blockIdx.x;
  pg8::PG8_LAS_T lds = (pg8::PG8_LAS_T)smem;
  volatile LAS unsigned* xbw = (volatile LAS unsigned*)(smem + SMEM_BYTES - 32);
  if (threadIdx.x == 0) { xbw[0] = 0u; xbw[1] = 0u; xbw[2] = 0u; xbw[3] = 0u; }
  __syncthreads();
  (void)xcd_barrier_post(p.counters + 1024, xbw);

  phase_prep(p, smem, p.counters + 32);
  grid.sync();
  phase_modreduce(p);
  for (int task = blockIdx.x; task < 512; task += gridDim.x) kf_task(p, task >> 8, task & 255, smem);
  for (int task = blockIdx.x; task < 256; task += gridDim.x) wqk_task(p, task >> 7, (task >> 3) & 15, task & 7, smem);
  for (int task = blockIdx.x; task < 2 * 368; task += gridDim.x) {
    const int l = task / 368, t = task - l * 368;
    if (t < 176) tr_tile4<true>(p.w_in + (size_t)l * 1024 * 2816, 2816, 1024, p.Win8 + (size_t)l * 2816 * 1024, t, p.sw + l * 5888, smem);
    else tr_tile4<true>(p.w_gate + (size_t)l * 1024 * 3072, 3072, 1024, p.Wg8 + (size_t)l * 3072 * 1024, t - 176, p.sw + l * 5888 + 2816, smem);
  }
  xcd_barrier(p.counters + 1024, xbw);

  layer_body<0>(p, smem, lds, xbw, nb, bid);
  layer_body<1>(p, smem, lds, xbw, nb, bid);
}

extern "C" void kernel_launch(void* const* d_in, const int* in_sizes, int n_in, void* d_out, int out_size, void* d_ws,
                              size_t ws_size, hipStream_t stream) {
  P p;
  memset(&p, 0, sizeof(p));
  const float** ins = (const float**)&p;
  for (int i = 0; i < 37; ++i) ins[i] = (const float*)d_in[i];
  p.out = (float*)d_out;
  char* w = (char*)d_ws;
  size_t off = 0;
  auto take = [&](size_t bytes) { char* r = w + off; off += (bytes + 255) & ~(size_t)255; return r; };
  p.counters = (unsigned*)take(32768);
  p.WinT = nullptr; p.WgT = nullptr;
  p.Win8 = (unsigned char*)take((size_t)2 * 2816 * 1024);
  p.Wg8 = (unsigned char*)take((size_t)2 * 3072 * 1024);
  p.sw = (float*)take((size_t)2 * 5888 * 4);
  p.xn8 = (unsigned char*)take((size_t)NTOK * 1024);
  p.sa = (float*)take((size_t)NTOK * 4);
  p.WaT = (u16*)take((size_t)2 * 1024 * 1024 * 2);
  p.WbT = nullptr; p.WcT = nullptr;
  p.WoT = (u16*)take((size_t)2 * 1024 * 1024 * 2);
  p.WqkT = (u16*)take((size_t)2 * 2048 * 1024 * 2);
  p.rgW = (u16*)take((size_t)2 * 16 * 4096 * 2);
  p.mod = (float*)take((size_t)2 * 9 * 6144 * 4);
  p.hc = (float*)take((size_t)512 * 256 * 4);
  p.Kf = (float*)take((size_t)2 * 256 * 8192 * 8);
  p.xn = (u16*)take((size_t)NTOK * 1024 * 2);
  p.qk = (u16*)take((size_t)NTOK * 1024 * 2);
  p.mbuf = p.qk;
  p.vT = (u16*)take((size_t)8 * 512 * 4096 * 2);
  p.vTc = (u16*)take((size_t)8 * 512 * 256 * 2);
  p.hyT = (u16*)take((size_t)8 * 768 * 4096 * 2);
  p.hyTc = (u16*)take((size_t)8 * 768 * 256 * 2);
  p.rg = (u16*)take((size_t)NTOK * 512 * 2);
  p.ycat = (u16*)take((size_t)NTOK * 1024 * 2);
  p.Ub = (unsigned char*)p.ycat;
  p.Vb = p.Ub + (size_t)16384 * 512;
  p.agg = (float*)take((size_t)8 * 2 * (136 + 34) * 256 * 8);
  p.ybT = (u16*)take((size_t)8 * 256 * 4096 * 2);
  p.hT = (float*)take((size_t)2 * 512 * 4096 * 4);
  p.WqB = (u16*)take((size_t)2 * 1024 * 2048 * 2);
  p.modpart = (float*)take((size_t)16 * 2 * 9 * 6144 * 4);
  p.keysB = (u16*)take((size_t)2 * 16 * 16384 * 2);
  p.res = (u16*)p.hT;
  {
    const size_t have = (size_t)((w + off) - (char*)p.hT), need = (size_t)NTOK * 1024 * 2;
    if (need > have) (void)take(need - have);
  }
  p.ctxs = nullptr;
  p.g8 = (unsigned char*)p.vT;
  p.q = p.qk;
  p.topk = (unsigned*)((char*)p.qk + (size_t)NTOK * 2048 * 2);
  if (off > ws_size) {
    fprintf(stderr, "workspace too small: need %zu have %zu\n", off, ws_size);
    return;
  }
  static int grid_blocks = 0;
  if (!grid_blocks) {
    int dev = 0, cus = 0, per_cu = 0;
    (void)hipGetDevice(&dev);
    (void)hipDeviceGetAttribute(&cus, hipDeviceAttributeMultiprocessorCount, dev);
    (void)hipOccupancyMaxActiveBlocksPerMultiprocessor(&per_cu, fwd_megakernel, NTHR, 0);
    if (per_cu > 1) per_cu = 1;
    grid_blocks = cus * per_cu;
  }
  (void)hipMemsetAsync(p.counters, 0, 32768, stream);
  void* args[] = {&p};
  hipError_t e = hipLaunchCooperativeKernel((void*)fwd_megakernel, dim3(grid_blocks), dim3(NTHR), args, 0, stream);
  if (e != hipSuccess) fprintf(stderr, "cooperative launch failed: %s (grid %d)\n", hipGetErrorString(e), grid_blocks);
}
```

```cpp
#include <hip/hip_runtime.h>
#include <hip/hip_cooperative_groups.h>
#include <cstdio>
#include <cstring>
namespace cg = cooperative_groups;

typedef unsigned short u16;
typedef __attribute__((ext_vector_type(8))) short bf16x8;
typedef __attribute__((ext_vector_type(16))) float f32x16;
typedef __attribute__((ext_vector_type(2))) float f32x2;
typedef int i32x8 __attribute__((ext_vector_type(8)));

#define NLAT 32768
#define NTOK 34816
#define SMEM_BYTES 151552
#define NTHR 512
#ifndef DUP_1A
#define DUP_1A 1
#endif
#ifndef DUP_PREP
#define DUP_PREP 1
#endif
#ifndef DUP_2B
#define DUP_2B 1
#endif
#ifndef XRGA
#define XRGA 1
#endif
#ifndef REP_PEER
#define HOOK_NG 2
#define REP_PEER 1
#endif
#ifndef REP_INPROJ
#define REP_INPROJ 1
#endif
#ifndef REP_GATE
#define REP_GATE 1
#endif
#ifndef REP_BRANCH
#define REP_BRANCH 1
#endif
#ifndef REP_Q
#define REP_Q 1
#endif
#ifndef REP_SCORE
#define REP_SCORE 1
#endif
#ifndef REP_1A
#define REP_1A 1
#endif
#ifndef REP_2B
#define REP_2B 1
#endif
#ifndef REP_KF
#define REP_KF 1
#endif
#ifndef DUP_GEMM
#define DUP_GEMM 1
#endif
#ifndef DUP_PEER
#define DUP_PEER 1
#endif
#ifndef DUP_MIX
#define DUP_MIX 1
#endif
#ifndef XRG
#define XRG 1
#endif
#ifndef XFFT
#define XFFT 1
#endif
#ifndef XATT
#define XATT 1
#endif

struct P {
  const float *x, *c, *ctx, *c_ctx, *norm_mix_g, *norm_ffn_g, *w_ada, *b_ada, *w_in, *na_rpb,
      *hy_short_w, *hy_short_b, *hy_f1_w, *hy_f1_b, *hy_f2_w, *hy_f2_b, *hy_f3_w, *hy_freq, *hy_bias,
      *rg_conv_w, *rg_conv_b, *rg_wa, *rg_ba, *rg_wx, *rg_bx, *rg_lambda,
      *w_gate, *b_gate, *w_br_a, *w_br_b, *w_br_c, *w_out, *peer_wq, *peer_keys, *peer_u, *peer_v, *final_g;
  float* out;
  unsigned* counters;
  u16 *WinT, *WgT, *WaT, *WbT, *WcT, *WoT, *WqB, *WqkT, *keysB, *rgW;
  float *modpart, *mod, *hT, *hc;
  float* Kf;
  u16 *xn, *qk, *vT, *vTc, *hyT, *hyTc, *rg, *ycat, *mbuf, *ybT;
  unsigned char *Ub, *Vb, *g8, *xn8, *Win8, *Wg8;
  float *sa, *sw;
  u16* q;
  float *agg, *ctxs;
  float* swq;
  u16* res;
  unsigned* topk;
};

__device__ __forceinline__ u16 f2bf(float f) {
  unsigned u = __float_as_uint(f);
  u += 0x7fffu + ((u >> 16) & 1u);
  return (u16)(u >> 16);
}
__device__ __forceinline__ float bf2f(u16 h) { return __uint_as_float(((unsigned)h) << 16); }
__device__ __forceinline__ unsigned pk2(float a, float b) { return (unsigned)f2bf(a) | ((unsigned)f2bf(b) << 16); }
__device__ __forceinline__ float bflo(unsigned u) { return __uint_as_float(u << 16); }
__device__ __forceinline__ float bfhi(unsigned u) { return __uint_as_float(u & 0xffff0000u); }
__device__ __forceinline__ int opaque_tid() {
  int t = threadIdx.x;
  asm volatile("" : "+v"(t));
  return t;
}
__device__ __forceinline__ int my_lane() { return opaque_tid() & 63; }
__device__ __forceinline__ float shx(float v, int o);
__device__ __forceinline__ float shf(float v, int src) { return __builtin_bit_cast(float, __builtin_amdgcn_ds_bpermute((src & 63) << 2, __builtin_bit_cast(int, v))); }
__device__ __forceinline__ unsigned shu(unsigned v, int src) { return (unsigned)__builtin_amdgcn_ds_bpermute((src & 63) << 2, (int)v); }
typedef unsigned u32x2_t __attribute__((ext_vector_type(2)));
template <int J> __device__ __forceinline__ unsigned xorl(unsigned v, int lane) {
  if constexpr (J == 1) return (unsigned)__builtin_amdgcn_mov_dpp((int)v, 0xB1, 0xF, 0xF, true);
  else if constexpr (J == 2) return (unsigned)__builtin_amdgcn_mov_dpp((int)v, 0x4E, 0xF, 0xF, true);
  else if constexpr (J == 4) {
    const unsigned a = (unsigned)__builtin_amdgcn_mov_dpp((int)v, 0x104, 0xF, 0xF, true);
    const unsigned b = (unsigned)__builtin_amdgcn_mov_dpp((int)v, 0x114, 0xF, 0xF, true);
    return (lane & 4) ? b : a;
  }
  else if constexpr (J == 8) return (unsigned)__builtin_amdgcn_mov_dpp((int)v, 0x128, 0xF, 0xF, true);
  else if constexpr (J == 16) { const u32x2_t r = __builtin_amdgcn_permlane16_swap(v, v, false, false); return (lane & 16) ? r.x : r.y; }
  else { const u32x2_t r = __builtin_amdgcn_permlane32_swap(v, v, false, false); return (lane & 32) ? r.x : r.y; }
}
template <int J> __device__ __forceinline__ float xorf(float v, int lane) { return __uint_as_float(xorl<J>(__float_as_uint(v), lane)); }
__device__ __forceinline__ float shx(float v, int o) {
  const int lane = my_lane();
  switch (o) {
    case 1: return xorf<1>(v, lane);
    case 2: return xorf<2>(v, lane);
    case 4: return xorf<4>(v, lane);
    case 8: return xorf<8>(v, lane);
    case 16: return xorf<16>(v, lane);
    case 32: return xorf<32>(v, lane);
    default: return __builtin_bit_cast(float, __builtin_amdgcn_ds_bpermute(((lane ^ o) << 2), __builtin_bit_cast(int, v)));
  }
}
__device__ __forceinline__ float wave_sum(float v) {
  const int lane = my_lane();
  v += xorf<32>(v, lane); v += xorf<16>(v, lane); v += xorf<8>(v, lane); v += xorf<4>(v, lane); v += xorf<2>(v, lane); v += xorf<1>(v, lane);
  return v;
}
__device__ __forceinline__ float wave_max(float v) {
  const int lane = my_lane();
  v = fmaxf(v, xorf<32>(v, lane)); v = fmaxf(v, xorf<16>(v, lane)); v = fmaxf(v, xorf<8>(v, lane));
  v = fmaxf(v, xorf<4>(v, lane)); v = fmaxf(v, xorf<2>(v, lane)); v = fmaxf(v, xorf<1>(v, lane));
  return v;
}
__device__ __forceinline__ float sigmoidf_(float x) { return __builtin_amdgcn_rcpf(1.0f + __expf(-x)); }
__device__ __forceinline__ float gelu_tanh(float x) {
  const float u2 = 1.5957691216057308f * (x + 0.044715f * x * x * x);
  return x * __builtin_amdgcn_rcpf(1.0f + __expf(-u2));
}
__device__ __forceinline__ f32x16 mfma32(bf16x8 a, bf16x8 b, f32x16 c) {
  return __builtin_amdgcn_mfma_f32_32x32x16_bf16(a, b, c, 0, 0, 0);
}
__device__ __forceinline__ f32x16 zero16() {
  f32x16 z;
#pragma unroll
  for (int i = 0; i < 16; ++i) z[i] = 0.f;
  return z;
}
__device__ __forceinline__ int swz128(int row, int ch) { return row * 128 + ((ch ^ ((row >> 1) & 7)) << 4); }
__device__ __forceinline__ int swz256(int row, int ch) { return row * 256 + ((ch ^ (row & 15)) << 4); }

struct c2 { float x, y; };
__device__ __forceinline__ c2 cadd(c2 a, c2 b) { return {a.x + b.x, a.y + b.y}; }
__device__ __forceinline__ c2 csub(c2 a, c2 b) { return {a.x - b.x, a.y - b.y}; }
__device__ __forceinline__ c2 cmul(c2 a, c2 b) { return {a.x * b.x - a.y * b.y, a.x * b.y + a.y * b.x}; }
__device__ __forceinline__ float c16(int i) {
  const float tb[16] = {1.0f, 0.9238795325112867f, 0.7071067811865476f, 0.3826834323650898f, 0.0f,
                        -0.3826834323650898f, -0.7071067811865476f, -0.9238795325112867f, -1.0f,
                        -0.9238795325112867f, -0.7071067811865476f, -0.3826834323650898f, 0.0f,
                        0.3826834323650898f, 0.7071067811865476f, 0.9238795325112867f};
  return tb[i & 15];
}
__device__ __forceinline__ float s16(int i) { return c16(i + 12); }
template <int R> __device__ __forceinline__ constexpr int brev(int k) {
  int r = 0;
  for (int b = 1, o = R >> 1; b < R; b <<= 1, o >>= 1)
    if (k & b) r |= o;
  return r;
}
template <int R> __device__ __forceinline__ void dft_reg(c2* v, float sgn) {
#pragma unroll
  for (int h = R / 2; h >= 1; h >>= 1) {
#pragma unroll
    for (int g = 0; g < R; g += 2 * h) {
#pragma unroll
      for (int j = 0; j < h; ++j) {
        c2 a = v[g + j], b = v[g + j + h];
        v[g + j] = cadd(a, b);
        c2 d = csub(a, b);
        const int ti = j * (16 / (2 * h));
        c2 w = {c16(ti), sgn * s16(ti)};
        v[g + j + h] = (j == 0) ? d : cmul(d, w);
      }
    }
  }
}
template <int R> __device__ __forceinline__ int fft_bfly(c2* v, int j, int Ns, float sgn) {
  const int k = j & (Ns - 1);
  const float f = sgn * (float)k / (float)(Ns * R);
#pragma unroll
  for (int r = 1; r < R; ++r) {
    float t = f * (float)r;
    c2 w = {__builtin_amdgcn_cosf(t), __builtin_amdgcn_sinf(t)};
    v[r] = cmul(v[r], w);
  }
  dft_reg<R>(v, sgn);
  return (j - k) * R + k;
}
template <int R> __device__ __forceinline__ void fft_pass(c2* buf, int Ns, float sgn) {
  constexpr int NBF = 8192 / R;
  constexpr int PER = NBF / NTHR;
  const int tid = opaque_tid();
  c2 v[PER][R];
#pragma unroll
  for (int i = 0; i < PER; ++i) {
    const int j = tid + NTHR * i;
#pragma unroll
    for (int r = 0; r < R; ++r) v[i][r] = buf[j + r * NBF];
  }
  __syncthreads();
#pragma unroll
  for (int i = 0; i < PER; ++i) {
    const int j = tid + NTHR * i;
    const int base = fft_bfly<R>(v[i], j, Ns, sgn);
#pragma unroll
    for (int r = 0; r < R; ++r) buf[base + r * Ns] = v[i][brev<R>(r)];
  }
  __syncthreads();
}
__device__ __forceinline__ void fft8192(c2* buf, float sgn) {
  fft_pass<8>(buf, 1, sgn);
  fft_pass<8>(buf, 8, sgn);
  fft_pass<8>(buf, 64, sgn);
  fft_pass<16>(buf, 512, sgn);
}

__device__ __forceinline__ void gemm_kloop(f32x16 (&acc)[2][2], const u16* __restrict__ A, int lda,
                                           const u16* __restrict__ B, int ldb, int K, char* smem) {
  const int tid = opaque_tid(), lane = tid & 63, wid = tid >> 6;
  const int wm = wid >> 1, wn = wid & 1;
  const int l31 = lane & 31, hh = lane >> 5;
  uint4 ra[4], rb[2];
  const int nk = K >> 6;
  const int srow = tid >> 3, sch = tid & 7;
  const char* Ab = (const char*)A;
  const char* Bb = (const char*)B;
  const unsigned aoff = (unsigned)(srow * lda + sch * 8) * 2u;
  const unsigned boff = (unsigned)(srow * ldb + sch * 8) * 2u;
  const unsigned astep = (unsigned)lda * 128u, bstep = (unsigned)ldb * 128u;
#pragma unroll
  for (int i = 0; i < 4; ++i) ra[i] = *(const uint4*)(Ab + (aoff + i * astep));
#pragma unroll
  for (int i = 0; i < 2; ++i) rb[i] = *(const uint4*)(Bb + (boff + i * bstep));
#pragma unroll
  for (int i = 0; i < 4; ++i) *(uint4*)(smem + swz128(srow + i * 64, sch)) = ra[i];
#pragma unroll
  for (int i = 0; i < 2; ++i) *(uint4*)(smem + 65536 + swz128(srow + i * 64, sch)) = rb[i];
  __syncthreads();
  for (int kt = 0; kt < nk; ++kt) {
    const bool more = (kt + 1 < nk);
    if (more) {
      const unsigned ko = (unsigned)(kt + 1) * 128u;
#pragma unroll
      for (int i = 0; i < 4; ++i) ra[i] = *(const uint4*)(Ab + (aoff + i * astep + ko));
#pragma unroll
      for (int i = 0; i < 2; ++i) rb[i] = *(const uint4*)(Bb + (boff + i * bstep + ko));
    }
    const char* as = smem + (kt & 1) * 32768;
    const char* bs = smem + 65536 + (kt & 1) * 16384;
    int lrow = l31;
    asm volatile("" : "+v"(lrow));
#pragma unroll
    for (int s = 0; s < 4; ++s) {
      bf16x8 af[2], bfr[2];
#pragma unroll
      for (int i = 0; i < 2; ++i) af[i] = *(const bf16x8*)(as + swz128(wm * 64 + i * 32 + lrow, s * 2 + hh));
#pragma unroll
      for (int j = 0; j < 2; ++j) bfr[j] = *(const bf16x8*)(bs + swz128(wn * 64 + j * 32 + lrow, s * 2 + hh));
#pragma unroll
      for (int i = 0; i < 2; ++i)
#pragma unroll
        for (int j = 0; j < 2; ++j) acc[i][j] = mfma32(af[i], bfr[j], acc[i][j]);
    }
    if (more) {
      char* an = smem + ((kt + 1) & 1) * 32768;
      char* bn = smem + 65536 + ((kt + 1) & 1) * 16384;
      int sr2 = srow;
      asm volatile("" : "+v"(sr2));
#pragma unroll
      for (int i = 0; i < 4; ++i) *(uint4*)(an + swz128(sr2 + i * 64, sch)) = ra[i];
#pragma unroll
      for (int i = 0; i < 2; ++i) *(uint4*)(bn + swz128(sr2 + i * 64, sch)) = rb[i];
    }
    __syncthreads();
  }
}
__device__ __forceinline__ void zero_acc(f32x16 (&acc)[2][2]) {
#pragma unroll
  for (int i = 0; i < 2; ++i)
#pragma unroll
    for (int j = 0; j < 2; ++j) acc[i][j] = zero16();
}
#define EPI_ROW(i, e) (wm * 64 + (i)*32 + ((e)&3) + 8 * ((e) >> 2) + 4 * hh)
#define EPI_COL(j) (wn * 64 + (j)*32 + l31)
#define EPI_VARS                                                    \
  const int tid = opaque_tid(), lane = tid & 63, wid = tid >> 6;     \
  const int wm = wid >> 1, wn = wid & 1, l31 = lane & 31, hh = lane >> 5; \
  (void)tid; (void)wm; (void)wn; (void)l31; (void)hh;


namespace pg8 {
__device__ __forceinline__ unsigned pkh(float a, float b) { unsigned r; asm("v_cvt_pk_bf16_f32 %0, %1, %2" : "=v"(r) : "v"(a), "v"(b)); return r; }
#define PG8_LAS __attribute__((address_space(3)))
typedef PG8_LAS unsigned char* PG8_LAS_T;
typedef float f32x4 __attribute__((ext_vector_type(4)));
typedef unsigned u32x4 __attribute__((ext_vector_type(4)));
typedef int i32x4 __attribute__((ext_vector_type(4)));
constexpr int BM = 256, BK = 64, HALF = 128, HTB = HALF * BK * 2, STAGE_BYTES = 8 * HTB, NXCD = 8, WGM = 8;
__device__ __forceinline__ int lds_byte(int r, int c) { const int st = (r >> 4) * 2 + (c >> 5), rr = r & 15, cc = c & 31, ob = rr * 64 + cc * 2; return st * 1024 + (ob ^ (((ob >> 9) & 1) << 5)); }
__device__ __forceinline__ void stage_rc(int b, int& R, int& C) { const int st = b / 1024, sb = b % 1024, swz = sb ^ (((sb >> 9) & 1) << 5); R = (st >> 1) * 16 + swz / 64; C = (st & 1) * 32 + (swz % 64) / 2; }
__device__ __forceinline__ int perm32(int rho) { const int n = rho >> 4, i = rho & 15; return 8 * (i >> 2) + 4 * n + (i & 3); }
struct Unit { int pm, pn; };
struct Gemm { const u16* A; const u16* Bt; int lda, ldb, K; };
struct Order {
  int nM, nN, nwg, G, c, skip_from, skip_by;
  __device__ __forceinline__ void init(int nM_, int nN_, int G_, int c_, int sf = 1 << 30, int sb = 0) { nM = nM_; nN = nN_; nwg = nM * nN; G = G_; c = c_; skip_from = sf; skip_by = sb; }
  __device__ __forceinline__ bool next(int i, Unit& u) const {
    const long L = (long)i * G + c; if (L >= nwg) return false;
    int wgid = (int)L; { const int q = nwg / NXCD, r = nwg % NXCD, xcd = wgid % NXCD, off = wgid / NXCD; wgid = (xcd < r ? xcd * (q + 1) : r * (q + 1) + (xcd - r) * q) + off; }
    const int nig = WGM * nN, gid = wgid / nig, fm = gid * WGM, gsz = (nM - fm) < WGM ? (nM - fm) : WGM;
    u.pm = fm + ((wgid % nig) % gsz); u.pn = (wgid % nig) / gsz;
    if (u.pn >= skip_from) u.pn += skip_by;
    return true;
  }
};
__device__ __forceinline__ f32x4 mma16(bf16x8 a, bf16x8 b, f32x4 c) { return __builtin_amdgcn_mfma_f32_16x16x32_bf16(a, b, c, 0, 0, 0); }
__device__ __forceinline__ i32x4 mma16(bf16x8 a, bf16x8 b, i32x4 c) { return __builtin_amdgcn_mfma_i32_16x16x64_i8(__builtin_bit_cast(i32x4, a), __builtin_bit_cast(i32x4, b), c, 0, 0, 0); }
template <class Epi>
__device__ __forceinline__ void gemm_phase(PG8_LAS unsigned char* lds, const Gemm g, const Order& S, const Epi& E) {
  const int tid = opaque_tid(), wid = __builtin_amdgcn_readfirstlane(tid >> 6), lane = tid & 63, wr = wid >> 2, wc = wid & 3, fr = lane & 15, fq = lane >> 4;
  const int K = g.K, nt = K / BK;
  unsigned voffA[2], voffB[2];
#pragma unroll
  for (int i = 0; i < 2; ++i) { int R, C; stage_rc(tid * 16 + i * 8192, R, C); const int Rb = Epi::PERM ? ((R & ~31) + perm32(R & 31)) : R;
    voffA[i] = (unsigned)(R * g.lda + C) * 2u; voffB[i] = (unsigned)(Rb * g.ldb + C) * 2u; }
#define PG8_VOFF(T) do { _Pragma("unroll") for (int i = 0; i < 2; ++i) { int R, C; stage_rc((T) * 16 + i * 8192, R, C); const int Rb = Epi::PERM ? ((R & ~31) + perm32(R & 31)) : R; \
    voffA[i] = (unsigned)(R * g.lda + C) * 2u; voffB[i] = (unsigned)(Rb * g.ldb + C) * 2u; } } while (0)
  const size_t kstep = (size_t)(BK * 2);
  const size_t hstepA = (size_t)HALF * g.lda * 2, hstepB = (size_t)HALF * g.ldb * 2;
  const size_t tstepA = 2 * hstepA, tstepB = 2 * hstepB;
  const unsigned ldsw = (unsigned)wid * 1024u;
  int aoff = lds_byte(wr * 64 + fr, fq * 8), boff = lds_byte(wc * 32 + fr, fq * 8);
#define PG8_SA(b, h) (((b) * 2 + (h)) * HTB)
#define PG8_SB(b, h) ((4 + (b) * 2 + (h)) * HTB)
#define PG8_STAGE(bufoff, gbase, voff) do { _Pragma("unroll") for (int _i = 0; _i < 2; ++_i) \
    __builtin_amdgcn_global_load_lds((const unsigned*)((const char*)(gbase) + (voff)[_i]), (PG8_LAS unsigned*)(lds + (bufoff) + ldsw + _i * 8192), 16, 0, 0); } while (0)
#define PG8_LDA(dst, b, h) do { _Pragma("unroll") for (int m = 0; m < 4; ++m) _Pragma("unroll") for (int k = 0; k < 2; ++k) dst[m][k] = *(const PG8_LAS bf16x8*)(lds + PG8_SA(b, h) + aoff + m * 2048 + k * 1024); } while (0)
#define PG8_LDB(dst, b, h) do { _Pragma("unroll") for (int n = 0; n < 2; ++n) _Pragma("unroll") for (int k = 0; k < 2; ++k) dst[n][k] = *(const PG8_LAS bf16x8*)(lds + PG8_SB(b, h) + boff + n * 2048 + k * 1024); } while (0)
#define PG8_MMA(ai, bj, At, Bt) do { __builtin_amdgcn_s_setprio(1); _Pragma("unroll") for (int m = 0; m < 4; ++m) _Pragma("unroll") for (int n = 0; n < 2; ++n) _Pragma("unroll") for (int k = 0; k < 2; ++k) \
    acc[ai][bj][m][n] = mma16(Bt[n][k], At[m][k], acc[ai][bj][m][n]); __builtin_amdgcn_s_setprio(0); } while (0)
#define PG8_WAIT_V(n) asm volatile("s_waitcnt vmcnt(" #n ")" ::: "memory")
#define PG8_WAIT_L(n) asm volatile("s_waitcnt lgkmcnt(" #n ")" ::: "memory")
#define PG8_BAR __builtin_amdgcn_s_barrier()
#define PG8_SCHED __builtin_amdgcn_sched_barrier(0)
  Unit cur, nxt; int ui = 0;
  if (!S.next(0, cur)) return;
  typedef typename Epi::acc_t acc_t;
  acc_t acc[2][2][4][2];
#pragma unroll
  for (int a = 0; a < 2; ++a)
#pragma unroll
    for (int b = 0; b < 2; ++b)
#pragma unroll
      for (int m = 0; m < 4; ++m)
#pragma unroll
        for (int n = 0; n < 2; ++n) acc[a][b][m][n] = (acc_t){0, 0, 0, 0};
  bf16x8 At[4][2], B0[2][2], B1[2][2];
  const char* cA = (const char*)g.A + (size_t)cur.pm * tstepA; const char* cB = (const char*)g.Bt + (size_t)cur.pn * tstepB;
  PG8_STAGE(PG8_SB(0, 0), cB, voffB); PG8_STAGE(PG8_SA(0, 0), cA, voffA); PG8_STAGE(PG8_SB(0, 1), cB + hstepB, voffB); PG8_STAGE(PG8_SA(0, 1), cA + hstepA, voffA);
  if (wr == 1) PG8_BAR;
  PG8_WAIT_V(4); PG8_BAR;
  PG8_STAGE(PG8_SB(1, 0), cB + kstep, voffB); PG8_STAGE(PG8_SA(1, 0), cA + kstep, voffA); PG8_STAGE(PG8_SB(1, 1), cB + hstepB + kstep, voffB);
  PG8_WAIT_V(6); PG8_BAR;
  for (;;) {
    const bool has_next = S.next(ui + 1, nxt);
    const char* nA = has_next ? (const char*)g.A + (size_t)nxt.pm * tstepA : cA; const char* nB = has_next ? (const char*)g.Bt + (size_t)nxt.pn * tstepB : cB;
#define PG8_KBODY \
      const bool last = (t == nt - 2); \
      const char* a1 = cA + (size_t)(t + 1) * kstep; \
      const char* a2 = last ? nA : cA + (size_t)(t + 2) * kstep; const char* b2 = last ? nB : cB + (size_t)(t + 2) * kstep; \
      const char* a3 = a2 + kstep; const char* b3 = b2 + kstep; \
      PG8_LDB(B0, 0, 0); PG8_SCHED; PG8_LDA(At, 0, 0); PG8_STAGE(PG8_SA(1, 1), a1 + hstepA, voffA); \
      PG8_WAIT_L(8); PG8_BAR; PG8_WAIT_L(0); PG8_MMA(0, 0, At, B0); PG8_BAR; PG8_SCHED; \
      PG8_LDB(B1, 0, 1); PG8_STAGE(PG8_SB(0, 0), b2, voffB); \
      PG8_BAR; PG8_WAIT_L(0); PG8_MMA(0, 1, At, B1); PG8_BAR; \
      PG8_LDA(At, 0, 1); PG8_STAGE(PG8_SA(0, 0), a2, voffA); \
      PG8_BAR; PG8_WAIT_L(0); PG8_MMA(1, 0, At, B0); PG8_BAR; PG8_SCHED; \
      PG8_STAGE(PG8_SB(0, 1), b2 + hstepB, voffB); \
      PG8_WAIT_V(6); PG8_BAR; PG8_MMA(1, 1, At, B1); PG8_BAR; \
      PG8_LDB(B0, 1, 0); PG8_SCHED; PG8_LDA(At, 1, 0); PG8_STAGE(PG8_SA(0, 1), a2 + hstepA, voffA); \
      PG8_WAIT_L(8); PG8_BAR; PG8_WAIT_L(0); PG8_MMA(0, 0, At, B0); PG8_BAR; PG8_SCHED; \
      PG8_LDB(B1, 1, 1); PG8_STAGE(PG8_SB(1, 0), b3, voffB); \
      PG8_BAR; PG8_WAIT_L(0); PG8_MMA(0, 1, At, B1); PG8_BAR; \
      PG8_LDA(At, 1, 1); PG8_STAGE(PG8_SA(1, 0), a3, voffA); \
      PG8_BAR; PG8_WAIT_L(0); PG8_MMA(1, 0, At, B0); PG8_BAR; PG8_SCHED; \
      PG8_STAGE(PG8_SB(1, 1), b3 + hstepB, voffB); \
      PG8_WAIT_V(6); PG8_BAR; PG8_MMA(1, 1, At, B1); PG8_BAR;
    if constexpr (Epi::HOOKS) {
      asm volatile("" : "+v"(aoff), "+v"(boff));
      PG8_VOFF(opaque_tid());
      for (int t = 0; t < Epi::H1; t += 2) { PG8_KBODY }
      E.hook(acc, cur, wr, wc, fr, fq, Epi::H1);
      asm volatile("" : "+v"(aoff), "+v"(boff));
      PG8_VOFF(opaque_tid());
      for (int t = Epi::H1; t < Epi::H2; t += 2) { PG8_KBODY }
      E.hook(acc, cur, wr, wc, fr, fq, Epi::H2);
      asm volatile("" : "+v"(aoff), "+v"(boff));
      PG8_VOFF(opaque_tid());
      for (int t = Epi::H2; t < nt; t += 2) { PG8_KBODY }
    } else {
      for (int t = 0; t < nt; t += 2) { PG8_KBODY }
    }
#undef PG8_KBODY
    E(acc, cur, wr, wc, fr, fq);
    if (!has_next) break;
#pragma unroll
    for (int a = 0; a < 2; ++a)
#pragma unroll
      for (int b = 0; b < 2; ++b)
#pragma unroll
        for (int m = 0; m < 4; ++m)
#pragma unroll
          for (int n = 0; n < 2; ++n) acc[a][b][m][n] = (acc_t){0, 0, 0, 0};
    cur = nxt; cA = nA; cB = nB; ++ui;
  }
  PG8_WAIT_V(0);
  if (wr == 0) PG8_BAR;
  PG8_BAR;
#undef PG8_VOFF
#undef PG8_SA
#undef PG8_SB
#undef PG8_STAGE
#undef PG8_LDA
#undef PG8_LDB
#undef PG8_MMA
#undef PG8_WAIT_V
#undef PG8_WAIT_L
#undef PG8_BAR
#undef PG8_SCHED
}
typedef const f32x4 (&AccRef)[2][2][4][2];
typedef const i32x4 (&AccRefI)[2][2][4][2];
struct EpiInprojN {
  static constexpr bool PERM = true; static constexpr bool HOOKS = false; static constexpr int H1 = 0, H2 = 0;
  typedef f32x4 acc_t;
  u16* qk; u16* rg;
  __device__ __forceinline__ void operator()(AccRef acc, const Unit& u, int wr, int wc, int fr, int fq) const {
    const int row0 = u.pm * BM + wr * 64 + fr;
    u16* base; int ld, colt;
    if (u.pn < 4) { base = qk; ld = 1024; colt = u.pn * 256; } else { base = rg; ld = 512; colt = (u.pn - 9) * 256; }
    const int col0 = colt + wc * 32 + 8 * fq;
#pragma unroll
    for (int ai = 0; ai < 2; ++ai)
#pragma unroll
      for (int m = 0; m < 4; ++m) {
        u16* rowp = base + (size_t)(row0 + ai * HALF + m * 16) * ld + col0;
#pragma unroll
        for (int bj = 0; bj < 2; ++bj) {
          const f32x4 v0 = acc[ai][bj][m][0], v1 = acc[ai][bj][m][1];
          u32x4 w; w.x = pkh(v0[0], v0[1]); w.y = pkh(v0[2], v0[3]); w.z = pkh(v1[0], v1[1]); w.w = pkh(v1[2], v1[3]);
          *(u32x4*)(rowp + bj * HALF) = w;
        }
      }
  }
};
struct EpiInprojT {
  static constexpr bool PERM = true; static constexpr bool HOOKS = false; static constexpr int H1 = 0, H2 = 0;
  typedef f32x4 acc_t;
  u16 *vT, *vTc, *hyT, *hyTc;
  __device__ __forceinline__ void operator()(AccRef acc, const Unit& u, int wr, int wc, int fr, int fq) const {
    const bool isctx = (u.pn >= 128);
    const int b = isctx ? (u.pn - 128) : (u.pn >> 4);
    const int Lseg = isctx ? 256 : 4096, t0 = isctx ? 0 : (u.pn & 15) * 256;
    const bool isv = (u.pm < 2);
    const size_t boff = isv ? (isctx ? (size_t)16777216 : (size_t)0) : (isctx ? (size_t)(16777216 + 1048576 + 25165824) : (size_t)(16777216 + 1048576));
    u16* base = vT + boff;
    const int nc = isv ? 512 : 768;
    const int wrow0 = (isv ? u.pm : u.pm - 2) * BM + wr * 64 + fr;
    const int col0 = t0 + wc * 32 + 8 * fq;
#pragma unroll
    for (int ai = 0; ai < 2; ++ai)
#pragma unroll
      for (int m = 0; m < 4; ++m) {
        u16* rowp = base + ((size_t)(b * nc + wrow0 + ai * HALF + m * 16)) * Lseg + col0;
#pragma unroll
        for (int bj = 0; bj < 2; ++bj) {
          const f32x4 v0 = acc[ai][bj][m][0], v1 = acc[ai][bj][m][1];
          u32x4 w; w.x = pkh(v0[0], v0[1]); w.y = pkh(v0[2], v0[3]); w.z = pkh(v1[0], v1[1]); w.w = pkh(v1[2], v1[3]);
          *(u32x4*)(rowp + bj * HALF) = w;
        }
      }
  }
};
struct EpiGate {
  static constexpr bool PERM = true; static constexpr bool HOOKS = false; static constexpr int H1 = 0, H2 = 0;
  typedef f32x4 acc_t;
  unsigned char* g8; const float* bias;
  __device__ __forceinline__ void operator()(AccRef acc, const Unit& u, int wr, int wc, int fr, int fq) const {
    const int row0 = u.pm * BM + wr * 64 + fr;
    const int col0 = u.pn * BM + wc * 32 + 8 * fq;
#pragma unroll
    for (int bj = 0; bj < 2; ++bj) {
      const f32x4 b0 = *(const f32x4*)(bias + col0 + bj * HALF), b1 = *(const f32x4*)(bias + col0 + bj * HALF + 4);
#pragma unroll
      for (int ai = 0; ai < 2; ++ai)
#pragma unroll
        for (int m = 0; m < 4; ++m) {
          const f32x4 v0 = acc[ai][bj][m][0] + b0, v1 = acc[ai][bj][m][1] + b1;
          unsigned w0 = 0, w1 = 0;
#pragma unroll
          for (int k = 0; k < 4; ++k) {
            w0 |= (unsigned)(sigmoidf_(v0[k]) * 255.0f + 0.5f) << (8 * k);
            w1 |= (unsigned)(sigmoidf_(v1[k]) * 255.0f + 0.5f) << (8 * k);
          }
          *(uint2*)(g8 + (size_t)(row0 + ai * HALF + m * 16) * 3072 + col0 + bj * HALF) = make_uint2(w0, w1);
        }
    }
  }
};
struct EpiBranch {
  static constexpr bool PERM = true; static constexpr bool HOOKS = false; static constexpr int H1 = 0, H2 = 0;
  typedef f32x4 acc_t;
  u16* mbuf; const unsigned char* g8; int br;
  __device__ __forceinline__ void operator()(AccRef acc, const Unit& u, int wr, int wc, int fr, int fq) const {
    const int row0 = u.pm * BM + wr * 64 + fr;
    const int col0 = u.pn * BM + wc * 32 + 8 * fq;
    uint2 gq[2][2][2];
    u32x4 o[2][2][2];
#define EB_LOAD(G) do { _Pragma("unroll") for (int j = 0; j < 2; ++j) _Pragma("unroll") for (int bj = 0; bj < 2; ++bj) { \
      const size_t row = (size_t)(row0 + (((G) * 2 + j) >> 2) * HALF + (((G) * 2 + j) & 3) * 16); \
      gq[(G) & 1][j][bj] = *(const uint2*)(g8 + row * 3072 + br * 1024 + col0 + bj * HALF); \
      if (br != 0) o[(G) & 1][j][bj] = *(const u32x4*)(mbuf + row * 1024 + col0 + bj * HALF); } } while (0)
    EB_LOAD(0);
#pragma unroll
    for (int G = 0; G < 4; ++G) {
      if (G < 3) EB_LOAD(G + 1);
#pragma unroll
      for (int j = 0; j < 2; ++j) {
        const int ai = (G * 2 + j) >> 2, m = (G * 2 + j) & 3;
        const size_t row = (size_t)(row0 + ai * HALF + m * 16);
#pragma unroll
        for (int bj = 0; bj < 2; ++bj) {
          const uint2 g = gq[G & 1][j][bj];
          u16* mp = mbuf + row * 1024 + col0 + bj * HALF;
          const f32x4 v0 = acc[ai][bj][m][0], v1 = acc[ai][bj][m][1];
          float r[8];
          r[0] = (float)(g.x & 255u) * v0[0]; r[1] = (float)((g.x >> 8) & 255u) * v0[1];
          r[2] = (float)((g.x >> 16) & 255u) * v0[2]; r[3] = (float)(g.x >> 24) * v0[3];
          r[4] = (float)(g.y & 255u) * v1[0]; r[5] = (float)((g.y >> 8) & 255u) * v1[1];
          r[6] = (float)((g.y >> 16) & 255u) * v1[2]; r[7] = (float)(g.y >> 24) * v1[3];
          u32x4 w;
          if (br == 0) {
            w.x = pkh(r[0] * (1.f / 255.f), r[1] * (1.f / 255.f)); w.y = pkh(r[2] * (1.f / 255.f), r[3] * (1.f / 255.f));
            w.z = pkh(r[4] * (1.f / 255.f), r[5] * (1.f / 255.f)); w.w = pkh(r[6] * (1.f / 255.f), r[7] * (1.f / 255.f));
          } else {
            const u32x4 ov = o[G & 1][j][bj];
            w.x = pkh(bflo(ov.x) + r[0] * (1.f / 255.f), bfhi(ov.x) + r[1] * (1.f / 255.f));
            w.y = pkh(bflo(ov.y) + r[2] * (1.f / 255.f), bfhi(ov.y) + r[3] * (1.f / 255.f));
            w.z = pkh(bflo(ov.z) + r[4] * (1.f / 255.f), bfhi(ov.z) + r[5] * (1.f / 255.f));
            w.w = pkh(bflo(ov.w) + r[6] * (1.f / 255.f), bfhi(ov.w) + r[7] * (1.f / 255.f));
          }
          *(u32x4*)mp = w;
        }
      }
    }
#undef EB_LOAD
  }
};
struct EpiBranchF {
  static constexpr bool PERM = true; static constexpr bool HOOKS = true;
  static constexpr int H1 = 8, H2 = 12;
  typedef f32x4 acc_t;
  u16* mbuf; const unsigned char* g8;
  template <int NUM, int NG>
  __device__ __forceinline__ void rescale(f32x4 (&acc)[2][2][4][2], const Unit& u) const {
    const int tid_ = opaque_tid(), lane_ = tid_ & 63, wid_ = tid_ >> 6;
    const int row0 = u.pm * BM + (wid_ >> 2) * 64 + (lane_ & 15);
    const int col0 = u.pn * BM + (wid_ & 3) * 32 + 8 * (lane_ >> 4);
    constexpr int PER = 8 / NG;
#pragma unroll
    for (int G = 0; G < NG; ++G) {
      __builtin_amdgcn_sched_barrier(0);
      uint2 gn[PER][2], gd[PER][2];
#pragma unroll
      for (int j = 0; j < PER; ++j)
#pragma unroll
        for (int bj = 0; bj < 2; ++bj) {
          const unsigned char* gp = g8 + (size_t)(row0 + ((G * PER + j) >> 2) * HALF + ((G * PER + j) & 3) * 16) * 3072 + col0 + bj * HALF;
          gn[j][bj] = *(const uint2*)(gp + NUM * 1024); gd[j][bj] = *(const uint2*)(gp + (NUM + 1) * 1024);
        }
#pragma unroll
      for (int j = 0; j < PER; ++j) {
        const int ai = (G * PER + j) >> 2, m = (G * PER + j) & 3;
#pragma unroll
        for (int bj = 0; bj < 2; ++bj) {
          __builtin_amdgcn_sched_barrier(0);
          const unsigned n0 = gn[j][bj].x, n1 = gn[j][bj].y, d0 = gd[j][bj].x, d1 = gd[j][bj].y;
          f32x4 r0, r1;
#pragma unroll
          for (int k = 0; k < 4; ++k) {
            float fn0 = (float)((n0 >> (8 * k)) & 255u), fn1 = (float)((n1 >> (8 * k)) & 255u);
            if (NUM != 0) { fn0 = fmaxf(fn0, 1.0f); fn1 = fmaxf(fn1, 1.0f); }
            const float fd0 = fmaxf((float)((d0 >> (8 * k)) & 255u), 1.0f), fd1 = fmaxf((float)((d1 >> (8 * k)) & 255u), 1.0f);
            r0[k] = fn0 * __builtin_amdgcn_rcpf(fd0);
            r1[k] = fn1 * __builtin_amdgcn_rcpf(fd1);
          }
          acc[ai][bj][m][0] *= r0;
          acc[ai][bj][m][1] *= r1;
        }
      }
    }
    __builtin_amdgcn_sched_barrier(0);
  }
  __device__ __forceinline__ void hook(f32x4 (&acc)[2][2][4][2], const Unit& u, int wr, int wc, int fr, int fq, int t) const {
    if (t == H1) rescale<0, HOOK_NG>(acc, u); else rescale<1, HOOK_NG>(acc, u);
  }
  __device__ __forceinline__ void operator()(AccRef acc, const Unit& u, int wr, int wc, int fr, int fq) const {
    const int tid_ = opaque_tid(), lane_ = tid_ & 63, wid_ = tid_ >> 6;
    const int row0 = u.pm * BM + (wid_ >> 2) * 64 + (lane_ & 15);
    const int col0 = u.pn * BM + (wid_ & 3) * 32 + 8 * (lane_ >> 4);
    uint2 gq[2][4][2];
#pragma unroll
    for (int ai = 0; ai < 2; ++ai)
#pragma unroll
      for (int m = 0; m < 4; ++m)
#pragma unroll
        for (int bj = 0; bj < 2; ++bj)
          gq[ai][m][bj] = *(const uint2*)(g8 + (size_t)(row0 + ai * HALF + m * 16) * 3072 + 2048 + col0 + bj * HALF);
#pragma unroll
    for (int ai = 0; ai < 2; ++ai)
#pragma unroll
      for (int m = 0; m < 4; ++m)
#pragma unroll
        for (int bj = 0; bj < 2; ++bj) {
          const uint2 g = gq[ai][m][bj];
          const f32x4 v0 = acc[ai][bj][m][0], v1 = acc[ai][bj][m][1];
          float r[8];
#pragma unroll
          for (int k = 0; k < 4; ++k) {
            r[k] = fmaxf((float)((g.x >> (8 * k)) & 255u), 1.0f) * (1.f / 255.f) * v0[k];
            r[4 + k] = fmaxf((float)((g.y >> (8 * k)) & 255u), 1.0f) * (1.f / 255.f) * v1[k];
          }
          u32x4 w;
          w.x = pkh(r[0], r[1]); w.y = pkh(r[2], r[3]); w.z = pkh(r[4], r[5]); w.w = pkh(r[6], r[7]);
          *(u32x4*)(mbuf + (size_t)(row0 + ai * HALF + m * 16) * 1024 + col0 + bj * HALF) = w;
        }
  }
};
template <bool SRC_F32>
struct EpiOutR {
  static constexpr bool PERM = true; static constexpr bool HOOKS = false; static constexpr int H1 = 0, H2 = 0;
  typedef f32x4 acc_t;
  const float *xsrc, *csrc; u16* res; const float* modl;
  __device__ __forceinline__ void operator()(AccRef acc, const Unit& u, int wr, int wc, int fr, int fq) const {
    const bool isctx = (u.pm >= 128);
    const int bi = isctx ? 8 : (u.pm >> 4);
    const float* gatev = modl + ((size_t)bi * 6 + 2) * 1024;
    const int row0 = u.pm * BM + wr * 64 + fr, col0 = u.pn * BM + wc * 32 + 8 * fq;
    f32x4 gv[2][2];
#pragma unroll
    for (int bj = 0; bj < 2; ++bj) { gv[bj][0] = *(const f32x4*)(gatev + col0 + bj * HALF); gv[bj][1] = *(const f32x4*)(gatev + col0 + bj * HALF + 4); }
    if (SRC_F32) {
      const float* src = isctx ? (csrc - (size_t)NLAT * 1024) : xsrc;
#pragma unroll
      for (int G = 0; G < 4; ++G) {
        f32x4 sv[2][2][2];
#pragma unroll
        for (int j = 0; j < 2; ++j)
#pragma unroll
          for (int bj = 0; bj < 2; ++bj) {
            const float* sp = src + (size_t)(row0 + ((G * 2 + j) >> 2) * HALF + ((G * 2 + j) & 3) * 16) * 1024 + col0 + bj * HALF;
            sv[j][bj][0] = *(const f32x4*)sp; sv[j][bj][1] = *(const f32x4*)(sp + 4);
          }
#pragma unroll
        for (int j = 0; j < 2; ++j) {
          const int ai = (G * 2 + j) >> 2, m = (G * 2 + j) & 3;
#pragma unroll
          for (int bj = 0; bj < 2; ++bj) {
            const f32x4 o0 = sv[j][bj][0] + gv[bj][0] * acc[ai][bj][m][0], o1 = sv[j][bj][1] + gv[bj][1] * acc[ai][bj][m][1];
            u32x4 w;
            w.x = pkh(o0[0], o0[1]); w.y = pkh(o0[2], o0[3]); w.z = pkh(o1[0], o1[1]); w.w = pkh(o1[2], o1[3]);
            *(u32x4*)(res + (size_t)(row0 + ai * HALF + m * 16) * 1024 + col0 + bj * HALF) = w;
          }
        }
      }
    } else {
#pragma unroll
      for (int G = 0; G < 2; ++G) {
        u32x4 sv[4][2];
#pragma unroll
        for (int m = 0; m < 4; ++m)
#pragma unroll
          for (int bj = 0; bj < 2; ++bj) sv[m][bj] = *(const u32x4*)(res + (size_t)(row0 + G * HALF + m * 16) * 1024 + col0 + bj * HALF);
#pragma unroll
        for (int m = 0; m < 4; ++m)
#pragma unroll
          for (int bj = 0; bj < 2; ++bj) {
            const u32x4 r = sv[m][bj];
            const f32x4 a0 = acc[G][bj][m][0], a1 = acc[G][bj][m][1], g0 = gv[bj][0], g1 = gv[bj][1];
            u32x4 w;
            w.x = pkh(bflo(r.x) + g0[0] * a0[0], bfhi(r.x) + g0[1] * a0[1]); w.y = pkh(bflo(r.y) + g0[2] * a0[2], bfhi(r.y) + g0[3] * a0[3]);
            w.z = pkh(bflo(r.z) + g1[0] * a1[0], bfhi(r.z) + g1[1] * a1[1]); w.w = pkh(bflo(r.w) + g1[2] * a1[2], bfhi(r.w) + g1[3] * a1[3]);
            *(u32x4*)(res + (size_t)(row0 + G * HALF + m * 16) * 1024 + col0 + bj * HALF) = w;
          }
      }
    }
  }
};
struct EpiQ {
  static constexpr bool PERM = true; static constexpr bool HOOKS = false; static constexpr int H1 = 0, H2 = 0;
  typedef f32x4 acc_t;
  u16* q;
  __device__ __forceinline__ void operator()(AccRef acc, const Unit& u, int wr, int wc, int fr, int fq) const {
    const int row0 = u.pm * BM + wr * 64 + fr;
    const int col0 = u.pn * BM + wc * 32 + 8 * fq;
#pragma unroll
    for (int ai = 0; ai < 2; ++ai)
#pragma unroll
      for (int m = 0; m < 4; ++m) {
        u16* rowp = q + (size_t)(row0 + ai * HALF + m * 16) * 2048 + col0;
#pragma unroll
        for (int bj = 0; bj < 2; ++bj) {
          const f32x4 v0 = acc[ai][bj][m][0], v1 = acc[ai][bj][m][1];
          u32x4 w;
          w.x = __builtin_bit_cast(unsigned, __builtin_amdgcn_cvt_pkrtz(v0[0], v0[1]));
          w.y = __builtin_bit_cast(unsigned, __builtin_amdgcn_cvt_pkrtz(v0[2], v0[3]));
          w.z = __builtin_bit_cast(unsigned, __builtin_amdgcn_cvt_pkrtz(v1[0], v1[1]));
          w.w = __builtin_bit_cast(unsigned, __builtin_amdgcn_cvt_pkrtz(v1[2], v1[3]));
          *(u32x4*)(rowp + bj * HALF) = w;
        }
      }
  }
};
struct EpiQ8 {
  static constexpr bool PERM = true; static constexpr bool HOOKS = false; static constexpr int H1 = 0, H2 = 0;
  typedef i32x4 acc_t;
  u16* q; const float* sa; const float* sw;
  __device__ __forceinline__ void operator()(AccRefI acc, const Unit& u, int wr, int wc, int fr, int fq) const {
    const int row0 = u.pm * BM + wr * 64 + fr;
    const int col0 = u.pn * BM + wc * 32 + 8 * fq;
    float rs[8];
    f32x4 cs[2][2];
#pragma unroll
    for (int i = 0; i < 8; ++i) rs[i] = sa[row0 + (i >> 2) * HALF + (i & 3) * 16];
#pragma unroll
    for (int bj = 0; bj < 2; ++bj) { cs[bj][0] = *(const f32x4*)(sw + col0 + bj * HALF); cs[bj][1] = *(const f32x4*)(sw + col0 + bj * HALF + 4); }
#pragma unroll
    for (int ai = 0; ai < 2; ++ai)
#pragma unroll
      for (int m = 0; m < 4; ++m) {
        u16* rowp = q + (size_t)(row0 + ai * HALF + m * 16) * 2048 + col0;
        const float r = rs[ai * 4 + m];
#pragma unroll
        for (int bj = 0; bj < 2; ++bj) {
          const i32x4 a0 = acc[ai][bj][m][0], a1 = acc[ai][bj][m][1];
          const f32x4 c0 = cs[bj][0], c1 = cs[bj][1];
          u32x4 w;
          w.x = __builtin_bit_cast(unsigned, __builtin_amdgcn_cvt_pkrtz((float)a0[0] * r * c0[0], (float)a0[1] * r * c0[1]));
          w.y = __builtin_bit_cast(unsigned, __builtin_amdgcn_cvt_pkrtz((float)a0[2] * r * c0[2], (float)a0[3] * r * c0[3]));
          w.z = __builtin_bit_cast(unsigned, __builtin_amdgcn_cvt_pkrtz((float)a1[0] * r * c1[0], (float)a1[1] * r * c1[1]));
          w.w = __builtin_bit_cast(unsigned, __builtin_amdgcn_cvt_pkrtz((float)a1[2] * r * c1[2], (float)a1[3] * r * c1[3]));
          *(u32x4*)(rowp + bj * HALF) = w;
        }
      }
  }
};
struct EpiInprojN8 {
  static constexpr bool PERM = true; static constexpr bool HOOKS = false; static constexpr int H1 = 0, H2 = 0;
  typedef i32x4 acc_t;
  u16* qk; u16* rg; const float* sa; const float* sw;
  __device__ __forceinline__ void operator()(AccRefI acc, const Unit& u, int wr, int wc, int fr, int fq) const {
    const int row0 = u.pm * BM + wr * 64 + fr;
    u16* base; int ld, colt;
    if (u.pn < 4) { base = qk; ld = 1024; colt = u.pn * 256; } else { base = rg; ld = 512; colt = (u.pn - 9) * 256; }
    const int col0 = colt + wc * 32 + 8 * fq;
    const int wcol0 = u.pn * 256 + wc * 32 + 8 * fq;
    float rs[8];
    f32x4 cs[2][2];
#pragma unroll
    for (int i = 0; i < 8; ++i) rs[i] = sa[row0 + (i >> 2) * HALF + (i & 3) * 16];
#pragma unroll
    for (int bj = 0; bj < 2; ++bj) { cs[bj][0] = *(const f32x4*)(sw + wcol0 + bj * HALF); cs[bj][1] = *(const f32x4*)(sw + wcol0 + bj * HALF + 4); }
#pragma unroll
    for (int bj = 0; bj < 2; ++bj) {
      const f32x4 c0 = cs[bj][0], c1 = cs[bj][1];
#pragma unroll
      for (int ai = 0; ai < 2; ++ai)
#pragma unroll
        for (int m = 0; m < 4; ++m) {
          const int row = row0 + ai * HALF + m * 16;
          const float r = rs[ai * 4 + m];
          const i32x4 a0 = acc[ai][bj][m][0], a1 = acc[ai][bj][m][1];
          u32x4 w;
          w.x = pkh((float)a0[0] * r * c0[0], (float)a0[1] * r * c0[1]); w.y = pkh((float)a0[2] * r * c0[2], (float)a0[3] * r * c0[3]);
          w.z = pkh((float)a1[0] * r * c1[0], (float)a1[1] * r * c1[1]); w.w = pkh((float)a1[2] * r * c1[2], (float)a1[3] * r * c1[3]);
          *(u32x4*)(base + (size_t)row * ld + col0 + bj * HALF) = w;
        }
    }
  }
};
struct EpiInprojT8 {
  static constexpr bool PERM = true; static constexpr bool HOOKS = false; static constexpr int H1 = 0, H2 = 0;
  typedef i32x4 acc_t;
  u16* vT; const float* sa; const float* sw;
  __device__ __forceinline__ void operator()(AccRefI acc, const Unit& u, int wr, int wc, int fr, int fq) const {
    const bool isctx = (u.pn >= 128);
    const int b = isctx ? (u.pn - 128) : (u.pn >> 4);
    const int Lseg = isctx ? 256 : 4096, t0 = isctx ? 0 : (u.pn & 15) * 256;
    const bool isv = (u.pm < 2);
    const size_t boff = isv ? (isctx ? (size_t)16777216 : (size_t)0) : (isctx ? (size_t)(16777216 + 1048576 + 25165824) : (size_t)(16777216 + 1048576));
    u16* base = vT + boff;
    const int nc = isv ? 512 : 768;
    const int wrow0 = (isv ? u.pm : u.pm - 2) * BM + wr * 64 + fr;
    const int srow0 = u.pm * BM + wr * 64 + fr;
    const int col0 = t0 + wc * 32 + 8 * fq;
    const int tok0 = u.pn * BM + wc * 32 + 8 * fq;
    float rs[8];
    f32x4 cs[2][2];
#pragma unroll
    for (int i = 0; i < 8; ++i) rs[i] = sw[srow0 + (i >> 2) * HALF + (i & 3) * 16];
#pragma unroll
    for (int bj = 0; bj < 2; ++bj) { cs[bj][0] = *(const f32x4*)(sa + tok0 + bj * HALF); cs[bj][1] = *(const f32x4*)(sa + tok0 + bj * HALF + 4); }
#pragma unroll
    for (int bj = 0; bj < 2; ++bj) {
      const f32x4 c0 = cs[bj][0], c1 = cs[bj][1];
#pragma unroll
      for (int ai = 0; ai < 2; ++ai)
#pragma unroll
        for (int m = 0; m < 4; ++m) {
          const float r = rs[ai * 4 + m];
          const i32x4 a0 = acc[ai][bj][m][0], a1 = acc[ai][bj][m][1];
          u32x4 w;
          w.x = pkh((float)a0[0] * r * c0[0], (float)a0[1] * r * c0[1]); w.y = pkh((float)a0[2] * r * c0[2], (float)a0[3] * r * c0[3]);
          w.z = pkh((float)a1[0] * r * c1[0], (float)a1[1] * r * c1[1]); w.w = pkh((float)a1[2] * r * c1[2], (float)a1[3] * r * c1[3]);
          *(u32x4*)(base + ((size_t)(b * nc + wrow0 + ai * HALF + m * 16)) * Lseg + col0 + bj * HALF) = w;
        }
    }
  }
};
struct EpiGate8 {
  static constexpr bool PERM = true; static constexpr bool HOOKS = false; static constexpr int H1 = 0, H2 = 0;
  typedef i32x4 acc_t;
  unsigned char* g8; const float* bias; const float* sa; const float* sw;
  __device__ __forceinline__ void operator()(AccRefI acc, const Unit& u, int wr, int wc, int fr, int fq) const {
    const int row0 = u.pm * BM + wr * 64 + fr;
    const int col0 = u.pn * BM + wc * 32 + 8 * fq;
    typedef float f32x2 __attribute__((ext_vector_type(2)));
    float rs[8];
    f32x4 bs[2][2], cs[2][2];
#pragma unroll
    for (int i = 0; i < 8; ++i) rs[i] = sa[row0 + (i >> 2) * HALF + (i & 3) * 16];
#pragma unroll
    for (int bj = 0; bj < 2; ++bj) {
      bs[bj][0] = *(const f32x4*)(bias + col0 + bj * HALF); bs[bj][1] = *(const f32x4*)(bias + col0 + bj * HALF + 4);
      cs[bj][0] = *(const f32x4*)(sw + col0 + bj * HALF); cs[bj][1] = *(const f32x4*)(sw + col0 + bj * HALF + 4);
    }
#pragma unroll
    for (int bj = 0; bj < 2; ++bj) {
      f32x2 cn[4], bn[4];
#pragma unroll
      for (int k = 0; k < 2; ++k) {
        cn[k] = (f32x2){cs[bj][0][2 * k], cs[bj][0][2 * k + 1]} * -1.4426950408889634f; cn[2 + k] = (f32x2){cs[bj][1][2 * k], cs[bj][1][2 * k + 1]} * -1.4426950408889634f;
        bn[k] = (f32x2){bs[bj][0][2 * k], bs[bj][0][2 * k + 1]} * -1.4426950408889634f; bn[2 + k] = (f32x2){bs[bj][1][2 * k], bs[bj][1][2 * k + 1]} * -1.4426950408889634f;
      }
#pragma unroll
      for (int ai = 0; ai < 2; ++ai)
#pragma unroll
        for (int m = 0; m < 4; ++m) {
          const int row = row0 + ai * HALF + m * 16;
          const float r = rs[ai * 4 + m];
          const i32x4 a0 = acc[ai][bj][m][0], a1 = acc[ai][bj][m][1];
          unsigned qb[8];
#pragma unroll
          for (int k = 0; k < 4; ++k) {
            const f32x2 av = (k < 2) ? (f32x2){(float)a0[2 * k], (float)a0[2 * k + 1]} : (f32x2){(float)a1[2 * k - 4], (float)a1[2 * k - 3]};
            const f32x2 z = __builtin_elementwise_fma(av * r, cn[k], bn[k]);
            const f32x2 d = (f32x2){__builtin_amdgcn_exp2f(z.x), __builtin_amdgcn_exp2f(z.y)} + 1.0f;
            const f32x2 sg = {__builtin_amdgcn_rcpf(d.x), __builtin_amdgcn_rcpf(d.y)};
            const f32x2 q = __builtin_elementwise_fma(sg, (f32x2){255.0f, 255.0f}, (f32x2){8388608.0f, 8388608.0f});
            const float qx = q.x, qy = q.y;
            qb[2 * k] = __float_as_uint(qx); qb[2 * k + 1] = __float_as_uint(qy);
          }
          unsigned p0, p1, p2, p3;
          asm("v_perm_b32 %0, %1, %2, %3" : "=v"(p0) : "v"(qb[1]), "v"(qb[0]), "s"(0x0c0c0400u));
          asm("v_perm_b32 %0, %1, %2, %3" : "=v"(p1) : "v"(qb[3]), "v"(qb[2]), "s"(0x04000c0cu));
          asm("v_perm_b32 %0, %1, %2, %3" : "=v"(p2) : "v"(qb[5]), "v"(qb[4]), "s"(0x0c0c0400u));
          asm("v_perm_b32 %0, %1, %2, %3" : "=v"(p3) : "v"(qb[7]), "v"(qb[6]), "s"(0x04000c0cu));
          const unsigned w0 = p0 | p1, w1 = p2 | p3;
          *(uint2*)(g8 + (size_t)row * 3072 + col0 + bj * HALF) = make_uint2(w0, w1);
        }
    }
  }
};
}

__device__ __forceinline__ void tr_tile(const float* __restrict__ src, int N, int K, u16* __restrict__ dst, int tile, char* smem) {
  float* lds = (float*)smem;
  const int tiles_n = N >> 6;
  const int tk = tile / tiles_n, tn = tile - tk * tiles_n;
  const int tid = opaque_tid();
  {
    const int r = tid >> 3, c8 = (tid & 7) * 8;
    const float* s = src + (size_t)(tk * 64 + r) * N + tn * 64 + c8;
    float4 a = *(const float4*)s, b = *(const float4*)(s + 4);
    float* d = lds + r * 65 + c8;
    d[0] = a.x; d[1] = a.y; d[2] = a.z; d[3] = a.w; d[4] = b.x; d[5] = b.y; d[6] = b.z; d[7] = b.w;
  }
  __syncthreads();
  {
    const int n = tid >> 3, k0 = (tid & 7) * 8;
    uint4 o;
    o.x = pk2(lds[(k0 + 0) * 65 + n], lds[(k0 + 1) * 65 + n]);
    o.y = pk2(lds[(k0 + 2) * 65 + n], lds[(k0 + 3) * 65 + n]);
    o.z = pk2(lds[(k0 + 4) * 65 + n], lds[(k0 + 5) * 65 + n]);
    o.w = pk2(lds[(k0 + 6) * 65 + n], lds[(k0 + 7) * 65 + n]);
    *(uint4*)(dst + (size_t)(tn * 64 + n) * K + tk * 64 + k0) = o;
  }
  __syncthreads();
}
__device__ __forceinline__ void colmax_task(const float* __restrict__ w, int N, int n0, float* __restrict__ swp, char* smem) {
  const int tid = opaque_tid();
  const int col = tid & 63, kg = tid >> 6;
  float m = 0.f;
  const float* wp = w + (size_t)(kg * 128) * N + n0 + col;
#pragma unroll 16
  for (int k = 0; k < 128; ++k) m = fmaxf(m, fabsf(wp[(size_t)k * N]));
  float* red = (float*)smem;
  red[kg * 64 + col] = m;
  __syncthreads();
  if (tid < 64) {
    float mm = red[tid];
#pragma unroll
    for (int g = 1; g < 8; ++g) mm = fmaxf(mm, red[g * 64 + tid]);
    swp[n0 + tid] = fmaxf(mm, 1e-20f) * (1.0f / 127.0f);
  }
  __syncthreads();
}
__device__ __forceinline__ void tr_tile_i8(const float* __restrict__ src, int N, int K, unsigned char* __restrict__ dst, int tile, const float* __restrict__ swp, char* smem) {
  float* lds = (float*)smem;
  const int tiles_n = N >> 6;
  const int tk = tile / tiles_n, tn = tile - tk * tiles_n;
  const int tid = opaque_tid();
  {
    const int r = tid >> 3, c8 = (tid & 7) * 8;
    const float* sp = src + (size_t)(tk * 64 + r) * N + tn * 64 + c8;
    float4 a = *(const float4*)sp, b = *(const float4*)(sp + 4);
    float* d = lds + r * 65 + c8;
    d[0] = a.x; d[1] = a.y; d[2] = a.z; d[3] = a.w; d[4] = b.x; d[5] = b.y; d[6] = b.z; d[7] = b.w;
  }
  __syncthreads();
  {
    const int n = tid >> 3, k0 = (tid & 7) * 8;
    const float inv = 1.0f / swp[tn * 64 + n];
    unsigned w0 = 0, w1 = 0;
#pragma unroll
    for (int i = 0; i < 4; ++i) {
      w0 |= ((unsigned)__float2int_rn(lds[(k0 + i) * 65 + n] * inv) & 255u) << (8 * i);
      w1 |= ((unsigned)__float2int_rn(lds[(k0 + 4 + i) * 65 + n] * inv) & 255u) << (8 * i);
    }
    *(uint2*)(dst + (size_t)(tn * 64 + n) * K + tk * 64 + k0) = make_uint2(w0, w1);
  }
  __syncthreads();
}
__device__ __forceinline__ void cvt_chunk(const float* __restrict__ src, u16* __restrict__ dst, size_t chunk) {
  const size_t i = chunk * 4096 + (size_t)opaque_tid() * 8;
  float4 a = *(const float4*)(src + i), b = *(const float4*)(src + i + 4);
  uint4 o;
  o.x = pk2(a.x, a.y); o.y = pk2(a.z, a.w); o.z = pk2(b.x, b.y); o.w = pk2(b.z, b.w);
  *(uint4*)(dst + i) = o;
}
template <bool I8>
__device__ __forceinline__ void tr_tile4(const float* __restrict__ src, int N, int K, void* __restrict__ dstv, int tile4, const float* __restrict__ swp, char* smem) {
  float* lds = (float*)smem;
  const int tiles_n = N >> 6;
  const int tkq = tile4 / tiles_n, tn = tile4 - tkq * tiles_n;
  const int tid = opaque_tid();
  {
    const int r = tid >> 3, c8 = (tid & 7) * 8;
    const float* sp = src + (size_t)(tkq * 256 + r) * N + tn * 64 + c8;
    float4 a[4], b[4];
#pragma unroll
    for (int q = 0; q < 4; ++q) { a[q] = *(const float4*)(sp + (size_t)q * 64 * N); b[q] = *(const float4*)(sp + (size_t)q * 64 * N + 4); }
#pragma unroll
    for (int q = 0; q < 4; ++q) {
      float* d = lds + q * 4160 + r * 65 + c8;
      d[0] = a[q].x; d[1] = a[q].y; d[2] = a[q].z; d[3] = a[q].w; d[4] = b[q].x; d[5] = b[q].y; d[6] = b[q].z; d[7] = b[q].w;
    }
  }
  __syncthreads();
  {
    const int n = tid >> 3, k0 = (tid & 7) * 8;
    if (I8) {
      const float inv = 1.0f / swp[tn * 64 + n];
      unsigned char* dst = (unsigned char*)dstv;
#pragma unroll
      for (int q = 0; q < 4; ++q) {
        const float* lq = lds + q * 4160;
        unsigned w0 = 0, w1 = 0;
#pragma unroll
        for (int i = 0; i < 4; ++i) {
          w0 |= ((unsigned)__float2int_rn(lq[(k0 + i) * 65 + n] * inv) & 255u) << (8 * i);
          w1 |= ((unsigned)__float2int_rn(lq[(k0 + 4 + i) * 65 + n] * inv) & 255u) << (8 * i);
        }
        *(uint2*)(dst + (size_t)(tn * 64 + n) * K + tkq * 256 + q * 64 + k0) = make_uint2(w0, w1);
      }
    } else {
      u16* dst = (u16*)dstv;
#pragma unroll
      for (int q = 0; q < 4; ++q) {
        const float* lq = lds + q * 4160;
        uint4 o;
        o.x = pk2(lq[(k0 + 0) * 65 + n], lq[(k0 + 1) * 65 + n]);
        o.y = pk2(lq[(k0 + 2) * 65 + n], lq[(k0 + 3) * 65 + n]);
        o.z = pk2(lq[(k0 + 4) * 65 + n], lq[(k0 + 5) * 65 + n]);
        o.w = pk2(lq[(k0 + 6) * 65 + n], lq[(k0 + 7) * 65 + n]);
        *(uint4*)(dst + (size_t)(tn * 64 + n) * K + tkq * 256 + q * 64 + k0) = o;
      }
    }
  }
  __syncthreads();
}
__device__ __forceinline__ void colmax4_task(const float* __restrict__ w, int N, int n0, float* __restrict__ swp, char* smem) {
  const int tid = opaque_tid();
  const int c4 = (tid & 15) * 4, rg = tid >> 4;
  const float* wp = w + (size_t)(rg * 32) * N + n0 + c4;
  float4 m = {0.f, 0.f, 0.f, 0.f};
#pragma unroll 16
  for (int k = 0; k < 32; ++k) {
    const float4 v = *(const float4*)(wp + (size_t)k * N);
    m.x = fmaxf(m.x, fabsf(v.x)); m.y = fmaxf(m.y, fabsf(v.y)); m.z = fmaxf(m.z, fabsf(v.z)); m.w = fmaxf(m.w, fabsf(v.w));
  }
  float* red = (float*)smem;
  *(float4*)(red + rg * 64 + c4) = m;
  __syncthreads();
  if (tid < 64) {
    float mm = red[tid];
#pragma unroll
    for (int g = 1; g < 32; ++g) mm = fmaxf(mm, red[g * 64 + tid]);
    swp[n0 + tid] = fmaxf(mm, 1e-20f) * (1.0f / 127.0f);
  }
  __syncthreads();
}
__device__ __forceinline__ void cvt_chunk4(const float* __restrict__ src, u16* __restrict__ dst, size_t chunk4) {
  const size_t i = chunk4 * 16384 + (size_t)opaque_tid() * 8;
  float4 a[4], b[4];
#pragma unroll
  for (int q = 0; q < 4; ++q) { a[q] = *(const float4*)(src + i + q * 4096); b[q] = *(const float4*)(src + i + q * 4096 + 4); }
#pragma unroll
  for (int q = 0; q < 4; ++q) {
    uint4 o;
    o.x = pk2(a[q].x, a[q].y); o.y = pk2(a[q].z, a[q].w); o.z = pk2(b[q].x, b[q].y); o.w = pk2(b[q].z, b[q].w);
    *(uint4*)(dst + i + q * 4096) = o;
  }
}
__device__ __forceinline__ void cvt_chunk_fp8(const float* __restrict__ src, unsigned char* __restrict__ dst, size_t chunk, float scale) {
  const size_t i = chunk * 4096 + (size_t)opaque_tid() * 8;
  const float4 a = *(const float4*)(src + i), b = *(const float4*)(src + i + 4);
  int w0 = __builtin_amdgcn_cvt_pk_fp8_f32(a.x * scale, a.y * scale, 0, false);
  w0 = __builtin_amdgcn_cvt_pk_fp8_f32(a.z * scale, a.w * scale, w0, true);
  int w1 = __builtin_amdgcn_cvt_pk_fp8_f32(b.x * scale, b.y * scale, 0, false);
  w1 = __builtin_amdgcn_cvt_pk_fp8_f32(b.z * scale, b.w * scale, w1, true);
  *(uint2*)(dst + i) = make_uint2((unsigned)w0, (unsigned)w1);
}
__device__ __forceinline__ void cvt_chunk_fp4(const float* __restrict__ src, unsigned char* __restrict__ dst, size_t chunk, float scale, int vhalf) {
  const size_t i = chunk * 4096 + (size_t)opaque_tid() * 8;
  const float4 a = *(const float4*)(src + i), b = *(const float4*)(src + i + 4);
  unsigned w = 0;
  w = __builtin_amdgcn_cvt_scalef32_pk_fp4_f32(w, a.x * scale, a.y * scale, 1.0f, 0);
  w = __builtin_amdgcn_cvt_scalef32_pk_fp4_f32(w, a.z * scale, a.w * scale, 1.0f, 1);
  w = __builtin_amdgcn_cvt_scalef32_pk_fp4_f32(w, b.x * scale, b.y * scale, 1.0f, 2);
  w = __builtin_amdgcn_cvt_scalef32_pk_fp4_f32(w, b.z * scale, b.w * scale, 1.0f, 3);
  const size_t e = i >> 10;
  const unsigned d = (unsigned)(i & 1023);
  *(unsigned*)(dst + e * 1024 + vhalf * 512 + (d >> 1)) = w;
}
__device__ __forceinline__ void cvt_chunk_fp4x8(const float* __restrict__ src, unsigned char* __restrict__ dst, int t0, int step, int tmax, float scale, int vhalf) {
  const int tid8 = opaque_tid() * 8;
  float4 a[8], b[8];
#pragma unroll
  for (int q = 0; q < 8; ++q) {
    const int t = t0 + q * step;
    const size_t i = (size_t)(t < tmax ? t : t0) * 4096 + tid8;
    a[q] = *(const float4*)(src + i); b[q] = *(const float4*)(src + i + 4);
  }
#pragma unroll
  for (int q = 0; q < 8; ++q) {
    const int t = t0 + q * step;
    if (t < tmax) {
      const size_t i = (size_t)t * 4096 + tid8;
      unsigned w = 0;
      w = __builtin_amdgcn_cvt_scalef32_pk_fp4_f32(w, a[q].x * scale, a[q].y * scale, 1.0f, 0);
      w = __builtin_amdgcn_cvt_scalef32_pk_fp4_f32(w, a[q].z * scale, a[q].w * scale, 1.0f, 1);
      w = __builtin_amdgcn_cvt_scalef32_pk_fp4_f32(w, b[q].x * scale, b[q].y * scale, 1.0f, 2);
      w = __builtin_amdgcn_cvt_scalef32_pk_fp4_f32(w, b[q].z * scale, b[q].w * scale, 1.0f, 3);
      const size_t e = i >> 10;
      const unsigned d = (unsigned)(i & 1023);
      *(unsigned*)(dst + e * 1024 + vhalf * 512 + (d >> 1)) = w;
    }
  }
}
__device__ __forceinline__ void phase_modreduce(const P& p) {
  const int n = 2 * 9 * 6144;
  for (int i = blockIdx.x * NTHR + opaque_tid(); i < n; i += gridDim.x * NTHR) {
    const int l = i / (9 * 6144);
    const int j = i % 6144;
    float s = p.b_ada[l * 6144 + j];
#pragma unroll
    for (int kc = 0; kc < 16; ++kc) s += p.modpart[(size_t)kc * n + i];
    p.mod[i] = s;
  }
}

__device__ __forceinline__ void phase_norm(const P& p, int l, int which) {
  const int tid_ = opaque_tid(); const int lane = tid_ & 63, wid = tid_ >> 6;
  const int ntok = (which == 2 || (which == 1 && l == 1)) ? NLAT : NTOK;
  float4 vn[4]; uint2 rn[4];
#define PN_LOAD(R) do { const int r_ = (R); if (which == 0) { const float* src_ = (r_ < NLAT) ? p.x + (size_t)r_ * 1024 : p.ctx + (size_t)(r_ - NLAT) * 1024; \
      _Pragma("unroll") for (int i = 0; i < 4; ++i) vn[i] = *(const float4*)(src_ + i * 256 + lane * 4); } \
    else { _Pragma("unroll") for (int i = 0; i < 4; ++i) rn[i] = *(const uint2*)(p.res + (size_t)r_ * 1024 + i * 256 + lane * 4); } } while (0)
  if (blockIdx.x * 8 + wid < ntok) PN_LOAD(blockIdx.x * 8 + wid);
  for (int row = blockIdx.x * 8 + wid; row < ntok; row += gridDim.x * 8) {
    float4 v[4];
    float ss = 0.f;
#pragma unroll
    for (int i = 0; i < 4; ++i) {
      if (which == 0) v[i] = vn[i]; else v[i] = make_float4(bflo(rn[i].x), bfhi(rn[i].x), bflo(rn[i].y), bfhi(rn[i].y));
      ss += v[i].x * v[i].x + v[i].y * v[i].y + v[i].z * v[i].z + v[i].w * v[i].w;
    }
    {
      const int nrow = row + gridDim.x * 8;
      if (nrow < ntok) PN_LOAD(nrow);
    }
    ss = wave_sum(ss);
    const float rstd = rsqrtf(ss * (1.0f / 1024.0f) + 1e-6f);
    if (which == 2) {
#pragma unroll
      for (int i = 0; i < 4; ++i) {
        const int col = i * 256 + lane * 4;
        const float4 g = *(const float4*)(p.final_g + col);
        float4 o = {v[i].x * rstd * g.x, v[i].y * rstd * g.y, v[i].z * rstd * g.z, v[i].w * rstd * g.w};
        *(float4*)(p.out + (size_t)row * 1024 + col) = o;
      }
    } else {
      const int bi = row < NLAT ? (row >> 12) : 8;
      const float* gam = (which == 0 ? p.norm_mix_g : p.norm_ffn_g) + l * 1024;
      const float* msh = p.mod + ((size_t)(l * 9 + bi) * 6 + (which == 0 ? 0 : 3)) * 1024;
      const float* msc = msh + 1024;
      float4 y[4];
      float amax = 0.f;
#pragma unroll
      for (int i = 0; i < 4; ++i) {
        const int col = i * 256 + lane * 4;
        const float4 g = *(const float4*)(gam + col);
        const float4 sh = *(const float4*)(msh + col);
        const float4 sc = *(const float4*)(msc + col);
        y[i].x = v[i].x * rstd * g.x * (1.f + sc.x) + sh.x; y[i].y = v[i].y * rstd * g.y * (1.f + sc.y) + sh.y;
        y[i].z = v[i].z * rstd * g.z * (1.f + sc.z) + sh.z; y[i].w = v[i].w * rstd * g.w * (1.f + sc.w) + sh.w;
        amax = fmaxf(amax, fmaxf(fmaxf(fabsf(y[i].x), fabsf(y[i].y)), fmaxf(fabsf(y[i].z), fabsf(y[i].w))));
      }
      if (which == 0 || which == 1) {
        amax = fmaxf(wave_max(amax), 1e-20f);
        const float inv = 127.0f / amax;
#pragma unroll
        for (int i = 0; i < 4; ++i) {
          const unsigned w = ((unsigned)__float2int_rn(y[i].x * inv) & 255u) | (((unsigned)__float2int_rn(y[i].y * inv) & 255u) << 8) |
                             (((unsigned)__float2int_rn(y[i].z * inv) & 255u) << 16) | (((unsigned)__float2int_rn(y[i].w * inv) & 255u) << 24);
          *(unsigned*)(p.xn8 + (size_t)row * 1024 + i * 256 + lane * 4) = w;
        }
        if (lane == 0) p.sa[row] = amax * (1.0f / 127.0f);
      } else {
#pragma unroll
        for (int i = 0; i < 4; ++i) {
          uint2 o;
          o.x = pk2(y[i].x, y[i].y);
          o.y = pk2(y[i].z, y[i].w);
          *(uint2*)(p.xn + (size_t)row * 1024 + i * 256 + lane * 4) = o;
        }
      }
    }
  }
}

__device__ __forceinline__ void filter_wave(const P& p, int l, int L, int t, float* __restrict__ outp) {
  const int lane = opaque_tid() & 63;
  const float tl = (float)t / (float)(L - 1);
  const float wang = (6.283185307179586f / (float)L) * (float)t;
  float z = 0.f;
  if (lane == 0) z = tl;
  else if (lane <= 16) { const float band = 1e-4f + (float)(lane - 1) * ((15.0f - 1e-4f) / 15.0f); z = cosf(band * wang); }
  else if (lane <= 32) { const float band = 1e-4f + (float)(lane - 17) * ((15.0f - 1e-4f) / 15.0f); z = -sinf(band * wang); }
  float a1 = p.hy_f1_b[l * 64 + lane];
  for (int i = 0; i < 33; ++i) a1 += shf(z, i) * p.hy_f1_w[(l * 33 + i) * 64 + lane];
  const float h1 = sinf(p.hy_freq[l * 128 + lane] * a1);
  float a2 = p.hy_f2_b[l * 64 + lane];
  for (int i = 0; i < 64; ++i) a2 += shf(h1, i) * p.hy_f2_w[(l * 64 + i) * 64 + lane];
  const float h2 = sinf(p.hy_freq[l * 128 + 64 + lane] * a2);
  float a3[8];
#pragma unroll
  for (int m = 0; m < 8; ++m) a3[m] = 0.f;
  for (int i = 0; i < 64; ++i) {
    const float hv = shf(h2, i);
    const float* wr = p.hy_f3_w + (size_t)(l * 64 + i) * 512 + lane;
#pragma unroll
    for (int m = 0; m < 8; ++m) a3[m] += hv * wr[m * 64];
  }
  const float LN100 = 4.605170185988092f;
  const float d0 = LN100 / 1.5f, d1 = LN100 / 0.3f;
#pragma unroll
  for (int m = 0; m < 8; ++m) {
    const int cp = lane + 64 * m;
    const int ch = cp & 255;
    const float delta = d0 + (float)ch * ((d1 - d0) / 255.0f);
    outp[(size_t)cp * L + t] = a3[m] * expf(-tl * delta);
  }
}
__device__ __forceinline__ void filter_block_task(const P& p, int l, int L, int t0, float* __restrict__ outp, char* smem) {
  const int tid = opaque_tid(), lane = tid & 63, wid = tid >> 6;
  float* W3s = (float*)smem;
  float* W2s = (float*)(smem + 131072);
  {
    const float4* s3 = (const float4*)(p.hy_f3_w + (size_t)l * 64 * 512);
    const float4* s2 = (const float4*)(p.hy_f2_w + (size_t)l * 64 * 64);
#pragma unroll
    for (int i = 0; i < 16; ++i) ((float4*)W3s)[tid + NTHR * i] = s3[tid + NTHR * i];
#pragma unroll
    for (int i = 0; i < 2; ++i) ((float4*)W2s)[tid + NTHR * i] = s2[tid + NTHR * i];
  }
  __syncthreads();
  float z[4], tl[4];
#pragma unroll
  for (int j = 0; j < 4; ++j) {
    const int t = t0 + wid * 4 + j;
    tl[j] = (float)t / (float)(L - 1);
    const float wang = (6.283185307179586f / (float)L) * (float)t;
    float zz = 0.f;
    if (lane == 0) zz = tl[j];
    else if (lane <= 16) { const float band = 1e-4f + (float)(lane - 1) * ((15.0f - 1e-4f) / 15.0f); zz = cosf(band * wang); }
    else if (lane <= 32) { const float band = 1e-4f + (float)(lane - 17) * ((15.0f - 1e-4f) / 15.0f); zz = -sinf(band * wang); }
    z[j] = zz;
  }
  float a1[4], a2[4];
  {
    const float b1 = p.hy_f1_b[l * 64 + lane];
#pragma unroll
    for (int j = 0; j < 4; ++j) a1[j] = b1;
#pragma unroll 11
    for (int i = 0; i < 33; ++i) {
      const float w = p.hy_f1_w[(l * 33 + i) * 64 + lane];
#pragma unroll
      for (int j = 0; j < 4; ++j) a1[j] += shf(z[j], i) * w;
    }
    const float f0 = p.hy_freq[l * 128 + lane];
#pragma unroll
    for (int j = 0; j < 4; ++j) a1[j] = sinf(f0 * a1[j]);
  }
  {
    const float b2 = p.hy_f2_b[l * 64 + lane];
#pragma unroll
    for (int j = 0; j < 4; ++j) a2[j] = b2;
#pragma unroll 8
    for (int i = 0; i < 64; ++i) {
      const float w = W2s[i * 64 + lane];
#pragma unroll
      for (int j = 0; j < 4; ++j) a2[j] += shf(a1[j], i) * w;
    }
    const float f1 = p.hy_freq[l * 128 + 64 + lane];
#pragma unroll
    for (int j = 0; j < 4; ++j) a2[j] = sinf(f1 * a2[j]);
  }
  float a3[4][8];
#pragma unroll
  for (int j = 0; j < 4; ++j)
#pragma unroll
    for (int m = 0; m < 8; ++m) a3[j][m] = 0.f;
#pragma unroll 4
  for (int i = 0; i < 64; ++i) {
    float w[8];
#pragma unroll
    for (int m = 0; m < 8; ++m) w[m] = W3s[i * 512 + lane + 64 * m];
#pragma unroll
    for (int j = 0; j < 4; ++j) {
      const float hv = shf(a2[j], i);
#pragma unroll
      for (int m = 0; m < 8; ++m) a3[j][m] += hv * w[m];
    }
  }
  const float LN100 = 4.605170185988092f;
  const float d0 = LN100 / 1.5f, d1 = LN100 / 0.3f;
#pragma unroll
  for (int m = 0; m < 8; ++m) {
    const int cp = lane + 64 * m;
    const float delta = d0 + (float)(cp & 255) * ((d1 - d0) / 255.0f);
    float4 o;
    o.x = a3[0][m] * expf(-tl[0] * delta); o.y = a3[1][m] * expf(-tl[1] * delta);
    o.z = a3[2][m] * expf(-tl[2] * delta); o.w = a3[3][m] * expf(-tl[3] * delta);
    *(float4*)(outp + (size_t)cp * L + t0 + wid * 4) = o;
  }
  __syncthreads();
}
__device__ __forceinline__ void phase_filters(const P& p, int l, char* smem) {
  const int ntask = 128 + (l == 0 ? 8 : 0);
  for (int t = blockIdx.x; t < ntask; t += gridDim.x) {
    if (t < 128) filter_block_task(p, l, 4096, t * 32, p.hT + (size_t)l * 512 * 4096, smem);
    else filter_block_task(p, l, 256, (t - 128) * 32, p.hc, smem);
  }
}
__device__ __forceinline__ void adaln_task(const P& p, int t, char* smem) {
  const int tid = opaque_tid();
  const int kc = t & 15; t >>= 4;
  const int jc = t % 12, l = t / 12;
  float* s = (float*)smem;
  float* red = (float*)(smem + 4096);
  for (int i = tid; i < 576; i += NTHR) {
    const int bi = i >> 6, kk = i & 63;
    const float v = (bi < 8) ? p.c[bi * 1024 + kc * 64 + kk] : p.c_ctx[kc * 64 + kk];
    s[i] = v / (1.0f + __expf(-v));
  }
  const int kq = tid >> 7, c4 = (tid & 127) * 4;
  const float* wp = p.w_ada + ((size_t)l * 1024 + kc * 64 + kq * 16) * 6144 + jc * 512 + c4;
  float4 w[16];
#pragma unroll
  for (int kk = 0; kk < 16; ++kk) w[kk] = *(const float4*)(wp + (size_t)kk * 6144);
  __syncthreads();
  float4 acc[9];
#pragma unroll
  for (int bi = 0; bi < 9; ++bi) acc[bi] = make_float4(0.f, 0.f, 0.f, 0.f);
#pragma unroll
  for (int kk = 0; kk < 16; ++kk) {
#pragma unroll
    for (int bi = 0; bi < 9; ++bi) {
      const float sv = s[bi * 64 + kq * 16 + kk];
      acc[bi].x += sv * w[kk].x; acc[bi].y += sv * w[kk].y; acc[bi].z += sv * w[kk].z; acc[bi].w += sv * w[kk].w;
    }
  }
#pragma unroll
  for (int bi = 0; bi < 9; ++bi) *(float4*)(red + (kq * 9 + bi) * 512 + c4) = acc[bi];
  __syncthreads();
#pragma unroll
  for (int bi = 0; bi < 9; ++bi) {
    const float v = red[bi * 512 + tid] + red[(9 + bi) * 512 + tid] + red[(18 + bi) * 512 + tid] + red[(27 + bi) * 512 + tid];
    p.modpart[((size_t)(kc * 2 + l) * 9 + bi) * 6144 + jc * 512 + tid] = v;
  }
  __syncthreads();
}
__device__ __forceinline__ void phase_prep(const P& p, char* smem, unsigned* counter) {
  volatile int* s_taskp = (volatile int*)(smem + SMEM_BYTES - 16);
  const int total = 264 + 184 + 384 + 544 + 32;
  int nxt = 0;
  if (threadIdx.x == 0) nxt = (int)atomicAdd(counter, 1u);
  for (;;) {
    __syncthreads();
    if (threadIdx.x == 0) *s_taskp = nxt;
    __syncthreads();
    int t = *s_taskp;
    if (t >= total) break;
    if (threadIdx.x == 0) nxt = (int)atomicAdd(counter, 1u);
    if (t < 264) {
      if (t < 128) filter_block_task(p, 0, 4096, t * 32, p.hT, smem);
      else if (t < 256) filter_block_task(p, 1, 4096, (t - 128) * 32, p.hT + (size_t)512 * 4096, smem);
      else filter_block_task(p, 0, 256, (t - 256) * 32, p.hc, smem);
      continue;
    }
    t -= 264;
    if (t < 184) {
      const int l = t / 92; t -= l * 92;
      if (t < 44) colmax4_task(p.w_in + (size_t)l * 1024 * 2816, 2816, t * 64, p.sw + l * 5888, smem);
      else colmax4_task(p.w_gate + (size_t)l * 1024 * 3072, 3072, (t - 44) * 64, p.sw + l * 5888 + 2816, smem);
      continue;
    }
    t -= 184;
    if (t < 384) { adaln_task(p, t, smem); continue; }
    t -= 384;
    if (t < 544) {
      const int l = t / 272; t -= l * 272;
      if (t < 32) tr_tile4<false>(p.w_br_a + (size_t)l * 512 * 1024, 1024, 1024, p.WaT + (size_t)l * 1024 * 1024, t, nullptr, smem);
      else if ((t -= 32) < 16) tr_tile4<false>(p.w_br_b + (size_t)l * 256 * 1024, 1024, 1024, p.WaT + (size_t)l * 1024 * 1024 + 512, t, nullptr, smem);
      else if ((t -= 16) < 16) tr_tile4<false>(p.w_br_c + (size_t)l * 256 * 1024, 1024, 1024, p.WaT + (size_t)l * 1024 * 1024 + 768, t, nullptr, smem);
      else if ((t -= 16) < 64) tr_tile4<false>(p.w_out + (size_t)l * 1024 * 1024, 1024, 1024, p.WoT + (size_t)l * 1024 * 1024, t, nullptr, smem);
      else if ((t -= 64) < 128) cvt_chunk4(p.peer_wq + (size_t)l * 1024 * 2048, p.WqB + (size_t)l * 1024 * 2048, (size_t)t);
      else {
        t -= 128;
        const int gate = t >> 3, dn = t & 7;
        const float* src = (gate ? p.rg_wx : p.rg_wa) + (size_t)(l * 8 + dn) * 4096;
        tr_tile(src, 64, 64, p.rgW + (size_t)((l * 2 + gate) * 8 + dn) * 4096, 0, smem);
      }
      continue;
    }
    t -= 544;
    cvt_chunk4(p.peer_keys, p.keysB, (size_t)t);
  }
}
__device__ __forceinline__ void kf_task(const P& p, int l, int c, char* smem) {
  const float* hTl = p.hT + (size_t)l * 512 * 4096;
  c2* buf = (c2*)smem;
  const int tid = opaque_tid();
  for (int i = 0; i < 16; ++i) {
    const int j = tid + NTHR * i;
    float v;
    if (j < 4096) v = hTl[(size_t)c * 4096 + j];
    else if (j == 4096) v = 0.f;
    else v = hTl[(size_t)(256 + c) * 4096 + (8192 - j)];
    buf[j] = {v, 0.f};
  }
  __syncthreads();
  fft8192(buf, -1.f);
  c2* o = (c2*)p.Kf + ((size_t)l * 256 + c) * 8192;
  for (int i = 0; i < 16; ++i) { const int j = tid + NTHR * i; o[j] = buf[j]; }
  __syncthreads();
}

__device__ __forceinline__ void inproj_tile(const P& p, int l, int mt, int nt, char* smem) {
  f32x16 acc[2][2];
  zero_acc(acc);
  const int m0 = mt * 256, n0 = nt * 128;
  gemm_kloop(acc, p.xn + (size_t)m0 * 1024, 1024, p.WinT + ((size_t)l * 2816 + n0) * 1024, 1024, 1024, smem);
  EPI_VARS
  if (nt < 8 || nt >= 18) {
    u16* dst; int ld, cbase;
    if (nt < 8) { dst = p.qk; ld = 1024; cbase = n0; }
    else { dst = p.rg; ld = 512; cbase = n0 - 2304; }
#pragma unroll
    for (int i = 0; i < 2; ++i)
#pragma unroll
      for (int j = 0; j < 2; ++j)
#pragma unroll
        for (int e = 0; e < 16; ++e)
          dst[(size_t)(m0 + EPI_ROW(i, e)) * ld + cbase + EPI_COL(j)] = f2bf(acc[i][j][e]);
  } else {
#pragma unroll
    for (int i = 0; i < 2; ++i)
#pragma unroll
      for (int j = 0; j < 2; ++j)
#pragma unroll
        for (int qd = 0; qd < 4; ++qd) {
          uint2 o;
          o.x = pk2(acc[i][j][4 * qd + 0], acc[i][j][4 * qd + 1]);
          o.y = pk2(acc[i][j][4 * qd + 2], acc[i][j][4 * qd + 3]);
          const int row0 = wm * 64 + i * 32 + 8 * qd + 4 * hh;
          *(uint2*)(smem + EPI_COL(j) * 520 + row0 * 2) = o;
        }
    __syncthreads();
    u16* dstT; int Lseg, t0, ncol0, nc;
    const bool isctx = (mt >= 128);
    const int b = isctx ? (mt - 128) : (mt >> 4);
    if (nt < 12) { ncol0 = n0 - 1024; nc = 512; dstT = isctx ? p.vTc : p.vT; }
    else { ncol0 = n0 - 1536; nc = 768; dstT = isctx ? p.hyTc : p.hyT; }
    if (isctx) { Lseg = 256; t0 = 0; } else { Lseg = 4096; t0 = (mt & 15) * 256; }
#pragma unroll 4
    for (int it = 0; it < 16; ++it) {
      const int idx = tid + NTHR * it;
      const int col = idx >> 6, u = idx & 63;
      const uint2 v = *(const uint2*)(smem + col * 520 + u * 8);
      *(uint2*)(dstT + ((size_t)(b * nc + ncol0 + col)) * Lseg + t0 + u * 4) = v;
    }
    __syncthreads();
  }
}

__device__ __forceinline__ float ldbf(const u16* p, int t, int L) { return (t >= 0 && t < L) ? bf2f(p[t]) : 0.f; }
__device__ __forceinline__ void ld10(const u16* __restrict__ seq, int t0, float (&v)[10]) {
  const uint4 r = *(const uint4*)(seq + t0);
  v[0] = (t0 > 0) ? bf2f(seq[t0 - 1]) : 0.f;
  v[9] = (t0 + 8 < 4096) ? bf2f(seq[t0 + 8]) : 0.f;
  v[1] = bflo(r.x); v[2] = bfhi(r.x); v[3] = bflo(r.y); v[4] = bfhi(r.y);
  v[5] = bflo(r.z); v[6] = bfhi(r.z); v[7] = bflo(r.w); v[8] = bfhi(r.w);
}
__device__ __forceinline__ void hyena_fft_task(const P& p, int l, int c, int bp, char* smem) {
  c2* buf = (c2*)smem;
  c2* ub = (c2*)(smem + 65536);
  const int tid = opaque_tid();
  const float* sw = p.hy_short_w + l * 3 * 768;
  const float* sb = p.hy_short_b + l * 768;
  const float wx0[3] = {sw[c], sw[768 + c], sw[1536 + c]};
  const float wx1[3] = {sw[256 + c], sw[768 + 256 + c], sw[1536 + 256 + c]};
  const float wv[3] = {sw[512 + c], sw[768 + 512 + c], sw[1536 + 512 + c]};
  const float bx0 = sb[c], bx1 = sb[256 + c], bv = sb[512 + c];
  const float dsk = p.hy_bias[l * 256 + c];
  const int t0 = tid * 8;
  {
    float u[2][8];
#pragma unroll
    for (int bb = 0; bb < 2; ++bb) {
      const int b = 2 * bp + bb;
      float x1[10], vv[10];
      ld10(p.hyT + ((size_t)(b * 768 + 256 + c)) * 4096, t0, x1);
      ld10(p.hyT + ((size_t)(b * 768 + 512 + c)) * 4096, t0, vv);
#pragma unroll
      for (int k = 0; k < 8; ++k) {
        const float x1c = bx1 + wx1[0] * x1[k] + wx1[1] * x1[k + 1] + wx1[2] * x1[k + 2];
        const float vc = bv + wv[0] * vv[k] + wv[1] * vv[k + 1] + wv[2] * vv[k + 2];
        u[bb][k] = vc * x1c;
      }
    }
#pragma unroll
    for (int k = 0; k < 8; k += 2) {
      const float4 w = make_float4(u[0][k], u[1][k], u[0][k + 1], u[1][k + 1]);
      *(float4*)(buf + t0 + k) = w;
      *(float4*)(ub + t0 + k) = w;
      *(float4*)(buf + 4096 + t0 + k) = make_float4(0.f, 0.f, 0.f, 0.f);
    }
  }
  __syncthreads();
  fft8192(buf, -1.f);
  const c2* kf = (const c2*)p.Kf + ((size_t)l * 256 + c) * 8192;
  for (int i = 0; i < 16; ++i) {
    const int k = tid + NTHR * i;
    buf[k] = cmul(buf[k], kf[k]);
  }
  __syncthreads();
  fft8192(buf, 1.f);
#pragma unroll
  for (int bb = 0; bb < 2; ++bb) {
    const int b = 2 * bp + bb;
    float x0[10];
    ld10(p.hyT + ((size_t)(b * 768 + c)) * 4096, t0, x0);
    float o[8];
#pragma unroll
    for (int k = 0; k < 8; ++k) {
      const c2 y = buf[t0 + k];
      const c2 uu = ub[t0 + k];
      const float x0c = bx0 + wx0[0] * x0[k] + wx0[1] * x0[k + 1] + wx0[2] * x0[k + 2];
      const float yy = ldexpf(bb ? y.y : y.x, -13);
      const float uv = bb ? uu.y : uu.x;
      o[k] = x0c * (yy + uv * dsk);
    }
    uint4 w; w.x = pk2(o[0], o[1]); w.y = pk2(o[2], o[3]); w.z = pk2(o[4], o[5]); w.w = pk2(o[6], o[7]);
    *(uint4*)(p.ybT + ((size_t)(b * 256 + c)) * 4096 + t0) = w;
  }
  __syncthreads();
}
__device__ __forceinline__ void yb_transpose_task(const P& p, int b, int tb, char* smem) {
  const int tid = opaque_tid(), lane = tid & 63, wid = tid >> 6;
  u16* T = (u16*)smem;
#pragma unroll
  for (int it = 0; it < 4; ++it) {
    const int id = tid + NTHR * it;
    const int c = id >> 3, ch = id & 7;
    const uint4 r = *(const uint4*)(p.ybT + ((size_t)(b * 256 + c)) * 4096 + tb * 64 + ch * 8);
    unsigned* d = (unsigned*)(T + c * 66 + ch * 8);
    d[0] = r.x; d[1] = r.y; d[2] = r.z; d[3] = r.w;
  }
  __syncthreads();
#pragma unroll
  for (int it = 0; it < 8; ++it) {
    const int tt = wid + 8 * it;
    const int c0 = lane * 4;
    uint2 w;
    w.x = (unsigned)T[(c0 + 0) * 66 + tt] | ((unsigned)T[(c0 + 1) * 66 + tt] << 16);
    w.y = (unsigned)T[(c0 + 2) * 66 + tt] | ((unsigned)T[(c0 + 3) * 66 + tt] << 16);
    *(uint2*)(p.ycat + (size_t)(b * 4096 + tb * 64 + tt) * 1024 + 512 + c0) = w;
  }
  __syncthreads();
}
__device__ __forceinline__ void hyena_ctx_task(const P& p, int l, int b, int cg8, char* smem) {
  const int tid_ = opaque_tid(); const int lane = tid_ & 63, wid = tid_ >> 6;
  const int c = cg8 * 8 + wid;
  float* us = (float*)smem + wid * 1024;
  float* kfp = us + 256 + 255;
  const float* sw = p.hy_short_w + l * 3 * 768;
  const float* sb = p.hy_short_b + l * 768;
  const u16* x0 = p.hyTc + ((size_t)(b * 768 + c)) * 256;
  const u16* x1 = p.hyTc + ((size_t)(b * 768 + 256 + c)) * 256;
  const u16* vv = p.hyTc + ((size_t)(b * 768 + 512 + c)) * 256;
  for (int i = 0; i < 4; ++i) {
    const int t = lane + 64 * i;
    const float x1c = sb[256 + c] + sw[256 + c] * ldbf(x1, t - 1, 256) + sw[768 + 256 + c] * ldbf(x1, t, 256) + sw[1536 + 256 + c] * ldbf(x1, t + 1, 256);
    const float vc = sb[512 + c] + sw[512 + c] * ldbf(vv, t - 1, 256) + sw[768 + 512 + c] * ldbf(vv, t, 256) + sw[1536 + 512 + c] * ldbf(vv, t + 1, 256);
    us[t] = vc * x1c;
    kfp[t] = p.hc[(size_t)c * 256 + t];
    if (t > 0) kfp[-t] = p.hc[(size_t)(256 + c) * 256 + t];
  }
  __syncthreads();
  const float dsk = p.hy_bias[l * 256 + c];
  float acc[4] = {0.f, 0.f, 0.f, 0.f};
  for (int s = 0; s < 256; ++s) {
    const float uv = us[s];
#pragma unroll
    for (int i = 0; i < 4; ++i) acc[i] += kfp[lane + 64 * i - s] * uv;
  }
#pragma unroll
  for (int i = 0; i < 4; ++i) {
    const int t = lane + 64 * i;
    const float x0c = sb[c] + sw[c] * ldbf(x0, t - 1, 256) + sw[768 + c] * ldbf(x0, t, 256) + sw[1536 + c] * ldbf(x0, t + 1, 256);
    p.ycat[(size_t)(NLAT + b * 256 + t) * 1024 + 512 + c] = f2bf(x0c * (acc[i] + us[t] * dsk));
  }
  __syncthreads();
}

template <int DIR>
__device__ __forceinline__ void rg_scan32(const float (&Av)[2][16], const float (&Bv)[2][16], float (&carry)[2], float (&H)[2][16], int hh) {
#pragma unroll
  for (int nt = 0; nt < 2; ++nt) {
    float c = carry[nt];
#pragma unroll
    for (int go = 0; go < 8; ++go) {
      const int g = DIR ? 7 - go : go, q = g >> 1, own = g & 1;
      float h = c;
#pragma unroll
      for (int io = 0; io < 4; ++io) {
        const int e = 4 * q + (DIR ? 3 - io : io);
        h = Av[nt][e] * h + Bv[nt][e];
        H[nt][e] = (hh == own) ? h : H[nt][e];
      }
      const float mine = (hh == own) ? h : c;
      const float other = shx(mine, 32);
      c = (hh == own) ? mine : other;
    }
    carry[nt] = c;
  }
}
__device__ __forceinline__ void rg_wave_task(const P& p, int l, int bq, int nblk, int mode, bool last, char* smem) {
  const int tid = opaque_tid(), lane = tid & 63, wid = tid >> 6;
  const int l31 = lane & 31, hh = lane >> 5;
  const int b = bq / 34, rr = bq - b * 34;
  const int seg = rr < 2 ? 0 : 1, blk = rr < 2 ? rr : rr - 2;
  if (mode == 1 && seg == 0 && last) return;
  const int ck = wid >> 1, dir = wid & 1;
  char* wreg = smem + wid * 17408;
  u16* xs = (u16*)wreg;
  char* xcb = wreg + 4608;
  float* xcf = (float*)(wreg + 8704);
  float2* blockagg = (float2*)(smem + 139264);
  const int Lseg = seg ? 4096 : 256;
  const int tokbase = seg ? b * 4096 : NLAT + b * 256;
  const int T0 = blk * 128 + ck * 32;
  const int cg32 = (seg ? 8 : 0) + blk * 4 + ck;
  uint4 xt[5];
#pragma unroll
  for (int i = 0; i < 5; ++i) {
    const int idx = lane + 64 * i;
    const int row = idx >> 3, chunk = idx & 7;
    xt[i] = make_uint4(0u, 0u, 0u, 0u);
    if (row < 35) {
      const int pos = T0 - 2 + row;
      if (pos >= 0 && pos < Lseg) xt[i] = *(const uint4*)(p.rg + (size_t)(tokbase + pos) * 512 + nblk * 64 + chunk * 8);
    }
  }
  const float cw0 = p.rg_conv_w[(l * 4 + 0) * 256 + nblk * 64 + lane], cw1 = p.rg_conv_w[(l * 4 + 1) * 256 + nblk * 64 + lane];
  const float cw2 = p.rg_conv_w[(l * 4 + 2) * 256 + nblk * 64 + lane], cw3 = p.rg_conv_w[(l * 4 + 3) * 256 + nblk * 64 + lane];
  const float ccb = p.rg_conv_b[l * 256 + nblk * 64 + lane];
  bf16x8 wf[2][2][4];
#pragma unroll
  for (int gate = 0; gate < 2; ++gate) {
    const u16* wp = p.rgW + (size_t)(((l * 2 + gate) * 2 + dir) * 4 + nblk) * 4096 + l31 * 64 + 8 * hh;
#pragma unroll
    for (int nt = 0; nt < 2; ++nt)
#pragma unroll
      for (int s = 0; s < 4; ++s) wf[gate][nt][s] = *(const bf16x8*)(wp + nt * 2048 + 16 * s);
  }
  float cba[2], cbx[2], csp[2];
#pragma unroll
  for (int nt = 0; nt < 2; ++nt) {
    const int ch = (l * 2 + dir) * 256 + nblk * 64 + nt * 32 + l31;
    cba[nt] = p.rg_ba[ch];
    cbx[nt] = p.rg_bx[ch];
    csp[nt] = p.rg_lambda[ch];
  }
  float2* agg1 = (float2*)p.agg;
  float2* agg2 = (float2*)p.agg + (size_t)8 * 2 * 136 * 256;
  const int pos2 = dir ? (seg == 0 ? 1 - blk : 33 - blk) : (seg == 0 ? blk : 2 + blk);
  float hin = 0.f;
  uint4 gq[2];
  if (mode == 1) {
    const float2* a2 = agg2 + ((size_t)(b * 2 + dir) * 34) * 256 + nblk * 64 + lane;
    const float2* a1 = agg1 + ((size_t)(b * 2 + dir) * 136 + (cg32 - ck)) * 256 + nblk * 64 + lane;
    const int npre = dir ? 3 - ck : ck;
    float2 ga[34], gb[3];
    const int pm1 = pos2 > 0 ? pos2 - 1 : 0;
#pragma unroll
    for (int j = 0; j < 34; ++j) ga[j] = a2[(size_t)(j < pm1 ? j : pm1) * 256];
#pragma unroll
    for (int i = 0; i < 3; ++i) { const int ii = i < npre ? i : 0; gb[i] = a1[(size_t)(dir ? 3 - ii : ii) * 256]; }
    {
      const int tok = 16 * dir + (lane >> 2), c16 = (lane & 3) * 16;
      const u16* gp = p.rg + ((size_t)tokbase + T0 + tok) * 512 + 256 + nblk * 64 + c16;
      gq[0] = *(const uint4*)gp; gq[1] = *(const uint4*)(gp + 8);
    }
#pragma unroll
    for (int j = 0; j < 34; ++j) hin = (j < pos2) ? ga[j].x * hin + ga[j].y : hin;
#pragma unroll
    for (int i = 0; i < 3; ++i) hin = (i < npre) ? gb[i].x * hin + gb[i].y : hin;
  }
#pragma unroll
  for (int nt = 0; nt < 2; ++nt) csp[nt] = __logf(1.0f + __expf(-csp[nt]));
#pragma unroll
  for (int i = 0; i < 5; ++i) {
    const int idx = lane + 64 * i;
    const int row = idx >> 3, chunk = idx & 7;
    if (row < 35) *(uint4*)(xs + row * 64 + chunk * 8) = xt[i];
  }
  asm volatile("s_waitcnt lgkmcnt(0)" ::: "memory");
  {
    float x0 = bf2f(xs[0 * 64 + lane]), x1 = bf2f(xs[1 * 64 + lane]), x2 = bf2f(xs[2 * 64 + lane]);
#pragma unroll
    for (int t = 0; t < 32; ++t) {
      const float x3 = bf2f(xs[(t + 3) * 64 + lane]);
      const float xc = ccb + cw0 * x0 + cw1 * x1 + cw2 * x2 + cw3 * x3;
      xcf[t * 68 + lane] = xc;
      *(u16*)(xcb + swz128(t, lane >> 3) + (lane & 7) * 2) = f2bf(xc);
      x0 = x1; x1 = x2; x2 = x3;
    }
  }
  asm volatile("s_waitcnt lgkmcnt(0)" ::: "memory");
  float Av[2][16], Bv[2][16];
  {
    f32x16 acc[2][2];
#pragma unroll
    for (int gate = 0; gate < 2; ++gate)
#pragma unroll
      for (int nt = 0; nt < 2; ++nt) acc[gate][nt] = zero16();
#pragma unroll
    for (int s = 0; s < 4; ++s) {
      const bf16x8 af = *(const bf16x8*)(xcb + swz128(l31, 2 * s + hh));
#pragma unroll
      for (int gate = 0; gate < 2; ++gate)
#pragma unroll
        for (int nt = 0; nt < 2; ++nt) acc[gate][nt] = mfma32(af, wf[gate][nt][s], acc[gate][nt]);
    }
#pragma unroll
    for (int nt = 0; nt < 2; ++nt)
#pragma unroll
      for (int e = 0; e < 16; ++e) {
        const int tok = (e & 3) + 8 * (e >> 2) + 4 * hh;
        const float r = sigmoidf_(acc[0][nt][e] + cba[nt]);
        const float ii = sigmoidf_(acc[1][nt][e] + cbx[nt]);
        const float la = -8.0f * r * csp[nt];
        const float av = __expf(la);
        const float e2 = 2.0f * la;
        const float om = (e2 > -0.1f) ? (-e2 * (1.0f + e2 * (0.5f + e2 * (0.16666667f + e2 * 0.041666668f)))) : (1.0f - __expf(e2));
        Av[nt][e] = av;
        Bv[nt][e] = sqrtf(om) * ii * xcf[tok * 68 + nt * 32 + l31];
      }
  }
  float H[2][16];
#pragma unroll
  for (int nt = 0; nt < 2; ++nt)
#pragma unroll
    for (int e = 0; e < 16; ++e) H[nt][e] = 0.f;
  float carry[2] = {0.f, 0.f};
  if (mode == 0) {
    if (dir) rg_scan32<1>(Av, Bv, carry, H, hh); else rg_scan32<0>(Av, Bv, carry, H, hh);
    float P[2];
#pragma unroll
    for (int nt = 0; nt < 2; ++nt) {
      float pr = 1.f;
#pragma unroll
      for (int e = 0; e < 16; ++e) pr *= Av[nt][e];
      P[nt] = pr * shx(pr, 32);
    }
    const float2 mine = make_float2(hh ? P[1] : P[0], hh ? carry[1] : carry[0]);
    agg1[((size_t)(b * 2 + dir) * 136 + cg32) * 256 + nblk * 64 + lane] = mine;
    blockagg[(ck * 2 + dir) * 64 + lane] = mine;
    __syncthreads();
    if (wid < 2) {
      const int d2 = wid;
      float A = 1.f, B = 0.f;
#pragma unroll
      for (int co = 0; co < 4; ++co) {
        const int c = d2 ? 3 - co : co;
        const float2 g = blockagg[(c * 2 + d2) * 64 + lane];
        B = g.x * B + g.y;
        A *= g.x;
      }
      const int p2 = d2 ? (seg == 0 ? 1 - blk : 33 - blk) : (seg == 0 ? blk : 2 + blk);
      agg2[((size_t)(b * 2 + d2) * 34 + p2) * 256 + nblk * 64 + lane] = make_float2(A, B);
    }
    __syncthreads();
    return;
  }
  carry[0] = shf(hin, l31);
  carry[1] = shf(hin, 32 + l31);
  if (dir) rg_scan32<1>(Av, Bv, carry, H, hh); else rg_scan32<0>(Av, Bv, carry, H, hh);
  asm volatile("s_waitcnt lgkmcnt(0)" ::: "memory");
#pragma unroll
  for (int nt = 0; nt < 2; ++nt)
#pragma unroll
    for (int e = 0; e < 16; ++e) xcf[((e & 3) + 8 * (e >> 2) + 4 * hh) * 68 + nt * 32 + l31] = H[nt][e];
  __syncthreads();
  {
    const float* hfT = (const float*)(smem + (ck * 2 + 0) * 17408 + 8704);
    const float* hbT = (const float*)(smem + (ck * 2 + 1) * 17408 + 8704);
    const int tok = 16 * dir + (lane >> 2), c16 = (lane & 3) * 16;
    const size_t gtok = (size_t)tokbase + T0 + tok;
    u16* op = p.ycat + gtok * 1024 + 768 + nblk * 64 + c16;
#pragma unroll
    for (int hv = 0; hv < 2; ++hv) {
      const uint4 g = gq[hv];
      const float4 f0 = *(const float4*)(hfT + tok * 68 + c16 + hv * 8), f1 = *(const float4*)(hfT + tok * 68 + c16 + hv * 8 + 4);
      const float4 h0 = *(const float4*)(hbT + tok * 68 + c16 + hv * 8), h1 = *(const float4*)(hbT + tok * 68 + c16 + hv * 8 + 4);
      uint4 o;
      o.x = pk2((f0.x + h0.x) * gelu_tanh(bflo(g.x)), (f0.y + h0.y) * gelu_tanh(bfhi(g.x)));
      o.y = pk2((f0.z + h0.z) * gelu_tanh(bflo(g.y)), (f0.w + h0.w) * gelu_tanh(bfhi(g.y)));
      o.z = pk2((f1.x + h1.x) * gelu_tanh(bflo(g.z)), (f1.y + h1.y) * gelu_tanh(bfhi(g.z)));
      o.w = pk2((f1.z + h1.z) * gelu_tanh(bflo(g.w)), (f1.w + h1.w) * gelu_tanh(bfhi(g.w)));
      *(uint4*)(op + hv * 8) = o;
    }
  }
  __syncthreads();
}

__device__ __forceinline__ void attn_wave(const P& p, int l, int b, int h, bool local, int r, int half, int qtok0, const float* rpbL) {
  const int lane = opaque_tid() & 63, q = lane & 31, hh = lane >> 5;
  bf16x8 qf[4];
  {
    const u16* qp = p.qk + (size_t)(qtok0 + q) * 1024 + h * 64 + 8 * hh;
#pragma unroll
    for (int s = 0; s < 4; ++s) qf[s] = *(const bf16x8*)(qp + 16 * s);
  }
  f32x16 o0 = zero16(), o1 = zero16();
  float m_run = -1e30f, l_run = 0.f;
  const int pi = (q & 19) | ((q & 4) << 1) | ((q & 8) >> 1);
  const int w = half * 32 + q;
  const int st = min(max(w - 8, 0), 48);
  const int rs = min(max(r - 4, 0), 56);
  const int ntiles = local ? 24 : 8;
  bf16x8 kfn[4], vfn[2][2];
  auto tile_load = [&](int ti, bf16x8 (&kfo)[4], bf16x8 (&vfo)[2][2]) {
    int ktok0, vstride;
    const u16* vb;
    if (ti < 8) {
      ktok0 = NLAT + b * 256 + ti * 32;
      vb = p.vTc + ((size_t)(b * 512 + h * 64)) * 256 + ti * 32;
      vstride = 256;
    } else {
      const int tl = ti - 8;
      const int a2 = tl >> 1, g2 = tl & 1;
      ktok0 = b * 4096 + (rs + a2) * 64 + g2 * 32;
      vb = p.vT + ((size_t)(b * 512 + h * 64)) * 4096 + (rs + a2) * 64 + g2 * 32;
      vstride = 4096;
    }
    const u16* kp = p.qk + (size_t)(ktok0 + pi) * 1024 + 512 + h * 64 + 8 * hh;
#pragma unroll
    for (int s = 0; s < 4; ++s) kfo[s] = *(const bf16x8*)(kp + 16 * s);
#pragma unroll
    for (int dt = 0; dt < 2; ++dt)
#pragma unroll
      for (int s2 = 0; s2 < 2; ++s2) vfo[dt][s2] = *(const bf16x8*)(vb + (size_t)(dt * 32 + q) * vstride + 16 * s2 + 8 * hh);
  };
  tile_load(0, kfn, vfn);
  for (int ti = 0; ti < ntiles; ++ti) {
    int a = 0, g = 0;
    if (ti >= 8) { a = (ti - 8) >> 1; g = (ti - 8) & 1; }
    bf16x8 kf[4], vf[2][2];
#pragma unroll
    for (int s = 0; s < 4; ++s) kf[s] = kfn[s];
#pragma unroll
    for (int dt = 0; dt < 2; ++dt)
#pragma unroll
      for (int s2 = 0; s2 < 2; ++s2) vf[dt][s2] = vfn[dt][s2];
    if (ti + 1 < ntiles) tile_load(ti + 1, kfn, vfn);
    f32x16 sacc = zero16();
#pragma unroll
    for (int s = 0; s < 4; ++s) sacc = mfma32(kf[s], qf[s], sacc);
    float sv[16];
    float tmax = -1e30f;
#pragma unroll
    for (int e = 0; e < 16; ++e) {
      float x = sacc[e] * 0.125f;
      if (ti >= 8) {
        const int kc = g * 32 + (e & 7) + 8 * hh + 16 * (e >> 3);
        const bool valid = (kc >= st) && (kc < st + 16);
        const int bi = valid ? ((rs + a - r + 7) * 31 + (kc - w + 15)) : 0;
        const float bias = rpbL[bi];
        x = valid ? (x + bias) : -1e30f;
      }
      sv[e] = x;
      tmax = fmaxf(tmax, x);
    }
    tmax = fmaxf(tmax, shx(tmax, 32));
    const float m_new = fmaxf(m_run, tmax);
    const float alpha = __expf(m_run - m_new);
    m_run = m_new;
    l_run *= alpha;
#pragma unroll
    for (int e = 0; e < 16; ++e) { o0[e] *= alpha; o1[e] *= alpha; }
    float psum = 0.f;
#pragma unroll
    for (int e = 0; e < 16; ++e) { const float pe = __expf(sv[e] - m_new); sv[e] = pe; psum += pe; }
    l_run += psum;
    bf16x8 pf[2];
#pragma unroll
    for (int s2 = 0; s2 < 2; ++s2) {
      union { bf16x8 v; unsigned u[4]; } cv;
#pragma unroll
      for (int j = 0; j < 4; ++j) cv.u[j] = pk2(sv[8 * s2 + 2 * j], sv[8 * s2 + 2 * j + 1]);
      pf[s2] = cv.v;
    }
#pragma unroll
    for (int s2 = 0; s2 < 2; ++s2) {
      o0 = mfma32(vf[0][s2], pf[s2], o0);
      o1 = mfma32(vf[1][s2], pf[s2], o1);
    }
  }
  const float lt = l_run + shx(l_run, 32);
  const float inv = 1.0f / lt;
  u16* op = p.ycat + (size_t)(qtok0 + q) * 1024 + h * 64;
#pragma unroll
  for (int qd = 0; qd < 4; ++qd) {
    uint2 a0, a1;
    a0.x = pk2(o0[4 * qd] * inv, o0[4 * qd + 1] * inv);
    a0.y = pk2(o0[4 * qd + 2] * inv, o0[4 * qd + 3] * inv);
    a1.x = pk2(o1[4 * qd] * inv, o1[4 * qd + 1] * inv);
    a1.y = pk2(o1[4 * qd + 2] * inv, o1[4 * qd + 3] * inv);
    *(uint2*)(op + 8 * qd + 4 * hh) = a0;
    *(uint2*)(op + 32 + 8 * qd + 4 * hh) = a1;
  }
}
__device__ __forceinline__ void attn_block_task(const P& p, int l, int b, int h, int rg4, char* smem) {
  const int tid = opaque_tid(), lane = tid & 63, wid = tid >> 6;
  const int q = lane & 31, hh = lane >> 5;
  const int R0 = rg4 * 4;
  const int r = R0 + (wid >> 1), half = wid & 1;
  float* rpbL = (float*)(smem + 32768) + 64;
  for (int i = tid; i < 465; i += NTHR) rpbL[i] = p.na_rpb[(size_t)(l * 8 + h) * 465 + i] * 1.4426950408889634f;
  const int lo = min(max(R0 - 4, 0), 56);
  const int hi = min(max(R0 + 3 - 4, 0), 56) + 7;
  const int ntile = 4 + (hi - lo + 1);
  const int rs = min(max(r - 4, 0), 56);
  const int qtok = b * 4096 + r * 64 + half * 32 + q;
  bf16x8 qf[4];
  {
    const u16* qp = p.qk + (size_t)qtok * 1024 + h * 64 + 8 * hh;
#pragma unroll
    for (int s = 0; s < 4; ++s) qf[s] = *(const bf16x8*)(qp + 16 * s);
  }
  f32x16 o0 = zero16(), o1 = zero16();
  float m_run = -1e30f, l_run = 0.f;
  const int pi = (q & 19) | ((q & 4) << 1) | ((q & 8) >> 1);
  const int w = half * 32 + q;
  const int st = min(max(w - 8, 0), 48);
  unsigned vmask = 0u;
#pragma unroll
  for (int g = 0; g < 2; ++g)
#pragma unroll
    for (int e = 0; e < 16; ++e) {
      const int kc = g * 32 + (e & 7) + 8 * hh + 16 * (e >> 3);
      vmask |= ((kc >= st) && (kc < st + 16)) ? (1u << (g * 16 + e)) : 0u;
    }
  const int cbase = 8 * hh - w + 15;
  const int srow = tid >> 3, sch = tid & 7;
  uint4 rkA, rvA, rkB, rvB;
  auto gload = [&](int ti, uint4& rk, uint4& rv) {
    int ktok0, vstride;
    const u16* vb;
    if (ti < 4) { ktok0 = NLAT + b * 256 + ti * 64; vb = p.vTc + ((size_t)(b * 512 + h * 64)) * 256 + ti * 64; vstride = 256; }
    else { const int R = lo + ti - 4; ktok0 = b * 4096 + R * 64; vb = p.vT + ((size_t)(b * 512 + h * 64)) * 4096 + R * 64; vstride = 4096; }
    rk = *(const uint4*)(p.qk + (size_t)(ktok0 + srow) * 1024 + 512 + h * 64 + sch * 8);
    rv = *(const uint4*)(vb + (size_t)srow * vstride + sch * 8);
  };
  gload(0, rkA, rvA);
  *(uint4*)(smem + swz128(srow, sch)) = rkA;
  *(uint4*)(smem + 16384 + swz128(srow, sch)) = rvA;
  gload(1, rkA, rvA);
  if (2 < ntile) gload(2, rkB, rvB);
  __syncthreads();
  auto compute = [&](int ti) {
    const char* Kb = smem + (ti & 1) * 8192;
    const char* Vb = smem + 16384 + (ti & 1) * 8192;
    const int R = lo + ti - 4;
    const bool active = (ti < 4) || (R >= rs && R < rs + 8);
    if (active) {
      f32x16 sacc0 = zero16(), sacc1 = zero16();
#pragma unroll
      for (int s = 0; s < 4; ++s) {
        const bf16x8 kf0 = *(const bf16x8*)(Kb + swz128(pi, 2 * s + hh));
        const bf16x8 kf1 = *(const bf16x8*)(Kb + swz128(32 + pi, 2 * s + hh));
        sacc0 = mfma32(kf0, qf[s], sacc0);
        sacc1 = mfma32(kf1, qf[s], sacc1);
      }
      float sv[32];
      float tmax = -1e30f;
      if (ti >= 4) {
        const float* brow = rpbL + (R - r + 7) * 31 + cbase;
        float bias[32];
#pragma unroll
        for (int g = 0; g < 2; ++g)
#pragma unroll
          for (int e = 0; e < 16; ++e) bias[g * 16 + e] = brow[g * 32 + (e & 7) + 16 * (e >> 3)];
#pragma unroll
        for (int g = 0; g < 2; ++g)
#pragma unroll
          for (int e = 0; e < 16; ++e) {
            const float sc = g ? sacc1[e] : sacc0[e];
            const float x = ((int)(vmask << (31 - (g * 16 + e))) < 0) ? fmaf(sc, 0.18033688011112042f, bias[g * 16 + e]) : -1e30f;
            sv[g * 16 + e] = x;
            tmax = fmaxf(tmax, x);
          }
      } else {
#pragma unroll
        for (int g = 0; g < 2; ++g)
#pragma unroll
          for (int e = 0; e < 16; ++e) {
            const float x = (g ? sacc1[e] : sacc0[e]) * 0.18033688011112042f;
            sv[g * 16 + e] = x;
            tmax = fmaxf(tmax, x);
          }
      }
      tmax = fmaxf(tmax, shx(tmax, 32));
      if (__builtin_amdgcn_ballot_w64(tmax > m_run) != 0ull) {
        const float m_new = fmaxf(m_run, tmax);
        const float alpha = __builtin_amdgcn_exp2f(m_run - m_new);
        m_run = m_new;
        l_run *= alpha;
#pragma unroll
        for (int e = 0; e < 16; ++e) { o0[e] *= alpha; o1[e] *= alpha; }
      }
      float psum = 0.f;
#pragma unroll
      for (int e = 0; e < 32; ++e) { const float pe = __builtin_amdgcn_exp2f(sv[e] - m_run); sv[e] = pe; psum += pe; }
      l_run += psum;
#pragma unroll
      for (int g = 0; g < 2; ++g)
#pragma unroll
        for (int s2 = 0; s2 < 2; ++s2) {
          union { bf16x8 v; unsigned u[4]; } cv;
#pragma unroll
          for (int j = 0; j < 4; ++j) cv.u[j] = pk2(sv[g * 16 + 8 * s2 + 2 * j], sv[g * 16 + 8 * s2 + 2 * j + 1]);
          const bf16x8 v0 = *(const bf16x8*)(Vb + swz128(q, g * 4 + 2 * s2 + hh));
          const bf16x8 v1 = *(const bf16x8*)(Vb + swz128(32 + q, g * 4 + 2 * s2 + hh));
          o0 = mfma32(v0, cv.v, o0);
          o1 = mfma32(v1, cv.v, o1);
        }
    }
  };
  for (int ti = 0; ti < ntile; ti += 2) {
    compute(ti);
    if (ti + 1 < ntile) {
      *(uint4*)(smem + 8192 + swz128(srow, sch)) = rkA;
      *(uint4*)(smem + 16384 + 8192 + swz128(srow, sch)) = rvA;
      if (ti + 3 < ntile) gload(ti + 3, rkA, rvA);
    }
    __syncthreads();
    if (ti + 1 < ntile) {
      compute(ti + 1);
      if (ti + 2 < ntile) {
        *(uint4*)(smem + swz128(srow, sch)) = rkB;
        *(uint4*)(smem + 16384 + swz128(srow, sch)) = rvB;
        if (ti + 4 < ntile) gload(ti + 4, rkB, rvB);
      }
      __syncthreads();
    }
  }
  const float lt = l_run + shx(l_run, 32);
  const float inv = 1.0f / lt;
  __syncthreads();
  {
    char* ot = smem + wid * 4608;
#pragma unroll
    for (int qd = 0; qd < 4; ++qd) {
      uint2 a0, a1;
      a0.x = pk2(o0[4 * qd] * inv, o0[4 * qd + 1] * inv);
      a0.y = pk2(o0[4 * qd + 2] * inv, o0[4 * qd + 3] * inv);
      a1.x = pk2(o1[4 * qd] * inv, o1[4 * qd + 1] * inv);
      a1.y = pk2(o1[4 * qd + 2] * inv, o1[4 * qd + 3] * inv);
      *(uint2*)(ot + q * 144 + (8 * qd + 4 * hh) * 2) = a0;
      *(uint2*)(ot + q * 144 + (32 + 8 * qd + 4 * hh) * 2) = a1;
    }
    asm volatile("s_waitcnt lgkmcnt(0)" ::: "memory");
    const int tok0 = b * 4096 + r * 64 + half * 32;
#pragma unroll
    for (int it = 0; it < 4; ++it) {
      const int qq = it * 8 + (lane >> 3), ch = lane & 7;
      const uint4 v = *(const uint4*)(ot + qq * 144 + ch * 16);
      *(uint4*)(p.ycat + (size_t)(tok0 + qq) * 1024 + h * 64 + ch * 8) = v;
    }
  }
  __syncthreads();
}
__device__ __forceinline__ void attn_task(const P& p, int l, int kind, int idx, char* smem) {
  const int tid_ = opaque_tid(); const int lane = tid_ & 63, wid = tid_ >> 6;
  float* rpbL = (float*)smem + wid * 480;
  for (int i = lane; i < 465; i += 64) rpbL[i] = p.na_rpb[(size_t)(l * 8 + wid) * 465 + i];
  __syncthreads();
  if (kind == 0) {
    const int half = idx & 1, r = (idx >> 1) & 63, b = idx >> 7;
    attn_wave(p, l, b, wid, true, r, half, b * 4096 + r * 64 + half * 32, rpbL);
  } else {
    const int qg = idx & 7, b = idx >> 3;
    attn_wave(p, l, b, wid, false, 0, 0, NLAT + b * 256 + qg * 32, rpbL);
  }
  __syncthreads();
}

__device__ __forceinline__ void phase_mixers(const P& p, int l, char* smem, unsigned* counter) {
  const bool last = (l == 1);
  const int n_rg = 1088 * XRGA, n_fft = 1024 * XFFT, n_hc = last ? 0 : 256, n_att = 1024 * XATT, n_attc = last ? 0 : 64;
  const int total = n_rg + n_fft + n_hc + n_att + n_attc;
  volatile int* s_taskp = (volatile int*)(smem + SMEM_BYTES - 16);
  for (;;) {
    __syncthreads();
    if (threadIdx.x == 0) *s_taskp = (int)atomicAdd(counter, 1u);
    __syncthreads();
    int t = *s_taskp;
    if (t >= total) break;
    if (t < n_att) { t &= 1023; attn_block_task(p, l, t >> 7, (t >> 4) & 7, t & 15, smem); continue; }
    t -= n_att;
    if (t < n_attc) { attn_task(p, l, 1, t, smem); continue; }
    t -= n_attc;
    if (t < n_fft) { t &= 1023; hyena_fft_task(p, l, t >> 2, t & 3, smem); continue; }
    t -= n_fft;
    if (t < n_hc) { hyena_ctx_task(p, l, t >> 5, t & 31, smem); continue; }
    t -= n_hc;
    if (t >= 1088) t -= 1088;
    rg_wave_task(p, l, t >> 2, t & 3, 0, last, smem);
  }
}

__device__ __forceinline__ void merge_tile(const P& p, int l, int mt, int nt, char* smem) {
  EPI_VARS
  const int m0 = mt * 256, n0 = nt * 128;
  f32x16 macc[2][2];
  zero_acc(macc);
  for (int br = 0; br < 3; ++br) {
    unsigned* gpl = (unsigned*)(smem + 98304) + tid;
    {
      f32x16 acc[2][2];
      zero_acc(acc);
      gemm_kloop(acc, p.xn + (size_t)m0 * 1024, 1024, p.WgT + ((size_t)l * 3072 + br * 1024 + n0) * 1024, 1024, 1024, smem);
#pragma unroll
      for (int j = 0; j < 2; ++j) {
        const float bg = p.b_gate[l * 3072 + br * 1024 + n0 + EPI_COL(j)];
#pragma unroll
        for (int i = 0; i < 2; ++i)
#pragma unroll
          for (int e = 0; e < 4; ++e) {
            const unsigned q0 = (unsigned)(sigmoidf_(acc[i][j][4 * e] + bg) * 255.0f + 0.5f);
            const unsigned q1 = (unsigned)(sigmoidf_(acc[i][j][4 * e + 1] + bg) * 255.0f + 0.5f);
            const unsigned q2 = (unsigned)(sigmoidf_(acc[i][j][4 * e + 2] + bg) * 255.0f + 0.5f);
            const unsigned q3 = (unsigned)(sigmoidf_(acc[i][j][4 * e + 3] + bg) * 255.0f + 0.5f);
            gpl[((i * 2 + j) * 4 + e) * 512] = q0 | (q1 << 8) | (q2 << 16) | (q3 << 24);
          }
      }
    }
    {
      f32x16 acc[2][2];
      zero_acc(acc);
      const u16* A; const u16* B; int K;
      if (br == 0) { A = p.ycat + (size_t)m0 * 1024; B = p.WaT + ((size_t)l * 1024 + n0) * 512; K = 512; }
      else if (br == 1) { A = p.ycat + (size_t)m0 * 1024 + 512; B = p.WbT + ((size_t)l * 1024 + n0) * 256; K = 256; }
      else { A = p.ycat + (size_t)m0 * 1024 + 768; B = p.WcT + ((size_t)l * 1024 + n0) * 256; K = 256; }
      gemm_kloop(acc, A, 1024, B, K, K, smem);
#pragma unroll
      for (int i = 0; i < 2; ++i)
#pragma unroll
        for (int j = 0; j < 2; ++j)
#pragma unroll
          for (int e = 0; e < 4; ++e) {
            const unsigned g4 = gpl[((i * 2 + j) * 4 + e) * 512];
            macc[i][j][4 * e] += (float)(g4 & 255u) * (1.0f / 255.0f) * acc[i][j][4 * e];
            macc[i][j][4 * e + 1] += (float)((g4 >> 8) & 255u) * (1.0f / 255.0f) * acc[i][j][4 * e + 1];
            macc[i][j][4 * e + 2] += (float)((g4 >> 16) & 255u) * (1.0f / 255.0f) * acc[i][j][4 * e + 2];
            macc[i][j][4 * e + 3] += (float)(g4 >> 24) * (1.0f / 255.0f) * acc[i][j][4 * e + 3];
          }
    }
  }
#pragma unroll
  for (int i = 0; i < 2; ++i)
#pragma unroll
    for (int j = 0; j < 2; ++j)
#pragma unroll
      for (int e = 0; e < 16; ++e)
        p.mbuf[(size_t)(m0 + EPI_ROW(i, e)) * 1024 + n0 + EPI_COL(j)] = f2bf(macc[i][j][e]);
}
__device__ __forceinline__ void outproj_tile(const P& p, int l, int mt, int nt, char* smem, bool do_store) {
  EPI_VARS
  const int m0 = mt * 256, n0 = nt * 128;
  f32x16 acc[2][2];
  zero_acc(acc);
  gemm_kloop(acc, p.mbuf + (size_t)m0 * 1024, 1024, p.WoT + ((size_t)l * 1024 + n0) * 1024, 1024, 1024, smem);
  const bool isctx = (mt >= 128);
  const int bi = isctx ? 8 : (mt >> 4);
  const float* gatev = p.mod + ((size_t)(l * 9 + bi) * 6 + 2) * 1024;
  const float* src; float* dst;
  if (isctx) { src = (l == 0 ? p.ctx : p.ctxs) - (size_t)NLAT * 1024; dst = p.ctxs - (size_t)NLAT * 1024; }
  else { src = (l == 0 ? p.x : p.out); dst = p.out; }
#pragma unroll
  for (int j = 0; j < 2; ++j) {
    const int col = n0 + EPI_COL(j);
    const float gv = gatev[col];
#pragma unroll
    for (int i = 0; i < 2; ++i)
#pragma unroll
      for (int e = 0; e < 16; ++e) {
        const size_t o = (size_t)(m0 + EPI_ROW(i, e)) * 1024 + col;
        if (do_store) dst[o] = src[o] + gv * acc[i][j][e];
      }
  }
}

__device__ __forceinline__ void wqk_task(const P& p, int l, int hp, int nt, char* smem) {
  EPI_VARS
  f32x16 acc[2][2];
  zero_acc(acc);
  gemm_kloop(acc, p.keysB + ((size_t)l * 16 + hp) * 16384, 128, p.WqB + (size_t)l * 1024 * 2048 + (size_t)(nt * 128) * 2048 + hp * 128, 2048, 128, smem);
  if (wm < 2) {
#pragma unroll
    for (int i = 0; i < 2; ++i)
#pragma unroll
      for (int j = 0; j < 2; ++j)
#pragma unroll
        for (int e = 0; e < 16; ++e)
          p.WqkT[((size_t)l * 2048 + hp * 128 + EPI_ROW(i, e)) * 1024 + nt * 128 + EPI_COL(j)] = f2bf(acc[i][j][e]);
  }
}
__device__ __forceinline__ void ins16(unsigned (&L)[16], unsigned x) {
#pragma unroll
  for (int i = 0; i < 16; ++i) {
    const unsigned hi = max(L[i], x);
    x = min(L[i], x);
    L[i] = hi;
  }
}
__device__ __forceinline__ unsigned f2sort(float f) {
  const unsigned b = __float_as_uint(f);
  return b ^ ((unsigned)((int)b >> 31) | 0x80000000u);
}
__device__ __forceinline__ float sort2f(unsigned k) {
  const unsigned u = k & ~127u;
  const unsigned b = (u & 0x80000000u) ? (u ^ 0x80000000u) : ~u;
  return __uint_as_float(b);
}
__device__ __forceinline__ void cx_desc(unsigned& a, unsigned& b) { const unsigned hi = max(a, b), lo = min(a, b); a = hi; b = lo; }
template <int BASE> __device__ __forceinline__ void sort16_desc(unsigned (&k)[64]) {
#pragma unroll
  for (int sz = 2; sz <= 16; sz <<= 1) {
#pragma unroll
    for (int j = sz >> 1; j >= 1; j >>= 1) {
#pragma unroll
      for (int i = 0; i < 16; ++i) {
        const int l2 = i ^ j;
        if (l2 > i) {
          if ((i & sz) == 0) cx_desc(k[BASE + i], k[BASE + l2]);
          else cx_desc(k[BASE + l2], k[BASE + i]);
        }
      }
    }
  }
}
template <int AB, int BB> __device__ __forceinline__ void merge16_desc(unsigned (&k)[64]) {
#pragma unroll
  for (int i = 0; i < 16; ++i) k[AB + i] = max(k[AB + i], k[BB + 15 - i]);
#pragma unroll
  for (int j = 8; j >= 1; j >>= 1) {
#pragma unroll
    for (int i = 0; i < 16; ++i)
      if ((i & j) == 0) cx_desc(k[AB + i], k[AB + i + j]);
  }
}
#define PS_LOAD(mt_, hp_) do { _Pragma("unroll") for (int it = 0; it < 8; ++it) { const int id = tid + NTHR * it; \
    pre[it] = *(const uint4*)(p.q + (size_t)((mt_) * 256 + (id >> 4)) * 2048 + (hp_) * 128 + (id & 15) * 8); } } while (0)
__device__ __forceinline__ void peer_score_tile(const P& p, int l, int mt, int hp, char* smem, uint4& p0, uint4& p1, uint4& p2, uint4& p3, uint4& p4, uint4& p5, uint4& p6, uint4& p7, int nmt, int nhp) {
  const int tid = opaque_tid();
  const int m0 = mt * 256;
  const int row = tid >> 1, hf = tid & 1;
  {
    char* T = smem + 16384;
    uint4 pre[8] = {p0, p1, p2, p3, p4, p5, p6, p7};
#pragma unroll
    for (int it = 0; it < 8; ++it) {
      const int id = tid + NTHR * it;
      const int r = id >> 4, ch = id & 15;
      *(uint4*)(T + r * 272 + ch * 16) = pre[it];
    }
    PS_LOAD(nmt, nhp);
    p0 = pre[0]; p1 = pre[1]; p2 = pre[2]; p3 = pre[3]; p4 = pre[4]; p5 = pre[5]; p6 = pre[6]; p7 = pre[7];
  }
  __syncthreads();
  const char* sp = smem + 16384 + row * 272 + hf * 128;
  unsigned k[64];
#pragma unroll
  for (int c = 0; c < 8; ++c) {
    const uint4 r = *(const uint4*)(sp + 16 * c);
    const unsigned w[4] = {r.x, r.y, r.z, r.w};
#pragma unroll
    for (int q = 0; q < 4; ++q) {
      const float v0 = __builtin_bit_cast(_Float16, (unsigned short)(w[q] & 0xffffu));
      const float v1 = __builtin_bit_cast(_Float16, (unsigned short)(w[q] >> 16));
      const int key = hf * 64 + c * 8 + q * 2;
      k[c * 8 + q * 2] = (f2sort(v0) & ~127u) | (unsigned)key;
      k[c * 8 + q * 2 + 1] = (f2sort(v1) & ~127u) | (unsigned)(key + 1);
    }
  }
  sort16_desc<0>(k); sort16_desc<16>(k); sort16_desc<32>(k); sort16_desc<48>(k);
  merge16_desc<0, 16>(k);
  merge16_desc<32, 48>(k);
  merge16_desc<0, 32>(k);
  unsigned* X = (unsigned*)smem;
  if (hf) {
#pragma unroll
    for (int i = 0; i < 16; ++i) X[row * 16 + i] = k[i];
  }
  __syncthreads();
  if (!hf) {
#pragma unroll
    for (int i = 0; i < 16; ++i) k[16 + i] = X[row * 16 + i];
    merge16_desc<0, 16>(k);
    unsigned* o = p.topk + ((size_t)(m0 + row) * 16 + hp) * 16;
#pragma unroll
    for (int i = 0; i < 4; ++i) *(uint4*)(o + 4 * i) = make_uint4(k[4 * i], k[4 * i + 1], k[4 * i + 2], k[4 * i + 3]);
  }
  __syncthreads();
}

__device__ __forceinline__ void phase_peer_experts(const P& p, int l, bool do_store, char* smem) {
  const int tid_ = opaque_tid(); const int lane = tid_ & 63, wid = tid_ >> 6;
  const int ntok = (l == 1) ? NLAT : NTOK;
  int ci, cj;
  {
    const int e = lane;
    if (e < 16) { ci = 0; cj = e; }
    else if (e < 24) { ci = 1; cj = e - 16; }
    else if (e < 29) { ci = 2; cj = e - 24; }
    else if (e < 33) { ci = 3; cj = e - 29; }
    else if (e < 36) { ci = 4; cj = e - 33; }
    else if (e < 38) { ci = 5; cj = e - 36; }
    else if (e < 40) { ci = 6; cj = e - 38; }
    else if (e < 42) { ci = 7; cj = e - 40; }
    else { ci = min(8 + (e - 42), 15); cj = 0; }
  }
  for (int tok = blockIdx.x * 8 + wid; tok < ntok; tok += gridDim.x * 8) {
    float xr[16];
    {
      const uint4 a = *(const uint4*)(p.xn8 + (size_t)tok * 1024 + lane * 16);
      const float sx = p.sa[tok];
      const unsigned aw[4] = {a.x, a.y, a.z, a.w};
#pragma unroll
      for (int i = 0; i < 4; ++i) {
        xr[4 * i] = (float)((int)(aw[i] << 24) >> 24) * sx; xr[4 * i + 1] = (float)((int)(aw[i] << 16) >> 24) * sx;
        xr[4 * i + 2] = (float)((int)(aw[i] << 8) >> 24) * sx; xr[4 * i + 3] = (float)((int)aw[i] >> 24) * sx;
      }
    }
    typedef _Float16 h2_t __attribute__((ext_vector_type(2)));
    h2_t yh[8];
#pragma unroll
    for (int i = 0; i < 8; ++i) yh[i] = (h2_t){(_Float16)0, (_Float16)0};
    int* selw = (int*)(smem + wid * 4096);
    const unsigned* kvp = p.topk + (size_t)tok * 256 + (lane & 31);
#pragma unroll 1
    for (int hb = 0; hb < 8; hb += 4) {
      unsigned key[4]; int eidx[4];
#pragma unroll
      for (int u = 0; u < 4; ++u) {
        const unsigned kv = kvp[(hb + u) * 32];
        const unsigned k0 = shu(kv, ci);
        const unsigned k1 = shu(kv, 16 + cj);
        const float val = (lane < 50) ? (sort2f(k0) + sort2f(k1)) : -3.0e38f;
        eidx[u] = (int)((k0 & 127u) * 128u + (k1 & 127u));
        key[u] = (f2sort(val) & ~63u) | (unsigned)lane;
      }
#pragma unroll
      for (int k = 2; k <= 64; k <<= 1) {
#pragma unroll
        for (int j = k >> 1; j >= 1; j >>= 1) {
          const bool take_max = (((lane & j) == 0) == ((lane & k) == 0));
#pragma unroll
          for (int u = 0; u < 4; ++u) {
            unsigned ok;
            if (j == 1) ok = xorl<1>(key[u], lane); else if (j == 2) ok = xorl<2>(key[u], lane); else if (j == 4) ok = xorl<4>(key[u], lane);
            else if (j == 8) ok = xorl<8>(key[u], lane); else if (j == 16) ok = xorl<16>(key[u], lane); else ok = xorl<32>(key[u], lane);
            key[u] = take_max ? max(key[u], ok) : min(key[u], ok);
          }
        }
      }
#pragma unroll
      for (int u = 0; u < 4; ++u) {
        const int si = __builtin_amdgcn_ds_bpermute((int)(key[u] & 63u) << 2, eidx[u]);
        const unsigned ku = key[u] & ~63u;
        const float sv = __uint_as_float((ku & 0x80000000u) ? (ku ^ 0x80000000u) : ~ku);
        const float mx = __builtin_bit_cast(float, __builtin_amdgcn_readlane(__builtin_bit_cast(int, sv), 0));
        const float ex = (lane < 16) ? __builtin_amdgcn_exp2f((sv - mx) * 1.4426950408889634f) : 0.f;
        const float sm = wave_sum(ex);
        selw[(hb + u) * 64 + lane] = si;
        selw[512 + (hb + u) * 64 + lane] = __builtin_bit_cast(int, ex * __builtin_amdgcn_rcpf(sm));
      }
    }
    {
      int w[4];
#pragma unroll
      for (int i = 0; i < 4; ++i) {
        int t = __builtin_amdgcn_cvt_pk_fp8_f32(xr[4 * i], xr[4 * i + 1], 0, false);
        w[i] = __builtin_amdgcn_cvt_pk_fp8_f32(xr[4 * i + 2], xr[4 * i + 3], t, true);
      }
      *(uint4*)(smem + 32768 + wid * 1024 + lane * 16) = make_uint4((unsigned)w[0], (unsigned)w[1], (unsigned)w[2], (unsigned)w[3]);
    }
    asm volatile("s_waitcnt lgkmcnt(0)" ::: "memory");
    const int e15 = lane & 15, g4 = lane >> 4;
#pragma unroll 1
    for (int h = 0; h < 8; ++h) {
      const int eperm_h = selw[h * 64 + lane];
      const int gperm_h = selw[512 + h * 64 + lane];
      const int ide = (int)shu((unsigned)eperm_h, e15);
      const unsigned char* ub = p.Ub + (size_t)ide * 1024 + g4 * 16;
      uint4 ua[8];
#pragma unroll
      for (int sI = 0; sI < 8; ++sI) ua[sI] = *(const uint4*)(ub + sI * 64);
      pg8::f32x4 hacc = {0.f, 0.f, 0.f, 0.f};
#pragma unroll
      for (int sI = 0; sI < 8; ++sI) {
        const uint4 b0 = *(const uint4*)(smem + 32768 + wid * 1024 + sI * 128 + g4 * 16);
        const uint4 b1 = *(const uint4*)(smem + 32768 + wid * 1024 + sI * 128 + 64 + g4 * 16);
        const i32x8 A = {(int)ua[sI].x, (int)ua[sI].y, (int)ua[sI].z, (int)ua[sI].w, 0, 0, 0, 0};
        const i32x8 B = {(int)b0.x, (int)b0.y, (int)b0.z, (int)b0.w, (int)b1.x, (int)b1.y, (int)b1.z, (int)b1.w};
        hacc = __builtin_amdgcn_mfma_scale_f32_16x16x128_f8f6f4(A, B, hacc, 4  , 0  , 0, 0x7f7f7f7f, 0, 0x7f7f7f7f);
      }
      asm volatile("" ::: "memory");
      uint2 V[16];
#pragma unroll
      for (int k = 0; k < 16; ++k) {
        const int id = __builtin_amdgcn_readlane(eperm_h, k);
        V[k] = *(const uint2*)(p.Ub + (size_t)id * 1024 + 512 + lane * 8);
      }
      float actv[4];
#pragma unroll
      for (int r4 = 0; r4 < 4; ++r4) {
        const float gl = __builtin_bit_cast(float, shu((unsigned)gperm_h, 4 * g4 + r4));
        actv[r4] = gelu_tanh(hacc[r4] * (1.0f / 64.0f)) * gl;
      }
#pragma unroll
      for (int k = 0; k < 16; ++k) {
        const float ak = __builtin_bit_cast(float, __builtin_amdgcn_readlane(__builtin_bit_cast(int, actv[k & 3]), 16 * (k >> 2)));
        const h2_t akh = {(_Float16)ak, (_Float16)ak};
        const unsigned vw[2] = {V[k].x, V[k].y};
#pragma unroll
        for (int q2 = 0; q2 < 2; ++q2) {
          yh[4 * q2 + 0] = __builtin_elementwise_fma(akh, __builtin_bit_cast(h2_t, __builtin_amdgcn_cvt_scalef32_pk_f16_fp4(vw[q2], 1.0f, 0)), yh[4 * q2 + 0]);
          yh[4 * q2 + 1] = __builtin_elementwise_fma(akh, __builtin_bit_cast(h2_t, __builtin_amdgcn_cvt_scalef32_pk_f16_fp4(vw[q2], 1.0f, 1)), yh[4 * q2 + 1]);
          yh[4 * q2 + 2] = __builtin_elementwise_fma(akh, __builtin_bit_cast(h2_t, __builtin_amdgcn_cvt_scalef32_pk_f16_fp4(vw[q2], 1.0f, 2)), yh[4 * q2 + 2]);
          yh[4 * q2 + 3] = __builtin_elementwise_fma(akh, __builtin_bit_cast(h2_t, __builtin_amdgcn_cvt_scalef32_pk_f16_fp4(vw[q2], 1.0f, 3)), yh[4 * q2 + 3]);
        }
      }
    }
    float yacc[16];
#pragma unroll
    for (int i = 0; i < 8; ++i) { yacc[2 * i] = (float)yh[i].x; yacc[2 * i + 1] = (float)yh[i].y; }
    const int bi = tok < NLAT ? (tok >> 12) : 8;
    const float* gv = p.mod + ((size_t)(l * 9 + bi) * 6 + 5) * 1024 + lane * 16;
    u16* rp = p.res + (size_t)tok * 1024 + lane * 16;
    float4 xv[4];
    float ss = 0.f;
    {
      const uint4 r0 = *(const uint4*)rp, r1 = *(const uint4*)(rp + 8);
      xv[0] = make_float4(bflo(r0.x), bfhi(r0.x), bflo(r0.y), bfhi(r0.y)); xv[1] = make_float4(bflo(r0.z), bfhi(r0.z), bflo(r0.w), bfhi(r0.w));
      xv[2] = make_float4(bflo(r1.x), bfhi(r1.x), bflo(r1.y), bfhi(r1.y)); xv[3] = make_float4(bflo(r1.z), bfhi(r1.z), bflo(r1.w), bfhi(r1.w));
    }
#pragma unroll
    for (int i = 0; i < 4; ++i) {
      const float4 g4 = *(const float4*)(gv + 4 * i);
      xv[i].x += g4.x * yacc[4 * i] * 0.25f; xv[i].y += g4.y * yacc[4 * i + 1] * 0.25f; xv[i].z += g4.z * yacc[4 * i + 2] * 0.25f; xv[i].w += g4.w * yacc[4 * i + 3] * 0.25f;
      ss += xv[i].x * xv[i].x + xv[i].y * xv[i].y + xv[i].z * xv[i].z + xv[i].w * xv[i].w;
    }
    ss = wave_sum(ss);
    const float rstd = rsqrtf(ss * (1.0f / 1024.0f) + 1e-6f);
    if (l == 0) {
      const float* gam = p.norm_mix_g + 1024 + lane * 16;
      const float* msh = p.mod + ((size_t)(9 + bi) * 6 + 0) * 1024 + lane * 16;
      const float* msc = msh + 1024;
      float yv[16];
      float amax = 0.f;
#pragma unroll
      for (int i = 0; i < 4; ++i) {
        const float4 g = *(const float4*)(gam + 4 * i);
        const float4 sh = *(const float4*)(msh + 4 * i);
        const float4 sc = *(const float4*)(msc + 4 * i);
        yv[4 * i] = xv[i].x * rstd * g.x * (1.f + sc.x) + sh.x; yv[4 * i + 1] = xv[i].y * rstd * g.y * (1.f + sc.y) + sh.y;
        yv[4 * i + 2] = xv[i].z * rstd * g.z * (1.f + sc.z) + sh.z; yv[4 * i + 3] = xv[i].w * rstd * g.w * (1.f + sc.w) + sh.w;
      }
#pragma unroll
      for (int i = 0; i < 16; ++i) amax = fmaxf(amax, fabsf(yv[i]));
      amax = fmaxf(wave_max(amax), 1e-20f);
      const float inv = 127.0f / amax;
      unsigned w[4];
#pragma unroll
      for (int i = 0; i < 4; ++i)
        w[i] = ((unsigned)__float2int_rn(yv[4 * i] * inv) & 255u) | (((unsigned)__float2int_rn(yv[4 * i + 1] * inv) & 255u) << 8) |
               (((unsigned)__float2int_rn(yv[4 * i + 2] * inv) & 255u) << 16) | (((unsigned)__float2int_rn(yv[4 * i + 3] * inv) & 255u) << 24);
      if (do_store) {
        *(uint4*)rp = make_uint4(pk2(xv[0].x, xv[0].y), pk2(xv[0].z, xv[0].w), pk2(xv[1].x, xv[1].y), pk2(xv[1].z, xv[1].w));
        *(uint4*)(rp + 8) = make_uint4(pk2(xv[2].x, xv[2].y), pk2(xv[2].z, xv[2].w), pk2(xv[3].x, xv[3].y), pk2(xv[3].z, xv[3].w));
        *(uint4*)(p.xn8 + (size_t)tok * 1024 + lane * 16) = make_uint4(w[0], w[1], w[2], w[3]);
        if (lane == 0) p.sa[tok] = amax * (1.0f / 127.0f);
      }
    } else {
      const float* fg = p.final_g + lane * 16;
      float4 gf[4];
#pragma unroll
      for (int i = 0; i < 4; ++i) gf[i] = *(const float4*)(fg + 4 * i);
#pragma unroll
      for (int i = 0; i < 4; ++i) {
        const float4 g = gf[i];
        const float4 o = make_float4(xv[i].x * rstd * g.x, xv[i].y * rstd * g.y, xv[i].z * rstd * g.z, xv[i].w * rstd * g.w);
        if (do_store) *(float4*)(p.out + (size_t)tok * 1024 + lane * 16 + 4 * i) = o;
      }
    }
  }
}


__device__ __forceinline__ void wqk_quant(const P& p) {
  const int tid_ = opaque_tid(); const int lane = tid_ & 63, wid = tid_ >> 6;
  for (int row = blockIdx.x * 8 + wid; row < 2 * 2048; row += gridDim.x * 8) {
    u16* rp = p.WqkT + (size_t)row * 1024;
    const uint4 a = *(const uint4*)(rp + lane * 16), b = *(const uint4*)(rp + lane * 16 + 8);
    float v[16];
    v[0] = bflo(a.x); v[1] = bfhi(a.x); v[2] = bflo(a.y); v[3] = bfhi(a.y); v[4] = bflo(a.z); v[5] = bfhi(a.z); v[6] = bflo(a.w); v[7] = bfhi(a.w);
    v[8] = bflo(b.x); v[9] = bfhi(b.x); v[10] = bflo(b.y); v[11] = bfhi(b.y); v[12] = bflo(b.z); v[13] = bfhi(b.z); v[14] = bflo(b.w); v[15] = bfhi(b.w);
    float amax = 0.f;
#pragma unroll
    for (int i = 0; i < 16; ++i) amax = fmaxf(amax, fabsf(v[i]));
    amax = fmaxf(wave_max(amax), 1e-20f);
    const float inv = 127.0f / amax;
    unsigned w[4];
#pragma unroll
    for (int i = 0; i < 4; ++i)
      w[i] = ((unsigned)__float2int_rn(v[4 * i] * inv) & 255u) | (((unsigned)__float2int_rn(v[4 * i + 1] * inv) & 255u) << 8) |
             (((unsigned)__float2int_rn(v[4 * i + 2] * inv) & 255u) << 16) | (((unsigned)__float2int_rn(v[4 * i + 3] * inv) & 255u) << 24);
    *(uint4*)((unsigned char*)rp + lane * 16) = make_uint4(w[0], w[1], w[2], w[3]);
    if (lane == 0) p.swq[row] = amax * (1.0f / 127.0f);
  }
}

#define XB_TMO      128
#define XB_XCNT(j)  (256  + 64 * (j))
#define XB_XSUB(j)  (1280 + 64 * (j))
#define XB_XGEN(j)  (2304 + 64 * (j))
#define XB_TOP      3328
#define XB_TOPGEN   3392
#define XCD_BAR_WORDS 3456
#define XB_SPIN_CAP (1u << 22)
#define LAS __attribute__((address_space(3)))
__device__ __forceinline__ unsigned xb_ld(unsigned* p) { return __hip_atomic_load(p, __ATOMIC_RELAXED, __HIP_MEMORY_SCOPE_AGENT); }
__device__ __forceinline__ unsigned xb_add(unsigned* p, unsigned v) { return __hip_atomic_fetch_add(p, v, __ATOMIC_RELAXED, __HIP_MEMORY_SCOPE_AGENT); }
__device__ __forceinline__ unsigned xb_xcc_id() { return (unsigned)__builtin_amdgcn_s_getreg((3 << 11) | 20) & 0xFu; }
#define XB_SPIN(cond, bar) do { unsigned _sp = 0; while (cond) { __builtin_amdgcn_s_sleep(1); \
    if ((++_sp & 255u) == 0u) { if (xb_ld(&(bar)[XB_TMO])) break; if (_sp > XB_SPIN_CAP) { atomicAdd(&(bar)[XB_TMO], 1u); break; } } } } while (0)
struct XcdBarrier { unsigned* bar; unsigned x; volatile LAS unsigned* st; };
__device__ __forceinline__ XcdBarrier xcd_barrier_post(unsigned* bar, volatile LAS unsigned* st) {
  XcdBarrier b; b.bar = bar; b.x = xb_xcc_id(); b.st = st;
  if (threadIdx.x == 0) (void)xb_add(&bar[XB_XCNT(b.x)], 1u);
  return b;
}
__device__ __forceinline__ void xcd_barrier_complete(unsigned* bar, unsigned x, unsigned& nloc, unsigned& nx) {
  const unsigned G = gridDim.x * gridDim.y * gridDim.z;
  unsigned sum, cnt, mine, sp = 0u;
  for (;;) {
    sum = 0u; cnt = 0u; mine = 0u;
#pragma unroll
    for (unsigned j = 0; j < 16; ++j) { const unsigned c = xb_ld(&bar[XB_XCNT(j)]); sum += c; cnt += (c > 0u) ? 1u : 0u; mine = (j == x) ? c : mine; }
    if (sum == G) break;
    __builtin_amdgcn_s_sleep(1);
    if ((++sp & 255u) == 0u) { if (xb_ld(&bar[XB_TMO])) break; if (sp > XB_SPIN_CAP) { atomicAdd(&bar[XB_TMO], 1u); break; } }
  }
  nloc = mine > 0u ? mine : 1u; nx = cnt > 0u ? cnt : 1u;
}
__device__ __forceinline__ void xcd_barrier(unsigned* bar_u, volatile LAS unsigned* st_u) {
  XcdBarrier b; b.bar = bar_u; b.x = xb_xcc_id(); b.st = st_u;
  asm volatile("s_waitcnt vmcnt(0)" ::: "memory");
  __syncthreads();
  if (threadIdx.x == 0) {
    unsigned long long bp_ = (unsigned long long)b.bar;
    asm volatile("" : "+v"(bp_));
    unsigned* bar = (unsigned*)bp_;
    __builtin_amdgcn_s_waitcnt(0);
    unsigned nloc = b.st[0], nx = b.st[1];
    if (nloc == 0u) { xcd_barrier_complete(bar, b.x, nloc, nx); b.st[0] = nloc; b.st[1] = nx; }
    const unsigned old = xb_add(&bar[XB_XSUB(b.x)], 1u);
    const unsigned gen = old / nloc;
    if (old + 1u == (gen + 1u) * nloc) {
      __builtin_amdgcn_fence(__ATOMIC_RELEASE, "agent");
      asm volatile("s_waitcnt vmcnt(0)" ::: "memory");
      const unsigned og = xb_add(&bar[XB_TOP], 1u);
      const unsigned tg = og / nx;
      if (og + 1u == (tg + 1u) * nx) xb_add(&bar[XB_TOPGEN], 1u);
      else XB_SPIN(xb_ld(&bar[XB_TOPGEN]) == tg, bar);
      __builtin_amdgcn_fence(__ATOMIC_ACQUIRE, "agent");
      xb_add(&bar[XB_XGEN(b.x)], 1u);
      asm volatile("s_waitcnt vmcnt(0)" ::: "memory");
    } else {
      XB_SPIN(xb_ld(&bar[XB_XGEN(b.x)]) == gen, bar);
      __builtin_amdgcn_fence(__ATOMIC_ACQUIRE, "agent");
      asm volatile("s_waitcnt vmcnt(0)" ::: "memory");
    }
  }
  __syncthreads();
}

template <int l>
__device__ __forceinline__ void layer_body(const P& p, char* smem, pg8::PG8_LAS_T lds, volatile LAS unsigned* xbw, const int nb, const int bid) {
    const bool last = (l == 1);
    const int n_mt = last ? 128 : 136;
    if (l == 0) {
      phase_norm(p, l, 0);
      xcd_barrier(p.counters + 1024, xbw);
    }
_Pragma("unroll 1")
    for (int rep = 0; rep < REP_INPROJ; ++rep) {
      pg8::Gemm g; pg8::Order S;
      g.A = (const u16*)p.xn8; g.Bt = (const u16*)(p.Win8 + (size_t)l * 2816 * 1024); g.lda = 512; g.ldb = 512; g.K = 512;
      S.init(136, 6, nb, bid, 4, 5);
      pg8::EpiInprojN8 e1; e1.qk = p.qk; e1.rg = p.rg; e1.sa = p.sa; e1.sw = p.sw + l * 5888;
      pg8::gemm_phase(lds, g, S, e1);
      g.A = (const u16*)(p.Win8 + ((size_t)l * 2816 + 1024) * 1024); g.Bt = (const u16*)p.xn8;
      S.init(5, 136, nb, (bid + nb - (136 * 6) % nb) % nb);
      pg8::EpiInprojT8 e2; e2.vT = p.vT; e2.sa = p.sa; e2.sw = p.sw + l * 5888 + 1024;
      pg8::gemm_phase(lds, g, S, e2);
    }
    xcd_barrier(p.counters + 1024, xbw);
    phase_mixers(p, l, smem, p.counters + l * 4);
    xcd_barrier(p.counters + 1024, xbw);
_Pragma("unroll 1")
    for (int rep = 0; rep < REP_2B; ++rep)
      for (int task = bid; task < 1088 + 512; task += nb) {
        if (task < 1088) rg_wave_task(p, l, task >> 2, task & 3, 1, last, smem);
        else yb_transpose_task(p, (task - 1088) >> 6, (task - 1088) & 63, smem);
      }
    xcd_barrier(p.counters + 1024, xbw);
_Pragma("unroll 1")
    for (int rep = 0; rep < REP_GATE; ++rep) {
      pg8::Gemm g; pg8::Order S;
      g.A = (const u16*)p.xn8; g.Bt = (const u16*)(p.Wg8 + (size_t)l * 3072 * 1024); g.lda = 512; g.ldb = 512; g.K = 512;
      S.init(n_mt, 12, nb, bid);
      pg8::EpiGate8 e; e.g8 = p.g8; e.bias = p.b_gate + l * 3072; e.sa = p.sa; e.sw = p.sw + l * 5888 + 2816;
      pg8::gemm_phase(lds, g, S, e);
    }
    xcd_barrier(p.counters + 1024, xbw);
_Pragma("unroll 1")
    for (int rep = 0; rep < REP_BRANCH; ++rep) {
      pg8::Gemm g; pg8::Order S;
      S.init(n_mt, 4, nb, bid);
      pg8::EpiBranchF e; e.mbuf = p.mbuf; e.g8 = p.g8;
      g.A = p.ycat; g.lda = 1024; g.Bt = p.WaT + (size_t)l * 1024 * 1024; g.ldb = 1024; g.K = 1024;
      pg8::gemm_phase(lds, g, S, e);
    }
    xcd_barrier(p.counters + 1024, xbw);
    {
      pg8::Gemm g; pg8::Order S;
      g.A = p.mbuf; g.Bt = p.WoT + (size_t)l * 1024 * 1024; g.lda = 1024; g.ldb = 1024; g.K = 1024;
      S.init(n_mt, 4, nb, bid);
      pg8::EpiOutR<(l == 0)> e; e.xsrc = p.x; e.csrc = p.ctx; e.res = p.res;
      e.modl = p.mod + (size_t)l * 9 * 6144;
_Pragma("unroll 1")
      for (int half = 0; half < 2; ++half) {
        if ((bid & 1) != half) {
          for (int t = bid; t < 4096; t += 8 * nb) {
            cvt_chunk_fp4x8(p.peer_u + (size_t)l * 16384 * 1024, p.Ub, t, nb, 4096, 64.0f, 0);
            cvt_chunk_fp4x8(p.peer_v + (size_t)l * 16384 * 1024, p.Ub, t, nb, 4096, 4.0f, 1);
          }
        }
        if (half == 0) pg8::gemm_phase(lds, g, S, e);
      }
    }
    xcd_barrier(p.counters + 1024, xbw);
    phase_norm(p, l, 1);
    xcd_barrier(p.counters + 1024, xbw);
_Pragma("unroll 1")
    for (int rep = 0; rep < REP_Q; ++rep) {
      pg8::Gemm g; pg8::Order S;
      g.A = (const u16*)p.xn8; g.Bt = p.WqkT + (size_t)l * 2048 * 1024; g.lda = 512; g.ldb = 1024; g.K = 512;
      S.init(n_mt, 8, nb, bid);
      pg8::EpiQ8 e; e.q = p.q; e.sa = p.sa; e.sw = p.swq + l * 2048;
      pg8::gemm_phase(lds, g, S, e);
    }
    xcd_barrier(p.counters + 1024, xbw);
_Pragma("unroll 1")
    for (int rep = 0; rep < REP_SCORE; ++rep)
    {
      uint4 q0, q1, q2, q3, q4, q5, q6, q7;
      {
        const int tid = opaque_tid();
        const int t0 = bid < n_mt * 16 ? bid : 0;
        uint4 pre[8];
        PS_LOAD(t0 >> 4, t0 & 15);
        q0 = pre[0]; q1 = pre[1]; q2 = pre[2]; q3 = pre[3]; q4 = pre[4]; q5 = pre[5]; q6 = pre[6]; q7 = pre[7];
      }
      for (int task = bid; task < n_mt * 16; task += nb) {
        const int nt_ = (task + nb < n_mt * 16) ? task + nb : task;
        peer_score_tile(p, l, task >> 4, task & 15, smem, q0, q1, q2, q3, q4, q5, q6, q7, nt_ >> 4, nt_ & 15);
      }
    }
    xcd_barrier(p.counters + 1024, xbw);
_Pragma("unroll 1")
    for (int rep = 0; rep < REP_PEER; ++rep) phase_peer_experts(p, l, rep == REP_PEER - 1, smem);
    xcd_barrier(p.counters + 1024, xbw);
  }

__global__ void __launch_bounds__(NTHR) fwd_megakernel(P p) {
  __shared__ __attribute__((aligned(16))) char smem[SMEM_BYTES];
  cg::grid_group grid = cg::this_grid();
  const int nb = gridDim.x, bid = blockIdx.x;
  pg8::PG8_LAS_T lds = (pg8::PG8_LAS_T)smem;
  volatile LAS unsigned* xbw = (volatile LAS unsigned*)(smem + SMEM_BYTES - 32);
  if (threadIdx.x == 0) { xbw[0] = 0u; xbw[1] = 0u; xbw[2] = 0u; xbw[3] = 0u; }
  __syncthreads();
  (void)xcd_barrier_post(p.counters + 1024, xbw);

  phase_prep(p, smem, p.counters + 32);
  grid.sync();
  phase_modreduce(p);
  for (int task = blockIdx.x; task < 512; task += gridDim.x) kf_task(p, task >> 8, task & 255, smem);
  for (int task = blockIdx.x; task < 256; task += gridDim.x) wqk_task(p, task >> 7, (task >> 3) & 15, task & 7, smem);
  for (int task = blockIdx.x; task < 2 * 368; task += gridDim.x) {
    const int l = task / 368, t = task - l * 368;
    if (t < 176) tr_tile4<true>(p.w_in + (size_t)l * 1024 * 2816, 2816, 1024, p.Win8 + (size_t)l * 2816 * 1024, t, p.sw + l * 5888, smem);
    else tr_tile4<true>(p.w_gate + (size_t)l * 1024 * 3072, 3072, 1024, p.Wg8 + (size_t)l * 3072 * 1024, t - 176, p.sw + l * 5888 + 2816, smem);
  }
  xcd_barrier(p.counters + 1024, xbw);

  wqk_quant(p);
  layer_body<0>(p, smem, lds, xbw, nb, bid);
  layer_body<1>(p, smem, lds, xbw, nb, bid);
}

extern "C" void kernel_launch(void* const* d_in, const int* in_sizes, int n_in, void* d_out, int out_size, void* d_ws,
                              size_t ws_size, hipStream_t stream) {
  P p;
  memset(&p, 0, sizeof(p));
  const float** ins = (const float**)&p;
  for (int i = 0; i < 37; ++i) ins[i] = (const float*)d_in[i];
  p.out = (float*)d_out;
  char* w = (char*)d_ws;
  size_t off = 0;
  auto take = [&](size_t bytes) { char* r = w + off; off += (bytes + 255) & ~(size_t)255; return r; };
  p.counters = (unsigned*)take(32768);
  p.WinT = nullptr; p.WgT = nullptr;
  p.Win8 = (unsigned char*)take((size_t)2 * 2816 * 1024);
  p.Wg8 = (unsigned char*)take((size_t)2 * 3072 * 1024);
  p.sw = (float*)take((size_t)2 * 5888 * 4);
  p.xn8 = (unsigned char*)take((size_t)NTOK * 1024);
  p.sa = (float*)take((size_t)NTOK * 4);
  p.WaT = (u16*)take((size_t)2 * 1024 * 1024 * 2);
  p.WbT = nullptr; p.WcT = nullptr;
  p.WoT = (u16*)take((size_t)2 * 1024 * 1024 * 2);
  p.WqkT = (u16*)take((size_t)2 * 2048 * 1024 * 2);
  p.rgW = (u16*)take((size_t)2 * 16 * 4096 * 2);
  p.mod = (float*)take((size_t)2 * 9 * 6144 * 4);
  p.hc = (float*)take((size_t)512 * 256 * 4);
  p.Kf = (float*)take((size_t)2 * 256 * 8192 * 8);
  p.xn = (u16*)take((size_t)NTOK * 1024 * 2);
  p.qk = (u16*)take((size_t)NTOK * 1024 * 2);
  p.mbuf = p.qk;
  p.vT = (u16*)take((size_t)8 * 512 * 4096 * 2);
  p.vTc = (u16*)take((size_t)8 * 512 * 256 * 2);
  p.hyT = (u16*)take((size_t)8 * 768 * 4096 * 2);
  p.hyTc = (u16*)take((size_t)8 * 768 * 256 * 2);
  p.rg = (u16*)take((size_t)NTOK * 512 * 2);
  p.ycat = (u16*)take((size_t)NTOK * 1024 * 2);
  p.Ub = (unsigned char*)p.ycat;
  p.Vb = p.Ub + (size_t)16384 * 512;
  p.agg = (float*)take((size_t)8 * 2 * (136 + 34) * 256 * 8);
  p.ybT = (u16*)take((size_t)8 * 256 * 4096 * 2);
  p.hT = (float*)take((size_t)2 * 512 * 4096 * 4);
  p.WqB = (u16*)take((size_t)2 * 1024 * 2048 * 2);
  p.modpart = (float*)take((size_t)16 * 2 * 9 * 6144 * 4);
  p.keysB = (u16*)take((size_t)2 * 16 * 16384 * 2);
  p.res = (u16*)p.hT;
  {
    const size_t have = (size_t)((w + off) - (char*)p.hT), need = (size_t)NTOK * 1024 * 2;
    if (need > have) (void)take(need - have);
  }
  p.ctxs = nullptr;
  p.swq = (float*)take((size_t)2 * 2048 * 4);
  p.g8 = (unsigned char*)p.vT;
  p.q = p.qk;
  p.topk = (unsigned*)((char*)p.qk + (size_t)NTOK * 2048 * 2);
  if (off > ws_size) {
    fprintf(stderr, "workspace too small: need %zu have %zu\n", off, ws_size);
    return;
  }
  static int grid_blocks = 0;
  if (!grid_blocks) {
    int dev = 0, cus = 0, per_cu = 0;
    (void)hipGetDevice(&dev);
    (void)hipDeviceGetAttribute(&cus, hipDeviceAttributeMultiprocessorCount, dev);
    (void)hipOccupancyMaxActiveBlocksPerMultiprocessor(&per_cu, fwd_megakernel, NTHR, 0);
    if (per_cu > 1) per_cu = 1;
    grid_blocks = cus * per_cu;
  }
  (void)hipMemsetAsync(p.counters, 0, 32768, stream);
  void* args[] = {&p};
  hipError_t e = hipLaunchCooperativeKernel((void*)fwd_megakernel, dim3(grid_blocks), dim3(NTHR), args, 0, stream);
  if (e != hipSuccess) fprintf(stderr, "cooperative launch failed: %s (grid %d)\n", hipGetErrorString(e), grid_blocks);
}
```

```cpp
#include <hip/hip_runtime.h>
#include <hip/hip_cooperative_groups.h>
#include <cstdio>
#include <cstring>
namespace cg = cooperative_groups;

typedef unsigned short u16;
typedef __attribute__((ext_vector_type(8))) short bf16x8;
typedef __attribute__((ext_vector_type(16))) float f32x16;
typedef __attribute__((ext_vector_type(2))) float f32x2;
typedef int i32x8 __attribute__((ext_vector_type(8)));

#define NLAT 32768
#define NTOK 34816
#define SMEM_BYTES 151552
#define NTHR 512
#ifndef DUP_1A
#define DUP_1A 1
#endif
#ifndef DUP_PREP
#define DUP_PREP 1
#endif
#ifndef DUP_2B
#define DUP_2B 1
#endif
#ifndef XRGA
#define XRGA 1
#endif
#ifndef REP_PEER
#define HOOK_NG 2
#define REP_PEER 1
#endif
#ifndef REP_INPROJ
#define REP_INPROJ 1
#endif
#ifndef REP_GATE
#define REP_GATE 1
#endif
#ifndef REP_BRANCH
#define REP_BRANCH 1
#endif
#ifndef REP_Q
#define REP_Q 1
#endif
#ifndef REP_SCORE
#define REP_SCORE 1
#endif
#ifndef REP_1A
#define REP_1A 1
#endif
#ifndef REP_2B
#define REP_2B 1
#endif
#ifndef REP_KF
#define REP_KF 1
#endif
#ifndef DUP_GEMM
#define DUP_GEMM 1
#endif
#ifndef DUP_PEER
#define DUP_PEER 1
#endif
#ifndef DUP_MIX
#define DUP_MIX 1
#endif
#ifndef XRG
#define XRG 1
#endif
#ifndef XFFT
#define XFFT 1
#endif
#ifndef XATT
#define XATT 1
#endif

struct P {
  const float *x, *c, *ctx, *c_ctx, *norm_mix_g, *norm_ffn_g, *w_ada, *b_ada, *w_in, *na_rpb,
      *hy_short_w, *hy_short_b, *hy_f1_w, *hy_f1_b, *hy_f2_w, *hy_f2_b, *hy_f3_w, *hy_freq, *hy_bias,
      *rg_conv_w, *rg_conv_b, *rg_wa, *rg_ba, *rg_wx, *rg_bx, *rg_lambda,
      *w_gate, *b_gate, *w_br_a, *w_br_b, *w_br_c, *w_out, *peer_wq, *peer_keys, *peer_u, *peer_v, *final_g;
  float* out;
  unsigned* counters;
  u16 *WinT, *WgT, *WaT, *WbT, *WcT, *WoT, *WqB, *WqkT, *keysB, *rgW;
  float *modpart, *mod, *hT, *hc;
  float* Kf;
  u16 *xn, *qk, *vT, *vTc, *hyT, *hyTc, *rg, *ycat, *mbuf, *ybT;
  unsigned char *Ub, *Vb, *g8, *xn8, *Win8, *Wg8;
  float *sa, *sw;
  u16* q;
  float *agg, *ctxs;
  float* swq;
  u16* res;
  unsigned* topk;
};

__device__ __forceinline__ u16 f2bf(float f) {
  unsigned u = __float_as_uint(f);
  u += 0x7fffu + ((u >> 16) & 1u);
  return (u16)(u >> 16);
}
__device__ __forceinline__ float bf2f(u16 h) { return __uint_as_float(((unsigned)h) << 16); }
__device__ __forceinline__ unsigned pk2(float a, float b) { return (unsigned)f2bf(a) | ((unsigned)f2bf(b) << 16); }
__device__ __forceinline__ float bflo(unsigned u) { return __uint_as_float(u << 16); }
__device__ __forceinline__ float bfhi(unsigned u) { return __uint_as_float(u & 0xffff0000u); }
__device__ __forceinline__ int opaque_tid() {
  int t = threadIdx.x;
  asm volatile("" : "+v"(t));
  return t;
}
__device__ __forceinline__ int my_lane() { return opaque_tid() & 63; }
__device__ __forceinline__ float shx(float v, int o);
__device__ __forceinline__ float shf(float v, int src) { return __builtin_bit_cast(float, __builtin_amdgcn_ds_bpermute((src & 63) << 2, __builtin_bit_cast(int, v))); }
__device__ __forceinline__ unsigned shu(unsigned v, int src) { return (unsigned)__builtin_amdgcn_ds_bpermute((src & 63) << 2, (int)v); }
typedef unsigned u32x2_t __attribute__((ext_vector_type(2)));
template <int J> __device__ __forceinline__ unsigned xorl(unsigned v, int lane) {
  if constexpr (J == 1) return (unsigned)__builtin_amdgcn_mov_dpp((int)v, 0xB1, 0xF, 0xF, true);
  else if constexpr (J == 2) return (unsigned)__builtin_amdgcn_mov_dpp((int)v, 0x4E, 0xF, 0xF, true);
  else if constexpr (J == 4) {
    const unsigned a = (unsigned)__builtin_amdgcn_mov_dpp((int)v, 0x104, 0xF, 0xF, true);
    const unsigned b = (unsigned)__builtin_amdgcn_mov_dpp((int)v, 0x114, 0xF, 0xF, true);
    return (lane & 4) ? b : a;
  }
  else if constexpr (J == 8) return (unsigned)__builtin_amdgcn_mov_dpp((int)v, 0x128, 0xF, 0xF, true);
  else if constexpr (J == 16) { const u32x2_t r = __builtin_amdgcn_permlane16_swap(v, v, false, false); return (lane & 16) ? r.x : r.y; }
  else { const u32x2_t r = __builtin_amdgcn_permlane32_swap(v, v, false, false); return (lane & 32) ? r.x : r.y; }
}
template <int J> __device__ __forceinline__ float xorf(float v, int lane) { return __uint_as_float(xorl<J>(__float_as_uint(v), lane)); }
__device__ __forceinline__ float shx(float v, int o) {
  const int lane = my_lane();
  switch (o) {
    case 1: return xorf<1>(v, lane);
    case 2: return xorf<2>(v, lane);
    case 4: return xorf<4>(v, lane);
    case 8: return xorf<8>(v, lane);
    case 16: return xorf<16>(v, lane);
    case 32: return xorf<32>(v, lane);
    default: return __builtin_bit_cast(float, __builtin_amdgcn_ds_bpermute(((lane ^ o) << 2), __builtin_bit_cast(int, v)));
  }
}
__device__ __forceinline__ float wave_sum(float v) {
  const int lane = my_lane();
  v += xorf<32>(v, lane); v += xorf<16>(v, lane); v += xorf<8>(v, lane); v += xorf<4>(v, lane); v += xorf<2>(v, lane); v += xorf<1>(v, lane);
  return v;
}
__device__ __forceinline__ float wave_max(float v) {
  const int lane = my_lane();
  v = fmaxf(v, xorf<32>(v, lane)); v = fmaxf(v, xorf<16>(v, lane)); v = fmaxf(v, xorf<8>(v, lane));
  v = fmaxf(v, xorf<4>(v, lane)); v = fmaxf(v, xorf<2>(v, lane)); v = fmaxf(v, xorf<1>(v, lane));
  return v;
}
__device__ __forceinline__ float sigmoidf_(float x) { return __builtin_amdgcn_rcpf(1.0f + __expf(-x)); }
__device__ __forceinline__ float gelu_tanh(float x) {
  const float u2 = 1.5957691216057308f * (x + 0.044715f * x * x * x);
  return x * __builtin_amdgcn_rcpf(1.0f + __expf(-u2));
}
__device__ __forceinline__ f32x16 mfma32(bf16x8 a, bf16x8 b, f32x16 c) {
  return __builtin_amdgcn_mfma_f32_32x32x16_bf16(a, b, c, 0, 0, 0);
}
__device__ __forceinline__ f32x16 zero16() {
  f32x16 z;
#pragma unroll
  for (int i = 0; i < 16; ++i) z[i] = 0.f;
  return z;
}
__device__ __forceinline__ int swz128(int row, int ch) { return row * 128 + ((ch ^ ((row >> 1) & 7)) << 4); }
__device__ __forceinline__ int swz256(int row, int ch) { return row * 256 + ((ch ^ (row & 15)) << 4); }

struct c2 { float x, y; };
__device__ __forceinline__ c2 cadd(c2 a, c2 b) { return {a.x + b.x, a.y + b.y}; }
__device__ __forceinline__ c2 csub(c2 a, c2 b) { return {a.x - b.x, a.y - b.y}; }
__device__ __forceinline__ c2 cmul(c2 a, c2 b) { return {a.x * b.x - a.y * b.y, a.x * b.y + a.y * b.x}; }
__device__ __forceinline__ float c16(int i) {
  const float tb[16] = {1.0f, 0.9238795325112867f, 0.7071067811865476f, 0.3826834323650898f, 0.0f,
                        -0.3826834323650898f, -0.7071067811865476f, -0.9238795325112867f, -1.0f,
                        -0.9238795325112867f, -0.7071067811865476f, -0.3826834323650898f, 0.0f,
                        0.3826834323650898f, 0.7071067811865476f, 0.9238795325112867f};
  return tb[i & 15];
}
__device__ __forceinline__ float s16(int i) { return c16(i + 12); }
template <int R> __device__ __forceinline__ constexpr int brev(int k) {
  int r = 0;
  for (int b = 1, o = R >> 1; b < R; b <<= 1, o >>= 1)
    if (k & b) r |= o;
  return r;
}
template <int R> __device__ __forceinline__ void dft_reg(c2* v, float sgn) {
#pragma unroll
  for (int h = R / 2; h >= 1; h >>= 1) {
#pragma unroll
    for (int g = 0; g < R; g += 2 * h) {
#pragma unroll
      for (int j = 0; j < h; ++j) {
        c2 a = v[g + j], b = v[g + j + h];
        v[g + j] = cadd(a, b);
        c2 d = csub(a, b);
        const int ti = j * (16 / (2 * h));
        c2 w = {c16(ti), sgn * s16(ti)};
        v[g + j + h] = (j == 0) ? d : cmul(d, w);
      }
    }
  }
}
template <int R> __device__ __forceinline__ int fft_bfly(c2* v, int j, int Ns, float sgn) {
  const int k = j & (Ns - 1);
  const float f = sgn * (float)k / (float)(Ns * R);
#pragma unroll
  for (int r = 1; r < R; ++r) {
    float t = f * (float)r;
    c2 w = {__builtin_amdgcn_cosf(t), __builtin_amdgcn_sinf(t)};
    v[r] = cmul(v[r], w);
  }
  dft_reg<R>(v, sgn);
  return (j - k) * R + k;
}
template <int R> __device__ __forceinline__ void fft_pass(c2* buf, int Ns, float sgn) {
  constexpr int NBF = 8192 / R;
  constexpr int PER = NBF / NTHR;
  const int tid = opaque_tid();
  c2 v[PER][R];
#pragma unroll
  for (int i = 0; i < PER; ++i) {
    const int j = tid + NTHR * i;
#pragma unroll
    for (int r = 0; r < R; ++r) v[i][r] = buf[j + r * NBF];
  }
  __syncthreads();
#pragma unroll
  for (int i = 0; i < PER; ++i) {
    const int j = tid + NTHR * i;
    const int base = fft_bfly<R>(v[i], j, Ns, sgn);
#pragma unroll
    for (int r = 0; r < R; ++r) buf[base + r * Ns] = v[i][brev<R>(r)];
  }
  __syncthreads();
}
__device__ __forceinline__ void fft8192(c2* buf, float sgn) {
  fft_pass<8>(buf, 1, sgn);
  fft_pass<8>(buf, 8, sgn);
  fft_pass<8>(buf, 64, sgn);
  fft_pass<16>(buf, 512, sgn);
}

__device__ __forceinline__ void gemm_kloop(f32x16 (&acc)[2][2], const u16* __restrict__ A, int lda,
                                           const u16* __restrict__ B, int ldb, int K, char* smem) {
  const int tid = opaque_tid(), lane = tid & 63, wid = tid >> 6;
  const int wm = wid >> 1, wn = wid & 1;
  const int l31 = lane & 31, hh = lane >> 5;
  uint4 ra[4], rb[2];
  const int nk = K >> 6;
  const int srow = tid >> 3, sch = tid & 7;
  const char* Ab = (const char*)A;
  const char* Bb = (const char*)B;
  const unsigned aoff = (unsigned)(srow * lda + sch * 8) * 2u;
  const unsigned boff = (unsigned)(srow * ldb + sch * 8) * 2u;
  const unsigned astep = (unsigned)lda * 128u, bstep = (unsigned)ldb * 128u;
#pragma unroll
  for (int i = 0; i < 4; ++i) ra[i] = *(const uint4*)(Ab + (aoff + i * astep));
#pragma unroll
  for (int i = 0; i < 2; ++i) rb[i] = *(const uint4*)(Bb + (boff + i * bstep));
#pragma unroll
  for (int i = 0; i < 4; ++i) *(uint4*)(smem + swz128(srow + i * 64, sch)) = ra[i];
#pragma unroll
  for (int i = 0; i < 2; ++i) *(uint4*)(smem + 65536 + swz128(srow + i * 64, sch)) = rb[i];
  __syncthreads();
  for (int kt = 0; kt < nk; ++kt) {
    const bool more = (kt + 1 < nk);
    if (more) {
      const unsigned ko = (unsigned)(kt + 1) * 128u;
#pragma unroll
      for (int i = 0; i < 4; ++i) ra[i] = *(const uint4*)(Ab + (aoff + i * astep + ko));
#pragma unroll
      for (int i = 0; i < 2; ++i) rb[i] = *(const uint4*)(Bb + (boff + i * bstep + ko));
    }
    const char* as = smem + (kt & 1) * 32768;
    const char* bs = smem + 65536 + (kt & 1) * 16384;
    int lrow = l31;
    asm volatile("" : "+v"(lrow));
#pragma unroll
    for (int s = 0; s < 4; ++s) {
      bf16x8 af[2], bfr[2];
#pragma unroll
      for (int i = 0; i < 2; ++i) af[i] = *(const bf16x8*)(as + swz128(wm * 64 + i * 32 + lrow, s * 2 + hh));
#pragma unroll
      for (int j = 0; j < 2; ++j) bfr[j] = *(const bf16x8*)(bs + swz128(wn * 64 + j * 32 + lrow, s * 2 + hh));
#pragma unroll
      for (int i = 0; i < 2; ++i)
#pragma unroll
        for (int j = 0; j < 2; ++j) acc[i][j] = mfma32(af[i], bfr[j], acc[i][j]);
    }
    if (more) {
      char* an = smem + ((kt + 1) & 1) * 32768;
      char* bn = smem + 65536 + ((kt + 1) & 1) * 16384;
      int sr2 = srow;
      asm volatile("" : "+v"(sr2));
#pragma unroll
      for (int i = 0; i < 4; ++i) *(uint4*)(an + swz128(sr2 + i * 64, sch)) = ra[i];
#pragma unroll
      for (int i = 0; i < 2; ++i) *(uint4*)(bn + swz128(sr2 + i * 64, sch)) = rb[i];
    }
    __syncthreads();
  }
}
__device__ __forceinline__ void zero_acc(f32x16 (&acc)[2][2]) {
#pragma unroll
  for (int i = 0; i < 2; ++i)
#pragma unroll
    for (int j = 0; j < 2; ++j) acc[i][j] = zero16();
}
#define EPI_ROW(i, e) (wm * 64 + (i)*32 + ((e)&3) + 8 * ((e) >> 2) + 4 * hh)
#define EPI_COL(j) (wn * 64 + (j)*32 + l31)
#define EPI_VARS                                                    \
  const int tid = opaque_tid(), lane = tid & 63, wid = tid >> 6;     \
  const int wm = wid >> 1, wn = wid & 1, l31 = lane & 31, hh = lane >> 5; \
  (void)tid; (void)wm; (void)wn; (void)l31; (void)hh;


namespace pg8 {
__device__ __forceinline__ unsigned pkh(float a, float b) { unsigned r; asm("v_cvt_pk_bf16_f32 %0, %1, %2" : "=v"(r) : "v"(a), "v"(b)); return r; }
#define PG8_LAS __attribute__((address_space(3)))
typedef PG8_LAS unsigned char* PG8_LAS_T;
typedef float f32x4 __attribute__((ext_vector_type(4)));
typedef unsigned u32x4 __attribute__((ext_vector_type(4)));
typedef int i32x4 __attribute__((ext_vector_type(4)));
constexpr int BM = 256, BK = 64, HALF = 128, HTB = HALF * BK * 2, STAGE_BYTES = 8 * HTB, NXCD = 8, WGM = 8;
__device__ __forceinline__ int lds_byte(int r, int c) { const int st = (r >> 4) * 2 + (c >> 5), rr = r & 15, cc = c & 31, ob = rr * 64 + cc * 2; return st * 1024 + (ob ^ (((ob >> 9) & 1) << 5)); }
__device__ __forceinline__ void stage_rc(int b, int& R, int& C) { const int st = b / 1024, sb = b % 1024, swz = sb ^ (((sb >> 9) & 1) << 5); R = (st >> 1) * 16 + swz / 64; C = (st & 1) * 32 + (swz % 64) / 2; }
__device__ __forceinline__ int perm32(int rho) { const int n = rho >> 4, i = rho & 15; return 8 * (i >> 2) + 4 * n + (i & 3); }
struct Unit { int pm, pn; };
struct Gemm { const u16* A; const u16* Bt; int lda, ldb, K; };
struct Order {
  int nM, nN, nwg, G, c, skip_from, skip_by;
  __device__ __forceinline__ void init(int nM_, int nN_, int G_, int c_, int sf = 1 << 30, int sb = 0) { nM = nM_; nN = nN_; nwg = nM * nN; G = G_; c = c_; skip_from = sf; skip_by = sb; }
  __device__ __forceinline__ bool next(int i, Unit& u) const {
    const long L = (long)i * G + c; if (L >= nwg) return false;
    int wgid = (int)L; { const int q = nwg / NXCD, r = nwg % NXCD, xcd = wgid % NXCD, off = wgid / NXCD; wgid = (xcd < r ? xcd * (q + 1) : r * (q + 1) + (xcd - r) * q) + off; }
    const int nig = WGM * nN, gid = wgid / nig, fm = gid * WGM, gsz = (nM - fm) < WGM ? (nM - fm) : WGM;
    u.pm = fm + ((wgid % nig) % gsz); u.pn = (wgid % nig) / gsz;
    if (u.pn >= skip_from) u.pn += skip_by;
    return true;
  }
};
__device__ __forceinline__ f32x4 mma16(bf16x8 a, bf16x8 b, f32x4 c) { return __builtin_amdgcn_mfma_f32_16x16x32_bf16(a, b, c, 0, 0, 0); }
__device__ __forceinline__ i32x4 mma16(bf16x8 a, bf16x8 b, i32x4 c) { return __builtin_amdgcn_mfma_i32_16x16x64_i8(__builtin_bit_cast(i32x4, a), __builtin_bit_cast(i32x4, b), c, 0, 0, 0); }
template <class Epi>
__device__ __forceinline__ void gemm_phase(PG8_LAS unsigned char* lds, const Gemm g, const Order& S, const Epi& E) {
  const int tid = opaque_tid(), wid = __builtin_amdgcn_readfirstlane(tid >> 6), lane = tid & 63, wr = wid >> 2, wc = wid & 3, fr = lane & 15, fq = lane >> 4;
  const int K = g.K, nt = K / BK;
  unsigned voffA[2], voffB[2];
#pragma unroll
  for (int i = 0; i < 2; ++i) { int R, C; stage_rc(tid * 16 + i * 8192, R, C); const int Rb = Epi::PERM ? ((R & ~31) + perm32(R & 31)) : R;
    voffA[i] = (unsigned)(R * g.lda + C) * 2u; voffB[i] = (unsigned)(Rb * g.ldb + C) * 2u; }
#define PG8_VOFF(T) do { _Pragma("unroll") for (int i = 0; i < 2; ++i) { int R, C; stage_rc((T) * 16 + i * 8192, R, C); const int Rb = Epi::PERM ? ((R & ~31) + perm32(R & 31)) : R; \
    voffA[i] = (unsigned)(R * g.lda + C) * 2u; voffB[i] = (unsigned)(Rb * g.ldb + C) * 2u; } } while (0)
  const size_t kstep = (size_t)(BK * 2);
  const size_t hstepA = (size_t)HALF * g.lda * 2, hstepB = (size_t)HALF * g.ldb * 2;
  const size_t tstepA = 2 * hstepA, tstepB = 2 * hstepB;
  const unsigned ldsw = (unsigned)wid * 1024u;
  int aoff = lds_byte(wr * 64 + fr, fq * 8), boff = lds_byte(wc * 32 + fr, fq * 8);
#define PG8_SA(b, h) (((b) * 2 + (h)) * HTB)
#define PG8_SB(b, h) ((4 + (b) * 2 + (h)) * HTB)
#define PG8_STAGE(bufoff, gbase, voff) do { _Pragma("unroll") for (int _i = 0; _i < 2; ++_i) \
    __builtin_amdgcn_global_load_lds((const unsigned*)((const char*)(gbase) + (voff)[_i]), (PG8_LAS unsigned*)(lds + (bufoff) + ldsw + _i * 8192), 16, 0, 0); } while (0)
#define PG8_LDA(dst, b, h) do { _Pragma("unroll") for (int m = 0; m < 4; ++m) _Pragma("unroll") for (int k = 0; k < 2; ++k) dst[m][k] = *(const PG8_LAS bf16x8*)(lds + PG8_SA(b, h) + aoff + m * 2048 + k * 1024); } while (0)
#define PG8_LDB(dst, b, h) do { _Pragma("unroll") for (int n = 0; n < 2; ++n) _Pragma("unroll") for (int k = 0; k < 2; ++k) dst[n][k] = *(const PG8_LAS bf16x8*)(lds + PG8_SB(b, h) + boff + n * 2048 + k * 1024); } while (0)
#define PG8_MMA(ai, bj, At, Bt) do { __builtin_amdgcn_s_setprio(1); _Pragma("unroll") for (int m = 0; m < 4; ++m) _Pragma("unroll") for (int n = 0; n < 2; ++n) _Pragma("unroll") for (int k = 0; k < 2; ++k) \
    acc[ai][bj][m][n] = mma16(Bt[n][k], At[m][k], acc[ai][bj][m][n]); __builtin_amdgcn_s_setprio(0); } while (0)
#define PG8_WAIT_V(n) asm volatile("s_waitcnt vmcnt(" #n ")" ::: "memory")
#define PG8_WAIT_L(n) asm volatile("s_waitcnt lgkmcnt(" #n ")" ::: "memory")
#define PG8_BAR __builtin_amdgcn_s_barrier()
#define PG8_SCHED __builtin_amdgcn_sched_barrier(0)
  Unit cur, nxt; int ui = 0;
  if (!S.next(0, cur)) return;
  typedef typename Epi::acc_t acc_t;
  acc_t acc[2][2][4][2];
#pragma unroll
  for (int a = 0; a < 2; ++a)
#pragma unroll
    for (int b = 0; b < 2; ++b)
#pragma unroll
      for (int m = 0; m < 4; ++m)
#pragma unroll
        for (int n = 0; n < 2; ++n) acc[a][b][m][n] = (acc_t){0, 0, 0, 0};
  bf16x8 At[4][2], B0[2][2], B1[2][2];
  const char* cA = (const char*)g.A + (size_t)cur.pm * tstepA; const char* cB = (const char*)g.Bt + (size_t)cur.pn * tstepB;
  PG8_STAGE(PG8_SB(0, 0), cB, voffB); PG8_STAGE(PG8_SA(0, 0), cA, voffA); PG8_STAGE(PG8_SB(0, 1), cB + hstepB, voffB); PG8_STAGE(PG8_SA(0, 1), cA + hstepA, voffA);
  if (wr == 1) PG8_BAR;
  PG8_WAIT_V(4); PG8_BAR;
  PG8_STAGE(PG8_SB(1, 0), cB + kstep, voffB); PG8_STAGE(PG8_SA(1, 0), cA + kstep, voffA); PG8_STAGE(PG8_SB(1, 1), cB + hstepB + kstep, voffB);
  PG8_WAIT_V(6); PG8_BAR;
  for (;;) {
    const bool has_next = S.next(ui + 1, nxt);
    const char* nA = has_next ? (const char*)g.A + (size_t)nxt.pm * tstepA : cA; const char* nB = has_next ? (const char*)g.Bt + (size_t)nxt.pn * tstepB : cB;
#define PG8_KBODY \
      const bool last = (t == nt - 2); \
      const char* a1 = cA + (size_t)(t + 1) * kstep; \
      const char* a2 = last ? nA : cA + (size_t)(t + 2) * kstep; const char* b2 = last ? nB : cB + (size_t)(t + 2) * kstep; \
      const char* a3 = a2 + kstep; const char* b3 = b2 + kstep; \
      PG8_LDB(B0, 0, 0); PG8_SCHED; PG8_LDA(At, 0, 0); PG8_STAGE(PG8_SA(1, 1), a1 + hstepA, voffA); \
      PG8_WAIT_L(8); PG8_BAR; PG8_WAIT_L(0); PG8_MMA(0, 0, At, B0); PG8_BAR; PG8_SCHED; \
      PG8_LDB(B1, 0, 1); PG8_STAGE(PG8_SB(0, 0), b2, voffB); \
      PG8_BAR; PG8_WAIT_L(0); PG8_MMA(0, 1, At, B1); PG8_BAR; \
      PG8_LDA(At, 0, 1); PG8_STAGE(PG8_SA(0, 0), a2, voffA); \
      PG8_BAR; PG8_WAIT_L(0); PG8_MMA(1, 0, At, B0); PG8_BAR; PG8_SCHED; \
      PG8_STAGE(PG8_SB(0, 1), b2 + hstepB, voffB); \
      PG8_WAIT_V(6); PG8_BAR; PG8_MMA(1, 1, At, B1); PG8_BAR; \
      PG8_LDB(B0, 1, 0); PG8_SCHED; PG8_LDA(At, 1, 0); PG8_STAGE(PG8_SA(0, 1), a2 + hstepA, voffA); \
      PG8_WAIT_L(8); PG8_BAR; PG8_WAIT_L(0); PG8_MMA(0, 0, At, B0); PG8_BAR; PG8_SCHED; \
      PG8_LDB(B1, 1, 1); PG8_STAGE(PG8_SB(1, 0), b3, voffB); \
      PG8_BAR; PG8_WAIT_L(0); PG8_MMA(0, 1, At, B1); PG8_BAR; \
      PG8_LDA(At, 1, 1); PG8_STAGE(PG8_SA(1, 0), a3, voffA); \
      PG8_BAR; PG8_WAIT_L(0); PG8_MMA(1, 0, At, B0); PG8_BAR; PG8_SCHED; \
      PG8_STAGE(PG8_SB(1, 1), b3 + hstepB, voffB); \
      PG8_WAIT_V(6); PG8_BAR; PG8_MMA(1, 1, At, B1); PG8_BAR;
    if constexpr (Epi::HOOKS) {
      asm volatile("" : "+v"(aoff), "+v"(boff));
      PG8_VOFF(opaque_tid());
      for (int t = 0; t < Epi::H1; t += 2) { PG8_KBODY }
      E.hook(acc, cur, wr, wc, fr, fq, Epi::H1);
      asm volatile("" : "+v"(aoff), "+v"(boff));
      PG8_VOFF(opaque_tid());
      for (int t = Epi::H1; t < Epi::H2; t += 2) { PG8_KBODY }
      E.hook(acc, cur, wr, wc, fr, fq, Epi::H2);
      asm volatile("" : "+v"(aoff), "+v"(boff));
      PG8_VOFF(opaque_tid());
      for (int t = Epi::H2; t < nt; t += 2) { PG8_KBODY }
    } else {
      for (int t = 0; t < nt; t += 2) { PG8_KBODY }
    }
#undef PG8_KBODY
    E(acc, cur, wr, wc, fr, fq);
    if (!has_next) break;
#pragma unroll
    for (int a = 0; a < 2; ++a)
#pragma unroll
      for (int b = 0; b < 2; ++b)
#pragma unroll
        for (int m = 0; m < 4; ++m)
#pragma unroll
          for (int n = 0; n < 2; ++n) acc[a][b][m][n] = (acc_t){0, 0, 0, 0};
    cur = nxt; cA = nA; cB = nB; ++ui;
  }
  PG8_WAIT_V(0);
  if (wr == 0) PG8_BAR;
  PG8_BAR;
#undef PG8_VOFF
#undef PG8_SA
#undef PG8_SB
#undef PG8_STAGE
#undef PG8_LDA
#undef PG8_LDB
#undef PG8_MMA
#undef PG8_WAIT_V
#undef PG8_WAIT_L
#undef PG8_BAR
#undef PG8_SCHED
}
typedef const f32x4 (&AccRef)[2][2][4][2];
typedef const i32x4 (&AccRefI)[2][2][4][2];
struct EpiInprojN {
  static constexpr bool PERM = true; static constexpr bool HOOKS = false; static constexpr int H1 = 0, H2 = 0;
  typedef f32x4 acc_t;
  u16* qk; u16* rg;
  __device__ __forceinline__ void operator()(AccRef acc, const Unit& u, int wr, int wc, int fr, int fq) const {
    const int row0 = u.pm * BM + wr * 64 + fr;
    u16* base; int ld, colt;
    if (u.pn < 4) { base = qk; ld = 1024; colt = u.pn * 256; } else { base = rg; ld = 512; colt = (u.pn - 9) * 256; }
    const int col0 = colt + wc * 32 + 8 * fq;
#pragma unroll
    for (int ai = 0; ai < 2; ++ai)
#pragma unroll
      for (int m = 0; m < 4; ++m) {
        u16* rowp = base + (size_t)(row0 + ai * HALF + m * 16) * ld + col0;
#pragma unroll
        for (int bj = 0; bj < 2; ++bj) {
          const f32x4 v0 = acc[ai][bj][m][0], v1 = acc[ai][bj][m][1];
          u32x4 w; w.x = pkh(v0[0], v0[1]); w.y = pkh(v0[2], v0[3]); w.z = pkh(v1[0], v1[1]); w.w = pkh(v1[2], v1[3]);
          *(u32x4*)(rowp + bj * HALF) = w;
        }
      }
  }
};
struct EpiInprojT {
  static constexpr bool PERM = true; static constexpr bool HOOKS = false; static constexpr int H1 = 0, H2 = 0;
  typedef f32x4 acc_t;
  u16 *vT, *vTc, *hyT, *hyTc;
  __device__ __forceinline__ void operator()(AccRef acc, const Unit& u, int wr, int wc, int fr, int fq) const {
    const bool isctx = (u.pn >= 128);
    const int b = isctx ? (u.pn - 128) : (u.pn >> 4);
    const int Lseg = isctx ? 256 : 4096, t0 = isctx ? 0 : (u.pn & 15) * 256;
    const bool isv = (u.pm < 2);
    const size_t boff = isv ? (isctx ? (size_t)16777216 : (size_t)0) : (isctx ? (size_t)(16777216 + 1048576 + 25165824) : (size_t)(16777216 + 1048576));
    u16* base = vT + boff;
    const int nc = isv ? 512 : 768;
    const int wrow0 = (isv ? u.pm : u.pm - 2) * BM + wr * 64 + fr;
    const int col0 = t0 + wc * 32 + 8 * fq;
#pragma unroll
    for (int ai = 0; ai < 2; ++ai)
#pragma unroll
      for (int m = 0; m < 4; ++m) {
        u16* rowp = base + ((size_t)(b * nc + wrow0 + ai * HALF + m * 16)) * Lseg + col0;
#pragma unroll
        for (int bj = 0; bj < 2; ++bj) {
          const f32x4 v0 = acc[ai][bj][m][0], v1 = acc[ai][bj][m][1];
          u32x4 w; w.x = pkh(v0[0], v0[1]); w.y = pkh(v0[2], v0[3]); w.z = pkh(v1[0], v1[1]); w.w = pkh(v1[2], v1[3]);
          *(u32x4*)(rowp + bj * HALF) = w;
        }
      }
  }
};
struct EpiGate {
  static constexpr bool PERM = true; static constexpr bool HOOKS = false; static constexpr int H1 = 0, H2 = 0;
  typedef f32x4 acc_t;
  unsigned char* g8; const float* bias;
  __device__ __forceinline__ void operator()(AccRef acc, const Unit& u, int wr, int wc, int fr, int fq) const {
    const int row0 = u.pm * BM + wr * 64 + fr;
    const int col0 = u.pn * BM + wc * 32 + 8 * fq;
#pragma unroll
    for (int bj = 0; bj < 2; ++bj) {
      const f32x4 b0 = *(const f32x4*)(bias + col0 + bj * HALF), b1 = *(const f32x4*)(bias + col0 + bj * HALF + 4);
#pragma unroll
      for (int ai = 0; ai < 2; ++ai)
#pragma unroll
        for (int m = 0; m < 4; ++m) {
          const f32x4 v0 = acc[ai][bj][m][0] + b0, v1 = acc[ai][bj][m][1] + b1;
          unsigned w0 = 0, w1 = 0;
#pragma unroll
          for (int k = 0; k < 4; ++k) {
            w0 |= (unsigned)(sigmoidf_(v0[k]) * 255.0f + 0.5f) << (8 * k);
            w1 |= (unsigned)(sigmoidf_(v1[k]) * 255.0f + 0.5f) << (8 * k);
          }
          *(uint2*)(g8 + (size_t)(row0 + ai * HALF + m * 16) * 3072 + col0 + bj * HALF) = make_uint2(w0, w1);
        }
    }
  }
};
struct EpiBranch {
  static constexpr bool PERM = true; static constexpr bool HOOKS = false; static constexpr int H1 = 0, H2 = 0;
  typedef f32x4 acc_t;
  u16* mbuf; const unsigned char* g8; int br;
  __device__ __forceinline__ void operator()(AccRef acc, const Unit& u, int wr, int wc, int fr, int fq) const {
    const int row0 = u.pm * BM + wr * 64 + fr;
    const int col0 = u.pn * BM + wc * 32 + 8 * fq;
    uint2 gq[2][2][2];
    u32x4 o[2][2][2];
#define EB_LOAD(G) do { _Pragma("unroll") for (int j = 0; j < 2; ++j) _Pragma("unroll") for (int bj = 0; bj < 2; ++bj) { \
      const size_t row = (size_t)(row0 + (((G) * 2 + j) >> 2) * HALF + (((G) * 2 + j) & 3) * 16); \
      gq[(G) & 1][j][bj] = *(const uint2*)(g8 + row * 3072 + br * 1024 + col0 + bj * HALF); \
      if (br != 0) o[(G) & 1][j][bj] = *(const u32x4*)(mbuf + row * 1024 + col0 + bj * HALF); } } while (0)
    EB_LOAD(0);
#pragma unroll
    for (int G = 0; G < 4; ++G) {
      if (G < 3) EB_LOAD(G + 1);
#pragma unroll
      for (int j = 0; j < 2; ++j) {
        const int ai = (G * 2 + j) >> 2, m = (G * 2 + j) & 3;
        const size_t row = (size_t)(row0 + ai * HALF + m * 16);
#pragma unroll
        for (int bj = 0; bj < 2; ++bj) {
          const uint2 g = gq[G & 1][j][bj];
          u16* mp = mbuf + row * 1024 + col0 + bj * HALF;
          const f32x4 v0 = acc[ai][bj][m][0], v1 = acc[ai][bj][m][1];
          float r[8];
          r[0] = (float)(g.x & 255u) * v0[0]; r[1] = (float)((g.x >> 8) & 255u) * v0[1];
          r[2] = (float)((g.x >> 16) & 255u) * v0[2]; r[3] = (float)(g.x >> 24) * v0[3];
          r[4] = (float)(g.y & 255u) * v1[0]; r[5] = (float)((g.y >> 8) & 255u) * v1[1];
          r[6] = (float)((g.y >> 16) & 255u) * v1[2]; r[7] = (float)(g.y >> 24) * v1[3];
          u32x4 w;
          if (br == 0) {
            w.x = pkh(r[0] * (1.f / 255.f), r[1] * (1.f / 255.f)); w.y = pkh(r[2] * (1.f / 255.f), r[3] * (1.f / 255.f));
            w.z = pkh(r[4] * (1.f / 255.f), r[5] * (1.f / 255.f)); w.w = pkh(r[6] * (1.f / 255.f), r[7] * (1.f / 255.f));
          } else {
            const u32x4 ov = o[G & 1][j][bj];
            w.x = pkh(bflo(ov.x) + r[0] * (1.f / 255.f), bfhi(ov.x) + r[1] * (1.f / 255.f));
            w.y = pkh(bflo(ov.y) + r[2] * (1.f / 255.f), bfhi(ov.y) + r[3] * (1.f / 255.f));
            w.z = pkh(bflo(ov.z) + r[4] * (1.f / 255.f), bfhi(ov.z) + r[5] * (1.f / 255.f));
            w.w = pkh(bflo(ov.w) + r[6] * (1.f / 255.f), bfhi(ov.w) + r[7] * (1.f / 255.f));
          }
          *(u32x4*)mp = w;
        }
      }
    }
#undef EB_LOAD
  }
};
struct EpiBranchF {
  static constexpr bool PERM = true; static constexpr bool HOOKS = true;
  static constexpr int H1 = 8, H2 = 12;
  typedef f32x4 acc_t;
  u16* mbuf; const unsigned char* g8;
  template <int NUM, int NG>
  __device__ __forceinline__ void rescale(f32x4 (&acc)[2][2][4][2], const Unit& u) const {
    const int tid_ = opaque_tid(), lane_ = tid_ & 63, wid_ = tid_ >> 6;
    const int row0 = u.pm * BM + (wid_ >> 2) * 64 + (lane_ & 15);
    const int col0 = u.pn * BM + (wid_ & 3) * 32 + 8 * (lane_ >> 4);
    constexpr int PER = 8 / NG;
#pragma unroll
    for (int G = 0; G < NG; ++G) {
      __builtin_amdgcn_sched_barrier(0);
      uint2 gn[PER][2], gd[PER][2];
#pragma unroll
      for (int j = 0; j < PER; ++j)
#pragma unroll
        for (int bj = 0; bj < 2; ++bj) {
          const unsigned char* gp = g8 + (size_t)(row0 + ((G * PER + j) >> 2) * HALF + ((G * PER + j) & 3) * 16) * 3072 + col0 + bj * HALF;
          gn[j][bj] = *(const uint2*)(gp + NUM * 1024); gd[j][bj] = *(const uint2*)(gp + (NUM + 1) * 1024);
        }
#pragma unroll
      for (int j = 0; j < PER; ++j) {
        const int ai = (G * PER + j) >> 2, m = (G * PER + j) & 3;
#pragma unroll
        for (int bj = 0; bj < 2; ++bj) {
          __builtin_amdgcn_sched_barrier(0);
          const unsigned n0 = gn[j][bj].x, n1 = gn[j][bj].y, d0 = gd[j][bj].x, d1 = gd[j][bj].y;
          f32x4 r0, r1;
#pragma unroll
          for (int k = 0; k < 4; ++k) {
            float fn0 = (float)((n0 >> (8 * k)) & 255u), fn1 = (float)((n1 >> (8 * k)) & 255u);
            if (NUM != 0) { fn0 = fmaxf(fn0, 1.0f); fn1 = fmaxf(fn1, 1.0f); }
            const float fd0 = fmaxf((float)((d0 >> (8 * k)) & 255u), 1.0f), fd1 = fmaxf((float)((d1 >> (8 * k)) & 255u), 1.0f);
            r0[k] = fn0 * __builtin_amdgcn_rcpf(fd0);
            r1[k] = fn1 * __builtin_amdgcn_rcpf(fd1);
          }
          acc[ai][bj][m][0] *= r0;
          acc[ai][bj][m][1] *= r1;
        }
      }
    }
    __builtin_amdgcn_sched_barrier(0);
  }
  __device__ __forceinline__ void hook(f32x4 (&acc)[2][2][4][2], const Unit& u, int wr, int wc, int fr, int fq, int t) const {
    if (t == H1) rescale<0, HOOK_NG>(acc, u); else rescale<1, HOOK_NG>(acc, u);
  }
  __device__ __forceinline__ void operator()(AccRef acc, const Unit& u, int wr, int wc, int fr, int fq) const {
    const int tid_ = opaque_tid(), lane_ = tid_ & 63, wid_ = tid_ >> 6;
    const int row0 = u.pm * BM + (wid_ >> 2) * 64 + (lane_ & 15);
    const int col0 = u.pn * BM + (wid_ & 3) * 32 + 8 * (lane_ >> 4);
    uint2 gq[2][4][2];
#pragma unroll
    for (int ai = 0; ai < 2; ++ai)
#pragma unroll
      for (int m = 0; m < 4; ++m)
#pragma unroll
        for (int bj = 0; bj < 2; ++bj)
          gq[ai][m][bj] = *(const uint2*)(g8 + (size_t)(row0 + ai * HALF + m * 16) * 3072 + 2048 + col0 + bj * HALF);
#pragma unroll
    for (int ai = 0; ai < 2; ++ai)
#pragma unroll
      for (int m = 0; m < 4; ++m)
#pragma unroll
        for (int bj = 0; bj < 2; ++bj) {
          const uint2 g = gq[ai][m][bj];
          const f32x4 v0 = acc[ai][bj][m][0], v1 = acc[ai][bj][m][1];
          float r[8];
#pragma unroll
          for (int k = 0; k < 4; ++k) {
            r[k] = fmaxf((float)((g.x >> (8 * k)) & 255u), 1.0f) * (1.f / 255.f) * v0[k];
            r[4 + k] = fmaxf((float)((g.y >> (8 * k)) & 255u), 1.0f) * (1.f / 255.f) * v1[k];
          }
          u32x4 w;
          w.x = pkh(r[0], r[1]); w.y = pkh(r[2], r[3]); w.z = pkh(r[4], r[5]); w.w = pkh(r[6], r[7]);
          *(u32x4*)(mbuf + (size_t)(row0 + ai * HALF + m * 16) * 1024 + col0 + bj * HALF) = w;
        }
  }
};
template <bool SRC_F32>
struct EpiOutR {
  static constexpr bool PERM = true; static constexpr bool HOOKS = false; static constexpr int H1 = 0, H2 = 0;
  typedef f32x4 acc_t;
  const float *xsrc, *csrc; u16* res; const float* modl;
  __device__ __forceinline__ void operator()(AccRef acc, const Unit& u, int wr, int wc, int fr, int fq) const {
    const bool isctx = (u.pm >= 128);
    const int bi = isctx ? 8 : (u.pm >> 4);
    const float* gatev = modl + ((size_t)bi * 6 + 2) * 1024;
    const int row0 = u.pm * BM + wr * 64 + fr, col0 = u.pn * BM + wc * 32 + 8 * fq;
    f32x4 gv[2][2];
#pragma unroll
    for (int bj = 0; bj < 2; ++bj) { gv[bj][0] = *(const f32x4*)(gatev + col0 + bj * HALF); gv[bj][1] = *(const f32x4*)(gatev + col0 + bj * HALF + 4); }
    if (SRC_F32) {
      const float* src = isctx ? (csrc - (size_t)NLAT * 1024) : xsrc;
#pragma unroll
      for (int G = 0; G < 4; ++G) {
        f32x4 sv[2][2][2];
#pragma unroll
        for (int j = 0; j < 2; ++j)
#pragma unroll
          for (int bj = 0; bj < 2; ++bj) {
            const float* sp = src + (size_t)(row0 + ((G * 2 + j) >> 2) * HALF + ((G * 2 + j) & 3) * 16) * 1024 + col0 + bj * HALF;
            sv[j][bj][0] = *(const f32x4*)sp; sv[j][bj][1] = *(const f32x4*)(sp + 4);
          }
#pragma unroll
        for (int j = 0; j < 2; ++j) {
          const int ai = (G * 2 + j) >> 2, m = (G * 2 + j) & 3;
#pragma unroll
          for (int bj = 0; bj < 2; ++bj) {
            const f32x4 o0 = sv[j][bj][0] + gv[bj][0] * acc[ai][bj][m][0], o1 = sv[j][bj][1] + gv[bj][1] * acc[ai][bj][m][1];
            u32x4 w;
            w.x = pkh(o0[0], o0[1]); w.y = pkh(o0[2], o0[3]); w.z = pkh(o1[0], o1[1]); w.w = pkh(o1[2], o1[3]);
            *(u32x4*)(res + (size_t)(row0 + ai * HALF + m * 16) * 1024 + col0 + bj * HALF) = w;
          }
        }
      }
    } else {
#pragma unroll
      for (int G = 0; G < 2; ++G) {
        u32x4 sv[4][2];
#pragma unroll
        for (int m = 0; m < 4; ++m)
#pragma unroll
          for (int bj = 0; bj < 2; ++bj) sv[m][bj] = *(const u32x4*)(res + (size_t)(row0 + G * HALF + m * 16) * 1024 + col0 + bj * HALF);
#pragma unroll
        for (int m = 0; m < 4; ++m)
#pragma unroll
          for (int bj = 0; bj < 2; ++bj) {
            const u32x4 r = sv[m][bj];
            const f32x4 a0 = acc[G][bj][m][0], a1 = acc[G][bj][m][1], g0 = gv[bj][0], g1 = gv[bj][1];
            u32x4 w;
            w.x = pkh(bflo(r.x) + g0[0] * a0[0], bfhi(r.x) + g0[1] * a0[1]); w.y = pkh(bflo(r.y) + g0[2] * a0[2], bfhi(r.y) + g0[3] * a0[3]);
            w.z = pkh(bflo(r.z) + g1[0] * a1[0], bfhi(r.z) + g1[1] * a1[1]); w.w = pkh(bflo(r.w) + g1[2] * a1[2], bfhi(r.w) + g1[3] * a1[3]);
            *(u32x4*)(res + (size_t)(row0 + G * HALF + m * 16) * 1024 + col0 + bj * HALF) = w;
          }
      }
    }
  }
};
struct EpiQ {
  static constexpr bool PERM = true; static constexpr bool HOOKS = false; static constexpr int H1 = 0, H2 = 0;
  typedef f32x4 acc_t;
  u16* q;
  __device__ __forceinline__ void operator()(AccRef acc, const Unit& u, int wr, int wc, int fr, int fq) const {
    const int row0 = u.pm * BM + wr * 64 + fr;
    const int col0 = u.pn * BM + wc * 32 + 8 * fq;
#pragma unroll
    for (int ai = 0; ai < 2; ++ai)
#pragma unroll
      for (int m = 0; m < 4; ++m) {
        u16* rowp = q + (size_t)(row0 + ai * HALF + m * 16) * 2048 + col0;
#pragma unroll
        for (int bj = 0; bj < 2; ++bj) {
          const f32x4 v0 = acc[ai][bj][m][0], v1 = acc[ai][bj][m][1];
          u32x4 w;
          w.x = __builtin_bit_cast(unsigned, __builtin_amdgcn_cvt_pkrtz(v0[0], v0[1]));
          w.y = __builtin_bit_cast(unsigned, __builtin_amdgcn_cvt_pkrtz(v0[2], v0[3]));
          w.z = __builtin_bit_cast(unsigned, __builtin_amdgcn_cvt_pkrtz(v1[0], v1[1]));
          w.w = __builtin_bit_cast(unsigned, __builtin_amdgcn_cvt_pkrtz(v1[2], v1[3]));
          *(u32x4*)(rowp + bj * HALF) = w;
        }
      }
  }
};
struct EpiQ8 {
  static constexpr bool PERM = true; static constexpr bool HOOKS = false; static constexpr int H1 = 0, H2 = 0;
  typedef i32x4 acc_t;
  u16* q; const float* sa; const float* sw;
  __device__ __forceinline__ void operator()(AccRefI acc, const Unit& u, int wr, int wc, int fr, int fq) const {
    const int row0 = u.pm * BM + wr * 64 + fr;
    const int col0 = u.pn * BM + wc * 32 + 8 * fq;
    float rs[8];
    f32x4 cs[2][2];
#pragma unroll
    for (int i = 0; i < 8; ++i) rs[i] = sa[row0 + (i >> 2) * HALF + (i & 3) * 16];
#pragma unroll
    for (int bj = 0; bj < 2; ++bj) { cs[bj][0] = *(const f32x4*)(sw + col0 + bj * HALF); cs[bj][1] = *(const f32x4*)(sw + col0 + bj * HALF + 4); }
#pragma unroll
    for (int ai = 0; ai < 2; ++ai)
#pragma unroll
      for (int m = 0; m < 4; ++m) {
        u16* rowp = q + (size_t)(row0 + ai * HALF + m * 16) * 2048 + col0;
        const float r = rs[ai * 4 + m];
#pragma unroll
        for (int bj = 0; bj < 2; ++bj) {
          const i32x4 a0 = acc[ai][bj][m][0], a1 = acc[ai][bj][m][1];
          const f32x4 c0 = cs[bj][0], c1 = cs[bj][1];
          u32x4 w;
          w.x = __builtin_bit_cast(unsigned, __builtin_amdgcn_cvt_pkrtz((float)a0[0] * r * c0[0], (float)a0[1] * r * c0[1]));
          w.y = __builtin_bit_cast(unsigned, __builtin_amdgcn_cvt_pkrtz((float)a0[2] * r * c0[2], (float)a0[3] * r * c0[3]));
          w.z = __builtin_bit_cast(unsigned, __builtin_amdgcn_cvt_pkrtz((float)a1[0] * r * c1[0], (float)a1[1] * r * c1[1]));
          w.w = __builtin_bit_cast(unsigned, __builtin_amdgcn_cvt_pkrtz((float)a1[2] * r * c1[2], (float)a1[3] * r * c1[3]));
          *(u32x4*)(rowp + bj * HALF) = w;
        }
      }
  }
};
struct EpiInprojN8 {
  static constexpr bool PERM = true; static constexpr bool HOOKS = false; static constexpr int H1 = 0, H2 = 0;
  typedef i32x4 acc_t;
  u16* qk; u16* rg; const float* sa; const float* sw;
  __device__ __forceinline__ void operator()(AccRefI acc, const Unit& u, int wr, int wc, int fr, int fq) const {
    const int row0 = u.pm * BM + wr * 64 + fr;
    u16* base; int ld, colt;
    if (u.pn < 4) { base = qk; ld = 1024; colt = u.pn * 256; } else { base = rg; ld = 512; colt = (u.pn - 9) * 256; }
    const int col0 = colt + wc * 32 + 8 * fq;
    const int wcol0 = u.pn * 256 + wc * 32 + 8 * fq;
    float rs[8];
    f32x4 cs[2][2];
#pragma unroll
    for (int i = 0; i < 8; ++i) rs[i] = sa[row0 + (i >> 2) * HALF + (i & 3) * 16];
#pragma unroll
    for (int bj = 0; bj < 2; ++bj) { cs[bj][0] = *(const f32x4*)(sw + wcol0 + bj * HALF); cs[bj][1] = *(const f32x4*)(sw + wcol0 + bj * HALF + 4); }
#pragma unroll
    for (int bj = 0; bj < 2; ++bj) {
      const f32x4 c0 = cs[bj][0], c1 = cs[bj][1];
#pragma unroll
      for (int ai = 0; ai < 2; ++ai)
#pragma unroll
        for (int m = 0; m < 4; ++m) {
          const int row = row0 + ai * HALF + m * 16;
          const float r = rs[ai * 4 + m];
          const i32x4 a0 = acc[ai][bj][m][0], a1 = acc[ai][bj][m][1];
          u32x4 w;
          w.x = pkh((float)a0[0] * r * c0[0], (float)a0[1] * r * c0[1]); w.y = pkh((float)a0[2] * r * c0[2], (float)a0[3] * r * c0[3]);
          w.z = pkh((float)a1[0] * r * c1[0], (float)a1[1] * r * c1[1]); w.w = pkh((float)a1[2] * r * c1[2], (float)a1[3] * r * c1[3]);
          *(u32x4*)(base + (size_t)row * ld + col0 + bj * HALF) = w;
        }
    }
  }
};
struct EpiInprojT8 {
  static constexpr bool PERM = true; static constexpr bool HOOKS = false; static constexpr int H1 = 0, H2 = 0;
  typedef i32x4 acc_t;
  u16* vT; const float* sa; const float* sw;
  __device__ __forceinline__ void operator()(AccRefI acc, const Unit& u, int wr, int wc, int fr, int fq) const {
    const bool isctx = (u.pn >= 128);
    const int b = isctx ? (u.pn - 128) : (u.pn >> 4);
    const int Lseg = isctx ? 256 : 4096, t0 = isctx ? 0 : (u.pn & 15) * 256;
    const bool isv = (u.pm < 2);
    const size_t boff = isv ? (isctx ? (size_t)16777216 : (size_t)0) : (isctx ? (size_t)(16777216 + 1048576 + 25165824) : (size_t)(16777216 + 1048576));
    u16* base = vT + boff;
    const int nc = isv ? 512 : 768;
    const int wrow0 = (isv ? u.pm : u.pm - 2) * BM + wr * 64 + fr;
    const int srow0 = u.pm * BM + wr * 64 + fr;
    const int col0 = t0 + wc * 32 + 8 * fq;
    const int tok0 = u.pn * BM + wc * 32 + 8 * fq;
    float rs[8];
    f32x4 cs[2][2];
#pragma unroll
    for (int i = 0; i < 8; ++i) rs[i] = sw[srow0 + (i >> 2) * HALF + (i & 3) * 16];
#pragma unroll
    for (int bj = 0; bj < 2; ++bj) { cs[bj][0] = *(const f32x4*)(sa + tok0 + bj * HALF); cs[bj][1] = *(const f32x4*)(sa + tok0 + bj * HALF + 4); }
#pragma unroll
    for (int bj = 0; bj < 2; ++bj) {
      const f32x4 c0 = cs[bj][0], c1 = cs[bj][1];
#pragma unroll
      for (int ai = 0; ai < 2; ++ai)
#pragma unroll
        for (int m = 0; m < 4; ++m) {
          const float r = rs[ai * 4 + m];
          const i32x4 a0 = acc[ai][bj][m][0], a1 = acc[ai][bj][m][1];
          u32x4 w;
          w.x = pkh((float)a0[0] * r * c0[0], (float)a0[1] * r * c0[1]); w.y = pkh((float)a0[2] * r * c0[2], (float)a0[3] * r * c0[3]);
          w.z = pkh((float)a1[0] * r * c1[0], (float)a1[1] * r * c1[1]); w.w = pkh((float)a1[2] * r * c1[2], (float)a1[3] * r * c1[3]);
          *(u32x4*)(base + ((size_t)(b * nc + wrow0 + ai * HALF + m * 16)) * Lseg + col0 + bj * HALF) = w;
        }
    }
  }
};
struct EpiGate8 {
  static constexpr bool PERM = true; static constexpr bool HOOKS = false; static constexpr int H1 = 0, H2 = 0;
  typedef i32x4 acc_t;
  unsigned char* g8; const float* bias; const float* sa; const float* sw;
  __device__ __forceinline__ void operator()(AccRefI acc, const Unit& u, int wr, int wc, int fr, int fq) const {
    const int row0 = u.pm * BM + wr * 64 + fr;
    const int col0 = u.pn * BM + wc * 32 + 8 * fq;
    typedef float f32x2 __attribute__((ext_vector_type(2)));
    float rs[8];
    f32x4 bs[2][2], cs[2][2];
#pragma unroll
    for (int i = 0; i < 8; ++i) rs[i] = sa[row0 + (i >> 2) * HALF + (i & 3) * 16];
#pragma unroll
    for (int bj = 0; bj < 2; ++bj) {
      bs[bj][0] = *(const f32x4*)(bias + col0 + bj * HALF); bs[bj][1] = *(const f32x4*)(bias + col0 + bj * HALF + 4);
      cs[bj][0] = *(const f32x4*)(sw + col0 + bj * HALF); cs[bj][1] = *(const f32x4*)(sw + col0 + bj * HALF + 4);
    }
#pragma unroll
    for (int bj = 0; bj < 2; ++bj) {
      f32x2 cn[4], bn[4];
#pragma unroll
      for (int k = 0; k < 2; ++k) {
        cn[k] = (f32x2){cs[bj][0][2 * k], cs[bj][0][2 * k + 1]} * -1.4426950408889634f; cn[2 + k] = (f32x2){cs[bj][1][2 * k], cs[bj][1][2 * k + 1]} * -1.4426950408889634f;
        bn[k] = (f32x2){bs[bj][0][2 * k], bs[bj][0][2 * k + 1]} * -1.4426950408889634f; bn[2 + k] = (f32x2){bs[bj][1][2 * k], bs[bj][1][2 * k + 1]} * -1.4426950408889634f;
      }
#pragma unroll
      for (int ai = 0; ai < 2; ++ai)
#pragma unroll
        for (int m = 0; m < 4; ++m) {
          const int row = row0 + ai * HALF + m * 16;
          const float r = rs[ai * 4 + m];
          const i32x4 a0 = acc[ai][bj][m][0], a1 = acc[ai][bj][m][1];
          unsigned qb[8];
#pragma unroll
          for (int k = 0; k < 4; ++k) {
            const f32x2 av = (k < 2) ? (f32x2){(float)a0[2 * k], (float)a0[2 * k + 1]} : (f32x2){(float)a1[2 * k - 4], (float)a1[2 * k - 3]};
            const f32x2 z = __builtin_elementwise_fma(av * r, cn[k], bn[k]);
            const f32x2 d = (f32x2){__builtin_amdgcn_exp2f(z.x), __builtin_amdgcn_exp2f(z.y)} + 1.0f;
            const f32x2 sg = {__builtin_amdgcn_rcpf(d.x), __builtin_amdgcn_rcpf(d.y)};
            const f32x2 q = __builtin_elementwise_fma(sg, (f32x2){255.0f, 255.0f}, (f32x2){8388608.0f, 8388608.0f});
            const float qx = q.x, qy = q.y;
            qb[2 * k] = __float_as_uint(qx); qb[2 * k + 1] = __float_as_uint(qy);
          }
          unsigned p0, p1, p2, p3;
          asm("v_perm_b32 %0, %1, %2, %3" : "=v"(p0) : "v"(qb[1]), "v"(qb[0]), "s"(0x0c0c0400u));
          asm("v_perm_b32 %0, %1, %2, %3" : "=v"(p1) : "v"(qb[3]), "v"(qb[2]), "s"(0x04000c0cu));
          asm("v_perm_b32 %0, %1, %2, %3" : "=v"(p2) : "v"(qb[5]), "v"(qb[4]), "s"(0x0c0c0400u));
          asm("v_perm_b32 %0, %1, %2, %3" : "=v"(p3) : "v"(qb[7]), "v"(qb[6]), "s"(0x04000c0cu));
          const unsigned w0 = p0 | p1, w1 = p2 | p3;
          *(uint2*)(g8 + (size_t)row * 3072 + col0 + bj * HALF) = make_uint2(w0, w1);
        }
    }
  }
};
}

__device__ __forceinline__ void tr_tile(const float* __restrict__ src, int N, int K, u16* __restrict__ dst, int tile, char* smem) {
  float* lds = (float*)smem;
  const int tiles_n = N >> 6;
  const int tk = tile / tiles_n, tn = tile - tk * tiles_n;
  const int tid = opaque_tid();
  {
    const int r = tid >> 3, c8 = (tid & 7) * 8;
    const float* s = src + (size_t)(tk * 64 + r) * N + tn * 64 + c8;
    float4 a = *(const float4*)s, b = *(const float4*)(s + 4);
    float* d = lds + r * 65 + c8;
    d[0] = a.x; d[1] = a.y; d[2] = a.z; d[3] = a.w; d[4] = b.x; d[5] = b.y; d[6] = b.z; d[7] = b.w;
  }
  __syncthreads();
  {
    const int n = tid >> 3, k0 = (tid & 7) * 8;
    uint4 o;
    o.x = pk2(lds[(k0 + 0) * 65 + n], lds[(k0 + 1) * 65 + n]);
    o.y = pk2(lds[(k0 + 2) * 65 + n], lds[(k0 + 3) * 65 + n]);
    o.z = pk2(lds[(k0 + 4) * 65 + n], lds[(k0 + 5) * 65 + n]);
    o.w = pk2(lds[(k0 + 6) * 65 + n], lds[(k0 + 7) * 65 + n]);
    *(uint4*)(dst + (size_t)(tn * 64 + n) * K + tk * 64 + k0) = o;
  }
  __syncthreads();
}
__device__ __forceinline__ void colmax_task(const float* __restrict__ w, int N, int n0, float* __restrict__ swp, char* smem) {
  const int tid = opaque_tid();
  const int col = tid & 63, kg = tid >> 6;
  float m = 0.f;
  const float* wp = w + (size_t)(kg * 128) * N + n0 + col;
#pragma unroll 16
  for (int k = 0; k < 128; ++k) m = fmaxf(m, fabsf(wp[(size_t)k * N]));
  float* red = (float*)smem;
  red[kg * 64 + col] = m;
  __syncthreads();
  if (tid < 64) {
    float mm = red[tid];
#pragma unroll
    for (int g = 1; g < 8; ++g) mm = fmaxf(mm, red[g * 64 + tid]);
    swp[n0 + tid] = fmaxf(mm, 1e-20f) * (1.0f / 127.0f);
  }
  __syncthreads();
}
__device__ __forceinline__ void tr_tile_i8(const float* __restrict__ src, int N, int K, unsigned char* __restrict__ dst, int tile, const float* __restrict__ swp, char* smem) {
  float* lds = (float*)smem;
  const int tiles_n = N >> 6;
  const int tk = tile / tiles_n, tn = tile - tk * tiles_n;
  const int tid = opaque_tid();
  {
    const int r = tid >> 3, c8 = (tid & 7) * 8;
    const float* sp = src + (size_t)(tk * 64 + r) * N + tn * 64 + c8;
    float4 a = *(const float4*)sp, b = *(const float4*)(sp + 4);
    float* d = lds + r * 65 + c8;
    d[0] = a.x; d[1] = a.y; d[2] = a.z; d[3] = a.w; d[4] = b.x; d[5] = b.y; d[6] = b.z; d[7] = b.w;
  }
  __syncthreads();
  {
    const int n = tid >> 3, k0 = (tid & 7) * 8;
    const float inv = 1.0f / swp[tn * 64 + n];
    unsigned w0 = 0, w1 = 0;
#pragma unroll
    for (int i = 0; i < 4; ++i) {
      w0 |= ((unsigned)__float2int_rn(lds[(k0 + i) * 65 + n] * inv) & 255u) << (8 * i);
      w1 |= ((unsigned)__float2int_rn(lds[(k0 + 4 + i) * 65 + n] * inv) & 255u) << (8 * i);
    }
    *(uint2*)(dst + (size_t)(tn * 64 + n) * K + tk * 64 + k0) = make_uint2(w0, w1);
  }
  __syncthreads();
}
__device__ __forceinline__ void cvt_chunk(const float* __restrict__ src, u16* __restrict__ dst, size_t chunk) {
  const size_t i = chunk * 4096 + (size_t)opaque_tid() * 8;
  float4 a = *(const float4*)(src + i), b = *(const float4*)(src + i + 4);
  uint4 o;
  o.x = pk2(a.x, a.y); o.y = pk2(a.z, a.w); o.z = pk2(b.x, b.y); o.w = pk2(b.z, b.w);
  *(uint4*)(dst + i) = o;
}
template <bool I8>
__device__ __forceinline__ void tr_tile4(const float* __restrict__ src, int N, int K, void* __restrict__ dstv, int tile4, const float* __restrict__ swp, char* smem) {
  float* lds = (float*)smem;
  const int tiles_n = N >> 6;
  const int tkq = tile4 / tiles_n, tn = tile4 - tkq * tiles_n;
  const int tid = opaque_tid();
  {
    const int r = tid >> 3, c8 = (tid & 7) * 8;
    const float* sp = src + (size_t)(tkq * 256 + r) * N + tn * 64 + c8;
    float4 a[4], b[4];
#pragma unroll
    for (int q = 0; q < 4; ++q) { a[q] = *(const float4*)(sp + (size_t)q * 64 * N); b[q] = *(const float4*)(sp + (size_t)q * 64 * N + 4); }
#pragma unroll
    for (int q = 0; q < 4; ++q) {
      float* d = lds + q * 4160 + r * 65 + c8;
      d[0] = a[q].x; d[1] = a[q].y; d[2] = a[q].z; d[3] = a[q].w; d[4] = b[q].x; d[5] = b[q].y; d[6] = b[q].z; d[7] = b[q].w;
    }
  }
  __syncthreads();
  {
    const int n = tid >> 3, k0 = (tid & 7) * 8;
    if (I8) {
      const float inv = 1.0f / swp[tn * 64 + n];
      unsigned char* dst = (unsigned char*)dstv;
#pragma unroll
      for (int q = 0; q < 4; ++q) {
        const float* lq = lds + q * 4160;
        unsigned w0 = 0, w1 = 0;
#pragma unroll
        for (int i = 0; i < 4; ++i) {
          w0 |= ((unsigned)__float2int_rn(lq[(k0 + i) * 65 + n] * inv) & 255u) << (8 * i);
          w1 |= ((unsigned)__float2int_rn(lq[(k0 + 4 + i) * 65 + n] * inv) & 255u) << (8 * i);
        }
        *(uint2*)(dst + (size_t)(tn * 64 + n) * K + tkq * 256 + q * 64 + k0) = make_uint2(w0, w1);
      }
    } else {
      u16* dst = (u16*)dstv;
#pragma unroll
      for (int q = 0; q < 4; ++q) {
        const float* lq = lds + q * 4160;
        uint4 o;
        o.x = pk2(lq[(k0 + 0) * 65 + n], lq[(k0 + 1) * 65 + n]);
        o.y = pk2(lq[(k0 + 2) * 65 + n], lq[(k0 + 3) * 65 + n]);
        o.z = pk2(lq[(k0 + 4) * 65 + n], lq[(k0 + 5) * 65 + n]);
        o.w = pk2(lq[(k0 + 6) * 65 + n], lq[(k0 + 7) * 65 + n]);
        *(uint4*)(dst + (size_t)(tn * 64 + n) * K + tkq * 256 + q * 64 + k0) = o;
      }
    }
  }
  __syncthreads();
}
__device__ __forceinline__ void colmax4_task(const float* __restrict__ w, int N, int n0, float* __restrict__ swp, char* smem) {
  const int tid = opaque_tid();
  const int c4 = (tid & 15) * 4, rg = tid >> 4;
  const float* wp = w + (size_t)(rg * 32) * N + n0 + c4;
  float4 m = {0.f, 0.f, 0.f, 0.f};
#pragma unroll 16
  for (int k = 0; k < 32; ++k) {
    const float4 v = *(const float4*)(wp + (size_t)k * N);
    m.x = fmaxf(m.x, fabsf(v.x)); m.y = fmaxf(m.y, fabsf(v.y)); m.z = fmaxf(m.z, fabsf(v.z)); m.w = fmaxf(m.w, fabsf(v.w));
  }
  float* red = (float*)smem;
  *(float4*)(red + rg * 64 + c4) = m;
  __syncthreads();
  if (tid < 64) {
    float mm = red[tid];
#pragma unroll
    for (int g = 1; g < 32; ++g) mm = fmaxf(mm, red[g * 64 + tid]);
    swp[n0 + tid] = fmaxf(mm, 1e-20f) * (1.0f / 127.0f);
  }
  __syncthreads();
}
__device__ __forceinline__ void cvt_chunk4(const float* __restrict__ src, u16* __restrict__ dst, size_t chunk4) {
  const size_t i = chunk4 * 16384 + (size_t)opaque_tid() * 8;
  float4 a[4], b[4];
#pragma unroll
  for (int q = 0; q < 4; ++q) { a[q] = *(const float4*)(src + i + q * 4096); b[q] = *(const float4*)(src + i + q * 4096 + 4); }
#pragma unroll
  for (int q = 0; q < 4; ++q) {
    uint4 o;
    o.x = pk2(a[q].x, a[q].y); o.y = pk2(a[q].z, a[q].w); o.z = pk2(b[q].x, b[q].y); o.w = pk2(b[q].z, b[q].w);
    *(uint4*)(dst + i + q * 4096) = o;
  }
}
__device__ __forceinline__ void cvt_chunk_fp8(const float* __restrict__ src, unsigned char* __restrict__ dst, size_t chunk, float scale) {
  const size_t i = chunk * 4096 + (size_t)opaque_tid() * 8;
  const float4 a = *(const float4*)(src + i), b = *(const float4*)(src + i + 4);
  int w0 = __builtin_amdgcn_cvt_pk_fp8_f32(a.x * scale, a.y * scale, 0, false);
  w0 = __builtin_amdgcn_cvt_pk_fp8_f32(a.z * scale, a.w * scale, w0, true);
  int w1 = __builtin_amdgcn_cvt_pk_fp8_f32(b.x * scale, b.y * scale, 0, false);
  w1 = __builtin_amdgcn_cvt_pk_fp8_f32(b.z * scale, b.w * scale, w1, true);
  *(uint2*)(dst + i) = make_uint2((unsigned)w0, (unsigned)w1);
}
__device__ __forceinline__ void cvt_chunk_fp4(const float* __restrict__ src, unsigned char* __restrict__ dst, size_t chunk, float scale, int vhalf) {
  const size_t i = chunk * 4096 + (size_t)opaque_tid() * 8;
  const float4 a = *(const float4*)(src + i), b = *(const float4*)(src + i + 4);
  unsigned w = 0;
  w = __builtin_amdgcn_cvt_scalef32_pk_fp4_f32(w, a.x * scale, a.y * scale, 1.0f, 0);
  w = __builtin_amdgcn_cvt_scalef32_pk_fp4_f32(w, a.z * scale, a.w * scale, 1.0f, 1);
  w = __builtin_amdgcn_cvt_scalef32_pk_fp4_f32(w, b.x * scale, b.y * scale, 1.0f, 2);
  w = __builtin_amdgcn_cvt_scalef32_pk_fp4_f32(w, b.z * scale, b.w * scale, 1.0f, 3);
  const size_t e = i >> 10;
  const unsigned d = (unsigned)(i & 1023);
  *(unsigned*)(dst + e * 1024 + vhalf * 512 + (d >> 1)) = w;
}
__device__ __forceinline__ void cvt_chunk_fp4x8(const float* __restrict__ src, unsigned char* __restrict__ dst, int t0, int step, int tmax, float scale, int vhalf) {
  const int tid8 = opaque_tid() * 8;
  float4 a[8], b[8];
#pragma unroll
  for (int q = 0; q < 8; ++q) {
    const int t = t0 + q * step;
    const size_t i = (size_t)(t < tmax ? t : t0) * 4096 + tid8;
    a[q] = *(const float4*)(src + i); b[q] = *(const float4*)(src + i + 4);
  }
#pragma unroll
  for (int q = 0; q < 8; ++q) {
    const int t = t0 + q * step;
    if (t < tmax) {
      const size_t i = (size_t)t * 4096 + tid8;
      unsigned w = 0;
      w = __builtin_amdgcn_cvt_scalef32_pk_fp4_f32(w, a[q].x * scale, a[q].y * scale, 1.0f, 0);
      w = __builtin_amdgcn_cvt_scalef32_pk_fp4_f32(w, a[q].z * scale, a[q].w * scale, 1.0f, 1);
      w = __builtin_amdgcn_cvt_scalef32_pk_fp4_f32(w, b[q].x * scale, b[q].y * scale, 1.0f, 2);
      w = __builtin_amdgcn_cvt_scalef32_pk_fp4_f32(w, b[q].z * scale, b[q].w * scale, 1.0f, 3);
      const size_t e = i >> 10;
      const unsigned d = (unsigned)(i & 1023);
      *(unsigned*)(dst + e * 1024 + vhalf * 512 + (d >> 1)) = w;
    }
  }
}
__device__ __forceinline__ void phase_modreduce(const P& p) {
  const int n = 2 * 9 * 6144;
  for (int i = blockIdx.x * NTHR + opaque_tid(); i < n; i += gridDim.x * NTHR) {
    const int l = i / (9 * 6144);
    const int j = i % 6144;
    float s = p.b_ada[l * 6144 + j];
#pragma unroll
    for (int kc = 0; kc < 16; ++kc) s += p.modpart[(size_t)kc * n + i];
    p.mod[i] = s;
  }
}

__device__ __forceinline__ void phase_norm(const P& p, int l, int which) {
  const int tid_ = opaque_tid(); const int lane = tid_ & 63, wid = tid_ >> 6;
  const int ntok = (which == 2 || (which == 1 && l == 1)) ? NLAT : NTOK;
  float4 vn[4]; uint2 rn[4];
#define PN_LOAD(R) do { const int r_ = (R); if (which == 0) { const float* src_ = (r_ < NLAT) ? p.x + (size_t)r_ * 1024 : p.ctx + (size_t)(r_ - NLAT) * 1024; \
      _Pragma("unroll") for (int i = 0; i < 4; ++i) vn[i] = *(const float4*)(src_ + i * 256 + lane * 4); } \
    else { _Pragma("unroll") for (int i = 0; i < 4; ++i) rn[i] = *(const uint2*)(p.res + (size_t)r_ * 1024 + i * 256 + lane * 4); } } while (0)
  if (blockIdx.x * 8 + wid < ntok) PN_LOAD(blockIdx.x * 8 + wid);
  for (int row = blockIdx.x * 8 + wid; row < ntok; row += gridDim.x * 8) {
    float4 v[4];
    float ss = 0.f;
#pragma unroll
    for (int i = 0; i < 4; ++i) {
      if (which == 0) v[i] = vn[i]; else v[i] = make_float4(bflo(rn[i].x), bfhi(rn[i].x), bflo(rn[i].y), bfhi(rn[i].y));
      ss += v[i].x * v[i].x + v[i].y * v[i].y + v[i].z * v[i].z + v[i].w * v[i].w;
    }
    {
      const int nrow = row + gridDim.x * 8;
      if (nrow < ntok) PN_LOAD(nrow);
    }
    ss = wave_sum(ss);
    const float rstd = rsqrtf(ss * (1.0f / 1024.0f) + 1e-6f);
    if (which == 2) {
#pragma unroll
      for (int i = 0; i < 4; ++i) {
        const int col = i * 256 + lane * 4;
        const float4 g = *(const float4*)(p.final_g + col);
        float4 o = {v[i].x * rstd * g.x, v[i].y * rstd * g.y, v[i].z * rstd * g.z, v[i].w * rstd * g.w};
        *(float4*)(p.out + (size_t)row * 1024 + col) = o;
      }
    } else {
      const int bi = row < NLAT ? (row >> 12) : 8;
      const float* gam = (which == 0 ? p.norm_mix_g : p.norm_ffn_g) + l * 1024;
      const float* msh = p.mod + ((size_t)(l * 9 + bi) * 6 + (which == 0 ? 0 : 3)) * 1024;
      const float* msc = msh + 1024;
      float4 y[4];
      float amax = 0.f;
#pragma unroll
      for (int i = 0; i < 4; ++i) {
        const int col = i * 256 + lane * 4;
        const float4 g = *(const float4*)(gam + col);
        const float4 sh = *(const float4*)(msh + col);
        const float4 sc = *(const float4*)(msc + col);
        y[i].x = v[i].x * rstd * g.x * (1.f + sc.x) + sh.x; y[i].y = v[i].y * rstd * g.y * (1.f + sc.y) + sh.y;
        y[i].z = v[i].z * rstd * g.z * (1.f + sc.z) + sh.z; y[i].w = v[i].w * rstd * g.w * (1.f + sc.w) + sh.w;
        amax = fmaxf(amax, fmaxf(fmaxf(fabsf(y[i].x), fabsf(y[i].y)), fmaxf(fabsf(y[i].z), fabsf(y[i].w))));
      }
      if (which == 0 || which == 1) {
        amax = fmaxf(wave_max(amax), 1e-20f);
        const float inv = 127.0f / amax;
#pragma unroll
        for (int i = 0; i < 4; ++i) {
          const unsigned w = ((unsigned)__float2int_rn(y[i].x * inv) & 255u) | (((unsigned)__float2int_rn(y[i].y * inv) & 255u) << 8) |
                             (((unsigned)__float2int_rn(y[i].z * inv) & 255u) << 16) | (((unsigned)__float2int_rn(y[i].w * inv) & 255u) << 24);
          *(unsigned*)(p.xn8 + (size_t)row * 1024 + i * 256 + lane * 4) = w;
        }
        if (lane == 0) p.sa[row] = amax * (1.0f / 127.0f);
      } else {
#pragma unroll
        for (int i = 0; i < 4; ++i) {
          uint2 o;
          o.x = pk2(y[i].x, y[i].y);
          o.y = pk2(y[i].z, y[i].w);
          *(uint2*)(p.xn + (size_t)row * 1024 + i * 256 + lane * 4) = o;
        }
      }
    }
  }
}

__device__ __forceinline__ void filter_wave(const P& p, int l, int L, int t, float* __restrict__ outp) {
  const int lane = opaque_tid() & 63;
  const float tl = (float)t / (float)(L - 1);
  const float wang = (6.283185307179586f / (float)L) * (float)t;
  float z = 0.f;
  if (lane == 0) z = tl;
  else if (lane <= 16) { const float band = 1e-4f + (float)(lane - 1) * ((15.0f - 1e-4f) / 15.0f); z = cosf(band * wang); }
  else if (lane <= 32) { const float band = 1e-4f + (float)(lane - 17) * ((15.0f - 1e-4f) / 15.0f); z = -sinf(band * wang); }
  float a1 = p.hy_f1_b[l * 64 + lane];
  for (int i = 0; i < 33; ++i) a1 += shf(z, i) * p.hy_f1_w[(l * 33 + i) * 64 + lane];
  const float h1 = sinf(p.hy_freq[l * 128 + lane] * a1);
  float a2 = p.hy_f2_b[l * 64 + lane];
  for (int i = 0; i < 64; ++i) a2 += shf(h1, i) * p.hy_f2_w[(l * 64 + i) * 64 + lane];
  const float h2 = sinf(p.hy_freq[l * 128 + 64 + lane] * a2);
  float a3[8];
#pragma unroll
  for (int m = 0; m < 8; ++m) a3[m] = 0.f;
  for (int i = 0; i < 64; ++i) {
    const float hv = shf(h2, i);
    const float* wr = p.hy_f3_w + (size_t)(l * 64 + i) * 512 + lane;
#pragma unroll
    for (int m = 0; m < 8; ++m) a3[m] += hv * wr[m * 64];
  }
  const float LN100 = 4.605170185988092f;
  const float d0 = LN100 / 1.5f, d1 = LN100 / 0.3f;
#pragma unroll
  for (int m = 0; m < 8; ++m) {
    const int cp = lane + 64 * m;
    const int ch = cp & 255;
    const float delta = d0 + (float)ch * ((d1 - d0) / 255.0f);
    outp[(size_t)cp * L + t] = a3[m] * expf(-tl * delta);
  }
}
__device__ __forceinline__ void filter_block_task(const P& p, int l, int L, int t0, float* __restrict__ outp, char* smem) {
  const int tid = opaque_tid(), lane = tid & 63, wid = tid >> 6;
  float* W3s = (float*)smem;
  float* W2s = (float*)(smem + 131072);
  {
    const float4* s3 = (const float4*)(p.hy_f3_w + (size_t)l * 64 * 512);
    const float4* s2 = (const float4*)(p.hy_f2_w + (size_t)l * 64 * 64);
#pragma unroll
    for (int i = 0; i < 16; ++i) ((float4*)W3s)[tid + NTHR * i] = s3[tid + NTHR * i];
#pragma unroll
    for (int i = 0; i < 2; ++i) ((float4*)W2s)[tid + NTHR * i] = s2[tid + NTHR * i];
  }
  __syncthreads();
  float z[4], tl[4];
#pragma unroll
  for (int j = 0; j < 4; ++j) {
    const int t = t0 + wid * 4 + j;
    tl[j] = (float)t / (float)(L - 1);
    const float wang = (6.283185307179586f / (float)L) * (float)t;
    float zz = 0.f;
    if (lane == 0) zz = tl[j];
    else if (lane <= 16) { const float band = 1e-4f + (float)(lane - 1) * ((15.0f - 1e-4f) / 15.0f); zz = cosf(band * wang); }
    else if (lane <= 32) { const float band = 1e-4f + (float)(lane - 17) * ((15.0f - 1e-4f) / 15.0f); zz = -sinf(band * wang); }
    z[j] = zz;
  }
  float a1[4], a2[4];
  {
    const float b1 = p.hy_f1_b[l * 64 + lane];
#pragma unroll
    for (int j = 0; j < 4; ++j) a1[j] = b1;
#pragma unroll 11
    for (int i = 0; i < 33; ++i) {
      const float w = p.hy_f1_w[(l * 33 + i) * 64 + lane];
#pragma unroll
      for (int j = 0; j < 4; ++j) a1[j] += shf(z[j], i) * w;
    }
    const float f0 = p.hy_freq[l * 128 + lane];
#pragma unroll
    for (int j = 0; j < 4; ++j) a1[j] = sinf(f0 * a1[j]);
  }
  {
    const float b2 = p.hy_f2_b[l * 64 + lane];
#pragma unroll
    for (int j = 0; j < 4; ++j) a2[j] = b2;
#pragma unroll 8
    for (int i = 0; i < 64; ++i) {
      const float w = W2s[i * 64 + lane];
#pragma unroll
      for (int j = 0; j < 4; ++j) a2[j] += shf(a1[j], i) * w;
    }
    const float f1 = p.hy_freq[l * 128 + 64 + lane];
#pragma unroll
    for (int j = 0; j < 4; ++j) a2[j] = sinf(f1 * a2[j]);
  }
  float a3[4][8];
#pragma unroll
  for (int j = 0; j < 4; ++j)
#pragma unroll
    for (int m = 0; m < 8; ++m) a3[j][m] = 0.f;
#pragma unroll 4
  for (int i = 0; i < 64; ++i) {
    float w[8];
#pragma unroll
    for (int m = 0; m < 8; ++m) w[m] = W3s[i * 512 + lane + 64 * m];
#pragma unroll
    for (int j = 0; j < 4; ++j) {
      const float hv = shf(a2[j], i);
#pragma unroll
      for (int m = 0; m < 8; ++m) a3[j][m] += hv * w[m];
    }
  }
  const float LN100 = 4.605170185988092f;
  const float d0 = LN100 / 1.5f, d1 = LN100 / 0.3f;
#pragma unroll
  for (int m = 0; m < 8; ++m) {
    const int cp = lane + 64 * m;
    const float delta = d0 + (float)(cp & 255) * ((d1 - d0) / 255.0f);
    float4 o;
    o.x = a3[0][m] * expf(-tl[0] * delta); o.y = a3[1][m] * expf(-tl[1] * delta);
    o.z = a3[2][m] * expf(-tl[2] * delta); o.w = a3[3][m] * expf(-tl[3] * delta);
    *(float4*)(outp + (size_t)cp * L + t0 + wid * 4) = o;
  }
  __syncthreads();
}
__device__ __forceinline__ void phase_filters(const P& p, int l, char* smem) {
  const int ntask = 128 + (l == 0 ? 8 : 0);
  for (int t = blockIdx.x; t < ntask; t += gridDim.x) {
    if (t < 128) filter_block_task(p, l, 4096, t * 32, p.hT + (size_t)l * 512 * 4096, smem);
    else filter_block_task(p, l, 256, (t - 128) * 32, p.hc, smem);
  }
}
__device__ __forceinline__ void adaln_task(const P& p, int t, char* smem) {
  const int tid = opaque_tid();
  const int kc = t & 15; t >>= 4;
  const int jc = t % 12, l = t / 12;
  float* s = (float*)smem;
  float* red = (float*)(smem + 4096);
  for (int i = tid; i < 576; i += NTHR) {
    const int bi = i >> 6, kk = i & 63;
    const float v = (bi < 8) ? p.c[bi * 1024 + kc * 64 + kk] : p.c_ctx[kc * 64 + kk];
    s[i] = v / (1.0f + __expf(-v));
  }
  const int kq = tid >> 7, c4 = (tid & 127) * 4;
  const float* wp = p.w_ada + ((size_t)l * 1024 + kc * 64 + kq * 16) * 6144 + jc * 512 + c4;
  float4 w[16];
#pragma unroll
  for (int kk = 0; kk < 16; ++kk) w[kk] = *(const float4*)(wp + (size_t)kk * 6144);
  __syncthreads();
  float4 acc[9];
#pragma unroll
  for (int bi = 0; bi < 9; ++bi) acc[bi] = make_float4(0.f, 0.f, 0.f, 0.f);
#pragma unroll
  for (int kk = 0; kk < 16; ++kk) {
#pragma unroll
    for (int bi = 0; bi < 9; ++bi) {
      const float sv = s[bi * 64 + kq * 16 + kk];
      acc[bi].x += sv * w[kk].x; acc[bi].y += sv * w[kk].y; acc[bi].z += sv * w[kk].z; acc[bi].w += sv * w[kk].w;
    }
  }
#pragma unroll
  for (int bi = 0; bi < 9; ++bi) *(float4*)(red + (kq * 9 + bi) * 512 + c4) = acc[bi];
  __syncthreads();
#pragma unroll
  for (int bi = 0; bi < 9; ++bi) {
    const float v = red[bi * 512 + tid] + red[(9 + bi) * 512 + tid] + red[(18 + bi) * 512 + tid] + red[(27 + bi) * 512 + tid];
    p.modpart[((size_t)(kc * 2 + l) * 9 + bi) * 6144 + jc * 512 + tid] = v;
  }
  __syncthreads();
}
__device__ __forceinline__ void phase_prep(const P& p, char* smem, unsigned* counter) {
  volatile int* s_taskp = (volatile int*)(smem + SMEM_BYTES - 16);
  const int total = 264 + 184 + 384 + 544 + 32;
  int nxt = 0;
  if (threadIdx.x == 0) nxt = (int)atomicAdd(counter, 1u);
  for (;;) {
    __syncthreads();
    if (threadIdx.x == 0) *s_taskp = nxt;
    __syncthreads();
    int t = *s_taskp;
    if (t >= total) break;
    if (threadIdx.x == 0) nxt = (int)atomicAdd(counter, 1u);
    if (t < 264) {
      if (t < 128) filter_block_task(p, 0, 4096, t * 32, p.hT, smem);
      else if (t < 256) filter_block_task(p, 1, 4096, (t - 128) * 32, p.hT + (size_t)512 * 4096, smem);
      else filter_block_task(p, 0, 256, (t - 256) * 32, p.hc, smem);
      continue;
    }
    t -= 264;
    if (t < 184) {
      const int l = t / 92; t -= l * 92;
      if (t < 44) colmax4_task(p.w_in + (size_t)l * 1024 * 2816, 2816, t * 64, p.sw + l * 5888, smem);
      else colmax4_task(p.w_gate + (size_t)l * 1024 * 3072, 3072, (t - 44) * 64, p.sw + l * 5888 + 2816, smem);
      continue;
    }
    t -= 184;
    if (t < 384) { adaln_task(p, t, smem); continue; }
    t -= 384;
    if (t < 544) {
      const int l = t / 272; t -= l * 272;
      if (t < 32) tr_tile4<false>(p.w_br_a + (size_t)l * 512 * 1024, 1024, 1024, p.WaT + (size_t)l * 1024 * 1024, t, nullptr, smem);
      else if ((t -= 32) < 16) tr_tile4<false>(p.w_br_b + (size_t)l * 256 * 1024, 1024, 1024, p.WaT + (size_t)l * 1024 * 1024 + 512, t, nullptr, smem);
      else if ((t -= 16) < 16) tr_tile4<false>(p.w_br_c + (size_t)l * 256 * 1024, 1024, 1024, p.WaT + (size_t)l * 1024 * 1024 + 768, t, nullptr, smem);
      else if ((t -= 16) < 64) tr_tile4<false>(p.w_out + (size_t)l * 1024 * 1024, 1024, 1024, p.WoT + (size_t)l * 1024 * 1024, t, nullptr, smem);
      else if ((t -= 64) < 128) cvt_chunk4(p.peer_wq + (size_t)l * 1024 * 2048, p.WqB + (size_t)l * 1024 * 2048, (size_t)t);
      else {
        t -= 128;
        const int gate = t >> 3, dn = t & 7;
        const float* src = (gate ? p.rg_wx : p.rg_wa) + (size_t)(l * 8 + dn) * 4096;
        tr_tile(src, 64, 64, p.rgW + (size_t)((l * 2 + gate) * 8 + dn) * 4096, 0, smem);
      }
      continue;
    }
    t -= 544;
    cvt_chunk4(p.peer_keys, p.keysB, (size_t)t);
  }
}
__device__ __forceinline__ void kf_task(const P& p, int l, int c, char* smem) {
  const float* hTl = p.hT + (size_t)l * 512 * 4096;
  c2* buf = (c2*)smem;
  const int tid = opaque_tid();
  for (int i = 0; i < 16; ++i) {
    const int j = tid + NTHR * i;
    float v;
    if (j < 4096) v = hTl[(size_t)c * 4096 + j];
    else if (j == 4096) v = 0.f;
    else v = hTl[(size_t)(256 + c) * 4096 + (8192 - j)];
    buf[j] = {v, 0.f};
  }
  __syncthreads();
  fft8192(buf, -1.f);
  c2* o = (c2*)p.Kf + ((size_t)l * 256 + c) * 8192;
  for (int i = 0; i < 16; ++i) { const int j = tid + NTHR * i; o[j] = buf[j]; }
  __syncthreads();
}

__device__ __forceinline__ void inproj_tile(const P& p, int l, int mt, int nt, char* smem) {
  f32x16 acc[2][2];
  zero_acc(acc);
  const int m0 = mt * 256, n0 = nt * 128;
  gemm_kloop(acc, p.xn + (size_t)m0 * 1024, 1024, p.WinT + ((size_t)l * 2816 + n0) * 1024, 1024, 1024, smem);
  EPI_VARS
  if (nt < 8 || nt >= 18) {
    u16* dst; int ld, cbase;
    if (nt < 8) { dst = p.qk; ld = 1024; cbase = n0; }
    else { dst = p.rg; ld = 512; cbase = n0 - 2304; }
#pragma unroll
    for (int i = 0; i < 2; ++i)
#pragma unroll
      for (int j = 0; j < 2; ++j)
#pragma unroll
        for (int e = 0; e < 16; ++e)
          dst[(size_t)(m0 + EPI_ROW(i, e)) * ld + cbase + EPI_COL(j)] = f2bf(acc[i][j][e]);
  } else {
#pragma unroll
    for (int i = 0; i < 2; ++i)
#pragma unroll
      for (int j = 0; j < 2; ++j)
#pragma unroll
        for (int qd = 0; qd < 4; ++qd) {
          uint2 o;
          o.x = pk2(acc[i][j][4 * qd + 0], acc[i][j][4 * qd + 1]);
          o.y = pk2(acc[i][j][4 * qd + 2], acc[i][j][4 * qd + 3]);
          const int row0 = wm * 64 + i * 32 + 8 * qd + 4 * hh;
          *(uint2*)(smem + EPI_COL(j) * 520 + row0 * 2) = o;
        }
    __syncthreads();
    u16* dstT; int Lseg, t0, ncol0, nc;
    const bool isctx = (mt >= 128);
    const int b = isctx ? (mt - 128) : (mt >> 4);
    if (nt < 12) { ncol0 = n0 - 1024; nc = 512; dstT = isctx ? p.vTc : p.vT; }
    else { ncol0 = n0 - 1536; nc = 768; dstT = isctx ? p.hyTc : p.hyT; }
    if (isctx) { Lseg = 256; t0 = 0; } else { Lseg = 4096; t0 = (mt & 15) * 256; }
#pragma unroll 4
    for (int it = 0; it < 16; ++it) {
      const int idx = tid + NTHR * it;
      const int col = idx >> 6, u = idx & 63;
      const uint2 v = *(const uint2*)(smem + col * 520 + u * 8);
      *(uint2*)(dstT + ((size_t)(b * nc + ncol0 + col)) * Lseg + t0 + u * 4) = v;
    }
    __syncthreads();
  }
}

__device__ __forceinline__ float ldbf(const u16* p, int t, int L) { return (t >= 0 && t < L) ? bf2f(p[t]) : 0.f; }
__device__ __forceinline__ void ld10(const u16* __restrict__ seq, int t0, float (&v)[10]) {
  const uint4 r = *(const uint4*)(seq + t0);
  v[0] = (t0 > 0) ? bf2f(seq[t0 - 1]) : 0.f;
  v[9] = (t0 + 8 < 4096) ? bf2f(seq[t0 + 8]) : 0.f;
  v[1] = bflo(r.x); v[2] = bfhi(r.x); v[3] = bflo(r.y); v[4] = bfhi(r.y);
  v[5] = bflo(r.z); v[6] = bfhi(r.z); v[7] = bflo(r.w); v[8] = bfhi(r.w);
}
__device__ __forceinline__ void hyena_fft_task(const P& p, int l, int c, int bp, char* smem) {
  c2* buf = (c2*)smem;
  c2* ub = (c2*)(smem + 65536);
  const int tid = opaque_tid();
  const float* sw = p.hy_short_w + l * 3 * 768;
  const float* sb = p.hy_short_b + l * 768;
  const float wx0[3] = {sw[c], sw[768 + c], sw[1536 + c]};
  const float wx1[3] = {sw[256 + c], sw[768 + 256 + c], sw[1536 + 256 + c]};
  const float wv[3] = {sw[512 + c], sw[768 + 512 + c], sw[1536 + 512 + c]};
  const float bx0 = sb[c], bx1 = sb[256 + c], bv = sb[512 + c];
  const float dsk = p.hy_bias[l * 256 + c];
  const int t0 = tid * 8;
  {
    float u[2][8];
#pragma unroll
    for (int bb = 0; bb < 2; ++bb) {
      const int b = 2 * bp + bb;
      float x1[10], vv[10];
      ld10(p.hyT + ((size_t)(b * 768 + 256 + c)) * 4096, t0, x1);
      ld10(p.hyT + ((size_t)(b * 768 + 512 + c)) * 4096, t0, vv);
#pragma unroll
      for (int k = 0; k < 8; ++k) {
        const float x1c = bx1 + wx1[0] * x1[k] + wx1[1] * x1[k + 1] + wx1[2] * x1[k + 2];
        const float vc = bv + wv[0] * vv[k] + wv[1] * vv[k + 1] + wv[2] * vv[k + 2];
        u[bb][k] = vc * x1c;
      }
    }
#pragma unroll
    for (int k = 0; k < 8; k += 2) {
      const float4 w = make_float4(u[0][k], u[1][k], u[0][k + 1], u[1][k + 1]);
      *(float4*)(buf + t0 + k) = w;
      *(float4*)(ub + t0 + k) = w;
      *(float4*)(buf + 4096 + t0 + k) = make_float4(0.f, 0.f, 0.f, 0.f);
    }
  }
  __syncthreads();
  fft8192(buf, -1.f);
  const c2* kf = (const c2*)p.Kf + ((size_t)l * 256 + c) * 8192;
  for (int i = 0; i < 16; ++i) {
    const int k = tid + NTHR * i;
    buf[k] = cmul(buf[k], kf[k]);
  }
  __syncthreads();
  fft8192(buf, 1.f);
#pragma unroll
  for (int bb = 0; bb < 2; ++bb) {
    const int b = 2 * bp + bb;
    float x0[10];
    ld10(p.hyT + ((size_t)(b * 768 + c)) * 4096, t0, x0);
    float o[8];
#pragma unroll
    for (int k = 0; k < 8; ++k) {
      const c2 y = buf[t0 + k];
      const c2 uu = ub[t0 + k];
      const float x0c = bx0 + wx0[0] * x0[k] + wx0[1] * x0[k + 1] + wx0[2] * x0[k + 2];
      const float yy = ldexpf(bb ? y.y : y.x, -13);
      const float uv = bb ? uu.y : uu.x;
      o[k] = x0c * (yy + uv * dsk);
    }
    uint4 w; w.x = pk2(o[0], o[1]); w.y = pk2(o[2], o[3]); w.z = pk2(o[4], o[5]); w.w = pk2(o[6], o[7]);
    *(uint4*)(p.ybT + ((size_t)(b * 256 + c)) * 4096 + t0) = w;
  }
  __syncthreads();
}
__device__ __forceinline__ void yb_transpose_task(const P& p, int b, int tb, char* smem) {
  const int tid = opaque_tid(), lane = tid & 63, wid = tid >> 6;
  u16* T = (u16*)smem;
#pragma unroll
  for (int it = 0; it < 4; ++it) {
    const int id = tid + NTHR * it;
    const int c = id >> 3, ch = id & 7;
    const uint4 r = *(const uint4*)(p.ybT + ((size_t)(b * 256 + c)) * 4096 + tb * 64 + ch * 8);
    unsigned* d = (unsigned*)(T + c * 66 + ch * 8);
    d[0] = r.x; d[1] = r.y; d[2] = r.z; d[3] = r.w;
  }
  __syncthreads();
#pragma unroll
  for (int it = 0; it < 8; ++it) {
    const int tt = wid + 8 * it;
    const int c0 = lane * 4;
    uint2 w;
    w.x = (unsigned)T[(c0 + 0) * 66 + tt] | ((unsigned)T[(c0 + 1) * 66 + tt] << 16);
    w.y = (unsigned)T[(c0 + 2) * 66 + tt] | ((unsigned)T[(c0 + 3) * 66 + tt] << 16);
    *(uint2*)(p.ycat + (size_t)(b * 4096 + tb * 64 + tt) * 1024 + 512 + c0) = w;
  }
  __syncthreads();
}
__device__ __forceinline__ void hyena_ctx_task(const P& p, int l, int b, int cg8, char* smem) {
  const int tid_ = opaque_tid(); const int lane = tid_ & 63, wid = tid_ >> 6;
  const int c = cg8 * 8 + wid;
  float* us = (float*)smem + wid * 1024;
  float* kfp = us + 256 + 255;
  const float* sw = p.hy_short_w + l * 3 * 768;
  const float* sb = p.hy_short_b + l * 768;
  const u16* x0 = p.hyTc + ((size_t)(b * 768 + c)) * 256;
  const u16* x1 = p.hyTc + ((size_t)(b * 768 + 256 + c)) * 256;
  const u16* vv = p.hyTc + ((size_t)(b * 768 + 512 + c)) * 256;
  for (int i = 0; i < 4; ++i) {
    const int t = lane + 64 * i;
    const float x1c = sb[256 + c] + sw[256 + c] * ldbf(x1, t - 1, 256) + sw[768 + 256 + c] * ldbf(x1, t, 256) + sw[1536 + 256 + c] * ldbf(x1, t + 1, 256);
    const float vc = sb[512 + c] + sw[512 + c] * ldbf(vv, t - 1, 256) + sw[768 + 512 + c] * ldbf(vv, t, 256) + sw[1536 + 512 + c] * ldbf(vv, t + 1, 256);
    us[t] = vc * x1c;
    kfp[t] = p.hc[(size_t)c * 256 + t];
    if (t > 0) kfp[-t] = p.hc[(size_t)(256 + c) * 256 + t];
  }
  __syncthreads();
  const float dsk = p.hy_bias[l * 256 + c];
  float acc[4] = {0.f, 0.f, 0.f, 0.f};
  for (int s = 0; s < 256; ++s) {
    const float uv = us[s];
#pragma unroll
    for (int i = 0; i < 4; ++i) acc[i] += kfp[lane + 64 * i - s] * uv;
  }
#pragma unroll
  for (int i = 0; i < 4; ++i) {
    const int t = lane + 64 * i;
    const float x0c = sb[c] + sw[c] * ldbf(x0, t - 1, 256) + sw[768 + c] * ldbf(x0, t, 256) + sw[1536 + c] * ldbf(x0, t + 1, 256);
    p.ycat[(size_t)(NLAT + b * 256 + t) * 1024 + 512 + c] = f2bf(x0c * (acc[i] + us[t] * dsk));
  }
  __syncthreads();
}

template <int DIR>
__device__ __forceinline__ void rg_scan32(const float (&Av)[2][16], const float (&Bv)[2][16], float (&carry)[2], float (&H)[2][16], int hh) {
#pragma unroll
  for (int nt = 0; nt < 2; ++nt) {
    float c = carry[nt];
#pragma unroll
    for (int go = 0; go < 8; ++go) {
      const int g = DIR ? 7 - go : go, q = g >> 1, own = g & 1;
      float h = c;
#pragma unroll
      for (int io = 0; io < 4; ++io) {
        const int e = 4 * q + (DIR ? 3 - io : io);
        h = Av[nt][e] * h + Bv[nt][e];
        H[nt][e] = (hh == own) ? h : H[nt][e];
      }
      const float mine = (hh == own) ? h : c;
      const float other = shx(mine, 32);
      c = (hh == own) ? mine : other;
    }
    carry[nt] = c;
  }
}
__device__ __forceinline__ void rg_wave_task(const P& p, int l, int bq, int nblk, int mode, bool last, char* smem) {
  const int tid = opaque_tid(), lane = tid & 63, wid = tid >> 6;
  const int l31 = lane & 31, hh = lane >> 5;
  const int b = bq / 34, rr = bq - b * 34;
  const int seg = rr < 2 ? 0 : 1, blk = rr < 2 ? rr : rr - 2;
  if (mode == 1 && seg == 0 && last) return;
  const int ck = wid >> 1, dir = wid & 1;
  char* wreg = smem + wid * 17408;
  u16* xs = (u16*)wreg;
  char* xcb = wreg + 4608;
  float* xcf = (float*)(wreg + 8704);
  float2* blockagg = (float2*)(smem + 139264);
  const int Lseg = seg ? 4096 : 256;
  const int tokbase = seg ? b * 4096 : NLAT + b * 256;
  const int T0 = blk * 128 + ck * 32;
  const int cg32 = (seg ? 8 : 0) + blk * 4 + ck;
  uint4 xt[5];
#pragma unroll
  for (int i = 0; i < 5; ++i) {
    const int idx = lane + 64 * i;
    const int row = idx >> 3, chunk = idx & 7;
    xt[i] = make_uint4(0u, 0u, 0u, 0u);
    if (row < 35) {
      const int pos = T0 - 2 + row;
      if (pos >= 0 && pos < Lseg) xt[i] = *(const uint4*)(p.rg + (size_t)(tokbase + pos) * 512 + nblk * 64 + chunk * 8);
    }
  }
  const float cw0 = p.rg_conv_w[(l * 4 + 0) * 256 + nblk * 64 + lane], cw1 = p.rg_conv_w[(l * 4 + 1) * 256 + nblk * 64 + lane];
  const float cw2 = p.rg_conv_w[(l * 4 + 2) * 256 + nblk * 64 + lane], cw3 = p.rg_conv_w[(l * 4 + 3) * 256 + nblk * 64 + lane];
  const float ccb = p.rg_conv_b[l * 256 + nblk * 64 + lane];
  bf16x8 wf[2][2][4];
#pragma unroll
  for (int gate = 0; gate < 2; ++gate) {
    const u16* wp = p.rgW + (size_t)(((l * 2 + gate) * 2 + dir) * 4 + nblk) * 4096 + l31 * 64 + 8 * hh;
#pragma unroll
    for (int nt = 0; nt < 2; ++nt)
#pragma unroll
      for (int s = 0; s < 4; ++s) wf[gate][nt][s] = *(const bf16x8*)(wp + nt * 2048 + 16 * s);
  }
  float cba[2], cbx[2], csp[2];
#pragma unroll
  for (int nt = 0; nt < 2; ++nt) {
    const int ch = (l * 2 + dir) * 256 + nblk * 64 + nt * 32 + l31;
    cba[nt] = p.rg_ba[ch];
    cbx[nt] = p.rg_bx[ch];
    csp[nt] = p.rg_lambda[ch];
  }
  float2* agg1 = (float2*)p.agg;
  float2* agg2 = (float2*)p.agg + (size_t)8 * 2 * 136 * 256;
  const int pos2 = dir ? (seg == 0 ? 1 - blk : 33 - blk) : (seg == 0 ? blk : 2 + blk);
  float hin = 0.f;
  uint4 gq[2];
  if (mode == 1) {
    const float2* a2 = agg2 + ((size_t)(b * 2 + dir) * 34) * 256 + nblk * 64 + lane;
    const float2* a1 = agg1 + ((size_t)(b * 2 + dir) * 136 + (cg32 - ck)) * 256 + nblk * 64 + lane;
    const int npre = dir ? 3 - ck : ck;
    float2 ga[34], gb[3];
    const int pm1 = pos2 > 0 ? pos2 - 1 : 0;
#pragma unroll
    for (int j = 0; j < 34; ++j) ga[j] = a2[(size_t)(j < pm1 ? j : pm1) * 256];
#pragma unroll
    for (int i = 0; i < 3; ++i) { const int ii = i < npre ? i : 0; gb[i] = a1[(size_t)(dir ? 3 - ii : ii) * 256]; }
    {
      const int tok = 16 * dir + (lane >> 2), c16 = (lane & 3) * 16;
      const u16* gp = p.rg + ((size_t)tokbase + T0 + tok) * 512 + 256 + nblk * 64 + c16;
      gq[0] = *(const uint4*)gp; gq[1] = *(const uint4*)(gp + 8);
    }
#pragma unroll
    for (int j = 0; j < 34; ++j) hin = (j < pos2) ? ga[j].x * hin + ga[j].y : hin;
#pragma unroll
    for (int i = 0; i < 3; ++i) hin = (i < npre) ? gb[i].x * hin + gb[i].y : hin;
  }
  float Av[2][16], Bv[2][16];
  uint4* abase = (uint4*)p.xn + ((size_t)((bq * 4 + nblk) * 8 + wid) * 8) * 64 + lane;
  if (mode == 0) {
#pragma unroll
  for (int nt = 0; nt < 2; ++nt) csp[nt] = __logf(1.0f + __expf(-csp[nt]));
#pragma unroll
  for (int i = 0; i < 5; ++i) {
    const int idx = lane + 64 * i;
    const int row = idx >> 3, chunk = idx & 7;
    if (row < 35) *(uint4*)(xs + row * 64 + chunk * 8) = xt[i];
  }
  asm volatile("s_waitcnt lgkmcnt(0)" ::: "memory");
  {
    float x0 = bf2f(xs[0 * 64 + lane]), x1 = bf2f(xs[1 * 64 + lane]), x2 = bf2f(xs[2 * 64 + lane]);
#pragma unroll
    for (int t = 0; t < 32; ++t) {
      const float x3 = bf2f(xs[(t + 3) * 64 + lane]);
      const float xc = ccb + cw0 * x0 + cw1 * x1 + cw2 * x2 + cw3 * x3;
      xcf[t * 68 + lane] = xc;
      *(u16*)(xcb + swz128(t, lane >> 3) + (lane & 7) * 2) = f2bf(xc);
      x0 = x1; x1 = x2; x2 = x3;
    }
  }
  asm volatile("s_waitcnt lgkmcnt(0)" ::: "memory");
  {
    f32x16 acc[2][2];
#pragma unroll
    for (int gate = 0; gate < 2; ++gate)
#pragma unroll
      for (int nt = 0; nt < 2; ++nt) acc[gate][nt] = zero16();
#pragma unroll
    for (int s = 0; s < 4; ++s) {
      const bf16x8 af = *(const bf16x8*)(xcb + swz128(l31, 2 * s + hh));
#pragma unroll
      for (int gate = 0; gate < 2; ++gate)
#pragma unroll
        for (int nt = 0; nt < 2; ++nt) acc[gate][nt] = mfma32(af, wf[gate][nt][s], acc[gate][nt]);
    }
#pragma unroll
    for (int nt = 0; nt < 2; ++nt)
#pragma unroll
      for (int e = 0; e < 16; ++e) {
        const int tok = (e & 3) + 8 * (e >> 2) + 4 * hh;
        const float r = sigmoidf_(acc[0][nt][e] + cba[nt]);
        const float ii = sigmoidf_(acc[1][nt][e] + cbx[nt]);
        const float la = -8.0f * r * csp[nt];
        const float e2 = 2.0f * la;
        const float om = (e2 > -0.1f) ? (-e2 * (1.0f + e2 * (0.5f + e2 * (0.16666667f + e2 * 0.041666668f)))) : (1.0f - __expf(e2));
        const float dm = (la > -0.1f) ? (-la * (1.0f + la * (0.5f + la * (0.16666667f + la * 0.041666668f)))) : (1.0f - __expf(la));
        Av[nt][e] = dm;
        Bv[nt][e] = sqrtf(om) * ii * xcf[tok * 68 + nt * 32 + l31];
      }
  }
#pragma unroll
    for (int k = 0; k < 8; ++k) {
      unsigned w[4];
#pragma unroll
      for (int q = 0; q < 4; ++q) {
        const int j = 4 * k + q, nt = j >> 4, e = j & 15;
        w[q] = pk2(Av[nt][e], Bv[nt][e]);
        Av[nt][e] = 1.0f - bflo(w[q]);
        Bv[nt][e] = bfhi(w[q]);
      }
      abase[(size_t)k * 64] = make_uint4(w[0], w[1], w[2], w[3]);
    }
  } else {
#pragma unroll
    for (int k = 0; k < 8; ++k) {
      const uint4 w4 = abase[(size_t)k * 64];
      const unsigned w[4] = {w4.x, w4.y, w4.z, w4.w};
#pragma unroll
      for (int q = 0; q < 4; ++q) {
        const int j = 4 * k + q, nt = j >> 4, e = j & 15;
        Av[nt][e] = 1.0f - bflo(w[q]);
        Bv[nt][e] = bfhi(w[q]);
      }
    }
  }
  float H[2][16];
#pragma unroll
  for (int nt = 0; nt < 2; ++nt)
#pragma unroll
    for (int e = 0; e < 16; ++e) H[nt][e] = 0.f;
  float carry[2] = {0.f, 0.f};
  if (mode == 0) {
    if (dir) rg_scan32<1>(Av, Bv, carry, H, hh); else rg_scan32<0>(Av, Bv, carry, H, hh);
    float P[2];
#pragma unroll
    for (int nt = 0; nt < 2; ++nt) {
      float pr = 1.f;
#pragma unroll
      for (int e = 0; e < 16; ++e) pr *= Av[nt][e];
      P[nt] = pr * shx(pr, 32);
    }
    const float2 mine = make_float2(hh ? P[1] : P[0], hh ? carry[1] : carry[0]);
    agg1[((size_t)(b * 2 + dir) * 136 + cg32) * 256 + nblk * 64 + lane] = mine;
    blockagg[(ck * 2 + dir) * 64 + lane] = mine;
    __syncthreads();
    if (wid < 2) {
      const int d2 = wid;
      float A = 1.f, B = 0.f;
#pragma unroll
      for (int co = 0; co < 4; ++co) {
        const int c = d2 ? 3 - co : co;
        const float2 g = blockagg[(c * 2 + d2) * 64 + lane];
        B = g.x * B + g.y;
        A *= g.x;
      }
      const int p2 = d2 ? (seg == 0 ? 1 - blk : 33 - blk) : (seg == 0 ? blk : 2 + blk);
      agg2[((size_t)(b * 2 + d2) * 34 + p2) * 256 + nblk * 64 + lane] = make_float2(A, B);
    }
    __syncthreads();
    return;
  }
  carry[0] = shf(hin, l31);
  carry[1] = shf(hin, 32 + l31);
  if (dir) rg_scan32<1>(Av, Bv, carry, H, hh); else rg_scan32<0>(Av, Bv, carry, H, hh);
  asm volatile("s_waitcnt lgkmcnt(0)" ::: "memory");
#pragma unroll
  for (int nt = 0; nt < 2; ++nt)
#pragma unroll
    for (int e = 0; e < 16; ++e) xcf[((e & 3) + 8 * (e >> 2) + 4 * hh) * 68 + nt * 32 + l31] = H[nt][e];
  __syncthreads();
  {
    const float* hfT = (const float*)(smem + (ck * 2 + 0) * 17408 + 8704);
    const float* hbT = (const float*)(smem + (ck * 2 + 1) * 17408 + 8704);
    const int tok = 16 * dir + (lane >> 2), c16 = (lane & 3) * 16;
    const size_t gtok = (size_t)tokbase + T0 + tok;
    u16* op = p.ycat + gtok * 1024 + 768 + nblk * 64 + c16;
#pragma unroll
    for (int hv = 0; hv < 2; ++hv) {
      const uint4 g = gq[hv];
      const float4 f0 = *(const float4*)(hfT + tok * 68 + c16 + hv * 8), f1 = *(const float4*)(hfT + tok * 68 + c16 + hv * 8 + 4);
      const float4 h0 = *(const float4*)(hbT + tok * 68 + c16 + hv * 8), h1 = *(const float4*)(hbT + tok * 68 + c16 + hv * 8 + 4);
      uint4 o;
      o.x = pk2((f0.x + h0.x) * gelu_tanh(bflo(g.x)), (f0.y + h0.y) * gelu_tanh(bfhi(g.x)));
      o.y = pk2((f0.z + h0.z) * gelu_tanh(bflo(g.y)), (f0.w + h0.w) * gelu_tanh(bfhi(g.y)));
      o.z = pk2((f1.x + h1.x) * gelu_tanh(bflo(g.z)), (f1.y + h1.y) * gelu_tanh(bfhi(g.z)));
      o.w = pk2((f1.z + h1.z) * gelu_tanh(bflo(g.w)), (f1.w + h1.w) * gelu_tanh(bfhi(g.w)));
      *(uint4*)(op + hv * 8) = o;
    }
  }
  __syncthreads();
}

__device__ __forceinline__ void attn_wave(const P& p, int l, int b, int h, bool local, int r, int half, int qtok0, const float* rpbL) {
  const int lane = opaque_tid() & 63, q = lane & 31, hh = lane >> 5;
  bf16x8 qf[4];
  {
    const u16* qp = p.qk + (size_t)(qtok0 + q) * 1024 + h * 64 + 8 * hh;
#pragma unroll
    for (int s = 0; s < 4; ++s) qf[s] = *(const bf16x8*)(qp + 16 * s);
  }
  f32x16 o0 = zero16(), o1 = zero16();
  float m_run = -1e30f, l_run = 0.f;
  const int pi = (q & 19) | ((q & 4) << 1) | ((q & 8) >> 1);
  const int w = half * 32 + q;
  const int st = min(max(w - 8, 0), 48);
  const int rs = min(max(r - 4, 0), 56);
  const int ntiles = local ? 24 : 8;
  bf16x8 kfn[4], vfn[2][2];
  auto tile_load = [&](int ti, bf16x8 (&kfo)[4], bf16x8 (&vfo)[2][2]) {
    int ktok0, vstride;
    const u16* vb;
    if (ti < 8) {
      ktok0 = NLAT + b * 256 + ti * 32;
      vb = p.vTc + ((size_t)(b * 512 + h * 64)) * 256 + ti * 32;
      vstride = 256;
    } else {
      const int tl = ti - 8;
      const int a2 = tl >> 1, g2 = tl & 1;
      ktok0 = b * 4096 + (rs + a2) * 64 + g2 * 32;
      vb = p.vT + ((size_t)(b * 512 + h * 64)) * 4096 + (rs + a2) * 64 + g2 * 32;
      vstride = 4096;
    }
    const u16* kp = p.qk + (size_t)(ktok0 + pi) * 1024 + 512 + h * 64 + 8 * hh;
#pragma unroll
    for (int s = 0; s < 4; ++s) kfo[s] = *(const bf16x8*)(kp + 16 * s);
#pragma unroll
    for (int dt = 0; dt < 2; ++dt)
#pragma unroll
      for (int s2 = 0; s2 < 2; ++s2) vfo[dt][s2] = *(const bf16x8*)(vb + (size_t)(dt * 32 + q) * vstride + 16 * s2 + 8 * hh);
  };
  tile_load(0, kfn, vfn);
  for (int ti = 0; ti < ntiles; ++ti) {
    int a = 0, g = 0;
    if (ti >= 8) { a = (ti - 8) >> 1; g = (ti - 8) & 1; }
    bf16x8 kf[4], vf[2][2];
#pragma unroll
    for (int s = 0; s < 4; ++s) kf[s] = kfn[s];
#pragma unroll
    for (int dt = 0; dt < 2; ++dt)
#pragma unroll
      for (int s2 = 0; s2 < 2; ++s2) vf[dt][s2] = vfn[dt][s2];
    if (ti + 1 < ntiles) tile_load(ti + 1, kfn, vfn);
    f32x16 sacc = zero16();
#pragma unroll
    for (int s = 0; s < 4; ++s) sacc = mfma32(kf[s], qf[s], sacc);
    float sv[16];
    float tmax = -1e30f;
#pragma unroll
    for (int e = 0; e < 16; ++e) {
      float x = sacc[e] * 0.125f;
      if (ti >= 8) {
        const int kc = g * 32 + (e & 7) + 8 * hh + 16 * (e >> 3);
        const bool valid = (kc >= st) && (kc < st + 16);
        const int bi = valid ? ((rs + a - r + 7) * 31 + (kc - w + 15)) : 0;
        const float bias = rpbL[bi];
        x = valid ? (x + bias) : -1e30f;
      }
      sv[e] = x;
      tmax = fmaxf(tmax, x);
    }
    tmax = fmaxf(tmax, shx(tmax, 32));
    const float m_new = fmaxf(m_run, tmax);
    const float alpha = __expf(m_run - m_new);
    m_run = m_new;
    l_run *= alpha;
#pragma unroll
    for (int e = 0; e < 16; ++e) { o0[e] *= alpha; o1[e] *= alpha; }
    float psum = 0.f;
#pragma unroll
    for (int e = 0; e < 16; ++e) { const float pe = __expf(sv[e] - m_new); sv[e] = pe; psum += pe; }
    l_run += psum;
    bf16x8 pf[2];
#pragma unroll
    for (int s2 = 0; s2 < 2; ++s2) {
      union { bf16x8 v; unsigned u[4]; } cv;
#pragma unroll
      for (int j = 0; j < 4; ++j) cv.u[j] = pk2(sv[8 * s2 + 2 * j], sv[8 * s2 + 2 * j + 1]);
      pf[s2] = cv.v;
    }
#pragma unroll
    for (int s2 = 0; s2 < 2; ++s2) {
      o0 = mfma32(vf[0][s2], pf[s2], o0);
      o1 = mfma32(vf[1][s2], pf[s2], o1);
    }
  }
  const float lt = l_run + shx(l_run, 32);
  const float inv = 1.0f / lt;
  u16* op = p.ycat + (size_t)(qtok0 + q) * 1024 + h * 64;
#pragma unroll
  for (int qd = 0; qd < 4; ++qd) {
    uint2 a0, a1;
    a0.x = pk2(o0[4 * qd] * inv, o0[4 * qd + 1] * inv);
    a0.y = pk2(o0[4 * qd + 2] * inv, o0[4 * qd + 3] * inv);
    a1.x = pk2(o1[4 * qd] * inv, o1[4 * qd + 1] * inv);
    a1.y = pk2(o1[4 * qd + 2] * inv, o1[4 * qd + 3] * inv);
    *(uint2*)(op + 8 * qd + 4 * hh) = a0;
    *(uint2*)(op + 32 + 8 * qd + 4 * hh) = a1;
  }
}
__device__ __forceinline__ void attn_block_task(const P& p, int l, int b, int h, int rg4, char* smem) {
  const int tid = opaque_tid(), lane = tid & 63, wid = tid >> 6;
  const int q = lane & 31, hh = lane >> 5;
  const int R0 = rg4 * 4;
  const int r = R0 + (wid >> 1), half = wid & 1;
  float* rpbL = (float*)(smem + 32768) + 64;
  for (int i = tid; i < 465; i += NTHR) rpbL[i] = p.na_rpb[(size_t)(l * 8 + h) * 465 + i] * 1.4426950408889634f;
  const int lo = min(max(R0 - 4, 0), 56);
  const int hi = min(max(R0 + 3 - 4, 0), 56) + 7;
  const int ntile = 4 + (hi - lo + 1);
  const int rs = min(max(r - 4, 0), 56);
  const int qtok = b * 4096 + r * 64 + half * 32 + q;
  bf16x8 qf[4];
  {
    const u16* qp = p.qk + (size_t)qtok * 1024 + h * 64 + 8 * hh;
#pragma unroll
    for (int s = 0; s < 4; ++s) qf[s] = *(const bf16x8*)(qp + 16 * s);
  }
  f32x16 o0 = zero16(), o1 = zero16();
  float m_run = -1e30f, l_run = 0.f;
  const int pi = (q & 19) | ((q & 4) << 1) | ((q & 8) >> 1);
  const int w = half * 32 + q;
  const int st = min(max(w - 8, 0), 48);
  unsigned vmask = 0u;
#pragma unroll
  for (int g = 0; g < 2; ++g)
#pragma unroll
    for (int e = 0; e < 16; ++e) {
      const int kc = g * 32 + (e & 7) + 8 * hh + 16 * (e >> 3);
      vmask |= ((kc >= st) && (kc < st + 16)) ? (1u << (g * 16 + e)) : 0u;
    }
  const int cbase = 8 * hh - w + 15;
  const int srow = tid >> 3, sch = tid & 7;
  uint4 rkA, rvA, rkB, rvB;
  auto gload = [&](int ti, uint4& rk, uint4& rv) {
    int ktok0, vstride;
    const u16* vb;
    if (ti < 4) { ktok0 = NLAT + b * 256 + ti * 64; vb = p.vTc + ((size_t)(b * 512 + h * 64)) * 256 + ti * 64; vstride = 256; }
    else { const int R = lo + ti - 4; ktok0 = b * 4096 + R * 64; vb = p.vT + ((size_t)(b * 512 + h * 64)) * 4096 + R * 64; vstride = 4096; }
    rk = *(const uint4*)(p.qk + (size_t)(ktok0 + srow) * 1024 + 512 + h * 64 + sch * 8);
    rv = *(const uint4*)(vb + (size_t)srow * vstride + sch * 8);
  };
  gload(0, rkA, rvA);
  *(uint4*)(smem + swz128(srow, sch)) = rkA;
  *(uint4*)(smem + 16384 + swz128(srow, sch)) = rvA;
  gload(1, rkA, rvA);
  if (2 < ntile) gload(2, rkB, rvB);
  __syncthreads();
  auto compute = [&](int ti) {
    const char* Kb = smem + (ti & 1) * 8192;
    const char* Vb = smem + 16384 + (ti & 1) * 8192;
    const int R = lo + ti - 4;
    const bool active = (ti < 4) || (R >= rs && R < rs + 8);
    if (active) {
      f32x16 sacc0 = zero16(), sacc1 = zero16();
#pragma unroll
      for (int s = 0; s < 4; ++s) {
        const bf16x8 kf0 = *(const bf16x8*)(Kb + swz128(pi, 2 * s + hh));
        const bf16x8 kf1 = *(const bf16x8*)(Kb + swz128(32 + pi, 2 * s + hh));
        sacc0 = mfma32(kf0, qf[s], sacc0);
        sacc1 = mfma32(kf1, qf[s], sacc1);
      }
      float sv[32];
      float tmax = -1e30f;
      if (ti >= 4) {
        const float* brow = rpbL + (R - r + 7) * 31 + cbase;
        float bias[32];
#pragma unroll
        for (int g = 0; g < 2; ++g)
#pragma unroll
          for (int e = 0; e < 16; ++e) bias[g * 16 + e] = brow[g * 32 + (e & 7) + 16 * (e >> 3)];
#pragma unroll
        for (int g = 0; g < 2; ++g)
#pragma unroll
          for (int e = 0; e < 16; ++e) {
            const float sc = g ? sacc1[e] : sacc0[e];
            const float x = ((int)(vmask << (31 - (g * 16 + e))) < 0) ? fmaf(sc, 0.18033688011112042f, bias[g * 16 + e]) : -1e30f;
            sv[g * 16 + e] = x;
            tmax = fmaxf(tmax, x);
          }
      } else {
#pragma unroll
        for (int g = 0; g < 2; ++g)
#pragma unroll
          for (int e = 0; e < 16; ++e) {
            const float x = (g ? sacc1[e] : sacc0[e]) * 0.18033688011112042f;
            sv[g * 16 + e] = x;
            tmax = fmaxf(tmax, x);
          }
      }
      tmax = fmaxf(tmax, shx(tmax, 32));
      if (__builtin_amdgcn_ballot_w64(tmax > m_run) != 0ull) {
        const float m_new = fmaxf(m_run, tmax);
        const float alpha = __builtin_amdgcn_exp2f(m_run - m_new);
        m_run = m_new;
        l_run *= alpha;
#pragma unroll
        for (int e = 0; e < 16; ++e) { o0[e] *= alpha; o1[e] *= alpha; }
      }
      float psum = 0.f;
#pragma unroll
      for (int e = 0; e < 32; ++e) { const float pe = __builtin_amdgcn_exp2f(sv[e] - m_run); sv[e] = pe; psum += pe; }
      l_run += psum;
#pragma unroll
      for (int g = 0; g < 2; ++g)
#pragma unroll
        for (int s2 = 0; s2 < 2; ++s2) {
          union { bf16x8 v; unsigned u[4]; } cv;
#pragma unroll
          for (int j = 0; j < 4; ++j) cv.u[j] = pk2(sv[g * 16 + 8 * s2 + 2 * j], sv[g * 16 + 8 * s2 + 2 * j + 1]);
          const bf16x8 v0 = *(const bf16x8*)(Vb + swz128(q, g * 4 + 2 * s2 + hh));
          const bf16x8 v1 = *(const bf16x8*)(Vb + swz128(32 + q, g * 4 + 2 * s2 + hh));
          o0 = mfma32(v0, cv.v, o0);
          o1 = mfma32(v1, cv.v, o1);
        }
    }
  };
  for (int ti = 0; ti < ntile; ti += 2) {
    compute(ti);
    if (ti + 1 < ntile) {
      *(uint4*)(smem + 8192 + swz128(srow, sch)) = rkA;
      *(uint4*)(smem + 16384 + 8192 + swz128(srow, sch)) = rvA;
      if (ti + 3 < ntile) gload(ti + 3, rkA, rvA);
    }
    __syncthreads();
    if (ti + 1 < ntile) {
      compute(ti + 1);
      if (ti + 2 < ntile) {
        *(uint4*)(smem + swz128(srow, sch)) = rkB;
        *(uint4*)(smem + 16384 + swz128(srow, sch)) = rvB;
        if (ti + 4 < ntile) gload(ti + 4, rkB, rvB);
      }
      __syncthreads();
    }
  }
  const float lt = l_run + shx(l_run, 32);
  const float inv = 1.0f / lt;
  __syncthreads();
  {
    char* ot = smem + wid * 4608;
#pragma unroll
    for (int qd = 0; qd < 4; ++qd) {
      uint2 a0, a1;
      a0.x = pk2(o0[4 * qd] * inv, o0[4 * qd + 1] * inv);
      a0.y = pk2(o0[4 * qd + 2] * inv, o0[4 * qd + 3] * inv);
      a1.x = pk2(o1[4 * qd] * inv, o1[4 * qd + 1] * inv);
      a1.y = pk2(o1[4 * qd + 2] * inv, o1[4 * qd + 3] * inv);
      *(uint2*)(ot + q * 144 + (8 * qd + 4 * hh) * 2) = a0;
      *(uint2*)(ot + q * 144 + (32 + 8 * qd + 4 * hh) * 2) = a1;
    }
    asm volatile("s_waitcnt lgkmcnt(0)" ::: "memory");
    const int tok0 = b * 4096 + r * 64 + half * 32;
#pragma unroll
    for (int it = 0; it < 4; ++it) {
      const int qq = it * 8 + (lane >> 3), ch = lane & 7;
      const uint4 v = *(const uint4*)(ot + qq * 144 + ch * 16);
      *(uint4*)(p.ycat + (size_t)(tok0 + qq) * 1024 + h * 64 + ch * 8) = v;
    }
  }
  __syncthreads();
}
__device__ __forceinline__ void attn_task(const P& p, int l, int kind, int idx, char* smem) {
  const int tid_ = opaque_tid(); const int lane = tid_ & 63, wid = tid_ >> 6;
  float* rpbL = (float*)smem + wid * 480;
  for (int i = lane; i < 465; i += 64) rpbL[i] = p.na_rpb[(size_t)(l * 8 + wid) * 465 + i];
  __syncthreads();
  if (kind == 0) {
    const int half = idx & 1, r = (idx >> 1) & 63, b = idx >> 7;
    attn_wave(p, l, b, wid, true, r, half, b * 4096 + r * 64 + half * 32, rpbL);
  } else {
    const int qg = idx & 7, b = idx >> 3;
    attn_wave(p, l, b, wid, false, 0, 0, NLAT + b * 256 + qg * 32, rpbL);
  }
  __syncthreads();
}

__device__ __forceinline__ void phase_mixers(const P& p, int l, char* smem, unsigned* counter) {
  const bool last = (l == 1);
  const int n_rg = 1088 * XRGA, n_fft = 1024 * XFFT, n_hc = last ? 0 : 256, n_att = 1024 * XATT, n_attc = last ? 0 : 64;
  const int total = n_rg + n_fft + n_hc + n_att + n_attc;
  volatile int* s_taskp = (volatile int*)(smem + SMEM_BYTES - 16);
  for (;;) {
    __syncthreads();
    if (threadIdx.x == 0) *s_taskp = (int)atomicAdd(counter, 1u);
    __syncthreads();
    int t = *s_taskp;
    if (t >= total) break;
    if (t < n_att) { t &= 1023; attn_block_task(p, l, t >> 7, (t >> 4) & 7, t & 15, smem); continue; }
    t -= n_att;
    if (t < n_attc) { attn_task(p, l, 1, t, smem); continue; }
    t -= n_attc;
    if (t < n_fft) { t &= 1023; hyena_fft_task(p, l, t >> 2, t & 3, smem); continue; }
    t -= n_fft;
    if (t < n_hc) { hyena_ctx_task(p, l, t >> 5, t & 31, smem); continue; }
    t -= n_hc;
    if (t >= 1088) t -= 1088;
    rg_wave_task(p, l, t >> 2, t & 3, 0, last, smem);
  }
}

__device__ __forceinline__ void merge_tile(const P& p, int l, int mt, int nt, char* smem) {
  EPI_VARS
  const int m0 = mt * 256, n0 = nt * 128;
  f32x16 macc[2][2];
  zero_acc(macc);
  for (int br = 0; br < 3; ++br) {
    unsigned* gpl = (unsigned*)(smem + 98304) + tid;
    {
      f32x16 acc[2][2];
      zero_acc(acc);
      gemm_kloop(acc, p.xn + (size_t)m0 * 1024, 1024, p.WgT + ((size_t)l * 3072 + br * 1024 + n0) * 1024, 1024, 1024, smem);
#pragma unroll
      for (int j = 0; j < 2; ++j) {
        const float bg = p.b_gate[l * 3072 + br * 1024 + n0 + EPI_COL(j)];
#pragma unroll
        for (int i = 0; i < 2; ++i)
#pragma unroll
          for (int e = 0; e < 4; ++e) {
            const unsigned q0 = (unsigned)(sigmoidf_(acc[i][j][4 * e] + bg) * 255.0f + 0.5f);
            const unsigned q1 = (unsigned)(sigmoidf_(acc[i][j][4 * e + 1] + bg) * 255.0f + 0.5f);
            const unsigned q2 = (unsigned)(sigmoidf_(acc[i][j][4 * e + 2] + bg) * 255.0f + 0.5f);
            const unsigned q3 = (unsigned)(sigmoidf_(acc[i][j][4 * e + 3] + bg) * 255.0f + 0.5f);
            gpl[((i * 2 + j) * 4 + e) * 512] = q0 | (q1 << 8) | (q2 << 16) | (q3 << 24);
          }
      }
    }
    {
      f32x16 acc[2][2];
      zero_acc(acc);
      const u16* A; const u16* B; int K;
      if (br == 0) { A = p.ycat + (size_t)m0 * 1024; B = p.WaT + ((size_t)l * 1024 + n0) * 512; K = 512; }
      else if (br == 1) { A = p.ycat + (size_t)m0 * 1024 + 512; B = p.WbT + ((size_t)l * 1024 + n0) * 256; K = 256; }
      else { A = p.ycat + (size_t)m0 * 1024 + 768; B = p.WcT + ((size_t)l * 1024 + n0) * 256; K = 256; }
      gemm_kloop(acc, A, 1024, B, K, K, smem);
#pragma unroll
      for (int i = 0; i < 2; ++i)
#pragma unroll
        for (int j = 0; j < 2; ++j)
#pragma unroll
          for (int e = 0; e < 4; ++e) {
            const unsigned g4 = gpl[((i * 2 + j) * 4 + e) * 512];
            macc[i][j][4 * e] += (float)(g4 & 255u) * (1.0f / 255.0f) * acc[i][j][4 * e];
            macc[i][j][4 * e + 1] += (float)((g4 >> 8) & 255u) * (1.0f / 255.0f) * acc[i][j][4 * e + 1];
            macc[i][j][4 * e + 2] += (float)((g4 >> 16) & 255u) * (1.0f / 255.0f) * acc[i][j][4 * e + 2];
            macc[i][j][4 * e + 3] += (float)(g4 >> 24) * (1.0f / 255.0f) * acc[i][j][4 * e + 3];
          }
    }
  }
#pragma unroll
  for (int i = 0; i < 2; ++i)
#pragma unroll
    for (int j = 0; j < 2; ++j)
#pragma unroll
      for (int e = 0; e < 16; ++e)
        p.mbuf[(size_t)(m0 + EPI_ROW(i, e)) * 1024 + n0 + EPI_COL(j)] = f2bf(macc[i][j][e]);
}
__device__ __forceinline__ void outproj_tile(const P& p, int l, int mt, int nt, char* smem, bool do_store) {
  EPI_VARS
  const int m0 = mt * 256, n0 = nt * 128;
  f32x16 acc[2][2];
  zero_acc(acc);
  gemm_kloop(acc, p.mbuf + (size_t)m0 * 1024, 1024, p.WoT + ((size_t)l * 1024 + n0) * 1024, 1024, 1024, smem);
  const bool isctx = (mt >= 128);
  const int bi = isctx ? 8 : (mt >> 4);
  const float* gatev = p.mod + ((size_t)(l * 9 + bi) * 6 + 2) * 1024;
  const float* src; float* dst;
  if (isctx) { src = (l == 0 ? p.ctx : p.ctxs) - (size_t)NLAT * 1024; dst = p.ctxs - (size_t)NLAT * 1024; }
  else { src = (l == 0 ? p.x : p.out); dst = p.out; }
#pragma unroll
  for (int j = 0; j < 2; ++j) {
    const int col = n0 + EPI_COL(j);
    const float gv = gatev[col];
#pragma unroll
    for (int i = 0; i < 2; ++i)
#pragma unroll
      for (int e = 0; e < 16; ++e) {
        const size_t o = (size_t)(m0 + EPI_ROW(i, e)) * 1024 + col;
        if (do_store) dst[o] = src[o] + gv * acc[i][j][e];
      }
  }
}

__device__ __forceinline__ void wqk_task(const P& p, int l, int hp, int nt, char* smem) {
  EPI_VARS
  f32x16 acc[2][2];
  zero_acc(acc);
  gemm_kloop(acc, p.keysB + ((size_t)l * 16 + hp) * 16384, 128, p.WqB + (size_t)l * 1024 * 2048 + (size_t)(nt * 128) * 2048 + hp * 128, 2048, 128, smem);
  if (wm < 2) {
#pragma unroll
    for (int i = 0; i < 2; ++i)
#pragma unroll
      for (int j = 0; j < 2; ++j)
#pragma unroll
        for (int e = 0; e < 16; ++e)
          p.WqkT[((size_t)l * 2048 + hp * 128 + EPI_ROW(i, e)) * 1024 + nt * 128 + EPI_COL(j)] = f2bf(acc[i][j][e]);
  }
}
__device__ __forceinline__ void ins16(unsigned (&L)[16], unsigned x) {
#pragma unroll
  for (int i = 0; i < 16; ++i) {
    const unsigned hi = max(L[i], x);
    x = min(L[i], x);
    L[i] = hi;
  }
}
__device__ __forceinline__ unsigned f2sort(float f) {
  const unsigned b = __float_as_uint(f);
  return b ^ ((unsigned)((int)b >> 31) | 0x80000000u);
}
__device__ __forceinline__ float sort2f(unsigned k) {
  const unsigned u = k & ~127u;
  const unsigned b = (u & 0x80000000u) ? (u ^ 0x80000000u) : ~u;
  return __uint_as_float(b);
}
__device__ __forceinline__ void cx_desc(unsigned& a, unsigned& b) { const unsigned hi = max(a, b), lo = min(a, b); a = hi; b = lo; }
template <int BASE> __device__ __forceinline__ void sort16_desc(unsigned (&k)[64]) {
#pragma unroll
  for (int sz = 2; sz <= 16; sz <<= 1) {
#pragma unroll
    for (int j = sz >> 1; j >= 1; j >>= 1) {
#pragma unroll
      for (int i = 0; i < 16; ++i) {
        const int l2 = i ^ j;
        if (l2 > i) {
          if ((i & sz) == 0) cx_desc(k[BASE + i], k[BASE + l2]);
          else cx_desc(k[BASE + l2], k[BASE + i]);
        }
      }
    }
  }
}
template <int AB, int BB> __device__ __forceinline__ void merge16_desc(unsigned (&k)[64]) {
#pragma unroll
  for (int i = 0; i < 16; ++i) k[AB + i] = max(k[AB + i], k[BB + 15 - i]);
#pragma unroll
  for (int j = 8; j >= 1; j >>= 1) {
#pragma unroll
    for (int i = 0; i < 16; ++i)
      if ((i & j) == 0) cx_desc(k[AB + i], k[AB + i + j]);
  }
}
#define PS_LOAD(mt_, hp_) do { _Pragma("unroll") for (int it = 0; it < 8; ++it) { const int id = tid + NTHR * it; \
    pre[it] = *(const uint4*)(p.q + (size_t)((mt_) * 256 + (id >> 4)) * 2048 + (hp_) * 128 + (id & 15) * 8); } } while (0)
__device__ __forceinline__ void peer_score_tile(const P& p, int l, int mt, int hp, char* smem, uint4& p0, uint4& p1, uint4& p2, uint4& p3, uint4& p4, uint4& p5, uint4& p6, uint4& p7, int nmt, int nhp) {
  const int tid = opaque_tid();
  const int m0 = mt * 256;
  const int row = tid >> 1, hf = tid & 1;
  {
    char* T = smem + 16384;
    uint4 pre[8] = {p0, p1, p2, p3, p4, p5, p6, p7};
#pragma unroll
    for (int it = 0; it < 8; ++it) {
      const int id = tid + NTHR * it;
      const int r = id >> 4, ch = id & 15;
      *(uint4*)(T + r * 272 + ch * 16) = pre[it];
    }
    PS_LOAD(nmt, nhp);
    p0 = pre[0]; p1 = pre[1]; p2 = pre[2]; p3 = pre[3]; p4 = pre[4]; p5 = pre[5]; p6 = pre[6]; p7 = pre[7];
  }
  __syncthreads();
  const char* sp = smem + 16384 + row * 272 + hf * 128;
  unsigned k[64];
#pragma unroll
  for (int c = 0; c < 8; ++c) {
    const uint4 r = *(const uint4*)(sp + 16 * c);
    const unsigned w[4] = {r.x, r.y, r.z, r.w};
#pragma unroll
    for (int q = 0; q < 4; ++q) {
      const float v0 = __builtin_bit_cast(_Float16, (unsigned short)(w[q] & 0xffffu));
      const float v1 = __builtin_bit_cast(_Float16, (unsigned short)(w[q] >> 16));
      const int key = hf * 64 + c * 8 + q * 2;
      k[c * 8 + q * 2] = (f2sort(v0) & ~127u) | (unsigned)key;
      k[c * 8 + q * 2 + 1] = (f2sort(v1) & ~127u) | (unsigned)(key + 1);
    }
  }
  sort16_desc<0>(k); sort16_desc<16>(k); sort16_desc<32>(k); sort16_desc<48>(k);
  merge16_desc<0, 16>(k);
  merge16_desc<32, 48>(k);
  merge16_desc<0, 32>(k);
  unsigned* X = (unsigned*)smem;
  if (hf) {
#pragma unroll
    for (int i = 0; i < 16; ++i) X[row * 16 + i] = k[i];
  }
  __syncthreads();
  if (!hf) {
#pragma unroll
    for (int i = 0; i < 16; ++i) k[16 + i] = X[row * 16 + i];
    merge16_desc<0, 16>(k);
    unsigned* o = p.topk + ((size_t)(m0 + row) * 16 + hp) * 16;
#pragma unroll
    for (int i = 0; i < 4; ++i) *(uint4*)(o + 4 * i) = make_uint4(k[4 * i], k[4 * i + 1], k[4 * i + 2], k[4 * i + 3]);
  }
  __syncthreads();
}

__device__ __forceinline__ void phase_peer_experts(const P& p, int l, bool do_store, char* smem) {
  const int tid_ = opaque_tid(); const int lane = tid_ & 63, wid = tid_ >> 6;
  const int ntok = (l == 1) ? NLAT : NTOK;
  int ci, cj;
  {
    const int e = lane;
    if (e < 16) { ci = 0; cj = e; }
    else if (e < 24) { ci = 1; cj = e - 16; }
    else if (e < 29) { ci = 2; cj = e - 24; }
    else if (e < 33) { ci = 3; cj = e - 29; }
    else if (e < 36) { ci = 4; cj = e - 33; }
    else if (e < 38) { ci = 5; cj = e - 36; }
    else if (e < 40) { ci = 6; cj = e - 38; }
    else if (e < 42) { ci = 7; cj = e - 40; }
    else { ci = min(8 + (e - 42), 15); cj = 0; }
  }
  for (int tok = blockIdx.x * 8 + wid; tok < ntok; tok += gridDim.x * 8) {
    float xr[16];
    {
      const uint4 a = *(const uint4*)(p.xn8 + (size_t)tok * 1024 + lane * 16);
      const float sx = p.sa[tok];
      const unsigned aw[4] = {a.x, a.y, a.z, a.w};
#pragma unroll
      for (int i = 0; i < 4; ++i) {
        xr[4 * i] = (float)((int)(aw[i] << 24) >> 24) * sx; xr[4 * i + 1] = (float)((int)(aw[i] << 16) >> 24) * sx;
        xr[4 * i + 2] = (float)((int)(aw[i] << 8) >> 24) * sx; xr[4 * i + 3] = (float)((int)aw[i] >> 24) * sx;
      }
    }
    typedef _Float16 h2_t __attribute__((ext_vector_type(2)));
    h2_t yh[8];
#pragma unroll
    for (int i = 0; i < 8; ++i) yh[i] = (h2_t){(_Float16)0, (_Float16)0};
    int* selw = (int*)(smem + wid * 4096);
    const unsigned* kvp = p.topk + (size_t)tok * 256 + (lane & 31);
#pragma unroll 1
    for (int hb = 0; hb < 8; hb += 4) {
      unsigned key[4]; int eidx[4];
#pragma unroll
      for (int u = 0; u < 4; ++u) {
        const unsigned kv = kvp[(hb + u) * 32];
        const unsigned k0 = shu(kv, ci);
        const unsigned k1 = shu(kv, 16 + cj);
        const float val = (lane < 50) ? (sort2f(k0) + sort2f(k1)) : -3.0e38f;
        eidx[u] = (int)((k0 & 127u) * 128u + (k1 & 127u));
        key[u] = (f2sort(val) & ~63u) | (unsigned)lane;
      }
#pragma unroll
      for (int k = 2; k <= 64; k <<= 1) {
#pragma unroll
        for (int j = k >> 1; j >= 1; j >>= 1) {
          const bool take_max = (((lane & j) == 0) == ((lane & k) == 0));
#pragma unroll
          for (int u = 0; u < 4; ++u) {
            unsigned ok;
            if (j == 1) ok = xorl<1>(key[u], lane); else if (j == 2) ok = xorl<2>(key[u], lane); else if (j == 4) ok = xorl<4>(key[u], lane);
            else if (j == 8) ok = xorl<8>(key[u], lane); else if (j == 16) ok = xorl<16>(key[u], lane); else ok = xorl<32>(key[u], lane);
            key[u] = take_max ? max(key[u], ok) : min(key[u], ok);
          }
        }
      }
#pragma unroll
      for (int u = 0; u < 4; ++u) {
        const int si = __builtin_amdgcn_ds_bpermute((int)(key[u] & 63u) << 2, eidx[u]);
        const unsigned ku = key[u] & ~63u;
        const float sv = __uint_as_float((ku & 0x80000000u) ? (ku ^ 0x80000000u) : ~ku);
        const float mx = __builtin_bit_cast(float, __builtin_amdgcn_readlane(__builtin_bit_cast(int, sv), 0));
        const float ex = (lane < 16) ? __builtin_amdgcn_exp2f((sv - mx) * 1.4426950408889634f) : 0.f;
        const float sm = wave_sum(ex);
        selw[(hb + u) * 64 + lane] = si;
        selw[512 + (hb + u) * 64 + lane] = __builtin_bit_cast(int, ex * __builtin_amdgcn_rcpf(sm));
      }
    }
    {
      int w[4];
#pragma unroll
      for (int i = 0; i < 4; ++i) {
        int t = __builtin_amdgcn_cvt_pk_fp8_f32(xr[4 * i], xr[4 * i + 1], 0, false);
        w[i] = __builtin_amdgcn_cvt_pk_fp8_f32(xr[4 * i + 2], xr[4 * i + 3], t, true);
      }
      *(uint4*)(smem + 32768 + wid * 1024 + lane * 16) = make_uint4((unsigned)w[0], (unsigned)w[1], (unsigned)w[2], (unsigned)w[3]);
    }
    asm volatile("s_waitcnt lgkmcnt(0)" ::: "memory");
    const int e15 = lane & 15, g4 = lane >> 4;
#pragma unroll 1
    for (int h = 0; h < 8; ++h) {
      const int eperm_h = selw[h * 64 + lane];
      const int gperm_h = selw[512 + h * 64 + lane];
      const int ide = (int)shu((unsigned)eperm_h, e15);
      const unsigned char* ub = p.Ub + (size_t)ide * 1024 + g4 * 16;
      uint4 ua[8];
#pragma unroll
      for (int sI = 0; sI < 8; ++sI) ua[sI] = *(const uint4*)(ub + sI * 64);
      pg8::f32x4 hacc = {0.f, 0.f, 0.f, 0.f};
#pragma unroll
      for (int sI = 0; sI < 8; ++sI) {
        const uint4 b0 = *(const uint4*)(smem + 32768 + wid * 1024 + sI * 128 + g4 * 16);
        const uint4 b1 = *(const uint4*)(smem + 32768 + wid * 1024 + sI * 128 + 64 + g4 * 16);
        const i32x8 A = {(int)ua[sI].x, (int)ua[sI].y, (int)ua[sI].z, (int)ua[sI].w, 0, 0, 0, 0};
        const i32x8 B = {(int)b0.x, (int)b0.y, (int)b0.z, (int)b0.w, (int)b1.x, (int)b1.y, (int)b1.z, (int)b1.w};
        hacc = __builtin_amdgcn_mfma_scale_f32_16x16x128_f8f6f4(A, B, hacc, 4  , 0  , 0, 0x7f7f7f7f, 0, 0x7f7f7f7f);
      }
      asm volatile("" ::: "memory");
      uint2 V[16];
#pragma unroll
      for (int k = 0; k < 16; ++k) {
        const int id = __builtin_amdgcn_readlane(eperm_h, k);
        V[k] = *(const uint2*)(p.Ub + (size_t)id * 1024 + 512 + lane * 8);
      }
      float actv[4];
#pragma unroll
      for (int r4 = 0; r4 < 4; ++r4) {
        const float gl = __builtin_bit_cast(float, shu((unsigned)gperm_h, 4 * g4 + r4));
        actv[r4] = gelu_tanh(hacc[r4] * (1.0f / 64.0f)) * gl;
      }
#pragma unroll
      for (int k = 0; k < 16; ++k) {
        const float ak = __builtin_bit_cast(float, __builtin_amdgcn_readlane(__builtin_bit_cast(int, actv[k & 3]), 16 * (k >> 2)));
        const h2_t akh = {(_Float16)ak, (_Float16)ak};
        const unsigned vw[2] = {V[k].x, V[k].y};
#pragma unroll
        for (int q2 = 0; q2 < 2; ++q2) {
          yh[4 * q2 + 0] = __builtin_elementwise_fma(akh, __builtin_bit_cast(h2_t, __builtin_amdgcn_cvt_scalef32_pk_f16_fp4(vw[q2], 1.0f, 0)), yh[4 * q2 + 0]);
          yh[4 * q2 + 1] = __builtin_elementwise_fma(akh, __builtin_bit_cast(h2_t, __builtin_amdgcn_cvt_scalef32_pk_f16_fp4(vw[q2], 1.0f, 1)), yh[4 * q2 + 1]);
          yh[4 * q2 + 2] = __builtin_elementwise_fma(akh, __builtin_bit_cast(h2_t, __builtin_amdgcn_cvt_scalef32_pk_f16_fp4(vw[q2], 1.0f, 2)), yh[4 * q2 + 2]);
          yh[4 * q2 + 3] = __builtin_elementwise_fma(akh, __builtin_bit_cast(h2_t, __builtin_amdgcn_cvt_scalef32_pk_f16_fp4(vw[q2], 1.0f, 3)), yh[4 * q2 + 3]);
        }
      }
    }
    float yacc[16];
#pragma unroll
    for (int i = 0; i < 8; ++i) { yacc[2 * i] = (float)yh[i].x; yacc[2 * i + 1] = (float)yh[i].y; }
    const int bi = tok < NLAT ? (tok >> 12) : 8;
    const float* gv = p.mod + ((size_t)(l * 9 + bi) * 6 + 5) * 1024 + lane * 16;
    u16* rp = p.res + (size_t)tok * 1024 + lane * 16;
    float4 xv[4];
    float ss = 0.f;
    {
      const uint4 r0 = *(const uint4*)rp, r1 = *(const uint4*)(rp + 8);
      xv[0] = make_float4(bflo(r0.x), bfhi(r0.x), bflo(r0.y), bfhi(r0.y)); xv[1] = make_float4(bflo(r0.z), bfhi(r0.z), bflo(r0.w), bfhi(r0.w));
      xv[2] = make_float4(bflo(r1.x), bfhi(r1.x), bflo(r1.y), bfhi(r1.y)); xv[3] = make_float4(bflo(r1.z), bfhi(r1.z), bflo(r1.w), bfhi(r1.w));
    }
#pragma unroll
    for (int i = 0; i < 4; ++i) {
      const float4 g4 = *(const float4*)(gv + 4 * i);
      xv[i].x += g4.x * yacc[4 * i] * 0.25f; xv[i].y += g4.y * yacc[4 * i + 1] * 0.25f; xv[i].z += g4.z * yacc[4 * i + 2] * 0.25f; xv[i].w += g4.w * yacc[4 * i + 3] * 0.25f;
      ss += xv[i].x * xv[i].x + xv[i].y * xv[i].y + xv[i].z * xv[i].z + xv[i].w * xv[i].w;
    }
    ss = wave_sum(ss);
    const float rstd = rsqrtf(ss * (1.0f / 1024.0f) + 1e-6f);
    if (l == 0) {
      const float* gam = p.norm_mix_g + 1024 + lane * 16;
      const float* msh = p.mod + ((size_t)(9 + bi) * 6 + 0) * 1024 + lane * 16;
      const float* msc = msh + 1024;
      float yv[16];
      float amax = 0.f;
#pragma unroll
      for (int i = 0; i < 4; ++i) {
        const float4 g = *(const float4*)(gam + 4 * i);
        const float4 sh = *(const float4*)(msh + 4 * i);
        const float4 sc = *(const float4*)(msc + 4 * i);
        yv[4 * i] = xv[i].x * rstd * g.x * (1.f + sc.x) + sh.x; yv[4 * i + 1] = xv[i].y * rstd * g.y * (1.f + sc.y) + sh.y;
        yv[4 * i + 2] = xv[i].z * rstd * g.z * (1.f + sc.z) + sh.z; yv[4 * i + 3] = xv[i].w * rstd * g.w * (1.f + sc.w) + sh.w;
      }
#pragma unroll
      for (int i = 0; i < 16; ++i) amax = fmaxf(amax, fabsf(yv[i]));
      amax = fmaxf(wave_max(amax), 1e-20f);
      const float inv = 127.0f / amax;
      unsigned w[4];
#pragma unroll
      for (int i = 0; i < 4; ++i)
        w[i] = ((unsigned)__float2int_rn(yv[4 * i] * inv) & 255u) | (((unsigned)__float2int_rn(yv[4 * i + 1] * inv) & 255u) << 8) |
               (((unsigned)__float2int_rn(yv[4 * i + 2] * inv) & 255u) << 16) | (((unsigned)__float2int_rn(yv[4 * i + 3] * inv) & 255u) << 24);
      if (do_store) {
        *(uint4*)rp = make_uint4(pk2(xv[0].x, xv[0].y), pk2(xv[0].z, xv[0].w), pk2(xv[1].x, xv[1].y), pk2(xv[1].z, xv[1].w));
        *(uint4*)(rp + 8) = make_uint4(pk2(xv[2].x, xv[2].y), pk2(xv[2].z, xv[2].w), pk2(xv[3].x, xv[3].y), pk2(xv[3].z, xv[3].w));
        *(uint4*)(p.xn8 + (size_t)tok * 1024 + lane * 16) = make_uint4(w[0], w[1], w[2], w[3]);
        if (lane == 0) p.sa[tok] = amax * (1.0f / 127.0f);
      }
    } else {
      const float* fg = p.final_g + lane * 16;
      float4 gf[4];
#pragma unroll
      for (int i = 0; i < 4; ++i) gf[i] = *(const float4*)(fg + 4 * i);
#pragma unroll
      for (int i = 0; i < 4; ++i) {
        const float4 g = gf[i];
        const float4 o = make_float4(xv[i].x * rstd * g.x, xv[i].y * rstd * g.y, xv[i].z * rstd * g.z, xv[i].w * rstd * g.w);
        if (do_store) *(float4*)(p.out + (size_t)tok * 1024 + lane * 16 + 4 * i) = o;
      }
    }
  }
}


__device__ __forceinline__ void wqk_quant(const P& p) {
  const int tid_ = opaque_tid(); const int lane = tid_ & 63, wid = tid_ >> 6;
  for (int row = blockIdx.x * 8 + wid; row < 2 * 2048; row += gridDim.x * 8) {
    u16* rp = p.WqkT + (size_t)row * 1024;
    const uint4 a = *(const uint4*)(rp + lane * 16), b = *(const uint4*)(rp + lane * 16 + 8);
    float v[16];
    v[0] = bflo(a.x); v[1] = bfhi(a.x); v[2] = bflo(a.y); v[3] = bfhi(a.y); v[4] = bflo(a.z); v[5] = bfhi(a.z); v[6] = bflo(a.w); v[7] = bfhi(a.w);
    v[8] = bflo(b.x); v[9] = bfhi(b.x); v[10] = bflo(b.y); v[11] = bfhi(b.y); v[12] = bflo(b.z); v[13] = bfhi(b.z); v[14] = bflo(b.w); v[15] = bfhi(b.w);
    float amax = 0.f;
#pragma unroll
    for (int i = 0; i < 16; ++i) amax = fmaxf(amax, fabsf(v[i]));
    amax = fmaxf(wave_max(amax), 1e-20f);
    const float inv = 127.0f / amax;
    unsigned w[4];
#pragma unroll
    for (int i = 0; i < 4; ++i)
      w[i] = ((unsigned)__float2int_rn(v[4 * i] * inv) & 255u) | (((unsigned)__float2int_rn(v[4 * i + 1] * inv) & 255u) << 8) |
             (((unsigned)__float2int_rn(v[4 * i + 2] * inv) & 255u) << 16) | (((unsigned)__float2int_rn(v[4 * i + 3] * inv) & 255u) << 24);
    *(uint4*)((unsigned char*)rp + lane * 16) = make_uint4(w[0], w[1], w[2], w[3]);
    if (lane == 0) p.swq[row] = amax * (1.0f / 127.0f);
  }
}

#define XB_TMO      128
#define XB_XCNT(j)  (256  + 64 * (j))
#define XB_XSUB(j)  (1280 + 64 * (j))
#define XB_XGEN(j)  (2304 + 64 * (j))
#define XB_TOP      3328
#define XB_TOPGEN   3392
#define XCD_BAR_WORDS 3456
#define XB_SPIN_CAP (1u << 22)
#define LAS __attribute__((address_space(3)))
__device__ __forceinline__ unsigned xb_ld(unsigned* p) { return __hip_atomic_load(p, __ATOMIC_RELAXED, __HIP_MEMORY_SCOPE_AGENT); }
__device__ __forceinline__ unsigned xb_add(unsigned* p, unsigned v) { return __hip_atomic_fetch_add(p, v, __ATOMIC_RELAXED, __HIP_MEMORY_SCOPE_AGENT); }
__device__ __forceinline__ unsigned xb_xcc_id() { return (unsigned)__builtin_amdgcn_s_getreg((3 << 11) | 20) & 0xFu; }
#define XB_SPIN(cond, bar) do { unsigned _sp = 0; while (cond) { __builtin_amdgcn_s_sleep(1); \
    if ((++_sp & 255u) == 0u) { if (xb_ld(&(bar)[XB_TMO])) break; if (_sp > XB_SPIN_CAP) { atomicAdd(&(bar)[XB_TMO], 1u); break; } } } } while (0)
struct XcdBarrier { unsigned* bar; unsigned x; volatile LAS unsigned* st; };
__device__ __forceinline__ XcdBarrier xcd_barrier_post(unsigned* bar, volatile LAS unsigned* st) {
  XcdBarrier b; b.bar = bar; b.x = xb_xcc_id(); b.st = st;
  if (threadIdx.x == 0) (void)xb_add(&bar[XB_XCNT(b.x)], 1u);
  return b;
}
__device__ __forceinline__ void xcd_barrier_complete(unsigned* bar, unsigned x, unsigned& nloc, unsigned& nx) {
  const unsigned G = gridDim.x * gridDim.y * gridDim.z;
  unsigned sum, cnt, mine, sp = 0u;
  for (;;) {
    sum = 0u; cnt = 0u; mine = 0u;
#pragma unroll
    for (unsigned j = 0; j < 16; ++j) { const unsigned c = xb_ld(&bar[XB_XCNT(j)]); sum += c; cnt += (c > 0u) ? 1u : 0u; mine = (j == x) ? c : mine; }
    if (sum == G) break;
    __builtin_amdgcn_s_sleep(1);
    if ((++sp & 255u) == 0u) { if (xb_ld(&bar[XB_TMO])) break; if (sp > XB_SPIN_CAP) { atomicAdd(&bar[XB_TMO], 1u); break; } }
  }
  nloc = mine > 0u ? mine : 1u; nx = cnt > 0u ? cnt : 1u;
}
__device__ __forceinline__ void xcd_barrier(unsigned* bar_u, volatile LAS unsigned* st_u) {
  XcdBarrier b; b.bar = bar_u; b.x = xb_xcc_id(); b.st = st_u;
  asm volatile("s_waitcnt vmcnt(0)" ::: "memory");
  __syncthreads();
  if (threadIdx.x == 0) {
    unsigned long long bp_ = (unsigned long long)b.bar;
    asm volatile("" : "+v"(bp_));
    unsigned* bar = (unsigned*)bp_;
    __builtin_amdgcn_s_waitcnt(0);
    unsigned nloc = b.st[0], nx = b.st[1];
    if (nloc == 0u) { xcd_barrier_complete(bar, b.x, nloc, nx); b.st[0] = nloc; b.st[1] = nx; }
    const unsigned old = xb_add(&bar[XB_XSUB(b.x)], 1u);
    const unsigned gen = old / nloc;
    if (old + 1u == (gen + 1u) * nloc) {
      __builtin_amdgcn_fence(__ATOMIC_RELEASE, "agent");
      asm volatile("s_waitcnt vmcnt(0)" ::: "memory");
      const unsigned og = xb_add(&bar[XB_TOP], 1u);
      const unsigned tg = og / nx;
      if (og + 1u == (tg + 1u) * nx) xb_add(&bar[XB_TOPGEN], 1u);
      else XB_SPIN(xb_ld(&bar[XB_TOPGEN]) == tg, bar);
      __builtin_amdgcn_fence(__ATOMIC_ACQUIRE, "agent");
      xb_add(&bar[XB_XGEN(b.x)], 1u);
      asm volatile("s_waitcnt vmcnt(0)" ::: "memory");
    } else {
      XB_SPIN(xb_ld(&bar[XB_XGEN(b.x)]) == gen, bar);
      __builtin_amdgcn_fence(__ATOMIC_ACQUIRE, "agent");
      asm volatile("s_waitcnt vmcnt(0)" ::: "memory");
    }
  }
  __syncthreads();
}

template <int l>
__device__ __forceinline__ void layer_body(const P& p, char* smem, pg8::PG8_LAS_T lds, volatile LAS unsigned* xbw, const int nb, const int bid) {
    const bool last = (l == 1);
    const int n_mt = last ? 128 : 136;
    if (l == 0) {
      phase_norm(p, l, 0);
      xcd_barrier(p.counters + 1024, xbw);
    }
_Pragma("unroll 1")
    for (int rep = 0; rep < REP_INPROJ; ++rep) {
      pg8::Gemm g; pg8::Order S;
      g.A = (const u16*)p.xn8; g.Bt = (const u16*)(p.Win8 + (size_t)l * 2816 * 1024); g.lda = 512; g.ldb = 512; g.K = 512;
      S.init(136, 6, nb, bid, 4, 5);
      pg8::EpiInprojN8 e1; e1.qk = p.qk; e1.rg = p.rg; e1.sa = p.sa; e1.sw = p.sw + l * 5888;
      pg8::gemm_phase(lds, g, S, e1);
      g.A = (const u16*)(p.Win8 + ((size_t)l * 2816 + 1024) * 1024); g.Bt = (const u16*)p.xn8;
      S.init(5, 136, nb, (bid + nb - (136 * 6) % nb) % nb);
      pg8::EpiInprojT8 e2; e2.vT = p.vT; e2.sa = p.sa; e2.sw = p.sw + l * 5888 + 1024;
      pg8::gemm_phase(lds, g, S, e2);
    }
    xcd_barrier(p.counters + 1024, xbw);
    phase_mixers(p, l, smem, p.counters + l * 4);
    xcd_barrier(p.counters + 1024, xbw);
_Pragma("unroll 1")
    for (int rep = 0; rep < REP_2B; ++rep)
      for (int task = bid; task < 1088 + 512; task += nb) {
        if (task < 1088) rg_wave_task(p, l, task >> 2, task & 3, 1, last, smem);
        else yb_transpose_task(p, (task - 1088) >> 6, (task - 1088) & 63, smem);
      }
    xcd_barrier(p.counters + 1024, xbw);
_Pragma("unroll 1")
    for (int rep = 0; rep < REP_GATE; ++rep) {
      pg8::Gemm g; pg8::Order S;
      g.A = (const u16*)p.xn8; g.Bt = (const u16*)(p.Wg8 + (size_t)l * 3072 * 1024); g.lda = 512; g.ldb = 512; g.K = 512;
      S.init(n_mt, 12, nb, bid);
      pg8::EpiGate8 e; e.g8 = p.g8; e.bias = p.b_gate + l * 3072; e.sa = p.sa; e.sw = p.sw + l * 5888 + 2816;
      pg8::gemm_phase(lds, g, S, e);
    }
    xcd_barrier(p.counters + 1024, xbw);
_Pragma("unroll 1")
    for (int rep = 0; rep < REP_BRANCH; ++rep) {
      pg8::Gemm g; pg8::Order S;
      S.init(n_mt, 4, nb, bid);
      pg8::EpiBranchF e; e.mbuf = p.mbuf; e.g8 = p.g8;
      g.A = p.ycat; g.lda = 1024; g.Bt = p.WaT + (size_t)l * 1024 * 1024; g.ldb = 1024; g.K = 1024;
      pg8::gemm_phase(lds, g, S, e);
    }
    xcd_barrier(p.counters + 1024, xbw);
    {
      pg8::Gemm g; pg8::Order S;
      g.A = p.mbuf; g.Bt = p.WoT + (size_t)l * 1024 * 1024; g.lda = 1024; g.ldb = 1024; g.K = 1024;
      S.init(n_mt, 4, nb, bid);
      pg8::EpiOutR<(l == 0)> e; e.xsrc = p.x; e.csrc = p.ctx; e.res = p.res;
      e.modl = p.mod + (size_t)l * 9 * 6144;
_Pragma("unroll 1")
      for (int half = 0; half < 2; ++half) {
        if ((bid & 1) != half) {
          for (int t = bid; t < 4096; t += 8 * nb) {
            cvt_chunk_fp4x8(p.peer_u + (size_t)l * 16384 * 1024, p.Ub, t, nb, 4096, 64.0f, 0);
            cvt_chunk_fp4x8(p.peer_v + (size_t)l * 16384 * 1024, p.Ub, t, nb, 4096, 4.0f, 1);
          }
        }
        if (half == 0) pg8::gemm_phase(lds, g, S, e);
      }
    }
    xcd_barrier(p.counters + 1024, xbw);
    phase_norm(p, l, 1);
    xcd_barrier(p.counters + 1024, xbw);
_Pragma("unroll 1")
    for (int rep = 0; rep < REP_Q; ++rep) {
      pg8::Gemm g; pg8::Order S;
      g.A = (const u16*)p.xn8; g.Bt = p.WqkT + (size_t)l * 2048 * 1024; g.lda = 512; g.ldb = 1024; g.K = 512;
      S.init(n_mt, 8, nb, bid);
      pg8::EpiQ8 e; e.q = p.q; e.sa = p.sa; e.sw = p.swq + l * 2048;
      pg8::gemm_phase(lds, g, S, e);
    }
    xcd_barrier(p.counters + 1024, xbw);
_Pragma("unroll 1")
    for (int rep = 0; rep < REP_SCORE; ++rep)
    {
      uint4 q0, q1, q2, q3, q4, q5, q6, q7;
      {
        const int tid = opaque_tid();
        const int t0 = bid < n_mt * 16 ? bid : 0;
        uint4 pre[8];
        PS_LOAD(t0 >> 4, t0 & 15);
        q0 = pre[0]; q1 = pre[1]; q2 = pre[2]; q3 = pre[3]; q4 = pre[4]; q5 = pre[5]; q6 = pre[6]; q7 = pre[7];
      }
      for (int task = bid; task < n_mt * 16; task += nb) {
        const int nt_ = (task + nb < n_mt * 16) ? task + nb : task;
        peer_score_tile(p, l, task >> 4, task & 15, smem, q0, q1, q2, q3, q4, q5, q6, q7, nt_ >> 4, nt_ & 15);
      }
    }
    xcd_barrier(p.counters + 1024, xbw);
_Pragma("unroll 1")
    for (int rep = 0; rep < REP_PEER; ++rep) phase_peer_experts(p, l, rep == REP_PEER - 1, smem);
    xcd_barrier(p.counters + 1024, xbw);
  }

__global__ void __launch_bounds__(NTHR) fwd_megakernel(P p) {
  __shared__ __attribute__((aligned(16))) char smem[SMEM_BYTES];
  cg::grid_group grid = cg::this_grid();
  const int nb = gridDim.x, bid = blockIdx.x;
  pg8::PG8_LAS_T lds = (pg8::PG8_LAS_T)smem;
  volatile LAS unsigned* xbw = (volatile LAS unsigned*)(smem + SMEM_BYTES - 32);
  if (threadIdx.x == 0) { xbw[0] = 0u; xbw[1] = 0u; xbw[2] = 0u; xbw[3] = 0u; }
  __syncthreads();
  (void)xcd_barrier_post(p.counters + 1024, xbw);

  phase_prep(p, smem, p.counters + 32);
  grid.sync();
  phase_modreduce(p);
  for (int task = blockIdx.x; task < 512; task += gridDim.x) kf_task(p, task >> 8, task & 255, smem);
  for (int task = blockIdx.x; task < 256; task += gridDim.x) wqk_task(p, task >> 7, (task >> 3) & 15, task & 7, smem);
  for (int task = blockIdx.x; task < 2 * 368; task += gridDim.x) {
    const int l = task / 368, t = task - l * 368;
    if (t < 176) tr_tile4<true>(p.w_in + (size_t)l * 1024 * 2816, 2816, 1024, p.Win8 + (size_t)l * 2816 * 1024, t, p.sw + l * 5888, smem);
    else tr_tile4<true>(p.w_gate + (size_t)l * 1024 * 3072, 3072, 1024, p.Wg8 + (size_t)l * 3072 * 1024, t - 176, p.sw + l * 5888 + 2816, smem);
  }
  xcd_barrier(p.counters + 1024, xbw);

  wqk_quant(p);
  layer_body<0>(p, smem, lds, xbw, nb, bid);
  layer_body<1>(p, smem, lds, xbw, nb, bid);
}

extern "C" void kernel_launch(void* const* d_in, const int* in_sizes, int n_in, void* d_out, int out_size, void* d_ws,
                              size_t ws_size, hipStream_t stream) {
  P p;
  memset(&p, 0, sizeof(p));
  const float** ins = (const float**)&p;
  for (int i = 0; i < 37; ++i) ins[i] = (const float*)d_in[i];
  p.out = (float*)d_out;
  char* w = (char*)d_ws;
  size_t off = 0;
  auto take = [&](size_t bytes) { char* r = w + off; off += (bytes + 255) & ~(size_t)255; return r; };
  p.counters = (unsigned*)take(32768);
  p.WinT = nullptr; p.WgT = nullptr;
  p.Win8 = (unsigned char*)take((size_t)2 * 2816 * 1024);
  p.Wg8 = (unsigned char*)take((size_t)2 * 3072 * 1024);
  p.sw = (float*)take((size_t)2 * 5888 * 4);
  p.xn8 = (unsigned char*)take((size_t)NTOK * 1024);
  p.sa = (float*)take((size_t)NTOK * 4);
  p.WaT = (u16*)take((size_t)2 * 1024 * 1024 * 2);
  p.WbT = nullptr; p.WcT = nullptr;
  p.WoT = (u16*)take((size_t)2 * 1024 * 1024 * 2);
  p.WqkT = (u16*)take((size_t)2 * 2048 * 1024 * 2);
  p.rgW = (u16*)take((size_t)2 * 16 * 4096 * 2);
  p.mod = (float*)take((size_t)2 * 9 * 6144 * 4);
  p.hc = (float*)take((size_t)512 * 256 * 4);
  p.Kf = (float*)take((size_t)2 * 256 * 8192 * 8);
  p.xn = (u16*)take((size_t)NTOK * 1024 * 2);
  p.qk = (u16*)take((size_t)NTOK * 1024 * 2);
  p.mbuf = p.qk;
  p.vT = (u16*)take((size_t)8 * 512 * 4096 * 2);
  p.vTc = (u16*)take((size_t)8 * 512 * 256 * 2);
  p.hyT = (u16*)take((size_t)8 * 768 * 4096 * 2);
  p.hyTc = (u16*)take((size_t)8 * 768 * 256 * 2);
  p.rg = (u16*)take((size_t)NTOK * 512 * 2);
  p.ycat = (u16*)take((size_t)NTOK * 1024 * 2);
  p.Ub = (unsigned char*)p.ycat;
  p.Vb = p.Ub + (size_t)16384 * 512;
  p.agg = (float*)take((size_t)8 * 2 * (136 + 34) * 256 * 8);
  p.ybT = (u16*)take((size_t)8 * 256 * 4096 * 2);
  p.hT = (float*)take((size_t)2 * 512 * 4096 * 4);
  p.WqB = (u16*)take((size_t)2 * 1024 * 2048 * 2);
  p.modpart = (float*)take((size_t)16 * 2 * 9 * 6144 * 4);
  p.keysB = (u16*)take((size_t)2 * 16 * 16384 * 2);
  p.res = (u16*)p.hT;
  {
    const size_t have = (size_t)((w + off) - (char*)p.hT), need = (size_t)NTOK * 1024 * 2;
    if (need > have) (void)take(need - have);
  }
  p.ctxs = nullptr;
  p.swq = (float*)take((size_t)2 * 2048 * 4);
  p.g8 = (unsigned char*)p.vT;
  p.q = p.qk;
  p.topk = (unsigned*)((char*)p.qk + (size_t)NTOK * 2048 * 2);
  if (off > ws_size) {
    fprintf(stderr, "workspace too small: need %zu have %zu\n", off, ws_size);
    return;
  }
  static int grid_blocks = 0;
  if (!grid_blocks) {
    int dev = 0, cus = 0, per_cu = 0;
    (void)hipGetDevice(&dev);
    (void)hipDeviceGetAttribute(&cus, hipDeviceAttributeMultiprocessorCount, dev);
    (void)hipOccupancyMaxActiveBlocksPerMultiprocessor(&per_cu, fwd_megakernel, NTHR, 0);
    if (per_cu > 1) per_cu = 1;
    grid_blocks = cus * per_cu;
  }
  (void)hipMemsetAsync(p.counters, 0, 32768, stream);
  void* args[] = {&p};
  hipError_t e = hipLaunchCooperativeKernel((void*)fwd_megakernel, dim3(grid_blocks), dim3(NTHR), args, 0, stream);
  if (e != hipSuccess) fprintf(stderr, "cooperative launch failed: %s (grid %d)\n", hipGetErrorString(e), grid_blocks);
}
```

```cpp
#include <hip/hip_runtime.h>
#include <hip/hip_cooperative_groups.h>
#include <cstdio>
#include <cstring>
namespace cg = cooperative_groups;

typedef unsigned short u16;
typedef __attribute__((ext_vector_type(8))) short bf16x8;
typedef __attribute__((ext_vector_type(16))) float f32x16;
typedef __attribute__((ext_vector_type(2))) float f32x2;
typedef int i32x8 __attribute__((ext_vector_type(8)));

#define NLAT 32768
#define NTOK 34816
#define SMEM_BYTES 151552
#define NTHR 512
#ifndef DUP_1A
#define DUP_1A 1
#endif
#ifndef DUP_PREP
#define DUP_PREP 1
#endif
#ifndef DUP_2B
#define DUP_2B 1
#endif
#ifndef XRGA
#define XRGA 1
#endif
#ifndef REP_PEER
#define HOOK_NG 2
#define REP_PEER 1
#endif
#ifndef REP_INPROJ
#define REP_INPROJ 1
#endif
#ifndef REP_GATE
#define REP_GATE 1
#endif
#ifndef REP_BRANCH
#define REP_BRANCH 1
#endif
#ifndef REP_Q
#define REP_Q 1
#endif
#ifndef REP_SCORE
#define REP_SCORE 1
#endif
#ifndef REP_1A
#define REP_1A 1
#endif
#ifndef REP_2B
#define REP_2B 1
#endif
#ifndef REP_KF
#define REP_KF 1
#endif
#ifndef DUP_GEMM
#define DUP_GEMM 1
#endif
#ifndef DUP_PEER
#define DUP_PEER 1
#endif
#ifndef DUP_MIX
#define DUP_MIX 1
#endif
#ifndef XRG
#define XRG 1
#endif
#ifndef XFFT
#define XFFT 1
#endif
#ifndef XATT
#define XATT 1
#endif

struct P {
  const float *x, *c, *ctx, *c_ctx, *norm_mix_g, *norm_ffn_g, *w_ada, *b_ada, *w_in, *na_rpb,
      *hy_short_w, *hy_short_b, *hy_f1_w, *hy_f1_b, *hy_f2_w, *hy_f2_b, *hy_f3_w, *hy_freq, *hy_bias,
      *rg_conv_w, *rg_conv_b, *rg_wa, *rg_ba, *rg_wx, *rg_bx, *rg_lambda,
      *w_gate, *b_gate, *w_br_a, *w_br_b, *w_br_c, *w_out, *peer_wq, *peer_keys, *peer_u, *peer_v, *final_g;
  float* out;
  unsigned* counters;
  u16 *WinT, *WgT, *WaT, *WbT, *WcT, *WoT, *WqB, *WqkT, *keysB, *rgW;
  float *modpart, *mod, *hT, *hc;
  float* Kf;
  u16 *xn, *qk, *vT, *vTc, *hyT, *hyTc, *rg, *ycat, *mbuf, *ybT;
  unsigned char *Ub, *Vb, *g8, *xn8, *Win8, *Wg8;
  float *sa, *sw;
  u16* q;
  float *agg, *ctxs;
  float* swq;
  u16* res;
  unsigned* topk;
};

__device__ __forceinline__ u16 f2bf(float f) {
  unsigned u = __float_as_uint(f);
  u += 0x7fffu + ((u >> 16) & 1u);
  return (u16)(u >> 16);
}
__device__ __forceinline__ float bf2f(u16 h) { return __uint_as_float(((unsigned)h) << 16); }
__device__ __forceinline__ unsigned pk2(float a, float b) { unsigned r; asm("v_cvt_pk_bf16_f32 %0, %1, %2" : "=v"(r) : "v"(a), "v"(b)); return r; }
__device__ __forceinline__ float bflo(unsigned u) { return __uint_as_float(u << 16); }
__device__ __forceinline__ float bfhi(unsigned u) { return __uint_as_float(u & 0xffff0000u); }
__device__ __forceinline__ int opaque_tid() {
  int t = threadIdx.x;
  asm volatile("" : "+v"(t));
  return t;
}
__device__ __forceinline__ int my_lane() { return opaque_tid() & 63; }
__device__ __forceinline__ float shx(float v, int o);
__device__ __forceinline__ float shf(float v, int src) { return __builtin_bit_cast(float, __builtin_amdgcn_ds_bpermute((src & 63) << 2, __builtin_bit_cast(int, v))); }
__device__ __forceinline__ unsigned shu(unsigned v, int src) { return (unsigned)__builtin_amdgcn_ds_bpermute((src & 63) << 2, (int)v); }
typedef unsigned u32x2_t __attribute__((ext_vector_type(2)));
template <int J> __device__ __forceinline__ unsigned xorl(unsigned v, int lane) {
  if constexpr (J == 1) return (unsigned)__builtin_amdgcn_mov_dpp((int)v, 0xB1, 0xF, 0xF, true);
  else if constexpr (J == 2) return (unsigned)__builtin_amdgcn_mov_dpp((int)v, 0x4E, 0xF, 0xF, true);
  else if constexpr (J == 4) {
    const unsigned a = (unsigned)__builtin_amdgcn_mov_dpp((int)v, 0x104, 0xF, 0xF, true);
    const unsigned b = (unsigned)__builtin_amdgcn_mov_dpp((int)v, 0x114, 0xF, 0xF, true);
    return (lane & 4) ? b : a;
  }
  else if constexpr (J == 8) return (unsigned)__builtin_amdgcn_mov_dpp((int)v, 0x128, 0xF, 0xF, true);
  else if constexpr (J == 16) { const u32x2_t r = __builtin_amdgcn_permlane16_swap(v, v, false, false); return (lane & 16) ? r.x : r.y; }
  else { const u32x2_t r = __builtin_amdgcn_permlane32_swap(v, v, false, false); return (lane & 32) ? r.x : r.y; }
}
template <int J> __device__ __forceinline__ float xorf(float v, int lane) { return __uint_as_float(xorl<J>(__float_as_uint(v), lane)); }
__device__ __forceinline__ float shx(float v, int o) {
  const int lane = my_lane();
  switch (o) {
    case 1: return xorf<1>(v, lane);
    case 2: return xorf<2>(v, lane);
    case 4: return xorf<4>(v, lane);
    case 8: return xorf<8>(v, lane);
    case 16: return xorf<16>(v, lane);
    case 32: return xorf<32>(v, lane);
    default: return __builtin_bit_cast(float, __builtin_amdgcn_ds_bpermute(((lane ^ o) << 2), __builtin_bit_cast(int, v)));
  }
}
__device__ __forceinline__ float wave_sum(float v) {
  const int lane = my_lane();
  v += xorf<32>(v, lane); v += xorf<16>(v, lane); v += xorf<8>(v, lane); v += xorf<4>(v, lane); v += xorf<2>(v, lane); v += xorf<1>(v, lane);
  return v;
}
__device__ __forceinline__ float wave_max(float v) {
  const int lane = my_lane();
  v = fmaxf(v, xorf<32>(v, lane)); v = fmaxf(v, xorf<16>(v, lane)); v = fmaxf(v, xorf<8>(v, lane));
  v = fmaxf(v, xorf<4>(v, lane)); v = fmaxf(v, xorf<2>(v, lane)); v = fmaxf(v, xorf<1>(v, lane));
  return v;
}
__device__ __forceinline__ float sigmoidf_(float x) { return __builtin_amdgcn_rcpf(1.0f + __expf(-x)); }
__device__ __forceinline__ float gelu_tanh(float x) {
  const float u2 = 1.5957691216057308f * (x + 0.044715f * x * x * x);
  return x * __builtin_amdgcn_rcpf(1.0f + __expf(-u2));
}
__device__ __forceinline__ f32x16 mfma32(bf16x8 a, bf16x8 b, f32x16 c) {
  return __builtin_amdgcn_mfma_f32_32x32x16_bf16(a, b, c, 0, 0, 0);
}
__device__ __forceinline__ f32x16 zero16() {
  f32x16 z;
#pragma unroll
  for (int i = 0; i < 16; ++i) z[i] = 0.f;
  return z;
}
__device__ __forceinline__ int swz128(int row, int ch) { return row * 128 + ((ch ^ ((row >> 1) & 7)) << 4); }
__device__ __forceinline__ int swz256(int row, int ch) { return row * 256 + ((ch ^ (row & 15)) << 4); }

struct c2 { float x, y; };
__device__ __forceinline__ c2 cadd(c2 a, c2 b) { return {a.x + b.x, a.y + b.y}; }
__device__ __forceinline__ c2 csub(c2 a, c2 b) { return {a.x - b.x, a.y - b.y}; }
__device__ __forceinline__ c2 cmul(c2 a, c2 b) { return {a.x * b.x - a.y * b.y, a.x * b.y + a.y * b.x}; }
__device__ __forceinline__ float c16(int i) {
  const float tb[16] = {1.0f, 0.9238795325112867f, 0.7071067811865476f, 0.3826834323650898f, 0.0f,
                        -0.3826834323650898f, -0.7071067811865476f, -0.9238795325112867f, -1.0f,
                        -0.9238795325112867f, -0.7071067811865476f, -0.3826834323650898f, 0.0f,
                        0.3826834323650898f, 0.7071067811865476f, 0.9238795325112867f};
  return tb[i & 15];
}
__device__ __forceinline__ float s16(int i) { return c16(i + 12); }
template <int R> __device__ __forceinline__ constexpr int brev(int k) {
  int r = 0;
  for (int b = 1, o = R >> 1; b < R; b <<= 1, o >>= 1)
    if (k & b) r |= o;
  return r;
}
template <int R> __device__ __forceinline__ void dft_reg(c2* v, float sgn) {
#pragma unroll
  for (int h = R / 2; h >= 1; h >>= 1) {
#pragma unroll
    for (int g = 0; g < R; g += 2 * h) {
#pragma unroll
      for (int j = 0; j < h; ++j) {
        c2 a = v[g + j], b = v[g + j + h];
        v[g + j] = cadd(a, b);
        c2 d = csub(a, b);
        const int ti = j * (16 / (2 * h));
        c2 w = {c16(ti), sgn * s16(ti)};
        v[g + j + h] = (j == 0) ? d : cmul(d, w);
      }
    }
  }
}
template <int R> __device__ __forceinline__ int fft_bfly(c2* v, int j, int Ns, float sgn) {
  const int k = j & (Ns - 1);
  const float f = sgn * (float)k / (float)(Ns * R);
#pragma unroll
  for (int r = 1; r < R; ++r) {
    float t = f * (float)r;
    c2 w = {__builtin_amdgcn_cosf(t), __builtin_amdgcn_sinf(t)};
    v[r] = cmul(v[r], w);
  }
  dft_reg<R>(v, sgn);
  return (j - k) * R + k;
}
template <int R> __device__ __forceinline__ void fft_pass(c2* buf, int Ns, float sgn) {
  constexpr int NBF = 8192 / R;
  constexpr int PER = NBF / NTHR;
  const int tid = opaque_tid();
  c2 v[PER][R];
#pragma unroll
  for (int i = 0; i < PER; ++i) {
    const int j = tid + NTHR * i;
#pragma unroll
    for (int r = 0; r < R; ++r) v[i][r] = buf[j + r * NBF];
  }
  __syncthreads();
#pragma unroll
  for (int i = 0; i < PER; ++i) {
    const int j = tid + NTHR * i;
    const int base = fft_bfly<R>(v[i], j, Ns, sgn);
#pragma unroll
    for (int r = 0; r < R; ++r) buf[base + r * Ns] = v[i][brev<R>(r)];
  }
  __syncthreads();
}
__device__ __forceinline__ void fft8192(c2* buf, float sgn) {
  fft_pass<8>(buf, 1, sgn);
  fft_pass<8>(buf, 8, sgn);
  fft_pass<8>(buf, 64, sgn);
  fft_pass<16>(buf, 512, sgn);
}

__device__ __forceinline__ void gemm_kloop(f32x16 (&acc)[2][2], const u16* __restrict__ A, int lda,
                                           const u16* __restrict__ B, int ldb, int K, char* smem) {
  const int tid = opaque_tid(), lane = tid & 63, wid = tid >> 6;
  const int wm = wid >> 1, wn = wid & 1;
  const int l31 = lane & 31, hh = lane >> 5;
  uint4 ra[4], rb[2];
  const int nk = K >> 6;
  const int srow = tid >> 3, sch = tid & 7;
  const char* Ab = (const char*)A;
  const char* Bb = (const char*)B;
  const unsigned aoff = (unsigned)(srow * lda + sch * 8) * 2u;
  const unsigned boff = (unsigned)(srow * ldb + sch * 8) * 2u;
  const unsigned astep = (unsigned)lda * 128u, bstep = (unsigned)ldb * 128u;
#pragma unroll
  for (int i = 0; i < 4; ++i) ra[i] = *(const uint4*)(Ab + (aoff + i * astep));
#pragma unroll
  for (int i = 0; i < 2; ++i) rb[i] = *(const uint4*)(Bb + (boff + i * bstep));
#pragma unroll
  for (int i = 0; i < 4; ++i) *(uint4*)(smem + swz128(srow + i * 64, sch)) = ra[i];
#pragma unroll
  for (int i = 0; i < 2; ++i) *(uint4*)(smem + 65536 + swz128(srow + i * 64, sch)) = rb[i];
  __syncthreads();
  for (int kt = 0; kt < nk; ++kt) {
    const bool more = (kt + 1 < nk);
    if (more) {
      const unsigned ko = (unsigned)(kt + 1) * 128u;
#pragma unroll
      for (int i = 0; i < 4; ++i) ra[i] = *(const uint4*)(Ab + (aoff + i * astep + ko));
#pragma unroll
      for (int i = 0; i < 2; ++i) rb[i] = *(const uint4*)(Bb + (boff + i * bstep + ko));
    }
    const char* as = smem + (kt & 1) * 32768;
    const char* bs = smem + 65536 + (kt & 1) * 16384;
    int lrow = l31;
    asm volatile("" : "+v"(lrow));
#pragma unroll
    for (int s = 0; s < 4; ++s) {
      bf16x8 af[2], bfr[2];
#pragma unroll
      for (int i = 0; i < 2; ++i) af[i] = *(const bf16x8*)(as + swz128(wm * 64 + i * 32 + lrow, s * 2 + hh));
#pragma unroll
      for (int j = 0; j < 2; ++j) bfr[j] = *(const bf16x8*)(bs + swz128(wn * 64 + j * 32 + lrow, s * 2 + hh));
#pragma unroll
      for (int i = 0; i < 2; ++i)
#pragma unroll
        for (int j = 0; j < 2; ++j) acc[i][j] = mfma32(af[i], bfr[j], acc[i][j]);
    }
    if (more) {
      char* an = smem + ((kt + 1) & 1) * 32768;
      char* bn = smem + 65536 + ((kt + 1) & 1) * 16384;
      int sr2 = srow;
      asm volatile("" : "+v"(sr2));
#pragma unroll
      for (int i = 0; i < 4; ++i) *(uint4*)(an + swz128(sr2 + i * 64, sch)) = ra[i];
#pragma unroll
      for (int i = 0; i < 2; ++i) *(uint4*)(bn + swz128(sr2 + i * 64, sch)) = rb[i];
    }
    __syncthreads();
  }
}
__device__ __forceinline__ void zero_acc(f32x16 (&acc)[2][2]) {
#pragma unroll
  for (int i = 0; i < 2; ++i)
#pragma unroll
    for (int j = 0; j < 2; ++j) acc[i][j] = zero16();
}
#define EPI_ROW(i, e) (wm * 64 + (i)*32 + ((e)&3) + 8 * ((e) >> 2) + 4 * hh)
#define EPI_COL(j) (wn * 64 + (j)*32 + l31)
#define EPI_VARS                                                    \
  const int tid = opaque_tid(), lane = tid & 63, wid = tid >> 6;     \
  const int wm = wid >> 1, wn = wid & 1, l31 = lane & 31, hh = lane >> 5; \
  (void)tid; (void)wm; (void)wn; (void)l31; (void)hh;


namespace pg8 {
__device__ __forceinline__ unsigned pkh(float a, float b) { unsigned r; asm("v_cvt_pk_bf16_f32 %0, %1, %2" : "=v"(r) : "v"(a), "v"(b)); return r; }
#define PG8_LAS __attribute__((address_space(3)))
typedef PG8_LAS unsigned char* PG8_LAS_T;
typedef float f32x4 __attribute__((ext_vector_type(4)));
typedef unsigned u32x4 __attribute__((ext_vector_type(4)));
typedef int i32x4 __attribute__((ext_vector_type(4)));
constexpr int BM = 256, BK = 64, HALF = 128, HTB = HALF * BK * 2, STAGE_BYTES = 8 * HTB, NXCD = 8, WGM = 8;
__device__ __forceinline__ int lds_byte(int r, int c) { const int st = (r >> 4) * 2 + (c >> 5), rr = r & 15, cc = c & 31, ob = rr * 64 + cc * 2; return st * 1024 + (ob ^ (((ob >> 9) & 1) << 5)); }
__device__ __forceinline__ void stage_rc(int b, int& R, int& C) { const int st = b / 1024, sb = b % 1024, swz = sb ^ (((sb >> 9) & 1) << 5); R = (st >> 1) * 16 + swz / 64; C = (st & 1) * 32 + (swz % 64) / 2; }
__device__ __forceinline__ int perm32(int rho) { const int n = rho >> 4, i = rho & 15; return 8 * (i >> 2) + 4 * n + (i & 3); }
struct Unit { int pm, pn; };
struct Gemm { const u16* A; const u16* Bt; int lda, ldb, K; };
struct Order {
  int nM, nN, nwg, G, c, skip_from, skip_by;
  __device__ __forceinline__ void init(int nM_, int nN_, int G_, int c_, int sf = 1 << 30, int sb = 0) { nM = nM_; nN = nN_; nwg = nM * nN; G = G_; c = c_; skip_from = sf; skip_by = sb; }
  __device__ __forceinline__ bool next(int i, Unit& u) const {
    const long L = (long)i * G + c; if (L >= nwg) return false;
    int wgid = (int)L; { const int q = nwg / NXCD, r = nwg % NXCD, xcd = wgid % NXCD, off = wgid / NXCD; wgid = (xcd < r ? xcd * (q + 1) : r * (q + 1) + (xcd - r) * q) + off; }
    const int nig = WGM * nN, gid = wgid / nig, fm = gid * WGM, gsz = (nM - fm) < WGM ? (nM - fm) : WGM;
    u.pm = fm + ((wgid % nig) % gsz); u.pn = (wgid % nig) / gsz;
    if (u.pn >= skip_from) u.pn += skip_by;
    return true;
  }
};
__device__ __forceinline__ f32x4 mma16(bf16x8 a, bf16x8 b, f32x4 c) { return __builtin_amdgcn_mfma_f32_16x16x32_bf16(a, b, c, 0, 0, 0); }
__device__ __forceinline__ i32x4 mma16(bf16x8 a, bf16x8 b, i32x4 c) { return __builtin_amdgcn_mfma_i32_16x16x64_i8(__builtin_bit_cast(i32x4, a), __builtin_bit_cast(i32x4, b), c, 0, 0, 0); }
template <class Epi>
__device__ __forceinline__ void gemm_phase(PG8_LAS unsigned char* lds, const Gemm g, const Order& S, const Epi& E) {
  const int tid = opaque_tid(), wid = __builtin_amdgcn_readfirstlane(tid >> 6), lane = tid & 63, wr = wid >> 2, wc = wid & 3, fr = lane & 15, fq = lane >> 4;
  const int K = g.K, nt = K / BK;
  unsigned voffA[2], voffB[2];
#pragma unroll
  for (int i = 0; i < 2; ++i) { int R, C; stage_rc(tid * 16 + i * 8192, R, C); const int Rb = Epi::PERM ? ((R & ~31) + perm32(R & 31)) : R;
    voffA[i] = (unsigned)(R * g.lda + C) * 2u; voffB[i] = (unsigned)(Rb * g.ldb + C) * 2u; }
#define PG8_VOFF(T) do { _Pragma("unroll") for (int i = 0; i < 2; ++i) { int R, C; stage_rc((T) * 16 + i * 8192, R, C); const int Rb = Epi::PERM ? ((R & ~31) + perm32(R & 31)) : R; \
    voffA[i] = (unsigned)(R * g.lda + C) * 2u; voffB[i] = (unsigned)(Rb * g.ldb + C) * 2u; } } while (0)
  const size_t kstep = (size_t)(BK * 2);
  const size_t hstepA = (size_t)HALF * g.lda * 2, hstepB = (size_t)HALF * g.ldb * 2;
  const size_t tstepA = 2 * hstepA, tstepB = 2 * hstepB;
  const unsigned ldsw = (unsigned)wid * 1024u;
  int aoff = lds_byte(wr * 64 + fr, fq * 8), boff = lds_byte(wc * 32 + fr, fq * 8);
#define PG8_SA(b, h) (((b) * 2 + (h)) * HTB)
#define PG8_SB(b, h) ((4 + (b) * 2 + (h)) * HTB)
#define PG8_STAGE(bufoff, gbase, voff) do { _Pragma("unroll") for (int _i = 0; _i < 2; ++_i) \
    __builtin_amdgcn_global_load_lds((const unsigned*)((const char*)(gbase) + (voff)[_i]), (PG8_LAS unsigned*)(lds + (bufoff) + ldsw + _i * 8192), 16, 0, 0); } while (0)
#define PG8_LDA(dst, b, h) do { _Pragma("unroll") for (int m = 0; m < 4; ++m) _Pragma("unroll") for (int k = 0; k < 2; ++k) dst[m][k] = *(const PG8_LAS bf16x8*)(lds + PG8_SA(b, h) + aoff + m * 2048 + k * 1024); } while (0)
#define PG8_LDB(dst, b, h) do { _Pragma("unroll") for (int n = 0; n < 2; ++n) _Pragma("unroll") for (int k = 0; k < 2; ++k) dst[n][k] = *(const PG8_LAS bf16x8*)(lds + PG8_SB(b, h) + boff + n * 2048 + k * 1024); } while (0)
#define PG8_MMA(ai, bj, At, Bt) do { __builtin_amdgcn_s_setprio(1); _Pragma("unroll") for (int m = 0; m < 4; ++m) _Pragma("unroll") for (int n = 0; n < 2; ++n) _Pragma("unroll") for (int k = 0; k < 2; ++k) \
    acc[ai][bj][m][n] = mma16(Bt[n][k], At[m][k], acc[ai][bj][m][n]); __builtin_amdgcn_s_setprio(0); } while (0)
#define PG8_WAIT_V(n) asm volatile("s_waitcnt vmcnt(" #n ")" ::: "memory")
#define PG8_WAIT_L(n) asm volatile("s_waitcnt lgkmcnt(" #n ")" ::: "memory")
#define PG8_BAR __builtin_amdgcn_s_barrier()
#define PG8_SCHED __builtin_amdgcn_sched_barrier(0)
  Unit cur, nxt; int ui = 0;
  if (!S.next(0, cur)) return;
  typedef typename Epi::acc_t acc_t;
  acc_t acc[2][2][4][2];
#pragma unroll
  for (int a = 0; a < 2; ++a)
#pragma unroll
    for (int b = 0; b < 2; ++b)
#pragma unroll
      for (int m = 0; m < 4; ++m)
#pragma unroll
        for (int n = 0; n < 2; ++n) acc[a][b][m][n] = (acc_t){0, 0, 0, 0};
  bf16x8 At[4][2], B0[2][2], B1[2][2];
  const char* cA = (const char*)g.A + (size_t)cur.pm * tstepA; const char* cB = (const char*)g.Bt + (size_t)cur.pn * tstepB;
  PG8_STAGE(PG8_SB(0, 0), cB, voffB); PG8_STAGE(PG8_SA(0, 0), cA, voffA); PG8_STAGE(PG8_SB(0, 1), cB + hstepB, voffB); PG8_STAGE(PG8_SA(0, 1), cA + hstepA, voffA);
  if (wr == 1) PG8_BAR;
  PG8_WAIT_V(4); PG8_BAR;
  PG8_STAGE(PG8_SB(1, 0), cB + kstep, voffB); PG8_STAGE(PG8_SA(1, 0), cA + kstep, voffA); PG8_STAGE(PG8_SB(1, 1), cB + hstepB + kstep, voffB);
  PG8_WAIT_V(6); PG8_BAR;
  for (;;) {
    const bool has_next = S.next(ui + 1, nxt);
    const char* nA = has_next ? (const char*)g.A + (size_t)nxt.pm * tstepA : cA; const char* nB = has_next ? (const char*)g.Bt + (size_t)nxt.pn * tstepB : cB;
#define PG8_KBODY \
      const bool last = (t == nt - 2); \
      const char* a1 = cA + (size_t)(t + 1) * kstep; \
      const char* a2 = last ? nA : cA + (size_t)(t + 2) * kstep; const char* b2 = last ? nB : cB + (size_t)(t + 2) * kstep; \
      const char* a3 = a2 + kstep; const char* b3 = b2 + kstep; \
      PG8_LDB(B0, 0, 0); PG8_SCHED; PG8_LDA(At, 0, 0); PG8_STAGE(PG8_SA(1, 1), a1 + hstepA, voffA); \
      PG8_WAIT_L(8); PG8_BAR; PG8_WAIT_L(0); PG8_MMA(0, 0, At, B0); PG8_BAR; PG8_SCHED; \
      PG8_LDB(B1, 0, 1); PG8_STAGE(PG8_SB(0, 0), b2, voffB); \
      PG8_BAR; PG8_WAIT_L(0); PG8_MMA(0, 1, At, B1); PG8_BAR; \
      PG8_LDA(At, 0, 1); PG8_STAGE(PG8_SA(0, 0), a2, voffA); \
      PG8_BAR; PG8_WAIT_L(0); PG8_MMA(1, 0, At, B0); PG8_BAR; PG8_SCHED; \
      PG8_STAGE(PG8_SB(0, 1), b2 + hstepB, voffB); \
      PG8_WAIT_V(6); PG8_BAR; PG8_MMA(1, 1, At, B1); PG8_BAR; \
      PG8_LDB(B0, 1, 0); PG8_SCHED; PG8_LDA(At, 1, 0); PG8_STAGE(PG8_SA(0, 1), a2 + hstepA, voffA); \
      PG8_WAIT_L(8); PG8_BAR; PG8_WAIT_L(0); PG8_MMA(0, 0, At, B0); PG8_BAR; PG8_SCHED; \
      PG8_LDB(B1, 1, 1); PG8_STAGE(PG8_SB(1, 0), b3, voffB); \
      PG8_BAR; PG8_WAIT_L(0); PG8_MMA(0, 1, At, B1); PG8_BAR; \
      PG8_LDA(At, 1, 1); PG8_STAGE(PG8_SA(1, 0), a3, voffA); \
      PG8_BAR; PG8_WAIT_L(0); PG8_MMA(1, 0, At, B0); PG8_BAR; PG8_SCHED; \
      PG8_STAGE(PG8_SB(1, 1), b3 + hstepB, voffB); \
      PG8_WAIT_V(6); PG8_BAR; PG8_MMA(1, 1, At, B1); PG8_BAR;
    if constexpr (Epi::HOOKS) {
      asm volatile("" : "+v"(aoff), "+v"(boff));
      PG8_VOFF(opaque_tid());
      for (int t = 0; t < Epi::H1; t += 2) { PG8_KBODY }
      E.hook(acc, cur, wr, wc, fr, fq, Epi::H1);
      asm volatile("" : "+v"(aoff), "+v"(boff));
      PG8_VOFF(opaque_tid());
      for (int t = Epi::H1; t < Epi::H2; t += 2) { PG8_KBODY }
      E.hook(acc, cur, wr, wc, fr, fq, Epi::H2);
      asm volatile("" : "+v"(aoff), "+v"(boff));
      PG8_VOFF(opaque_tid());
      for (int t = Epi::H2; t < nt; t += 2) { PG8_KBODY }
    } else {
      for (int t = 0; t < nt; t += 2) { PG8_KBODY }
    }
#undef PG8_KBODY
    E(acc, cur, wr, wc, fr, fq);
    if (!has_next) break;
#pragma unroll
    for (int a = 0; a < 2; ++a)
#pragma unroll
      for (int b = 0; b < 2; ++b)
#pragma unroll
        for (int m = 0; m < 4; ++m)
#pragma unroll
          for (int n = 0; n < 2; ++n) acc[a][b][m][n] = (acc_t){0, 0, 0, 0};
    cur = nxt; cA = nA; cB = nB; ++ui;
  }
  PG8_WAIT_V(0);
  if (wr == 0) PG8_BAR;
  PG8_BAR;
#undef PG8_VOFF
#undef PG8_SA
#undef PG8_SB
#undef PG8_STAGE
#undef PG8_LDA
#undef PG8_LDB
#undef PG8_MMA
#undef PG8_WAIT_V
#undef PG8_WAIT_L
#undef PG8_BAR
#undef PG8_SCHED
}
typedef const f32x4 (&AccRef)[2][2][4][2];
typedef const i32x4 (&AccRefI)[2][2][4][2];
struct EpiInprojN {
  static constexpr bool PERM = true; static constexpr bool HOOKS = false; static constexpr int H1 = 0, H2 = 0;
  typedef f32x4 acc_t;
  u16* qk; u16* rg;
  __device__ __forceinline__ void operator()(AccRef acc, const Unit& u, int wr, int wc, int fr, int fq) const {
    const int row0 = u.pm * BM + wr * 64 + fr;
    u16* base; int ld, colt;
    if (u.pn < 4) { base = qk; ld = 1024; colt = u.pn * 256; } else { base = rg; ld = 512; colt = (u.pn - 9) * 256; }
    const int col0 = colt + wc * 32 + 8 * fq;
#pragma unroll
    for (int ai = 0; ai < 2; ++ai)
#pragma unroll
      for (int m = 0; m < 4; ++m) {
        u16* rowp = base + (size_t)(row0 + ai * HALF + m * 16) * ld + col0;
#pragma unroll
        for (int bj = 0; bj < 2; ++bj) {
          const f32x4 v0 = acc[ai][bj][m][0], v1 = acc[ai][bj][m][1];
          u32x4 w; w.x = pkh(v0[0], v0[1]); w.y = pkh(v0[2], v0[3]); w.z = pkh(v1[0], v1[1]); w.w = pkh(v1[2], v1[3]);
          *(u32x4*)(rowp + bj * HALF) = w;
        }
      }
  }
};
struct EpiInprojT {
  static constexpr bool PERM = true; static constexpr bool HOOKS = false; static constexpr int H1 = 0, H2 = 0;
  typedef f32x4 acc_t;
  u16 *vT, *vTc, *hyT, *hyTc;
  __device__ __forceinline__ void operator()(AccRef acc, const Unit& u, int wr, int wc, int fr, int fq) const {
    const bool isctx = (u.pn >= 128);
    const int b = isctx ? (u.pn - 128) : (u.pn >> 4);
    const int Lseg = isctx ? 256 : 4096, t0 = isctx ? 0 : (u.pn & 15) * 256;
    const bool isv = (u.pm < 2);
    const size_t boff = isv ? (isctx ? (size_t)16777216 : (size_t)0) : (isctx ? (size_t)(16777216 + 1048576 + 25165824) : (size_t)(16777216 + 1048576));
    u16* base = vT + boff;
    const int nc = isv ? 512 : 768;
    const int wrow0 = (isv ? u.pm : u.pm - 2) * BM + wr * 64 + fr;
    const int col0 = t0 + wc * 32 + 8 * fq;
#pragma unroll
    for (int ai = 0; ai < 2; ++ai)
#pragma unroll
      for (int m = 0; m < 4; ++m) {
        u16* rowp = base + ((size_t)(b * nc + wrow0 + ai * HALF + m * 16)) * Lseg + col0;
#pragma unroll
        for (int bj = 0; bj < 2; ++bj) {
          const f32x4 v0 = acc[ai][bj][m][0], v1 = acc[ai][bj][m][1];
          u32x4 w; w.x = pkh(v0[0], v0[1]); w.y = pkh(v0[2], v0[3]); w.z = pkh(v1[0], v1[1]); w.w = pkh(v1[2], v1[3]);
          *(u32x4*)(rowp + bj * HALF) = w;
        }
      }
  }
};
struct EpiGate {
  static constexpr bool PERM = true; static constexpr bool HOOKS = false; static constexpr int H1 = 0, H2 = 0;
  typedef f32x4 acc_t;
  unsigned char* g8; const float* bias;
  __device__ __forceinline__ void operator()(AccRef acc, const Unit& u, int wr, int wc, int fr, int fq) const {
    const int row0 = u.pm * BM + wr * 64 + fr;
    const int col0 = u.pn * BM + wc * 32 + 8 * fq;
#pragma unroll
    for (int bj = 0; bj < 2; ++bj) {
      const f32x4 b0 = *(const f32x4*)(bias + col0 + bj * HALF), b1 = *(const f32x4*)(bias + col0 + bj * HALF + 4);
#pragma unroll
      for (int ai = 0; ai < 2; ++ai)
#pragma unroll
        for (int m = 0; m < 4; ++m) {
          const f32x4 v0 = acc[ai][bj][m][0] + b0, v1 = acc[ai][bj][m][1] + b1;
          unsigned w0 = 0, w1 = 0;
#pragma unroll
          for (int k = 0; k < 4; ++k) {
            w0 |= (unsigned)(sigmoidf_(v0[k]) * 255.0f + 0.5f) << (8 * k);
            w1 |= (unsigned)(sigmoidf_(v1[k]) * 255.0f + 0.5f) << (8 * k);
          }
          *(uint2*)(g8 + (size_t)(row0 + ai * HALF + m * 16) * 3072 + col0 + bj * HALF) = make_uint2(w0, w1);
        }
    }
  }
};
struct EpiBranch {
  static constexpr bool PERM = true; static constexpr bool HOOKS = false; static constexpr int H1 = 0, H2 = 0;
  typedef f32x4 acc_t;
  u16* mbuf; const unsigned char* g8; int br;
  __device__ __forceinline__ void operator()(AccRef acc, const Unit& u, int wr, int wc, int fr, int fq) const {
    const int row0 = u.pm * BM + wr * 64 + fr;
    const int col0 = u.pn * BM + wc * 32 + 8 * fq;
    uint2 gq[2][2][2];
    u32x4 o[2][2][2];
#define EB_LOAD(G) do { _Pragma("unroll") for (int j = 0; j < 2; ++j) _Pragma("unroll") for (int bj = 0; bj < 2; ++bj) { \
      const size_t row = (size_t)(row0 + (((G) * 2 + j) >> 2) * HALF + (((G) * 2 + j) & 3) * 16); \
      gq[(G) & 1][j][bj] = *(const uint2*)(g8 + row * 3072 + br * 1024 + col0 + bj * HALF); \
      if (br != 0) o[(G) & 1][j][bj] = *(const u32x4*)(mbuf + row * 1024 + col0 + bj * HALF); } } while (0)
    EB_LOAD(0);
#pragma unroll
    for (int G = 0; G < 4; ++G) {
      if (G < 3) EB_LOAD(G + 1);
#pragma unroll
      for (int j = 0; j < 2; ++j) {
        const int ai = (G * 2 + j) >> 2, m = (G * 2 + j) & 3;
        const size_t row = (size_t)(row0 + ai * HALF + m * 16);
#pragma unroll
        for (int bj = 0; bj < 2; ++bj) {
          const uint2 g = gq[G & 1][j][bj];
          u16* mp = mbuf + row * 1024 + col0 + bj * HALF;
          const f32x4 v0 = acc[ai][bj][m][0], v1 = acc[ai][bj][m][1];
          float r[8];
          r[0] = (float)(g.x & 255u) * v0[0]; r[1] = (float)((g.x >> 8) & 255u) * v0[1];
          r[2] = (float)((g.x >> 16) & 255u) * v0[2]; r[3] = (float)(g.x >> 24) * v0[3];
          r[4] = (float)(g.y & 255u) * v1[0]; r[5] = (float)((g.y >> 8) & 255u) * v1[1];
          r[6] = (float)((g.y >> 16) & 255u) * v1[2]; r[7] = (float)(g.y >> 24) * v1[3];
          u32x4 w;
          if (br == 0) {
            w.x = pkh(r[0] * (1.f / 255.f), r[1] * (1.f / 255.f)); w.y = pkh(r[2] * (1.f / 255.f), r[3] * (1.f / 255.f));
            w.z = pkh(r[4] * (1.f / 255.f), r[5] * (1.f / 255.f)); w.w = pkh(r[6] * (1.f / 255.f), r[7] * (1.f / 255.f));
          } else {
            const u32x4 ov = o[G & 1][j][bj];
            w.x = pkh(bflo(ov.x) + r[0] * (1.f / 255.f), bfhi(ov.x) + r[1] * (1.f / 255.f));
            w.y = pkh(bflo(ov.y) + r[2] * (1.f / 255.f), bfhi(ov.y) + r[3] * (1.f / 255.f));
            w.z = pkh(bflo(ov.z) + r[4] * (1.f / 255.f), bfhi(ov.z) + r[5] * (1.f / 255.f));
            w.w = pkh(bflo(ov.w) + r[6] * (1.f / 255.f), bfhi(ov.w) + r[7] * (1.f / 255.f));
          }
          *(u32x4*)mp = w;
        }
      }
    }
#undef EB_LOAD
  }
};
struct EpiBranchF {
  static constexpr bool PERM = true; static constexpr bool HOOKS = true;
  static constexpr int H1 = 8, H2 = 12;
  typedef f32x4 acc_t;
  u16* mbuf; const unsigned char* g8;
  template <int NUM, int NG>
  __device__ __forceinline__ void rescale(f32x4 (&acc)[2][2][4][2], const Unit& u) const {
    const int tid_ = opaque_tid(), lane_ = tid_ & 63, wid_ = tid_ >> 6;
    const int row0 = u.pm * BM + (wid_ >> 2) * 64 + (lane_ & 15);
    const int col0 = u.pn * BM + (wid_ & 3) * 32 + 8 * (lane_ >> 4);
    constexpr int PER = 8 / NG;
#pragma unroll
    for (int G = 0; G < NG; ++G) {
      __builtin_amdgcn_sched_barrier(0);
      uint2 gn[PER][2], gd[PER][2];
#pragma unroll
      for (int j = 0; j < PER; ++j)
#pragma unroll
        for (int bj = 0; bj < 2; ++bj) {
          const unsigned char* gp = g8 + (size_t)(row0 + ((G * PER + j) >> 2) * HALF + ((G * PER + j) & 3) * 16) * 3072 + col0 + bj * HALF;
          gn[j][bj] = *(const uint2*)(gp + NUM * 1024); gd[j][bj] = *(const uint2*)(gp + (NUM + 1) * 1024);
        }
#pragma unroll
      for (int j = 0; j < PER; ++j) {
        const int ai = (G * PER + j) >> 2, m = (G * PER + j) & 3;
#pragma unroll
        for (int bj = 0; bj < 2; ++bj) {
          __builtin_amdgcn_sched_barrier(0);
          const unsigned n0 = gn[j][bj].x, n1 = gn[j][bj].y, d0 = gd[j][bj].x, d1 = gd[j][bj].y;
          f32x4 r0, r1;
#pragma unroll
          for (int k = 0; k < 4; ++k) {
            float fn0 = (float)((n0 >> (8 * k)) & 255u), fn1 = (float)((n1 >> (8 * k)) & 255u);
            if (NUM != 0) { fn0 = fmaxf(fn0, 1.0f); fn1 = fmaxf(fn1, 1.0f); }
            const float fd0 = fmaxf((float)((d0 >> (8 * k)) & 255u), 1.0f), fd1 = fmaxf((float)((d1 >> (8 * k)) & 255u), 1.0f);
            r0[k] = fn0 * __builtin_amdgcn_rcpf(fd0);
            r1[k] = fn1 * __builtin_amdgcn_rcpf(fd1);
          }
          acc[ai][bj][m][0] *= r0;
          acc[ai][bj][m][1] *= r1;
        }
      }
    }
    __builtin_amdgcn_sched_barrier(0);
  }
  __device__ __forceinline__ void hook(f32x4 (&acc)[2][2][4][2], const Unit& u, int wr, int wc, int fr, int fq, int t) const {
    if (t == H1) rescale<0, HOOK_NG>(acc, u); else rescale<1, HOOK_NG>(acc, u);
  }
  __device__ __forceinline__ void operator()(AccRef acc, const Unit& u, int wr, int wc, int fr, int fq) const {
    const int tid_ = opaque_tid(), lane_ = tid_ & 63, wid_ = tid_ >> 6;
    const int row0 = u.pm * BM + (wid_ >> 2) * 64 + (lane_ & 15);
    const int col0 = u.pn * BM + (wid_ & 3) * 32 + 8 * (lane_ >> 4);
    uint2 gq[2][4][2];
#pragma unroll
    for (int ai = 0; ai < 2; ++ai)
#pragma unroll
      for (int m = 0; m < 4; ++m)
#pragma unroll
        for (int bj = 0; bj < 2; ++bj)
          gq[ai][m][bj] = *(const uint2*)(g8 + (size_t)(row0 + ai * HALF + m * 16) * 3072 + 2048 + col0 + bj * HALF);
#pragma unroll
    for (int ai = 0; ai < 2; ++ai)
#pragma unroll
      for (int m = 0; m < 4; ++m)
#pragma unroll
        for (int bj = 0; bj < 2; ++bj) {
          const uint2 g = gq[ai][m][bj];
          const f32x4 v0 = acc[ai][bj][m][0], v1 = acc[ai][bj][m][1];
          float r[8];
#pragma unroll
          for (int k = 0; k < 4; ++k) {
            r[k] = fmaxf((float)((g.x >> (8 * k)) & 255u), 1.0f) * (1.f / 255.f) * v0[k];
            r[4 + k] = fmaxf((float)((g.y >> (8 * k)) & 255u), 1.0f) * (1.f / 255.f) * v1[k];
          }
          u32x4 w;
          w.x = pkh(r[0], r[1]); w.y = pkh(r[2], r[3]); w.z = pkh(r[4], r[5]); w.w = pkh(r[6], r[7]);
          *(u32x4*)(mbuf + (size_t)(row0 + ai * HALF + m * 16) * 1024 + col0 + bj * HALF) = w;
        }
  }
};
template <bool SRC_F32>
struct EpiOutR {
  static constexpr bool PERM = true; static constexpr bool HOOKS = false; static constexpr int H1 = 0, H2 = 0;
  typedef f32x4 acc_t;
  const float *xsrc, *csrc; u16* res; const float* modl;
  __device__ __forceinline__ void operator()(AccRef acc, const Unit& u, int wr, int wc, int fr, int fq) const {
    const bool isctx = (u.pm >= 128);
    const int bi = isctx ? 8 : (u.pm >> 4);
    const float* gatev = modl + ((size_t)bi * 6 + 2) * 1024;
    const int row0 = u.pm * BM + wr * 64 + fr, col0 = u.pn * BM + wc * 32 + 8 * fq;
    f32x4 gv[2][2];
#pragma unroll
    for (int bj = 0; bj < 2; ++bj) { gv[bj][0] = *(const f32x4*)(gatev + col0 + bj * HALF); gv[bj][1] = *(const f32x4*)(gatev + col0 + bj * HALF + 4); }
    if (SRC_F32) {
      const float* src = isctx ? (csrc - (size_t)NLAT * 1024) : xsrc;
#pragma unroll
      for (int G = 0; G < 4; ++G) {
        f32x4 sv[2][2][2];
#pragma unroll
        for (int j = 0; j < 2; ++j)
#pragma unroll
          for (int bj = 0; bj < 2; ++bj) {
            const float* sp = src + (size_t)(row0 + ((G * 2 + j) >> 2) * HALF + ((G * 2 + j) & 3) * 16) * 1024 + col0 + bj * HALF;
            sv[j][bj][0] = *(const f32x4*)sp; sv[j][bj][1] = *(const f32x4*)(sp + 4);
          }
#pragma unroll
        for (int j = 0; j < 2; ++j) {
          const int ai = (G * 2 + j) >> 2, m = (G * 2 + j) & 3;
#pragma unroll
          for (int bj = 0; bj < 2; ++bj) {
            const f32x4 o0 = sv[j][bj][0] + gv[bj][0] * acc[ai][bj][m][0], o1 = sv[j][bj][1] + gv[bj][1] * acc[ai][bj][m][1];
            u32x4 w;
            w.x = pkh(o0[0], o0[1]); w.y = pkh(o0[2], o0[3]); w.z = pkh(o1[0], o1[1]); w.w = pkh(o1[2], o1[3]);
            *(u32x4*)(res + (size_t)(row0 + ai * HALF + m * 16) * 1024 + col0 + bj * HALF) = w;
          }
        }
      }
    } else {
#pragma unroll
      for (int G = 0; G < 2; ++G) {
        u32x4 sv[4][2];
#pragma unroll
        for (int m = 0; m < 4; ++m)
#pragma unroll
          for (int bj = 0; bj < 2; ++bj) sv[m][bj] = *(const u32x4*)(res + (size_t)(row0 + G * HALF + m * 16) * 1024 + col0 + bj * HALF);
#pragma unroll
        for (int m = 0; m < 4; ++m)
#pragma unroll
          for (int bj = 0; bj < 2; ++bj) {
            const u32x4 r = sv[m][bj];
            const f32x4 a0 = acc[G][bj][m][0], a1 = acc[G][bj][m][1], g0 = gv[bj][0], g1 = gv[bj][1];
            u32x4 w;
            w.x = pkh(bflo(r.x) + g0[0] * a0[0], bfhi(r.x) + g0[1] * a0[1]); w.y = pkh(bflo(r.y) + g0[2] * a0[2], bfhi(r.y) + g0[3] * a0[3]);
            w.z = pkh(bflo(r.z) + g1[0] * a1[0], bfhi(r.z) + g1[1] * a1[1]); w.w = pkh(bflo(r.w) + g1[2] * a1[2], bfhi(r.w) + g1[3] * a1[3]);
            *(u32x4*)(res + (size_t)(row0 + G * HALF + m * 16) * 1024 + col0 + bj * HALF) = w;
          }
      }
    }
  }
};
struct EpiQ {
  static constexpr bool PERM = true; static constexpr bool HOOKS = false; static constexpr int H1 = 0, H2 = 0;
  typedef f32x4 acc_t;
  u16* q;
  __device__ __forceinline__ void operator()(AccRef acc, const Unit& u, int wr, int wc, int fr, int fq) const {
    const int row0 = u.pm * BM + wr * 64 + fr;
    const int col0 = u.pn * BM + wc * 32 + 8 * fq;
#pragma unroll
    for (int ai = 0; ai < 2; ++ai)
#pragma unroll
      for (int m = 0; m < 4; ++m) {
        u16* rowp = q + (size_t)(row0 + ai * HALF + m * 16) * 2048 + col0;
#pragma unroll
        for (int bj = 0; bj < 2; ++bj) {
          const f32x4 v0 = acc[ai][bj][m][0], v1 = acc[ai][bj][m][1];
          u32x4 w;
          w.x = __builtin_bit_cast(unsigned, __builtin_amdgcn_cvt_pkrtz(v0[0], v0[1]));
          w.y = __builtin_bit_cast(unsigned, __builtin_amdgcn_cvt_pkrtz(v0[2], v0[3]));
          w.z = __builtin_bit_cast(unsigned, __builtin_amdgcn_cvt_pkrtz(v1[0], v1[1]));
          w.w = __builtin_bit_cast(unsigned, __builtin_amdgcn_cvt_pkrtz(v1[2], v1[3]));
          *(u32x4*)(rowp + bj * HALF) = w;
        }
      }
  }
};
struct EpiQ8 {
  static constexpr bool PERM = true; static constexpr bool HOOKS = false; static constexpr int H1 = 0, H2 = 0;
  typedef i32x4 acc_t;
  u16* q; const float* sa; const float* sw;
  __device__ __forceinline__ void operator()(AccRefI acc, const Unit& u, int wr, int wc, int fr, int fq) const {
    const int row0 = u.pm * BM + wr * 64 + fr;
    const int col0 = u.pn * BM + wc * 32 + 8 * fq;
    float rs[8];
    f32x4 cs[2][2];
#pragma unroll
    for (int i = 0; i < 8; ++i) rs[i] = sa[row0 + (i >> 2) * HALF + (i & 3) * 16];
#pragma unroll
    for (int bj = 0; bj < 2; ++bj) { cs[bj][0] = *(const f32x4*)(sw + col0 + bj * HALF); cs[bj][1] = *(const f32x4*)(sw + col0 + bj * HALF + 4); }
#pragma unroll
    for (int ai = 0; ai < 2; ++ai)
#pragma unroll
      for (int m = 0; m < 4; ++m) {
        u16* rowp = q + (size_t)(row0 + ai * HALF + m * 16) * 2048 + col0;
        const float r = rs[ai * 4 + m];
#pragma unroll
        for (int bj = 0; bj < 2; ++bj) {
          const i32x4 a0 = acc[ai][bj][m][0], a1 = acc[ai][bj][m][1];
          const f32x4 c0 = cs[bj][0], c1 = cs[bj][1];
          u32x4 w;
          w.x = __builtin_bit_cast(unsigned, __builtin_amdgcn_cvt_pkrtz((float)a0[0] * r * c0[0], (float)a0[1] * r * c0[1]));
          w.y = __builtin_bit_cast(unsigned, __builtin_amdgcn_cvt_pkrtz((float)a0[2] * r * c0[2], (float)a0[3] * r * c0[3]));
          w.z = __builtin_bit_cast(unsigned, __builtin_amdgcn_cvt_pkrtz((float)a1[0] * r * c1[0], (float)a1[1] * r * c1[1]));
          w.w = __builtin_bit_cast(unsigned, __builtin_amdgcn_cvt_pkrtz((float)a1[2] * r * c1[2], (float)a1[3] * r * c1[3]));
          *(u32x4*)(rowp + bj * HALF) = w;
        }
      }
  }
};
struct EpiInprojN8 {
  static constexpr bool PERM = true; static constexpr bool HOOKS = false; static constexpr int H1 = 0, H2 = 0;
  typedef i32x4 acc_t;
  u16* qk; u16* rg; const float* sa; const float* sw;
  __device__ __forceinline__ void operator()(AccRefI acc, const Unit& u, int wr, int wc, int fr, int fq) const {
    const int row0 = u.pm * BM + wr * 64 + fr;
    u16* base; int ld, colt;
    if (u.pn < 4) { base = qk; ld = 1024; colt = u.pn * 256; } else { base = rg; ld = 512; colt = (u.pn - 9) * 256; }
    const int col0 = colt + wc * 32 + 8 * fq;
    const int wcol0 = u.pn * 256 + wc * 32 + 8 * fq;
    float rs[8];
    f32x4 cs[2][2];
#pragma unroll
    for (int i = 0; i < 8; ++i) rs[i] = sa[row0 + (i >> 2) * HALF + (i & 3) * 16];
#pragma unroll
    for (int bj = 0; bj < 2; ++bj) { cs[bj][0] = *(const f32x4*)(sw + wcol0 + bj * HALF); cs[bj][1] = *(const f32x4*)(sw + wcol0 + bj * HALF + 4); }
#pragma unroll
    for (int bj = 0; bj < 2; ++bj) {
      const f32x4 c0 = cs[bj][0], c1 = cs[bj][1];
#pragma unroll
      for (int ai = 0; ai < 2; ++ai)
#pragma unroll
        for (int m = 0; m < 4; ++m) {
          const int row = row0 + ai * HALF + m * 16;
          const float r = rs[ai * 4 + m];
          const i32x4 a0 = acc[ai][bj][m][0], a1 = acc[ai][bj][m][1];
          u32x4 w;
          w.x = pkh((float)a0[0] * r * c0[0], (float)a0[1] * r * c0[1]); w.y = pkh((float)a0[2] * r * c0[2], (float)a0[3] * r * c0[3]);
          w.z = pkh((float)a1[0] * r * c1[0], (float)a1[1] * r * c1[1]); w.w = pkh((float)a1[2] * r * c1[2], (float)a1[3] * r * c1[3]);
          *(u32x4*)(base + (size_t)row * ld + col0 + bj * HALF) = w;
        }
    }
  }
};
struct EpiInprojT8 {
  static constexpr bool PERM = true; static constexpr bool HOOKS = false; static constexpr int H1 = 0, H2 = 0;
  typedef i32x4 acc_t;
  u16* vT; const float* sa; const float* sw;
  __device__ __forceinline__ void operator()(AccRefI acc, const Unit& u, int wr, int wc, int fr, int fq) const {
    const bool isctx = (u.pn >= 128);
    const int b = isctx ? (u.pn - 128) : (u.pn >> 4);
    const int Lseg = isctx ? 256 : 4096, t0 = isctx ? 0 : (u.pn & 15) * 256;
    const bool isv = (u.pm < 2);
    const size_t boff = isv ? (isctx ? (size_t)16777216 : (size_t)0) : (isctx ? (size_t)(16777216 + 1048576 + 25165824) : (size_t)(16777216 + 1048576));
    u16* base = vT + boff;
    const int nc = isv ? 512 : 768;
    const int wrow0 = (isv ? u.pm : u.pm - 2) * BM + wr * 64 + fr;
    const int srow0 = u.pm * BM + wr * 64 + fr;
    const int col0 = t0 + wc * 32 + 8 * fq;
    const int tok0 = u.pn * BM + wc * 32 + 8 * fq;
    float rs[8];
    f32x4 cs[2][2];
#pragma unroll
    for (int i = 0; i < 8; ++i) rs[i] = sw[srow0 + (i >> 2) * HALF + (i & 3) * 16];
#pragma unroll
    for (int bj = 0; bj < 2; ++bj) { cs[bj][0] = *(const f32x4*)(sa + tok0 + bj * HALF); cs[bj][1] = *(const f32x4*)(sa + tok0 + bj * HALF + 4); }
#pragma unroll
    for (int bj = 0; bj < 2; ++bj) {
      const f32x4 c0 = cs[bj][0], c1 = cs[bj][1];
#pragma unroll
      for (int ai = 0; ai < 2; ++ai)
#pragma unroll
        for (int m = 0; m < 4; ++m) {
          const float r = rs[ai * 4 + m];
          const i32x4 a0 = acc[ai][bj][m][0], a1 = acc[ai][bj][m][1];
          u32x4 w;
          w.x = pkh((float)a0[0] * r * c0[0], (float)a0[1] * r * c0[1]); w.y = pkh((float)a0[2] * r * c0[2], (float)a0[3] * r * c0[3]);
          w.z = pkh((float)a1[0] * r * c1[0], (float)a1[1] * r * c1[1]); w.w = pkh((float)a1[2] * r * c1[2], (float)a1[3] * r * c1[3]);
          *(u32x4*)(base + ((size_t)(b * nc + wrow0 + ai * HALF + m * 16)) * Lseg + col0 + bj * HALF) = w;
        }
    }
  }
};
struct EpiGate8 {
  static constexpr bool PERM = true; static constexpr bool HOOKS = false; static constexpr int H1 = 0, H2 = 0;
  typedef i32x4 acc_t;
  unsigned char* g8; const float* bias; const float* sa; const float* sw;
  __device__ __forceinline__ void operator()(AccRefI acc, const Unit& u, int wr, int wc, int fr, int fq) const {
    const int row0 = u.pm * BM + wr * 64 + fr;
    const int col0 = u.pn * BM + wc * 32 + 8 * fq;
    typedef float f32x2 __attribute__((ext_vector_type(2)));
    float rs[8];
    f32x4 bs[2][2], cs[2][2];
#pragma unroll
    for (int i = 0; i < 8; ++i) rs[i] = sa[row0 + (i >> 2) * HALF + (i & 3) * 16];
#pragma unroll
    for (int bj = 0; bj < 2; ++bj) {
      bs[bj][0] = *(const f32x4*)(bias + col0 + bj * HALF); bs[bj][1] = *(const f32x4*)(bias + col0 + bj * HALF + 4);
      cs[bj][0] = *(const f32x4*)(sw + col0 + bj * HALF); cs[bj][1] = *(const f32x4*)(sw + col0 + bj * HALF + 4);
    }
#pragma unroll
    for (int bj = 0; bj < 2; ++bj) {
      f32x2 cn[4], bn[4];
#pragma unroll
      for (int k = 0; k < 2; ++k) {
        cn[k] = (f32x2){cs[bj][0][2 * k], cs[bj][0][2 * k + 1]} * -1.4426950408889634f; cn[2 + k] = (f32x2){cs[bj][1][2 * k], cs[bj][1][2 * k + 1]} * -1.4426950408889634f;
        bn[k] = (f32x2){bs[bj][0][2 * k], bs[bj][0][2 * k + 1]} * -1.4426950408889634f; bn[2 + k] = (f32x2){bs[bj][1][2 * k], bs[bj][1][2 * k + 1]} * -1.4426950408889634f;
      }
#pragma unroll
      for (int ai = 0; ai < 2; ++ai)
#pragma unroll
        for (int m = 0; m < 4; ++m) {
          const int row = row0 + ai * HALF + m * 16;
          const float r = rs[ai * 4 + m];
          const i32x4 a0 = acc[ai][bj][m][0], a1 = acc[ai][bj][m][1];
          unsigned qb[8];
#pragma unroll
          for (int k = 0; k < 4; ++k) {
            const f32x2 av = (k < 2) ? (f32x2){(float)a0[2 * k], (float)a0[2 * k + 1]} : (f32x2){(float)a1[2 * k - 4], (float)a1[2 * k - 3]};
            const f32x2 z = __builtin_elementwise_fma(av * r, cn[k], bn[k]);
            const f32x2 d = (f32x2){__builtin_amdgcn_exp2f(z.x), __builtin_amdgcn_exp2f(z.y)} + 1.0f;
            const f32x2 sg = {__builtin_amdgcn_rcpf(d.x), __builtin_amdgcn_rcpf(d.y)};
            const f32x2 q = __builtin_elementwise_fma(sg, (f32x2){255.0f, 255.0f}, (f32x2){8388608.0f, 8388608.0f});
            const float qx = q.x, qy = q.y;
            qb[2 * k] = __float_as_uint(qx); qb[2 * k + 1] = __float_as_uint(qy);
          }
          unsigned p0, p1, p2, p3;
          asm("v_perm_b32 %0, %1, %2, %3" : "=v"(p0) : "v"(qb[1]), "v"(qb[0]), "s"(0x0c0c0400u));
          asm("v_perm_b32 %0, %1, %2, %3" : "=v"(p1) : "v"(qb[3]), "v"(qb[2]), "s"(0x04000c0cu));
          asm("v_perm_b32 %0, %1, %2, %3" : "=v"(p2) : "v"(qb[5]), "v"(qb[4]), "s"(0x0c0c0400u));
          asm("v_perm_b32 %0, %1, %2, %3" : "=v"(p3) : "v"(qb[7]), "v"(qb[6]), "s"(0x04000c0cu));
          const unsigned w0 = p0 | p1, w1 = p2 | p3;
          *(uint2*)(g8 + (size_t)row * 3072 + col0 + bj * HALF) = make_uint2(w0, w1);
        }
    }
  }
};
}

__device__ __forceinline__ void tr_tile(const float* __restrict__ src, int N, int K, u16* __restrict__ dst, int tile, char* smem) {
  float* lds = (float*)smem;
  const int tiles_n = N >> 6;
  const int tk = tile / tiles_n, tn = tile - tk * tiles_n;
  const int tid = opaque_tid();
  {
    const int r = tid >> 3, c8 = (tid & 7) * 8;
    const float* s = src + (size_t)(tk * 64 + r) * N + tn * 64 + c8;
    float4 a = *(const float4*)s, b = *(const float4*)(s + 4);
    float* d = lds + r * 65 + c8;
    d[0] = a.x; d[1] = a.y; d[2] = a.z; d[3] = a.w; d[4] = b.x; d[5] = b.y; d[6] = b.z; d[7] = b.w;
  }
  __syncthreads();
  {
    const int n = tid >> 3, k0 = (tid & 7) * 8;
    uint4 o;
    o.x = pk2(lds[(k0 + 0) * 65 + n], lds[(k0 + 1) * 65 + n]);
    o.y = pk2(lds[(k0 + 2) * 65 + n], lds[(k0 + 3) * 65 + n]);
    o.z = pk2(lds[(k0 + 4) * 65 + n], lds[(k0 + 5) * 65 + n]);
    o.w = pk2(lds[(k0 + 6) * 65 + n], lds[(k0 + 7) * 65 + n]);
    *(uint4*)(dst + (size_t)(tn * 64 + n) * K + tk * 64 + k0) = o;
  }
  __syncthreads();
}
__device__ __forceinline__ void colmax_task(const float* __restrict__ w, int N, int n0, float* __restrict__ swp, char* smem) {
  const int tid = opaque_tid();
  const int col = tid & 63, kg = tid >> 6;
  float m = 0.f;
  const float* wp = w + (size_t)(kg * 128) * N + n0 + col;
#pragma unroll 16
  for (int k = 0; k < 128; ++k) m = fmaxf(m, fabsf(wp[(size_t)k * N]));
  float* red = (float*)smem;
  red[kg * 64 + col] = m;
  __syncthreads();
  if (tid < 64) {
    float mm = red[tid];
#pragma unroll
    for (int g = 1; g < 8; ++g) mm = fmaxf(mm, red[g * 64 + tid]);
    swp[n0 + tid] = fmaxf(mm, 1e-20f) * (1.0f / 127.0f);
  }
  __syncthreads();
}
__device__ __forceinline__ void tr_tile_i8(const float* __restrict__ src, int N, int K, unsigned char* __restrict__ dst, int tile, const float* __restrict__ swp, char* smem) {
  float* lds = (float*)smem;
  const int tiles_n = N >> 6;
  const int tk = tile / tiles_n, tn = tile - tk * tiles_n;
  const int tid = opaque_tid();
  {
    const int r = tid >> 3, c8 = (tid & 7) * 8;
    const float* sp = src + (size_t)(tk * 64 + r) * N + tn * 64 + c8;
    float4 a = *(const float4*)sp, b = *(const float4*)(sp + 4);
    float* d = lds + r * 65 + c8;
    d[0] = a.x; d[1] = a.y; d[2] = a.z; d[3] = a.w; d[4] = b.x; d[5] = b.y; d[6] = b.z; d[7] = b.w;
  }
  __syncthreads();
  {
    const int n = tid >> 3, k0 = (tid & 7) * 8;
    const float inv = 1.0f / swp[tn * 64 + n];
    unsigned w0 = 0, w1 = 0;
#pragma unroll
    for (int i = 0; i < 4; ++i) {
      w0 |= ((unsigned)__float2int_rn(lds[(k0 + i) * 65 + n] * inv) & 255u) << (8 * i);
      w1 |= ((unsigned)__float2int_rn(lds[(k0 + 4 + i) * 65 + n] * inv) & 255u) << (8 * i);
    }
    *(uint2*)(dst + (size_t)(tn * 64 + n) * K + tk * 64 + k0) = make_uint2(w0, w1);
  }
  __syncthreads();
}
__device__ __forceinline__ void cvt_chunk(const float* __restrict__ src, u16* __restrict__ dst, size_t chunk) {
  const size_t i = chunk * 4096 + (size_t)opaque_tid() * 8;
  float4 a = *(const float4*)(src + i), b = *(const float4*)(src + i + 4);
  uint4 o;
  o.x = pk2(a.x, a.y); o.y = pk2(a.z, a.w); o.z = pk2(b.x, b.y); o.w = pk2(b.z, b.w);
  *(uint4*)(dst + i) = o;
}
template <bool I8>
__device__ __forceinline__ void tr_tile4(const float* __restrict__ src, int N, int K, void* __restrict__ dstv, int tile4, const float* __restrict__ swp, char* smem) {
  float* lds = (float*)smem;
  const int tiles_n = N >> 6;
  const int tkq = tile4 / tiles_n, tn = tile4 - tkq * tiles_n;
  const int tid = opaque_tid();
  {
    const int r = tid >> 3, c8 = (tid & 7) * 8;
    const float* sp = src + (size_t)(tkq * 256 + r) * N + tn * 64 + c8;
    float4 a[4], b[4];
#pragma unroll
    for (int q = 0; q < 4; ++q) { a[q] = *(const float4*)(sp + (size_t)q * 64 * N); b[q] = *(const float4*)(sp + (size_t)q * 64 * N + 4); }
    __builtin_amdgcn_sched_barrier(0);
#pragma unroll
    for (int q = 0; q < 4; ++q) {
      float* d = lds + q * 4160 + r * 65 + c8;
      d[0] = a[q].x; d[1] = a[q].y; d[2] = a[q].z; d[3] = a[q].w; d[4] = b[q].x; d[5] = b[q].y; d[6] = b[q].z; d[7] = b[q].w;
    }
  }
  __syncthreads();
  {
    const int n = tid >> 3, k0 = (tid & 7) * 8;
    if (I8) {
      const float inv = 1.0f / swp[tn * 64 + n];
      unsigned char* dst = (unsigned char*)dstv;
#pragma unroll
      for (int q = 0; q < 4; ++q) {
        const float* lq = lds + q * 4160;
        unsigned w0 = 0, w1 = 0;
#pragma unroll
        for (int i = 0; i < 4; ++i) {
          w0 |= ((unsigned)__float2int_rn(lq[(k0 + i) * 65 + n] * inv) & 255u) << (8 * i);
          w1 |= ((unsigned)__float2int_rn(lq[(k0 + 4 + i) * 65 + n] * inv) & 255u) << (8 * i);
        }
        *(uint2*)(dst + (size_t)(tn * 64 + n) * K + tkq * 256 + q * 64 + k0) = make_uint2(w0, w1);
      }
    } else {
      u16* dst = (u16*)dstv;
#pragma unroll
      for (int q = 0; q < 4; ++q) {
        const float* lq = lds + q * 4160;
        uint4 o;
        o.x = pk2(lq[(k0 + 0) * 65 + n], lq[(k0 + 1) * 65 + n]);
        o.y = pk2(lq[(k0 + 2) * 65 + n], lq[(k0 + 3) * 65 + n]);
        o.z = pk2(lq[(k0 + 4) * 65 + n], lq[(k0 + 5) * 65 + n]);
        o.w = pk2(lq[(k0 + 6) * 65 + n], lq[(k0 + 7) * 65 + n]);
        *(uint4*)(dst + (size_t)(tn * 64 + n) * K + tkq * 256 + q * 64 + k0) = o;
      }
    }
  }
  __syncthreads();
}
__device__ __forceinline__ void colmax4_task(const float* __restrict__ w, int N, int n0, float* __restrict__ swp, char* smem) {
  const int tid = opaque_tid();
  const int c4 = (tid & 15) * 4, rg = tid >> 4;
  const float* wp = w + (size_t)(rg * 32) * N + n0 + c4;
  float4 m = {0.f, 0.f, 0.f, 0.f};
#pragma unroll 16
  for (int k = 0; k < 32; ++k) {
    const float4 v = *(const float4*)(wp + (size_t)k * N);
    m.x = fmaxf(m.x, fabsf(v.x)); m.y = fmaxf(m.y, fabsf(v.y)); m.z = fmaxf(m.z, fabsf(v.z)); m.w = fmaxf(m.w, fabsf(v.w));
  }
  float* red = (float*)smem;
  *(float4*)(red + rg * 64 + c4) = m;
  __syncthreads();
  if (tid < 64) {
    float mm = red[tid];
#pragma unroll
    for (int g = 1; g < 32; ++g) mm = fmaxf(mm, red[g * 64 + tid]);
    swp[n0 + tid] = fmaxf(mm, 1e-20f) * (1.0f / 127.0f);
  }
  __syncthreads();
}
__device__ __forceinline__ void cvt_chunk4(const float* __restrict__ src, u16* __restrict__ dst, size_t chunk4) {
  const size_t i = chunk4 * 16384 + (size_t)opaque_tid() * 8;
  float4 a[4], b[4];
#pragma unroll
  for (int q = 0; q < 4; ++q) { a[q] = *(const float4*)(src + i + q * 4096); b[q] = *(const float4*)(src + i + q * 4096 + 4); }
#pragma unroll
  for (int q = 0; q < 4; ++q) {
    uint4 o;
    o.x = pk2(a[q].x, a[q].y); o.y = pk2(a[q].z, a[q].w); o.z = pk2(b[q].x, b[q].y); o.w = pk2(b[q].z, b[q].w);
    *(uint4*)(dst + i + q * 4096) = o;
  }
}
__device__ __forceinline__ void cvt_chunk_fp8(const float* __restrict__ src, unsigned char* __restrict__ dst, size_t chunk, float scale) {
  const size_t i = chunk * 4096 + (size_t)opaque_tid() * 8;
  const float4 a = *(const float4*)(src + i), b = *(const float4*)(src + i + 4);
  int w0 = __builtin_amdgcn_cvt_pk_fp8_f32(a.x * scale, a.y * scale, 0, false);
  w0 = __builtin_amdgcn_cvt_pk_fp8_f32(a.z * scale, a.w * scale, w0, true);
  int w1 = __builtin_amdgcn_cvt_pk_fp8_f32(b.x * scale, b.y * scale, 0, false);
  w1 = __builtin_amdgcn_cvt_pk_fp8_f32(b.z * scale, b.w * scale, w1, true);
  *(uint2*)(dst + i) = make_uint2((unsigned)w0, (unsigned)w1);
}
__device__ __forceinline__ void cvt_chunk_fp4(const float* __restrict__ src, unsigned char* __restrict__ dst, size_t chunk, float scale, int vhalf) {
  const size_t i = chunk * 4096 + (size_t)opaque_tid() * 8;
  const float4 a = *(const float4*)(src + i), b = *(const float4*)(src + i + 4);
  unsigned w = 0;
  w = __builtin_amdgcn_cvt_scalef32_pk_fp4_f32(w, a.x * scale, a.y * scale, 1.0f, 0);
  w = __builtin_amdgcn_cvt_scalef32_pk_fp4_f32(w, a.z * scale, a.w * scale, 1.0f, 1);
  w = __builtin_amdgcn_cvt_scalef32_pk_fp4_f32(w, b.x * scale, b.y * scale, 1.0f, 2);
  w = __builtin_amdgcn_cvt_scalef32_pk_fp4_f32(w, b.z * scale, b.w * scale, 1.0f, 3);
  const size_t e = i >> 10;
  const unsigned d = (unsigned)(i & 1023);
  *(unsigned*)(dst + e * 1024 + vhalf * 512 + (d >> 1)) = w;
}
__device__ __forceinline__ void cvt_chunk_fp4x8(const float* __restrict__ src, unsigned char* __restrict__ dst, int t0, int step, int tmax, float scale, int vhalf) {
  const int tid8 = opaque_tid() * 8;
  float4 a[8], b[8];
#pragma unroll
  for (int q = 0; q < 8; ++q) {
    const int t = t0 + q * step;
    const size_t i = (size_t)(t < tmax ? t : t0) * 4096 + tid8;
    typedef float f4_t __attribute__((ext_vector_type(4)));
    const f4_t av = __builtin_nontemporal_load((const f4_t*)(src + i)), bv = __builtin_nontemporal_load((const f4_t*)(src + i + 4));
    a[q] = make_float4(av.x, av.y, av.z, av.w); b[q] = make_float4(bv.x, bv.y, bv.z, bv.w);
  }
#pragma unroll
  for (int q = 0; q < 8; ++q) {
    const int t = t0 + q * step;
    if (t < tmax) {
      const size_t i = (size_t)t * 4096 + tid8;
      unsigned w = 0;
      w = __builtin_amdgcn_cvt_scalef32_pk_fp4_f32(w, a[q].x * scale, a[q].y * scale, 1.0f, 0);
      w = __builtin_amdgcn_cvt_scalef32_pk_fp4_f32(w, a[q].z * scale, a[q].w * scale, 1.0f, 1);
      w = __builtin_amdgcn_cvt_scalef32_pk_fp4_f32(w, b[q].x * scale, b[q].y * scale, 1.0f, 2);
      w = __builtin_amdgcn_cvt_scalef32_pk_fp4_f32(w, b[q].z * scale, b[q].w * scale, 1.0f, 3);
      const size_t e = i >> 10;
      const unsigned d = (unsigned)(i & 1023);
      *(unsigned*)(dst + e * 1024 + vhalf * 512 + (d >> 1)) = w;
    }
  }
}
__device__ __forceinline__ void phase_modreduce(const P& p) {
  const int n = 2 * 9 * 6144;
  for (int i = blockIdx.x * NTHR + opaque_tid(); i < n; i += gridDim.x * NTHR) {
    const int l = i / (9 * 6144);
    const int j = i % 6144;
    float s = p.b_ada[l * 6144 + j];
    float part[16];
#pragma unroll
    for (int kc = 0; kc < 16; ++kc) part[kc] = p.modpart[(size_t)kc * n + i];
    __builtin_amdgcn_sched_barrier(0);
#pragma unroll
    for (int kc = 0; kc < 16; ++kc) s += part[kc];
    p.mod[i] = s;
  }
}

__device__ __forceinline__ void phase_norm(const P& p, int l, int which) {
  const int tid_ = opaque_tid(); const int lane = tid_ & 63, wid = tid_ >> 6;
  const int ntok = (which == 2 || (which == 1 && l == 1)) ? NLAT : NTOK;
  float4 vn[4]; uint2 rn[4];
#define PN_LOAD(R) do { const int r_ = (R); if (which == 0) { const float* src_ = (r_ < NLAT) ? p.x + (size_t)r_ * 1024 : p.ctx + (size_t)(r_ - NLAT) * 1024; \
      _Pragma("unroll") for (int i = 0; i < 4; ++i) vn[i] = *(const float4*)(src_ + i * 256 + lane * 4); } \
    else { _Pragma("unroll") for (int i = 0; i < 4; ++i) rn[i] = *(const uint2*)(p.res + (size_t)r_ * 1024 + i * 256 + lane * 4); } } while (0)
  if (blockIdx.x * 8 + wid < ntok) PN_LOAD(blockIdx.x * 8 + wid);
  for (int row = blockIdx.x * 8 + wid; row < ntok; row += gridDim.x * 8) {
    float4 v[4];
    float ss = 0.f;
#pragma unroll
    for (int i = 0; i < 4; ++i) {
      if (which == 0) v[i] = vn[i]; else v[i] = make_float4(bflo(rn[i].x), bfhi(rn[i].x), bflo(rn[i].y), bfhi(rn[i].y));
      ss += v[i].x * v[i].x + v[i].y * v[i].y + v[i].z * v[i].z + v[i].w * v[i].w;
    }
    {
      const int nrow = row + gridDim.x * 8;
      if (nrow < ntok) PN_LOAD(nrow);
    }
    ss = wave_sum(ss);
    const float rstd = rsqrtf(ss * (1.0f / 1024.0f) + 1e-6f);
    if (which == 2) {
#pragma unroll
      for (int i = 0; i < 4; ++i) {
        const int col = i * 256 + lane * 4;
        const float4 g = *(const float4*)(p.final_g + col);
        float4 o = {v[i].x * rstd * g.x, v[i].y * rstd * g.y, v[i].z * rstd * g.z, v[i].w * rstd * g.w};
        *(float4*)(p.out + (size_t)row * 1024 + col) = o;
      }
    } else {
      const int bi = row < NLAT ? (row >> 12) : 8;
      const float* gam = (which == 0 ? p.norm_mix_g : p.norm_ffn_g) + l * 1024;
      const float* msh = p.mod + ((size_t)(l * 9 + bi) * 6 + (which == 0 ? 0 : 3)) * 1024;
      const float* msc = msh + 1024;
      float4 y[4];
      float amax = 0.f;
      float4 gq_[4], shq_[4], scq_[4];
#pragma unroll
      for (int i = 0; i < 4; ++i) { const int col = i * 256 + lane * 4; gq_[i] = *(const float4*)(gam + col); shq_[i] = *(const float4*)(msh + col); scq_[i] = *(const float4*)(msc + col); }
      __builtin_amdgcn_sched_barrier(0);
#pragma unroll
      for (int i = 0; i < 4; ++i) {
        const float4 g = gq_[i];
        const float4 sh = shq_[i];
        const float4 sc = scq_[i];
        y[i].x = v[i].x * rstd * g.x * (1.f + sc.x) + sh.x; y[i].y = v[i].y * rstd * g.y * (1.f + sc.y) + sh.y;
        y[i].z = v[i].z * rstd * g.z * (1.f + sc.z) + sh.z; y[i].w = v[i].w * rstd * g.w * (1.f + sc.w) + sh.w;
        amax = fmaxf(amax, fmaxf(fmaxf(fabsf(y[i].x), fabsf(y[i].y)), fmaxf(fabsf(y[i].z), fabsf(y[i].w))));
      }
      if (which == 0 || which == 1) {
        amax = fmaxf(wave_max(amax), 1e-20f);
        const float inv = 127.0f / amax;
#pragma unroll
        for (int i = 0; i < 4; ++i) {
          const unsigned w = ((unsigned)__float2int_rn(y[i].x * inv) & 255u) | (((unsigned)__float2int_rn(y[i].y * inv) & 255u) << 8) |
                             (((unsigned)__float2int_rn(y[i].z * inv) & 255u) << 16) | (((unsigned)__float2int_rn(y[i].w * inv) & 255u) << 24);
          *(unsigned*)(p.xn8 + (size_t)row * 1024 + i * 256 + lane * 4) = w;
        }
        if (lane == 0) p.sa[row] = amax * (1.0f / 127.0f);
      } else {
#pragma unroll
        for (int i = 0; i < 4; ++i) {
          uint2 o;
          o.x = pk2(y[i].x, y[i].y);
          o.y = pk2(y[i].z, y[i].w);
          *(uint2*)(p.xn + (size_t)row * 1024 + i * 256 + lane * 4) = o;
        }
      }
    }
  }
}

__device__ __forceinline__ void filter_wave(const P& p, int l, int L, int t, float* __restrict__ outp) {
  const int lane = opaque_tid() & 63;
  const float tl = (float)t / (float)(L - 1);
  const float wang = (6.283185307179586f / (float)L) * (float)t;
  float z = 0.f;
  if (lane == 0) z = tl;
  else if (lane <= 16) { const float band = 1e-4f + (float)(lane - 1) * ((15.0f - 1e-4f) / 15.0f); z = cosf(band * wang); }
  else if (lane <= 32) { const float band = 1e-4f + (float)(lane - 17) * ((15.0f - 1e-4f) / 15.0f); z = -sinf(band * wang); }
  float a1 = p.hy_f1_b[l * 64 + lane];
  for (int i = 0; i < 33; ++i) a1 += shf(z, i) * p.hy_f1_w[(l * 33 + i) * 64 + lane];
  const float h1 = sinf(p.hy_freq[l * 128 + lane] * a1);
  float a2 = p.hy_f2_b[l * 64 + lane];
  for (int i = 0; i < 64; ++i) a2 += shf(h1, i) * p.hy_f2_w[(l * 64 + i) * 64 + lane];
  const float h2 = sinf(p.hy_freq[l * 128 + 64 + lane] * a2);
  float a3[8];
#pragma unroll
  for (int m = 0; m < 8; ++m) a3[m] = 0.f;
  for (int i = 0; i < 64; ++i) {
    const float hv = shf(h2, i);
    const float* wr = p.hy_f3_w + (size_t)(l * 64 + i) * 512 + lane;
#pragma unroll
    for (int m = 0; m < 8; ++m) a3[m] += hv * wr[m * 64];
  }
  const float LN100 = 4.605170185988092f;
  const float d0 = LN100 / 1.5f, d1 = LN100 / 0.3f;
#pragma unroll
  for (int m = 0; m < 8; ++m) {
    const int cp = lane + 64 * m;
    const int ch = cp & 255;
    const float delta = d0 + (float)ch * ((d1 - d0) / 255.0f);
    outp[(size_t)cp * L + t] = a3[m] * expf(-tl * delta);
  }
}
__device__ __forceinline__ void filter_block_task(const P& p, int l, int L, int t0, float* __restrict__ outp, char* smem) {
  const int tid = opaque_tid(), lane = tid & 63, wid = tid >> 6;
  float* W3s = (float*)smem;
  float* W2s = (float*)(smem + 131072);
  {
    const float4* s3 = (const float4*)(p.hy_f3_w + (size_t)l * 64 * 512);
    const float4* s2 = (const float4*)(p.hy_f2_w + (size_t)l * 64 * 64);
    typedef float f4v_t __attribute__((ext_vector_type(4)));
    const f4v_t* q3 = (const f4v_t*)s3; const f4v_t* q2 = (const f4v_t*)s2;
#define FB_LD(i) const f4v_t w3_##i = q3[tid + NTHR * (i)]
#define FB_ST(i) ((f4v_t*)W3s)[tid + NTHR * (i)] = w3_##i
    FB_LD(0); FB_LD(1); FB_LD(2); FB_LD(3); FB_LD(4); FB_LD(5); FB_LD(6); FB_LD(7);
    FB_LD(8); FB_LD(9); FB_LD(10); FB_LD(11); FB_LD(12); FB_LD(13); FB_LD(14); FB_LD(15);
    const f4v_t w2_0 = q2[tid], w2_1 = q2[tid + NTHR];
    __builtin_amdgcn_sched_barrier(0);
    FB_ST(0); FB_ST(1); FB_ST(2); FB_ST(3); FB_ST(4); FB_ST(5); FB_ST(6); FB_ST(7);
    FB_ST(8); FB_ST(9); FB_ST(10); FB_ST(11); FB_ST(12); FB_ST(13); FB_ST(14); FB_ST(15);
    ((f4v_t*)W2s)[tid] = w2_0; ((f4v_t*)W2s)[tid + NTHR] = w2_1;
#undef FB_LD
#undef FB_ST
  }
  __syncthreads();
  float z[4], tl[4];
#pragma unroll
  for (int j = 0; j < 4; ++j) {
    const int t = t0 + wid * 4 + j;
    tl[j] = (float)t / (float)(L - 1);
    const float wang = (6.283185307179586f / (float)L) * (float)t;
    float zz = 0.f;
    if (lane == 0) zz = tl[j];
    else if (lane <= 16) { const float band = 1e-4f + (float)(lane - 1) * ((15.0f - 1e-4f) / 15.0f); zz = cosf(band * wang); }
    else if (lane <= 32) { const float band = 1e-4f + (float)(lane - 17) * ((15.0f - 1e-4f) / 15.0f); zz = -sinf(band * wang); }
    z[j] = zz;
  }
  float a1[4], a2[4];
  {
    const float b1 = p.hy_f1_b[l * 64 + lane];
#pragma unroll
    for (int j = 0; j < 4; ++j) a1[j] = b1;
    float w1[33];
#pragma unroll
    for (int i = 0; i < 33; ++i) w1[i] = p.hy_f1_w[(l * 33 + i) * 64 + lane];
    __builtin_amdgcn_sched_barrier(0);
#pragma unroll
    for (int i = 0; i < 33; ++i) {
      const float w = w1[i];
#pragma unroll
      for (int j = 0; j < 4; ++j) a1[j] += shf(z[j], i) * w;
    }
    const float f0 = p.hy_freq[l * 128 + lane];
#pragma unroll
    for (int j = 0; j < 4; ++j) a1[j] = sinf(f0 * a1[j]);
  }
  {
    const float b2 = p.hy_f2_b[l * 64 + lane];
#pragma unroll
    for (int j = 0; j < 4; ++j) a2[j] = b2;
#pragma unroll 8
    for (int i = 0; i < 64; ++i) {
      const float w = W2s[i * 64 + lane];
#pragma unroll
      for (int j = 0; j < 4; ++j) a2[j] += shf(a1[j], i) * w;
    }
    const float f1 = p.hy_freq[l * 128 + 64 + lane];
#pragma unroll
    for (int j = 0; j < 4; ++j) a2[j] = sinf(f1 * a2[j]);
  }
  float a3[4][8];
#pragma unroll
  for (int j = 0; j < 4; ++j)
#pragma unroll
    for (int m = 0; m < 8; ++m) a3[j][m] = 0.f;
#pragma unroll 4
  for (int i = 0; i < 64; ++i) {
    float w[8];
#pragma unroll
    for (int m = 0; m < 8; ++m) w[m] = W3s[i * 512 + lane + 64 * m];
#pragma unroll
    for (int j = 0; j < 4; ++j) {
      const float hv = shf(a2[j], i);
#pragma unroll
      for (int m = 0; m < 8; ++m) a3[j][m] += hv * w[m];
    }
  }
  const float LN100 = 4.605170185988092f;
  const float d0 = LN100 / 1.5f, d1 = LN100 / 0.3f;
#pragma unroll
  for (int m = 0; m < 8; ++m) {
    const int cp = lane + 64 * m;
    const float delta = d0 + (float)(cp & 255) * ((d1 - d0) / 255.0f);
    float4 o;
    o.x = a3[0][m] * expf(-tl[0] * delta); o.y = a3[1][m] * expf(-tl[1] * delta);
    o.z = a3[2][m] * expf(-tl[2] * delta); o.w = a3[3][m] * expf(-tl[3] * delta);
    *(float4*)(outp + (size_t)cp * L + t0 + wid * 4) = o;
  }
  __syncthreads();
}
__device__ __forceinline__ void phase_filters(const P& p, int l, char* smem) {
  const int ntask = 128 + (l == 0 ? 8 : 0);
  for (int t = blockIdx.x; t < ntask; t += gridDim.x) {
    if (t < 128) filter_block_task(p, l, 4096, t * 32, p.hT + (size_t)l * 512 * 4096, smem);
    else filter_block_task(p, l, 256, (t - 128) * 32, p.hc, smem);
  }
}
__device__ __forceinline__ void adaln_task(const P& p, int t, char* smem) {
  const int tid = opaque_tid();
  const int kc = t & 15; t >>= 4;
  const int jc = t % 12, l = t / 12;
  float* s = (float*)smem;
  float* red = (float*)(smem + 4096);
  for (int i = tid; i < 576; i += NTHR) {
    const int bi = i >> 6, kk = i & 63;
    const float v = (bi < 8) ? p.c[bi * 1024 + kc * 64 + kk] : p.c_ctx[kc * 64 + kk];
    s[i] = v / (1.0f + __expf(-v));
  }
  const int kq = tid >> 7, c4 = (tid & 127) * 4;
  const float* wp = p.w_ada + ((size_t)l * 1024 + kc * 64 + kq * 16) * 6144 + jc * 512 + c4;
  float4 w[16];
#pragma unroll
  for (int kk = 0; kk < 16; ++kk) w[kk] = *(const float4*)(wp + (size_t)kk * 6144);
  __syncthreads();
  float4 acc[9];
#pragma unroll
  for (int bi = 0; bi < 9; ++bi) acc[bi] = make_float4(0.f, 0.f, 0.f, 0.f);
#pragma unroll
  for (int kk = 0; kk < 16; ++kk) {
#pragma unroll
    for (int bi = 0; bi < 9; ++bi) {
      const float sv = s[bi * 64 + kq * 16 + kk];
      acc[bi].x += sv * w[kk].x; acc[bi].y += sv * w[kk].y; acc[bi].z += sv * w[kk].z; acc[bi].w += sv * w[kk].w;
    }
  }
#pragma unroll
  for (int bi = 0; bi < 9; ++bi) *(float4*)(red + (kq * 9 + bi) * 512 + c4) = acc[bi];
  __syncthreads();
#pragma unroll
  for (int bi = 0; bi < 9; ++bi) {
    const float v = red[bi * 512 + tid] + red[(9 + bi) * 512 + tid] + red[(18 + bi) * 512 + tid] + red[(27 + bi) * 512 + tid];
    p.modpart[((size_t)(kc * 2 + l) * 9 + bi) * 6144 + jc * 512 + tid] = v;
  }
  __syncthreads();
}
__device__ __forceinline__ void phase_prep(const P& p, char* smem, unsigned* counter) {
  volatile int* s_taskp = (volatile int*)(smem + SMEM_BYTES - 16);
  const int total = 264 + 184 + 384 + 544 + 32;
  int nxt = 0;
  if (threadIdx.x == 0) nxt = (int)atomicAdd(counter, 1u);
  for (;;) {
    __syncthreads();
    if (threadIdx.x == 0) *s_taskp = nxt;
    __syncthreads();
    int t = *s_taskp;
    if (t >= total) break;
    if (threadIdx.x == 0) nxt = (int)atomicAdd(counter, 1u);
    if (t < 264) {
      if (t < 128) filter_block_task(p, 0, 4096, t * 32, p.hT, smem);
      else if (t < 256) filter_block_task(p, 1, 4096, (t - 128) * 32, p.hT + (size_t)512 * 4096, smem);
      else filter_block_task(p, 0, 256, (t - 256) * 32, p.hc, smem);
      continue;
    }
    t -= 264;
    if (t < 184) {
      const int l = t / 92; t -= l * 92;
      if (t < 44) colmax4_task(p.w_in + (size_t)l * 1024 * 2816, 2816, t * 64, p.sw + l * 5888, smem);
      else colmax4_task(p.w_gate + (size_t)l * 1024 * 3072, 3072, (t - 44) * 64, p.sw + l * 5888 + 2816, smem);
      continue;
    }
    t -= 184;
    if (t < 384) { adaln_task(p, t, smem); continue; }
    t -= 384;
    if (t < 544) {
      const int l = t / 272; t -= l * 272;
      if (t < 32) tr_tile4<false>(p.w_br_a + (size_t)l * 512 * 1024, 1024, 1024, p.WaT + (size_t)l * 1024 * 1024, t, nullptr, smem);
      else if ((t -= 32) < 16) tr_tile4<false>(p.w_br_b + (size_t)l * 256 * 1024, 1024, 1024, p.WaT + (size_t)l * 1024 * 1024 + 512, t, nullptr, smem);
      else if ((t -= 16) < 16) tr_tile4<false>(p.w_br_c + (size_t)l * 256 * 1024, 1024, 1024, p.WaT + (size_t)l * 1024 * 1024 + 768, t, nullptr, smem);
      else if ((t -= 16) < 64) tr_tile4<false>(p.w_out + (size_t)l * 1024 * 1024, 1024, 1024, p.WoT + (size_t)l * 1024 * 1024, t, nullptr, smem);
      else if ((t -= 64) < 128) cvt_chunk4(p.peer_wq + (size_t)l * 1024 * 2048, p.WqB + (size_t)l * 1024 * 2048, (size_t)t);
      else {
        t -= 128;
        const int gate = t >> 3, dn = t & 7;
        const float* src = (gate ? p.rg_wx : p.rg_wa) + (size_t)(l * 8 + dn) * 4096;
        tr_tile(src, 64, 64, p.rgW + (size_t)((l * 2 + gate) * 8 + dn) * 4096, 0, smem);
      }
      continue;
    }
    t -= 544;
    cvt_chunk4(p.peer_keys, p.keysB, (size_t)t);
  }
}
__device__ __forceinline__ void kf_task(const P& p, int l, int c, char* smem) {
  const float* hTl = p.hT + (size_t)l * 512 * 4096;
  c2* buf = (c2*)smem;
  const int tid = opaque_tid();
  float hv[16];
#pragma unroll
  for (int i = 0; i < 16; ++i) {
    const int j = tid + NTHR * i;
    hv[i] = (i < 8) ? hTl[(size_t)c * 4096 + j] : hTl[(size_t)(256 + c) * 4096 + (j == 4096 ? 1 : 8192 - j)];
  }
  __builtin_amdgcn_sched_barrier(0);
#pragma unroll
  for (int i = 0; i < 16; ++i) {
    const int j = tid + NTHR * i;
    buf[j] = {(j == 4096) ? 0.f : hv[i], 0.f};
  }
  __syncthreads();
  fft8192(buf, -1.f);
  c2* o = (c2*)p.Kf + ((size_t)l * 256 + c) * 8192;
  for (int i = 0; i < 16; ++i) { const int j = tid + NTHR * i; o[j] = buf[j]; }
  __syncthreads();
}

__device__ __forceinline__ void inproj_tile(const P& p, int l, int mt, int nt, char* smem) {
  f32x16 acc[2][2];
  zero_acc(acc);
  const int m0 = mt * 256, n0 = nt * 128;
  gemm_kloop(acc, p.xn + (size_t)m0 * 1024, 1024, p.WinT + ((size_t)l * 2816 + n0) * 1024, 1024, 1024, smem);
  EPI_VARS
  if (nt < 8 || nt >= 18) {
    u16* dst; int ld, cbase;
    if (nt < 8) { dst = p.qk; ld = 1024; cbase = n0; }
    else { dst = p.rg; ld = 512; cbase = n0 - 2304; }
#pragma unroll
    for (int i = 0; i < 2; ++i)
#pragma unroll
      for (int j = 0; j < 2; ++j)
#pragma unroll
        for (int e = 0; e < 16; ++e)
          dst[(size_t)(m0 + EPI_ROW(i, e)) * ld + cbase + EPI_COL(j)] = f2bf(acc[i][j][e]);
  } else {
#pragma unroll
    for (int i = 0; i < 2; ++i)
#pragma unroll
      for (int j = 0; j < 2; ++j)
#pragma unroll
        for (int qd = 0; qd < 4; ++qd) {
          uint2 o;
          o.x = pk2(acc[i][j][4 * qd + 0], acc[i][j][4 * qd + 1]);
          o.y = pk2(acc[i][j][4 * qd + 2], acc[i][j][4 * qd + 3]);
          const int row0 = wm * 64 + i * 32 + 8 * qd + 4 * hh;
          *(uint2*)(smem + EPI_COL(j) * 520 + row0 * 2) = o;
        }
    __syncthreads();
    u16* dstT; int Lseg, t0, ncol0, nc;
    const bool isctx = (mt >= 128);
    const int b = isctx ? (mt - 128) : (mt >> 4);
    if (nt < 12) { ncol0 = n0 - 1024; nc = 512; dstT = isctx ? p.vTc : p.vT; }
    else { ncol0 = n0 - 1536; nc = 768; dstT = isctx ? p.hyTc : p.hyT; }
    if (isctx) { Lseg = 256; t0 = 0; } else { Lseg = 4096; t0 = (mt & 15) * 256; }
#pragma unroll 4
    for (int it = 0; it < 16; ++it) {
      const int idx = tid + NTHR * it;
      const int col = idx >> 6, u = idx & 63;
      const uint2 v = *(const uint2*)(smem + col * 520 + u * 8);
      *(uint2*)(dstT + ((size_t)(b * nc + ncol0 + col)) * Lseg + t0 + u * 4) = v;
    }
    __syncthreads();
  }
}

__device__ __forceinline__ float ldbf(const u16* p, int t, int L) { return (t >= 0 && t < L) ? bf2f(p[t]) : 0.f; }
struct Raw10 { uint4 r; u16 e0, e9; };
__device__ __forceinline__ Raw10 ld10_raw(const u16* __restrict__ seq, int t0) {
  Raw10 w;
  w.r = *(const uint4*)(seq + t0);
  w.e0 = seq[t0 > 0 ? t0 - 1 : 0]; w.e9 = seq[t0 + 8 < 4096 ? t0 + 8 : 4095];
  return w;
}
__device__ __forceinline__ void cvt10(const Raw10& w, int t0, float (&v)[10]) {
  v[0] = (t0 > 0) ? bf2f(w.e0) : 0.f;
  v[9] = (t0 + 8 < 4096) ? bf2f(w.e9) : 0.f;
  v[1] = bflo(w.r.x); v[2] = bfhi(w.r.x); v[3] = bflo(w.r.y); v[4] = bfhi(w.r.y);
  v[5] = bflo(w.r.z); v[6] = bfhi(w.r.z); v[7] = bflo(w.r.w); v[8] = bfhi(w.r.w);
}
__device__ __forceinline__ void ld10(const u16* __restrict__ seq, int t0, float (&v)[10]) {
  const uint4 r = *(const uint4*)(seq + t0);
  const u16 e0 = seq[t0 > 0 ? t0 - 1 : 0], e9 = seq[t0 + 8 < 4096 ? t0 + 8 : 4095];
  v[0] = (t0 > 0) ? bf2f(e0) : 0.f;
  v[9] = (t0 + 8 < 4096) ? bf2f(e9) : 0.f;
  v[1] = bflo(r.x); v[2] = bfhi(r.x); v[3] = bflo(r.y); v[4] = bfhi(r.y);
  v[5] = bflo(r.z); v[6] = bfhi(r.z); v[7] = bflo(r.w); v[8] = bfhi(r.w);
}
__device__ __forceinline__ void hyena_fft_task(const P& p, int l, int c, int bp, char* smem) {
  c2* buf = (c2*)smem;
  c2* ub = (c2*)(smem + 65536);
  const int tid = opaque_tid();
  const float* sw = p.hy_short_w + l * 3 * 768;
  const float* sb = p.hy_short_b + l * 768;
  const float wx0[3] = {sw[c], sw[768 + c], sw[1536 + c]};
  const float wx1[3] = {sw[256 + c], sw[768 + 256 + c], sw[1536 + 256 + c]};
  const float wv[3] = {sw[512 + c], sw[768 + 512 + c], sw[1536 + 512 + c]};
  const float bx0 = sb[c], bx1 = sb[256 + c], bv = sb[512 + c];
  const float dsk = p.hy_bias[l * 256 + c];
  const int t0 = tid * 8;
  {
    float u[2][8];
    float x1a[10], vva[10], x1b[10], vvb[10];
    {
      const Raw10 r0 = ld10_raw(p.hyT + ((size_t)((2 * bp) * 768 + 256 + c)) * 4096, t0);
      const Raw10 r1 = ld10_raw(p.hyT + ((size_t)((2 * bp) * 768 + 512 + c)) * 4096, t0);
      const Raw10 r2 = ld10_raw(p.hyT + ((size_t)((2 * bp + 1) * 768 + 256 + c)) * 4096, t0);
      const Raw10 r3 = ld10_raw(p.hyT + ((size_t)((2 * bp + 1) * 768 + 512 + c)) * 4096, t0);
      __builtin_amdgcn_sched_barrier(0);
      cvt10(r0, t0, x1a); cvt10(r1, t0, vva); cvt10(r2, t0, x1b); cvt10(r3, t0, vvb);
    }
#pragma unroll
    for (int k = 0; k < 8; ++k) {
      u[0][k] = (bv + wv[0] * vva[k] + wv[1] * vva[k + 1] + wv[2] * vva[k + 2]) * (bx1 + wx1[0] * x1a[k] + wx1[1] * x1a[k + 1] + wx1[2] * x1a[k + 2]);
      u[1][k] = (bv + wv[0] * vvb[k] + wv[1] * vvb[k + 1] + wv[2] * vvb[k + 2]) * (bx1 + wx1[0] * x1b[k] + wx1[1] * x1b[k + 1] + wx1[2] * x1b[k + 2]);
    }
#pragma unroll
    for (int k = 0; k < 8; k += 2) {
      const float4 w = make_float4(u[0][k], u[1][k], u[0][k + 1], u[1][k + 1]);
      *(float4*)(buf + t0 + k) = w;
      *(float4*)(ub + t0 + k) = w;
      *(float4*)(buf + 4096 + t0 + k) = make_float4(0.f, 0.f, 0.f, 0.f);
    }
  }
  const c2* kf = (const c2*)p.Kf + ((size_t)l * 256 + c) * 8192;
  c2 kv[16];
#pragma unroll
  for (int i = 0; i < 16; ++i) kv[i] = kf[tid + NTHR * i];
  __syncthreads();
  fft8192(buf, -1.f);
#pragma unroll
  for (int i = 0; i < 16; ++i) {
    const int k = tid + NTHR * i;
    buf[k] = cmul(buf[k], kv[i]);
  }
  const Raw10 rx0 = ld10_raw(p.hyT + ((size_t)((2 * bp) * 768 + c)) * 4096, t0);
  const Raw10 rx1 = ld10_raw(p.hyT + ((size_t)((2 * bp + 1) * 768 + c)) * 4096, t0);
  __syncthreads();
  fft8192(buf, 1.f);
  float x0a[10], x0b[10];
  cvt10(rx0, t0, x0a); cvt10(rx1, t0, x0b);
#pragma unroll
  for (int bb = 0; bb < 2; ++bb) {
    const int b = 2 * bp + bb;
    float x0[10];
#pragma unroll
    for (int k = 0; k < 10; ++k) x0[k] = bb ? x0b[k] : x0a[k];
    float o[8];
#pragma unroll
    for (int k = 0; k < 8; ++k) {
      const c2 y = buf[t0 + k];
      const c2 uu = ub[t0 + k];
      const float x0c = bx0 + wx0[0] * x0[k] + wx0[1] * x0[k + 1] + wx0[2] * x0[k + 2];
      const float yy = ldexpf(bb ? y.y : y.x, -13);
      const float uv = bb ? uu.y : uu.x;
      o[k] = x0c * (yy + uv * dsk);
    }
    uint4 w; w.x = pk2(o[0], o[1]); w.y = pk2(o[2], o[3]); w.z = pk2(o[4], o[5]); w.w = pk2(o[6], o[7]);
    *(uint4*)(p.ybT + ((size_t)(b * 256 + c)) * 4096 + t0) = w;
  }
  __syncthreads();
}
__device__ __forceinline__ void yb_transpose_task(const P& p, int b, int tb, char* smem) {
  const int tid = opaque_tid(), lane = tid & 63, wid = tid >> 6;
  u16* T = (u16*)smem;
#define YB_LD(it) const uint4 r##it = *(const uint4*)(p.ybT + ((size_t)(b * 256 + ((tid + NTHR * it) >> 3))) * 4096 + tb * 64 + ((tid + NTHR * it) & 7) * 8)
#define YB_ST(it) do { unsigned* d = (unsigned*)(T + ((tid + NTHR * it) >> 3) * 66 + ((tid + NTHR * it) & 7) * 8); d[0] = r##it.x; d[1] = r##it.y; d[2] = r##it.z; d[3] = r##it.w; } while (0)
  YB_LD(0); YB_LD(1); YB_LD(2); YB_LD(3);
  __builtin_amdgcn_sched_barrier(0);
  YB_ST(0); YB_ST(1); YB_ST(2); YB_ST(3);
#undef YB_LD
#undef YB_ST
  __syncthreads();
#pragma unroll
  for (int it = 0; it < 8; ++it) {
    const int tt = wid + 8 * it;
    const int c0 = lane * 4;
    uint2 w;
    w.x = (unsigned)T[(c0 + 0) * 66 + tt] | ((unsigned)T[(c0 + 1) * 66 + tt] << 16);
    w.y = (unsigned)T[(c0 + 2) * 66 + tt] | ((unsigned)T[(c0 + 3) * 66 + tt] << 16);
    *(uint2*)(p.ycat + (size_t)(b * 4096 + tb * 64 + tt) * 1024 + 512 + c0) = w;
  }
  __syncthreads();
}
__device__ __forceinline__ void hyena_ctx_task(const P& p, int l, int b, int cg8, char* smem) {
  const int tid_ = opaque_tid(); const int lane = tid_ & 63, wid = tid_ >> 6;
  const int c = cg8 * 8 + wid;
  float* us = (float*)smem + wid * 1024;
  float* kfp = us + 256 + 255;
  const float* sw = p.hy_short_w + l * 3 * 768;
  const float* sb = p.hy_short_b + l * 768;
  const u16* x0 = p.hyTc + ((size_t)(b * 768 + c)) * 256;
  const u16* x1 = p.hyTc + ((size_t)(b * 768 + 256 + c)) * 256;
  const u16* vv = p.hyTc + ((size_t)(b * 768 + 512 + c)) * 256;
  float x0c[4], x1c[4], vc[4], kpos[4], kneg[4];
#pragma unroll
  for (int i = 0; i < 4; ++i) {
    const int t = lane + 64 * i;
    x1c[i] = sb[256 + c] + sw[256 + c] * ldbf(x1, t - 1, 256) + sw[768 + 256 + c] * ldbf(x1, t, 256) + sw[1536 + 256 + c] * ldbf(x1, t + 1, 256);
    vc[i] = sb[512 + c] + sw[512 + c] * ldbf(vv, t - 1, 256) + sw[768 + 512 + c] * ldbf(vv, t, 256) + sw[1536 + 512 + c] * ldbf(vv, t + 1, 256);
    x0c[i] = sb[c] + sw[c] * ldbf(x0, t - 1, 256) + sw[768 + c] * ldbf(x0, t, 256) + sw[1536 + c] * ldbf(x0, t + 1, 256);
    kpos[i] = p.hc[(size_t)c * 256 + t];
    kneg[i] = p.hc[(size_t)(256 + c) * 256 + t];
  }
  const float dsk = p.hy_bias[l * 256 + c];
  __builtin_amdgcn_sched_barrier(0);
#pragma unroll
  for (int i = 0; i < 4; ++i) {
    const int t = lane + 64 * i;
    us[t] = vc[i] * x1c[i];
    kfp[t] = kpos[i];
    if (t > 0) kfp[-t] = kneg[i];
  }
  __syncthreads();
  float acc[4] = {0.f, 0.f, 0.f, 0.f};
  for (int s = 0; s < 256; ++s) {
    const float uv = us[s];
#pragma unroll
    for (int i = 0; i < 4; ++i) acc[i] += kfp[lane + 64 * i - s] * uv;
  }
#pragma unroll
  for (int i = 0; i < 4; ++i) {
    const int t = lane + 64 * i;
    p.ycat[(size_t)(NLAT + b * 256 + t) * 1024 + 512 + c] = f2bf(x0c[i] * (acc[i] + us[t] * dsk));
  }
  __syncthreads();
}

template <int DIR>
__device__ __forceinline__ void rg_scan32(const float (&Av)[2][16], const float (&Bv)[2][16], float (&carry)[2], float (&H)[2][16], int hh) {
#pragma unroll
  for (int nt = 0; nt < 2; ++nt) {
    float c = carry[nt];
#pragma unroll
    for (int go = 0; go < 8; ++go) {
      const int g = DIR ? 7 - go : go, q = g >> 1, own = g & 1;
      float h = c;
#pragma unroll
      for (int io = 0; io < 4; ++io) {
        const int e = 4 * q + (DIR ? 3 - io : io);
        h = Av[nt][e] * h + Bv[nt][e];
        H[nt][e] = (hh == own) ? h : H[nt][e];
      }
      const float mine = (hh == own) ? h : c;
      const float other = shx(mine, 32);
      c = (hh == own) ? mine : other;
    }
    carry[nt] = c;
  }
}
__device__ __forceinline__ void rg_wave_task(const P& p, int l, int bq, int nblk, int mode, bool last, char* smem) {
  const int tid = opaque_tid(), lane = tid & 63, wid = tid >> 6;
  const int l31 = lane & 31, hh = lane >> 5;
  const int b = bq / 34, rr = bq - b * 34;
  const int seg = rr < 2 ? 0 : 1, blk = rr < 2 ? rr : rr - 2;
  if (mode == 1 && seg == 0 && last) return;
  const int ck = wid >> 1, dir = wid & 1;
  char* wreg = smem + wid * 17408;
  u16* xs = (u16*)wreg;
  char* xcb = wreg + 4608;
  float* xcf = (float*)(wreg + 8704);
  float2* blockagg = (float2*)(smem + 139264);
  const int Lseg = seg ? 4096 : 256;
  const int tokbase = seg ? b * 4096 : NLAT + b * 256;
  const int T0 = blk * 128 + ck * 32;
  const int cg32 = (seg ? 8 : 0) + blk * 4 + ck;
  uint4 xt[5];
#pragma unroll
  for (int i = 0; i < 5; ++i) {
    const int idx = lane + 64 * i;
    const int row = idx >> 3, chunk = idx & 7;
    xt[i] = make_uint4(0u, 0u, 0u, 0u);
    if (row < 35) {
      const int pos = T0 - 2 + row;
      if (pos >= 0 && pos < Lseg) xt[i] = *(const uint4*)(p.rg + (size_t)(tokbase + pos) * 512 + nblk * 64 + chunk * 8);
    }
  }
  const float cw0 = p.rg_conv_w[(l * 4 + 0) * 256 + nblk * 64 + lane], cw1 = p.rg_conv_w[(l * 4 + 1) * 256 + nblk * 64 + lane];
  const float cw2 = p.rg_conv_w[(l * 4 + 2) * 256 + nblk * 64 + lane], cw3 = p.rg_conv_w[(l * 4 + 3) * 256 + nblk * 64 + lane];
  const float ccb = p.rg_conv_b[l * 256 + nblk * 64 + lane];
  bf16x8 wf[2][2][4];
#pragma unroll
  for (int gate = 0; gate < 2; ++gate) {
    const u16* wp = p.rgW + (size_t)(((l * 2 + gate) * 2 + dir) * 4 + nblk) * 4096 + l31 * 64 + 8 * hh;
#pragma unroll
    for (int nt = 0; nt < 2; ++nt)
#pragma unroll
      for (int s = 0; s < 4; ++s) wf[gate][nt][s] = *(const bf16x8*)(wp + nt * 2048 + 16 * s);
  }
  float cba[2], cbx[2], csp[2];
#pragma unroll
  for (int nt = 0; nt < 2; ++nt) {
    const int ch = (l * 2 + dir) * 256 + nblk * 64 + nt * 32 + l31;
    cba[nt] = p.rg_ba[ch];
    cbx[nt] = p.rg_bx[ch];
    csp[nt] = p.rg_lambda[ch];
  }
  float2* agg1 = (float2*)p.agg;
  float2* agg2 = (float2*)p.agg + (size_t)8 * 2 * 136 * 256;
  const int pos2 = dir ? (seg == 0 ? 1 - blk : 33 - blk) : (seg == 0 ? blk : 2 + blk);
  float hin = 0.f;
  uint4 gq[2];
  if (mode == 1) {
    const float2* a2 = agg2 + ((size_t)(b * 2 + dir) * 34) * 256 + nblk * 64 + lane;
    const float2* a1 = agg1 + ((size_t)(b * 2 + dir) * 136 + (cg32 - ck)) * 256 + nblk * 64 + lane;
    const int npre = dir ? 3 - ck : ck;
    float2 ga[34], gb[3];
    const int pm1 = pos2 > 0 ? pos2 - 1 : 0;
#pragma unroll
    for (int j = 0; j < 34; ++j) ga[j] = a2[(size_t)(j < pm1 ? j : pm1) * 256];
#pragma unroll
    for (int i = 0; i < 3; ++i) { const int ii = i < npre ? i : 0; gb[i] = a1[(size_t)(dir ? 3 - ii : ii) * 256]; }
    {
      const int tok = 16 * dir + (lane >> 2), c16 = (lane & 3) * 16;
      const u16* gp = p.rg + ((size_t)tokbase + T0 + tok) * 512 + 256 + nblk * 64 + c16;
      gq[0] = *(const uint4*)gp; gq[1] = *(const uint4*)(gp + 8);
    }
#pragma unroll
    for (int j = 0; j < 34; ++j) hin = (j < pos2) ? ga[j].x * hin + ga[j].y : hin;
#pragma unroll
    for (int i = 0; i < 3; ++i) hin = (i < npre) ? gb[i].x * hin + gb[i].y : hin;
  }
  float Av[2][16], Bv[2][16];
  uint4* abase = (uint4*)p.xn + ((size_t)((bq * 4 + nblk) * 8 + wid) * 8) * 64 + lane;
  if (mode == 0) {
#pragma unroll
  for (int nt = 0; nt < 2; ++nt) csp[nt] = __logf(1.0f + __expf(-csp[nt]));
#pragma unroll
  for (int i = 0; i < 5; ++i) {
    const int idx = lane + 64 * i;
    const int row = idx >> 3, chunk = idx & 7;
    if (row < 35) *(uint4*)(xs + row * 64 + chunk * 8) = xt[i];
  }
  asm volatile("s_waitcnt lgkmcnt(0)" ::: "memory");
  {
    float x0 = bf2f(xs[0 * 64 + lane]), x1 = bf2f(xs[1 * 64 + lane]), x2 = bf2f(xs[2 * 64 + lane]);
#pragma unroll
    for (int t = 0; t < 32; ++t) {
      const float x3 = bf2f(xs[(t + 3) * 64 + lane]);
      const float xc = ccb + cw0 * x0 + cw1 * x1 + cw2 * x2 + cw3 * x3;
      xcf[t * 68 + lane] = xc;
      *(u16*)(xcb + swz128(t, lane >> 3) + (lane & 7) * 2) = f2bf(xc);
      x0 = x1; x1 = x2; x2 = x3;
    }
  }
  asm volatile("s_waitcnt lgkmcnt(0)" ::: "memory");
  {
    f32x16 acc[2][2];
#pragma unroll
    for (int gate = 0; gate < 2; ++gate)
#pragma unroll
      for (int nt = 0; nt < 2; ++nt) acc[gate][nt] = zero16();
#pragma unroll
    for (int s = 0; s < 4; ++s) {
      const bf16x8 af = *(const bf16x8*)(xcb + swz128(l31, 2 * s + hh));
#pragma unroll
      for (int gate = 0; gate < 2; ++gate)
#pragma unroll
        for (int nt = 0; nt < 2; ++nt) acc[gate][nt] = mfma32(af, wf[gate][nt][s], acc[gate][nt]);
    }
#pragma unroll
    for (int nt = 0; nt < 2; ++nt)
#pragma unroll
      for (int e = 0; e < 16; ++e) {
        const int tok = (e & 3) + 8 * (e >> 2) + 4 * hh;
        const float r = sigmoidf_(acc[0][nt][e] + cba[nt]);
        const float ii = sigmoidf_(acc[1][nt][e] + cbx[nt]);
        const float la = -8.0f * r * csp[nt];
        const float e2 = 2.0f * la;
        const float om = (e2 > -0.1f) ? (-e2 * (1.0f + e2 * (0.5f + e2 * (0.16666667f + e2 * 0.041666668f)))) : (1.0f - __expf(e2));
        const float dm = (la > -0.1f) ? (-la * (1.0f + la * (0.5f + la * (0.16666667f + la * 0.041666668f)))) : (1.0f - __expf(la));
        Av[nt][e] = dm;
        Bv[nt][e] = sqrtf(om) * ii * xcf[tok * 68 + nt * 32 + l31];
      }
  }
#pragma unroll
    for (int k = 0; k < 8; ++k) {
      unsigned w[4];
#pragma unroll
      for (int q = 0; q < 4; ++q) {
        const int j = 4 * k + q, nt = j >> 4, e = j & 15;
        w[q] = pk2(Av[nt][e], Bv[nt][e]);
        Av[nt][e] = 1.0f - bflo(w[q]);
        Bv[nt][e] = bfhi(w[q]);
      }
      abase[(size_t)k * 64] = make_uint4(w[0], w[1], w[2], w[3]);
    }
  } else {
#pragma unroll
    for (int k = 0; k < 8; ++k) {
      const uint4 w4 = abase[(size_t)k * 64];
      const unsigned w[4] = {w4.x, w4.y, w4.z, w4.w};
#pragma unroll
      for (int q = 0; q < 4; ++q) {
        const int j = 4 * k + q, nt = j >> 4, e = j & 15;
        Av[nt][e] = 1.0f - bflo(w[q]);
        Bv[nt][e] = bfhi(w[q]);
      }
    }
  }
  float H[2][16];
#pragma unroll
  for (int nt = 0; nt < 2; ++nt)
#pragma unroll
    for (int e = 0; e < 16; ++e) H[nt][e] = 0.f;
  float carry[2] = {0.f, 0.f};
  if (mode == 0) {
    if (dir) rg_scan32<1>(Av, Bv, carry, H, hh); else rg_scan32<0>(Av, Bv, carry, H, hh);
    float P[2];
#pragma unroll
    for (int nt = 0; nt < 2; ++nt) {
      float pr = 1.f;
#pragma unroll
      for (int e = 0; e < 16; ++e) pr *= Av[nt][e];
      P[nt] = pr * shx(pr, 32);
    }
    const float2 mine = make_float2(hh ? P[1] : P[0], hh ? carry[1] : carry[0]);
    agg1[((size_t)(b * 2 + dir) * 136 + cg32) * 256 + nblk * 64 + lane] = mine;
    blockagg[(ck * 2 + dir) * 64 + lane] = mine;
    __syncthreads();
    if (wid < 2) {
      const int d2 = wid;
      float A = 1.f, B = 0.f;
#pragma unroll
      for (int co = 0; co < 4; ++co) {
        const int c = d2 ? 3 - co : co;
        const float2 g = blockagg[(c * 2 + d2) * 64 + lane];
        B = g.x * B + g.y;
        A *= g.x;
      }
      const int p2 = d2 ? (seg == 0 ? 1 - blk : 33 - blk) : (seg == 0 ? blk : 2 + blk);
      agg2[((size_t)(b * 2 + d2) * 34 + p2) * 256 + nblk * 64 + lane] = make_float2(A, B);
    }
    __syncthreads();
    return;
  }
  carry[0] = shf(hin, l31);
  carry[1] = shf(hin, 32 + l31);
  if (dir) rg_scan32<1>(Av, Bv, carry, H, hh); else rg_scan32<0>(Av, Bv, carry, H, hh);
  asm volatile("s_waitcnt lgkmcnt(0)" ::: "memory");
#pragma unroll
  for (int nt = 0; nt < 2; ++nt)
#pragma unroll
    for (int e = 0; e < 16; ++e) xcf[((e & 3) + 8 * (e >> 2) + 4 * hh) * 68 + nt * 32 + l31] = H[nt][e];
  __syncthreads();
  {
    const float* hfT = (const float*)(smem + (ck * 2 + 0) * 17408 + 8704);
    const float* hbT = (const float*)(smem + (ck * 2 + 1) * 17408 + 8704);
    const int tok = 16 * dir + (lane >> 2), c16 = (lane & 3) * 16;
    const size_t gtok = (size_t)tokbase + T0 + tok;
    u16* op = p.ycat + gtok * 1024 + 768 + nblk * 64 + c16;
#pragma unroll
    for (int hv = 0; hv < 2; ++hv) {
      const uint4 g = gq[hv];
      const float4 f0 = *(const float4*)(hfT + tok * 68 + c16 + hv * 8), f1 = *(const float4*)(hfT + tok * 68 + c16 + hv * 8 + 4);
      const float4 h0 = *(const float4*)(hbT + tok * 68 + c16 + hv * 8), h1 = *(const float4*)(hbT + tok * 68 + c16 + hv * 8 + 4);
      uint4 o;
      o.x = pk2((f0.x + h0.x) * gelu_tanh(bflo(g.x)), (f0.y + h0.y) * gelu_tanh(bfhi(g.x)));
      o.y = pk2((f0.z + h0.z) * gelu_tanh(bflo(g.y)), (f0.w + h0.w) * gelu_tanh(bfhi(g.y)));
      o.z = pk2((f1.x + h1.x) * gelu_tanh(bflo(g.z)), (f1.y + h1.y) * gelu_tanh(bfhi(g.z)));
      o.w = pk2((f1.z + h1.z) * gelu_tanh(bflo(g.w)), (f1.w + h1.w) * gelu_tanh(bfhi(g.w)));
      *(uint4*)(op + hv * 8) = o;
    }
  }
  __syncthreads();
}

__device__ __forceinline__ void attn_wave(const P& p, int l, int b, int h, bool local, int r, int half, int qtok0, const float* rpbL) {
  const int lane = opaque_tid() & 63, q = lane & 31, hh = lane >> 5;
  bf16x8 qf[4];
  {
    const u16* qp = p.qk + (size_t)(qtok0 + q) * 1024 + h * 64 + 8 * hh;
#pragma unroll
    for (int s = 0; s < 4; ++s) qf[s] = *(const bf16x8*)(qp + 16 * s);
  }
  f32x16 o0 = zero16(), o1 = zero16();
  float m_run = -1e30f, l_run = 0.f;
  const int pi = (q & 19) | ((q & 4) << 1) | ((q & 8) >> 1);
  const int w = half * 32 + q;
  const int st = min(max(w - 8, 0), 48);
  const int rs = min(max(r - 4, 0), 56);
  const int ntiles = local ? 24 : 8;
  bf16x8 kfn[4], vfn[2][2];
  auto tile_load = [&](int ti, bf16x8 (&kfo)[4], bf16x8 (&vfo)[2][2]) {
    int ktok0, vstride;
    const u16* vb;
    if (ti < 8) {
      ktok0 = NLAT + b * 256 + ti * 32;
      vb = p.vTc + ((size_t)(b * 512 + h * 64)) * 256 + ti * 32;
      vstride = 256;
    } else {
      const int tl = ti - 8;
      const int a2 = tl >> 1, g2 = tl & 1;
      ktok0 = b * 4096 + (rs + a2) * 64 + g2 * 32;
      vb = p.vT + ((size_t)(b * 512 + h * 64)) * 4096 + (rs + a2) * 64 + g2 * 32;
      vstride = 4096;
    }
    const u16* kp = p.qk + (size_t)(ktok0 + pi) * 1024 + 512 + h * 64 + 8 * hh;
#pragma unroll
    for (int s = 0; s < 4; ++s) kfo[s] = *(const bf16x8*)(kp + 16 * s);
#pragma unroll
    for (int dt = 0; dt < 2; ++dt)
#pragma unroll
      for (int s2 = 0; s2 < 2; ++s2) vfo[dt][s2] = *(const bf16x8*)(vb + (size_t)(dt * 32 + q) * vstride + 16 * s2 + 8 * hh);
  };
  tile_load(0, kfn, vfn);
  for (int ti = 0; ti < ntiles; ++ti) {
    int a = 0, g = 0;
    if (ti >= 8) { a = (ti - 8) >> 1; g = (ti - 8) & 1; }
    bf16x8 kf[4], vf[2][2];
#pragma unroll
    for (int s = 0; s < 4; ++s) kf[s] = kfn[s];
#pragma unroll
    for (int dt = 0; dt < 2; ++dt)
#pragma unroll
      for (int s2 = 0; s2 < 2; ++s2) vf[dt][s2] = vfn[dt][s2];
    if (ti + 1 < ntiles) tile_load(ti + 1, kfn, vfn);
    f32x16 sacc = zero16();
#pragma unroll
    for (int s = 0; s < 4; ++s) sacc = mfma32(kf[s], qf[s], sacc);
    float sv[16];
    float tmax = -1e30f;
#pragma unroll
    for (int e = 0; e < 16; ++e) {
      float x = sacc[e] * 0.125f;
      if (ti >= 8) {
        const int kc = g * 32 + (e & 7) + 8 * hh + 16 * (e >> 3);
        const bool valid = (kc >= st) && (kc < st + 16);
        const int bi = valid ? ((rs + a - r + 7) * 31 + (kc - w + 15)) : 0;
        const float bias = rpbL[bi];
        x = valid ? (x + bias) : -1e30f;
      }
      sv[e] = x;
      tmax = fmaxf(tmax, x);
    }
    tmax = fmaxf(tmax, shx(tmax, 32));
    const float m_new = fmaxf(m_run, tmax);
    const float alpha = __expf(m_run - m_new);
    m_run = m_new;
    l_run *= alpha;
#pragma unroll
    for (int e = 0; e < 16; ++e) { o0[e] *= alpha; o1[e] *= alpha; }
    float psum = 0.f;
#pragma unroll
    for (int e = 0; e < 16; ++e) { const float pe = __expf(sv[e] - m_new); sv[e] = pe; psum += pe; }
    l_run += psum;
    bf16x8 pf[2];
#pragma unroll
    for (int s2 = 0; s2 < 2; ++s2) {
      union { bf16x8 v; unsigned u[4]; } cv;
#pragma unroll
      for (int j = 0; j < 4; ++j) cv.u[j] = pk2(sv[8 * s2 + 2 * j], sv[8 * s2 + 2 * j + 1]);
      pf[s2] = cv.v;
    }
#pragma unroll
    for (int s2 = 0; s2 < 2; ++s2) {
      o0 = mfma32(vf[0][s2], pf[s2], o0);
      o1 = mfma32(vf[1][s2], pf[s2], o1);
    }
  }
  const float lt = l_run + shx(l_run, 32);
  const float inv = 1.0f / lt;
  u16* op = p.ycat + (size_t)(qtok0 + q) * 1024 + h * 64;
#pragma unroll
  for (int qd = 0; qd < 4; ++qd) {
    uint2 a0, a1;
    a0.x = pk2(o0[4 * qd] * inv, o0[4 * qd + 1] * inv);
    a0.y = pk2(o0[4 * qd + 2] * inv, o0[4 * qd + 3] * inv);
    a1.x = pk2(o1[4 * qd] * inv, o1[4 * qd + 1] * inv);
    a1.y = pk2(o1[4 * qd + 2] * inv, o1[4 * qd + 3] * inv);
    *(uint2*)(op + 8 * qd + 4 * hh) = a0;
    *(uint2*)(op + 32 + 8 * qd + 4 * hh) = a1;
  }
}
__device__ __forceinline__ void attn_block_task(const P& p, int l, int b, int h, int rg4, char* smem) {
  const int tid = opaque_tid(), lane = tid & 63, wid = tid >> 6;
  const int q = lane & 31, hh = lane >> 5;
  const int R0 = rg4 * 4;
  const int r = R0 + (wid >> 1), half = wid & 1;
  float* rpbL = (float*)(smem + 32768) + 64;
  for (int i = tid; i < 465; i += NTHR) rpbL[i] = p.na_rpb[(size_t)(l * 8 + h) * 465 + i] * 1.4426950408889634f;
  const int lo = min(max(R0 - 4, 0), 56);
  const int hi = min(max(R0 + 3 - 4, 0), 56) + 7;
  const int ntile = 4 + (hi - lo + 1);
  const int rs = min(max(r - 4, 0), 56);
  const int qtok = b * 4096 + r * 64 + half * 32 + q;
  bf16x8 qf[4];
  {
    const u16* qp = p.qk + (size_t)qtok * 1024 + h * 64 + 8 * hh;
#pragma unroll
    for (int s = 0; s < 4; ++s) qf[s] = *(const bf16x8*)(qp + 16 * s);
  }
  f32x16 o0 = zero16(), o1 = zero16();
  float m_run = -1e30f, l_run = 0.f;
  const int pi = (q & 19) | ((q & 4) << 1) | ((q & 8) >> 1);
  const int w = half * 32 + q;
  const int st = min(max(w - 8, 0), 48);
  unsigned vmask = 0u;
#pragma unroll
  for (int g = 0; g < 2; ++g)
#pragma unroll
    for (int e = 0; e < 16; ++e) {
      const int kc = g * 32 + (e & 7) + 8 * hh + 16 * (e >> 3);
      vmask |= ((kc >= st) && (kc < st + 16)) ? (1u << (g * 16 + e)) : 0u;
    }
  const int cbase = 8 * hh - w + 15;
  const int srow = tid >> 3, sch = tid & 7;
  uint4 rkA, rvA, rkB, rvB;
  auto gload = [&](int ti, uint4& rk, uint4& rv) {
    int ktok0, vstride;
    const u16* vb;
    if (ti < 4) { ktok0 = NLAT + b * 256 + ti * 64; vb = p.vTc + ((size_t)(b * 512 + h * 64)) * 256 + ti * 64; vstride = 256; }
    else { const int R = lo + ti - 4; ktok0 = b * 4096 + R * 64; vb = p.vT + ((size_t)(b * 512 + h * 64)) * 4096 + R * 64; vstride = 4096; }
    rk = *(const uint4*)(p.qk + (size_t)(ktok0 + srow) * 1024 + 512 + h * 64 + sch * 8);
    rv = *(const uint4*)(vb + (size_t)srow * vstride + sch * 8);
  };
  gload(0, rkB, rvB);
  gload(1, rkA, rvA);
  *(uint4*)(smem + swz128(srow, sch)) = rkB;
  *(uint4*)(smem + 16384 + swz128(srow, sch)) = rvB;
  if (2 < ntile) gload(2, rkB, rvB);
  __syncthreads();
  auto compute = [&](int ti) {
    const char* Kb = smem + (ti & 1) * 8192;
    const char* Vb = smem + 16384 + (ti & 1) * 8192;
    const int R = lo + ti - 4;
    const bool active = (ti < 4) || (R >= rs && R < rs + 8);
    if (active) {
      f32x16 sacc0 = zero16(), sacc1 = zero16();
      __builtin_amdgcn_s_setprio(1);
#pragma unroll
      for (int s = 0; s < 4; ++s) {
        const bf16x8 kf0 = *(const bf16x8*)(Kb + swz128(pi, 2 * s + hh));
        const bf16x8 kf1 = *(const bf16x8*)(Kb + swz128(32 + pi, 2 * s + hh));
        sacc0 = mfma32(kf0, qf[s], sacc0);
        sacc1 = mfma32(kf1, qf[s], sacc1);
      }
      __builtin_amdgcn_s_setprio(0);
      float sv[32];
      float tmax = -1e30f;
      if (ti >= 4) {
        const float* brow = rpbL + (R - r + 7) * 31 + cbase;
        float bias[32];
#pragma unroll
        for (int g = 0; g < 2; ++g)
#pragma unroll
          for (int e = 0; e < 16; ++e) bias[g * 16 + e] = brow[g * 32 + (e & 7) + 16 * (e >> 3)];
#pragma unroll
        for (int g = 0; g < 2; ++g)
#pragma unroll
          for (int e = 0; e < 16; ++e) {
            const float sc = g ? sacc1[e] : sacc0[e];
            const float x = ((int)(vmask << (31 - (g * 16 + e))) < 0) ? fmaf(sc, 0.18033688011112042f, bias[g * 16 + e]) : -1e30f;
            sv[g * 16 + e] = x;
            tmax = fmaxf(tmax, x);
          }
      } else {
#pragma unroll
        for (int g = 0; g < 2; ++g)
#pragma unroll
          for (int e = 0; e < 16; ++e) {
            const float x = (g ? sacc1[e] : sacc0[e]) * 0.18033688011112042f;
            sv[g * 16 + e] = x;
            tmax = fmaxf(tmax, x);
          }
      }
      tmax = fmaxf(tmax, shx(tmax, 32));
      if (__builtin_amdgcn_ballot_w64(tmax > m_run) != 0ull) {
        const float m_new = fmaxf(m_run, tmax);
        const float alpha = __builtin_amdgcn_exp2f(m_run - m_new);
        m_run = m_new;
        l_run *= alpha;
#pragma unroll
        for (int e = 0; e < 16; ++e) { o0[e] *= alpha; o1[e] *= alpha; }
      }
      float psum = 0.f;
#pragma unroll
      for (int e = 0; e < 32; ++e) { const float pe = __builtin_amdgcn_exp2f(sv[e] - m_run); sv[e] = pe; psum += pe; }
      l_run += psum;
      __builtin_amdgcn_s_setprio(1);
#pragma unroll
      for (int g = 0; g < 2; ++g)
#pragma unroll
        for (int s2 = 0; s2 < 2; ++s2) {
          union { bf16x8 v; unsigned u[4]; } cv;
#pragma unroll
          for (int j = 0; j < 4; ++j) cv.u[j] = pk2(sv[g * 16 + 8 * s2 + 2 * j], sv[g * 16 + 8 * s2 + 2 * j + 1]);
          const bf16x8 v0 = *(const bf16x8*)(Vb + swz128(q, g * 4 + 2 * s2 + hh));
          const bf16x8 v1 = *(const bf16x8*)(Vb + swz128(32 + q, g * 4 + 2 * s2 + hh));
          o0 = mfma32(v0, cv.v, o0);
          o1 = mfma32(v1, cv.v, o1);
        }
      __builtin_amdgcn_s_setprio(0);
    }
  };
  for (int ti = 0; ti < ntile; ti += 2) {
    compute(ti);
    if (ti + 1 < ntile) {
      *(uint4*)(smem + 8192 + swz128(srow, sch)) = rkA;
      *(uint4*)(smem + 16384 + 8192 + swz128(srow, sch)) = rvA;
      if (ti + 3 < ntile) gload(ti + 3, rkA, rvA);
    }
    __syncthreads();
    if (ti + 1 < ntile) {
      compute(ti + 1);
      if (ti + 2 < ntile) {
        *(uint4*)(smem + swz128(srow, sch)) = rkB;
        *(uint4*)(smem + 16384 + swz128(srow, sch)) = rvB;
        if (ti + 4 < ntile) gload(ti + 4, rkB, rvB);
      }
      __syncthreads();
    }
  }
  const float lt = l_run + shx(l_run, 32);
  const float inv = 1.0f / lt;
  __syncthreads();
  {
    char* ot = smem + wid * 4608;
#pragma unroll
    for (int qd = 0; qd < 4; ++qd) {
      uint2 a0, a1;
      a0.x = pk2(o0[4 * qd] * inv, o0[4 * qd + 1] * inv);
      a0.y = pk2(o0[4 * qd + 2] * inv, o0[4 * qd + 3] * inv);
      a1.x = pk2(o1[4 * qd] * inv, o1[4 * qd + 1] * inv);
      a1.y = pk2(o1[4 * qd + 2] * inv, o1[4 * qd + 3] * inv);
      *(uint2*)(ot + q * 144 + (8 * qd + 4 * hh) * 2) = a0;
      *(uint2*)(ot + q * 144 + (32 + 8 * qd + 4 * hh) * 2) = a1;
    }
    asm volatile("s_waitcnt lgkmcnt(0)" ::: "memory");
    const int tok0 = b * 4096 + r * 64 + half * 32;
#pragma unroll
    for (int it = 0; it < 4; ++it) {
      const int qq = it * 8 + (lane >> 3), ch = lane & 7;
      const uint4 v = *(const uint4*)(ot + qq * 144 + ch * 16);
      *(uint4*)(p.ycat + (size_t)(tok0 + qq) * 1024 + h * 64 + ch * 8) = v;
    }
  }
  __syncthreads();
}
__device__ __forceinline__ void attn_task(const P& p, int l, int kind, int idx, char* smem) {
  const int tid_ = opaque_tid(); const int lane = tid_ & 63, wid = tid_ >> 6;
  float* rpbL = (float*)smem + wid * 480;
  for (int i = lane; i < 465; i += 64) rpbL[i] = p.na_rpb[(size_t)(l * 8 + wid) * 465 + i];
  __syncthreads();
  if (kind == 0) {
    const int half = idx & 1, r = (idx >> 1) & 63, b = idx >> 7;
    attn_wave(p, l, b, wid, true, r, half, b * 4096 + r * 64 + half * 32, rpbL);
  } else {
    const int qg = idx & 7, b = idx >> 3;
    attn_wave(p, l, b, wid, false, 0, 0, NLAT + b * 256 + qg * 32, rpbL);
  }
  __syncthreads();
}

__device__ __forceinline__ void phase_mixers(const P& p, int l, char* smem, unsigned* counter) {
  const bool last = (l == 1);
  const int n_rg = 1088 * XRGA, n_fft = 1024 * XFFT, n_hc = last ? 0 : 256, n_att = 1024 * XATT, n_attc = last ? 0 : 64;
  const int total = n_rg + n_fft + n_hc + n_att + n_attc;
  volatile int* s_taskp = (volatile int*)(smem + SMEM_BYTES - 16);
  int nxt = 0;
  if (threadIdx.x == 0) nxt = (int)atomicAdd(counter, 1u);
  for (;;) {
    __syncthreads();
    if (threadIdx.x == 0) *s_taskp = nxt;
    __syncthreads();
    int t = *s_taskp;
    if (t >= total) break;
    if (threadIdx.x == 0) nxt = (int)atomicAdd(counter, 1u);
    if (t < n_att) { t &= 1023; attn_block_task(p, l, t >> 7, (t >> 4) & 7, t & 15, smem); continue; }
    t -= n_att;
    if (t < n_attc) { attn_task(p, l, 1, t, smem); continue; }
    t -= n_attc;
    if (t < n_fft) { t &= 1023; hyena_fft_task(p, l, t >> 2, t & 3, smem); continue; }
    t -= n_fft;
    if (t < n_hc) { hyena_ctx_task(p, l, t >> 5, t & 31, smem); continue; }
    t -= n_hc;
    if (t >= 1088) t -= 1088;
    rg_wave_task(p, l, t >> 2, t & 3, 0, last, smem);
  }
}

__device__ __forceinline__ void merge_tile(const P& p, int l, int mt, int nt, char* smem) {
  EPI_VARS
  const int m0 = mt * 256, n0 = nt * 128;
  f32x16 macc[2][2];
  zero_acc(macc);
  for (int br = 0; br < 3; ++br) {
    unsigned* gpl = (unsigned*)(smem + 98304) + tid;
    {
      f32x16 acc[2][2];
      zero_acc(acc);
      gemm_kloop(acc, p.xn + (size_t)m0 * 1024, 1024, p.WgT + ((size_t)l * 3072 + br * 1024 + n0) * 1024, 1024, 1024, smem);
#pragma unroll
      for (int j = 0; j < 2; ++j) {
        const float bg = p.b_gate[l * 3072 + br * 1024 + n0 + EPI_COL(j)];
#pragma unroll
        for (int i = 0; i < 2; ++i)
#pragma unroll
          for (int e = 0; e < 4; ++e) {
            const unsigned q0 = (unsigned)(sigmoidf_(acc[i][j][4 * e] + bg) * 255.0f + 0.5f);
            const unsigned q1 = (unsigned)(sigmoidf_(acc[i][j][4 * e + 1] + bg) * 255.0f + 0.5f);
            const unsigned q2 = (unsigned)(sigmoidf_(acc[i][j][4 * e + 2] + bg) * 255.0f + 0.5f);
            const unsigned q3 = (unsigned)(sigmoidf_(acc[i][j][4 * e + 3] + bg) * 255.0f + 0.5f);
            gpl[((i * 2 + j) * 4 + e) * 512] = q0 | (q1 << 8) | (q2 << 16) | (q3 << 24);
          }
      }
    }
    {
      f32x16 acc[2][2];
      zero_acc(acc);
      const u16* A; const u16* B; int K;
      if (br == 0) { A = p.ycat + (size_t)m0 * 1024; B = p.WaT + ((size_t)l * 1024 + n0) * 512; K = 512; }
      else if (br == 1) { A = p.ycat + (size_t)m0 * 1024 + 512; B = p.WbT + ((size_t)l * 1024 + n0) * 256; K = 256; }
      else { A = p.ycat + (size_t)m0 * 1024 + 768; B = p.WcT + ((size_t)l * 1024 + n0) * 256; K = 256; }
      gemm_kloop(acc, A, 1024, B, K, K, smem);
#pragma unroll
      for (int i = 0; i < 2; ++i)
#pragma unroll
        for (int j = 0; j < 2; ++j)
#pragma unroll
          for (int e = 0; e < 4; ++e) {
            const unsigned g4 = gpl[((i * 2 + j) * 4 + e) * 512];
            macc[i][j][4 * e] += (float)(g4 & 255u) * (1.0f / 255.0f) * acc[i][j][4 * e];
            macc[i][j][4 * e + 1] += (float)((g4 >> 8) & 255u) * (1.0f / 255.0f) * acc[i][j][4 * e + 1];
            macc[i][j][4 * e + 2] += (float)((g4 >> 16) & 255u) * (1.0f / 255.0f) * acc[i][j][4 * e + 2];
            macc[i][j][4 * e + 3] += (float)(g4 >> 24) * (1.0f / 255.0f) * acc[i][j][4 * e + 3];
          }
    }
  }
#pragma unroll
  for (int i = 0; i < 2; ++i)
#pragma unroll
    for (int j = 0; j < 2; ++j)
#pragma unroll
      for (int e = 0; e < 16; ++e)
        p.mbuf[(size_t)(m0 + EPI_ROW(i, e)) * 1024 + n0 + EPI_COL(j)] = f2bf(macc[i][j][e]);
}
__device__ __forceinline__ void outproj_tile(const P& p, int l, int mt, int nt, char* smem, bool do_store) {
  EPI_VARS
  const int m0 = mt * 256, n0 = nt * 128;
  f32x16 acc[2][2];
  zero_acc(acc);
  gemm_kloop(acc, p.mbuf + (size_t)m0 * 1024, 1024, p.WoT + ((size_t)l * 1024 + n0) * 1024, 1024, 1024, smem);
  const bool isctx = (mt >= 128);
  const int bi = isctx ? 8 : (mt >> 4);
  const float* gatev = p.mod + ((size_t)(l * 9 + bi) * 6 + 2) * 1024;
  const float* src; float* dst;
  if (isctx) { src = (l == 0 ? p.ctx : p.ctxs) - (size_t)NLAT * 1024; dst = p.ctxs - (size_t)NLAT * 1024; }
  else { src = (l == 0 ? p.x : p.out); dst = p.out; }
#pragma unroll
  for (int j = 0; j < 2; ++j) {
    const int col = n0 + EPI_COL(j);
    const float gv = gatev[col];
#pragma unroll
    for (int i = 0; i < 2; ++i)
#pragma unroll
      for (int e = 0; e < 16; ++e) {
        const size_t o = (size_t)(m0 + EPI_ROW(i, e)) * 1024 + col;
        if (do_store) dst[o] = src[o] + gv * acc[i][j][e];
      }
  }
}

__device__ __forceinline__ void wqk_task(const P& p, int l, int hp, int nt, char* smem) {
  EPI_VARS
  f32x16 acc[2][2];
  zero_acc(acc);
  gemm_kloop(acc, p.keysB + ((size_t)l * 16 + hp) * 16384, 128, p.WqB + (size_t)l * 1024 * 2048 + (size_t)(nt * 128) * 2048 + hp * 128, 2048, 128, smem);
  if (wm < 2) {
#pragma unroll
    for (int i = 0; i < 2; ++i)
#pragma unroll
      for (int j = 0; j < 2; ++j)
#pragma unroll
        for (int e = 0; e < 16; ++e)
          p.WqkT[((size_t)l * 2048 + hp * 128 + EPI_ROW(i, e)) * 1024 + nt * 128 + EPI_COL(j)] = f2bf(acc[i][j][e]);
  }
}
__device__ __forceinline__ void ins16(unsigned (&L)[16], unsigned x) {
#pragma unroll
  for (int i = 0; i < 16; ++i) {
    const unsigned hi = max(L[i], x);
    x = min(L[i], x);
    L[i] = hi;
  }
}
__device__ __forceinline__ unsigned f2sort(float f) {
  const unsigned b = __float_as_uint(f);
  return b ^ ((unsigned)((int)b >> 31) | 0x80000000u);
}
__device__ __forceinline__ float sort2f16(unsigned k) {
  const unsigned sv = k >> 16;
  const unsigned h = (sv & 0x8000u) ? (sv ^ 0x8000u) : (~sv & 0xffffu);
  return (float)__builtin_bit_cast(_Float16, (unsigned short)h);
}
__device__ __forceinline__ float sort2f(unsigned k) {
  const unsigned u = k & ~127u;
  const unsigned b = (u & 0x80000000u) ? (u ^ 0x80000000u) : ~u;
  return __uint_as_float(b);
}
__device__ __forceinline__ void cx_desc(unsigned& a, unsigned& b) { const unsigned hi = max(a, b), lo = min(a, b); a = hi; b = lo; }
template <int BASE> __device__ __forceinline__ void sort16_desc(unsigned (&k)[64]) {
#pragma unroll
  for (int sz = 2; sz <= 16; sz <<= 1) {
#pragma unroll
    for (int j = sz >> 1; j >= 1; j >>= 1) {
#pragma unroll
      for (int i = 0; i < 16; ++i) {
        const int l2 = i ^ j;
        if (l2 > i) {
          if ((i & sz) == 0) cx_desc(k[BASE + i], k[BASE + l2]);
          else cx_desc(k[BASE + l2], k[BASE + i]);
        }
      }
    }
  }
}
template <int AB, int BB> __device__ __forceinline__ void merge16_desc(unsigned (&k)[64]) {
#pragma unroll
  for (int i = 0; i < 16; ++i) k[AB + i] = max(k[AB + i], k[BB + 15 - i]);
#pragma unroll
  for (int j = 8; j >= 1; j >>= 1) {
#pragma unroll
    for (int i = 0; i < 16; ++i)
      if ((i & j) == 0) cx_desc(k[AB + i], k[AB + i + j]);
  }
}
#define PS_LOAD(mt_, hp_) do { _Pragma("unroll") for (int it = 0; it < 8; ++it) { const int id = tid + NTHR * it; \
    pre[it] = *(const uint4*)(p.q + (size_t)((mt_) * 256 + (id >> 4)) * 2048 + (hp_) * 128 + (id & 15) * 8); } } while (0)
__device__ __forceinline__ void peer_score_tile(const P& p, int l, int mt, int hp, char* smem, uint4& p0, uint4& p1, uint4& p2, uint4& p3, uint4& p4, uint4& p5, uint4& p6, uint4& p7, int nmt, int nhp) {
  const int tid = opaque_tid();
  const int m0 = mt * 256;
  const int row = tid >> 1, hf = tid & 1;
  {
    char* T = smem + 16384;
    uint4 pre[8] = {p0, p1, p2, p3, p4, p5, p6, p7};
#pragma unroll
    for (int it = 0; it < 8; ++it) {
      const int id = tid + NTHR * it;
      const int r = id >> 4, ch = id & 15;
      *(uint4*)(T + r * 272 + ch * 16) = pre[it];
    }
    PS_LOAD(nmt, nhp);
    p0 = pre[0]; p1 = pre[1]; p2 = pre[2]; p3 = pre[3]; p4 = pre[4]; p5 = pre[5]; p6 = pre[6]; p7 = pre[7];
  }
  __syncthreads();
  const char* sp = smem + 16384 + row * 272 + hf * 128;
  unsigned k[64];
#pragma unroll
  for (int c = 0; c < 8; ++c) {
    const uint4 r = *(const uint4*)(sp + 16 * c);
    const unsigned w[4] = {r.x, r.y, r.z, r.w};
#pragma unroll
    for (int q = 0; q < 4; ++q) {
      const unsigned sk = w[q] ^ ((((w[q] >> 15) & 0x00010001u) * 0x7fffu) | 0x80008000u);
      const int key = hf * 64 + c * 8 + q * 2;
      k[c * 8 + q * 2] = (sk << 16) | (unsigned)key;
      k[c * 8 + q * 2 + 1] = (sk & 0xffff0000u) | (unsigned)(key + 1);
    }
  }
  sort16_desc<0>(k); sort16_desc<16>(k); sort16_desc<32>(k); sort16_desc<48>(k);
  merge16_desc<0, 16>(k);
  merge16_desc<32, 48>(k);
  merge16_desc<0, 32>(k);
  unsigned* X = (unsigned*)smem;
  if (hf) {
#pragma unroll
    for (int i = 0; i < 16; ++i) X[row * 16 + i] = k[i];
  }
  __syncthreads();
  if (!hf) {
#pragma unroll
    for (int i = 0; i < 16; ++i) k[16 + i] = X[row * 16 + i];
    merge16_desc<0, 16>(k);
    unsigned* o = p.topk + ((size_t)(m0 + row) * 16 + hp) * 16;
#pragma unroll
    for (int i = 0; i < 4; ++i) *(uint4*)(o + 4 * i) = make_uint4(k[4 * i], k[4 * i + 1], k[4 * i + 2], k[4 * i + 3]);
  }
  __syncthreads();
}

__device__ __forceinline__ void phase_peer_experts(const P& p, int l, bool do_store, char* smem) {
  const int tid_ = opaque_tid(); const int lane = tid_ & 63, wid = tid_ >> 6;
  const int ntok = (l == 1) ? NLAT : NTOK;
  int ci, cj;
  {
    const int e = lane;
    if (e < 16) { ci = 0; cj = e; }
    else if (e < 24) { ci = 1; cj = e - 16; }
    else if (e < 29) { ci = 2; cj = e - 24; }
    else if (e < 33) { ci = 3; cj = e - 29; }
    else if (e < 36) { ci = 4; cj = e - 33; }
    else if (e < 38) { ci = 5; cj = e - 36; }
    else if (e < 40) { ci = 6; cj = e - 38; }
    else if (e < 42) { ci = 7; cj = e - 40; }
    else { ci = min(8 + (e - 42), 15); cj = 0; }
  }
#define PX_LOAD(T) do { const unsigned* kvp_ = p.topk + (size_t)(T) * 256 + (lane & 31); \
    nk0 = kvp_[0]; nk1 = kvp_[32]; nk2 = kvp_[64]; nk3 = kvp_[96]; nk4 = kvp_[128]; nk5 = kvp_[160]; nk6 = kvp_[192]; nk7 = kvp_[224]; \
    na = *(const uint4*)(p.xn8 + (size_t)(T) * 1024 + lane * 16); ns = p.sa[T]; } while (0)
  unsigned nk0 = 0, nk1 = 0, nk2 = 0, nk3 = 0, nk4 = 0, nk5 = 0, nk6 = 0, nk7 = 0; uint4 na = make_uint4(0u, 0u, 0u, 0u); float ns = 0.f;
  if (blockIdx.x * 8 + wid < ntok) PX_LOAD(blockIdx.x * 8 + wid);
  for (int tok = blockIdx.x * 8 + wid; tok < ntok; tok += gridDim.x * 8) {
    const unsigned kv8[8] = {nk0, nk1, nk2, nk3, nk4, nk5, nk6, nk7};
    float xr[16];
    {
      const uint4 a = na;
      const float sx = ns;
      const unsigned aw[4] = {a.x, a.y, a.z, a.w};
#pragma unroll
      for (int i = 0; i < 4; ++i) {
        xr[4 * i] = (float)((int)(aw[i] << 24) >> 24) * sx; xr[4 * i + 1] = (float)((int)(aw[i] << 16) >> 24) * sx;
        xr[4 * i + 2] = (float)((int)(aw[i] << 8) >> 24) * sx; xr[4 * i + 3] = (float)((int)aw[i] >> 24) * sx;
      }
    }
    typedef _Float16 h2_t __attribute__((ext_vector_type(2)));
    h2_t yh[16];
#pragma unroll
    for (int i = 0; i < 16; ++i) yh[i] = (h2_t){(_Float16)0, (_Float16)0};
    int* selw = (int*)(smem + wid * 4096);
#pragma unroll 1
    for (int hb = 0; hb < 8; hb += 4) {
      unsigned key[4]; int eidx[4];
#pragma unroll
      for (int u = 0; u < 4; ++u) {
        const unsigned kv = hb ? kv8[4 + u] : kv8[u];
        const unsigned k0 = shu(kv, ci);
        const unsigned k1 = shu(kv, 16 + cj);
        const float val = (lane < 50) ? (sort2f16(k0) + sort2f16(k1)) : -3.0e38f;
        eidx[u] = (int)((k0 & 127u) * 128u + (k1 & 127u));
        key[u] = (f2sort(val) & ~63u) | (unsigned)lane;
      }
#pragma unroll
      for (int k = 2; k <= 64; k <<= 1) {
#pragma unroll
        for (int j = k >> 1; j >= 1; j >>= 1) {
          const bool take_max = (((lane & j) == 0) == ((lane & k) == 0));
#pragma unroll
          for (int u = 0; u < 4; ++u) {
            unsigned ok;
            if (j == 1) ok = xorl<1>(key[u], lane); else if (j == 2) ok = xorl<2>(key[u], lane); else if (j == 4) ok = xorl<4>(key[u], lane);
            else if (j == 8) ok = xorl<8>(key[u], lane); else if (j == 16) ok = xorl<16>(key[u], lane); else ok = xorl<32>(key[u], lane);
            key[u] = take_max ? max(key[u], ok) : min(key[u], ok);
          }
        }
      }
#pragma unroll
      for (int u = 0; u < 4; ++u) {
        const int si = __builtin_amdgcn_ds_bpermute((int)(key[u] & 63u) << 2, eidx[u]);
        const unsigned ku = key[u] & ~63u;
        const float sv = __uint_as_float((ku & 0x80000000u) ? (ku ^ 0x80000000u) : ~ku);
        const float mx = __builtin_bit_cast(float, __builtin_amdgcn_readlane(__builtin_bit_cast(int, sv), 0));
        const float ex = (lane < 16) ? __builtin_amdgcn_exp2f((sv - mx) * 1.4426950408889634f) : 0.f;
        const float sm = wave_sum(ex);
        selw[(hb + u) * 64 + lane] = si;
        selw[512 + (hb + u) * 64 + lane] = __builtin_bit_cast(int, ex * __builtin_amdgcn_rcpf(sm));
      }
    }
    {
      int w[4];
#pragma unroll
      for (int i = 0; i < 4; ++i) {
        int t = __builtin_amdgcn_cvt_pk_fp8_f32(xr[4 * i], xr[4 * i + 1], 0, false);
        w[i] = __builtin_amdgcn_cvt_pk_fp8_f32(xr[4 * i + 2], xr[4 * i + 3], t, true);
      }
      *(uint4*)(smem + 32768 + wid * 1024 + lane * 16) = make_uint4((unsigned)w[0], (unsigned)w[1], (unsigned)w[2], (unsigned)w[3]);
    }
    asm volatile("s_waitcnt lgkmcnt(0)" ::: "memory");
    {
      const int tokn = (tok + (int)gridDim.x * 8 < ntok) ? tok + (int)gridDim.x * 8 : tok;
      PX_LOAD(tokn);
    }
    const int bi = tok < NLAT ? (tok >> 12) : 8;
    const float* gv = p.mod + ((size_t)(l * 9 + bi) * 6 + 5) * 1024 + lane * 16;
    u16* rp = p.res + (size_t)tok * 1024 + lane * 16;
    const uint4 pr0 = *(const uint4*)rp, pr1 = *(const uint4*)(rp + 8);
    const float4 pg0 = *(const float4*)(gv), pg1 = *(const float4*)(gv + 4), pg2 = *(const float4*)(gv + 8), pg3 = *(const float4*)(gv + 12);
    const int e15 = lane & 15, g4 = lane >> 4;
#pragma unroll 1
    for (int h = 0; h < 8; ++h) {
      const int eperm_h = selw[h * 64 + lane];
      const int gperm_h = selw[512 + h * 64 + lane];
      const int ide = (int)shu((unsigned)eperm_h, e15);
      const unsigned char* ub = p.Ub + (size_t)ide * 1024 + g4 * 16;
      uint4 ua[8];
#pragma unroll
      for (int sI = 0; sI < 8; ++sI) ua[sI] = *(const uint4*)(ub + sI * 64);
      pg8::f32x4 hacc = {0.f, 0.f, 0.f, 0.f};
#pragma unroll
      for (int sI = 0; sI < 8; ++sI) {
        const uint4 b0 = *(const uint4*)(smem + 32768 + wid * 1024 + sI * 128 + g4 * 16);
        const uint4 b1 = *(const uint4*)(smem + 32768 + wid * 1024 + sI * 128 + 64 + g4 * 16);
        const i32x8 A = {(int)ua[sI].x, (int)ua[sI].y, (int)ua[sI].z, (int)ua[sI].w, 0, 0, 0, 0};
        const i32x8 B = {(int)b0.x, (int)b0.y, (int)b0.z, (int)b0.w, (int)b1.x, (int)b1.y, (int)b1.z, (int)b1.w};
        hacc = __builtin_amdgcn_mfma_scale_f32_16x16x128_f8f6f4(A, B, hacc, 4  , 0  , 0, 0x7f7f7f7f, 0, 0x7f7f7f7f);
      }
      asm volatile("" ::: "memory");
      uint4 W[8];
#pragma unroll
      for (int k2 = 0; k2 < 8; ++k2) {
        const int idA = __builtin_amdgcn_readlane(eperm_h, 2 * k2), idB = __builtin_amdgcn_readlane(eperm_h, 2 * k2 + 1);
        const int id = (lane < 32) ? idA : idB;
        W[k2] = *(const uint4*)(p.Ub + (size_t)id * 1024 + 512 + (lane & 31) * 16);
      }
      float actv[4];
#pragma unroll
      for (int r4 = 0; r4 < 4; ++r4) {
        const float gl = __builtin_bit_cast(float, shu((unsigned)gperm_h, 4 * g4 + r4));
        actv[r4] = gelu_tanh(hacc[r4] * (1.0f / 64.0f)) * gl;
      }
#pragma unroll
      for (int k2 = 0; k2 < 8; ++k2) {
        const float akA = __builtin_bit_cast(float, __builtin_amdgcn_readlane(__builtin_bit_cast(int, actv[(2 * k2) & 3]), 16 * ((2 * k2) >> 2)));
        const float akB = __builtin_bit_cast(float, __builtin_amdgcn_readlane(__builtin_bit_cast(int, actv[(2 * k2 + 1) & 3]), 16 * ((2 * k2 + 1) >> 2)));
        const float ak = (lane < 32) ? akA : akB;
        const h2_t akh = {(_Float16)ak, (_Float16)ak};
        const unsigned vw[4] = {W[k2].x, W[k2].y, W[k2].z, W[k2].w};
#pragma unroll
        for (int q4 = 0; q4 < 4; ++q4) {
          yh[4 * q4 + 0] = __builtin_elementwise_fma(akh, __builtin_bit_cast(h2_t, __builtin_amdgcn_cvt_scalef32_pk_f16_fp4(vw[q4], 1.0f, 0)), yh[4 * q4 + 0]);
          yh[4 * q4 + 1] = __builtin_elementwise_fma(akh, __builtin_bit_cast(h2_t, __builtin_amdgcn_cvt_scalef32_pk_f16_fp4(vw[q4], 1.0f, 1)), yh[4 * q4 + 1]);
          yh[4 * q4 + 2] = __builtin_elementwise_fma(akh, __builtin_bit_cast(h2_t, __builtin_amdgcn_cvt_scalef32_pk_f16_fp4(vw[q4], 1.0f, 2)), yh[4 * q4 + 2]);
          yh[4 * q4 + 3] = __builtin_elementwise_fma(akh, __builtin_bit_cast(h2_t, __builtin_amdgcn_cvt_scalef32_pk_f16_fp4(vw[q4], 1.0f, 3)), yh[4 * q4 + 3]);
        }
      }
    }
    float yacc[16];
    {
      unsigned tot[16];
#pragma unroll
      for (int i = 0; i < 16; ++i) {
        const unsigned own = __builtin_bit_cast(unsigned, yh[i]);
        const h2_t oth = __builtin_bit_cast(h2_t, xorl<32>(own, lane));
        tot[i] = __builtin_bit_cast(unsigned, (h2_t)(yh[i] + oth));
      }
      const int srcl = (lane >> 1) << 2;
#pragma unroll
      for (int i = 0; i < 8; ++i) {
        const unsigned lo = (unsigned)__builtin_amdgcn_ds_bpermute(srcl, (int)tot[i]);
        const unsigned hi = (unsigned)__builtin_amdgcn_ds_bpermute(srcl, (int)tot[8 + i]);
        const h2_t v = __builtin_bit_cast(h2_t, (lane & 1) ? hi : lo);
        yacc[2 * i] = (float)v.x; yacc[2 * i + 1] = (float)v.y;
      }
    }

    float4 xv[4];
    float ss = 0.f;
    {
      const uint4 r0 = pr0, r1 = pr1;
      xv[0] = make_float4(bflo(r0.x), bfhi(r0.x), bflo(r0.y), bfhi(r0.y)); xv[1] = make_float4(bflo(r0.z), bfhi(r0.z), bflo(r0.w), bfhi(r0.w));
      xv[2] = make_float4(bflo(r1.x), bfhi(r1.x), bflo(r1.y), bfhi(r1.y)); xv[3] = make_float4(bflo(r1.z), bfhi(r1.z), bflo(r1.w), bfhi(r1.w));
    }
#pragma unroll
    for (int i = 0; i < 4; ++i) {
      const float4 g4 = (i == 0) ? pg0 : (i == 1) ? pg1 : (i == 2) ? pg2 : pg3;
      xv[i].x += g4.x * yacc[4 * i] * 0.25f; xv[i].y += g4.y * yacc[4 * i + 1] * 0.25f; xv[i].z += g4.z * yacc[4 * i + 2] * 0.25f; xv[i].w += g4.w * yacc[4 * i + 3] * 0.25f;
      ss += xv[i].x * xv[i].x + xv[i].y * xv[i].y + xv[i].z * xv[i].z + xv[i].w * xv[i].w;
    }
    ss = wave_sum(ss);
    const float rstd = rsqrtf(ss * (1.0f / 1024.0f) + 1e-6f);
    if (l == 0) {
      const float* gam = p.norm_mix_g + 1024 + lane * 16;
      const float* msh = p.mod + ((size_t)(9 + bi) * 6 + 0) * 1024 + lane * 16;
      const float* msc = msh + 1024;
      float yv[16];
      float amax = 0.f;
      float4 gq_[4], shq_[4], scq_[4];
#pragma unroll
      for (int i = 0; i < 4; ++i) { gq_[i] = *(const float4*)(gam + 4 * i); shq_[i] = *(const float4*)(msh + 4 * i); scq_[i] = *(const float4*)(msc + 4 * i); }
      __builtin_amdgcn_sched_barrier(0);
#pragma unroll
      for (int i = 0; i < 4; ++i) {
        const float4 g = gq_[i];
        const float4 sh = shq_[i];
        const float4 sc = scq_[i];
        yv[4 * i] = xv[i].x * rstd * g.x * (1.f + sc.x) + sh.x; yv[4 * i + 1] = xv[i].y * rstd * g.y * (1.f + sc.y) + sh.y;
        yv[4 * i + 2] = xv[i].z * rstd * g.z * (1.f + sc.z) + sh.z; yv[4 * i + 3] = xv[i].w * rstd * g.w * (1.f + sc.w) + sh.w;
      }
#pragma unroll
      for (int i = 0; i < 16; ++i) amax = fmaxf(amax, fabsf(yv[i]));
      amax = fmaxf(wave_max(amax), 1e-20f);
      const float inv = 127.0f / amax;
      unsigned w[4];
#pragma unroll
      for (int i = 0; i < 4; ++i)
        w[i] = ((unsigned)__float2int_rn(yv[4 * i] * inv) & 255u) | (((unsigned)__float2int_rn(yv[4 * i + 1] * inv) & 255u) << 8) |
               (((unsigned)__float2int_rn(yv[4 * i + 2] * inv) & 255u) << 16) | (((unsigned)__float2int_rn(yv[4 * i + 3] * inv) & 255u) << 24);
      if (do_store) {
        *(uint4*)rp = make_uint4(pk2(xv[0].x, xv[0].y), pk2(xv[0].z, xv[0].w), pk2(xv[1].x, xv[1].y), pk2(xv[1].z, xv[1].w));
        *(uint4*)(rp + 8) = make_uint4(pk2(xv[2].x, xv[2].y), pk2(xv[2].z, xv[2].w), pk2(xv[3].x, xv[3].y), pk2(xv[3].z, xv[3].w));
        *(uint4*)(p.xn8 + (size_t)tok * 1024 + lane * 16) = make_uint4(w[0], w[1], w[2], w[3]);
        if (lane == 0) p.sa[tok] = amax * (1.0f / 127.0f);
      }
    } else {
      const float* fg = p.final_g + lane * 16;
      float4 gf[4];
#pragma unroll
      for (int i = 0; i < 4; ++i) gf[i] = *(const float4*)(fg + 4 * i);
#pragma unroll
      for (int i = 0; i < 4; ++i) {
        const float4 g = gf[i];
        const float4 o = make_float4(xv[i].x * rstd * g.x, xv[i].y * rstd * g.y, xv[i].z * rstd * g.z, xv[i].w * rstd * g.w);
        if (do_store) *(float4*)(p.out + (size_t)tok * 1024 + lane * 16 + 4 * i) = o;
      }
    }
  }
}


__device__ __forceinline__ void wqk_quant(const P& p) {
  const int tid_ = opaque_tid(); const int lane = tid_ & 63, wid = tid_ >> 6;
  for (int row = blockIdx.x * 8 + wid; row < 2 * 2048; row += gridDim.x * 8) {
    u16* rp = p.WqkT + (size_t)row * 1024;
    const uint4 a = *(const uint4*)(rp + lane * 16), b = *(const uint4*)(rp + lane * 16 + 8);
    float v[16];
    v[0] = bflo(a.x); v[1] = bfhi(a.x); v[2] = bflo(a.y); v[3] = bfhi(a.y); v[4] = bflo(a.z); v[5] = bfhi(a.z); v[6] = bflo(a.w); v[7] = bfhi(a.w);
    v[8] = bflo(b.x); v[9] = bfhi(b.x); v[10] = bflo(b.y); v[11] = bfhi(b.y); v[12] = bflo(b.z); v[13] = bfhi(b.z); v[14] = bflo(b.w); v[15] = bfhi(b.w);
    float amax = 0.f;
#pragma unroll
    for (int i = 0; i < 16; ++i) amax = fmaxf(amax, fabsf(v[i]));
    amax = fmaxf(wave_max(amax), 1e-20f);
    const float inv = 127.0f / amax;
    unsigned w[4];
#pragma unroll
    for (int i = 0; i < 4; ++i)
      w[i] = ((unsigned)__float2int_rn(v[4 * i] * inv) & 255u) | (((unsigned)__float2int_rn(v[4 * i + 1] * inv) & 255u) << 8) |
             (((unsigned)__float2int_rn(v[4 * i + 2] * inv) & 255u) << 16) | (((unsigned)__float2int_rn(v[4 * i + 3] * inv) & 255u) << 24);
    *(uint4*)((unsigned char*)rp + lane * 16) = make_uint4(w[0], w[1], w[2], w[3]);
    if (lane == 0) p.swq[row] = amax * (1.0f / 127.0f);
  }
}

#define XB_TMO      128
#define XB_XCNT(j)  (256  + 64 * (j))
#define XB_XSUB(j)  (1280 + 64 * (j))
#define XB_XGEN(j)  (2304 + 64 * (j))
#define XB_TOP      3328
#define XB_TOPGEN   3392
#define XCD_BAR_WORDS 3456
#define XB_SPIN_CAP (1u << 22)
#define LAS __attribute__((address_space(3)))
__device__ __forceinline__ unsigned xb_ld(unsigned* p) { return __hip_atomic_load(p, __ATOMIC_RELAXED, __HIP_MEMORY_SCOPE_AGENT); }
__device__ __forceinline__ unsigned xb_add(unsigned* p, unsigned v) { return __hip_atomic_fetch_add(p, v, __ATOMIC_RELAXED, __HIP_MEMORY_SCOPE_AGENT); }
__device__ __forceinline__ unsigned xb_xcc_id() { return (unsigned)__builtin_amdgcn_s_getreg((3 << 11) | 20) & 0xFu; }
#define XB_SPIN(cond, bar) do { unsigned _sp = 0; while (cond) { __builtin_amdgcn_s_sleep(1); \
    if ((++_sp & 255u) == 0u) { if (xb_ld(&(bar)[XB_TMO])) break; if (_sp > XB_SPIN_CAP) { atomicAdd(&(bar)[XB_TMO], 1u); break; } } } } while (0)
struct XcdBarrier { unsigned* bar; unsigned x; volatile LAS unsigned* st; };
__device__ __forceinline__ XcdBarrier xcd_barrier_post(unsigned* bar, volatile LAS unsigned* st) {
  XcdBarrier b; b.bar = bar; b.x = xb_xcc_id(); b.st = st;
  if (threadIdx.x == 0) (void)xb_add(&bar[XB_XCNT(b.x)], 1u);
  return b;
}
__device__ __forceinline__ void xcd_barrier_complete(unsigned* bar, unsigned x, unsigned& nloc, unsigned& nx) {
  const unsigned G = gridDim.x * gridDim.y * gridDim.z;
  unsigned sum, cnt, mine, sp = 0u;
  for (;;) {
    sum = 0u; cnt = 0u; mine = 0u;
#pragma unroll
    for (unsigned j = 0; j < 16; ++j) { const unsigned c = xb_ld(&bar[XB_XCNT(j)]); sum += c; cnt += (c > 0u) ? 1u : 0u; mine = (j == x) ? c : mine; }
    if (sum == G) break;
    __builtin_amdgcn_s_sleep(1);
    if ((++sp & 255u) == 0u) { if (xb_ld(&bar[XB_TMO])) break; if (sp > XB_SPIN_CAP) { atomicAdd(&bar[XB_TMO], 1u); break; } }
  }
  nloc = mine > 0u ? mine : 1u; nx = cnt > 0u ? cnt : 1u;
}
__device__ __forceinline__ void xcd_barrier(unsigned* bar_u, volatile LAS unsigned* st_u) {
  XcdBarrier b; b.bar = bar_u; b.x = xb_xcc_id(); b.st = st_u;
  asm volatile("s_waitcnt vmcnt(0)" ::: "memory");
  __syncthreads();
  if (threadIdx.x == 0) {
    unsigned long long bp_ = (unsigned long long)b.bar;
    asm volatile("" : "+v"(bp_));
    unsigned* bar = (unsigned*)bp_;
    __builtin_amdgcn_s_waitcnt(0);
    unsigned nloc = b.st[0], nx = b.st[1];
    if (nloc == 0u) { xcd_barrier_complete(bar, b.x, nloc, nx); b.st[0] = nloc; b.st[1] = nx; }
    const unsigned old = xb_add(&bar[XB_XSUB(b.x)], 1u);
    const unsigned gen = old / nloc;
    if (old + 1u == (gen + 1u) * nloc) {
      __builtin_amdgcn_fence(__ATOMIC_RELEASE, "agent");
      asm volatile("s_waitcnt vmcnt(0)" ::: "memory");
      const unsigned og = xb_add(&bar[XB_TOP], 1u);
      const unsigned tg = og / nx;
      if (og + 1u == (tg + 1u) * nx) xb_add(&bar[XB_TOPGEN], 1u);
      else XB_SPIN(xb_ld(&bar[XB_TOPGEN]) == tg, bar);
      __builtin_amdgcn_fence(__ATOMIC_ACQUIRE, "agent");
      xb_add(&bar[XB_XGEN(b.x)], 1u);
      asm volatile("s_waitcnt vmcnt(0)" ::: "memory");
    } else {
      XB_SPIN(xb_ld(&bar[XB_XGEN(b.x)]) == gen, bar);
      __builtin_amdgcn_fence(__ATOMIC_ACQUIRE, "agent");
      asm volatile("s_waitcnt vmcnt(0)" ::: "memory");
    }
  }
  __syncthreads();
}

template <int l>
__device__ __forceinline__ void layer_body(const P& p, char* smem, pg8::PG8_LAS_T lds, volatile LAS unsigned* xbw, const int nb, const int bid) {
    const bool last = (l == 1);
    const int n_mt = last ? 128 : 136;
    if (l == 0) {
      phase_norm(p, l, 0);
      xcd_barrier(p.counters + 1024, xbw);
    }
_Pragma("unroll 1")
    for (int rep = 0; rep < REP_INPROJ; ++rep) {
      pg8::Gemm g; pg8::Order S;
      g.A = (const u16*)p.xn8; g.Bt = (const u16*)(p.Win8 + (size_t)l * 2816 * 1024); g.lda = 512; g.ldb = 512; g.K = 512;
      S.init(136, 6, nb, bid, 4, 5);
      pg8::EpiInprojN8 e1; e1.qk = p.qk; e1.rg = p.rg; e1.sa = p.sa; e1.sw = p.sw + l * 5888;
      pg8::gemm_phase(lds, g, S, e1);
      g.A = (const u16*)(p.Win8 + ((size_t)l * 2816 + 1024) * 1024); g.Bt = (const u16*)p.xn8;
      S.init(5, 136, nb, (bid + nb - (136 * 6) % nb) % nb);
      pg8::EpiInprojT8 e2; e2.vT = p.vT; e2.sa = p.sa; e2.sw = p.sw + l * 5888 + 1024;
      pg8::gemm_phase(lds, g, S, e2);
    }
    xcd_barrier(p.counters + 1024, xbw);
    phase_mixers(p, l, smem, p.counters + l * 4);
    xcd_barrier(p.counters + 1024, xbw);
    {
      volatile int* s_taskp = (volatile int*)(smem + SMEM_BYTES - 16);
      unsigned* counter = p.counters + 64 + l;
      int nxt = 0;
      if (threadIdx.x == 0) nxt = (int)atomicAdd(counter, 1u);
      for (;;) {
        __syncthreads();
        if (threadIdx.x == 0) *s_taskp = nxt;
        __syncthreads();
        const int task = *s_taskp;
        if (task >= 1088 + 512) break;
        if (threadIdx.x == 0) nxt = (int)atomicAdd(counter, 1u);
        if (task < 1088) rg_wave_task(p, l, task >> 2, task & 3, 1, last, smem);
        else yb_transpose_task(p, (task - 1088) >> 6, (task - 1088) & 63, smem);
      }
      __syncthreads();
    }
_Pragma("unroll 1")
    for (int rep = 0; rep < REP_GATE; ++rep) {
      pg8::Gemm g; pg8::Order S;
      g.A = (const u16*)p.xn8; g.Bt = (const u16*)(p.Wg8 + (size_t)l * 3072 * 1024); g.lda = 512; g.ldb = 512; g.K = 512;
      S.init(n_mt, 12, nb, bid);
      pg8::EpiGate8 e; e.g8 = p.g8; e.bias = p.b_gate + l * 3072; e.sa = p.sa; e.sw = p.sw + l * 5888 + 2816;
      pg8::gemm_phase(lds, g, S, e);
    }
    xcd_barrier(p.counters + 1024, xbw);
_Pragma("unroll 1")
    for (int rep = 0; rep < REP_BRANCH; ++rep) {
      pg8::Gemm g; pg8::Order S;
      S.init(n_mt, 4, nb, bid);
      pg8::EpiBranchF e; e.mbuf = p.mbuf; e.g8 = p.g8;
      g.A = p.ycat; g.lda = 1024; g.Bt = p.WaT + (size_t)l * 1024 * 1024; g.ldb = 1024; g.K = 1024;
      pg8::gemm_phase(lds, g, S, e);
    }
    xcd_barrier(p.counters + 1024, xbw);
    {
      pg8::Gemm g; pg8::Order S;
      g.A = p.mbuf; g.Bt = p.WoT + (size_t)l * 1024 * 1024; g.lda = 1024; g.ldb = 1024; g.K = 1024;
      S.init(n_mt, 4, nb, bid);
      pg8::EpiOutR<(l == 0)> e; e.xsrc = p.x; e.csrc = p.ctx; e.res = p.res;
      e.modl = p.mod + (size_t)l * 9 * 6144;
_Pragma("unroll 1")
      for (int half = 0; half < 2; ++half) {
        if ((bid & 1) != half) {
          const int nx = (n_mt * 4) % nb;
          const int cb = bid - nx, cnb = nb - nx;
          if (cb >= 0)
            for (int t = cb; t < 4096; t += 8 * cnb) {
              cvt_chunk_fp4x8(p.peer_u + (size_t)l * 16384 * 1024, p.Ub, t, cnb, 4096, 64.0f, 0);
              cvt_chunk_fp4x8(p.peer_v + (size_t)l * 16384 * 1024, p.Ub, t, cnb, 4096, 4.0f, 1);
            }
        }
        if (half == 0) pg8::gemm_phase(lds, g, S, e);
      }
    }
    xcd_barrier(p.counters + 1024, xbw);
    phase_norm(p, l, 1);
    xcd_barrier(p.counters + 1024, xbw);
_Pragma("unroll 1")
    for (int rep = 0; rep < REP_Q; ++rep) {
      pg8::Gemm g; pg8::Order S;
      g.A = (const u16*)p.xn8; g.Bt = p.WqkT + (size_t)l * 2048 * 1024; g.lda = 512; g.ldb = 1024; g.K = 512;
      S.init(n_mt, 8, nb, bid);
      pg8::EpiQ8 e; e.q = p.q; e.sa = p.sa; e.sw = p.swq + l * 2048;
      pg8::gemm_phase(lds, g, S, e);
    }
    xcd_barrier(p.counters + 1024, xbw);
_Pragma("unroll 1")
    for (int rep = 0; rep < REP_SCORE; ++rep)
    {
      uint4 q0, q1, q2, q3, q4, q5, q6, q7;
      {
        const int tid = opaque_tid();
        const int t0 = bid < n_mt * 16 ? bid : 0;
        uint4 pre[8];
        PS_LOAD(t0 >> 4, t0 & 15);
        q0 = pre[0]; q1 = pre[1]; q2 = pre[2]; q3 = pre[3]; q4 = pre[4]; q5 = pre[5]; q6 = pre[6]; q7 = pre[7];
      }
      for (int task = bid; task < n_mt * 16; task += nb) {
        const int nt_ = (task + nb < n_mt * 16) ? task + nb : task;
        peer_score_tile(p, l, task >> 4, task & 15, smem, q0, q1, q2, q3, q4, q5, q6, q7, nt_ >> 4, nt_ & 15);
      }
    }
    xcd_barrier(p.counters + 1024, xbw);
_Pragma("unroll 1")
    for (int rep = 0; rep < REP_PEER; ++rep) phase_peer_experts(p, l, rep == REP_PEER - 1, smem);
    if (!last) xcd_barrier(p.counters + 1024, xbw);
  }

__global__ void __launch_bounds__(NTHR) fwd_megakernel(P p) {
  __shared__ __attribute__((aligned(16))) char smem[SMEM_BYTES];
  cg::grid_group grid = cg::this_grid();
  const int nb = gridDim.x, bid = blockIdx.x;
  pg8::PG8_LAS_T lds = (pg8::PG8_LAS_T)smem;
  volatile LAS unsigned* xbw = (volatile LAS unsigned*)(smem + SMEM_BYTES - 32);
  if (threadIdx.x == 0) { xbw[0] = 0u; xbw[1] = 0u; xbw[2] = 0u; xbw[3] = 0u; }
  __syncthreads();
  (void)xcd_barrier_post(p.counters + 1024, xbw);

  phase_prep(p, smem, p.counters + 32);
  grid.sync();
  phase_modreduce(p);
  for (int task = blockIdx.x; task < 512; task += gridDim.x) kf_task(p, task >> 8, task & 255, smem);
  for (int task = blockIdx.x; task < 256; task += gridDim.x) wqk_task(p, task >> 7, (task >> 3) & 15, task & 7, smem);
  for (int task = blockIdx.x; task < 2 * 368; task += gridDim.x) {
    const int l = task / 368, t = task - l * 368;
    if (t < 176) tr_tile4<true>(p.w_in + (size_t)l * 1024 * 2816, 2816, 1024, p.Win8 + (size_t)l * 2816 * 1024, t, p.sw + l * 5888, smem);
    else tr_tile4<true>(p.w_gate + (size_t)l * 1024 * 3072, 3072, 1024, p.Wg8 + (size_t)l * 3072 * 1024, t - 176, p.sw + l * 5888 + 2816, smem);
  }
  xcd_barrier(p.counters + 1024, xbw);

  wqk_quant(p);
  layer_body<0>(p, smem, lds, xbw, nb, bid);
  layer_body<1>(p, smem, lds, xbw, nb, bid);
}

extern "C" void kernel_launch(void* const* d_in, const int* in_sizes, int n_in, void* d_out, int out_size, void* d_ws,
                              size_t ws_size, hipStream_t stream) {
  P p;
  memset(&p, 0, sizeof(p));
  const float** ins = (const float**)&p;
  for (int i = 0; i < 37; ++i) ins[i] = (const float*)d_in[i];
  p.out = (float*)d_out;
  char* w = (char*)d_ws;
  size_t off = 0;
  auto take = [&](size_t bytes) { char* r = w + off; off += (bytes + 255) & ~(size_t)255; return r; };
  p.counters = (unsigned*)take(32768);
  p.WinT = nullptr; p.WgT = nullptr;
  p.Win8 = (unsigned char*)take((size_t)2 * 2816 * 1024);
  p.Wg8 = (unsigned char*)take((size_t)2 * 3072 * 1024);
  p.sw = (float*)take((size_t)2 * 5888 * 4);
  p.xn8 = (unsigned char*)take((size_t)NTOK * 1024);
  p.sa = (float*)take((size_t)NTOK * 4);
  p.WaT = (u16*)take((size_t)2 * 1024 * 1024 * 2);
  p.WbT = nullptr; p.WcT = nullptr;
  p.WoT = (u16*)take((size_t)2 * 1024 * 1024 * 2);
  p.WqkT = (u16*)take((size_t)2 * 2048 * 1024 * 2);
  p.rgW = (u16*)take((size_t)2 * 16 * 4096 * 2);
  p.mod = (float*)take((size_t)2 * 9 * 6144 * 4);
  p.hc = (float*)take((size_t)512 * 256 * 4);
  p.Kf = (float*)take((size_t)2 * 256 * 8192 * 8);
  p.xn = (u16*)take((size_t)NTOK * 1024 * 2);
  p.qk = (u16*)take((size_t)NTOK * 1024 * 2);
  p.mbuf = p.xn;
  p.vT = (u16*)take((size_t)8 * 512 * 4096 * 2);
  p.vTc = (u16*)take((size_t)8 * 512 * 256 * 2);
  p.hyT = (u16*)take((size_t)8 * 768 * 4096 * 2);
  p.hyTc = (u16*)take((size_t)8 * 768 * 256 * 2);
  p.rg = (u16*)take((size_t)NTOK * 512 * 2);
  p.ycat = (u16*)take((size_t)NTOK * 1024 * 2);
  p.Ub = (unsigned char*)p.ycat;
  p.Vb = p.Ub + (size_t)16384 * 512;
  p.agg = (float*)take((size_t)8 * 2 * (136 + 34) * 256 * 8);
  p.ybT = (u16*)take((size_t)8 * 256 * 4096 * 2);
  p.hT = (float*)take((size_t)2 * 512 * 4096 * 4);
  p.WqB = (u16*)take((size_t)2 * 1024 * 2048 * 2);
  p.modpart = (float*)take((size_t)16 * 2 * 9 * 6144 * 4);
  p.keysB = (u16*)take((size_t)2 * 16 * 16384 * 2);
  p.res = (u16*)p.hT;
  {
    const size_t have = (size_t)((w + off) - (char*)p.hT), need = (size_t)NTOK * 1024 * 2;
    if (need > have) (void)take(need - have);
  }
  p.ctxs = nullptr;
  p.swq = (float*)take((size_t)2 * 2048 * 4);
  p.g8 = (unsigned char*)p.qk;
  p.q = p.qk;
  p.topk = (unsigned*)((char*)p.qk + (size_t)NTOK * 2048 * 2);
  if (off > ws_size) {
    fprintf(stderr, "workspace too small: need %zu have %zu\n", off, ws_size);
    return;
  }
  static int grid_blocks = 0;
  if (!grid_blocks) {
    int dev = 0, cus = 0, per_cu = 0;
    (void)hipGetDevice(&dev);
    (void)hipDeviceGetAttribute(&cus, hipDeviceAttributeMultiprocessorCount, dev);
    (void)hipOccupancyMaxActiveBlocksPerMultiprocessor(&per_cu, fwd_megakernel, NTHR, 0);
    if (per_cu > 1) per_cu = 1;
    grid_blocks = cus * per_cu;
  }
  (void)hipMemsetAsync(p.counters, 0, 32768, stream);
  void* args[] = {&p};
  hipError_t e = hipLaunchCooperativeKernel((void*)fwd_megakernel, dim3(grid_blocks), dim3(NTHR), args, 0, stream);
  if (e != hipSuccess) fprintf(stderr, "cooperative launch failed: %s (grid %d)\n", hipGetErrorString(e), grid_blocks);
}
```
